# Optimizing an MI355X kernel written in HIP

```python
import math
import jax, jax.numpy as jnp
from jax import lax
import numpy as np

D_MODEL = 1024
BATCH = 1
SEQ = 16384
DEPTH = 4

N_EVEN = (DEPTH + 1) // 2
N_ODD = DEPTH // 2
RMS_EPS = 1e-6
DA_HEADS = 4
DA_HEAD_DIM = 64
DA_V_DIM = 2 * DA_HEAD_DIM
DA_QK_WIDTH = 2 * DA_HEADS * DA_HEAD_DIM
DA_V_WIDTH = DA_HEADS * DA_V_DIM
Q_BLOCK = 128
ROPE_THETA = 500000.0
ROT_DIM = DA_HEAD_DIM // 4
SUBLN_EPS = 1e-5
SC_WIDTH = 512
SC_GROUPS = 8
SC_KERNEL = 3
EVEN_IN_WIDTH = 2 * DA_QK_WIDTH + DA_V_WIDTH + 3 * SC_WIDTH
EVEN_MIX_WIDTH = DA_V_WIDTH + SC_WIDTH
DN_HEADS = 8
DN_HEAD_DIM = 128
DN_WIDTH = DN_HEADS * DN_HEAD_DIM
DN_CONV = 4
DN_CHUNK = 64
ODD_IN_WIDTH = 4 * DN_WIDTH + 2 * DN_HEADS
D_FF = 3584
N_EXPERTS = 8
TOP_K = 2
EXPERT_D_FF = 3584
MOE_BLOCK = 256
PLE_DIM = 256

kernel_name = "hybrid_diffattn_shortconv_gdn_moe_trunk"


def rmsnorm(x, g, eps=RMS_EPS):
    xf = x.astype(jnp.float32)
    y = xf * lax.rsqrt(jnp.mean(xf * xf, axis=-1, keepdims=True) + eps)
    return (y * g.astype(jnp.float32)).astype(x.dtype)


def split_cols(t, widths):
    idx = np.cumsum(widths)[:-1].tolist()
    return jnp.split(t, idx, axis=-1)


def causal_dwconv(u, w):
    K = w.shape[0]
    S = u.shape[1]
    up = jnp.pad(u, ((0, 0), (K - 1, 0), (0, 0)))
    out = up[:, 0:S] * w[0]
    for j in range(1, K):
        out = out + up[:, j:j + S] * w[j]
    return out


def partial_rotary(x, positions):
    inv_freq = ROPE_THETA ** (-jnp.arange(0, ROT_DIM, 2, dtype=jnp.float32) / ROT_DIM)
    ang = positions.astype(jnp.float32)[..., None] * inv_freq
    cos = jnp.cos(ang)[:, :, None, :]
    sin = jnp.sin(ang)[:, :, None, :]
    xr = x[..., :ROT_DIM].astype(jnp.float32)
    x1, x2 = xr[..., :ROT_DIM // 2], xr[..., ROT_DIM // 2:]
    rot = jnp.concatenate([x1 * cos - x2 * sin, x2 * cos + x1 * sin], axis=-1).astype(x.dtype)
    return jnp.concatenate([rot, x[..., ROT_DIM:]], axis=-1)


def lambda_init(layer_idx):
    return 0.8 - 0.6 * math.exp(-0.3 * layer_idx)


def diff_attention(q, k, v, lam, positions):
    Bsz, H2, S, dh = q.shape
    H = H2 // 2
    nqb = S // Q_BLOCK
    qf = (q.astype(jnp.float32) * (dh ** -0.5)).reshape(Bsz, H2, nqb, Q_BLOCK, dh).transpose(2, 0, 1, 3, 4)
    qpos = positions.reshape(Bsz, nqb, Q_BLOCK).transpose(1, 0, 2)
    kf = k.astype(jnp.float32)
    vf = v.astype(jnp.float32)

    def block(args):
        qb, pq = args
        s = jnp.einsum('bhqd,bhkd->bhqk', qb, kf)
        mask = positions[:, None, None, :] <= pq[:, None, :, None]
        s = jnp.where(mask, s, -jnp.inf)
        pm = jax.nn.softmax(s, axis=-1).reshape(Bsz, H, 2, Q_BLOCK, S)
        a = pm[:, :, 0] - lam * pm[:, :, 1]
        return jnp.einsum('bhqk,bhkv->bhqv', a, vf)

    out = lax.map(block, (qf, qpos))
    return out.transpose(1, 2, 0, 3, 4).reshape(Bsz, H, S, 2 * dh)


def even_mixer(hn, positions, w_in, w_out, lam_q1, lam_k1, lam_q2, lam_k2, subln_g, conv_w, layer_idx):
    Bsz, S, _ = hn.shape
    proj = hn @ w_in
    q, k, v, b_gate, c_gate, xb = split_cols(
        proj, [DA_QK_WIDTH, DA_QK_WIDTH, DA_V_WIDTH, SC_WIDTH, SC_WIDTH, SC_WIDTH])
    q = partial_rotary(q.reshape(Bsz, S, 2 * DA_HEADS, DA_HEAD_DIM), positions)
    k = partial_rotary(k.reshape(Bsz, S, 2 * DA_HEADS, DA_HEAD_DIM), positions)
    v = v.reshape(Bsz, S, DA_HEADS, DA_V_DIM)
    lam_0 = lambda_init(layer_idx)
    f32 = jnp.float32
    lam = (jnp.exp(jnp.sum(lam_q1.astype(f32) * lam_k1.astype(f32)))
           - jnp.exp(jnp.sum(lam_q2.astype(f32) * lam_k2.astype(f32))) + lam_0)
    o = diff_attention(q.transpose(0, 2, 1, 3), k.transpose(0, 2, 1, 3), v.transpose(0, 2, 1, 3), lam, positions)
    o = rmsnorm(o, subln_g, SUBLN_EPS) * (1.0 - lam_0)
    o = o.transpose(0, 2, 1, 3).reshape(Bsz, S, DA_V_WIDTH).astype(hn.dtype)
    sc = b_gate * causal_dwconv(c_gate * xb, conv_w)
    return jnp.concatenate([o, sc], axis=-1) @ w_out


def l2norm(x, eps=1e-6):
    return x * lax.rsqrt(jnp.sum(x * x, axis=-1, keepdims=True) + eps)


def chunk_gated_delta_rule(q, k, v, g, beta):
    Bsz, S, H, dk = q.shape
    dv = v.shape[-1]
    C = DN_CHUNK
    N = S // C

    def chunks(t):
        t = jnp.moveaxis(t, 2, 1)
        return t.reshape(t.shape[:2] + (N, C) + t.shape[3:])

    q = chunks(q * (dk ** -0.5))
    k = chunks(k)
    v = chunks(v)
    g = jnp.cumsum(chunks(g), axis=-1)
    beta = chunks(beta)
    k_beta = k * beta[..., None]
    v_beta = v * beta[..., None]
    incl = jnp.tril(jnp.ones((C, C), dtype=bool))
    strict = jnp.tril(jnp.ones((C, C), dtype=bool), -1)
    gdiff = g[..., :, None] - g[..., None, :]
    decay = jnp.where(incl, jnp.exp(jnp.where(incl, gdiff, 0.0)), 0.0)
    L = jnp.where(strict, jnp.einsum('bhnid,bhnjd->bhnij', k_beta, k) * decay, 0.0)
    T = L + jnp.eye(C, dtype=jnp.float32)
    u = lax.linalg.triangular_solve(T, v_beta, left_side=True, lower=True, unit_diagonal=True)
    w = lax.linalg.triangular_solve(T, k_beta * jnp.exp(g)[..., None], left_side=True, lower=True,
                                    unit_diagonal=True)
    a_intra = jnp.einsum('bhnid,bhnjd->bhnij', q, k) * decay

    def step(state, xs):
        qi, ki, ui, wi, gi, ai = xs
        v_new = ui - jnp.einsum('bhcd,bhdv->bhcv', wi, state)
        o = (jnp.einsum('bhcd,bhdv->bhcv', qi * jnp.exp(gi)[..., None], state)
             + jnp.einsum('bhij,bhjv->bhiv', ai, v_new))
        g_last = gi[..., -1:]
        state = (state * jnp.exp(g_last)[..., None]
                 + jnp.einsum('bhcd,bhcv->bhdv', ki * jnp.exp(g_last - gi)[..., None], v_new))
        return state, o

    xs = tuple(jnp.moveaxis(t, 2, 0) for t in (q, k, u, w, g, a_intra))
    state0 = jnp.zeros((Bsz, H, dk, dv), jnp.float32)
    _, o = lax.scan(step, state0, xs)
    o = jnp.moveaxis(o, 0, 2).reshape(Bsz, H, S, dv)
    return jnp.moveaxis(o, 1, 2)


def odd_mixer(hn, w_in, conv_w, a_log, dt_bias, onorm_g, w_out):
    Bsz, S, _ = hn.shape
    f32 = jnp.float32
    proj = hn @ w_in
    qkv, z, b, a = split_cols(proj, [3 * DN_WIDTH, DN_WIDTH, DN_HEADS, DN_HEADS])
    qkv = jax.nn.silu(causal_dwconv(qkv, conv_w))
    q, k, v = jnp.split(qkv.astype(f32), 3, axis=-1)
    q = l2norm(q.reshape(Bsz, S, DN_HEADS, DN_HEAD_DIM))
    k = l2norm(k.reshape(Bsz, S, DN_HEADS, DN_HEAD_DIM))
    v = v.reshape(Bsz, S, DN_HEADS, DN_HEAD_DIM)
    beta = jax.nn.sigmoid(b.astype(f32))
    g = -jnp.exp(a_log.astype(f32)) * jax.nn.softplus(a.astype(f32) + dt_bias.astype(f32))
    o = chunk_gated_delta_rule(q, k, v, g, beta)
    o = rmsnorm(o, onorm_g) * jax.nn.silu(z.astype(f32).reshape(Bsz, S, DN_HEADS, DN_HEAD_DIM))
    return o.reshape(Bsz, S, DN_WIDTH).astype(hn.dtype) @ w_out


def swiglu(xn, w1, w3, w2):
    return (jax.nn.silu(xn @ w1) * (xn @ w3)) @ w2


def moe_swiglu(xn, w_router, w1, w3, w2):
    Bsz, S, D = xn.shape
    T = Bsz * S
    xt = xn.reshape(T, D)
    logits = (xt @ w_router).astype(jnp.float32)
    top_logit, top_idx = lax.top_k(logits, TOP_K)
    gates = jax.nn.softmax(top_logit, axis=-1).astype(xn.dtype)
    n_assign = T * TOP_K
    e_flat = top_idx.reshape(-1).astype(jnp.int32)
    tok_flat = jnp.repeat(jnp.arange(T, dtype=jnp.int32), TOP_K)
    g_flat = gates.reshape(-1)
    order = jnp.argsort(e_flat)
    e_sorted = e_flat[order]
    counts = jnp.zeros((N_EXPERTS,), jnp.int32).at[e_flat].add(1)
    starts = jnp.cumsum(counts) - counts
    padded = ((counts + MOE_BLOCK - 1) // MOE_BLOCK) * MOE_BLOCK
    pends = jnp.cumsum(padded)
    pstarts = pends - padded
    dest = pstarts[e_sorted] + (jnp.arange(n_assign, dtype=jnp.int32) - starts[e_sorted])
    P = ((n_assign + MOE_BLOCK - 1) // MOE_BLOCK) * MOE_BLOCK + N_EXPERTS * MOE_BLOCK
    NB = P // MOE_BLOCK
    buf_tok = jnp.full((P,), T, jnp.int32).at[dest].set(tok_flat[order])
    buf_gate = jnp.zeros((P,), xn.dtype).at[dest].set(g_flat[order])
    blk_e = jnp.minimum(
        jnp.searchsorted(pends, jnp.arange(NB, dtype=jnp.int32) * MOE_BLOCK, side='right'), N_EXPERTS - 1)
    x_pad = jnp.concatenate([xt, jnp.zeros((1, D), xt.dtype)], axis=0)

    def run_block(args):
        tok, gate, e = args
        xb = x_pad[tok]
        hb = jax.nn.silu(xb @ w1[e]) * (xb @ w3[e])
        return (hb @ w2[e]) * gate[:, None]

    y = lax.map(run_block, (buf_tok.reshape(NB, MOE_BLOCK), buf_gate.reshape(NB, MOE_BLOCK), blk_e))
    out = jnp.zeros((T + 1, D), xn.dtype).at[buf_tok].add(y.reshape(P, D))
    return out[:T].reshape(Bsz, S, D)


def setup_inputs(seed: int = 0) -> dict:
    key = jax.random.key(seed)
    ks = jax.random.split(key, 32)
    f32 = jnp.float32

    def nrm(k, shape, fan_in):
        return jax.random.normal(k, shape, f32) * (fan_in ** -0.5)

    def gain(k, shape):
        return 1.0 + 0.05 * jax.random.normal(k, shape, f32)

    x = jax.random.normal(ks[0], (BATCH, SEQ, D_MODEL), f32)
    p = jax.random.normal(ks[1], (DEPTH, BATCH, SEQ, PLE_DIM), f32)
    positions = jnp.tile(jnp.arange(SEQ, dtype=jnp.int32)[None, :], (BATCH, 1))
    ln_mix = gain(ks[2], (DEPTH, D_MODEL))
    ln_ffn = gain(ks[3], (DEPTH, D_MODEL))
    ln_ple = gain(ks[4], (DEPTH, D_MODEL))
    ln_final = gain(ks[5], (D_MODEL,))
    w_in_even = nrm(ks[6], (N_EVEN, D_MODEL, EVEN_IN_WIDTH), D_MODEL)
    w_out_even = nrm(ks[7], (N_EVEN, EVEN_MIX_WIDTH, D_MODEL), EVEN_MIX_WIDTH)
    lam_q1 = 0.1 * jax.random.normal(ks[8], (N_EVEN, DA_HEAD_DIM), f32)
    lam_k1 = 0.1 * jax.random.normal(ks[9], (N_EVEN, DA_HEAD_DIM), f32)
    lam_q2 = 0.1 * jax.random.normal(ks[10], (N_EVEN, DA_HEAD_DIM), f32)
    lam_k2 = 0.1 * jax.random.normal(ks[11], (N_EVEN, DA_HEAD_DIM), f32)
    subln_gain = gain(ks[12], (N_EVEN, DA_V_DIM))
    conv_w_short = nrm(ks[13], (N_EVEN, SC_KERNEL, SC_WIDTH), SC_KERNEL)
    w_in_odd = nrm(ks[14], (N_ODD, D_MODEL, ODD_IN_WIDTH), D_MODEL)
    conv_w_qkv = nrm(ks[15], (N_ODD, DN_CONV, 3 * DN_WIDTH), DN_CONV)
    a_log = jnp.log(jax.random.uniform(ks[16], (N_ODD, DN_HEADS), f32, 1.0, 16.0))
    dt = jnp.exp(jax.random.uniform(ks[17], (N_ODD, DN_HEADS), f32, math.log(1e-3), math.log(1e-1)))
    dt_bias = dt + jnp.log(-jnp.expm1(-dt))
    onorm_gain = gain(ks[18], (N_ODD, DN_HEAD_DIM))
    w_out_odd = nrm(ks[19], (N_ODD, DN_WIDTH, D_MODEL), DN_WIDTH)
    w1_dense = nrm(ks[20], (N_EVEN, D_MODEL, D_FF), D_MODEL)
    w3_dense = nrm(ks[21], (N_EVEN, D_MODEL, D_FF), D_MODEL)
    w2_dense = nrm(ks[22], (N_EVEN, D_FF, D_MODEL), D_FF)
    w_router = nrm(ks[23], (N_ODD, D_MODEL, N_EXPERTS), D_MODEL)
    w1_moe = nrm(ks[24], (N_ODD, N_EXPERTS, D_MODEL, EXPERT_D_FF), D_MODEL)
    w3_moe = nrm(ks[25], (N_ODD, N_EXPERTS, D_MODEL, EXPERT_D_FF), D_MODEL)
    w2_moe = nrm(ks[26], (N_ODD, N_EXPERTS, EXPERT_D_FF, D_MODEL), EXPERT_D_FF)
    w_ple_gate = nrm(ks[27], (DEPTH, D_MODEL, D_MODEL), D_MODEL)
    w_ple_proj = nrm(ks[28], (DEPTH, PLE_DIM, D_MODEL), PLE_DIM)
    return {"x": x, "p": p, "positions": positions, "ln_mix": ln_mix, "ln_ffn": ln_ffn,
            "ln_ple": ln_ple, "ln_final": ln_final, "w_in_even": w_in_even, "w_out_even": w_out_even,
            "lam_q1": lam_q1, "lam_k1": lam_k1, "lam_q2": lam_q2, "lam_k2": lam_k2,
            "subln_gain": subln_gain, "conv_w_short": conv_w_short, "w_in_odd": w_in_odd,
            "conv_w_qkv": conv_w_qkv, "a_log": a_log, "dt_bias": dt_bias, "onorm_gain": onorm_gain,
            "w_out_odd": w_out_odd, "w1_dense": w1_dense, "w3_dense": w3_dense, "w2_dense": w2_dense,
            "w_router": w_router, "w1_moe": w1_moe, "w3_moe": w3_moe, "w2_moe": w2_moe,
            "w_ple_gate": w_ple_gate, "w_ple_proj": w_ple_proj}


def reference(x, p, positions, ln_mix, ln_ffn, ln_ple, ln_final, w_in_even, w_out_even,
              lam_q1, lam_k1, lam_q2, lam_k2, subln_gain, conv_w_short, w_in_odd, conv_w_qkv,
              a_log, dt_bias, onorm_gain, w_out_odd, w1_dense, w3_dense, w2_dense,
              w_router, w1_moe, w3_moe, w2_moe, w_ple_gate, w_ple_proj):
    h = x
    for i in range(DEPTH):
        j = i // 2
        hn = rmsnorm(h, ln_mix[i])
        if i % 2 == 0:
            h = h + even_mixer(hn, positions, w_in_even[j], w_out_even[j], lam_q1[j], lam_k1[j],
                               lam_q2[j], lam_k2[j], subln_gain[j], conv_w_short[j], i)
            hn = rmsnorm(h, ln_ffn[i])
            h = h + swiglu(hn, w1_dense[j], w3_dense[j], w2_dense[j])
        else:
            h = h + odd_mixer(hn, w_in_odd[j], conv_w_qkv[j], a_log[j], dt_bias[j], onorm_gain[j],
                              w_out_odd[j])
            hn = rmsnorm(h, ln_ffn[i])
            h = h + moe_swiglu(hn, w_router[j], w1_moe[j], w3_moe[j], w2_moe[j])
        gate = jax.nn.sigmoid(rmsnorm(h, ln_ple[i]) @ w_ple_gate[i])
        h = h + gate * (p[i] @ w_ple_proj[i])
    return rmsnorm(h, ln_final)
```

```cpp
#include <hip/hip_runtime.h>
#include <hip/hip_bf16.h>
#include <cstdio>
#include <cstdint>
#include <cmath>

constexpr int S_ = 16384, D_ = 1024, DEPTH_ = 4;
constexpr int EIN = 3072, OIN = 4096, OIN_SRC = 4112, DFF = 3584, NEXP = 8, PLE = 256;
constexpr int MOE_P = 2 * S_ + NEXP * 256;
constexpr int NCHUNK = S_ / 64, NUNIT = NCHUNK * 8;
constexpr float RMS_EPS = 1e-6f;

namespace pg8 {
#define PG8_LAS __attribute__((address_space(3)))
typedef unsigned short bf16_t;
typedef short bf16x8 __attribute__((ext_vector_type(8)));
typedef float f32x4 __attribute__((ext_vector_type(4)));
typedef float f32x2 __attribute__((ext_vector_type(2)));
typedef unsigned u32x4 __attribute__((ext_vector_type(4)));
typedef unsigned u32x2 __attribute__((ext_vector_type(2)));
constexpr int BM = 256, BK = 64, HALF = 128, HTB = HALF * BK * 2, STAGE_BYTES = 8 * HTB, NXCD = 8, WGM = 8;

__host__ __device__ __forceinline__ int lds_byte(int r, int c) { const int st = (r >> 4) * 2 + (c >> 5), rr = r & 15, cc = c & 31, ob = rr * 64 + cc * 2; return st * 1024 + (ob ^ (((ob >> 9) & 1) << 5)); }
__host__ __device__ __forceinline__ void stage_rc(int b, int& R, int& C) { const int st = b / 1024, sb = b % 1024, swz = sb ^ (((sb >> 9) & 1) << 5); R = (st >> 1) * 16 + swz / 64; C = (st & 1) * 32 + (swz % 64) / 2; }
__host__ __device__ __forceinline__ int perm32(int rho) { const int n = rho >> 4, i = rho & 15; return 8 * (i >> 2) + 4 * n + (i & 3); }

struct Unit { int pm, pn, be; };
struct Gemm { const bf16_t* A; const bf16_t* Bt; int M, N, K; size_t bstride; };

struct StaticOrder {
    int nM, nN, nwg, G, c;
    __host__ __device__ void init(int M, int N, int G_, int c_) { nM = M / BM; nN = N / BM; nwg = nM * nN; G = G_; c = c_; }
    __host__ __device__ bool next(int i, Unit& u) const {
        const long L = (long)i * G + c; if (L >= nwg) return false;
        int wgid = (int)L; { const int q = nwg / NXCD, r = nwg % NXCD, xcd = wgid % NXCD, off = wgid / NXCD; wgid = (xcd < r ? xcd * (q + 1) : r * (q + 1) + (xcd - r) * q) + off; }
        const int nig = WGM * nN, gid = wgid / nig, fm = gid * WGM, gsz = (nM - fm) < WGM ? (nM - fm) : WGM;
        u.pm = fm + ((wgid % nig) % gsz); u.pn = (wgid % nig) / gsz; u.be = 0; return true;
    }
    __device__ __forceinline__ void a_ready(const Unit&) const {}
    __device__ __forceinline__ void done(const Unit&) const {}
};
struct MoeOrder : StaticOrder {
    const PG8_LAS int* blk_e;
    __device__ __forceinline__ bool next(int i, Unit& u) const { if (!StaticOrder::next(i, u)) return false; u.be = blk_e[u.pm]; return true; }
};

__device__ __forceinline__ unsigned cvt_pk_bf16(float lo, float hi) { unsigned r; asm volatile("v_cvt_pk_bf16_f32 %0, %1, %2" : "=v"(r) : "v"(lo), "v"(hi)); return r; }
typedef __bf16 bf16x2_t_ __attribute__((ext_vector_type(2)));
__device__ __forceinline__ unsigned cvt_pk_bf16_cv(float lo, float hi) { const f32x2 v = {lo, hi}; const bf16x2_t_ b = __builtin_convertvector(v, bf16x2_t_); return __builtin_bit_cast(unsigned, b); }
__device__ __forceinline__ float bf_lo(unsigned w) { return __uint_as_float(w << 16); }
__device__ __forceinline__ float bf_hi(unsigned w) { return __uint_as_float(w & 0xffff0000u); }

__device__ __forceinline__ float rstd_row(const float* ssq, int row) {
    const f32x4* p = (const f32x4*)(ssq + (size_t)row * 16);
    const f32x4 a = p[0], b = p[1], c = p[2], d = p[3];
    const float s = (((a[0] + a[1]) + (a[2] + a[3])) + ((b[0] + b[1]) + (b[2] + b[3]))) + (((c[0] + c[1]) + (c[2] + c[3])) + ((d[0] + d[1]) + (d[2] + d[3])));
    return __builtin_amdgcn_rsqf(s * (1.0f / 1024.0f) + RMS_EPS);
}
__device__ __forceinline__ float sigmoidf_(float x) { return __builtin_amdgcn_rcpf(1.0f + __builtin_amdgcn_exp2f(-1.4426950408889634f * x)); }
__device__ __forceinline__ float siluf_(float x) { return x * sigmoidf_(x); }

constexpr float C2 = 0.125f * 1.4426950408889634f;

struct EpiProjEven {
    static constexpr bool PERM = true, AFTER_DRAIN = false;
    bf16_t* O; const float* ssq; const float* tab;
    __device__ __forceinline__ void operator()(const f32x4 (&acc)[2][2][4][2], const Unit& u, int wr, int wc, int fr, int fq) const {
        const int row0 = u.pm * BM + wr * 64 + fr, colt = u.pn * BM;
        const bool rot = (colt < 1024) && ((wc & 1) == 0);
        const float qs = (colt < 512) ? C2 : 1.0f;
#pragma unroll
        for (int ai = 0; ai < 2; ++ai)
#pragma unroll
            for (int m = 0; m < 4; ++m) {
                const int row = row0 + ai * HALF + m * 16; const float rs = rstd_row(ssq, row);
                f32x4 c0 = {1.f, 1.f, 1.f, 1.f}, c1 = c0, s0 = {0.f, 0.f, 0.f, 0.f}, s1 = s0;
                if (rot && fq < 2) { const f32x4* t = (const f32x4*)(tab + (size_t)row * 16); c0 = t[0]; c1 = t[1]; s0 = t[2]; s1 = t[3]; if (fq == 0) { s0 = -s0; s1 = -s1; } }
#pragma unroll
                for (int bj = 0; bj < 2; ++bj) {
                    f32x4 v0 = acc[ai][bj][m][0] * rs, v1 = acc[ai][bj][m][1] * rs;
                    if (rot) {
                        f32x4 p0, p1;
#pragma unroll
                        for (int i = 0; i < 4; ++i) { p0[i] = __shfl_xor(v0[i], 16); p1[i] = __shfl_xor(v1[i], 16); }
                        v0 = v0 * c0 + p0 * s0; v1 = v1 * c1 + p1 * s1;
                    }
                    v0 = v0 * qs; v1 = v1 * qs;
                    u32x4 w; w.x = cvt_pk_bf16(v0[0], v0[1]); w.y = cvt_pk_bf16(v0[2], v0[3]); w.z = cvt_pk_bf16(v1[0], v1[1]); w.w = cvt_pk_bf16(v1[2], v1[3]);
                    *(u32x4*)(O + (size_t)row * EIN + colt + bj * HALF + wc * 32 + 8 * fq) = w;
                }
                asm volatile("" ::: "memory");
            }
    }
};
struct EpiBf16 {
    static constexpr bool PERM = true, AFTER_DRAIN = false;
    bf16_t* O; int ldc; const float* ssq; float scale0; int scale_cols;
    __device__ __forceinline__ void operator()(const f32x4 (&acc)[2][2][4][2], const Unit& u, int wr, int wc, int fr, int fq) const {
        const int row0 = u.pm * BM + wr * 64 + fr, colt = u.pn * BM;
#pragma unroll
        for (int ai = 0; ai < 2; ++ai)
#pragma unroll
            for (int m = 0; m < 4; ++m) {
                const int row = row0 + ai * HALF + m * 16; const float rs = (ssq ? rstd_row(ssq, row) : 1.0f) * (colt < scale_cols ? scale0 : 1.0f);
#pragma unroll
                for (int bj = 0; bj < 2; ++bj) {
                    const f32x4 v0 = acc[ai][bj][m][0] * rs, v1 = acc[ai][bj][m][1] * rs;
                    u32x4 w; w.x = cvt_pk_bf16(v0[0], v0[1]); w.y = cvt_pk_bf16(v0[2], v0[3]); w.z = cvt_pk_bf16(v1[0], v1[1]); w.w = cvt_pk_bf16(v1[2], v1[3]);
                    *(u32x4*)(O + (size_t)row * ldc + colt + bj * HALF + wc * 32 + 8 * fq) = w;
                }
                if (m & 1) asm volatile("" ::: "memory");
            }
    }
};
struct EpiSwiglu {
    static constexpr bool PERM = true, AFTER_DRAIN = false;
    bf16_t* O; const float* ssq;
    __device__ __forceinline__ void operator()(const f32x4 (&acc)[2][2][4][2], const Unit& u, int wr, int wc, int fr, int fq) const {
        const int row0 = u.pm * BM + wr * 64 + fr, col = u.pn * HALF + wc * 32 + 8 * fq;
#pragma unroll
        for (int ai = 0; ai < 2; ++ai)
#pragma unroll
            for (int m = 0; m < 4; ++m) {
                const int row = row0 + ai * HALF + m * 16; const float rs = ssq ? rstd_row(ssq, row) : 1.0f;
                float o[8];
#pragma unroll
                for (int n = 0; n < 2; ++n)
#pragma unroll
                    for (int i = 0; i < 4; ++i) { const float a = acc[ai][0][m][n][i] * rs, b = acc[ai][1][m][n][i] * rs; o[4 * n + i] = siluf_(a) * b; }
                u32x4 w; w.x = cvt_pk_bf16(o[0], o[1]); w.y = cvt_pk_bf16(o[2], o[3]); w.z = cvt_pk_bf16(o[4], o[5]); w.w = cvt_pk_bf16(o[6], o[7]);
                *(u32x4*)(O + (size_t)row * DFF + col) = w;
                if (m & 1) asm volatile("" ::: "memory");
            }
    }
};
struct EpiResid {
    static constexpr bool PERM = true, AFTER_DRAIN = false;
    float* h; bf16_t* hb; float* ssq;
    __device__ __forceinline__ void operator()(const f32x4 (&acc)[2][2][4][2], const Unit& u, int wr, int wc, int fr, int fq) const {
        const int row0 = u.pm * BM + wr * 64 + fr, colt = u.pn * BM;
#pragma unroll
        for (int ai = 0; ai < 2; ++ai)
#pragma unroll
            for (int m = 0; m < 4; ++m) {
                const int row = row0 + ai * HALF + m * 16; float ss = 0.f;
#pragma unroll
                for (int bj = 0; bj < 2; ++bj) {
                    const size_t off = (size_t)row * D_ + colt + bj * HALF + wc * 32 + 8 * fq;
                    f32x4 x0 = *(const f32x4*)(h + off), x1 = *(const f32x4*)(h + off + 4);
                    x0 = x0 + acc[ai][bj][m][0]; x1 = x1 + acc[ai][bj][m][1];
                    *(f32x4*)(h + off) = x0; *(f32x4*)(h + off + 4) = x1;
                    ss += (x0[0] * x0[0] + x0[1] * x0[1]) + (x0[2] * x0[2] + x0[3] * x0[3]) + (x1[0] * x1[0] + x1[1] * x1[1]) + (x1[2] * x1[2] + x1[3] * x1[3]);
                    u32x4 w; w.x = cvt_pk_bf16(x0[0], x0[1]); w.y = cvt_pk_bf16(x0[2], x0[3]); w.z = cvt_pk_bf16(x1[0], x1[1]); w.w = cvt_pk_bf16(x1[2], x1[3]);
                    *(u32x4*)(hb + off) = w;
                }
                ss += __shfl_xor(ss, 16); ss += __shfl_xor(ss, 32);
                if (fq == 0) ssq[(size_t)row * 16 + u.pn * 4 + wc] = ss;
                asm volatile("" ::: "memory");
            }
    }
};
struct EpiPle {
    static constexpr bool PERM = true, AFTER_DRAIN = false;
    float* h; bf16_t* hb; const float* ssq_in; float* ssq_out; const bf16_t* pp;
    __device__ __forceinline__ void operator()(const f32x4 (&acc)[2][2][4][2], const Unit& u, int wr, int wc, int fr, int fq) const {
        const int row0 = u.pm * BM + wr * 64 + fr, colt = u.pn * BM;
#pragma unroll
        for (int ai = 0; ai < 2; ++ai)
#pragma unroll
            for (int m = 0; m < 4; ++m) {
                const int row = row0 + ai * HALF + m * 16; const float rs = rstd_row(ssq_in, row); float ss = 0.f;
#pragma unroll
                for (int bj = 0; bj < 2; ++bj) {
                    const size_t off = (size_t)row * D_ + colt + bj * HALF + wc * 32 + 8 * fq;
                    f32x4 x0 = *(const f32x4*)(h + off), x1 = *(const f32x4*)(h + off + 4);
                    const u32x4 pw = *(const u32x4*)(pp + off);
                    const f32x4 a0 = acc[ai][bj][m][0] * rs, a1 = acc[ai][bj][m][1] * rs;
                    x0[0] += sigmoidf_(a0[0]) * bf_lo(pw.x); x0[1] += sigmoidf_(a0[1]) * bf_hi(pw.x); x0[2] += sigmoidf_(a0[2]) * bf_lo(pw.y); x0[3] += sigmoidf_(a0[3]) * bf_hi(pw.y);
                    x1[0] += sigmoidf_(a1[0]) * bf_lo(pw.z); x1[1] += sigmoidf_(a1[1]) * bf_hi(pw.z); x1[2] += sigmoidf_(a1[2]) * bf_lo(pw.w); x1[3] += sigmoidf_(a1[3]) * bf_hi(pw.w);
                    *(f32x4*)(h + off) = x0; *(f32x4*)(h + off + 4) = x1;
                    ss += (x0[0] * x0[0] + x0[1] * x0[1]) + (x0[2] * x0[2] + x0[3] * x0[3]) + (x1[0] * x1[0] + x1[1] * x1[1]) + (x1[2] * x1[2] + x1[3] * x1[3]);
                    u32x4 w; w.x = cvt_pk_bf16(x0[0], x0[1]); w.y = cvt_pk_bf16(x0[2], x0[3]); w.z = cvt_pk_bf16(x1[0], x1[1]); w.w = cvt_pk_bf16(x1[2], x1[3]);
                    *(u32x4*)(hb + off) = w;
                }
                ss += __shfl_xor(ss, 16); ss += __shfl_xor(ss, 32);
                if (fq == 0) ssq_out[(size_t)row * 16 + u.pn * 4 + wc] = ss;
                asm volatile("" ::: "memory");
            }
    }
};
struct EpiMoeDown {
    static constexpr bool PERM = true, AFTER_DRAIN = false;
    bf16_t* Y; const float* gate;
    __device__ __forceinline__ void operator()(const f32x4 (&acc)[2][2][4][2], const Unit& u, int wr, int wc, int fr, int fq) const {
        const int row0 = u.pm * BM + wr * 64 + fr, colt = u.pn * BM;
#pragma unroll
        for (int ai = 0; ai < 2; ++ai)
#pragma unroll
            for (int m = 0; m < 4; ++m) {
                const int row = row0 + ai * HALF + m * 16; const float gt = gate[row];
#pragma unroll
                for (int bj = 0; bj < 2; ++bj) {
                    const f32x4 v0 = acc[ai][bj][m][0] * gt, v1 = acc[ai][bj][m][1] * gt;
                    u32x4 w; w.x = cvt_pk_bf16(v0[0], v0[1]); w.y = cvt_pk_bf16(v0[2], v0[3]); w.z = cvt_pk_bf16(v1[0], v1[1]); w.w = cvt_pk_bf16(v1[2], v1[3]);
                    *(u32x4*)(Y + (size_t)row * D_ + colt + bj * HALF + wc * 32 + 8 * fq) = w;
                }
                if (m & 1) asm volatile("" ::: "memory");
            }
    }
};

template <class Epi, class Sched, bool ALIGN_EPI = false, bool SP2 = false>
__device__ __forceinline__ void gemm_phase(PG8_LAS unsigned char* lds, const Gemm g, const Sched& S, const Epi& E) {
    int tid_ = threadIdx.x; asm volatile("" : "+v"(tid_));
    const int tid = tid_, wid = __builtin_amdgcn_readfirstlane(tid >> 6), lane = tid & 63, wr = wid >> 2, wc = wid & 3, fr = lane & 15, fq = lane >> 4;
    const int K = g.K, nt = K / BK;
    unsigned voffA[2], voffB[2];
#pragma unroll
    for (int i = 0; i < 2; ++i) { int R, C; stage_rc(tid * 16 + i * 8192, R, C); const int Rb = Epi::PERM ? ((R & ~31) + perm32(R & 31)) : R;
        voffA[i] = (unsigned)(R * K + C) * 2u; voffB[i] = (unsigned)(Rb * K + C) * 2u; }
    const size_t kstep = (size_t)(BK * 2);
    const size_t hstep = (size_t)HALF * K * 2;
    const size_t tstep = 2 * hstep;
    const unsigned ldsw = (unsigned)wid * 1024u;
    const int aoff = lds_byte(wr * 64 + fr, fq * 8), boff = lds_byte(wc * 32 + fr, fq * 8);
#define PG8_SA(b, h) (((b) * 2 + (h)) * HTB)
#define PG8_SB(b, h) ((4 + (b) * 2 + (h)) * HTB)
#define PG8_STAGE(bufoff, gbase, voff) do { _Pragma("unroll") for (int _i = 0; _i < 2; ++_i) \
        __builtin_amdgcn_global_load_lds((const unsigned*)((const char*)(gbase) + (voff)[_i]), (PG8_LAS unsigned*)(lds + (bufoff) + ldsw + _i * 8192), 16, 0, 0); } while (0)
#define PG8_LDA(dst, b, h) do { _Pragma("unroll") for (int m = 0; m < 4; ++m) _Pragma("unroll") for (int k = 0; k < 2; ++k) dst[m][k] = *(const PG8_LAS bf16x8*)(lds + PG8_SA(b, h) + aoff + m * 2048 + k * 1024); } while (0)
#define PG8_LDB(dst, b, h) do { _Pragma("unroll") for (int n = 0; n < 2; ++n) _Pragma("unroll") for (int k = 0; k < 2; ++k) dst[n][k] = *(const PG8_LAS bf16x8*)(lds + PG8_SB(b, h) + boff + n * 2048 + k * 1024); } while (0)
#define PG8_MMA(ai, bj, At, Bt) do { __builtin_amdgcn_s_setprio(1); _Pragma("unroll") for (int m = 0; m < 4; ++m) _Pragma("unroll") for (int n = 0; n < 2; ++n) _Pragma("unroll") for (int k = 0; k < 2; ++k) \
        acc[ai][bj][m][n] = __builtin_amdgcn_mfma_f32_16x16x32_bf16(Bt[n][k], At[m][k], acc[ai][bj][m][n], 0, 0, 0); __builtin_amdgcn_s_setprio(0); } while (0)
#define PG8_WAIT_V(n) asm volatile("s_waitcnt vmcnt(" #n ")" ::: "memory")
#define PG8_WAIT_L(n) asm volatile("s_waitcnt lgkmcnt(" #n ")" ::: "memory")
#define PG8_BAR __builtin_amdgcn_s_barrier()
#define PG8_SCHED __builtin_amdgcn_sched_barrier(0)
    Unit cur, nxt; int ui = 0;
    if (!S.next(0, cur)) return;
    f32x4 acc[2][2][4][2];
#pragma unroll
    for (int a = 0; a < 2; ++a)
#pragma unroll
        for (int b = 0; b < 2; ++b)
#pragma unroll
            for (int m = 0; m < 4; ++m)
#pragma unroll
                for (int n = 0; n < 2; ++n) acc[a][b][m][n] = (f32x4){0.f, 0.f, 0.f, 0.f};
    bf16x8 At[4][2], B0[2][2], B1[2][2];
    const char* cA = (const char*)g.A + (size_t)cur.pm * tstep; const char* cB = (const char*)g.Bt + (size_t)cur.pn * tstep + (size_t)cur.be * g.bstride;
    S.a_ready(cur);
    if constexpr (SP2) {
        PG8_STAGE(PG8_SB(0, 0), cB, voffB); PG8_STAGE(PG8_SB(0, 1), cB + hstep, voffB); PG8_STAGE(PG8_SA(0, 0), cA, voffA); PG8_STAGE(PG8_SA(0, 1), cA + hstep, voffA);
        if (wr == 1) PG8_BAR;
        PG8_WAIT_V(2); PG8_BAR;
        PG8_STAGE(PG8_SB(1, 0), cB + kstep, voffB); PG8_STAGE(PG8_SA(1, 0), cA + kstep, voffA); PG8_STAGE(PG8_SB(1, 1), cB + hstep + kstep, voffB);
        PG8_WAIT_V(6); PG8_BAR;
    } else {
        PG8_STAGE(PG8_SB(0, 0), cB, voffB); PG8_STAGE(PG8_SA(0, 0), cA, voffA); PG8_STAGE(PG8_SB(0, 1), cB + hstep, voffB); PG8_STAGE(PG8_SA(0, 1), cA + hstep, voffA);
        if (wr == 1) PG8_BAR;
        PG8_WAIT_V(4); PG8_BAR;
        PG8_STAGE(PG8_SB(1, 0), cB + kstep, voffB); PG8_STAGE(PG8_SA(1, 0), cA + kstep, voffA); PG8_STAGE(PG8_SB(1, 1), cB + hstep + kstep, voffB);
        PG8_WAIT_V(6); PG8_BAR;
    }
    for (;;) {
        const bool has_next = S.next(ui + 1, nxt);
        const char* nA = has_next ? (const char*)g.A + (size_t)nxt.pm * tstep : cA; const char* nB = has_next ? (const char*)g.Bt + (size_t)nxt.pn * tstep + (size_t)nxt.be * g.bstride : cB;
        for (int t = 0; t < nt; t += 2) {
            const bool last = (t == nt - 2);
            const char* a1 = cA + (size_t)(t + 1) * kstep;
            const char* a2 = last ? nA : cA + (size_t)(t + 2) * kstep; const char* b2 = last ? nB : cB + (size_t)(t + 2) * kstep;
            const char* a3 = a2 + kstep; const char* b3 = b2 + kstep;
            if (last && has_next) S.a_ready(nxt);
            if constexpr (SP2) {
            PG8_LDB(B0, 0, 0); PG8_LDB(B1, 0, 1); PG8_SCHED; PG8_LDA(At, 0, 0); PG8_STAGE(PG8_SA(1, 1), a1 + hstep, voffA);
            PG8_WAIT_V(8); PG8_WAIT_L(0); PG8_BAR; PG8_MMA(0, 0, At, B0); PG8_MMA(0, 1, At, B1); PG8_BAR; PG8_SCHED;
            PG8_LDA(At, 0, 1); PG8_STAGE(PG8_SB(0, 0), b2, voffB); PG8_STAGE(PG8_SB(0, 1), b2 + hstep, voffB); PG8_STAGE(PG8_SA(0, 0), a2, voffA);
            PG8_WAIT_V(8); PG8_WAIT_L(0); PG8_BAR; PG8_MMA(1, 0, At, B0); PG8_MMA(1, 1, At, B1); PG8_BAR; PG8_SCHED;
            PG8_LDB(B0, 1, 0); PG8_LDB(B1, 1, 1); PG8_SCHED; PG8_LDA(At, 1, 0); PG8_STAGE(PG8_SA(0, 1), a2 + hstep, voffA);
            PG8_WAIT_V(8); PG8_WAIT_L(0); PG8_BAR; PG8_MMA(0, 0, At, B0); PG8_MMA(0, 1, At, B1); PG8_BAR; PG8_SCHED;
            PG8_LDA(At, 1, 1); PG8_STAGE(PG8_SB(1, 0), b3, voffB); PG8_STAGE(PG8_SB(1, 1), b3 + hstep, voffB); PG8_STAGE(PG8_SA(1, 0), a3, voffA);
            PG8_WAIT_V(8); PG8_WAIT_L(0); PG8_BAR; PG8_MMA(1, 0, At, B0); PG8_MMA(1, 1, At, B1); PG8_BAR; PG8_SCHED;
            } else {
            PG8_LDB(B0, 0, 0); PG8_SCHED; PG8_LDA(At, 0, 0); PG8_STAGE(PG8_SA(1, 1), a1 + hstep, voffA);
            PG8_WAIT_L(8); PG8_BAR; PG8_WAIT_L(0); PG8_MMA(0, 0, At, B0); PG8_BAR; PG8_SCHED;
            PG8_LDB(B1, 0, 1); PG8_STAGE(PG8_SB(0, 0), b2, voffB);
            PG8_BAR; PG8_WAIT_L(0); PG8_MMA(0, 1, At, B1); PG8_BAR;
            PG8_LDA(At, 0, 1); PG8_STAGE(PG8_SA(0, 0), a2, voffA);
            PG8_BAR; PG8_WAIT_L(0); PG8_MMA(1, 0, At, B0); PG8_BAR; PG8_SCHED;
            PG8_STAGE(PG8_SB(0, 1), b2 + hstep, voffB);
            PG8_WAIT_V(6); PG8_BAR; PG8_MMA(1, 1, At, B1); PG8_BAR;
            PG8_LDB(B0, 1, 0); PG8_SCHED; PG8_LDA(At, 1, 0); PG8_STAGE(PG8_SA(0, 1), a2 + hstep, voffA);
            PG8_WAIT_L(8); PG8_BAR; PG8_WAIT_L(0); PG8_MMA(0, 0, At, B0); PG8_BAR; PG8_SCHED;
            PG8_LDB(B1, 1, 1); PG8_STAGE(PG8_SB(1, 0), b3, voffB);
            PG8_BAR; PG8_WAIT_L(0); PG8_MMA(0, 1, At, B1); PG8_BAR;
            PG8_LDA(At, 1, 1); PG8_STAGE(PG8_SA(1, 0), a3, voffA);
            PG8_BAR; PG8_WAIT_L(0); PG8_MMA(1, 0, At, B0); PG8_BAR; PG8_SCHED;
            PG8_STAGE(PG8_SB(1, 1), b3 + hstep, voffB);
            PG8_WAIT_V(6); PG8_BAR; PG8_MMA(1, 1, At, B1); PG8_BAR;
            }
        }
        if constexpr (ALIGN_EPI) { if (wr == 0) PG8_BAR; }
        if constexpr (!Epi::AFTER_DRAIN) { E(acc, cur, wr, wc, fr, fq); S.done(cur); }
        if (!has_next) break;
#pragma unroll
        for (int a = 0; a < 2; ++a)
#pragma unroll
            for (int b = 0; b < 2; ++b)
#pragma unroll
                for (int m = 0; m < 4; ++m)
#pragma unroll
                    for (int n = 0; n < 2; ++n) acc[a][b][m][n] = (f32x4){0.f, 0.f, 0.f, 0.f};
        cur = nxt; cA = nA; cB = nB; ++ui;
        if constexpr (ALIGN_EPI) { if (wr == 1) PG8_BAR; }
    }
    PG8_WAIT_V(0);
    if constexpr (!ALIGN_EPI) { if (wr == 0) PG8_BAR; }
    PG8_BAR;
    if constexpr (Epi::AFTER_DRAIN) { E.fused(acc, cur, wr, wc, fr, fq, lds, wid, lane); S.done(cur); }
#undef PG8_SA
#undef PG8_SB
#undef PG8_STAGE
#undef PG8_LDA
#undef PG8_LDB
#undef PG8_MMA
#undef PG8_WAIT_V
#undef PG8_WAIT_L
#undef PG8_BAR
#undef PG8_SCHED
}
}

#include <hip/hip_bf16.h>
#include <cmath>
namespace attn_body {
using bf16=__hip_bfloat16;
using bf16x8=__attribute__((ext_vector_type(8)))short;
using s16x4=__attribute__((ext_vector_type(4)))short;
using f32x16=__attribute__((ext_vector_type(16)))float;
using u32x4=__attribute__((ext_vector_type(4)))unsigned;
constexpr int SEQ=16384,D=64,LDP=3072,LDO=1024;
constexpr int NW=8,QBLK=32,QB=QBLK*NW,KVBLK=64,NQB=SEQ/QB;
constexpr int ATTN_UNIT_ROWS=QB;
__device__ __forceinline__ int crow(int r,int hi){return (r&3)+8*(r>>2)+4*hi;}
#define SBAR() __builtin_amdgcn_sched_barrier(0)
__device__ __forceinline__ void cmask(f32x16&p0,f32x16&p1,int jb,int qrel,int hi){
  const float NEG=-INFINITY; int kb=64*jb+4*hi;
  #pragma unroll
  for(int r=0;r<16;++r){int kv=kb+(r&3)+8*(r>>2); if(kv>qrel)p0[r]=NEG; if(kv+32>qrel)p1[r]=NEG;}
}

constexpr int NSLOT=3, SLOTB=8192;
constexpr int LDS_K=0, LDS_V=NSLOT*SLOTB, LDS_WS=2*NSLOT*SLOTB, LDS_OST=LDS_WS+NW*64*4, LDS_BYTES=LDS_OST+NW*4096;
constexpr float C2=0.125f*1.4426950408889634f;
__device__ __forceinline__ void glds16(const void*gsrc,unsigned lds_dst){unsigned keep;
  asm volatile("s_mov_b32 %0, m0\n\ts_mov_b32 m0, %2\n\ts_nop 0\n\tglobal_load_lds_dwordx4 %1, off\n\ts_mov_b32 m0, %0":"=&s"(keep):"v"(gsrc),"s"(lds_dst):"memory");}
__device__ __forceinline__ float max3f(float a,float b,float c){float r;asm("v_max3_f32 %0, %1, %2, %3":"=v"(r):"v"(a),"v"(b),"v"(c));return r;}
__device__ __forceinline__ float max2f(float a,float b){float r;asm("v_max_f32_e32 %0, %1, %2":"=v"(r):"v"(a),"v"(b));return r;}
__device__ __forceinline__ float fadd_s(float a,float b){float r;asm("v_add_f32_e32 %0, %1, %2":"=v"(r):"v"(a),"v"(b));return r;}
__device__ __forceinline__ float fsub_s(float a,float b){float r;asm("v_sub_f32_e32 %0, %1, %2":"=v"(r):"v"(a),"v"(b));return r;}
typedef float f32x2_t __attribute__((ext_vector_type(2))); typedef __bf16 bf16x2_t __attribute__((ext_vector_type(2)));
__device__ __forceinline__ unsigned cvtpk_s(float lo,float hi){f32x2_t v={lo,hi};bf16x2_t b=__builtin_convertvector(v,bf16x2_t);return __builtin_bit_cast(unsigned,b);}
#define WAIT_BAR(N) asm volatile("s_waitcnt vmcnt(" #N ") lgkmcnt(0)\n\ts_barrier":::"memory")

__device__ __forceinline__ void qkt(f32x16&p0,f32x16&p1,const char*Kslot,const bf16x8*qr,int r32,int hi){
  const char*kb=Kslot+hi*1024+r32*16;
  #pragma unroll
  for(int d0=0;d0<4;++d0){
    const bf16x8 b0=*reinterpret_cast<const bf16x8*>(kb+d0*2048);
    const bf16x8 b1=*reinterpret_cast<const bf16x8*>(kb+d0*2048+512);
    if(d0==0){p0=__builtin_amdgcn_mfma_f32_32x32x16_bf16(b0,qr[0],f32x16{},0,0,0);p1=__builtin_amdgcn_mfma_f32_32x32x16_bf16(b1,qr[0],f32x16{},0,0,0);}
    else{p0=__builtin_amdgcn_mfma_f32_32x32x16_bf16(b0,qr[d0],p0,0,0,0);p1=__builtin_amdgcn_mfma_f32_32x32x16_bf16(b1,qr[d0],p1,0,0,0);}}
}
typedef __attribute__((address_space(3))) const char* lds_cptr;
typedef short v4i16_t __attribute__((ext_vector_type(4)));
__device__ __forceinline__ void kload8(bf16x8*kf,lds_cptr kp){
  kf[0]=*(const __attribute__((address_space(3))) bf16x8*)(kp);      kf[1]=*(const __attribute__((address_space(3))) bf16x8*)(kp+512);
  kf[2]=*(const __attribute__((address_space(3))) bf16x8*)(kp+2048); kf[3]=*(const __attribute__((address_space(3))) bf16x8*)(kp+2560);
  kf[4]=*(const __attribute__((address_space(3))) bf16x8*)(kp+4096); kf[5]=*(const __attribute__((address_space(3))) bf16x8*)(kp+4608);
  kf[6]=*(const __attribute__((address_space(3))) bf16x8*)(kp+6144); kf[7]=*(const __attribute__((address_space(3))) bf16x8*)(kp+6656);
}
__device__ __forceinline__ void kload2(bf16x8*kf,lds_cptr kp,int j){ kf[2*j]=*(const __attribute__((address_space(3))) bf16x8*)(kp+j*2048); kf[2*j+1]=*(const __attribute__((address_space(3))) bf16x8*)(kp+j*2048+512); }
__device__ __forceinline__ s16x4 vtr(lds_cptr p){ return __builtin_bit_cast(s16x4,__builtin_amdgcn_ds_read_tr16_b64_v4i16((__attribute__((address_space(3))) v4i16_t*)p)); }
__device__ __forceinline__ float rowmax(const f32x16&p0,const f32x16&p1){
  float a=max3f(p0[0],p0[1],p1[0]),b=max3f(p0[2],p0[3],p1[1]);a=max3f(a,p1[2],p1[3]);
  #pragma unroll
  for(int r=4;r<16;r+=4){a=max3f(a,p0[r],p0[r+1]);b=max3f(b,p0[r+2],p0[r+3]);a=max3f(a,p1[r],p1[r+1]);b=max3f(b,p1[r+2],p1[r+3]);}
  const float m=max2f(a,b);
  auto rr=__builtin_amdgcn_permlane32_swap(__float_as_uint(m),__float_as_uint(m),false,false);
  return max2f(__uint_as_float(rr[0]),__uint_as_float(rr[1]));
}
__device__ __forceinline__ void pv(f32x16*o,int vb,bf16x8 pa0,bf16x8 pa1,bf16x8 pa2,bf16x8 pa3){
  #pragma unroll
  for(int d0=0;d0<2;++d0){s16x4 lo[4],hi[4];
    #pragma unroll
    for(int ks=0;ks<4;++ks){
      asm volatile("ds_read_b64_tr_b16 %0,%1 offset:%c2":"=&v"(lo[ks]):"v"(vb),"i"(d0*4096+ks*1024):"memory");
      asm volatile("ds_read_b64_tr_b16 %0,%1 offset:%c2":"=&v"(hi[ks]):"v"(vb),"i"(d0*4096+ks*1024+512):"memory");}
    asm volatile("s_waitcnt lgkmcnt(0)":::"memory");SBAR();
    #define PK(k) (bf16x8){lo[k][0],lo[k][1],lo[k][2],lo[k][3],hi[k][0],hi[k][1],hi[k][2],hi[k][3]}
    o[d0]=__builtin_amdgcn_mfma_f32_32x32x16_bf16(pa0,PK(0),o[d0],0,0,0);
    o[d0]=__builtin_amdgcn_mfma_f32_32x32x16_bf16(pa1,PK(1),o[d0],0,0,0);
    o[d0]=__builtin_amdgcn_mfma_f32_32x32x16_bf16(pa2,PK(2),o[d0],0,0,0);
    o[d0]=__builtin_amdgcn_mfma_f32_32x32x16_bf16(pa3,PK(3),o[d0],0,0,0);
    #undef PK
  }
}

#ifndef ATTN_STORE16
#define ATTN_STORE16(p,v) (*(u32x4*)(p)=(v))
#endif
template<int THRL> __device__ __forceinline__ void attn_unit(int qb,const bf16*Qh,const bf16*__restrict__ Kh,const bf16*__restrict__ Vh,bf16*Oh,char*shm){
  const int tid=threadIdx.x,lane=tid&63,r32=lane&31,hi=lane>>5; const int wid=__builtin_amdgcn_readfirstlane(tid>>6);
  const int q0=qb*QB;
  const bf16*Qw=Qh+(long)(q0+wid*QBLK)*LDP;
  const unsigned lds0=(unsigned)(uintptr_t)shm;
  float*wsf=(float*)(shm+LDS_WS)+wid*64;
  const bf16*ksrc=Kh+(long)lane*LDP+wid*8;
  const bf16*vsrc=Vh+(long)(16*(wid&3)+(lane>>2))*LDP+(wid>>2)*32+(lane&3)*8;
  const unsigned kdst=lds0+LDS_K+wid*1024, vdst=lds0+LDS_V+wid*1024;
  #define DMA_K(t,slot) glds16(ksrc+(long)(t)*KVBLK*LDP,(unsigned)__builtin_amdgcn_readfirstlane(kdst+(slot)))
  #define DMA_V(t,slot) glds16(vsrc+(long)(t)*KVBLK*LDP,(unsigned)__builtin_amdgcn_readfirstlane(vdst+(slot)))
  const int vb0=(int)(lds0+LDS_V)+((lane>>4)&1)*32+(lane&3)*8+(4*hi+((lane&15)>>2))*64;
  const char*Kbase=shm+LDS_K; bf16x8 kf[8];
  const lds_cptr shm3=(lds_cptr)shm; const lds_cptr kp0=shm3+LDS_K+hi*1024+r32*16; const lds_cptr vp0=shm3+LDS_V+((lane>>4)&1)*32+(lane&3)*8+(4*hi+((lane&15)>>2))*64;
  const int NT=(q0+QB)/KVBLK;
  DMA_K(0,0);DMA_V(0,0);DMA_K(1,SLOTB);
  bf16x8 qr[4];
  #pragma unroll
  for(int d0=0;d0<4;++d0)qr[d0]=*reinterpret_cast<const bf16x8*>(&Qw[(long)r32*LDP+d0*16+hi*8]);
  float mhat=0.f,l_reg=0.f;f32x16 o[2];o[0]=f32x16{};o[1]=f32x16{};
  const int qrel=wid*QBLK+r32;
  #define CMASK(P0,P1,t) do{int jb_=(t)-(NT-4); if(jb_>=0)cmask(P0,P1,jb_,qrel,hi);}while(0)
  bool resc=false;
  #define START(P0,P1) do{ const float rm=rowmax(P0,P1); resc=false; mhat=rm; \
    _Pragma("unroll") for(int r=0;r<16;++r)P0[r]=__builtin_amdgcn_exp2f(fsub_s(P0[r],mhat)); }while(0)
  #define RESC() do{ if(resc){ asm volatile("s_waitcnt lgkmcnt(0)":::"memory"); \
      _Pragma("unroll") for(int d_=0;d_<2;++d_) _Pragma("unroll") for(int r=0;r<16;++r)o[d_][r]*=wsf[crow(r,hi)]; } }while(0)
  f32x16 pA0,pA1,pB0,pB1;
  int sl_prev=0,sl_cur=0,sl_next=SLOTB;
  #define ROT() do{sl_prev=sl_cur;sl_cur=sl_next;sl_next=(sl_next==(NSLOT-1)*SLOTB)?0:sl_next+SLOTB;}while(0)
  DMA_K(2,2*SLOTB);
  WAIT_BAR(3);
  qkt(pA0,pA1,Kbase,qr,r32,hi);asm volatile("s_nop 15\n\ts_nop 7":"+v"(pA0),"+v"(pA1));CMASK(pA0,pA1,0);
  START(pA0,pA1);
  _Pragma("unroll") for(int r=0;r<16;++r)pA1[r]=__builtin_amdgcn_exp2f(pA1[r]-mhat);
  WAIT_BAR(0);
  DMA_K(3,0);DMA_V(1,SLOTB);
  ROT();
  kload8(kf,kp0+sl_cur);
  WAIT_BAR(2);
  s16x4 vlo[8],vhi[8]; u32x4 pw0,pw1,pw2,pw3;
  #define PKW(P,B) cvtpk_s(P[B],P[B+1])
  #define PAF(k) __builtin_bit_cast(bf16x8,pw##k)
  #define VFR(i) (bf16x8){vlo[i][0],vlo[i][1],vlo[i][2],vlo[i][3],vhi[i][0],vhi[i][1],vhi[i][2],vhi[i][3]}
  #define PIN(x) asm volatile("":"+v"(x))
  #define MX3(a,b,c) __builtin_fmaxf(__builtin_fmaxf((a),(b)),(c))
  #define GAPA(MF,A0,A1,A2,A3,W0,W1,PW) do{ MF; sacc+=A0; sacc+=A1; sacc+=A2; sacc+=A3; PIN(sacc); W0; W1; PIN(PW); SBAR(); }while(0)
  #define EX(v) __builtin_amdgcn_exp2f(v)
  #define GAPB(MF,X,B) do{ MF; X[B]=EX(X[B]-mhat); X[B+1]=EX(X[B+1]-mhat); X[B+2]=EX(X[B+2]-mhat); X[B+3]=EX(X[B+3]-mhat); PIN(X); SBAR(); }while(0)
  #define VRD(i) do{ vlo[i]=vtr(vp_+(((i)>>2)*4096+((i)&3)*1024)); vhi[i]=vtr(vp_+(((i)>>2)*4096+((i)&3)*1024+512)); }while(0)
  #define KRD(G,j) do{ if(G){ kload2(kf,kp0+sl_next,j); SBAR(); } }while(0)
  #define STEP(C0,C1,P0,P1,t,GK,GV,GL) do{ SBAR(); \
    const lds_cptr vp_=vp0+sl_prev; \
    VRD(0); SBAR(); float sacc=(P0[0]+P0[1]); \
    GAPA(C0=__builtin_amdgcn_mfma_f32_32x32x16_bf16(kf[0],qr[0],f32x16{},0,0,0), P0[2],P0[3],P0[4],P0[5],     pw0[0]=PKW(P0,0), pw0[1]=PKW(P0,2), pw0); \
    VRD(4); SBAR(); GAPA(C1=__builtin_amdgcn_mfma_f32_32x32x16_bf16(kf[1],qr[0],f32x16{},0,0,0), P0[6],P0[7],P0[8],P0[9],     pw0[2]=PKW(P0,4), pw0[3]=PKW(P0,6), pw0); \
    VRD(1); SBAR(); GAPA(C0=__builtin_amdgcn_mfma_f32_32x32x16_bf16(kf[2],qr[1],C0,0,0,0),   P0[10],P0[11],P0[12],P0[13], pw1[0]=PKW(P0,8), pw1[1]=PKW(P0,10), pw1); \
    VRD(5); SBAR(); GAPA(C1=__builtin_amdgcn_mfma_f32_32x32x16_bf16(kf[3],qr[1],C1,0,0,0),   P0[14],P0[15],P1[0],P1[1],   pw1[2]=PKW(P0,12),pw1[3]=PKW(P0,14), pw1); \
    VRD(2); SBAR(); GAPA(C0=__builtin_amdgcn_mfma_f32_32x32x16_bf16(kf[4],qr[2],C0,0,0,0),   P1[2],P1[3],P1[4],P1[5],     pw2[0]=PKW(P1,0), pw2[1]=PKW(P1,2), pw2); \
    VRD(6); SBAR(); GAPA(C1=__builtin_amdgcn_mfma_f32_32x32x16_bf16(kf[5],qr[2],C1,0,0,0),   P1[6],P1[7],P1[8],P1[9],     pw2[2]=PKW(P1,4), pw2[3]=PKW(P1,6), pw2); \
    VRD(3); SBAR(); GAPA(C0=__builtin_amdgcn_mfma_f32_32x32x16_bf16(kf[6],qr[3],C0,0,0,0),   P1[10],P1[11],P1[12],P1[13], pw3[0]=PKW(P1,8), pw3[1]=PKW(P1,10), pw3); \
    VRD(7); SBAR(); GAPA(C1=__builtin_amdgcn_mfma_f32_32x32x16_bf16(kf[7],qr[3],C1,0,0,0),   P1[14],P1[15],0.f,0.f,       pw3[2]=PKW(P1,12),pw3[3]=PKW(P1,14), pw3); \
    l_reg+=sacc; \
    if(GK){DMA_K((t)+3,sl_cur);} if(GV){DMA_V((t)+1,sl_next);} \
    CMASK(C0,C1,t); \
    { float a=MX3(C0[0],C0[1],C1[0]),b=MX3(C0[2],C0[3],C1[1]); a=MX3(a,C1[2],C1[3]); \
      _Pragma("unroll") for(int r=4;r<16;r+=4){a=MX3(a,C0[r],C0[r+1]);b=MX3(b,C0[r+2],C0[r+3]);a=MX3(a,C1[r],C1[r+1]);b=MX3(b,C1[r+2],C1[r+3]);} \
      float rm=__builtin_fmaxf(a,b); { auto rr=__builtin_amdgcn_permlane32_swap(__float_as_uint(rm),__float_as_uint(rm),false,false); rm=__builtin_fmaxf(__uint_as_float(rr[0]),__uint_as_float(rr[1])); } \
      resc=false; const float rel=rm-mhat; \
      if(__builtin_expect(__any(rel>(float)THRL),0)){ const float dl=__builtin_fmaxf(rel,0.f); mhat+=dl; \
        const float f=__builtin_amdgcn_exp2f(-dl); l_reg*=f; if(hi==0)wsf[r32]=f; resc=true; } } \
    SBAR(); \
    GAPB(o[0]=__builtin_amdgcn_mfma_f32_32x32x16_bf16(PAF(0),VFR(0),o[0],0,0,0), C0,0); \
    GAPB(o[1]=__builtin_amdgcn_mfma_f32_32x32x16_bf16(PAF(0),VFR(4),o[1],0,0,0), C0,4); \
    KRD(GL,0); GAPB(o[0]=__builtin_amdgcn_mfma_f32_32x32x16_bf16(PAF(1),VFR(1),o[0],0,0,0), C0,8); \
    KRD(GL,1); GAPB(o[1]=__builtin_amdgcn_mfma_f32_32x32x16_bf16(PAF(1),VFR(5),o[1],0,0,0), C0,12); \
    KRD(GL,2); GAPB(o[0]=__builtin_amdgcn_mfma_f32_32x32x16_bf16(PAF(2),VFR(2),o[0],0,0,0), C1,0); \
    KRD(GL,3); GAPB(o[1]=__builtin_amdgcn_mfma_f32_32x32x16_bf16(PAF(2),VFR(6),o[1],0,0,0), C1,4); \
    GAPB(o[0]=__builtin_amdgcn_mfma_f32_32x32x16_bf16(PAF(3),VFR(3),o[0],0,0,0), C1,8); \
    GAPB(o[1]=__builtin_amdgcn_mfma_f32_32x32x16_bf16(PAF(3),VFR(7),o[1],0,0,0), C1,12); \
    }while(0)
  int t=1;
  #undef CMASK
  #define CMASK(P0,P1,t) do{}while(0)
  for(;t+5<NT;t+=2){
    STEP(pB0,pB1,pA0,pA1,t,true,true,true);     WAIT_BAR(2); RESC(); ROT();
    STEP(pA0,pA1,pB0,pB1,t+1,true,true,true);   WAIT_BAR(2); RESC(); ROT();
  }
  #undef CMASK
  int hi_b=hi,qrel_b=qrel; asm volatile("":"+v"(hi_b),"+v"(qrel_b));
  #define CMASK(P0,P1,t) do{int jb_=(t)-(NT-4); if(jb_>=0)cmask(P0,P1,jb_,qrel_b,hi_b);}while(0)
  #define ENDW(tt) do{ if((tt)+3<NT){WAIT_BAR(2);} else if((tt)+2<NT){WAIT_BAR(1);} else {WAIT_BAR(0);} }while(0)
  for(;t+1<NT;t+=2){
    STEP(pB0,pB1,pA0,pA1,t,(t+3<NT),(t+1<NT),(t+1<NT));       ENDW(t);   RESC(); ROT();
    STEP(pA0,pA1,pB0,pB1,t+1,(t+4<NT),(t+2<NT),(t+2<NT));     ENDW(t+1); RESC(); ROT();
  }
  STEP(pB0,pB1,pA0,pA1,NT-1,false,false,false); RESC();
  { float sacc=pB0[0]+pB0[1]; _Pragma("unroll") for(int r=2;r<16;++r)sacc+=pB0[r]; _Pragma("unroll") for(int r=0;r<16;++r)sacc+=pB1[r]; l_reg+=sacc;
    pw0=(u32x4){PKW(pB0,0),PKW(pB0,2),PKW(pB0,4),PKW(pB0,6)};pw1=(u32x4){PKW(pB0,8),PKW(pB0,10),PKW(pB0,12),PKW(pB0,14)};pw2=(u32x4){PKW(pB1,0),PKW(pB1,2),PKW(pB1,4),PKW(pB1,6)};pw3=(u32x4){PKW(pB1,8),PKW(pB1,10),PKW(pB1,12),PKW(pB1,14)};
    SBAR(); pv(o,vb0+sl_cur,PAF(0),PAF(1),PAF(2),PAF(3)); }
  #undef PKW
  #undef PAF
  #undef VFR
  #undef PIN
  #undef MX3
  #undef GAPA
  #undef GAPB
  #undef EX
  #undef VRD
  #undef KRD
  #undef STEP
  #undef ENDW
  {auto rr=__builtin_amdgcn_permlane32_swap(__float_as_uint(l_reg),__float_as_uint(l_reg),false,false);l_reg=__uint_as_float(rr[0])+__uint_as_float(rr[1]);}
  if(hi==0)wsf[32+r32]=l_reg;asm volatile("s_waitcnt lgkmcnt(0)":::"memory");
  float rli[16];
  #pragma unroll
  for(int r=0;r<16;++r)rli[r]=__builtin_amdgcn_rcpf(wsf[32+crow(r,hi)]);
  bf16*Ow=Oh+(long)(q0+wid*QBLK)*LDO;
  { bf16*stg=(bf16*)(shm+LDS_OST)+wid*2048;
    #pragma unroll
    for(int r=0;r<16;++r){const int orow=crow(r,hi);
      #pragma unroll
      for(int d0=0;d0<2;++d0)stg[orow*64+d0*32+r32]=__float2bfloat16(o[d0][r]*rli[r]);}
    asm volatile("s_waitcnt lgkmcnt(0)":::"memory");
    #pragma unroll
    for(int i=0;i<4;++i){const int row=i*8+(lane>>3),ch=lane&7; const u32x4 v=*(const u32x4*)(stg+row*64+ch*8); ATTN_STORE16(Ow+(long)row*LDO+ch*8,v);} }
  asm volatile("s_waitcnt lgkmcnt(0)\n\ts_barrier":::"memory");
  #undef DMA_K
  #undef DMA_V
  #undef CMASK
  #undef START
  #undef RESC
  #undef ROT
}
constexpr int ATTN_LDS_BYTES=LDS_BYTES;
template<int THRL=8> __device__ __forceinline__ void attn_phase(char*lds,const bf16*PE,bf16*AO,int vcu,int G){
  const int nu=(G==256)?4:((16*NQB-vcu+G-1)/G);
  #pragma unroll 1
  for(int i=0;i<nu;++i){
    int vh,qb;
    if(G==256){ const int s=vcu&15; vh=vcu>>4; qb=(i==0)?s:(i==1)?31-s:(i==2)?32+s:63-s; }
    else { const int u=vcu+i*G; vh=u/NQB; qb=u%NQB; }
    const int h2=vh>>1,half=vh&1;
    attn_unit<THRL>(qb,PE+h2*64,PE+512+h2*64,PE+1024+(h2>>1)*128+half*64,AO+vh*64,lds);
  }
}
#undef SBAR
#undef WAIT_BAR
}

#define GAS __attribute__((address_space(1)))
#define LAS __attribute__((address_space(3)))
typedef unsigned short bf16;
typedef unsigned v4u __attribute__((ext_vector_type(4)));
typedef float f32x4 __attribute__((ext_vector_type(4)));
typedef short bf16x8 __attribute__((ext_vector_type(8)));
typedef GAS unsigned gu32;
typedef GAS unsigned long long gu64;
#define RLX_AGENT __ATOMIC_RELAXED, __HIP_MEMORY_SCOPE_AGENT
#define LDS_WAIT() asm volatile("s_waitcnt lgkmcnt(0)" ::: "memory")
#define VM_WAIT() asm volatile("s_waitcnt vmcnt(0)" ::: "memory")
__device__ __forceinline__ unsigned long long rt() { return __builtin_amdgcn_s_memrealtime(); }
__device__ __forceinline__ unsigned f2bf(float f) { unsigned u = __builtin_bit_cast(unsigned, f); return (u + 0x7fffu + ((u >> 16) & 1u)) >> 16; }
__device__ __forceinline__ unsigned pk2(float lo, float hi) { return f2bf(lo) | (f2bf(hi) << 16); }

#define XB_TMO      128
#define XB_XCNT(j)  (256  + 64 * (j))
#define XB_XSUB(j)  (1280 + 64 * (j))
#define XB_XGEN(j)  (2304 + 64 * (j))
#define XB_TOP      3328
#define XB_TOPGEN   3392
#define XCD_BAR_WORDS 3456
#define XB_SPIN_CAP (1u << 18)

__device__ __forceinline__ unsigned xb_ld(unsigned* p)              { return __hip_atomic_load(p, __ATOMIC_RELAXED, __HIP_MEMORY_SCOPE_AGENT); }
__device__ __forceinline__ unsigned xb_add(unsigned* p, unsigned v) { return __hip_atomic_fetch_add(p, v, __ATOMIC_RELAXED, __HIP_MEMORY_SCOPE_AGENT); }
__device__ __forceinline__ unsigned xb_xcc_id() { return (unsigned)__builtin_amdgcn_s_getreg((3 << 11) | 20) & 0xFu; }
#define XB_SPIN(cond, bar) do { unsigned _sp = 0; while (cond) { __builtin_amdgcn_s_sleep(1); \
    if ((++_sp & 255u) == 0u) { if (xb_ld(&(bar)[XB_TMO])) break; if (_sp > XB_SPIN_CAP) { atomicAdd(&(bar)[XB_TMO], 1u); break; } } } } while (0)

struct XcdBarrier {
    unsigned* bar; unsigned x;
    volatile LAS unsigned* st;
};

__device__ __forceinline__ XcdBarrier xcd_barrier_post(unsigned* bar, volatile LAS unsigned* st) {
    XcdBarrier b; b.bar = bar; b.x = xb_xcc_id(); b.st = st;
    if (threadIdx.x == 0) (void)xb_add(&bar[XB_XCNT(b.x)], 1u);
    return b;
}
__device__ __forceinline__ void xcd_barrier_complete(unsigned* bar, unsigned x, unsigned& nloc, unsigned& nx) {
    const unsigned G = gridDim.x * gridDim.y * gridDim.z;
    unsigned sum, cnt, mine, sp = 0u;
    for (;;) {
        sum = 0u; cnt = 0u; mine = 0u;
#pragma unroll
        for (unsigned j = 0; j < 16; ++j) { const unsigned c = xb_ld(&bar[XB_XCNT(j)]); sum += c; cnt += (c > 0u) ? 1u : 0u; mine = (j == x) ? c : mine; }
        if (sum == G) break;
        __builtin_amdgcn_s_sleep(1);
        if ((++sp & 255u) == 0u) { if (xb_ld(&bar[XB_TMO])) break; if (sp > XB_SPIN_CAP) { atomicAdd(&bar[XB_TMO], 1u); break; } }
    }
    nloc = mine > 0u ? mine : 1u; nx = cnt > 0u ? cnt : 1u;
}

__device__ __forceinline__ void xcd_barrier(const XcdBarrier& b) {
    asm volatile("s_waitcnt vmcnt(0)" ::: "memory");
    __syncthreads();
    if (threadIdx.x == 0) {
        unsigned* bar = b.bar;
        __builtin_amdgcn_s_waitcnt(0);
        unsigned nloc = b.st[0], nx = b.st[1];
        if (nloc == 0u) { xcd_barrier_complete(bar, b.x, nloc, nx); b.st[0] = nloc; b.st[1] = nx; }
        const unsigned old = xb_add(&bar[XB_XSUB(b.x)], 1u);
        const unsigned gen = old / nloc;
        if (old + 1u == (gen + 1u) * nloc) {
            __builtin_amdgcn_fence(__ATOMIC_RELEASE, "agent");
            asm volatile("s_waitcnt vmcnt(0)" ::: "memory");
            const unsigned og = xb_add(&bar[XB_TOP], 1u);
            const unsigned tg = og / nx;
            if (og + 1u == (tg + 1u) * nx) xb_add(&bar[XB_TOPGEN], 1u);
            else XB_SPIN(xb_ld(&bar[XB_TOPGEN]) == tg, bar);
            __builtin_amdgcn_fence(__ATOMIC_ACQUIRE, "agent");
            xb_add(&bar[XB_XGEN(b.x)], 1u);
            asm volatile("s_waitcnt vmcnt(0)" ::: "memory");
        } else {
            XB_SPIN(xb_ld(&bar[XB_XGEN(b.x)]) == gen, bar);
            __builtin_amdgcn_fence(__ATOMIC_ACQUIRE, "agent");
            asm volatile("s_waitcnt vmcnt(0)" ::: "memory");
        }
    }
    __syncthreads();
}

constexpr int NWAVES = 8;
constexpr size_t MiB = 1u << 20;
constexpr size_t WS_CTL = 0, CTL_ZERO_BYTES = 1 * MiB;
constexpr size_t WS_TAB = 1 * MiB;
constexpr size_t WS_SSQA = 2 * MiB, WS_SSQB = 3 * MiB;
constexpr size_t WS_GB = 4 * MiB;
constexpr size_t WS_TOK = 5 * MiB;
constexpr size_t WS_W = 6 * MiB;
constexpr size_t WS_WINE = WS_W, WS_WOUTE = WS_W + 12 * MiB, WS_W13D = WS_W + 16 * MiB, WS_W2D = WS_W + 44 * MiB, WS_WINO = WS_W + 58 * MiB, WS_WOUTO = WS_W + 74 * MiB,
                 WS_WG = WS_W + 78 * MiB, WS_WP = WS_W + 86 * MiB, WS_W13M = WS_W + 88 * MiB, WS_W2M = WS_W + 200 * MiB;
constexpr size_t WS_PBF = 262 * MiB, WS_HBF = 294 * MiB, WS_PP = 326 * MiB, WS_MIX = 358 * MiB, WS_ARENA = 390 * MiB;
constexpr size_t AR_PE = 0, AR_AO = 96 * MiB;
constexpr size_t AR_PO = 0, AR_QN = 128 * MiB, AR_QT = 160 * MiB, AR_KN = 192 * MiB, AR_KGT = 224 * MiB, AR_VBT = 256 * MiB, AR_KTT = 288 * MiB, AR_AI = 320 * MiB, AR_NEGW = 336 * MiB,
                 AR_UT = 368 * MiB, AR_MP = 400 * MiB, AR_NT = 464 * MiB, AR_WT = 528 * MiB, AR_SG = 192 * MiB  , AR_END = 560 * MiB;
constexpr size_t AR_ACT = 0, AR_XS = 240 * MiB, AR_Y = 308 * MiB;
constexpr size_t WS_NEED = WS_ARENA + AR_END;
constexpr size_t TOK_E = 0, TOK_R = 128 * 1024, TOK_G = 256 * 1024, TOK_DST = 384 * 1024, TOK_GPAD = 512 * 1024, TOK_DN = 704 * 1024;
constexpr int CW_TMO = 0, CW_BAR = 4096, CW_CNT = 8192  , CW_DBG = 12288;

constexpr int RING_OFF = 0, WAVE_LDS = 17408;
constexpr int LDSCTL_OFF = 139264, MISC_OFF = LDSCTL_OFF + 64, BLKE_OFF = LDSCTL_OFF + 256  , RT_OFF = LDSCTL_OFF + 1024  ;
constexpr int LDS_BYTES = 147456;

typedef unsigned u32x2v __attribute__((ext_vector_type(2)));
__device__ __forceinline__ float bflo(unsigned w) { return __uint_as_float(w << 16); }
__device__ __forceinline__ float bfhi(unsigned w) { return __uint_as_float(w & 0xffff0000u); }
__device__ __forceinline__ unsigned cvtpk(float lo, float hi) { return pg8::cvt_pk_bf16_cv(lo, hi); }
__device__ __forceinline__ float wave_sum(float v) {
#pragma unroll
    for (int o = 1; o < 64; o <<= 1) v += __shfl_xor(v, o);
    return v;
}
__device__ __forceinline__ float sigm(float x) { return pg8::sigmoidf_(x); }
__device__ __forceinline__ float silu(float x) { return x * pg8::sigmoidf_(x); }

struct Args { const void* in[30]; float* out; unsigned char* ws; int ph_lo, ph_hi, use_bar, pad; };

struct Frame {
    LAS unsigned char* lds; int tid, lane, wave, vcu, G, gw, NGW;
};

__device__ __forceinline__ void xpose_item(const float* W, int ldw, int K, int N, const float* gain, bf16* WT, int ilv, LAS float* scr, int item, int lane) {
    const int nblk = N / 32, kb = item / nblk, nb = item % nblk, k0 = 64 * kb, n0 = 32 * nb;
#pragma unroll 8
    for (int i = 0; i < 32; ++i) { const int kk = 2 * i + (lane >> 5); const float gv = gain ? gain[k0 + kk] : 1.0f; scr[kk * 33 + (lane & 31)] = gv * W[(size_t)(k0 + kk) * ldw + n0 + (lane & 31)]; }
    LDS_WAIT(); asm volatile("" ::: "memory");
    const int c = lane & 7;
#pragma unroll
    for (int j = 0; j < 4; ++j) { const int nl = (lane >> 3) + 8 * j, n = n0 + nl; const LAS float* s = scr + (8 * c) * 33 + nl;
        const int dr = ilv ? (((n >> 7) << 8) + (n & 127) + (ilv == 2 ? 128 : 0)) : n;
        v4u o; o.x = pk2(s[0 * 33], s[1 * 33]); o.y = pk2(s[2 * 33], s[3 * 33]); o.z = pk2(s[4 * 33], s[5 * 33]); o.w = pk2(s[6 * 33], s[7 * 33]);
        *(GAS v4u*)(WT + (size_t)dr * K + k0 + 8 * c) = o; }
    LDS_WAIT(); asm volatile("" ::: "memory");
}
struct MatD { const float* W; int ldw, K, N; const float* gain; bf16* WT; int ilv; int items; };
__device__ __forceinline__ MatD dense_mat(const Args& a, int id) {
    unsigned char* ws = a.ws; MatD m; m.gain = nullptr; m.ilv = 0;
    if (id < 2)       { const int j = id;      m.W = (const float*)a.in[7] + (size_t)j * D_ * EIN;    m.ldw = EIN; m.K = D_; m.N = EIN; m.gain = (const float*)a.in[3] + (2 * j) * D_; m.WT = (bf16*)(ws + WS_WINE) + (size_t)j * EIN * D_; }
    else if (id < 4)  { const int j = id - 2;  m.W = (const float*)a.in[8] + (size_t)j * D_ * D_;     m.ldw = D_; m.K = D_; m.N = D_; m.WT = (bf16*)(ws + WS_WOUTE) + (size_t)j * D_ * D_; }
    else if (id < 6)  { const int j = id - 4;  m.W = (const float*)a.in[21] + (size_t)j * D_ * DFF;   m.ldw = DFF; m.K = D_; m.N = DFF; m.gain = (const float*)a.in[4] + (2 * j) * D_; m.WT = (bf16*)(ws + WS_W13D) + (size_t)j * 2 * DFF * D_; m.ilv = 1; }
    else if (id < 8)  { const int j = id - 6;  m.W = (const float*)a.in[22] + (size_t)j * D_ * DFF;   m.ldw = DFF; m.K = D_; m.N = DFF; m.gain = (const float*)a.in[4] + (2 * j) * D_; m.WT = (bf16*)(ws + WS_W13D) + (size_t)j * 2 * DFF * D_; m.ilv = 2; }
    else if (id < 10) { const int j = id - 8;  m.W = (const float*)a.in[23] + (size_t)j * DFF * D_;   m.ldw = D_; m.K = DFF; m.N = D_; m.WT = (bf16*)(ws + WS_W2D) + (size_t)j * D_ * DFF; }
    else if (id < 12) { const int j = id - 10; m.W = (const float*)a.in[15] + (size_t)j * D_ * OIN_SRC; m.ldw = OIN_SRC; m.K = D_; m.N = OIN; m.gain = (const float*)a.in[3] + (2 * j + 1) * D_; m.WT = (bf16*)(ws + WS_WINO) + (size_t)j * OIN * D_; }
    else if (id < 14) { const int j = id - 12; m.W = (const float*)a.in[20] + (size_t)j * D_ * D_;    m.ldw = D_; m.K = D_; m.N = D_; m.WT = (bf16*)(ws + WS_WOUTO) + (size_t)j * D_ * D_; }
    else if (id < 18) { const int i = id - 14; m.W = (const float*)a.in[28] + (size_t)i * D_ * D_;    m.ldw = D_; m.K = D_; m.N = D_; m.gain = (const float*)a.in[5] + i * D_; m.WT = (bf16*)(ws + WS_WG) + (size_t)i * D_ * D_; }
    else              { const int i = id - 18; m.W = (const float*)a.in[29] + (size_t)i * PLE * D_;   m.ldw = D_; m.K = PLE; m.N = D_; m.WT = (bf16*)(ws + WS_WP) + (size_t)i * D_ * PLE; }
    m.items = (m.K / 64) * (m.N / 32); return m;
}
__device__ __forceinline__ MatD moe_mat(const Args& a, int j, int id) {
    unsigned char* ws = a.ws; MatD m; m.gain = nullptr; m.ilv = 0; const int e = id / 3, k = id % 3;
    if (k < 2) { m.W = (const float*)a.in[25 + k] + ((size_t)j * NEXP + e) * D_ * DFF; m.ldw = DFF; m.K = D_; m.N = DFF; m.gain = (const float*)a.in[4] + (2 * j + 1) * D_; m.WT = (bf16*)(ws + WS_W13M) + (size_t)e * 2 * DFF * D_; m.ilv = 1 + k; }
    else       { m.W = (const float*)a.in[27] + ((size_t)j * NEXP + e) * DFF * D_; m.ldw = D_; m.K = DFF; m.N = D_; m.WT = (bf16*)(ws + WS_W2M) + (size_t)e * D_ * DFF; }
    m.items = (m.K / 64) * (m.N / 32); return m;
}

__device__ __forceinline__ void p_prologue(const Frame& F, const Args& a) {
    LAS float* scr = (LAS float*)(F.lds + F.wave * 16384);
    unsigned char* ws = a.ws;
    {
        int base = 0;
#pragma unroll 1
        for (int id = 0; id < 22; ++id) { const MatD m = dense_mat(a, id);
            int first = (F.gw - base) % F.NGW; if (first < 0) first += F.NGW;
#pragma unroll 1
            for (int it = first; it < m.items; it += F.NGW) xpose_item(m.W, m.ldw, m.K, m.N, m.gain, m.WT, m.ilv, scr, it, F.lane);
            base += m.items; }
    }
    { const float* p = (const float*)a.in[1]; bf16* pb = (bf16*)(ws + WS_PBF); const size_t n8 = (size_t)DEPTH_ * S_ * PLE / 8;
#pragma unroll 1
      for (size_t i = (size_t)F.gw * 64 + F.lane; i < n8; i += (size_t)F.NGW * 64) { const f32x4 x0 = *(const GAS f32x4*)(p + i * 8), x1 = *(const GAS f32x4*)(p + i * 8 + 4);
          v4u o; o.x = cvtpk(x0[0], x0[1]); o.y = cvtpk(x0[2], x0[3]); o.z = cvtpk(x1[0], x1[1]); o.w = cvtpk(x1[2], x1[3]); *(GAS v4u*)(pb + i * 8) = o; } }
    { const float* x = (const float*)a.in[0]; bf16* hb = (bf16*)(ws + WS_HBF); float* ssq = (float*)(ws + WS_SSQB);
#pragma unroll 1
      for (int m = F.gw; m < S_; m += F.NGW) { const GAS f32x4* xr = (const GAS f32x4*)(x + (size_t)m * D_) + F.lane; float s = 0.f;
#pragma unroll
          for (int j = 0; j < 4; ++j) { const f32x4 v = xr[64 * j]; s += (v[0] * v[0] + v[1] * v[1]) + (v[2] * v[2] + v[3] * v[3]);
              *((GAS f32x4*)(a.out + (size_t)m * D_) + F.lane + 64 * j) = v;
              u32x2v o; o.x = cvtpk(v[0], v[1]); o.y = cvtpk(v[2], v[3]); *((GAS u32x2v*)(hb + (size_t)m * D_) + F.lane + 64 * j) = o; }
          s = wave_sum(s);
          if (F.lane < 16) ssq[(size_t)m * 16 + F.lane] = (F.lane == 0) ? s : 0.f; } }
    { const int* pos = (const int*)a.in[2]; float* tab = (float*)(ws + WS_TAB);
#pragma unroll 1
      for (int idx = F.gw * 64 + F.lane; idx < S_ * 8; idx += F.NGW * 64) { const int row = idx >> 3, i = idx & 7;
          const float inv = exp2f(-(float)i * (18.931568569324174f / 8.0f));
          const float ang = (float)pos[row] * inv;
          double t = (double)ang * 0.15915494309189535; t -= rint(t); const float tf = (float)t;
          tab[(size_t)row * 16 + i] = __builtin_amdgcn_cosf(tf); tab[(size_t)row * 16 + 8 + i] = __builtin_amdgcn_sinf(tf); } }
}

__device__ __forceinline__ void p_mixprep(const Frame& F, const Args& a, int L) {
    unsigned char* ws = a.ws; asm volatile("" : "+s"(ws)); int lane_ = F.lane; asm volatile("" : "+v"(lane_)); const int j = L >> 1, lane = lane_;
    const bf16* AO = (const bf16*)(ws + WS_ARENA + AR_AO); const bf16* PE = (const bf16*)(ws + WS_ARENA + AR_PE); bf16* mix = (bf16*)(ws + WS_MIX);
    const float lam0 = 0.8f - 0.6f * expf(-0.3f * (float)L);
    float s1 = ((const float*)a.in[9])[j * 64 + lane] * ((const float*)a.in[10])[j * 64 + lane], s2 = ((const float*)a.in[11])[j * 64 + lane] * ((const float*)a.in[12])[j * 64 + lane];
    s1 = wave_sum(s1); s2 = wave_sum(s2);
    const float lam = expf(s1) - expf(s2) + lam0, post = 1.0f - lam0;
    const int hh = lane >> 4, dd = (lane & 15) * 8, ch = lane * 8;
    float sg[8], w0[8], w1[8], w2[8];
#pragma unroll
    for (int e = 0; e < 8; ++e) { sg[e] = ((const float*)a.in[13])[j * 128 + dd + e] * post;
        w0[e] = ((const float*)a.in[14])[(j * 3 + 0) * 512 + ch + e]; w1[e] = ((const float*)a.in[14])[(j * 3 + 1) * 512 + ch + e]; w2[e] = ((const float*)a.in[14])[(j * 3 + 2) * 512 + ch + e]; }
#pragma unroll 1
    for (int t = F.gw; t < S_; t += F.NGW) {
        const v4u o1 = *(const GAS v4u*)(AO + (size_t)t * D_ + 256 * hh + dd), o2 = *(const GAS v4u*)(AO + (size_t)t * D_ + 256 * hh + 128 + dd);
        float d[8]; const unsigned a1[4] = {o1.x, o1.y, o1.z, o1.w}, a2[4] = {o2.x, o2.y, o2.z, o2.w}; float ss = 0.f;
#pragma unroll
        for (int q = 0; q < 4; ++q) { d[2 * q] = bflo(a1[q]) - lam * bflo(a2[q]); d[2 * q + 1] = bfhi(a1[q]) - lam * bfhi(a2[q]); ss += d[2 * q] * d[2 * q] + d[2 * q + 1] * d[2 * q + 1]; }
        ss += __shfl_xor(ss, 1); ss += __shfl_xor(ss, 2); ss += __shfl_xor(ss, 4); ss += __shfl_xor(ss, 8);
        const float rms = __builtin_amdgcn_rsqf(ss * (1.0f / 128.0f) + 1e-5f);
        v4u o; o.x = cvtpk(d[0] * rms * sg[0], d[1] * rms * sg[1]); o.y = cvtpk(d[2] * rms * sg[2], d[3] * rms * sg[3]); o.z = cvtpk(d[4] * rms * sg[4], d[5] * rms * sg[5]); o.w = cvtpk(d[6] * rms * sg[6], d[7] * rms * sg[7]);
        *(GAS v4u*)(mix + (size_t)t * D_ + hh * 128 + dd) = o;
        const bf16* r0 = PE + (size_t)t * EIN;
        const v4u bb = *(const GAS v4u*)(r0 + 1536 + ch), c0 = *(const GAS v4u*)(r0 + 2048 + ch), x0 = *(const GAS v4u*)(r0 + 2560 + ch);
        v4u c1 = {0u, 0u, 0u, 0u}, x1 = c1, c2 = c1, x2 = c1;
        if (t >= 1) { c1 = *(const GAS v4u*)(r0 - EIN + 2048 + ch); x1 = *(const GAS v4u*)(r0 - EIN + 2560 + ch); }
        if (t >= 2) { c2 = *(const GAS v4u*)(r0 - 2 * EIN + 2048 + ch); x2 = *(const GAS v4u*)(r0 - 2 * EIN + 2560 + ch); }
        const unsigned B[4] = {bb.x, bb.y, bb.z, bb.w}, C0[4] = {c0.x, c0.y, c0.z, c0.w}, X0[4] = {x0.x, x0.y, x0.z, x0.w}, C1[4] = {c1.x, c1.y, c1.z, c1.w}, X1[4] = {x1.x, x1.y, x1.z, x1.w},
                       C2[4] = {c2.x, c2.y, c2.z, c2.w}, X2[4] = {x2.x, x2.y, x2.z, x2.w};
        float sc[8];
#pragma unroll
        for (int q = 0; q < 4; ++q) {
            sc[2 * q] = bflo(B[q]) * (w2[2 * q] * (bflo(C0[q]) * bflo(X0[q])) + w1[2 * q] * (bflo(C1[q]) * bflo(X1[q])) + w0[2 * q] * (bflo(C2[q]) * bflo(X2[q])));
            sc[2 * q + 1] = bfhi(B[q]) * (w2[2 * q + 1] * (bfhi(C0[q]) * bfhi(X0[q])) + w1[2 * q + 1] * (bfhi(C1[q]) * bfhi(X1[q])) + w0[2 * q + 1] * (bfhi(C2[q]) * bfhi(X2[q]))); }
        v4u so; so.x = cvtpk(sc[0], sc[1]); so.y = cvtpk(sc[2], sc[3]); so.z = cvtpk(sc[4], sc[5]); so.w = cvtpk(sc[6], sc[7]);
        *(GAS v4u*)(mix + (size_t)t * D_ + 512 + ch) = so;
    }
}


__device__ __forceinline__ void p_rot(const Frame& F, const Args& a) {
    unsigned char* ws = a.ws; asm volatile("" : "+s"(ws)); int lane_ = F.lane; asm volatile("" : "+v"(lane_)); const int lane = lane_;
    bf16* PE = (bf16*)(ws + WS_ARENA + AR_PE); const float* tab = (const float*)(ws + WS_TAB);
    const int hd = lane >> 2, i0 = 2 * (lane & 3), col = (hd < 8 ? hd * 64 : 512 + (hd - 8) * 64) + i0;
#pragma unroll 1
    for (int t = F.gw; t < S_; t += F.NGW) {
        GAS unsigned* p1 = (GAS unsigned*)(PE + (size_t)t * EIN + col); GAS unsigned* p2 = (GAS unsigned*)(PE + (size_t)t * EIN + col + 8);
        const unsigned w1 = *p1, w2 = *p2;
        const float c0 = tab[(size_t)t * 16 + i0], c1 = tab[(size_t)t * 16 + i0 + 1], s0 = tab[(size_t)t * 16 + 8 + i0], s1 = tab[(size_t)t * 16 + 8 + i0 + 1];
        const float a0 = bflo(w1), a1 = bfhi(w1), b0 = bflo(w2), b1 = bfhi(w2);
        *p1 = cvtpk(a0 * c0 - b0 * s0, a1 * c1 - b1 * s1); *p2 = cvtpk(b0 * c0 + a0 * s0, b1 * c1 + a1 * s1);
    }
}
__device__ __forceinline__ void p_ab(const Frame& F, const Args& a, int L) {
    unsigned char* ws = a.ws; asm volatile("" : "+s"(ws)); int lane_ = F.lane; asm volatile("" : "+v"(lane_)); const int j = L >> 1, lane = lane_;
    LAS float* wl = (LAS float*)F.lds;
    const float* W = (const float*)a.in[15] + (size_t)j * D_ * OIN_SRC; const float* ln = (const float*)a.in[3] + L * D_;
    for (int idx = F.tid; idx < D_ * 16; idx += NWAVES * 64) { const int k = idx >> 4, c = idx & 15; wl[k * 20 + c] = ln[k] * W[(size_t)k * OIN_SRC + 4096 + c]; }
    __syncthreads();
    const float* ssq = (const float*)(ws + WS_SSQB); float* gg = (float*)(ws + WS_GB); float* gbeta = gg + S_ * 8;
    const float alog = ((const float*)a.in[17])[j * 8 + (lane & 7)], dtb = ((const float*)a.in[18])[j * 8 + (lane & 7)];
#pragma unroll 1
    for (int t = F.gw; t < S_; t += F.NGW) {
        const float rs = pg8::rstd_row(ssq, t); float acc[16];
#pragma unroll
        for (int c = 0; c < 16; ++c) acc[c] = 0.f;
#pragma unroll 4
        for (int i = 0; i < 16; ++i) { const int k = 64 * i + lane; const float x = a.out[(size_t)t * D_ + k];
            const LAS f32x4* wr = (const LAS f32x4*)(wl + k * 20);
#pragma unroll
            for (int q = 0; q < 4; ++q) { const f32x4 w = wr[q]; acc[4 * q] += x * w[0]; acc[4 * q + 1] += x * w[1]; acc[4 * q + 2] += x * w[2]; acc[4 * q + 3] += x * w[3]; } }
        float mine = 0.f;
#pragma unroll
        for (int c = 0; c < 16; ++c) { const float s = wave_sum(acc[c]); mine = ((lane & 15) == c) ? s : mine; }
        mine *= rs;
        if (lane < 8) gbeta[(size_t)t * 8 + lane] = sigm(mine);
        else if (lane < 16) { const float z = mine + dtb; const float sp = z > 20.f ? z : log1pf(expf(z)); gg[(size_t)t * 8 + lane - 8] = -expf(alog) * sp; }
    }
    __syncthreads();
}
__device__ __forceinline__ void tri_solve(const LAS float* Lc, LAS bf16* Xs, int lane) {
    float x0, x1, x2, x3, x4, x5, x6, x7, x8, x9, x10, x11, x12, x13, x14, x15, x16, x17, x18, x19, x20, x21, x22, x23, x24, x25, x26, x27, x28, x29, x30, x31, x32, x33, x34, x35, x36, x37, x38, x39, x40, x41, x42, x43, x44, x45, x46, x47, x48, x49, x50, x51, x52, x53, x54, x55, x56, x57, x58, x59, x60, x61, x62, x63;
    { x63 = (lane == 63) ? 1.0f : 0.0f; asm volatile("" : "+v"(x63) : : "memory"); }
    { float s0 = 0.f, s1 = 0.f, s2 = 0.f, s3 = 0.f; { const f32x4 l = *(const LAS f32x4*)(Lc + 4276); s3 = fmaf(x63, l[3], s3); } x62 = (lane == 62) ? 1.0f : -((s0 + s1) + (s2 + s3)); asm volatile("" : "+v"(x62) : : "memory"); }
    { float s0 = 0.f, s1 = 0.f, s2 = 0.f, s3 = 0.f; { const f32x4 l = *(const LAS f32x4*)(Lc + 4208); s2 = fmaf(x62, l[2], s2); s3 = fmaf(x63, l[3], s3); } x61 = (lane == 61) ? 1.0f : -((s0 + s1) + (s2 + s3)); asm volatile("" : "+v"(x61) : : "memory"); }
    { float s0 = 0.f, s1 = 0.f, s2 = 0.f, s3 = 0.f; { const f32x4 l = *(const LAS f32x4*)(Lc + 4140); s1 = fmaf(x61, l[1], s1); s2 = fmaf(x62, l[2], s2); s3 = fmaf(x63, l[3], s3); } x60 = (lane == 60) ? 1.0f : -((s0 + s1) + (s2 + s3)); asm volatile("" : "+v"(x60) : : "memory"); }
    { float s0 = 0.f, s1 = 0.f, s2 = 0.f, s3 = 0.f; { const f32x4 l = *(const LAS f32x4*)(Lc + 4072); s0 = fmaf(x60, l[0], s0); s1 = fmaf(x61, l[1], s1); s2 = fmaf(x62, l[2], s2); s3 = fmaf(x63, l[3], s3); } x59 = (lane == 59) ? 1.0f : -((s0 + s1) + (s2 + s3)); asm volatile("" : "+v"(x59) : : "memory"); }
    { float s0 = 0.f, s1 = 0.f, s2 = 0.f, s3 = 0.f; { const f32x4 l = *(const LAS f32x4*)(Lc + 4000); s3 = fmaf(x59, l[3], s3); } { const f32x4 l = *(const LAS f32x4*)(Lc + 4004); s0 = fmaf(x60, l[0], s0); s1 = fmaf(x61, l[1], s1); s2 = fmaf(x62, l[2], s2); s3 = fmaf(x63, l[3], s3); } x58 = (lane == 58) ? 1.0f : -((s0 + s1) + (s2 + s3)); asm volatile("" : "+v"(x58) : : "memory"); }
    { float s0 = 0.f, s1 = 0.f, s2 = 0.f, s3 = 0.f; { const f32x4 l = *(const LAS f32x4*)(Lc + 3932); s2 = fmaf(x58, l[2], s2); s3 = fmaf(x59, l[3], s3); } { const f32x4 l = *(const LAS f32x4*)(Lc + 3936); s0 = fmaf(x60, l[0], s0); s1 = fmaf(x61, l[1], s1); s2 = fmaf(x62, l[2], s2); s3 = fmaf(x63, l[3], s3); } x57 = (lane == 57) ? 1.0f : -((s0 + s1) + (s2 + s3)); asm volatile("" : "+v"(x57) : : "memory"); }
    { float s0 = 0.f, s1 = 0.f, s2 = 0.f, s3 = 0.f; { const f32x4 l = *(const LAS f32x4*)(Lc + 3864); s1 = fmaf(x57, l[1], s1); s2 = fmaf(x58, l[2], s2); s3 = fmaf(x59, l[3], s3); } { const f32x4 l = *(const LAS f32x4*)(Lc + 3868); s0 = fmaf(x60, l[0], s0); s1 = fmaf(x61, l[1], s1); s2 = fmaf(x62, l[2], s2); s3 = fmaf(x63, l[3], s3); } x56 = (lane == 56) ? 1.0f : -((s0 + s1) + (s2 + s3)); asm volatile("" : "+v"(x56) : : "memory"); }
    { float s0 = 0.f, s1 = 0.f, s2 = 0.f, s3 = 0.f; { const f32x4 l = *(const LAS f32x4*)(Lc + 3796); s0 = fmaf(x56, l[0], s0); s1 = fmaf(x57, l[1], s1); s2 = fmaf(x58, l[2], s2); s3 = fmaf(x59, l[3], s3); } { const f32x4 l = *(const LAS f32x4*)(Lc + 3800); s0 = fmaf(x60, l[0], s0); s1 = fmaf(x61, l[1], s1); s2 = fmaf(x62, l[2], s2); s3 = fmaf(x63, l[3], s3); } x55 = (lane == 55) ? 1.0f : -((s0 + s1) + (s2 + s3)); asm volatile("" : "+v"(x55) : : "memory"); }
    { float s0 = 0.f, s1 = 0.f, s2 = 0.f, s3 = 0.f; { const f32x4 l = *(const LAS f32x4*)(Lc + 3724); s3 = fmaf(x55, l[3], s3); } { const f32x4 l = *(const LAS f32x4*)(Lc + 3728); s0 = fmaf(x56, l[0], s0); s1 = fmaf(x57, l[1], s1); s2 = fmaf(x58, l[2], s2); s3 = fmaf(x59, l[3], s3); } { const f32x4 l = *(const LAS f32x4*)(Lc + 3732); s0 = fmaf(x60, l[0], s0); s1 = fmaf(x61, l[1], s1); s2 = fmaf(x62, l[2], s2); s3 = fmaf(x63, l[3], s3); } x54 = (lane == 54) ? 1.0f : -((s0 + s1) + (s2 + s3)); asm volatile("" : "+v"(x54) : : "memory"); }
    { float s0 = 0.f, s1 = 0.f, s2 = 0.f, s3 = 0.f; { const f32x4 l = *(const LAS f32x4*)(Lc + 3656); s2 = fmaf(x54, l[2], s2); s3 = fmaf(x55, l[3], s3); } { const f32x4 l = *(const LAS f32x4*)(Lc + 3660); s0 = fmaf(x56, l[0], s0); s1 = fmaf(x57, l[1], s1); s2 = fmaf(x58, l[2], s2); s3 = fmaf(x59, l[3], s3); } { const f32x4 l = *(const LAS f32x4*)(Lc + 3664); s0 = fmaf(x60, l[0], s0); s1 = fmaf(x61, l[1], s1); s2 = fmaf(x62, l[2], s2); s3 = fmaf(x63, l[3], s3); } x53 = (lane == 53) ? 1.0f : -((s0 + s1) + (s2 + s3)); asm volatile("" : "+v"(x53) : : "memory"); }
    { float s0 = 0.f, s1 = 0.f, s2 = 0.f, s3 = 0.f; { const f32x4 l = *(const LAS f32x4*)(Lc + 3588); s1 = fmaf(x53, l[1], s1); s2 = fmaf(x54, l[2], s2); s3 = fmaf(x55, l[3], s3); } { const f32x4 l = *(const LAS f32x4*)(Lc + 3592); s0 = fmaf(x56, l[0], s0); s1 = fmaf(x57, l[1], s1); s2 = fmaf(x58, l[2], s2); s3 = fmaf(x59, l[3], s3); } { const f32x4 l = *(const LAS f32x4*)(Lc + 3596); s0 = fmaf(x60, l[0], s0); s1 = fmaf(x61, l[1], s1); s2 = fmaf(x62, l[2], s2); s3 = fmaf(x63, l[3], s3); } x52 = (lane == 52) ? 1.0f : -((s0 + s1) + (s2 + s3)); asm volatile("" : "+v"(x52) : : "memory"); }
    { float s0 = 0.f, s1 = 0.f, s2 = 0.f, s3 = 0.f; { const f32x4 l = *(const LAS f32x4*)(Lc + 3520); s0 = fmaf(x52, l[0], s0); s1 = fmaf(x53, l[1], s1); s2 = fmaf(x54, l[2], s2); s3 = fmaf(x55, l[3], s3); } { const f32x4 l = *(const LAS f32x4*)(Lc + 3524); s0 = fmaf(x56, l[0], s0); s1 = fmaf(x57, l[1], s1); s2 = fmaf(x58, l[2], s2); s3 = fmaf(x59, l[3], s3); } { const f32x4 l = *(const LAS f32x4*)(Lc + 3528); s0 = fmaf(x60, l[0], s0); s1 = fmaf(x61, l[1], s1); s2 = fmaf(x62, l[2], s2); s3 = fmaf(x63, l[3], s3); } x51 = (lane == 51) ? 1.0f : -((s0 + s1) + (s2 + s3)); asm volatile("" : "+v"(x51) : : "memory"); }
    { float s0 = 0.f, s1 = 0.f, s2 = 0.f, s3 = 0.f; { const f32x4 l = *(const LAS f32x4*)(Lc + 3448); s3 = fmaf(x51, l[3], s3); } { const f32x4 l = *(const LAS f32x4*)(Lc + 3452); s0 = fmaf(x52, l[0], s0); s1 = fmaf(x53, l[1], s1); s2 = fmaf(x54, l[2], s2); s3 = fmaf(x55, l[3], s3); } { const f32x4 l = *(const LAS f32x4*)(Lc + 3456); s0 = fmaf(x56, l[0], s0); s1 = fmaf(x57, l[1], s1); s2 = fmaf(x58, l[2], s2); s3 = fmaf(x59, l[3], s3); } { const f32x4 l = *(const LAS f32x4*)(Lc + 3460); s0 = fmaf(x60, l[0], s0); s1 = fmaf(x61, l[1], s1); s2 = fmaf(x62, l[2], s2); s3 = fmaf(x63, l[3], s3); } x50 = (lane == 50) ? 1.0f : -((s0 + s1) + (s2 + s3)); asm volatile("" : "+v"(x50) : : "memory"); }
    { float s0 = 0.f, s1 = 0.f, s2 = 0.f, s3 = 0.f; { const f32x4 l = *(const LAS f32x4*)(Lc + 3380); s2 = fmaf(x50, l[2], s2); s3 = fmaf(x51, l[3], s3); } { const f32x4 l = *(const LAS f32x4*)(Lc + 3384); s0 = fmaf(x52, l[0], s0); s1 = fmaf(x53, l[1], s1); s2 = fmaf(x54, l[2], s2); s3 = fmaf(x55, l[3], s3); } { const f32x4 l = *(const LAS f32x4*)(Lc + 3388); s0 = fmaf(x56, l[0], s0); s1 = fmaf(x57, l[1], s1); s2 = fmaf(x58, l[2], s2); s3 = fmaf(x59, l[3], s3); } { const f32x4 l = *(const LAS f32x4*)(Lc + 3392); s0 = fmaf(x60, l[0], s0); s1 = fmaf(x61, l[1], s1); s2 = fmaf(x62, l[2], s2); s3 = fmaf(x63, l[3], s3); } x49 = (lane == 49) ? 1.0f : -((s0 + s1) + (s2 + s3)); asm volatile("" : "+v"(x49) : : "memory"); }
    { float s0 = 0.f, s1 = 0.f, s2 = 0.f, s3 = 0.f; { const f32x4 l = *(const LAS f32x4*)(Lc + 3312); s1 = fmaf(x49, l[1], s1); s2 = fmaf(x50, l[2], s2); s3 = fmaf(x51, l[3], s3); } { const f32x4 l = *(const LAS f32x4*)(Lc + 3316); s0 = fmaf(x52, l[0], s0); s1 = fmaf(x53, l[1], s1); s2 = fmaf(x54, l[2], s2); s3 = fmaf(x55, l[3], s3); } { const f32x4 l = *(const LAS f32x4*)(Lc + 3320); s0 = fmaf(x56, l[0], s0); s1 = fmaf(x57, l[1], s1); s2 = fmaf(x58, l[2], s2); s3 = fmaf(x59, l[3], s3); } { const f32x4 l = *(const LAS f32x4*)(Lc + 3324); s0 = fmaf(x60, l[0], s0); s1 = fmaf(x61, l[1], s1); s2 = fmaf(x62, l[2], s2); s3 = fmaf(x63, l[3], s3); } x48 = (lane == 48) ? 1.0f : -((s0 + s1) + (s2 + s3)); asm volatile("" : "+v"(x48) : : "memory"); }
    { float s0 = 0.f, s1 = 0.f, s2 = 0.f, s3 = 0.f; { const f32x4 l = *(const LAS f32x4*)(Lc + 3244); s0 = fmaf(x48, l[0], s0); s1 = fmaf(x49, l[1], s1); s2 = fmaf(x50, l[2], s2); s3 = fmaf(x51, l[3], s3); } { const f32x4 l = *(const LAS f32x4*)(Lc + 3248); s0 = fmaf(x52, l[0], s0); s1 = fmaf(x53, l[1], s1); s2 = fmaf(x54, l[2], s2); s3 = fmaf(x55, l[3], s3); } { const f32x4 l = *(const LAS f32x4*)(Lc + 3252); s0 = fmaf(x56, l[0], s0); s1 = fmaf(x57, l[1], s1); s2 = fmaf(x58, l[2], s2); s3 = fmaf(x59, l[3], s3); } { const f32x4 l = *(const LAS f32x4*)(Lc + 3256); s0 = fmaf(x60, l[0], s0); s1 = fmaf(x61, l[1], s1); s2 = fmaf(x62, l[2], s2); s3 = fmaf(x63, l[3], s3); } x47 = (lane == 47) ? 1.0f : -((s0 + s1) + (s2 + s3)); asm volatile("" : "+v"(x47) : : "memory"); }
    { float s0 = 0.f, s1 = 0.f, s2 = 0.f, s3 = 0.f; { const f32x4 l = *(const LAS f32x4*)(Lc + 3172); s3 = fmaf(x47, l[3], s3); } { const f32x4 l = *(const LAS f32x4*)(Lc + 3176); s0 = fmaf(x48, l[0], s0); s1 = fmaf(x49, l[1], s1); s2 = fmaf(x50, l[2], s2); s3 = fmaf(x51, l[3], s3); } { const f32x4 l = *(const LAS f32x4*)(Lc + 3180); s0 = fmaf(x52, l[0], s0); s1 = fmaf(x53, l[1], s1); s2 = fmaf(x54, l[2], s2); s3 = fmaf(x55, l[3], s3); } { const f32x4 l = *(const LAS f32x4*)(Lc + 3184); s0 = fmaf(x56, l[0], s0); s1 = fmaf(x57, l[1], s1); s2 = fmaf(x58, l[2], s2); s3 = fmaf(x59, l[3], s3); } { const f32x4 l = *(const LAS f32x4*)(Lc + 3188); s0 = fmaf(x60, l[0], s0); s1 = fmaf(x61, l[1], s1); s2 = fmaf(x62, l[2], s2); s3 = fmaf(x63, l[3], s3); } x46 = (lane == 46) ? 1.0f : -((s0 + s1) + (s2 + s3)); asm volatile("" : "+v"(x46) : : "memory"); }
    { float s0 = 0.f, s1 = 0.f, s2 = 0.f, s3 = 0.f; { const f32x4 l = *(const LAS f32x4*)(Lc + 3104); s2 = fmaf(x46, l[2], s2); s3 = fmaf(x47, l[3], s3); } { const f32x4 l = *(const LAS f32x4*)(Lc + 3108); s0 = fmaf(x48, l[0], s0); s1 = fmaf(x49, l[1], s1); s2 = fmaf(x50, l[2], s2); s3 = fmaf(x51, l[3], s3); } { const f32x4 l = *(const LAS f32x4*)(Lc + 3112); s0 = fmaf(x52, l[0], s0); s1 = fmaf(x53, l[1], s1); s2 = fmaf(x54, l[2], s2); s3 = fmaf(x55, l[3], s3); } { const f32x4 l = *(const LAS f32x4*)(Lc + 3116); s0 = fmaf(x56, l[0], s0); s1 = fmaf(x57, l[1], s1); s2 = fmaf(x58, l[2], s2); s3 = fmaf(x59, l[3], s3); } { const f32x4 l = *(const LAS f32x4*)(Lc + 3120); s0 = fmaf(x60, l[0], s0); s1 = fmaf(x61, l[1], s1); s2 = fmaf(x62, l[2], s2); s3 = fmaf(x63, l[3], s3); } x45 = (lane == 45) ? 1.0f : -((s0 + s1) + (s2 + s3)); asm volatile("" : "+v"(x45) : : "memory"); }
    { float s0 = 0.f, s1 = 0.f, s2 = 0.f, s3 = 0.f; { const f32x4 l = *(const LAS f32x4*)(Lc + 3036); s1 = fmaf(x45, l[1], s1); s2 = fmaf(x46, l[2], s2); s3 = fmaf(x47, l[3], s3); } { const f32x4 l = *(const LAS f32x4*)(Lc + 3040); s0 = fmaf(x48, l[0], s0); s1 = fmaf(x49, l[1], s1); s2 = fmaf(x50, l[2], s2); s3 = fmaf(x51, l[3], s3); } { const f32x4 l = *(const LAS f32x4*)(Lc + 3044); s0 = fmaf(x52, l[0], s0); s1 = fmaf(x53, l[1], s1); s2 = fmaf(x54, l[2], s2); s3 = fmaf(x55, l[3], s3); } { const f32x4 l = *(const LAS f32x4*)(Lc + 3048); s0 = fmaf(x56, l[0], s0); s1 = fmaf(x57, l[1], s1); s2 = fmaf(x58, l[2], s2); s3 = fmaf(x59, l[3], s3); } { const f32x4 l = *(const LAS f32x4*)(Lc + 3052); s0 = fmaf(x60, l[0], s0); s1 = fmaf(x61, l[1], s1); s2 = fmaf(x62, l[2], s2); s3 = fmaf(x63, l[3], s3); } x44 = (lane == 44) ? 1.0f : -((s0 + s1) + (s2 + s3)); asm volatile("" : "+v"(x44) : : "memory"); }
    { float s0 = 0.f, s1 = 0.f, s2 = 0.f, s3 = 0.f; { const f32x4 l = *(const LAS f32x4*)(Lc + 2968); s0 = fmaf(x44, l[0], s0); s1 = fmaf(x45, l[1], s1); s2 = fmaf(x46, l[2], s2); s3 = fmaf(x47, l[3], s3); } { const f32x4 l = *(const LAS f32x4*)(Lc + 2972); s0 = fmaf(x48, l[0], s0); s1 = fmaf(x49, l[1], s1); s2 = fmaf(x50, l[2], s2); s3 = fmaf(x51, l[3], s3); } { const f32x4 l = *(const LAS f32x4*)(Lc + 2976); s0 = fmaf(x52, l[0], s0); s1 = fmaf(x53, l[1], s1); s2 = fmaf(x54, l[2], s2); s3 = fmaf(x55, l[3], s3); } { const f32x4 l = *(const LAS f32x4*)(Lc + 2980); s0 = fmaf(x56, l[0], s0); s1 = fmaf(x57, l[1], s1); s2 = fmaf(x58, l[2], s2); s3 = fmaf(x59, l[3], s3); } { const f32x4 l = *(const LAS f32x4*)(Lc + 2984); s0 = fmaf(x60, l[0], s0); s1 = fmaf(x61, l[1], s1); s2 = fmaf(x62, l[2], s2); s3 = fmaf(x63, l[3], s3); } x43 = (lane == 43) ? 1.0f : -((s0 + s1) + (s2 + s3)); asm volatile("" : "+v"(x43) : : "memory"); }
    { float s0 = 0.f, s1 = 0.f, s2 = 0.f, s3 = 0.f; { const f32x4 l = *(const LAS f32x4*)(Lc + 2896); s3 = fmaf(x43, l[3], s3); } { const f32x4 l = *(const LAS f32x4*)(Lc + 2900); s0 = fmaf(x44, l[0], s0); s1 = fmaf(x45, l[1], s1); s2 = fmaf(x46, l[2], s2); s3 = fmaf(x47, l[3], s3); } { const f32x4 l = *(const LAS f32x4*)(Lc + 2904); s0 = fmaf(x48, l[0], s0); s1 = fmaf(x49, l[1], s1); s2 = fmaf(x50, l[2], s2); s3 = fmaf(x51, l[3], s3); } { const f32x4 l = *(const LAS f32x4*)(Lc + 2908); s0 = fmaf(x52, l[0], s0); s1 = fmaf(x53, l[1], s1); s2 = fmaf(x54, l[2], s2); s3 = fmaf(x55, l[3], s3); } { const f32x4 l = *(const LAS f32x4*)(Lc + 2912); s0 = fmaf(x56, l[0], s0); s1 = fmaf(x57, l[1], s1); s2 = fmaf(x58, l[2], s2); s3 = fmaf(x59, l[3], s3); } { const f32x4 l = *(const LAS f32x4*)(Lc + 2916); s0 = fmaf(x60, l[0], s0); s1 = fmaf(x61, l[1], s1); s2 = fmaf(x62, l[2], s2); s3 = fmaf(x63, l[3], s3); } x42 = (lane == 42) ? 1.0f : -((s0 + s1) + (s2 + s3)); asm volatile("" : "+v"(x42) : : "memory"); }
    { float s0 = 0.f, s1 = 0.f, s2 = 0.f, s3 = 0.f; { const f32x4 l = *(const LAS f32x4*)(Lc + 2828); s2 = fmaf(x42, l[2], s2); s3 = fmaf(x43, l[3], s3); } { const f32x4 l = *(const LAS f32x4*)(Lc + 2832); s0 = fmaf(x44, l[0], s0); s1 = fmaf(x45, l[1], s1); s2 = fmaf(x46, l[2], s2); s3 = fmaf(x47, l[3], s3); } { const f32x4 l = *(const LAS f32x4*)(Lc + 2836); s0 = fmaf(x48, l[0], s0); s1 = fmaf(x49, l[1], s1); s2 = fmaf(x50, l[2], s2); s3 = fmaf(x51, l[3], s3); } { const f32x4 l = *(const LAS f32x4*)(Lc + 2840); s0 = fmaf(x52, l[0], s0); s1 = fmaf(x53, l[1], s1); s2 = fmaf(x54, l[2], s2); s3 = fmaf(x55, l[3], s3); } { const f32x4 l = *(const LAS f32x4*)(Lc + 2844); s0 = fmaf(x56, l[0], s0); s1 = fmaf(x57, l[1], s1); s2 = fmaf(x58, l[2], s2); s3 = fmaf(x59, l[3], s3); } { const f32x4 l = *(const LAS f32x4*)(Lc + 2848); s0 = fmaf(x60, l[0], s0); s1 = fmaf(x61, l[1], s1); s2 = fmaf(x62, l[2], s2); s3 = fmaf(x63, l[3], s3); } x41 = (lane == 41) ? 1.0f : -((s0 + s1) + (s2 + s3)); asm volatile("" : "+v"(x41) : : "memory"); }
    { float s0 = 0.f, s1 = 0.f, s2 = 0.f, s3 = 0.f; { const f32x4 l = *(const LAS f32x4*)(Lc + 2760); s1 = fmaf(x41, l[1], s1); s2 = fmaf(x42, l[2], s2); s3 = fmaf(x43, l[3], s3); } { const f32x4 l = *(const LAS f32x4*)(Lc + 2764); s0 = fmaf(x44, l[0], s0); s1 = fmaf(x45, l[1], s1); s2 = fmaf(x46, l[2], s2); s3 = fmaf(x47, l[3], s3); } { const f32x4 l = *(const LAS f32x4*)(Lc + 2768); s0 = fmaf(x48, l[0], s0); s1 = fmaf(x49, l[1], s1); s2 = fmaf(x50, l[2], s2); s3 = fmaf(x51, l[3], s3); } { const f32x4 l = *(const LAS f32x4*)(Lc + 2772); s0 = fmaf(x52, l[0], s0); s1 = fmaf(x53, l[1], s1); s2 = fmaf(x54, l[2], s2); s3 = fmaf(x55, l[3], s3); } { const f32x4 l = *(const LAS f32x4*)(Lc + 2776); s0 = fmaf(x56, l[0], s0); s1 = fmaf(x57, l[1], s1); s2 = fmaf(x58, l[2], s2); s3 = fmaf(x59, l[3], s3); } { const f32x4 l = *(const LAS f32x4*)(Lc + 2780); s0 = fmaf(x60, l[0], s0); s1 = fmaf(x61, l[1], s1); s2 = fmaf(x62, l[2], s2); s3 = fmaf(x63, l[3], s3); } x40 = (lane == 40) ? 1.0f : -((s0 + s1) + (s2 + s3)); asm volatile("" : "+v"(x40) : : "memory"); }
    { float s0 = 0.f, s1 = 0.f, s2 = 0.f, s3 = 0.f; { const f32x4 l = *(const LAS f32x4*)(Lc + 2692); s0 = fmaf(x40, l[0], s0); s1 = fmaf(x41, l[1], s1); s2 = fmaf(x42, l[2], s2); s3 = fmaf(x43, l[3], s3); } { const f32x4 l = *(const LAS f32x4*)(Lc + 2696); s0 = fmaf(x44, l[0], s0); s1 = fmaf(x45, l[1], s1); s2 = fmaf(x46, l[2], s2); s3 = fmaf(x47, l[3], s3); } { const f32x4 l = *(const LAS f32x4*)(Lc + 2700); s0 = fmaf(x48, l[0], s0); s1 = fmaf(x49, l[1], s1); s2 = fmaf(x50, l[2], s2); s3 = fmaf(x51, l[3], s3); } { const f32x4 l = *(const LAS f32x4*)(Lc + 2704); s0 = fmaf(x52, l[0], s0); s1 = fmaf(x53, l[1], s1); s2 = fmaf(x54, l[2], s2); s3 = fmaf(x55, l[3], s3); } { const f32x4 l = *(const LAS f32x4*)(Lc + 2708); s0 = fmaf(x56, l[0], s0); s1 = fmaf(x57, l[1], s1); s2 = fmaf(x58, l[2], s2); s3 = fmaf(x59, l[3], s3); } { const f32x4 l = *(const LAS f32x4*)(Lc + 2712); s0 = fmaf(x60, l[0], s0); s1 = fmaf(x61, l[1], s1); s2 = fmaf(x62, l[2], s2); s3 = fmaf(x63, l[3], s3); } x39 = (lane == 39) ? 1.0f : -((s0 + s1) + (s2 + s3)); asm volatile("" : "+v"(x39) : : "memory"); }
    { float s0 = 0.f, s1 = 0.f, s2 = 0.f, s3 = 0.f; { const f32x4 l = *(const LAS f32x4*)(Lc + 2620); s3 = fmaf(x39, l[3], s3); } { const f32x4 l = *(const LAS f32x4*)(Lc + 2624); s0 = fmaf(x40, l[0], s0); s1 = fmaf(x41, l[1], s1); s2 = fmaf(x42, l[2], s2); s3 = fmaf(x43, l[3], s3); } { const f32x4 l = *(const LAS f32x4*)(Lc + 2628); s0 = fmaf(x44, l[0], s0); s1 = fmaf(x45, l[1], s1); s2 = fmaf(x46, l[2], s2); s3 = fmaf(x47, l[3], s3); } { const f32x4 l = *(const LAS f32x4*)(Lc + 2632); s0 = fmaf(x48, l[0], s0); s1 = fmaf(x49, l[1], s1); s2 = fmaf(x50, l[2], s2); s3 = fmaf(x51, l[3], s3); } { const f32x4 l = *(const LAS f32x4*)(Lc + 2636); s0 = fmaf(x52, l[0], s0); s1 = fmaf(x53, l[1], s1); s2 = fmaf(x54, l[2], s2); s3 = fmaf(x55, l[3], s3); } { const f32x4 l = *(const LAS f32x4*)(Lc + 2640); s0 = fmaf(x56, l[0], s0); s1 = fmaf(x57, l[1], s1); s2 = fmaf(x58, l[2], s2); s3 = fmaf(x59, l[3], s3); } { const f32x4 l = *(const LAS f32x4*)(Lc + 2644); s0 = fmaf(x60, l[0], s0); s1 = fmaf(x61, l[1], s1); s2 = fmaf(x62, l[2], s2); s3 = fmaf(x63, l[3], s3); } x38 = (lane == 38) ? 1.0f : -((s0 + s1) + (s2 + s3)); asm volatile("" : "+v"(x38) : : "memory"); }
    { float s0 = 0.f, s1 = 0.f, s2 = 0.f, s3 = 0.f; { const f32x4 l = *(const LAS f32x4*)(Lc + 2552); s2 = fmaf(x38, l[2], s2); s3 = fmaf(x39, l[3], s3); } { const f32x4 l = *(const LAS f32x4*)(Lc + 2556); s0 = fmaf(x40, l[0], s0); s1 = fmaf(x41, l[1], s1); s2 = fmaf(x42, l[2], s2); s3 = fmaf(x43, l[3], s3); } { const f32x4 l = *(const LAS f32x4*)(Lc + 2560); s0 = fmaf(x44, l[0], s0); s1 = fmaf(x45, l[1], s1); s2 = fmaf(x46, l[2], s2); s3 = fmaf(x47, l[3], s3); } { const f32x4 l = *(const LAS f32x4*)(Lc + 2564); s0 = fmaf(x48, l[0], s0); s1 = fmaf(x49, l[1], s1); s2 = fmaf(x50, l[2], s2); s3 = fmaf(x51, l[3], s3); } { const f32x4 l = *(const LAS f32x4*)(Lc + 2568); s0 = fmaf(x52, l[0], s0); s1 = fmaf(x53, l[1], s1); s2 = fmaf(x54, l[2], s2); s3 = fmaf(x55, l[3], s3); } { const f32x4 l = *(const LAS f32x4*)(Lc + 2572); s0 = fmaf(x56, l[0], s0); s1 = fmaf(x57, l[1], s1); s2 = fmaf(x58, l[2], s2); s3 = fmaf(x59, l[3], s3); } { const f32x4 l = *(const LAS f32x4*)(Lc + 2576); s0 = fmaf(x60, l[0], s0); s1 = fmaf(x61, l[1], s1); s2 = fmaf(x62, l[2], s2); s3 = fmaf(x63, l[3], s3); } x37 = (lane == 37) ? 1.0f : -((s0 + s1) + (s2 + s3)); asm volatile("" : "+v"(x37) : : "memory"); }
    { float s0 = 0.f, s1 = 0.f, s2 = 0.f, s3 = 0.f; { const f32x4 l = *(const LAS f32x4*)(Lc + 2484); s1 = fmaf(x37, l[1], s1); s2 = fmaf(x38, l[2], s2); s3 = fmaf(x39, l[3], s3); } { const f32x4 l = *(const LAS f32x4*)(Lc + 2488); s0 = fmaf(x40, l[0], s0); s1 = fmaf(x41, l[1], s1); s2 = fmaf(x42, l[2], s2); s3 = fmaf(x43, l[3], s3); } { const f32x4 l = *(const LAS f32x4*)(Lc + 2492); s0 = fmaf(x44, l[0], s0); s1 = fmaf(x45, l[1], s1); s2 = fmaf(x46, l[2], s2); s3 = fmaf(x47, l[3], s3); } { const f32x4 l = *(const LAS f32x4*)(Lc + 2496); s0 = fmaf(x48, l[0], s0); s1 = fmaf(x49, l[1], s1); s2 = fmaf(x50, l[2], s2); s3 = fmaf(x51, l[3], s3); } { const f32x4 l = *(const LAS f32x4*)(Lc + 2500); s0 = fmaf(x52, l[0], s0); s1 = fmaf(x53, l[1], s1); s2 = fmaf(x54, l[2], s2); s3 = fmaf(x55, l[3], s3); } { const f32x4 l = *(const LAS f32x4*)(Lc + 2504); s0 = fmaf(x56, l[0], s0); s1 = fmaf(x57, l[1], s1); s2 = fmaf(x58, l[2], s2); s3 = fmaf(x59, l[3], s3); } { const f32x4 l = *(const LAS f32x4*)(Lc + 2508); s0 = fmaf(x60, l[0], s0); s1 = fmaf(x61, l[1], s1); s2 = fmaf(x62, l[2], s2); s3 = fmaf(x63, l[3], s3); } x36 = (lane == 36) ? 1.0f : -((s0 + s1) + (s2 + s3)); asm volatile("" : "+v"(x36) : : "memory"); }
    { float s0 = 0.f, s1 = 0.f, s2 = 0.f, s3 = 0.f; { const f32x4 l = *(const LAS f32x4*)(Lc + 2416); s0 = fmaf(x36, l[0], s0); s1 = fmaf(x37, l[1], s1); s2 = fmaf(x38, l[2], s2); s3 = fmaf(x39, l[3], s3); } { const f32x4 l = *(const LAS f32x4*)(Lc + 2420); s0 = fmaf(x40, l[0], s0); s1 = fmaf(x41, l[1], s1); s2 = fmaf(x42, l[2], s2); s3 = fmaf(x43, l[3], s3); } { const f32x4 l = *(const LAS f32x4*)(Lc + 2424); s0 = fmaf(x44, l[0], s0); s1 = fmaf(x45, l[1], s1); s2 = fmaf(x46, l[2], s2); s3 = fmaf(x47, l[3], s3); } { const f32x4 l = *(const LAS f32x4*)(Lc + 2428); s0 = fmaf(x48, l[0], s0); s1 = fmaf(x49, l[1], s1); s2 = fmaf(x50, l[2], s2); s3 = fmaf(x51, l[3], s3); } { const f32x4 l = *(const LAS f32x4*)(Lc + 2432); s0 = fmaf(x52, l[0], s0); s1 = fmaf(x53, l[1], s1); s2 = fmaf(x54, l[2], s2); s3 = fmaf(x55, l[3], s3); } { const f32x4 l = *(const LAS f32x4*)(Lc + 2436); s0 = fmaf(x56, l[0], s0); s1 = fmaf(x57, l[1], s1); s2 = fmaf(x58, l[2], s2); s3 = fmaf(x59, l[3], s3); } { const f32x4 l = *(const LAS f32x4*)(Lc + 2440); s0 = fmaf(x60, l[0], s0); s1 = fmaf(x61, l[1], s1); s2 = fmaf(x62, l[2], s2); s3 = fmaf(x63, l[3], s3); } x35 = (lane == 35) ? 1.0f : -((s0 + s1) + (s2 + s3)); asm volatile("" : "+v"(x35) : : "memory"); }
    { float s0 = 0.f, s1 = 0.f, s2 = 0.f, s3 = 0.f; { const f32x4 l = *(const LAS f32x4*)(Lc + 2344); s3 = fmaf(x35, l[3], s3); } { const f32x4 l = *(const LAS f32x4*)(Lc + 2348); s0 = fmaf(x36, l[0], s0); s1 = fmaf(x37, l[1], s1); s2 = fmaf(x38, l[2], s2); s3 = fmaf(x39, l[3], s3); } { const f32x4 l = *(const LAS f32x4*)(Lc + 2352); s0 = fmaf(x40, l[0], s0); s1 = fmaf(x41, l[1], s1); s2 = fmaf(x42, l[2], s2); s3 = fmaf(x43, l[3], s3); } { const f32x4 l = *(const LAS f32x4*)(Lc + 2356); s0 = fmaf(x44, l[0], s0); s1 = fmaf(x45, l[1], s1); s2 = fmaf(x46, l[2], s2); s3 = fmaf(x47, l[3], s3); } { const f32x4 l = *(const LAS f32x4*)(Lc + 2360); s0 = fmaf(x48, l[0], s0); s1 = fmaf(x49, l[1], s1); s2 = fmaf(x50, l[2], s2); s3 = fmaf(x51, l[3], s3); } { const f32x4 l = *(const LAS f32x4*)(Lc + 2364); s0 = fmaf(x52, l[0], s0); s1 = fmaf(x53, l[1], s1); s2 = fmaf(x54, l[2], s2); s3 = fmaf(x55, l[3], s3); } { const f32x4 l = *(const LAS f32x4*)(Lc + 2368); s0 = fmaf(x56, l[0], s0); s1 = fmaf(x57, l[1], s1); s2 = fmaf(x58, l[2], s2); s3 = fmaf(x59, l[3], s3); } { const f32x4 l = *(const LAS f32x4*)(Lc + 2372); s0 = fmaf(x60, l[0], s0); s1 = fmaf(x61, l[1], s1); s2 = fmaf(x62, l[2], s2); s3 = fmaf(x63, l[3], s3); } x34 = (lane == 34) ? 1.0f : -((s0 + s1) + (s2 + s3)); asm volatile("" : "+v"(x34) : : "memory"); }
    { float s0 = 0.f, s1 = 0.f, s2 = 0.f, s3 = 0.f; { const f32x4 l = *(const LAS f32x4*)(Lc + 2276); s2 = fmaf(x34, l[2], s2); s3 = fmaf(x35, l[3], s3); } { const f32x4 l = *(const LAS f32x4*)(Lc + 2280); s0 = fmaf(x36, l[0], s0); s1 = fmaf(x37, l[1], s1); s2 = fmaf(x38, l[2], s2); s3 = fmaf(x39, l[3], s3); } { const f32x4 l = *(const LAS f32x4*)(Lc + 2284); s0 = fmaf(x40, l[0], s0); s1 = fmaf(x41, l[1], s1); s2 = fmaf(x42, l[2], s2); s3 = fmaf(x43, l[3], s3); } { const f32x4 l = *(const LAS f32x4*)(Lc + 2288); s0 = fmaf(x44, l[0], s0); s1 = fmaf(x45, l[1], s1); s2 = fmaf(x46, l[2], s2); s3 = fmaf(x47, l[3], s3); } { const f32x4 l = *(const LAS f32x4*)(Lc + 2292); s0 = fmaf(x48, l[0], s0); s1 = fmaf(x49, l[1], s1); s2 = fmaf(x50, l[2], s2); s3 = fmaf(x51, l[3], s3); } { const f32x4 l = *(const LAS f32x4*)(Lc + 2296); s0 = fmaf(x52, l[0], s0); s1 = fmaf(x53, l[1], s1); s2 = fmaf(x54, l[2], s2); s3 = fmaf(x55, l[3], s3); } { const f32x4 l = *(const LAS f32x4*)(Lc + 2300); s0 = fmaf(x56, l[0], s0); s1 = fmaf(x57, l[1], s1); s2 = fmaf(x58, l[2], s2); s3 = fmaf(x59, l[3], s3); } { const f32x4 l = *(const LAS f32x4*)(Lc + 2304); s0 = fmaf(x60, l[0], s0); s1 = fmaf(x61, l[1], s1); s2 = fmaf(x62, l[2], s2); s3 = fmaf(x63, l[3], s3); } x33 = (lane == 33) ? 1.0f : -((s0 + s1) + (s2 + s3)); asm volatile("" : "+v"(x33) : : "memory"); }
    { float s0 = 0.f, s1 = 0.f, s2 = 0.f, s3 = 0.f; { const f32x4 l = *(const LAS f32x4*)(Lc + 2208); s1 = fmaf(x33, l[1], s1); s2 = fmaf(x34, l[2], s2); s3 = fmaf(x35, l[3], s3); } { const f32x4 l = *(const LAS f32x4*)(Lc + 2212); s0 = fmaf(x36, l[0], s0); s1 = fmaf(x37, l[1], s1); s2 = fmaf(x38, l[2], s2); s3 = fmaf(x39, l[3], s3); } { const f32x4 l = *(const LAS f32x4*)(Lc + 2216); s0 = fmaf(x40, l[0], s0); s1 = fmaf(x41, l[1], s1); s2 = fmaf(x42, l[2], s2); s3 = fmaf(x43, l[3], s3); } { const f32x4 l = *(const LAS f32x4*)(Lc + 2220); s0 = fmaf(x44, l[0], s0); s1 = fmaf(x45, l[1], s1); s2 = fmaf(x46, l[2], s2); s3 = fmaf(x47, l[3], s3); } { const f32x4 l = *(const LAS f32x4*)(Lc + 2224); s0 = fmaf(x48, l[0], s0); s1 = fmaf(x49, l[1], s1); s2 = fmaf(x50, l[2], s2); s3 = fmaf(x51, l[3], s3); } { const f32x4 l = *(const LAS f32x4*)(Lc + 2228); s0 = fmaf(x52, l[0], s0); s1 = fmaf(x53, l[1], s1); s2 = fmaf(x54, l[2], s2); s3 = fmaf(x55, l[3], s3); } { const f32x4 l = *(const LAS f32x4*)(Lc + 2232); s0 = fmaf(x56, l[0], s0); s1 = fmaf(x57, l[1], s1); s2 = fmaf(x58, l[2], s2); s3 = fmaf(x59, l[3], s3); } { const f32x4 l = *(const LAS f32x4*)(Lc + 2236); s0 = fmaf(x60, l[0], s0); s1 = fmaf(x61, l[1], s1); s2 = fmaf(x62, l[2], s2); s3 = fmaf(x63, l[3], s3); } x32 = (lane == 32) ? 1.0f : -((s0 + s1) + (s2 + s3)); asm volatile("" : "+v"(x32) : : "memory"); }
    { float s0 = 0.f, s1 = 0.f, s2 = 0.f, s3 = 0.f; { const f32x4 l = *(const LAS f32x4*)(Lc + 2140); s0 = fmaf(x32, l[0], s0); s1 = fmaf(x33, l[1], s1); s2 = fmaf(x34, l[2], s2); s3 = fmaf(x35, l[3], s3); } { const f32x4 l = *(const LAS f32x4*)(Lc + 2144); s0 = fmaf(x36, l[0], s0); s1 = fmaf(x37, l[1], s1); s2 = fmaf(x38, l[2], s2); s3 = fmaf(x39, l[3], s3); } { const f32x4 l = *(const LAS f32x4*)(Lc + 2148); s0 = fmaf(x40, l[0], s0); s1 = fmaf(x41, l[1], s1); s2 = fmaf(x42, l[2], s2); s3 = fmaf(x43, l[3], s3); } { const f32x4 l = *(const LAS f32x4*)(Lc + 2152); s0 = fmaf(x44, l[0], s0); s1 = fmaf(x45, l[1], s1); s2 = fmaf(x46, l[2], s2); s3 = fmaf(x47, l[3], s3); } { const f32x4 l = *(const LAS f32x4*)(Lc + 2156); s0 = fmaf(x48, l[0], s0); s1 = fmaf(x49, l[1], s1); s2 = fmaf(x50, l[2], s2); s3 = fmaf(x51, l[3], s3); } { const f32x4 l = *(const LAS f32x4*)(Lc + 2160); s0 = fmaf(x52, l[0], s0); s1 = fmaf(x53, l[1], s1); s2 = fmaf(x54, l[2], s2); s3 = fmaf(x55, l[3], s3); } { const f32x4 l = *(const LAS f32x4*)(Lc + 2164); s0 = fmaf(x56, l[0], s0); s1 = fmaf(x57, l[1], s1); s2 = fmaf(x58, l[2], s2); s3 = fmaf(x59, l[3], s3); } { const f32x4 l = *(const LAS f32x4*)(Lc + 2168); s0 = fmaf(x60, l[0], s0); s1 = fmaf(x61, l[1], s1); s2 = fmaf(x62, l[2], s2); s3 = fmaf(x63, l[3], s3); } x31 = (lane == 31) ? 1.0f : -((s0 + s1) + (s2 + s3)); asm volatile("" : "+v"(x31) : : "memory"); }
    { float s0 = 0.f, s1 = 0.f, s2 = 0.f, s3 = 0.f; { const f32x4 l = *(const LAS f32x4*)(Lc + 2068); s3 = fmaf(x31, l[3], s3); } { const f32x4 l = *(const LAS f32x4*)(Lc + 2072); s0 = fmaf(x32, l[0], s0); s1 = fmaf(x33, l[1], s1); s2 = fmaf(x34, l[2], s2); s3 = fmaf(x35, l[3], s3); } { const f32x4 l = *(const LAS f32x4*)(Lc + 2076); s0 = fmaf(x36, l[0], s0); s1 = fmaf(x37, l[1], s1); s2 = fmaf(x38, l[2], s2); s3 = fmaf(x39, l[3], s3); } { const f32x4 l = *(const LAS f32x4*)(Lc + 2080); s0 = fmaf(x40, l[0], s0); s1 = fmaf(x41, l[1], s1); s2 = fmaf(x42, l[2], s2); s3 = fmaf(x43, l[3], s3); } { const f32x4 l = *(const LAS f32x4*)(Lc + 2084); s0 = fmaf(x44, l[0], s0); s1 = fmaf(x45, l[1], s1); s2 = fmaf(x46, l[2], s2); s3 = fmaf(x47, l[3], s3); } { const f32x4 l = *(const LAS f32x4*)(Lc + 2088); s0 = fmaf(x48, l[0], s0); s1 = fmaf(x49, l[1], s1); s2 = fmaf(x50, l[2], s2); s3 = fmaf(x51, l[3], s3); } { const f32x4 l = *(const LAS f32x4*)(Lc + 2092); s0 = fmaf(x52, l[0], s0); s1 = fmaf(x53, l[1], s1); s2 = fmaf(x54, l[2], s2); s3 = fmaf(x55, l[3], s3); } { const f32x4 l = *(const LAS f32x4*)(Lc + 2096); s0 = fmaf(x56, l[0], s0); s1 = fmaf(x57, l[1], s1); s2 = fmaf(x58, l[2], s2); s3 = fmaf(x59, l[3], s3); } { const f32x4 l = *(const LAS f32x4*)(Lc + 2100); s0 = fmaf(x60, l[0], s0); s1 = fmaf(x61, l[1], s1); s2 = fmaf(x62, l[2], s2); s3 = fmaf(x63, l[3], s3); } x30 = (lane == 30) ? 1.0f : -((s0 + s1) + (s2 + s3)); asm volatile("" : "+v"(x30) : : "memory"); }
    { float s0 = 0.f, s1 = 0.f, s2 = 0.f, s3 = 0.f; { const f32x4 l = *(const LAS f32x4*)(Lc + 2000); s2 = fmaf(x30, l[2], s2); s3 = fmaf(x31, l[3], s3); } { const f32x4 l = *(const LAS f32x4*)(Lc + 2004); s0 = fmaf(x32, l[0], s0); s1 = fmaf(x33, l[1], s1); s2 = fmaf(x34, l[2], s2); s3 = fmaf(x35, l[3], s3); } { const f32x4 l = *(const LAS f32x4*)(Lc + 2008); s0 = fmaf(x36, l[0], s0); s1 = fmaf(x37, l[1], s1); s2 = fmaf(x38, l[2], s2); s3 = fmaf(x39, l[3], s3); } { const f32x4 l = *(const LAS f32x4*)(Lc + 2012); s0 = fmaf(x40, l[0], s0); s1 = fmaf(x41, l[1], s1); s2 = fmaf(x42, l[2], s2); s3 = fmaf(x43, l[3], s3); } { const f32x4 l = *(const LAS f32x4*)(Lc + 2016); s0 = fmaf(x44, l[0], s0); s1 = fmaf(x45, l[1], s1); s2 = fmaf(x46, l[2], s2); s3 = fmaf(x47, l[3], s3); } { const f32x4 l = *(const LAS f32x4*)(Lc + 2020); s0 = fmaf(x48, l[0], s0); s1 = fmaf(x49, l[1], s1); s2 = fmaf(x50, l[2], s2); s3 = fmaf(x51, l[3], s3); } { const f32x4 l = *(const LAS f32x4*)(Lc + 2024); s0 = fmaf(x52, l[0], s0); s1 = fmaf(x53, l[1], s1); s2 = fmaf(x54, l[2], s2); s3 = fmaf(x55, l[3], s3); } { const f32x4 l = *(const LAS f32x4*)(Lc + 2028); s0 = fmaf(x56, l[0], s0); s1 = fmaf(x57, l[1], s1); s2 = fmaf(x58, l[2], s2); s3 = fmaf(x59, l[3], s3); } { const f32x4 l = *(const LAS f32x4*)(Lc + 2032); s0 = fmaf(x60, l[0], s0); s1 = fmaf(x61, l[1], s1); s2 = fmaf(x62, l[2], s2); s3 = fmaf(x63, l[3], s3); } x29 = (lane == 29) ? 1.0f : -((s0 + s1) + (s2 + s3)); asm volatile("" : "+v"(x29) : : "memory"); }
    { float s0 = 0.f, s1 = 0.f, s2 = 0.f, s3 = 0.f; { const f32x4 l = *(const LAS f32x4*)(Lc + 1932); s1 = fmaf(x29, l[1], s1); s2 = fmaf(x30, l[2], s2); s3 = fmaf(x31, l[3], s3); } { const f32x4 l = *(const LAS f32x4*)(Lc + 1936); s0 = fmaf(x32, l[0], s0); s1 = fmaf(x33, l[1], s1); s2 = fmaf(x34, l[2], s2); s3 = fmaf(x35, l[3], s3); } { const f32x4 l = *(const LAS f32x4*)(Lc + 1940); s0 = fmaf(x36, l[0], s0); s1 = fmaf(x37, l[1], s1); s2 = fmaf(x38, l[2], s2); s3 = fmaf(x39, l[3], s3); } { const f32x4 l = *(const LAS f32x4*)(Lc + 1944); s0 = fmaf(x40, l[0], s0); s1 = fmaf(x41, l[1], s1); s2 = fmaf(x42, l[2], s2); s3 = fmaf(x43, l[3], s3); } { const f32x4 l = *(const LAS f32x4*)(Lc + 1948); s0 = fmaf(x44, l[0], s0); s1 = fmaf(x45, l[1], s1); s2 = fmaf(x46, l[2], s2); s3 = fmaf(x47, l[3], s3); } { const f32x4 l = *(const LAS f32x4*)(Lc + 1952); s0 = fmaf(x48, l[0], s0); s1 = fmaf(x49, l[1], s1); s2 = fmaf(x50, l[2], s2); s3 = fmaf(x51, l[3], s3); } { const f32x4 l = *(const LAS f32x4*)(Lc + 1956); s0 = fmaf(x52, l[0], s0); s1 = fmaf(x53, l[1], s1); s2 = fmaf(x54, l[2], s2); s3 = fmaf(x55, l[3], s3); } { const f32x4 l = *(const LAS f32x4*)(Lc + 1960); s0 = fmaf(x56, l[0], s0); s1 = fmaf(x57, l[1], s1); s2 = fmaf(x58, l[2], s2); s3 = fmaf(x59, l[3], s3); } { const f32x4 l = *(const LAS f32x4*)(Lc + 1964); s0 = fmaf(x60, l[0], s0); s1 = fmaf(x61, l[1], s1); s2 = fmaf(x62, l[2], s2); s3 = fmaf(x63, l[3], s3); } x28 = (lane == 28) ? 1.0f : -((s0 + s1) + (s2 + s3)); asm volatile("" : "+v"(x28) : : "memory"); }
    { float s0 = 0.f, s1 = 0.f, s2 = 0.f, s3 = 0.f; { const f32x4 l = *(const LAS f32x4*)(Lc + 1864); s0 = fmaf(x28, l[0], s0); s1 = fmaf(x29, l[1], s1); s2 = fmaf(x30, l[2], s2); s3 = fmaf(x31, l[3], s3); } { const f32x4 l = *(const LAS f32x4*)(Lc + 1868); s0 = fmaf(x32, l[0], s0); s1 = fmaf(x33, l[1], s1); s2 = fmaf(x34, l[2], s2); s3 = fmaf(x35, l[3], s3); } { const f32x4 l = *(const LAS f32x4*)(Lc + 1872); s0 = fmaf(x36, l[0], s0); s1 = fmaf(x37, l[1], s1); s2 = fmaf(x38, l[2], s2); s3 = fmaf(x39, l[3], s3); } { const f32x4 l = *(const LAS f32x4*)(Lc + 1876); s0 = fmaf(x40, l[0], s0); s1 = fmaf(x41, l[1], s1); s2 = fmaf(x42, l[2], s2); s3 = fmaf(x43, l[3], s3); } { const f32x4 l = *(const LAS f32x4*)(Lc + 1880); s0 = fmaf(x44, l[0], s0); s1 = fmaf(x45, l[1], s1); s2 = fmaf(x46, l[2], s2); s3 = fmaf(x47, l[3], s3); } { const f32x4 l = *(const LAS f32x4*)(Lc + 1884); s0 = fmaf(x48, l[0], s0); s1 = fmaf(x49, l[1], s1); s2 = fmaf(x50, l[2], s2); s3 = fmaf(x51, l[3], s3); } { const f32x4 l = *(const LAS f32x4*)(Lc + 1888); s0 = fmaf(x52, l[0], s0); s1 = fmaf(x53, l[1], s1); s2 = fmaf(x54, l[2], s2); s3 = fmaf(x55, l[3], s3); } { const f32x4 l = *(const LAS f32x4*)(Lc + 1892); s0 = fmaf(x56, l[0], s0); s1 = fmaf(x57, l[1], s1); s2 = fmaf(x58, l[2], s2); s3 = fmaf(x59, l[3], s3); } { const f32x4 l = *(const LAS f32x4*)(Lc + 1896); s0 = fmaf(x60, l[0], s0); s1 = fmaf(x61, l[1], s1); s2 = fmaf(x62, l[2], s2); s3 = fmaf(x63, l[3], s3); } x27 = (lane == 27) ? 1.0f : -((s0 + s1) + (s2 + s3)); asm volatile("" : "+v"(x27) : : "memory"); }
    { float s0 = 0.f, s1 = 0.f, s2 = 0.f, s3 = 0.f; { const f32x4 l = *(const LAS f32x4*)(Lc + 1792); s3 = fmaf(x27, l[3], s3); } { const f32x4 l = *(const LAS f32x4*)(Lc + 1796); s0 = fmaf(x28, l[0], s0); s1 = fmaf(x29, l[1], s1); s2 = fmaf(x30, l[2], s2); s3 = fmaf(x31, l[3], s3); } { const f32x4 l = *(const LAS f32x4*)(Lc + 1800); s0 = fmaf(x32, l[0], s0); s1 = fmaf(x33, l[1], s1); s2 = fmaf(x34, l[2], s2); s3 = fmaf(x35, l[3], s3); } { const f32x4 l = *(const LAS f32x4*)(Lc + 1804); s0 = fmaf(x36, l[0], s0); s1 = fmaf(x37, l[1], s1); s2 = fmaf(x38, l[2], s2); s3 = fmaf(x39, l[3], s3); } { const f32x4 l = *(const LAS f32x4*)(Lc + 1808); s0 = fmaf(x40, l[0], s0); s1 = fmaf(x41, l[1], s1); s2 = fmaf(x42, l[2], s2); s3 = fmaf(x43, l[3], s3); } { const f32x4 l = *(const LAS f32x4*)(Lc + 1812); s0 = fmaf(x44, l[0], s0); s1 = fmaf(x45, l[1], s1); s2 = fmaf(x46, l[2], s2); s3 = fmaf(x47, l[3], s3); } { const f32x4 l = *(const LAS f32x4*)(Lc + 1816); s0 = fmaf(x48, l[0], s0); s1 = fmaf(x49, l[1], s1); s2 = fmaf(x50, l[2], s2); s3 = fmaf(x51, l[3], s3); } { const f32x4 l = *(const LAS f32x4*)(Lc + 1820); s0 = fmaf(x52, l[0], s0); s1 = fmaf(x53, l[1], s1); s2 = fmaf(x54, l[2], s2); s3 = fmaf(x55, l[3], s3); } { const f32x4 l = *(const LAS f32x4*)(Lc + 1824); s0 = fmaf(x56, l[0], s0); s1 = fmaf(x57, l[1], s1); s2 = fmaf(x58, l[2], s2); s3 = fmaf(x59, l[3], s3); } { const f32x4 l = *(const LAS f32x4*)(Lc + 1828); s0 = fmaf(x60, l[0], s0); s1 = fmaf(x61, l[1], s1); s2 = fmaf(x62, l[2], s2); s3 = fmaf(x63, l[3], s3); } x26 = (lane == 26) ? 1.0f : -((s0 + s1) + (s2 + s3)); asm volatile("" : "+v"(x26) : : "memory"); }
    { float s0 = 0.f, s1 = 0.f, s2 = 0.f, s3 = 0.f; { const f32x4 l = *(const LAS f32x4*)(Lc + 1724); s2 = fmaf(x26, l[2], s2); s3 = fmaf(x27, l[3], s3); } { const f32x4 l = *(const LAS f32x4*)(Lc + 1728); s0 = fmaf(x28, l[0], s0); s1 = fmaf(x29, l[1], s1); s2 = fmaf(x30, l[2], s2); s3 = fmaf(x31, l[3], s3); } { const f32x4 l = *(const LAS f32x4*)(Lc + 1732); s0 = fmaf(x32, l[0], s0); s1 = fmaf(x33, l[1], s1); s2 = fmaf(x34, l[2], s2); s3 = fmaf(x35, l[3], s3); } { const f32x4 l = *(const LAS f32x4*)(Lc + 1736); s0 = fmaf(x36, l[0], s0); s1 = fmaf(x37, l[1], s1); s2 = fmaf(x38, l[2], s2); s3 = fmaf(x39, l[3], s3); } { const f32x4 l = *(const LAS f32x4*)(Lc + 1740); s0 = fmaf(x40, l[0], s0); s1 = fmaf(x41, l[1], s1); s2 = fmaf(x42, l[2], s2); s3 = fmaf(x43, l[3], s3); } { const f32x4 l = *(const LAS f32x4*)(Lc + 1744); s0 = fmaf(x44, l[0], s0); s1 = fmaf(x45, l[1], s1); s2 = fmaf(x46, l[2], s2); s3 = fmaf(x47, l[3], s3); } { const f32x4 l = *(const LAS f32x4*)(Lc + 1748); s0 = fmaf(x48, l[0], s0); s1 = fmaf(x49, l[1], s1); s2 = fmaf(x50, l[2], s2); s3 = fmaf(x51, l[3], s3); } { const f32x4 l = *(const LAS f32x4*)(Lc + 1752); s0 = fmaf(x52, l[0], s0); s1 = fmaf(x53, l[1], s1); s2 = fmaf(x54, l[2], s2); s3 = fmaf(x55, l[3], s3); } { const f32x4 l = *(const LAS f32x4*)(Lc + 1756); s0 = fmaf(x56, l[0], s0); s1 = fmaf(x57, l[1], s1); s2 = fmaf(x58, l[2], s2); s3 = fmaf(x59, l[3], s3); } { const f32x4 l = *(const LAS f32x4*)(Lc + 1760); s0 = fmaf(x60, l[0], s0); s1 = fmaf(x61, l[1], s1); s2 = fmaf(x62, l[2], s2); s3 = fmaf(x63, l[3], s3); } x25 = (lane == 25) ? 1.0f : -((s0 + s1) + (s2 + s3)); asm volatile("" : "+v"(x25) : : "memory"); }
    { float s0 = 0.f, s1 = 0.f, s2 = 0.f, s3 = 0.f; { const f32x4 l = *(const LAS f32x4*)(Lc + 1656); s1 = fmaf(x25, l[1], s1); s2 = fmaf(x26, l[2], s2); s3 = fmaf(x27, l[3], s3); } { const f32x4 l = *(const LAS f32x4*)(Lc + 1660); s0 = fmaf(x28, l[0], s0); s1 = fmaf(x29, l[1], s1); s2 = fmaf(x30, l[2], s2); s3 = fmaf(x31, l[3], s3); } { const f32x4 l = *(const LAS f32x4*)(Lc + 1664); s0 = fmaf(x32, l[0], s0); s1 = fmaf(x33, l[1], s1); s2 = fmaf(x34, l[2], s2); s3 = fmaf(x35, l[3], s3); } { const f32x4 l = *(const LAS f32x4*)(Lc + 1668); s0 = fmaf(x36, l[0], s0); s1 = fmaf(x37, l[1], s1); s2 = fmaf(x38, l[2], s2); s3 = fmaf(x39, l[3], s3); } { const f32x4 l = *(const LAS f32x4*)(Lc + 1672); s0 = fmaf(x40, l[0], s0); s1 = fmaf(x41, l[1], s1); s2 = fmaf(x42, l[2], s2); s3 = fmaf(x43, l[3], s3); } { const f32x4 l = *(const LAS f32x4*)(Lc + 1676); s0 = fmaf(x44, l[0], s0); s1 = fmaf(x45, l[1], s1); s2 = fmaf(x46, l[2], s2); s3 = fmaf(x47, l[3], s3); } { const f32x4 l = *(const LAS f32x4*)(Lc + 1680); s0 = fmaf(x48, l[0], s0); s1 = fmaf(x49, l[1], s1); s2 = fmaf(x50, l[2], s2); s3 = fmaf(x51, l[3], s3); } { const f32x4 l = *(const LAS f32x4*)(Lc + 1684); s0 = fmaf(x52, l[0], s0); s1 = fmaf(x53, l[1], s1); s2 = fmaf(x54, l[2], s2); s3 = fmaf(x55, l[3], s3); } { const f32x4 l = *(const LAS f32x4*)(Lc + 1688); s0 = fmaf(x56, l[0], s0); s1 = fmaf(x57, l[1], s1); s2 = fmaf(x58, l[2], s2); s3 = fmaf(x59, l[3], s3); } { const f32x4 l = *(const LAS f32x4*)(Lc + 1692); s0 = fmaf(x60, l[0], s0); s1 = fmaf(x61, l[1], s1); s2 = fmaf(x62, l[2], s2); s3 = fmaf(x63, l[3], s3); } x24 = (lane == 24) ? 1.0f : -((s0 + s1) + (s2 + s3)); asm volatile("" : "+v"(x24) : : "memory"); }
    { float s0 = 0.f, s1 = 0.f, s2 = 0.f, s3 = 0.f; { const f32x4 l = *(const LAS f32x4*)(Lc + 1588); s0 = fmaf(x24, l[0], s0); s1 = fmaf(x25, l[1], s1); s2 = fmaf(x26, l[2], s2); s3 = fmaf(x27, l[3], s3); } { const f32x4 l = *(const LAS f32x4*)(Lc + 1592); s0 = fmaf(x28, l[0], s0); s1 = fmaf(x29, l[1], s1); s2 = fmaf(x30, l[2], s2); s3 = fmaf(x31, l[3], s3); } { const f32x4 l = *(const LAS f32x4*)(Lc + 1596); s0 = fmaf(x32, l[0], s0); s1 = fmaf(x33, l[1], s1); s2 = fmaf(x34, l[2], s2); s3 = fmaf(x35, l[3], s3); } { const f32x4 l = *(const LAS f32x4*)(Lc + 1600); s0 = fmaf(x36, l[0], s0); s1 = fmaf(x37, l[1], s1); s2 = fmaf(x38, l[2], s2); s3 = fmaf(x39, l[3], s3); } { const f32x4 l = *(const LAS f32x4*)(Lc + 1604); s0 = fmaf(x40, l[0], s0); s1 = fmaf(x41, l[1], s1); s2 = fmaf(x42, l[2], s2); s3 = fmaf(x43, l[3], s3); } { const f32x4 l = *(const LAS f32x4*)(Lc + 1608); s0 = fmaf(x44, l[0], s0); s1 = fmaf(x45, l[1], s1); s2 = fmaf(x46, l[2], s2); s3 = fmaf(x47, l[3], s3); } { const f32x4 l = *(const LAS f32x4*)(Lc + 1612); s0 = fmaf(x48, l[0], s0); s1 = fmaf(x49, l[1], s1); s2 = fmaf(x50, l[2], s2); s3 = fmaf(x51, l[3], s3); } { const f32x4 l = *(const LAS f32x4*)(Lc + 1616); s0 = fmaf(x52, l[0], s0); s1 = fmaf(x53, l[1], s1); s2 = fmaf(x54, l[2], s2); s3 = fmaf(x55, l[3], s3); } { const f32x4 l = *(const LAS f32x4*)(Lc + 1620); s0 = fmaf(x56, l[0], s0); s1 = fmaf(x57, l[1], s1); s2 = fmaf(x58, l[2], s2); s3 = fmaf(x59, l[3], s3); } { const f32x4 l = *(const LAS f32x4*)(Lc + 1624); s0 = fmaf(x60, l[0], s0); s1 = fmaf(x61, l[1], s1); s2 = fmaf(x62, l[2], s2); s3 = fmaf(x63, l[3], s3); } x23 = (lane == 23) ? 1.0f : -((s0 + s1) + (s2 + s3)); asm volatile("" : "+v"(x23) : : "memory"); }
    { float s0 = 0.f, s1 = 0.f, s2 = 0.f, s3 = 0.f; { const f32x4 l = *(const LAS f32x4*)(Lc + 1516); s3 = fmaf(x23, l[3], s3); } { const f32x4 l = *(const LAS f32x4*)(Lc + 1520); s0 = fmaf(x24, l[0], s0); s1 = fmaf(x25, l[1], s1); s2 = fmaf(x26, l[2], s2); s3 = fmaf(x27, l[3], s3); } { const f32x4 l = *(const LAS f32x4*)(Lc + 1524); s0 = fmaf(x28, l[0], s0); s1 = fmaf(x29, l[1], s1); s2 = fmaf(x30, l[2], s2); s3 = fmaf(x31, l[3], s3); } { const f32x4 l = *(const LAS f32x4*)(Lc + 1528); s0 = fmaf(x32, l[0], s0); s1 = fmaf(x33, l[1], s1); s2 = fmaf(x34, l[2], s2); s3 = fmaf(x35, l[3], s3); } { const f32x4 l = *(const LAS f32x4*)(Lc + 1532); s0 = fmaf(x36, l[0], s0); s1 = fmaf(x37, l[1], s1); s2 = fmaf(x38, l[2], s2); s3 = fmaf(x39, l[3], s3); } { const f32x4 l = *(const LAS f32x4*)(Lc + 1536); s0 = fmaf(x40, l[0], s0); s1 = fmaf(x41, l[1], s1); s2 = fmaf(x42, l[2], s2); s3 = fmaf(x43, l[3], s3); } { const f32x4 l = *(const LAS f32x4*)(Lc + 1540); s0 = fmaf(x44, l[0], s0); s1 = fmaf(x45, l[1], s1); s2 = fmaf(x46, l[2], s2); s3 = fmaf(x47, l[3], s3); } { const f32x4 l = *(const LAS f32x4*)(Lc + 1544); s0 = fmaf(x48, l[0], s0); s1 = fmaf(x49, l[1], s1); s2 = fmaf(x50, l[2], s2); s3 = fmaf(x51, l[3], s3); } { const f32x4 l = *(const LAS f32x4*)(Lc + 1548); s0 = fmaf(x52, l[0], s0); s1 = fmaf(x53, l[1], s1); s2 = fmaf(x54, l[2], s2); s3 = fmaf(x55, l[3], s3); } { const f32x4 l = *(const LAS f32x4*)(Lc + 1552); s0 = fmaf(x56, l[0], s0); s1 = fmaf(x57, l[1], s1); s2 = fmaf(x58, l[2], s2); s3 = fmaf(x59, l[3], s3); } { const f32x4 l = *(const LAS f32x4*)(Lc + 1556); s0 = fmaf(x60, l[0], s0); s1 = fmaf(x61, l[1], s1); s2 = fmaf(x62, l[2], s2); s3 = fmaf(x63, l[3], s3); } x22 = (lane == 22) ? 1.0f : -((s0 + s1) + (s2 + s3)); asm volatile("" : "+v"(x22) : : "memory"); }
    { float s0 = 0.f, s1 = 0.f, s2 = 0.f, s3 = 0.f; { const f32x4 l = *(const LAS f32x4*)(Lc + 1448); s2 = fmaf(x22, l[2], s2); s3 = fmaf(x23, l[3], s3); } { const f32x4 l = *(const LAS f32x4*)(Lc + 1452); s0 = fmaf(x24, l[0], s0); s1 = fmaf(x25, l[1], s1); s2 = fmaf(x26, l[2], s2); s3 = fmaf(x27, l[3], s3); } { const f32x4 l = *(const LAS f32x4*)(Lc + 1456); s0 = fmaf(x28, l[0], s0); s1 = fmaf(x29, l[1], s1); s2 = fmaf(x30, l[2], s2); s3 = fmaf(x31, l[3], s3); } { const f32x4 l = *(const LAS f32x4*)(Lc + 1460); s0 = fmaf(x32, l[0], s0); s1 = fmaf(x33, l[1], s1); s2 = fmaf(x34, l[2], s2); s3 = fmaf(x35, l[3], s3); } { const f32x4 l = *(const LAS f32x4*)(Lc + 1464); s0 = fmaf(x36, l[0], s0); s1 = fmaf(x37, l[1], s1); s2 = fmaf(x38, l[2], s2); s3 = fmaf(x39, l[3], s3); } { const f32x4 l = *(const LAS f32x4*)(Lc + 1468); s0 = fmaf(x40, l[0], s0); s1 = fmaf(x41, l[1], s1); s2 = fmaf(x42, l[2], s2); s3 = fmaf(x43, l[3], s3); } { const f32x4 l = *(const LAS f32x4*)(Lc + 1472); s0 = fmaf(x44, l[0], s0); s1 = fmaf(x45, l[1], s1); s2 = fmaf(x46, l[2], s2); s3 = fmaf(x47, l[3], s3); } { const f32x4 l = *(const LAS f32x4*)(Lc + 1476); s0 = fmaf(x48, l[0], s0); s1 = fmaf(x49, l[1], s1); s2 = fmaf(x50, l[2], s2); s3 = fmaf(x51, l[3], s3); } { const f32x4 l = *(const LAS f32x4*)(Lc + 1480); s0 = fmaf(x52, l[0], s0); s1 = fmaf(x53, l[1], s1); s2 = fmaf(x54, l[2], s2); s3 = fmaf(x55, l[3], s3); } { const f32x4 l = *(const LAS f32x4*)(Lc + 1484); s0 = fmaf(x56, l[0], s0); s1 = fmaf(x57, l[1], s1); s2 = fmaf(x58, l[2], s2); s3 = fmaf(x59, l[3], s3); } { const f32x4 l = *(const LAS f32x4*)(Lc + 1488); s0 = fmaf(x60, l[0], s0); s1 = fmaf(x61, l[1], s1); s2 = fmaf(x62, l[2], s2); s3 = fmaf(x63, l[3], s3); } x21 = (lane == 21) ? 1.0f : -((s0 + s1) + (s2 + s3)); asm volatile("" : "+v"(x21) : : "memory"); }
    { float s0 = 0.f, s1 = 0.f, s2 = 0.f, s3 = 0.f; { const f32x4 l = *(const LAS f32x4*)(Lc + 1380); s1 = fmaf(x21, l[1], s1); s2 = fmaf(x22, l[2], s2); s3 = fmaf(x23, l[3], s3); } { const f32x4 l = *(const LAS f32x4*)(Lc + 1384); s0 = fmaf(x24, l[0], s0); s1 = fmaf(x25, l[1], s1); s2 = fmaf(x26, l[2], s2); s3 = fmaf(x27, l[3], s3); } { const f32x4 l = *(const LAS f32x4*)(Lc + 1388); s0 = fmaf(x28, l[0], s0); s1 = fmaf(x29, l[1], s1); s2 = fmaf(x30, l[2], s2); s3 = fmaf(x31, l[3], s3); } { const f32x4 l = *(const LAS f32x4*)(Lc + 1392); s0 = fmaf(x32, l[0], s0); s1 = fmaf(x33, l[1], s1); s2 = fmaf(x34, l[2], s2); s3 = fmaf(x35, l[3], s3); } { const f32x4 l = *(const LAS f32x4*)(Lc + 1396); s0 = fmaf(x36, l[0], s0); s1 = fmaf(x37, l[1], s1); s2 = fmaf(x38, l[2], s2); s3 = fmaf(x39, l[3], s3); } { const f32x4 l = *(const LAS f32x4*)(Lc + 1400); s0 = fmaf(x40, l[0], s0); s1 = fmaf(x41, l[1], s1); s2 = fmaf(x42, l[2], s2); s3 = fmaf(x43, l[3], s3); } { const f32x4 l = *(const LAS f32x4*)(Lc + 1404); s0 = fmaf(x44, l[0], s0); s1 = fmaf(x45, l[1], s1); s2 = fmaf(x46, l[2], s2); s3 = fmaf(x47, l[3], s3); } { const f32x4 l = *(const LAS f32x4*)(Lc + 1408); s0 = fmaf(x48, l[0], s0); s1 = fmaf(x49, l[1], s1); s2 = fmaf(x50, l[2], s2); s3 = fmaf(x51, l[3], s3); } { const f32x4 l = *(const LAS f32x4*)(Lc + 1412); s0 = fmaf(x52, l[0], s0); s1 = fmaf(x53, l[1], s1); s2 = fmaf(x54, l[2], s2); s3 = fmaf(x55, l[3], s3); } { const f32x4 l = *(const LAS f32x4*)(Lc + 1416); s0 = fmaf(x56, l[0], s0); s1 = fmaf(x57, l[1], s1); s2 = fmaf(x58, l[2], s2); s3 = fmaf(x59, l[3], s3); } { const f32x4 l = *(const LAS f32x4*)(Lc + 1420); s0 = fmaf(x60, l[0], s0); s1 = fmaf(x61, l[1], s1); s2 = fmaf(x62, l[2], s2); s3 = fmaf(x63, l[3], s3); } x20 = (lane == 20) ? 1.0f : -((s0 + s1) + (s2 + s3)); asm volatile("" : "+v"(x20) : : "memory"); }
    { float s0 = 0.f, s1 = 0.f, s2 = 0.f, s3 = 0.f; { const f32x4 l = *(const LAS f32x4*)(Lc + 1312); s0 = fmaf(x20, l[0], s0); s1 = fmaf(x21, l[1], s1); s2 = fmaf(x22, l[2], s2); s3 = fmaf(x23, l[3], s3); } { const f32x4 l = *(const LAS f32x4*)(Lc + 1316); s0 = fmaf(x24, l[0], s0); s1 = fmaf(x25, l[1], s1); s2 = fmaf(x26, l[2], s2); s3 = fmaf(x27, l[3], s3); } { const f32x4 l = *(const LAS f32x4*)(Lc + 1320); s0 = fmaf(x28, l[0], s0); s1 = fmaf(x29, l[1], s1); s2 = fmaf(x30, l[2], s2); s3 = fmaf(x31, l[3], s3); } { const f32x4 l = *(const LAS f32x4*)(Lc + 1324); s0 = fmaf(x32, l[0], s0); s1 = fmaf(x33, l[1], s1); s2 = fmaf(x34, l[2], s2); s3 = fmaf(x35, l[3], s3); } { const f32x4 l = *(const LAS f32x4*)(Lc + 1328); s0 = fmaf(x36, l[0], s0); s1 = fmaf(x37, l[1], s1); s2 = fmaf(x38, l[2], s2); s3 = fmaf(x39, l[3], s3); } { const f32x4 l = *(const LAS f32x4*)(Lc + 1332); s0 = fmaf(x40, l[0], s0); s1 = fmaf(x41, l[1], s1); s2 = fmaf(x42, l[2], s2); s3 = fmaf(x43, l[3], s3); } { const f32x4 l = *(const LAS f32x4*)(Lc + 1336); s0 = fmaf(x44, l[0], s0); s1 = fmaf(x45, l[1], s1); s2 = fmaf(x46, l[2], s2); s3 = fmaf(x47, l[3], s3); } { const f32x4 l = *(const LAS f32x4*)(Lc + 1340); s0 = fmaf(x48, l[0], s0); s1 = fmaf(x49, l[1], s1); s2 = fmaf(x50, l[2], s2); s3 = fmaf(x51, l[3], s3); } { const f32x4 l = *(const LAS f32x4*)(Lc + 1344); s0 = fmaf(x52, l[0], s0); s1 = fmaf(x53, l[1], s1); s2 = fmaf(x54, l[2], s2); s3 = fmaf(x55, l[3], s3); } { const f32x4 l = *(const LAS f32x4*)(Lc + 1348); s0 = fmaf(x56, l[0], s0); s1 = fmaf(x57, l[1], s1); s2 = fmaf(x58, l[2], s2); s3 = fmaf(x59, l[3], s3); } { const f32x4 l = *(const LAS f32x4*)(Lc + 1352); s0 = fmaf(x60, l[0], s0); s1 = fmaf(x61, l[1], s1); s2 = fmaf(x62, l[2], s2); s3 = fmaf(x63, l[3], s3); } x19 = (lane == 19) ? 1.0f : -((s0 + s1) + (s2 + s3)); asm volatile("" : "+v"(x19) : : "memory"); }
    { float s0 = 0.f, s1 = 0.f, s2 = 0.f, s3 = 0.f; { const f32x4 l = *(const LAS f32x4*)(Lc + 1240); s3 = fmaf(x19, l[3], s3); } { const f32x4 l = *(const LAS f32x4*)(Lc + 1244); s0 = fmaf(x20, l[0], s0); s1 = fmaf(x21, l[1], s1); s2 = fmaf(x22, l[2], s2); s3 = fmaf(x23, l[3], s3); } { const f32x4 l = *(const LAS f32x4*)(Lc + 1248); s0 = fmaf(x24, l[0], s0); s1 = fmaf(x25, l[1], s1); s2 = fmaf(x26, l[2], s2); s3 = fmaf(x27, l[3], s3); } { const f32x4 l = *(const LAS f32x4*)(Lc + 1252); s0 = fmaf(x28, l[0], s0); s1 = fmaf(x29, l[1], s1); s2 = fmaf(x30, l[2], s2); s3 = fmaf(x31, l[3], s3); } { const f32x4 l = *(const LAS f32x4*)(Lc + 1256); s0 = fmaf(x32, l[0], s0); s1 = fmaf(x33, l[1], s1); s2 = fmaf(x34, l[2], s2); s3 = fmaf(x35, l[3], s3); } { const f32x4 l = *(const LAS f32x4*)(Lc + 1260); s0 = fmaf(x36, l[0], s0); s1 = fmaf(x37, l[1], s1); s2 = fmaf(x38, l[2], s2); s3 = fmaf(x39, l[3], s3); } { const f32x4 l = *(const LAS f32x4*)(Lc + 1264); s0 = fmaf(x40, l[0], s0); s1 = fmaf(x41, l[1], s1); s2 = fmaf(x42, l[2], s2); s3 = fmaf(x43, l[3], s3); } { const f32x4 l = *(const LAS f32x4*)(Lc + 1268); s0 = fmaf(x44, l[0], s0); s1 = fmaf(x45, l[1], s1); s2 = fmaf(x46, l[2], s2); s3 = fmaf(x47, l[3], s3); } { const f32x4 l = *(const LAS f32x4*)(Lc + 1272); s0 = fmaf(x48, l[0], s0); s1 = fmaf(x49, l[1], s1); s2 = fmaf(x50, l[2], s2); s3 = fmaf(x51, l[3], s3); } { const f32x4 l = *(const LAS f32x4*)(Lc + 1276); s0 = fmaf(x52, l[0], s0); s1 = fmaf(x53, l[1], s1); s2 = fmaf(x54, l[2], s2); s3 = fmaf(x55, l[3], s3); } { const f32x4 l = *(const LAS f32x4*)(Lc + 1280); s0 = fmaf(x56, l[0], s0); s1 = fmaf(x57, l[1], s1); s2 = fmaf(x58, l[2], s2); s3 = fmaf(x59, l[3], s3); } { const f32x4 l = *(const LAS f32x4*)(Lc + 1284); s0 = fmaf(x60, l[0], s0); s1 = fmaf(x61, l[1], s1); s2 = fmaf(x62, l[2], s2); s3 = fmaf(x63, l[3], s3); } x18 = (lane == 18) ? 1.0f : -((s0 + s1) + (s2 + s3)); asm volatile("" : "+v"(x18) : : "memory"); }
    { float s0 = 0.f, s1 = 0.f, s2 = 0.f, s3 = 0.f; { const f32x4 l = *(const LAS f32x4*)(Lc + 1172); s2 = fmaf(x18, l[2], s2); s3 = fmaf(x19, l[3], s3); } { const f32x4 l = *(const LAS f32x4*)(Lc + 1176); s0 = fmaf(x20, l[0], s0); s1 = fmaf(x21, l[1], s1); s2 = fmaf(x22, l[2], s2); s3 = fmaf(x23, l[3], s3); } { const f32x4 l = *(const LAS f32x4*)(Lc + 1180); s0 = fmaf(x24, l[0], s0); s1 = fmaf(x25, l[1], s1); s2 = fmaf(x26, l[2], s2); s3 = fmaf(x27, l[3], s3); } { const f32x4 l = *(const LAS f32x4*)(Lc + 1184); s0 = fmaf(x28, l[0], s0); s1 = fmaf(x29, l[1], s1); s2 = fmaf(x30, l[2], s2); s3 = fmaf(x31, l[3], s3); } { const f32x4 l = *(const LAS f32x4*)(Lc + 1188); s0 = fmaf(x32, l[0], s0); s1 = fmaf(x33, l[1], s1); s2 = fmaf(x34, l[2], s2); s3 = fmaf(x35, l[3], s3); } { const f32x4 l = *(const LAS f32x4*)(Lc + 1192); s0 = fmaf(x36, l[0], s0); s1 = fmaf(x37, l[1], s1); s2 = fmaf(x38, l[2], s2); s3 = fmaf(x39, l[3], s3); } { const f32x4 l = *(const LAS f32x4*)(Lc + 1196); s0 = fmaf(x40, l[0], s0); s1 = fmaf(x41, l[1], s1); s2 = fmaf(x42, l[2], s2); s3 = fmaf(x43, l[3], s3); } { const f32x4 l = *(const LAS f32x4*)(Lc + 1200); s0 = fmaf(x44, l[0], s0); s1 = fmaf(x45, l[1], s1); s2 = fmaf(x46, l[2], s2); s3 = fmaf(x47, l[3], s3); } { const f32x4 l = *(const LAS f32x4*)(Lc + 1204); s0 = fmaf(x48, l[0], s0); s1 = fmaf(x49, l[1], s1); s2 = fmaf(x50, l[2], s2); s3 = fmaf(x51, l[3], s3); } { const f32x4 l = *(const LAS f32x4*)(Lc + 1208); s0 = fmaf(x52, l[0], s0); s1 = fmaf(x53, l[1], s1); s2 = fmaf(x54, l[2], s2); s3 = fmaf(x55, l[3], s3); } { const f32x4 l = *(const LAS f32x4*)(Lc + 1212); s0 = fmaf(x56, l[0], s0); s1 = fmaf(x57, l[1], s1); s2 = fmaf(x58, l[2], s2); s3 = fmaf(x59, l[3], s3); } { const f32x4 l = *(const LAS f32x4*)(Lc + 1216); s0 = fmaf(x60, l[0], s0); s1 = fmaf(x61, l[1], s1); s2 = fmaf(x62, l[2], s2); s3 = fmaf(x63, l[3], s3); } x17 = (lane == 17) ? 1.0f : -((s0 + s1) + (s2 + s3)); asm volatile("" : "+v"(x17) : : "memory"); }
    { float s0 = 0.f, s1 = 0.f, s2 = 0.f, s3 = 0.f; { const f32x4 l = *(const LAS f32x4*)(Lc + 1104); s1 = fmaf(x17, l[1], s1); s2 = fmaf(x18, l[2], s2); s3 = fmaf(x19, l[3], s3); } { const f32x4 l = *(const LAS f32x4*)(Lc + 1108); s0 = fmaf(x20, l[0], s0); s1 = fmaf(x21, l[1], s1); s2 = fmaf(x22, l[2], s2); s3 = fmaf(x23, l[3], s3); } { const f32x4 l = *(const LAS f32x4*)(Lc + 1112); s0 = fmaf(x24, l[0], s0); s1 = fmaf(x25, l[1], s1); s2 = fmaf(x26, l[2], s2); s3 = fmaf(x27, l[3], s3); } { const f32x4 l = *(const LAS f32x4*)(Lc + 1116); s0 = fmaf(x28, l[0], s0); s1 = fmaf(x29, l[1], s1); s2 = fmaf(x30, l[2], s2); s3 = fmaf(x31, l[3], s3); } { const f32x4 l = *(const LAS f32x4*)(Lc + 1120); s0 = fmaf(x32, l[0], s0); s1 = fmaf(x33, l[1], s1); s2 = fmaf(x34, l[2], s2); s3 = fmaf(x35, l[3], s3); } { const f32x4 l = *(const LAS f32x4*)(Lc + 1124); s0 = fmaf(x36, l[0], s0); s1 = fmaf(x37, l[1], s1); s2 = fmaf(x38, l[2], s2); s3 = fmaf(x39, l[3], s3); } { const f32x4 l = *(const LAS f32x4*)(Lc + 1128); s0 = fmaf(x40, l[0], s0); s1 = fmaf(x41, l[1], s1); s2 = fmaf(x42, l[2], s2); s3 = fmaf(x43, l[3], s3); } { const f32x4 l = *(const LAS f32x4*)(Lc + 1132); s0 = fmaf(x44, l[0], s0); s1 = fmaf(x45, l[1], s1); s2 = fmaf(x46, l[2], s2); s3 = fmaf(x47, l[3], s3); } { const f32x4 l = *(const LAS f32x4*)(Lc + 1136); s0 = fmaf(x48, l[0], s0); s1 = fmaf(x49, l[1], s1); s2 = fmaf(x50, l[2], s2); s3 = fmaf(x51, l[3], s3); } { const f32x4 l = *(const LAS f32x4*)(Lc + 1140); s0 = fmaf(x52, l[0], s0); s1 = fmaf(x53, l[1], s1); s2 = fmaf(x54, l[2], s2); s3 = fmaf(x55, l[3], s3); } { const f32x4 l = *(const LAS f32x4*)(Lc + 1144); s0 = fmaf(x56, l[0], s0); s1 = fmaf(x57, l[1], s1); s2 = fmaf(x58, l[2], s2); s3 = fmaf(x59, l[3], s3); } { const f32x4 l = *(const LAS f32x4*)(Lc + 1148); s0 = fmaf(x60, l[0], s0); s1 = fmaf(x61, l[1], s1); s2 = fmaf(x62, l[2], s2); s3 = fmaf(x63, l[3], s3); } x16 = (lane == 16) ? 1.0f : -((s0 + s1) + (s2 + s3)); asm volatile("" : "+v"(x16) : : "memory"); }
    { float s0 = 0.f, s1 = 0.f, s2 = 0.f, s3 = 0.f; { const f32x4 l = *(const LAS f32x4*)(Lc + 1036); s0 = fmaf(x16, l[0], s0); s1 = fmaf(x17, l[1], s1); s2 = fmaf(x18, l[2], s2); s3 = fmaf(x19, l[3], s3); } { const f32x4 l = *(const LAS f32x4*)(Lc + 1040); s0 = fmaf(x20, l[0], s0); s1 = fmaf(x21, l[1], s1); s2 = fmaf(x22, l[2], s2); s3 = fmaf(x23, l[3], s3); } { const f32x4 l = *(const LAS f32x4*)(Lc + 1044); s0 = fmaf(x24, l[0], s0); s1 = fmaf(x25, l[1], s1); s2 = fmaf(x26, l[2], s2); s3 = fmaf(x27, l[3], s3); } { const f32x4 l = *(const LAS f32x4*)(Lc + 1048); s0 = fmaf(x28, l[0], s0); s1 = fmaf(x29, l[1], s1); s2 = fmaf(x30, l[2], s2); s3 = fmaf(x31, l[3], s3); } { const f32x4 l = *(const LAS f32x4*)(Lc + 1052); s0 = fmaf(x32, l[0], s0); s1 = fmaf(x33, l[1], s1); s2 = fmaf(x34, l[2], s2); s3 = fmaf(x35, l[3], s3); } { const f32x4 l = *(const LAS f32x4*)(Lc + 1056); s0 = fmaf(x36, l[0], s0); s1 = fmaf(x37, l[1], s1); s2 = fmaf(x38, l[2], s2); s3 = fmaf(x39, l[3], s3); } { const f32x4 l = *(const LAS f32x4*)(Lc + 1060); s0 = fmaf(x40, l[0], s0); s1 = fmaf(x41, l[1], s1); s2 = fmaf(x42, l[2], s2); s3 = fmaf(x43, l[3], s3); } { const f32x4 l = *(const LAS f32x4*)(Lc + 1064); s0 = fmaf(x44, l[0], s0); s1 = fmaf(x45, l[1], s1); s2 = fmaf(x46, l[2], s2); s3 = fmaf(x47, l[3], s3); } { const f32x4 l = *(const LAS f32x4*)(Lc + 1068); s0 = fmaf(x48, l[0], s0); s1 = fmaf(x49, l[1], s1); s2 = fmaf(x50, l[2], s2); s3 = fmaf(x51, l[3], s3); } { const f32x4 l = *(const LAS f32x4*)(Lc + 1072); s0 = fmaf(x52, l[0], s0); s1 = fmaf(x53, l[1], s1); s2 = fmaf(x54, l[2], s2); s3 = fmaf(x55, l[3], s3); } { const f32x4 l = *(const LAS f32x4*)(Lc + 1076); s0 = fmaf(x56, l[0], s0); s1 = fmaf(x57, l[1], s1); s2 = fmaf(x58, l[2], s2); s3 = fmaf(x59, l[3], s3); } { const f32x4 l = *(const LAS f32x4*)(Lc + 1080); s0 = fmaf(x60, l[0], s0); s1 = fmaf(x61, l[1], s1); s2 = fmaf(x62, l[2], s2); s3 = fmaf(x63, l[3], s3); } x15 = (lane == 15) ? 1.0f : -((s0 + s1) + (s2 + s3)); asm volatile("" : "+v"(x15) : : "memory"); }
    { float s0 = 0.f, s1 = 0.f, s2 = 0.f, s3 = 0.f; { const f32x4 l = *(const LAS f32x4*)(Lc + 964); s3 = fmaf(x15, l[3], s3); } { const f32x4 l = *(const LAS f32x4*)(Lc + 968); s0 = fmaf(x16, l[0], s0); s1 = fmaf(x17, l[1], s1); s2 = fmaf(x18, l[2], s2); s3 = fmaf(x19, l[3], s3); } { const f32x4 l = *(const LAS f32x4*)(Lc + 972); s0 = fmaf(x20, l[0], s0); s1 = fmaf(x21, l[1], s1); s2 = fmaf(x22, l[2], s2); s3 = fmaf(x23, l[3], s3); } { const f32x4 l = *(const LAS f32x4*)(Lc + 976); s0 = fmaf(x24, l[0], s0); s1 = fmaf(x25, l[1], s1); s2 = fmaf(x26, l[2], s2); s3 = fmaf(x27, l[3], s3); } { const f32x4 l = *(const LAS f32x4*)(Lc + 980); s0 = fmaf(x28, l[0], s0); s1 = fmaf(x29, l[1], s1); s2 = fmaf(x30, l[2], s2); s3 = fmaf(x31, l[3], s3); } { const f32x4 l = *(const LAS f32x4*)(Lc + 984); s0 = fmaf(x32, l[0], s0); s1 = fmaf(x33, l[1], s1); s2 = fmaf(x34, l[2], s2); s3 = fmaf(x35, l[3], s3); } { const f32x4 l = *(const LAS f32x4*)(Lc + 988); s0 = fmaf(x36, l[0], s0); s1 = fmaf(x37, l[1], s1); s2 = fmaf(x38, l[2], s2); s3 = fmaf(x39, l[3], s3); } { const f32x4 l = *(const LAS f32x4*)(Lc + 992); s0 = fmaf(x40, l[0], s0); s1 = fmaf(x41, l[1], s1); s2 = fmaf(x42, l[2], s2); s3 = fmaf(x43, l[3], s3); } { const f32x4 l = *(const LAS f32x4*)(Lc + 996); s0 = fmaf(x44, l[0], s0); s1 = fmaf(x45, l[1], s1); s2 = fmaf(x46, l[2], s2); s3 = fmaf(x47, l[3], s3); } { const f32x4 l = *(const LAS f32x4*)(Lc + 1000); s0 = fmaf(x48, l[0], s0); s1 = fmaf(x49, l[1], s1); s2 = fmaf(x50, l[2], s2); s3 = fmaf(x51, l[3], s3); } { const f32x4 l = *(const LAS f32x4*)(Lc + 1004); s0 = fmaf(x52, l[0], s0); s1 = fmaf(x53, l[1], s1); s2 = fmaf(x54, l[2], s2); s3 = fmaf(x55, l[3], s3); } { const f32x4 l = *(const LAS f32x4*)(Lc + 1008); s0 = fmaf(x56, l[0], s0); s1 = fmaf(x57, l[1], s1); s2 = fmaf(x58, l[2], s2); s3 = fmaf(x59, l[3], s3); } { const f32x4 l = *(const LAS f32x4*)(Lc + 1012); s0 = fmaf(x60, l[0], s0); s1 = fmaf(x61, l[1], s1); s2 = fmaf(x62, l[2], s2); s3 = fmaf(x63, l[3], s3); } x14 = (lane == 14) ? 1.0f : -((s0 + s1) + (s2 + s3)); asm volatile("" : "+v"(x14) : : "memory"); }
    { float s0 = 0.f, s1 = 0.f, s2 = 0.f, s3 = 0.f; { const f32x4 l = *(const LAS f32x4*)(Lc + 896); s2 = fmaf(x14, l[2], s2); s3 = fmaf(x15, l[3], s3); } { const f32x4 l = *(const LAS f32x4*)(Lc + 900); s0 = fmaf(x16, l[0], s0); s1 = fmaf(x17, l[1], s1); s2 = fmaf(x18, l[2], s2); s3 = fmaf(x19, l[3], s3); } { const f32x4 l = *(const LAS f32x4*)(Lc + 904); s0 = fmaf(x20, l[0], s0); s1 = fmaf(x21, l[1], s1); s2 = fmaf(x22, l[2], s2); s3 = fmaf(x23, l[3], s3); } { const f32x4 l = *(const LAS f32x4*)(Lc + 908); s0 = fmaf(x24, l[0], s0); s1 = fmaf(x25, l[1], s1); s2 = fmaf(x26, l[2], s2); s3 = fmaf(x27, l[3], s3); } { const f32x4 l = *(const LAS f32x4*)(Lc + 912); s0 = fmaf(x28, l[0], s0); s1 = fmaf(x29, l[1], s1); s2 = fmaf(x30, l[2], s2); s3 = fmaf(x31, l[3], s3); } { const f32x4 l = *(const LAS f32x4*)(Lc + 916); s0 = fmaf(x32, l[0], s0); s1 = fmaf(x33, l[1], s1); s2 = fmaf(x34, l[2], s2); s3 = fmaf(x35, l[3], s3); } { const f32x4 l = *(const LAS f32x4*)(Lc + 920); s0 = fmaf(x36, l[0], s0); s1 = fmaf(x37, l[1], s1); s2 = fmaf(x38, l[2], s2); s3 = fmaf(x39, l[3], s3); } { const f32x4 l = *(const LAS f32x4*)(Lc + 924); s0 = fmaf(x40, l[0], s0); s1 = fmaf(x41, l[1], s1); s2 = fmaf(x42, l[2], s2); s3 = fmaf(x43, l[3], s3); } { const f32x4 l = *(const LAS f32x4*)(Lc + 928); s0 = fmaf(x44, l[0], s0); s1 = fmaf(x45, l[1], s1); s2 = fmaf(x46, l[2], s2); s3 = fmaf(x47, l[3], s3); } { const f32x4 l = *(const LAS f32x4*)(Lc + 932); s0 = fmaf(x48, l[0], s0); s1 = fmaf(x49, l[1], s1); s2 = fmaf(x50, l[2], s2); s3 = fmaf(x51, l[3], s3); } { const f32x4 l = *(const LAS f32x4*)(Lc + 936); s0 = fmaf(x52, l[0], s0); s1 = fmaf(x53, l[1], s1); s2 = fmaf(x54, l[2], s2); s3 = fmaf(x55, l[3], s3); } { const f32x4 l = *(const LAS f32x4*)(Lc + 940); s0 = fmaf(x56, l[0], s0); s1 = fmaf(x57, l[1], s1); s2 = fmaf(x58, l[2], s2); s3 = fmaf(x59, l[3], s3); } { const f32x4 l = *(const LAS f32x4*)(Lc + 944); s0 = fmaf(x60, l[0], s0); s1 = fmaf(x61, l[1], s1); s2 = fmaf(x62, l[2], s2); s3 = fmaf(x63, l[3], s3); } x13 = (lane == 13) ? 1.0f : -((s0 + s1) + (s2 + s3)); asm volatile("" : "+v"(x13) : : "memory"); }
    { float s0 = 0.f, s1 = 0.f, s2 = 0.f, s3 = 0.f; { const f32x4 l = *(const LAS f32x4*)(Lc + 828); s1 = fmaf(x13, l[1], s1); s2 = fmaf(x14, l[2], s2); s3 = fmaf(x15, l[3], s3); } { const f32x4 l = *(const LAS f32x4*)(Lc + 832); s0 = fmaf(x16, l[0], s0); s1 = fmaf(x17, l[1], s1); s2 = fmaf(x18, l[2], s2); s3 = fmaf(x19, l[3], s3); } { const f32x4 l = *(const LAS f32x4*)(Lc + 836); s0 = fmaf(x20, l[0], s0); s1 = fmaf(x21, l[1], s1); s2 = fmaf(x22, l[2], s2); s3 = fmaf(x23, l[3], s3); } { const f32x4 l = *(const LAS f32x4*)(Lc + 840); s0 = fmaf(x24, l[0], s0); s1 = fmaf(x25, l[1], s1); s2 = fmaf(x26, l[2], s2); s3 = fmaf(x27, l[3], s3); } { const f32x4 l = *(const LAS f32x4*)(Lc + 844); s0 = fmaf(x28, l[0], s0); s1 = fmaf(x29, l[1], s1); s2 = fmaf(x30, l[2], s2); s3 = fmaf(x31, l[3], s3); } { const f32x4 l = *(const LAS f32x4*)(Lc + 848); s0 = fmaf(x32, l[0], s0); s1 = fmaf(x33, l[1], s1); s2 = fmaf(x34, l[2], s2); s3 = fmaf(x35, l[3], s3); } { const f32x4 l = *(const LAS f32x4*)(Lc + 852); s0 = fmaf(x36, l[0], s0); s1 = fmaf(x37, l[1], s1); s2 = fmaf(x38, l[2], s2); s3 = fmaf(x39, l[3], s3); } { const f32x4 l = *(const LAS f32x4*)(Lc + 856); s0 = fmaf(x40, l[0], s0); s1 = fmaf(x41, l[1], s1); s2 = fmaf(x42, l[2], s2); s3 = fmaf(x43, l[3], s3); } { const f32x4 l = *(const LAS f32x4*)(Lc + 860); s0 = fmaf(x44, l[0], s0); s1 = fmaf(x45, l[1], s1); s2 = fmaf(x46, l[2], s2); s3 = fmaf(x47, l[3], s3); } { const f32x4 l = *(const LAS f32x4*)(Lc + 864); s0 = fmaf(x48, l[0], s0); s1 = fmaf(x49, l[1], s1); s2 = fmaf(x50, l[2], s2); s3 = fmaf(x51, l[3], s3); } { const f32x4 l = *(const LAS f32x4*)(Lc + 868); s0 = fmaf(x52, l[0], s0); s1 = fmaf(x53, l[1], s1); s2 = fmaf(x54, l[2], s2); s3 = fmaf(x55, l[3], s3); } { const f32x4 l = *(const LAS f32x4*)(Lc + 872); s0 = fmaf(x56, l[0], s0); s1 = fmaf(x57, l[1], s1); s2 = fmaf(x58, l[2], s2); s3 = fmaf(x59, l[3], s3); } { const f32x4 l = *(const LAS f32x4*)(Lc + 876); s0 = fmaf(x60, l[0], s0); s1 = fmaf(x61, l[1], s1); s2 = fmaf(x62, l[2], s2); s3 = fmaf(x63, l[3], s3); } x12 = (lane == 12) ? 1.0f : -((s0 + s1) + (s2 + s3)); asm volatile("" : "+v"(x12) : : "memory"); }
    { float s0 = 0.f, s1 = 0.f, s2 = 0.f, s3 = 0.f; { const f32x4 l = *(const LAS f32x4*)(Lc + 760); s0 = fmaf(x12, l[0], s0); s1 = fmaf(x13, l[1], s1); s2 = fmaf(x14, l[2], s2); s3 = fmaf(x15, l[3], s3); } { const f32x4 l = *(const LAS f32x4*)(Lc + 764); s0 = fmaf(x16, l[0], s0); s1 = fmaf(x17, l[1], s1); s2 = fmaf(x18, l[2], s2); s3 = fmaf(x19, l[3], s3); } { const f32x4 l = *(const LAS f32x4*)(Lc + 768); s0 = fmaf(x20, l[0], s0); s1 = fmaf(x21, l[1], s1); s2 = fmaf(x22, l[2], s2); s3 = fmaf(x23, l[3], s3); } { const f32x4 l = *(const LAS f32x4*)(Lc + 772); s0 = fmaf(x24, l[0], s0); s1 = fmaf(x25, l[1], s1); s2 = fmaf(x26, l[2], s2); s3 = fmaf(x27, l[3], s3); } { const f32x4 l = *(const LAS f32x4*)(Lc + 776); s0 = fmaf(x28, l[0], s0); s1 = fmaf(x29, l[1], s1); s2 = fmaf(x30, l[2], s2); s3 = fmaf(x31, l[3], s3); } { const f32x4 l = *(const LAS f32x4*)(Lc + 780); s0 = fmaf(x32, l[0], s0); s1 = fmaf(x33, l[1], s1); s2 = fmaf(x34, l[2], s2); s3 = fmaf(x35, l[3], s3); } { const f32x4 l = *(const LAS f32x4*)(Lc + 784); s0 = fmaf(x36, l[0], s0); s1 = fmaf(x37, l[1], s1); s2 = fmaf(x38, l[2], s2); s3 = fmaf(x39, l[3], s3); } { const f32x4 l = *(const LAS f32x4*)(Lc + 788); s0 = fmaf(x40, l[0], s0); s1 = fmaf(x41, l[1], s1); s2 = fmaf(x42, l[2], s2); s3 = fmaf(x43, l[3], s3); } { const f32x4 l = *(const LAS f32x4*)(Lc + 792); s0 = fmaf(x44, l[0], s0); s1 = fmaf(x45, l[1], s1); s2 = fmaf(x46, l[2], s2); s3 = fmaf(x47, l[3], s3); } { const f32x4 l = *(const LAS f32x4*)(Lc + 796); s0 = fmaf(x48, l[0], s0); s1 = fmaf(x49, l[1], s1); s2 = fmaf(x50, l[2], s2); s3 = fmaf(x51, l[3], s3); } { const f32x4 l = *(const LAS f32x4*)(Lc + 800); s0 = fmaf(x52, l[0], s0); s1 = fmaf(x53, l[1], s1); s2 = fmaf(x54, l[2], s2); s3 = fmaf(x55, l[3], s3); } { const f32x4 l = *(const LAS f32x4*)(Lc + 804); s0 = fmaf(x56, l[0], s0); s1 = fmaf(x57, l[1], s1); s2 = fmaf(x58, l[2], s2); s3 = fmaf(x59, l[3], s3); } { const f32x4 l = *(const LAS f32x4*)(Lc + 808); s0 = fmaf(x60, l[0], s0); s1 = fmaf(x61, l[1], s1); s2 = fmaf(x62, l[2], s2); s3 = fmaf(x63, l[3], s3); } x11 = (lane == 11) ? 1.0f : -((s0 + s1) + (s2 + s3)); asm volatile("" : "+v"(x11) : : "memory"); }
    { float s0 = 0.f, s1 = 0.f, s2 = 0.f, s3 = 0.f; { const f32x4 l = *(const LAS f32x4*)(Lc + 688); s3 = fmaf(x11, l[3], s3); } { const f32x4 l = *(const LAS f32x4*)(Lc + 692); s0 = fmaf(x12, l[0], s0); s1 = fmaf(x13, l[1], s1); s2 = fmaf(x14, l[2], s2); s3 = fmaf(x15, l[3], s3); } { const f32x4 l = *(const LAS f32x4*)(Lc + 696); s0 = fmaf(x16, l[0], s0); s1 = fmaf(x17, l[1], s1); s2 = fmaf(x18, l[2], s2); s3 = fmaf(x19, l[3], s3); } { const f32x4 l = *(const LAS f32x4*)(Lc + 700); s0 = fmaf(x20, l[0], s0); s1 = fmaf(x21, l[1], s1); s2 = fmaf(x22, l[2], s2); s3 = fmaf(x23, l[3], s3); } { const f32x4 l = *(const LAS f32x4*)(Lc + 704); s0 = fmaf(x24, l[0], s0); s1 = fmaf(x25, l[1], s1); s2 = fmaf(x26, l[2], s2); s3 = fmaf(x27, l[3], s3); } { const f32x4 l = *(const LAS f32x4*)(Lc + 708); s0 = fmaf(x28, l[0], s0); s1 = fmaf(x29, l[1], s1); s2 = fmaf(x30, l[2], s2); s3 = fmaf(x31, l[3], s3); } { const f32x4 l = *(const LAS f32x4*)(Lc + 712); s0 = fmaf(x32, l[0], s0); s1 = fmaf(x33, l[1], s1); s2 = fmaf(x34, l[2], s2); s3 = fmaf(x35, l[3], s3); } { const f32x4 l = *(const LAS f32x4*)(Lc + 716); s0 = fmaf(x36, l[0], s0); s1 = fmaf(x37, l[1], s1); s2 = fmaf(x38, l[2], s2); s3 = fmaf(x39, l[3], s3); } { const f32x4 l = *(const LAS f32x4*)(Lc + 720); s0 = fmaf(x40, l[0], s0); s1 = fmaf(x41, l[1], s1); s2 = fmaf(x42, l[2], s2); s3 = fmaf(x43, l[3], s3); } { const f32x4 l = *(const LAS f32x4*)(Lc + 724); s0 = fmaf(x44, l[0], s0); s1 = fmaf(x45, l[1], s1); s2 = fmaf(x46, l[2], s2); s3 = fmaf(x47, l[3], s3); } { const f32x4 l = *(const LAS f32x4*)(Lc + 728); s0 = fmaf(x48, l[0], s0); s1 = fmaf(x49, l[1], s1); s2 = fmaf(x50, l[2], s2); s3 = fmaf(x51, l[3], s3); } { const f32x4 l = *(const LAS f32x4*)(Lc + 732); s0 = fmaf(x52, l[0], s0); s1 = fmaf(x53, l[1], s1); s2 = fmaf(x54, l[2], s2); s3 = fmaf(x55, l[3], s3); } { const f32x4 l = *(const LAS f32x4*)(Lc + 736); s0 = fmaf(x56, l[0], s0); s1 = fmaf(x57, l[1], s1); s2 = fmaf(x58, l[2], s2); s3 = fmaf(x59, l[3], s3); } { const f32x4 l = *(const LAS f32x4*)(Lc + 740); s0 = fmaf(x60, l[0], s0); s1 = fmaf(x61, l[1], s1); s2 = fmaf(x62, l[2], s2); s3 = fmaf(x63, l[3], s3); } x10 = (lane == 10) ? 1.0f : -((s0 + s1) + (s2 + s3)); asm volatile("" : "+v"(x10) : : "memory"); }
    { float s0 = 0.f, s1 = 0.f, s2 = 0.f, s3 = 0.f; { const f32x4 l = *(const LAS f32x4*)(Lc + 620); s2 = fmaf(x10, l[2], s2); s3 = fmaf(x11, l[3], s3); } { const f32x4 l = *(const LAS f32x4*)(Lc + 624); s0 = fmaf(x12, l[0], s0); s1 = fmaf(x13, l[1], s1); s2 = fmaf(x14, l[2], s2); s3 = fmaf(x15, l[3], s3); } { const f32x4 l = *(const LAS f32x4*)(Lc + 628); s0 = fmaf(x16, l[0], s0); s1 = fmaf(x17, l[1], s1); s2 = fmaf(x18, l[2], s2); s3 = fmaf(x19, l[3], s3); } { const f32x4 l = *(const LAS f32x4*)(Lc + 632); s0 = fmaf(x20, l[0], s0); s1 = fmaf(x21, l[1], s1); s2 = fmaf(x22, l[2], s2); s3 = fmaf(x23, l[3], s3); } { const f32x4 l = *(const LAS f32x4*)(Lc + 636); s0 = fmaf(x24, l[0], s0); s1 = fmaf(x25, l[1], s1); s2 = fmaf(x26, l[2], s2); s3 = fmaf(x27, l[3], s3); } { const f32x4 l = *(const LAS f32x4*)(Lc + 640); s0 = fmaf(x28, l[0], s0); s1 = fmaf(x29, l[1], s1); s2 = fmaf(x30, l[2], s2); s3 = fmaf(x31, l[3], s3); } { const f32x4 l = *(const LAS f32x4*)(Lc + 644); s0 = fmaf(x32, l[0], s0); s1 = fmaf(x33, l[1], s1); s2 = fmaf(x34, l[2], s2); s3 = fmaf(x35, l[3], s3); } { const f32x4 l = *(const LAS f32x4*)(Lc + 648); s0 = fmaf(x36, l[0], s0); s1 = fmaf(x37, l[1], s1); s2 = fmaf(x38, l[2], s2); s3 = fmaf(x39, l[3], s3); } { const f32x4 l = *(const LAS f32x4*)(Lc + 652); s0 = fmaf(x40, l[0], s0); s1 = fmaf(x41, l[1], s1); s2 = fmaf(x42, l[2], s2); s3 = fmaf(x43, l[3], s3); } { const f32x4 l = *(const LAS f32x4*)(Lc + 656); s0 = fmaf(x44, l[0], s0); s1 = fmaf(x45, l[1], s1); s2 = fmaf(x46, l[2], s2); s3 = fmaf(x47, l[3], s3); } { const f32x4 l = *(const LAS f32x4*)(Lc + 660); s0 = fmaf(x48, l[0], s0); s1 = fmaf(x49, l[1], s1); s2 = fmaf(x50, l[2], s2); s3 = fmaf(x51, l[3], s3); } { const f32x4 l = *(const LAS f32x4*)(Lc + 664); s0 = fmaf(x52, l[0], s0); s1 = fmaf(x53, l[1], s1); s2 = fmaf(x54, l[2], s2); s3 = fmaf(x55, l[3], s3); } { const f32x4 l = *(const LAS f32x4*)(Lc + 668); s0 = fmaf(x56, l[0], s0); s1 = fmaf(x57, l[1], s1); s2 = fmaf(x58, l[2], s2); s3 = fmaf(x59, l[3], s3); } { const f32x4 l = *(const LAS f32x4*)(Lc + 672); s0 = fmaf(x60, l[0], s0); s1 = fmaf(x61, l[1], s1); s2 = fmaf(x62, l[2], s2); s3 = fmaf(x63, l[3], s3); } x9 = (lane == 9) ? 1.0f : -((s0 + s1) + (s2 + s3)); asm volatile("" : "+v"(x9) : : "memory"); }
    { float s0 = 0.f, s1 = 0.f, s2 = 0.f, s3 = 0.f; { const f32x4 l = *(const LAS f32x4*)(Lc + 552); s1 = fmaf(x9, l[1], s1); s2 = fmaf(x10, l[2], s2); s3 = fmaf(x11, l[3], s3); } { const f32x4 l = *(const LAS f32x4*)(Lc + 556); s0 = fmaf(x12, l[0], s0); s1 = fmaf(x13, l[1], s1); s2 = fmaf(x14, l[2], s2); s3 = fmaf(x15, l[3], s3); } { const f32x4 l = *(const LAS f32x4*)(Lc + 560); s0 = fmaf(x16, l[0], s0); s1 = fmaf(x17, l[1], s1); s2 = fmaf(x18, l[2], s2); s3 = fmaf(x19, l[3], s3); } { const f32x4 l = *(const LAS f32x4*)(Lc + 564); s0 = fmaf(x20, l[0], s0); s1 = fmaf(x21, l[1], s1); s2 = fmaf(x22, l[2], s2); s3 = fmaf(x23, l[3], s3); } { const f32x4 l = *(const LAS f32x4*)(Lc + 568); s0 = fmaf(x24, l[0], s0); s1 = fmaf(x25, l[1], s1); s2 = fmaf(x26, l[2], s2); s3 = fmaf(x27, l[3], s3); } { const f32x4 l = *(const LAS f32x4*)(Lc + 572); s0 = fmaf(x28, l[0], s0); s1 = fmaf(x29, l[1], s1); s2 = fmaf(x30, l[2], s2); s3 = fmaf(x31, l[3], s3); } { const f32x4 l = *(const LAS f32x4*)(Lc + 576); s0 = fmaf(x32, l[0], s0); s1 = fmaf(x33, l[1], s1); s2 = fmaf(x34, l[2], s2); s3 = fmaf(x35, l[3], s3); } { const f32x4 l = *(const LAS f32x4*)(Lc + 580); s0 = fmaf(x36, l[0], s0); s1 = fmaf(x37, l[1], s1); s2 = fmaf(x38, l[2], s2); s3 = fmaf(x39, l[3], s3); } { const f32x4 l = *(const LAS f32x4*)(Lc + 584); s0 = fmaf(x40, l[0], s0); s1 = fmaf(x41, l[1], s1); s2 = fmaf(x42, l[2], s2); s3 = fmaf(x43, l[3], s3); } { const f32x4 l = *(const LAS f32x4*)(Lc + 588); s0 = fmaf(x44, l[0], s0); s1 = fmaf(x45, l[1], s1); s2 = fmaf(x46, l[2], s2); s3 = fmaf(x47, l[3], s3); } { const f32x4 l = *(const LAS f32x4*)(Lc + 592); s0 = fmaf(x48, l[0], s0); s1 = fmaf(x49, l[1], s1); s2 = fmaf(x50, l[2], s2); s3 = fmaf(x51, l[3], s3); } { const f32x4 l = *(const LAS f32x4*)(Lc + 596); s0 = fmaf(x52, l[0], s0); s1 = fmaf(x53, l[1], s1); s2 = fmaf(x54, l[2], s2); s3 = fmaf(x55, l[3], s3); } { const f32x4 l = *(const LAS f32x4*)(Lc + 600); s0 = fmaf(x56, l[0], s0); s1 = fmaf(x57, l[1], s1); s2 = fmaf(x58, l[2], s2); s3 = fmaf(x59, l[3], s3); } { const f32x4 l = *(const LAS f32x4*)(Lc + 604); s0 = fmaf(x60, l[0], s0); s1 = fmaf(x61, l[1], s1); s2 = fmaf(x62, l[2], s2); s3 = fmaf(x63, l[3], s3); } x8 = (lane == 8) ? 1.0f : -((s0 + s1) + (s2 + s3)); asm volatile("" : "+v"(x8) : : "memory"); }
    { float s0 = 0.f, s1 = 0.f, s2 = 0.f, s3 = 0.f; { const f32x4 l = *(const LAS f32x4*)(Lc + 484); s0 = fmaf(x8, l[0], s0); s1 = fmaf(x9, l[1], s1); s2 = fmaf(x10, l[2], s2); s3 = fmaf(x11, l[3], s3); } { const f32x4 l = *(const LAS f32x4*)(Lc + 488); s0 = fmaf(x12, l[0], s0); s1 = fmaf(x13, l[1], s1); s2 = fmaf(x14, l[2], s2); s3 = fmaf(x15, l[3], s3); } { const f32x4 l = *(const LAS f32x4*)(Lc + 492); s0 = fmaf(x16, l[0], s0); s1 = fmaf(x17, l[1], s1); s2 = fmaf(x18, l[2], s2); s3 = fmaf(x19, l[3], s3); } { const f32x4 l = *(const LAS f32x4*)(Lc + 496); s0 = fmaf(x20, l[0], s0); s1 = fmaf(x21, l[1], s1); s2 = fmaf(x22, l[2], s2); s3 = fmaf(x23, l[3], s3); } { const f32x4 l = *(const LAS f32x4*)(Lc + 500); s0 = fmaf(x24, l[0], s0); s1 = fmaf(x25, l[1], s1); s2 = fmaf(x26, l[2], s2); s3 = fmaf(x27, l[3], s3); } { const f32x4 l = *(const LAS f32x4*)(Lc + 504); s0 = fmaf(x28, l[0], s0); s1 = fmaf(x29, l[1], s1); s2 = fmaf(x30, l[2], s2); s3 = fmaf(x31, l[3], s3); } { const f32x4 l = *(const LAS f32x4*)(Lc + 508); s0 = fmaf(x32, l[0], s0); s1 = fmaf(x33, l[1], s1); s2 = fmaf(x34, l[2], s2); s3 = fmaf(x35, l[3], s3); } { const f32x4 l = *(const LAS f32x4*)(Lc + 512); s0 = fmaf(x36, l[0], s0); s1 = fmaf(x37, l[1], s1); s2 = fmaf(x38, l[2], s2); s3 = fmaf(x39, l[3], s3); } { const f32x4 l = *(const LAS f32x4*)(Lc + 516); s0 = fmaf(x40, l[0], s0); s1 = fmaf(x41, l[1], s1); s2 = fmaf(x42, l[2], s2); s3 = fmaf(x43, l[3], s3); } { const f32x4 l = *(const LAS f32x4*)(Lc + 520); s0 = fmaf(x44, l[0], s0); s1 = fmaf(x45, l[1], s1); s2 = fmaf(x46, l[2], s2); s3 = fmaf(x47, l[3], s3); } { const f32x4 l = *(const LAS f32x4*)(Lc + 524); s0 = fmaf(x48, l[0], s0); s1 = fmaf(x49, l[1], s1); s2 = fmaf(x50, l[2], s2); s3 = fmaf(x51, l[3], s3); } { const f32x4 l = *(const LAS f32x4*)(Lc + 528); s0 = fmaf(x52, l[0], s0); s1 = fmaf(x53, l[1], s1); s2 = fmaf(x54, l[2], s2); s3 = fmaf(x55, l[3], s3); } { const f32x4 l = *(const LAS f32x4*)(Lc + 532); s0 = fmaf(x56, l[0], s0); s1 = fmaf(x57, l[1], s1); s2 = fmaf(x58, l[2], s2); s3 = fmaf(x59, l[3], s3); } { const f32x4 l = *(const LAS f32x4*)(Lc + 536); s0 = fmaf(x60, l[0], s0); s1 = fmaf(x61, l[1], s1); s2 = fmaf(x62, l[2], s2); s3 = fmaf(x63, l[3], s3); } x7 = (lane == 7) ? 1.0f : -((s0 + s1) + (s2 + s3)); asm volatile("" : "+v"(x7) : : "memory"); }
    { float s0 = 0.f, s1 = 0.f, s2 = 0.f, s3 = 0.f; { const f32x4 l = *(const LAS f32x4*)(Lc + 412); s3 = fmaf(x7, l[3], s3); } { const f32x4 l = *(const LAS f32x4*)(Lc + 416); s0 = fmaf(x8, l[0], s0); s1 = fmaf(x9, l[1], s1); s2 = fmaf(x10, l[2], s2); s3 = fmaf(x11, l[3], s3); } { const f32x4 l = *(const LAS f32x4*)(Lc + 420); s0 = fmaf(x12, l[0], s0); s1 = fmaf(x13, l[1], s1); s2 = fmaf(x14, l[2], s2); s3 = fmaf(x15, l[3], s3); } { const f32x4 l = *(const LAS f32x4*)(Lc + 424); s0 = fmaf(x16, l[0], s0); s1 = fmaf(x17, l[1], s1); s2 = fmaf(x18, l[2], s2); s3 = fmaf(x19, l[3], s3); } { const f32x4 l = *(const LAS f32x4*)(Lc + 428); s0 = fmaf(x20, l[0], s0); s1 = fmaf(x21, l[1], s1); s2 = fmaf(x22, l[2], s2); s3 = fmaf(x23, l[3], s3); } { const f32x4 l = *(const LAS f32x4*)(Lc + 432); s0 = fmaf(x24, l[0], s0); s1 = fmaf(x25, l[1], s1); s2 = fmaf(x26, l[2], s2); s3 = fmaf(x27, l[3], s3); } { const f32x4 l = *(const LAS f32x4*)(Lc + 436); s0 = fmaf(x28, l[0], s0); s1 = fmaf(x29, l[1], s1); s2 = fmaf(x30, l[2], s2); s3 = fmaf(x31, l[3], s3); } { const f32x4 l = *(const LAS f32x4*)(Lc + 440); s0 = fmaf(x32, l[0], s0); s1 = fmaf(x33, l[1], s1); s2 = fmaf(x34, l[2], s2); s3 = fmaf(x35, l[3], s3); } { const f32x4 l = *(const LAS f32x4*)(Lc + 444); s0 = fmaf(x36, l[0], s0); s1 = fmaf(x37, l[1], s1); s2 = fmaf(x38, l[2], s2); s3 = fmaf(x39, l[3], s3); } { const f32x4 l = *(const LAS f32x4*)(Lc + 448); s0 = fmaf(x40, l[0], s0); s1 = fmaf(x41, l[1], s1); s2 = fmaf(x42, l[2], s2); s3 = fmaf(x43, l[3], s3); } { const f32x4 l = *(const LAS f32x4*)(Lc + 452); s0 = fmaf(x44, l[0], s0); s1 = fmaf(x45, l[1], s1); s2 = fmaf(x46, l[2], s2); s3 = fmaf(x47, l[3], s3); } { const f32x4 l = *(const LAS f32x4*)(Lc + 456); s0 = fmaf(x48, l[0], s0); s1 = fmaf(x49, l[1], s1); s2 = fmaf(x50, l[2], s2); s3 = fmaf(x51, l[3], s3); } { const f32x4 l = *(const LAS f32x4*)(Lc + 460); s0 = fmaf(x52, l[0], s0); s1 = fmaf(x53, l[1], s1); s2 = fmaf(x54, l[2], s2); s3 = fmaf(x55, l[3], s3); } { const f32x4 l = *(const LAS f32x4*)(Lc + 464); s0 = fmaf(x56, l[0], s0); s1 = fmaf(x57, l[1], s1); s2 = fmaf(x58, l[2], s2); s3 = fmaf(x59, l[3], s3); } { const f32x4 l = *(const LAS f32x4*)(Lc + 468); s0 = fmaf(x60, l[0], s0); s1 = fmaf(x61, l[1], s1); s2 = fmaf(x62, l[2], s2); s3 = fmaf(x63, l[3], s3); } x6 = (lane == 6) ? 1.0f : -((s0 + s1) + (s2 + s3)); asm volatile("" : "+v"(x6) : : "memory"); }
    { float s0 = 0.f, s1 = 0.f, s2 = 0.f, s3 = 0.f; { const f32x4 l = *(const LAS f32x4*)(Lc + 344); s2 = fmaf(x6, l[2], s2); s3 = fmaf(x7, l[3], s3); } { const f32x4 l = *(const LAS f32x4*)(Lc + 348); s0 = fmaf(x8, l[0], s0); s1 = fmaf(x9, l[1], s1); s2 = fmaf(x10, l[2], s2); s3 = fmaf(x11, l[3], s3); } { const f32x4 l = *(const LAS f32x4*)(Lc + 352); s0 = fmaf(x12, l[0], s0); s1 = fmaf(x13, l[1], s1); s2 = fmaf(x14, l[2], s2); s3 = fmaf(x15, l[3], s3); } { const f32x4 l = *(const LAS f32x4*)(Lc + 356); s0 = fmaf(x16, l[0], s0); s1 = fmaf(x17, l[1], s1); s2 = fmaf(x18, l[2], s2); s3 = fmaf(x19, l[3], s3); } { const f32x4 l = *(const LAS f32x4*)(Lc + 360); s0 = fmaf(x20, l[0], s0); s1 = fmaf(x21, l[1], s1); s2 = fmaf(x22, l[2], s2); s3 = fmaf(x23, l[3], s3); } { const f32x4 l = *(const LAS f32x4*)(Lc + 364); s0 = fmaf(x24, l[0], s0); s1 = fmaf(x25, l[1], s1); s2 = fmaf(x26, l[2], s2); s3 = fmaf(x27, l[3], s3); } { const f32x4 l = *(const LAS f32x4*)(Lc + 368); s0 = fmaf(x28, l[0], s0); s1 = fmaf(x29, l[1], s1); s2 = fmaf(x30, l[2], s2); s3 = fmaf(x31, l[3], s3); } { const f32x4 l = *(const LAS f32x4*)(Lc + 372); s0 = fmaf(x32, l[0], s0); s1 = fmaf(x33, l[1], s1); s2 = fmaf(x34, l[2], s2); s3 = fmaf(x35, l[3], s3); } { const f32x4 l = *(const LAS f32x4*)(Lc + 376); s0 = fmaf(x36, l[0], s0); s1 = fmaf(x37, l[1], s1); s2 = fmaf(x38, l[2], s2); s3 = fmaf(x39, l[3], s3); } { const f32x4 l = *(const LAS f32x4*)(Lc + 380); s0 = fmaf(x40, l[0], s0); s1 = fmaf(x41, l[1], s1); s2 = fmaf(x42, l[2], s2); s3 = fmaf(x43, l[3], s3); } { const f32x4 l = *(const LAS f32x4*)(Lc + 384); s0 = fmaf(x44, l[0], s0); s1 = fmaf(x45, l[1], s1); s2 = fmaf(x46, l[2], s2); s3 = fmaf(x47, l[3], s3); } { const f32x4 l = *(const LAS f32x4*)(Lc + 388); s0 = fmaf(x48, l[0], s0); s1 = fmaf(x49, l[1], s1); s2 = fmaf(x50, l[2], s2); s3 = fmaf(x51, l[3], s3); } { const f32x4 l = *(const LAS f32x4*)(Lc + 392); s0 = fmaf(x52, l[0], s0); s1 = fmaf(x53, l[1], s1); s2 = fmaf(x54, l[2], s2); s3 = fmaf(x55, l[3], s3); } { const f32x4 l = *(const LAS f32x4*)(Lc + 396); s0 = fmaf(x56, l[0], s0); s1 = fmaf(x57, l[1], s1); s2 = fmaf(x58, l[2], s2); s3 = fmaf(x59, l[3], s3); } { const f32x4 l = *(const LAS f32x4*)(Lc + 400); s0 = fmaf(x60, l[0], s0); s1 = fmaf(x61, l[1], s1); s2 = fmaf(x62, l[2], s2); s3 = fmaf(x63, l[3], s3); } x5 = (lane == 5) ? 1.0f : -((s0 + s1) + (s2 + s3)); asm volatile("" : "+v"(x5) : : "memory"); }
    { float s0 = 0.f, s1 = 0.f, s2 = 0.f, s3 = 0.f; { const f32x4 l = *(const LAS f32x4*)(Lc + 276); s1 = fmaf(x5, l[1], s1); s2 = fmaf(x6, l[2], s2); s3 = fmaf(x7, l[3], s3); } { const f32x4 l = *(const LAS f32x4*)(Lc + 280); s0 = fmaf(x8, l[0], s0); s1 = fmaf(x9, l[1], s1); s2 = fmaf(x10, l[2], s2); s3 = fmaf(x11, l[3], s3); } { const f32x4 l = *(const LAS f32x4*)(Lc + 284); s0 = fmaf(x12, l[0], s0); s1 = fmaf(x13, l[1], s1); s2 = fmaf(x14, l[2], s2); s3 = fmaf(x15, l[3], s3); } { const f32x4 l = *(const LAS f32x4*)(Lc + 288); s0 = fmaf(x16, l[0], s0); s1 = fmaf(x17, l[1], s1); s2 = fmaf(x18, l[2], s2); s3 = fmaf(x19, l[3], s3); } { const f32x4 l = *(const LAS f32x4*)(Lc + 292); s0 = fmaf(x20, l[0], s0); s1 = fmaf(x21, l[1], s1); s2 = fmaf(x22, l[2], s2); s3 = fmaf(x23, l[3], s3); } { const f32x4 l = *(const LAS f32x4*)(Lc + 296); s0 = fmaf(x24, l[0], s0); s1 = fmaf(x25, l[1], s1); s2 = fmaf(x26, l[2], s2); s3 = fmaf(x27, l[3], s3); } { const f32x4 l = *(const LAS f32x4*)(Lc + 300); s0 = fmaf(x28, l[0], s0); s1 = fmaf(x29, l[1], s1); s2 = fmaf(x30, l[2], s2); s3 = fmaf(x31, l[3], s3); } { const f32x4 l = *(const LAS f32x4*)(Lc + 304); s0 = fmaf(x32, l[0], s0); s1 = fmaf(x33, l[1], s1); s2 = fmaf(x34, l[2], s2); s3 = fmaf(x35, l[3], s3); } { const f32x4 l = *(const LAS f32x4*)(Lc + 308); s0 = fmaf(x36, l[0], s0); s1 = fmaf(x37, l[1], s1); s2 = fmaf(x38, l[2], s2); s3 = fmaf(x39, l[3], s3); } { const f32x4 l = *(const LAS f32x4*)(Lc + 312); s0 = fmaf(x40, l[0], s0); s1 = fmaf(x41, l[1], s1); s2 = fmaf(x42, l[2], s2); s3 = fmaf(x43, l[3], s3); } { const f32x4 l = *(const LAS f32x4*)(Lc + 316); s0 = fmaf(x44, l[0], s0); s1 = fmaf(x45, l[1], s1); s2 = fmaf(x46, l[2], s2); s3 = fmaf(x47, l[3], s3); } { const f32x4 l = *(const LAS f32x4*)(Lc + 320); s0 = fmaf(x48, l[0], s0); s1 = fmaf(x49, l[1], s1); s2 = fmaf(x50, l[2], s2); s3 = fmaf(x51, l[3], s3); } { const f32x4 l = *(const LAS f32x4*)(Lc + 324); s0 = fmaf(x52, l[0], s0); s1 = fmaf(x53, l[1], s1); s2 = fmaf(x54, l[2], s2); s3 = fmaf(x55, l[3], s3); } { const f32x4 l = *(const LAS f32x4*)(Lc + 328); s0 = fmaf(x56, l[0], s0); s1 = fmaf(x57, l[1], s1); s2 = fmaf(x58, l[2], s2); s3 = fmaf(x59, l[3], s3); } { const f32x4 l = *(const LAS f32x4*)(Lc + 332); s0 = fmaf(x60, l[0], s0); s1 = fmaf(x61, l[1], s1); s2 = fmaf(x62, l[2], s2); s3 = fmaf(x63, l[3], s3); } x4 = (lane == 4) ? 1.0f : -((s0 + s1) + (s2 + s3)); asm volatile("" : "+v"(x4) : : "memory"); }
    { float s0 = 0.f, s1 = 0.f, s2 = 0.f, s3 = 0.f; { const f32x4 l = *(const LAS f32x4*)(Lc + 208); s0 = fmaf(x4, l[0], s0); s1 = fmaf(x5, l[1], s1); s2 = fmaf(x6, l[2], s2); s3 = fmaf(x7, l[3], s3); } { const f32x4 l = *(const LAS f32x4*)(Lc + 212); s0 = fmaf(x8, l[0], s0); s1 = fmaf(x9, l[1], s1); s2 = fmaf(x10, l[2], s2); s3 = fmaf(x11, l[3], s3); } { const f32x4 l = *(const LAS f32x4*)(Lc + 216); s0 = fmaf(x12, l[0], s0); s1 = fmaf(x13, l[1], s1); s2 = fmaf(x14, l[2], s2); s3 = fmaf(x15, l[3], s3); } { const f32x4 l = *(const LAS f32x4*)(Lc + 220); s0 = fmaf(x16, l[0], s0); s1 = fmaf(x17, l[1], s1); s2 = fmaf(x18, l[2], s2); s3 = fmaf(x19, l[3], s3); } { const f32x4 l = *(const LAS f32x4*)(Lc + 224); s0 = fmaf(x20, l[0], s0); s1 = fmaf(x21, l[1], s1); s2 = fmaf(x22, l[2], s2); s3 = fmaf(x23, l[3], s3); } { const f32x4 l = *(const LAS f32x4*)(Lc + 228); s0 = fmaf(x24, l[0], s0); s1 = fmaf(x25, l[1], s1); s2 = fmaf(x26, l[2], s2); s3 = fmaf(x27, l[3], s3); } { const f32x4 l = *(const LAS f32x4*)(Lc + 232); s0 = fmaf(x28, l[0], s0); s1 = fmaf(x29, l[1], s1); s2 = fmaf(x30, l[2], s2); s3 = fmaf(x31, l[3], s3); } { const f32x4 l = *(const LAS f32x4*)(Lc + 236); s0 = fmaf(x32, l[0], s0); s1 = fmaf(x33, l[1], s1); s2 = fmaf(x34, l[2], s2); s3 = fmaf(x35, l[3], s3); } { const f32x4 l = *(const LAS f32x4*)(Lc + 240); s0 = fmaf(x36, l[0], s0); s1 = fmaf(x37, l[1], s1); s2 = fmaf(x38, l[2], s2); s3 = fmaf(x39, l[3], s3); } { const f32x4 l = *(const LAS f32x4*)(Lc + 244); s0 = fmaf(x40, l[0], s0); s1 = fmaf(x41, l[1], s1); s2 = fmaf(x42, l[2], s2); s3 = fmaf(x43, l[3], s3); } { const f32x4 l = *(const LAS f32x4*)(Lc + 248); s0 = fmaf(x44, l[0], s0); s1 = fmaf(x45, l[1], s1); s2 = fmaf(x46, l[2], s2); s3 = fmaf(x47, l[3], s3); } { const f32x4 l = *(const LAS f32x4*)(Lc + 252); s0 = fmaf(x48, l[0], s0); s1 = fmaf(x49, l[1], s1); s2 = fmaf(x50, l[2], s2); s3 = fmaf(x51, l[3], s3); } { const f32x4 l = *(const LAS f32x4*)(Lc + 256); s0 = fmaf(x52, l[0], s0); s1 = fmaf(x53, l[1], s1); s2 = fmaf(x54, l[2], s2); s3 = fmaf(x55, l[3], s3); } { const f32x4 l = *(const LAS f32x4*)(Lc + 260); s0 = fmaf(x56, l[0], s0); s1 = fmaf(x57, l[1], s1); s2 = fmaf(x58, l[2], s2); s3 = fmaf(x59, l[3], s3); } { const f32x4 l = *(const LAS f32x4*)(Lc + 264); s0 = fmaf(x60, l[0], s0); s1 = fmaf(x61, l[1], s1); s2 = fmaf(x62, l[2], s2); s3 = fmaf(x63, l[3], s3); } x3 = (lane == 3) ? 1.0f : -((s0 + s1) + (s2 + s3)); asm volatile("" : "+v"(x3) : : "memory"); }
    { float s0 = 0.f, s1 = 0.f, s2 = 0.f, s3 = 0.f; { const f32x4 l = *(const LAS f32x4*)(Lc + 136); s3 = fmaf(x3, l[3], s3); } { const f32x4 l = *(const LAS f32x4*)(Lc + 140); s0 = fmaf(x4, l[0], s0); s1 = fmaf(x5, l[1], s1); s2 = fmaf(x6, l[2], s2); s3 = fmaf(x7, l[3], s3); } { const f32x4 l = *(const LAS f32x4*)(Lc + 144); s0 = fmaf(x8, l[0], s0); s1 = fmaf(x9, l[1], s1); s2 = fmaf(x10, l[2], s2); s3 = fmaf(x11, l[3], s3); } { const f32x4 l = *(const LAS f32x4*)(Lc + 148); s0 = fmaf(x12, l[0], s0); s1 = fmaf(x13, l[1], s1); s2 = fmaf(x14, l[2], s2); s3 = fmaf(x15, l[3], s3); } { const f32x4 l = *(const LAS f32x4*)(Lc + 152); s0 = fmaf(x16, l[0], s0); s1 = fmaf(x17, l[1], s1); s2 = fmaf(x18, l[2], s2); s3 = fmaf(x19, l[3], s3); } { const f32x4 l = *(const LAS f32x4*)(Lc + 156); s0 = fmaf(x20, l[0], s0); s1 = fmaf(x21, l[1], s1); s2 = fmaf(x22, l[2], s2); s3 = fmaf(x23, l[3], s3); } { const f32x4 l = *(const LAS f32x4*)(Lc + 160); s0 = fmaf(x24, l[0], s0); s1 = fmaf(x25, l[1], s1); s2 = fmaf(x26, l[2], s2); s3 = fmaf(x27, l[3], s3); } { const f32x4 l = *(const LAS f32x4*)(Lc + 164); s0 = fmaf(x28, l[0], s0); s1 = fmaf(x29, l[1], s1); s2 = fmaf(x30, l[2], s2); s3 = fmaf(x31, l[3], s3); } { const f32x4 l = *(const LAS f32x4*)(Lc + 168); s0 = fmaf(x32, l[0], s0); s1 = fmaf(x33, l[1], s1); s2 = fmaf(x34, l[2], s2); s3 = fmaf(x35, l[3], s3); } { const f32x4 l = *(const LAS f32x4*)(Lc + 172); s0 = fmaf(x36, l[0], s0); s1 = fmaf(x37, l[1], s1); s2 = fmaf(x38, l[2], s2); s3 = fmaf(x39, l[3], s3); } { const f32x4 l = *(const LAS f32x4*)(Lc + 176); s0 = fmaf(x40, l[0], s0); s1 = fmaf(x41, l[1], s1); s2 = fmaf(x42, l[2], s2); s3 = fmaf(x43, l[3], s3); } { const f32x4 l = *(const LAS f32x4*)(Lc + 180); s0 = fmaf(x44, l[0], s0); s1 = fmaf(x45, l[1], s1); s2 = fmaf(x46, l[2], s2); s3 = fmaf(x47, l[3], s3); } { const f32x4 l = *(const LAS f32x4*)(Lc + 184); s0 = fmaf(x48, l[0], s0); s1 = fmaf(x49, l[1], s1); s2 = fmaf(x50, l[2], s2); s3 = fmaf(x51, l[3], s3); } { const f32x4 l = *(const LAS f32x4*)(Lc + 188); s0 = fmaf(x52, l[0], s0); s1 = fmaf(x53, l[1], s1); s2 = fmaf(x54, l[2], s2); s3 = fmaf(x55, l[3], s3); } { const f32x4 l = *(const LAS f32x4*)(Lc + 192); s0 = fmaf(x56, l[0], s0); s1 = fmaf(x57, l[1], s1); s2 = fmaf(x58, l[2], s2); s3 = fmaf(x59, l[3], s3); } { const f32x4 l = *(const LAS f32x4*)(Lc + 196); s0 = fmaf(x60, l[0], s0); s1 = fmaf(x61, l[1], s1); s2 = fmaf(x62, l[2], s2); s3 = fmaf(x63, l[3], s3); } x2 = (lane == 2) ? 1.0f : -((s0 + s1) + (s2 + s3)); asm volatile("" : "+v"(x2) : : "memory"); }
    { float s0 = 0.f, s1 = 0.f, s2 = 0.f, s3 = 0.f; { const f32x4 l = *(const LAS f32x4*)(Lc + 68); s2 = fmaf(x2, l[2], s2); s3 = fmaf(x3, l[3], s3); } { const f32x4 l = *(const LAS f32x4*)(Lc + 72); s0 = fmaf(x4, l[0], s0); s1 = fmaf(x5, l[1], s1); s2 = fmaf(x6, l[2], s2); s3 = fmaf(x7, l[3], s3); } { const f32x4 l = *(const LAS f32x4*)(Lc + 76); s0 = fmaf(x8, l[0], s0); s1 = fmaf(x9, l[1], s1); s2 = fmaf(x10, l[2], s2); s3 = fmaf(x11, l[3], s3); } { const f32x4 l = *(const LAS f32x4*)(Lc + 80); s0 = fmaf(x12, l[0], s0); s1 = fmaf(x13, l[1], s1); s2 = fmaf(x14, l[2], s2); s3 = fmaf(x15, l[3], s3); } { const f32x4 l = *(const LAS f32x4*)(Lc + 84); s0 = fmaf(x16, l[0], s0); s1 = fmaf(x17, l[1], s1); s2 = fmaf(x18, l[2], s2); s3 = fmaf(x19, l[3], s3); } { const f32x4 l = *(const LAS f32x4*)(Lc + 88); s0 = fmaf(x20, l[0], s0); s1 = fmaf(x21, l[1], s1); s2 = fmaf(x22, l[2], s2); s3 = fmaf(x23, l[3], s3); } { const f32x4 l = *(const LAS f32x4*)(Lc + 92); s0 = fmaf(x24, l[0], s0); s1 = fmaf(x25, l[1], s1); s2 = fmaf(x26, l[2], s2); s3 = fmaf(x27, l[3], s3); } { const f32x4 l = *(const LAS f32x4*)(Lc + 96); s0 = fmaf(x28, l[0], s0); s1 = fmaf(x29, l[1], s1); s2 = fmaf(x30, l[2], s2); s3 = fmaf(x31, l[3], s3); } { const f32x4 l = *(const LAS f32x4*)(Lc + 100); s0 = fmaf(x32, l[0], s0); s1 = fmaf(x33, l[1], s1); s2 = fmaf(x34, l[2], s2); s3 = fmaf(x35, l[3], s3); } { const f32x4 l = *(const LAS f32x4*)(Lc + 104); s0 = fmaf(x36, l[0], s0); s1 = fmaf(x37, l[1], s1); s2 = fmaf(x38, l[2], s2); s3 = fmaf(x39, l[3], s3); } { const f32x4 l = *(const LAS f32x4*)(Lc + 108); s0 = fmaf(x40, l[0], s0); s1 = fmaf(x41, l[1], s1); s2 = fmaf(x42, l[2], s2); s3 = fmaf(x43, l[3], s3); } { const f32x4 l = *(const LAS f32x4*)(Lc + 112); s0 = fmaf(x44, l[0], s0); s1 = fmaf(x45, l[1], s1); s2 = fmaf(x46, l[2], s2); s3 = fmaf(x47, l[3], s3); } { const f32x4 l = *(const LAS f32x4*)(Lc + 116); s0 = fmaf(x48, l[0], s0); s1 = fmaf(x49, l[1], s1); s2 = fmaf(x50, l[2], s2); s3 = fmaf(x51, l[3], s3); } { const f32x4 l = *(const LAS f32x4*)(Lc + 120); s0 = fmaf(x52, l[0], s0); s1 = fmaf(x53, l[1], s1); s2 = fmaf(x54, l[2], s2); s3 = fmaf(x55, l[3], s3); } { const f32x4 l = *(const LAS f32x4*)(Lc + 124); s0 = fmaf(x56, l[0], s0); s1 = fmaf(x57, l[1], s1); s2 = fmaf(x58, l[2], s2); s3 = fmaf(x59, l[3], s3); } { const f32x4 l = *(const LAS f32x4*)(Lc + 128); s0 = fmaf(x60, l[0], s0); s1 = fmaf(x61, l[1], s1); s2 = fmaf(x62, l[2], s2); s3 = fmaf(x63, l[3], s3); } x1 = (lane == 1) ? 1.0f : -((s0 + s1) + (s2 + s3)); asm volatile("" : "+v"(x1) : : "memory"); }
    { float s0 = 0.f, s1 = 0.f, s2 = 0.f, s3 = 0.f; { const f32x4 l = *(const LAS f32x4*)(Lc + 0); s1 = fmaf(x1, l[1], s1); s2 = fmaf(x2, l[2], s2); s3 = fmaf(x3, l[3], s3); } { const f32x4 l = *(const LAS f32x4*)(Lc + 4); s0 = fmaf(x4, l[0], s0); s1 = fmaf(x5, l[1], s1); s2 = fmaf(x6, l[2], s2); s3 = fmaf(x7, l[3], s3); } { const f32x4 l = *(const LAS f32x4*)(Lc + 8); s0 = fmaf(x8, l[0], s0); s1 = fmaf(x9, l[1], s1); s2 = fmaf(x10, l[2], s2); s3 = fmaf(x11, l[3], s3); } { const f32x4 l = *(const LAS f32x4*)(Lc + 12); s0 = fmaf(x12, l[0], s0); s1 = fmaf(x13, l[1], s1); s2 = fmaf(x14, l[2], s2); s3 = fmaf(x15, l[3], s3); } { const f32x4 l = *(const LAS f32x4*)(Lc + 16); s0 = fmaf(x16, l[0], s0); s1 = fmaf(x17, l[1], s1); s2 = fmaf(x18, l[2], s2); s3 = fmaf(x19, l[3], s3); } { const f32x4 l = *(const LAS f32x4*)(Lc + 20); s0 = fmaf(x20, l[0], s0); s1 = fmaf(x21, l[1], s1); s2 = fmaf(x22, l[2], s2); s3 = fmaf(x23, l[3], s3); } { const f32x4 l = *(const LAS f32x4*)(Lc + 24); s0 = fmaf(x24, l[0], s0); s1 = fmaf(x25, l[1], s1); s2 = fmaf(x26, l[2], s2); s3 = fmaf(x27, l[3], s3); } { const f32x4 l = *(const LAS f32x4*)(Lc + 28); s0 = fmaf(x28, l[0], s0); s1 = fmaf(x29, l[1], s1); s2 = fmaf(x30, l[2], s2); s3 = fmaf(x31, l[3], s3); } { const f32x4 l = *(const LAS f32x4*)(Lc + 32); s0 = fmaf(x32, l[0], s0); s1 = fmaf(x33, l[1], s1); s2 = fmaf(x34, l[2], s2); s3 = fmaf(x35, l[3], s3); } { const f32x4 l = *(const LAS f32x4*)(Lc + 36); s0 = fmaf(x36, l[0], s0); s1 = fmaf(x37, l[1], s1); s2 = fmaf(x38, l[2], s2); s3 = fmaf(x39, l[3], s3); } { const f32x4 l = *(const LAS f32x4*)(Lc + 40); s0 = fmaf(x40, l[0], s0); s1 = fmaf(x41, l[1], s1); s2 = fmaf(x42, l[2], s2); s3 = fmaf(x43, l[3], s3); } { const f32x4 l = *(const LAS f32x4*)(Lc + 44); s0 = fmaf(x44, l[0], s0); s1 = fmaf(x45, l[1], s1); s2 = fmaf(x46, l[2], s2); s3 = fmaf(x47, l[3], s3); } { const f32x4 l = *(const LAS f32x4*)(Lc + 48); s0 = fmaf(x48, l[0], s0); s1 = fmaf(x49, l[1], s1); s2 = fmaf(x50, l[2], s2); s3 = fmaf(x51, l[3], s3); } { const f32x4 l = *(const LAS f32x4*)(Lc + 52); s0 = fmaf(x52, l[0], s0); s1 = fmaf(x53, l[1], s1); s2 = fmaf(x54, l[2], s2); s3 = fmaf(x55, l[3], s3); } { const f32x4 l = *(const LAS f32x4*)(Lc + 56); s0 = fmaf(x56, l[0], s0); s1 = fmaf(x57, l[1], s1); s2 = fmaf(x58, l[2], s2); s3 = fmaf(x59, l[3], s3); } { const f32x4 l = *(const LAS f32x4*)(Lc + 60); s0 = fmaf(x60, l[0], s0); s1 = fmaf(x61, l[1], s1); s2 = fmaf(x62, l[2], s2); s3 = fmaf(x63, l[3], s3); } x0 = (lane == 0) ? 1.0f : -((s0 + s1) + (s2 + s3)); asm volatile("" : "+v"(x0) : : "memory"); }
    { v4u o; o.x = cvtpk(x0, x1); o.y = cvtpk(x2, x3); o.z = cvtpk(x4, x5); o.w = cvtpk(x6, x7); *(LAS v4u*)(Xs + lane * 72 + 0) = o; }
    { v4u o; o.x = cvtpk(x8, x9); o.y = cvtpk(x10, x11); o.z = cvtpk(x12, x13); o.w = cvtpk(x14, x15); *(LAS v4u*)(Xs + lane * 72 + 8) = o; }
    { v4u o; o.x = cvtpk(x16, x17); o.y = cvtpk(x18, x19); o.z = cvtpk(x20, x21); o.w = cvtpk(x22, x23); *(LAS v4u*)(Xs + lane * 72 + 16) = o; }
    { v4u o; o.x = cvtpk(x24, x25); o.y = cvtpk(x26, x27); o.z = cvtpk(x28, x29); o.w = cvtpk(x30, x31); *(LAS v4u*)(Xs + lane * 72 + 24) = o; }
    { v4u o; o.x = cvtpk(x32, x33); o.y = cvtpk(x34, x35); o.z = cvtpk(x36, x37); o.w = cvtpk(x38, x39); *(LAS v4u*)(Xs + lane * 72 + 32) = o; }
    { v4u o; o.x = cvtpk(x40, x41); o.y = cvtpk(x42, x43); o.z = cvtpk(x44, x45); o.w = cvtpk(x46, x47); *(LAS v4u*)(Xs + lane * 72 + 40) = o; }
    { v4u o; o.x = cvtpk(x48, x49); o.y = cvtpk(x50, x51); o.z = cvtpk(x52, x53); o.w = cvtpk(x54, x55); *(LAS v4u*)(Xs + lane * 72 + 48) = o; }
    { v4u o; o.x = cvtpk(x56, x57); o.y = cvtpk(x58, x59); o.z = cvtpk(x60, x61); o.w = cvtpk(x62, x63); *(LAS v4u*)(Xs + lane * 72 + 56) = o; }
}
#ifndef G1P
#define G1P 15
#endif

#define MF16(a, b, c) __builtin_amdgcn_mfma_f32_16x16x32_bf16((a), (b), (c), 0, 0, 0)
__device__ __forceinline__ bf16x8 ld16g(const bf16* p) { return *(const GAS bf16x8*)p; }
__device__ __forceinline__ float ldbf(const bf16* p) { return __uint_as_float(((unsigned)*(const GAS unsigned short*)p) << 16); }
__device__ __forceinline__ void st8(bf16* p, float a, float b, float c, float d) { u32x2v o; o.x = cvtpk(a, b); o.y = cvtpk(c, d); *(GAS u32x2v*)p = o; }

__device__ __forceinline__ void p_ga(const Frame& F, const Args& a, int L) {
    unsigned char* ws = a.ws; asm volatile("" : "+s"(ws)); int lane_ = F.lane; asm volatile("" : "+v"(lane_)); const int j = L >> 1, lane = lane_;
    const bf16* PO = (const bf16*)(ws + WS_ARENA + AR_PO);
    bf16 *QN = (bf16*)(ws + WS_ARENA + AR_QN), *QT = (bf16*)(ws + WS_ARENA + AR_QT), *KN = (bf16*)(ws + WS_ARENA + AR_KN), *KGT = (bf16*)(ws + WS_ARENA + AR_KGT), *VBT = (bf16*)(ws + WS_ARENA + AR_VBT), *KTT = (bf16*)(ws + WS_ARENA + AR_KTT);
    float* gg = (float*)(ws + WS_GB); const float* gbeta = gg + S_ * 8; float* dn = (float*)(ws + WS_TOK + TOK_DN);
    const float* cw = (const float*)a.in[16] + (size_t)j * 4 * 3072;
    LAS float* sc = (LAS float*)(F.lds + F.wave * WAVE_LDS);
    const int dg = lane & 15, ts = lane >> 4, d0 = 8 * dg;
#pragma unroll 1
    for (int u = F.gw; u < NUNIT; u += F.NGW) {
        const int n = u >> 3, hh = u & 7, tok0 = 64 * n;
        {
            const float g = gg[(size_t)(tok0 + lane) * 8 + hh], beta = gbeta[(size_t)(tok0 + lane) * 8 + hh];
            float gc = g;
#pragma unroll
            for (int o = 1; o < 64; o <<= 1) { const float t = __shfl_up(gc, o); if (lane >= o) gc += t; }
            const float glast = __shfl(gc, 63);
            gg[(size_t)(tok0 + lane) * 8 + hh] = gc;
            if (lane == 0) dn[u] = expf(glast);
            const float eg = expf(gc);
            sc[64 + lane] = beta * eg; sc[128 + lane] = expf(glast - gc); sc[192 + lane] = beta; sc[256 + lane] = eg;
        }
#pragma unroll 1
        for (int qk = 0; qk < 2; ++qk) {
            const int coff = qk * 1024 + hh * 128 + d0;
            float w[4][8];
#pragma unroll
            for (int jj = 0; jj < 4; ++jj)
#pragma unroll
                for (int e = 0; e < 8; ++e) w[jj][e] = cw[jj * 3072 + coff + e];
#pragma unroll 2
            for (int it = 0; it < 16; ++it) {
                const int i = 4 * it + ts, tok = tok0 + i; float acc[8];
#pragma unroll
                for (int e = 0; e < 8; ++e) acc[e] = 0.f;
#pragma unroll
                for (int jj = 0; jj < 4; ++jj) { const int r = tok - 3 + jj;
                    if (r >= 0) { const v4u v = *(const GAS v4u*)(PO + (size_t)r * OIN + coff); const unsigned vv[4] = {v.x, v.y, v.z, v.w};
#pragma unroll
                        for (int q = 0; q < 4; ++q) { acc[2 * q] += w[jj][2 * q] * bflo(vv[q]); acc[2 * q + 1] += w[jj][2 * q + 1] * bfhi(vv[q]); } } }
                float ss = 0.f;
#pragma unroll
                for (int e = 0; e < 8; ++e) { acc[e] = silu(acc[e]); ss += acc[e] * acc[e]; }
                ss += __shfl_xor(ss, 1); ss += __shfl_xor(ss, 2); ss += __shfl_xor(ss, 4); ss += __shfl_xor(ss, 8);
                const float rn = __builtin_amdgcn_rsqf(ss + 1e-6f);
                if (qk == 0) {
                    const float s1 = rn * 0.08838834764831845f, s2 = s1 * sc[256 + i];
                    v4u o; o.x = cvtpk(acc[0] * s1, acc[1] * s1); o.y = cvtpk(acc[2] * s1, acc[3] * s1); o.z = cvtpk(acc[4] * s1, acc[5] * s1); o.w = cvtpk(acc[6] * s1, acc[7] * s1);
                    *(GAS v4u*)(QN + (size_t)tok * D_ + hh * 128 + d0) = o;
                    o.x = cvtpk(acc[0] * s2, acc[1] * s2); o.y = cvtpk(acc[2] * s2, acc[3] * s2); o.z = cvtpk(acc[4] * s2, acc[5] * s2); o.w = cvtpk(acc[6] * s2, acc[7] * s2);
                    *(GAS v4u*)(QT + (size_t)tok * D_ + hh * 128 + d0) = o;
                } else {
                    v4u o; o.x = cvtpk(acc[0] * rn, acc[1] * rn); o.y = cvtpk(acc[2] * rn, acc[3] * rn); o.z = cvtpk(acc[4] * rn, acc[5] * rn); o.w = cvtpk(acc[6] * rn, acc[7] * rn);
                    *(GAS v4u*)(KN + (size_t)tok * D_ + hh * 128 + d0) = o;
                    if (dg == 0) sc[i] = rn;
                }
            }
        }
#pragma unroll 1
        for (int kv = 0; kv < 2; ++kv)
#pragma unroll 1
            for (int half = 0; half < 2; ++half) {
                const int d = 64 * half + lane, c = (1 + kv) * 1024 + hh * 128 + d;
                const float w0 = cw[c], w1 = cw[3072 + c], w2 = cw[2 * 3072 + c], w3 = cw[3 * 3072 + c];
                float r0 = 0.f, r1 = 0.f, r2 = 0.f;
                if (tok0 > 0) { r0 = ldbf(PO + (size_t)(tok0 - 3) * OIN + c); r1 = ldbf(PO + (size_t)(tok0 - 2) * OIN + c); r2 = ldbf(PO + (size_t)(tok0 - 1) * OIN + c); }
                const size_t obase = ((size_t)u * 128 + d) * 64;
#pragma unroll 1
                for (int ig = 0; ig < 8; ++ig) {
                    float o1[8], o2[8];
#pragma unroll
                    for (int e = 0; e < 8; ++e) { const int i = 8 * ig + e; const float r3 = ldbf(PO + (size_t)(tok0 + i) * OIN + c);
                        const float v = silu(w0 * r0 + w1 * r1 + w2 * r2 + w3 * r3); r0 = r1; r1 = r2; r2 = r3;
                        if (kv == 0) { const float kn = v * sc[i]; o1[e] = kn * sc[64 + i]; o2[e] = kn * sc[128 + i]; } else { o1[e] = v * sc[192 + i]; o2[e] = 0.f; } }
                    v4u o; o.x = cvtpk(o1[0], o1[1]); o.y = cvtpk(o1[2], o1[3]); o.z = cvtpk(o1[4], o1[5]); o.w = cvtpk(o1[6], o1[7]);
                    if (kv == 0) { *(GAS v4u*)(KGT + obase + 8 * ig) = o;
                        o.x = cvtpk(o2[0], o2[1]); o.y = cvtpk(o2[2], o2[3]); o.z = cvtpk(o2[4], o2[5]); o.w = cvtpk(o2[6], o2[7]); *(GAS v4u*)(KTT + obase + 8 * ig) = o; }
                    else *(GAS v4u*)(VBT + obase + 8 * ig) = o;
                }
            }
    }
}

__device__ __forceinline__ void p_g1(const Frame& F, const Args& a) {
    unsigned char* ws = a.ws; asm volatile("" : "+s"(ws)); int lane_ = F.lane; asm volatile("" : "+v"(lane_)); const int lane = lane_, r16 = lane & 15, g = lane >> 4;
    const bf16 *QN = (const bf16*)(ws + WS_ARENA + AR_QN), *KN = (const bf16*)(ws + WS_ARENA + AR_KN), *KGT = (const bf16*)(ws + WS_ARENA + AR_KGT), *VBT = (const bf16*)(ws + WS_ARENA + AR_VBT), *KTT = (const bf16*)(ws + WS_ARENA + AR_KTT);
    bf16 *AI = (bf16*)(ws + WS_ARENA + AR_AI), *NEGW = (bf16*)(ws + WS_ARENA + AR_NEGW), *UT = (bf16*)(ws + WS_ARENA + AR_UT), *MP = (bf16*)(ws + WS_ARENA + AR_MP), *NT = (bf16*)(ws + WS_ARENA + AR_NT), *WT = (bf16*)(ws + WS_ARENA + AR_WT);
    const float* gg = (const float*)(ws + WS_GB); const float* gbeta = gg + S_ * 8;
    LAS float* Lc = (LAS float*)(F.lds + F.wave * WAVE_LDS);
    LAS bf16* Xs = (LAS bf16*)(F.lds + F.wave * WAVE_LDS);
    const f32x4 Z4 = {0.f, 0.f, 0.f, 0.f};
#pragma unroll 1
    for (int u = F.gw; u < NUNIT; u += F.NGW) {
        const int n = u >> 3, hh = u & 7, tok0 = 64 * n;
        const float gc = gg[(size_t)(tok0 + lane) * 8 + hh], beta = gbeta[(size_t)(tok0 + lane) * 8 + hh];
#if G1P & 1
        {
            bf16x8 kf[4][4];
#pragma unroll
            for (int t = 0; t < 4; ++t)
#pragma unroll
                for (int kk = 0; kk < 4; ++kk) kf[t][kk] = ld16g(KN + (size_t)(tok0 + 16 * t + r16) * D_ + hh * 128 + 32 * kk + 8 * g);
#pragma unroll
            for (int ti = 0; ti < 4; ++ti)
#pragma unroll
                for (int tj = 0; tj <= ti; ++tj) {
                    f32x4 Dv = Z4;
#pragma unroll
                    for (int kk = 0; kk < 4; ++kk) Dv = MF16(kf[ti][kk], kf[tj][kk], Dv);
                    const int jx = 16 * tj + r16; const float gcj = __shfl(gc, jx); f32x4 val;
#pragma unroll
                    for (int r = 0; r < 4; ++r) { const int ix = 16 * ti + 4 * g + r; const float gci = __shfl(gc, ix), bi = __shfl(beta, ix); val[r] = (ix > jx) ? bi * Dv[r] * expf(gci - gcj) : 0.f; }
                    *(LAS f32x4*)(Lc + jx * 68 + 16 * ti + 4 * g) = val;
                }
#pragma unroll
            for (int ti = 0; ti < 4; ++ti) {
                bf16x8 qf[4];
#pragma unroll
                for (int kk = 0; kk < 4; ++kk) qf[kk] = ld16g(QN + (size_t)(tok0 + 16 * ti + r16) * D_ + hh * 128 + 32 * kk + 8 * g);
                const int ix = 16 * ti + r16; const float gci = __shfl(gc, ix);
#pragma unroll
                for (int tj = 0; tj < 4; ++tj) {
                    f32x4 val = Z4;
                    if (tj <= ti) {
                        f32x4 Dv = Z4;
#pragma unroll
                        for (int kk = 0; kk < 4; ++kk) Dv = MF16(kf[tj][kk], qf[kk], Dv);
#pragma unroll
                        for (int r = 0; r < 4; ++r) { const int jx = 16 * tj + 4 * g + r; const float gcj = __shfl(gc, jx); val[r] = (ix >= jx) ? Dv[r] * expf(gci - gcj) : 0.f; }
                    }
                    st8(AI + ((size_t)u * 64 + ix) * 64 + 16 * tj + 4 * g, val[0], val[1], val[2], val[3]);
                }
            }
        }
        asm volatile("s_waitcnt lgkmcnt(0)" ::: "memory");
#endif
#if G1P & 2
        tri_solve(Lc, Xs, lane);
#endif
#if G1P & 4
        asm volatile("s_waitcnt lgkmcnt(0)" ::: "memory");
        {
            bf16x8 xf[4][2];
#pragma unroll
            for (int t = 0; t < 4; ++t)
#pragma unroll
                for (int kk = 0; kk < 2; ++kk) xf[t][kk] = *(const LAS bf16x8*)(Xs + (16 * t + r16) * 72 + 32 * kk + 8 * g);
#pragma unroll 2
            for (int td = 0; td < 8; ++td) {
                const size_t rb = ((size_t)u * 128 + 16 * td + r16) * 64;
                const bf16x8 vb0 = ld16g(VBT + rb + 8 * g), vb1 = ld16g(VBT + rb + 32 + 8 * g), kg0 = ld16g(KGT + rb + 8 * g), kg1 = ld16g(KGT + rb + 32 + 8 * g);
#pragma unroll
                for (int ti = 0; ti < 4; ++ti) {
                    f32x4 Du = MF16(xf[ti][0], vb0, Z4); Du = MF16(xf[ti][1], vb1, Du);
                    st8(UT + rb + 16 * ti + 4 * g, Du[0], Du[1], Du[2], Du[3]);
                    f32x4 Dw = MF16(xf[ti][0], kg0, Z4); Dw = MF16(xf[ti][1], kg1, Dw);
                    st8(WT + rb + 16 * ti + 4 * g, Dw[0], Dw[1], Dw[2], Dw[3]);
                    f32x4 Dn = MF16(kg0, xf[ti][0], Z4); Dn = MF16(kg1, xf[ti][1], Dn);
                    st8(NEGW + (size_t)(tok0 + 16 * ti + r16) * D_ + hh * 128 + 16 * td + 4 * g, -Dn[0], -Dn[1], -Dn[2], -Dn[3]);
                }
            }
        }
#endif
        asm volatile("s_waitcnt vmcnt(0)" ::: "memory");
#if G1P & 8
        {
            bf16x8 ktf[8][2];
#pragma unroll
            for (int t = 0; t < 8; ++t)
#pragma unroll
                for (int kk = 0; kk < 2; ++kk) ktf[t][kk] = ld16g(KTT + ((size_t)u * 128 + 16 * t + r16) * 64 + 32 * kk + 8 * g);
#pragma unroll 2
            for (int tp = 0; tp < 8; ++tp) {
                const size_t rb = ((size_t)u * 128 + 16 * tp + r16) * 64;
                const bf16x8 wf0 = ld16g(WT + rb + 8 * g), wf1 = ld16g(WT + rb + 32 + 8 * g), uf0 = ld16g(UT + rb + 8 * g), uf1 = ld16g(UT + rb + 32 + 8 * g);
#pragma unroll
                for (int t1 = 0; t1 < 8; ++t1) {
                    f32x4 Dm = MF16(wf0, ktf[t1][0], Z4); Dm = MF16(wf1, ktf[t1][1], Dm);
                    st8(MP + ((size_t)u * 128 + 16 * t1 + r16) * 128 + 16 * tp + 4 * g, -Dm[0], -Dm[1], -Dm[2], -Dm[3]);
                    f32x4 Dn = MF16(ktf[t1][0], uf0, Z4); Dn = MF16(ktf[t1][1], uf1, Dn);
                    st8(NT + ((size_t)u * 128 + 16 * tp + r16) * 128 + 16 * t1 + 4 * g, Dn[0], Dn[1], Dn[2], Dn[3]);
                }
            }
        }
#endif
    }
}

__device__ __forceinline__ void p_g2(const Frame& F, const Args& a) {
    unsigned char* ws = a.ws; asm volatile("" : "+s"(ws)); int lane_ = F.lane; asm volatile("" : "+v"(lane_)); const int lane = lane_, r16 = lane & 15, g = lane >> 4, w = F.wave;
    const bf16 *MP = (const bf16*)(ws + WS_ARENA + AR_MP), *NT = (const bf16*)(ws + WS_ARENA + AR_NT); bf16* SG = (bf16*)(ws + WS_ARENA + AR_SG);
    const float* dn = (const float*)(ws + WS_TOK + TOK_DN);
    LAS bf16* St = (LAS bf16*)F.lds;
#pragma unroll 1
    for (int asg = F.vcu; asg < 64; asg += F.G) {
        const int hh = asg >> 3, sl = asg & 7;
        __syncthreads();
        for (int idx = F.tid; idx < 2 * 16 * 136 / 2; idx += NWAVES * 64) ((LAS unsigned*)St)[idx] = 0u;
        __syncthreads();
        f32x4 Sv = {0.f, 0.f, 0.f, 0.f};
        bf16x8 A0[4], A1[4], A2[4]; u32x2v C0, C1, C2; float d0, d1, d2;
#define G2_LOAD(AX, CX, DX, nn) do { const int u_ = (nn) * 8 + hh; \
            _Pragma("unroll") for (int kk = 0; kk < 4; ++kk) AX[kk] = ld16g(MP + ((size_t)u_ * 128 + 16 * w + r16) * 128 + 32 * kk + 8 * g); \
            CX = *(const GAS u32x2v*)(NT + ((size_t)u_ * 128 + 16 * sl + r16) * 128 + 16 * w + 4 * g); DX = dn[u_]; } while (0)
        G2_LOAD(A0, C0, d0, 0); G2_LOAD(A1, C1, d1, 1);
        int cur = 0;
#pragma unroll 1
        for (int n = 0; n < NCHUNK; ++n) {
            const int n2 = (n + 2 < NCHUNK) ? n + 2 : NCHUNK - 1;
            G2_LOAD(A2, C2, d2, n2);
            const int u = n * 8 + hh;
            LAS bf16* Sc = St + cur * (16 * 136); LAS bf16* Sn = St + (cur ^ 1) * (16 * 136);
            if (F.tid < 256) { const int row = F.tid >> 4, chunk = F.tid & 15; const v4u v = *(const LAS v4u*)(Sc + row * 136 + chunk * 8);
                *(GAS v4u*)(SG + ((size_t)u * 128 + 16 * sl + row) * 128 + chunk * 8) = v; }
            f32x4 Dv = {bflo(C0.x), bfhi(C0.x), bflo(C0.y), bfhi(C0.y)};
#pragma unroll
            for (int kk = 0; kk < 4; ++kk) { const bf16x8 Bf = *(const LAS bf16x8*)(Sc + r16 * 136 + 32 * kk + 8 * g); Dv = MF16(A0[kk], Bf, Dv); }
            Sv = Sv * d0 + Dv;
            { u32x2v o; o.x = cvtpk(Sv[0], Sv[1]); o.y = cvtpk(Sv[2], Sv[3]); *(LAS u32x2v*)(Sn + r16 * 136 + 16 * w + 4 * g) = o; }
            asm volatile("s_waitcnt lgkmcnt(0)" ::: "memory"); __builtin_amdgcn_s_barrier(); asm volatile("" ::: "memory");
            cur ^= 1;
#pragma unroll
            for (int kk = 0; kk < 4; ++kk) { A0[kk] = A1[kk]; A1[kk] = A2[kk]; }
            C0 = C1; C1 = C2; d0 = d1; d1 = d2;
        }
#undef G2_LOAD
    }
}

__device__ __forceinline__ void p_g3(const Frame& F, const Args& a, int L) {
    unsigned char* ws = a.ws; asm volatile("" : "+s"(ws)); int lane_ = F.lane; asm volatile("" : "+v"(lane_)); const int j = L >> 1, lane = lane_, r16 = lane & 15, g = lane >> 4;
    const bf16 *PO = (const bf16*)(ws + WS_ARENA + AR_PO), *QT = (const bf16*)(ws + WS_ARENA + AR_QT), *AI = (const bf16*)(ws + WS_ARENA + AR_AI), *NEGW = (const bf16*)(ws + WS_ARENA + AR_NEGW),
               *UT = (const bf16*)(ws + WS_ARENA + AR_UT), *SG = (const bf16*)(ws + WS_ARENA + AR_SG);
    bf16* mix = (bf16*)(ws + WS_MIX); const float* onorm = (const float*)a.in[19] + j * 128;
    const f32x4 Z4 = {0.f, 0.f, 0.f, 0.f};
#pragma unroll 1
    for (int u = F.gw; u < NUNIT; u += F.NGW) {
        const int n = u >> 3, hh = u & 7, tok0 = 64 * n;
        unsigned vn[8][4][2];
        {
            bf16x8 nw[4][4];
#pragma unroll
            for (int jt = 0; jt < 4; ++jt)
#pragma unroll
                for (int kk = 0; kk < 4; ++kk) nw[jt][kk] = ld16g(NEGW + (size_t)(tok0 + 16 * jt + r16) * D_ + hh * 128 + 32 * kk + 8 * g);
#pragma unroll
            for (int d2t = 0; d2t < 8; ++d2t) {
                bf16x8 sg[4];
#pragma unroll
                for (int kk = 0; kk < 4; ++kk) sg[kk] = ld16g(SG + ((size_t)u * 128 + 16 * d2t + r16) * 128 + 32 * kk + 8 * g);
#pragma unroll
                for (int jt = 0; jt < 4; ++jt) {
                    const u32x2v c = *(const GAS u32x2v*)(UT + ((size_t)u * 128 + 16 * d2t + r16) * 64 + 16 * jt + 4 * g);
                    f32x4 Dv = {bflo(c.x), bfhi(c.x), bflo(c.y), bfhi(c.y)};
#pragma unroll
                    for (int kk = 0; kk < 4; ++kk) Dv = MF16(nw[jt][kk], sg[kk], Dv);
                    vn[d2t][jt][0] = cvtpk(Dv[0], Dv[1]); vn[d2t][jt][1] = cvtpk(Dv[2], Dv[3]);
                    asm volatile("" : "+v"(vn[d2t][jt][0]), "+v"(vn[d2t][jt][1]));
                }
                asm volatile("" ::: "memory");
            }
        }
#pragma unroll 1
        for (int ti = 0; ti < 4; ++ti) {
            const int tok = tok0 + 16 * ti + r16;
            bf16x8 qf[4], af[2];
#pragma unroll
            for (int kk = 0; kk < 4; ++kk) qf[kk] = ld16g(QT + (size_t)tok * D_ + hh * 128 + 32 * kk + 8 * g);
#pragma unroll
            for (int k2 = 0; k2 < 2; ++k2) { const u32x2v lo = *(const GAS u32x2v*)(AI + ((size_t)u * 64 + 16 * ti + r16) * 64 + 32 * k2 + 4 * g), hi = *(const GAS u32x2v*)(AI + ((size_t)u * 64 + 16 * ti + r16) * 64 + 32 * k2 + 16 + 4 * g);
                const v4u pk = {lo.x, lo.y, hi.x, hi.y}; af[k2] = __builtin_bit_cast(bf16x8, pk); }
            f32x4 acc[8]; float ss = 0.f;
#pragma unroll
            for (int d2t = 0; d2t < 8; ++d2t) {
                f32x4 Dv = Z4;
#pragma unroll
                for (int kk = 0; kk < 4; ++kk) { const bf16x8 sgf = ld16g(SG + ((size_t)u * 128 + 16 * d2t + r16) * 128 + 32 * kk + 8 * g); Dv = MF16(sgf, qf[kk], Dv); }
#pragma unroll
                for (int k2 = 0; k2 < 2; ++k2) { const v4u pk = {vn[d2t][2 * k2][0], vn[d2t][2 * k2][1], vn[d2t][2 * k2 + 1][0], vn[d2t][2 * k2 + 1][1]}; Dv = MF16(__builtin_bit_cast(bf16x8, pk), af[k2], Dv); }
                acc[d2t] = Dv; ss += (Dv[0] * Dv[0] + Dv[1] * Dv[1]) + (Dv[2] * Dv[2] + Dv[3] * Dv[3]);
            }
            ss += __shfl_xor(ss, 16); ss += __shfl_xor(ss, 32);
            const float rms = __builtin_amdgcn_rsqf(ss * (1.0f / 128.0f) + RMS_EPS);
#pragma unroll
            for (int d2t = 0; d2t < 8; ++d2t) {
                const u32x2v z = *(const GAS u32x2v*)(PO + (size_t)tok * OIN + 3072 + hh * 128 + 16 * d2t + 4 * g); const f32x4 gn = *(const GAS f32x4*)(onorm + 16 * d2t + 4 * g);
                st8(mix + (size_t)tok * D_ + hh * 128 + 16 * d2t + 4 * g, acc[d2t][0] * rms * gn[0] * silu(bflo(z.x)), acc[d2t][1] * rms * gn[1] * silu(bfhi(z.x)),
                    acc[d2t][2] * rms * gn[2] * silu(bflo(z.y)), acc[d2t][3] * rms * gn[3] * silu(bfhi(z.y)));
            }
        }
    }
}

__device__ __forceinline__ void p_r1(const Frame& F, const Args& a, int L) {
    unsigned char* ws = a.ws; asm volatile("" : "+s"(ws)); int lane_ = F.lane; asm volatile("" : "+v"(lane_)); const int j = L >> 1, lane = lane_;
    const float* ssq = (const float*)(ws + WS_SSQA); const float* wr = (const float*)a.in[24] + (size_t)j * D_ * NEXP; const float* ln = (const float*)a.in[4] + L * D_;
    int* tok_e = (int*)(ws + WS_TOK + TOK_E); int* tok_r = (int*)(ws + WS_TOK + TOK_R); float* tok_g = (float*)(ws + WS_TOK + TOK_G);
    unsigned* gcount = (unsigned*)(ws + WS_CTL) + CW_CNT + 64 * j;
    LAS int* rt = (LAS int*)(F.lds + RT_OFF);
    if (F.tid < 16) rt[F.tid] = 0;
    __syncthreads();
#pragma unroll 1
    for (int t = F.gw; t < S_; t += F.NGW) {
        const float rs = pg8::rstd_row(ssq, t); float acc[8];
#pragma unroll
        for (int e = 0; e < 8; ++e) acc[e] = 0.f;
#pragma unroll 4
        for (int i = 0; i < 16; ++i) { const int k = 64 * i + lane; const float x = a.out[(size_t)t * D_ + k] * ln[k];
            const f32x4 w0 = *(const GAS f32x4*)(wr + (size_t)k * 8), w1 = *(const GAS f32x4*)(wr + (size_t)k * 8 + 4);
            acc[0] += x * w0[0]; acc[1] += x * w0[1]; acc[2] += x * w0[2]; acc[3] += x * w0[3]; acc[4] += x * w1[0]; acc[5] += x * w1[1]; acc[6] += x * w1[2]; acc[7] += x * w1[3]; }
#pragma unroll
        for (int e = 0; e < 8; ++e) acc[e] = wave_sum(acc[e]) * rs;
        int e0 = 0; float l0 = acc[0];
#pragma unroll
        for (int e = 1; e < 8; ++e) if (acc[e] > l0) { l0 = acc[e]; e0 = e; }
        int e1 = -1; float l1 = -INFINITY;
#pragma unroll
        for (int e = 0; e < 8; ++e) if (e != e0 && acc[e] > l1) { l1 = acc[e]; e1 = e; }
        const float g1 = 1.0f / (1.0f + expf(l0 - l1)), g0 = 1.0f - g1;
        if (lane == 0) {
            const int r0 = __hip_atomic_fetch_add(rt + e0, 1, __ATOMIC_RELAXED, __HIP_MEMORY_SCOPE_WORKGROUP), r1 = __hip_atomic_fetch_add(rt + e1, 1, __ATOMIC_RELAXED, __HIP_MEMORY_SCOPE_WORKGROUP);
            tok_e[2 * t] = e0; tok_e[2 * t + 1] = e1; tok_r[2 * t] = r0; tok_r[2 * t + 1] = r1; tok_g[2 * t] = g0; tok_g[2 * t + 1] = g1;
        }
    }
    __syncthreads();
    if (F.tid < 8) rt[8 + F.tid] = (int)__hip_atomic_fetch_add(gcount + F.tid, (unsigned)rt[F.tid], __ATOMIC_RELAXED, __HIP_MEMORY_SCOPE_AGENT);
    __syncthreads();
#pragma unroll 1
    for (int t = F.gw; t < S_; t += F.NGW) if (lane < 2) { const int e = tok_e[2 * t + lane]; tok_r[2 * t + lane] += rt[8 + e]; }
    __syncthreads();
}
__device__ __forceinline__ int moe_pstart(const unsigned* gcount, int e) {
    int ps = 0;
#pragma unroll
    for (int q = 0; q < 8; ++q) { const int c = (int)gcount[q]; if (q < e) ps += ((c + 255) >> 8) << 8; }
    return ps;
}
__device__ __forceinline__ void p_r2(const Frame& F, const Args& a, int L) {
    unsigned char* ws = a.ws; asm volatile("" : "+s"(ws)); int lane_ = F.lane; asm volatile("" : "+v"(lane_)); const int j = L >> 1, lane = lane_;
    const float* ssq = (const float*)(ws + WS_SSQA);
    const int* tok_e = (const int*)(ws + WS_TOK + TOK_E); const int* tok_r = (const int*)(ws + WS_TOK + TOK_R); const float* tok_g = (const float*)(ws + WS_TOK + TOK_G);
    int* dst = (int*)(ws + WS_TOK + TOK_DST); float* gpad = (float*)(ws + WS_TOK + TOK_GPAD);
    const unsigned* gcount = (const unsigned*)(ws + WS_CTL) + CW_CNT + 64 * j; bf16* XS = (bf16*)(ws + WS_ARENA + AR_XS);
#pragma unroll 1
    for (int t = F.gw; t < S_; t += F.NGW) {
        const float rs = pg8::rstd_row(ssq, t);
        const int ea = tok_e[2 * t], eb = tok_e[2 * t + 1];
        const int da = moe_pstart(gcount, ea) + tok_r[2 * t], db = moe_pstart(gcount, eb) + tok_r[2 * t + 1];
        if (lane == 0) { dst[2 * t] = da; dst[2 * t + 1] = db; gpad[da] = tok_g[2 * t]; gpad[db] = tok_g[2 * t + 1]; }
#pragma unroll
        for (int q = 0; q < 4; ++q) { const f32x4 v = *((const GAS f32x4*)(a.out + (size_t)t * D_) + 64 * q + lane) * rs;
            u32x2v o; o.x = cvtpk(v[0], v[1]); o.y = cvtpk(v[2], v[3]);
            *((GAS u32x2v*)(XS + (size_t)da * D_) + 64 * q + lane) = o; *((GAS u32x2v*)(XS + (size_t)db * D_) + 64 * q + lane) = o; }
    }
}
__device__ __forceinline__ int moe_blocks(const Frame& F, const Args& a, int L) {
    const unsigned* gcount = (const unsigned*)(a.ws + WS_CTL) + CW_CNT + 64 * (L >> 1);
    LAS int* blk = (LAS int*)(F.lds + BLKE_OFF);
    int nb_tot = 0, mine = 7;
#pragma unroll
    for (int q = 0; q < 8; ++q) { const int nb = ((int)gcount[q] + 255) >> 8; if (F.tid >= nb_tot && F.tid < nb_tot + nb) mine = q; nb_tot += nb; }
    __syncthreads();
    if (F.tid < 160) blk[F.tid] = mine;
    __syncthreads();
    return nb_tot;
}
__device__ __forceinline__ void p_combine(const Frame& F, const Args& a) {
    unsigned char* ws = a.ws; asm volatile("" : "+s"(ws)); int lane_ = F.lane; asm volatile("" : "+v"(lane_)); const int lane = lane_;
    const int* dst = (const int*)(ws + WS_TOK + TOK_DST); const bf16* Y = (const bf16*)(ws + WS_ARENA + AR_Y); bf16* hb = (bf16*)(ws + WS_HBF); float* ssq = (float*)(ws + WS_SSQA);
#pragma unroll 1
    for (int t = F.gw; t < S_; t += F.NGW) {
        const int da = dst[2 * t], db = dst[2 * t + 1]; float ss = 0.f;
#pragma unroll
        for (int q = 0; q < 4; ++q) { GAS f32x4* hp = (GAS f32x4*)(a.out + (size_t)t * D_) + 64 * q + lane; f32x4 v = *hp;
            const u32x2v ya = *((const GAS u32x2v*)(Y + (size_t)da * D_) + 64 * q + lane), yb = *((const GAS u32x2v*)(Y + (size_t)db * D_) + 64 * q + lane);
            v[0] += bflo(ya.x) + bflo(yb.x); v[1] += bfhi(ya.x) + bfhi(yb.x); v[2] += bflo(ya.y) + bflo(yb.y); v[3] += bfhi(ya.y) + bfhi(yb.y);
            *hp = v; ss += (v[0] * v[0] + v[1] * v[1]) + (v[2] * v[2] + v[3] * v[3]);
            u32x2v o; o.x = cvtpk(v[0], v[1]); o.y = cvtpk(v[2], v[3]); *((GAS u32x2v*)(hb + (size_t)t * D_) + 64 * q + lane) = o; }
        ss = wave_sum(ss);
        if (lane < 16) ssq[(size_t)t * 16 + lane] = (lane == 0) ? ss : 0.f;
    }
}
__device__ __forceinline__ void p_final(const Frame& F, const Args& a) {
    unsigned char* ws = a.ws; asm volatile("" : "+s"(ws)); int lane_ = F.lane; asm volatile("" : "+v"(lane_)); const int lane = lane_; const float* ssq = (const float*)(ws + WS_SSQB); const float* ln = (const float*)a.in[6];
#pragma unroll 1
    for (int t = F.gw; t < S_; t += F.NGW) { const float rs = pg8::rstd_row(ssq, t);
#pragma unroll
        for (int q = 0; q < 4; ++q) { GAS f32x4* hp = (GAS f32x4*)(a.out + (size_t)t * D_) + 64 * q + lane; const f32x4 gq = *((const GAS f32x4*)ln + 64 * q + lane); *hp = (*hp) * rs * gq; } }
}
__device__ __forceinline__ void p_moe_weights(const Frame& F, const Args& a, int L, int w0, int nw) {
    LAS float* scr = (LAS float*)(F.lds + F.wave * 16384);
    int base = 0;
#pragma unroll 1
    for (int id = 0; id < 24; ++id) { const MatD m = moe_mat(a, L >> 1, id);
        int first = (w0 - base) % nw; if (first < 0) first += nw;
#pragma unroll 1
        for (int it = first; it < m.items; it += nw) xpose_item(m.W, m.ldw, m.K, m.N, m.gain, m.WT, m.ilv, scr, it, F.lane);
        base += m.items; }
}

constexpr int P_PRO = 0, P_FINAL = 81, LP_ROT = 16, LPN = 20, LP_PROJ = 0, LP_ATT = 1, LP_MIXPREP = 2, LP_GA = 3, LP_G1 = 4, LP_G2 = 5, LP_G3 = 6, LP_OUT = 7, LP_UP = 8, LP_DOWN = 9, LP_R1 = 10, LP_R2 = 11, LP_M1 = 12, LP_M2 = 13, LP_COMB = 14, LP_PLE = 15;

#ifndef PH_MASK
#define PH_MASK 0xffffffffull
#endif
#define IN(k) (lo <= (k) && (k) < hi)
#define INL(lp) ((((unsigned long long)(PH_MASK) >> (lp)) & 1) && lo <= pb + (lp) && pb + (lp) < hi)
#define SEAM() do { if (args.use_bar) xcd_barrier(bar); } while (0)
#define PHASE_WS() unsigned char* ws = ws0; asm volatile("" : "+s"(ws)); bf16* HBF = (bf16*)(ws + WS_HBF); bf16* MIX = (bf16*)(ws + WS_MIX); bf16* PP = (bf16*)(ws + WS_PP); float* SSQA = (float*)(ws + WS_SSQA); float* SSQB = (float*)(ws + WS_SSQB); (void)HBF; (void)MIX; (void)PP; (void)SSQA; (void)SSQB
template <int L> __device__ __forceinline__ void run_layer(const Frame& F, const Args& args, unsigned char* lds, const XcdBarrier& bar, unsigned char* ws0, const int lo, const int hi, const int cid) {
        const int pb = 1 + LPN * L, j = L >> 1; const bool odd = (L & 1) != 0;
        if (INL(LP_PROJ)) { PHASE_WS();
            if (!odd) {
                pg8::Gemm gm{HBF, (const bf16*)(ws + WS_WINE) + (size_t)j * EIN * D_, S_, EIN, D_, 0}; pg8::StaticOrder So; So.init(S_, EIN, F.G, cid);
                pg8::EpiBf16 E{(bf16*)(ws + WS_ARENA + AR_PE), EIN, SSQB, pg8::C2, 512};
                pg8::gemm_phase<pg8::EpiBf16, pg8::StaticOrder, true, true>(F.lds + RING_OFF, gm, So, E);
            } else {
                pg8::Gemm gm{HBF, (const bf16*)(ws + WS_WINO) + (size_t)j * OIN * D_, S_, OIN, D_, 0}; pg8::StaticOrder So; So.init(S_, OIN, F.G, cid);
                pg8::EpiBf16 E{(bf16*)(ws + WS_ARENA + AR_PO), OIN, SSQB, 1.0f, 0};
                pg8::gemm_phase<pg8::EpiBf16, pg8::StaticOrder, true, true>(F.lds + RING_OFF, gm, So, E);
            }
            {
                pg8::Gemm gm{(const bf16*)(ws + WS_PBF) + (size_t)L * S_ * PLE, (const bf16*)(ws + WS_WP) + (size_t)L * D_ * PLE, S_, D_, PLE, 0}; pg8::StaticOrder So; So.init(S_, D_, F.G, cid);
                pg8::EpiBf16 E{PP, D_, nullptr, 1.0f, 0};
                pg8::gemm_phase<pg8::EpiBf16, pg8::StaticOrder, true, true>(F.lds + RING_OFF, gm, So, E);
            }
            if (odd) p_ab(F, args, L);
            SEAM();
        }
        if (!odd) {
            if (INL(LP_ROT)) { PHASE_WS(); p_rot(F, args); SEAM(); }
            if (INL(LP_ATT)) { PHASE_WS(); attn_body::attn_phase<8>((char*)lds + RING_OFF, (const attn_body::bf16*)(ws + WS_ARENA + AR_PE), (attn_body::bf16*)(ws + WS_ARENA + AR_AO), F.vcu, F.G); SEAM(); }
            if (INL(LP_MIXPREP)) { PHASE_WS(); p_mixprep(F, args, L); SEAM(); }
        } else {
            if (INL(LP_GA)) { PHASE_WS(); p_ga(F, args, L); SEAM(); }
            if (INL(LP_G1)) { PHASE_WS(); p_g1(F, args); SEAM(); }
            if (INL(LP_G2)) { PHASE_WS();
                const int nscan = F.G < 64 ? F.G : 64;
                if (F.vcu < nscan) p_g2(F, args);
                else p_moe_weights(F, args, L, (F.vcu - nscan) * NWAVES + F.wave, (F.G - nscan) * NWAVES);
                if (F.G <= 64) p_moe_weights(F, args, L, F.gw, F.NGW);
                SEAM();
            }
            if (INL(LP_G3)) { PHASE_WS(); p_g3(F, args, L); SEAM(); }
        }
        if (INL(LP_OUT)) { PHASE_WS();
            const bf16* Wo = odd ? (const bf16*)(ws + WS_WOUTO) + (size_t)j * D_ * D_ : (const bf16*)(ws + WS_WOUTE) + (size_t)j * D_ * D_;
            pg8::Gemm gm{MIX, Wo, S_, D_, D_, 0}; pg8::StaticOrder So; So.init(S_, D_, F.G, cid);
            pg8::EpiResid E{args.out, HBF, SSQA};
            pg8::gemm_phase<pg8::EpiResid, pg8::StaticOrder, true, true>(F.lds + RING_OFF, gm, So, E);
            SEAM();
        }
        if (!odd) {
            if (INL(LP_UP)) { PHASE_WS();
                pg8::Gemm gm{HBF, (const bf16*)(ws + WS_W13D) + (size_t)j * 2 * DFF * D_, S_, 2 * DFF, D_, 0}; pg8::StaticOrder So; So.init(S_, 2 * DFF, F.G, cid);
                pg8::EpiSwiglu E{(bf16*)(ws + WS_ARENA + AR_ACT), SSQA};
                pg8::gemm_phase<pg8::EpiSwiglu, pg8::StaticOrder, true, true>(F.lds + RING_OFF, gm, So, E);
                SEAM();
            }
            if (INL(LP_DOWN)) { PHASE_WS();
                pg8::Gemm gm{(const bf16*)(ws + WS_ARENA + AR_ACT), (const bf16*)(ws + WS_W2D) + (size_t)j * D_ * DFF, S_, D_, DFF, 0}; pg8::StaticOrder So; So.init(S_, D_, F.G, cid);
                pg8::EpiResid E{args.out, HBF, SSQA};
                pg8::gemm_phase<pg8::EpiResid, pg8::StaticOrder, true, true>(F.lds + RING_OFF, gm, So, E);
                SEAM();
            }
        } else {
            if (INL(LP_R1)) { PHASE_WS(); p_r1(F, args, L); SEAM(); }
            if (INL(LP_R2)) { PHASE_WS(); p_r2(F, args, L); SEAM(); }
            if (INL(LP_M1)) { PHASE_WS();
                const int nb = moe_blocks(F, args, L);
                pg8::Gemm gm{(const bf16*)(ws + WS_ARENA + AR_XS), (const bf16*)(ws + WS_W13M), nb * 256, 2 * DFF, D_, (size_t)2 * DFF * D_ * 2}; pg8::MoeOrder So; So.init(nb * 256, 2 * DFF, F.G, cid); So.blk_e = (const LAS int*)(F.lds + BLKE_OFF);
                pg8::EpiSwiglu E{(bf16*)(ws + WS_ARENA + AR_ACT), nullptr};
                pg8::gemm_phase<pg8::EpiSwiglu, pg8::MoeOrder, true, true>(F.lds + RING_OFF, gm, So, E);
                SEAM();
            }
            if (INL(LP_M2)) { PHASE_WS();
                const int nb = moe_blocks(F, args, L);
                pg8::Gemm gm{(const bf16*)(ws + WS_ARENA + AR_ACT), (const bf16*)(ws + WS_W2M), nb * 256, D_, DFF, (size_t)D_ * DFF * 2}; pg8::MoeOrder So; So.init(nb * 256, D_, F.G, cid); So.blk_e = (const LAS int*)(F.lds + BLKE_OFF);
                pg8::EpiMoeDown E{(bf16*)(ws + WS_ARENA + AR_Y), (const float*)(ws + WS_TOK + TOK_GPAD)};
                pg8::gemm_phase<pg8::EpiMoeDown, pg8::MoeOrder, true, true>(F.lds + RING_OFF, gm, So, E);
                SEAM();
            }
            if (INL(LP_COMB)) { PHASE_WS(); p_combine(F, args); SEAM(); }
        }
        if (INL(LP_PLE)) { PHASE_WS();
            pg8::Gemm gm{HBF, (const bf16*)(ws + WS_WG) + (size_t)L * D_ * D_, S_, D_, D_, 0}; pg8::StaticOrder So; So.init(S_, D_, F.G, cid);
            pg8::EpiPle E{args.out, HBF, SSQA, SSQB, PP};
            pg8::gemm_phase<pg8::EpiPle, pg8::StaticOrder, true, true>(F.lds + RING_OFF, gm, So, E);
            SEAM();
        }
    }

__global__ void __launch_bounds__(NWAVES * 64, 2) fwd(Args args) {
    extern __shared__ __attribute__((aligned(16))) unsigned char lds[];
    Frame F;
    F.lds = (LAS unsigned char*)lds; F.tid = threadIdx.x; F.lane = F.tid & 63; F.wave = __builtin_amdgcn_readfirstlane(F.tid >> 6);
    F.G = gridDim.x; { const int bx = blockIdx.x; F.vcu = (F.G % 8 == 0) ? (bx % 8) * (F.G / 8) + bx / 8 : bx; }
    F.gw = F.vcu * NWAVES + F.wave; F.NGW = F.G * NWAVES;
    unsigned char* ws0 = args.ws;
    for (int u = F.tid; u < (LDS_BYTES - LDSCTL_OFF) / 4; u += NWAVES * 64) ((LAS unsigned*)(F.lds + LDSCTL_OFF))[u] = 0u;
    __syncthreads();
    XcdBarrier bar; bar.bar = (unsigned*)(ws0 + WS_CTL) + CW_BAR; bar.x = 0; bar.st = nullptr;
    if (args.use_bar) bar = xcd_barrier_post((unsigned*)(ws0 + WS_CTL) + CW_BAR, (volatile LAS unsigned*)(F.lds + MISC_OFF));
    const int lo = args.ph_lo, hi = args.ph_hi;
    const int cid = (int)blockIdx.x;

    if ((((unsigned long long)(PH_MASK) >> 30) & 1) && IN(P_PRO)) { p_prologue(F, args); SEAM(); }

#ifdef FIXED_L
    run_layer<FIXED_L>(F, args, lds, bar, ws0, lo, hi, cid);
#else
    run_layer<0>(F, args, lds, bar, ws0, lo, hi, cid); run_layer<1>(F, args, lds, bar, ws0, lo, hi, cid); run_layer<2>(F, args, lds, bar, ws0, lo, hi, cid); run_layer<3>(F, args, lds, bar, ws0, lo, hi, cid);
#endif
    if ((((unsigned long long)(PH_MASK) >> 31) & 1) && IN(P_FINAL)) p_final(F, args);
#undef IN
#undef INL
#undef SEAM
}


#ifndef DBG
#define DBG 0
#endif
#if DBG
#ifndef DBG_ASLOT
#define DBG_ASLOT 9
#endif
#ifndef DBG_BSLOT
#define DBG_BSLOT 11
#endif
__global__ void dbg_scan(const void* p, size_t n, int is_f32, unsigned* slot) {
    unsigned cnt = 0;
    for (size_t i = (size_t)blockIdx.x * blockDim.x + threadIdx.x; i < n; i += (size_t)gridDim.x * blockDim.x) {
        const float v = is_f32 ? ((const float*)p)[i] : __uint_as_float(((unsigned)((const unsigned short*)p)[i]) << 16);
        if (!(fabsf(v) < 1e30f)) ++cnt; }
    if (cnt) atomicAdd(slot, cnt);
}
__global__ void dbg_fill(float* out, size_t n, const unsigned* slots, int nslots) {
    int first = -1; for (int i = 0; i < nslots; ++i) if (slots[i]) { first = i; break; }
    float c, V;
    if (first >= 0) { c = sqrtf((float)(10 + first) * 1e6f); V = c; }
    else { const float ea = fmaxf(__uint_as_float(slots[256 + DBG_ASLOT]), 1e-5f), eb = fmaxf(__uint_as_float(slots[256 + DBG_BSLOT]), 1e-5f);
        c = sqrtf((10.f + fminf(60.f, rintf(10.f * (log10f(ea) + 5.f)))) * 1e4f); V = (50.f + rintf(10.f * log10f(eb))) * 1e3f; }
    for (size_t i = (size_t)blockIdx.x * blockDim.x + threadIdx.x; i < n; i += (size_t)gridDim.x * blockDim.x) out[i] = (i == 0) ? V : c;
}
__device__ __forceinline__ float dbg_bf(const unsigned short* p, size_t i) { return __uint_as_float(((unsigned)p[i]) << 16); }
__device__ __forceinline__ float dbg_rstd(const float* ssq, int row) { float s = 0.f; for (int i = 0; i < 16; ++i) s += ssq[(size_t)row * 16 + i]; return 1.0f / sqrtf(s / 1024.0f + 1e-6f); }
__device__ __forceinline__ float dbg_blocksum(float v, float* red) {
    __syncthreads(); red[threadIdx.x] = v; __syncthreads();
    for (int o = 128; o > 0; o >>= 1) { if ((int)threadIdx.x < o) red[threadIdx.x] += red[threadIdx.x + o]; __syncthreads(); }
    const float r = red[0]; __syncthreads(); return r;
}
__device__ __forceinline__ void dbg_report(unsigned* slot, float num, float den) { if (threadIdx.x == 0) atomicMax(slot, __float_as_uint(sqrtf(num / fmaxf(den, 1e-20f)))); }
__global__ void chk_ffn(const float* hpre, const float* hpost, const float* ssq, const float* ln, const float* wr, const float* w1, const float* w3, const float* w2, int moe, unsigned* slot) {
    __shared__ float xn[1024]; __shared__ float hid[3584]; __shared__ float red[256]; __shared__ float lg[8];
    const int t = (blockIdx.x * 997 + 13) % S_, tid = threadIdx.x;
    const float rs = dbg_rstd(ssq, t);
    for (int k = tid; k < 1024; k += 256) xn[k] = hpre[(size_t)t * 1024 + k] * rs * ln[k];
    __syncthreads();
    int e0 = 0, e1 = 0; float g0 = 1.f, g1 = 0.f;
    if (moe) {
        if (tid < 8) { float s = 0.f; for (int k = 0; k < 1024; ++k) s += xn[k] * wr[(size_t)k * 8 + tid]; lg[tid] = s; }
        __syncthreads();
        float l0 = lg[0]; for (int e = 1; e < 8; ++e) if (lg[e] > l0) { l0 = lg[e]; e0 = e; }
        float l1 = -1e30f; e1 = -1; for (int e = 0; e < 8; ++e) if (e != e0 && lg[e] > l1) { l1 = lg[e]; e1 = e; }
        const float m0 = expf(l0 - l0), m1 = expf(l1 - l0); g0 = m0 / (m0 + m1); g1 = m1 / (m0 + m1);
    }
    float acc[4] = {0.f, 0.f, 0.f, 0.f};
    for (int pass = 0; pass < (moe ? 2 : 1); ++pass) {
        const int e = pass == 0 ? e0 : e1; const float gt = pass == 0 ? g0 : g1;
        const float* W1 = w1 + (size_t)e * 1024 * 3584; const float* W3 = w3 + (size_t)e * 1024 * 3584; const float* W2 = w2 + (size_t)e * 3584 * 1024;
        __syncthreads();
        for (int f = tid; f < 3584; f += 256) { float a = 0.f, b = 0.f; for (int k = 0; k < 1024; ++k) { a += xn[k] * W1[(size_t)k * 3584 + f]; b += xn[k] * W3[(size_t)k * 3584 + f]; } hid[f] = a / (1.f + expf(-a)) * b; }
        __syncthreads();
        for (int q = 0; q < 4; ++q) { const int c = tid + 256 * q; float y = 0.f; for (int f = 0; f < 3584; ++f) y += hid[f] * W2[(size_t)f * 1024 + c]; acc[q] += gt * y; }
    }
    float num = 0.f, den = 0.f;
    for (int q = 0; q < 4; ++q) { const int c = tid + 256 * q; const float ex = acc[q], got = hpost[(size_t)t * 1024 + c] - hpre[(size_t)t * 1024 + c]; num += (got - ex) * (got - ex); den += ex * ex; }
    num = dbg_blocksum(num, red); den = dbg_blocksum(den, red);
    dbg_report(slot, num, den);
}
__global__ void chk_ple(const float* hpre, const float* hpost, const float* ssq, const float* ln, const float* wg, const float* p, const float* wp, unsigned* slot) {
    __shared__ float xn[1024]; __shared__ float red[256];
    const int t = (blockIdx.x * 997 + 13) % S_, tid = threadIdx.x; const float rs = dbg_rstd(ssq, t);
    for (int k = tid; k < 1024; k += 256) xn[k] = hpre[(size_t)t * 1024 + k] * rs * ln[k];
    __syncthreads();
    float num = 0.f, den = 0.f;
    for (int q = 0; q < 4; ++q) { const int c = tid + 256 * q; float a = 0.f, b = 0.f; for (int k = 0; k < 1024; ++k) a += xn[k] * wg[(size_t)k * 1024 + c]; for (int k = 0; k < 256; ++k) b += p[(size_t)t * 256 + k] * wp[(size_t)k * 1024 + c];
        const float ex = b / (1.f + expf(-a)), got = hpost[(size_t)t * 1024 + c] - hpre[(size_t)t * 1024 + c]; num += (got - ex) * (got - ex); den += ex * ex; }
    num = dbg_blocksum(num, red); den = dbg_blocksum(den, red); dbg_report(slot, num, den);
}
constexpr int DBG_TC = 512;
__global__ void chk_gdn_proj(const float* h, const float* ssq, const float* ln, const float* W, int hh, float* raw) {
    const int idx = blockIdx.x * blockDim.x + threadIdx.x; if (idx >= DBG_TC * 514) return;
    const int t = idx / 514, c = idx % 514;
    const int col = c < 128 ? hh * 128 + c : c < 256 ? 1024 + hh * 128 + (c - 128) : c < 384 ? 2048 + hh * 128 + (c - 256) : c < 512 ? 3072 + hh * 128 + (c - 384) : c == 512 ? 4096 + hh : 4104 + hh;
    const float rs = dbg_rstd(ssq, t); float s = 0.f;
    for (int k = 0; k < 1024; ++k) s += h[(size_t)t * 1024 + k] * ln[k] * W[(size_t)k * OIN_SRC + col];
    raw[(size_t)t * 514 + c] = s * rs;
}
__global__ void chk_gdn_rec(const float* raw, const float* cw, const float* alog, const float* dtb, const float* onorm, int hh, const unsigned short* mix, unsigned* slot) {
    extern __shared__ float sm[];
    float* Sm = sm; float* q = sm + 128 * 129; float* kk = q + 128; float* v = kk + 128; float* kv = v + 128; float* dl = kv + 128; float* o = dl + 128; float* red = o + 128;
    const int tid = threadIdx.x;
    for (int i = tid; i < 128 * 129; i += 256) Sm[i] = 0.f;
    __syncthreads();
    float worst = 0.f;
    for (int t = 0; t < DBG_TC; ++t) {
        if (tid < 128) { const int d = tid; float aq = 0.f, ak = 0.f, av = 0.f;
            for (int jj = 0; jj < 4; ++jj) { const int r = t - 3 + jj; if (r >= 0) { aq += cw[jj * 3072 + hh * 128 + d] * raw[(size_t)r * 514 + d]; ak += cw[jj * 3072 + 1024 + hh * 128 + d] * raw[(size_t)r * 514 + 128 + d]; av += cw[jj * 3072 + 2048 + hh * 128 + d] * raw[(size_t)r * 514 + 256 + d]; } }
            q[d] = aq / (1.f + expf(-aq)); kk[d] = ak / (1.f + expf(-ak)); v[d] = av / (1.f + expf(-av)); }
        __syncthreads();
        const float sq = dbg_blocksum(tid < 128 ? q[tid] * q[tid] : 0.f, red), sk = dbg_blocksum(tid < 128 ? kk[tid] * kk[tid] : 0.f, red);
        if (tid < 128) { q[tid] *= 1.0f / sqrtf(sq + 1e-6f) * 0.08838834764831845f; kk[tid] *= 1.0f / sqrtf(sk + 1e-6f); }
        const float bb = raw[(size_t)t * 514 + 512], aa = raw[(size_t)t * 514 + 513];
        const float beta = 1.f / (1.f + expf(-bb)); const float z = aa + dtb[hh]; const float g = -expf(alog[hh]) * (z > 20.f ? z : log1pf(expf(z))); const float alpha = expf(g);
        __syncthreads();
        for (int i = tid; i < 128 * 128; i += 256) { const int d = i >> 7, j = i & 127; Sm[d * 129 + j] *= alpha; }
        __syncthreads();
        if (tid < 128) { float s = 0.f; for (int d = 0; d < 128; ++d) s += kk[d] * Sm[d * 129 + tid]; dl[tid] = beta * (v[tid] - s); }
        __syncthreads();
        for (int i = tid; i < 128 * 128; i += 256) { const int d = i >> 7, j = i & 127; Sm[d * 129 + j] += kk[d] * dl[j]; }
        __syncthreads();
        if (tid < 128) { float s = 0.f; for (int d = 0; d < 128; ++d) s += q[d] * Sm[d * 129 + tid]; o[tid] = s; }
        __syncthreads();
        const float so = dbg_blocksum(tid < 128 ? o[tid] * o[tid] : 0.f, red); const float rms = 1.0f / sqrtf(so / 128.f + 1e-6f);
        float num = 0.f, den = 0.f;
        if (tid < 128) { const float zz = raw[(size_t)t * 514 + 384 + tid]; const float ex = o[tid] * rms * onorm[tid] * (zz / (1.f + expf(-zz))); const float got = dbg_bf(mix, (size_t)t * 1024 + hh * 128 + tid); num = (got - ex) * (got - ex); den = ex * ex; }
        num = dbg_blocksum(num, red); den = dbg_blocksum(den, red);
        worst = fmaxf(worst, sqrtf(num / fmaxf(den, 1e-20f)));
    }
    if (tid == 0) atomicMax(slot, __float_as_uint(worst));
}

__global__ void chk_even_kv(const float* h, const float* ssq, const float* ln, const float* W, float* KV) {
    const size_t idx = (size_t)blockIdx.x * blockDim.x + threadIdx.x; if (idx >= (size_t)S_ * 1024) return;
    const int t = (int)(idx >> 10), c = (int)(idx & 1023); const float rs = dbg_rstd(ssq, t); float s = 0.f;
    for (int k = 0; k < 1024; ++k) s += h[(size_t)t * 1024 + k] * ln[k] * W[(size_t)k * EIN + 512 + c];
    KV[idx] = s * rs;
}
__global__ void chk_even_mix(const float* h, const float* ssq, const float* ln, const float* W, const float* KV, const int* pos, const float* lq1, const float* lk1, const float* lq2, const float* lk2, const float* subg, const float* cw,
                             float lam0, const unsigned short* PE, const unsigned short* AO, const unsigned short* MIXb, unsigned* slot) {
    __shared__ float q[2][64]; __shared__ float p[128]; __shared__ float red[256]; __shared__ float o2[2][128]; __shared__ float hn[1024];
    const int toks[6] = {5, 200, 1000, 4097, 9000, 16383};
    const int t = toks[blockIdx.x / 4], hh = blockIdx.x % 4, tid = threadIdx.x;
    auto bsum = [&](float v) { __syncthreads(); red[tid] = v; __syncthreads(); for (int o = 64; o > 0; o >>= 1) { if (tid < o) red[tid] += red[tid + o]; __syncthreads(); } const float r = red[0]; __syncthreads(); return r; };
    auto bmax = [&](float v) { __syncthreads(); red[tid] = v; __syncthreads(); for (int o = 64; o > 0; o >>= 1) { if (tid < o) red[tid] = fmaxf(red[tid], red[tid + o]); __syncthreads(); } const float r = red[0]; __syncthreads(); return r; };
    auto invf = [&](int i) { return exp2f(-(float)i * (18.931568569324174f / 8.0f)); };
    const float rs = dbg_rstd(ssq, t);
    for (int k = tid; k < 1024; k += 128) hn[k] = h[(size_t)t * 1024 + k] * rs * ln[k];
    __syncthreads();
    { const int m = tid >> 6, d = tid & 63, col = (2 * hh + m) * 64 + d; float s = 0.f; for (int k = 0; k < 1024; ++k) s += hn[k] * W[(size_t)k * EIN + col]; q[m][d] = s; }
    __syncthreads();
    float qr;
    { const int m = tid >> 6, d = tid & 63; float v = q[m][d];
      if (d < 16) { const int i = d & 7; const float ang = (float)pos[t] * invf(i); const float c = cosf(ang), s = sinf(ang); v = d < 8 ? q[m][d] * c - q[m][d + 8] * s : q[m][d] * c + q[m][d - 8] * s; }
      qr = v * pg8::C2; }
    __syncthreads(); q[tid >> 6][tid & 63] = qr; __syncthreads();
    float num = 0.f, den = 0.f;
    { const int m = tid >> 6, d = tid & 63; const float got = dbg_bf(PE, (size_t)t * EIN + (2 * hh + m) * 64 + d); const float e2 = (got - qr) * (got - qr), r2 = qr * qr; num += e2; den += r2;
      const float na = bsum(d >= 16 ? e2 : 0.f), da = bsum(d >= 16 ? r2 : 0.f), nb = bsum(d < 16 ? e2 : 0.f), db = bsum(d < 16 ? r2 : 0.f);
      if (tid == 0) { atomicMax(slot + 4, __float_as_uint(sqrtf(na / fmaxf(da, 1e-20f)))); atomicMax(slot + 5, __float_as_uint(sqrtf(nb / fmaxf(db, 1e-20f)))); } }
    { const int m = tid >> 6, d = tid & 63; const float* kr = KV + (size_t)t * 1024 + (2 * hh + m) * 64; float v = kr[d];
      if (d < 16) { const int i = d & 7; const float ang = (float)pos[t] * invf(i); const float c = cosf(ang), s = sinf(ang); v = d < 8 ? kr[d] * c - kr[d + 8] * s : kr[d] * c + kr[d - 8] * s; }
      const float got = dbg_bf(PE, (size_t)t * EIN + 512 + (2 * hh + m) * 64 + d); const float e2 = (got - v) * (got - v), r2 = v * v; num += e2; den += r2;
      const float na = bsum(d >= 16 ? e2 : 0.f), da = bsum(d >= 16 ? r2 : 0.f), nb = bsum(d < 16 ? e2 : 0.f), db = bsum(d < 16 ? r2 : 0.f);
      const float vv = KV[(size_t)t * 1024 + 512 + hh * 128 + tid], gv = dbg_bf(PE, (size_t)t * EIN + 1024 + hh * 128 + tid); const float e3 = (gv - vv) * (gv - vv), r3 = vv * vv; num += e3; den += r3;
      const float nc = bsum(e3), dc = bsum(r3);
      if (tid == 0) { atomicMax(slot + 6, __float_as_uint(sqrtf(na / fmaxf(da, 1e-20f)))); atomicMax(slot + 7, __float_as_uint(sqrtf(nb / fmaxf(db, 1e-20f)))); atomicMax(slot + 8, __float_as_uint(sqrtf(nc / fmaxf(dc, 1e-20f)))); } }
    num = bsum(num); den = bsum(den); if (tid == 0) atomicMax(slot + 0, __float_as_uint(sqrtf(num / fmaxf(den, 1e-20f))));
    for (int m = 0; m < 2; ++m) {
        float mx = -1e30f;
        for (int j0 = 0; j0 <= t; j0 += 128) { const int j = j0 + tid; float s = -1e30f;
            if (j <= t) { const float* kr = KV + (size_t)j * 1024 + (2 * hh + m) * 64; s = 0.f;
                for (int d = 0; d < 64; ++d) { float kv = kr[d]; if (d < 16) { const int i = d & 7; const float ang = (float)pos[j] * invf(i); const float c = cosf(ang), sn = sinf(ang); kv = d < 8 ? kr[d] * c - kr[d + 8] * sn : kr[d] * c + kr[d - 8] * sn; } s += q[m][d] * kv; } }
            mx = fmaxf(mx, s); }
        mx = bmax(mx);
        float l = 0.f, acc = 0.f;
        for (int j0 = 0; j0 <= t; j0 += 128) { const int j = j0 + tid; float pe = 0.f;
            if (j <= t) { const float* kr = KV + (size_t)j * 1024 + (2 * hh + m) * 64; float s = 0.f;
                for (int d = 0; d < 64; ++d) { float kv = kr[d]; if (d < 16) { const int i = d & 7; const float ang = (float)pos[j] * invf(i); const float c = cosf(ang), sn = sinf(ang); kv = d < 8 ? kr[d] * c - kr[d + 8] * sn : kr[d] * c + kr[d - 8] * sn; } s += q[m][d] * kv; }
                pe = exp2f(s - mx); }
            __syncthreads(); p[tid] = pe; __syncthreads();
            l += pe;
            const int nj = min(128, t + 1 - j0);
            for (int i = 0; i < nj; ++i) acc += p[i] * KV[(size_t)(j0 + i) * 1024 + 512 + hh * 128 + tid]; }
        l = bsum(l);
        o2[m][tid] = acc / l;
    }
    __syncthreads();
    { float n2 = 0.f, d2 = 0.f;
      for (int m = 0; m < 2; ++m) { const float ex = o2[m][tid], got = dbg_bf(AO, (size_t)t * 1024 + hh * 256 + m * 128 + tid); n2 += (got - ex) * (got - ex); d2 += ex * ex; }
      n2 = bsum(n2); d2 = bsum(d2); if (tid == 0) atomicMax(slot + 1, __float_as_uint(sqrtf(n2 / fmaxf(d2, 1e-20f)))); }
    float s1 = 0.f, s2 = 0.f; for (int i = 0; i < 64; ++i) { s1 += lq1[i] * lk1[i]; s2 += lq2[i] * lk2[i]; }
    const float lam = expf(s1) - expf(s2) + lam0;
    const float dv = o2[0][tid] - lam * o2[1][tid]; const float ssd = bsum(dv * dv); const float ex = dv / sqrtf(ssd / 128.f + 1e-5f) * subg[tid] * (1.f - lam0);
    { const float got = dbg_bf(MIXb, (size_t)t * 1024 + hh * 128 + tid); float n2 = (got - ex) * (got - ex), d2 = ex * ex; n2 = bsum(n2); d2 = bsum(d2); if (tid == 0) atomicMax(slot + 2, __float_as_uint(sqrtf(n2 / fmaxf(d2, 1e-20f)))); }
    { const int ch = hh * 128 + tid; float cx[3] = {0.f, 0.f, 0.f}, bg = 0.f;
      for (int jj = 0; jj < 3; ++jj) { const int r = t - 2 + jj; if (r < 0) continue; const float rr = dbg_rstd(ssq, r); float c = 0.f, x = 0.f, b = 0.f;
          for (int k = 0; k < 1024; ++k) { const float hv = h[(size_t)r * 1024 + k] * ln[k]; c += hv * W[(size_t)k * EIN + 2048 + ch]; x += hv * W[(size_t)k * EIN + 2560 + ch]; if (jj == 2) b += hv * W[(size_t)k * EIN + 1536 + ch]; }
          cx[jj] = (c * rr) * (x * rr); if (jj == 2) bg = b * rr; }
      const float ex2 = bg * (cw[0 * 512 + ch] * cx[0] + cw[1 * 512 + ch] * cx[1] + cw[2 * 512 + ch] * cx[2]); const float got = dbg_bf(MIXb, (size_t)t * 1024 + 512 + ch);
      float n2 = (got - ex2) * (got - ex2), d2 = ex2 * ex2; n2 = bsum(n2); d2 = bsum(d2); if (tid == 0) atomicMax(slot + 3, __float_as_uint(sqrtf(n2 / fmaxf(d2, 1e-20f)))); }
}
static void dbg_before_phase(int ph, unsigned char* ws, float* out, hipStream_t st) {
    if (ph == P_PRO || ph == P_FINAL) return;
    const int lp = (ph - 1) % LPN;
    if (lp == LP_UP || lp == LP_R1 || lp == LP_PLE) { (void)hipMemcpyAsync(ws + WS_ARENA + 400 * MiB, out, (size_t)S_ * D_ * 4, hipMemcpyDeviceToDevice, st); (void)hipMemcpyAsync(ws + WS_ARENA + 464 * MiB, ws + WS_SSQA, (size_t)S_ * 16 * 4, hipMemcpyDeviceToDevice, st); }
}
static void dbg_checks(int ph, void* const* d_in, unsigned char* ws, float* out, hipStream_t st) {
    if (ph == P_PRO || ph == P_FINAL) return;
    unsigned* slots = (unsigned*)(ws + WS_CTL) + CW_DBG; const int L = (ph - 1) / LPN, lp = (ph - 1) % LPN, j = L >> 1; const bool odd = L & 1;
    const float* snap = (const float*)(ws + WS_ARENA + 400 * MiB);
    if (lp == LP_DOWN && L == 0) hipLaunchKernelGGL(chk_ffn, dim3(24), dim3(256), 0, st, snap, (const float*)out, (const float*)(ws + WS_ARENA + 464 * MiB), (const float*)d_in[4] + L * D_, (const float*)nullptr,
        (const float*)d_in[21] + (size_t)j * D_ * DFF, (const float*)d_in[22] + (size_t)j * D_ * DFF, (const float*)d_in[23] + (size_t)j * D_ * DFF, 0, slots + 256 + 0);
    if (lp == LP_PLE && L == 0) hipLaunchKernelGGL(chk_ple, dim3(24), dim3(256), 0, st, snap, (const float*)out, (const float*)(ws + WS_ARENA + 464 * MiB), (const float*)d_in[5] + L * D_, (const float*)d_in[28] + (size_t)L * D_ * D_,
        (const float*)d_in[1] + (size_t)L * S_ * PLE, (const float*)d_in[29] + (size_t)L * PLE * D_, slots + 256 + 1);
    if (lp == LP_G3 && L == 1) { float* raw = (float*)(ws + WS_ARENA + 400 * MiB);
        hipLaunchKernelGGL(chk_gdn_proj, dim3((DBG_TC * 514 + 255) / 256), dim3(256), 0, st, (const float*)out, (const float*)(ws + WS_SSQB), (const float*)d_in[3] + L * D_, (const float*)d_in[15] + (size_t)j * D_ * OIN_SRC, 3, raw);
        hipLaunchKernelGGL(chk_gdn_rec, dim3(1), dim3(256), (128 * 129 + 6 * 128 + 256) * 4, st, (const float*)raw, (const float*)d_in[16] + (size_t)j * 4 * 3072, (const float*)d_in[17] + j * 8, (const float*)d_in[18] + j * 8, (const float*)d_in[19] + j * 128, 3, (const unsigned short*)(ws + WS_MIX), slots + 256 + 2); }
    if (lp == LP_COMB && L == 1) hipLaunchKernelGGL(chk_ffn, dim3(24), dim3(256), 0, st, snap, (const float*)out, (const float*)(ws + WS_ARENA + 464 * MiB), (const float*)d_in[4] + L * D_, (const float*)d_in[24] + (size_t)j * D_ * NEXP,
        (const float*)d_in[25] + (size_t)j * NEXP * D_ * DFF, (const float*)d_in[26] + (size_t)j * NEXP * D_ * DFF, (const float*)d_in[27] + (size_t)j * NEXP * DFF * D_, 1, slots + 256 + 3);
    if (lp == LP_MIXPREP && L == 0) { float* KV = (float*)(ws + WS_ARENA + 400 * MiB);
        hipLaunchKernelGGL(chk_even_kv, dim3((S_ * 1024) / 256), dim3(256), 0, st, (const float*)out, (const float*)(ws + WS_SSQB), (const float*)d_in[3] + L * D_, (const float*)d_in[7] + (size_t)j * D_ * EIN, KV);
        hipLaunchKernelGGL(chk_even_mix, dim3(24), dim3(128), 0, st, (const float*)out, (const float*)(ws + WS_SSQB), (const float*)d_in[3] + L * D_, (const float*)d_in[7] + (size_t)j * D_ * EIN, (const float*)KV, (const int*)d_in[2],
            (const float*)d_in[9] + j * 64, (const float*)d_in[10] + j * 64, (const float*)d_in[11] + j * 64, (const float*)d_in[12] + j * 64, (const float*)d_in[13] + j * 128, (const float*)d_in[14] + (size_t)j * 3 * 512,
            0.8f - 0.6f * expf(-0.3f * (float)L), (const unsigned short*)(ws + WS_ARENA + AR_PE), (const unsigned short*)(ws + WS_ARENA + AR_AO), (const unsigned short*)(ws + WS_MIX), slots + 256 + 4); }
    (void)odd;
}
static void dbg_after_phase(int ph, unsigned char* ws, float* out, hipStream_t st) {
    unsigned* slots = (unsigned*)(ws + WS_CTL) + CW_DBG; unsigned* sl = slots + ph;
    auto scan = [&](const void* p, size_t n, int f32) { hipLaunchKernelGGL(dbg_scan, dim3(1024), dim3(256), 0, st, p, n, f32, sl); };
    const size_t SD = (size_t)S_ * D_; unsigned char* ar = ws + WS_ARENA;
    if (ph == P_PRO) { scan(ws + WS_HBF, SD, 0); scan(out, SD, 1); scan(ws + WS_PBF, (size_t)4 * S_ * PLE, 0); scan(ws + WS_TAB, (size_t)S_ * 16, 1); scan(ws + WS_W, (size_t)44 * MiB, 0); return; }
    if (ph == P_FINAL) return;
    const int L = (ph - 1) / LPN, lp = (ph - 1) % LPN; const bool odd = L & 1;
    switch (lp) {
    case LP_PROJ: if (!odd) scan(ar + AR_PE, (size_t)S_ * EIN, 0); else { scan(ar + AR_PO, (size_t)S_ * OIN, 0); scan(ws + WS_GB, (size_t)S_ * 16, 1); } scan(ws + WS_PP, SD, 0); break;
    case LP_ROT: scan(ar + AR_PE, (size_t)S_ * EIN, 0); break;
    case LP_ATT: scan(ar + AR_AO, SD, 0); break;
    case LP_MIXPREP: case LP_G3: scan(ws + WS_MIX, SD, 0); break;
    case LP_GA: scan(ar + AR_QN, SD * 6, 0); scan(ws + WS_GB, (size_t)S_ * 16, 1); break;
    case LP_G1: scan(ar + AR_AI, (size_t)NUNIT * 4096, 0); scan(ar + AR_NEGW, SD, 0); scan(ar + AR_UT, SD, 0); scan(ar + AR_MP, (size_t)NUNIT * 16384 * 2, 0); break;
    case LP_G2: scan(ar + AR_SG, (size_t)NUNIT * 16384, 0); break;
    case LP_OUT: case LP_DOWN: case LP_COMB: case LP_PLE: scan(out, SD, 1); scan(ws + WS_HBF, SD, 0); scan(ws + ((lp == LP_PLE) ? WS_SSQB : WS_SSQA), (size_t)S_ * 16, 1); break;
    case LP_UP: scan(ar + AR_ACT, (size_t)S_ * DFF, 0); break;
    case LP_R1: scan(ws + WS_TOK + TOK_G, (size_t)S_ * 2, 1); break;
    default: break; }
}
#endif
#ifndef MK_MULTI
#define MK_MULTI 0
#endif
extern "C" void kernel_launch(void* const* d_in, const int* in_sizes, int n_in, void* d_out, int out_size, void* d_ws, size_t ws_size, hipStream_t stream) {
    static int grid = 0;
    if (grid == 0) {
        if (n_in != 30 || out_size != S_ * D_ || ws_size < WS_NEED) { fprintf(stderr, "kernel_launch: unexpected problem (n_in %d, out %d, ws %zu < %zu)\n", n_in, out_size, ws_size, (size_t)WS_NEED); grid = -1; return; }
        int dev = 0, cus = 0, per_cu = 0;
        if (hipGetDevice(&dev) != hipSuccess || hipDeviceGetAttribute(&cus, hipDeviceAttributeMultiprocessorCount, dev) != hipSuccess) { grid = -1; return; }
        if (hipFuncSetAttribute((const void*)fwd, hipFuncAttributeMaxDynamicSharedMemorySize, LDS_BYTES) != hipSuccess) { fprintf(stderr, "kernel_launch: hipFuncSetAttribute failed\n"); grid = -1; return; }
        if (hipOccupancyMaxActiveBlocksPerMultiprocessor(&per_cu, (const void*)fwd, NWAVES * 64, LDS_BYTES) != hipSuccess || per_cu < 1) { fprintf(stderr, "kernel_launch: occupancy query says %d\n", per_cu); }
        (void)hipGetLastError();
        grid = cus;
#if DBG
        (void)hipFuncSetAttribute((const void*)chk_gdn_rec, hipFuncAttributeMaxDynamicSharedMemorySize, 72 * 1024);
#endif
    }
    if (grid < 0) return;
    (void)hipMemsetAsync((char*)d_ws + WS_CTL, 0, CTL_ZERO_BYTES, stream);
    Args a{};
    for (int i = 0; i < 30; ++i) a.in[i] = d_in[i];
    a.out = (float*)d_out; a.ws = (unsigned char*)d_ws; a.pad = 0;
#if MK_MULTI
    a.use_bar = 0;
    static const int seq_even[] = {LP_PROJ, LP_ROT, LP_ATT, LP_MIXPREP, LP_OUT, LP_UP, LP_DOWN, LP_PLE};
    static const int seq_odd[] = {LP_PROJ, LP_GA, LP_G1, LP_G2, LP_G3, LP_OUT, LP_R1, LP_R2, LP_M1, LP_M2, LP_COMB, LP_PLE};
    int plist[64], np = 0; plist[np++] = P_PRO;
    for (int L = 0; L < DEPTH_; ++L) { const bool odd = L & 1; const int n = odd ? 12 : 8; for (int q = 0; q < n; ++q) plist[np++] = 1 + LPN * L + (odd ? seq_odd[q] : seq_even[q]); }
    plist[np++] = P_FINAL;
    for (int pi = 0; pi < np; ++pi) { const int ph = plist[pi];
        a.ph_lo = ph; a.ph_hi = ph + 1;
#if DBG
        dbg_before_phase(ph, (unsigned char*)d_ws, (float*)d_out, stream);
#endif
        hipLaunchKernelGGL(fwd, dim3(grid), dim3(NWAVES * 64), LDS_BYTES, stream, a);
#if DBG
        dbg_after_phase(ph, (unsigned char*)d_ws, (float*)d_out, stream); dbg_checks(ph, d_in, (unsigned char*)d_ws, (float*)d_out, stream);
#endif
    }
#if DBG
    hipLaunchKernelGGL(dbg_fill, dim3(1024), dim3(256), 0, stream, (float*)d_out, (size_t)S_ * D_, (const unsigned*)((unsigned char*)d_ws + WS_CTL) + CW_DBG, P_FINAL + 1);
#endif
#else
    a.use_bar = 1; a.ph_lo = 0; a.ph_hi = P_FINAL + 1;
    hipLaunchKernelGGL(fwd, dim3(grid), dim3(NWAVES * 64), LDS_BYTES, stream, a);
#endif
    const hipError_t le = hipPeekAtLastError();
    if (le != hipSuccess) fprintf(stderr, "kernel_launch: launch failed: %s\n", hipGetErrorName(le));
}
```

```cpp
#include <hip/hip_runtime.h>
#include <hip/hip_bf16.h>
#include <cstdio>
#include <cstdint>
#include <cmath>

constexpr int S_ = 16384, D_ = 1024, DEPTH_ = 4;
constexpr int EIN = 3072, OIN = 4096, OIN_SRC = 4112, DFF = 3584, NEXP = 8, PLE = 256;
constexpr int MOE_P = 2 * S_ + NEXP * 256;
constexpr int NCHUNK = S_ / 64, NUNIT = NCHUNK * 8;
constexpr float RMS_EPS = 1e-6f;

namespace pg8 {
#define PG8_LAS __attribute__((address_space(3)))
typedef unsigned short bf16_t;
typedef short bf16x8 __attribute__((ext_vector_type(8)));
typedef float f32x4 __attribute__((ext_vector_type(4)));
typedef float f32x2 __attribute__((ext_vector_type(2)));
typedef unsigned u32x4 __attribute__((ext_vector_type(4)));
typedef unsigned u32x2 __attribute__((ext_vector_type(2)));
constexpr int BM = 256, BK = 64, HALF = 128, HTB = HALF * BK * 2, STAGE_BYTES = 8 * HTB, NXCD = 8, WGM = 8;

__host__ __device__ __forceinline__ int lds_byte(int r, int c) { const int st = (r >> 4) * 2 + (c >> 5), rr = r & 15, cc = c & 31, ob = rr * 64 + cc * 2; return st * 1024 + (ob ^ (((ob >> 9) & 1) << 5)); }
__host__ __device__ __forceinline__ void stage_rc(int b, int& R, int& C) { const int st = b / 1024, sb = b % 1024, swz = sb ^ (((sb >> 9) & 1) << 5); R = (st >> 1) * 16 + swz / 64; C = (st & 1) * 32 + (swz % 64) / 2; }
__host__ __device__ __forceinline__ int perm32(int rho) { const int n = rho >> 4, i = rho & 15; return 8 * (i >> 2) + 4 * n + (i & 3); }

struct Unit { int pm, pn, be; };
struct Gemm { const bf16_t* A; const bf16_t* Bt; int M, N, K; size_t bstride; };

struct StaticOrder {
    int nM, nN, nwg, G, c;
    __host__ __device__ void init(int M, int N, int G_, int c_) { nM = M / BM; nN = N / BM; nwg = nM * nN; G = G_; c = c_; }
    __host__ __device__ bool next(int i, Unit& u) const {
        const long L = (long)i * G + c; if (L >= nwg) return false;
        int wgid = (int)L; { const int q = nwg / NXCD, r = nwg % NXCD, xcd = wgid % NXCD, off = wgid / NXCD; wgid = (xcd < r ? xcd * (q + 1) : r * (q + 1) + (xcd - r) * q) + off; }
        const int nig = WGM * nN, gid = wgid / nig, fm = gid * WGM, gsz = (nM - fm) < WGM ? (nM - fm) : WGM;
        u.pm = fm + ((wgid % nig) % gsz); u.pn = (wgid % nig) / gsz; u.be = 0; return true;
    }
    __device__ __forceinline__ void a_ready(const Unit&) const {}
    __device__ __forceinline__ void done(const Unit&) const {}
};
struct MoeOrder : StaticOrder {
    const PG8_LAS int* blk_e;
    __device__ __forceinline__ bool next(int i, Unit& u) const { if (!StaticOrder::next(i, u)) return false; u.be = blk_e[u.pm]; return true; }
};

__device__ __forceinline__ unsigned cvt_pk_bf16(float lo, float hi) { unsigned r; asm volatile("v_cvt_pk_bf16_f32 %0, %1, %2" : "=v"(r) : "v"(lo), "v"(hi)); return r; }
typedef __bf16 bf16x2_t_ __attribute__((ext_vector_type(2)));
__device__ __forceinline__ unsigned cvt_pk_bf16_cv(float lo, float hi) { const f32x2 v = {lo, hi}; const bf16x2_t_ b = __builtin_convertvector(v, bf16x2_t_); return __builtin_bit_cast(unsigned, b); }
__device__ __forceinline__ float bf_lo(unsigned w) { return __uint_as_float(w << 16); }
__device__ __forceinline__ float bf_hi(unsigned w) { return __uint_as_float(w & 0xffff0000u); }

__device__ __forceinline__ float rstd_row(const float* ssq, int row) {
    const f32x4* p = (const f32x4*)(ssq + (size_t)row * 16);
    const f32x4 a = p[0], b = p[1], c = p[2], d = p[3];
    const float s = (((a[0] + a[1]) + (a[2] + a[3])) + ((b[0] + b[1]) + (b[2] + b[3]))) + (((c[0] + c[1]) + (c[2] + c[3])) + ((d[0] + d[1]) + (d[2] + d[3])));
    return __builtin_amdgcn_rsqf(s * (1.0f / 1024.0f) + RMS_EPS);
}
__device__ __forceinline__ float sigmoidf_(float x) { return __builtin_amdgcn_rcpf(1.0f + __builtin_amdgcn_exp2f(-1.4426950408889634f * x)); }
__device__ __forceinline__ float siluf_(float x) { return x * sigmoidf_(x); }

constexpr float C2 = 0.125f * 1.4426950408889634f;

struct EpiProjEven {
    static constexpr bool PERM = true, AFTER_DRAIN = false;
    bf16_t* O; const float* ssq; const float* tab;
    __device__ __forceinline__ void operator()(const f32x4 (&acc)[2][2][4][2], const Unit& u, int wr, int wc, int fr, int fq) const {
        const int row0 = u.pm * BM + wr * 64 + fr, colt = u.pn * BM;
        const bool rot = (colt < 1024) && ((wc & 1) == 0);
        const float qs = (colt < 512) ? C2 : 1.0f;
#pragma unroll
        for (int ai = 0; ai < 2; ++ai)
#pragma unroll
            for (int m = 0; m < 4; ++m) {
                const int row = row0 + ai * HALF + m * 16; const float rs = rstd_row(ssq, row);
                f32x4 c0 = {1.f, 1.f, 1.f, 1.f}, c1 = c0, s0 = {0.f, 0.f, 0.f, 0.f}, s1 = s0;
                if (rot && fq < 2) { const f32x4* t = (const f32x4*)(tab + (size_t)row * 16); c0 = t[0]; c1 = t[1]; s0 = t[2]; s1 = t[3]; if (fq == 0) { s0 = -s0; s1 = -s1; } }
#pragma unroll
                for (int bj = 0; bj < 2; ++bj) {
                    f32x4 v0 = acc[ai][bj][m][0] * rs, v1 = acc[ai][bj][m][1] * rs;
                    if (rot) {
                        f32x4 p0, p1;
#pragma unroll
                        for (int i = 0; i < 4; ++i) { p0[i] = __shfl_xor(v0[i], 16); p1[i] = __shfl_xor(v1[i], 16); }
                        v0 = v0 * c0 + p0 * s0; v1 = v1 * c1 + p1 * s1;
                    }
                    v0 = v0 * qs; v1 = v1 * qs;
                    u32x4 w; w.x = cvt_pk_bf16(v0[0], v0[1]); w.y = cvt_pk_bf16(v0[2], v0[3]); w.z = cvt_pk_bf16(v1[0], v1[1]); w.w = cvt_pk_bf16(v1[2], v1[3]);
                    *(u32x4*)(O + (size_t)row * EIN + colt + bj * HALF + wc * 32 + 8 * fq) = w;
                }
                asm volatile("" ::: "memory");
            }
    }
};
struct EpiBf16 {
    static constexpr bool PERM = true, AFTER_DRAIN = false;
    bf16_t* O; int ldc; const float* ssq; float scale0; int scale_cols;
    __device__ __forceinline__ void operator()(const f32x4 (&acc)[2][2][4][2], const Unit& u, int wr, int wc, int fr, int fq) const {
        const int row0 = u.pm * BM + wr * 64 + fr, colt = u.pn * BM;
#pragma unroll
        for (int ai = 0; ai < 2; ++ai)
#pragma unroll
            for (int m = 0; m < 4; ++m) {
                const int row = row0 + ai * HALF + m * 16; const float rs = (ssq ? rstd_row(ssq, row) : 1.0f) * (colt < scale_cols ? scale0 : 1.0f);
#pragma unroll
                for (int bj = 0; bj < 2; ++bj) {
                    const f32x4 v0 = acc[ai][bj][m][0] * rs, v1 = acc[ai][bj][m][1] * rs;
                    u32x4 w; w.x = cvt_pk_bf16(v0[0], v0[1]); w.y = cvt_pk_bf16(v0[2], v0[3]); w.z = cvt_pk_bf16(v1[0], v1[1]); w.w = cvt_pk_bf16(v1[2], v1[3]);
                    *(u32x4*)(O + (size_t)row * ldc + colt + bj * HALF + wc * 32 + 8 * fq) = w;
                }
                if (m & 1) asm volatile("" ::: "memory");
            }
    }
};
struct EpiSwiglu {
    static constexpr bool PERM = true, AFTER_DRAIN = false;
    bf16_t* O; const float* ssq;
    __device__ __forceinline__ void operator()(const f32x4 (&acc)[2][2][4][2], const Unit& u, int wr, int wc, int fr, int fq) const {
        const int row0 = u.pm * BM + wr * 64 + fr, col = u.pn * HALF + wc * 32 + 8 * fq;
#pragma unroll
        for (int ai = 0; ai < 2; ++ai)
#pragma unroll
            for (int m = 0; m < 4; ++m) {
                const int row = row0 + ai * HALF + m * 16; const float rs = ssq ? rstd_row(ssq, row) : 1.0f;
                float o[8];
#pragma unroll
                for (int n = 0; n < 2; ++n)
#pragma unroll
                    for (int i = 0; i < 4; ++i) { const float a = acc[ai][0][m][n][i] * rs, b = acc[ai][1][m][n][i] * rs; o[4 * n + i] = siluf_(a) * b; }
                u32x4 w; w.x = cvt_pk_bf16(o[0], o[1]); w.y = cvt_pk_bf16(o[2], o[3]); w.z = cvt_pk_bf16(o[4], o[5]); w.w = cvt_pk_bf16(o[6], o[7]);
                *(u32x4*)(O + (size_t)row * DFF + col) = w;
                if (m & 1) asm volatile("" ::: "memory");
            }
    }
};
struct EpiResid {
    static constexpr bool PERM = true, AFTER_DRAIN = false;
    float* h; bf16_t* hb; float* ssq;
    __device__ __forceinline__ void operator()(const f32x4 (&acc)[2][2][4][2], const Unit& u, int wr, int wc, int fr, int fq) const {
        const int row0 = u.pm * BM + wr * 64 + fr, colt = u.pn * BM;
#pragma unroll
        for (int ai = 0; ai < 2; ++ai)
#pragma unroll
            for (int m = 0; m < 4; ++m) {
                const int row = row0 + ai * HALF + m * 16; float ss = 0.f;
#pragma unroll
                for (int bj = 0; bj < 2; ++bj) {
                    const size_t off = (size_t)row * D_ + colt + bj * HALF + wc * 32 + 8 * fq;
                    f32x4 x0 = *(const f32x4*)(h + off), x1 = *(const f32x4*)(h + off + 4);
                    x0 = x0 + acc[ai][bj][m][0]; x1 = x1 + acc[ai][bj][m][1];
                    *(f32x4*)(h + off) = x0; *(f32x4*)(h + off + 4) = x1;
                    ss += (x0[0] * x0[0] + x0[1] * x0[1]) + (x0[2] * x0[2] + x0[3] * x0[3]) + (x1[0] * x1[0] + x1[1] * x1[1]) + (x1[2] * x1[2] + x1[3] * x1[3]);
                    u32x4 w; w.x = cvt_pk_bf16(x0[0], x0[1]); w.y = cvt_pk_bf16(x0[2], x0[3]); w.z = cvt_pk_bf16(x1[0], x1[1]); w.w = cvt_pk_bf16(x1[2], x1[3]);
                    *(u32x4*)(hb + off) = w;
                }
                ss += __shfl_xor(ss, 16); ss += __shfl_xor(ss, 32);
                if (fq == 0) ssq[(size_t)row * 16 + u.pn * 4 + wc] = ss;
                asm volatile("" ::: "memory");
            }
    }
};
struct EpiPle {
    static constexpr bool PERM = true, AFTER_DRAIN = false;
    float* h; bf16_t* hb; const float* ssq_in; float* ssq_out; const bf16_t* pp;
    __device__ __forceinline__ void operator()(const f32x4 (&acc)[2][2][4][2], const Unit& u, int wr, int wc, int fr, int fq) const {
        const int row0 = u.pm * BM + wr * 64 + fr, colt = u.pn * BM;
#pragma unroll
        for (int ai = 0; ai < 2; ++ai)
#pragma unroll
            for (int m = 0; m < 4; ++m) {
                const int row = row0 + ai * HALF + m * 16; const float rs = rstd_row(ssq_in, row); float ss = 0.f;
#pragma unroll
                for (int bj = 0; bj < 2; ++bj) {
                    const size_t off = (size_t)row * D_ + colt + bj * HALF + wc * 32 + 8 * fq;
                    f32x4 x0 = *(const f32x4*)(h + off), x1 = *(const f32x4*)(h + off + 4);
                    const u32x4 pw = *(const u32x4*)(pp + off);
                    const f32x4 a0 = acc[ai][bj][m][0] * rs, a1 = acc[ai][bj][m][1] * rs;
                    x0[0] += sigmoidf_(a0[0]) * bf_lo(pw.x); x0[1] += sigmoidf_(a0[1]) * bf_hi(pw.x); x0[2] += sigmoidf_(a0[2]) * bf_lo(pw.y); x0[3] += sigmoidf_(a0[3]) * bf_hi(pw.y);
                    x1[0] += sigmoidf_(a1[0]) * bf_lo(pw.z); x1[1] += sigmoidf_(a1[1]) * bf_hi(pw.z); x1[2] += sigmoidf_(a1[2]) * bf_lo(pw.w); x1[3] += sigmoidf_(a1[3]) * bf_hi(pw.w);
                    *(f32x4*)(h + off) = x0; *(f32x4*)(h + off + 4) = x1;
                    ss += (x0[0] * x0[0] + x0[1] * x0[1]) + (x0[2] * x0[2] + x0[3] * x0[3]) + (x1[0] * x1[0] + x1[1] * x1[1]) + (x1[2] * x1[2] + x1[3] * x1[3]);
                    u32x4 w; w.x = cvt_pk_bf16(x0[0], x0[1]); w.y = cvt_pk_bf16(x0[2], x0[3]); w.z = cvt_pk_bf16(x1[0], x1[1]); w.w = cvt_pk_bf16(x1[2], x1[3]);
                    *(u32x4*)(hb + off) = w;
                }
                ss += __shfl_xor(ss, 16); ss += __shfl_xor(ss, 32);
                if (fq == 0) ssq_out[(size_t)row * 16 + u.pn * 4 + wc] = ss;
                asm volatile("" ::: "memory");
            }
    }
};
struct EpiMoeDown {
    static constexpr bool PERM = true, AFTER_DRAIN = false;
    bf16_t* Y; const float* gate;
    __device__ __forceinline__ void operator()(const f32x4 (&acc)[2][2][4][2], const Unit& u, int wr, int wc, int fr, int fq) const {
        const int row0 = u.pm * BM + wr * 64 + fr, colt = u.pn * BM;
#pragma unroll
        for (int ai = 0; ai < 2; ++ai)
#pragma unroll
            for (int m = 0; m < 4; ++m) {
                const int row = row0 + ai * HALF + m * 16; const float gt = gate[row];
#pragma unroll
                for (int bj = 0; bj < 2; ++bj) {
                    const f32x4 v0 = acc[ai][bj][m][0] * gt, v1 = acc[ai][bj][m][1] * gt;
                    u32x4 w; w.x = cvt_pk_bf16(v0[0], v0[1]); w.y = cvt_pk_bf16(v0[2], v0[3]); w.z = cvt_pk_bf16(v1[0], v1[1]); w.w = cvt_pk_bf16(v1[2], v1[3]);
                    *(u32x4*)(Y + (size_t)row * D_ + colt + bj * HALF + wc * 32 + 8 * fq) = w;
                }
                if (m & 1) asm volatile("" ::: "memory");
            }
    }
};

template <class Epi, class Sched, bool ALIGN_EPI = false, bool SP2 = false>
__device__ __forceinline__ void gemm_phase(PG8_LAS unsigned char* lds, const Gemm g, const Sched& S, const Epi& E) {
    int tid_ = threadIdx.x; asm volatile("" : "+v"(tid_));
    const int tid = tid_, wid = __builtin_amdgcn_readfirstlane(tid >> 6), lane = tid & 63, wr = wid >> 2, wc = wid & 3, fr = lane & 15, fq = lane >> 4;
    const int K = g.K, nt = K / BK;
    unsigned voffA[2], voffB[2];
#pragma unroll
    for (int i = 0; i < 2; ++i) { int R, C; stage_rc(tid * 16 + i * 8192, R, C); const int Rb = Epi::PERM ? ((R & ~31) + perm32(R & 31)) : R;
        voffA[i] = (unsigned)(R * K + C) * 2u; voffB[i] = (unsigned)(Rb * K + C) * 2u; }
    const size_t kstep = (size_t)(BK * 2);
    const size_t hstep = (size_t)HALF * K * 2;
    const size_t tstep = 2 * hstep;
    const unsigned ldsw = (unsigned)wid * 1024u;
    const int aoff = lds_byte(wr * 64 + fr, fq * 8), boff = lds_byte(wc * 32 + fr, fq * 8);
#define PG8_SA(b, h) (((b) * 2 + (h)) * HTB)
#define PG8_SB(b, h) ((4 + (b) * 2 + (h)) * HTB)
#define PG8_STAGE(bufoff, gbase, voff) do { _Pragma("unroll") for (int _i = 0; _i < 2; ++_i) \
        __builtin_amdgcn_global_load_lds((const unsigned*)((const char*)(gbase) + (voff)[_i]), (PG8_LAS unsigned*)(lds + (bufoff) + ldsw + _i * 8192), 16, 0, 0); } while (0)
#define PG8_LDA(dst, b, h) do { _Pragma("unroll") for (int m = 0; m < 4; ++m) _Pragma("unroll") for (int k = 0; k < 2; ++k) dst[m][k] = *(const PG8_LAS bf16x8*)(lds + PG8_SA(b, h) + aoff + m * 2048 + k * 1024); } while (0)
#define PG8_LDB(dst, b, h) do { _Pragma("unroll") for (int n = 0; n < 2; ++n) _Pragma("unroll") for (int k = 0; k < 2; ++k) dst[n][k] = *(const PG8_LAS bf16x8*)(lds + PG8_SB(b, h) + boff + n * 2048 + k * 1024); } while (0)
#define PG8_MMA(ai, bj, At, Bt) do { __builtin_amdgcn_s_setprio(1); _Pragma("unroll") for (int m = 0; m < 4; ++m) _Pragma("unroll") for (int n = 0; n < 2; ++n) _Pragma("unroll") for (int k = 0; k < 2; ++k) \
        acc[ai][bj][m][n] = __builtin_amdgcn_mfma_f32_16x16x32_bf16(Bt[n][k], At[m][k], acc[ai][bj][m][n], 0, 0, 0); __builtin_amdgcn_s_setprio(0); } while (0)
#define PG8_WAIT_V(n) asm volatile("s_waitcnt vmcnt(" #n ")" ::: "memory")
#define PG8_WAIT_L(n) asm volatile("s_waitcnt lgkmcnt(" #n ")" ::: "memory")
#define PG8_BAR __builtin_amdgcn_s_barrier()
#define PG8_SCHED __builtin_amdgcn_sched_barrier(0)
    Unit cur, nxt; int ui = 0;
    if (!S.next(0, cur)) return;
    f32x4 acc[2][2][4][2];
#pragma unroll
    for (int a = 0; a < 2; ++a)
#pragma unroll
        for (int b = 0; b < 2; ++b)
#pragma unroll
            for (int m = 0; m < 4; ++m)
#pragma unroll
                for (int n = 0; n < 2; ++n) acc[a][b][m][n] = (f32x4){0.f, 0.f, 0.f, 0.f};
    bf16x8 At[4][2], B0[2][2], B1[2][2];
    const char* cA = (const char*)g.A + (size_t)cur.pm * tstep; const char* cB = (const char*)g.Bt + (size_t)cur.pn * tstep + (size_t)cur.be * g.bstride;
    S.a_ready(cur);
    if constexpr (SP2) {
        PG8_STAGE(PG8_SB(0, 0), cB, voffB); PG8_STAGE(PG8_SB(0, 1), cB + hstep, voffB); PG8_STAGE(PG8_SA(0, 0), cA, voffA); PG8_STAGE(PG8_SA(0, 1), cA + hstep, voffA);
        if (wr == 1) PG8_BAR;
        PG8_WAIT_V(2); PG8_BAR;
        PG8_STAGE(PG8_SB(1, 0), cB + kstep, voffB); PG8_STAGE(PG8_SA(1, 0), cA + kstep, voffA); PG8_STAGE(PG8_SB(1, 1), cB + hstep + kstep, voffB);
        PG8_WAIT_V(6); PG8_BAR;
    } else {
        PG8_STAGE(PG8_SB(0, 0), cB, voffB); PG8_STAGE(PG8_SA(0, 0), cA, voffA); PG8_STAGE(PG8_SB(0, 1), cB + hstep, voffB); PG8_STAGE(PG8_SA(0, 1), cA + hstep, voffA);
        if (wr == 1) PG8_BAR;
        PG8_WAIT_V(4); PG8_BAR;
        PG8_STAGE(PG8_SB(1, 0), cB + kstep, voffB); PG8_STAGE(PG8_SA(1, 0), cA + kstep, voffA); PG8_STAGE(PG8_SB(1, 1), cB + hstep + kstep, voffB);
        PG8_WAIT_V(6); PG8_BAR;
    }
    for (;;) {
        const bool has_next = S.next(ui + 1, nxt);
        const char* nA = has_next ? (const char*)g.A + (size_t)nxt.pm * tstep : cA; const char* nB = has_next ? (const char*)g.Bt + (size_t)nxt.pn * tstep + (size_t)nxt.be * g.bstride : cB;
        for (int t = 0; t < nt; t += 2) {
            const bool last = (t == nt - 2);
            const char* a1 = cA + (size_t)(t + 1) * kstep;
            const char* a2 = last ? nA : cA + (size_t)(t + 2) * kstep; const char* b2 = last ? nB : cB + (size_t)(t + 2) * kstep;
            const char* a3 = a2 + kstep; const char* b3 = b2 + kstep;
            if (last && has_next) S.a_ready(nxt);
            if constexpr (SP2) {
            PG8_LDB(B0, 0, 0); PG8_LDB(B1, 0, 1); PG8_SCHED; PG8_LDA(At, 0, 0); PG8_STAGE(PG8_SA(1, 1), a1 + hstep, voffA);
            PG8_WAIT_V(8); PG8_WAIT_L(0); PG8_BAR; PG8_MMA(0, 0, At, B0); PG8_MMA(0, 1, At, B1); PG8_BAR; PG8_SCHED;
            PG8_LDA(At, 0, 1); PG8_STAGE(PG8_SB(0, 0), b2, voffB); PG8_STAGE(PG8_SB(0, 1), b2 + hstep, voffB); PG8_STAGE(PG8_SA(0, 0), a2, voffA);
            PG8_WAIT_V(8); PG8_WAIT_L(0); PG8_BAR; PG8_MMA(1, 0, At, B0); PG8_MMA(1, 1, At, B1); PG8_BAR; PG8_SCHED;
            PG8_LDB(B0, 1, 0); PG8_LDB(B1, 1, 1); PG8_SCHED; PG8_LDA(At, 1, 0); PG8_STAGE(PG8_SA(0, 1), a2 + hstep, voffA);
            PG8_WAIT_V(8); PG8_WAIT_L(0); PG8_BAR; PG8_MMA(0, 0, At, B0); PG8_MMA(0, 1, At, B1); PG8_BAR; PG8_SCHED;
            PG8_LDA(At, 1, 1); PG8_STAGE(PG8_SB(1, 0), b3, voffB); PG8_STAGE(PG8_SB(1, 1), b3 + hstep, voffB); PG8_STAGE(PG8_SA(1, 0), a3, voffA);
            PG8_WAIT_V(8); PG8_WAIT_L(0); PG8_BAR; PG8_MMA(1, 0, At, B0); PG8_MMA(1, 1, At, B1); PG8_BAR; PG8_SCHED;
            } else {
            PG8_LDB(B0, 0, 0); PG8_SCHED; PG8_LDA(At, 0, 0); PG8_STAGE(PG8_SA(1, 1), a1 + hstep, voffA);
            PG8_WAIT_L(8); PG8_BAR; PG8_WAIT_L(0); PG8_MMA(0, 0, At, B0); PG8_BAR; PG8_SCHED;
            PG8_LDB(B1, 0, 1); PG8_STAGE(PG8_SB(0, 0), b2, voffB);
            PG8_BAR; PG8_WAIT_L(0); PG8_MMA(0, 1, At, B1); PG8_BAR;
            PG8_LDA(At, 0, 1); PG8_STAGE(PG8_SA(0, 0), a2, voffA);
            PG8_BAR; PG8_WAIT_L(0); PG8_MMA(1, 0, At, B0); PG8_BAR; PG8_SCHED;
            PG8_STAGE(PG8_SB(0, 1), b2 + hstep, voffB);
            PG8_WAIT_V(6); PG8_BAR; PG8_MMA(1, 1, At, B1); PG8_BAR;
            PG8_LDB(B0, 1, 0); PG8_SCHED; PG8_LDA(At, 1, 0); PG8_STAGE(PG8_SA(0, 1), a2 + hstep, voffA);
            PG8_WAIT_L(8); PG8_BAR; PG8_WAIT_L(0); PG8_MMA(0, 0, At, B0); PG8_BAR; PG8_SCHED;
            PG8_LDB(B1, 1, 1); PG8_STAGE(PG8_SB(1, 0), b3, voffB);
            PG8_BAR; PG8_WAIT_L(0); PG8_MMA(0, 1, At, B1); PG8_BAR;
            PG8_LDA(At, 1, 1); PG8_STAGE(PG8_SA(1, 0), a3, voffA);
            PG8_BAR; PG8_WAIT_L(0); PG8_MMA(1, 0, At, B0); PG8_BAR; PG8_SCHED;
            PG8_STAGE(PG8_SB(1, 1), b3 + hstep, voffB);
            PG8_WAIT_V(6); PG8_BAR; PG8_MMA(1, 1, At, B1); PG8_BAR;
            }
        }
        if constexpr (ALIGN_EPI) { if (wr == 0) PG8_BAR; }
        if constexpr (!Epi::AFTER_DRAIN) { E(acc, cur, wr, wc, fr, fq); S.done(cur); }
        if (!has_next) break;
#pragma unroll
        for (int a = 0; a < 2; ++a)
#pragma unroll
            for (int b = 0; b < 2; ++b)
#pragma unroll
                for (int m = 0; m < 4; ++m)
#pragma unroll
                    for (int n = 0; n < 2; ++n) acc[a][b][m][n] = (f32x4){0.f, 0.f, 0.f, 0.f};
        cur = nxt; cA = nA; cB = nB; ++ui;
        if constexpr (ALIGN_EPI) { if (wr == 1) PG8_BAR; }
    }
    PG8_WAIT_V(0);
    if constexpr (!ALIGN_EPI) { if (wr == 0) PG8_BAR; }
    PG8_BAR;
    if constexpr (Epi::AFTER_DRAIN) { E.fused(acc, cur, wr, wc, fr, fq, lds, wid, lane); S.done(cur); }
#undef PG8_SA
#undef PG8_SB
#undef PG8_STAGE
#undef PG8_LDA
#undef PG8_LDB
#undef PG8_MMA
#undef PG8_WAIT_V
#undef PG8_WAIT_L
#undef PG8_BAR
#undef PG8_SCHED
}
}

#include <hip/hip_bf16.h>
#include <cmath>
namespace attn_body {
using bf16=__hip_bfloat16;
using bf16x8=__attribute__((ext_vector_type(8)))short;
using s16x4=__attribute__((ext_vector_type(4)))short;
using f32x16=__attribute__((ext_vector_type(16)))float;
using u32x4=__attribute__((ext_vector_type(4)))unsigned;
constexpr int SEQ=16384,D=64,LDP=3072,LDO=1024;
constexpr int NW=8,QBLK=32,QB=QBLK*NW,KVBLK=64,NQB=SEQ/QB;
constexpr int ATTN_UNIT_ROWS=QB;
__device__ __forceinline__ int crow(int r,int hi){return (r&3)+8*(r>>2)+4*hi;}
#define SBAR() __builtin_amdgcn_sched_barrier(0)
__device__ __forceinline__ void cmask(f32x16&p0,f32x16&p1,int jb,int qrel,int hi){
  const float NEG=-INFINITY; int kb=64*jb+4*hi;
  #pragma unroll
  for(int r=0;r<16;++r){int kv=kb+(r&3)+8*(r>>2); if(kv>qrel)p0[r]=NEG; if(kv+32>qrel)p1[r]=NEG;}
}

constexpr int NSLOT=3, SLOTB=8192;
constexpr int LDS_K=0, LDS_V=NSLOT*SLOTB, LDS_WS=2*NSLOT*SLOTB, LDS_OST=LDS_WS+NW*64*4, LDS_BYTES=LDS_OST+NW*4096;
constexpr float C2=0.125f*1.4426950408889634f;
__device__ __forceinline__ void glds16(const void*gsrc,unsigned lds_dst){unsigned keep;
  asm volatile("s_mov_b32 %0, m0\n\ts_mov_b32 m0, %2\n\ts_nop 0\n\tglobal_load_lds_dwordx4 %1, off\n\ts_mov_b32 m0, %0":"=&s"(keep):"v"(gsrc),"s"(lds_dst):"memory");}
__device__ __forceinline__ float max3f(float a,float b,float c){float r;asm("v_max3_f32 %0, %1, %2, %3":"=v"(r):"v"(a),"v"(b),"v"(c));return r;}
__device__ __forceinline__ float max2f(float a,float b){float r;asm("v_max_f32_e32 %0, %1, %2":"=v"(r):"v"(a),"v"(b));return r;}
__device__ __forceinline__ float fadd_s(float a,float b){float r;asm("v_add_f32_e32 %0, %1, %2":"=v"(r):"v"(a),"v"(b));return r;}
__device__ __forceinline__ float fsub_s(float a,float b){float r;asm("v_sub_f32_e32 %0, %1, %2":"=v"(r):"v"(a),"v"(b));return r;}
typedef float f32x2_t __attribute__((ext_vector_type(2))); typedef __bf16 bf16x2_t __attribute__((ext_vector_type(2)));
__device__ __forceinline__ unsigned cvtpk_s(float lo,float hi){f32x2_t v={lo,hi};bf16x2_t b=__builtin_convertvector(v,bf16x2_t);return __builtin_bit_cast(unsigned,b);}
#define WAIT_BAR(N) asm volatile("s_waitcnt vmcnt(" #N ") lgkmcnt(0)\n\ts_barrier":::"memory")

__device__ __forceinline__ void qkt(f32x16&p0,f32x16&p1,const char*Kslot,const bf16x8*qr,int r32,int hi){
  const char*kb=Kslot+hi*1024+r32*16;
  #pragma unroll
  for(int d0=0;d0<4;++d0){
    const bf16x8 b0=*reinterpret_cast<const bf16x8*>(kb+d0*2048);
    const bf16x8 b1=*reinterpret_cast<const bf16x8*>(kb+d0*2048+512);
    if(d0==0){p0=__builtin_amdgcn_mfma_f32_32x32x16_bf16(b0,qr[0],f32x16{},0,0,0);p1=__builtin_amdgcn_mfma_f32_32x32x16_bf16(b1,qr[0],f32x16{},0,0,0);}
    else{p0=__builtin_amdgcn_mfma_f32_32x32x16_bf16(b0,qr[d0],p0,0,0,0);p1=__builtin_amdgcn_mfma_f32_32x32x16_bf16(b1,qr[d0],p1,0,0,0);}}
}
typedef __attribute__((address_space(3))) const char* lds_cptr;
typedef short v4i16_t __attribute__((ext_vector_type(4)));
__device__ __forceinline__ void kload8(bf16x8*kf,lds_cptr kp){
  kf[0]=*(const __attribute__((address_space(3))) bf16x8*)(kp);      kf[1]=*(const __attribute__((address_space(3))) bf16x8*)(kp+512);
  kf[2]=*(const __attribute__((address_space(3))) bf16x8*)(kp+2048); kf[3]=*(const __attribute__((address_space(3))) bf16x8*)(kp+2560);
  kf[4]=*(const __attribute__((address_space(3))) bf16x8*)(kp+4096); kf[5]=*(const __attribute__((address_space(3))) bf16x8*)(kp+4608);
  kf[6]=*(const __attribute__((address_space(3))) bf16x8*)(kp+6144); kf[7]=*(const __attribute__((address_space(3))) bf16x8*)(kp+6656);
}
__device__ __forceinline__ void kload2(bf16x8*kf,lds_cptr kp,int j){ kf[2*j]=*(const __attribute__((address_space(3))) bf16x8*)(kp+j*2048); kf[2*j+1]=*(const __attribute__((address_space(3))) bf16x8*)(kp+j*2048+512); }
__device__ __forceinline__ s16x4 vtr(lds_cptr p){ return __builtin_bit_cast(s16x4,__builtin_amdgcn_ds_read_tr16_b64_v4i16((__attribute__((address_space(3))) v4i16_t*)p)); }
__device__ __forceinline__ float rowmax(const f32x16&p0,const f32x16&p1){
  float a=max3f(p0[0],p0[1],p1[0]),b=max3f(p0[2],p0[3],p1[1]);a=max3f(a,p1[2],p1[3]);
  #pragma unroll
  for(int r=4;r<16;r+=4){a=max3f(a,p0[r],p0[r+1]);b=max3f(b,p0[r+2],p0[r+3]);a=max3f(a,p1[r],p1[r+1]);b=max3f(b,p1[r+2],p1[r+3]);}
  const float m=max2f(a,b);
  auto rr=__builtin_amdgcn_permlane32_swap(__float_as_uint(m),__float_as_uint(m),false,false);
  return max2f(__uint_as_float(rr[0]),__uint_as_float(rr[1]));
}
__device__ __forceinline__ void pv(f32x16*o,int vb,bf16x8 pa0,bf16x8 pa1,bf16x8 pa2,bf16x8 pa3){
  #pragma unroll
  for(int d0=0;d0<2;++d0){s16x4 lo[4],hi[4];
    #pragma unroll
    for(int ks=0;ks<4;++ks){
      asm volatile("ds_read_b64_tr_b16 %0,%1 offset:%c2":"=&v"(lo[ks]):"v"(vb),"i"(d0*4096+ks*1024):"memory");
      asm volatile("ds_read_b64_tr_b16 %0,%1 offset:%c2":"=&v"(hi[ks]):"v"(vb),"i"(d0*4096+ks*1024+512):"memory");}
    asm volatile("s_waitcnt lgkmcnt(0)":::"memory");SBAR();
    #define PK(k) (bf16x8){lo[k][0],lo[k][1],lo[k][2],lo[k][3],hi[k][0],hi[k][1],hi[k][2],hi[k][3]}
    o[d0]=__builtin_amdgcn_mfma_f32_32x32x16_bf16(pa0,PK(0),o[d0],0,0,0);
    o[d0]=__builtin_amdgcn_mfma_f32_32x32x16_bf16(pa1,PK(1),o[d0],0,0,0);
    o[d0]=__builtin_amdgcn_mfma_f32_32x32x16_bf16(pa2,PK(2),o[d0],0,0,0);
    o[d0]=__builtin_amdgcn_mfma_f32_32x32x16_bf16(pa3,PK(3),o[d0],0,0,0);
    #undef PK
  }
}

#ifndef ATTN_STORE16
#define ATTN_STORE16(p,v) (*(u32x4*)(p)=(v))
#endif
template<int THRL> __device__ __forceinline__ void attn_unit(int qb,const bf16*Qh,const bf16*__restrict__ Kh,const bf16*__restrict__ Vh,bf16*Oh,char*shm){
  const int tid=threadIdx.x,lane=tid&63,r32=lane&31,hi=lane>>5; const int wid=__builtin_amdgcn_readfirstlane(tid>>6);
  const int q0=qb*QB;
  const bf16*Qw=Qh+(long)(q0+wid*QBLK)*LDP;
  const unsigned lds0=(unsigned)(uintptr_t)shm;
  float*wsf=(float*)(shm+LDS_WS)+wid*64;
  const bf16*ksrc=Kh+(long)lane*LDP+wid*8;
  const bf16*vsrc=Vh+(long)(16*(wid&3)+(lane>>2))*LDP+(wid>>2)*32+(lane&3)*8;
  const unsigned kdst=lds0+LDS_K+wid*1024, vdst=lds0+LDS_V+wid*1024;
  #define DMA_K(t,slot) glds16(ksrc+(long)(t)*KVBLK*LDP,(unsigned)__builtin_amdgcn_readfirstlane(kdst+(slot)))
  #define DMA_V(t,slot) glds16(vsrc+(long)(t)*KVBLK*LDP,(unsigned)__builtin_amdgcn_readfirstlane(vdst+(slot)))
  const int vb0=(int)(lds0+LDS_V)+((lane>>4)&1)*32+(lane&3)*8+(4*hi+((lane&15)>>2))*64;
  const char*Kbase=shm+LDS_K; bf16x8 kf[8];
  const lds_cptr shm3=(lds_cptr)shm; const lds_cptr kp0=shm3+LDS_K+hi*1024+r32*16; const lds_cptr vp0=shm3+LDS_V+((lane>>4)&1)*32+(lane&3)*8+(4*hi+((lane&15)>>2))*64;
  const int NT=(q0+QB)/KVBLK;
  DMA_K(0,0);DMA_V(0,0);DMA_K(1,SLOTB);
  bf16x8 qr[4];
  #pragma unroll
  for(int d0=0;d0<4;++d0)qr[d0]=*reinterpret_cast<const bf16x8*>(&Qw[(long)r32*LDP+d0*16+hi*8]);
  float mhat=0.f,l_reg=0.f;f32x16 o[2];o[0]=f32x16{};o[1]=f32x16{};
  const int qrel=wid*QBLK+r32;
  #define CMASK(P0,P1,t) do{int jb_=(t)-(NT-4); if(jb_>=0)cmask(P0,P1,jb_,qrel,hi);}while(0)
  bool resc=false;
  #define START(P0,P1) do{ const float rm=rowmax(P0,P1); resc=false; mhat=rm; \
    _Pragma("unroll") for(int r=0;r<16;++r)P0[r]=__builtin_amdgcn_exp2f(fsub_s(P0[r],mhat)); }while(0)
  #define RESC() do{ if(resc){ asm volatile("s_waitcnt lgkmcnt(0)":::"memory"); \
      _Pragma("unroll") for(int d_=0;d_<2;++d_) _Pragma("unroll") for(int r=0;r<16;++r)o[d_][r]*=wsf[crow(r,hi)]; } }while(0)
  f32x16 pA0,pA1,pB0,pB1;
  int sl_prev=0,sl_cur=0,sl_next=SLOTB;
  #define ROT() do{sl_prev=sl_cur;sl_cur=sl_next;sl_next=(sl_next==(NSLOT-1)*SLOTB)?0:sl_next+SLOTB;}while(0)
  DMA_K(2,2*SLOTB);
  WAIT_BAR(3);
  qkt(pA0,pA1,Kbase,qr,r32,hi);asm volatile("s_nop 15\n\ts_nop 7":"+v"(pA0),"+v"(pA1));CMASK(pA0,pA1,0);
  START(pA0,pA1);
  _Pragma("unroll") for(int r=0;r<16;++r)pA1[r]=__builtin_amdgcn_exp2f(pA1[r]-mhat);
  WAIT_BAR(0);
  DMA_K(3,0);DMA_V(1,SLOTB);
  ROT();
  kload8(kf,kp0+sl_cur);
  WAIT_BAR(2);
  s16x4 vlo[8],vhi[8]; u32x4 pw0,pw1,pw2,pw3;
  #define PKW(P,B) cvtpk_s(P[B],P[B+1])
  #define PAF(k) __builtin_bit_cast(bf16x8,pw##k)
  #define VFR(i) (bf16x8){vlo[i][0],vlo[i][1],vlo[i][2],vlo[i][3],vhi[i][0],vhi[i][1],vhi[i][2],vhi[i][3]}
  #define PIN(x) asm volatile("":"+v"(x))
  #define MX3(a,b,c) __builtin_fmaxf(__builtin_fmaxf((a),(b)),(c))
  #define GAPA(MF,A0,A1,A2,A3,W0,W1,PW) do{ MF; sacc+=A0; sacc+=A1; sacc+=A2; sacc+=A3; PIN(sacc); W0; W1; PIN(PW); SBAR(); }while(0)
  #define EX(v) __builtin_amdgcn_exp2f(v)
  #define GAPB(MF,X,B) do{ MF; X[B]=EX(X[B]-mhat); X[B+1]=EX(X[B+1]-mhat); X[B+2]=EX(X[B+2]-mhat); X[B+3]=EX(X[B+3]-mhat); PIN(X); SBAR(); }while(0)
  #define VRD(i) do{ vlo[i]=vtr(vp_+(((i)>>2)*4096+((i)&3)*1024)); vhi[i]=vtr(vp_+(((i)>>2)*4096+((i)&3)*1024+512)); }while(0)
  #define KRD(G,j) do{ if(G){ kload2(kf,kp0+sl_next,j); SBAR(); } }while(0)
  #define STEP(C0,C1,P0,P1,t,GK,GV,GL) do{ SBAR(); \
    const lds_cptr vp_=vp0+sl_prev; \
    VRD(0); SBAR(); float sacc=(P0[0]+P0[1]); \
    GAPA(C0=__builtin_amdgcn_mfma_f32_32x32x16_bf16(kf[0],qr[0],f32x16{},0,0,0), P0[2],P0[3],P0[4],P0[5],     pw0[0]=PKW(P0,0), pw0[1]=PKW(P0,2), pw0); \
    VRD(4); SBAR(); GAPA(C1=__builtin_amdgcn_mfma_f32_32x32x16_bf16(kf[1],qr[0],f32x16{},0,0,0), P0[6],P0[7],P0[8],P0[9],     pw0[2]=PKW(P0,4), pw0[3]=PKW(P0,6), pw0); \
    VRD(1); SBAR(); GAPA(C0=__builtin_amdgcn_mfma_f32_32x32x16_bf16(kf[2],qr[1],C0,0,0,0),   P0[10],P0[11],P0[12],P0[13], pw1[0]=PKW(P0,8), pw1[1]=PKW(P0,10), pw1); \
    VRD(5); SBAR(); GAPA(C1=__builtin_amdgcn_mfma_f32_32x32x16_bf16(kf[3],qr[1],C1,0,0,0),   P0[14],P0[15],P1[0],P1[1],   pw1[2]=PKW(P0,12),pw1[3]=PKW(P0,14), pw1); \
    VRD(2); SBAR(); GAPA(C0=__builtin_amdgcn_mfma_f32_32x32x16_bf16(kf[4],qr[2],C0,0,0,0),   P1[2],P1[3],P1[4],P1[5],     pw2[0]=PKW(P1,0), pw2[1]=PKW(P1,2), pw2); \
    VRD(6); SBAR(); GAPA(C1=__builtin_amdgcn_mfma_f32_32x32x16_bf16(kf[5],qr[2],C1,0,0,0),   P1[6],P1[7],P1[8],P1[9],     pw2[2]=PKW(P1,4), pw2[3]=PKW(P1,6), pw2); \
    VRD(3); SBAR(); GAPA(C0=__builtin_amdgcn_mfma_f32_32x32x16_bf16(kf[6],qr[3],C0,0,0,0),   P1[10],P1[11],P1[12],P1[13], pw3[0]=PKW(P1,8), pw3[1]=PKW(P1,10), pw3); \
    VRD(7); SBAR(); GAPA(C1=__builtin_amdgcn_mfma_f32_32x32x16_bf16(kf[7],qr[3],C1,0,0,0),   P1[14],P1[15],0.f,0.f,       pw3[2]=PKW(P1,12),pw3[3]=PKW(P1,14), pw3); \
    l_reg+=sacc; \
    if(GK){DMA_K((t)+3,sl_cur);} if(GV){DMA_V((t)+1,sl_next);} \
    CMASK(C0,C1,t); \
    { float a=MX3(C0[0],C0[1],C1[0]),b=MX3(C0[2],C0[3],C1[1]); a=MX3(a,C1[2],C1[3]); \
      _Pragma("unroll") for(int r=4;r<16;r+=4){a=MX3(a,C0[r],C0[r+1]);b=MX3(b,C0[r+2],C0[r+3]);a=MX3(a,C1[r],C1[r+1]);b=MX3(b,C1[r+2],C1[r+3]);} \
      float rm=__builtin_fmaxf(a,b); { auto rr=__builtin_amdgcn_permlane32_swap(__float_as_uint(rm),__float_as_uint(rm),false,false); rm=__builtin_fmaxf(__uint_as_float(rr[0]),__uint_as_float(rr[1])); } \
      resc=false; const float rel=rm-mhat; \
      if(__builtin_expect(__any(rel>(float)THRL),0)){ const float dl=__builtin_fmaxf(rel,0.f); mhat+=dl; \
        const float f=__builtin_amdgcn_exp2f(-dl); l_reg*=f; if(hi==0)wsf[r32]=f; resc=true; } } \
    SBAR(); \
    GAPB(o[0]=__builtin_amdgcn_mfma_f32_32x32x16_bf16(PAF(0),VFR(0),o[0],0,0,0), C0,0); \
    GAPB(o[1]=__builtin_amdgcn_mfma_f32_32x32x16_bf16(PAF(0),VFR(4),o[1],0,0,0), C0,4); \
    KRD(GL,0); GAPB(o[0]=__builtin_amdgcn_mfma_f32_32x32x16_bf16(PAF(1),VFR(1),o[0],0,0,0), C0,8); \
    KRD(GL,1); GAPB(o[1]=__builtin_amdgcn_mfma_f32_32x32x16_bf16(PAF(1),VFR(5),o[1],0,0,0), C0,12); \
    KRD(GL,2); GAPB(o[0]=__builtin_amdgcn_mfma_f32_32x32x16_bf16(PAF(2),VFR(2),o[0],0,0,0), C1,0); \
    KRD(GL,3); GAPB(o[1]=__builtin_amdgcn_mfma_f32_32x32x16_bf16(PAF(2),VFR(6),o[1],0,0,0), C1,4); \
    GAPB(o[0]=__builtin_amdgcn_mfma_f32_32x32x16_bf16(PAF(3),VFR(3),o[0],0,0,0), C1,8); \
    GAPB(o[1]=__builtin_amdgcn_mfma_f32_32x32x16_bf16(PAF(3),VFR(7),o[1],0,0,0), C1,12); \
    }while(0)
  int t=1;
  #undef CMASK
  #define CMASK(P0,P1,t) do{}while(0)
  for(;t+5<NT;t+=2){
    STEP(pB0,pB1,pA0,pA1,t,true,true,true);     WAIT_BAR(2); RESC(); ROT();
    STEP(pA0,pA1,pB0,pB1,t+1,true,true,true);   WAIT_BAR(2); RESC(); ROT();
  }
  #undef CMASK
  int hi_b=hi,qrel_b=qrel; asm volatile("":"+v"(hi_b),"+v"(qrel_b));
  #define CMASK(P0,P1,t) do{int jb_=(t)-(NT-4); if(jb_>=0)cmask(P0,P1,jb_,qrel_b,hi_b);}while(0)
  #define ENDW(tt) do{ if((tt)+3<NT){WAIT_BAR(2);} else if((tt)+2<NT){WAIT_BAR(1);} else {WAIT_BAR(0);} }while(0)
  for(;t+1<NT;t+=2){
    STEP(pB0,pB1,pA0,pA1,t,(t+3<NT),(t+1<NT),(t+1<NT));       ENDW(t);   RESC(); ROT();
    STEP(pA0,pA1,pB0,pB1,t+1,(t+4<NT),(t+2<NT),(t+2<NT));     ENDW(t+1); RESC(); ROT();
  }
  STEP(pB0,pB1,pA0,pA1,NT-1,false,false,false); RESC();
  { float sacc=pB0[0]+pB0[1]; _Pragma("unroll") for(int r=2;r<16;++r)sacc+=pB0[r]; _Pragma("unroll") for(int r=0;r<16;++r)sacc+=pB1[r]; l_reg+=sacc;
    pw0=(u32x4){PKW(pB0,0),PKW(pB0,2),PKW(pB0,4),PKW(pB0,6)};pw1=(u32x4){PKW(pB0,8),PKW(pB0,10),PKW(pB0,12),PKW(pB0,14)};pw2=(u32x4){PKW(pB1,0),PKW(pB1,2),PKW(pB1,4),PKW(pB1,6)};pw3=(u32x4){PKW(pB1,8),PKW(pB1,10),PKW(pB1,12),PKW(pB1,14)};
    SBAR(); pv(o,vb0+sl_cur,PAF(0),PAF(1),PAF(2),PAF(3)); }
  #undef PKW
  #undef PAF
  #undef VFR
  #undef PIN
  #undef MX3
  #undef GAPA
  #undef GAPB
  #undef EX
  #undef VRD
  #undef KRD
  #undef STEP
  #undef ENDW
  {auto rr=__builtin_amdgcn_permlane32_swap(__float_as_uint(l_reg),__float_as_uint(l_reg),false,false);l_reg=__uint_as_float(rr[0])+__uint_as_float(rr[1]);}
  if(hi==0)wsf[32+r32]=l_reg;asm volatile("s_waitcnt lgkmcnt(0)":::"memory");
  float rli[16];
  #pragma unroll
  for(int r=0;r<16;++r)rli[r]=__builtin_amdgcn_rcpf(wsf[32+crow(r,hi)]);
  bf16*Ow=Oh+(long)(q0+wid*QBLK)*LDO;
  { bf16*stg=(bf16*)(shm+LDS_OST)+wid*2048;
    #pragma unroll
    for(int r=0;r<16;++r){const int orow=crow(r,hi);
      #pragma unroll
      for(int d0=0;d0<2;++d0)stg[orow*64+d0*32+r32]=__float2bfloat16(o[d0][r]*rli[r]);}
    asm volatile("s_waitcnt lgkmcnt(0)":::"memory");
    #pragma unroll
    for(int i=0;i<4;++i){const int row=i*8+(lane>>3),ch=lane&7; const u32x4 v=*(const u32x4*)(stg+row*64+ch*8); ATTN_STORE16(Ow+(long)row*LDO+ch*8,v);} }
  asm volatile("s_waitcnt lgkmcnt(0)\n\ts_barrier":::"memory");
  #undef DMA_K
  #undef DMA_V
  #undef CMASK
  #undef START
  #undef RESC
  #undef ROT
}
constexpr int ATTN_LDS_BYTES=LDS_BYTES;
template<int THRL=8> __device__ __forceinline__ void attn_phase(char*lds,const bf16*PE,bf16*AO,int vcu,int G){
  const int nu=(G==256)?4:((16*NQB-vcu+G-1)/G);
  #pragma unroll 1
  for(int i=0;i<nu;++i){
    int vh,qb;
    if(G==256){ const int s=vcu&15; vh=vcu>>4; qb=(i==0)?s:(i==1)?31-s:(i==2)?32+s:63-s; }
    else { const int u=vcu+i*G; vh=u/NQB; qb=u%NQB; }
    const int h2=vh>>1,half=vh&1;
    attn_unit<THRL>(qb,PE+h2*64,PE+512+h2*64,PE+1024+(h2>>1)*128+half*64,AO+vh*64,lds);
  }
}
#undef SBAR
#undef WAIT_BAR
}

#define GAS __attribute__((address_space(1)))
#define LAS __attribute__((address_space(3)))
typedef unsigned short bf16;
typedef unsigned v4u __attribute__((ext_vector_type(4)));
typedef float f32x4 __attribute__((ext_vector_type(4)));
typedef short bf16x8 __attribute__((ext_vector_type(8)));
typedef GAS unsigned gu32;
typedef GAS unsigned long long gu64;
#define RLX_AGENT __ATOMIC_RELAXED, __HIP_MEMORY_SCOPE_AGENT
#define LDS_WAIT() asm volatile("s_waitcnt lgkmcnt(0)" ::: "memory")
#define VM_WAIT() asm volatile("s_waitcnt vmcnt(0)" ::: "memory")
__device__ __forceinline__ unsigned long long rt() { return __builtin_amdgcn_s_memrealtime(); }
__device__ __forceinline__ unsigned f2bf(float f) { unsigned u = __builtin_bit_cast(unsigned, f); return (u + 0x7fffu + ((u >> 16) & 1u)) >> 16; }
__device__ __forceinline__ unsigned pk2(float lo, float hi) { return f2bf(lo) | (f2bf(hi) << 16); }

#define XB_TMO      128
#define XB_XCNT(j)  (256  + 64 * (j))
#define XB_XSUB(j)  (1280 + 64 * (j))
#define XB_XGEN(j)  (2304 + 64 * (j))
#define XB_TOP      3328
#define XB_TOPGEN   3392
#define XCD_BAR_WORDS 3456
#define XB_SPIN_CAP (1u << 18)

__device__ __forceinline__ unsigned xb_ld(unsigned* p)              { return __hip_atomic_load(p, __ATOMIC_RELAXED, __HIP_MEMORY_SCOPE_AGENT); }
__device__ __forceinline__ unsigned xb_add(unsigned* p, unsigned v) { return __hip_atomic_fetch_add(p, v, __ATOMIC_RELAXED, __HIP_MEMORY_SCOPE_AGENT); }
__device__ __forceinline__ unsigned xb_xcc_id() { return (unsigned)__builtin_amdgcn_s_getreg((3 << 11) | 20) & 0xFu; }
#define XB_SPIN(cond, bar) do { unsigned _sp = 0; while (cond) { __builtin_amdgcn_s_sleep(1); \
    if ((++_sp & 255u) == 0u) { if (xb_ld(&(bar)[XB_TMO])) break; if (_sp > XB_SPIN_CAP) { atomicAdd(&(bar)[XB_TMO], 1u); break; } } } } while (0)

struct XcdBarrier {
    unsigned* bar; unsigned x;
    volatile LAS unsigned* st;
};

__device__ __forceinline__ XcdBarrier xcd_barrier_post(unsigned* bar, volatile LAS unsigned* st) {
    XcdBarrier b; b.bar = bar; b.x = xb_xcc_id(); b.st = st;
    if (threadIdx.x == 0) (void)xb_add(&bar[XB_XCNT(b.x)], 1u);
    return b;
}
__device__ __forceinline__ void xcd_barrier_complete(unsigned* bar, unsigned x, unsigned& nloc, unsigned& nx) {
    const unsigned G = gridDim.x * gridDim.y * gridDim.z;
    unsigned sum, cnt, mine, sp = 0u;
    for (;;) {
        sum = 0u; cnt = 0u; mine = 0u;
#pragma unroll
        for (unsigned j = 0; j < 16; ++j) { const unsigned c = xb_ld(&bar[XB_XCNT(j)]); sum += c; cnt += (c > 0u) ? 1u : 0u; mine = (j == x) ? c : mine; }
        if (sum == G) break;
        __builtin_amdgcn_s_sleep(1);
        if ((++sp & 255u) == 0u) { if (xb_ld(&bar[XB_TMO])) break; if (sp > XB_SPIN_CAP) { atomicAdd(&bar[XB_TMO], 1u); break; } }
    }
    nloc = mine > 0u ? mine : 1u; nx = cnt > 0u ? cnt : 1u;
}

__device__ __forceinline__ void xcd_barrier(const XcdBarrier& b) {
    asm volatile("s_waitcnt vmcnt(0)" ::: "memory");
    __syncthreads();
    if (threadIdx.x == 0) {
        unsigned* bar = b.bar;
        __builtin_amdgcn_s_waitcnt(0);
        unsigned nloc = b.st[0], nx = b.st[1];
        if (nloc == 0u) { xcd_barrier_complete(bar, b.x, nloc, nx); b.st[0] = nloc; b.st[1] = nx; }
        const unsigned old = xb_add(&bar[XB_XSUB(b.x)], 1u);
        const unsigned gen = old / nloc;
        if (old + 1u == (gen + 1u) * nloc) {
            __builtin_amdgcn_fence(__ATOMIC_RELEASE, "agent");
            asm volatile("s_waitcnt vmcnt(0)" ::: "memory");
            const unsigned og = xb_add(&bar[XB_TOP], 1u);
            const unsigned tg = og / nx;
            if (og + 1u == (tg + 1u) * nx) xb_add(&bar[XB_TOPGEN], 1u);
            else XB_SPIN(xb_ld(&bar[XB_TOPGEN]) == tg, bar);
            __builtin_amdgcn_fence(__ATOMIC_ACQUIRE, "agent");
            xb_add(&bar[XB_XGEN(b.x)], 1u);
            asm volatile("s_waitcnt vmcnt(0)" ::: "memory");
        } else {
            XB_SPIN(xb_ld(&bar[XB_XGEN(b.x)]) == gen, bar);
            __builtin_amdgcn_fence(__ATOMIC_ACQUIRE, "agent");
            asm volatile("s_waitcnt vmcnt(0)" ::: "memory");
        }
    }
    __syncthreads();
}

constexpr int NWAVES = 8;
constexpr size_t MiB = 1u << 20;
constexpr size_t WS_CTL = 0, CTL_ZERO_BYTES = 1 * MiB;
constexpr size_t WS_TAB = 1 * MiB;
constexpr size_t WS_SSQA = 2 * MiB, WS_SSQB = 3 * MiB;
constexpr size_t WS_GB = 4 * MiB;
constexpr size_t WS_GC = 512 * 1024;
constexpr size_t WS_TOK = 5 * MiB;
constexpr size_t WS_W = 6 * MiB;
constexpr size_t WS_WINE = WS_W, WS_WOUTE = WS_W + 12 * MiB, WS_W13D = WS_W + 16 * MiB, WS_W2D = WS_W + 44 * MiB, WS_WINO = WS_W + 58 * MiB, WS_WOUTO = WS_W + 74 * MiB,
                 WS_WG = WS_W + 78 * MiB, WS_WP = WS_W + 86 * MiB, WS_W13M = WS_W + 88 * MiB, WS_W2M = WS_W + 200 * MiB;
constexpr size_t WS_PBF = 262 * MiB, WS_HBF = 294 * MiB, WS_PP = 326 * MiB, WS_MIX = 358 * MiB, WS_ARENA = 390 * MiB;
constexpr size_t AR_PE = 0, AR_AO = 96 * MiB;
constexpr size_t AR_PO = 0, AR_QN = 128 * MiB, AR_QT = 160 * MiB, AR_KN = 192 * MiB, AR_KGT = 224 * MiB, AR_VBT = 256 * MiB, AR_KTT = 288 * MiB, AR_AI = 320 * MiB, AR_NEGW = 336 * MiB,
                 AR_UT = 368 * MiB, AR_MP = 400 * MiB, AR_NT = 464 * MiB, AR_WT = 528 * MiB, AR_SG = 192 * MiB  , AR_END = 560 * MiB;
constexpr size_t AR_ACT = 0, AR_XS = 240 * MiB, AR_Y = 308 * MiB;
constexpr size_t WS_NEED = WS_ARENA + AR_END;
constexpr size_t TOK_E = 0, TOK_R = 128 * 1024, TOK_G = 256 * 1024, TOK_DST = 384 * 1024, TOK_GPAD = 512 * 1024, TOK_DN = 704 * 1024;
constexpr int CW_TMO = 0, CW_BAR = 4096, CW_CNT = 8192  , CW_DBG = 12288;

constexpr int RING_OFF = 0, WAVE_LDS = 17408;
constexpr int LDSCTL_OFF = 139264, MISC_OFF = LDSCTL_OFF + 64, BLKE_OFF = LDSCTL_OFF + 256  , RT_OFF = LDSCTL_OFF + 1024  ;
constexpr int LDS_BYTES = 147456;

typedef unsigned u32x2v __attribute__((ext_vector_type(2)));
__device__ __forceinline__ float bflo(unsigned w) { return __uint_as_float(w << 16); }
__device__ __forceinline__ float bfhi(unsigned w) { return __uint_as_float(w & 0xffff0000u); }
__device__ __forceinline__ unsigned cvtpk(float lo, float hi) { return pg8::cvt_pk_bf16_cv(lo, hi); }
__device__ __forceinline__ float wave_sum(float v) {
#pragma unroll
    for (int o = 1; o < 64; o <<= 1) v += __shfl_xor(v, o);
    return v;
}
__device__ __forceinline__ float sigm(float x) { return pg8::sigmoidf_(x); }
__device__ __forceinline__ float silu(float x) { return x * pg8::sigmoidf_(x); }

struct Args { const void* in[30]; float* out; unsigned char* ws; int ph_lo, ph_hi, use_bar, pad; };

struct Frame {
    LAS unsigned char* lds; int tid, lane, wave, vcu, G, gw, NGW;
};

__device__ __forceinline__ void xpose_item(const float* W, int ldw, int K, int N, const float* gain, bf16* WT, int ilv, LAS float* scr, int item, int lane) {
    const int nblk = N / 64, kb = item / nblk, nb = item % nblk, k0 = 64 * kb, n0 = 64 * nb;
    const int lr = lane >> 4, lc = (lane & 15) * 4;
    f32x4 v[16];
#pragma unroll
    for (int i = 0; i < 16; ++i) v[i] = *(const GAS f32x4*)(W + (size_t)(k0 + 4 * i + lr) * ldw + n0 + lc);
    if (gain) {
#pragma unroll
        for (int i = 0; i < 16; ++i) v[i] = v[i] * gain[k0 + 4 * i + lr]; }
#pragma unroll
    for (int i = 0; i < 16; ++i) { LAS float* s = scr + (4 * i + lr) * 65 + lc; s[0] = v[i][0]; s[1] = v[i][1]; s[2] = v[i][2]; s[3] = v[i][3]; }
    LDS_WAIT(); asm volatile("" ::: "memory");
    const int c = lane & 7;
#pragma unroll
    for (int j = 0; j < 8; ++j) { const int nl = (lane >> 3) + 8 * j, n = n0 + nl; const LAS float* s = scr + (8 * c) * 65 + nl;
        const int dr = ilv ? (((n >> 7) << 8) + (n & 127) + (ilv == 2 ? 128 : 0)) : n;
        v4u o; o.x = pk2(s[0 * 65], s[1 * 65]); o.y = pk2(s[2 * 65], s[3 * 65]); o.z = pk2(s[4 * 65], s[5 * 65]); o.w = pk2(s[6 * 65], s[7 * 65]);
        *(GAS v4u*)(WT + (size_t)dr * K + k0 + 8 * c) = o; }
    LDS_WAIT(); asm volatile("" ::: "memory");
}
struct MatD { const float* W; int ldw, K, N; const float* gain; bf16* WT; int ilv; int items; };
__device__ __forceinline__ MatD dense_mat(const Args& a, int id) {
    unsigned char* ws = a.ws; MatD m; m.gain = nullptr; m.ilv = 0;
    if (id < 2)       { const int j = id;      m.W = (const float*)a.in[7] + (size_t)j * D_ * EIN;    m.ldw = EIN; m.K = D_; m.N = EIN; m.gain = (const float*)a.in[3] + (2 * j) * D_; m.WT = (bf16*)(ws + WS_WINE) + (size_t)j * EIN * D_; }
    else if (id < 4)  { const int j = id - 2;  m.W = (const float*)a.in[8] + (size_t)j * D_ * D_;     m.ldw = D_; m.K = D_; m.N = D_; m.WT = (bf16*)(ws + WS_WOUTE) + (size_t)j * D_ * D_; }
    else if (id < 6)  { const int j = id - 4;  m.W = (const float*)a.in[21] + (size_t)j * D_ * DFF;   m.ldw = DFF; m.K = D_; m.N = DFF; m.gain = (const float*)a.in[4] + (2 * j) * D_; m.WT = (bf16*)(ws + WS_W13D) + (size_t)j * 2 * DFF * D_; m.ilv = 1; }
    else if (id < 8)  { const int j = id - 6;  m.W = (const float*)a.in[22] + (size_t)j * D_ * DFF;   m.ldw = DFF; m.K = D_; m.N = DFF; m.gain = (const float*)a.in[4] + (2 * j) * D_; m.WT = (bf16*)(ws + WS_W13D) + (size_t)j * 2 * DFF * D_; m.ilv = 2; }
    else if (id < 10) { const int j = id - 8;  m.W = (const float*)a.in[23] + (size_t)j * DFF * D_;   m.ldw = D_; m.K = DFF; m.N = D_; m.WT = (bf16*)(ws + WS_W2D) + (size_t)j * D_ * DFF; }
    else if (id < 12) { const int j = id - 10; m.W = (const float*)a.in[15] + (size_t)j * D_ * OIN_SRC; m.ldw = OIN_SRC; m.K = D_; m.N = OIN; m.gain = (const float*)a.in[3] + (2 * j + 1) * D_; m.WT = (bf16*)(ws + WS_WINO) + (size_t)j * OIN * D_; }
    else if (id < 14) { const int j = id - 12; m.W = (const float*)a.in[20] + (size_t)j * D_ * D_;    m.ldw = D_; m.K = D_; m.N = D_; m.WT = (bf16*)(ws + WS_WOUTO) + (size_t)j * D_ * D_; }
    else if (id < 18) { const int i = id - 14; m.W = (const float*)a.in[28] + (size_t)i * D_ * D_;    m.ldw = D_; m.K = D_; m.N = D_; m.gain = (const float*)a.in[5] + i * D_; m.WT = (bf16*)(ws + WS_WG) + (size_t)i * D_ * D_; }
    else              { const int i = id - 18; m.W = (const float*)a.in[29] + (size_t)i * PLE * D_;   m.ldw = D_; m.K = PLE; m.N = D_; m.WT = (bf16*)(ws + WS_WP) + (size_t)i * D_ * PLE; }
    m.items = (m.K / 64) * (m.N / 64); return m;
}
__device__ __forceinline__ MatD moe_mat(const Args& a, int j, int id) {
    unsigned char* ws = a.ws; MatD m; m.gain = nullptr; m.ilv = 0; const int e = id / 3, k = id % 3;
    if (k < 2) { m.W = (const float*)a.in[25 + k] + ((size_t)j * NEXP + e) * D_ * DFF; m.ldw = DFF; m.K = D_; m.N = DFF; m.gain = (const float*)a.in[4] + (2 * j + 1) * D_; m.WT = (bf16*)(ws + WS_W13M) + (size_t)e * 2 * DFF * D_; m.ilv = 1 + k; }
    else       { m.W = (const float*)a.in[27] + ((size_t)j * NEXP + e) * DFF * D_; m.ldw = D_; m.K = DFF; m.N = D_; m.WT = (bf16*)(ws + WS_W2M) + (size_t)e * D_ * DFF; }
    m.items = (m.K / 64) * (m.N / 64); return m;
}

__device__ __forceinline__ void p_prologue(const Frame& F, const Args& a) {
    LAS float* scr = (LAS float*)(F.lds + F.wave * WAVE_LDS);
    unsigned char* ws = a.ws;
    {
        int base = 0;
#pragma unroll 1
        for (int id = 0; id < 22; ++id) { const MatD m = dense_mat(a, id);
            int first = (F.gw - base) % F.NGW; if (first < 0) first += F.NGW;
#pragma unroll 1
            for (int it = first; it < m.items; it += F.NGW) xpose_item(m.W, m.ldw, m.K, m.N, m.gain, m.WT, m.ilv, scr, it, F.lane);
            base += m.items; }
    }
    { const float* p = (const float*)a.in[1]; bf16* pb = (bf16*)(ws + WS_PBF); const size_t n8 = (size_t)DEPTH_ * S_ * PLE / 8;
#pragma unroll 1
      for (size_t i = (size_t)F.gw * 64 + F.lane; i < n8; i += (size_t)F.NGW * 64) { const f32x4 x0 = *(const GAS f32x4*)(p + i * 8), x1 = *(const GAS f32x4*)(p + i * 8 + 4);
          v4u o; o.x = cvtpk(x0[0], x0[1]); o.y = cvtpk(x0[2], x0[3]); o.z = cvtpk(x1[0], x1[1]); o.w = cvtpk(x1[2], x1[3]); *(GAS v4u*)(pb + i * 8) = o; } }
    { const float* x = (const float*)a.in[0]; bf16* hb = (bf16*)(ws + WS_HBF); float* ssq = (float*)(ws + WS_SSQB);
#pragma unroll 1
      for (int m = F.gw; m < S_; m += F.NGW) { const GAS f32x4* xr = (const GAS f32x4*)(x + (size_t)m * D_) + F.lane; float s = 0.f;
#pragma unroll
          for (int j = 0; j < 4; ++j) { const f32x4 v = xr[64 * j]; s += (v[0] * v[0] + v[1] * v[1]) + (v[2] * v[2] + v[3] * v[3]);
              *((GAS f32x4*)(a.out + (size_t)m * D_) + F.lane + 64 * j) = v;
              u32x2v o; o.x = cvtpk(v[0], v[1]); o.y = cvtpk(v[2], v[3]); *((GAS u32x2v*)(hb + (size_t)m * D_) + F.lane + 64 * j) = o; }
          s = wave_sum(s);
          if (F.lane < 16) ssq[(size_t)m * 16 + F.lane] = (F.lane == 0) ? s : 0.f; } }
    { const int* pos = (const int*)a.in[2]; float* tab = (float*)(ws + WS_TAB);
#pragma unroll 1
      for (int idx = F.gw * 64 + F.lane; idx < S_ * 8; idx += F.NGW * 64) { const int row = idx >> 3, i = idx & 7;
          const float inv = exp2f(-(float)i * (18.931568569324174f / 8.0f));
          const float ang = (float)pos[row] * inv;
          double t = (double)ang * 0.15915494309189535; t -= rint(t); const float tf = (float)t;
          tab[(size_t)row * 16 + i] = __builtin_amdgcn_cosf(tf); tab[(size_t)row * 16 + 8 + i] = __builtin_amdgcn_sinf(tf); } }
}

__device__ __forceinline__ void p_mixprep(const Frame& F, const Args& a, int L) {
    GAS unsigned char* ws = (GAS unsigned char*)a.ws; asm volatile("" : "+s"(ws)); int lane_ = F.lane; asm volatile("" : "+v"(lane_)); const int j = L >> 1, lane = lane_;
    const bf16* AO = (const bf16*)(ws + WS_ARENA + AR_AO); const bf16* PE = (const bf16*)(ws + WS_ARENA + AR_PE); bf16* mix = (bf16*)(ws + WS_MIX);
    const float lam0 = 0.8f - 0.6f * expf(-0.3f * (float)L);
    float s1 = ((const float*)a.in[9])[j * 64 + lane] * ((const float*)a.in[10])[j * 64 + lane], s2 = ((const float*)a.in[11])[j * 64 + lane] * ((const float*)a.in[12])[j * 64 + lane];
    s1 = wave_sum(s1); s2 = wave_sum(s2);
    const float lam = expf(s1) - expf(s2) + lam0, post = 1.0f - lam0;
    const int hh = lane >> 4, dd = (lane & 15) * 8, ch = lane * 8;
    float sg[8], w0[8], w1[8], w2[8];
#pragma unroll
    for (int e = 0; e < 8; ++e) { sg[e] = ((const float*)a.in[13])[j * 128 + dd + e] * post;
        w0[e] = ((const float*)a.in[14])[(j * 3 + 0) * 512 + ch + e]; w1[e] = ((const float*)a.in[14])[(j * 3 + 1) * 512 + ch + e]; w2[e] = ((const float*)a.in[14])[(j * 3 + 2) * 512 + ch + e]; }
#pragma unroll 1
    for (int t = F.gw; t < S_; t += F.NGW) {
        const v4u o1 = *(const GAS v4u*)(AO + (size_t)t * D_ + 256 * hh + dd), o2 = *(const GAS v4u*)(AO + (size_t)t * D_ + 256 * hh + 128 + dd);
        float d[8]; const unsigned a1[4] = {o1.x, o1.y, o1.z, o1.w}, a2[4] = {o2.x, o2.y, o2.z, o2.w}; float ss = 0.f;
#pragma unroll
        for (int q = 0; q < 4; ++q) { d[2 * q] = bflo(a1[q]) - lam * bflo(a2[q]); d[2 * q + 1] = bfhi(a1[q]) - lam * bfhi(a2[q]); ss += d[2 * q] * d[2 * q] + d[2 * q + 1] * d[2 * q + 1]; }
        ss += __shfl_xor(ss, 1); ss += __shfl_xor(ss, 2); ss += __shfl_xor(ss, 4); ss += __shfl_xor(ss, 8);
        const float rms = __builtin_amdgcn_rsqf(ss * (1.0f / 128.0f) + 1e-5f);
        v4u o; o.x = cvtpk(d[0] * rms * sg[0], d[1] * rms * sg[1]); o.y = cvtpk(d[2] * rms * sg[2], d[3] * rms * sg[3]); o.z = cvtpk(d[4] * rms * sg[4], d[5] * rms * sg[5]); o.w = cvtpk(d[6] * rms * sg[6], d[7] * rms * sg[7]);
        *(GAS v4u*)(mix + (size_t)t * D_ + hh * 128 + dd) = o;
        const bf16* r0 = PE + (size_t)t * EIN;
        const v4u bb = *(const GAS v4u*)(r0 + 1536 + ch), c0 = *(const GAS v4u*)(r0 + 2048 + ch), x0 = *(const GAS v4u*)(r0 + 2560 + ch);
        v4u c1 = {0u, 0u, 0u, 0u}, x1 = c1, c2 = c1, x2 = c1;
        if (t >= 1) { c1 = *(const GAS v4u*)(r0 - EIN + 2048 + ch); x1 = *(const GAS v4u*)(r0 - EIN + 2560 + ch); }
        if (t >= 2) { c2 = *(const GAS v4u*)(r0 - 2 * EIN + 2048 + ch); x2 = *(const GAS v4u*)(r0 - 2 * EIN + 2560 + ch); }
        const unsigned B[4] = {bb.x, bb.y, bb.z, bb.w}, C0[4] = {c0.x, c0.y, c0.z, c0.w}, X0[4] = {x0.x, x0.y, x0.z, x0.w}, C1[4] = {c1.x, c1.y, c1.z, c1.w}, X1[4] = {x1.x, x1.y, x1.z, x1.w},
                       C2[4] = {c2.x, c2.y, c2.z, c2.w}, X2[4] = {x2.x, x2.y, x2.z, x2.w};
        float sc[8];
#pragma unroll
        for (int q = 0; q < 4; ++q) {
            sc[2 * q] = bflo(B[q]) * (w2[2 * q] * (bflo(C0[q]) * bflo(X0[q])) + w1[2 * q] * (bflo(C1[q]) * bflo(X1[q])) + w0[2 * q] * (bflo(C2[q]) * bflo(X2[q])));
            sc[2 * q + 1] = bfhi(B[q]) * (w2[2 * q + 1] * (bfhi(C0[q]) * bfhi(X0[q])) + w1[2 * q + 1] * (bfhi(C1[q]) * bfhi(X1[q])) + w0[2 * q + 1] * (bfhi(C2[q]) * bfhi(X2[q]))); }
        v4u so; so.x = cvtpk(sc[0], sc[1]); so.y = cvtpk(sc[2], sc[3]); so.z = cvtpk(sc[4], sc[5]); so.w = cvtpk(sc[6], sc[7]);
        *(GAS v4u*)(mix + (size_t)t * D_ + 512 + ch) = so;
    }
}


__device__ __forceinline__ void p_rot(const Frame& F, const Args& a) {
    GAS unsigned char* ws = (GAS unsigned char*)a.ws; asm volatile("" : "+s"(ws)); int lane_ = F.lane; asm volatile("" : "+v"(lane_)); const int lane = lane_;
    bf16* PE = (bf16*)(ws + WS_ARENA + AR_PE); const float* tab = (const float*)(ws + WS_TAB);
    const int hd = lane >> 2, i0 = 2 * (lane & 3), col = (hd < 8 ? hd * 64 : 512 + (hd - 8) * 64) + i0;
#pragma unroll 1
    for (int t = F.gw; t < S_; t += F.NGW) {
        GAS unsigned* p1 = (GAS unsigned*)(PE + (size_t)t * EIN + col); GAS unsigned* p2 = (GAS unsigned*)(PE + (size_t)t * EIN + col + 8);
        const unsigned w1 = *p1, w2 = *p2;
        const float c0 = tab[(size_t)t * 16 + i0], c1 = tab[(size_t)t * 16 + i0 + 1], s0 = tab[(size_t)t * 16 + 8 + i0], s1 = tab[(size_t)t * 16 + 8 + i0 + 1];
        const float a0 = bflo(w1), a1 = bfhi(w1), b0 = bflo(w2), b1 = bfhi(w2);
        *p1 = cvtpk(a0 * c0 - b0 * s0, a1 * c1 - b1 * s1); *p2 = cvtpk(b0 * c0 + a0 * s0, b1 * c1 + a1 * s1);
    }
}
__device__ __forceinline__ void p_ab(const Frame& F, const Args& a, int L) {
    GAS unsigned char* ws = (GAS unsigned char*)a.ws; asm volatile("" : "+s"(ws)); int lane_ = F.lane; asm volatile("" : "+v"(lane_)); const int j = L >> 1, lane = lane_;
    LAS float* wl = (LAS float*)F.lds;
    const float* W = (const float*)a.in[15] + (size_t)j * D_ * OIN_SRC; const float* ln = (const float*)a.in[3] + L * D_;
    for (int idx = F.tid; idx < D_ * 16; idx += NWAVES * 64) { const int k = idx >> 4, c = idx & 15; wl[k * 20 + c] = ln[k] * W[(size_t)k * OIN_SRC + 4096 + c]; }
    __syncthreads();
    const float* ssq = (const float*)(ws + WS_SSQB); float* gg = (float*)(ws + WS_GB); float* gbeta = gg + S_ * 8;
    const float alog = ((const float*)a.in[17])[j * 8 + (lane & 7)], dtb = ((const float*)a.in[18])[j * 8 + (lane & 7)];
#pragma unroll 1
    for (int t = F.gw; t < S_; t += F.NGW) {
        const float rs = pg8::rstd_row(ssq, t); float acc[16];
#pragma unroll
        for (int c = 0; c < 16; ++c) acc[c] = 0.f;
#pragma unroll 4
        for (int i = 0; i < 16; ++i) { const int k = 64 * i + lane; const float x = a.out[(size_t)t * D_ + k];
            const LAS f32x4* wr = (const LAS f32x4*)(wl + k * 20);
#pragma unroll
            for (int q = 0; q < 4; ++q) { const f32x4 w = wr[q]; acc[4 * q] += x * w[0]; acc[4 * q + 1] += x * w[1]; acc[4 * q + 2] += x * w[2]; acc[4 * q + 3] += x * w[3]; } }
        float mine = 0.f;
#pragma unroll
        for (int c = 0; c < 16; ++c) { const float s = wave_sum(acc[c]); mine = ((lane & 15) == c) ? s : mine; }
        mine *= rs;
        if (lane < 8) gbeta[(size_t)t * 8 + lane] = sigm(mine);
        else if (lane < 16) { const float z = mine + dtb; const float sp = z > 20.f ? z : log1pf(expf(z)); gg[(size_t)t * 8 + lane - 8] = -expf(alog) * sp; }
    }
    __syncthreads();
}
__device__ __forceinline__ void tri_solve(const LAS float* Lc, LAS bf16* Xs, int lane) {
    float x0, x1, x2, x3, x4, x5, x6, x7, x8, x9, x10, x11, x12, x13, x14, x15, x16, x17, x18, x19, x20, x21, x22, x23, x24, x25, x26, x27, x28, x29, x30, x31, x32, x33, x34, x35, x36, x37, x38, x39, x40, x41, x42, x43, x44, x45, x46, x47, x48, x49, x50, x51, x52, x53, x54, x55, x56, x57, x58, x59, x60, x61, x62, x63;
    { x63 = (lane == 63) ? 1.0f : 0.0f; asm volatile("" : "+v"(x63) : : "memory"); }
    { float s0 = 0.f, s1 = 0.f, s2 = 0.f, s3 = 0.f; { const f32x4 l = *(const LAS f32x4*)(Lc + 4276); s3 = fmaf(x63, l[3], s3); } x62 = (lane == 62) ? 1.0f : -((s0 + s1) + (s2 + s3)); asm volatile("" : "+v"(x62) : : "memory"); }
    { float s0 = 0.f, s1 = 0.f, s2 = 0.f, s3 = 0.f; { const f32x4 l = *(const LAS f32x4*)(Lc + 4208); s2 = fmaf(x62, l[2], s2); s3 = fmaf(x63, l[3], s3); } x61 = (lane == 61) ? 1.0f : -((s0 + s1) + (s2 + s3)); asm volatile("" : "+v"(x61) : : "memory"); }
    { float s0 = 0.f, s1 = 0.f, s2 = 0.f, s3 = 0.f; { const f32x4 l = *(const LAS f32x4*)(Lc + 4140); s1 = fmaf(x61, l[1], s1); s2 = fmaf(x62, l[2], s2); s3 = fmaf(x63, l[3], s3); } x60 = (lane == 60) ? 1.0f : -((s0 + s1) + (s2 + s3)); asm volatile("" : "+v"(x60) : : "memory"); }
    { float s0 = 0.f, s1 = 0.f, s2 = 0.f, s3 = 0.f; { const f32x4 l = *(const LAS f32x4*)(Lc + 4072); s0 = fmaf(x60, l[0], s0); s1 = fmaf(x61, l[1], s1); s2 = fmaf(x62, l[2], s2); s3 = fmaf(x63, l[3], s3); } x59 = (lane == 59) ? 1.0f : -((s0 + s1) + (s2 + s3)); asm volatile("" : "+v"(x59) : : "memory"); }
    { float s0 = 0.f, s1 = 0.f, s2 = 0.f, s3 = 0.f; { const f32x4 l = *(const LAS f32x4*)(Lc + 4000); s3 = fmaf(x59, l[3], s3); } { const f32x4 l = *(const LAS f32x4*)(Lc + 4004); s0 = fmaf(x60, l[0], s0); s1 = fmaf(x61, l[1], s1); s2 = fmaf(x62, l[2], s2); s3 = fmaf(x63, l[3], s3); } x58 = (lane == 58) ? 1.0f : -((s0 + s1) + (s2 + s3)); asm volatile("" : "+v"(x58) : : "memory"); }
    { float s0 = 0.f, s1 = 0.f, s2 = 0.f, s3 = 0.f; { const f32x4 l = *(const LAS f32x4*)(Lc + 3932); s2 = fmaf(x58, l[2], s2); s3 = fmaf(x59, l[3], s3); } { const f32x4 l = *(const LAS f32x4*)(Lc + 3936); s0 = fmaf(x60, l[0], s0); s1 = fmaf(x61, l[1], s1); s2 = fmaf(x62, l[2], s2); s3 = fmaf(x63, l[3], s3); } x57 = (lane == 57) ? 1.0f : -((s0 + s1) + (s2 + s3)); asm volatile("" : "+v"(x57) : : "memory"); }
    { float s0 = 0.f, s1 = 0.f, s2 = 0.f, s3 = 0.f; { const f32x4 l = *(const LAS f32x4*)(Lc + 3864); s1 = fmaf(x57, l[1], s1); s2 = fmaf(x58, l[2], s2); s3 = fmaf(x59, l[3], s3); } { const f32x4 l = *(const LAS f32x4*)(Lc + 3868); s0 = fmaf(x60, l[0], s0); s1 = fmaf(x61, l[1], s1); s2 = fmaf(x62, l[2], s2); s3 = fmaf(x63, l[3], s3); } x56 = (lane == 56) ? 1.0f : -((s0 + s1) + (s2 + s3)); asm volatile("" : "+v"(x56) : : "memory"); }
    { float s0 = 0.f, s1 = 0.f, s2 = 0.f, s3 = 0.f; { const f32x4 l = *(const LAS f32x4*)(Lc + 3796); s0 = fmaf(x56, l[0], s0); s1 = fmaf(x57, l[1], s1); s2 = fmaf(x58, l[2], s2); s3 = fmaf(x59, l[3], s3); } { const f32x4 l = *(const LAS f32x4*)(Lc + 3800); s0 = fmaf(x60, l[0], s0); s1 = fmaf(x61, l[1], s1); s2 = fmaf(x62, l[2], s2); s3 = fmaf(x63, l[3], s3); } x55 = (lane == 55) ? 1.0f : -((s0 + s1) + (s2 + s3)); asm volatile("" : "+v"(x55) : : "memory"); }
    { float s0 = 0.f, s1 = 0.f, s2 = 0.f, s3 = 0.f; { const f32x4 l = *(const LAS f32x4*)(Lc + 3724); s3 = fmaf(x55, l[3], s3); } { const f32x4 l = *(const LAS f32x4*)(Lc + 3728); s0 = fmaf(x56, l[0], s0); s1 = fmaf(x57, l[1], s1); s2 = fmaf(x58, l[2], s2); s3 = fmaf(x59, l[3], s3); } { const f32x4 l = *(const LAS f32x4*)(Lc + 3732); s0 = fmaf(x60, l[0], s0); s1 = fmaf(x61, l[1], s1); s2 = fmaf(x62, l[2], s2); s3 = fmaf(x63, l[3], s3); } x54 = (lane == 54) ? 1.0f : -((s0 + s1) + (s2 + s3)); asm volatile("" : "+v"(x54) : : "memory"); }
    { float s0 = 0.f, s1 = 0.f, s2 = 0.f, s3 = 0.f; { const f32x4 l = *(const LAS f32x4*)(Lc + 3656); s2 = fmaf(x54, l[2], s2); s3 = fmaf(x55, l[3], s3); } { const f32x4 l = *(const LAS f32x4*)(Lc + 3660); s0 = fmaf(x56, l[0], s0); s1 = fmaf(x57, l[1], s1); s2 = fmaf(x58, l[2], s2); s3 = fmaf(x59, l[3], s3); } { const f32x4 l = *(const LAS f32x4*)(Lc + 3664); s0 = fmaf(x60, l[0], s0); s1 = fmaf(x61, l[1], s1); s2 = fmaf(x62, l[2], s2); s3 = fmaf(x63, l[3], s3); } x53 = (lane == 53) ? 1.0f : -((s0 + s1) + (s2 + s3)); asm volatile("" : "+v"(x53) : : "memory"); }
    { float s0 = 0.f, s1 = 0.f, s2 = 0.f, s3 = 0.f; { const f32x4 l = *(const LAS f32x4*)(Lc + 3588); s1 = fmaf(x53, l[1], s1); s2 = fmaf(x54, l[2], s2); s3 = fmaf(x55, l[3], s3); } { const f32x4 l = *(const LAS f32x4*)(Lc + 3592); s0 = fmaf(x56, l[0], s0); s1 = fmaf(x57, l[1], s1); s2 = fmaf(x58, l[2], s2); s3 = fmaf(x59, l[3], s3); } { const f32x4 l = *(const LAS f32x4*)(Lc + 3596); s0 = fmaf(x60, l[0], s0); s1 = fmaf(x61, l[1], s1); s2 = fmaf(x62, l[2], s2); s3 = fmaf(x63, l[3], s3); } x52 = (lane == 52) ? 1.0f : -((s0 + s1) + (s2 + s3)); asm volatile("" : "+v"(x52) : : "memory"); }
    { float s0 = 0.f, s1 = 0.f, s2 = 0.f, s3 = 0.f; { const f32x4 l = *(const LAS f32x4*)(Lc + 3520); s0 = fmaf(x52, l[0], s0); s1 = fmaf(x53, l[1], s1); s2 = fmaf(x54, l[2], s2); s3 = fmaf(x55, l[3], s3); } { const f32x4 l = *(const LAS f32x4*)(Lc + 3524); s0 = fmaf(x56, l[0], s0); s1 = fmaf(x57, l[1], s1); s2 = fmaf(x58, l[2], s2); s3 = fmaf(x59, l[3], s3); } { const f32x4 l = *(const LAS f32x4*)(Lc + 3528); s0 = fmaf(x60, l[0], s0); s1 = fmaf(x61, l[1], s1); s2 = fmaf(x62, l[2], s2); s3 = fmaf(x63, l[3], s3); } x51 = (lane == 51) ? 1.0f : -((s0 + s1) + (s2 + s3)); asm volatile("" : "+v"(x51) : : "memory"); }
    { float s0 = 0.f, s1 = 0.f, s2 = 0.f, s3 = 0.f; { const f32x4 l = *(const LAS f32x4*)(Lc + 3448); s3 = fmaf(x51, l[3], s3); } { const f32x4 l = *(const LAS f32x4*)(Lc + 3452); s0 = fmaf(x52, l[0], s0); s1 = fmaf(x53, l[1], s1); s2 = fmaf(x54, l[2], s2); s3 = fmaf(x55, l[3], s3); } { const f32x4 l = *(const LAS f32x4*)(Lc + 3456); s0 = fmaf(x56, l[0], s0); s1 = fmaf(x57, l[1], s1); s2 = fmaf(x58, l[2], s2); s3 = fmaf(x59, l[3], s3); } { const f32x4 l = *(const LAS f32x4*)(Lc + 3460); s0 = fmaf(x60, l[0], s0); s1 = fmaf(x61, l[1], s1); s2 = fmaf(x62, l[2], s2); s3 = fmaf(x63, l[3], s3); } x50 = (lane == 50) ? 1.0f : -((s0 + s1) + (s2 + s3)); asm volatile("" : "+v"(x50) : : "memory"); }
    { float s0 = 0.f, s1 = 0.f, s2 = 0.f, s3 = 0.f; { const f32x4 l = *(const LAS f32x4*)(Lc + 3380); s2 = fmaf(x50, l[2], s2); s3 = fmaf(x51, l[3], s3); } { const f32x4 l = *(const LAS f32x4*)(Lc + 3384); s0 = fmaf(x52, l[0], s0); s1 = fmaf(x53, l[1], s1); s2 = fmaf(x54, l[2], s2); s3 = fmaf(x55, l[3], s3); } { const f32x4 l = *(const LAS f32x4*)(Lc + 3388); s0 = fmaf(x56, l[0], s0); s1 = fmaf(x57, l[1], s1); s2 = fmaf(x58, l[2], s2); s3 = fmaf(x59, l[3], s3); } { const f32x4 l = *(const LAS f32x4*)(Lc + 3392); s0 = fmaf(x60, l[0], s0); s1 = fmaf(x61, l[1], s1); s2 = fmaf(x62, l[2], s2); s3 = fmaf(x63, l[3], s3); } x49 = (lane == 49) ? 1.0f : -((s0 + s1) + (s2 + s3)); asm volatile("" : "+v"(x49) : : "memory"); }
    { float s0 = 0.f, s1 = 0.f, s2 = 0.f, s3 = 0.f; { const f32x4 l = *(const LAS f32x4*)(Lc + 3312); s1 = fmaf(x49, l[1], s1); s2 = fmaf(x50, l[2], s2); s3 = fmaf(x51, l[3], s3); } { const f32x4 l = *(const LAS f32x4*)(Lc + 3316); s0 = fmaf(x52, l[0], s0); s1 = fmaf(x53, l[1], s1); s2 = fmaf(x54, l[2], s2); s3 = fmaf(x55, l[3], s3); } { const f32x4 l = *(const LAS f32x4*)(Lc + 3320); s0 = fmaf(x56, l[0], s0); s1 = fmaf(x57, l[1], s1); s2 = fmaf(x58, l[2], s2); s3 = fmaf(x59, l[3], s3); } { const f32x4 l = *(const LAS f32x4*)(Lc + 3324); s0 = fmaf(x60, l[0], s0); s1 = fmaf(x61, l[1], s1); s2 = fmaf(x62, l[2], s2); s3 = fmaf(x63, l[3], s3); } x48 = (lane == 48) ? 1.0f : -((s0 + s1) + (s2 + s3)); asm volatile("" : "+v"(x48) : : "memory"); }
    { float s0 = 0.f, s1 = 0.f, s2 = 0.f, s3 = 0.f; { const f32x4 l = *(const LAS f32x4*)(Lc + 3244); s0 = fmaf(x48, l[0], s0); s1 = fmaf(x49, l[1], s1); s2 = fmaf(x50, l[2], s2); s3 = fmaf(x51, l[3], s3); } { const f32x4 l = *(const LAS f32x4*)(Lc + 3248); s0 = fmaf(x52, l[0], s0); s1 = fmaf(x53, l[1], s1); s2 = fmaf(x54, l[2], s2); s3 = fmaf(x55, l[3], s3); } { const f32x4 l = *(const LAS f32x4*)(Lc + 3252); s0 = fmaf(x56, l[0], s0); s1 = fmaf(x57, l[1], s1); s2 = fmaf(x58, l[2], s2); s3 = fmaf(x59, l[3], s3); } { const f32x4 l = *(const LAS f32x4*)(Lc + 3256); s0 = fmaf(x60, l[0], s0); s1 = fmaf(x61, l[1], s1); s2 = fmaf(x62, l[2], s2); s3 = fmaf(x63, l[3], s3); } x47 = (lane == 47) ? 1.0f : -((s0 + s1) + (s2 + s3)); asm volatile("" : "+v"(x47) : : "memory"); }
    { float s0 = 0.f, s1 = 0.f, s2 = 0.f, s3 = 0.f; { const f32x4 l = *(const LAS f32x4*)(Lc + 3172); s3 = fmaf(x47, l[3], s3); } { const f32x4 l = *(const LAS f32x4*)(Lc + 3176); s0 = fmaf(x48, l[0], s0); s1 = fmaf(x49, l[1], s1); s2 = fmaf(x50, l[2], s2); s3 = fmaf(x51, l[3], s3); } { const f32x4 l = *(const LAS f32x4*)(Lc + 3180); s0 = fmaf(x52, l[0], s0); s1 = fmaf(x53, l[1], s1); s2 = fmaf(x54, l[2], s2); s3 = fmaf(x55, l[3], s3); } { const f32x4 l = *(const LAS f32x4*)(Lc + 3184); s0 = fmaf(x56, l[0], s0); s1 = fmaf(x57, l[1], s1); s2 = fmaf(x58, l[2], s2); s3 = fmaf(x59, l[3], s3); } { const f32x4 l = *(const LAS f32x4*)(Lc + 3188); s0 = fmaf(x60, l[0], s0); s1 = fmaf(x61, l[1], s1); s2 = fmaf(x62, l[2], s2); s3 = fmaf(x63, l[3], s3); } x46 = (lane == 46) ? 1.0f : -((s0 + s1) + (s2 + s3)); asm volatile("" : "+v"(x46) : : "memory"); }
    { float s0 = 0.f, s1 = 0.f, s2 = 0.f, s3 = 0.f; { const f32x4 l = *(const LAS f32x4*)(Lc + 3104); s2 = fmaf(x46, l[2], s2); s3 = fmaf(x47, l[3], s3); } { const f32x4 l = *(const LAS f32x4*)(Lc + 3108); s0 = fmaf(x48, l[0], s0); s1 = fmaf(x49, l[1], s1); s2 = fmaf(x50, l[2], s2); s3 = fmaf(x51, l[3], s3); } { const f32x4 l = *(const LAS f32x4*)(Lc + 3112); s0 = fmaf(x52, l[0], s0); s1 = fmaf(x53, l[1], s1); s2 = fmaf(x54, l[2], s2); s3 = fmaf(x55, l[3], s3); } { const f32x4 l = *(const LAS f32x4*)(Lc + 3116); s0 = fmaf(x56, l[0], s0); s1 = fmaf(x57, l[1], s1); s2 = fmaf(x58, l[2], s2); s3 = fmaf(x59, l[3], s3); } { const f32x4 l = *(const LAS f32x4*)(Lc + 3120); s0 = fmaf(x60, l[0], s0); s1 = fmaf(x61, l[1], s1); s2 = fmaf(x62, l[2], s2); s3 = fmaf(x63, l[3], s3); } x45 = (lane == 45) ? 1.0f : -((s0 + s1) + (s2 + s3)); asm volatile("" : "+v"(x45) : : "memory"); }
    { float s0 = 0.f, s1 = 0.f, s2 = 0.f, s3 = 0.f; { const f32x4 l = *(const LAS f32x4*)(Lc + 3036); s1 = fmaf(x45, l[1], s1); s2 = fmaf(x46, l[2], s2); s3 = fmaf(x47, l[3], s3); } { const f32x4 l = *(const LAS f32x4*)(Lc + 3040); s0 = fmaf(x48, l[0], s0); s1 = fmaf(x49, l[1], s1); s2 = fmaf(x50, l[2], s2); s3 = fmaf(x51, l[3], s3); } { const f32x4 l = *(const LAS f32x4*)(Lc + 3044); s0 = fmaf(x52, l[0], s0); s1 = fmaf(x53, l[1], s1); s2 = fmaf(x54, l[2], s2); s3 = fmaf(x55, l[3], s3); } { const f32x4 l = *(const LAS f32x4*)(Lc + 3048); s0 = fmaf(x56, l[0], s0); s1 = fmaf(x57, l[1], s1); s2 = fmaf(x58, l[2], s2); s3 = fmaf(x59, l[3], s3); } { const f32x4 l = *(const LAS f32x4*)(Lc + 3052); s0 = fmaf(x60, l[0], s0); s1 = fmaf(x61, l[1], s1); s2 = fmaf(x62, l[2], s2); s3 = fmaf(x63, l[3], s3); } x44 = (lane == 44) ? 1.0f : -((s0 + s1) + (s2 + s3)); asm volatile("" : "+v"(x44) : : "memory"); }
    { float s0 = 0.f, s1 = 0.f, s2 = 0.f, s3 = 0.f; { const f32x4 l = *(const LAS f32x4*)(Lc + 2968); s0 = fmaf(x44, l[0], s0); s1 = fmaf(x45, l[1], s1); s2 = fmaf(x46, l[2], s2); s3 = fmaf(x47, l[3], s3); } { const f32x4 l = *(const LAS f32x4*)(Lc + 2972); s0 = fmaf(x48, l[0], s0); s1 = fmaf(x49, l[1], s1); s2 = fmaf(x50, l[2], s2); s3 = fmaf(x51, l[3], s3); } { const f32x4 l = *(const LAS f32x4*)(Lc + 2976); s0 = fmaf(x52, l[0], s0); s1 = fmaf(x53, l[1], s1); s2 = fmaf(x54, l[2], s2); s3 = fmaf(x55, l[3], s3); } { const f32x4 l = *(const LAS f32x4*)(Lc + 2980); s0 = fmaf(x56, l[0], s0); s1 = fmaf(x57, l[1], s1); s2 = fmaf(x58, l[2], s2); s3 = fmaf(x59, l[3], s3); } { const f32x4 l = *(const LAS f32x4*)(Lc + 2984); s0 = fmaf(x60, l[0], s0); s1 = fmaf(x61, l[1], s1); s2 = fmaf(x62, l[2], s2); s3 = fmaf(x63, l[3], s3); } x43 = (lane == 43) ? 1.0f : -((s0 + s1) + (s2 + s3)); asm volatile("" : "+v"(x43) : : "memory"); }
    { float s0 = 0.f, s1 = 0.f, s2 = 0.f, s3 = 0.f; { const f32x4 l = *(const LAS f32x4*)(Lc + 2896); s3 = fmaf(x43, l[3], s3); } { const f32x4 l = *(const LAS f32x4*)(Lc + 2900); s0 = fmaf(x44, l[0], s0); s1 = fmaf(x45, l[1], s1); s2 = fmaf(x46, l[2], s2); s3 = fmaf(x47, l[3], s3); } { const f32x4 l = *(const LAS f32x4*)(Lc + 2904); s0 = fmaf(x48, l[0], s0); s1 = fmaf(x49, l[1], s1); s2 = fmaf(x50, l[2], s2); s3 = fmaf(x51, l[3], s3); } { const f32x4 l = *(const LAS f32x4*)(Lc + 2908); s0 = fmaf(x52, l[0], s0); s1 = fmaf(x53, l[1], s1); s2 = fmaf(x54, l[2], s2); s3 = fmaf(x55, l[3], s3); } { const f32x4 l = *(const LAS f32x4*)(Lc + 2912); s0 = fmaf(x56, l[0], s0); s1 = fmaf(x57, l[1], s1); s2 = fmaf(x58, l[2], s2); s3 = fmaf(x59, l[3], s3); } { const f32x4 l = *(const LAS f32x4*)(Lc + 2916); s0 = fmaf(x60, l[0], s0); s1 = fmaf(x61, l[1], s1); s2 = fmaf(x62, l[2], s2); s3 = fmaf(x63, l[3], s3); } x42 = (lane == 42) ? 1.0f : -((s0 + s1) + (s2 + s3)); asm volatile("" : "+v"(x42) : : "memory"); }
    { float s0 = 0.f, s1 = 0.f, s2 = 0.f, s3 = 0.f; { const f32x4 l = *(const LAS f32x4*)(Lc + 2828); s2 = fmaf(x42, l[2], s2); s3 = fmaf(x43, l[3], s3); } { const f32x4 l = *(const LAS f32x4*)(Lc + 2832); s0 = fmaf(x44, l[0], s0); s1 = fmaf(x45, l[1], s1); s2 = fmaf(x46, l[2], s2); s3 = fmaf(x47, l[3], s3); } { const f32x4 l = *(const LAS f32x4*)(Lc + 2836); s0 = fmaf(x48, l[0], s0); s1 = fmaf(x49, l[1], s1); s2 = fmaf(x50, l[2], s2); s3 = fmaf(x51, l[3], s3); } { const f32x4 l = *(const LAS f32x4*)(Lc + 2840); s0 = fmaf(x52, l[0], s0); s1 = fmaf(x53, l[1], s1); s2 = fmaf(x54, l[2], s2); s3 = fmaf(x55, l[3], s3); } { const f32x4 l = *(const LAS f32x4*)(Lc + 2844); s0 = fmaf(x56, l[0], s0); s1 = fmaf(x57, l[1], s1); s2 = fmaf(x58, l[2], s2); s3 = fmaf(x59, l[3], s3); } { const f32x4 l = *(const LAS f32x4*)(Lc + 2848); s0 = fmaf(x60, l[0], s0); s1 = fmaf(x61, l[1], s1); s2 = fmaf(x62, l[2], s2); s3 = fmaf(x63, l[3], s3); } x41 = (lane == 41) ? 1.0f : -((s0 + s1) + (s2 + s3)); asm volatile("" : "+v"(x41) : : "memory"); }
    { float s0 = 0.f, s1 = 0.f, s2 = 0.f, s3 = 0.f; { const f32x4 l = *(const LAS f32x4*)(Lc + 2760); s1 = fmaf(x41, l[1], s1); s2 = fmaf(x42, l[2], s2); s3 = fmaf(x43, l[3], s3); } { const f32x4 l = *(const LAS f32x4*)(Lc + 2764); s0 = fmaf(x44, l[0], s0); s1 = fmaf(x45, l[1], s1); s2 = fmaf(x46, l[2], s2); s3 = fmaf(x47, l[3], s3); } { const f32x4 l = *(const LAS f32x4*)(Lc + 2768); s0 = fmaf(x48, l[0], s0); s1 = fmaf(x49, l[1], s1); s2 = fmaf(x50, l[2], s2); s3 = fmaf(x51, l[3], s3); } { const f32x4 l = *(const LAS f32x4*)(Lc + 2772); s0 = fmaf(x52, l[0], s0); s1 = fmaf(x53, l[1], s1); s2 = fmaf(x54, l[2], s2); s3 = fmaf(x55, l[3], s3); } { const f32x4 l = *(const LAS f32x4*)(Lc + 2776); s0 = fmaf(x56, l[0], s0); s1 = fmaf(x57, l[1], s1); s2 = fmaf(x58, l[2], s2); s3 = fmaf(x59, l[3], s3); } { const f32x4 l = *(const LAS f32x4*)(Lc + 2780); s0 = fmaf(x60, l[0], s0); s1 = fmaf(x61, l[1], s1); s2 = fmaf(x62, l[2], s2); s3 = fmaf(x63, l[3], s3); } x40 = (lane == 40) ? 1.0f : -((s0 + s1) + (s2 + s3)); asm volatile("" : "+v"(x40) : : "memory"); }
    { float s0 = 0.f, s1 = 0.f, s2 = 0.f, s3 = 0.f; { const f32x4 l = *(const LAS f32x4*)(Lc + 2692); s0 = fmaf(x40, l[0], s0); s1 = fmaf(x41, l[1], s1); s2 = fmaf(x42, l[2], s2); s3 = fmaf(x43, l[3], s3); } { const f32x4 l = *(const LAS f32x4*)(Lc + 2696); s0 = fmaf(x44, l[0], s0); s1 = fmaf(x45, l[1], s1); s2 = fmaf(x46, l[2], s2); s3 = fmaf(x47, l[3], s3); } { const f32x4 l = *(const LAS f32x4*)(Lc + 2700); s0 = fmaf(x48, l[0], s0); s1 = fmaf(x49, l[1], s1); s2 = fmaf(x50, l[2], s2); s3 = fmaf(x51, l[3], s3); } { const f32x4 l = *(const LAS f32x4*)(Lc + 2704); s0 = fmaf(x52, l[0], s0); s1 = fmaf(x53, l[1], s1); s2 = fmaf(x54, l[2], s2); s3 = fmaf(x55, l[3], s3); } { const f32x4 l = *(const LAS f32x4*)(Lc + 2708); s0 = fmaf(x56, l[0], s0); s1 = fmaf(x57, l[1], s1); s2 = fmaf(x58, l[2], s2); s3 = fmaf(x59, l[3], s3); } { const f32x4 l = *(const LAS f32x4*)(Lc + 2712); s0 = fmaf(x60, l[0], s0); s1 = fmaf(x61, l[1], s1); s2 = fmaf(x62, l[2], s2); s3 = fmaf(x63, l[3], s3); } x39 = (lane == 39) ? 1.0f : -((s0 + s1) + (s2 + s3)); asm volatile("" : "+v"(x39) : : "memory"); }
    { float s0 = 0.f, s1 = 0.f, s2 = 0.f, s3 = 0.f; { const f32x4 l = *(const LAS f32x4*)(Lc + 2620); s3 = fmaf(x39, l[3], s3); } { const f32x4 l = *(const LAS f32x4*)(Lc + 2624); s0 = fmaf(x40, l[0], s0); s1 = fmaf(x41, l[1], s1); s2 = fmaf(x42, l[2], s2); s3 = fmaf(x43, l[3], s3); } { const f32x4 l = *(const LAS f32x4*)(Lc + 2628); s0 = fmaf(x44, l[0], s0); s1 = fmaf(x45, l[1], s1); s2 = fmaf(x46, l[2], s2); s3 = fmaf(x47, l[3], s3); } { const f32x4 l = *(const LAS f32x4*)(Lc + 2632); s0 = fmaf(x48, l[0], s0); s1 = fmaf(x49, l[1], s1); s2 = fmaf(x50, l[2], s2); s3 = fmaf(x51, l[3], s3); } { const f32x4 l = *(const LAS f32x4*)(Lc + 2636); s0 = fmaf(x52, l[0], s0); s1 = fmaf(x53, l[1], s1); s2 = fmaf(x54, l[2], s2); s3 = fmaf(x55, l[3], s3); } { const f32x4 l = *(const LAS f32x4*)(Lc + 2640); s0 = fmaf(x56, l[0], s0); s1 = fmaf(x57, l[1], s1); s2 = fmaf(x58, l[2], s2); s3 = fmaf(x59, l[3], s3); } { const f32x4 l = *(const LAS f32x4*)(Lc + 2644); s0 = fmaf(x60, l[0], s0); s1 = fmaf(x61, l[1], s1); s2 = fmaf(x62, l[2], s2); s3 = fmaf(x63, l[3], s3); } x38 = (lane == 38) ? 1.0f : -((s0 + s1) + (s2 + s3)); asm volatile("" : "+v"(x38) : : "memory"); }
    { float s0 = 0.f, s1 = 0.f, s2 = 0.f, s3 = 0.f; { const f32x4 l = *(const LAS f32x4*)(Lc + 2552); s2 = fmaf(x38, l[2], s2); s3 = fmaf(x39, l[3], s3); } { const f32x4 l = *(const LAS f32x4*)(Lc + 2556); s0 = fmaf(x40, l[0], s0); s1 = fmaf(x41, l[1], s1); s2 = fmaf(x42, l[2], s2); s3 = fmaf(x43, l[3], s3); } { const f32x4 l = *(const LAS f32x4*)(Lc + 2560); s0 = fmaf(x44, l[0], s0); s1 = fmaf(x45, l[1], s1); s2 = fmaf(x46, l[2], s2); s3 = fmaf(x47, l[3], s3); } { const f32x4 l = *(const LAS f32x4*)(Lc + 2564); s0 = fmaf(x48, l[0], s0); s1 = fmaf(x49, l[1], s1); s2 = fmaf(x50, l[2], s2); s3 = fmaf(x51, l[3], s3); } { const f32x4 l = *(const LAS f32x4*)(Lc + 2568); s0 = fmaf(x52, l[0], s0); s1 = fmaf(x53, l[1], s1); s2 = fmaf(x54, l[2], s2); s3 = fmaf(x55, l[3], s3); } { const f32x4 l = *(const LAS f32x4*)(Lc + 2572); s0 = fmaf(x56, l[0], s0); s1 = fmaf(x57, l[1], s1); s2 = fmaf(x58, l[2], s2); s3 = fmaf(x59, l[3], s3); } { const f32x4 l = *(const LAS f32x4*)(Lc + 2576); s0 = fmaf(x60, l[0], s0); s1 = fmaf(x61, l[1], s1); s2 = fmaf(x62, l[2], s2); s3 = fmaf(x63, l[3], s3); } x37 = (lane == 37) ? 1.0f : -((s0 + s1) + (s2 + s3)); asm volatile("" : "+v"(x37) : : "memory"); }
    { float s0 = 0.f, s1 = 0.f, s2 = 0.f, s3 = 0.f; { const f32x4 l = *(const LAS f32x4*)(Lc + 2484); s1 = fmaf(x37, l[1], s1); s2 = fmaf(x38, l[2], s2); s3 = fmaf(x39, l[3], s3); } { const f32x4 l = *(const LAS f32x4*)(Lc + 2488); s0 = fmaf(x40, l[0], s0); s1 = fmaf(x41, l[1], s1); s2 = fmaf(x42, l[2], s2); s3 = fmaf(x43, l[3], s3); } { const f32x4 l = *(const LAS f32x4*)(Lc + 2492); s0 = fmaf(x44, l[0], s0); s1 = fmaf(x45, l[1], s1); s2 = fmaf(x46, l[2], s2); s3 = fmaf(x47, l[3], s3); } { const f32x4 l = *(const LAS f32x4*)(Lc + 2496); s0 = fmaf(x48, l[0], s0); s1 = fmaf(x49, l[1], s1); s2 = fmaf(x50, l[2], s2); s3 = fmaf(x51, l[3], s3); } { const f32x4 l = *(const LAS f32x4*)(Lc + 2500); s0 = fmaf(x52, l[0], s0); s1 = fmaf(x53, l[1], s1); s2 = fmaf(x54, l[2], s2); s3 = fmaf(x55, l[3], s3); } { const f32x4 l = *(const LAS f32x4*)(Lc + 2504); s0 = fmaf(x56, l[0], s0); s1 = fmaf(x57, l[1], s1); s2 = fmaf(x58, l[2], s2); s3 = fmaf(x59, l[3], s3); } { const f32x4 l = *(const LAS f32x4*)(Lc + 2508); s0 = fmaf(x60, l[0], s0); s1 = fmaf(x61, l[1], s1); s2 = fmaf(x62, l[2], s2); s3 = fmaf(x63, l[3], s3); } x36 = (lane == 36) ? 1.0f : -((s0 + s1) + (s2 + s3)); asm volatile("" : "+v"(x36) : : "memory"); }
    { float s0 = 0.f, s1 = 0.f, s2 = 0.f, s3 = 0.f; { const f32x4 l = *(const LAS f32x4*)(Lc + 2416); s0 = fmaf(x36, l[0], s0); s1 = fmaf(x37, l[1], s1); s2 = fmaf(x38, l[2], s2); s3 = fmaf(x39, l[3], s3); } { const f32x4 l = *(const LAS f32x4*)(Lc + 2420); s0 = fmaf(x40, l[0], s0); s1 = fmaf(x41, l[1], s1); s2 = fmaf(x42, l[2], s2); s3 = fmaf(x43, l[3], s3); } { const f32x4 l = *(const LAS f32x4*)(Lc + 2424); s0 = fmaf(x44, l[0], s0); s1 = fmaf(x45, l[1], s1); s2 = fmaf(x46, l[2], s2); s3 = fmaf(x47, l[3], s3); } { const f32x4 l = *(const LAS f32x4*)(Lc + 2428); s0 = fmaf(x48, l[0], s0); s1 = fmaf(x49, l[1], s1); s2 = fmaf(x50, l[2], s2); s3 = fmaf(x51, l[3], s3); } { const f32x4 l = *(const LAS f32x4*)(Lc + 2432); s0 = fmaf(x52, l[0], s0); s1 = fmaf(x53, l[1], s1); s2 = fmaf(x54, l[2], s2); s3 = fmaf(x55, l[3], s3); } { const f32x4 l = *(const LAS f32x4*)(Lc + 2436); s0 = fmaf(x56, l[0], s0); s1 = fmaf(x57, l[1], s1); s2 = fmaf(x58, l[2], s2); s3 = fmaf(x59, l[3], s3); } { const f32x4 l = *(const LAS f32x4*)(Lc + 2440); s0 = fmaf(x60, l[0], s0); s1 = fmaf(x61, l[1], s1); s2 = fmaf(x62, l[2], s2); s3 = fmaf(x63, l[3], s3); } x35 = (lane == 35) ? 1.0f : -((s0 + s1) + (s2 + s3)); asm volatile("" : "+v"(x35) : : "memory"); }
    { float s0 = 0.f, s1 = 0.f, s2 = 0.f, s3 = 0.f; { const f32x4 l = *(const LAS f32x4*)(Lc + 2344); s3 = fmaf(x35, l[3], s3); } { const f32x4 l = *(const LAS f32x4*)(Lc + 2348); s0 = fmaf(x36, l[0], s0); s1 = fmaf(x37, l[1], s1); s2 = fmaf(x38, l[2], s2); s3 = fmaf(x39, l[3], s3); } { const f32x4 l = *(const LAS f32x4*)(Lc + 2352); s0 = fmaf(x40, l[0], s0); s1 = fmaf(x41, l[1], s1); s2 = fmaf(x42, l[2], s2); s3 = fmaf(x43, l[3], s3); } { const f32x4 l = *(const LAS f32x4*)(Lc + 2356); s0 = fmaf(x44, l[0], s0); s1 = fmaf(x45, l[1], s1); s2 = fmaf(x46, l[2], s2); s3 = fmaf(x47, l[3], s3); } { const f32x4 l = *(const LAS f32x4*)(Lc + 2360); s0 = fmaf(x48, l[0], s0); s1 = fmaf(x49, l[1], s1); s2 = fmaf(x50, l[2], s2); s3 = fmaf(x51, l[3], s3); } { const f32x4 l = *(const LAS f32x4*)(Lc + 2364); s0 = fmaf(x52, l[0], s0); s1 = fmaf(x53, l[1], s1); s2 = fmaf(x54, l[2], s2); s3 = fmaf(x55, l[3], s3); } { const f32x4 l = *(const LAS f32x4*)(Lc + 2368); s0 = fmaf(x56, l[0], s0); s1 = fmaf(x57, l[1], s1); s2 = fmaf(x58, l[2], s2); s3 = fmaf(x59, l[3], s3); } { const f32x4 l = *(const LAS f32x4*)(Lc + 2372); s0 = fmaf(x60, l[0], s0); s1 = fmaf(x61, l[1], s1); s2 = fmaf(x62, l[2], s2); s3 = fmaf(x63, l[3], s3); } x34 = (lane == 34) ? 1.0f : -((s0 + s1) + (s2 + s3)); asm volatile("" : "+v"(x34) : : "memory"); }
    { float s0 = 0.f, s1 = 0.f, s2 = 0.f, s3 = 0.f; { const f32x4 l = *(const LAS f32x4*)(Lc + 2276); s2 = fmaf(x34, l[2], s2); s3 = fmaf(x35, l[3], s3); } { const f32x4 l = *(const LAS f32x4*)(Lc + 2280); s0 = fmaf(x36, l[0], s0); s1 = fmaf(x37, l[1], s1); s2 = fmaf(x38, l[2], s2); s3 = fmaf(x39, l[3], s3); } { const f32x4 l = *(const LAS f32x4*)(Lc + 2284); s0 = fmaf(x40, l[0], s0); s1 = fmaf(x41, l[1], s1); s2 = fmaf(x42, l[2], s2); s3 = fmaf(x43, l[3], s3); } { const f32x4 l = *(const LAS f32x4*)(Lc + 2288); s0 = fmaf(x44, l[0], s0); s1 = fmaf(x45, l[1], s1); s2 = fmaf(x46, l[2], s2); s3 = fmaf(x47, l[3], s3); } { const f32x4 l = *(const LAS f32x4*)(Lc + 2292); s0 = fmaf(x48, l[0], s0); s1 = fmaf(x49, l[1], s1); s2 = fmaf(x50, l[2], s2); s3 = fmaf(x51, l[3], s3); } { const f32x4 l = *(const LAS f32x4*)(Lc + 2296); s0 = fmaf(x52, l[0], s0); s1 = fmaf(x53, l[1], s1); s2 = fmaf(x54, l[2], s2); s3 = fmaf(x55, l[3], s3); } { const f32x4 l = *(const LAS f32x4*)(Lc + 2300); s0 = fmaf(x56, l[0], s0); s1 = fmaf(x57, l[1], s1); s2 = fmaf(x58, l[2], s2); s3 = fmaf(x59, l[3], s3); } { const f32x4 l = *(const LAS f32x4*)(Lc + 2304); s0 = fmaf(x60, l[0], s0); s1 = fmaf(x61, l[1], s1); s2 = fmaf(x62, l[2], s2); s3 = fmaf(x63, l[3], s3); } x33 = (lane == 33) ? 1.0f : -((s0 + s1) + (s2 + s3)); asm volatile("" : "+v"(x33) : : "memory"); }
    { float s0 = 0.f, s1 = 0.f, s2 = 0.f, s3 = 0.f; { const f32x4 l = *(const LAS f32x4*)(Lc + 2208); s1 = fmaf(x33, l[1], s1); s2 = fmaf(x34, l[2], s2); s3 = fmaf(x35, l[3], s3); } { const f32x4 l = *(const LAS f32x4*)(Lc + 2212); s0 = fmaf(x36, l[0], s0); s1 = fmaf(x37, l[1], s1); s2 = fmaf(x38, l[2], s2); s3 = fmaf(x39, l[3], s3); } { const f32x4 l = *(const LAS f32x4*)(Lc + 2216); s0 = fmaf(x40, l[0], s0); s1 = fmaf(x41, l[1], s1); s2 = fmaf(x42, l[2], s2); s3 = fmaf(x43, l[3], s3); } { const f32x4 l = *(const LAS f32x4*)(Lc + 2220); s0 = fmaf(x44, l[0], s0); s1 = fmaf(x45, l[1], s1); s2 = fmaf(x46, l[2], s2); s3 = fmaf(x47, l[3], s3); } { const f32x4 l = *(const LAS f32x4*)(Lc + 2224); s0 = fmaf(x48, l[0], s0); s1 = fmaf(x49, l[1], s1); s2 = fmaf(x50, l[2], s2); s3 = fmaf(x51, l[3], s3); } { const f32x4 l = *(const LAS f32x4*)(Lc + 2228); s0 = fmaf(x52, l[0], s0); s1 = fmaf(x53, l[1], s1); s2 = fmaf(x54, l[2], s2); s3 = fmaf(x55, l[3], s3); } { const f32x4 l = *(const LAS f32x4*)(Lc + 2232); s0 = fmaf(x56, l[0], s0); s1 = fmaf(x57, l[1], s1); s2 = fmaf(x58, l[2], s2); s3 = fmaf(x59, l[3], s3); } { const f32x4 l = *(const LAS f32x4*)(Lc + 2236); s0 = fmaf(x60, l[0], s0); s1 = fmaf(x61, l[1], s1); s2 = fmaf(x62, l[2], s2); s3 = fmaf(x63, l[3], s3); } x32 = (lane == 32) ? 1.0f : -((s0 + s1) + (s2 + s3)); asm volatile("" : "+v"(x32) : : "memory"); }
    { float s0 = 0.f, s1 = 0.f, s2 = 0.f, s3 = 0.f; { const f32x4 l = *(const LAS f32x4*)(Lc + 2140); s0 = fmaf(x32, l[0], s0); s1 = fmaf(x33, l[1], s1); s2 = fmaf(x34, l[2], s2); s3 = fmaf(x35, l[3], s3); } { const f32x4 l = *(const LAS f32x4*)(Lc + 2144); s0 = fmaf(x36, l[0], s0); s1 = fmaf(x37, l[1], s1); s2 = fmaf(x38, l[2], s2); s3 = fmaf(x39, l[3], s3); } { const f32x4 l = *(const LAS f32x4*)(Lc + 2148); s0 = fmaf(x40, l[0], s0); s1 = fmaf(x41, l[1], s1); s2 = fmaf(x42, l[2], s2); s3 = fmaf(x43, l[3], s3); } { const f32x4 l = *(const LAS f32x4*)(Lc + 2152); s0 = fmaf(x44, l[0], s0); s1 = fmaf(x45, l[1], s1); s2 = fmaf(x46, l[2], s2); s3 = fmaf(x47, l[3], s3); } { const f32x4 l = *(const LAS f32x4*)(Lc + 2156); s0 = fmaf(x48, l[0], s0); s1 = fmaf(x49, l[1], s1); s2 = fmaf(x50, l[2], s2); s3 = fmaf(x51, l[3], s3); } { const f32x4 l = *(const LAS f32x4*)(Lc + 2160); s0 = fmaf(x52, l[0], s0); s1 = fmaf(x53, l[1], s1); s2 = fmaf(x54, l[2], s2); s3 = fmaf(x55, l[3], s3); } { const f32x4 l = *(const LAS f32x4*)(Lc + 2164); s0 = fmaf(x56, l[0], s0); s1 = fmaf(x57, l[1], s1); s2 = fmaf(x58, l[2], s2); s3 = fmaf(x59, l[3], s3); } { const f32x4 l = *(const LAS f32x4*)(Lc + 2168); s0 = fmaf(x60, l[0], s0); s1 = fmaf(x61, l[1], s1); s2 = fmaf(x62, l[2], s2); s3 = fmaf(x63, l[3], s3); } x31 = (lane == 31) ? 1.0f : -((s0 + s1) + (s2 + s3)); asm volatile("" : "+v"(x31) : : "memory"); }
    { float s0 = 0.f, s1 = 0.f, s2 = 0.f, s3 = 0.f; { const f32x4 l = *(const LAS f32x4*)(Lc + 2068); s3 = fmaf(x31, l[3], s3); } { const f32x4 l = *(const LAS f32x4*)(Lc + 2072); s0 = fmaf(x32, l[0], s0); s1 = fmaf(x33, l[1], s1); s2 = fmaf(x34, l[2], s2); s3 = fmaf(x35, l[3], s3); } { const f32x4 l = *(const LAS f32x4*)(Lc + 2076); s0 = fmaf(x36, l[0], s0); s1 = fmaf(x37, l[1], s1); s2 = fmaf(x38, l[2], s2); s3 = fmaf(x39, l[3], s3); } { const f32x4 l = *(const LAS f32x4*)(Lc + 2080); s0 = fmaf(x40, l[0], s0); s1 = fmaf(x41, l[1], s1); s2 = fmaf(x42, l[2], s2); s3 = fmaf(x43, l[3], s3); } { const f32x4 l = *(const LAS f32x4*)(Lc + 2084); s0 = fmaf(x44, l[0], s0); s1 = fmaf(x45, l[1], s1); s2 = fmaf(x46, l[2], s2); s3 = fmaf(x47, l[3], s3); } { const f32x4 l = *(const LAS f32x4*)(Lc + 2088); s0 = fmaf(x48, l[0], s0); s1 = fmaf(x49, l[1], s1); s2 = fmaf(x50, l[2], s2); s3 = fmaf(x51, l[3], s3); } { const f32x4 l = *(const LAS f32x4*)(Lc + 2092); s0 = fmaf(x52, l[0], s0); s1 = fmaf(x53, l[1], s1); s2 = fmaf(x54, l[2], s2); s3 = fmaf(x55, l[3], s3); } { const f32x4 l = *(const LAS f32x4*)(Lc + 2096); s0 = fmaf(x56, l[0], s0); s1 = fmaf(x57, l[1], s1); s2 = fmaf(x58, l[2], s2); s3 = fmaf(x59, l[3], s3); } { const f32x4 l = *(const LAS f32x4*)(Lc + 2100); s0 = fmaf(x60, l[0], s0); s1 = fmaf(x61, l[1], s1); s2 = fmaf(x62, l[2], s2); s3 = fmaf(x63, l[3], s3); } x30 = (lane == 30) ? 1.0f : -((s0 + s1) + (s2 + s3)); asm volatile("" : "+v"(x30) : : "memory"); }
    { float s0 = 0.f, s1 = 0.f, s2 = 0.f, s3 = 0.f; { const f32x4 l = *(const LAS f32x4*)(Lc + 2000); s2 = fmaf(x30, l[2], s2); s3 = fmaf(x31, l[3], s3); } { const f32x4 l = *(const LAS f32x4*)(Lc + 2004); s0 = fmaf(x32, l[0], s0); s1 = fmaf(x33, l[1], s1); s2 = fmaf(x34, l[2], s2); s3 = fmaf(x35, l[3], s3); } { const f32x4 l = *(const LAS f32x4*)(Lc + 2008); s0 = fmaf(x36, l[0], s0); s1 = fmaf(x37, l[1], s1); s2 = fmaf(x38, l[2], s2); s3 = fmaf(x39, l[3], s3); } { const f32x4 l = *(const LAS f32x4*)(Lc + 2012); s0 = fmaf(x40, l[0], s0); s1 = fmaf(x41, l[1], s1); s2 = fmaf(x42, l[2], s2); s3 = fmaf(x43, l[3], s3); } { const f32x4 l = *(const LAS f32x4*)(Lc + 2016); s0 = fmaf(x44, l[0], s0); s1 = fmaf(x45, l[1], s1); s2 = fmaf(x46, l[2], s2); s3 = fmaf(x47, l[3], s3); } { const f32x4 l = *(const LAS f32x4*)(Lc + 2020); s0 = fmaf(x48, l[0], s0); s1 = fmaf(x49, l[1], s1); s2 = fmaf(x50, l[2], s2); s3 = fmaf(x51, l[3], s3); } { const f32x4 l = *(const LAS f32x4*)(Lc + 2024); s0 = fmaf(x52, l[0], s0); s1 = fmaf(x53, l[1], s1); s2 = fmaf(x54, l[2], s2); s3 = fmaf(x55, l[3], s3); } { const f32x4 l = *(const LAS f32x4*)(Lc + 2028); s0 = fmaf(x56, l[0], s0); s1 = fmaf(x57, l[1], s1); s2 = fmaf(x58, l[2], s2); s3 = fmaf(x59, l[3], s3); } { const f32x4 l = *(const LAS f32x4*)(Lc + 2032); s0 = fmaf(x60, l[0], s0); s1 = fmaf(x61, l[1], s1); s2 = fmaf(x62, l[2], s2); s3 = fmaf(x63, l[3], s3); } x29 = (lane == 29) ? 1.0f : -((s0 + s1) + (s2 + s3)); asm volatile("" : "+v"(x29) : : "memory"); }
    { float s0 = 0.f, s1 = 0.f, s2 = 0.f, s3 = 0.f; { const f32x4 l = *(const LAS f32x4*)(Lc + 1932); s1 = fmaf(x29, l[1], s1); s2 = fmaf(x30, l[2], s2); s3 = fmaf(x31, l[3], s3); } { const f32x4 l = *(const LAS f32x4*)(Lc + 1936); s0 = fmaf(x32, l[0], s0); s1 = fmaf(x33, l[1], s1); s2 = fmaf(x34, l[2], s2); s3 = fmaf(x35, l[3], s3); } { const f32x4 l = *(const LAS f32x4*)(Lc + 1940); s0 = fmaf(x36, l[0], s0); s1 = fmaf(x37, l[1], s1); s2 = fmaf(x38, l[2], s2); s3 = fmaf(x39, l[3], s3); } { const f32x4 l = *(const LAS f32x4*)(Lc + 1944); s0 = fmaf(x40, l[0], s0); s1 = fmaf(x41, l[1], s1); s2 = fmaf(x42, l[2], s2); s3 = fmaf(x43, l[3], s3); } { const f32x4 l = *(const LAS f32x4*)(Lc + 1948); s0 = fmaf(x44, l[0], s0); s1 = fmaf(x45, l[1], s1); s2 = fmaf(x46, l[2], s2); s3 = fmaf(x47, l[3], s3); } { const f32x4 l = *(const LAS f32x4*)(Lc + 1952); s0 = fmaf(x48, l[0], s0); s1 = fmaf(x49, l[1], s1); s2 = fmaf(x50, l[2], s2); s3 = fmaf(x51, l[3], s3); } { const f32x4 l = *(const LAS f32x4*)(Lc + 1956); s0 = fmaf(x52, l[0], s0); s1 = fmaf(x53, l[1], s1); s2 = fmaf(x54, l[2], s2); s3 = fmaf(x55, l[3], s3); } { const f32x4 l = *(const LAS f32x4*)(Lc + 1960); s0 = fmaf(x56, l[0], s0); s1 = fmaf(x57, l[1], s1); s2 = fmaf(x58, l[2], s2); s3 = fmaf(x59, l[3], s3); } { const f32x4 l = *(const LAS f32x4*)(Lc + 1964); s0 = fmaf(x60, l[0], s0); s1 = fmaf(x61, l[1], s1); s2 = fmaf(x62, l[2], s2); s3 = fmaf(x63, l[3], s3); } x28 = (lane == 28) ? 1.0f : -((s0 + s1) + (s2 + s3)); asm volatile("" : "+v"(x28) : : "memory"); }
    { float s0 = 0.f, s1 = 0.f, s2 = 0.f, s3 = 0.f; { const f32x4 l = *(const LAS f32x4*)(Lc + 1864); s0 = fmaf(x28, l[0], s0); s1 = fmaf(x29, l[1], s1); s2 = fmaf(x30, l[2], s2); s3 = fmaf(x31, l[3], s3); } { const f32x4 l = *(const LAS f32x4*)(Lc + 1868); s0 = fmaf(x32, l[0], s0); s1 = fmaf(x33, l[1], s1); s2 = fmaf(x34, l[2], s2); s3 = fmaf(x35, l[3], s3); } { const f32x4 l = *(const LAS f32x4*)(Lc + 1872); s0 = fmaf(x36, l[0], s0); s1 = fmaf(x37, l[1], s1); s2 = fmaf(x38, l[2], s2); s3 = fmaf(x39, l[3], s3); } { const f32x4 l = *(const LAS f32x4*)(Lc + 1876); s0 = fmaf(x40, l[0], s0); s1 = fmaf(x41, l[1], s1); s2 = fmaf(x42, l[2], s2); s3 = fmaf(x43, l[3], s3); } { const f32x4 l = *(const LAS f32x4*)(Lc + 1880); s0 = fmaf(x44, l[0], s0); s1 = fmaf(x45, l[1], s1); s2 = fmaf(x46, l[2], s2); s3 = fmaf(x47, l[3], s3); } { const f32x4 l = *(const LAS f32x4*)(Lc + 1884); s0 = fmaf(x48, l[0], s0); s1 = fmaf(x49, l[1], s1); s2 = fmaf(x50, l[2], s2); s3 = fmaf(x51, l[3], s3); } { const f32x4 l = *(const LAS f32x4*)(Lc + 1888); s0 = fmaf(x52, l[0], s0); s1 = fmaf(x53, l[1], s1); s2 = fmaf(x54, l[2], s2); s3 = fmaf(x55, l[3], s3); } { const f32x4 l = *(const LAS f32x4*)(Lc + 1892); s0 = fmaf(x56, l[0], s0); s1 = fmaf(x57, l[1], s1); s2 = fmaf(x58, l[2], s2); s3 = fmaf(x59, l[3], s3); } { const f32x4 l = *(const LAS f32x4*)(Lc + 1896); s0 = fmaf(x60, l[0], s0); s1 = fmaf(x61, l[1], s1); s2 = fmaf(x62, l[2], s2); s3 = fmaf(x63, l[3], s3); } x27 = (lane == 27) ? 1.0f : -((s0 + s1) + (s2 + s3)); asm volatile("" : "+v"(x27) : : "memory"); }
    { float s0 = 0.f, s1 = 0.f, s2 = 0.f, s3 = 0.f; { const f32x4 l = *(const LAS f32x4*)(Lc + 1792); s3 = fmaf(x27, l[3], s3); } { const f32x4 l = *(const LAS f32x4*)(Lc + 1796); s0 = fmaf(x28, l[0], s0); s1 = fmaf(x29, l[1], s1); s2 = fmaf(x30, l[2], s2); s3 = fmaf(x31, l[3], s3); } { const f32x4 l = *(const LAS f32x4*)(Lc + 1800); s0 = fmaf(x32, l[0], s0); s1 = fmaf(x33, l[1], s1); s2 = fmaf(x34, l[2], s2); s3 = fmaf(x35, l[3], s3); } { const f32x4 l = *(const LAS f32x4*)(Lc + 1804); s0 = fmaf(x36, l[0], s0); s1 = fmaf(x37, l[1], s1); s2 = fmaf(x38, l[2], s2); s3 = fmaf(x39, l[3], s3); } { const f32x4 l = *(const LAS f32x4*)(Lc + 1808); s0 = fmaf(x40, l[0], s0); s1 = fmaf(x41, l[1], s1); s2 = fmaf(x42, l[2], s2); s3 = fmaf(x43, l[3], s3); } { const f32x4 l = *(const LAS f32x4*)(Lc + 1812); s0 = fmaf(x44, l[0], s0); s1 = fmaf(x45, l[1], s1); s2 = fmaf(x46, l[2], s2); s3 = fmaf(x47, l[3], s3); } { const f32x4 l = *(const LAS f32x4*)(Lc + 1816); s0 = fmaf(x48, l[0], s0); s1 = fmaf(x49, l[1], s1); s2 = fmaf(x50, l[2], s2); s3 = fmaf(x51, l[3], s3); } { const f32x4 l = *(const LAS f32x4*)(Lc + 1820); s0 = fmaf(x52, l[0], s0); s1 = fmaf(x53, l[1], s1); s2 = fmaf(x54, l[2], s2); s3 = fmaf(x55, l[3], s3); } { const f32x4 l = *(const LAS f32x4*)(Lc + 1824); s0 = fmaf(x56, l[0], s0); s1 = fmaf(x57, l[1], s1); s2 = fmaf(x58, l[2], s2); s3 = fmaf(x59, l[3], s3); } { const f32x4 l = *(const LAS f32x4*)(Lc + 1828); s0 = fmaf(x60, l[0], s0); s1 = fmaf(x61, l[1], s1); s2 = fmaf(x62, l[2], s2); s3 = fmaf(x63, l[3], s3); } x26 = (lane == 26) ? 1.0f : -((s0 + s1) + (s2 + s3)); asm volatile("" : "+v"(x26) : : "memory"); }
    { float s0 = 0.f, s1 = 0.f, s2 = 0.f, s3 = 0.f; { const f32x4 l = *(const LAS f32x4*)(Lc + 1724); s2 = fmaf(x26, l[2], s2); s3 = fmaf(x27, l[3], s3); } { const f32x4 l = *(const LAS f32x4*)(Lc + 1728); s0 = fmaf(x28, l[0], s0); s1 = fmaf(x29, l[1], s1); s2 = fmaf(x30, l[2], s2); s3 = fmaf(x31, l[3], s3); } { const f32x4 l = *(const LAS f32x4*)(Lc + 1732); s0 = fmaf(x32, l[0], s0); s1 = fmaf(x33, l[1], s1); s2 = fmaf(x34, l[2], s2); s3 = fmaf(x35, l[3], s3); } { const f32x4 l = *(const LAS f32x4*)(Lc + 1736); s0 = fmaf(x36, l[0], s0); s1 = fmaf(x37, l[1], s1); s2 = fmaf(x38, l[2], s2); s3 = fmaf(x39, l[3], s3); } { const f32x4 l = *(const LAS f32x4*)(Lc + 1740); s0 = fmaf(x40, l[0], s0); s1 = fmaf(x41, l[1], s1); s2 = fmaf(x42, l[2], s2); s3 = fmaf(x43, l[3], s3); } { const f32x4 l = *(const LAS f32x4*)(Lc + 1744); s0 = fmaf(x44, l[0], s0); s1 = fmaf(x45, l[1], s1); s2 = fmaf(x46, l[2], s2); s3 = fmaf(x47, l[3], s3); } { const f32x4 l = *(const LAS f32x4*)(Lc + 1748); s0 = fmaf(x48, l[0], s0); s1 = fmaf(x49, l[1], s1); s2 = fmaf(x50, l[2], s2); s3 = fmaf(x51, l[3], s3); } { const f32x4 l = *(const LAS f32x4*)(Lc + 1752); s0 = fmaf(x52, l[0], s0); s1 = fmaf(x53, l[1], s1); s2 = fmaf(x54, l[2], s2); s3 = fmaf(x55, l[3], s3); } { const f32x4 l = *(const LAS f32x4*)(Lc + 1756); s0 = fmaf(x56, l[0], s0); s1 = fmaf(x57, l[1], s1); s2 = fmaf(x58, l[2], s2); s3 = fmaf(x59, l[3], s3); } { const f32x4 l = *(const LAS f32x4*)(Lc + 1760); s0 = fmaf(x60, l[0], s0); s1 = fmaf(x61, l[1], s1); s2 = fmaf(x62, l[2], s2); s3 = fmaf(x63, l[3], s3); } x25 = (lane == 25) ? 1.0f : -((s0 + s1) + (s2 + s3)); asm volatile("" : "+v"(x25) : : "memory"); }
    { float s0 = 0.f, s1 = 0.f, s2 = 0.f, s3 = 0.f; { const f32x4 l = *(const LAS f32x4*)(Lc + 1656); s1 = fmaf(x25, l[1], s1); s2 = fmaf(x26, l[2], s2); s3 = fmaf(x27, l[3], s3); } { const f32x4 l = *(const LAS f32x4*)(Lc + 1660); s0 = fmaf(x28, l[0], s0); s1 = fmaf(x29, l[1], s1); s2 = fmaf(x30, l[2], s2); s3 = fmaf(x31, l[3], s3); } { const f32x4 l = *(const LAS f32x4*)(Lc + 1664); s0 = fmaf(x32, l[0], s0); s1 = fmaf(x33, l[1], s1); s2 = fmaf(x34, l[2], s2); s3 = fmaf(x35, l[3], s3); } { const f32x4 l = *(const LAS f32x4*)(Lc + 1668); s0 = fmaf(x36, l[0], s0); s1 = fmaf(x37, l[1], s1); s2 = fmaf(x38, l[2], s2); s3 = fmaf(x39, l[3], s3); } { const f32x4 l = *(const LAS f32x4*)(Lc + 1672); s0 = fmaf(x40, l[0], s0); s1 = fmaf(x41, l[1], s1); s2 = fmaf(x42, l[2], s2); s3 = fmaf(x43, l[3], s3); } { const f32x4 l = *(const LAS f32x4*)(Lc + 1676); s0 = fmaf(x44, l[0], s0); s1 = fmaf(x45, l[1], s1); s2 = fmaf(x46, l[2], s2); s3 = fmaf(x47, l[3], s3); } { const f32x4 l = *(const LAS f32x4*)(Lc + 1680); s0 = fmaf(x48, l[0], s0); s1 = fmaf(x49, l[1], s1); s2 = fmaf(x50, l[2], s2); s3 = fmaf(x51, l[3], s3); } { const f32x4 l = *(const LAS f32x4*)(Lc + 1684); s0 = fmaf(x52, l[0], s0); s1 = fmaf(x53, l[1], s1); s2 = fmaf(x54, l[2], s2); s3 = fmaf(x55, l[3], s3); } { const f32x4 l = *(const LAS f32x4*)(Lc + 1688); s0 = fmaf(x56, l[0], s0); s1 = fmaf(x57, l[1], s1); s2 = fmaf(x58, l[2], s2); s3 = fmaf(x59, l[3], s3); } { const f32x4 l = *(const LAS f32x4*)(Lc + 1692); s0 = fmaf(x60, l[0], s0); s1 = fmaf(x61, l[1], s1); s2 = fmaf(x62, l[2], s2); s3 = fmaf(x63, l[3], s3); } x24 = (lane == 24) ? 1.0f : -((s0 + s1) + (s2 + s3)); asm volatile("" : "+v"(x24) : : "memory"); }
    { float s0 = 0.f, s1 = 0.f, s2 = 0.f, s3 = 0.f; { const f32x4 l = *(const LAS f32x4*)(Lc + 1588); s0 = fmaf(x24, l[0], s0); s1 = fmaf(x25, l[1], s1); s2 = fmaf(x26, l[2], s2); s3 = fmaf(x27, l[3], s3); } { const f32x4 l = *(const LAS f32x4*)(Lc + 1592); s0 = fmaf(x28, l[0], s0); s1 = fmaf(x29, l[1], s1); s2 = fmaf(x30, l[2], s2); s3 = fmaf(x31, l[3], s3); } { const f32x4 l = *(const LAS f32x4*)(Lc + 1596); s0 = fmaf(x32, l[0], s0); s1 = fmaf(x33, l[1], s1); s2 = fmaf(x34, l[2], s2); s3 = fmaf(x35, l[3], s3); } { const f32x4 l = *(const LAS f32x4*)(Lc + 1600); s0 = fmaf(x36, l[0], s0); s1 = fmaf(x37, l[1], s1); s2 = fmaf(x38, l[2], s2); s3 = fmaf(x39, l[3], s3); } { const f32x4 l = *(const LAS f32x4*)(Lc + 1604); s0 = fmaf(x40, l[0], s0); s1 = fmaf(x41, l[1], s1); s2 = fmaf(x42, l[2], s2); s3 = fmaf(x43, l[3], s3); } { const f32x4 l = *(const LAS f32x4*)(Lc + 1608); s0 = fmaf(x44, l[0], s0); s1 = fmaf(x45, l[1], s1); s2 = fmaf(x46, l[2], s2); s3 = fmaf(x47, l[3], s3); } { const f32x4 l = *(const LAS f32x4*)(Lc + 1612); s0 = fmaf(x48, l[0], s0); s1 = fmaf(x49, l[1], s1); s2 = fmaf(x50, l[2], s2); s3 = fmaf(x51, l[3], s3); } { const f32x4 l = *(const LAS f32x4*)(Lc + 1616); s0 = fmaf(x52, l[0], s0); s1 = fmaf(x53, l[1], s1); s2 = fmaf(x54, l[2], s2); s3 = fmaf(x55, l[3], s3); } { const f32x4 l = *(const LAS f32x4*)(Lc + 1620); s0 = fmaf(x56, l[0], s0); s1 = fmaf(x57, l[1], s1); s2 = fmaf(x58, l[2], s2); s3 = fmaf(x59, l[3], s3); } { const f32x4 l = *(const LAS f32x4*)(Lc + 1624); s0 = fmaf(x60, l[0], s0); s1 = fmaf(x61, l[1], s1); s2 = fmaf(x62, l[2], s2); s3 = fmaf(x63, l[3], s3); } x23 = (lane == 23) ? 1.0f : -((s0 + s1) + (s2 + s3)); asm volatile("" : "+v"(x23) : : "memory"); }
    { float s0 = 0.f, s1 = 0.f, s2 = 0.f, s3 = 0.f; { const f32x4 l = *(const LAS f32x4*)(Lc + 1516); s3 = fmaf(x23, l[3], s3); } { const f32x4 l = *(const LAS f32x4*)(Lc + 1520); s0 = fmaf(x24, l[0], s0); s1 = fmaf(x25, l[1], s1); s2 = fmaf(x26, l[2], s2); s3 = fmaf(x27, l[3], s3); } { const f32x4 l = *(const LAS f32x4*)(Lc + 1524); s0 = fmaf(x28, l[0], s0); s1 = fmaf(x29, l[1], s1); s2 = fmaf(x30, l[2], s2); s3 = fmaf(x31, l[3], s3); } { const f32x4 l = *(const LAS f32x4*)(Lc + 1528); s0 = fmaf(x32, l[0], s0); s1 = fmaf(x33, l[1], s1); s2 = fmaf(x34, l[2], s2); s3 = fmaf(x35, l[3], s3); } { const f32x4 l = *(const LAS f32x4*)(Lc + 1532); s0 = fmaf(x36, l[0], s0); s1 = fmaf(x37, l[1], s1); s2 = fmaf(x38, l[2], s2); s3 = fmaf(x39, l[3], s3); } { const f32x4 l = *(const LAS f32x4*)(Lc + 1536); s0 = fmaf(x40, l[0], s0); s1 = fmaf(x41, l[1], s1); s2 = fmaf(x42, l[2], s2); s3 = fmaf(x43, l[3], s3); } { const f32x4 l = *(const LAS f32x4*)(Lc + 1540); s0 = fmaf(x44, l[0], s0); s1 = fmaf(x45, l[1], s1); s2 = fmaf(x46, l[2], s2); s3 = fmaf(x47, l[3], s3); } { const f32x4 l = *(const LAS f32x4*)(Lc + 1544); s0 = fmaf(x48, l[0], s0); s1 = fmaf(x49, l[1], s1); s2 = fmaf(x50, l[2], s2); s3 = fmaf(x51, l[3], s3); } { const f32x4 l = *(const LAS f32x4*)(Lc + 1548); s0 = fmaf(x52, l[0], s0); s1 = fmaf(x53, l[1], s1); s2 = fmaf(x54, l[2], s2); s3 = fmaf(x55, l[3], s3); } { const f32x4 l = *(const LAS f32x4*)(Lc + 1552); s0 = fmaf(x56, l[0], s0); s1 = fmaf(x57, l[1], s1); s2 = fmaf(x58, l[2], s2); s3 = fmaf(x59, l[3], s3); } { const f32x4 l = *(const LAS f32x4*)(Lc + 1556); s0 = fmaf(x60, l[0], s0); s1 = fmaf(x61, l[1], s1); s2 = fmaf(x62, l[2], s2); s3 = fmaf(x63, l[3], s3); } x22 = (lane == 22) ? 1.0f : -((s0 + s1) + (s2 + s3)); asm volatile("" : "+v"(x22) : : "memory"); }
    { float s0 = 0.f, s1 = 0.f, s2 = 0.f, s3 = 0.f; { const f32x4 l = *(const LAS f32x4*)(Lc + 1448); s2 = fmaf(x22, l[2], s2); s3 = fmaf(x23, l[3], s3); } { const f32x4 l = *(const LAS f32x4*)(Lc + 1452); s0 = fmaf(x24, l[0], s0); s1 = fmaf(x25, l[1], s1); s2 = fmaf(x26, l[2], s2); s3 = fmaf(x27, l[3], s3); } { const f32x4 l = *(const LAS f32x4*)(Lc + 1456); s0 = fmaf(x28, l[0], s0); s1 = fmaf(x29, l[1], s1); s2 = fmaf(x30, l[2], s2); s3 = fmaf(x31, l[3], s3); } { const f32x4 l = *(const LAS f32x4*)(Lc + 1460); s0 = fmaf(x32, l[0], s0); s1 = fmaf(x33, l[1], s1); s2 = fmaf(x34, l[2], s2); s3 = fmaf(x35, l[3], s3); } { const f32x4 l = *(const LAS f32x4*)(Lc + 1464); s0 = fmaf(x36, l[0], s0); s1 = fmaf(x37, l[1], s1); s2 = fmaf(x38, l[2], s2); s3 = fmaf(x39, l[3], s3); } { const f32x4 l = *(const LAS f32x4*)(Lc + 1468); s0 = fmaf(x40, l[0], s0); s1 = fmaf(x41, l[1], s1); s2 = fmaf(x42, l[2], s2); s3 = fmaf(x43, l[3], s3); } { const f32x4 l = *(const LAS f32x4*)(Lc + 1472); s0 = fmaf(x44, l[0], s0); s1 = fmaf(x45, l[1], s1); s2 = fmaf(x46, l[2], s2); s3 = fmaf(x47, l[3], s3); } { const f32x4 l = *(const LAS f32x4*)(Lc + 1476); s0 = fmaf(x48, l[0], s0); s1 = fmaf(x49, l[1], s1); s2 = fmaf(x50, l[2], s2); s3 = fmaf(x51, l[3], s3); } { const f32x4 l = *(const LAS f32x4*)(Lc + 1480); s0 = fmaf(x52, l[0], s0); s1 = fmaf(x53, l[1], s1); s2 = fmaf(x54, l[2], s2); s3 = fmaf(x55, l[3], s3); } { const f32x4 l = *(const LAS f32x4*)(Lc + 1484); s0 = fmaf(x56, l[0], s0); s1 = fmaf(x57, l[1], s1); s2 = fmaf(x58, l[2], s2); s3 = fmaf(x59, l[3], s3); } { const f32x4 l = *(const LAS f32x4*)(Lc + 1488); s0 = fmaf(x60, l[0], s0); s1 = fmaf(x61, l[1], s1); s2 = fmaf(x62, l[2], s2); s3 = fmaf(x63, l[3], s3); } x21 = (lane == 21) ? 1.0f : -((s0 + s1) + (s2 + s3)); asm volatile("" : "+v"(x21) : : "memory"); }
    { float s0 = 0.f, s1 = 0.f, s2 = 0.f, s3 = 0.f; { const f32x4 l = *(const LAS f32x4*)(Lc + 1380); s1 = fmaf(x21, l[1], s1); s2 = fmaf(x22, l[2], s2); s3 = fmaf(x23, l[3], s3); } { const f32x4 l = *(const LAS f32x4*)(Lc + 1384); s0 = fmaf(x24, l[0], s0); s1 = fmaf(x25, l[1], s1); s2 = fmaf(x26, l[2], s2); s3 = fmaf(x27, l[3], s3); } { const f32x4 l = *(const LAS f32x4*)(Lc + 1388); s0 = fmaf(x28, l[0], s0); s1 = fmaf(x29, l[1], s1); s2 = fmaf(x30, l[2], s2); s3 = fmaf(x31, l[3], s3); } { const f32x4 l = *(const LAS f32x4*)(Lc + 1392); s0 = fmaf(x32, l[0], s0); s1 = fmaf(x33, l[1], s1); s2 = fmaf(x34, l[2], s2); s3 = fmaf(x35, l[3], s3); } { const f32x4 l = *(const LAS f32x4*)(Lc + 1396); s0 = fmaf(x36, l[0], s0); s1 = fmaf(x37, l[1], s1); s2 = fmaf(x38, l[2], s2); s3 = fmaf(x39, l[3], s3); } { const f32x4 l = *(const LAS f32x4*)(Lc + 1400); s0 = fmaf(x40, l[0], s0); s1 = fmaf(x41, l[1], s1); s2 = fmaf(x42, l[2], s2); s3 = fmaf(x43, l[3], s3); } { const f32x4 l = *(const LAS f32x4*)(Lc + 1404); s0 = fmaf(x44, l[0], s0); s1 = fmaf(x45, l[1], s1); s2 = fmaf(x46, l[2], s2); s3 = fmaf(x47, l[3], s3); } { const f32x4 l = *(const LAS f32x4*)(Lc + 1408); s0 = fmaf(x48, l[0], s0); s1 = fmaf(x49, l[1], s1); s2 = fmaf(x50, l[2], s2); s3 = fmaf(x51, l[3], s3); } { const f32x4 l = *(const LAS f32x4*)(Lc + 1412); s0 = fmaf(x52, l[0], s0); s1 = fmaf(x53, l[1], s1); s2 = fmaf(x54, l[2], s2); s3 = fmaf(x55, l[3], s3); } { const f32x4 l = *(const LAS f32x4*)(Lc + 1416); s0 = fmaf(x56, l[0], s0); s1 = fmaf(x57, l[1], s1); s2 = fmaf(x58, l[2], s2); s3 = fmaf(x59, l[3], s3); } { const f32x4 l = *(const LAS f32x4*)(Lc + 1420); s0 = fmaf(x60, l[0], s0); s1 = fmaf(x61, l[1], s1); s2 = fmaf(x62, l[2], s2); s3 = fmaf(x63, l[3], s3); } x20 = (lane == 20) ? 1.0f : -((s0 + s1) + (s2 + s3)); asm volatile("" : "+v"(x20) : : "memory"); }
    { float s0 = 0.f, s1 = 0.f, s2 = 0.f, s3 = 0.f; { const f32x4 l = *(const LAS f32x4*)(Lc + 1312); s0 = fmaf(x20, l[0], s0); s1 = fmaf(x21, l[1], s1); s2 = fmaf(x22, l[2], s2); s3 = fmaf(x23, l[3], s3); } { const f32x4 l = *(const LAS f32x4*)(Lc + 1316); s0 = fmaf(x24, l[0], s0); s1 = fmaf(x25, l[1], s1); s2 = fmaf(x26, l[2], s2); s3 = fmaf(x27, l[3], s3); } { const f32x4 l = *(const LAS f32x4*)(Lc + 1320); s0 = fmaf(x28, l[0], s0); s1 = fmaf(x29, l[1], s1); s2 = fmaf(x30, l[2], s2); s3 = fmaf(x31, l[3], s3); } { const f32x4 l = *(const LAS f32x4*)(Lc + 1324); s0 = fmaf(x32, l[0], s0); s1 = fmaf(x33, l[1], s1); s2 = fmaf(x34, l[2], s2); s3 = fmaf(x35, l[3], s3); } { const f32x4 l = *(const LAS f32x4*)(Lc + 1328); s0 = fmaf(x36, l[0], s0); s1 = fmaf(x37, l[1], s1); s2 = fmaf(x38, l[2], s2); s3 = fmaf(x39, l[3], s3); } { const f32x4 l = *(const LAS f32x4*)(Lc + 1332); s0 = fmaf(x40, l[0], s0); s1 = fmaf(x41, l[1], s1); s2 = fmaf(x42, l[2], s2); s3 = fmaf(x43, l[3], s3); } { const f32x4 l = *(const LAS f32x4*)(Lc + 1336); s0 = fmaf(x44, l[0], s0); s1 = fmaf(x45, l[1], s1); s2 = fmaf(x46, l[2], s2); s3 = fmaf(x47, l[3], s3); } { const f32x4 l = *(const LAS f32x4*)(Lc + 1340); s0 = fmaf(x48, l[0], s0); s1 = fmaf(x49, l[1], s1); s2 = fmaf(x50, l[2], s2); s3 = fmaf(x51, l[3], s3); } { const f32x4 l = *(const LAS f32x4*)(Lc + 1344); s0 = fmaf(x52, l[0], s0); s1 = fmaf(x53, l[1], s1); s2 = fmaf(x54, l[2], s2); s3 = fmaf(x55, l[3], s3); } { const f32x4 l = *(const LAS f32x4*)(Lc + 1348); s0 = fmaf(x56, l[0], s0); s1 = fmaf(x57, l[1], s1); s2 = fmaf(x58, l[2], s2); s3 = fmaf(x59, l[3], s3); } { const f32x4 l = *(const LAS f32x4*)(Lc + 1352); s0 = fmaf(x60, l[0], s0); s1 = fmaf(x61, l[1], s1); s2 = fmaf(x62, l[2], s2); s3 = fmaf(x63, l[3], s3); } x19 = (lane == 19) ? 1.0f : -((s0 + s1) + (s2 + s3)); asm volatile("" : "+v"(x19) : : "memory"); }
    { float s0 = 0.f, s1 = 0.f, s2 = 0.f, s3 = 0.f; { const f32x4 l = *(const LAS f32x4*)(Lc + 1240); s3 = fmaf(x19, l[3], s3); } { const f32x4 l = *(const LAS f32x4*)(Lc + 1244); s0 = fmaf(x20, l[0], s0); s1 = fmaf(x21, l[1], s1); s2 = fmaf(x22, l[2], s2); s3 = fmaf(x23, l[3], s3); } { const f32x4 l = *(const LAS f32x4*)(Lc + 1248); s0 = fmaf(x24, l[0], s0); s1 = fmaf(x25, l[1], s1); s2 = fmaf(x26, l[2], s2); s3 = fmaf(x27, l[3], s3); } { const f32x4 l = *(const LAS f32x4*)(Lc + 1252); s0 = fmaf(x28, l[0], s0); s1 = fmaf(x29, l[1], s1); s2 = fmaf(x30, l[2], s2); s3 = fmaf(x31, l[3], s3); } { const f32x4 l = *(const LAS f32x4*)(Lc + 1256); s0 = fmaf(x32, l[0], s0); s1 = fmaf(x33, l[1], s1); s2 = fmaf(x34, l[2], s2); s3 = fmaf(x35, l[3], s3); } { const f32x4 l = *(const LAS f32x4*)(Lc + 1260); s0 = fmaf(x36, l[0], s0); s1 = fmaf(x37, l[1], s1); s2 = fmaf(x38, l[2], s2); s3 = fmaf(x39, l[3], s3); } { const f32x4 l = *(const LAS f32x4*)(Lc + 1264); s0 = fmaf(x40, l[0], s0); s1 = fmaf(x41, l[1], s1); s2 = fmaf(x42, l[2], s2); s3 = fmaf(x43, l[3], s3); } { const f32x4 l = *(const LAS f32x4*)(Lc + 1268); s0 = fmaf(x44, l[0], s0); s1 = fmaf(x45, l[1], s1); s2 = fmaf(x46, l[2], s2); s3 = fmaf(x47, l[3], s3); } { const f32x4 l = *(const LAS f32x4*)(Lc + 1272); s0 = fmaf(x48, l[0], s0); s1 = fmaf(x49, l[1], s1); s2 = fmaf(x50, l[2], s2); s3 = fmaf(x51, l[3], s3); } { const f32x4 l = *(const LAS f32x4*)(Lc + 1276); s0 = fmaf(x52, l[0], s0); s1 = fmaf(x53, l[1], s1); s2 = fmaf(x54, l[2], s2); s3 = fmaf(x55, l[3], s3); } { const f32x4 l = *(const LAS f32x4*)(Lc + 1280); s0 = fmaf(x56, l[0], s0); s1 = fmaf(x57, l[1], s1); s2 = fmaf(x58, l[2], s2); s3 = fmaf(x59, l[3], s3); } { const f32x4 l = *(const LAS f32x4*)(Lc + 1284); s0 = fmaf(x60, l[0], s0); s1 = fmaf(x61, l[1], s1); s2 = fmaf(x62, l[2], s2); s3 = fmaf(x63, l[3], s3); } x18 = (lane == 18) ? 1.0f : -((s0 + s1) + (s2 + s3)); asm volatile("" : "+v"(x18) : : "memory"); }
    { float s0 = 0.f, s1 = 0.f, s2 = 0.f, s3 = 0.f; { const f32x4 l = *(const LAS f32x4*)(Lc + 1172); s2 = fmaf(x18, l[2], s2); s3 = fmaf(x19, l[3], s3); } { const f32x4 l = *(const LAS f32x4*)(Lc + 1176); s0 = fmaf(x20, l[0], s0); s1 = fmaf(x21, l[1], s1); s2 = fmaf(x22, l[2], s2); s3 = fmaf(x23, l[3], s3); } { const f32x4 l = *(const LAS f32x4*)(Lc + 1180); s0 = fmaf(x24, l[0], s0); s1 = fmaf(x25, l[1], s1); s2 = fmaf(x26, l[2], s2); s3 = fmaf(x27, l[3], s3); } { const f32x4 l = *(const LAS f32x4*)(Lc + 1184); s0 = fmaf(x28, l[0], s0); s1 = fmaf(x29, l[1], s1); s2 = fmaf(x30, l[2], s2); s3 = fmaf(x31, l[3], s3); } { const f32x4 l = *(const LAS f32x4*)(Lc + 1188); s0 = fmaf(x32, l[0], s0); s1 = fmaf(x33, l[1], s1); s2 = fmaf(x34, l[2], s2); s3 = fmaf(x35, l[3], s3); } { const f32x4 l = *(const LAS f32x4*)(Lc + 1192); s0 = fmaf(x36, l[0], s0); s1 = fmaf(x37, l[1], s1); s2 = fmaf(x38, l[2], s2); s3 = fmaf(x39, l[3], s3); } { const f32x4 l = *(const LAS f32x4*)(Lc + 1196); s0 = fmaf(x40, l[0], s0); s1 = fmaf(x41, l[1], s1); s2 = fmaf(x42, l[2], s2); s3 = fmaf(x43, l[3], s3); } { const f32x4 l = *(const LAS f32x4*)(Lc + 1200); s0 = fmaf(x44, l[0], s0); s1 = fmaf(x45, l[1], s1); s2 = fmaf(x46, l[2], s2); s3 = fmaf(x47, l[3], s3); } { const f32x4 l = *(const LAS f32x4*)(Lc + 1204); s0 = fmaf(x48, l[0], s0); s1 = fmaf(x49, l[1], s1); s2 = fmaf(x50, l[2], s2); s3 = fmaf(x51, l[3], s3); } { const f32x4 l = *(const LAS f32x4*)(Lc + 1208); s0 = fmaf(x52, l[0], s0); s1 = fmaf(x53, l[1], s1); s2 = fmaf(x54, l[2], s2); s3 = fmaf(x55, l[3], s3); } { const f32x4 l = *(const LAS f32x4*)(Lc + 1212); s0 = fmaf(x56, l[0], s0); s1 = fmaf(x57, l[1], s1); s2 = fmaf(x58, l[2], s2); s3 = fmaf(x59, l[3], s3); } { const f32x4 l = *(const LAS f32x4*)(Lc + 1216); s0 = fmaf(x60, l[0], s0); s1 = fmaf(x61, l[1], s1); s2 = fmaf(x62, l[2], s2); s3 = fmaf(x63, l[3], s3); } x17 = (lane == 17) ? 1.0f : -((s0 + s1) + (s2 + s3)); asm volatile("" : "+v"(x17) : : "memory"); }
    { float s0 = 0.f, s1 = 0.f, s2 = 0.f, s3 = 0.f; { const f32x4 l = *(const LAS f32x4*)(Lc + 1104); s1 = fmaf(x17, l[1], s1); s2 = fmaf(x18, l[2], s2); s3 = fmaf(x19, l[3], s3); } { const f32x4 l = *(const LAS f32x4*)(Lc + 1108); s0 = fmaf(x20, l[0], s0); s1 = fmaf(x21, l[1], s1); s2 = fmaf(x22, l[2], s2); s3 = fmaf(x23, l[3], s3); } { const f32x4 l = *(const LAS f32x4*)(Lc + 1112); s0 = fmaf(x24, l[0], s0); s1 = fmaf(x25, l[1], s1); s2 = fmaf(x26, l[2], s2); s3 = fmaf(x27, l[3], s3); } { const f32x4 l = *(const LAS f32x4*)(Lc + 1116); s0 = fmaf(x28, l[0], s0); s1 = fmaf(x29, l[1], s1); s2 = fmaf(x30, l[2], s2); s3 = fmaf(x31, l[3], s3); } { const f32x4 l = *(const LAS f32x4*)(Lc + 1120); s0 = fmaf(x32, l[0], s0); s1 = fmaf(x33, l[1], s1); s2 = fmaf(x34, l[2], s2); s3 = fmaf(x35, l[3], s3); } { const f32x4 l = *(const LAS f32x4*)(Lc + 1124); s0 = fmaf(x36, l[0], s0); s1 = fmaf(x37, l[1], s1); s2 = fmaf(x38, l[2], s2); s3 = fmaf(x39, l[3], s3); } { const f32x4 l = *(const LAS f32x4*)(Lc + 1128); s0 = fmaf(x40, l[0], s0); s1 = fmaf(x41, l[1], s1); s2 = fmaf(x42, l[2], s2); s3 = fmaf(x43, l[3], s3); } { const f32x4 l = *(const LAS f32x4*)(Lc + 1132); s0 = fmaf(x44, l[0], s0); s1 = fmaf(x45, l[1], s1); s2 = fmaf(x46, l[2], s2); s3 = fmaf(x47, l[3], s3); } { const f32x4 l = *(const LAS f32x4*)(Lc + 1136); s0 = fmaf(x48, l[0], s0); s1 = fmaf(x49, l[1], s1); s2 = fmaf(x50, l[2], s2); s3 = fmaf(x51, l[3], s3); } { const f32x4 l = *(const LAS f32x4*)(Lc + 1140); s0 = fmaf(x52, l[0], s0); s1 = fmaf(x53, l[1], s1); s2 = fmaf(x54, l[2], s2); s3 = fmaf(x55, l[3], s3); } { const f32x4 l = *(const LAS f32x4*)(Lc + 1144); s0 = fmaf(x56, l[0], s0); s1 = fmaf(x57, l[1], s1); s2 = fmaf(x58, l[2], s2); s3 = fmaf(x59, l[3], s3); } { const f32x4 l = *(const LAS f32x4*)(Lc + 1148); s0 = fmaf(x60, l[0], s0); s1 = fmaf(x61, l[1], s1); s2 = fmaf(x62, l[2], s2); s3 = fmaf(x63, l[3], s3); } x16 = (lane == 16) ? 1.0f : -((s0 + s1) + (s2 + s3)); asm volatile("" : "+v"(x16) : : "memory"); }
    { float s0 = 0.f, s1 = 0.f, s2 = 0.f, s3 = 0.f; { const f32x4 l = *(const LAS f32x4*)(Lc + 1036); s0 = fmaf(x16, l[0], s0); s1 = fmaf(x17, l[1], s1); s2 = fmaf(x18, l[2], s2); s3 = fmaf(x19, l[3], s3); } { const f32x4 l = *(const LAS f32x4*)(Lc + 1040); s0 = fmaf(x20, l[0], s0); s1 = fmaf(x21, l[1], s1); s2 = fmaf(x22, l[2], s2); s3 = fmaf(x23, l[3], s3); } { const f32x4 l = *(const LAS f32x4*)(Lc + 1044); s0 = fmaf(x24, l[0], s0); s1 = fmaf(x25, l[1], s1); s2 = fmaf(x26, l[2], s2); s3 = fmaf(x27, l[3], s3); } { const f32x4 l = *(const LAS f32x4*)(Lc + 1048); s0 = fmaf(x28, l[0], s0); s1 = fmaf(x29, l[1], s1); s2 = fmaf(x30, l[2], s2); s3 = fmaf(x31, l[3], s3); } { const f32x4 l = *(const LAS f32x4*)(Lc + 1052); s0 = fmaf(x32, l[0], s0); s1 = fmaf(x33, l[1], s1); s2 = fmaf(x34, l[2], s2); s3 = fmaf(x35, l[3], s3); } { const f32x4 l = *(const LAS f32x4*)(Lc + 1056); s0 = fmaf(x36, l[0], s0); s1 = fmaf(x37, l[1], s1); s2 = fmaf(x38, l[2], s2); s3 = fmaf(x39, l[3], s3); } { const f32x4 l = *(const LAS f32x4*)(Lc + 1060); s0 = fmaf(x40, l[0], s0); s1 = fmaf(x41, l[1], s1); s2 = fmaf(x42, l[2], s2); s3 = fmaf(x43, l[3], s3); } { const f32x4 l = *(const LAS f32x4*)(Lc + 1064); s0 = fmaf(x44, l[0], s0); s1 = fmaf(x45, l[1], s1); s2 = fmaf(x46, l[2], s2); s3 = fmaf(x47, l[3], s3); } { const f32x4 l = *(const LAS f32x4*)(Lc + 1068); s0 = fmaf(x48, l[0], s0); s1 = fmaf(x49, l[1], s1); s2 = fmaf(x50, l[2], s2); s3 = fmaf(x51, l[3], s3); } { const f32x4 l = *(const LAS f32x4*)(Lc + 1072); s0 = fmaf(x52, l[0], s0); s1 = fmaf(x53, l[1], s1); s2 = fmaf(x54, l[2], s2); s3 = fmaf(x55, l[3], s3); } { const f32x4 l = *(const LAS f32x4*)(Lc + 1076); s0 = fmaf(x56, l[0], s0); s1 = fmaf(x57, l[1], s1); s2 = fmaf(x58, l[2], s2); s3 = fmaf(x59, l[3], s3); } { const f32x4 l = *(const LAS f32x4*)(Lc + 1080); s0 = fmaf(x60, l[0], s0); s1 = fmaf(x61, l[1], s1); s2 = fmaf(x62, l[2], s2); s3 = fmaf(x63, l[3], s3); } x15 = (lane == 15) ? 1.0f : -((s0 + s1) + (s2 + s3)); asm volatile("" : "+v"(x15) : : "memory"); }
    { float s0 = 0.f, s1 = 0.f, s2 = 0.f, s3 = 0.f; { const f32x4 l = *(const LAS f32x4*)(Lc + 964); s3 = fmaf(x15, l[3], s3); } { const f32x4 l = *(const LAS f32x4*)(Lc + 968); s0 = fmaf(x16, l[0], s0); s1 = fmaf(x17, l[1], s1); s2 = fmaf(x18, l[2], s2); s3 = fmaf(x19, l[3], s3); } { const f32x4 l = *(const LAS f32x4*)(Lc + 972); s0 = fmaf(x20, l[0], s0); s1 = fmaf(x21, l[1], s1); s2 = fmaf(x22, l[2], s2); s3 = fmaf(x23, l[3], s3); } { const f32x4 l = *(const LAS f32x4*)(Lc + 976); s0 = fmaf(x24, l[0], s0); s1 = fmaf(x25, l[1], s1); s2 = fmaf(x26, l[2], s2); s3 = fmaf(x27, l[3], s3); } { const f32x4 l = *(const LAS f32x4*)(Lc + 980); s0 = fmaf(x28, l[0], s0); s1 = fmaf(x29, l[1], s1); s2 = fmaf(x30, l[2], s2); s3 = fmaf(x31, l[3], s3); } { const f32x4 l = *(const LAS f32x4*)(Lc + 984); s0 = fmaf(x32, l[0], s0); s1 = fmaf(x33, l[1], s1); s2 = fmaf(x34, l[2], s2); s3 = fmaf(x35, l[3], s3); } { const f32x4 l = *(const LAS f32x4*)(Lc + 988); s0 = fmaf(x36, l[0], s0); s1 = fmaf(x37, l[1], s1); s2 = fmaf(x38, l[2], s2); s3 = fmaf(x39, l[3], s3); } { const f32x4 l = *(const LAS f32x4*)(Lc + 992); s0 = fmaf(x40, l[0], s0); s1 = fmaf(x41, l[1], s1); s2 = fmaf(x42, l[2], s2); s3 = fmaf(x43, l[3], s3); } { const f32x4 l = *(const LAS f32x4*)(Lc + 996); s0 = fmaf(x44, l[0], s0); s1 = fmaf(x45, l[1], s1); s2 = fmaf(x46, l[2], s2); s3 = fmaf(x47, l[3], s3); } { const f32x4 l = *(const LAS f32x4*)(Lc + 1000); s0 = fmaf(x48, l[0], s0); s1 = fmaf(x49, l[1], s1); s2 = fmaf(x50, l[2], s2); s3 = fmaf(x51, l[3], s3); } { const f32x4 l = *(const LAS f32x4*)(Lc + 1004); s0 = fmaf(x52, l[0], s0); s1 = fmaf(x53, l[1], s1); s2 = fmaf(x54, l[2], s2); s3 = fmaf(x55, l[3], s3); } { const f32x4 l = *(const LAS f32x4*)(Lc + 1008); s0 = fmaf(x56, l[0], s0); s1 = fmaf(x57, l[1], s1); s2 = fmaf(x58, l[2], s2); s3 = fmaf(x59, l[3], s3); } { const f32x4 l = *(const LAS f32x4*)(Lc + 1012); s0 = fmaf(x60, l[0], s0); s1 = fmaf(x61, l[1], s1); s2 = fmaf(x62, l[2], s2); s3 = fmaf(x63, l[3], s3); } x14 = (lane == 14) ? 1.0f : -((s0 + s1) + (s2 + s3)); asm volatile("" : "+v"(x14) : : "memory"); }
    { float s0 = 0.f, s1 = 0.f, s2 = 0.f, s3 = 0.f; { const f32x4 l = *(const LAS f32x4*)(Lc + 896); s2 = fmaf(x14, l[2], s2); s3 = fmaf(x15, l[3], s3); } { const f32x4 l = *(const LAS f32x4*)(Lc + 900); s0 = fmaf(x16, l[0], s0); s1 = fmaf(x17, l[1], s1); s2 = fmaf(x18, l[2], s2); s3 = fmaf(x19, l[3], s3); } { const f32x4 l = *(const LAS f32x4*)(Lc + 904); s0 = fmaf(x20, l[0], s0); s1 = fmaf(x21, l[1], s1); s2 = fmaf(x22, l[2], s2); s3 = fmaf(x23, l[3], s3); } { const f32x4 l = *(const LAS f32x4*)(Lc + 908); s0 = fmaf(x24, l[0], s0); s1 = fmaf(x25, l[1], s1); s2 = fmaf(x26, l[2], s2); s3 = fmaf(x27, l[3], s3); } { const f32x4 l = *(const LAS f32x4*)(Lc + 912); s0 = fmaf(x28, l[0], s0); s1 = fmaf(x29, l[1], s1); s2 = fmaf(x30, l[2], s2); s3 = fmaf(x31, l[3], s3); } { const f32x4 l = *(const LAS f32x4*)(Lc + 916); s0 = fmaf(x32, l[0], s0); s1 = fmaf(x33, l[1], s1); s2 = fmaf(x34, l[2], s2); s3 = fmaf(x35, l[3], s3); } { const f32x4 l = *(const LAS f32x4*)(Lc + 920); s0 = fmaf(x36, l[0], s0); s1 = fmaf(x37, l[1], s1); s2 = fmaf(x38, l[2], s2); s3 = fmaf(x39, l[3], s3); } { const f32x4 l = *(const LAS f32x4*)(Lc + 924); s0 = fmaf(x40, l[0], s0); s1 = fmaf(x41, l[1], s1); s2 = fmaf(x42, l[2], s2); s3 = fmaf(x43, l[3], s3); } { const f32x4 l = *(const LAS f32x4*)(Lc + 928); s0 = fmaf(x44, l[0], s0); s1 = fmaf(x45, l[1], s1); s2 = fmaf(x46, l[2], s2); s3 = fmaf(x47, l[3], s3); } { const f32x4 l = *(const LAS f32x4*)(Lc + 932); s0 = fmaf(x48, l[0], s0); s1 = fmaf(x49, l[1], s1); s2 = fmaf(x50, l[2], s2); s3 = fmaf(x51, l[3], s3); } { const f32x4 l = *(const LAS f32x4*)(Lc + 936); s0 = fmaf(x52, l[0], s0); s1 = fmaf(x53, l[1], s1); s2 = fmaf(x54, l[2], s2); s3 = fmaf(x55, l[3], s3); } { const f32x4 l = *(const LAS f32x4*)(Lc + 940); s0 = fmaf(x56, l[0], s0); s1 = fmaf(x57, l[1], s1); s2 = fmaf(x58, l[2], s2); s3 = fmaf(x59, l[3], s3); } { const f32x4 l = *(const LAS f32x4*)(Lc + 944); s0 = fmaf(x60, l[0], s0); s1 = fmaf(x61, l[1], s1); s2 = fmaf(x62, l[2], s2); s3 = fmaf(x63, l[3], s3); } x13 = (lane == 13) ? 1.0f : -((s0 + s1) + (s2 + s3)); asm volatile("" : "+v"(x13) : : "memory"); }
    { float s0 = 0.f, s1 = 0.f, s2 = 0.f, s3 = 0.f; { const f32x4 l = *(const LAS f32x4*)(Lc + 828); s1 = fmaf(x13, l[1], s1); s2 = fmaf(x14, l[2], s2); s3 = fmaf(x15, l[3], s3); } { const f32x4 l = *(const LAS f32x4*)(Lc + 832); s0 = fmaf(x16, l[0], s0); s1 = fmaf(x17, l[1], s1); s2 = fmaf(x18, l[2], s2); s3 = fmaf(x19, l[3], s3); } { const f32x4 l = *(const LAS f32x4*)(Lc + 836); s0 = fmaf(x20, l[0], s0); s1 = fmaf(x21, l[1], s1); s2 = fmaf(x22, l[2], s2); s3 = fmaf(x23, l[3], s3); } { const f32x4 l = *(const LAS f32x4*)(Lc + 840); s0 = fmaf(x24, l[0], s0); s1 = fmaf(x25, l[1], s1); s2 = fmaf(x26, l[2], s2); s3 = fmaf(x27, l[3], s3); } { const f32x4 l = *(const LAS f32x4*)(Lc + 844); s0 = fmaf(x28, l[0], s0); s1 = fmaf(x29, l[1], s1); s2 = fmaf(x30, l[2], s2); s3 = fmaf(x31, l[3], s3); } { const f32x4 l = *(const LAS f32x4*)(Lc + 848); s0 = fmaf(x32, l[0], s0); s1 = fmaf(x33, l[1], s1); s2 = fmaf(x34, l[2], s2); s3 = fmaf(x35, l[3], s3); } { const f32x4 l = *(const LAS f32x4*)(Lc + 852); s0 = fmaf(x36, l[0], s0); s1 = fmaf(x37, l[1], s1); s2 = fmaf(x38, l[2], s2); s3 = fmaf(x39, l[3], s3); } { const f32x4 l = *(const LAS f32x4*)(Lc + 856); s0 = fmaf(x40, l[0], s0); s1 = fmaf(x41, l[1], s1); s2 = fmaf(x42, l[2], s2); s3 = fmaf(x43, l[3], s3); } { const f32x4 l = *(const LAS f32x4*)(Lc + 860); s0 = fmaf(x44, l[0], s0); s1 = fmaf(x45, l[1], s1); s2 = fmaf(x46, l[2], s2); s3 = fmaf(x47, l[3], s3); } { const f32x4 l = *(const LAS f32x4*)(Lc + 864); s0 = fmaf(x48, l[0], s0); s1 = fmaf(x49, l[1], s1); s2 = fmaf(x50, l[2], s2); s3 = fmaf(x51, l[3], s3); } { const f32x4 l = *(const LAS f32x4*)(Lc + 868); s0 = fmaf(x52, l[0], s0); s1 = fmaf(x53, l[1], s1); s2 = fmaf(x54, l[2], s2); s3 = fmaf(x55, l[3], s3); } { const f32x4 l = *(const LAS f32x4*)(Lc + 872); s0 = fmaf(x56, l[0], s0); s1 = fmaf(x57, l[1], s1); s2 = fmaf(x58, l[2], s2); s3 = fmaf(x59, l[3], s3); } { const f32x4 l = *(const LAS f32x4*)(Lc + 876); s0 = fmaf(x60, l[0], s0); s1 = fmaf(x61, l[1], s1); s2 = fmaf(x62, l[2], s2); s3 = fmaf(x63, l[3], s3); } x12 = (lane == 12) ? 1.0f : -((s0 + s1) + (s2 + s3)); asm volatile("" : "+v"(x12) : : "memory"); }
    { float s0 = 0.f, s1 = 0.f, s2 = 0.f, s3 = 0.f; { const f32x4 l = *(const LAS f32x4*)(Lc + 760); s0 = fmaf(x12, l[0], s0); s1 = fmaf(x13, l[1], s1); s2 = fmaf(x14, l[2], s2); s3 = fmaf(x15, l[3], s3); } { const f32x4 l = *(const LAS f32x4*)(Lc + 764); s0 = fmaf(x16, l[0], s0); s1 = fmaf(x17, l[1], s1); s2 = fmaf(x18, l[2], s2); s3 = fmaf(x19, l[3], s3); } { const f32x4 l = *(const LAS f32x4*)(Lc + 768); s0 = fmaf(x20, l[0], s0); s1 = fmaf(x21, l[1], s1); s2 = fmaf(x22, l[2], s2); s3 = fmaf(x23, l[3], s3); } { const f32x4 l = *(const LAS f32x4*)(Lc + 772); s0 = fmaf(x24, l[0], s0); s1 = fmaf(x25, l[1], s1); s2 = fmaf(x26, l[2], s2); s3 = fmaf(x27, l[3], s3); } { const f32x4 l = *(const LAS f32x4*)(Lc + 776); s0 = fmaf(x28, l[0], s0); s1 = fmaf(x29, l[1], s1); s2 = fmaf(x30, l[2], s2); s3 = fmaf(x31, l[3], s3); } { const f32x4 l = *(const LAS f32x4*)(Lc + 780); s0 = fmaf(x32, l[0], s0); s1 = fmaf(x33, l[1], s1); s2 = fmaf(x34, l[2], s2); s3 = fmaf(x35, l[3], s3); } { const f32x4 l = *(const LAS f32x4*)(Lc + 784); s0 = fmaf(x36, l[0], s0); s1 = fmaf(x37, l[1], s1); s2 = fmaf(x38, l[2], s2); s3 = fmaf(x39, l[3], s3); } { const f32x4 l = *(const LAS f32x4*)(Lc + 788); s0 = fmaf(x40, l[0], s0); s1 = fmaf(x41, l[1], s1); s2 = fmaf(x42, l[2], s2); s3 = fmaf(x43, l[3], s3); } { const f32x4 l = *(const LAS f32x4*)(Lc + 792); s0 = fmaf(x44, l[0], s0); s1 = fmaf(x45, l[1], s1); s2 = fmaf(x46, l[2], s2); s3 = fmaf(x47, l[3], s3); } { const f32x4 l = *(const LAS f32x4*)(Lc + 796); s0 = fmaf(x48, l[0], s0); s1 = fmaf(x49, l[1], s1); s2 = fmaf(x50, l[2], s2); s3 = fmaf(x51, l[3], s3); } { const f32x4 l = *(const LAS f32x4*)(Lc + 800); s0 = fmaf(x52, l[0], s0); s1 = fmaf(x53, l[1], s1); s2 = fmaf(x54, l[2], s2); s3 = fmaf(x55, l[3], s3); } { const f32x4 l = *(const LAS f32x4*)(Lc + 804); s0 = fmaf(x56, l[0], s0); s1 = fmaf(x57, l[1], s1); s2 = fmaf(x58, l[2], s2); s3 = fmaf(x59, l[3], s3); } { const f32x4 l = *(const LAS f32x4*)(Lc + 808); s0 = fmaf(x60, l[0], s0); s1 = fmaf(x61, l[1], s1); s2 = fmaf(x62, l[2], s2); s3 = fmaf(x63, l[3], s3); } x11 = (lane == 11) ? 1.0f : -((s0 + s1) + (s2 + s3)); asm volatile("" : "+v"(x11) : : "memory"); }
    { float s0 = 0.f, s1 = 0.f, s2 = 0.f, s3 = 0.f; { const f32x4 l = *(const LAS f32x4*)(Lc + 688); s3 = fmaf(x11, l[3], s3); } { const f32x4 l = *(const LAS f32x4*)(Lc + 692); s0 = fmaf(x12, l[0], s0); s1 = fmaf(x13, l[1], s1); s2 = fmaf(x14, l[2], s2); s3 = fmaf(x15, l[3], s3); } { const f32x4 l = *(const LAS f32x4*)(Lc + 696); s0 = fmaf(x16, l[0], s0); s1 = fmaf(x17, l[1], s1); s2 = fmaf(x18, l[2], s2); s3 = fmaf(x19, l[3], s3); } { const f32x4 l = *(const LAS f32x4*)(Lc + 700); s0 = fmaf(x20, l[0], s0); s1 = fmaf(x21, l[1], s1); s2 = fmaf(x22, l[2], s2); s3 = fmaf(x23, l[3], s3); } { const f32x4 l = *(const LAS f32x4*)(Lc + 704); s0 = fmaf(x24, l[0], s0); s1 = fmaf(x25, l[1], s1); s2 = fmaf(x26, l[2], s2); s3 = fmaf(x27, l[3], s3); } { const f32x4 l = *(const LAS f32x4*)(Lc + 708); s0 = fmaf(x28, l[0], s0); s1 = fmaf(x29, l[1], s1); s2 = fmaf(x30, l[2], s2); s3 = fmaf(x31, l[3], s3); } { const f32x4 l = *(const LAS f32x4*)(Lc + 712); s0 = fmaf(x32, l[0], s0); s1 = fmaf(x33, l[1], s1); s2 = fmaf(x34, l[2], s2); s3 = fmaf(x35, l[3], s3); } { const f32x4 l = *(const LAS f32x4*)(Lc + 716); s0 = fmaf(x36, l[0], s0); s1 = fmaf(x37, l[1], s1); s2 = fmaf(x38, l[2], s2); s3 = fmaf(x39, l[3], s3); } { const f32x4 l = *(const LAS f32x4*)(Lc + 720); s0 = fmaf(x40, l[0], s0); s1 = fmaf(x41, l[1], s1); s2 = fmaf(x42, l[2], s2); s3 = fmaf(x43, l[3], s3); } { const f32x4 l = *(const LAS f32x4*)(Lc + 724); s0 = fmaf(x44, l[0], s0); s1 = fmaf(x45, l[1], s1); s2 = fmaf(x46, l[2], s2); s3 = fmaf(x47, l[3], s3); } { const f32x4 l = *(const LAS f32x4*)(Lc + 728); s0 = fmaf(x48, l[0], s0); s1 = fmaf(x49, l[1], s1); s2 = fmaf(x50, l[2], s2); s3 = fmaf(x51, l[3], s3); } { const f32x4 l = *(const LAS f32x4*)(Lc + 732); s0 = fmaf(x52, l[0], s0); s1 = fmaf(x53, l[1], s1); s2 = fmaf(x54, l[2], s2); s3 = fmaf(x55, l[3], s3); } { const f32x4 l = *(const LAS f32x4*)(Lc + 736); s0 = fmaf(x56, l[0], s0); s1 = fmaf(x57, l[1], s1); s2 = fmaf(x58, l[2], s2); s3 = fmaf(x59, l[3], s3); } { const f32x4 l = *(const LAS f32x4*)(Lc + 740); s0 = fmaf(x60, l[0], s0); s1 = fmaf(x61, l[1], s1); s2 = fmaf(x62, l[2], s2); s3 = fmaf(x63, l[3], s3); } x10 = (lane == 10) ? 1.0f : -((s0 + s1) + (s2 + s3)); asm volatile("" : "+v"(x10) : : "memory"); }
    { float s0 = 0.f, s1 = 0.f, s2 = 0.f, s3 = 0.f; { const f32x4 l = *(const LAS f32x4*)(Lc + 620); s2 = fmaf(x10, l[2], s2); s3 = fmaf(x11, l[3], s3); } { const f32x4 l = *(const LAS f32x4*)(Lc + 624); s0 = fmaf(x12, l[0], s0); s1 = fmaf(x13, l[1], s1); s2 = fmaf(x14, l[2], s2); s3 = fmaf(x15, l[3], s3); } { const f32x4 l = *(const LAS f32x4*)(Lc + 628); s0 = fmaf(x16, l[0], s0); s1 = fmaf(x17, l[1], s1); s2 = fmaf(x18, l[2], s2); s3 = fmaf(x19, l[3], s3); } { const f32x4 l = *(const LAS f32x4*)(Lc + 632); s0 = fmaf(x20, l[0], s0); s1 = fmaf(x21, l[1], s1); s2 = fmaf(x22, l[2], s2); s3 = fmaf(x23, l[3], s3); } { const f32x4 l = *(const LAS f32x4*)(Lc + 636); s0 = fmaf(x24, l[0], s0); s1 = fmaf(x25, l[1], s1); s2 = fmaf(x26, l[2], s2); s3 = fmaf(x27, l[3], s3); } { const f32x4 l = *(const LAS f32x4*)(Lc + 640); s0 = fmaf(x28, l[0], s0); s1 = fmaf(x29, l[1], s1); s2 = fmaf(x30, l[2], s2); s3 = fmaf(x31, l[3], s3); } { const f32x4 l = *(const LAS f32x4*)(Lc + 644); s0 = fmaf(x32, l[0], s0); s1 = fmaf(x33, l[1], s1); s2 = fmaf(x34, l[2], s2); s3 = fmaf(x35, l[3], s3); } { const f32x4 l = *(const LAS f32x4*)(Lc + 648); s0 = fmaf(x36, l[0], s0); s1 = fmaf(x37, l[1], s1); s2 = fmaf(x38, l[2], s2); s3 = fmaf(x39, l[3], s3); } { const f32x4 l = *(const LAS f32x4*)(Lc + 652); s0 = fmaf(x40, l[0], s0); s1 = fmaf(x41, l[1], s1); s2 = fmaf(x42, l[2], s2); s3 = fmaf(x43, l[3], s3); } { const f32x4 l = *(const LAS f32x4*)(Lc + 656); s0 = fmaf(x44, l[0], s0); s1 = fmaf(x45, l[1], s1); s2 = fmaf(x46, l[2], s2); s3 = fmaf(x47, l[3], s3); } { const f32x4 l = *(const LAS f32x4*)(Lc + 660); s0 = fmaf(x48, l[0], s0); s1 = fmaf(x49, l[1], s1); s2 = fmaf(x50, l[2], s2); s3 = fmaf(x51, l[3], s3); } { const f32x4 l = *(const LAS f32x4*)(Lc + 664); s0 = fmaf(x52, l[0], s0); s1 = fmaf(x53, l[1], s1); s2 = fmaf(x54, l[2], s2); s3 = fmaf(x55, l[3], s3); } { const f32x4 l = *(const LAS f32x4*)(Lc + 668); s0 = fmaf(x56, l[0], s0); s1 = fmaf(x57, l[1], s1); s2 = fmaf(x58, l[2], s2); s3 = fmaf(x59, l[3], s3); } { const f32x4 l = *(const LAS f32x4*)(Lc + 672); s0 = fmaf(x60, l[0], s0); s1 = fmaf(x61, l[1], s1); s2 = fmaf(x62, l[2], s2); s3 = fmaf(x63, l[3], s3); } x9 = (lane == 9) ? 1.0f : -((s0 + s1) + (s2 + s3)); asm volatile("" : "+v"(x9) : : "memory"); }
    { float s0 = 0.f, s1 = 0.f, s2 = 0.f, s3 = 0.f; { const f32x4 l = *(const LAS f32x4*)(Lc + 552); s1 = fmaf(x9, l[1], s1); s2 = fmaf(x10, l[2], s2); s3 = fmaf(x11, l[3], s3); } { const f32x4 l = *(const LAS f32x4*)(Lc + 556); s0 = fmaf(x12, l[0], s0); s1 = fmaf(x13, l[1], s1); s2 = fmaf(x14, l[2], s2); s3 = fmaf(x15, l[3], s3); } { const f32x4 l = *(const LAS f32x4*)(Lc + 560); s0 = fmaf(x16, l[0], s0); s1 = fmaf(x17, l[1], s1); s2 = fmaf(x18, l[2], s2); s3 = fmaf(x19, l[3], s3); } { const f32x4 l = *(const LAS f32x4*)(Lc + 564); s0 = fmaf(x20, l[0], s0); s1 = fmaf(x21, l[1], s1); s2 = fmaf(x22, l[2], s2); s3 = fmaf(x23, l[3], s3); } { const f32x4 l = *(const LAS f32x4*)(Lc + 568); s0 = fmaf(x24, l[0], s0); s1 = fmaf(x25, l[1], s1); s2 = fmaf(x26, l[2], s2); s3 = fmaf(x27, l[3], s3); } { const f32x4 l = *(const LAS f32x4*)(Lc + 572); s0 = fmaf(x28, l[0], s0); s1 = fmaf(x29, l[1], s1); s2 = fmaf(x30, l[2], s2); s3 = fmaf(x31, l[3], s3); } { const f32x4 l = *(const LAS f32x4*)(Lc + 576); s0 = fmaf(x32, l[0], s0); s1 = fmaf(x33, l[1], s1); s2 = fmaf(x34, l[2], s2); s3 = fmaf(x35, l[3], s3); } { const f32x4 l = *(const LAS f32x4*)(Lc + 580); s0 = fmaf(x36, l[0], s0); s1 = fmaf(x37, l[1], s1); s2 = fmaf(x38, l[2], s2); s3 = fmaf(x39, l[3], s3); } { const f32x4 l = *(const LAS f32x4*)(Lc + 584); s0 = fmaf(x40, l[0], s0); s1 = fmaf(x41, l[1], s1); s2 = fmaf(x42, l[2], s2); s3 = fmaf(x43, l[3], s3); } { const f32x4 l = *(const LAS f32x4*)(Lc + 588); s0 = fmaf(x44, l[0], s0); s1 = fmaf(x45, l[1], s1); s2 = fmaf(x46, l[2], s2); s3 = fmaf(x47, l[3], s3); } { const f32x4 l = *(const LAS f32x4*)(Lc + 592); s0 = fmaf(x48, l[0], s0); s1 = fmaf(x49, l[1], s1); s2 = fmaf(x50, l[2], s2); s3 = fmaf(x51, l[3], s3); } { const f32x4 l = *(const LAS f32x4*)(Lc + 596); s0 = fmaf(x52, l[0], s0); s1 = fmaf(x53, l[1], s1); s2 = fmaf(x54, l[2], s2); s3 = fmaf(x55, l[3], s3); } { const f32x4 l = *(const LAS f32x4*)(Lc + 600); s0 = fmaf(x56, l[0], s0); s1 = fmaf(x57, l[1], s1); s2 = fmaf(x58, l[2], s2); s3 = fmaf(x59, l[3], s3); } { const f32x4 l = *(const LAS f32x4*)(Lc + 604); s0 = fmaf(x60, l[0], s0); s1 = fmaf(x61, l[1], s1); s2 = fmaf(x62, l[2], s2); s3 = fmaf(x63, l[3], s3); } x8 = (lane == 8) ? 1.0f : -((s0 + s1) + (s2 + s3)); asm volatile("" : "+v"(x8) : : "memory"); }
    { float s0 = 0.f, s1 = 0.f, s2 = 0.f, s3 = 0.f; { const f32x4 l = *(const LAS f32x4*)(Lc + 484); s0 = fmaf(x8, l[0], s0); s1 = fmaf(x9, l[1], s1); s2 = fmaf(x10, l[2], s2); s3 = fmaf(x11, l[3], s3); } { const f32x4 l = *(const LAS f32x4*)(Lc + 488); s0 = fmaf(x12, l[0], s0); s1 = fmaf(x13, l[1], s1); s2 = fmaf(x14, l[2], s2); s3 = fmaf(x15, l[3], s3); } { const f32x4 l = *(const LAS f32x4*)(Lc + 492); s0 = fmaf(x16, l[0], s0); s1 = fmaf(x17, l[1], s1); s2 = fmaf(x18, l[2], s2); s3 = fmaf(x19, l[3], s3); } { const f32x4 l = *(const LAS f32x4*)(Lc + 496); s0 = fmaf(x20, l[0], s0); s1 = fmaf(x21, l[1], s1); s2 = fmaf(x22, l[2], s2); s3 = fmaf(x23, l[3], s3); } { const f32x4 l = *(const LAS f32x4*)(Lc + 500); s0 = fmaf(x24, l[0], s0); s1 = fmaf(x25, l[1], s1); s2 = fmaf(x26, l[2], s2); s3 = fmaf(x27, l[3], s3); } { const f32x4 l = *(const LAS f32x4*)(Lc + 504); s0 = fmaf(x28, l[0], s0); s1 = fmaf(x29, l[1], s1); s2 = fmaf(x30, l[2], s2); s3 = fmaf(x31, l[3], s3); } { const f32x4 l = *(const LAS f32x4*)(Lc + 508); s0 = fmaf(x32, l[0], s0); s1 = fmaf(x33, l[1], s1); s2 = fmaf(x34, l[2], s2); s3 = fmaf(x35, l[3], s3); } { const f32x4 l = *(const LAS f32x4*)(Lc + 512); s0 = fmaf(x36, l[0], s0); s1 = fmaf(x37, l[1], s1); s2 = fmaf(x38, l[2], s2); s3 = fmaf(x39, l[3], s3); } { const f32x4 l = *(const LAS f32x4*)(Lc + 516); s0 = fmaf(x40, l[0], s0); s1 = fmaf(x41, l[1], s1); s2 = fmaf(x42, l[2], s2); s3 = fmaf(x43, l[3], s3); } { const f32x4 l = *(const LAS f32x4*)(Lc + 520); s0 = fmaf(x44, l[0], s0); s1 = fmaf(x45, l[1], s1); s2 = fmaf(x46, l[2], s2); s3 = fmaf(x47, l[3], s3); } { const f32x4 l = *(const LAS f32x4*)(Lc + 524); s0 = fmaf(x48, l[0], s0); s1 = fmaf(x49, l[1], s1); s2 = fmaf(x50, l[2], s2); s3 = fmaf(x51, l[3], s3); } { const f32x4 l = *(const LAS f32x4*)(Lc + 528); s0 = fmaf(x52, l[0], s0); s1 = fmaf(x53, l[1], s1); s2 = fmaf(x54, l[2], s2); s3 = fmaf(x55, l[3], s3); } { const f32x4 l = *(const LAS f32x4*)(Lc + 532); s0 = fmaf(x56, l[0], s0); s1 = fmaf(x57, l[1], s1); s2 = fmaf(x58, l[2], s2); s3 = fmaf(x59, l[3], s3); } { const f32x4 l = *(const LAS f32x4*)(Lc + 536); s0 = fmaf(x60, l[0], s0); s1 = fmaf(x61, l[1], s1); s2 = fmaf(x62, l[2], s2); s3 = fmaf(x63, l[3], s3); } x7 = (lane == 7) ? 1.0f : -((s0 + s1) + (s2 + s3)); asm volatile("" : "+v"(x7) : : "memory"); }
    { float s0 = 0.f, s1 = 0.f, s2 = 0.f, s3 = 0.f; { const f32x4 l = *(const LAS f32x4*)(Lc + 412); s3 = fmaf(x7, l[3], s3); } { const f32x4 l = *(const LAS f32x4*)(Lc + 416); s0 = fmaf(x8, l[0], s0); s1 = fmaf(x9, l[1], s1); s2 = fmaf(x10, l[2], s2); s3 = fmaf(x11, l[3], s3); } { const f32x4 l = *(const LAS f32x4*)(Lc + 420); s0 = fmaf(x12, l[0], s0); s1 = fmaf(x13, l[1], s1); s2 = fmaf(x14, l[2], s2); s3 = fmaf(x15, l[3], s3); } { const f32x4 l = *(const LAS f32x4*)(Lc + 424); s0 = fmaf(x16, l[0], s0); s1 = fmaf(x17, l[1], s1); s2 = fmaf(x18, l[2], s2); s3 = fmaf(x19, l[3], s3); } { const f32x4 l = *(const LAS f32x4*)(Lc + 428); s0 = fmaf(x20, l[0], s0); s1 = fmaf(x21, l[1], s1); s2 = fmaf(x22, l[2], s2); s3 = fmaf(x23, l[3], s3); } { const f32x4 l = *(const LAS f32x4*)(Lc + 432); s0 = fmaf(x24, l[0], s0); s1 = fmaf(x25, l[1], s1); s2 = fmaf(x26, l[2], s2); s3 = fmaf(x27, l[3], s3); } { const f32x4 l = *(const LAS f32x4*)(Lc + 436); s0 = fmaf(x28, l[0], s0); s1 = fmaf(x29, l[1], s1); s2 = fmaf(x30, l[2], s2); s3 = fmaf(x31, l[3], s3); } { const f32x4 l = *(const LAS f32x4*)(Lc + 440); s0 = fmaf(x32, l[0], s0); s1 = fmaf(x33, l[1], s1); s2 = fmaf(x34, l[2], s2); s3 = fmaf(x35, l[3], s3); } { const f32x4 l = *(const LAS f32x4*)(Lc + 444); s0 = fmaf(x36, l[0], s0); s1 = fmaf(x37, l[1], s1); s2 = fmaf(x38, l[2], s2); s3 = fmaf(x39, l[3], s3); } { const f32x4 l = *(const LAS f32x4*)(Lc + 448); s0 = fmaf(x40, l[0], s0); s1 = fmaf(x41, l[1], s1); s2 = fmaf(x42, l[2], s2); s3 = fmaf(x43, l[3], s3); } { const f32x4 l = *(const LAS f32x4*)(Lc + 452); s0 = fmaf(x44, l[0], s0); s1 = fmaf(x45, l[1], s1); s2 = fmaf(x46, l[2], s2); s3 = fmaf(x47, l[3], s3); } { const f32x4 l = *(const LAS f32x4*)(Lc + 456); s0 = fmaf(x48, l[0], s0); s1 = fmaf(x49, l[1], s1); s2 = fmaf(x50, l[2], s2); s3 = fmaf(x51, l[3], s3); } { const f32x4 l = *(const LAS f32x4*)(Lc + 460); s0 = fmaf(x52, l[0], s0); s1 = fmaf(x53, l[1], s1); s2 = fmaf(x54, l[2], s2); s3 = fmaf(x55, l[3], s3); } { const f32x4 l = *(const LAS f32x4*)(Lc + 464); s0 = fmaf(x56, l[0], s0); s1 = fmaf(x57, l[1], s1); s2 = fmaf(x58, l[2], s2); s3 = fmaf(x59, l[3], s3); } { const f32x4 l = *(const LAS f32x4*)(Lc + 468); s0 = fmaf(x60, l[0], s0); s1 = fmaf(x61, l[1], s1); s2 = fmaf(x62, l[2], s2); s3 = fmaf(x63, l[3], s3); } x6 = (lane == 6) ? 1.0f : -((s0 + s1) + (s2 + s3)); asm volatile("" : "+v"(x6) : : "memory"); }
    { float s0 = 0.f, s1 = 0.f, s2 = 0.f, s3 = 0.f; { const f32x4 l = *(const LAS f32x4*)(Lc + 344); s2 = fmaf(x6, l[2], s2); s3 = fmaf(x7, l[3], s3); } { const f32x4 l = *(const LAS f32x4*)(Lc + 348); s0 = fmaf(x8, l[0], s0); s1 = fmaf(x9, l[1], s1); s2 = fmaf(x10, l[2], s2); s3 = fmaf(x11, l[3], s3); } { const f32x4 l = *(const LAS f32x4*)(Lc + 352); s0 = fmaf(x12, l[0], s0); s1 = fmaf(x13, l[1], s1); s2 = fmaf(x14, l[2], s2); s3 = fmaf(x15, l[3], s3); } { const f32x4 l = *(const LAS f32x4*)(Lc + 356); s0 = fmaf(x16, l[0], s0); s1 = fmaf(x17, l[1], s1); s2 = fmaf(x18, l[2], s2); s3 = fmaf(x19, l[3], s3); } { const f32x4 l = *(const LAS f32x4*)(Lc + 360); s0 = fmaf(x20, l[0], s0); s1 = fmaf(x21, l[1], s1); s2 = fmaf(x22, l[2], s2); s3 = fmaf(x23, l[3], s3); } { const f32x4 l = *(const LAS f32x4*)(Lc + 364); s0 = fmaf(x24, l[0], s0); s1 = fmaf(x25, l[1], s1); s2 = fmaf(x26, l[2], s2); s3 = fmaf(x27, l[3], s3); } { const f32x4 l = *(const LAS f32x4*)(Lc + 368); s0 = fmaf(x28, l[0], s0); s1 = fmaf(x29, l[1], s1); s2 = fmaf(x30, l[2], s2); s3 = fmaf(x31, l[3], s3); } { const f32x4 l = *(const LAS f32x4*)(Lc + 372); s0 = fmaf(x32, l[0], s0); s1 = fmaf(x33, l[1], s1); s2 = fmaf(x34, l[2], s2); s3 = fmaf(x35, l[3], s3); } { const f32x4 l = *(const LAS f32x4*)(Lc + 376); s0 = fmaf(x36, l[0], s0); s1 = fmaf(x37, l[1], s1); s2 = fmaf(x38, l[2], s2); s3 = fmaf(x39, l[3], s3); } { const f32x4 l = *(const LAS f32x4*)(Lc + 380); s0 = fmaf(x40, l[0], s0); s1 = fmaf(x41, l[1], s1); s2 = fmaf(x42, l[2], s2); s3 = fmaf(x43, l[3], s3); } { const f32x4 l = *(const LAS f32x4*)(Lc + 384); s0 = fmaf(x44, l[0], s0); s1 = fmaf(x45, l[1], s1); s2 = fmaf(x46, l[2], s2); s3 = fmaf(x47, l[3], s3); } { const f32x4 l = *(const LAS f32x4*)(Lc + 388); s0 = fmaf(x48, l[0], s0); s1 = fmaf(x49, l[1], s1); s2 = fmaf(x50, l[2], s2); s3 = fmaf(x51, l[3], s3); } { const f32x4 l = *(const LAS f32x4*)(Lc + 392); s0 = fmaf(x52, l[0], s0); s1 = fmaf(x53, l[1], s1); s2 = fmaf(x54, l[2], s2); s3 = fmaf(x55, l[3], s3); } { const f32x4 l = *(const LAS f32x4*)(Lc + 396); s0 = fmaf(x56, l[0], s0); s1 = fmaf(x57, l[1], s1); s2 = fmaf(x58, l[2], s2); s3 = fmaf(x59, l[3], s3); } { const f32x4 l = *(const LAS f32x4*)(Lc + 400); s0 = fmaf(x60, l[0], s0); s1 = fmaf(x61, l[1], s1); s2 = fmaf(x62, l[2], s2); s3 = fmaf(x63, l[3], s3); } x5 = (lane == 5) ? 1.0f : -((s0 + s1) + (s2 + s3)); asm volatile("" : "+v"(x5) : : "memory"); }
    { float s0 = 0.f, s1 = 0.f, s2 = 0.f, s3 = 0.f; { const f32x4 l = *(const LAS f32x4*)(Lc + 276); s1 = fmaf(x5, l[1], s1); s2 = fmaf(x6, l[2], s2); s3 = fmaf(x7, l[3], s3); } { const f32x4 l = *(const LAS f32x4*)(Lc + 280); s0 = fmaf(x8, l[0], s0); s1 = fmaf(x9, l[1], s1); s2 = fmaf(x10, l[2], s2); s3 = fmaf(x11, l[3], s3); } { const f32x4 l = *(const LAS f32x4*)(Lc + 284); s0 = fmaf(x12, l[0], s0); s1 = fmaf(x13, l[1], s1); s2 = fmaf(x14, l[2], s2); s3 = fmaf(x15, l[3], s3); } { const f32x4 l = *(const LAS f32x4*)(Lc + 288); s0 = fmaf(x16, l[0], s0); s1 = fmaf(x17, l[1], s1); s2 = fmaf(x18, l[2], s2); s3 = fmaf(x19, l[3], s3); } { const f32x4 l = *(const LAS f32x4*)(Lc + 292); s0 = fmaf(x20, l[0], s0); s1 = fmaf(x21, l[1], s1); s2 = fmaf(x22, l[2], s2); s3 = fmaf(x23, l[3], s3); } { const f32x4 l = *(const LAS f32x4*)(Lc + 296); s0 = fmaf(x24, l[0], s0); s1 = fmaf(x25, l[1], s1); s2 = fmaf(x26, l[2], s2); s3 = fmaf(x27, l[3], s3); } { const f32x4 l = *(const LAS f32x4*)(Lc + 300); s0 = fmaf(x28, l[0], s0); s1 = fmaf(x29, l[1], s1); s2 = fmaf(x30, l[2], s2); s3 = fmaf(x31, l[3], s3); } { const f32x4 l = *(const LAS f32x4*)(Lc + 304); s0 = fmaf(x32, l[0], s0); s1 = fmaf(x33, l[1], s1); s2 = fmaf(x34, l[2], s2); s3 = fmaf(x35, l[3], s3); } { const f32x4 l = *(const LAS f32x4*)(Lc + 308); s0 = fmaf(x36, l[0], s0); s1 = fmaf(x37, l[1], s1); s2 = fmaf(x38, l[2], s2); s3 = fmaf(x39, l[3], s3); } { const f32x4 l = *(const LAS f32x4*)(Lc + 312); s0 = fmaf(x40, l[0], s0); s1 = fmaf(x41, l[1], s1); s2 = fmaf(x42, l[2], s2); s3 = fmaf(x43, l[3], s3); } { const f32x4 l = *(const LAS f32x4*)(Lc + 316); s0 = fmaf(x44, l[0], s0); s1 = fmaf(x45, l[1], s1); s2 = fmaf(x46, l[2], s2); s3 = fmaf(x47, l[3], s3); } { const f32x4 l = *(const LAS f32x4*)(Lc + 320); s0 = fmaf(x48, l[0], s0); s1 = fmaf(x49, l[1], s1); s2 = fmaf(x50, l[2], s2); s3 = fmaf(x51, l[3], s3); } { const f32x4 l = *(const LAS f32x4*)(Lc + 324); s0 = fmaf(x52, l[0], s0); s1 = fmaf(x53, l[1], s1); s2 = fmaf(x54, l[2], s2); s3 = fmaf(x55, l[3], s3); } { const f32x4 l = *(const LAS f32x4*)(Lc + 328); s0 = fmaf(x56, l[0], s0); s1 = fmaf(x57, l[1], s1); s2 = fmaf(x58, l[2], s2); s3 = fmaf(x59, l[3], s3); } { const f32x4 l = *(const LAS f32x4*)(Lc + 332); s0 = fmaf(x60, l[0], s0); s1 = fmaf(x61, l[1], s1); s2 = fmaf(x62, l[2], s2); s3 = fmaf(x63, l[3], s3); } x4 = (lane == 4) ? 1.0f : -((s0 + s1) + (s2 + s3)); asm volatile("" : "+v"(x4) : : "memory"); }
    { float s0 = 0.f, s1 = 0.f, s2 = 0.f, s3 = 0.f; { const f32x4 l = *(const LAS f32x4*)(Lc + 208); s0 = fmaf(x4, l[0], s0); s1 = fmaf(x5, l[1], s1); s2 = fmaf(x6, l[2], s2); s3 = fmaf(x7, l[3], s3); } { const f32x4 l = *(const LAS f32x4*)(Lc + 212); s0 = fmaf(x8, l[0], s0); s1 = fmaf(x9, l[1], s1); s2 = fmaf(x10, l[2], s2); s3 = fmaf(x11, l[3], s3); } { const f32x4 l = *(const LAS f32x4*)(Lc + 216); s0 = fmaf(x12, l[0], s0); s1 = fmaf(x13, l[1], s1); s2 = fmaf(x14, l[2], s2); s3 = fmaf(x15, l[3], s3); } { const f32x4 l = *(const LAS f32x4*)(Lc + 220); s0 = fmaf(x16, l[0], s0); s1 = fmaf(x17, l[1], s1); s2 = fmaf(x18, l[2], s2); s3 = fmaf(x19, l[3], s3); } { const f32x4 l = *(const LAS f32x4*)(Lc + 224); s0 = fmaf(x20, l[0], s0); s1 = fmaf(x21, l[1], s1); s2 = fmaf(x22, l[2], s2); s3 = fmaf(x23, l[3], s3); } { const f32x4 l = *(const LAS f32x4*)(Lc + 228); s0 = fmaf(x24, l[0], s0); s1 = fmaf(x25, l[1], s1); s2 = fmaf(x26, l[2], s2); s3 = fmaf(x27, l[3], s3); } { const f32x4 l = *(const LAS f32x4*)(Lc + 232); s0 = fmaf(x28, l[0], s0); s1 = fmaf(x29, l[1], s1); s2 = fmaf(x30, l[2], s2); s3 = fmaf(x31, l[3], s3); } { const f32x4 l = *(const LAS f32x4*)(Lc + 236); s0 = fmaf(x32, l[0], s0); s1 = fmaf(x33, l[1], s1); s2 = fmaf(x34, l[2], s2); s3 = fmaf(x35, l[3], s3); } { const f32x4 l = *(const LAS f32x4*)(Lc + 240); s0 = fmaf(x36, l[0], s0); s1 = fmaf(x37, l[1], s1); s2 = fmaf(x38, l[2], s2); s3 = fmaf(x39, l[3], s3); } { const f32x4 l = *(const LAS f32x4*)(Lc + 244); s0 = fmaf(x40, l[0], s0); s1 = fmaf(x41, l[1], s1); s2 = fmaf(x42, l[2], s2); s3 = fmaf(x43, l[3], s3); } { const f32x4 l = *(const LAS f32x4*)(Lc + 248); s0 = fmaf(x44, l[0], s0); s1 = fmaf(x45, l[1], s1); s2 = fmaf(x46, l[2], s2); s3 = fmaf(x47, l[3], s3); } { const f32x4 l = *(const LAS f32x4*)(Lc + 252); s0 = fmaf(x48, l[0], s0); s1 = fmaf(x49, l[1], s1); s2 = fmaf(x50, l[2], s2); s3 = fmaf(x51, l[3], s3); } { const f32x4 l = *(const LAS f32x4*)(Lc + 256); s0 = fmaf(x52, l[0], s0); s1 = fmaf(x53, l[1], s1); s2 = fmaf(x54, l[2], s2); s3 = fmaf(x55, l[3], s3); } { const f32x4 l = *(const LAS f32x4*)(Lc + 260); s0 = fmaf(x56, l[0], s0); s1 = fmaf(x57, l[1], s1); s2 = fmaf(x58, l[2], s2); s3 = fmaf(x59, l[3], s3); } { const f32x4 l = *(const LAS f32x4*)(Lc + 264); s0 = fmaf(x60, l[0], s0); s1 = fmaf(x61, l[1], s1); s2 = fmaf(x62, l[2], s2); s3 = fmaf(x63, l[3], s3); } x3 = (lane == 3) ? 1.0f : -((s0 + s1) + (s2 + s3)); asm volatile("" : "+v"(x3) : : "memory"); }
    { float s0 = 0.f, s1 = 0.f, s2 = 0.f, s3 = 0.f; { const f32x4 l = *(const LAS f32x4*)(Lc + 136); s3 = fmaf(x3, l[3], s3); } { const f32x4 l = *(const LAS f32x4*)(Lc + 140); s0 = fmaf(x4, l[0], s0); s1 = fmaf(x5, l[1], s1); s2 = fmaf(x6, l[2], s2); s3 = fmaf(x7, l[3], s3); } { const f32x4 l = *(const LAS f32x4*)(Lc + 144); s0 = fmaf(x8, l[0], s0); s1 = fmaf(x9, l[1], s1); s2 = fmaf(x10, l[2], s2); s3 = fmaf(x11, l[3], s3); } { const f32x4 l = *(const LAS f32x4*)(Lc + 148); s0 = fmaf(x12, l[0], s0); s1 = fmaf(x13, l[1], s1); s2 = fmaf(x14, l[2], s2); s3 = fmaf(x15, l[3], s3); } { const f32x4 l = *(const LAS f32x4*)(Lc + 152); s0 = fmaf(x16, l[0], s0); s1 = fmaf(x17, l[1], s1); s2 = fmaf(x18, l[2], s2); s3 = fmaf(x19, l[3], s3); } { const f32x4 l = *(const LAS f32x4*)(Lc + 156); s0 = fmaf(x20, l[0], s0); s1 = fmaf(x21, l[1], s1); s2 = fmaf(x22, l[2], s2); s3 = fmaf(x23, l[3], s3); } { const f32x4 l = *(const LAS f32x4*)(Lc + 160); s0 = fmaf(x24, l[0], s0); s1 = fmaf(x25, l[1], s1); s2 = fmaf(x26, l[2], s2); s3 = fmaf(x27, l[3], s3); } { const f32x4 l = *(const LAS f32x4*)(Lc + 164); s0 = fmaf(x28, l[0], s0); s1 = fmaf(x29, l[1], s1); s2 = fmaf(x30, l[2], s2); s3 = fmaf(x31, l[3], s3); } { const f32x4 l = *(const LAS f32x4*)(Lc + 168); s0 = fmaf(x32, l[0], s0); s1 = fmaf(x33, l[1], s1); s2 = fmaf(x34, l[2], s2); s3 = fmaf(x35, l[3], s3); } { const f32x4 l = *(const LAS f32x4*)(Lc + 172); s0 = fmaf(x36, l[0], s0); s1 = fmaf(x37, l[1], s1); s2 = fmaf(x38, l[2], s2); s3 = fmaf(x39, l[3], s3); } { const f32x4 l = *(const LAS f32x4*)(Lc + 176); s0 = fmaf(x40, l[0], s0); s1 = fmaf(x41, l[1], s1); s2 = fmaf(x42, l[2], s2); s3 = fmaf(x43, l[3], s3); } { const f32x4 l = *(const LAS f32x4*)(Lc + 180); s0 = fmaf(x44, l[0], s0); s1 = fmaf(x45, l[1], s1); s2 = fmaf(x46, l[2], s2); s3 = fmaf(x47, l[3], s3); } { const f32x4 l = *(const LAS f32x4*)(Lc + 184); s0 = fmaf(x48, l[0], s0); s1 = fmaf(x49, l[1], s1); s2 = fmaf(x50, l[2], s2); s3 = fmaf(x51, l[3], s3); } { const f32x4 l = *(const LAS f32x4*)(Lc + 188); s0 = fmaf(x52, l[0], s0); s1 = fmaf(x53, l[1], s1); s2 = fmaf(x54, l[2], s2); s3 = fmaf(x55, l[3], s3); } { const f32x4 l = *(const LAS f32x4*)(Lc + 192); s0 = fmaf(x56, l[0], s0); s1 = fmaf(x57, l[1], s1); s2 = fmaf(x58, l[2], s2); s3 = fmaf(x59, l[3], s3); } { const f32x4 l = *(const LAS f32x4*)(Lc + 196); s0 = fmaf(x60, l[0], s0); s1 = fmaf(x61, l[1], s1); s2 = fmaf(x62, l[2], s2); s3 = fmaf(x63, l[3], s3); } x2 = (lane == 2) ? 1.0f : -((s0 + s1) + (s2 + s3)); asm volatile("" : "+v"(x2) : : "memory"); }
    { float s0 = 0.f, s1 = 0.f, s2 = 0.f, s3 = 0.f; { const f32x4 l = *(const LAS f32x4*)(Lc + 68); s2 = fmaf(x2, l[2], s2); s3 = fmaf(x3, l[3], s3); } { const f32x4 l = *(const LAS f32x4*)(Lc + 72); s0 = fmaf(x4, l[0], s0); s1 = fmaf(x5, l[1], s1); s2 = fmaf(x6, l[2], s2); s3 = fmaf(x7, l[3], s3); } { const f32x4 l = *(const LAS f32x4*)(Lc + 76); s0 = fmaf(x8, l[0], s0); s1 = fmaf(x9, l[1], s1); s2 = fmaf(x10, l[2], s2); s3 = fmaf(x11, l[3], s3); } { const f32x4 l = *(const LAS f32x4*)(Lc + 80); s0 = fmaf(x12, l[0], s0); s1 = fmaf(x13, l[1], s1); s2 = fmaf(x14, l[2], s2); s3 = fmaf(x15, l[3], s3); } { const f32x4 l = *(const LAS f32x4*)(Lc + 84); s0 = fmaf(x16, l[0], s0); s1 = fmaf(x17, l[1], s1); s2 = fmaf(x18, l[2], s2); s3 = fmaf(x19, l[3], s3); } { const f32x4 l = *(const LAS f32x4*)(Lc + 88); s0 = fmaf(x20, l[0], s0); s1 = fmaf(x21, l[1], s1); s2 = fmaf(x22, l[2], s2); s3 = fmaf(x23, l[3], s3); } { const f32x4 l = *(const LAS f32x4*)(Lc + 92); s0 = fmaf(x24, l[0], s0); s1 = fmaf(x25, l[1], s1); s2 = fmaf(x26, l[2], s2); s3 = fmaf(x27, l[3], s3); } { const f32x4 l = *(const LAS f32x4*)(Lc + 96); s0 = fmaf(x28, l[0], s0); s1 = fmaf(x29, l[1], s1); s2 = fmaf(x30, l[2], s2); s3 = fmaf(x31, l[3], s3); } { const f32x4 l = *(const LAS f32x4*)(Lc + 100); s0 = fmaf(x32, l[0], s0); s1 = fmaf(x33, l[1], s1); s2 = fmaf(x34, l[2], s2); s3 = fmaf(x35, l[3], s3); } { const f32x4 l = *(const LAS f32x4*)(Lc + 104); s0 = fmaf(x36, l[0], s0); s1 = fmaf(x37, l[1], s1); s2 = fmaf(x38, l[2], s2); s3 = fmaf(x39, l[3], s3); } { const f32x4 l = *(const LAS f32x4*)(Lc + 108); s0 = fmaf(x40, l[0], s0); s1 = fmaf(x41, l[1], s1); s2 = fmaf(x42, l[2], s2); s3 = fmaf(x43, l[3], s3); } { const f32x4 l = *(const LAS f32x4*)(Lc + 112); s0 = fmaf(x44, l[0], s0); s1 = fmaf(x45, l[1], s1); s2 = fmaf(x46, l[2], s2); s3 = fmaf(x47, l[3], s3); } { const f32x4 l = *(const LAS f32x4*)(Lc + 116); s0 = fmaf(x48, l[0], s0); s1 = fmaf(x49, l[1], s1); s2 = fmaf(x50, l[2], s2); s3 = fmaf(x51, l[3], s3); } { const f32x4 l = *(const LAS f32x4*)(Lc + 120); s0 = fmaf(x52, l[0], s0); s1 = fmaf(x53, l[1], s1); s2 = fmaf(x54, l[2], s2); s3 = fmaf(x55, l[3], s3); } { const f32x4 l = *(const LAS f32x4*)(Lc + 124); s0 = fmaf(x56, l[0], s0); s1 = fmaf(x57, l[1], s1); s2 = fmaf(x58, l[2], s2); s3 = fmaf(x59, l[3], s3); } { const f32x4 l = *(const LAS f32x4*)(Lc + 128); s0 = fmaf(x60, l[0], s0); s1 = fmaf(x61, l[1], s1); s2 = fmaf(x62, l[2], s2); s3 = fmaf(x63, l[3], s3); } x1 = (lane == 1) ? 1.0f : -((s0 + s1) + (s2 + s3)); asm volatile("" : "+v"(x1) : : "memory"); }
    { float s0 = 0.f, s1 = 0.f, s2 = 0.f, s3 = 0.f; { const f32x4 l = *(const LAS f32x4*)(Lc + 0); s1 = fmaf(x1, l[1], s1); s2 = fmaf(x2, l[2], s2); s3 = fmaf(x3, l[3], s3); } { const f32x4 l = *(const LAS f32x4*)(Lc + 4); s0 = fmaf(x4, l[0], s0); s1 = fmaf(x5, l[1], s1); s2 = fmaf(x6, l[2], s2); s3 = fmaf(x7, l[3], s3); } { const f32x4 l = *(const LAS f32x4*)(Lc + 8); s0 = fmaf(x8, l[0], s0); s1 = fmaf(x9, l[1], s1); s2 = fmaf(x10, l[2], s2); s3 = fmaf(x11, l[3], s3); } { const f32x4 l = *(const LAS f32x4*)(Lc + 12); s0 = fmaf(x12, l[0], s0); s1 = fmaf(x13, l[1], s1); s2 = fmaf(x14, l[2], s2); s3 = fmaf(x15, l[3], s3); } { const f32x4 l = *(const LAS f32x4*)(Lc + 16); s0 = fmaf(x16, l[0], s0); s1 = fmaf(x17, l[1], s1); s2 = fmaf(x18, l[2], s2); s3 = fmaf(x19, l[3], s3); } { const f32x4 l = *(const LAS f32x4*)(Lc + 20); s0 = fmaf(x20, l[0], s0); s1 = fmaf(x21, l[1], s1); s2 = fmaf(x22, l[2], s2); s3 = fmaf(x23, l[3], s3); } { const f32x4 l = *(const LAS f32x4*)(Lc + 24); s0 = fmaf(x24, l[0], s0); s1 = fmaf(x25, l[1], s1); s2 = fmaf(x26, l[2], s2); s3 = fmaf(x27, l[3], s3); } { const f32x4 l = *(const LAS f32x4*)(Lc + 28); s0 = fmaf(x28, l[0], s0); s1 = fmaf(x29, l[1], s1); s2 = fmaf(x30, l[2], s2); s3 = fmaf(x31, l[3], s3); } { const f32x4 l = *(const LAS f32x4*)(Lc + 32); s0 = fmaf(x32, l[0], s0); s1 = fmaf(x33, l[1], s1); s2 = fmaf(x34, l[2], s2); s3 = fmaf(x35, l[3], s3); } { const f32x4 l = *(const LAS f32x4*)(Lc + 36); s0 = fmaf(x36, l[0], s0); s1 = fmaf(x37, l[1], s1); s2 = fmaf(x38, l[2], s2); s3 = fmaf(x39, l[3], s3); } { const f32x4 l = *(const LAS f32x4*)(Lc + 40); s0 = fmaf(x40, l[0], s0); s1 = fmaf(x41, l[1], s1); s2 = fmaf(x42, l[2], s2); s3 = fmaf(x43, l[3], s3); } { const f32x4 l = *(const LAS f32x4*)(Lc + 44); s0 = fmaf(x44, l[0], s0); s1 = fmaf(x45, l[1], s1); s2 = fmaf(x46, l[2], s2); s3 = fmaf(x47, l[3], s3); } { const f32x4 l = *(const LAS f32x4*)(Lc + 48); s0 = fmaf(x48, l[0], s0); s1 = fmaf(x49, l[1], s1); s2 = fmaf(x50, l[2], s2); s3 = fmaf(x51, l[3], s3); } { const f32x4 l = *(const LAS f32x4*)(Lc + 52); s0 = fmaf(x52, l[0], s0); s1 = fmaf(x53, l[1], s1); s2 = fmaf(x54, l[2], s2); s3 = fmaf(x55, l[3], s3); } { const f32x4 l = *(const LAS f32x4*)(Lc + 56); s0 = fmaf(x56, l[0], s0); s1 = fmaf(x57, l[1], s1); s2 = fmaf(x58, l[2], s2); s3 = fmaf(x59, l[3], s3); } { const f32x4 l = *(const LAS f32x4*)(Lc + 60); s0 = fmaf(x60, l[0], s0); s1 = fmaf(x61, l[1], s1); s2 = fmaf(x62, l[2], s2); s3 = fmaf(x63, l[3], s3); } x0 = (lane == 0) ? 1.0f : -((s0 + s1) + (s2 + s3)); asm volatile("" : "+v"(x0) : : "memory"); }
    { v4u o; o.x = cvtpk(x0, x1); o.y = cvtpk(x2, x3); o.z = cvtpk(x4, x5); o.w = cvtpk(x6, x7); *(LAS v4u*)(Xs + lane * 72 + 0) = o; }
    { v4u o; o.x = cvtpk(x8, x9); o.y = cvtpk(x10, x11); o.z = cvtpk(x12, x13); o.w = cvtpk(x14, x15); *(LAS v4u*)(Xs + lane * 72 + 8) = o; }
    { v4u o; o.x = cvtpk(x16, x17); o.y = cvtpk(x18, x19); o.z = cvtpk(x20, x21); o.w = cvtpk(x22, x23); *(LAS v4u*)(Xs + lane * 72 + 16) = o; }
    { v4u o; o.x = cvtpk(x24, x25); o.y = cvtpk(x26, x27); o.z = cvtpk(x28, x29); o.w = cvtpk(x30, x31); *(LAS v4u*)(Xs + lane * 72 + 24) = o; }
    { v4u o; o.x = cvtpk(x32, x33); o.y = cvtpk(x34, x35); o.z = cvtpk(x36, x37); o.w = cvtpk(x38, x39); *(LAS v4u*)(Xs + lane * 72 + 32) = o; }
    { v4u o; o.x = cvtpk(x40, x41); o.y = cvtpk(x42, x43); o.z = cvtpk(x44, x45); o.w = cvtpk(x46, x47); *(LAS v4u*)(Xs + lane * 72 + 40) = o; }
    { v4u o; o.x = cvtpk(x48, x49); o.y = cvtpk(x50, x51); o.z = cvtpk(x52, x53); o.w = cvtpk(x54, x55); *(LAS v4u*)(Xs + lane * 72 + 48) = o; }
    { v4u o; o.x = cvtpk(x56, x57); o.y = cvtpk(x58, x59); o.z = cvtpk(x60, x61); o.w = cvtpk(x62, x63); *(LAS v4u*)(Xs + lane * 72 + 56) = o; }
}
#ifndef G1P
#define G1P 15
#endif

#define MF16(a, b, c) __builtin_amdgcn_mfma_f32_16x16x32_bf16((a), (b), (c), 0, 0, 0)
__device__ __forceinline__ bf16x8 ld16g(const bf16* p) { return *(const GAS bf16x8*)p; }
__device__ __forceinline__ float ldbf(const bf16* p) { return __uint_as_float(((unsigned)*(const GAS unsigned short*)p) << 16); }
__device__ __forceinline__ void st8(bf16* p, float a, float b, float c, float d) { u32x2v o; o.x = cvtpk(a, b); o.y = cvtpk(c, d); *(GAS u32x2v*)p = o; }

__device__ __forceinline__ void p_ga(const Frame& F, const Args& a, int L) {
    GAS unsigned char* ws = (GAS unsigned char*)a.ws; asm volatile("" : "+s"(ws)); int lane_ = F.lane; asm volatile("" : "+v"(lane_)); const int j = L >> 1, lane = lane_;
    const bf16* PO = (const bf16*)(ws + WS_ARENA + AR_PO);
    bf16 *QN = (bf16*)(ws + WS_ARENA + AR_QN), *QT = (bf16*)(ws + WS_ARENA + AR_QT), *KN = (bf16*)(ws + WS_ARENA + AR_KN), *KGT = (bf16*)(ws + WS_ARENA + AR_KGT), *VBT = (bf16*)(ws + WS_ARENA + AR_VBT), *KTT = (bf16*)(ws + WS_ARENA + AR_KTT);
    const float* gg = (const float*)(ws + WS_GB); const float* gbeta = gg + S_ * 8; float* dn = (float*)(ws + WS_TOK + TOK_DN); float* gcs = (float*)(ws + WS_GC);
    const float* cw = (const float*)a.in[16] + (size_t)j * 4 * 3072;
    LAS float* sc = (LAS float*)(F.lds + F.wave * WAVE_LDS);
    const int dg = lane & 15, ts = lane >> 4, d0 = 8 * dg;
#pragma unroll 1
    for (int u = F.gw; u < NUNIT; u += F.NGW) {
        const int n = u >> 3, hh = u & 7, tok0 = 64 * n;
        {
            const float g = gg[(size_t)(tok0 + lane) * 8 + hh], beta = gbeta[(size_t)(tok0 + lane) * 8 + hh];
            float gc = g;
#pragma unroll
            for (int o = 1; o < 64; o <<= 1) { const float t = __shfl_up(gc, o); if (lane >= o) gc += t; }
            const float glast = __shfl(gc, 63);
            gcs[(size_t)(tok0 + lane) * 8 + hh] = gc;
            if (lane == 0) dn[u] = expf(glast);
            const float eg = expf(gc);
            sc[64 + lane] = beta * eg; sc[128 + lane] = expf(glast - gc); sc[192 + lane] = beta; sc[256 + lane] = eg;
        }
#pragma unroll 1
        for (int qk = 0; qk < 2; ++qk) {
            const int coff = qk * 1024 + hh * 128 + d0;
            float w[4][8];
#pragma unroll
            for (int jj = 0; jj < 4; ++jj)
#pragma unroll
                for (int e = 0; e < 8; ++e) w[jj][e] = *(const GAS float*)(cw + jj * 3072 + coff + e);
#pragma unroll 4
            for (int it = 0; it < 16; ++it) {
                const int i = 4 * it + ts, tok = tok0 + i; float acc[8];
                v4u rv[4];
#pragma unroll
                for (int jj = 0; jj < 4; ++jj) { const int r = tok - 3 + jj; rv[jj] = *(const GAS v4u*)(PO + (size_t)(r < 0 ? 0 : r) * OIN + coff); }
#pragma unroll
                for (int e = 0; e < 8; ++e) acc[e] = 0.f;
#pragma unroll
                for (int jj = 0; jj < 4; ++jj) { const float on = (tok - 3 + jj >= 0) ? 1.0f : 0.0f; const unsigned vv[4] = {rv[jj].x, rv[jj].y, rv[jj].z, rv[jj].w};
#pragma unroll
                    for (int q = 0; q < 4; ++q) { acc[2 * q] += (w[jj][2 * q] * on) * bflo(vv[q]); acc[2 * q + 1] += (w[jj][2 * q + 1] * on) * bfhi(vv[q]); } }
                float ss = 0.f;
#pragma unroll
                for (int e = 0; e < 8; ++e) { acc[e] = silu(acc[e]); ss += acc[e] * acc[e]; }
                ss += __shfl_xor(ss, 1); ss += __shfl_xor(ss, 2); ss += __shfl_xor(ss, 4); ss += __shfl_xor(ss, 8);
                const float rn = __builtin_amdgcn_rsqf(ss + 1e-6f);
                const float s1 = (qk == 0) ? rn * 0.08838834764831845f : rn;
                v4u o; o.x = cvtpk(acc[0] * s1, acc[1] * s1); o.y = cvtpk(acc[2] * s1, acc[3] * s1); o.z = cvtpk(acc[4] * s1, acc[5] * s1); o.w = cvtpk(acc[6] * s1, acc[7] * s1);
                *(GAS v4u*)((qk == 0 ? QN : KN) + (size_t)tok * D_ + hh * 128 + d0) = o;
                if (qk == 0) { const float s2 = s1 * sc[256 + i];
                    o.x = cvtpk(acc[0] * s2, acc[1] * s2); o.y = cvtpk(acc[2] * s2, acc[3] * s2); o.z = cvtpk(acc[4] * s2, acc[5] * s2); o.w = cvtpk(acc[6] * s2, acc[7] * s2);
                    *(GAS v4u*)(QT + (size_t)tok * D_ + hh * 128 + d0) = o; }
                else if (dg == 0) sc[i] = rn;
            }
        }
#pragma unroll 1
        for (int kv = 0; kv < 2; ++kv)
#pragma unroll 1
            for (int half = 0; half < 2; ++half) {
                const int d = 64 * half + lane, c = (1 + kv) * 1024 + hh * 128 + d;
                const float w0 = *(const GAS float*)(cw + c), w1 = *(const GAS float*)(cw + 3072 + c), w2 = *(const GAS float*)(cw + 2 * 3072 + c), w3 = *(const GAS float*)(cw + 3 * 3072 + c);
                const float hon = tok0 > 0 ? 1.0f : 0.0f; const int hb = tok0 > 0 ? tok0 - 3 : 0;
                float r0 = hon * ldbf(PO + (size_t)hb * OIN + c), r1 = hon * ldbf(PO + (size_t)(hb + 1) * OIN + c), r2 = hon * ldbf(PO + (size_t)(hb + 2) * OIN + c);
                const size_t obase = ((size_t)u * 128 + d) * 64;
                const LAS float* m1 = sc + (kv == 0 ? 64 : 192);
                bf16* O1 = kv == 0 ? KGT : VBT;
#pragma unroll 1
                for (int ig4 = 0; ig4 < 2; ++ig4) {
                    float x[32];
#pragma unroll
                    for (int e = 0; e < 32; ++e) x[e] = ldbf(PO + (size_t)(tok0 + 32 * ig4 + e) * OIN + c);
#pragma unroll
                    for (int sb = 0; sb < 4; ++sb) { const int ig = 4 * ig4 + sb; float o1[8], o2[8];
#pragma unroll
                        for (int e = 0; e < 8; ++e) { const int i = 8 * ig + e; const float r3 = x[8 * sb + e];
                            float v = silu(w0 * r0 + w1 * r1 + w2 * r2 + w3 * r3); r0 = r1; r1 = r2; r2 = r3;
                            const float rk = sc[i]; v = (kv == 0) ? v * rk : v;
                            o1[e] = v * m1[i]; o2[e] = v * sc[128 + i]; }
                        v4u o; o.x = cvtpk(o1[0], o1[1]); o.y = cvtpk(o1[2], o1[3]); o.z = cvtpk(o1[4], o1[5]); o.w = cvtpk(o1[6], o1[7]);
                        *(GAS v4u*)(O1 + obase + 8 * ig) = o;
                        if (kv == 0) { o.x = cvtpk(o2[0], o2[1]); o.y = cvtpk(o2[2], o2[3]); o.z = cvtpk(o2[4], o2[5]); o.w = cvtpk(o2[6], o2[7]); *(GAS v4u*)(KTT + obase + 8 * ig) = o; } }
                }
            }
    }
}

__device__ __forceinline__ void p_g1(const Frame& F, const Args& a) {
    GAS unsigned char* ws = (GAS unsigned char*)a.ws; asm volatile("" : "+s"(ws)); int lane_ = F.lane; asm volatile("" : "+v"(lane_)); const int lane = lane_, r16 = lane & 15, g = lane >> 4;
    const bf16 *QN = (const bf16*)(ws + WS_ARENA + AR_QN), *KN = (const bf16*)(ws + WS_ARENA + AR_KN), *KGT = (const bf16*)(ws + WS_ARENA + AR_KGT), *VBT = (const bf16*)(ws + WS_ARENA + AR_VBT), *KTT = (const bf16*)(ws + WS_ARENA + AR_KTT);
    bf16 *AI = (bf16*)(ws + WS_ARENA + AR_AI), *NEGW = (bf16*)(ws + WS_ARENA + AR_NEGW), *UT = (bf16*)(ws + WS_ARENA + AR_UT), *MP = (bf16*)(ws + WS_ARENA + AR_MP), *NT = (bf16*)(ws + WS_ARENA + AR_NT), *WT = (bf16*)(ws + WS_ARENA + AR_WT);
    const float* gg = (const float*)(ws + WS_GC); const float* gbeta = (const float*)(ws + WS_GB) + S_ * 8;
    LAS float* Lc = (LAS float*)(F.lds + F.wave * WAVE_LDS);
    LAS bf16* Xs = (LAS bf16*)(F.lds + F.wave * WAVE_LDS);
    const f32x4 Z4 = {0.f, 0.f, 0.f, 0.f};
#pragma unroll 1
    for (int u = F.gw; u < NUNIT; u += F.NGW) {
        const int n = u >> 3, hh = u & 7, tok0 = 64 * n; const int uh = hh * NCHUNK + n;
        const float gc = gg[(size_t)(tok0 + lane) * 8 + hh], beta = gbeta[(size_t)(tok0 + lane) * 8 + hh];
#if G1P & 1
        {
            bf16x8 kf[4][4];
#pragma unroll
            for (int t = 0; t < 4; ++t)
#pragma unroll
                for (int kk = 0; kk < 4; ++kk) kf[t][kk] = ld16g(KN + (size_t)(tok0 + 16 * t + r16) * D_ + hh * 128 + 32 * kk + 8 * g);
#pragma unroll
            for (int ti = 0; ti < 4; ++ti)
#pragma unroll
                for (int tj = 0; tj <= ti; ++tj) {
                    f32x4 Dv = Z4;
#pragma unroll
                    for (int kk = 0; kk < 4; ++kk) Dv = MF16(kf[ti][kk], kf[tj][kk], Dv);
                    const int jx = 16 * tj + r16; const float gcj = __shfl(gc, jx); f32x4 val;
#pragma unroll
                    for (int r = 0; r < 4; ++r) { const int ix = 16 * ti + 4 * g + r; const float gci = __shfl(gc, ix), bi = __shfl(beta, ix); val[r] = (ix > jx) ? bi * Dv[r] * expf(gci - gcj) : 0.f; }
                    *(LAS f32x4*)(Lc + jx * 68 + 16 * ti + 4 * g) = val;
                }
#pragma unroll
            for (int ti = 0; ti < 4; ++ti) {
                bf16x8 qf[4];
#pragma unroll
                for (int kk = 0; kk < 4; ++kk) qf[kk] = ld16g(QN + (size_t)(tok0 + 16 * ti + r16) * D_ + hh * 128 + 32 * kk + 8 * g);
                const int ix = 16 * ti + r16; const float gci = __shfl(gc, ix);
#pragma unroll
                for (int tj = 0; tj < 4; ++tj) {
                    f32x4 val = Z4;
                    if (tj <= ti) {
                        f32x4 Dv = Z4;
#pragma unroll
                        for (int kk = 0; kk < 4; ++kk) Dv = MF16(kf[tj][kk], qf[kk], Dv);
#pragma unroll
                        for (int r = 0; r < 4; ++r) { const int jx = 16 * tj + 4 * g + r; const float gcj = __shfl(gc, jx); val[r] = (ix >= jx) ? Dv[r] * expf(gci - gcj) : 0.f; }
                    }
                    st8(AI + ((size_t)u * 64 + ix) * 64 + 16 * tj + 4 * g, val[0], val[1], val[2], val[3]);
                }
            }
        }
        asm volatile("s_waitcnt lgkmcnt(0)" ::: "memory");
#endif
#if G1P & 2
        tri_solve(Lc, Xs, lane);
#endif
#if G1P & 4
        asm volatile("s_waitcnt lgkmcnt(0)" ::: "memory");
        {
            bf16x8 xf[4][2];
#pragma unroll
            for (int t = 0; t < 4; ++t)
#pragma unroll
                for (int kk = 0; kk < 2; ++kk) xf[t][kk] = *(const LAS bf16x8*)(Xs + (16 * t + r16) * 72 + 32 * kk + 8 * g);
#pragma unroll 2
            for (int td = 0; td < 8; ++td) {
                const size_t rb = ((size_t)u * 128 + 16 * td + r16) * 64;
                const bf16x8 vb0 = ld16g(VBT + rb + 8 * g), vb1 = ld16g(VBT + rb + 32 + 8 * g), kg0 = ld16g(KGT + rb + 8 * g), kg1 = ld16g(KGT + rb + 32 + 8 * g);
#pragma unroll
                for (int ti = 0; ti < 4; ++ti) {
                    f32x4 Du = MF16(xf[ti][0], vb0, Z4); Du = MF16(xf[ti][1], vb1, Du);
                    st8(UT + rb + 16 * ti + 4 * g, Du[0], Du[1], Du[2], Du[3]);
                    f32x4 Dw = MF16(xf[ti][0], kg0, Z4); Dw = MF16(xf[ti][1], kg1, Dw);
                    st8(WT + rb + 16 * ti + 4 * g, Dw[0], Dw[1], Dw[2], Dw[3]);
                    f32x4 Dn = MF16(kg0, xf[ti][0], Z4); Dn = MF16(kg1, xf[ti][1], Dn);
                    st8(NEGW + (size_t)(tok0 + 16 * ti + r16) * D_ + hh * 128 + 16 * td + 4 * g, -Dn[0], -Dn[1], -Dn[2], -Dn[3]);
                }
            }
        }
#endif
        asm volatile("s_waitcnt vmcnt(0)" ::: "memory");
#if G1P & 8
        {
            bf16x8 ktf[8][2];
#pragma unroll
            for (int t = 0; t < 8; ++t)
#pragma unroll
                for (int kk = 0; kk < 2; ++kk) ktf[t][kk] = ld16g(KTT + ((size_t)u * 128 + 16 * t + r16) * 64 + 32 * kk + 8 * g);
#pragma unroll 2
            for (int tp = 0; tp < 8; ++tp) {
                const size_t rb = ((size_t)u * 128 + 16 * tp + r16) * 64;
                const bf16x8 wf0 = ld16g(WT + rb + 8 * g), wf1 = ld16g(WT + rb + 32 + 8 * g), uf0 = ld16g(UT + rb + 8 * g), uf1 = ld16g(UT + rb + 32 + 8 * g);
#pragma unroll
                for (int t1 = 0; t1 < 8; ++t1) {
                    f32x4 Dm = MF16(wf0, ktf[t1][0], Z4); Dm = MF16(wf1, ktf[t1][1], Dm);
                    st8(MP + ((size_t)uh * 128 + 16 * t1 + r16) * 128 + 16 * tp + 4 * g, -Dm[0], -Dm[1], -Dm[2], -Dm[3]);
                    f32x4 Dn = MF16(ktf[t1][0], uf0, Z4); Dn = MF16(ktf[t1][1], uf1, Dn);
                    st8(NT + ((size_t)uh * 128 + 16 * tp + r16) * 128 + 16 * t1 + 4 * g, Dn[0], Dn[1], Dn[2], Dn[3]);
                }
            }
        }
#endif
    }
}

__device__ __forceinline__ void p_g2(const Frame& F, const Args& a) {
    GAS unsigned char* ws = (GAS unsigned char*)a.ws; asm volatile("" : "+s"(ws)); int lane_ = F.lane; asm volatile("" : "+v"(lane_)); const int lane = lane_, r16 = lane & 15, g = lane >> 4, w = F.wave;
    const bf16 *MP = (const bf16*)(ws + WS_ARENA + AR_MP), *NT = (const bf16*)(ws + WS_ARENA + AR_NT); bf16* SG = (bf16*)(ws + WS_ARENA + AR_SG);
    const float* dn = (const float*)(ws + WS_TOK + TOK_DN);
    LAS bf16* St = (LAS bf16*)F.lds;
    const int args_use_bar = a.use_bar; (void)args_use_bar;
#pragma unroll 1
    for (int asg = F.vcu; asg < 64; asg += F.G) {
        const int hh = asg >> 3, sl = asg & 7;
        __syncthreads();
        for (int idx = F.tid; idx < 2 * 16 * 136 / 2; idx += NWAVES * 64) ((LAS unsigned*)St)[idx] = 0u;
        __syncthreads();
        if (w >= 4) {
            const int st = F.tid - 256, row = st >> 4, chunk = st & 15;
#pragma unroll 1
            for (int n = 0; n < NCHUNK; ++n) {
                const v4u v = *(const LAS v4u*)(St + (n & 1) * (16 * 136) + row * 136 + chunk * 8);
                *(GAS v4u*)(SG + ((size_t)(hh * NCHUNK + n) * 128 + 16 * sl + row) * 128 + chunk * 8) = v;
                asm volatile("s_waitcnt lgkmcnt(0)" ::: "memory"); __builtin_amdgcn_s_barrier(); asm volatile("" ::: "memory");
            }
        } else {
            f32x4 Sv[2] = {{0.f, 0.f, 0.f, 0.f}, {0.f, 0.f, 0.f, 0.f}};
            bf16x8 A0[2][4], A1[2][4], A2[2][4], A3[2][4]; u32x2v C0[2], C1[2], C2[2], C3[2]; float d0, d1, d2, d3;
#define G2_LOAD(AX, CX, DX, nn) do { const int u_ = hh * NCHUNK + (nn); \
            _Pragma("unroll") for (int t = 0; t < 2; ++t) { \
                _Pragma("unroll") for (int kk = 0; kk < 4; ++kk) AX[t][kk] = ld16g(MP + ((size_t)u_ * 128 + 32 * w + 16 * t + r16) * 128 + 32 * kk + 8 * g); \
                CX[t] = *(const GAS u32x2v*)(NT + ((size_t)u_ * 128 + 16 * sl + r16) * 128 + 32 * w + 16 * t + 4 * g); } \
            DX = *(const GAS float*)(dn + (nn) * 8 + hh); } while (0)
#ifdef PROBE_G2_NOLOAD
#define G2_STEPLOAD(AL, CL, DL, nn) do { if (args_use_bar) G2_LOAD(AL, CL, DL, nn); } while (0)
#else
#define G2_STEPLOAD(AL, CL, DL, nn) G2_LOAD(AL, CL, DL, nn)
#endif
#define G2_STEP(AU, CU, DU, AL, CL, DL, nn) do { const int n_ = (nn); const int n2_ = (n_ + 3 < NCHUNK) ? n_ + 3 : NCHUNK - 1; \
            G2_STEPLOAD(AL, CL, DL, n2_); \
            LAS bf16* Sc = St + (n_ & 1) * (16 * 136); LAS bf16* Sn = St + ((n_ & 1) ^ 1) * (16 * 136); \
            f32x4 D0 = {bflo(CU[0].x), bfhi(CU[0].x), bflo(CU[0].y), bfhi(CU[0].y)}, D1 = {bflo(CU[1].x), bfhi(CU[1].x), bflo(CU[1].y), bfhi(CU[1].y)}; \
            _Pragma("unroll") for (int kk = 0; kk < 4; ++kk) { const bf16x8 Bf = *(const LAS bf16x8*)(Sc + r16 * 136 + 32 * kk + 8 * g); D0 = MF16(AU[0][kk], Bf, D0); D1 = MF16(AU[1][kk], Bf, D1); } \
            Sv[0] = Sv[0] * DU + D0; Sv[1] = Sv[1] * DU + D1; \
            { u32x2v o; o.x = cvtpk(Sv[0][0], Sv[0][1]); o.y = cvtpk(Sv[0][2], Sv[0][3]); *(LAS u32x2v*)(Sn + r16 * 136 + 32 * w + 4 * g) = o; \
              o.x = cvtpk(Sv[1][0], Sv[1][1]); o.y = cvtpk(Sv[1][2], Sv[1][3]); *(LAS u32x2v*)(Sn + r16 * 136 + 32 * w + 16 + 4 * g) = o; } \
            asm volatile("s_waitcnt lgkmcnt(0)" ::: "memory"); __builtin_amdgcn_s_barrier(); asm volatile("" ::: "memory"); } while (0)
            G2_LOAD(A0, C0, d0, 0); G2_LOAD(A1, C1, d1, 1); G2_LOAD(A2, C2, d2, 2);
            static_assert(NCHUNK == 10 * 24 + 16, "scan written for 256 chunks");
            int n = 0;
#pragma unroll 1
            for (; n + 24 <= NCHUNK; n += 24) {
                G2_STEP(A0, C0, d0, A3, C3, d3, n + 0);
                G2_STEP(A1, C1, d1, A0, C0, d0, n + 1);
                G2_STEP(A2, C2, d2, A1, C1, d1, n + 2);
                G2_STEP(A3, C3, d3, A2, C2, d2, n + 3);
                G2_STEP(A0, C0, d0, A3, C3, d3, n + 4);
                G2_STEP(A1, C1, d1, A0, C0, d0, n + 5);
                G2_STEP(A2, C2, d2, A1, C1, d1, n + 6);
                G2_STEP(A3, C3, d3, A2, C2, d2, n + 7);
                G2_STEP(A0, C0, d0, A3, C3, d3, n + 8);
                G2_STEP(A1, C1, d1, A0, C0, d0, n + 9);
                G2_STEP(A2, C2, d2, A1, C1, d1, n + 10);
                G2_STEP(A3, C3, d3, A2, C2, d2, n + 11);
                G2_STEP(A0, C0, d0, A3, C3, d3, n + 12);
                G2_STEP(A1, C1, d1, A0, C0, d0, n + 13);
                G2_STEP(A2, C2, d2, A1, C1, d1, n + 14);
                G2_STEP(A3, C3, d3, A2, C2, d2, n + 15);
                G2_STEP(A0, C0, d0, A3, C3, d3, n + 16);
                G2_STEP(A1, C1, d1, A0, C0, d0, n + 17);
                G2_STEP(A2, C2, d2, A1, C1, d1, n + 18);
                G2_STEP(A3, C3, d3, A2, C2, d2, n + 19);
                G2_STEP(A0, C0, d0, A3, C3, d3, n + 20);
                G2_STEP(A1, C1, d1, A0, C0, d0, n + 21);
                G2_STEP(A2, C2, d2, A1, C1, d1, n + 22);
                G2_STEP(A3, C3, d3, A2, C2, d2, n + 23);
            }
            G2_STEP(A0, C0, d0, A3, C3, d3, n + 0);
            G2_STEP(A1, C1, d1, A0, C0, d0, n + 1);
            G2_STEP(A2, C2, d2, A1, C1, d1, n + 2);
            G2_STEP(A3, C3, d3, A2, C2, d2, n + 3);
            G2_STEP(A0, C0, d0, A3, C3, d3, n + 4);
            G2_STEP(A1, C1, d1, A0, C0, d0, n + 5);
            G2_STEP(A2, C2, d2, A1, C1, d1, n + 6);
            G2_STEP(A3, C3, d3, A2, C2, d2, n + 7);
            G2_STEP(A0, C0, d0, A3, C3, d3, n + 8);
            G2_STEP(A1, C1, d1, A0, C0, d0, n + 9);
            G2_STEP(A2, C2, d2, A1, C1, d1, n + 10);
            G2_STEP(A3, C3, d3, A2, C2, d2, n + 11);
            G2_STEP(A0, C0, d0, A3, C3, d3, n + 12);
            G2_STEP(A1, C1, d1, A0, C0, d0, n + 13);
            G2_STEP(A2, C2, d2, A1, C1, d1, n + 14);
            G2_STEP(A3, C3, d3, A2, C2, d2, n + 15);
#undef G2_STEP
#undef G2_LOAD
        }
    }
}

__device__ __forceinline__ void p_g3(const Frame& F, const Args& a, int L) {
    GAS unsigned char* ws = (GAS unsigned char*)a.ws; asm volatile("" : "+s"(ws)); int lane_ = F.lane; asm volatile("" : "+v"(lane_)); const int j = L >> 1, lane = lane_, r16 = lane & 15, g = lane >> 4;
    const bf16 *PO = (const bf16*)(ws + WS_ARENA + AR_PO), *QT = (const bf16*)(ws + WS_ARENA + AR_QT), *AI = (const bf16*)(ws + WS_ARENA + AR_AI), *NEGW = (const bf16*)(ws + WS_ARENA + AR_NEGW),
               *UT = (const bf16*)(ws + WS_ARENA + AR_UT), *SG = (const bf16*)(ws + WS_ARENA + AR_SG);
    bf16* mix = (bf16*)(ws + WS_MIX); const float* onorm = (const float*)a.in[19] + j * 128;
    const f32x4 Z4 = {0.f, 0.f, 0.f, 0.f};
#pragma unroll 1
    for (int u = F.gw; u < NUNIT; u += F.NGW) {
        const int n = u >> 3, hh = u & 7, tok0 = 64 * n; const int uh = hh * NCHUNK + n;
        unsigned vn[8][4][2];
        {
            bf16x8 nw[4][4];
#pragma unroll
            for (int jt = 0; jt < 4; ++jt)
#pragma unroll
                for (int kk = 0; kk < 4; ++kk) nw[jt][kk] = ld16g(NEGW + (size_t)(tok0 + 16 * jt + r16) * D_ + hh * 128 + 32 * kk + 8 * g);
#pragma unroll
            for (int d2t = 0; d2t < 8; ++d2t) {
                bf16x8 sg[4];
#pragma unroll
                for (int kk = 0; kk < 4; ++kk) sg[kk] = ld16g(SG + ((size_t)uh * 128 + 16 * d2t + r16) * 128 + 32 * kk + 8 * g);
#pragma unroll
                for (int jt = 0; jt < 4; ++jt) {
                    const u32x2v c = *(const GAS u32x2v*)(UT + ((size_t)u * 128 + 16 * d2t + r16) * 64 + 16 * jt + 4 * g);
                    f32x4 Dv = {bflo(c.x), bfhi(c.x), bflo(c.y), bfhi(c.y)};
#pragma unroll
                    for (int kk = 0; kk < 4; ++kk) Dv = MF16(nw[jt][kk], sg[kk], Dv);
                    vn[d2t][jt][0] = cvtpk(Dv[0], Dv[1]); vn[d2t][jt][1] = cvtpk(Dv[2], Dv[3]);
                    asm volatile("" : "+v"(vn[d2t][jt][0]), "+v"(vn[d2t][jt][1]));
                }
                asm volatile("" ::: "memory");
            }
        }
#pragma unroll 1
        for (int ti = 0; ti < 4; ++ti) {
            const int tok = tok0 + 16 * ti + r16;
            bf16x8 qf[4], af[2];
#pragma unroll
            for (int kk = 0; kk < 4; ++kk) qf[kk] = ld16g(QT + (size_t)tok * D_ + hh * 128 + 32 * kk + 8 * g);
#pragma unroll
            for (int k2 = 0; k2 < 2; ++k2) { const u32x2v lo = *(const GAS u32x2v*)(AI + ((size_t)u * 64 + 16 * ti + r16) * 64 + 32 * k2 + 4 * g), hi = *(const GAS u32x2v*)(AI + ((size_t)u * 64 + 16 * ti + r16) * 64 + 32 * k2 + 16 + 4 * g);
                const v4u pk = {lo.x, lo.y, hi.x, hi.y}; af[k2] = __builtin_bit_cast(bf16x8, pk); }
            f32x4 acc[8]; float ss = 0.f;
#pragma unroll
            for (int d2t = 0; d2t < 8; ++d2t) {
                f32x4 Dv = Z4;
#pragma unroll
                for (int kk = 0; kk < 4; ++kk) { const bf16x8 sgf = ld16g(SG + ((size_t)uh * 128 + 16 * d2t + r16) * 128 + 32 * kk + 8 * g); Dv = MF16(sgf, qf[kk], Dv); }
#pragma unroll
                for (int k2 = 0; k2 < 2; ++k2) { const v4u pk = {vn[d2t][2 * k2][0], vn[d2t][2 * k2][1], vn[d2t][2 * k2 + 1][0], vn[d2t][2 * k2 + 1][1]}; Dv = MF16(__builtin_bit_cast(bf16x8, pk), af[k2], Dv); }
                acc[d2t] = Dv; ss += (Dv[0] * Dv[0] + Dv[1] * Dv[1]) + (Dv[2] * Dv[2] + Dv[3] * Dv[3]);
            }
            ss += __shfl_xor(ss, 16); ss += __shfl_xor(ss, 32);
            const float rms = __builtin_amdgcn_rsqf(ss * (1.0f / 128.0f) + RMS_EPS);
#pragma unroll
            for (int d2t = 0; d2t < 8; ++d2t) {
                const u32x2v z = *(const GAS u32x2v*)(PO + (size_t)tok * OIN + 3072 + hh * 128 + 16 * d2t + 4 * g); const f32x4 gn = *(const GAS f32x4*)(onorm + 16 * d2t + 4 * g);
                st8(mix + (size_t)tok * D_ + hh * 128 + 16 * d2t + 4 * g, acc[d2t][0] * rms * gn[0] * silu(bflo(z.x)), acc[d2t][1] * rms * gn[1] * silu(bfhi(z.x)),
                    acc[d2t][2] * rms * gn[2] * silu(bflo(z.y)), acc[d2t][3] * rms * gn[3] * silu(bfhi(z.y)));
            }
        }
    }
}

__device__ __forceinline__ void p_r1(const Frame& F, const Args& a, int L) {
    GAS unsigned char* ws = (GAS unsigned char*)a.ws; asm volatile("" : "+s"(ws)); int lane_ = F.lane; asm volatile("" : "+v"(lane_)); const int j = L >> 1, lane = lane_;
    const float* ssq = (const float*)(ws + WS_SSQA); const float* wr = (const float*)a.in[24] + (size_t)j * D_ * NEXP; const float* ln = (const float*)a.in[4] + L * D_;
    int* tok_e = (int*)(ws + WS_TOK + TOK_E); int* tok_r = (int*)(ws + WS_TOK + TOK_R); float* tok_g = (float*)(ws + WS_TOK + TOK_G);
    unsigned* gcount = (unsigned*)(ws + WS_CTL) + CW_CNT + 64 * j;
    LAS int* rt = (LAS int*)(F.lds + RT_OFF);
    if (F.tid < 16) rt[F.tid] = 0;
    __syncthreads();
#pragma unroll 1
    for (int t = F.gw; t < S_; t += F.NGW) {
        const float rs = pg8::rstd_row(ssq, t); float acc[8];
#pragma unroll
        for (int e = 0; e < 8; ++e) acc[e] = 0.f;
#pragma unroll 4
        for (int i = 0; i < 16; ++i) { const int k = 64 * i + lane; const float x = a.out[(size_t)t * D_ + k] * ln[k];
            const f32x4 w0 = *(const GAS f32x4*)(wr + (size_t)k * 8), w1 = *(const GAS f32x4*)(wr + (size_t)k * 8 + 4);
            acc[0] += x * w0[0]; acc[1] += x * w0[1]; acc[2] += x * w0[2]; acc[3] += x * w0[3]; acc[4] += x * w1[0]; acc[5] += x * w1[1]; acc[6] += x * w1[2]; acc[7] += x * w1[3]; }
#pragma unroll
        for (int e = 0; e < 8; ++e) acc[e] = wave_sum(acc[e]) * rs;
        int e0 = 0; float l0 = acc[0];
#pragma unroll
        for (int e = 1; e < 8; ++e) if (acc[e] > l0) { l0 = acc[e]; e0 = e; }
        int e1 = -1; float l1 = -INFINITY;
#pragma unroll
        for (int e = 0; e < 8; ++e) if (e != e0 && acc[e] > l1) { l1 = acc[e]; e1 = e; }
        const float g1 = 1.0f / (1.0f + expf(l0 - l1)), g0 = 1.0f - g1;
        if (lane == 0) {
            const int r0 = __hip_atomic_fetch_add(rt + e0, 1, __ATOMIC_RELAXED, __HIP_MEMORY_SCOPE_WORKGROUP), r1 = __hip_atomic_fetch_add(rt + e1, 1, __ATOMIC_RELAXED, __HIP_MEMORY_SCOPE_WORKGROUP);
            tok_e[2 * t] = e0; tok_e[2 * t + 1] = e1; tok_r[2 * t] = r0; tok_r[2 * t + 1] = r1; tok_g[2 * t] = g0; tok_g[2 * t + 1] = g1;
        }
    }
    __syncthreads();
    if (F.tid < 8) rt[8 + F.tid] = (int)__hip_atomic_fetch_add(gcount + F.tid, (unsigned)rt[F.tid], __ATOMIC_RELAXED, __HIP_MEMORY_SCOPE_AGENT);
    __syncthreads();
#pragma unroll 1
    for (int t = F.gw; t < S_; t += F.NGW) if (lane < 2) { const int e = tok_e[2 * t + lane]; tok_r[2 * t + lane] += rt[8 + e]; }
    __syncthreads();
}
__device__ __forceinline__ int moe_pstart(const unsigned* gcount, int e) {
    int ps = 0;
#pragma unroll
    for (int q = 0; q < 8; ++q) { const int c = (int)gcount[q]; if (q < e) ps += ((c + 255) >> 8) << 8; }
    return ps;
}
__device__ __forceinline__ void p_r2(const Frame& F, const Args& a, int L) {
    GAS unsigned char* ws = (GAS unsigned char*)a.ws; asm volatile("" : "+s"(ws)); int lane_ = F.lane; asm volatile("" : "+v"(lane_)); const int j = L >> 1, lane = lane_;
    const float* ssq = (const float*)(ws + WS_SSQA);
    const int* tok_e = (const int*)(ws + WS_TOK + TOK_E); const int* tok_r = (const int*)(ws + WS_TOK + TOK_R); const float* tok_g = (const float*)(ws + WS_TOK + TOK_G);
    int* dst = (int*)(ws + WS_TOK + TOK_DST); float* gpad = (float*)(ws + WS_TOK + TOK_GPAD);
    const unsigned* gcount = (const unsigned*)(ws + WS_CTL) + CW_CNT + 64 * j; bf16* XS = (bf16*)(ws + WS_ARENA + AR_XS);
#pragma unroll 1
    for (int t = F.gw; t < S_; t += F.NGW) {
        const float rs = pg8::rstd_row(ssq, t);
        const int ea = tok_e[2 * t], eb = tok_e[2 * t + 1];
        const int da = moe_pstart(gcount, ea) + tok_r[2 * t], db = moe_pstart(gcount, eb) + tok_r[2 * t + 1];
        if (lane == 0) { dst[2 * t] = da; dst[2 * t + 1] = db; gpad[da] = tok_g[2 * t]; gpad[db] = tok_g[2 * t + 1]; }
#pragma unroll
        for (int q = 0; q < 4; ++q) { const f32x4 v = *((const GAS f32x4*)(a.out + (size_t)t * D_) + 64 * q + lane) * rs;
            u32x2v o; o.x = cvtpk(v[0], v[1]); o.y = cvtpk(v[2], v[3]);
            *((GAS u32x2v*)(XS + (size_t)da * D_) + 64 * q + lane) = o; *((GAS u32x2v*)(XS + (size_t)db * D_) + 64 * q + lane) = o; }
    }
}
__device__ __forceinline__ int moe_blocks(const Frame& F, const Args& a, int L) {
    const unsigned* gcount = (const unsigned*)(a.ws + WS_CTL) + CW_CNT + 64 * (L >> 1);
    LAS int* blk = (LAS int*)(F.lds + BLKE_OFF);
    int nb_tot = 0, mine = 7;
#pragma unroll
    for (int q = 0; q < 8; ++q) { const int nb = ((int)gcount[q] + 255) >> 8; if (F.tid >= nb_tot && F.tid < nb_tot + nb) mine = q; nb_tot += nb; }
    __syncthreads();
    if (F.tid < 160) blk[F.tid] = mine;
    __syncthreads();
    return nb_tot;
}
__device__ __forceinline__ void p_combine(const Frame& F, const Args& a) {
    GAS unsigned char* ws = (GAS unsigned char*)a.ws; asm volatile("" : "+s"(ws)); int lane_ = F.lane; asm volatile("" : "+v"(lane_)); const int lane = lane_;
    const int* dst = (const int*)(ws + WS_TOK + TOK_DST); const bf16* Y = (const bf16*)(ws + WS_ARENA + AR_Y); bf16* hb = (bf16*)(ws + WS_HBF); float* ssq = (float*)(ws + WS_SSQA);
#pragma unroll 1
    for (int t = F.gw; t < S_; t += F.NGW) {
        const int da = dst[2 * t], db = dst[2 * t + 1]; float ss = 0.f;
#pragma unroll
        for (int q = 0; q < 4; ++q) { GAS f32x4* hp = (GAS f32x4*)(a.out + (size_t)t * D_) + 64 * q + lane; f32x4 v = *hp;
            const u32x2v ya = *((const GAS u32x2v*)(Y + (size_t)da * D_) + 64 * q + lane), yb = *((const GAS u32x2v*)(Y + (size_t)db * D_) + 64 * q + lane);
            v[0] += bflo(ya.x) + bflo(yb.x); v[1] += bfhi(ya.x) + bfhi(yb.x); v[2] += bflo(ya.y) + bflo(yb.y); v[3] += bfhi(ya.y) + bfhi(yb.y);
            *hp = v; ss += (v[0] * v[0] + v[1] * v[1]) + (v[2] * v[2] + v[3] * v[3]);
            u32x2v o; o.x = cvtpk(v[0], v[1]); o.y = cvtpk(v[2], v[3]); *((GAS u32x2v*)(hb + (size_t)t * D_) + 64 * q + lane) = o; }
        ss = wave_sum(ss);
        if (lane < 16) ssq[(size_t)t * 16 + lane] = (lane == 0) ? ss : 0.f;
    }
}
__device__ __forceinline__ void p_final(const Frame& F, const Args& a) {
    GAS unsigned char* ws = (GAS unsigned char*)a.ws; asm volatile("" : "+s"(ws)); int lane_ = F.lane; asm volatile("" : "+v"(lane_)); const int lane = lane_; const float* ssq = (const float*)(ws + WS_SSQB); const float* ln = (const float*)a.in[6];
#pragma unroll 1
    for (int t = F.gw; t < S_; t += F.NGW) { const float rs = pg8::rstd_row(ssq, t);
#pragma unroll
        for (int q = 0; q < 4; ++q) { GAS f32x4* hp = (GAS f32x4*)(a.out + (size_t)t * D_) + 64 * q + lane; const f32x4 gq = *((const GAS f32x4*)ln + 64 * q + lane); *hp = (*hp) * rs * gq; } }
}
__device__ __forceinline__ void p_moe_weights(const Frame& F, const Args& a, int L, int w0, int nw) {
    LAS float* scr = (LAS float*)(F.lds + F.wave * WAVE_LDS);
    int base = 0;
#pragma unroll 1
    for (int id = 0; id < 24; ++id) { const MatD m = moe_mat(a, L >> 1, id);
        int first = (w0 - base) % nw; if (first < 0) first += nw;
#pragma unroll 1
        for (int it = first; it < m.items; it += nw) xpose_item(m.W, m.ldw, m.K, m.N, m.gain, m.WT, m.ilv, scr, it, F.lane);
        base += m.items; }
}

constexpr int P_PRO = 0, P_FINAL = 81, LP_ROT = 16, LPN = 20, LP_PROJ = 0, LP_ATT = 1, LP_MIXPREP = 2, LP_GA = 3, LP_G1 = 4, LP_G2 = 5, LP_G3 = 6, LP_OUT = 7, LP_UP = 8, LP_DOWN = 9, LP_R1 = 10, LP_R2 = 11, LP_M1 = 12, LP_M2 = 13, LP_COMB = 14, LP_PLE = 15;

#ifndef PH_MASK
#define PH_MASK 0xffffffffull
#endif
#define IN(k) (lo <= (k) && (k) < hi)
#define INL(lp) ((((unsigned long long)(PH_MASK) >> (lp)) & 1) && lo <= pb + (lp) && pb + (lp) < hi)
#define SEAM() do { if (args.use_bar) xcd_barrier(bar); } while (0)
#ifndef REP_LP
#define REP_LP -1
#endif
#ifndef REP_L
#define REP_L -1
#endif
#ifndef REP_N
#define REP_N 2
#endif
#define REPS(lp) ((L == (REP_L) && (lp) == (REP_LP)) ? 1 + (REP_N) : 1)
#if REP_LP >= 0
#define REPLOOP(lp) _Pragma("unroll 1") for (int rep_ = 0; rep_ < REPS(lp); ++rep_)
#else
#define REPLOOP(lp)
#endif
#define PHASE_WS() GAS unsigned char* ws = (GAS unsigned char*)ws0; asm volatile("" : "+s"(ws)); bf16* HBF = (bf16*)(ws + WS_HBF); bf16* MIX = (bf16*)(ws + WS_MIX); bf16* PP = (bf16*)(ws + WS_PP); float* SSQA = (float*)(ws + WS_SSQA); float* SSQB = (float*)(ws + WS_SSQB); (void)HBF; (void)MIX; (void)PP; (void)SSQA; (void)SSQB
template <int L> __device__ __forceinline__ void run_layer(const Frame& F, const Args& args, unsigned char* lds, const XcdBarrier& bar, unsigned char* ws0, const int lo, const int hi, const int cid) {
        const int pb = 1 + LPN * L, j = L >> 1; const bool odd = (L & 1) != 0;
        REPLOOP(LP_PROJ) if (INL(LP_PROJ)) { PHASE_WS();
            if (!odd) {
                pg8::Gemm gm{HBF, (const bf16*)(ws + WS_WINE) + (size_t)j * EIN * D_, S_, EIN, D_, 0}; pg8::StaticOrder So; So.init(S_, EIN, F.G, cid);
                pg8::EpiBf16 E{(bf16*)(ws + WS_ARENA + AR_PE), EIN, SSQB, pg8::C2, 512};
                pg8::gemm_phase<pg8::EpiBf16, pg8::StaticOrder, true, true>(F.lds + RING_OFF, gm, So, E);
            } else {
                pg8::Gemm gm{HBF, (const bf16*)(ws + WS_WINO) + (size_t)j * OIN * D_, S_, OIN, D_, 0}; pg8::StaticOrder So; So.init(S_, OIN, F.G, cid);
                pg8::EpiBf16 E{(bf16*)(ws + WS_ARENA + AR_PO), OIN, SSQB, 1.0f, 0};
                pg8::gemm_phase<pg8::EpiBf16, pg8::StaticOrder, true, true>(F.lds + RING_OFF, gm, So, E);
            }
            {
                pg8::Gemm gm{(const bf16*)(ws + WS_PBF) + (size_t)L * S_ * PLE, (const bf16*)(ws + WS_WP) + (size_t)L * D_ * PLE, S_, D_, PLE, 0}; pg8::StaticOrder So; So.init(S_, D_, F.G, cid);
                pg8::EpiBf16 E{PP, D_, nullptr, 1.0f, 0};
                pg8::gemm_phase<pg8::EpiBf16, pg8::StaticOrder, true, true>(F.lds + RING_OFF, gm, So, E);
            }
            if (odd) p_ab(F, args, L);
            SEAM();
        }
        if (!odd) {
            REPLOOP(LP_ROT) if (INL(LP_ROT)) { PHASE_WS(); p_rot(F, args); SEAM(); }
            REPLOOP(LP_ATT) if (INL(LP_ATT)) { PHASE_WS(); attn_body::attn_phase<8>((char*)lds + RING_OFF, (const attn_body::bf16*)(ws + WS_ARENA + AR_PE), (attn_body::bf16*)(ws + WS_ARENA + AR_AO), F.vcu, F.G); SEAM(); }
            REPLOOP(LP_MIXPREP) if (INL(LP_MIXPREP)) { PHASE_WS(); p_mixprep(F, args, L); SEAM(); }
        } else {
            REPLOOP(LP_GA) if (INL(LP_GA)) { PHASE_WS(); p_ga(F, args, L); SEAM(); }
            REPLOOP(LP_G1) if (INL(LP_G1)) { PHASE_WS(); p_g1(F, args); SEAM(); }
            REPLOOP(LP_G2) if (INL(LP_G2)) { PHASE_WS();
                const int nscan = F.G < 64 ? F.G : 64;
#ifdef PROBE_NOCONV
                if (!args.use_bar) { if (F.vcu < nscan) p_g2(F, args); } else
#endif
#ifdef PROBE_NOSCAN
                if (!args.use_bar) { if (F.vcu >= nscan) p_moe_weights(F, args, L, (F.vcu - nscan) * NWAVES + F.wave, (F.G - nscan) * NWAVES); } else
#endif
                if (F.vcu < nscan) p_g2(F, args);
                else p_moe_weights(F, args, L, (F.vcu - nscan) * NWAVES + F.wave, (F.G - nscan) * NWAVES);
                if (F.G <= 64) p_moe_weights(F, args, L, F.gw, F.NGW);
                SEAM();
            }
            REPLOOP(LP_G3) if (INL(LP_G3)) { PHASE_WS(); p_g3(F, args, L); SEAM(); }
        }
        REPLOOP(LP_OUT) if (INL(LP_OUT)) { PHASE_WS();
            const bf16* Wo = odd ? (const bf16*)(ws + WS_WOUTO) + (size_t)j * D_ * D_ : (const bf16*)(ws + WS_WOUTE) + (size_t)j * D_ * D_;
            pg8::Gemm gm{MIX, Wo, S_, D_, D_, 0}; pg8::StaticOrder So; So.init(S_, D_, F.G, cid);
            pg8::EpiResid E{args.out, HBF, SSQA};
            pg8::gemm_phase<pg8::EpiResid, pg8::StaticOrder, true, true>(F.lds + RING_OFF, gm, So, E);
            SEAM();
        }
        if (!odd) {
            REPLOOP(LP_UP) if (INL(LP_UP)) { PHASE_WS();
                pg8::Gemm gm{HBF, (const bf16*)(ws + WS_W13D) + (size_t)j * 2 * DFF * D_, S_, 2 * DFF, D_, 0}; pg8::StaticOrder So; So.init(S_, 2 * DFF, F.G, cid);
                pg8::EpiSwiglu E{(bf16*)(ws + WS_ARENA + AR_ACT), SSQA};
                pg8::gemm_phase<pg8::EpiSwiglu, pg8::StaticOrder, true, true>(F.lds + RING_OFF, gm, So, E);
                SEAM();
            }
            REPLOOP(LP_DOWN) if (INL(LP_DOWN)) { PHASE_WS();
                pg8::Gemm gm{(const bf16*)(ws + WS_ARENA + AR_ACT), (const bf16*)(ws + WS_W2D) + (size_t)j * D_ * DFF, S_, D_, DFF, 0}; pg8::StaticOrder So; So.init(S_, D_, F.G, cid);
                pg8::EpiResid E{args.out, HBF, SSQA};
                pg8::gemm_phase<pg8::EpiResid, pg8::StaticOrder, true, true>(F.lds + RING_OFF, gm, So, E);
                SEAM();
            }
        } else {
            REPLOOP(LP_R1) if (INL(LP_R1)) { PHASE_WS(); p_r1(F, args, L); SEAM(); }
            REPLOOP(LP_R2) if (INL(LP_R2)) { PHASE_WS(); p_r2(F, args, L); SEAM(); }
            REPLOOP(LP_M1) if (INL(LP_M1)) { PHASE_WS();
                const int nb = moe_blocks(F, args, L);
                pg8::Gemm gm{(const bf16*)(ws + WS_ARENA + AR_XS), (const bf16*)(ws + WS_W13M), nb * 256, 2 * DFF, D_, (size_t)2 * DFF * D_ * 2}; pg8::MoeOrder So; So.init(nb * 256, 2 * DFF, F.G, cid); So.blk_e = (const LAS int*)(F.lds + BLKE_OFF);
                pg8::EpiSwiglu E{(bf16*)(ws + WS_ARENA + AR_ACT), nullptr};
                pg8::gemm_phase<pg8::EpiSwiglu, pg8::MoeOrder, true, true>(F.lds + RING_OFF, gm, So, E);
                SEAM();
            }
            REPLOOP(LP_M2) if (INL(LP_M2)) { PHASE_WS();
                const int nb = moe_blocks(F, args, L);
                pg8::Gemm gm{(const bf16*)(ws + WS_ARENA + AR_ACT), (const bf16*)(ws + WS_W2M), nb * 256, D_, DFF, (size_t)D_ * DFF * 2}; pg8::MoeOrder So; So.init(nb * 256, D_, F.G, cid); So.blk_e = (const LAS int*)(F.lds + BLKE_OFF);
                pg8::EpiMoeDown E{(bf16*)(ws + WS_ARENA + AR_Y), (const float*)(ws + WS_TOK + TOK_GPAD)};
                pg8::gemm_phase<pg8::EpiMoeDown, pg8::MoeOrder, true, true>(F.lds + RING_OFF, gm, So, E);
                SEAM();
            }
            REPLOOP(LP_COMB) if (INL(LP_COMB)) { PHASE_WS(); p_combine(F, args); SEAM(); }
        }
        REPLOOP(LP_PLE) if (INL(LP_PLE)) { PHASE_WS();
            pg8::Gemm gm{HBF, (const bf16*)(ws + WS_WG) + (size_t)L * D_ * D_, S_, D_, D_, 0}; pg8::StaticOrder So; So.init(S_, D_, F.G, cid);
            pg8::EpiPle E{args.out, HBF, SSQA, SSQB, PP};
            pg8::gemm_phase<pg8::EpiPle, pg8::StaticOrder, true, true>(F.lds + RING_OFF, gm, So, E);
            SEAM();
        }
    }

__global__ void __launch_bounds__(NWAVES * 64, 2) fwd(Args args) {
    extern __shared__ __attribute__((aligned(16))) unsigned char lds[];
    Frame F;
    F.lds = (LAS unsigned char*)lds; F.tid = threadIdx.x; F.lane = F.tid & 63; F.wave = __builtin_amdgcn_readfirstlane(F.tid >> 6);
    F.G = gridDim.x; { const int bx = blockIdx.x; F.vcu = (F.G % 8 == 0) ? (bx % 8) * (F.G / 8) + bx / 8 : bx; }
    F.gw = F.vcu * NWAVES + F.wave; F.NGW = F.G * NWAVES;
    unsigned char* ws0 = args.ws;
    for (int u = F.tid; u < (LDS_BYTES - LDSCTL_OFF) / 4; u += NWAVES * 64) ((LAS unsigned*)(F.lds + LDSCTL_OFF))[u] = 0u;
    __syncthreads();
    XcdBarrier bar; bar.bar = (unsigned*)(ws0 + WS_CTL) + CW_BAR; bar.x = 0; bar.st = nullptr;
    if (args.use_bar) bar = xcd_barrier_post((unsigned*)(ws0 + WS_CTL) + CW_BAR, (volatile LAS unsigned*)(F.lds + MISC_OFF));
    const int lo = args.ph_lo, hi = args.ph_hi;
    const int cid = (int)blockIdx.x;

    if ((((unsigned long long)(PH_MASK) >> 30) & 1) && IN(P_PRO)) { p_prologue(F, args); SEAM(); }

#ifdef FIXED_L
    run_layer<FIXED_L>(F, args, lds, bar, ws0, lo, hi, cid);
#else
    run_layer<0>(F, args, lds, bar, ws0, lo, hi, cid); run_layer<1>(F, args, lds, bar, ws0, lo, hi, cid); run_layer<2>(F, args, lds, bar, ws0, lo, hi, cid); run_layer<3>(F, args, lds, bar, ws0, lo, hi, cid);
#endif
    if ((((unsigned long long)(PH_MASK) >> 31) & 1) && IN(P_FINAL)) p_final(F, args);
#undef IN
#undef INL
#undef SEAM
}


#ifndef DBG
#define DBG 0
#endif
#if DBG
#ifndef DBG_ASLOT
#define DBG_ASLOT 9
#endif
#ifndef DBG_BSLOT
#define DBG_BSLOT 11
#endif
__global__ void dbg_scan(const void* p, size_t n, int is_f32, unsigned* slot) {
    unsigned cnt = 0;
    for (size_t i = (size_t)blockIdx.x * blockDim.x + threadIdx.x; i < n; i += (size_t)gridDim.x * blockDim.x) {
        const float v = is_f32 ? ((const float*)p)[i] : __uint_as_float(((unsigned)((const unsigned short*)p)[i]) << 16);
        if (!(fabsf(v) < 1e30f)) ++cnt; }
    if (cnt) atomicAdd(slot, cnt);
}
__global__ void dbg_fill(float* out, size_t n, const unsigned* slots, int nslots) {
    int first = -1; for (int i = 0; i < nslots; ++i) if (slots[i]) { first = i; break; }
    float c, V;
    if (first >= 0) { c = sqrtf((float)(10 + first) * 1e6f); V = c; }
    else { const float ea = fmaxf(__uint_as_float(slots[256 + DBG_ASLOT]), 1e-5f), eb = fmaxf(__uint_as_float(slots[256 + DBG_BSLOT]), 1e-5f);
        c = sqrtf((10.f + fminf(60.f, rintf(10.f * (log10f(ea) + 5.f)))) * 1e4f); V = (50.f + rintf(10.f * log10f(eb))) * 1e3f; }
    for (size_t i = (size_t)blockIdx.x * blockDim.x + threadIdx.x; i < n; i += (size_t)gridDim.x * blockDim.x) out[i] = (i == 0) ? V : c;
}
__device__ __forceinline__ float dbg_bf(const unsigned short* p, size_t i) { return __uint_as_float(((unsigned)p[i]) << 16); }
__device__ __forceinline__ float dbg_rstd(const float* ssq, int row) { float s = 0.f; for (int i = 0; i < 16; ++i) s += ssq[(size_t)row * 16 + i]; return 1.0f / sqrtf(s / 1024.0f + 1e-6f); }
__device__ __forceinline__ float dbg_blocksum(float v, float* red) {
    __syncthreads(); red[threadIdx.x] = v; __syncthreads();
    for (int o = 128; o > 0; o >>= 1) { if ((int)threadIdx.x < o) red[threadIdx.x] += red[threadIdx.x + o]; __syncthreads(); }
    const float r = red[0]; __syncthreads(); return r;
}
__device__ __forceinline__ void dbg_report(unsigned* slot, float num, float den) { if (threadIdx.x == 0) atomicMax(slot, __float_as_uint(sqrtf(num / fmaxf(den, 1e-20f)))); }
__global__ void chk_ffn(const float* hpre, const float* hpost, const float* ssq, const float* ln, const float* wr, const float* w1, const float* w3, const float* w2, int moe, unsigned* slot) {
    __shared__ float xn[1024]; __shared__ float hid[3584]; __shared__ float red[256]; __shared__ float lg[8];
    const int t = (blockIdx.x * 997 + 13) % S_, tid = threadIdx.x;
    const float rs = dbg_rstd(ssq, t);
    for (int k = tid; k < 1024; k += 256) xn[k] = hpre[(size_t)t * 1024 + k] * rs * ln[k];
    __syncthreads();
    int e0 = 0, e1 = 0; float g0 = 1.f, g1 = 0.f;
    if (moe) {
        if (tid < 8) { float s = 0.f; for (int k = 0; k < 1024; ++k) s += xn[k] * wr[(size_t)k * 8 + tid]; lg[tid] = s; }
        __syncthreads();
        float l0 = lg[0]; for (int e = 1; e < 8; ++e) if (lg[e] > l0) { l0 = lg[e]; e0 = e; }
        float l1 = -1e30f; e1 = -1; for (int e = 0; e < 8; ++e) if (e != e0 && lg[e] > l1) { l1 = lg[e]; e1 = e; }
        const float m0 = expf(l0 - l0), m1 = expf(l1 - l0); g0 = m0 / (m0 + m1); g1 = m1 / (m0 + m1);
    }
    float acc[4] = {0.f, 0.f, 0.f, 0.f};
    for (int pass = 0; pass < (moe ? 2 : 1); ++pass) {
        const int e = pass == 0 ? e0 : e1; const float gt = pass == 0 ? g0 : g1;
        const float* W1 = w1 + (size_t)e * 1024 * 3584; const float* W3 = w3 + (size_t)e * 1024 * 3584; const float* W2 = w2 + (size_t)e * 3584 * 1024;
        __syncthreads();
        for (int f = tid; f < 3584; f += 256) { float a = 0.f, b = 0.f; for (int k = 0; k < 1024; ++k) { a += xn[k] * W1[(size_t)k * 3584 + f]; b += xn[k] * W3[(size_t)k * 3584 + f]; } hid[f] = a / (1.f + expf(-a)) * b; }
        __syncthreads();
        for (int q = 0; q < 4; ++q) { const int c = tid + 256 * q; float y = 0.f; for (int f = 0; f < 3584; ++f) y += hid[f] * W2[(size_t)f * 1024 + c]; acc[q] += gt * y; }
    }
    float num = 0.f, den = 0.f;
    for (int q = 0; q < 4; ++q) { const int c = tid + 256 * q; const float ex = acc[q], got = hpost[(size_t)t * 1024 + c] - hpre[(size_t)t * 1024 + c]; num += (got - ex) * (got - ex); den += ex * ex; }
    num = dbg_blocksum(num, red); den = dbg_blocksum(den, red);
    dbg_report(slot, num, den);
}
__global__ void chk_ple(const float* hpre, const float* hpost, const float* ssq, const float* ln, const float* wg, const float* p, const float* wp, unsigned* slot) {
    __shared__ float xn[1024]; __shared__ float red[256];
    const int t = (blockIdx.x * 997 + 13) % S_, tid = threadIdx.x; const float rs = dbg_rstd(ssq, t);
    for (int k = tid; k < 1024; k += 256) xn[k] = hpre[(size_t)t * 1024 + k] * rs * ln[k];
    __syncthreads();
    float num = 0.f, den = 0.f;
    for (int q = 0; q < 4; ++q) { const int c = tid + 256 * q; float a = 0.f, b = 0.f; for (int k = 0; k < 1024; ++k) a += xn[k] * wg[(size_t)k * 1024 + c]; for (int k = 0; k < 256; ++k) b += p[(size_t)t * 256 + k] * wp[(size_t)k * 1024 + c];
        const float ex = b / (1.f + expf(-a)), got = hpost[(size_t)t * 1024 + c] - hpre[(size_t)t * 1024 + c]; num += (got - ex) * (got - ex); den += ex * ex; }
    num = dbg_blocksum(num, red); den = dbg_blocksum(den, red); dbg_report(slot, num, den);
}
constexpr int DBG_TC = 512;
__global__ void chk_gdn_proj(const float* h, const float* ssq, const float* ln, const float* W, int hh, float* raw) {
    const int idx = blockIdx.x * blockDim.x + threadIdx.x; if (idx >= DBG_TC * 514) return;
    const int t = idx / 514, c = idx % 514;
    const int col = c < 128 ? hh * 128 + c : c < 256 ? 1024 + hh * 128 + (c - 128) : c < 384 ? 2048 + hh * 128 + (c - 256) : c < 512 ? 3072 + hh * 128 + (c - 384) : c == 512 ? 4096 + hh : 4104 + hh;
    const float rs = dbg_rstd(ssq, t); float s = 0.f;
    for (int k = 0; k < 1024; ++k) s += h[(size_t)t * 1024 + k] * ln[k] * W[(size_t)k * OIN_SRC + col];
    raw[(size_t)t * 514 + c] = s * rs;
}
__global__ void chk_gdn_rec(const float* raw, const float* cw, const float* alog, const float* dtb, const float* onorm, int hh, const unsigned short* mix, unsigned* slot) {
    extern __shared__ float sm[];
    float* Sm = sm; float* q = sm + 128 * 129; float* kk = q + 128; float* v = kk + 128; float* kv = v + 128; float* dl = kv + 128; float* o = dl + 128; float* red = o + 128;
    const int tid = threadIdx.x;
    for (int i = tid; i < 128 * 129; i += 256) Sm[i] = 0.f;
    __syncthreads();
    float worst = 0.f;
    for (int t = 0; t < DBG_TC; ++t) {
        if (tid < 128) { const int d = tid; float aq = 0.f, ak = 0.f, av = 0.f;
            for (int jj = 0; jj < 4; ++jj) { const int r = t - 3 + jj; if (r >= 0) { aq += cw[jj * 3072 + hh * 128 + d] * raw[(size_t)r * 514 + d]; ak += cw[jj * 3072 + 1024 + hh * 128 + d] * raw[(size_t)r * 514 + 128 + d]; av += cw[jj * 3072 + 2048 + hh * 128 + d] * raw[(size_t)r * 514 + 256 + d]; } }
            q[d] = aq / (1.f + expf(-aq)); kk[d] = ak / (1.f + expf(-ak)); v[d] = av / (1.f + expf(-av)); }
        __syncthreads();
        const float sq = dbg_blocksum(tid < 128 ? q[tid] * q[tid] : 0.f, red), sk = dbg_blocksum(tid < 128 ? kk[tid] * kk[tid] : 0.f, red);
        if (tid < 128) { q[tid] *= 1.0f / sqrtf(sq + 1e-6f) * 0.08838834764831845f; kk[tid] *= 1.0f / sqrtf(sk + 1e-6f); }
        const float bb = raw[(size_t)t * 514 + 512], aa = raw[(size_t)t * 514 + 513];
        const float beta = 1.f / (1.f + expf(-bb)); const float z = aa + dtb[hh]; const float g = -expf(alog[hh]) * (z > 20.f ? z : log1pf(expf(z))); const float alpha = expf(g);
        __syncthreads();
        for (int i = tid; i < 128 * 128; i += 256) { const int d = i >> 7, j = i & 127; Sm[d * 129 + j] *= alpha; }
        __syncthreads();
        if (tid < 128) { float s = 0.f; for (int d = 0; d < 128; ++d) s += kk[d] * Sm[d * 129 + tid]; dl[tid] = beta * (v[tid] - s); }
        __syncthreads();
        for (int i = tid; i < 128 * 128; i += 256) { const int d = i >> 7, j = i & 127; Sm[d * 129 + j] += kk[d] * dl[j]; }
        __syncthreads();
        if (tid < 128) { float s = 0.f; for (int d = 0; d < 128; ++d) s += q[d] * Sm[d * 129 + tid]; o[tid] = s; }
        __syncthreads();
        const float so = dbg_blocksum(tid < 128 ? o[tid] * o[tid] : 0.f, red); const float rms = 1.0f / sqrtf(so / 128.f + 1e-6f);
        float num = 0.f, den = 0.f;
        if (tid < 128) { const float zz = raw[(size_t)t * 514 + 384 + tid]; const float ex = o[tid] * rms * onorm[tid] * (zz / (1.f + expf(-zz))); const float got = dbg_bf(mix, (size_t)t * 1024 + hh * 128 + tid); num = (got - ex) * (got - ex); den = ex * ex; }
        num = dbg_blocksum(num, red); den = dbg_blocksum(den, red);
        worst = fmaxf(worst, sqrtf(num / fmaxf(den, 1e-20f)));
    }
    if (tid == 0) atomicMax(slot, __float_as_uint(worst));
}

__global__ void chk_even_kv(const float* h, const float* ssq, const float* ln, const float* W, float* KV) {
    const size_t idx = (size_t)blockIdx.x * blockDim.x + threadIdx.x; if (idx >= (size_t)S_ * 1024) return;
    const int t = (int)(idx >> 10), c = (int)(idx & 1023); const float rs = dbg_rstd(ssq, t); float s = 0.f;
    for (int k = 0; k < 1024; ++k) s += h[(size_t)t * 1024 + k] * ln[k] * W[(size_t)k * EIN + 512 + c];
    KV[idx] = s * rs;
}
__global__ void chk_even_mix(const float* h, const float* ssq, const float* ln, const float* W, const float* KV, const int* pos, const float* lq1, const float* lk1, const float* lq2, const float* lk2, const float* subg, const float* cw,
                             float lam0, const unsigned short* PE, const unsigned short* AO, const unsigned short* MIXb, unsigned* slot) {
    __shared__ float q[2][64]; __shared__ float p[128]; __shared__ float red[256]; __shared__ float o2[2][128]; __shared__ float hn[1024];
    const int toks[6] = {5, 200, 1000, 4097, 9000, 16383};
    const int t = toks[blockIdx.x / 4], hh = blockIdx.x % 4, tid = threadIdx.x;
    auto bsum = [&](float v) { __syncthreads(); red[tid] = v; __syncthreads(); for (int o = 64; o > 0; o >>= 1) { if (tid < o) red[tid] += red[tid + o]; __syncthreads(); } const float r = red[0]; __syncthreads(); return r; };
    auto bmax = [&](float v) { __syncthreads(); red[tid] = v; __syncthreads(); for (int o = 64; o > 0; o >>= 1) { if (tid < o) red[tid] = fmaxf(red[tid], red[tid + o]); __syncthreads(); } const float r = red[0]; __syncthreads(); return r; };
    auto invf = [&](int i) { return exp2f(-(float)i * (18.931568569324174f / 8.0f)); };
    const float rs = dbg_rstd(ssq, t);
    for (int k = tid; k < 1024; k += 128) hn[k] = h[(size_t)t * 1024 + k] * rs * ln[k];
    __syncthreads();
    { const int m = tid >> 6, d = tid & 63, col = (2 * hh + m) * 64 + d; float s = 0.f; for (int k = 0; k < 1024; ++k) s += hn[k] * W[(size_t)k * EIN + col]; q[m][d] = s; }
    __syncthreads();
    float qr;
    { const int m = tid >> 6, d = tid & 63; float v = q[m][d];
      if (d < 16) { const int i = d & 7; const float ang = (float)pos[t] * invf(i); const float c = cosf(ang), s = sinf(ang); v = d < 8 ? q[m][d] * c - q[m][d + 8] * s : q[m][d] * c + q[m][d - 8] * s; }
      qr = v * pg8::C2; }
    __syncthreads(); q[tid >> 6][tid & 63] = qr; __syncthreads();
    float num = 0.f, den = 0.f;
    { const int m = tid >> 6, d = tid & 63; const float got = dbg_bf(PE, (size_t)t * EIN + (2 * hh + m) * 64 + d); const float e2 = (got - qr) * (got - qr), r2 = qr * qr; num += e2; den += r2;
      const float na = bsum(d >= 16 ? e2 : 0.f), da = bsum(d >= 16 ? r2 : 0.f), nb = bsum(d < 16 ? e2 : 0.f), db = bsum(d < 16 ? r2 : 0.f);
      if (tid == 0) { atomicMax(slot + 4, __float_as_uint(sqrtf(na / fmaxf(da, 1e-20f)))); atomicMax(slot + 5, __float_as_uint(sqrtf(nb / fmaxf(db, 1e-20f)))); } }
    { const int m = tid >> 6, d = tid & 63; const float* kr = KV + (size_t)t * 1024 + (2 * hh + m) * 64; float v = kr[d];
      if (d < 16) { const int i = d & 7; const float ang = (float)pos[t] * invf(i); const float c = cosf(ang), s = sinf(ang); v = d < 8 ? kr[d] * c - kr[d + 8] * s : kr[d] * c + kr[d - 8] * s; }
      const float got = dbg_bf(PE, (size_t)t * EIN + 512 + (2 * hh + m) * 64 + d); const float e2 = (got - v) * (got - v), r2 = v * v; num += e2; den += r2;
      const float na = bsum(d >= 16 ? e2 : 0.f), da = bsum(d >= 16 ? r2 : 0.f), nb = bsum(d < 16 ? e2 : 0.f), db = bsum(d < 16 ? r2 : 0.f);
      const float vv = KV[(size_t)t * 1024 + 512 + hh * 128 + tid], gv = dbg_bf(PE, (size_t)t * EIN + 1024 + hh * 128 + tid); const float e3 = (gv - vv) * (gv - vv), r3 = vv * vv; num += e3; den += r3;
      const float nc = bsum(e3), dc = bsum(r3);
      if (tid == 0) { atomicMax(slot + 6, __float_as_uint(sqrtf(na / fmaxf(da, 1e-20f)))); atomicMax(slot + 7, __float_as_uint(sqrtf(nb / fmaxf(db, 1e-20f)))); atomicMax(slot + 8, __float_as_uint(sqrtf(nc / fmaxf(dc, 1e-20f)))); } }
    num = bsum(num); den = bsum(den); if (tid == 0) atomicMax(slot + 0, __float_as_uint(sqrtf(num / fmaxf(den, 1e-20f))));
    for (int m = 0; m < 2; ++m) {
        float mx = -1e30f;
        for (int j0 = 0; j0 <= t; j0 += 128) { const int j = j0 + tid; float s = -1e30f;
            if (j <= t) { const float* kr = KV + (size_t)j * 1024 + (2 * hh + m) * 64; s = 0.f;
                for (int d = 0; d < 64; ++d) { float kv = kr[d]; if (d < 16) { const int i = d & 7; const float ang = (float)pos[j] * invf(i); const float c = cosf(ang), sn = sinf(ang); kv = d < 8 ? kr[d] * c - kr[d + 8] * sn : kr[d] * c + kr[d - 8] * sn; } s += q[m][d] * kv; } }
            mx = fmaxf(mx, s); }
        mx = bmax(mx);
        float l = 0.f, acc = 0.f;
        for (int j0 = 0; j0 <= t; j0 += 128) { const int j = j0 + tid; float pe = 0.f;
            if (j <= t) { const float* kr = KV + (size_t)j * 1024 + (2 * hh + m) * 64; float s = 0.f;
                for (int d = 0; d < 64; ++d) { float kv = kr[d]; if (d < 16) { const int i = d & 7; const float ang = (float)pos[j] * invf(i); const float c = cosf(ang), sn = sinf(ang); kv = d < 8 ? kr[d] * c - kr[d + 8] * sn : kr[d] * c + kr[d - 8] * sn; } s += q[m][d] * kv; }
                pe = exp2f(s - mx); }
            __syncthreads(); p[tid] = pe; __syncthreads();
            l += pe;
            const int nj = min(128, t + 1 - j0);
            for (int i = 0; i < nj; ++i) acc += p[i] * KV[(size_t)(j0 + i) * 1024 + 512 + hh * 128 + tid]; }
        l = bsum(l);
        o2[m][tid] = acc / l;
    }
    __syncthreads();
    { float n2 = 0.f, d2 = 0.f;
      for (int m = 0; m < 2; ++m) { const float ex = o2[m][tid], got = dbg_bf(AO, (size_t)t * 1024 + hh * 256 + m * 128 + tid); n2 += (got - ex) * (got - ex); d2 += ex * ex; }
      n2 = bsum(n2); d2 = bsum(d2); if (tid == 0) atomicMax(slot + 1, __float_as_uint(sqrtf(n2 / fmaxf(d2, 1e-20f)))); }
    float s1 = 0.f, s2 = 0.f; for (int i = 0; i < 64; ++i) { s1 += lq1[i] * lk1[i]; s2 += lq2[i] * lk2[i]; }
    const float lam = expf(s1) - expf(s2) + lam0;
    const float dv = o2[0][tid] - lam * o2[1][tid]; const float ssd = bsum(dv * dv); const float ex = dv / sqrtf(ssd / 128.f + 1e-5f) * subg[tid] * (1.f - lam0);
    { const float got = dbg_bf(MIXb, (size_t)t * 1024 + hh * 128 + tid); float n2 = (got - ex) * (got - ex), d2 = ex * ex; n2 = bsum(n2); d2 = bsum(d2); if (tid == 0) atomicMax(slot + 2, __float_as_uint(sqrtf(n2 / fmaxf(d2, 1e-20f)))); }
    { const int ch = hh * 128 + tid; float cx[3] = {0.f, 0.f, 0.f}, bg = 0.f;
      for (int jj = 0; jj < 3; ++jj) { const int r = t - 2 + jj; if (r < 0) continue; const float rr = dbg_rstd(ssq, r); float c = 0.f, x = 0.f, b = 0.f;
          for (int k = 0; k < 1024; ++k) { const float hv = h[(size_t)r * 1024 + k] * ln[k]; c += hv * W[(size_t)k * EIN + 2048 + ch]; x += hv * W[(size_t)k * EIN + 2560 + ch]; if (jj == 2) b += hv * W[(size_t)k * EIN + 1536 + ch]; }
          cx[jj] = (c * rr) * (x * rr); if (jj == 2) bg = b * rr; }
      const float ex2 = bg * (cw[0 * 512 + ch] * cx[0] + cw[1 * 512 + ch] * cx[1] + cw[2 * 512 + ch] * cx[2]); const float got = dbg_bf(MIXb, (size_t)t * 1024 + 512 + ch);
      float n2 = (got - ex2) * (got - ex2), d2 = ex2 * ex2; n2 = bsum(n2); d2 = bsum(d2); if (tid == 0) atomicMax(slot + 3, __float_as_uint(sqrtf(n2 / fmaxf(d2, 1e-20f)))); }
}
static void dbg_before_phase(int ph, unsigned char* ws, float* out, hipStream_t st) {
    if (ph == P_PRO || ph == P_FINAL) return;
    const int lp = (ph - 1) % LPN;
    if (lp == LP_UP || lp == LP_R1 || lp == LP_PLE) { (void)hipMemcpyAsync(ws + WS_ARENA + 400 * MiB, out, (size_t)S_ * D_ * 4, hipMemcpyDeviceToDevice, st); (void)hipMemcpyAsync(ws + WS_ARENA + 464 * MiB, ws + WS_SSQA, (size_t)S_ * 16 * 4, hipMemcpyDeviceToDevice, st); }
}
static void dbg_checks(int ph, void* const* d_in, unsigned char* ws, float* out, hipStream_t st) {
    if (ph == P_PRO || ph == P_FINAL) return;
    unsigned* slots = (unsigned*)(ws + WS_CTL) + CW_DBG; const int L = (ph - 1) / LPN, lp = (ph - 1) % LPN, j = L >> 1; const bool odd = L & 1;
    const float* snap = (const float*)(ws + WS_ARENA + 400 * MiB);
    if (lp == LP_DOWN && L == 0) hipLaunchKernelGGL(chk_ffn, dim3(24), dim3(256), 0, st, snap, (const float*)out, (const float*)(ws + WS_ARENA + 464 * MiB), (const float*)d_in[4] + L * D_, (const float*)nullptr,
        (const float*)d_in[21] + (size_t)j * D_ * DFF, (const float*)d_in[22] + (size_t)j * D_ * DFF, (const float*)d_in[23] + (size_t)j * D_ * DFF, 0, slots + 256 + 0);
    if (lp == LP_PLE && L == 0) hipLaunchKernelGGL(chk_ple, dim3(24), dim3(256), 0, st, snap, (const float*)out, (const float*)(ws + WS_ARENA + 464 * MiB), (const float*)d_in[5] + L * D_, (const float*)d_in[28] + (size_t)L * D_ * D_,
        (const float*)d_in[1] + (size_t)L * S_ * PLE, (const float*)d_in[29] + (size_t)L * PLE * D_, slots + 256 + 1);
    if (lp == LP_G3 && L == 1) { float* raw = (float*)(ws + WS_ARENA + 400 * MiB);
        hipLaunchKernelGGL(chk_gdn_proj, dim3((DBG_TC * 514 + 255) / 256), dim3(256), 0, st, (const float*)out, (const float*)(ws + WS_SSQB), (const float*)d_in[3] + L * D_, (const float*)d_in[15] + (size_t)j * D_ * OIN_SRC, 3, raw);
        hipLaunchKernelGGL(chk_gdn_rec, dim3(1), dim3(256), (128 * 129 + 6 * 128 + 256) * 4, st, (const float*)raw, (const float*)d_in[16] + (size_t)j * 4 * 3072, (const float*)d_in[17] + j * 8, (const float*)d_in[18] + j * 8, (const float*)d_in[19] + j * 128, 3, (const unsigned short*)(ws + WS_MIX), slots + 256 + 2); }
    if (lp == LP_COMB && L == 1) hipLaunchKernelGGL(chk_ffn, dim3(24), dim3(256), 0, st, snap, (const float*)out, (const float*)(ws + WS_ARENA + 464 * MiB), (const float*)d_in[4] + L * D_, (const float*)d_in[24] + (size_t)j * D_ * NEXP,
        (const float*)d_in[25] + (size_t)j * NEXP * D_ * DFF, (const float*)d_in[26] + (size_t)j * NEXP * D_ * DFF, (const float*)d_in[27] + (size_t)j * NEXP * DFF * D_, 1, slots + 256 + 3);
    if (lp == LP_MIXPREP && L == 0) { float* KV = (float*)(ws + WS_ARENA + 400 * MiB);
        hipLaunchKernelGGL(chk_even_kv, dim3((S_ * 1024) / 256), dim3(256), 0, st, (const float*)out, (const float*)(ws + WS_SSQB), (const float*)d_in[3] + L * D_, (const float*)d_in[7] + (size_t)j * D_ * EIN, KV);
        hipLaunchKernelGGL(chk_even_mix, dim3(24), dim3(128), 0, st, (const float*)out, (const float*)(ws + WS_SSQB), (const float*)d_in[3] + L * D_, (const float*)d_in[7] + (size_t)j * D_ * EIN, (const float*)KV, (const int*)d_in[2],
            (const float*)d_in[9] + j * 64, (const float*)d_in[10] + j * 64, (const float*)d_in[11] + j * 64, (const float*)d_in[12] + j * 64, (const float*)d_in[13] + j * 128, (const float*)d_in[14] + (size_t)j * 3 * 512,
            0.8f - 0.6f * expf(-0.3f * (float)L), (const unsigned short*)(ws + WS_ARENA + AR_PE), (const unsigned short*)(ws + WS_ARENA + AR_AO), (const unsigned short*)(ws + WS_MIX), slots + 256 + 4); }
    (void)odd;
}
static void dbg_after_phase(int ph, unsigned char* ws, float* out, hipStream_t st) {
    unsigned* slots = (unsigned*)(ws + WS_CTL) + CW_DBG; unsigned* sl = slots + ph;
    auto scan = [&](const void* p, size_t n, int f32) { hipLaunchKernelGGL(dbg_scan, dim3(1024), dim3(256), 0, st, p, n, f32, sl); };
    const size_t SD = (size_t)S_ * D_; unsigned char* ar = ws + WS_ARENA;
    if (ph == P_PRO) { scan(ws + WS_HBF, SD, 0); scan(out, SD, 1); scan(ws + WS_PBF, (size_t)4 * S_ * PLE, 0); scan(ws + WS_TAB, (size_t)S_ * 16, 1); scan(ws + WS_W, (size_t)44 * MiB, 0); return; }
    if (ph == P_FINAL) return;
    const int L = (ph - 1) / LPN, lp = (ph - 1) % LPN; const bool odd = L & 1;
    switch (lp) {
    case LP_PROJ: if (!odd) scan(ar + AR_PE, (size_t)S_ * EIN, 0); else { scan(ar + AR_PO, (size_t)S_ * OIN, 0); scan(ws + WS_GB, (size_t)S_ * 16, 1); } scan(ws + WS_PP, SD, 0); break;
    case LP_ROT: scan(ar + AR_PE, (size_t)S_ * EIN, 0); break;
    case LP_ATT: scan(ar + AR_AO, SD, 0); break;
    case LP_MIXPREP: case LP_G3: scan(ws + WS_MIX, SD, 0); break;
    case LP_GA: scan(ar + AR_QN, SD * 6, 0); scan(ws + WS_GB, (size_t)S_ * 16, 1); break;
    case LP_G1: scan(ar + AR_AI, (size_t)NUNIT * 4096, 0); scan(ar + AR_NEGW, SD, 0); scan(ar + AR_UT, SD, 0); scan(ar + AR_MP, (size_t)NUNIT * 16384 * 2, 0); break;
    case LP_G2: scan(ar + AR_SG, (size_t)NUNIT * 16384, 0); break;
    case LP_OUT: case LP_DOWN: case LP_COMB: case LP_PLE: scan(out, SD, 1); scan(ws + WS_HBF, SD, 0); scan(ws + ((lp == LP_PLE) ? WS_SSQB : WS_SSQA), (size_t)S_ * 16, 1); break;
    case LP_UP: scan(ar + AR_ACT, (size_t)S_ * DFF, 0); break;
    case LP_R1: scan(ws + WS_TOK + TOK_G, (size_t)S_ * 2, 1); break;
    default: break; }
}
#endif
#ifndef MK_MULTI
#define MK_MULTI 0
#endif
extern "C" void kernel_launch(void* const* d_in, const int* in_sizes, int n_in, void* d_out, int out_size, void* d_ws, size_t ws_size, hipStream_t stream) {
    static int grid = 0;
    if (grid == 0) {
        if (n_in != 30 || out_size != S_ * D_ || ws_size < WS_NEED) { fprintf(stderr, "kernel_launch: unexpected problem (n_in %d, out %d, ws %zu < %zu)\n", n_in, out_size, ws_size, (size_t)WS_NEED); grid = -1; return; }
        int dev = 0, cus = 0, per_cu = 0;
        if (hipGetDevice(&dev) != hipSuccess || hipDeviceGetAttribute(&cus, hipDeviceAttributeMultiprocessorCount, dev) != hipSuccess) { grid = -1; return; }
        if (hipFuncSetAttribute((const void*)fwd, hipFuncAttributeMaxDynamicSharedMemorySize, LDS_BYTES) != hipSuccess) { fprintf(stderr, "kernel_launch: hipFuncSetAttribute failed\n"); grid = -1; return; }
        if (hipOccupancyMaxActiveBlocksPerMultiprocessor(&per_cu, (const void*)fwd, NWAVES * 64, LDS_BYTES) != hipSuccess || per_cu < 1) { fprintf(stderr, "kernel_launch: occupancy query says %d\n", per_cu); }
        (void)hipGetLastError();
        grid = cus;
#if DBG
        (void)hipFuncSetAttribute((const void*)chk_gdn_rec, hipFuncAttributeMaxDynamicSharedMemorySize, 72 * 1024);
#endif
    }
    if (grid < 0) return;
    (void)hipMemsetAsync((char*)d_ws + WS_CTL, 0, CTL_ZERO_BYTES, stream);
    Args a{};
    for (int i = 0; i < 30; ++i) a.in[i] = d_in[i];
    a.out = (float*)d_out; a.ws = (unsigned char*)d_ws; a.pad = 0;
#if MK_MULTI
    a.use_bar = 0;
    static const int seq_even[] = {LP_PROJ, LP_ROT, LP_ATT, LP_MIXPREP, LP_OUT, LP_UP, LP_DOWN, LP_PLE};
    static const int seq_odd[] = {LP_PROJ, LP_GA, LP_G1, LP_G2, LP_G3, LP_OUT, LP_R1, LP_R2, LP_M1, LP_M2, LP_COMB, LP_PLE};
    int plist[64], np = 0; plist[np++] = P_PRO;
    for (int L = 0; L < DEPTH_; ++L) { const bool odd = L & 1; const int n = odd ? 12 : 8; for (int q = 0; q < n; ++q) plist[np++] = 1 + LPN * L + (odd ? seq_odd[q] : seq_even[q]); }
    plist[np++] = P_FINAL;
    for (int pi = 0; pi < np; ++pi) { const int ph = plist[pi];
        a.ph_lo = ph; a.ph_hi = ph + 1;
#if DBG
        dbg_before_phase(ph, (unsigned char*)d_ws, (float*)d_out, stream);
#endif
        hipLaunchKernelGGL(fwd, dim3(grid), dim3(NWAVES * 64), LDS_BYTES, stream, a);
#if DBG
        dbg_after_phase(ph, (unsigned char*)d_ws, (float*)d_out, stream); dbg_checks(ph, d_in, (unsigned char*)d_ws, (float*)d_out, stream);
#endif
    }
#if DBG
    hipLaunchKernelGGL(dbg_fill, dim3(1024), dim3(256), 0, stream, (float*)d_out, (size_t)S_ * D_, (const unsigned*)((unsigned char*)d_ws + WS_CTL) + CW_DBG, P_FINAL + 1);
#endif
#else
    a.use_bar = 1; a.ph_lo = 0; a.ph_hi = P_FINAL + 1;
    hipLaunchKernelGGL(fwd, dim3(grid), dim3(NWAVES * 64), LDS_BYTES, stream, a);
#ifdef PROBE_PH
    for (int i = 0; i < PROBE_N; ++i) { a.use_bar = 0; a.ph_lo = PROBE_PH; a.ph_hi = PROBE_PH + 1; hipLaunchKernelGGL(fwd, dim3(grid), dim3(NWAVES * 64), LDS_BYTES, stream, a); }
#endif
#endif
    const hipError_t le = hipPeekAtLastError();
    if (le != hipSuccess) fprintf(stderr, "kernel_launch: launch failed: %s\n", hipGetErrorName(le));
}
```

```cpp
#include <hip/hip_runtime.h>
#include <hip/hip_bf16.h>
#include <cstdio>
#include <cstdint>
#include <cmath>

constexpr int S_ = 16384, D_ = 1024, DEPTH_ = 4;
constexpr int EIN = 3072, OIN = 4096, OIN_SRC = 4112, DFF = 3584, NEXP = 8, PLE = 256;
constexpr int MOE_P = 2 * S_ + NEXP * 256;
constexpr int NCHUNK = S_ / 64, NUNIT = NCHUNK * 8;
constexpr float RMS_EPS = 1e-6f;

namespace pg8 {
#define PG8_LAS __attribute__((address_space(3)))
typedef unsigned short bf16_t;
typedef short bf16x8 __attribute__((ext_vector_type(8)));
typedef float f32x4 __attribute__((ext_vector_type(4)));
typedef float f32x2 __attribute__((ext_vector_type(2)));
typedef unsigned u32x4 __attribute__((ext_vector_type(4)));
typedef unsigned u32x2 __attribute__((ext_vector_type(2)));
constexpr int BM = 256, BK = 64, HALF = 128, HTB = HALF * BK * 2, STAGE_BYTES = 8 * HTB, NXCD = 8, WGM = 8;

__host__ __device__ __forceinline__ int lds_byte(int r, int c) { const int st = (r >> 4) * 2 + (c >> 5), rr = r & 15, cc = c & 31, ob = rr * 64 + cc * 2; return st * 1024 + (ob ^ (((ob >> 9) & 1) << 5)); }
__host__ __device__ __forceinline__ void stage_rc(int b, int& R, int& C) { const int st = b / 1024, sb = b % 1024, swz = sb ^ (((sb >> 9) & 1) << 5); R = (st >> 1) * 16 + swz / 64; C = (st & 1) * 32 + (swz % 64) / 2; }
__host__ __device__ __forceinline__ int perm32(int rho) { const int n = rho >> 4, i = rho & 15; return 8 * (i >> 2) + 4 * n + (i & 3); }

struct Unit { int pm, pn, be; };
struct Gemm { const bf16_t* A; const bf16_t* Bt; int M, N, K; size_t bstride; };

struct StaticOrder {
    int nM, nN, nwg, G, c;
    __host__ __device__ void init(int M, int N, int G_, int c_) { nM = M / BM; nN = N / BM; nwg = nM * nN; G = G_; c = c_; }
    __host__ __device__ bool next(int i, Unit& u) const {
        const long L = (long)i * G + c; if (L >= nwg) return false;
        int wgid = (int)L; { const int q = nwg / NXCD, r = nwg % NXCD, xcd = wgid % NXCD, off = wgid / NXCD; wgid = (xcd < r ? xcd * (q + 1) : r * (q + 1) + (xcd - r) * q) + off; }
        const int nig = WGM * nN, gid = wgid / nig, fm = gid * WGM, gsz = (nM - fm) < WGM ? (nM - fm) : WGM;
        u.pm = fm + ((wgid % nig) % gsz); u.pn = (wgid % nig) / gsz; u.be = 0; return true;
    }
    __device__ __forceinline__ void a_ready(const Unit&) const {}
    __device__ __forceinline__ void done(const Unit&) const {}
};
struct MoeOrder : StaticOrder {
    const PG8_LAS int* blk_e;
    __device__ __forceinline__ bool next(int i, Unit& u) const { if (!StaticOrder::next(i, u)) return false; u.be = blk_e[u.pm]; return true; }
};

__device__ __forceinline__ unsigned cvt_pk_bf16(float lo, float hi) { unsigned r; asm volatile("v_cvt_pk_bf16_f32 %0, %1, %2" : "=v"(r) : "v"(lo), "v"(hi)); return r; }
typedef __bf16 bf16x2_t_ __attribute__((ext_vector_type(2)));
__device__ __forceinline__ unsigned cvt_pk_bf16_cv(float lo, float hi) { const f32x2 v = {lo, hi}; const bf16x2_t_ b = __builtin_convertvector(v, bf16x2_t_); return __builtin_bit_cast(unsigned, b); }
__device__ __forceinline__ float bf_lo(unsigned w) { return __uint_as_float(w << 16); }
__device__ __forceinline__ float bf_hi(unsigned w) { return __uint_as_float(w & 0xffff0000u); }

__device__ __forceinline__ float rstd_row(const float* ssq, int row) {
    const f32x4* p = (const f32x4*)(ssq + (size_t)row * 16);
    const f32x4 a = p[0], b = p[1], c = p[2], d = p[3];
    const float s = (((a[0] + a[1]) + (a[2] + a[3])) + ((b[0] + b[1]) + (b[2] + b[3]))) + (((c[0] + c[1]) + (c[2] + c[3])) + ((d[0] + d[1]) + (d[2] + d[3])));
    return __builtin_amdgcn_rsqf(s * (1.0f / 1024.0f) + RMS_EPS);
}
__device__ __forceinline__ float sigmoidf_(float x) { return __builtin_amdgcn_rcpf(1.0f + __builtin_amdgcn_exp2f(-1.4426950408889634f * x)); }
__device__ __forceinline__ float siluf_(float x) { return x * sigmoidf_(x); }

constexpr float C2 = 0.125f * 1.4426950408889634f;

struct EpiProjEven {
    static constexpr bool PERM = true, AFTER_DRAIN = false;
    bf16_t* O; const float* ssq; const float* tab;
    __device__ __forceinline__ void operator()(const f32x4 (&acc)[2][2][4][2], const Unit& u, int wr, int wc, int fr, int fq) const {
        const int row0 = u.pm * BM + wr * 64 + fr, colt = u.pn * BM;
        const bool rot = (colt < 1024) && ((wc & 1) == 0);
        const float qs = (colt < 512) ? C2 : 1.0f;
#pragma unroll
        for (int ai = 0; ai < 2; ++ai)
#pragma unroll
            for (int m = 0; m < 4; ++m) {
                const int row = row0 + ai * HALF + m * 16; const float rs = rstd_row(ssq, row);
                f32x4 c0 = {1.f, 1.f, 1.f, 1.f}, c1 = c0, s0 = {0.f, 0.f, 0.f, 0.f}, s1 = s0;
                if (rot && fq < 2) { const f32x4* t = (const f32x4*)(tab + (size_t)row * 16); c0 = t[0]; c1 = t[1]; s0 = t[2]; s1 = t[3]; if (fq == 0) { s0 = -s0; s1 = -s1; } }
#pragma unroll
                for (int bj = 0; bj < 2; ++bj) {
                    f32x4 v0 = acc[ai][bj][m][0] * rs, v1 = acc[ai][bj][m][1] * rs;
                    if (rot) {
                        f32x4 p0, p1;
#pragma unroll
                        for (int i = 0; i < 4; ++i) { p0[i] = __shfl_xor(v0[i], 16); p1[i] = __shfl_xor(v1[i], 16); }
                        v0 = v0 * c0 + p0 * s0; v1 = v1 * c1 + p1 * s1;
                    }
                    v0 = v0 * qs; v1 = v1 * qs;
                    u32x4 w; w.x = cvt_pk_bf16(v0[0], v0[1]); w.y = cvt_pk_bf16(v0[2], v0[3]); w.z = cvt_pk_bf16(v1[0], v1[1]); w.w = cvt_pk_bf16(v1[2], v1[3]);
                    *(u32x4*)(O + (size_t)row * EIN + colt + bj * HALF + wc * 32 + 8 * fq) = w;
                }
                asm volatile("" ::: "memory");
            }
    }
};
struct EpiBf16 {
    static constexpr bool PERM = true, AFTER_DRAIN = false;
    bf16_t* O; int ldc; const float* ssq; float scale0; int scale_cols;
    __device__ __forceinline__ void operator()(const f32x4 (&acc)[2][2][4][2], const Unit& u, int wr, int wc, int fr, int fq) const {
        const int row0 = u.pm * BM + wr * 64 + fr, colt = u.pn * BM;
#pragma unroll
        for (int ai = 0; ai < 2; ++ai)
#pragma unroll
            for (int m = 0; m < 4; ++m) {
                const int row = row0 + ai * HALF + m * 16; const float rs = (ssq ? rstd_row(ssq, row) : 1.0f) * (colt < scale_cols ? scale0 : 1.0f);
#pragma unroll
                for (int bj = 0; bj < 2; ++bj) {
                    const f32x4 v0 = acc[ai][bj][m][0] * rs, v1 = acc[ai][bj][m][1] * rs;
                    u32x4 w; w.x = cvt_pk_bf16(v0[0], v0[1]); w.y = cvt_pk_bf16(v0[2], v0[3]); w.z = cvt_pk_bf16(v1[0], v1[1]); w.w = cvt_pk_bf16(v1[2], v1[3]);
                    *(u32x4*)(O + (size_t)row * ldc + colt + bj * HALF + wc * 32 + 8 * fq) = w;
                }
                if (m & 1) asm volatile("" ::: "memory");
            }
    }
};
struct EpiSwiglu {
    static constexpr bool PERM = true, AFTER_DRAIN = false;
    bf16_t* O; const float* ssq;
    __device__ __forceinline__ void operator()(const f32x4 (&acc)[2][2][4][2], const Unit& u, int wr, int wc, int fr, int fq) const {
        const int row0 = u.pm * BM + wr * 64 + fr, col = u.pn * HALF + wc * 32 + 8 * fq;
#pragma unroll
        for (int ai = 0; ai < 2; ++ai)
#pragma unroll
            for (int m = 0; m < 4; ++m) {
                const int row = row0 + ai * HALF + m * 16; const float rs = ssq ? rstd_row(ssq, row) : 1.0f;
                float o[8];
#pragma unroll
                for (int n = 0; n < 2; ++n)
#pragma unroll
                    for (int i = 0; i < 4; ++i) { const float a = acc[ai][0][m][n][i] * rs, b = acc[ai][1][m][n][i] * rs; o[4 * n + i] = siluf_(a) * b; }
                u32x4 w; w.x = cvt_pk_bf16(o[0], o[1]); w.y = cvt_pk_bf16(o[2], o[3]); w.z = cvt_pk_bf16(o[4], o[5]); w.w = cvt_pk_bf16(o[6], o[7]);
                *(u32x4*)(O + (size_t)row * DFF + col) = w;
                if (m & 1) asm volatile("" ::: "memory");
            }
    }
};
struct EpiResid {
    static constexpr bool PERM = true, AFTER_DRAIN = false;
    float* h; bf16_t* hb; float* ssq;
    __device__ __forceinline__ void operator()(const f32x4 (&acc)[2][2][4][2], const Unit& u, int wr, int wc, int fr, int fq) const {
        const int row0 = u.pm * BM + wr * 64 + fr, colt = u.pn * BM;
#pragma unroll
        for (int ai = 0; ai < 2; ++ai)
#pragma unroll
            for (int m = 0; m < 4; ++m) {
                const int row = row0 + ai * HALF + m * 16; float ss = 0.f;
#pragma unroll
                for (int bj = 0; bj < 2; ++bj) {
                    const size_t off = (size_t)row * D_ + colt + bj * HALF + wc * 32 + 8 * fq;
                    f32x4 x0 = *(const f32x4*)(h + off), x1 = *(const f32x4*)(h + off + 4);
                    x0 = x0 + acc[ai][bj][m][0]; x1 = x1 + acc[ai][bj][m][1];
                    *(f32x4*)(h + off) = x0; *(f32x4*)(h + off + 4) = x1;
                    ss += (x0[0] * x0[0] + x0[1] * x0[1]) + (x0[2] * x0[2] + x0[3] * x0[3]) + (x1[0] * x1[0] + x1[1] * x1[1]) + (x1[2] * x1[2] + x1[3] * x1[3]);
                    u32x4 w; w.x = cvt_pk_bf16(x0[0], x0[1]); w.y = cvt_pk_bf16(x0[2], x0[3]); w.z = cvt_pk_bf16(x1[0], x1[1]); w.w = cvt_pk_bf16(x1[2], x1[3]);
                    *(u32x4*)(hb + off) = w;
                }
                ss += __shfl_xor(ss, 16); ss += __shfl_xor(ss, 32);
                if (fq == 0) ssq[(size_t)row * 16 + u.pn * 4 + wc] = ss;
                asm volatile("" ::: "memory");
            }
    }
};
struct EpiPle {
    static constexpr bool PERM = true, AFTER_DRAIN = false;
    float* h; bf16_t* hb; const float* ssq_in; float* ssq_out; const bf16_t* pp;
    __device__ __forceinline__ void operator()(const f32x4 (&acc)[2][2][4][2], const Unit& u, int wr, int wc, int fr, int fq) const {
        const int row0 = u.pm * BM + wr * 64 + fr, colt = u.pn * BM;
#pragma unroll
        for (int ai = 0; ai < 2; ++ai)
#pragma unroll
            for (int m = 0; m < 4; ++m) {
                const int row = row0 + ai * HALF + m * 16; const float rs = rstd_row(ssq_in, row); float ss = 0.f;
#pragma unroll
                for (int bj = 0; bj < 2; ++bj) {
                    const size_t off = (size_t)row * D_ + colt + bj * HALF + wc * 32 + 8 * fq;
                    f32x4 x0 = *(const f32x4*)(h + off), x1 = *(const f32x4*)(h + off + 4);
                    const u32x4 pw = *(const u32x4*)(pp + off);
                    const f32x4 a0 = acc[ai][bj][m][0] * rs, a1 = acc[ai][bj][m][1] * rs;
                    x0[0] += sigmoidf_(a0[0]) * bf_lo(pw.x); x0[1] += sigmoidf_(a0[1]) * bf_hi(pw.x); x0[2] += sigmoidf_(a0[2]) * bf_lo(pw.y); x0[3] += sigmoidf_(a0[3]) * bf_hi(pw.y);
                    x1[0] += sigmoidf_(a1[0]) * bf_lo(pw.z); x1[1] += sigmoidf_(a1[1]) * bf_hi(pw.z); x1[2] += sigmoidf_(a1[2]) * bf_lo(pw.w); x1[3] += sigmoidf_(a1[3]) * bf_hi(pw.w);
                    *(f32x4*)(h + off) = x0; *(f32x4*)(h + off + 4) = x1;
                    ss += (x0[0] * x0[0] + x0[1] * x0[1]) + (x0[2] * x0[2] + x0[3] * x0[3]) + (x1[0] * x1[0] + x1[1] * x1[1]) + (x1[2] * x1[2] + x1[3] * x1[3]);
                    u32x4 w; w.x = cvt_pk_bf16(x0[0], x0[1]); w.y = cvt_pk_bf16(x0[2], x0[3]); w.z = cvt_pk_bf16(x1[0], x1[1]); w.w = cvt_pk_bf16(x1[2], x1[3]);
                    *(u32x4*)(hb + off) = w;
                }
                ss += __shfl_xor(ss, 16); ss += __shfl_xor(ss, 32);
                if (fq == 0) ssq_out[(size_t)row * 16 + u.pn * 4 + wc] = ss;
                asm volatile("" ::: "memory");
            }
    }
};
struct EpiMoeDown {
    static constexpr bool PERM = true, AFTER_DRAIN = false;
    bf16_t* Y; const float* gate;
    __device__ __forceinline__ void operator()(const f32x4 (&acc)[2][2][4][2], const Unit& u, int wr, int wc, int fr, int fq) const {
        const int row0 = u.pm * BM + wr * 64 + fr, colt = u.pn * BM;
#pragma unroll
        for (int ai = 0; ai < 2; ++ai)
#pragma unroll
            for (int m = 0; m < 4; ++m) {
                const int row = row0 + ai * HALF + m * 16; const float gt = gate[row];
#pragma unroll
                for (int bj = 0; bj < 2; ++bj) {
                    const f32x4 v0 = acc[ai][bj][m][0] * gt, v1 = acc[ai][bj][m][1] * gt;
                    u32x4 w; w.x = cvt_pk_bf16(v0[0], v0[1]); w.y = cvt_pk_bf16(v0[2], v0[3]); w.z = cvt_pk_bf16(v1[0], v1[1]); w.w = cvt_pk_bf16(v1[2], v1[3]);
                    *(u32x4*)(Y + (size_t)row * D_ + colt + bj * HALF + wc * 32 + 8 * fq) = w;
                }
                if (m & 1) asm volatile("" ::: "memory");
            }
    }
};

template <class Epi, class Sched, bool ALIGN_EPI = false, bool SP2 = false>
__device__ __forceinline__ void gemm_phase(PG8_LAS unsigned char* lds, const Gemm g, const Sched& S, const Epi& E) {
    int tid_ = threadIdx.x; asm volatile("" : "+v"(tid_));
    const int tid = tid_, wid = __builtin_amdgcn_readfirstlane(tid >> 6), lane = tid & 63, wr = wid >> 2, wc = wid & 3, fr = lane & 15, fq = lane >> 4;
    const int K = g.K, nt = K / BK;
    unsigned voffA[2], voffB[2];
#pragma unroll
    for (int i = 0; i < 2; ++i) { int R, C; stage_rc(tid * 16 + i * 8192, R, C); const int Rb = Epi::PERM ? ((R & ~31) + perm32(R & 31)) : R;
        voffA[i] = (unsigned)(R * K + C) * 2u; voffB[i] = (unsigned)(Rb * K + C) * 2u; }
    const size_t kstep = (size_t)(BK * 2);
    const size_t hstep = (size_t)HALF * K * 2;
    const size_t tstep = 2 * hstep;
    const unsigned ldsw = (unsigned)wid * 1024u;
    const int aoff = lds_byte(wr * 64 + fr, fq * 8), boff = lds_byte(wc * 32 + fr, fq * 8);
#define PG8_SA(b, h) (((b) * 2 + (h)) * HTB)
#define PG8_SB(b, h) ((4 + (b) * 2 + (h)) * HTB)
#define PG8_STAGE(bufoff, gbase, voff) do { _Pragma("unroll") for (int _i = 0; _i < 2; ++_i) \
        __builtin_amdgcn_global_load_lds((const unsigned*)((const char*)(gbase) + (voff)[_i]), (PG8_LAS unsigned*)(lds + (bufoff) + ldsw + _i * 8192), 16, 0, 0); } while (0)
#define PG8_LDA(dst, b, h) do { _Pragma("unroll") for (int m = 0; m < 4; ++m) _Pragma("unroll") for (int k = 0; k < 2; ++k) dst[m][k] = *(const PG8_LAS bf16x8*)(lds + PG8_SA(b, h) + aoff + m * 2048 + k * 1024); } while (0)
#define PG8_LDB(dst, b, h) do { _Pragma("unroll") for (int n = 0; n < 2; ++n) _Pragma("unroll") for (int k = 0; k < 2; ++k) dst[n][k] = *(const PG8_LAS bf16x8*)(lds + PG8_SB(b, h) + boff + n * 2048 + k * 1024); } while (0)
#define PG8_MMA(ai, bj, At, Bt) do { __builtin_amdgcn_s_setprio(1); _Pragma("unroll") for (int m = 0; m < 4; ++m) _Pragma("unroll") for (int n = 0; n < 2; ++n) _Pragma("unroll") for (int k = 0; k < 2; ++k) \
        acc[ai][bj][m][n] = __builtin_amdgcn_mfma_f32_16x16x32_bf16(Bt[n][k], At[m][k], acc[ai][bj][m][n], 0, 0, 0); __builtin_amdgcn_s_setprio(0); } while (0)
#define PG8_WAIT_V(n) asm volatile("s_waitcnt vmcnt(" #n ")" ::: "memory")
#define PG8_WAIT_L(n) asm volatile("s_waitcnt lgkmcnt(" #n ")" ::: "memory")
#define PG8_BAR __builtin_amdgcn_s_barrier()
#define PG8_SCHED __builtin_amdgcn_sched_barrier(0)
    Unit cur, nxt; int ui = 0;
    if (!S.next(0, cur)) return;
    f32x4 acc[2][2][4][2];
#pragma unroll
    for (int a = 0; a < 2; ++a)
#pragma unroll
        for (int b = 0; b < 2; ++b)
#pragma unroll
            for (int m = 0; m < 4; ++m)
#pragma unroll
                for (int n = 0; n < 2; ++n) acc[a][b][m][n] = (f32x4){0.f, 0.f, 0.f, 0.f};
    bf16x8 At[4][2], B0[2][2], B1[2][2];
    const char* cA = (const char*)g.A + (size_t)cur.pm * tstep; const char* cB = (const char*)g.Bt + (size_t)cur.pn * tstep + (size_t)cur.be * g.bstride;
    S.a_ready(cur);
    if constexpr (SP2) {
        PG8_STAGE(PG8_SB(0, 0), cB, voffB); PG8_STAGE(PG8_SB(0, 1), cB + hstep, voffB); PG8_STAGE(PG8_SA(0, 0), cA, voffA); PG8_STAGE(PG8_SA(0, 1), cA + hstep, voffA);
        if (wr == 1) PG8_BAR;
        PG8_WAIT_V(2); PG8_BAR;
        PG8_STAGE(PG8_SB(1, 0), cB + kstep, voffB); PG8_STAGE(PG8_SA(1, 0), cA + kstep, voffA); PG8_STAGE(PG8_SB(1, 1), cB + hstep + kstep, voffB);
        PG8_WAIT_V(6); PG8_BAR;
    } else {
        PG8_STAGE(PG8_SB(0, 0), cB, voffB); PG8_STAGE(PG8_SA(0, 0), cA, voffA); PG8_STAGE(PG8_SB(0, 1), cB + hstep, voffB); PG8_STAGE(PG8_SA(0, 1), cA + hstep, voffA);
        if (wr == 1) PG8_BAR;
        PG8_WAIT_V(4); PG8_BAR;
        PG8_STAGE(PG8_SB(1, 0), cB + kstep, voffB); PG8_STAGE(PG8_SA(1, 0), cA + kstep, voffA); PG8_STAGE(PG8_SB(1, 1), cB + hstep + kstep, voffB);
        PG8_WAIT_V(6); PG8_BAR;
    }
    for (;;) {
        const bool has_next = S.next(ui + 1, nxt);
        const char* nA = has_next ? (const char*)g.A + (size_t)nxt.pm * tstep : cA; const char* nB = has_next ? (const char*)g.Bt + (size_t)nxt.pn * tstep + (size_t)nxt.be * g.bstride : cB;
        for (int t = 0; t < nt; t += 2) {
            const bool last = (t == nt - 2);
            const char* a1 = cA + (size_t)(t + 1) * kstep;
            const char* a2 = last ? nA : cA + (size_t)(t + 2) * kstep; const char* b2 = last ? nB : cB + (size_t)(t + 2) * kstep;
            const char* a3 = a2 + kstep; const char* b3 = b2 + kstep;
            if (last && has_next) S.a_ready(nxt);
            if constexpr (SP2) {
            PG8_LDB(B0, 0, 0); PG8_LDB(B1, 0, 1); PG8_SCHED; PG8_LDA(At, 0, 0); PG8_STAGE(PG8_SA(1, 1), a1 + hstep, voffA);
            PG8_WAIT_V(8); PG8_WAIT_L(0); PG8_BAR; PG8_MMA(0, 0, At, B0); PG8_MMA(0, 1, At, B1); PG8_BAR; PG8_SCHED;
            PG8_LDA(At, 0, 1); PG8_STAGE(PG8_SB(0, 0), b2, voffB); PG8_STAGE(PG8_SB(0, 1), b2 + hstep, voffB); PG8_STAGE(PG8_SA(0, 0), a2, voffA);
            PG8_WAIT_V(8); PG8_WAIT_L(0); PG8_BAR; PG8_MMA(1, 0, At, B0); PG8_MMA(1, 1, At, B1); PG8_BAR; PG8_SCHED;
            PG8_LDB(B0, 1, 0); PG8_LDB(B1, 1, 1); PG8_SCHED; PG8_LDA(At, 1, 0); PG8_STAGE(PG8_SA(0, 1), a2 + hstep, voffA);
            PG8_WAIT_V(8); PG8_WAIT_L(0); PG8_BAR; PG8_MMA(0, 0, At, B0); PG8_MMA(0, 1, At, B1); PG8_BAR; PG8_SCHED;
            PG8_LDA(At, 1, 1); PG8_STAGE(PG8_SB(1, 0), b3, voffB); PG8_STAGE(PG8_SB(1, 1), b3 + hstep, voffB); PG8_STAGE(PG8_SA(1, 0), a3, voffA);
            PG8_WAIT_V(8); PG8_WAIT_L(0); PG8_BAR; PG8_MMA(1, 0, At, B0); PG8_MMA(1, 1, At, B1); PG8_BAR; PG8_SCHED;
            } else {
            PG8_LDB(B0, 0, 0); PG8_SCHED; PG8_LDA(At, 0, 0); PG8_STAGE(PG8_SA(1, 1), a1 + hstep, voffA);
            PG8_WAIT_L(8); PG8_BAR; PG8_WAIT_L(0); PG8_MMA(0, 0, At, B0); PG8_BAR; PG8_SCHED;
            PG8_LDB(B1, 0, 1); PG8_STAGE(PG8_SB(0, 0), b2, voffB);
            PG8_BAR; PG8_WAIT_L(0); PG8_MMA(0, 1, At, B1); PG8_BAR;
            PG8_LDA(At, 0, 1); PG8_STAGE(PG8_SA(0, 0), a2, voffA);
            PG8_BAR; PG8_WAIT_L(0); PG8_MMA(1, 0, At, B0); PG8_BAR; PG8_SCHED;
            PG8_STAGE(PG8_SB(0, 1), b2 + hstep, voffB);
            PG8_WAIT_V(6); PG8_BAR; PG8_MMA(1, 1, At, B1); PG8_BAR;
            PG8_LDB(B0, 1, 0); PG8_SCHED; PG8_LDA(At, 1, 0); PG8_STAGE(PG8_SA(0, 1), a2 + hstep, voffA);
            PG8_WAIT_L(8); PG8_BAR; PG8_WAIT_L(0); PG8_MMA(0, 0, At, B0); PG8_BAR; PG8_SCHED;
            PG8_LDB(B1, 1, 1); PG8_STAGE(PG8_SB(1, 0), b3, voffB);
            PG8_BAR; PG8_WAIT_L(0); PG8_MMA(0, 1, At, B1); PG8_BAR;
            PG8_LDA(At, 1, 1); PG8_STAGE(PG8_SA(1, 0), a3, voffA);
            PG8_BAR; PG8_WAIT_L(0); PG8_MMA(1, 0, At, B0); PG8_BAR; PG8_SCHED;
            PG8_STAGE(PG8_SB(1, 1), b3 + hstep, voffB);
            PG8_WAIT_V(6); PG8_BAR; PG8_MMA(1, 1, At, B1); PG8_BAR;
            }
        }
        if constexpr (ALIGN_EPI) { if (wr == 0) PG8_BAR; }
        if constexpr (!Epi::AFTER_DRAIN) { E(acc, cur, wr, wc, fr, fq); S.done(cur); }
        if (!has_next) break;
#pragma unroll
        for (int a = 0; a < 2; ++a)
#pragma unroll
            for (int b = 0; b < 2; ++b)
#pragma unroll
                for (int m = 0; m < 4; ++m)
#pragma unroll
                    for (int n = 0; n < 2; ++n) acc[a][b][m][n] = (f32x4){0.f, 0.f, 0.f, 0.f};
        cur = nxt; cA = nA; cB = nB; ++ui;
        if constexpr (ALIGN_EPI) { if (wr == 1) PG8_BAR; }
    }
    PG8_WAIT_V(0);
    if constexpr (!ALIGN_EPI) { if (wr == 0) PG8_BAR; }
    PG8_BAR;
    if constexpr (Epi::AFTER_DRAIN) { E.fused(acc, cur, wr, wc, fr, fq, lds, wid, lane); S.done(cur); }
#undef PG8_SA
#undef PG8_SB
#undef PG8_STAGE
#undef PG8_LDA
#undef PG8_LDB
#undef PG8_MMA
#undef PG8_WAIT_V
#undef PG8_WAIT_L
#undef PG8_BAR
#undef PG8_SCHED
}
}

#include <hip/hip_bf16.h>
#include <cmath>
namespace attn_body {
using bf16=__hip_bfloat16;
using bf16x8=__attribute__((ext_vector_type(8)))short;
using s16x4=__attribute__((ext_vector_type(4)))short;
using f32x16=__attribute__((ext_vector_type(16)))float;
using u32x4=__attribute__((ext_vector_type(4)))unsigned;
constexpr int SEQ=16384,D=64,LDP=3072,LDO=1024;
constexpr int NW=8,QBLK=32,QB=QBLK*NW,KVBLK=64,NQB=SEQ/QB;
constexpr int ATTN_UNIT_ROWS=QB;
__device__ __forceinline__ int crow(int r,int hi){return (r&3)+8*(r>>2)+4*hi;}
#define SBAR() __builtin_amdgcn_sched_barrier(0)
__device__ __forceinline__ void cmask(f32x16&p0,f32x16&p1,int jb,int qrel,int hi){
  const float NEG=-INFINITY; int kb=64*jb+4*hi;
  #pragma unroll
  for(int r=0;r<16;++r){int kv=kb+(r&3)+8*(r>>2); if(kv>qrel)p0[r]=NEG; if(kv+32>qrel)p1[r]=NEG;}
}

constexpr int NSLOT=3, SLOTB=8192;
constexpr int LDS_K=0, LDS_V=NSLOT*SLOTB, LDS_WS=2*NSLOT*SLOTB, LDS_OST=LDS_WS+NW*64*4, LDS_BYTES=LDS_OST+NW*4096;
constexpr float C2=0.125f*1.4426950408889634f;
__device__ __forceinline__ void glds16(const void*gsrc,unsigned lds_dst){unsigned keep;
  asm volatile("s_mov_b32 %0, m0\n\ts_mov_b32 m0, %2\n\ts_nop 0\n\tglobal_load_lds_dwordx4 %1, off\n\ts_mov_b32 m0, %0":"=&s"(keep):"v"(gsrc),"s"(lds_dst):"memory");}
__device__ __forceinline__ float max3f(float a,float b,float c){float r;asm("v_max3_f32 %0, %1, %2, %3":"=v"(r):"v"(a),"v"(b),"v"(c));return r;}
__device__ __forceinline__ float max2f(float a,float b){float r;asm("v_max_f32_e32 %0, %1, %2":"=v"(r):"v"(a),"v"(b));return r;}
__device__ __forceinline__ float fadd_s(float a,float b){float r;asm("v_add_f32_e32 %0, %1, %2":"=v"(r):"v"(a),"v"(b));return r;}
__device__ __forceinline__ float fsub_s(float a,float b){float r;asm("v_sub_f32_e32 %0, %1, %2":"=v"(r):"v"(a),"v"(b));return r;}
typedef float f32x2_t __attribute__((ext_vector_type(2))); typedef __bf16 bf16x2_t __attribute__((ext_vector_type(2)));
__device__ __forceinline__ unsigned cvtpk_s(float lo,float hi){f32x2_t v={lo,hi};bf16x2_t b=__builtin_convertvector(v,bf16x2_t);return __builtin_bit_cast(unsigned,b);}
#define WAIT_BAR(N) asm volatile("s_waitcnt vmcnt(" #N ") lgkmcnt(0)\n\ts_barrier":::"memory")

__device__ __forceinline__ void qkt(f32x16&p0,f32x16&p1,const char*Kslot,const bf16x8*qr,int r32,int hi){
  const char*kb=Kslot+hi*1024+r32*16;
  #pragma unroll
  for(int d0=0;d0<4;++d0){
    const bf16x8 b0=*reinterpret_cast<const bf16x8*>(kb+d0*2048);
    const bf16x8 b1=*reinterpret_cast<const bf16x8*>(kb+d0*2048+512);
    if(d0==0){p0=__builtin_amdgcn_mfma_f32_32x32x16_bf16(b0,qr[0],f32x16{},0,0,0);p1=__builtin_amdgcn_mfma_f32_32x32x16_bf16(b1,qr[0],f32x16{},0,0,0);}
    else{p0=__builtin_amdgcn_mfma_f32_32x32x16_bf16(b0,qr[d0],p0,0,0,0);p1=__builtin_amdgcn_mfma_f32_32x32x16_bf16(b1,qr[d0],p1,0,0,0);}}
}
typedef __attribute__((address_space(3))) const char* lds_cptr;
typedef short v4i16_t __attribute__((ext_vector_type(4)));
__device__ __forceinline__ void kload8(bf16x8*kf,lds_cptr kp){
  kf[0]=*(const __attribute__((address_space(3))) bf16x8*)(kp);      kf[1]=*(const __attribute__((address_space(3))) bf16x8*)(kp+512);
  kf[2]=*(const __attribute__((address_space(3))) bf16x8*)(kp+2048); kf[3]=*(const __attribute__((address_space(3))) bf16x8*)(kp+2560);
  kf[4]=*(const __attribute__((address_space(3))) bf16x8*)(kp+4096); kf[5]=*(const __attribute__((address_space(3))) bf16x8*)(kp+4608);
  kf[6]=*(const __attribute__((address_space(3))) bf16x8*)(kp+6144); kf[7]=*(const __attribute__((address_space(3))) bf16x8*)(kp+6656);
}
__device__ __forceinline__ void kload2(bf16x8*kf,lds_cptr kp,int j){ kf[2*j]=*(const __attribute__((address_space(3))) bf16x8*)(kp+j*2048); kf[2*j+1]=*(const __attribute__((address_space(3))) bf16x8*)(kp+j*2048+512); }
__device__ __forceinline__ s16x4 vtr(lds_cptr p){ return __builtin_bit_cast(s16x4,__builtin_amdgcn_ds_read_tr16_b64_v4i16((__attribute__((address_space(3))) v4i16_t*)p)); }
__device__ __forceinline__ float rowmax(const f32x16&p0,const f32x16&p1){
  float a=max3f(p0[0],p0[1],p1[0]),b=max3f(p0[2],p0[3],p1[1]);a=max3f(a,p1[2],p1[3]);
  #pragma unroll
  for(int r=4;r<16;r+=4){a=max3f(a,p0[r],p0[r+1]);b=max3f(b,p0[r+2],p0[r+3]);a=max3f(a,p1[r],p1[r+1]);b=max3f(b,p1[r+2],p1[r+3]);}
  const float m=max2f(a,b);
  auto rr=__builtin_amdgcn_permlane32_swap(__float_as_uint(m),__float_as_uint(m),false,false);
  return max2f(__uint_as_float(rr[0]),__uint_as_float(rr[1]));
}
__device__ __forceinline__ void pv(f32x16*o,int vb,bf16x8 pa0,bf16x8 pa1,bf16x8 pa2,bf16x8 pa3){
  #pragma unroll
  for(int d0=0;d0<2;++d0){s16x4 lo[4],hi[4];
    #pragma unroll
    for(int ks=0;ks<4;++ks){
      asm volatile("ds_read_b64_tr_b16 %0,%1 offset:%c2":"=&v"(lo[ks]):"v"(vb),"i"(d0*4096+ks*1024):"memory");
      asm volatile("ds_read_b64_tr_b16 %0,%1 offset:%c2":"=&v"(hi[ks]):"v"(vb),"i"(d0*4096+ks*1024+512):"memory");}
    asm volatile("s_waitcnt lgkmcnt(0)":::"memory");SBAR();
    #define PK(k) (bf16x8){lo[k][0],lo[k][1],lo[k][2],lo[k][3],hi[k][0],hi[k][1],hi[k][2],hi[k][3]}
    o[d0]=__builtin_amdgcn_mfma_f32_32x32x16_bf16(pa0,PK(0),o[d0],0,0,0);
    o[d0]=__builtin_amdgcn_mfma_f32_32x32x16_bf16(pa1,PK(1),o[d0],0,0,0);
    o[d0]=__builtin_amdgcn_mfma_f32_32x32x16_bf16(pa2,PK(2),o[d0],0,0,0);
    o[d0]=__builtin_amdgcn_mfma_f32_32x32x16_bf16(pa3,PK(3),o[d0],0,0,0);
    #undef PK
  }
}

#ifndef ATTN_STORE16
#define ATTN_STORE16(p,v) (*(u32x4*)(p)=(v))
#endif
template<int THRL> __device__ __forceinline__ void attn_unit(int qb,const bf16*Qh,const bf16*__restrict__ Kh,const bf16*__restrict__ Vh,bf16*Oh,char*shm){
  const int tid=threadIdx.x,lane=tid&63,r32=lane&31,hi=lane>>5; const int wid=__builtin_amdgcn_readfirstlane(tid>>6);
  const int q0=qb*QB;
  const bf16*Qw=Qh+(long)(q0+wid*QBLK)*LDP;
  const unsigned lds0=(unsigned)(uintptr_t)shm;
  float*wsf=(float*)(shm+LDS_WS)+wid*64;
  const bf16*ksrc=Kh+(long)lane*LDP+wid*8;
  const bf16*vsrc=Vh+(long)(16*(wid&3)+(lane>>2))*LDP+(wid>>2)*32+(lane&3)*8;
  const unsigned kdst=lds0+LDS_K+wid*1024, vdst=lds0+LDS_V+wid*1024;
  #define DMA_K(t,slot) glds16(ksrc+(long)(t)*KVBLK*LDP,(unsigned)__builtin_amdgcn_readfirstlane(kdst+(slot)))
  #define DMA_V(t,slot) glds16(vsrc+(long)(t)*KVBLK*LDP,(unsigned)__builtin_amdgcn_readfirstlane(vdst+(slot)))
  const int vb0=(int)(lds0+LDS_V)+((lane>>4)&1)*32+(lane&3)*8+(4*hi+((lane&15)>>2))*64;
  const char*Kbase=shm+LDS_K; bf16x8 kf[8];
  const lds_cptr shm3=(lds_cptr)shm; const lds_cptr kp0=shm3+LDS_K+hi*1024+r32*16; const lds_cptr vp0=shm3+LDS_V+((lane>>4)&1)*32+(lane&3)*8+(4*hi+((lane&15)>>2))*64;
  const int NT=(q0+QB)/KVBLK;
  DMA_K(0,0);DMA_V(0,0);DMA_K(1,SLOTB);
  bf16x8 qr[4];
  #pragma unroll
  for(int d0=0;d0<4;++d0)qr[d0]=*reinterpret_cast<const bf16x8*>(&Qw[(long)r32*LDP+d0*16+hi*8]);
  float mhat=0.f,l_reg=0.f;f32x16 o[2];o[0]=f32x16{};o[1]=f32x16{};
  const int qrel=wid*QBLK+r32;
  #define CMASK(P0,P1,t) do{int jb_=(t)-(NT-4); if(jb_>=0)cmask(P0,P1,jb_,qrel,hi);}while(0)
  bool resc=false;
  #define START(P0,P1) do{ const float rm=rowmax(P0,P1); resc=false; mhat=rm; \
    _Pragma("unroll") for(int r=0;r<16;++r)P0[r]=__builtin_amdgcn_exp2f(fsub_s(P0[r],mhat)); }while(0)
  #define RESC() do{ if(resc){ asm volatile("s_waitcnt lgkmcnt(0)":::"memory"); \
      _Pragma("unroll") for(int d_=0;d_<2;++d_) _Pragma("unroll") for(int r=0;r<16;++r)o[d_][r]*=wsf[crow(r,hi)]; } }while(0)
  f32x16 pA0,pA1,pB0,pB1;
  int sl_prev=0,sl_cur=0,sl_next=SLOTB;
  #define ROT() do{sl_prev=sl_cur;sl_cur=sl_next;sl_next=(sl_next==(NSLOT-1)*SLOTB)?0:sl_next+SLOTB;}while(0)
  DMA_K(2,2*SLOTB);
  WAIT_BAR(3);
  qkt(pA0,pA1,Kbase,qr,r32,hi);asm volatile("s_nop 15\n\ts_nop 7":"+v"(pA0),"+v"(pA1));CMASK(pA0,pA1,0);
  START(pA0,pA1);
  _Pragma("unroll") for(int r=0;r<16;++r)pA1[r]=__builtin_amdgcn_exp2f(pA1[r]-mhat);
  WAIT_BAR(0);
  DMA_K(3,0);DMA_V(1,SLOTB);
  ROT();
  kload8(kf,kp0+sl_cur);
  WAIT_BAR(2);
  s16x4 vlo[8],vhi[8]; u32x4 pw0,pw1,pw2,pw3;
  #define PKW(P,B) cvtpk_s(P[B],P[B+1])
  #define PAF(k) __builtin_bit_cast(bf16x8,pw##k)
  #define VFR(i) (bf16x8){vlo[i][0],vlo[i][1],vlo[i][2],vlo[i][3],vhi[i][0],vhi[i][1],vhi[i][2],vhi[i][3]}
  #define PIN(x) asm volatile("":"+v"(x))
  #define MX3(a,b,c) __builtin_fmaxf(__builtin_fmaxf((a),(b)),(c))
  #define GAPA(MF,A0,A1,A2,A3,W0,W1,PW) do{ MF; sacc+=A0; sacc+=A1; sacc+=A2; sacc+=A3; PIN(sacc); W0; W1; PIN(PW); SBAR(); }while(0)
  #define EX(v) __builtin_amdgcn_exp2f(v)
  #define GAPB(MF,X,B) do{ MF; X[B]=EX(X[B]-mhat); X[B+1]=EX(X[B+1]-mhat); X[B+2]=EX(X[B+2]-mhat); X[B+3]=EX(X[B+3]-mhat); PIN(X); SBAR(); }while(0)
  #define VRD(i) do{ vlo[i]=vtr(vp_+(((i)>>2)*4096+((i)&3)*1024)); vhi[i]=vtr(vp_+(((i)>>2)*4096+((i)&3)*1024+512)); }while(0)
  #define KRD(G,j) do{ if(G){ kload2(kf,kp0+sl_next,j); SBAR(); } }while(0)
  #define STEP(C0,C1,P0,P1,t,GK,GV,GL) do{ SBAR(); \
    const lds_cptr vp_=vp0+sl_prev; \
    VRD(0); SBAR(); float sacc=(P0[0]+P0[1]); \
    GAPA(C0=__builtin_amdgcn_mfma_f32_32x32x16_bf16(kf[0],qr[0],f32x16{},0,0,0), P0[2],P0[3],P0[4],P0[5],     pw0[0]=PKW(P0,0), pw0[1]=PKW(P0,2), pw0); \
    VRD(4); SBAR(); GAPA(C1=__builtin_amdgcn_mfma_f32_32x32x16_bf16(kf[1],qr[0],f32x16{},0,0,0), P0[6],P0[7],P0[8],P0[9],     pw0[2]=PKW(P0,4), pw0[3]=PKW(P0,6), pw0); \
    VRD(1); SBAR(); GAPA(C0=__builtin_amdgcn_mfma_f32_32x32x16_bf16(kf[2],qr[1],C0,0,0,0),   P0[10],P0[11],P0[12],P0[13], pw1[0]=PKW(P0,8), pw1[1]=PKW(P0,10), pw1); \
    VRD(5); SBAR(); GAPA(C1=__builtin_amdgcn_mfma_f32_32x32x16_bf16(kf[3],qr[1],C1,0,0,0),   P0[14],P0[15],P1[0],P1[1],   pw1[2]=PKW(P0,12),pw1[3]=PKW(P0,14), pw1); \
    VRD(2); SBAR(); GAPA(C0=__builtin_amdgcn_mfma_f32_32x32x16_bf16(kf[4],qr[2],C0,0,0,0),   P1[2],P1[3],P1[4],P1[5],     pw2[0]=PKW(P1,0), pw2[1]=PKW(P1,2), pw2); \
    VRD(6); SBAR(); GAPA(C1=__builtin_amdgcn_mfma_f32_32x32x16_bf16(kf[5],qr[2],C1,0,0,0),   P1[6],P1[7],P1[8],P1[9],     pw2[2]=PKW(P1,4), pw2[3]=PKW(P1,6), pw2); \
    VRD(3); SBAR(); GAPA(C0=__builtin_amdgcn_mfma_f32_32x32x16_bf16(kf[6],qr[3],C0,0,0,0),   P1[10],P1[11],P1[12],P1[13], pw3[0]=PKW(P1,8), pw3[1]=PKW(P1,10), pw3); \
    VRD(7); SBAR(); GAPA(C1=__builtin_amdgcn_mfma_f32_32x32x16_bf16(kf[7],qr[3],C1,0,0,0),   P1[14],P1[15],0.f,0.f,       pw3[2]=PKW(P1,12),pw3[3]=PKW(P1,14), pw3); \
    l_reg+=sacc; \
    if(GK){DMA_K((t)+3,sl_cur);} if(GV){DMA_V((t)+1,sl_next);} \
    CMASK(C0,C1,t); \
    { float a=MX3(C0[0],C0[1],C1[0]),b=MX3(C0[2],C0[3],C1[1]); a=MX3(a,C1[2],C1[3]); \
      _Pragma("unroll") for(int r=4;r<16;r+=4){a=MX3(a,C0[r],C0[r+1]);b=MX3(b,C0[r+2],C0[r+3]);a=MX3(a,C1[r],C1[r+1]);b=MX3(b,C1[r+2],C1[r+3]);} \
      float rm=__builtin_fmaxf(a,b); { auto rr=__builtin_amdgcn_permlane32_swap(__float_as_uint(rm),__float_as_uint(rm),false,false); rm=__builtin_fmaxf(__uint_as_float(rr[0]),__uint_as_float(rr[1])); } \
      resc=false; const float rel=rm-mhat; \
      if(__builtin_expect(__any(rel>(float)THRL),0)){ const float dl=__builtin_fmaxf(rel,0.f); mhat+=dl; \
        const float f=__builtin_amdgcn_exp2f(-dl); l_reg*=f; if(hi==0)wsf[r32]=f; resc=true; } } \
    SBAR(); \
    GAPB(o[0]=__builtin_amdgcn_mfma_f32_32x32x16_bf16(PAF(0),VFR(0),o[0],0,0,0), C0,0); \
    GAPB(o[1]=__builtin_amdgcn_mfma_f32_32x32x16_bf16(PAF(0),VFR(4),o[1],0,0,0), C0,4); \
    KRD(GL,0); GAPB(o[0]=__builtin_amdgcn_mfma_f32_32x32x16_bf16(PAF(1),VFR(1),o[0],0,0,0), C0,8); \
    KRD(GL,1); GAPB(o[1]=__builtin_amdgcn_mfma_f32_32x32x16_bf16(PAF(1),VFR(5),o[1],0,0,0), C0,12); \
    KRD(GL,2); GAPB(o[0]=__builtin_amdgcn_mfma_f32_32x32x16_bf16(PAF(2),VFR(2),o[0],0,0,0), C1,0); \
    KRD(GL,3); GAPB(o[1]=__builtin_amdgcn_mfma_f32_32x32x16_bf16(PAF(2),VFR(6),o[1],0,0,0), C1,4); \
    GAPB(o[0]=__builtin_amdgcn_mfma_f32_32x32x16_bf16(PAF(3),VFR(3),o[0],0,0,0), C1,8); \
    GAPB(o[1]=__builtin_amdgcn_mfma_f32_32x32x16_bf16(PAF(3),VFR(7),o[1],0,0,0), C1,12); \
    }while(0)
  int t=1;
  #undef CMASK
  #define CMASK(P0,P1,t) do{}while(0)
  for(;t+5<NT;t+=2){
    STEP(pB0,pB1,pA0,pA1,t,true,true,true);     WAIT_BAR(2); RESC(); ROT();
    STEP(pA0,pA1,pB0,pB1,t+1,true,true,true);   WAIT_BAR(2); RESC(); ROT();
  }
  #undef CMASK
  int hi_b=hi,qrel_b=qrel; asm volatile("":"+v"(hi_b),"+v"(qrel_b));
  #define CMASK(P0,P1,t) do{int jb_=(t)-(NT-4); if(jb_>=0)cmask(P0,P1,jb_,qrel_b,hi_b);}while(0)
  #define ENDW(tt) do{ if((tt)+3<NT){WAIT_BAR(2);} else if((tt)+2<NT){WAIT_BAR(1);} else {WAIT_BAR(0);} }while(0)
  for(;t+1<NT;t+=2){
    STEP(pB0,pB1,pA0,pA1,t,(t+3<NT),(t+1<NT),(t+1<NT));       ENDW(t);   RESC(); ROT();
    STEP(pA0,pA1,pB0,pB1,t+1,(t+4<NT),(t+2<NT),(t+2<NT));     ENDW(t+1); RESC(); ROT();
  }
  STEP(pB0,pB1,pA0,pA1,NT-1,false,false,false); RESC();
  { float sacc=pB0[0]+pB0[1]; _Pragma("unroll") for(int r=2;r<16;++r)sacc+=pB0[r]; _Pragma("unroll") for(int r=0;r<16;++r)sacc+=pB1[r]; l_reg+=sacc;
    pw0=(u32x4){PKW(pB0,0),PKW(pB0,2),PKW(pB0,4),PKW(pB0,6)};pw1=(u32x4){PKW(pB0,8),PKW(pB0,10),PKW(pB0,12),PKW(pB0,14)};pw2=(u32x4){PKW(pB1,0),PKW(pB1,2),PKW(pB1,4),PKW(pB1,6)};pw3=(u32x4){PKW(pB1,8),PKW(pB1,10),PKW(pB1,12),PKW(pB1,14)};
    SBAR(); pv(o,vb0+sl_cur,PAF(0),PAF(1),PAF(2),PAF(3)); }
  #undef PKW
  #undef PAF
  #undef VFR
  #undef PIN
  #undef MX3
  #undef GAPA
  #undef GAPB
  #undef EX
  #undef VRD
  #undef KRD
  #undef STEP
  #undef ENDW
  {auto rr=__builtin_amdgcn_permlane32_swap(__float_as_uint(l_reg),__float_as_uint(l_reg),false,false);l_reg=__uint_as_float(rr[0])+__uint_as_float(rr[1]);}
  if(hi==0)wsf[32+r32]=l_reg;asm volatile("s_waitcnt lgkmcnt(0)":::"memory");
  float rli[16];
  #pragma unroll
  for(int r=0;r<16;++r)rli[r]=__builtin_amdgcn_rcpf(wsf[32+crow(r,hi)]);
  bf16*Ow=Oh+(long)(q0+wid*QBLK)*LDO;
  { bf16*stg=(bf16*)(shm+LDS_OST)+wid*2048;
    #pragma unroll
    for(int r=0;r<16;++r){const int orow=crow(r,hi);
      #pragma unroll
      for(int d0=0;d0<2;++d0)stg[orow*64+d0*32+r32]=__float2bfloat16(o[d0][r]*rli[r]);}
    asm volatile("s_waitcnt lgkmcnt(0)":::"memory");
    #pragma unroll
    for(int i=0;i<4;++i){const int row=i*8+(lane>>3),ch=lane&7; const u32x4 v=*(const u32x4*)(stg+row*64+ch*8); ATTN_STORE16(Ow+(long)row*LDO+ch*8,v);} }
  asm volatile("s_waitcnt lgkmcnt(0)\n\ts_barrier":::"memory");
  #undef DMA_K
  #undef DMA_V
  #undef CMASK
  #undef START
  #undef RESC
  #undef ROT
}
constexpr int ATTN_LDS_BYTES=LDS_BYTES;
template<int THRL=8> __device__ __forceinline__ void attn_phase(char*lds,const bf16*PE,bf16*AO,int vcu,int G){
  const int nu=(G==256)?4:((16*NQB-vcu+G-1)/G);
  #pragma unroll 1
  for(int i=0;i<nu;++i){
    int vh,qb;
    if(G==256){ const int s=vcu&15; vh=vcu>>4; qb=(i==0)?s:(i==1)?31-s:(i==2)?32+s:63-s; }
    else { const int u=vcu+i*G; vh=u/NQB; qb=u%NQB; }
    const int h2=vh>>1,half=vh&1;
    attn_unit<THRL>(qb,PE+h2*64,PE+512+h2*64,PE+1024+(h2>>1)*128+half*64,AO+vh*64,lds);
  }
}
#undef SBAR
#undef WAIT_BAR
}

#define GAS __attribute__((address_space(1)))
#define LAS __attribute__((address_space(3)))
typedef unsigned short bf16;
typedef unsigned v4u __attribute__((ext_vector_type(4)));
typedef float f32x4 __attribute__((ext_vector_type(4)));
typedef short bf16x8 __attribute__((ext_vector_type(8)));
typedef GAS unsigned gu32;
typedef GAS unsigned long long gu64;
#define RLX_AGENT __ATOMIC_RELAXED, __HIP_MEMORY_SCOPE_AGENT
#define LDS_WAIT() asm volatile("s_waitcnt lgkmcnt(0)" ::: "memory")
#define VM_WAIT() asm volatile("s_waitcnt vmcnt(0)" ::: "memory")
__device__ __forceinline__ unsigned long long rt() { return __builtin_amdgcn_s_memrealtime(); }
__device__ __forceinline__ unsigned f2bf(float f) { unsigned u = __builtin_bit_cast(unsigned, f); return (u + 0x7fffu + ((u >> 16) & 1u)) >> 16; }
__device__ __forceinline__ unsigned pk2(float lo, float hi) { return f2bf(lo) | (f2bf(hi) << 16); }

#define XB_TMO      128
#define XB_XCNT(j)  (256  + 64 * (j))
#define XB_XSUB(j)  (1280 + 64 * (j))
#define XB_XGEN(j)  (2304 + 64 * (j))
#define XB_TOP      3328
#define XB_TOPGEN   3392
#define XCD_BAR_WORDS 3456
#define XB_SPIN_CAP (1u << 18)

__device__ __forceinline__ unsigned xb_ld(unsigned* p)              { return __hip_atomic_load(p, __ATOMIC_RELAXED, __HIP_MEMORY_SCOPE_AGENT); }
__device__ __forceinline__ unsigned xb_add(unsigned* p, unsigned v) { return __hip_atomic_fetch_add(p, v, __ATOMIC_RELAXED, __HIP_MEMORY_SCOPE_AGENT); }
__device__ __forceinline__ unsigned xb_xcc_id() { return (unsigned)__builtin_amdgcn_s_getreg((3 << 11) | 20) & 0xFu; }
#define XB_SPIN(cond, bar) do { unsigned _sp = 0; while (cond) { __builtin_amdgcn_s_sleep(1); \
    if ((++_sp & 255u) == 0u) { if (xb_ld(&(bar)[XB_TMO])) break; if (_sp > XB_SPIN_CAP) { atomicAdd(&(bar)[XB_TMO], 1u); break; } } } } while (0)

struct XcdBarrier {
    unsigned* bar; unsigned x;
    volatile LAS unsigned* st;
};

__device__ __forceinline__ XcdBarrier xcd_barrier_post(unsigned* bar, volatile LAS unsigned* st) {
    XcdBarrier b; b.bar = bar; b.x = xb_xcc_id(); b.st = st;
    if (threadIdx.x == 0) (void)xb_add(&bar[XB_XCNT(b.x)], 1u);
    return b;
}
__device__ __forceinline__ void xcd_barrier_complete(unsigned* bar, unsigned x, unsigned& nloc, unsigned& nx) {
    const unsigned G = gridDim.x * gridDim.y * gridDim.z;
    unsigned sum, cnt, mine, sp = 0u;
    for (;;) {
        sum = 0u; cnt = 0u; mine = 0u;
#pragma unroll
        for (unsigned j = 0; j < 16; ++j) { const unsigned c = xb_ld(&bar[XB_XCNT(j)]); sum += c; cnt += (c > 0u) ? 1u : 0u; mine = (j == x) ? c : mine; }
        if (sum == G) break;
        __builtin_amdgcn_s_sleep(1);
        if ((++sp & 255u) == 0u) { if (xb_ld(&bar[XB_TMO])) break; if (sp > XB_SPIN_CAP) { atomicAdd(&bar[XB_TMO], 1u); break; } }
    }
    nloc = mine > 0u ? mine : 1u; nx = cnt > 0u ? cnt : 1u;
}

__device__ __forceinline__ void xcd_barrier(const XcdBarrier& b) {
    asm volatile("s_waitcnt vmcnt(0)" ::: "memory");
    __syncthreads();
    if (threadIdx.x == 0) {
        unsigned* bar = b.bar;
        __builtin_amdgcn_s_waitcnt(0);
        unsigned nloc = b.st[0], nx = b.st[1];
        if (nloc == 0u) { xcd_barrier_complete(bar, b.x, nloc, nx); b.st[0] = nloc; b.st[1] = nx; }
        const unsigned old = xb_add(&bar[XB_XSUB(b.x)], 1u);
        const unsigned gen = old / nloc;
        if (old + 1u == (gen + 1u) * nloc) {
            __builtin_amdgcn_fence(__ATOMIC_RELEASE, "agent");
            asm volatile("s_waitcnt vmcnt(0)" ::: "memory");
            const unsigned og = xb_add(&bar[XB_TOP], 1u);
            const unsigned tg = og / nx;
            if (og + 1u == (tg + 1u) * nx) xb_add(&bar[XB_TOPGEN], 1u);
            else XB_SPIN(xb_ld(&bar[XB_TOPGEN]) == tg, bar);
            __builtin_amdgcn_fence(__ATOMIC_ACQUIRE, "agent");
            xb_add(&bar[XB_XGEN(b.x)], 1u);
            asm volatile("s_waitcnt vmcnt(0)" ::: "memory");
        } else {
            XB_SPIN(xb_ld(&bar[XB_XGEN(b.x)]) == gen, bar);
            __builtin_amdgcn_fence(__ATOMIC_ACQUIRE, "agent");
            asm volatile("s_waitcnt vmcnt(0)" ::: "memory");
        }
    }
    __syncthreads();
}

constexpr int NWAVES = 8;
constexpr size_t MiB = 1u << 20;
constexpr size_t WS_CTL = 0, CTL_ZERO_BYTES = 1 * MiB;
constexpr size_t WS_TAB = 1 * MiB;
constexpr size_t WS_SSQA = 2 * MiB, WS_SSQB = 3 * MiB;
constexpr size_t WS_GB = 4 * MiB;
constexpr size_t WS_GC = 512 * 1024;
constexpr size_t WS_TOK = 5 * MiB;
constexpr size_t WS_W = 6 * MiB;
constexpr size_t WS_WINE = WS_W, WS_WOUTE = WS_W + 12 * MiB, WS_W13D = WS_W + 16 * MiB, WS_W2D = WS_W + 44 * MiB, WS_WINO = WS_W + 58 * MiB, WS_WOUTO = WS_W + 74 * MiB,
                 WS_WG = WS_W + 78 * MiB, WS_WP = WS_W + 86 * MiB, WS_W13M = WS_W + 88 * MiB, WS_W2M = WS_W + 200 * MiB;
constexpr size_t WS_PBF = 262 * MiB, WS_HBF = 294 * MiB, WS_PP = 326 * MiB, WS_MIX = 358 * MiB, WS_ARENA = 390 * MiB;
constexpr size_t AR_PE = 0, AR_AO = 96 * MiB;
constexpr size_t AR_PO = 0, AR_QN = 128 * MiB, AR_QT = 160 * MiB, AR_KN = 192 * MiB, AR_KGT = 224 * MiB, AR_VBT = 256 * MiB, AR_KTT = 288 * MiB, AR_AI = 320 * MiB, AR_NEGW = 336 * MiB,
                 AR_UT = 368 * MiB, AR_MP = 400 * MiB, AR_NT = 464 * MiB, AR_WT = 528 * MiB, AR_SG = 192 * MiB  , AR_MPC = 288 * MiB  , AR_NTC = 304 * MiB, AR_END = 560 * MiB;
constexpr size_t AR_ACT = 0, AR_XS = 240 * MiB, AR_Y = 308 * MiB;
constexpr size_t WS_NEED = WS_ARENA + AR_END;
constexpr size_t TOK_E = 0, TOK_R = 128 * 1024, TOK_G = 256 * 1024, TOK_DST = 384 * 1024, TOK_GPAD = 512 * 1024, TOK_DN = 704 * 1024, TOK_DNC = 720 * 1024;
constexpr int CW_TMO = 0, CW_BAR = 4096, CW_CNT = 8192  , CW_DBG = 12288;

constexpr int RING_OFF = 0, WAVE_LDS = 17408;
constexpr int LDSCTL_OFF = 139264, MISC_OFF = LDSCTL_OFF + 64, BLKE_OFF = LDSCTL_OFF + 256  , RT_OFF = LDSCTL_OFF + 1024  ;
constexpr int LDS_BYTES = 147456;

typedef unsigned u32x2v __attribute__((ext_vector_type(2)));
__device__ __forceinline__ float bflo(unsigned w) { return __uint_as_float(w << 16); }
__device__ __forceinline__ float bfhi(unsigned w) { return __uint_as_float(w & 0xffff0000u); }
__device__ __forceinline__ unsigned cvtpk(float lo, float hi) { return pg8::cvt_pk_bf16_cv(lo, hi); }
__device__ __forceinline__ float wave_sum(float v) {
#pragma unroll
    for (int o = 1; o < 64; o <<= 1) v += __shfl_xor(v, o);
    return v;
}
__device__ __forceinline__ float sigm(float x) { return pg8::sigmoidf_(x); }
__device__ __forceinline__ float silu(float x) { return x * pg8::sigmoidf_(x); }

struct Args { const void* in[30]; float* out; unsigned char* ws; int ph_lo, ph_hi, use_bar, pad; };

struct Frame {
    LAS unsigned char* lds; int tid, lane, wave, vcu, G, gw, NGW;
};

__device__ __forceinline__ void xpose_item(const float* W, int ldw, int K, int N, const float* gain, bf16* WT, int ilv, LAS float* scr, int item, int lane) {
    const int nblk = N / 64, kb = item / nblk, nb = item % nblk, k0 = 64 * kb, n0 = 64 * nb;
    const int lr = lane >> 4, lc = (lane & 15) * 4;
    f32x4 v[16];
#pragma unroll
    for (int i = 0; i < 16; ++i) v[i] = *(const GAS f32x4*)(W + (size_t)(k0 + 4 * i + lr) * ldw + n0 + lc);
    if (gain) {
#pragma unroll
        for (int i = 0; i < 16; ++i) v[i] = v[i] * gain[k0 + 4 * i + lr]; }
#pragma unroll
    for (int i = 0; i < 16; ++i) { LAS float* s = scr + (4 * i + lr) * 65 + lc; s[0] = v[i][0]; s[1] = v[i][1]; s[2] = v[i][2]; s[3] = v[i][3]; }
    LDS_WAIT(); asm volatile("" ::: "memory");
    const int c = lane & 7;
#pragma unroll
    for (int j = 0; j < 8; ++j) { const int nl = (lane >> 3) + 8 * j, n = n0 + nl; const LAS float* s = scr + (8 * c) * 65 + nl;
        const int dr = ilv ? (((n >> 7) << 8) + (n & 127) + (ilv == 2 ? 128 : 0)) : n;
        v4u o; o.x = pk2(s[0 * 65], s[1 * 65]); o.y = pk2(s[2 * 65], s[3 * 65]); o.z = pk2(s[4 * 65], s[5 * 65]); o.w = pk2(s[6 * 65], s[7 * 65]);
        *(GAS v4u*)(WT + (size_t)dr * K + k0 + 8 * c) = o; }
    LDS_WAIT(); asm volatile("" ::: "memory");
}
struct MatD { const float* W; int ldw, K, N; const float* gain; bf16* WT; int ilv; int items; };
__device__ __forceinline__ MatD dense_mat(const Args& a, int id) {
    unsigned char* ws = a.ws; MatD m; m.gain = nullptr; m.ilv = 0;
    if (id < 2)       { const int j = id;      m.W = (const float*)a.in[7] + (size_t)j * D_ * EIN;    m.ldw = EIN; m.K = D_; m.N = EIN; m.gain = (const float*)a.in[3] + (2 * j) * D_; m.WT = (bf16*)(ws + WS_WINE) + (size_t)j * EIN * D_; }
    else if (id < 4)  { const int j = id - 2;  m.W = (const float*)a.in[8] + (size_t)j * D_ * D_;     m.ldw = D_; m.K = D_; m.N = D_; m.WT = (bf16*)(ws + WS_WOUTE) + (size_t)j * D_ * D_; }
    else if (id < 6)  { const int j = id - 4;  m.W = (const float*)a.in[21] + (size_t)j * D_ * DFF;   m.ldw = DFF; m.K = D_; m.N = DFF; m.gain = (const float*)a.in[4] + (2 * j) * D_; m.WT = (bf16*)(ws + WS_W13D) + (size_t)j * 2 * DFF * D_; m.ilv = 1; }
    else if (id < 8)  { const int j = id - 6;  m.W = (const float*)a.in[22] + (size_t)j * D_ * DFF;   m.ldw = DFF; m.K = D_; m.N = DFF; m.gain = (const float*)a.in[4] + (2 * j) * D_; m.WT = (bf16*)(ws + WS_W13D) + (size_t)j * 2 * DFF * D_; m.ilv = 2; }
    else if (id < 10) { const int j = id - 8;  m.W = (const float*)a.in[23] + (size_t)j * DFF * D_;   m.ldw = D_; m.K = DFF; m.N = D_; m.WT = (bf16*)(ws + WS_W2D) + (size_t)j * D_ * DFF; }
    else if (id < 12) { const int j = id - 10; m.W = (const float*)a.in[15] + (size_t)j * D_ * OIN_SRC; m.ldw = OIN_SRC; m.K = D_; m.N = OIN; m.gain = (const float*)a.in[3] + (2 * j + 1) * D_; m.WT = (bf16*)(ws + WS_WINO) + (size_t)j * OIN * D_; }
    else if (id < 14) { const int j = id - 12; m.W = (const float*)a.in[20] + (size_t)j * D_ * D_;    m.ldw = D_; m.K = D_; m.N = D_; m.WT = (bf16*)(ws + WS_WOUTO) + (size_t)j * D_ * D_; }
    else if (id < 18) { const int i = id - 14; m.W = (const float*)a.in[28] + (size_t)i * D_ * D_;    m.ldw = D_; m.K = D_; m.N = D_; m.gain = (const float*)a.in[5] + i * D_; m.WT = (bf16*)(ws + WS_WG) + (size_t)i * D_ * D_; }
    else              { const int i = id - 18; m.W = (const float*)a.in[29] + (size_t)i * PLE * D_;   m.ldw = D_; m.K = PLE; m.N = D_; m.WT = (bf16*)(ws + WS_WP) + (size_t)i * D_ * PLE; }
    m.items = (m.K / 64) * (m.N / 64); return m;
}
__device__ __forceinline__ MatD moe_mat(const Args& a, int j, int id) {
    unsigned char* ws = a.ws; MatD m; m.gain = nullptr; m.ilv = 0; const int e = id / 3, k = id % 3;
    if (k < 2) { m.W = (const float*)a.in[25 + k] + ((size_t)j * NEXP + e) * D_ * DFF; m.ldw = DFF; m.K = D_; m.N = DFF; m.gain = (const float*)a.in[4] + (2 * j + 1) * D_; m.WT = (bf16*)(ws + WS_W13M) + (size_t)e * 2 * DFF * D_; m.ilv = 1 + k; }
    else       { m.W = (const float*)a.in[27] + ((size_t)j * NEXP + e) * DFF * D_; m.ldw = D_; m.K = DFF; m.N = D_; m.WT = (bf16*)(ws + WS_W2M) + (size_t)e * D_ * DFF; }
    m.items = (m.K / 64) * (m.N / 64); return m;
}

__device__ __forceinline__ void p_prologue(const Frame& F, const Args& a) {
    LAS float* scr = (LAS float*)(F.lds + F.wave * WAVE_LDS);
    unsigned char* ws = a.ws;
    {
        int base = 0;
#pragma unroll 1
        for (int id = 0; id < 22; ++id) { const MatD m = dense_mat(a, id);
            int first = (F.gw - base) % F.NGW; if (first < 0) first += F.NGW;
#pragma unroll 1
            for (int it = first; it < m.items; it += F.NGW) xpose_item(m.W, m.ldw, m.K, m.N, m.gain, m.WT, m.ilv, scr, it, F.lane);
            base += m.items; }
    }
    { const float* p = (const float*)a.in[1]; bf16* pb = (bf16*)(ws + WS_PBF); const size_t n8 = (size_t)DEPTH_ * S_ * PLE / 8;
#pragma unroll 1
      for (size_t i = (size_t)F.gw * 64 + F.lane; i < n8; i += (size_t)F.NGW * 64) { const f32x4 x0 = *(const GAS f32x4*)(p + i * 8), x1 = *(const GAS f32x4*)(p + i * 8 + 4);
          v4u o; o.x = cvtpk(x0[0], x0[1]); o.y = cvtpk(x0[2], x0[3]); o.z = cvtpk(x1[0], x1[1]); o.w = cvtpk(x1[2], x1[3]); *(GAS v4u*)(pb + i * 8) = o; } }
    { const float* x = (const float*)a.in[0]; bf16* hb = (bf16*)(ws + WS_HBF); float* ssq = (float*)(ws + WS_SSQB);
#pragma unroll 1
      for (int m = F.gw; m < S_; m += F.NGW) { const GAS f32x4* xr = (const GAS f32x4*)(x + (size_t)m * D_) + F.lane; float s = 0.f;
#pragma unroll
          for (int j = 0; j < 4; ++j) { const f32x4 v = xr[64 * j]; s += (v[0] * v[0] + v[1] * v[1]) + (v[2] * v[2] + v[3] * v[3]);
              *((GAS f32x4*)(a.out + (size_t)m * D_) + F.lane + 64 * j) = v;
              u32x2v o; o.x = cvtpk(v[0], v[1]); o.y = cvtpk(v[2], v[3]); *((GAS u32x2v*)(hb + (size_t)m * D_) + F.lane + 64 * j) = o; }
          s = wave_sum(s);
          if (F.lane < 16) ssq[(size_t)m * 16 + F.lane] = (F.lane == 0) ? s : 0.f; } }
    { const int* pos = (const int*)a.in[2]; float* tab = (float*)(ws + WS_TAB);
#pragma unroll 1
      for (int idx = F.gw * 64 + F.lane; idx < S_ * 8; idx += F.NGW * 64) { const int row = idx >> 3, i = idx & 7;
          const float inv = exp2f(-(float)i * (18.931568569324174f / 8.0f));
          const float ang = (float)pos[row] * inv;
          double t = (double)ang * 0.15915494309189535; t -= rint(t); const float tf = (float)t;
          tab[(size_t)row * 16 + i] = __builtin_amdgcn_cosf(tf); tab[(size_t)row * 16 + 8 + i] = __builtin_amdgcn_sinf(tf); } }
}

__device__ __forceinline__ void p_mixprep(const Frame& F, const Args& a, int L) {
    GAS unsigned char* ws = (GAS unsigned char*)a.ws; asm volatile("" : "+s"(ws)); int lane_ = F.lane; asm volatile("" : "+v"(lane_)); const int j = L >> 1, lane = lane_;
    const bf16* AO = (const bf16*)(ws + WS_ARENA + AR_AO); const bf16* PE = (const bf16*)(ws + WS_ARENA + AR_PE); bf16* mix = (bf16*)(ws + WS_MIX);
    const float lam0 = 0.8f - 0.6f * expf(-0.3f * (float)L);
    float s1 = ((const float*)a.in[9])[j * 64 + lane] * ((const float*)a.in[10])[j * 64 + lane], s2 = ((const float*)a.in[11])[j * 64 + lane] * ((const float*)a.in[12])[j * 64 + lane];
    s1 = wave_sum(s1); s2 = wave_sum(s2);
    const float lam = expf(s1) - expf(s2) + lam0, post = 1.0f - lam0;
    const int hh = lane >> 4, dd = (lane & 15) * 8, ch = lane * 8;
    float sg[8], w0[8], w1[8], w2[8];
#pragma unroll
    for (int e = 0; e < 8; ++e) { sg[e] = ((const float*)a.in[13])[j * 128 + dd + e] * post;
        w0[e] = ((const float*)a.in[14])[(j * 3 + 0) * 512 + ch + e]; w1[e] = ((const float*)a.in[14])[(j * 3 + 1) * 512 + ch + e]; w2[e] = ((const float*)a.in[14])[(j * 3 + 2) * 512 + ch + e]; }
#pragma unroll 1
    for (int t = F.gw; t < S_; t += F.NGW) {
        const v4u o1 = *(const GAS v4u*)(AO + (size_t)t * D_ + 256 * hh + dd), o2 = *(const GAS v4u*)(AO + (size_t)t * D_ + 256 * hh + 128 + dd);
        float d[8]; const unsigned a1[4] = {o1.x, o1.y, o1.z, o1.w}, a2[4] = {o2.x, o2.y, o2.z, o2.w}; float ss = 0.f;
#pragma unroll
        for (int q = 0; q < 4; ++q) { d[2 * q] = bflo(a1[q]) - lam * bflo(a2[q]); d[2 * q + 1] = bfhi(a1[q]) - lam * bfhi(a2[q]); ss += d[2 * q] * d[2 * q] + d[2 * q + 1] * d[2 * q + 1]; }
        ss += __shfl_xor(ss, 1); ss += __shfl_xor(ss, 2); ss += __shfl_xor(ss, 4); ss += __shfl_xor(ss, 8);
        const float rms = __builtin_amdgcn_rsqf(ss * (1.0f / 128.0f) + 1e-5f);
        v4u o; o.x = cvtpk(d[0] * rms * sg[0], d[1] * rms * sg[1]); o.y = cvtpk(d[2] * rms * sg[2], d[3] * rms * sg[3]); o.z = cvtpk(d[4] * rms * sg[4], d[5] * rms * sg[5]); o.w = cvtpk(d[6] * rms * sg[6], d[7] * rms * sg[7]);
        *(GAS v4u*)(mix + (size_t)t * D_ + hh * 128 + dd) = o;
        const bf16* r0 = PE + (size_t)t * EIN;
        const v4u bb = *(const GAS v4u*)(r0 + 1536 + ch), c0 = *(const GAS v4u*)(r0 + 2048 + ch), x0 = *(const GAS v4u*)(r0 + 2560 + ch);
        v4u c1 = {0u, 0u, 0u, 0u}, x1 = c1, c2 = c1, x2 = c1;
        if (t >= 1) { c1 = *(const GAS v4u*)(r0 - EIN + 2048 + ch); x1 = *(const GAS v4u*)(r0 - EIN + 2560 + ch); }
        if (t >= 2) { c2 = *(const GAS v4u*)(r0 - 2 * EIN + 2048 + ch); x2 = *(const GAS v4u*)(r0 - 2 * EIN + 2560 + ch); }
        const unsigned B[4] = {bb.x, bb.y, bb.z, bb.w}, C0[4] = {c0.x, c0.y, c0.z, c0.w}, X0[4] = {x0.x, x0.y, x0.z, x0.w}, C1[4] = {c1.x, c1.y, c1.z, c1.w}, X1[4] = {x1.x, x1.y, x1.z, x1.w},
                       C2[4] = {c2.x, c2.y, c2.z, c2.w}, X2[4] = {x2.x, x2.y, x2.z, x2.w};
        float sc[8];
#pragma unroll
        for (int q = 0; q < 4; ++q) {
            sc[2 * q] = bflo(B[q]) * (w2[2 * q] * (bflo(C0[q]) * bflo(X0[q])) + w1[2 * q] * (bflo(C1[q]) * bflo(X1[q])) + w0[2 * q] * (bflo(C2[q]) * bflo(X2[q])));
            sc[2 * q + 1] = bfhi(B[q]) * (w2[2 * q + 1] * (bfhi(C0[q]) * bfhi(X0[q])) + w1[2 * q + 1] * (bfhi(C1[q]) * bfhi(X1[q])) + w0[2 * q + 1] * (bfhi(C2[q]) * bfhi(X2[q]))); }
        v4u so; so.x = cvtpk(sc[0], sc[1]); so.y = cvtpk(sc[2], sc[3]); so.z = cvtpk(sc[4], sc[5]); so.w = cvtpk(sc[6], sc[7]);
        *(GAS v4u*)(mix + (size_t)t * D_ + 512 + ch) = so;
    }
}


__device__ __forceinline__ void p_rot(const Frame& F, const Args& a) {
    GAS unsigned char* ws = (GAS unsigned char*)a.ws; asm volatile("" : "+s"(ws)); int lane_ = F.lane; asm volatile("" : "+v"(lane_)); const int lane = lane_;
    bf16* PE = (bf16*)(ws + WS_ARENA + AR_PE); const float* tab = (const float*)(ws + WS_TAB);
    const int hd = lane >> 2, i0 = 2 * (lane & 3), col = (hd < 8 ? hd * 64 : 512 + (hd - 8) * 64) + i0;
#pragma unroll 1
    for (int t = F.gw; t < S_; t += F.NGW) {
        GAS unsigned* p1 = (GAS unsigned*)(PE + (size_t)t * EIN + col); GAS unsigned* p2 = (GAS unsigned*)(PE + (size_t)t * EIN + col + 8);
        const unsigned w1 = *p1, w2 = *p2;
        const float c0 = tab[(size_t)t * 16 + i0], c1 = tab[(size_t)t * 16 + i0 + 1], s0 = tab[(size_t)t * 16 + 8 + i0], s1 = tab[(size_t)t * 16 + 8 + i0 + 1];
        const float a0 = bflo(w1), a1 = bfhi(w1), b0 = bflo(w2), b1 = bfhi(w2);
        *p1 = cvtpk(a0 * c0 - b0 * s0, a1 * c1 - b1 * s1); *p2 = cvtpk(b0 * c0 + a0 * s0, b1 * c1 + a1 * s1);
    }
}
__device__ __forceinline__ void p_ab(const Frame& F, const Args& a, int L) {
    GAS unsigned char* ws = (GAS unsigned char*)a.ws; asm volatile("" : "+s"(ws)); int lane_ = F.lane; asm volatile("" : "+v"(lane_)); const int j = L >> 1, lane = lane_;
    LAS float* wl = (LAS float*)F.lds;
    const float* W = (const float*)a.in[15] + (size_t)j * D_ * OIN_SRC; const float* ln = (const float*)a.in[3] + L * D_;
    for (int idx = F.tid; idx < D_ * 16; idx += NWAVES * 64) { const int k = idx >> 4, c = idx & 15; wl[k * 20 + c] = ln[k] * W[(size_t)k * OIN_SRC + 4096 + c]; }
    __syncthreads();
    const float* ssq = (const float*)(ws + WS_SSQB); float* gg = (float*)(ws + WS_GB); float* gbeta = gg + S_ * 8;
    const float alog = ((const float*)a.in[17])[j * 8 + (lane & 7)], dtb = ((const float*)a.in[18])[j * 8 + (lane & 7)];
    const GAS float* hG = (const GAS float*)a.out;
#pragma unroll 1
    for (int t0 = F.gw; t0 < S_; t0 += 2 * F.NGW) {
        const int tb = t0 + F.NGW; const bool hasb = tb < S_; const int tbc = hasb ? tb : t0;
        float xa[16], xb[16];
#pragma unroll
        for (int i = 0; i < 16; ++i) { xa[i] = hG[(size_t)t0 * D_ + 64 * i + lane]; xb[i] = hG[(size_t)tbc * D_ + 64 * i + lane]; }
        const float rsa = pg8::rstd_row(ssq, t0), rsb = pg8::rstd_row(ssq, tbc);
        float acca[16], accb[16];
#pragma unroll
        for (int c = 0; c < 16; ++c) { acca[c] = 0.f; accb[c] = 0.f; }
#pragma unroll 4
        for (int i = 0; i < 16; ++i) { const LAS f32x4* wr = (const LAS f32x4*)(wl + (64 * i + lane) * 20);
#pragma unroll
            for (int q = 0; q < 4; ++q) { const f32x4 w = wr[q];
                acca[4 * q] += xa[i] * w[0]; acca[4 * q + 1] += xa[i] * w[1]; acca[4 * q + 2] += xa[i] * w[2]; acca[4 * q + 3] += xa[i] * w[3];
                accb[4 * q] += xb[i] * w[0]; accb[4 * q + 1] += xb[i] * w[1]; accb[4 * q + 2] += xb[i] * w[2]; accb[4 * q + 3] += xb[i] * w[3]; } }
        float minea = 0.f, mineb = 0.f;
#pragma unroll
        for (int c = 0; c < 16; ++c) { const float sa = wave_sum(acca[c]), sb = wave_sum(accb[c]); minea = ((lane & 15) == c) ? sa : minea; mineb = ((lane & 15) == c) ? sb : mineb; }
#pragma unroll
        for (int half = 0; half < 2; ++half) { if (half == 1 && !hasb) break;
            const int t = half ? tb : t0; const float mine = (half ? mineb * rsb : minea * rsa);
            if (lane < 8) gbeta[(size_t)t * 8 + lane] = sigm(mine);
            else if (lane < 16) { const float z = mine + dtb; const float sp = z > 20.f ? z : log1pf(expf(z)); gg[(size_t)t * 8 + lane - 8] = -expf(alog) * sp; } }
    }
    __syncthreads();
}
__device__ __forceinline__ void tri_solve(const LAS float* Lc, LAS bf16* Xs, int lane) {
    float x0, x1, x2, x3, x4, x5, x6, x7, x8, x9, x10, x11, x12, x13, x14, x15, x16, x17, x18, x19, x20, x21, x22, x23, x24, x25, x26, x27, x28, x29, x30, x31, x32, x33, x34, x35, x36, x37, x38, x39, x40, x41, x42, x43, x44, x45, x46, x47, x48, x49, x50, x51, x52, x53, x54, x55, x56, x57, x58, x59, x60, x61, x62, x63;
    { x63 = (lane == 63) ? 1.0f : 0.0f; asm volatile("" : "+v"(x63) : : "memory"); }
    { float s0 = 0.f, s1 = 0.f, s2 = 0.f, s3 = 0.f; { const f32x4 l = *(const LAS f32x4*)(Lc + 4276); s3 = fmaf(x63, l[3], s3); } x62 = (lane == 62) ? 1.0f : -((s0 + s1) + (s2 + s3)); asm volatile("" : "+v"(x62) : : "memory"); }
    { float s0 = 0.f, s1 = 0.f, s2 = 0.f, s3 = 0.f; { const f32x4 l = *(const LAS f32x4*)(Lc + 4208); s2 = fmaf(x62, l[2], s2); s3 = fmaf(x63, l[3], s3); } x61 = (lane == 61) ? 1.0f : -((s0 + s1) + (s2 + s3)); asm volatile("" : "+v"(x61) : : "memory"); }
    { float s0 = 0.f, s1 = 0.f, s2 = 0.f, s3 = 0.f; { const f32x4 l = *(const LAS f32x4*)(Lc + 4140); s1 = fmaf(x61, l[1], s1); s2 = fmaf(x62, l[2], s2); s3 = fmaf(x63, l[3], s3); } x60 = (lane == 60) ? 1.0f : -((s0 + s1) + (s2 + s3)); asm volatile("" : "+v"(x60) : : "memory"); }
    { float s0 = 0.f, s1 = 0.f, s2 = 0.f, s3 = 0.f; { const f32x4 l = *(const LAS f32x4*)(Lc + 4072); s0 = fmaf(x60, l[0], s0); s1 = fmaf(x61, l[1], s1); s2 = fmaf(x62, l[2], s2); s3 = fmaf(x63, l[3], s3); } x59 = (lane == 59) ? 1.0f : -((s0 + s1) + (s2 + s3)); asm volatile("" : "+v"(x59) : : "memory"); }
    { float s0 = 0.f, s1 = 0.f, s2 = 0.f, s3 = 0.f; { const f32x4 l = *(const LAS f32x4*)(Lc + 4000); s3 = fmaf(x59, l[3], s3); } { const f32x4 l = *(const LAS f32x4*)(Lc + 4004); s0 = fmaf(x60, l[0], s0); s1 = fmaf(x61, l[1], s1); s2 = fmaf(x62, l[2], s2); s3 = fmaf(x63, l[3], s3); } x58 = (lane == 58) ? 1.0f : -((s0 + s1) + (s2 + s3)); asm volatile("" : "+v"(x58) : : "memory"); }
    { float s0 = 0.f, s1 = 0.f, s2 = 0.f, s3 = 0.f; { const f32x4 l = *(const LAS f32x4*)(Lc + 3932); s2 = fmaf(x58, l[2], s2); s3 = fmaf(x59, l[3], s3); } { const f32x4 l = *(const LAS f32x4*)(Lc + 3936); s0 = fmaf(x60, l[0], s0); s1 = fmaf(x61, l[1], s1); s2 = fmaf(x62, l[2], s2); s3 = fmaf(x63, l[3], s3); } x57 = (lane == 57) ? 1.0f : -((s0 + s1) + (s2 + s3)); asm volatile("" : "+v"(x57) : : "memory"); }
    { float s0 = 0.f, s1 = 0.f, s2 = 0.f, s3 = 0.f; { const f32x4 l = *(const LAS f32x4*)(Lc + 3864); s1 = fmaf(x57, l[1], s1); s2 = fmaf(x58, l[2], s2); s3 = fmaf(x59, l[3], s3); } { const f32x4 l = *(const LAS f32x4*)(Lc + 3868); s0 = fmaf(x60, l[0], s0); s1 = fmaf(x61, l[1], s1); s2 = fmaf(x62, l[2], s2); s3 = fmaf(x63, l[3], s3); } x56 = (lane == 56) ? 1.0f : -((s0 + s1) + (s2 + s3)); asm volatile("" : "+v"(x56) : : "memory"); }
    { float s0 = 0.f, s1 = 0.f, s2 = 0.f, s3 = 0.f; { const f32x4 l = *(const LAS f32x4*)(Lc + 3796); s0 = fmaf(x56, l[0], s0); s1 = fmaf(x57, l[1], s1); s2 = fmaf(x58, l[2], s2); s3 = fmaf(x59, l[3], s3); } { const f32x4 l = *(const LAS f32x4*)(Lc + 3800); s0 = fmaf(x60, l[0], s0); s1 = fmaf(x61, l[1], s1); s2 = fmaf(x62, l[2], s2); s3 = fmaf(x63, l[3], s3); } x55 = (lane == 55) ? 1.0f : -((s0 + s1) + (s2 + s3)); asm volatile("" : "+v"(x55) : : "memory"); }
    { float s0 = 0.f, s1 = 0.f, s2 = 0.f, s3 = 0.f; { const f32x4 l = *(const LAS f32x4*)(Lc + 3724); s3 = fmaf(x55, l[3], s3); } { const f32x4 l = *(const LAS f32x4*)(Lc + 3728); s0 = fmaf(x56, l[0], s0); s1 = fmaf(x57, l[1], s1); s2 = fmaf(x58, l[2], s2); s3 = fmaf(x59, l[3], s3); } { const f32x4 l = *(const LAS f32x4*)(Lc + 3732); s0 = fmaf(x60, l[0], s0); s1 = fmaf(x61, l[1], s1); s2 = fmaf(x62, l[2], s2); s3 = fmaf(x63, l[3], s3); } x54 = (lane == 54) ? 1.0f : -((s0 + s1) + (s2 + s3)); asm volatile("" : "+v"(x54) : : "memory"); }
    { float s0 = 0.f, s1 = 0.f, s2 = 0.f, s3 = 0.f; { const f32x4 l = *(const LAS f32x4*)(Lc + 3656); s2 = fmaf(x54, l[2], s2); s3 = fmaf(x55, l[3], s3); } { const f32x4 l = *(const LAS f32x4*)(Lc + 3660); s0 = fmaf(x56, l[0], s0); s1 = fmaf(x57, l[1], s1); s2 = fmaf(x58, l[2], s2); s3 = fmaf(x59, l[3], s3); } { const f32x4 l = *(const LAS f32x4*)(Lc + 3664); s0 = fmaf(x60, l[0], s0); s1 = fmaf(x61, l[1], s1); s2 = fmaf(x62, l[2], s2); s3 = fmaf(x63, l[3], s3); } x53 = (lane == 53) ? 1.0f : -((s0 + s1) + (s2 + s3)); asm volatile("" : "+v"(x53) : : "memory"); }
    { float s0 = 0.f, s1 = 0.f, s2 = 0.f, s3 = 0.f; { const f32x4 l = *(const LAS f32x4*)(Lc + 3588); s1 = fmaf(x53, l[1], s1); s2 = fmaf(x54, l[2], s2); s3 = fmaf(x55, l[3], s3); } { const f32x4 l = *(const LAS f32x4*)(Lc + 3592); s0 = fmaf(x56, l[0], s0); s1 = fmaf(x57, l[1], s1); s2 = fmaf(x58, l[2], s2); s3 = fmaf(x59, l[3], s3); } { const f32x4 l = *(const LAS f32x4*)(Lc + 3596); s0 = fmaf(x60, l[0], s0); s1 = fmaf(x61, l[1], s1); s2 = fmaf(x62, l[2], s2); s3 = fmaf(x63, l[3], s3); } x52 = (lane == 52) ? 1.0f : -((s0 + s1) + (s2 + s3)); asm volatile("" : "+v"(x52) : : "memory"); }
    { float s0 = 0.f, s1 = 0.f, s2 = 0.f, s3 = 0.f; { const f32x4 l = *(const LAS f32x4*)(Lc + 3520); s0 = fmaf(x52, l[0], s0); s1 = fmaf(x53, l[1], s1); s2 = fmaf(x54, l[2], s2); s3 = fmaf(x55, l[3], s3); } { const f32x4 l = *(const LAS f32x4*)(Lc + 3524); s0 = fmaf(x56, l[0], s0); s1 = fmaf(x57, l[1], s1); s2 = fmaf(x58, l[2], s2); s3 = fmaf(x59, l[3], s3); } { const f32x4 l = *(const LAS f32x4*)(Lc + 3528); s0 = fmaf(x60, l[0], s0); s1 = fmaf(x61, l[1], s1); s2 = fmaf(x62, l[2], s2); s3 = fmaf(x63, l[3], s3); } x51 = (lane == 51) ? 1.0f : -((s0 + s1) + (s2 + s3)); asm volatile("" : "+v"(x51) : : "memory"); }
    { float s0 = 0.f, s1 = 0.f, s2 = 0.f, s3 = 0.f; { const f32x4 l = *(const LAS f32x4*)(Lc + 3448); s3 = fmaf(x51, l[3], s3); } { const f32x4 l = *(const LAS f32x4*)(Lc + 3452); s0 = fmaf(x52, l[0], s0); s1 = fmaf(x53, l[1], s1); s2 = fmaf(x54, l[2], s2); s3 = fmaf(x55, l[3], s3); } { const f32x4 l = *(const LAS f32x4*)(Lc + 3456); s0 = fmaf(x56, l[0], s0); s1 = fmaf(x57, l[1], s1); s2 = fmaf(x58, l[2], s2); s3 = fmaf(x59, l[3], s3); } { const f32x4 l = *(const LAS f32x4*)(Lc + 3460); s0 = fmaf(x60, l[0], s0); s1 = fmaf(x61, l[1], s1); s2 = fmaf(x62, l[2], s2); s3 = fmaf(x63, l[3], s3); } x50 = (lane == 50) ? 1.0f : -((s0 + s1) + (s2 + s3)); asm volatile("" : "+v"(x50) : : "memory"); }
    { float s0 = 0.f, s1 = 0.f, s2 = 0.f, s3 = 0.f; { const f32x4 l = *(const LAS f32x4*)(Lc + 3380); s2 = fmaf(x50, l[2], s2); s3 = fmaf(x51, l[3], s3); } { const f32x4 l = *(const LAS f32x4*)(Lc + 3384); s0 = fmaf(x52, l[0], s0); s1 = fmaf(x53, l[1], s1); s2 = fmaf(x54, l[2], s2); s3 = fmaf(x55, l[3], s3); } { const f32x4 l = *(const LAS f32x4*)(Lc + 3388); s0 = fmaf(x56, l[0], s0); s1 = fmaf(x57, l[1], s1); s2 = fmaf(x58, l[2], s2); s3 = fmaf(x59, l[3], s3); } { const f32x4 l = *(const LAS f32x4*)(Lc + 3392); s0 = fmaf(x60, l[0], s0); s1 = fmaf(x61, l[1], s1); s2 = fmaf(x62, l[2], s2); s3 = fmaf(x63, l[3], s3); } x49 = (lane == 49) ? 1.0f : -((s0 + s1) + (s2 + s3)); asm volatile("" : "+v"(x49) : : "memory"); }
    { float s0 = 0.f, s1 = 0.f, s2 = 0.f, s3 = 0.f; { const f32x4 l = *(const LAS f32x4*)(Lc + 3312); s1 = fmaf(x49, l[1], s1); s2 = fmaf(x50, l[2], s2); s3 = fmaf(x51, l[3], s3); } { const f32x4 l = *(const LAS f32x4*)(Lc + 3316); s0 = fmaf(x52, l[0], s0); s1 = fmaf(x53, l[1], s1); s2 = fmaf(x54, l[2], s2); s3 = fmaf(x55, l[3], s3); } { const f32x4 l = *(const LAS f32x4*)(Lc + 3320); s0 = fmaf(x56, l[0], s0); s1 = fmaf(x57, l[1], s1); s2 = fmaf(x58, l[2], s2); s3 = fmaf(x59, l[3], s3); } { const f32x4 l = *(const LAS f32x4*)(Lc + 3324); s0 = fmaf(x60, l[0], s0); s1 = fmaf(x61, l[1], s1); s2 = fmaf(x62, l[2], s2); s3 = fmaf(x63, l[3], s3); } x48 = (lane == 48) ? 1.0f : -((s0 + s1) + (s2 + s3)); asm volatile("" : "+v"(x48) : : "memory"); }
    { float s0 = 0.f, s1 = 0.f, s2 = 0.f, s3 = 0.f; { const f32x4 l = *(const LAS f32x4*)(Lc + 3244); s0 = fmaf(x48, l[0], s0); s1 = fmaf(x49, l[1], s1); s2 = fmaf(x50, l[2], s2); s3 = fmaf(x51, l[3], s3); } { const f32x4 l = *(const LAS f32x4*)(Lc + 3248); s0 = fmaf(x52, l[0], s0); s1 = fmaf(x53, l[1], s1); s2 = fmaf(x54, l[2], s2); s3 = fmaf(x55, l[3], s3); } { const f32x4 l = *(const LAS f32x4*)(Lc + 3252); s0 = fmaf(x56, l[0], s0); s1 = fmaf(x57, l[1], s1); s2 = fmaf(x58, l[2], s2); s3 = fmaf(x59, l[3], s3); } { const f32x4 l = *(const LAS f32x4*)(Lc + 3256); s0 = fmaf(x60, l[0], s0); s1 = fmaf(x61, l[1], s1); s2 = fmaf(x62, l[2], s2); s3 = fmaf(x63, l[3], s3); } x47 = (lane == 47) ? 1.0f : -((s0 + s1) + (s2 + s3)); asm volatile("" : "+v"(x47) : : "memory"); }
    { float s0 = 0.f, s1 = 0.f, s2 = 0.f, s3 = 0.f; { const f32x4 l = *(const LAS f32x4*)(Lc + 3172); s3 = fmaf(x47, l[3], s3); } { const f32x4 l = *(const LAS f32x4*)(Lc + 3176); s0 = fmaf(x48, l[0], s0); s1 = fmaf(x49, l[1], s1); s2 = fmaf(x50, l[2], s2); s3 = fmaf(x51, l[3], s3); } { const f32x4 l = *(const LAS f32x4*)(Lc + 3180); s0 = fmaf(x52, l[0], s0); s1 = fmaf(x53, l[1], s1); s2 = fmaf(x54, l[2], s2); s3 = fmaf(x55, l[3], s3); } { const f32x4 l = *(const LAS f32x4*)(Lc + 3184); s0 = fmaf(x56, l[0], s0); s1 = fmaf(x57, l[1], s1); s2 = fmaf(x58, l[2], s2); s3 = fmaf(x59, l[3], s3); } { const f32x4 l = *(const LAS f32x4*)(Lc + 3188); s0 = fmaf(x60, l[0], s0); s1 = fmaf(x61, l[1], s1); s2 = fmaf(x62, l[2], s2); s3 = fmaf(x63, l[3], s3); } x46 = (lane == 46) ? 1.0f : -((s0 + s1) + (s2 + s3)); asm volatile("" : "+v"(x46) : : "memory"); }
    { float s0 = 0.f, s1 = 0.f, s2 = 0.f, s3 = 0.f; { const f32x4 l = *(const LAS f32x4*)(Lc + 3104); s2 = fmaf(x46, l[2], s2); s3 = fmaf(x47, l[3], s3); } { const f32x4 l = *(const LAS f32x4*)(Lc + 3108); s0 = fmaf(x48, l[0], s0); s1 = fmaf(x49, l[1], s1); s2 = fmaf(x50, l[2], s2); s3 = fmaf(x51, l[3], s3); } { const f32x4 l = *(const LAS f32x4*)(Lc + 3112); s0 = fmaf(x52, l[0], s0); s1 = fmaf(x53, l[1], s1); s2 = fmaf(x54, l[2], s2); s3 = fmaf(x55, l[3], s3); } { const f32x4 l = *(const LAS f32x4*)(Lc + 3116); s0 = fmaf(x56, l[0], s0); s1 = fmaf(x57, l[1], s1); s2 = fmaf(x58, l[2], s2); s3 = fmaf(x59, l[3], s3); } { const f32x4 l = *(const LAS f32x4*)(Lc + 3120); s0 = fmaf(x60, l[0], s0); s1 = fmaf(x61, l[1], s1); s2 = fmaf(x62, l[2], s2); s3 = fmaf(x63, l[3], s3); } x45 = (lane == 45) ? 1.0f : -((s0 + s1) + (s2 + s3)); asm volatile("" : "+v"(x45) : : "memory"); }
    { float s0 = 0.f, s1 = 0.f, s2 = 0.f, s3 = 0.f; { const f32x4 l = *(const LAS f32x4*)(Lc + 3036); s1 = fmaf(x45, l[1], s1); s2 = fmaf(x46, l[2], s2); s3 = fmaf(x47, l[3], s3); } { const f32x4 l = *(const LAS f32x4*)(Lc + 3040); s0 = fmaf(x48, l[0], s0); s1 = fmaf(x49, l[1], s1); s2 = fmaf(x50, l[2], s2); s3 = fmaf(x51, l[3], s3); } { const f32x4 l = *(const LAS f32x4*)(Lc + 3044); s0 = fmaf(x52, l[0], s0); s1 = fmaf(x53, l[1], s1); s2 = fmaf(x54, l[2], s2); s3 = fmaf(x55, l[3], s3); } { const f32x4 l = *(const LAS f32x4*)(Lc + 3048); s0 = fmaf(x56, l[0], s0); s1 = fmaf(x57, l[1], s1); s2 = fmaf(x58, l[2], s2); s3 = fmaf(x59, l[3], s3); } { const f32x4 l = *(const LAS f32x4*)(Lc + 3052); s0 = fmaf(x60, l[0], s0); s1 = fmaf(x61, l[1], s1); s2 = fmaf(x62, l[2], s2); s3 = fmaf(x63, l[3], s3); } x44 = (lane == 44) ? 1.0f : -((s0 + s1) + (s2 + s3)); asm volatile("" : "+v"(x44) : : "memory"); }
    { float s0 = 0.f, s1 = 0.f, s2 = 0.f, s3 = 0.f; { const f32x4 l = *(const LAS f32x4*)(Lc + 2968); s0 = fmaf(x44, l[0], s0); s1 = fmaf(x45, l[1], s1); s2 = fmaf(x46, l[2], s2); s3 = fmaf(x47, l[3], s3); } { const f32x4 l = *(const LAS f32x4*)(Lc + 2972); s0 = fmaf(x48, l[0], s0); s1 = fmaf(x49, l[1], s1); s2 = fmaf(x50, l[2], s2); s3 = fmaf(x51, l[3], s3); } { const f32x4 l = *(const LAS f32x4*)(Lc + 2976); s0 = fmaf(x52, l[0], s0); s1 = fmaf(x53, l[1], s1); s2 = fmaf(x54, l[2], s2); s3 = fmaf(x55, l[3], s3); } { const f32x4 l = *(const LAS f32x4*)(Lc + 2980); s0 = fmaf(x56, l[0], s0); s1 = fmaf(x57, l[1], s1); s2 = fmaf(x58, l[2], s2); s3 = fmaf(x59, l[3], s3); } { const f32x4 l = *(const LAS f32x4*)(Lc + 2984); s0 = fmaf(x60, l[0], s0); s1 = fmaf(x61, l[1], s1); s2 = fmaf(x62, l[2], s2); s3 = fmaf(x63, l[3], s3); } x43 = (lane == 43) ? 1.0f : -((s0 + s1) + (s2 + s3)); asm volatile("" : "+v"(x43) : : "memory"); }
    { float s0 = 0.f, s1 = 0.f, s2 = 0.f, s3 = 0.f; { const f32x4 l = *(const LAS f32x4*)(Lc + 2896); s3 = fmaf(x43, l[3], s3); } { const f32x4 l = *(const LAS f32x4*)(Lc + 2900); s0 = fmaf(x44, l[0], s0); s1 = fmaf(x45, l[1], s1); s2 = fmaf(x46, l[2], s2); s3 = fmaf(x47, l[3], s3); } { const f32x4 l = *(const LAS f32x4*)(Lc + 2904); s0 = fmaf(x48, l[0], s0); s1 = fmaf(x49, l[1], s1); s2 = fmaf(x50, l[2], s2); s3 = fmaf(x51, l[3], s3); } { const f32x4 l = *(const LAS f32x4*)(Lc + 2908); s0 = fmaf(x52, l[0], s0); s1 = fmaf(x53, l[1], s1); s2 = fmaf(x54, l[2], s2); s3 = fmaf(x55, l[3], s3); } { const f32x4 l = *(const LAS f32x4*)(Lc + 2912); s0 = fmaf(x56, l[0], s0); s1 = fmaf(x57, l[1], s1); s2 = fmaf(x58, l[2], s2); s3 = fmaf(x59, l[3], s3); } { const f32x4 l = *(const LAS f32x4*)(Lc + 2916); s0 = fmaf(x60, l[0], s0); s1 = fmaf(x61, l[1], s1); s2 = fmaf(x62, l[2], s2); s3 = fmaf(x63, l[3], s3); } x42 = (lane == 42) ? 1.0f : -((s0 + s1) + (s2 + s3)); asm volatile("" : "+v"(x42) : : "memory"); }
    { float s0 = 0.f, s1 = 0.f, s2 = 0.f, s3 = 0.f; { const f32x4 l = *(const LAS f32x4*)(Lc + 2828); s2 = fmaf(x42, l[2], s2); s3 = fmaf(x43, l[3], s3); } { const f32x4 l = *(const LAS f32x4*)(Lc + 2832); s0 = fmaf(x44, l[0], s0); s1 = fmaf(x45, l[1], s1); s2 = fmaf(x46, l[2], s2); s3 = fmaf(x47, l[3], s3); } { const f32x4 l = *(const LAS f32x4*)(Lc + 2836); s0 = fmaf(x48, l[0], s0); s1 = fmaf(x49, l[1], s1); s2 = fmaf(x50, l[2], s2); s3 = fmaf(x51, l[3], s3); } { const f32x4 l = *(const LAS f32x4*)(Lc + 2840); s0 = fmaf(x52, l[0], s0); s1 = fmaf(x53, l[1], s1); s2 = fmaf(x54, l[2], s2); s3 = fmaf(x55, l[3], s3); } { const f32x4 l = *(const LAS f32x4*)(Lc + 2844); s0 = fmaf(x56, l[0], s0); s1 = fmaf(x57, l[1], s1); s2 = fmaf(x58, l[2], s2); s3 = fmaf(x59, l[3], s3); } { const f32x4 l = *(const LAS f32x4*)(Lc + 2848); s0 = fmaf(x60, l[0], s0); s1 = fmaf(x61, l[1], s1); s2 = fmaf(x62, l[2], s2); s3 = fmaf(x63, l[3], s3); } x41 = (lane == 41) ? 1.0f : -((s0 + s1) + (s2 + s3)); asm volatile("" : "+v"(x41) : : "memory"); }
    { float s0 = 0.f, s1 = 0.f, s2 = 0.f, s3 = 0.f; { const f32x4 l = *(const LAS f32x4*)(Lc + 2760); s1 = fmaf(x41, l[1], s1); s2 = fmaf(x42, l[2], s2); s3 = fmaf(x43, l[3], s3); } { const f32x4 l = *(const LAS f32x4*)(Lc + 2764); s0 = fmaf(x44, l[0], s0); s1 = fmaf(x45, l[1], s1); s2 = fmaf(x46, l[2], s2); s3 = fmaf(x47, l[3], s3); } { const f32x4 l = *(const LAS f32x4*)(Lc + 2768); s0 = fmaf(x48, l[0], s0); s1 = fmaf(x49, l[1], s1); s2 = fmaf(x50, l[2], s2); s3 = fmaf(x51, l[3], s3); } { const f32x4 l = *(const LAS f32x4*)(Lc + 2772); s0 = fmaf(x52, l[0], s0); s1 = fmaf(x53, l[1], s1); s2 = fmaf(x54, l[2], s2); s3 = fmaf(x55, l[3], s3); } { const f32x4 l = *(const LAS f32x4*)(Lc + 2776); s0 = fmaf(x56, l[0], s0); s1 = fmaf(x57, l[1], s1); s2 = fmaf(x58, l[2], s2); s3 = fmaf(x59, l[3], s3); } { const f32x4 l = *(const LAS f32x4*)(Lc + 2780); s0 = fmaf(x60, l[0], s0); s1 = fmaf(x61, l[1], s1); s2 = fmaf(x62, l[2], s2); s3 = fmaf(x63, l[3], s3); } x40 = (lane == 40) ? 1.0f : -((s0 + s1) + (s2 + s3)); asm volatile("" : "+v"(x40) : : "memory"); }
    { float s0 = 0.f, s1 = 0.f, s2 = 0.f, s3 = 0.f; { const f32x4 l = *(const LAS f32x4*)(Lc + 2692); s0 = fmaf(x40, l[0], s0); s1 = fmaf(x41, l[1], s1); s2 = fmaf(x42, l[2], s2); s3 = fmaf(x43, l[3], s3); } { const f32x4 l = *(const LAS f32x4*)(Lc + 2696); s0 = fmaf(x44, l[0], s0); s1 = fmaf(x45, l[1], s1); s2 = fmaf(x46, l[2], s2); s3 = fmaf(x47, l[3], s3); } { const f32x4 l = *(const LAS f32x4*)(Lc + 2700); s0 = fmaf(x48, l[0], s0); s1 = fmaf(x49, l[1], s1); s2 = fmaf(x50, l[2], s2); s3 = fmaf(x51, l[3], s3); } { const f32x4 l = *(const LAS f32x4*)(Lc + 2704); s0 = fmaf(x52, l[0], s0); s1 = fmaf(x53, l[1], s1); s2 = fmaf(x54, l[2], s2); s3 = fmaf(x55, l[3], s3); } { const f32x4 l = *(const LAS f32x4*)(Lc + 2708); s0 = fmaf(x56, l[0], s0); s1 = fmaf(x57, l[1], s1); s2 = fmaf(x58, l[2], s2); s3 = fmaf(x59, l[3], s3); } { const f32x4 l = *(const LAS f32x4*)(Lc + 2712); s0 = fmaf(x60, l[0], s0); s1 = fmaf(x61, l[1], s1); s2 = fmaf(x62, l[2], s2); s3 = fmaf(x63, l[3], s3); } x39 = (lane == 39) ? 1.0f : -((s0 + s1) + (s2 + s3)); asm volatile("" : "+v"(x39) : : "memory"); }
    { float s0 = 0.f, s1 = 0.f, s2 = 0.f, s3 = 0.f; { const f32x4 l = *(const LAS f32x4*)(Lc + 2620); s3 = fmaf(x39, l[3], s3); } { const f32x4 l = *(const LAS f32x4*)(Lc + 2624); s0 = fmaf(x40, l[0], s0); s1 = fmaf(x41, l[1], s1); s2 = fmaf(x42, l[2], s2); s3 = fmaf(x43, l[3], s3); } { const f32x4 l = *(const LAS f32x4*)(Lc + 2628); s0 = fmaf(x44, l[0], s0); s1 = fmaf(x45, l[1], s1); s2 = fmaf(x46, l[2], s2); s3 = fmaf(x47, l[3], s3); } { const f32x4 l = *(const LAS f32x4*)(Lc + 2632); s0 = fmaf(x48, l[0], s0); s1 = fmaf(x49, l[1], s1); s2 = fmaf(x50, l[2], s2); s3 = fmaf(x51, l[3], s3); } { const f32x4 l = *(const LAS f32x4*)(Lc + 2636); s0 = fmaf(x52, l[0], s0); s1 = fmaf(x53, l[1], s1); s2 = fmaf(x54, l[2], s2); s3 = fmaf(x55, l[3], s3); } { const f32x4 l = *(const LAS f32x4*)(Lc + 2640); s0 = fmaf(x56, l[0], s0); s1 = fmaf(x57, l[1], s1); s2 = fmaf(x58, l[2], s2); s3 = fmaf(x59, l[3], s3); } { const f32x4 l = *(const LAS f32x4*)(Lc + 2644); s0 = fmaf(x60, l[0], s0); s1 = fmaf(x61, l[1], s1); s2 = fmaf(x62, l[2], s2); s3 = fmaf(x63, l[3], s3); } x38 = (lane == 38) ? 1.0f : -((s0 + s1) + (s2 + s3)); asm volatile("" : "+v"(x38) : : "memory"); }
    { float s0 = 0.f, s1 = 0.f, s2 = 0.f, s3 = 0.f; { const f32x4 l = *(const LAS f32x4*)(Lc + 2552); s2 = fmaf(x38, l[2], s2); s3 = fmaf(x39, l[3], s3); } { const f32x4 l = *(const LAS f32x4*)(Lc + 2556); s0 = fmaf(x40, l[0], s0); s1 = fmaf(x41, l[1], s1); s2 = fmaf(x42, l[2], s2); s3 = fmaf(x43, l[3], s3); } { const f32x4 l = *(const LAS f32x4*)(Lc + 2560); s0 = fmaf(x44, l[0], s0); s1 = fmaf(x45, l[1], s1); s2 = fmaf(x46, l[2], s2); s3 = fmaf(x47, l[3], s3); } { const f32x4 l = *(const LAS f32x4*)(Lc + 2564); s0 = fmaf(x48, l[0], s0); s1 = fmaf(x49, l[1], s1); s2 = fmaf(x50, l[2], s2); s3 = fmaf(x51, l[3], s3); } { const f32x4 l = *(const LAS f32x4*)(Lc + 2568); s0 = fmaf(x52, l[0], s0); s1 = fmaf(x53, l[1], s1); s2 = fmaf(x54, l[2], s2); s3 = fmaf(x55, l[3], s3); } { const f32x4 l = *(const LAS f32x4*)(Lc + 2572); s0 = fmaf(x56, l[0], s0); s1 = fmaf(x57, l[1], s1); s2 = fmaf(x58, l[2], s2); s3 = fmaf(x59, l[3], s3); } { const f32x4 l = *(const LAS f32x4*)(Lc + 2576); s0 = fmaf(x60, l[0], s0); s1 = fmaf(x61, l[1], s1); s2 = fmaf(x62, l[2], s2); s3 = fmaf(x63, l[3], s3); } x37 = (lane == 37) ? 1.0f : -((s0 + s1) + (s2 + s3)); asm volatile("" : "+v"(x37) : : "memory"); }
    { float s0 = 0.f, s1 = 0.f, s2 = 0.f, s3 = 0.f; { const f32x4 l = *(const LAS f32x4*)(Lc + 2484); s1 = fmaf(x37, l[1], s1); s2 = fmaf(x38, l[2], s2); s3 = fmaf(x39, l[3], s3); } { const f32x4 l = *(const LAS f32x4*)(Lc + 2488); s0 = fmaf(x40, l[0], s0); s1 = fmaf(x41, l[1], s1); s2 = fmaf(x42, l[2], s2); s3 = fmaf(x43, l[3], s3); } { const f32x4 l = *(const LAS f32x4*)(Lc + 2492); s0 = fmaf(x44, l[0], s0); s1 = fmaf(x45, l[1], s1); s2 = fmaf(x46, l[2], s2); s3 = fmaf(x47, l[3], s3); } { const f32x4 l = *(const LAS f32x4*)(Lc + 2496); s0 = fmaf(x48, l[0], s0); s1 = fmaf(x49, l[1], s1); s2 = fmaf(x50, l[2], s2); s3 = fmaf(x51, l[3], s3); } { const f32x4 l = *(const LAS f32x4*)(Lc + 2500); s0 = fmaf(x52, l[0], s0); s1 = fmaf(x53, l[1], s1); s2 = fmaf(x54, l[2], s2); s3 = fmaf(x55, l[3], s3); } { const f32x4 l = *(const LAS f32x4*)(Lc + 2504); s0 = fmaf(x56, l[0], s0); s1 = fmaf(x57, l[1], s1); s2 = fmaf(x58, l[2], s2); s3 = fmaf(x59, l[3], s3); } { const f32x4 l = *(const LAS f32x4*)(Lc + 2508); s0 = fmaf(x60, l[0], s0); s1 = fmaf(x61, l[1], s1); s2 = fmaf(x62, l[2], s2); s3 = fmaf(x63, l[3], s3); } x36 = (lane == 36) ? 1.0f : -((s0 + s1) + (s2 + s3)); asm volatile("" : "+v"(x36) : : "memory"); }
    { float s0 = 0.f, s1 = 0.f, s2 = 0.f, s3 = 0.f; { const f32x4 l = *(const LAS f32x4*)(Lc + 2416); s0 = fmaf(x36, l[0], s0); s1 = fmaf(x37, l[1], s1); s2 = fmaf(x38, l[2], s2); s3 = fmaf(x39, l[3], s3); } { const f32x4 l = *(const LAS f32x4*)(Lc + 2420); s0 = fmaf(x40, l[0], s0); s1 = fmaf(x41, l[1], s1); s2 = fmaf(x42, l[2], s2); s3 = fmaf(x43, l[3], s3); } { const f32x4 l = *(const LAS f32x4*)(Lc + 2424); s0 = fmaf(x44, l[0], s0); s1 = fmaf(x45, l[1], s1); s2 = fmaf(x46, l[2], s2); s3 = fmaf(x47, l[3], s3); } { const f32x4 l = *(const LAS f32x4*)(Lc + 2428); s0 = fmaf(x48, l[0], s0); s1 = fmaf(x49, l[1], s1); s2 = fmaf(x50, l[2], s2); s3 = fmaf(x51, l[3], s3); } { const f32x4 l = *(const LAS f32x4*)(Lc + 2432); s0 = fmaf(x52, l[0], s0); s1 = fmaf(x53, l[1], s1); s2 = fmaf(x54, l[2], s2); s3 = fmaf(x55, l[3], s3); } { const f32x4 l = *(const LAS f32x4*)(Lc + 2436); s0 = fmaf(x56, l[0], s0); s1 = fmaf(x57, l[1], s1); s2 = fmaf(x58, l[2], s2); s3 = fmaf(x59, l[3], s3); } { const f32x4 l = *(const LAS f32x4*)(Lc + 2440); s0 = fmaf(x60, l[0], s0); s1 = fmaf(x61, l[1], s1); s2 = fmaf(x62, l[2], s2); s3 = fmaf(x63, l[3], s3); } x35 = (lane == 35) ? 1.0f : -((s0 + s1) + (s2 + s3)); asm volatile("" : "+v"(x35) : : "memory"); }
    { float s0 = 0.f, s1 = 0.f, s2 = 0.f, s3 = 0.f; { const f32x4 l = *(const LAS f32x4*)(Lc + 2344); s3 = fmaf(x35, l[3], s3); } { const f32x4 l = *(const LAS f32x4*)(Lc + 2348); s0 = fmaf(x36, l[0], s0); s1 = fmaf(x37, l[1], s1); s2 = fmaf(x38, l[2], s2); s3 = fmaf(x39, l[3], s3); } { const f32x4 l = *(const LAS f32x4*)(Lc + 2352); s0 = fmaf(x40, l[0], s0); s1 = fmaf(x41, l[1], s1); s2 = fmaf(x42, l[2], s2); s3 = fmaf(x43, l[3], s3); } { const f32x4 l = *(const LAS f32x4*)(Lc + 2356); s0 = fmaf(x44, l[0], s0); s1 = fmaf(x45, l[1], s1); s2 = fmaf(x46, l[2], s2); s3 = fmaf(x47, l[3], s3); } { const f32x4 l = *(const LAS f32x4*)(Lc + 2360); s0 = fmaf(x48, l[0], s0); s1 = fmaf(x49, l[1], s1); s2 = fmaf(x50, l[2], s2); s3 = fmaf(x51, l[3], s3); } { const f32x4 l = *(const LAS f32x4*)(Lc + 2364); s0 = fmaf(x52, l[0], s0); s1 = fmaf(x53, l[1], s1); s2 = fmaf(x54, l[2], s2); s3 = fmaf(x55, l[3], s3); } { const f32x4 l = *(const LAS f32x4*)(Lc + 2368); s0 = fmaf(x56, l[0], s0); s1 = fmaf(x57, l[1], s1); s2 = fmaf(x58, l[2], s2); s3 = fmaf(x59, l[3], s3); } { const f32x4 l = *(const LAS f32x4*)(Lc + 2372); s0 = fmaf(x60, l[0], s0); s1 = fmaf(x61, l[1], s1); s2 = fmaf(x62, l[2], s2); s3 = fmaf(x63, l[3], s3); } x34 = (lane == 34) ? 1.0f : -((s0 + s1) + (s2 + s3)); asm volatile("" : "+v"(x34) : : "memory"); }
    { float s0 = 0.f, s1 = 0.f, s2 = 0.f, s3 = 0.f; { const f32x4 l = *(const LAS f32x4*)(Lc + 2276); s2 = fmaf(x34, l[2], s2); s3 = fmaf(x35, l[3], s3); } { const f32x4 l = *(const LAS f32x4*)(Lc + 2280); s0 = fmaf(x36, l[0], s0); s1 = fmaf(x37, l[1], s1); s2 = fmaf(x38, l[2], s2); s3 = fmaf(x39, l[3], s3); } { const f32x4 l = *(const LAS f32x4*)(Lc + 2284); s0 = fmaf(x40, l[0], s0); s1 = fmaf(x41, l[1], s1); s2 = fmaf(x42, l[2], s2); s3 = fmaf(x43, l[3], s3); } { const f32x4 l = *(const LAS f32x4*)(Lc + 2288); s0 = fmaf(x44, l[0], s0); s1 = fmaf(x45, l[1], s1); s2 = fmaf(x46, l[2], s2); s3 = fmaf(x47, l[3], s3); } { const f32x4 l = *(const LAS f32x4*)(Lc + 2292); s0 = fmaf(x48, l[0], s0); s1 = fmaf(x49, l[1], s1); s2 = fmaf(x50, l[2], s2); s3 = fmaf(x51, l[3], s3); } { const f32x4 l = *(const LAS f32x4*)(Lc + 2296); s0 = fmaf(x52, l[0], s0); s1 = fmaf(x53, l[1], s1); s2 = fmaf(x54, l[2], s2); s3 = fmaf(x55, l[3], s3); } { const f32x4 l = *(const LAS f32x4*)(Lc + 2300); s0 = fmaf(x56, l[0], s0); s1 = fmaf(x57, l[1], s1); s2 = fmaf(x58, l[2], s2); s3 = fmaf(x59, l[3], s3); } { const f32x4 l = *(const LAS f32x4*)(Lc + 2304); s0 = fmaf(x60, l[0], s0); s1 = fmaf(x61, l[1], s1); s2 = fmaf(x62, l[2], s2); s3 = fmaf(x63, l[3], s3); } x33 = (lane == 33) ? 1.0f : -((s0 + s1) + (s2 + s3)); asm volatile("" : "+v"(x33) : : "memory"); }
    { float s0 = 0.f, s1 = 0.f, s2 = 0.f, s3 = 0.f; { const f32x4 l = *(const LAS f32x4*)(Lc + 2208); s1 = fmaf(x33, l[1], s1); s2 = fmaf(x34, l[2], s2); s3 = fmaf(x35, l[3], s3); } { const f32x4 l = *(const LAS f32x4*)(Lc + 2212); s0 = fmaf(x36, l[0], s0); s1 = fmaf(x37, l[1], s1); s2 = fmaf(x38, l[2], s2); s3 = fmaf(x39, l[3], s3); } { const f32x4 l = *(const LAS f32x4*)(Lc + 2216); s0 = fmaf(x40, l[0], s0); s1 = fmaf(x41, l[1], s1); s2 = fmaf(x42, l[2], s2); s3 = fmaf(x43, l[3], s3); } { const f32x4 l = *(const LAS f32x4*)(Lc + 2220); s0 = fmaf(x44, l[0], s0); s1 = fmaf(x45, l[1], s1); s2 = fmaf(x46, l[2], s2); s3 = fmaf(x47, l[3], s3); } { const f32x4 l = *(const LAS f32x4*)(Lc + 2224); s0 = fmaf(x48, l[0], s0); s1 = fmaf(x49, l[1], s1); s2 = fmaf(x50, l[2], s2); s3 = fmaf(x51, l[3], s3); } { const f32x4 l = *(const LAS f32x4*)(Lc + 2228); s0 = fmaf(x52, l[0], s0); s1 = fmaf(x53, l[1], s1); s2 = fmaf(x54, l[2], s2); s3 = fmaf(x55, l[3], s3); } { const f32x4 l = *(const LAS f32x4*)(Lc + 2232); s0 = fmaf(x56, l[0], s0); s1 = fmaf(x57, l[1], s1); s2 = fmaf(x58, l[2], s2); s3 = fmaf(x59, l[3], s3); } { const f32x4 l = *(const LAS f32x4*)(Lc + 2236); s0 = fmaf(x60, l[0], s0); s1 = fmaf(x61, l[1], s1); s2 = fmaf(x62, l[2], s2); s3 = fmaf(x63, l[3], s3); } x32 = (lane == 32) ? 1.0f : -((s0 + s1) + (s2 + s3)); asm volatile("" : "+v"(x32) : : "memory"); }
    { float s0 = 0.f, s1 = 0.f, s2 = 0.f, s3 = 0.f; { const f32x4 l = *(const LAS f32x4*)(Lc + 2140); s0 = fmaf(x32, l[0], s0); s1 = fmaf(x33, l[1], s1); s2 = fmaf(x34, l[2], s2); s3 = fmaf(x35, l[3], s3); } { const f32x4 l = *(const LAS f32x4*)(Lc + 2144); s0 = fmaf(x36, l[0], s0); s1 = fmaf(x37, l[1], s1); s2 = fmaf(x38, l[2], s2); s3 = fmaf(x39, l[3], s3); } { const f32x4 l = *(const LAS f32x4*)(Lc + 2148); s0 = fmaf(x40, l[0], s0); s1 = fmaf(x41, l[1], s1); s2 = fmaf(x42, l[2], s2); s3 = fmaf(x43, l[3], s3); } { const f32x4 l = *(const LAS f32x4*)(Lc + 2152); s0 = fmaf(x44, l[0], s0); s1 = fmaf(x45, l[1], s1); s2 = fmaf(x46, l[2], s2); s3 = fmaf(x47, l[3], s3); } { const f32x4 l = *(const LAS f32x4*)(Lc + 2156); s0 = fmaf(x48, l[0], s0); s1 = fmaf(x49, l[1], s1); s2 = fmaf(x50, l[2], s2); s3 = fmaf(x51, l[3], s3); } { const f32x4 l = *(const LAS f32x4*)(Lc + 2160); s0 = fmaf(x52, l[0], s0); s1 = fmaf(x53, l[1], s1); s2 = fmaf(x54, l[2], s2); s3 = fmaf(x55, l[3], s3); } { const f32x4 l = *(const LAS f32x4*)(Lc + 2164); s0 = fmaf(x56, l[0], s0); s1 = fmaf(x57, l[1], s1); s2 = fmaf(x58, l[2], s2); s3 = fmaf(x59, l[3], s3); } { const f32x4 l = *(const LAS f32x4*)(Lc + 2168); s0 = fmaf(x60, l[0], s0); s1 = fmaf(x61, l[1], s1); s2 = fmaf(x62, l[2], s2); s3 = fmaf(x63, l[3], s3); } x31 = (lane == 31) ? 1.0f : -((s0 + s1) + (s2 + s3)); asm volatile("" : "+v"(x31) : : "memory"); }
    { float s0 = 0.f, s1 = 0.f, s2 = 0.f, s3 = 0.f; { const f32x4 l = *(const LAS f32x4*)(Lc + 2068); s3 = fmaf(x31, l[3], s3); } { const f32x4 l = *(const LAS f32x4*)(Lc + 2072); s0 = fmaf(x32, l[0], s0); s1 = fmaf(x33, l[1], s1); s2 = fmaf(x34, l[2], s2); s3 = fmaf(x35, l[3], s3); } { const f32x4 l = *(const LAS f32x4*)(Lc + 2076); s0 = fmaf(x36, l[0], s0); s1 = fmaf(x37, l[1], s1); s2 = fmaf(x38, l[2], s2); s3 = fmaf(x39, l[3], s3); } { const f32x4 l = *(const LAS f32x4*)(Lc + 2080); s0 = fmaf(x40, l[0], s0); s1 = fmaf(x41, l[1], s1); s2 = fmaf(x42, l[2], s2); s3 = fmaf(x43, l[3], s3); } { const f32x4 l = *(const LAS f32x4*)(Lc + 2084); s0 = fmaf(x44, l[0], s0); s1 = fmaf(x45, l[1], s1); s2 = fmaf(x46, l[2], s2); s3 = fmaf(x47, l[3], s3); } { const f32x4 l = *(const LAS f32x4*)(Lc + 2088); s0 = fmaf(x48, l[0], s0); s1 = fmaf(x49, l[1], s1); s2 = fmaf(x50, l[2], s2); s3 = fmaf(x51, l[3], s3); } { const f32x4 l = *(const LAS f32x4*)(Lc + 2092); s0 = fmaf(x52, l[0], s0); s1 = fmaf(x53, l[1], s1); s2 = fmaf(x54, l[2], s2); s3 = fmaf(x55, l[3], s3); } { const f32x4 l = *(const LAS f32x4*)(Lc + 2096); s0 = fmaf(x56, l[0], s0); s1 = fmaf(x57, l[1], s1); s2 = fmaf(x58, l[2], s2); s3 = fmaf(x59, l[3], s3); } { const f32x4 l = *(const LAS f32x4*)(Lc + 2100); s0 = fmaf(x60, l[0], s0); s1 = fmaf(x61, l[1], s1); s2 = fmaf(x62, l[2], s2); s3 = fmaf(x63, l[3], s3); } x30 = (lane == 30) ? 1.0f : -((s0 + s1) + (s2 + s3)); asm volatile("" : "+v"(x30) : : "memory"); }
    { float s0 = 0.f, s1 = 0.f, s2 = 0.f, s3 = 0.f; { const f32x4 l = *(const LAS f32x4*)(Lc + 2000); s2 = fmaf(x30, l[2], s2); s3 = fmaf(x31, l[3], s3); } { const f32x4 l = *(const LAS f32x4*)(Lc + 2004); s0 = fmaf(x32, l[0], s0); s1 = fmaf(x33, l[1], s1); s2 = fmaf(x34, l[2], s2); s3 = fmaf(x35, l[3], s3); } { const f32x4 l = *(const LAS f32x4*)(Lc + 2008); s0 = fmaf(x36, l[0], s0); s1 = fmaf(x37, l[1], s1); s2 = fmaf(x38, l[2], s2); s3 = fmaf(x39, l[3], s3); } { const f32x4 l = *(const LAS f32x4*)(Lc + 2012); s0 = fmaf(x40, l[0], s0); s1 = fmaf(x41, l[1], s1); s2 = fmaf(x42, l[2], s2); s3 = fmaf(x43, l[3], s3); } { const f32x4 l = *(const LAS f32x4*)(Lc + 2016); s0 = fmaf(x44, l[0], s0); s1 = fmaf(x45, l[1], s1); s2 = fmaf(x46, l[2], s2); s3 = fmaf(x47, l[3], s3); } { const f32x4 l = *(const LAS f32x4*)(Lc + 2020); s0 = fmaf(x48, l[0], s0); s1 = fmaf(x49, l[1], s1); s2 = fmaf(x50, l[2], s2); s3 = fmaf(x51, l[3], s3); } { const f32x4 l = *(const LAS f32x4*)(Lc + 2024); s0 = fmaf(x52, l[0], s0); s1 = fmaf(x53, l[1], s1); s2 = fmaf(x54, l[2], s2); s3 = fmaf(x55, l[3], s3); } { const f32x4 l = *(const LAS f32x4*)(Lc + 2028); s0 = fmaf(x56, l[0], s0); s1 = fmaf(x57, l[1], s1); s2 = fmaf(x58, l[2], s2); s3 = fmaf(x59, l[3], s3); } { const f32x4 l = *(const LAS f32x4*)(Lc + 2032); s0 = fmaf(x60, l[0], s0); s1 = fmaf(x61, l[1], s1); s2 = fmaf(x62, l[2], s2); s3 = fmaf(x63, l[3], s3); } x29 = (lane == 29) ? 1.0f : -((s0 + s1) + (s2 + s3)); asm volatile("" : "+v"(x29) : : "memory"); }
    { float s0 = 0.f, s1 = 0.f, s2 = 0.f, s3 = 0.f; { const f32x4 l = *(const LAS f32x4*)(Lc + 1932); s1 = fmaf(x29, l[1], s1); s2 = fmaf(x30, l[2], s2); s3 = fmaf(x31, l[3], s3); } { const f32x4 l = *(const LAS f32x4*)(Lc + 1936); s0 = fmaf(x32, l[0], s0); s1 = fmaf(x33, l[1], s1); s2 = fmaf(x34, l[2], s2); s3 = fmaf(x35, l[3], s3); } { const f32x4 l = *(const LAS f32x4*)(Lc + 1940); s0 = fmaf(x36, l[0], s0); s1 = fmaf(x37, l[1], s1); s2 = fmaf(x38, l[2], s2); s3 = fmaf(x39, l[3], s3); } { const f32x4 l = *(const LAS f32x4*)(Lc + 1944); s0 = fmaf(x40, l[0], s0); s1 = fmaf(x41, l[1], s1); s2 = fmaf(x42, l[2], s2); s3 = fmaf(x43, l[3], s3); } { const f32x4 l = *(const LAS f32x4*)(Lc + 1948); s0 = fmaf(x44, l[0], s0); s1 = fmaf(x45, l[1], s1); s2 = fmaf(x46, l[2], s2); s3 = fmaf(x47, l[3], s3); } { const f32x4 l = *(const LAS f32x4*)(Lc + 1952); s0 = fmaf(x48, l[0], s0); s1 = fmaf(x49, l[1], s1); s2 = fmaf(x50, l[2], s2); s3 = fmaf(x51, l[3], s3); } { const f32x4 l = *(const LAS f32x4*)(Lc + 1956); s0 = fmaf(x52, l[0], s0); s1 = fmaf(x53, l[1], s1); s2 = fmaf(x54, l[2], s2); s3 = fmaf(x55, l[3], s3); } { const f32x4 l = *(const LAS f32x4*)(Lc + 1960); s0 = fmaf(x56, l[0], s0); s1 = fmaf(x57, l[1], s1); s2 = fmaf(x58, l[2], s2); s3 = fmaf(x59, l[3], s3); } { const f32x4 l = *(const LAS f32x4*)(Lc + 1964); s0 = fmaf(x60, l[0], s0); s1 = fmaf(x61, l[1], s1); s2 = fmaf(x62, l[2], s2); s3 = fmaf(x63, l[3], s3); } x28 = (lane == 28) ? 1.0f : -((s0 + s1) + (s2 + s3)); asm volatile("" : "+v"(x28) : : "memory"); }
    { float s0 = 0.f, s1 = 0.f, s2 = 0.f, s3 = 0.f; { const f32x4 l = *(const LAS f32x4*)(Lc + 1864); s0 = fmaf(x28, l[0], s0); s1 = fmaf(x29, l[1], s1); s2 = fmaf(x30, l[2], s2); s3 = fmaf(x31, l[3], s3); } { const f32x4 l = *(const LAS f32x4*)(Lc + 1868); s0 = fmaf(x32, l[0], s0); s1 = fmaf(x33, l[1], s1); s2 = fmaf(x34, l[2], s2); s3 = fmaf(x35, l[3], s3); } { const f32x4 l = *(const LAS f32x4*)(Lc + 1872); s0 = fmaf(x36, l[0], s0); s1 = fmaf(x37, l[1], s1); s2 = fmaf(x38, l[2], s2); s3 = fmaf(x39, l[3], s3); } { const f32x4 l = *(const LAS f32x4*)(Lc + 1876); s0 = fmaf(x40, l[0], s0); s1 = fmaf(x41, l[1], s1); s2 = fmaf(x42, l[2], s2); s3 = fmaf(x43, l[3], s3); } { const f32x4 l = *(const LAS f32x4*)(Lc + 1880); s0 = fmaf(x44, l[0], s0); s1 = fmaf(x45, l[1], s1); s2 = fmaf(x46, l[2], s2); s3 = fmaf(x47, l[3], s3); } { const f32x4 l = *(const LAS f32x4*)(Lc + 1884); s0 = fmaf(x48, l[0], s0); s1 = fmaf(x49, l[1], s1); s2 = fmaf(x50, l[2], s2); s3 = fmaf(x51, l[3], s3); } { const f32x4 l = *(const LAS f32x4*)(Lc + 1888); s0 = fmaf(x52, l[0], s0); s1 = fmaf(x53, l[1], s1); s2 = fmaf(x54, l[2], s2); s3 = fmaf(x55, l[3], s3); } { const f32x4 l = *(const LAS f32x4*)(Lc + 1892); s0 = fmaf(x56, l[0], s0); s1 = fmaf(x57, l[1], s1); s2 = fmaf(x58, l[2], s2); s3 = fmaf(x59, l[3], s3); } { const f32x4 l = *(const LAS f32x4*)(Lc + 1896); s0 = fmaf(x60, l[0], s0); s1 = fmaf(x61, l[1], s1); s2 = fmaf(x62, l[2], s2); s3 = fmaf(x63, l[3], s3); } x27 = (lane == 27) ? 1.0f : -((s0 + s1) + (s2 + s3)); asm volatile("" : "+v"(x27) : : "memory"); }
    { float s0 = 0.f, s1 = 0.f, s2 = 0.f, s3 = 0.f; { const f32x4 l = *(const LAS f32x4*)(Lc + 1792); s3 = fmaf(x27, l[3], s3); } { const f32x4 l = *(const LAS f32x4*)(Lc + 1796); s0 = fmaf(x28, l[0], s0); s1 = fmaf(x29, l[1], s1); s2 = fmaf(x30, l[2], s2); s3 = fmaf(x31, l[3], s3); } { const f32x4 l = *(const LAS f32x4*)(Lc + 1800); s0 = fmaf(x32, l[0], s0); s1 = fmaf(x33, l[1], s1); s2 = fmaf(x34, l[2], s2); s3 = fmaf(x35, l[3], s3); } { const f32x4 l = *(const LAS f32x4*)(Lc + 1804); s0 = fmaf(x36, l[0], s0); s1 = fmaf(x37, l[1], s1); s2 = fmaf(x38, l[2], s2); s3 = fmaf(x39, l[3], s3); } { const f32x4 l = *(const LAS f32x4*)(Lc + 1808); s0 = fmaf(x40, l[0], s0); s1 = fmaf(x41, l[1], s1); s2 = fmaf(x42, l[2], s2); s3 = fmaf(x43, l[3], s3); } { const f32x4 l = *(const LAS f32x4*)(Lc + 1812); s0 = fmaf(x44, l[0], s0); s1 = fmaf(x45, l[1], s1); s2 = fmaf(x46, l[2], s2); s3 = fmaf(x47, l[3], s3); } { const f32x4 l = *(const LAS f32x4*)(Lc + 1816); s0 = fmaf(x48, l[0], s0); s1 = fmaf(x49, l[1], s1); s2 = fmaf(x50, l[2], s2); s3 = fmaf(x51, l[3], s3); } { const f32x4 l = *(const LAS f32x4*)(Lc + 1820); s0 = fmaf(x52, l[0], s0); s1 = fmaf(x53, l[1], s1); s2 = fmaf(x54, l[2], s2); s3 = fmaf(x55, l[3], s3); } { const f32x4 l = *(const LAS f32x4*)(Lc + 1824); s0 = fmaf(x56, l[0], s0); s1 = fmaf(x57, l[1], s1); s2 = fmaf(x58, l[2], s2); s3 = fmaf(x59, l[3], s3); } { const f32x4 l = *(const LAS f32x4*)(Lc + 1828); s0 = fmaf(x60, l[0], s0); s1 = fmaf(x61, l[1], s1); s2 = fmaf(x62, l[2], s2); s3 = fmaf(x63, l[3], s3); } x26 = (lane == 26) ? 1.0f : -((s0 + s1) + (s2 + s3)); asm volatile("" : "+v"(x26) : : "memory"); }
    { float s0 = 0.f, s1 = 0.f, s2 = 0.f, s3 = 0.f; { const f32x4 l = *(const LAS f32x4*)(Lc + 1724); s2 = fmaf(x26, l[2], s2); s3 = fmaf(x27, l[3], s3); } { const f32x4 l = *(const LAS f32x4*)(Lc + 1728); s0 = fmaf(x28, l[0], s0); s1 = fmaf(x29, l[1], s1); s2 = fmaf(x30, l[2], s2); s3 = fmaf(x31, l[3], s3); } { const f32x4 l = *(const LAS f32x4*)(Lc + 1732); s0 = fmaf(x32, l[0], s0); s1 = fmaf(x33, l[1], s1); s2 = fmaf(x34, l[2], s2); s3 = fmaf(x35, l[3], s3); } { const f32x4 l = *(const LAS f32x4*)(Lc + 1736); s0 = fmaf(x36, l[0], s0); s1 = fmaf(x37, l[1], s1); s2 = fmaf(x38, l[2], s2); s3 = fmaf(x39, l[3], s3); } { const f32x4 l = *(const LAS f32x4*)(Lc + 1740); s0 = fmaf(x40, l[0], s0); s1 = fmaf(x41, l[1], s1); s2 = fmaf(x42, l[2], s2); s3 = fmaf(x43, l[3], s3); } { const f32x4 l = *(const LAS f32x4*)(Lc + 1744); s0 = fmaf(x44, l[0], s0); s1 = fmaf(x45, l[1], s1); s2 = fmaf(x46, l[2], s2); s3 = fmaf(x47, l[3], s3); } { const f32x4 l = *(const LAS f32x4*)(Lc + 1748); s0 = fmaf(x48, l[0], s0); s1 = fmaf(x49, l[1], s1); s2 = fmaf(x50, l[2], s2); s3 = fmaf(x51, l[3], s3); } { const f32x4 l = *(const LAS f32x4*)(Lc + 1752); s0 = fmaf(x52, l[0], s0); s1 = fmaf(x53, l[1], s1); s2 = fmaf(x54, l[2], s2); s3 = fmaf(x55, l[3], s3); } { const f32x4 l = *(const LAS f32x4*)(Lc + 1756); s0 = fmaf(x56, l[0], s0); s1 = fmaf(x57, l[1], s1); s2 = fmaf(x58, l[2], s2); s3 = fmaf(x59, l[3], s3); } { const f32x4 l = *(const LAS f32x4*)(Lc + 1760); s0 = fmaf(x60, l[0], s0); s1 = fmaf(x61, l[1], s1); s2 = fmaf(x62, l[2], s2); s3 = fmaf(x63, l[3], s3); } x25 = (lane == 25) ? 1.0f : -((s0 + s1) + (s2 + s3)); asm volatile("" : "+v"(x25) : : "memory"); }
    { float s0 = 0.f, s1 = 0.f, s2 = 0.f, s3 = 0.f; { const f32x4 l = *(const LAS f32x4*)(Lc + 1656); s1 = fmaf(x25, l[1], s1); s2 = fmaf(x26, l[2], s2); s3 = fmaf(x27, l[3], s3); } { const f32x4 l = *(const LAS f32x4*)(Lc + 1660); s0 = fmaf(x28, l[0], s0); s1 = fmaf(x29, l[1], s1); s2 = fmaf(x30, l[2], s2); s3 = fmaf(x31, l[3], s3); } { const f32x4 l = *(const LAS f32x4*)(Lc + 1664); s0 = fmaf(x32, l[0], s0); s1 = fmaf(x33, l[1], s1); s2 = fmaf(x34, l[2], s2); s3 = fmaf(x35, l[3], s3); } { const f32x4 l = *(const LAS f32x4*)(Lc + 1668); s0 = fmaf(x36, l[0], s0); s1 = fmaf(x37, l[1], s1); s2 = fmaf(x38, l[2], s2); s3 = fmaf(x39, l[3], s3); } { const f32x4 l = *(const LAS f32x4*)(Lc + 1672); s0 = fmaf(x40, l[0], s0); s1 = fmaf(x41, l[1], s1); s2 = fmaf(x42, l[2], s2); s3 = fmaf(x43, l[3], s3); } { const f32x4 l = *(const LAS f32x4*)(Lc + 1676); s0 = fmaf(x44, l[0], s0); s1 = fmaf(x45, l[1], s1); s2 = fmaf(x46, l[2], s2); s3 = fmaf(x47, l[3], s3); } { const f32x4 l = *(const LAS f32x4*)(Lc + 1680); s0 = fmaf(x48, l[0], s0); s1 = fmaf(x49, l[1], s1); s2 = fmaf(x50, l[2], s2); s3 = fmaf(x51, l[3], s3); } { const f32x4 l = *(const LAS f32x4*)(Lc + 1684); s0 = fmaf(x52, l[0], s0); s1 = fmaf(x53, l[1], s1); s2 = fmaf(x54, l[2], s2); s3 = fmaf(x55, l[3], s3); } { const f32x4 l = *(const LAS f32x4*)(Lc + 1688); s0 = fmaf(x56, l[0], s0); s1 = fmaf(x57, l[1], s1); s2 = fmaf(x58, l[2], s2); s3 = fmaf(x59, l[3], s3); } { const f32x4 l = *(const LAS f32x4*)(Lc + 1692); s0 = fmaf(x60, l[0], s0); s1 = fmaf(x61, l[1], s1); s2 = fmaf(x62, l[2], s2); s3 = fmaf(x63, l[3], s3); } x24 = (lane == 24) ? 1.0f : -((s0 + s1) + (s2 + s3)); asm volatile("" : "+v"(x24) : : "memory"); }
    { float s0 = 0.f, s1 = 0.f, s2 = 0.f, s3 = 0.f; { const f32x4 l = *(const LAS f32x4*)(Lc + 1588); s0 = fmaf(x24, l[0], s0); s1 = fmaf(x25, l[1], s1); s2 = fmaf(x26, l[2], s2); s3 = fmaf(x27, l[3], s3); } { const f32x4 l = *(const LAS f32x4*)(Lc + 1592); s0 = fmaf(x28, l[0], s0); s1 = fmaf(x29, l[1], s1); s2 = fmaf(x30, l[2], s2); s3 = fmaf(x31, l[3], s3); } { const f32x4 l = *(const LAS f32x4*)(Lc + 1596); s0 = fmaf(x32, l[0], s0); s1 = fmaf(x33, l[1], s1); s2 = fmaf(x34, l[2], s2); s3 = fmaf(x35, l[3], s3); } { const f32x4 l = *(const LAS f32x4*)(Lc + 1600); s0 = fmaf(x36, l[0], s0); s1 = fmaf(x37, l[1], s1); s2 = fmaf(x38, l[2], s2); s3 = fmaf(x39, l[3], s3); } { const f32x4 l = *(const LAS f32x4*)(Lc + 1604); s0 = fmaf(x40, l[0], s0); s1 = fmaf(x41, l[1], s1); s2 = fmaf(x42, l[2], s2); s3 = fmaf(x43, l[3], s3); } { const f32x4 l = *(const LAS f32x4*)(Lc + 1608); s0 = fmaf(x44, l[0], s0); s1 = fmaf(x45, l[1], s1); s2 = fmaf(x46, l[2], s2); s3 = fmaf(x47, l[3], s3); } { const f32x4 l = *(const LAS f32x4*)(Lc + 1612); s0 = fmaf(x48, l[0], s0); s1 = fmaf(x49, l[1], s1); s2 = fmaf(x50, l[2], s2); s3 = fmaf(x51, l[3], s3); } { const f32x4 l = *(const LAS f32x4*)(Lc + 1616); s0 = fmaf(x52, l[0], s0); s1 = fmaf(x53, l[1], s1); s2 = fmaf(x54, l[2], s2); s3 = fmaf(x55, l[3], s3); } { const f32x4 l = *(const LAS f32x4*)(Lc + 1620); s0 = fmaf(x56, l[0], s0); s1 = fmaf(x57, l[1], s1); s2 = fmaf(x58, l[2], s2); s3 = fmaf(x59, l[3], s3); } { const f32x4 l = *(const LAS f32x4*)(Lc + 1624); s0 = fmaf(x60, l[0], s0); s1 = fmaf(x61, l[1], s1); s2 = fmaf(x62, l[2], s2); s3 = fmaf(x63, l[3], s3); } x23 = (lane == 23) ? 1.0f : -((s0 + s1) + (s2 + s3)); asm volatile("" : "+v"(x23) : : "memory"); }
    { float s0 = 0.f, s1 = 0.f, s2 = 0.f, s3 = 0.f; { const f32x4 l = *(const LAS f32x4*)(Lc + 1516); s3 = fmaf(x23, l[3], s3); } { const f32x4 l = *(const LAS f32x4*)(Lc + 1520); s0 = fmaf(x24, l[0], s0); s1 = fmaf(x25, l[1], s1); s2 = fmaf(x26, l[2], s2); s3 = fmaf(x27, l[3], s3); } { const f32x4 l = *(const LAS f32x4*)(Lc + 1524); s0 = fmaf(x28, l[0], s0); s1 = fmaf(x29, l[1], s1); s2 = fmaf(x30, l[2], s2); s3 = fmaf(x31, l[3], s3); } { const f32x4 l = *(const LAS f32x4*)(Lc + 1528); s0 = fmaf(x32, l[0], s0); s1 = fmaf(x33, l[1], s1); s2 = fmaf(x34, l[2], s2); s3 = fmaf(x35, l[3], s3); } { const f32x4 l = *(const LAS f32x4*)(Lc + 1532); s0 = fmaf(x36, l[0], s0); s1 = fmaf(x37, l[1], s1); s2 = fmaf(x38, l[2], s2); s3 = fmaf(x39, l[3], s3); } { const f32x4 l = *(const LAS f32x4*)(Lc + 1536); s0 = fmaf(x40, l[0], s0); s1 = fmaf(x41, l[1], s1); s2 = fmaf(x42, l[2], s2); s3 = fmaf(x43, l[3], s3); } { const f32x4 l = *(const LAS f32x4*)(Lc + 1540); s0 = fmaf(x44, l[0], s0); s1 = fmaf(x45, l[1], s1); s2 = fmaf(x46, l[2], s2); s3 = fmaf(x47, l[3], s3); } { const f32x4 l = *(const LAS f32x4*)(Lc + 1544); s0 = fmaf(x48, l[0], s0); s1 = fmaf(x49, l[1], s1); s2 = fmaf(x50, l[2], s2); s3 = fmaf(x51, l[3], s3); } { const f32x4 l = *(const LAS f32x4*)(Lc + 1548); s0 = fmaf(x52, l[0], s0); s1 = fmaf(x53, l[1], s1); s2 = fmaf(x54, l[2], s2); s3 = fmaf(x55, l[3], s3); } { const f32x4 l = *(const LAS f32x4*)(Lc + 1552); s0 = fmaf(x56, l[0], s0); s1 = fmaf(x57, l[1], s1); s2 = fmaf(x58, l[2], s2); s3 = fmaf(x59, l[3], s3); } { const f32x4 l = *(const LAS f32x4*)(Lc + 1556); s0 = fmaf(x60, l[0], s0); s1 = fmaf(x61, l[1], s1); s2 = fmaf(x62, l[2], s2); s3 = fmaf(x63, l[3], s3); } x22 = (lane == 22) ? 1.0f : -((s0 + s1) + (s2 + s3)); asm volatile("" : "+v"(x22) : : "memory"); }
    { float s0 = 0.f, s1 = 0.f, s2 = 0.f, s3 = 0.f; { const f32x4 l = *(const LAS f32x4*)(Lc + 1448); s2 = fmaf(x22, l[2], s2); s3 = fmaf(x23, l[3], s3); } { const f32x4 l = *(const LAS f32x4*)(Lc + 1452); s0 = fmaf(x24, l[0], s0); s1 = fmaf(x25, l[1], s1); s2 = fmaf(x26, l[2], s2); s3 = fmaf(x27, l[3], s3); } { const f32x4 l = *(const LAS f32x4*)(Lc + 1456); s0 = fmaf(x28, l[0], s0); s1 = fmaf(x29, l[1], s1); s2 = fmaf(x30, l[2], s2); s3 = fmaf(x31, l[3], s3); } { const f32x4 l = *(const LAS f32x4*)(Lc + 1460); s0 = fmaf(x32, l[0], s0); s1 = fmaf(x33, l[1], s1); s2 = fmaf(x34, l[2], s2); s3 = fmaf(x35, l[3], s3); } { const f32x4 l = *(const LAS f32x4*)(Lc + 1464); s0 = fmaf(x36, l[0], s0); s1 = fmaf(x37, l[1], s1); s2 = fmaf(x38, l[2], s2); s3 = fmaf(x39, l[3], s3); } { const f32x4 l = *(const LAS f32x4*)(Lc + 1468); s0 = fmaf(x40, l[0], s0); s1 = fmaf(x41, l[1], s1); s2 = fmaf(x42, l[2], s2); s3 = fmaf(x43, l[3], s3); } { const f32x4 l = *(const LAS f32x4*)(Lc + 1472); s0 = fmaf(x44, l[0], s0); s1 = fmaf(x45, l[1], s1); s2 = fmaf(x46, l[2], s2); s3 = fmaf(x47, l[3], s3); } { const f32x4 l = *(const LAS f32x4*)(Lc + 1476); s0 = fmaf(x48, l[0], s0); s1 = fmaf(x49, l[1], s1); s2 = fmaf(x50, l[2], s2); s3 = fmaf(x51, l[3], s3); } { const f32x4 l = *(const LAS f32x4*)(Lc + 1480); s0 = fmaf(x52, l[0], s0); s1 = fmaf(x53, l[1], s1); s2 = fmaf(x54, l[2], s2); s3 = fmaf(x55, l[3], s3); } { const f32x4 l = *(const LAS f32x4*)(Lc + 1484); s0 = fmaf(x56, l[0], s0); s1 = fmaf(x57, l[1], s1); s2 = fmaf(x58, l[2], s2); s3 = fmaf(x59, l[3], s3); } { const f32x4 l = *(const LAS f32x4*)(Lc + 1488); s0 = fmaf(x60, l[0], s0); s1 = fmaf(x61, l[1], s1); s2 = fmaf(x62, l[2], s2); s3 = fmaf(x63, l[3], s3); } x21 = (lane == 21) ? 1.0f : -((s0 + s1) + (s2 + s3)); asm volatile("" : "+v"(x21) : : "memory"); }
    { float s0 = 0.f, s1 = 0.f, s2 = 0.f, s3 = 0.f; { const f32x4 l = *(const LAS f32x4*)(Lc + 1380); s1 = fmaf(x21, l[1], s1); s2 = fmaf(x22, l[2], s2); s3 = fmaf(x23, l[3], s3); } { const f32x4 l = *(const LAS f32x4*)(Lc + 1384); s0 = fmaf(x24, l[0], s0); s1 = fmaf(x25, l[1], s1); s2 = fmaf(x26, l[2], s2); s3 = fmaf(x27, l[3], s3); } { const f32x4 l = *(const LAS f32x4*)(Lc + 1388); s0 = fmaf(x28, l[0], s0); s1 = fmaf(x29, l[1], s1); s2 = fmaf(x30, l[2], s2); s3 = fmaf(x31, l[3], s3); } { const f32x4 l = *(const LAS f32x4*)(Lc + 1392); s0 = fmaf(x32, l[0], s0); s1 = fmaf(x33, l[1], s1); s2 = fmaf(x34, l[2], s2); s3 = fmaf(x35, l[3], s3); } { const f32x4 l = *(const LAS f32x4*)(Lc + 1396); s0 = fmaf(x36, l[0], s0); s1 = fmaf(x37, l[1], s1); s2 = fmaf(x38, l[2], s2); s3 = fmaf(x39, l[3], s3); } { const f32x4 l = *(const LAS f32x4*)(Lc + 1400); s0 = fmaf(x40, l[0], s0); s1 = fmaf(x41, l[1], s1); s2 = fmaf(x42, l[2], s2); s3 = fmaf(x43, l[3], s3); } { const f32x4 l = *(const LAS f32x4*)(Lc + 1404); s0 = fmaf(x44, l[0], s0); s1 = fmaf(x45, l[1], s1); s2 = fmaf(x46, l[2], s2); s3 = fmaf(x47, l[3], s3); } { const f32x4 l = *(const LAS f32x4*)(Lc + 1408); s0 = fmaf(x48, l[0], s0); s1 = fmaf(x49, l[1], s1); s2 = fmaf(x50, l[2], s2); s3 = fmaf(x51, l[3], s3); } { const f32x4 l = *(const LAS f32x4*)(Lc + 1412); s0 = fmaf(x52, l[0], s0); s1 = fmaf(x53, l[1], s1); s2 = fmaf(x54, l[2], s2); s3 = fmaf(x55, l[3], s3); } { const f32x4 l = *(const LAS f32x4*)(Lc + 1416); s0 = fmaf(x56, l[0], s0); s1 = fmaf(x57, l[1], s1); s2 = fmaf(x58, l[2], s2); s3 = fmaf(x59, l[3], s3); } { const f32x4 l = *(const LAS f32x4*)(Lc + 1420); s0 = fmaf(x60, l[0], s0); s1 = fmaf(x61, l[1], s1); s2 = fmaf(x62, l[2], s2); s3 = fmaf(x63, l[3], s3); } x20 = (lane == 20) ? 1.0f : -((s0 + s1) + (s2 + s3)); asm volatile("" : "+v"(x20) : : "memory"); }
    { float s0 = 0.f, s1 = 0.f, s2 = 0.f, s3 = 0.f; { const f32x4 l = *(const LAS f32x4*)(Lc + 1312); s0 = fmaf(x20, l[0], s0); s1 = fmaf(x21, l[1], s1); s2 = fmaf(x22, l[2], s2); s3 = fmaf(x23, l[3], s3); } { const f32x4 l = *(const LAS f32x4*)(Lc + 1316); s0 = fmaf(x24, l[0], s0); s1 = fmaf(x25, l[1], s1); s2 = fmaf(x26, l[2], s2); s3 = fmaf(x27, l[3], s3); } { const f32x4 l = *(const LAS f32x4*)(Lc + 1320); s0 = fmaf(x28, l[0], s0); s1 = fmaf(x29, l[1], s1); s2 = fmaf(x30, l[2], s2); s3 = fmaf(x31, l[3], s3); } { const f32x4 l = *(const LAS f32x4*)(Lc + 1324); s0 = fmaf(x32, l[0], s0); s1 = fmaf(x33, l[1], s1); s2 = fmaf(x34, l[2], s2); s3 = fmaf(x35, l[3], s3); } { const f32x4 l = *(const LAS f32x4*)(Lc + 1328); s0 = fmaf(x36, l[0], s0); s1 = fmaf(x37, l[1], s1); s2 = fmaf(x38, l[2], s2); s3 = fmaf(x39, l[3], s3); } { const f32x4 l = *(const LAS f32x4*)(Lc + 1332); s0 = fmaf(x40, l[0], s0); s1 = fmaf(x41, l[1], s1); s2 = fmaf(x42, l[2], s2); s3 = fmaf(x43, l[3], s3); } { const f32x4 l = *(const LAS f32x4*)(Lc + 1336); s0 = fmaf(x44, l[0], s0); s1 = fmaf(x45, l[1], s1); s2 = fmaf(x46, l[2], s2); s3 = fmaf(x47, l[3], s3); } { const f32x4 l = *(const LAS f32x4*)(Lc + 1340); s0 = fmaf(x48, l[0], s0); s1 = fmaf(x49, l[1], s1); s2 = fmaf(x50, l[2], s2); s3 = fmaf(x51, l[3], s3); } { const f32x4 l = *(const LAS f32x4*)(Lc + 1344); s0 = fmaf(x52, l[0], s0); s1 = fmaf(x53, l[1], s1); s2 = fmaf(x54, l[2], s2); s3 = fmaf(x55, l[3], s3); } { const f32x4 l = *(const LAS f32x4*)(Lc + 1348); s0 = fmaf(x56, l[0], s0); s1 = fmaf(x57, l[1], s1); s2 = fmaf(x58, l[2], s2); s3 = fmaf(x59, l[3], s3); } { const f32x4 l = *(const LAS f32x4*)(Lc + 1352); s0 = fmaf(x60, l[0], s0); s1 = fmaf(x61, l[1], s1); s2 = fmaf(x62, l[2], s2); s3 = fmaf(x63, l[3], s3); } x19 = (lane == 19) ? 1.0f : -((s0 + s1) + (s2 + s3)); asm volatile("" : "+v"(x19) : : "memory"); }
    { float s0 = 0.f, s1 = 0.f, s2 = 0.f, s3 = 0.f; { const f32x4 l = *(const LAS f32x4*)(Lc + 1240); s3 = fmaf(x19, l[3], s3); } { const f32x4 l = *(const LAS f32x4*)(Lc + 1244); s0 = fmaf(x20, l[0], s0); s1 = fmaf(x21, l[1], s1); s2 = fmaf(x22, l[2], s2); s3 = fmaf(x23, l[3], s3); } { const f32x4 l = *(const LAS f32x4*)(Lc + 1248); s0 = fmaf(x24, l[0], s0); s1 = fmaf(x25, l[1], s1); s2 = fmaf(x26, l[2], s2); s3 = fmaf(x27, l[3], s3); } { const f32x4 l = *(const LAS f32x4*)(Lc + 1252); s0 = fmaf(x28, l[0], s0); s1 = fmaf(x29, l[1], s1); s2 = fmaf(x30, l[2], s2); s3 = fmaf(x31, l[3], s3); } { const f32x4 l = *(const LAS f32x4*)(Lc + 1256); s0 = fmaf(x32, l[0], s0); s1 = fmaf(x33, l[1], s1); s2 = fmaf(x34, l[2], s2); s3 = fmaf(x35, l[3], s3); } { const f32x4 l = *(const LAS f32x4*)(Lc + 1260); s0 = fmaf(x36, l[0], s0); s1 = fmaf(x37, l[1], s1); s2 = fmaf(x38, l[2], s2); s3 = fmaf(x39, l[3], s3); } { const f32x4 l = *(const LAS f32x4*)(Lc + 1264); s0 = fmaf(x40, l[0], s0); s1 = fmaf(x41, l[1], s1); s2 = fmaf(x42, l[2], s2); s3 = fmaf(x43, l[3], s3); } { const f32x4 l = *(const LAS f32x4*)(Lc + 1268); s0 = fmaf(x44, l[0], s0); s1 = fmaf(x45, l[1], s1); s2 = fmaf(x46, l[2], s2); s3 = fmaf(x47, l[3], s3); } { const f32x4 l = *(const LAS f32x4*)(Lc + 1272); s0 = fmaf(x48, l[0], s0); s1 = fmaf(x49, l[1], s1); s2 = fmaf(x50, l[2], s2); s3 = fmaf(x51, l[3], s3); } { const f32x4 l = *(const LAS f32x4*)(Lc + 1276); s0 = fmaf(x52, l[0], s0); s1 = fmaf(x53, l[1], s1); s2 = fmaf(x54, l[2], s2); s3 = fmaf(x55, l[3], s3); } { const f32x4 l = *(const LAS f32x4*)(Lc + 1280); s0 = fmaf(x56, l[0], s0); s1 = fmaf(x57, l[1], s1); s2 = fmaf(x58, l[2], s2); s3 = fmaf(x59, l[3], s3); } { const f32x4 l = *(const LAS f32x4*)(Lc + 1284); s0 = fmaf(x60, l[0], s0); s1 = fmaf(x61, l[1], s1); s2 = fmaf(x62, l[2], s2); s3 = fmaf(x63, l[3], s3); } x18 = (lane == 18) ? 1.0f : -((s0 + s1) + (s2 + s3)); asm volatile("" : "+v"(x18) : : "memory"); }
    { float s0 = 0.f, s1 = 0.f, s2 = 0.f, s3 = 0.f; { const f32x4 l = *(const LAS f32x4*)(Lc + 1172); s2 = fmaf(x18, l[2], s2); s3 = fmaf(x19, l[3], s3); } { const f32x4 l = *(const LAS f32x4*)(Lc + 1176); s0 = fmaf(x20, l[0], s0); s1 = fmaf(x21, l[1], s1); s2 = fmaf(x22, l[2], s2); s3 = fmaf(x23, l[3], s3); } { const f32x4 l = *(const LAS f32x4*)(Lc + 1180); s0 = fmaf(x24, l[0], s0); s1 = fmaf(x25, l[1], s1); s2 = fmaf(x26, l[2], s2); s3 = fmaf(x27, l[3], s3); } { const f32x4 l = *(const LAS f32x4*)(Lc + 1184); s0 = fmaf(x28, l[0], s0); s1 = fmaf(x29, l[1], s1); s2 = fmaf(x30, l[2], s2); s3 = fmaf(x31, l[3], s3); } { const f32x4 l = *(const LAS f32x4*)(Lc + 1188); s0 = fmaf(x32, l[0], s0); s1 = fmaf(x33, l[1], s1); s2 = fmaf(x34, l[2], s2); s3 = fmaf(x35, l[3], s3); } { const f32x4 l = *(const LAS f32x4*)(Lc + 1192); s0 = fmaf(x36, l[0], s0); s1 = fmaf(x37, l[1], s1); s2 = fmaf(x38, l[2], s2); s3 = fmaf(x39, l[3], s3); } { const f32x4 l = *(const LAS f32x4*)(Lc + 1196); s0 = fmaf(x40, l[0], s0); s1 = fmaf(x41, l[1], s1); s2 = fmaf(x42, l[2], s2); s3 = fmaf(x43, l[3], s3); } { const f32x4 l = *(const LAS f32x4*)(Lc + 1200); s0 = fmaf(x44, l[0], s0); s1 = fmaf(x45, l[1], s1); s2 = fmaf(x46, l[2], s2); s3 = fmaf(x47, l[3], s3); } { const f32x4 l = *(const LAS f32x4*)(Lc + 1204); s0 = fmaf(x48, l[0], s0); s1 = fmaf(x49, l[1], s1); s2 = fmaf(x50, l[2], s2); s3 = fmaf(x51, l[3], s3); } { const f32x4 l = *(const LAS f32x4*)(Lc + 1208); s0 = fmaf(x52, l[0], s0); s1 = fmaf(x53, l[1], s1); s2 = fmaf(x54, l[2], s2); s3 = fmaf(x55, l[3], s3); } { const f32x4 l = *(const LAS f32x4*)(Lc + 1212); s0 = fmaf(x56, l[0], s0); s1 = fmaf(x57, l[1], s1); s2 = fmaf(x58, l[2], s2); s3 = fmaf(x59, l[3], s3); } { const f32x4 l = *(const LAS f32x4*)(Lc + 1216); s0 = fmaf(x60, l[0], s0); s1 = fmaf(x61, l[1], s1); s2 = fmaf(x62, l[2], s2); s3 = fmaf(x63, l[3], s3); } x17 = (lane == 17) ? 1.0f : -((s0 + s1) + (s2 + s3)); asm volatile("" : "+v"(x17) : : "memory"); }
    { float s0 = 0.f, s1 = 0.f, s2 = 0.f, s3 = 0.f; { const f32x4 l = *(const LAS f32x4*)(Lc + 1104); s1 = fmaf(x17, l[1], s1); s2 = fmaf(x18, l[2], s2); s3 = fmaf(x19, l[3], s3); } { const f32x4 l = *(const LAS f32x4*)(Lc + 1108); s0 = fmaf(x20, l[0], s0); s1 = fmaf(x21, l[1], s1); s2 = fmaf(x22, l[2], s2); s3 = fmaf(x23, l[3], s3); } { const f32x4 l = *(const LAS f32x4*)(Lc + 1112); s0 = fmaf(x24, l[0], s0); s1 = fmaf(x25, l[1], s1); s2 = fmaf(x26, l[2], s2); s3 = fmaf(x27, l[3], s3); } { const f32x4 l = *(const LAS f32x4*)(Lc + 1116); s0 = fmaf(x28, l[0], s0); s1 = fmaf(x29, l[1], s1); s2 = fmaf(x30, l[2], s2); s3 = fmaf(x31, l[3], s3); } { const f32x4 l = *(const LAS f32x4*)(Lc + 1120); s0 = fmaf(x32, l[0], s0); s1 = fmaf(x33, l[1], s1); s2 = fmaf(x34, l[2], s2); s3 = fmaf(x35, l[3], s3); } { const f32x4 l = *(const LAS f32x4*)(Lc + 1124); s0 = fmaf(x36, l[0], s0); s1 = fmaf(x37, l[1], s1); s2 = fmaf(x38, l[2], s2); s3 = fmaf(x39, l[3], s3); } { const f32x4 l = *(const LAS f32x4*)(Lc + 1128); s0 = fmaf(x40, l[0], s0); s1 = fmaf(x41, l[1], s1); s2 = fmaf(x42, l[2], s2); s3 = fmaf(x43, l[3], s3); } { const f32x4 l = *(const LAS f32x4*)(Lc + 1132); s0 = fmaf(x44, l[0], s0); s1 = fmaf(x45, l[1], s1); s2 = fmaf(x46, l[2], s2); s3 = fmaf(x47, l[3], s3); } { const f32x4 l = *(const LAS f32x4*)(Lc + 1136); s0 = fmaf(x48, l[0], s0); s1 = fmaf(x49, l[1], s1); s2 = fmaf(x50, l[2], s2); s3 = fmaf(x51, l[3], s3); } { const f32x4 l = *(const LAS f32x4*)(Lc + 1140); s0 = fmaf(x52, l[0], s0); s1 = fmaf(x53, l[1], s1); s2 = fmaf(x54, l[2], s2); s3 = fmaf(x55, l[3], s3); } { const f32x4 l = *(const LAS f32x4*)(Lc + 1144); s0 = fmaf(x56, l[0], s0); s1 = fmaf(x57, l[1], s1); s2 = fmaf(x58, l[2], s2); s3 = fmaf(x59, l[3], s3); } { const f32x4 l = *(const LAS f32x4*)(Lc + 1148); s0 = fmaf(x60, l[0], s0); s1 = fmaf(x61, l[1], s1); s2 = fmaf(x62, l[2], s2); s3 = fmaf(x63, l[3], s3); } x16 = (lane == 16) ? 1.0f : -((s0 + s1) + (s2 + s3)); asm volatile("" : "+v"(x16) : : "memory"); }
    { float s0 = 0.f, s1 = 0.f, s2 = 0.f, s3 = 0.f; { const f32x4 l = *(const LAS f32x4*)(Lc + 1036); s0 = fmaf(x16, l[0], s0); s1 = fmaf(x17, l[1], s1); s2 = fmaf(x18, l[2], s2); s3 = fmaf(x19, l[3], s3); } { const f32x4 l = *(const LAS f32x4*)(Lc + 1040); s0 = fmaf(x20, l[0], s0); s1 = fmaf(x21, l[1], s1); s2 = fmaf(x22, l[2], s2); s3 = fmaf(x23, l[3], s3); } { const f32x4 l = *(const LAS f32x4*)(Lc + 1044); s0 = fmaf(x24, l[0], s0); s1 = fmaf(x25, l[1], s1); s2 = fmaf(x26, l[2], s2); s3 = fmaf(x27, l[3], s3); } { const f32x4 l = *(const LAS f32x4*)(Lc + 1048); s0 = fmaf(x28, l[0], s0); s1 = fmaf(x29, l[1], s1); s2 = fmaf(x30, l[2], s2); s3 = fmaf(x31, l[3], s3); } { const f32x4 l = *(const LAS f32x4*)(Lc + 1052); s0 = fmaf(x32, l[0], s0); s1 = fmaf(x33, l[1], s1); s2 = fmaf(x34, l[2], s2); s3 = fmaf(x35, l[3], s3); } { const f32x4 l = *(const LAS f32x4*)(Lc + 1056); s0 = fmaf(x36, l[0], s0); s1 = fmaf(x37, l[1], s1); s2 = fmaf(x38, l[2], s2); s3 = fmaf(x39, l[3], s3); } { const f32x4 l = *(const LAS f32x4*)(Lc + 1060); s0 = fmaf(x40, l[0], s0); s1 = fmaf(x41, l[1], s1); s2 = fmaf(x42, l[2], s2); s3 = fmaf(x43, l[3], s3); } { const f32x4 l = *(const LAS f32x4*)(Lc + 1064); s0 = fmaf(x44, l[0], s0); s1 = fmaf(x45, l[1], s1); s2 = fmaf(x46, l[2], s2); s3 = fmaf(x47, l[3], s3); } { const f32x4 l = *(const LAS f32x4*)(Lc + 1068); s0 = fmaf(x48, l[0], s0); s1 = fmaf(x49, l[1], s1); s2 = fmaf(x50, l[2], s2); s3 = fmaf(x51, l[3], s3); } { const f32x4 l = *(const LAS f32x4*)(Lc + 1072); s0 = fmaf(x52, l[0], s0); s1 = fmaf(x53, l[1], s1); s2 = fmaf(x54, l[2], s2); s3 = fmaf(x55, l[3], s3); } { const f32x4 l = *(const LAS f32x4*)(Lc + 1076); s0 = fmaf(x56, l[0], s0); s1 = fmaf(x57, l[1], s1); s2 = fmaf(x58, l[2], s2); s3 = fmaf(x59, l[3], s3); } { const f32x4 l = *(const LAS f32x4*)(Lc + 1080); s0 = fmaf(x60, l[0], s0); s1 = fmaf(x61, l[1], s1); s2 = fmaf(x62, l[2], s2); s3 = fmaf(x63, l[3], s3); } x15 = (lane == 15) ? 1.0f : -((s0 + s1) + (s2 + s3)); asm volatile("" : "+v"(x15) : : "memory"); }
    { float s0 = 0.f, s1 = 0.f, s2 = 0.f, s3 = 0.f; { const f32x4 l = *(const LAS f32x4*)(Lc + 964); s3 = fmaf(x15, l[3], s3); } { const f32x4 l = *(const LAS f32x4*)(Lc + 968); s0 = fmaf(x16, l[0], s0); s1 = fmaf(x17, l[1], s1); s2 = fmaf(x18, l[2], s2); s3 = fmaf(x19, l[3], s3); } { const f32x4 l = *(const LAS f32x4*)(Lc + 972); s0 = fmaf(x20, l[0], s0); s1 = fmaf(x21, l[1], s1); s2 = fmaf(x22, l[2], s2); s3 = fmaf(x23, l[3], s3); } { const f32x4 l = *(const LAS f32x4*)(Lc + 976); s0 = fmaf(x24, l[0], s0); s1 = fmaf(x25, l[1], s1); s2 = fmaf(x26, l[2], s2); s3 = fmaf(x27, l[3], s3); } { const f32x4 l = *(const LAS f32x4*)(Lc + 980); s0 = fmaf(x28, l[0], s0); s1 = fmaf(x29, l[1], s1); s2 = fmaf(x30, l[2], s2); s3 = fmaf(x31, l[3], s3); } { const f32x4 l = *(const LAS f32x4*)(Lc + 984); s0 = fmaf(x32, l[0], s0); s1 = fmaf(x33, l[1], s1); s2 = fmaf(x34, l[2], s2); s3 = fmaf(x35, l[3], s3); } { const f32x4 l = *(const LAS f32x4*)(Lc + 988); s0 = fmaf(x36, l[0], s0); s1 = fmaf(x37, l[1], s1); s2 = fmaf(x38, l[2], s2); s3 = fmaf(x39, l[3], s3); } { const f32x4 l = *(const LAS f32x4*)(Lc + 992); s0 = fmaf(x40, l[0], s0); s1 = fmaf(x41, l[1], s1); s2 = fmaf(x42, l[2], s2); s3 = fmaf(x43, l[3], s3); } { const f32x4 l = *(const LAS f32x4*)(Lc + 996); s0 = fmaf(x44, l[0], s0); s1 = fmaf(x45, l[1], s1); s2 = fmaf(x46, l[2], s2); s3 = fmaf(x47, l[3], s3); } { const f32x4 l = *(const LAS f32x4*)(Lc + 1000); s0 = fmaf(x48, l[0], s0); s1 = fmaf(x49, l[1], s1); s2 = fmaf(x50, l[2], s2); s3 = fmaf(x51, l[3], s3); } { const f32x4 l = *(const LAS f32x4*)(Lc + 1004); s0 = fmaf(x52, l[0], s0); s1 = fmaf(x53, l[1], s1); s2 = fmaf(x54, l[2], s2); s3 = fmaf(x55, l[3], s3); } { const f32x4 l = *(const LAS f32x4*)(Lc + 1008); s0 = fmaf(x56, l[0], s0); s1 = fmaf(x57, l[1], s1); s2 = fmaf(x58, l[2], s2); s3 = fmaf(x59, l[3], s3); } { const f32x4 l = *(const LAS f32x4*)(Lc + 1012); s0 = fmaf(x60, l[0], s0); s1 = fmaf(x61, l[1], s1); s2 = fmaf(x62, l[2], s2); s3 = fmaf(x63, l[3], s3); } x14 = (lane == 14) ? 1.0f : -((s0 + s1) + (s2 + s3)); asm volatile("" : "+v"(x14) : : "memory"); }
    { float s0 = 0.f, s1 = 0.f, s2 = 0.f, s3 = 0.f; { const f32x4 l = *(const LAS f32x4*)(Lc + 896); s2 = fmaf(x14, l[2], s2); s3 = fmaf(x15, l[3], s3); } { const f32x4 l = *(const LAS f32x4*)(Lc + 900); s0 = fmaf(x16, l[0], s0); s1 = fmaf(x17, l[1], s1); s2 = fmaf(x18, l[2], s2); s3 = fmaf(x19, l[3], s3); } { const f32x4 l = *(const LAS f32x4*)(Lc + 904); s0 = fmaf(x20, l[0], s0); s1 = fmaf(x21, l[1], s1); s2 = fmaf(x22, l[2], s2); s3 = fmaf(x23, l[3], s3); } { const f32x4 l = *(const LAS f32x4*)(Lc + 908); s0 = fmaf(x24, l[0], s0); s1 = fmaf(x25, l[1], s1); s2 = fmaf(x26, l[2], s2); s3 = fmaf(x27, l[3], s3); } { const f32x4 l = *(const LAS f32x4*)(Lc + 912); s0 = fmaf(x28, l[0], s0); s1 = fmaf(x29, l[1], s1); s2 = fmaf(x30, l[2], s2); s3 = fmaf(x31, l[3], s3); } { const f32x4 l = *(const LAS f32x4*)(Lc + 916); s0 = fmaf(x32, l[0], s0); s1 = fmaf(x33, l[1], s1); s2 = fmaf(x34, l[2], s2); s3 = fmaf(x35, l[3], s3); } { const f32x4 l = *(const LAS f32x4*)(Lc + 920); s0 = fmaf(x36, l[0], s0); s1 = fmaf(x37, l[1], s1); s2 = fmaf(x38, l[2], s2); s3 = fmaf(x39, l[3], s3); } { const f32x4 l = *(const LAS f32x4*)(Lc + 924); s0 = fmaf(x40, l[0], s0); s1 = fmaf(x41, l[1], s1); s2 = fmaf(x42, l[2], s2); s3 = fmaf(x43, l[3], s3); } { const f32x4 l = *(const LAS f32x4*)(Lc + 928); s0 = fmaf(x44, l[0], s0); s1 = fmaf(x45, l[1], s1); s2 = fmaf(x46, l[2], s2); s3 = fmaf(x47, l[3], s3); } { const f32x4 l = *(const LAS f32x4*)(Lc + 932); s0 = fmaf(x48, l[0], s0); s1 = fmaf(x49, l[1], s1); s2 = fmaf(x50, l[2], s2); s3 = fmaf(x51, l[3], s3); } { const f32x4 l = *(const LAS f32x4*)(Lc + 936); s0 = fmaf(x52, l[0], s0); s1 = fmaf(x53, l[1], s1); s2 = fmaf(x54, l[2], s2); s3 = fmaf(x55, l[3], s3); } { const f32x4 l = *(const LAS f32x4*)(Lc + 940); s0 = fmaf(x56, l[0], s0); s1 = fmaf(x57, l[1], s1); s2 = fmaf(x58, l[2], s2); s3 = fmaf(x59, l[3], s3); } { const f32x4 l = *(const LAS f32x4*)(Lc + 944); s0 = fmaf(x60, l[0], s0); s1 = fmaf(x61, l[1], s1); s2 = fmaf(x62, l[2], s2); s3 = fmaf(x63, l[3], s3); } x13 = (lane == 13) ? 1.0f : -((s0 + s1) + (s2 + s3)); asm volatile("" : "+v"(x13) : : "memory"); }
    { float s0 = 0.f, s1 = 0.f, s2 = 0.f, s3 = 0.f; { const f32x4 l = *(const LAS f32x4*)(Lc + 828); s1 = fmaf(x13, l[1], s1); s2 = fmaf(x14, l[2], s2); s3 = fmaf(x15, l[3], s3); } { const f32x4 l = *(const LAS f32x4*)(Lc + 832); s0 = fmaf(x16, l[0], s0); s1 = fmaf(x17, l[1], s1); s2 = fmaf(x18, l[2], s2); s3 = fmaf(x19, l[3], s3); } { const f32x4 l = *(const LAS f32x4*)(Lc + 836); s0 = fmaf(x20, l[0], s0); s1 = fmaf(x21, l[1], s1); s2 = fmaf(x22, l[2], s2); s3 = fmaf(x23, l[3], s3); } { const f32x4 l = *(const LAS f32x4*)(Lc + 840); s0 = fmaf(x24, l[0], s0); s1 = fmaf(x25, l[1], s1); s2 = fmaf(x26, l[2], s2); s3 = fmaf(x27, l[3], s3); } { const f32x4 l = *(const LAS f32x4*)(Lc + 844); s0 = fmaf(x28, l[0], s0); s1 = fmaf(x29, l[1], s1); s2 = fmaf(x30, l[2], s2); s3 = fmaf(x31, l[3], s3); } { const f32x4 l = *(const LAS f32x4*)(Lc + 848); s0 = fmaf(x32, l[0], s0); s1 = fmaf(x33, l[1], s1); s2 = fmaf(x34, l[2], s2); s3 = fmaf(x35, l[3], s3); } { const f32x4 l = *(const LAS f32x4*)(Lc + 852); s0 = fmaf(x36, l[0], s0); s1 = fmaf(x37, l[1], s1); s2 = fmaf(x38, l[2], s2); s3 = fmaf(x39, l[3], s3); } { const f32x4 l = *(const LAS f32x4*)(Lc + 856); s0 = fmaf(x40, l[0], s0); s1 = fmaf(x41, l[1], s1); s2 = fmaf(x42, l[2], s2); s3 = fmaf(x43, l[3], s3); } { const f32x4 l = *(const LAS f32x4*)(Lc + 860); s0 = fmaf(x44, l[0], s0); s1 = fmaf(x45, l[1], s1); s2 = fmaf(x46, l[2], s2); s3 = fmaf(x47, l[3], s3); } { const f32x4 l = *(const LAS f32x4*)(Lc + 864); s0 = fmaf(x48, l[0], s0); s1 = fmaf(x49, l[1], s1); s2 = fmaf(x50, l[2], s2); s3 = fmaf(x51, l[3], s3); } { const f32x4 l = *(const LAS f32x4*)(Lc + 868); s0 = fmaf(x52, l[0], s0); s1 = fmaf(x53, l[1], s1); s2 = fmaf(x54, l[2], s2); s3 = fmaf(x55, l[3], s3); } { const f32x4 l = *(const LAS f32x4*)(Lc + 872); s0 = fmaf(x56, l[0], s0); s1 = fmaf(x57, l[1], s1); s2 = fmaf(x58, l[2], s2); s3 = fmaf(x59, l[3], s3); } { const f32x4 l = *(const LAS f32x4*)(Lc + 876); s0 = fmaf(x60, l[0], s0); s1 = fmaf(x61, l[1], s1); s2 = fmaf(x62, l[2], s2); s3 = fmaf(x63, l[3], s3); } x12 = (lane == 12) ? 1.0f : -((s0 + s1) + (s2 + s3)); asm volatile("" : "+v"(x12) : : "memory"); }
    { float s0 = 0.f, s1 = 0.f, s2 = 0.f, s3 = 0.f; { const f32x4 l = *(const LAS f32x4*)(Lc + 760); s0 = fmaf(x12, l[0], s0); s1 = fmaf(x13, l[1], s1); s2 = fmaf(x14, l[2], s2); s3 = fmaf(x15, l[3], s3); } { const f32x4 l = *(const LAS f32x4*)(Lc + 764); s0 = fmaf(x16, l[0], s0); s1 = fmaf(x17, l[1], s1); s2 = fmaf(x18, l[2], s2); s3 = fmaf(x19, l[3], s3); } { const f32x4 l = *(const LAS f32x4*)(Lc + 768); s0 = fmaf(x20, l[0], s0); s1 = fmaf(x21, l[1], s1); s2 = fmaf(x22, l[2], s2); s3 = fmaf(x23, l[3], s3); } { const f32x4 l = *(const LAS f32x4*)(Lc + 772); s0 = fmaf(x24, l[0], s0); s1 = fmaf(x25, l[1], s1); s2 = fmaf(x26, l[2], s2); s3 = fmaf(x27, l[3], s3); } { const f32x4 l = *(const LAS f32x4*)(Lc + 776); s0 = fmaf(x28, l[0], s0); s1 = fmaf(x29, l[1], s1); s2 = fmaf(x30, l[2], s2); s3 = fmaf(x31, l[3], s3); } { const f32x4 l = *(const LAS f32x4*)(Lc + 780); s0 = fmaf(x32, l[0], s0); s1 = fmaf(x33, l[1], s1); s2 = fmaf(x34, l[2], s2); s3 = fmaf(x35, l[3], s3); } { const f32x4 l = *(const LAS f32x4*)(Lc + 784); s0 = fmaf(x36, l[0], s0); s1 = fmaf(x37, l[1], s1); s2 = fmaf(x38, l[2], s2); s3 = fmaf(x39, l[3], s3); } { const f32x4 l = *(const LAS f32x4*)(Lc + 788); s0 = fmaf(x40, l[0], s0); s1 = fmaf(x41, l[1], s1); s2 = fmaf(x42, l[2], s2); s3 = fmaf(x43, l[3], s3); } { const f32x4 l = *(const LAS f32x4*)(Lc + 792); s0 = fmaf(x44, l[0], s0); s1 = fmaf(x45, l[1], s1); s2 = fmaf(x46, l[2], s2); s3 = fmaf(x47, l[3], s3); } { const f32x4 l = *(const LAS f32x4*)(Lc + 796); s0 = fmaf(x48, l[0], s0); s1 = fmaf(x49, l[1], s1); s2 = fmaf(x50, l[2], s2); s3 = fmaf(x51, l[3], s3); } { const f32x4 l = *(const LAS f32x4*)(Lc + 800); s0 = fmaf(x52, l[0], s0); s1 = fmaf(x53, l[1], s1); s2 = fmaf(x54, l[2], s2); s3 = fmaf(x55, l[3], s3); } { const f32x4 l = *(const LAS f32x4*)(Lc + 804); s0 = fmaf(x56, l[0], s0); s1 = fmaf(x57, l[1], s1); s2 = fmaf(x58, l[2], s2); s3 = fmaf(x59, l[3], s3); } { const f32x4 l = *(const LAS f32x4*)(Lc + 808); s0 = fmaf(x60, l[0], s0); s1 = fmaf(x61, l[1], s1); s2 = fmaf(x62, l[2], s2); s3 = fmaf(x63, l[3], s3); } x11 = (lane == 11) ? 1.0f : -((s0 + s1) + (s2 + s3)); asm volatile("" : "+v"(x11) : : "memory"); }
    { float s0 = 0.f, s1 = 0.f, s2 = 0.f, s3 = 0.f; { const f32x4 l = *(const LAS f32x4*)(Lc + 688); s3 = fmaf(x11, l[3], s3); } { const f32x4 l = *(const LAS f32x4*)(Lc + 692); s0 = fmaf(x12, l[0], s0); s1 = fmaf(x13, l[1], s1); s2 = fmaf(x14, l[2], s2); s3 = fmaf(x15, l[3], s3); } { const f32x4 l = *(const LAS f32x4*)(Lc + 696); s0 = fmaf(x16, l[0], s0); s1 = fmaf(x17, l[1], s1); s2 = fmaf(x18, l[2], s2); s3 = fmaf(x19, l[3], s3); } { const f32x4 l = *(const LAS f32x4*)(Lc + 700); s0 = fmaf(x20, l[0], s0); s1 = fmaf(x21, l[1], s1); s2 = fmaf(x22, l[2], s2); s3 = fmaf(x23, l[3], s3); } { const f32x4 l = *(const LAS f32x4*)(Lc + 704); s0 = fmaf(x24, l[0], s0); s1 = fmaf(x25, l[1], s1); s2 = fmaf(x26, l[2], s2); s3 = fmaf(x27, l[3], s3); } { const f32x4 l = *(const LAS f32x4*)(Lc + 708); s0 = fmaf(x28, l[0], s0); s1 = fmaf(x29, l[1], s1); s2 = fmaf(x30, l[2], s2); s3 = fmaf(x31, l[3], s3); } { const f32x4 l = *(const LAS f32x4*)(Lc + 712); s0 = fmaf(x32, l[0], s0); s1 = fmaf(x33, l[1], s1); s2 = fmaf(x34, l[2], s2); s3 = fmaf(x35, l[3], s3); } { const f32x4 l = *(const LAS f32x4*)(Lc + 716); s0 = fmaf(x36, l[0], s0); s1 = fmaf(x37, l[1], s1); s2 = fmaf(x38, l[2], s2); s3 = fmaf(x39, l[3], s3); } { const f32x4 l = *(const LAS f32x4*)(Lc + 720); s0 = fmaf(x40, l[0], s0); s1 = fmaf(x41, l[1], s1); s2 = fmaf(x42, l[2], s2); s3 = fmaf(x43, l[3], s3); } { const f32x4 l = *(const LAS f32x4*)(Lc + 724); s0 = fmaf(x44, l[0], s0); s1 = fmaf(x45, l[1], s1); s2 = fmaf(x46, l[2], s2); s3 = fmaf(x47, l[3], s3); } { const f32x4 l = *(const LAS f32x4*)(Lc + 728); s0 = fmaf(x48, l[0], s0); s1 = fmaf(x49, l[1], s1); s2 = fmaf(x50, l[2], s2); s3 = fmaf(x51, l[3], s3); } { const f32x4 l = *(const LAS f32x4*)(Lc + 732); s0 = fmaf(x52, l[0], s0); s1 = fmaf(x53, l[1], s1); s2 = fmaf(x54, l[2], s2); s3 = fmaf(x55, l[3], s3); } { const f32x4 l = *(const LAS f32x4*)(Lc + 736); s0 = fmaf(x56, l[0], s0); s1 = fmaf(x57, l[1], s1); s2 = fmaf(x58, l[2], s2); s3 = fmaf(x59, l[3], s3); } { const f32x4 l = *(const LAS f32x4*)(Lc + 740); s0 = fmaf(x60, l[0], s0); s1 = fmaf(x61, l[1], s1); s2 = fmaf(x62, l[2], s2); s3 = fmaf(x63, l[3], s3); } x10 = (lane == 10) ? 1.0f : -((s0 + s1) + (s2 + s3)); asm volatile("" : "+v"(x10) : : "memory"); }
    { float s0 = 0.f, s1 = 0.f, s2 = 0.f, s3 = 0.f; { const f32x4 l = *(const LAS f32x4*)(Lc + 620); s2 = fmaf(x10, l[2], s2); s3 = fmaf(x11, l[3], s3); } { const f32x4 l = *(const LAS f32x4*)(Lc + 624); s0 = fmaf(x12, l[0], s0); s1 = fmaf(x13, l[1], s1); s2 = fmaf(x14, l[2], s2); s3 = fmaf(x15, l[3], s3); } { const f32x4 l = *(const LAS f32x4*)(Lc + 628); s0 = fmaf(x16, l[0], s0); s1 = fmaf(x17, l[1], s1); s2 = fmaf(x18, l[2], s2); s3 = fmaf(x19, l[3], s3); } { const f32x4 l = *(const LAS f32x4*)(Lc + 632); s0 = fmaf(x20, l[0], s0); s1 = fmaf(x21, l[1], s1); s2 = fmaf(x22, l[2], s2); s3 = fmaf(x23, l[3], s3); } { const f32x4 l = *(const LAS f32x4*)(Lc + 636); s0 = fmaf(x24, l[0], s0); s1 = fmaf(x25, l[1], s1); s2 = fmaf(x26, l[2], s2); s3 = fmaf(x27, l[3], s3); } { const f32x4 l = *(const LAS f32x4*)(Lc + 640); s0 = fmaf(x28, l[0], s0); s1 = fmaf(x29, l[1], s1); s2 = fmaf(x30, l[2], s2); s3 = fmaf(x31, l[3], s3); } { const f32x4 l = *(const LAS f32x4*)(Lc + 644); s0 = fmaf(x32, l[0], s0); s1 = fmaf(x33, l[1], s1); s2 = fmaf(x34, l[2], s2); s3 = fmaf(x35, l[3], s3); } { const f32x4 l = *(const LAS f32x4*)(Lc + 648); s0 = fmaf(x36, l[0], s0); s1 = fmaf(x37, l[1], s1); s2 = fmaf(x38, l[2], s2); s3 = fmaf(x39, l[3], s3); } { const f32x4 l = *(const LAS f32x4*)(Lc + 652); s0 = fmaf(x40, l[0], s0); s1 = fmaf(x41, l[1], s1); s2 = fmaf(x42, l[2], s2); s3 = fmaf(x43, l[3], s3); } { const f32x4 l = *(const LAS f32x4*)(Lc + 656); s0 = fmaf(x44, l[0], s0); s1 = fmaf(x45, l[1], s1); s2 = fmaf(x46, l[2], s2); s3 = fmaf(x47, l[3], s3); } { const f32x4 l = *(const LAS f32x4*)(Lc + 660); s0 = fmaf(x48, l[0], s0); s1 = fmaf(x49, l[1], s1); s2 = fmaf(x50, l[2], s2); s3 = fmaf(x51, l[3], s3); } { const f32x4 l = *(const LAS f32x4*)(Lc + 664); s0 = fmaf(x52, l[0], s0); s1 = fmaf(x53, l[1], s1); s2 = fmaf(x54, l[2], s2); s3 = fmaf(x55, l[3], s3); } { const f32x4 l = *(const LAS f32x4*)(Lc + 668); s0 = fmaf(x56, l[0], s0); s1 = fmaf(x57, l[1], s1); s2 = fmaf(x58, l[2], s2); s3 = fmaf(x59, l[3], s3); } { const f32x4 l = *(const LAS f32x4*)(Lc + 672); s0 = fmaf(x60, l[0], s0); s1 = fmaf(x61, l[1], s1); s2 = fmaf(x62, l[2], s2); s3 = fmaf(x63, l[3], s3); } x9 = (lane == 9) ? 1.0f : -((s0 + s1) + (s2 + s3)); asm volatile("" : "+v"(x9) : : "memory"); }
    { float s0 = 0.f, s1 = 0.f, s2 = 0.f, s3 = 0.f; { const f32x4 l = *(const LAS f32x4*)(Lc + 552); s1 = fmaf(x9, l[1], s1); s2 = fmaf(x10, l[2], s2); s3 = fmaf(x11, l[3], s3); } { const f32x4 l = *(const LAS f32x4*)(Lc + 556); s0 = fmaf(x12, l[0], s0); s1 = fmaf(x13, l[1], s1); s2 = fmaf(x14, l[2], s2); s3 = fmaf(x15, l[3], s3); } { const f32x4 l = *(const LAS f32x4*)(Lc + 560); s0 = fmaf(x16, l[0], s0); s1 = fmaf(x17, l[1], s1); s2 = fmaf(x18, l[2], s2); s3 = fmaf(x19, l[3], s3); } { const f32x4 l = *(const LAS f32x4*)(Lc + 564); s0 = fmaf(x20, l[0], s0); s1 = fmaf(x21, l[1], s1); s2 = fmaf(x22, l[2], s2); s3 = fmaf(x23, l[3], s3); } { const f32x4 l = *(const LAS f32x4*)(Lc + 568); s0 = fmaf(x24, l[0], s0); s1 = fmaf(x25, l[1], s1); s2 = fmaf(x26, l[2], s2); s3 = fmaf(x27, l[3], s3); } { const f32x4 l = *(const LAS f32x4*)(Lc + 572); s0 = fmaf(x28, l[0], s0); s1 = fmaf(x29, l[1], s1); s2 = fmaf(x30, l[2], s2); s3 = fmaf(x31, l[3], s3); } { const f32x4 l = *(const LAS f32x4*)(Lc + 576); s0 = fmaf(x32, l[0], s0); s1 = fmaf(x33, l[1], s1); s2 = fmaf(x34, l[2], s2); s3 = fmaf(x35, l[3], s3); } { const f32x4 l = *(const LAS f32x4*)(Lc + 580); s0 = fmaf(x36, l[0], s0); s1 = fmaf(x37, l[1], s1); s2 = fmaf(x38, l[2], s2); s3 = fmaf(x39, l[3], s3); } { const f32x4 l = *(const LAS f32x4*)(Lc + 584); s0 = fmaf(x40, l[0], s0); s1 = fmaf(x41, l[1], s1); s2 = fmaf(x42, l[2], s2); s3 = fmaf(x43, l[3], s3); } { const f32x4 l = *(const LAS f32x4*)(Lc + 588); s0 = fmaf(x44, l[0], s0); s1 = fmaf(x45, l[1], s1); s2 = fmaf(x46, l[2], s2); s3 = fmaf(x47, l[3], s3); } { const f32x4 l = *(const LAS f32x4*)(Lc + 592); s0 = fmaf(x48, l[0], s0); s1 = fmaf(x49, l[1], s1); s2 = fmaf(x50, l[2], s2); s3 = fmaf(x51, l[3], s3); } { const f32x4 l = *(const LAS f32x4*)(Lc + 596); s0 = fmaf(x52, l[0], s0); s1 = fmaf(x53, l[1], s1); s2 = fmaf(x54, l[2], s2); s3 = fmaf(x55, l[3], s3); } { const f32x4 l = *(const LAS f32x4*)(Lc + 600); s0 = fmaf(x56, l[0], s0); s1 = fmaf(x57, l[1], s1); s2 = fmaf(x58, l[2], s2); s3 = fmaf(x59, l[3], s3); } { const f32x4 l = *(const LAS f32x4*)(Lc + 604); s0 = fmaf(x60, l[0], s0); s1 = fmaf(x61, l[1], s1); s2 = fmaf(x62, l[2], s2); s3 = fmaf(x63, l[3], s3); } x8 = (lane == 8) ? 1.0f : -((s0 + s1) + (s2 + s3)); asm volatile("" : "+v"(x8) : : "memory"); }
    { float s0 = 0.f, s1 = 0.f, s2 = 0.f, s3 = 0.f; { const f32x4 l = *(const LAS f32x4*)(Lc + 484); s0 = fmaf(x8, l[0], s0); s1 = fmaf(x9, l[1], s1); s2 = fmaf(x10, l[2], s2); s3 = fmaf(x11, l[3], s3); } { const f32x4 l = *(const LAS f32x4*)(Lc + 488); s0 = fmaf(x12, l[0], s0); s1 = fmaf(x13, l[1], s1); s2 = fmaf(x14, l[2], s2); s3 = fmaf(x15, l[3], s3); } { const f32x4 l = *(const LAS f32x4*)(Lc + 492); s0 = fmaf(x16, l[0], s0); s1 = fmaf(x17, l[1], s1); s2 = fmaf(x18, l[2], s2); s3 = fmaf(x19, l[3], s3); } { const f32x4 l = *(const LAS f32x4*)(Lc + 496); s0 = fmaf(x20, l[0], s0); s1 = fmaf(x21, l[1], s1); s2 = fmaf(x22, l[2], s2); s3 = fmaf(x23, l[3], s3); } { const f32x4 l = *(const LAS f32x4*)(Lc + 500); s0 = fmaf(x24, l[0], s0); s1 = fmaf(x25, l[1], s1); s2 = fmaf(x26, l[2], s2); s3 = fmaf(x27, l[3], s3); } { const f32x4 l = *(const LAS f32x4*)(Lc + 504); s0 = fmaf(x28, l[0], s0); s1 = fmaf(x29, l[1], s1); s2 = fmaf(x30, l[2], s2); s3 = fmaf(x31, l[3], s3); } { const f32x4 l = *(const LAS f32x4*)(Lc + 508); s0 = fmaf(x32, l[0], s0); s1 = fmaf(x33, l[1], s1); s2 = fmaf(x34, l[2], s2); s3 = fmaf(x35, l[3], s3); } { const f32x4 l = *(const LAS f32x4*)(Lc + 512); s0 = fmaf(x36, l[0], s0); s1 = fmaf(x37, l[1], s1); s2 = fmaf(x38, l[2], s2); s3 = fmaf(x39, l[3], s3); } { const f32x4 l = *(const LAS f32x4*)(Lc + 516); s0 = fmaf(x40, l[0], s0); s1 = fmaf(x41, l[1], s1); s2 = fmaf(x42, l[2], s2); s3 = fmaf(x43, l[3], s3); } { const f32x4 l = *(const LAS f32x4*)(Lc + 520); s0 = fmaf(x44, l[0], s0); s1 = fmaf(x45, l[1], s1); s2 = fmaf(x46, l[2], s2); s3 = fmaf(x47, l[3], s3); } { const f32x4 l = *(const LAS f32x4*)(Lc + 524); s0 = fmaf(x48, l[0], s0); s1 = fmaf(x49, l[1], s1); s2 = fmaf(x50, l[2], s2); s3 = fmaf(x51, l[3], s3); } { const f32x4 l = *(const LAS f32x4*)(Lc + 528); s0 = fmaf(x52, l[0], s0); s1 = fmaf(x53, l[1], s1); s2 = fmaf(x54, l[2], s2); s3 = fmaf(x55, l[3], s3); } { const f32x4 l = *(const LAS f32x4*)(Lc + 532); s0 = fmaf(x56, l[0], s0); s1 = fmaf(x57, l[1], s1); s2 = fmaf(x58, l[2], s2); s3 = fmaf(x59, l[3], s3); } { const f32x4 l = *(const LAS f32x4*)(Lc + 536); s0 = fmaf(x60, l[0], s0); s1 = fmaf(x61, l[1], s1); s2 = fmaf(x62, l[2], s2); s3 = fmaf(x63, l[3], s3); } x7 = (lane == 7) ? 1.0f : -((s0 + s1) + (s2 + s3)); asm volatile("" : "+v"(x7) : : "memory"); }
    { float s0 = 0.f, s1 = 0.f, s2 = 0.f, s3 = 0.f; { const f32x4 l = *(const LAS f32x4*)(Lc + 412); s3 = fmaf(x7, l[3], s3); } { const f32x4 l = *(const LAS f32x4*)(Lc + 416); s0 = fmaf(x8, l[0], s0); s1 = fmaf(x9, l[1], s1); s2 = fmaf(x10, l[2], s2); s3 = fmaf(x11, l[3], s3); } { const f32x4 l = *(const LAS f32x4*)(Lc + 420); s0 = fmaf(x12, l[0], s0); s1 = fmaf(x13, l[1], s1); s2 = fmaf(x14, l[2], s2); s3 = fmaf(x15, l[3], s3); } { const f32x4 l = *(const LAS f32x4*)(Lc + 424); s0 = fmaf(x16, l[0], s0); s1 = fmaf(x17, l[1], s1); s2 = fmaf(x18, l[2], s2); s3 = fmaf(x19, l[3], s3); } { const f32x4 l = *(const LAS f32x4*)(Lc + 428); s0 = fmaf(x20, l[0], s0); s1 = fmaf(x21, l[1], s1); s2 = fmaf(x22, l[2], s2); s3 = fmaf(x23, l[3], s3); } { const f32x4 l = *(const LAS f32x4*)(Lc + 432); s0 = fmaf(x24, l[0], s0); s1 = fmaf(x25, l[1], s1); s2 = fmaf(x26, l[2], s2); s3 = fmaf(x27, l[3], s3); } { const f32x4 l = *(const LAS f32x4*)(Lc + 436); s0 = fmaf(x28, l[0], s0); s1 = fmaf(x29, l[1], s1); s2 = fmaf(x30, l[2], s2); s3 = fmaf(x31, l[3], s3); } { const f32x4 l = *(const LAS f32x4*)(Lc + 440); s0 = fmaf(x32, l[0], s0); s1 = fmaf(x33, l[1], s1); s2 = fmaf(x34, l[2], s2); s3 = fmaf(x35, l[3], s3); } { const f32x4 l = *(const LAS f32x4*)(Lc + 444); s0 = fmaf(x36, l[0], s0); s1 = fmaf(x37, l[1], s1); s2 = fmaf(x38, l[2], s2); s3 = fmaf(x39, l[3], s3); } { const f32x4 l = *(const LAS f32x4*)(Lc + 448); s0 = fmaf(x40, l[0], s0); s1 = fmaf(x41, l[1], s1); s2 = fmaf(x42, l[2], s2); s3 = fmaf(x43, l[3], s3); } { const f32x4 l = *(const LAS f32x4*)(Lc + 452); s0 = fmaf(x44, l[0], s0); s1 = fmaf(x45, l[1], s1); s2 = fmaf(x46, l[2], s2); s3 = fmaf(x47, l[3], s3); } { const f32x4 l = *(const LAS f32x4*)(Lc + 456); s0 = fmaf(x48, l[0], s0); s1 = fmaf(x49, l[1], s1); s2 = fmaf(x50, l[2], s2); s3 = fmaf(x51, l[3], s3); } { const f32x4 l = *(const LAS f32x4*)(Lc + 460); s0 = fmaf(x52, l[0], s0); s1 = fmaf(x53, l[1], s1); s2 = fmaf(x54, l[2], s2); s3 = fmaf(x55, l[3], s3); } { const f32x4 l = *(const LAS f32x4*)(Lc + 464); s0 = fmaf(x56, l[0], s0); s1 = fmaf(x57, l[1], s1); s2 = fmaf(x58, l[2], s2); s3 = fmaf(x59, l[3], s3); } { const f32x4 l = *(const LAS f32x4*)(Lc + 468); s0 = fmaf(x60, l[0], s0); s1 = fmaf(x61, l[1], s1); s2 = fmaf(x62, l[2], s2); s3 = fmaf(x63, l[3], s3); } x6 = (lane == 6) ? 1.0f : -((s0 + s1) + (s2 + s3)); asm volatile("" : "+v"(x6) : : "memory"); }
    { float s0 = 0.f, s1 = 0.f, s2 = 0.f, s3 = 0.f; { const f32x4 l = *(const LAS f32x4*)(Lc + 344); s2 = fmaf(x6, l[2], s2); s3 = fmaf(x7, l[3], s3); } { const f32x4 l = *(const LAS f32x4*)(Lc + 348); s0 = fmaf(x8, l[0], s0); s1 = fmaf(x9, l[1], s1); s2 = fmaf(x10, l[2], s2); s3 = fmaf(x11, l[3], s3); } { const f32x4 l = *(const LAS f32x4*)(Lc + 352); s0 = fmaf(x12, l[0], s0); s1 = fmaf(x13, l[1], s1); s2 = fmaf(x14, l[2], s2); s3 = fmaf(x15, l[3], s3); } { const f32x4 l = *(const LAS f32x4*)(Lc + 356); s0 = fmaf(x16, l[0], s0); s1 = fmaf(x17, l[1], s1); s2 = fmaf(x18, l[2], s2); s3 = fmaf(x19, l[3], s3); } { const f32x4 l = *(const LAS f32x4*)(Lc + 360); s0 = fmaf(x20, l[0], s0); s1 = fmaf(x21, l[1], s1); s2 = fmaf(x22, l[2], s2); s3 = fmaf(x23, l[3], s3); } { const f32x4 l = *(const LAS f32x4*)(Lc + 364); s0 = fmaf(x24, l[0], s0); s1 = fmaf(x25, l[1], s1); s2 = fmaf(x26, l[2], s2); s3 = fmaf(x27, l[3], s3); } { const f32x4 l = *(const LAS f32x4*)(Lc + 368); s0 = fmaf(x28, l[0], s0); s1 = fmaf(x29, l[1], s1); s2 = fmaf(x30, l[2], s2); s3 = fmaf(x31, l[3], s3); } { const f32x4 l = *(const LAS f32x4*)(Lc + 372); s0 = fmaf(x32, l[0], s0); s1 = fmaf(x33, l[1], s1); s2 = fmaf(x34, l[2], s2); s3 = fmaf(x35, l[3], s3); } { const f32x4 l = *(const LAS f32x4*)(Lc + 376); s0 = fmaf(x36, l[0], s0); s1 = fmaf(x37, l[1], s1); s2 = fmaf(x38, l[2], s2); s3 = fmaf(x39, l[3], s3); } { const f32x4 l = *(const LAS f32x4*)(Lc + 380); s0 = fmaf(x40, l[0], s0); s1 = fmaf(x41, l[1], s1); s2 = fmaf(x42, l[2], s2); s3 = fmaf(x43, l[3], s3); } { const f32x4 l = *(const LAS f32x4*)(Lc + 384); s0 = fmaf(x44, l[0], s0); s1 = fmaf(x45, l[1], s1); s2 = fmaf(x46, l[2], s2); s3 = fmaf(x47, l[3], s3); } { const f32x4 l = *(const LAS f32x4*)(Lc + 388); s0 = fmaf(x48, l[0], s0); s1 = fmaf(x49, l[1], s1); s2 = fmaf(x50, l[2], s2); s3 = fmaf(x51, l[3], s3); } { const f32x4 l = *(const LAS f32x4*)(Lc + 392); s0 = fmaf(x52, l[0], s0); s1 = fmaf(x53, l[1], s1); s2 = fmaf(x54, l[2], s2); s3 = fmaf(x55, l[3], s3); } { const f32x4 l = *(const LAS f32x4*)(Lc + 396); s0 = fmaf(x56, l[0], s0); s1 = fmaf(x57, l[1], s1); s2 = fmaf(x58, l[2], s2); s3 = fmaf(x59, l[3], s3); } { const f32x4 l = *(const LAS f32x4*)(Lc + 400); s0 = fmaf(x60, l[0], s0); s1 = fmaf(x61, l[1], s1); s2 = fmaf(x62, l[2], s2); s3 = fmaf(x63, l[3], s3); } x5 = (lane == 5) ? 1.0f : -((s0 + s1) + (s2 + s3)); asm volatile("" : "+v"(x5) : : "memory"); }
    { float s0 = 0.f, s1 = 0.f, s2 = 0.f, s3 = 0.f; { const f32x4 l = *(const LAS f32x4*)(Lc + 276); s1 = fmaf(x5, l[1], s1); s2 = fmaf(x6, l[2], s2); s3 = fmaf(x7, l[3], s3); } { const f32x4 l = *(const LAS f32x4*)(Lc + 280); s0 = fmaf(x8, l[0], s0); s1 = fmaf(x9, l[1], s1); s2 = fmaf(x10, l[2], s2); s3 = fmaf(x11, l[3], s3); } { const f32x4 l = *(const LAS f32x4*)(Lc + 284); s0 = fmaf(x12, l[0], s0); s1 = fmaf(x13, l[1], s1); s2 = fmaf(x14, l[2], s2); s3 = fmaf(x15, l[3], s3); } { const f32x4 l = *(const LAS f32x4*)(Lc + 288); s0 = fmaf(x16, l[0], s0); s1 = fmaf(x17, l[1], s1); s2 = fmaf(x18, l[2], s2); s3 = fmaf(x19, l[3], s3); } { const f32x4 l = *(const LAS f32x4*)(Lc + 292); s0 = fmaf(x20, l[0], s0); s1 = fmaf(x21, l[1], s1); s2 = fmaf(x22, l[2], s2); s3 = fmaf(x23, l[3], s3); } { const f32x4 l = *(const LAS f32x4*)(Lc + 296); s0 = fmaf(x24, l[0], s0); s1 = fmaf(x25, l[1], s1); s2 = fmaf(x26, l[2], s2); s3 = fmaf(x27, l[3], s3); } { const f32x4 l = *(const LAS f32x4*)(Lc + 300); s0 = fmaf(x28, l[0], s0); s1 = fmaf(x29, l[1], s1); s2 = fmaf(x30, l[2], s2); s3 = fmaf(x31, l[3], s3); } { const f32x4 l = *(const LAS f32x4*)(Lc + 304); s0 = fmaf(x32, l[0], s0); s1 = fmaf(x33, l[1], s1); s2 = fmaf(x34, l[2], s2); s3 = fmaf(x35, l[3], s3); } { const f32x4 l = *(const LAS f32x4*)(Lc + 308); s0 = fmaf(x36, l[0], s0); s1 = fmaf(x37, l[1], s1); s2 = fmaf(x38, l[2], s2); s3 = fmaf(x39, l[3], s3); } { const f32x4 l = *(const LAS f32x4*)(Lc + 312); s0 = fmaf(x40, l[0], s0); s1 = fmaf(x41, l[1], s1); s2 = fmaf(x42, l[2], s2); s3 = fmaf(x43, l[3], s3); } { const f32x4 l = *(const LAS f32x4*)(Lc + 316); s0 = fmaf(x44, l[0], s0); s1 = fmaf(x45, l[1], s1); s2 = fmaf(x46, l[2], s2); s3 = fmaf(x47, l[3], s3); } { const f32x4 l = *(const LAS f32x4*)(Lc + 320); s0 = fmaf(x48, l[0], s0); s1 = fmaf(x49, l[1], s1); s2 = fmaf(x50, l[2], s2); s3 = fmaf(x51, l[3], s3); } { const f32x4 l = *(const LAS f32x4*)(Lc + 324); s0 = fmaf(x52, l[0], s0); s1 = fmaf(x53, l[1], s1); s2 = fmaf(x54, l[2], s2); s3 = fmaf(x55, l[3], s3); } { const f32x4 l = *(const LAS f32x4*)(Lc + 328); s0 = fmaf(x56, l[0], s0); s1 = fmaf(x57, l[1], s1); s2 = fmaf(x58, l[2], s2); s3 = fmaf(x59, l[3], s3); } { const f32x4 l = *(const LAS f32x4*)(Lc + 332); s0 = fmaf(x60, l[0], s0); s1 = fmaf(x61, l[1], s1); s2 = fmaf(x62, l[2], s2); s3 = fmaf(x63, l[3], s3); } x4 = (lane == 4) ? 1.0f : -((s0 + s1) + (s2 + s3)); asm volatile("" : "+v"(x4) : : "memory"); }
    { float s0 = 0.f, s1 = 0.f, s2 = 0.f, s3 = 0.f; { const f32x4 l = *(const LAS f32x4*)(Lc + 208); s0 = fmaf(x4, l[0], s0); s1 = fmaf(x5, l[1], s1); s2 = fmaf(x6, l[2], s2); s3 = fmaf(x7, l[3], s3); } { const f32x4 l = *(const LAS f32x4*)(Lc + 212); s0 = fmaf(x8, l[0], s0); s1 = fmaf(x9, l[1], s1); s2 = fmaf(x10, l[2], s2); s3 = fmaf(x11, l[3], s3); } { const f32x4 l = *(const LAS f32x4*)(Lc + 216); s0 = fmaf(x12, l[0], s0); s1 = fmaf(x13, l[1], s1); s2 = fmaf(x14, l[2], s2); s3 = fmaf(x15, l[3], s3); } { const f32x4 l = *(const LAS f32x4*)(Lc + 220); s0 = fmaf(x16, l[0], s0); s1 = fmaf(x17, l[1], s1); s2 = fmaf(x18, l[2], s2); s3 = fmaf(x19, l[3], s3); } { const f32x4 l = *(const LAS f32x4*)(Lc + 224); s0 = fmaf(x20, l[0], s0); s1 = fmaf(x21, l[1], s1); s2 = fmaf(x22, l[2], s2); s3 = fmaf(x23, l[3], s3); } { const f32x4 l = *(const LAS f32x4*)(Lc + 228); s0 = fmaf(x24, l[0], s0); s1 = fmaf(x25, l[1], s1); s2 = fmaf(x26, l[2], s2); s3 = fmaf(x27, l[3], s3); } { const f32x4 l = *(const LAS f32x4*)(Lc + 232); s0 = fmaf(x28, l[0], s0); s1 = fmaf(x29, l[1], s1); s2 = fmaf(x30, l[2], s2); s3 = fmaf(x31, l[3], s3); } { const f32x4 l = *(const LAS f32x4*)(Lc + 236); s0 = fmaf(x32, l[0], s0); s1 = fmaf(x33, l[1], s1); s2 = fmaf(x34, l[2], s2); s3 = fmaf(x35, l[3], s3); } { const f32x4 l = *(const LAS f32x4*)(Lc + 240); s0 = fmaf(x36, l[0], s0); s1 = fmaf(x37, l[1], s1); s2 = fmaf(x38, l[2], s2); s3 = fmaf(x39, l[3], s3); } { const f32x4 l = *(const LAS f32x4*)(Lc + 244); s0 = fmaf(x40, l[0], s0); s1 = fmaf(x41, l[1], s1); s2 = fmaf(x42, l[2], s2); s3 = fmaf(x43, l[3], s3); } { const f32x4 l = *(const LAS f32x4*)(Lc + 248); s0 = fmaf(x44, l[0], s0); s1 = fmaf(x45, l[1], s1); s2 = fmaf(x46, l[2], s2); s3 = fmaf(x47, l[3], s3); } { const f32x4 l = *(const LAS f32x4*)(Lc + 252); s0 = fmaf(x48, l[0], s0); s1 = fmaf(x49, l[1], s1); s2 = fmaf(x50, l[2], s2); s3 = fmaf(x51, l[3], s3); } { const f32x4 l = *(const LAS f32x4*)(Lc + 256); s0 = fmaf(x52, l[0], s0); s1 = fmaf(x53, l[1], s1); s2 = fmaf(x54, l[2], s2); s3 = fmaf(x55, l[3], s3); } { const f32x4 l = *(const LAS f32x4*)(Lc + 260); s0 = fmaf(x56, l[0], s0); s1 = fmaf(x57, l[1], s1); s2 = fmaf(x58, l[2], s2); s3 = fmaf(x59, l[3], s3); } { const f32x4 l = *(const LAS f32x4*)(Lc + 264); s0 = fmaf(x60, l[0], s0); s1 = fmaf(x61, l[1], s1); s2 = fmaf(x62, l[2], s2); s3 = fmaf(x63, l[3], s3); } x3 = (lane == 3) ? 1.0f : -((s0 + s1) + (s2 + s3)); asm volatile("" : "+v"(x3) : : "memory"); }
    { float s0 = 0.f, s1 = 0.f, s2 = 0.f, s3 = 0.f; { const f32x4 l = *(const LAS f32x4*)(Lc + 136); s3 = fmaf(x3, l[3], s3); } { const f32x4 l = *(const LAS f32x4*)(Lc + 140); s0 = fmaf(x4, l[0], s0); s1 = fmaf(x5, l[1], s1); s2 = fmaf(x6, l[2], s2); s3 = fmaf(x7, l[3], s3); } { const f32x4 l = *(const LAS f32x4*)(Lc + 144); s0 = fmaf(x8, l[0], s0); s1 = fmaf(x9, l[1], s1); s2 = fmaf(x10, l[2], s2); s3 = fmaf(x11, l[3], s3); } { const f32x4 l = *(const LAS f32x4*)(Lc + 148); s0 = fmaf(x12, l[0], s0); s1 = fmaf(x13, l[1], s1); s2 = fmaf(x14, l[2], s2); s3 = fmaf(x15, l[3], s3); } { const f32x4 l = *(const LAS f32x4*)(Lc + 152); s0 = fmaf(x16, l[0], s0); s1 = fmaf(x17, l[1], s1); s2 = fmaf(x18, l[2], s2); s3 = fmaf(x19, l[3], s3); } { const f32x4 l = *(const LAS f32x4*)(Lc + 156); s0 = fmaf(x20, l[0], s0); s1 = fmaf(x21, l[1], s1); s2 = fmaf(x22, l[2], s2); s3 = fmaf(x23, l[3], s3); } { const f32x4 l = *(const LAS f32x4*)(Lc + 160); s0 = fmaf(x24, l[0], s0); s1 = fmaf(x25, l[1], s1); s2 = fmaf(x26, l[2], s2); s3 = fmaf(x27, l[3], s3); } { const f32x4 l = *(const LAS f32x4*)(Lc + 164); s0 = fmaf(x28, l[0], s0); s1 = fmaf(x29, l[1], s1); s2 = fmaf(x30, l[2], s2); s3 = fmaf(x31, l[3], s3); } { const f32x4 l = *(const LAS f32x4*)(Lc + 168); s0 = fmaf(x32, l[0], s0); s1 = fmaf(x33, l[1], s1); s2 = fmaf(x34, l[2], s2); s3 = fmaf(x35, l[3], s3); } { const f32x4 l = *(const LAS f32x4*)(Lc + 172); s0 = fmaf(x36, l[0], s0); s1 = fmaf(x37, l[1], s1); s2 = fmaf(x38, l[2], s2); s3 = fmaf(x39, l[3], s3); } { const f32x4 l = *(const LAS f32x4*)(Lc + 176); s0 = fmaf(x40, l[0], s0); s1 = fmaf(x41, l[1], s1); s2 = fmaf(x42, l[2], s2); s3 = fmaf(x43, l[3], s3); } { const f32x4 l = *(const LAS f32x4*)(Lc + 180); s0 = fmaf(x44, l[0], s0); s1 = fmaf(x45, l[1], s1); s2 = fmaf(x46, l[2], s2); s3 = fmaf(x47, l[3], s3); } { const f32x4 l = *(const LAS f32x4*)(Lc + 184); s0 = fmaf(x48, l[0], s0); s1 = fmaf(x49, l[1], s1); s2 = fmaf(x50, l[2], s2); s3 = fmaf(x51, l[3], s3); } { const f32x4 l = *(const LAS f32x4*)(Lc + 188); s0 = fmaf(x52, l[0], s0); s1 = fmaf(x53, l[1], s1); s2 = fmaf(x54, l[2], s2); s3 = fmaf(x55, l[3], s3); } { const f32x4 l = *(const LAS f32x4*)(Lc + 192); s0 = fmaf(x56, l[0], s0); s1 = fmaf(x57, l[1], s1); s2 = fmaf(x58, l[2], s2); s3 = fmaf(x59, l[3], s3); } { const f32x4 l = *(const LAS f32x4*)(Lc + 196); s0 = fmaf(x60, l[0], s0); s1 = fmaf(x61, l[1], s1); s2 = fmaf(x62, l[2], s2); s3 = fmaf(x63, l[3], s3); } x2 = (lane == 2) ? 1.0f : -((s0 + s1) + (s2 + s3)); asm volatile("" : "+v"(x2) : : "memory"); }
    { float s0 = 0.f, s1 = 0.f, s2 = 0.f, s3 = 0.f; { const f32x4 l = *(const LAS f32x4*)(Lc + 68); s2 = fmaf(x2, l[2], s2); s3 = fmaf(x3, l[3], s3); } { const f32x4 l = *(const LAS f32x4*)(Lc + 72); s0 = fmaf(x4, l[0], s0); s1 = fmaf(x5, l[1], s1); s2 = fmaf(x6, l[2], s2); s3 = fmaf(x7, l[3], s3); } { const f32x4 l = *(const LAS f32x4*)(Lc + 76); s0 = fmaf(x8, l[0], s0); s1 = fmaf(x9, l[1], s1); s2 = fmaf(x10, l[2], s2); s3 = fmaf(x11, l[3], s3); } { const f32x4 l = *(const LAS f32x4*)(Lc + 80); s0 = fmaf(x12, l[0], s0); s1 = fmaf(x13, l[1], s1); s2 = fmaf(x14, l[2], s2); s3 = fmaf(x15, l[3], s3); } { const f32x4 l = *(const LAS f32x4*)(Lc + 84); s0 = fmaf(x16, l[0], s0); s1 = fmaf(x17, l[1], s1); s2 = fmaf(x18, l[2], s2); s3 = fmaf(x19, l[3], s3); } { const f32x4 l = *(const LAS f32x4*)(Lc + 88); s0 = fmaf(x20, l[0], s0); s1 = fmaf(x21, l[1], s1); s2 = fmaf(x22, l[2], s2); s3 = fmaf(x23, l[3], s3); } { const f32x4 l = *(const LAS f32x4*)(Lc + 92); s0 = fmaf(x24, l[0], s0); s1 = fmaf(x25, l[1], s1); s2 = fmaf(x26, l[2], s2); s3 = fmaf(x27, l[3], s3); } { const f32x4 l = *(const LAS f32x4*)(Lc + 96); s0 = fmaf(x28, l[0], s0); s1 = fmaf(x29, l[1], s1); s2 = fmaf(x30, l[2], s2); s3 = fmaf(x31, l[3], s3); } { const f32x4 l = *(const LAS f32x4*)(Lc + 100); s0 = fmaf(x32, l[0], s0); s1 = fmaf(x33, l[1], s1); s2 = fmaf(x34, l[2], s2); s3 = fmaf(x35, l[3], s3); } { const f32x4 l = *(const LAS f32x4*)(Lc + 104); s0 = fmaf(x36, l[0], s0); s1 = fmaf(x37, l[1], s1); s2 = fmaf(x38, l[2], s2); s3 = fmaf(x39, l[3], s3); } { const f32x4 l = *(const LAS f32x4*)(Lc + 108); s0 = fmaf(x40, l[0], s0); s1 = fmaf(x41, l[1], s1); s2 = fmaf(x42, l[2], s2); s3 = fmaf(x43, l[3], s3); } { const f32x4 l = *(const LAS f32x4*)(Lc + 112); s0 = fmaf(x44, l[0], s0); s1 = fmaf(x45, l[1], s1); s2 = fmaf(x46, l[2], s2); s3 = fmaf(x47, l[3], s3); } { const f32x4 l = *(const LAS f32x4*)(Lc + 116); s0 = fmaf(x48, l[0], s0); s1 = fmaf(x49, l[1], s1); s2 = fmaf(x50, l[2], s2); s3 = fmaf(x51, l[3], s3); } { const f32x4 l = *(const LAS f32x4*)(Lc + 120); s0 = fmaf(x52, l[0], s0); s1 = fmaf(x53, l[1], s1); s2 = fmaf(x54, l[2], s2); s3 = fmaf(x55, l[3], s3); } { const f32x4 l = *(const LAS f32x4*)(Lc + 124); s0 = fmaf(x56, l[0], s0); s1 = fmaf(x57, l[1], s1); s2 = fmaf(x58, l[2], s2); s3 = fmaf(x59, l[3], s3); } { const f32x4 l = *(const LAS f32x4*)(Lc + 128); s0 = fmaf(x60, l[0], s0); s1 = fmaf(x61, l[1], s1); s2 = fmaf(x62, l[2], s2); s3 = fmaf(x63, l[3], s3); } x1 = (lane == 1) ? 1.0f : -((s0 + s1) + (s2 + s3)); asm volatile("" : "+v"(x1) : : "memory"); }
    { float s0 = 0.f, s1 = 0.f, s2 = 0.f, s3 = 0.f; { const f32x4 l = *(const LAS f32x4*)(Lc + 0); s1 = fmaf(x1, l[1], s1); s2 = fmaf(x2, l[2], s2); s3 = fmaf(x3, l[3], s3); } { const f32x4 l = *(const LAS f32x4*)(Lc + 4); s0 = fmaf(x4, l[0], s0); s1 = fmaf(x5, l[1], s1); s2 = fmaf(x6, l[2], s2); s3 = fmaf(x7, l[3], s3); } { const f32x4 l = *(const LAS f32x4*)(Lc + 8); s0 = fmaf(x8, l[0], s0); s1 = fmaf(x9, l[1], s1); s2 = fmaf(x10, l[2], s2); s3 = fmaf(x11, l[3], s3); } { const f32x4 l = *(const LAS f32x4*)(Lc + 12); s0 = fmaf(x12, l[0], s0); s1 = fmaf(x13, l[1], s1); s2 = fmaf(x14, l[2], s2); s3 = fmaf(x15, l[3], s3); } { const f32x4 l = *(const LAS f32x4*)(Lc + 16); s0 = fmaf(x16, l[0], s0); s1 = fmaf(x17, l[1], s1); s2 = fmaf(x18, l[2], s2); s3 = fmaf(x19, l[3], s3); } { const f32x4 l = *(const LAS f32x4*)(Lc + 20); s0 = fmaf(x20, l[0], s0); s1 = fmaf(x21, l[1], s1); s2 = fmaf(x22, l[2], s2); s3 = fmaf(x23, l[3], s3); } { const f32x4 l = *(const LAS f32x4*)(Lc + 24); s0 = fmaf(x24, l[0], s0); s1 = fmaf(x25, l[1], s1); s2 = fmaf(x26, l[2], s2); s3 = fmaf(x27, l[3], s3); } { const f32x4 l = *(const LAS f32x4*)(Lc + 28); s0 = fmaf(x28, l[0], s0); s1 = fmaf(x29, l[1], s1); s2 = fmaf(x30, l[2], s2); s3 = fmaf(x31, l[3], s3); } { const f32x4 l = *(const LAS f32x4*)(Lc + 32); s0 = fmaf(x32, l[0], s0); s1 = fmaf(x33, l[1], s1); s2 = fmaf(x34, l[2], s2); s3 = fmaf(x35, l[3], s3); } { const f32x4 l = *(const LAS f32x4*)(Lc + 36); s0 = fmaf(x36, l[0], s0); s1 = fmaf(x37, l[1], s1); s2 = fmaf(x38, l[2], s2); s3 = fmaf(x39, l[3], s3); } { const f32x4 l = *(const LAS f32x4*)(Lc + 40); s0 = fmaf(x40, l[0], s0); s1 = fmaf(x41, l[1], s1); s2 = fmaf(x42, l[2], s2); s3 = fmaf(x43, l[3], s3); } { const f32x4 l = *(const LAS f32x4*)(Lc + 44); s0 = fmaf(x44, l[0], s0); s1 = fmaf(x45, l[1], s1); s2 = fmaf(x46, l[2], s2); s3 = fmaf(x47, l[3], s3); } { const f32x4 l = *(const LAS f32x4*)(Lc + 48); s0 = fmaf(x48, l[0], s0); s1 = fmaf(x49, l[1], s1); s2 = fmaf(x50, l[2], s2); s3 = fmaf(x51, l[3], s3); } { const f32x4 l = *(const LAS f32x4*)(Lc + 52); s0 = fmaf(x52, l[0], s0); s1 = fmaf(x53, l[1], s1); s2 = fmaf(x54, l[2], s2); s3 = fmaf(x55, l[3], s3); } { const f32x4 l = *(const LAS f32x4*)(Lc + 56); s0 = fmaf(x56, l[0], s0); s1 = fmaf(x57, l[1], s1); s2 = fmaf(x58, l[2], s2); s3 = fmaf(x59, l[3], s3); } { const f32x4 l = *(const LAS f32x4*)(Lc + 60); s0 = fmaf(x60, l[0], s0); s1 = fmaf(x61, l[1], s1); s2 = fmaf(x62, l[2], s2); s3 = fmaf(x63, l[3], s3); } x0 = (lane == 0) ? 1.0f : -((s0 + s1) + (s2 + s3)); asm volatile("" : "+v"(x0) : : "memory"); }
    { v4u o; o.x = cvtpk(x0, x1); o.y = cvtpk(x2, x3); o.z = cvtpk(x4, x5); o.w = cvtpk(x6, x7); *(LAS v4u*)(Xs + lane * 72 + 0) = o; }
    { v4u o; o.x = cvtpk(x8, x9); o.y = cvtpk(x10, x11); o.z = cvtpk(x12, x13); o.w = cvtpk(x14, x15); *(LAS v4u*)(Xs + lane * 72 + 8) = o; }
    { v4u o; o.x = cvtpk(x16, x17); o.y = cvtpk(x18, x19); o.z = cvtpk(x20, x21); o.w = cvtpk(x22, x23); *(LAS v4u*)(Xs + lane * 72 + 16) = o; }
    { v4u o; o.x = cvtpk(x24, x25); o.y = cvtpk(x26, x27); o.z = cvtpk(x28, x29); o.w = cvtpk(x30, x31); *(LAS v4u*)(Xs + lane * 72 + 24) = o; }
    { v4u o; o.x = cvtpk(x32, x33); o.y = cvtpk(x34, x35); o.z = cvtpk(x36, x37); o.w = cvtpk(x38, x39); *(LAS v4u*)(Xs + lane * 72 + 32) = o; }
    { v4u o; o.x = cvtpk(x40, x41); o.y = cvtpk(x42, x43); o.z = cvtpk(x44, x45); o.w = cvtpk(x46, x47); *(LAS v4u*)(Xs + lane * 72 + 40) = o; }
    { v4u o; o.x = cvtpk(x48, x49); o.y = cvtpk(x50, x51); o.z = cvtpk(x52, x53); o.w = cvtpk(x54, x55); *(LAS v4u*)(Xs + lane * 72 + 48) = o; }
    { v4u o; o.x = cvtpk(x56, x57); o.y = cvtpk(x58, x59); o.z = cvtpk(x60, x61); o.w = cvtpk(x62, x63); *(LAS v4u*)(Xs + lane * 72 + 56) = o; }
}
#ifndef G1P
#define G1P 15
#endif

#define MF16(a, b, c) __builtin_amdgcn_mfma_f32_16x16x32_bf16((a), (b), (c), 0, 0, 0)
__device__ __forceinline__ bf16x8 ld16g(const bf16* p) { return *(const GAS bf16x8*)p; }
__device__ __forceinline__ float ldbf(const bf16* p) { return __uint_as_float(((unsigned)*(const GAS unsigned short*)p) << 16); }
__device__ __forceinline__ void st8(bf16* p, float a, float b, float c, float d) { u32x2v o; o.x = cvtpk(a, b); o.y = cvtpk(c, d); *(GAS u32x2v*)p = o; }

__device__ __forceinline__ void p_ga(const Frame& F, const Args& a, int L) {
    GAS unsigned char* ws = (GAS unsigned char*)a.ws; asm volatile("" : "+s"(ws)); int lane_ = F.lane; asm volatile("" : "+v"(lane_)); const int j = L >> 1, lane = lane_;
    const bf16* PO = (const bf16*)(ws + WS_ARENA + AR_PO);
    bf16 *QN = (bf16*)(ws + WS_ARENA + AR_QN), *QT = (bf16*)(ws + WS_ARENA + AR_QT), *KN = (bf16*)(ws + WS_ARENA + AR_KN), *KGT = (bf16*)(ws + WS_ARENA + AR_KGT), *VBT = (bf16*)(ws + WS_ARENA + AR_VBT), *KTT = (bf16*)(ws + WS_ARENA + AR_KTT);
    const float* gg = (const float*)(ws + WS_GB); const float* gbeta = gg + S_ * 8; float* dn = (float*)(ws + WS_TOK + TOK_DN); float* gcs = (float*)(ws + WS_GC);
    const float* cw = (const float*)a.in[16] + (size_t)j * 4 * 3072;
    LAS float* sc = (LAS float*)(F.lds + F.wave * WAVE_LDS);
    const int dg = lane & 15, ts = lane >> 4, d0 = 8 * dg;
#pragma unroll 1
    for (int u = F.gw; u < NUNIT; u += F.NGW) {
        const int n = u >> 3, hh = u & 7, tok0 = 64 * n;
        {
            const float g = gg[(size_t)(tok0 + lane) * 8 + hh], beta = gbeta[(size_t)(tok0 + lane) * 8 + hh];
            float gc = g;
#pragma unroll
            for (int o = 1; o < 64; o <<= 1) { const float t = __shfl_up(gc, o); if (lane >= o) gc += t; }
            const float glast = __shfl(gc, 63);
            gcs[(size_t)(tok0 + lane) * 8 + hh] = gc;
            if (lane == 0) dn[u] = expf(glast);
            const float eg = expf(gc);
            sc[64 + lane] = beta * eg; sc[128 + lane] = expf(glast - gc); sc[192 + lane] = beta; sc[256 + lane] = eg;
        }
#pragma unroll 1
        for (int qk = 0; qk < 2; ++qk) {
            const int coff = qk * 1024 + hh * 128 + d0;
            float w[4][8];
#pragma unroll
            for (int jj = 0; jj < 4; ++jj)
#pragma unroll
                for (int e = 0; e < 8; ++e) w[jj][e] = *(const GAS float*)(cw + jj * 3072 + coff + e);
#pragma unroll 4
            for (int it = 0; it < 16; ++it) {
                const int i = 4 * it + ts, tok = tok0 + i; float acc[8];
                v4u rv[4];
#pragma unroll
                for (int jj = 0; jj < 4; ++jj) { const int r = tok - 3 + jj; rv[jj] = *(const GAS v4u*)(PO + (size_t)(r < 0 ? 0 : r) * OIN + coff); }
#pragma unroll
                for (int e = 0; e < 8; ++e) acc[e] = 0.f;
#pragma unroll
                for (int jj = 0; jj < 4; ++jj) { const float on = (tok - 3 + jj >= 0) ? 1.0f : 0.0f; const unsigned vv[4] = {rv[jj].x, rv[jj].y, rv[jj].z, rv[jj].w};
#pragma unroll
                    for (int q = 0; q < 4; ++q) { acc[2 * q] += (w[jj][2 * q] * on) * bflo(vv[q]); acc[2 * q + 1] += (w[jj][2 * q + 1] * on) * bfhi(vv[q]); } }
                float ss = 0.f;
#pragma unroll
                for (int e = 0; e < 8; ++e) { acc[e] = silu(acc[e]); ss += acc[e] * acc[e]; }
                ss += __shfl_xor(ss, 1); ss += __shfl_xor(ss, 2); ss += __shfl_xor(ss, 4); ss += __shfl_xor(ss, 8);
                const float rn = __builtin_amdgcn_rsqf(ss + 1e-6f);
                const float s1 = (qk == 0) ? rn * 0.08838834764831845f : rn;
                v4u o; o.x = cvtpk(acc[0] * s1, acc[1] * s1); o.y = cvtpk(acc[2] * s1, acc[3] * s1); o.z = cvtpk(acc[4] * s1, acc[5] * s1); o.w = cvtpk(acc[6] * s1, acc[7] * s1);
                *(GAS v4u*)((qk == 0 ? QN : KN) + (size_t)tok * D_ + hh * 128 + d0) = o;
                if (qk == 0) { const float s2 = s1 * sc[256 + i];
                    o.x = cvtpk(acc[0] * s2, acc[1] * s2); o.y = cvtpk(acc[2] * s2, acc[3] * s2); o.z = cvtpk(acc[4] * s2, acc[5] * s2); o.w = cvtpk(acc[6] * s2, acc[7] * s2);
                    *(GAS v4u*)(QT + (size_t)tok * D_ + hh * 128 + d0) = o; }
                else if (dg == 0) sc[i] = rn;
            }
        }
#pragma unroll 1
        for (int kv = 0; kv < 2; ++kv)
#pragma unroll 1
            for (int half = 0; half < 2; ++half) {
                const int d = 64 * half + lane, c = (1 + kv) * 1024 + hh * 128 + d;
                const float w0 = *(const GAS float*)(cw + c), w1 = *(const GAS float*)(cw + 3072 + c), w2 = *(const GAS float*)(cw + 2 * 3072 + c), w3 = *(const GAS float*)(cw + 3 * 3072 + c);
                const float hon = tok0 > 0 ? 1.0f : 0.0f; const int hb = tok0 > 0 ? tok0 - 3 : 0;
                float r0 = hon * ldbf(PO + (size_t)hb * OIN + c), r1 = hon * ldbf(PO + (size_t)(hb + 1) * OIN + c), r2 = hon * ldbf(PO + (size_t)(hb + 2) * OIN + c);
                const size_t obase = ((size_t)u * 128 + d) * 64;
                const LAS float* m1 = sc + (kv == 0 ? 64 : 192);
                bf16* O1 = kv == 0 ? KGT : VBT;
#pragma unroll 1
                for (int ig4 = 0; ig4 < 2; ++ig4) {
                    float x[32];
#pragma unroll
                    for (int e = 0; e < 32; ++e) x[e] = ldbf(PO + (size_t)(tok0 + 32 * ig4 + e) * OIN + c);
#pragma unroll
                    for (int sb = 0; sb < 4; ++sb) { const int ig = 4 * ig4 + sb; float o1[8], o2[8];
#pragma unroll
                        for (int e = 0; e < 8; ++e) { const int i = 8 * ig + e; const float r3 = x[8 * sb + e];
                            float v = silu(w0 * r0 + w1 * r1 + w2 * r2 + w3 * r3); r0 = r1; r1 = r2; r2 = r3;
                            const float rk = sc[i]; v = (kv == 0) ? v * rk : v;
                            o1[e] = v * m1[i]; o2[e] = v * sc[128 + i]; }
                        v4u o; o.x = cvtpk(o1[0], o1[1]); o.y = cvtpk(o1[2], o1[3]); o.z = cvtpk(o1[4], o1[5]); o.w = cvtpk(o1[6], o1[7]);
                        *(GAS v4u*)(O1 + obase + 8 * ig) = o;
                        if (kv == 0) { o.x = cvtpk(o2[0], o2[1]); o.y = cvtpk(o2[2], o2[3]); o.z = cvtpk(o2[4], o2[5]); o.w = cvtpk(o2[6], o2[7]); *(GAS v4u*)(KTT + obase + 8 * ig) = o; } }
                }
            }
    }
}

__device__ __forceinline__ void p_g1(const Frame& F, const Args& a) {
    GAS unsigned char* ws = (GAS unsigned char*)a.ws; asm volatile("" : "+s"(ws)); int lane_ = F.lane; asm volatile("" : "+v"(lane_)); const int lane = lane_, r16 = lane & 15, g = lane >> 4;
    const bf16 *QN = (const bf16*)(ws + WS_ARENA + AR_QN), *KN = (const bf16*)(ws + WS_ARENA + AR_KN), *KGT = (const bf16*)(ws + WS_ARENA + AR_KGT), *VBT = (const bf16*)(ws + WS_ARENA + AR_VBT), *KTT = (const bf16*)(ws + WS_ARENA + AR_KTT);
    bf16 *AI = (bf16*)(ws + WS_ARENA + AR_AI), *NEGW = (bf16*)(ws + WS_ARENA + AR_NEGW), *UT = (bf16*)(ws + WS_ARENA + AR_UT), *MP = (bf16*)(ws + WS_ARENA + AR_MP), *NT = (bf16*)(ws + WS_ARENA + AR_NT), *WT = (bf16*)(ws + WS_ARENA + AR_WT);
    const float* gg = (const float*)(ws + WS_GC); const float* gbeta = (const float*)(ws + WS_GB) + S_ * 8;
    LAS float* Lc = (LAS float*)(F.lds + F.wave * WAVE_LDS);
    LAS bf16* Xs = (LAS bf16*)(F.lds + F.wave * WAVE_LDS);
    const f32x4 Z4 = {0.f, 0.f, 0.f, 0.f};
#pragma unroll 1
    for (int u = F.gw; u < NUNIT; u += F.NGW) {
        const int n = u >> 3, hh = u & 7, tok0 = 64 * n; const int uh = hh * NCHUNK + n;
        const float gc = gg[(size_t)(tok0 + lane) * 8 + hh], beta = gbeta[(size_t)(tok0 + lane) * 8 + hh];
#if G1P & 1
        {
            bf16x8 kf[4][4];
#pragma unroll
            for (int t = 0; t < 4; ++t)
#pragma unroll
                for (int kk = 0; kk < 4; ++kk) kf[t][kk] = ld16g(KN + (size_t)(tok0 + 16 * t + r16) * D_ + hh * 128 + 32 * kk + 8 * g);
#pragma unroll
            for (int ti = 0; ti < 4; ++ti)
#pragma unroll
                for (int tj = 0; tj <= ti; ++tj) {
                    f32x4 Dv = Z4;
#pragma unroll
                    for (int kk = 0; kk < 4; ++kk) Dv = MF16(kf[ti][kk], kf[tj][kk], Dv);
                    const int jx = 16 * tj + r16; const float gcj = __shfl(gc, jx); f32x4 val;
#pragma unroll
                    for (int r = 0; r < 4; ++r) { const int ix = 16 * ti + 4 * g + r; const float gci = __shfl(gc, ix), bi = __shfl(beta, ix); val[r] = (ix > jx) ? bi * Dv[r] * expf(gci - gcj) : 0.f; }
                    *(LAS f32x4*)(Lc + jx * 68 + 16 * ti + 4 * g) = val;
                }
#pragma unroll
            for (int ti = 0; ti < 4; ++ti) {
                bf16x8 qf[4];
#pragma unroll
                for (int kk = 0; kk < 4; ++kk) qf[kk] = ld16g(QN + (size_t)(tok0 + 16 * ti + r16) * D_ + hh * 128 + 32 * kk + 8 * g);
                const int ix = 16 * ti + r16; const float gci = __shfl(gc, ix);
#pragma unroll
                for (int tj = 0; tj < 4; ++tj) {
                    f32x4 val = Z4;
                    if (tj <= ti) {
                        f32x4 Dv = Z4;
#pragma unroll
                        for (int kk = 0; kk < 4; ++kk) Dv = MF16(kf[tj][kk], qf[kk], Dv);
#pragma unroll
                        for (int r = 0; r < 4; ++r) { const int jx = 16 * tj + 4 * g + r; const float gcj = __shfl(gc, jx); val[r] = (ix >= jx) ? Dv[r] * expf(gci - gcj) : 0.f; }
                    }
                    st8(AI + ((size_t)u * 64 + ix) * 64 + 16 * tj + 4 * g, val[0], val[1], val[2], val[3]);
                }
            }
        }
        asm volatile("s_waitcnt lgkmcnt(0)" ::: "memory");
#endif
#if G1P & 2
        tri_solve(Lc, Xs, lane);
#endif
#if G1P & 4
        asm volatile("s_waitcnt lgkmcnt(0)" ::: "memory");
        {
            bf16x8 xf[4][2];
#pragma unroll
            for (int t = 0; t < 4; ++t)
#pragma unroll
                for (int kk = 0; kk < 2; ++kk) xf[t][kk] = *(const LAS bf16x8*)(Xs + (16 * t + r16) * 72 + 32 * kk + 8 * g);
#pragma unroll 2
            for (int td = 0; td < 8; ++td) {
                const size_t rb = ((size_t)u * 128 + 16 * td + r16) * 64;
                const bf16x8 vb0 = ld16g(VBT + rb + 8 * g), vb1 = ld16g(VBT + rb + 32 + 8 * g), kg0 = ld16g(KGT + rb + 8 * g), kg1 = ld16g(KGT + rb + 32 + 8 * g);
#pragma unroll
                for (int ti = 0; ti < 4; ++ti) {
                    f32x4 Du = MF16(xf[ti][0], vb0, Z4); Du = MF16(xf[ti][1], vb1, Du);
                    st8(UT + rb + 16 * ti + 4 * g, Du[0], Du[1], Du[2], Du[3]);
                    f32x4 Dw = MF16(xf[ti][0], kg0, Z4); Dw = MF16(xf[ti][1], kg1, Dw);
                    st8(WT + rb + 16 * ti + 4 * g, Dw[0], Dw[1], Dw[2], Dw[3]);
                    f32x4 Dn = MF16(kg0, xf[ti][0], Z4); Dn = MF16(kg1, xf[ti][1], Dn);
                    st8(NEGW + (size_t)(tok0 + 16 * ti + r16) * D_ + hh * 128 + 16 * td + 4 * g, -Dn[0], -Dn[1], -Dn[2], -Dn[3]);
                }
            }
        }
#endif
        asm volatile("s_waitcnt vmcnt(0)" ::: "memory");
#if G1P & 8
        {
            bf16x8 ktf[8][2];
#pragma unroll
            for (int t = 0; t < 8; ++t)
#pragma unroll
                for (int kk = 0; kk < 2; ++kk) ktf[t][kk] = ld16g(KTT + ((size_t)u * 128 + 16 * t + r16) * 64 + 32 * kk + 8 * g);
#pragma unroll 2
            for (int tp = 0; tp < 8; ++tp) {
                const size_t rb = ((size_t)u * 128 + 16 * tp + r16) * 64;
                const bf16x8 wf0 = ld16g(WT + rb + 8 * g), wf1 = ld16g(WT + rb + 32 + 8 * g), uf0 = ld16g(UT + rb + 8 * g), uf1 = ld16g(UT + rb + 32 + 8 * g);
#pragma unroll
                for (int t1 = 0; t1 < 8; ++t1) {
                    f32x4 Dm = MF16(wf0, ktf[t1][0], Z4); Dm = MF16(wf1, ktf[t1][1], Dm);
                    st8(MP + ((size_t)uh * 128 + 16 * t1 + r16) * 128 + 16 * tp + 4 * g, -Dm[0], -Dm[1], -Dm[2], -Dm[3]);
                    f32x4 Dn = MF16(ktf[t1][0], uf0, Z4); Dn = MF16(ktf[t1][1], uf1, Dn);
                    st8(NT + ((size_t)uh * 128 + 16 * tp + r16) * 128 + 16 * t1 + 4 * g, Dn[0], Dn[1], Dn[2], Dn[3]);
                }
            }
        }
#endif
    }
}

template <int NS, int SGSTEP> __device__ __forceinline__ void p_g2(const Frame& F, const Args& a, const bf16* MPsrc, const bf16* NTsrc, const float* dnsrc) {
    GAS unsigned char* ws = (GAS unsigned char*)a.ws; asm volatile("" : "+s"(ws)); int lane_ = F.lane; asm volatile("" : "+v"(lane_)); const int lane = lane_, r16 = lane & 15, g = lane >> 4, w = F.wave;
    const bf16 *MP = MPsrc, *NT = NTsrc; bf16* SG = (bf16*)(ws + WS_ARENA + AR_SG);
    const float* dn = dnsrc;
    LAS bf16* St = (LAS bf16*)F.lds;
    const int args_use_bar = a.use_bar; (void)args_use_bar;
#pragma unroll 1
    for (int asg = F.vcu; asg < 64; asg += F.G) {
        const int hh = asg >> 3, sl = asg & 7;
        __syncthreads();
        for (int idx = F.tid; idx < 2 * 16 * 136 / 2; idx += NWAVES * 64) ((LAS unsigned*)St)[idx] = 0u;
        __syncthreads();
        if (w >= 4) {
            const int st = F.tid - 256, row = st >> 4, chunk = st & 15;
#pragma unroll 1
            for (int n = 0; n < NS; ++n) {
                const v4u v = *(const LAS v4u*)(St + (n & 1) * (16 * 136) + row * 136 + chunk * 8);
                *(GAS v4u*)(SG + ((size_t)(hh * NCHUNK + n * SGSTEP) * 128 + 16 * sl + row) * 128 + chunk * 8) = v;
                asm volatile("s_waitcnt lgkmcnt(0)" ::: "memory"); __builtin_amdgcn_s_barrier(); asm volatile("" ::: "memory");
            }
        } else {
            f32x4 Sv[2] = {{0.f, 0.f, 0.f, 0.f}, {0.f, 0.f, 0.f, 0.f}};
            bf16x8 A0[2][4], A1[2][4], A2[2][4], A3[2][4]; u32x2v C0[2], C1[2], C2[2], C3[2]; float d0, d1, d2, d3;
#define G2_LOAD(AX, CX, DX, nn) do { const int u_ = hh * NS + (nn); \
            _Pragma("unroll") for (int t = 0; t < 2; ++t) { \
                _Pragma("unroll") for (int kk = 0; kk < 4; ++kk) AX[t][kk] = ld16g(MP + ((size_t)u_ * 128 + 32 * w + 16 * t + r16) * 128 + 32 * kk + 8 * g); \
                CX[t] = *(const GAS u32x2v*)(NT + ((size_t)u_ * 128 + 16 * sl + r16) * 128 + 32 * w + 16 * t + 4 * g); } \
            DX = *(const GAS float*)(dn + (nn) * 8 + hh); } while (0)
#ifdef PROBE_G2_NOLOAD
#define G2_STEPLOAD(AL, CL, DL, nn) do { if (args_use_bar) G2_LOAD(AL, CL, DL, nn); } while (0)
#else
#define G2_STEPLOAD(AL, CL, DL, nn) G2_LOAD(AL, CL, DL, nn)
#endif
#define G2_STEP(AU, CU, DU, AL, CL, DL, nn) do { const int n_ = (nn); const int n2_ = (n_ + 3 < NS) ? n_ + 3 : NS - 1; \
            G2_STEPLOAD(AL, CL, DL, n2_); \
            LAS bf16* Sc = St + (n_ & 1) * (16 * 136); LAS bf16* Sn = St + ((n_ & 1) ^ 1) * (16 * 136); \
            f32x4 D0 = {bflo(CU[0].x), bfhi(CU[0].x), bflo(CU[0].y), bfhi(CU[0].y)}, D1 = {bflo(CU[1].x), bfhi(CU[1].x), bflo(CU[1].y), bfhi(CU[1].y)}; \
            _Pragma("unroll") for (int kk = 0; kk < 4; ++kk) { const bf16x8 Bf = *(const LAS bf16x8*)(Sc + r16 * 136 + 32 * kk + 8 * g); D0 = MF16(AU[0][kk], Bf, D0); D1 = MF16(AU[1][kk], Bf, D1); } \
            Sv[0] = Sv[0] * DU + D0; Sv[1] = Sv[1] * DU + D1; \
            { u32x2v o; o.x = cvtpk(Sv[0][0], Sv[0][1]); o.y = cvtpk(Sv[0][2], Sv[0][3]); *(LAS u32x2v*)(Sn + r16 * 136 + 32 * w + 4 * g) = o; \
              o.x = cvtpk(Sv[1][0], Sv[1][1]); o.y = cvtpk(Sv[1][2], Sv[1][3]); *(LAS u32x2v*)(Sn + r16 * 136 + 32 * w + 16 + 4 * g) = o; } \
            asm volatile("s_waitcnt lgkmcnt(0)" ::: "memory"); __builtin_amdgcn_s_barrier(); asm volatile("" ::: "memory"); } while (0)
            G2_LOAD(A0, C0, d0, 0); G2_LOAD(A1, C1, d1, 1); G2_LOAD(A2, C2, d2, 2);
            static_assert(NS % 24 == 16, "scan loop: trips of 24 steps + a 16-step tail");
            int n = 0;
#pragma unroll 1
            for (; n + 24 <= NS - 16; n += 24) {
                G2_STEP(A0, C0, d0, A3, C3, d3, n + 0);
                G2_STEP(A1, C1, d1, A0, C0, d0, n + 1);
                G2_STEP(A2, C2, d2, A1, C1, d1, n + 2);
                G2_STEP(A3, C3, d3, A2, C2, d2, n + 3);
                G2_STEP(A0, C0, d0, A3, C3, d3, n + 4);
                G2_STEP(A1, C1, d1, A0, C0, d0, n + 5);
                G2_STEP(A2, C2, d2, A1, C1, d1, n + 6);
                G2_STEP(A3, C3, d3, A2, C2, d2, n + 7);
                G2_STEP(A0, C0, d0, A3, C3, d3, n + 8);
                G2_STEP(A1, C1, d1, A0, C0, d0, n + 9);
                G2_STEP(A2, C2, d2, A1, C1, d1, n + 10);
                G2_STEP(A3, C3, d3, A2, C2, d2, n + 11);
                G2_STEP(A0, C0, d0, A3, C3, d3, n + 12);
                G2_STEP(A1, C1, d1, A0, C0, d0, n + 13);
                G2_STEP(A2, C2, d2, A1, C1, d1, n + 14);
                G2_STEP(A3, C3, d3, A2, C2, d2, n + 15);
                G2_STEP(A0, C0, d0, A3, C3, d3, n + 16);
                G2_STEP(A1, C1, d1, A0, C0, d0, n + 17);
                G2_STEP(A2, C2, d2, A1, C1, d1, n + 18);
                G2_STEP(A3, C3, d3, A2, C2, d2, n + 19);
                G2_STEP(A0, C0, d0, A3, C3, d3, n + 20);
                G2_STEP(A1, C1, d1, A0, C0, d0, n + 21);
                G2_STEP(A2, C2, d2, A1, C1, d1, n + 22);
                G2_STEP(A3, C3, d3, A2, C2, d2, n + 23);
            }
            G2_STEP(A0, C0, d0, A3, C3, d3, n + 0);
            G2_STEP(A1, C1, d1, A0, C0, d0, n + 1);
            G2_STEP(A2, C2, d2, A1, C1, d1, n + 2);
            G2_STEP(A3, C3, d3, A2, C2, d2, n + 3);
            G2_STEP(A0, C0, d0, A3, C3, d3, n + 4);
            G2_STEP(A1, C1, d1, A0, C0, d0, n + 5);
            G2_STEP(A2, C2, d2, A1, C1, d1, n + 6);
            G2_STEP(A3, C3, d3, A2, C2, d2, n + 7);
            G2_STEP(A0, C0, d0, A3, C3, d3, n + 8);
            G2_STEP(A1, C1, d1, A0, C0, d0, n + 9);
            G2_STEP(A2, C2, d2, A1, C1, d1, n + 10);
            G2_STEP(A3, C3, d3, A2, C2, d2, n + 11);
            G2_STEP(A0, C0, d0, A3, C3, d3, n + 12);
            G2_STEP(A1, C1, d1, A0, C0, d0, n + 13);
            G2_STEP(A2, C2, d2, A1, C1, d1, n + 14);
            G2_STEP(A3, C3, d3, A2, C2, d2, n + 15);
#undef G2_STEP
#undef G2_LOAD
        }
    }
}


constexpr int GST_PAIR = 128 * 136, GST_BYTES = 2 * GST_PAIR * 2, GW_BYTES = 8704;
static_assert(GST_BYTES + 8 * GW_BYTES <= LDSCTL_OFF, "group-phase LDS map");
__device__ __forceinline__ void g_stage_mp(const Frame& F, const bf16* MP, int uh0, int uh1, bool on0, bool on1) {
    LAS bf16* st = (LAS bf16*)F.lds;
#pragma unroll
    for (int q = 0; q < 4; ++q) { const int idx = F.tid + 512 * q, row = idx >> 4, ch = idx & 15;
        v4u v0 = {0u, 0u, 0u, 0u}, v1 = v0;
        if (on0) v0 = *(const GAS v4u*)(MP + ((size_t)uh0 * 128 + row) * 128 + ch * 8);
        if (on1) v1 = *(const GAS v4u*)(MP + ((size_t)uh1 * 128 + row) * 128 + ch * 8);
        *(LAS v4u*)(st + row * 136 + ch * 8) = v0; *(LAS v4u*)(st + GST_PAIR + row * 136 + ch * 8) = v1; }
}
__device__ __forceinline__ void p_g1b(const Frame& F, const Args& a) {
    GAS unsigned char* ws = (GAS unsigned char*)a.ws; asm volatile("" : "+s"(ws)); int lane_ = F.lane; asm volatile("" : "+v"(lane_)); const int lane = lane_, r16 = lane & 15, g = lane >> 4;
    const bf16 *MP = (const bf16*)(ws + WS_ARENA + AR_MP), *NT = (const bf16*)(ws + WS_ARENA + AR_NT); const float* dn = (const float*)(ws + WS_TOK + TOK_DN);
    bf16 *MPc = (bf16*)(ws + WS_ARENA + AR_MPC), *NTc = (bf16*)(ws + WS_ARENA + AR_NTC); float* dnc = (float*)(ws + WS_TOK + TOK_DNC);
    const bool isB = F.wave >= 4; const int sl = F.wave & 3, c0 = 32 * sl;
    const LAS bf16* stg = (const LAS bf16*)F.lds; LAS bf16* wa = (LAS bf16*)(F.lds + GST_BYTES + F.wave * GW_BYTES);
#pragma unroll 1
    for (int tp = F.vcu; tp < 512; tp += F.G) {
        const int hh = tp & 7, gq = tp >> 3;
        f32x4 X[8][2]; float Dd = 1.0f;
#pragma unroll
        for (int mt = 0; mt < 8; ++mt)
#pragma unroll
            for (int nt = 0; nt < 2; ++nt) X[mt][nt] = (f32x4){0.f, 0.f, 0.f, 0.f};
#pragma unroll 1
        for (int i = 0; i < 4; ++i) {
            const int uh = hh * NCHUNK + 4 * gq + i; const float di = *(const GAS float*)(dn + (4 * gq + i) * 8 + hh);
            bf16x8 xo[4][2]; const float dadd = isB ? 0.0f : Dd;
#pragma unroll
            for (int s = 0; s < 4; ++s)
#pragma unroll
                for (int nt = 0; nt < 2; ++nt) { v4u pr; const int col = c0 + 16 * nt + r16; f32x4 t0 = X[2 * s][nt], t1 = X[2 * s + 1][nt];
#pragma unroll
                    for (int r = 0; r < 4; ++r) { if (32 * s + 4 * g + r == col) t0[r] += dadd; if (32 * s + 16 + 4 * g + r == col) t1[r] += dadd; }
                    pr.x = cvtpk(t0[0], t0[1]); pr.y = cvtpk(t0[2], t0[3]); pr.z = cvtpk(t1[0], t1[1]); pr.w = cvtpk(t1[2], t1[3]); xo[s][nt] = __builtin_bit_cast(bf16x8, pr); }
            __syncthreads();
            {
                LAS bf16* st = (LAS bf16*)F.lds;
#pragma unroll
                for (int q = 0; q < 4; ++q) { const int idx = F.tid + 512 * q, row = idx >> 4, ch = idx & 15; const v4u v = *(const GAS v4u*)(MP + ((size_t)uh * 128 + row) * 128 + ch * 8); *(LAS v4u*)(st + row * 136 + ch * 8) = v; }
            }
            if (isB) {
#pragma unroll
                for (int q = 0; q < 8; ++q) { const int row = 4 * q + (lane >> 4), ch = lane & 15; const v4u v = *(const GAS v4u*)(NT + ((size_t)uh * 128 + c0 + row) * 128 + ch * 8); *(LAS v4u*)(wa + row * 136 + ch * 8) = v; }
            }
            __syncthreads();
#pragma unroll
            for (int mt = 0; mt < 8; ++mt) {
                bf16x8 af[4];
#pragma unroll
                for (int s = 0; s < 4; ++s) { const LAS bf16* rp = stg + (16 * mt + r16) * 136 + 32 * s + 4 * g; const u32x2v lo = *(const LAS u32x2v*)rp, hi = *(const LAS u32x2v*)(rp + 16);
                    const v4u pk = {lo.x, lo.y, hi.x, hi.y}; af[s] = __builtin_bit_cast(bf16x8, pk); }
#pragma unroll
                for (int nt = 0; nt < 2; ++nt) { f32x4 acc = X[mt][nt] * di;
                    if (isB) { const u32x2v nn = *(const LAS u32x2v*)(wa + (16 * nt + r16) * 136 + 16 * mt + 4 * g); acc = acc + (f32x4){bflo(nn.x), bfhi(nn.x), bflo(nn.y), bfhi(nn.y)}; }
#pragma unroll
                    for (int s = 0; s < 4; ++s) acc = MF16(af[s], xo[s][nt], acc);
                    X[mt][nt] = acc; }
                asm volatile("" ::: "memory");
            }
            Dd *= di;
        }
        const int uc = hh * 64 + gq;
        if (isB) {
#pragma unroll
            for (int mt = 0; mt < 8; ++mt)
#pragma unroll
                for (int nt = 0; nt < 2; ++nt) st8(NTc + ((size_t)uc * 128 + c0 + 16 * nt + r16) * 128 + 16 * mt + 4 * g, X[mt][nt][0], X[mt][nt][1], X[mt][nt][2], X[mt][nt][3]);
        } else {
            if (sl == 0 && lane == 0) dnc[gq * 8 + hh] = Dd;
#pragma unroll
            for (int hf = 0; hf < 2; ++hf) {
                asm volatile("s_waitcnt lgkmcnt(0)" ::: "memory");
#pragma unroll
                for (int m4 = 0; m4 < 4; ++m4)
#pragma unroll
                    for (int nt = 0; nt < 2; ++nt)
#pragma unroll
                        for (int r = 0; r < 4; ++r) wa[(16 * m4 + 4 * g + r) * 40 + 16 * nt + r16] = (unsigned short)(cvtpk(X[4 * hf + m4][nt][r], 0.f) & 0xffffu);
                asm volatile("s_waitcnt lgkmcnt(0)" ::: "memory");
#pragma unroll
                for (int q = 0; q < 4; ++q) { const int row = 16 * q + (lane >> 2), ch = lane & 3; const v4u v = *(const LAS v4u*)(wa + row * 40 + ch * 8);
                    *(GAS v4u*)(MPc + ((size_t)uc * 128 + 64 * hf + row) * 128 + c0 + ch * 8) = v; }
            }
        }
    }
    __syncthreads();
}

__device__ __forceinline__ void p_g2b(const Frame& F, const Args& a) {
    GAS unsigned char* ws = (GAS unsigned char*)a.ws; asm volatile("" : "+s"(ws)); int lane_ = F.lane; asm volatile("" : "+v"(lane_)); const int lane = lane_, r16 = lane & 15, g = lane >> 4;
    const bf16 *MP = (const bf16*)(ws + WS_ARENA + AR_MP), *NT = (const bf16*)(ws + WS_ARENA + AR_NT); const float* dn = (const float*)(ws + WS_TOK + TOK_DN); bf16* SG = (bf16*)(ws + WS_ARENA + AR_SG);
    const int pw = F.wave >> 2, qf = F.wave & 3, c0 = 32 * qf;
    const LAS bf16* stg = (const LAS bf16*)F.lds + pw * GST_PAIR; LAS bf16* Sl = (LAS bf16*)(F.lds + GST_BYTES + F.wave * GW_BYTES);
#pragma unroll 1
    for (int tp0 = 2 * F.vcu; tp0 < 512; tp0 += 2 * F.G) {
        const int tp = tp0 + pw; const bool on = tp < 512; const int tpc = on ? tp : 0, hh = tpc & 7, gq = tpc >> 3;
        const int tpa = tp0, tpb = tp0 + 1;
        { const int u0 = hh * NCHUNK + 4 * gq;
#pragma unroll
          for (int q = 0; q < 8; ++q) { const int row = 4 * q + (lane >> 4), ch = lane & 15; const v4u v = *(const GAS v4u*)(SG + ((size_t)u0 * 128 + c0 + row) * 128 + ch * 8); *(LAS v4u*)(Sl + row * 136 + ch * 8) = v; } }
#pragma unroll 1
        for (int i = 0; i < 3; ++i) {
            __syncthreads();
            g_stage_mp(F, MP, (tpa & 7) * NCHUNK + 4 * (tpa >> 3) + i, (tpb & 7) * NCHUNK + 4 * ((tpb < 512 ? tpb : 0) >> 3) + i, tpa < 512, tpb < 512);
            const int uh = hh * NCHUNK + 4 * gq + i; const float di = *(const GAS float*)(dn + (4 * gq + i) * 8 + hh);
            u32x2v nn[8][2];
#pragma unroll
            for (int mt = 0; mt < 8; ++mt)
#pragma unroll
                for (int nt = 0; nt < 2; ++nt) nn[mt][nt] = *(const GAS u32x2v*)(NT + ((size_t)uh * 128 + c0 + 16 * nt + r16) * 128 + 16 * mt + 4 * g);
            bf16x8 Bf[2][4];
#pragma unroll
            for (int nt = 0; nt < 2; ++nt)
#pragma unroll
                for (int s = 0; s < 4; ++s) Bf[nt][s] = *(const LAS bf16x8*)(Sl + (16 * nt + r16) * 136 + 32 * s + 8 * g);
            __syncthreads();
            f32x4 acc[8][2];
#pragma unroll
            for (int mt = 0; mt < 8; ++mt) {
                bf16x8 af[4];
#pragma unroll
                for (int s = 0; s < 4; ++s) af[s] = *(const LAS bf16x8*)(stg + (16 * mt + r16) * 136 + 32 * s + 8 * g);
#pragma unroll
                for (int nt = 0; nt < 2; ++nt) {
                    const u32x2v so = *(const LAS u32x2v*)(Sl + (16 * nt + r16) * 136 + 16 * mt + 4 * g);
                    f32x4 Dv = {bflo(nn[mt][nt].x) + di * bflo(so.x), bfhi(nn[mt][nt].x) + di * bfhi(so.x), bflo(nn[mt][nt].y) + di * bflo(so.y), bfhi(nn[mt][nt].y) + di * bfhi(so.y)};
#pragma unroll
                    for (int s = 0; s < 4; ++s) Dv = MF16(af[s], Bf[nt][s], Dv);
                    acc[mt][nt] = Dv;
                }
            }
            asm volatile("s_waitcnt lgkmcnt(0)" ::: "memory");
#pragma unroll
            for (int mt = 0; mt < 8; ++mt)
#pragma unroll
                for (int nt = 0; nt < 2; ++nt) { u32x2v o; o.x = cvtpk(acc[mt][nt][0], acc[mt][nt][1]); o.y = cvtpk(acc[mt][nt][2], acc[mt][nt][3]);
                    *(LAS u32x2v*)(Sl + (16 * nt + r16) * 136 + 16 * mt + 4 * g) = o;
                    if (on) *(GAS u32x2v*)(SG + ((size_t)(uh + 1) * 128 + c0 + 16 * nt + r16) * 128 + 16 * mt + 4 * g) = o; }
            asm volatile("s_waitcnt lgkmcnt(0)" ::: "memory");
        }
    }
    __syncthreads();
}

__device__ __forceinline__ void p_g3(const Frame& F, const Args& a, int L) {
    GAS unsigned char* ws = (GAS unsigned char*)a.ws; asm volatile("" : "+s"(ws)); int lane_ = F.lane; asm volatile("" : "+v"(lane_)); const int j = L >> 1, lane = lane_, r16 = lane & 15, g = lane >> 4;
    const bf16 *PO = (const bf16*)(ws + WS_ARENA + AR_PO), *QT = (const bf16*)(ws + WS_ARENA + AR_QT), *AI = (const bf16*)(ws + WS_ARENA + AR_AI), *NEGW = (const bf16*)(ws + WS_ARENA + AR_NEGW),
               *UT = (const bf16*)(ws + WS_ARENA + AR_UT), *SG = (const bf16*)(ws + WS_ARENA + AR_SG);
    bf16* mix = (bf16*)(ws + WS_MIX); const float* onorm = (const float*)a.in[19] + j * 128;
    const f32x4 Z4 = {0.f, 0.f, 0.f, 0.f};
#pragma unroll 1
    for (int u = F.gw; u < NUNIT; u += F.NGW) {
        const int n = u >> 3, hh = u & 7, tok0 = 64 * n; const int uh = hh * NCHUNK + n;
        unsigned vn[8][4][2];
        {
            bf16x8 nw[4][4];
#pragma unroll
            for (int jt = 0; jt < 4; ++jt)
#pragma unroll
                for (int kk = 0; kk < 4; ++kk) nw[jt][kk] = ld16g(NEGW + (size_t)(tok0 + 16 * jt + r16) * D_ + hh * 128 + 32 * kk + 8 * g);
#pragma unroll
            for (int d2t = 0; d2t < 8; ++d2t) {
                bf16x8 sg[4];
#pragma unroll
                for (int kk = 0; kk < 4; ++kk) sg[kk] = ld16g(SG + ((size_t)uh * 128 + 16 * d2t + r16) * 128 + 32 * kk + 8 * g);
#pragma unroll
                for (int jt = 0; jt < 4; ++jt) {
                    const u32x2v c = *(const GAS u32x2v*)(UT + ((size_t)u * 128 + 16 * d2t + r16) * 64 + 16 * jt + 4 * g);
                    f32x4 Dv = {bflo(c.x), bfhi(c.x), bflo(c.y), bfhi(c.y)};
#pragma unroll
                    for (int kk = 0; kk < 4; ++kk) Dv = MF16(nw[jt][kk], sg[kk], Dv);
                    vn[d2t][jt][0] = cvtpk(Dv[0], Dv[1]); vn[d2t][jt][1] = cvtpk(Dv[2], Dv[3]);
                    asm volatile("" : "+v"(vn[d2t][jt][0]), "+v"(vn[d2t][jt][1]));
                }
                asm volatile("" ::: "memory");
            }
        }
#pragma unroll 1
        for (int ti = 0; ti < 4; ++ti) {
            const int tok = tok0 + 16 * ti + r16;
            bf16x8 qf[4], af[2];
#pragma unroll
            for (int kk = 0; kk < 4; ++kk) qf[kk] = ld16g(QT + (size_t)tok * D_ + hh * 128 + 32 * kk + 8 * g);
#pragma unroll
            for (int k2 = 0; k2 < 2; ++k2) { const u32x2v lo = *(const GAS u32x2v*)(AI + ((size_t)u * 64 + 16 * ti + r16) * 64 + 32 * k2 + 4 * g), hi = *(const GAS u32x2v*)(AI + ((size_t)u * 64 + 16 * ti + r16) * 64 + 32 * k2 + 16 + 4 * g);
                const v4u pk = {lo.x, lo.y, hi.x, hi.y}; af[k2] = __builtin_bit_cast(bf16x8, pk); }
            f32x4 acc[8]; float ss = 0.f;
#pragma unroll
            for (int d2t = 0; d2t < 8; ++d2t) {
                f32x4 Dv = Z4;
#pragma unroll
                for (int kk = 0; kk < 4; ++kk) { const bf16x8 sgf = ld16g(SG + ((size_t)uh * 128 + 16 * d2t + r16) * 128 + 32 * kk + 8 * g); Dv = MF16(sgf, qf[kk], Dv); }
#pragma unroll
                for (int k2 = 0; k2 < 2; ++k2) { const v4u pk = {vn[d2t][2 * k2][0], vn[d2t][2 * k2][1], vn[d2t][2 * k2 + 1][0], vn[d2t][2 * k2 + 1][1]}; Dv = MF16(__builtin_bit_cast(bf16x8, pk), af[k2], Dv); }
                acc[d2t] = Dv; ss += (Dv[0] * Dv[0] + Dv[1] * Dv[1]) + (Dv[2] * Dv[2] + Dv[3] * Dv[3]);
            }
            ss += __shfl_xor(ss, 16); ss += __shfl_xor(ss, 32);
            const float rms = __builtin_amdgcn_rsqf(ss * (1.0f / 128.0f) + RMS_EPS);
#pragma unroll
            for (int d2t = 0; d2t < 8; ++d2t) {
                const u32x2v z = *(const GAS u32x2v*)(PO + (size_t)tok * OIN + 3072 + hh * 128 + 16 * d2t + 4 * g); const f32x4 gn = *(const GAS f32x4*)(onorm + 16 * d2t + 4 * g);
                st8(mix + (size_t)tok * D_ + hh * 128 + 16 * d2t + 4 * g, acc[d2t][0] * rms * gn[0] * silu(bflo(z.x)), acc[d2t][1] * rms * gn[1] * silu(bfhi(z.x)),
                    acc[d2t][2] * rms * gn[2] * silu(bflo(z.y)), acc[d2t][3] * rms * gn[3] * silu(bfhi(z.y)));
            }
        }
    }
}

__device__ __forceinline__ void p_r1(const Frame& F, const Args& a, int L) {
    GAS unsigned char* ws = (GAS unsigned char*)a.ws; asm volatile("" : "+s"(ws)); int lane_ = F.lane; asm volatile("" : "+v"(lane_)); const int j = L >> 1, lane = lane_;
    const float* ssq = (const float*)(ws + WS_SSQA); const float* wr = (const float*)a.in[24] + (size_t)j * D_ * NEXP; const float* ln = (const float*)a.in[4] + L * D_;
    int* tok_e = (int*)(ws + WS_TOK + TOK_E); int* tok_r = (int*)(ws + WS_TOK + TOK_R); float* tok_g = (float*)(ws + WS_TOK + TOK_G);
    unsigned* gcount = (unsigned*)(ws + WS_CTL) + CW_CNT + 64 * j;
    LAS int* rt = (LAS int*)(F.lds + RT_OFF);
    if (F.tid < 16) rt[F.tid] = 0;
    __syncthreads();
    const GAS float* hG = (const GAS float*)a.out; const GAS float* wrG = (const GAS float*)wr; const GAS float* lnG = (const GAS float*)ln;
    float lnr[16];
#pragma unroll
    for (int i = 0; i < 16; ++i) lnr[i] = lnG[64 * i + lane];
#pragma unroll 1
    for (int t = F.gw; t < S_; t += 2 * F.NGW) {
        const int tb = t + F.NGW; const bool hasb = tb < S_; const int tbc = hasb ? tb : t;
        float xa[16], xb[16];
#pragma unroll
        for (int i = 0; i < 16; ++i) { xa[i] = hG[(size_t)t * D_ + 64 * i + lane]; xb[i] = hG[(size_t)tbc * D_ + 64 * i + lane]; }
        const float rsa = pg8::rstd_row(ssq, t), rsb = pg8::rstd_row(ssq, tbc);
        float acca[8], accb[8];
#pragma unroll
        for (int e = 0; e < 8; ++e) { acca[e] = 0.f; accb[e] = 0.f; }
#pragma unroll
        for (int i = 0; i < 16; ++i) { const int k = 64 * i + lane; const f32x4 w0 = *(const GAS f32x4*)(wrG + (size_t)k * 8), w1 = *(const GAS f32x4*)(wrG + (size_t)k * 8 + 4);
            const float x = xa[i] * lnr[i], y = xb[i] * lnr[i];
            acca[0] += x * w0[0]; acca[1] += x * w0[1]; acca[2] += x * w0[2]; acca[3] += x * w0[3]; acca[4] += x * w1[0]; acca[5] += x * w1[1]; acca[6] += x * w1[2]; acca[7] += x * w1[3];
            accb[0] += y * w0[0]; accb[1] += y * w0[1]; accb[2] += y * w0[2]; accb[3] += y * w0[3]; accb[4] += y * w1[0]; accb[5] += y * w1[1]; accb[6] += y * w1[2]; accb[7] += y * w1[3]; }
#pragma unroll
        for (int e = 0; e < 8; ++e) { acca[e] = wave_sum(acca[e]) * rsa; accb[e] = wave_sum(accb[e]) * rsb; }
#pragma unroll
        for (int half = 0; half < 2; ++half) {
            if (half == 1 && !hasb) break;
            const int tt = half ? tb : t; float acc[8];
#pragma unroll
            for (int e = 0; e < 8; ++e) acc[e] = half ? accb[e] : acca[e];
            int e0 = 0; float l0 = acc[0];
#pragma unroll
            for (int e = 1; e < 8; ++e) if (acc[e] > l0) { l0 = acc[e]; e0 = e; }
            int e1 = -1; float l1 = -INFINITY;
#pragma unroll
            for (int e = 0; e < 8; ++e) if (e != e0 && acc[e] > l1) { l1 = acc[e]; e1 = e; }
            const float g1 = 1.0f / (1.0f + expf(l0 - l1)), g0 = 1.0f - g1;
            if (lane == 0) {
                const int r0 = __hip_atomic_fetch_add(rt + e0, 1, __ATOMIC_RELAXED, __HIP_MEMORY_SCOPE_WORKGROUP), r1 = __hip_atomic_fetch_add(rt + e1, 1, __ATOMIC_RELAXED, __HIP_MEMORY_SCOPE_WORKGROUP);
                tok_e[2 * tt] = e0; tok_e[2 * tt + 1] = e1; tok_r[2 * tt] = r0; tok_r[2 * tt + 1] = r1; tok_g[2 * tt] = g0; tok_g[2 * tt + 1] = g1;
            }
        }
    }
    __syncthreads();
    if (F.tid < 8) rt[8 + F.tid] = (int)__hip_atomic_fetch_add(gcount + F.tid, (unsigned)rt[F.tid], __ATOMIC_RELAXED, __HIP_MEMORY_SCOPE_AGENT);
    __syncthreads();
#pragma unroll 1
    for (int t = F.gw; t < S_; t += F.NGW) if (lane < 2) { const int e = tok_e[2 * t + lane]; tok_r[2 * t + lane] += rt[8 + e]; }
    __syncthreads();
}
__device__ __forceinline__ int moe_pstart(const unsigned* gcount, int e) {
    int ps = 0;
#pragma unroll
    for (int q = 0; q < 8; ++q) { const int c = (int)gcount[q]; if (q < e) ps += ((c + 255) >> 8) << 8; }
    return ps;
}
__device__ __forceinline__ void p_r2(const Frame& F, const Args& a, int L) {
    GAS unsigned char* ws = (GAS unsigned char*)a.ws; asm volatile("" : "+s"(ws)); int lane_ = F.lane; asm volatile("" : "+v"(lane_)); const int j = L >> 1, lane = lane_;
    const float* ssq = (const float*)(ws + WS_SSQA);
    const int* tok_e = (const int*)(ws + WS_TOK + TOK_E); const int* tok_r = (const int*)(ws + WS_TOK + TOK_R); const float* tok_g = (const float*)(ws + WS_TOK + TOK_G);
    int* dst = (int*)(ws + WS_TOK + TOK_DST); float* gpad = (float*)(ws + WS_TOK + TOK_GPAD);
    const unsigned* gcount = (const unsigned*)(ws + WS_CTL) + CW_CNT + 64 * j; bf16* XS = (bf16*)(ws + WS_ARENA + AR_XS);
    int pst[8]; { int ps = 0;
#pragma unroll
        for (int q = 0; q < 8; ++q) { pst[q] = ps; ps += (((int)gcount[q] + 255) >> 8) << 8; } }
    const GAS float* hG = (const GAS float*)a.out;
#pragma unroll 1
    for (int t0 = F.gw; t0 < S_; t0 += 4 * F.NGW) {
        int tt[4], da[4], db[4]; float rs[4], ga[4], gb[4]; f32x4 v[4][4];
#pragma unroll
        for (int u = 0; u < 4; ++u) { const int t = t0 + u * F.NGW; tt[u] = t < S_ ? t : t0;
#pragma unroll
            for (int q = 0; q < 4; ++q) v[u][q] = *((const GAS f32x4*)(hG + (size_t)tt[u] * D_) + 64 * q + lane); }
#pragma unroll
        for (int u = 0; u < 4; ++u) { const int t = tt[u]; rs[u] = pg8::rstd_row(ssq, t);
            const int ea = tok_e[2 * t], eb = tok_e[2 * t + 1]; int pa = 0, pb = 0;
#pragma unroll
            for (int q = 0; q < 8; ++q) { pa = (q == ea) ? pst[q] : pa; pb = (q == eb) ? pst[q] : pb; }
            da[u] = pa + tok_r[2 * t]; db[u] = pb + tok_r[2 * t + 1]; ga[u] = tok_g[2 * t]; gb[u] = tok_g[2 * t + 1]; }
#pragma unroll
        for (int u = 0; u < 4; ++u) { if (t0 + u * F.NGW >= S_) break; const int t = tt[u];
            if (lane == 0) { dst[2 * t] = da[u]; dst[2 * t + 1] = db[u]; gpad[da[u]] = ga[u]; gpad[db[u]] = gb[u]; }
#pragma unroll
            for (int q = 0; q < 4; ++q) { const f32x4 x = v[u][q] * rs[u]; u32x2v o; o.x = cvtpk(x[0], x[1]); o.y = cvtpk(x[2], x[3]);
                *((GAS u32x2v*)(XS + (size_t)da[u] * D_) + 64 * q + lane) = o; *((GAS u32x2v*)(XS + (size_t)db[u] * D_) + 64 * q + lane) = o; } }
    }
}
__device__ __forceinline__ int moe_blocks(const Frame& F, const Args& a, int L) {
    const unsigned* gcount = (const unsigned*)(a.ws + WS_CTL) + CW_CNT + 64 * (L >> 1);
    LAS int* blk = (LAS int*)(F.lds + BLKE_OFF);
    int nb_tot = 0, mine = 7;
#pragma unroll
    for (int q = 0; q < 8; ++q) { const int nb = ((int)gcount[q] + 255) >> 8; if (F.tid >= nb_tot && F.tid < nb_tot + nb) mine = q; nb_tot += nb; }
    __syncthreads();
    if (F.tid < 160) blk[F.tid] = mine;
    __syncthreads();
    return nb_tot;
}
__device__ __forceinline__ void p_combine(const Frame& F, const Args& a) {
    GAS unsigned char* ws = (GAS unsigned char*)a.ws; asm volatile("" : "+s"(ws)); int lane_ = F.lane; asm volatile("" : "+v"(lane_)); const int lane = lane_;
    const int* dst = (const int*)(ws + WS_TOK + TOK_DST); const bf16* Y = (const bf16*)(ws + WS_ARENA + AR_Y); bf16* hb = (bf16*)(ws + WS_HBF); float* ssq = (float*)(ws + WS_SSQA);
    const GAS float* hG = (const GAS float*)a.out;
#pragma unroll 1
    for (int t0 = F.gw; t0 < S_; t0 += 2 * F.NGW) {
        int tt[2], da[2], db[2]; f32x4 v[2][4]; u32x2v ya[2][4], yb[2][4];
#pragma unroll
        for (int u = 0; u < 2; ++u) { const int t = t0 + u * F.NGW; tt[u] = t < S_ ? t : t0; da[u] = dst[2 * tt[u]]; db[u] = dst[2 * tt[u] + 1];
#pragma unroll
            for (int q = 0; q < 4; ++q) v[u][q] = *((const GAS f32x4*)(hG + (size_t)tt[u] * D_) + 64 * q + lane); }
#pragma unroll
        for (int u = 0; u < 2; ++u)
#pragma unroll
            for (int q = 0; q < 4; ++q) { ya[u][q] = *((const GAS u32x2v*)(Y + (size_t)da[u] * D_) + 64 * q + lane); yb[u][q] = *((const GAS u32x2v*)(Y + (size_t)db[u] * D_) + 64 * q + lane); }
#pragma unroll
        for (int u = 0; u < 2; ++u) { if (t0 + u * F.NGW >= S_) break; const int t = tt[u]; float ss = 0.f;
#pragma unroll
            for (int q = 0; q < 4; ++q) { f32x4 x = v[u][q];
                x[0] += bflo(ya[u][q].x) + bflo(yb[u][q].x); x[1] += bfhi(ya[u][q].x) + bfhi(yb[u][q].x); x[2] += bflo(ya[u][q].y) + bflo(yb[u][q].y); x[3] += bfhi(ya[u][q].y) + bfhi(yb[u][q].y);
                *((GAS f32x4*)(a.out + (size_t)t * D_) + 64 * q + lane) = x; ss += (x[0] * x[0] + x[1] * x[1]) + (x[2] * x[2] + x[3] * x[3]);
                u32x2v o; o.x = cvtpk(x[0], x[1]); o.y = cvtpk(x[2], x[3]); *((GAS u32x2v*)(hb + (size_t)t * D_) + 64 * q + lane) = o; }
            ss = wave_sum(ss);
            if (lane < 16) ssq[(size_t)t * 16 + lane] = (lane == 0) ? ss : 0.f; }
    }
}
__device__ __forceinline__ void p_final(const Frame& F, const Args& a) {
    GAS unsigned char* ws = (GAS unsigned char*)a.ws; asm volatile("" : "+s"(ws)); int lane_ = F.lane; asm volatile("" : "+v"(lane_)); const int lane = lane_; const float* ssq = (const float*)(ws + WS_SSQB); const float* ln = (const float*)a.in[6];
#pragma unroll 1
    for (int t = F.gw; t < S_; t += F.NGW) { const float rs = pg8::rstd_row(ssq, t);
#pragma unroll
        for (int q = 0; q < 4; ++q) { GAS f32x4* hp = (GAS f32x4*)(a.out + (size_t)t * D_) + 64 * q + lane; const f32x4 gq = *((const GAS f32x4*)ln + 64 * q + lane); *hp = (*hp) * rs * gq; } }
}
__device__ __forceinline__ void p_moe_weights(const Frame& F, const Args& a, int L, int w0, int nw) {
    LAS float* scr = (LAS float*)(F.lds + F.wave * WAVE_LDS);
    int base = 0;
#pragma unroll 1
    for (int id = 0; id < 24; ++id) { const MatD m = moe_mat(a, L >> 1, id);
        int first = (w0 - base) % nw; if (first < 0) first += nw;
#pragma unroll 1
        for (int it = first; it < m.items; it += nw) xpose_item(m.W, m.ldw, m.K, m.N, m.gain, m.WT, m.ilv, scr, it, F.lane);
        base += m.items; }
}

constexpr int P_PRO = 0, P_FINAL = 81, LP_ROT = 16, LP_G1B = 17, LP_G2B = 18, LPN = 20, LP_PROJ = 0, LP_ATT = 1, LP_MIXPREP = 2, LP_GA = 3, LP_G1 = 4, LP_G2 = 5, LP_G3 = 6, LP_OUT = 7, LP_UP = 8, LP_DOWN = 9, LP_R1 = 10, LP_R2 = 11, LP_M1 = 12, LP_M2 = 13, LP_COMB = 14, LP_PLE = 15;

#ifndef PH_MASK
#define PH_MASK 0xffffffffull
#endif
#define IN(k) (lo <= (k) && (k) < hi)
#define INL(lp) ((((unsigned long long)(PH_MASK) >> (lp)) & 1) && lo <= pb + (lp) && pb + (lp) < hi)
#define SEAM() do { if (args.use_bar) xcd_barrier(bar); } while (0)
#ifndef REP_LP
#define REP_LP -1
#endif
#ifndef REP_L
#define REP_L -1
#endif
#ifndef REP_N
#define REP_N 2
#endif
#define REPS(lp) ((L == (REP_L) && (lp) == (REP_LP)) ? 1 + (REP_N) : 1)
#if REP_LP >= 0
#define REPLOOP(lp) _Pragma("unroll 1") for (int rep_ = 0; rep_ < REPS(lp); ++rep_)
#else
#define REPLOOP(lp)
#endif
#define PHASE_WS() GAS unsigned char* ws = (GAS unsigned char*)ws0; asm volatile("" : "+s"(ws)); bf16* HBF = (bf16*)(ws + WS_HBF); bf16* MIX = (bf16*)(ws + WS_MIX); bf16* PP = (bf16*)(ws + WS_PP); float* SSQA = (float*)(ws + WS_SSQA); float* SSQB = (float*)(ws + WS_SSQB); (void)HBF; (void)MIX; (void)PP; (void)SSQA; (void)SSQB
template <int L> __device__ __forceinline__ void run_layer(const Frame& F, const Args& args, unsigned char* lds, const XcdBarrier& bar, unsigned char* ws0, const int lo, const int hi, const int cid) {
        const int pb = 1 + LPN * L, j = L >> 1; const bool odd = (L & 1) != 0;
        REPLOOP(LP_PROJ) if (INL(LP_PROJ)) { PHASE_WS();
            if (!odd) {
                pg8::Gemm gm{HBF, (const bf16*)(ws + WS_WINE) + (size_t)j * EIN * D_, S_, EIN, D_, 0}; pg8::StaticOrder So; So.init(S_, EIN, F.G, cid);
                pg8::EpiBf16 E{(bf16*)(ws + WS_ARENA + AR_PE), EIN, SSQB, pg8::C2, 512};
                pg8::gemm_phase<pg8::EpiBf16, pg8::StaticOrder, true, true>(F.lds + RING_OFF, gm, So, E);
            } else {
                pg8::Gemm gm{HBF, (const bf16*)(ws + WS_WINO) + (size_t)j * OIN * D_, S_, OIN, D_, 0}; pg8::StaticOrder So; So.init(S_, OIN, F.G, cid);
                pg8::EpiBf16 E{(bf16*)(ws + WS_ARENA + AR_PO), OIN, SSQB, 1.0f, 0};
                pg8::gemm_phase<pg8::EpiBf16, pg8::StaticOrder, true, true>(F.lds + RING_OFF, gm, So, E);
            }
            {
                pg8::Gemm gm{(const bf16*)(ws + WS_PBF) + (size_t)L * S_ * PLE, (const bf16*)(ws + WS_WP) + (size_t)L * D_ * PLE, S_, D_, PLE, 0}; pg8::StaticOrder So; So.init(S_, D_, F.G, cid);
                pg8::EpiBf16 E{PP, D_, nullptr, 1.0f, 0};
                pg8::gemm_phase<pg8::EpiBf16, pg8::StaticOrder, true, true>(F.lds + RING_OFF, gm, So, E);
            }
            if (odd) p_ab(F, args, L);
            SEAM();
        }
        if (!odd) {
            REPLOOP(LP_ROT) if (INL(LP_ROT)) { PHASE_WS(); p_rot(F, args); SEAM(); }
            REPLOOP(LP_ATT) if (INL(LP_ATT)) { PHASE_WS(); attn_body::attn_phase<8>((char*)lds + RING_OFF, (const attn_body::bf16*)(ws + WS_ARENA + AR_PE), (attn_body::bf16*)(ws + WS_ARENA + AR_AO), F.vcu, F.G); SEAM(); }
            REPLOOP(LP_MIXPREP) if (INL(LP_MIXPREP)) { PHASE_WS(); p_mixprep(F, args, L); SEAM(); }
        } else {
            REPLOOP(LP_GA) if (INL(LP_GA)) { PHASE_WS(); p_ga(F, args, L); SEAM(); }
            REPLOOP(LP_G1) if (INL(LP_G1)) { PHASE_WS(); p_g1(F, args); SEAM(); }
            REPLOOP(LP_G1B) if (INL(LP_G1B)) { PHASE_WS(); p_g1b(F, args); SEAM(); }
            REPLOOP(LP_G2) if (INL(LP_G2)) { PHASE_WS();
                const int nscan = F.G < 64 ? F.G : 64;
#ifdef PROBE_NOCONV
                if (!args.use_bar) { if (F.vcu < nscan) p_g2<64, 4>(F, args, (const bf16*)(ws + WS_ARENA + AR_MPC), (const bf16*)(ws + WS_ARENA + AR_NTC), (const float*)(ws + WS_TOK + TOK_DNC)); } else
#endif
#ifdef PROBE_NOSCAN
                if (!args.use_bar) { if (F.vcu >= nscan) p_moe_weights(F, args, L, (F.vcu - nscan) * NWAVES + F.wave, (F.G - nscan) * NWAVES); } else
#endif
                if (F.vcu < nscan) p_g2<64, 4>(F, args, (const bf16*)(ws + WS_ARENA + AR_MPC), (const bf16*)(ws + WS_ARENA + AR_NTC), (const float*)(ws + WS_TOK + TOK_DNC));
                else p_moe_weights(F, args, L, (F.vcu - nscan) * NWAVES + F.wave, (F.G - nscan) * NWAVES);
                if (F.G <= 64) p_moe_weights(F, args, L, F.gw, F.NGW);
                SEAM();
            }
            REPLOOP(LP_G2B) if (INL(LP_G2B)) { PHASE_WS(); p_g2b(F, args); SEAM(); }
            REPLOOP(LP_G3) if (INL(LP_G3)) { PHASE_WS(); p_g3(F, args, L); SEAM(); }
        }
        REPLOOP(LP_OUT) if (INL(LP_OUT)) { PHASE_WS();
            const bf16* Wo = odd ? (const bf16*)(ws + WS_WOUTO) + (size_t)j * D_ * D_ : (const bf16*)(ws + WS_WOUTE) + (size_t)j * D_ * D_;
            pg8::Gemm gm{MIX, Wo, S_, D_, D_, 0}; pg8::StaticOrder So; So.init(S_, D_, F.G, cid);
            pg8::EpiResid E{args.out, HBF, SSQA};
            pg8::gemm_phase<pg8::EpiResid, pg8::StaticOrder, true, true>(F.lds + RING_OFF, gm, So, E);
            SEAM();
        }
        if (!odd) {
            REPLOOP(LP_UP) if (INL(LP_UP)) { PHASE_WS();
                pg8::Gemm gm{HBF, (const bf16*)(ws + WS_W13D) + (size_t)j * 2 * DFF * D_, S_, 2 * DFF, D_, 0}; pg8::StaticOrder So; So.init(S_, 2 * DFF, F.G, cid);
                pg8::EpiSwiglu E{(bf16*)(ws + WS_ARENA + AR_ACT), SSQA};
                pg8::gemm_phase<pg8::EpiSwiglu, pg8::StaticOrder, true, true>(F.lds + RING_OFF, gm, So, E);
                SEAM();
            }
            REPLOOP(LP_DOWN) if (INL(LP_DOWN)) { PHASE_WS();
                pg8::Gemm gm{(const bf16*)(ws + WS_ARENA + AR_ACT), (const bf16*)(ws + WS_W2D) + (size_t)j * D_ * DFF, S_, D_, DFF, 0}; pg8::StaticOrder So; So.init(S_, D_, F.G, cid);
                pg8::EpiResid E{args.out, HBF, SSQA};
                pg8::gemm_phase<pg8::EpiResid, pg8::StaticOrder, true, true>(F.lds + RING_OFF, gm, So, E);
                SEAM();
            }
        } else {
            REPLOOP(LP_R1) if (INL(LP_R1)) { PHASE_WS(); p_r1(F, args, L); SEAM(); }
            REPLOOP(LP_R2) if (INL(LP_R2)) { PHASE_WS(); p_r2(F, args, L); SEAM(); }
            REPLOOP(LP_M1) if (INL(LP_M1)) { PHASE_WS();
                const int nb = moe_blocks(F, args, L);
                pg8::Gemm gm{(const bf16*)(ws + WS_ARENA + AR_XS), (const bf16*)(ws + WS_W13M), nb * 256, 2 * DFF, D_, (size_t)2 * DFF * D_ * 2}; pg8::MoeOrder So; So.init(nb * 256, 2 * DFF, F.G, cid); So.blk_e = (const LAS int*)(F.lds + BLKE_OFF);
                pg8::EpiSwiglu E{(bf16*)(ws + WS_ARENA + AR_ACT), nullptr};
                pg8::gemm_phase<pg8::EpiSwiglu, pg8::MoeOrder, true, true>(F.lds + RING_OFF, gm, So, E);
                SEAM();
            }
            REPLOOP(LP_M2) if (INL(LP_M2)) { PHASE_WS();
                const int nb = moe_blocks(F, args, L);
                pg8::Gemm gm{(const bf16*)(ws + WS_ARENA + AR_ACT), (const bf16*)(ws + WS_W2M), nb * 256, D_, DFF, (size_t)D_ * DFF * 2}; pg8::MoeOrder So; So.init(nb * 256, D_, F.G, cid); So.blk_e = (const LAS int*)(F.lds + BLKE_OFF);
                pg8::EpiMoeDown E{(bf16*)(ws + WS_ARENA + AR_Y), (const float*)(ws + WS_TOK + TOK_GPAD)};
                pg8::gemm_phase<pg8::EpiMoeDown, pg8::MoeOrder, true, true>(F.lds + RING_OFF, gm, So, E);
                SEAM();
            }
            REPLOOP(LP_COMB) if (INL(LP_COMB)) { PHASE_WS(); p_combine(F, args); SEAM(); }
        }
        REPLOOP(LP_PLE) if (INL(LP_PLE)) { PHASE_WS();
            pg8::Gemm gm{HBF, (const bf16*)(ws + WS_WG) + (size_t)L * D_ * D_, S_, D_, D_, 0}; pg8::StaticOrder So; So.init(S_, D_, F.G, cid);
            pg8::EpiPle E{args.out, HBF, SSQA, SSQB, PP};
            pg8::gemm_phase<pg8::EpiPle, pg8::StaticOrder, true, true>(F.lds + RING_OFF, gm, So, E);
            SEAM();
        }
    }

__global__ void __launch_bounds__(NWAVES * 64, 2) fwd(Args args) {
    extern __shared__ __attribute__((aligned(16))) unsigned char lds[];
    Frame F;
    F.lds = (LAS unsigned char*)lds; F.tid = threadIdx.x; F.lane = F.tid & 63; F.wave = __builtin_amdgcn_readfirstlane(F.tid >> 6);
    F.G = gridDim.x; { const int bx = blockIdx.x; F.vcu = (F.G % 8 == 0) ? (bx % 8) * (F.G / 8) + bx / 8 : bx; }
    F.gw = F.vcu * NWAVES + F.wave; F.NGW = F.G * NWAVES;
    unsigned char* ws0 = args.ws;
    for (int u = F.tid; u < (LDS_BYTES - LDSCTL_OFF) / 4; u += NWAVES * 64) ((LAS unsigned*)(F.lds + LDSCTL_OFF))[u] = 0u;
    __syncthreads();
    XcdBarrier bar; bar.bar = (unsigned*)(ws0 + WS_CTL) + CW_BAR; bar.x = 0; bar.st = nullptr;
    if (args.use_bar) bar = xcd_barrier_post((unsigned*)(ws0 + WS_CTL) + CW_BAR, (volatile LAS unsigned*)(F.lds + MISC_OFF));
    const int lo = args.ph_lo, hi = args.ph_hi;
    const int cid = (int)blockIdx.x;

    if ((((unsigned long long)(PH_MASK) >> 30) & 1) && IN(P_PRO)) { p_prologue(F, args); SEAM(); }

#ifdef FIXED_L
    run_layer<FIXED_L>(F, args, lds, bar, ws0, lo, hi, cid);
#else
    run_layer<0>(F, args, lds, bar, ws0, lo, hi, cid); run_layer<1>(F, args, lds, bar, ws0, lo, hi, cid); run_layer<2>(F, args, lds, bar, ws0, lo, hi, cid); run_layer<3>(F, args, lds, bar, ws0, lo, hi, cid);
#endif
    if ((((unsigned long long)(PH_MASK) >> 31) & 1) && IN(P_FINAL)) p_final(F, args);
#undef IN
#undef INL
#undef SEAM
}


#ifndef DBG
#define DBG 0
#endif
#if DBG
#ifndef DBG_ASLOT
#define DBG_ASLOT 9
#endif
#ifndef DBG_BSLOT
#define DBG_BSLOT 11
#endif
__global__ void dbg_scan(const void* p, size_t n, int is_f32, unsigned* slot) {
    unsigned cnt = 0;
    for (size_t i = (size_t)blockIdx.x * blockDim.x + threadIdx.x; i < n; i += (size_t)gridDim.x * blockDim.x) {
        const float v = is_f32 ? ((const float*)p)[i] : __uint_as_float(((unsigned)((const unsigned short*)p)[i]) << 16);
        if (!(fabsf(v) < 1e30f)) ++cnt; }
    if (cnt) atomicAdd(slot, cnt);
}
__global__ void dbg_fill(float* out, size_t n, const unsigned* slots, int nslots) {
    int first = -1; for (int i = 0; i < nslots; ++i) if (slots[i]) { first = i; break; }
    float c, V;
    if (first >= 0) { c = sqrtf((float)(10 + first) * 1e6f); V = c; }
    else { const float ea = fmaxf(__uint_as_float(slots[256 + DBG_ASLOT]), 1e-5f), eb = fmaxf(__uint_as_float(slots[256 + DBG_BSLOT]), 1e-5f);
        c = sqrtf((10.f + fminf(60.f, rintf(10.f * (log10f(ea) + 5.f)))) * 1e4f); V = (50.f + rintf(10.f * log10f(eb))) * 1e3f; }
    for (size_t i = (size_t)blockIdx.x * blockDim.x + threadIdx.x; i < n; i += (size_t)gridDim.x * blockDim.x) out[i] = (i == 0) ? V : c;
}
__device__ __forceinline__ float dbg_bf(const unsigned short* p, size_t i) { return __uint_as_float(((unsigned)p[i]) << 16); }
__device__ __forceinline__ float dbg_rstd(const float* ssq, int row) { float s = 0.f; for (int i = 0; i < 16; ++i) s += ssq[(size_t)row * 16 + i]; return 1.0f / sqrtf(s / 1024.0f + 1e-6f); }
__device__ __forceinline__ float dbg_blocksum(float v, float* red) {
    __syncthreads(); red[threadIdx.x] = v; __syncthreads();
    for (int o = 128; o > 0; o >>= 1) { if ((int)threadIdx.x < o) red[threadIdx.x] += red[threadIdx.x + o]; __syncthreads(); }
    const float r = red[0]; __syncthreads(); return r;
}
__device__ __forceinline__ void dbg_report(unsigned* slot, float num, float den) { if (threadIdx.x == 0) atomicMax(slot, __float_as_uint(sqrtf(num / fmaxf(den, 1e-20f)))); }
__global__ void chk_ffn(const float* hpre, const float* hpost, const float* ssq, const float* ln, const float* wr, const float* w1, const float* w3, const float* w2, int moe, unsigned* slot) {
    __shared__ float xn[1024]; __shared__ float hid[3584]; __shared__ float red[256]; __shared__ float lg[8];
    const int t = (blockIdx.x * 997 + 13) % S_, tid = threadIdx.x;
    const float rs = dbg_rstd(ssq, t);
    for (int k = tid; k < 1024; k += 256) xn[k] = hpre[(size_t)t * 1024 + k] * rs * ln[k];
    __syncthreads();
    int e0 = 0, e1 = 0; float g0 = 1.f, g1 = 0.f;
    if (moe) {
        if (tid < 8) { float s = 0.f; for (int k = 0; k < 1024; ++k) s += xn[k] * wr[(size_t)k * 8 + tid]; lg[tid] = s; }
        __syncthreads();
        float l0 = lg[0]; for (int e = 1; e < 8; ++e) if (lg[e] > l0) { l0 = lg[e]; e0 = e; }
        float l1 = -1e30f; e1 = -1; for (int e = 0; e < 8; ++e) if (e != e0 && lg[e] > l1) { l1 = lg[e]; e1 = e; }
        const float m0 = expf(l0 - l0), m1 = expf(l1 - l0); g0 = m0 / (m0 + m1); g1 = m1 / (m0 + m1);
    }
    float acc[4] = {0.f, 0.f, 0.f, 0.f};
    for (int pass = 0; pass < (moe ? 2 : 1); ++pass) {
        const int e = pass == 0 ? e0 : e1; const float gt = pass == 0 ? g0 : g1;
        const float* W1 = w1 + (size_t)e * 1024 * 3584; const float* W3 = w3 + (size_t)e * 1024 * 3584; const float* W2 = w2 + (size_t)e * 3584 * 1024;
        __syncthreads();
        for (int f = tid; f < 3584; f += 256) { float a = 0.f, b = 0.f; for (int k = 0; k < 1024; ++k) { a += xn[k] * W1[(size_t)k * 3584 + f]; b += xn[k] * W3[(size_t)k * 3584 + f]; } hid[f] = a / (1.f + expf(-a)) * b; }
        __syncthreads();
        for (int q = 0; q < 4; ++q) { const int c = tid + 256 * q; float y = 0.f; for (int f = 0; f < 3584; ++f) y += hid[f] * W2[(size_t)f * 1024 + c]; acc[q] += gt * y; }
    }
    float num = 0.f, den = 0.f;
    for (int q = 0; q < 4; ++q) { const int c = tid + 256 * q; const float ex = acc[q], got = hpost[(size_t)t * 1024 + c] - hpre[(size_t)t * 1024 + c]; num += (got - ex) * (got - ex); den += ex * ex; }
    num = dbg_blocksum(num, red); den = dbg_blocksum(den, red);
    dbg_report(slot, num, den);
}
__global__ void chk_ple(const float* hpre, const float* hpost, const float* ssq, const float* ln, const float* wg, const float* p, const float* wp, unsigned* slot) {
    __shared__ float xn[1024]; __shared__ float red[256];
    const int t = (blockIdx.x * 997 + 13) % S_, tid = threadIdx.x; const float rs = dbg_rstd(ssq, t);
    for (int k = tid; k < 1024; k += 256) xn[k] = hpre[(size_t)t * 1024 + k] * rs * ln[k];
    __syncthreads();
    float num = 0.f, den = 0.f;
    for (int q = 0; q < 4; ++q) { const int c = tid + 256 * q; float a = 0.f, b = 0.f; for (int k = 0; k < 1024; ++k) a += xn[k] * wg[(size_t)k * 1024 + c]; for (int k = 0; k < 256; ++k) b += p[(size_t)t * 256 + k] * wp[(size_t)k * 1024 + c];
        const float ex = b / (1.f + expf(-a)), got = hpost[(size_t)t * 1024 + c] - hpre[(size_t)t * 1024 + c]; num += (got - ex) * (got - ex); den += ex * ex; }
    num = dbg_blocksum(num, red); den = dbg_blocksum(den, red); dbg_report(slot, num, den);
}
constexpr int DBG_TC = 512;
__global__ void chk_gdn_proj(const float* h, const float* ssq, const float* ln, const float* W, int hh, float* raw) {
    const int idx = blockIdx.x * blockDim.x + threadIdx.x; if (idx >= DBG_TC * 514) return;
    const int t = idx / 514, c = idx % 514;
    const int col = c < 128 ? hh * 128 + c : c < 256 ? 1024 + hh * 128 + (c - 128) : c < 384 ? 2048 + hh * 128 + (c - 256) : c < 512 ? 3072 + hh * 128 + (c - 384) : c == 512 ? 4096 + hh : 4104 + hh;
    const float rs = dbg_rstd(ssq, t); float s = 0.f;
    for (int k = 0; k < 1024; ++k) s += h[(size_t)t * 1024 + k] * ln[k] * W[(size_t)k * OIN_SRC + col];
    raw[(size_t)t * 514 + c] = s * rs;
}
__global__ void chk_gdn_rec(const float* raw, const float* cw, const float* alog, const float* dtb, const float* onorm, int hh, const unsigned short* mix, unsigned* slot) {
    extern __shared__ float sm[];
    float* Sm = sm; float* q = sm + 128 * 129; float* kk = q + 128; float* v = kk + 128; float* kv = v + 128; float* dl = kv + 128; float* o = dl + 128; float* red = o + 128;
    const int tid = threadIdx.x;
    for (int i = tid; i < 128 * 129; i += 256) Sm[i] = 0.f;
    __syncthreads();
    float worst = 0.f;
    for (int t = 0; t < DBG_TC; ++t) {
        if (tid < 128) { const int d = tid; float aq = 0.f, ak = 0.f, av = 0.f;
            for (int jj = 0; jj < 4; ++jj) { const int r = t - 3 + jj; if (r >= 0) { aq += cw[jj * 3072 + hh * 128 + d] * raw[(size_t)r * 514 + d]; ak += cw[jj * 3072 + 1024 + hh * 128 + d] * raw[(size_t)r * 514 + 128 + d]; av += cw[jj * 3072 + 2048 + hh * 128 + d] * raw[(size_t)r * 514 + 256 + d]; } }
            q[d] = aq / (1.f + expf(-aq)); kk[d] = ak / (1.f + expf(-ak)); v[d] = av / (1.f + expf(-av)); }
        __syncthreads();
        const float sq = dbg_blocksum(tid < 128 ? q[tid] * q[tid] : 0.f, red), sk = dbg_blocksum(tid < 128 ? kk[tid] * kk[tid] : 0.f, red);
        if (tid < 128) { q[tid] *= 1.0f / sqrtf(sq + 1e-6f) * 0.08838834764831845f; kk[tid] *= 1.0f / sqrtf(sk + 1e-6f); }
        const float bb = raw[(size_t)t * 514 + 512], aa = raw[(size_t)t * 514 + 513];
        const float beta = 1.f / (1.f + expf(-bb)); const float z = aa + dtb[hh]; const float g = -expf(alog[hh]) * (z > 20.f ? z : log1pf(expf(z))); const float alpha = expf(g);
        __syncthreads();
        for (int i = tid; i < 128 * 128; i += 256) { const int d = i >> 7, j = i & 127; Sm[d * 129 + j] *= alpha; }
        __syncthreads();
        if (tid < 128) { float s = 0.f; for (int d = 0; d < 128; ++d) s += kk[d] * Sm[d * 129 + tid]; dl[tid] = beta * (v[tid] - s); }
        __syncthreads();
        for (int i = tid; i < 128 * 128; i += 256) { const int d = i >> 7, j = i & 127; Sm[d * 129 + j] += kk[d] * dl[j]; }
        __syncthreads();
        if (tid < 128) { float s = 0.f; for (int d = 0; d < 128; ++d) s += q[d] * Sm[d * 129 + tid]; o[tid] = s; }
        __syncthreads();
        const float so = dbg_blocksum(tid < 128 ? o[tid] * o[tid] : 0.f, red); const float rms = 1.0f / sqrtf(so / 128.f + 1e-6f);
        float num = 0.f, den = 0.f;
        if (tid < 128) { const float zz = raw[(size_t)t * 514 + 384 + tid]; const float ex = o[tid] * rms * onorm[tid] * (zz / (1.f + expf(-zz))); const float got = dbg_bf(mix, (size_t)t * 1024 + hh * 128 + tid); num = (got - ex) * (got - ex); den = ex * ex; }
        num = dbg_blocksum(num, red); den = dbg_blocksum(den, red);
        worst = fmaxf(worst, sqrtf(num / fmaxf(den, 1e-20f)));
    }
    if (tid == 0) atomicMax(slot, __float_as_uint(worst));
}

__global__ void chk_even_kv(const float* h, const float* ssq, const float* ln, const float* W, float* KV) {
    const size_t idx = (size_t)blockIdx.x * blockDim.x + threadIdx.x; if (idx >= (size_t)S_ * 1024) return;
    const int t = (int)(idx >> 10), c = (int)(idx & 1023); const float rs = dbg_rstd(ssq, t); float s = 0.f;
    for (int k = 0; k < 1024; ++k) s += h[(size_t)t * 1024 + k] * ln[k] * W[(size_t)k * EIN + 512 + c];
    KV[idx] = s * rs;
}
__global__ void chk_even_mix(const float* h, const float* ssq, const float* ln, const float* W, const float* KV, const int* pos, const float* lq1, const float* lk1, const float* lq2, const float* lk2, const float* subg, const float* cw,
                             float lam0, const unsigned short* PE, const unsigned short* AO, const unsigned short* MIXb, unsigned* slot) {
    __shared__ float q[2][64]; __shared__ float p[128]; __shared__ float red[256]; __shared__ float o2[2][128]; __shared__ float hn[1024];
    const int toks[6] = {5, 200, 1000, 4097, 9000, 16383};
    const int t = toks[blockIdx.x / 4], hh = blockIdx.x % 4, tid = threadIdx.x;
    auto bsum = [&](float v) { __syncthreads(); red[tid] = v; __syncthreads(); for (int o = 64; o > 0; o >>= 1) { if (tid < o) red[tid] += red[tid + o]; __syncthreads(); } const float r = red[0]; __syncthreads(); return r; };
    auto bmax = [&](float v) { __syncthreads(); red[tid] = v; __syncthreads(); for (int o = 64; o > 0; o >>= 1) { if (tid < o) red[tid] = fmaxf(red[tid], red[tid + o]); __syncthreads(); } const float r = red[0]; __syncthreads(); return r; };
    auto invf = [&](int i) { return exp2f(-(float)i * (18.931568569324174f / 8.0f)); };
    const float rs = dbg_rstd(ssq, t);
    for (int k = tid; k < 1024; k += 128) hn[k] = h[(size_t)t * 1024 + k] * rs * ln[k];
    __syncthreads();
    { const int m = tid >> 6, d = tid & 63, col = (2 * hh + m) * 64 + d; float s = 0.f; for (int k = 0; k < 1024; ++k) s += hn[k] * W[(size_t)k * EIN + col]; q[m][d] = s; }
    __syncthreads();
    float qr;
    { const int m = tid >> 6, d = tid & 63; float v = q[m][d];
      if (d < 16) { const int i = d & 7; const float ang = (float)pos[t] * invf(i); const float c = cosf(ang), s = sinf(ang); v = d < 8 ? q[m][d] * c - q[m][d + 8] * s : q[m][d] * c + q[m][d - 8] * s; }
      qr = v * pg8::C2; }
    __syncthreads(); q[tid >> 6][tid & 63] = qr; __syncthreads();
    float num = 0.f, den = 0.f;
    { const int m = tid >> 6, d = tid & 63; const float got = dbg_bf(PE, (size_t)t * EIN + (2 * hh + m) * 64 + d); const float e2 = (got - qr) * (got - qr), r2 = qr * qr; num += e2; den += r2;
      const float na = bsum(d >= 16 ? e2 : 0.f), da = bsum(d >= 16 ? r2 : 0.f), nb = bsum(d < 16 ? e2 : 0.f), db = bsum(d < 16 ? r2 : 0.f);
      if (tid == 0) { atomicMax(slot + 4, __float_as_uint(sqrtf(na / fmaxf(da, 1e-20f)))); atomicMax(slot + 5, __float_as_uint(sqrtf(nb / fmaxf(db, 1e-20f)))); } }
    { const int m = tid >> 6, d = tid & 63; const float* kr = KV + (size_t)t * 1024 + (2 * hh + m) * 64; float v = kr[d];
      if (d < 16) { const int i = d & 7; const float ang = (float)pos[t] * invf(i); const float c = cosf(ang), s = sinf(ang); v = d < 8 ? kr[d] * c - kr[d + 8] * s : kr[d] * c + kr[d - 8] * s; }
      const float got = dbg_bf(PE, (size_t)t * EIN + 512 + (2 * hh + m) * 64 + d); const float e2 = (got - v) * (got - v), r2 = v * v; num += e2; den += r2;
      const float na = bsum(d >= 16 ? e2 : 0.f), da = bsum(d >= 16 ? r2 : 0.f), nb = bsum(d < 16 ? e2 : 0.f), db = bsum(d < 16 ? r2 : 0.f);
      const float vv = KV[(size_t)t * 1024 + 512 + hh * 128 + tid], gv = dbg_bf(PE, (size_t)t * EIN + 1024 + hh * 128 + tid); const float e3 = (gv - vv) * (gv - vv), r3 = vv * vv; num += e3; den += r3;
      const float nc = bsum(e3), dc = bsum(r3);
      if (tid == 0) { atomicMax(slot + 6, __float_as_uint(sqrtf(na / fmaxf(da, 1e-20f)))); atomicMax(slot + 7, __float_as_uint(sqrtf(nb / fmaxf(db, 1e-20f)))); atomicMax(slot + 8, __float_as_uint(sqrtf(nc / fmaxf(dc, 1e-20f)))); } }
    num = bsum(num); den = bsum(den); if (tid == 0) atomicMax(slot + 0, __float_as_uint(sqrtf(num / fmaxf(den, 1e-20f))));
    for (int m = 0; m < 2; ++m) {
        float mx = -1e30f;
        for (int j0 = 0; j0 <= t; j0 += 128) { const int j = j0 + tid; float s = -1e30f;
            if (j <= t) { const float* kr = KV + (size_t)j * 1024 + (2 * hh + m) * 64; s = 0.f;
                for (int d = 0; d < 64; ++d) { float kv = kr[d]; if (d < 16) { const int i = d & 7; const float ang = (float)pos[j] * invf(i); const float c = cosf(ang), sn = sinf(ang); kv = d < 8 ? kr[d] * c - kr[d + 8] * sn : kr[d] * c + kr[d - 8] * sn; } s += q[m][d] * kv; } }
            mx = fmaxf(mx, s); }
        mx = bmax(mx);
        float l = 0.f, acc = 0.f;
        for (int j0 = 0; j0 <= t; j0 += 128) { const int j = j0 + tid; float pe = 0.f;
            if (j <= t) { const float* kr = KV + (size_t)j * 1024 + (2 * hh + m) * 64; float s = 0.f;
                for (int d = 0; d < 64; ++d) { float kv = kr[d]; if (d < 16) { const int i = d & 7; const float ang = (float)pos[j] * invf(i); const float c = cosf(ang), sn = sinf(ang); kv = d < 8 ? kr[d] * c - kr[d + 8] * sn : kr[d] * c + kr[d - 8] * sn; } s += q[m][d] * kv; }
                pe = exp2f(s - mx); }
            __syncthreads(); p[tid] = pe; __syncthreads();
            l += pe;
            const int nj = min(128, t + 1 - j0);
            for (int i = 0; i < nj; ++i) acc += p[i] * KV[(size_t)(j0 + i) * 1024 + 512 + hh * 128 + tid]; }
        l = bsum(l);
        o2[m][tid] = acc / l;
    }
    __syncthreads();
    { float n2 = 0.f, d2 = 0.f;
      for (int m = 0; m < 2; ++m) { const float ex = o2[m][tid], got = dbg_bf(AO, (size_t)t * 1024 + hh * 256 + m * 128 + tid); n2 += (got - ex) * (got - ex); d2 += ex * ex; }
      n2 = bsum(n2); d2 = bsum(d2); if (tid == 0) atomicMax(slot + 1, __float_as_uint(sqrtf(n2 / fmaxf(d2, 1e-20f)))); }
    float s1 = 0.f, s2 = 0.f; for (int i = 0; i < 64; ++i) { s1 += lq1[i] * lk1[i]; s2 += lq2[i] * lk2[i]; }
    const float lam = expf(s1) - expf(s2) + lam0;
    const float dv = o2[0][tid] - lam * o2[1][tid]; const float ssd = bsum(dv * dv); const float ex = dv / sqrtf(ssd / 128.f + 1e-5f) * subg[tid] * (1.f - lam0);
    { const float got = dbg_bf(MIXb, (size_t)t * 1024 + hh * 128 + tid); float n2 = (got - ex) * (got - ex), d2 = ex * ex; n2 = bsum(n2); d2 = bsum(d2); if (tid == 0) atomicMax(slot + 2, __float_as_uint(sqrtf(n2 / fmaxf(d2, 1e-20f)))); }
    { const int ch = hh * 128 + tid; float cx[3] = {0.f, 0.f, 0.f}, bg = 0.f;
      for (int jj = 0; jj < 3; ++jj) { const int r = t - 2 + jj; if (r < 0) continue; const float rr = dbg_rstd(ssq, r); float c = 0.f, x = 0.f, b = 0.f;
          for (int k = 0; k < 1024; ++k) { const float hv = h[(size_t)r * 1024 + k] * ln[k]; c += hv * W[(size_t)k * EIN + 2048 + ch]; x += hv * W[(size_t)k * EIN + 2560 + ch]; if (jj == 2) b += hv * W[(size_t)k * EIN + 1536 + ch]; }
          cx[jj] = (c * rr) * (x * rr); if (jj == 2) bg = b * rr; }
      const float ex2 = bg * (cw[0 * 512 + ch] * cx[0] + cw[1 * 512 + ch] * cx[1] + cw[2 * 512 + ch] * cx[2]); const float got = dbg_bf(MIXb, (size_t)t * 1024 + 512 + ch);
      float n2 = (got - ex2) * (got - ex2), d2 = ex2 * ex2; n2 = bsum(n2); d2 = bsum(d2); if (tid == 0) atomicMax(slot + 3, __float_as_uint(sqrtf(n2 / fmaxf(d2, 1e-20f)))); }
}
static void dbg_before_phase(int ph, unsigned char* ws, float* out, hipStream_t st) {
    if (ph == P_PRO || ph == P_FINAL) return;
    const int lp = (ph - 1) % LPN;
    if (lp == LP_UP || lp == LP_R1 || lp == LP_PLE) { (void)hipMemcpyAsync(ws + WS_ARENA + 400 * MiB, out, (size_t)S_ * D_ * 4, hipMemcpyDeviceToDevice, st); (void)hipMemcpyAsync(ws + WS_ARENA + 464 * MiB, ws + WS_SSQA, (size_t)S_ * 16 * 4, hipMemcpyDeviceToDevice, st); }
}
static void dbg_checks(int ph, void* const* d_in, unsigned char* ws, float* out, hipStream_t st) {
    if (ph == P_PRO || ph == P_FINAL) return;
    unsigned* slots = (unsigned*)(ws + WS_CTL) + CW_DBG; const int L = (ph - 1) / LPN, lp = (ph - 1) % LPN, j = L >> 1; const bool odd = L & 1;
    const float* snap = (const float*)(ws + WS_ARENA + 400 * MiB);
    if (lp == LP_DOWN && L == 0) hipLaunchKernelGGL(chk_ffn, dim3(24), dim3(256), 0, st, snap, (const float*)out, (const float*)(ws + WS_ARENA + 464 * MiB), (const float*)d_in[4] + L * D_, (const float*)nullptr,
        (const float*)d_in[21] + (size_t)j * D_ * DFF, (const float*)d_in[22] + (size_t)j * D_ * DFF, (const float*)d_in[23] + (size_t)j * D_ * DFF, 0, slots + 256 + 0);
    if (lp == LP_PLE && L == 0) hipLaunchKernelGGL(chk_ple, dim3(24), dim3(256), 0, st, snap, (const float*)out, (const float*)(ws + WS_ARENA + 464 * MiB), (const float*)d_in[5] + L * D_, (const float*)d_in[28] + (size_t)L * D_ * D_,
        (const float*)d_in[1] + (size_t)L * S_ * PLE, (const float*)d_in[29] + (size_t)L * PLE * D_, slots + 256 + 1);
    if (lp == LP_G3 && L == 1) { float* raw = (float*)(ws + WS_ARENA + 400 * MiB);
        hipLaunchKernelGGL(chk_gdn_proj, dim3((DBG_TC * 514 + 255) / 256), dim3(256), 0, st, (const float*)out, (const float*)(ws + WS_SSQB), (const float*)d_in[3] + L * D_, (const float*)d_in[15] + (size_t)j * D_ * OIN_SRC, 3, raw);
        hipLaunchKernelGGL(chk_gdn_rec, dim3(1), dim3(256), (128 * 129 + 6 * 128 + 256) * 4, st, (const float*)raw, (const float*)d_in[16] + (size_t)j * 4 * 3072, (const float*)d_in[17] + j * 8, (const float*)d_in[18] + j * 8, (const float*)d_in[19] + j * 128, 3, (const unsigned short*)(ws + WS_MIX), slots + 256 + 2); }
    if (lp == LP_COMB && L == 1) hipLaunchKernelGGL(chk_ffn, dim3(24), dim3(256), 0, st, snap, (const float*)out, (const float*)(ws + WS_ARENA + 464 * MiB), (const float*)d_in[4] + L * D_, (const float*)d_in[24] + (size_t)j * D_ * NEXP,
        (const float*)d_in[25] + (size_t)j * NEXP * D_ * DFF, (const float*)d_in[26] + (size_t)j * NEXP * D_ * DFF, (const float*)d_in[27] + (size_t)j * NEXP * DFF * D_, 1, slots + 256 + 3);
    if (lp == LP_MIXPREP && L == 0) { float* KV = (float*)(ws + WS_ARENA + 400 * MiB);
        hipLaunchKernelGGL(chk_even_kv, dim3((S_ * 1024) / 256), dim3(256), 0, st, (const float*)out, (const float*)(ws + WS_SSQB), (const float*)d_in[3] + L * D_, (const float*)d_in[7] + (size_t)j * D_ * EIN, KV);
        hipLaunchKernelGGL(chk_even_mix, dim3(24), dim3(128), 0, st, (const float*)out, (const float*)(ws + WS_SSQB), (const float*)d_in[3] + L * D_, (const float*)d_in[7] + (size_t)j * D_ * EIN, (const float*)KV, (const int*)d_in[2],
            (const float*)d_in[9] + j * 64, (const float*)d_in[10] + j * 64, (const float*)d_in[11] + j * 64, (const float*)d_in[12] + j * 64, (const float*)d_in[13] + j * 128, (const float*)d_in[14] + (size_t)j * 3 * 512,
            0.8f - 0.6f * expf(-0.3f * (float)L), (const unsigned short*)(ws + WS_ARENA + AR_PE), (const unsigned short*)(ws + WS_ARENA + AR_AO), (const unsigned short*)(ws + WS_MIX), slots + 256 + 4); }
    (void)odd;
}
static void dbg_after_phase(int ph, unsigned char* ws, float* out, hipStream_t st) {
    unsigned* slots = (unsigned*)(ws + WS_CTL) + CW_DBG; unsigned* sl = slots + ph;
    auto scan = [&](const void* p, size_t n, int f32) { hipLaunchKernelGGL(dbg_scan, dim3(1024), dim3(256), 0, st, p, n, f32, sl); };
    const size_t SD = (size_t)S_ * D_; unsigned char* ar = ws + WS_ARENA;
    if (ph == P_PRO) { scan(ws + WS_HBF, SD, 0); scan(out, SD, 1); scan(ws + WS_PBF, (size_t)4 * S_ * PLE, 0); scan(ws + WS_TAB, (size_t)S_ * 16, 1); scan(ws + WS_W, (size_t)44 * MiB, 0); return; }
    if (ph == P_FINAL) return;
    const int L = (ph - 1) / LPN, lp = (ph - 1) % LPN; const bool odd = L & 1;
    switch (lp) {
    case LP_PROJ: if (!odd) scan(ar + AR_PE, (size_t)S_ * EIN, 0); else { scan(ar + AR_PO, (size_t)S_ * OIN, 0); scan(ws + WS_GB, (size_t)S_ * 16, 1); } scan(ws + WS_PP, SD, 0); break;
    case LP_ROT: scan(ar + AR_PE, (size_t)S_ * EIN, 0); break;
    case LP_ATT: scan(ar + AR_AO, SD, 0); break;
    case LP_MIXPREP: case LP_G3: scan(ws + WS_MIX, SD, 0); break;
    case LP_GA: scan(ar + AR_QN, SD * 6, 0); scan(ws + WS_GB, (size_t)S_ * 16, 1); break;
    case LP_G1: scan(ar + AR_AI, (size_t)NUNIT * 4096, 0); scan(ar + AR_NEGW, SD, 0); scan(ar + AR_UT, SD, 0); scan(ar + AR_MP, (size_t)NUNIT * 16384 * 2, 0); break;
    case LP_G2: scan(ar + AR_SG, (size_t)NUNIT * 16384, 0); break;
    case LP_OUT: case LP_DOWN: case LP_COMB: case LP_PLE: scan(out, SD, 1); scan(ws + WS_HBF, SD, 0); scan(ws + ((lp == LP_PLE) ? WS_SSQB : WS_SSQA), (size_t)S_ * 16, 1); break;
    case LP_UP: scan(ar + AR_ACT, (size_t)S_ * DFF, 0); break;
    case LP_R1: scan(ws + WS_TOK + TOK_G, (size_t)S_ * 2, 1); break;
    default: break; }
}
#endif
#ifndef MK_MULTI
#define MK_MULTI 0
#endif
extern "C" void kernel_launch(void* const* d_in, const int* in_sizes, int n_in, void* d_out, int out_size, void* d_ws, size_t ws_size, hipStream_t stream) {
    static int grid = 0;
    if (grid == 0) {
        if (n_in != 30 || out_size != S_ * D_ || ws_size < WS_NEED) { fprintf(stderr, "kernel_launch: unexpected problem (n_in %d, out %d, ws %zu < %zu)\n", n_in, out_size, ws_size, (size_t)WS_NEED); grid = -1; return; }
        int dev = 0, cus = 0, per_cu = 0;
        if (hipGetDevice(&dev) != hipSuccess || hipDeviceGetAttribute(&cus, hipDeviceAttributeMultiprocessorCount, dev) != hipSuccess) { grid = -1; return; }
        if (hipFuncSetAttribute((const void*)fwd, hipFuncAttributeMaxDynamicSharedMemorySize, LDS_BYTES) != hipSuccess) { fprintf(stderr, "kernel_launch: hipFuncSetAttribute failed\n"); grid = -1; return; }
        if (hipOccupancyMaxActiveBlocksPerMultiprocessor(&per_cu, (const void*)fwd, NWAVES * 64, LDS_BYTES) != hipSuccess || per_cu < 1) { fprintf(stderr, "kernel_launch: occupancy query says %d\n", per_cu); }
        (void)hipGetLastError();
        grid = cus;
#if DBG
        (void)hipFuncSetAttribute((const void*)chk_gdn_rec, hipFuncAttributeMaxDynamicSharedMemorySize, 72 * 1024);
#endif
    }
    if (grid < 0) return;
    (void)hipMemsetAsync((char*)d_ws + WS_CTL, 0, CTL_ZERO_BYTES, stream);
    Args a{};
    for (int i = 0; i < 30; ++i) a.in[i] = d_in[i];
    a.out = (float*)d_out; a.ws = (unsigned char*)d_ws; a.pad = 0;
#if MK_MULTI
    a.use_bar = 0;
    static const int seq_even[] = {LP_PROJ, LP_ROT, LP_ATT, LP_MIXPREP, LP_OUT, LP_UP, LP_DOWN, LP_PLE};
    static const int seq_odd[] = {LP_PROJ, LP_GA, LP_G1, LP_G1B, LP_G2, LP_G2B, LP_G3, LP_OUT, LP_R1, LP_R2, LP_M1, LP_M2, LP_COMB, LP_PLE};
    int plist[64], np = 0; plist[np++] = P_PRO;
    for (int L = 0; L < DEPTH_; ++L) { const bool odd = L & 1; const int n = odd ? 14 : 8; for (int q = 0; q < n; ++q) plist[np++] = 1 + LPN * L + (odd ? seq_odd[q] : seq_even[q]); }
    plist[np++] = P_FINAL;
    for (int pi = 0; pi < np; ++pi) { const int ph = plist[pi];
        a.ph_lo = ph; a.ph_hi = ph + 1;
#if DBG
        dbg_before_phase(ph, (unsigned char*)d_ws, (float*)d_out, stream);
#endif
        hipLaunchKernelGGL(fwd, dim3(grid), dim3(NWAVES * 64), LDS_BYTES, stream, a);
#if DBG
        dbg_after_phase(ph, (unsigned char*)d_ws, (float*)d_out, stream); dbg_checks(ph, d_in, (unsigned char*)d_ws, (float*)d_out, stream);
#endif
    }
#if DBG
    hipLaunchKernelGGL(dbg_fill, dim3(1024), dim3(256), 0, stream, (float*)d_out, (size_t)S_ * D_, (const unsigned*)((unsigned char*)d_ws + WS_CTL) + CW_DBG, P_FINAL + 1);
#endif
#else
    a.use_bar = 1; a.ph_lo = 0; a.ph_hi = P_FINAL + 1;
    hipLaunchKernelGGL(fwd, dim3(grid), dim3(NWAVES * 64), LDS_BYTES, stream, a);
#ifdef PROBE_PH
    for (int i = 0; i < PROBE_N; ++i) { a.use_bar = 0; a.ph_lo = PROBE_PH; a.ph_hi = PROBE_PH + 1; hipLaunchKernelGGL(fwd, dim3(grid), dim3(NWAVES * 64), LDS_BYTES, stream, a); }
#endif
#endif
    const hipError_t le = hipPeekAtLastError();
    if (le != hipSuccess) fprintf(stderr, "kernel_launch: launch failed: %s\n", hipGetErrorName(le));
}
```

```cpp
#include <hip/hip_runtime.h>
#include <hip/hip_bf16.h>
#include <cstdio>
#include <cstdint>
#include <cmath>

constexpr int S_ = 16384, D_ = 1024, DEPTH_ = 4;
constexpr int EIN = 3072, OIN = 4096, OIN_SRC = 4112, DFF = 3584, NEXP = 8, PLE = 256;
constexpr int MOE_P = 2 * S_ + NEXP * 256;
constexpr int NCHUNK = S_ / 64, NUNIT = NCHUNK * 8;
constexpr float RMS_EPS = 1e-6f;

namespace pg8 {
#define PG8_LAS __attribute__((address_space(3)))
typedef unsigned short bf16_t;
typedef short bf16x8 __attribute__((ext_vector_type(8)));
typedef float f32x4 __attribute__((ext_vector_type(4)));
typedef float f32x2 __attribute__((ext_vector_type(2)));
typedef unsigned u32x4 __attribute__((ext_vector_type(4)));
typedef unsigned u32x2 __attribute__((ext_vector_type(2)));
constexpr int BM = 256, BK = 64, HALF = 128, HTB = HALF * BK * 2, STAGE_BYTES = 8 * HTB, NXCD = 8, WGM = 8;

__host__ __device__ __forceinline__ int lds_byte(int r, int c) { const int st = (r >> 4) * 2 + (c >> 5), rr = r & 15, cc = c & 31, ob = rr * 64 + cc * 2; return st * 1024 + (ob ^ (((ob >> 9) & 1) << 5)); }
__host__ __device__ __forceinline__ void stage_rc(int b, int& R, int& C) { const int st = b / 1024, sb = b % 1024, swz = sb ^ (((sb >> 9) & 1) << 5); R = (st >> 1) * 16 + swz / 64; C = (st & 1) * 32 + (swz % 64) / 2; }
__host__ __device__ __forceinline__ int perm32(int rho) { const int n = rho >> 4, i = rho & 15; return 8 * (i >> 2) + 4 * n + (i & 3); }

struct Unit { int pm, pn, be; };
struct Gemm { const bf16_t* A; const bf16_t* Bt; int M, N, K; size_t bstride; };

struct StaticOrder {
    int nM, nN, nwg, G, c;
    __host__ __device__ void init(int M, int N, int G_, int c_) { nM = M / BM; nN = N / BM; nwg = nM * nN; G = G_; c = c_; }
    __host__ __device__ bool next(int i, Unit& u) const {
        const long L = (long)i * G + c; if (L >= nwg) return false;
        int wgid = (int)L; { const int q = nwg / NXCD, r = nwg % NXCD, xcd = wgid % NXCD, off = wgid / NXCD; wgid = (xcd < r ? xcd * (q + 1) : r * (q + 1) + (xcd - r) * q) + off; }
        const int nig = WGM * nN, gid = wgid / nig, fm = gid * WGM, gsz = (nM - fm) < WGM ? (nM - fm) : WGM;
        u.pm = fm + ((wgid % nig) % gsz); u.pn = (wgid % nig) / gsz; u.be = 0; return true;
    }
    __device__ __forceinline__ void a_ready(const Unit&) const {}
    __device__ __forceinline__ void done(const Unit&) const {}
};
struct MoeOrder : StaticOrder {
    const PG8_LAS int* blk_e;
    __device__ __forceinline__ bool next(int i, Unit& u) const { if (!StaticOrder::next(i, u)) return false; u.be = blk_e[u.pm]; return true; }
};

__device__ __forceinline__ unsigned cvt_pk_bf16(float lo, float hi) { unsigned r; asm volatile("v_cvt_pk_bf16_f32 %0, %1, %2" : "=v"(r) : "v"(lo), "v"(hi)); return r; }
typedef __bf16 bf16x2_t_ __attribute__((ext_vector_type(2)));
__device__ __forceinline__ unsigned cvt_pk_bf16_cv(float lo, float hi) { const f32x2 v = {lo, hi}; const bf16x2_t_ b = __builtin_convertvector(v, bf16x2_t_); return __builtin_bit_cast(unsigned, b); }
__device__ __forceinline__ float bf_lo(unsigned w) { return __uint_as_float(w << 16); }
__device__ __forceinline__ float bf_hi(unsigned w) { return __uint_as_float(w & 0xffff0000u); }

__device__ __forceinline__ float rstd_row(const float* ssq, int row) {
    const f32x4* p = (const f32x4*)(ssq + (size_t)row * 16);
    const f32x4 a = p[0], b = p[1], c = p[2], d = p[3];
    const float s = (((a[0] + a[1]) + (a[2] + a[3])) + ((b[0] + b[1]) + (b[2] + b[3]))) + (((c[0] + c[1]) + (c[2] + c[3])) + ((d[0] + d[1]) + (d[2] + d[3])));
    return __builtin_amdgcn_rsqf(s * (1.0f / 1024.0f) + RMS_EPS);
}
__device__ __forceinline__ float sigmoidf_(float x) { return __builtin_amdgcn_rcpf(1.0f + __builtin_amdgcn_exp2f(-1.4426950408889634f * x)); }
__device__ __forceinline__ float siluf_(float x) { return x * sigmoidf_(x); }

constexpr float C2 = 0.125f * 1.4426950408889634f;

struct EpiProjEven {
    static constexpr bool PERM = true, AFTER_DRAIN = false;
    bf16_t* O; const float* ssq; const float* tab;
    __device__ __forceinline__ void operator()(const f32x4 (&acc)[2][2][4][2], const Unit& u, int wr, int wc, int fr, int fq) const {
        const int row0 = u.pm * BM + wr * 64 + fr, colt = u.pn * BM;
        const bool rot = (colt < 1024) && ((wc & 1) == 0);
        const float qs = (colt < 512) ? C2 : 1.0f;
#pragma unroll
        for (int ai = 0; ai < 2; ++ai)
#pragma unroll
            for (int m = 0; m < 4; ++m) {
                const int row = row0 + ai * HALF + m * 16; const float rs = rstd_row(ssq, row);
                f32x4 c0 = {1.f, 1.f, 1.f, 1.f}, c1 = c0, s0 = {0.f, 0.f, 0.f, 0.f}, s1 = s0;
                if (rot && fq < 2) { const f32x4* t = (const f32x4*)(tab + (size_t)row * 16); c0 = t[0]; c1 = t[1]; s0 = t[2]; s1 = t[3]; if (fq == 0) { s0 = -s0; s1 = -s1; } }
#pragma unroll
                for (int bj = 0; bj < 2; ++bj) {
                    f32x4 v0 = acc[ai][bj][m][0] * rs, v1 = acc[ai][bj][m][1] * rs;
                    if (rot) {
                        f32x4 p0, p1;
#pragma unroll
                        for (int i = 0; i < 4; ++i) { p0[i] = __shfl_xor(v0[i], 16); p1[i] = __shfl_xor(v1[i], 16); }
                        v0 = v0 * c0 + p0 * s0; v1 = v1 * c1 + p1 * s1;
                    }
                    v0 = v0 * qs; v1 = v1 * qs;
                    u32x4 w; w.x = cvt_pk_bf16(v0[0], v0[1]); w.y = cvt_pk_bf16(v0[2], v0[3]); w.z = cvt_pk_bf16(v1[0], v1[1]); w.w = cvt_pk_bf16(v1[2], v1[3]);
                    *(u32x4*)(O + (size_t)row * EIN + colt + bj * HALF + wc * 32 + 8 * fq) = w;
                }
                asm volatile("" ::: "memory");
            }
    }
};
struct EpiBf16 {
    static constexpr bool PERM = true, AFTER_DRAIN = false;
    bf16_t* O; int ldc; const float* ssq; float scale0; int scale_cols;
    __device__ __forceinline__ void operator()(const f32x4 (&acc)[2][2][4][2], const Unit& u, int wr, int wc, int fr, int fq) const {
        const int row0 = u.pm * BM + wr * 64 + fr, colt = u.pn * BM;
#pragma unroll
        for (int ai = 0; ai < 2; ++ai)
#pragma unroll
            for (int m = 0; m < 4; ++m) {
                const int row = row0 + ai * HALF + m * 16; const float rs = (ssq ? rstd_row(ssq, row) : 1.0f) * (colt < scale_cols ? scale0 : 1.0f);
#pragma unroll
                for (int bj = 0; bj < 2; ++bj) {
                    const f32x4 v0 = acc[ai][bj][m][0] * rs, v1 = acc[ai][bj][m][1] * rs;
                    u32x4 w; w.x = cvt_pk_bf16(v0[0], v0[1]); w.y = cvt_pk_bf16(v0[2], v0[3]); w.z = cvt_pk_bf16(v1[0], v1[1]); w.w = cvt_pk_bf16(v1[2], v1[3]);
                    *(u32x4*)(O + (size_t)row * ldc + colt + bj * HALF + wc * 32 + 8 * fq) = w;
                }
                if (m & 1) asm volatile("" ::: "memory");
            }
    }
};
struct EpiSwiglu {
    static constexpr bool PERM = true, AFTER_DRAIN = false;
    bf16_t* O; const float* ssq;
    __device__ __forceinline__ void operator()(const f32x4 (&acc)[2][2][4][2], const Unit& u, int wr, int wc, int fr, int fq) const {
        const int row0 = u.pm * BM + wr * 64 + fr, col = u.pn * HALF + wc * 32 + 8 * fq;
#pragma unroll
        for (int ai = 0; ai < 2; ++ai)
#pragma unroll
            for (int m = 0; m < 4; ++m) {
                const int row = row0 + ai * HALF + m * 16; const float rs = ssq ? rstd_row(ssq, row) : 1.0f;
                float o[8];
#pragma unroll
                for (int n = 0; n < 2; ++n)
#pragma unroll
                    for (int i = 0; i < 4; ++i) { const float a = acc[ai][0][m][n][i] * rs, b = acc[ai][1][m][n][i] * rs; o[4 * n + i] = siluf_(a) * b; }
                u32x4 w; w.x = cvt_pk_bf16(o[0], o[1]); w.y = cvt_pk_bf16(o[2], o[3]); w.z = cvt_pk_bf16(o[4], o[5]); w.w = cvt_pk_bf16(o[6], o[7]);
                *(u32x4*)(O + (size_t)row * DFF + col) = w;
                if (m & 1) asm volatile("" ::: "memory");
            }
    }
};
struct EpiResid {
    static constexpr bool PERM = true, AFTER_DRAIN = false;
    float* h; bf16_t* hb; float* ssq;
    __device__ __forceinline__ void operator()(const f32x4 (&acc)[2][2][4][2], const Unit& u, int wr, int wc, int fr, int fq) const {
        const int row0 = u.pm * BM + wr * 64 + fr, colt = u.pn * BM;
#pragma unroll
        for (int ai = 0; ai < 2; ++ai)
#pragma unroll
            for (int m = 0; m < 4; ++m) {
                const int row = row0 + ai * HALF + m * 16; float ss = 0.f;
#pragma unroll
                for (int bj = 0; bj < 2; ++bj) {
                    const size_t off = (size_t)row * D_ + colt + bj * HALF + wc * 32 + 8 * fq;
                    f32x4 x0 = *(const f32x4*)(h + off), x1 = *(const f32x4*)(h + off + 4);
                    x0 = x0 + acc[ai][bj][m][0]; x1 = x1 + acc[ai][bj][m][1];
                    *(f32x4*)(h + off) = x0; *(f32x4*)(h + off + 4) = x1;
                    ss += (x0[0] * x0[0] + x0[1] * x0[1]) + (x0[2] * x0[2] + x0[3] * x0[3]) + (x1[0] * x1[0] + x1[1] * x1[1]) + (x1[2] * x1[2] + x1[3] * x1[3]);
                    u32x4 w; w.x = cvt_pk_bf16(x0[0], x0[1]); w.y = cvt_pk_bf16(x0[2], x0[3]); w.z = cvt_pk_bf16(x1[0], x1[1]); w.w = cvt_pk_bf16(x1[2], x1[3]);
                    *(u32x4*)(hb + off) = w;
                }
                ss += __shfl_xor(ss, 16); ss += __shfl_xor(ss, 32);
                if (fq == 0) ssq[(size_t)row * 16 + u.pn * 4 + wc] = ss;
                asm volatile("" ::: "memory");
            }
    }
};
struct EpiPle {
    static constexpr bool PERM = true, AFTER_DRAIN = false;
    float* h; bf16_t* hb; const float* ssq_in; float* ssq_out; const bf16_t* pp;
    __device__ __forceinline__ void operator()(const f32x4 (&acc)[2][2][4][2], const Unit& u, int wr, int wc, int fr, int fq) const {
        const int row0 = u.pm * BM + wr * 64 + fr, colt = u.pn * BM;
#pragma unroll
        for (int ai = 0; ai < 2; ++ai)
#pragma unroll
            for (int m = 0; m < 4; ++m) {
                const int row = row0 + ai * HALF + m * 16; const float rs = rstd_row(ssq_in, row); float ss = 0.f;
#pragma unroll
                for (int bj = 0; bj < 2; ++bj) {
                    const size_t off = (size_t)row * D_ + colt + bj * HALF + wc * 32 + 8 * fq;
                    f32x4 x0 = *(const f32x4*)(h + off), x1 = *(const f32x4*)(h + off + 4);
                    const u32x4 pw = *(const u32x4*)(pp + off);
                    const f32x4 a0 = acc[ai][bj][m][0] * rs, a1 = acc[ai][bj][m][1] * rs;
                    x0[0] += sigmoidf_(a0[0]) * bf_lo(pw.x); x0[1] += sigmoidf_(a0[1]) * bf_hi(pw.x); x0[2] += sigmoidf_(a0[2]) * bf_lo(pw.y); x0[3] += sigmoidf_(a0[3]) * bf_hi(pw.y);
                    x1[0] += sigmoidf_(a1[0]) * bf_lo(pw.z); x1[1] += sigmoidf_(a1[1]) * bf_hi(pw.z); x1[2] += sigmoidf_(a1[2]) * bf_lo(pw.w); x1[3] += sigmoidf_(a1[3]) * bf_hi(pw.w);
                    *(f32x4*)(h + off) = x0; *(f32x4*)(h + off + 4) = x1;
                    ss += (x0[0] * x0[0] + x0[1] * x0[1]) + (x0[2] * x0[2] + x0[3] * x0[3]) + (x1[0] * x1[0] + x1[1] * x1[1]) + (x1[2] * x1[2] + x1[3] * x1[3]);
                    u32x4 w; w.x = cvt_pk_bf16(x0[0], x0[1]); w.y = cvt_pk_bf16(x0[2], x0[3]); w.z = cvt_pk_bf16(x1[0], x1[1]); w.w = cvt_pk_bf16(x1[2], x1[3]);
                    *(u32x4*)(hb + off) = w;
                }
                ss += __shfl_xor(ss, 16); ss += __shfl_xor(ss, 32);
                if (fq == 0) ssq_out[(size_t)row * 16 + u.pn * 4 + wc] = ss;
                asm volatile("" ::: "memory");
            }
    }
};
struct EpiMoeDown {
    static constexpr bool PERM = true, AFTER_DRAIN = false;
    bf16_t* Y; const float* gate;
    __device__ __forceinline__ void operator()(const f32x4 (&acc)[2][2][4][2], const Unit& u, int wr, int wc, int fr, int fq) const {
        const int row0 = u.pm * BM + wr * 64 + fr, colt = u.pn * BM;
#pragma unroll
        for (int ai = 0; ai < 2; ++ai)
#pragma unroll
            for (int m = 0; m < 4; ++m) {
                const int row = row0 + ai * HALF + m * 16; const float gt = gate[row];
#pragma unroll
                for (int bj = 0; bj < 2; ++bj) {
                    const f32x4 v0 = acc[ai][bj][m][0] * gt, v1 = acc[ai][bj][m][1] * gt;
                    u32x4 w; w.x = cvt_pk_bf16(v0[0], v0[1]); w.y = cvt_pk_bf16(v0[2], v0[3]); w.z = cvt_pk_bf16(v1[0], v1[1]); w.w = cvt_pk_bf16(v1[2], v1[3]);
                    *(u32x4*)(Y + (size_t)row * D_ + colt + bj * HALF + wc * 32 + 8 * fq) = w;
                }
                if (m & 1) asm volatile("" ::: "memory");
            }
    }
};

template <class Epi, class Sched, bool ALIGN_EPI = false, bool SP2 = false>
__device__ __forceinline__ void gemm_phase(PG8_LAS unsigned char* lds, const Gemm g, const Sched& S, const Epi& E) {
    int tid_ = threadIdx.x; asm volatile("" : "+v"(tid_));
    const int tid = tid_, wid = __builtin_amdgcn_readfirstlane(tid >> 6), lane = tid & 63, wr = wid >> 2, wc = wid & 3, fr = lane & 15, fq = lane >> 4;
    const int K = g.K, nt = K / BK;
    unsigned voffA[2], voffB[2];
#pragma unroll
    for (int i = 0; i < 2; ++i) { int R, C; stage_rc(tid * 16 + i * 8192, R, C); const int Rb = Epi::PERM ? ((R & ~31) + perm32(R & 31)) : R;
        voffA[i] = (unsigned)(R * K + C) * 2u; voffB[i] = (unsigned)(Rb * K + C) * 2u; }
    const size_t kstep = (size_t)(BK * 2);
    const size_t hstep = (size_t)HALF * K * 2;
    const size_t tstep = 2 * hstep;
    const unsigned ldsw = (unsigned)wid * 1024u;
    const int aoff = lds_byte(wr * 64 + fr, fq * 8), boff = lds_byte(wc * 32 + fr, fq * 8);
#define PG8_SA(b, h) (((b) * 2 + (h)) * HTB)
#define PG8_SB(b, h) ((4 + (b) * 2 + (h)) * HTB)
#define PG8_STAGE(bufoff, gbase, voff) do { _Pragma("unroll") for (int _i = 0; _i < 2; ++_i) \
        __builtin_amdgcn_global_load_lds((const unsigned*)((const char*)(gbase) + (voff)[_i]), (PG8_LAS unsigned*)(lds + (bufoff) + ldsw + _i * 8192), 16, 0, 0); } while (0)
#define PG8_LDA(dst, b, h) do { _Pragma("unroll") for (int m = 0; m < 4; ++m) _Pragma("unroll") for (int k = 0; k < 2; ++k) dst[m][k] = *(const PG8_LAS bf16x8*)(lds + PG8_SA(b, h) + aoff + m * 2048 + k * 1024); } while (0)
#define PG8_LDB(dst, b, h) do { _Pragma("unroll") for (int n = 0; n < 2; ++n) _Pragma("unroll") for (int k = 0; k < 2; ++k) dst[n][k] = *(const PG8_LAS bf16x8*)(lds + PG8_SB(b, h) + boff + n * 2048 + k * 1024); } while (0)
#define PG8_MMA(ai, bj, At, Bt) do { __builtin_amdgcn_s_setprio(1); _Pragma("unroll") for (int m = 0; m < 4; ++m) _Pragma("unroll") for (int n = 0; n < 2; ++n) _Pragma("unroll") for (int k = 0; k < 2; ++k) \
        acc[ai][bj][m][n] = __builtin_amdgcn_mfma_f32_16x16x32_bf16(Bt[n][k], At[m][k], acc[ai][bj][m][n], 0, 0, 0); __builtin_amdgcn_s_setprio(0); } while (0)
#define PG8_WAIT_V(n) asm volatile("s_waitcnt vmcnt(" #n ")" ::: "memory")
#define PG8_WAIT_L(n) asm volatile("s_waitcnt lgkmcnt(" #n ")" ::: "memory")
#define PG8_BAR __builtin_amdgcn_s_barrier()
#define PG8_SCHED __builtin_amdgcn_sched_barrier(0)
    Unit cur, nxt; int ui = 0;
    if (!S.next(0, cur)) return;
    f32x4 acc[2][2][4][2];
#pragma unroll
    for (int a = 0; a < 2; ++a)
#pragma unroll
        for (int b = 0; b < 2; ++b)
#pragma unroll
            for (int m = 0; m < 4; ++m)
#pragma unroll
                for (int n = 0; n < 2; ++n) acc[a][b][m][n] = (f32x4){0.f, 0.f, 0.f, 0.f};
    bf16x8 At[4][2], B0[2][2], B1[2][2];
    const char* cA = (const char*)g.A + (size_t)cur.pm * tstep; const char* cB = (const char*)g.Bt + (size_t)cur.pn * tstep + (size_t)cur.be * g.bstride;
    S.a_ready(cur);
    if constexpr (SP2) {
        PG8_STAGE(PG8_SB(0, 0), cB, voffB); PG8_STAGE(PG8_SB(0, 1), cB + hstep, voffB); PG8_STAGE(PG8_SA(0, 0), cA, voffA); PG8_STAGE(PG8_SA(0, 1), cA + hstep, voffA);
        if (wr == 1) PG8_BAR;
        PG8_WAIT_V(2); PG8_BAR;
        PG8_STAGE(PG8_SB(1, 0), cB + kstep, voffB); PG8_STAGE(PG8_SA(1, 0), cA + kstep, voffA); PG8_STAGE(PG8_SB(1, 1), cB + hstep + kstep, voffB);
        PG8_WAIT_V(6); PG8_BAR;
    } else {
        PG8_STAGE(PG8_SB(0, 0), cB, voffB); PG8_STAGE(PG8_SA(0, 0), cA, voffA); PG8_STAGE(PG8_SB(0, 1), cB + hstep, voffB); PG8_STAGE(PG8_SA(0, 1), cA + hstep, voffA);
        if (wr == 1) PG8_BAR;
        PG8_WAIT_V(4); PG8_BAR;
        PG8_STAGE(PG8_SB(1, 0), cB + kstep, voffB); PG8_STAGE(PG8_SA(1, 0), cA + kstep, voffA); PG8_STAGE(PG8_SB(1, 1), cB + hstep + kstep, voffB);
        PG8_WAIT_V(6); PG8_BAR;
    }
    for (;;) {
        const bool has_next = S.next(ui + 1, nxt);
        const char* nA = has_next ? (const char*)g.A + (size_t)nxt.pm * tstep : cA; const char* nB = has_next ? (const char*)g.Bt + (size_t)nxt.pn * tstep + (size_t)nxt.be * g.bstride : cB;
        for (int t = 0; t < nt; t += 2) {
            const bool last = (t == nt - 2);
            const char* a1 = cA + (size_t)(t + 1) * kstep;
            const char* a2 = last ? nA : cA + (size_t)(t + 2) * kstep; const char* b2 = last ? nB : cB + (size_t)(t + 2) * kstep;
            const char* a3 = a2 + kstep; const char* b3 = b2 + kstep;
            if (last && has_next) S.a_ready(nxt);
            if constexpr (SP2) {
            PG8_LDB(B0, 0, 0); PG8_LDB(B1, 0, 1); PG8_SCHED; PG8_LDA(At, 0, 0); PG8_STAGE(PG8_SA(1, 1), a1 + hstep, voffA);
            PG8_WAIT_V(8); PG8_WAIT_L(0); PG8_BAR; PG8_MMA(0, 0, At, B0); PG8_MMA(0, 1, At, B1); PG8_BAR; PG8_SCHED;
            PG8_LDA(At, 0, 1); PG8_STAGE(PG8_SB(0, 0), b2, voffB); PG8_STAGE(PG8_SB(0, 1), b2 + hstep, voffB); PG8_STAGE(PG8_SA(0, 0), a2, voffA);
            PG8_WAIT_V(8); PG8_WAIT_L(0); PG8_BAR; PG8_MMA(1, 0, At, B0); PG8_MMA(1, 1, At, B1); PG8_BAR; PG8_SCHED;
            PG8_LDB(B0, 1, 0); PG8_LDB(B1, 1, 1); PG8_SCHED; PG8_LDA(At, 1, 0); PG8_STAGE(PG8_SA(0, 1), a2 + hstep, voffA);
            PG8_WAIT_V(8); PG8_WAIT_L(0); PG8_BAR; PG8_MMA(0, 0, At, B0); PG8_MMA(0, 1, At, B1); PG8_BAR; PG8_SCHED;
            PG8_LDA(At, 1, 1); PG8_STAGE(PG8_SB(1, 0), b3, voffB); PG8_STAGE(PG8_SB(1, 1), b3 + hstep, voffB); PG8_STAGE(PG8_SA(1, 0), a3, voffA);
            PG8_WAIT_V(8); PG8_WAIT_L(0); PG8_BAR; PG8_MMA(1, 0, At, B0); PG8_MMA(1, 1, At, B1); PG8_BAR; PG8_SCHED;
            } else {
            PG8_LDB(B0, 0, 0); PG8_SCHED; PG8_LDA(At, 0, 0); PG8_STAGE(PG8_SA(1, 1), a1 + hstep, voffA);
            PG8_WAIT_L(8); PG8_BAR; PG8_WAIT_L(0); PG8_MMA(0, 0, At, B0); PG8_BAR; PG8_SCHED;
            PG8_LDB(B1, 0, 1); PG8_STAGE(PG8_SB(0, 0), b2, voffB);
            PG8_BAR; PG8_WAIT_L(0); PG8_MMA(0, 1, At, B1); PG8_BAR;
            PG8_LDA(At, 0, 1); PG8_STAGE(PG8_SA(0, 0), a2, voffA);
            PG8_BAR; PG8_WAIT_L(0); PG8_MMA(1, 0, At, B0); PG8_BAR; PG8_SCHED;
            PG8_STAGE(PG8_SB(0, 1), b2 + hstep, voffB);
            PG8_WAIT_V(6); PG8_BAR; PG8_MMA(1, 1, At, B1); PG8_BAR;
            PG8_LDB(B0, 1, 0); PG8_SCHED; PG8_LDA(At, 1, 0); PG8_STAGE(PG8_SA(0, 1), a2 + hstep, voffA);
            PG8_WAIT_L(8); PG8_BAR; PG8_WAIT_L(0); PG8_MMA(0, 0, At, B0); PG8_BAR; PG8_SCHED;
            PG8_LDB(B1, 1, 1); PG8_STAGE(PG8_SB(1, 0), b3, voffB);
            PG8_BAR; PG8_WAIT_L(0); PG8_MMA(0, 1, At, B1); PG8_BAR;
            PG8_LDA(At, 1, 1); PG8_STAGE(PG8_SA(1, 0), a3, voffA);
            PG8_BAR; PG8_WAIT_L(0); PG8_MMA(1, 0, At, B0); PG8_BAR; PG8_SCHED;
            PG8_STAGE(PG8_SB(1, 1), b3 + hstep, voffB);
            PG8_WAIT_V(6); PG8_BAR; PG8_MMA(1, 1, At, B1); PG8_BAR;
            }
        }
        if constexpr (ALIGN_EPI) { if (wr == 0) PG8_BAR; }
        if constexpr (!Epi::AFTER_DRAIN) { E(acc, cur, wr, wc, fr, fq); S.done(cur); }
        if (!has_next) break;
#pragma unroll
        for (int a = 0; a < 2; ++a)
#pragma unroll
            for (int b = 0; b < 2; ++b)
#pragma unroll
                for (int m = 0; m < 4; ++m)
#pragma unroll
                    for (int n = 0; n < 2; ++n) acc[a][b][m][n] = (f32x4){0.f, 0.f, 0.f, 0.f};
        cur = nxt; cA = nA; cB = nB; ++ui;
        if constexpr (ALIGN_EPI) { if (wr == 1) PG8_BAR; }
    }
    PG8_WAIT_V(0);
    if constexpr (!ALIGN_EPI) { if (wr == 0) PG8_BAR; }
    PG8_BAR;
    if constexpr (Epi::AFTER_DRAIN) { E.fused(acc, cur, wr, wc, fr, fq, lds, wid, lane); S.done(cur); }
#undef PG8_SA
#undef PG8_SB
#undef PG8_STAGE
#undef PG8_LDA
#undef PG8_LDB
#undef PG8_MMA
#undef PG8_WAIT_V
#undef PG8_WAIT_L
#undef PG8_BAR
#undef PG8_SCHED
}
}

#include <hip/hip_bf16.h>
#include <cmath>
namespace attn_body {
using bf16=__hip_bfloat16;
using bf16x8=__attribute__((ext_vector_type(8)))short;
using s16x4=__attribute__((ext_vector_type(4)))short;
using f32x16=__attribute__((ext_vector_type(16)))float;
using u32x4=__attribute__((ext_vector_type(4)))unsigned;
constexpr int SEQ=16384,D=64,LDP=3072,LDO=1024;
constexpr int NW=8,QBLK=32,QB=QBLK*NW,KVBLK=64,NQB=SEQ/QB;
constexpr int ATTN_UNIT_ROWS=QB;
__device__ __forceinline__ int crow(int r,int hi){return (r&3)+8*(r>>2)+4*hi;}
#define SBAR() __builtin_amdgcn_sched_barrier(0)
__device__ __forceinline__ void cmask(f32x16&p0,f32x16&p1,int jb,int qrel,int hi){
  const float NEG=-INFINITY; int kb=64*jb+4*hi;
  #pragma unroll
  for(int r=0;r<16;++r){int kv=kb+(r&3)+8*(r>>2); if(kv>qrel)p0[r]=NEG; if(kv+32>qrel)p1[r]=NEG;}
}

constexpr int NSLOT=3, SLOTB=8192, VSLOTB=2*SLOTB;
constexpr int LDS_K=0, LDS_V=NSLOT*SLOTB, LDS_WS=LDS_V+NSLOT*VSLOTB, LDS_OST=0  , LDS_BYTES=LDS_WS+NW*64*4;
constexpr float C2=0.125f*1.4426950408889634f;
__device__ __forceinline__ void glds16(const void*gsrc,unsigned lds_dst){unsigned keep;
  asm volatile("s_mov_b32 %0, m0\n\ts_mov_b32 m0, %2\n\ts_nop 0\n\tglobal_load_lds_dwordx4 %1, off\n\ts_mov_b32 m0, %0":"=&s"(keep):"v"(gsrc),"s"(lds_dst):"memory");}
__device__ __forceinline__ float max3f(float a,float b,float c){float r;asm("v_max3_f32 %0, %1, %2, %3":"=v"(r):"v"(a),"v"(b),"v"(c));return r;}
__device__ __forceinline__ float max2f(float a,float b){float r;asm("v_max_f32_e32 %0, %1, %2":"=v"(r):"v"(a),"v"(b));return r;}
__device__ __forceinline__ float fadd_s(float a,float b){float r;asm("v_add_f32_e32 %0, %1, %2":"=v"(r):"v"(a),"v"(b));return r;}
__device__ __forceinline__ float fsub_s(float a,float b){float r;asm("v_sub_f32_e32 %0, %1, %2":"=v"(r):"v"(a),"v"(b));return r;}
typedef float f32x2_t __attribute__((ext_vector_type(2))); typedef __bf16 bf16x2_t __attribute__((ext_vector_type(2)));
__device__ __forceinline__ unsigned cvtpk_s(float lo,float hi){f32x2_t v={lo,hi};bf16x2_t b=__builtin_convertvector(v,bf16x2_t);return __builtin_bit_cast(unsigned,b);}
#define WAIT_BAR(N) asm volatile("s_waitcnt vmcnt(" #N ") lgkmcnt(0)\n\ts_barrier":::"memory")

__device__ __forceinline__ void qkt(f32x16&p0,f32x16&p1,const char*Kslot,const bf16x8*qr,int r32,int hi){
  const char*kb=Kslot+hi*1024+r32*16;
  #pragma unroll
  for(int d0=0;d0<4;++d0){
    const bf16x8 b0=*reinterpret_cast<const bf16x8*>(kb+d0*2048);
    const bf16x8 b1=*reinterpret_cast<const bf16x8*>(kb+d0*2048+512);
    if(d0==0){p0=__builtin_amdgcn_mfma_f32_32x32x16_bf16(b0,qr[0],f32x16{},0,0,0);p1=__builtin_amdgcn_mfma_f32_32x32x16_bf16(b1,qr[0],f32x16{},0,0,0);}
    else{p0=__builtin_amdgcn_mfma_f32_32x32x16_bf16(b0,qr[d0],p0,0,0,0);p1=__builtin_amdgcn_mfma_f32_32x32x16_bf16(b1,qr[d0],p1,0,0,0);}}
}
typedef __attribute__((address_space(3))) const char* lds_cptr;
typedef short v4i16_t __attribute__((ext_vector_type(4)));
__device__ __forceinline__ void kload8(bf16x8*kf,lds_cptr kp){
  kf[0]=*(const __attribute__((address_space(3))) bf16x8*)(kp);      kf[1]=*(const __attribute__((address_space(3))) bf16x8*)(kp+512);
  kf[2]=*(const __attribute__((address_space(3))) bf16x8*)(kp+2048); kf[3]=*(const __attribute__((address_space(3))) bf16x8*)(kp+2560);
  kf[4]=*(const __attribute__((address_space(3))) bf16x8*)(kp+4096); kf[5]=*(const __attribute__((address_space(3))) bf16x8*)(kp+4608);
  kf[6]=*(const __attribute__((address_space(3))) bf16x8*)(kp+6144); kf[7]=*(const __attribute__((address_space(3))) bf16x8*)(kp+6656);
}
__device__ __forceinline__ void kload2(bf16x8*kf,lds_cptr kp,int j){ kf[2*j]=*(const __attribute__((address_space(3))) bf16x8*)(kp+j*2048); kf[2*j+1]=*(const __attribute__((address_space(3))) bf16x8*)(kp+j*2048+512); }
__device__ __forceinline__ s16x4 vtr(lds_cptr p){ return __builtin_bit_cast(s16x4,__builtin_amdgcn_ds_read_tr16_b64_v4i16((__attribute__((address_space(3))) v4i16_t*)p)); }
__device__ __forceinline__ float rowmax(const f32x16&p0,const f32x16&p1){
  float a=max3f(p0[0],p0[1],p1[0]),b=max3f(p0[2],p0[3],p1[1]);a=max3f(a,p1[2],p1[3]);
  #pragma unroll
  for(int r=4;r<16;r+=4){a=max3f(a,p0[r],p0[r+1]);b=max3f(b,p0[r+2],p0[r+3]);a=max3f(a,p1[r],p1[r+1]);b=max3f(b,p1[r+2],p1[r+3]);}
  const float m=max2f(a,b);
  auto rr=__builtin_amdgcn_permlane32_swap(__float_as_uint(m),__float_as_uint(m),false,false);
  return max2f(__uint_as_float(rr[0]),__uint_as_float(rr[1]));
}
__device__ __forceinline__ void pv(f32x16*o,int vb,bf16x8 pa0,bf16x8 pa1,bf16x8 pa2,bf16x8 pa3){
  #pragma unroll
  for(int d0=0;d0<4;++d0){s16x4 lo[4],hi[4];
    #pragma unroll
    for(int ks=0;ks<4;++ks){
      asm volatile("ds_read_b64_tr_b16 %0,%1 offset:%c2":"=&v"(lo[ks]):"v"(vb),"i"(d0*4096+ks*1024):"memory");
      asm volatile("ds_read_b64_tr_b16 %0,%1 offset:%c2":"=&v"(hi[ks]):"v"(vb),"i"(d0*4096+ks*1024+512):"memory");}
    asm volatile("s_waitcnt lgkmcnt(0)":::"memory");SBAR();
    #define PK(k) (bf16x8){lo[k][0],lo[k][1],lo[k][2],lo[k][3],hi[k][0],hi[k][1],hi[k][2],hi[k][3]}
    o[d0]=__builtin_amdgcn_mfma_f32_32x32x16_bf16(pa0,PK(0),o[d0],0,0,0);
    o[d0]=__builtin_amdgcn_mfma_f32_32x32x16_bf16(pa1,PK(1),o[d0],0,0,0);
    o[d0]=__builtin_amdgcn_mfma_f32_32x32x16_bf16(pa2,PK(2),o[d0],0,0,0);
    o[d0]=__builtin_amdgcn_mfma_f32_32x32x16_bf16(pa3,PK(3),o[d0],0,0,0);
    #undef PK
  }
}

#ifndef ATTN_STORE16
#define ATTN_STORE16(p,v) (*(u32x4*)(p)=(v))
#endif
template<int THRL> __device__ __forceinline__ void attn_unit(int qb,const bf16*Qh,const bf16*__restrict__ Kh,const bf16*__restrict__ Vh,bf16*Oh,char*shm){
  int tid_=threadIdx.x; asm volatile("":"+v"(tid_));
  const int tid=tid_,lane=tid&63,r32=lane&31,hi=lane>>5; const int wid=__builtin_amdgcn_readfirstlane(tid>>6);
  const int q0=qb*QB;
  const bf16*Qw=Qh+(long)(q0+wid*QBLK)*LDP;
  const unsigned lds0=(unsigned)(uintptr_t)shm;
  float*wsf=(float*)(shm+LDS_WS)+wid*64;
  const bf16*ksrc=Kh+(long)lane*LDP+wid*8;
  const bf16*vsrc=Vh+(long)(16*(wid&3)+(lane>>2))*LDP+(wid>>2)*32+(lane&3)*8;
  const unsigned kdst=lds0+LDS_K+wid*1024, vdst=lds0+LDS_V+wid*1024;
  #define DMA_K(t,slot) glds16(ksrc+(long)(t)*KVBLK*LDP,(unsigned)__builtin_amdgcn_readfirstlane(kdst+(slot)))
  #define DMA_V(t,slot) do{ glds16(vsrc+(long)(t)*KVBLK*LDP,(unsigned)__builtin_amdgcn_readfirstlane(vdst+2*(slot))); glds16(vsrc+64+(long)(t)*KVBLK*LDP,(unsigned)__builtin_amdgcn_readfirstlane(vdst+2*(slot)+8192)); }while(0)
  const int vb0=(int)(lds0+LDS_V)+((lane>>4)&1)*32+(lane&3)*8+(4*hi+((lane&15)>>2))*64;
  const char*Kbase=shm+LDS_K; bf16x8 kf[8];
  const lds_cptr shm3=(lds_cptr)shm; const lds_cptr kp0=shm3+LDS_K+hi*1024+r32*16; const lds_cptr vp0=shm3+LDS_V+((lane>>4)&1)*32+(lane&3)*8+(4*hi+((lane&15)>>2))*64;
  const int NT=(q0+QB)/KVBLK;
  DMA_K(0,0);DMA_V(0,0);DMA_K(1,SLOTB);
  bf16x8 qr[4];
  #pragma unroll
  for(int d0=0;d0<4;++d0)qr[d0]=*reinterpret_cast<const bf16x8*>(&Qw[(long)r32*LDP+d0*16+hi*8]);
  float mhat=0.f,l_reg=0.f;f32x16 o[4];o[0]=f32x16{};o[1]=f32x16{};o[2]=f32x16{};o[3]=f32x16{};
  const int qrel=wid*QBLK+r32;
  #define CMASK(P0,P1,t) do{int jb_=(t)-(NT-4); if(jb_>=0)cmask(P0,P1,jb_,qrel,hi);}while(0)
  bool resc=false;
  #define START(P0,P1) do{ const float rm=rowmax(P0,P1); resc=false; mhat=rm; \
    _Pragma("unroll") for(int r=0;r<16;++r)P0[r]=__builtin_amdgcn_exp2f(fsub_s(P0[r],mhat)); }while(0)
  #define RESC() do{ if(resc){ asm volatile("s_waitcnt lgkmcnt(0)":::"memory"); \
      _Pragma("unroll") for(int d_=0;d_<4;++d_) _Pragma("unroll") for(int r=0;r<16;++r)o[d_][r]*=wsf[crow(r,hi)]; } }while(0)
  f32x16 pA0,pA1,pB0,pB1;
  int sl_prev=0,sl_cur=0,sl_next=SLOTB;
  #define ROT() do{sl_prev=sl_cur;sl_cur=sl_next;sl_next=(sl_next==(NSLOT-1)*SLOTB)?0:sl_next+SLOTB;}while(0)
  DMA_K(2,2*SLOTB);
  WAIT_BAR(4);
  qkt(pA0,pA1,Kbase,qr,r32,hi);asm volatile("s_nop 15\n\ts_nop 7":"+v"(pA0),"+v"(pA1));CMASK(pA0,pA1,0);
  START(pA0,pA1);
  _Pragma("unroll") for(int r=0;r<16;++r)pA1[r]=__builtin_amdgcn_exp2f(pA1[r]-mhat);
  WAIT_BAR(0);
  DMA_K(3,0);DMA_V(1,SLOTB);
  ROT();
  kload8(kf,kp0+sl_cur);
  WAIT_BAR(3);
  s16x4 vlo[3],vhi[3]; u32x4 pw0,pw1,pw2,pw3;
  #define PKW(P,B) cvtpk_s(P[B],P[B+1])
  #define PAF(k) __builtin_bit_cast(bf16x8,pw##k)
  #define VFJ(j) (bf16x8){vlo[(j)%3][0],vlo[(j)%3][1],vlo[(j)%3][2],vlo[(j)%3][3],vhi[(j)%3][0],vhi[(j)%3][1],vhi[(j)%3][2],vhi[(j)%3][3]}
  #define PIN(x) asm volatile("":"+v"(x))
  #define MX3(a,b,c) __builtin_fmaxf(__builtin_fmaxf((a),(b)),(c))
  #define GAPA(MF,A0,A1,A2,A3,W0,W1,PW) do{ MF; sacc+=A0; sacc+=A1; sacc+=A2; sacc+=A3; PIN(sacc); W0; W1; PIN(PW); SBAR(); }while(0)
  #define EX(v) __builtin_amdgcn_exp2f(v)
  #define VJ(j) do{ vlo[(j)%3]=vtr(vp_+(((j)&3)*4096+((j)>>2)*1024)); vhi[(j)%3]=vtr(vp_+(((j)&3)*4096+((j)>>2)*1024+512)); }while(0)
  #define PVJ(j,PA,X,B) do{ if((j)+2<16){ VJ((j)+2); SBAR(); } o[(j)&3]=__builtin_amdgcn_mfma_f32_32x32x16_bf16(PA,VFJ(j),o[(j)&3],0,0,0); X[B]=EX(X[B]-mhat); X[B+1]=EX(X[B+1]-mhat); PIN(X); SBAR(); }while(0)
  #define KRD(G,j) do{ if(G){ kload2(kf,kp0+sl_next,j); SBAR(); } }while(0)
  #define STEP(C0,C1,P0,P1,t,GK,GV,GL) do{ SBAR(); \
    const lds_cptr vp_=vp0+2*sl_prev; \
    float sacc=(P0[0]+P0[1]); \
    GAPA(C0=__builtin_amdgcn_mfma_f32_32x32x16_bf16(kf[0],qr[0],f32x16{},0,0,0), P0[2],P0[3],P0[4],P0[5],     pw0[0]=PKW(P0,0), pw0[1]=PKW(P0,2), pw0); \
    GAPA(C1=__builtin_amdgcn_mfma_f32_32x32x16_bf16(kf[1],qr[0],f32x16{},0,0,0), P0[6],P0[7],P0[8],P0[9],     pw0[2]=PKW(P0,4), pw0[3]=PKW(P0,6), pw0); \
    GAPA(C0=__builtin_amdgcn_mfma_f32_32x32x16_bf16(kf[2],qr[1],C0,0,0,0),   P0[10],P0[11],P0[12],P0[13], pw1[0]=PKW(P0,8), pw1[1]=PKW(P0,10), pw1); \
    GAPA(C1=__builtin_amdgcn_mfma_f32_32x32x16_bf16(kf[3],qr[1],C1,0,0,0),   P0[14],P0[15],P1[0],P1[1],   pw1[2]=PKW(P0,12),pw1[3]=PKW(P0,14), pw1); \
    GAPA(C0=__builtin_amdgcn_mfma_f32_32x32x16_bf16(kf[4],qr[2],C0,0,0,0),   P1[2],P1[3],P1[4],P1[5],     pw2[0]=PKW(P1,0), pw2[1]=PKW(P1,2), pw2); \
    GAPA(C1=__builtin_amdgcn_mfma_f32_32x32x16_bf16(kf[5],qr[2],C1,0,0,0),   P1[6],P1[7],P1[8],P1[9],     pw2[2]=PKW(P1,4), pw2[3]=PKW(P1,6), pw2); \
    GAPA(C0=__builtin_amdgcn_mfma_f32_32x32x16_bf16(kf[6],qr[3],C0,0,0,0),   P1[10],P1[11],P1[12],P1[13], pw3[0]=PKW(P1,8), pw3[1]=PKW(P1,10), pw3); \
    GAPA(C1=__builtin_amdgcn_mfma_f32_32x32x16_bf16(kf[7],qr[3],C1,0,0,0),   P1[14],P1[15],0.f,0.f,       pw3[2]=PKW(P1,12),pw3[3]=PKW(P1,14), pw3); \
    l_reg+=sacc; VJ(0); VJ(1); SBAR(); \
 \
    if(GK){DMA_K((t)+3,sl_cur);} if(GV){DMA_V((t)+1,sl_next);} \
    CMASK(C0,C1,t); \
    { float a=MX3(C0[0],C0[1],C1[0]),b=MX3(C0[2],C0[3],C1[1]); a=MX3(a,C1[2],C1[3]); \
      _Pragma("unroll") for(int r=4;r<16;r+=4){a=MX3(a,C0[r],C0[r+1]);b=MX3(b,C0[r+2],C0[r+3]);a=MX3(a,C1[r],C1[r+1]);b=MX3(b,C1[r+2],C1[r+3]);} \
      float rm=__builtin_fmaxf(a,b); { auto rr=__builtin_amdgcn_permlane32_swap(__float_as_uint(rm),__float_as_uint(rm),false,false); rm=__builtin_fmaxf(__uint_as_float(rr[0]),__uint_as_float(rr[1])); } \
      resc=false; const float rel=rm-mhat; \
      if(__builtin_expect(__any(rel>(float)THRL),0)){ const float dl=__builtin_fmaxf(rel,0.f); mhat+=dl; \
        const float f=__builtin_amdgcn_exp2f(-dl); l_reg*=f; if(hi==0)wsf[r32]=f; resc=true; } } \
    SBAR(); \
    PVJ(0, PAF(0),C0,0);  PVJ(1, PAF(0),C0,2);  PVJ(2, PAF(0),C0,4);  PVJ(3, PAF(0),C0,6); \
    KRD(GL,0); PVJ(4, PAF(1),C0,8);  PVJ(5, PAF(1),C0,10); KRD(GL,1); PVJ(6, PAF(1),C0,12); PVJ(7, PAF(1),C0,14); \
    KRD(GL,2); PVJ(8, PAF(2),C1,0);  PVJ(9, PAF(2),C1,2);  KRD(GL,3); PVJ(10,PAF(2),C1,4);  PVJ(11,PAF(2),C1,6); \
    PVJ(12,PAF(3),C1,8);  PVJ(13,PAF(3),C1,10); PVJ(14,PAF(3),C1,12); PVJ(15,PAF(3),C1,14); \
    }while(0)
  int t=1;
  #undef CMASK
  #define CMASK(P0,P1,t) do{}while(0)
  for(;t+5<NT;t+=2){
    STEP(pB0,pB1,pA0,pA1,t,true,true,true);     WAIT_BAR(3); RESC(); ROT();
    STEP(pA0,pA1,pB0,pB1,t+1,true,true,true);   WAIT_BAR(3); RESC(); ROT();
  }
  #undef CMASK
  int hi_b=hi,qrel_b=qrel; asm volatile("":"+v"(hi_b),"+v"(qrel_b));
  #define CMASK(P0,P1,t) do{int jb_=(t)-(NT-4); if(jb_>=0)cmask(P0,P1,jb_,qrel_b,hi_b);}while(0)
  #define ENDW(tt) do{ if((tt)+3<NT){WAIT_BAR(3);} else if((tt)+2<NT){WAIT_BAR(2);} else {WAIT_BAR(0);} }while(0)
  for(;t+1<NT;t+=2){
    STEP(pB0,pB1,pA0,pA1,t,(t+3<NT),(t+1<NT),(t+1<NT));       ENDW(t);   RESC(); ROT();
    STEP(pA0,pA1,pB0,pB1,t+1,(t+4<NT),(t+2<NT),(t+2<NT));     ENDW(t+1); RESC(); ROT();
  }
  STEP(pB0,pB1,pA0,pA1,NT-1,false,false,false); RESC();
  { float sacc=pB0[0]+pB0[1]; _Pragma("unroll") for(int r=2;r<16;++r)sacc+=pB0[r]; _Pragma("unroll") for(int r=0;r<16;++r)sacc+=pB1[r]; l_reg+=sacc;
    pw0=(u32x4){PKW(pB0,0),PKW(pB0,2),PKW(pB0,4),PKW(pB0,6)};pw1=(u32x4){PKW(pB0,8),PKW(pB0,10),PKW(pB0,12),PKW(pB0,14)};pw2=(u32x4){PKW(pB1,0),PKW(pB1,2),PKW(pB1,4),PKW(pB1,6)};pw3=(u32x4){PKW(pB1,8),PKW(pB1,10),PKW(pB1,12),PKW(pB1,14)};
    SBAR(); pv(o,vb0+2*sl_cur,PAF(0),PAF(1),PAF(2),PAF(3)); }
  #undef PKW
  #undef PAF
  #undef VFJ
  #undef VJ
  #undef PVJ
  #undef PIN
  #undef MX3
  #undef GAPA
  #undef EX
  #undef KRD
  #undef STEP
  #undef ENDW
  int lanee=lane; asm volatile("":"+v"(lanee)); const int r32e=lanee&31,hie=lanee>>5;
  {auto rr=__builtin_amdgcn_permlane32_swap(__float_as_uint(l_reg),__float_as_uint(l_reg),false,false);l_reg=__uint_as_float(rr[0])+__uint_as_float(rr[1]);}
  if(hie==0)wsf[32+r32e]=l_reg;asm volatile("s_waitcnt lgkmcnt(0)":::"memory");
  float rli[16];
  #pragma unroll
  for(int r=0;r<16;++r)rli[r]=__builtin_amdgcn_rcpf(wsf[32+crow(r,hie)]);
  bf16*Ow=Oh+(long)(q0+wid*QBLK)*LDO;
  asm volatile("s_waitcnt lgkmcnt(0)\n\ts_barrier":::"memory");
  { bf16*stg=(bf16*)(shm)+wid*4096;
    #pragma unroll
    for(int r=0;r<16;++r){const int orow=crow(r,hie);
      #pragma unroll
      for(int d0=0;d0<4;++d0)stg[orow*128+d0*32+r32e]=__float2bfloat16(o[d0][r]*rli[r]);}
    asm volatile("s_waitcnt lgkmcnt(0)":::"memory");
    #pragma unroll
    for(int i=0;i<8;++i){const int row=i*4+(lanee>>4),ch=lanee&15; const u32x4 v=*(const u32x4*)(stg+row*128+ch*8); ATTN_STORE16(Ow+(long)row*LDO+ch*8,v);} }
  asm volatile("s_waitcnt lgkmcnt(0)\n\ts_barrier":::"memory");
  #undef DMA_K
  #undef DMA_V
  #undef CMASK
  #undef START
  #undef RESC
  #undef ROT
}
constexpr int ATTN_LDS_BYTES=LDS_BYTES;
template<int THRL=8> __device__ __forceinline__ void attn_phase(char*lds,const bf16*PE,bf16*AO,int vcu,int G){
  const int nu=(G==256)?2:((8*NQB-vcu+G-1)/G);
  #pragma unroll 1
  for(int i=0;i<nu;++i){
    int h2,qb;
    if(G==256){ const int s=vcu&31; h2=vcu>>5; qb=(i==0)?s:63-s; }
    else { const int u=vcu+i*G; h2=u/NQB; qb=u%NQB; }
    attn_unit<THRL>(qb,PE+h2*64,PE+512+h2*64,PE+1024+(h2>>1)*128,AO+h2*128,lds);
  }
}
#undef SBAR
#undef WAIT_BAR
}

#define GAS __attribute__((address_space(1)))
#define LAS __attribute__((address_space(3)))
typedef unsigned short bf16;
typedef unsigned v4u __attribute__((ext_vector_type(4)));
typedef float f32x4 __attribute__((ext_vector_type(4)));
typedef short bf16x8 __attribute__((ext_vector_type(8)));
typedef GAS unsigned gu32;
typedef GAS unsigned long long gu64;
#define RLX_AGENT __ATOMIC_RELAXED, __HIP_MEMORY_SCOPE_AGENT
#define LDS_WAIT() asm volatile("s_waitcnt lgkmcnt(0)" ::: "memory")
#define VM_WAIT() asm volatile("s_waitcnt vmcnt(0)" ::: "memory")
__device__ __forceinline__ unsigned long long rt() { return __builtin_amdgcn_s_memrealtime(); }
__device__ __forceinline__ unsigned f2bf(float f) { unsigned u = __builtin_bit_cast(unsigned, f); return (u + 0x7fffu + ((u >> 16) & 1u)) >> 16; }
__device__ __forceinline__ unsigned pk2(float lo, float hi) { return f2bf(lo) | (f2bf(hi) << 16); }

#define XB_TMO      128
#define XB_XCNT(j)  (256  + 64 * (j))
#define XB_XSUB(j)  (1280 + 64 * (j))
#define XB_XGEN(j)  (2304 + 64 * (j))
#define XB_TOP      3328
#define XB_TOPGEN   3392
#define XCD_BAR_WORDS 3456
#define XB_SPIN_CAP (1u << 18)

__device__ __forceinline__ unsigned xb_ld(unsigned* p)              { return __hip_atomic_load(p, __ATOMIC_RELAXED, __HIP_MEMORY_SCOPE_AGENT); }
__device__ __forceinline__ unsigned xb_add(unsigned* p, unsigned v) { return __hip_atomic_fetch_add(p, v, __ATOMIC_RELAXED, __HIP_MEMORY_SCOPE_AGENT); }
__device__ __forceinline__ unsigned xb_xcc_id() { return (unsigned)__builtin_amdgcn_s_getreg((3 << 11) | 20) & 0xFu; }
#define XB_SPIN(cond, bar) do { unsigned _sp = 0; while (cond) { __builtin_amdgcn_s_sleep(1); \
    if ((++_sp & 255u) == 0u) { if (xb_ld(&(bar)[XB_TMO])) break; if (_sp > XB_SPIN_CAP) { atomicAdd(&(bar)[XB_TMO], 1u); break; } } } } while (0)

struct XcdBarrier {
    unsigned* bar; unsigned x;
    volatile LAS unsigned* st;
};

__device__ __forceinline__ XcdBarrier xcd_barrier_post(unsigned* bar, volatile LAS unsigned* st) {
    XcdBarrier b; b.bar = bar; b.x = xb_xcc_id(); b.st = st;
    if (threadIdx.x == 0) (void)xb_add(&bar[XB_XCNT(b.x)], 1u);
    return b;
}
__device__ __forceinline__ void xcd_barrier_complete(unsigned* bar, unsigned x, unsigned& nloc, unsigned& nx) {
    const unsigned G = gridDim.x * gridDim.y * gridDim.z;
    unsigned sum, cnt, mine, sp = 0u;
    for (;;) {
        sum = 0u; cnt = 0u; mine = 0u;
#pragma unroll
        for (unsigned j = 0; j < 16; ++j) { const unsigned c = xb_ld(&bar[XB_XCNT(j)]); sum += c; cnt += (c > 0u) ? 1u : 0u; mine = (j == x) ? c : mine; }
        if (sum == G) break;
        __builtin_amdgcn_s_sleep(1);
        if ((++sp & 255u) == 0u) { if (xb_ld(&bar[XB_TMO])) break; if (sp > XB_SPIN_CAP) { atomicAdd(&bar[XB_TMO], 1u); break; } }
    }
    nloc = mine > 0u ? mine : 1u; nx = cnt > 0u ? cnt : 1u;
}

__device__ __forceinline__ void xcd_barrier(const XcdBarrier& b) {
    asm volatile("s_waitcnt vmcnt(0)" ::: "memory");
    __syncthreads();
    if (threadIdx.x == 0) {
        unsigned* bar = b.bar;
        __builtin_amdgcn_s_waitcnt(0);
        unsigned nloc = b.st[0], nx = b.st[1];
        if (nloc == 0u) { xcd_barrier_complete(bar, b.x, nloc, nx); b.st[0] = nloc; b.st[1] = nx; }
        const unsigned old = xb_add(&bar[XB_XSUB(b.x)], 1u);
        const unsigned gen = old / nloc;
        if (old + 1u == (gen + 1u) * nloc) {
            __builtin_amdgcn_fence(__ATOMIC_RELEASE, "agent");
            asm volatile("s_waitcnt vmcnt(0)" ::: "memory");
            const unsigned og = xb_add(&bar[XB_TOP], 1u);
            const unsigned tg = og / nx;
            if (og + 1u == (tg + 1u) * nx) xb_add(&bar[XB_TOPGEN], 1u);
            else XB_SPIN(xb_ld(&bar[XB_TOPGEN]) == tg, bar);
            __builtin_amdgcn_fence(__ATOMIC_ACQUIRE, "agent");
            xb_add(&bar[XB_XGEN(b.x)], 1u);
            asm volatile("s_waitcnt vmcnt(0)" ::: "memory");
        } else {
            XB_SPIN(xb_ld(&bar[XB_XGEN(b.x)]) == gen, bar);
            __builtin_amdgcn_fence(__ATOMIC_ACQUIRE, "agent");
            asm volatile("s_waitcnt vmcnt(0)" ::: "memory");
        }
    }
    __syncthreads();
}

constexpr int NWAVES = 8;
constexpr size_t MiB = 1u << 20;
constexpr size_t WS_CTL = 0, CTL_ZERO_BYTES = 1 * MiB;
constexpr size_t WS_TAB = 1 * MiB;
constexpr size_t WS_SSQA = 2 * MiB, WS_SSQB = 3 * MiB;
constexpr size_t WS_GB = 4 * MiB;
constexpr size_t WS_GC = 512 * 1024;
constexpr size_t WS_TOK = 5 * MiB;
constexpr size_t WS_W = 6 * MiB;
constexpr size_t WS_WINE = WS_W, WS_WOUTE = WS_W + 12 * MiB, WS_W13D = WS_W + 16 * MiB, WS_W2D = WS_W + 44 * MiB, WS_WINO = WS_W + 58 * MiB, WS_WOUTO = WS_W + 74 * MiB,
                 WS_WG = WS_W + 78 * MiB, WS_WP = WS_W + 86 * MiB, WS_W13M = WS_W + 88 * MiB, WS_W2M = WS_W + 200 * MiB;
constexpr size_t WS_PBF = 262 * MiB, WS_HBF = 294 * MiB, WS_PP = 326 * MiB, WS_MIX = 358 * MiB, WS_ARENA = 390 * MiB;
constexpr size_t AR_PE = 0, AR_AO = 96 * MiB;
constexpr size_t AR_PO = 0, AR_QN = 128 * MiB, AR_QT = 160 * MiB, AR_KN = 192 * MiB, AR_KGT = 224 * MiB, AR_VBT = 256 * MiB, AR_KTT = 288 * MiB, AR_AI = 320 * MiB, AR_NEGW = 336 * MiB,
                 AR_UT = 368 * MiB, AR_MP = 400 * MiB, AR_NT = 464 * MiB, AR_WT = 528 * MiB, AR_SG = 192 * MiB  , AR_MPC = 288 * MiB  , AR_NTC = 304 * MiB, AR_END = 560 * MiB;
constexpr size_t AR_ACT = 0, AR_XS = 240 * MiB, AR_Y = 308 * MiB;
constexpr size_t WS_NEED = WS_ARENA + AR_END;
constexpr size_t TOK_E = 0, TOK_R = 128 * 1024, TOK_G = 256 * 1024, TOK_DST = 384 * 1024, TOK_GPAD = 512 * 1024, TOK_DN = 704 * 1024, TOK_DNC = 720 * 1024;
constexpr int CW_TMO = 0, CW_BAR = 4096, CW_CNT = 8192  , CW_DBG = 12288;

constexpr int RING_OFF = 0, WAVE_LDS = 17408;
constexpr int LDSCTL_OFF = 139264, MISC_OFF = LDSCTL_OFF + 64, BLKE_OFF = LDSCTL_OFF + 256  , RT_OFF = LDSCTL_OFF + 1024  ;
constexpr int LDS_BYTES = 147456;

typedef unsigned u32x2v __attribute__((ext_vector_type(2)));
__device__ __forceinline__ float bflo(unsigned w) { return __uint_as_float(w << 16); }
__device__ __forceinline__ float bfhi(unsigned w) { return __uint_as_float(w & 0xffff0000u); }
__device__ __forceinline__ unsigned cvtpk(float lo, float hi) { return pg8::cvt_pk_bf16_cv(lo, hi); }
__device__ __forceinline__ float wave_sum(float v) {
#pragma unroll
    for (int o = 1; o < 64; o <<= 1) v += __shfl_xor(v, o);
    return v;
}
__device__ __forceinline__ float sigm(float x) { return pg8::sigmoidf_(x); }
__device__ __forceinline__ float silu(float x) { return x * pg8::sigmoidf_(x); }

struct Args { const void* in[30]; float* out; unsigned char* ws; int ph_lo, ph_hi, use_bar, pad; };

struct Frame {
    LAS unsigned char* lds; int tid, lane, wave, vcu, G, gw, NGW;
};

__device__ __forceinline__ void xpose_item(const float* W, int ldw, int K, int N, const float* gain, bf16* WT, int ilv, LAS float* scr, int item, int lane) {
    const int nblk = N / 64, kb = item / nblk, nb = item % nblk, k0 = 64 * kb, n0 = 64 * nb;
    const int lr = lane >> 4, lc = (lane & 15) * 4;
    f32x4 v[16];
#pragma unroll
    for (int i = 0; i < 16; ++i) v[i] = *(const GAS f32x4*)(W + (size_t)(k0 + 4 * i + lr) * ldw + n0 + lc);
    if (gain) {
#pragma unroll
        for (int i = 0; i < 16; ++i) v[i] = v[i] * gain[k0 + 4 * i + lr]; }
#pragma unroll
    for (int i = 0; i < 16; ++i) { LAS float* s = scr + (4 * i + lr) * 65 + lc; s[0] = v[i][0]; s[1] = v[i][1]; s[2] = v[i][2]; s[3] = v[i][3]; }
    LDS_WAIT(); asm volatile("" ::: "memory");
    const int c = lane & 7;
#pragma unroll
    for (int j = 0; j < 8; ++j) { const int nl = (lane >> 3) + 8 * j, n = n0 + nl; const LAS float* s = scr + (8 * c) * 65 + nl;
        const int dr = ilv ? (((n >> 7) << 8) + (n & 127) + (ilv == 2 ? 128 : 0)) : n;
        v4u o; o.x = pk2(s[0 * 65], s[1 * 65]); o.y = pk2(s[2 * 65], s[3 * 65]); o.z = pk2(s[4 * 65], s[5 * 65]); o.w = pk2(s[6 * 65], s[7 * 65]);
        *(GAS v4u*)(WT + (size_t)dr * K + k0 + 8 * c) = o; }
    LDS_WAIT(); asm volatile("" ::: "memory");
}
struct MatD { const float* W; int ldw, K, N; const float* gain; bf16* WT; int ilv; int items; };
__device__ __forceinline__ MatD dense_mat(const Args& a, int id) {
    unsigned char* ws = a.ws; MatD m; m.gain = nullptr; m.ilv = 0;
    if (id < 2)       { const int j = id;      m.W = (const float*)a.in[7] + (size_t)j * D_ * EIN;    m.ldw = EIN; m.K = D_; m.N = EIN; m.gain = (const float*)a.in[3] + (2 * j) * D_; m.WT = (bf16*)(ws + WS_WINE) + (size_t)j * EIN * D_; }
    else if (id < 4)  { const int j = id - 2;  m.W = (const float*)a.in[8] + (size_t)j * D_ * D_;     m.ldw = D_; m.K = D_; m.N = D_; m.WT = (bf16*)(ws + WS_WOUTE) + (size_t)j * D_ * D_; }
    else if (id < 6)  { const int j = id - 4;  m.W = (const float*)a.in[21] + (size_t)j * D_ * DFF;   m.ldw = DFF; m.K = D_; m.N = DFF; m.gain = (const float*)a.in[4] + (2 * j) * D_; m.WT = (bf16*)(ws + WS_W13D) + (size_t)j * 2 * DFF * D_; m.ilv = 1; }
    else if (id < 8)  { const int j = id - 6;  m.W = (const float*)a.in[22] + (size_t)j * D_ * DFF;   m.ldw = DFF; m.K = D_; m.N = DFF; m.gain = (const float*)a.in[4] + (2 * j) * D_; m.WT = (bf16*)(ws + WS_W13D) + (size_t)j * 2 * DFF * D_; m.ilv = 2; }
    else if (id < 10) { const int j = id - 8;  m.W = (const float*)a.in[23] + (size_t)j * DFF * D_;   m.ldw = D_; m.K = DFF; m.N = D_; m.WT = (bf16*)(ws + WS_W2D) + (size_t)j * D_ * DFF; }
    else if (id < 12) { const int j = id - 10; m.W = (const float*)a.in[15] + (size_t)j * D_ * OIN_SRC; m.ldw = OIN_SRC; m.K = D_; m.N = OIN; m.gain = (const float*)a.in[3] + (2 * j + 1) * D_; m.WT = (bf16*)(ws + WS_WINO) + (size_t)j * OIN * D_; }
    else if (id < 14) { const int j = id - 12; m.W = (const float*)a.in[20] + (size_t)j * D_ * D_;    m.ldw = D_; m.K = D_; m.N = D_; m.WT = (bf16*)(ws + WS_WOUTO) + (size_t)j * D_ * D_; }
    else if (id < 18) { const int i = id - 14; m.W = (const float*)a.in[28] + (size_t)i * D_ * D_;    m.ldw = D_; m.K = D_; m.N = D_; m.gain = (const float*)a.in[5] + i * D_; m.WT = (bf16*)(ws + WS_WG) + (size_t)i * D_ * D_; }
    else              { const int i = id - 18; m.W = (const float*)a.in[29] + (size_t)i * PLE * D_;   m.ldw = D_; m.K = PLE; m.N = D_; m.WT = (bf16*)(ws + WS_WP) + (size_t)i * D_ * PLE; }
    m.items = (m.K / 64) * (m.N / 64); return m;
}
__device__ __forceinline__ MatD moe_mat(const Args& a, int j, int id) {
    unsigned char* ws = a.ws; MatD m; m.gain = nullptr; m.ilv = 0; const int e = id / 3, k = id % 3;
    if (k < 2) { m.W = (const float*)a.in[25 + k] + ((size_t)j * NEXP + e) * D_ * DFF; m.ldw = DFF; m.K = D_; m.N = DFF; m.gain = (const float*)a.in[4] + (2 * j + 1) * D_; m.WT = (bf16*)(ws + WS_W13M) + (size_t)e * 2 * DFF * D_; m.ilv = 1 + k; }
    else       { m.W = (const float*)a.in[27] + ((size_t)j * NEXP + e) * DFF * D_; m.ldw = D_; m.K = DFF; m.N = D_; m.WT = (bf16*)(ws + WS_W2M) + (size_t)e * D_ * DFF; }
    m.items = (m.K / 64) * (m.N / 64); return m;
}

__device__ __forceinline__ void p_prologue(const Frame& F, const Args& a) {
    LAS float* scr = (LAS float*)(F.lds + F.wave * WAVE_LDS);
    unsigned char* ws = a.ws;
    {
        int base = 0;
#pragma unroll 1
        for (int id = 0; id < 22; ++id) { const MatD m = dense_mat(a, id);
            int first = (F.gw - base) % F.NGW; if (first < 0) first += F.NGW;
#pragma unroll 1
            for (int it = first; it < m.items; it += F.NGW) xpose_item(m.W, m.ldw, m.K, m.N, m.gain, m.WT, m.ilv, scr, it, F.lane);
            base += m.items; }
    }
    { const float* p = (const float*)a.in[1]; bf16* pb = (bf16*)(ws + WS_PBF); const size_t n8 = (size_t)DEPTH_ * S_ * PLE / 8;
#pragma unroll 1
      for (size_t i = (size_t)F.gw * 64 + F.lane; i < n8; i += (size_t)F.NGW * 64) { const f32x4 x0 = *(const GAS f32x4*)(p + i * 8), x1 = *(const GAS f32x4*)(p + i * 8 + 4);
          v4u o; o.x = cvtpk(x0[0], x0[1]); o.y = cvtpk(x0[2], x0[3]); o.z = cvtpk(x1[0], x1[1]); o.w = cvtpk(x1[2], x1[3]); *(GAS v4u*)(pb + i * 8) = o; } }
    { const float* x = (const float*)a.in[0]; bf16* hb = (bf16*)(ws + WS_HBF); float* ssq = (float*)(ws + WS_SSQB);
#pragma unroll 1
      for (int m = F.gw; m < S_; m += F.NGW) { const GAS f32x4* xr = (const GAS f32x4*)(x + (size_t)m * D_) + F.lane; float s = 0.f;
#pragma unroll
          for (int j = 0; j < 4; ++j) { const f32x4 v = xr[64 * j]; s += (v[0] * v[0] + v[1] * v[1]) + (v[2] * v[2] + v[3] * v[3]);
              *((GAS f32x4*)(a.out + (size_t)m * D_) + F.lane + 64 * j) = v;
              u32x2v o; o.x = cvtpk(v[0], v[1]); o.y = cvtpk(v[2], v[3]); *((GAS u32x2v*)(hb + (size_t)m * D_) + F.lane + 64 * j) = o; }
          s = wave_sum(s);
          if (F.lane < 16) ssq[(size_t)m * 16 + F.lane] = (F.lane == 0) ? s : 0.f; } }
    { const int* pos = (const int*)a.in[2]; float* tab = (float*)(ws + WS_TAB);
#pragma unroll 1
      for (int idx = F.gw * 64 + F.lane; idx < S_ * 8; idx += F.NGW * 64) { const int row = idx >> 3, i = idx & 7;
          const float inv = exp2f(-(float)i * (18.931568569324174f / 8.0f));
          const float ang = (float)pos[row] * inv;
          double t = (double)ang * 0.15915494309189535; t -= rint(t); const float tf = (float)t;
          tab[(size_t)row * 16 + i] = __builtin_amdgcn_cosf(tf); tab[(size_t)row * 16 + 8 + i] = __builtin_amdgcn_sinf(tf); } }
}

__device__ __forceinline__ void p_mixprep(const Frame& F, const Args& a, int L) {
    GAS unsigned char* ws = (GAS unsigned char*)a.ws; asm volatile("" : "+s"(ws)); int lane_ = F.lane; asm volatile("" : "+v"(lane_)); const int j = L >> 1, lane = lane_;
    const bf16* AO = (const bf16*)(ws + WS_ARENA + AR_AO); const bf16* PE = (const bf16*)(ws + WS_ARENA + AR_PE); bf16* mix = (bf16*)(ws + WS_MIX);
    const float lam0 = 0.8f - 0.6f * expf(-0.3f * (float)L);
    float s1 = ((const float*)a.in[9])[j * 64 + lane] * ((const float*)a.in[10])[j * 64 + lane], s2 = ((const float*)a.in[11])[j * 64 + lane] * ((const float*)a.in[12])[j * 64 + lane];
    s1 = wave_sum(s1); s2 = wave_sum(s2);
    const float lam = expf(s1) - expf(s2) + lam0, post = 1.0f - lam0;
    const int hh = lane >> 4, dd = (lane & 15) * 8, ch = lane * 8;
    float sg[8], w0[8], w1[8], w2[8];
#pragma unroll
    for (int e = 0; e < 8; ++e) { sg[e] = ((const float*)a.in[13])[j * 128 + dd + e] * post;
        w0[e] = ((const float*)a.in[14])[(j * 3 + 0) * 512 + ch + e]; w1[e] = ((const float*)a.in[14])[(j * 3 + 1) * 512 + ch + e]; w2[e] = ((const float*)a.in[14])[(j * 3 + 2) * 512 + ch + e]; }
#pragma unroll 1
    for (int t = F.gw; t < S_; t += F.NGW) {
        const v4u o1 = *(const GAS v4u*)(AO + (size_t)t * D_ + 256 * hh + dd), o2 = *(const GAS v4u*)(AO + (size_t)t * D_ + 256 * hh + 128 + dd);
        float d[8]; const unsigned a1[4] = {o1.x, o1.y, o1.z, o1.w}, a2[4] = {o2.x, o2.y, o2.z, o2.w}; float ss = 0.f;
#pragma unroll
        for (int q = 0; q < 4; ++q) { d[2 * q] = bflo(a1[q]) - lam * bflo(a2[q]); d[2 * q + 1] = bfhi(a1[q]) - lam * bfhi(a2[q]); ss += d[2 * q] * d[2 * q] + d[2 * q + 1] * d[2 * q + 1]; }
        ss += __shfl_xor(ss, 1); ss += __shfl_xor(ss, 2); ss += __shfl_xor(ss, 4); ss += __shfl_xor(ss, 8);
        const float rms = __builtin_amdgcn_rsqf(ss * (1.0f / 128.0f) + 1e-5f);
        v4u o; o.x = cvtpk(d[0] * rms * sg[0], d[1] * rms * sg[1]); o.y = cvtpk(d[2] * rms * sg[2], d[3] * rms * sg[3]); o.z = cvtpk(d[4] * rms * sg[4], d[5] * rms * sg[5]); o.w = cvtpk(d[6] * rms * sg[6], d[7] * rms * sg[7]);
        *(GAS v4u*)(mix + (size_t)t * D_ + hh * 128 + dd) = o;
        const bf16* r0 = PE + (size_t)t * EIN;
        const v4u bb = *(const GAS v4u*)(r0 + 1536 + ch), c0 = *(const GAS v4u*)(r0 + 2048 + ch), x0 = *(const GAS v4u*)(r0 + 2560 + ch);
        v4u c1 = {0u, 0u, 0u, 0u}, x1 = c1, c2 = c1, x2 = c1;
        if (t >= 1) { c1 = *(const GAS v4u*)(r0 - EIN + 2048 + ch); x1 = *(const GAS v4u*)(r0 - EIN + 2560 + ch); }
        if (t >= 2) { c2 = *(const GAS v4u*)(r0 - 2 * EIN + 2048 + ch); x2 = *(const GAS v4u*)(r0 - 2 * EIN + 2560 + ch); }
        const unsigned B[4] = {bb.x, bb.y, bb.z, bb.w}, C0[4] = {c0.x, c0.y, c0.z, c0.w}, X0[4] = {x0.x, x0.y, x0.z, x0.w}, C1[4] = {c1.x, c1.y, c1.z, c1.w}, X1[4] = {x1.x, x1.y, x1.z, x1.w},
                       C2[4] = {c2.x, c2.y, c2.z, c2.w}, X2[4] = {x2.x, x2.y, x2.z, x2.w};
        float sc[8];
#pragma unroll
        for (int q = 0; q < 4; ++q) {
            sc[2 * q] = bflo(B[q]) * (w2[2 * q] * (bflo(C0[q]) * bflo(X0[q])) + w1[2 * q] * (bflo(C1[q]) * bflo(X1[q])) + w0[2 * q] * (bflo(C2[q]) * bflo(X2[q])));
            sc[2 * q + 1] = bfhi(B[q]) * (w2[2 * q + 1] * (bfhi(C0[q]) * bfhi(X0[q])) + w1[2 * q + 1] * (bfhi(C1[q]) * bfhi(X1[q])) + w0[2 * q + 1] * (bfhi(C2[q]) * bfhi(X2[q]))); }
        v4u so; so.x = cvtpk(sc[0], sc[1]); so.y = cvtpk(sc[2], sc[3]); so.z = cvtpk(sc[4], sc[5]); so.w = cvtpk(sc[6], sc[7]);
        *(GAS v4u*)(mix + (size_t)t * D_ + 512 + ch) = so;
    }
}


__device__ __forceinline__ void p_rot(const Frame& F, const Args& a) {
    GAS unsigned char* ws = (GAS unsigned char*)a.ws; asm volatile("" : "+s"(ws)); int lane_ = F.lane; asm volatile("" : "+v"(lane_)); const int lane = lane_;
    bf16* PE = (bf16*)(ws + WS_ARENA + AR_PE); const float* tab = (const float*)(ws + WS_TAB);
    const int hd = lane >> 2, i0 = 2 * (lane & 3), col = (hd < 8 ? hd * 64 : 512 + (hd - 8) * 64) + i0;
#pragma unroll 1
    for (int t = F.gw; t < S_; t += F.NGW) {
        GAS unsigned* p1 = (GAS unsigned*)(PE + (size_t)t * EIN + col); GAS unsigned* p2 = (GAS unsigned*)(PE + (size_t)t * EIN + col + 8);
        const unsigned w1 = *p1, w2 = *p2;
        const float c0 = tab[(size_t)t * 16 + i0], c1 = tab[(size_t)t * 16 + i0 + 1], s0 = tab[(size_t)t * 16 + 8 + i0], s1 = tab[(size_t)t * 16 + 8 + i0 + 1];
        const float a0 = bflo(w1), a1 = bfhi(w1), b0 = bflo(w2), b1 = bfhi(w2);
        *p1 = cvtpk(a0 * c0 - b0 * s0, a1 * c1 - b1 * s1); *p2 = cvtpk(b0 * c0 + a0 * s0, b1 * c1 + a1 * s1);
    }
}
__device__ __forceinline__ void p_ab(const Frame& F, const Args& a, int L) {
    GAS unsigned char* ws = (GAS unsigned char*)a.ws; asm volatile("" : "+s"(ws)); int lane_ = F.lane; asm volatile("" : "+v"(lane_)); const int j = L >> 1, lane = lane_;
    LAS float* wl = (LAS float*)F.lds;
    const float* W = (const float*)a.in[15] + (size_t)j * D_ * OIN_SRC; const float* ln = (const float*)a.in[3] + L * D_;
    for (int idx = F.tid; idx < D_ * 16; idx += NWAVES * 64) { const int k = idx >> 4, c = idx & 15; wl[k * 20 + c] = ln[k] * W[(size_t)k * OIN_SRC + 4096 + c]; }
    __syncthreads();
    const float* ssq = (const float*)(ws + WS_SSQB); float* gg = (float*)(ws + WS_GB); float* gbeta = gg + S_ * 8;
    const float alog = ((const float*)a.in[17])[j * 8 + (lane & 7)], dtb = ((const float*)a.in[18])[j * 8 + (lane & 7)];
    const GAS float* hG = (const GAS float*)a.out;
#pragma unroll 1
    for (int t0 = F.gw; t0 < S_; t0 += 2 * F.NGW) {
        const int tb = t0 + F.NGW; const bool hasb = tb < S_; const int tbc = hasb ? tb : t0;
        float xa[16], xb[16];
#pragma unroll
        for (int i = 0; i < 16; ++i) { xa[i] = hG[(size_t)t0 * D_ + 64 * i + lane]; xb[i] = hG[(size_t)tbc * D_ + 64 * i + lane]; }
        const float rsa = pg8::rstd_row(ssq, t0), rsb = pg8::rstd_row(ssq, tbc);
        float acca[16], accb[16];
#pragma unroll
        for (int c = 0; c < 16; ++c) { acca[c] = 0.f; accb[c] = 0.f; }
#pragma unroll 4
        for (int i = 0; i < 16; ++i) { const LAS f32x4* wr = (const LAS f32x4*)(wl + (64 * i + lane) * 20);
#pragma unroll
            for (int q = 0; q < 4; ++q) { const f32x4 w = wr[q];
                acca[4 * q] += xa[i] * w[0]; acca[4 * q + 1] += xa[i] * w[1]; acca[4 * q + 2] += xa[i] * w[2]; acca[4 * q + 3] += xa[i] * w[3];
                accb[4 * q] += xb[i] * w[0]; accb[4 * q + 1] += xb[i] * w[1]; accb[4 * q + 2] += xb[i] * w[2]; accb[4 * q + 3] += xb[i] * w[3]; } }
        float minea = 0.f, mineb = 0.f;
#pragma unroll
        for (int c = 0; c < 16; ++c) { const float sa = wave_sum(acca[c]), sb = wave_sum(accb[c]); minea = ((lane & 15) == c) ? sa : minea; mineb = ((lane & 15) == c) ? sb : mineb; }
#pragma unroll
        for (int half = 0; half < 2; ++half) { if (half == 1 && !hasb) break;
            const int t = half ? tb : t0; const float mine = (half ? mineb * rsb : minea * rsa);
            if (lane < 8) gbeta[(size_t)t * 8 + lane] = sigm(mine);
            else if (lane < 16) { const float z = mine + dtb; const float sp = z > 20.f ? z : log1pf(expf(z)); gg[(size_t)t * 8 + lane - 8] = -expf(alog) * sp; } }
    }
    __syncthreads();
}
__device__ __forceinline__ void tri_solve(const LAS float* Lc, LAS bf16* Xs, int lane) {
    float x0, x1, x2, x3, x4, x5, x6, x7, x8, x9, x10, x11, x12, x13, x14, x15, x16, x17, x18, x19, x20, x21, x22, x23, x24, x25, x26, x27, x28, x29, x30, x31, x32, x33, x34, x35, x36, x37, x38, x39, x40, x41, x42, x43, x44, x45, x46, x47, x48, x49, x50, x51, x52, x53, x54, x55, x56, x57, x58, x59, x60, x61, x62, x63;
    { x63 = (lane == 63) ? 1.0f : 0.0f; asm volatile("" : "+v"(x63) : : "memory"); }
    { float s0 = 0.f, s1 = 0.f, s2 = 0.f, s3 = 0.f; { const f32x4 l = *(const LAS f32x4*)(Lc + 4276); s3 = fmaf(x63, l[3], s3); } x62 = (lane == 62) ? 1.0f : -((s0 + s1) + (s2 + s3)); asm volatile("" : "+v"(x62) : : "memory"); }
    { float s0 = 0.f, s1 = 0.f, s2 = 0.f, s3 = 0.f; { const f32x4 l = *(const LAS f32x4*)(Lc + 4208); s2 = fmaf(x62, l[2], s2); s3 = fmaf(x63, l[3], s3); } x61 = (lane == 61) ? 1.0f : -((s0 + s1) + (s2 + s3)); asm volatile("" : "+v"(x61) : : "memory"); }
    { float s0 = 0.f, s1 = 0.f, s2 = 0.f, s3 = 0.f; { const f32x4 l = *(const LAS f32x4*)(Lc + 4140); s1 = fmaf(x61, l[1], s1); s2 = fmaf(x62, l[2], s2); s3 = fmaf(x63, l[3], s3); } x60 = (lane == 60) ? 1.0f : -((s0 + s1) + (s2 + s3)); asm volatile("" : "+v"(x60) : : "memory"); }
    { float s0 = 0.f, s1 = 0.f, s2 = 0.f, s3 = 0.f; { const f32x4 l = *(const LAS f32x4*)(Lc + 4072); s0 = fmaf(x60, l[0], s0); s1 = fmaf(x61, l[1], s1); s2 = fmaf(x62, l[2], s2); s3 = fmaf(x63, l[3], s3); } x59 = (lane == 59) ? 1.0f : -((s0 + s1) + (s2 + s3)); asm volatile("" : "+v"(x59) : : "memory"); }
    { float s0 = 0.f, s1 = 0.f, s2 = 0.f, s3 = 0.f; { const f32x4 l = *(const LAS f32x4*)(Lc + 4000); s3 = fmaf(x59, l[3], s3); } { const f32x4 l = *(const LAS f32x4*)(Lc + 4004); s0 = fmaf(x60, l[0], s0); s1 = fmaf(x61, l[1], s1); s2 = fmaf(x62, l[2], s2); s3 = fmaf(x63, l[3], s3); } x58 = (lane == 58) ? 1.0f : -((s0 + s1) + (s2 + s3)); asm volatile("" : "+v"(x58) : : "memory"); }
    { float s0 = 0.f, s1 = 0.f, s2 = 0.f, s3 = 0.f; { const f32x4 l = *(const LAS f32x4*)(Lc + 3932); s2 = fmaf(x58, l[2], s2); s3 = fmaf(x59, l[3], s3); } { const f32x4 l = *(const LAS f32x4*)(Lc + 3936); s0 = fmaf(x60, l[0], s0); s1 = fmaf(x61, l[1], s1); s2 = fmaf(x62, l[2], s2); s3 = fmaf(x63, l[3], s3); } x57 = (lane == 57) ? 1.0f : -((s0 + s1) + (s2 + s3)); asm volatile("" : "+v"(x57) : : "memory"); }
    { float s0 = 0.f, s1 = 0.f, s2 = 0.f, s3 = 0.f; { const f32x4 l = *(const LAS f32x4*)(Lc + 3864); s1 = fmaf(x57, l[1], s1); s2 = fmaf(x58, l[2], s2); s3 = fmaf(x59, l[3], s3); } { const f32x4 l = *(const LAS f32x4*)(Lc + 3868); s0 = fmaf(x60, l[0], s0); s1 = fmaf(x61, l[1], s1); s2 = fmaf(x62, l[2], s2); s3 = fmaf(x63, l[3], s3); } x56 = (lane == 56) ? 1.0f : -((s0 + s1) + (s2 + s3)); asm volatile("" : "+v"(x56) : : "memory"); }
    { float s0 = 0.f, s1 = 0.f, s2 = 0.f, s3 = 0.f; { const f32x4 l = *(const LAS f32x4*)(Lc + 3796); s0 = fmaf(x56, l[0], s0); s1 = fmaf(x57, l[1], s1); s2 = fmaf(x58, l[2], s2); s3 = fmaf(x59, l[3], s3); } { const f32x4 l = *(const LAS f32x4*)(Lc + 3800); s0 = fmaf(x60, l[0], s0); s1 = fmaf(x61, l[1], s1); s2 = fmaf(x62, l[2], s2); s3 = fmaf(x63, l[3], s3); } x55 = (lane == 55) ? 1.0f : -((s0 + s1) + (s2 + s3)); asm volatile("" : "+v"(x55) : : "memory"); }
    { float s0 = 0.f, s1 = 0.f, s2 = 0.f, s3 = 0.f; { const f32x4 l = *(const LAS f32x4*)(Lc + 3724); s3 = fmaf(x55, l[3], s3); } { const f32x4 l = *(const LAS f32x4*)(Lc + 3728); s0 = fmaf(x56, l[0], s0); s1 = fmaf(x57, l[1], s1); s2 = fmaf(x58, l[2], s2); s3 = fmaf(x59, l[3], s3); } { const f32x4 l = *(const LAS f32x4*)(Lc + 3732); s0 = fmaf(x60, l[0], s0); s1 = fmaf(x61, l[1], s1); s2 = fmaf(x62, l[2], s2); s3 = fmaf(x63, l[3], s3); } x54 = (lane == 54) ? 1.0f : -((s0 + s1) + (s2 + s3)); asm volatile("" : "+v"(x54) : : "memory"); }
    { float s0 = 0.f, s1 = 0.f, s2 = 0.f, s3 = 0.f; { const f32x4 l = *(const LAS f32x4*)(Lc + 3656); s2 = fmaf(x54, l[2], s2); s3 = fmaf(x55, l[3], s3); } { const f32x4 l = *(const LAS f32x4*)(Lc + 3660); s0 = fmaf(x56, l[0], s0); s1 = fmaf(x57, l[1], s1); s2 = fmaf(x58, l[2], s2); s3 = fmaf(x59, l[3], s3); } { const f32x4 l = *(const LAS f32x4*)(Lc + 3664); s0 = fmaf(x60, l[0], s0); s1 = fmaf(x61, l[1], s1); s2 = fmaf(x62, l[2], s2); s3 = fmaf(x63, l[3], s3); } x53 = (lane == 53) ? 1.0f : -((s0 + s1) + (s2 + s3)); asm volatile("" : "+v"(x53) : : "memory"); }
    { float s0 = 0.f, s1 = 0.f, s2 = 0.f, s3 = 0.f; { const f32x4 l = *(const LAS f32x4*)(Lc + 3588); s1 = fmaf(x53, l[1], s1); s2 = fmaf(x54, l[2], s2); s3 = fmaf(x55, l[3], s3); } { const f32x4 l = *(const LAS f32x4*)(Lc + 3592); s0 = fmaf(x56, l[0], s0); s1 = fmaf(x57, l[1], s1); s2 = fmaf(x58, l[2], s2); s3 = fmaf(x59, l[3], s3); } { const f32x4 l = *(const LAS f32x4*)(Lc + 3596); s0 = fmaf(x60, l[0], s0); s1 = fmaf(x61, l[1], s1); s2 = fmaf(x62, l[2], s2); s3 = fmaf(x63, l[3], s3); } x52 = (lane == 52) ? 1.0f : -((s0 + s1) + (s2 + s3)); asm volatile("" : "+v"(x52) : : "memory"); }
    { float s0 = 0.f, s1 = 0.f, s2 = 0.f, s3 = 0.f; { const f32x4 l = *(const LAS f32x4*)(Lc + 3520); s0 = fmaf(x52, l[0], s0); s1 = fmaf(x53, l[1], s1); s2 = fmaf(x54, l[2], s2); s3 = fmaf(x55, l[3], s3); } { const f32x4 l = *(const LAS f32x4*)(Lc + 3524); s0 = fmaf(x56, l[0], s0); s1 = fmaf(x57, l[1], s1); s2 = fmaf(x58, l[2], s2); s3 = fmaf(x59, l[3], s3); } { const f32x4 l = *(const LAS f32x4*)(Lc + 3528); s0 = fmaf(x60, l[0], s0); s1 = fmaf(x61, l[1], s1); s2 = fmaf(x62, l[2], s2); s3 = fmaf(x63, l[3], s3); } x51 = (lane == 51) ? 1.0f : -((s0 + s1) + (s2 + s3)); asm volatile("" : "+v"(x51) : : "memory"); }
    { float s0 = 0.f, s1 = 0.f, s2 = 0.f, s3 = 0.f; { const f32x4 l = *(const LAS f32x4*)(Lc + 3448); s3 = fmaf(x51, l[3], s3); } { const f32x4 l = *(const LAS f32x4*)(Lc + 3452); s0 = fmaf(x52, l[0], s0); s1 = fmaf(x53, l[1], s1); s2 = fmaf(x54, l[2], s2); s3 = fmaf(x55, l[3], s3); } { const f32x4 l = *(const LAS f32x4*)(Lc + 3456); s0 = fmaf(x56, l[0], s0); s1 = fmaf(x57, l[1], s1); s2 = fmaf(x58, l[2], s2); s3 = fmaf(x59, l[3], s3); } { const f32x4 l = *(const LAS f32x4*)(Lc + 3460); s0 = fmaf(x60, l[0], s0); s1 = fmaf(x61, l[1], s1); s2 = fmaf(x62, l[2], s2); s3 = fmaf(x63, l[3], s3); } x50 = (lane == 50) ? 1.0f : -((s0 + s1) + (s2 + s3)); asm volatile("" : "+v"(x50) : : "memory"); }
    { float s0 = 0.f, s1 = 0.f, s2 = 0.f, s3 = 0.f; { const f32x4 l = *(const LAS f32x4*)(Lc + 3380); s2 = fmaf(x50, l[2], s2); s3 = fmaf(x51, l[3], s3); } { const f32x4 l = *(const LAS f32x4*)(Lc + 3384); s0 = fmaf(x52, l[0], s0); s1 = fmaf(x53, l[1], s1); s2 = fmaf(x54, l[2], s2); s3 = fmaf(x55, l[3], s3); } { const f32x4 l = *(const LAS f32x4*)(Lc + 3388); s0 = fmaf(x56, l[0], s0); s1 = fmaf(x57, l[1], s1); s2 = fmaf(x58, l[2], s2); s3 = fmaf(x59, l[3], s3); } { const f32x4 l = *(const LAS f32x4*)(Lc + 3392); s0 = fmaf(x60, l[0], s0); s1 = fmaf(x61, l[1], s1); s2 = fmaf(x62, l[2], s2); s3 = fmaf(x63, l[3], s3); } x49 = (lane == 49) ? 1.0f : -((s0 + s1) + (s2 + s3)); asm volatile("" : "+v"(x49) : : "memory"); }
    { float s0 = 0.f, s1 = 0.f, s2 = 0.f, s3 = 0.f; { const f32x4 l = *(const LAS f32x4*)(Lc + 3312); s1 = fmaf(x49, l[1], s1); s2 = fmaf(x50, l[2], s2); s3 = fmaf(x51, l[3], s3); } { const f32x4 l = *(const LAS f32x4*)(Lc + 3316); s0 = fmaf(x52, l[0], s0); s1 = fmaf(x53, l[1], s1); s2 = fmaf(x54, l[2], s2); s3 = fmaf(x55, l[3], s3); } { const f32x4 l = *(const LAS f32x4*)(Lc + 3320); s0 = fmaf(x56, l[0], s0); s1 = fmaf(x57, l[1], s1); s2 = fmaf(x58, l[2], s2); s3 = fmaf(x59, l[3], s3); } { const f32x4 l = *(const LAS f32x4*)(Lc + 3324); s0 = fmaf(x60, l[0], s0); s1 = fmaf(x61, l[1], s1); s2 = fmaf(x62, l[2], s2); s3 = fmaf(x63, l[3], s3); } x48 = (lane == 48) ? 1.0f : -((s0 + s1) + (s2 + s3)); asm volatile("" : "+v"(x48) : : "memory"); }
    { float s0 = 0.f, s1 = 0.f, s2 = 0.f, s3 = 0.f; { const f32x4 l = *(const LAS f32x4*)(Lc + 3244); s0 = fmaf(x48, l[0], s0); s1 = fmaf(x49, l[1], s1); s2 = fmaf(x50, l[2], s2); s3 = fmaf(x51, l[3], s3); } { const f32x4 l = *(const LAS f32x4*)(Lc + 3248); s0 = fmaf(x52, l[0], s0); s1 = fmaf(x53, l[1], s1); s2 = fmaf(x54, l[2], s2); s3 = fmaf(x55, l[3], s3); } { const f32x4 l = *(const LAS f32x4*)(Lc + 3252); s0 = fmaf(x56, l[0], s0); s1 = fmaf(x57, l[1], s1); s2 = fmaf(x58, l[2], s2); s3 = fmaf(x59, l[3], s3); } { const f32x4 l = *(const LAS f32x4*)(Lc + 3256); s0 = fmaf(x60, l[0], s0); s1 = fmaf(x61, l[1], s1); s2 = fmaf(x62, l[2], s2); s3 = fmaf(x63, l[3], s3); } x47 = (lane == 47) ? 1.0f : -((s0 + s1) + (s2 + s3)); asm volatile("" : "+v"(x47) : : "memory"); }
    { float s0 = 0.f, s1 = 0.f, s2 = 0.f, s3 = 0.f; { const f32x4 l = *(const LAS f32x4*)(Lc + 3172); s3 = fmaf(x47, l[3], s3); } { const f32x4 l = *(const LAS f32x4*)(Lc + 3176); s0 = fmaf(x48, l[0], s0); s1 = fmaf(x49, l[1], s1); s2 = fmaf(x50, l[2], s2); s3 = fmaf(x51, l[3], s3); } { const f32x4 l = *(const LAS f32x4*)(Lc + 3180); s0 = fmaf(x52, l[0], s0); s1 = fmaf(x53, l[1], s1); s2 = fmaf(x54, l[2], s2); s3 = fmaf(x55, l[3], s3); } { const f32x4 l = *(const LAS f32x4*)(Lc + 3184); s0 = fmaf(x56, l[0], s0); s1 = fmaf(x57, l[1], s1); s2 = fmaf(x58, l[2], s2); s3 = fmaf(x59, l[3], s3); } { const f32x4 l = *(const LAS f32x4*)(Lc + 3188); s0 = fmaf(x60, l[0], s0); s1 = fmaf(x61, l[1], s1); s2 = fmaf(x62, l[2], s2); s3 = fmaf(x63, l[3], s3); } x46 = (lane == 46) ? 1.0f : -((s0 + s1) + (s2 + s3)); asm volatile("" : "+v"(x46) : : "memory"); }
    { float s0 = 0.f, s1 = 0.f, s2 = 0.f, s3 = 0.f; { const f32x4 l = *(const LAS f32x4*)(Lc + 3104); s2 = fmaf(x46, l[2], s2); s3 = fmaf(x47, l[3], s3); } { const f32x4 l = *(const LAS f32x4*)(Lc + 3108); s0 = fmaf(x48, l[0], s0); s1 = fmaf(x49, l[1], s1); s2 = fmaf(x50, l[2], s2); s3 = fmaf(x51, l[3], s3); } { const f32x4 l = *(const LAS f32x4*)(Lc + 3112); s0 = fmaf(x52, l[0], s0); s1 = fmaf(x53, l[1], s1); s2 = fmaf(x54, l[2], s2); s3 = fmaf(x55, l[3], s3); } { const f32x4 l = *(const LAS f32x4*)(Lc + 3116); s0 = fmaf(x56, l[0], s0); s1 = fmaf(x57, l[1], s1); s2 = fmaf(x58, l[2], s2); s3 = fmaf(x59, l[3], s3); } { const f32x4 l = *(const LAS f32x4*)(Lc + 3120); s0 = fmaf(x60, l[0], s0); s1 = fmaf(x61, l[1], s1); s2 = fmaf(x62, l[2], s2); s3 = fmaf(x63, l[3], s3); } x45 = (lane == 45) ? 1.0f : -((s0 + s1) + (s2 + s3)); asm volatile("" : "+v"(x45) : : "memory"); }
    { float s0 = 0.f, s1 = 0.f, s2 = 0.f, s3 = 0.f; { const f32x4 l = *(const LAS f32x4*)(Lc + 3036); s1 = fmaf(x45, l[1], s1); s2 = fmaf(x46, l[2], s2); s3 = fmaf(x47, l[3], s3); } { const f32x4 l = *(const LAS f32x4*)(Lc + 3040); s0 = fmaf(x48, l[0], s0); s1 = fmaf(x49, l[1], s1); s2 = fmaf(x50, l[2], s2); s3 = fmaf(x51, l[3], s3); } { const f32x4 l = *(const LAS f32x4*)(Lc + 3044); s0 = fmaf(x52, l[0], s0); s1 = fmaf(x53, l[1], s1); s2 = fmaf(x54, l[2], s2); s3 = fmaf(x55, l[3], s3); } { const f32x4 l = *(const LAS f32x4*)(Lc + 3048); s0 = fmaf(x56, l[0], s0); s1 = fmaf(x57, l[1], s1); s2 = fmaf(x58, l[2], s2); s3 = fmaf(x59, l[3], s3); } { const f32x4 l = *(const LAS f32x4*)(Lc + 3052); s0 = fmaf(x60, l[0], s0); s1 = fmaf(x61, l[1], s1); s2 = fmaf(x62, l[2], s2); s3 = fmaf(x63, l[3], s3); } x44 = (lane == 44) ? 1.0f : -((s0 + s1) + (s2 + s3)); asm volatile("" : "+v"(x44) : : "memory"); }
    { float s0 = 0.f, s1 = 0.f, s2 = 0.f, s3 = 0.f; { const f32x4 l = *(const LAS f32x4*)(Lc + 2968); s0 = fmaf(x44, l[0], s0); s1 = fmaf(x45, l[1], s1); s2 = fmaf(x46, l[2], s2); s3 = fmaf(x47, l[3], s3); } { const f32x4 l = *(const LAS f32x4*)(Lc + 2972); s0 = fmaf(x48, l[0], s0); s1 = fmaf(x49, l[1], s1); s2 = fmaf(x50, l[2], s2); s3 = fmaf(x51, l[3], s3); } { const f32x4 l = *(const LAS f32x4*)(Lc + 2976); s0 = fmaf(x52, l[0], s0); s1 = fmaf(x53, l[1], s1); s2 = fmaf(x54, l[2], s2); s3 = fmaf(x55, l[3], s3); } { const f32x4 l = *(const LAS f32x4*)(Lc + 2980); s0 = fmaf(x56, l[0], s0); s1 = fmaf(x57, l[1], s1); s2 = fmaf(x58, l[2], s2); s3 = fmaf(x59, l[3], s3); } { const f32x4 l = *(const LAS f32x4*)(Lc + 2984); s0 = fmaf(x60, l[0], s0); s1 = fmaf(x61, l[1], s1); s2 = fmaf(x62, l[2], s2); s3 = fmaf(x63, l[3], s3); } x43 = (lane == 43) ? 1.0f : -((s0 + s1) + (s2 + s3)); asm volatile("" : "+v"(x43) : : "memory"); }
    { float s0 = 0.f, s1 = 0.f, s2 = 0.f, s3 = 0.f; { const f32x4 l = *(const LAS f32x4*)(Lc + 2896); s3 = fmaf(x43, l[3], s3); } { const f32x4 l = *(const LAS f32x4*)(Lc + 2900); s0 = fmaf(x44, l[0], s0); s1 = fmaf(x45, l[1], s1); s2 = fmaf(x46, l[2], s2); s3 = fmaf(x47, l[3], s3); } { const f32x4 l = *(const LAS f32x4*)(Lc + 2904); s0 = fmaf(x48, l[0], s0); s1 = fmaf(x49, l[1], s1); s2 = fmaf(x50, l[2], s2); s3 = fmaf(x51, l[3], s3); } { const f32x4 l = *(const LAS f32x4*)(Lc + 2908); s0 = fmaf(x52, l[0], s0); s1 = fmaf(x53, l[1], s1); s2 = fmaf(x54, l[2], s2); s3 = fmaf(x55, l[3], s3); } { const f32x4 l = *(const LAS f32x4*)(Lc + 2912); s0 = fmaf(x56, l[0], s0); s1 = fmaf(x57, l[1], s1); s2 = fmaf(x58, l[2], s2); s3 = fmaf(x59, l[3], s3); } { const f32x4 l = *(const LAS f32x4*)(Lc + 2916); s0 = fmaf(x60, l[0], s0); s1 = fmaf(x61, l[1], s1); s2 = fmaf(x62, l[2], s2); s3 = fmaf(x63, l[3], s3); } x42 = (lane == 42) ? 1.0f : -((s0 + s1) + (s2 + s3)); asm volatile("" : "+v"(x42) : : "memory"); }
    { float s0 = 0.f, s1 = 0.f, s2 = 0.f, s3 = 0.f; { const f32x4 l = *(const LAS f32x4*)(Lc + 2828); s2 = fmaf(x42, l[2], s2); s3 = fmaf(x43, l[3], s3); } { const f32x4 l = *(const LAS f32x4*)(Lc + 2832); s0 = fmaf(x44, l[0], s0); s1 = fmaf(x45, l[1], s1); s2 = fmaf(x46, l[2], s2); s3 = fmaf(x47, l[3], s3); } { const f32x4 l = *(const LAS f32x4*)(Lc + 2836); s0 = fmaf(x48, l[0], s0); s1 = fmaf(x49, l[1], s1); s2 = fmaf(x50, l[2], s2); s3 = fmaf(x51, l[3], s3); } { const f32x4 l = *(const LAS f32x4*)(Lc + 2840); s0 = fmaf(x52, l[0], s0); s1 = fmaf(x53, l[1], s1); s2 = fmaf(x54, l[2], s2); s3 = fmaf(x55, l[3], s3); } { const f32x4 l = *(const LAS f32x4*)(Lc + 2844); s0 = fmaf(x56, l[0], s0); s1 = fmaf(x57, l[1], s1); s2 = fmaf(x58, l[2], s2); s3 = fmaf(x59, l[3], s3); } { const f32x4 l = *(const LAS f32x4*)(Lc + 2848); s0 = fmaf(x60, l[0], s0); s1 = fmaf(x61, l[1], s1); s2 = fmaf(x62, l[2], s2); s3 = fmaf(x63, l[3], s3); } x41 = (lane == 41) ? 1.0f : -((s0 + s1) + (s2 + s3)); asm volatile("" : "+v"(x41) : : "memory"); }
    { float s0 = 0.f, s1 = 0.f, s2 = 0.f, s3 = 0.f; { const f32x4 l = *(const LAS f32x4*)(Lc + 2760); s1 = fmaf(x41, l[1], s1); s2 = fmaf(x42, l[2], s2); s3 = fmaf(x43, l[3], s3); } { const f32x4 l = *(const LAS f32x4*)(Lc + 2764); s0 = fmaf(x44, l[0], s0); s1 = fmaf(x45, l[1], s1); s2 = fmaf(x46, l[2], s2); s3 = fmaf(x47, l[3], s3); } { const f32x4 l = *(const LAS f32x4*)(Lc + 2768); s0 = fmaf(x48, l[0], s0); s1 = fmaf(x49, l[1], s1); s2 = fmaf(x50, l[2], s2); s3 = fmaf(x51, l[3], s3); } { const f32x4 l = *(const LAS f32x4*)(Lc + 2772); s0 = fmaf(x52, l[0], s0); s1 = fmaf(x53, l[1], s1); s2 = fmaf(x54, l[2], s2); s3 = fmaf(x55, l[3], s3); } { const f32x4 l = *(const LAS f32x4*)(Lc + 2776); s0 = fmaf(x56, l[0], s0); s1 = fmaf(x57, l[1], s1); s2 = fmaf(x58, l[2], s2); s3 = fmaf(x59, l[3], s3); } { const f32x4 l = *(const LAS f32x4*)(Lc + 2780); s0 = fmaf(x60, l[0], s0); s1 = fmaf(x61, l[1], s1); s2 = fmaf(x62, l[2], s2); s3 = fmaf(x63, l[3], s3); } x40 = (lane == 40) ? 1.0f : -((s0 + s1) + (s2 + s3)); asm volatile("" : "+v"(x40) : : "memory"); }
    { float s0 = 0.f, s1 = 0.f, s2 = 0.f, s3 = 0.f; { const f32x4 l = *(const LAS f32x4*)(Lc + 2692); s0 = fmaf(x40, l[0], s0); s1 = fmaf(x41, l[1], s1); s2 = fmaf(x42, l[2], s2); s3 = fmaf(x43, l[3], s3); } { const f32x4 l = *(const LAS f32x4*)(Lc + 2696); s0 = fmaf(x44, l[0], s0); s1 = fmaf(x45, l[1], s1); s2 = fmaf(x46, l[2], s2); s3 = fmaf(x47, l[3], s3); } { const f32x4 l = *(const LAS f32x4*)(Lc + 2700); s0 = fmaf(x48, l[0], s0); s1 = fmaf(x49, l[1], s1); s2 = fmaf(x50, l[2], s2); s3 = fmaf(x51, l[3], s3); } { const f32x4 l = *(const LAS f32x4*)(Lc + 2704); s0 = fmaf(x52, l[0], s0); s1 = fmaf(x53, l[1], s1); s2 = fmaf(x54, l[2], s2); s3 = fmaf(x55, l[3], s3); } { const f32x4 l = *(const LAS f32x4*)(Lc + 2708); s0 = fmaf(x56, l[0], s0); s1 = fmaf(x57, l[1], s1); s2 = fmaf(x58, l[2], s2); s3 = fmaf(x59, l[3], s3); } { const f32x4 l = *(const LAS f32x4*)(Lc + 2712); s0 = fmaf(x60, l[0], s0); s1 = fmaf(x61, l[1], s1); s2 = fmaf(x62, l[2], s2); s3 = fmaf(x63, l[3], s3); } x39 = (lane == 39) ? 1.0f : -((s0 + s1) + (s2 + s3)); asm volatile("" : "+v"(x39) : : "memory"); }
    { float s0 = 0.f, s1 = 0.f, s2 = 0.f, s3 = 0.f; { const f32x4 l = *(const LAS f32x4*)(Lc + 2620); s3 = fmaf(x39, l[3], s3); } { const f32x4 l = *(const LAS f32x4*)(Lc + 2624); s0 = fmaf(x40, l[0], s0); s1 = fmaf(x41, l[1], s1); s2 = fmaf(x42, l[2], s2); s3 = fmaf(x43, l[3], s3); } { const f32x4 l = *(const LAS f32x4*)(Lc + 2628); s0 = fmaf(x44, l[0], s0); s1 = fmaf(x45, l[1], s1); s2 = fmaf(x46, l[2], s2); s3 = fmaf(x47, l[3], s3); } { const f32x4 l = *(const LAS f32x4*)(Lc + 2632); s0 = fmaf(x48, l[0], s0); s1 = fmaf(x49, l[1], s1); s2 = fmaf(x50, l[2], s2); s3 = fmaf(x51, l[3], s3); } { const f32x4 l = *(const LAS f32x4*)(Lc + 2636); s0 = fmaf(x52, l[0], s0); s1 = fmaf(x53, l[1], s1); s2 = fmaf(x54, l[2], s2); s3 = fmaf(x55, l[3], s3); } { const f32x4 l = *(const LAS f32x4*)(Lc + 2640); s0 = fmaf(x56, l[0], s0); s1 = fmaf(x57, l[1], s1); s2 = fmaf(x58, l[2], s2); s3 = fmaf(x59, l[3], s3); } { const f32x4 l = *(const LAS f32x4*)(Lc + 2644); s0 = fmaf(x60, l[0], s0); s1 = fmaf(x61, l[1], s1); s2 = fmaf(x62, l[2], s2); s3 = fmaf(x63, l[3], s3); } x38 = (lane == 38) ? 1.0f : -((s0 + s1) + (s2 + s3)); asm volatile("" : "+v"(x38) : : "memory"); }
    { float s0 = 0.f, s1 = 0.f, s2 = 0.f, s3 = 0.f; { const f32x4 l = *(const LAS f32x4*)(Lc + 2552); s2 = fmaf(x38, l[2], s2); s3 = fmaf(x39, l[3], s3); } { const f32x4 l = *(const LAS f32x4*)(Lc + 2556); s0 = fmaf(x40, l[0], s0); s1 = fmaf(x41, l[1], s1); s2 = fmaf(x42, l[2], s2); s3 = fmaf(x43, l[3], s3); } { const f32x4 l = *(const LAS f32x4*)(Lc + 2560); s0 = fmaf(x44, l[0], s0); s1 = fmaf(x45, l[1], s1); s2 = fmaf(x46, l[2], s2); s3 = fmaf(x47, l[3], s3); } { const f32x4 l = *(const LAS f32x4*)(Lc + 2564); s0 = fmaf(x48, l[0], s0); s1 = fmaf(x49, l[1], s1); s2 = fmaf(x50, l[2], s2); s3 = fmaf(x51, l[3], s3); } { const f32x4 l = *(const LAS f32x4*)(Lc + 2568); s0 = fmaf(x52, l[0], s0); s1 = fmaf(x53, l[1], s1); s2 = fmaf(x54, l[2], s2); s3 = fmaf(x55, l[3], s3); } { const f32x4 l = *(const LAS f32x4*)(Lc + 2572); s0 = fmaf(x56, l[0], s0); s1 = fmaf(x57, l[1], s1); s2 = fmaf(x58, l[2], s2); s3 = fmaf(x59, l[3], s3); } { const f32x4 l = *(const LAS f32x4*)(Lc + 2576); s0 = fmaf(x60, l[0], s0); s1 = fmaf(x61, l[1], s1); s2 = fmaf(x62, l[2], s2); s3 = fmaf(x63, l[3], s3); } x37 = (lane == 37) ? 1.0f : -((s0 + s1) + (s2 + s3)); asm volatile("" : "+v"(x37) : : "memory"); }
    { float s0 = 0.f, s1 = 0.f, s2 = 0.f, s3 = 0.f; { const f32x4 l = *(const LAS f32x4*)(Lc + 2484); s1 = fmaf(x37, l[1], s1); s2 = fmaf(x38, l[2], s2); s3 = fmaf(x39, l[3], s3); } { const f32x4 l = *(const LAS f32x4*)(Lc + 2488); s0 = fmaf(x40, l[0], s0); s1 = fmaf(x41, l[1], s1); s2 = fmaf(x42, l[2], s2); s3 = fmaf(x43, l[3], s3); } { const f32x4 l = *(const LAS f32x4*)(Lc + 2492); s0 = fmaf(x44, l[0], s0); s1 = fmaf(x45, l[1], s1); s2 = fmaf(x46, l[2], s2); s3 = fmaf(x47, l[3], s3); } { const f32x4 l = *(const LAS f32x4*)(Lc + 2496); s0 = fmaf(x48, l[0], s0); s1 = fmaf(x49, l[1], s1); s2 = fmaf(x50, l[2], s2); s3 = fmaf(x51, l[3], s3); } { const f32x4 l = *(const LAS f32x4*)(Lc + 2500); s0 = fmaf(x52, l[0], s0); s1 = fmaf(x53, l[1], s1); s2 = fmaf(x54, l[2], s2); s3 = fmaf(x55, l[3], s3); } { const f32x4 l = *(const LAS f32x4*)(Lc + 2504); s0 = fmaf(x56, l[0], s0); s1 = fmaf(x57, l[1], s1); s2 = fmaf(x58, l[2], s2); s3 = fmaf(x59, l[3], s3); } { const f32x4 l = *(const LAS f32x4*)(Lc + 2508); s0 = fmaf(x60, l[0], s0); s1 = fmaf(x61, l[1], s1); s2 = fmaf(x62, l[2], s2); s3 = fmaf(x63, l[3], s3); } x36 = (lane == 36) ? 1.0f : -((s0 + s1) + (s2 + s3)); asm volatile("" : "+v"(x36) : : "memory"); }
    { float s0 = 0.f, s1 = 0.f, s2 = 0.f, s3 = 0.f; { const f32x4 l = *(const LAS f32x4*)(Lc + 2416); s0 = fmaf(x36, l[0], s0); s1 = fmaf(x37, l[1], s1); s2 = fmaf(x38, l[2], s2); s3 = fmaf(x39, l[3], s3); } { const f32x4 l = *(const LAS f32x4*)(Lc + 2420); s0 = fmaf(x40, l[0], s0); s1 = fmaf(x41, l[1], s1); s2 = fmaf(x42, l[2], s2); s3 = fmaf(x43, l[3], s3); } { const f32x4 l = *(const LAS f32x4*)(Lc + 2424); s0 = fmaf(x44, l[0], s0); s1 = fmaf(x45, l[1], s1); s2 = fmaf(x46, l[2], s2); s3 = fmaf(x47, l[3], s3); } { const f32x4 l = *(const LAS f32x4*)(Lc + 2428); s0 = fmaf(x48, l[0], s0); s1 = fmaf(x49, l[1], s1); s2 = fmaf(x50, l[2], s2); s3 = fmaf(x51, l[3], s3); } { const f32x4 l = *(const LAS f32x4*)(Lc + 2432); s0 = fmaf(x52, l[0], s0); s1 = fmaf(x53, l[1], s1); s2 = fmaf(x54, l[2], s2); s3 = fmaf(x55, l[3], s3); } { const f32x4 l = *(const LAS f32x4*)(Lc + 2436); s0 = fmaf(x56, l[0], s0); s1 = fmaf(x57, l[1], s1); s2 = fmaf(x58, l[2], s2); s3 = fmaf(x59, l[3], s3); } { const f32x4 l = *(const LAS f32x4*)(Lc + 2440); s0 = fmaf(x60, l[0], s0); s1 = fmaf(x61, l[1], s1); s2 = fmaf(x62, l[2], s2); s3 = fmaf(x63, l[3], s3); } x35 = (lane == 35) ? 1.0f : -((s0 + s1) + (s2 + s3)); asm volatile("" : "+v"(x35) : : "memory"); }
    { float s0 = 0.f, s1 = 0.f, s2 = 0.f, s3 = 0.f; { const f32x4 l = *(const LAS f32x4*)(Lc + 2344); s3 = fmaf(x35, l[3], s3); } { const f32x4 l = *(const LAS f32x4*)(Lc + 2348); s0 = fmaf(x36, l[0], s0); s1 = fmaf(x37, l[1], s1); s2 = fmaf(x38, l[2], s2); s3 = fmaf(x39, l[3], s3); } { const f32x4 l = *(const LAS f32x4*)(Lc + 2352); s0 = fmaf(x40, l[0], s0); s1 = fmaf(x41, l[1], s1); s2 = fmaf(x42, l[2], s2); s3 = fmaf(x43, l[3], s3); } { const f32x4 l = *(const LAS f32x4*)(Lc + 2356); s0 = fmaf(x44, l[0], s0); s1 = fmaf(x45, l[1], s1); s2 = fmaf(x46, l[2], s2); s3 = fmaf(x47, l[3], s3); } { const f32x4 l = *(const LAS f32x4*)(Lc + 2360); s0 = fmaf(x48, l[0], s0); s1 = fmaf(x49, l[1], s1); s2 = fmaf(x50, l[2], s2); s3 = fmaf(x51, l[3], s3); } { const f32x4 l = *(const LAS f32x4*)(Lc + 2364); s0 = fmaf(x52, l[0], s0); s1 = fmaf(x53, l[1], s1); s2 = fmaf(x54, l[2], s2); s3 = fmaf(x55, l[3], s3); } { const f32x4 l = *(const LAS f32x4*)(Lc + 2368); s0 = fmaf(x56, l[0], s0); s1 = fmaf(x57, l[1], s1); s2 = fmaf(x58, l[2], s2); s3 = fmaf(x59, l[3], s3); } { const f32x4 l = *(const LAS f32x4*)(Lc + 2372); s0 = fmaf(x60, l[0], s0); s1 = fmaf(x61, l[1], s1); s2 = fmaf(x62, l[2], s2); s3 = fmaf(x63, l[3], s3); } x34 = (lane == 34) ? 1.0f : -((s0 + s1) + (s2 + s3)); asm volatile("" : "+v"(x34) : : "memory"); }
    { float s0 = 0.f, s1 = 0.f, s2 = 0.f, s3 = 0.f; { const f32x4 l = *(const LAS f32x4*)(Lc + 2276); s2 = fmaf(x34, l[2], s2); s3 = fmaf(x35, l[3], s3); } { const f32x4 l = *(const LAS f32x4*)(Lc + 2280); s0 = fmaf(x36, l[0], s0); s1 = fmaf(x37, l[1], s1); s2 = fmaf(x38, l[2], s2); s3 = fmaf(x39, l[3], s3); } { const f32x4 l = *(const LAS f32x4*)(Lc + 2284); s0 = fmaf(x40, l[0], s0); s1 = fmaf(x41, l[1], s1); s2 = fmaf(x42, l[2], s2); s3 = fmaf(x43, l[3], s3); } { const f32x4 l = *(const LAS f32x4*)(Lc + 2288); s0 = fmaf(x44, l[0], s0); s1 = fmaf(x45, l[1], s1); s2 = fmaf(x46, l[2], s2); s3 = fmaf(x47, l[3], s3); } { const f32x4 l = *(const LAS f32x4*)(Lc + 2292); s0 = fmaf(x48, l[0], s0); s1 = fmaf(x49, l[1], s1); s2 = fmaf(x50, l[2], s2); s3 = fmaf(x51, l[3], s3); } { const f32x4 l = *(const LAS f32x4*)(Lc + 2296); s0 = fmaf(x52, l[0], s0); s1 = fmaf(x53, l[1], s1); s2 = fmaf(x54, l[2], s2); s3 = fmaf(x55, l[3], s3); } { const f32x4 l = *(const LAS f32x4*)(Lc + 2300); s0 = fmaf(x56, l[0], s0); s1 = fmaf(x57, l[1], s1); s2 = fmaf(x58, l[2], s2); s3 = fmaf(x59, l[3], s3); } { const f32x4 l = *(const LAS f32x4*)(Lc + 2304); s0 = fmaf(x60, l[0], s0); s1 = fmaf(x61, l[1], s1); s2 = fmaf(x62, l[2], s2); s3 = fmaf(x63, l[3], s3); } x33 = (lane == 33) ? 1.0f : -((s0 + s1) + (s2 + s3)); asm volatile("" : "+v"(x33) : : "memory"); }
    { float s0 = 0.f, s1 = 0.f, s2 = 0.f, s3 = 0.f; { const f32x4 l = *(const LAS f32x4*)(Lc + 2208); s1 = fmaf(x33, l[1], s1); s2 = fmaf(x34, l[2], s2); s3 = fmaf(x35, l[3], s3); } { const f32x4 l = *(const LAS f32x4*)(Lc + 2212); s0 = fmaf(x36, l[0], s0); s1 = fmaf(x37, l[1], s1); s2 = fmaf(x38, l[2], s2); s3 = fmaf(x39, l[3], s3); } { const f32x4 l = *(const LAS f32x4*)(Lc + 2216); s0 = fmaf(x40, l[0], s0); s1 = fmaf(x41, l[1], s1); s2 = fmaf(x42, l[2], s2); s3 = fmaf(x43, l[3], s3); } { const f32x4 l = *(const LAS f32x4*)(Lc + 2220); s0 = fmaf(x44, l[0], s0); s1 = fmaf(x45, l[1], s1); s2 = fmaf(x46, l[2], s2); s3 = fmaf(x47, l[3], s3); } { const f32x4 l = *(const LAS f32x4*)(Lc + 2224); s0 = fmaf(x48, l[0], s0); s1 = fmaf(x49, l[1], s1); s2 = fmaf(x50, l[2], s2); s3 = fmaf(x51, l[3], s3); } { const f32x4 l = *(const LAS f32x4*)(Lc + 2228); s0 = fmaf(x52, l[0], s0); s1 = fmaf(x53, l[1], s1); s2 = fmaf(x54, l[2], s2); s3 = fmaf(x55, l[3], s3); } { const f32x4 l = *(const LAS f32x4*)(Lc + 2232); s0 = fmaf(x56, l[0], s0); s1 = fmaf(x57, l[1], s1); s2 = fmaf(x58, l[2], s2); s3 = fmaf(x59, l[3], s3); } { const f32x4 l = *(const LAS f32x4*)(Lc + 2236); s0 = fmaf(x60, l[0], s0); s1 = fmaf(x61, l[1], s1); s2 = fmaf(x62, l[2], s2); s3 = fmaf(x63, l[3], s3); } x32 = (lane == 32) ? 1.0f : -((s0 + s1) + (s2 + s3)); asm volatile("" : "+v"(x32) : : "memory"); }
    { float s0 = 0.f, s1 = 0.f, s2 = 0.f, s3 = 0.f; { const f32x4 l = *(const LAS f32x4*)(Lc + 2140); s0 = fmaf(x32, l[0], s0); s1 = fmaf(x33, l[1], s1); s2 = fmaf(x34, l[2], s2); s3 = fmaf(x35, l[3], s3); } { const f32x4 l = *(const LAS f32x4*)(Lc + 2144); s0 = fmaf(x36, l[0], s0); s1 = fmaf(x37, l[1], s1); s2 = fmaf(x38, l[2], s2); s3 = fmaf(x39, l[3], s3); } { const f32x4 l = *(const LAS f32x4*)(Lc + 2148); s0 = fmaf(x40, l[0], s0); s1 = fmaf(x41, l[1], s1); s2 = fmaf(x42, l[2], s2); s3 = fmaf(x43, l[3], s3); } { const f32x4 l = *(const LAS f32x4*)(Lc + 2152); s0 = fmaf(x44, l[0], s0); s1 = fmaf(x45, l[1], s1); s2 = fmaf(x46, l[2], s2); s3 = fmaf(x47, l[3], s3); } { const f32x4 l = *(const LAS f32x4*)(Lc + 2156); s0 = fmaf(x48, l[0], s0); s1 = fmaf(x49, l[1], s1); s2 = fmaf(x50, l[2], s2); s3 = fmaf(x51, l[3], s3); } { const f32x4 l = *(const LAS f32x4*)(Lc + 2160); s0 = fmaf(x52, l[0], s0); s1 = fmaf(x53, l[1], s1); s2 = fmaf(x54, l[2], s2); s3 = fmaf(x55, l[3], s3); } { const f32x4 l = *(const LAS f32x4*)(Lc + 2164); s0 = fmaf(x56, l[0], s0); s1 = fmaf(x57, l[1], s1); s2 = fmaf(x58, l[2], s2); s3 = fmaf(x59, l[3], s3); } { const f32x4 l = *(const LAS f32x4*)(Lc + 2168); s0 = fmaf(x60, l[0], s0); s1 = fmaf(x61, l[1], s1); s2 = fmaf(x62, l[2], s2); s3 = fmaf(x63, l[3], s3); } x31 = (lane == 31) ? 1.0f : -((s0 + s1) + (s2 + s3)); asm volatile("" : "+v"(x31) : : "memory"); }
    { float s0 = 0.f, s1 = 0.f, s2 = 0.f, s3 = 0.f; { const f32x4 l = *(const LAS f32x4*)(Lc + 2068); s3 = fmaf(x31, l[3], s3); } { const f32x4 l = *(const LAS f32x4*)(Lc + 2072); s0 = fmaf(x32, l[0], s0); s1 = fmaf(x33, l[1], s1); s2 = fmaf(x34, l[2], s2); s3 = fmaf(x35, l[3], s3); } { const f32x4 l = *(const LAS f32x4*)(Lc + 2076); s0 = fmaf(x36, l[0], s0); s1 = fmaf(x37, l[1], s1); s2 = fmaf(x38, l[2], s2); s3 = fmaf(x39, l[3], s3); } { const f32x4 l = *(const LAS f32x4*)(Lc + 2080); s0 = fmaf(x40, l[0], s0); s1 = fmaf(x41, l[1], s1); s2 = fmaf(x42, l[2], s2); s3 = fmaf(x43, l[3], s3); } { const f32x4 l = *(const LAS f32x4*)(Lc + 2084); s0 = fmaf(x44, l[0], s0); s1 = fmaf(x45, l[1], s1); s2 = fmaf(x46, l[2], s2); s3 = fmaf(x47, l[3], s3); } { const f32x4 l = *(const LAS f32x4*)(Lc + 2088); s0 = fmaf(x48, l[0], s0); s1 = fmaf(x49, l[1], s1); s2 = fmaf(x50, l[2], s2); s3 = fmaf(x51, l[3], s3); } { const f32x4 l = *(const LAS f32x4*)(Lc + 2092); s0 = fmaf(x52, l[0], s0); s1 = fmaf(x53, l[1], s1); s2 = fmaf(x54, l[2], s2); s3 = fmaf(x55, l[3], s3); } { const f32x4 l = *(const LAS f32x4*)(Lc + 2096); s0 = fmaf(x56, l[0], s0); s1 = fmaf(x57, l[1], s1); s2 = fmaf(x58, l[2], s2); s3 = fmaf(x59, l[3], s3); } { const f32x4 l = *(const LAS f32x4*)(Lc + 2100); s0 = fmaf(x60, l[0], s0); s1 = fmaf(x61, l[1], s1); s2 = fmaf(x62, l[2], s2); s3 = fmaf(x63, l[3], s3); } x30 = (lane == 30) ? 1.0f : -((s0 + s1) + (s2 + s3)); asm volatile("" : "+v"(x30) : : "memory"); }
    { float s0 = 0.f, s1 = 0.f, s2 = 0.f, s3 = 0.f; { const f32x4 l = *(const LAS f32x4*)(Lc + 2000); s2 = fmaf(x30, l[2], s2); s3 = fmaf(x31, l[3], s3); } { const f32x4 l = *(const LAS f32x4*)(Lc + 2004); s0 = fmaf(x32, l[0], s0); s1 = fmaf(x33, l[1], s1); s2 = fmaf(x34, l[2], s2); s3 = fmaf(x35, l[3], s3); } { const f32x4 l = *(const LAS f32x4*)(Lc + 2008); s0 = fmaf(x36, l[0], s0); s1 = fmaf(x37, l[1], s1); s2 = fmaf(x38, l[2], s2); s3 = fmaf(x39, l[3], s3); } { const f32x4 l = *(const LAS f32x4*)(Lc + 2012); s0 = fmaf(x40, l[0], s0); s1 = fmaf(x41, l[1], s1); s2 = fmaf(x42, l[2], s2); s3 = fmaf(x43, l[3], s3); } { const f32x4 l = *(const LAS f32x4*)(Lc + 2016); s0 = fmaf(x44, l[0], s0); s1 = fmaf(x45, l[1], s1); s2 = fmaf(x46, l[2], s2); s3 = fmaf(x47, l[3], s3); } { const f32x4 l = *(const LAS f32x4*)(Lc + 2020); s0 = fmaf(x48, l[0], s0); s1 = fmaf(x49, l[1], s1); s2 = fmaf(x50, l[2], s2); s3 = fmaf(x51, l[3], s3); } { const f32x4 l = *(const LAS f32x4*)(Lc + 2024); s0 = fmaf(x52, l[0], s0); s1 = fmaf(x53, l[1], s1); s2 = fmaf(x54, l[2], s2); s3 = fmaf(x55, l[3], s3); } { const f32x4 l = *(const LAS f32x4*)(Lc + 2028); s0 = fmaf(x56, l[0], s0); s1 = fmaf(x57, l[1], s1); s2 = fmaf(x58, l[2], s2); s3 = fmaf(x59, l[3], s3); } { const f32x4 l = *(const LAS f32x4*)(Lc + 2032); s0 = fmaf(x60, l[0], s0); s1 = fmaf(x61, l[1], s1); s2 = fmaf(x62, l[2], s2); s3 = fmaf(x63, l[3], s3); } x29 = (lane == 29) ? 1.0f : -((s0 + s1) + (s2 + s3)); asm volatile("" : "+v"(x29) : : "memory"); }
    { float s0 = 0.f, s1 = 0.f, s2 = 0.f, s3 = 0.f; { const f32x4 l = *(const LAS f32x4*)(Lc + 1932); s1 = fmaf(x29, l[1], s1); s2 = fmaf(x30, l[2], s2); s3 = fmaf(x31, l[3], s3); } { const f32x4 l = *(const LAS f32x4*)(Lc + 1936); s0 = fmaf(x32, l[0], s0); s1 = fmaf(x33, l[1], s1); s2 = fmaf(x34, l[2], s2); s3 = fmaf(x35, l[3], s3); } { const f32x4 l = *(const LAS f32x4*)(Lc + 1940); s0 = fmaf(x36, l[0], s0); s1 = fmaf(x37, l[1], s1); s2 = fmaf(x38, l[2], s2); s3 = fmaf(x39, l[3], s3); } { const f32x4 l = *(const LAS f32x4*)(Lc + 1944); s0 = fmaf(x40, l[0], s0); s1 = fmaf(x41, l[1], s1); s2 = fmaf(x42, l[2], s2); s3 = fmaf(x43, l[3], s3); } { const f32x4 l = *(const LAS f32x4*)(Lc + 1948); s0 = fmaf(x44, l[0], s0); s1 = fmaf(x45, l[1], s1); s2 = fmaf(x46, l[2], s2); s3 = fmaf(x47, l[3], s3); } { const f32x4 l = *(const LAS f32x4*)(Lc + 1952); s0 = fmaf(x48, l[0], s0); s1 = fmaf(x49, l[1], s1); s2 = fmaf(x50, l[2], s2); s3 = fmaf(x51, l[3], s3); } { const f32x4 l = *(const LAS f32x4*)(Lc + 1956); s0 = fmaf(x52, l[0], s0); s1 = fmaf(x53, l[1], s1); s2 = fmaf(x54, l[2], s2); s3 = fmaf(x55, l[3], s3); } { const f32x4 l = *(const LAS f32x4*)(Lc + 1960); s0 = fmaf(x56, l[0], s0); s1 = fmaf(x57, l[1], s1); s2 = fmaf(x58, l[2], s2); s3 = fmaf(x59, l[3], s3); } { const f32x4 l = *(const LAS f32x4*)(Lc + 1964); s0 = fmaf(x60, l[0], s0); s1 = fmaf(x61, l[1], s1); s2 = fmaf(x62, l[2], s2); s3 = fmaf(x63, l[3], s3); } x28 = (lane == 28) ? 1.0f : -((s0 + s1) + (s2 + s3)); asm volatile("" : "+v"(x28) : : "memory"); }
    { float s0 = 0.f, s1 = 0.f, s2 = 0.f, s3 = 0.f; { const f32x4 l = *(const LAS f32x4*)(Lc + 1864); s0 = fmaf(x28, l[0], s0); s1 = fmaf(x29, l[1], s1); s2 = fmaf(x30, l[2], s2); s3 = fmaf(x31, l[3], s3); } { const f32x4 l = *(const LAS f32x4*)(Lc + 1868); s0 = fmaf(x32, l[0], s0); s1 = fmaf(x33, l[1], s1); s2 = fmaf(x34, l[2], s2); s3 = fmaf(x35, l[3], s3); } { const f32x4 l = *(const LAS f32x4*)(Lc + 1872); s0 = fmaf(x36, l[0], s0); s1 = fmaf(x37, l[1], s1); s2 = fmaf(x38, l[2], s2); s3 = fmaf(x39, l[3], s3); } { const f32x4 l = *(const LAS f32x4*)(Lc + 1876); s0 = fmaf(x40, l[0], s0); s1 = fmaf(x41, l[1], s1); s2 = fmaf(x42, l[2], s2); s3 = fmaf(x43, l[3], s3); } { const f32x4 l = *(const LAS f32x4*)(Lc + 1880); s0 = fmaf(x44, l[0], s0); s1 = fmaf(x45, l[1], s1); s2 = fmaf(x46, l[2], s2); s3 = fmaf(x47, l[3], s3); } { const f32x4 l = *(const LAS f32x4*)(Lc + 1884); s0 = fmaf(x48, l[0], s0); s1 = fmaf(x49, l[1], s1); s2 = fmaf(x50, l[2], s2); s3 = fmaf(x51, l[3], s3); } { const f32x4 l = *(const LAS f32x4*)(Lc + 1888); s0 = fmaf(x52, l[0], s0); s1 = fmaf(x53, l[1], s1); s2 = fmaf(x54, l[2], s2); s3 = fmaf(x55, l[3], s3); } { const f32x4 l = *(const LAS f32x4*)(Lc + 1892); s0 = fmaf(x56, l[0], s0); s1 = fmaf(x57, l[1], s1); s2 = fmaf(x58, l[2], s2); s3 = fmaf(x59, l[3], s3); } { const f32x4 l = *(const LAS f32x4*)(Lc + 1896); s0 = fmaf(x60, l[0], s0); s1 = fmaf(x61, l[1], s1); s2 = fmaf(x62, l[2], s2); s3 = fmaf(x63, l[3], s3); } x27 = (lane == 27) ? 1.0f : -((s0 + s1) + (s2 + s3)); asm volatile("" : "+v"(x27) : : "memory"); }
    { float s0 = 0.f, s1 = 0.f, s2 = 0.f, s3 = 0.f; { const f32x4 l = *(const LAS f32x4*)(Lc + 1792); s3 = fmaf(x27, l[3], s3); } { const f32x4 l = *(const LAS f32x4*)(Lc + 1796); s0 = fmaf(x28, l[0], s0); s1 = fmaf(x29, l[1], s1); s2 = fmaf(x30, l[2], s2); s3 = fmaf(x31, l[3], s3); } { const f32x4 l = *(const LAS f32x4*)(Lc + 1800); s0 = fmaf(x32, l[0], s0); s1 = fmaf(x33, l[1], s1); s2 = fmaf(x34, l[2], s2); s3 = fmaf(x35, l[3], s3); } { const f32x4 l = *(const LAS f32x4*)(Lc + 1804); s0 = fmaf(x36, l[0], s0); s1 = fmaf(x37, l[1], s1); s2 = fmaf(x38, l[2], s2); s3 = fmaf(x39, l[3], s3); } { const f32x4 l = *(const LAS f32x4*)(Lc + 1808); s0 = fmaf(x40, l[0], s0); s1 = fmaf(x41, l[1], s1); s2 = fmaf(x42, l[2], s2); s3 = fmaf(x43, l[3], s3); } { const f32x4 l = *(const LAS f32x4*)(Lc + 1812); s0 = fmaf(x44, l[0], s0); s1 = fmaf(x45, l[1], s1); s2 = fmaf(x46, l[2], s2); s3 = fmaf(x47, l[3], s3); } { const f32x4 l = *(const LAS f32x4*)(Lc + 1816); s0 = fmaf(x48, l[0], s0); s1 = fmaf(x49, l[1], s1); s2 = fmaf(x50, l[2], s2); s3 = fmaf(x51, l[3], s3); } { const f32x4 l = *(const LAS f32x4*)(Lc + 1820); s0 = fmaf(x52, l[0], s0); s1 = fmaf(x53, l[1], s1); s2 = fmaf(x54, l[2], s2); s3 = fmaf(x55, l[3], s3); } { const f32x4 l = *(const LAS f32x4*)(Lc + 1824); s0 = fmaf(x56, l[0], s0); s1 = fmaf(x57, l[1], s1); s2 = fmaf(x58, l[2], s2); s3 = fmaf(x59, l[3], s3); } { const f32x4 l = *(const LAS f32x4*)(Lc + 1828); s0 = fmaf(x60, l[0], s0); s1 = fmaf(x61, l[1], s1); s2 = fmaf(x62, l[2], s2); s3 = fmaf(x63, l[3], s3); } x26 = (lane == 26) ? 1.0f : -((s0 + s1) + (s2 + s3)); asm volatile("" : "+v"(x26) : : "memory"); }
    { float s0 = 0.f, s1 = 0.f, s2 = 0.f, s3 = 0.f; { const f32x4 l = *(const LAS f32x4*)(Lc + 1724); s2 = fmaf(x26, l[2], s2); s3 = fmaf(x27, l[3], s3); } { const f32x4 l = *(const LAS f32x4*)(Lc + 1728); s0 = fmaf(x28, l[0], s0); s1 = fmaf(x29, l[1], s1); s2 = fmaf(x30, l[2], s2); s3 = fmaf(x31, l[3], s3); } { const f32x4 l = *(const LAS f32x4*)(Lc + 1732); s0 = fmaf(x32, l[0], s0); s1 = fmaf(x33, l[1], s1); s2 = fmaf(x34, l[2], s2); s3 = fmaf(x35, l[3], s3); } { const f32x4 l = *(const LAS f32x4*)(Lc + 1736); s0 = fmaf(x36, l[0], s0); s1 = fmaf(x37, l[1], s1); s2 = fmaf(x38, l[2], s2); s3 = fmaf(x39, l[3], s3); } { const f32x4 l = *(const LAS f32x4*)(Lc + 1740); s0 = fmaf(x40, l[0], s0); s1 = fmaf(x41, l[1], s1); s2 = fmaf(x42, l[2], s2); s3 = fmaf(x43, l[3], s3); } { const f32x4 l = *(const LAS f32x4*)(Lc + 1744); s0 = fmaf(x44, l[0], s0); s1 = fmaf(x45, l[1], s1); s2 = fmaf(x46, l[2], s2); s3 = fmaf(x47, l[3], s3); } { const f32x4 l = *(const LAS f32x4*)(Lc + 1748); s0 = fmaf(x48, l[0], s0); s1 = fmaf(x49, l[1], s1); s2 = fmaf(x50, l[2], s2); s3 = fmaf(x51, l[3], s3); } { const f32x4 l = *(const LAS f32x4*)(Lc + 1752); s0 = fmaf(x52, l[0], s0); s1 = fmaf(x53, l[1], s1); s2 = fmaf(x54, l[2], s2); s3 = fmaf(x55, l[3], s3); } { const f32x4 l = *(const LAS f32x4*)(Lc + 1756); s0 = fmaf(x56, l[0], s0); s1 = fmaf(x57, l[1], s1); s2 = fmaf(x58, l[2], s2); s3 = fmaf(x59, l[3], s3); } { const f32x4 l = *(const LAS f32x4*)(Lc + 1760); s0 = fmaf(x60, l[0], s0); s1 = fmaf(x61, l[1], s1); s2 = fmaf(x62, l[2], s2); s3 = fmaf(x63, l[3], s3); } x25 = (lane == 25) ? 1.0f : -((s0 + s1) + (s2 + s3)); asm volatile("" : "+v"(x25) : : "memory"); }
    { float s0 = 0.f, s1 = 0.f, s2 = 0.f, s3 = 0.f; { const f32x4 l = *(const LAS f32x4*)(Lc + 1656); s1 = fmaf(x25, l[1], s1); s2 = fmaf(x26, l[2], s2); s3 = fmaf(x27, l[3], s3); } { const f32x4 l = *(const LAS f32x4*)(Lc + 1660); s0 = fmaf(x28, l[0], s0); s1 = fmaf(x29, l[1], s1); s2 = fmaf(x30, l[2], s2); s3 = fmaf(x31, l[3], s3); } { const f32x4 l = *(const LAS f32x4*)(Lc + 1664); s0 = fmaf(x32, l[0], s0); s1 = fmaf(x33, l[1], s1); s2 = fmaf(x34, l[2], s2); s3 = fmaf(x35, l[3], s3); } { const f32x4 l = *(const LAS f32x4*)(Lc + 1668); s0 = fmaf(x36, l[0], s0); s1 = fmaf(x37, l[1], s1); s2 = fmaf(x38, l[2], s2); s3 = fmaf(x39, l[3], s3); } { const f32x4 l = *(const LAS f32x4*)(Lc + 1672); s0 = fmaf(x40, l[0], s0); s1 = fmaf(x41, l[1], s1); s2 = fmaf(x42, l[2], s2); s3 = fmaf(x43, l[3], s3); } { const f32x4 l = *(const LAS f32x4*)(Lc + 1676); s0 = fmaf(x44, l[0], s0); s1 = fmaf(x45, l[1], s1); s2 = fmaf(x46, l[2], s2); s3 = fmaf(x47, l[3], s3); } { const f32x4 l = *(const LAS f32x4*)(Lc + 1680); s0 = fmaf(x48, l[0], s0); s1 = fmaf(x49, l[1], s1); s2 = fmaf(x50, l[2], s2); s3 = fmaf(x51, l[3], s3); } { const f32x4 l = *(const LAS f32x4*)(Lc + 1684); s0 = fmaf(x52, l[0], s0); s1 = fmaf(x53, l[1], s1); s2 = fmaf(x54, l[2], s2); s3 = fmaf(x55, l[3], s3); } { const f32x4 l = *(const LAS f32x4*)(Lc + 1688); s0 = fmaf(x56, l[0], s0); s1 = fmaf(x57, l[1], s1); s2 = fmaf(x58, l[2], s2); s3 = fmaf(x59, l[3], s3); } { const f32x4 l = *(const LAS f32x4*)(Lc + 1692); s0 = fmaf(x60, l[0], s0); s1 = fmaf(x61, l[1], s1); s2 = fmaf(x62, l[2], s2); s3 = fmaf(x63, l[3], s3); } x24 = (lane == 24) ? 1.0f : -((s0 + s1) + (s2 + s3)); asm volatile("" : "+v"(x24) : : "memory"); }
    { float s0 = 0.f, s1 = 0.f, s2 = 0.f, s3 = 0.f; { const f32x4 l = *(const LAS f32x4*)(Lc + 1588); s0 = fmaf(x24, l[0], s0); s1 = fmaf(x25, l[1], s1); s2 = fmaf(x26, l[2], s2); s3 = fmaf(x27, l[3], s3); } { const f32x4 l = *(const LAS f32x4*)(Lc + 1592); s0 = fmaf(x28, l[0], s0); s1 = fmaf(x29, l[1], s1); s2 = fmaf(x30, l[2], s2); s3 = fmaf(x31, l[3], s3); } { const f32x4 l = *(const LAS f32x4*)(Lc + 1596); s0 = fmaf(x32, l[0], s0); s1 = fmaf(x33, l[1], s1); s2 = fmaf(x34, l[2], s2); s3 = fmaf(x35, l[3], s3); } { const f32x4 l = *(const LAS f32x4*)(Lc + 1600); s0 = fmaf(x36, l[0], s0); s1 = fmaf(x37, l[1], s1); s2 = fmaf(x38, l[2], s2); s3 = fmaf(x39, l[3], s3); } { const f32x4 l = *(const LAS f32x4*)(Lc + 1604); s0 = fmaf(x40, l[0], s0); s1 = fmaf(x41, l[1], s1); s2 = fmaf(x42, l[2], s2); s3 = fmaf(x43, l[3], s3); } { const f32x4 l = *(const LAS f32x4*)(Lc + 1608); s0 = fmaf(x44, l[0], s0); s1 = fmaf(x45, l[1], s1); s2 = fmaf(x46, l[2], s2); s3 = fmaf(x47, l[3], s3); } { const f32x4 l = *(const LAS f32x4*)(Lc + 1612); s0 = fmaf(x48, l[0], s0); s1 = fmaf(x49, l[1], s1); s2 = fmaf(x50, l[2], s2); s3 = fmaf(x51, l[3], s3); } { const f32x4 l = *(const LAS f32x4*)(Lc + 1616); s0 = fmaf(x52, l[0], s0); s1 = fmaf(x53, l[1], s1); s2 = fmaf(x54, l[2], s2); s3 = fmaf(x55, l[3], s3); } { const f32x4 l = *(const LAS f32x4*)(Lc + 1620); s0 = fmaf(x56, l[0], s0); s1 = fmaf(x57, l[1], s1); s2 = fmaf(x58, l[2], s2); s3 = fmaf(x59, l[3], s3); } { const f32x4 l = *(const LAS f32x4*)(Lc + 1624); s0 = fmaf(x60, l[0], s0); s1 = fmaf(x61, l[1], s1); s2 = fmaf(x62, l[2], s2); s3 = fmaf(x63, l[3], s3); } x23 = (lane == 23) ? 1.0f : -((s0 + s1) + (s2 + s3)); asm volatile("" : "+v"(x23) : : "memory"); }
    { float s0 = 0.f, s1 = 0.f, s2 = 0.f, s3 = 0.f; { const f32x4 l = *(const LAS f32x4*)(Lc + 1516); s3 = fmaf(x23, l[3], s3); } { const f32x4 l = *(const LAS f32x4*)(Lc + 1520); s0 = fmaf(x24, l[0], s0); s1 = fmaf(x25, l[1], s1); s2 = fmaf(x26, l[2], s2); s3 = fmaf(x27, l[3], s3); } { const f32x4 l = *(const LAS f32x4*)(Lc + 1524); s0 = fmaf(x28, l[0], s0); s1 = fmaf(x29, l[1], s1); s2 = fmaf(x30, l[2], s2); s3 = fmaf(x31, l[3], s3); } { const f32x4 l = *(const LAS f32x4*)(Lc + 1528); s0 = fmaf(x32, l[0], s0); s1 = fmaf(x33, l[1], s1); s2 = fmaf(x34, l[2], s2); s3 = fmaf(x35, l[3], s3); } { const f32x4 l = *(const LAS f32x4*)(Lc + 1532); s0 = fmaf(x36, l[0], s0); s1 = fmaf(x37, l[1], s1); s2 = fmaf(x38, l[2], s2); s3 = fmaf(x39, l[3], s3); } { const f32x4 l = *(const LAS f32x4*)(Lc + 1536); s0 = fmaf(x40, l[0], s0); s1 = fmaf(x41, l[1], s1); s2 = fmaf(x42, l[2], s2); s3 = fmaf(x43, l[3], s3); } { const f32x4 l = *(const LAS f32x4*)(Lc + 1540); s0 = fmaf(x44, l[0], s0); s1 = fmaf(x45, l[1], s1); s2 = fmaf(x46, l[2], s2); s3 = fmaf(x47, l[3], s3); } { const f32x4 l = *(const LAS f32x4*)(Lc + 1544); s0 = fmaf(x48, l[0], s0); s1 = fmaf(x49, l[1], s1); s2 = fmaf(x50, l[2], s2); s3 = fmaf(x51, l[3], s3); } { const f32x4 l = *(const LAS f32x4*)(Lc + 1548); s0 = fmaf(x52, l[0], s0); s1 = fmaf(x53, l[1], s1); s2 = fmaf(x54, l[2], s2); s3 = fmaf(x55, l[3], s3); } { const f32x4 l = *(const LAS f32x4*)(Lc + 1552); s0 = fmaf(x56, l[0], s0); s1 = fmaf(x57, l[1], s1); s2 = fmaf(x58, l[2], s2); s3 = fmaf(x59, l[3], s3); } { const f32x4 l = *(const LAS f32x4*)(Lc + 1556); s0 = fmaf(x60, l[0], s0); s1 = fmaf(x61, l[1], s1); s2 = fmaf(x62, l[2], s2); s3 = fmaf(x63, l[3], s3); } x22 = (lane == 22) ? 1.0f : -((s0 + s1) + (s2 + s3)); asm volatile("" : "+v"(x22) : : "memory"); }
    { float s0 = 0.f, s1 = 0.f, s2 = 0.f, s3 = 0.f; { const f32x4 l = *(const LAS f32x4*)(Lc + 1448); s2 = fmaf(x22, l[2], s2); s3 = fmaf(x23, l[3], s3); } { const f32x4 l = *(const LAS f32x4*)(Lc + 1452); s0 = fmaf(x24, l[0], s0); s1 = fmaf(x25, l[1], s1); s2 = fmaf(x26, l[2], s2); s3 = fmaf(x27, l[3], s3); } { const f32x4 l = *(const LAS f32x4*)(Lc + 1456); s0 = fmaf(x28, l[0], s0); s1 = fmaf(x29, l[1], s1); s2 = fmaf(x30, l[2], s2); s3 = fmaf(x31, l[3], s3); } { const f32x4 l = *(const LAS f32x4*)(Lc + 1460); s0 = fmaf(x32, l[0], s0); s1 = fmaf(x33, l[1], s1); s2 = fmaf(x34, l[2], s2); s3 = fmaf(x35, l[3], s3); } { const f32x4 l = *(const LAS f32x4*)(Lc + 1464); s0 = fmaf(x36, l[0], s0); s1 = fmaf(x37, l[1], s1); s2 = fmaf(x38, l[2], s2); s3 = fmaf(x39, l[3], s3); } { const f32x4 l = *(const LAS f32x4*)(Lc + 1468); s0 = fmaf(x40, l[0], s0); s1 = fmaf(x41, l[1], s1); s2 = fmaf(x42, l[2], s2); s3 = fmaf(x43, l[3], s3); } { const f32x4 l = *(const LAS f32x4*)(Lc + 1472); s0 = fmaf(x44, l[0], s0); s1 = fmaf(x45, l[1], s1); s2 = fmaf(x46, l[2], s2); s3 = fmaf(x47, l[3], s3); } { const f32x4 l = *(const LAS f32x4*)(Lc + 1476); s0 = fmaf(x48, l[0], s0); s1 = fmaf(x49, l[1], s1); s2 = fmaf(x50, l[2], s2); s3 = fmaf(x51, l[3], s3); } { const f32x4 l = *(const LAS f32x4*)(Lc + 1480); s0 = fmaf(x52, l[0], s0); s1 = fmaf(x53, l[1], s1); s2 = fmaf(x54, l[2], s2); s3 = fmaf(x55, l[3], s3); } { const f32x4 l = *(const LAS f32x4*)(Lc + 1484); s0 = fmaf(x56, l[0], s0); s1 = fmaf(x57, l[1], s1); s2 = fmaf(x58, l[2], s2); s3 = fmaf(x59, l[3], s3); } { const f32x4 l = *(const LAS f32x4*)(Lc + 1488); s0 = fmaf(x60, l[0], s0); s1 = fmaf(x61, l[1], s1); s2 = fmaf(x62, l[2], s2); s3 = fmaf(x63, l[3], s3); } x21 = (lane == 21) ? 1.0f : -((s0 + s1) + (s2 + s3)); asm volatile("" : "+v"(x21) : : "memory"); }
    { float s0 = 0.f, s1 = 0.f, s2 = 0.f, s3 = 0.f; { const f32x4 l = *(const LAS f32x4*)(Lc + 1380); s1 = fmaf(x21, l[1], s1); s2 = fmaf(x22, l[2], s2); s3 = fmaf(x23, l[3], s3); } { const f32x4 l = *(const LAS f32x4*)(Lc + 1384); s0 = fmaf(x24, l[0], s0); s1 = fmaf(x25, l[1], s1); s2 = fmaf(x26, l[2], s2); s3 = fmaf(x27, l[3], s3); } { const f32x4 l = *(const LAS f32x4*)(Lc + 1388); s0 = fmaf(x28, l[0], s0); s1 = fmaf(x29, l[1], s1); s2 = fmaf(x30, l[2], s2); s3 = fmaf(x31, l[3], s3); } { const f32x4 l = *(const LAS f32x4*)(Lc + 1392); s0 = fmaf(x32, l[0], s0); s1 = fmaf(x33, l[1], s1); s2 = fmaf(x34, l[2], s2); s3 = fmaf(x35, l[3], s3); } { const f32x4 l = *(const LAS f32x4*)(Lc + 1396); s0 = fmaf(x36, l[0], s0); s1 = fmaf(x37, l[1], s1); s2 = fmaf(x38, l[2], s2); s3 = fmaf(x39, l[3], s3); } { const f32x4 l = *(const LAS f32x4*)(Lc + 1400); s0 = fmaf(x40, l[0], s0); s1 = fmaf(x41, l[1], s1); s2 = fmaf(x42, l[2], s2); s3 = fmaf(x43, l[3], s3); } { const f32x4 l = *(const LAS f32x4*)(Lc + 1404); s0 = fmaf(x44, l[0], s0); s1 = fmaf(x45, l[1], s1); s2 = fmaf(x46, l[2], s2); s3 = fmaf(x47, l[3], s3); } { const f32x4 l = *(const LAS f32x4*)(Lc + 1408); s0 = fmaf(x48, l[0], s0); s1 = fmaf(x49, l[1], s1); s2 = fmaf(x50, l[2], s2); s3 = fmaf(x51, l[3], s3); } { const f32x4 l = *(const LAS f32x4*)(Lc + 1412); s0 = fmaf(x52, l[0], s0); s1 = fmaf(x53, l[1], s1); s2 = fmaf(x54, l[2], s2); s3 = fmaf(x55, l[3], s3); } { const f32x4 l = *(const LAS f32x4*)(Lc + 1416); s0 = fmaf(x56, l[0], s0); s1 = fmaf(x57, l[1], s1); s2 = fmaf(x58, l[2], s2); s3 = fmaf(x59, l[3], s3); } { const f32x4 l = *(const LAS f32x4*)(Lc + 1420); s0 = fmaf(x60, l[0], s0); s1 = fmaf(x61, l[1], s1); s2 = fmaf(x62, l[2], s2); s3 = fmaf(x63, l[3], s3); } x20 = (lane == 20) ? 1.0f : -((s0 + s1) + (s2 + s3)); asm volatile("" : "+v"(x20) : : "memory"); }
    { float s0 = 0.f, s1 = 0.f, s2 = 0.f, s3 = 0.f; { const f32x4 l = *(const LAS f32x4*)(Lc + 1312); s0 = fmaf(x20, l[0], s0); s1 = fmaf(x21, l[1], s1); s2 = fmaf(x22, l[2], s2); s3 = fmaf(x23, l[3], s3); } { const f32x4 l = *(const LAS f32x4*)(Lc + 1316); s0 = fmaf(x24, l[0], s0); s1 = fmaf(x25, l[1], s1); s2 = fmaf(x26, l[2], s2); s3 = fmaf(x27, l[3], s3); } { const f32x4 l = *(const LAS f32x4*)(Lc + 1320); s0 = fmaf(x28, l[0], s0); s1 = fmaf(x29, l[1], s1); s2 = fmaf(x30, l[2], s2); s3 = fmaf(x31, l[3], s3); } { const f32x4 l = *(const LAS f32x4*)(Lc + 1324); s0 = fmaf(x32, l[0], s0); s1 = fmaf(x33, l[1], s1); s2 = fmaf(x34, l[2], s2); s3 = fmaf(x35, l[3], s3); } { const f32x4 l = *(const LAS f32x4*)(Lc + 1328); s0 = fmaf(x36, l[0], s0); s1 = fmaf(x37, l[1], s1); s2 = fmaf(x38, l[2], s2); s3 = fmaf(x39, l[3], s3); } { const f32x4 l = *(const LAS f32x4*)(Lc + 1332); s0 = fmaf(x40, l[0], s0); s1 = fmaf(x41, l[1], s1); s2 = fmaf(x42, l[2], s2); s3 = fmaf(x43, l[3], s3); } { const f32x4 l = *(const LAS f32x4*)(Lc + 1336); s0 = fmaf(x44, l[0], s0); s1 = fmaf(x45, l[1], s1); s2 = fmaf(x46, l[2], s2); s3 = fmaf(x47, l[3], s3); } { const f32x4 l = *(const LAS f32x4*)(Lc + 1340); s0 = fmaf(x48, l[0], s0); s1 = fmaf(x49, l[1], s1); s2 = fmaf(x50, l[2], s2); s3 = fmaf(x51, l[3], s3); } { const f32x4 l = *(const LAS f32x4*)(Lc + 1344); s0 = fmaf(x52, l[0], s0); s1 = fmaf(x53, l[1], s1); s2 = fmaf(x54, l[2], s2); s3 = fmaf(x55, l[3], s3); } { const f32x4 l = *(const LAS f32x4*)(Lc + 1348); s0 = fmaf(x56, l[0], s0); s1 = fmaf(x57, l[1], s1); s2 = fmaf(x58, l[2], s2); s3 = fmaf(x59, l[3], s3); } { const f32x4 l = *(const LAS f32x4*)(Lc + 1352); s0 = fmaf(x60, l[0], s0); s1 = fmaf(x61, l[1], s1); s2 = fmaf(x62, l[2], s2); s3 = fmaf(x63, l[3], s3); } x19 = (lane == 19) ? 1.0f : -((s0 + s1) + (s2 + s3)); asm volatile("" : "+v"(x19) : : "memory"); }
    { float s0 = 0.f, s1 = 0.f, s2 = 0.f, s3 = 0.f; { const f32x4 l = *(const LAS f32x4*)(Lc + 1240); s3 = fmaf(x19, l[3], s3); } { const f32x4 l = *(const LAS f32x4*)(Lc + 1244); s0 = fmaf(x20, l[0], s0); s1 = fmaf(x21, l[1], s1); s2 = fmaf(x22, l[2], s2); s3 = fmaf(x23, l[3], s3); } { const f32x4 l = *(const LAS f32x4*)(Lc + 1248); s0 = fmaf(x24, l[0], s0); s1 = fmaf(x25, l[1], s1); s2 = fmaf(x26, l[2], s2); s3 = fmaf(x27, l[3], s3); } { const f32x4 l = *(const LAS f32x4*)(Lc + 1252); s0 = fmaf(x28, l[0], s0); s1 = fmaf(x29, l[1], s1); s2 = fmaf(x30, l[2], s2); s3 = fmaf(x31, l[3], s3); } { const f32x4 l = *(const LAS f32x4*)(Lc + 1256); s0 = fmaf(x32, l[0], s0); s1 = fmaf(x33, l[1], s1); s2 = fmaf(x34, l[2], s2); s3 = fmaf(x35, l[3], s3); } { const f32x4 l = *(const LAS f32x4*)(Lc + 1260); s0 = fmaf(x36, l[0], s0); s1 = fmaf(x37, l[1], s1); s2 = fmaf(x38, l[2], s2); s3 = fmaf(x39, l[3], s3); } { const f32x4 l = *(const LAS f32x4*)(Lc + 1264); s0 = fmaf(x40, l[0], s0); s1 = fmaf(x41, l[1], s1); s2 = fmaf(x42, l[2], s2); s3 = fmaf(x43, l[3], s3); } { const f32x4 l = *(const LAS f32x4*)(Lc + 1268); s0 = fmaf(x44, l[0], s0); s1 = fmaf(x45, l[1], s1); s2 = fmaf(x46, l[2], s2); s3 = fmaf(x47, l[3], s3); } { const f32x4 l = *(const LAS f32x4*)(Lc + 1272); s0 = fmaf(x48, l[0], s0); s1 = fmaf(x49, l[1], s1); s2 = fmaf(x50, l[2], s2); s3 = fmaf(x51, l[3], s3); } { const f32x4 l = *(const LAS f32x4*)(Lc + 1276); s0 = fmaf(x52, l[0], s0); s1 = fmaf(x53, l[1], s1); s2 = fmaf(x54, l[2], s2); s3 = fmaf(x55, l[3], s3); } { const f32x4 l = *(const LAS f32x4*)(Lc + 1280); s0 = fmaf(x56, l[0], s0); s1 = fmaf(x57, l[1], s1); s2 = fmaf(x58, l[2], s2); s3 = fmaf(x59, l[3], s3); } { const f32x4 l = *(const LAS f32x4*)(Lc + 1284); s0 = fmaf(x60, l[0], s0); s1 = fmaf(x61, l[1], s1); s2 = fmaf(x62, l[2], s2); s3 = fmaf(x63, l[3], s3); } x18 = (lane == 18) ? 1.0f : -((s0 + s1) + (s2 + s3)); asm volatile("" : "+v"(x18) : : "memory"); }
    { float s0 = 0.f, s1 = 0.f, s2 = 0.f, s3 = 0.f; { const f32x4 l = *(const LAS f32x4*)(Lc + 1172); s2 = fmaf(x18, l[2], s2); s3 = fmaf(x19, l[3], s3); } { const f32x4 l = *(const LAS f32x4*)(Lc + 1176); s0 = fmaf(x20, l[0], s0); s1 = fmaf(x21, l[1], s1); s2 = fmaf(x22, l[2], s2); s3 = fmaf(x23, l[3], s3); } { const f32x4 l = *(const LAS f32x4*)(Lc + 1180); s0 = fmaf(x24, l[0], s0); s1 = fmaf(x25, l[1], s1); s2 = fmaf(x26, l[2], s2); s3 = fmaf(x27, l[3], s3); } { const f32x4 l = *(const LAS f32x4*)(Lc + 1184); s0 = fmaf(x28, l[0], s0); s1 = fmaf(x29, l[1], s1); s2 = fmaf(x30, l[2], s2); s3 = fmaf(x31, l[3], s3); } { const f32x4 l = *(const LAS f32x4*)(Lc + 1188); s0 = fmaf(x32, l[0], s0); s1 = fmaf(x33, l[1], s1); s2 = fmaf(x34, l[2], s2); s3 = fmaf(x35, l[3], s3); } { const f32x4 l = *(const LAS f32x4*)(Lc + 1192); s0 = fmaf(x36, l[0], s0); s1 = fmaf(x37, l[1], s1); s2 = fmaf(x38, l[2], s2); s3 = fmaf(x39, l[3], s3); } { const f32x4 l = *(const LAS f32x4*)(Lc + 1196); s0 = fmaf(x40, l[0], s0); s1 = fmaf(x41, l[1], s1); s2 = fmaf(x42, l[2], s2); s3 = fmaf(x43, l[3], s3); } { const f32x4 l = *(const LAS f32x4*)(Lc + 1200); s0 = fmaf(x44, l[0], s0); s1 = fmaf(x45, l[1], s1); s2 = fmaf(x46, l[2], s2); s3 = fmaf(x47, l[3], s3); } { const f32x4 l = *(const LAS f32x4*)(Lc + 1204); s0 = fmaf(x48, l[0], s0); s1 = fmaf(x49, l[1], s1); s2 = fmaf(x50, l[2], s2); s3 = fmaf(x51, l[3], s3); } { const f32x4 l = *(const LAS f32x4*)(Lc + 1208); s0 = fmaf(x52, l[0], s0); s1 = fmaf(x53, l[1], s1); s2 = fmaf(x54, l[2], s2); s3 = fmaf(x55, l[3], s3); } { const f32x4 l = *(const LAS f32x4*)(Lc + 1212); s0 = fmaf(x56, l[0], s0); s1 = fmaf(x57, l[1], s1); s2 = fmaf(x58, l[2], s2); s3 = fmaf(x59, l[3], s3); } { const f32x4 l = *(const LAS f32x4*)(Lc + 1216); s0 = fmaf(x60, l[0], s0); s1 = fmaf(x61, l[1], s1); s2 = fmaf(x62, l[2], s2); s3 = fmaf(x63, l[3], s3); } x17 = (lane == 17) ? 1.0f : -((s0 + s1) + (s2 + s3)); asm volatile("" : "+v"(x17) : : "memory"); }
    { float s0 = 0.f, s1 = 0.f, s2 = 0.f, s3 = 0.f; { const f32x4 l = *(const LAS f32x4*)(Lc + 1104); s1 = fmaf(x17, l[1], s1); s2 = fmaf(x18, l[2], s2); s3 = fmaf(x19, l[3], s3); } { const f32x4 l = *(const LAS f32x4*)(Lc + 1108); s0 = fmaf(x20, l[0], s0); s1 = fmaf(x21, l[1], s1); s2 = fmaf(x22, l[2], s2); s3 = fmaf(x23, l[3], s3); } { const f32x4 l = *(const LAS f32x4*)(Lc + 1112); s0 = fmaf(x24, l[0], s0); s1 = fmaf(x25, l[1], s1); s2 = fmaf(x26, l[2], s2); s3 = fmaf(x27, l[3], s3); } { const f32x4 l = *(const LAS f32x4*)(Lc + 1116); s0 = fmaf(x28, l[0], s0); s1 = fmaf(x29, l[1], s1); s2 = fmaf(x30, l[2], s2); s3 = fmaf(x31, l[3], s3); } { const f32x4 l = *(const LAS f32x4*)(Lc + 1120); s0 = fmaf(x32, l[0], s0); s1 = fmaf(x33, l[1], s1); s2 = fmaf(x34, l[2], s2); s3 = fmaf(x35, l[3], s3); } { const f32x4 l = *(const LAS f32x4*)(Lc + 1124); s0 = fmaf(x36, l[0], s0); s1 = fmaf(x37, l[1], s1); s2 = fmaf(x38, l[2], s2); s3 = fmaf(x39, l[3], s3); } { const f32x4 l = *(const LAS f32x4*)(Lc + 1128); s0 = fmaf(x40, l[0], s0); s1 = fmaf(x41, l[1], s1); s2 = fmaf(x42, l[2], s2); s3 = fmaf(x43, l[3], s3); } { const f32x4 l = *(const LAS f32x4*)(Lc + 1132); s0 = fmaf(x44, l[0], s0); s1 = fmaf(x45, l[1], s1); s2 = fmaf(x46, l[2], s2); s3 = fmaf(x47, l[3], s3); } { const f32x4 l = *(const LAS f32x4*)(Lc + 1136); s0 = fmaf(x48, l[0], s0); s1 = fmaf(x49, l[1], s1); s2 = fmaf(x50, l[2], s2); s3 = fmaf(x51, l[3], s3); } { const f32x4 l = *(const LAS f32x4*)(Lc + 1140); s0 = fmaf(x52, l[0], s0); s1 = fmaf(x53, l[1], s1); s2 = fmaf(x54, l[2], s2); s3 = fmaf(x55, l[3], s3); } { const f32x4 l = *(const LAS f32x4*)(Lc + 1144); s0 = fmaf(x56, l[0], s0); s1 = fmaf(x57, l[1], s1); s2 = fmaf(x58, l[2], s2); s3 = fmaf(x59, l[3], s3); } { const f32x4 l = *(const LAS f32x4*)(Lc + 1148); s0 = fmaf(x60, l[0], s0); s1 = fmaf(x61, l[1], s1); s2 = fmaf(x62, l[2], s2); s3 = fmaf(x63, l[3], s3); } x16 = (lane == 16) ? 1.0f : -((s0 + s1) + (s2 + s3)); asm volatile("" : "+v"(x16) : : "memory"); }
    { float s0 = 0.f, s1 = 0.f, s2 = 0.f, s3 = 0.f; { const f32x4 l = *(const LAS f32x4*)(Lc + 1036); s0 = fmaf(x16, l[0], s0); s1 = fmaf(x17, l[1], s1); s2 = fmaf(x18, l[2], s2); s3 = fmaf(x19, l[3], s3); } { const f32x4 l = *(const LAS f32x4*)(Lc + 1040); s0 = fmaf(x20, l[0], s0); s1 = fmaf(x21, l[1], s1); s2 = fmaf(x22, l[2], s2); s3 = fmaf(x23, l[3], s3); } { const f32x4 l = *(const LAS f32x4*)(Lc + 1044); s0 = fmaf(x24, l[0], s0); s1 = fmaf(x25, l[1], s1); s2 = fmaf(x26, l[2], s2); s3 = fmaf(x27, l[3], s3); } { const f32x4 l = *(const LAS f32x4*)(Lc + 1048); s0 = fmaf(x28, l[0], s0); s1 = fmaf(x29, l[1], s1); s2 = fmaf(x30, l[2], s2); s3 = fmaf(x31, l[3], s3); } { const f32x4 l = *(const LAS f32x4*)(Lc + 1052); s0 = fmaf(x32, l[0], s0); s1 = fmaf(x33, l[1], s1); s2 = fmaf(x34, l[2], s2); s3 = fmaf(x35, l[3], s3); } { const f32x4 l = *(const LAS f32x4*)(Lc + 1056); s0 = fmaf(x36, l[0], s0); s1 = fmaf(x37, l[1], s1); s2 = fmaf(x38, l[2], s2); s3 = fmaf(x39, l[3], s3); } { const f32x4 l = *(const LAS f32x4*)(Lc + 1060); s0 = fmaf(x40, l[0], s0); s1 = fmaf(x41, l[1], s1); s2 = fmaf(x42, l[2], s2); s3 = fmaf(x43, l[3], s3); } { const f32x4 l = *(const LAS f32x4*)(Lc + 1064); s0 = fmaf(x44, l[0], s0); s1 = fmaf(x45, l[1], s1); s2 = fmaf(x46, l[2], s2); s3 = fmaf(x47, l[3], s3); } { const f32x4 l = *(const LAS f32x4*)(Lc + 1068); s0 = fmaf(x48, l[0], s0); s1 = fmaf(x49, l[1], s1); s2 = fmaf(x50, l[2], s2); s3 = fmaf(x51, l[3], s3); } { const f32x4 l = *(const LAS f32x4*)(Lc + 1072); s0 = fmaf(x52, l[0], s0); s1 = fmaf(x53, l[1], s1); s2 = fmaf(x54, l[2], s2); s3 = fmaf(x55, l[3], s3); } { const f32x4 l = *(const LAS f32x4*)(Lc + 1076); s0 = fmaf(x56, l[0], s0); s1 = fmaf(x57, l[1], s1); s2 = fmaf(x58, l[2], s2); s3 = fmaf(x59, l[3], s3); } { const f32x4 l = *(const LAS f32x4*)(Lc + 1080); s0 = fmaf(x60, l[0], s0); s1 = fmaf(x61, l[1], s1); s2 = fmaf(x62, l[2], s2); s3 = fmaf(x63, l[3], s3); } x15 = (lane == 15) ? 1.0f : -((s0 + s1) + (s2 + s3)); asm volatile("" : "+v"(x15) : : "memory"); }
    { float s0 = 0.f, s1 = 0.f, s2 = 0.f, s3 = 0.f; { const f32x4 l = *(const LAS f32x4*)(Lc + 964); s3 = fmaf(x15, l[3], s3); } { const f32x4 l = *(const LAS f32x4*)(Lc + 968); s0 = fmaf(x16, l[0], s0); s1 = fmaf(x17, l[1], s1); s2 = fmaf(x18, l[2], s2); s3 = fmaf(x19, l[3], s3); } { const f32x4 l = *(const LAS f32x4*)(Lc + 972); s0 = fmaf(x20, l[0], s0); s1 = fmaf(x21, l[1], s1); s2 = fmaf(x22, l[2], s2); s3 = fmaf(x23, l[3], s3); } { const f32x4 l = *(const LAS f32x4*)(Lc + 976); s0 = fmaf(x24, l[0], s0); s1 = fmaf(x25, l[1], s1); s2 = fmaf(x26, l[2], s2); s3 = fmaf(x27, l[3], s3); } { const f32x4 l = *(const LAS f32x4*)(Lc + 980); s0 = fmaf(x28, l[0], s0); s1 = fmaf(x29, l[1], s1); s2 = fmaf(x30, l[2], s2); s3 = fmaf(x31, l[3], s3); } { const f32x4 l = *(const LAS f32x4*)(Lc + 984); s0 = fmaf(x32, l[0], s0); s1 = fmaf(x33, l[1], s1); s2 = fmaf(x34, l[2], s2); s3 = fmaf(x35, l[3], s3); } { const f32x4 l = *(const LAS f32x4*)(Lc + 988); s0 = fmaf(x36, l[0], s0); s1 = fmaf(x37, l[1], s1); s2 = fmaf(x38, l[2], s2); s3 = fmaf(x39, l[3], s3); } { const f32x4 l = *(const LAS f32x4*)(Lc + 992); s0 = fmaf(x40, l[0], s0); s1 = fmaf(x41, l[1], s1); s2 = fmaf(x42, l[2], s2); s3 = fmaf(x43, l[3], s3); } { const f32x4 l = *(const LAS f32x4*)(Lc + 996); s0 = fmaf(x44, l[0], s0); s1 = fmaf(x45, l[1], s1); s2 = fmaf(x46, l[2], s2); s3 = fmaf(x47, l[3], s3); } { const f32x4 l = *(const LAS f32x4*)(Lc + 1000); s0 = fmaf(x48, l[0], s0); s1 = fmaf(x49, l[1], s1); s2 = fmaf(x50, l[2], s2); s3 = fmaf(x51, l[3], s3); } { const f32x4 l = *(const LAS f32x4*)(Lc + 1004); s0 = fmaf(x52, l[0], s0); s1 = fmaf(x53, l[1], s1); s2 = fmaf(x54, l[2], s2); s3 = fmaf(x55, l[3], s3); } { const f32x4 l = *(const LAS f32x4*)(Lc + 1008); s0 = fmaf(x56, l[0], s0); s1 = fmaf(x57, l[1], s1); s2 = fmaf(x58, l[2], s2); s3 = fmaf(x59, l[3], s3); } { const f32x4 l = *(const LAS f32x4*)(Lc + 1012); s0 = fmaf(x60, l[0], s0); s1 = fmaf(x61, l[1], s1); s2 = fmaf(x62, l[2], s2); s3 = fmaf(x63, l[3], s3); } x14 = (lane == 14) ? 1.0f : -((s0 + s1) + (s2 + s3)); asm volatile("" : "+v"(x14) : : "memory"); }
    { float s0 = 0.f, s1 = 0.f, s2 = 0.f, s3 = 0.f; { const f32x4 l = *(const LAS f32x4*)(Lc + 896); s2 = fmaf(x14, l[2], s2); s3 = fmaf(x15, l[3], s3); } { const f32x4 l = *(const LAS f32x4*)(Lc + 900); s0 = fmaf(x16, l[0], s0); s1 = fmaf(x17, l[1], s1); s2 = fmaf(x18, l[2], s2); s3 = fmaf(x19, l[3], s3); } { const f32x4 l = *(const LAS f32x4*)(Lc + 904); s0 = fmaf(x20, l[0], s0); s1 = fmaf(x21, l[1], s1); s2 = fmaf(x22, l[2], s2); s3 = fmaf(x23, l[3], s3); } { const f32x4 l = *(const LAS f32x4*)(Lc + 908); s0 = fmaf(x24, l[0], s0); s1 = fmaf(x25, l[1], s1); s2 = fmaf(x26, l[2], s2); s3 = fmaf(x27, l[3], s3); } { const f32x4 l = *(const LAS f32x4*)(Lc + 912); s0 = fmaf(x28, l[0], s0); s1 = fmaf(x29, l[1], s1); s2 = fmaf(x30, l[2], s2); s3 = fmaf(x31, l[3], s3); } { const f32x4 l = *(const LAS f32x4*)(Lc + 916); s0 = fmaf(x32, l[0], s0); s1 = fmaf(x33, l[1], s1); s2 = fmaf(x34, l[2], s2); s3 = fmaf(x35, l[3], s3); } { const f32x4 l = *(const LAS f32x4*)(Lc + 920); s0 = fmaf(x36, l[0], s0); s1 = fmaf(x37, l[1], s1); s2 = fmaf(x38, l[2], s2); s3 = fmaf(x39, l[3], s3); } { const f32x4 l = *(const LAS f32x4*)(Lc + 924); s0 = fmaf(x40, l[0], s0); s1 = fmaf(x41, l[1], s1); s2 = fmaf(x42, l[2], s2); s3 = fmaf(x43, l[3], s3); } { const f32x4 l = *(const LAS f32x4*)(Lc + 928); s0 = fmaf(x44, l[0], s0); s1 = fmaf(x45, l[1], s1); s2 = fmaf(x46, l[2], s2); s3 = fmaf(x47, l[3], s3); } { const f32x4 l = *(const LAS f32x4*)(Lc + 932); s0 = fmaf(x48, l[0], s0); s1 = fmaf(x49, l[1], s1); s2 = fmaf(x50, l[2], s2); s3 = fmaf(x51, l[3], s3); } { const f32x4 l = *(const LAS f32x4*)(Lc + 936); s0 = fmaf(x52, l[0], s0); s1 = fmaf(x53, l[1], s1); s2 = fmaf(x54, l[2], s2); s3 = fmaf(x55, l[3], s3); } { const f32x4 l = *(const LAS f32x4*)(Lc + 940); s0 = fmaf(x56, l[0], s0); s1 = fmaf(x57, l[1], s1); s2 = fmaf(x58, l[2], s2); s3 = fmaf(x59, l[3], s3); } { const f32x4 l = *(const LAS f32x4*)(Lc + 944); s0 = fmaf(x60, l[0], s0); s1 = fmaf(x61, l[1], s1); s2 = fmaf(x62, l[2], s2); s3 = fmaf(x63, l[3], s3); } x13 = (lane == 13) ? 1.0f : -((s0 + s1) + (s2 + s3)); asm volatile("" : "+v"(x13) : : "memory"); }
    { float s0 = 0.f, s1 = 0.f, s2 = 0.f, s3 = 0.f; { const f32x4 l = *(const LAS f32x4*)(Lc + 828); s1 = fmaf(x13, l[1], s1); s2 = fmaf(x14, l[2], s2); s3 = fmaf(x15, l[3], s3); } { const f32x4 l = *(const LAS f32x4*)(Lc + 832); s0 = fmaf(x16, l[0], s0); s1 = fmaf(x17, l[1], s1); s2 = fmaf(x18, l[2], s2); s3 = fmaf(x19, l[3], s3); } { const f32x4 l = *(const LAS f32x4*)(Lc + 836); s0 = fmaf(x20, l[0], s0); s1 = fmaf(x21, l[1], s1); s2 = fmaf(x22, l[2], s2); s3 = fmaf(x23, l[3], s3); } { const f32x4 l = *(const LAS f32x4*)(Lc + 840); s0 = fmaf(x24, l[0], s0); s1 = fmaf(x25, l[1], s1); s2 = fmaf(x26, l[2], s2); s3 = fmaf(x27, l[3], s3); } { const f32x4 l = *(const LAS f32x4*)(Lc + 844); s0 = fmaf(x28, l[0], s0); s1 = fmaf(x29, l[1], s1); s2 = fmaf(x30, l[2], s2); s3 = fmaf(x31, l[3], s3); } { const f32x4 l = *(const LAS f32x4*)(Lc + 848); s0 = fmaf(x32, l[0], s0); s1 = fmaf(x33, l[1], s1); s2 = fmaf(x34, l[2], s2); s3 = fmaf(x35, l[3], s3); } { const f32x4 l = *(const LAS f32x4*)(Lc + 852); s0 = fmaf(x36, l[0], s0); s1 = fmaf(x37, l[1], s1); s2 = fmaf(x38, l[2], s2); s3 = fmaf(x39, l[3], s3); } { const f32x4 l = *(const LAS f32x4*)(Lc + 856); s0 = fmaf(x40, l[0], s0); s1 = fmaf(x41, l[1], s1); s2 = fmaf(x42, l[2], s2); s3 = fmaf(x43, l[3], s3); } { const f32x4 l = *(const LAS f32x4*)(Lc + 860); s0 = fmaf(x44, l[0], s0); s1 = fmaf(x45, l[1], s1); s2 = fmaf(x46, l[2], s2); s3 = fmaf(x47, l[3], s3); } { const f32x4 l = *(const LAS f32x4*)(Lc + 864); s0 = fmaf(x48, l[0], s0); s1 = fmaf(x49, l[1], s1); s2 = fmaf(x50, l[2], s2); s3 = fmaf(x51, l[3], s3); } { const f32x4 l = *(const LAS f32x4*)(Lc + 868); s0 = fmaf(x52, l[0], s0); s1 = fmaf(x53, l[1], s1); s2 = fmaf(x54, l[2], s2); s3 = fmaf(x55, l[3], s3); } { const f32x4 l = *(const LAS f32x4*)(Lc + 872); s0 = fmaf(x56, l[0], s0); s1 = fmaf(x57, l[1], s1); s2 = fmaf(x58, l[2], s2); s3 = fmaf(x59, l[3], s3); } { const f32x4 l = *(const LAS f32x4*)(Lc + 876); s0 = fmaf(x60, l[0], s0); s1 = fmaf(x61, l[1], s1); s2 = fmaf(x62, l[2], s2); s3 = fmaf(x63, l[3], s3); } x12 = (lane == 12) ? 1.0f : -((s0 + s1) + (s2 + s3)); asm volatile("" : "+v"(x12) : : "memory"); }
    { float s0 = 0.f, s1 = 0.f, s2 = 0.f, s3 = 0.f; { const f32x4 l = *(const LAS f32x4*)(Lc + 760); s0 = fmaf(x12, l[0], s0); s1 = fmaf(x13, l[1], s1); s2 = fmaf(x14, l[2], s2); s3 = fmaf(x15, l[3], s3); } { const f32x4 l = *(const LAS f32x4*)(Lc + 764); s0 = fmaf(x16, l[0], s0); s1 = fmaf(x17, l[1], s1); s2 = fmaf(x18, l[2], s2); s3 = fmaf(x19, l[3], s3); } { const f32x4 l = *(const LAS f32x4*)(Lc + 768); s0 = fmaf(x20, l[0], s0); s1 = fmaf(x21, l[1], s1); s2 = fmaf(x22, l[2], s2); s3 = fmaf(x23, l[3], s3); } { const f32x4 l = *(const LAS f32x4*)(Lc + 772); s0 = fmaf(x24, l[0], s0); s1 = fmaf(x25, l[1], s1); s2 = fmaf(x26, l[2], s2); s3 = fmaf(x27, l[3], s3); } { const f32x4 l = *(const LAS f32x4*)(Lc + 776); s0 = fmaf(x28, l[0], s0); s1 = fmaf(x29, l[1], s1); s2 = fmaf(x30, l[2], s2); s3 = fmaf(x31, l[3], s3); } { const f32x4 l = *(const LAS f32x4*)(Lc + 780); s0 = fmaf(x32, l[0], s0); s1 = fmaf(x33, l[1], s1); s2 = fmaf(x34, l[2], s2); s3 = fmaf(x35, l[3], s3); } { const f32x4 l = *(const LAS f32x4*)(Lc + 784); s0 = fmaf(x36, l[0], s0); s1 = fmaf(x37, l[1], s1); s2 = fmaf(x38, l[2], s2); s3 = fmaf(x39, l[3], s3); } { const f32x4 l = *(const LAS f32x4*)(Lc + 788); s0 = fmaf(x40, l[0], s0); s1 = fmaf(x41, l[1], s1); s2 = fmaf(x42, l[2], s2); s3 = fmaf(x43, l[3], s3); } { const f32x4 l = *(const LAS f32x4*)(Lc + 792); s0 = fmaf(x44, l[0], s0); s1 = fmaf(x45, l[1], s1); s2 = fmaf(x46, l[2], s2); s3 = fmaf(x47, l[3], s3); } { const f32x4 l = *(const LAS f32x4*)(Lc + 796); s0 = fmaf(x48, l[0], s0); s1 = fmaf(x49, l[1], s1); s2 = fmaf(x50, l[2], s2); s3 = fmaf(x51, l[3], s3); } { const f32x4 l = *(const LAS f32x4*)(Lc + 800); s0 = fmaf(x52, l[0], s0); s1 = fmaf(x53, l[1], s1); s2 = fmaf(x54, l[2], s2); s3 = fmaf(x55, l[3], s3); } { const f32x4 l = *(const LAS f32x4*)(Lc + 804); s0 = fmaf(x56, l[0], s0); s1 = fmaf(x57, l[1], s1); s2 = fmaf(x58, l[2], s2); s3 = fmaf(x59, l[3], s3); } { const f32x4 l = *(const LAS f32x4*)(Lc + 808); s0 = fmaf(x60, l[0], s0); s1 = fmaf(x61, l[1], s1); s2 = fmaf(x62, l[2], s2); s3 = fmaf(x63, l[3], s3); } x11 = (lane == 11) ? 1.0f : -((s0 + s1) + (s2 + s3)); asm volatile("" : "+v"(x11) : : "memory"); }
    { float s0 = 0.f, s1 = 0.f, s2 = 0.f, s3 = 0.f; { const f32x4 l = *(const LAS f32x4*)(Lc + 688); s3 = fmaf(x11, l[3], s3); } { const f32x4 l = *(const LAS f32x4*)(Lc + 692); s0 = fmaf(x12, l[0], s0); s1 = fmaf(x13, l[1], s1); s2 = fmaf(x14, l[2], s2); s3 = fmaf(x15, l[3], s3); } { const f32x4 l = *(const LAS f32x4*)(Lc + 696); s0 = fmaf(x16, l[0], s0); s1 = fmaf(x17, l[1], s1); s2 = fmaf(x18, l[2], s2); s3 = fmaf(x19, l[3], s3); } { const f32x4 l = *(const LAS f32x4*)(Lc + 700); s0 = fmaf(x20, l[0], s0); s1 = fmaf(x21, l[1], s1); s2 = fmaf(x22, l[2], s2); s3 = fmaf(x23, l[3], s3); } { const f32x4 l = *(const LAS f32x4*)(Lc + 704); s0 = fmaf(x24, l[0], s0); s1 = fmaf(x25, l[1], s1); s2 = fmaf(x26, l[2], s2); s3 = fmaf(x27, l[3], s3); } { const f32x4 l = *(const LAS f32x4*)(Lc + 708); s0 = fmaf(x28, l[0], s0); s1 = fmaf(x29, l[1], s1); s2 = fmaf(x30, l[2], s2); s3 = fmaf(x31, l[3], s3); } { const f32x4 l = *(const LAS f32x4*)(Lc + 712); s0 = fmaf(x32, l[0], s0); s1 = fmaf(x33, l[1], s1); s2 = fmaf(x34, l[2], s2); s3 = fmaf(x35, l[3], s3); } { const f32x4 l = *(const LAS f32x4*)(Lc + 716); s0 = fmaf(x36, l[0], s0); s1 = fmaf(x37, l[1], s1); s2 = fmaf(x38, l[2], s2); s3 = fmaf(x39, l[3], s3); } { const f32x4 l = *(const LAS f32x4*)(Lc + 720); s0 = fmaf(x40, l[0], s0); s1 = fmaf(x41, l[1], s1); s2 = fmaf(x42, l[2], s2); s3 = fmaf(x43, l[3], s3); } { const f32x4 l = *(const LAS f32x4*)(Lc + 724); s0 = fmaf(x44, l[0], s0); s1 = fmaf(x45, l[1], s1); s2 = fmaf(x46, l[2], s2); s3 = fmaf(x47, l[3], s3); } { const f32x4 l = *(const LAS f32x4*)(Lc + 728); s0 = fmaf(x48, l[0], s0); s1 = fmaf(x49, l[1], s1); s2 = fmaf(x50, l[2], s2); s3 = fmaf(x51, l[3], s3); } { const f32x4 l = *(const LAS f32x4*)(Lc + 732); s0 = fmaf(x52, l[0], s0); s1 = fmaf(x53, l[1], s1); s2 = fmaf(x54, l[2], s2); s3 = fmaf(x55, l[3], s3); } { const f32x4 l = *(const LAS f32x4*)(Lc + 736); s0 = fmaf(x56, l[0], s0); s1 = fmaf(x57, l[1], s1); s2 = fmaf(x58, l[2], s2); s3 = fmaf(x59, l[3], s3); } { const f32x4 l = *(const LAS f32x4*)(Lc + 740); s0 = fmaf(x60, l[0], s0); s1 = fmaf(x61, l[1], s1); s2 = fmaf(x62, l[2], s2); s3 = fmaf(x63, l[3], s3); } x10 = (lane == 10) ? 1.0f : -((s0 + s1) + (s2 + s3)); asm volatile("" : "+v"(x10) : : "memory"); }
    { float s0 = 0.f, s1 = 0.f, s2 = 0.f, s3 = 0.f; { const f32x4 l = *(const LAS f32x4*)(Lc + 620); s2 = fmaf(x10, l[2], s2); s3 = fmaf(x11, l[3], s3); } { const f32x4 l = *(const LAS f32x4*)(Lc + 624); s0 = fmaf(x12, l[0], s0); s1 = fmaf(x13, l[1], s1); s2 = fmaf(x14, l[2], s2); s3 = fmaf(x15, l[3], s3); } { const f32x4 l = *(const LAS f32x4*)(Lc + 628); s0 = fmaf(x16, l[0], s0); s1 = fmaf(x17, l[1], s1); s2 = fmaf(x18, l[2], s2); s3 = fmaf(x19, l[3], s3); } { const f32x4 l = *(const LAS f32x4*)(Lc + 632); s0 = fmaf(x20, l[0], s0); s1 = fmaf(x21, l[1], s1); s2 = fmaf(x22, l[2], s2); s3 = fmaf(x23, l[3], s3); } { const f32x4 l = *(const LAS f32x4*)(Lc + 636); s0 = fmaf(x24, l[0], s0); s1 = fmaf(x25, l[1], s1); s2 = fmaf(x26, l[2], s2); s3 = fmaf(x27, l[3], s3); } { const f32x4 l = *(const LAS f32x4*)(Lc + 640); s0 = fmaf(x28, l[0], s0); s1 = fmaf(x29, l[1], s1); s2 = fmaf(x30, l[2], s2); s3 = fmaf(x31, l[3], s3); } { const f32x4 l = *(const LAS f32x4*)(Lc + 644); s0 = fmaf(x32, l[0], s0); s1 = fmaf(x33, l[1], s1); s2 = fmaf(x34, l[2], s2); s3 = fmaf(x35, l[3], s3); } { const f32x4 l = *(const LAS f32x4*)(Lc + 648); s0 = fmaf(x36, l[0], s0); s1 = fmaf(x37, l[1], s1); s2 = fmaf(x38, l[2], s2); s3 = fmaf(x39, l[3], s3); } { const f32x4 l = *(const LAS f32x4*)(Lc + 652); s0 = fmaf(x40, l[0], s0); s1 = fmaf(x41, l[1], s1); s2 = fmaf(x42, l[2], s2); s3 = fmaf(x43, l[3], s3); } { const f32x4 l = *(const LAS f32x4*)(Lc + 656); s0 = fmaf(x44, l[0], s0); s1 = fmaf(x45, l[1], s1); s2 = fmaf(x46, l[2], s2); s3 = fmaf(x47, l[3], s3); } { const f32x4 l = *(const LAS f32x4*)(Lc + 660); s0 = fmaf(x48, l[0], s0); s1 = fmaf(x49, l[1], s1); s2 = fmaf(x50, l[2], s2); s3 = fmaf(x51, l[3], s3); } { const f32x4 l = *(const LAS f32x4*)(Lc + 664); s0 = fmaf(x52, l[0], s0); s1 = fmaf(x53, l[1], s1); s2 = fmaf(x54, l[2], s2); s3 = fmaf(x55, l[3], s3); } { const f32x4 l = *(const LAS f32x4*)(Lc + 668); s0 = fmaf(x56, l[0], s0); s1 = fmaf(x57, l[1], s1); s2 = fmaf(x58, l[2], s2); s3 = fmaf(x59, l[3], s3); } { const f32x4 l = *(const LAS f32x4*)(Lc + 672); s0 = fmaf(x60, l[0], s0); s1 = fmaf(x61, l[1], s1); s2 = fmaf(x62, l[2], s2); s3 = fmaf(x63, l[3], s3); } x9 = (lane == 9) ? 1.0f : -((s0 + s1) + (s2 + s3)); asm volatile("" : "+v"(x9) : : "memory"); }
    { float s0 = 0.f, s1 = 0.f, s2 = 0.f, s3 = 0.f; { const f32x4 l = *(const LAS f32x4*)(Lc + 552); s1 = fmaf(x9, l[1], s1); s2 = fmaf(x10, l[2], s2); s3 = fmaf(x11, l[3], s3); } { const f32x4 l = *(const LAS f32x4*)(Lc + 556); s0 = fmaf(x12, l[0], s0); s1 = fmaf(x13, l[1], s1); s2 = fmaf(x14, l[2], s2); s3 = fmaf(x15, l[3], s3); } { const f32x4 l = *(const LAS f32x4*)(Lc + 560); s0 = fmaf(x16, l[0], s0); s1 = fmaf(x17, l[1], s1); s2 = fmaf(x18, l[2], s2); s3 = fmaf(x19, l[3], s3); } { const f32x4 l = *(const LAS f32x4*)(Lc + 564); s0 = fmaf(x20, l[0], s0); s1 = fmaf(x21, l[1], s1); s2 = fmaf(x22, l[2], s2); s3 = fmaf(x23, l[3], s3); } { const f32x4 l = *(const LAS f32x4*)(Lc + 568); s0 = fmaf(x24, l[0], s0); s1 = fmaf(x25, l[1], s1); s2 = fmaf(x26, l[2], s2); s3 = fmaf(x27, l[3], s3); } { const f32x4 l = *(const LAS f32x4*)(Lc + 572); s0 = fmaf(x28, l[0], s0); s1 = fmaf(x29, l[1], s1); s2 = fmaf(x30, l[2], s2); s3 = fmaf(x31, l[3], s3); } { const f32x4 l = *(const LAS f32x4*)(Lc + 576); s0 = fmaf(x32, l[0], s0); s1 = fmaf(x33, l[1], s1); s2 = fmaf(x34, l[2], s2); s3 = fmaf(x35, l[3], s3); } { const f32x4 l = *(const LAS f32x4*)(Lc + 580); s0 = fmaf(x36, l[0], s0); s1 = fmaf(x37, l[1], s1); s2 = fmaf(x38, l[2], s2); s3 = fmaf(x39, l[3], s3); } { const f32x4 l = *(const LAS f32x4*)(Lc + 584); s0 = fmaf(x40, l[0], s0); s1 = fmaf(x41, l[1], s1); s2 = fmaf(x42, l[2], s2); s3 = fmaf(x43, l[3], s3); } { const f32x4 l = *(const LAS f32x4*)(Lc + 588); s0 = fmaf(x44, l[0], s0); s1 = fmaf(x45, l[1], s1); s2 = fmaf(x46, l[2], s2); s3 = fmaf(x47, l[3], s3); } { const f32x4 l = *(const LAS f32x4*)(Lc + 592); s0 = fmaf(x48, l[0], s0); s1 = fmaf(x49, l[1], s1); s2 = fmaf(x50, l[2], s2); s3 = fmaf(x51, l[3], s3); } { const f32x4 l = *(const LAS f32x4*)(Lc + 596); s0 = fmaf(x52, l[0], s0); s1 = fmaf(x53, l[1], s1); s2 = fmaf(x54, l[2], s2); s3 = fmaf(x55, l[3], s3); } { const f32x4 l = *(const LAS f32x4*)(Lc + 600); s0 = fmaf(x56, l[0], s0); s1 = fmaf(x57, l[1], s1); s2 = fmaf(x58, l[2], s2); s3 = fmaf(x59, l[3], s3); } { const f32x4 l = *(const LAS f32x4*)(Lc + 604); s0 = fmaf(x60, l[0], s0); s1 = fmaf(x61, l[1], s1); s2 = fmaf(x62, l[2], s2); s3 = fmaf(x63, l[3], s3); } x8 = (lane == 8) ? 1.0f : -((s0 + s1) + (s2 + s3)); asm volatile("" : "+v"(x8) : : "memory"); }
    { float s0 = 0.f, s1 = 0.f, s2 = 0.f, s3 = 0.f; { const f32x4 l = *(const LAS f32x4*)(Lc + 484); s0 = fmaf(x8, l[0], s0); s1 = fmaf(x9, l[1], s1); s2 = fmaf(x10, l[2], s2); s3 = fmaf(x11, l[3], s3); } { const f32x4 l = *(const LAS f32x4*)(Lc + 488); s0 = fmaf(x12, l[0], s0); s1 = fmaf(x13, l[1], s1); s2 = fmaf(x14, l[2], s2); s3 = fmaf(x15, l[3], s3); } { const f32x4 l = *(const LAS f32x4*)(Lc + 492); s0 = fmaf(x16, l[0], s0); s1 = fmaf(x17, l[1], s1); s2 = fmaf(x18, l[2], s2); s3 = fmaf(x19, l[3], s3); } { const f32x4 l = *(const LAS f32x4*)(Lc + 496); s0 = fmaf(x20, l[0], s0); s1 = fmaf(x21, l[1], s1); s2 = fmaf(x22, l[2], s2); s3 = fmaf(x23, l[3], s3); } { const f32x4 l = *(const LAS f32x4*)(Lc + 500); s0 = fmaf(x24, l[0], s0); s1 = fmaf(x25, l[1], s1); s2 = fmaf(x26, l[2], s2); s3 = fmaf(x27, l[3], s3); } { const f32x4 l = *(const LAS f32x4*)(Lc + 504); s0 = fmaf(x28, l[0], s0); s1 = fmaf(x29, l[1], s1); s2 = fmaf(x30, l[2], s2); s3 = fmaf(x31, l[3], s3); } { const f32x4 l = *(const LAS f32x4*)(Lc + 508); s0 = fmaf(x32, l[0], s0); s1 = fmaf(x33, l[1], s1); s2 = fmaf(x34, l[2], s2); s3 = fmaf(x35, l[3], s3); } { const f32x4 l = *(const LAS f32x4*)(Lc + 512); s0 = fmaf(x36, l[0], s0); s1 = fmaf(x37, l[1], s1); s2 = fmaf(x38, l[2], s2); s3 = fmaf(x39, l[3], s3); } { const f32x4 l = *(const LAS f32x4*)(Lc + 516); s0 = fmaf(x40, l[0], s0); s1 = fmaf(x41, l[1], s1); s2 = fmaf(x42, l[2], s2); s3 = fmaf(x43, l[3], s3); } { const f32x4 l = *(const LAS f32x4*)(Lc + 520); s0 = fmaf(x44, l[0], s0); s1 = fmaf(x45, l[1], s1); s2 = fmaf(x46, l[2], s2); s3 = fmaf(x47, l[3], s3); } { const f32x4 l = *(const LAS f32x4*)(Lc + 524); s0 = fmaf(x48, l[0], s0); s1 = fmaf(x49, l[1], s1); s2 = fmaf(x50, l[2], s2); s3 = fmaf(x51, l[3], s3); } { const f32x4 l = *(const LAS f32x4*)(Lc + 528); s0 = fmaf(x52, l[0], s0); s1 = fmaf(x53, l[1], s1); s2 = fmaf(x54, l[2], s2); s3 = fmaf(x55, l[3], s3); } { const f32x4 l = *(const LAS f32x4*)(Lc + 532); s0 = fmaf(x56, l[0], s0); s1 = fmaf(x57, l[1], s1); s2 = fmaf(x58, l[2], s2); s3 = fmaf(x59, l[3], s3); } { const f32x4 l = *(const LAS f32x4*)(Lc + 536); s0 = fmaf(x60, l[0], s0); s1 = fmaf(x61, l[1], s1); s2 = fmaf(x62, l[2], s2); s3 = fmaf(x63, l[3], s3); } x7 = (lane == 7) ? 1.0f : -((s0 + s1) + (s2 + s3)); asm volatile("" : "+v"(x7) : : "memory"); }
    { float s0 = 0.f, s1 = 0.f, s2 = 0.f, s3 = 0.f; { const f32x4 l = *(const LAS f32x4*)(Lc + 412); s3 = fmaf(x7, l[3], s3); } { const f32x4 l = *(const LAS f32x4*)(Lc + 416); s0 = fmaf(x8, l[0], s0); s1 = fmaf(x9, l[1], s1); s2 = fmaf(x10, l[2], s2); s3 = fmaf(x11, l[3], s3); } { const f32x4 l = *(const LAS f32x4*)(Lc + 420); s0 = fmaf(x12, l[0], s0); s1 = fmaf(x13, l[1], s1); s2 = fmaf(x14, l[2], s2); s3 = fmaf(x15, l[3], s3); } { const f32x4 l = *(const LAS f32x4*)(Lc + 424); s0 = fmaf(x16, l[0], s0); s1 = fmaf(x17, l[1], s1); s2 = fmaf(x18, l[2], s2); s3 = fmaf(x19, l[3], s3); } { const f32x4 l = *(const LAS f32x4*)(Lc + 428); s0 = fmaf(x20, l[0], s0); s1 = fmaf(x21, l[1], s1); s2 = fmaf(x22, l[2], s2); s3 = fmaf(x23, l[3], s3); } { const f32x4 l = *(const LAS f32x4*)(Lc + 432); s0 = fmaf(x24, l[0], s0); s1 = fmaf(x25, l[1], s1); s2 = fmaf(x26, l[2], s2); s3 = fmaf(x27, l[3], s3); } { const f32x4 l = *(const LAS f32x4*)(Lc + 436); s0 = fmaf(x28, l[0], s0); s1 = fmaf(x29, l[1], s1); s2 = fmaf(x30, l[2], s2); s3 = fmaf(x31, l[3], s3); } { const f32x4 l = *(const LAS f32x4*)(Lc + 440); s0 = fmaf(x32, l[0], s0); s1 = fmaf(x33, l[1], s1); s2 = fmaf(x34, l[2], s2); s3 = fmaf(x35, l[3], s3); } { const f32x4 l = *(const LAS f32x4*)(Lc + 444); s0 = fmaf(x36, l[0], s0); s1 = fmaf(x37, l[1], s1); s2 = fmaf(x38, l[2], s2); s3 = fmaf(x39, l[3], s3); } { const f32x4 l = *(const LAS f32x4*)(Lc + 448); s0 = fmaf(x40, l[0], s0); s1 = fmaf(x41, l[1], s1); s2 = fmaf(x42, l[2], s2); s3 = fmaf(x43, l[3], s3); } { const f32x4 l = *(const LAS f32x4*)(Lc + 452); s0 = fmaf(x44, l[0], s0); s1 = fmaf(x45, l[1], s1); s2 = fmaf(x46, l[2], s2); s3 = fmaf(x47, l[3], s3); } { const f32x4 l = *(const LAS f32x4*)(Lc + 456); s0 = fmaf(x48, l[0], s0); s1 = fmaf(x49, l[1], s1); s2 = fmaf(x50, l[2], s2); s3 = fmaf(x51, l[3], s3); } { const f32x4 l = *(const LAS f32x4*)(Lc + 460); s0 = fmaf(x52, l[0], s0); s1 = fmaf(x53, l[1], s1); s2 = fmaf(x54, l[2], s2); s3 = fmaf(x55, l[3], s3); } { const f32x4 l = *(const LAS f32x4*)(Lc + 464); s0 = fmaf(x56, l[0], s0); s1 = fmaf(x57, l[1], s1); s2 = fmaf(x58, l[2], s2); s3 = fmaf(x59, l[3], s3); } { const f32x4 l = *(const LAS f32x4*)(Lc + 468); s0 = fmaf(x60, l[0], s0); s1 = fmaf(x61, l[1], s1); s2 = fmaf(x62, l[2], s2); s3 = fmaf(x63, l[3], s3); } x6 = (lane == 6) ? 1.0f : -((s0 + s1) + (s2 + s3)); asm volatile("" : "+v"(x6) : : "memory"); }
    { float s0 = 0.f, s1 = 0.f, s2 = 0.f, s3 = 0.f; { const f32x4 l = *(const LAS f32x4*)(Lc + 344); s2 = fmaf(x6, l[2], s2); s3 = fmaf(x7, l[3], s3); } { const f32x4 l = *(const LAS f32x4*)(Lc + 348); s0 = fmaf(x8, l[0], s0); s1 = fmaf(x9, l[1], s1); s2 = fmaf(x10, l[2], s2); s3 = fmaf(x11, l[3], s3); } { const f32x4 l = *(const LAS f32x4*)(Lc + 352); s0 = fmaf(x12, l[0], s0); s1 = fmaf(x13, l[1], s1); s2 = fmaf(x14, l[2], s2); s3 = fmaf(x15, l[3], s3); } { const f32x4 l = *(const LAS f32x4*)(Lc + 356); s0 = fmaf(x16, l[0], s0); s1 = fmaf(x17, l[1], s1); s2 = fmaf(x18, l[2], s2); s3 = fmaf(x19, l[3], s3); } { const f32x4 l = *(const LAS f32x4*)(Lc + 360); s0 = fmaf(x20, l[0], s0); s1 = fmaf(x21, l[1], s1); s2 = fmaf(x22, l[2], s2); s3 = fmaf(x23, l[3], s3); } { const f32x4 l = *(const LAS f32x4*)(Lc + 364); s0 = fmaf(x24, l[0], s0); s1 = fmaf(x25, l[1], s1); s2 = fmaf(x26, l[2], s2); s3 = fmaf(x27, l[3], s3); } { const f32x4 l = *(const LAS f32x4*)(Lc + 368); s0 = fmaf(x28, l[0], s0); s1 = fmaf(x29, l[1], s1); s2 = fmaf(x30, l[2], s2); s3 = fmaf(x31, l[3], s3); } { const f32x4 l = *(const LAS f32x4*)(Lc + 372); s0 = fmaf(x32, l[0], s0); s1 = fmaf(x33, l[1], s1); s2 = fmaf(x34, l[2], s2); s3 = fmaf(x35, l[3], s3); } { const f32x4 l = *(const LAS f32x4*)(Lc + 376); s0 = fmaf(x36, l[0], s0); s1 = fmaf(x37, l[1], s1); s2 = fmaf(x38, l[2], s2); s3 = fmaf(x39, l[3], s3); } { const f32x4 l = *(const LAS f32x4*)(Lc + 380); s0 = fmaf(x40, l[0], s0); s1 = fmaf(x41, l[1], s1); s2 = fmaf(x42, l[2], s2); s3 = fmaf(x43, l[3], s3); } { const f32x4 l = *(const LAS f32x4*)(Lc + 384); s0 = fmaf(x44, l[0], s0); s1 = fmaf(x45, l[1], s1); s2 = fmaf(x46, l[2], s2); s3 = fmaf(x47, l[3], s3); } { const f32x4 l = *(const LAS f32x4*)(Lc + 388); s0 = fmaf(x48, l[0], s0); s1 = fmaf(x49, l[1], s1); s2 = fmaf(x50, l[2], s2); s3 = fmaf(x51, l[3], s3); } { const f32x4 l = *(const LAS f32x4*)(Lc + 392); s0 = fmaf(x52, l[0], s0); s1 = fmaf(x53, l[1], s1); s2 = fmaf(x54, l[2], s2); s3 = fmaf(x55, l[3], s3); } { const f32x4 l = *(const LAS f32x4*)(Lc + 396); s0 = fmaf(x56, l[0], s0); s1 = fmaf(x57, l[1], s1); s2 = fmaf(x58, l[2], s2); s3 = fmaf(x59, l[3], s3); } { const f32x4 l = *(const LAS f32x4*)(Lc + 400); s0 = fmaf(x60, l[0], s0); s1 = fmaf(x61, l[1], s1); s2 = fmaf(x62, l[2], s2); s3 = fmaf(x63, l[3], s3); } x5 = (lane == 5) ? 1.0f : -((s0 + s1) + (s2 + s3)); asm volatile("" : "+v"(x5) : : "memory"); }
    { float s0 = 0.f, s1 = 0.f, s2 = 0.f, s3 = 0.f; { const f32x4 l = *(const LAS f32x4*)(Lc + 276); s1 = fmaf(x5, l[1], s1); s2 = fmaf(x6, l[2], s2); s3 = fmaf(x7, l[3], s3); } { const f32x4 l = *(const LAS f32x4*)(Lc + 280); s0 = fmaf(x8, l[0], s0); s1 = fmaf(x9, l[1], s1); s2 = fmaf(x10, l[2], s2); s3 = fmaf(x11, l[3], s3); } { const f32x4 l = *(const LAS f32x4*)(Lc + 284); s0 = fmaf(x12, l[0], s0); s1 = fmaf(x13, l[1], s1); s2 = fmaf(x14, l[2], s2); s3 = fmaf(x15, l[3], s3); } { const f32x4 l = *(const LAS f32x4*)(Lc + 288); s0 = fmaf(x16, l[0], s0); s1 = fmaf(x17, l[1], s1); s2 = fmaf(x18, l[2], s2); s3 = fmaf(x19, l[3], s3); } { const f32x4 l = *(const LAS f32x4*)(Lc + 292); s0 = fmaf(x20, l[0], s0); s1 = fmaf(x21, l[1], s1); s2 = fmaf(x22, l[2], s2); s3 = fmaf(x23, l[3], s3); } { const f32x4 l = *(const LAS f32x4*)(Lc + 296); s0 = fmaf(x24, l[0], s0); s1 = fmaf(x25, l[1], s1); s2 = fmaf(x26, l[2], s2); s3 = fmaf(x27, l[3], s3); } { const f32x4 l = *(const LAS f32x4*)(Lc + 300); s0 = fmaf(x28, l[0], s0); s1 = fmaf(x29, l[1], s1); s2 = fmaf(x30, l[2], s2); s3 = fmaf(x31, l[3], s3); } { const f32x4 l = *(const LAS f32x4*)(Lc + 304); s0 = fmaf(x32, l[0], s0); s1 = fmaf(x33, l[1], s1); s2 = fmaf(x34, l[2], s2); s3 = fmaf(x35, l[3], s3); } { const f32x4 l = *(const LAS f32x4*)(Lc + 308); s0 = fmaf(x36, l[0], s0); s1 = fmaf(x37, l[1], s1); s2 = fmaf(x38, l[2], s2); s3 = fmaf(x39, l[3], s3); } { const f32x4 l = *(const LAS f32x4*)(Lc + 312); s0 = fmaf(x40, l[0], s0); s1 = fmaf(x41, l[1], s1); s2 = fmaf(x42, l[2], s2); s3 = fmaf(x43, l[3], s3); } { const f32x4 l = *(const LAS f32x4*)(Lc + 316); s0 = fmaf(x44, l[0], s0); s1 = fmaf(x45, l[1], s1); s2 = fmaf(x46, l[2], s2); s3 = fmaf(x47, l[3], s3); } { const f32x4 l = *(const LAS f32x4*)(Lc + 320); s0 = fmaf(x48, l[0], s0); s1 = fmaf(x49, l[1], s1); s2 = fmaf(x50, l[2], s2); s3 = fmaf(x51, l[3], s3); } { const f32x4 l = *(const LAS f32x4*)(Lc + 324); s0 = fmaf(x52, l[0], s0); s1 = fmaf(x53, l[1], s1); s2 = fmaf(x54, l[2], s2); s3 = fmaf(x55, l[3], s3); } { const f32x4 l = *(const LAS f32x4*)(Lc + 328); s0 = fmaf(x56, l[0], s0); s1 = fmaf(x57, l[1], s1); s2 = fmaf(x58, l[2], s2); s3 = fmaf(x59, l[3], s3); } { const f32x4 l = *(const LAS f32x4*)(Lc + 332); s0 = fmaf(x60, l[0], s0); s1 = fmaf(x61, l[1], s1); s2 = fmaf(x62, l[2], s2); s3 = fmaf(x63, l[3], s3); } x4 = (lane == 4) ? 1.0f : -((s0 + s1) + (s2 + s3)); asm volatile("" : "+v"(x4) : : "memory"); }
    { float s0 = 0.f, s1 = 0.f, s2 = 0.f, s3 = 0.f; { const f32x4 l = *(const LAS f32x4*)(Lc + 208); s0 = fmaf(x4, l[0], s0); s1 = fmaf(x5, l[1], s1); s2 = fmaf(x6, l[2], s2); s3 = fmaf(x7, l[3], s3); } { const f32x4 l = *(const LAS f32x4*)(Lc + 212); s0 = fmaf(x8, l[0], s0); s1 = fmaf(x9, l[1], s1); s2 = fmaf(x10, l[2], s2); s3 = fmaf(x11, l[3], s3); } { const f32x4 l = *(const LAS f32x4*)(Lc + 216); s0 = fmaf(x12, l[0], s0); s1 = fmaf(x13, l[1], s1); s2 = fmaf(x14, l[2], s2); s3 = fmaf(x15, l[3], s3); } { const f32x4 l = *(const LAS f32x4*)(Lc + 220); s0 = fmaf(x16, l[0], s0); s1 = fmaf(x17, l[1], s1); s2 = fmaf(x18, l[2], s2); s3 = fmaf(x19, l[3], s3); } { const f32x4 l = *(const LAS f32x4*)(Lc + 224); s0 = fmaf(x20, l[0], s0); s1 = fmaf(x21, l[1], s1); s2 = fmaf(x22, l[2], s2); s3 = fmaf(x23, l[3], s3); } { const f32x4 l = *(const LAS f32x4*)(Lc + 228); s0 = fmaf(x24, l[0], s0); s1 = fmaf(x25, l[1], s1); s2 = fmaf(x26, l[2], s2); s3 = fmaf(x27, l[3], s3); } { const f32x4 l = *(const LAS f32x4*)(Lc + 232); s0 = fmaf(x28, l[0], s0); s1 = fmaf(x29, l[1], s1); s2 = fmaf(x30, l[2], s2); s3 = fmaf(x31, l[3], s3); } { const f32x4 l = *(const LAS f32x4*)(Lc + 236); s0 = fmaf(x32, l[0], s0); s1 = fmaf(x33, l[1], s1); s2 = fmaf(x34, l[2], s2); s3 = fmaf(x35, l[3], s3); } { const f32x4 l = *(const LAS f32x4*)(Lc + 240); s0 = fmaf(x36, l[0], s0); s1 = fmaf(x37, l[1], s1); s2 = fmaf(x38, l[2], s2); s3 = fmaf(x39, l[3], s3); } { const f32x4 l = *(const LAS f32x4*)(Lc + 244); s0 = fmaf(x40, l[0], s0); s1 = fmaf(x41, l[1], s1); s2 = fmaf(x42, l[2], s2); s3 = fmaf(x43, l[3], s3); } { const f32x4 l = *(const LAS f32x4*)(Lc + 248); s0 = fmaf(x44, l[0], s0); s1 = fmaf(x45, l[1], s1); s2 = fmaf(x46, l[2], s2); s3 = fmaf(x47, l[3], s3); } { const f32x4 l = *(const LAS f32x4*)(Lc + 252); s0 = fmaf(x48, l[0], s0); s1 = fmaf(x49, l[1], s1); s2 = fmaf(x50, l[2], s2); s3 = fmaf(x51, l[3], s3); } { const f32x4 l = *(const LAS f32x4*)(Lc + 256); s0 = fmaf(x52, l[0], s0); s1 = fmaf(x53, l[1], s1); s2 = fmaf(x54, l[2], s2); s3 = fmaf(x55, l[3], s3); } { const f32x4 l = *(const LAS f32x4*)(Lc + 260); s0 = fmaf(x56, l[0], s0); s1 = fmaf(x57, l[1], s1); s2 = fmaf(x58, l[2], s2); s3 = fmaf(x59, l[3], s3); } { const f32x4 l = *(const LAS f32x4*)(Lc + 264); s0 = fmaf(x60, l[0], s0); s1 = fmaf(x61, l[1], s1); s2 = fmaf(x62, l[2], s2); s3 = fmaf(x63, l[3], s3); } x3 = (lane == 3) ? 1.0f : -((s0 + s1) + (s2 + s3)); asm volatile("" : "+v"(x3) : : "memory"); }
    { float s0 = 0.f, s1 = 0.f, s2 = 0.f, s3 = 0.f; { const f32x4 l = *(const LAS f32x4*)(Lc + 136); s3 = fmaf(x3, l[3], s3); } { const f32x4 l = *(const LAS f32x4*)(Lc + 140); s0 = fmaf(x4, l[0], s0); s1 = fmaf(x5, l[1], s1); s2 = fmaf(x6, l[2], s2); s3 = fmaf(x7, l[3], s3); } { const f32x4 l = *(const LAS f32x4*)(Lc + 144); s0 = fmaf(x8, l[0], s0); s1 = fmaf(x9, l[1], s1); s2 = fmaf(x10, l[2], s2); s3 = fmaf(x11, l[3], s3); } { const f32x4 l = *(const LAS f32x4*)(Lc + 148); s0 = fmaf(x12, l[0], s0); s1 = fmaf(x13, l[1], s1); s2 = fmaf(x14, l[2], s2); s3 = fmaf(x15, l[3], s3); } { const f32x4 l = *(const LAS f32x4*)(Lc + 152); s0 = fmaf(x16, l[0], s0); s1 = fmaf(x17, l[1], s1); s2 = fmaf(x18, l[2], s2); s3 = fmaf(x19, l[3], s3); } { const f32x4 l = *(const LAS f32x4*)(Lc + 156); s0 = fmaf(x20, l[0], s0); s1 = fmaf(x21, l[1], s1); s2 = fmaf(x22, l[2], s2); s3 = fmaf(x23, l[3], s3); } { const f32x4 l = *(const LAS f32x4*)(Lc + 160); s0 = fmaf(x24, l[0], s0); s1 = fmaf(x25, l[1], s1); s2 = fmaf(x26, l[2], s2); s3 = fmaf(x27, l[3], s3); } { const f32x4 l = *(const LAS f32x4*)(Lc + 164); s0 = fmaf(x28, l[0], s0); s1 = fmaf(x29, l[1], s1); s2 = fmaf(x30, l[2], s2); s3 = fmaf(x31, l[3], s3); } { const f32x4 l = *(const LAS f32x4*)(Lc + 168); s0 = fmaf(x32, l[0], s0); s1 = fmaf(x33, l[1], s1); s2 = fmaf(x34, l[2], s2); s3 = fmaf(x35, l[3], s3); } { const f32x4 l = *(const LAS f32x4*)(Lc + 172); s0 = fmaf(x36, l[0], s0); s1 = fmaf(x37, l[1], s1); s2 = fmaf(x38, l[2], s2); s3 = fmaf(x39, l[3], s3); } { const f32x4 l = *(const LAS f32x4*)(Lc + 176); s0 = fmaf(x40, l[0], s0); s1 = fmaf(x41, l[1], s1); s2 = fmaf(x42, l[2], s2); s3 = fmaf(x43, l[3], s3); } { const f32x4 l = *(const LAS f32x4*)(Lc + 180); s0 = fmaf(x44, l[0], s0); s1 = fmaf(x45, l[1], s1); s2 = fmaf(x46, l[2], s2); s3 = fmaf(x47, l[3], s3); } { const f32x4 l = *(const LAS f32x4*)(Lc + 184); s0 = fmaf(x48, l[0], s0); s1 = fmaf(x49, l[1], s1); s2 = fmaf(x50, l[2], s2); s3 = fmaf(x51, l[3], s3); } { const f32x4 l = *(const LAS f32x4*)(Lc + 188); s0 = fmaf(x52, l[0], s0); s1 = fmaf(x53, l[1], s1); s2 = fmaf(x54, l[2], s2); s3 = fmaf(x55, l[3], s3); } { const f32x4 l = *(const LAS f32x4*)(Lc + 192); s0 = fmaf(x56, l[0], s0); s1 = fmaf(x57, l[1], s1); s2 = fmaf(x58, l[2], s2); s3 = fmaf(x59, l[3], s3); } { const f32x4 l = *(const LAS f32x4*)(Lc + 196); s0 = fmaf(x60, l[0], s0); s1 = fmaf(x61, l[1], s1); s2 = fmaf(x62, l[2], s2); s3 = fmaf(x63, l[3], s3); } x2 = (lane == 2) ? 1.0f : -((s0 + s1) + (s2 + s3)); asm volatile("" : "+v"(x2) : : "memory"); }
    { float s0 = 0.f, s1 = 0.f, s2 = 0.f, s3 = 0.f; { const f32x4 l = *(const LAS f32x4*)(Lc + 68); s2 = fmaf(x2, l[2], s2); s3 = fmaf(x3, l[3], s3); } { const f32x4 l = *(const LAS f32x4*)(Lc + 72); s0 = fmaf(x4, l[0], s0); s1 = fmaf(x5, l[1], s1); s2 = fmaf(x6, l[2], s2); s3 = fmaf(x7, l[3], s3); } { const f32x4 l = *(const LAS f32x4*)(Lc + 76); s0 = fmaf(x8, l[0], s0); s1 = fmaf(x9, l[1], s1); s2 = fmaf(x10, l[2], s2); s3 = fmaf(x11, l[3], s3); } { const f32x4 l = *(const LAS f32x4*)(Lc + 80); s0 = fmaf(x12, l[0], s0); s1 = fmaf(x13, l[1], s1); s2 = fmaf(x14, l[2], s2); s3 = fmaf(x15, l[3], s3); } { const f32x4 l = *(const LAS f32x4*)(Lc + 84); s0 = fmaf(x16, l[0], s0); s1 = fmaf(x17, l[1], s1); s2 = fmaf(x18, l[2], s2); s3 = fmaf(x19, l[3], s3); } { const f32x4 l = *(const LAS f32x4*)(Lc + 88); s0 = fmaf(x20, l[0], s0); s1 = fmaf(x21, l[1], s1); s2 = fmaf(x22, l[2], s2); s3 = fmaf(x23, l[3], s3); } { const f32x4 l = *(const LAS f32x4*)(Lc + 92); s0 = fmaf(x24, l[0], s0); s1 = fmaf(x25, l[1], s1); s2 = fmaf(x26, l[2], s2); s3 = fmaf(x27, l[3], s3); } { const f32x4 l = *(const LAS f32x4*)(Lc + 96); s0 = fmaf(x28, l[0], s0); s1 = fmaf(x29, l[1], s1); s2 = fmaf(x30, l[2], s2); s3 = fmaf(x31, l[3], s3); } { const f32x4 l = *(const LAS f32x4*)(Lc + 100); s0 = fmaf(x32, l[0], s0); s1 = fmaf(x33, l[1], s1); s2 = fmaf(x34, l[2], s2); s3 = fmaf(x35, l[3], s3); } { const f32x4 l = *(const LAS f32x4*)(Lc + 104); s0 = fmaf(x36, l[0], s0); s1 = fmaf(x37, l[1], s1); s2 = fmaf(x38, l[2], s2); s3 = fmaf(x39, l[3], s3); } { const f32x4 l = *(const LAS f32x4*)(Lc + 108); s0 = fmaf(x40, l[0], s0); s1 = fmaf(x41, l[1], s1); s2 = fmaf(x42, l[2], s2); s3 = fmaf(x43, l[3], s3); } { const f32x4 l = *(const LAS f32x4*)(Lc + 112); s0 = fmaf(x44, l[0], s0); s1 = fmaf(x45, l[1], s1); s2 = fmaf(x46, l[2], s2); s3 = fmaf(x47, l[3], s3); } { const f32x4 l = *(const LAS f32x4*)(Lc + 116); s0 = fmaf(x48, l[0], s0); s1 = fmaf(x49, l[1], s1); s2 = fmaf(x50, l[2], s2); s3 = fmaf(x51, l[3], s3); } { const f32x4 l = *(const LAS f32x4*)(Lc + 120); s0 = fmaf(x52, l[0], s0); s1 = fmaf(x53, l[1], s1); s2 = fmaf(x54, l[2], s2); s3 = fmaf(x55, l[3], s3); } { const f32x4 l = *(const LAS f32x4*)(Lc + 124); s0 = fmaf(x56, l[0], s0); s1 = fmaf(x57, l[1], s1); s2 = fmaf(x58, l[2], s2); s3 = fmaf(x59, l[3], s3); } { const f32x4 l = *(const LAS f32x4*)(Lc + 128); s0 = fmaf(x60, l[0], s0); s1 = fmaf(x61, l[1], s1); s2 = fmaf(x62, l[2], s2); s3 = fmaf(x63, l[3], s3); } x1 = (lane == 1) ? 1.0f : -((s0 + s1) + (s2 + s3)); asm volatile("" : "+v"(x1) : : "memory"); }
    { float s0 = 0.f, s1 = 0.f, s2 = 0.f, s3 = 0.f; { const f32x4 l = *(const LAS f32x4*)(Lc + 0); s1 = fmaf(x1, l[1], s1); s2 = fmaf(x2, l[2], s2); s3 = fmaf(x3, l[3], s3); } { const f32x4 l = *(const LAS f32x4*)(Lc + 4); s0 = fmaf(x4, l[0], s0); s1 = fmaf(x5, l[1], s1); s2 = fmaf(x6, l[2], s2); s3 = fmaf(x7, l[3], s3); } { const f32x4 l = *(const LAS f32x4*)(Lc + 8); s0 = fmaf(x8, l[0], s0); s1 = fmaf(x9, l[1], s1); s2 = fmaf(x10, l[2], s2); s3 = fmaf(x11, l[3], s3); } { const f32x4 l = *(const LAS f32x4*)(Lc + 12); s0 = fmaf(x12, l[0], s0); s1 = fmaf(x13, l[1], s1); s2 = fmaf(x14, l[2], s2); s3 = fmaf(x15, l[3], s3); } { const f32x4 l = *(const LAS f32x4*)(Lc + 16); s0 = fmaf(x16, l[0], s0); s1 = fmaf(x17, l[1], s1); s2 = fmaf(x18, l[2], s2); s3 = fmaf(x19, l[3], s3); } { const f32x4 l = *(const LAS f32x4*)(Lc + 20); s0 = fmaf(x20, l[0], s0); s1 = fmaf(x21, l[1], s1); s2 = fmaf(x22, l[2], s2); s3 = fmaf(x23, l[3], s3); } { const f32x4 l = *(const LAS f32x4*)(Lc + 24); s0 = fmaf(x24, l[0], s0); s1 = fmaf(x25, l[1], s1); s2 = fmaf(x26, l[2], s2); s3 = fmaf(x27, l[3], s3); } { const f32x4 l = *(const LAS f32x4*)(Lc + 28); s0 = fmaf(x28, l[0], s0); s1 = fmaf(x29, l[1], s1); s2 = fmaf(x30, l[2], s2); s3 = fmaf(x31, l[3], s3); } { const f32x4 l = *(const LAS f32x4*)(Lc + 32); s0 = fmaf(x32, l[0], s0); s1 = fmaf(x33, l[1], s1); s2 = fmaf(x34, l[2], s2); s3 = fmaf(x35, l[3], s3); } { const f32x4 l = *(const LAS f32x4*)(Lc + 36); s0 = fmaf(x36, l[0], s0); s1 = fmaf(x37, l[1], s1); s2 = fmaf(x38, l[2], s2); s3 = fmaf(x39, l[3], s3); } { const f32x4 l = *(const LAS f32x4*)(Lc + 40); s0 = fmaf(x40, l[0], s0); s1 = fmaf(x41, l[1], s1); s2 = fmaf(x42, l[2], s2); s3 = fmaf(x43, l[3], s3); } { const f32x4 l = *(const LAS f32x4*)(Lc + 44); s0 = fmaf(x44, l[0], s0); s1 = fmaf(x45, l[1], s1); s2 = fmaf(x46, l[2], s2); s3 = fmaf(x47, l[3], s3); } { const f32x4 l = *(const LAS f32x4*)(Lc + 48); s0 = fmaf(x48, l[0], s0); s1 = fmaf(x49, l[1], s1); s2 = fmaf(x50, l[2], s2); s3 = fmaf(x51, l[3], s3); } { const f32x4 l = *(const LAS f32x4*)(Lc + 52); s0 = fmaf(x52, l[0], s0); s1 = fmaf(x53, l[1], s1); s2 = fmaf(x54, l[2], s2); s3 = fmaf(x55, l[3], s3); } { const f32x4 l = *(const LAS f32x4*)(Lc + 56); s0 = fmaf(x56, l[0], s0); s1 = fmaf(x57, l[1], s1); s2 = fmaf(x58, l[2], s2); s3 = fmaf(x59, l[3], s3); } { const f32x4 l = *(const LAS f32x4*)(Lc + 60); s0 = fmaf(x60, l[0], s0); s1 = fmaf(x61, l[1], s1); s2 = fmaf(x62, l[2], s2); s3 = fmaf(x63, l[3], s3); } x0 = (lane == 0) ? 1.0f : -((s0 + s1) + (s2 + s3)); asm volatile("" : "+v"(x0) : : "memory"); }
    { v4u o; o.x = cvtpk(x0, x1); o.y = cvtpk(x2, x3); o.z = cvtpk(x4, x5); o.w = cvtpk(x6, x7); *(LAS v4u*)(Xs + lane * 72 + 0) = o; }
    { v4u o; o.x = cvtpk(x8, x9); o.y = cvtpk(x10, x11); o.z = cvtpk(x12, x13); o.w = cvtpk(x14, x15); *(LAS v4u*)(Xs + lane * 72 + 8) = o; }
    { v4u o; o.x = cvtpk(x16, x17); o.y = cvtpk(x18, x19); o.z = cvtpk(x20, x21); o.w = cvtpk(x22, x23); *(LAS v4u*)(Xs + lane * 72 + 16) = o; }
    { v4u o; o.x = cvtpk(x24, x25); o.y = cvtpk(x26, x27); o.z = cvtpk(x28, x29); o.w = cvtpk(x30, x31); *(LAS v4u*)(Xs + lane * 72 + 24) = o; }
    { v4u o; o.x = cvtpk(x32, x33); o.y = cvtpk(x34, x35); o.z = cvtpk(x36, x37); o.w = cvtpk(x38, x39); *(LAS v4u*)(Xs + lane * 72 + 32) = o; }
    { v4u o; o.x = cvtpk(x40, x41); o.y = cvtpk(x42, x43); o.z = cvtpk(x44, x45); o.w = cvtpk(x46, x47); *(LAS v4u*)(Xs + lane * 72 + 40) = o; }
    { v4u o; o.x = cvtpk(x48, x49); o.y = cvtpk(x50, x51); o.z = cvtpk(x52, x53); o.w = cvtpk(x54, x55); *(LAS v4u*)(Xs + lane * 72 + 48) = o; }
    { v4u o; o.x = cvtpk(x56, x57); o.y = cvtpk(x58, x59); o.z = cvtpk(x60, x61); o.w = cvtpk(x62, x63); *(LAS v4u*)(Xs + lane * 72 + 56) = o; }
}
#ifndef G1P
#define G1P 15
#endif

#define MF16(a, b, c) __builtin_amdgcn_mfma_f32_16x16x32_bf16((a), (b), (c), 0, 0, 0)
__device__ __forceinline__ bf16x8 ld16g(const bf16* p) { return *(const GAS bf16x8*)p; }
__device__ __forceinline__ float ldbf(const bf16* p) { return __uint_as_float(((unsigned)*(const GAS unsigned short*)p) << 16); }
__device__ __forceinline__ void st8(bf16* p, float a, float b, float c, float d) { u32x2v o; o.x = cvtpk(a, b); o.y = cvtpk(c, d); *(GAS u32x2v*)p = o; }

__device__ __forceinline__ void p_ga(const Frame& F, const Args& a, int L) {
    GAS unsigned char* ws = (GAS unsigned char*)a.ws; asm volatile("" : "+s"(ws)); int lane_ = F.lane; asm volatile("" : "+v"(lane_)); const int j = L >> 1, lane = lane_;
    const bf16* PO = (const bf16*)(ws + WS_ARENA + AR_PO);
    bf16 *QN = (bf16*)(ws + WS_ARENA + AR_QN), *QT = (bf16*)(ws + WS_ARENA + AR_QT), *KN = (bf16*)(ws + WS_ARENA + AR_KN), *KGT = (bf16*)(ws + WS_ARENA + AR_KGT), *VBT = (bf16*)(ws + WS_ARENA + AR_VBT), *KTT = (bf16*)(ws + WS_ARENA + AR_KTT);
    const float* gg = (const float*)(ws + WS_GB); const float* gbeta = gg + S_ * 8; float* dn = (float*)(ws + WS_TOK + TOK_DN); float* gcs = (float*)(ws + WS_GC);
    const float* cw = (const float*)a.in[16] + (size_t)j * 4 * 3072;
    LAS float* sc = (LAS float*)(F.lds + F.wave * WAVE_LDS);
    const int dg = lane & 15, ts = lane >> 4, d0 = 8 * dg;
#pragma unroll 1
    for (int u = F.gw; u < NUNIT; u += F.NGW) {
        const int n = u >> 3, hh = u & 7, tok0 = 64 * n;
        {
            const float g = gg[(size_t)(tok0 + lane) * 8 + hh], beta = gbeta[(size_t)(tok0 + lane) * 8 + hh];
            float gc = g;
#pragma unroll
            for (int o = 1; o < 64; o <<= 1) { const float t = __shfl_up(gc, o); if (lane >= o) gc += t; }
            const float glast = __shfl(gc, 63);
            gcs[(size_t)(tok0 + lane) * 8 + hh] = gc;
            if (lane == 0) dn[u] = expf(glast);
            const float eg = expf(gc);
            sc[64 + lane] = beta * eg; sc[128 + lane] = expf(glast - gc); sc[192 + lane] = beta; sc[256 + lane] = eg;
        }
#pragma unroll 1
        for (int qk = 0; qk < 2; ++qk) {
            const int coff = qk * 1024 + hh * 128 + d0;
            float w[4][8];
#pragma unroll
            for (int jj = 0; jj < 4; ++jj)
#pragma unroll
                for (int e = 0; e < 8; ++e) w[jj][e] = *(const GAS float*)(cw + jj * 3072 + coff + e);
#pragma unroll 4
            for (int it = 0; it < 16; ++it) {
                const int i = 4 * it + ts, tok = tok0 + i; float acc[8];
                v4u rv[4];
#pragma unroll
                for (int jj = 0; jj < 4; ++jj) { const int r = tok - 3 + jj; rv[jj] = *(const GAS v4u*)(PO + (size_t)(r < 0 ? 0 : r) * OIN + coff); }
#pragma unroll
                for (int e = 0; e < 8; ++e) acc[e] = 0.f;
#pragma unroll
                for (int jj = 0; jj < 4; ++jj) { const float on = (tok - 3 + jj >= 0) ? 1.0f : 0.0f; const unsigned vv[4] = {rv[jj].x, rv[jj].y, rv[jj].z, rv[jj].w};
#pragma unroll
                    for (int q = 0; q < 4; ++q) { acc[2 * q] += (w[jj][2 * q] * on) * bflo(vv[q]); acc[2 * q + 1] += (w[jj][2 * q + 1] * on) * bfhi(vv[q]); } }
                float ss = 0.f;
#pragma unroll
                for (int e = 0; e < 8; ++e) { acc[e] = silu(acc[e]); ss += acc[e] * acc[e]; }
                ss += __shfl_xor(ss, 1); ss += __shfl_xor(ss, 2); ss += __shfl_xor(ss, 4); ss += __shfl_xor(ss, 8);
                const float rn = __builtin_amdgcn_rsqf(ss + 1e-6f);
                const float s1 = (qk == 0) ? rn * 0.08838834764831845f : rn;
                v4u o; o.x = cvtpk(acc[0] * s1, acc[1] * s1); o.y = cvtpk(acc[2] * s1, acc[3] * s1); o.z = cvtpk(acc[4] * s1, acc[5] * s1); o.w = cvtpk(acc[6] * s1, acc[7] * s1);
                *(GAS v4u*)((qk == 0 ? QN : KN) + (size_t)tok * D_ + hh * 128 + d0) = o;
                if (qk == 0) { const float s2 = s1 * sc[256 + i];
                    o.x = cvtpk(acc[0] * s2, acc[1] * s2); o.y = cvtpk(acc[2] * s2, acc[3] * s2); o.z = cvtpk(acc[4] * s2, acc[5] * s2); o.w = cvtpk(acc[6] * s2, acc[7] * s2);
                    *(GAS v4u*)(QT + (size_t)tok * D_ + hh * 128 + d0) = o; }
                else if (dg == 0) sc[i] = rn;
            }
        }
#pragma unroll 1
        for (int kv = 0; kv < 2; ++kv)
#pragma unroll 1
            for (int half = 0; half < 2; ++half) {
                const int d = 64 * half + lane, c = (1 + kv) * 1024 + hh * 128 + d;
                const float w0 = *(const GAS float*)(cw + c), w1 = *(const GAS float*)(cw + 3072 + c), w2 = *(const GAS float*)(cw + 2 * 3072 + c), w3 = *(const GAS float*)(cw + 3 * 3072 + c);
                const float hon = tok0 > 0 ? 1.0f : 0.0f; const int hb = tok0 > 0 ? tok0 - 3 : 0;
                float r0 = hon * ldbf(PO + (size_t)hb * OIN + c), r1 = hon * ldbf(PO + (size_t)(hb + 1) * OIN + c), r2 = hon * ldbf(PO + (size_t)(hb + 2) * OIN + c);
                const size_t obase = ((size_t)u * 128 + d) * 64;
                const LAS float* m1 = sc + (kv == 0 ? 64 : 192);
                bf16* O1 = kv == 0 ? KGT : VBT;
#pragma unroll 1
                for (int ig4 = 0; ig4 < 2; ++ig4) {
                    float x[32];
#pragma unroll
                    for (int e = 0; e < 32; ++e) x[e] = ldbf(PO + (size_t)(tok0 + 32 * ig4 + e) * OIN + c);
#pragma unroll
                    for (int sb = 0; sb < 4; ++sb) { const int ig = 4 * ig4 + sb; float o1[8], o2[8];
#pragma unroll
                        for (int e = 0; e < 8; ++e) { const int i = 8 * ig + e; const float r3 = x[8 * sb + e];
                            float v = silu(w0 * r0 + w1 * r1 + w2 * r2 + w3 * r3); r0 = r1; r1 = r2; r2 = r3;
                            const float rk = sc[i]; v = (kv == 0) ? v * rk : v;
                            o1[e] = v * m1[i]; o2[e] = v * sc[128 + i]; }
                        v4u o; o.x = cvtpk(o1[0], o1[1]); o.y = cvtpk(o1[2], o1[3]); o.z = cvtpk(o1[4], o1[5]); o.w = cvtpk(o1[6], o1[7]);
                        *(GAS v4u*)(O1 + obase + 8 * ig) = o;
                        if (kv == 0) { o.x = cvtpk(o2[0], o2[1]); o.y = cvtpk(o2[2], o2[3]); o.z = cvtpk(o2[4], o2[5]); o.w = cvtpk(o2[6], o2[7]); *(GAS v4u*)(KTT + obase + 8 * ig) = o; } }
                }
            }
    }
}

__device__ __forceinline__ void p_g1(const Frame& F, const Args& a) {
    GAS unsigned char* ws = (GAS unsigned char*)a.ws; asm volatile("" : "+s"(ws)); int lane_ = F.lane; asm volatile("" : "+v"(lane_)); const int lane = lane_, r16 = lane & 15, g = lane >> 4;
    const bf16 *QN = (const bf16*)(ws + WS_ARENA + AR_QN), *KN = (const bf16*)(ws + WS_ARENA + AR_KN), *KGT = (const bf16*)(ws + WS_ARENA + AR_KGT), *VBT = (const bf16*)(ws + WS_ARENA + AR_VBT), *KTT = (const bf16*)(ws + WS_ARENA + AR_KTT);
    bf16 *AI = (bf16*)(ws + WS_ARENA + AR_AI), *NEGW = (bf16*)(ws + WS_ARENA + AR_NEGW), *UT = (bf16*)(ws + WS_ARENA + AR_UT), *MP = (bf16*)(ws + WS_ARENA + AR_MP), *NT = (bf16*)(ws + WS_ARENA + AR_NT), *WT = (bf16*)(ws + WS_ARENA + AR_WT);
    const float* gg = (const float*)(ws + WS_GC); const float* gbeta = (const float*)(ws + WS_GB) + S_ * 8;
    LAS float* Lc = (LAS float*)(F.lds + F.wave * WAVE_LDS);
    LAS bf16* Xs = (LAS bf16*)(F.lds + F.wave * WAVE_LDS);
    const f32x4 Z4 = {0.f, 0.f, 0.f, 0.f};
#pragma unroll 1
    for (int u = F.gw; u < NUNIT; u += F.NGW) {
        const int n = u >> 3, hh = u & 7, tok0 = 64 * n; const int uh = hh * NCHUNK + n;
        const float gc = gg[(size_t)(tok0 + lane) * 8 + hh], beta = gbeta[(size_t)(tok0 + lane) * 8 + hh];
#if G1P & 1
        {
            bf16x8 kf[4][4];
#pragma unroll
            for (int t = 0; t < 4; ++t)
#pragma unroll
                for (int kk = 0; kk < 4; ++kk) kf[t][kk] = ld16g(KN + (size_t)(tok0 + 16 * t + r16) * D_ + hh * 128 + 32 * kk + 8 * g);
#pragma unroll
            for (int ti = 0; ti < 4; ++ti)
#pragma unroll
                for (int tj = 0; tj <= ti; ++tj) {
                    f32x4 Dv = Z4;
#pragma unroll
                    for (int kk = 0; kk < 4; ++kk) Dv = MF16(kf[ti][kk], kf[tj][kk], Dv);
                    const int jx = 16 * tj + r16; const float gcj = __shfl(gc, jx); f32x4 val;
#pragma unroll
                    for (int r = 0; r < 4; ++r) { const int ix = 16 * ti + 4 * g + r; const float gci = __shfl(gc, ix), bi = __shfl(beta, ix); val[r] = (ix > jx) ? bi * Dv[r] * expf(gci - gcj) : 0.f; }
                    *(LAS f32x4*)(Lc + jx * 68 + 16 * ti + 4 * g) = val;
                }
#pragma unroll
            for (int ti = 0; ti < 4; ++ti) {
                bf16x8 qf[4];
#pragma unroll
                for (int kk = 0; kk < 4; ++kk) qf[kk] = ld16g(QN + (size_t)(tok0 + 16 * ti + r16) * D_ + hh * 128 + 32 * kk + 8 * g);
                const int ix = 16 * ti + r16; const float gci = __shfl(gc, ix);
#pragma unroll
                for (int tj = 0; tj < 4; ++tj) {
                    f32x4 val = Z4;
                    if (tj <= ti) {
                        f32x4 Dv = Z4;
#pragma unroll
                        for (int kk = 0; kk < 4; ++kk) Dv = MF16(kf[tj][kk], qf[kk], Dv);
#pragma unroll
                        for (int r = 0; r < 4; ++r) { const int jx = 16 * tj + 4 * g + r; const float gcj = __shfl(gc, jx); val[r] = (ix >= jx) ? Dv[r] * expf(gci - gcj) : 0.f; }
                    }
                    st8(AI + ((size_t)u * 64 + ix) * 64 + 16 * tj + 4 * g, val[0], val[1], val[2], val[3]);
                }
            }
        }
        asm volatile("s_waitcnt lgkmcnt(0)" ::: "memory");
#endif
#if G1P & 2
        tri_solve(Lc, Xs, lane);
#endif
#if G1P & 4
        asm volatile("s_waitcnt lgkmcnt(0)" ::: "memory");
        {
            bf16x8 xf[4][2];
#pragma unroll
            for (int t = 0; t < 4; ++t)
#pragma unroll
                for (int kk = 0; kk < 2; ++kk) xf[t][kk] = *(const LAS bf16x8*)(Xs + (16 * t + r16) * 72 + 32 * kk + 8 * g);
#pragma unroll 2
            for (int td = 0; td < 8; ++td) {
                const size_t rb = ((size_t)u * 128 + 16 * td + r16) * 64;
                const bf16x8 vb0 = ld16g(VBT + rb + 8 * g), vb1 = ld16g(VBT + rb + 32 + 8 * g), kg0 = ld16g(KGT + rb + 8 * g), kg1 = ld16g(KGT + rb + 32 + 8 * g);
#pragma unroll
                for (int ti = 0; ti < 4; ++ti) {
                    f32x4 Du = MF16(xf[ti][0], vb0, Z4); Du = MF16(xf[ti][1], vb1, Du);
                    st8(UT + rb + 16 * ti + 4 * g, Du[0], Du[1], Du[2], Du[3]);
                    f32x4 Dw = MF16(xf[ti][0], kg0, Z4); Dw = MF16(xf[ti][1], kg1, Dw);
                    st8(WT + rb + 16 * ti + 4 * g, Dw[0], Dw[1], Dw[2], Dw[3]);
                    f32x4 Dn = MF16(kg0, xf[ti][0], Z4); Dn = MF16(kg1, xf[ti][1], Dn);
                    st8(NEGW + (size_t)(tok0 + 16 * ti + r16) * D_ + hh * 128 + 16 * td + 4 * g, -Dn[0], -Dn[1], -Dn[2], -Dn[3]);
                }
            }
        }
#endif
        asm volatile("s_waitcnt vmcnt(0)" ::: "memory");
#if G1P & 8
        {
            bf16x8 ktf[8][2];
#pragma unroll
            for (int t = 0; t < 8; ++t)
#pragma unroll
                for (int kk = 0; kk < 2; ++kk) ktf[t][kk] = ld16g(KTT + ((size_t)u * 128 + 16 * t + r16) * 64 + 32 * kk + 8 * g);
#pragma unroll 2
            for (int tp = 0; tp < 8; ++tp) {
                const size_t rb = ((size_t)u * 128 + 16 * tp + r16) * 64;
                const bf16x8 wf0 = ld16g(WT + rb + 8 * g), wf1 = ld16g(WT + rb + 32 + 8 * g), uf0 = ld16g(UT + rb + 8 * g), uf1 = ld16g(UT + rb + 32 + 8 * g);
#pragma unroll
                for (int t1 = 0; t1 < 8; ++t1) {
                    f32x4 Dm = MF16(wf0, ktf[t1][0], Z4); Dm = MF16(wf1, ktf[t1][1], Dm);
                    st8(MP + ((size_t)uh * 128 + 16 * t1 + r16) * 128 + 16 * tp + 4 * g, -Dm[0], -Dm[1], -Dm[2], -Dm[3]);
                    f32x4 Dn = MF16(ktf[t1][0], uf0, Z4); Dn = MF16(ktf[t1][1], uf1, Dn);
                    st8(NT + ((size_t)uh * 128 + 16 * tp + r16) * 128 + 16 * t1 + 4 * g, Dn[0], Dn[1], Dn[2], Dn[3]);
                }
            }
        }
#endif
    }
}

template <int NS, int SGSTEP> __device__ __forceinline__ void p_g2(const Frame& F, const Args& a, const bf16* MPsrc, const bf16* NTsrc, const float* dnsrc) {
    GAS unsigned char* ws = (GAS unsigned char*)a.ws; asm volatile("" : "+s"(ws)); int lane_ = F.lane; asm volatile("" : "+v"(lane_)); const int lane = lane_, r16 = lane & 15, g = lane >> 4, w = F.wave;
    const bf16 *MP = MPsrc, *NT = NTsrc; bf16* SG = (bf16*)(ws + WS_ARENA + AR_SG);
    const float* dn = dnsrc;
    LAS bf16* St = (LAS bf16*)F.lds;
    const int args_use_bar = a.use_bar; (void)args_use_bar;
#pragma unroll 1
    for (int asg = F.vcu; asg < 64; asg += F.G) {
        const int hh = asg >> 3, sl = asg & 7;
        __syncthreads();
        for (int idx = F.tid; idx < 2 * 16 * 136 / 2; idx += NWAVES * 64) ((LAS unsigned*)St)[idx] = 0u;
        __syncthreads();
        if (w >= 4) {
            const int st = F.tid - 256, row = st >> 4, chunk = st & 15;
#pragma unroll 1
            for (int n = 0; n < NS; ++n) {
                const v4u v = *(const LAS v4u*)(St + (n & 1) * (16 * 136) + row * 136 + chunk * 8);
                *(GAS v4u*)(SG + ((size_t)(hh * NCHUNK + n * SGSTEP) * 128 + 16 * sl + row) * 128 + chunk * 8) = v;
                asm volatile("s_waitcnt lgkmcnt(0)" ::: "memory"); __builtin_amdgcn_s_barrier(); asm volatile("" ::: "memory");
            }
        } else {
            f32x4 Sv[2] = {{0.f, 0.f, 0.f, 0.f}, {0.f, 0.f, 0.f, 0.f}};
            bf16x8 A0[2][4], A1[2][4], A2[2][4], A3[2][4]; u32x2v C0[2], C1[2], C2[2], C3[2]; float d0, d1, d2, d3;
#define G2_LOAD(AX, CX, DX, nn) do { const int u_ = hh * NS + (nn); \
            _Pragma("unroll") for (int t = 0; t < 2; ++t) { \
                _Pragma("unroll") for (int kk = 0; kk < 4; ++kk) AX[t][kk] = ld16g(MP + ((size_t)u_ * 128 + 32 * w + 16 * t + r16) * 128 + 32 * kk + 8 * g); \
                CX[t] = *(const GAS u32x2v*)(NT + ((size_t)u_ * 128 + 16 * sl + r16) * 128 + 32 * w + 16 * t + 4 * g); } \
            DX = *(const GAS float*)(dn + (nn) * 8 + hh); } while (0)
#ifdef PROBE_G2_NOLOAD
#define G2_STEPLOAD(AL, CL, DL, nn) do { if (args_use_bar) G2_LOAD(AL, CL, DL, nn); } while (0)
#else
#define G2_STEPLOAD(AL, CL, DL, nn) G2_LOAD(AL, CL, DL, nn)
#endif
#define G2_STEP(AU, CU, DU, AL, CL, DL, nn) do { const int n_ = (nn); const int n2_ = (n_ + 3 < NS) ? n_ + 3 : NS - 1; \
            G2_STEPLOAD(AL, CL, DL, n2_); \
            LAS bf16* Sc = St + (n_ & 1) * (16 * 136); LAS bf16* Sn = St + ((n_ & 1) ^ 1) * (16 * 136); \
            f32x4 D0 = {bflo(CU[0].x), bfhi(CU[0].x), bflo(CU[0].y), bfhi(CU[0].y)}, D1 = {bflo(CU[1].x), bfhi(CU[1].x), bflo(CU[1].y), bfhi(CU[1].y)}; \
            _Pragma("unroll") for (int kk = 0; kk < 4; ++kk) { const bf16x8 Bf = *(const LAS bf16x8*)(Sc + r16 * 136 + 32 * kk + 8 * g); D0 = MF16(AU[0][kk], Bf, D0); D1 = MF16(AU[1][kk], Bf, D1); } \
            Sv[0] = Sv[0] * DU + D0; Sv[1] = Sv[1] * DU + D1; \
            { u32x2v o; o.x = cvtpk(Sv[0][0], Sv[0][1]); o.y = cvtpk(Sv[0][2], Sv[0][3]); *(LAS u32x2v*)(Sn + r16 * 136 + 32 * w + 4 * g) = o; \
              o.x = cvtpk(Sv[1][0], Sv[1][1]); o.y = cvtpk(Sv[1][2], Sv[1][3]); *(LAS u32x2v*)(Sn + r16 * 136 + 32 * w + 16 + 4 * g) = o; } \
            asm volatile("s_waitcnt lgkmcnt(0)" ::: "memory"); __builtin_amdgcn_s_barrier(); asm volatile("" ::: "memory"); } while (0)
            G2_LOAD(A0, C0, d0, 0); G2_LOAD(A1, C1, d1, 1); G2_LOAD(A2, C2, d2, 2);
            static_assert(NS % 24 == 16, "scan loop: trips of 24 steps + a 16-step tail");
            int n = 0;
#pragma unroll 1
            for (; n + 24 <= NS - 16; n += 24) {
                G2_STEP(A0, C0, d0, A3, C3, d3, n + 0);
                G2_STEP(A1, C1, d1, A0, C0, d0, n + 1);
                G2_STEP(A2, C2, d2, A1, C1, d1, n + 2);
                G2_STEP(A3, C3, d3, A2, C2, d2, n + 3);
                G2_STEP(A0, C0, d0, A3, C3, d3, n + 4);
                G2_STEP(A1, C1, d1, A0, C0, d0, n + 5);
                G2_STEP(A2, C2, d2, A1, C1, d1, n + 6);
                G2_STEP(A3, C3, d3, A2, C2, d2, n + 7);
                G2_STEP(A0, C0, d0, A3, C3, d3, n + 8);
                G2_STEP(A1, C1, d1, A0, C0, d0, n + 9);
                G2_STEP(A2, C2, d2, A1, C1, d1, n + 10);
                G2_STEP(A3, C3, d3, A2, C2, d2, n + 11);
                G2_STEP(A0, C0, d0, A3, C3, d3, n + 12);
                G2_STEP(A1, C1, d1, A0, C0, d0, n + 13);
                G2_STEP(A2, C2, d2, A1, C1, d1, n + 14);
                G2_STEP(A3, C3, d3, A2, C2, d2, n + 15);
                G2_STEP(A0, C0, d0, A3, C3, d3, n + 16);
                G2_STEP(A1, C1, d1, A0, C0, d0, n + 17);
                G2_STEP(A2, C2, d2, A1, C1, d1, n + 18);
                G2_STEP(A3, C3, d3, A2, C2, d2, n + 19);
                G2_STEP(A0, C0, d0, A3, C3, d3, n + 20);
                G2_STEP(A1, C1, d1, A0, C0, d0, n + 21);
                G2_STEP(A2, C2, d2, A1, C1, d1, n + 22);
                G2_STEP(A3, C3, d3, A2, C2, d2, n + 23);
            }
            G2_STEP(A0, C0, d0, A3, C3, d3, n + 0);
            G2_STEP(A1, C1, d1, A0, C0, d0, n + 1);
            G2_STEP(A2, C2, d2, A1, C1, d1, n + 2);
            G2_STEP(A3, C3, d3, A2, C2, d2, n + 3);
            G2_STEP(A0, C0, d0, A3, C3, d3, n + 4);
            G2_STEP(A1, C1, d1, A0, C0, d0, n + 5);
            G2_STEP(A2, C2, d2, A1, C1, d1, n + 6);
            G2_STEP(A3, C3, d3, A2, C2, d2, n + 7);
            G2_STEP(A0, C0, d0, A3, C3, d3, n + 8);
            G2_STEP(A1, C1, d1, A0, C0, d0, n + 9);
            G2_STEP(A2, C2, d2, A1, C1, d1, n + 10);
            G2_STEP(A3, C3, d3, A2, C2, d2, n + 11);
            G2_STEP(A0, C0, d0, A3, C3, d3, n + 12);
            G2_STEP(A1, C1, d1, A0, C0, d0, n + 13);
            G2_STEP(A2, C2, d2, A1, C1, d1, n + 14);
            G2_STEP(A3, C3, d3, A2, C2, d2, n + 15);
#undef G2_STEP
#undef G2_LOAD
        }
    }
}


constexpr int GST_PAIR = 128 * 136, GST_BYTES = 2 * GST_PAIR * 2, GW_BYTES = 8704;
static_assert(GST_BYTES + 8 * GW_BYTES <= LDSCTL_OFF, "group-phase LDS map");
__device__ __forceinline__ void g_stage_mp(const Frame& F, const bf16* MP, int uh0, int uh1, bool on0, bool on1) {
    LAS bf16* st = (LAS bf16*)F.lds;
#pragma unroll
    for (int q = 0; q < 4; ++q) { const int idx = F.tid + 512 * q, row = idx >> 4, ch = idx & 15;
        v4u v0 = {0u, 0u, 0u, 0u}, v1 = v0;
        if (on0) v0 = *(const GAS v4u*)(MP + ((size_t)uh0 * 128 + row) * 128 + ch * 8);
        if (on1) v1 = *(const GAS v4u*)(MP + ((size_t)uh1 * 128 + row) * 128 + ch * 8);
        *(LAS v4u*)(st + row * 136 + ch * 8) = v0; *(LAS v4u*)(st + GST_PAIR + row * 136 + ch * 8) = v1; }
}
__device__ __forceinline__ void p_g1b(const Frame& F, const Args& a) {
    GAS unsigned char* ws = (GAS unsigned char*)a.ws; asm volatile("" : "+s"(ws)); int lane_ = F.lane; asm volatile("" : "+v"(lane_)); const int lane = lane_, r16 = lane & 15, g = lane >> 4;
    const bf16 *MP = (const bf16*)(ws + WS_ARENA + AR_MP), *NT = (const bf16*)(ws + WS_ARENA + AR_NT); const float* dn = (const float*)(ws + WS_TOK + TOK_DN);
    bf16 *MPc = (bf16*)(ws + WS_ARENA + AR_MPC), *NTc = (bf16*)(ws + WS_ARENA + AR_NTC); float* dnc = (float*)(ws + WS_TOK + TOK_DNC);
    const bool isB = F.wave >= 4; const int sl = F.wave & 3, c0 = 32 * sl;
    const LAS bf16* stg = (const LAS bf16*)F.lds; LAS bf16* wa = (LAS bf16*)(F.lds + GST_BYTES + F.wave * GW_BYTES);
#pragma unroll 1
    for (int tp = F.vcu; tp < 512; tp += F.G) {
        const int hh = tp & 7, gq = tp >> 3;
        f32x4 X[8][2]; float Dd = 1.0f;
#pragma unroll
        for (int mt = 0; mt < 8; ++mt)
#pragma unroll
            for (int nt = 0; nt < 2; ++nt) X[mt][nt] = (f32x4){0.f, 0.f, 0.f, 0.f};
#pragma unroll 1
        for (int i = 0; i < 4; ++i) {
            const int uh = hh * NCHUNK + 4 * gq + i; const float di = *(const GAS float*)(dn + (4 * gq + i) * 8 + hh);
            bf16x8 xo[4][2]; const float dadd = isB ? 0.0f : Dd;
#pragma unroll
            for (int s = 0; s < 4; ++s)
#pragma unroll
                for (int nt = 0; nt < 2; ++nt) { v4u pr; const int col = c0 + 16 * nt + r16; f32x4 t0 = X[2 * s][nt], t1 = X[2 * s + 1][nt];
#pragma unroll
                    for (int r = 0; r < 4; ++r) { if (32 * s + 4 * g + r == col) t0[r] += dadd; if (32 * s + 16 + 4 * g + r == col) t1[r] += dadd; }
                    pr.x = cvtpk(t0[0], t0[1]); pr.y = cvtpk(t0[2], t0[3]); pr.z = cvtpk(t1[0], t1[1]); pr.w = cvtpk(t1[2], t1[3]); xo[s][nt] = __builtin_bit_cast(bf16x8, pr); }
            __syncthreads();
            {
                LAS bf16* st = (LAS bf16*)F.lds;
#pragma unroll
                for (int q = 0; q < 4; ++q) { const int idx = F.tid + 512 * q, row = idx >> 4, ch = idx & 15; const v4u v = *(const GAS v4u*)(MP + ((size_t)uh * 128 + row) * 128 + ch * 8); *(LAS v4u*)(st + row * 136 + ch * 8) = v; }
            }
            if (isB) {
#pragma unroll
                for (int q = 0; q < 8; ++q) { const int row = 4 * q + (lane >> 4), ch = lane & 15; const v4u v = *(const GAS v4u*)(NT + ((size_t)uh * 128 + c0 + row) * 128 + ch * 8); *(LAS v4u*)(wa + row * 136 + ch * 8) = v; }
            }
            __syncthreads();
#pragma unroll
            for (int mt = 0; mt < 8; ++mt) {
                bf16x8 af[4];
#pragma unroll
                for (int s = 0; s < 4; ++s) { const LAS bf16* rp = stg + (16 * mt + r16) * 136 + 32 * s + 4 * g; const u32x2v lo = *(const LAS u32x2v*)rp, hi = *(const LAS u32x2v*)(rp + 16);
                    const v4u pk = {lo.x, lo.y, hi.x, hi.y}; af[s] = __builtin_bit_cast(bf16x8, pk); }
#pragma unroll
                for (int nt = 0; nt < 2; ++nt) { f32x4 acc = X[mt][nt] * di;
                    if (isB) { const u32x2v nn = *(const LAS u32x2v*)(wa + (16 * nt + r16) * 136 + 16 * mt + 4 * g); acc = acc + (f32x4){bflo(nn.x), bfhi(nn.x), bflo(nn.y), bfhi(nn.y)}; }
#pragma unroll
                    for (int s = 0; s < 4; ++s) acc = MF16(af[s], xo[s][nt], acc);
                    X[mt][nt] = acc; }
                asm volatile("" ::: "memory");
            }
            Dd *= di;
        }
        const int uc = hh * 64 + gq;
        if (isB) {
#pragma unroll
            for (int mt = 0; mt < 8; ++mt)
#pragma unroll
                for (int nt = 0; nt < 2; ++nt) st8(NTc + ((size_t)uc * 128 + c0 + 16 * nt + r16) * 128 + 16 * mt + 4 * g, X[mt][nt][0], X[mt][nt][1], X[mt][nt][2], X[mt][nt][3]);
        } else {
            if (sl == 0 && lane == 0) dnc[gq * 8 + hh] = Dd;
#pragma unroll
            for (int hf = 0; hf < 2; ++hf) {
                asm volatile("s_waitcnt lgkmcnt(0)" ::: "memory");
#pragma unroll
                for (int m4 = 0; m4 < 4; ++m4)
#pragma unroll
                    for (int nt = 0; nt < 2; ++nt)
#pragma unroll
                        for (int r = 0; r < 4; ++r) wa[(16 * m4 + 4 * g + r) * 40 + 16 * nt + r16] = (unsigned short)(cvtpk(X[4 * hf + m4][nt][r], 0.f) & 0xffffu);
                asm volatile("s_waitcnt lgkmcnt(0)" ::: "memory");
#pragma unroll
                for (int q = 0; q < 4; ++q) { const int row = 16 * q + (lane >> 2), ch = lane & 3; const v4u v = *(const LAS v4u*)(wa + row * 40 + ch * 8);
                    *(GAS v4u*)(MPc + ((size_t)uc * 128 + 64 * hf + row) * 128 + c0 + ch * 8) = v; }
            }
        }
    }
    __syncthreads();
}

__device__ __forceinline__ void p_g2b(const Frame& F, const Args& a) {
    GAS unsigned char* ws = (GAS unsigned char*)a.ws; asm volatile("" : "+s"(ws)); int lane_ = F.lane; asm volatile("" : "+v"(lane_)); const int lane = lane_, r16 = lane & 15, g = lane >> 4;
    const bf16 *MP = (const bf16*)(ws + WS_ARENA + AR_MP), *NT = (const bf16*)(ws + WS_ARENA + AR_NT); const float* dn = (const float*)(ws + WS_TOK + TOK_DN); bf16* SG = (bf16*)(ws + WS_ARENA + AR_SG);
    const int pw = F.wave >> 2, qf = F.wave & 3, c0 = 32 * qf;
    const LAS bf16* stg = (const LAS bf16*)F.lds + pw * GST_PAIR; LAS bf16* Sl = (LAS bf16*)(F.lds + GST_BYTES + F.wave * GW_BYTES);
#pragma unroll 1
    for (int tp0 = 2 * F.vcu; tp0 < 512; tp0 += 2 * F.G) {
        const int tp = tp0 + pw; const bool on = tp < 512; const int tpc = on ? tp : 0, hh = tpc & 7, gq = tpc >> 3;
        const int tpa = tp0, tpb = tp0 + 1;
        { const int u0 = hh * NCHUNK + 4 * gq;
#pragma unroll
          for (int q = 0; q < 8; ++q) { const int row = 4 * q + (lane >> 4), ch = lane & 15; const v4u v = *(const GAS v4u*)(SG + ((size_t)u0 * 128 + c0 + row) * 128 + ch * 8); *(LAS v4u*)(Sl + row * 136 + ch * 8) = v; } }
#pragma unroll 1
        for (int i = 0; i < 3; ++i) {
            __syncthreads();
            g_stage_mp(F, MP, (tpa & 7) * NCHUNK + 4 * (tpa >> 3) + i, (tpb & 7) * NCHUNK + 4 * ((tpb < 512 ? tpb : 0) >> 3) + i, tpa < 512, tpb < 512);
            const int uh = hh * NCHUNK + 4 * gq + i; const float di = *(const GAS float*)(dn + (4 * gq + i) * 8 + hh);
            u32x2v nn[8][2];
#pragma unroll
            for (int mt = 0; mt < 8; ++mt)
#pragma unroll
                for (int nt = 0; nt < 2; ++nt) nn[mt][nt] = *(const GAS u32x2v*)(NT + ((size_t)uh * 128 + c0 + 16 * nt + r16) * 128 + 16 * mt + 4 * g);
            bf16x8 Bf[2][4];
#pragma unroll
            for (int nt = 0; nt < 2; ++nt)
#pragma unroll
                for (int s = 0; s < 4; ++s) Bf[nt][s] = *(const LAS bf16x8*)(Sl + (16 * nt + r16) * 136 + 32 * s + 8 * g);
            __syncthreads();
            f32x4 acc[8][2];
#pragma unroll
            for (int mt = 0; mt < 8; ++mt) {
                bf16x8 af[4];
#pragma unroll
                for (int s = 0; s < 4; ++s) af[s] = *(const LAS bf16x8*)(stg + (16 * mt + r16) * 136 + 32 * s + 8 * g);
#pragma unroll
                for (int nt = 0; nt < 2; ++nt) {
                    const u32x2v so = *(const LAS u32x2v*)(Sl + (16 * nt + r16) * 136 + 16 * mt + 4 * g);
                    f32x4 Dv = {bflo(nn[mt][nt].x) + di * bflo(so.x), bfhi(nn[mt][nt].x) + di * bfhi(so.x), bflo(nn[mt][nt].y) + di * bflo(so.y), bfhi(nn[mt][nt].y) + di * bfhi(so.y)};
#pragma unroll
                    for (int s = 0; s < 4; ++s) Dv = MF16(af[s], Bf[nt][s], Dv);
                    acc[mt][nt] = Dv;
                }
            }
            asm volatile("s_waitcnt lgkmcnt(0)" ::: "memory");
#pragma unroll
            for (int mt = 0; mt < 8; ++mt)
#pragma unroll
                for (int nt = 0; nt < 2; ++nt) { u32x2v o; o.x = cvtpk(acc[mt][nt][0], acc[mt][nt][1]); o.y = cvtpk(acc[mt][nt][2], acc[mt][nt][3]);
                    *(LAS u32x2v*)(Sl + (16 * nt + r16) * 136 + 16 * mt + 4 * g) = o;
                    if (on) *(GAS u32x2v*)(SG + ((size_t)(uh + 1) * 128 + c0 + 16 * nt + r16) * 128 + 16 * mt + 4 * g) = o; }
            asm volatile("s_waitcnt lgkmcnt(0)" ::: "memory");
        }
    }
    __syncthreads();
}

__device__ __forceinline__ void p_g3(const Frame& F, const Args& a, int L) {
    GAS unsigned char* ws = (GAS unsigned char*)a.ws; asm volatile("" : "+s"(ws)); int lane_ = F.lane; asm volatile("" : "+v"(lane_)); const int j = L >> 1, lane = lane_, r16 = lane & 15, g = lane >> 4;
    const bf16 *PO = (const bf16*)(ws + WS_ARENA + AR_PO), *QT = (const bf16*)(ws + WS_ARENA + AR_QT), *AI = (const bf16*)(ws + WS_ARENA + AR_AI), *NEGW = (const bf16*)(ws + WS_ARENA + AR_NEGW),
               *UT = (const bf16*)(ws + WS_ARENA + AR_UT), *SG = (const bf16*)(ws + WS_ARENA + AR_SG);
    bf16* mix = (bf16*)(ws + WS_MIX); const float* onorm = (const float*)a.in[19] + j * 128;
    const f32x4 Z4 = {0.f, 0.f, 0.f, 0.f};
#pragma unroll 1
    for (int u = F.gw; u < NUNIT; u += F.NGW) {
        const int n = u >> 3, hh = u & 7, tok0 = 64 * n; const int uh = hh * NCHUNK + n;
        unsigned vn[8][4][2];
        {
            bf16x8 nw[4][4];
#pragma unroll
            for (int jt = 0; jt < 4; ++jt)
#pragma unroll
                for (int kk = 0; kk < 4; ++kk) nw[jt][kk] = ld16g(NEGW + (size_t)(tok0 + 16 * jt + r16) * D_ + hh * 128 + 32 * kk + 8 * g);
#pragma unroll
            for (int d2t = 0; d2t < 8; ++d2t) {
                bf16x8 sg[4];
#pragma unroll
                for (int kk = 0; kk < 4; ++kk) sg[kk] = ld16g(SG + ((size_t)uh * 128 + 16 * d2t + r16) * 128 + 32 * kk + 8 * g);
#pragma unroll
                for (int jt = 0; jt < 4; ++jt) {
                    const u32x2v c = *(const GAS u32x2v*)(UT + ((size_t)u * 128 + 16 * d2t + r16) * 64 + 16 * jt + 4 * g);
                    f32x4 Dv = {bflo(c.x), bfhi(c.x), bflo(c.y), bfhi(c.y)};
#pragma unroll
                    for (int kk = 0; kk < 4; ++kk) Dv = MF16(nw[jt][kk], sg[kk], Dv);
                    vn[d2t][jt][0] = cvtpk(Dv[0], Dv[1]); vn[d2t][jt][1] = cvtpk(Dv[2], Dv[3]);
                    asm volatile("" : "+v"(vn[d2t][jt][0]), "+v"(vn[d2t][jt][1]));
                }
                asm volatile("" ::: "memory");
            }
        }
#pragma unroll 1
        for (int ti = 0; ti < 4; ++ti) {
            const int tok = tok0 + 16 * ti + r16;
            bf16x8 qf[4], af[2];
#pragma unroll
            for (int kk = 0; kk < 4; ++kk) qf[kk] = ld16g(QT + (size_t)tok * D_ + hh * 128 + 32 * kk + 8 * g);
#pragma unroll
            for (int k2 = 0; k2 < 2; ++k2) { const u32x2v lo = *(const GAS u32x2v*)(AI + ((size_t)u * 64 + 16 * ti + r16) * 64 + 32 * k2 + 4 * g), hi = *(const GAS u32x2v*)(AI + ((size_t)u * 64 + 16 * ti + r16) * 64 + 32 * k2 + 16 + 4 * g);
                const v4u pk = {lo.x, lo.y, hi.x, hi.y}; af[k2] = __builtin_bit_cast(bf16x8, pk); }
            f32x4 acc[8]; float ss = 0.f;
#pragma unroll
            for (int d2t = 0; d2t < 8; ++d2t) {
                f32x4 Dv = Z4;
#pragma unroll
                for (int kk = 0; kk < 4; ++kk) { const bf16x8 sgf = ld16g(SG + ((size_t)uh * 128 + 16 * d2t + r16) * 128 + 32 * kk + 8 * g); Dv = MF16(sgf, qf[kk], Dv); }
#pragma unroll
                for (int k2 = 0; k2 < 2; ++k2) { const v4u pk = {vn[d2t][2 * k2][0], vn[d2t][2 * k2][1], vn[d2t][2 * k2 + 1][0], vn[d2t][2 * k2 + 1][1]}; Dv = MF16(__builtin_bit_cast(bf16x8, pk), af[k2], Dv); }
                acc[d2t] = Dv; ss += (Dv[0] * Dv[0] + Dv[1] * Dv[1]) + (Dv[2] * Dv[2] + Dv[3] * Dv[3]);
            }
            ss += __shfl_xor(ss, 16); ss += __shfl_xor(ss, 32);
            const float rms = __builtin_amdgcn_rsqf(ss * (1.0f / 128.0f) + RMS_EPS);
#pragma unroll
            for (int d2t = 0; d2t < 8; ++d2t) {
                const u32x2v z = *(const GAS u32x2v*)(PO + (size_t)tok * OIN + 3072 + hh * 128 + 16 * d2t + 4 * g); const f32x4 gn = *(const GAS f32x4*)(onorm + 16 * d2t + 4 * g);
                st8(mix + (size_t)tok * D_ + hh * 128 + 16 * d2t + 4 * g, acc[d2t][0] * rms * gn[0] * silu(bflo(z.x)), acc[d2t][1] * rms * gn[1] * silu(bfhi(z.x)),
                    acc[d2t][2] * rms * gn[2] * silu(bflo(z.y)), acc[d2t][3] * rms * gn[3] * silu(bfhi(z.y)));
            }
        }
    }
}

__device__ __forceinline__ void p_r1(const Frame& F, const Args& a, int L) {
    GAS unsigned char* ws = (GAS unsigned char*)a.ws; asm volatile("" : "+s"(ws)); int lane_ = F.lane; asm volatile("" : "+v"(lane_)); const int j = L >> 1, lane = lane_;
    const float* ssq = (const float*)(ws + WS_SSQA); const float* wr = (const float*)a.in[24] + (size_t)j * D_ * NEXP; const float* ln = (const float*)a.in[4] + L * D_;
    int* tok_e = (int*)(ws + WS_TOK + TOK_E); int* tok_r = (int*)(ws + WS_TOK + TOK_R); float* tok_g = (float*)(ws + WS_TOK + TOK_G);
    unsigned* gcount = (unsigned*)(ws + WS_CTL) + CW_CNT + 64 * j;
    LAS int* rt = (LAS int*)(F.lds + RT_OFF);
    if (F.tid < 16) rt[F.tid] = 0;
    __syncthreads();
    const GAS float* hG = (const GAS float*)a.out; const GAS float* wrG = (const GAS float*)wr; const GAS float* lnG = (const GAS float*)ln;
    float lnr[16];
#pragma unroll
    for (int i = 0; i < 16; ++i) lnr[i] = lnG[64 * i + lane];
#pragma unroll 1
    for (int t = F.gw; t < S_; t += 2 * F.NGW) {
        const int tb = t + F.NGW; const bool hasb = tb < S_; const int tbc = hasb ? tb : t;
        float xa[16], xb[16];
#pragma unroll
        for (int i = 0; i < 16; ++i) { xa[i] = hG[(size_t)t * D_ + 64 * i + lane]; xb[i] = hG[(size_t)tbc * D_ + 64 * i + lane]; }
        const float rsa = pg8::rstd_row(ssq, t), rsb = pg8::rstd_row(ssq, tbc);
        float acca[8], accb[8];
#pragma unroll
        for (int e = 0; e < 8; ++e) { acca[e] = 0.f; accb[e] = 0.f; }
#pragma unroll
        for (int i = 0; i < 16; ++i) { const int k = 64 * i + lane; const f32x4 w0 = *(const GAS f32x4*)(wrG + (size_t)k * 8), w1 = *(const GAS f32x4*)(wrG + (size_t)k * 8 + 4);
            const float x = xa[i] * lnr[i], y = xb[i] * lnr[i];
            acca[0] += x * w0[0]; acca[1] += x * w0[1]; acca[2] += x * w0[2]; acca[3] += x * w0[3]; acca[4] += x * w1[0]; acca[5] += x * w1[1]; acca[6] += x * w1[2]; acca[7] += x * w1[3];
            accb[0] += y * w0[0]; accb[1] += y * w0[1]; accb[2] += y * w0[2]; accb[3] += y * w0[3]; accb[4] += y * w1[0]; accb[5] += y * w1[1]; accb[6] += y * w1[2]; accb[7] += y * w1[3]; }
#pragma unroll
        for (int e = 0; e < 8; ++e) { acca[e] = wave_sum(acca[e]) * rsa; accb[e] = wave_sum(accb[e]) * rsb; }
#pragma unroll
        for (int half = 0; half < 2; ++half) {
            if (half == 1 && !hasb) break;
            const int tt = half ? tb : t; float acc[8];
#pragma unroll
            for (int e = 0; e < 8; ++e) acc[e] = half ? accb[e] : acca[e];
            int e0 = 0; float l0 = acc[0];
#pragma unroll
            for (int e = 1; e < 8; ++e) if (acc[e] > l0) { l0 = acc[e]; e0 = e; }
            int e1 = -1; float l1 = -INFINITY;
#pragma unroll
            for (int e = 0; e < 8; ++e) if (e != e0 && acc[e] > l1) { l1 = acc[e]; e1 = e; }
            const float g1 = 1.0f / (1.0f + expf(l0 - l1)), g0 = 1.0f - g1;
            if (lane == 0) {
                const int r0 = __hip_atomic_fetch_add(rt + e0, 1, __ATOMIC_RELAXED, __HIP_MEMORY_SCOPE_WORKGROUP), r1 = __hip_atomic_fetch_add(rt + e1, 1, __ATOMIC_RELAXED, __HIP_MEMORY_SCOPE_WORKGROUP);
                tok_e[2 * tt] = e0; tok_e[2 * tt + 1] = e1; tok_r[2 * tt] = r0; tok_r[2 * tt + 1] = r1; tok_g[2 * tt] = g0; tok_g[2 * tt + 1] = g1;
            }
        }
    }
    __syncthreads();
    if (F.tid < 8) rt[8 + F.tid] = (int)__hip_atomic_fetch_add(gcount + F.tid, (unsigned)rt[F.tid], __ATOMIC_RELAXED, __HIP_MEMORY_SCOPE_AGENT);
    __syncthreads();
#pragma unroll 1
    for (int t = F.gw; t < S_; t += F.NGW) if (lane < 2) { const int e = tok_e[2 * t + lane]; tok_r[2 * t + lane] += rt[8 + e]; }
    __syncthreads();
}
__device__ __forceinline__ int moe_pstart(const unsigned* gcount, int e) {
    int ps = 0;
#pragma unroll
    for (int q = 0; q < 8; ++q) { const int c = (int)gcount[q]; if (q < e) ps += ((c + 255) >> 8) << 8; }
    return ps;
}
__device__ __forceinline__ void p_r2(const Frame& F, const Args& a, int L) {
    GAS unsigned char* ws = (GAS unsigned char*)a.ws; asm volatile("" : "+s"(ws)); int lane_ = F.lane; asm volatile("" : "+v"(lane_)); const int j = L >> 1, lane = lane_;
    const float* ssq = (const float*)(ws + WS_SSQA);
    const int* tok_e = (const int*)(ws + WS_TOK + TOK_E); const int* tok_r = (const int*)(ws + WS_TOK + TOK_R); const float* tok_g = (const float*)(ws + WS_TOK + TOK_G);
    int* dst = (int*)(ws + WS_TOK + TOK_DST); float* gpad = (float*)(ws + WS_TOK + TOK_GPAD);
    const unsigned* gcount = (const unsigned*)(ws + WS_CTL) + CW_CNT + 64 * j; bf16* XS = (bf16*)(ws + WS_ARENA + AR_XS);
    int pst[8]; { int ps = 0;
#pragma unroll
        for (int q = 0; q < 8; ++q) { pst[q] = ps; ps += (((int)gcount[q] + 255) >> 8) << 8; } }
    const GAS float* hG = (const GAS float*)a.out;
#pragma unroll 1
    for (int t0 = F.gw; t0 < S_; t0 += 4 * F.NGW) {
        int tt[4], da[4], db[4]; float rs[4], ga[4], gb[4]; f32x4 v[4][4];
#pragma unroll
        for (int u = 0; u < 4; ++u) { const int t = t0 + u * F.NGW; tt[u] = t < S_ ? t : t0;
#pragma unroll
            for (int q = 0; q < 4; ++q) v[u][q] = *((const GAS f32x4*)(hG + (size_t)tt[u] * D_) + 64 * q + lane); }
#pragma unroll
        for (int u = 0; u < 4; ++u) { const int t = tt[u]; rs[u] = pg8::rstd_row(ssq, t);
            const int ea = tok_e[2 * t], eb = tok_e[2 * t + 1]; int pa = 0, pb = 0;
#pragma unroll
            for (int q = 0; q < 8; ++q) { pa = (q == ea) ? pst[q] : pa; pb = (q == eb) ? pst[q] : pb; }
            da[u] = pa + tok_r[2 * t]; db[u] = pb + tok_r[2 * t + 1]; ga[u] = tok_g[2 * t]; gb[u] = tok_g[2 * t + 1]; }
#pragma unroll
        for (int u = 0; u < 4; ++u) { if (t0 + u * F.NGW >= S_) break; const int t = tt[u];
            if (lane == 0) { dst[2 * t] = da[u]; dst[2 * t + 1] = db[u]; gpad[da[u]] = ga[u]; gpad[db[u]] = gb[u]; }
#pragma unroll
            for (int q = 0; q < 4; ++q) { const f32x4 x = v[u][q] * rs[u]; u32x2v o; o.x = cvtpk(x[0], x[1]); o.y = cvtpk(x[2], x[3]);
                *((GAS u32x2v*)(XS + (size_t)da[u] * D_) + 64 * q + lane) = o; *((GAS u32x2v*)(XS + (size_t)db[u] * D_) + 64 * q + lane) = o; } }
    }
}
__device__ __forceinline__ int moe_blocks(const Frame& F, const Args& a, int L) {
    const unsigned* gcount = (const unsigned*)(a.ws + WS_CTL) + CW_CNT + 64 * (L >> 1);
    LAS int* blk = (LAS int*)(F.lds + BLKE_OFF);
    int nb_tot = 0, mine = 7;
#pragma unroll
    for (int q = 0; q < 8; ++q) { const int nb = ((int)gcount[q] + 255) >> 8; if (F.tid >= nb_tot && F.tid < nb_tot + nb) mine = q; nb_tot += nb; }
    __syncthreads();
    if (F.tid < 160) blk[F.tid] = mine;
    __syncthreads();
    return nb_tot;
}
__device__ __forceinline__ void p_combine(const Frame& F, const Args& a) {
    GAS unsigned char* ws = (GAS unsigned char*)a.ws; asm volatile("" : "+s"(ws)); int lane_ = F.lane; asm volatile("" : "+v"(lane_)); const int lane = lane_;
    const int* dst = (const int*)(ws + WS_TOK + TOK_DST); const bf16* Y = (const bf16*)(ws + WS_ARENA + AR_Y); bf16* hb = (bf16*)(ws + WS_HBF); float* ssq = (float*)(ws + WS_SSQA);
    const GAS float* hG = (const GAS float*)a.out;
#pragma unroll 1
    for (int t0 = F.gw; t0 < S_; t0 += 2 * F.NGW) {
        int tt[2], da[2], db[2]; f32x4 v[2][4]; u32x2v ya[2][4], yb[2][4];
#pragma unroll
        for (int u = 0; u < 2; ++u) { const int t = t0 + u * F.NGW; tt[u] = t < S_ ? t : t0; da[u] = dst[2 * tt[u]]; db[u] = dst[2 * tt[u] + 1];
#pragma unroll
            for (int q = 0; q < 4; ++q) v[u][q] = *((const GAS f32x4*)(hG + (size_t)tt[u] * D_) + 64 * q + lane); }
#pragma unroll
        for (int u = 0; u < 2; ++u)
#pragma unroll
            for (int q = 0; q < 4; ++q) { ya[u][q] = *((const GAS u32x2v*)(Y + (size_t)da[u] * D_) + 64 * q + lane); yb[u][q] = *((const GAS u32x2v*)(Y + (size_t)db[u] * D_) + 64 * q + lane); }
#pragma unroll
        for (int u = 0; u < 2; ++u) { if (t0 + u * F.NGW >= S_) break; const int t = tt[u]; float ss = 0.f;
#pragma unroll
            for (int q = 0; q < 4; ++q) { f32x4 x = v[u][q];
                x[0] += bflo(ya[u][q].x) + bflo(yb[u][q].x); x[1] += bfhi(ya[u][q].x) + bfhi(yb[u][q].x); x[2] += bflo(ya[u][q].y) + bflo(yb[u][q].y); x[3] += bfhi(ya[u][q].y) + bfhi(yb[u][q].y);
                *((GAS f32x4*)(a.out + (size_t)t * D_) + 64 * q + lane) = x; ss += (x[0] * x[0] + x[1] * x[1]) + (x[2] * x[2] + x[3] * x[3]);
                u32x2v o; o.x = cvtpk(x[0], x[1]); o.y = cvtpk(x[2], x[3]); *((GAS u32x2v*)(hb + (size_t)t * D_) + 64 * q + lane) = o; }
            ss = wave_sum(ss);
            if (lane < 16) ssq[(size_t)t * 16 + lane] = (lane == 0) ? ss : 0.f; }
    }
}
__device__ __forceinline__ void p_final(const Frame& F, const Args& a) {
    GAS unsigned char* ws = (GAS unsigned char*)a.ws; asm volatile("" : "+s"(ws)); int lane_ = F.lane; asm volatile("" : "+v"(lane_)); const int lane = lane_; const float* ssq = (const float*)(ws + WS_SSQB); const float* ln = (const float*)a.in[6];
#pragma unroll 1
    for (int t = F.gw; t < S_; t += F.NGW) { const float rs = pg8::rstd_row(ssq, t);
#pragma unroll
        for (int q = 0; q < 4; ++q) { GAS f32x4* hp = (GAS f32x4*)(a.out + (size_t)t * D_) + 64 * q + lane; const f32x4 gq = *((const GAS f32x4*)ln + 64 * q + lane); *hp = (*hp) * rs * gq; } }
}
__device__ __forceinline__ void p_moe_weights(const Frame& F, const Args& a, int L, int w0, int nw) {
    LAS float* scr = (LAS float*)(F.lds + F.wave * WAVE_LDS);
    int base = 0;
#pragma unroll 1
    for (int id = 0; id < 24; ++id) { const MatD m = moe_mat(a, L >> 1, id);
        int first = (w0 - base) % nw; if (first < 0) first += nw;
#pragma unroll 1
        for (int it = first; it < m.items; it += nw) xpose_item(m.W, m.ldw, m.K, m.N, m.gain, m.WT, m.ilv, scr, it, F.lane);
        base += m.items; }
}

constexpr int P_PRO = 0, P_FINAL = 81, LP_ROT = 16, LP_G1B = 17, LP_G2B = 18, LPN = 20, LP_PROJ = 0, LP_ATT = 1, LP_MIXPREP = 2, LP_GA = 3, LP_G1 = 4, LP_G2 = 5, LP_G3 = 6, LP_OUT = 7, LP_UP = 8, LP_DOWN = 9, LP_R1 = 10, LP_R2 = 11, LP_M1 = 12, LP_M2 = 13, LP_COMB = 14, LP_PLE = 15;

#ifndef PH_MASK
#define PH_MASK 0xffffffffull
#endif
#define IN(k) (lo <= (k) && (k) < hi)
#define INL(lp) ((((unsigned long long)(PH_MASK) >> (lp)) & 1) && lo <= pb + (lp) && pb + (lp) < hi)
#define SEAM() do { if (args.use_bar) xcd_barrier(bar); } while (0)
#ifndef REP_LP
#define REP_LP -1
#endif
#ifndef REP_L
#define REP_L -1
#endif
#ifndef REP_N
#define REP_N 2
#endif
#define REPS(lp) ((L == (REP_L) && (lp) == (REP_LP)) ? 1 + (REP_N) : 1)
#if REP_LP >= 0
#define REPLOOP(lp) _Pragma("unroll 1") for (int rep_ = 0; rep_ < REPS(lp); ++rep_)
#else
#define REPLOOP(lp)
#endif
#define PHASE_WS() GAS unsigned char* ws = (GAS unsigned char*)ws0; asm volatile("" : "+s"(ws)); bf16* HBF = (bf16*)(ws + WS_HBF); bf16* MIX = (bf16*)(ws + WS_MIX); bf16* PP = (bf16*)(ws + WS_PP); float* SSQA = (float*)(ws + WS_SSQA); float* SSQB = (float*)(ws + WS_SSQB); (void)HBF; (void)MIX; (void)PP; (void)SSQA; (void)SSQB
template <int L> __device__ __forceinline__ void run_layer(const Frame& F, const Args& args, unsigned char* lds, const XcdBarrier& bar, unsigned char* ws0, const int lo, const int hi, const int cid) {
        const int pb = 1 + LPN * L, j = L >> 1; const bool odd = (L & 1) != 0;
        REPLOOP(LP_PROJ) if (INL(LP_PROJ)) { PHASE_WS();
            if (!odd) {
                pg8::Gemm gm{HBF, (const bf16*)(ws + WS_WINE) + (size_t)j * EIN * D_, S_, EIN, D_, 0}; pg8::StaticOrder So; So.init(S_, EIN, F.G, cid);
                pg8::EpiBf16 E{(bf16*)(ws + WS_ARENA + AR_PE), EIN, SSQB, pg8::C2, 512};
                pg8::gemm_phase<pg8::EpiBf16, pg8::StaticOrder, true, true>(F.lds + RING_OFF, gm, So, E);
            } else {
                pg8::Gemm gm{HBF, (const bf16*)(ws + WS_WINO) + (size_t)j * OIN * D_, S_, OIN, D_, 0}; pg8::StaticOrder So; So.init(S_, OIN, F.G, cid);
                pg8::EpiBf16 E{(bf16*)(ws + WS_ARENA + AR_PO), OIN, SSQB, 1.0f, 0};
                pg8::gemm_phase<pg8::EpiBf16, pg8::StaticOrder, true, true>(F.lds + RING_OFF, gm, So, E);
            }
            {
                pg8::Gemm gm{(const bf16*)(ws + WS_PBF) + (size_t)L * S_ * PLE, (const bf16*)(ws + WS_WP) + (size_t)L * D_ * PLE, S_, D_, PLE, 0}; pg8::StaticOrder So; So.init(S_, D_, F.G, cid);
                pg8::EpiBf16 E{PP, D_, nullptr, 1.0f, 0};
                pg8::gemm_phase<pg8::EpiBf16, pg8::StaticOrder, true, true>(F.lds + RING_OFF, gm, So, E);
            }
            if (odd) p_ab(F, args, L);
            SEAM();
        }
        if (!odd) {
            REPLOOP(LP_ROT) if (INL(LP_ROT)) { PHASE_WS(); p_rot(F, args); SEAM(); }
            REPLOOP(LP_ATT) if (INL(LP_ATT)) { PHASE_WS(); attn_body::attn_phase<8>((char*)lds + RING_OFF, (const attn_body::bf16*)(ws + WS_ARENA + AR_PE), (attn_body::bf16*)(ws + WS_ARENA + AR_AO), F.vcu, F.G); SEAM(); }
            REPLOOP(LP_MIXPREP) if (INL(LP_MIXPREP)) { PHASE_WS(); p_mixprep(F, args, L); SEAM(); }
        } else {
            REPLOOP(LP_GA) if (INL(LP_GA)) { PHASE_WS(); p_ga(F, args, L); SEAM(); }
            REPLOOP(LP_G1) if (INL(LP_G1)) { PHASE_WS(); p_g1(F, args); SEAM(); }
            REPLOOP(LP_G1B) if (INL(LP_G1B)) { PHASE_WS(); p_g1b(F, args); SEAM(); }
            REPLOOP(LP_G2) if (INL(LP_G2)) { PHASE_WS();
                const int nscan = F.G < 64 ? F.G : 64;
#ifdef PROBE_NOCONV
                if (!args.use_bar) { if (F.vcu < nscan) p_g2<64, 4>(F, args, (const bf16*)(ws + WS_ARENA + AR_MPC), (const bf16*)(ws + WS_ARENA + AR_NTC), (const float*)(ws + WS_TOK + TOK_DNC)); } else
#endif
#ifdef PROBE_NOSCAN
                if (!args.use_bar) { if (F.vcu >= nscan) p_moe_weights(F, args, L, (F.vcu - nscan) * NWAVES + F.wave, (F.G - nscan) * NWAVES); } else
#endif
                if (F.vcu < nscan) p_g2<64, 4>(F, args, (const bf16*)(ws + WS_ARENA + AR_MPC), (const bf16*)(ws + WS_ARENA + AR_NTC), (const float*)(ws + WS_TOK + TOK_DNC));
                else p_moe_weights(F, args, L, (F.vcu - nscan) * NWAVES + F.wave, (F.G - nscan) * NWAVES);
                if (F.G <= 64) p_moe_weights(F, args, L, F.gw, F.NGW);
                SEAM();
            }
            REPLOOP(LP_G2B) if (INL(LP_G2B)) { PHASE_WS(); p_g2b(F, args); SEAM(); }
            REPLOOP(LP_G3) if (INL(LP_G3)) { PHASE_WS(); p_g3(F, args, L); SEAM(); }
        }
        REPLOOP(LP_OUT) if (INL(LP_OUT)) { PHASE_WS();
            const bf16* Wo = odd ? (const bf16*)(ws + WS_WOUTO) + (size_t)j * D_ * D_ : (const bf16*)(ws + WS_WOUTE) + (size_t)j * D_ * D_;
            pg8::Gemm gm{MIX, Wo, S_, D_, D_, 0}; pg8::StaticOrder So; So.init(S_, D_, F.G, cid);
            pg8::EpiResid E{args.out, HBF, SSQA};
            pg8::gemm_phase<pg8::EpiResid, pg8::StaticOrder, true, true>(F.lds + RING_OFF, gm, So, E);
            SEAM();
        }
        if (!odd) {
            REPLOOP(LP_UP) if (INL(LP_UP)) { PHASE_WS();
                pg8::Gemm gm{HBF, (const bf16*)(ws + WS_W13D) + (size_t)j * 2 * DFF * D_, S_, 2 * DFF, D_, 0}; pg8::StaticOrder So; So.init(S_, 2 * DFF, F.G, cid);
                pg8::EpiSwiglu E{(bf16*)(ws + WS_ARENA + AR_ACT), SSQA};
                pg8::gemm_phase<pg8::EpiSwiglu, pg8::StaticOrder, true, true>(F.lds + RING_OFF, gm, So, E);
                SEAM();
            }
            REPLOOP(LP_DOWN) if (INL(LP_DOWN)) { PHASE_WS();
                pg8::Gemm gm{(const bf16*)(ws + WS_ARENA + AR_ACT), (const bf16*)(ws + WS_W2D) + (size_t)j * D_ * DFF, S_, D_, DFF, 0}; pg8::StaticOrder So; So.init(S_, D_, F.G, cid);
                pg8::EpiResid E{args.out, HBF, SSQA};
                pg8::gemm_phase<pg8::EpiResid, pg8::StaticOrder, true, true>(F.lds + RING_OFF, gm, So, E);
                SEAM();
            }
        } else {
            REPLOOP(LP_R1) if (INL(LP_R1)) { PHASE_WS(); p_r1(F, args, L); SEAM(); }
            REPLOOP(LP_R2) if (INL(LP_R2)) { PHASE_WS(); p_r2(F, args, L); SEAM(); }
            REPLOOP(LP_M1) if (INL(LP_M1)) { PHASE_WS();
                const int nb = moe_blocks(F, args, L);
                pg8::Gemm gm{(const bf16*)(ws + WS_ARENA + AR_XS), (const bf16*)(ws + WS_W13M), nb * 256, 2 * DFF, D_, (size_t)2 * DFF * D_ * 2}; pg8::MoeOrder So; So.init(nb * 256, 2 * DFF, F.G, cid); So.blk_e = (const LAS int*)(F.lds + BLKE_OFF);
                pg8::EpiSwiglu E{(bf16*)(ws + WS_ARENA + AR_ACT), nullptr};
                pg8::gemm_phase<pg8::EpiSwiglu, pg8::MoeOrder, true, true>(F.lds + RING_OFF, gm, So, E);
                SEAM();
            }
            REPLOOP(LP_M2) if (INL(LP_M2)) { PHASE_WS();
                const int nb = moe_blocks(F, args, L);
                pg8::Gemm gm{(const bf16*)(ws + WS_ARENA + AR_ACT), (const bf16*)(ws + WS_W2M), nb * 256, D_, DFF, (size_t)D_ * DFF * 2}; pg8::MoeOrder So; So.init(nb * 256, D_, F.G, cid); So.blk_e = (const LAS int*)(F.lds + BLKE_OFF);
                pg8::EpiMoeDown E{(bf16*)(ws + WS_ARENA + AR_Y), (const float*)(ws + WS_TOK + TOK_GPAD)};
                pg8::gemm_phase<pg8::EpiMoeDown, pg8::MoeOrder, true, true>(F.lds + RING_OFF, gm, So, E);
                SEAM();
            }
            REPLOOP(LP_COMB) if (INL(LP_COMB)) { PHASE_WS(); p_combine(F, args); SEAM(); }
        }
        REPLOOP(LP_PLE) if (INL(LP_PLE)) { PHASE_WS();
            pg8::Gemm gm{HBF, (const bf16*)(ws + WS_WG) + (size_t)L * D_ * D_, S_, D_, D_, 0}; pg8::StaticOrder So; So.init(S_, D_, F.G, cid);
            pg8::EpiPle E{args.out, HBF, SSQA, SSQB, PP};
            pg8::gemm_phase<pg8::EpiPle, pg8::StaticOrder, true, true>(F.lds + RING_OFF, gm, So, E);
            SEAM();
        }
    }

__global__ void __launch_bounds__(NWAVES * 64, 2) fwd(Args args) {
    extern __shared__ __attribute__((aligned(16))) unsigned char lds[];
    Frame F;
    F.lds = (LAS unsigned char*)lds; F.tid = threadIdx.x; F.lane = F.tid & 63; F.wave = __builtin_amdgcn_readfirstlane(F.tid >> 6);
    F.G = gridDim.x; { const int bx = blockIdx.x; F.vcu = (F.G % 8 == 0) ? (bx % 8) * (F.G / 8) + bx / 8 : bx; }
    F.gw = F.vcu * NWAVES + F.wave; F.NGW = F.G * NWAVES;
    unsigned char* ws0 = args.ws;
    for (int u = F.tid; u < (LDS_BYTES - LDSCTL_OFF) / 4; u += NWAVES * 64) ((LAS unsigned*)(F.lds + LDSCTL_OFF))[u] = 0u;
    __syncthreads();
    XcdBarrier bar; bar.bar = (unsigned*)(ws0 + WS_CTL) + CW_BAR; bar.x = 0; bar.st = nullptr;
    if (args.use_bar) bar = xcd_barrier_post((unsigned*)(ws0 + WS_CTL) + CW_BAR, (volatile LAS unsigned*)(F.lds + MISC_OFF));
    const int lo = args.ph_lo, hi = args.ph_hi;
    const int cid = (int)blockIdx.x;

    if ((((unsigned long long)(PH_MASK) >> 30) & 1) && IN(P_PRO)) { p_prologue(F, args); SEAM(); }

#ifdef FIXED_L
    run_layer<FIXED_L>(F, args, lds, bar, ws0, lo, hi, cid);
#else
    run_layer<0>(F, args, lds, bar, ws0, lo, hi, cid); run_layer<1>(F, args, lds, bar, ws0, lo, hi, cid); run_layer<2>(F, args, lds, bar, ws0, lo, hi, cid); run_layer<3>(F, args, lds, bar, ws0, lo, hi, cid);
#endif
    if ((((unsigned long long)(PH_MASK) >> 31) & 1) && IN(P_FINAL)) p_final(F, args);
#undef IN
#undef INL
#undef SEAM
}


#ifndef DBG
#define DBG 0
#endif
#if DBG
#ifndef DBG_ASLOT
#define DBG_ASLOT 9
#endif
#ifndef DBG_BSLOT
#define DBG_BSLOT 11
#endif
__global__ void dbg_scan(const void* p, size_t n, int is_f32, unsigned* slot) {
    unsigned cnt = 0;
    for (size_t i = (size_t)blockIdx.x * blockDim.x + threadIdx.x; i < n; i += (size_t)gridDim.x * blockDim.x) {
        const float v = is_f32 ? ((const float*)p)[i] : __uint_as_float(((unsigned)((const unsigned short*)p)[i]) << 16);
        if (!(fabsf(v) < 1e30f)) ++cnt; }
    if (cnt) atomicAdd(slot, cnt);
}
__global__ void dbg_fill(float* out, size_t n, const unsigned* slots, int nslots) {
    int first = -1; for (int i = 0; i < nslots; ++i) if (slots[i]) { first = i; break; }
    float c, V;
    if (first >= 0) { c = sqrtf((float)(10 + first) * 1e6f); V = c; }
    else { const float ea = fmaxf(__uint_as_float(slots[256 + DBG_ASLOT]), 1e-5f), eb = fmaxf(__uint_as_float(slots[256 + DBG_BSLOT]), 1e-5f);
        c = sqrtf((10.f + fminf(60.f, rintf(10.f * (log10f(ea) + 5.f)))) * 1e4f); V = (50.f + rintf(10.f * log10f(eb))) * 1e3f; }
    for (size_t i = (size_t)blockIdx.x * blockDim.x + threadIdx.x; i < n; i += (size_t)gridDim.x * blockDim.x) out[i] = (i == 0) ? V : c;
}
__device__ __forceinline__ float dbg_bf(const unsigned short* p, size_t i) { return __uint_as_float(((unsigned)p[i]) << 16); }
__device__ __forceinline__ float dbg_rstd(const float* ssq, int row) { float s = 0.f; for (int i = 0; i < 16; ++i) s += ssq[(size_t)row * 16 + i]; return 1.0f / sqrtf(s / 1024.0f + 1e-6f); }
__device__ __forceinline__ float dbg_blocksum(float v, float* red) {
    __syncthreads(); red[threadIdx.x] = v; __syncthreads();
    for (int o = 128; o > 0; o >>= 1) { if ((int)threadIdx.x < o) red[threadIdx.x] += red[threadIdx.x + o]; __syncthreads(); }
    const float r = red[0]; __syncthreads(); return r;
}
__device__ __forceinline__ void dbg_report(unsigned* slot, float num, float den) { if (threadIdx.x == 0) atomicMax(slot, __float_as_uint(sqrtf(num / fmaxf(den, 1e-20f)))); }
__global__ void chk_ffn(const float* hpre, const float* hpost, const float* ssq, const float* ln, const float* wr, const float* w1, const float* w3, const float* w2, int moe, unsigned* slot) {
    __shared__ float xn[1024]; __shared__ float hid[3584]; __shared__ float red[256]; __shared__ float lg[8];
    const int t = (blockIdx.x * 997 + 13) % S_, tid = threadIdx.x;
    const float rs = dbg_rstd(ssq, t);
    for (int k = tid; k < 1024; k += 256) xn[k] = hpre[(size_t)t * 1024 + k] * rs * ln[k];
    __syncthreads();
    int e0 = 0, e1 = 0; float g0 = 1.f, g1 = 0.f;
    if (moe) {
        if (tid < 8) { float s = 0.f; for (int k = 0; k < 1024; ++k) s += xn[k] * wr[(size_t)k * 8 + tid]; lg[tid] = s; }
        __syncthreads();
        float l0 = lg[0]; for (int e = 1; e < 8; ++e) if (lg[e] > l0) { l0 = lg[e]; e0 = e; }
        float l1 = -1e30f; e1 = -1; for (int e = 0; e < 8; ++e) if (e != e0 && lg[e] > l1) { l1 = lg[e]; e1 = e; }
        const float m0 = expf(l0 - l0), m1 = expf(l1 - l0); g0 = m0 / (m0 + m1); g1 = m1 / (m0 + m1);
    }
    float acc[4] = {0.f, 0.f, 0.f, 0.f};
    for (int pass = 0; pass < (moe ? 2 : 1); ++pass) {
        const int e = pass == 0 ? e0 : e1; const float gt = pass == 0 ? g0 : g1;
        const float* W1 = w1 + (size_t)e * 1024 * 3584; const float* W3 = w3 + (size_t)e * 1024 * 3584; const float* W2 = w2 + (size_t)e * 3584 * 1024;
        __syncthreads();
        for (int f = tid; f < 3584; f += 256) { float a = 0.f, b = 0.f; for (int k = 0; k < 1024; ++k) { a += xn[k] * W1[(size_t)k * 3584 + f]; b += xn[k] * W3[(size_t)k * 3584 + f]; } hid[f] = a / (1.f + expf(-a)) * b; }
        __syncthreads();
        for (int q = 0; q < 4; ++q) { const int c = tid + 256 * q; float y = 0.f; for (int f = 0; f < 3584; ++f) y += hid[f] * W2[(size_t)f * 1024 + c]; acc[q] += gt * y; }
    }
    float num = 0.f, den = 0.f;
    for (int q = 0; q < 4; ++q) { const int c = tid + 256 * q; const float ex = acc[q], got = hpost[(size_t)t * 1024 + c] - hpre[(size_t)t * 1024 + c]; num += (got - ex) * (got - ex); den += ex * ex; }
    num = dbg_blocksum(num, red); den = dbg_blocksum(den, red);
    dbg_report(slot, num, den);
}
__global__ void chk_ple(const float* hpre, const float* hpost, const float* ssq, const float* ln, const float* wg, const float* p, const float* wp, unsigned* slot) {
    __shared__ float xn[1024]; __shared__ float red[256];
    const int t = (blockIdx.x * 997 + 13) % S_, tid = threadIdx.x; const float rs = dbg_rstd(ssq, t);
    for (int k = tid; k < 1024; k += 256) xn[k] = hpre[(size_t)t * 1024 + k] * rs * ln[k];
    __syncthreads();
    float num = 0.f, den = 0.f;
    for (int q = 0; q < 4; ++q) { const int c = tid + 256 * q; float a = 0.f, b = 0.f; for (int k = 0; k < 1024; ++k) a += xn[k] * wg[(size_t)k * 1024 + c]; for (int k = 0; k < 256; ++k) b += p[(size_t)t * 256 + k] * wp[(size_t)k * 1024 + c];
        const float ex = b / (1.f + expf(-a)), got = hpost[(size_t)t * 1024 + c] - hpre[(size_t)t * 1024 + c]; num += (got - ex) * (got - ex); den += ex * ex; }
    num = dbg_blocksum(num, red); den = dbg_blocksum(den, red); dbg_report(slot, num, den);
}
constexpr int DBG_TC = 512;
__global__ void chk_gdn_proj(const float* h, const float* ssq, const float* ln, const float* W, int hh, float* raw) {
    const int idx = blockIdx.x * blockDim.x + threadIdx.x; if (idx >= DBG_TC * 514) return;
    const int t = idx / 514, c = idx % 514;
    const int col = c < 128 ? hh * 128 + c : c < 256 ? 1024 + hh * 128 + (c - 128) : c < 384 ? 2048 + hh * 128 + (c - 256) : c < 512 ? 3072 + hh * 128 + (c - 384) : c == 512 ? 4096 + hh : 4104 + hh;
    const float rs = dbg_rstd(ssq, t); float s = 0.f;
    for (int k = 0; k < 1024; ++k) s += h[(size_t)t * 1024 + k] * ln[k] * W[(size_t)k * OIN_SRC + col];
    raw[(size_t)t * 514 + c] = s * rs;
}
__global__ void chk_gdn_rec(const float* raw, const float* cw, const float* alog, const float* dtb, const float* onorm, int hh, const unsigned short* mix, unsigned* slot) {
    extern __shared__ float sm[];
    float* Sm = sm; float* q = sm + 128 * 129; float* kk = q + 128; float* v = kk + 128; float* kv = v + 128; float* dl = kv + 128; float* o = dl + 128; float* red = o + 128;
    const int tid = threadIdx.x;
    for (int i = tid; i < 128 * 129; i += 256) Sm[i] = 0.f;
    __syncthreads();
    float worst = 0.f;
    for (int t = 0; t < DBG_TC; ++t) {
        if (tid < 128) { const int d = tid; float aq = 0.f, ak = 0.f, av = 0.f;
            for (int jj = 0; jj < 4; ++jj) { const int r = t - 3 + jj; if (r >= 0) { aq += cw[jj * 3072 + hh * 128 + d] * raw[(size_t)r * 514 + d]; ak += cw[jj * 3072 + 1024 + hh * 128 + d] * raw[(size_t)r * 514 + 128 + d]; av += cw[jj * 3072 + 2048 + hh * 128 + d] * raw[(size_t)r * 514 + 256 + d]; } }
            q[d] = aq / (1.f + expf(-aq)); kk[d] = ak / (1.f + expf(-ak)); v[d] = av / (1.f + expf(-av)); }
        __syncthreads();
        const float sq = dbg_blocksum(tid < 128 ? q[tid] * q[tid] : 0.f, red), sk = dbg_blocksum(tid < 128 ? kk[tid] * kk[tid] : 0.f, red);
        if (tid < 128) { q[tid] *= 1.0f / sqrtf(sq + 1e-6f) * 0.08838834764831845f; kk[tid] *= 1.0f / sqrtf(sk + 1e-6f); }
        const float bb = raw[(size_t)t * 514 + 512], aa = raw[(size_t)t * 514 + 513];
        const float beta = 1.f / (1.f + expf(-bb)); const float z = aa + dtb[hh]; const float g = -expf(alog[hh]) * (z > 20.f ? z : log1pf(expf(z))); const float alpha = expf(g);
        __syncthreads();
        for (int i = tid; i < 128 * 128; i += 256) { const int d = i >> 7, j = i & 127; Sm[d * 129 + j] *= alpha; }
        __syncthreads();
        if (tid < 128) { float s = 0.f; for (int d = 0; d < 128; ++d) s += kk[d] * Sm[d * 129 + tid]; dl[tid] = beta * (v[tid] - s); }
        __syncthreads();
        for (int i = tid; i < 128 * 128; i += 256) { const int d = i >> 7, j = i & 127; Sm[d * 129 + j] += kk[d] * dl[j]; }
        __syncthreads();
        if (tid < 128) { float s = 0.f; for (int d = 0; d < 128; ++d) s += q[d] * Sm[d * 129 + tid]; o[tid] = s; }
        __syncthreads();
        const float so = dbg_blocksum(tid < 128 ? o[tid] * o[tid] : 0.f, red); const float rms = 1.0f / sqrtf(so / 128.f + 1e-6f);
        float num = 0.f, den = 0.f;
        if (tid < 128) { const float zz = raw[(size_t)t * 514 + 384 + tid]; const float ex = o[tid] * rms * onorm[tid] * (zz / (1.f + expf(-zz))); const float got = dbg_bf(mix, (size_t)t * 1024 + hh * 128 + tid); num = (got - ex) * (got - ex); den = ex * ex; }
        num = dbg_blocksum(num, red); den = dbg_blocksum(den, red);
        worst = fmaxf(worst, sqrtf(num / fmaxf(den, 1e-20f)));
    }
    if (tid == 0) atomicMax(slot, __float_as_uint(worst));
}

__global__ void chk_even_kv(const float* h, const float* ssq, const float* ln, const float* W, float* KV) {
    const size_t idx = (size_t)blockIdx.x * blockDim.x + threadIdx.x; if (idx >= (size_t)S_ * 1024) return;
    const int t = (int)(idx >> 10), c = (int)(idx & 1023); const float rs = dbg_rstd(ssq, t); float s = 0.f;
    for (int k = 0; k < 1024; ++k) s += h[(size_t)t * 1024 + k] * ln[k] * W[(size_t)k * EIN + 512 + c];
    KV[idx] = s * rs;
}
__global__ void chk_even_mix(const float* h, const float* ssq, const float* ln, const float* W, const float* KV, const int* pos, const float* lq1, const float* lk1, const float* lq2, const float* lk2, const float* subg, const float* cw,
                             float lam0, const unsigned short* PE, const unsigned short* AO, const unsigned short* MIXb, unsigned* slot) {
    __shared__ float q[2][64]; __shared__ float p[128]; __shared__ float red[256]; __shared__ float o2[2][128]; __shared__ float hn[1024];
    const int toks[6] = {5, 200, 1000, 4097, 9000, 16383};
    const int t = toks[blockIdx.x / 4], hh = blockIdx.x % 4, tid = threadIdx.x;
    auto bsum = [&](float v) { __syncthreads(); red[tid] = v; __syncthreads(); for (int o = 64; o > 0; o >>= 1) { if (tid < o) red[tid] += red[tid + o]; __syncthreads(); } const float r = red[0]; __syncthreads(); return r; };
    auto bmax = [&](float v) { __syncthreads(); red[tid] = v; __syncthreads(); for (int o = 64; o > 0; o >>= 1) { if (tid < o) red[tid] = fmaxf(red[tid], red[tid + o]); __syncthreads(); } const float r = red[0]; __syncthreads(); return r; };
    auto invf = [&](int i) { return exp2f(-(float)i * (18.931568569324174f / 8.0f)); };
    const float rs = dbg_rstd(ssq, t);
    for (int k = tid; k < 1024; k += 128) hn[k] = h[(size_t)t * 1024 + k] * rs * ln[k];
    __syncthreads();
    { const int m = tid >> 6, d = tid & 63, col = (2 * hh + m) * 64 + d; float s = 0.f; for (int k = 0; k < 1024; ++k) s += hn[k] * W[(size_t)k * EIN + col]; q[m][d] = s; }
    __syncthreads();
    float qr;
    { const int m = tid >> 6, d = tid & 63; float v = q[m][d];
      if (d < 16) { const int i = d & 7; const float ang = (float)pos[t] * invf(i); const float c = cosf(ang), s = sinf(ang); v = d < 8 ? q[m][d] * c - q[m][d + 8] * s : q[m][d] * c + q[m][d - 8] * s; }
      qr = v * pg8::C2; }
    __syncthreads(); q[tid >> 6][tid & 63] = qr; __syncthreads();
    float num = 0.f, den = 0.f;
    { const int m = tid >> 6, d = tid & 63; const float got = dbg_bf(PE, (size_t)t * EIN + (2 * hh + m) * 64 + d); const float e2 = (got - qr) * (got - qr), r2 = qr * qr; num += e2; den += r2;
      const float na = bsum(d >= 16 ? e2 : 0.f), da = bsum(d >= 16 ? r2 : 0.f), nb = bsum(d < 16 ? e2 : 0.f), db = bsum(d < 16 ? r2 : 0.f);
      if (tid == 0) { atomicMax(slot + 4, __float_as_uint(sqrtf(na / fmaxf(da, 1e-20f)))); atomicMax(slot + 5, __float_as_uint(sqrtf(nb / fmaxf(db, 1e-20f)))); } }
    { const int m = tid >> 6, d = tid & 63; const float* kr = KV + (size_t)t * 1024 + (2 * hh + m) * 64; float v = kr[d];
      if (d < 16) { const int i = d & 7; const float ang = (float)pos[t] * invf(i); const float c = cosf(ang), s = sinf(ang); v = d < 8 ? kr[d] * c - kr[d + 8] * s : kr[d] * c + kr[d - 8] * s; }
      const float got = dbg_bf(PE, (size_t)t * EIN + 512 + (2 * hh + m) * 64 + d); const float e2 = (got - v) * (got - v), r2 = v * v; num += e2; den += r2;
      const float na = bsum(d >= 16 ? e2 : 0.f), da = bsum(d >= 16 ? r2 : 0.f), nb = bsum(d < 16 ? e2 : 0.f), db = bsum(d < 16 ? r2 : 0.f);
      const float vv = KV[(size_t)t * 1024 + 512 + hh * 128 + tid], gv = dbg_bf(PE, (size_t)t * EIN + 1024 + hh * 128 + tid); const float e3 = (gv - vv) * (gv - vv), r3 = vv * vv; num += e3; den += r3;
      const float nc = bsum(e3), dc = bsum(r3);
      if (tid == 0) { atomicMax(slot + 6, __float_as_uint(sqrtf(na / fmaxf(da, 1e-20f)))); atomicMax(slot + 7, __float_as_uint(sqrtf(nb / fmaxf(db, 1e-20f)))); atomicMax(slot + 8, __float_as_uint(sqrtf(nc / fmaxf(dc, 1e-20f)))); } }
    num = bsum(num); den = bsum(den); if (tid == 0) atomicMax(slot + 0, __float_as_uint(sqrtf(num / fmaxf(den, 1e-20f))));
    for (int m = 0; m < 2; ++m) {
        float mx = -1e30f;
        for (int j0 = 0; j0 <= t; j0 += 128) { const int j = j0 + tid; float s = -1e30f;
            if (j <= t) { const float* kr = KV + (size_t)j * 1024 + (2 * hh + m) * 64; s = 0.f;
                for (int d = 0; d < 64; ++d) { float kv = kr[d]; if (d < 16) { const int i = d & 7; const float ang = (float)pos[j] * invf(i); const float c = cosf(ang), sn = sinf(ang); kv = d < 8 ? kr[d] * c - kr[d + 8] * sn : kr[d] * c + kr[d - 8] * sn; } s += q[m][d] * kv; } }
            mx = fmaxf(mx, s); }
        mx = bmax(mx);
        float l = 0.f, acc = 0.f;
        for (int j0 = 0; j0 <= t; j0 += 128) { const int j = j0 + tid; float pe = 0.f;
            if (j <= t) { const float* kr = KV + (size_t)j * 1024 + (2 * hh + m) * 64; float s = 0.f;
                for (int d = 0; d < 64; ++d) { float kv = kr[d]; if (d < 16) { const int i = d & 7; const float ang = (float)pos[j] * invf(i); const float c = cosf(ang), sn = sinf(ang); kv = d < 8 ? kr[d] * c - kr[d + 8] * sn : kr[d] * c + kr[d - 8] * sn; } s += q[m][d] * kv; }
                pe = exp2f(s - mx); }
            __syncthreads(); p[tid] = pe; __syncthreads();
            l += pe;
            const int nj = min(128, t + 1 - j0);
            for (int i = 0; i < nj; ++i) acc += p[i] * KV[(size_t)(j0 + i) * 1024 + 512 + hh * 128 + tid]; }
        l = bsum(l);
        o2[m][tid] = acc / l;
    }
    __syncthreads();
    { float n2 = 0.f, d2 = 0.f;
      for (int m = 0; m < 2; ++m) { const float ex = o2[m][tid], got = dbg_bf(AO, (size_t)t * 1024 + hh * 256 + m * 128 + tid); n2 += (got - ex) * (got - ex); d2 += ex * ex; }
      n2 = bsum(n2); d2 = bsum(d2); if (tid == 0) atomicMax(slot + 1, __float_as_uint(sqrtf(n2 / fmaxf(d2, 1e-20f)))); }
    float s1 = 0.f, s2 = 0.f; for (int i = 0; i < 64; ++i) { s1 += lq1[i] * lk1[i]; s2 += lq2[i] * lk2[i]; }
    const float lam = expf(s1) - expf(s2) + lam0;
    const float dv = o2[0][tid] - lam * o2[1][tid]; const float ssd = bsum(dv * dv); const float ex = dv / sqrtf(ssd / 128.f + 1e-5f) * subg[tid] * (1.f - lam0);
    { const float got = dbg_bf(MIXb, (size_t)t * 1024 + hh * 128 + tid); float n2 = (got - ex) * (got - ex), d2 = ex * ex; n2 = bsum(n2); d2 = bsum(d2); if (tid == 0) atomicMax(slot + 2, __float_as_uint(sqrtf(n2 / fmaxf(d2, 1e-20f)))); }
    { const int ch = hh * 128 + tid; float cx[3] = {0.f, 0.f, 0.f}, bg = 0.f;
      for (int jj = 0; jj < 3; ++jj) { const int r = t - 2 + jj; if (r < 0) continue; const float rr = dbg_rstd(ssq, r); float c = 0.f, x = 0.f, b = 0.f;
          for (int k = 0; k < 1024; ++k) { const float hv = h[(size_t)r * 1024 + k] * ln[k]; c += hv * W[(size_t)k * EIN + 2048 + ch]; x += hv * W[(size_t)k * EIN + 2560 + ch]; if (jj == 2) b += hv * W[(size_t)k * EIN + 1536 + ch]; }
          cx[jj] = (c * rr) * (x * rr); if (jj == 2) bg = b * rr; }
      const float ex2 = bg * (cw[0 * 512 + ch] * cx[0] + cw[1 * 512 + ch] * cx[1] + cw[2 * 512 + ch] * cx[2]); const float got = dbg_bf(MIXb, (size_t)t * 1024 + 512 + ch);
      float n2 = (got - ex2) * (got - ex2), d2 = ex2 * ex2; n2 = bsum(n2); d2 = bsum(d2); if (tid == 0) atomicMax(slot + 3, __float_as_uint(sqrtf(n2 / fmaxf(d2, 1e-20f)))); }
}
static void dbg_before_phase(int ph, unsigned char* ws, float* out, hipStream_t st) {
    if (ph == P_PRO || ph == P_FINAL) return;
    const int lp = (ph - 1) % LPN;
    if (lp == LP_UP || lp == LP_R1 || lp == LP_PLE) { (void)hipMemcpyAsync(ws + WS_ARENA + 400 * MiB, out, (size_t)S_ * D_ * 4, hipMemcpyDeviceToDevice, st); (void)hipMemcpyAsync(ws + WS_ARENA + 464 * MiB, ws + WS_SSQA, (size_t)S_ * 16 * 4, hipMemcpyDeviceToDevice, st); }
}
static void dbg_checks(int ph, void* const* d_in, unsigned char* ws, float* out, hipStream_t st) {
    if (ph == P_PRO || ph == P_FINAL) return;
    unsigned* slots = (unsigned*)(ws + WS_CTL) + CW_DBG; const int L = (ph - 1) / LPN, lp = (ph - 1) % LPN, j = L >> 1; const bool odd = L & 1;
    const float* snap = (const float*)(ws + WS_ARENA + 400 * MiB);
    if (lp == LP_DOWN && L == 0) hipLaunchKernelGGL(chk_ffn, dim3(24), dim3(256), 0, st, snap, (const float*)out, (const float*)(ws + WS_ARENA + 464 * MiB), (const float*)d_in[4] + L * D_, (const float*)nullptr,
        (const float*)d_in[21] + (size_t)j * D_ * DFF, (const float*)d_in[22] + (size_t)j * D_ * DFF, (const float*)d_in[23] + (size_t)j * D_ * DFF, 0, slots + 256 + 0);
    if (lp == LP_PLE && L == 0) hipLaunchKernelGGL(chk_ple, dim3(24), dim3(256), 0, st, snap, (const float*)out, (const float*)(ws + WS_ARENA + 464 * MiB), (const float*)d_in[5] + L * D_, (const float*)d_in[28] + (size_t)L * D_ * D_,
        (const float*)d_in[1] + (size_t)L * S_ * PLE, (const float*)d_in[29] + (size_t)L * PLE * D_, slots + 256 + 1);
    if (lp == LP_G3 && L == 1) { float* raw = (float*)(ws + WS_ARENA + 400 * MiB);
        hipLaunchKernelGGL(chk_gdn_proj, dim3((DBG_TC * 514 + 255) / 256), dim3(256), 0, st, (const float*)out, (const float*)(ws + WS_SSQB), (const float*)d_in[3] + L * D_, (const float*)d_in[15] + (size_t)j * D_ * OIN_SRC, 3, raw);
        hipLaunchKernelGGL(chk_gdn_rec, dim3(1), dim3(256), (128 * 129 + 6 * 128 + 256) * 4, st, (const float*)raw, (const float*)d_in[16] + (size_t)j * 4 * 3072, (const float*)d_in[17] + j * 8, (const float*)d_in[18] + j * 8, (const float*)d_in[19] + j * 128, 3, (const unsigned short*)(ws + WS_MIX), slots + 256 + 2); }
    if (lp == LP_COMB && L == 1) hipLaunchKernelGGL(chk_ffn, dim3(24), dim3(256), 0, st, snap, (const float*)out, (const float*)(ws + WS_ARENA + 464 * MiB), (const float*)d_in[4] + L * D_, (const float*)d_in[24] + (size_t)j * D_ * NEXP,
        (const float*)d_in[25] + (size_t)j * NEXP * D_ * DFF, (const float*)d_in[26] + (size_t)j * NEXP * D_ * DFF, (const float*)d_in[27] + (size_t)j * NEXP * DFF * D_, 1, slots + 256 + 3);
    if (lp == LP_MIXPREP && L == 0) { float* KV = (float*)(ws + WS_ARENA + 400 * MiB);
        hipLaunchKernelGGL(chk_even_kv, dim3((S_ * 1024) / 256), dim3(256), 0, st, (const float*)out, (const float*)(ws + WS_SSQB), (const float*)d_in[3] + L * D_, (const float*)d_in[7] + (size_t)j * D_ * EIN, KV);
        hipLaunchKernelGGL(chk_even_mix, dim3(24), dim3(128), 0, st, (const float*)out, (const float*)(ws + WS_SSQB), (const float*)d_in[3] + L * D_, (const float*)d_in[7] + (size_t)j * D_ * EIN, (const float*)KV, (const int*)d_in[2],
            (const float*)d_in[9] + j * 64, (const float*)d_in[10] + j * 64, (const float*)d_in[11] + j * 64, (const float*)d_in[12] + j * 64, (const float*)d_in[13] + j * 128, (const float*)d_in[14] + (size_t)j * 3 * 512,
            0.8f - 0.6f * expf(-0.3f * (float)L), (const unsigned short*)(ws + WS_ARENA + AR_PE), (const unsigned short*)(ws + WS_ARENA + AR_AO), (const unsigned short*)(ws + WS_MIX), slots + 256 + 4); }
    (void)odd;
}
static void dbg_after_phase(int ph, unsigned char* ws, float* out, hipStream_t st) {
    unsigned* slots = (unsigned*)(ws + WS_CTL) + CW_DBG; unsigned* sl = slots + ph;
    auto scan = [&](const void* p, size_t n, int f32) { hipLaunchKernelGGL(dbg_scan, dim3(1024), dim3(256), 0, st, p, n, f32, sl); };
    const size_t SD = (size_t)S_ * D_; unsigned char* ar = ws + WS_ARENA;
    if (ph == P_PRO) { scan(ws + WS_HBF, SD, 0); scan(out, SD, 1); scan(ws + WS_PBF, (size_t)4 * S_ * PLE, 0); scan(ws + WS_TAB, (size_t)S_ * 16, 1); scan(ws + WS_W, (size_t)44 * MiB, 0); return; }
    if (ph == P_FINAL) return;
    const int L = (ph - 1) / LPN, lp = (ph - 1) % LPN; const bool odd = L & 1;
    switch (lp) {
    case LP_PROJ: if (!odd) scan(ar + AR_PE, (size_t)S_ * EIN, 0); else { scan(ar + AR_PO, (size_t)S_ * OIN, 0); scan(ws + WS_GB, (size_t)S_ * 16, 1); } scan(ws + WS_PP, SD, 0); break;
    case LP_ROT: scan(ar + AR_PE, (size_t)S_ * EIN, 0); break;
    case LP_ATT: scan(ar + AR_AO, SD, 0); break;
    case LP_MIXPREP: case LP_G3: scan(ws + WS_MIX, SD, 0); break;
    case LP_GA: scan(ar + AR_QN, SD * 6, 0); scan(ws + WS_GB, (size_t)S_ * 16, 1); break;
    case LP_G1: scan(ar + AR_AI, (size_t)NUNIT * 4096, 0); scan(ar + AR_NEGW, SD, 0); scan(ar + AR_UT, SD, 0); scan(ar + AR_MP, (size_t)NUNIT * 16384 * 2, 0); break;
    case LP_G2: scan(ar + AR_SG, (size_t)NUNIT * 16384, 0); break;
    case LP_OUT: case LP_DOWN: case LP_COMB: case LP_PLE: scan(out, SD, 1); scan(ws + WS_HBF, SD, 0); scan(ws + ((lp == LP_PLE) ? WS_SSQB : WS_SSQA), (size_t)S_ * 16, 1); break;
    case LP_UP: scan(ar + AR_ACT, (size_t)S_ * DFF, 0); break;
    case LP_R1: scan(ws + WS_TOK + TOK_G, (size_t)S_ * 2, 1); break;
    default: break; }
}
#endif
#ifndef MK_MULTI
#define MK_MULTI 0
#endif
extern "C" void kernel_launch(void* const* d_in, const int* in_sizes, int n_in, void* d_out, int out_size, void* d_ws, size_t ws_size, hipStream_t stream) {
    static int grid = 0;
    if (grid == 0) {
        if (n_in != 30 || out_size != S_ * D_ || ws_size < WS_NEED) { fprintf(stderr, "kernel_launch: unexpected problem (n_in %d, out %d, ws %zu < %zu)\n", n_in, out_size, ws_size, (size_t)WS_NEED); grid = -1; return; }
        int dev = 0, cus = 0, per_cu = 0;
        if (hipGetDevice(&dev) != hipSuccess || hipDeviceGetAttribute(&cus, hipDeviceAttributeMultiprocessorCount, dev) != hipSuccess) { grid = -1; return; }
        if (hipFuncSetAttribute((const void*)fwd, hipFuncAttributeMaxDynamicSharedMemorySize, LDS_BYTES) != hipSuccess) { fprintf(stderr, "kernel_launch: hipFuncSetAttribute failed\n"); grid = -1; return; }
        if (hipOccupancyMaxActiveBlocksPerMultiprocessor(&per_cu, (const void*)fwd, NWAVES * 64, LDS_BYTES) != hipSuccess || per_cu < 1) { fprintf(stderr, "kernel_launch: occupancy query says %d\n", per_cu); }
        (void)hipGetLastError();
        grid = cus;
#if DBG
        (void)hipFuncSetAttribute((const void*)chk_gdn_rec, hipFuncAttributeMaxDynamicSharedMemorySize, 72 * 1024);
#endif
    }
    if (grid < 0) return;
    (void)hipMemsetAsync((char*)d_ws + WS_CTL, 0, CTL_ZERO_BYTES, stream);
    Args a{};
    for (int i = 0; i < 30; ++i) a.in[i] = d_in[i];
    a.out = (float*)d_out; a.ws = (unsigned char*)d_ws; a.pad = 0;
#if MK_MULTI
    a.use_bar = 0;
    static const int seq_even[] = {LP_PROJ, LP_ROT, LP_ATT, LP_MIXPREP, LP_OUT, LP_UP, LP_DOWN, LP_PLE};
    static const int seq_odd[] = {LP_PROJ, LP_GA, LP_G1, LP_G1B, LP_G2, LP_G2B, LP_G3, LP_OUT, LP_R1, LP_R2, LP_M1, LP_M2, LP_COMB, LP_PLE};
    int plist[64], np = 0; plist[np++] = P_PRO;
    for (int L = 0; L < DEPTH_; ++L) { const bool odd = L & 1; const int n = odd ? 14 : 8; for (int q = 0; q < n; ++q) plist[np++] = 1 + LPN * L + (odd ? seq_odd[q] : seq_even[q]); }
    plist[np++] = P_FINAL;
    for (int pi = 0; pi < np; ++pi) { const int ph = plist[pi];
        a.ph_lo = ph; a.ph_hi = ph + 1;
#if DBG
        dbg_before_phase(ph, (unsigned char*)d_ws, (float*)d_out, stream);
#endif
        hipLaunchKernelGGL(fwd, dim3(grid), dim3(NWAVES * 64), LDS_BYTES, stream, a);
#if DBG
        dbg_after_phase(ph, (unsigned char*)d_ws, (float*)d_out, stream); dbg_checks(ph, d_in, (unsigned char*)d_ws, (float*)d_out, stream);
#endif
    }
#if DBG
    hipLaunchKernelGGL(dbg_fill, dim3(1024), dim3(256), 0, stream, (float*)d_out, (size_t)S_ * D_, (const unsigned*)((unsigned char*)d_ws + WS_CTL) + CW_DBG, P_FINAL + 1);
#endif
#else
    a.use_bar = 1; a.ph_lo = 0; a.ph_hi = P_FINAL + 1;
    hipLaunchKernelGGL(fwd, dim3(grid), dim3(NWAVES * 64), LDS_BYTES, stream, a);
#ifdef PROBE_PH
    for (int i = 0; i < PROBE_N; ++i) { a.use_bar = 0; a.ph_lo = PROBE_PH; a.ph_hi = PROBE_PH + 1; hipLaunchKernelGGL(fwd, dim3(grid), dim3(NWAVES * 64), LDS_BYTES, stream, a); }
#endif
#endif
    const hipError_t le = hipPeekAtLastError();
    if (le != hipSuccess) fprintf(stderr, "kernel_launch: launch failed: %s\n", hipGetErrorName(le));
}
```

```cpp
#include <hip/hip_runtime.h>
#include <hip/hip_bf16.h>
#include <cstdio>
#include <cstdint>
#include <cmath>

constexpr int S_ = 16384, D_ = 1024, DEPTH_ = 4;
constexpr int EIN = 3072, OIN = 4096, OIN_SRC = 4112, DFF = 3584, NEXP = 8, PLE = 256;
constexpr int MOE_P = 2 * S_ + NEXP * 256;
constexpr int NCHUNK = S_ / 64, NUNIT = NCHUNK * 8;
constexpr float RMS_EPS = 1e-6f;

namespace pg8 {
#define PG8_LAS __attribute__((address_space(3)))
typedef unsigned short bf16_t;
typedef short bf16x8 __attribute__((ext_vector_type(8)));
typedef float f32x4 __attribute__((ext_vector_type(4)));
typedef float f32x2 __attribute__((ext_vector_type(2)));
typedef unsigned u32x4 __attribute__((ext_vector_type(4)));
typedef unsigned u32x2 __attribute__((ext_vector_type(2)));
constexpr int BM = 256, BK = 64, HALF = 128, HTB = HALF * BK * 2, STAGE_BYTES = 8 * HTB, NXCD = 8, WGM = 8;

__host__ __device__ __forceinline__ int lds_byte(int r, int c) { const int st = (r >> 4) * 2 + (c >> 5), rr = r & 15, cc = c & 31, ob = rr * 64 + cc * 2; return st * 1024 + (ob ^ (((ob >> 9) & 1) << 5)); }
__host__ __device__ __forceinline__ void stage_rc(int b, int& R, int& C) { const int st = b / 1024, sb = b % 1024, swz = sb ^ (((sb >> 9) & 1) << 5); R = (st >> 1) * 16 + swz / 64; C = (st & 1) * 32 + (swz % 64) / 2; }
__host__ __device__ __forceinline__ int perm32(int rho) { const int n = rho >> 4, i = rho & 15; return 8 * (i >> 2) + 4 * n + (i & 3); }

struct Unit { int pm, pn, be; };
struct Gemm { const bf16_t* A; const bf16_t* Bt; int M, N, K; size_t bstride; };

struct StaticOrder {
    int nM, nN, nwg, G, c;
    __host__ __device__ void init(int M, int N, int G_, int c_) { nM = M / BM; nN = N / BM; nwg = nM * nN; G = G_; c = c_; }
    __host__ __device__ bool next(int i, Unit& u) const {
        const long L = (long)i * G + c; if (L >= nwg) return false;
        int wgid = (int)L; { const int q = nwg / NXCD, r = nwg % NXCD, xcd = wgid % NXCD, off = wgid / NXCD; wgid = (xcd < r ? xcd * (q + 1) : r * (q + 1) + (xcd - r) * q) + off; }
        const int nig = WGM * nN, gid = wgid / nig, fm = gid * WGM, gsz = (nM - fm) < WGM ? (nM - fm) : WGM;
        u.pm = fm + ((wgid % nig) % gsz); u.pn = (wgid % nig) / gsz; u.be = 0; return true;
    }
    __device__ __forceinline__ void a_ready(const Unit&) const {}
    __device__ __forceinline__ void done(const Unit&) const {}
};
struct MoeOrder : StaticOrder {
    const PG8_LAS int* blk_e;
    __device__ __forceinline__ bool next(int i, Unit& u) const { if (!StaticOrder::next(i, u)) return false; u.be = blk_e[u.pm]; return true; }
};

__device__ __forceinline__ unsigned cvt_pk_bf16(float lo, float hi) { unsigned r; asm volatile("v_cvt_pk_bf16_f32 %0, %1, %2" : "=v"(r) : "v"(lo), "v"(hi)); return r; }
typedef __bf16 bf16x2_t_ __attribute__((ext_vector_type(2)));
__device__ __forceinline__ unsigned cvt_pk_bf16_cv(float lo, float hi) { const f32x2 v = {lo, hi}; const bf16x2_t_ b = __builtin_convertvector(v, bf16x2_t_); return __builtin_bit_cast(unsigned, b); }
__device__ __forceinline__ float bf_lo(unsigned w) { return __uint_as_float(w << 16); }
__device__ __forceinline__ float bf_hi(unsigned w) { return __uint_as_float(w & 0xffff0000u); }

__device__ __forceinline__ float rstd_row(const float* ssq, int row) {
    const f32x4* p = (const f32x4*)(ssq + (size_t)row * 16);
    const f32x4 a = p[0], b = p[1], c = p[2], d = p[3];
    const float s = (((a[0] + a[1]) + (a[2] + a[3])) + ((b[0] + b[1]) + (b[2] + b[3]))) + (((c[0] + c[1]) + (c[2] + c[3])) + ((d[0] + d[1]) + (d[2] + d[3])));
    return __builtin_amdgcn_rsqf(s * (1.0f / 1024.0f) + RMS_EPS);
}
__device__ __forceinline__ float sigmoidf_(float x) { return __builtin_amdgcn_rcpf(1.0f + __builtin_amdgcn_exp2f(-1.4426950408889634f * x)); }
__device__ __forceinline__ float siluf_(float x) { return x * sigmoidf_(x); }

constexpr float C2 = 0.125f * 1.4426950408889634f;

struct EpiProjEven {
    static constexpr bool PERM = true, AFTER_DRAIN = false;
    bf16_t* O; const float* ssq; const float* tab;
    __device__ __forceinline__ void operator()(const f32x4 (&acc)[2][2][4][2], const Unit& u, int wr, int wc, int fr, int fq) const {
        const int row0 = u.pm * BM + wr * 64 + fr, colt = u.pn * BM;
        const bool rot = (colt < 1024) && ((wc & 1) == 0);
        const float qs = (colt < 512) ? C2 : 1.0f;
#pragma unroll
        for (int ai = 0; ai < 2; ++ai)
#pragma unroll
            for (int m = 0; m < 4; ++m) {
                const int row = row0 + ai * HALF + m * 16; const float rs = rstd_row(ssq, row);
                f32x4 c0 = {1.f, 1.f, 1.f, 1.f}, c1 = c0, s0 = {0.f, 0.f, 0.f, 0.f}, s1 = s0;
                if (rot && fq < 2) { const f32x4* t = (const f32x4*)(tab + (size_t)row * 16); c0 = t[0]; c1 = t[1]; s0 = t[2]; s1 = t[3]; if (fq == 0) { s0 = -s0; s1 = -s1; } }
#pragma unroll
                for (int bj = 0; bj < 2; ++bj) {
                    f32x4 v0 = acc[ai][bj][m][0] * rs, v1 = acc[ai][bj][m][1] * rs;
                    if (rot) {
                        f32x4 p0, p1;
#pragma unroll
                        for (int i = 0; i < 4; ++i) { p0[i] = __shfl_xor(v0[i], 16); p1[i] = __shfl_xor(v1[i], 16); }
                        v0 = v0 * c0 + p0 * s0; v1 = v1 * c1 + p1 * s1;
                    }
                    v0 = v0 * qs; v1 = v1 * qs;
                    u32x4 w; w.x = cvt_pk_bf16(v0[0], v0[1]); w.y = cvt_pk_bf16(v0[2], v0[3]); w.z = cvt_pk_bf16(v1[0], v1[1]); w.w = cvt_pk_bf16(v1[2], v1[3]);
                    *(u32x4*)(O + (size_t)row * EIN + colt + bj * HALF + wc * 32 + 8 * fq) = w;
                }
                asm volatile("" ::: "memory");
            }
    }
};
struct EpiBf16 {
    static constexpr bool PERM = true, AFTER_DRAIN = false;
    bf16_t* O; int ldc; const float* ssq; float scale0; int scale_cols;
    __device__ __forceinline__ void operator()(const f32x4 (&acc)[2][2][4][2], const Unit& u, int wr, int wc, int fr, int fq) const {
        const int row0 = u.pm * BM + wr * 64 + fr, colt = u.pn * BM;
#pragma unroll
        for (int ai = 0; ai < 2; ++ai)
#pragma unroll
            for (int m = 0; m < 4; ++m) {
                const int row = row0 + ai * HALF + m * 16; const float rs = (ssq ? rstd_row(ssq, row) : 1.0f) * (colt < scale_cols ? scale0 : 1.0f);
#pragma unroll
                for (int bj = 0; bj < 2; ++bj) {
                    const f32x4 v0 = acc[ai][bj][m][0] * rs, v1 = acc[ai][bj][m][1] * rs;
                    u32x4 w; w.x = cvt_pk_bf16(v0[0], v0[1]); w.y = cvt_pk_bf16(v0[2], v0[3]); w.z = cvt_pk_bf16(v1[0], v1[1]); w.w = cvt_pk_bf16(v1[2], v1[3]);
                    *(u32x4*)(O + (size_t)row * ldc + colt + bj * HALF + wc * 32 + 8 * fq) = w;
                }
                if (m & 1) asm volatile("" ::: "memory");
            }
    }
};
struct EpiSwiglu {
    static constexpr bool PERM = true, AFTER_DRAIN = false;
    bf16_t* O; const float* ssq;
    __device__ __forceinline__ void operator()(const f32x4 (&acc)[2][2][4][2], const Unit& u, int wr, int wc, int fr, int fq) const {
        const int row0 = u.pm * BM + wr * 64 + fr, col = u.pn * HALF + wc * 32 + 8 * fq;
#pragma unroll
        for (int ai = 0; ai < 2; ++ai)
#pragma unroll
            for (int m = 0; m < 4; ++m) {
                const int row = row0 + ai * HALF + m * 16; const float rs = ssq ? rstd_row(ssq, row) : 1.0f;
                float o[8];
#pragma unroll
                for (int n = 0; n < 2; ++n)
#pragma unroll
                    for (int i = 0; i < 4; ++i) { const float a = acc[ai][0][m][n][i] * rs, b = acc[ai][1][m][n][i] * rs; o[4 * n + i] = siluf_(a) * b; }
                u32x4 w; w.x = cvt_pk_bf16(o[0], o[1]); w.y = cvt_pk_bf16(o[2], o[3]); w.z = cvt_pk_bf16(o[4], o[5]); w.w = cvt_pk_bf16(o[6], o[7]);
                *(u32x4*)(O + (size_t)row * DFF + col) = w;
                if (m & 1) asm volatile("" ::: "memory");
            }
    }
};
struct EpiResid {
    static constexpr bool PERM = true, AFTER_DRAIN = false;
    float* h; bf16_t* hb; float* ssq;
    __device__ __forceinline__ void operator()(const f32x4 (&acc)[2][2][4][2], const Unit& u, int wr, int wc, int fr, int fq) const {
        const int row0 = u.pm * BM + wr * 64 + fr, colt = u.pn * BM;
#pragma unroll
        for (int ai = 0; ai < 2; ++ai)
#pragma unroll
            for (int m = 0; m < 4; ++m) {
                const int row = row0 + ai * HALF + m * 16; float ss = 0.f;
#pragma unroll
                for (int bj = 0; bj < 2; ++bj) {
                    const size_t off = (size_t)row * D_ + colt + bj * HALF + wc * 32 + 8 * fq;
                    f32x4 x0 = *(const f32x4*)(h + off), x1 = *(const f32x4*)(h + off + 4);
                    x0 = x0 + acc[ai][bj][m][0]; x1 = x1 + acc[ai][bj][m][1];
                    *(f32x4*)(h + off) = x0; *(f32x4*)(h + off + 4) = x1;
                    ss += (x0[0] * x0[0] + x0[1] * x0[1]) + (x0[2] * x0[2] + x0[3] * x0[3]) + (x1[0] * x1[0] + x1[1] * x1[1]) + (x1[2] * x1[2] + x1[3] * x1[3]);
                    u32x4 w; w.x = cvt_pk_bf16(x0[0], x0[1]); w.y = cvt_pk_bf16(x0[2], x0[3]); w.z = cvt_pk_bf16(x1[0], x1[1]); w.w = cvt_pk_bf16(x1[2], x1[3]);
                    *(u32x4*)(hb + off) = w;
                }
                ss += __shfl_xor(ss, 16); ss += __shfl_xor(ss, 32);
                if (fq == 0) ssq[(size_t)row * 16 + u.pn * 4 + wc] = ss;
                asm volatile("" ::: "memory");
            }
    }
};
struct EpiPle {
    static constexpr bool PERM = true, AFTER_DRAIN = false;
    float* h; bf16_t* hb; const float* ssq_in; float* ssq_out; const bf16_t* pp;
    __device__ __forceinline__ void operator()(const f32x4 (&acc)[2][2][4][2], const Unit& u, int wr, int wc, int fr, int fq) const {
        const int row0 = u.pm * BM + wr * 64 + fr, colt = u.pn * BM;
#pragma unroll
        for (int ai = 0; ai < 2; ++ai)
#pragma unroll
            for (int m = 0; m < 4; ++m) {
                const int row = row0 + ai * HALF + m * 16; const float rs = rstd_row(ssq_in, row); float ss = 0.f;
#pragma unroll
                for (int bj = 0; bj < 2; ++bj) {
                    const size_t off = (size_t)row * D_ + colt + bj * HALF + wc * 32 + 8 * fq;
                    f32x4 x0 = *(const f32x4*)(h + off), x1 = *(const f32x4*)(h + off + 4);
                    const u32x4 pw = *(const u32x4*)(pp + off);
                    const f32x4 a0 = acc[ai][bj][m][0] * rs, a1 = acc[ai][bj][m][1] * rs;
                    x0[0] += sigmoidf_(a0[0]) * bf_lo(pw.x); x0[1] += sigmoidf_(a0[1]) * bf_hi(pw.x); x0[2] += sigmoidf_(a0[2]) * bf_lo(pw.y); x0[3] += sigmoidf_(a0[3]) * bf_hi(pw.y);
                    x1[0] += sigmoidf_(a1[0]) * bf_lo(pw.z); x1[1] += sigmoidf_(a1[1]) * bf_hi(pw.z); x1[2] += sigmoidf_(a1[2]) * bf_lo(pw.w); x1[3] += sigmoidf_(a1[3]) * bf_hi(pw.w);
                    *(f32x4*)(h + off) = x0; *(f32x4*)(h + off + 4) = x1;
                    ss += (x0[0] * x0[0] + x0[1] * x0[1]) + (x0[2] * x0[2] + x0[3] * x0[3]) + (x1[0] * x1[0] + x1[1] * x1[1]) + (x1[2] * x1[2] + x1[3] * x1[3]);
                    u32x4 w; w.x = cvt_pk_bf16(x0[0], x0[1]); w.y = cvt_pk_bf16(x0[2], x0[3]); w.z = cvt_pk_bf16(x1[0], x1[1]); w.w = cvt_pk_bf16(x1[2], x1[3]);
                    *(u32x4*)(hb + off) = w;
                }
                ss += __shfl_xor(ss, 16); ss += __shfl_xor(ss, 32);
                if (fq == 0) ssq_out[(size_t)row * 16 + u.pn * 4 + wc] = ss;
                asm volatile("" ::: "memory");
            }
    }
};
struct EpiMoeDown {
    static constexpr bool PERM = true, AFTER_DRAIN = false;
    bf16_t* Y; const float* gate;
    __device__ __forceinline__ void operator()(const f32x4 (&acc)[2][2][4][2], const Unit& u, int wr, int wc, int fr, int fq) const {
        const int row0 = u.pm * BM + wr * 64 + fr, colt = u.pn * BM;
#pragma unroll
        for (int ai = 0; ai < 2; ++ai)
#pragma unroll
            for (int m = 0; m < 4; ++m) {
                const int row = row0 + ai * HALF + m * 16; const float gt = gate[row];
#pragma unroll
                for (int bj = 0; bj < 2; ++bj) {
                    const f32x4 v0 = acc[ai][bj][m][0] * gt, v1 = acc[ai][bj][m][1] * gt;
                    u32x4 w; w.x = cvt_pk_bf16(v0[0], v0[1]); w.y = cvt_pk_bf16(v0[2], v0[3]); w.z = cvt_pk_bf16(v1[0], v1[1]); w.w = cvt_pk_bf16(v1[2], v1[3]);
                    *(u32x4*)(Y + (size_t)row * D_ + colt + bj * HALF + wc * 32 + 8 * fq) = w;
                }
                if (m & 1) asm volatile("" ::: "memory");
            }
    }
};

template <class Epi, class Sched, bool ALIGN_EPI = false, bool SP2 = false>
__device__ __forceinline__ void gemm_phase(PG8_LAS unsigned char* lds, const Gemm g, const Sched& S, const Epi& E) {
    int tid_ = threadIdx.x; asm volatile("" : "+v"(tid_));
    const int tid = tid_, wid = __builtin_amdgcn_readfirstlane(tid >> 6), lane = tid & 63, wr = wid >> 2, wc = wid & 3, fr = lane & 15, fq = lane >> 4;
    const int K = g.K, nt = K / BK;
    unsigned voffA[2], voffB[2];
#pragma unroll
    for (int i = 0; i < 2; ++i) { int R, C; stage_rc(tid * 16 + i * 8192, R, C); const int Rb = Epi::PERM ? ((R & ~31) + perm32(R & 31)) : R;
        voffA[i] = (unsigned)(R * K + C) * 2u; voffB[i] = (unsigned)(Rb * K + C) * 2u; }
    const size_t kstep = (size_t)(BK * 2);
    const size_t hstep = (size_t)HALF * K * 2;
    const size_t tstep = 2 * hstep;
    const unsigned ldsw = (unsigned)wid * 1024u;
    const int aoff = lds_byte(wr * 64 + fr, fq * 8), boff = lds_byte(wc * 32 + fr, fq * 8);
#define PG8_SA(b, h) (((b) * 2 + (h)) * HTB)
#define PG8_SB(b, h) ((4 + (b) * 2 + (h)) * HTB)
#define PG8_STAGE(bufoff, gbase, voff) do { _Pragma("unroll") for (int _i = 0; _i < 2; ++_i) \
        __builtin_amdgcn_global_load_lds((const unsigned*)((const char*)(gbase) + (voff)[_i]), (PG8_LAS unsigned*)(lds + (bufoff) + ldsw + _i * 8192), 16, 0, 0); } while (0)
#define PG8_LDA(dst, b, h) do { _Pragma("unroll") for (int m = 0; m < 4; ++m) _Pragma("unroll") for (int k = 0; k < 2; ++k) dst[m][k] = *(const PG8_LAS bf16x8*)(lds + PG8_SA(b, h) + aoff + m * 2048 + k * 1024); } while (0)
#define PG8_LDB(dst, b, h) do { _Pragma("unroll") for (int n = 0; n < 2; ++n) _Pragma("unroll") for (int k = 0; k < 2; ++k) dst[n][k] = *(const PG8_LAS bf16x8*)(lds + PG8_SB(b, h) + boff + n * 2048 + k * 1024); } while (0)
#define PG8_MMA(ai, bj, At, Bt) do { __builtin_amdgcn_s_setprio(1); _Pragma("unroll") for (int m = 0; m < 4; ++m) _Pragma("unroll") for (int n = 0; n < 2; ++n) _Pragma("unroll") for (int k = 0; k < 2; ++k) \
        acc[ai][bj][m][n] = __builtin_amdgcn_mfma_f32_16x16x32_bf16(Bt[n][k], At[m][k], acc[ai][bj][m][n], 0, 0, 0); __builtin_amdgcn_s_setprio(0); } while (0)
#define PG8_WAIT_V(n) asm volatile("s_waitcnt vmcnt(" #n ")" ::: "memory")
#define PG8_WAIT_L(n) asm volatile("s_waitcnt lgkmcnt(" #n ")" ::: "memory")
#define PG8_BAR __builtin_amdgcn_s_barrier()
#define PG8_SCHED __builtin_amdgcn_sched_barrier(0)
    Unit cur, nxt; int ui = 0;
    if (!S.next(0, cur)) return;
    f32x4 acc[2][2][4][2];
#pragma unroll
    for (int a = 0; a < 2; ++a)
#pragma unroll
        for (int b = 0; b < 2; ++b)
#pragma unroll
            for (int m = 0; m < 4; ++m)
#pragma unroll
                for (int n = 0; n < 2; ++n) acc[a][b][m][n] = (f32x4){0.f, 0.f, 0.f, 0.f};
    bf16x8 At[4][2], B0[2][2], B1[2][2];
    const char* cA = (const char*)g.A + (size_t)cur.pm * tstep; const char* cB = (const char*)g.Bt + (size_t)cur.pn * tstep + (size_t)cur.be * g.bstride;
    S.a_ready(cur);
    if constexpr (SP2) {
        PG8_STAGE(PG8_SB(0, 0), cB, voffB); PG8_STAGE(PG8_SB(0, 1), cB + hstep, voffB); PG8_STAGE(PG8_SA(0, 0), cA, voffA); PG8_STAGE(PG8_SA(0, 1), cA + hstep, voffA);
        if (wr == 1) PG8_BAR;
        PG8_WAIT_V(2); PG8_BAR;
        PG8_STAGE(PG8_SB(1, 0), cB + kstep, voffB); PG8_STAGE(PG8_SA(1, 0), cA + kstep, voffA); PG8_STAGE(PG8_SB(1, 1), cB + hstep + kstep, voffB);
        PG8_WAIT_V(6); PG8_BAR;
    } else {
        PG8_STAGE(PG8_SB(0, 0), cB, voffB); PG8_STAGE(PG8_SA(0, 0), cA, voffA); PG8_STAGE(PG8_SB(0, 1), cB + hstep, voffB); PG8_STAGE(PG8_SA(0, 1), cA + hstep, voffA);
        if (wr == 1) PG8_BAR;
        PG8_WAIT_V(4); PG8_BAR;
        PG8_STAGE(PG8_SB(1, 0), cB + kstep, voffB); PG8_STAGE(PG8_SA(1, 0), cA + kstep, voffA); PG8_STAGE(PG8_SB(1, 1), cB + hstep + kstep, voffB);
        PG8_WAIT_V(6); PG8_BAR;
    }
    for (;;) {
        const bool has_next = S.next(ui + 1, nxt);
        const char* nA = has_next ? (const char*)g.A + (size_t)nxt.pm * tstep : cA; const char* nB = has_next ? (const char*)g.Bt + (size_t)nxt.pn * tstep + (size_t)nxt.be * g.bstride : cB;
        for (int t = 0; t < nt; t += 2) {
            const bool last = (t == nt - 2);
            const char* a1 = cA + (size_t)(t + 1) * kstep;
            const char* a2 = last ? nA : cA + (size_t)(t + 2) * kstep; const char* b2 = last ? nB : cB + (size_t)(t + 2) * kstep;
            const char* a3 = a2 + kstep; const char* b3 = b2 + kstep;
            if (last && has_next) S.a_ready(nxt);
            if constexpr (SP2) {
            PG8_LDB(B0, 0, 0); PG8_LDB(B1, 0, 1); PG8_SCHED; PG8_LDA(At, 0, 0); PG8_STAGE(PG8_SA(1, 1), a1 + hstep, voffA);
            PG8_WAIT_V(8); PG8_WAIT_L(0); PG8_BAR; PG8_MMA(0, 0, At, B0); PG8_MMA(0, 1, At, B1); PG8_BAR; PG8_SCHED;
            PG8_LDA(At, 0, 1); PG8_STAGE(PG8_SB(0, 0), b2, voffB); PG8_STAGE(PG8_SB(0, 1), b2 + hstep, voffB); PG8_STAGE(PG8_SA(0, 0), a2, voffA);
            PG8_WAIT_V(8); PG8_WAIT_L(0); PG8_BAR; PG8_MMA(1, 0, At, B0); PG8_MMA(1, 1, At, B1); PG8_BAR; PG8_SCHED;
            PG8_LDB(B0, 1, 0); PG8_LDB(B1, 1, 1); PG8_SCHED; PG8_LDA(At, 1, 0); PG8_STAGE(PG8_SA(0, 1), a2 + hstep, voffA);
            PG8_WAIT_V(8); PG8_WAIT_L(0); PG8_BAR; PG8_MMA(0, 0, At, B0); PG8_MMA(0, 1, At, B1); PG8_BAR; PG8_SCHED;
            PG8_LDA(At, 1, 1); PG8_STAGE(PG8_SB(1, 0), b3, voffB); PG8_STAGE(PG8_SB(1, 1), b3 + hstep, voffB); PG8_STAGE(PG8_SA(1, 0), a3, voffA);
            PG8_WAIT_V(8); PG8_WAIT_L(0); PG8_BAR; PG8_MMA(1, 0, At, B0); PG8_MMA(1, 1, At, B1); PG8_BAR; PG8_SCHED;
            } else {
            PG8_LDB(B0, 0, 0); PG8_SCHED; PG8_LDA(At, 0, 0); PG8_STAGE(PG8_SA(1, 1), a1 + hstep, voffA);
            PG8_WAIT_L(8); PG8_BAR; PG8_WAIT_L(0); PG8_MMA(0, 0, At, B0); PG8_BAR; PG8_SCHED;
            PG8_LDB(B1, 0, 1); PG8_STAGE(PG8_SB(0, 0), b2, voffB);
            PG8_BAR; PG8_WAIT_L(0); PG8_MMA(0, 1, At, B1); PG8_BAR;
            PG8_LDA(At, 0, 1); PG8_STAGE(PG8_SA(0, 0), a2, voffA);
            PG8_BAR; PG8_WAIT_L(0); PG8_MMA(1, 0, At, B0); PG8_BAR; PG8_SCHED;
            PG8_STAGE(PG8_SB(0, 1), b2 + hstep, voffB);
            PG8_WAIT_V(6); PG8_BAR; PG8_MMA(1, 1, At, B1); PG8_BAR;
            PG8_LDB(B0, 1, 0); PG8_SCHED; PG8_LDA(At, 1, 0); PG8_STAGE(PG8_SA(0, 1), a2 + hstep, voffA);
            PG8_WAIT_L(8); PG8_BAR; PG8_WAIT_L(0); PG8_MMA(0, 0, At, B0); PG8_BAR; PG8_SCHED;
            PG8_LDB(B1, 1, 1); PG8_STAGE(PG8_SB(1, 0), b3, voffB);
            PG8_BAR; PG8_WAIT_L(0); PG8_MMA(0, 1, At, B1); PG8_BAR;
            PG8_LDA(At, 1, 1); PG8_STAGE(PG8_SA(1, 0), a3, voffA);
            PG8_BAR; PG8_WAIT_L(0); PG8_MMA(1, 0, At, B0); PG8_BAR; PG8_SCHED;
            PG8_STAGE(PG8_SB(1, 1), b3 + hstep, voffB);
            PG8_WAIT_V(6); PG8_BAR; PG8_MMA(1, 1, At, B1); PG8_BAR;
            }
        }
        if constexpr (ALIGN_EPI) { if (wr == 0) PG8_BAR; }
        if constexpr (!Epi::AFTER_DRAIN) { E(acc, cur, wr, wc, fr, fq); S.done(cur); }
        if (!has_next) break;
#pragma unroll
        for (int a = 0; a < 2; ++a)
#pragma unroll
            for (int b = 0; b < 2; ++b)
#pragma unroll
                for (int m = 0; m < 4; ++m)
#pragma unroll
                    for (int n = 0; n < 2; ++n) acc[a][b][m][n] = (f32x4){0.f, 0.f, 0.f, 0.f};
        cur = nxt; cA = nA; cB = nB; ++ui;
        if constexpr (ALIGN_EPI) { if (wr == 1) PG8_BAR; }
    }
    PG8_WAIT_V(0);
    if constexpr (!ALIGN_EPI) { if (wr == 0) PG8_BAR; }
    PG8_BAR;
    if constexpr (Epi::AFTER_DRAIN) { E.fused(acc, cur, wr, wc, fr, fq, lds, wid, lane); S.done(cur); }
#undef PG8_SA
#undef PG8_SB
#undef PG8_STAGE
#undef PG8_LDA
#undef PG8_LDB
#undef PG8_MMA
#undef PG8_WAIT_V
#undef PG8_WAIT_L
#undef PG8_BAR
#undef PG8_SCHED
}
}

#include <hip/hip_bf16.h>
#include <cmath>
namespace attn_body {
using bf16=__hip_bfloat16;
using bf16x8=__attribute__((ext_vector_type(8)))short;
using s16x4=__attribute__((ext_vector_type(4)))short;
using f32x16=__attribute__((ext_vector_type(16)))float;
using u32x4=__attribute__((ext_vector_type(4)))unsigned;
constexpr int SEQ=16384,D=64,LDP=3072,LDO=1024;
constexpr int NW=8,QBLK=32,QB=QBLK*NW,KVBLK=64,NQB=SEQ/QB;
constexpr int ATTN_UNIT_ROWS=QB;
__device__ __forceinline__ int crow(int r,int hi){return (r&3)+8*(r>>2)+4*hi;}
#define SBAR() __builtin_amdgcn_sched_barrier(0)
__device__ __forceinline__ void cmask(f32x16&p0,f32x16&p1,int jb,int qrel,int hi){
  const float NEG=-INFINITY; int kb=64*jb+4*hi;
  #pragma unroll
  for(int r=0;r<16;++r){int kv=kb+(r&3)+8*(r>>2); if(kv>qrel)p0[r]=NEG; if(kv+32>qrel)p1[r]=NEG;}
}

constexpr int NSLOT=3, SLOTB=8192, VSLOTB=2*SLOTB;
constexpr int LDS_K=0, LDS_V=NSLOT*SLOTB, LDS_WS=LDS_V+NSLOT*VSLOTB, LDS_OST=0  , LDS_BYTES=LDS_WS+NW*64*4;
constexpr float C2=0.125f*1.4426950408889634f;
__device__ __forceinline__ void glds16(const void*gsrc,unsigned lds_dst){unsigned keep;
  asm volatile("s_mov_b32 %0, m0\n\ts_mov_b32 m0, %2\n\ts_nop 0\n\tglobal_load_lds_dwordx4 %1, off\n\ts_mov_b32 m0, %0":"=&s"(keep):"v"(gsrc),"s"(lds_dst):"memory");}
__device__ __forceinline__ float max3f(float a,float b,float c){float r;asm("v_max3_f32 %0, %1, %2, %3":"=v"(r):"v"(a),"v"(b),"v"(c));return r;}
__device__ __forceinline__ float max2f(float a,float b){float r;asm("v_max_f32_e32 %0, %1, %2":"=v"(r):"v"(a),"v"(b));return r;}
__device__ __forceinline__ float fadd_s(float a,float b){float r;asm("v_add_f32_e32 %0, %1, %2":"=v"(r):"v"(a),"v"(b));return r;}
__device__ __forceinline__ float fsub_s(float a,float b){float r;asm("v_sub_f32_e32 %0, %1, %2":"=v"(r):"v"(a),"v"(b));return r;}
typedef float f32x2_t __attribute__((ext_vector_type(2))); typedef __bf16 bf16x2_t __attribute__((ext_vector_type(2)));
__device__ __forceinline__ unsigned cvtpk_s(float lo,float hi){f32x2_t v={lo,hi};bf16x2_t b=__builtin_convertvector(v,bf16x2_t);return __builtin_bit_cast(unsigned,b);}
#define WAIT_BAR(N) asm volatile("s_waitcnt vmcnt(" #N ") lgkmcnt(0)\n\ts_barrier":::"memory")

__device__ __forceinline__ void qkt(f32x16&p0,f32x16&p1,const char*Kslot,const bf16x8*qr,int r32,int hi){
  const char*kb=Kslot+hi*1024+r32*16;
  #pragma unroll
  for(int d0=0;d0<4;++d0){
    const bf16x8 b0=*reinterpret_cast<const bf16x8*>(kb+d0*2048);
    const bf16x8 b1=*reinterpret_cast<const bf16x8*>(kb+d0*2048+512);
    if(d0==0){p0=__builtin_amdgcn_mfma_f32_32x32x16_bf16(b0,qr[0],f32x16{},0,0,0);p1=__builtin_amdgcn_mfma_f32_32x32x16_bf16(b1,qr[0],f32x16{},0,0,0);}
    else{p0=__builtin_amdgcn_mfma_f32_32x32x16_bf16(b0,qr[d0],p0,0,0,0);p1=__builtin_amdgcn_mfma_f32_32x32x16_bf16(b1,qr[d0],p1,0,0,0);}}
}
typedef __attribute__((address_space(3))) const char* lds_cptr;
typedef short v4i16_t __attribute__((ext_vector_type(4)));
__device__ __forceinline__ void kload8(bf16x8*kf,lds_cptr kp){
  kf[0]=*(const __attribute__((address_space(3))) bf16x8*)(kp);      kf[1]=*(const __attribute__((address_space(3))) bf16x8*)(kp+512);
  kf[2]=*(const __attribute__((address_space(3))) bf16x8*)(kp+2048); kf[3]=*(const __attribute__((address_space(3))) bf16x8*)(kp+2560);
  kf[4]=*(const __attribute__((address_space(3))) bf16x8*)(kp+4096); kf[5]=*(const __attribute__((address_space(3))) bf16x8*)(kp+4608);
  kf[6]=*(const __attribute__((address_space(3))) bf16x8*)(kp+6144); kf[7]=*(const __attribute__((address_space(3))) bf16x8*)(kp+6656);
}
__device__ __forceinline__ void kload2(bf16x8*kf,lds_cptr kp,int j){ kf[2*j]=*(const __attribute__((address_space(3))) bf16x8*)(kp+j*2048); kf[2*j+1]=*(const __attribute__((address_space(3))) bf16x8*)(kp+j*2048+512); }
__device__ __forceinline__ s16x4 vtr(lds_cptr p){ return __builtin_bit_cast(s16x4,__builtin_amdgcn_ds_read_tr16_b64_v4i16((__attribute__((address_space(3))) v4i16_t*)p)); }
__device__ __forceinline__ float rowmax(const f32x16&p0,const f32x16&p1){
  float a=max3f(p0[0],p0[1],p1[0]),b=max3f(p0[2],p0[3],p1[1]);a=max3f(a,p1[2],p1[3]);
  #pragma unroll
  for(int r=4;r<16;r+=4){a=max3f(a,p0[r],p0[r+1]);b=max3f(b,p0[r+2],p0[r+3]);a=max3f(a,p1[r],p1[r+1]);b=max3f(b,p1[r+2],p1[r+3]);}
  const float m=max2f(a,b);
  auto rr=__builtin_amdgcn_permlane32_swap(__float_as_uint(m),__float_as_uint(m),false,false);
  return max2f(__uint_as_float(rr[0]),__uint_as_float(rr[1]));
}
__device__ __forceinline__ void pv(f32x16*o,int vb,bf16x8 pa0,bf16x8 pa1,bf16x8 pa2,bf16x8 pa3){
  #pragma unroll
  for(int d0=0;d0<4;++d0){s16x4 lo[4],hi[4];
    #pragma unroll
    for(int ks=0;ks<4;++ks){
      asm volatile("ds_read_b64_tr_b16 %0,%1 offset:%c2":"=&v"(lo[ks]):"v"(vb),"i"(d0*4096+ks*1024):"memory");
      asm volatile("ds_read_b64_tr_b16 %0,%1 offset:%c2":"=&v"(hi[ks]):"v"(vb),"i"(d0*4096+ks*1024+512):"memory");}
    asm volatile("s_waitcnt lgkmcnt(0)":::"memory");SBAR();
    #define PK(k) (bf16x8){lo[k][0],lo[k][1],lo[k][2],lo[k][3],hi[k][0],hi[k][1],hi[k][2],hi[k][3]}
    o[d0]=__builtin_amdgcn_mfma_f32_32x32x16_bf16(pa0,PK(0),o[d0],0,0,0);
    o[d0]=__builtin_amdgcn_mfma_f32_32x32x16_bf16(pa1,PK(1),o[d0],0,0,0);
    o[d0]=__builtin_amdgcn_mfma_f32_32x32x16_bf16(pa2,PK(2),o[d0],0,0,0);
    o[d0]=__builtin_amdgcn_mfma_f32_32x32x16_bf16(pa3,PK(3),o[d0],0,0,0);
    #undef PK
  }
}

#ifndef ATTN_STORE16
#define ATTN_STORE16(p,v) (*(u32x4*)(p)=(v))
#endif
template<int THRL> __device__ __forceinline__ void attn_unit(int qb,const bf16*Qh,const bf16*__restrict__ Kh,const bf16*__restrict__ Vh,bf16*Oh,char*shm){
  int tid_=threadIdx.x; asm volatile("":"+v"(tid_));
  const int tid=tid_,lane=tid&63,r32=lane&31,hi=lane>>5; const int wid=__builtin_amdgcn_readfirstlane(tid>>6);
  const int q0=qb*QB;
  const bf16*Qw=Qh+(long)(q0+wid*QBLK)*LDP;
  const unsigned lds0=(unsigned)(uintptr_t)shm;
  float*wsf=(float*)(shm+LDS_WS)+wid*64;
  const bf16*ksrc=Kh+(long)lane*LDP+wid*8;
  const bf16*vsrc=Vh+(long)(16*(wid&3)+(lane>>2))*LDP+(wid>>2)*32+(lane&3)*8;
  const unsigned kdst=lds0+LDS_K+wid*1024, vdst=lds0+LDS_V+wid*1024;
  #define DMA_K(t,slot) glds16(ksrc+(long)(t)*KVBLK*LDP,(unsigned)__builtin_amdgcn_readfirstlane(kdst+(slot)))
  #define DMA_V(t,slot) do{ glds16(vsrc+(long)(t)*KVBLK*LDP,(unsigned)__builtin_amdgcn_readfirstlane(vdst+2*(slot))); glds16(vsrc+64+(long)(t)*KVBLK*LDP,(unsigned)__builtin_amdgcn_readfirstlane(vdst+2*(slot)+8192)); }while(0)
  const int vb0=(int)(lds0+LDS_V)+((lane>>4)&1)*32+(lane&3)*8+(4*hi+((lane&15)>>2))*64;
  const char*Kbase=shm+LDS_K; bf16x8 kf[8];
  const lds_cptr shm3=(lds_cptr)shm; const lds_cptr kp0=shm3+LDS_K+hi*1024+r32*16; const lds_cptr vp0=shm3+LDS_V+((lane>>4)&1)*32+(lane&3)*8+(4*hi+((lane&15)>>2))*64;
  const int NT=(q0+QB)/KVBLK;
  DMA_K(0,0);DMA_V(0,0);DMA_K(1,SLOTB);
  bf16x8 qr[4];
  #pragma unroll
  for(int d0=0;d0<4;++d0)qr[d0]=*reinterpret_cast<const bf16x8*>(&Qw[(long)r32*LDP+d0*16+hi*8]);
  float mhat=0.f,l_reg=0.f;f32x16 o[4];o[0]=f32x16{};o[1]=f32x16{};o[2]=f32x16{};o[3]=f32x16{};
  const int qrel=wid*QBLK+r32;
  #define CMASK(P0,P1,t) do{int jb_=(t)-(NT-4); if(jb_>=0)cmask(P0,P1,jb_,qrel,hi);}while(0)
  bool resc=false;
  #define START(P0,P1) do{ const float rm=rowmax(P0,P1); resc=false; mhat=rm; \
    _Pragma("unroll") for(int r=0;r<16;++r)P0[r]=__builtin_amdgcn_exp2f(fsub_s(P0[r],mhat)); }while(0)
  #define RESC() do{ if(resc){ asm volatile("s_waitcnt lgkmcnt(0)":::"memory"); \
      _Pragma("unroll") for(int d_=0;d_<4;++d_) _Pragma("unroll") for(int r=0;r<16;++r)o[d_][r]*=wsf[crow(r,hi)]; } }while(0)
  f32x16 pA0,pA1,pB0,pB1;
  int sl_prev=0,sl_cur=0,sl_next=SLOTB;
  #define ROT() do{sl_prev=sl_cur;sl_cur=sl_next;sl_next=(sl_next==(NSLOT-1)*SLOTB)?0:sl_next+SLOTB;}while(0)
  DMA_K(2,2*SLOTB);
  WAIT_BAR(4);
  qkt(pA0,pA1,Kbase,qr,r32,hi);asm volatile("s_nop 15\n\ts_nop 7":"+v"(pA0),"+v"(pA1));CMASK(pA0,pA1,0);
  START(pA0,pA1);
  _Pragma("unroll") for(int r=0;r<16;++r)pA1[r]=__builtin_amdgcn_exp2f(pA1[r]-mhat);
  WAIT_BAR(0);
  DMA_K(3,0);DMA_V(1,SLOTB);
  ROT();
  kload8(kf,kp0+sl_cur);
  WAIT_BAR(3);
  s16x4 vlo[3],vhi[3]; u32x4 pw0,pw1,pw2,pw3;
  #define PKW(P,B) cvtpk_s(P[B],P[B+1])
  #define PAF(k) __builtin_bit_cast(bf16x8,pw##k)
  #define VFJ(j) (bf16x8){vlo[(j)%3][0],vlo[(j)%3][1],vlo[(j)%3][2],vlo[(j)%3][3],vhi[(j)%3][0],vhi[(j)%3][1],vhi[(j)%3][2],vhi[(j)%3][3]}
  #define PIN(x) asm volatile("":"+v"(x))
  #define MX3(a,b,c) __builtin_fmaxf(__builtin_fmaxf((a),(b)),(c))
  #define GAPA(MF,A0,A1,A2,A3,W0,W1,PW) do{ MF; sacc+=A0; sacc+=A1; sacc+=A2; sacc+=A3; PIN(sacc); W0; W1; PIN(PW); SBAR(); }while(0)
  #define EX(v) __builtin_amdgcn_exp2f(v)
  #define VJ(j) do{ vlo[(j)%3]=vtr(vp_+(((j)&3)*4096+((j)>>2)*1024)); vhi[(j)%3]=vtr(vp_+(((j)&3)*4096+((j)>>2)*1024+512)); }while(0)
  #define PVJ(j,PA,X,B) do{ if((j)+2<16){ VJ((j)+2); SBAR(); } o[(j)&3]=__builtin_amdgcn_mfma_f32_32x32x16_bf16(PA,VFJ(j),o[(j)&3],0,0,0); X[B]=EX(X[B]-mhat); X[B+1]=EX(X[B+1]-mhat); PIN(X); SBAR(); }while(0)
  #define KRD(G,j) do{ if(G){ kload2(kf,kp0+sl_next,j); SBAR(); } }while(0)
  #define STEP(C0,C1,P0,P1,t,GK,GV,GL) do{ SBAR(); \
    const lds_cptr vp_=vp0+2*sl_prev; \
    float sacc=(P0[0]+P0[1]); \
    GAPA(C0=__builtin_amdgcn_mfma_f32_32x32x16_bf16(kf[0],qr[0],f32x16{},0,0,0), P0[2],P0[3],P0[4],P0[5],     pw0[0]=PKW(P0,0), pw0[1]=PKW(P0,2), pw0); \
    GAPA(C1=__builtin_amdgcn_mfma_f32_32x32x16_bf16(kf[1],qr[0],f32x16{},0,0,0), P0[6],P0[7],P0[8],P0[9],     pw0[2]=PKW(P0,4), pw0[3]=PKW(P0,6), pw0); \
    GAPA(C0=__builtin_amdgcn_mfma_f32_32x32x16_bf16(kf[2],qr[1],C0,0,0,0),   P0[10],P0[11],P0[12],P0[13], pw1[0]=PKW(P0,8), pw1[1]=PKW(P0,10), pw1); \
    GAPA(C1=__builtin_amdgcn_mfma_f32_32x32x16_bf16(kf[3],qr[1],C1,0,0,0),   P0[14],P0[15],P1[0],P1[1],   pw1[2]=PKW(P0,12),pw1[3]=PKW(P0,14), pw1); \
    GAPA(C0=__builtin_amdgcn_mfma_f32_32x32x16_bf16(kf[4],qr[2],C0,0,0,0),   P1[2],P1[3],P1[4],P1[5],     pw2[0]=PKW(P1,0), pw2[1]=PKW(P1,2), pw2); \
    GAPA(C1=__builtin_amdgcn_mfma_f32_32x32x16_bf16(kf[5],qr[2],C1,0,0,0),   P1[6],P1[7],P1[8],P1[9],     pw2[2]=PKW(P1,4), pw2[3]=PKW(P1,6), pw2); \
    GAPA(C0=__builtin_amdgcn_mfma_f32_32x32x16_bf16(kf[6],qr[3],C0,0,0,0),   P1[10],P1[11],P1[12],P1[13], pw3[0]=PKW(P1,8), pw3[1]=PKW(P1,10), pw3); \
    GAPA(C1=__builtin_amdgcn_mfma_f32_32x32x16_bf16(kf[7],qr[3],C1,0,0,0),   P1[14],P1[15],0.f,0.f,       pw3[2]=PKW(P1,12),pw3[3]=PKW(P1,14), pw3); \
    l_reg+=sacc; VJ(0); VJ(1); SBAR(); \
 \
    if(GK){DMA_K((t)+3,sl_cur);} if(GV){DMA_V((t)+1,sl_next);} \
    CMASK(C0,C1,t); \
    { float a=MX3(C0[0],C0[1],C1[0]),b=MX3(C0[2],C0[3],C1[1]); a=MX3(a,C1[2],C1[3]); \
      _Pragma("unroll") for(int r=4;r<16;r+=4){a=MX3(a,C0[r],C0[r+1]);b=MX3(b,C0[r+2],C0[r+3]);a=MX3(a,C1[r],C1[r+1]);b=MX3(b,C1[r+2],C1[r+3]);} \
      float rm=__builtin_fmaxf(a,b); { auto rr=__builtin_amdgcn_permlane32_swap(__float_as_uint(rm),__float_as_uint(rm),false,false); rm=__builtin_fmaxf(__uint_as_float(rr[0]),__uint_as_float(rr[1])); } \
      resc=false; const float rel=rm-mhat; \
      if(__builtin_expect(__any(rel>(float)THRL),0)){ const float dl=__builtin_fmaxf(rel,0.f); mhat+=dl; \
        const float f=__builtin_amdgcn_exp2f(-dl); l_reg*=f; if(hi==0)wsf[r32]=f; resc=true; } } \
    SBAR(); \
    PVJ(0, PAF(0),C0,0);  PVJ(1, PAF(0),C0,2);  PVJ(2, PAF(0),C0,4);  PVJ(3, PAF(0),C0,6); \
    KRD(GL,0); PVJ(4, PAF(1),C0,8);  PVJ(5, PAF(1),C0,10); KRD(GL,1); PVJ(6, PAF(1),C0,12); PVJ(7, PAF(1),C0,14); \
    KRD(GL,2); PVJ(8, PAF(2),C1,0);  PVJ(9, PAF(2),C1,2);  KRD(GL,3); PVJ(10,PAF(2),C1,4);  PVJ(11,PAF(2),C1,6); \
    PVJ(12,PAF(3),C1,8);  PVJ(13,PAF(3),C1,10); PVJ(14,PAF(3),C1,12); PVJ(15,PAF(3),C1,14); \
    }while(0)
  int t=1;
  #undef CMASK
  #define CMASK(P0,P1,t) do{}while(0)
  for(;t+5<NT;t+=2){
    STEP(pB0,pB1,pA0,pA1,t,true,true,true);     WAIT_BAR(3); RESC(); ROT();
    STEP(pA0,pA1,pB0,pB1,t+1,true,true,true);   WAIT_BAR(3); RESC(); ROT();
  }
  #undef CMASK
  int hi_b=hi,qrel_b=qrel; asm volatile("":"+v"(hi_b),"+v"(qrel_b));
  #define CMASK(P0,P1,t) do{int jb_=(t)-(NT-4); if(jb_>=0)cmask(P0,P1,jb_,qrel_b,hi_b);}while(0)
  #define ENDW(tt) do{ if((tt)+3<NT){WAIT_BAR(3);} else if((tt)+2<NT){WAIT_BAR(2);} else {WAIT_BAR(0);} }while(0)
  for(;t+1<NT;t+=2){
    STEP(pB0,pB1,pA0,pA1,t,(t+3<NT),(t+1<NT),(t+1<NT));       ENDW(t);   RESC(); ROT();
    STEP(pA0,pA1,pB0,pB1,t+1,(t+4<NT),(t+2<NT),(t+2<NT));     ENDW(t+1); RESC(); ROT();
  }
  STEP(pB0,pB1,pA0,pA1,NT-1,false,false,false); RESC();
  { float sacc=pB0[0]+pB0[1]; _Pragma("unroll") for(int r=2;r<16;++r)sacc+=pB0[r]; _Pragma("unroll") for(int r=0;r<16;++r)sacc+=pB1[r]; l_reg+=sacc;
    pw0=(u32x4){PKW(pB0,0),PKW(pB0,2),PKW(pB0,4),PKW(pB0,6)};pw1=(u32x4){PKW(pB0,8),PKW(pB0,10),PKW(pB0,12),PKW(pB0,14)};pw2=(u32x4){PKW(pB1,0),PKW(pB1,2),PKW(pB1,4),PKW(pB1,6)};pw3=(u32x4){PKW(pB1,8),PKW(pB1,10),PKW(pB1,12),PKW(pB1,14)};
    SBAR(); pv(o,vb0+2*sl_cur,PAF(0),PAF(1),PAF(2),PAF(3)); }
  #undef PKW
  #undef PAF
  #undef VFJ
  #undef VJ
  #undef PVJ
  #undef PIN
  #undef MX3
  #undef GAPA
  #undef EX
  #undef KRD
  #undef STEP
  #undef ENDW
  int lanee=lane; asm volatile("":"+v"(lanee)); const int r32e=lanee&31,hie=lanee>>5;
  {auto rr=__builtin_amdgcn_permlane32_swap(__float_as_uint(l_reg),__float_as_uint(l_reg),false,false);l_reg=__uint_as_float(rr[0])+__uint_as_float(rr[1]);}
  if(hie==0)wsf[32+r32e]=l_reg;asm volatile("s_waitcnt lgkmcnt(0)":::"memory");
  float rli[16];
  #pragma unroll
  for(int r=0;r<16;++r)rli[r]=__builtin_amdgcn_rcpf(wsf[32+crow(r,hie)]);
  bf16*Ow=Oh+(long)(q0+wid*QBLK)*LDO;
  asm volatile("s_waitcnt lgkmcnt(0)\n\ts_barrier":::"memory");
  { bf16*stg=(bf16*)(shm)+wid*4096;
    #pragma unroll
    for(int r=0;r<16;++r){const int orow=crow(r,hie);
      #pragma unroll
      for(int d0=0;d0<4;++d0)stg[orow*128+d0*32+r32e]=__float2bfloat16(o[d0][r]*rli[r]);}
    asm volatile("s_waitcnt lgkmcnt(0)":::"memory");
    #pragma unroll
    for(int i=0;i<8;++i){const int row=i*4+(lanee>>4),ch=lanee&15; const u32x4 v=*(const u32x4*)(stg+row*128+ch*8); ATTN_STORE16(Ow+(long)row*LDO+ch*8,v);} }
  asm volatile("s_waitcnt lgkmcnt(0)\n\ts_barrier":::"memory");
  #undef DMA_K
  #undef DMA_V
  #undef CMASK
  #undef START
  #undef RESC
  #undef ROT
}
constexpr int ATTN_LDS_BYTES=LDS_BYTES;
template<int THRL=8> __device__ __forceinline__ void attn_phase(char*lds,const bf16*PE,bf16*AO,int vcu,int G){
  const int nu=(G==256)?2:((8*NQB-vcu+G-1)/G);
  #pragma unroll 1
  for(int i=0;i<nu;++i){
    int h2,qb;
    if(G==256){ const int s=vcu&31; h2=vcu>>5; qb=(i==0)?s:63-s; }
    else { const int u=vcu+i*G; h2=u/NQB; qb=u%NQB; }
    attn_unit<THRL>(qb,PE+h2*64,PE+512+h2*64,PE+1024+(h2>>1)*128,AO+h2*128,lds);
  }
}
#undef SBAR
#undef WAIT_BAR
}

#define GAS __attribute__((address_space(1)))
#define LAS __attribute__((address_space(3)))
typedef unsigned short bf16;
typedef unsigned v4u __attribute__((ext_vector_type(4)));
typedef float f32x4 __attribute__((ext_vector_type(4)));
typedef short bf16x8 __attribute__((ext_vector_type(8)));
typedef GAS unsigned gu32;
typedef GAS unsigned long long gu64;
#define RLX_AGENT __ATOMIC_RELAXED, __HIP_MEMORY_SCOPE_AGENT
#define LDS_WAIT() asm volatile("s_waitcnt lgkmcnt(0)" ::: "memory")
#define VM_WAIT() asm volatile("s_waitcnt vmcnt(0)" ::: "memory")
__device__ __forceinline__ unsigned long long rt() { return __builtin_amdgcn_s_memrealtime(); }
__device__ __forceinline__ unsigned f2bf(float f) { unsigned u = __builtin_bit_cast(unsigned, f); return (u + 0x7fffu + ((u >> 16) & 1u)) >> 16; }
__device__ __forceinline__ unsigned pk2(float lo, float hi) { return f2bf(lo) | (f2bf(hi) << 16); }

#define XB_TMO      128
#define XB_XCNT(j)  (256  + 64 * (j))
#define XB_XSUB(j)  (1280 + 64 * (j))
#define XB_XGEN(j)  (2304 + 64 * (j))
#define XB_TOP      3328
#define XB_TOPGEN   3392
#define XCD_BAR_WORDS 3456
#define XB_SPIN_CAP (1u << 18)

__device__ __forceinline__ unsigned xb_ld(unsigned* p)              { return __hip_atomic_load(p, __ATOMIC_RELAXED, __HIP_MEMORY_SCOPE_AGENT); }
__device__ __forceinline__ unsigned xb_add(unsigned* p, unsigned v) { return __hip_atomic_fetch_add(p, v, __ATOMIC_RELAXED, __HIP_MEMORY_SCOPE_AGENT); }
__device__ __forceinline__ unsigned xb_xcc_id() { return (unsigned)__builtin_amdgcn_s_getreg((3 << 11) | 20) & 0xFu; }
#define XB_SPIN(cond, bar) do { unsigned _sp = 0; while (cond) { __builtin_amdgcn_s_sleep(1); \
    if ((++_sp & 255u) == 0u) { if (xb_ld(&(bar)[XB_TMO])) break; if (_sp > XB_SPIN_CAP) { atomicAdd(&(bar)[XB_TMO], 1u); break; } } } } while (0)

struct XcdBarrier {
    unsigned* bar; unsigned x;
    volatile LAS unsigned* st;
};

__device__ __forceinline__ XcdBarrier xcd_barrier_post(unsigned* bar, volatile LAS unsigned* st) {
    XcdBarrier b; b.bar = bar; b.x = xb_xcc_id(); b.st = st;
    if (threadIdx.x == 0) (void)xb_add(&bar[XB_XCNT(b.x)], 1u);
    return b;
}
__device__ __forceinline__ void xcd_barrier_complete(unsigned* bar, unsigned x, unsigned& nloc, unsigned& nx) {
    const unsigned G = gridDim.x * gridDim.y * gridDim.z;
    unsigned sum, cnt, mine, sp = 0u;
    for (;;) {
        sum = 0u; cnt = 0u; mine = 0u;
#pragma unroll
        for (unsigned j = 0; j < 16; ++j) { const unsigned c = xb_ld(&bar[XB_XCNT(j)]); sum += c; cnt += (c > 0u) ? 1u : 0u; mine = (j == x) ? c : mine; }
        if (sum == G) break;
        __builtin_amdgcn_s_sleep(1);
        if ((++sp & 255u) == 0u) { if (xb_ld(&bar[XB_TMO])) break; if (sp > XB_SPIN_CAP) { atomicAdd(&bar[XB_TMO], 1u); break; } }
    }
    nloc = mine > 0u ? mine : 1u; nx = cnt > 0u ? cnt : 1u;
}

__device__ __forceinline__ void xcd_barrier(const XcdBarrier& b) {
    asm volatile("s_waitcnt vmcnt(0)" ::: "memory");
    __syncthreads();
    if (threadIdx.x == 0) {
        unsigned* bar = b.bar;
        __builtin_amdgcn_s_waitcnt(0);
        unsigned nloc = b.st[0], nx = b.st[1];
        if (nloc == 0u) { xcd_barrier_complete(bar, b.x, nloc, nx); b.st[0] = nloc; b.st[1] = nx; }
        const unsigned old = xb_add(&bar[XB_XSUB(b.x)], 1u);
        const unsigned gen = old / nloc;
        if (old + 1u == (gen + 1u) * nloc) {
            __builtin_amdgcn_fence(__ATOMIC_RELEASE, "agent");
            asm volatile("s_waitcnt vmcnt(0)" ::: "memory");
            const unsigned og = xb_add(&bar[XB_TOP], 1u);
            const unsigned tg = og / nx;
            if (og + 1u == (tg + 1u) * nx) xb_add(&bar[XB_TOPGEN], 1u);
            else XB_SPIN(xb_ld(&bar[XB_TOPGEN]) == tg, bar);
            __builtin_amdgcn_fence(__ATOMIC_ACQUIRE, "agent");
            xb_add(&bar[XB_XGEN(b.x)], 1u);
            asm volatile("s_waitcnt vmcnt(0)" ::: "memory");
        } else {
            XB_SPIN(xb_ld(&bar[XB_XGEN(b.x)]) == gen, bar);
            __builtin_amdgcn_fence(__ATOMIC_ACQUIRE, "agent");
            asm volatile("s_waitcnt vmcnt(0)" ::: "memory");
        }
    }
    __syncthreads();
}

constexpr int NWAVES = 8;
constexpr size_t MiB = 1u << 20;
constexpr size_t WS_CTL = 0, CTL_ZERO_BYTES = 1 * MiB;
constexpr size_t WS_TAB = 1 * MiB;
constexpr size_t WS_SSQA = 2 * MiB, WS_SSQB = 3 * MiB;
constexpr size_t WS_GB = 4 * MiB;
constexpr size_t WS_GC = 512 * 1024;
constexpr size_t WS_TOK = 5 * MiB;
constexpr size_t WS_W = 6 * MiB;
constexpr size_t WS_WINE = WS_W, WS_WOUTE = WS_W + 12 * MiB, WS_W13D = WS_W + 16 * MiB, WS_W2D = WS_W + 44 * MiB, WS_WINO = WS_W + 58 * MiB, WS_WOUTO = WS_W + 74 * MiB,
                 WS_WG = WS_W + 78 * MiB, WS_WP = WS_W + 86 * MiB, WS_W13M = WS_W + 88 * MiB, WS_W2M = WS_W + 200 * MiB;
constexpr size_t WS_PBF = 262 * MiB, WS_HBF = 294 * MiB, WS_PP = 326 * MiB, WS_MIX = 358 * MiB, WS_ARENA = 390 * MiB;
constexpr size_t AR_PE = 0, AR_AO = 96 * MiB;
constexpr size_t AR_PO = 0, AR_QN = 128 * MiB, AR_QT = 160 * MiB, AR_KN = 192 * MiB, AR_KGT = 224 * MiB, AR_VBT = 256 * MiB, AR_KTT = 288 * MiB, AR_AI = 320 * MiB, AR_NEGW = 336 * MiB,
                 AR_UT = 368 * MiB, AR_MP = 400 * MiB, AR_NT = 464 * MiB, AR_WT = 528 * MiB, AR_SG = 192 * MiB  , AR_MPC = 288 * MiB  , AR_NTC = 304 * MiB, AR_END = 560 * MiB;
constexpr size_t AR_ACT = 0, AR_XS = 240 * MiB, AR_Y = 308 * MiB;
constexpr size_t WS_NEED = WS_ARENA + AR_END;
constexpr size_t TOK_E = 0, TOK_R = 128 * 1024, TOK_G = 256 * 1024, TOK_DST = 384 * 1024, TOK_GPAD = 512 * 1024, TOK_DN = 704 * 1024, TOK_DNC = 720 * 1024;
constexpr int CW_TMO = 0, CW_BAR = 4096, CW_CNT = 8192  , CW_DBG = 12288;

constexpr int RING_OFF = 0, WAVE_LDS = 17408;
constexpr int LDSCTL_OFF = 139264, MISC_OFF = LDSCTL_OFF + 64, BLKE_OFF = LDSCTL_OFF + 256  , RT_OFF = LDSCTL_OFF + 1024  ;
constexpr int LDS_BYTES = 147456;

typedef unsigned u32x2v __attribute__((ext_vector_type(2)));
__device__ __forceinline__ float bflo(unsigned w) { return __uint_as_float(w << 16); }
__device__ __forceinline__ float bfhi(unsigned w) { return __uint_as_float(w & 0xffff0000u); }
__device__ __forceinline__ unsigned cvtpk(float lo, float hi) { return pg8::cvt_pk_bf16_cv(lo, hi); }
__device__ __forceinline__ float wave_sum(float v) {
#pragma unroll
    for (int o = 1; o < 64; o <<= 1) v += __shfl_xor(v, o);
    return v;
}
__device__ __forceinline__ float sigm(float x) { return pg8::sigmoidf_(x); }
__device__ __forceinline__ float silu(float x) { return x * pg8::sigmoidf_(x); }

struct Args { const void* in[30]; float* out; unsigned char* ws; int ph_lo, ph_hi, use_bar, pad; };

struct Frame {
    LAS unsigned char* lds; int tid, lane, wave, vcu, G, gw, NGW;
};

__device__ __forceinline__ void xpose_item(const float* W, int ldw, int K, int N, const float* gain, bf16* WT, int ilv, LAS float* scr, int item, int lane) {
    const int nblk = N / 64, kb = item / nblk, nb = item % nblk, k0 = 64 * kb, n0 = 64 * nb;
    const int lr = lane >> 4, lc = (lane & 15) * 4;
    f32x4 v[16];
#pragma unroll
    for (int i = 0; i < 16; ++i) v[i] = *(const GAS f32x4*)(W + (size_t)(k0 + 4 * i + lr) * ldw + n0 + lc);
    if (gain) {
#pragma unroll
        for (int i = 0; i < 16; ++i) v[i] = v[i] * gain[k0 + 4 * i + lr]; }
#pragma unroll
    for (int i = 0; i < 16; ++i) { LAS float* s = scr + (4 * i + lr) * 65 + lc; s[0] = v[i][0]; s[1] = v[i][1]; s[2] = v[i][2]; s[3] = v[i][3]; }
    LDS_WAIT(); asm volatile("" ::: "memory");
    const int c = lane & 7;
#pragma unroll
    for (int j = 0; j < 8; ++j) { const int nl = (lane >> 3) + 8 * j, n = n0 + nl; const LAS float* s = scr + (8 * c) * 65 + nl;
        const int dr = ilv ? (((n >> 7) << 8) + (n & 127) + (ilv == 2 ? 128 : 0)) : n;
        v4u o; o.x = pk2(s[0 * 65], s[1 * 65]); o.y = pk2(s[2 * 65], s[3 * 65]); o.z = pk2(s[4 * 65], s[5 * 65]); o.w = pk2(s[6 * 65], s[7 * 65]);
        *(GAS v4u*)(WT + (size_t)dr * K + k0 + 8 * c) = o; }
    LDS_WAIT(); asm volatile("" ::: "memory");
}
struct MatD { const float* W; int ldw, K, N; const float* gain; bf16* WT; int ilv; int items; };
__device__ __forceinline__ MatD dense_mat(const Args& a, int id) {
    unsigned char* ws = a.ws; MatD m; m.gain = nullptr; m.ilv = 0;
    if (id < 2)       { const int j = id;      m.W = (const float*)a.in[7] + (size_t)j * D_ * EIN;    m.ldw = EIN; m.K = D_; m.N = EIN; m.gain = (const float*)a.in[3] + (2 * j) * D_; m.WT = (bf16*)(ws + WS_WINE) + (size_t)j * EIN * D_; }
    else if (id < 4)  { const int j = id - 2;  m.W = (const float*)a.in[8] + (size_t)j * D_ * D_;     m.ldw = D_; m.K = D_; m.N = D_; m.WT = (bf16*)(ws + WS_WOUTE) + (size_t)j * D_ * D_; }
    else if (id < 6)  { const int j = id - 4;  m.W = (const float*)a.in[21] + (size_t)j * D_ * DFF;   m.ldw = DFF; m.K = D_; m.N = DFF; m.gain = (const float*)a.in[4] + (2 * j) * D_; m.WT = (bf16*)(ws + WS_W13D) + (size_t)j * 2 * DFF * D_; m.ilv = 1; }
    else if (id < 8)  { const int j = id - 6;  m.W = (const float*)a.in[22] + (size_t)j * D_ * DFF;   m.ldw = DFF; m.K = D_; m.N = DFF; m.gain = (const float*)a.in[4] + (2 * j) * D_; m.WT = (bf16*)(ws + WS_W13D) + (size_t)j * 2 * DFF * D_; m.ilv = 2; }
    else if (id < 10) { const int j = id - 8;  m.W = (const float*)a.in[23] + (size_t)j * DFF * D_;   m.ldw = D_; m.K = DFF; m.N = D_; m.WT = (bf16*)(ws + WS_W2D) + (size_t)j * D_ * DFF; }
    else if (id < 12) { const int j = id - 10; m.W = (const float*)a.in[15] + (size_t)j * D_ * OIN_SRC; m.ldw = OIN_SRC; m.K = D_; m.N = OIN; m.gain = (const float*)a.in[3] + (2 * j + 1) * D_; m.WT = (bf16*)(ws + WS_WINO) + (size_t)j * OIN * D_; }
    else if (id < 14) { const int j = id - 12; m.W = (const float*)a.in[20] + (size_t)j * D_ * D_;    m.ldw = D_; m.K = D_; m.N = D_; m.WT = (bf16*)(ws + WS_WOUTO) + (size_t)j * D_ * D_; }
    else if (id < 18) { const int i = id - 14; m.W = (const float*)a.in[28] + (size_t)i * D_ * D_;    m.ldw = D_; m.K = D_; m.N = D_; m.gain = (const float*)a.in[5] + i * D_; m.WT = (bf16*)(ws + WS_WG) + (size_t)i * D_ * D_; }
    else              { const int i = id - 18; m.W = (const float*)a.in[29] + (size_t)i * PLE * D_;   m.ldw = D_; m.K = PLE; m.N = D_; m.WT = (bf16*)(ws + WS_WP) + (size_t)i * D_ * PLE; }
    m.items = (m.K / 64) * (m.N / 64); return m;
}
__device__ __forceinline__ MatD moe_mat(const Args& a, int j, int id) {
    unsigned char* ws = a.ws; MatD m; m.gain = nullptr; m.ilv = 0; const int e = id / 3, k = id % 3;
    if (k < 2) { m.W = (const float*)a.in[25 + k] + ((size_t)j * NEXP + e) * D_ * DFF; m.ldw = DFF; m.K = D_; m.N = DFF; m.gain = (const float*)a.in[4] + (2 * j + 1) * D_; m.WT = (bf16*)(ws + WS_W13M) + (size_t)e * 2 * DFF * D_; m.ilv = 1 + k; }
    else       { m.W = (const float*)a.in[27] + ((size_t)j * NEXP + e) * DFF * D_; m.ldw = D_; m.K = DFF; m.N = D_; m.WT = (bf16*)(ws + WS_W2M) + (size_t)e * D_ * DFF; }
    m.items = (m.K / 64) * (m.N / 64); return m;
}

__device__ __forceinline__ void p_prologue(const Frame& F, const Args& a) {
    LAS float* scr = (LAS float*)(F.lds + F.wave * WAVE_LDS);
    unsigned char* ws = a.ws;
    {
        int base = 0;
#pragma unroll 1
        for (int id = 0; id < 22; ++id) { const MatD m = dense_mat(a, id);
            int first = (F.gw - base) % F.NGW; if (first < 0) first += F.NGW;
#pragma unroll 1
            for (int it = first; it < m.items; it += F.NGW) xpose_item(m.W, m.ldw, m.K, m.N, m.gain, m.WT, m.ilv, scr, it, F.lane);
            base += m.items; }
    }
    { const float* p = (const float*)a.in[1]; bf16* pb = (bf16*)(ws + WS_PBF); const size_t n8 = (size_t)DEPTH_ * S_ * PLE / 8;
#pragma unroll 1
      for (size_t i = (size_t)F.gw * 64 + F.lane; i < n8; i += (size_t)F.NGW * 64) { const f32x4 x0 = *(const GAS f32x4*)(p + i * 8), x1 = *(const GAS f32x4*)(p + i * 8 + 4);
          v4u o; o.x = cvtpk(x0[0], x0[1]); o.y = cvtpk(x0[2], x0[3]); o.z = cvtpk(x1[0], x1[1]); o.w = cvtpk(x1[2], x1[3]); *(GAS v4u*)(pb + i * 8) = o; } }
    { const float* x = (const float*)a.in[0]; bf16* hb = (bf16*)(ws + WS_HBF); float* ssq = (float*)(ws + WS_SSQB);
#pragma unroll 1
      for (int m = F.gw; m < S_; m += F.NGW) { const GAS f32x4* xr = (const GAS f32x4*)(x + (size_t)m * D_) + F.lane; float s = 0.f;
#pragma unroll
          for (int j = 0; j < 4; ++j) { const f32x4 v = xr[64 * j]; s += (v[0] * v[0] + v[1] * v[1]) + (v[2] * v[2] + v[3] * v[3]);
              *((GAS f32x4*)(a.out + (size_t)m * D_) + F.lane + 64 * j) = v;
              u32x2v o; o.x = cvtpk(v[0], v[1]); o.y = cvtpk(v[2], v[3]); *((GAS u32x2v*)(hb + (size_t)m * D_) + F.lane + 64 * j) = o; }
          s = wave_sum(s);
          if (F.lane < 16) ssq[(size_t)m * 16 + F.lane] = (F.lane == 0) ? s : 0.f; } }
    { const int* pos = (const int*)a.in[2]; float* tab = (float*)(ws + WS_TAB);
#pragma unroll 1
      for (int idx = F.gw * 64 + F.lane; idx < S_ * 8; idx += F.NGW * 64) { const int row = idx >> 3, i = idx & 7;
          const float inv = exp2f(-(float)i * (18.931568569324174f / 8.0f));
          const float ang = (float)pos[row] * inv;
          double t = (double)ang * 0.15915494309189535; t -= rint(t); const float tf = (float)t;
          tab[(size_t)row * 16 + i] = __builtin_amdgcn_cosf(tf); tab[(size_t)row * 16 + 8 + i] = __builtin_amdgcn_sinf(tf); } }
}

__device__ __forceinline__ void p_mixprep(const Frame& F, const Args& a, int L) {
    GAS unsigned char* ws = (GAS unsigned char*)a.ws; asm volatile("" : "+s"(ws)); int lane_ = F.lane; asm volatile("" : "+v"(lane_)); const int j = L >> 1, lane = lane_;
    const bf16* AO = (const bf16*)(ws + WS_ARENA + AR_AO); const bf16* PE = (const bf16*)(ws + WS_ARENA + AR_PE); bf16* mix = (bf16*)(ws + WS_MIX);
    const float lam0 = 0.8f - 0.6f * expf(-0.3f * (float)L);
    float s1 = ((const float*)a.in[9])[j * 64 + lane] * ((const float*)a.in[10])[j * 64 + lane], s2 = ((const float*)a.in[11])[j * 64 + lane] * ((const float*)a.in[12])[j * 64 + lane];
    s1 = wave_sum(s1); s2 = wave_sum(s2);
    const float lam = expf(s1) - expf(s2) + lam0, post = 1.0f - lam0;
    const int hh = lane >> 4, dd = (lane & 15) * 8, ch = lane * 8;
    float sg[8], w0[8], w1[8], w2[8];
#pragma unroll
    for (int e = 0; e < 8; ++e) { sg[e] = ((const float*)a.in[13])[j * 128 + dd + e] * post;
        w0[e] = ((const float*)a.in[14])[(j * 3 + 0) * 512 + ch + e]; w1[e] = ((const float*)a.in[14])[(j * 3 + 1) * 512 + ch + e]; w2[e] = ((const float*)a.in[14])[(j * 3 + 2) * 512 + ch + e]; }
#pragma unroll 1
    for (int t = F.gw; t < S_; t += F.NGW) {
        const v4u o1 = *(const GAS v4u*)(AO + (size_t)t * D_ + 256 * hh + dd), o2 = *(const GAS v4u*)(AO + (size_t)t * D_ + 256 * hh + 128 + dd);
        float d[8]; const unsigned a1[4] = {o1.x, o1.y, o1.z, o1.w}, a2[4] = {o2.x, o2.y, o2.z, o2.w}; float ss = 0.f;
#pragma unroll
        for (int q = 0; q < 4; ++q) { d[2 * q] = bflo(a1[q]) - lam * bflo(a2[q]); d[2 * q + 1] = bfhi(a1[q]) - lam * bfhi(a2[q]); ss += d[2 * q] * d[2 * q] + d[2 * q + 1] * d[2 * q + 1]; }
        ss += __shfl_xor(ss, 1); ss += __shfl_xor(ss, 2); ss += __shfl_xor(ss, 4); ss += __shfl_xor(ss, 8);
        const float rms = __builtin_amdgcn_rsqf(ss * (1.0f / 128.0f) + 1e-5f);
        v4u o; o.x = cvtpk(d[0] * rms * sg[0], d[1] * rms * sg[1]); o.y = cvtpk(d[2] * rms * sg[2], d[3] * rms * sg[3]); o.z = cvtpk(d[4] * rms * sg[4], d[5] * rms * sg[5]); o.w = cvtpk(d[6] * rms * sg[6], d[7] * rms * sg[7]);
        *(GAS v4u*)(mix + (size_t)t * D_ + hh * 128 + dd) = o;
        const bf16* r0 = PE + (size_t)t * EIN;
        const v4u bb = *(const GAS v4u*)(r0 + 1536 + ch), c0 = *(const GAS v4u*)(r0 + 2048 + ch), x0 = *(const GAS v4u*)(r0 + 2560 + ch);
        v4u c1 = {0u, 0u, 0u, 0u}, x1 = c1, c2 = c1, x2 = c1;
        if (t >= 1) { c1 = *(const GAS v4u*)(r0 - EIN + 2048 + ch); x1 = *(const GAS v4u*)(r0 - EIN + 2560 + ch); }
        if (t >= 2) { c2 = *(const GAS v4u*)(r0 - 2 * EIN + 2048 + ch); x2 = *(const GAS v4u*)(r0 - 2 * EIN + 2560 + ch); }
        const unsigned B[4] = {bb.x, bb.y, bb.z, bb.w}, C0[4] = {c0.x, c0.y, c0.z, c0.w}, X0[4] = {x0.x, x0.y, x0.z, x0.w}, C1[4] = {c1.x, c1.y, c1.z, c1.w}, X1[4] = {x1.x, x1.y, x1.z, x1.w},
                       C2[4] = {c2.x, c2.y, c2.z, c2.w}, X2[4] = {x2.x, x2.y, x2.z, x2.w};
        float sc[8];
#pragma unroll
        for (int q = 0; q < 4; ++q) {
            sc[2 * q] = bflo(B[q]) * (w2[2 * q] * (bflo(C0[q]) * bflo(X0[q])) + w1[2 * q] * (bflo(C1[q]) * bflo(X1[q])) + w0[2 * q] * (bflo(C2[q]) * bflo(X2[q])));
            sc[2 * q + 1] = bfhi(B[q]) * (w2[2 * q + 1] * (bfhi(C0[q]) * bfhi(X0[q])) + w1[2 * q + 1] * (bfhi(C1[q]) * bfhi(X1[q])) + w0[2 * q + 1] * (bfhi(C2[q]) * bfhi(X2[q]))); }
        v4u so; so.x = cvtpk(sc[0], sc[1]); so.y = cvtpk(sc[2], sc[3]); so.z = cvtpk(sc[4], sc[5]); so.w = cvtpk(sc[6], sc[7]);
        *(GAS v4u*)(mix + (size_t)t * D_ + 512 + ch) = so;
    }
}


__device__ __forceinline__ void p_rot(const Frame& F, const Args& a) {
    GAS unsigned char* ws = (GAS unsigned char*)a.ws; asm volatile("" : "+s"(ws)); int lane_ = F.lane; asm volatile("" : "+v"(lane_)); const int lane = lane_;
    bf16* PE = (bf16*)(ws + WS_ARENA + AR_PE); const float* tab = (const float*)(ws + WS_TAB);
    const int hd = lane >> 2, i0 = 2 * (lane & 3), col = (hd < 8 ? hd * 64 : 512 + (hd - 8) * 64) + i0;
#pragma unroll 1
    for (int t = F.gw; t < S_; t += F.NGW) {
        GAS unsigned* p1 = (GAS unsigned*)(PE + (size_t)t * EIN + col); GAS unsigned* p2 = (GAS unsigned*)(PE + (size_t)t * EIN + col + 8);
        const unsigned w1 = *p1, w2 = *p2;
        const float c0 = tab[(size_t)t * 16 + i0], c1 = tab[(size_t)t * 16 + i0 + 1], s0 = tab[(size_t)t * 16 + 8 + i0], s1 = tab[(size_t)t * 16 + 8 + i0 + 1];
        const float a0 = bflo(w1), a1 = bfhi(w1), b0 = bflo(w2), b1 = bfhi(w2);
        *p1 = cvtpk(a0 * c0 - b0 * s0, a1 * c1 - b1 * s1); *p2 = cvtpk(b0 * c0 + a0 * s0, b1 * c1 + a1 * s1);
    }
}
__device__ __forceinline__ void p_ab(const Frame& F, const Args& a, int L) {
    GAS unsigned char* ws = (GAS unsigned char*)a.ws; asm volatile("" : "+s"(ws)); int lane_ = F.lane; asm volatile("" : "+v"(lane_)); const int j = L >> 1, lane = lane_;
    LAS float* wl = (LAS float*)F.lds;
    const float* W = (const float*)a.in[15] + (size_t)j * D_ * OIN_SRC; const float* ln = (const float*)a.in[3] + L * D_;
    for (int idx = F.tid; idx < D_ * 16; idx += NWAVES * 64) { const int k = idx >> 4, c = idx & 15; wl[k * 20 + c] = ln[k] * W[(size_t)k * OIN_SRC + 4096 + c]; }
    __syncthreads();
    const float* ssq = (const float*)(ws + WS_SSQB); float* gg = (float*)(ws + WS_GB); float* gbeta = gg + S_ * 8;
    const float alog = ((const float*)a.in[17])[j * 8 + (lane & 7)], dtb = ((const float*)a.in[18])[j * 8 + (lane & 7)];
    const GAS float* hG = (const GAS float*)a.out;
#pragma unroll 1
    for (int t0 = F.gw; t0 < S_; t0 += 2 * F.NGW) {
        const int tb = t0 + F.NGW; const bool hasb = tb < S_; const int tbc = hasb ? tb : t0;
        float xa[16], xb[16];
#pragma unroll
        for (int i = 0; i < 16; ++i) { xa[i] = hG[(size_t)t0 * D_ + 64 * i + lane]; xb[i] = hG[(size_t)tbc * D_ + 64 * i + lane]; }
        const float rsa = pg8::rstd_row(ssq, t0), rsb = pg8::rstd_row(ssq, tbc);
        float acca[16], accb[16];
#pragma unroll
        for (int c = 0; c < 16; ++c) { acca[c] = 0.f; accb[c] = 0.f; }
#pragma unroll 4
        for (int i = 0; i < 16; ++i) { const LAS f32x4* wr = (const LAS f32x4*)(wl + (64 * i + lane) * 20);
#pragma unroll
            for (int q = 0; q < 4; ++q) { const f32x4 w = wr[q];
                acca[4 * q] += xa[i] * w[0]; acca[4 * q + 1] += xa[i] * w[1]; acca[4 * q + 2] += xa[i] * w[2]; acca[4 * q + 3] += xa[i] * w[3];
                accb[4 * q] += xb[i] * w[0]; accb[4 * q + 1] += xb[i] * w[1]; accb[4 * q + 2] += xb[i] * w[2]; accb[4 * q + 3] += xb[i] * w[3]; } }
        float minea = 0.f, mineb = 0.f;
#pragma unroll
        for (int c = 0; c < 16; ++c) { const float sa = wave_sum(acca[c]), sb = wave_sum(accb[c]); minea = ((lane & 15) == c) ? sa : minea; mineb = ((lane & 15) == c) ? sb : mineb; }
#pragma unroll
        for (int half = 0; half < 2; ++half) { if (half == 1 && !hasb) break;
            const int t = half ? tb : t0; const float mine = (half ? mineb * rsb : minea * rsa);
            if (lane < 8) gbeta[(size_t)t * 8 + lane] = sigm(mine);
            else if (lane < 16) { const float z = mine + dtb; const float sp = z > 20.f ? z : log1pf(expf(z)); gg[(size_t)t * 8 + lane - 8] = -expf(alog) * sp; } }
    }
    __syncthreads();
}
__device__ __forceinline__ void tri_solve(const LAS float* Lc, LAS bf16* Xs, int lane) {
    float x0, x1, x2, x3, x4, x5, x6, x7, x8, x9, x10, x11, x12, x13, x14, x15, x16, x17, x18, x19, x20, x21, x22, x23, x24, x25, x26, x27, x28, x29, x30, x31, x32, x33, x34, x35, x36, x37, x38, x39, x40, x41, x42, x43, x44, x45, x46, x47, x48, x49, x50, x51, x52, x53, x54, x55, x56, x57, x58, x59, x60, x61, x62, x63;
    { x63 = (lane == 63) ? 1.0f : 0.0f; asm volatile("" : "+v"(x63) : : "memory"); }
    { float s0 = 0.f, s1 = 0.f, s2 = 0.f, s3 = 0.f; { const f32x4 l = *(const LAS f32x4*)(Lc + 4276); s3 = fmaf(x63, l[3], s3); } x62 = (lane == 62) ? 1.0f : -((s0 + s1) + (s2 + s3)); asm volatile("" : "+v"(x62) : : "memory"); }
    { float s0 = 0.f, s1 = 0.f, s2 = 0.f, s3 = 0.f; { const f32x4 l = *(const LAS f32x4*)(Lc + 4208); s2 = fmaf(x62, l[2], s2); s3 = fmaf(x63, l[3], s3); } x61 = (lane == 61) ? 1.0f : -((s0 + s1) + (s2 + s3)); asm volatile("" : "+v"(x61) : : "memory"); }
    { float s0 = 0.f, s1 = 0.f, s2 = 0.f, s3 = 0.f; { const f32x4 l = *(const LAS f32x4*)(Lc + 4140); s1 = fmaf(x61, l[1], s1); s2 = fmaf(x62, l[2], s2); s3 = fmaf(x63, l[3], s3); } x60 = (lane == 60) ? 1.0f : -((s0 + s1) + (s2 + s3)); asm volatile("" : "+v"(x60) : : "memory"); }
    { float s0 = 0.f, s1 = 0.f, s2 = 0.f, s3 = 0.f; { const f32x4 l = *(const LAS f32x4*)(Lc + 4072); s0 = fmaf(x60, l[0], s0); s1 = fmaf(x61, l[1], s1); s2 = fmaf(x62, l[2], s2); s3 = fmaf(x63, l[3], s3); } x59 = (lane == 59) ? 1.0f : -((s0 + s1) + (s2 + s3)); asm volatile("" : "+v"(x59) : : "memory"); }
    { float s0 = 0.f, s1 = 0.f, s2 = 0.f, s3 = 0.f; { const f32x4 l = *(const LAS f32x4*)(Lc + 4000); s3 = fmaf(x59, l[3], s3); } { const f32x4 l = *(const LAS f32x4*)(Lc + 4004); s0 = fmaf(x60, l[0], s0); s1 = fmaf(x61, l[1], s1); s2 = fmaf(x62, l[2], s2); s3 = fmaf(x63, l[3], s3); } x58 = (lane == 58) ? 1.0f : -((s0 + s1) + (s2 + s3)); asm volatile("" : "+v"(x58) : : "memory"); }
    { float s0 = 0.f, s1 = 0.f, s2 = 0.f, s3 = 0.f; { const f32x4 l = *(const LAS f32x4*)(Lc + 3932); s2 = fmaf(x58, l[2], s2); s3 = fmaf(x59, l[3], s3); } { const f32x4 l = *(const LAS f32x4*)(Lc + 3936); s0 = fmaf(x60, l[0], s0); s1 = fmaf(x61, l[1], s1); s2 = fmaf(x62, l[2], s2); s3 = fmaf(x63, l[3], s3); } x57 = (lane == 57) ? 1.0f : -((s0 + s1) + (s2 + s3)); asm volatile("" : "+v"(x57) : : "memory"); }
    { float s0 = 0.f, s1 = 0.f, s2 = 0.f, s3 = 0.f; { const f32x4 l = *(const LAS f32x4*)(Lc + 3864); s1 = fmaf(x57, l[1], s1); s2 = fmaf(x58, l[2], s2); s3 = fmaf(x59, l[3], s3); } { const f32x4 l = *(const LAS f32x4*)(Lc + 3868); s0 = fmaf(x60, l[0], s0); s1 = fmaf(x61, l[1], s1); s2 = fmaf(x62, l[2], s2); s3 = fmaf(x63, l[3], s3); } x56 = (lane == 56) ? 1.0f : -((s0 + s1) + (s2 + s3)); asm volatile("" : "+v"(x56) : : "memory"); }
    { float s0 = 0.f, s1 = 0.f, s2 = 0.f, s3 = 0.f; { const f32x4 l = *(const LAS f32x4*)(Lc + 3796); s0 = fmaf(x56, l[0], s0); s1 = fmaf(x57, l[1], s1); s2 = fmaf(x58, l[2], s2); s3 = fmaf(x59, l[3], s3); } { const f32x4 l = *(const LAS f32x4*)(Lc + 3800); s0 = fmaf(x60, l[0], s0); s1 = fmaf(x61, l[1], s1); s2 = fmaf(x62, l[2], s2); s3 = fmaf(x63, l[3], s3); } x55 = (lane == 55) ? 1.0f : -((s0 + s1) + (s2 + s3)); asm volatile("" : "+v"(x55) : : "memory"); }
    { float s0 = 0.f, s1 = 0.f, s2 = 0.f, s3 = 0.f; { const f32x4 l = *(const LAS f32x4*)(Lc + 3724); s3 = fmaf(x55, l[3], s3); } { const f32x4 l = *(const LAS f32x4*)(Lc + 3728); s0 = fmaf(x56, l[0], s0); s1 = fmaf(x57, l[1], s1); s2 = fmaf(x58, l[2], s2); s3 = fmaf(x59, l[3], s3); } { const f32x4 l = *(const LAS f32x4*)(Lc + 3732); s0 = fmaf(x60, l[0], s0); s1 = fmaf(x61, l[1], s1); s2 = fmaf(x62, l[2], s2); s3 = fmaf(x63, l[3], s3); } x54 = (lane == 54) ? 1.0f : -((s0 + s1) + (s2 + s3)); asm volatile("" : "+v"(x54) : : "memory"); }
    { float s0 = 0.f, s1 = 0.f, s2 = 0.f, s3 = 0.f; { const f32x4 l = *(const LAS f32x4*)(Lc + 3656); s2 = fmaf(x54, l[2], s2); s3 = fmaf(x55, l[3], s3); } { const f32x4 l = *(const LAS f32x4*)(Lc + 3660); s0 = fmaf(x56, l[0], s0); s1 = fmaf(x57, l[1], s1); s2 = fmaf(x58, l[2], s2); s3 = fmaf(x59, l[3], s3); } { const f32x4 l = *(const LAS f32x4*)(Lc + 3664); s0 = fmaf(x60, l[0], s0); s1 = fmaf(x61, l[1], s1); s2 = fmaf(x62, l[2], s2); s3 = fmaf(x63, l[3], s3); } x53 = (lane == 53) ? 1.0f : -((s0 + s1) + (s2 + s3)); asm volatile("" : "+v"(x53) : : "memory"); }
    { float s0 = 0.f, s1 = 0.f, s2 = 0.f, s3 = 0.f; { const f32x4 l = *(const LAS f32x4*)(Lc + 3588); s1 = fmaf(x53, l[1], s1); s2 = fmaf(x54, l[2], s2); s3 = fmaf(x55, l[3], s3); } { const f32x4 l = *(const LAS f32x4*)(Lc + 3592); s0 = fmaf(x56, l[0], s0); s1 = fmaf(x57, l[1], s1); s2 = fmaf(x58, l[2], s2); s3 = fmaf(x59, l[3], s3); } { const f32x4 l = *(const LAS f32x4*)(Lc + 3596); s0 = fmaf(x60, l[0], s0); s1 = fmaf(x61, l[1], s1); s2 = fmaf(x62, l[2], s2); s3 = fmaf(x63, l[3], s3); } x52 = (lane == 52) ? 1.0f : -((s0 + s1) + (s2 + s3)); asm volatile("" : "+v"(x52) : : "memory"); }
    { float s0 = 0.f, s1 = 0.f, s2 = 0.f, s3 = 0.f; { const f32x4 l = *(const LAS f32x4*)(Lc + 3520); s0 = fmaf(x52, l[0], s0); s1 = fmaf(x53, l[1], s1); s2 = fmaf(x54, l[2], s2); s3 = fmaf(x55, l[3], s3); } { const f32x4 l = *(const LAS f32x4*)(Lc + 3524); s0 = fmaf(x56, l[0], s0); s1 = fmaf(x57, l[1], s1); s2 = fmaf(x58, l[2], s2); s3 = fmaf(x59, l[3], s3); } { const f32x4 l = *(const LAS f32x4*)(Lc + 3528); s0 = fmaf(x60, l[0], s0); s1 = fmaf(x61, l[1], s1); s2 = fmaf(x62, l[2], s2); s3 = fmaf(x63, l[3], s3); } x51 = (lane == 51) ? 1.0f : -((s0 + s1) + (s2 + s3)); asm volatile("" : "+v"(x51) : : "memory"); }
    { float s0 = 0.f, s1 = 0.f, s2 = 0.f, s3 = 0.f; { const f32x4 l = *(const LAS f32x4*)(Lc + 3448); s3 = fmaf(x51, l[3], s3); } { const f32x4 l = *(const LAS f32x4*)(Lc + 3452); s0 = fmaf(x52, l[0], s0); s1 = fmaf(x53, l[1], s1); s2 = fmaf(x54, l[2], s2); s3 = fmaf(x55, l[3], s3); } { const f32x4 l = *(const LAS f32x4*)(Lc + 3456); s0 = fmaf(x56, l[0], s0); s1 = fmaf(x57, l[1], s1); s2 = fmaf(x58, l[2], s2); s3 = fmaf(x59, l[3], s3); } { const f32x4 l = *(const LAS f32x4*)(Lc + 3460); s0 = fmaf(x60, l[0], s0); s1 = fmaf(x61, l[1], s1); s2 = fmaf(x62, l[2], s2); s3 = fmaf(x63, l[3], s3); } x50 = (lane == 50) ? 1.0f : -((s0 + s1) + (s2 + s3)); asm volatile("" : "+v"(x50) : : "memory"); }
    { float s0 = 0.f, s1 = 0.f, s2 = 0.f, s3 = 0.f; { const f32x4 l = *(const LAS f32x4*)(Lc + 3380); s2 = fmaf(x50, l[2], s2); s3 = fmaf(x51, l[3], s3); } { const f32x4 l = *(const LAS f32x4*)(Lc + 3384); s0 = fmaf(x52, l[0], s0); s1 = fmaf(x53, l[1], s1); s2 = fmaf(x54, l[2], s2); s3 = fmaf(x55, l[3], s3); } { const f32x4 l = *(const LAS f32x4*)(Lc + 3388); s0 = fmaf(x56, l[0], s0); s1 = fmaf(x57, l[1], s1); s2 = fmaf(x58, l[2], s2); s3 = fmaf(x59, l[3], s3); } { const f32x4 l = *(const LAS f32x4*)(Lc + 3392); s0 = fmaf(x60, l[0], s0); s1 = fmaf(x61, l[1], s1); s2 = fmaf(x62, l[2], s2); s3 = fmaf(x63, l[3], s3); } x49 = (lane == 49) ? 1.0f : -((s0 + s1) + (s2 + s3)); asm volatile("" : "+v"(x49) : : "memory"); }
    { float s0 = 0.f, s1 = 0.f, s2 = 0.f, s3 = 0.f; { const f32x4 l = *(const LAS f32x4*)(Lc + 3312); s1 = fmaf(x49, l[1], s1); s2 = fmaf(x50, l[2], s2); s3 = fmaf(x51, l[3], s3); } { const f32x4 l = *(const LAS f32x4*)(Lc + 3316); s0 = fmaf(x52, l[0], s0); s1 = fmaf(x53, l[1], s1); s2 = fmaf(x54, l[2], s2); s3 = fmaf(x55, l[3], s3); } { const f32x4 l = *(const LAS f32x4*)(Lc + 3320); s0 = fmaf(x56, l[0], s0); s1 = fmaf(x57, l[1], s1); s2 = fmaf(x58, l[2], s2); s3 = fmaf(x59, l[3], s3); } { const f32x4 l = *(const LAS f32x4*)(Lc + 3324); s0 = fmaf(x60, l[0], s0); s1 = fmaf(x61, l[1], s1); s2 = fmaf(x62, l[2], s2); s3 = fmaf(x63, l[3], s3); } x48 = (lane == 48) ? 1.0f : -((s0 + s1) + (s2 + s3)); asm volatile("" : "+v"(x48) : : "memory"); }
    { float s0 = 0.f, s1 = 0.f, s2 = 0.f, s3 = 0.f; { const f32x4 l = *(const LAS f32x4*)(Lc + 3244); s0 = fmaf(x48, l[0], s0); s1 = fmaf(x49, l[1], s1); s2 = fmaf(x50, l[2], s2); s3 = fmaf(x51, l[3], s3); } { const f32x4 l = *(const LAS f32x4*)(Lc + 3248); s0 = fmaf(x52, l[0], s0); s1 = fmaf(x53, l[1], s1); s2 = fmaf(x54, l[2], s2); s3 = fmaf(x55, l[3], s3); } { const f32x4 l = *(const LAS f32x4*)(Lc + 3252); s0 = fmaf(x56, l[0], s0); s1 = fmaf(x57, l[1], s1); s2 = fmaf(x58, l[2], s2); s3 = fmaf(x59, l[3], s3); } { const f32x4 l = *(const LAS f32x4*)(Lc + 3256); s0 = fmaf(x60, l[0], s0); s1 = fmaf(x61, l[1], s1); s2 = fmaf(x62, l[2], s2); s3 = fmaf(x63, l[3], s3); } x47 = (lane == 47) ? 1.0f : -((s0 + s1) + (s2 + s3)); asm volatile("" : "+v"(x47) : : "memory"); }
    { float s0 = 0.f, s1 = 0.f, s2 = 0.f, s3 = 0.f; { const f32x4 l = *(const LAS f32x4*)(Lc + 3172); s3 = fmaf(x47, l[3], s3); } { const f32x4 l = *(const LAS f32x4*)(Lc + 3176); s0 = fmaf(x48, l[0], s0); s1 = fmaf(x49, l[1], s1); s2 = fmaf(x50, l[2], s2); s3 = fmaf(x51, l[3], s3); } { const f32x4 l = *(const LAS f32x4*)(Lc + 3180); s0 = fmaf(x52, l[0], s0); s1 = fmaf(x53, l[1], s1); s2 = fmaf(x54, l[2], s2); s3 = fmaf(x55, l[3], s3); } { const f32x4 l = *(const LAS f32x4*)(Lc + 3184); s0 = fmaf(x56, l[0], s0); s1 = fmaf(x57, l[1], s1); s2 = fmaf(x58, l[2], s2); s3 = fmaf(x59, l[3], s3); } { const f32x4 l = *(const LAS f32x4*)(Lc + 3188); s0 = fmaf(x60, l[0], s0); s1 = fmaf(x61, l[1], s1); s2 = fmaf(x62, l[2], s2); s3 = fmaf(x63, l[3], s3); } x46 = (lane == 46) ? 1.0f : -((s0 + s1) + (s2 + s3)); asm volatile("" : "+v"(x46) : : "memory"); }
    { float s0 = 0.f, s1 = 0.f, s2 = 0.f, s3 = 0.f; { const f32x4 l = *(const LAS f32x4*)(Lc + 3104); s2 = fmaf(x46, l[2], s2); s3 = fmaf(x47, l[3], s3); } { const f32x4 l = *(const LAS f32x4*)(Lc + 3108); s0 = fmaf(x48, l[0], s0); s1 = fmaf(x49, l[1], s1); s2 = fmaf(x50, l[2], s2); s3 = fmaf(x51, l[3], s3); } { const f32x4 l = *(const LAS f32x4*)(Lc + 3112); s0 = fmaf(x52, l[0], s0); s1 = fmaf(x53, l[1], s1); s2 = fmaf(x54, l[2], s2); s3 = fmaf(x55, l[3], s3); } { const f32x4 l = *(const LAS f32x4*)(Lc + 3116); s0 = fmaf(x56, l[0], s0); s1 = fmaf(x57, l[1], s1); s2 = fmaf(x58, l[2], s2); s3 = fmaf(x59, l[3], s3); } { const f32x4 l = *(const LAS f32x4*)(Lc + 3120); s0 = fmaf(x60, l[0], s0); s1 = fmaf(x61, l[1], s1); s2 = fmaf(x62, l[2], s2); s3 = fmaf(x63, l[3], s3); } x45 = (lane == 45) ? 1.0f : -((s0 + s1) + (s2 + s3)); asm volatile("" : "+v"(x45) : : "memory"); }
    { float s0 = 0.f, s1 = 0.f, s2 = 0.f, s3 = 0.f; { const f32x4 l = *(const LAS f32x4*)(Lc + 3036); s1 = fmaf(x45, l[1], s1); s2 = fmaf(x46, l[2], s2); s3 = fmaf(x47, l[3], s3); } { const f32x4 l = *(const LAS f32x4*)(Lc + 3040); s0 = fmaf(x48, l[0], s0); s1 = fmaf(x49, l[1], s1); s2 = fmaf(x50, l[2], s2); s3 = fmaf(x51, l[3], s3); } { const f32x4 l = *(const LAS f32x4*)(Lc + 3044); s0 = fmaf(x52, l[0], s0); s1 = fmaf(x53, l[1], s1); s2 = fmaf(x54, l[2], s2); s3 = fmaf(x55, l[3], s3); } { const f32x4 l = *(const LAS f32x4*)(Lc + 3048); s0 = fmaf(x56, l[0], s0); s1 = fmaf(x57, l[1], s1); s2 = fmaf(x58, l[2], s2); s3 = fmaf(x59, l[3], s3); } { const f32x4 l = *(const LAS f32x4*)(Lc + 3052); s0 = fmaf(x60, l[0], s0); s1 = fmaf(x61, l[1], s1); s2 = fmaf(x62, l[2], s2); s3 = fmaf(x63, l[3], s3); } x44 = (lane == 44) ? 1.0f : -((s0 + s1) + (s2 + s3)); asm volatile("" : "+v"(x44) : : "memory"); }
    { float s0 = 0.f, s1 = 0.f, s2 = 0.f, s3 = 0.f; { const f32x4 l = *(const LAS f32x4*)(Lc + 2968); s0 = fmaf(x44, l[0], s0); s1 = fmaf(x45, l[1], s1); s2 = fmaf(x46, l[2], s2); s3 = fmaf(x47, l[3], s3); } { const f32x4 l = *(const LAS f32x4*)(Lc + 2972); s0 = fmaf(x48, l[0], s0); s1 = fmaf(x49, l[1], s1); s2 = fmaf(x50, l[2], s2); s3 = fmaf(x51, l[3], s3); } { const f32x4 l = *(const LAS f32x4*)(Lc + 2976); s0 = fmaf(x52, l[0], s0); s1 = fmaf(x53, l[1], s1); s2 = fmaf(x54, l[2], s2); s3 = fmaf(x55, l[3], s3); } { const f32x4 l = *(const LAS f32x4*)(Lc + 2980); s0 = fmaf(x56, l[0], s0); s1 = fmaf(x57, l[1], s1); s2 = fmaf(x58, l[2], s2); s3 = fmaf(x59, l[3], s3); } { const f32x4 l = *(const LAS f32x4*)(Lc + 2984); s0 = fmaf(x60, l[0], s0); s1 = fmaf(x61, l[1], s1); s2 = fmaf(x62, l[2], s2); s3 = fmaf(x63, l[3], s3); } x43 = (lane == 43) ? 1.0f : -((s0 + s1) + (s2 + s3)); asm volatile("" : "+v"(x43) : : "memory"); }
    { float s0 = 0.f, s1 = 0.f, s2 = 0.f, s3 = 0.f; { const f32x4 l = *(const LAS f32x4*)(Lc + 2896); s3 = fmaf(x43, l[3], s3); } { const f32x4 l = *(const LAS f32x4*)(Lc + 2900); s0 = fmaf(x44, l[0], s0); s1 = fmaf(x45, l[1], s1); s2 = fmaf(x46, l[2], s2); s3 = fmaf(x47, l[3], s3); } { const f32x4 l = *(const LAS f32x4*)(Lc + 2904); s0 = fmaf(x48, l[0], s0); s1 = fmaf(x49, l[1], s1); s2 = fmaf(x50, l[2], s2); s3 = fmaf(x51, l[3], s3); } { const f32x4 l = *(const LAS f32x4*)(Lc + 2908); s0 = fmaf(x52, l[0], s0); s1 = fmaf(x53, l[1], s1); s2 = fmaf(x54, l[2], s2); s3 = fmaf(x55, l[3], s3); } { const f32x4 l = *(const LAS f32x4*)(Lc + 2912); s0 = fmaf(x56, l[0], s0); s1 = fmaf(x57, l[1], s1); s2 = fmaf(x58, l[2], s2); s3 = fmaf(x59, l[3], s3); } { const f32x4 l = *(const LAS f32x4*)(Lc + 2916); s0 = fmaf(x60, l[0], s0); s1 = fmaf(x61, l[1], s1); s2 = fmaf(x62, l[2], s2); s3 = fmaf(x63, l[3], s3); } x42 = (lane == 42) ? 1.0f : -((s0 + s1) + (s2 + s3)); asm volatile("" : "+v"(x42) : : "memory"); }
    { float s0 = 0.f, s1 = 0.f, s2 = 0.f, s3 = 0.f; { const f32x4 l = *(const LAS f32x4*)(Lc + 2828); s2 = fmaf(x42, l[2], s2); s3 = fmaf(x43, l[3], s3); } { const f32x4 l = *(const LAS f32x4*)(Lc + 2832); s0 = fmaf(x44, l[0], s0); s1 = fmaf(x45, l[1], s1); s2 = fmaf(x46, l[2], s2); s3 = fmaf(x47, l[3], s3); } { const f32x4 l = *(const LAS f32x4*)(Lc + 2836); s0 = fmaf(x48, l[0], s0); s1 = fmaf(x49, l[1], s1); s2 = fmaf(x50, l[2], s2); s3 = fmaf(x51, l[3], s3); } { const f32x4 l = *(const LAS f32x4*)(Lc + 2840); s0 = fmaf(x52, l[0], s0); s1 = fmaf(x53, l[1], s1); s2 = fmaf(x54, l[2], s2); s3 = fmaf(x55, l[3], s3); } { const f32x4 l = *(const LAS f32x4*)(Lc + 2844); s0 = fmaf(x56, l[0], s0); s1 = fmaf(x57, l[1], s1); s2 = fmaf(x58, l[2], s2); s3 = fmaf(x59, l[3], s3); } { const f32x4 l = *(const LAS f32x4*)(Lc + 2848); s0 = fmaf(x60, l[0], s0); s1 = fmaf(x61, l[1], s1); s2 = fmaf(x62, l[2], s2); s3 = fmaf(x63, l[3], s3); } x41 = (lane == 41) ? 1.0f : -((s0 + s1) + (s2 + s3)); asm volatile("" : "+v"(x41) : : "memory"); }
    { float s0 = 0.f, s1 = 0.f, s2 = 0.f, s3 = 0.f; { const f32x4 l = *(const LAS f32x4*)(Lc + 2760); s1 = fmaf(x41, l[1], s1); s2 = fmaf(x42, l[2], s2); s3 = fmaf(x43, l[3], s3); } { const f32x4 l = *(const LAS f32x4*)(Lc + 2764); s0 = fmaf(x44, l[0], s0); s1 = fmaf(x45, l[1], s1); s2 = fmaf(x46, l[2], s2); s3 = fmaf(x47, l[3], s3); } { const f32x4 l = *(const LAS f32x4*)(Lc + 2768); s0 = fmaf(x48, l[0], s0); s1 = fmaf(x49, l[1], s1); s2 = fmaf(x50, l[2], s2); s3 = fmaf(x51, l[3], s3); } { const f32x4 l = *(const LAS f32x4*)(Lc + 2772); s0 = fmaf(x52, l[0], s0); s1 = fmaf(x53, l[1], s1); s2 = fmaf(x54, l[2], s2); s3 = fmaf(x55, l[3], s3); } { const f32x4 l = *(const LAS f32x4*)(Lc + 2776); s0 = fmaf(x56, l[0], s0); s1 = fmaf(x57, l[1], s1); s2 = fmaf(x58, l[2], s2); s3 = fmaf(x59, l[3], s3); } { const f32x4 l = *(const LAS f32x4*)(Lc + 2780); s0 = fmaf(x60, l[0], s0); s1 = fmaf(x61, l[1], s1); s2 = fmaf(x62, l[2], s2); s3 = fmaf(x63, l[3], s3); } x40 = (lane == 40) ? 1.0f : -((s0 + s1) + (s2 + s3)); asm volatile("" : "+v"(x40) : : "memory"); }
    { float s0 = 0.f, s1 = 0.f, s2 = 0.f, s3 = 0.f; { const f32x4 l = *(const LAS f32x4*)(Lc + 2692); s0 = fmaf(x40, l[0], s0); s1 = fmaf(x41, l[1], s1); s2 = fmaf(x42, l[2], s2); s3 = fmaf(x43, l[3], s3); } { const f32x4 l = *(const LAS f32x4*)(Lc + 2696); s0 = fmaf(x44, l[0], s0); s1 = fmaf(x45, l[1], s1); s2 = fmaf(x46, l[2], s2); s3 = fmaf(x47, l[3], s3); } { const f32x4 l = *(const LAS f32x4*)(Lc + 2700); s0 = fmaf(x48, l[0], s0); s1 = fmaf(x49, l[1], s1); s2 = fmaf(x50, l[2], s2); s3 = fmaf(x51, l[3], s3); } { const f32x4 l = *(const LAS f32x4*)(Lc + 2704); s0 = fmaf(x52, l[0], s0); s1 = fmaf(x53, l[1], s1); s2 = fmaf(x54, l[2], s2); s3 = fmaf(x55, l[3], s3); } { const f32x4 l = *(const LAS f32x4*)(Lc + 2708); s0 = fmaf(x56, l[0], s0); s1 = fmaf(x57, l[1], s1); s2 = fmaf(x58, l[2], s2); s3 = fmaf(x59, l[3], s3); } { const f32x4 l = *(const LAS f32x4*)(Lc + 2712); s0 = fmaf(x60, l[0], s0); s1 = fmaf(x61, l[1], s1); s2 = fmaf(x62, l[2], s2); s3 = fmaf(x63, l[3], s3); } x39 = (lane == 39) ? 1.0f : -((s0 + s1) + (s2 + s3)); asm volatile("" : "+v"(x39) : : "memory"); }
    { float s0 = 0.f, s1 = 0.f, s2 = 0.f, s3 = 0.f; { const f32x4 l = *(const LAS f32x4*)(Lc + 2620); s3 = fmaf(x39, l[3], s3); } { const f32x4 l = *(const LAS f32x4*)(Lc + 2624); s0 = fmaf(x40, l[0], s0); s1 = fmaf(x41, l[1], s1); s2 = fmaf(x42, l[2], s2); s3 = fmaf(x43, l[3], s3); } { const f32x4 l = *(const LAS f32x4*)(Lc + 2628); s0 = fmaf(x44, l[0], s0); s1 = fmaf(x45, l[1], s1); s2 = fmaf(x46, l[2], s2); s3 = fmaf(x47, l[3], s3); } { const f32x4 l = *(const LAS f32x4*)(Lc + 2632); s0 = fmaf(x48, l[0], s0); s1 = fmaf(x49, l[1], s1); s2 = fmaf(x50, l[2], s2); s3 = fmaf(x51, l[3], s3); } { const f32x4 l = *(const LAS f32x4*)(Lc + 2636); s0 = fmaf(x52, l[0], s0); s1 = fmaf(x53, l[1], s1); s2 = fmaf(x54, l[2], s2); s3 = fmaf(x55, l[3], s3); } { const f32x4 l = *(const LAS f32x4*)(Lc + 2640); s0 = fmaf(x56, l[0], s0); s1 = fmaf(x57, l[1], s1); s2 = fmaf(x58, l[2], s2); s3 = fmaf(x59, l[3], s3); } { const f32x4 l = *(const LAS f32x4*)(Lc + 2644); s0 = fmaf(x60, l[0], s0); s1 = fmaf(x61, l[1], s1); s2 = fmaf(x62, l[2], s2); s3 = fmaf(x63, l[3], s3); } x38 = (lane == 38) ? 1.0f : -((s0 + s1) + (s2 + s3)); asm volatile("" : "+v"(x38) : : "memory"); }
    { float s0 = 0.f, s1 = 0.f, s2 = 0.f, s3 = 0.f; { const f32x4 l = *(const LAS f32x4*)(Lc + 2552); s2 = fmaf(x38, l[2], s2); s3 = fmaf(x39, l[3], s3); } { const f32x4 l = *(const LAS f32x4*)(Lc + 2556); s0 = fmaf(x40, l[0], s0); s1 = fmaf(x41, l[1], s1); s2 = fmaf(x42, l[2], s2); s3 = fmaf(x43, l[3], s3); } { const f32x4 l = *(const LAS f32x4*)(Lc + 2560); s0 = fmaf(x44, l[0], s0); s1 = fmaf(x45, l[1], s1); s2 = fmaf(x46, l[2], s2); s3 = fmaf(x47, l[3], s3); } { const f32x4 l = *(const LAS f32x4*)(Lc + 2564); s0 = fmaf(x48, l[0], s0); s1 = fmaf(x49, l[1], s1); s2 = fmaf(x50, l[2], s2); s3 = fmaf(x51, l[3], s3); } { const f32x4 l = *(const LAS f32x4*)(Lc + 2568); s0 = fmaf(x52, l[0], s0); s1 = fmaf(x53, l[1], s1); s2 = fmaf(x54, l[2], s2); s3 = fmaf(x55, l[3], s3); } { const f32x4 l = *(const LAS f32x4*)(Lc + 2572); s0 = fmaf(x56, l[0], s0); s1 = fmaf(x57, l[1], s1); s2 = fmaf(x58, l[2], s2); s3 = fmaf(x59, l[3], s3); } { const f32x4 l = *(const LAS f32x4*)(Lc + 2576); s0 = fmaf(x60, l[0], s0); s1 = fmaf(x61, l[1], s1); s2 = fmaf(x62, l[2], s2); s3 = fmaf(x63, l[3], s3); } x37 = (lane == 37) ? 1.0f : -((s0 + s1) + (s2 + s3)); asm volatile("" : "+v"(x37) : : "memory"); }
    { float s0 = 0.f, s1 = 0.f, s2 = 0.f, s3 = 0.f; { const f32x4 l = *(const LAS f32x4*)(Lc + 2484); s1 = fmaf(x37, l[1], s1); s2 = fmaf(x38, l[2], s2); s3 = fmaf(x39, l[3], s3); } { const f32x4 l = *(const LAS f32x4*)(Lc + 2488); s0 = fmaf(x40, l[0], s0); s1 = fmaf(x41, l[1], s1); s2 = fmaf(x42, l[2], s2); s3 = fmaf(x43, l[3], s3); } { const f32x4 l = *(const LAS f32x4*)(Lc + 2492); s0 = fmaf(x44, l[0], s0); s1 = fmaf(x45, l[1], s1); s2 = fmaf(x46, l[2], s2); s3 = fmaf(x47, l[3], s3); } { const f32x4 l = *(const LAS f32x4*)(Lc + 2496); s0 = fmaf(x48, l[0], s0); s1 = fmaf(x49, l[1], s1); s2 = fmaf(x50, l[2], s2); s3 = fmaf(x51, l[3], s3); } { const f32x4 l = *(const LAS f32x4*)(Lc + 2500); s0 = fmaf(x52, l[0], s0); s1 = fmaf(x53, l[1], s1); s2 = fmaf(x54, l[2], s2); s3 = fmaf(x55, l[3], s3); } { const f32x4 l = *(const LAS f32x4*)(Lc + 2504); s0 = fmaf(x56, l[0], s0); s1 = fmaf(x57, l[1], s1); s2 = fmaf(x58, l[2], s2); s3 = fmaf(x59, l[3], s3); } { const f32x4 l = *(const LAS f32x4*)(Lc + 2508); s0 = fmaf(x60, l[0], s0); s1 = fmaf(x61, l[1], s1); s2 = fmaf(x62, l[2], s2); s3 = fmaf(x63, l[3], s3); } x36 = (lane == 36) ? 1.0f : -((s0 + s1) + (s2 + s3)); asm volatile("" : "+v"(x36) : : "memory"); }
    { float s0 = 0.f, s1 = 0.f, s2 = 0.f, s3 = 0.f; { const f32x4 l = *(const LAS f32x4*)(Lc + 2416); s0 = fmaf(x36, l[0], s0); s1 = fmaf(x37, l[1], s1); s2 = fmaf(x38, l[2], s2); s3 = fmaf(x39, l[3], s3); } { const f32x4 l = *(const LAS f32x4*)(Lc + 2420); s0 = fmaf(x40, l[0], s0); s1 = fmaf(x41, l[1], s1); s2 = fmaf(x42, l[2], s2); s3 = fmaf(x43, l[3], s3); } { const f32x4 l = *(const LAS f32x4*)(Lc + 2424); s0 = fmaf(x44, l[0], s0); s1 = fmaf(x45, l[1], s1); s2 = fmaf(x46, l[2], s2); s3 = fmaf(x47, l[3], s3); } { const f32x4 l = *(const LAS f32x4*)(Lc + 2428); s0 = fmaf(x48, l[0], s0); s1 = fmaf(x49, l[1], s1); s2 = fmaf(x50, l[2], s2); s3 = fmaf(x51, l[3], s3); } { const f32x4 l = *(const LAS f32x4*)(Lc + 2432); s0 = fmaf(x52, l[0], s0); s1 = fmaf(x53, l[1], s1); s2 = fmaf(x54, l[2], s2); s3 = fmaf(x55, l[3], s3); } { const f32x4 l = *(const LAS f32x4*)(Lc + 2436); s0 = fmaf(x56, l[0], s0); s1 = fmaf(x57, l[1], s1); s2 = fmaf(x58, l[2], s2); s3 = fmaf(x59, l[3], s3); } { const f32x4 l = *(const LAS f32x4*)(Lc + 2440); s0 = fmaf(x60, l[0], s0); s1 = fmaf(x61, l[1], s1); s2 = fmaf(x62, l[2], s2); s3 = fmaf(x63, l[3], s3); } x35 = (lane == 35) ? 1.0f : -((s0 + s1) + (s2 + s3)); asm volatile("" : "+v"(x35) : : "memory"); }
    { float s0 = 0.f, s1 = 0.f, s2 = 0.f, s3 = 0.f; { const f32x4 l = *(const LAS f32x4*)(Lc + 2344); s3 = fmaf(x35, l[3], s3); } { const f32x4 l = *(const LAS f32x4*)(Lc + 2348); s0 = fmaf(x36, l[0], s0); s1 = fmaf(x37, l[1], s1); s2 = fmaf(x38, l[2], s2); s3 = fmaf(x39, l[3], s3); } { const f32x4 l = *(const LAS f32x4*)(Lc + 2352); s0 = fmaf(x40, l[0], s0); s1 = fmaf(x41, l[1], s1); s2 = fmaf(x42, l[2], s2); s3 = fmaf(x43, l[3], s3); } { const f32x4 l = *(const LAS f32x4*)(Lc + 2356); s0 = fmaf(x44, l[0], s0); s1 = fmaf(x45, l[1], s1); s2 = fmaf(x46, l[2], s2); s3 = fmaf(x47, l[3], s3); } { const f32x4 l = *(const LAS f32x4*)(Lc + 2360); s0 = fmaf(x48, l[0], s0); s1 = fmaf(x49, l[1], s1); s2 = fmaf(x50, l[2], s2); s3 = fmaf(x51, l[3], s3); } { const f32x4 l = *(const LAS f32x4*)(Lc + 2364); s0 = fmaf(x52, l[0], s0); s1 = fmaf(x53, l[1], s1); s2 = fmaf(x54, l[2], s2); s3 = fmaf(x55, l[3], s3); } { const f32x4 l = *(const LAS f32x4*)(Lc + 2368); s0 = fmaf(x56, l[0], s0); s1 = fmaf(x57, l[1], s1); s2 = fmaf(x58, l[2], s2); s3 = fmaf(x59, l[3], s3); } { const f32x4 l = *(const LAS f32x4*)(Lc + 2372); s0 = fmaf(x60, l[0], s0); s1 = fmaf(x61, l[1], s1); s2 = fmaf(x62, l[2], s2); s3 = fmaf(x63, l[3], s3); } x34 = (lane == 34) ? 1.0f : -((s0 + s1) + (s2 + s3)); asm volatile("" : "+v"(x34) : : "memory"); }
    { float s0 = 0.f, s1 = 0.f, s2 = 0.f, s3 = 0.f; { const f32x4 l = *(const LAS f32x4*)(Lc + 2276); s2 = fmaf(x34, l[2], s2); s3 = fmaf(x35, l[3], s3); } { const f32x4 l = *(const LAS f32x4*)(Lc + 2280); s0 = fmaf(x36, l[0], s0); s1 = fmaf(x37, l[1], s1); s2 = fmaf(x38, l[2], s2); s3 = fmaf(x39, l[3], s3); } { const f32x4 l = *(const LAS f32x4*)(Lc + 2284); s0 = fmaf(x40, l[0], s0); s1 = fmaf(x41, l[1], s1); s2 = fmaf(x42, l[2], s2); s3 = fmaf(x43, l[3], s3); } { const f32x4 l = *(const LAS f32x4*)(Lc + 2288); s0 = fmaf(x44, l[0], s0); s1 = fmaf(x45, l[1], s1); s2 = fmaf(x46, l[2], s2); s3 = fmaf(x47, l[3], s3); } { const f32x4 l = *(const LAS f32x4*)(Lc + 2292); s0 = fmaf(x48, l[0], s0); s1 = fmaf(x49, l[1], s1); s2 = fmaf(x50, l[2], s2); s3 = fmaf(x51, l[3], s3); } { const f32x4 l = *(const LAS f32x4*)(Lc + 2296); s0 = fmaf(x52, l[0], s0); s1 = fmaf(x53, l[1], s1); s2 = fmaf(x54, l[2], s2); s3 = fmaf(x55, l[3], s3); } { const f32x4 l = *(const LAS f32x4*)(Lc + 2300); s0 = fmaf(x56, l[0], s0); s1 = fmaf(x57, l[1], s1); s2 = fmaf(x58, l[2], s2); s3 = fmaf(x59, l[3], s3); } { const f32x4 l = *(const LAS f32x4*)(Lc + 2304); s0 = fmaf(x60, l[0], s0); s1 = fmaf(x61, l[1], s1); s2 = fmaf(x62, l[2], s2); s3 = fmaf(x63, l[3], s3); } x33 = (lane == 33) ? 1.0f : -((s0 + s1) + (s2 + s3)); asm volatile("" : "+v"(x33) : : "memory"); }
    { float s0 = 0.f, s1 = 0.f, s2 = 0.f, s3 = 0.f; { const f32x4 l = *(const LAS f32x4*)(Lc + 2208); s1 = fmaf(x33, l[1], s1); s2 = fmaf(x34, l[2], s2); s3 = fmaf(x35, l[3], s3); } { const f32x4 l = *(const LAS f32x4*)(Lc + 2212); s0 = fmaf(x36, l[0], s0); s1 = fmaf(x37, l[1], s1); s2 = fmaf(x38, l[2], s2); s3 = fmaf(x39, l[3], s3); } { const f32x4 l = *(const LAS f32x4*)(Lc + 2216); s0 = fmaf(x40, l[0], s0); s1 = fmaf(x41, l[1], s1); s2 = fmaf(x42, l[2], s2); s3 = fmaf(x43, l[3], s3); } { const f32x4 l = *(const LAS f32x4*)(Lc + 2220); s0 = fmaf(x44, l[0], s0); s1 = fmaf(x45, l[1], s1); s2 = fmaf(x46, l[2], s2); s3 = fmaf(x47, l[3], s3); } { const f32x4 l = *(const LAS f32x4*)(Lc + 2224); s0 = fmaf(x48, l[0], s0); s1 = fmaf(x49, l[1], s1); s2 = fmaf(x50, l[2], s2); s3 = fmaf(x51, l[3], s3); } { const f32x4 l = *(const LAS f32x4*)(Lc + 2228); s0 = fmaf(x52, l[0], s0); s1 = fmaf(x53, l[1], s1); s2 = fmaf(x54, l[2], s2); s3 = fmaf(x55, l[3], s3); } { const f32x4 l = *(const LAS f32x4*)(Lc + 2232); s0 = fmaf(x56, l[0], s0); s1 = fmaf(x57, l[1], s1); s2 = fmaf(x58, l[2], s2); s3 = fmaf(x59, l[3], s3); } { const f32x4 l = *(const LAS f32x4*)(Lc + 2236); s0 = fmaf(x60, l[0], s0); s1 = fmaf(x61, l[1], s1); s2 = fmaf(x62, l[2], s2); s3 = fmaf(x63, l[3], s3); } x32 = (lane == 32) ? 1.0f : -((s0 + s1) + (s2 + s3)); asm volatile("" : "+v"(x32) : : "memory"); }
    { float s0 = 0.f, s1 = 0.f, s2 = 0.f, s3 = 0.f; { const f32x4 l = *(const LAS f32x4*)(Lc + 2140); s0 = fmaf(x32, l[0], s0); s1 = fmaf(x33, l[1], s1); s2 = fmaf(x34, l[2], s2); s3 = fmaf(x35, l[3], s3); } { const f32x4 l = *(const LAS f32x4*)(Lc + 2144); s0 = fmaf(x36, l[0], s0); s1 = fmaf(x37, l[1], s1); s2 = fmaf(x38, l[2], s2); s3 = fmaf(x39, l[3], s3); } { const f32x4 l = *(const LAS f32x4*)(Lc + 2148); s0 = fmaf(x40, l[0], s0); s1 = fmaf(x41, l[1], s1); s2 = fmaf(x42, l[2], s2); s3 = fmaf(x43, l[3], s3); } { const f32x4 l = *(const LAS f32x4*)(Lc + 2152); s0 = fmaf(x44, l[0], s0); s1 = fmaf(x45, l[1], s1); s2 = fmaf(x46, l[2], s2); s3 = fmaf(x47, l[3], s3); } { const f32x4 l = *(const LAS f32x4*)(Lc + 2156); s0 = fmaf(x48, l[0], s0); s1 = fmaf(x49, l[1], s1); s2 = fmaf(x50, l[2], s2); s3 = fmaf(x51, l[3], s3); } { const f32x4 l = *(const LAS f32x4*)(Lc + 2160); s0 = fmaf(x52, l[0], s0); s1 = fmaf(x53, l[1], s1); s2 = fmaf(x54, l[2], s2); s3 = fmaf(x55, l[3], s3); } { const f32x4 l = *(const LAS f32x4*)(Lc + 2164); s0 = fmaf(x56, l[0], s0); s1 = fmaf(x57, l[1], s1); s2 = fmaf(x58, l[2], s2); s3 = fmaf(x59, l[3], s3); } { const f32x4 l = *(const LAS f32x4*)(Lc + 2168); s0 = fmaf(x60, l[0], s0); s1 = fmaf(x61, l[1], s1); s2 = fmaf(x62, l[2], s2); s3 = fmaf(x63, l[3], s3); } x31 = (lane == 31) ? 1.0f : -((s0 + s1) + (s2 + s3)); asm volatile("" : "+v"(x31) : : "memory"); }
    { float s0 = 0.f, s1 = 0.f, s2 = 0.f, s3 = 0.f; { const f32x4 l = *(const LAS f32x4*)(Lc + 2068); s3 = fmaf(x31, l[3], s3); } { const f32x4 l = *(const LAS f32x4*)(Lc + 2072); s0 = fmaf(x32, l[0], s0); s1 = fmaf(x33, l[1], s1); s2 = fmaf(x34, l[2], s2); s3 = fmaf(x35, l[3], s3); } { const f32x4 l = *(const LAS f32x4*)(Lc + 2076); s0 = fmaf(x36, l[0], s0); s1 = fmaf(x37, l[1], s1); s2 = fmaf(x38, l[2], s2); s3 = fmaf(x39, l[3], s3); } { const f32x4 l = *(const LAS f32x4*)(Lc + 2080); s0 = fmaf(x40, l[0], s0); s1 = fmaf(x41, l[1], s1); s2 = fmaf(x42, l[2], s2); s3 = fmaf(x43, l[3], s3); } { const f32x4 l = *(const LAS f32x4*)(Lc + 2084); s0 = fmaf(x44, l[0], s0); s1 = fmaf(x45, l[1], s1); s2 = fmaf(x46, l[2], s2); s3 = fmaf(x47, l[3], s3); } { const f32x4 l = *(const LAS f32x4*)(Lc + 2088); s0 = fmaf(x48, l[0], s0); s1 = fmaf(x49, l[1], s1); s2 = fmaf(x50, l[2], s2); s3 = fmaf(x51, l[3], s3); } { const f32x4 l = *(const LAS f32x4*)(Lc + 2092); s0 = fmaf(x52, l[0], s0); s1 = fmaf(x53, l[1], s1); s2 = fmaf(x54, l[2], s2); s3 = fmaf(x55, l[3], s3); } { const f32x4 l = *(const LAS f32x4*)(Lc + 2096); s0 = fmaf(x56, l[0], s0); s1 = fmaf(x57, l[1], s1); s2 = fmaf(x58, l[2], s2); s3 = fmaf(x59, l[3], s3); } { const f32x4 l = *(const LAS f32x4*)(Lc + 2100); s0 = fmaf(x60, l[0], s0); s1 = fmaf(x61, l[1], s1); s2 = fmaf(x62, l[2], s2); s3 = fmaf(x63, l[3], s3); } x30 = (lane == 30) ? 1.0f : -((s0 + s1) + (s2 + s3)); asm volatile("" : "+v"(x30) : : "memory"); }
    { float s0 = 0.f, s1 = 0.f, s2 = 0.f, s3 = 0.f; { const f32x4 l = *(const LAS f32x4*)(Lc + 2000); s2 = fmaf(x30, l[2], s2); s3 = fmaf(x31, l[3], s3); } { const f32x4 l = *(const LAS f32x4*)(Lc + 2004); s0 = fmaf(x32, l[0], s0); s1 = fmaf(x33, l[1], s1); s2 = fmaf(x34, l[2], s2); s3 = fmaf(x35, l[3], s3); } { const f32x4 l = *(const LAS f32x4*)(Lc + 2008); s0 = fmaf(x36, l[0], s0); s1 = fmaf(x37, l[1], s1); s2 = fmaf(x38, l[2], s2); s3 = fmaf(x39, l[3], s3); } { const f32x4 l = *(const LAS f32x4*)(Lc + 2012); s0 = fmaf(x40, l[0], s0); s1 = fmaf(x41, l[1], s1); s2 = fmaf(x42, l[2], s2); s3 = fmaf(x43, l[3], s3); } { const f32x4 l = *(const LAS f32x4*)(Lc + 2016); s0 = fmaf(x44, l[0], s0); s1 = fmaf(x45, l[1], s1); s2 = fmaf(x46, l[2], s2); s3 = fmaf(x47, l[3], s3); } { const f32x4 l = *(const LAS f32x4*)(Lc + 2020); s0 = fmaf(x48, l[0], s0); s1 = fmaf(x49, l[1], s1); s2 = fmaf(x50, l[2], s2); s3 = fmaf(x51, l[3], s3); } { const f32x4 l = *(const LAS f32x4*)(Lc + 2024); s0 = fmaf(x52, l[0], s0); s1 = fmaf(x53, l[1], s1); s2 = fmaf(x54, l[2], s2); s3 = fmaf(x55, l[3], s3); } { const f32x4 l = *(const LAS f32x4*)(Lc + 2028); s0 = fmaf(x56, l[0], s0); s1 = fmaf(x57, l[1], s1); s2 = fmaf(x58, l[2], s2); s3 = fmaf(x59, l[3], s3); } { const f32x4 l = *(const LAS f32x4*)(Lc + 2032); s0 = fmaf(x60, l[0], s0); s1 = fmaf(x61, l[1], s1); s2 = fmaf(x62, l[2], s2); s3 = fmaf(x63, l[3], s3); } x29 = (lane == 29) ? 1.0f : -((s0 + s1) + (s2 + s3)); asm volatile("" : "+v"(x29) : : "memory"); }
    { float s0 = 0.f, s1 = 0.f, s2 = 0.f, s3 = 0.f; { const f32x4 l = *(const LAS f32x4*)(Lc + 1932); s1 = fmaf(x29, l[1], s1); s2 = fmaf(x30, l[2], s2); s3 = fmaf(x31, l[3], s3); } { const f32x4 l = *(const LAS f32x4*)(Lc + 1936); s0 = fmaf(x32, l[0], s0); s1 = fmaf(x33, l[1], s1); s2 = fmaf(x34, l[2], s2); s3 = fmaf(x35, l[3], s3); } { const f32x4 l = *(const LAS f32x4*)(Lc + 1940); s0 = fmaf(x36, l[0], s0); s1 = fmaf(x37, l[1], s1); s2 = fmaf(x38, l[2], s2); s3 = fmaf(x39, l[3], s3); } { const f32x4 l = *(const LAS f32x4*)(Lc + 1944); s0 = fmaf(x40, l[0], s0); s1 = fmaf(x41, l[1], s1); s2 = fmaf(x42, l[2], s2); s3 = fmaf(x43, l[3], s3); } { const f32x4 l = *(const LAS f32x4*)(Lc + 1948); s0 = fmaf(x44, l[0], s0); s1 = fmaf(x45, l[1], s1); s2 = fmaf(x46, l[2], s2); s3 = fmaf(x47, l[3], s3); } { const f32x4 l = *(const LAS f32x4*)(Lc + 1952); s0 = fmaf(x48, l[0], s0); s1 = fmaf(x49, l[1], s1); s2 = fmaf(x50, l[2], s2); s3 = fmaf(x51, l[3], s3); } { const f32x4 l = *(const LAS f32x4*)(Lc + 1956); s0 = fmaf(x52, l[0], s0); s1 = fmaf(x53, l[1], s1); s2 = fmaf(x54, l[2], s2); s3 = fmaf(x55, l[3], s3); } { const f32x4 l = *(const LAS f32x4*)(Lc + 1960); s0 = fmaf(x56, l[0], s0); s1 = fmaf(x57, l[1], s1); s2 = fmaf(x58, l[2], s2); s3 = fmaf(x59, l[3], s3); } { const f32x4 l = *(const LAS f32x4*)(Lc + 1964); s0 = fmaf(x60, l[0], s0); s1 = fmaf(x61, l[1], s1); s2 = fmaf(x62, l[2], s2); s3 = fmaf(x63, l[3], s3); } x28 = (lane == 28) ? 1.0f : -((s0 + s1) + (s2 + s3)); asm volatile("" : "+v"(x28) : : "memory"); }
    { float s0 = 0.f, s1 = 0.f, s2 = 0.f, s3 = 0.f; { const f32x4 l = *(const LAS f32x4*)(Lc + 1864); s0 = fmaf(x28, l[0], s0); s1 = fmaf(x29, l[1], s1); s2 = fmaf(x30, l[2], s2); s3 = fmaf(x31, l[3], s3); } { const f32x4 l = *(const LAS f32x4*)(Lc + 1868); s0 = fmaf(x32, l[0], s0); s1 = fmaf(x33, l[1], s1); s2 = fmaf(x34, l[2], s2); s3 = fmaf(x35, l[3], s3); } { const f32x4 l = *(const LAS f32x4*)(Lc + 1872); s0 = fmaf(x36, l[0], s0); s1 = fmaf(x37, l[1], s1); s2 = fmaf(x38, l[2], s2); s3 = fmaf(x39, l[3], s3); } { const f32x4 l = *(const LAS f32x4*)(Lc + 1876); s0 = fmaf(x40, l[0], s0); s1 = fmaf(x41, l[1], s1); s2 = fmaf(x42, l[2], s2); s3 = fmaf(x43, l[3], s3); } { const f32x4 l = *(const LAS f32x4*)(Lc + 1880); s0 = fmaf(x44, l[0], s0); s1 = fmaf(x45, l[1], s1); s2 = fmaf(x46, l[2], s2); s3 = fmaf(x47, l[3], s3); } { const f32x4 l = *(const LAS f32x4*)(Lc + 1884); s0 = fmaf(x48, l[0], s0); s1 = fmaf(x49, l[1], s1); s2 = fmaf(x50, l[2], s2); s3 = fmaf(x51, l[3], s3); } { const f32x4 l = *(const LAS f32x4*)(Lc + 1888); s0 = fmaf(x52, l[0], s0); s1 = fmaf(x53, l[1], s1); s2 = fmaf(x54, l[2], s2); s3 = fmaf(x55, l[3], s3); } { const f32x4 l = *(const LAS f32x4*)(Lc + 1892); s0 = fmaf(x56, l[0], s0); s1 = fmaf(x57, l[1], s1); s2 = fmaf(x58, l[2], s2); s3 = fmaf(x59, l[3], s3); } { const f32x4 l = *(const LAS f32x4*)(Lc + 1896); s0 = fmaf(x60, l[0], s0); s1 = fmaf(x61, l[1], s1); s2 = fmaf(x62, l[2], s2); s3 = fmaf(x63, l[3], s3); } x27 = (lane == 27) ? 1.0f : -((s0 + s1) + (s2 + s3)); asm volatile("" : "+v"(x27) : : "memory"); }
    { float s0 = 0.f, s1 = 0.f, s2 = 0.f, s3 = 0.f; { const f32x4 l = *(const LAS f32x4*)(Lc + 1792); s3 = fmaf(x27, l[3], s3); } { const f32x4 l = *(const LAS f32x4*)(Lc + 1796); s0 = fmaf(x28, l[0], s0); s1 = fmaf(x29, l[1], s1); s2 = fmaf(x30, l[2], s2); s3 = fmaf(x31, l[3], s3); } { const f32x4 l = *(const LAS f32x4*)(Lc + 1800); s0 = fmaf(x32, l[0], s0); s1 = fmaf(x33, l[1], s1); s2 = fmaf(x34, l[2], s2); s3 = fmaf(x35, l[3], s3); } { const f32x4 l = *(const LAS f32x4*)(Lc + 1804); s0 = fmaf(x36, l[0], s0); s1 = fmaf(x37, l[1], s1); s2 = fmaf(x38, l[2], s2); s3 = fmaf(x39, l[3], s3); } { const f32x4 l = *(const LAS f32x4*)(Lc + 1808); s0 = fmaf(x40, l[0], s0); s1 = fmaf(x41, l[1], s1); s2 = fmaf(x42, l[2], s2); s3 = fmaf(x43, l[3], s3); } { const f32x4 l = *(const LAS f32x4*)(Lc + 1812); s0 = fmaf(x44, l[0], s0); s1 = fmaf(x45, l[1], s1); s2 = fmaf(x46, l[2], s2); s3 = fmaf(x47, l[3], s3); } { const f32x4 l = *(const LAS f32x4*)(Lc + 1816); s0 = fmaf(x48, l[0], s0); s1 = fmaf(x49, l[1], s1); s2 = fmaf(x50, l[2], s2); s3 = fmaf(x51, l[3], s3); } { const f32x4 l = *(const LAS f32x4*)(Lc + 1820); s0 = fmaf(x52, l[0], s0); s1 = fmaf(x53, l[1], s1); s2 = fmaf(x54, l[2], s2); s3 = fmaf(x55, l[3], s3); } { const f32x4 l = *(const LAS f32x4*)(Lc + 1824); s0 = fmaf(x56, l[0], s0); s1 = fmaf(x57, l[1], s1); s2 = fmaf(x58, l[2], s2); s3 = fmaf(x59, l[3], s3); } { const f32x4 l = *(const LAS f32x4*)(Lc + 1828); s0 = fmaf(x60, l[0], s0); s1 = fmaf(x61, l[1], s1); s2 = fmaf(x62, l[2], s2); s3 = fmaf(x63, l[3], s3); } x26 = (lane == 26) ? 1.0f : -((s0 + s1) + (s2 + s3)); asm volatile("" : "+v"(x26) : : "memory"); }
    { float s0 = 0.f, s1 = 0.f, s2 = 0.f, s3 = 0.f; { const f32x4 l = *(const LAS f32x4*)(Lc + 1724); s2 = fmaf(x26, l[2], s2); s3 = fmaf(x27, l[3], s3); } { const f32x4 l = *(const LAS f32x4*)(Lc + 1728); s0 = fmaf(x28, l[0], s0); s1 = fmaf(x29, l[1], s1); s2 = fmaf(x30, l[2], s2); s3 = fmaf(x31, l[3], s3); } { const f32x4 l = *(const LAS f32x4*)(Lc + 1732); s0 = fmaf(x32, l[0], s0); s1 = fmaf(x33, l[1], s1); s2 = fmaf(x34, l[2], s2); s3 = fmaf(x35, l[3], s3); } { const f32x4 l = *(const LAS f32x4*)(Lc + 1736); s0 = fmaf(x36, l[0], s0); s1 = fmaf(x37, l[1], s1); s2 = fmaf(x38, l[2], s2); s3 = fmaf(x39, l[3], s3); } { const f32x4 l = *(const LAS f32x4*)(Lc + 1740); s0 = fmaf(x40, l[0], s0); s1 = fmaf(x41, l[1], s1); s2 = fmaf(x42, l[2], s2); s3 = fmaf(x43, l[3], s3); } { const f32x4 l = *(const LAS f32x4*)(Lc + 1744); s0 = fmaf(x44, l[0], s0); s1 = fmaf(x45, l[1], s1); s2 = fmaf(x46, l[2], s2); s3 = fmaf(x47, l[3], s3); } { const f32x4 l = *(const LAS f32x4*)(Lc + 1748); s0 = fmaf(x48, l[0], s0); s1 = fmaf(x49, l[1], s1); s2 = fmaf(x50, l[2], s2); s3 = fmaf(x51, l[3], s3); } { const f32x4 l = *(const LAS f32x4*)(Lc + 1752); s0 = fmaf(x52, l[0], s0); s1 = fmaf(x53, l[1], s1); s2 = fmaf(x54, l[2], s2); s3 = fmaf(x55, l[3], s3); } { const f32x4 l = *(const LAS f32x4*)(Lc + 1756); s0 = fmaf(x56, l[0], s0); s1 = fmaf(x57, l[1], s1); s2 = fmaf(x58, l[2], s2); s3 = fmaf(x59, l[3], s3); } { const f32x4 l = *(const LAS f32x4*)(Lc + 1760); s0 = fmaf(x60, l[0], s0); s1 = fmaf(x61, l[1], s1); s2 = fmaf(x62, l[2], s2); s3 = fmaf(x63, l[3], s3); } x25 = (lane == 25) ? 1.0f : -((s0 + s1) + (s2 + s3)); asm volatile("" : "+v"(x25) : : "memory"); }
    { float s0 = 0.f, s1 = 0.f, s2 = 0.f, s3 = 0.f; { const f32x4 l = *(const LAS f32x4*)(Lc + 1656); s1 = fmaf(x25, l[1], s1); s2 = fmaf(x26, l[2], s2); s3 = fmaf(x27, l[3], s3); } { const f32x4 l = *(const LAS f32x4*)(Lc + 1660); s0 = fmaf(x28, l[0], s0); s1 = fmaf(x29, l[1], s1); s2 = fmaf(x30, l[2], s2); s3 = fmaf(x31, l[3], s3); } { const f32x4 l = *(const LAS f32x4*)(Lc + 1664); s0 = fmaf(x32, l[0], s0); s1 = fmaf(x33, l[1], s1); s2 = fmaf(x34, l[2], s2); s3 = fmaf(x35, l[3], s3); } { const f32x4 l = *(const LAS f32x4*)(Lc + 1668); s0 = fmaf(x36, l[0], s0); s1 = fmaf(x37, l[1], s1); s2 = fmaf(x38, l[2], s2); s3 = fmaf(x39, l[3], s3); } { const f32x4 l = *(const LAS f32x4*)(Lc + 1672); s0 = fmaf(x40, l[0], s0); s1 = fmaf(x41, l[1], s1); s2 = fmaf(x42, l[2], s2); s3 = fmaf(x43, l[3], s3); } { const f32x4 l = *(const LAS f32x4*)(Lc + 1676); s0 = fmaf(x44, l[0], s0); s1 = fmaf(x45, l[1], s1); s2 = fmaf(x46, l[2], s2); s3 = fmaf(x47, l[3], s3); } { const f32x4 l = *(const LAS f32x4*)(Lc + 1680); s0 = fmaf(x48, l[0], s0); s1 = fmaf(x49, l[1], s1); s2 = fmaf(x50, l[2], s2); s3 = fmaf(x51, l[3], s3); } { const f32x4 l = *(const LAS f32x4*)(Lc + 1684); s0 = fmaf(x52, l[0], s0); s1 = fmaf(x53, l[1], s1); s2 = fmaf(x54, l[2], s2); s3 = fmaf(x55, l[3], s3); } { const f32x4 l = *(const LAS f32x4*)(Lc + 1688); s0 = fmaf(x56, l[0], s0); s1 = fmaf(x57, l[1], s1); s2 = fmaf(x58, l[2], s2); s3 = fmaf(x59, l[3], s3); } { const f32x4 l = *(const LAS f32x4*)(Lc + 1692); s0 = fmaf(x60, l[0], s0); s1 = fmaf(x61, l[1], s1); s2 = fmaf(x62, l[2], s2); s3 = fmaf(x63, l[3], s3); } x24 = (lane == 24) ? 1.0f : -((s0 + s1) + (s2 + s3)); asm volatile("" : "+v"(x24) : : "memory"); }
    { float s0 = 0.f, s1 = 0.f, s2 = 0.f, s3 = 0.f; { const f32x4 l = *(const LAS f32x4*)(Lc + 1588); s0 = fmaf(x24, l[0], s0); s1 = fmaf(x25, l[1], s1); s2 = fmaf(x26, l[2], s2); s3 = fmaf(x27, l[3], s3); } { const f32x4 l = *(const LAS f32x4*)(Lc + 1592); s0 = fmaf(x28, l[0], s0); s1 = fmaf(x29, l[1], s1); s2 = fmaf(x30, l[2], s2); s3 = fmaf(x31, l[3], s3); } { const f32x4 l = *(const LAS f32x4*)(Lc + 1596); s0 = fmaf(x32, l[0], s0); s1 = fmaf(x33, l[1], s1); s2 = fmaf(x34, l[2], s2); s3 = fmaf(x35, l[3], s3); } { const f32x4 l = *(const LAS f32x4*)(Lc + 1600); s0 = fmaf(x36, l[0], s0); s1 = fmaf(x37, l[1], s1); s2 = fmaf(x38, l[2], s2); s3 = fmaf(x39, l[3], s3); } { const f32x4 l = *(const LAS f32x4*)(Lc + 1604); s0 = fmaf(x40, l[0], s0); s1 = fmaf(x41, l[1], s1); s2 = fmaf(x42, l[2], s2); s3 = fmaf(x43, l[3], s3); } { const f32x4 l = *(const LAS f32x4*)(Lc + 1608); s0 = fmaf(x44, l[0], s0); s1 = fmaf(x45, l[1], s1); s2 = fmaf(x46, l[2], s2); s3 = fmaf(x47, l[3], s3); } { const f32x4 l = *(const LAS f32x4*)(Lc + 1612); s0 = fmaf(x48, l[0], s0); s1 = fmaf(x49, l[1], s1); s2 = fmaf(x50, l[2], s2); s3 = fmaf(x51, l[3], s3); } { const f32x4 l = *(const LAS f32x4*)(Lc + 1616); s0 = fmaf(x52, l[0], s0); s1 = fmaf(x53, l[1], s1); s2 = fmaf(x54, l[2], s2); s3 = fmaf(x55, l[3], s3); } { const f32x4 l = *(const LAS f32x4*)(Lc + 1620); s0 = fmaf(x56, l[0], s0); s1 = fmaf(x57, l[1], s1); s2 = fmaf(x58, l[2], s2); s3 = fmaf(x59, l[3], s3); } { const f32x4 l = *(const LAS f32x4*)(Lc + 1624); s0 = fmaf(x60, l[0], s0); s1 = fmaf(x61, l[1], s1); s2 = fmaf(x62, l[2], s2); s3 = fmaf(x63, l[3], s3); } x23 = (lane == 23) ? 1.0f : -((s0 + s1) + (s2 + s3)); asm volatile("" : "+v"(x23) : : "memory"); }
    { float s0 = 0.f, s1 = 0.f, s2 = 0.f, s3 = 0.f; { const f32x4 l = *(const LAS f32x4*)(Lc + 1516); s3 = fmaf(x23, l[3], s3); } { const f32x4 l = *(const LAS f32x4*)(Lc + 1520); s0 = fmaf(x24, l[0], s0); s1 = fmaf(x25, l[1], s1); s2 = fmaf(x26, l[2], s2); s3 = fmaf(x27, l[3], s3); } { const f32x4 l = *(const LAS f32x4*)(Lc + 1524); s0 = fmaf(x28, l[0], s0); s1 = fmaf(x29, l[1], s1); s2 = fmaf(x30, l[2], s2); s3 = fmaf(x31, l[3], s3); } { const f32x4 l = *(const LAS f32x4*)(Lc + 1528); s0 = fmaf(x32, l[0], s0); s1 = fmaf(x33, l[1], s1); s2 = fmaf(x34, l[2], s2); s3 = fmaf(x35, l[3], s3); } { const f32x4 l = *(const LAS f32x4*)(Lc + 1532); s0 = fmaf(x36, l[0], s0); s1 = fmaf(x37, l[1], s1); s2 = fmaf(x38, l[2], s2); s3 = fmaf(x39, l[3], s3); } { const f32x4 l = *(const LAS f32x4*)(Lc + 1536); s0 = fmaf(x40, l[0], s0); s1 = fmaf(x41, l[1], s1); s2 = fmaf(x42, l[2], s2); s3 = fmaf(x43, l[3], s3); } { const f32x4 l = *(const LAS f32x4*)(Lc + 1540); s0 = fmaf(x44, l[0], s0); s1 = fmaf(x45, l[1], s1); s2 = fmaf(x46, l[2], s2); s3 = fmaf(x47, l[3], s3); } { const f32x4 l = *(const LAS f32x4*)(Lc + 1544); s0 = fmaf(x48, l[0], s0); s1 = fmaf(x49, l[1], s1); s2 = fmaf(x50, l[2], s2); s3 = fmaf(x51, l[3], s3); } { const f32x4 l = *(const LAS f32x4*)(Lc + 1548); s0 = fmaf(x52, l[0], s0); s1 = fmaf(x53, l[1], s1); s2 = fmaf(x54, l[2], s2); s3 = fmaf(x55, l[3], s3); } { const f32x4 l = *(const LAS f32x4*)(Lc + 1552); s0 = fmaf(x56, l[0], s0); s1 = fmaf(x57, l[1], s1); s2 = fmaf(x58, l[2], s2); s3 = fmaf(x59, l[3], s3); } { const f32x4 l = *(const LAS f32x4*)(Lc + 1556); s0 = fmaf(x60, l[0], s0); s1 = fmaf(x61, l[1], s1); s2 = fmaf(x62, l[2], s2); s3 = fmaf(x63, l[3], s3); } x22 = (lane == 22) ? 1.0f : -((s0 + s1) + (s2 + s3)); asm volatile("" : "+v"(x22) : : "memory"); }
    { float s0 = 0.f, s1 = 0.f, s2 = 0.f, s3 = 0.f; { const f32x4 l = *(const LAS f32x4*)(Lc + 1448); s2 = fmaf(x22, l[2], s2); s3 = fmaf(x23, l[3], s3); } { const f32x4 l = *(const LAS f32x4*)(Lc + 1452); s0 = fmaf(x24, l[0], s0); s1 = fmaf(x25, l[1], s1); s2 = fmaf(x26, l[2], s2); s3 = fmaf(x27, l[3], s3); } { const f32x4 l = *(const LAS f32x4*)(Lc + 1456); s0 = fmaf(x28, l[0], s0); s1 = fmaf(x29, l[1], s1); s2 = fmaf(x30, l[2], s2); s3 = fmaf(x31, l[3], s3); } { const f32x4 l = *(const LAS f32x4*)(Lc + 1460); s0 = fmaf(x32, l[0], s0); s1 = fmaf(x33, l[1], s1); s2 = fmaf(x34, l[2], s2); s3 = fmaf(x35, l[3], s3); } { const f32x4 l = *(const LAS f32x4*)(Lc + 1464); s0 = fmaf(x36, l[0], s0); s1 = fmaf(x37, l[1], s1); s2 = fmaf(x38, l[2], s2); s3 = fmaf(x39, l[3], s3); } { const f32x4 l = *(const LAS f32x4*)(Lc + 1468); s0 = fmaf(x40, l[0], s0); s1 = fmaf(x41, l[1], s1); s2 = fmaf(x42, l[2], s2); s3 = fmaf(x43, l[3], s3); } { const f32x4 l = *(const LAS f32x4*)(Lc + 1472); s0 = fmaf(x44, l[0], s0); s1 = fmaf(x45, l[1], s1); s2 = fmaf(x46, l[2], s2); s3 = fmaf(x47, l[3], s3); } { const f32x4 l = *(const LAS f32x4*)(Lc + 1476); s0 = fmaf(x48, l[0], s0); s1 = fmaf(x49, l[1], s1); s2 = fmaf(x50, l[2], s2); s3 = fmaf(x51, l[3], s3); } { const f32x4 l = *(const LAS f32x4*)(Lc + 1480); s0 = fmaf(x52, l[0], s0); s1 = fmaf(x53, l[1], s1); s2 = fmaf(x54, l[2], s2); s3 = fmaf(x55, l[3], s3); } { const f32x4 l = *(const LAS f32x4*)(Lc + 1484); s0 = fmaf(x56, l[0], s0); s1 = fmaf(x57, l[1], s1); s2 = fmaf(x58, l[2], s2); s3 = fmaf(x59, l[3], s3); } { const f32x4 l = *(const LAS f32x4*)(Lc + 1488); s0 = fmaf(x60, l[0], s0); s1 = fmaf(x61, l[1], s1); s2 = fmaf(x62, l[2], s2); s3 = fmaf(x63, l[3], s3); } x21 = (lane == 21) ? 1.0f : -((s0 + s1) + (s2 + s3)); asm volatile("" : "+v"(x21) : : "memory"); }
    { float s0 = 0.f, s1 = 0.f, s2 = 0.f, s3 = 0.f; { const f32x4 l = *(const LAS f32x4*)(Lc + 1380); s1 = fmaf(x21, l[1], s1); s2 = fmaf(x22, l[2], s2); s3 = fmaf(x23, l[3], s3); } { const f32x4 l = *(const LAS f32x4*)(Lc + 1384); s0 = fmaf(x24, l[0], s0); s1 = fmaf(x25, l[1], s1); s2 = fmaf(x26, l[2], s2); s3 = fmaf(x27, l[3], s3); } { const f32x4 l = *(const LAS f32x4*)(Lc + 1388); s0 = fmaf(x28, l[0], s0); s1 = fmaf(x29, l[1], s1); s2 = fmaf(x30, l[2], s2); s3 = fmaf(x31, l[3], s3); } { const f32x4 l = *(const LAS f32x4*)(Lc + 1392); s0 = fmaf(x32, l[0], s0); s1 = fmaf(x33, l[1], s1); s2 = fmaf(x34, l[2], s2); s3 = fmaf(x35, l[3], s3); } { const f32x4 l = *(const LAS f32x4*)(Lc + 1396); s0 = fmaf(x36, l[0], s0); s1 = fmaf(x37, l[1], s1); s2 = fmaf(x38, l[2], s2); s3 = fmaf(x39, l[3], s3); } { const f32x4 l = *(const LAS f32x4*)(Lc + 1400); s0 = fmaf(x40, l[0], s0); s1 = fmaf(x41, l[1], s1); s2 = fmaf(x42, l[2], s2); s3 = fmaf(x43, l[3], s3); } { const f32x4 l = *(const LAS f32x4*)(Lc + 1404); s0 = fmaf(x44, l[0], s0); s1 = fmaf(x45, l[1], s1); s2 = fmaf(x46, l[2], s2); s3 = fmaf(x47, l[3], s3); } { const f32x4 l = *(const LAS f32x4*)(Lc + 1408); s0 = fmaf(x48, l[0], s0); s1 = fmaf(x49, l[1], s1); s2 = fmaf(x50, l[2], s2); s3 = fmaf(x51, l[3], s3); } { const f32x4 l = *(const LAS f32x4*)(Lc + 1412); s0 = fmaf(x52, l[0], s0); s1 = fmaf(x53, l[1], s1); s2 = fmaf(x54, l[2], s2); s3 = fmaf(x55, l[3], s3); } { const f32x4 l = *(const LAS f32x4*)(Lc + 1416); s0 = fmaf(x56, l[0], s0); s1 = fmaf(x57, l[1], s1); s2 = fmaf(x58, l[2], s2); s3 = fmaf(x59, l[3], s3); } { const f32x4 l = *(const LAS f32x4*)(Lc + 1420); s0 = fmaf(x60, l[0], s0); s1 = fmaf(x61, l[1], s1); s2 = fmaf(x62, l[2], s2); s3 = fmaf(x63, l[3], s3); } x20 = (lane == 20) ? 1.0f : -((s0 + s1) + (s2 + s3)); asm volatile("" : "+v"(x20) : : "memory"); }
    { float s0 = 0.f, s1 = 0.f, s2 = 0.f, s3 = 0.f; { const f32x4 l = *(const LAS f32x4*)(Lc + 1312); s0 = fmaf(x20, l[0], s0); s1 = fmaf(x21, l[1], s1); s2 = fmaf(x22, l[2], s2); s3 = fmaf(x23, l[3], s3); } { const f32x4 l = *(const LAS f32x4*)(Lc + 1316); s0 = fmaf(x24, l[0], s0); s1 = fmaf(x25, l[1], s1); s2 = fmaf(x26, l[2], s2); s3 = fmaf(x27, l[3], s3); } { const f32x4 l = *(const LAS f32x4*)(Lc + 1320); s0 = fmaf(x28, l[0], s0); s1 = fmaf(x29, l[1], s1); s2 = fmaf(x30, l[2], s2); s3 = fmaf(x31, l[3], s3); } { const f32x4 l = *(const LAS f32x4*)(Lc + 1324); s0 = fmaf(x32, l[0], s0); s1 = fmaf(x33, l[1], s1); s2 = fmaf(x34, l[2], s2); s3 = fmaf(x35, l[3], s3); } { const f32x4 l = *(const LAS f32x4*)(Lc + 1328); s0 = fmaf(x36, l[0], s0); s1 = fmaf(x37, l[1], s1); s2 = fmaf(x38, l[2], s2); s3 = fmaf(x39, l[3], s3); } { const f32x4 l = *(const LAS f32x4*)(Lc + 1332); s0 = fmaf(x40, l[0], s0); s1 = fmaf(x41, l[1], s1); s2 = fmaf(x42, l[2], s2); s3 = fmaf(x43, l[3], s3); } { const f32x4 l = *(const LAS f32x4*)(Lc + 1336); s0 = fmaf(x44, l[0], s0); s1 = fmaf(x45, l[1], s1); s2 = fmaf(x46, l[2], s2); s3 = fmaf(x47, l[3], s3); } { const f32x4 l = *(const LAS f32x4*)(Lc + 1340); s0 = fmaf(x48, l[0], s0); s1 = fmaf(x49, l[1], s1); s2 = fmaf(x50, l[2], s2); s3 = fmaf(x51, l[3], s3); } { const f32x4 l = *(const LAS f32x4*)(Lc + 1344); s0 = fmaf(x52, l[0], s0); s1 = fmaf(x53, l[1], s1); s2 = fmaf(x54, l[2], s2); s3 = fmaf(x55, l[3], s3); } { const f32x4 l = *(const LAS f32x4*)(Lc + 1348); s0 = fmaf(x56, l[0], s0); s1 = fmaf(x57, l[1], s1); s2 = fmaf(x58, l[2], s2); s3 = fmaf(x59, l[3], s3); } { const f32x4 l = *(const LAS f32x4*)(Lc + 1352); s0 = fmaf(x60, l[0], s0); s1 = fmaf(x61, l[1], s1); s2 = fmaf(x62, l[2], s2); s3 = fmaf(x63, l[3], s3); } x19 = (lane == 19) ? 1.0f : -((s0 + s1) + (s2 + s3)); asm volatile("" : "+v"(x19) : : "memory"); }
    { float s0 = 0.f, s1 = 0.f, s2 = 0.f, s3 = 0.f; { const f32x4 l = *(const LAS f32x4*)(Lc + 1240); s3 = fmaf(x19, l[3], s3); } { const f32x4 l = *(const LAS f32x4*)(Lc + 1244); s0 = fmaf(x20, l[0], s0); s1 = fmaf(x21, l[1], s1); s2 = fmaf(x22, l[2], s2); s3 = fmaf(x23, l[3], s3); } { const f32x4 l = *(const LAS f32x4*)(Lc + 1248); s0 = fmaf(x24, l[0], s0); s1 = fmaf(x25, l[1], s1); s2 = fmaf(x26, l[2], s2); s3 = fmaf(x27, l[3], s3); } { const f32x4 l = *(const LAS f32x4*)(Lc + 1252); s0 = fmaf(x28, l[0], s0); s1 = fmaf(x29, l[1], s1); s2 = fmaf(x30, l[2], s2); s3 = fmaf(x31, l[3], s3); } { const f32x4 l = *(const LAS f32x4*)(Lc + 1256); s0 = fmaf(x32, l[0], s0); s1 = fmaf(x33, l[1], s1); s2 = fmaf(x34, l[2], s2); s3 = fmaf(x35, l[3], s3); } { const f32x4 l = *(const LAS f32x4*)(Lc + 1260); s0 = fmaf(x36, l[0], s0); s1 = fmaf(x37, l[1], s1); s2 = fmaf(x38, l[2], s2); s3 = fmaf(x39, l[3], s3); } { const f32x4 l = *(const LAS f32x4*)(Lc + 1264); s0 = fmaf(x40, l[0], s0); s1 = fmaf(x41, l[1], s1); s2 = fmaf(x42, l[2], s2); s3 = fmaf(x43, l[3], s3); } { const f32x4 l = *(const LAS f32x4*)(Lc + 1268); s0 = fmaf(x44, l[0], s0); s1 = fmaf(x45, l[1], s1); s2 = fmaf(x46, l[2], s2); s3 = fmaf(x47, l[3], s3); } { const f32x4 l = *(const LAS f32x4*)(Lc + 1272); s0 = fmaf(x48, l[0], s0); s1 = fmaf(x49, l[1], s1); s2 = fmaf(x50, l[2], s2); s3 = fmaf(x51, l[3], s3); } { const f32x4 l = *(const LAS f32x4*)(Lc + 1276); s0 = fmaf(x52, l[0], s0); s1 = fmaf(x53, l[1], s1); s2 = fmaf(x54, l[2], s2); s3 = fmaf(x55, l[3], s3); } { const f32x4 l = *(const LAS f32x4*)(Lc + 1280); s0 = fmaf(x56, l[0], s0); s1 = fmaf(x57, l[1], s1); s2 = fmaf(x58, l[2], s2); s3 = fmaf(x59, l[3], s3); } { const f32x4 l = *(const LAS f32x4*)(Lc + 1284); s0 = fmaf(x60, l[0], s0); s1 = fmaf(x61, l[1], s1); s2 = fmaf(x62, l[2], s2); s3 = fmaf(x63, l[3], s3); } x18 = (lane == 18) ? 1.0f : -((s0 + s1) + (s2 + s3)); asm volatile("" : "+v"(x18) : : "memory"); }
    { float s0 = 0.f, s1 = 0.f, s2 = 0.f, s3 = 0.f; { const f32x4 l = *(const LAS f32x4*)(Lc + 1172); s2 = fmaf(x18, l[2], s2); s3 = fmaf(x19, l[3], s3); } { const f32x4 l = *(const LAS f32x4*)(Lc + 1176); s0 = fmaf(x20, l[0], s0); s1 = fmaf(x21, l[1], s1); s2 = fmaf(x22, l[2], s2); s3 = fmaf(x23, l[3], s3); } { const f32x4 l = *(const LAS f32x4*)(Lc + 1180); s0 = fmaf(x24, l[0], s0); s1 = fmaf(x25, l[1], s1); s2 = fmaf(x26, l[2], s2); s3 = fmaf(x27, l[3], s3); } { const f32x4 l = *(const LAS f32x4*)(Lc + 1184); s0 = fmaf(x28, l[0], s0); s1 = fmaf(x29, l[1], s1); s2 = fmaf(x30, l[2], s2); s3 = fmaf(x31, l[3], s3); } { const f32x4 l = *(const LAS f32x4*)(Lc + 1188); s0 = fmaf(x32, l[0], s0); s1 = fmaf(x33, l[1], s1); s2 = fmaf(x34, l[2], s2); s3 = fmaf(x35, l[3], s3); } { const f32x4 l = *(const LAS f32x4*)(Lc + 1192); s0 = fmaf(x36, l[0], s0); s1 = fmaf(x37, l[1], s1); s2 = fmaf(x38, l[2], s2); s3 = fmaf(x39, l[3], s3); } { const f32x4 l = *(const LAS f32x4*)(Lc + 1196); s0 = fmaf(x40, l[0], s0); s1 = fmaf(x41, l[1], s1); s2 = fmaf(x42, l[2], s2); s3 = fmaf(x43, l[3], s3); } { const f32x4 l = *(const LAS f32x4*)(Lc + 1200); s0 = fmaf(x44, l[0], s0); s1 = fmaf(x45, l[1], s1); s2 = fmaf(x46, l[2], s2); s3 = fmaf(x47, l[3], s3); } { const f32x4 l = *(const LAS f32x4*)(Lc + 1204); s0 = fmaf(x48, l[0], s0); s1 = fmaf(x49, l[1], s1); s2 = fmaf(x50, l[2], s2); s3 = fmaf(x51, l[3], s3); } { const f32x4 l = *(const LAS f32x4*)(Lc + 1208); s0 = fmaf(x52, l[0], s0); s1 = fmaf(x53, l[1], s1); s2 = fmaf(x54, l[2], s2); s3 = fmaf(x55, l[3], s3); } { const f32x4 l = *(const LAS f32x4*)(Lc + 1212); s0 = fmaf(x56, l[0], s0); s1 = fmaf(x57, l[1], s1); s2 = fmaf(x58, l[2], s2); s3 = fmaf(x59, l[3], s3); } { const f32x4 l = *(const LAS f32x4*)(Lc + 1216); s0 = fmaf(x60, l[0], s0); s1 = fmaf(x61, l[1], s1); s2 = fmaf(x62, l[2], s2); s3 = fmaf(x63, l[3], s3); } x17 = (lane == 17) ? 1.0f : -((s0 + s1) + (s2 + s3)); asm volatile("" : "+v"(x17) : : "memory"); }
    { float s0 = 0.f, s1 = 0.f, s2 = 0.f, s3 = 0.f; { const f32x4 l = *(const LAS f32x4*)(Lc + 1104); s1 = fmaf(x17, l[1], s1); s2 = fmaf(x18, l[2], s2); s3 = fmaf(x19, l[3], s3); } { const f32x4 l = *(const LAS f32x4*)(Lc + 1108); s0 = fmaf(x20, l[0], s0); s1 = fmaf(x21, l[1], s1); s2 = fmaf(x22, l[2], s2); s3 = fmaf(x23, l[3], s3); } { const f32x4 l = *(const LAS f32x4*)(Lc + 1112); s0 = fmaf(x24, l[0], s0); s1 = fmaf(x25, l[1], s1); s2 = fmaf(x26, l[2], s2); s3 = fmaf(x27, l[3], s3); } { const f32x4 l = *(const LAS f32x4*)(Lc + 1116); s0 = fmaf(x28, l[0], s0); s1 = fmaf(x29, l[1], s1); s2 = fmaf(x30, l[2], s2); s3 = fmaf(x31, l[3], s3); } { const f32x4 l = *(const LAS f32x4*)(Lc + 1120); s0 = fmaf(x32, l[0], s0); s1 = fmaf(x33, l[1], s1); s2 = fmaf(x34, l[2], s2); s3 = fmaf(x35, l[3], s3); } { const f32x4 l = *(const LAS f32x4*)(Lc + 1124); s0 = fmaf(x36, l[0], s0); s1 = fmaf(x37, l[1], s1); s2 = fmaf(x38, l[2], s2); s3 = fmaf(x39, l[3], s3); } { const f32x4 l = *(const LAS f32x4*)(Lc + 1128); s0 = fmaf(x40, l[0], s0); s1 = fmaf(x41, l[1], s1); s2 = fmaf(x42, l[2], s2); s3 = fmaf(x43, l[3], s3); } { const f32x4 l = *(const LAS f32x4*)(Lc + 1132); s0 = fmaf(x44, l[0], s0); s1 = fmaf(x45, l[1], s1); s2 = fmaf(x46, l[2], s2); s3 = fmaf(x47, l[3], s3); } { const f32x4 l = *(const LAS f32x4*)(Lc + 1136); s0 = fmaf(x48, l[0], s0); s1 = fmaf(x49, l[1], s1); s2 = fmaf(x50, l[2], s2); s3 = fmaf(x51, l[3], s3); } { const f32x4 l = *(const LAS f32x4*)(Lc + 1140); s0 = fmaf(x52, l[0], s0); s1 = fmaf(x53, l[1], s1); s2 = fmaf(x54, l[2], s2); s3 = fmaf(x55, l[3], s3); } { const f32x4 l = *(const LAS f32x4*)(Lc + 1144); s0 = fmaf(x56, l[0], s0); s1 = fmaf(x57, l[1], s1); s2 = fmaf(x58, l[2], s2); s3 = fmaf(x59, l[3], s3); } { const f32x4 l = *(const LAS f32x4*)(Lc + 1148); s0 = fmaf(x60, l[0], s0); s1 = fmaf(x61, l[1], s1); s2 = fmaf(x62, l[2], s2); s3 = fmaf(x63, l[3], s3); } x16 = (lane == 16) ? 1.0f : -((s0 + s1) + (s2 + s3)); asm volatile("" : "+v"(x16) : : "memory"); }
    { float s0 = 0.f, s1 = 0.f, s2 = 0.f, s3 = 0.f; { const f32x4 l = *(const LAS f32x4*)(Lc + 1036); s0 = fmaf(x16, l[0], s0); s1 = fmaf(x17, l[1], s1); s2 = fmaf(x18, l[2], s2); s3 = fmaf(x19, l[3], s3); } { const f32x4 l = *(const LAS f32x4*)(Lc + 1040); s0 = fmaf(x20, l[0], s0); s1 = fmaf(x21, l[1], s1); s2 = fmaf(x22, l[2], s2); s3 = fmaf(x23, l[3], s3); } { const f32x4 l = *(const LAS f32x4*)(Lc + 1044); s0 = fmaf(x24, l[0], s0); s1 = fmaf(x25, l[1], s1); s2 = fmaf(x26, l[2], s2); s3 = fmaf(x27, l[3], s3); } { const f32x4 l = *(const LAS f32x4*)(Lc + 1048); s0 = fmaf(x28, l[0], s0); s1 = fmaf(x29, l[1], s1); s2 = fmaf(x30, l[2], s2); s3 = fmaf(x31, l[3], s3); } { const f32x4 l = *(const LAS f32x4*)(Lc + 1052); s0 = fmaf(x32, l[0], s0); s1 = fmaf(x33, l[1], s1); s2 = fmaf(x34, l[2], s2); s3 = fmaf(x35, l[3], s3); } { const f32x4 l = *(const LAS f32x4*)(Lc + 1056); s0 = fmaf(x36, l[0], s0); s1 = fmaf(x37, l[1], s1); s2 = fmaf(x38, l[2], s2); s3 = fmaf(x39, l[3], s3); } { const f32x4 l = *(const LAS f32x4*)(Lc + 1060); s0 = fmaf(x40, l[0], s0); s1 = fmaf(x41, l[1], s1); s2 = fmaf(x42, l[2], s2); s3 = fmaf(x43, l[3], s3); } { const f32x4 l = *(const LAS f32x4*)(Lc + 1064); s0 = fmaf(x44, l[0], s0); s1 = fmaf(x45, l[1], s1); s2 = fmaf(x46, l[2], s2); s3 = fmaf(x47, l[3], s3); } { const f32x4 l = *(const LAS f32x4*)(Lc + 1068); s0 = fmaf(x48, l[0], s0); s1 = fmaf(x49, l[1], s1); s2 = fmaf(x50, l[2], s2); s3 = fmaf(x51, l[3], s3); } { const f32x4 l = *(const LAS f32x4*)(Lc + 1072); s0 = fmaf(x52, l[0], s0); s1 = fmaf(x53, l[1], s1); s2 = fmaf(x54, l[2], s2); s3 = fmaf(x55, l[3], s3); } { const f32x4 l = *(const LAS f32x4*)(Lc + 1076); s0 = fmaf(x56, l[0], s0); s1 = fmaf(x57, l[1], s1); s2 = fmaf(x58, l[2], s2); s3 = fmaf(x59, l[3], s3); } { const f32x4 l = *(const LAS f32x4*)(Lc + 1080); s0 = fmaf(x60, l[0], s0); s1 = fmaf(x61, l[1], s1); s2 = fmaf(x62, l[2], s2); s3 = fmaf(x63, l[3], s3); } x15 = (lane == 15) ? 1.0f : -((s0 + s1) + (s2 + s3)); asm volatile("" : "+v"(x15) : : "memory"); }
    { float s0 = 0.f, s1 = 0.f, s2 = 0.f, s3 = 0.f; { const f32x4 l = *(const LAS f32x4*)(Lc + 964); s3 = fmaf(x15, l[3], s3); } { const f32x4 l = *(const LAS f32x4*)(Lc + 968); s0 = fmaf(x16, l[0], s0); s1 = fmaf(x17, l[1], s1); s2 = fmaf(x18, l[2], s2); s3 = fmaf(x19, l[3], s3); } { const f32x4 l = *(const LAS f32x4*)(Lc + 972); s0 = fmaf(x20, l[0], s0); s1 = fmaf(x21, l[1], s1); s2 = fmaf(x22, l[2], s2); s3 = fmaf(x23, l[3], s3); } { const f32x4 l = *(const LAS f32x4*)(Lc + 976); s0 = fmaf(x24, l[0], s0); s1 = fmaf(x25, l[1], s1); s2 = fmaf(x26, l[2], s2); s3 = fmaf(x27, l[3], s3); } { const f32x4 l = *(const LAS f32x4*)(Lc + 980); s0 = fmaf(x28, l[0], s0); s1 = fmaf(x29, l[1], s1); s2 = fmaf(x30, l[2], s2); s3 = fmaf(x31, l[3], s3); } { const f32x4 l = *(const LAS f32x4*)(Lc + 984); s0 = fmaf(x32, l[0], s0); s1 = fmaf(x33, l[1], s1); s2 = fmaf(x34, l[2], s2); s3 = fmaf(x35, l[3], s3); } { const f32x4 l = *(const LAS f32x4*)(Lc + 988); s0 = fmaf(x36, l[0], s0); s1 = fmaf(x37, l[1], s1); s2 = fmaf(x38, l[2], s2); s3 = fmaf(x39, l[3], s3); } { const f32x4 l = *(const LAS f32x4*)(Lc + 992); s0 = fmaf(x40, l[0], s0); s1 = fmaf(x41, l[1], s1); s2 = fmaf(x42, l[2], s2); s3 = fmaf(x43, l[3], s3); } { const f32x4 l = *(const LAS f32x4*)(Lc + 996); s0 = fmaf(x44, l[0], s0); s1 = fmaf(x45, l[1], s1); s2 = fmaf(x46, l[2], s2); s3 = fmaf(x47, l[3], s3); } { const f32x4 l = *(const LAS f32x4*)(Lc + 1000); s0 = fmaf(x48, l[0], s0); s1 = fmaf(x49, l[1], s1); s2 = fmaf(x50, l[2], s2); s3 = fmaf(x51, l[3], s3); } { const f32x4 l = *(const LAS f32x4*)(Lc + 1004); s0 = fmaf(x52, l[0], s0); s1 = fmaf(x53, l[1], s1); s2 = fmaf(x54, l[2], s2); s3 = fmaf(x55, l[3], s3); } { const f32x4 l = *(const LAS f32x4*)(Lc + 1008); s0 = fmaf(x56, l[0], s0); s1 = fmaf(x57, l[1], s1); s2 = fmaf(x58, l[2], s2); s3 = fmaf(x59, l[3], s3); } { const f32x4 l = *(const LAS f32x4*)(Lc + 1012); s0 = fmaf(x60, l[0], s0); s1 = fmaf(x61, l[1], s1); s2 = fmaf(x62, l[2], s2); s3 = fmaf(x63, l[3], s3); } x14 = (lane == 14) ? 1.0f : -((s0 + s1) + (s2 + s3)); asm volatile("" : "+v"(x14) : : "memory"); }
    { float s0 = 0.f, s1 = 0.f, s2 = 0.f, s3 = 0.f; { const f32x4 l = *(const LAS f32x4*)(Lc + 896); s2 = fmaf(x14, l[2], s2); s3 = fmaf(x15, l[3], s3); } { const f32x4 l = *(const LAS f32x4*)(Lc + 900); s0 = fmaf(x16, l[0], s0); s1 = fmaf(x17, l[1], s1); s2 = fmaf(x18, l[2], s2); s3 = fmaf(x19, l[3], s3); } { const f32x4 l = *(const LAS f32x4*)(Lc + 904); s0 = fmaf(x20, l[0], s0); s1 = fmaf(x21, l[1], s1); s2 = fmaf(x22, l[2], s2); s3 = fmaf(x23, l[3], s3); } { const f32x4 l = *(const LAS f32x4*)(Lc + 908); s0 = fmaf(x24, l[0], s0); s1 = fmaf(x25, l[1], s1); s2 = fmaf(x26, l[2], s2); s3 = fmaf(x27, l[3], s3); } { const f32x4 l = *(const LAS f32x4*)(Lc + 912); s0 = fmaf(x28, l[0], s0); s1 = fmaf(x29, l[1], s1); s2 = fmaf(x30, l[2], s2); s3 = fmaf(x31, l[3], s3); } { const f32x4 l = *(const LAS f32x4*)(Lc + 916); s0 = fmaf(x32, l[0], s0); s1 = fmaf(x33, l[1], s1); s2 = fmaf(x34, l[2], s2); s3 = fmaf(x35, l[3], s3); } { const f32x4 l = *(const LAS f32x4*)(Lc + 920); s0 = fmaf(x36, l[0], s0); s1 = fmaf(x37, l[1], s1); s2 = fmaf(x38, l[2], s2); s3 = fmaf(x39, l[3], s3); } { const f32x4 l = *(const LAS f32x4*)(Lc + 924); s0 = fmaf(x40, l[0], s0); s1 = fmaf(x41, l[1], s1); s2 = fmaf(x42, l[2], s2); s3 = fmaf(x43, l[3], s3); } { const f32x4 l = *(const LAS f32x4*)(Lc + 928); s0 = fmaf(x44, l[0], s0); s1 = fmaf(x45, l[1], s1); s2 = fmaf(x46, l[2], s2); s3 = fmaf(x47, l[3], s3); } { const f32x4 l = *(const LAS f32x4*)(Lc + 932); s0 = fmaf(x48, l[0], s0); s1 = fmaf(x49, l[1], s1); s2 = fmaf(x50, l[2], s2); s3 = fmaf(x51, l[3], s3); } { const f32x4 l = *(const LAS f32x4*)(Lc + 936); s0 = fmaf(x52, l[0], s0); s1 = fmaf(x53, l[1], s1); s2 = fmaf(x54, l[2], s2); s3 = fmaf(x55, l[3], s3); } { const f32x4 l = *(const LAS f32x4*)(Lc + 940); s0 = fmaf(x56, l[0], s0); s1 = fmaf(x57, l[1], s1); s2 = fmaf(x58, l[2], s2); s3 = fmaf(x59, l[3], s3); } { const f32x4 l = *(const LAS f32x4*)(Lc + 944); s0 = fmaf(x60, l[0], s0); s1 = fmaf(x61, l[1], s1); s2 = fmaf(x62, l[2], s2); s3 = fmaf(x63, l[3], s3); } x13 = (lane == 13) ? 1.0f : -((s0 + s1) + (s2 + s3)); asm volatile("" : "+v"(x13) : : "memory"); }
    { float s0 = 0.f, s1 = 0.f, s2 = 0.f, s3 = 0.f; { const f32x4 l = *(const LAS f32x4*)(Lc + 828); s1 = fmaf(x13, l[1], s1); s2 = fmaf(x14, l[2], s2); s3 = fmaf(x15, l[3], s3); } { const f32x4 l = *(const LAS f32x4*)(Lc + 832); s0 = fmaf(x16, l[0], s0); s1 = fmaf(x17, l[1], s1); s2 = fmaf(x18, l[2], s2); s3 = fmaf(x19, l[3], s3); } { const f32x4 l = *(const LAS f32x4*)(Lc + 836); s0 = fmaf(x20, l[0], s0); s1 = fmaf(x21, l[1], s1); s2 = fmaf(x22, l[2], s2); s3 = fmaf(x23, l[3], s3); } { const f32x4 l = *(const LAS f32x4*)(Lc + 840); s0 = fmaf(x24, l[0], s0); s1 = fmaf(x25, l[1], s1); s2 = fmaf(x26, l[2], s2); s3 = fmaf(x27, l[3], s3); } { const f32x4 l = *(const LAS f32x4*)(Lc + 844); s0 = fmaf(x28, l[0], s0); s1 = fmaf(x29, l[1], s1); s2 = fmaf(x30, l[2], s2); s3 = fmaf(x31, l[3], s3); } { const f32x4 l = *(const LAS f32x4*)(Lc + 848); s0 = fmaf(x32, l[0], s0); s1 = fmaf(x33, l[1], s1); s2 = fmaf(x34, l[2], s2); s3 = fmaf(x35, l[3], s3); } { const f32x4 l = *(const LAS f32x4*)(Lc + 852); s0 = fmaf(x36, l[0], s0); s1 = fmaf(x37, l[1], s1); s2 = fmaf(x38, l[2], s2); s3 = fmaf(x39, l[3], s3); } { const f32x4 l = *(const LAS f32x4*)(Lc + 856); s0 = fmaf(x40, l[0], s0); s1 = fmaf(x41, l[1], s1); s2 = fmaf(x42, l[2], s2); s3 = fmaf(x43, l[3], s3); } { const f32x4 l = *(const LAS f32x4*)(Lc + 860); s0 = fmaf(x44, l[0], s0); s1 = fmaf(x45, l[1], s1); s2 = fmaf(x46, l[2], s2); s3 = fmaf(x47, l[3], s3); } { const f32x4 l = *(const LAS f32x4*)(Lc + 864); s0 = fmaf(x48, l[0], s0); s1 = fmaf(x49, l[1], s1); s2 = fmaf(x50, l[2], s2); s3 = fmaf(x51, l[3], s3); } { const f32x4 l = *(const LAS f32x4*)(Lc + 868); s0 = fmaf(x52, l[0], s0); s1 = fmaf(x53, l[1], s1); s2 = fmaf(x54, l[2], s2); s3 = fmaf(x55, l[3], s3); } { const f32x4 l = *(const LAS f32x4*)(Lc + 872); s0 = fmaf(x56, l[0], s0); s1 = fmaf(x57, l[1], s1); s2 = fmaf(x58, l[2], s2); s3 = fmaf(x59, l[3], s3); } { const f32x4 l = *(const LAS f32x4*)(Lc + 876); s0 = fmaf(x60, l[0], s0); s1 = fmaf(x61, l[1], s1); s2 = fmaf(x62, l[2], s2); s3 = fmaf(x63, l[3], s3); } x12 = (lane == 12) ? 1.0f : -((s0 + s1) + (s2 + s3)); asm volatile("" : "+v"(x12) : : "memory"); }
    { float s0 = 0.f, s1 = 0.f, s2 = 0.f, s3 = 0.f; { const f32x4 l = *(const LAS f32x4*)(Lc + 760); s0 = fmaf(x12, l[0], s0); s1 = fmaf(x13, l[1], s1); s2 = fmaf(x14, l[2], s2); s3 = fmaf(x15, l[3], s3); } { const f32x4 l = *(const LAS f32x4*)(Lc + 764); s0 = fmaf(x16, l[0], s0); s1 = fmaf(x17, l[1], s1); s2 = fmaf(x18, l[2], s2); s3 = fmaf(x19, l[3], s3); } { const f32x4 l = *(const LAS f32x4*)(Lc + 768); s0 = fmaf(x20, l[0], s0); s1 = fmaf(x21, l[1], s1); s2 = fmaf(x22, l[2], s2); s3 = fmaf(x23, l[3], s3); } { const f32x4 l = *(const LAS f32x4*)(Lc + 772); s0 = fmaf(x24, l[0], s0); s1 = fmaf(x25, l[1], s1); s2 = fmaf(x26, l[2], s2); s3 = fmaf(x27, l[3], s3); } { const f32x4 l = *(const LAS f32x4*)(Lc + 776); s0 = fmaf(x28, l[0], s0); s1 = fmaf(x29, l[1], s1); s2 = fmaf(x30, l[2], s2); s3 = fmaf(x31, l[3], s3); } { const f32x4 l = *(const LAS f32x4*)(Lc + 780); s0 = fmaf(x32, l[0], s0); s1 = fmaf(x33, l[1], s1); s2 = fmaf(x34, l[2], s2); s3 = fmaf(x35, l[3], s3); } { const f32x4 l = *(const LAS f32x4*)(Lc + 784); s0 = fmaf(x36, l[0], s0); s1 = fmaf(x37, l[1], s1); s2 = fmaf(x38, l[2], s2); s3 = fmaf(x39, l[3], s3); } { const f32x4 l = *(const LAS f32x4*)(Lc + 788); s0 = fmaf(x40, l[0], s0); s1 = fmaf(x41, l[1], s1); s2 = fmaf(x42, l[2], s2); s3 = fmaf(x43, l[3], s3); } { const f32x4 l = *(const LAS f32x4*)(Lc + 792); s0 = fmaf(x44, l[0], s0); s1 = fmaf(x45, l[1], s1); s2 = fmaf(x46, l[2], s2); s3 = fmaf(x47, l[3], s3); } { const f32x4 l = *(const LAS f32x4*)(Lc + 796); s0 = fmaf(x48, l[0], s0); s1 = fmaf(x49, l[1], s1); s2 = fmaf(x50, l[2], s2); s3 = fmaf(x51, l[3], s3); } { const f32x4 l = *(const LAS f32x4*)(Lc + 800); s0 = fmaf(x52, l[0], s0); s1 = fmaf(x53, l[1], s1); s2 = fmaf(x54, l[2], s2); s3 = fmaf(x55, l[3], s3); } { const f32x4 l = *(const LAS f32x4*)(Lc + 804); s0 = fmaf(x56, l[0], s0); s1 = fmaf(x57, l[1], s1); s2 = fmaf(x58, l[2], s2); s3 = fmaf(x59, l[3], s3); } { const f32x4 l = *(const LAS f32x4*)(Lc + 808); s0 = fmaf(x60, l[0], s0); s1 = fmaf(x61, l[1], s1); s2 = fmaf(x62, l[2], s2); s3 = fmaf(x63, l[3], s3); } x11 = (lane == 11) ? 1.0f : -((s0 + s1) + (s2 + s3)); asm volatile("" : "+v"(x11) : : "memory"); }
    { float s0 = 0.f, s1 = 0.f, s2 = 0.f, s3 = 0.f; { const f32x4 l = *(const LAS f32x4*)(Lc + 688); s3 = fmaf(x11, l[3], s3); } { const f32x4 l = *(const LAS f32x4*)(Lc + 692); s0 = fmaf(x12, l[0], s0); s1 = fmaf(x13, l[1], s1); s2 = fmaf(x14, l[2], s2); s3 = fmaf(x15, l[3], s3); } { const f32x4 l = *(const LAS f32x4*)(Lc + 696); s0 = fmaf(x16, l[0], s0); s1 = fmaf(x17, l[1], s1); s2 = fmaf(x18, l[2], s2); s3 = fmaf(x19, l[3], s3); } { const f32x4 l = *(const LAS f32x4*)(Lc + 700); s0 = fmaf(x20, l[0], s0); s1 = fmaf(x21, l[1], s1); s2 = fmaf(x22, l[2], s2); s3 = fmaf(x23, l[3], s3); } { const f32x4 l = *(const LAS f32x4*)(Lc + 704); s0 = fmaf(x24, l[0], s0); s1 = fmaf(x25, l[1], s1); s2 = fmaf(x26, l[2], s2); s3 = fmaf(x27, l[3], s3); } { const f32x4 l = *(const LAS f32x4*)(Lc + 708); s0 = fmaf(x28, l[0], s0); s1 = fmaf(x29, l[1], s1); s2 = fmaf(x30, l[2], s2); s3 = fmaf(x31, l[3], s3); } { const f32x4 l = *(const LAS f32x4*)(Lc + 712); s0 = fmaf(x32, l[0], s0); s1 = fmaf(x33, l[1], s1); s2 = fmaf(x34, l[2], s2); s3 = fmaf(x35, l[3], s3); } { const f32x4 l = *(const LAS f32x4*)(Lc + 716); s0 = fmaf(x36, l[0], s0); s1 = fmaf(x37, l[1], s1); s2 = fmaf(x38, l[2], s2); s3 = fmaf(x39, l[3], s3); } { const f32x4 l = *(const LAS f32x4*)(Lc + 720); s0 = fmaf(x40, l[0], s0); s1 = fmaf(x41, l[1], s1); s2 = fmaf(x42, l[2], s2); s3 = fmaf(x43, l[3], s3); } { const f32x4 l = *(const LAS f32x4*)(Lc + 724); s0 = fmaf(x44, l[0], s0); s1 = fmaf(x45, l[1], s1); s2 = fmaf(x46, l[2], s2); s3 = fmaf(x47, l[3], s3); } { const f32x4 l = *(const LAS f32x4*)(Lc + 728); s0 = fmaf(x48, l[0], s0); s1 = fmaf(x49, l[1], s1); s2 = fmaf(x50, l[2], s2); s3 = fmaf(x51, l[3], s3); } { const f32x4 l = *(const LAS f32x4*)(Lc + 732); s0 = fmaf(x52, l[0], s0); s1 = fmaf(x53, l[1], s1); s2 = fmaf(x54, l[2], s2); s3 = fmaf(x55, l[3], s3); } { const f32x4 l = *(const LAS f32x4*)(Lc + 736); s0 = fmaf(x56, l[0], s0); s1 = fmaf(x57, l[1], s1); s2 = fmaf(x58, l[2], s2); s3 = fmaf(x59, l[3], s3); } { const f32x4 l = *(const LAS f32x4*)(Lc + 740); s0 = fmaf(x60, l[0], s0); s1 = fmaf(x61, l[1], s1); s2 = fmaf(x62, l[2], s2); s3 = fmaf(x63, l[3], s3); } x10 = (lane == 10) ? 1.0f : -((s0 + s1) + (s2 + s3)); asm volatile("" : "+v"(x10) : : "memory"); }
    { float s0 = 0.f, s1 = 0.f, s2 = 0.f, s3 = 0.f; { const f32x4 l = *(const LAS f32x4*)(Lc + 620); s2 = fmaf(x10, l[2], s2); s3 = fmaf(x11, l[3], s3); } { const f32x4 l = *(const LAS f32x4*)(Lc + 624); s0 = fmaf(x12, l[0], s0); s1 = fmaf(x13, l[1], s1); s2 = fmaf(x14, l[2], s2); s3 = fmaf(x15, l[3], s3); } { const f32x4 l = *(const LAS f32x4*)(Lc + 628); s0 = fmaf(x16, l[0], s0); s1 = fmaf(x17, l[1], s1); s2 = fmaf(x18, l[2], s2); s3 = fmaf(x19, l[3], s3); } { const f32x4 l = *(const LAS f32x4*)(Lc + 632); s0 = fmaf(x20, l[0], s0); s1 = fmaf(x21, l[1], s1); s2 = fmaf(x22, l[2], s2); s3 = fmaf(x23, l[3], s3); } { const f32x4 l = *(const LAS f32x4*)(Lc + 636); s0 = fmaf(x24, l[0], s0); s1 = fmaf(x25, l[1], s1); s2 = fmaf(x26, l[2], s2); s3 = fmaf(x27, l[3], s3); } { const f32x4 l = *(const LAS f32x4*)(Lc + 640); s0 = fmaf(x28, l[0], s0); s1 = fmaf(x29, l[1], s1); s2 = fmaf(x30, l[2], s2); s3 = fmaf(x31, l[3], s3); } { const f32x4 l = *(const LAS f32x4*)(Lc + 644); s0 = fmaf(x32, l[0], s0); s1 = fmaf(x33, l[1], s1); s2 = fmaf(x34, l[2], s2); s3 = fmaf(x35, l[3], s3); } { const f32x4 l = *(const LAS f32x4*)(Lc + 648); s0 = fmaf(x36, l[0], s0); s1 = fmaf(x37, l[1], s1); s2 = fmaf(x38, l[2], s2); s3 = fmaf(x39, l[3], s3); } { const f32x4 l = *(const LAS f32x4*)(Lc + 652); s0 = fmaf(x40, l[0], s0); s1 = fmaf(x41, l[1], s1); s2 = fmaf(x42, l[2], s2); s3 = fmaf(x43, l[3], s3); } { const f32x4 l = *(const LAS f32x4*)(Lc + 656); s0 = fmaf(x44, l[0], s0); s1 = fmaf(x45, l[1], s1); s2 = fmaf(x46, l[2], s2); s3 = fmaf(x47, l[3], s3); } { const f32x4 l = *(const LAS f32x4*)(Lc + 660); s0 = fmaf(x48, l[0], s0); s1 = fmaf(x49, l[1], s1); s2 = fmaf(x50, l[2], s2); s3 = fmaf(x51, l[3], s3); } { const f32x4 l = *(const LAS f32x4*)(Lc + 664); s0 = fmaf(x52, l[0], s0); s1 = fmaf(x53, l[1], s1); s2 = fmaf(x54, l[2], s2); s3 = fmaf(x55, l[3], s3); } { const f32x4 l = *(const LAS f32x4*)(Lc + 668); s0 = fmaf(x56, l[0], s0); s1 = fmaf(x57, l[1], s1); s2 = fmaf(x58, l[2], s2); s3 = fmaf(x59, l[3], s3); } { const f32x4 l = *(const LAS f32x4*)(Lc + 672); s0 = fmaf(x60, l[0], s0); s1 = fmaf(x61, l[1], s1); s2 = fmaf(x62, l[2], s2); s3 = fmaf(x63, l[3], s3); } x9 = (lane == 9) ? 1.0f : -((s0 + s1) + (s2 + s3)); asm volatile("" : "+v"(x9) : : "memory"); }
    { float s0 = 0.f, s1 = 0.f, s2 = 0.f, s3 = 0.f; { const f32x4 l = *(const LAS f32x4*)(Lc + 552); s1 = fmaf(x9, l[1], s1); s2 = fmaf(x10, l[2], s2); s3 = fmaf(x11, l[3], s3); } { const f32x4 l = *(const LAS f32x4*)(Lc + 556); s0 = fmaf(x12, l[0], s0); s1 = fmaf(x13, l[1], s1); s2 = fmaf(x14, l[2], s2); s3 = fmaf(x15, l[3], s3); } { const f32x4 l = *(const LAS f32x4*)(Lc + 560); s0 = fmaf(x16, l[0], s0); s1 = fmaf(x17, l[1], s1); s2 = fmaf(x18, l[2], s2); s3 = fmaf(x19, l[3], s3); } { const f32x4 l = *(const LAS f32x4*)(Lc + 564); s0 = fmaf(x20, l[0], s0); s1 = fmaf(x21, l[1], s1); s2 = fmaf(x22, l[2], s2); s3 = fmaf(x23, l[3], s3); } { const f32x4 l = *(const LAS f32x4*)(Lc + 568); s0 = fmaf(x24, l[0], s0); s1 = fmaf(x25, l[1], s1); s2 = fmaf(x26, l[2], s2); s3 = fmaf(x27, l[3], s3); } { const f32x4 l = *(const LAS f32x4*)(Lc + 572); s0 = fmaf(x28, l[0], s0); s1 = fmaf(x29, l[1], s1); s2 = fmaf(x30, l[2], s2); s3 = fmaf(x31, l[3], s3); } { const f32x4 l = *(const LAS f32x4*)(Lc + 576); s0 = fmaf(x32, l[0], s0); s1 = fmaf(x33, l[1], s1); s2 = fmaf(x34, l[2], s2); s3 = fmaf(x35, l[3], s3); } { const f32x4 l = *(const LAS f32x4*)(Lc + 580); s0 = fmaf(x36, l[0], s0); s1 = fmaf(x37, l[1], s1); s2 = fmaf(x38, l[2], s2); s3 = fmaf(x39, l[3], s3); } { const f32x4 l = *(const LAS f32x4*)(Lc + 584); s0 = fmaf(x40, l[0], s0); s1 = fmaf(x41, l[1], s1); s2 = fmaf(x42, l[2], s2); s3 = fmaf(x43, l[3], s3); } { const f32x4 l = *(const LAS f32x4*)(Lc + 588); s0 = fmaf(x44, l[0], s0); s1 = fmaf(x45, l[1], s1); s2 = fmaf(x46, l[2], s2); s3 = fmaf(x47, l[3], s3); } { const f32x4 l = *(const LAS f32x4*)(Lc + 592); s0 = fmaf(x48, l[0], s0); s1 = fmaf(x49, l[1], s1); s2 = fmaf(x50, l[2], s2); s3 = fmaf(x51, l[3], s3); } { const f32x4 l = *(const LAS f32x4*)(Lc + 596); s0 = fmaf(x52, l[0], s0); s1 = fmaf(x53, l[1], s1); s2 = fmaf(x54, l[2], s2); s3 = fmaf(x55, l[3], s3); } { const f32x4 l = *(const LAS f32x4*)(Lc + 600); s0 = fmaf(x56, l[0], s0); s1 = fmaf(x57, l[1], s1); s2 = fmaf(x58, l[2], s2); s3 = fmaf(x59, l[3], s3); } { const f32x4 l = *(const LAS f32x4*)(Lc + 604); s0 = fmaf(x60, l[0], s0); s1 = fmaf(x61, l[1], s1); s2 = fmaf(x62, l[2], s2); s3 = fmaf(x63, l[3], s3); } x8 = (lane == 8) ? 1.0f : -((s0 + s1) + (s2 + s3)); asm volatile("" : "+v"(x8) : : "memory"); }
    { float s0 = 0.f, s1 = 0.f, s2 = 0.f, s3 = 0.f; { const f32x4 l = *(const LAS f32x4*)(Lc + 484); s0 = fmaf(x8, l[0], s0); s1 = fmaf(x9, l[1], s1); s2 = fmaf(x10, l[2], s2); s3 = fmaf(x11, l[3], s3); } { const f32x4 l = *(const LAS f32x4*)(Lc + 488); s0 = fmaf(x12, l[0], s0); s1 = fmaf(x13, l[1], s1); s2 = fmaf(x14, l[2], s2); s3 = fmaf(x15, l[3], s3); } { const f32x4 l = *(const LAS f32x4*)(Lc + 492); s0 = fmaf(x16, l[0], s0); s1 = fmaf(x17, l[1], s1); s2 = fmaf(x18, l[2], s2); s3 = fmaf(x19, l[3], s3); } { const f32x4 l = *(const LAS f32x4*)(Lc + 496); s0 = fmaf(x20, l[0], s0); s1 = fmaf(x21, l[1], s1); s2 = fmaf(x22, l[2], s2); s3 = fmaf(x23, l[3], s3); } { const f32x4 l = *(const LAS f32x4*)(Lc + 500); s0 = fmaf(x24, l[0], s0); s1 = fmaf(x25, l[1], s1); s2 = fmaf(x26, l[2], s2); s3 = fmaf(x27, l[3], s3); } { const f32x4 l = *(const LAS f32x4*)(Lc + 504); s0 = fmaf(x28, l[0], s0); s1 = fmaf(x29, l[1], s1); s2 = fmaf(x30, l[2], s2); s3 = fmaf(x31, l[3], s3); } { const f32x4 l = *(const LAS f32x4*)(Lc + 508); s0 = fmaf(x32, l[0], s0); s1 = fmaf(x33, l[1], s1); s2 = fmaf(x34, l[2], s2); s3 = fmaf(x35, l[3], s3); } { const f32x4 l = *(const LAS f32x4*)(Lc + 512); s0 = fmaf(x36, l[0], s0); s1 = fmaf(x37, l[1], s1); s2 = fmaf(x38, l[2], s2); s3 = fmaf(x39, l[3], s3); } { const f32x4 l = *(const LAS f32x4*)(Lc + 516); s0 = fmaf(x40, l[0], s0); s1 = fmaf(x41, l[1], s1); s2 = fmaf(x42, l[2], s2); s3 = fmaf(x43, l[3], s3); } { const f32x4 l = *(const LAS f32x4*)(Lc + 520); s0 = fmaf(x44, l[0], s0); s1 = fmaf(x45, l[1], s1); s2 = fmaf(x46, l[2], s2); s3 = fmaf(x47, l[3], s3); } { const f32x4 l = *(const LAS f32x4*)(Lc + 524); s0 = fmaf(x48, l[0], s0); s1 = fmaf(x49, l[1], s1); s2 = fmaf(x50, l[2], s2); s3 = fmaf(x51, l[3], s3); } { const f32x4 l = *(const LAS f32x4*)(Lc + 528); s0 = fmaf(x52, l[0], s0); s1 = fmaf(x53, l[1], s1); s2 = fmaf(x54, l[2], s2); s3 = fmaf(x55, l[3], s3); } { const f32x4 l = *(const LAS f32x4*)(Lc + 532); s0 = fmaf(x56, l[0], s0); s1 = fmaf(x57, l[1], s1); s2 = fmaf(x58, l[2], s2); s3 = fmaf(x59, l[3], s3); } { const f32x4 l = *(const LAS f32x4*)(Lc + 536); s0 = fmaf(x60, l[0], s0); s1 = fmaf(x61, l[1], s1); s2 = fmaf(x62, l[2], s2); s3 = fmaf(x63, l[3], s3); } x7 = (lane == 7) ? 1.0f : -((s0 + s1) + (s2 + s3)); asm volatile("" : "+v"(x7) : : "memory"); }
    { float s0 = 0.f, s1 = 0.f, s2 = 0.f, s3 = 0.f; { const f32x4 l = *(const LAS f32x4*)(Lc + 412); s3 = fmaf(x7, l[3], s3); } { const f32x4 l = *(const LAS f32x4*)(Lc + 416); s0 = fmaf(x8, l[0], s0); s1 = fmaf(x9, l[1], s1); s2 = fmaf(x10, l[2], s2); s3 = fmaf(x11, l[3], s3); } { const f32x4 l = *(const LAS f32x4*)(Lc + 420); s0 = fmaf(x12, l[0], s0); s1 = fmaf(x13, l[1], s1); s2 = fmaf(x14, l[2], s2); s3 = fmaf(x15, l[3], s3); } { const f32x4 l = *(const LAS f32x4*)(Lc + 424); s0 = fmaf(x16, l[0], s0); s1 = fmaf(x17, l[1], s1); s2 = fmaf(x18, l[2], s2); s3 = fmaf(x19, l[3], s3); } { const f32x4 l = *(const LAS f32x4*)(Lc + 428); s0 = fmaf(x20, l[0], s0); s1 = fmaf(x21, l[1], s1); s2 = fmaf(x22, l[2], s2); s3 = fmaf(x23, l[3], s3); } { const f32x4 l = *(const LAS f32x4*)(Lc + 432); s0 = fmaf(x24, l[0], s0); s1 = fmaf(x25, l[1], s1); s2 = fmaf(x26, l[2], s2); s3 = fmaf(x27, l[3], s3); } { const f32x4 l = *(const LAS f32x4*)(Lc + 436); s0 = fmaf(x28, l[0], s0); s1 = fmaf(x29, l[1], s1); s2 = fmaf(x30, l[2], s2); s3 = fmaf(x31, l[3], s3); } { const f32x4 l = *(const LAS f32x4*)(Lc + 440); s0 = fmaf(x32, l[0], s0); s1 = fmaf(x33, l[1], s1); s2 = fmaf(x34, l[2], s2); s3 = fmaf(x35, l[3], s3); } { const f32x4 l = *(const LAS f32x4*)(Lc + 444); s0 = fmaf(x36, l[0], s0); s1 = fmaf(x37, l[1], s1); s2 = fmaf(x38, l[2], s2); s3 = fmaf(x39, l[3], s3); } { const f32x4 l = *(const LAS f32x4*)(Lc + 448); s0 = fmaf(x40, l[0], s0); s1 = fmaf(x41, l[1], s1); s2 = fmaf(x42, l[2], s2); s3 = fmaf(x43, l[3], s3); } { const f32x4 l = *(const LAS f32x4*)(Lc + 452); s0 = fmaf(x44, l[0], s0); s1 = fmaf(x45, l[1], s1); s2 = fmaf(x46, l[2], s2); s3 = fmaf(x47, l[3], s3); } { const f32x4 l = *(const LAS f32x4*)(Lc + 456); s0 = fmaf(x48, l[0], s0); s1 = fmaf(x49, l[1], s1); s2 = fmaf(x50, l[2], s2); s3 = fmaf(x51, l[3], s3); } { const f32x4 l = *(const LAS f32x4*)(Lc + 460); s0 = fmaf(x52, l[0], s0); s1 = fmaf(x53, l[1], s1); s2 = fmaf(x54, l[2], s2); s3 = fmaf(x55, l[3], s3); } { const f32x4 l = *(const LAS f32x4*)(Lc + 464); s0 = fmaf(x56, l[0], s0); s1 = fmaf(x57, l[1], s1); s2 = fmaf(x58, l[2], s2); s3 = fmaf(x59, l[3], s3); } { const f32x4 l = *(const LAS f32x4*)(Lc + 468); s0 = fmaf(x60, l[0], s0); s1 = fmaf(x61, l[1], s1); s2 = fmaf(x62, l[2], s2); s3 = fmaf(x63, l[3], s3); } x6 = (lane == 6) ? 1.0f : -((s0 + s1) + (s2 + s3)); asm volatile("" : "+v"(x6) : : "memory"); }
    { float s0 = 0.f, s1 = 0.f, s2 = 0.f, s3 = 0.f; { const f32x4 l = *(const LAS f32x4*)(Lc + 344); s2 = fmaf(x6, l[2], s2); s3 = fmaf(x7, l[3], s3); } { const f32x4 l = *(const LAS f32x4*)(Lc + 348); s0 = fmaf(x8, l[0], s0); s1 = fmaf(x9, l[1], s1); s2 = fmaf(x10, l[2], s2); s3 = fmaf(x11, l[3], s3); } { const f32x4 l = *(const LAS f32x4*)(Lc + 352); s0 = fmaf(x12, l[0], s0); s1 = fmaf(x13, l[1], s1); s2 = fmaf(x14, l[2], s2); s3 = fmaf(x15, l[3], s3); } { const f32x4 l = *(const LAS f32x4*)(Lc + 356); s0 = fmaf(x16, l[0], s0); s1 = fmaf(x17, l[1], s1); s2 = fmaf(x18, l[2], s2); s3 = fmaf(x19, l[3], s3); } { const f32x4 l = *(const LAS f32x4*)(Lc + 360); s0 = fmaf(x20, l[0], s0); s1 = fmaf(x21, l[1], s1); s2 = fmaf(x22, l[2], s2); s3 = fmaf(x23, l[3], s3); } { const f32x4 l = *(const LAS f32x4*)(Lc + 364); s0 = fmaf(x24, l[0], s0); s1 = fmaf(x25, l[1], s1); s2 = fmaf(x26, l[2], s2); s3 = fmaf(x27, l[3], s3); } { const f32x4 l = *(const LAS f32x4*)(Lc + 368); s0 = fmaf(x28, l[0], s0); s1 = fmaf(x29, l[1], s1); s2 = fmaf(x30, l[2], s2); s3 = fmaf(x31, l[3], s3); } { const f32x4 l = *(const LAS f32x4*)(Lc + 372); s0 = fmaf(x32, l[0], s0); s1 = fmaf(x33, l[1], s1); s2 = fmaf(x34, l[2], s2); s3 = fmaf(x35, l[3], s3); } { const f32x4 l = *(const LAS f32x4*)(Lc + 376); s0 = fmaf(x36, l[0], s0); s1 = fmaf(x37, l[1], s1); s2 = fmaf(x38, l[2], s2); s3 = fmaf(x39, l[3], s3); } { const f32x4 l = *(const LAS f32x4*)(Lc + 380); s0 = fmaf(x40, l[0], s0); s1 = fmaf(x41, l[1], s1); s2 = fmaf(x42, l[2], s2); s3 = fmaf(x43, l[3], s3); } { const f32x4 l = *(const LAS f32x4*)(Lc + 384); s0 = fmaf(x44, l[0], s0); s1 = fmaf(x45, l[1], s1); s2 = fmaf(x46, l[2], s2); s3 = fmaf(x47, l[3], s3); } { const f32x4 l = *(const LAS f32x4*)(Lc + 388); s0 = fmaf(x48, l[0], s0); s1 = fmaf(x49, l[1], s1); s2 = fmaf(x50, l[2], s2); s3 = fmaf(x51, l[3], s3); } { const f32x4 l = *(const LAS f32x4*)(Lc + 392); s0 = fmaf(x52, l[0], s0); s1 = fmaf(x53, l[1], s1); s2 = fmaf(x54, l[2], s2); s3 = fmaf(x55, l[3], s3); } { const f32x4 l = *(const LAS f32x4*)(Lc + 396); s0 = fmaf(x56, l[0], s0); s1 = fmaf(x57, l[1], s1); s2 = fmaf(x58, l[2], s2); s3 = fmaf(x59, l[3], s3); } { const f32x4 l = *(const LAS f32x4*)(Lc + 400); s0 = fmaf(x60, l[0], s0); s1 = fmaf(x61, l[1], s1); s2 = fmaf(x62, l[2], s2); s3 = fmaf(x63, l[3], s3); } x5 = (lane == 5) ? 1.0f : -((s0 + s1) + (s2 + s3)); asm volatile("" : "+v"(x5) : : "memory"); }
    { float s0 = 0.f, s1 = 0.f, s2 = 0.f, s3 = 0.f; { const f32x4 l = *(const LAS f32x4*)(Lc + 276); s1 = fmaf(x5, l[1], s1); s2 = fmaf(x6, l[2], s2); s3 = fmaf(x7, l[3], s3); } { const f32x4 l = *(const LAS f32x4*)(Lc + 280); s0 = fmaf(x8, l[0], s0); s1 = fmaf(x9, l[1], s1); s2 = fmaf(x10, l[2], s2); s3 = fmaf(x11, l[3], s3); } { const f32x4 l = *(const LAS f32x4*)(Lc + 284); s0 = fmaf(x12, l[0], s0); s1 = fmaf(x13, l[1], s1); s2 = fmaf(x14, l[2], s2); s3 = fmaf(x15, l[3], s3); } { const f32x4 l = *(const LAS f32x4*)(Lc + 288); s0 = fmaf(x16, l[0], s0); s1 = fmaf(x17, l[1], s1); s2 = fmaf(x18, l[2], s2); s3 = fmaf(x19, l[3], s3); } { const f32x4 l = *(const LAS f32x4*)(Lc + 292); s0 = fmaf(x20, l[0], s0); s1 = fmaf(x21, l[1], s1); s2 = fmaf(x22, l[2], s2); s3 = fmaf(x23, l[3], s3); } { const f32x4 l = *(const LAS f32x4*)(Lc + 296); s0 = fmaf(x24, l[0], s0); s1 = fmaf(x25, l[1], s1); s2 = fmaf(x26, l[2], s2); s3 = fmaf(x27, l[3], s3); } { const f32x4 l = *(const LAS f32x4*)(Lc + 300); s0 = fmaf(x28, l[0], s0); s1 = fmaf(x29, l[1], s1); s2 = fmaf(x30, l[2], s2); s3 = fmaf(x31, l[3], s3); } { const f32x4 l = *(const LAS f32x4*)(Lc + 304); s0 = fmaf(x32, l[0], s0); s1 = fmaf(x33, l[1], s1); s2 = fmaf(x34, l[2], s2); s3 = fmaf(x35, l[3], s3); } { const f32x4 l = *(const LAS f32x4*)(Lc + 308); s0 = fmaf(x36, l[0], s0); s1 = fmaf(x37, l[1], s1); s2 = fmaf(x38, l[2], s2); s3 = fmaf(x39, l[3], s3); } { const f32x4 l = *(const LAS f32x4*)(Lc + 312); s0 = fmaf(x40, l[0], s0); s1 = fmaf(x41, l[1], s1); s2 = fmaf(x42, l[2], s2); s3 = fmaf(x43, l[3], s3); } { const f32x4 l = *(const LAS f32x4*)(Lc + 316); s0 = fmaf(x44, l[0], s0); s1 = fmaf(x45, l[1], s1); s2 = fmaf(x46, l[2], s2); s3 = fmaf(x47, l[3], s3); } { const f32x4 l = *(const LAS f32x4*)(Lc + 320); s0 = fmaf(x48, l[0], s0); s1 = fmaf(x49, l[1], s1); s2 = fmaf(x50, l[2], s2); s3 = fmaf(x51, l[3], s3); } { const f32x4 l = *(const LAS f32x4*)(Lc + 324); s0 = fmaf(x52, l[0], s0); s1 = fmaf(x53, l[1], s1); s2 = fmaf(x54, l[2], s2); s3 = fmaf(x55, l[3], s3); } { const f32x4 l = *(const LAS f32x4*)(Lc + 328); s0 = fmaf(x56, l[0], s0); s1 = fmaf(x57, l[1], s1); s2 = fmaf(x58, l[2], s2); s3 = fmaf(x59, l[3], s3); } { const f32x4 l = *(const LAS f32x4*)(Lc + 332); s0 = fmaf(x60, l[0], s0); s1 = fmaf(x61, l[1], s1); s2 = fmaf(x62, l[2], s2); s3 = fmaf(x63, l[3], s3); } x4 = (lane == 4) ? 1.0f : -((s0 + s1) + (s2 + s3)); asm volatile("" : "+v"(x4) : : "memory"); }
    { float s0 = 0.f, s1 = 0.f, s2 = 0.f, s3 = 0.f; { const f32x4 l = *(const LAS f32x4*)(Lc + 208); s0 = fmaf(x4, l[0], s0); s1 = fmaf(x5, l[1], s1); s2 = fmaf(x6, l[2], s2); s3 = fmaf(x7, l[3], s3); } { const f32x4 l = *(const LAS f32x4*)(Lc + 212); s0 = fmaf(x8, l[0], s0); s1 = fmaf(x9, l[1], s1); s2 = fmaf(x10, l[2], s2); s3 = fmaf(x11, l[3], s3); } { const f32x4 l = *(const LAS f32x4*)(Lc + 216); s0 = fmaf(x12, l[0], s0); s1 = fmaf(x13, l[1], s1); s2 = fmaf(x14, l[2], s2); s3 = fmaf(x15, l[3], s3); } { const f32x4 l = *(const LAS f32x4*)(Lc + 220); s0 = fmaf(x16, l[0], s0); s1 = fmaf(x17, l[1], s1); s2 = fmaf(x18, l[2], s2); s3 = fmaf(x19, l[3], s3); } { const f32x4 l = *(const LAS f32x4*)(Lc + 224); s0 = fmaf(x20, l[0], s0); s1 = fmaf(x21, l[1], s1); s2 = fmaf(x22, l[2], s2); s3 = fmaf(x23, l[3], s3); } { const f32x4 l = *(const LAS f32x4*)(Lc + 228); s0 = fmaf(x24, l[0], s0); s1 = fmaf(x25, l[1], s1); s2 = fmaf(x26, l[2], s2); s3 = fmaf(x27, l[3], s3); } { const f32x4 l = *(const LAS f32x4*)(Lc + 232); s0 = fmaf(x28, l[0], s0); s1 = fmaf(x29, l[1], s1); s2 = fmaf(x30, l[2], s2); s3 = fmaf(x31, l[3], s3); } { const f32x4 l = *(const LAS f32x4*)(Lc + 236); s0 = fmaf(x32, l[0], s0); s1 = fmaf(x33, l[1], s1); s2 = fmaf(x34, l[2], s2); s3 = fmaf(x35, l[3], s3); } { const f32x4 l = *(const LAS f32x4*)(Lc + 240); s0 = fmaf(x36, l[0], s0); s1 = fmaf(x37, l[1], s1); s2 = fmaf(x38, l[2], s2); s3 = fmaf(x39, l[3], s3); } { const f32x4 l = *(const LAS f32x4*)(Lc + 244); s0 = fmaf(x40, l[0], s0); s1 = fmaf(x41, l[1], s1); s2 = fmaf(x42, l[2], s2); s3 = fmaf(x43, l[3], s3); } { const f32x4 l = *(const LAS f32x4*)(Lc + 248); s0 = fmaf(x44, l[0], s0); s1 = fmaf(x45, l[1], s1); s2 = fmaf(x46, l[2], s2); s3 = fmaf(x47, l[3], s3); } { const f32x4 l = *(const LAS f32x4*)(Lc + 252); s0 = fmaf(x48, l[0], s0); s1 = fmaf(x49, l[1], s1); s2 = fmaf(x50, l[2], s2); s3 = fmaf(x51, l[3], s3); } { const f32x4 l = *(const LAS f32x4*)(Lc + 256); s0 = fmaf(x52, l[0], s0); s1 = fmaf(x53, l[1], s1); s2 = fmaf(x54, l[2], s2); s3 = fmaf(x55, l[3], s3); } { const f32x4 l = *(const LAS f32x4*)(Lc + 260); s0 = fmaf(x56, l[0], s0); s1 = fmaf(x57, l[1], s1); s2 = fmaf(x58, l[2], s2); s3 = fmaf(x59, l[3], s3); } { const f32x4 l = *(const LAS f32x4*)(Lc + 264); s0 = fmaf(x60, l[0], s0); s1 = fmaf(x61, l[1], s1); s2 = fmaf(x62, l[2], s2); s3 = fmaf(x63, l[3], s3); } x3 = (lane == 3) ? 1.0f : -((s0 + s1) + (s2 + s3)); asm volatile("" : "+v"(x3) : : "memory"); }
    { float s0 = 0.f, s1 = 0.f, s2 = 0.f, s3 = 0.f; { const f32x4 l = *(const LAS f32x4*)(Lc + 136); s3 = fmaf(x3, l[3], s3); } { const f32x4 l = *(const LAS f32x4*)(Lc + 140); s0 = fmaf(x4, l[0], s0); s1 = fmaf(x5, l[1], s1); s2 = fmaf(x6, l[2], s2); s3 = fmaf(x7, l[3], s3); } { const f32x4 l = *(const LAS f32x4*)(Lc + 144); s0 = fmaf(x8, l[0], s0); s1 = fmaf(x9, l[1], s1); s2 = fmaf(x10, l[2], s2); s3 = fmaf(x11, l[3], s3); } { const f32x4 l = *(const LAS f32x4*)(Lc + 148); s0 = fmaf(x12, l[0], s0); s1 = fmaf(x13, l[1], s1); s2 = fmaf(x14, l[2], s2); s3 = fmaf(x15, l[3], s3); } { const f32x4 l = *(const LAS f32x4*)(Lc + 152); s0 = fmaf(x16, l[0], s0); s1 = fmaf(x17, l[1], s1); s2 = fmaf(x18, l[2], s2); s3 = fmaf(x19, l[3], s3); } { const f32x4 l = *(const LAS f32x4*)(Lc + 156); s0 = fmaf(x20, l[0], s0); s1 = fmaf(x21, l[1], s1); s2 = fmaf(x22, l[2], s2); s3 = fmaf(x23, l[3], s3); } { const f32x4 l = *(const LAS f32x4*)(Lc + 160); s0 = fmaf(x24, l[0], s0); s1 = fmaf(x25, l[1], s1); s2 = fmaf(x26, l[2], s2); s3 = fmaf(x27, l[3], s3); } { const f32x4 l = *(const LAS f32x4*)(Lc + 164); s0 = fmaf(x28, l[0], s0); s1 = fmaf(x29, l[1], s1); s2 = fmaf(x30, l[2], s2); s3 = fmaf(x31, l[3], s3); } { const f32x4 l = *(const LAS f32x4*)(Lc + 168); s0 = fmaf(x32, l[0], s0); s1 = fmaf(x33, l[1], s1); s2 = fmaf(x34, l[2], s2); s3 = fmaf(x35, l[3], s3); } { const f32x4 l = *(const LAS f32x4*)(Lc + 172); s0 = fmaf(x36, l[0], s0); s1 = fmaf(x37, l[1], s1); s2 = fmaf(x38, l[2], s2); s3 = fmaf(x39, l[3], s3); } { const f32x4 l = *(const LAS f32x4*)(Lc + 176); s0 = fmaf(x40, l[0], s0); s1 = fmaf(x41, l[1], s1); s2 = fmaf(x42, l[2], s2); s3 = fmaf(x43, l[3], s3); } { const f32x4 l = *(const LAS f32x4*)(Lc + 180); s0 = fmaf(x44, l[0], s0); s1 = fmaf(x45, l[1], s1); s2 = fmaf(x46, l[2], s2); s3 = fmaf(x47, l[3], s3); } { const f32x4 l = *(const LAS f32x4*)(Lc + 184); s0 = fmaf(x48, l[0], s0); s1 = fmaf(x49, l[1], s1); s2 = fmaf(x50, l[2], s2); s3 = fmaf(x51, l[3], s3); } { const f32x4 l = *(const LAS f32x4*)(Lc + 188); s0 = fmaf(x52, l[0], s0); s1 = fmaf(x53, l[1], s1); s2 = fmaf(x54, l[2], s2); s3 = fmaf(x55, l[3], s3); } { const f32x4 l = *(const LAS f32x4*)(Lc + 192); s0 = fmaf(x56, l[0], s0); s1 = fmaf(x57, l[1], s1); s2 = fmaf(x58, l[2], s2); s3 = fmaf(x59, l[3], s3); } { const f32x4 l = *(const LAS f32x4*)(Lc + 196); s0 = fmaf(x60, l[0], s0); s1 = fmaf(x61, l[1], s1); s2 = fmaf(x62, l[2], s2); s3 = fmaf(x63, l[3], s3); } x2 = (lane == 2) ? 1.0f : -((s0 + s1) + (s2 + s3)); asm volatile("" : "+v"(x2) : : "memory"); }
    { float s0 = 0.f, s1 = 0.f, s2 = 0.f, s3 = 0.f; { const f32x4 l = *(const LAS f32x4*)(Lc + 68); s2 = fmaf(x2, l[2], s2); s3 = fmaf(x3, l[3], s3); } { const f32x4 l = *(const LAS f32x4*)(Lc + 72); s0 = fmaf(x4, l[0], s0); s1 = fmaf(x5, l[1], s1); s2 = fmaf(x6, l[2], s2); s3 = fmaf(x7, l[3], s3); } { const f32x4 l = *(const LAS f32x4*)(Lc + 76); s0 = fmaf(x8, l[0], s0); s1 = fmaf(x9, l[1], s1); s2 = fmaf(x10, l[2], s2); s3 = fmaf(x11, l[3], s3); } { const f32x4 l = *(const LAS f32x4*)(Lc + 80); s0 = fmaf(x12, l[0], s0); s1 = fmaf(x13, l[1], s1); s2 = fmaf(x14, l[2], s2); s3 = fmaf(x15, l[3], s3); } { const f32x4 l = *(const LAS f32x4*)(Lc + 84); s0 = fmaf(x16, l[0], s0); s1 = fmaf(x17, l[1], s1); s2 = fmaf(x18, l[2], s2); s3 = fmaf(x19, l[3], s3); } { const f32x4 l = *(const LAS f32x4*)(Lc + 88); s0 = fmaf(x20, l[0], s0); s1 = fmaf(x21, l[1], s1); s2 = fmaf(x22, l[2], s2); s3 = fmaf(x23, l[3], s3); } { const f32x4 l = *(const LAS f32x4*)(Lc + 92); s0 = fmaf(x24, l[0], s0); s1 = fmaf(x25, l[1], s1); s2 = fmaf(x26, l[2], s2); s3 = fmaf(x27, l[3], s3); } { const f32x4 l = *(const LAS f32x4*)(Lc + 96); s0 = fmaf(x28, l[0], s0); s1 = fmaf(x29, l[1], s1); s2 = fmaf(x30, l[2], s2); s3 = fmaf(x31, l[3], s3); } { const f32x4 l = *(const LAS f32x4*)(Lc + 100); s0 = fmaf(x32, l[0], s0); s1 = fmaf(x33, l[1], s1); s2 = fmaf(x34, l[2], s2); s3 = fmaf(x35, l[3], s3); } { const f32x4 l = *(const LAS f32x4*)(Lc + 104); s0 = fmaf(x36, l[0], s0); s1 = fmaf(x37, l[1], s1); s2 = fmaf(x38, l[2], s2); s3 = fmaf(x39, l[3], s3); } { const f32x4 l = *(const LAS f32x4*)(Lc + 108); s0 = fmaf(x40, l[0], s0); s1 = fmaf(x41, l[1], s1); s2 = fmaf(x42, l[2], s2); s3 = fmaf(x43, l[3], s3); } { const f32x4 l = *(const LAS f32x4*)(Lc + 112); s0 = fmaf(x44, l[0], s0); s1 = fmaf(x45, l[1], s1); s2 = fmaf(x46, l[2], s2); s3 = fmaf(x47, l[3], s3); } { const f32x4 l = *(const LAS f32x4*)(Lc + 116); s0 = fmaf(x48, l[0], s0); s1 = fmaf(x49, l[1], s1); s2 = fmaf(x50, l[2], s2); s3 = fmaf(x51, l[3], s3); } { const f32x4 l = *(const LAS f32x4*)(Lc + 120); s0 = fmaf(x52, l[0], s0); s1 = fmaf(x53, l[1], s1); s2 = fmaf(x54, l[2], s2); s3 = fmaf(x55, l[3], s3); } { const f32x4 l = *(const LAS f32x4*)(Lc + 124); s0 = fmaf(x56, l[0], s0); s1 = fmaf(x57, l[1], s1); s2 = fmaf(x58, l[2], s2); s3 = fmaf(x59, l[3], s3); } { const f32x4 l = *(const LAS f32x4*)(Lc + 128); s0 = fmaf(x60, l[0], s0); s1 = fmaf(x61, l[1], s1); s2 = fmaf(x62, l[2], s2); s3 = fmaf(x63, l[3], s3); } x1 = (lane == 1) ? 1.0f : -((s0 + s1) + (s2 + s3)); asm volatile("" : "+v"(x1) : : "memory"); }
    { float s0 = 0.f, s1 = 0.f, s2 = 0.f, s3 = 0.f; { const f32x4 l = *(const LAS f32x4*)(Lc + 0); s1 = fmaf(x1, l[1], s1); s2 = fmaf(x2, l[2], s2); s3 = fmaf(x3, l[3], s3); } { const f32x4 l = *(const LAS f32x4*)(Lc + 4); s0 = fmaf(x4, l[0], s0); s1 = fmaf(x5, l[1], s1); s2 = fmaf(x6, l[2], s2); s3 = fmaf(x7, l[3], s3); } { const f32x4 l = *(const LAS f32x4*)(Lc + 8); s0 = fmaf(x8, l[0], s0); s1 = fmaf(x9, l[1], s1); s2 = fmaf(x10, l[2], s2); s3 = fmaf(x11, l[3], s3); } { const f32x4 l = *(const LAS f32x4*)(Lc + 12); s0 = fmaf(x12, l[0], s0); s1 = fmaf(x13, l[1], s1); s2 = fmaf(x14, l[2], s2); s3 = fmaf(x15, l[3], s3); } { const f32x4 l = *(const LAS f32x4*)(Lc + 16); s0 = fmaf(x16, l[0], s0); s1 = fmaf(x17, l[1], s1); s2 = fmaf(x18, l[2], s2); s3 = fmaf(x19, l[3], s3); } { const f32x4 l = *(const LAS f32x4*)(Lc + 20); s0 = fmaf(x20, l[0], s0); s1 = fmaf(x21, l[1], s1); s2 = fmaf(x22, l[2], s2); s3 = fmaf(x23, l[3], s3); } { const f32x4 l = *(const LAS f32x4*)(Lc + 24); s0 = fmaf(x24, l[0], s0); s1 = fmaf(x25, l[1], s1); s2 = fmaf(x26, l[2], s2); s3 = fmaf(x27, l[3], s3); } { const f32x4 l = *(const LAS f32x4*)(Lc + 28); s0 = fmaf(x28, l[0], s0); s1 = fmaf(x29, l[1], s1); s2 = fmaf(x30, l[2], s2); s3 = fmaf(x31, l[3], s3); } { const f32x4 l = *(const LAS f32x4*)(Lc + 32); s0 = fmaf(x32, l[0], s0); s1 = fmaf(x33, l[1], s1); s2 = fmaf(x34, l[2], s2); s3 = fmaf(x35, l[3], s3); } { const f32x4 l = *(const LAS f32x4*)(Lc + 36); s0 = fmaf(x36, l[0], s0); s1 = fmaf(x37, l[1], s1); s2 = fmaf(x38, l[2], s2); s3 = fmaf(x39, l[3], s3); } { const f32x4 l = *(const LAS f32x4*)(Lc + 40); s0 = fmaf(x40, l[0], s0); s1 = fmaf(x41, l[1], s1); s2 = fmaf(x42, l[2], s2); s3 = fmaf(x43, l[3], s3); } { const f32x4 l = *(const LAS f32x4*)(Lc + 44); s0 = fmaf(x44, l[0], s0); s1 = fmaf(x45, l[1], s1); s2 = fmaf(x46, l[2], s2); s3 = fmaf(x47, l[3], s3); } { const f32x4 l = *(const LAS f32x4*)(Lc + 48); s0 = fmaf(x48, l[0], s0); s1 = fmaf(x49, l[1], s1); s2 = fmaf(x50, l[2], s2); s3 = fmaf(x51, l[3], s3); } { const f32x4 l = *(const LAS f32x4*)(Lc + 52); s0 = fmaf(x52, l[0], s0); s1 = fmaf(x53, l[1], s1); s2 = fmaf(x54, l[2], s2); s3 = fmaf(x55, l[3], s3); } { const f32x4 l = *(const LAS f32x4*)(Lc + 56); s0 = fmaf(x56, l[0], s0); s1 = fmaf(x57, l[1], s1); s2 = fmaf(x58, l[2], s2); s3 = fmaf(x59, l[3], s3); } { const f32x4 l = *(const LAS f32x4*)(Lc + 60); s0 = fmaf(x60, l[0], s0); s1 = fmaf(x61, l[1], s1); s2 = fmaf(x62, l[2], s2); s3 = fmaf(x63, l[3], s3); } x0 = (lane == 0) ? 1.0f : -((s0 + s1) + (s2 + s3)); asm volatile("" : "+v"(x0) : : "memory"); }
    { v4u o; o.x = cvtpk(x0, x1); o.y = cvtpk(x2, x3); o.z = cvtpk(x4, x5); o.w = cvtpk(x6, x7); *(LAS v4u*)(Xs + lane * 72 + 0) = o; }
    { v4u o; o.x = cvtpk(x8, x9); o.y = cvtpk(x10, x11); o.z = cvtpk(x12, x13); o.w = cvtpk(x14, x15); *(LAS v4u*)(Xs + lane * 72 + 8) = o; }
    { v4u o; o.x = cvtpk(x16, x17); o.y = cvtpk(x18, x19); o.z = cvtpk(x20, x21); o.w = cvtpk(x22, x23); *(LAS v4u*)(Xs + lane * 72 + 16) = o; }
    { v4u o; o.x = cvtpk(x24, x25); o.y = cvtpk(x26, x27); o.z = cvtpk(x28, x29); o.w = cvtpk(x30, x31); *(LAS v4u*)(Xs + lane * 72 + 24) = o; }
    { v4u o; o.x = cvtpk(x32, x33); o.y = cvtpk(x34, x35); o.z = cvtpk(x36, x37); o.w = cvtpk(x38, x39); *(LAS v4u*)(Xs + lane * 72 + 32) = o; }
    { v4u o; o.x = cvtpk(x40, x41); o.y = cvtpk(x42, x43); o.z = cvtpk(x44, x45); o.w = cvtpk(x46, x47); *(LAS v4u*)(Xs + lane * 72 + 40) = o; }
    { v4u o; o.x = cvtpk(x48, x49); o.y = cvtpk(x50, x51); o.z = cvtpk(x52, x53); o.w = cvtpk(x54, x55); *(LAS v4u*)(Xs + lane * 72 + 48) = o; }
    { v4u o; o.x = cvtpk(x56, x57); o.y = cvtpk(x58, x59); o.z = cvtpk(x60, x61); o.w = cvtpk(x62, x63); *(LAS v4u*)(Xs + lane * 72 + 56) = o; }
}
#ifndef G1P
#define G1P 15
#endif

#define MF16(a, b, c) __builtin_amdgcn_mfma_f32_16x16x32_bf16((a), (b), (c), 0, 0, 0)
__device__ __forceinline__ bf16x8 ld16g(const bf16* p) { return *(const GAS bf16x8*)p; }
__device__ __forceinline__ float ldbf(const bf16* p) { return __uint_as_float(((unsigned)*(const GAS unsigned short*)p) << 16); }
__device__ __forceinline__ void st8(bf16* p, float a, float b, float c, float d) { u32x2v o; o.x = cvtpk(a, b); o.y = cvtpk(c, d); *(GAS u32x2v*)p = o; }

__device__ __forceinline__ void p_ga(const Frame& F, const Args& a, int L) {
    GAS unsigned char* ws = (GAS unsigned char*)a.ws; asm volatile("" : "+s"(ws)); int lane_ = F.lane; asm volatile("" : "+v"(lane_)); const int j = L >> 1, lane = lane_;
    const bf16* PO = (const bf16*)(ws + WS_ARENA + AR_PO);
    bf16 *QN = (bf16*)(ws + WS_ARENA + AR_QN), *QT = (bf16*)(ws + WS_ARENA + AR_QT), *KN = (bf16*)(ws + WS_ARENA + AR_KN), *KGT = (bf16*)(ws + WS_ARENA + AR_KGT), *VBT = (bf16*)(ws + WS_ARENA + AR_VBT), *KTT = (bf16*)(ws + WS_ARENA + AR_KTT);
    const float* gg = (const float*)(ws + WS_GB); const float* gbeta = gg + S_ * 8; float* dn = (float*)(ws + WS_TOK + TOK_DN); float* gcs = (float*)(ws + WS_GC);
    const float* cw = (const float*)a.in[16] + (size_t)j * 4 * 3072;
    LAS float* sc = (LAS float*)(F.lds + F.wave * WAVE_LDS);
    const int dg = lane & 15, ts = lane >> 4, d0 = 8 * dg;
#pragma unroll 1
    for (int tp_ = 2 * F.vcu + (F.wave >> 2); tp_ < 512; tp_ += 2 * F.G) {
        const int u = (4 * (tp_ >> 3) + (F.wave & 3)) * 8 + (tp_ & 7);
        const int n = u >> 3, hh = u & 7, tok0 = 64 * n;
        {
            const float g = gg[(size_t)(tok0 + lane) * 8 + hh], beta = gbeta[(size_t)(tok0 + lane) * 8 + hh];
            float gc = g;
#pragma unroll
            for (int o = 1; o < 64; o <<= 1) { const float t = __shfl_up(gc, o); if (lane >= o) gc += t; }
            const float glast = __shfl(gc, 63);
            gcs[(size_t)(tok0 + lane) * 8 + hh] = gc;
            if (lane == 0) dn[u] = expf(glast);
            const float eg = expf(gc);
            sc[64 + lane] = beta * eg; sc[128 + lane] = expf(glast - gc); sc[192 + lane] = beta; sc[256 + lane] = eg;
        }
#pragma unroll 1
        for (int qk = 0; qk < 2; ++qk) {
            const int coff = qk * 1024 + hh * 128 + d0;
            float w[4][8];
#pragma unroll
            for (int jj = 0; jj < 4; ++jj)
#pragma unroll
                for (int e = 0; e < 8; ++e) w[jj][e] = *(const GAS float*)(cw + jj * 3072 + coff + e);
#pragma unroll 4
            for (int it = 0; it < 16; ++it) {
                const int i = 4 * it + ts, tok = tok0 + i; float acc[8];
                v4u rv[4];
#pragma unroll
                for (int jj = 0; jj < 4; ++jj) { const int r = tok - 3 + jj; rv[jj] = *(const GAS v4u*)(PO + (size_t)(r < 0 ? 0 : r) * OIN + coff); }
#pragma unroll
                for (int e = 0; e < 8; ++e) acc[e] = 0.f;
#pragma unroll
                for (int jj = 0; jj < 4; ++jj) { const float on = (tok - 3 + jj >= 0) ? 1.0f : 0.0f; const unsigned vv[4] = {rv[jj].x, rv[jj].y, rv[jj].z, rv[jj].w};
#pragma unroll
                    for (int q = 0; q < 4; ++q) { acc[2 * q] += (w[jj][2 * q] * on) * bflo(vv[q]); acc[2 * q + 1] += (w[jj][2 * q + 1] * on) * bfhi(vv[q]); } }
                float ss = 0.f;
#pragma unroll
                for (int e = 0; e < 8; ++e) { acc[e] = silu(acc[e]); ss += acc[e] * acc[e]; }
                ss += __shfl_xor(ss, 1); ss += __shfl_xor(ss, 2); ss += __shfl_xor(ss, 4); ss += __shfl_xor(ss, 8);
                const float rn = __builtin_amdgcn_rsqf(ss + 1e-6f);
                const float s1 = (qk == 0) ? rn * 0.08838834764831845f : rn;
                v4u o; o.x = cvtpk(acc[0] * s1, acc[1] * s1); o.y = cvtpk(acc[2] * s1, acc[3] * s1); o.z = cvtpk(acc[4] * s1, acc[5] * s1); o.w = cvtpk(acc[6] * s1, acc[7] * s1);
                *(GAS v4u*)((qk == 0 ? QN : KN) + (size_t)tok * D_ + hh * 128 + d0) = o;
                if (qk == 0) { const float s2 = s1 * sc[256 + i];
                    o.x = cvtpk(acc[0] * s2, acc[1] * s2); o.y = cvtpk(acc[2] * s2, acc[3] * s2); o.z = cvtpk(acc[4] * s2, acc[5] * s2); o.w = cvtpk(acc[6] * s2, acc[7] * s2);
                    *(GAS v4u*)(QT + (size_t)tok * D_ + hh * 128 + d0) = o; }
                else if (dg == 0) sc[i] = rn;
            }
        }
#pragma unroll 1
        for (int kv = 0; kv < 2; ++kv)
#pragma unroll 1
            for (int half = 0; half < 2; ++half) {
                const int d = 64 * half + lane, c = (1 + kv) * 1024 + hh * 128 + d;
                const float w0 = *(const GAS float*)(cw + c), w1 = *(const GAS float*)(cw + 3072 + c), w2 = *(const GAS float*)(cw + 2 * 3072 + c), w3 = *(const GAS float*)(cw + 3 * 3072 + c);
                const float hon = tok0 > 0 ? 1.0f : 0.0f; const int hb = tok0 > 0 ? tok0 - 3 : 0;
                float r0 = hon * ldbf(PO + (size_t)hb * OIN + c), r1 = hon * ldbf(PO + (size_t)(hb + 1) * OIN + c), r2 = hon * ldbf(PO + (size_t)(hb + 2) * OIN + c);
                const size_t obase = ((size_t)u * 128 + d) * 64;
                const LAS float* m1 = sc + (kv == 0 ? 64 : 192);
                bf16* O1 = kv == 0 ? KGT : VBT;
#pragma unroll 1
                for (int ig4 = 0; ig4 < 2; ++ig4) {
                    float x[32];
#pragma unroll
                    for (int e = 0; e < 32; ++e) x[e] = ldbf(PO + (size_t)(tok0 + 32 * ig4 + e) * OIN + c);
#pragma unroll
                    for (int sb = 0; sb < 4; ++sb) { const int ig = 4 * ig4 + sb; float o1[8], o2[8];
#pragma unroll
                        for (int e = 0; e < 8; ++e) { const int i = 8 * ig + e; const float r3 = x[8 * sb + e];
                            float v = silu(w0 * r0 + w1 * r1 + w2 * r2 + w3 * r3); r0 = r1; r1 = r2; r2 = r3;
                            const float rk = sc[i]; v = (kv == 0) ? v * rk : v;
                            o1[e] = v * m1[i]; o2[e] = v * sc[128 + i]; }
                        v4u o; o.x = cvtpk(o1[0], o1[1]); o.y = cvtpk(o1[2], o1[3]); o.z = cvtpk(o1[4], o1[5]); o.w = cvtpk(o1[6], o1[7]);
                        *(GAS v4u*)(O1 + obase + 8 * ig) = o;
                        if (kv == 0) { o.x = cvtpk(o2[0], o2[1]); o.y = cvtpk(o2[2], o2[3]); o.z = cvtpk(o2[4], o2[5]); o.w = cvtpk(o2[6], o2[7]); *(GAS v4u*)(KTT + obase + 8 * ig) = o; } }
                }
            }
    }
}

__device__ __forceinline__ void p_g1(const Frame& F, const Args& a) {
    GAS unsigned char* ws = (GAS unsigned char*)a.ws; asm volatile("" : "+s"(ws)); int lane_ = F.lane; asm volatile("" : "+v"(lane_)); const int lane = lane_, r16 = lane & 15, g = lane >> 4;
    const bf16 *QN = (const bf16*)(ws + WS_ARENA + AR_QN), *KN = (const bf16*)(ws + WS_ARENA + AR_KN), *KGT = (const bf16*)(ws + WS_ARENA + AR_KGT), *VBT = (const bf16*)(ws + WS_ARENA + AR_VBT), *KTT = (const bf16*)(ws + WS_ARENA + AR_KTT);
    bf16 *AI = (bf16*)(ws + WS_ARENA + AR_AI), *NEGW = (bf16*)(ws + WS_ARENA + AR_NEGW), *UT = (bf16*)(ws + WS_ARENA + AR_UT), *MP = (bf16*)(ws + WS_ARENA + AR_MP), *NT = (bf16*)(ws + WS_ARENA + AR_NT), *WT = (bf16*)(ws + WS_ARENA + AR_WT);
    const float* gg = (const float*)(ws + WS_GC); const float* gbeta = (const float*)(ws + WS_GB) + S_ * 8;
    LAS float* Lc = (LAS float*)(F.lds + F.wave * WAVE_LDS);
    LAS bf16* Xs = (LAS bf16*)(F.lds + F.wave * WAVE_LDS);
    const f32x4 Z4 = {0.f, 0.f, 0.f, 0.f};
#ifdef PROBE_G1P
    const int g1p = a.use_bar ? 15 : PROBE_G1P;
#else
    const int g1p = 15;
#endif
#pragma unroll 1
    for (int tp_ = 2 * F.vcu + (F.wave >> 2); tp_ < 512; tp_ += 2 * F.G) {
        const int u = (4 * (tp_ >> 3) + (F.wave & 3)) * 8 + (tp_ & 7);
        const int n = u >> 3, hh = u & 7, tok0 = 64 * n; const int uh = hh * NCHUNK + n;
        const float gc = gg[(size_t)(tok0 + lane) * 8 + hh], beta = gbeta[(size_t)(tok0 + lane) * 8 + hh];
        if (g1p & 1) {
        {
            bf16x8 kf[4][4];
#pragma unroll
            for (int t = 0; t < 4; ++t)
#pragma unroll
                for (int kk = 0; kk < 4; ++kk) kf[t][kk] = ld16g(KN + (size_t)(tok0 + 16 * t + r16) * D_ + hh * 128 + 32 * kk + 8 * g);
#pragma unroll
            for (int ti = 0; ti < 4; ++ti)
#pragma unroll
                for (int tj = 0; tj <= ti; ++tj) {
                    f32x4 Dv = Z4;
#pragma unroll
                    for (int kk = 0; kk < 4; ++kk) Dv = MF16(kf[ti][kk], kf[tj][kk], Dv);
                    const int jx = 16 * tj + r16; const float gcj = __shfl(gc, jx); f32x4 val;
#pragma unroll
                    for (int r = 0; r < 4; ++r) { const int ix = 16 * ti + 4 * g + r; const float gci = __shfl(gc, ix), bi = __shfl(beta, ix); val[r] = (ix > jx) ? bi * Dv[r] * expf(gci - gcj) : 0.f; }
                    *(LAS f32x4*)(Lc + jx * 68 + 16 * ti + 4 * g) = val;
                }
#pragma unroll
            for (int ti = 0; ti < 4; ++ti) {
                bf16x8 qf[4];
#pragma unroll
                for (int kk = 0; kk < 4; ++kk) qf[kk] = ld16g(QN + (size_t)(tok0 + 16 * ti + r16) * D_ + hh * 128 + 32 * kk + 8 * g);
                const int ix = 16 * ti + r16; const float gci = __shfl(gc, ix);
#pragma unroll
                for (int tj = 0; tj < 4; ++tj) {
                    f32x4 val = Z4;
                    if (tj <= ti) {
                        f32x4 Dv = Z4;
#pragma unroll
                        for (int kk = 0; kk < 4; ++kk) Dv = MF16(kf[tj][kk], qf[kk], Dv);
#pragma unroll
                        for (int r = 0; r < 4; ++r) { const int jx = 16 * tj + 4 * g + r; const float gcj = __shfl(gc, jx); val[r] = (ix >= jx) ? Dv[r] * expf(gci - gcj) : 0.f; }
                    }
                    st8(AI + ((size_t)u * 64 + ix) * 64 + 16 * tj + 4 * g, val[0], val[1], val[2], val[3]);
                }
            }
        }
        asm volatile("s_waitcnt lgkmcnt(0)" ::: "memory");
        }
        if (g1p & 2) {
        tri_solve(Lc, Xs, lane);
        }
        if (g1p & 4) {
        asm volatile("s_waitcnt lgkmcnt(0)" ::: "memory");
        {
            bf16x8 xf[4][2];
#pragma unroll
            for (int t = 0; t < 4; ++t)
#pragma unroll
                for (int kk = 0; kk < 2; ++kk) xf[t][kk] = *(const LAS bf16x8*)(Xs + (16 * t + r16) * 72 + 32 * kk + 8 * g);
#pragma unroll 2
            for (int td = 0; td < 8; ++td) {
                const size_t rb = ((size_t)u * 128 + 16 * td + r16) * 64;
                const bf16x8 vb0 = ld16g(VBT + rb + 8 * g), vb1 = ld16g(VBT + rb + 32 + 8 * g), kg0 = ld16g(KGT + rb + 8 * g), kg1 = ld16g(KGT + rb + 32 + 8 * g);
#pragma unroll
                for (int ti = 0; ti < 4; ++ti) {
                    f32x4 Du = MF16(xf[ti][0], vb0, Z4); Du = MF16(xf[ti][1], vb1, Du);
                    st8(UT + rb + 16 * ti + 4 * g, Du[0], Du[1], Du[2], Du[3]);
                    f32x4 Dw = MF16(xf[ti][0], kg0, Z4); Dw = MF16(xf[ti][1], kg1, Dw);
                    st8(WT + rb + 16 * ti + 4 * g, Dw[0], Dw[1], Dw[2], Dw[3]);
                    f32x4 Dn = MF16(kg0, xf[ti][0], Z4); Dn = MF16(kg1, xf[ti][1], Dn);
                    st8(NEGW + (size_t)(tok0 + 16 * ti + r16) * D_ + hh * 128 + 16 * td + 4 * g, -Dn[0], -Dn[1], -Dn[2], -Dn[3]);
                }
            }
        }
        }
        asm volatile("s_waitcnt vmcnt(0)" ::: "memory");
        if (g1p & 8) {
        {
            LAS bf16* ost = (LAS bf16*)(F.lds + F.wave * WAVE_LDS);
            {
                bf16x8 wf[8][2];
#pragma unroll
                for (int t = 0; t < 8; ++t)
#pragma unroll
                    for (int kk = 0; kk < 2; ++kk) wf[t][kk] = ld16g(WT + ((size_t)u * 128 + 16 * t + r16) * 64 + 32 * kk + 8 * g);
#pragma unroll 2
                for (int t1 = 0; t1 < 8; ++t1) {
                    const size_t rb = ((size_t)u * 128 + 16 * t1 + r16) * 64;
                    const bf16x8 k0 = ld16g(KTT + rb + 8 * g), k1 = ld16g(KTT + rb + 32 + 8 * g);
                    asm volatile("s_waitcnt lgkmcnt(0)" ::: "memory");
#pragma unroll
                    for (int tp = 0; tp < 8; ++tp) { f32x4 Dm = MF16(wf[tp][0], k0, Z4); Dm = MF16(wf[tp][1], k1, Dm);
                        u32x2v o; o.x = cvtpk(-Dm[0], -Dm[1]); o.y = cvtpk(-Dm[2], -Dm[3]); *(LAS u32x2v*)(ost + r16 * 136 + 16 * tp + 4 * g) = o; }
                    asm volatile("s_waitcnt lgkmcnt(0)" ::: "memory");
#pragma unroll
                    for (int q = 0; q < 4; ++q) { const int row = 4 * q + (lane >> 4), ch = lane & 15; const v4u v = *(const LAS v4u*)(ost + row * 136 + ch * 8);
                        *(GAS v4u*)(MP + ((size_t)uh * 128 + 16 * t1 + row) * 128 + ch * 8) = v; }
                }
            }
            {
                bf16x8 ktf[8][2];
#pragma unroll
                for (int t = 0; t < 8; ++t)
#pragma unroll
                    for (int kk = 0; kk < 2; ++kk) ktf[t][kk] = ld16g(KTT + ((size_t)u * 128 + 16 * t + r16) * 64 + 32 * kk + 8 * g);
#pragma unroll 2
                for (int tp = 0; tp < 8; ++tp) {
                    const size_t rb = ((size_t)u * 128 + 16 * tp + r16) * 64;
                    const bf16x8 uf0 = ld16g(UT + rb + 8 * g), uf1 = ld16g(UT + rb + 32 + 8 * g);
                    asm volatile("s_waitcnt lgkmcnt(0)" ::: "memory");
#pragma unroll
                    for (int t1 = 0; t1 < 8; ++t1) { f32x4 Dn = MF16(ktf[t1][0], uf0, Z4); Dn = MF16(ktf[t1][1], uf1, Dn);
                        u32x2v o; o.x = cvtpk(Dn[0], Dn[1]); o.y = cvtpk(Dn[2], Dn[3]); *(LAS u32x2v*)(ost + r16 * 136 + 16 * t1 + 4 * g) = o; }
                    asm volatile("s_waitcnt lgkmcnt(0)" ::: "memory");
#pragma unroll
                    for (int q = 0; q < 4; ++q) { const int row = 4 * q + (lane >> 4), ch = lane & 15; const v4u v = *(const LAS v4u*)(ost + row * 136 + ch * 8);
                        *(GAS v4u*)(NT + ((size_t)uh * 128 + 16 * tp + row) * 128 + ch * 8) = v; }
                }
            }
        }
        }
    }
}

template <int NS, int SGSTEP> __device__ __forceinline__ void p_g2(const Frame& F, const Args& a, const bf16* MPsrc, const bf16* NTsrc, const float* dnsrc) {
    GAS unsigned char* ws = (GAS unsigned char*)a.ws; asm volatile("" : "+s"(ws)); int lane_ = F.lane; asm volatile("" : "+v"(lane_)); const int lane = lane_, r16 = lane & 15, g = lane >> 4, w = F.wave;
    const bf16 *MP = MPsrc, *NT = NTsrc; bf16* SG = (bf16*)(ws + WS_ARENA + AR_SG);
    const float* dn = dnsrc;
    LAS bf16* St = (LAS bf16*)F.lds;
    const int args_use_bar = a.use_bar; (void)args_use_bar;
#pragma unroll 1
    for (int asg = F.vcu; asg < 64; asg += F.G) {
        const int hh = asg >> 3, sl = asg & 7;
        __syncthreads();
        for (int idx = F.tid; idx < 2 * 16 * 136 / 2; idx += NWAVES * 64) ((LAS unsigned*)St)[idx] = 0u;
        __syncthreads();
        if (w >= 4) {
            const int st = F.tid - 256, row = st >> 4, chunk = st & 15;
#pragma unroll 1
            for (int n = 0; n < NS; ++n) {
                const v4u v = *(const LAS v4u*)(St + (n & 1) * (16 * 136) + row * 136 + chunk * 8);
                *(GAS v4u*)(SG + ((size_t)(hh * NCHUNK + n * SGSTEP) * 128 + 16 * sl + row) * 128 + chunk * 8) = v;
                asm volatile("s_waitcnt lgkmcnt(0)" ::: "memory"); __builtin_amdgcn_s_barrier(); asm volatile("" ::: "memory");
            }
        } else {
            f32x4 Sv[2] = {{0.f, 0.f, 0.f, 0.f}, {0.f, 0.f, 0.f, 0.f}};
            bf16x8 A0[2][4], A1[2][4], A2[2][4], A3[2][4]; u32x2v C0[2], C1[2], C2[2], C3[2]; float d0, d1, d2, d3;
#define G2_LOAD(AX, CX, DX, nn) do { const int u_ = hh * NS + (nn); \
            _Pragma("unroll") for (int t = 0; t < 2; ++t) { \
                _Pragma("unroll") for (int kk = 0; kk < 4; ++kk) AX[t][kk] = ld16g(MP + ((size_t)u_ * 128 + 32 * w + 16 * t + r16) * 128 + 32 * kk + 8 * g); \
                CX[t] = *(const GAS u32x2v*)(NT + ((size_t)u_ * 128 + 16 * sl + r16) * 128 + 32 * w + 16 * t + 4 * g); } \
            DX = *(const GAS float*)(dn + (nn) * 8 + hh); } while (0)
#ifdef PROBE_G2_NOLOAD
#define G2_STEPLOAD(AL, CL, DL, nn) do { if (args_use_bar) G2_LOAD(AL, CL, DL, nn); } while (0)
#else
#define G2_STEPLOAD(AL, CL, DL, nn) G2_LOAD(AL, CL, DL, nn)
#endif
#define G2_STEP(AU, CU, DU, AL, CL, DL, nn) do { const int n_ = (nn); const int n2_ = (n_ + 3 < NS) ? n_ + 3 : NS - 1; \
            G2_STEPLOAD(AL, CL, DL, n2_); \
            LAS bf16* Sc = St + (n_ & 1) * (16 * 136); LAS bf16* Sn = St + ((n_ & 1) ^ 1) * (16 * 136); \
            f32x4 D0 = {bflo(CU[0].x), bfhi(CU[0].x), bflo(CU[0].y), bfhi(CU[0].y)}, D1 = {bflo(CU[1].x), bfhi(CU[1].x), bflo(CU[1].y), bfhi(CU[1].y)}; \
            _Pragma("unroll") for (int kk = 0; kk < 4; ++kk) { const bf16x8 Bf = *(const LAS bf16x8*)(Sc + r16 * 136 + 32 * kk + 8 * g); D0 = MF16(AU[0][kk], Bf, D0); D1 = MF16(AU[1][kk], Bf, D1); } \
            Sv[0] = Sv[0] * DU + D0; Sv[1] = Sv[1] * DU + D1; \
            { u32x2v o; o.x = cvtpk(Sv[0][0], Sv[0][1]); o.y = cvtpk(Sv[0][2], Sv[0][3]); *(LAS u32x2v*)(Sn + r16 * 136 + 32 * w + 4 * g) = o; \
              o.x = cvtpk(Sv[1][0], Sv[1][1]); o.y = cvtpk(Sv[1][2], Sv[1][3]); *(LAS u32x2v*)(Sn + r16 * 136 + 32 * w + 16 + 4 * g) = o; } \
            asm volatile("s_waitcnt lgkmcnt(0)" ::: "memory"); __builtin_amdgcn_s_barrier(); asm volatile("" ::: "memory"); } while (0)
            G2_LOAD(A0, C0, d0, 0); G2_LOAD(A1, C1, d1, 1); G2_LOAD(A2, C2, d2, 2);
            static_assert(NS % 24 == 16, "scan loop: trips of 24 steps + a 16-step tail");
            int n = 0;
#pragma unroll 1
            for (; n + 24 <= NS - 16; n += 24) {
                G2_STEP(A0, C0, d0, A3, C3, d3, n + 0);
                G2_STEP(A1, C1, d1, A0, C0, d0, n + 1);
                G2_STEP(A2, C2, d2, A1, C1, d1, n + 2);
                G2_STEP(A3, C3, d3, A2, C2, d2, n + 3);
                G2_STEP(A0, C0, d0, A3, C3, d3, n + 4);
                G2_STEP(A1, C1, d1, A0, C0, d0, n + 5);
                G2_STEP(A2, C2, d2, A1, C1, d1, n + 6);
                G2_STEP(A3, C3, d3, A2, C2, d2, n + 7);
                G2_STEP(A0, C0, d0, A3, C3, d3, n + 8);
                G2_STEP(A1, C1, d1, A0, C0, d0, n + 9);
                G2_STEP(A2, C2, d2, A1, C1, d1, n + 10);
                G2_STEP(A3, C3, d3, A2, C2, d2, n + 11);
                G2_STEP(A0, C0, d0, A3, C3, d3, n + 12);
                G2_STEP(A1, C1, d1, A0, C0, d0, n + 13);
                G2_STEP(A2, C2, d2, A1, C1, d1, n + 14);
                G2_STEP(A3, C3, d3, A2, C2, d2, n + 15);
                G2_STEP(A0, C0, d0, A3, C3, d3, n + 16);
                G2_STEP(A1, C1, d1, A0, C0, d0, n + 17);
                G2_STEP(A2, C2, d2, A1, C1, d1, n + 18);
                G2_STEP(A3, C3, d3, A2, C2, d2, n + 19);
                G2_STEP(A0, C0, d0, A3, C3, d3, n + 20);
                G2_STEP(A1, C1, d1, A0, C0, d0, n + 21);
                G2_STEP(A2, C2, d2, A1, C1, d1, n + 22);
                G2_STEP(A3, C3, d3, A2, C2, d2, n + 23);
            }
            G2_STEP(A0, C0, d0, A3, C3, d3, n + 0);
            G2_STEP(A1, C1, d1, A0, C0, d0, n + 1);
            G2_STEP(A2, C2, d2, A1, C1, d1, n + 2);
            G2_STEP(A3, C3, d3, A2, C2, d2, n + 3);
            G2_STEP(A0, C0, d0, A3, C3, d3, n + 4);
            G2_STEP(A1, C1, d1, A0, C0, d0, n + 5);
            G2_STEP(A2, C2, d2, A1, C1, d1, n + 6);
            G2_STEP(A3, C3, d3, A2, C2, d2, n + 7);
            G2_STEP(A0, C0, d0, A3, C3, d3, n + 8);
            G2_STEP(A1, C1, d1, A0, C0, d0, n + 9);
            G2_STEP(A2, C2, d2, A1, C1, d1, n + 10);
            G2_STEP(A3, C3, d3, A2, C2, d2, n + 11);
            G2_STEP(A0, C0, d0, A3, C3, d3, n + 12);
            G2_STEP(A1, C1, d1, A0, C0, d0, n + 13);
            G2_STEP(A2, C2, d2, A1, C1, d1, n + 14);
            G2_STEP(A3, C3, d3, A2, C2, d2, n + 15);
#undef G2_STEP
#undef G2_LOAD
        }
    }
}


constexpr int GST_PAIR = 128 * 136, GST_BYTES = 2 * GST_PAIR * 2, GW_BYTES = 8704;
static_assert(GST_BYTES + 8 * GW_BYTES <= LDSCTL_OFF, "group-phase LDS map");
__device__ __forceinline__ void g_stage_mp(const Frame& F, const bf16* MP, int uh0, int uh1, bool on0, bool on1) {
    LAS bf16* st = (LAS bf16*)F.lds;
#pragma unroll
    for (int q = 0; q < 4; ++q) { const int idx = F.tid + 512 * q, row = idx >> 4, ch = idx & 15;
        v4u v0 = {0u, 0u, 0u, 0u}, v1 = v0;
        if (on0) v0 = *(const GAS v4u*)(MP + ((size_t)uh0 * 128 + row) * 128 + ch * 8);
        if (on1) v1 = *(const GAS v4u*)(MP + ((size_t)uh1 * 128 + row) * 128 + ch * 8);
        *(LAS v4u*)(st + row * 136 + ch * 8) = v0; *(LAS v4u*)(st + GST_PAIR + row * 136 + ch * 8) = v1; }
}
__device__ __forceinline__ void p_g1b(const Frame& F, const Args& a) {
    GAS unsigned char* ws = (GAS unsigned char*)a.ws; asm volatile("" : "+s"(ws)); int lane_ = F.lane; asm volatile("" : "+v"(lane_)); const int lane = lane_, r16 = lane & 15, g = lane >> 4;
    const bf16 *MP = (const bf16*)(ws + WS_ARENA + AR_MP), *NT = (const bf16*)(ws + WS_ARENA + AR_NT); const float* dn = (const float*)(ws + WS_TOK + TOK_DN);
    bf16 *MPc = (bf16*)(ws + WS_ARENA + AR_MPC), *NTc = (bf16*)(ws + WS_ARENA + AR_NTC); float* dnc = (float*)(ws + WS_TOK + TOK_DNC);
    const bool isB = F.wave >= 4; const int sl = F.wave & 3, c0 = 32 * sl;
    const LAS bf16* stg = (const LAS bf16*)F.lds; LAS bf16* wa = (LAS bf16*)(F.lds + GST_BYTES + F.wave * GW_BYTES);
#pragma unroll 1
    for (int tp = 2 * F.vcu; tp < 512; tp += (tp & 1) ? 2 * F.G - 1 : 1) {
        const int hh = tp & 7, gq = tp >> 3;
        f32x4 X[8][2]; float Dd = 1.0f;
#pragma unroll
        for (int mt = 0; mt < 8; ++mt)
#pragma unroll
            for (int nt = 0; nt < 2; ++nt) X[mt][nt] = (f32x4){0.f, 0.f, 0.f, 0.f};
#pragma unroll 1
        for (int i = 0; i < 4; ++i) {
            const int uh = hh * NCHUNK + 4 * gq + i; const float di = *(const GAS float*)(dn + (4 * gq + i) * 8 + hh);
            bf16x8 xo[4][2]; const float dadd = isB ? 0.0f : Dd;
#pragma unroll
            for (int s = 0; s < 4; ++s)
#pragma unroll
                for (int nt = 0; nt < 2; ++nt) { v4u pr; const int col = c0 + 16 * nt + r16; f32x4 t0 = X[2 * s][nt], t1 = X[2 * s + 1][nt];
#pragma unroll
                    for (int r = 0; r < 4; ++r) { if (32 * s + 4 * g + r == col) t0[r] += dadd; if (32 * s + 16 + 4 * g + r == col) t1[r] += dadd; }
                    pr.x = cvtpk(t0[0], t0[1]); pr.y = cvtpk(t0[2], t0[3]); pr.z = cvtpk(t1[0], t1[1]); pr.w = cvtpk(t1[2], t1[3]); xo[s][nt] = __builtin_bit_cast(bf16x8, pr); }
            __syncthreads();
            {
                LAS bf16* st = (LAS bf16*)F.lds;
#pragma unroll
                for (int q = 0; q < 4; ++q) { const int idx = F.tid + 512 * q, row = idx >> 4, ch = idx & 15; const v4u v = *(const GAS v4u*)(MP + ((size_t)uh * 128 + row) * 128 + ch * 8); *(LAS v4u*)(st + row * 136 + ch * 8) = v; }
            }
            if (isB) {
#pragma unroll
                for (int q = 0; q < 8; ++q) { const int row = 4 * q + (lane >> 4), ch = lane & 15; const v4u v = *(const GAS v4u*)(NT + ((size_t)uh * 128 + c0 + row) * 128 + ch * 8); *(LAS v4u*)(wa + row * 136 + ch * 8) = v; }
            }
            __syncthreads();
#pragma unroll
            for (int mt = 0; mt < 8; ++mt) {
                bf16x8 af[4];
#pragma unroll
                for (int s = 0; s < 4; ++s) { const LAS bf16* rp = stg + (16 * mt + r16) * 136 + 32 * s + 4 * g; const u32x2v lo = *(const LAS u32x2v*)rp, hi = *(const LAS u32x2v*)(rp + 16);
                    const v4u pk = {lo.x, lo.y, hi.x, hi.y}; af[s] = __builtin_bit_cast(bf16x8, pk); }
#pragma unroll
                for (int nt = 0; nt < 2; ++nt) { f32x4 acc = X[mt][nt] * di;
                    if (isB) { const u32x2v nn = *(const LAS u32x2v*)(wa + (16 * nt + r16) * 136 + 16 * mt + 4 * g); acc = acc + (f32x4){bflo(nn.x), bfhi(nn.x), bflo(nn.y), bfhi(nn.y)}; }
#pragma unroll
                    for (int s = 0; s < 4; ++s) acc = MF16(af[s], xo[s][nt], acc);
                    X[mt][nt] = acc; }
                asm volatile("" ::: "memory");
            }
            Dd *= di;
        }
        const int uc = hh * 64 + gq;
        if (isB) {
#pragma unroll
            for (int mt = 0; mt < 8; ++mt)
#pragma unroll
                for (int nt = 0; nt < 2; ++nt) st8(NTc + ((size_t)uc * 128 + c0 + 16 * nt + r16) * 128 + 16 * mt + 4 * g, X[mt][nt][0], X[mt][nt][1], X[mt][nt][2], X[mt][nt][3]);
        } else {
            if (sl == 0 && lane == 0) dnc[gq * 8 + hh] = Dd;
#pragma unroll
            for (int hf = 0; hf < 2; ++hf) {
                asm volatile("s_waitcnt lgkmcnt(0)" ::: "memory");
#pragma unroll
                for (int m4 = 0; m4 < 4; ++m4)
#pragma unroll
                    for (int nt = 0; nt < 2; ++nt)
#pragma unroll
                        for (int r = 0; r < 4; ++r) wa[(16 * m4 + 4 * g + r) * 40 + 16 * nt + r16] = (unsigned short)(cvtpk(X[4 * hf + m4][nt][r], 0.f) & 0xffffu);
                asm volatile("s_waitcnt lgkmcnt(0)" ::: "memory");
#pragma unroll
                for (int q = 0; q < 4; ++q) { const int row = 16 * q + (lane >> 2), ch = lane & 3; const v4u v = *(const LAS v4u*)(wa + row * 40 + ch * 8);
                    *(GAS v4u*)(MPc + ((size_t)uc * 128 + 64 * hf + row) * 128 + c0 + ch * 8) = v; }
            }
        }
    }
    __syncthreads();
}

__device__ __forceinline__ void p_g2b(const Frame& F, const Args& a) {
    GAS unsigned char* ws = (GAS unsigned char*)a.ws; asm volatile("" : "+s"(ws)); int lane_ = F.lane; asm volatile("" : "+v"(lane_)); const int lane = lane_, r16 = lane & 15, g = lane >> 4;
    const bf16 *MP = (const bf16*)(ws + WS_ARENA + AR_MP), *NT = (const bf16*)(ws + WS_ARENA + AR_NT); const float* dn = (const float*)(ws + WS_TOK + TOK_DN); bf16* SG = (bf16*)(ws + WS_ARENA + AR_SG);
    const int pw = F.wave >> 2, qf = F.wave & 3, c0 = 32 * qf;
    const LAS bf16* stg = (const LAS bf16*)F.lds + pw * GST_PAIR; LAS bf16* Sl = (LAS bf16*)(F.lds + GST_BYTES + F.wave * GW_BYTES);
#pragma unroll 1
    for (int tp0 = 2 * F.vcu; tp0 < 512; tp0 += 2 * F.G) {
        const int tp = tp0 + pw; const bool on = tp < 512; const int tpc = on ? tp : 0, hh = tpc & 7, gq = tpc >> 3;
        const int tpa = tp0, tpb = tp0 + 1;
        { const int u0 = hh * NCHUNK + 4 * gq;
#pragma unroll
          for (int q = 0; q < 8; ++q) { const int row = 4 * q + (lane >> 4), ch = lane & 15; const v4u v = *(const GAS v4u*)(SG + ((size_t)u0 * 128 + c0 + row) * 128 + ch * 8); *(LAS v4u*)(Sl + row * 136 + ch * 8) = v; } }
#pragma unroll 1
        for (int i = 0; i < 3; ++i) {
            __syncthreads();
            g_stage_mp(F, MP, (tpa & 7) * NCHUNK + 4 * (tpa >> 3) + i, (tpb & 7) * NCHUNK + 4 * ((tpb < 512 ? tpb : 0) >> 3) + i, tpa < 512, tpb < 512);
            const int uh = hh * NCHUNK + 4 * gq + i; const float di = *(const GAS float*)(dn + (4 * gq + i) * 8 + hh);
            u32x2v nn[8][2];
#pragma unroll
            for (int mt = 0; mt < 8; ++mt)
#pragma unroll
                for (int nt = 0; nt < 2; ++nt) nn[mt][nt] = *(const GAS u32x2v*)(NT + ((size_t)uh * 128 + c0 + 16 * nt + r16) * 128 + 16 * mt + 4 * g);
            bf16x8 Bf[2][4];
#pragma unroll
            for (int nt = 0; nt < 2; ++nt)
#pragma unroll
                for (int s = 0; s < 4; ++s) Bf[nt][s] = *(const LAS bf16x8*)(Sl + (16 * nt + r16) * 136 + 32 * s + 8 * g);
            __syncthreads();
            f32x4 acc[8][2];
#pragma unroll
            for (int mt = 0; mt < 8; ++mt) {
                bf16x8 af[4];
#pragma unroll
                for (int s = 0; s < 4; ++s) af[s] = *(const LAS bf16x8*)(stg + (16 * mt + r16) * 136 + 32 * s + 8 * g);
#pragma unroll
                for (int nt = 0; nt < 2; ++nt) {
                    const u32x2v so = *(const LAS u32x2v*)(Sl + (16 * nt + r16) * 136 + 16 * mt + 4 * g);
                    f32x4 Dv = {bflo(nn[mt][nt].x) + di * bflo(so.x), bfhi(nn[mt][nt].x) + di * bfhi(so.x), bflo(nn[mt][nt].y) + di * bflo(so.y), bfhi(nn[mt][nt].y) + di * bfhi(so.y)};
#pragma unroll
                    for (int s = 0; s < 4; ++s) Dv = MF16(af[s], Bf[nt][s], Dv);
                    acc[mt][nt] = Dv;
                }
            }
            asm volatile("s_waitcnt lgkmcnt(0)" ::: "memory");
#pragma unroll
            for (int mt = 0; mt < 8; ++mt)
#pragma unroll
                for (int nt = 0; nt < 2; ++nt) { u32x2v o; o.x = cvtpk(acc[mt][nt][0], acc[mt][nt][1]); o.y = cvtpk(acc[mt][nt][2], acc[mt][nt][3]);
                    *(LAS u32x2v*)(Sl + (16 * nt + r16) * 136 + 16 * mt + 4 * g) = o;
                    if (on) *(GAS u32x2v*)(SG + ((size_t)(uh + 1) * 128 + c0 + 16 * nt + r16) * 128 + 16 * mt + 4 * g) = o; }
            asm volatile("s_waitcnt lgkmcnt(0)" ::: "memory");
        }
    }
    __syncthreads();
}

__device__ __forceinline__ void p_g3(const Frame& F, const Args& a, int L) {
    GAS unsigned char* ws = (GAS unsigned char*)a.ws; asm volatile("" : "+s"(ws)); int lane_ = F.lane; asm volatile("" : "+v"(lane_)); const int j = L >> 1, lane = lane_, r16 = lane & 15, g = lane >> 4;
    const bf16 *PO = (const bf16*)(ws + WS_ARENA + AR_PO), *QT = (const bf16*)(ws + WS_ARENA + AR_QT), *AI = (const bf16*)(ws + WS_ARENA + AR_AI), *NEGW = (const bf16*)(ws + WS_ARENA + AR_NEGW),
               *UT = (const bf16*)(ws + WS_ARENA + AR_UT), *SG = (const bf16*)(ws + WS_ARENA + AR_SG);
    bf16* mix = (bf16*)(ws + WS_MIX); const float* onorm = (const float*)a.in[19] + j * 128;
    const f32x4 Z4 = {0.f, 0.f, 0.f, 0.f};
#pragma unroll 1
    for (int tp_ = 2 * F.vcu + (F.wave >> 2); tp_ < 512; tp_ += 2 * F.G) {
        const int u = (4 * (tp_ >> 3) + (F.wave & 3)) * 8 + (tp_ & 7);
        const int n = u >> 3, hh = u & 7, tok0 = 64 * n; const int uh = hh * NCHUNK + n;
        unsigned vn[8][4][2];
        {
            bf16x8 nw[4][4];
#pragma unroll
            for (int jt = 0; jt < 4; ++jt)
#pragma unroll
                for (int kk = 0; kk < 4; ++kk) nw[jt][kk] = ld16g(NEGW + (size_t)(tok0 + 16 * jt + r16) * D_ + hh * 128 + 32 * kk + 8 * g);
#pragma unroll
            for (int d2t = 0; d2t < 8; ++d2t) {
                bf16x8 sg[4];
#pragma unroll
                for (int kk = 0; kk < 4; ++kk) sg[kk] = ld16g(SG + ((size_t)uh * 128 + 16 * d2t + r16) * 128 + 32 * kk + 8 * g);
#pragma unroll
                for (int jt = 0; jt < 4; ++jt) {
                    const u32x2v c = *(const GAS u32x2v*)(UT + ((size_t)u * 128 + 16 * d2t + r16) * 64 + 16 * jt + 4 * g);
                    f32x4 Dv = {bflo(c.x), bfhi(c.x), bflo(c.y), bfhi(c.y)};
#pragma unroll
                    for (int kk = 0; kk < 4; ++kk) Dv = MF16(nw[jt][kk], sg[kk], Dv);
                    vn[d2t][jt][0] = cvtpk(Dv[0], Dv[1]); vn[d2t][jt][1] = cvtpk(Dv[2], Dv[3]);
                    asm volatile("" : "+v"(vn[d2t][jt][0]), "+v"(vn[d2t][jt][1]));
                }
                asm volatile("" ::: "memory");
            }
        }
#pragma unroll 1
        for (int ti = 0; ti < 4; ++ti) {
            const int tok = tok0 + 16 * ti + r16;
            bf16x8 qf[4], af[2];
#pragma unroll
            for (int kk = 0; kk < 4; ++kk) qf[kk] = ld16g(QT + (size_t)tok * D_ + hh * 128 + 32 * kk + 8 * g);
#pragma unroll
            for (int k2 = 0; k2 < 2; ++k2) { const u32x2v lo = *(const GAS u32x2v*)(AI + ((size_t)u * 64 + 16 * ti + r16) * 64 + 32 * k2 + 4 * g), hi = *(const GAS u32x2v*)(AI + ((size_t)u * 64 + 16 * ti + r16) * 64 + 32 * k2 + 16 + 4 * g);
                const v4u pk = {lo.x, lo.y, hi.x, hi.y}; af[k2] = __builtin_bit_cast(bf16x8, pk); }
            f32x4 acc[8]; float ss = 0.f;
#pragma unroll
            for (int d2t = 0; d2t < 8; ++d2t) {
                f32x4 Dv = Z4;
#pragma unroll
                for (int kk = 0; kk < 4; ++kk) { const bf16x8 sgf = ld16g(SG + ((size_t)uh * 128 + 16 * d2t + r16) * 128 + 32 * kk + 8 * g); Dv = MF16(sgf, qf[kk], Dv); }
#pragma unroll
                for (int k2 = 0; k2 < 2; ++k2) { const v4u pk = {vn[d2t][2 * k2][0], vn[d2t][2 * k2][1], vn[d2t][2 * k2 + 1][0], vn[d2t][2 * k2 + 1][1]}; Dv = MF16(__builtin_bit_cast(bf16x8, pk), af[k2], Dv); }
                acc[d2t] = Dv; ss += (Dv[0] * Dv[0] + Dv[1] * Dv[1]) + (Dv[2] * Dv[2] + Dv[3] * Dv[3]);
            }
            ss += __shfl_xor(ss, 16); ss += __shfl_xor(ss, 32);
            const float rms = __builtin_amdgcn_rsqf(ss * (1.0f / 128.0f) + RMS_EPS);
#pragma unroll
            for (int d2t = 0; d2t < 8; ++d2t) {
                const u32x2v z = *(const GAS u32x2v*)(PO + (size_t)tok * OIN + 3072 + hh * 128 + 16 * d2t + 4 * g); const f32x4 gn = *(const GAS f32x4*)(onorm + 16 * d2t + 4 * g);
                st8(mix + (size_t)tok * D_ + hh * 128 + 16 * d2t + 4 * g, acc[d2t][0] * rms * gn[0] * silu(bflo(z.x)), acc[d2t][1] * rms * gn[1] * silu(bfhi(z.x)),
                    acc[d2t][2] * rms * gn[2] * silu(bflo(z.y)), acc[d2t][3] * rms * gn[3] * silu(bfhi(z.y)));
            }
        }
    }
}

__device__ __forceinline__ void p_r1(const Frame& F, const Args& a, int L) {
    GAS unsigned char* ws = (GAS unsigned char*)a.ws; asm volatile("" : "+s"(ws)); int lane_ = F.lane; asm volatile("" : "+v"(lane_)); const int j = L >> 1, lane = lane_;
    const float* ssq = (const float*)(ws + WS_SSQA); const float* wr = (const float*)a.in[24] + (size_t)j * D_ * NEXP; const float* ln = (const float*)a.in[4] + L * D_;
    int* tok_e = (int*)(ws + WS_TOK + TOK_E); int* tok_r = (int*)(ws + WS_TOK + TOK_R); float* tok_g = (float*)(ws + WS_TOK + TOK_G);
    unsigned* gcount = (unsigned*)(ws + WS_CTL) + CW_CNT + 64 * j;
    LAS int* rt = (LAS int*)(F.lds + RT_OFF);
    if (F.tid < 16) rt[F.tid] = 0;
    __syncthreads();
    const GAS float* hG = (const GAS float*)a.out; const GAS float* wrG = (const GAS float*)wr; const GAS float* lnG = (const GAS float*)ln;
    float lnr[16];
#pragma unroll
    for (int i = 0; i < 16; ++i) lnr[i] = lnG[64 * i + lane];
#pragma unroll 1
    for (int t = F.gw; t < S_; t += 2 * F.NGW) {
        const int tb = t + F.NGW; const bool hasb = tb < S_; const int tbc = hasb ? tb : t;
        float xa[16], xb[16];
#pragma unroll
        for (int i = 0; i < 16; ++i) { xa[i] = hG[(size_t)t * D_ + 64 * i + lane]; xb[i] = hG[(size_t)tbc * D_ + 64 * i + lane]; }
        const float rsa = pg8::rstd_row(ssq, t), rsb = pg8::rstd_row(ssq, tbc);
        float acca[8], accb[8];
#pragma unroll
        for (int e = 0; e < 8; ++e) { acca[e] = 0.f; accb[e] = 0.f; }
#pragma unroll
        for (int i = 0; i < 16; ++i) { const int k = 64 * i + lane; const f32x4 w0 = *(const GAS f32x4*)(wrG + (size_t)k * 8), w1 = *(const GAS f32x4*)(wrG + (size_t)k * 8 + 4);
            const float x = xa[i] * lnr[i], y = xb[i] * lnr[i];
            acca[0] += x * w0[0]; acca[1] += x * w0[1]; acca[2] += x * w0[2]; acca[3] += x * w0[3]; acca[4] += x * w1[0]; acca[5] += x * w1[1]; acca[6] += x * w1[2]; acca[7] += x * w1[3];
            accb[0] += y * w0[0]; accb[1] += y * w0[1]; accb[2] += y * w0[2]; accb[3] += y * w0[3]; accb[4] += y * w1[0]; accb[5] += y * w1[1]; accb[6] += y * w1[2]; accb[7] += y * w1[3]; }
#pragma unroll
        for (int e = 0; e < 8; ++e) { acca[e] = wave_sum(acca[e]) * rsa; accb[e] = wave_sum(accb[e]) * rsb; }
#pragma unroll
        for (int half = 0; half < 2; ++half) {
            if (half == 1 && !hasb) break;
            const int tt = half ? tb : t; float acc[8];
#pragma unroll
            for (int e = 0; e < 8; ++e) acc[e] = half ? accb[e] : acca[e];
            int e0 = 0; float l0 = acc[0];
#pragma unroll
            for (int e = 1; e < 8; ++e) if (acc[e] > l0) { l0 = acc[e]; e0 = e; }
            int e1 = -1; float l1 = -INFINITY;
#pragma unroll
            for (int e = 0; e < 8; ++e) if (e != e0 && acc[e] > l1) { l1 = acc[e]; e1 = e; }
            const float g1 = 1.0f / (1.0f + expf(l0 - l1)), g0 = 1.0f - g1;
            if (lane == 0) {
                const int r0 = __hip_atomic_fetch_add(rt + e0, 1, __ATOMIC_RELAXED, __HIP_MEMORY_SCOPE_WORKGROUP), r1 = __hip_atomic_fetch_add(rt + e1, 1, __ATOMIC_RELAXED, __HIP_MEMORY_SCOPE_WORKGROUP);
                tok_e[2 * tt] = e0; tok_e[2 * tt + 1] = e1; tok_r[2 * tt] = r0; tok_r[2 * tt + 1] = r1; tok_g[2 * tt] = g0; tok_g[2 * tt + 1] = g1;
            }
        }
    }
    __syncthreads();
    if (F.tid < 8) rt[8 + F.tid] = (int)__hip_atomic_fetch_add(gcount + F.tid, (unsigned)rt[F.tid], __ATOMIC_RELAXED, __HIP_MEMORY_SCOPE_AGENT);
    __syncthreads();
#pragma unroll 1
    for (int t = F.gw; t < S_; t += F.NGW) if (lane < 2) { const int e = tok_e[2 * t + lane]; tok_r[2 * t + lane] += rt[8 + e]; }
    __syncthreads();
}
__device__ __forceinline__ int moe_pstart(const unsigned* gcount, int e) {
    int ps = 0;
#pragma unroll
    for (int q = 0; q < 8; ++q) { const int c = (int)gcount[q]; if (q < e) ps += ((c + 255) >> 8) << 8; }
    return ps;
}
__device__ __forceinline__ void p_r2(const Frame& F, const Args& a, int L) {
    GAS unsigned char* ws = (GAS unsigned char*)a.ws; asm volatile("" : "+s"(ws)); int lane_ = F.lane; asm volatile("" : "+v"(lane_)); const int j = L >> 1, lane = lane_;
    const float* ssq = (const float*)(ws + WS_SSQA);
    const int* tok_e = (const int*)(ws + WS_TOK + TOK_E); const int* tok_r = (const int*)(ws + WS_TOK + TOK_R); const float* tok_g = (const float*)(ws + WS_TOK + TOK_G);
    int* dst = (int*)(ws + WS_TOK + TOK_DST); float* gpad = (float*)(ws + WS_TOK + TOK_GPAD);
    const unsigned* gcount = (const unsigned*)(ws + WS_CTL) + CW_CNT + 64 * j; bf16* XS = (bf16*)(ws + WS_ARENA + AR_XS);
    int pst[8]; { int ps = 0;
#pragma unroll
        for (int q = 0; q < 8; ++q) { pst[q] = ps; ps += (((int)gcount[q] + 255) >> 8) << 8; } }
    const GAS float* hG = (const GAS float*)a.out;
#pragma unroll 1
    for (int t0 = F.gw; t0 < S_; t0 += 4 * F.NGW) {
        int tt[4], da[4], db[4]; float rs[4], ga[4], gb[4]; f32x4 v[4][4];
#pragma unroll
        for (int u = 0; u < 4; ++u) { const int t = t0 + u * F.NGW; tt[u] = t < S_ ? t : t0;
#pragma unroll
            for (int q = 0; q < 4; ++q) v[u][q] = *((const GAS f32x4*)(hG + (size_t)tt[u] * D_) + 64 * q + lane); }
#pragma unroll
        for (int u = 0; u < 4; ++u) { const int t = tt[u]; rs[u] = pg8::rstd_row(ssq, t);
            const int ea = tok_e[2 * t], eb = tok_e[2 * t + 1]; int pa = 0, pb = 0;
#pragma unroll
            for (int q = 0; q < 8; ++q) { pa = (q == ea) ? pst[q] : pa; pb = (q == eb) ? pst[q] : pb; }
            da[u] = pa + tok_r[2 * t]; db[u] = pb + tok_r[2 * t + 1]; ga[u] = tok_g[2 * t]; gb[u] = tok_g[2 * t + 1]; }
#pragma unroll
        for (int u = 0; u < 4; ++u) { if (t0 + u * F.NGW >= S_) break; const int t = tt[u];
            if (lane == 0) { dst[2 * t] = da[u]; dst[2 * t + 1] = db[u]; gpad[da[u]] = ga[u]; gpad[db[u]] = gb[u]; }
#pragma unroll
            for (int q = 0; q < 4; ++q) { const f32x4 x = v[u][q] * rs[u]; u32x2v o; o.x = cvtpk(x[0], x[1]); o.y = cvtpk(x[2], x[3]);
                *((GAS u32x2v*)(XS + (size_t)da[u] * D_) + 64 * q + lane) = o; *((GAS u32x2v*)(XS + (size_t)db[u] * D_) + 64 * q + lane) = o; } }
    }
}
__device__ __forceinline__ int moe_blocks(const Frame& F, const Args& a, int L) {
    const unsigned* gcount = (const unsigned*)(a.ws + WS_CTL) + CW_CNT + 64 * (L >> 1);
    LAS int* blk = (LAS int*)(F.lds + BLKE_OFF);
    int nb_tot = 0, mine = 7;
#pragma unroll
    for (int q = 0; q < 8; ++q) { const int nb = ((int)gcount[q] + 255) >> 8; if (F.tid >= nb_tot && F.tid < nb_tot + nb) mine = q; nb_tot += nb; }
    __syncthreads();
    if (F.tid < 160) blk[F.tid] = mine;
    __syncthreads();
    return nb_tot;
}
__device__ __forceinline__ void p_combine(const Frame& F, const Args& a) {
    GAS unsigned char* ws = (GAS unsigned char*)a.ws; asm volatile("" : "+s"(ws)); int lane_ = F.lane; asm volatile("" : "+v"(lane_)); const int lane = lane_;
    const int* dst = (const int*)(ws + WS_TOK + TOK_DST); const bf16* Y = (const bf16*)(ws + WS_ARENA + AR_Y); bf16* hb = (bf16*)(ws + WS_HBF); float* ssq = (float*)(ws + WS_SSQA);
    const GAS float* hG = (const GAS float*)a.out;
#pragma unroll 1
    for (int t0 = F.gw; t0 < S_; t0 += 2 * F.NGW) {
        int tt[2], da[2], db[2]; f32x4 v[2][4]; u32x2v ya[2][4], yb[2][4];
#pragma unroll
        for (int u = 0; u < 2; ++u) { const int t = t0 + u * F.NGW; tt[u] = t < S_ ? t : t0; da[u] = dst[2 * tt[u]]; db[u] = dst[2 * tt[u] + 1];
#pragma unroll
            for (int q = 0; q < 4; ++q) v[u][q] = *((const GAS f32x4*)(hG + (size_t)tt[u] * D_) + 64 * q + lane); }
#pragma unroll
        for (int u = 0; u < 2; ++u)
#pragma unroll
            for (int q = 0; q < 4; ++q) { ya[u][q] = *((const GAS u32x2v*)(Y + (size_t)da[u] * D_) + 64 * q + lane); yb[u][q] = *((const GAS u32x2v*)(Y + (size_t)db[u] * D_) + 64 * q + lane); }
#pragma unroll
        for (int u = 0; u < 2; ++u) { if (t0 + u * F.NGW >= S_) break; const int t = tt[u]; float ss = 0.f;
#pragma unroll
            for (int q = 0; q < 4; ++q) { f32x4 x = v[u][q];
                x[0] += bflo(ya[u][q].x) + bflo(yb[u][q].x); x[1] += bfhi(ya[u][q].x) + bfhi(yb[u][q].x); x[2] += bflo(ya[u][q].y) + bflo(yb[u][q].y); x[3] += bfhi(ya[u][q].y) + bfhi(yb[u][q].y);
                *((GAS f32x4*)(a.out + (size_t)t * D_) + 64 * q + lane) = x; ss += (x[0] * x[0] + x[1] * x[1]) + (x[2] * x[2] + x[3] * x[3]);
                u32x2v o; o.x = cvtpk(x[0], x[1]); o.y = cvtpk(x[2], x[3]); *((GAS u32x2v*)(hb + (size_t)t * D_) + 64 * q + lane) = o; }
            ss = wave_sum(ss);
            if (lane < 16) ssq[(size_t)t * 16 + lane] = (lane == 0) ? ss : 0.f; }
    }
}
__device__ __forceinline__ void p_final(const Frame& F, const Args& a) {
    GAS unsigned char* ws = (GAS unsigned char*)a.ws; asm volatile("" : "+s"(ws)); int lane_ = F.lane; asm volatile("" : "+v"(lane_)); const int lane = lane_; const float* ssq = (const float*)(ws + WS_SSQB); const float* ln = (const float*)a.in[6];
#pragma unroll 1
    for (int t = F.gw; t < S_; t += F.NGW) { const float rs = pg8::rstd_row(ssq, t);
#pragma unroll
        for (int q = 0; q < 4; ++q) { GAS f32x4* hp = (GAS f32x4*)(a.out + (size_t)t * D_) + 64 * q + lane; const f32x4 gq = *((const GAS f32x4*)ln + 64 * q + lane); *hp = (*hp) * rs * gq; } }
}
__device__ __forceinline__ void p_moe_weights(const Frame& F, const Args& a, int L, int w0, int nw) {
    LAS float* scr = (LAS float*)(F.lds + F.wave * WAVE_LDS);
    int base = 0;
#pragma unroll 1
    for (int id = 0; id < 24; ++id) { const MatD m = moe_mat(a, L >> 1, id);
        int first = (w0 - base) % nw; if (first < 0) first += nw;
#pragma unroll 1
        for (int it = first; it < m.items; it += nw) xpose_item(m.W, m.ldw, m.K, m.N, m.gain, m.WT, m.ilv, scr, it, F.lane);
        base += m.items; }
}

constexpr int P_PRO = 0, P_FINAL = 81, LP_ROT = 16, LP_G1B = 17, LP_G2B = 18, LPN = 20, LP_PROJ = 0, LP_ATT = 1, LP_MIXPREP = 2, LP_GA = 3, LP_G1 = 4, LP_G2 = 5, LP_G3 = 6, LP_OUT = 7, LP_UP = 8, LP_DOWN = 9, LP_R1 = 10, LP_R2 = 11, LP_M1 = 12, LP_M2 = 13, LP_COMB = 14, LP_PLE = 15;

#ifndef PH_MASK
#define PH_MASK 0xffffffffull
#endif
#define IN(k) (lo <= (k) && (k) < hi)
#define INL(lp) ((((unsigned long long)(PH_MASK) >> (lp)) & 1) && lo <= pb + (lp) && pb + (lp) < hi)
#define SEAM() do { if (args.use_bar) xcd_barrier(bar); } while (0)
#ifndef REP_LP
#define REP_LP -1
#endif
#ifndef REP_L
#define REP_L -1
#endif
#ifndef REP_N
#define REP_N 2
#endif
#define REPS(lp) ((L == (REP_L) && (lp) == (REP_LP)) ? 1 + (REP_N) : 1)
#if REP_LP >= 0
#define REPLOOP(lp) _Pragma("unroll 1") for (int rep_ = 0; rep_ < REPS(lp); ++rep_)
#else
#define REPLOOP(lp)
#endif
#define PHASE_WS() GAS unsigned char* ws = (GAS unsigned char*)ws0; asm volatile("" : "+s"(ws)); bf16* HBF = (bf16*)(ws + WS_HBF); bf16* MIX = (bf16*)(ws + WS_MIX); bf16* PP = (bf16*)(ws + WS_PP); float* SSQA = (float*)(ws + WS_SSQA); float* SSQB = (float*)(ws + WS_SSQB); (void)HBF; (void)MIX; (void)PP; (void)SSQA; (void)SSQB
template <int L> __device__ __forceinline__ void run_layer(const Frame& F, const Args& args, unsigned char* lds, const XcdBarrier& bar, unsigned char* ws0, const int lo, const int hi, const int cid) {
        const int pb = 1 + LPN * L, j = L >> 1; const bool odd = (L & 1) != 0;
        REPLOOP(LP_PROJ) if (INL(LP_PROJ)) { PHASE_WS();
            if (!odd) {
                pg8::Gemm gm{HBF, (const bf16*)(ws + WS_WINE) + (size_t)j * EIN * D_, S_, EIN, D_, 0}; pg8::StaticOrder So; So.init(S_, EIN, F.G, cid);
                pg8::EpiBf16 E{(bf16*)(ws + WS_ARENA + AR_PE), EIN, SSQB, pg8::C2, 512};
                pg8::gemm_phase<pg8::EpiBf16, pg8::StaticOrder, true, true>(F.lds + RING_OFF, gm, So, E);
            } else {
                pg8::Gemm gm{HBF, (const bf16*)(ws + WS_WINO) + (size_t)j * OIN * D_, S_, OIN, D_, 0}; pg8::StaticOrder So; So.init(S_, OIN, F.G, cid);
                pg8::EpiBf16 E{(bf16*)(ws + WS_ARENA + AR_PO), OIN, SSQB, 1.0f, 0};
                pg8::gemm_phase<pg8::EpiBf16, pg8::StaticOrder, true, true>(F.lds + RING_OFF, gm, So, E);
            }
            {
                pg8::Gemm gm{(const bf16*)(ws + WS_PBF) + (size_t)L * S_ * PLE, (const bf16*)(ws + WS_WP) + (size_t)L * D_ * PLE, S_, D_, PLE, 0}; pg8::StaticOrder So; So.init(S_, D_, F.G, cid);
                pg8::EpiBf16 E{PP, D_, nullptr, 1.0f, 0};
                pg8::gemm_phase<pg8::EpiBf16, pg8::StaticOrder, true, true>(F.lds + RING_OFF, gm, So, E);
            }
            if (odd) p_ab(F, args, L);
            SEAM();
        }
        if (!odd) {
            REPLOOP(LP_ROT) if (INL(LP_ROT)) { PHASE_WS(); p_rot(F, args); SEAM(); }
            REPLOOP(LP_ATT) if (INL(LP_ATT)) { PHASE_WS(); attn_body::attn_phase<8>((char*)lds + RING_OFF, (const attn_body::bf16*)(ws + WS_ARENA + AR_PE), (attn_body::bf16*)(ws + WS_ARENA + AR_AO), F.vcu, F.G); SEAM(); }
            REPLOOP(LP_MIXPREP) if (INL(LP_MIXPREP)) { PHASE_WS(); p_mixprep(F, args, L); SEAM(); }
        } else {
            REPLOOP(LP_GA) if (INL(LP_GA)) { PHASE_WS(); p_ga(F, args, L); asm volatile("s_waitcnt vmcnt(0)" ::: "memory"); __syncthreads(); p_g1(F, args); asm volatile("s_waitcnt vmcnt(0)" ::: "memory"); __syncthreads(); p_g1b(F, args); SEAM(); }
            REPLOOP(LP_G2) if (INL(LP_G2)) { PHASE_WS();
                const int nscan = F.G < 64 ? F.G : 64;
#ifdef PROBE_NOCONV
                if (!args.use_bar) { if (F.vcu < nscan) p_g2<64, 4>(F, args, (const bf16*)(ws + WS_ARENA + AR_MPC), (const bf16*)(ws + WS_ARENA + AR_NTC), (const float*)(ws + WS_TOK + TOK_DNC)); } else
#endif
#ifdef PROBE_NOSCAN
                if (!args.use_bar) { if (F.vcu >= nscan) p_moe_weights(F, args, L, (F.vcu - nscan) * NWAVES + F.wave, (F.G - nscan) * NWAVES); } else
#endif
                if (F.vcu < nscan) p_g2<64, 4>(F, args, (const bf16*)(ws + WS_ARENA + AR_MPC), (const bf16*)(ws + WS_ARENA + AR_NTC), (const float*)(ws + WS_TOK + TOK_DNC));
                else p_moe_weights(F, args, L, (F.vcu - nscan) * NWAVES + F.wave, (F.G - nscan) * NWAVES);
                if (F.G <= 64) p_moe_weights(F, args, L, F.gw, F.NGW);
                SEAM();
            }
            REPLOOP(LP_G3) if (INL(LP_G3)) { PHASE_WS(); p_g2b(F, args); asm volatile("s_waitcnt vmcnt(0)" ::: "memory"); __syncthreads(); p_g3(F, args, L); SEAM(); }
        }
        REPLOOP(LP_OUT) if (INL(LP_OUT)) { PHASE_WS();
            const bf16* Wo = odd ? (const bf16*)(ws + WS_WOUTO) + (size_t)j * D_ * D_ : (const bf16*)(ws + WS_WOUTE) + (size_t)j * D_ * D_;
            pg8::Gemm gm{MIX, Wo, S_, D_, D_, 0}; pg8::StaticOrder So; So.init(S_, D_, F.G, cid);
            pg8::EpiResid E{args.out, HBF, SSQA};
            pg8::gemm_phase<pg8::EpiResid, pg8::StaticOrder, true, true>(F.lds + RING_OFF, gm, So, E);
            SEAM();
        }
        if (!odd) {
            REPLOOP(LP_UP) if (INL(LP_UP)) { PHASE_WS();
                pg8::Gemm gm{HBF, (const bf16*)(ws + WS_W13D) + (size_t)j * 2 * DFF * D_, S_, 2 * DFF, D_, 0}; pg8::StaticOrder So; So.init(S_, 2 * DFF, F.G, cid);
                pg8::EpiSwiglu E{(bf16*)(ws + WS_ARENA + AR_ACT), SSQA};
                pg8::gemm_phase<pg8::EpiSwiglu, pg8::StaticOrder, true, true>(F.lds + RING_OFF, gm, So, E);
                SEAM();
            }
            REPLOOP(LP_DOWN) if (INL(LP_DOWN)) { PHASE_WS();
                pg8::Gemm gm{(const bf16*)(ws + WS_ARENA + AR_ACT), (const bf16*)(ws + WS_W2D) + (size_t)j * D_ * DFF, S_, D_, DFF, 0}; pg8::StaticOrder So; So.init(S_, D_, F.G, cid);
                pg8::EpiResid E{args.out, HBF, SSQA};
                pg8::gemm_phase<pg8::EpiResid, pg8::StaticOrder, true, true>(F.lds + RING_OFF, gm, So, E);
                SEAM();
            }
        } else {
            REPLOOP(LP_R1) if (INL(LP_R1)) { PHASE_WS(); p_r1(F, args, L); SEAM(); }
            REPLOOP(LP_R2) if (INL(LP_R2)) { PHASE_WS(); p_r2(F, args, L); SEAM(); }
            REPLOOP(LP_M1) if (INL(LP_M1)) { PHASE_WS();
                const int nb = moe_blocks(F, args, L);
                pg8::Gemm gm{(const bf16*)(ws + WS_ARENA + AR_XS), (const bf16*)(ws + WS_W13M), nb * 256, 2 * DFF, D_, (size_t)2 * DFF * D_ * 2}; pg8::MoeOrder So; So.init(nb * 256, 2 * DFF, F.G, cid); So.blk_e = (const LAS int*)(F.lds + BLKE_OFF);
                pg8::EpiSwiglu E{(bf16*)(ws + WS_ARENA + AR_ACT), nullptr};
                pg8::gemm_phase<pg8::EpiSwiglu, pg8::MoeOrder, true, true>(F.lds + RING_OFF, gm, So, E);
                SEAM();
            }
            REPLOOP(LP_M2) if (INL(LP_M2)) { PHASE_WS();
                const int nb = moe_blocks(F, args, L);
                pg8::Gemm gm{(const bf16*)(ws + WS_ARENA + AR_ACT), (const bf16*)(ws + WS_W2M), nb * 256, D_, DFF, (size_t)D_ * DFF * 2}; pg8::MoeOrder So; So.init(nb * 256, D_, F.G, cid); So.blk_e = (const LAS int*)(F.lds + BLKE_OFF);
                pg8::EpiMoeDown E{(bf16*)(ws + WS_ARENA + AR_Y), (const float*)(ws + WS_TOK + TOK_GPAD)};
                pg8::gemm_phase<pg8::EpiMoeDown, pg8::MoeOrder, true, true>(F.lds + RING_OFF, gm, So, E);
                SEAM();
            }
            REPLOOP(LP_COMB) if (INL(LP_COMB)) { PHASE_WS(); p_combine(F, args); SEAM(); }
        }
        REPLOOP(LP_PLE) if (INL(LP_PLE)) { PHASE_WS();
            pg8::Gemm gm{HBF, (const bf16*)(ws + WS_WG) + (size_t)L * D_ * D_, S_, D_, D_, 0}; pg8::StaticOrder So; So.init(S_, D_, F.G, cid);
            pg8::EpiPle E{args.out, HBF, SSQA, SSQB, PP};
            pg8::gemm_phase<pg8::EpiPle, pg8::StaticOrder, true, true>(F.lds + RING_OFF, gm, So, E);
            SEAM();
        }
    }

__global__ void __launch_bounds__(NWAVES * 64, 2) fwd(Args args) {
    extern __shared__ __attribute__((aligned(16))) unsigned char lds[];
    Frame F;
    F.lds = (LAS unsigned char*)lds; F.tid = threadIdx.x; F.lane = F.tid & 63; F.wave = __builtin_amdgcn_readfirstlane(F.tid >> 6);
    F.G = gridDim.x; { const int bx = blockIdx.x; F.vcu = (F.G % 8 == 0) ? (bx % 8) * (F.G / 8) + bx / 8 : bx; }
    F.gw = F.vcu * NWAVES + F.wave; F.NGW = F.G * NWAVES;
    unsigned char* ws0 = args.ws;
    for (int u = F.tid; u < (LDS_BYTES - LDSCTL_OFF) / 4; u += NWAVES * 64) ((LAS unsigned*)(F.lds + LDSCTL_OFF))[u] = 0u;
    __syncthreads();
    XcdBarrier bar; bar.bar = (unsigned*)(ws0 + WS_CTL) + CW_BAR; bar.x = 0; bar.st = nullptr;
    if (args.use_bar) bar = xcd_barrier_post((unsigned*)(ws0 + WS_CTL) + CW_BAR, (volatile LAS unsigned*)(F.lds + MISC_OFF));
    const int lo = args.ph_lo, hi = args.ph_hi;
    const int cid = (int)blockIdx.x;

    if ((((unsigned long long)(PH_MASK) >> 30) & 1) && IN(P_PRO)) { p_prologue(F, args); SEAM(); }

#ifdef FIXED_L
    run_layer<FIXED_L>(F, args, lds, bar, ws0, lo, hi, cid);
#else
    run_layer<0>(F, args, lds, bar, ws0, lo, hi, cid); run_layer<1>(F, args, lds, bar, ws0, lo, hi, cid); run_layer<2>(F, args, lds, bar, ws0, lo, hi, cid); run_layer<3>(F, args, lds, bar, ws0, lo, hi, cid);
#endif
    if ((((unsigned long long)(PH_MASK) >> 31) & 1) && IN(P_FINAL)) p_final(F, args);
#undef IN
#undef INL
#undef SEAM
}


#ifndef DBG
#define DBG 0
#endif
#if DBG
#ifndef DBG_ASLOT
#define DBG_ASLOT 9
#endif
#ifndef DBG_BSLOT
#define DBG_BSLOT 11
#endif
__global__ void dbg_scan(const void* p, size_t n, int is_f32, unsigned* slot) {
    unsigned cnt = 0;
    for (size_t i = (size_t)blockIdx.x * blockDim.x + threadIdx.x; i < n; i += (size_t)gridDim.x * blockDim.x) {
        const float v = is_f32 ? ((const float*)p)[i] : __uint_as_float(((unsigned)((const unsigned short*)p)[i]) << 16);
        if (!(fabsf(v) < 1e30f)) ++cnt; }
    if (cnt) atomicAdd(slot, cnt);
}
__global__ void dbg_fill(float* out, size_t n, const unsigned* slots, int nslots) {
    int first = -1; for (int i = 0; i < nslots; ++i) if (slots[i]) { first = i; break; }
    float c, V;
    if (first >= 0) { c = sqrtf((float)(10 + first) * 1e6f); V = c; }
    else { const float ea = fmaxf(__uint_as_float(slots[256 + DBG_ASLOT]), 1e-5f), eb = fmaxf(__uint_as_float(slots[256 + DBG_BSLOT]), 1e-5f);
        c = sqrtf((10.f + fminf(60.f, rintf(10.f * (log10f(ea) + 5.f)))) * 1e4f); V = (50.f + rintf(10.f * log10f(eb))) * 1e3f; }
    for (size_t i = (size_t)blockIdx.x * blockDim.x + threadIdx.x; i < n; i += (size_t)gridDim.x * blockDim.x) out[i] = (i == 0) ? V : c;
}
__device__ __forceinline__ float dbg_bf(const unsigned short* p, size_t i) { return __uint_as_float(((unsigned)p[i]) << 16); }
__device__ __forceinline__ float dbg_rstd(const float* ssq, int row) { float s = 0.f; for (int i = 0; i < 16; ++i) s += ssq[(size_t)row * 16 + i]; return 1.0f / sqrtf(s / 1024.0f + 1e-6f); }
__device__ __forceinline__ float dbg_blocksum(float v, float* red) {
    __syncthreads(); red[threadIdx.x] = v; __syncthreads();
    for (int o = 128; o > 0; o >>= 1) { if ((int)threadIdx.x < o) red[threadIdx.x] += red[threadIdx.x + o]; __syncthreads(); }
    const float r = red[0]; __syncthreads(); return r;
}
__device__ __forceinline__ void dbg_report(unsigned* slot, float num, float den) { if (threadIdx.x == 0) atomicMax(slot, __float_as_uint(sqrtf(num / fmaxf(den, 1e-20f)))); }
__global__ void chk_ffn(const float* hpre, const float* hpost, const float* ssq, const float* ln, const float* wr, const float* w1, const float* w3, const float* w2, int moe, unsigned* slot) {
    __shared__ float xn[1024]; __shared__ float hid[3584]; __shared__ float red[256]; __shared__ float lg[8];
    const int t = (blockIdx.x * 997 + 13) % S_, tid = threadIdx.x;
    const float rs = dbg_rstd(ssq, t);
    for (int k = tid; k < 1024; k += 256) xn[k] = hpre[(size_t)t * 1024 + k] * rs * ln[k];
    __syncthreads();
    int e0 = 0, e1 = 0; float g0 = 1.f, g1 = 0.f;
    if (moe) {
        if (tid < 8) { float s = 0.f; for (int k = 0; k < 1024; ++k) s += xn[k] * wr[(size_t)k * 8 + tid]; lg[tid] = s; }
        __syncthreads();
        float l0 = lg[0]; for (int e = 1; e < 8; ++e) if (lg[e] > l0) { l0 = lg[e]; e0 = e; }
        float l1 = -1e30f; e1 = -1; for (int e = 0; e < 8; ++e) if (e != e0 && lg[e] > l1) { l1 = lg[e]; e1 = e; }
        const float m0 = expf(l0 - l0), m1 = expf(l1 - l0); g0 = m0 / (m0 + m1); g1 = m1 / (m0 + m1);
    }
    float acc[4] = {0.f, 0.f, 0.f, 0.f};
    for (int pass = 0; pass < (moe ? 2 : 1); ++pass) {
        const int e = pass == 0 ? e0 : e1; const float gt = pass == 0 ? g0 : g1;
        const float* W1 = w1 + (size_t)e * 1024 * 3584; const float* W3 = w3 + (size_t)e * 1024 * 3584; const float* W2 = w2 + (size_t)e * 3584 * 1024;
        __syncthreads();
        for (int f = tid; f < 3584; f += 256) { float a = 0.f, b = 0.f; for (int k = 0; k < 1024; ++k) { a += xn[k] * W1[(size_t)k * 3584 + f]; b += xn[k] * W3[(size_t)k * 3584 + f]; } hid[f] = a / (1.f + expf(-a)) * b; }
        __syncthreads();
        for (int q = 0; q < 4; ++q) { const int c = tid + 256 * q; float y = 0.f; for (int f = 0; f < 3584; ++f) y += hid[f] * W2[(size_t)f * 1024 + c]; acc[q] += gt * y; }
    }
    float num = 0.f, den = 0.f;
    for (int q = 0; q < 4; ++q) { const int c = tid + 256 * q; const float ex = acc[q], got = hpost[(size_t)t * 1024 + c] - hpre[(size_t)t * 1024 + c]; num += (got - ex) * (got - ex); den += ex * ex; }
    num = dbg_blocksum(num, red); den = dbg_blocksum(den, red);
    dbg_report(slot, num, den);
}
__global__ void chk_ple(const float* hpre, const float* hpost, const float* ssq, const float* ln, const float* wg, const float* p, const float* wp, unsigned* slot) {
    __shared__ float xn[1024]; __shared__ float red[256];
    const int t = (blockIdx.x * 997 + 13) % S_, tid = threadIdx.x; const float rs = dbg_rstd(ssq, t);
    for (int k = tid; k < 1024; k += 256) xn[k] = hpre[(size_t)t * 1024 + k] * rs * ln[k];
    __syncthreads();
    float num = 0.f, den = 0.f;
    for (int q = 0; q < 4; ++q) { const int c = tid + 256 * q; float a = 0.f, b = 0.f; for (int k = 0; k < 1024; ++k) a += xn[k] * wg[(size_t)k * 1024 + c]; for (int k = 0; k < 256; ++k) b += p[(size_t)t * 256 + k] * wp[(size_t)k * 1024 + c];
        const float ex = b / (1.f + expf(-a)), got = hpost[(size_t)t * 1024 + c] - hpre[(size_t)t * 1024 + c]; num += (got - ex) * (got - ex); den += ex * ex; }
    num = dbg_blocksum(num, red); den = dbg_blocksum(den, red); dbg_report(slot, num, den);
}
constexpr int DBG_TC = 512;
__global__ void chk_gdn_proj(const float* h, const float* ssq, const float* ln, const float* W, int hh, float* raw) {
    const int idx = blockIdx.x * blockDim.x + threadIdx.x; if (idx >= DBG_TC * 514) return;
    const int t = idx / 514, c = idx % 514;
    const int col = c < 128 ? hh * 128 + c : c < 256 ? 1024 + hh * 128 + (c - 128) : c < 384 ? 2048 + hh * 128 + (c - 256) : c < 512 ? 3072 + hh * 128 + (c - 384) : c == 512 ? 4096 + hh : 4104 + hh;
    const float rs = dbg_rstd(ssq, t); float s = 0.f;
    for (int k = 0; k < 1024; ++k) s += h[(size_t)t * 1024 + k] * ln[k] * W[(size_t)k * OIN_SRC + col];
    raw[(size_t)t * 514 + c] = s * rs;
}
__global__ void chk_gdn_rec(const float* raw, const float* cw, const float* alog, const float* dtb, const float* onorm, int hh, const unsigned short* mix, unsigned* slot) {
    extern __shared__ float sm[];
    float* Sm = sm; float* q = sm + 128 * 129; float* kk = q + 128; float* v = kk + 128; float* kv = v + 128; float* dl = kv + 128; float* o = dl + 128; float* red = o + 128;
    const int tid = threadIdx.x;
    for (int i = tid; i < 128 * 129; i += 256) Sm[i] = 0.f;
    __syncthreads();
    float worst = 0.f;
    for (int t = 0; t < DBG_TC; ++t) {
        if (tid < 128) { const int d = tid; float aq = 0.f, ak = 0.f, av = 0.f;
            for (int jj = 0; jj < 4; ++jj) { const int r = t - 3 + jj; if (r >= 0) { aq += cw[jj * 3072 + hh * 128 + d] * raw[(size_t)r * 514 + d]; ak += cw[jj * 3072 + 1024 + hh * 128 + d] * raw[(size_t)r * 514 + 128 + d]; av += cw[jj * 3072 + 2048 + hh * 128 + d] * raw[(size_t)r * 514 + 256 + d]; } }
            q[d] = aq / (1.f + expf(-aq)); kk[d] = ak / (1.f + expf(-ak)); v[d] = av / (1.f + expf(-av)); }
        __syncthreads();
        const float sq = dbg_blocksum(tid < 128 ? q[tid] * q[tid] : 0.f, red), sk = dbg_blocksum(tid < 128 ? kk[tid] * kk[tid] : 0.f, red);
        if (tid < 128) { q[tid] *= 1.0f / sqrtf(sq + 1e-6f) * 0.08838834764831845f; kk[tid] *= 1.0f / sqrtf(sk + 1e-6f); }
        const float bb = raw[(size_t)t * 514 + 512], aa = raw[(size_t)t * 514 + 513];
        const float beta = 1.f / (1.f + expf(-bb)); const float z = aa + dtb[hh]; const float g = -expf(alog[hh]) * (z > 20.f ? z : log1pf(expf(z))); const float alpha = expf(g);
        __syncthreads();
        for (int i = tid; i < 128 * 128; i += 256) { const int d = i >> 7, j = i & 127; Sm[d * 129 + j] *= alpha; }
        __syncthreads();
        if (tid < 128) { float s = 0.f; for (int d = 0; d < 128; ++d) s += kk[d] * Sm[d * 129 + tid]; dl[tid] = beta * (v[tid] - s); }
        __syncthreads();
        for (int i = tid; i < 128 * 128; i += 256) { const int d = i >> 7, j = i & 127; Sm[d * 129 + j] += kk[d] * dl[j]; }
        __syncthreads();
        if (tid < 128) { float s = 0.f; for (int d = 0; d < 128; ++d) s += q[d] * Sm[d * 129 + tid]; o[tid] = s; }
        __syncthreads();
        const float so = dbg_blocksum(tid < 128 ? o[tid] * o[tid] : 0.f, red); const float rms = 1.0f / sqrtf(so / 128.f + 1e-6f);
        float num = 0.f, den = 0.f;
        if (tid < 128) { const float zz = raw[(size_t)t * 514 + 384 + tid]; const float ex = o[tid] * rms * onorm[tid] * (zz / (1.f + expf(-zz))); const float got = dbg_bf(mix, (size_t)t * 1024 + hh * 128 + tid); num = (got - ex) * (got - ex); den = ex * ex; }
        num = dbg_blocksum(num, red); den = dbg_blocksum(den, red);
        worst = fmaxf(worst, sqrtf(num / fmaxf(den, 1e-20f)));
    }
    if (tid == 0) atomicMax(slot, __float_as_uint(worst));
}

__global__ void chk_even_kv(const float* h, const float* ssq, const float* ln, const float* W, float* KV) {
    const size_t idx = (size_t)blockIdx.x * blockDim.x + threadIdx.x; if (idx >= (size_t)S_ * 1024) return;
    const int t = (int)(idx >> 10), c = (int)(idx & 1023); const float rs = dbg_rstd(ssq, t); float s = 0.f;
    for (int k = 0; k < 1024; ++k) s += h[(size_t)t * 1024 + k] * ln[k] * W[(size_t)k * EIN + 512 + c];
    KV[idx] = s * rs;
}
__global__ void chk_even_mix(const float* h, const float* ssq, const float* ln, const float* W, const float* KV, const int* pos, const float* lq1, const float* lk1, const float* lq2, const float* lk2, const float* subg, const float* cw,
                             float lam0, const unsigned short* PE, const unsigned short* AO, const unsigned short* MIXb, unsigned* slot) {
    __shared__ float q[2][64]; __shared__ float p[128]; __shared__ float red[256]; __shared__ float o2[2][128]; __shared__ float hn[1024];
    const int toks[6] = {5, 200, 1000, 4097, 9000, 16383};
    const int t = toks[blockIdx.x / 4], hh = blockIdx.x % 4, tid = threadIdx.x;
    auto bsum = [&](float v) { __syncthreads(); red[tid] = v; __syncthreads(); for (int o = 64; o > 0; o >>= 1) { if (tid < o) red[tid] += red[tid + o]; __syncthreads(); } const float r = red[0]; __syncthreads(); return r; };
    auto bmax = [&](float v) { __syncthreads(); red[tid] = v; __syncthreads(); for (int o = 64; o > 0; o >>= 1) { if (tid < o) red[tid] = fmaxf(red[tid], red[tid + o]); __syncthreads(); } const float r = red[0]; __syncthreads(); return r; };
    auto invf = [&](int i) { return exp2f(-(float)i * (18.931568569324174f / 8.0f)); };
    const float rs = dbg_rstd(ssq, t);
    for (int k = tid; k < 1024; k += 128) hn[k] = h[(size_t)t * 1024 + k] * rs * ln[k];
    __syncthreads();
    { const int m = tid >> 6, d = tid & 63, col = (2 * hh + m) * 64 + d; float s = 0.f; for (int k = 0; k < 1024; ++k) s += hn[k] * W[(size_t)k * EIN + col]; q[m][d] = s; }
    __syncthreads();
    float qr;
    { const int m = tid >> 6, d = tid & 63; float v = q[m][d];
      if (d < 16) { const int i = d & 7; const float ang = (float)pos[t] * invf(i); const float c = cosf(ang), s = sinf(ang); v = d < 8 ? q[m][d] * c - q[m][d + 8] * s : q[m][d] * c + q[m][d - 8] * s; }
      qr = v * pg8::C2; }
    __syncthreads(); q[tid >> 6][tid & 63] = qr; __syncthreads();
    float num = 0.f, den = 0.f;
    { const int m = tid >> 6, d = tid & 63; const float got = dbg_bf(PE, (size_t)t * EIN + (2 * hh + m) * 64 + d); const float e2 = (got - qr) * (got - qr), r2 = qr * qr; num += e2; den += r2;
      const float na = bsum(d >= 16 ? e2 : 0.f), da = bsum(d >= 16 ? r2 : 0.f), nb = bsum(d < 16 ? e2 : 0.f), db = bsum(d < 16 ? r2 : 0.f);
      if (tid == 0) { atomicMax(slot + 4, __float_as_uint(sqrtf(na / fmaxf(da, 1e-20f)))); atomicMax(slot + 5, __float_as_uint(sqrtf(nb / fmaxf(db, 1e-20f)))); } }
    { const int m = tid >> 6, d = tid & 63; const float* kr = KV + (size_t)t * 1024 + (2 * hh + m) * 64; float v = kr[d];
      if (d < 16) { const int i = d & 7; const float ang = (float)pos[t] * invf(i); const float c = cosf(ang), s = sinf(ang); v = d < 8 ? kr[d] * c - kr[d + 8] * s : kr[d] * c + kr[d - 8] * s; }
      const float got = dbg_bf(PE, (size_t)t * EIN + 512 + (2 * hh + m) * 64 + d); const float e2 = (got - v) * (got - v), r2 = v * v; num += e2; den += r2;
      const float na = bsum(d >= 16 ? e2 : 0.f), da = bsum(d >= 16 ? r2 : 0.f), nb = bsum(d < 16 ? e2 : 0.f), db = bsum(d < 16 ? r2 : 0.f);
      const float vv = KV[(size_t)t * 1024 + 512 + hh * 128 + tid], gv = dbg_bf(PE, (size_t)t * EIN + 1024 + hh * 128 + tid); const float e3 = (gv - vv) * (gv - vv), r3 = vv * vv; num += e3; den += r3;
      const float nc = bsum(e3), dc = bsum(r3);
      if (tid == 0) { atomicMax(slot + 6, __float_as_uint(sqrtf(na / fmaxf(da, 1e-20f)))); atomicMax(slot + 7, __float_as_uint(sqrtf(nb / fmaxf(db, 1e-20f)))); atomicMax(slot + 8, __float_as_uint(sqrtf(nc / fmaxf(dc, 1e-20f)))); } }
    num = bsum(num); den = bsum(den); if (tid == 0) atomicMax(slot + 0, __float_as_uint(sqrtf(num / fmaxf(den, 1e-20f))));
    for (int m = 0; m < 2; ++m) {
        float mx = -1e30f;
        for (int j0 = 0; j0 <= t; j0 += 128) { const int j = j0 + tid; float s = -1e30f;
            if (j <= t) { const float* kr = KV + (size_t)j * 1024 + (2 * hh + m) * 64; s = 0.f;
                for (int d = 0; d < 64; ++d) { float kv = kr[d]; if (d < 16) { const int i = d & 7; const float ang = (float)pos[j] * invf(i); const float c = cosf(ang), sn = sinf(ang); kv = d < 8 ? kr[d] * c - kr[d + 8] * sn : kr[d] * c + kr[d - 8] * sn; } s += q[m][d] * kv; } }
            mx = fmaxf(mx, s); }
        mx = bmax(mx);
        float l = 0.f, acc = 0.f;
        for (int j0 = 0; j0 <= t; j0 += 128) { const int j = j0 + tid; float pe = 0.f;
            if (j <= t) { const float* kr = KV + (size_t)j * 1024 + (2 * hh + m) * 64; float s = 0.f;
                for (int d = 0; d < 64; ++d) { float kv = kr[d]; if (d < 16) { const int i = d & 7; const float ang = (float)pos[j] * invf(i); const float c = cosf(ang), sn = sinf(ang); kv = d < 8 ? kr[d] * c - kr[d + 8] * sn : kr[d] * c + kr[d - 8] * sn; } s += q[m][d] * kv; }
                pe = exp2f(s - mx); }
            __syncthreads(); p[tid] = pe; __syncthreads();
            l += pe;
            const int nj = min(128, t + 1 - j0);
            for (int i = 0; i < nj; ++i) acc += p[i] * KV[(size_t)(j0 + i) * 1024 + 512 + hh * 128 + tid]; }
        l = bsum(l);
        o2[m][tid] = acc / l;
    }
    __syncthreads();
    { float n2 = 0.f, d2 = 0.f;
      for (int m = 0; m < 2; ++m) { const float ex = o2[m][tid], got = dbg_bf(AO, (size_t)t * 1024 + hh * 256 + m * 128 + tid); n2 += (got - ex) * (got - ex); d2 += ex * ex; }
      n2 = bsum(n2); d2 = bsum(d2); if (tid == 0) atomicMax(slot + 1, __float_as_uint(sqrtf(n2 / fmaxf(d2, 1e-20f)))); }
    float s1 = 0.f, s2 = 0.f; for (int i = 0; i < 64; ++i) { s1 += lq1[i] * lk1[i]; s2 += lq2[i] * lk2[i]; }
    const float lam = expf(s1) - expf(s2) + lam0;
    const float dv = o2[0][tid] - lam * o2[1][tid]; const float ssd = bsum(dv * dv); const float ex = dv / sqrtf(ssd / 128.f + 1e-5f) * subg[tid] * (1.f - lam0);
    { const float got = dbg_bf(MIXb, (size_t)t * 1024 + hh * 128 + tid); float n2 = (got - ex) * (got - ex), d2 = ex * ex; n2 = bsum(n2); d2 = bsum(d2); if (tid == 0) atomicMax(slot + 2, __float_as_uint(sqrtf(n2 / fmaxf(d2, 1e-20f)))); }
    { const int ch = hh * 128 + tid; float cx[3] = {0.f, 0.f, 0.f}, bg = 0.f;
      for (int jj = 0; jj < 3; ++jj) { const int r = t - 2 + jj; if (r < 0) continue; const float rr = dbg_rstd(ssq, r); float c = 0.f, x = 0.f, b = 0.f;
          for (int k = 0; k < 1024; ++k) { const float hv = h[(size_t)r * 1024 + k] * ln[k]; c += hv * W[(size_t)k * EIN + 2048 + ch]; x += hv * W[(size_t)k * EIN + 2560 + ch]; if (jj == 2) b += hv * W[(size_t)k * EIN + 1536 + ch]; }
          cx[jj] = (c * rr) * (x * rr); if (jj == 2) bg = b * rr; }
      const float ex2 = bg * (cw[0 * 512 + ch] * cx[0] + cw[1 * 512 + ch] * cx[1] + cw[2 * 512 + ch] * cx[2]); const float got = dbg_bf(MIXb, (size_t)t * 1024 + 512 + ch);
      float n2 = (got - ex2) * (got - ex2), d2 = ex2 * ex2; n2 = bsum(n2); d2 = bsum(d2); if (tid == 0) atomicMax(slot + 3, __float_as_uint(sqrtf(n2 / fmaxf(d2, 1e-20f)))); }
}
static void dbg_before_phase(int ph, unsigned char* ws, float* out, hipStream_t st) {
    if (ph == P_PRO || ph == P_FINAL) return;
    const int lp = (ph - 1) % LPN;
    if (lp == LP_UP || lp == LP_R1 || lp == LP_PLE) { (void)hipMemcpyAsync(ws + WS_ARENA + 400 * MiB, out, (size_t)S_ * D_ * 4, hipMemcpyDeviceToDevice, st); (void)hipMemcpyAsync(ws + WS_ARENA + 464 * MiB, ws + WS_SSQA, (size_t)S_ * 16 * 4, hipMemcpyDeviceToDevice, st); }
}
static void dbg_checks(int ph, void* const* d_in, unsigned char* ws, float* out, hipStream_t st) {
    if (ph == P_PRO || ph == P_FINAL) return;
    unsigned* slots = (unsigned*)(ws + WS_CTL) + CW_DBG; const int L = (ph - 1) / LPN, lp = (ph - 1) % LPN, j = L >> 1; const bool odd = L & 1;
    const float* snap = (const float*)(ws + WS_ARENA + 400 * MiB);
    if (lp == LP_DOWN && L == 0) hipLaunchKernelGGL(chk_ffn, dim3(24), dim3(256), 0, st, snap, (const float*)out, (const float*)(ws + WS_ARENA + 464 * MiB), (const float*)d_in[4] + L * D_, (const float*)nullptr,
        (const float*)d_in[21] + (size_t)j * D_ * DFF, (const float*)d_in[22] + (size_t)j * D_ * DFF, (const float*)d_in[23] + (size_t)j * D_ * DFF, 0, slots + 256 + 0);
    if (lp == LP_PLE && L == 0) hipLaunchKernelGGL(chk_ple, dim3(24), dim3(256), 0, st, snap, (const float*)out, (const float*)(ws + WS_ARENA + 464 * MiB), (const float*)d_in[5] + L * D_, (const float*)d_in[28] + (size_t)L * D_ * D_,
        (const float*)d_in[1] + (size_t)L * S_ * PLE, (const float*)d_in[29] + (size_t)L * PLE * D_, slots + 256 + 1);
    if (lp == LP_G3 && L == 1) { float* raw = (float*)(ws + WS_ARENA + 400 * MiB);
        hipLaunchKernelGGL(chk_gdn_proj, dim3((DBG_TC * 514 + 255) / 256), dim3(256), 0, st, (const float*)out, (const float*)(ws + WS_SSQB), (const float*)d_in[3] + L * D_, (const float*)d_in[15] + (size_t)j * D_ * OIN_SRC, 3, raw);
        hipLaunchKernelGGL(chk_gdn_rec, dim3(1), dim3(256), (128 * 129 + 6 * 128 + 256) * 4, st, (const float*)raw, (const float*)d_in[16] + (size_t)j * 4 * 3072, (const float*)d_in[17] + j * 8, (const float*)d_in[18] + j * 8, (const float*)d_in[19] + j * 128, 3, (const unsigned short*)(ws + WS_MIX), slots + 256 + 2); }
    if (lp == LP_COMB && L == 1) hipLaunchKernelGGL(chk_ffn, dim3(24), dim3(256), 0, st, snap, (const float*)out, (const float*)(ws + WS_ARENA + 464 * MiB), (const float*)d_in[4] + L * D_, (const float*)d_in[24] + (size_t)j * D_ * NEXP,
        (const float*)d_in[25] + (size_t)j * NEXP * D_ * DFF, (const float*)d_in[26] + (size_t)j * NEXP * D_ * DFF, (const float*)d_in[27] + (size_t)j * NEXP * DFF * D_, 1, slots + 256 + 3);
    if (lp == LP_MIXPREP && L == 0) { float* KV = (float*)(ws + WS_ARENA + 400 * MiB);
        hipLaunchKernelGGL(chk_even_kv, dim3((S_ * 1024) / 256), dim3(256), 0, st, (const float*)out, (const float*)(ws + WS_SSQB), (const float*)d_in[3] + L * D_, (const float*)d_in[7] + (size_t)j * D_ * EIN, KV);
        hipLaunchKernelGGL(chk_even_mix, dim3(24), dim3(128), 0, st, (const float*)out, (const float*)(ws + WS_SSQB), (const float*)d_in[3] + L * D_, (const float*)d_in[7] + (size_t)j * D_ * EIN, (const float*)KV, (const int*)d_in[2],
            (const float*)d_in[9] + j * 64, (const float*)d_in[10] + j * 64, (const float*)d_in[11] + j * 64, (const float*)d_in[12] + j * 64, (const float*)d_in[13] + j * 128, (const float*)d_in[14] + (size_t)j * 3 * 512,
            0.8f - 0.6f * expf(-0.3f * (float)L), (const unsigned short*)(ws + WS_ARENA + AR_PE), (const unsigned short*)(ws + WS_ARENA + AR_AO), (const unsigned short*)(ws + WS_MIX), slots + 256 + 4); }
    (void)odd;
}
static void dbg_after_phase(int ph, unsigned char* ws, float* out, hipStream_t st) {
    unsigned* slots = (unsigned*)(ws + WS_CTL) + CW_DBG; unsigned* sl = slots + ph;
    auto scan = [&](const void* p, size_t n, int f32) { hipLaunchKernelGGL(dbg_scan, dim3(1024), dim3(256), 0, st, p, n, f32, sl); };
    const size_t SD = (size_t)S_ * D_; unsigned char* ar = ws + WS_ARENA;
    if (ph == P_PRO) { scan(ws + WS_HBF, SD, 0); scan(out, SD, 1); scan(ws + WS_PBF, (size_t)4 * S_ * PLE, 0); scan(ws + WS_TAB, (size_t)S_ * 16, 1); scan(ws + WS_W, (size_t)44 * MiB, 0); return; }
    if (ph == P_FINAL) return;
    const int L = (ph - 1) / LPN, lp = (ph - 1) % LPN; const bool odd = L & 1;
    switch (lp) {
    case LP_PROJ: if (!odd) scan(ar + AR_PE, (size_t)S_ * EIN, 0); else { scan(ar + AR_PO, (size_t)S_ * OIN, 0); scan(ws + WS_GB, (size_t)S_ * 16, 1); } scan(ws + WS_PP, SD, 0); break;
    case LP_ROT: scan(ar + AR_PE, (size_t)S_ * EIN, 0); break;
    case LP_ATT: scan(ar + AR_AO, SD, 0); break;
    case LP_MIXPREP: case LP_G3: scan(ws + WS_MIX, SD, 0); break;
    case LP_GA: scan(ar + AR_QN, SD * 6, 0); scan(ws + WS_GB, (size_t)S_ * 16, 1); break;
    case LP_G1: scan(ar + AR_AI, (size_t)NUNIT * 4096, 0); scan(ar + AR_NEGW, SD, 0); scan(ar + AR_UT, SD, 0); scan(ar + AR_MP, (size_t)NUNIT * 16384 * 2, 0); break;
    case LP_G2: scan(ar + AR_SG, (size_t)NUNIT * 16384, 0); break;
    case LP_OUT: case LP_DOWN: case LP_COMB: case LP_PLE: scan(out, SD, 1); scan(ws + WS_HBF, SD, 0); scan(ws + ((lp == LP_PLE) ? WS_SSQB : WS_SSQA), (size_t)S_ * 16, 1); break;
    case LP_UP: scan(ar + AR_ACT, (size_t)S_ * DFF, 0); break;
    case LP_R1: scan(ws + WS_TOK + TOK_G, (size_t)S_ * 2, 1); break;
    default: break; }
}
#endif
#ifndef MK_MULTI
#define MK_MULTI 0
#endif
extern "C" void kernel_launch(void* const* d_in, const int* in_sizes, int n_in, void* d_out, int out_size, void* d_ws, size_t ws_size, hipStream_t stream) {
    static int grid = 0;
    if (grid == 0) {
        if (n_in != 30 || out_size != S_ * D_ || ws_size < WS_NEED) { fprintf(stderr, "kernel_launch: unexpected problem (n_in %d, out %d, ws %zu < %zu)\n", n_in, out_size, ws_size, (size_t)WS_NEED); grid = -1; return; }
        int dev = 0, cus = 0, per_cu = 0;
        if (hipGetDevice(&dev) != hipSuccess || hipDeviceGetAttribute(&cus, hipDeviceAttributeMultiprocessorCount, dev) != hipSuccess) { grid = -1; return; }
        if (hipFuncSetAttribute((const void*)fwd, hipFuncAttributeMaxDynamicSharedMemorySize, LDS_BYTES) != hipSuccess) { fprintf(stderr, "kernel_launch: hipFuncSetAttribute failed\n"); grid = -1; return; }
        if (hipOccupancyMaxActiveBlocksPerMultiprocessor(&per_cu, (const void*)fwd, NWAVES * 64, LDS_BYTES) != hipSuccess || per_cu < 1) { fprintf(stderr, "kernel_launch: occupancy query says %d\n", per_cu); }
        (void)hipGetLastError();
        grid = cus;
#if DBG
        (void)hipFuncSetAttribute((const void*)chk_gdn_rec, hipFuncAttributeMaxDynamicSharedMemorySize, 72 * 1024);
#endif
    }
    if (grid < 0) return;
    (void)hipMemsetAsync((char*)d_ws + WS_CTL, 0, CTL_ZERO_BYTES, stream);
    Args a{};
    for (int i = 0; i < 30; ++i) a.in[i] = d_in[i];
    a.out = (float*)d_out; a.ws = (unsigned char*)d_ws; a.pad = 0;
#if MK_MULTI
    a.use_bar = 0;
    static const int seq_even[] = {LP_PROJ, LP_ROT, LP_ATT, LP_MIXPREP, LP_OUT, LP_UP, LP_DOWN, LP_PLE};
    static const int seq_odd[] = {LP_PROJ, LP_GA, LP_G2, LP_G3, LP_OUT, LP_R1, LP_R2, LP_M1, LP_M2, LP_COMB, LP_PLE};
    int plist[64], np = 0; plist[np++] = P_PRO;
    for (int L = 0; L < DEPTH_; ++L) { const bool odd = L & 1; const int n = odd ? 11 : 8; for (int q = 0; q < n; ++q) plist[np++] = 1 + LPN * L + (odd ? seq_odd[q] : seq_even[q]); }
    plist[np++] = P_FINAL;
    for (int pi = 0; pi < np; ++pi) { const int ph = plist[pi];
        a.ph_lo = ph; a.ph_hi = ph + 1;
#if DBG
        dbg_before_phase(ph, (unsigned char*)d_ws, (float*)d_out, stream);
#endif
        hipLaunchKernelGGL(fwd, dim3(grid), dim3(NWAVES * 64), LDS_BYTES, stream, a);
#if DBG
        dbg_after_phase(ph, (unsigned char*)d_ws, (float*)d_out, stream); dbg_checks(ph, d_in, (unsigned char*)d_ws, (float*)d_out, stream);
#endif
    }
#if DBG
    hipLaunchKernelGGL(dbg_fill, dim3(1024), dim3(256), 0, stream, (float*)d_out, (size_t)S_ * D_, (const unsigned*)((unsigned char*)d_ws + WS_CTL) + CW_DBG, P_FINAL + 1);
#endif
#else
    a.use_bar = 1; a.ph_lo = 0; a.ph_hi = P_FINAL + 1;
    hipLaunchKernelGGL(fwd, dim3(grid), dim3(NWAVES * 64), LDS_BYTES, stream, a);
#ifdef PROBE_PH
    for (int i = 0; i < PROBE_N; ++i) { a.use_bar = 0; a.ph_lo = PROBE_PH; a.ph_hi = PROBE_PH + 1; hipLaunchKernelGGL(fwd, dim3(grid), dim3(NWAVES * 64), LDS_BYTES, stream, a); }
#endif
#endif
    const hipError_t le = hipPeekAtLastError();
    if (le != hipSuccess) fprintf(stderr, "kernel_launch: launch failed: %s\n", hipGetErrorName(le));
}
```

```cpp
#include <hip/hip_runtime.h>
#include <hip/hip_bf16.h>
#include <cstdio>
#include <cstdint>
#include <cmath>

constexpr int S_ = 16384, D_ = 1024, DEPTH_ = 4;
constexpr int EIN = 3072, OIN = 4096, OIN_SRC = 4112, DFF = 3584, NEXP = 8, PLE = 256;
constexpr int MOE_P = 2 * S_ + NEXP * 256;
constexpr int NCHUNK = S_ / 64, NUNIT = NCHUNK * 8;
constexpr float RMS_EPS = 1e-6f;

namespace pg8 {
#define PG8_LAS __attribute__((address_space(3)))
typedef unsigned short bf16_t;
typedef short bf16x8 __attribute__((ext_vector_type(8)));
typedef float f32x4 __attribute__((ext_vector_type(4)));
typedef float f32x2 __attribute__((ext_vector_type(2)));
typedef unsigned u32x4 __attribute__((ext_vector_type(4)));
typedef unsigned u32x2 __attribute__((ext_vector_type(2)));
constexpr int BM = 256, BK = 64, HALF = 128, HTB = HALF * BK * 2, STAGE_BYTES = 8 * HTB, NXCD = 8, WGM = 8;

__host__ __device__ __forceinline__ int lds_byte(int r, int c) { const int st = (r >> 4) * 2 + (c >> 5), rr = r & 15, cc = c & 31, ob = rr * 64 + cc * 2; return st * 1024 + (ob ^ (((ob >> 9) & 1) << 5)); }
__host__ __device__ __forceinline__ void stage_rc(int b, int& R, int& C) { const int st = b / 1024, sb = b % 1024, swz = sb ^ (((sb >> 9) & 1) << 5); R = (st >> 1) * 16 + swz / 64; C = (st & 1) * 32 + (swz % 64) / 2; }
__host__ __device__ __forceinline__ int perm32(int rho) { const int n = rho >> 4, i = rho & 15; return 8 * (i >> 2) + 4 * n + (i & 3); }

struct Unit { int pm, pn, be; };
struct Gemm { const bf16_t* A; const bf16_t* Bt; int M, N, K; size_t bstride; };

struct StaticOrder {
    int nM, nN, nwg, G, c;
    __host__ __device__ void init(int M, int N, int G_, int c_) { nM = M / BM; nN = N / BM; nwg = nM * nN; G = G_; c = c_; }
    __host__ __device__ bool next(int i, Unit& u) const {
        const long L = (long)i * G + c; if (L >= nwg) return false;
        int wgid = (int)L; { const int q = nwg / NXCD, r = nwg % NXCD, xcd = wgid % NXCD, off = wgid / NXCD; wgid = (xcd < r ? xcd * (q + 1) : r * (q + 1) + (xcd - r) * q) + off; }
        const int nig = WGM * nN, gid = wgid / nig, fm = gid * WGM, gsz = (nM - fm) < WGM ? (nM - fm) : WGM;
        u.pm = fm + ((wgid % nig) % gsz); u.pn = (wgid % nig) / gsz; u.be = 0; return true;
    }
    __device__ __forceinline__ void a_ready(const Unit&) const {}
    __device__ __forceinline__ void done(const Unit&) const {}
};
struct MoeOrder : StaticOrder {
    const PG8_LAS int* blk_e;
    __device__ __forceinline__ bool next(int i, Unit& u) const { if (!StaticOrder::next(i, u)) return false; u.be = blk_e[u.pm]; return true; }
};

__device__ __forceinline__ unsigned cvt_pk_bf16(float lo, float hi) { unsigned r; asm volatile("v_cvt_pk_bf16_f32 %0, %1, %2" : "=v"(r) : "v"(lo), "v"(hi)); return r; }
typedef __bf16 bf16x2_t_ __attribute__((ext_vector_type(2)));
__device__ __forceinline__ unsigned cvt_pk_bf16_cv(float lo, float hi) { const f32x2 v = {lo, hi}; const bf16x2_t_ b = __builtin_convertvector(v, bf16x2_t_); return __builtin_bit_cast(unsigned, b); }
__device__ __forceinline__ float bf_lo(unsigned w) { return __uint_as_float(w << 16); }
__device__ __forceinline__ float bf_hi(unsigned w) { return __uint_as_float(w & 0xffff0000u); }

__device__ __forceinline__ float rstd_row(const float* ssq, int row) {
    const f32x4* p = (const f32x4*)(ssq + (size_t)row * 16);
    const f32x4 a = p[0], b = p[1], c = p[2], d = p[3];
    const float s = (((a[0] + a[1]) + (a[2] + a[3])) + ((b[0] + b[1]) + (b[2] + b[3]))) + (((c[0] + c[1]) + (c[2] + c[3])) + ((d[0] + d[1]) + (d[2] + d[3])));
    return __builtin_amdgcn_rsqf(s * (1.0f / 1024.0f) + RMS_EPS);
}
__device__ __forceinline__ float sigmoidf_(float x) { return __builtin_amdgcn_rcpf(1.0f + __builtin_amdgcn_exp2f(-1.4426950408889634f * x)); }
__device__ __forceinline__ float siluf_(float x) { return x * sigmoidf_(x); }

constexpr float C2 = 0.125f * 1.4426950408889634f;

struct EpiProjEven {
    static constexpr bool PERM = true, AFTER_DRAIN = false;
    bf16_t* O; const float* ssq; const float* tab;
    __device__ __forceinline__ void operator()(const f32x4 (&acc)[2][2][4][2], const Unit& u, int wr, int wc, int fr, int fq) const {
        const int row0 = u.pm * BM + wr * 64 + fr, colt = u.pn * BM;
        const bool rot = (colt < 1024) && ((wc & 1) == 0);
        const float qs = (colt < 512) ? C2 : 1.0f;
#pragma unroll
        for (int ai = 0; ai < 2; ++ai)
#pragma unroll
            for (int m = 0; m < 4; ++m) {
                const int row = row0 + ai * HALF + m * 16; const float rs = rstd_row(ssq, row);
                f32x4 c0 = {1.f, 1.f, 1.f, 1.f}, c1 = c0, s0 = {0.f, 0.f, 0.f, 0.f}, s1 = s0;
                if (rot && fq < 2) { const f32x4* t = (const f32x4*)(tab + (size_t)row * 16); c0 = t[0]; c1 = t[1]; s0 = t[2]; s1 = t[3]; if (fq == 0) { s0 = -s0; s1 = -s1; } }
#pragma unroll
                for (int bj = 0; bj < 2; ++bj) {
                    f32x4 v0 = acc[ai][bj][m][0] * rs, v1 = acc[ai][bj][m][1] * rs;
                    if (rot) {
                        f32x4 p0, p1;
#pragma unroll
                        for (int i = 0; i < 4; ++i) { p0[i] = __shfl_xor(v0[i], 16); p1[i] = __shfl_xor(v1[i], 16); }
                        v0 = v0 * c0 + p0 * s0; v1 = v1 * c1 + p1 * s1;
                    }
                    v0 = v0 * qs; v1 = v1 * qs;
                    u32x4 w; w.x = cvt_pk_bf16(v0[0], v0[1]); w.y = cvt_pk_bf16(v0[2], v0[3]); w.z = cvt_pk_bf16(v1[0], v1[1]); w.w = cvt_pk_bf16(v1[2], v1[3]);
                    *(u32x4*)(O + (size_t)row * EIN + colt + bj * HALF + wc * 32 + 8 * fq) = w;
                }
                asm volatile("" ::: "memory");
            }
    }
};
struct EpiBf16 {
    static constexpr bool PERM = true, AFTER_DRAIN = false;
    bf16_t* O; int ldc; const float* ssq; float scale0; int scale_cols;
    __device__ __forceinline__ void operator()(const f32x4 (&acc)[2][2][4][2], const Unit& u, int wr, int wc, int fr, int fq) const {
        const int row0 = u.pm * BM + wr * 64 + fr, colt = u.pn * BM;
#pragma unroll
        for (int ai = 0; ai < 2; ++ai)
#pragma unroll
            for (int m = 0; m < 4; ++m) {
                const int row = row0 + ai * HALF + m * 16; const float rs = (ssq ? rstd_row(ssq, row) : 1.0f) * (colt < scale_cols ? scale0 : 1.0f);
#pragma unroll
                for (int bj = 0; bj < 2; ++bj) {
                    const f32x4 v0 = acc[ai][bj][m][0] * rs, v1 = acc[ai][bj][m][1] * rs;
                    u32x4 w; w.x = cvt_pk_bf16(v0[0], v0[1]); w.y = cvt_pk_bf16(v0[2], v0[3]); w.z = cvt_pk_bf16(v1[0], v1[1]); w.w = cvt_pk_bf16(v1[2], v1[3]);
                    *(u32x4*)(O + (size_t)row * ldc + colt + bj * HALF + wc * 32 + 8 * fq) = w;
                }
                if (m & 1) asm volatile("" ::: "memory");
            }
    }
};
struct EpiSwiglu {
    static constexpr bool PERM = true, AFTER_DRAIN = false;
    bf16_t* O; const float* ssq;
    __device__ __forceinline__ void operator()(const f32x4 (&acc)[2][2][4][2], const Unit& u, int wr, int wc, int fr, int fq) const {
        const int row0 = u.pm * BM + wr * 64 + fr, col = u.pn * HALF + wc * 32 + 8 * fq;
#pragma unroll
        for (int ai = 0; ai < 2; ++ai)
#pragma unroll
            for (int m = 0; m < 4; ++m) {
                const int row = row0 + ai * HALF + m * 16; const float rs = ssq ? rstd_row(ssq, row) : 1.0f;
                float o[8];
#pragma unroll
                for (int n = 0; n < 2; ++n)
#pragma unroll
                    for (int i = 0; i < 4; ++i) { const float a = acc[ai][0][m][n][i] * rs, b = acc[ai][1][m][n][i] * rs; o[4 * n + i] = siluf_(a) * b; }
                u32x4 w; w.x = cvt_pk_bf16(o[0], o[1]); w.y = cvt_pk_bf16(o[2], o[3]); w.z = cvt_pk_bf16(o[4], o[5]); w.w = cvt_pk_bf16(o[6], o[7]);
                *(u32x4*)(O + (size_t)row * DFF + col) = w;
                if (m & 1) asm volatile("" ::: "memory");
            }
    }
};
struct EpiResid {
    static constexpr bool PERM = true, AFTER_DRAIN = false;
    float* h; bf16_t* hb; float* ssq;
    __device__ __forceinline__ void operator()(const f32x4 (&acc)[2][2][4][2], const Unit& u, int wr, int wc, int fr, int fq) const {
        const int row0 = u.pm * BM + wr * 64 + fr, colt = u.pn * BM;
#pragma unroll
        for (int ai = 0; ai < 2; ++ai)
#pragma unroll
            for (int m = 0; m < 4; ++m) {
                const int row = row0 + ai * HALF + m * 16; float ss = 0.f;
#pragma unroll
                for (int bj = 0; bj < 2; ++bj) {
                    const size_t off = (size_t)row * D_ + colt + bj * HALF + wc * 32 + 8 * fq;
                    f32x4 x0 = *(const f32x4*)(h + off), x1 = *(const f32x4*)(h + off + 4);
                    x0 = x0 + acc[ai][bj][m][0]; x1 = x1 + acc[ai][bj][m][1];
                    *(f32x4*)(h + off) = x0; *(f32x4*)(h + off + 4) = x1;
                    ss += (x0[0] * x0[0] + x0[1] * x0[1]) + (x0[2] * x0[2] + x0[3] * x0[3]) + (x1[0] * x1[0] + x1[1] * x1[1]) + (x1[2] * x1[2] + x1[3] * x1[3]);
                    u32x4 w; w.x = cvt_pk_bf16(x0[0], x0[1]); w.y = cvt_pk_bf16(x0[2], x0[3]); w.z = cvt_pk_bf16(x1[0], x1[1]); w.w = cvt_pk_bf16(x1[2], x1[3]);
                    *(u32x4*)(hb + off) = w;
                }
                ss += __shfl_xor(ss, 16); ss += __shfl_xor(ss, 32);
                if (fq == 0) ssq[(size_t)row * 16 + u.pn * 4 + wc] = ss;
                asm volatile("" ::: "memory");
            }
    }
};
struct EpiPle {
    static constexpr bool PERM = true, AFTER_DRAIN = false;
    float* h; bf16_t* hb; const float* ssq_in; float* ssq_out; const bf16_t* pp;
    __device__ __forceinline__ void operator()(const f32x4 (&acc)[2][2][4][2], const Unit& u, int wr, int wc, int fr, int fq) const {
        const int row0 = u.pm * BM + wr * 64 + fr, colt = u.pn * BM;
#pragma unroll
        for (int ai = 0; ai < 2; ++ai)
#pragma unroll
            for (int m = 0; m < 4; ++m) {
                const int row = row0 + ai * HALF + m * 16; const float rs = rstd_row(ssq_in, row); float ss = 0.f;
#pragma unroll
                for (int bj = 0; bj < 2; ++bj) {
                    const size_t off = (size_t)row * D_ + colt + bj * HALF + wc * 32 + 8 * fq;
                    f32x4 x0 = *(const f32x4*)(h + off), x1 = *(const f32x4*)(h + off + 4);
                    const u32x4 pw = *(const u32x4*)(pp + off);
                    const f32x4 a0 = acc[ai][bj][m][0] * rs, a1 = acc[ai][bj][m][1] * rs;
                    x0[0] += sigmoidf_(a0[0]) * bf_lo(pw.x); x0[1] += sigmoidf_(a0[1]) * bf_hi(pw.x); x0[2] += sigmoidf_(a0[2]) * bf_lo(pw.y); x0[3] += sigmoidf_(a0[3]) * bf_hi(pw.y);
                    x1[0] += sigmoidf_(a1[0]) * bf_lo(pw.z); x1[1] += sigmoidf_(a1[1]) * bf_hi(pw.z); x1[2] += sigmoidf_(a1[2]) * bf_lo(pw.w); x1[3] += sigmoidf_(a1[3]) * bf_hi(pw.w);
                    *(f32x4*)(h + off) = x0; *(f32x4*)(h + off + 4) = x1;
                    ss += (x0[0] * x0[0] + x0[1] * x0[1]) + (x0[2] * x0[2] + x0[3] * x0[3]) + (x1[0] * x1[0] + x1[1] * x1[1]) + (x1[2] * x1[2] + x1[3] * x1[3]);
                    u32x4 w; w.x = cvt_pk_bf16(x0[0], x0[1]); w.y = cvt_pk_bf16(x0[2], x0[3]); w.z = cvt_pk_bf16(x1[0], x1[1]); w.w = cvt_pk_bf16(x1[2], x1[3]);
                    *(u32x4*)(hb + off) = w;
                }
                ss += __shfl_xor(ss, 16); ss += __shfl_xor(ss, 32);
                if (fq == 0) ssq_out[(size_t)row * 16 + u.pn * 4 + wc] = ss;
                asm volatile("" ::: "memory");
            }
    }
};
struct EpiMoeDown {
    static constexpr bool PERM = true, AFTER_DRAIN = false;
    bf16_t* Y; const float* gate;
    __device__ __forceinline__ void operator()(const f32x4 (&acc)[2][2][4][2], const Unit& u, int wr, int wc, int fr, int fq) const {
        const int row0 = u.pm * BM + wr * 64 + fr, colt = u.pn * BM;
#pragma unroll
        for (int ai = 0; ai < 2; ++ai)
#pragma unroll
            for (int m = 0; m < 4; ++m) {
                const int row = row0 + ai * HALF + m * 16; const float gt = gate[row];
#pragma unroll
                for (int bj = 0; bj < 2; ++bj) {
                    const f32x4 v0 = acc[ai][bj][m][0] * gt, v1 = acc[ai][bj][m][1] * gt;
                    u32x4 w; w.x = cvt_pk_bf16(v0[0], v0[1]); w.y = cvt_pk_bf16(v0[2], v0[3]); w.z = cvt_pk_bf16(v1[0], v1[1]); w.w = cvt_pk_bf16(v1[2], v1[3]);
                    *(u32x4*)(Y + (size_t)row * D_ + colt + bj * HALF + wc * 32 + 8 * fq) = w;
                }
                if (m & 1) asm volatile("" ::: "memory");
            }
    }
};

template <class Epi, class Sched, bool ALIGN_EPI = false, bool SP2 = false>
__device__ __forceinline__ void gemm_phase(PG8_LAS unsigned char* lds, const Gemm g, const Sched& S, const Epi& E) {
    int tid_ = threadIdx.x; asm volatile("" : "+v"(tid_));
    const int tid = tid_, wid = __builtin_amdgcn_readfirstlane(tid >> 6), lane = tid & 63, wr = wid >> 2, wc = wid & 3, fr = lane & 15, fq = lane >> 4;
    const int K = g.K, nt = K / BK;
    unsigned voffA[2], voffB[2];
#pragma unroll
    for (int i = 0; i < 2; ++i) { int R, C; stage_rc(tid * 16 + i * 8192, R, C); const int Rb = Epi::PERM ? ((R & ~31) + perm32(R & 31)) : R;
        voffA[i] = (unsigned)(R * K + C) * 2u; voffB[i] = (unsigned)(Rb * K + C) * 2u; }
    const size_t kstep = (size_t)(BK * 2);
    const size_t hstep = (size_t)HALF * K * 2;
    const size_t tstep = 2 * hstep;
    const unsigned ldsw = (unsigned)wid * 1024u;
    const int aoff = lds_byte(wr * 64 + fr, fq * 8), boff = lds_byte(wc * 32 + fr, fq * 8);
#define PG8_SA(b, h) (((b) * 2 + (h)) * HTB)
#define PG8_SB(b, h) ((4 + (b) * 2 + (h)) * HTB)
#define PG8_STAGE(bufoff, gbase, voff) do { _Pragma("unroll") for (int _i = 0; _i < 2; ++_i) \
        __builtin_amdgcn_global_load_lds((const unsigned*)((const char*)(gbase) + (voff)[_i]), (PG8_LAS unsigned*)(lds + (bufoff) + ldsw + _i * 8192), 16, 0, 0); } while (0)
#define PG8_LDA(dst, b, h) do { _Pragma("unroll") for (int m = 0; m < 4; ++m) _Pragma("unroll") for (int k = 0; k < 2; ++k) dst[m][k] = *(const PG8_LAS bf16x8*)(lds + PG8_SA(b, h) + aoff + m * 2048 + k * 1024); } while (0)
#define PG8_LDB(dst, b, h) do { _Pragma("unroll") for (int n = 0; n < 2; ++n) _Pragma("unroll") for (int k = 0; k < 2; ++k) dst[n][k] = *(const PG8_LAS bf16x8*)(lds + PG8_SB(b, h) + boff + n * 2048 + k * 1024); } while (0)
#define PG8_MMA(ai, bj, At, Bt) do { __builtin_amdgcn_s_setprio(1); _Pragma("unroll") for (int m = 0; m < 4; ++m) _Pragma("unroll") for (int n = 0; n < 2; ++n) _Pragma("unroll") for (int k = 0; k < 2; ++k) \
        acc[ai][bj][m][n] = __builtin_amdgcn_mfma_f32_16x16x32_bf16(Bt[n][k], At[m][k], acc[ai][bj][m][n], 0, 0, 0); __builtin_amdgcn_s_setprio(0); } while (0)
#define PG8_WAIT_V(n) asm volatile("s_waitcnt vmcnt(" #n ")" ::: "memory")
#define PG8_WAIT_L(n) asm volatile("s_waitcnt lgkmcnt(" #n ")" ::: "memory")
#define PG8_BAR __builtin_amdgcn_s_barrier()
#define PG8_SCHED __builtin_amdgcn_sched_barrier(0)
    Unit cur, nxt; int ui = 0;
    if (!S.next(0, cur)) return;
    f32x4 acc[2][2][4][2];
#pragma unroll
    for (int a = 0; a < 2; ++a)
#pragma unroll
        for (int b = 0; b < 2; ++b)
#pragma unroll
            for (int m = 0; m < 4; ++m)
#pragma unroll
                for (int n = 0; n < 2; ++n) acc[a][b][m][n] = (f32x4){0.f, 0.f, 0.f, 0.f};
    bf16x8 At[4][2], B0[2][2], B1[2][2];
    const char* cA = (const char*)g.A + (size_t)cur.pm * tstep; const char* cB = (const char*)g.Bt + (size_t)cur.pn * tstep + (size_t)cur.be * g.bstride;
    S.a_ready(cur);
    if constexpr (SP2) {
        PG8_STAGE(PG8_SB(0, 0), cB, voffB); PG8_STAGE(PG8_SB(0, 1), cB + hstep, voffB); PG8_STAGE(PG8_SA(0, 0), cA, voffA); PG8_STAGE(PG8_SA(0, 1), cA + hstep, voffA);
        if (wr == 1) PG8_BAR;
        PG8_WAIT_V(2); PG8_BAR;
        PG8_STAGE(PG8_SB(1, 0), cB + kstep, voffB); PG8_STAGE(PG8_SA(1, 0), cA + kstep, voffA); PG8_STAGE(PG8_SB(1, 1), cB + hstep + kstep, voffB);
        PG8_WAIT_V(6); PG8_BAR;
    } else {
        PG8_STAGE(PG8_SB(0, 0), cB, voffB); PG8_STAGE(PG8_SA(0, 0), cA, voffA); PG8_STAGE(PG8_SB(0, 1), cB + hstep, voffB); PG8_STAGE(PG8_SA(0, 1), cA + hstep, voffA);
        if (wr == 1) PG8_BAR;
        PG8_WAIT_V(4); PG8_BAR;
        PG8_STAGE(PG8_SB(1, 0), cB + kstep, voffB); PG8_STAGE(PG8_SA(1, 0), cA + kstep, voffA); PG8_STAGE(PG8_SB(1, 1), cB + hstep + kstep, voffB);
        PG8_WAIT_V(6); PG8_BAR;
    }
    for (;;) {
        const bool has_next = S.next(ui + 1, nxt);
        const char* nA = has_next ? (const char*)g.A + (size_t)nxt.pm * tstep : cA; const char* nB = has_next ? (const char*)g.Bt + (size_t)nxt.pn * tstep + (size_t)nxt.be * g.bstride : cB;
        for (int t = 0; t < nt; t += 2) {
            const bool last = (t == nt - 2);
            const char* a1 = cA + (size_t)(t + 1) * kstep;
            const char* a2 = last ? nA : cA + (size_t)(t + 2) * kstep; const char* b2 = last ? nB : cB + (size_t)(t + 2) * kstep;
            const char* a3 = a2 + kstep; const char* b3 = b2 + kstep;
            if (last && has_next) S.a_ready(nxt);
            if constexpr (SP2) {
            PG8_LDB(B0, 0, 0); PG8_LDB(B1, 0, 1); PG8_SCHED; PG8_LDA(At, 0, 0); PG8_STAGE(PG8_SA(1, 1), a1 + hstep, voffA);
            PG8_WAIT_V(8); PG8_WAIT_L(0); PG8_BAR; PG8_MMA(0, 0, At, B0); PG8_MMA(0, 1, At, B1); PG8_BAR; PG8_SCHED;
            PG8_LDA(At, 0, 1); PG8_STAGE(PG8_SB(0, 0), b2, voffB); PG8_STAGE(PG8_SB(0, 1), b2 + hstep, voffB); PG8_STAGE(PG8_SA(0, 0), a2, voffA);
            PG8_WAIT_V(8); PG8_WAIT_L(0); PG8_BAR; PG8_MMA(1, 0, At, B0); PG8_MMA(1, 1, At, B1); PG8_BAR; PG8_SCHED;
            PG8_LDB(B0, 1, 0); PG8_LDB(B1, 1, 1); PG8_SCHED; PG8_LDA(At, 1, 0); PG8_STAGE(PG8_SA(0, 1), a2 + hstep, voffA);
            PG8_WAIT_V(8); PG8_WAIT_L(0); PG8_BAR; PG8_MMA(0, 0, At, B0); PG8_MMA(0, 1, At, B1); PG8_BAR; PG8_SCHED;
            PG8_LDA(At, 1, 1); PG8_STAGE(PG8_SB(1, 0), b3, voffB); PG8_STAGE(PG8_SB(1, 1), b3 + hstep, voffB); PG8_STAGE(PG8_SA(1, 0), a3, voffA);
            PG8_WAIT_V(8); PG8_WAIT_L(0); PG8_BAR; PG8_MMA(1, 0, At, B0); PG8_MMA(1, 1, At, B1); PG8_BAR; PG8_SCHED;
            } else {
            PG8_LDB(B0, 0, 0); PG8_SCHED; PG8_LDA(At, 0, 0); PG8_STAGE(PG8_SA(1, 1), a1 + hstep, voffA);
            PG8_WAIT_L(8); PG8_BAR; PG8_WAIT_L(0); PG8_MMA(0, 0, At, B0); PG8_BAR; PG8_SCHED;
            PG8_LDB(B1, 0, 1); PG8_STAGE(PG8_SB(0, 0), b2, voffB);
            PG8_BAR; PG8_WAIT_L(0); PG8_MMA(0, 1, At, B1); PG8_BAR;
            PG8_LDA(At, 0, 1); PG8_STAGE(PG8_SA(0, 0), a2, voffA);
            PG8_BAR; PG8_WAIT_L(0); PG8_MMA(1, 0, At, B0); PG8_BAR; PG8_SCHED;
            PG8_STAGE(PG8_SB(0, 1), b2 + hstep, voffB);
            PG8_WAIT_V(6); PG8_BAR; PG8_MMA(1, 1, At, B1); PG8_BAR;
            PG8_LDB(B0, 1, 0); PG8_SCHED; PG8_LDA(At, 1, 0); PG8_STAGE(PG8_SA(0, 1), a2 + hstep, voffA);
            PG8_WAIT_L(8); PG8_BAR; PG8_WAIT_L(0); PG8_MMA(0, 0, At, B0); PG8_BAR; PG8_SCHED;
            PG8_LDB(B1, 1, 1); PG8_STAGE(PG8_SB(1, 0), b3, voffB);
            PG8_BAR; PG8_WAIT_L(0); PG8_MMA(0, 1, At, B1); PG8_BAR;
            PG8_LDA(At, 1, 1); PG8_STAGE(PG8_SA(1, 0), a3, voffA);
            PG8_BAR; PG8_WAIT_L(0); PG8_MMA(1, 0, At, B0); PG8_BAR; PG8_SCHED;
            PG8_STAGE(PG8_SB(1, 1), b3 + hstep, voffB);
            PG8_WAIT_V(6); PG8_BAR; PG8_MMA(1, 1, At, B1); PG8_BAR;
            }
        }
        if constexpr (ALIGN_EPI) { if (wr == 0) PG8_BAR; }
        if constexpr (!Epi::AFTER_DRAIN) { E(acc, cur, wr, wc, fr, fq); S.done(cur); }
        if (!has_next) break;
#pragma unroll
        for (int a = 0; a < 2; ++a)
#pragma unroll
            for (int b = 0; b < 2; ++b)
#pragma unroll
                for (int m = 0; m < 4; ++m)
#pragma unroll
                    for (int n = 0; n < 2; ++n) acc[a][b][m][n] = (f32x4){0.f, 0.f, 0.f, 0.f};
        cur = nxt; cA = nA; cB = nB; ++ui;
        if constexpr (ALIGN_EPI) { if (wr == 1) PG8_BAR; }
    }
    PG8_WAIT_V(0);
    if constexpr (!ALIGN_EPI) { if (wr == 0) PG8_BAR; }
    PG8_BAR;
    if constexpr (Epi::AFTER_DRAIN) { E.fused(acc, cur, wr, wc, fr, fq, lds, wid, lane); S.done(cur); }
#undef PG8_SA
#undef PG8_SB
#undef PG8_STAGE
#undef PG8_LDA
#undef PG8_LDB
#undef PG8_MMA
#undef PG8_WAIT_V
#undef PG8_WAIT_L
#undef PG8_BAR
#undef PG8_SCHED
}
}

#include <hip/hip_bf16.h>
#include <cmath>
namespace attn_body {
using bf16=__hip_bfloat16;
using bf16x8=__attribute__((ext_vector_type(8)))short;
using s16x4=__attribute__((ext_vector_type(4)))short;
using f32x16=__attribute__((ext_vector_type(16)))float;
using u32x4=__attribute__((ext_vector_type(4)))unsigned;
constexpr int SEQ=16384,D=64,LDP=3072,LDO=1024;
constexpr int NW=8,QBLK=32,QB=QBLK*NW,KVBLK=64,NQB=SEQ/QB;
constexpr int ATTN_UNIT_ROWS=QB;
__device__ __forceinline__ int crow(int r,int hi){return (r&3)+8*(r>>2)+4*hi;}
#define SBAR() __builtin_amdgcn_sched_barrier(0)
__device__ __forceinline__ void cmask(f32x16&p0,f32x16&p1,int jb,int qrel,int hi){
  const float NEG=-INFINITY; int kb=64*jb+4*hi;
  #pragma unroll
  for(int r=0;r<16;++r){int kv=kb+(r&3)+8*(r>>2); if(kv>qrel)p0[r]=NEG; if(kv+32>qrel)p1[r]=NEG;}
}

constexpr int NSLOT=3, SLOTB=8192, VSLOTB=2*SLOTB;
constexpr int LDS_K=0, LDS_V=NSLOT*SLOTB, LDS_WS=LDS_V+NSLOT*VSLOTB, LDS_OST=0  , LDS_BYTES=LDS_WS+NW*64*4;
constexpr float C2=0.125f*1.4426950408889634f;
__device__ __forceinline__ void glds16(const void*gsrc,unsigned lds_dst){unsigned keep;
  asm volatile("s_mov_b32 %0, m0\n\ts_mov_b32 m0, %2\n\ts_nop 0\n\tglobal_load_lds_dwordx4 %1, off\n\ts_mov_b32 m0, %0":"=&s"(keep):"v"(gsrc),"s"(lds_dst):"memory");}
__device__ __forceinline__ float max3f(float a,float b,float c){float r;asm("v_max3_f32 %0, %1, %2, %3":"=v"(r):"v"(a),"v"(b),"v"(c));return r;}
__device__ __forceinline__ float max2f(float a,float b){float r;asm("v_max_f32_e32 %0, %1, %2":"=v"(r):"v"(a),"v"(b));return r;}
__device__ __forceinline__ float fadd_s(float a,float b){float r;asm("v_add_f32_e32 %0, %1, %2":"=v"(r):"v"(a),"v"(b));return r;}
__device__ __forceinline__ float fsub_s(float a,float b){float r;asm("v_sub_f32_e32 %0, %1, %2":"=v"(r):"v"(a),"v"(b));return r;}
typedef float f32x2_t __attribute__((ext_vector_type(2))); typedef __bf16 bf16x2_t __attribute__((ext_vector_type(2)));
__device__ __forceinline__ unsigned cvtpk_s(float lo,float hi){f32x2_t v={lo,hi};bf16x2_t b=__builtin_convertvector(v,bf16x2_t);return __builtin_bit_cast(unsigned,b);}
#define WAIT_BAR(N) asm volatile("s_waitcnt vmcnt(" #N ") lgkmcnt(0)\n\ts_barrier":::"memory")

__device__ __forceinline__ void qkt(f32x16&p0,f32x16&p1,const char*Kslot,const bf16x8*qr,int r32,int hi){
  const char*kb=Kslot+hi*1024+r32*16;
  #pragma unroll
  for(int d0=0;d0<4;++d0){
    const bf16x8 b0=*reinterpret_cast<const bf16x8*>(kb+d0*2048);
    const bf16x8 b1=*reinterpret_cast<const bf16x8*>(kb+d0*2048+512);
    if(d0==0){p0=__builtin_amdgcn_mfma_f32_32x32x16_bf16(b0,qr[0],f32x16{},0,0,0);p1=__builtin_amdgcn_mfma_f32_32x32x16_bf16(b1,qr[0],f32x16{},0,0,0);}
    else{p0=__builtin_amdgcn_mfma_f32_32x32x16_bf16(b0,qr[d0],p0,0,0,0);p1=__builtin_amdgcn_mfma_f32_32x32x16_bf16(b1,qr[d0],p1,0,0,0);}}
}
typedef __attribute__((address_space(3))) const char* lds_cptr;
typedef short v4i16_t __attribute__((ext_vector_type(4)));
__device__ __forceinline__ void kload8(bf16x8*kf,lds_cptr kp){
  kf[0]=*(const __attribute__((address_space(3))) bf16x8*)(kp);      kf[1]=*(const __attribute__((address_space(3))) bf16x8*)(kp+512);
  kf[2]=*(const __attribute__((address_space(3))) bf16x8*)(kp+2048); kf[3]=*(const __attribute__((address_space(3))) bf16x8*)(kp+2560);
  kf[4]=*(const __attribute__((address_space(3))) bf16x8*)(kp+4096); kf[5]=*(const __attribute__((address_space(3))) bf16x8*)(kp+4608);
  kf[6]=*(const __attribute__((address_space(3))) bf16x8*)(kp+6144); kf[7]=*(const __attribute__((address_space(3))) bf16x8*)(kp+6656);
}
__device__ __forceinline__ void kload2(bf16x8*kf,lds_cptr kp,int j){ kf[2*j]=*(const __attribute__((address_space(3))) bf16x8*)(kp+j*2048); kf[2*j+1]=*(const __attribute__((address_space(3))) bf16x8*)(kp+j*2048+512); }
__device__ __forceinline__ s16x4 vtr(lds_cptr p){ return __builtin_bit_cast(s16x4,__builtin_amdgcn_ds_read_tr16_b64_v4i16((__attribute__((address_space(3))) v4i16_t*)p)); }
__device__ __forceinline__ float rowmax(const f32x16&p0,const f32x16&p1){
  float a=max3f(p0[0],p0[1],p1[0]),b=max3f(p0[2],p0[3],p1[1]);a=max3f(a,p1[2],p1[3]);
  #pragma unroll
  for(int r=4;r<16;r+=4){a=max3f(a,p0[r],p0[r+1]);b=max3f(b,p0[r+2],p0[r+3]);a=max3f(a,p1[r],p1[r+1]);b=max3f(b,p1[r+2],p1[r+3]);}
  const float m=max2f(a,b);
  auto rr=__builtin_amdgcn_permlane32_swap(__float_as_uint(m),__float_as_uint(m),false,false);
  return max2f(__uint_as_float(rr[0]),__uint_as_float(rr[1]));
}
__device__ __forceinline__ void pv(f32x16*o,int vb,bf16x8 pa0,bf16x8 pa1,bf16x8 pa2,bf16x8 pa3){
  #pragma unroll
  for(int d0=0;d0<4;++d0){s16x4 lo[4],hi[4];
    #pragma unroll
    for(int ks=0;ks<4;++ks){
      asm volatile("ds_read_b64_tr_b16 %0,%1 offset:%c2":"=&v"(lo[ks]):"v"(vb),"i"(d0*4096+ks*1024):"memory");
      asm volatile("ds_read_b64_tr_b16 %0,%1 offset:%c2":"=&v"(hi[ks]):"v"(vb),"i"(d0*4096+ks*1024+512):"memory");}
    asm volatile("s_waitcnt lgkmcnt(0)":::"memory");SBAR();
    #define PK(k) (bf16x8){lo[k][0],lo[k][1],lo[k][2],lo[k][3],hi[k][0],hi[k][1],hi[k][2],hi[k][3]}
    o[d0]=__builtin_amdgcn_mfma_f32_32x32x16_bf16(pa0,PK(0),o[d0],0,0,0);
    o[d0]=__builtin_amdgcn_mfma_f32_32x32x16_bf16(pa1,PK(1),o[d0],0,0,0);
    o[d0]=__builtin_amdgcn_mfma_f32_32x32x16_bf16(pa2,PK(2),o[d0],0,0,0);
    o[d0]=__builtin_amdgcn_mfma_f32_32x32x16_bf16(pa3,PK(3),o[d0],0,0,0);
    #undef PK
  }
}

#ifndef ATTN_STORE16
#define ATTN_STORE16(p,v) (*(u32x4*)(p)=(v))
#endif
template<int THRL> __device__ __forceinline__ void attn_unit(int qb,const bf16*Qh,const bf16*__restrict__ Kh,const bf16*__restrict__ Vh,bf16*Oh,char*shm){
  int tid_=threadIdx.x; asm volatile("":"+v"(tid_));
  const int tid=tid_,lane=tid&63,r32=lane&31,hi=lane>>5; const int wid=__builtin_amdgcn_readfirstlane(tid>>6);
  const int q0=qb*QB;
  const bf16*Qw=Qh+(long)(q0+wid*QBLK)*LDP;
  const unsigned lds0=(unsigned)(uintptr_t)shm;
  float*wsf=(float*)(shm+LDS_WS)+wid*64;
  const bf16*ksrc=Kh+(long)lane*LDP+wid*8;
  const bf16*vsrc=Vh+(long)(16*(wid&3)+(lane>>2))*LDP+(wid>>2)*32+(lane&3)*8;
  const unsigned kdst=lds0+LDS_K+wid*1024, vdst=lds0+LDS_V+wid*1024;
  #define DMA_K(t,slot) glds16(ksrc+(long)(t)*KVBLK*LDP,(unsigned)__builtin_amdgcn_readfirstlane(kdst+(slot)))
  #define DMA_V(t,slot) do{ glds16(vsrc+(long)(t)*KVBLK*LDP,(unsigned)__builtin_amdgcn_readfirstlane(vdst+2*(slot))); glds16(vsrc+64+(long)(t)*KVBLK*LDP,(unsigned)__builtin_amdgcn_readfirstlane(vdst+2*(slot)+8192)); }while(0)
  const int vb0=(int)(lds0+LDS_V)+((lane>>4)&1)*32+(lane&3)*8+(4*hi+((lane&15)>>2))*64;
  const char*Kbase=shm+LDS_K; bf16x8 kf[8];
  const lds_cptr shm3=(lds_cptr)shm; const lds_cptr kp0=shm3+LDS_K+hi*1024+r32*16; const lds_cptr vp0=shm3+LDS_V+((lane>>4)&1)*32+(lane&3)*8+(4*hi+((lane&15)>>2))*64;
  const int NT=(q0+QB)/KVBLK;
  DMA_K(0,0);DMA_V(0,0);DMA_K(1,SLOTB);
  bf16x8 qr[4];
  #pragma unroll
  for(int d0=0;d0<4;++d0)qr[d0]=*reinterpret_cast<const bf16x8*>(&Qw[(long)r32*LDP+d0*16+hi*8]);
  float mhat=0.f,l_reg=0.f;f32x16 o[4];o[0]=f32x16{};o[1]=f32x16{};o[2]=f32x16{};o[3]=f32x16{};
  const int qrel=wid*QBLK+r32;
  #define CMASK(P0,P1,t) do{int jb_=(t)-(NT-4); if(jb_>=0)cmask(P0,P1,jb_,qrel,hi);}while(0)
  bool resc=false;
  #define START(P0,P1) do{ const float rm=rowmax(P0,P1); resc=false; mhat=rm; \
    _Pragma("unroll") for(int r=0;r<16;++r)P0[r]=__builtin_amdgcn_exp2f(fsub_s(P0[r],mhat)); }while(0)
  #define RESC() do{ if(resc){ asm volatile("s_waitcnt lgkmcnt(0)":::"memory"); \
      _Pragma("unroll") for(int d_=0;d_<4;++d_) _Pragma("unroll") for(int r=0;r<16;++r)o[d_][r]*=wsf[crow(r,hi)]; } }while(0)
  f32x16 pA0,pA1,pB0,pB1;
  int sl_prev=0,sl_cur=0,sl_next=SLOTB;
  #define ROT() do{sl_prev=sl_cur;sl_cur=sl_next;sl_next=(sl_next==(NSLOT-1)*SLOTB)?0:sl_next+SLOTB;}while(0)
  DMA_K(2,2*SLOTB);
  WAIT_BAR(4);
  qkt(pA0,pA1,Kbase,qr,r32,hi);asm volatile("s_nop 15\n\ts_nop 7":"+v"(pA0),"+v"(pA1));CMASK(pA0,pA1,0);
  START(pA0,pA1);
  _Pragma("unroll") for(int r=0;r<16;++r)pA1[r]=__builtin_amdgcn_exp2f(pA1[r]-mhat);
  WAIT_BAR(0);
  DMA_K(3,0);DMA_V(1,SLOTB);
  ROT();
  kload8(kf,kp0+sl_cur);
  WAIT_BAR(3);
  s16x4 vlo[3],vhi[3]; u32x4 pw0,pw1,pw2,pw3;
  #define PKW(P,B) cvtpk_s(P[B],P[B+1])
  #define PAF(k) __builtin_bit_cast(bf16x8,pw##k)
  #define VFJ(j) (bf16x8){vlo[(j)%3][0],vlo[(j)%3][1],vlo[(j)%3][2],vlo[(j)%3][3],vhi[(j)%3][0],vhi[(j)%3][1],vhi[(j)%3][2],vhi[(j)%3][3]}
  #define PIN(x) asm volatile("":"+v"(x))
  #define MX3(a,b,c) __builtin_fmaxf(__builtin_fmaxf((a),(b)),(c))
  #define GAPA(MF,A0,A1,A2,A3,W0,W1,PW) do{ MF; sacc+=A0; sacc+=A1; sacc+=A2; sacc+=A3; PIN(sacc); W0; W1; PIN(PW); SBAR(); }while(0)
  #define EX(v) __builtin_amdgcn_exp2f(v)
  #define VJ(j) do{ vlo[(j)%3]=vtr(vp_+(((j)&3)*4096+((j)>>2)*1024)); vhi[(j)%3]=vtr(vp_+(((j)&3)*4096+((j)>>2)*1024+512)); }while(0)
  #define PVJ(j,PA,X,B) do{ if((j)+2<16){ VJ((j)+2); SBAR(); } o[(j)&3]=__builtin_amdgcn_mfma_f32_32x32x16_bf16(PA,VFJ(j),o[(j)&3],0,0,0); X[B]=EX(X[B]-mhat); X[B+1]=EX(X[B+1]-mhat); PIN(X); SBAR(); }while(0)
  #define KRD(G,j) do{ if(G){ kload2(kf,kp0+sl_next,j); SBAR(); } }while(0)
  #define STEP(C0,C1,P0,P1,t,GK,GV,GL) do{ SBAR(); \
    const lds_cptr vp_=vp0+2*sl_prev; \
    float sacc=(P0[0]+P0[1]); \
    GAPA(C0=__builtin_amdgcn_mfma_f32_32x32x16_bf16(kf[0],qr[0],f32x16{},0,0,0), P0[2],P0[3],P0[4],P0[5],     pw0[0]=PKW(P0,0), pw0[1]=PKW(P0,2), pw0); \
    GAPA(C1=__builtin_amdgcn_mfma_f32_32x32x16_bf16(kf[1],qr[0],f32x16{},0,0,0), P0[6],P0[7],P0[8],P0[9],     pw0[2]=PKW(P0,4), pw0[3]=PKW(P0,6), pw0); \
    GAPA(C0=__builtin_amdgcn_mfma_f32_32x32x16_bf16(kf[2],qr[1],C0,0,0,0),   P0[10],P0[11],P0[12],P0[13], pw1[0]=PKW(P0,8), pw1[1]=PKW(P0,10), pw1); \
    GAPA(C1=__builtin_amdgcn_mfma_f32_32x32x16_bf16(kf[3],qr[1],C1,0,0,0),   P0[14],P0[15],P1[0],P1[1],   pw1[2]=PKW(P0,12),pw1[3]=PKW(P0,14), pw1); \
    GAPA(C0=__builtin_amdgcn_mfma_f32_32x32x16_bf16(kf[4],qr[2],C0,0,0,0),   P1[2],P1[3],P1[4],P1[5],     pw2[0]=PKW(P1,0), pw2[1]=PKW(P1,2), pw2); \
    GAPA(C1=__builtin_amdgcn_mfma_f32_32x32x16_bf16(kf[5],qr[2],C1,0,0,0),   P1[6],P1[7],P1[8],P1[9],     pw2[2]=PKW(P1,4), pw2[3]=PKW(P1,6), pw2); \
    GAPA(C0=__builtin_amdgcn_mfma_f32_32x32x16_bf16(kf[6],qr[3],C0,0,0,0),   P1[10],P1[11],P1[12],P1[13], pw3[0]=PKW(P1,8), pw3[1]=PKW(P1,10), pw3); \
    GAPA(C1=__builtin_amdgcn_mfma_f32_32x32x16_bf16(kf[7],qr[3],C1,0,0,0),   P1[14],P1[15],0.f,0.f,       pw3[2]=PKW(P1,12),pw3[3]=PKW(P1,14), pw3); \
    l_reg+=sacc; VJ(0); VJ(1); SBAR(); \
 \
    if(GK){DMA_K((t)+3,sl_cur);} if(GV){DMA_V((t)+1,sl_next);} \
    CMASK(C0,C1,t); \
    { float a=MX3(C0[0],C0[1],C1[0]),b=MX3(C0[2],C0[3],C1[1]); a=MX3(a,C1[2],C1[3]); \
      _Pragma("unroll") for(int r=4;r<16;r+=4){a=MX3(a,C0[r],C0[r+1]);b=MX3(b,C0[r+2],C0[r+3]);a=MX3(a,C1[r],C1[r+1]);b=MX3(b,C1[r+2],C1[r+3]);} \
      float rm=__builtin_fmaxf(a,b); { auto rr=__builtin_amdgcn_permlane32_swap(__float_as_uint(rm),__float_as_uint(rm),false,false); rm=__builtin_fmaxf(__uint_as_float(rr[0]),__uint_as_float(rr[1])); } \
      resc=false; const float rel=rm-mhat; \
      if(__builtin_expect(__any(rel>(float)THRL),0)){ const float dl=__builtin_fmaxf(rel,0.f); mhat+=dl; \
        const float f=__builtin_amdgcn_exp2f(-dl); l_reg*=f; if(hi==0)wsf[r32]=f; resc=true; } } \
    SBAR(); \
    PVJ(0, PAF(0),C0,0);  PVJ(1, PAF(0),C0,2);  PVJ(2, PAF(0),C0,4);  PVJ(3, PAF(0),C0,6); \
    KRD(GL,0); PVJ(4, PAF(1),C0,8);  PVJ(5, PAF(1),C0,10); KRD(GL,1); PVJ(6, PAF(1),C0,12); PVJ(7, PAF(1),C0,14); \
    KRD(GL,2); PVJ(8, PAF(2),C1,0);  PVJ(9, PAF(2),C1,2);  KRD(GL,3); PVJ(10,PAF(2),C1,4);  PVJ(11,PAF(2),C1,6); \
    PVJ(12,PAF(3),C1,8);  PVJ(13,PAF(3),C1,10); PVJ(14,PAF(3),C1,12); PVJ(15,PAF(3),C1,14); \
    }while(0)
  int t=1;
  #undef CMASK
  #define CMASK(P0,P1,t) do{}while(0)
  for(;t+5<NT;t+=2){
    STEP(pB0,pB1,pA0,pA1,t,true,true,true);     WAIT_BAR(3); RESC(); ROT();
    STEP(pA0,pA1,pB0,pB1,t+1,true,true,true);   WAIT_BAR(3); RESC(); ROT();
  }
  #undef CMASK
  int hi_b=hi,qrel_b=qrel; asm volatile("":"+v"(hi_b),"+v"(qrel_b));
  #define CMASK(P0,P1,t) do{int jb_=(t)-(NT-4); if(jb_>=0)cmask(P0,P1,jb_,qrel_b,hi_b);}while(0)
  #define ENDW(tt) do{ if((tt)+3<NT){WAIT_BAR(3);} else if((tt)+2<NT){WAIT_BAR(2);} else {WAIT_BAR(0);} }while(0)
  for(;t+1<NT;t+=2){
    STEP(pB0,pB1,pA0,pA1,t,(t+3<NT),(t+1<NT),(t+1<NT));       ENDW(t);   RESC(); ROT();
    STEP(pA0,pA1,pB0,pB1,t+1,(t+4<NT),(t+2<NT),(t+2<NT));     ENDW(t+1); RESC(); ROT();
  }
  STEP(pB0,pB1,pA0,pA1,NT-1,false,false,false); RESC();
  { float sacc=pB0[0]+pB0[1]; _Pragma("unroll") for(int r=2;r<16;++r)sacc+=pB0[r]; _Pragma("unroll") for(int r=0;r<16;++r)sacc+=pB1[r]; l_reg+=sacc;
    pw0=(u32x4){PKW(pB0,0),PKW(pB0,2),PKW(pB0,4),PKW(pB0,6)};pw1=(u32x4){PKW(pB0,8),PKW(pB0,10),PKW(pB0,12),PKW(pB0,14)};pw2=(u32x4){PKW(pB1,0),PKW(pB1,2),PKW(pB1,4),PKW(pB1,6)};pw3=(u32x4){PKW(pB1,8),PKW(pB1,10),PKW(pB1,12),PKW(pB1,14)};
    SBAR(); pv(o,vb0+2*sl_cur,PAF(0),PAF(1),PAF(2),PAF(3)); }
  #undef PKW
  #undef PAF
  #undef VFJ
  #undef VJ
  #undef PVJ
  #undef PIN
  #undef MX3
  #undef GAPA
  #undef EX
  #undef KRD
  #undef STEP
  #undef ENDW
  int lanee=lane; asm volatile("":"+v"(lanee)); const int r32e=lanee&31,hie=lanee>>5;
  {auto rr=__builtin_amdgcn_permlane32_swap(__float_as_uint(l_reg),__float_as_uint(l_reg),false,false);l_reg=__uint_as_float(rr[0])+__uint_as_float(rr[1]);}
  if(hie==0)wsf[32+r32e]=l_reg;asm volatile("s_waitcnt lgkmcnt(0)":::"memory");
  float rli[16];
  #pragma unroll
  for(int r=0;r<16;++r)rli[r]=__builtin_amdgcn_rcpf(wsf[32+crow(r,hie)]);
  bf16*Ow=Oh+(long)(q0+wid*QBLK)*LDO;
  asm volatile("s_waitcnt lgkmcnt(0)\n\ts_barrier":::"memory");
  { bf16*stg=(bf16*)(shm)+wid*4096;
    #pragma unroll
    for(int r=0;r<16;++r){const int orow=crow(r,hie);
      #pragma unroll
      for(int d0=0;d0<4;++d0)stg[orow*128+d0*32+r32e]=__float2bfloat16(o[d0][r]*rli[r]);}
    asm volatile("s_waitcnt lgkmcnt(0)":::"memory");
    #pragma unroll
    for(int i=0;i<8;++i){const int row=i*4+(lanee>>4),ch=lanee&15; const u32x4 v=*(const u32x4*)(stg+row*128+ch*8); ATTN_STORE16(Ow+(long)row*LDO+ch*8,v);} }
  asm volatile("s_waitcnt lgkmcnt(0)\n\ts_barrier":::"memory");
  #undef DMA_K
  #undef DMA_V
  #undef CMASK
  #undef START
  #undef RESC
  #undef ROT
}
constexpr int ATTN_LDS_BYTES=LDS_BYTES;
template<int THRL=8> __device__ __forceinline__ void attn_phase(char*lds,const bf16*PE,bf16*AO,int vcu,int G){
  const int nu=(G==256)?2:((8*NQB-vcu+G-1)/G);
  #pragma unroll 1
  for(int i=0;i<nu;++i){
    int h2,qb;
    if(G==256){ const int s=vcu&31; h2=vcu>>5; qb=(i==0)?s:63-s; }
    else { const int u=vcu+i*G; h2=u/NQB; qb=u%NQB; }
    attn_unit<THRL>(qb,PE+h2*64,PE+512+h2*64,PE+1024+(h2>>1)*128,AO+h2*128,lds);
  }
}
#undef SBAR
#undef WAIT_BAR
}

#define GAS __attribute__((address_space(1)))
#define LAS __attribute__((address_space(3)))
typedef unsigned short bf16;
typedef unsigned v4u __attribute__((ext_vector_type(4)));
typedef float f32x4 __attribute__((ext_vector_type(4)));
typedef short bf16x8 __attribute__((ext_vector_type(8)));
typedef GAS unsigned gu32;
typedef GAS unsigned long long gu64;
#define RLX_AGENT __ATOMIC_RELAXED, __HIP_MEMORY_SCOPE_AGENT
#define LDS_WAIT() asm volatile("s_waitcnt lgkmcnt(0)" ::: "memory")
#define VM_WAIT() asm volatile("s_waitcnt vmcnt(0)" ::: "memory")
__device__ __forceinline__ unsigned long long rt() { return __builtin_amdgcn_s_memrealtime(); }
__device__ __forceinline__ unsigned f2bf(float f) { unsigned u = __builtin_bit_cast(unsigned, f); return (u + 0x7fffu + ((u >> 16) & 1u)) >> 16; }
__device__ __forceinline__ unsigned pk2(float lo, float hi) { return f2bf(lo) | (f2bf(hi) << 16); }

#define XB_TMO      128
#define XB_XCNT(j)  (256  + 64 * (j))
#define XB_XSUB(j)  (1280 + 64 * (j))
#define XB_XGEN(j)  (2304 + 64 * (j))
#define XB_TOP      3328
#define XB_TOPGEN   3392
#define XCD_BAR_WORDS 3456
#define XB_SPIN_CAP (1u << 18)

__device__ __forceinline__ unsigned xb_ld(unsigned* p)              { return __hip_atomic_load(p, __ATOMIC_RELAXED, __HIP_MEMORY_SCOPE_AGENT); }
__device__ __forceinline__ unsigned xb_add(unsigned* p, unsigned v) { return __hip_atomic_fetch_add(p, v, __ATOMIC_RELAXED, __HIP_MEMORY_SCOPE_AGENT); }
__device__ __forceinline__ unsigned xb_xcc_id() { return (unsigned)__builtin_amdgcn_s_getreg((3 << 11) | 20) & 0xFu; }
#define XB_SPIN(cond, bar) do { unsigned _sp = 0; while (cond) { __builtin_amdgcn_s_sleep(1); \
    if ((++_sp & 255u) == 0u) { if (xb_ld(&(bar)[XB_TMO])) break; if (_sp > XB_SPIN_CAP) { atomicAdd(&(bar)[XB_TMO], 1u); break; } } } } while (0)

struct XcdBarrier {
    unsigned* bar; unsigned x;
    volatile LAS unsigned* st;
};

__device__ __forceinline__ XcdBarrier xcd_barrier_post(unsigned* bar, volatile LAS unsigned* st) {
    XcdBarrier b; b.bar = bar; b.x = xb_xcc_id(); b.st = st;
    if (threadIdx.x == 0) (void)xb_add(&bar[XB_XCNT(b.x)], 1u);
    return b;
}
__device__ __forceinline__ void xcd_barrier_complete(unsigned* bar, unsigned x, unsigned& nloc, unsigned& nx) {
    const unsigned G = gridDim.x * gridDim.y * gridDim.z;
    unsigned sum, cnt, mine, sp = 0u;
    for (;;) {
        sum = 0u; cnt = 0u; mine = 0u;
#pragma unroll
        for (unsigned j = 0; j < 16; ++j) { const unsigned c = xb_ld(&bar[XB_XCNT(j)]); sum += c; cnt += (c > 0u) ? 1u : 0u; mine = (j == x) ? c : mine; }
        if (sum == G) break;
        __builtin_amdgcn_s_sleep(1);
        if ((++sp & 255u) == 0u) { if (xb_ld(&bar[XB_TMO])) break; if (sp > XB_SPIN_CAP) { atomicAdd(&bar[XB_TMO], 1u); break; } }
    }
    nloc = mine > 0u ? mine : 1u; nx = cnt > 0u ? cnt : 1u;
}

__device__ __forceinline__ void xcd_barrier(const XcdBarrier& b) {
    asm volatile("s_waitcnt vmcnt(0)" ::: "memory");
    __syncthreads();
    if (threadIdx.x == 0) {
        unsigned* bar = b.bar;
        __builtin_amdgcn_s_waitcnt(0);
        unsigned nloc = b.st[0], nx = b.st[1];
        if (nloc == 0u) { xcd_barrier_complete(bar, b.x, nloc, nx); b.st[0] = nloc; b.st[1] = nx; }
        const unsigned old = xb_add(&bar[XB_XSUB(b.x)], 1u);
        const unsigned gen = old / nloc;
        if (old + 1u == (gen + 1u) * nloc) {
            __builtin_amdgcn_fence(__ATOMIC_RELEASE, "agent");
            asm volatile("s_waitcnt vmcnt(0)" ::: "memory");
            const unsigned og = xb_add(&bar[XB_TOP], 1u);
            const unsigned tg = og / nx;
            if (og + 1u == (tg + 1u) * nx) xb_add(&bar[XB_TOPGEN], 1u);
            else XB_SPIN(xb_ld(&bar[XB_TOPGEN]) == tg, bar);
            __builtin_amdgcn_fence(__ATOMIC_ACQUIRE, "agent");
            xb_add(&bar[XB_XGEN(b.x)], 1u);
            asm volatile("s_waitcnt vmcnt(0)" ::: "memory");
        } else {
            XB_SPIN(xb_ld(&bar[XB_XGEN(b.x)]) == gen, bar);
            __builtin_amdgcn_fence(__ATOMIC_ACQUIRE, "agent");
            asm volatile("s_waitcnt vmcnt(0)" ::: "memory");
        }
    }
    __syncthreads();
}

constexpr int NWAVES = 8;
constexpr size_t MiB = 1u << 20;
constexpr size_t WS_CTL = 0, CTL_ZERO_BYTES = 1 * MiB;
constexpr size_t WS_TAB = 1 * MiB;
constexpr size_t WS_SSQA = 2 * MiB, WS_SSQB = 3 * MiB;
constexpr size_t WS_GB = 4 * MiB;
constexpr size_t WS_GC = 512 * 1024;
constexpr size_t WS_TOK = 5 * MiB;
constexpr size_t WS_W = 6 * MiB;
constexpr size_t WS_WINE = WS_W, WS_WOUTE = WS_W + 12 * MiB, WS_W13D = WS_W + 16 * MiB, WS_W2D = WS_W + 44 * MiB, WS_WINO = WS_W + 58 * MiB, WS_WOUTO = WS_W + 74 * MiB,
                 WS_WG = WS_W + 78 * MiB, WS_WP = WS_W + 86 * MiB, WS_W13M = WS_W + 88 * MiB, WS_W2M = WS_W + 200 * MiB;
constexpr size_t WS_PBF = 262 * MiB, WS_HBF = 294 * MiB, WS_PP = 326 * MiB, WS_MIX = 358 * MiB, WS_ARENA = 390 * MiB;
constexpr size_t AR_PE = 0, AR_AO = 96 * MiB;
constexpr size_t AR_PO = 0, AR_QN = 128 * MiB, AR_QT = 160 * MiB, AR_KN = 192 * MiB, AR_KGT = 224 * MiB, AR_VBT = 256 * MiB, AR_KTT = 288 * MiB, AR_AI = 320 * MiB, AR_NEGW = 336 * MiB,
                 AR_UT = 368 * MiB, AR_MP = 400 * MiB, AR_NT = 464 * MiB, AR_WT = 528 * MiB, AR_SG = 192 * MiB  , AR_MPC = 400 * MiB  , AR_NTC = 416 * MiB, AR_END = 560 * MiB;
constexpr size_t AR_ACT = 0, AR_XS = 240 * MiB, AR_Y = 308 * MiB;
constexpr size_t WS_NEED = WS_ARENA + AR_END;
constexpr size_t TOK_E = 0, TOK_R = 128 * 1024, TOK_G = 256 * 1024, TOK_DST = 384 * 1024, TOK_GPAD = 512 * 1024, TOK_DN = 704 * 1024, TOK_DNC = 720 * 1024;
constexpr int CW_TMO = 0, CW_BAR = 4096, CW_CNT = 8192  , CW_DBG = 12288;

constexpr int RING_OFF = 0, WAVE_LDS = 17408;
constexpr int LDSCTL_OFF = 139264, MISC_OFF = LDSCTL_OFF + 64, BLKE_OFF = LDSCTL_OFF + 256  , RT_OFF = LDSCTL_OFF + 1024  ;
constexpr int LDS_BYTES = 147456;

typedef unsigned u32x2v __attribute__((ext_vector_type(2)));
__device__ __forceinline__ float bflo(unsigned w) { return __uint_as_float(w << 16); }
__device__ __forceinline__ float bfhi(unsigned w) { return __uint_as_float(w & 0xffff0000u); }
__device__ __forceinline__ unsigned cvtpk(float lo, float hi) { return pg8::cvt_pk_bf16_cv(lo, hi); }
__device__ __forceinline__ float wave_sum(float v) {
#pragma unroll
    for (int o = 1; o < 64; o <<= 1) v += __shfl_xor(v, o);
    return v;
}
__device__ __forceinline__ float sigm(float x) { return pg8::sigmoidf_(x); }
__device__ __forceinline__ float silu(float x) { return x * pg8::sigmoidf_(x); }

struct Args { const void* in[30]; float* out; unsigned char* ws; int ph_lo, ph_hi, use_bar, pad; };

struct Frame {
    LAS unsigned char* lds; int tid, lane, wave, vcu, G, gw, NGW;
};

__device__ __forceinline__ void xpose_item(const float* W, int ldw, int K, int N, const float* gain, bf16* WT, int ilv, LAS float* scr, int item, int lane) {
    const int nblk = N / 64, kb = item / nblk, nb = item % nblk, k0 = 64 * kb, n0 = 64 * nb;
    const int lr = lane >> 4, lc = (lane & 15) * 4;
    f32x4 v[16];
#pragma unroll
    for (int i = 0; i < 16; ++i) v[i] = *(const GAS f32x4*)(W + (size_t)(k0 + 4 * i + lr) * ldw + n0 + lc);
    if (gain) {
#pragma unroll
        for (int i = 0; i < 16; ++i) v[i] = v[i] * gain[k0 + 4 * i + lr]; }
#pragma unroll
    for (int i = 0; i < 16; ++i) { LAS float* s = scr + (4 * i + lr) * 65 + lc; s[0] = v[i][0]; s[1] = v[i][1]; s[2] = v[i][2]; s[3] = v[i][3]; }
    LDS_WAIT(); asm volatile("" ::: "memory");
    const int c = lane & 7;
#pragma unroll
    for (int j = 0; j < 8; ++j) { const int nl = (lane >> 3) + 8 * j, n = n0 + nl; const LAS float* s = scr + (8 * c) * 65 + nl;
        const int dr = ilv ? (((n >> 7) << 8) + (n & 127) + (ilv == 2 ? 128 : 0)) : n;
        v4u o; o.x = pk2(s[0 * 65], s[1 * 65]); o.y = pk2(s[2 * 65], s[3 * 65]); o.z = pk2(s[4 * 65], s[5 * 65]); o.w = pk2(s[6 * 65], s[7 * 65]);
        *(GAS v4u*)(WT + (size_t)dr * K + k0 + 8 * c) = o; }
    LDS_WAIT(); asm volatile("" ::: "memory");
}
struct MatD { const float* W; int ldw, K, N; const float* gain; bf16* WT; int ilv; int items; };
__device__ __forceinline__ MatD dense_mat(const Args& a, int id) {
    unsigned char* ws = a.ws; MatD m; m.gain = nullptr; m.ilv = 0;
    if (id < 2)       { const int j = id;      m.W = (const float*)a.in[7] + (size_t)j * D_ * EIN;    m.ldw = EIN; m.K = D_; m.N = EIN; m.gain = (const float*)a.in[3] + (2 * j) * D_; m.WT = (bf16*)(ws + WS_WINE) + (size_t)j * EIN * D_; }
    else if (id < 4)  { const int j = id - 2;  m.W = (const float*)a.in[8] + (size_t)j * D_ * D_;     m.ldw = D_; m.K = D_; m.N = D_; m.WT = (bf16*)(ws + WS_WOUTE) + (size_t)j * D_ * D_; }
    else if (id < 6)  { const int j = id - 4;  m.W = (const float*)a.in[21] + (size_t)j * D_ * DFF;   m.ldw = DFF; m.K = D_; m.N = DFF; m.gain = (const float*)a.in[4] + (2 * j) * D_; m.WT = (bf16*)(ws + WS_W13D) + (size_t)j * 2 * DFF * D_; m.ilv = 1; }
    else if (id < 8)  { const int j = id - 6;  m.W = (const float*)a.in[22] + (size_t)j * D_ * DFF;   m.ldw = DFF; m.K = D_; m.N = DFF; m.gain = (const float*)a.in[4] + (2 * j) * D_; m.WT = (bf16*)(ws + WS_W13D) + (size_t)j * 2 * DFF * D_; m.ilv = 2; }
    else if (id < 10) { const int j = id - 8;  m.W = (const float*)a.in[23] + (size_t)j * DFF * D_;   m.ldw = D_; m.K = DFF; m.N = D_; m.WT = (bf16*)(ws + WS_W2D) + (size_t)j * D_ * DFF; }
    else if (id < 12) { const int j = id - 10; m.W = (const float*)a.in[15] + (size_t)j * D_ * OIN_SRC; m.ldw = OIN_SRC; m.K = D_; m.N = OIN; m.gain = (const float*)a.in[3] + (2 * j + 1) * D_; m.WT = (bf16*)(ws + WS_WINO) + (size_t)j * OIN * D_; }
    else if (id < 14) { const int j = id - 12; m.W = (const float*)a.in[20] + (size_t)j * D_ * D_;    m.ldw = D_; m.K = D_; m.N = D_; m.WT = (bf16*)(ws + WS_WOUTO) + (size_t)j * D_ * D_; }
    else if (id < 18) { const int i = id - 14; m.W = (const float*)a.in[28] + (size_t)i * D_ * D_;    m.ldw = D_; m.K = D_; m.N = D_; m.gain = (const float*)a.in[5] + i * D_; m.WT = (bf16*)(ws + WS_WG) + (size_t)i * D_ * D_; }
    else              { const int i = id - 18; m.W = (const float*)a.in[29] + (size_t)i * PLE * D_;   m.ldw = D_; m.K = PLE; m.N = D_; m.WT = (bf16*)(ws + WS_WP) + (size_t)i * D_ * PLE; }
    m.items = (m.K / 64) * (m.N / 64); return m;
}
__device__ __forceinline__ MatD moe_mat(const Args& a, int j, int id) {
    unsigned char* ws = a.ws; MatD m; m.gain = nullptr; m.ilv = 0; const int e = id / 3, k = id % 3;
    if (k < 2) { m.W = (const float*)a.in[25 + k] + ((size_t)j * NEXP + e) * D_ * DFF; m.ldw = DFF; m.K = D_; m.N = DFF; m.gain = (const float*)a.in[4] + (2 * j + 1) * D_; m.WT = (bf16*)(ws + WS_W13M) + (size_t)e * 2 * DFF * D_; m.ilv = 1 + k; }
    else       { m.W = (const float*)a.in[27] + ((size_t)j * NEXP + e) * DFF * D_; m.ldw = D_; m.K = DFF; m.N = D_; m.WT = (bf16*)(ws + WS_W2M) + (size_t)e * D_ * DFF; }
    m.items = (m.K / 64) * (m.N / 64); return m;
}

__device__ __forceinline__ void p_prologue(const Frame& F, const Args& a) {
    LAS float* scr = (LAS float*)(F.lds + F.wave * WAVE_LDS);
    unsigned char* ws = a.ws;
    {
        int base = 0;
#pragma unroll 1
        for (int id = 0; id < 22; ++id) { const MatD m = dense_mat(a, id);
            int first = (F.gw - base) % F.NGW; if (first < 0) first += F.NGW;
#pragma unroll 1
            for (int it = first; it < m.items; it += F.NGW) xpose_item(m.W, m.ldw, m.K, m.N, m.gain, m.WT, m.ilv, scr, it, F.lane);
            base += m.items; }
    }
    { const float* p = (const float*)a.in[1]; bf16* pb = (bf16*)(ws + WS_PBF); const size_t n8 = (size_t)DEPTH_ * S_ * PLE / 8;
#pragma unroll 1
      for (size_t i = (size_t)F.gw * 64 + F.lane; i < n8; i += (size_t)F.NGW * 64) { const f32x4 x0 = *(const GAS f32x4*)(p + i * 8), x1 = *(const GAS f32x4*)(p + i * 8 + 4);
          v4u o; o.x = cvtpk(x0[0], x0[1]); o.y = cvtpk(x0[2], x0[3]); o.z = cvtpk(x1[0], x1[1]); o.w = cvtpk(x1[2], x1[3]); *(GAS v4u*)(pb + i * 8) = o; } }
#ifdef PROBE_PRO_NOC
    if (a.use_bar)
#endif
    { const float* x = (const float*)a.in[0]; bf16* hb = (bf16*)(ws + WS_HBF); float* ssq = (float*)(ws + WS_SSQB);
#pragma unroll 1
      for (int m = F.gw; m < S_; m += F.NGW) { const GAS f32x4* xr = (const GAS f32x4*)(x + (size_t)m * D_) + F.lane; float s = 0.f;
#pragma unroll
          for (int j = 0; j < 4; ++j) { const f32x4 v = xr[64 * j]; s += (v[0] * v[0] + v[1] * v[1]) + (v[2] * v[2] + v[3] * v[3]);
              *((GAS f32x4*)(a.out + (size_t)m * D_) + F.lane + 64 * j) = v;
              u32x2v o; o.x = cvtpk(v[0], v[1]); o.y = cvtpk(v[2], v[3]); *((GAS u32x2v*)(hb + (size_t)m * D_) + F.lane + 64 * j) = o; }
          s = wave_sum(s);
          if (F.lane < 16) ssq[(size_t)m * 16 + F.lane] = (F.lane == 0) ? s : 0.f; } }
    { const int* pos = (const int*)a.in[2]; float* tab = (float*)(ws + WS_TAB);
#pragma unroll 1
      for (int idx = F.gw * 64 + F.lane; idx < S_ * 8; idx += F.NGW * 64) { const int row = idx >> 3, i = idx & 7;
          const float inv = exp2f(-(float)i * (18.931568569324174f / 8.0f));
          const float ang = (float)pos[row] * inv;
          double t = (double)ang * 0.15915494309189535; t -= rint(t); const float tf = (float)t;
          tab[(size_t)row * 16 + i] = __builtin_amdgcn_cosf(tf); tab[(size_t)row * 16 + 8 + i] = __builtin_amdgcn_sinf(tf); } }
}

__device__ __forceinline__ void p_mixprep(const Frame& F, const Args& a, int L) {
    GAS unsigned char* ws = (GAS unsigned char*)a.ws; asm volatile("" : "+s"(ws)); int lane_ = F.lane; asm volatile("" : "+v"(lane_)); const int j = L >> 1, lane = lane_;
    const bf16* AO = (const bf16*)(ws + WS_ARENA + AR_AO); const bf16* PE = (const bf16*)(ws + WS_ARENA + AR_PE); bf16* mix = (bf16*)(ws + WS_MIX);
    const float lam0 = 0.8f - 0.6f * expf(-0.3f * (float)L);
    float s1 = ((const float*)a.in[9])[j * 64 + lane] * ((const float*)a.in[10])[j * 64 + lane], s2 = ((const float*)a.in[11])[j * 64 + lane] * ((const float*)a.in[12])[j * 64 + lane];
    s1 = wave_sum(s1); s2 = wave_sum(s2);
    const float lam = expf(s1) - expf(s2) + lam0, post = 1.0f - lam0;
    const int hh = lane >> 4, dd = (lane & 15) * 8, ch = lane * 8;
    float sg[8], w0[8], w1[8], w2[8];
#pragma unroll
    for (int e = 0; e < 8; ++e) { sg[e] = ((const float*)a.in[13])[j * 128 + dd + e] * post;
        w0[e] = ((const float*)a.in[14])[(j * 3 + 0) * 512 + ch + e]; w1[e] = ((const float*)a.in[14])[(j * 3 + 1) * 512 + ch + e]; w2[e] = ((const float*)a.in[14])[(j * 3 + 2) * 512 + ch + e]; }
#pragma unroll 1
    for (int t = F.gw; t < S_; t += F.NGW) {
        const v4u o1 = *(const GAS v4u*)(AO + (size_t)t * D_ + 256 * hh + dd), o2 = *(const GAS v4u*)(AO + (size_t)t * D_ + 256 * hh + 128 + dd);
        float d[8]; const unsigned a1[4] = {o1.x, o1.y, o1.z, o1.w}, a2[4] = {o2.x, o2.y, o2.z, o2.w}; float ss = 0.f;
#pragma unroll
        for (int q = 0; q < 4; ++q) { d[2 * q] = bflo(a1[q]) - lam * bflo(a2[q]); d[2 * q + 1] = bfhi(a1[q]) - lam * bfhi(a2[q]); ss += d[2 * q] * d[2 * q] + d[2 * q + 1] * d[2 * q + 1]; }
        ss += __shfl_xor(ss, 1); ss += __shfl_xor(ss, 2); ss += __shfl_xor(ss, 4); ss += __shfl_xor(ss, 8);
        const float rms = __builtin_amdgcn_rsqf(ss * (1.0f / 128.0f) + 1e-5f);
        v4u o; o.x = cvtpk(d[0] * rms * sg[0], d[1] * rms * sg[1]); o.y = cvtpk(d[2] * rms * sg[2], d[3] * rms * sg[3]); o.z = cvtpk(d[4] * rms * sg[4], d[5] * rms * sg[5]); o.w = cvtpk(d[6] * rms * sg[6], d[7] * rms * sg[7]);
        *(GAS v4u*)(mix + (size_t)t * D_ + hh * 128 + dd) = o;
        const bf16* r0 = PE + (size_t)t * EIN;
        const v4u bb = *(const GAS v4u*)(r0 + 1536 + ch), c0 = *(const GAS v4u*)(r0 + 2048 + ch), x0 = *(const GAS v4u*)(r0 + 2560 + ch);
        v4u c1 = {0u, 0u, 0u, 0u}, x1 = c1, c2 = c1, x2 = c1;
        if (t >= 1) { c1 = *(const GAS v4u*)(r0 - EIN + 2048 + ch); x1 = *(const GAS v4u*)(r0 - EIN + 2560 + ch); }
        if (t >= 2) { c2 = *(const GAS v4u*)(r0 - 2 * EIN + 2048 + ch); x2 = *(const GAS v4u*)(r0 - 2 * EIN + 2560 + ch); }
        const unsigned B[4] = {bb.x, bb.y, bb.z, bb.w}, C0[4] = {c0.x, c0.y, c0.z, c0.w}, X0[4] = {x0.x, x0.y, x0.z, x0.w}, C1[4] = {c1.x, c1.y, c1.z, c1.w}, X1[4] = {x1.x, x1.y, x1.z, x1.w},
                       C2[4] = {c2.x, c2.y, c2.z, c2.w}, X2[4] = {x2.x, x2.y, x2.z, x2.w};
        float sc[8];
#pragma unroll
        for (int q = 0; q < 4; ++q) {
            sc[2 * q] = bflo(B[q]) * (w2[2 * q] * (bflo(C0[q]) * bflo(X0[q])) + w1[2 * q] * (bflo(C1[q]) * bflo(X1[q])) + w0[2 * q] * (bflo(C2[q]) * bflo(X2[q])));
            sc[2 * q + 1] = bfhi(B[q]) * (w2[2 * q + 1] * (bfhi(C0[q]) * bfhi(X0[q])) + w1[2 * q + 1] * (bfhi(C1[q]) * bfhi(X1[q])) + w0[2 * q + 1] * (bfhi(C2[q]) * bfhi(X2[q]))); }
        v4u so; so.x = cvtpk(sc[0], sc[1]); so.y = cvtpk(sc[2], sc[3]); so.z = cvtpk(sc[4], sc[5]); so.w = cvtpk(sc[6], sc[7]);
        *(GAS v4u*)(mix + (size_t)t * D_ + 512 + ch) = so;
    }
}


__device__ __forceinline__ void p_rot(const Frame& F, const Args& a) {
    GAS unsigned char* ws = (GAS unsigned char*)a.ws; asm volatile("" : "+s"(ws)); int lane_ = F.lane; asm volatile("" : "+v"(lane_)); const int lane = lane_;
    bf16* PE = (bf16*)(ws + WS_ARENA + AR_PE); const float* tab = (const float*)(ws + WS_TAB);
    const int hd = lane >> 2, i0 = 2 * (lane & 3), col = (hd < 8 ? hd * 64 : 512 + (hd - 8) * 64) + i0;
#pragma unroll 1
    for (int t = F.gw; t < S_; t += F.NGW) {
        GAS unsigned* p1 = (GAS unsigned*)(PE + (size_t)t * EIN + col); GAS unsigned* p2 = (GAS unsigned*)(PE + (size_t)t * EIN + col + 8);
        const unsigned w1 = *p1, w2 = *p2;
        const float c0 = tab[(size_t)t * 16 + i0], c1 = tab[(size_t)t * 16 + i0 + 1], s0 = tab[(size_t)t * 16 + 8 + i0], s1 = tab[(size_t)t * 16 + 8 + i0 + 1];
        const float a0 = bflo(w1), a1 = bfhi(w1), b0 = bflo(w2), b1 = bfhi(w2);
        *p1 = cvtpk(a0 * c0 - b0 * s0, a1 * c1 - b1 * s1); *p2 = cvtpk(b0 * c0 + a0 * s0, b1 * c1 + a1 * s1);
    }
}
__device__ __forceinline__ void p_ab(const Frame& F, const Args& a, int L) {
    GAS unsigned char* ws = (GAS unsigned char*)a.ws; asm volatile("" : "+s"(ws)); int lane_ = F.lane; asm volatile("" : "+v"(lane_)); const int j = L >> 1, lane = lane_;
    LAS float* wl = (LAS float*)F.lds;
    const float* W = (const float*)a.in[15] + (size_t)j * D_ * OIN_SRC; const float* ln = (const float*)a.in[3] + L * D_;
    for (int idx = F.tid; idx < D_ * 16; idx += NWAVES * 64) { const int k = idx >> 4, c = idx & 15; wl[k * 20 + c] = ln[k] * W[(size_t)k * OIN_SRC + 4096 + c]; }
    __syncthreads();
    const float* ssq = (const float*)(ws + WS_SSQB); float* gg = (float*)(ws + WS_GB); float* gbeta = gg + S_ * 8;
    const float alog = ((const float*)a.in[17])[j * 8 + (lane & 7)], dtb = ((const float*)a.in[18])[j * 8 + (lane & 7)];
    const GAS float* hG = (const GAS float*)a.out;
#pragma unroll 1
    for (int t0 = F.gw; t0 < S_; t0 += 2 * F.NGW) {
        const int tb = t0 + F.NGW; const bool hasb = tb < S_; const int tbc = hasb ? tb : t0;
        float xa[16], xb[16];
#pragma unroll
        for (int i = 0; i < 16; ++i) { xa[i] = hG[(size_t)t0 * D_ + 64 * i + lane]; xb[i] = hG[(size_t)tbc * D_ + 64 * i + lane]; }
        const float rsa = pg8::rstd_row(ssq, t0), rsb = pg8::rstd_row(ssq, tbc);
        float acca[16], accb[16];
#pragma unroll
        for (int c = 0; c < 16; ++c) { acca[c] = 0.f; accb[c] = 0.f; }
#pragma unroll 4
        for (int i = 0; i < 16; ++i) { const LAS f32x4* wr = (const LAS f32x4*)(wl + (64 * i + lane) * 20);
#pragma unroll
            for (int q = 0; q < 4; ++q) { const f32x4 w = wr[q];
                acca[4 * q] += xa[i] * w[0]; acca[4 * q + 1] += xa[i] * w[1]; acca[4 * q + 2] += xa[i] * w[2]; acca[4 * q + 3] += xa[i] * w[3];
                accb[4 * q] += xb[i] * w[0]; accb[4 * q + 1] += xb[i] * w[1]; accb[4 * q + 2] += xb[i] * w[2]; accb[4 * q + 3] += xb[i] * w[3]; } }
        float minea = 0.f, mineb = 0.f;
#pragma unroll
        for (int c = 0; c < 16; ++c) { const float sa = wave_sum(acca[c]), sb = wave_sum(accb[c]); minea = ((lane & 15) == c) ? sa : minea; mineb = ((lane & 15) == c) ? sb : mineb; }
#pragma unroll
        for (int half = 0; half < 2; ++half) { if (half == 1 && !hasb) break;
            const int t = half ? tb : t0; const float mine = (half ? mineb * rsb : minea * rsa);
            if (lane < 8) gbeta[(size_t)t * 8 + lane] = sigm(mine);
            else if (lane < 16) { const float z = mine + dtb; const float sp = z > 20.f ? z : log1pf(expf(z)); gg[(size_t)t * 8 + lane - 8] = -expf(alog) * sp; } }
    }
    __syncthreads();
}
__device__ __forceinline__ void tri_solve(const LAS float* Lc, LAS bf16* Xs, int lane) {
    float x0, x1, x2, x3, x4, x5, x6, x7, x8, x9, x10, x11, x12, x13, x14, x15, x16, x17, x18, x19, x20, x21, x22, x23, x24, x25, x26, x27, x28, x29, x30, x31, x32, x33, x34, x35, x36, x37, x38, x39, x40, x41, x42, x43, x44, x45, x46, x47, x48, x49, x50, x51, x52, x53, x54, x55, x56, x57, x58, x59, x60, x61, x62, x63;
    { x63 = (lane == 63) ? 1.0f : 0.0f; asm volatile("" : "+v"(x63) : : "memory"); }
    { float s0 = 0.f, s1 = 0.f, s2 = 0.f, s3 = 0.f; { const f32x4 l = *(const LAS f32x4*)(Lc + 4276); s3 = fmaf(x63, l[3], s3); } x62 = (lane == 62) ? 1.0f : -((s0 + s1) + (s2 + s3)); asm volatile("" : "+v"(x62) : : "memory"); }
    { float s0 = 0.f, s1 = 0.f, s2 = 0.f, s3 = 0.f; { const f32x4 l = *(const LAS f32x4*)(Lc + 4208); s2 = fmaf(x62, l[2], s2); s3 = fmaf(x63, l[3], s3); } x61 = (lane == 61) ? 1.0f : -((s0 + s1) + (s2 + s3)); asm volatile("" : "+v"(x61) : : "memory"); }
    { float s0 = 0.f, s1 = 0.f, s2 = 0.f, s3 = 0.f; { const f32x4 l = *(const LAS f32x4*)(Lc + 4140); s1 = fmaf(x61, l[1], s1); s2 = fmaf(x62, l[2], s2); s3 = fmaf(x63, l[3], s3); } x60 = (lane == 60) ? 1.0f : -((s0 + s1) + (s2 + s3)); asm volatile("" : "+v"(x60) : : "memory"); }
    { float s0 = 0.f, s1 = 0.f, s2 = 0.f, s3 = 0.f; { const f32x4 l = *(const LAS f32x4*)(Lc + 4072); s0 = fmaf(x60, l[0], s0); s1 = fmaf(x61, l[1], s1); s2 = fmaf(x62, l[2], s2); s3 = fmaf(x63, l[3], s3); } x59 = (lane == 59) ? 1.0f : -((s0 + s1) + (s2 + s3)); asm volatile("" : "+v"(x59) : : "memory"); }
    { float s0 = 0.f, s1 = 0.f, s2 = 0.f, s3 = 0.f; { const f32x4 l = *(const LAS f32x4*)(Lc + 4000); s3 = fmaf(x59, l[3], s3); } { const f32x4 l = *(const LAS f32x4*)(Lc + 4004); s0 = fmaf(x60, l[0], s0); s1 = fmaf(x61, l[1], s1); s2 = fmaf(x62, l[2], s2); s3 = fmaf(x63, l[3], s3); } x58 = (lane == 58) ? 1.0f : -((s0 + s1) + (s2 + s3)); asm volatile("" : "+v"(x58) : : "memory"); }
    { float s0 = 0.f, s1 = 0.f, s2 = 0.f, s3 = 0.f; { const f32x4 l = *(const LAS f32x4*)(Lc + 3932); s2 = fmaf(x58, l[2], s2); s3 = fmaf(x59, l[3], s3); } { const f32x4 l = *(const LAS f32x4*)(Lc + 3936); s0 = fmaf(x60, l[0], s0); s1 = fmaf(x61, l[1], s1); s2 = fmaf(x62, l[2], s2); s3 = fmaf(x63, l[3], s3); } x57 = (lane == 57) ? 1.0f : -((s0 + s1) + (s2 + s3)); asm volatile("" : "+v"(x57) : : "memory"); }
    { float s0 = 0.f, s1 = 0.f, s2 = 0.f, s3 = 0.f; { const f32x4 l = *(const LAS f32x4*)(Lc + 3864); s1 = fmaf(x57, l[1], s1); s2 = fmaf(x58, l[2], s2); s3 = fmaf(x59, l[3], s3); } { const f32x4 l = *(const LAS f32x4*)(Lc + 3868); s0 = fmaf(x60, l[0], s0); s1 = fmaf(x61, l[1], s1); s2 = fmaf(x62, l[2], s2); s3 = fmaf(x63, l[3], s3); } x56 = (lane == 56) ? 1.0f : -((s0 + s1) + (s2 + s3)); asm volatile("" : "+v"(x56) : : "memory"); }
    { float s0 = 0.f, s1 = 0.f, s2 = 0.f, s3 = 0.f; { const f32x4 l = *(const LAS f32x4*)(Lc + 3796); s0 = fmaf(x56, l[0], s0); s1 = fmaf(x57, l[1], s1); s2 = fmaf(x58, l[2], s2); s3 = fmaf(x59, l[3], s3); } { const f32x4 l = *(const LAS f32x4*)(Lc + 3800); s0 = fmaf(x60, l[0], s0); s1 = fmaf(x61, l[1], s1); s2 = fmaf(x62, l[2], s2); s3 = fmaf(x63, l[3], s3); } x55 = (lane == 55) ? 1.0f : -((s0 + s1) + (s2 + s3)); asm volatile("" : "+v"(x55) : : "memory"); }
    { float s0 = 0.f, s1 = 0.f, s2 = 0.f, s3 = 0.f; { const f32x4 l = *(const LAS f32x4*)(Lc + 3724); s3 = fmaf(x55, l[3], s3); } { const f32x4 l = *(const LAS f32x4*)(Lc + 3728); s0 = fmaf(x56, l[0], s0); s1 = fmaf(x57, l[1], s1); s2 = fmaf(x58, l[2], s2); s3 = fmaf(x59, l[3], s3); } { const f32x4 l = *(const LAS f32x4*)(Lc + 3732); s0 = fmaf(x60, l[0], s0); s1 = fmaf(x61, l[1], s1); s2 = fmaf(x62, l[2], s2); s3 = fmaf(x63, l[3], s3); } x54 = (lane == 54) ? 1.0f : -((s0 + s1) + (s2 + s3)); asm volatile("" : "+v"(x54) : : "memory"); }
    { float s0 = 0.f, s1 = 0.f, s2 = 0.f, s3 = 0.f; { const f32x4 l = *(const LAS f32x4*)(Lc + 3656); s2 = fmaf(x54, l[2], s2); s3 = fmaf(x55, l[3], s3); } { const f32x4 l = *(const LAS f32x4*)(Lc + 3660); s0 = fmaf(x56, l[0], s0); s1 = fmaf(x57, l[1], s1); s2 = fmaf(x58, l[2], s2); s3 = fmaf(x59, l[3], s3); } { const f32x4 l = *(const LAS f32x4*)(Lc + 3664); s0 = fmaf(x60, l[0], s0); s1 = fmaf(x61, l[1], s1); s2 = fmaf(x62, l[2], s2); s3 = fmaf(x63, l[3], s3); } x53 = (lane == 53) ? 1.0f : -((s0 + s1) + (s2 + s3)); asm volatile("" : "+v"(x53) : : "memory"); }
    { float s0 = 0.f, s1 = 0.f, s2 = 0.f, s3 = 0.f; { const f32x4 l = *(const LAS f32x4*)(Lc + 3588); s1 = fmaf(x53, l[1], s1); s2 = fmaf(x54, l[2], s2); s3 = fmaf(x55, l[3], s3); } { const f32x4 l = *(const LAS f32x4*)(Lc + 3592); s0 = fmaf(x56, l[0], s0); s1 = fmaf(x57, l[1], s1); s2 = fmaf(x58, l[2], s2); s3 = fmaf(x59, l[3], s3); } { const f32x4 l = *(const LAS f32x4*)(Lc + 3596); s0 = fmaf(x60, l[0], s0); s1 = fmaf(x61, l[1], s1); s2 = fmaf(x62, l[2], s2); s3 = fmaf(x63, l[3], s3); } x52 = (lane == 52) ? 1.0f : -((s0 + s1) + (s2 + s3)); asm volatile("" : "+v"(x52) : : "memory"); }
    { float s0 = 0.f, s1 = 0.f, s2 = 0.f, s3 = 0.f; { const f32x4 l = *(const LAS f32x4*)(Lc + 3520); s0 = fmaf(x52, l[0], s0); s1 = fmaf(x53, l[1], s1); s2 = fmaf(x54, l[2], s2); s3 = fmaf(x55, l[3], s3); } { const f32x4 l = *(const LAS f32x4*)(Lc + 3524); s0 = fmaf(x56, l[0], s0); s1 = fmaf(x57, l[1], s1); s2 = fmaf(x58, l[2], s2); s3 = fmaf(x59, l[3], s3); } { const f32x4 l = *(const LAS f32x4*)(Lc + 3528); s0 = fmaf(x60, l[0], s0); s1 = fmaf(x61, l[1], s1); s2 = fmaf(x62, l[2], s2); s3 = fmaf(x63, l[3], s3); } x51 = (lane == 51) ? 1.0f : -((s0 + s1) + (s2 + s3)); asm volatile("" : "+v"(x51) : : "memory"); }
    { float s0 = 0.f, s1 = 0.f, s2 = 0.f, s3 = 0.f; { const f32x4 l = *(const LAS f32x4*)(Lc + 3448); s3 = fmaf(x51, l[3], s3); } { const f32x4 l = *(const LAS f32x4*)(Lc + 3452); s0 = fmaf(x52, l[0], s0); s1 = fmaf(x53, l[1], s1); s2 = fmaf(x54, l[2], s2); s3 = fmaf(x55, l[3], s3); } { const f32x4 l = *(const LAS f32x4*)(Lc + 3456); s0 = fmaf(x56, l[0], s0); s1 = fmaf(x57, l[1], s1); s2 = fmaf(x58, l[2], s2); s3 = fmaf(x59, l[3], s3); } { const f32x4 l = *(const LAS f32x4*)(Lc + 3460); s0 = fmaf(x60, l[0], s0); s1 = fmaf(x61, l[1], s1); s2 = fmaf(x62, l[2], s2); s3 = fmaf(x63, l[3], s3); } x50 = (lane == 50) ? 1.0f : -((s0 + s1) + (s2 + s3)); asm volatile("" : "+v"(x50) : : "memory"); }
    { float s0 = 0.f, s1 = 0.f, s2 = 0.f, s3 = 0.f; { const f32x4 l = *(const LAS f32x4*)(Lc + 3380); s2 = fmaf(x50, l[2], s2); s3 = fmaf(x51, l[3], s3); } { const f32x4 l = *(const LAS f32x4*)(Lc + 3384); s0 = fmaf(x52, l[0], s0); s1 = fmaf(x53, l[1], s1); s2 = fmaf(x54, l[2], s2); s3 = fmaf(x55, l[3], s3); } { const f32x4 l = *(const LAS f32x4*)(Lc + 3388); s0 = fmaf(x56, l[0], s0); s1 = fmaf(x57, l[1], s1); s2 = fmaf(x58, l[2], s2); s3 = fmaf(x59, l[3], s3); } { const f32x4 l = *(const LAS f32x4*)(Lc + 3392); s0 = fmaf(x60, l[0], s0); s1 = fmaf(x61, l[1], s1); s2 = fmaf(x62, l[2], s2); s3 = fmaf(x63, l[3], s3); } x49 = (lane == 49) ? 1.0f : -((s0 + s1) + (s2 + s3)); asm volatile("" : "+v"(x49) : : "memory"); }
    { float s0 = 0.f, s1 = 0.f, s2 = 0.f, s3 = 0.f; { const f32x4 l = *(const LAS f32x4*)(Lc + 3312); s1 = fmaf(x49, l[1], s1); s2 = fmaf(x50, l[2], s2); s3 = fmaf(x51, l[3], s3); } { const f32x4 l = *(const LAS f32x4*)(Lc + 3316); s0 = fmaf(x52, l[0], s0); s1 = fmaf(x53, l[1], s1); s2 = fmaf(x54, l[2], s2); s3 = fmaf(x55, l[3], s3); } { const f32x4 l = *(const LAS f32x4*)(Lc + 3320); s0 = fmaf(x56, l[0], s0); s1 = fmaf(x57, l[1], s1); s2 = fmaf(x58, l[2], s2); s3 = fmaf(x59, l[3], s3); } { const f32x4 l = *(const LAS f32x4*)(Lc + 3324); s0 = fmaf(x60, l[0], s0); s1 = fmaf(x61, l[1], s1); s2 = fmaf(x62, l[2], s2); s3 = fmaf(x63, l[3], s3); } x48 = (lane == 48) ? 1.0f : -((s0 + s1) + (s2 + s3)); asm volatile("" : "+v"(x48) : : "memory"); }
    { float s0 = 0.f, s1 = 0.f, s2 = 0.f, s3 = 0.f; { const f32x4 l = *(const LAS f32x4*)(Lc + 3244); s0 = fmaf(x48, l[0], s0); s1 = fmaf(x49, l[1], s1); s2 = fmaf(x50, l[2], s2); s3 = fmaf(x51, l[3], s3); } { const f32x4 l = *(const LAS f32x4*)(Lc + 3248); s0 = fmaf(x52, l[0], s0); s1 = fmaf(x53, l[1], s1); s2 = fmaf(x54, l[2], s2); s3 = fmaf(x55, l[3], s3); } { const f32x4 l = *(const LAS f32x4*)(Lc + 3252); s0 = fmaf(x56, l[0], s0); s1 = fmaf(x57, l[1], s1); s2 = fmaf(x58, l[2], s2); s3 = fmaf(x59, l[3], s3); } { const f32x4 l = *(const LAS f32x4*)(Lc + 3256); s0 = fmaf(x60, l[0], s0); s1 = fmaf(x61, l[1], s1); s2 = fmaf(x62, l[2], s2); s3 = fmaf(x63, l[3], s3); } x47 = (lane == 47) ? 1.0f : -((s0 + s1) + (s2 + s3)); asm volatile("" : "+v"(x47) : : "memory"); }
    { float s0 = 0.f, s1 = 0.f, s2 = 0.f, s3 = 0.f; { const f32x4 l = *(const LAS f32x4*)(Lc + 3172); s3 = fmaf(x47, l[3], s3); } { const f32x4 l = *(const LAS f32x4*)(Lc + 3176); s0 = fmaf(x48, l[0], s0); s1 = fmaf(x49, l[1], s1); s2 = fmaf(x50, l[2], s2); s3 = fmaf(x51, l[3], s3); } { const f32x4 l = *(const LAS f32x4*)(Lc + 3180); s0 = fmaf(x52, l[0], s0); s1 = fmaf(x53, l[1], s1); s2 = fmaf(x54, l[2], s2); s3 = fmaf(x55, l[3], s3); } { const f32x4 l = *(const LAS f32x4*)(Lc + 3184); s0 = fmaf(x56, l[0], s0); s1 = fmaf(x57, l[1], s1); s2 = fmaf(x58, l[2], s2); s3 = fmaf(x59, l[3], s3); } { const f32x4 l = *(const LAS f32x4*)(Lc + 3188); s0 = fmaf(x60, l[0], s0); s1 = fmaf(x61, l[1], s1); s2 = fmaf(x62, l[2], s2); s3 = fmaf(x63, l[3], s3); } x46 = (lane == 46) ? 1.0f : -((s0 + s1) + (s2 + s3)); asm volatile("" : "+v"(x46) : : "memory"); }
    { float s0 = 0.f, s1 = 0.f, s2 = 0.f, s3 = 0.f; { const f32x4 l = *(const LAS f32x4*)(Lc + 3104); s2 = fmaf(x46, l[2], s2); s3 = fmaf(x47, l[3], s3); } { const f32x4 l = *(const LAS f32x4*)(Lc + 3108); s0 = fmaf(x48, l[0], s0); s1 = fmaf(x49, l[1], s1); s2 = fmaf(x50, l[2], s2); s3 = fmaf(x51, l[3], s3); } { const f32x4 l = *(const LAS f32x4*)(Lc + 3112); s0 = fmaf(x52, l[0], s0); s1 = fmaf(x53, l[1], s1); s2 = fmaf(x54, l[2], s2); s3 = fmaf(x55, l[3], s3); } { const f32x4 l = *(const LAS f32x4*)(Lc + 3116); s0 = fmaf(x56, l[0], s0); s1 = fmaf(x57, l[1], s1); s2 = fmaf(x58, l[2], s2); s3 = fmaf(x59, l[3], s3); } { const f32x4 l = *(const LAS f32x4*)(Lc + 3120); s0 = fmaf(x60, l[0], s0); s1 = fmaf(x61, l[1], s1); s2 = fmaf(x62, l[2], s2); s3 = fmaf(x63, l[3], s3); } x45 = (lane == 45) ? 1.0f : -((s0 + s1) + (s2 + s3)); asm volatile("" : "+v"(x45) : : "memory"); }
    { float s0 = 0.f, s1 = 0.f, s2 = 0.f, s3 = 0.f; { const f32x4 l = *(const LAS f32x4*)(Lc + 3036); s1 = fmaf(x45, l[1], s1); s2 = fmaf(x46, l[2], s2); s3 = fmaf(x47, l[3], s3); } { const f32x4 l = *(const LAS f32x4*)(Lc + 3040); s0 = fmaf(x48, l[0], s0); s1 = fmaf(x49, l[1], s1); s2 = fmaf(x50, l[2], s2); s3 = fmaf(x51, l[3], s3); } { const f32x4 l = *(const LAS f32x4*)(Lc + 3044); s0 = fmaf(x52, l[0], s0); s1 = fmaf(x53, l[1], s1); s2 = fmaf(x54, l[2], s2); s3 = fmaf(x55, l[3], s3); } { const f32x4 l = *(const LAS f32x4*)(Lc + 3048); s0 = fmaf(x56, l[0], s0); s1 = fmaf(x57, l[1], s1); s2 = fmaf(x58, l[2], s2); s3 = fmaf(x59, l[3], s3); } { const f32x4 l = *(const LAS f32x4*)(Lc + 3052); s0 = fmaf(x60, l[0], s0); s1 = fmaf(x61, l[1], s1); s2 = fmaf(x62, l[2], s2); s3 = fmaf(x63, l[3], s3); } x44 = (lane == 44) ? 1.0f : -((s0 + s1) + (s2 + s3)); asm volatile("" : "+v"(x44) : : "memory"); }
    { float s0 = 0.f, s1 = 0.f, s2 = 0.f, s3 = 0.f; { const f32x4 l = *(const LAS f32x4*)(Lc + 2968); s0 = fmaf(x44, l[0], s0); s1 = fmaf(x45, l[1], s1); s2 = fmaf(x46, l[2], s2); s3 = fmaf(x47, l[3], s3); } { const f32x4 l = *(const LAS f32x4*)(Lc + 2972); s0 = fmaf(x48, l[0], s0); s1 = fmaf(x49, l[1], s1); s2 = fmaf(x50, l[2], s2); s3 = fmaf(x51, l[3], s3); } { const f32x4 l = *(const LAS f32x4*)(Lc + 2976); s0 = fmaf(x52, l[0], s0); s1 = fmaf(x53, l[1], s1); s2 = fmaf(x54, l[2], s2); s3 = fmaf(x55, l[3], s3); } { const f32x4 l = *(const LAS f32x4*)(Lc + 2980); s0 = fmaf(x56, l[0], s0); s1 = fmaf(x57, l[1], s1); s2 = fmaf(x58, l[2], s2); s3 = fmaf(x59, l[3], s3); } { const f32x4 l = *(const LAS f32x4*)(Lc + 2984); s0 = fmaf(x60, l[0], s0); s1 = fmaf(x61, l[1], s1); s2 = fmaf(x62, l[2], s2); s3 = fmaf(x63, l[3], s3); } x43 = (lane == 43) ? 1.0f : -((s0 + s1) + (s2 + s3)); asm volatile("" : "+v"(x43) : : "memory"); }
    { float s0 = 0.f, s1 = 0.f, s2 = 0.f, s3 = 0.f; { const f32x4 l = *(const LAS f32x4*)(Lc + 2896); s3 = fmaf(x43, l[3], s3); } { const f32x4 l = *(const LAS f32x4*)(Lc + 2900); s0 = fmaf(x44, l[0], s0); s1 = fmaf(x45, l[1], s1); s2 = fmaf(x46, l[2], s2); s3 = fmaf(x47, l[3], s3); } { const f32x4 l = *(const LAS f32x4*)(Lc + 2904); s0 = fmaf(x48, l[0], s0); s1 = fmaf(x49, l[1], s1); s2 = fmaf(x50, l[2], s2); s3 = fmaf(x51, l[3], s3); } { const f32x4 l = *(const LAS f32x4*)(Lc + 2908); s0 = fmaf(x52, l[0], s0); s1 = fmaf(x53, l[1], s1); s2 = fmaf(x54, l[2], s2); s3 = fmaf(x55, l[3], s3); } { const f32x4 l = *(const LAS f32x4*)(Lc + 2912); s0 = fmaf(x56, l[0], s0); s1 = fmaf(x57, l[1], s1); s2 = fmaf(x58, l[2], s2); s3 = fmaf(x59, l[3], s3); } { const f32x4 l = *(const LAS f32x4*)(Lc + 2916); s0 = fmaf(x60, l[0], s0); s1 = fmaf(x61, l[1], s1); s2 = fmaf(x62, l[2], s2); s3 = fmaf(x63, l[3], s3); } x42 = (lane == 42) ? 1.0f : -((s0 + s1) + (s2 + s3)); asm volatile("" : "+v"(x42) : : "memory"); }
    { float s0 = 0.f, s1 = 0.f, s2 = 0.f, s3 = 0.f; { const f32x4 l = *(const LAS f32x4*)(Lc + 2828); s2 = fmaf(x42, l[2], s2); s3 = fmaf(x43, l[3], s3); } { const f32x4 l = *(const LAS f32x4*)(Lc + 2832); s0 = fmaf(x44, l[0], s0); s1 = fmaf(x45, l[1], s1); s2 = fmaf(x46, l[2], s2); s3 = fmaf(x47, l[3], s3); } { const f32x4 l = *(const LAS f32x4*)(Lc + 2836); s0 = fmaf(x48, l[0], s0); s1 = fmaf(x49, l[1], s1); s2 = fmaf(x50, l[2], s2); s3 = fmaf(x51, l[3], s3); } { const f32x4 l = *(const LAS f32x4*)(Lc + 2840); s0 = fmaf(x52, l[0], s0); s1 = fmaf(x53, l[1], s1); s2 = fmaf(x54, l[2], s2); s3 = fmaf(x55, l[3], s3); } { const f32x4 l = *(const LAS f32x4*)(Lc + 2844); s0 = fmaf(x56, l[0], s0); s1 = fmaf(x57, l[1], s1); s2 = fmaf(x58, l[2], s2); s3 = fmaf(x59, l[3], s3); } { const f32x4 l = *(const LAS f32x4*)(Lc + 2848); s0 = fmaf(x60, l[0], s0); s1 = fmaf(x61, l[1], s1); s2 = fmaf(x62, l[2], s2); s3 = fmaf(x63, l[3], s3); } x41 = (lane == 41) ? 1.0f : -((s0 + s1) + (s2 + s3)); asm volatile("" : "+v"(x41) : : "memory"); }
    { float s0 = 0.f, s1 = 0.f, s2 = 0.f, s3 = 0.f; { const f32x4 l = *(const LAS f32x4*)(Lc + 2760); s1 = fmaf(x41, l[1], s1); s2 = fmaf(x42, l[2], s2); s3 = fmaf(x43, l[3], s3); } { const f32x4 l = *(const LAS f32x4*)(Lc + 2764); s0 = fmaf(x44, l[0], s0); s1 = fmaf(x45, l[1], s1); s2 = fmaf(x46, l[2], s2); s3 = fmaf(x47, l[3], s3); } { const f32x4 l = *(const LAS f32x4*)(Lc + 2768); s0 = fmaf(x48, l[0], s0); s1 = fmaf(x49, l[1], s1); s2 = fmaf(x50, l[2], s2); s3 = fmaf(x51, l[3], s3); } { const f32x4 l = *(const LAS f32x4*)(Lc + 2772); s0 = fmaf(x52, l[0], s0); s1 = fmaf(x53, l[1], s1); s2 = fmaf(x54, l[2], s2); s3 = fmaf(x55, l[3], s3); } { const f32x4 l = *(const LAS f32x4*)(Lc + 2776); s0 = fmaf(x56, l[0], s0); s1 = fmaf(x57, l[1], s1); s2 = fmaf(x58, l[2], s2); s3 = fmaf(x59, l[3], s3); } { const f32x4 l = *(const LAS f32x4*)(Lc + 2780); s0 = fmaf(x60, l[0], s0); s1 = fmaf(x61, l[1], s1); s2 = fmaf(x62, l[2], s2); s3 = fmaf(x63, l[3], s3); } x40 = (lane == 40) ? 1.0f : -((s0 + s1) + (s2 + s3)); asm volatile("" : "+v"(x40) : : "memory"); }
    { float s0 = 0.f, s1 = 0.f, s2 = 0.f, s3 = 0.f; { const f32x4 l = *(const LAS f32x4*)(Lc + 2692); s0 = fmaf(x40, l[0], s0); s1 = fmaf(x41, l[1], s1); s2 = fmaf(x42, l[2], s2); s3 = fmaf(x43, l[3], s3); } { const f32x4 l = *(const LAS f32x4*)(Lc + 2696); s0 = fmaf(x44, l[0], s0); s1 = fmaf(x45, l[1], s1); s2 = fmaf(x46, l[2], s2); s3 = fmaf(x47, l[3], s3); } { const f32x4 l = *(const LAS f32x4*)(Lc + 2700); s0 = fmaf(x48, l[0], s0); s1 = fmaf(x49, l[1], s1); s2 = fmaf(x50, l[2], s2); s3 = fmaf(x51, l[3], s3); } { const f32x4 l = *(const LAS f32x4*)(Lc + 2704); s0 = fmaf(x52, l[0], s0); s1 = fmaf(x53, l[1], s1); s2 = fmaf(x54, l[2], s2); s3 = fmaf(x55, l[3], s3); } { const f32x4 l = *(const LAS f32x4*)(Lc + 2708); s0 = fmaf(x56, l[0], s0); s1 = fmaf(x57, l[1], s1); s2 = fmaf(x58, l[2], s2); s3 = fmaf(x59, l[3], s3); } { const f32x4 l = *(const LAS f32x4*)(Lc + 2712); s0 = fmaf(x60, l[0], s0); s1 = fmaf(x61, l[1], s1); s2 = fmaf(x62, l[2], s2); s3 = fmaf(x63, l[3], s3); } x39 = (lane == 39) ? 1.0f : -((s0 + s1) + (s2 + s3)); asm volatile("" : "+v"(x39) : : "memory"); }
    { float s0 = 0.f, s1 = 0.f, s2 = 0.f, s3 = 0.f; { const f32x4 l = *(const LAS f32x4*)(Lc + 2620); s3 = fmaf(x39, l[3], s3); } { const f32x4 l = *(const LAS f32x4*)(Lc + 2624); s0 = fmaf(x40, l[0], s0); s1 = fmaf(x41, l[1], s1); s2 = fmaf(x42, l[2], s2); s3 = fmaf(x43, l[3], s3); } { const f32x4 l = *(const LAS f32x4*)(Lc + 2628); s0 = fmaf(x44, l[0], s0); s1 = fmaf(x45, l[1], s1); s2 = fmaf(x46, l[2], s2); s3 = fmaf(x47, l[3], s3); } { const f32x4 l = *(const LAS f32x4*)(Lc + 2632); s0 = fmaf(x48, l[0], s0); s1 = fmaf(x49, l[1], s1); s2 = fmaf(x50, l[2], s2); s3 = fmaf(x51, l[3], s3); } { const f32x4 l = *(const LAS f32x4*)(Lc + 2636); s0 = fmaf(x52, l[0], s0); s1 = fmaf(x53, l[1], s1); s2 = fmaf(x54, l[2], s2); s3 = fmaf(x55, l[3], s3); } { const f32x4 l = *(const LAS f32x4*)(Lc + 2640); s0 = fmaf(x56, l[0], s0); s1 = fmaf(x57, l[1], s1); s2 = fmaf(x58, l[2], s2); s3 = fmaf(x59, l[3], s3); } { const f32x4 l = *(const LAS f32x4*)(Lc + 2644); s0 = fmaf(x60, l[0], s0); s1 = fmaf(x61, l[1], s1); s2 = fmaf(x62, l[2], s2); s3 = fmaf(x63, l[3], s3); } x38 = (lane == 38) ? 1.0f : -((s0 + s1) + (s2 + s3)); asm volatile("" : "+v"(x38) : : "memory"); }
    { float s0 = 0.f, s1 = 0.f, s2 = 0.f, s3 = 0.f; { const f32x4 l = *(const LAS f32x4*)(Lc + 2552); s2 = fmaf(x38, l[2], s2); s3 = fmaf(x39, l[3], s3); } { const f32x4 l = *(const LAS f32x4*)(Lc + 2556); s0 = fmaf(x40, l[0], s0); s1 = fmaf(x41, l[1], s1); s2 = fmaf(x42, l[2], s2); s3 = fmaf(x43, l[3], s3); } { const f32x4 l = *(const LAS f32x4*)(Lc + 2560); s0 = fmaf(x44, l[0], s0); s1 = fmaf(x45, l[1], s1); s2 = fmaf(x46, l[2], s2); s3 = fmaf(x47, l[3], s3); } { const f32x4 l = *(const LAS f32x4*)(Lc + 2564); s0 = fmaf(x48, l[0], s0); s1 = fmaf(x49, l[1], s1); s2 = fmaf(x50, l[2], s2); s3 = fmaf(x51, l[3], s3); } { const f32x4 l = *(const LAS f32x4*)(Lc + 2568); s0 = fmaf(x52, l[0], s0); s1 = fmaf(x53, l[1], s1); s2 = fmaf(x54, l[2], s2); s3 = fmaf(x55, l[3], s3); } { const f32x4 l = *(const LAS f32x4*)(Lc + 2572); s0 = fmaf(x56, l[0], s0); s1 = fmaf(x57, l[1], s1); s2 = fmaf(x58, l[2], s2); s3 = fmaf(x59, l[3], s3); } { const f32x4 l = *(const LAS f32x4*)(Lc + 2576); s0 = fmaf(x60, l[0], s0); s1 = fmaf(x61, l[1], s1); s2 = fmaf(x62, l[2], s2); s3 = fmaf(x63, l[3], s3); } x37 = (lane == 37) ? 1.0f : -((s0 + s1) + (s2 + s3)); asm volatile("" : "+v"(x37) : : "memory"); }
    { float s0 = 0.f, s1 = 0.f, s2 = 0.f, s3 = 0.f; { const f32x4 l = *(const LAS f32x4*)(Lc + 2484); s1 = fmaf(x37, l[1], s1); s2 = fmaf(x38, l[2], s2); s3 = fmaf(x39, l[3], s3); } { const f32x4 l = *(const LAS f32x4*)(Lc + 2488); s0 = fmaf(x40, l[0], s0); s1 = fmaf(x41, l[1], s1); s2 = fmaf(x42, l[2], s2); s3 = fmaf(x43, l[3], s3); } { const f32x4 l = *(const LAS f32x4*)(Lc + 2492); s0 = fmaf(x44, l[0], s0); s1 = fmaf(x45, l[1], s1); s2 = fmaf(x46, l[2], s2); s3 = fmaf(x47, l[3], s3); } { const f32x4 l = *(const LAS f32x4*)(Lc + 2496); s0 = fmaf(x48, l[0], s0); s1 = fmaf(x49, l[1], s1); s2 = fmaf(x50, l[2], s2); s3 = fmaf(x51, l[3], s3); } { const f32x4 l = *(const LAS f32x4*)(Lc + 2500); s0 = fmaf(x52, l[0], s0); s1 = fmaf(x53, l[1], s1); s2 = fmaf(x54, l[2], s2); s3 = fmaf(x55, l[3], s3); } { const f32x4 l = *(const LAS f32x4*)(Lc + 2504); s0 = fmaf(x56, l[0], s0); s1 = fmaf(x57, l[1], s1); s2 = fmaf(x58, l[2], s2); s3 = fmaf(x59, l[3], s3); } { const f32x4 l = *(const LAS f32x4*)(Lc + 2508); s0 = fmaf(x60, l[0], s0); s1 = fmaf(x61, l[1], s1); s2 = fmaf(x62, l[2], s2); s3 = fmaf(x63, l[3], s3); } x36 = (lane == 36) ? 1.0f : -((s0 + s1) + (s2 + s3)); asm volatile("" : "+v"(x36) : : "memory"); }
    { float s0 = 0.f, s1 = 0.f, s2 = 0.f, s3 = 0.f; { const f32x4 l = *(const LAS f32x4*)(Lc + 2416); s0 = fmaf(x36, l[0], s0); s1 = fmaf(x37, l[1], s1); s2 = fmaf(x38, l[2], s2); s3 = fmaf(x39, l[3], s3); } { const f32x4 l = *(const LAS f32x4*)(Lc + 2420); s0 = fmaf(x40, l[0], s0); s1 = fmaf(x41, l[1], s1); s2 = fmaf(x42, l[2], s2); s3 = fmaf(x43, l[3], s3); } { const f32x4 l = *(const LAS f32x4*)(Lc + 2424); s0 = fmaf(x44, l[0], s0); s1 = fmaf(x45, l[1], s1); s2 = fmaf(x46, l[2], s2); s3 = fmaf(x47, l[3], s3); } { const f32x4 l = *(const LAS f32x4*)(Lc + 2428); s0 = fmaf(x48, l[0], s0); s1 = fmaf(x49, l[1], s1); s2 = fmaf(x50, l[2], s2); s3 = fmaf(x51, l[3], s3); } { const f32x4 l = *(const LAS f32x4*)(Lc + 2432); s0 = fmaf(x52, l[0], s0); s1 = fmaf(x53, l[1], s1); s2 = fmaf(x54, l[2], s2); s3 = fmaf(x55, l[3], s3); } { const f32x4 l = *(const LAS f32x4*)(Lc + 2436); s0 = fmaf(x56, l[0], s0); s1 = fmaf(x57, l[1], s1); s2 = fmaf(x58, l[2], s2); s3 = fmaf(x59, l[3], s3); } { const f32x4 l = *(const LAS f32x4*)(Lc + 2440); s0 = fmaf(x60, l[0], s0); s1 = fmaf(x61, l[1], s1); s2 = fmaf(x62, l[2], s2); s3 = fmaf(x63, l[3], s3); } x35 = (lane == 35) ? 1.0f : -((s0 + s1) + (s2 + s3)); asm volatile("" : "+v"(x35) : : "memory"); }
    { float s0 = 0.f, s1 = 0.f, s2 = 0.f, s3 = 0.f; { const f32x4 l = *(const LAS f32x4*)(Lc + 2344); s3 = fmaf(x35, l[3], s3); } { const f32x4 l = *(const LAS f32x4*)(Lc + 2348); s0 = fmaf(x36, l[0], s0); s1 = fmaf(x37, l[1], s1); s2 = fmaf(x38, l[2], s2); s3 = fmaf(x39, l[3], s3); } { const f32x4 l = *(const LAS f32x4*)(Lc + 2352); s0 = fmaf(x40, l[0], s0); s1 = fmaf(x41, l[1], s1); s2 = fmaf(x42, l[2], s2); s3 = fmaf(x43, l[3], s3); } { const f32x4 l = *(const LAS f32x4*)(Lc + 2356); s0 = fmaf(x44, l[0], s0); s1 = fmaf(x45, l[1], s1); s2 = fmaf(x46, l[2], s2); s3 = fmaf(x47, l[3], s3); } { const f32x4 l = *(const LAS f32x4*)(Lc + 2360); s0 = fmaf(x48, l[0], s0); s1 = fmaf(x49, l[1], s1); s2 = fmaf(x50, l[2], s2); s3 = fmaf(x51, l[3], s3); } { const f32x4 l = *(const LAS f32x4*)(Lc + 2364); s0 = fmaf(x52, l[0], s0); s1 = fmaf(x53, l[1], s1); s2 = fmaf(x54, l[2], s2); s3 = fmaf(x55, l[3], s3); } { const f32x4 l = *(const LAS f32x4*)(Lc + 2368); s0 = fmaf(x56, l[0], s0); s1 = fmaf(x57, l[1], s1); s2 = fmaf(x58, l[2], s2); s3 = fmaf(x59, l[3], s3); } { const f32x4 l = *(const LAS f32x4*)(Lc + 2372); s0 = fmaf(x60, l[0], s0); s1 = fmaf(x61, l[1], s1); s2 = fmaf(x62, l[2], s2); s3 = fmaf(x63, l[3], s3); } x34 = (lane == 34) ? 1.0f : -((s0 + s1) + (s2 + s3)); asm volatile("" : "+v"(x34) : : "memory"); }
    { float s0 = 0.f, s1 = 0.f, s2 = 0.f, s3 = 0.f; { const f32x4 l = *(const LAS f32x4*)(Lc + 2276); s2 = fmaf(x34, l[2], s2); s3 = fmaf(x35, l[3], s3); } { const f32x4 l = *(const LAS f32x4*)(Lc + 2280); s0 = fmaf(x36, l[0], s0); s1 = fmaf(x37, l[1], s1); s2 = fmaf(x38, l[2], s2); s3 = fmaf(x39, l[3], s3); } { const f32x4 l = *(const LAS f32x4*)(Lc + 2284); s0 = fmaf(x40, l[0], s0); s1 = fmaf(x41, l[1], s1); s2 = fmaf(x42, l[2], s2); s3 = fmaf(x43, l[3], s3); } { const f32x4 l = *(const LAS f32x4*)(Lc + 2288); s0 = fmaf(x44, l[0], s0); s1 = fmaf(x45, l[1], s1); s2 = fmaf(x46, l[2], s2); s3 = fmaf(x47, l[3], s3); } { const f32x4 l = *(const LAS f32x4*)(Lc + 2292); s0 = fmaf(x48, l[0], s0); s1 = fmaf(x49, l[1], s1); s2 = fmaf(x50, l[2], s2); s3 = fmaf(x51, l[3], s3); } { const f32x4 l = *(const LAS f32x4*)(Lc + 2296); s0 = fmaf(x52, l[0], s0); s1 = fmaf(x53, l[1], s1); s2 = fmaf(x54, l[2], s2); s3 = fmaf(x55, l[3], s3); } { const f32x4 l = *(const LAS f32x4*)(Lc + 2300); s0 = fmaf(x56, l[0], s0); s1 = fmaf(x57, l[1], s1); s2 = fmaf(x58, l[2], s2); s3 = fmaf(x59, l[3], s3); } { const f32x4 l = *(const LAS f32x4*)(Lc + 2304); s0 = fmaf(x60, l[0], s0); s1 = fmaf(x61, l[1], s1); s2 = fmaf(x62, l[2], s2); s3 = fmaf(x63, l[3], s3); } x33 = (lane == 33) ? 1.0f : -((s0 + s1) + (s2 + s3)); asm volatile("" : "+v"(x33) : : "memory"); }
    { float s0 = 0.f, s1 = 0.f, s2 = 0.f, s3 = 0.f; { const f32x4 l = *(const LAS f32x4*)(Lc + 2208); s1 = fmaf(x33, l[1], s1); s2 = fmaf(x34, l[2], s2); s3 = fmaf(x35, l[3], s3); } { const f32x4 l = *(const LAS f32x4*)(Lc + 2212); s0 = fmaf(x36, l[0], s0); s1 = fmaf(x37, l[1], s1); s2 = fmaf(x38, l[2], s2); s3 = fmaf(x39, l[3], s3); } { const f32x4 l = *(const LAS f32x4*)(Lc + 2216); s0 = fmaf(x40, l[0], s0); s1 = fmaf(x41, l[1], s1); s2 = fmaf(x42, l[2], s2); s3 = fmaf(x43, l[3], s3); } { const f32x4 l = *(const LAS f32x4*)(Lc + 2220); s0 = fmaf(x44, l[0], s0); s1 = fmaf(x45, l[1], s1); s2 = fmaf(x46, l[2], s2); s3 = fmaf(x47, l[3], s3); } { const f32x4 l = *(const LAS f32x4*)(Lc + 2224); s0 = fmaf(x48, l[0], s0); s1 = fmaf(x49, l[1], s1); s2 = fmaf(x50, l[2], s2); s3 = fmaf(x51, l[3], s3); } { const f32x4 l = *(const LAS f32x4*)(Lc + 2228); s0 = fmaf(x52, l[0], s0); s1 = fmaf(x53, l[1], s1); s2 = fmaf(x54, l[2], s2); s3 = fmaf(x55, l[3], s3); } { const f32x4 l = *(const LAS f32x4*)(Lc + 2232); s0 = fmaf(x56, l[0], s0); s1 = fmaf(x57, l[1], s1); s2 = fmaf(x58, l[2], s2); s3 = fmaf(x59, l[3], s3); } { const f32x4 l = *(const LAS f32x4*)(Lc + 2236); s0 = fmaf(x60, l[0], s0); s1 = fmaf(x61, l[1], s1); s2 = fmaf(x62, l[2], s2); s3 = fmaf(x63, l[3], s3); } x32 = (lane == 32) ? 1.0f : -((s0 + s1) + (s2 + s3)); asm volatile("" : "+v"(x32) : : "memory"); }
    { float s0 = 0.f, s1 = 0.f, s2 = 0.f, s3 = 0.f; { const f32x4 l = *(const LAS f32x4*)(Lc + 2140); s0 = fmaf(x32, l[0], s0); s1 = fmaf(x33, l[1], s1); s2 = fmaf(x34, l[2], s2); s3 = fmaf(x35, l[3], s3); } { const f32x4 l = *(const LAS f32x4*)(Lc + 2144); s0 = fmaf(x36, l[0], s0); s1 = fmaf(x37, l[1], s1); s2 = fmaf(x38, l[2], s2); s3 = fmaf(x39, l[3], s3); } { const f32x4 l = *(const LAS f32x4*)(Lc + 2148); s0 = fmaf(x40, l[0], s0); s1 = fmaf(x41, l[1], s1); s2 = fmaf(x42, l[2], s2); s3 = fmaf(x43, l[3], s3); } { const f32x4 l = *(const LAS f32x4*)(Lc + 2152); s0 = fmaf(x44, l[0], s0); s1 = fmaf(x45, l[1], s1); s2 = fmaf(x46, l[2], s2); s3 = fmaf(x47, l[3], s3); } { const f32x4 l = *(const LAS f32x4*)(Lc + 2156); s0 = fmaf(x48, l[0], s0); s1 = fmaf(x49, l[1], s1); s2 = fmaf(x50, l[2], s2); s3 = fmaf(x51, l[3], s3); } { const f32x4 l = *(const LAS f32x4*)(Lc + 2160); s0 = fmaf(x52, l[0], s0); s1 = fmaf(x53, l[1], s1); s2 = fmaf(x54, l[2], s2); s3 = fmaf(x55, l[3], s3); } { const f32x4 l = *(const LAS f32x4*)(Lc + 2164); s0 = fmaf(x56, l[0], s0); s1 = fmaf(x57, l[1], s1); s2 = fmaf(x58, l[2], s2); s3 = fmaf(x59, l[3], s3); } { const f32x4 l = *(const LAS f32x4*)(Lc + 2168); s0 = fmaf(x60, l[0], s0); s1 = fmaf(x61, l[1], s1); s2 = fmaf(x62, l[2], s2); s3 = fmaf(x63, l[3], s3); } x31 = (lane == 31) ? 1.0f : -((s0 + s1) + (s2 + s3)); asm volatile("" : "+v"(x31) : : "memory"); }
    { float s0 = 0.f, s1 = 0.f, s2 = 0.f, s3 = 0.f; { const f32x4 l = *(const LAS f32x4*)(Lc + 2068); s3 = fmaf(x31, l[3], s3); } { const f32x4 l = *(const LAS f32x4*)(Lc + 2072); s0 = fmaf(x32, l[0], s0); s1 = fmaf(x33, l[1], s1); s2 = fmaf(x34, l[2], s2); s3 = fmaf(x35, l[3], s3); } { const f32x4 l = *(const LAS f32x4*)(Lc + 2076); s0 = fmaf(x36, l[0], s0); s1 = fmaf(x37, l[1], s1); s2 = fmaf(x38, l[2], s2); s3 = fmaf(x39, l[3], s3); } { const f32x4 l = *(const LAS f32x4*)(Lc + 2080); s0 = fmaf(x40, l[0], s0); s1 = fmaf(x41, l[1], s1); s2 = fmaf(x42, l[2], s2); s3 = fmaf(x43, l[3], s3); } { const f32x4 l = *(const LAS f32x4*)(Lc + 2084); s0 = fmaf(x44, l[0], s0); s1 = fmaf(x45, l[1], s1); s2 = fmaf(x46, l[2], s2); s3 = fmaf(x47, l[3], s3); } { const f32x4 l = *(const LAS f32x4*)(Lc + 2088); s0 = fmaf(x48, l[0], s0); s1 = fmaf(x49, l[1], s1); s2 = fmaf(x50, l[2], s2); s3 = fmaf(x51, l[3], s3); } { const f32x4 l = *(const LAS f32x4*)(Lc + 2092); s0 = fmaf(x52, l[0], s0); s1 = fmaf(x53, l[1], s1); s2 = fmaf(x54, l[2], s2); s3 = fmaf(x55, l[3], s3); } { const f32x4 l = *(const LAS f32x4*)(Lc + 2096); s0 = fmaf(x56, l[0], s0); s1 = fmaf(x57, l[1], s1); s2 = fmaf(x58, l[2], s2); s3 = fmaf(x59, l[3], s3); } { const f32x4 l = *(const LAS f32x4*)(Lc + 2100); s0 = fmaf(x60, l[0], s0); s1 = fmaf(x61, l[1], s1); s2 = fmaf(x62, l[2], s2); s3 = fmaf(x63, l[3], s3); } x30 = (lane == 30) ? 1.0f : -((s0 + s1) + (s2 + s3)); asm volatile("" : "+v"(x30) : : "memory"); }
    { float s0 = 0.f, s1 = 0.f, s2 = 0.f, s3 = 0.f; { const f32x4 l = *(const LAS f32x4*)(Lc + 2000); s2 = fmaf(x30, l[2], s2); s3 = fmaf(x31, l[3], s3); } { const f32x4 l = *(const LAS f32x4*)(Lc + 2004); s0 = fmaf(x32, l[0], s0); s1 = fmaf(x33, l[1], s1); s2 = fmaf(x34, l[2], s2); s3 = fmaf(x35, l[3], s3); } { const f32x4 l = *(const LAS f32x4*)(Lc + 2008); s0 = fmaf(x36, l[0], s0); s1 = fmaf(x37, l[1], s1); s2 = fmaf(x38, l[2], s2); s3 = fmaf(x39, l[3], s3); } { const f32x4 l = *(const LAS f32x4*)(Lc + 2012); s0 = fmaf(x40, l[0], s0); s1 = fmaf(x41, l[1], s1); s2 = fmaf(x42, l[2], s2); s3 = fmaf(x43, l[3], s3); } { const f32x4 l = *(const LAS f32x4*)(Lc + 2016); s0 = fmaf(x44, l[0], s0); s1 = fmaf(x45, l[1], s1); s2 = fmaf(x46, l[2], s2); s3 = fmaf(x47, l[3], s3); } { const f32x4 l = *(const LAS f32x4*)(Lc + 2020); s0 = fmaf(x48, l[0], s0); s1 = fmaf(x49, l[1], s1); s2 = fmaf(x50, l[2], s2); s3 = fmaf(x51, l[3], s3); } { const f32x4 l = *(const LAS f32x4*)(Lc + 2024); s0 = fmaf(x52, l[0], s0); s1 = fmaf(x53, l[1], s1); s2 = fmaf(x54, l[2], s2); s3 = fmaf(x55, l[3], s3); } { const f32x4 l = *(const LAS f32x4*)(Lc + 2028); s0 = fmaf(x56, l[0], s0); s1 = fmaf(x57, l[1], s1); s2 = fmaf(x58, l[2], s2); s3 = fmaf(x59, l[3], s3); } { const f32x4 l = *(const LAS f32x4*)(Lc + 2032); s0 = fmaf(x60, l[0], s0); s1 = fmaf(x61, l[1], s1); s2 = fmaf(x62, l[2], s2); s3 = fmaf(x63, l[3], s3); } x29 = (lane == 29) ? 1.0f : -((s0 + s1) + (s2 + s3)); asm volatile("" : "+v"(x29) : : "memory"); }
    { float s0 = 0.f, s1 = 0.f, s2 = 0.f, s3 = 0.f; { const f32x4 l = *(const LAS f32x4*)(Lc + 1932); s1 = fmaf(x29, l[1], s1); s2 = fmaf(x30, l[2], s2); s3 = fmaf(x31, l[3], s3); } { const f32x4 l = *(const LAS f32x4*)(Lc + 1936); s0 = fmaf(x32, l[0], s0); s1 = fmaf(x33, l[1], s1); s2 = fmaf(x34, l[2], s2); s3 = fmaf(x35, l[3], s3); } { const f32x4 l = *(const LAS f32x4*)(Lc + 1940); s0 = fmaf(x36, l[0], s0); s1 = fmaf(x37, l[1], s1); s2 = fmaf(x38, l[2], s2); s3 = fmaf(x39, l[3], s3); } { const f32x4 l = *(const LAS f32x4*)(Lc + 1944); s0 = fmaf(x40, l[0], s0); s1 = fmaf(x41, l[1], s1); s2 = fmaf(x42, l[2], s2); s3 = fmaf(x43, l[3], s3); } { const f32x4 l = *(const LAS f32x4*)(Lc + 1948); s0 = fmaf(x44, l[0], s0); s1 = fmaf(x45, l[1], s1); s2 = fmaf(x46, l[2], s2); s3 = fmaf(x47, l[3], s3); } { const f32x4 l = *(const LAS f32x4*)(Lc + 1952); s0 = fmaf(x48, l[0], s0); s1 = fmaf(x49, l[1], s1); s2 = fmaf(x50, l[2], s2); s3 = fmaf(x51, l[3], s3); } { const f32x4 l = *(const LAS f32x4*)(Lc + 1956); s0 = fmaf(x52, l[0], s0); s1 = fmaf(x53, l[1], s1); s2 = fmaf(x54, l[2], s2); s3 = fmaf(x55, l[3], s3); } { const f32x4 l = *(const LAS f32x4*)(Lc + 1960); s0 = fmaf(x56, l[0], s0); s1 = fmaf(x57, l[1], s1); s2 = fmaf(x58, l[2], s2); s3 = fmaf(x59, l[3], s3); } { const f32x4 l = *(const LAS f32x4*)(Lc + 1964); s0 = fmaf(x60, l[0], s0); s1 = fmaf(x61, l[1], s1); s2 = fmaf(x62, l[2], s2); s3 = fmaf(x63, l[3], s3); } x28 = (lane == 28) ? 1.0f : -((s0 + s1) + (s2 + s3)); asm volatile("" : "+v"(x28) : : "memory"); }
    { float s0 = 0.f, s1 = 0.f, s2 = 0.f, s3 = 0.f; { const f32x4 l = *(const LAS f32x4*)(Lc + 1864); s0 = fmaf(x28, l[0], s0); s1 = fmaf(x29, l[1], s1); s2 = fmaf(x30, l[2], s2); s3 = fmaf(x31, l[3], s3); } { const f32x4 l = *(const LAS f32x4*)(Lc + 1868); s0 = fmaf(x32, l[0], s0); s1 = fmaf(x33, l[1], s1); s2 = fmaf(x34, l[2], s2); s3 = fmaf(x35, l[3], s3); } { const f32x4 l = *(const LAS f32x4*)(Lc + 1872); s0 = fmaf(x36, l[0], s0); s1 = fmaf(x37, l[1], s1); s2 = fmaf(x38, l[2], s2); s3 = fmaf(x39, l[3], s3); } { const f32x4 l = *(const LAS f32x4*)(Lc + 1876); s0 = fmaf(x40, l[0], s0); s1 = fmaf(x41, l[1], s1); s2 = fmaf(x42, l[2], s2); s3 = fmaf(x43, l[3], s3); } { const f32x4 l = *(const LAS f32x4*)(Lc + 1880); s0 = fmaf(x44, l[0], s0); s1 = fmaf(x45, l[1], s1); s2 = fmaf(x46, l[2], s2); s3 = fmaf(x47, l[3], s3); } { const f32x4 l = *(const LAS f32x4*)(Lc + 1884); s0 = fmaf(x48, l[0], s0); s1 = fmaf(x49, l[1], s1); s2 = fmaf(x50, l[2], s2); s3 = fmaf(x51, l[3], s3); } { const f32x4 l = *(const LAS f32x4*)(Lc + 1888); s0 = fmaf(x52, l[0], s0); s1 = fmaf(x53, l[1], s1); s2 = fmaf(x54, l[2], s2); s3 = fmaf(x55, l[3], s3); } { const f32x4 l = *(const LAS f32x4*)(Lc + 1892); s0 = fmaf(x56, l[0], s0); s1 = fmaf(x57, l[1], s1); s2 = fmaf(x58, l[2], s2); s3 = fmaf(x59, l[3], s3); } { const f32x4 l = *(const LAS f32x4*)(Lc + 1896); s0 = fmaf(x60, l[0], s0); s1 = fmaf(x61, l[1], s1); s2 = fmaf(x62, l[2], s2); s3 = fmaf(x63, l[3], s3); } x27 = (lane == 27) ? 1.0f : -((s0 + s1) + (s2 + s3)); asm volatile("" : "+v"(x27) : : "memory"); }
    { float s0 = 0.f, s1 = 0.f, s2 = 0.f, s3 = 0.f; { const f32x4 l = *(const LAS f32x4*)(Lc + 1792); s3 = fmaf(x27, l[3], s3); } { const f32x4 l = *(const LAS f32x4*)(Lc + 1796); s0 = fmaf(x28, l[0], s0); s1 = fmaf(x29, l[1], s1); s2 = fmaf(x30, l[2], s2); s3 = fmaf(x31, l[3], s3); } { const f32x4 l = *(const LAS f32x4*)(Lc + 1800); s0 = fmaf(x32, l[0], s0); s1 = fmaf(x33, l[1], s1); s2 = fmaf(x34, l[2], s2); s3 = fmaf(x35, l[3], s3); } { const f32x4 l = *(const LAS f32x4*)(Lc + 1804); s0 = fmaf(x36, l[0], s0); s1 = fmaf(x37, l[1], s1); s2 = fmaf(x38, l[2], s2); s3 = fmaf(x39, l[3], s3); } { const f32x4 l = *(const LAS f32x4*)(Lc + 1808); s0 = fmaf(x40, l[0], s0); s1 = fmaf(x41, l[1], s1); s2 = fmaf(x42, l[2], s2); s3 = fmaf(x43, l[3], s3); } { const f32x4 l = *(const LAS f32x4*)(Lc + 1812); s0 = fmaf(x44, l[0], s0); s1 = fmaf(x45, l[1], s1); s2 = fmaf(x46, l[2], s2); s3 = fmaf(x47, l[3], s3); } { const f32x4 l = *(const LAS f32x4*)(Lc + 1816); s0 = fmaf(x48, l[0], s0); s1 = fmaf(x49, l[1], s1); s2 = fmaf(x50, l[2], s2); s3 = fmaf(x51, l[3], s3); } { const f32x4 l = *(const LAS f32x4*)(Lc + 1820); s0 = fmaf(x52, l[0], s0); s1 = fmaf(x53, l[1], s1); s2 = fmaf(x54, l[2], s2); s3 = fmaf(x55, l[3], s3); } { const f32x4 l = *(const LAS f32x4*)(Lc + 1824); s0 = fmaf(x56, l[0], s0); s1 = fmaf(x57, l[1], s1); s2 = fmaf(x58, l[2], s2); s3 = fmaf(x59, l[3], s3); } { const f32x4 l = *(const LAS f32x4*)(Lc + 1828); s0 = fmaf(x60, l[0], s0); s1 = fmaf(x61, l[1], s1); s2 = fmaf(x62, l[2], s2); s3 = fmaf(x63, l[3], s3); } x26 = (lane == 26) ? 1.0f : -((s0 + s1) + (s2 + s3)); asm volatile("" : "+v"(x26) : : "memory"); }
    { float s0 = 0.f, s1 = 0.f, s2 = 0.f, s3 = 0.f; { const f32x4 l = *(const LAS f32x4*)(Lc + 1724); s2 = fmaf(x26, l[2], s2); s3 = fmaf(x27, l[3], s3); } { const f32x4 l = *(const LAS f32x4*)(Lc + 1728); s0 = fmaf(x28, l[0], s0); s1 = fmaf(x29, l[1], s1); s2 = fmaf(x30, l[2], s2); s3 = fmaf(x31, l[3], s3); } { const f32x4 l = *(const LAS f32x4*)(Lc + 1732); s0 = fmaf(x32, l[0], s0); s1 = fmaf(x33, l[1], s1); s2 = fmaf(x34, l[2], s2); s3 = fmaf(x35, l[3], s3); } { const f32x4 l = *(const LAS f32x4*)(Lc + 1736); s0 = fmaf(x36, l[0], s0); s1 = fmaf(x37, l[1], s1); s2 = fmaf(x38, l[2], s2); s3 = fmaf(x39, l[3], s3); } { const f32x4 l = *(const LAS f32x4*)(Lc + 1740); s0 = fmaf(x40, l[0], s0); s1 = fmaf(x41, l[1], s1); s2 = fmaf(x42, l[2], s2); s3 = fmaf(x43, l[3], s3); } { const f32x4 l = *(const LAS f32x4*)(Lc + 1744); s0 = fmaf(x44, l[0], s0); s1 = fmaf(x45, l[1], s1); s2 = fmaf(x46, l[2], s2); s3 = fmaf(x47, l[3], s3); } { const f32x4 l = *(const LAS f32x4*)(Lc + 1748); s0 = fmaf(x48, l[0], s0); s1 = fmaf(x49, l[1], s1); s2 = fmaf(x50, l[2], s2); s3 = fmaf(x51, l[3], s3); } { const f32x4 l = *(const LAS f32x4*)(Lc + 1752); s0 = fmaf(x52, l[0], s0); s1 = fmaf(x53, l[1], s1); s2 = fmaf(x54, l[2], s2); s3 = fmaf(x55, l[3], s3); } { const f32x4 l = *(const LAS f32x4*)(Lc + 1756); s0 = fmaf(x56, l[0], s0); s1 = fmaf(x57, l[1], s1); s2 = fmaf(x58, l[2], s2); s3 = fmaf(x59, l[3], s3); } { const f32x4 l = *(const LAS f32x4*)(Lc + 1760); s0 = fmaf(x60, l[0], s0); s1 = fmaf(x61, l[1], s1); s2 = fmaf(x62, l[2], s2); s3 = fmaf(x63, l[3], s3); } x25 = (lane == 25) ? 1.0f : -((s0 + s1) + (s2 + s3)); asm volatile("" : "+v"(x25) : : "memory"); }
    { float s0 = 0.f, s1 = 0.f, s2 = 0.f, s3 = 0.f; { const f32x4 l = *(const LAS f32x4*)(Lc + 1656); s1 = fmaf(x25, l[1], s1); s2 = fmaf(x26, l[2], s2); s3 = fmaf(x27, l[3], s3); } { const f32x4 l = *(const LAS f32x4*)(Lc + 1660); s0 = fmaf(x28, l[0], s0); s1 = fmaf(x29, l[1], s1); s2 = fmaf(x30, l[2], s2); s3 = fmaf(x31, l[3], s3); } { const f32x4 l = *(const LAS f32x4*)(Lc + 1664); s0 = fmaf(x32, l[0], s0); s1 = fmaf(x33, l[1], s1); s2 = fmaf(x34, l[2], s2); s3 = fmaf(x35, l[3], s3); } { const f32x4 l = *(const LAS f32x4*)(Lc + 1668); s0 = fmaf(x36, l[0], s0); s1 = fmaf(x37, l[1], s1); s2 = fmaf(x38, l[2], s2); s3 = fmaf(x39, l[3], s3); } { const f32x4 l = *(const LAS f32x4*)(Lc + 1672); s0 = fmaf(x40, l[0], s0); s1 = fmaf(x41, l[1], s1); s2 = fmaf(x42, l[2], s2); s3 = fmaf(x43, l[3], s3); } { const f32x4 l = *(const LAS f32x4*)(Lc + 1676); s0 = fmaf(x44, l[0], s0); s1 = fmaf(x45, l[1], s1); s2 = fmaf(x46, l[2], s2); s3 = fmaf(x47, l[3], s3); } { const f32x4 l = *(const LAS f32x4*)(Lc + 1680); s0 = fmaf(x48, l[0], s0); s1 = fmaf(x49, l[1], s1); s2 = fmaf(x50, l[2], s2); s3 = fmaf(x51, l[3], s3); } { const f32x4 l = *(const LAS f32x4*)(Lc + 1684); s0 = fmaf(x52, l[0], s0); s1 = fmaf(x53, l[1], s1); s2 = fmaf(x54, l[2], s2); s3 = fmaf(x55, l[3], s3); } { const f32x4 l = *(const LAS f32x4*)(Lc + 1688); s0 = fmaf(x56, l[0], s0); s1 = fmaf(x57, l[1], s1); s2 = fmaf(x58, l[2], s2); s3 = fmaf(x59, l[3], s3); } { const f32x4 l = *(const LAS f32x4*)(Lc + 1692); s0 = fmaf(x60, l[0], s0); s1 = fmaf(x61, l[1], s1); s2 = fmaf(x62, l[2], s2); s3 = fmaf(x63, l[3], s3); } x24 = (lane == 24) ? 1.0f : -((s0 + s1) + (s2 + s3)); asm volatile("" : "+v"(x24) : : "memory"); }
    { float s0 = 0.f, s1 = 0.f, s2 = 0.f, s3 = 0.f; { const f32x4 l = *(const LAS f32x4*)(Lc + 1588); s0 = fmaf(x24, l[0], s0); s1 = fmaf(x25, l[1], s1); s2 = fmaf(x26, l[2], s2); s3 = fmaf(x27, l[3], s3); } { const f32x4 l = *(const LAS f32x4*)(Lc + 1592); s0 = fmaf(x28, l[0], s0); s1 = fmaf(x29, l[1], s1); s2 = fmaf(x30, l[2], s2); s3 = fmaf(x31, l[3], s3); } { const f32x4 l = *(const LAS f32x4*)(Lc + 1596); s0 = fmaf(x32, l[0], s0); s1 = fmaf(x33, l[1], s1); s2 = fmaf(x34, l[2], s2); s3 = fmaf(x35, l[3], s3); } { const f32x4 l = *(const LAS f32x4*)(Lc + 1600); s0 = fmaf(x36, l[0], s0); s1 = fmaf(x37, l[1], s1); s2 = fmaf(x38, l[2], s2); s3 = fmaf(x39, l[3], s3); } { const f32x4 l = *(const LAS f32x4*)(Lc + 1604); s0 = fmaf(x40, l[0], s0); s1 = fmaf(x41, l[1], s1); s2 = fmaf(x42, l[2], s2); s3 = fmaf(x43, l[3], s3); } { const f32x4 l = *(const LAS f32x4*)(Lc + 1608); s0 = fmaf(x44, l[0], s0); s1 = fmaf(x45, l[1], s1); s2 = fmaf(x46, l[2], s2); s3 = fmaf(x47, l[3], s3); } { const f32x4 l = *(const LAS f32x4*)(Lc + 1612); s0 = fmaf(x48, l[0], s0); s1 = fmaf(x49, l[1], s1); s2 = fmaf(x50, l[2], s2); s3 = fmaf(x51, l[3], s3); } { const f32x4 l = *(const LAS f32x4*)(Lc + 1616); s0 = fmaf(x52, l[0], s0); s1 = fmaf(x53, l[1], s1); s2 = fmaf(x54, l[2], s2); s3 = fmaf(x55, l[3], s3); } { const f32x4 l = *(const LAS f32x4*)(Lc + 1620); s0 = fmaf(x56, l[0], s0); s1 = fmaf(x57, l[1], s1); s2 = fmaf(x58, l[2], s2); s3 = fmaf(x59, l[3], s3); } { const f32x4 l = *(const LAS f32x4*)(Lc + 1624); s0 = fmaf(x60, l[0], s0); s1 = fmaf(x61, l[1], s1); s2 = fmaf(x62, l[2], s2); s3 = fmaf(x63, l[3], s3); } x23 = (lane == 23) ? 1.0f : -((s0 + s1) + (s2 + s3)); asm volatile("" : "+v"(x23) : : "memory"); }
    { float s0 = 0.f, s1 = 0.f, s2 = 0.f, s3 = 0.f; { const f32x4 l = *(const LAS f32x4*)(Lc + 1516); s3 = fmaf(x23, l[3], s3); } { const f32x4 l = *(const LAS f32x4*)(Lc + 1520); s0 = fmaf(x24, l[0], s0); s1 = fmaf(x25, l[1], s1); s2 = fmaf(x26, l[2], s2); s3 = fmaf(x27, l[3], s3); } { const f32x4 l = *(const LAS f32x4*)(Lc + 1524); s0 = fmaf(x28, l[0], s0); s1 = fmaf(x29, l[1], s1); s2 = fmaf(x30, l[2], s2); s3 = fmaf(x31, l[3], s3); } { const f32x4 l = *(const LAS f32x4*)(Lc + 1528); s0 = fmaf(x32, l[0], s0); s1 = fmaf(x33, l[1], s1); s2 = fmaf(x34, l[2], s2); s3 = fmaf(x35, l[3], s3); } { const f32x4 l = *(const LAS f32x4*)(Lc + 1532); s0 = fmaf(x36, l[0], s0); s1 = fmaf(x37, l[1], s1); s2 = fmaf(x38, l[2], s2); s3 = fmaf(x39, l[3], s3); } { const f32x4 l = *(const LAS f32x4*)(Lc + 1536); s0 = fmaf(x40, l[0], s0); s1 = fmaf(x41, l[1], s1); s2 = fmaf(x42, l[2], s2); s3 = fmaf(x43, l[3], s3); } { const f32x4 l = *(const LAS f32x4*)(Lc + 1540); s0 = fmaf(x44, l[0], s0); s1 = fmaf(x45, l[1], s1); s2 = fmaf(x46, l[2], s2); s3 = fmaf(x47, l[3], s3); } { const f32x4 l = *(const LAS f32x4*)(Lc + 1544); s0 = fmaf(x48, l[0], s0); s1 = fmaf(x49, l[1], s1); s2 = fmaf(x50, l[2], s2); s3 = fmaf(x51, l[3], s3); } { const f32x4 l = *(const LAS f32x4*)(Lc + 1548); s0 = fmaf(x52, l[0], s0); s1 = fmaf(x53, l[1], s1); s2 = fmaf(x54, l[2], s2); s3 = fmaf(x55, l[3], s3); } { const f32x4 l = *(const LAS f32x4*)(Lc + 1552); s0 = fmaf(x56, l[0], s0); s1 = fmaf(x57, l[1], s1); s2 = fmaf(x58, l[2], s2); s3 = fmaf(x59, l[3], s3); } { const f32x4 l = *(const LAS f32x4*)(Lc + 1556); s0 = fmaf(x60, l[0], s0); s1 = fmaf(x61, l[1], s1); s2 = fmaf(x62, l[2], s2); s3 = fmaf(x63, l[3], s3); } x22 = (lane == 22) ? 1.0f : -((s0 + s1) + (s2 + s3)); asm volatile("" : "+v"(x22) : : "memory"); }
    { float s0 = 0.f, s1 = 0.f, s2 = 0.f, s3 = 0.f; { const f32x4 l = *(const LAS f32x4*)(Lc + 1448); s2 = fmaf(x22, l[2], s2); s3 = fmaf(x23, l[3], s3); } { const f32x4 l = *(const LAS f32x4*)(Lc + 1452); s0 = fmaf(x24, l[0], s0); s1 = fmaf(x25, l[1], s1); s2 = fmaf(x26, l[2], s2); s3 = fmaf(x27, l[3], s3); } { const f32x4 l = *(const LAS f32x4*)(Lc + 1456); s0 = fmaf(x28, l[0], s0); s1 = fmaf(x29, l[1], s1); s2 = fmaf(x30, l[2], s2); s3 = fmaf(x31, l[3], s3); } { const f32x4 l = *(const LAS f32x4*)(Lc + 1460); s0 = fmaf(x32, l[0], s0); s1 = fmaf(x33, l[1], s1); s2 = fmaf(x34, l[2], s2); s3 = fmaf(x35, l[3], s3); } { const f32x4 l = *(const LAS f32x4*)(Lc + 1464); s0 = fmaf(x36, l[0], s0); s1 = fmaf(x37, l[1], s1); s2 = fmaf(x38, l[2], s2); s3 = fmaf(x39, l[3], s3); } { const f32x4 l = *(const LAS f32x4*)(Lc + 1468); s0 = fmaf(x40, l[0], s0); s1 = fmaf(x41, l[1], s1); s2 = fmaf(x42, l[2], s2); s3 = fmaf(x43, l[3], s3); } { const f32x4 l = *(const LAS f32x4*)(Lc + 1472); s0 = fmaf(x44, l[0], s0); s1 = fmaf(x45, l[1], s1); s2 = fmaf(x46, l[2], s2); s3 = fmaf(x47, l[3], s3); } { const f32x4 l = *(const LAS f32x4*)(Lc + 1476); s0 = fmaf(x48, l[0], s0); s1 = fmaf(x49, l[1], s1); s2 = fmaf(x50, l[2], s2); s3 = fmaf(x51, l[3], s3); } { const f32x4 l = *(const LAS f32x4*)(Lc + 1480); s0 = fmaf(x52, l[0], s0); s1 = fmaf(x53, l[1], s1); s2 = fmaf(x54, l[2], s2); s3 = fmaf(x55, l[3], s3); } { const f32x4 l = *(const LAS f32x4*)(Lc + 1484); s0 = fmaf(x56, l[0], s0); s1 = fmaf(x57, l[1], s1); s2 = fmaf(x58, l[2], s2); s3 = fmaf(x59, l[3], s3); } { const f32x4 l = *(const LAS f32x4*)(Lc + 1488); s0 = fmaf(x60, l[0], s0); s1 = fmaf(x61, l[1], s1); s2 = fmaf(x62, l[2], s2); s3 = fmaf(x63, l[3], s3); } x21 = (lane == 21) ? 1.0f : -((s0 + s1) + (s2 + s3)); asm volatile("" : "+v"(x21) : : "memory"); }
    { float s0 = 0.f, s1 = 0.f, s2 = 0.f, s3 = 0.f; { const f32x4 l = *(const LAS f32x4*)(Lc + 1380); s1 = fmaf(x21, l[1], s1); s2 = fmaf(x22, l[2], s2); s3 = fmaf(x23, l[3], s3); } { const f32x4 l = *(const LAS f32x4*)(Lc + 1384); s0 = fmaf(x24, l[0], s0); s1 = fmaf(x25, l[1], s1); s2 = fmaf(x26, l[2], s2); s3 = fmaf(x27, l[3], s3); } { const f32x4 l = *(const LAS f32x4*)(Lc + 1388); s0 = fmaf(x28, l[0], s0); s1 = fmaf(x29, l[1], s1); s2 = fmaf(x30, l[2], s2); s3 = fmaf(x31, l[3], s3); } { const f32x4 l = *(const LAS f32x4*)(Lc + 1392); s0 = fmaf(x32, l[0], s0); s1 = fmaf(x33, l[1], s1); s2 = fmaf(x34, l[2], s2); s3 = fmaf(x35, l[3], s3); } { const f32x4 l = *(const LAS f32x4*)(Lc + 1396); s0 = fmaf(x36, l[0], s0); s1 = fmaf(x37, l[1], s1); s2 = fmaf(x38, l[2], s2); s3 = fmaf(x39, l[3], s3); } { const f32x4 l = *(const LAS f32x4*)(Lc + 1400); s0 = fmaf(x40, l[0], s0); s1 = fmaf(x41, l[1], s1); s2 = fmaf(x42, l[2], s2); s3 = fmaf(x43, l[3], s3); } { const f32x4 l = *(const LAS f32x4*)(Lc + 1404); s0 = fmaf(x44, l[0], s0); s1 = fmaf(x45, l[1], s1); s2 = fmaf(x46, l[2], s2); s3 = fmaf(x47, l[3], s3); } { const f32x4 l = *(const LAS f32x4*)(Lc + 1408); s0 = fmaf(x48, l[0], s0); s1 = fmaf(x49, l[1], s1); s2 = fmaf(x50, l[2], s2); s3 = fmaf(x51, l[3], s3); } { const f32x4 l = *(const LAS f32x4*)(Lc + 1412); s0 = fmaf(x52, l[0], s0); s1 = fmaf(x53, l[1], s1); s2 = fmaf(x54, l[2], s2); s3 = fmaf(x55, l[3], s3); } { const f32x4 l = *(const LAS f32x4*)(Lc + 1416); s0 = fmaf(x56, l[0], s0); s1 = fmaf(x57, l[1], s1); s2 = fmaf(x58, l[2], s2); s3 = fmaf(x59, l[3], s3); } { const f32x4 l = *(const LAS f32x4*)(Lc + 1420); s0 = fmaf(x60, l[0], s0); s1 = fmaf(x61, l[1], s1); s2 = fmaf(x62, l[2], s2); s3 = fmaf(x63, l[3], s3); } x20 = (lane == 20) ? 1.0f : -((s0 + s1) + (s2 + s3)); asm volatile("" : "+v"(x20) : : "memory"); }
    { float s0 = 0.f, s1 = 0.f, s2 = 0.f, s3 = 0.f; { const f32x4 l = *(const LAS f32x4*)(Lc + 1312); s0 = fmaf(x20, l[0], s0); s1 = fmaf(x21, l[1], s1); s2 = fmaf(x22, l[2], s2); s3 = fmaf(x23, l[3], s3); } { const f32x4 l = *(const LAS f32x4*)(Lc + 1316); s0 = fmaf(x24, l[0], s0); s1 = fmaf(x25, l[1], s1); s2 = fmaf(x26, l[2], s2); s3 = fmaf(x27, l[3], s3); } { const f32x4 l = *(const LAS f32x4*)(Lc + 1320); s0 = fmaf(x28, l[0], s0); s1 = fmaf(x29, l[1], s1); s2 = fmaf(x30, l[2], s2); s3 = fmaf(x31, l[3], s3); } { const f32x4 l = *(const LAS f32x4*)(Lc + 1324); s0 = fmaf(x32, l[0], s0); s1 = fmaf(x33, l[1], s1); s2 = fmaf(x34, l[2], s2); s3 = fmaf(x35, l[3], s3); } { const f32x4 l = *(const LAS f32x4*)(Lc + 1328); s0 = fmaf(x36, l[0], s0); s1 = fmaf(x37, l[1], s1); s2 = fmaf(x38, l[2], s2); s3 = fmaf(x39, l[3], s3); } { const f32x4 l = *(const LAS f32x4*)(Lc + 1332); s0 = fmaf(x40, l[0], s0); s1 = fmaf(x41, l[1], s1); s2 = fmaf(x42, l[2], s2); s3 = fmaf(x43, l[3], s3); } { const f32x4 l = *(const LAS f32x4*)(Lc + 1336); s0 = fmaf(x44, l[0], s0); s1 = fmaf(x45, l[1], s1); s2 = fmaf(x46, l[2], s2); s3 = fmaf(x47, l[3], s3); } { const f32x4 l = *(const LAS f32x4*)(Lc + 1340); s0 = fmaf(x48, l[0], s0); s1 = fmaf(x49, l[1], s1); s2 = fmaf(x50, l[2], s2); s3 = fmaf(x51, l[3], s3); } { const f32x4 l = *(const LAS f32x4*)(Lc + 1344); s0 = fmaf(x52, l[0], s0); s1 = fmaf(x53, l[1], s1); s2 = fmaf(x54, l[2], s2); s3 = fmaf(x55, l[3], s3); } { const f32x4 l = *(const LAS f32x4*)(Lc + 1348); s0 = fmaf(x56, l[0], s0); s1 = fmaf(x57, l[1], s1); s2 = fmaf(x58, l[2], s2); s3 = fmaf(x59, l[3], s3); } { const f32x4 l = *(const LAS f32x4*)(Lc + 1352); s0 = fmaf(x60, l[0], s0); s1 = fmaf(x61, l[1], s1); s2 = fmaf(x62, l[2], s2); s3 = fmaf(x63, l[3], s3); } x19 = (lane == 19) ? 1.0f : -((s0 + s1) + (s2 + s3)); asm volatile("" : "+v"(x19) : : "memory"); }
    { float s0 = 0.f, s1 = 0.f, s2 = 0.f, s3 = 0.f; { const f32x4 l = *(const LAS f32x4*)(Lc + 1240); s3 = fmaf(x19, l[3], s3); } { const f32x4 l = *(const LAS f32x4*)(Lc + 1244); s0 = fmaf(x20, l[0], s0); s1 = fmaf(x21, l[1], s1); s2 = fmaf(x22, l[2], s2); s3 = fmaf(x23, l[3], s3); } { const f32x4 l = *(const LAS f32x4*)(Lc + 1248); s0 = fmaf(x24, l[0], s0); s1 = fmaf(x25, l[1], s1); s2 = fmaf(x26, l[2], s2); s3 = fmaf(x27, l[3], s3); } { const f32x4 l = *(const LAS f32x4*)(Lc + 1252); s0 = fmaf(x28, l[0], s0); s1 = fmaf(x29, l[1], s1); s2 = fmaf(x30, l[2], s2); s3 = fmaf(x31, l[3], s3); } { const f32x4 l = *(const LAS f32x4*)(Lc + 1256); s0 = fmaf(x32, l[0], s0); s1 = fmaf(x33, l[1], s1); s2 = fmaf(x34, l[2], s2); s3 = fmaf(x35, l[3], s3); } { const f32x4 l = *(const LAS f32x4*)(Lc + 1260); s0 = fmaf(x36, l[0], s0); s1 = fmaf(x37, l[1], s1); s2 = fmaf(x38, l[2], s2); s3 = fmaf(x39, l[3], s3); } { const f32x4 l = *(const LAS f32x4*)(Lc + 1264); s0 = fmaf(x40, l[0], s0); s1 = fmaf(x41, l[1], s1); s2 = fmaf(x42, l[2], s2); s3 = fmaf(x43, l[3], s3); } { const f32x4 l = *(const LAS f32x4*)(Lc + 1268); s0 = fmaf(x44, l[0], s0); s1 = fmaf(x45, l[1], s1); s2 = fmaf(x46, l[2], s2); s3 = fmaf(x47, l[3], s3); } { const f32x4 l = *(const LAS f32x4*)(Lc + 1272); s0 = fmaf(x48, l[0], s0); s1 = fmaf(x49, l[1], s1); s2 = fmaf(x50, l[2], s2); s3 = fmaf(x51, l[3], s3); } { const f32x4 l = *(const LAS f32x4*)(Lc + 1276); s0 = fmaf(x52, l[0], s0); s1 = fmaf(x53, l[1], s1); s2 = fmaf(x54, l[2], s2); s3 = fmaf(x55, l[3], s3); } { const f32x4 l = *(const LAS f32x4*)(Lc + 1280); s0 = fmaf(x56, l[0], s0); s1 = fmaf(x57, l[1], s1); s2 = fmaf(x58, l[2], s2); s3 = fmaf(x59, l[3], s3); } { const f32x4 l = *(const LAS f32x4*)(Lc + 1284); s0 = fmaf(x60, l[0], s0); s1 = fmaf(x61, l[1], s1); s2 = fmaf(x62, l[2], s2); s3 = fmaf(x63, l[3], s3); } x18 = (lane == 18) ? 1.0f : -((s0 + s1) + (s2 + s3)); asm volatile("" : "+v"(x18) : : "memory"); }
    { float s0 = 0.f, s1 = 0.f, s2 = 0.f, s3 = 0.f; { const f32x4 l = *(const LAS f32x4*)(Lc + 1172); s2 = fmaf(x18, l[2], s2); s3 = fmaf(x19, l[3], s3); } { const f32x4 l = *(const LAS f32x4*)(Lc + 1176); s0 = fmaf(x20, l[0], s0); s1 = fmaf(x21, l[1], s1); s2 = fmaf(x22, l[2], s2); s3 = fmaf(x23, l[3], s3); } { const f32x4 l = *(const LAS f32x4*)(Lc + 1180); s0 = fmaf(x24, l[0], s0); s1 = fmaf(x25, l[1], s1); s2 = fmaf(x26, l[2], s2); s3 = fmaf(x27, l[3], s3); } { const f32x4 l = *(const LAS f32x4*)(Lc + 1184); s0 = fmaf(x28, l[0], s0); s1 = fmaf(x29, l[1], s1); s2 = fmaf(x30, l[2], s2); s3 = fmaf(x31, l[3], s3); } { const f32x4 l = *(const LAS f32x4*)(Lc + 1188); s0 = fmaf(x32, l[0], s0); s1 = fmaf(x33, l[1], s1); s2 = fmaf(x34, l[2], s2); s3 = fmaf(x35, l[3], s3); } { const f32x4 l = *(const LAS f32x4*)(Lc + 1192); s0 = fmaf(x36, l[0], s0); s1 = fmaf(x37, l[1], s1); s2 = fmaf(x38, l[2], s2); s3 = fmaf(x39, l[3], s3); } { const f32x4 l = *(const LAS f32x4*)(Lc + 1196); s0 = fmaf(x40, l[0], s0); s1 = fmaf(x41, l[1], s1); s2 = fmaf(x42, l[2], s2); s3 = fmaf(x43, l[3], s3); } { const f32x4 l = *(const LAS f32x4*)(Lc + 1200); s0 = fmaf(x44, l[0], s0); s1 = fmaf(x45, l[1], s1); s2 = fmaf(x46, l[2], s2); s3 = fmaf(x47, l[3], s3); } { const f32x4 l = *(const LAS f32x4*)(Lc + 1204); s0 = fmaf(x48, l[0], s0); s1 = fmaf(x49, l[1], s1); s2 = fmaf(x50, l[2], s2); s3 = fmaf(x51, l[3], s3); } { const f32x4 l = *(const LAS f32x4*)(Lc + 1208); s0 = fmaf(x52, l[0], s0); s1 = fmaf(x53, l[1], s1); s2 = fmaf(x54, l[2], s2); s3 = fmaf(x55, l[3], s3); } { const f32x4 l = *(const LAS f32x4*)(Lc + 1212); s0 = fmaf(x56, l[0], s0); s1 = fmaf(x57, l[1], s1); s2 = fmaf(x58, l[2], s2); s3 = fmaf(x59, l[3], s3); } { const f32x4 l = *(const LAS f32x4*)(Lc + 1216); s0 = fmaf(x60, l[0], s0); s1 = fmaf(x61, l[1], s1); s2 = fmaf(x62, l[2], s2); s3 = fmaf(x63, l[3], s3); } x17 = (lane == 17) ? 1.0f : -((s0 + s1) + (s2 + s3)); asm volatile("" : "+v"(x17) : : "memory"); }
    { float s0 = 0.f, s1 = 0.f, s2 = 0.f, s3 = 0.f; { const f32x4 l = *(const LAS f32x4*)(Lc + 1104); s1 = fmaf(x17, l[1], s1); s2 = fmaf(x18, l[2], s2); s3 = fmaf(x19, l[3], s3); } { const f32x4 l = *(const LAS f32x4*)(Lc + 1108); s0 = fmaf(x20, l[0], s0); s1 = fmaf(x21, l[1], s1); s2 = fmaf(x22, l[2], s2); s3 = fmaf(x23, l[3], s3); } { const f32x4 l = *(const LAS f32x4*)(Lc + 1112); s0 = fmaf(x24, l[0], s0); s1 = fmaf(x25, l[1], s1); s2 = fmaf(x26, l[2], s2); s3 = fmaf(x27, l[3], s3); } { const f32x4 l = *(const LAS f32x4*)(Lc + 1116); s0 = fmaf(x28, l[0], s0); s1 = fmaf(x29, l[1], s1); s2 = fmaf(x30, l[2], s2); s3 = fmaf(x31, l[3], s3); } { const f32x4 l = *(const LAS f32x4*)(Lc + 1120); s0 = fmaf(x32, l[0], s0); s1 = fmaf(x33, l[1], s1); s2 = fmaf(x34, l[2], s2); s3 = fmaf(x35, l[3], s3); } { const f32x4 l = *(const LAS f32x4*)(Lc + 1124); s0 = fmaf(x36, l[0], s0); s1 = fmaf(x37, l[1], s1); s2 = fmaf(x38, l[2], s2); s3 = fmaf(x39, l[3], s3); } { const f32x4 l = *(const LAS f32x4*)(Lc + 1128); s0 = fmaf(x40, l[0], s0); s1 = fmaf(x41, l[1], s1); s2 = fmaf(x42, l[2], s2); s3 = fmaf(x43, l[3], s3); } { const f32x4 l = *(const LAS f32x4*)(Lc + 1132); s0 = fmaf(x44, l[0], s0); s1 = fmaf(x45, l[1], s1); s2 = fmaf(x46, l[2], s2); s3 = fmaf(x47, l[3], s3); } { const f32x4 l = *(const LAS f32x4*)(Lc + 1136); s0 = fmaf(x48, l[0], s0); s1 = fmaf(x49, l[1], s1); s2 = fmaf(x50, l[2], s2); s3 = fmaf(x51, l[3], s3); } { const f32x4 l = *(const LAS f32x4*)(Lc + 1140); s0 = fmaf(x52, l[0], s0); s1 = fmaf(x53, l[1], s1); s2 = fmaf(x54, l[2], s2); s3 = fmaf(x55, l[3], s3); } { const f32x4 l = *(const LAS f32x4*)(Lc + 1144); s0 = fmaf(x56, l[0], s0); s1 = fmaf(x57, l[1], s1); s2 = fmaf(x58, l[2], s2); s3 = fmaf(x59, l[3], s3); } { const f32x4 l = *(const LAS f32x4*)(Lc + 1148); s0 = fmaf(x60, l[0], s0); s1 = fmaf(x61, l[1], s1); s2 = fmaf(x62, l[2], s2); s3 = fmaf(x63, l[3], s3); } x16 = (lane == 16) ? 1.0f : -((s0 + s1) + (s2 + s3)); asm volatile("" : "+v"(x16) : : "memory"); }
    { float s0 = 0.f, s1 = 0.f, s2 = 0.f, s3 = 0.f; { const f32x4 l = *(const LAS f32x4*)(Lc + 1036); s0 = fmaf(x16, l[0], s0); s1 = fmaf(x17, l[1], s1); s2 = fmaf(x18, l[2], s2); s3 = fmaf(x19, l[3], s3); } { const f32x4 l = *(const LAS f32x4*)(Lc + 1040); s0 = fmaf(x20, l[0], s0); s1 = fmaf(x21, l[1], s1); s2 = fmaf(x22, l[2], s2); s3 = fmaf(x23, l[3], s3); } { const f32x4 l = *(const LAS f32x4*)(Lc + 1044); s0 = fmaf(x24, l[0], s0); s1 = fmaf(x25, l[1], s1); s2 = fmaf(x26, l[2], s2); s3 = fmaf(x27, l[3], s3); } { const f32x4 l = *(const LAS f32x4*)(Lc + 1048); s0 = fmaf(x28, l[0], s0); s1 = fmaf(x29, l[1], s1); s2 = fmaf(x30, l[2], s2); s3 = fmaf(x31, l[3], s3); } { const f32x4 l = *(const LAS f32x4*)(Lc + 1052); s0 = fmaf(x32, l[0], s0); s1 = fmaf(x33, l[1], s1); s2 = fmaf(x34, l[2], s2); s3 = fmaf(x35, l[3], s3); } { const f32x4 l = *(const LAS f32x4*)(Lc + 1056); s0 = fmaf(x36, l[0], s0); s1 = fmaf(x37, l[1], s1); s2 = fmaf(x38, l[2], s2); s3 = fmaf(x39, l[3], s3); } { const f32x4 l = *(const LAS f32x4*)(Lc + 1060); s0 = fmaf(x40, l[0], s0); s1 = fmaf(x41, l[1], s1); s2 = fmaf(x42, l[2], s2); s3 = fmaf(x43, l[3], s3); } { const f32x4 l = *(const LAS f32x4*)(Lc + 1064); s0 = fmaf(x44, l[0], s0); s1 = fmaf(x45, l[1], s1); s2 = fmaf(x46, l[2], s2); s3 = fmaf(x47, l[3], s3); } { const f32x4 l = *(const LAS f32x4*)(Lc + 1068); s0 = fmaf(x48, l[0], s0); s1 = fmaf(x49, l[1], s1); s2 = fmaf(x50, l[2], s2); s3 = fmaf(x51, l[3], s3); } { const f32x4 l = *(const LAS f32x4*)(Lc + 1072); s0 = fmaf(x52, l[0], s0); s1 = fmaf(x53, l[1], s1); s2 = fmaf(x54, l[2], s2); s3 = fmaf(x55, l[3], s3); } { const f32x4 l = *(const LAS f32x4*)(Lc + 1076); s0 = fmaf(x56, l[0], s0); s1 = fmaf(x57, l[1], s1); s2 = fmaf(x58, l[2], s2); s3 = fmaf(x59, l[3], s3); } { const f32x4 l = *(const LAS f32x4*)(Lc + 1080); s0 = fmaf(x60, l[0], s0); s1 = fmaf(x61, l[1], s1); s2 = fmaf(x62, l[2], s2); s3 = fmaf(x63, l[3], s3); } x15 = (lane == 15) ? 1.0f : -((s0 + s1) + (s2 + s3)); asm volatile("" : "+v"(x15) : : "memory"); }
    { float s0 = 0.f, s1 = 0.f, s2 = 0.f, s3 = 0.f; { const f32x4 l = *(const LAS f32x4*)(Lc + 964); s3 = fmaf(x15, l[3], s3); } { const f32x4 l = *(const LAS f32x4*)(Lc + 968); s0 = fmaf(x16, l[0], s0); s1 = fmaf(x17, l[1], s1); s2 = fmaf(x18, l[2], s2); s3 = fmaf(x19, l[3], s3); } { const f32x4 l = *(const LAS f32x4*)(Lc + 972); s0 = fmaf(x20, l[0], s0); s1 = fmaf(x21, l[1], s1); s2 = fmaf(x22, l[2], s2); s3 = fmaf(x23, l[3], s3); } { const f32x4 l = *(const LAS f32x4*)(Lc + 976); s0 = fmaf(x24, l[0], s0); s1 = fmaf(x25, l[1], s1); s2 = fmaf(x26, l[2], s2); s3 = fmaf(x27, l[3], s3); } { const f32x4 l = *(const LAS f32x4*)(Lc + 980); s0 = fmaf(x28, l[0], s0); s1 = fmaf(x29, l[1], s1); s2 = fmaf(x30, l[2], s2); s3 = fmaf(x31, l[3], s3); } { const f32x4 l = *(const LAS f32x4*)(Lc + 984); s0 = fmaf(x32, l[0], s0); s1 = fmaf(x33, l[1], s1); s2 = fmaf(x34, l[2], s2); s3 = fmaf(x35, l[3], s3); } { const f32x4 l = *(const LAS f32x4*)(Lc + 988); s0 = fmaf(x36, l[0], s0); s1 = fmaf(x37, l[1], s1); s2 = fmaf(x38, l[2], s2); s3 = fmaf(x39, l[3], s3); } { const f32x4 l = *(const LAS f32x4*)(Lc + 992); s0 = fmaf(x40, l[0], s0); s1 = fmaf(x41, l[1], s1); s2 = fmaf(x42, l[2], s2); s3 = fmaf(x43, l[3], s3); } { const f32x4 l = *(const LAS f32x4*)(Lc + 996); s0 = fmaf(x44, l[0], s0); s1 = fmaf(x45, l[1], s1); s2 = fmaf(x46, l[2], s2); s3 = fmaf(x47, l[3], s3); } { const f32x4 l = *(const LAS f32x4*)(Lc + 1000); s0 = fmaf(x48, l[0], s0); s1 = fmaf(x49, l[1], s1); s2 = fmaf(x50, l[2], s2); s3 = fmaf(x51, l[3], s3); } { const f32x4 l = *(const LAS f32x4*)(Lc + 1004); s0 = fmaf(x52, l[0], s0); s1 = fmaf(x53, l[1], s1); s2 = fmaf(x54, l[2], s2); s3 = fmaf(x55, l[3], s3); } { const f32x4 l = *(const LAS f32x4*)(Lc + 1008); s0 = fmaf(x56, l[0], s0); s1 = fmaf(x57, l[1], s1); s2 = fmaf(x58, l[2], s2); s3 = fmaf(x59, l[3], s3); } { const f32x4 l = *(const LAS f32x4*)(Lc + 1012); s0 = fmaf(x60, l[0], s0); s1 = fmaf(x61, l[1], s1); s2 = fmaf(x62, l[2], s2); s3 = fmaf(x63, l[3], s3); } x14 = (lane == 14) ? 1.0f : -((s0 + s1) + (s2 + s3)); asm volatile("" : "+v"(x14) : : "memory"); }
    { float s0 = 0.f, s1 = 0.f, s2 = 0.f, s3 = 0.f; { const f32x4 l = *(const LAS f32x4*)(Lc + 896); s2 = fmaf(x14, l[2], s2); s3 = fmaf(x15, l[3], s3); } { const f32x4 l = *(const LAS f32x4*)(Lc + 900); s0 = fmaf(x16, l[0], s0); s1 = fmaf(x17, l[1], s1); s2 = fmaf(x18, l[2], s2); s3 = fmaf(x19, l[3], s3); } { const f32x4 l = *(const LAS f32x4*)(Lc + 904); s0 = fmaf(x20, l[0], s0); s1 = fmaf(x21, l[1], s1); s2 = fmaf(x22, l[2], s2); s3 = fmaf(x23, l[3], s3); } { const f32x4 l = *(const LAS f32x4*)(Lc + 908); s0 = fmaf(x24, l[0], s0); s1 = fmaf(x25, l[1], s1); s2 = fmaf(x26, l[2], s2); s3 = fmaf(x27, l[3], s3); } { const f32x4 l = *(const LAS f32x4*)(Lc + 912); s0 = fmaf(x28, l[0], s0); s1 = fmaf(x29, l[1], s1); s2 = fmaf(x30, l[2], s2); s3 = fmaf(x31, l[3], s3); } { const f32x4 l = *(const LAS f32x4*)(Lc + 916); s0 = fmaf(x32, l[0], s0); s1 = fmaf(x33, l[1], s1); s2 = fmaf(x34, l[2], s2); s3 = fmaf(x35, l[3], s3); } { const f32x4 l = *(const LAS f32x4*)(Lc + 920); s0 = fmaf(x36, l[0], s0); s1 = fmaf(x37, l[1], s1); s2 = fmaf(x38, l[2], s2); s3 = fmaf(x39, l[3], s3); } { const f32x4 l = *(const LAS f32x4*)(Lc + 924); s0 = fmaf(x40, l[0], s0); s1 = fmaf(x41, l[1], s1); s2 = fmaf(x42, l[2], s2); s3 = fmaf(x43, l[3], s3); } { const f32x4 l = *(const LAS f32x4*)(Lc + 928); s0 = fmaf(x44, l[0], s0); s1 = fmaf(x45, l[1], s1); s2 = fmaf(x46, l[2], s2); s3 = fmaf(x47, l[3], s3); } { const f32x4 l = *(const LAS f32x4*)(Lc + 932); s0 = fmaf(x48, l[0], s0); s1 = fmaf(x49, l[1], s1); s2 = fmaf(x50, l[2], s2); s3 = fmaf(x51, l[3], s3); } { const f32x4 l = *(const LAS f32x4*)(Lc + 936); s0 = fmaf(x52, l[0], s0); s1 = fmaf(x53, l[1], s1); s2 = fmaf(x54, l[2], s2); s3 = fmaf(x55, l[3], s3); } { const f32x4 l = *(const LAS f32x4*)(Lc + 940); s0 = fmaf(x56, l[0], s0); s1 = fmaf(x57, l[1], s1); s2 = fmaf(x58, l[2], s2); s3 = fmaf(x59, l[3], s3); } { const f32x4 l = *(const LAS f32x4*)(Lc + 944); s0 = fmaf(x60, l[0], s0); s1 = fmaf(x61, l[1], s1); s2 = fmaf(x62, l[2], s2); s3 = fmaf(x63, l[3], s3); } x13 = (lane == 13) ? 1.0f : -((s0 + s1) + (s2 + s3)); asm volatile("" : "+v"(x13) : : "memory"); }
    { float s0 = 0.f, s1 = 0.f, s2 = 0.f, s3 = 0.f; { const f32x4 l = *(const LAS f32x4*)(Lc + 828); s1 = fmaf(x13, l[1], s1); s2 = fmaf(x14, l[2], s2); s3 = fmaf(x15, l[3], s3); } { const f32x4 l = *(const LAS f32x4*)(Lc + 832); s0 = fmaf(x16, l[0], s0); s1 = fmaf(x17, l[1], s1); s2 = fmaf(x18, l[2], s2); s3 = fmaf(x19, l[3], s3); } { const f32x4 l = *(const LAS f32x4*)(Lc + 836); s0 = fmaf(x20, l[0], s0); s1 = fmaf(x21, l[1], s1); s2 = fmaf(x22, l[2], s2); s3 = fmaf(x23, l[3], s3); } { const f32x4 l = *(const LAS f32x4*)(Lc + 840); s0 = fmaf(x24, l[0], s0); s1 = fmaf(x25, l[1], s1); s2 = fmaf(x26, l[2], s2); s3 = fmaf(x27, l[3], s3); } { const f32x4 l = *(const LAS f32x4*)(Lc + 844); s0 = fmaf(x28, l[0], s0); s1 = fmaf(x29, l[1], s1); s2 = fmaf(x30, l[2], s2); s3 = fmaf(x31, l[3], s3); } { const f32x4 l = *(const LAS f32x4*)(Lc + 848); s0 = fmaf(x32, l[0], s0); s1 = fmaf(x33, l[1], s1); s2 = fmaf(x34, l[2], s2); s3 = fmaf(x35, l[3], s3); } { const f32x4 l = *(const LAS f32x4*)(Lc + 852); s0 = fmaf(x36, l[0], s0); s1 = fmaf(x37, l[1], s1); s2 = fmaf(x38, l[2], s2); s3 = fmaf(x39, l[3], s3); } { const f32x4 l = *(const LAS f32x4*)(Lc + 856); s0 = fmaf(x40, l[0], s0); s1 = fmaf(x41, l[1], s1); s2 = fmaf(x42, l[2], s2); s3 = fmaf(x43, l[3], s3); } { const f32x4 l = *(const LAS f32x4*)(Lc + 860); s0 = fmaf(x44, l[0], s0); s1 = fmaf(x45, l[1], s1); s2 = fmaf(x46, l[2], s2); s3 = fmaf(x47, l[3], s3); } { const f32x4 l = *(const LAS f32x4*)(Lc + 864); s0 = fmaf(x48, l[0], s0); s1 = fmaf(x49, l[1], s1); s2 = fmaf(x50, l[2], s2); s3 = fmaf(x51, l[3], s3); } { const f32x4 l = *(const LAS f32x4*)(Lc + 868); s0 = fmaf(x52, l[0], s0); s1 = fmaf(x53, l[1], s1); s2 = fmaf(x54, l[2], s2); s3 = fmaf(x55, l[3], s3); } { const f32x4 l = *(const LAS f32x4*)(Lc + 872); s0 = fmaf(x56, l[0], s0); s1 = fmaf(x57, l[1], s1); s2 = fmaf(x58, l[2], s2); s3 = fmaf(x59, l[3], s3); } { const f32x4 l = *(const LAS f32x4*)(Lc + 876); s0 = fmaf(x60, l[0], s0); s1 = fmaf(x61, l[1], s1); s2 = fmaf(x62, l[2], s2); s3 = fmaf(x63, l[3], s3); } x12 = (lane == 12) ? 1.0f : -((s0 + s1) + (s2 + s3)); asm volatile("" : "+v"(x12) : : "memory"); }
    { float s0 = 0.f, s1 = 0.f, s2 = 0.f, s3 = 0.f; { const f32x4 l = *(const LAS f32x4*)(Lc + 760); s0 = fmaf(x12, l[0], s0); s1 = fmaf(x13, l[1], s1); s2 = fmaf(x14, l[2], s2); s3 = fmaf(x15, l[3], s3); } { const f32x4 l = *(const LAS f32x4*)(Lc + 764); s0 = fmaf(x16, l[0], s0); s1 = fmaf(x17, l[1], s1); s2 = fmaf(x18, l[2], s2); s3 = fmaf(x19, l[3], s3); } { const f32x4 l = *(const LAS f32x4*)(Lc + 768); s0 = fmaf(x20, l[0], s0); s1 = fmaf(x21, l[1], s1); s2 = fmaf(x22, l[2], s2); s3 = fmaf(x23, l[3], s3); } { const f32x4 l = *(const LAS f32x4*)(Lc + 772); s0 = fmaf(x24, l[0], s0); s1 = fmaf(x25, l[1], s1); s2 = fmaf(x26, l[2], s2); s3 = fmaf(x27, l[3], s3); } { const f32x4 l = *(const LAS f32x4*)(Lc + 776); s0 = fmaf(x28, l[0], s0); s1 = fmaf(x29, l[1], s1); s2 = fmaf(x30, l[2], s2); s3 = fmaf(x31, l[3], s3); } { const f32x4 l = *(const LAS f32x4*)(Lc + 780); s0 = fmaf(x32, l[0], s0); s1 = fmaf(x33, l[1], s1); s2 = fmaf(x34, l[2], s2); s3 = fmaf(x35, l[3], s3); } { const f32x4 l = *(const LAS f32x4*)(Lc + 784); s0 = fmaf(x36, l[0], s0); s1 = fmaf(x37, l[1], s1); s2 = fmaf(x38, l[2], s2); s3 = fmaf(x39, l[3], s3); } { const f32x4 l = *(const LAS f32x4*)(Lc + 788); s0 = fmaf(x40, l[0], s0); s1 = fmaf(x41, l[1], s1); s2 = fmaf(x42, l[2], s2); s3 = fmaf(x43, l[3], s3); } { const f32x4 l = *(const LAS f32x4*)(Lc + 792); s0 = fmaf(x44, l[0], s0); s1 = fmaf(x45, l[1], s1); s2 = fmaf(x46, l[2], s2); s3 = fmaf(x47, l[3], s3); } { const f32x4 l = *(const LAS f32x4*)(Lc + 796); s0 = fmaf(x48, l[0], s0); s1 = fmaf(x49, l[1], s1); s2 = fmaf(x50, l[2], s2); s3 = fmaf(x51, l[3], s3); } { const f32x4 l = *(const LAS f32x4*)(Lc + 800); s0 = fmaf(x52, l[0], s0); s1 = fmaf(x53, l[1], s1); s2 = fmaf(x54, l[2], s2); s3 = fmaf(x55, l[3], s3); } { const f32x4 l = *(const LAS f32x4*)(Lc + 804); s0 = fmaf(x56, l[0], s0); s1 = fmaf(x57, l[1], s1); s2 = fmaf(x58, l[2], s2); s3 = fmaf(x59, l[3], s3); } { const f32x4 l = *(const LAS f32x4*)(Lc + 808); s0 = fmaf(x60, l[0], s0); s1 = fmaf(x61, l[1], s1); s2 = fmaf(x62, l[2], s2); s3 = fmaf(x63, l[3], s3); } x11 = (lane == 11) ? 1.0f : -((s0 + s1) + (s2 + s3)); asm volatile("" : "+v"(x11) : : "memory"); }
    { float s0 = 0.f, s1 = 0.f, s2 = 0.f, s3 = 0.f; { const f32x4 l = *(const LAS f32x4*)(Lc + 688); s3 = fmaf(x11, l[3], s3); } { const f32x4 l = *(const LAS f32x4*)(Lc + 692); s0 = fmaf(x12, l[0], s0); s1 = fmaf(x13, l[1], s1); s2 = fmaf(x14, l[2], s2); s3 = fmaf(x15, l[3], s3); } { const f32x4 l = *(const LAS f32x4*)(Lc + 696); s0 = fmaf(x16, l[0], s0); s1 = fmaf(x17, l[1], s1); s2 = fmaf(x18, l[2], s2); s3 = fmaf(x19, l[3], s3); } { const f32x4 l = *(const LAS f32x4*)(Lc + 700); s0 = fmaf(x20, l[0], s0); s1 = fmaf(x21, l[1], s1); s2 = fmaf(x22, l[2], s2); s3 = fmaf(x23, l[3], s3); } { const f32x4 l = *(const LAS f32x4*)(Lc + 704); s0 = fmaf(x24, l[0], s0); s1 = fmaf(x25, l[1], s1); s2 = fmaf(x26, l[2], s2); s3 = fmaf(x27, l[3], s3); } { const f32x4 l = *(const LAS f32x4*)(Lc + 708); s0 = fmaf(x28, l[0], s0); s1 = fmaf(x29, l[1], s1); s2 = fmaf(x30, l[2], s2); s3 = fmaf(x31, l[3], s3); } { const f32x4 l = *(const LAS f32x4*)(Lc + 712); s0 = fmaf(x32, l[0], s0); s1 = fmaf(x33, l[1], s1); s2 = fmaf(x34, l[2], s2); s3 = fmaf(x35, l[3], s3); } { const f32x4 l = *(const LAS f32x4*)(Lc + 716); s0 = fmaf(x36, l[0], s0); s1 = fmaf(x37, l[1], s1); s2 = fmaf(x38, l[2], s2); s3 = fmaf(x39, l[3], s3); } { const f32x4 l = *(const LAS f32x4*)(Lc + 720); s0 = fmaf(x40, l[0], s0); s1 = fmaf(x41, l[1], s1); s2 = fmaf(x42, l[2], s2); s3 = fmaf(x43, l[3], s3); } { const f32x4 l = *(const LAS f32x4*)(Lc + 724); s0 = fmaf(x44, l[0], s0); s1 = fmaf(x45, l[1], s1); s2 = fmaf(x46, l[2], s2); s3 = fmaf(x47, l[3], s3); } { const f32x4 l = *(const LAS f32x4*)(Lc + 728); s0 = fmaf(x48, l[0], s0); s1 = fmaf(x49, l[1], s1); s2 = fmaf(x50, l[2], s2); s3 = fmaf(x51, l[3], s3); } { const f32x4 l = *(const LAS f32x4*)(Lc + 732); s0 = fmaf(x52, l[0], s0); s1 = fmaf(x53, l[1], s1); s2 = fmaf(x54, l[2], s2); s3 = fmaf(x55, l[3], s3); } { const f32x4 l = *(const LAS f32x4*)(Lc + 736); s0 = fmaf(x56, l[0], s0); s1 = fmaf(x57, l[1], s1); s2 = fmaf(x58, l[2], s2); s3 = fmaf(x59, l[3], s3); } { const f32x4 l = *(const LAS f32x4*)(Lc + 740); s0 = fmaf(x60, l[0], s0); s1 = fmaf(x61, l[1], s1); s2 = fmaf(x62, l[2], s2); s3 = fmaf(x63, l[3], s3); } x10 = (lane == 10) ? 1.0f : -((s0 + s1) + (s2 + s3)); asm volatile("" : "+v"(x10) : : "memory"); }
    { float s0 = 0.f, s1 = 0.f, s2 = 0.f, s3 = 0.f; { const f32x4 l = *(const LAS f32x4*)(Lc + 620); s2 = fmaf(x10, l[2], s2); s3 = fmaf(x11, l[3], s3); } { const f32x4 l = *(const LAS f32x4*)(Lc + 624); s0 = fmaf(x12, l[0], s0); s1 = fmaf(x13, l[1], s1); s2 = fmaf(x14, l[2], s2); s3 = fmaf(x15, l[3], s3); } { const f32x4 l = *(const LAS f32x4*)(Lc + 628); s0 = fmaf(x16, l[0], s0); s1 = fmaf(x17, l[1], s1); s2 = fmaf(x18, l[2], s2); s3 = fmaf(x19, l[3], s3); } { const f32x4 l = *(const LAS f32x4*)(Lc + 632); s0 = fmaf(x20, l[0], s0); s1 = fmaf(x21, l[1], s1); s2 = fmaf(x22, l[2], s2); s3 = fmaf(x23, l[3], s3); } { const f32x4 l = *(const LAS f32x4*)(Lc + 636); s0 = fmaf(x24, l[0], s0); s1 = fmaf(x25, l[1], s1); s2 = fmaf(x26, l[2], s2); s3 = fmaf(x27, l[3], s3); } { const f32x4 l = *(const LAS f32x4*)(Lc + 640); s0 = fmaf(x28, l[0], s0); s1 = fmaf(x29, l[1], s1); s2 = fmaf(x30, l[2], s2); s3 = fmaf(x31, l[3], s3); } { const f32x4 l = *(const LAS f32x4*)(Lc + 644); s0 = fmaf(x32, l[0], s0); s1 = fmaf(x33, l[1], s1); s2 = fmaf(x34, l[2], s2); s3 = fmaf(x35, l[3], s3); } { const f32x4 l = *(const LAS f32x4*)(Lc + 648); s0 = fmaf(x36, l[0], s0); s1 = fmaf(x37, l[1], s1); s2 = fmaf(x38, l[2], s2); s3 = fmaf(x39, l[3], s3); } { const f32x4 l = *(const LAS f32x4*)(Lc + 652); s0 = fmaf(x40, l[0], s0); s1 = fmaf(x41, l[1], s1); s2 = fmaf(x42, l[2], s2); s3 = fmaf(x43, l[3], s3); } { const f32x4 l = *(const LAS f32x4*)(Lc + 656); s0 = fmaf(x44, l[0], s0); s1 = fmaf(x45, l[1], s1); s2 = fmaf(x46, l[2], s2); s3 = fmaf(x47, l[3], s3); } { const f32x4 l = *(const LAS f32x4*)(Lc + 660); s0 = fmaf(x48, l[0], s0); s1 = fmaf(x49, l[1], s1); s2 = fmaf(x50, l[2], s2); s3 = fmaf(x51, l[3], s3); } { const f32x4 l = *(const LAS f32x4*)(Lc + 664); s0 = fmaf(x52, l[0], s0); s1 = fmaf(x53, l[1], s1); s2 = fmaf(x54, l[2], s2); s3 = fmaf(x55, l[3], s3); } { const f32x4 l = *(const LAS f32x4*)(Lc + 668); s0 = fmaf(x56, l[0], s0); s1 = fmaf(x57, l[1], s1); s2 = fmaf(x58, l[2], s2); s3 = fmaf(x59, l[3], s3); } { const f32x4 l = *(const LAS f32x4*)(Lc + 672); s0 = fmaf(x60, l[0], s0); s1 = fmaf(x61, l[1], s1); s2 = fmaf(x62, l[2], s2); s3 = fmaf(x63, l[3], s3); } x9 = (lane == 9) ? 1.0f : -((s0 + s1) + (s2 + s3)); asm volatile("" : "+v"(x9) : : "memory"); }
    { float s0 = 0.f, s1 = 0.f, s2 = 0.f, s3 = 0.f; { const f32x4 l = *(const LAS f32x4*)(Lc + 552); s1 = fmaf(x9, l[1], s1); s2 = fmaf(x10, l[2], s2); s3 = fmaf(x11, l[3], s3); } { const f32x4 l = *(const LAS f32x4*)(Lc + 556); s0 = fmaf(x12, l[0], s0); s1 = fmaf(x13, l[1], s1); s2 = fmaf(x14, l[2], s2); s3 = fmaf(x15, l[3], s3); } { const f32x4 l = *(const LAS f32x4*)(Lc + 560); s0 = fmaf(x16, l[0], s0); s1 = fmaf(x17, l[1], s1); s2 = fmaf(x18, l[2], s2); s3 = fmaf(x19, l[3], s3); } { const f32x4 l = *(const LAS f32x4*)(Lc + 564); s0 = fmaf(x20, l[0], s0); s1 = fmaf(x21, l[1], s1); s2 = fmaf(x22, l[2], s2); s3 = fmaf(x23, l[3], s3); } { const f32x4 l = *(const LAS f32x4*)(Lc + 568); s0 = fmaf(x24, l[0], s0); s1 = fmaf(x25, l[1], s1); s2 = fmaf(x26, l[2], s2); s3 = fmaf(x27, l[3], s3); } { const f32x4 l = *(const LAS f32x4*)(Lc + 572); s0 = fmaf(x28, l[0], s0); s1 = fmaf(x29, l[1], s1); s2 = fmaf(x30, l[2], s2); s3 = fmaf(x31, l[3], s3); } { const f32x4 l = *(const LAS f32x4*)(Lc + 576); s0 = fmaf(x32, l[0], s0); s1 = fmaf(x33, l[1], s1); s2 = fmaf(x34, l[2], s2); s3 = fmaf(x35, l[3], s3); } { const f32x4 l = *(const LAS f32x4*)(Lc + 580); s0 = fmaf(x36, l[0], s0); s1 = fmaf(x37, l[1], s1); s2 = fmaf(x38, l[2], s2); s3 = fmaf(x39, l[3], s3); } { const f32x4 l = *(const LAS f32x4*)(Lc + 584); s0 = fmaf(x40, l[0], s0); s1 = fmaf(x41, l[1], s1); s2 = fmaf(x42, l[2], s2); s3 = fmaf(x43, l[3], s3); } { const f32x4 l = *(const LAS f32x4*)(Lc + 588); s0 = fmaf(x44, l[0], s0); s1 = fmaf(x45, l[1], s1); s2 = fmaf(x46, l[2], s2); s3 = fmaf(x47, l[3], s3); } { const f32x4 l = *(const LAS f32x4*)(Lc + 592); s0 = fmaf(x48, l[0], s0); s1 = fmaf(x49, l[1], s1); s2 = fmaf(x50, l[2], s2); s3 = fmaf(x51, l[3], s3); } { const f32x4 l = *(const LAS f32x4*)(Lc + 596); s0 = fmaf(x52, l[0], s0); s1 = fmaf(x53, l[1], s1); s2 = fmaf(x54, l[2], s2); s3 = fmaf(x55, l[3], s3); } { const f32x4 l = *(const LAS f32x4*)(Lc + 600); s0 = fmaf(x56, l[0], s0); s1 = fmaf(x57, l[1], s1); s2 = fmaf(x58, l[2], s2); s3 = fmaf(x59, l[3], s3); } { const f32x4 l = *(const LAS f32x4*)(Lc + 604); s0 = fmaf(x60, l[0], s0); s1 = fmaf(x61, l[1], s1); s2 = fmaf(x62, l[2], s2); s3 = fmaf(x63, l[3], s3); } x8 = (lane == 8) ? 1.0f : -((s0 + s1) + (s2 + s3)); asm volatile("" : "+v"(x8) : : "memory"); }
    { float s0 = 0.f, s1 = 0.f, s2 = 0.f, s3 = 0.f; { const f32x4 l = *(const LAS f32x4*)(Lc + 484); s0 = fmaf(x8, l[0], s0); s1 = fmaf(x9, l[1], s1); s2 = fmaf(x10, l[2], s2); s3 = fmaf(x11, l[3], s3); } { const f32x4 l = *(const LAS f32x4*)(Lc + 488); s0 = fmaf(x12, l[0], s0); s1 = fmaf(x13, l[1], s1); s2 = fmaf(x14, l[2], s2); s3 = fmaf(x15, l[3], s3); } { const f32x4 l = *(const LAS f32x4*)(Lc + 492); s0 = fmaf(x16, l[0], s0); s1 = fmaf(x17, l[1], s1); s2 = fmaf(x18, l[2], s2); s3 = fmaf(x19, l[3], s3); } { const f32x4 l = *(const LAS f32x4*)(Lc + 496); s0 = fmaf(x20, l[0], s0); s1 = fmaf(x21, l[1], s1); s2 = fmaf(x22, l[2], s2); s3 = fmaf(x23, l[3], s3); } { const f32x4 l = *(const LAS f32x4*)(Lc + 500); s0 = fmaf(x24, l[0], s0); s1 = fmaf(x25, l[1], s1); s2 = fmaf(x26, l[2], s2); s3 = fmaf(x27, l[3], s3); } { const f32x4 l = *(const LAS f32x4*)(Lc + 504); s0 = fmaf(x28, l[0], s0); s1 = fmaf(x29, l[1], s1); s2 = fmaf(x30, l[2], s2); s3 = fmaf(x31, l[3], s3); } { const f32x4 l = *(const LAS f32x4*)(Lc + 508); s0 = fmaf(x32, l[0], s0); s1 = fmaf(x33, l[1], s1); s2 = fmaf(x34, l[2], s2); s3 = fmaf(x35, l[3], s3); } { const f32x4 l = *(const LAS f32x4*)(Lc + 512); s0 = fmaf(x36, l[0], s0); s1 = fmaf(x37, l[1], s1); s2 = fmaf(x38, l[2], s2); s3 = fmaf(x39, l[3], s3); } { const f32x4 l = *(const LAS f32x4*)(Lc + 516); s0 = fmaf(x40, l[0], s0); s1 = fmaf(x41, l[1], s1); s2 = fmaf(x42, l[2], s2); s3 = fmaf(x43, l[3], s3); } { const f32x4 l = *(const LAS f32x4*)(Lc + 520); s0 = fmaf(x44, l[0], s0); s1 = fmaf(x45, l[1], s1); s2 = fmaf(x46, l[2], s2); s3 = fmaf(x47, l[3], s3); } { const f32x4 l = *(const LAS f32x4*)(Lc + 524); s0 = fmaf(x48, l[0], s0); s1 = fmaf(x49, l[1], s1); s2 = fmaf(x50, l[2], s2); s3 = fmaf(x51, l[3], s3); } { const f32x4 l = *(const LAS f32x4*)(Lc + 528); s0 = fmaf(x52, l[0], s0); s1 = fmaf(x53, l[1], s1); s2 = fmaf(x54, l[2], s2); s3 = fmaf(x55, l[3], s3); } { const f32x4 l = *(const LAS f32x4*)(Lc + 532); s0 = fmaf(x56, l[0], s0); s1 = fmaf(x57, l[1], s1); s2 = fmaf(x58, l[2], s2); s3 = fmaf(x59, l[3], s3); } { const f32x4 l = *(const LAS f32x4*)(Lc + 536); s0 = fmaf(x60, l[0], s0); s1 = fmaf(x61, l[1], s1); s2 = fmaf(x62, l[2], s2); s3 = fmaf(x63, l[3], s3); } x7 = (lane == 7) ? 1.0f : -((s0 + s1) + (s2 + s3)); asm volatile("" : "+v"(x7) : : "memory"); }
    { float s0 = 0.f, s1 = 0.f, s2 = 0.f, s3 = 0.f; { const f32x4 l = *(const LAS f32x4*)(Lc + 412); s3 = fmaf(x7, l[3], s3); } { const f32x4 l = *(const LAS f32x4*)(Lc + 416); s0 = fmaf(x8, l[0], s0); s1 = fmaf(x9, l[1], s1); s2 = fmaf(x10, l[2], s2); s3 = fmaf(x11, l[3], s3); } { const f32x4 l = *(const LAS f32x4*)(Lc + 420); s0 = fmaf(x12, l[0], s0); s1 = fmaf(x13, l[1], s1); s2 = fmaf(x14, l[2], s2); s3 = fmaf(x15, l[3], s3); } { const f32x4 l = *(const LAS f32x4*)(Lc + 424); s0 = fmaf(x16, l[0], s0); s1 = fmaf(x17, l[1], s1); s2 = fmaf(x18, l[2], s2); s3 = fmaf(x19, l[3], s3); } { const f32x4 l = *(const LAS f32x4*)(Lc + 428); s0 = fmaf(x20, l[0], s0); s1 = fmaf(x21, l[1], s1); s2 = fmaf(x22, l[2], s2); s3 = fmaf(x23, l[3], s3); } { const f32x4 l = *(const LAS f32x4*)(Lc + 432); s0 = fmaf(x24, l[0], s0); s1 = fmaf(x25, l[1], s1); s2 = fmaf(x26, l[2], s2); s3 = fmaf(x27, l[3], s3); } { const f32x4 l = *(const LAS f32x4*)(Lc + 436); s0 = fmaf(x28, l[0], s0); s1 = fmaf(x29, l[1], s1); s2 = fmaf(x30, l[2], s2); s3 = fmaf(x31, l[3], s3); } { const f32x4 l = *(const LAS f32x4*)(Lc + 440); s0 = fmaf(x32, l[0], s0); s1 = fmaf(x33, l[1], s1); s2 = fmaf(x34, l[2], s2); s3 = fmaf(x35, l[3], s3); } { const f32x4 l = *(const LAS f32x4*)(Lc + 444); s0 = fmaf(x36, l[0], s0); s1 = fmaf(x37, l[1], s1); s2 = fmaf(x38, l[2], s2); s3 = fmaf(x39, l[3], s3); } { const f32x4 l = *(const LAS f32x4*)(Lc + 448); s0 = fmaf(x40, l[0], s0); s1 = fmaf(x41, l[1], s1); s2 = fmaf(x42, l[2], s2); s3 = fmaf(x43, l[3], s3); } { const f32x4 l = *(const LAS f32x4*)(Lc + 452); s0 = fmaf(x44, l[0], s0); s1 = fmaf(x45, l[1], s1); s2 = fmaf(x46, l[2], s2); s3 = fmaf(x47, l[3], s3); } { const f32x4 l = *(const LAS f32x4*)(Lc + 456); s0 = fmaf(x48, l[0], s0); s1 = fmaf(x49, l[1], s1); s2 = fmaf(x50, l[2], s2); s3 = fmaf(x51, l[3], s3); } { const f32x4 l = *(const LAS f32x4*)(Lc + 460); s0 = fmaf(x52, l[0], s0); s1 = fmaf(x53, l[1], s1); s2 = fmaf(x54, l[2], s2); s3 = fmaf(x55, l[3], s3); } { const f32x4 l = *(const LAS f32x4*)(Lc + 464); s0 = fmaf(x56, l[0], s0); s1 = fmaf(x57, l[1], s1); s2 = fmaf(x58, l[2], s2); s3 = fmaf(x59, l[3], s3); } { const f32x4 l = *(const LAS f32x4*)(Lc + 468); s0 = fmaf(x60, l[0], s0); s1 = fmaf(x61, l[1], s1); s2 = fmaf(x62, l[2], s2); s3 = fmaf(x63, l[3], s3); } x6 = (lane == 6) ? 1.0f : -((s0 + s1) + (s2 + s3)); asm volatile("" : "+v"(x6) : : "memory"); }
    { float s0 = 0.f, s1 = 0.f, s2 = 0.f, s3 = 0.f; { const f32x4 l = *(const LAS f32x4*)(Lc + 344); s2 = fmaf(x6, l[2], s2); s3 = fmaf(x7, l[3], s3); } { const f32x4 l = *(const LAS f32x4*)(Lc + 348); s0 = fmaf(x8, l[0], s0); s1 = fmaf(x9, l[1], s1); s2 = fmaf(x10, l[2], s2); s3 = fmaf(x11, l[3], s3); } { const f32x4 l = *(const LAS f32x4*)(Lc + 352); s0 = fmaf(x12, l[0], s0); s1 = fmaf(x13, l[1], s1); s2 = fmaf(x14, l[2], s2); s3 = fmaf(x15, l[3], s3); } { const f32x4 l = *(const LAS f32x4*)(Lc + 356); s0 = fmaf(x16, l[0], s0); s1 = fmaf(x17, l[1], s1); s2 = fmaf(x18, l[2], s2); s3 = fmaf(x19, l[3], s3); } { const f32x4 l = *(const LAS f32x4*)(Lc + 360); s0 = fmaf(x20, l[0], s0); s1 = fmaf(x21, l[1], s1); s2 = fmaf(x22, l[2], s2); s3 = fmaf(x23, l[3], s3); } { const f32x4 l = *(const LAS f32x4*)(Lc + 364); s0 = fmaf(x24, l[0], s0); s1 = fmaf(x25, l[1], s1); s2 = fmaf(x26, l[2], s2); s3 = fmaf(x27, l[3], s3); } { const f32x4 l = *(const LAS f32x4*)(Lc + 368); s0 = fmaf(x28, l[0], s0); s1 = fmaf(x29, l[1], s1); s2 = fmaf(x30, l[2], s2); s3 = fmaf(x31, l[3], s3); } { const f32x4 l = *(const LAS f32x4*)(Lc + 372); s0 = fmaf(x32, l[0], s0); s1 = fmaf(x33, l[1], s1); s2 = fmaf(x34, l[2], s2); s3 = fmaf(x35, l[3], s3); } { const f32x4 l = *(const LAS f32x4*)(Lc + 376); s0 = fmaf(x36, l[0], s0); s1 = fmaf(x37, l[1], s1); s2 = fmaf(x38, l[2], s2); s3 = fmaf(x39, l[3], s3); } { const f32x4 l = *(const LAS f32x4*)(Lc + 380); s0 = fmaf(x40, l[0], s0); s1 = fmaf(x41, l[1], s1); s2 = fmaf(x42, l[2], s2); s3 = fmaf(x43, l[3], s3); } { const f32x4 l = *(const LAS f32x4*)(Lc + 384); s0 = fmaf(x44, l[0], s0); s1 = fmaf(x45, l[1], s1); s2 = fmaf(x46, l[2], s2); s3 = fmaf(x47, l[3], s3); } { const f32x4 l = *(const LAS f32x4*)(Lc + 388); s0 = fmaf(x48, l[0], s0); s1 = fmaf(x49, l[1], s1); s2 = fmaf(x50, l[2], s2); s3 = fmaf(x51, l[3], s3); } { const f32x4 l = *(const LAS f32x4*)(Lc + 392); s0 = fmaf(x52, l[0], s0); s1 = fmaf(x53, l[1], s1); s2 = fmaf(x54, l[2], s2); s3 = fmaf(x55, l[3], s3); } { const f32x4 l = *(const LAS f32x4*)(Lc + 396); s0 = fmaf(x56, l[0], s0); s1 = fmaf(x57, l[1], s1); s2 = fmaf(x58, l[2], s2); s3 = fmaf(x59, l[3], s3); } { const f32x4 l = *(const LAS f32x4*)(Lc + 400); s0 = fmaf(x60, l[0], s0); s1 = fmaf(x61, l[1], s1); s2 = fmaf(x62, l[2], s2); s3 = fmaf(x63, l[3], s3); } x5 = (lane == 5) ? 1.0f : -((s0 + s1) + (s2 + s3)); asm volatile("" : "+v"(x5) : : "memory"); }
    { float s0 = 0.f, s1 = 0.f, s2 = 0.f, s3 = 0.f; { const f32x4 l = *(const LAS f32x4*)(Lc + 276); s1 = fmaf(x5, l[1], s1); s2 = fmaf(x6, l[2], s2); s3 = fmaf(x7, l[3], s3); } { const f32x4 l = *(const LAS f32x4*)(Lc + 280); s0 = fmaf(x8, l[0], s0); s1 = fmaf(x9, l[1], s1); s2 = fmaf(x10, l[2], s2); s3 = fmaf(x11, l[3], s3); } { const f32x4 l = *(const LAS f32x4*)(Lc + 284); s0 = fmaf(x12, l[0], s0); s1 = fmaf(x13, l[1], s1); s2 = fmaf(x14, l[2], s2); s3 = fmaf(x15, l[3], s3); } { const f32x4 l = *(const LAS f32x4*)(Lc + 288); s0 = fmaf(x16, l[0], s0); s1 = fmaf(x17, l[1], s1); s2 = fmaf(x18, l[2], s2); s3 = fmaf(x19, l[3], s3); } { const f32x4 l = *(const LAS f32x4*)(Lc + 292); s0 = fmaf(x20, l[0], s0); s1 = fmaf(x21, l[1], s1); s2 = fmaf(x22, l[2], s2); s3 = fmaf(x23, l[3], s3); } { const f32x4 l = *(const LAS f32x4*)(Lc + 296); s0 = fmaf(x24, l[0], s0); s1 = fmaf(x25, l[1], s1); s2 = fmaf(x26, l[2], s2); s3 = fmaf(x27, l[3], s3); } { const f32x4 l = *(const LAS f32x4*)(Lc + 300); s0 = fmaf(x28, l[0], s0); s1 = fmaf(x29, l[1], s1); s2 = fmaf(x30, l[2], s2); s3 = fmaf(x31, l[3], s3); } { const f32x4 l = *(const LAS f32x4*)(Lc + 304); s0 = fmaf(x32, l[0], s0); s1 = fmaf(x33, l[1], s1); s2 = fmaf(x34, l[2], s2); s3 = fmaf(x35, l[3], s3); } { const f32x4 l = *(const LAS f32x4*)(Lc + 308); s0 = fmaf(x36, l[0], s0); s1 = fmaf(x37, l[1], s1); s2 = fmaf(x38, l[2], s2); s3 = fmaf(x39, l[3], s3); } { const f32x4 l = *(const LAS f32x4*)(Lc + 312); s0 = fmaf(x40, l[0], s0); s1 = fmaf(x41, l[1], s1); s2 = fmaf(x42, l[2], s2); s3 = fmaf(x43, l[3], s3); } { const f32x4 l = *(const LAS f32x4*)(Lc + 316); s0 = fmaf(x44, l[0], s0); s1 = fmaf(x45, l[1], s1); s2 = fmaf(x46, l[2], s2); s3 = fmaf(x47, l[3], s3); } { const f32x4 l = *(const LAS f32x4*)(Lc + 320); s0 = fmaf(x48, l[0], s0); s1 = fmaf(x49, l[1], s1); s2 = fmaf(x50, l[2], s2); s3 = fmaf(x51, l[3], s3); } { const f32x4 l = *(const LAS f32x4*)(Lc + 324); s0 = fmaf(x52, l[0], s0); s1 = fmaf(x53, l[1], s1); s2 = fmaf(x54, l[2], s2); s3 = fmaf(x55, l[3], s3); } { const f32x4 l = *(const LAS f32x4*)(Lc + 328); s0 = fmaf(x56, l[0], s0); s1 = fmaf(x57, l[1], s1); s2 = fmaf(x58, l[2], s2); s3 = fmaf(x59, l[3], s3); } { const f32x4 l = *(const LAS f32x4*)(Lc + 332); s0 = fmaf(x60, l[0], s0); s1 = fmaf(x61, l[1], s1); s2 = fmaf(x62, l[2], s2); s3 = fmaf(x63, l[3], s3); } x4 = (lane == 4) ? 1.0f : -((s0 + s1) + (s2 + s3)); asm volatile("" : "+v"(x4) : : "memory"); }
    { float s0 = 0.f, s1 = 0.f, s2 = 0.f, s3 = 0.f; { const f32x4 l = *(const LAS f32x4*)(Lc + 208); s0 = fmaf(x4, l[0], s0); s1 = fmaf(x5, l[1], s1); s2 = fmaf(x6, l[2], s2); s3 = fmaf(x7, l[3], s3); } { const f32x4 l = *(const LAS f32x4*)(Lc + 212); s0 = fmaf(x8, l[0], s0); s1 = fmaf(x9, l[1], s1); s2 = fmaf(x10, l[2], s2); s3 = fmaf(x11, l[3], s3); } { const f32x4 l = *(const LAS f32x4*)(Lc + 216); s0 = fmaf(x12, l[0], s0); s1 = fmaf(x13, l[1], s1); s2 = fmaf(x14, l[2], s2); s3 = fmaf(x15, l[3], s3); } { const f32x4 l = *(const LAS f32x4*)(Lc + 220); s0 = fmaf(x16, l[0], s0); s1 = fmaf(x17, l[1], s1); s2 = fmaf(x18, l[2], s2); s3 = fmaf(x19, l[3], s3); } { const f32x4 l = *(const LAS f32x4*)(Lc + 224); s0 = fmaf(x20, l[0], s0); s1 = fmaf(x21, l[1], s1); s2 = fmaf(x22, l[2], s2); s3 = fmaf(x23, l[3], s3); } { const f32x4 l = *(const LAS f32x4*)(Lc + 228); s0 = fmaf(x24, l[0], s0); s1 = fmaf(x25, l[1], s1); s2 = fmaf(x26, l[2], s2); s3 = fmaf(x27, l[3], s3); } { const f32x4 l = *(const LAS f32x4*)(Lc + 232); s0 = fmaf(x28, l[0], s0); s1 = fmaf(x29, l[1], s1); s2 = fmaf(x30, l[2], s2); s3 = fmaf(x31, l[3], s3); } { const f32x4 l = *(const LAS f32x4*)(Lc + 236); s0 = fmaf(x32, l[0], s0); s1 = fmaf(x33, l[1], s1); s2 = fmaf(x34, l[2], s2); s3 = fmaf(x35, l[3], s3); } { const f32x4 l = *(const LAS f32x4*)(Lc + 240); s0 = fmaf(x36, l[0], s0); s1 = fmaf(x37, l[1], s1); s2 = fmaf(x38, l[2], s2); s3 = fmaf(x39, l[3], s3); } { const f32x4 l = *(const LAS f32x4*)(Lc + 244); s0 = fmaf(x40, l[0], s0); s1 = fmaf(x41, l[1], s1); s2 = fmaf(x42, l[2], s2); s3 = fmaf(x43, l[3], s3); } { const f32x4 l = *(const LAS f32x4*)(Lc + 248); s0 = fmaf(x44, l[0], s0); s1 = fmaf(x45, l[1], s1); s2 = fmaf(x46, l[2], s2); s3 = fmaf(x47, l[3], s3); } { const f32x4 l = *(const LAS f32x4*)(Lc + 252); s0 = fmaf(x48, l[0], s0); s1 = fmaf(x49, l[1], s1); s2 = fmaf(x50, l[2], s2); s3 = fmaf(x51, l[3], s3); } { const f32x4 l = *(const LAS f32x4*)(Lc + 256); s0 = fmaf(x52, l[0], s0); s1 = fmaf(x53, l[1], s1); s2 = fmaf(x54, l[2], s2); s3 = fmaf(x55, l[3], s3); } { const f32x4 l = *(const LAS f32x4*)(Lc + 260); s0 = fmaf(x56, l[0], s0); s1 = fmaf(x57, l[1], s1); s2 = fmaf(x58, l[2], s2); s3 = fmaf(x59, l[3], s3); } { const f32x4 l = *(const LAS f32x4*)(Lc + 264); s0 = fmaf(x60, l[0], s0); s1 = fmaf(x61, l[1], s1); s2 = fmaf(x62, l[2], s2); s3 = fmaf(x63, l[3], s3); } x3 = (lane == 3) ? 1.0f : -((s0 + s1) + (s2 + s3)); asm volatile("" : "+v"(x3) : : "memory"); }
    { float s0 = 0.f, s1 = 0.f, s2 = 0.f, s3 = 0.f; { const f32x4 l = *(const LAS f32x4*)(Lc + 136); s3 = fmaf(x3, l[3], s3); } { const f32x4 l = *(const LAS f32x4*)(Lc + 140); s0 = fmaf(x4, l[0], s0); s1 = fmaf(x5, l[1], s1); s2 = fmaf(x6, l[2], s2); s3 = fmaf(x7, l[3], s3); } { const f32x4 l = *(const LAS f32x4*)(Lc + 144); s0 = fmaf(x8, l[0], s0); s1 = fmaf(x9, l[1], s1); s2 = fmaf(x10, l[2], s2); s3 = fmaf(x11, l[3], s3); } { const f32x4 l = *(const LAS f32x4*)(Lc + 148); s0 = fmaf(x12, l[0], s0); s1 = fmaf(x13, l[1], s1); s2 = fmaf(x14, l[2], s2); s3 = fmaf(x15, l[3], s3); } { const f32x4 l = *(const LAS f32x4*)(Lc + 152); s0 = fmaf(x16, l[0], s0); s1 = fmaf(x17, l[1], s1); s2 = fmaf(x18, l[2], s2); s3 = fmaf(x19, l[3], s3); } { const f32x4 l = *(const LAS f32x4*)(Lc + 156); s0 = fmaf(x20, l[0], s0); s1 = fmaf(x21, l[1], s1); s2 = fmaf(x22, l[2], s2); s3 = fmaf(x23, l[3], s3); } { const f32x4 l = *(const LAS f32x4*)(Lc + 160); s0 = fmaf(x24, l[0], s0); s1 = fmaf(x25, l[1], s1); s2 = fmaf(x26, l[2], s2); s3 = fmaf(x27, l[3], s3); } { const f32x4 l = *(const LAS f32x4*)(Lc + 164); s0 = fmaf(x28, l[0], s0); s1 = fmaf(x29, l[1], s1); s2 = fmaf(x30, l[2], s2); s3 = fmaf(x31, l[3], s3); } { const f32x4 l = *(const LAS f32x4*)(Lc + 168); s0 = fmaf(x32, l[0], s0); s1 = fmaf(x33, l[1], s1); s2 = fmaf(x34, l[2], s2); s3 = fmaf(x35, l[3], s3); } { const f32x4 l = *(const LAS f32x4*)(Lc + 172); s0 = fmaf(x36, l[0], s0); s1 = fmaf(x37, l[1], s1); s2 = fmaf(x38, l[2], s2); s3 = fmaf(x39, l[3], s3); } { const f32x4 l = *(const LAS f32x4*)(Lc + 176); s0 = fmaf(x40, l[0], s0); s1 = fmaf(x41, l[1], s1); s2 = fmaf(x42, l[2], s2); s3 = fmaf(x43, l[3], s3); } { const f32x4 l = *(const LAS f32x4*)(Lc + 180); s0 = fmaf(x44, l[0], s0); s1 = fmaf(x45, l[1], s1); s2 = fmaf(x46, l[2], s2); s3 = fmaf(x47, l[3], s3); } { const f32x4 l = *(const LAS f32x4*)(Lc + 184); s0 = fmaf(x48, l[0], s0); s1 = fmaf(x49, l[1], s1); s2 = fmaf(x50, l[2], s2); s3 = fmaf(x51, l[3], s3); } { const f32x4 l = *(const LAS f32x4*)(Lc + 188); s0 = fmaf(x52, l[0], s0); s1 = fmaf(x53, l[1], s1); s2 = fmaf(x54, l[2], s2); s3 = fmaf(x55, l[3], s3); } { const f32x4 l = *(const LAS f32x4*)(Lc + 192); s0 = fmaf(x56, l[0], s0); s1 = fmaf(x57, l[1], s1); s2 = fmaf(x58, l[2], s2); s3 = fmaf(x59, l[3], s3); } { const f32x4 l = *(const LAS f32x4*)(Lc + 196); s0 = fmaf(x60, l[0], s0); s1 = fmaf(x61, l[1], s1); s2 = fmaf(x62, l[2], s2); s3 = fmaf(x63, l[3], s3); } x2 = (lane == 2) ? 1.0f : -((s0 + s1) + (s2 + s3)); asm volatile("" : "+v"(x2) : : "memory"); }
    { float s0 = 0.f, s1 = 0.f, s2 = 0.f, s3 = 0.f; { const f32x4 l = *(const LAS f32x4*)(Lc + 68); s2 = fmaf(x2, l[2], s2); s3 = fmaf(x3, l[3], s3); } { const f32x4 l = *(const LAS f32x4*)(Lc + 72); s0 = fmaf(x4, l[0], s0); s1 = fmaf(x5, l[1], s1); s2 = fmaf(x6, l[2], s2); s3 = fmaf(x7, l[3], s3); } { const f32x4 l = *(const LAS f32x4*)(Lc + 76); s0 = fmaf(x8, l[0], s0); s1 = fmaf(x9, l[1], s1); s2 = fmaf(x10, l[2], s2); s3 = fmaf(x11, l[3], s3); } { const f32x4 l = *(const LAS f32x4*)(Lc + 80); s0 = fmaf(x12, l[0], s0); s1 = fmaf(x13, l[1], s1); s2 = fmaf(x14, l[2], s2); s3 = fmaf(x15, l[3], s3); } { const f32x4 l = *(const LAS f32x4*)(Lc + 84); s0 = fmaf(x16, l[0], s0); s1 = fmaf(x17, l[1], s1); s2 = fmaf(x18, l[2], s2); s3 = fmaf(x19, l[3], s3); } { const f32x4 l = *(const LAS f32x4*)(Lc + 88); s0 = fmaf(x20, l[0], s0); s1 = fmaf(x21, l[1], s1); s2 = fmaf(x22, l[2], s2); s3 = fmaf(x23, l[3], s3); } { const f32x4 l = *(const LAS f32x4*)(Lc + 92); s0 = fmaf(x24, l[0], s0); s1 = fmaf(x25, l[1], s1); s2 = fmaf(x26, l[2], s2); s3 = fmaf(x27, l[3], s3); } { const f32x4 l = *(const LAS f32x4*)(Lc + 96); s0 = fmaf(x28, l[0], s0); s1 = fmaf(x29, l[1], s1); s2 = fmaf(x30, l[2], s2); s3 = fmaf(x31, l[3], s3); } { const f32x4 l = *(const LAS f32x4*)(Lc + 100); s0 = fmaf(x32, l[0], s0); s1 = fmaf(x33, l[1], s1); s2 = fmaf(x34, l[2], s2); s3 = fmaf(x35, l[3], s3); } { const f32x4 l = *(const LAS f32x4*)(Lc + 104); s0 = fmaf(x36, l[0], s0); s1 = fmaf(x37, l[1], s1); s2 = fmaf(x38, l[2], s2); s3 = fmaf(x39, l[3], s3); } { const f32x4 l = *(const LAS f32x4*)(Lc + 108); s0 = fmaf(x40, l[0], s0); s1 = fmaf(x41, l[1], s1); s2 = fmaf(x42, l[2], s2); s3 = fmaf(x43, l[3], s3); } { const f32x4 l = *(const LAS f32x4*)(Lc + 112); s0 = fmaf(x44, l[0], s0); s1 = fmaf(x45, l[1], s1); s2 = fmaf(x46, l[2], s2); s3 = fmaf(x47, l[3], s3); } { const f32x4 l = *(const LAS f32x4*)(Lc + 116); s0 = fmaf(x48, l[0], s0); s1 = fmaf(x49, l[1], s1); s2 = fmaf(x50, l[2], s2); s3 = fmaf(x51, l[3], s3); } { const f32x4 l = *(const LAS f32x4*)(Lc + 120); s0 = fmaf(x52, l[0], s0); s1 = fmaf(x53, l[1], s1); s2 = fmaf(x54, l[2], s2); s3 = fmaf(x55, l[3], s3); } { const f32x4 l = *(const LAS f32x4*)(Lc + 124); s0 = fmaf(x56, l[0], s0); s1 = fmaf(x57, l[1], s1); s2 = fmaf(x58, l[2], s2); s3 = fmaf(x59, l[3], s3); } { const f32x4 l = *(const LAS f32x4*)(Lc + 128); s0 = fmaf(x60, l[0], s0); s1 = fmaf(x61, l[1], s1); s2 = fmaf(x62, l[2], s2); s3 = fmaf(x63, l[3], s3); } x1 = (lane == 1) ? 1.0f : -((s0 + s1) + (s2 + s3)); asm volatile("" : "+v"(x1) : : "memory"); }
    { float s0 = 0.f, s1 = 0.f, s2 = 0.f, s3 = 0.f; { const f32x4 l = *(const LAS f32x4*)(Lc + 0); s1 = fmaf(x1, l[1], s1); s2 = fmaf(x2, l[2], s2); s3 = fmaf(x3, l[3], s3); } { const f32x4 l = *(const LAS f32x4*)(Lc + 4); s0 = fmaf(x4, l[0], s0); s1 = fmaf(x5, l[1], s1); s2 = fmaf(x6, l[2], s2); s3 = fmaf(x7, l[3], s3); } { const f32x4 l = *(const LAS f32x4*)(Lc + 8); s0 = fmaf(x8, l[0], s0); s1 = fmaf(x9, l[1], s1); s2 = fmaf(x10, l[2], s2); s3 = fmaf(x11, l[3], s3); } { const f32x4 l = *(const LAS f32x4*)(Lc + 12); s0 = fmaf(x12, l[0], s0); s1 = fmaf(x13, l[1], s1); s2 = fmaf(x14, l[2], s2); s3 = fmaf(x15, l[3], s3); } { const f32x4 l = *(const LAS f32x4*)(Lc + 16); s0 = fmaf(x16, l[0], s0); s1 = fmaf(x17, l[1], s1); s2 = fmaf(x18, l[2], s2); s3 = fmaf(x19, l[3], s3); } { const f32x4 l = *(const LAS f32x4*)(Lc + 20); s0 = fmaf(x20, l[0], s0); s1 = fmaf(x21, l[1], s1); s2 = fmaf(x22, l[2], s2); s3 = fmaf(x23, l[3], s3); } { const f32x4 l = *(const LAS f32x4*)(Lc + 24); s0 = fmaf(x24, l[0], s0); s1 = fmaf(x25, l[1], s1); s2 = fmaf(x26, l[2], s2); s3 = fmaf(x27, l[3], s3); } { const f32x4 l = *(const LAS f32x4*)(Lc + 28); s0 = fmaf(x28, l[0], s0); s1 = fmaf(x29, l[1], s1); s2 = fmaf(x30, l[2], s2); s3 = fmaf(x31, l[3], s3); } { const f32x4 l = *(const LAS f32x4*)(Lc + 32); s0 = fmaf(x32, l[0], s0); s1 = fmaf(x33, l[1], s1); s2 = fmaf(x34, l[2], s2); s3 = fmaf(x35, l[3], s3); } { const f32x4 l = *(const LAS f32x4*)(Lc + 36); s0 = fmaf(x36, l[0], s0); s1 = fmaf(x37, l[1], s1); s2 = fmaf(x38, l[2], s2); s3 = fmaf(x39, l[3], s3); } { const f32x4 l = *(const LAS f32x4*)(Lc + 40); s0 = fmaf(x40, l[0], s0); s1 = fmaf(x41, l[1], s1); s2 = fmaf(x42, l[2], s2); s3 = fmaf(x43, l[3], s3); } { const f32x4 l = *(const LAS f32x4*)(Lc + 44); s0 = fmaf(x44, l[0], s0); s1 = fmaf(x45, l[1], s1); s2 = fmaf(x46, l[2], s2); s3 = fmaf(x47, l[3], s3); } { const f32x4 l = *(const LAS f32x4*)(Lc + 48); s0 = fmaf(x48, l[0], s0); s1 = fmaf(x49, l[1], s1); s2 = fmaf(x50, l[2], s2); s3 = fmaf(x51, l[3], s3); } { const f32x4 l = *(const LAS f32x4*)(Lc + 52); s0 = fmaf(x52, l[0], s0); s1 = fmaf(x53, l[1], s1); s2 = fmaf(x54, l[2], s2); s3 = fmaf(x55, l[3], s3); } { const f32x4 l = *(const LAS f32x4*)(Lc + 56); s0 = fmaf(x56, l[0], s0); s1 = fmaf(x57, l[1], s1); s2 = fmaf(x58, l[2], s2); s3 = fmaf(x59, l[3], s3); } { const f32x4 l = *(const LAS f32x4*)(Lc + 60); s0 = fmaf(x60, l[0], s0); s1 = fmaf(x61, l[1], s1); s2 = fmaf(x62, l[2], s2); s3 = fmaf(x63, l[3], s3); } x0 = (lane == 0) ? 1.0f : -((s0 + s1) + (s2 + s3)); asm volatile("" : "+v"(x0) : : "memory"); }
    { v4u o; o.x = cvtpk(x0, x1); o.y = cvtpk(x2, x3); o.z = cvtpk(x4, x5); o.w = cvtpk(x6, x7); *(LAS v4u*)(Xs + lane * 72 + 0) = o; }
    { v4u o; o.x = cvtpk(x8, x9); o.y = cvtpk(x10, x11); o.z = cvtpk(x12, x13); o.w = cvtpk(x14, x15); *(LAS v4u*)(Xs + lane * 72 + 8) = o; }
    { v4u o; o.x = cvtpk(x16, x17); o.y = cvtpk(x18, x19); o.z = cvtpk(x20, x21); o.w = cvtpk(x22, x23); *(LAS v4u*)(Xs + lane * 72 + 16) = o; }
    { v4u o; o.x = cvtpk(x24, x25); o.y = cvtpk(x26, x27); o.z = cvtpk(x28, x29); o.w = cvtpk(x30, x31); *(LAS v4u*)(Xs + lane * 72 + 24) = o; }
    { v4u o; o.x = cvtpk(x32, x33); o.y = cvtpk(x34, x35); o.z = cvtpk(x36, x37); o.w = cvtpk(x38, x39); *(LAS v4u*)(Xs + lane * 72 + 32) = o; }
    { v4u o; o.x = cvtpk(x40, x41); o.y = cvtpk(x42, x43); o.z = cvtpk(x44, x45); o.w = cvtpk(x46, x47); *(LAS v4u*)(Xs + lane * 72 + 40) = o; }
    { v4u o; o.x = cvtpk(x48, x49); o.y = cvtpk(x50, x51); o.z = cvtpk(x52, x53); o.w = cvtpk(x54, x55); *(LAS v4u*)(Xs + lane * 72 + 48) = o; }
    { v4u o; o.x = cvtpk(x56, x57); o.y = cvtpk(x58, x59); o.z = cvtpk(x60, x61); o.w = cvtpk(x62, x63); *(LAS v4u*)(Xs + lane * 72 + 56) = o; }
}
#ifndef G1P
#define G1P 15
#endif

#define MF16(a, b, c) __builtin_amdgcn_mfma_f32_16x16x32_bf16((a), (b), (c), 0, 0, 0)
__device__ __forceinline__ bf16x8 ld16g(const bf16* p) { return *(const GAS bf16x8*)p; }
__device__ __forceinline__ float ldbf(const bf16* p) { return __uint_as_float(((unsigned)*(const GAS unsigned short*)p) << 16); }
__device__ __forceinline__ void st8(bf16* p, float a, float b, float c, float d) { u32x2v o; o.x = cvtpk(a, b); o.y = cvtpk(c, d); *(GAS u32x2v*)p = o; }

__device__ __forceinline__ void p_ga(const Frame& F, const Args& a, int L) {
    GAS unsigned char* ws = (GAS unsigned char*)a.ws; asm volatile("" : "+s"(ws)); int lane_ = F.lane; asm volatile("" : "+v"(lane_)); const int j = L >> 1, lane = lane_;
    const bf16* PO = (const bf16*)(ws + WS_ARENA + AR_PO);
    bf16 *QN = (bf16*)(ws + WS_ARENA + AR_QN), *QT = (bf16*)(ws + WS_ARENA + AR_QT), *KN = (bf16*)(ws + WS_ARENA + AR_KN), *KGT = (bf16*)(ws + WS_ARENA + AR_KGT), *VBT = (bf16*)(ws + WS_ARENA + AR_VBT), *KTT = (bf16*)(ws + WS_ARENA + AR_KTT);
    const float* gg = (const float*)(ws + WS_GB); const float* gbeta = gg + S_ * 8; float* dn = (float*)(ws + WS_TOK + TOK_DN); float* gcs = (float*)(ws + WS_GC);
    const float* cw = (const float*)a.in[16] + (size_t)j * 4 * 3072;
    LAS float* sc = (LAS float*)(F.lds + F.wave * WAVE_LDS);
    const int dg = lane & 15, ts = lane >> 4, d0 = 8 * dg;
#pragma unroll 1
    for (int tp_ = 2 * F.vcu + (F.wave >> 2); tp_ < 512; tp_ += 2 * F.G) {
        const int u = (4 * (tp_ >> 3) + (F.wave & 3)) * 8 + (tp_ & 7);
        const int n = u >> 3, hh = u & 7, tok0 = 64 * n;
        {
            const float g = gg[(size_t)(tok0 + lane) * 8 + hh], beta = gbeta[(size_t)(tok0 + lane) * 8 + hh];
            float gc = g;
#pragma unroll
            for (int o = 1; o < 64; o <<= 1) { const float t = __shfl_up(gc, o); if (lane >= o) gc += t; }
            const float glast = __shfl(gc, 63);
            gcs[(size_t)(tok0 + lane) * 8 + hh] = gc;
            if (lane == 0) dn[u] = expf(glast);
            const float eg = expf(gc);
            sc[64 + lane] = beta * eg; sc[128 + lane] = expf(glast - gc); sc[192 + lane] = beta; sc[256 + lane] = eg;
        }
#pragma unroll 1
        for (int qk = 0; qk < 2; ++qk) {
            const int coff = qk * 1024 + hh * 128 + d0;
            float w[4][8];
#pragma unroll
            for (int jj = 0; jj < 4; ++jj)
#pragma unroll
                for (int e = 0; e < 8; ++e) w[jj][e] = *(const GAS float*)(cw + jj * 3072 + coff + e);
#pragma unroll 4
            for (int it = 0; it < 16; ++it) {
                const int i = 4 * it + ts, tok = tok0 + i; float acc[8];
                v4u rv[4];
#pragma unroll
                for (int jj = 0; jj < 4; ++jj) { const int r = tok - 3 + jj; rv[jj] = *(const GAS v4u*)(PO + (size_t)(r < 0 ? 0 : r) * OIN + coff); }
#pragma unroll
                for (int e = 0; e < 8; ++e) acc[e] = 0.f;
#pragma unroll
                for (int jj = 0; jj < 4; ++jj) { const float on = (tok - 3 + jj >= 0) ? 1.0f : 0.0f; const unsigned vv[4] = {rv[jj].x, rv[jj].y, rv[jj].z, rv[jj].w};
#pragma unroll
                    for (int q = 0; q < 4; ++q) { acc[2 * q] += (w[jj][2 * q] * on) * bflo(vv[q]); acc[2 * q + 1] += (w[jj][2 * q + 1] * on) * bfhi(vv[q]); } }
                float ss = 0.f;
#pragma unroll
                for (int e = 0; e < 8; ++e) { acc[e] = silu(acc[e]); ss += acc[e] * acc[e]; }
                ss += __shfl_xor(ss, 1); ss += __shfl_xor(ss, 2); ss += __shfl_xor(ss, 4); ss += __shfl_xor(ss, 8);
                const float rn = __builtin_amdgcn_rsqf(ss + 1e-6f);
                const float s1 = (qk == 0) ? rn * 0.08838834764831845f : rn;
                v4u o; o.x = cvtpk(acc[0] * s1, acc[1] * s1); o.y = cvtpk(acc[2] * s1, acc[3] * s1); o.z = cvtpk(acc[4] * s1, acc[5] * s1); o.w = cvtpk(acc[6] * s1, acc[7] * s1);
                *(GAS v4u*)((qk == 0 ? QN : KN) + (size_t)tok * D_ + hh * 128 + d0) = o;
                if (qk == 0) { const float s2 = s1 * sc[256 + i];
                    o.x = cvtpk(acc[0] * s2, acc[1] * s2); o.y = cvtpk(acc[2] * s2, acc[3] * s2); o.z = cvtpk(acc[4] * s2, acc[5] * s2); o.w = cvtpk(acc[6] * s2, acc[7] * s2);
                    *(GAS v4u*)(QT + (size_t)tok * D_ + hh * 128 + d0) = o; }
                else if (dg == 0) sc[i] = rn;
            }
        }
#pragma unroll 1
        for (int kv = 0; kv < 2; ++kv)
#pragma unroll 1
            for (int half = 0; half < 2; ++half) {
                const int d = 64 * half + lane, c = (1 + kv) * 1024 + hh * 128 + d;
                const float w0 = *(const GAS float*)(cw + c), w1 = *(const GAS float*)(cw + 3072 + c), w2 = *(const GAS float*)(cw + 2 * 3072 + c), w3 = *(const GAS float*)(cw + 3 * 3072 + c);
                const float hon = tok0 > 0 ? 1.0f : 0.0f; const int hb = tok0 > 0 ? tok0 - 3 : 0;
                float r0 = hon * ldbf(PO + (size_t)hb * OIN + c), r1 = hon * ldbf(PO + (size_t)(hb + 1) * OIN + c), r2 = hon * ldbf(PO + (size_t)(hb + 2) * OIN + c);
                const size_t obase = ((size_t)u * 128 + d) * 64;
                const LAS float* m1 = sc + (kv == 0 ? 64 : 192);
                bf16* O1 = kv == 0 ? KGT : VBT;
#pragma unroll 1
                for (int ig4 = 0; ig4 < 2; ++ig4) {
                    float x[32];
#pragma unroll
                    for (int e = 0; e < 32; ++e) x[e] = ldbf(PO + (size_t)(tok0 + 32 * ig4 + e) * OIN + c);
#pragma unroll
                    for (int sb = 0; sb < 4; ++sb) { const int ig = 4 * ig4 + sb; float o1[8], o2[8];
#pragma unroll
                        for (int e = 0; e < 8; ++e) { const int i = 8 * ig + e; const float r3 = x[8 * sb + e];
                            float v = silu(w0 * r0 + w1 * r1 + w2 * r2 + w3 * r3); r0 = r1; r1 = r2; r2 = r3;
                            const float rk = sc[i]; v = (kv == 0) ? v * rk : v;
                            o1[e] = v * m1[i]; o2[e] = v * sc[128 + i]; }
                        v4u o; o.x = cvtpk(o1[0], o1[1]); o.y = cvtpk(o1[2], o1[3]); o.z = cvtpk(o1[4], o1[5]); o.w = cvtpk(o1[6], o1[7]);
                        *(GAS v4u*)(O1 + obase + 8 * ig) = o;
                        if (kv == 0) { o.x = cvtpk(o2[0], o2[1]); o.y = cvtpk(o2[2], o2[3]); o.z = cvtpk(o2[4], o2[5]); o.w = cvtpk(o2[6], o2[7]); *(GAS v4u*)(KTT + obase + 8 * ig) = o; } }
                }
            }
    }
}

__device__ __forceinline__ void p_g1(const Frame& F, const Args& a) {
    GAS unsigned char* ws = (GAS unsigned char*)a.ws; asm volatile("" : "+s"(ws)); int lane_ = F.lane; asm volatile("" : "+v"(lane_)); const int lane = lane_, r16 = lane & 15, g = lane >> 4;
    const bf16 *QN = (const bf16*)(ws + WS_ARENA + AR_QN), *KN = (const bf16*)(ws + WS_ARENA + AR_KN), *KGT = (const bf16*)(ws + WS_ARENA + AR_KGT), *VBT = (const bf16*)(ws + WS_ARENA + AR_VBT), *KTT = (const bf16*)(ws + WS_ARENA + AR_KTT);
    bf16 *AI = (bf16*)(ws + WS_ARENA + AR_AI), *NEGW = (bf16*)(ws + WS_ARENA + AR_NEGW), *UT = (bf16*)(ws + WS_ARENA + AR_UT), *MP = (bf16*)(ws + WS_ARENA + AR_MP), *NT = (bf16*)(ws + WS_ARENA + AR_NT), *WT = (bf16*)(ws + WS_ARENA + AR_WT);
    const float* gg = (const float*)(ws + WS_GC); const float* gbeta = (const float*)(ws + WS_GB) + S_ * 8;
    LAS float* Lc = (LAS float*)(F.lds + F.wave * WAVE_LDS);
    LAS bf16* Xs = (LAS bf16*)(F.lds + F.wave * WAVE_LDS);
    const f32x4 Z4 = {0.f, 0.f, 0.f, 0.f};
#ifdef PROBE_G1P
    const int g1p = a.use_bar ? 15 : PROBE_G1P;
#else
    const int g1p = 15;
#endif
#pragma unroll 1
    for (int tp_ = 2 * F.vcu + (F.wave >> 2); tp_ < 512; tp_ += 2 * F.G) {
        const int u = (4 * (tp_ >> 3) + (F.wave & 3)) * 8 + (tp_ & 7);
        const int n = u >> 3, hh = u & 7, tok0 = 64 * n; const int uh = hh * NCHUNK + n;
        const float gc = gg[(size_t)(tok0 + lane) * 8 + hh], beta = gbeta[(size_t)(tok0 + lane) * 8 + hh];
        if (g1p & 1) {
        {
            bf16x8 kf[4][4];
#pragma unroll
            for (int t = 0; t < 4; ++t)
#pragma unroll
                for (int kk = 0; kk < 4; ++kk) kf[t][kk] = ld16g(KN + (size_t)(tok0 + 16 * t + r16) * D_ + hh * 128 + 32 * kk + 8 * g);
#pragma unroll
            for (int ti = 0; ti < 4; ++ti)
#pragma unroll
                for (int tj = 0; tj <= ti; ++tj) {
                    f32x4 Dv = Z4;
#pragma unroll
                    for (int kk = 0; kk < 4; ++kk) Dv = MF16(kf[ti][kk], kf[tj][kk], Dv);
                    const int jx = 16 * tj + r16; const float gcj = __shfl(gc, jx); f32x4 val;
#pragma unroll
                    for (int r = 0; r < 4; ++r) { const int ix = 16 * ti + 4 * g + r; const float gci = __shfl(gc, ix), bi = __shfl(beta, ix); val[r] = (ix > jx) ? bi * Dv[r] * expf(gci - gcj) : 0.f; }
                    *(LAS f32x4*)(Lc + jx * 68 + 16 * ti + 4 * g) = val;
                }
#pragma unroll
            for (int ti = 0; ti < 4; ++ti) {
                bf16x8 qf[4];
#pragma unroll
                for (int kk = 0; kk < 4; ++kk) qf[kk] = ld16g(QN + (size_t)(tok0 + 16 * ti + r16) * D_ + hh * 128 + 32 * kk + 8 * g);
                const int ix = 16 * ti + r16; const float gci = __shfl(gc, ix);
#pragma unroll
                for (int tj = 0; tj < 4; ++tj) {
                    f32x4 val = Z4;
                    if (tj <= ti) {
                        f32x4 Dv = Z4;
#pragma unroll
                        for (int kk = 0; kk < 4; ++kk) Dv = MF16(kf[tj][kk], qf[kk], Dv);
#pragma unroll
                        for (int r = 0; r < 4; ++r) { const int jx = 16 * tj + 4 * g + r; const float gcj = __shfl(gc, jx); val[r] = (ix >= jx) ? Dv[r] * expf(gci - gcj) : 0.f; }
                    }
                    st8(AI + ((size_t)u * 64 + ix) * 64 + 16 * tj + 4 * g, val[0], val[1], val[2], val[3]);
                }
            }
        }
        asm volatile("s_waitcnt lgkmcnt(0)" ::: "memory");
        }
        if (g1p & 2) {
        tri_solve(Lc, Xs, lane);
        }
        if (g1p & 4) {
        asm volatile("s_waitcnt lgkmcnt(0)" ::: "memory");
        {
            bf16x8 xf[4][2];
#pragma unroll
            for (int t = 0; t < 4; ++t)
#pragma unroll
                for (int kk = 0; kk < 2; ++kk) xf[t][kk] = *(const LAS bf16x8*)(Xs + (16 * t + r16) * 72 + 32 * kk + 8 * g);
#pragma unroll 2
            for (int td = 0; td < 8; ++td) {
                const size_t rb = ((size_t)u * 128 + 16 * td + r16) * 64;
                const bf16x8 vb0 = ld16g(VBT + rb + 8 * g), vb1 = ld16g(VBT + rb + 32 + 8 * g), kg0 = ld16g(KGT + rb + 8 * g), kg1 = ld16g(KGT + rb + 32 + 8 * g);
#pragma unroll
                for (int ti = 0; ti < 4; ++ti) {
                    f32x4 Du = MF16(xf[ti][0], vb0, Z4); Du = MF16(xf[ti][1], vb1, Du);
                    st8(UT + rb + 16 * ti + 4 * g, Du[0], Du[1], Du[2], Du[3]);
                    f32x4 Dn = MF16(kg0, xf[ti][0], Z4); Dn = MF16(kg1, xf[ti][1], Dn);
                    st8(NEGW + (size_t)(tok0 + 16 * ti + r16) * D_ + hh * 128 + 16 * td + 4 * g, -Dn[0], -Dn[1], -Dn[2], -Dn[3]);
                }
            }
        }
        }
    }
}

template <int NS, int SGSTEP> __device__ __forceinline__ void p_g2(const Frame& F, const Args& a, const bf16* MPsrc, const bf16* NTsrc, const float* dnsrc) {
    GAS unsigned char* ws = (GAS unsigned char*)a.ws; asm volatile("" : "+s"(ws)); int lane_ = F.lane; asm volatile("" : "+v"(lane_)); const int lane = lane_, r16 = lane & 15, g = lane >> 4, w = F.wave;
    const bf16 *MP = MPsrc, *NT = NTsrc; bf16* SG = (bf16*)(ws + WS_ARENA + AR_SG);
    const float* dn = dnsrc;
    LAS bf16* St = (LAS bf16*)F.lds;
    const int args_use_bar = a.use_bar; (void)args_use_bar;
#pragma unroll 1
    for (int asg = F.vcu; asg < 64; asg += F.G) {
        const int hh = asg >> 3, sl = asg & 7;
        __syncthreads();
        for (int idx = F.tid; idx < 2 * 16 * 136 / 2; idx += NWAVES * 64) ((LAS unsigned*)St)[idx] = 0u;
        __syncthreads();
        if (w >= 4) {
            const int st = F.tid - 256, row = st >> 4, chunk = st & 15;
#pragma unroll 1
            for (int n = 0; n < NS; ++n) {
                const v4u v = *(const LAS v4u*)(St + (n & 1) * (16 * 136) + row * 136 + chunk * 8);
                *(GAS v4u*)(SG + ((size_t)(hh * NCHUNK + n * SGSTEP) * 128 + 16 * sl + row) * 128 + chunk * 8) = v;
                asm volatile("s_waitcnt lgkmcnt(0)" ::: "memory"); __builtin_amdgcn_s_barrier(); asm volatile("" ::: "memory");
            }
        } else {
            f32x4 Sv[2] = {{0.f, 0.f, 0.f, 0.f}, {0.f, 0.f, 0.f, 0.f}};
            bf16x8 A0[2][4], A1[2][4], A2[2][4], A3[2][4]; u32x2v C0[2], C1[2], C2[2], C3[2]; float d0, d1, d2, d3;
#define G2_LOAD(AX, CX, DX, nn) do { const int u_ = hh * NS + (nn); \
            _Pragma("unroll") for (int t = 0; t < 2; ++t) { \
                _Pragma("unroll") for (int kk = 0; kk < 4; ++kk) AX[t][kk] = ld16g(MP + ((size_t)u_ * 128 + 32 * w + 16 * t + r16) * 128 + 32 * kk + 8 * g); \
                CX[t] = *(const GAS u32x2v*)(NT + ((size_t)u_ * 128 + 16 * sl + r16) * 128 + 32 * w + 16 * t + 4 * g); } \
            DX = *(const GAS float*)(dn + (nn) * 8 + hh); } while (0)
#ifdef PROBE_G2_NOLOAD
#define G2_STEPLOAD(AL, CL, DL, nn) do { if (args_use_bar) G2_LOAD(AL, CL, DL, nn); } while (0)
#else
#define G2_STEPLOAD(AL, CL, DL, nn) G2_LOAD(AL, CL, DL, nn)
#endif
#define G2_STEP(AU, CU, DU, AL, CL, DL, nn) do { const int n_ = (nn); const int n2_ = (n_ + 3 < NS) ? n_ + 3 : NS - 1; \
            G2_STEPLOAD(AL, CL, DL, n2_); \
            LAS bf16* Sc = St + (n_ & 1) * (16 * 136); LAS bf16* Sn = St + ((n_ & 1) ^ 1) * (16 * 136); \
            f32x4 D0 = {bflo(CU[0].x), bfhi(CU[0].x), bflo(CU[0].y), bfhi(CU[0].y)}, D1 = {bflo(CU[1].x), bfhi(CU[1].x), bflo(CU[1].y), bfhi(CU[1].y)}; \
            _Pragma("unroll") for (int kk = 0; kk < 4; ++kk) { const bf16x8 Bf = *(const LAS bf16x8*)(Sc + r16 * 136 + 32 * kk + 8 * g); D0 = MF16(AU[0][kk], Bf, D0); D1 = MF16(AU[1][kk], Bf, D1); } \
            Sv[0] = Sv[0] * DU + D0; Sv[1] = Sv[1] * DU + D1; \
            { u32x2v o; o.x = cvtpk(Sv[0][0], Sv[0][1]); o.y = cvtpk(Sv[0][2], Sv[0][3]); *(LAS u32x2v*)(Sn + r16 * 136 + 32 * w + 4 * g) = o; \
              o.x = cvtpk(Sv[1][0], Sv[1][1]); o.y = cvtpk(Sv[1][2], Sv[1][3]); *(LAS u32x2v*)(Sn + r16 * 136 + 32 * w + 16 + 4 * g) = o; } \
            asm volatile("s_waitcnt lgkmcnt(0)" ::: "memory"); __builtin_amdgcn_s_barrier(); asm volatile("" ::: "memory"); } while (0)
            G2_LOAD(A0, C0, d0, 0); G2_LOAD(A1, C1, d1, 1); G2_LOAD(A2, C2, d2, 2);
            static_assert(NS % 24 == 16, "scan loop: trips of 24 steps + a 16-step tail");
            int n = 0;
#pragma unroll 1
            for (; n + 24 <= NS - 16; n += 24) {
                G2_STEP(A0, C0, d0, A3, C3, d3, n + 0);
                G2_STEP(A1, C1, d1, A0, C0, d0, n + 1);
                G2_STEP(A2, C2, d2, A1, C1, d1, n + 2);
                G2_STEP(A3, C3, d3, A2, C2, d2, n + 3);
                G2_STEP(A0, C0, d0, A3, C3, d3, n + 4);
                G2_STEP(A1, C1, d1, A0, C0, d0, n + 5);
                G2_STEP(A2, C2, d2, A1, C1, d1, n + 6);
                G2_STEP(A3, C3, d3, A2, C2, d2, n + 7);
                G2_STEP(A0, C0, d0, A3, C3, d3, n + 8);
                G2_STEP(A1, C1, d1, A0, C0, d0, n + 9);
                G2_STEP(A2, C2, d2, A1, C1, d1, n + 10);
                G2_STEP(A3, C3, d3, A2, C2, d2, n + 11);
                G2_STEP(A0, C0, d0, A3, C3, d3, n + 12);
                G2_STEP(A1, C1, d1, A0, C0, d0, n + 13);
                G2_STEP(A2, C2, d2, A1, C1, d1, n + 14);
                G2_STEP(A3, C3, d3, A2, C2, d2, n + 15);
                G2_STEP(A0, C0, d0, A3, C3, d3, n + 16);
                G2_STEP(A1, C1, d1, A0, C0, d0, n + 17);
                G2_STEP(A2, C2, d2, A1, C1, d1, n + 18);
                G2_STEP(A3, C3, d3, A2, C2, d2, n + 19);
                G2_STEP(A0, C0, d0, A3, C3, d3, n + 20);
                G2_STEP(A1, C1, d1, A0, C0, d0, n + 21);
                G2_STEP(A2, C2, d2, A1, C1, d1, n + 22);
                G2_STEP(A3, C3, d3, A2, C2, d2, n + 23);
            }
            G2_STEP(A0, C0, d0, A3, C3, d3, n + 0);
            G2_STEP(A1, C1, d1, A0, C0, d0, n + 1);
            G2_STEP(A2, C2, d2, A1, C1, d1, n + 2);
            G2_STEP(A3, C3, d3, A2, C2, d2, n + 3);
            G2_STEP(A0, C0, d0, A3, C3, d3, n + 4);
            G2_STEP(A1, C1, d1, A0, C0, d0, n + 5);
            G2_STEP(A2, C2, d2, A1, C1, d1, n + 6);
            G2_STEP(A3, C3, d3, A2, C2, d2, n + 7);
            G2_STEP(A0, C0, d0, A3, C3, d3, n + 8);
            G2_STEP(A1, C1, d1, A0, C0, d0, n + 9);
            G2_STEP(A2, C2, d2, A1, C1, d1, n + 10);
            G2_STEP(A3, C3, d3, A2, C2, d2, n + 11);
            G2_STEP(A0, C0, d0, A3, C3, d3, n + 12);
            G2_STEP(A1, C1, d1, A0, C0, d0, n + 13);
            G2_STEP(A2, C2, d2, A1, C1, d1, n + 14);
            G2_STEP(A3, C3, d3, A2, C2, d2, n + 15);
#undef G2_STEP
#undef G2_LOAD
        }
    }
}


constexpr int GST_W = 64 * 136, GST_K = 128 * 68, GST_PAIR = GST_W + GST_K, GST_BYTES = 2 * GST_PAIR * 2, GW_BYTES = 8704;
static_assert(GST_BYTES + 8 * GW_BYTES <= LDSCTL_OFF, "group-phase LDS map");
__device__ __forceinline__ void g_stage(const Frame& F, const bf16* NEGW, const bf16* KTT, int p, int n, int hh, bool on) {
    LAS bf16* sw = (LAS bf16*)F.lds + p * GST_PAIR; LAS bf16* sk = sw + GST_W;
#pragma unroll
    for (int q = 0; q < 2; ++q) { const int idx = F.tid + 512 * q;
        { const int row = idx >> 4, ch = idx & 15; v4u v = {0u, 0u, 0u, 0u}; if (on) v = *(const GAS v4u*)(NEGW + (size_t)(64 * n + row) * D_ + hh * 128 + ch * 8); *(LAS v4u*)(sw + row * 136 + ch * 8) = v; }
        { const int row = idx >> 3, ch = idx & 7; u32x2v a = {0u, 0u}, b = a; if (on) { const v4u v = *(const GAS v4u*)(KTT + ((size_t)(n * 8 + hh) * 128 + row) * 64 + ch * 8); a.x = v.x; a.y = v.y; b.x = v.z; b.y = v.w; }
          *(LAS u32x2v*)(sk + row * 68 + ch * 8) = a; *(LAS u32x2v*)(sk + row * 68 + ch * 8 + 4) = b; } }
}
template <bool PERM> __device__ __forceinline__ void g_prod1(f32x4 (&T)[4][2], const LAS bf16* sw, const bf16x8 (&xo)[4][2], int r16, int g) {
#pragma unroll
    for (int mt = 0; mt < 4; ++mt) {
        bf16x8 af[4];
#pragma unroll
        for (int s = 0; s < 4; ++s) {
            if (PERM) { const LAS bf16* rp = sw + (16 * mt + r16) * 136 + 32 * s + 4 * g; const u32x2v lo = *(const LAS u32x2v*)rp, hi = *(const LAS u32x2v*)(rp + 16); const v4u pk = {lo.x, lo.y, hi.x, hi.y}; af[s] = __builtin_bit_cast(bf16x8, pk); }
            else af[s] = *(const LAS bf16x8*)(sw + (16 * mt + r16) * 136 + 32 * s + 8 * g); }
#pragma unroll
        for (int nt = 0; nt < 2; ++nt)
#pragma unroll
            for (int s = 0; s < 4; ++s) T[mt][nt] = MF16(af[s], xo[s][nt], T[mt][nt]);
        asm volatile("" ::: "memory");
    }
}
__device__ __forceinline__ void g_prod2(f32x4 (&X)[8][2], const LAS bf16* sk, const f32x4 (&T)[4][2], int r16, int g) {
    bf16x8 to[2][2];
#pragma unroll
    for (int s = 0; s < 2; ++s)
#pragma unroll
        for (int nt = 0; nt < 2; ++nt) { v4u p; p.x = cvtpk(T[2 * s][nt][0], T[2 * s][nt][1]); p.y = cvtpk(T[2 * s][nt][2], T[2 * s][nt][3]); p.z = cvtpk(T[2 * s + 1][nt][0], T[2 * s + 1][nt][1]); p.w = cvtpk(T[2 * s + 1][nt][2], T[2 * s + 1][nt][3]);
            to[s][nt] = __builtin_bit_cast(bf16x8, p); }
#pragma unroll
    for (int mt = 0; mt < 8; ++mt) {
        bf16x8 af[2];
#pragma unroll
        for (int s = 0; s < 2; ++s) { const LAS bf16* rp = sk + (16 * mt + r16) * 68 + 32 * s + 4 * g; const u32x2v lo = *(const LAS u32x2v*)rp, hi = *(const LAS u32x2v*)(rp + 16); const v4u pk = {lo.x, lo.y, hi.x, hi.y}; af[s] = __builtin_bit_cast(bf16x8, pk); }
#pragma unroll
        for (int nt = 0; nt < 2; ++nt)
#pragma unroll
            for (int s = 0; s < 2; ++s) X[mt][nt] = MF16(af[s], to[s][nt], X[mt][nt]);
        asm volatile("" ::: "memory");
    }
}
__device__ __forceinline__ void p_g1b(const Frame& F, const Args& a) {
    GAS unsigned char* ws = (GAS unsigned char*)a.ws; asm volatile("" : "+s"(ws)); int lane_ = F.lane; asm volatile("" : "+v"(lane_)); const int lane = lane_, r16 = lane & 15, g = lane >> 4;
    const bf16 *NEGW = (const bf16*)(ws + WS_ARENA + AR_NEGW), *KTT = (const bf16*)(ws + WS_ARENA + AR_KTT), *UT = (const bf16*)(ws + WS_ARENA + AR_UT); const float* dn = (const float*)(ws + WS_TOK + TOK_DN);
    bf16 *MPc = (bf16*)(ws + WS_ARENA + AR_MPC), *NTc = (bf16*)(ws + WS_ARENA + AR_NTC); float* dnc = (float*)(ws + WS_TOK + TOK_DNC);
    const bool isB = F.wave >= 4; const int sl = F.wave & 3, c0 = 32 * sl;
    const LAS bf16* sw = (const LAS bf16*)F.lds; const LAS bf16* sk = sw + GST_W; LAS bf16* wa = (LAS bf16*)(F.lds + GST_BYTES + F.wave * GW_BYTES);
#pragma unroll 1
    for (int tp = 2 * F.vcu; tp < 512; tp += (tp & 1) ? 2 * F.G - 1 : 1) {
        const int hh = tp & 7, gq = tp >> 3;
        f32x4 X[8][2]; float Dd = 1.0f;
#pragma unroll
        for (int mt = 0; mt < 8; ++mt)
#pragma unroll
            for (int nt = 0; nt < 2; ++nt) X[mt][nt] = (f32x4){0.f, 0.f, 0.f, 0.f};
#pragma unroll 1
        for (int i = 0; i < 4; ++i) {
            const int n = 4 * gq + i; const float di = *(const GAS float*)(dn + n * 8 + hh);
            bf16x8 xo[4][2]; const float dadd = isB ? 0.0f : Dd;
#pragma unroll
            for (int s = 0; s < 4; ++s)
#pragma unroll
                for (int nt = 0; nt < 2; ++nt) { v4u pr; const int col = c0 + 16 * nt + r16; f32x4 t0 = X[2 * s][nt], t1 = X[2 * s + 1][nt];
#pragma unroll
                    for (int r = 0; r < 4; ++r) { if (32 * s + 4 * g + r == col) t0[r] += dadd; if (32 * s + 16 + 4 * g + r == col) t1[r] += dadd; }
                    pr.x = cvtpk(t0[0], t0[1]); pr.y = cvtpk(t0[2], t0[3]); pr.z = cvtpk(t1[0], t1[1]); pr.w = cvtpk(t1[2], t1[3]); xo[s][nt] = __builtin_bit_cast(bf16x8, pr); }
            __syncthreads();
            g_stage(F, NEGW, KTT, 0, n, hh, true);
            f32x4 T[4][2];
#pragma unroll
            for (int mt = 0; mt < 4; ++mt)
#pragma unroll
                for (int nt = 0; nt < 2; ++nt) { T[mt][nt] = (f32x4){0.f, 0.f, 0.f, 0.f};
                    if (isB) { const u32x2v uu = *(const GAS u32x2v*)(UT + ((size_t)(n * 8 + hh) * 128 + c0 + 16 * nt + r16) * 64 + 16 * mt + 4 * g); T[mt][nt] = (f32x4){bflo(uu.x), bfhi(uu.x), bflo(uu.y), bfhi(uu.y)}; } }
            __syncthreads();
            g_prod1<true>(T, sw, xo, r16, g);
#pragma unroll
            for (int mt = 0; mt < 8; ++mt)
#pragma unroll
                for (int nt = 0; nt < 2; ++nt) X[mt][nt] = X[mt][nt] * di;
            g_prod2(X, sk, T, r16, g);
            Dd *= di;
        }
        const int uc = hh * 64 + gq;
        if (isB) {
#pragma unroll
            for (int mt = 0; mt < 8; ++mt)
#pragma unroll
                for (int nt = 0; nt < 2; ++nt) st8(NTc + ((size_t)uc * 128 + c0 + 16 * nt + r16) * 128 + 16 * mt + 4 * g, X[mt][nt][0], X[mt][nt][1], X[mt][nt][2], X[mt][nt][3]);
        } else {
            if (sl == 0 && lane == 0) dnc[gq * 8 + hh] = Dd;
#pragma unroll
            for (int hf = 0; hf < 2; ++hf) {
                asm volatile("s_waitcnt lgkmcnt(0)" ::: "memory");
#pragma unroll
                for (int m4 = 0; m4 < 4; ++m4)
#pragma unroll
                    for (int nt = 0; nt < 2; ++nt)
#pragma unroll
                        for (int r = 0; r < 4; ++r) wa[(16 * m4 + 4 * g + r) * 40 + 16 * nt + r16] = (unsigned short)(cvtpk(X[4 * hf + m4][nt][r], 0.f) & 0xffffu);
                asm volatile("s_waitcnt lgkmcnt(0)" ::: "memory");
#pragma unroll
                for (int q = 0; q < 4; ++q) { const int row = 16 * q + (lane >> 2), ch = lane & 3; const v4u v = *(const LAS v4u*)(wa + row * 40 + ch * 8);
                    *(GAS v4u*)(MPc + ((size_t)uc * 128 + 64 * hf + row) * 128 + c0 + ch * 8) = v; }
            }
        }
    }
    __syncthreads();
}

__device__ __forceinline__ void p_g2b(const Frame& F, const Args& a) {
    GAS unsigned char* ws = (GAS unsigned char*)a.ws; asm volatile("" : "+s"(ws)); int lane_ = F.lane; asm volatile("" : "+v"(lane_)); const int lane = lane_, r16 = lane & 15, g = lane >> 4;
    const bf16 *NEGW = (const bf16*)(ws + WS_ARENA + AR_NEGW), *KTT = (const bf16*)(ws + WS_ARENA + AR_KTT), *UT = (const bf16*)(ws + WS_ARENA + AR_UT); const float* dn = (const float*)(ws + WS_TOK + TOK_DN); bf16* SG = (bf16*)(ws + WS_ARENA + AR_SG);
    const int pw = F.wave >> 2, qf = F.wave & 3, c0 = 32 * qf;
    const LAS bf16* sw = (const LAS bf16*)F.lds + pw * GST_PAIR; const LAS bf16* sk = sw + GST_W; LAS bf16* Sl = (LAS bf16*)(F.lds + GST_BYTES + F.wave * GW_BYTES);
#pragma unroll 1
    for (int tp0 = 2 * F.vcu; tp0 < 512; tp0 += 2 * F.G) {
        const int tp = tp0 + pw; const bool on = tp < 512; const int tpc = on ? tp : 0, hh = tpc & 7, gq = tpc >> 3;
        const int tpa = tp0, tpb = (tp0 + 1 < 512) ? tp0 + 1 : 0;
        { const int u0 = hh * NCHUNK + 4 * gq;
#pragma unroll
          for (int q = 0; q < 8; ++q) { const int row = 4 * q + (lane >> 4), ch = lane & 15; const v4u v = *(const GAS v4u*)(SG + ((size_t)u0 * 128 + c0 + row) * 128 + ch * 8); *(LAS v4u*)(Sl + row * 136 + ch * 8) = v; } }
#pragma unroll 1
        for (int i = 0; i < 3; ++i) {
            __syncthreads();
            g_stage(F, NEGW, KTT, 0, 4 * (tpa >> 3) + i, tpa & 7, tpa < 512); g_stage(F, NEGW, KTT, 1, 4 * (tpb >> 3) + i, tpb & 7, tp0 + 1 < 512);
            const int n = 4 * gq + i, uh = hh * NCHUNK + n; const float di = *(const GAS float*)(dn + n * 8 + hh);
            f32x4 T[4][2];
#pragma unroll
            for (int mt = 0; mt < 4; ++mt)
#pragma unroll
                for (int nt = 0; nt < 2; ++nt) { const u32x2v uu = *(const GAS u32x2v*)(UT + ((size_t)(n * 8 + hh) * 128 + c0 + 16 * nt + r16) * 64 + 16 * mt + 4 * g); T[mt][nt] = (f32x4){bflo(uu.x), bfhi(uu.x), bflo(uu.y), bfhi(uu.y)}; }
            asm volatile("s_waitcnt lgkmcnt(0)" ::: "memory");
            bf16x8 Bf[4][2];
#pragma unroll
            for (int nt = 0; nt < 2; ++nt)
#pragma unroll
                for (int s = 0; s < 4; ++s) Bf[s][nt] = *(const LAS bf16x8*)(Sl + (16 * nt + r16) * 136 + 32 * s + 8 * g);
            f32x4 acc[8][2];
#pragma unroll
            for (int mt = 0; mt < 8; ++mt)
#pragma unroll
                for (int nt = 0; nt < 2; ++nt) { const u32x2v so = *(const LAS u32x2v*)(Sl + (16 * nt + r16) * 136 + 16 * mt + 4 * g); acc[mt][nt] = (f32x4){di * bflo(so.x), di * bfhi(so.x), di * bflo(so.y), di * bfhi(so.y)}; }
            __syncthreads();
            g_prod1<false>(T, sw, Bf, r16, g);
            g_prod2(acc, sk, T, r16, g);
            asm volatile("s_waitcnt lgkmcnt(0)" ::: "memory");
#pragma unroll
            for (int mt = 0; mt < 8; ++mt)
#pragma unroll
                for (int nt = 0; nt < 2; ++nt) { u32x2v o; o.x = cvtpk(acc[mt][nt][0], acc[mt][nt][1]); o.y = cvtpk(acc[mt][nt][2], acc[mt][nt][3]);
                    *(LAS u32x2v*)(Sl + (16 * nt + r16) * 136 + 16 * mt + 4 * g) = o;
                    if (on) *(GAS u32x2v*)(SG + ((size_t)(uh + 1) * 128 + c0 + 16 * nt + r16) * 128 + 16 * mt + 4 * g) = o; }
            asm volatile("s_waitcnt lgkmcnt(0)" ::: "memory");
        }
    }
    __syncthreads();
}

__device__ __forceinline__ void p_g3(const Frame& F, const Args& a, int L) {
    GAS unsigned char* ws = (GAS unsigned char*)a.ws; asm volatile("" : "+s"(ws)); int lane_ = F.lane; asm volatile("" : "+v"(lane_)); const int j = L >> 1, lane = lane_, r16 = lane & 15, g = lane >> 4;
    const bf16 *PO = (const bf16*)(ws + WS_ARENA + AR_PO), *QT = (const bf16*)(ws + WS_ARENA + AR_QT), *AI = (const bf16*)(ws + WS_ARENA + AR_AI), *NEGW = (const bf16*)(ws + WS_ARENA + AR_NEGW),
               *UT = (const bf16*)(ws + WS_ARENA + AR_UT), *SG = (const bf16*)(ws + WS_ARENA + AR_SG);
    bf16* mix = (bf16*)(ws + WS_MIX); const float* onorm = (const float*)a.in[19] + j * 128;
    const f32x4 Z4 = {0.f, 0.f, 0.f, 0.f};
#pragma unroll 1
    for (int tp_ = 2 * F.vcu + (F.wave >> 2); tp_ < 512; tp_ += 2 * F.G) {
        const int u = (4 * (tp_ >> 3) + (F.wave & 3)) * 8 + (tp_ & 7);
        const int n = u >> 3, hh = u & 7, tok0 = 64 * n; const int uh = hh * NCHUNK + n;
        unsigned vn[8][4][2];
        {
            bf16x8 nw[4][4];
#pragma unroll
            for (int jt = 0; jt < 4; ++jt)
#pragma unroll
                for (int kk = 0; kk < 4; ++kk) nw[jt][kk] = ld16g(NEGW + (size_t)(tok0 + 16 * jt + r16) * D_ + hh * 128 + 32 * kk + 8 * g);
#pragma unroll
            for (int d2t = 0; d2t < 8; ++d2t) {
                bf16x8 sg[4];
#pragma unroll
                for (int kk = 0; kk < 4; ++kk) sg[kk] = ld16g(SG + ((size_t)uh * 128 + 16 * d2t + r16) * 128 + 32 * kk + 8 * g);
#pragma unroll
                for (int jt = 0; jt < 4; ++jt) {
                    const u32x2v c = *(const GAS u32x2v*)(UT + ((size_t)u * 128 + 16 * d2t + r16) * 64 + 16 * jt + 4 * g);
                    f32x4 Dv = {bflo(c.x), bfhi(c.x), bflo(c.y), bfhi(c.y)};
#pragma unroll
                    for (int kk = 0; kk < 4; ++kk) Dv = MF16(nw[jt][kk], sg[kk], Dv);
                    vn[d2t][jt][0] = cvtpk(Dv[0], Dv[1]); vn[d2t][jt][1] = cvtpk(Dv[2], Dv[3]);
                    asm volatile("" : "+v"(vn[d2t][jt][0]), "+v"(vn[d2t][jt][1]));
                }
                asm volatile("" ::: "memory");
            }
        }
#pragma unroll 1
        for (int ti = 0; ti < 4; ++ti) {
            const int tok = tok0 + 16 * ti + r16;
            bf16x8 qf[4], af[2];
#pragma unroll
            for (int kk = 0; kk < 4; ++kk) qf[kk] = ld16g(QT + (size_t)tok * D_ + hh * 128 + 32 * kk + 8 * g);
#pragma unroll
            for (int k2 = 0; k2 < 2; ++k2) { const u32x2v lo = *(const GAS u32x2v*)(AI + ((size_t)u * 64 + 16 * ti + r16) * 64 + 32 * k2 + 4 * g), hi = *(const GAS u32x2v*)(AI + ((size_t)u * 64 + 16 * ti + r16) * 64 + 32 * k2 + 16 + 4 * g);
                const v4u pk = {lo.x, lo.y, hi.x, hi.y}; af[k2] = __builtin_bit_cast(bf16x8, pk); }
            f32x4 acc[8]; float ss = 0.f;
#pragma unroll
            for (int d2t = 0; d2t < 8; ++d2t) {
                f32x4 Dv = Z4;
#pragma unroll
                for (int kk = 0; kk < 4; ++kk) { const bf16x8 sgf = ld16g(SG + ((size_t)uh * 128 + 16 * d2t + r16) * 128 + 32 * kk + 8 * g); Dv = MF16(sgf, qf[kk], Dv); }
#pragma unroll
                for (int k2 = 0; k2 < 2; ++k2) { const v4u pk = {vn[d2t][2 * k2][0], vn[d2t][2 * k2][1], vn[d2t][2 * k2 + 1][0], vn[d2t][2 * k2 + 1][1]}; Dv = MF16(__builtin_bit_cast(bf16x8, pk), af[k2], Dv); }
                acc[d2t] = Dv; ss += (Dv[0] * Dv[0] + Dv[1] * Dv[1]) + (Dv[2] * Dv[2] + Dv[3] * Dv[3]);
            }
            ss += __shfl_xor(ss, 16); ss += __shfl_xor(ss, 32);
            const float rms = __builtin_amdgcn_rsqf(ss * (1.0f / 128.0f) + RMS_EPS);
#pragma unroll
            for (int d2t = 0; d2t < 8; ++d2t) {
                const u32x2v z = *(const GAS u32x2v*)(PO + (size_t)tok * OIN + 3072 + hh * 128 + 16 * d2t + 4 * g); const f32x4 gn = *(const GAS f32x4*)(onorm + 16 * d2t + 4 * g);
                st8(mix + (size_t)tok * D_ + hh * 128 + 16 * d2t + 4 * g, acc[d2t][0] * rms * gn[0] * silu(bflo(z.x)), acc[d2t][1] * rms * gn[1] * silu(bfhi(z.x)),
                    acc[d2t][2] * rms * gn[2] * silu(bflo(z.y)), acc[d2t][3] * rms * gn[3] * silu(bfhi(z.y)));
            }
        }
    }
}

__device__ __forceinline__ void p_r1(const Frame& F, const Args& a, int L) {
    GAS unsigned char* ws = (GAS unsigned char*)a.ws; asm volatile("" : "+s"(ws)); int lane_ = F.lane; asm volatile("" : "+v"(lane_)); const int j = L >> 1, lane = lane_;
    const float* ssq = (const float*)(ws + WS_SSQA); const float* wr = (const float*)a.in[24] + (size_t)j * D_ * NEXP; const float* ln = (const float*)a.in[4] + L * D_;
    int* tok_e = (int*)(ws + WS_TOK + TOK_E); int* tok_r = (int*)(ws + WS_TOK + TOK_R); float* tok_g = (float*)(ws + WS_TOK + TOK_G);
    unsigned* gcount = (unsigned*)(ws + WS_CTL) + CW_CNT + 64 * j;
    LAS int* rt = (LAS int*)(F.lds + RT_OFF);
    if (F.tid < 16) rt[F.tid] = 0;
    __syncthreads();
    const GAS float* hG = (const GAS float*)a.out; const GAS float* wrG = (const GAS float*)wr; const GAS float* lnG = (const GAS float*)ln;
    float lnr[16];
#pragma unroll
    for (int i = 0; i < 16; ++i) lnr[i] = lnG[64 * i + lane];
#pragma unroll 1
    for (int t = F.gw; t < S_; t += 2 * F.NGW) {
        const int tb = t + F.NGW; const bool hasb = tb < S_; const int tbc = hasb ? tb : t;
        float xa[16], xb[16];
#pragma unroll
        for (int i = 0; i < 16; ++i) { xa[i] = hG[(size_t)t * D_ + 64 * i + lane]; xb[i] = hG[(size_t)tbc * D_ + 64 * i + lane]; }
        const float rsa = pg8::rstd_row(ssq, t), rsb = pg8::rstd_row(ssq, tbc);
        float acca[8], accb[8];
#pragma unroll
        for (int e = 0; e < 8; ++e) { acca[e] = 0.f; accb[e] = 0.f; }
#pragma unroll
        for (int i = 0; i < 16; ++i) { const int k = 64 * i + lane; const f32x4 w0 = *(const GAS f32x4*)(wrG + (size_t)k * 8), w1 = *(const GAS f32x4*)(wrG + (size_t)k * 8 + 4);
            const float x = xa[i] * lnr[i], y = xb[i] * lnr[i];
            acca[0] += x * w0[0]; acca[1] += x * w0[1]; acca[2] += x * w0[2]; acca[3] += x * w0[3]; acca[4] += x * w1[0]; acca[5] += x * w1[1]; acca[6] += x * w1[2]; acca[7] += x * w1[3];
            accb[0] += y * w0[0]; accb[1] += y * w0[1]; accb[2] += y * w0[2]; accb[3] += y * w0[3]; accb[4] += y * w1[0]; accb[5] += y * w1[1]; accb[6] += y * w1[2]; accb[7] += y * w1[3]; }
#pragma unroll
        for (int e = 0; e < 8; ++e) { acca[e] = wave_sum(acca[e]) * rsa; accb[e] = wave_sum(accb[e]) * rsb; }
#pragma unroll
        for (int half = 0; half < 2; ++half) {
            if (half == 1 && !hasb) break;
            const int tt = half ? tb : t; float acc[8];
#pragma unroll
            for (int e = 0; e < 8; ++e) acc[e] = half ? accb[e] : acca[e];
            int e0 = 0; float l0 = acc[0];
#pragma unroll
            for (int e = 1; e < 8; ++e) if (acc[e] > l0) { l0 = acc[e]; e0 = e; }
            int e1 = -1; float l1 = -INFINITY;
#pragma unroll
            for (int e = 0; e < 8; ++e) if (e != e0 && acc[e] > l1) { l1 = acc[e]; e1 = e; }
            const float g1 = 1.0f / (1.0f + expf(l0 - l1)), g0 = 1.0f - g1;
            if (lane == 0) {
                const int r0 = __hip_atomic_fetch_add(rt + e0, 1, __ATOMIC_RELAXED, __HIP_MEMORY_SCOPE_WORKGROUP), r1 = __hip_atomic_fetch_add(rt + e1, 1, __ATOMIC_RELAXED, __HIP_MEMORY_SCOPE_WORKGROUP);
                tok_e[2 * tt] = e0; tok_e[2 * tt + 1] = e1; tok_r[2 * tt] = r0; tok_r[2 * tt + 1] = r1; tok_g[2 * tt] = g0; tok_g[2 * tt + 1] = g1;
            }
        }
    }
    __syncthreads();
    if (F.tid < 8) rt[8 + F.tid] = (int)__hip_atomic_fetch_add(gcount + F.tid, (unsigned)rt[F.tid], __ATOMIC_RELAXED, __HIP_MEMORY_SCOPE_AGENT);
    __syncthreads();
#pragma unroll 1
    for (int t = F.gw; t < S_; t += F.NGW) if (lane < 2) { const int e = tok_e[2 * t + lane]; tok_r[2 * t + lane] += rt[8 + e]; }
    __syncthreads();
}
__device__ __forceinline__ int moe_pstart(const unsigned* gcount, int e) {
    int ps = 0;
#pragma unroll
    for (int q = 0; q < 8; ++q) { const int c = (int)gcount[q]; if (q < e) ps += ((c + 255) >> 8) << 8; }
    return ps;
}
__device__ __forceinline__ void p_r2(const Frame& F, const Args& a, int L) {
    GAS unsigned char* ws = (GAS unsigned char*)a.ws; asm volatile("" : "+s"(ws)); int lane_ = F.lane; asm volatile("" : "+v"(lane_)); const int j = L >> 1, lane = lane_;
    const float* ssq = (const float*)(ws + WS_SSQA);
    const int* tok_e = (const int*)(ws + WS_TOK + TOK_E); const int* tok_r = (const int*)(ws + WS_TOK + TOK_R); const float* tok_g = (const float*)(ws + WS_TOK + TOK_G);
    int* dst = (int*)(ws + WS_TOK + TOK_DST); float* gpad = (float*)(ws + WS_TOK + TOK_GPAD);
    const unsigned* gcount = (const unsigned*)(ws + WS_CTL) + CW_CNT + 64 * j; bf16* XS = (bf16*)(ws + WS_ARENA + AR_XS);
    int pst[8]; { int ps = 0;
#pragma unroll
        for (int q = 0; q < 8; ++q) { pst[q] = ps; ps += (((int)gcount[q] + 255) >> 8) << 8; } }
    const GAS float* hG = (const GAS float*)a.out;
#pragma unroll 1
    for (int t0 = F.gw; t0 < S_; t0 += 4 * F.NGW) {
        int tt[4], da[4], db[4]; float rs[4], ga[4], gb[4]; f32x4 v[4][4];
#pragma unroll
        for (int u = 0; u < 4; ++u) { const int t = t0 + u * F.NGW; tt[u] = t < S_ ? t : t0;
#pragma unroll
            for (int q = 0; q < 4; ++q) v[u][q] = *((const GAS f32x4*)(hG + (size_t)tt[u] * D_) + 64 * q + lane); }
#pragma unroll
        for (int u = 0; u < 4; ++u) { const int t = tt[u]; rs[u] = pg8::rstd_row(ssq, t);
            const int ea = tok_e[2 * t], eb = tok_e[2 * t + 1]; int pa = 0, pb = 0;
#pragma unroll
            for (int q = 0; q < 8; ++q) { pa = (q == ea) ? pst[q] : pa; pb = (q == eb) ? pst[q] : pb; }
            da[u] = pa + tok_r[2 * t]; db[u] = pb + tok_r[2 * t + 1]; ga[u] = tok_g[2 * t]; gb[u] = tok_g[2 * t + 1]; }
#pragma unroll
        for (int u = 0; u < 4; ++u) { if (t0 + u * F.NGW >= S_) break; const int t = tt[u];
            if (lane == 0) { dst[2 * t] = da[u]; dst[2 * t + 1] = db[u]; gpad[da[u]] = ga[u]; gpad[db[u]] = gb[u]; }
#pragma unroll
            for (int q = 0; q < 4; ++q) { const f32x4 x = v[u][q] * rs[u]; u32x2v o; o.x = cvtpk(x[0], x[1]); o.y = cvtpk(x[2], x[3]);
                *((GAS u32x2v*)(XS + (size_t)da[u] * D_) + 64 * q + lane) = o; *((GAS u32x2v*)(XS + (size_t)db[u] * D_) + 64 * q + lane) = o; } }
    }
}
__device__ __forceinline__ int moe_blocks(const Frame& F, const Args& a, int L) {
    const unsigned* gcount = (const unsigned*)(a.ws + WS_CTL) + CW_CNT + 64 * (L >> 1);
    LAS int* blk = (LAS int*)(F.lds + BLKE_OFF);
    int nb_tot = 0, mine = 7;
#pragma unroll
    for (int q = 0; q < 8; ++q) { const int nb = ((int)gcount[q] + 255) >> 8; if (F.tid >= nb_tot && F.tid < nb_tot + nb) mine = q; nb_tot += nb; }
    __syncthreads();
    if (F.tid < 160) blk[F.tid] = mine;
    __syncthreads();
    return nb_tot;
}
__device__ __forceinline__ void p_combine(const Frame& F, const Args& a) {
    GAS unsigned char* ws = (GAS unsigned char*)a.ws; asm volatile("" : "+s"(ws)); int lane_ = F.lane; asm volatile("" : "+v"(lane_)); const int lane = lane_;
    const int* dst = (const int*)(ws + WS_TOK + TOK_DST); const bf16* Y = (const bf16*)(ws + WS_ARENA + AR_Y); bf16* hb = (bf16*)(ws + WS_HBF); float* ssq = (float*)(ws + WS_SSQA);
    const GAS float* hG = (const GAS float*)a.out;
#pragma unroll 1
    for (int t0 = F.gw; t0 < S_; t0 += 2 * F.NGW) {
        int tt[2], da[2], db[2]; f32x4 v[2][4]; u32x2v ya[2][4], yb[2][4];
#pragma unroll
        for (int u = 0; u < 2; ++u) { const int t = t0 + u * F.NGW; tt[u] = t < S_ ? t : t0; da[u] = dst[2 * tt[u]]; db[u] = dst[2 * tt[u] + 1];
#pragma unroll
            for (int q = 0; q < 4; ++q) v[u][q] = *((const GAS f32x4*)(hG + (size_t)tt[u] * D_) + 64 * q + lane); }
#pragma unroll
        for (int u = 0; u < 2; ++u)
#pragma unroll
            for (int q = 0; q < 4; ++q) { ya[u][q] = *((const GAS u32x2v*)(Y + (size_t)da[u] * D_) + 64 * q + lane); yb[u][q] = *((const GAS u32x2v*)(Y + (size_t)db[u] * D_) + 64 * q + lane); }
#pragma unroll
        for (int u = 0; u < 2; ++u) { if (t0 + u * F.NGW >= S_) break; const int t = tt[u]; float ss = 0.f;
#pragma unroll
            for (int q = 0; q < 4; ++q) { f32x4 x = v[u][q];
                x[0] += bflo(ya[u][q].x) + bflo(yb[u][q].x); x[1] += bfhi(ya[u][q].x) + bfhi(yb[u][q].x); x[2] += bflo(ya[u][q].y) + bflo(yb[u][q].y); x[3] += bfhi(ya[u][q].y) + bfhi(yb[u][q].y);
                *((GAS f32x4*)(a.out + (size_t)t * D_) + 64 * q + lane) = x; ss += (x[0] * x[0] + x[1] * x[1]) + (x[2] * x[2] + x[3] * x[3]);
                u32x2v o; o.x = cvtpk(x[0], x[1]); o.y = cvtpk(x[2], x[3]); *((GAS u32x2v*)(hb + (size_t)t * D_) + 64 * q + lane) = o; }
            ss = wave_sum(ss);
            if (lane < 16) ssq[(size_t)t * 16 + lane] = (lane == 0) ? ss : 0.f; }
    }
}
__device__ __forceinline__ void p_final(const Frame& F, const Args& a) {
    GAS unsigned char* ws = (GAS unsigned char*)a.ws; asm volatile("" : "+s"(ws)); int lane_ = F.lane; asm volatile("" : "+v"(lane_)); const int lane = lane_; const float* ssq = (const float*)(ws + WS_SSQB); const float* ln = (const float*)a.in[6];
#pragma unroll 1
    for (int t = F.gw; t < S_; t += F.NGW) { const float rs = pg8::rstd_row(ssq, t);
#pragma unroll
        for (int q = 0; q < 4; ++q) { GAS f32x4* hp = (GAS f32x4*)(a.out + (size_t)t * D_) + 64 * q + lane; const f32x4 gq = *((const GAS f32x4*)ln + 64 * q + lane); *hp = (*hp) * rs * gq; } }
}
__device__ __forceinline__ void p_moe_weights(const Frame& F, const Args& a, int L, int w0, int nw) {
    LAS float* scr = (LAS float*)(F.lds + F.wave * WAVE_LDS);
    int base = 0;
#pragma unroll 1
    for (int id = 0; id < 24; ++id) { const MatD m = moe_mat(a, L >> 1, id);
        int first = (w0 - base) % nw; if (first < 0) first += nw;
#pragma unroll 1
        for (int it = first; it < m.items; it += nw) xpose_item(m.W, m.ldw, m.K, m.N, m.gain, m.WT, m.ilv, scr, it, F.lane);
        base += m.items; }
}

constexpr int P_PRO = 0, P_FINAL = 81, LP_ROT = 16, LP_G1B = 17, LP_G2B = 18, LPN = 20, LP_PROJ = 0, LP_ATT = 1, LP_MIXPREP = 2, LP_GA = 3, LP_G1 = 4, LP_G2 = 5, LP_G3 = 6, LP_OUT = 7, LP_UP = 8, LP_DOWN = 9, LP_R1 = 10, LP_R2 = 11, LP_M1 = 12, LP_M2 = 13, LP_COMB = 14, LP_PLE = 15;

#ifndef PH_MASK
#define PH_MASK 0xffffffffull
#endif
#define IN(k) (lo <= (k) && (k) < hi)
#define INL(lp) ((((unsigned long long)(PH_MASK) >> (lp)) & 1) && lo <= pb + (lp) && pb + (lp) < hi)
#define SEAM() do { if (args.use_bar) xcd_barrier(bar); } while (0)
#ifndef REP_LP
#define REP_LP -1
#endif
#ifndef REP_L
#define REP_L -1
#endif
#ifndef REP_N
#define REP_N 2
#endif
#define REPS(lp) ((L == (REP_L) && (lp) == (REP_LP)) ? 1 + (REP_N) : 1)
#if REP_LP >= 0
#define REPLOOP(lp) _Pragma("unroll 1") for (int rep_ = 0; rep_ < REPS(lp); ++rep_)
#else
#define REPLOOP(lp)
#endif
#define PHASE_WS() GAS unsigned char* ws = (GAS unsigned char*)ws0; asm volatile("" : "+s"(ws)); bf16* HBF = (bf16*)(ws + WS_HBF); bf16* MIX = (bf16*)(ws + WS_MIX); bf16* PP = (bf16*)(ws + WS_PP); float* SSQA = (float*)(ws + WS_SSQA); float* SSQB = (float*)(ws + WS_SSQB); (void)HBF; (void)MIX; (void)PP; (void)SSQA; (void)SSQB
template <int L> __device__ __forceinline__ void run_layer(const Frame& F, const Args& args, unsigned char* lds, const XcdBarrier& bar, unsigned char* ws0, const int lo, const int hi, const int cid) {
        const int pb = 1 + LPN * L, j = L >> 1; const bool odd = (L & 1) != 0;
        REPLOOP(LP_PROJ) if (INL(LP_PROJ)) { PHASE_WS();
            if (!odd) {
                pg8::Gemm gm{HBF, (const bf16*)(ws + WS_WINE) + (size_t)j * EIN * D_, S_, EIN, D_, 0}; pg8::StaticOrder So; So.init(S_, EIN, F.G, cid);
                pg8::EpiBf16 E{(bf16*)(ws + WS_ARENA + AR_PE), EIN, SSQB, pg8::C2, 512};
                pg8::gemm_phase<pg8::EpiBf16, pg8::StaticOrder, true, true>(F.lds + RING_OFF, gm, So, E);
            } else {
                pg8::Gemm gm{HBF, (const bf16*)(ws + WS_WINO) + (size_t)j * OIN * D_, S_, OIN, D_, 0}; pg8::StaticOrder So; So.init(S_, OIN, F.G, cid);
                pg8::EpiBf16 E{(bf16*)(ws + WS_ARENA + AR_PO), OIN, SSQB, 1.0f, 0};
                pg8::gemm_phase<pg8::EpiBf16, pg8::StaticOrder, true, true>(F.lds + RING_OFF, gm, So, E);
            }
            {
                pg8::Gemm gm{(const bf16*)(ws + WS_PBF) + (size_t)L * S_ * PLE, (const bf16*)(ws + WS_WP) + (size_t)L * D_ * PLE, S_, D_, PLE, 0}; pg8::StaticOrder So; So.init(S_, D_, F.G, cid);
                pg8::EpiBf16 E{PP, D_, nullptr, 1.0f, 0};
                pg8::gemm_phase<pg8::EpiBf16, pg8::StaticOrder, true, true>(F.lds + RING_OFF, gm, So, E);
            }
            if (odd) p_ab(F, args, L);
            SEAM();
        }
        if (!odd) {
            REPLOOP(LP_ROT) if (INL(LP_ROT)) { PHASE_WS(); p_rot(F, args); SEAM(); }
            REPLOOP(LP_ATT) if (INL(LP_ATT)) { PHASE_WS(); attn_body::attn_phase<8>((char*)lds + RING_OFF, (const attn_body::bf16*)(ws + WS_ARENA + AR_PE), (attn_body::bf16*)(ws + WS_ARENA + AR_AO), F.vcu, F.G); SEAM(); }
            REPLOOP(LP_MIXPREP) if (INL(LP_MIXPREP)) { PHASE_WS(); p_mixprep(F, args, L); SEAM(); }
        } else {
            REPLOOP(LP_GA) if (INL(LP_GA)) { PHASE_WS();
#ifdef PROBE_GSEL
                const int gsel = args.use_bar ? 7 : PROBE_GSEL;
#else
                const int gsel = 7;
#endif
                if (gsel & 1) p_ga(F, args, L); asm volatile("s_waitcnt vmcnt(0)" ::: "memory"); __syncthreads(); if (gsel & 2) p_g1(F, args); asm volatile("s_waitcnt vmcnt(0)" ::: "memory"); __syncthreads(); if (gsel & 4) p_g1b(F, args); SEAM(); }
            REPLOOP(LP_G2) if (INL(LP_G2)) { PHASE_WS();
                const int nscan = F.G < 64 ? F.G : 64;
#ifdef PROBE_NOCONV
                if (!args.use_bar) { if (F.vcu < nscan) p_g2<64, 4>(F, args, (const bf16*)(ws + WS_ARENA + AR_MPC), (const bf16*)(ws + WS_ARENA + AR_NTC), (const float*)(ws + WS_TOK + TOK_DNC)); } else
#endif
#ifdef PROBE_NOSCAN
                if (!args.use_bar) { if (F.vcu >= nscan) p_moe_weights(F, args, L, (F.vcu - nscan) * NWAVES + F.wave, (F.G - nscan) * NWAVES); } else
#endif
                if (F.vcu < nscan) p_g2<64, 4>(F, args, (const bf16*)(ws + WS_ARENA + AR_MPC), (const bf16*)(ws + WS_ARENA + AR_NTC), (const float*)(ws + WS_TOK + TOK_DNC));
                else p_moe_weights(F, args, L, (F.vcu - nscan) * NWAVES + F.wave, (F.G - nscan) * NWAVES);
                if (F.G <= 64) p_moe_weights(F, args, L, F.gw, F.NGW);
                SEAM();
            }
            REPLOOP(LP_G3) if (INL(LP_G3)) { PHASE_WS(); p_g2b(F, args); asm volatile("s_waitcnt vmcnt(0)" ::: "memory"); __syncthreads(); p_g3(F, args, L); SEAM(); }
        }
        REPLOOP(LP_OUT) if (INL(LP_OUT)) { PHASE_WS();
            const bf16* Wo = odd ? (const bf16*)(ws + WS_WOUTO) + (size_t)j * D_ * D_ : (const bf16*)(ws + WS_WOUTE) + (size_t)j * D_ * D_;
            pg8::Gemm gm{MIX, Wo, S_, D_, D_, 0}; pg8::StaticOrder So; So.init(S_, D_, F.G, cid);
            pg8::EpiResid E{args.out, HBF, SSQA};
            pg8::gemm_phase<pg8::EpiResid, pg8::StaticOrder, true, true>(F.lds + RING_OFF, gm, So, E);
            SEAM();
        }
        if (!odd) {
            REPLOOP(LP_UP) if (INL(LP_UP)) { PHASE_WS();
                pg8::Gemm gm{HBF, (const bf16*)(ws + WS_W13D) + (size_t)j * 2 * DFF * D_, S_, 2 * DFF, D_, 0}; pg8::StaticOrder So; So.init(S_, 2 * DFF, F.G, cid);
                pg8::EpiSwiglu E{(bf16*)(ws + WS_ARENA + AR_ACT), SSQA};
                pg8::gemm_phase<pg8::EpiSwiglu, pg8::StaticOrder, true, true>(F.lds + RING_OFF, gm, So, E);
                SEAM();
            }
            REPLOOP(LP_DOWN) if (INL(LP_DOWN)) { PHASE_WS();
                pg8::Gemm gm{(const bf16*)(ws + WS_ARENA + AR_ACT), (const bf16*)(ws + WS_W2D) + (size_t)j * D_ * DFF, S_, D_, DFF, 0}; pg8::StaticOrder So; So.init(S_, D_, F.G, cid);
                pg8::EpiResid E{args.out, HBF, SSQA};
                pg8::gemm_phase<pg8::EpiResid, pg8::StaticOrder, true, true>(F.lds + RING_OFF, gm, So, E);
                SEAM();
            }
        } else {
            REPLOOP(LP_R1) if (INL(LP_R1)) { PHASE_WS(); p_r1(F, args, L); SEAM(); }
            REPLOOP(LP_R2) if (INL(LP_R2)) { PHASE_WS(); p_r2(F, args, L); SEAM(); }
            REPLOOP(LP_M1) if (INL(LP_M1)) { PHASE_WS();
                const int nb = moe_blocks(F, args, L);
                pg8::Gemm gm{(const bf16*)(ws + WS_ARENA + AR_XS), (const bf16*)(ws + WS_W13M), nb * 256, 2 * DFF, D_, (size_t)2 * DFF * D_ * 2}; pg8::MoeOrder So; So.init(nb * 256, 2 * DFF, F.G, cid); So.blk_e = (const LAS int*)(F.lds + BLKE_OFF);
                pg8::EpiSwiglu E{(bf16*)(ws + WS_ARENA + AR_ACT), nullptr};
                pg8::gemm_phase<pg8::EpiSwiglu, pg8::MoeOrder, true, true>(F.lds + RING_OFF, gm, So, E);
                SEAM();
            }
            REPLOOP(LP_M2) if (INL(LP_M2)) { PHASE_WS();
                const int nb = moe_blocks(F, args, L);
                pg8::Gemm gm{(const bf16*)(ws + WS_ARENA + AR_ACT), (const bf16*)(ws + WS_W2M), nb * 256, D_, DFF, (size_t)D_ * DFF * 2}; pg8::MoeOrder So; So.init(nb * 256, D_, F.G, cid); So.blk_e = (const LAS int*)(F.lds + BLKE_OFF);
                pg8::EpiMoeDown E{(bf16*)(ws + WS_ARENA + AR_Y), (const float*)(ws + WS_TOK + TOK_GPAD)};
                pg8::gemm_phase<pg8::EpiMoeDown, pg8::MoeOrder, true, true>(F.lds + RING_OFF, gm, So, E);
                SEAM();
            }
            REPLOOP(LP_COMB) if (INL(LP_COMB)) { PHASE_WS(); p_combine(F, args); SEAM(); }
        }
        REPLOOP(LP_PLE) if (INL(LP_PLE)) { PHASE_WS();
            pg8::Gemm gm{HBF, (const bf16*)(ws + WS_WG) + (size_t)L * D_ * D_, S_, D_, D_, 0}; pg8::StaticOrder So; So.init(S_, D_, F.G, cid);
            pg8::EpiPle E{args.out, HBF, SSQA, SSQB, PP};
            pg8::gemm_phase<pg8::EpiPle, pg8::StaticOrder, true, true>(F.lds + RING_OFF, gm, So, E);
            SEAM();
        }
    }

__global__ void __launch_bounds__(NWAVES * 64, 2) fwd(Args args) {
    extern __shared__ __attribute__((aligned(16))) unsigned char lds[];
    Frame F;
    F.lds = (LAS unsigned char*)lds; F.tid = threadIdx.x; F.lane = F.tid & 63; F.wave = __builtin_amdgcn_readfirstlane(F.tid >> 6);
    F.G = gridDim.x; { const int bx = blockIdx.x; F.vcu = (F.G % 8 == 0) ? (bx % 8) * (F.G / 8) + bx / 8 : bx; }
    F.gw = F.vcu * NWAVES + F.wave; F.NGW = F.G * NWAVES;
    unsigned char* ws0 = args.ws;
    for (int u = F.tid; u < (LDS_BYTES - LDSCTL_OFF) / 4; u += NWAVES * 64) ((LAS unsigned*)(F.lds + LDSCTL_OFF))[u] = 0u;
    __syncthreads();
    XcdBarrier bar; bar.bar = (unsigned*)(ws0 + WS_CTL) + CW_BAR; bar.x = 0; bar.st = nullptr;
    if (args.use_bar) bar = xcd_barrier_post((unsigned*)(ws0 + WS_CTL) + CW_BAR, (volatile LAS unsigned*)(F.lds + MISC_OFF));
    const int lo = args.ph_lo, hi = args.ph_hi;
    const int cid = (int)blockIdx.x;

    if ((((unsigned long long)(PH_MASK) >> 30) & 1) && IN(P_PRO)) { p_prologue(F, args); SEAM(); }

#ifdef FIXED_L
    run_layer<FIXED_L>(F, args, lds, bar, ws0, lo, hi, cid);
#else
    run_layer<0>(F, args, lds, bar, ws0, lo, hi, cid); run_layer<1>(F, args, lds, bar, ws0, lo, hi, cid); run_layer<2>(F, args, lds, bar, ws0, lo, hi, cid); run_layer<3>(F, args, lds, bar, ws0, lo, hi, cid);
#endif
    if ((((unsigned long long)(PH_MASK) >> 31) & 1) && IN(P_FINAL)) p_final(F, args);
#undef IN
#undef INL
#undef SEAM
}


#ifndef DBG
#define DBG 0
#endif
#if DBG
#ifndef DBG_ASLOT
#define DBG_ASLOT 9
#endif
#ifndef DBG_BSLOT
#define DBG_BSLOT 11
#endif
__global__ void dbg_scan(const void* p, size_t n, int is_f32, unsigned* slot) {
    unsigned cnt = 0;
    for (size_t i = (size_t)blockIdx.x * blockDim.x + threadIdx.x; i < n; i += (size_t)gridDim.x * blockDim.x) {
        const float v = is_f32 ? ((const float*)p)[i] : __uint_as_float(((unsigned)((const unsigned short*)p)[i]) << 16);
        if (!(fabsf(v) < 1e30f)) ++cnt; }
    if (cnt) atomicAdd(slot, cnt);
}
__global__ void dbg_fill(float* out, size_t n, const unsigned* slots, int nslots) {
    int first = -1; for (int i = 0; i < nslots; ++i) if (slots[i]) { first = i; break; }
    float c, V;
    if (first >= 0) { c = sqrtf((float)(10 + first) * 1e6f); V = c; }
    else { const float ea = fmaxf(__uint_as_float(slots[256 + DBG_ASLOT]), 1e-5f), eb = fmaxf(__uint_as_float(slots[256 + DBG_BSLOT]), 1e-5f);
        c = sqrtf((10.f + fminf(60.f, rintf(10.f * (log10f(ea) + 5.f)))) * 1e4f); V = (50.f + rintf(10.f * log10f(eb))) * 1e3f; }
    for (size_t i = (size_t)blockIdx.x * blockDim.x + threadIdx.x; i < n; i += (size_t)gridDim.x * blockDim.x) out[i] = (i == 0) ? V : c;
}
__device__ __forceinline__ float dbg_bf(const unsigned short* p, size_t i) { return __uint_as_float(((unsigned)p[i]) << 16); }
__device__ __forceinline__ float dbg_rstd(const float* ssq, int row) { float s = 0.f; for (int i = 0; i < 16; ++i) s += ssq[(size_t)row * 16 + i]; return 1.0f / sqrtf(s / 1024.0f + 1e-6f); }
__device__ __forceinline__ float dbg_blocksum(float v, float* red) {
    __syncthreads(); red[threadIdx.x] = v; __syncthreads();
    for (int o = 128; o > 0; o >>= 1) { if ((int)threadIdx.x < o) red[threadIdx.x] += red[threadIdx.x + o]; __syncthreads(); }
    const float r = red[0]; __syncthreads(); return r;
}
__device__ __forceinline__ void dbg_report(unsigned* slot, float num, float den) { if (threadIdx.x == 0) atomicMax(slot, __float_as_uint(sqrtf(num / fmaxf(den, 1e-20f)))); }
__global__ void chk_ffn(const float* hpre, const float* hpost, const float* ssq, const float* ln, const float* wr, const float* w1, const float* w3, const float* w2, int moe, unsigned* slot) {
    __shared__ float xn[1024]; __shared__ float hid[3584]; __shared__ float red[256]; __shared__ float lg[8];
    const int t = (blockIdx.x * 997 + 13) % S_, tid = threadIdx.x;
    const float rs = dbg_rstd(ssq, t);
    for (int k = tid; k < 1024; k += 256) xn[k] = hpre[(size_t)t * 1024 + k] * rs * ln[k];
    __syncthreads();
    int e0 = 0, e1 = 0; float g0 = 1.f, g1 = 0.f;
    if (moe) {
        if (tid < 8) { float s = 0.f; for (int k = 0; k < 1024; ++k) s += xn[k] * wr[(size_t)k * 8 + tid]; lg[tid] = s; }
        __syncthreads();
        float l0 = lg[0]; for (int e = 1; e < 8; ++e) if (lg[e] > l0) { l0 = lg[e]; e0 = e; }
        float l1 = -1e30f; e1 = -1; for (int e = 0; e < 8; ++e) if (e != e0 && lg[e] > l1) { l1 = lg[e]; e1 = e; }
        const float m0 = expf(l0 - l0), m1 = expf(l1 - l0); g0 = m0 / (m0 + m1); g1 = m1 / (m0 + m1);
    }
    float acc[4] = {0.f, 0.f, 0.f, 0.f};
    for (int pass = 0; pass < (moe ? 2 : 1); ++pass) {
        const int e = pass == 0 ? e0 : e1; const float gt = pass == 0 ? g0 : g1;
        const float* W1 = w1 + (size_t)e * 1024 * 3584; const float* W3 = w3 + (size_t)e * 1024 * 3584; const float* W2 = w2 + (size_t)e * 3584 * 1024;
        __syncthreads();
        for (int f = tid; f < 3584; f += 256) { float a = 0.f, b = 0.f; for (int k = 0; k < 1024; ++k) { a += xn[k] * W1[(size_t)k * 3584 + f]; b += xn[k] * W3[(size_t)k * 3584 + f]; } hid[f] = a / (1.f + expf(-a)) * b; }
        __syncthreads();
        for (int q = 0; q < 4; ++q) { const int c = tid + 256 * q; float y = 0.f; for (int f = 0; f < 3584; ++f) y += hid[f] * W2[(size_t)f * 1024 + c]; acc[q] += gt * y; }
    }
    float num = 0.f, den = 0.f;
    for (int q = 0; q < 4; ++q) { const int c = tid + 256 * q; const float ex = acc[q], got = hpost[(size_t)t * 1024 + c] - hpre[(size_t)t * 1024 + c]; num += (got - ex) * (got - ex); den += ex * ex; }
    num = dbg_blocksum(num, red); den = dbg_blocksum(den, red);
    dbg_report(slot, num, den);
}
__global__ void chk_ple(const float* hpre, const float* hpost, const float* ssq, const float* ln, const float* wg, const float* p, const float* wp, unsigned* slot) {
    __shared__ float xn[1024]; __shared__ float red[256];
    const int t = (blockIdx.x * 997 + 13) % S_, tid = threadIdx.x; const float rs = dbg_rstd(ssq, t);
    for (int k = tid; k < 1024; k += 256) xn[k] = hpre[(size_t)t * 1024 + k] * rs * ln[k];
    __syncthreads();
    float num = 0.f, den = 0.f;
    for (int q = 0; q < 4; ++q) { const int c = tid + 256 * q; float a = 0.f, b = 0.f; for (int k = 0; k < 1024; ++k) a += xn[k] * wg[(size_t)k * 1024 + c]; for (int k = 0; k < 256; ++k) b += p[(size_t)t * 256 + k] * wp[(size_t)k * 1024 + c];
        const float ex = b / (1.f + expf(-a)), got = hpost[(size_t)t * 1024 + c] - hpre[(size_t)t * 1024 + c]; num += (got - ex) * (got - ex); den += ex * ex; }
    num = dbg_blocksum(num, red); den = dbg_blocksum(den, red); dbg_report(slot, num, den);
}
constexpr int DBG_TC = 512;
__global__ void chk_gdn_proj(const float* h, const float* ssq, const float* ln, const float* W, int hh, float* raw) {
    const int idx = blockIdx.x * blockDim.x + threadIdx.x; if (idx >= DBG_TC * 514) return;
    const int t = idx / 514, c = idx % 514;
    const int col = c < 128 ? hh * 128 + c : c < 256 ? 1024 + hh * 128 + (c - 128) : c < 384 ? 2048 + hh * 128 + (c - 256) : c < 512 ? 3072 + hh * 128 + (c - 384) : c == 512 ? 4096 + hh : 4104 + hh;
    const float rs = dbg_rstd(ssq, t); float s = 0.f;
    for (int k = 0; k < 1024; ++k) s += h[(size_t)t * 1024 + k] * ln[k] * W[(size_t)k * OIN_SRC + col];
    raw[(size_t)t * 514 + c] = s * rs;
}
__global__ void chk_gdn_rec(const float* raw, const float* cw, const float* alog, const float* dtb, const float* onorm, int hh, const unsigned short* mix, unsigned* slot) {
    extern __shared__ float sm[];
    float* Sm = sm; float* q = sm + 128 * 129; float* kk = q + 128; float* v = kk + 128; float* kv = v + 128; float* dl = kv + 128; float* o = dl + 128; float* red = o + 128;
    const int tid = threadIdx.x;
    for (int i = tid; i < 128 * 129; i += 256) Sm[i] = 0.f;
    __syncthreads();
    float worst = 0.f;
    for (int t = 0; t < DBG_TC; ++t) {
        if (tid < 128) { const int d = tid; float aq = 0.f, ak = 0.f, av = 0.f;
            for (int jj = 0; jj < 4; ++jj) { const int r = t - 3 + jj; if (r >= 0) { aq += cw[jj * 3072 + hh * 128 + d] * raw[(size_t)r * 514 + d]; ak += cw[jj * 3072 + 1024 + hh * 128 + d] * raw[(size_t)r * 514 + 128 + d]; av += cw[jj * 3072 + 2048 + hh * 128 + d] * raw[(size_t)r * 514 + 256 + d]; } }
            q[d] = aq / (1.f + expf(-aq)); kk[d] = ak / (1.f + expf(-ak)); v[d] = av / (1.f + expf(-av)); }
        __syncthreads();
        const float sq = dbg_blocksum(tid < 128 ? q[tid] * q[tid] : 0.f, red), sk = dbg_blocksum(tid < 128 ? kk[tid] * kk[tid] : 0.f, red);
        if (tid < 128) { q[tid] *= 1.0f / sqrtf(sq + 1e-6f) * 0.08838834764831845f; kk[tid] *= 1.0f / sqrtf(sk + 1e-6f); }
        const float bb = raw[(size_t)t * 514 + 512], aa = raw[(size_t)t * 514 + 513];
        const float beta = 1.f / (1.f + expf(-bb)); const float z = aa + dtb[hh]; const float g = -expf(alog[hh]) * (z > 20.f ? z : log1pf(expf(z))); const float alpha = expf(g);
        __syncthreads();
        for (int i = tid; i < 128 * 128; i += 256) { const int d = i >> 7, j = i & 127; Sm[d * 129 + j] *= alpha; }
        __syncthreads();
        if (tid < 128) { float s = 0.f; for (int d = 0; d < 128; ++d) s += kk[d] * Sm[d * 129 + tid]; dl[tid] = beta * (v[tid] - s); }
        __syncthreads();
        for (int i = tid; i < 128 * 128; i += 256) { const int d = i >> 7, j = i & 127; Sm[d * 129 + j] += kk[d] * dl[j]; }
        __syncthreads();
        if (tid < 128) { float s = 0.f; for (int d = 0; d < 128; ++d) s += q[d] * Sm[d * 129 + tid]; o[tid] = s; }
        __syncthreads();
        const float so = dbg_blocksum(tid < 128 ? o[tid] * o[tid] : 0.f, red); const float rms = 1.0f / sqrtf(so / 128.f + 1e-6f);
        float num = 0.f, den = 0.f;
        if (tid < 128) { const float zz = raw[(size_t)t * 514 + 384 + tid]; const float ex = o[tid] * rms * onorm[tid] * (zz / (1.f + expf(-zz))); const float got = dbg_bf(mix, (size_t)t * 1024 + hh * 128 + tid); num = (got - ex) * (got - ex); den = ex * ex; }
        num = dbg_blocksum(num, red); den = dbg_blocksum(den, red);
        worst = fmaxf(worst, sqrtf(num / fmaxf(den, 1e-20f)));
    }
    if (tid == 0) atomicMax(slot, __float_as_uint(worst));
}

__global__ void chk_even_kv(const float* h, const float* ssq, const float* ln, const float* W, float* KV) {
    const size_t idx = (size_t)blockIdx.x * blockDim.x + threadIdx.x; if (idx >= (size_t)S_ * 1024) return;
    const int t = (int)(idx >> 10), c = (int)(idx & 1023); const float rs = dbg_rstd(ssq, t); float s = 0.f;
    for (int k = 0; k < 1024; ++k) s += h[(size_t)t * 1024 + k] * ln[k] * W[(size_t)k * EIN + 512 + c];
    KV[idx] = s * rs;
}
__global__ void chk_even_mix(const float* h, const float* ssq, const float* ln, const float* W, const float* KV, const int* pos, const float* lq1, const float* lk1, const float* lq2, const float* lk2, const float* subg, const float* cw,
                             float lam0, const unsigned short* PE, const unsigned short* AO, const unsigned short* MIXb, unsigned* slot) {
    __shared__ float q[2][64]; __shared__ float p[128]; __shared__ float red[256]; __shared__ float o2[2][128]; __shared__ float hn[1024];
    const int toks[6] = {5, 200, 1000, 4097, 9000, 16383};
    const int t = toks[blockIdx.x / 4], hh = blockIdx.x % 4, tid = threadIdx.x;
    auto bsum = [&](float v) { __syncthreads(); red[tid] = v; __syncthreads(); for (int o = 64; o > 0; o >>= 1) { if (tid < o) red[tid] += red[tid + o]; __syncthreads(); } const float r = red[0]; __syncthreads(); return r; };
    auto bmax = [&](float v) { __syncthreads(); red[tid] = v; __syncthreads(); for (int o = 64; o > 0; o >>= 1) { if (tid < o) red[tid] = fmaxf(red[tid], red[tid + o]); __syncthreads(); } const float r = red[0]; __syncthreads(); return r; };
    auto invf = [&](int i) { return exp2f(-(float)i * (18.931568569324174f / 8.0f)); };
    const float rs = dbg_rstd(ssq, t);
    for (int k = tid; k < 1024; k += 128) hn[k] = h[(size_t)t * 1024 + k] * rs * ln[k];
    __syncthreads();
    { const int m = tid >> 6, d = tid & 63, col = (2 * hh + m) * 64 + d; float s = 0.f; for (int k = 0; k < 1024; ++k) s += hn[k] * W[(size_t)k * EIN + col]; q[m][d] = s; }
    __syncthreads();
    float qr;
    { const int m = tid >> 6, d = tid & 63; float v = q[m][d];
      if (d < 16) { const int i = d & 7; const float ang = (float)pos[t] * invf(i); const float c = cosf(ang), s = sinf(ang); v = d < 8 ? q[m][d] * c - q[m][d + 8] * s : q[m][d] * c + q[m][d - 8] * s; }
      qr = v * pg8::C2; }
    __syncthreads(); q[tid >> 6][tid & 63] = qr; __syncthreads();
    float num = 0.f, den = 0.f;
    { const int m = tid >> 6, d = tid & 63; const float got = dbg_bf(PE, (size_t)t * EIN + (2 * hh + m) * 64 + d); const float e2 = (got - qr) * (got - qr), r2 = qr * qr; num += e2; den += r2;
      const float na = bsum(d >= 16 ? e2 : 0.f), da = bsum(d >= 16 ? r2 : 0.f), nb = bsum(d < 16 ? e2 : 0.f), db = bsum(d < 16 ? r2 : 0.f);
      if (tid == 0) { atomicMax(slot + 4, __float_as_uint(sqrtf(na / fmaxf(da, 1e-20f)))); atomicMax(slot + 5, __float_as_uint(sqrtf(nb / fmaxf(db, 1e-20f)))); } }
    { const int m = tid >> 6, d = tid & 63; const float* kr = KV + (size_t)t * 1024 + (2 * hh + m) * 64; float v = kr[d];
      if (d < 16) { const int i = d & 7; const float ang = (float)pos[t] * invf(i); const float c = cosf(ang), s = sinf(ang); v = d < 8 ? kr[d] * c - kr[d + 8] * s : kr[d] * c + kr[d - 8] * s; }
      const float got = dbg_bf(PE, (size_t)t * EIN + 512 + (2 * hh + m) * 64 + d); const float e2 = (got - v) * (got - v), r2 = v * v; num += e2; den += r2;
      const float na = bsum(d >= 16 ? e2 : 0.f), da = bsum(d >= 16 ? r2 : 0.f), nb = bsum(d < 16 ? e2 : 0.f), db = bsum(d < 16 ? r2 : 0.f);
      const float vv = KV[(size_t)t * 1024 + 512 + hh * 128 + tid], gv = dbg_bf(PE, (size_t)t * EIN + 1024 + hh * 128 + tid); const float e3 = (gv - vv) * (gv - vv), r3 = vv * vv; num += e3; den += r3;
      const float nc = bsum(e3), dc = bsum(r3);
      if (tid == 0) { atomicMax(slot + 6, __float_as_uint(sqrtf(na / fmaxf(da, 1e-20f)))); atomicMax(slot + 7, __float_as_uint(sqrtf(nb / fmaxf(db, 1e-20f)))); atomicMax(slot + 8, __float_as_uint(sqrtf(nc / fmaxf(dc, 1e-20f)))); } }
    num = bsum(num); den = bsum(den); if (tid == 0) atomicMax(slot + 0, __float_as_uint(sqrtf(num / fmaxf(den, 1e-20f))));
    for (int m = 0; m < 2; ++m) {
        float mx = -1e30f;
        for (int j0 = 0; j0 <= t; j0 += 128) { const int j = j0 + tid; float s = -1e30f;
            if (j <= t) { const float* kr = KV + (size_t)j * 1024 + (2 * hh + m) * 64; s = 0.f;
                for (int d = 0; d < 64; ++d) { float kv = kr[d]; if (d < 16) { const int i = d & 7; const float ang = (float)pos[j] * invf(i); const float c = cosf(ang), sn = sinf(ang); kv = d < 8 ? kr[d] * c - kr[d + 8] * sn : kr[d] * c + kr[d - 8] * sn; } s += q[m][d] * kv; } }
            mx = fmaxf(mx, s); }
        mx = bmax(mx);
        float l = 0.f, acc = 0.f;
        for (int j0 = 0; j0 <= t; j0 += 128) { const int j = j0 + tid; float pe = 0.f;
            if (j <= t) { const float* kr = KV + (size_t)j * 1024 + (2 * hh + m) * 64; float s = 0.f;
                for (int d = 0; d < 64; ++d) { float kv = kr[d]; if (d < 16) { const int i = d & 7; const float ang = (float)pos[j] * invf(i); const float c = cosf(ang), sn = sinf(ang); kv = d < 8 ? kr[d] * c - kr[d + 8] * sn : kr[d] * c + kr[d - 8] * sn; } s += q[m][d] * kv; }
                pe = exp2f(s - mx); }
            __syncthreads(); p[tid] = pe; __syncthreads();
            l += pe;
            const int nj = min(128, t + 1 - j0);
            for (int i = 0; i < nj; ++i) acc += p[i] * KV[(size_t)(j0 + i) * 1024 + 512 + hh * 128 + tid]; }
        l = bsum(l);
        o2[m][tid] = acc / l;
    }
    __syncthreads();
    { float n2 = 0.f, d2 = 0.f;
      for (int m = 0; m < 2; ++m) { const float ex = o2[m][tid], got = dbg_bf(AO, (size_t)t * 1024 + hh * 256 + m * 128 + tid); n2 += (got - ex) * (got - ex); d2 += ex * ex; }
      n2 = bsum(n2); d2 = bsum(d2); if (tid == 0) atomicMax(slot + 1, __float_as_uint(sqrtf(n2 / fmaxf(d2, 1e-20f)))); }
    float s1 = 0.f, s2 = 0.f; for (int i = 0; i < 64; ++i) { s1 += lq1[i] * lk1[i]; s2 += lq2[i] * lk2[i]; }
    const float lam = expf(s1) - expf(s2) + lam0;
    const float dv = o2[0][tid] - lam * o2[1][tid]; const float ssd = bsum(dv * dv); const float ex = dv / sqrtf(ssd / 128.f + 1e-5f) * subg[tid] * (1.f - lam0);
    { const float got = dbg_bf(MIXb, (size_t)t * 1024 + hh * 128 + tid); float n2 = (got - ex) * (got - ex), d2 = ex * ex; n2 = bsum(n2); d2 = bsum(d2); if (tid == 0) atomicMax(slot + 2, __float_as_uint(sqrtf(n2 / fmaxf(d2, 1e-20f)))); }
    { const int ch = hh * 128 + tid; float cx[3] = {0.f, 0.f, 0.f}, bg = 0.f;
      for (int jj = 0; jj < 3; ++jj) { const int r = t - 2 + jj; if (r < 0) continue; const float rr = dbg_rstd(ssq, r); float c = 0.f, x = 0.f, b = 0.f;
          for (int k = 0; k < 1024; ++k) { const float hv = h[(size_t)r * 1024 + k] * ln[k]; c += hv * W[(size_t)k * EIN + 2048 + ch]; x += hv * W[(size_t)k * EIN + 2560 + ch]; if (jj == 2) b += hv * W[(size_t)k * EIN + 1536 + ch]; }
          cx[jj] = (c * rr) * (x * rr); if (jj == 2) bg = b * rr; }
      const float ex2 = bg * (cw[0 * 512 + ch] * cx[0] + cw[1 * 512 + ch] * cx[1] + cw[2 * 512 + ch] * cx[2]); const float got = dbg_bf(MIXb, (size_t)t * 1024 + 512 + ch);
      float n2 = (got - ex2) * (got - ex2), d2 = ex2 * ex2; n2 = bsum(n2); d2 = bsum(d2); if (tid == 0) atomicMax(slot + 3, __float_as_uint(sqrtf(n2 / fmaxf(d2, 1e-20f)))); }
}
static void dbg_before_phase(int ph, unsigned char* ws, float* out, hipStream_t st) {
    if (ph == P_PRO || ph == P_FINAL) return;
    const int lp = (ph - 1) % LPN;
    if (lp == LP_UP || lp == LP_R1 || lp == LP_PLE) { (void)hipMemcpyAsync(ws + WS_ARENA + 400 * MiB, out, (size_t)S_ * D_ * 4, hipMemcpyDeviceToDevice, st); (void)hipMemcpyAsync(ws + WS_ARENA + 464 * MiB, ws + WS_SSQA, (size_t)S_ * 16 * 4, hipMemcpyDeviceToDevice, st); }
}
static void dbg_checks(int ph, void* const* d_in, unsigned char* ws, float* out, hipStream_t st) {
    if (ph == P_PRO || ph == P_FINAL) return;
    unsigned* slots = (unsigned*)(ws + WS_CTL) + CW_DBG; const int L = (ph - 1) / LPN, lp = (ph - 1) % LPN, j = L >> 1; const bool odd = L & 1;
    const float* snap = (const float*)(ws + WS_ARENA + 400 * MiB);
    if (lp == LP_DOWN && L == 0) hipLaunchKernelGGL(chk_ffn, dim3(24), dim3(256), 0, st, snap, (const float*)out, (const float*)(ws + WS_ARENA + 464 * MiB), (const float*)d_in[4] + L * D_, (const float*)nullptr,
        (const float*)d_in[21] + (size_t)j * D_ * DFF, (const float*)d_in[22] + (size_t)j * D_ * DFF, (const float*)d_in[23] + (size_t)j * D_ * DFF, 0, slots + 256 + 0);
    if (lp == LP_PLE && L == 0) hipLaunchKernelGGL(chk_ple, dim3(24), dim3(256), 0, st, snap, (const float*)out, (const float*)(ws + WS_ARENA + 464 * MiB), (const float*)d_in[5] + L * D_, (const float*)d_in[28] + (size_t)L * D_ * D_,
        (const float*)d_in[1] + (size_t)L * S_ * PLE, (const float*)d_in[29] + (size_t)L * PLE * D_, slots + 256 + 1);
    if (lp == LP_G3 && L == 1) { float* raw = (float*)(ws + WS_ARENA + 400 * MiB);
        hipLaunchKernelGGL(chk_gdn_proj, dim3((DBG_TC * 514 + 255) / 256), dim3(256), 0, st, (const float*)out, (const float*)(ws + WS_SSQB), (const float*)d_in[3] + L * D_, (const float*)d_in[15] + (size_t)j * D_ * OIN_SRC, 3, raw);
        hipLaunchKernelGGL(chk_gdn_rec, dim3(1), dim3(256), (128 * 129 + 6 * 128 + 256) * 4, st, (const float*)raw, (const float*)d_in[16] + (size_t)j * 4 * 3072, (const float*)d_in[17] + j * 8, (const float*)d_in[18] + j * 8, (const float*)d_in[19] + j * 128, 3, (const unsigned short*)(ws + WS_MIX), slots + 256 + 2); }
    if (lp == LP_COMB && L == 1) hipLaunchKernelGGL(chk_ffn, dim3(24), dim3(256), 0, st, snap, (const float*)out, (const float*)(ws + WS_ARENA + 464 * MiB), (const float*)d_in[4] + L * D_, (const float*)d_in[24] + (size_t)j * D_ * NEXP,
        (const float*)d_in[25] + (size_t)j * NEXP * D_ * DFF, (const float*)d_in[26] + (size_t)j * NEXP * D_ * DFF, (const float*)d_in[27] + (size_t)j * NEXP * DFF * D_, 1, slots + 256 + 3);
    if (lp == LP_MIXPREP && L == 0) { float* KV = (float*)(ws + WS_ARENA + 400 * MiB);
        hipLaunchKernelGGL(chk_even_kv, dim3((S_ * 1024) / 256), dim3(256), 0, st, (const float*)out, (const float*)(ws + WS_SSQB), (const float*)d_in[3] + L * D_, (const float*)d_in[7] + (size_t)j * D_ * EIN, KV);
        hipLaunchKernelGGL(chk_even_mix, dim3(24), dim3(128), 0, st, (const float*)out, (const float*)(ws + WS_SSQB), (const float*)d_in[3] + L * D_, (const float*)d_in[7] + (size_t)j * D_ * EIN, (const float*)KV, (const int*)d_in[2],
            (const float*)d_in[9] + j * 64, (const float*)d_in[10] + j * 64, (const float*)d_in[11] + j * 64, (const float*)d_in[12] + j * 64, (const float*)d_in[13] + j * 128, (const float*)d_in[14] + (size_t)j * 3 * 512,
            0.8f - 0.6f * expf(-0.3f * (float)L), (const unsigned short*)(ws + WS_ARENA + AR_PE), (const unsigned short*)(ws + WS_ARENA + AR_AO), (const unsigned short*)(ws + WS_MIX), slots + 256 + 4); }
    (void)odd;
}
static void dbg_after_phase(int ph, unsigned char* ws, float* out, hipStream_t st) {
    unsigned* slots = (unsigned*)(ws + WS_CTL) + CW_DBG; unsigned* sl = slots + ph;
    auto scan = [&](const void* p, size_t n, int f32) { hipLaunchKernelGGL(dbg_scan, dim3(1024), dim3(256), 0, st, p, n, f32, sl); };
    const size_t SD = (size_t)S_ * D_; unsigned char* ar = ws + WS_ARENA;
    if (ph == P_PRO) { scan(ws + WS_HBF, SD, 0); scan(out, SD, 1); scan(ws + WS_PBF, (size_t)4 * S_ * PLE, 0); scan(ws + WS_TAB, (size_t)S_ * 16, 1); scan(ws + WS_W, (size_t)44 * MiB, 0); return; }
    if (ph == P_FINAL) return;
    const int L = (ph - 1) / LPN, lp = (ph - 1) % LPN; const bool odd = L & 1;
    switch (lp) {
    case LP_PROJ: if (!odd) scan(ar + AR_PE, (size_t)S_ * EIN, 0); else { scan(ar + AR_PO, (size_t)S_ * OIN, 0); scan(ws + WS_GB, (size_t)S_ * 16, 1); } scan(ws + WS_PP, SD, 0); break;
    case LP_ROT: scan(ar + AR_PE, (size_t)S_ * EIN, 0); break;
    case LP_ATT: scan(ar + AR_AO, SD, 0); break;
    case LP_MIXPREP: case LP_G3: scan(ws + WS_MIX, SD, 0); break;
    case LP_GA: scan(ar + AR_QN, SD * 6, 0); scan(ws + WS_GB, (size_t)S_ * 16, 1); break;
    case LP_G1: scan(ar + AR_AI, (size_t)NUNIT * 4096, 0); scan(ar + AR_NEGW, SD, 0); scan(ar + AR_UT, SD, 0); scan(ar + AR_MP, (size_t)NUNIT * 16384 * 2, 0); break;
    case LP_G2: scan(ar + AR_SG, (size_t)NUNIT * 16384, 0); break;
    case LP_OUT: case LP_DOWN: case LP_COMB: case LP_PLE: scan(out, SD, 1); scan(ws + WS_HBF, SD, 0); scan(ws + ((lp == LP_PLE) ? WS_SSQB : WS_SSQA), (size_t)S_ * 16, 1); break;
    case LP_UP: scan(ar + AR_ACT, (size_t)S_ * DFF, 0); break;
    case LP_R1: scan(ws + WS_TOK + TOK_G, (size_t)S_ * 2, 1); break;
    default: break; }
}
#endif
#ifndef MK_MULTI
#define MK_MULTI 0
#endif
extern "C" void kernel_launch(void* const* d_in, const int* in_sizes, int n_in, void* d_out, int out_size, void* d_ws, size_t ws_size, hipStream_t stream) {
    static int grid = 0;
    if (grid == 0) {
        if (n_in != 30 || out_size != S_ * D_ || ws_size < WS_NEED) { fprintf(stderr, "kernel_launch: unexpected problem (n_in %d, out %d, ws %zu < %zu)\n", n_in, out_size, ws_size, (size_t)WS_NEED); grid = -1; return; }
        int dev = 0, cus = 0, per_cu = 0;
        if (hipGetDevice(&dev) != hipSuccess || hipDeviceGetAttribute(&cus, hipDeviceAttributeMultiprocessorCount, dev) != hipSuccess) { grid = -1; return; }
        if (hipFuncSetAttribute((const void*)fwd, hipFuncAttributeMaxDynamicSharedMemorySize, LDS_BYTES) != hipSuccess) { fprintf(stderr, "kernel_launch: hipFuncSetAttribute failed\n"); grid = -1; return; }
        if (hipOccupancyMaxActiveBlocksPerMultiprocessor(&per_cu, (const void*)fwd, NWAVES * 64, LDS_BYTES) != hipSuccess || per_cu < 1) { fprintf(stderr, "kernel_launch: occupancy query says %d\n", per_cu); }
        (void)hipGetLastError();
        grid = cus;
#if DBG
        (void)hipFuncSetAttribute((const void*)chk_gdn_rec, hipFuncAttributeMaxDynamicSharedMemorySize, 72 * 1024);
#endif
    }
    if (grid < 0) return;
    (void)hipMemsetAsync((char*)d_ws + WS_CTL, 0, CTL_ZERO_BYTES, stream);
    Args a{};
    for (int i = 0; i < 30; ++i) a.in[i] = d_in[i];
    a.out = (float*)d_out; a.ws = (unsigned char*)d_ws; a.pad = 0;
#if MK_MULTI
    a.use_bar = 0;
    static const int seq_even[] = {LP_PROJ, LP_ROT, LP_ATT, LP_MIXPREP, LP_OUT, LP_UP, LP_DOWN, LP_PLE};
    static const int seq_odd[] = {LP_PROJ, LP_GA, LP_G2, LP_G3, LP_OUT, LP_R1, LP_R2, LP_M1, LP_M2, LP_COMB, LP_PLE};
    int plist[64], np = 0; plist[np++] = P_PRO;
    for (int L = 0; L < DEPTH_; ++L) { const bool odd = L & 1; const int n = odd ? 11 : 8; for (int q = 0; q < n; ++q) plist[np++] = 1 + LPN * L + (odd ? seq_odd[q] : seq_even[q]); }
    plist[np++] = P_FINAL;
    for (int pi = 0; pi < np; ++pi) { const int ph = plist[pi];
        a.ph_lo = ph; a.ph_hi = ph + 1;
#if DBG
        dbg_before_phase(ph, (unsigned char*)d_ws, (float*)d_out, stream);
#endif
        hipLaunchKernelGGL(fwd, dim3(grid), dim3(NWAVES * 64), LDS_BYTES, stream, a);
#if DBG
        dbg_after_phase(ph, (unsigned char*)d_ws, (float*)d_out, stream); dbg_checks(ph, d_in, (unsigned char*)d_ws, (float*)d_out, stream);
#endif
    }
#if DBG
    hipLaunchKernelGGL(dbg_fill, dim3(1024), dim3(256), 0, stream, (float*)d_out, (size_t)S_ * D_, (const unsigned*)((unsigned char*)d_ws + WS_CTL) + CW_DBG, P_FINAL + 1);
#endif
#else
    a.use_bar = 1; a.ph_lo = 0; a.ph_hi = P_FINAL + 1;
    hipLaunchKernelGGL(fwd, dim3(grid), dim3(NWAVES * 64), LDS_BYTES, stream, a);
#ifdef PROBE_PH
    for (int i = 0; i < PROBE_N; ++i) { a.use_bar = 0; a.ph_lo = PROBE_PH; a.ph_hi = PROBE_PH + 1; hipLaunchKernelGGL(fwd, dim3(grid), dim3(NWAVES * 64), LDS_BYTES, stream, a); }
#endif
#endif
    const hipError_t le = hipPeekAtLastError();
    if (le != hipSuccess) fprintf(stderr, "kernel_launch: launch failed: %s\n", hipGetErrorName(le));
}
```

```cpp
#include <hip/hip_runtime.h>
#include <hip/hip_bf16.h>
#include <cstdio>
#include <cstdint>
#include <cmath>

constexpr int S_ = 16384, D_ = 1024, DEPTH_ = 4;
constexpr int EIN = 3072, OIN = 4096, OIN_SRC = 4112, DFF = 3584, NEXP = 8, PLE = 256;
constexpr int MOE_P = 2 * S_ + NEXP * 256;
constexpr int NCHUNK = S_ / 64, NUNIT = NCHUNK * 8;
constexpr float RMS_EPS = 1e-6f;

namespace pg8 {
#define PG8_LAS __attribute__((address_space(3)))
typedef unsigned short bf16_t;
typedef short bf16x8 __attribute__((ext_vector_type(8)));
typedef float f32x4 __attribute__((ext_vector_type(4)));
typedef float f32x2 __attribute__((ext_vector_type(2)));
typedef unsigned u32x4 __attribute__((ext_vector_type(4)));
typedef unsigned u32x2 __attribute__((ext_vector_type(2)));
constexpr int BM = 256, BK = 64, HALF = 128, HTB = HALF * BK * 2, STAGE_BYTES = 8 * HTB, NXCD = 8, WGM = 8;

__host__ __device__ __forceinline__ int lds_byte(int r, int c) { const int st = (r >> 4) * 2 + (c >> 5), rr = r & 15, cc = c & 31, ob = rr * 64 + cc * 2; return st * 1024 + (ob ^ (((ob >> 9) & 1) << 5)); }
__host__ __device__ __forceinline__ void stage_rc(int b, int& R, int& C) { const int st = b / 1024, sb = b % 1024, swz = sb ^ (((sb >> 9) & 1) << 5); R = (st >> 1) * 16 + swz / 64; C = (st & 1) * 32 + (swz % 64) / 2; }
__host__ __device__ __forceinline__ int perm32(int rho) { const int n = rho >> 4, i = rho & 15; return 8 * (i >> 2) + 4 * n + (i & 3); }

struct Unit { int pm, pn, be; };
struct Gemm { const bf16_t* A; const bf16_t* Bt; int M, N, K; size_t bstride; };

struct StaticOrder {
    int nM, nN, nwg, G, c;
    __host__ __device__ void init(int M, int N, int G_, int c_) { nM = M / BM; nN = N / BM; nwg = nM * nN; G = G_; c = c_; }
    __host__ __device__ bool next(int i, Unit& u) const {
        const long L = (long)i * G + c; if (L >= nwg) return false;
        int wgid = (int)L; { const int q = nwg / NXCD, r = nwg % NXCD, xcd = wgid % NXCD, off = wgid / NXCD; wgid = (xcd < r ? xcd * (q + 1) : r * (q + 1) + (xcd - r) * q) + off; }
        const int nig = WGM * nN, gid = wgid / nig, fm = gid * WGM, gsz = (nM - fm) < WGM ? (nM - fm) : WGM;
        u.pm = fm + ((wgid % nig) % gsz); u.pn = (wgid % nig) / gsz; u.be = 0; return true;
    }
    __device__ __forceinline__ void a_ready(const Unit&) const {}
    __device__ __forceinline__ void done(const Unit&) const {}
};
struct MoeOrder : StaticOrder {
    const PG8_LAS int* blk_e;
    __device__ __forceinline__ bool next(int i, Unit& u) const { if (!StaticOrder::next(i, u)) return false; u.be = blk_e[u.pm]; return true; }
};

__device__ __forceinline__ unsigned cvt_pk_bf16(float lo, float hi) { unsigned r; asm volatile("v_cvt_pk_bf16_f32 %0, %1, %2" : "=v"(r) : "v"(lo), "v"(hi)); return r; }
typedef __bf16 bf16x2_t_ __attribute__((ext_vector_type(2)));
__device__ __forceinline__ unsigned cvt_pk_bf16_cv(float lo, float hi) { const f32x2 v = {lo, hi}; const bf16x2_t_ b = __builtin_convertvector(v, bf16x2_t_); return __builtin_bit_cast(unsigned, b); }
__device__ __forceinline__ float bf_lo(unsigned w) { return __uint_as_float(w << 16); }
__device__ __forceinline__ float bf_hi(unsigned w) { return __uint_as_float(w & 0xffff0000u); }

__device__ __forceinline__ float rstd_row(const float* ssq, int row) {
    const f32x4* p = (const f32x4*)(ssq + (size_t)row * 16);
    const f32x4 a = p[0], b = p[1], c = p[2], d = p[3];
    const float s = (((a[0] + a[1]) + (a[2] + a[3])) + ((b[0] + b[1]) + (b[2] + b[3]))) + (((c[0] + c[1]) + (c[2] + c[3])) + ((d[0] + d[1]) + (d[2] + d[3])));
    return __builtin_amdgcn_rsqf(s * (1.0f / 1024.0f) + RMS_EPS);
}
__device__ __forceinline__ float sigmoidf_(float x) { return __builtin_amdgcn_rcpf(1.0f + __builtin_amdgcn_exp2f(-1.4426950408889634f * x)); }
__device__ __forceinline__ float siluf_(float x) { return x * sigmoidf_(x); }

constexpr float C2 = 0.125f * 1.4426950408889634f;

struct EpiProjEven {
    static constexpr bool PERM = true, AFTER_DRAIN = false;
    bf16_t* O; const float* ssq; const float* tab;
    __device__ __forceinline__ void operator()(const f32x4 (&acc)[2][2][4][2], const Unit& u, int wr, int wc, int fr, int fq) const {
        const int row0 = u.pm * BM + wr * 64 + fr, colt = u.pn * BM;
        const bool rot = (colt < 1024) && ((wc & 1) == 0);
        const float qs = (colt < 512) ? C2 : 1.0f;
#pragma unroll
        for (int ai = 0; ai < 2; ++ai)
#pragma unroll
            for (int m = 0; m < 4; ++m) {
                const int row = row0 + ai * HALF + m * 16; const float rs = rstd_row(ssq, row);
                f32x4 c0 = {1.f, 1.f, 1.f, 1.f}, c1 = c0, s0 = {0.f, 0.f, 0.f, 0.f}, s1 = s0;
                if (rot && fq < 2) { const f32x4* t = (const f32x4*)(tab + (size_t)row * 16); c0 = t[0]; c1 = t[1]; s0 = t[2]; s1 = t[3]; if (fq == 0) { s0 = -s0; s1 = -s1; } }
#pragma unroll
                for (int bj = 0; bj < 2; ++bj) {
                    f32x4 v0 = acc[ai][bj][m][0] * rs, v1 = acc[ai][bj][m][1] * rs;
                    if (rot) {
                        f32x4 p0, p1;
#pragma unroll
                        for (int i = 0; i < 4; ++i) { p0[i] = __shfl_xor(v0[i], 16); p1[i] = __shfl_xor(v1[i], 16); }
                        v0 = v0 * c0 + p0 * s0; v1 = v1 * c1 + p1 * s1;
                    }
                    v0 = v0 * qs; v1 = v1 * qs;
                    u32x4 w; w.x = cvt_pk_bf16(v0[0], v0[1]); w.y = cvt_pk_bf16(v0[2], v0[3]); w.z = cvt_pk_bf16(v1[0], v1[1]); w.w = cvt_pk_bf16(v1[2], v1[3]);
                    *(u32x4*)(O + (size_t)row * EIN + colt + bj * HALF + wc * 32 + 8 * fq) = w;
                }
                asm volatile("" ::: "memory");
            }
    }
};
struct EpiBf16 {
    static constexpr bool PERM = true, AFTER_DRAIN = false;
    bf16_t* O; int ldc; const float* ssq; float scale0; int scale_cols;
    __device__ __forceinline__ void operator()(const f32x4 (&acc)[2][2][4][2], const Unit& u, int wr, int wc, int fr, int fq) const {
        const int row0 = u.pm * BM + wr * 64 + fr, colt = u.pn * BM;
#pragma unroll
        for (int ai = 0; ai < 2; ++ai)
#pragma unroll
            for (int m = 0; m < 4; ++m) {
                const int row = row0 + ai * HALF + m * 16; const float rs = (ssq ? rstd_row(ssq, row) : 1.0f) * (colt < scale_cols ? scale0 : 1.0f);
#pragma unroll
                for (int bj = 0; bj < 2; ++bj) {
                    const f32x4 v0 = acc[ai][bj][m][0] * rs, v1 = acc[ai][bj][m][1] * rs;
                    u32x4 w; w.x = cvt_pk_bf16(v0[0], v0[1]); w.y = cvt_pk_bf16(v0[2], v0[3]); w.z = cvt_pk_bf16(v1[0], v1[1]); w.w = cvt_pk_bf16(v1[2], v1[3]);
                    *(u32x4*)(O + (size_t)row * ldc + colt + bj * HALF + wc * 32 + 8 * fq) = w;
                }
                if (m & 1) asm volatile("" ::: "memory");
            }
    }
};
struct EpiSwiglu {
    static constexpr bool PERM = true, AFTER_DRAIN = false;
    bf16_t* O; const float* ssq;
    __device__ __forceinline__ void operator()(const f32x4 (&acc)[2][2][4][2], const Unit& u, int wr, int wc, int fr, int fq) const {
        const int row0 = u.pm * BM + wr * 64 + fr, col = u.pn * HALF + wc * 32 + 8 * fq;
#pragma unroll
        for (int ai = 0; ai < 2; ++ai)
#pragma unroll
            for (int m = 0; m < 4; ++m) {
                const int row = row0 + ai * HALF + m * 16; const float rs = ssq ? rstd_row(ssq, row) : 1.0f;
                float o[8];
#pragma unroll
                for (int n = 0; n < 2; ++n)
#pragma unroll
                    for (int i = 0; i < 4; ++i) { const float a = acc[ai][0][m][n][i] * rs, b = acc[ai][1][m][n][i] * rs; o[4 * n + i] = siluf_(a) * b; }
                u32x4 w; w.x = cvt_pk_bf16(o[0], o[1]); w.y = cvt_pk_bf16(o[2], o[3]); w.z = cvt_pk_bf16(o[4], o[5]); w.w = cvt_pk_bf16(o[6], o[7]);
                *(u32x4*)(O + (size_t)row * DFF + col) = w;
                if (m & 1) asm volatile("" ::: "memory");
            }
    }
};
struct EpiResid {
    static constexpr bool PERM = true, AFTER_DRAIN = false;
    float* h; bf16_t* hb; float* ssq;
    __device__ __forceinline__ void operator()(const f32x4 (&acc)[2][2][4][2], const Unit& u, int wr, int wc, int fr, int fq) const {
        const int row0 = u.pm * BM + wr * 64 + fr, colt = u.pn * BM;
#pragma unroll
        for (int ai = 0; ai < 2; ++ai)
#pragma unroll
            for (int m = 0; m < 4; ++m) {
                const int row = row0 + ai * HALF + m * 16; float ss = 0.f;
#pragma unroll
                for (int bj = 0; bj < 2; ++bj) {
                    const size_t off = (size_t)row * D_ + colt + bj * HALF + wc * 32 + 8 * fq;
                    f32x4 x0 = *(const f32x4*)(h + off), x1 = *(const f32x4*)(h + off + 4);
                    x0 = x0 + acc[ai][bj][m][0]; x1 = x1 + acc[ai][bj][m][1];
                    *(f32x4*)(h + off) = x0; *(f32x4*)(h + off + 4) = x1;
                    ss += (x0[0] * x0[0] + x0[1] * x0[1]) + (x0[2] * x0[2] + x0[3] * x0[3]) + (x1[0] * x1[0] + x1[1] * x1[1]) + (x1[2] * x1[2] + x1[3] * x1[3]);
                    u32x4 w; w.x = cvt_pk_bf16(x0[0], x0[1]); w.y = cvt_pk_bf16(x0[2], x0[3]); w.z = cvt_pk_bf16(x1[0], x1[1]); w.w = cvt_pk_bf16(x1[2], x1[3]);
                    *(u32x4*)(hb + off) = w;
                }
                ss += __shfl_xor(ss, 16); ss += __shfl_xor(ss, 32);
                if (fq == 0) ssq[(size_t)row * 16 + u.pn * 4 + wc] = ss;
                asm volatile("" ::: "memory");
            }
    }
};
struct EpiPle {
    static constexpr bool PERM = true, AFTER_DRAIN = false;
    float* h; bf16_t* hb; const float* ssq_in; float* ssq_out; const bf16_t* pp;
    __device__ __forceinline__ void operator()(const f32x4 (&acc)[2][2][4][2], const Unit& u, int wr, int wc, int fr, int fq) const {
        const int row0 = u.pm * BM + wr * 64 + fr, colt = u.pn * BM;
#pragma unroll
        for (int ai = 0; ai < 2; ++ai)
#pragma unroll
            for (int m = 0; m < 4; ++m) {
                const int row = row0 + ai * HALF + m * 16; const float rs = rstd_row(ssq_in, row); float ss = 0.f;
#pragma unroll
                for (int bj = 0; bj < 2; ++bj) {
                    const size_t off = (size_t)row * D_ + colt + bj * HALF + wc * 32 + 8 * fq;
                    f32x4 x0 = *(const f32x4*)(h + off), x1 = *(const f32x4*)(h + off + 4);
                    const u32x4 pw = *(const u32x4*)(pp + off);
                    const f32x4 a0 = acc[ai][bj][m][0] * rs, a1 = acc[ai][bj][m][1] * rs;
                    x0[0] += sigmoidf_(a0[0]) * bf_lo(pw.x); x0[1] += sigmoidf_(a0[1]) * bf_hi(pw.x); x0[2] += sigmoidf_(a0[2]) * bf_lo(pw.y); x0[3] += sigmoidf_(a0[3]) * bf_hi(pw.y);
                    x1[0] += sigmoidf_(a1[0]) * bf_lo(pw.z); x1[1] += sigmoidf_(a1[1]) * bf_hi(pw.z); x1[2] += sigmoidf_(a1[2]) * bf_lo(pw.w); x1[3] += sigmoidf_(a1[3]) * bf_hi(pw.w);
                    *(f32x4*)(h + off) = x0; *(f32x4*)(h + off + 4) = x1;
                    ss += (x0[0] * x0[0] + x0[1] * x0[1]) + (x0[2] * x0[2] + x0[3] * x0[3]) + (x1[0] * x1[0] + x1[1] * x1[1]) + (x1[2] * x1[2] + x1[3] * x1[3]);
                    u32x4 w; w.x = cvt_pk_bf16(x0[0], x0[1]); w.y = cvt_pk_bf16(x0[2], x0[3]); w.z = cvt_pk_bf16(x1[0], x1[1]); w.w = cvt_pk_bf16(x1[2], x1[3]);
                    *(u32x4*)(hb + off) = w;
                }
                ss += __shfl_xor(ss, 16); ss += __shfl_xor(ss, 32);
                if (fq == 0) ssq_out[(size_t)row * 16 + u.pn * 4 + wc] = ss;
                asm volatile("" ::: "memory");
            }
    }
};
struct EpiMoeDown {
    static constexpr bool PERM = true, AFTER_DRAIN = false;
    bf16_t* Y; const float* gate;
    __device__ __forceinline__ void operator()(const f32x4 (&acc)[2][2][4][2], const Unit& u, int wr, int wc, int fr, int fq) const {
        const int row0 = u.pm * BM + wr * 64 + fr, colt = u.pn * BM;
#pragma unroll
        for (int ai = 0; ai < 2; ++ai)
#pragma unroll
            for (int m = 0; m < 4; ++m) {
                const int row = row0 + ai * HALF + m * 16; const float gt = gate[row];
#pragma unroll
                for (int bj = 0; bj < 2; ++bj) {
                    const f32x4 v0 = acc[ai][bj][m][0] * gt, v1 = acc[ai][bj][m][1] * gt;
                    u32x4 w; w.x = cvt_pk_bf16(v0[0], v0[1]); w.y = cvt_pk_bf16(v0[2], v0[3]); w.z = cvt_pk_bf16(v1[0], v1[1]); w.w = cvt_pk_bf16(v1[2], v1[3]);
                    *(u32x4*)(Y + (size_t)row * D_ + colt + bj * HALF + wc * 32 + 8 * fq) = w;
                }
                if (m & 1) asm volatile("" ::: "memory");
            }
    }
};

template <class Epi, class Sched, bool ALIGN_EPI = false, bool SP2 = false>
__device__ __forceinline__ void gemm_phase(PG8_LAS unsigned char* lds, const Gemm g, const Sched& S, const Epi& E) {
    int tid_ = threadIdx.x; asm volatile("" : "+v"(tid_));
    const int tid = tid_, wid = __builtin_amdgcn_readfirstlane(tid >> 6), lane = tid & 63, wr = wid >> 2, wc = wid & 3, fr = lane & 15, fq = lane >> 4;
    const int K = g.K, nt = K / BK;
    unsigned voffA[2], voffB[2];
#pragma unroll
    for (int i = 0; i < 2; ++i) { int R, C; stage_rc(tid * 16 + i * 8192, R, C); const int Rb = Epi::PERM ? ((R & ~31) + perm32(R & 31)) : R;
        voffA[i] = (unsigned)(R * K + C) * 2u; voffB[i] = (unsigned)(Rb * K + C) * 2u; }
    const size_t kstep = (size_t)(BK * 2);
    const size_t hstep = (size_t)HALF * K * 2;
    const size_t tstep = 2 * hstep;
    const unsigned ldsw = (unsigned)wid * 1024u;
    const int aoff = lds_byte(wr * 64 + fr, fq * 8), boff = lds_byte(wc * 32 + fr, fq * 8);
#define PG8_SA(b, h) (((b) * 2 + (h)) * HTB)
#define PG8_SB(b, h) ((4 + (b) * 2 + (h)) * HTB)
#define PG8_STAGE(bufoff, gbase, voff) do { _Pragma("unroll") for (int _i = 0; _i < 2; ++_i) \
        __builtin_amdgcn_global_load_lds((const unsigned*)((const char*)(gbase) + (voff)[_i]), (PG8_LAS unsigned*)(lds + (bufoff) + ldsw + _i * 8192), 16, 0, 0); } while (0)
#define PG8_LDA(dst, b, h) do { _Pragma("unroll") for (int m = 0; m < 4; ++m) _Pragma("unroll") for (int k = 0; k < 2; ++k) dst[m][k] = *(const PG8_LAS bf16x8*)(lds + PG8_SA(b, h) + aoff + m * 2048 + k * 1024); } while (0)
#define PG8_LDB(dst, b, h) do { _Pragma("unroll") for (int n = 0; n < 2; ++n) _Pragma("unroll") for (int k = 0; k < 2; ++k) dst[n][k] = *(const PG8_LAS bf16x8*)(lds + PG8_SB(b, h) + boff + n * 2048 + k * 1024); } while (0)
#define PG8_MMA(ai, bj, At, Bt) do { __builtin_amdgcn_s_setprio(1); _Pragma("unroll") for (int m = 0; m < 4; ++m) _Pragma("unroll") for (int n = 0; n < 2; ++n) _Pragma("unroll") for (int k = 0; k < 2; ++k) \
        acc[ai][bj][m][n] = __builtin_amdgcn_mfma_f32_16x16x32_bf16(Bt[n][k], At[m][k], acc[ai][bj][m][n], 0, 0, 0); __builtin_amdgcn_s_setprio(0); } while (0)
#define PG8_WAIT_V(n) asm volatile("s_waitcnt vmcnt(" #n ")" ::: "memory")
#define PG8_WAIT_L(n) asm volatile("s_waitcnt lgkmcnt(" #n ")" ::: "memory")
#define PG8_BAR __builtin_amdgcn_s_barrier()
#define PG8_SCHED __builtin_amdgcn_sched_barrier(0)
    Unit cur, nxt; int ui = 0;
    if (!S.next(0, cur)) return;
    f32x4 acc[2][2][4][2];
#pragma unroll
    for (int a = 0; a < 2; ++a)
#pragma unroll
        for (int b = 0; b < 2; ++b)
#pragma unroll
            for (int m = 0; m < 4; ++m)
#pragma unroll
                for (int n = 0; n < 2; ++n) acc[a][b][m][n] = (f32x4){0.f, 0.f, 0.f, 0.f};
    bf16x8 At[4][2], B0[2][2], B1[2][2];
    const char* cA = (const char*)g.A + (size_t)cur.pm * tstep; const char* cB = (const char*)g.Bt + (size_t)cur.pn * tstep + (size_t)cur.be * g.bstride;
    S.a_ready(cur);
    if constexpr (SP2) {
        PG8_STAGE(PG8_SB(0, 0), cB, voffB); PG8_STAGE(PG8_SB(0, 1), cB + hstep, voffB); PG8_STAGE(PG8_SA(0, 0), cA, voffA); PG8_STAGE(PG8_SA(0, 1), cA + hstep, voffA);
        if (wr == 1) PG8_BAR;
        PG8_WAIT_V(2); PG8_BAR;
        PG8_STAGE(PG8_SB(1, 0), cB + kstep, voffB); PG8_STAGE(PG8_SA(1, 0), cA + kstep, voffA); PG8_STAGE(PG8_SB(1, 1), cB + hstep + kstep, voffB);
        PG8_WAIT_V(6); PG8_BAR;
    } else {
        PG8_STAGE(PG8_SB(0, 0), cB, voffB); PG8_STAGE(PG8_SA(0, 0), cA, voffA); PG8_STAGE(PG8_SB(0, 1), cB + hstep, voffB); PG8_STAGE(PG8_SA(0, 1), cA + hstep, voffA);
        if (wr == 1) PG8_BAR;
        PG8_WAIT_V(4); PG8_BAR;
        PG8_STAGE(PG8_SB(1, 0), cB + kstep, voffB); PG8_STAGE(PG8_SA(1, 0), cA + kstep, voffA); PG8_STAGE(PG8_SB(1, 1), cB + hstep + kstep, voffB);
        PG8_WAIT_V(6); PG8_BAR;
    }
    for (;;) {
        const bool has_next = S.next(ui + 1, nxt);
        const char* nA = has_next ? (const char*)g.A + (size_t)nxt.pm * tstep : cA; const char* nB = has_next ? (const char*)g.Bt + (size_t)nxt.pn * tstep + (size_t)nxt.be * g.bstride : cB;
        for (int t = 0; t < nt; t += 2) {
            const bool last = (t == nt - 2);
            const char* a1 = cA + (size_t)(t + 1) * kstep;
            const char* a2 = last ? nA : cA + (size_t)(t + 2) * kstep; const char* b2 = last ? nB : cB + (size_t)(t + 2) * kstep;
            const char* a3 = a2 + kstep; const char* b3 = b2 + kstep;
            if (last && has_next) S.a_ready(nxt);
            if constexpr (SP2) {
            PG8_LDB(B0, 0, 0); PG8_LDB(B1, 0, 1); PG8_SCHED; PG8_LDA(At, 0, 0); PG8_STAGE(PG8_SA(1, 1), a1 + hstep, voffA);
            PG8_WAIT_V(8); PG8_WAIT_L(0); PG8_BAR; PG8_MMA(0, 0, At, B0); PG8_MMA(0, 1, At, B1); PG8_BAR; PG8_SCHED;
            PG8_LDA(At, 0, 1); PG8_STAGE(PG8_SB(0, 0), b2, voffB); PG8_STAGE(PG8_SB(0, 1), b2 + hstep, voffB); PG8_STAGE(PG8_SA(0, 0), a2, voffA);
            PG8_WAIT_V(8); PG8_WAIT_L(0); PG8_BAR; PG8_MMA(1, 0, At, B0); PG8_MMA(1, 1, At, B1); PG8_BAR; PG8_SCHED;
            PG8_LDB(B0, 1, 0); PG8_LDB(B1, 1, 1); PG8_SCHED; PG8_LDA(At, 1, 0); PG8_STAGE(PG8_SA(0, 1), a2 + hstep, voffA);
            PG8_WAIT_V(8); PG8_WAIT_L(0); PG8_BAR; PG8_MMA(0, 0, At, B0); PG8_MMA(0, 1, At, B1); PG8_BAR; PG8_SCHED;
            PG8_LDA(At, 1, 1); PG8_STAGE(PG8_SB(1, 0), b3, voffB); PG8_STAGE(PG8_SB(1, 1), b3 + hstep, voffB); PG8_STAGE(PG8_SA(1, 0), a3, voffA);
            PG8_WAIT_V(8); PG8_WAIT_L(0); PG8_BAR; PG8_MMA(1, 0, At, B0); PG8_MMA(1, 1, At, B1); PG8_BAR; PG8_SCHED;
            } else {
            PG8_LDB(B0, 0, 0); PG8_SCHED; PG8_LDA(At, 0, 0); PG8_STAGE(PG8_SA(1, 1), a1 + hstep, voffA);
            PG8_WAIT_L(8); PG8_BAR; PG8_WAIT_L(0); PG8_MMA(0, 0, At, B0); PG8_BAR; PG8_SCHED;
            PG8_LDB(B1, 0, 1); PG8_STAGE(PG8_SB(0, 0), b2, voffB);
            PG8_BAR; PG8_WAIT_L(0); PG8_MMA(0, 1, At, B1); PG8_BAR;
            PG8_LDA(At, 0, 1); PG8_STAGE(PG8_SA(0, 0), a2, voffA);
            PG8_BAR; PG8_WAIT_L(0); PG8_MMA(1, 0, At, B0); PG8_BAR; PG8_SCHED;
            PG8_STAGE(PG8_SB(0, 1), b2 + hstep, voffB);
            PG8_WAIT_V(6); PG8_BAR; PG8_MMA(1, 1, At, B1); PG8_BAR;
            PG8_LDB(B0, 1, 0); PG8_SCHED; PG8_LDA(At, 1, 0); PG8_STAGE(PG8_SA(0, 1), a2 + hstep, voffA);
            PG8_WAIT_L(8); PG8_BAR; PG8_WAIT_L(0); PG8_MMA(0, 0, At, B0); PG8_BAR; PG8_SCHED;
            PG8_LDB(B1, 1, 1); PG8_STAGE(PG8_SB(1, 0), b3, voffB);
            PG8_BAR; PG8_WAIT_L(0); PG8_MMA(0, 1, At, B1); PG8_BAR;
            PG8_LDA(At, 1, 1); PG8_STAGE(PG8_SA(1, 0), a3, voffA);
            PG8_BAR; PG8_WAIT_L(0); PG8_MMA(1, 0, At, B0); PG8_BAR; PG8_SCHED;
            PG8_STAGE(PG8_SB(1, 1), b3 + hstep, voffB);
            PG8_WAIT_V(6); PG8_BAR; PG8_MMA(1, 1, At, B1); PG8_BAR;
            }
        }
        if constexpr (ALIGN_EPI) { if (wr == 0) PG8_BAR; }
        if constexpr (!Epi::AFTER_DRAIN) { E(acc, cur, wr, wc, fr, fq); S.done(cur); }
        if (!has_next) break;
#pragma unroll
        for (int a = 0; a < 2; ++a)
#pragma unroll
            for (int b = 0; b < 2; ++b)
#pragma unroll
                for (int m = 0; m < 4; ++m)
#pragma unroll
                    for (int n = 0; n < 2; ++n) acc[a][b][m][n] = (f32x4){0.f, 0.f, 0.f, 0.f};
        cur = nxt; cA = nA; cB = nB; ++ui;
        if constexpr (ALIGN_EPI) { if (wr == 1) PG8_BAR; }
    }
    PG8_WAIT_V(0);
    if constexpr (!ALIGN_EPI) { if (wr == 0) PG8_BAR; }
    PG8_BAR;
    if constexpr (Epi::AFTER_DRAIN) { E.fused(acc, cur, wr, wc, fr, fq, lds, wid, lane); S.done(cur); }
#undef PG8_SA
#undef PG8_SB
#undef PG8_STAGE
#undef PG8_LDA
#undef PG8_LDB
#undef PG8_MMA
#undef PG8_WAIT_V
#undef PG8_WAIT_L
#undef PG8_BAR
#undef PG8_SCHED
}
}

#include <hip/hip_bf16.h>
#include <cmath>
namespace attn_body {
using bf16=__hip_bfloat16;
using bf16x8=__attribute__((ext_vector_type(8)))short;
using s16x4=__attribute__((ext_vector_type(4)))short;
using f32x16=__attribute__((ext_vector_type(16)))float;
using u32x4=__attribute__((ext_vector_type(4)))unsigned;
constexpr int SEQ=16384,D=64,LDP=3072,LDO=1024;
constexpr int NW=8,QBLK=32,QB=QBLK*NW,KVBLK=64,NQB=SEQ/QB;
constexpr int ATTN_UNIT_ROWS=QB;
__device__ __forceinline__ int crow(int r,int hi){return (r&3)+8*(r>>2)+4*hi;}
#define SBAR() __builtin_amdgcn_sched_barrier(0)
__device__ __forceinline__ void cmask(f32x16&p0,f32x16&p1,int jb,int qrel,int hi){
  const float NEG=-INFINITY; int kb=64*jb+4*hi;
  #pragma unroll
  for(int r=0;r<16;++r){int kv=kb+(r&3)+8*(r>>2); if(kv>qrel)p0[r]=NEG; if(kv+32>qrel)p1[r]=NEG;}
}

constexpr int NSLOT=3, SLOTB=8192, VSLOTB=2*SLOTB;
constexpr int LDS_K=0, LDS_V=NSLOT*SLOTB, LDS_WS=LDS_V+NSLOT*VSLOTB, LDS_OST=0  , LDS_BYTES=LDS_WS+NW*64*4;
constexpr float C2=0.125f*1.4426950408889634f;
__device__ __forceinline__ void glds16(const void*gsrc,unsigned lds_dst){unsigned keep;
  asm volatile("s_mov_b32 %0, m0\n\ts_mov_b32 m0, %2\n\ts_nop 0\n\tglobal_load_lds_dwordx4 %1, off\n\ts_mov_b32 m0, %0":"=&s"(keep):"v"(gsrc),"s"(lds_dst):"memory");}
__device__ __forceinline__ float max3f(float a,float b,float c){float r;asm("v_max3_f32 %0, %1, %2, %3":"=v"(r):"v"(a),"v"(b),"v"(c));return r;}
__device__ __forceinline__ float max2f(float a,float b){float r;asm("v_max_f32_e32 %0, %1, %2":"=v"(r):"v"(a),"v"(b));return r;}
__device__ __forceinline__ float fadd_s(float a,float b){float r;asm("v_add_f32_e32 %0, %1, %2":"=v"(r):"v"(a),"v"(b));return r;}
__device__ __forceinline__ float fsub_s(float a,float b){float r;asm("v_sub_f32_e32 %0, %1, %2":"=v"(r):"v"(a),"v"(b));return r;}
typedef float f32x2_t __attribute__((ext_vector_type(2))); typedef __bf16 bf16x2_t __attribute__((ext_vector_type(2)));
__device__ __forceinline__ unsigned cvtpk_s(float lo,float hi){f32x2_t v={lo,hi};bf16x2_t b=__builtin_convertvector(v,bf16x2_t);return __builtin_bit_cast(unsigned,b);}
#define WAIT_BAR(N) asm volatile("s_waitcnt vmcnt(" #N ") lgkmcnt(0)\n\ts_barrier":::"memory")

__device__ __forceinline__ void qkt(f32x16&p0,f32x16&p1,const char*Kslot,const bf16x8*qr,int r32,int hi){
  const char*kb=Kslot+hi*1024+r32*16;
  #pragma unroll
  for(int d0=0;d0<4;++d0){
    const bf16x8 b0=*reinterpret_cast<const bf16x8*>(kb+d0*2048);
    const bf16x8 b1=*reinterpret_cast<const bf16x8*>(kb+d0*2048+512);
    if(d0==0){p0=__builtin_amdgcn_mfma_f32_32x32x16_bf16(b0,qr[0],f32x16{},0,0,0);p1=__builtin_amdgcn_mfma_f32_32x32x16_bf16(b1,qr[0],f32x16{},0,0,0);}
    else{p0=__builtin_amdgcn_mfma_f32_32x32x16_bf16(b0,qr[d0],p0,0,0,0);p1=__builtin_amdgcn_mfma_f32_32x32x16_bf16(b1,qr[d0],p1,0,0,0);}}
}
typedef __attribute__((address_space(3))) const char* lds_cptr;
typedef short v4i16_t __attribute__((ext_vector_type(4)));
__device__ __forceinline__ void kload8(bf16x8*kf,lds_cptr kp){
  kf[0]=*(const __attribute__((address_space(3))) bf16x8*)(kp);      kf[1]=*(const __attribute__((address_space(3))) bf16x8*)(kp+512);
  kf[2]=*(const __attribute__((address_space(3))) bf16x8*)(kp+2048); kf[3]=*(const __attribute__((address_space(3))) bf16x8*)(kp+2560);
  kf[4]=*(const __attribute__((address_space(3))) bf16x8*)(kp+4096); kf[5]=*(const __attribute__((address_space(3))) bf16x8*)(kp+4608);
  kf[6]=*(const __attribute__((address_space(3))) bf16x8*)(kp+6144); kf[7]=*(const __attribute__((address_space(3))) bf16x8*)(kp+6656);
}
__device__ __forceinline__ void kload2(bf16x8*kf,lds_cptr kp,int j){ kf[2*j]=*(const __attribute__((address_space(3))) bf16x8*)(kp+j*2048); kf[2*j+1]=*(const __attribute__((address_space(3))) bf16x8*)(kp+j*2048+512); }
__device__ __forceinline__ s16x4 vtr(lds_cptr p){ return __builtin_bit_cast(s16x4,__builtin_amdgcn_ds_read_tr16_b64_v4i16((__attribute__((address_space(3))) v4i16_t*)p)); }
__device__ __forceinline__ float rowmax(const f32x16&p0,const f32x16&p1){
  float a=max3f(p0[0],p0[1],p1[0]),b=max3f(p0[2],p0[3],p1[1]);a=max3f(a,p1[2],p1[3]);
  #pragma unroll
  for(int r=4;r<16;r+=4){a=max3f(a,p0[r],p0[r+1]);b=max3f(b,p0[r+2],p0[r+3]);a=max3f(a,p1[r],p1[r+1]);b=max3f(b,p1[r+2],p1[r+3]);}
  const float m=max2f(a,b);
  auto rr=__builtin_amdgcn_permlane32_swap(__float_as_uint(m),__float_as_uint(m),false,false);
  return max2f(__uint_as_float(rr[0]),__uint_as_float(rr[1]));
}
__device__ __forceinline__ void pv(f32x16*o,int vb,bf16x8 pa0,bf16x8 pa1,bf16x8 pa2,bf16x8 pa3){
  #pragma unroll
  for(int d0=0;d0<4;++d0){s16x4 lo[4],hi[4];
    #pragma unroll
    for(int ks=0;ks<4;++ks){
      asm volatile("ds_read_b64_tr_b16 %0,%1 offset:%c2":"=&v"(lo[ks]):"v"(vb),"i"(d0*4096+ks*1024):"memory");
      asm volatile("ds_read_b64_tr_b16 %0,%1 offset:%c2":"=&v"(hi[ks]):"v"(vb),"i"(d0*4096+ks*1024+512):"memory");}
    asm volatile("s_waitcnt lgkmcnt(0)":::"memory");SBAR();
    #define PK(k) (bf16x8){lo[k][0],lo[k][1],lo[k][2],lo[k][3],hi[k][0],hi[k][1],hi[k][2],hi[k][3]}
    o[d0]=__builtin_amdgcn_mfma_f32_32x32x16_bf16(pa0,PK(0),o[d0],0,0,0);
    o[d0]=__builtin_amdgcn_mfma_f32_32x32x16_bf16(pa1,PK(1),o[d0],0,0,0);
    o[d0]=__builtin_amdgcn_mfma_f32_32x32x16_bf16(pa2,PK(2),o[d0],0,0,0);
    o[d0]=__builtin_amdgcn_mfma_f32_32x32x16_bf16(pa3,PK(3),o[d0],0,0,0);
    #undef PK
  }
}

#ifndef ATTN_STORE16
#define ATTN_STORE16(p,v) (*(u32x4*)(p)=(v))
#endif
template<int THRL> __device__ __forceinline__ void attn_unit(int qb,const bf16*Qh,const bf16*__restrict__ Kh,const bf16*__restrict__ Vh,bf16*Oh,char*shm){
  int tid_=threadIdx.x; asm volatile("":"+v"(tid_));
  const int tid=tid_,lane=tid&63,r32=lane&31,hi=lane>>5; const int wid=__builtin_amdgcn_readfirstlane(tid>>6);
  const int q0=qb*QB;
  const bf16*Qw=Qh+(long)(q0+wid*QBLK)*LDP;
  const unsigned lds0=(unsigned)(uintptr_t)shm;
  float*wsf=(float*)(shm+LDS_WS)+wid*64;
  const bf16*ksrc=Kh+(long)lane*LDP+wid*8;
  const bf16*vsrc=Vh+(long)(16*(wid&3)+(lane>>2))*LDP+(wid>>2)*32+(lane&3)*8;
  const unsigned kdst=lds0+LDS_K+wid*1024, vdst=lds0+LDS_V+wid*1024;
  #define DMA_K(t,slot) glds16(ksrc+(long)(t)*KVBLK*LDP,(unsigned)__builtin_amdgcn_readfirstlane(kdst+(slot)))
  #define DMA_V(t,slot) do{ glds16(vsrc+(long)(t)*KVBLK*LDP,(unsigned)__builtin_amdgcn_readfirstlane(vdst+2*(slot))); glds16(vsrc+64+(long)(t)*KVBLK*LDP,(unsigned)__builtin_amdgcn_readfirstlane(vdst+2*(slot)+8192)); }while(0)
  const int vb0=(int)(lds0+LDS_V)+((lane>>4)&1)*32+(lane&3)*8+(4*hi+((lane&15)>>2))*64;
  const char*Kbase=shm+LDS_K; bf16x8 kf[8];
  const lds_cptr shm3=(lds_cptr)shm; const lds_cptr kp0=shm3+LDS_K+hi*1024+r32*16; const lds_cptr vp0=shm3+LDS_V+((lane>>4)&1)*32+(lane&3)*8+(4*hi+((lane&15)>>2))*64;
  const int NT=(q0+QB)/KVBLK;
  DMA_K(0,0);DMA_V(0,0);DMA_K(1,SLOTB);
  bf16x8 qr[4];
  #pragma unroll
  for(int d0=0;d0<4;++d0)qr[d0]=*reinterpret_cast<const bf16x8*>(&Qw[(long)r32*LDP+d0*16+hi*8]);
  float mhat=0.f,l_reg=0.f;f32x16 o[4];o[0]=f32x16{};o[1]=f32x16{};o[2]=f32x16{};o[3]=f32x16{};
  const int qrel=wid*QBLK+r32;
  #define CMASK(P0,P1,t) do{int jb_=(t)-(NT-4); if(jb_>=0)cmask(P0,P1,jb_,qrel,hi);}while(0)
  bool resc=false;
  #define START(P0,P1) do{ const float rm=rowmax(P0,P1); resc=false; mhat=rm; \
    _Pragma("unroll") for(int r=0;r<16;++r)P0[r]=__builtin_amdgcn_exp2f(fsub_s(P0[r],mhat)); }while(0)
  #define RESC() do{ if(resc){ asm volatile("s_waitcnt lgkmcnt(0)":::"memory"); \
      _Pragma("unroll") for(int d_=0;d_<4;++d_) _Pragma("unroll") for(int r=0;r<16;++r)o[d_][r]*=wsf[crow(r,hi)]; } }while(0)
  f32x16 pA0,pA1,pB0,pB1;
  int sl_prev=0,sl_cur=0,sl_next=SLOTB;
  #define ROT() do{sl_prev=sl_cur;sl_cur=sl_next;sl_next=(sl_next==(NSLOT-1)*SLOTB)?0:sl_next+SLOTB;}while(0)
  DMA_K(2,2*SLOTB);
  WAIT_BAR(4);
  qkt(pA0,pA1,Kbase,qr,r32,hi);asm volatile("s_nop 15\n\ts_nop 7":"+v"(pA0),"+v"(pA1));CMASK(pA0,pA1,0);
  START(pA0,pA1);
  _Pragma("unroll") for(int r=0;r<16;++r)pA1[r]=__builtin_amdgcn_exp2f(pA1[r]-mhat);
  WAIT_BAR(0);
  DMA_K(3,0);DMA_V(1,SLOTB);
  ROT();
  kload8(kf,kp0+sl_cur);
  WAIT_BAR(3);
  s16x4 vlo[3],vhi[3]; u32x4 pw0,pw1,pw2,pw3;
  #define PKW(P,B) cvtpk_s(P[B],P[B+1])
  #define PAF(k) __builtin_bit_cast(bf16x8,pw##k)
  #define VFJ(j) (bf16x8){vlo[(j)%3][0],vlo[(j)%3][1],vlo[(j)%3][2],vlo[(j)%3][3],vhi[(j)%3][0],vhi[(j)%3][1],vhi[(j)%3][2],vhi[(j)%3][3]}
  #define PIN(x) asm volatile("":"+v"(x))
  #define MX3(a,b,c) __builtin_fmaxf(__builtin_fmaxf((a),(b)),(c))
  #define GAPA(MF,A0,A1,A2,A3,W0,W1,PW) do{ MF; sacc+=A0; sacc+=A1; sacc+=A2; sacc+=A3; PIN(sacc); W0; W1; PIN(PW); SBAR(); }while(0)
  #define EX(v) __builtin_amdgcn_exp2f(v)
  #define VJ(j) do{ vlo[(j)%3]=vtr(vp_+(((j)&3)*4096+((j)>>2)*1024)); vhi[(j)%3]=vtr(vp_+(((j)&3)*4096+((j)>>2)*1024+512)); }while(0)
  #define PVJ(j,PA,X,B) do{ if((j)+2<16){ VJ((j)+2); SBAR(); } o[(j)&3]=__builtin_amdgcn_mfma_f32_32x32x16_bf16(PA,VFJ(j),o[(j)&3],0,0,0); X[B]=EX(X[B]-mhat); X[B+1]=EX(X[B+1]-mhat); PIN(X); SBAR(); }while(0)
  #define KRD(G,j) do{ if(G){ kload2(kf,kp0+sl_next,j); SBAR(); } }while(0)
  #define STEP(C0,C1,P0,P1,t,GK,GV,GL) do{ SBAR(); \
    const lds_cptr vp_=vp0+2*sl_prev; \
    float sacc=(P0[0]+P0[1]); \
    GAPA(C0=__builtin_amdgcn_mfma_f32_32x32x16_bf16(kf[0],qr[0],f32x16{},0,0,0), P0[2],P0[3],P0[4],P0[5],     pw0[0]=PKW(P0,0), pw0[1]=PKW(P0,2), pw0); \
    GAPA(C1=__builtin_amdgcn_mfma_f32_32x32x16_bf16(kf[1],qr[0],f32x16{},0,0,0), P0[6],P0[7],P0[8],P0[9],     pw0[2]=PKW(P0,4), pw0[3]=PKW(P0,6), pw0); \
    GAPA(C0=__builtin_amdgcn_mfma_f32_32x32x16_bf16(kf[2],qr[1],C0,0,0,0),   P0[10],P0[11],P0[12],P0[13], pw1[0]=PKW(P0,8), pw1[1]=PKW(P0,10), pw1); \
    GAPA(C1=__builtin_amdgcn_mfma_f32_32x32x16_bf16(kf[3],qr[1],C1,0,0,0),   P0[14],P0[15],P1[0],P1[1],   pw1[2]=PKW(P0,12),pw1[3]=PKW(P0,14), pw1); \
    GAPA(C0=__builtin_amdgcn_mfma_f32_32x32x16_bf16(kf[4],qr[2],C0,0,0,0),   P1[2],P1[3],P1[4],P1[5],     pw2[0]=PKW(P1,0), pw2[1]=PKW(P1,2), pw2); \
    GAPA(C1=__builtin_amdgcn_mfma_f32_32x32x16_bf16(kf[5],qr[2],C1,0,0,0),   P1[6],P1[7],P1[8],P1[9],     pw2[2]=PKW(P1,4), pw2[3]=PKW(P1,6), pw2); \
    GAPA(C0=__builtin_amdgcn_mfma_f32_32x32x16_bf16(kf[6],qr[3],C0,0,0,0),   P1[10],P1[11],P1[12],P1[13], pw3[0]=PKW(P1,8), pw3[1]=PKW(P1,10), pw3); \
    GAPA(C1=__builtin_amdgcn_mfma_f32_32x32x16_bf16(kf[7],qr[3],C1,0,0,0),   P1[14],P1[15],0.f,0.f,       pw3[2]=PKW(P1,12),pw3[3]=PKW(P1,14), pw3); \
    l_reg+=sacc; VJ(0); VJ(1); SBAR(); \
 \
    if(GK){DMA_K((t)+3,sl_cur);} if(GV){DMA_V((t)+1,sl_next);} \
    CMASK(C0,C1,t); \
    { float a=MX3(C0[0],C0[1],C1[0]),b=MX3(C0[2],C0[3],C1[1]); a=MX3(a,C1[2],C1[3]); \
      _Pragma("unroll") for(int r=4;r<16;r+=4){a=MX3(a,C0[r],C0[r+1]);b=MX3(b,C0[r+2],C0[r+3]);a=MX3(a,C1[r],C1[r+1]);b=MX3(b,C1[r+2],C1[r+3]);} \
      float rm=__builtin_fmaxf(a,b); { auto rr=__builtin_amdgcn_permlane32_swap(__float_as_uint(rm),__float_as_uint(rm),false,false); rm=__builtin_fmaxf(__uint_as_float(rr[0]),__uint_as_float(rr[1])); } \
      resc=false; const float rel=rm-mhat; \
      if(__builtin_expect(__any(rel>(float)THRL),0)){ const float dl=__builtin_fmaxf(rel,0.f); mhat+=dl; \
        const float f=__builtin_amdgcn_exp2f(-dl); l_reg*=f; if(hi==0)wsf[r32]=f; resc=true; } } \
    SBAR(); \
    PVJ(0, PAF(0),C0,0);  PVJ(1, PAF(0),C0,2);  PVJ(2, PAF(0),C0,4);  PVJ(3, PAF(0),C0,6); \
    KRD(GL,0); PVJ(4, PAF(1),C0,8);  PVJ(5, PAF(1),C0,10); KRD(GL,1); PVJ(6, PAF(1),C0,12); PVJ(7, PAF(1),C0,14); \
    KRD(GL,2); PVJ(8, PAF(2),C1,0);  PVJ(9, PAF(2),C1,2);  KRD(GL,3); PVJ(10,PAF(2),C1,4);  PVJ(11,PAF(2),C1,6); \
    PVJ(12,PAF(3),C1,8);  PVJ(13,PAF(3),C1,10); PVJ(14,PAF(3),C1,12); PVJ(15,PAF(3),C1,14); \
    }while(0)
  int t=1;
  #undef CMASK
  #define CMASK(P0,P1,t) do{}while(0)
  for(;t+5<NT;t+=2){
    STEP(pB0,pB1,pA0,pA1,t,true,true,true);     WAIT_BAR(3); RESC(); ROT();
    STEP(pA0,pA1,pB0,pB1,t+1,true,true,true);   WAIT_BAR(3); RESC(); ROT();
  }
  #undef CMASK
  int hi_b=hi,qrel_b=qrel; asm volatile("":"+v"(hi_b),"+v"(qrel_b));
  #define CMASK(P0,P1,t) do{int jb_=(t)-(NT-4); if(jb_>=0)cmask(P0,P1,jb_,qrel_b,hi_b);}while(0)
  #define ENDW(tt) do{ if((tt)+3<NT){WAIT_BAR(3);} else if((tt)+2<NT){WAIT_BAR(2);} else {WAIT_BAR(0);} }while(0)
  for(;t+1<NT;t+=2){
    STEP(pB0,pB1,pA0,pA1,t,(t+3<NT),(t+1<NT),(t+1<NT));       ENDW(t);   RESC(); ROT();
    STEP(pA0,pA1,pB0,pB1,t+1,(t+4<NT),(t+2<NT),(t+2<NT));     ENDW(t+1); RESC(); ROT();
  }
  STEP(pB0,pB1,pA0,pA1,NT-1,false,false,false); RESC();
  { float sacc=pB0[0]+pB0[1]; _Pragma("unroll") for(int r=2;r<16;++r)sacc+=pB0[r]; _Pragma("unroll") for(int r=0;r<16;++r)sacc+=pB1[r]; l_reg+=sacc;
    pw0=(u32x4){PKW(pB0,0),PKW(pB0,2),PKW(pB0,4),PKW(pB0,6)};pw1=(u32x4){PKW(pB0,8),PKW(pB0,10),PKW(pB0,12),PKW(pB0,14)};pw2=(u32x4){PKW(pB1,0),PKW(pB1,2),PKW(pB1,4),PKW(pB1,6)};pw3=(u32x4){PKW(pB1,8),PKW(pB1,10),PKW(pB1,12),PKW(pB1,14)};
    SBAR(); pv(o,vb0+2*sl_cur,PAF(0),PAF(1),PAF(2),PAF(3)); }
  #undef PKW
  #undef PAF
  #undef VFJ
  #undef VJ
  #undef PVJ
  #undef PIN
  #undef MX3
  #undef GAPA
  #undef EX
  #undef KRD
  #undef STEP
  #undef ENDW
  int lanee=lane; asm volatile("":"+v"(lanee)); const int r32e=lanee&31,hie=lanee>>5;
  {auto rr=__builtin_amdgcn_permlane32_swap(__float_as_uint(l_reg),__float_as_uint(l_reg),false,false);l_reg=__uint_as_float(rr[0])+__uint_as_float(rr[1]);}
  if(hie==0)wsf[32+r32e]=l_reg;asm volatile("s_waitcnt lgkmcnt(0)":::"memory");
  float rli[16];
  #pragma unroll
  for(int r=0;r<16;++r)rli[r]=__builtin_amdgcn_rcpf(wsf[32+crow(r,hie)]);
  bf16*Ow=Oh+(long)(q0+wid*QBLK)*LDO;
  asm volatile("s_waitcnt lgkmcnt(0)\n\ts_barrier":::"memory");
  { bf16*stg=(bf16*)(shm)+wid*4096;
    #pragma unroll
    for(int r=0;r<16;++r){const int orow=crow(r,hie);
      #pragma unroll
      for(int d0=0;d0<4;++d0)stg[orow*128+d0*32+r32e]=__float2bfloat16(o[d0][r]*rli[r]);}
    asm volatile("s_waitcnt lgkmcnt(0)":::"memory");
    #pragma unroll
    for(int i=0;i<8;++i){const int row=i*4+(lanee>>4),ch=lanee&15; const u32x4 v=*(const u32x4*)(stg+row*128+ch*8); ATTN_STORE16(Ow+(long)row*LDO+ch*8,v);} }
  asm volatile("s_waitcnt lgkmcnt(0)\n\ts_barrier":::"memory");
  #undef DMA_K
  #undef DMA_V
  #undef CMASK
  #undef START
  #undef RESC
  #undef ROT
}
constexpr int ATTN_LDS_BYTES=LDS_BYTES;
template<int THRL=8> __device__ __forceinline__ void attn_phase(char*lds,const bf16*PE,bf16*AO,int vcu,int G){
  const int nu=(G==256)?2:((8*NQB-vcu+G-1)/G);
  #pragma unroll 1
  for(int i=0;i<nu;++i){
    int h2,qb;
    if(G==256){ const int s=vcu&31; h2=vcu>>5; qb=(i==0)?s:63-s; }
    else { const int u=vcu+i*G; h2=u/NQB; qb=u%NQB; }
    attn_unit<THRL>(qb,PE+h2*64,PE+512+h2*64,PE+1024+(h2>>1)*128,AO+h2*128,lds);
  }
}
#undef SBAR
#undef WAIT_BAR
}

#define GAS __attribute__((address_space(1)))
#define LAS __attribute__((address_space(3)))
typedef unsigned short bf16;
typedef unsigned v4u __attribute__((ext_vector_type(4)));
typedef float f32x4 __attribute__((ext_vector_type(4)));
typedef short bf16x8 __attribute__((ext_vector_type(8)));
typedef GAS unsigned gu32;
typedef GAS unsigned long long gu64;
#define RLX_AGENT __ATOMIC_RELAXED, __HIP_MEMORY_SCOPE_AGENT
#define LDS_WAIT() asm volatile("s_waitcnt lgkmcnt(0)" ::: "memory")
#define VM_WAIT() asm volatile("s_waitcnt vmcnt(0)" ::: "memory")
__device__ __forceinline__ unsigned long long rt() { return __builtin_amdgcn_s_memrealtime(); }
__device__ __forceinline__ unsigned f2bf(float f) { unsigned u = __builtin_bit_cast(unsigned, f); return (u + 0x7fffu + ((u >> 16) & 1u)) >> 16; }
__device__ __forceinline__ unsigned pk2(float lo, float hi) { return f2bf(lo) | (f2bf(hi) << 16); }

#define XB_TMO      128
#define XB_XCNT(j)  (256  + 64 * (j))
#define XB_XSUB(j)  (1280 + 64 * (j))
#define XB_XGEN(j)  (2304 + 64 * (j))
#define XB_TOP      3328
#define XB_TOPGEN   3392
#define XCD_BAR_WORDS 3456
#define XB_SPIN_CAP (1u << 18)

__device__ __forceinline__ unsigned xb_ld(unsigned* p)              { return __hip_atomic_load(p, __ATOMIC_RELAXED, __HIP_MEMORY_SCOPE_AGENT); }
__device__ __forceinline__ unsigned xb_add(unsigned* p, unsigned v) { return __hip_atomic_fetch_add(p, v, __ATOMIC_RELAXED, __HIP_MEMORY_SCOPE_AGENT); }
__device__ __forceinline__ unsigned xb_xcc_id() { return (unsigned)__builtin_amdgcn_s_getreg((3 << 11) | 20) & 0xFu; }
#define XB_SPIN(cond, bar) do { unsigned _sp = 0; while (cond) { __builtin_amdgcn_s_sleep(1); \
    if ((++_sp & 255u) == 0u) { if (xb_ld(&(bar)[XB_TMO])) break; if (_sp > XB_SPIN_CAP) { atomicAdd(&(bar)[XB_TMO], 1u); break; } } } } while (0)

struct XcdBarrier {
    unsigned* bar; unsigned x;
    volatile LAS unsigned* st;
};

__device__ __forceinline__ XcdBarrier xcd_barrier_post(unsigned* bar, volatile LAS unsigned* st) {
    XcdBarrier b; b.bar = bar; b.x = xb_xcc_id(); b.st = st;
    if (threadIdx.x == 0) (void)xb_add(&bar[XB_XCNT(b.x)], 1u);
    return b;
}
__device__ __forceinline__ void xcd_barrier_complete(unsigned* bar, unsigned x, unsigned& nloc, unsigned& nx) {
    const unsigned G = gridDim.x * gridDim.y * gridDim.z;
    unsigned sum, cnt, mine, sp = 0u;
    for (;;) {
        sum = 0u; cnt = 0u; mine = 0u;
#pragma unroll
        for (unsigned j = 0; j < 16; ++j) { const unsigned c = xb_ld(&bar[XB_XCNT(j)]); sum += c; cnt += (c > 0u) ? 1u : 0u; mine = (j == x) ? c : mine; }
        if (sum == G) break;
        __builtin_amdgcn_s_sleep(1);
        if ((++sp & 255u) == 0u) { if (xb_ld(&bar[XB_TMO])) break; if (sp > XB_SPIN_CAP) { atomicAdd(&bar[XB_TMO], 1u); break; } }
    }
    nloc = mine > 0u ? mine : 1u; nx = cnt > 0u ? cnt : 1u;
}

__device__ __forceinline__ void xcd_barrier(const XcdBarrier& b) {
    asm volatile("s_waitcnt vmcnt(0)" ::: "memory");
    __syncthreads();
    if (threadIdx.x == 0) {
        unsigned* bar = b.bar;
        __builtin_amdgcn_s_waitcnt(0);
        unsigned nloc = b.st[0], nx = b.st[1];
        if (nloc == 0u) { xcd_barrier_complete(bar, b.x, nloc, nx); b.st[0] = nloc; b.st[1] = nx; }
        const unsigned old = xb_add(&bar[XB_XSUB(b.x)], 1u);
        const unsigned gen = old / nloc;
        if (old + 1u == (gen + 1u) * nloc) {
            __builtin_amdgcn_fence(__ATOMIC_RELEASE, "agent");
            asm volatile("s_waitcnt vmcnt(0)" ::: "memory");
            const unsigned og = xb_add(&bar[XB_TOP], 1u);
            const unsigned tg = og / nx;
            if (og + 1u == (tg + 1u) * nx) xb_add(&bar[XB_TOPGEN], 1u);
            else XB_SPIN(xb_ld(&bar[XB_TOPGEN]) == tg, bar);
            __builtin_amdgcn_fence(__ATOMIC_ACQUIRE, "agent");
            xb_add(&bar[XB_XGEN(b.x)], 1u);
            asm volatile("s_waitcnt vmcnt(0)" ::: "memory");
        } else {
            XB_SPIN(xb_ld(&bar[XB_XGEN(b.x)]) == gen, bar);
            __builtin_amdgcn_fence(__ATOMIC_ACQUIRE, "agent");
            asm volatile("s_waitcnt vmcnt(0)" ::: "memory");
        }
    }
    __syncthreads();
}

constexpr int NWAVES = 8;
constexpr size_t MiB = 1u << 20;
constexpr size_t WS_CTL = 0, CTL_ZERO_BYTES = 1 * MiB;
constexpr size_t WS_TAB = 1 * MiB;
constexpr size_t WS_SSQA = 2 * MiB, WS_SSQB = 3 * MiB;
constexpr size_t WS_GB = 4 * MiB;
constexpr size_t WS_GC = 512 * 1024;
constexpr size_t WS_TOK = 5 * MiB;
constexpr size_t WS_W = 6 * MiB;
constexpr size_t WS_WINE = WS_W, WS_WOUTE = WS_W + 12 * MiB, WS_W13D = WS_W + 16 * MiB, WS_W2D = WS_W + 44 * MiB, WS_WINO = WS_W + 58 * MiB, WS_WOUTO = WS_W + 74 * MiB,
                 WS_WG = WS_W + 78 * MiB, WS_WP = WS_W + 86 * MiB, WS_W13M = WS_W + 88 * MiB, WS_W2M = WS_W + 200 * MiB;
constexpr size_t WS_PBF = 262 * MiB, WS_HBF = 294 * MiB, WS_PP = 326 * MiB, WS_MIX = 358 * MiB, WS_ARENA = 390 * MiB;
constexpr size_t AR_PE = 0, AR_AO = 96 * MiB;
constexpr size_t AR_PO = 0, AR_QN = 128 * MiB, AR_QT = 160 * MiB, AR_KN = 192 * MiB, AR_KGT = 224 * MiB, AR_VBT = 256 * MiB, AR_KTT = 288 * MiB, AR_AI = 320 * MiB, AR_NEGW = 336 * MiB,
                 AR_UT = 368 * MiB, AR_MP = 400 * MiB, AR_NT = 464 * MiB, AR_WT = 528 * MiB, AR_SG = 192 * MiB  , AR_MPC = 400 * MiB  , AR_NTC = 416 * MiB, AR_END = 560 * MiB;
constexpr size_t AR_ACT = 0, AR_XS = 240 * MiB, AR_Y = 308 * MiB;
constexpr size_t WS_NEED = WS_ARENA + AR_END;
constexpr size_t TOK_E = 0, TOK_R = 128 * 1024, TOK_G = 256 * 1024, TOK_DST = 384 * 1024, TOK_GPAD = 512 * 1024, TOK_DN = 704 * 1024, TOK_DNC = 720 * 1024;
constexpr int CW_TMO = 0, CW_BAR = 4096, CW_CNT = 8192  , CW_DBG = 12288;

constexpr int RING_OFF = 0, WAVE_LDS = 17408;
constexpr int LDSCTL_OFF = 139264, MISC_OFF = LDSCTL_OFF + 64, BLKE_OFF = LDSCTL_OFF + 256  , RT_OFF = LDSCTL_OFF + 1024  ;
constexpr int LDS_BYTES = 147456;

typedef unsigned u32x2v __attribute__((ext_vector_type(2)));
__device__ __forceinline__ float bflo(unsigned w) { return __uint_as_float(w << 16); }
__device__ __forceinline__ float bfhi(unsigned w) { return __uint_as_float(w & 0xffff0000u); }
__device__ __forceinline__ unsigned cvtpk(float lo, float hi) { return pg8::cvt_pk_bf16_cv(lo, hi); }
__device__ __forceinline__ float wave_sum(float v) {
#pragma unroll
    for (int o = 1; o < 64; o <<= 1) v += __shfl_xor(v, o);
    return v;
}
__device__ __forceinline__ float sigm(float x) { return pg8::sigmoidf_(x); }
__device__ __forceinline__ float silu(float x) { return x * pg8::sigmoidf_(x); }

struct Args { const void* in[30]; float* out; unsigned char* ws; int ph_lo, ph_hi, use_bar, pad; };

struct Frame {
    LAS unsigned char* lds; int tid, lane, wave, vcu, G, gw, NGW;
};

__device__ __forceinline__ void xpose_item(const float* W, int ldw, int K, int N, const float* gain, bf16* WT, int ilv, LAS float* scr, int item, int lane) {
    const int nblk = N / 64, kb = item / nblk, nb = item % nblk, k0 = 64 * kb, n0 = 64 * nb;
    const int lr = lane >> 4, lc = (lane & 15) * 4;
    f32x4 v[16];
#pragma unroll
    for (int i = 0; i < 16; ++i) v[i] = *(const GAS f32x4*)(W + (size_t)(k0 + 4 * i + lr) * ldw + n0 + lc);
    if (gain) {
#pragma unroll
        for (int i = 0; i < 16; ++i) v[i] = v[i] * gain[k0 + 4 * i + lr]; }
#pragma unroll
    for (int i = 0; i < 16; ++i) { LAS float* s = scr + (4 * i + lr) * 65 + lc; s[0] = v[i][0]; s[1] = v[i][1]; s[2] = v[i][2]; s[3] = v[i][3]; }
    LDS_WAIT(); asm volatile("" ::: "memory");
    const int c = lane & 7;
#pragma unroll
    for (int j = 0; j < 8; ++j) { const int nl = (lane >> 3) + 8 * j, n = n0 + nl; const LAS float* s = scr + (8 * c) * 65 + nl;
        const int dr = ilv ? (((n >> 7) << 8) + (n & 127) + (ilv == 2 ? 128 : 0)) : n;
        v4u o; o.x = pk2(s[0 * 65], s[1 * 65]); o.y = pk2(s[2 * 65], s[3 * 65]); o.z = pk2(s[4 * 65], s[5 * 65]); o.w = pk2(s[6 * 65], s[7 * 65]);
        *(GAS v4u*)(WT + (size_t)dr * K + k0 + 8 * c) = o; }
    LDS_WAIT(); asm volatile("" ::: "memory");
}
struct MatD { const float* W; int ldw, K, N; const float* gain; bf16* WT; int ilv; int items; };
__device__ __forceinline__ MatD dense_mat(const Args& a, int id) {
    unsigned char* ws = a.ws; MatD m; m.gain = nullptr; m.ilv = 0;
    if (id < 2)       { const int j = id;      m.W = (const float*)a.in[7] + (size_t)j * D_ * EIN;    m.ldw = EIN; m.K = D_; m.N = EIN; m.gain = (const float*)a.in[3] + (2 * j) * D_; m.WT = (bf16*)(ws + WS_WINE) + (size_t)j * EIN * D_; }
    else if (id < 4)  { const int j = id - 2;  m.W = (const float*)a.in[8] + (size_t)j * D_ * D_;     m.ldw = D_; m.K = D_; m.N = D_; m.WT = (bf16*)(ws + WS_WOUTE) + (size_t)j * D_ * D_; }
    else if (id < 6)  { const int j = id - 4;  m.W = (const float*)a.in[21] + (size_t)j * D_ * DFF;   m.ldw = DFF; m.K = D_; m.N = DFF; m.gain = (const float*)a.in[4] + (2 * j) * D_; m.WT = (bf16*)(ws + WS_W13D) + (size_t)j * 2 * DFF * D_; m.ilv = 1; }
    else if (id < 8)  { const int j = id - 6;  m.W = (const float*)a.in[22] + (size_t)j * D_ * DFF;   m.ldw = DFF; m.K = D_; m.N = DFF; m.gain = (const float*)a.in[4] + (2 * j) * D_; m.WT = (bf16*)(ws + WS_W13D) + (size_t)j * 2 * DFF * D_; m.ilv = 2; }
    else if (id < 10) { const int j = id - 8;  m.W = (const float*)a.in[23] + (size_t)j * DFF * D_;   m.ldw = D_; m.K = DFF; m.N = D_; m.WT = (bf16*)(ws + WS_W2D) + (size_t)j * D_ * DFF; }
    else if (id < 12) { const int j = id - 10; m.W = (const float*)a.in[15] + (size_t)j * D_ * OIN_SRC; m.ldw = OIN_SRC; m.K = D_; m.N = OIN; m.gain = (const float*)a.in[3] + (2 * j + 1) * D_; m.WT = (bf16*)(ws + WS_WINO) + (size_t)j * OIN * D_; }
    else if (id < 14) { const int j = id - 12; m.W = (const float*)a.in[20] + (size_t)j * D_ * D_;    m.ldw = D_; m.K = D_; m.N = D_; m.WT = (bf16*)(ws + WS_WOUTO) + (size_t)j * D_ * D_; }
    else if (id < 18) { const int i = id - 14; m.W = (const float*)a.in[28] + (size_t)i * D_ * D_;    m.ldw = D_; m.K = D_; m.N = D_; m.gain = (const float*)a.in[5] + i * D_; m.WT = (bf16*)(ws + WS_WG) + (size_t)i * D_ * D_; }
    else              { const int i = id - 18; m.W = (const float*)a.in[29] + (size_t)i * PLE * D_;   m.ldw = D_; m.K = PLE; m.N = D_; m.WT = (bf16*)(ws + WS_WP) + (size_t)i * D_ * PLE; }
    m.items = (m.K / 64) * (m.N / 64); return m;
}
__device__ __forceinline__ MatD moe_mat(const Args& a, int j, int id) {
    unsigned char* ws = a.ws; MatD m; m.gain = nullptr; m.ilv = 0; const int e = id / 3, k = id % 3;
    if (k < 2) { m.W = (const float*)a.in[25 + k] + ((size_t)j * NEXP + e) * D_ * DFF; m.ldw = DFF; m.K = D_; m.N = DFF; m.gain = (const float*)a.in[4] + (2 * j + 1) * D_; m.WT = (bf16*)(ws + WS_W13M) + (size_t)e * 2 * DFF * D_; m.ilv = 1 + k; }
    else       { m.W = (const float*)a.in[27] + ((size_t)j * NEXP + e) * DFF * D_; m.ldw = D_; m.K = DFF; m.N = D_; m.WT = (bf16*)(ws + WS_W2M) + (size_t)e * D_ * DFF; }
    m.items = (m.K / 64) * (m.N / 64); return m;
}

__device__ __forceinline__ void p_prologue(const Frame& F, const Args& a) {
    LAS float* scr = (LAS float*)(F.lds + F.wave * WAVE_LDS);
    unsigned char* ws = a.ws;
    {
        int base = 0;
#pragma unroll 1
        for (int id = 0; id < 22; ++id) { const MatD m = dense_mat(a, id);
            int first = (F.gw - base) % F.NGW; if (first < 0) first += F.NGW;
#pragma unroll 1
            for (int it = first; it < m.items; it += F.NGW) xpose_item(m.W, m.ldw, m.K, m.N, m.gain, m.WT, m.ilv, scr, it, F.lane);
            base += m.items; }
    }
    { const float* p = (const float*)a.in[1]; bf16* pb = (bf16*)(ws + WS_PBF); const size_t n8 = (size_t)DEPTH_ * S_ * PLE / 8;
#pragma unroll 1
      for (size_t i = (size_t)F.gw * 64 + F.lane; i < n8; i += (size_t)F.NGW * 64) { const f32x4 x0 = *(const GAS f32x4*)(p + i * 8), x1 = *(const GAS f32x4*)(p + i * 8 + 4);
          v4u o; o.x = cvtpk(x0[0], x0[1]); o.y = cvtpk(x0[2], x0[3]); o.z = cvtpk(x1[0], x1[1]); o.w = cvtpk(x1[2], x1[3]); *(GAS v4u*)(pb + i * 8) = o; } }
#ifdef PROBE_PRO_NOC
    if (a.use_bar)
#endif
    { const float* x = (const float*)a.in[0]; bf16* hb = (bf16*)(ws + WS_HBF); float* ssq = (float*)(ws + WS_SSQB);
#pragma unroll 1
      for (int m = F.gw; m < S_; m += F.NGW) { const GAS f32x4* xr = (const GAS f32x4*)(x + (size_t)m * D_) + F.lane; float s = 0.f;
#pragma unroll
          for (int j = 0; j < 4; ++j) { const f32x4 v = xr[64 * j]; s += (v[0] * v[0] + v[1] * v[1]) + (v[2] * v[2] + v[3] * v[3]);
              *((GAS f32x4*)(a.out + (size_t)m * D_) + F.lane + 64 * j) = v;
              u32x2v o; o.x = cvtpk(v[0], v[1]); o.y = cvtpk(v[2], v[3]); *((GAS u32x2v*)(hb + (size_t)m * D_) + F.lane + 64 * j) = o; }
          s = wave_sum(s);
          if (F.lane < 16) ssq[(size_t)m * 16 + F.lane] = (F.lane == 0) ? s : 0.f; } }
    { const int* pos = (const int*)a.in[2]; float* tab = (float*)(ws + WS_TAB);
#pragma unroll 1
      for (int idx = F.gw * 64 + F.lane; idx < S_ * 8; idx += F.NGW * 64) { const int row = idx >> 3, i = idx & 7;
          const float inv = exp2f(-(float)i * (18.931568569324174f / 8.0f));
          const float ang = (float)pos[row] * inv;
          double t = (double)ang * 0.15915494309189535; t -= rint(t); const float tf = (float)t;
          tab[(size_t)row * 16 + i] = __builtin_amdgcn_cosf(tf); tab[(size_t)row * 16 + 8 + i] = __builtin_amdgcn_sinf(tf); } }
}

__device__ __forceinline__ void p_mixprep(const Frame& F, const Args& a, int L) {
    GAS unsigned char* ws = (GAS unsigned char*)a.ws; asm volatile("" : "+s"(ws)); int lane_ = F.lane; asm volatile("" : "+v"(lane_)); const int j = L >> 1, lane = lane_;
    const bf16* AO = (const bf16*)(ws + WS_ARENA + AR_AO); const bf16* PE = (const bf16*)(ws + WS_ARENA + AR_PE); bf16* mix = (bf16*)(ws + WS_MIX);
    const float lam0 = 0.8f - 0.6f * expf(-0.3f * (float)L);
    float s1 = ((const float*)a.in[9])[j * 64 + lane] * ((const float*)a.in[10])[j * 64 + lane], s2 = ((const float*)a.in[11])[j * 64 + lane] * ((const float*)a.in[12])[j * 64 + lane];
    s1 = wave_sum(s1); s2 = wave_sum(s2);
    const float lam = expf(s1) - expf(s2) + lam0, post = 1.0f - lam0;
    const int hh = lane >> 4, dd = (lane & 15) * 8, ch = lane * 8;
    float sg[8], w0[8], w1[8], w2[8];
#pragma unroll
    for (int e = 0; e < 8; ++e) { sg[e] = ((const float*)a.in[13])[j * 128 + dd + e] * post;
        w0[e] = ((const float*)a.in[14])[(j * 3 + 0) * 512 + ch + e]; w1[e] = ((const float*)a.in[14])[(j * 3 + 1) * 512 + ch + e]; w2[e] = ((const float*)a.in[14])[(j * 3 + 2) * 512 + ch + e]; }
#pragma unroll 1
    for (int t = F.gw; t < S_; t += F.NGW) {
        const v4u o1 = *(const GAS v4u*)(AO + (size_t)t * D_ + 256 * hh + dd), o2 = *(const GAS v4u*)(AO + (size_t)t * D_ + 256 * hh + 128 + dd);
        float d[8]; const unsigned a1[4] = {o1.x, o1.y, o1.z, o1.w}, a2[4] = {o2.x, o2.y, o2.z, o2.w}; float ss = 0.f;
#pragma unroll
        for (int q = 0; q < 4; ++q) { d[2 * q] = bflo(a1[q]) - lam * bflo(a2[q]); d[2 * q + 1] = bfhi(a1[q]) - lam * bfhi(a2[q]); ss += d[2 * q] * d[2 * q] + d[2 * q + 1] * d[2 * q + 1]; }
        ss += __shfl_xor(ss, 1); ss += __shfl_xor(ss, 2); ss += __shfl_xor(ss, 4); ss += __shfl_xor(ss, 8);
        const float rms = __builtin_amdgcn_rsqf(ss * (1.0f / 128.0f) + 1e-5f);
        v4u o; o.x = cvtpk(d[0] * rms * sg[0], d[1] * rms * sg[1]); o.y = cvtpk(d[2] * rms * sg[2], d[3] * rms * sg[3]); o.z = cvtpk(d[4] * rms * sg[4], d[5] * rms * sg[5]); o.w = cvtpk(d[6] * rms * sg[6], d[7] * rms * sg[7]);
        *(GAS v4u*)(mix + (size_t)t * D_ + hh * 128 + dd) = o;
        const bf16* r0 = PE + (size_t)t * EIN;
        const v4u bb = *(const GAS v4u*)(r0 + 1536 + ch), c0 = *(const GAS v4u*)(r0 + 2048 + ch), x0 = *(const GAS v4u*)(r0 + 2560 + ch);
        v4u c1 = {0u, 0u, 0u, 0u}, x1 = c1, c2 = c1, x2 = c1;
        if (t >= 1) { c1 = *(const GAS v4u*)(r0 - EIN + 2048 + ch); x1 = *(const GAS v4u*)(r0 - EIN + 2560 + ch); }
        if (t >= 2) { c2 = *(const GAS v4u*)(r0 - 2 * EIN + 2048 + ch); x2 = *(const GAS v4u*)(r0 - 2 * EIN + 2560 + ch); }
        const unsigned B[4] = {bb.x, bb.y, bb.z, bb.w}, C0[4] = {c0.x, c0.y, c0.z, c0.w}, X0[4] = {x0.x, x0.y, x0.z, x0.w}, C1[4] = {c1.x, c1.y, c1.z, c1.w}, X1[4] = {x1.x, x1.y, x1.z, x1.w},
                       C2[4] = {c2.x, c2.y, c2.z, c2.w}, X2[4] = {x2.x, x2.y, x2.z, x2.w};
        float sc[8];
#pragma unroll
        for (int q = 0; q < 4; ++q) {
            sc[2 * q] = bflo(B[q]) * (w2[2 * q] * (bflo(C0[q]) * bflo(X0[q])) + w1[2 * q] * (bflo(C1[q]) * bflo(X1[q])) + w0[2 * q] * (bflo(C2[q]) * bflo(X2[q])));
            sc[2 * q + 1] = bfhi(B[q]) * (w2[2 * q + 1] * (bfhi(C0[q]) * bfhi(X0[q])) + w1[2 * q + 1] * (bfhi(C1[q]) * bfhi(X1[q])) + w0[2 * q + 1] * (bfhi(C2[q]) * bfhi(X2[q]))); }
        v4u so; so.x = cvtpk(sc[0], sc[1]); so.y = cvtpk(sc[2], sc[3]); so.z = cvtpk(sc[4], sc[5]); so.w = cvtpk(sc[6], sc[7]);
        *(GAS v4u*)(mix + (size_t)t * D_ + 512 + ch) = so;
    }
}


__device__ __forceinline__ void p_rot(const Frame& F, const Args& a) {
    GAS unsigned char* ws = (GAS unsigned char*)a.ws; asm volatile("" : "+s"(ws)); int lane_ = F.lane; asm volatile("" : "+v"(lane_)); const int lane = lane_;
    bf16* PE = (bf16*)(ws + WS_ARENA + AR_PE); const float* tab = (const float*)(ws + WS_TAB);
    const int hd = lane >> 2, i0 = 2 * (lane & 3), col = (hd < 8 ? hd * 64 : 512 + (hd - 8) * 64) + i0;
#pragma unroll 1
    for (int t = F.gw; t < S_; t += F.NGW) {
        GAS unsigned* p1 = (GAS unsigned*)(PE + (size_t)t * EIN + col); GAS unsigned* p2 = (GAS unsigned*)(PE + (size_t)t * EIN + col + 8);
        const unsigned w1 = *p1, w2 = *p2;
        const float c0 = tab[(size_t)t * 16 + i0], c1 = tab[(size_t)t * 16 + i0 + 1], s0 = tab[(size_t)t * 16 + 8 + i0], s1 = tab[(size_t)t * 16 + 8 + i0 + 1];
        const float a0 = bflo(w1), a1 = bfhi(w1), b0 = bflo(w2), b1 = bfhi(w2);
        *p1 = cvtpk(a0 * c0 - b0 * s0, a1 * c1 - b1 * s1); *p2 = cvtpk(b0 * c0 + a0 * s0, b1 * c1 + a1 * s1);
    }
}
__device__ __forceinline__ void p_ab(const Frame& F, const Args& a, int L) {
    GAS unsigned char* ws = (GAS unsigned char*)a.ws; asm volatile("" : "+s"(ws)); int lane_ = F.lane; asm volatile("" : "+v"(lane_)); const int j = L >> 1, lane = lane_;
    LAS float* wl = (LAS float*)F.lds;
    const float* W = (const float*)a.in[15] + (size_t)j * D_ * OIN_SRC; const float* ln = (const float*)a.in[3] + L * D_;
    for (int idx = F.tid; idx < D_ * 16; idx += NWAVES * 64) { const int k = idx >> 4, c = idx & 15; wl[k * 20 + c] = ln[k] * W[(size_t)k * OIN_SRC + 4096 + c]; }
    __syncthreads();
    const float* ssq = (const float*)(ws + WS_SSQB); float* gg = (float*)(ws + WS_GB); float* gbeta = gg + S_ * 8;
    const float alog = ((const float*)a.in[17])[j * 8 + (lane & 7)], dtb = ((const float*)a.in[18])[j * 8 + (lane & 7)];
    const GAS float* hG = (const GAS float*)a.out;
#pragma unroll 1
    for (int t0 = F.gw; t0 < S_; t0 += 2 * F.NGW) {
        const int tb = t0 + F.NGW; const bool hasb = tb < S_; const int tbc = hasb ? tb : t0;
        float xa[16], xb[16];
#pragma unroll
        for (int i = 0; i < 16; ++i) { xa[i] = hG[(size_t)t0 * D_ + 64 * i + lane]; xb[i] = hG[(size_t)tbc * D_ + 64 * i + lane]; }
        const float rsa = pg8::rstd_row(ssq, t0), rsb = pg8::rstd_row(ssq, tbc);
        float acca[16], accb[16];
#pragma unroll
        for (int c = 0; c < 16; ++c) { acca[c] = 0.f; accb[c] = 0.f; }
#pragma unroll 4
        for (int i = 0; i < 16; ++i) { const LAS f32x4* wr = (const LAS f32x4*)(wl + (64 * i + lane) * 20);
#pragma unroll
            for (int q = 0; q < 4; ++q) { const f32x4 w = wr[q];
                acca[4 * q] += xa[i] * w[0]; acca[4 * q + 1] += xa[i] * w[1]; acca[4 * q + 2] += xa[i] * w[2]; acca[4 * q + 3] += xa[i] * w[3];
                accb[4 * q] += xb[i] * w[0]; accb[4 * q + 1] += xb[i] * w[1]; accb[4 * q + 2] += xb[i] * w[2]; accb[4 * q + 3] += xb[i] * w[3]; } }
        float minea = 0.f, mineb = 0.f;
#pragma unroll
        for (int c = 0; c < 16; ++c) { const float sa = wave_sum(acca[c]), sb = wave_sum(accb[c]); minea = ((lane & 15) == c) ? sa : minea; mineb = ((lane & 15) == c) ? sb : mineb; }
#pragma unroll
        for (int half = 0; half < 2; ++half) { if (half == 1 && !hasb) break;
            const int t = half ? tb : t0; const float mine = (half ? mineb * rsb : minea * rsa);
            if (lane < 8) gbeta[(size_t)t * 8 + lane] = sigm(mine);
            else if (lane < 16) { const float z = mine + dtb; const float sp = z > 20.f ? z : log1pf(expf(z)); gg[(size_t)t * 8 + lane - 8] = -expf(alog) * sp; } }
    }
    __syncthreads();
}
__device__ __forceinline__ void tri_solve(const LAS float* Lc, LAS bf16* Xs, int lane) {
    float x0, x1, x2, x3, x4, x5, x6, x7, x8, x9, x10, x11, x12, x13, x14, x15, x16, x17, x18, x19, x20, x21, x22, x23, x24, x25, x26, x27, x28, x29, x30, x31, x32, x33, x34, x35, x36, x37, x38, x39, x40, x41, x42, x43, x44, x45, x46, x47, x48, x49, x50, x51, x52, x53, x54, x55, x56, x57, x58, x59, x60, x61, x62, x63;
    { x63 = (lane == 63) ? 1.0f : 0.0f; asm volatile("" : "+v"(x63) : : "memory"); }
    { float s0 = 0.f, s1 = 0.f, s2 = 0.f, s3 = 0.f; { const f32x4 l = *(const LAS f32x4*)(Lc + 4276); s3 = fmaf(x63, l[3], s3); } x62 = (lane == 62) ? 1.0f : -((s0 + s1) + (s2 + s3)); asm volatile("" : "+v"(x62) : : "memory"); }
    { float s0 = 0.f, s1 = 0.f, s2 = 0.f, s3 = 0.f; { const f32x4 l = *(const LAS f32x4*)(Lc + 4208); s2 = fmaf(x62, l[2], s2); s3 = fmaf(x63, l[3], s3); } x61 = (lane == 61) ? 1.0f : -((s0 + s1) + (s2 + s3)); asm volatile("" : "+v"(x61) : : "memory"); }
    { float s0 = 0.f, s1 = 0.f, s2 = 0.f, s3 = 0.f; { const f32x4 l = *(const LAS f32x4*)(Lc + 4140); s1 = fmaf(x61, l[1], s1); s2 = fmaf(x62, l[2], s2); s3 = fmaf(x63, l[3], s3); } x60 = (lane == 60) ? 1.0f : -((s0 + s1) + (s2 + s3)); asm volatile("" : "+v"(x60) : : "memory"); }
    { float s0 = 0.f, s1 = 0.f, s2 = 0.f, s3 = 0.f; { const f32x4 l = *(const LAS f32x4*)(Lc + 4072); s0 = fmaf(x60, l[0], s0); s1 = fmaf(x61, l[1], s1); s2 = fmaf(x62, l[2], s2); s3 = fmaf(x63, l[3], s3); } x59 = (lane == 59) ? 1.0f : -((s0 + s1) + (s2 + s3)); asm volatile("" : "+v"(x59) : : "memory"); }
    { float s0 = 0.f, s1 = 0.f, s2 = 0.f, s3 = 0.f; { const f32x4 l = *(const LAS f32x4*)(Lc + 4000); s3 = fmaf(x59, l[3], s3); } { const f32x4 l = *(const LAS f32x4*)(Lc + 4004); s0 = fmaf(x60, l[0], s0); s1 = fmaf(x61, l[1], s1); s2 = fmaf(x62, l[2], s2); s3 = fmaf(x63, l[3], s3); } x58 = (lane == 58) ? 1.0f : -((s0 + s1) + (s2 + s3)); asm volatile("" : "+v"(x58) : : "memory"); }
    { float s0 = 0.f, s1 = 0.f, s2 = 0.f, s3 = 0.f; { const f32x4 l = *(const LAS f32x4*)(Lc + 3932); s2 = fmaf(x58, l[2], s2); s3 = fmaf(x59, l[3], s3); } { const f32x4 l = *(const LAS f32x4*)(Lc + 3936); s0 = fmaf(x60, l[0], s0); s1 = fmaf(x61, l[1], s1); s2 = fmaf(x62, l[2], s2); s3 = fmaf(x63, l[3], s3); } x57 = (lane == 57) ? 1.0f : -((s0 + s1) + (s2 + s3)); asm volatile("" : "+v"(x57) : : "memory"); }
    { float s0 = 0.f, s1 = 0.f, s2 = 0.f, s3 = 0.f; { const f32x4 l = *(const LAS f32x4*)(Lc + 3864); s1 = fmaf(x57, l[1], s1); s2 = fmaf(x58, l[2], s2); s3 = fmaf(x59, l[3], s3); } { const f32x4 l = *(const LAS f32x4*)(Lc + 3868); s0 = fmaf(x60, l[0], s0); s1 = fmaf(x61, l[1], s1); s2 = fmaf(x62, l[2], s2); s3 = fmaf(x63, l[3], s3); } x56 = (lane == 56) ? 1.0f : -((s0 + s1) + (s2 + s3)); asm volatile("" : "+v"(x56) : : "memory"); }
    { float s0 = 0.f, s1 = 0.f, s2 = 0.f, s3 = 0.f; { const f32x4 l = *(const LAS f32x4*)(Lc + 3796); s0 = fmaf(x56, l[0], s0); s1 = fmaf(x57, l[1], s1); s2 = fmaf(x58, l[2], s2); s3 = fmaf(x59, l[3], s3); } { const f32x4 l = *(const LAS f32x4*)(Lc + 3800); s0 = fmaf(x60, l[0], s0); s1 = fmaf(x61, l[1], s1); s2 = fmaf(x62, l[2], s2); s3 = fmaf(x63, l[3], s3); } x55 = (lane == 55) ? 1.0f : -((s0 + s1) + (s2 + s3)); asm volatile("" : "+v"(x55) : : "memory"); }
    { float s0 = 0.f, s1 = 0.f, s2 = 0.f, s3 = 0.f; { const f32x4 l = *(const LAS f32x4*)(Lc + 3724); s3 = fmaf(x55, l[3], s3); } { const f32x4 l = *(const LAS f32x4*)(Lc + 3728); s0 = fmaf(x56, l[0], s0); s1 = fmaf(x57, l[1], s1); s2 = fmaf(x58, l[2], s2); s3 = fmaf(x59, l[3], s3); } { const f32x4 l = *(const LAS f32x4*)(Lc + 3732); s0 = fmaf(x60, l[0], s0); s1 = fmaf(x61, l[1], s1); s2 = fmaf(x62, l[2], s2); s3 = fmaf(x63, l[3], s3); } x54 = (lane == 54) ? 1.0f : -((s0 + s1) + (s2 + s3)); asm volatile("" : "+v"(x54) : : "memory"); }
    { float s0 = 0.f, s1 = 0.f, s2 = 0.f, s3 = 0.f; { const f32x4 l = *(const LAS f32x4*)(Lc + 3656); s2 = fmaf(x54, l[2], s2); s3 = fmaf(x55, l[3], s3); } { const f32x4 l = *(const LAS f32x4*)(Lc + 3660); s0 = fmaf(x56, l[0], s0); s1 = fmaf(x57, l[1], s1); s2 = fmaf(x58, l[2], s2); s3 = fmaf(x59, l[3], s3); } { const f32x4 l = *(const LAS f32x4*)(Lc + 3664); s0 = fmaf(x60, l[0], s0); s1 = fmaf(x61, l[1], s1); s2 = fmaf(x62, l[2], s2); s3 = fmaf(x63, l[3], s3); } x53 = (lane == 53) ? 1.0f : -((s0 + s1) + (s2 + s3)); asm volatile("" : "+v"(x53) : : "memory"); }
    { float s0 = 0.f, s1 = 0.f, s2 = 0.f, s3 = 0.f; { const f32x4 l = *(const LAS f32x4*)(Lc + 3588); s1 = fmaf(x53, l[1], s1); s2 = fmaf(x54, l[2], s2); s3 = fmaf(x55, l[3], s3); } { const f32x4 l = *(const LAS f32x4*)(Lc + 3592); s0 = fmaf(x56, l[0], s0); s1 = fmaf(x57, l[1], s1); s2 = fmaf(x58, l[2], s2); s3 = fmaf(x59, l[3], s3); } { const f32x4 l = *(const LAS f32x4*)(Lc + 3596); s0 = fmaf(x60, l[0], s0); s1 = fmaf(x61, l[1], s1); s2 = fmaf(x62, l[2], s2); s3 = fmaf(x63, l[3], s3); } x52 = (lane == 52) ? 1.0f : -((s0 + s1) + (s2 + s3)); asm volatile("" : "+v"(x52) : : "memory"); }
    { float s0 = 0.f, s1 = 0.f, s2 = 0.f, s3 = 0.f; { const f32x4 l = *(const LAS f32x4*)(Lc + 3520); s0 = fmaf(x52, l[0], s0); s1 = fmaf(x53, l[1], s1); s2 = fmaf(x54, l[2], s2); s3 = fmaf(x55, l[3], s3); } { const f32x4 l = *(const LAS f32x4*)(Lc + 3524); s0 = fmaf(x56, l[0], s0); s1 = fmaf(x57, l[1], s1); s2 = fmaf(x58, l[2], s2); s3 = fmaf(x59, l[3], s3); } { const f32x4 l = *(const LAS f32x4*)(Lc + 3528); s0 = fmaf(x60, l[0], s0); s1 = fmaf(x61, l[1], s1); s2 = fmaf(x62, l[2], s2); s3 = fmaf(x63, l[3], s3); } x51 = (lane == 51) ? 1.0f : -((s0 + s1) + (s2 + s3)); asm volatile("" : "+v"(x51) : : "memory"); }
    { float s0 = 0.f, s1 = 0.f, s2 = 0.f, s3 = 0.f; { const f32x4 l = *(const LAS f32x4*)(Lc + 3448); s3 = fmaf(x51, l[3], s3); } { const f32x4 l = *(const LAS f32x4*)(Lc + 3452); s0 = fmaf(x52, l[0], s0); s1 = fmaf(x53, l[1], s1); s2 = fmaf(x54, l[2], s2); s3 = fmaf(x55, l[3], s3); } { const f32x4 l = *(const LAS f32x4*)(Lc + 3456); s0 = fmaf(x56, l[0], s0); s1 = fmaf(x57, l[1], s1); s2 = fmaf(x58, l[2], s2); s3 = fmaf(x59, l[3], s3); } { const f32x4 l = *(const LAS f32x4*)(Lc + 3460); s0 = fmaf(x60, l[0], s0); s1 = fmaf(x61, l[1], s1); s2 = fmaf(x62, l[2], s2); s3 = fmaf(x63, l[3], s3); } x50 = (lane == 50) ? 1.0f : -((s0 + s1) + (s2 + s3)); asm volatile("" : "+v"(x50) : : "memory"); }
    { float s0 = 0.f, s1 = 0.f, s2 = 0.f, s3 = 0.f; { const f32x4 l = *(const LAS f32x4*)(Lc + 3380); s2 = fmaf(x50, l[2], s2); s3 = fmaf(x51, l[3], s3); } { const f32x4 l = *(const LAS f32x4*)(Lc + 3384); s0 = fmaf(x52, l[0], s0); s1 = fmaf(x53, l[1], s1); s2 = fmaf(x54, l[2], s2); s3 = fmaf(x55, l[3], s3); } { const f32x4 l = *(const LAS f32x4*)(Lc + 3388); s0 = fmaf(x56, l[0], s0); s1 = fmaf(x57, l[1], s1); s2 = fmaf(x58, l[2], s2); s3 = fmaf(x59, l[3], s3); } { const f32x4 l = *(const LAS f32x4*)(Lc + 3392); s0 = fmaf(x60, l[0], s0); s1 = fmaf(x61, l[1], s1); s2 = fmaf(x62, l[2], s2); s3 = fmaf(x63, l[3], s3); } x49 = (lane == 49) ? 1.0f : -((s0 + s1) + (s2 + s3)); asm volatile("" : "+v"(x49) : : "memory"); }
    { float s0 = 0.f, s1 = 0.f, s2 = 0.f, s3 = 0.f; { const f32x4 l = *(const LAS f32x4*)(Lc + 3312); s1 = fmaf(x49, l[1], s1); s2 = fmaf(x50, l[2], s2); s3 = fmaf(x51, l[3], s3); } { const f32x4 l = *(const LAS f32x4*)(Lc + 3316); s0 = fmaf(x52, l[0], s0); s1 = fmaf(x53, l[1], s1); s2 = fmaf(x54, l[2], s2); s3 = fmaf(x55, l[3], s3); } { const f32x4 l = *(const LAS f32x4*)(Lc + 3320); s0 = fmaf(x56, l[0], s0); s1 = fmaf(x57, l[1], s1); s2 = fmaf(x58, l[2], s2); s3 = fmaf(x59, l[3], s3); } { const f32x4 l = *(const LAS f32x4*)(Lc + 3324); s0 = fmaf(x60, l[0], s0); s1 = fmaf(x61, l[1], s1); s2 = fmaf(x62, l[2], s2); s3 = fmaf(x63, l[3], s3); } x48 = (lane == 48) ? 1.0f : -((s0 + s1) + (s2 + s3)); asm volatile("" : "+v"(x48) : : "memory"); }
    { float s0 = 0.f, s1 = 0.f, s2 = 0.f, s3 = 0.f; { const f32x4 l = *(const LAS f32x4*)(Lc + 3244); s0 = fmaf(x48, l[0], s0); s1 = fmaf(x49, l[1], s1); s2 = fmaf(x50, l[2], s2); s3 = fmaf(x51, l[3], s3); } { const f32x4 l = *(const LAS f32x4*)(Lc + 3248); s0 = fmaf(x52, l[0], s0); s1 = fmaf(x53, l[1], s1); s2 = fmaf(x54, l[2], s2); s3 = fmaf(x55, l[3], s3); } { const f32x4 l = *(const LAS f32x4*)(Lc + 3252); s0 = fmaf(x56, l[0], s0); s1 = fmaf(x57, l[1], s1); s2 = fmaf(x58, l[2], s2); s3 = fmaf(x59, l[3], s3); } { const f32x4 l = *(const LAS f32x4*)(Lc + 3256); s0 = fmaf(x60, l[0], s0); s1 = fmaf(x61, l[1], s1); s2 = fmaf(x62, l[2], s2); s3 = fmaf(x63, l[3], s3); } x47 = (lane == 47) ? 1.0f : -((s0 + s1) + (s2 + s3)); asm volatile("" : "+v"(x47) : : "memory"); }
    { float s0 = 0.f, s1 = 0.f, s2 = 0.f, s3 = 0.f; { const f32x4 l = *(const LAS f32x4*)(Lc + 3172); s3 = fmaf(x47, l[3], s3); } { const f32x4 l = *(const LAS f32x4*)(Lc + 3176); s0 = fmaf(x48, l[0], s0); s1 = fmaf(x49, l[1], s1); s2 = fmaf(x50, l[2], s2); s3 = fmaf(x51, l[3], s3); } { const f32x4 l = *(const LAS f32x4*)(Lc + 3180); s0 = fmaf(x52, l[0], s0); s1 = fmaf(x53, l[1], s1); s2 = fmaf(x54, l[2], s2); s3 = fmaf(x55, l[3], s3); } { const f32x4 l = *(const LAS f32x4*)(Lc + 3184); s0 = fmaf(x56, l[0], s0); s1 = fmaf(x57, l[1], s1); s2 = fmaf(x58, l[2], s2); s3 = fmaf(x59, l[3], s3); } { const f32x4 l = *(const LAS f32x4*)(Lc + 3188); s0 = fmaf(x60, l[0], s0); s1 = fmaf(x61, l[1], s1); s2 = fmaf(x62, l[2], s2); s3 = fmaf(x63, l[3], s3); } x46 = (lane == 46) ? 1.0f : -((s0 + s1) + (s2 + s3)); asm volatile("" : "+v"(x46) : : "memory"); }
    { float s0 = 0.f, s1 = 0.f, s2 = 0.f, s3 = 0.f; { const f32x4 l = *(const LAS f32x4*)(Lc + 3104); s2 = fmaf(x46, l[2], s2); s3 = fmaf(x47, l[3], s3); } { const f32x4 l = *(const LAS f32x4*)(Lc + 3108); s0 = fmaf(x48, l[0], s0); s1 = fmaf(x49, l[1], s1); s2 = fmaf(x50, l[2], s2); s3 = fmaf(x51, l[3], s3); } { const f32x4 l = *(const LAS f32x4*)(Lc + 3112); s0 = fmaf(x52, l[0], s0); s1 = fmaf(x53, l[1], s1); s2 = fmaf(x54, l[2], s2); s3 = fmaf(x55, l[3], s3); } { const f32x4 l = *(const LAS f32x4*)(Lc + 3116); s0 = fmaf(x56, l[0], s0); s1 = fmaf(x57, l[1], s1); s2 = fmaf(x58, l[2], s2); s3 = fmaf(x59, l[3], s3); } { const f32x4 l = *(const LAS f32x4*)(Lc + 3120); s0 = fmaf(x60, l[0], s0); s1 = fmaf(x61, l[1], s1); s2 = fmaf(x62, l[2], s2); s3 = fmaf(x63, l[3], s3); } x45 = (lane == 45) ? 1.0f : -((s0 + s1) + (s2 + s3)); asm volatile("" : "+v"(x45) : : "memory"); }
    { float s0 = 0.f, s1 = 0.f, s2 = 0.f, s3 = 0.f; { const f32x4 l = *(const LAS f32x4*)(Lc + 3036); s1 = fmaf(x45, l[1], s1); s2 = fmaf(x46, l[2], s2); s3 = fmaf(x47, l[3], s3); } { const f32x4 l = *(const LAS f32x4*)(Lc + 3040); s0 = fmaf(x48, l[0], s0); s1 = fmaf(x49, l[1], s1); s2 = fmaf(x50, l[2], s2); s3 = fmaf(x51, l[3], s3); } { const f32x4 l = *(const LAS f32x4*)(Lc + 3044); s0 = fmaf(x52, l[0], s0); s1 = fmaf(x53, l[1], s1); s2 = fmaf(x54, l[2], s2); s3 = fmaf(x55, l[3], s3); } { const f32x4 l = *(const LAS f32x4*)(Lc + 3048); s0 = fmaf(x56, l[0], s0); s1 = fmaf(x57, l[1], s1); s2 = fmaf(x58, l[2], s2); s3 = fmaf(x59, l[3], s3); } { const f32x4 l = *(const LAS f32x4*)(Lc + 3052); s0 = fmaf(x60, l[0], s0); s1 = fmaf(x61, l[1], s1); s2 = fmaf(x62, l[2], s2); s3 = fmaf(x63, l[3], s3); } x44 = (lane == 44) ? 1.0f : -((s0 + s1) + (s2 + s3)); asm volatile("" : "+v"(x44) : : "memory"); }
    { float s0 = 0.f, s1 = 0.f, s2 = 0.f, s3 = 0.f; { const f32x4 l = *(const LAS f32x4*)(Lc + 2968); s0 = fmaf(x44, l[0], s0); s1 = fmaf(x45, l[1], s1); s2 = fmaf(x46, l[2], s2); s3 = fmaf(x47, l[3], s3); } { const f32x4 l = *(const LAS f32x4*)(Lc + 2972); s0 = fmaf(x48, l[0], s0); s1 = fmaf(x49, l[1], s1); s2 = fmaf(x50, l[2], s2); s3 = fmaf(x51, l[3], s3); } { const f32x4 l = *(const LAS f32x4*)(Lc + 2976); s0 = fmaf(x52, l[0], s0); s1 = fmaf(x53, l[1], s1); s2 = fmaf(x54, l[2], s2); s3 = fmaf(x55, l[3], s3); } { const f32x4 l = *(const LAS f32x4*)(Lc + 2980); s0 = fmaf(x56, l[0], s0); s1 = fmaf(x57, l[1], s1); s2 = fmaf(x58, l[2], s2); s3 = fmaf(x59, l[3], s3); } { const f32x4 l = *(const LAS f32x4*)(Lc + 2984); s0 = fmaf(x60, l[0], s0); s1 = fmaf(x61, l[1], s1); s2 = fmaf(x62, l[2], s2); s3 = fmaf(x63, l[3], s3); } x43 = (lane == 43) ? 1.0f : -((s0 + s1) + (s2 + s3)); asm volatile("" : "+v"(x43) : : "memory"); }
    { float s0 = 0.f, s1 = 0.f, s2 = 0.f, s3 = 0.f; { const f32x4 l = *(const LAS f32x4*)(Lc + 2896); s3 = fmaf(x43, l[3], s3); } { const f32x4 l = *(const LAS f32x4*)(Lc + 2900); s0 = fmaf(x44, l[0], s0); s1 = fmaf(x45, l[1], s1); s2 = fmaf(x46, l[2], s2); s3 = fmaf(x47, l[3], s3); } { const f32x4 l = *(const LAS f32x4*)(Lc + 2904); s0 = fmaf(x48, l[0], s0); s1 = fmaf(x49, l[1], s1); s2 = fmaf(x50, l[2], s2); s3 = fmaf(x51, l[3], s3); } { const f32x4 l = *(const LAS f32x4*)(Lc + 2908); s0 = fmaf(x52, l[0], s0); s1 = fmaf(x53, l[1], s1); s2 = fmaf(x54, l[2], s2); s3 = fmaf(x55, l[3], s3); } { const f32x4 l = *(const LAS f32x4*)(Lc + 2912); s0 = fmaf(x56, l[0], s0); s1 = fmaf(x57, l[1], s1); s2 = fmaf(x58, l[2], s2); s3 = fmaf(x59, l[3], s3); } { const f32x4 l = *(const LAS f32x4*)(Lc + 2916); s0 = fmaf(x60, l[0], s0); s1 = fmaf(x61, l[1], s1); s2 = fmaf(x62, l[2], s2); s3 = fmaf(x63, l[3], s3); } x42 = (lane == 42) ? 1.0f : -((s0 + s1) + (s2 + s3)); asm volatile("" : "+v"(x42) : : "memory"); }
    { float s0 = 0.f, s1 = 0.f, s2 = 0.f, s3 = 0.f; { const f32x4 l = *(const LAS f32x4*)(Lc + 2828); s2 = fmaf(x42, l[2], s2); s3 = fmaf(x43, l[3], s3); } { const f32x4 l = *(const LAS f32x4*)(Lc + 2832); s0 = fmaf(x44, l[0], s0); s1 = fmaf(x45, l[1], s1); s2 = fmaf(x46, l[2], s2); s3 = fmaf(x47, l[3], s3); } { const f32x4 l = *(const LAS f32x4*)(Lc + 2836); s0 = fmaf(x48, l[0], s0); s1 = fmaf(x49, l[1], s1); s2 = fmaf(x50, l[2], s2); s3 = fmaf(x51, l[3], s3); } { const f32x4 l = *(const LAS f32x4*)(Lc + 2840); s0 = fmaf(x52, l[0], s0); s1 = fmaf(x53, l[1], s1); s2 = fmaf(x54, l[2], s2); s3 = fmaf(x55, l[3], s3); } { const f32x4 l = *(const LAS f32x4*)(Lc + 2844); s0 = fmaf(x56, l[0], s0); s1 = fmaf(x57, l[1], s1); s2 = fmaf(x58, l[2], s2); s3 = fmaf(x59, l[3], s3); } { const f32x4 l = *(const LAS f32x4*)(Lc + 2848); s0 = fmaf(x60, l[0], s0); s1 = fmaf(x61, l[1], s1); s2 = fmaf(x62, l[2], s2); s3 = fmaf(x63, l[3], s3); } x41 = (lane == 41) ? 1.0f : -((s0 + s1) + (s2 + s3)); asm volatile("" : "+v"(x41) : : "memory"); }
    { float s0 = 0.f, s1 = 0.f, s2 = 0.f, s3 = 0.f; { const f32x4 l = *(const LAS f32x4*)(Lc + 2760); s1 = fmaf(x41, l[1], s1); s2 = fmaf(x42, l[2], s2); s3 = fmaf(x43, l[3], s3); } { const f32x4 l = *(const LAS f32x4*)(Lc + 2764); s0 = fmaf(x44, l[0], s0); s1 = fmaf(x45, l[1], s1); s2 = fmaf(x46, l[2], s2); s3 = fmaf(x47, l[3], s3); } { const f32x4 l = *(const LAS f32x4*)(Lc + 2768); s0 = fmaf(x48, l[0], s0); s1 = fmaf(x49, l[1], s1); s2 = fmaf(x50, l[2], s2); s3 = fmaf(x51, l[3], s3); } { const f32x4 l = *(const LAS f32x4*)(Lc + 2772); s0 = fmaf(x52, l[0], s0); s1 = fmaf(x53, l[1], s1); s2 = fmaf(x54, l[2], s2); s3 = fmaf(x55, l[3], s3); } { const f32x4 l = *(const LAS f32x4*)(Lc + 2776); s0 = fmaf(x56, l[0], s0); s1 = fmaf(x57, l[1], s1); s2 = fmaf(x58, l[2], s2); s3 = fmaf(x59, l[3], s3); } { const f32x4 l = *(const LAS f32x4*)(Lc + 2780); s0 = fmaf(x60, l[0], s0); s1 = fmaf(x61, l[1], s1); s2 = fmaf(x62, l[2], s2); s3 = fmaf(x63, l[3], s3); } x40 = (lane == 40) ? 1.0f : -((s0 + s1) + (s2 + s3)); asm volatile("" : "+v"(x40) : : "memory"); }
    { float s0 = 0.f, s1 = 0.f, s2 = 0.f, s3 = 0.f; { const f32x4 l = *(const LAS f32x4*)(Lc + 2692); s0 = fmaf(x40, l[0], s0); s1 = fmaf(x41, l[1], s1); s2 = fmaf(x42, l[2], s2); s3 = fmaf(x43, l[3], s3); } { const f32x4 l = *(const LAS f32x4*)(Lc + 2696); s0 = fmaf(x44, l[0], s0); s1 = fmaf(x45, l[1], s1); s2 = fmaf(x46, l[2], s2); s3 = fmaf(x47, l[3], s3); } { const f32x4 l = *(const LAS f32x4*)(Lc + 2700); s0 = fmaf(x48, l[0], s0); s1 = fmaf(x49, l[1], s1); s2 = fmaf(x50, l[2], s2); s3 = fmaf(x51, l[3], s3); } { const f32x4 l = *(const LAS f32x4*)(Lc + 2704); s0 = fmaf(x52, l[0], s0); s1 = fmaf(x53, l[1], s1); s2 = fmaf(x54, l[2], s2); s3 = fmaf(x55, l[3], s3); } { const f32x4 l = *(const LAS f32x4*)(Lc + 2708); s0 = fmaf(x56, l[0], s0); s1 = fmaf(x57, l[1], s1); s2 = fmaf(x58, l[2], s2); s3 = fmaf(x59, l[3], s3); } { const f32x4 l = *(const LAS f32x4*)(Lc + 2712); s0 = fmaf(x60, l[0], s0); s1 = fmaf(x61, l[1], s1); s2 = fmaf(x62, l[2], s2); s3 = fmaf(x63, l[3], s3); } x39 = (lane == 39) ? 1.0f : -((s0 + s1) + (s2 + s3)); asm volatile("" : "+v"(x39) : : "memory"); }
    { float s0 = 0.f, s1 = 0.f, s2 = 0.f, s3 = 0.f; { const f32x4 l = *(const LAS f32x4*)(Lc + 2620); s3 = fmaf(x39, l[3], s3); } { const f32x4 l = *(const LAS f32x4*)(Lc + 2624); s0 = fmaf(x40, l[0], s0); s1 = fmaf(x41, l[1], s1); s2 = fmaf(x42, l[2], s2); s3 = fmaf(x43, l[3], s3); } { const f32x4 l = *(const LAS f32x4*)(Lc + 2628); s0 = fmaf(x44, l[0], s0); s1 = fmaf(x45, l[1], s1); s2 = fmaf(x46, l[2], s2); s3 = fmaf(x47, l[3], s3); } { const f32x4 l = *(const LAS f32x4*)(Lc + 2632); s0 = fmaf(x48, l[0], s0); s1 = fmaf(x49, l[1], s1); s2 = fmaf(x50, l[2], s2); s3 = fmaf(x51, l[3], s3); } { const f32x4 l = *(const LAS f32x4*)(Lc + 2636); s0 = fmaf(x52, l[0], s0); s1 = fmaf(x53, l[1], s1); s2 = fmaf(x54, l[2], s2); s3 = fmaf(x55, l[3], s3); } { const f32x4 l = *(const LAS f32x4*)(Lc + 2640); s0 = fmaf(x56, l[0], s0); s1 = fmaf(x57, l[1], s1); s2 = fmaf(x58, l[2], s2); s3 = fmaf(x59, l[3], s3); } { const f32x4 l = *(const LAS f32x4*)(Lc + 2644); s0 = fmaf(x60, l[0], s0); s1 = fmaf(x61, l[1], s1); s2 = fmaf(x62, l[2], s2); s3 = fmaf(x63, l[3], s3); } x38 = (lane == 38) ? 1.0f : -((s0 + s1) + (s2 + s3)); asm volatile("" : "+v"(x38) : : "memory"); }
    { float s0 = 0.f, s1 = 0.f, s2 = 0.f, s3 = 0.f; { const f32x4 l = *(const LAS f32x4*)(Lc + 2552); s2 = fmaf(x38, l[2], s2); s3 = fmaf(x39, l[3], s3); } { const f32x4 l = *(const LAS f32x4*)(Lc + 2556); s0 = fmaf(x40, l[0], s0); s1 = fmaf(x41, l[1], s1); s2 = fmaf(x42, l[2], s2); s3 = fmaf(x43, l[3], s3); } { const f32x4 l = *(const LAS f32x4*)(Lc + 2560); s0 = fmaf(x44, l[0], s0); s1 = fmaf(x45, l[1], s1); s2 = fmaf(x46, l[2], s2); s3 = fmaf(x47, l[3], s3); } { const f32x4 l = *(const LAS f32x4*)(Lc + 2564); s0 = fmaf(x48, l[0], s0); s1 = fmaf(x49, l[1], s1); s2 = fmaf(x50, l[2], s2); s3 = fmaf(x51, l[3], s3); } { const f32x4 l = *(const LAS f32x4*)(Lc + 2568); s0 = fmaf(x52, l[0], s0); s1 = fmaf(x53, l[1], s1); s2 = fmaf(x54, l[2], s2); s3 = fmaf(x55, l[3], s3); } { const f32x4 l = *(const LAS f32x4*)(Lc + 2572); s0 = fmaf(x56, l[0], s0); s1 = fmaf(x57, l[1], s1); s2 = fmaf(x58, l[2], s2); s3 = fmaf(x59, l[3], s3); } { const f32x4 l = *(const LAS f32x4*)(Lc + 2576); s0 = fmaf(x60, l[0], s0); s1 = fmaf(x61, l[1], s1); s2 = fmaf(x62, l[2], s2); s3 = fmaf(x63, l[3], s3); } x37 = (lane == 37) ? 1.0f : -((s0 + s1) + (s2 + s3)); asm volatile("" : "+v"(x37) : : "memory"); }
    { float s0 = 0.f, s1 = 0.f, s2 = 0.f, s3 = 0.f; { const f32x4 l = *(const LAS f32x4*)(Lc + 2484); s1 = fmaf(x37, l[1], s1); s2 = fmaf(x38, l[2], s2); s3 = fmaf(x39, l[3], s3); } { const f32x4 l = *(const LAS f32x4*)(Lc + 2488); s0 = fmaf(x40, l[0], s0); s1 = fmaf(x41, l[1], s1); s2 = fmaf(x42, l[2], s2); s3 = fmaf(x43, l[3], s3); } { const f32x4 l = *(const LAS f32x4*)(Lc + 2492); s0 = fmaf(x44, l[0], s0); s1 = fmaf(x45, l[1], s1); s2 = fmaf(x46, l[2], s2); s3 = fmaf(x47, l[3], s3); } { const f32x4 l = *(const LAS f32x4*)(Lc + 2496); s0 = fmaf(x48, l[0], s0); s1 = fmaf(x49, l[1], s1); s2 = fmaf(x50, l[2], s2); s3 = fmaf(x51, l[3], s3); } { const f32x4 l = *(const LAS f32x4*)(Lc + 2500); s0 = fmaf(x52, l[0], s0); s1 = fmaf(x53, l[1], s1); s2 = fmaf(x54, l[2], s2); s3 = fmaf(x55, l[3], s3); } { const f32x4 l = *(const LAS f32x4*)(Lc + 2504); s0 = fmaf(x56, l[0], s0); s1 = fmaf(x57, l[1], s1); s2 = fmaf(x58, l[2], s2); s3 = fmaf(x59, l[3], s3); } { const f32x4 l = *(const LAS f32x4*)(Lc + 2508); s0 = fmaf(x60, l[0], s0); s1 = fmaf(x61, l[1], s1); s2 = fmaf(x62, l[2], s2); s3 = fmaf(x63, l[3], s3); } x36 = (lane == 36) ? 1.0f : -((s0 + s1) + (s2 + s3)); asm volatile("" : "+v"(x36) : : "memory"); }
    { float s0 = 0.f, s1 = 0.f, s2 = 0.f, s3 = 0.f; { const f32x4 l = *(const LAS f32x4*)(Lc + 2416); s0 = fmaf(x36, l[0], s0); s1 = fmaf(x37, l[1], s1); s2 = fmaf(x38, l[2], s2); s3 = fmaf(x39, l[3], s3); } { const f32x4 l = *(const LAS f32x4*)(Lc + 2420); s0 = fmaf(x40, l[0], s0); s1 = fmaf(x41, l[1], s1); s2 = fmaf(x42, l[2], s2); s3 = fmaf(x43, l[3], s3); } { const f32x4 l = *(const LAS f32x4*)(Lc + 2424); s0 = fmaf(x44, l[0], s0); s1 = fmaf(x45, l[1], s1); s2 = fmaf(x46, l[2], s2); s3 = fmaf(x47, l[3], s3); } { const f32x4 l = *(const LAS f32x4*)(Lc + 2428); s0 = fmaf(x48, l[0], s0); s1 = fmaf(x49, l[1], s1); s2 = fmaf(x50, l[2], s2); s3 = fmaf(x51, l[3], s3); } { const f32x4 l = *(const LAS f32x4*)(Lc + 2432); s0 = fmaf(x52, l[0], s0); s1 = fmaf(x53, l[1], s1); s2 = fmaf(x54, l[2], s2); s3 = fmaf(x55, l[3], s3); } { const f32x4 l = *(const LAS f32x4*)(Lc + 2436); s0 = fmaf(x56, l[0], s0); s1 = fmaf(x57, l[1], s1); s2 = fmaf(x58, l[2], s2); s3 = fmaf(x59, l[3], s3); } { const f32x4 l = *(const LAS f32x4*)(Lc + 2440); s0 = fmaf(x60, l[0], s0); s1 = fmaf(x61, l[1], s1); s2 = fmaf(x62, l[2], s2); s3 = fmaf(x63, l[3], s3); } x35 = (lane == 35) ? 1.0f : -((s0 + s1) + (s2 + s3)); asm volatile("" : "+v"(x35) : : "memory"); }
    { float s0 = 0.f, s1 = 0.f, s2 = 0.f, s3 = 0.f; { const f32x4 l = *(const LAS f32x4*)(Lc + 2344); s3 = fmaf(x35, l[3], s3); } { const f32x4 l = *(const LAS f32x4*)(Lc + 2348); s0 = fmaf(x36, l[0], s0); s1 = fmaf(x37, l[1], s1); s2 = fmaf(x38, l[2], s2); s3 = fmaf(x39, l[3], s3); } { const f32x4 l = *(const LAS f32x4*)(Lc + 2352); s0 = fmaf(x40, l[0], s0); s1 = fmaf(x41, l[1], s1); s2 = fmaf(x42, l[2], s2); s3 = fmaf(x43, l[3], s3); } { const f32x4 l = *(const LAS f32x4*)(Lc + 2356); s0 = fmaf(x44, l[0], s0); s1 = fmaf(x45, l[1], s1); s2 = fmaf(x46, l[2], s2); s3 = fmaf(x47, l[3], s3); } { const f32x4 l = *(const LAS f32x4*)(Lc + 2360); s0 = fmaf(x48, l[0], s0); s1 = fmaf(x49, l[1], s1); s2 = fmaf(x50, l[2], s2); s3 = fmaf(x51, l[3], s3); } { const f32x4 l = *(const LAS f32x4*)(Lc + 2364); s0 = fmaf(x52, l[0], s0); s1 = fmaf(x53, l[1], s1); s2 = fmaf(x54, l[2], s2); s3 = fmaf(x55, l[3], s3); } { const f32x4 l = *(const LAS f32x4*)(Lc + 2368); s0 = fmaf(x56, l[0], s0); s1 = fmaf(x57, l[1], s1); s2 = fmaf(x58, l[2], s2); s3 = fmaf(x59, l[3], s3); } { const f32x4 l = *(const LAS f32x4*)(Lc + 2372); s0 = fmaf(x60, l[0], s0); s1 = fmaf(x61, l[1], s1); s2 = fmaf(x62, l[2], s2); s3 = fmaf(x63, l[3], s3); } x34 = (lane == 34) ? 1.0f : -((s0 + s1) + (s2 + s3)); asm volatile("" : "+v"(x34) : : "memory"); }
    { float s0 = 0.f, s1 = 0.f, s2 = 0.f, s3 = 0.f; { const f32x4 l = *(const LAS f32x4*)(Lc + 2276); s2 = fmaf(x34, l[2], s2); s3 = fmaf(x35, l[3], s3); } { const f32x4 l = *(const LAS f32x4*)(Lc + 2280); s0 = fmaf(x36, l[0], s0); s1 = fmaf(x37, l[1], s1); s2 = fmaf(x38, l[2], s2); s3 = fmaf(x39, l[3], s3); } { const f32x4 l = *(const LAS f32x4*)(Lc + 2284); s0 = fmaf(x40, l[0], s0); s1 = fmaf(x41, l[1], s1); s2 = fmaf(x42, l[2], s2); s3 = fmaf(x43, l[3], s3); } { const f32x4 l = *(const LAS f32x4*)(Lc + 2288); s0 = fmaf(x44, l[0], s0); s1 = fmaf(x45, l[1], s1); s2 = fmaf(x46, l[2], s2); s3 = fmaf(x47, l[3], s3); } { const f32x4 l = *(const LAS f32x4*)(Lc + 2292); s0 = fmaf(x48, l[0], s0); s1 = fmaf(x49, l[1], s1); s2 = fmaf(x50, l[2], s2); s3 = fmaf(x51, l[3], s3); } { const f32x4 l = *(const LAS f32x4*)(Lc + 2296); s0 = fmaf(x52, l[0], s0); s1 = fmaf(x53, l[1], s1); s2 = fmaf(x54, l[2], s2); s3 = fmaf(x55, l[3], s3); } { const f32x4 l = *(const LAS f32x4*)(Lc + 2300); s0 = fmaf(x56, l[0], s0); s1 = fmaf(x57, l[1], s1); s2 = fmaf(x58, l[2], s2); s3 = fmaf(x59, l[3], s3); } { const f32x4 l = *(const LAS f32x4*)(Lc + 2304); s0 = fmaf(x60, l[0], s0); s1 = fmaf(x61, l[1], s1); s2 = fmaf(x62, l[2], s2); s3 = fmaf(x63, l[3], s3); } x33 = (lane == 33) ? 1.0f : -((s0 + s1) + (s2 + s3)); asm volatile("" : "+v"(x33) : : "memory"); }
    { float s0 = 0.f, s1 = 0.f, s2 = 0.f, s3 = 0.f; { const f32x4 l = *(const LAS f32x4*)(Lc + 2208); s1 = fmaf(x33, l[1], s1); s2 = fmaf(x34, l[2], s2); s3 = fmaf(x35, l[3], s3); } { const f32x4 l = *(const LAS f32x4*)(Lc + 2212); s0 = fmaf(x36, l[0], s0); s1 = fmaf(x37, l[1], s1); s2 = fmaf(x38, l[2], s2); s3 = fmaf(x39, l[3], s3); } { const f32x4 l = *(const LAS f32x4*)(Lc + 2216); s0 = fmaf(x40, l[0], s0); s1 = fmaf(x41, l[1], s1); s2 = fmaf(x42, l[2], s2); s3 = fmaf(x43, l[3], s3); } { const f32x4 l = *(const LAS f32x4*)(Lc + 2220); s0 = fmaf(x44, l[0], s0); s1 = fmaf(x45, l[1], s1); s2 = fmaf(x46, l[2], s2); s3 = fmaf(x47, l[3], s3); } { const f32x4 l = *(const LAS f32x4*)(Lc + 2224); s0 = fmaf(x48, l[0], s0); s1 = fmaf(x49, l[1], s1); s2 = fmaf(x50, l[2], s2); s3 = fmaf(x51, l[3], s3); } { const f32x4 l = *(const LAS f32x4*)(Lc + 2228); s0 = fmaf(x52, l[0], s0); s1 = fmaf(x53, l[1], s1); s2 = fmaf(x54, l[2], s2); s3 = fmaf(x55, l[3], s3); } { const f32x4 l = *(const LAS f32x4*)(Lc + 2232); s0 = fmaf(x56, l[0], s0); s1 = fmaf(x57, l[1], s1); s2 = fmaf(x58, l[2], s2); s3 = fmaf(x59, l[3], s3); } { const f32x4 l = *(const LAS f32x4*)(Lc + 2236); s0 = fmaf(x60, l[0], s0); s1 = fmaf(x61, l[1], s1); s2 = fmaf(x62, l[2], s2); s3 = fmaf(x63, l[3], s3); } x32 = (lane == 32) ? 1.0f : -((s0 + s1) + (s2 + s3)); asm volatile("" : "+v"(x32) : : "memory"); }
    { float s0 = 0.f, s1 = 0.f, s2 = 0.f, s3 = 0.f; { const f32x4 l = *(const LAS f32x4*)(Lc + 2140); s0 = fmaf(x32, l[0], s0); s1 = fmaf(x33, l[1], s1); s2 = fmaf(x34, l[2], s2); s3 = fmaf(x35, l[3], s3); } { const f32x4 l = *(const LAS f32x4*)(Lc + 2144); s0 = fmaf(x36, l[0], s0); s1 = fmaf(x37, l[1], s1); s2 = fmaf(x38, l[2], s2); s3 = fmaf(x39, l[3], s3); } { const f32x4 l = *(const LAS f32x4*)(Lc + 2148); s0 = fmaf(x40, l[0], s0); s1 = fmaf(x41, l[1], s1); s2 = fmaf(x42, l[2], s2); s3 = fmaf(x43, l[3], s3); } { const f32x4 l = *(const LAS f32x4*)(Lc + 2152); s0 = fmaf(x44, l[0], s0); s1 = fmaf(x45, l[1], s1); s2 = fmaf(x46, l[2], s2); s3 = fmaf(x47, l[3], s3); } { const f32x4 l = *(const LAS f32x4*)(Lc + 2156); s0 = fmaf(x48, l[0], s0); s1 = fmaf(x49, l[1], s1); s2 = fmaf(x50, l[2], s2); s3 = fmaf(x51, l[3], s3); } { const f32x4 l = *(const LAS f32x4*)(Lc + 2160); s0 = fmaf(x52, l[0], s0); s1 = fmaf(x53, l[1], s1); s2 = fmaf(x54, l[2], s2); s3 = fmaf(x55, l[3], s3); } { const f32x4 l = *(const LAS f32x4*)(Lc + 2164); s0 = fmaf(x56, l[0], s0); s1 = fmaf(x57, l[1], s1); s2 = fmaf(x58, l[2], s2); s3 = fmaf(x59, l[3], s3); } { const f32x4 l = *(const LAS f32x4*)(Lc + 2168); s0 = fmaf(x60, l[0], s0); s1 = fmaf(x61, l[1], s1); s2 = fmaf(x62, l[2], s2); s3 = fmaf(x63, l[3], s3); } x31 = (lane == 31) ? 1.0f : -((s0 + s1) + (s2 + s3)); asm volatile("" : "+v"(x31) : : "memory"); }
    { float s0 = 0.f, s1 = 0.f, s2 = 0.f, s3 = 0.f; { const f32x4 l = *(const LAS f32x4*)(Lc + 2068); s3 = fmaf(x31, l[3], s3); } { const f32x4 l = *(const LAS f32x4*)(Lc + 2072); s0 = fmaf(x32, l[0], s0); s1 = fmaf(x33, l[1], s1); s2 = fmaf(x34, l[2], s2); s3 = fmaf(x35, l[3], s3); } { const f32x4 l = *(const LAS f32x4*)(Lc + 2076); s0 = fmaf(x36, l[0], s0); s1 = fmaf(x37, l[1], s1); s2 = fmaf(x38, l[2], s2); s3 = fmaf(x39, l[3], s3); } { const f32x4 l = *(const LAS f32x4*)(Lc + 2080); s0 = fmaf(x40, l[0], s0); s1 = fmaf(x41, l[1], s1); s2 = fmaf(x42, l[2], s2); s3 = fmaf(x43, l[3], s3); } { const f32x4 l = *(const LAS f32x4*)(Lc + 2084); s0 = fmaf(x44, l[0], s0); s1 = fmaf(x45, l[1], s1); s2 = fmaf(x46, l[2], s2); s3 = fmaf(x47, l[3], s3); } { const f32x4 l = *(const LAS f32x4*)(Lc + 2088); s0 = fmaf(x48, l[0], s0); s1 = fmaf(x49, l[1], s1); s2 = fmaf(x50, l[2], s2); s3 = fmaf(x51, l[3], s3); } { const f32x4 l = *(const LAS f32x4*)(Lc + 2092); s0 = fmaf(x52, l[0], s0); s1 = fmaf(x53, l[1], s1); s2 = fmaf(x54, l[2], s2); s3 = fmaf(x55, l[3], s3); } { const f32x4 l = *(const LAS f32x4*)(Lc + 2096); s0 = fmaf(x56, l[0], s0); s1 = fmaf(x57, l[1], s1); s2 = fmaf(x58, l[2], s2); s3 = fmaf(x59, l[3], s3); } { const f32x4 l = *(const LAS f32x4*)(Lc + 2100); s0 = fmaf(x60, l[0], s0); s1 = fmaf(x61, l[1], s1); s2 = fmaf(x62, l[2], s2); s3 = fmaf(x63, l[3], s3); } x30 = (lane == 30) ? 1.0f : -((s0 + s1) + (s2 + s3)); asm volatile("" : "+v"(x30) : : "memory"); }
    { float s0 = 0.f, s1 = 0.f, s2 = 0.f, s3 = 0.f; { const f32x4 l = *(const LAS f32x4*)(Lc + 2000); s2 = fmaf(x30, l[2], s2); s3 = fmaf(x31, l[3], s3); } { const f32x4 l = *(const LAS f32x4*)(Lc + 2004); s0 = fmaf(x32, l[0], s0); s1 = fmaf(x33, l[1], s1); s2 = fmaf(x34, l[2], s2); s3 = fmaf(x35, l[3], s3); } { const f32x4 l = *(const LAS f32x4*)(Lc + 2008); s0 = fmaf(x36, l[0], s0); s1 = fmaf(x37, l[1], s1); s2 = fmaf(x38, l[2], s2); s3 = fmaf(x39, l[3], s3); } { const f32x4 l = *(const LAS f32x4*)(Lc + 2012); s0 = fmaf(x40, l[0], s0); s1 = fmaf(x41, l[1], s1); s2 = fmaf(x42, l[2], s2); s3 = fmaf(x43, l[3], s3); } { const f32x4 l = *(const LAS f32x4*)(Lc + 2016); s0 = fmaf(x44, l[0], s0); s1 = fmaf(x45, l[1], s1); s2 = fmaf(x46, l[2], s2); s3 = fmaf(x47, l[3], s3); } { const f32x4 l = *(const LAS f32x4*)(Lc + 2020); s0 = fmaf(x48, l[0], s0); s1 = fmaf(x49, l[1], s1); s2 = fmaf(x50, l[2], s2); s3 = fmaf(x51, l[3], s3); } { const f32x4 l = *(const LAS f32x4*)(Lc + 2024); s0 = fmaf(x52, l[0], s0); s1 = fmaf(x53, l[1], s1); s2 = fmaf(x54, l[2], s2); s3 = fmaf(x55, l[3], s3); } { const f32x4 l = *(const LAS f32x4*)(Lc + 2028); s0 = fmaf(x56, l[0], s0); s1 = fmaf(x57, l[1], s1); s2 = fmaf(x58, l[2], s2); s3 = fmaf(x59, l[3], s3); } { const f32x4 l = *(const LAS f32x4*)(Lc + 2032); s0 = fmaf(x60, l[0], s0); s1 = fmaf(x61, l[1], s1); s2 = fmaf(x62, l[2], s2); s3 = fmaf(x63, l[3], s3); } x29 = (lane == 29) ? 1.0f : -((s0 + s1) + (s2 + s3)); asm volatile("" : "+v"(x29) : : "memory"); }
    { float s0 = 0.f, s1 = 0.f, s2 = 0.f, s3 = 0.f; { const f32x4 l = *(const LAS f32x4*)(Lc + 1932); s1 = fmaf(x29, l[1], s1); s2 = fmaf(x30, l[2], s2); s3 = fmaf(x31, l[3], s3); } { const f32x4 l = *(const LAS f32x4*)(Lc + 1936); s0 = fmaf(x32, l[0], s0); s1 = fmaf(x33, l[1], s1); s2 = fmaf(x34, l[2], s2); s3 = fmaf(x35, l[3], s3); } { const f32x4 l = *(const LAS f32x4*)(Lc + 1940); s0 = fmaf(x36, l[0], s0); s1 = fmaf(x37, l[1], s1); s2 = fmaf(x38, l[2], s2); s3 = fmaf(x39, l[3], s3); } { const f32x4 l = *(const LAS f32x4*)(Lc + 1944); s0 = fmaf(x40, l[0], s0); s1 = fmaf(x41, l[1], s1); s2 = fmaf(x42, l[2], s2); s3 = fmaf(x43, l[3], s3); } { const f32x4 l = *(const LAS f32x4*)(Lc + 1948); s0 = fmaf(x44, l[0], s0); s1 = fmaf(x45, l[1], s1); s2 = fmaf(x46, l[2], s2); s3 = fmaf(x47, l[3], s3); } { const f32x4 l = *(const LAS f32x4*)(Lc + 1952); s0 = fmaf(x48, l[0], s0); s1 = fmaf(x49, l[1], s1); s2 = fmaf(x50, l[2], s2); s3 = fmaf(x51, l[3], s3); } { const f32x4 l = *(const LAS f32x4*)(Lc + 1956); s0 = fmaf(x52, l[0], s0); s1 = fmaf(x53, l[1], s1); s2 = fmaf(x54, l[2], s2); s3 = fmaf(x55, l[3], s3); } { const f32x4 l = *(const LAS f32x4*)(Lc + 1960); s0 = fmaf(x56, l[0], s0); s1 = fmaf(x57, l[1], s1); s2 = fmaf(x58, l[2], s2); s3 = fmaf(x59, l[3], s3); } { const f32x4 l = *(const LAS f32x4*)(Lc + 1964); s0 = fmaf(x60, l[0], s0); s1 = fmaf(x61, l[1], s1); s2 = fmaf(x62, l[2], s2); s3 = fmaf(x63, l[3], s3); } x28 = (lane == 28) ? 1.0f : -((s0 + s1) + (s2 + s3)); asm volatile("" : "+v"(x28) : : "memory"); }
    { float s0 = 0.f, s1 = 0.f, s2 = 0.f, s3 = 0.f; { const f32x4 l = *(const LAS f32x4*)(Lc + 1864); s0 = fmaf(x28, l[0], s0); s1 = fmaf(x29, l[1], s1); s2 = fmaf(x30, l[2], s2); s3 = fmaf(x31, l[3], s3); } { const f32x4 l = *(const LAS f32x4*)(Lc + 1868); s0 = fmaf(x32, l[0], s0); s1 = fmaf(x33, l[1], s1); s2 = fmaf(x34, l[2], s2); s3 = fmaf(x35, l[3], s3); } { const f32x4 l = *(const LAS f32x4*)(Lc + 1872); s0 = fmaf(x36, l[0], s0); s1 = fmaf(x37, l[1], s1); s2 = fmaf(x38, l[2], s2); s3 = fmaf(x39, l[3], s3); } { const f32x4 l = *(const LAS f32x4*)(Lc + 1876); s0 = fmaf(x40, l[0], s0); s1 = fmaf(x41, l[1], s1); s2 = fmaf(x42, l[2], s2); s3 = fmaf(x43, l[3], s3); } { const f32x4 l = *(const LAS f32x4*)(Lc + 1880); s0 = fmaf(x44, l[0], s0); s1 = fmaf(x45, l[1], s1); s2 = fmaf(x46, l[2], s2); s3 = fmaf(x47, l[3], s3); } { const f32x4 l = *(const LAS f32x4*)(Lc + 1884); s0 = fmaf(x48, l[0], s0); s1 = fmaf(x49, l[1], s1); s2 = fmaf(x50, l[2], s2); s3 = fmaf(x51, l[3], s3); } { const f32x4 l = *(const LAS f32x4*)(Lc + 1888); s0 = fmaf(x52, l[0], s0); s1 = fmaf(x53, l[1], s1); s2 = fmaf(x54, l[2], s2); s3 = fmaf(x55, l[3], s3); } { const f32x4 l = *(const LAS f32x4*)(Lc + 1892); s0 = fmaf(x56, l[0], s0); s1 = fmaf(x57, l[1], s1); s2 = fmaf(x58, l[2], s2); s3 = fmaf(x59, l[3], s3); } { const f32x4 l = *(const LAS f32x4*)(Lc + 1896); s0 = fmaf(x60, l[0], s0); s1 = fmaf(x61, l[1], s1); s2 = fmaf(x62, l[2], s2); s3 = fmaf(x63, l[3], s3); } x27 = (lane == 27) ? 1.0f : -((s0 + s1) + (s2 + s3)); asm volatile("" : "+v"(x27) : : "memory"); }
    { float s0 = 0.f, s1 = 0.f, s2 = 0.f, s3 = 0.f; { const f32x4 l = *(const LAS f32x4*)(Lc + 1792); s3 = fmaf(x27, l[3], s3); } { const f32x4 l = *(const LAS f32x4*)(Lc + 1796); s0 = fmaf(x28, l[0], s0); s1 = fmaf(x29, l[1], s1); s2 = fmaf(x30, l[2], s2); s3 = fmaf(x31, l[3], s3); } { const f32x4 l = *(const LAS f32x4*)(Lc + 1800); s0 = fmaf(x32, l[0], s0); s1 = fmaf(x33, l[1], s1); s2 = fmaf(x34, l[2], s2); s3 = fmaf(x35, l[3], s3); } { const f32x4 l = *(const LAS f32x4*)(Lc + 1804); s0 = fmaf(x36, l[0], s0); s1 = fmaf(x37, l[1], s1); s2 = fmaf(x38, l[2], s2); s3 = fmaf(x39, l[3], s3); } { const f32x4 l = *(const LAS f32x4*)(Lc + 1808); s0 = fmaf(x40, l[0], s0); s1 = fmaf(x41, l[1], s1); s2 = fmaf(x42, l[2], s2); s3 = fmaf(x43, l[3], s3); } { const f32x4 l = *(const LAS f32x4*)(Lc + 1812); s0 = fmaf(x44, l[0], s0); s1 = fmaf(x45, l[1], s1); s2 = fmaf(x46, l[2], s2); s3 = fmaf(x47, l[3], s3); } { const f32x4 l = *(const LAS f32x4*)(Lc + 1816); s0 = fmaf(x48, l[0], s0); s1 = fmaf(x49, l[1], s1); s2 = fmaf(x50, l[2], s2); s3 = fmaf(x51, l[3], s3); } { const f32x4 l = *(const LAS f32x4*)(Lc + 1820); s0 = fmaf(x52, l[0], s0); s1 = fmaf(x53, l[1], s1); s2 = fmaf(x54, l[2], s2); s3 = fmaf(x55, l[3], s3); } { const f32x4 l = *(const LAS f32x4*)(Lc + 1824); s0 = fmaf(x56, l[0], s0); s1 = fmaf(x57, l[1], s1); s2 = fmaf(x58, l[2], s2); s3 = fmaf(x59, l[3], s3); } { const f32x4 l = *(const LAS f32x4*)(Lc + 1828); s0 = fmaf(x60, l[0], s0); s1 = fmaf(x61, l[1], s1); s2 = fmaf(x62, l[2], s2); s3 = fmaf(x63, l[3], s3); } x26 = (lane == 26) ? 1.0f : -((s0 + s1) + (s2 + s3)); asm volatile("" : "+v"(x26) : : "memory"); }
    { float s0 = 0.f, s1 = 0.f, s2 = 0.f, s3 = 0.f; { const f32x4 l = *(const LAS f32x4*)(Lc + 1724); s2 = fmaf(x26, l[2], s2); s3 = fmaf(x27, l[3], s3); } { const f32x4 l = *(const LAS f32x4*)(Lc + 1728); s0 = fmaf(x28, l[0], s0); s1 = fmaf(x29, l[1], s1); s2 = fmaf(x30, l[2], s2); s3 = fmaf(x31, l[3], s3); } { const f32x4 l = *(const LAS f32x4*)(Lc + 1732); s0 = fmaf(x32, l[0], s0); s1 = fmaf(x33, l[1], s1); s2 = fmaf(x34, l[2], s2); s3 = fmaf(x35, l[3], s3); } { const f32x4 l = *(const LAS f32x4*)(Lc + 1736); s0 = fmaf(x36, l[0], s0); s1 = fmaf(x37, l[1], s1); s2 = fmaf(x38, l[2], s2); s3 = fmaf(x39, l[3], s3); } { const f32x4 l = *(const LAS f32x4*)(Lc + 1740); s0 = fmaf(x40, l[0], s0); s1 = fmaf(x41, l[1], s1); s2 = fmaf(x42, l[2], s2); s3 = fmaf(x43, l[3], s3); } { const f32x4 l = *(const LAS f32x4*)(Lc + 1744); s0 = fmaf(x44, l[0], s0); s1 = fmaf(x45, l[1], s1); s2 = fmaf(x46, l[2], s2); s3 = fmaf(x47, l[3], s3); } { const f32x4 l = *(const LAS f32x4*)(Lc + 1748); s0 = fmaf(x48, l[0], s0); s1 = fmaf(x49, l[1], s1); s2 = fmaf(x50, l[2], s2); s3 = fmaf(x51, l[3], s3); } { const f32x4 l = *(const LAS f32x4*)(Lc + 1752); s0 = fmaf(x52, l[0], s0); s1 = fmaf(x53, l[1], s1); s2 = fmaf(x54, l[2], s2); s3 = fmaf(x55, l[3], s3); } { const f32x4 l = *(const LAS f32x4*)(Lc + 1756); s0 = fmaf(x56, l[0], s0); s1 = fmaf(x57, l[1], s1); s2 = fmaf(x58, l[2], s2); s3 = fmaf(x59, l[3], s3); } { const f32x4 l = *(const LAS f32x4*)(Lc + 1760); s0 = fmaf(x60, l[0], s0); s1 = fmaf(x61, l[1], s1); s2 = fmaf(x62, l[2], s2); s3 = fmaf(x63, l[3], s3); } x25 = (lane == 25) ? 1.0f : -((s0 + s1) + (s2 + s3)); asm volatile("" : "+v"(x25) : : "memory"); }
    { float s0 = 0.f, s1 = 0.f, s2 = 0.f, s3 = 0.f; { const f32x4 l = *(const LAS f32x4*)(Lc + 1656); s1 = fmaf(x25, l[1], s1); s2 = fmaf(x26, l[2], s2); s3 = fmaf(x27, l[3], s3); } { const f32x4 l = *(const LAS f32x4*)(Lc + 1660); s0 = fmaf(x28, l[0], s0); s1 = fmaf(x29, l[1], s1); s2 = fmaf(x30, l[2], s2); s3 = fmaf(x31, l[3], s3); } { const f32x4 l = *(const LAS f32x4*)(Lc + 1664); s0 = fmaf(x32, l[0], s0); s1 = fmaf(x33, l[1], s1); s2 = fmaf(x34, l[2], s2); s3 = fmaf(x35, l[3], s3); } { const f32x4 l = *(const LAS f32x4*)(Lc + 1668); s0 = fmaf(x36, l[0], s0); s1 = fmaf(x37, l[1], s1); s2 = fmaf(x38, l[2], s2); s3 = fmaf(x39, l[3], s3); } { const f32x4 l = *(const LAS f32x4*)(Lc + 1672); s0 = fmaf(x40, l[0], s0); s1 = fmaf(x41, l[1], s1); s2 = fmaf(x42, l[2], s2); s3 = fmaf(x43, l[3], s3); } { const f32x4 l = *(const LAS f32x4*)(Lc + 1676); s0 = fmaf(x44, l[0], s0); s1 = fmaf(x45, l[1], s1); s2 = fmaf(x46, l[2], s2); s3 = fmaf(x47, l[3], s3); } { const f32x4 l = *(const LAS f32x4*)(Lc + 1680); s0 = fmaf(x48, l[0], s0); s1 = fmaf(x49, l[1], s1); s2 = fmaf(x50, l[2], s2); s3 = fmaf(x51, l[3], s3); } { const f32x4 l = *(const LAS f32x4*)(Lc + 1684); s0 = fmaf(x52, l[0], s0); s1 = fmaf(x53, l[1], s1); s2 = fmaf(x54, l[2], s2); s3 = fmaf(x55, l[3], s3); } { const f32x4 l = *(const LAS f32x4*)(Lc + 1688); s0 = fmaf(x56, l[0], s0); s1 = fmaf(x57, l[1], s1); s2 = fmaf(x58, l[2], s2); s3 = fmaf(x59, l[3], s3); } { const f32x4 l = *(const LAS f32x4*)(Lc + 1692); s0 = fmaf(x60, l[0], s0); s1 = fmaf(x61, l[1], s1); s2 = fmaf(x62, l[2], s2); s3 = fmaf(x63, l[3], s3); } x24 = (lane == 24) ? 1.0f : -((s0 + s1) + (s2 + s3)); asm volatile("" : "+v"(x24) : : "memory"); }
    { float s0 = 0.f, s1 = 0.f, s2 = 0.f, s3 = 0.f; { const f32x4 l = *(const LAS f32x4*)(Lc + 1588); s0 = fmaf(x24, l[0], s0); s1 = fmaf(x25, l[1], s1); s2 = fmaf(x26, l[2], s2); s3 = fmaf(x27, l[3], s3); } { const f32x4 l = *(const LAS f32x4*)(Lc + 1592); s0 = fmaf(x28, l[0], s0); s1 = fmaf(x29, l[1], s1); s2 = fmaf(x30, l[2], s2); s3 = fmaf(x31, l[3], s3); } { const f32x4 l = *(const LAS f32x4*)(Lc + 1596); s0 = fmaf(x32, l[0], s0); s1 = fmaf(x33, l[1], s1); s2 = fmaf(x34, l[2], s2); s3 = fmaf(x35, l[3], s3); } { const f32x4 l = *(const LAS f32x4*)(Lc + 1600); s0 = fmaf(x36, l[0], s0); s1 = fmaf(x37, l[1], s1); s2 = fmaf(x38, l[2], s2); s3 = fmaf(x39, l[3], s3); } { const f32x4 l = *(const LAS f32x4*)(Lc + 1604); s0 = fmaf(x40, l[0], s0); s1 = fmaf(x41, l[1], s1); s2 = fmaf(x42, l[2], s2); s3 = fmaf(x43, l[3], s3); } { const f32x4 l = *(const LAS f32x4*)(Lc + 1608); s0 = fmaf(x44, l[0], s0); s1 = fmaf(x45, l[1], s1); s2 = fmaf(x46, l[2], s2); s3 = fmaf(x47, l[3], s3); } { const f32x4 l = *(const LAS f32x4*)(Lc + 1612); s0 = fmaf(x48, l[0], s0); s1 = fmaf(x49, l[1], s1); s2 = fmaf(x50, l[2], s2); s3 = fmaf(x51, l[3], s3); } { const f32x4 l = *(const LAS f32x4*)(Lc + 1616); s0 = fmaf(x52, l[0], s0); s1 = fmaf(x53, l[1], s1); s2 = fmaf(x54, l[2], s2); s3 = fmaf(x55, l[3], s3); } { const f32x4 l = *(const LAS f32x4*)(Lc + 1620); s0 = fmaf(x56, l[0], s0); s1 = fmaf(x57, l[1], s1); s2 = fmaf(x58, l[2], s2); s3 = fmaf(x59, l[3], s3); } { const f32x4 l = *(const LAS f32x4*)(Lc + 1624); s0 = fmaf(x60, l[0], s0); s1 = fmaf(x61, l[1], s1); s2 = fmaf(x62, l[2], s2); s3 = fmaf(x63, l[3], s3); } x23 = (lane == 23) ? 1.0f : -((s0 + s1) + (s2 + s3)); asm volatile("" : "+v"(x23) : : "memory"); }
    { float s0 = 0.f, s1 = 0.f, s2 = 0.f, s3 = 0.f; { const f32x4 l = *(const LAS f32x4*)(Lc + 1516); s3 = fmaf(x23, l[3], s3); } { const f32x4 l = *(const LAS f32x4*)(Lc + 1520); s0 = fmaf(x24, l[0], s0); s1 = fmaf(x25, l[1], s1); s2 = fmaf(x26, l[2], s2); s3 = fmaf(x27, l[3], s3); } { const f32x4 l = *(const LAS f32x4*)(Lc + 1524); s0 = fmaf(x28, l[0], s0); s1 = fmaf(x29, l[1], s1); s2 = fmaf(x30, l[2], s2); s3 = fmaf(x31, l[3], s3); } { const f32x4 l = *(const LAS f32x4*)(Lc + 1528); s0 = fmaf(x32, l[0], s0); s1 = fmaf(x33, l[1], s1); s2 = fmaf(x34, l[2], s2); s3 = fmaf(x35, l[3], s3); } { const f32x4 l = *(const LAS f32x4*)(Lc + 1532); s0 = fmaf(x36, l[0], s0); s1 = fmaf(x37, l[1], s1); s2 = fmaf(x38, l[2], s2); s3 = fmaf(x39, l[3], s3); } { const f32x4 l = *(const LAS f32x4*)(Lc + 1536); s0 = fmaf(x40, l[0], s0); s1 = fmaf(x41, l[1], s1); s2 = fmaf(x42, l[2], s2); s3 = fmaf(x43, l[3], s3); } { const f32x4 l = *(const LAS f32x4*)(Lc + 1540); s0 = fmaf(x44, l[0], s0); s1 = fmaf(x45, l[1], s1); s2 = fmaf(x46, l[2], s2); s3 = fmaf(x47, l[3], s3); } { const f32x4 l = *(const LAS f32x4*)(Lc + 1544); s0 = fmaf(x48, l[0], s0); s1 = fmaf(x49, l[1], s1); s2 = fmaf(x50, l[2], s2); s3 = fmaf(x51, l[3], s3); } { const f32x4 l = *(const LAS f32x4*)(Lc + 1548); s0 = fmaf(x52, l[0], s0); s1 = fmaf(x53, l[1], s1); s2 = fmaf(x54, l[2], s2); s3 = fmaf(x55, l[3], s3); } { const f32x4 l = *(const LAS f32x4*)(Lc + 1552); s0 = fmaf(x56, l[0], s0); s1 = fmaf(x57, l[1], s1); s2 = fmaf(x58, l[2], s2); s3 = fmaf(x59, l[3], s3); } { const f32x4 l = *(const LAS f32x4*)(Lc + 1556); s0 = fmaf(x60, l[0], s0); s1 = fmaf(x61, l[1], s1); s2 = fmaf(x62, l[2], s2); s3 = fmaf(x63, l[3], s3); } x22 = (lane == 22) ? 1.0f : -((s0 + s1) + (s2 + s3)); asm volatile("" : "+v"(x22) : : "memory"); }
    { float s0 = 0.f, s1 = 0.f, s2 = 0.f, s3 = 0.f; { const f32x4 l = *(const LAS f32x4*)(Lc + 1448); s2 = fmaf(x22, l[2], s2); s3 = fmaf(x23, l[3], s3); } { const f32x4 l = *(const LAS f32x4*)(Lc + 1452); s0 = fmaf(x24, l[0], s0); s1 = fmaf(x25, l[1], s1); s2 = fmaf(x26, l[2], s2); s3 = fmaf(x27, l[3], s3); } { const f32x4 l = *(const LAS f32x4*)(Lc + 1456); s0 = fmaf(x28, l[0], s0); s1 = fmaf(x29, l[1], s1); s2 = fmaf(x30, l[2], s2); s3 = fmaf(x31, l[3], s3); } { const f32x4 l = *(const LAS f32x4*)(Lc + 1460); s0 = fmaf(x32, l[0], s0); s1 = fmaf(x33, l[1], s1); s2 = fmaf(x34, l[2], s2); s3 = fmaf(x35, l[3], s3); } { const f32x4 l = *(const LAS f32x4*)(Lc + 1464); s0 = fmaf(x36, l[0], s0); s1 = fmaf(x37, l[1], s1); s2 = fmaf(x38, l[2], s2); s3 = fmaf(x39, l[3], s3); } { const f32x4 l = *(const LAS f32x4*)(Lc + 1468); s0 = fmaf(x40, l[0], s0); s1 = fmaf(x41, l[1], s1); s2 = fmaf(x42, l[2], s2); s3 = fmaf(x43, l[3], s3); } { const f32x4 l = *(const LAS f32x4*)(Lc + 1472); s0 = fmaf(x44, l[0], s0); s1 = fmaf(x45, l[1], s1); s2 = fmaf(x46, l[2], s2); s3 = fmaf(x47, l[3], s3); } { const f32x4 l = *(const LAS f32x4*)(Lc + 1476); s0 = fmaf(x48, l[0], s0); s1 = fmaf(x49, l[1], s1); s2 = fmaf(x50, l[2], s2); s3 = fmaf(x51, l[3], s3); } { const f32x4 l = *(const LAS f32x4*)(Lc + 1480); s0 = fmaf(x52, l[0], s0); s1 = fmaf(x53, l[1], s1); s2 = fmaf(x54, l[2], s2); s3 = fmaf(x55, l[3], s3); } { const f32x4 l = *(const LAS f32x4*)(Lc + 1484); s0 = fmaf(x56, l[0], s0); s1 = fmaf(x57, l[1], s1); s2 = fmaf(x58, l[2], s2); s3 = fmaf(x59, l[3], s3); } { const f32x4 l = *(const LAS f32x4*)(Lc + 1488); s0 = fmaf(x60, l[0], s0); s1 = fmaf(x61, l[1], s1); s2 = fmaf(x62, l[2], s2); s3 = fmaf(x63, l[3], s3); } x21 = (lane == 21) ? 1.0f : -((s0 + s1) + (s2 + s3)); asm volatile("" : "+v"(x21) : : "memory"); }
    { float s0 = 0.f, s1 = 0.f, s2 = 0.f, s3 = 0.f; { const f32x4 l = *(const LAS f32x4*)(Lc + 1380); s1 = fmaf(x21, l[1], s1); s2 = fmaf(x22, l[2], s2); s3 = fmaf(x23, l[3], s3); } { const f32x4 l = *(const LAS f32x4*)(Lc + 1384); s0 = fmaf(x24, l[0], s0); s1 = fmaf(x25, l[1], s1); s2 = fmaf(x26, l[2], s2); s3 = fmaf(x27, l[3], s3); } { const f32x4 l = *(const LAS f32x4*)(Lc + 1388); s0 = fmaf(x28, l[0], s0); s1 = fmaf(x29, l[1], s1); s2 = fmaf(x30, l[2], s2); s3 = fmaf(x31, l[3], s3); } { const f32x4 l = *(const LAS f32x4*)(Lc + 1392); s0 = fmaf(x32, l[0], s0); s1 = fmaf(x33, l[1], s1); s2 = fmaf(x34, l[2], s2); s3 = fmaf(x35, l[3], s3); } { const f32x4 l = *(const LAS f32x4*)(Lc + 1396); s0 = fmaf(x36, l[0], s0); s1 = fmaf(x37, l[1], s1); s2 = fmaf(x38, l[2], s2); s3 = fmaf(x39, l[3], s3); } { const f32x4 l = *(const LAS f32x4*)(Lc + 1400); s0 = fmaf(x40, l[0], s0); s1 = fmaf(x41, l[1], s1); s2 = fmaf(x42, l[2], s2); s3 = fmaf(x43, l[3], s3); } { const f32x4 l = *(const LAS f32x4*)(Lc + 1404); s0 = fmaf(x44, l[0], s0); s1 = fmaf(x45, l[1], s1); s2 = fmaf(x46, l[2], s2); s3 = fmaf(x47, l[3], s3); } { const f32x4 l = *(const LAS f32x4*)(Lc + 1408); s0 = fmaf(x48, l[0], s0); s1 = fmaf(x49, l[1], s1); s2 = fmaf(x50, l[2], s2); s3 = fmaf(x51, l[3], s3); } { const f32x4 l = *(const LAS f32x4*)(Lc + 1412); s0 = fmaf(x52, l[0], s0); s1 = fmaf(x53, l[1], s1); s2 = fmaf(x54, l[2], s2); s3 = fmaf(x55, l[3], s3); } { const f32x4 l = *(const LAS f32x4*)(Lc + 1416); s0 = fmaf(x56, l[0], s0); s1 = fmaf(x57, l[1], s1); s2 = fmaf(x58, l[2], s2); s3 = fmaf(x59, l[3], s3); } { const f32x4 l = *(const LAS f32x4*)(Lc + 1420); s0 = fmaf(x60, l[0], s0); s1 = fmaf(x61, l[1], s1); s2 = fmaf(x62, l[2], s2); s3 = fmaf(x63, l[3], s3); } x20 = (lane == 20) ? 1.0f : -((s0 + s1) + (s2 + s3)); asm volatile("" : "+v"(x20) : : "memory"); }
    { float s0 = 0.f, s1 = 0.f, s2 = 0.f, s3 = 0.f; { const f32x4 l = *(const LAS f32x4*)(Lc + 1312); s0 = fmaf(x20, l[0], s0); s1 = fmaf(x21, l[1], s1); s2 = fmaf(x22, l[2], s2); s3 = fmaf(x23, l[3], s3); } { const f32x4 l = *(const LAS f32x4*)(Lc + 1316); s0 = fmaf(x24, l[0], s0); s1 = fmaf(x25, l[1], s1); s2 = fmaf(x26, l[2], s2); s3 = fmaf(x27, l[3], s3); } { const f32x4 l = *(const LAS f32x4*)(Lc + 1320); s0 = fmaf(x28, l[0], s0); s1 = fmaf(x29, l[1], s1); s2 = fmaf(x30, l[2], s2); s3 = fmaf(x31, l[3], s3); } { const f32x4 l = *(const LAS f32x4*)(Lc + 1324); s0 = fmaf(x32, l[0], s0); s1 = fmaf(x33, l[1], s1); s2 = fmaf(x34, l[2], s2); s3 = fmaf(x35, l[3], s3); } { const f32x4 l = *(const LAS f32x4*)(Lc + 1328); s0 = fmaf(x36, l[0], s0); s1 = fmaf(x37, l[1], s1); s2 = fmaf(x38, l[2], s2); s3 = fmaf(x39, l[3], s3); } { const f32x4 l = *(const LAS f32x4*)(Lc + 1332); s0 = fmaf(x40, l[0], s0); s1 = fmaf(x41, l[1], s1); s2 = fmaf(x42, l[2], s2); s3 = fmaf(x43, l[3], s3); } { const f32x4 l = *(const LAS f32x4*)(Lc + 1336); s0 = fmaf(x44, l[0], s0); s1 = fmaf(x45, l[1], s1); s2 = fmaf(x46, l[2], s2); s3 = fmaf(x47, l[3], s3); } { const f32x4 l = *(const LAS f32x4*)(Lc + 1340); s0 = fmaf(x48, l[0], s0); s1 = fmaf(x49, l[1], s1); s2 = fmaf(x50, l[2], s2); s3 = fmaf(x51, l[3], s3); } { const f32x4 l = *(const LAS f32x4*)(Lc + 1344); s0 = fmaf(x52, l[0], s0); s1 = fmaf(x53, l[1], s1); s2 = fmaf(x54, l[2], s2); s3 = fmaf(x55, l[3], s3); } { const f32x4 l = *(const LAS f32x4*)(Lc + 1348); s0 = fmaf(x56, l[0], s0); s1 = fmaf(x57, l[1], s1); s2 = fmaf(x58, l[2], s2); s3 = fmaf(x59, l[3], s3); } { const f32x4 l = *(const LAS f32x4*)(Lc + 1352); s0 = fmaf(x60, l[0], s0); s1 = fmaf(x61, l[1], s1); s2 = fmaf(x62, l[2], s2); s3 = fmaf(x63, l[3], s3); } x19 = (lane == 19) ? 1.0f : -((s0 + s1) + (s2 + s3)); asm volatile("" : "+v"(x19) : : "memory"); }
    { float s0 = 0.f, s1 = 0.f, s2 = 0.f, s3 = 0.f; { const f32x4 l = *(const LAS f32x4*)(Lc + 1240); s3 = fmaf(x19, l[3], s3); } { const f32x4 l = *(const LAS f32x4*)(Lc + 1244); s0 = fmaf(x20, l[0], s0); s1 = fmaf(x21, l[1], s1); s2 = fmaf(x22, l[2], s2); s3 = fmaf(x23, l[3], s3); } { const f32x4 l = *(const LAS f32x4*)(Lc + 1248); s0 = fmaf(x24, l[0], s0); s1 = fmaf(x25, l[1], s1); s2 = fmaf(x26, l[2], s2); s3 = fmaf(x27, l[3], s3); } { const f32x4 l = *(const LAS f32x4*)(Lc + 1252); s0 = fmaf(x28, l[0], s0); s1 = fmaf(x29, l[1], s1); s2 = fmaf(x30, l[2], s2); s3 = fmaf(x31, l[3], s3); } { const f32x4 l = *(const LAS f32x4*)(Lc + 1256); s0 = fmaf(x32, l[0], s0); s1 = fmaf(x33, l[1], s1); s2 = fmaf(x34, l[2], s2); s3 = fmaf(x35, l[3], s3); } { const f32x4 l = *(const LAS f32x4*)(Lc + 1260); s0 = fmaf(x36, l[0], s0); s1 = fmaf(x37, l[1], s1); s2 = fmaf(x38, l[2], s2); s3 = fmaf(x39, l[3], s3); } { const f32x4 l = *(const LAS f32x4*)(Lc + 1264); s0 = fmaf(x40, l[0], s0); s1 = fmaf(x41, l[1], s1); s2 = fmaf(x42, l[2], s2); s3 = fmaf(x43, l[3], s3); } { const f32x4 l = *(const LAS f32x4*)(Lc + 1268); s0 = fmaf(x44, l[0], s0); s1 = fmaf(x45, l[1], s1); s2 = fmaf(x46, l[2], s2); s3 = fmaf(x47, l[3], s3); } { const f32x4 l = *(const LAS f32x4*)(Lc + 1272); s0 = fmaf(x48, l[0], s0); s1 = fmaf(x49, l[1], s1); s2 = fmaf(x50, l[2], s2); s3 = fmaf(x51, l[3], s3); } { const f32x4 l = *(const LAS f32x4*)(Lc + 1276); s0 = fmaf(x52, l[0], s0); s1 = fmaf(x53, l[1], s1); s2 = fmaf(x54, l[2], s2); s3 = fmaf(x55, l[3], s3); } { const f32x4 l = *(const LAS f32x4*)(Lc + 1280); s0 = fmaf(x56, l[0], s0); s1 = fmaf(x57, l[1], s1); s2 = fmaf(x58, l[2], s2); s3 = fmaf(x59, l[3], s3); } { const f32x4 l = *(const LAS f32x4*)(Lc + 1284); s0 = fmaf(x60, l[0], s0); s1 = fmaf(x61, l[1], s1); s2 = fmaf(x62, l[2], s2); s3 = fmaf(x63, l[3], s3); } x18 = (lane == 18) ? 1.0f : -((s0 + s1) + (s2 + s3)); asm volatile("" : "+v"(x18) : : "memory"); }
    { float s0 = 0.f, s1 = 0.f, s2 = 0.f, s3 = 0.f; { const f32x4 l = *(const LAS f32x4*)(Lc + 1172); s2 = fmaf(x18, l[2], s2); s3 = fmaf(x19, l[3], s3); } { const f32x4 l = *(const LAS f32x4*)(Lc + 1176); s0 = fmaf(x20, l[0], s0); s1 = fmaf(x21, l[1], s1); s2 = fmaf(x22, l[2], s2); s3 = fmaf(x23, l[3], s3); } { const f32x4 l = *(const LAS f32x4*)(Lc + 1180); s0 = fmaf(x24, l[0], s0); s1 = fmaf(x25, l[1], s1); s2 = fmaf(x26, l[2], s2); s3 = fmaf(x27, l[3], s3); } { const f32x4 l = *(const LAS f32x4*)(Lc + 1184); s0 = fmaf(x28, l[0], s0); s1 = fmaf(x29, l[1], s1); s2 = fmaf(x30, l[2], s2); s3 = fmaf(x31, l[3], s3); } { const f32x4 l = *(const LAS f32x4*)(Lc + 1188); s0 = fmaf(x32, l[0], s0); s1 = fmaf(x33, l[1], s1); s2 = fmaf(x34, l[2], s2); s3 = fmaf(x35, l[3], s3); } { const f32x4 l = *(const LAS f32x4*)(Lc + 1192); s0 = fmaf(x36, l[0], s0); s1 = fmaf(x37, l[1], s1); s2 = fmaf(x38, l[2], s2); s3 = fmaf(x39, l[3], s3); } { const f32x4 l = *(const LAS f32x4*)(Lc + 1196); s0 = fmaf(x40, l[0], s0); s1 = fmaf(x41, l[1], s1); s2 = fmaf(x42, l[2], s2); s3 = fmaf(x43, l[3], s3); } { const f32x4 l = *(const LAS f32x4*)(Lc + 1200); s0 = fmaf(x44, l[0], s0); s1 = fmaf(x45, l[1], s1); s2 = fmaf(x46, l[2], s2); s3 = fmaf(x47, l[3], s3); } { const f32x4 l = *(const LAS f32x4*)(Lc + 1204); s0 = fmaf(x48, l[0], s0); s1 = fmaf(x49, l[1], s1); s2 = fmaf(x50, l[2], s2); s3 = fmaf(x51, l[3], s3); } { const f32x4 l = *(const LAS f32x4*)(Lc + 1208); s0 = fmaf(x52, l[0], s0); s1 = fmaf(x53, l[1], s1); s2 = fmaf(x54, l[2], s2); s3 = fmaf(x55, l[3], s3); } { const f32x4 l = *(const LAS f32x4*)(Lc + 1212); s0 = fmaf(x56, l[0], s0); s1 = fmaf(x57, l[1], s1); s2 = fmaf(x58, l[2], s2); s3 = fmaf(x59, l[3], s3); } { const f32x4 l = *(const LAS f32x4*)(Lc + 1216); s0 = fmaf(x60, l[0], s0); s1 = fmaf(x61, l[1], s1); s2 = fmaf(x62, l[2], s2); s3 = fmaf(x63, l[3], s3); } x17 = (lane == 17) ? 1.0f : -((s0 + s1) + (s2 + s3)); asm volatile("" : "+v"(x17) : : "memory"); }
    { float s0 = 0.f, s1 = 0.f, s2 = 0.f, s3 = 0.f; { const f32x4 l = *(const LAS f32x4*)(Lc + 1104); s1 = fmaf(x17, l[1], s1); s2 = fmaf(x18, l[2], s2); s3 = fmaf(x19, l[3], s3); } { const f32x4 l = *(const LAS f32x4*)(Lc + 1108); s0 = fmaf(x20, l[0], s0); s1 = fmaf(x21, l[1], s1); s2 = fmaf(x22, l[2], s2); s3 = fmaf(x23, l[3], s3); } { const f32x4 l = *(const LAS f32x4*)(Lc + 1112); s0 = fmaf(x24, l[0], s0); s1 = fmaf(x25, l[1], s1); s2 = fmaf(x26, l[2], s2); s3 = fmaf(x27, l[3], s3); } { const f32x4 l = *(const LAS f32x4*)(Lc + 1116); s0 = fmaf(x28, l[0], s0); s1 = fmaf(x29, l[1], s1); s2 = fmaf(x30, l[2], s2); s3 = fmaf(x31, l[3], s3); } { const f32x4 l = *(const LAS f32x4*)(Lc + 1120); s0 = fmaf(x32, l[0], s0); s1 = fmaf(x33, l[1], s1); s2 = fmaf(x34, l[2], s2); s3 = fmaf(x35, l[3], s3); } { const f32x4 l = *(const LAS f32x4*)(Lc + 1124); s0 = fmaf(x36, l[0], s0); s1 = fmaf(x37, l[1], s1); s2 = fmaf(x38, l[2], s2); s3 = fmaf(x39, l[3], s3); } { const f32x4 l = *(const LAS f32x4*)(Lc + 1128); s0 = fmaf(x40, l[0], s0); s1 = fmaf(x41, l[1], s1); s2 = fmaf(x42, l[2], s2); s3 = fmaf(x43, l[3], s3); } { const f32x4 l = *(const LAS f32x4*)(Lc + 1132); s0 = fmaf(x44, l[0], s0); s1 = fmaf(x45, l[1], s1); s2 = fmaf(x46, l[2], s2); s3 = fmaf(x47, l[3], s3); } { const f32x4 l = *(const LAS f32x4*)(Lc + 1136); s0 = fmaf(x48, l[0], s0); s1 = fmaf(x49, l[1], s1); s2 = fmaf(x50, l[2], s2); s3 = fmaf(x51, l[3], s3); } { const f32x4 l = *(const LAS f32x4*)(Lc + 1140); s0 = fmaf(x52, l[0], s0); s1 = fmaf(x53, l[1], s1); s2 = fmaf(x54, l[2], s2); s3 = fmaf(x55, l[3], s3); } { const f32x4 l = *(const LAS f32x4*)(Lc + 1144); s0 = fmaf(x56, l[0], s0); s1 = fmaf(x57, l[1], s1); s2 = fmaf(x58, l[2], s2); s3 = fmaf(x59, l[3], s3); } { const f32x4 l = *(const LAS f32x4*)(Lc + 1148); s0 = fmaf(x60, l[0], s0); s1 = fmaf(x61, l[1], s1); s2 = fmaf(x62, l[2], s2); s3 = fmaf(x63, l[3], s3); } x16 = (lane == 16) ? 1.0f : -((s0 + s1) + (s2 + s3)); asm volatile("" : "+v"(x16) : : "memory"); }
    { float s0 = 0.f, s1 = 0.f, s2 = 0.f, s3 = 0.f; { const f32x4 l = *(const LAS f32x4*)(Lc + 1036); s0 = fmaf(x16, l[0], s0); s1 = fmaf(x17, l[1], s1); s2 = fmaf(x18, l[2], s2); s3 = fmaf(x19, l[3], s3); } { const f32x4 l = *(const LAS f32x4*)(Lc + 1040); s0 = fmaf(x20, l[0], s0); s1 = fmaf(x21, l[1], s1); s2 = fmaf(x22, l[2], s2); s3 = fmaf(x23, l[3], s3); } { const f32x4 l = *(const LAS f32x4*)(Lc + 1044); s0 = fmaf(x24, l[0], s0); s1 = fmaf(x25, l[1], s1); s2 = fmaf(x26, l[2], s2); s3 = fmaf(x27, l[3], s3); } { const f32x4 l = *(const LAS f32x4*)(Lc + 1048); s0 = fmaf(x28, l[0], s0); s1 = fmaf(x29, l[1], s1); s2 = fmaf(x30, l[2], s2); s3 = fmaf(x31, l[3], s3); } { const f32x4 l = *(const LAS f32x4*)(Lc + 1052); s0 = fmaf(x32, l[0], s0); s1 = fmaf(x33, l[1], s1); s2 = fmaf(x34, l[2], s2); s3 = fmaf(x35, l[3], s3); } { const f32x4 l = *(const LAS f32x4*)(Lc + 1056); s0 = fmaf(x36, l[0], s0); s1 = fmaf(x37, l[1], s1); s2 = fmaf(x38, l[2], s2); s3 = fmaf(x39, l[3], s3); } { const f32x4 l = *(const LAS f32x4*)(Lc + 1060); s0 = fmaf(x40, l[0], s0); s1 = fmaf(x41, l[1], s1); s2 = fmaf(x42, l[2], s2); s3 = fmaf(x43, l[3], s3); } { const f32x4 l = *(const LAS f32x4*)(Lc + 1064); s0 = fmaf(x44, l[0], s0); s1 = fmaf(x45, l[1], s1); s2 = fmaf(x46, l[2], s2); s3 = fmaf(x47, l[3], s3); } { const f32x4 l = *(const LAS f32x4*)(Lc + 1068); s0 = fmaf(x48, l[0], s0); s1 = fmaf(x49, l[1], s1); s2 = fmaf(x50, l[2], s2); s3 = fmaf(x51, l[3], s3); } { const f32x4 l = *(const LAS f32x4*)(Lc + 1072); s0 = fmaf(x52, l[0], s0); s1 = fmaf(x53, l[1], s1); s2 = fmaf(x54, l[2], s2); s3 = fmaf(x55, l[3], s3); } { const f32x4 l = *(const LAS f32x4*)(Lc + 1076); s0 = fmaf(x56, l[0], s0); s1 = fmaf(x57, l[1], s1); s2 = fmaf(x58, l[2], s2); s3 = fmaf(x59, l[3], s3); } { const f32x4 l = *(const LAS f32x4*)(Lc + 1080); s0 = fmaf(x60, l[0], s0); s1 = fmaf(x61, l[1], s1); s2 = fmaf(x62, l[2], s2); s3 = fmaf(x63, l[3], s3); } x15 = (lane == 15) ? 1.0f : -((s0 + s1) + (s2 + s3)); asm volatile("" : "+v"(x15) : : "memory"); }
    { float s0 = 0.f, s1 = 0.f, s2 = 0.f, s3 = 0.f; { const f32x4 l = *(const LAS f32x4*)(Lc + 964); s3 = fmaf(x15, l[3], s3); } { const f32x4 l = *(const LAS f32x4*)(Lc + 968); s0 = fmaf(x16, l[0], s0); s1 = fmaf(x17, l[1], s1); s2 = fmaf(x18, l[2], s2); s3 = fmaf(x19, l[3], s3); } { const f32x4 l = *(const LAS f32x4*)(Lc + 972); s0 = fmaf(x20, l[0], s0); s1 = fmaf(x21, l[1], s1); s2 = fmaf(x22, l[2], s2); s3 = fmaf(x23, l[3], s3); } { const f32x4 l = *(const LAS f32x4*)(Lc + 976); s0 = fmaf(x24, l[0], s0); s1 = fmaf(x25, l[1], s1); s2 = fmaf(x26, l[2], s2); s3 = fmaf(x27, l[3], s3); } { const f32x4 l = *(const LAS f32x4*)(Lc + 980); s0 = fmaf(x28, l[0], s0); s1 = fmaf(x29, l[1], s1); s2 = fmaf(x30, l[2], s2); s3 = fmaf(x31, l[3], s3); } { const f32x4 l = *(const LAS f32x4*)(Lc + 984); s0 = fmaf(x32, l[0], s0); s1 = fmaf(x33, l[1], s1); s2 = fmaf(x34, l[2], s2); s3 = fmaf(x35, l[3], s3); } { const f32x4 l = *(const LAS f32x4*)(Lc + 988); s0 = fmaf(x36, l[0], s0); s1 = fmaf(x37, l[1], s1); s2 = fmaf(x38, l[2], s2); s3 = fmaf(x39, l[3], s3); } { const f32x4 l = *(const LAS f32x4*)(Lc + 992); s0 = fmaf(x40, l[0], s0); s1 = fmaf(x41, l[1], s1); s2 = fmaf(x42, l[2], s2); s3 = fmaf(x43, l[3], s3); } { const f32x4 l = *(const LAS f32x4*)(Lc + 996); s0 = fmaf(x44, l[0], s0); s1 = fmaf(x45, l[1], s1); s2 = fmaf(x46, l[2], s2); s3 = fmaf(x47, l[3], s3); } { const f32x4 l = *(const LAS f32x4*)(Lc + 1000); s0 = fmaf(x48, l[0], s0); s1 = fmaf(x49, l[1], s1); s2 = fmaf(x50, l[2], s2); s3 = fmaf(x51, l[3], s3); } { const f32x4 l = *(const LAS f32x4*)(Lc + 1004); s0 = fmaf(x52, l[0], s0); s1 = fmaf(x53, l[1], s1); s2 = fmaf(x54, l[2], s2); s3 = fmaf(x55, l[3], s3); } { const f32x4 l = *(const LAS f32x4*)(Lc + 1008); s0 = fmaf(x56, l[0], s0); s1 = fmaf(x57, l[1], s1); s2 = fmaf(x58, l[2], s2); s3 = fmaf(x59, l[3], s3); } { const f32x4 l = *(const LAS f32x4*)(Lc + 1012); s0 = fmaf(x60, l[0], s0); s1 = fmaf(x61, l[1], s1); s2 = fmaf(x62, l[2], s2); s3 = fmaf(x63, l[3], s3); } x14 = (lane == 14) ? 1.0f : -((s0 + s1) + (s2 + s3)); asm volatile("" : "+v"(x14) : : "memory"); }
    { float s0 = 0.f, s1 = 0.f, s2 = 0.f, s3 = 0.f; { const f32x4 l = *(const LAS f32x4*)(Lc + 896); s2 = fmaf(x14, l[2], s2); s3 = fmaf(x15, l[3], s3); } { const f32x4 l = *(const LAS f32x4*)(Lc + 900); s0 = fmaf(x16, l[0], s0); s1 = fmaf(x17, l[1], s1); s2 = fmaf(x18, l[2], s2); s3 = fmaf(x19, l[3], s3); } { const f32x4 l = *(const LAS f32x4*)(Lc + 904); s0 = fmaf(x20, l[0], s0); s1 = fmaf(x21, l[1], s1); s2 = fmaf(x22, l[2], s2); s3 = fmaf(x23, l[3], s3); } { const f32x4 l = *(const LAS f32x4*)(Lc + 908); s0 = fmaf(x24, l[0], s0); s1 = fmaf(x25, l[1], s1); s2 = fmaf(x26, l[2], s2); s3 = fmaf(x27, l[3], s3); } { const f32x4 l = *(const LAS f32x4*)(Lc + 912); s0 = fmaf(x28, l[0], s0); s1 = fmaf(x29, l[1], s1); s2 = fmaf(x30, l[2], s2); s3 = fmaf(x31, l[3], s3); } { const f32x4 l = *(const LAS f32x4*)(Lc + 916); s0 = fmaf(x32, l[0], s0); s1 = fmaf(x33, l[1], s1); s2 = fmaf(x34, l[2], s2); s3 = fmaf(x35, l[3], s3); } { const f32x4 l = *(const LAS f32x4*)(Lc + 920); s0 = fmaf(x36, l[0], s0); s1 = fmaf(x37, l[1], s1); s2 = fmaf(x38, l[2], s2); s3 = fmaf(x39, l[3], s3); } { const f32x4 l = *(const LAS f32x4*)(Lc + 924); s0 = fmaf(x40, l[0], s0); s1 = fmaf(x41, l[1], s1); s2 = fmaf(x42, l[2], s2); s3 = fmaf(x43, l[3], s3); } { const f32x4 l = *(const LAS f32x4*)(Lc + 928); s0 = fmaf(x44, l[0], s0); s1 = fmaf(x45, l[1], s1); s2 = fmaf(x46, l[2], s2); s3 = fmaf(x47, l[3], s3); } { const f32x4 l = *(const LAS f32x4*)(Lc + 932); s0 = fmaf(x48, l[0], s0); s1 = fmaf(x49, l[1], s1); s2 = fmaf(x50, l[2], s2); s3 = fmaf(x51, l[3], s3); } { const f32x4 l = *(const LAS f32x4*)(Lc + 936); s0 = fmaf(x52, l[0], s0); s1 = fmaf(x53, l[1], s1); s2 = fmaf(x54, l[2], s2); s3 = fmaf(x55, l[3], s3); } { const f32x4 l = *(const LAS f32x4*)(Lc + 940); s0 = fmaf(x56, l[0], s0); s1 = fmaf(x57, l[1], s1); s2 = fmaf(x58, l[2], s2); s3 = fmaf(x59, l[3], s3); } { const f32x4 l = *(const LAS f32x4*)(Lc + 944); s0 = fmaf(x60, l[0], s0); s1 = fmaf(x61, l[1], s1); s2 = fmaf(x62, l[2], s2); s3 = fmaf(x63, l[3], s3); } x13 = (lane == 13) ? 1.0f : -((s0 + s1) + (s2 + s3)); asm volatile("" : "+v"(x13) : : "memory"); }
    { float s0 = 0.f, s1 = 0.f, s2 = 0.f, s3 = 0.f; { const f32x4 l = *(const LAS f32x4*)(Lc + 828); s1 = fmaf(x13, l[1], s1); s2 = fmaf(x14, l[2], s2); s3 = fmaf(x15, l[3], s3); } { const f32x4 l = *(const LAS f32x4*)(Lc + 832); s0 = fmaf(x16, l[0], s0); s1 = fmaf(x17, l[1], s1); s2 = fmaf(x18, l[2], s2); s3 = fmaf(x19, l[3], s3); } { const f32x4 l = *(const LAS f32x4*)(Lc + 836); s0 = fmaf(x20, l[0], s0); s1 = fmaf(x21, l[1], s1); s2 = fmaf(x22, l[2], s2); s3 = fmaf(x23, l[3], s3); } { const f32x4 l = *(const LAS f32x4*)(Lc + 840); s0 = fmaf(x24, l[0], s0); s1 = fmaf(x25, l[1], s1); s2 = fmaf(x26, l[2], s2); s3 = fmaf(x27, l[3], s3); } { const f32x4 l = *(const LAS f32x4*)(Lc + 844); s0 = fmaf(x28, l[0], s0); s1 = fmaf(x29, l[1], s1); s2 = fmaf(x30, l[2], s2); s3 = fmaf(x31, l[3], s3); } { const f32x4 l = *(const LAS f32x4*)(Lc + 848); s0 = fmaf(x32, l[0], s0); s1 = fmaf(x33, l[1], s1); s2 = fmaf(x34, l[2], s2); s3 = fmaf(x35, l[3], s3); } { const f32x4 l = *(const LAS f32x4*)(Lc + 852); s0 = fmaf(x36, l[0], s0); s1 = fmaf(x37, l[1], s1); s2 = fmaf(x38, l[2], s2); s3 = fmaf(x39, l[3], s3); } { const f32x4 l = *(const LAS f32x4*)(Lc + 856); s0 = fmaf(x40, l[0], s0); s1 = fmaf(x41, l[1], s1); s2 = fmaf(x42, l[2], s2); s3 = fmaf(x43, l[3], s3); } { const f32x4 l = *(const LAS f32x4*)(Lc + 860); s0 = fmaf(x44, l[0], s0); s1 = fmaf(x45, l[1], s1); s2 = fmaf(x46, l[2], s2); s3 = fmaf(x47, l[3], s3); } { const f32x4 l = *(const LAS f32x4*)(Lc + 864); s0 = fmaf(x48, l[0], s0); s1 = fmaf(x49, l[1], s1); s2 = fmaf(x50, l[2], s2); s3 = fmaf(x51, l[3], s3); } { const f32x4 l = *(const LAS f32x4*)(Lc + 868); s0 = fmaf(x52, l[0], s0); s1 = fmaf(x53, l[1], s1); s2 = fmaf(x54, l[2], s2); s3 = fmaf(x55, l[3], s3); } { const f32x4 l = *(const LAS f32x4*)(Lc + 872); s0 = fmaf(x56, l[0], s0); s1 = fmaf(x57, l[1], s1); s2 = fmaf(x58, l[2], s2); s3 = fmaf(x59, l[3], s3); } { const f32x4 l = *(const LAS f32x4*)(Lc + 876); s0 = fmaf(x60, l[0], s0); s1 = fmaf(x61, l[1], s1); s2 = fmaf(x62, l[2], s2); s3 = fmaf(x63, l[3], s3); } x12 = (lane == 12) ? 1.0f : -((s0 + s1) + (s2 + s3)); asm volatile("" : "+v"(x12) : : "memory"); }
    { float s0 = 0.f, s1 = 0.f, s2 = 0.f, s3 = 0.f; { const f32x4 l = *(const LAS f32x4*)(Lc + 760); s0 = fmaf(x12, l[0], s0); s1 = fmaf(x13, l[1], s1); s2 = fmaf(x14, l[2], s2); s3 = fmaf(x15, l[3], s3); } { const f32x4 l = *(const LAS f32x4*)(Lc + 764); s0 = fmaf(x16, l[0], s0); s1 = fmaf(x17, l[1], s1); s2 = fmaf(x18, l[2], s2); s3 = fmaf(x19, l[3], s3); } { const f32x4 l = *(const LAS f32x4*)(Lc + 768); s0 = fmaf(x20, l[0], s0); s1 = fmaf(x21, l[1], s1); s2 = fmaf(x22, l[2], s2); s3 = fmaf(x23, l[3], s3); } { const f32x4 l = *(const LAS f32x4*)(Lc + 772); s0 = fmaf(x24, l[0], s0); s1 = fmaf(x25, l[1], s1); s2 = fmaf(x26, l[2], s2); s3 = fmaf(x27, l[3], s3); } { const f32x4 l = *(const LAS f32x4*)(Lc + 776); s0 = fmaf(x28, l[0], s0); s1 = fmaf(x29, l[1], s1); s2 = fmaf(x30, l[2], s2); s3 = fmaf(x31, l[3], s3); } { const f32x4 l = *(const LAS f32x4*)(Lc + 780); s0 = fmaf(x32, l[0], s0); s1 = fmaf(x33, l[1], s1); s2 = fmaf(x34, l[2], s2); s3 = fmaf(x35, l[3], s3); } { const f32x4 l = *(const LAS f32x4*)(Lc + 784); s0 = fmaf(x36, l[0], s0); s1 = fmaf(x37, l[1], s1); s2 = fmaf(x38, l[2], s2); s3 = fmaf(x39, l[3], s3); } { const f32x4 l = *(const LAS f32x4*)(Lc + 788); s0 = fmaf(x40, l[0], s0); s1 = fmaf(x41, l[1], s1); s2 = fmaf(x42, l[2], s2); s3 = fmaf(x43, l[3], s3); } { const f32x4 l = *(const LAS f32x4*)(Lc + 792); s0 = fmaf(x44, l[0], s0); s1 = fmaf(x45, l[1], s1); s2 = fmaf(x46, l[2], s2); s3 = fmaf(x47, l[3], s3); } { const f32x4 l = *(const LAS f32x4*)(Lc + 796); s0 = fmaf(x48, l[0], s0); s1 = fmaf(x49, l[1], s1); s2 = fmaf(x50, l[2], s2); s3 = fmaf(x51, l[3], s3); } { const f32x4 l = *(const LAS f32x4*)(Lc + 800); s0 = fmaf(x52, l[0], s0); s1 = fmaf(x53, l[1], s1); s2 = fmaf(x54, l[2], s2); s3 = fmaf(x55, l[3], s3); } { const f32x4 l = *(const LAS f32x4*)(Lc + 804); s0 = fmaf(x56, l[0], s0); s1 = fmaf(x57, l[1], s1); s2 = fmaf(x58, l[2], s2); s3 = fmaf(x59, l[3], s3); } { const f32x4 l = *(const LAS f32x4*)(Lc + 808); s0 = fmaf(x60, l[0], s0); s1 = fmaf(x61, l[1], s1); s2 = fmaf(x62, l[2], s2); s3 = fmaf(x63, l[3], s3); } x11 = (lane == 11) ? 1.0f : -((s0 + s1) + (s2 + s3)); asm volatile("" : "+v"(x11) : : "memory"); }
    { float s0 = 0.f, s1 = 0.f, s2 = 0.f, s3 = 0.f; { const f32x4 l = *(const LAS f32x4*)(Lc + 688); s3 = fmaf(x11, l[3], s3); } { const f32x4 l = *(const LAS f32x4*)(Lc + 692); s0 = fmaf(x12, l[0], s0); s1 = fmaf(x13, l[1], s1); s2 = fmaf(x14, l[2], s2); s3 = fmaf(x15, l[3], s3); } { const f32x4 l = *(const LAS f32x4*)(Lc + 696); s0 = fmaf(x16, l[0], s0); s1 = fmaf(x17, l[1], s1); s2 = fmaf(x18, l[2], s2); s3 = fmaf(x19, l[3], s3); } { const f32x4 l = *(const LAS f32x4*)(Lc + 700); s0 = fmaf(x20, l[0], s0); s1 = fmaf(x21, l[1], s1); s2 = fmaf(x22, l[2], s2); s3 = fmaf(x23, l[3], s3); } { const f32x4 l = *(const LAS f32x4*)(Lc + 704); s0 = fmaf(x24, l[0], s0); s1 = fmaf(x25, l[1], s1); s2 = fmaf(x26, l[2], s2); s3 = fmaf(x27, l[3], s3); } { const f32x4 l = *(const LAS f32x4*)(Lc + 708); s0 = fmaf(x28, l[0], s0); s1 = fmaf(x29, l[1], s1); s2 = fmaf(x30, l[2], s2); s3 = fmaf(x31, l[3], s3); } { const f32x4 l = *(const LAS f32x4*)(Lc + 712); s0 = fmaf(x32, l[0], s0); s1 = fmaf(x33, l[1], s1); s2 = fmaf(x34, l[2], s2); s3 = fmaf(x35, l[3], s3); } { const f32x4 l = *(const LAS f32x4*)(Lc + 716); s0 = fmaf(x36, l[0], s0); s1 = fmaf(x37, l[1], s1); s2 = fmaf(x38, l[2], s2); s3 = fmaf(x39, l[3], s3); } { const f32x4 l = *(const LAS f32x4*)(Lc + 720); s0 = fmaf(x40, l[0], s0); s1 = fmaf(x41, l[1], s1); s2 = fmaf(x42, l[2], s2); s3 = fmaf(x43, l[3], s3); } { const f32x4 l = *(const LAS f32x4*)(Lc + 724); s0 = fmaf(x44, l[0], s0); s1 = fmaf(x45, l[1], s1); s2 = fmaf(x46, l[2], s2); s3 = fmaf(x47, l[3], s3); } { const f32x4 l = *(const LAS f32x4*)(Lc + 728); s0 = fmaf(x48, l[0], s0); s1 = fmaf(x49, l[1], s1); s2 = fmaf(x50, l[2], s2); s3 = fmaf(x51, l[3], s3); } { const f32x4 l = *(const LAS f32x4*)(Lc + 732); s0 = fmaf(x52, l[0], s0); s1 = fmaf(x53, l[1], s1); s2 = fmaf(x54, l[2], s2); s3 = fmaf(x55, l[3], s3); } { const f32x4 l = *(const LAS f32x4*)(Lc + 736); s0 = fmaf(x56, l[0], s0); s1 = fmaf(x57, l[1], s1); s2 = fmaf(x58, l[2], s2); s3 = fmaf(x59, l[3], s3); } { const f32x4 l = *(const LAS f32x4*)(Lc + 740); s0 = fmaf(x60, l[0], s0); s1 = fmaf(x61, l[1], s1); s2 = fmaf(x62, l[2], s2); s3 = fmaf(x63, l[3], s3); } x10 = (lane == 10) ? 1.0f : -((s0 + s1) + (s2 + s3)); asm volatile("" : "+v"(x10) : : "memory"); }
    { float s0 = 0.f, s1 = 0.f, s2 = 0.f, s3 = 0.f; { const f32x4 l = *(const LAS f32x4*)(Lc + 620); s2 = fmaf(x10, l[2], s2); s3 = fmaf(x11, l[3], s3); } { const f32x4 l = *(const LAS f32x4*)(Lc + 624); s0 = fmaf(x12, l[0], s0); s1 = fmaf(x13, l[1], s1); s2 = fmaf(x14, l[2], s2); s3 = fmaf(x15, l[3], s3); } { const f32x4 l = *(const LAS f32x4*)(Lc + 628); s0 = fmaf(x16, l[0], s0); s1 = fmaf(x17, l[1], s1); s2 = fmaf(x18, l[2], s2); s3 = fmaf(x19, l[3], s3); } { const f32x4 l = *(const LAS f32x4*)(Lc + 632); s0 = fmaf(x20, l[0], s0); s1 = fmaf(x21, l[1], s1); s2 = fmaf(x22, l[2], s2); s3 = fmaf(x23, l[3], s3); } { const f32x4 l = *(const LAS f32x4*)(Lc + 636); s0 = fmaf(x24, l[0], s0); s1 = fmaf(x25, l[1], s1); s2 = fmaf(x26, l[2], s2); s3 = fmaf(x27, l[3], s3); } { const f32x4 l = *(const LAS f32x4*)(Lc + 640); s0 = fmaf(x28, l[0], s0); s1 = fmaf(x29, l[1], s1); s2 = fmaf(x30, l[2], s2); s3 = fmaf(x31, l[3], s3); } { const f32x4 l = *(const LAS f32x4*)(Lc + 644); s0 = fmaf(x32, l[0], s0); s1 = fmaf(x33, l[1], s1); s2 = fmaf(x34, l[2], s2); s3 = fmaf(x35, l[3], s3); } { const f32x4 l = *(const LAS f32x4*)(Lc + 648); s0 = fmaf(x36, l[0], s0); s1 = fmaf(x37, l[1], s1); s2 = fmaf(x38, l[2], s2); s3 = fmaf(x39, l[3], s3); } { const f32x4 l = *(const LAS f32x4*)(Lc + 652); s0 = fmaf(x40, l[0], s0); s1 = fmaf(x41, l[1], s1); s2 = fmaf(x42, l[2], s2); s3 = fmaf(x43, l[3], s3); } { const f32x4 l = *(const LAS f32x4*)(Lc + 656); s0 = fmaf(x44, l[0], s0); s1 = fmaf(x45, l[1], s1); s2 = fmaf(x46, l[2], s2); s3 = fmaf(x47, l[3], s3); } { const f32x4 l = *(const LAS f32x4*)(Lc + 660); s0 = fmaf(x48, l[0], s0); s1 = fmaf(x49, l[1], s1); s2 = fmaf(x50, l[2], s2); s3 = fmaf(x51, l[3], s3); } { const f32x4 l = *(const LAS f32x4*)(Lc + 664); s0 = fmaf(x52, l[0], s0); s1 = fmaf(x53, l[1], s1); s2 = fmaf(x54, l[2], s2); s3 = fmaf(x55, l[3], s3); } { const f32x4 l = *(const LAS f32x4*)(Lc + 668); s0 = fmaf(x56, l[0], s0); s1 = fmaf(x57, l[1], s1); s2 = fmaf(x58, l[2], s2); s3 = fmaf(x59, l[3], s3); } { const f32x4 l = *(const LAS f32x4*)(Lc + 672); s0 = fmaf(x60, l[0], s0); s1 = fmaf(x61, l[1], s1); s2 = fmaf(x62, l[2], s2); s3 = fmaf(x63, l[3], s3); } x9 = (lane == 9) ? 1.0f : -((s0 + s1) + (s2 + s3)); asm volatile("" : "+v"(x9) : : "memory"); }
    { float s0 = 0.f, s1 = 0.f, s2 = 0.f, s3 = 0.f; { const f32x4 l = *(const LAS f32x4*)(Lc + 552); s1 = fmaf(x9, l[1], s1); s2 = fmaf(x10, l[2], s2); s3 = fmaf(x11, l[3], s3); } { const f32x4 l = *(const LAS f32x4*)(Lc + 556); s0 = fmaf(x12, l[0], s0); s1 = fmaf(x13, l[1], s1); s2 = fmaf(x14, l[2], s2); s3 = fmaf(x15, l[3], s3); } { const f32x4 l = *(const LAS f32x4*)(Lc + 560); s0 = fmaf(x16, l[0], s0); s1 = fmaf(x17, l[1], s1); s2 = fmaf(x18, l[2], s2); s3 = fmaf(x19, l[3], s3); } { const f32x4 l = *(const LAS f32x4*)(Lc + 564); s0 = fmaf(x20, l[0], s0); s1 = fmaf(x21, l[1], s1); s2 = fmaf(x22, l[2], s2); s3 = fmaf(x23, l[3], s3); } { const f32x4 l = *(const LAS f32x4*)(Lc + 568); s0 = fmaf(x24, l[0], s0); s1 = fmaf(x25, l[1], s1); s2 = fmaf(x26, l[2], s2); s3 = fmaf(x27, l[3], s3); } { const f32x4 l = *(const LAS f32x4*)(Lc + 572); s0 = fmaf(x28, l[0], s0); s1 = fmaf(x29, l[1], s1); s2 = fmaf(x30, l[2], s2); s3 = fmaf(x31, l[3], s3); } { const f32x4 l = *(const LAS f32x4*)(Lc + 576); s0 = fmaf(x32, l[0], s0); s1 = fmaf(x33, l[1], s1); s2 = fmaf(x34, l[2], s2); s3 = fmaf(x35, l[3], s3); } { const f32x4 l = *(const LAS f32x4*)(Lc + 580); s0 = fmaf(x36, l[0], s0); s1 = fmaf(x37, l[1], s1); s2 = fmaf(x38, l[2], s2); s3 = fmaf(x39, l[3], s3); } { const f32x4 l = *(const LAS f32x4*)(Lc + 584); s0 = fmaf(x40, l[0], s0); s1 = fmaf(x41, l[1], s1); s2 = fmaf(x42, l[2], s2); s3 = fmaf(x43, l[3], s3); } { const f32x4 l = *(const LAS f32x4*)(Lc + 588); s0 = fmaf(x44, l[0], s0); s1 = fmaf(x45, l[1], s1); s2 = fmaf(x46, l[2], s2); s3 = fmaf(x47, l[3], s3); } { const f32x4 l = *(const LAS f32x4*)(Lc + 592); s0 = fmaf(x48, l[0], s0); s1 = fmaf(x49, l[1], s1); s2 = fmaf(x50, l[2], s2); s3 = fmaf(x51, l[3], s3); } { const f32x4 l = *(const LAS f32x4*)(Lc + 596); s0 = fmaf(x52, l[0], s0); s1 = fmaf(x53, l[1], s1); s2 = fmaf(x54, l[2], s2); s3 = fmaf(x55, l[3], s3); } { const f32x4 l = *(const LAS f32x4*)(Lc + 600); s0 = fmaf(x56, l[0], s0); s1 = fmaf(x57, l[1], s1); s2 = fmaf(x58, l[2], s2); s3 = fmaf(x59, l[3], s3); } { const f32x4 l = *(const LAS f32x4*)(Lc + 604); s0 = fmaf(x60, l[0], s0); s1 = fmaf(x61, l[1], s1); s2 = fmaf(x62, l[2], s2); s3 = fmaf(x63, l[3], s3); } x8 = (lane == 8) ? 1.0f : -((s0 + s1) + (s2 + s3)); asm volatile("" : "+v"(x8) : : "memory"); }
    { float s0 = 0.f, s1 = 0.f, s2 = 0.f, s3 = 0.f; { const f32x4 l = *(const LAS f32x4*)(Lc + 484); s0 = fmaf(x8, l[0], s0); s1 = fmaf(x9, l[1], s1); s2 = fmaf(x10, l[2], s2); s3 = fmaf(x11, l[3], s3); } { const f32x4 l = *(const LAS f32x4*)(Lc + 488); s0 = fmaf(x12, l[0], s0); s1 = fmaf(x13, l[1], s1); s2 = fmaf(x14, l[2], s2); s3 = fmaf(x15, l[3], s3); } { const f32x4 l = *(const LAS f32x4*)(Lc + 492); s0 = fmaf(x16, l[0], s0); s1 = fmaf(x17, l[1], s1); s2 = fmaf(x18, l[2], s2); s3 = fmaf(x19, l[3], s3); } { const f32x4 l = *(const LAS f32x4*)(Lc + 496); s0 = fmaf(x20, l[0], s0); s1 = fmaf(x21, l[1], s1); s2 = fmaf(x22, l[2], s2); s3 = fmaf(x23, l[3], s3); } { const f32x4 l = *(const LAS f32x4*)(Lc + 500); s0 = fmaf(x24, l[0], s0); s1 = fmaf(x25, l[1], s1); s2 = fmaf(x26, l[2], s2); s3 = fmaf(x27, l[3], s3); } { const f32x4 l = *(const LAS f32x4*)(Lc + 504); s0 = fmaf(x28, l[0], s0); s1 = fmaf(x29, l[1], s1); s2 = fmaf(x30, l[2], s2); s3 = fmaf(x31, l[3], s3); } { const f32x4 l = *(const LAS f32x4*)(Lc + 508); s0 = fmaf(x32, l[0], s0); s1 = fmaf(x33, l[1], s1); s2 = fmaf(x34, l[2], s2); s3 = fmaf(x35, l[3], s3); } { const f32x4 l = *(const LAS f32x4*)(Lc + 512); s0 = fmaf(x36, l[0], s0); s1 = fmaf(x37, l[1], s1); s2 = fmaf(x38, l[2], s2); s3 = fmaf(x39, l[3], s3); } { const f32x4 l = *(const LAS f32x4*)(Lc + 516); s0 = fmaf(x40, l[0], s0); s1 = fmaf(x41, l[1], s1); s2 = fmaf(x42, l[2], s2); s3 = fmaf(x43, l[3], s3); } { const f32x4 l = *(const LAS f32x4*)(Lc + 520); s0 = fmaf(x44, l[0], s0); s1 = fmaf(x45, l[1], s1); s2 = fmaf(x46, l[2], s2); s3 = fmaf(x47, l[3], s3); } { const f32x4 l = *(const LAS f32x4*)(Lc + 524); s0 = fmaf(x48, l[0], s0); s1 = fmaf(x49, l[1], s1); s2 = fmaf(x50, l[2], s2); s3 = fmaf(x51, l[3], s3); } { const f32x4 l = *(const LAS f32x4*)(Lc + 528); s0 = fmaf(x52, l[0], s0); s1 = fmaf(x53, l[1], s1); s2 = fmaf(x54, l[2], s2); s3 = fmaf(x55, l[3], s3); } { const f32x4 l = *(const LAS f32x4*)(Lc + 532); s0 = fmaf(x56, l[0], s0); s1 = fmaf(x57, l[1], s1); s2 = fmaf(x58, l[2], s2); s3 = fmaf(x59, l[3], s3); } { const f32x4 l = *(const LAS f32x4*)(Lc + 536); s0 = fmaf(x60, l[0], s0); s1 = fmaf(x61, l[1], s1); s2 = fmaf(x62, l[2], s2); s3 = fmaf(x63, l[3], s3); } x7 = (lane == 7) ? 1.0f : -((s0 + s1) + (s2 + s3)); asm volatile("" : "+v"(x7) : : "memory"); }
    { float s0 = 0.f, s1 = 0.f, s2 = 0.f, s3 = 0.f; { const f32x4 l = *(const LAS f32x4*)(Lc + 412); s3 = fmaf(x7, l[3], s3); } { const f32x4 l = *(const LAS f32x4*)(Lc + 416); s0 = fmaf(x8, l[0], s0); s1 = fmaf(x9, l[1], s1); s2 = fmaf(x10, l[2], s2); s3 = fmaf(x11, l[3], s3); } { const f32x4 l = *(const LAS f32x4*)(Lc + 420); s0 = fmaf(x12, l[0], s0); s1 = fmaf(x13, l[1], s1); s2 = fmaf(x14, l[2], s2); s3 = fmaf(x15, l[3], s3); } { const f32x4 l = *(const LAS f32x4*)(Lc + 424); s0 = fmaf(x16, l[0], s0); s1 = fmaf(x17, l[1], s1); s2 = fmaf(x18, l[2], s2); s3 = fmaf(x19, l[3], s3); } { const f32x4 l = *(const LAS f32x4*)(Lc + 428); s0 = fmaf(x20, l[0], s0); s1 = fmaf(x21, l[1], s1); s2 = fmaf(x22, l[2], s2); s3 = fmaf(x23, l[3], s3); } { const f32x4 l = *(const LAS f32x4*)(Lc + 432); s0 = fmaf(x24, l[0], s0); s1 = fmaf(x25, l[1], s1); s2 = fmaf(x26, l[2], s2); s3 = fmaf(x27, l[3], s3); } { const f32x4 l = *(const LAS f32x4*)(Lc + 436); s0 = fmaf(x28, l[0], s0); s1 = fmaf(x29, l[1], s1); s2 = fmaf(x30, l[2], s2); s3 = fmaf(x31, l[3], s3); } { const f32x4 l = *(const LAS f32x4*)(Lc + 440); s0 = fmaf(x32, l[0], s0); s1 = fmaf(x33, l[1], s1); s2 = fmaf(x34, l[2], s2); s3 = fmaf(x35, l[3], s3); } { const f32x4 l = *(const LAS f32x4*)(Lc + 444); s0 = fmaf(x36, l[0], s0); s1 = fmaf(x37, l[1], s1); s2 = fmaf(x38, l[2], s2); s3 = fmaf(x39, l[3], s3); } { const f32x4 l = *(const LAS f32x4*)(Lc + 448); s0 = fmaf(x40, l[0], s0); s1 = fmaf(x41, l[1], s1); s2 = fmaf(x42, l[2], s2); s3 = fmaf(x43, l[3], s3); } { const f32x4 l = *(const LAS f32x4*)(Lc + 452); s0 = fmaf(x44, l[0], s0); s1 = fmaf(x45, l[1], s1); s2 = fmaf(x46, l[2], s2); s3 = fmaf(x47, l[3], s3); } { const f32x4 l = *(const LAS f32x4*)(Lc + 456); s0 = fmaf(x48, l[0], s0); s1 = fmaf(x49, l[1], s1); s2 = fmaf(x50, l[2], s2); s3 = fmaf(x51, l[3], s3); } { const f32x4 l = *(const LAS f32x4*)(Lc + 460); s0 = fmaf(x52, l[0], s0); s1 = fmaf(x53, l[1], s1); s2 = fmaf(x54, l[2], s2); s3 = fmaf(x55, l[3], s3); } { const f32x4 l = *(const LAS f32x4*)(Lc + 464); s0 = fmaf(x56, l[0], s0); s1 = fmaf(x57, l[1], s1); s2 = fmaf(x58, l[2], s2); s3 = fmaf(x59, l[3], s3); } { const f32x4 l = *(const LAS f32x4*)(Lc + 468); s0 = fmaf(x60, l[0], s0); s1 = fmaf(x61, l[1], s1); s2 = fmaf(x62, l[2], s2); s3 = fmaf(x63, l[3], s3); } x6 = (lane == 6) ? 1.0f : -((s0 + s1) + (s2 + s3)); asm volatile("" : "+v"(x6) : : "memory"); }
    { float s0 = 0.f, s1 = 0.f, s2 = 0.f, s3 = 0.f; { const f32x4 l = *(const LAS f32x4*)(Lc + 344); s2 = fmaf(x6, l[2], s2); s3 = fmaf(x7, l[3], s3); } { const f32x4 l = *(const LAS f32x4*)(Lc + 348); s0 = fmaf(x8, l[0], s0); s1 = fmaf(x9, l[1], s1); s2 = fmaf(x10, l[2], s2); s3 = fmaf(x11, l[3], s3); } { const f32x4 l = *(const LAS f32x4*)(Lc + 352); s0 = fmaf(x12, l[0], s0); s1 = fmaf(x13, l[1], s1); s2 = fmaf(x14, l[2], s2); s3 = fmaf(x15, l[3], s3); } { const f32x4 l = *(const LAS f32x4*)(Lc + 356); s0 = fmaf(x16, l[0], s0); s1 = fmaf(x17, l[1], s1); s2 = fmaf(x18, l[2], s2); s3 = fmaf(x19, l[3], s3); } { const f32x4 l = *(const LAS f32x4*)(Lc + 360); s0 = fmaf(x20, l[0], s0); s1 = fmaf(x21, l[1], s1); s2 = fmaf(x22, l[2], s2); s3 = fmaf(x23, l[3], s3); } { const f32x4 l = *(const LAS f32x4*)(Lc + 364); s0 = fmaf(x24, l[0], s0); s1 = fmaf(x25, l[1], s1); s2 = fmaf(x26, l[2], s2); s3 = fmaf(x27, l[3], s3); } { const f32x4 l = *(const LAS f32x4*)(Lc + 368); s0 = fmaf(x28, l[0], s0); s1 = fmaf(x29, l[1], s1); s2 = fmaf(x30, l[2], s2); s3 = fmaf(x31, l[3], s3); } { const f32x4 l = *(const LAS f32x4*)(Lc + 372); s0 = fmaf(x32, l[0], s0); s1 = fmaf(x33, l[1], s1); s2 = fmaf(x34, l[2], s2); s3 = fmaf(x35, l[3], s3); } { const f32x4 l = *(const LAS f32x4*)(Lc + 376); s0 = fmaf(x36, l[0], s0); s1 = fmaf(x37, l[1], s1); s2 = fmaf(x38, l[2], s2); s3 = fmaf(x39, l[3], s3); } { const f32x4 l = *(const LAS f32x4*)(Lc + 380); s0 = fmaf(x40, l[0], s0); s1 = fmaf(x41, l[1], s1); s2 = fmaf(x42, l[2], s2); s3 = fmaf(x43, l[3], s3); } { const f32x4 l = *(const LAS f32x4*)(Lc + 384); s0 = fmaf(x44, l[0], s0); s1 = fmaf(x45, l[1], s1); s2 = fmaf(x46, l[2], s2); s3 = fmaf(x47, l[3], s3); } { const f32x4 l = *(const LAS f32x4*)(Lc + 388); s0 = fmaf(x48, l[0], s0); s1 = fmaf(x49, l[1], s1); s2 = fmaf(x50, l[2], s2); s3 = fmaf(x51, l[3], s3); } { const f32x4 l = *(const LAS f32x4*)(Lc + 392); s0 = fmaf(x52, l[0], s0); s1 = fmaf(x53, l[1], s1); s2 = fmaf(x54, l[2], s2); s3 = fmaf(x55, l[3], s3); } { const f32x4 l = *(const LAS f32x4*)(Lc + 396); s0 = fmaf(x56, l[0], s0); s1 = fmaf(x57, l[1], s1); s2 = fmaf(x58, l[2], s2); s3 = fmaf(x59, l[3], s3); } { const f32x4 l = *(const LAS f32x4*)(Lc + 400); s0 = fmaf(x60, l[0], s0); s1 = fmaf(x61, l[1], s1); s2 = fmaf(x62, l[2], s2); s3 = fmaf(x63, l[3], s3); } x5 = (lane == 5) ? 1.0f : -((s0 + s1) + (s2 + s3)); asm volatile("" : "+v"(x5) : : "memory"); }
    { float s0 = 0.f, s1 = 0.f, s2 = 0.f, s3 = 0.f; { const f32x4 l = *(const LAS f32x4*)(Lc + 276); s1 = fmaf(x5, l[1], s1); s2 = fmaf(x6, l[2], s2); s3 = fmaf(x7, l[3], s3); } { const f32x4 l = *(const LAS f32x4*)(Lc + 280); s0 = fmaf(x8, l[0], s0); s1 = fmaf(x9, l[1], s1); s2 = fmaf(x10, l[2], s2); s3 = fmaf(x11, l[3], s3); } { const f32x4 l = *(const LAS f32x4*)(Lc + 284); s0 = fmaf(x12, l[0], s0); s1 = fmaf(x13, l[1], s1); s2 = fmaf(x14, l[2], s2); s3 = fmaf(x15, l[3], s3); } { const f32x4 l = *(const LAS f32x4*)(Lc + 288); s0 = fmaf(x16, l[0], s0); s1 = fmaf(x17, l[1], s1); s2 = fmaf(x18, l[2], s2); s3 = fmaf(x19, l[3], s3); } { const f32x4 l = *(const LAS f32x4*)(Lc + 292); s0 = fmaf(x20, l[0], s0); s1 = fmaf(x21, l[1], s1); s2 = fmaf(x22, l[2], s2); s3 = fmaf(x23, l[3], s3); } { const f32x4 l = *(const LAS f32x4*)(Lc + 296); s0 = fmaf(x24, l[0], s0); s1 = fmaf(x25, l[1], s1); s2 = fmaf(x26, l[2], s2); s3 = fmaf(x27, l[3], s3); } { const f32x4 l = *(const LAS f32x4*)(Lc + 300); s0 = fmaf(x28, l[0], s0); s1 = fmaf(x29, l[1], s1); s2 = fmaf(x30, l[2], s2); s3 = fmaf(x31, l[3], s3); } { const f32x4 l = *(const LAS f32x4*)(Lc + 304); s0 = fmaf(x32, l[0], s0); s1 = fmaf(x33, l[1], s1); s2 = fmaf(x34, l[2], s2); s3 = fmaf(x35, l[3], s3); } { const f32x4 l = *(const LAS f32x4*)(Lc + 308); s0 = fmaf(x36, l[0], s0); s1 = fmaf(x37, l[1], s1); s2 = fmaf(x38, l[2], s2); s3 = fmaf(x39, l[3], s3); } { const f32x4 l = *(const LAS f32x4*)(Lc + 312); s0 = fmaf(x40, l[0], s0); s1 = fmaf(x41, l[1], s1); s2 = fmaf(x42, l[2], s2); s3 = fmaf(x43, l[3], s3); } { const f32x4 l = *(const LAS f32x4*)(Lc + 316); s0 = fmaf(x44, l[0], s0); s1 = fmaf(x45, l[1], s1); s2 = fmaf(x46, l[2], s2); s3 = fmaf(x47, l[3], s3); } { const f32x4 l = *(const LAS f32x4*)(Lc + 320); s0 = fmaf(x48, l[0], s0); s1 = fmaf(x49, l[1], s1); s2 = fmaf(x50, l[2], s2); s3 = fmaf(x51, l[3], s3); } { const f32x4 l = *(const LAS f32x4*)(Lc + 324); s0 = fmaf(x52, l[0], s0); s1 = fmaf(x53, l[1], s1); s2 = fmaf(x54, l[2], s2); s3 = fmaf(x55, l[3], s3); } { const f32x4 l = *(const LAS f32x4*)(Lc + 328); s0 = fmaf(x56, l[0], s0); s1 = fmaf(x57, l[1], s1); s2 = fmaf(x58, l[2], s2); s3 = fmaf(x59, l[3], s3); } { const f32x4 l = *(const LAS f32x4*)(Lc + 332); s0 = fmaf(x60, l[0], s0); s1 = fmaf(x61, l[1], s1); s2 = fmaf(x62, l[2], s2); s3 = fmaf(x63, l[3], s3); } x4 = (lane == 4) ? 1.0f : -((s0 + s1) + (s2 + s3)); asm volatile("" : "+v"(x4) : : "memory"); }
    { float s0 = 0.f, s1 = 0.f, s2 = 0.f, s3 = 0.f; { const f32x4 l = *(const LAS f32x4*)(Lc + 208); s0 = fmaf(x4, l[0], s0); s1 = fmaf(x5, l[1], s1); s2 = fmaf(x6, l[2], s2); s3 = fmaf(x7, l[3], s3); } { const f32x4 l = *(const LAS f32x4*)(Lc + 212); s0 = fmaf(x8, l[0], s0); s1 = fmaf(x9, l[1], s1); s2 = fmaf(x10, l[2], s2); s3 = fmaf(x11, l[3], s3); } { const f32x4 l = *(const LAS f32x4*)(Lc + 216); s0 = fmaf(x12, l[0], s0); s1 = fmaf(x13, l[1], s1); s2 = fmaf(x14, l[2], s2); s3 = fmaf(x15, l[3], s3); } { const f32x4 l = *(const LAS f32x4*)(Lc + 220); s0 = fmaf(x16, l[0], s0); s1 = fmaf(x17, l[1], s1); s2 = fmaf(x18, l[2], s2); s3 = fmaf(x19, l[3], s3); } { const f32x4 l = *(const LAS f32x4*)(Lc + 224); s0 = fmaf(x20, l[0], s0); s1 = fmaf(x21, l[1], s1); s2 = fmaf(x22, l[2], s2); s3 = fmaf(x23, l[3], s3); } { const f32x4 l = *(const LAS f32x4*)(Lc + 228); s0 = fmaf(x24, l[0], s0); s1 = fmaf(x25, l[1], s1); s2 = fmaf(x26, l[2], s2); s3 = fmaf(x27, l[3], s3); } { const f32x4 l = *(const LAS f32x4*)(Lc + 232); s0 = fmaf(x28, l[0], s0); s1 = fmaf(x29, l[1], s1); s2 = fmaf(x30, l[2], s2); s3 = fmaf(x31, l[3], s3); } { const f32x4 l = *(const LAS f32x4*)(Lc + 236); s0 = fmaf(x32, l[0], s0); s1 = fmaf(x33, l[1], s1); s2 = fmaf(x34, l[2], s2); s3 = fmaf(x35, l[3], s3); } { const f32x4 l = *(const LAS f32x4*)(Lc + 240); s0 = fmaf(x36, l[0], s0); s1 = fmaf(x37, l[1], s1); s2 = fmaf(x38, l[2], s2); s3 = fmaf(x39, l[3], s3); } { const f32x4 l = *(const LAS f32x4*)(Lc + 244); s0 = fmaf(x40, l[0], s0); s1 = fmaf(x41, l[1], s1); s2 = fmaf(x42, l[2], s2); s3 = fmaf(x43, l[3], s3); } { const f32x4 l = *(const LAS f32x4*)(Lc + 248); s0 = fmaf(x44, l[0], s0); s1 = fmaf(x45, l[1], s1); s2 = fmaf(x46, l[2], s2); s3 = fmaf(x47, l[3], s3); } { const f32x4 l = *(const LAS f32x4*)(Lc + 252); s0 = fmaf(x48, l[0], s0); s1 = fmaf(x49, l[1], s1); s2 = fmaf(x50, l[2], s2); s3 = fmaf(x51, l[3], s3); } { const f32x4 l = *(const LAS f32x4*)(Lc + 256); s0 = fmaf(x52, l[0], s0); s1 = fmaf(x53, l[1], s1); s2 = fmaf(x54, l[2], s2); s3 = fmaf(x55, l[3], s3); } { const f32x4 l = *(const LAS f32x4*)(Lc + 260); s0 = fmaf(x56, l[0], s0); s1 = fmaf(x57, l[1], s1); s2 = fmaf(x58, l[2], s2); s3 = fmaf(x59, l[3], s3); } { const f32x4 l = *(const LAS f32x4*)(Lc + 264); s0 = fmaf(x60, l[0], s0); s1 = fmaf(x61, l[1], s1); s2 = fmaf(x62, l[2], s2); s3 = fmaf(x63, l[3], s3); } x3 = (lane == 3) ? 1.0f : -((s0 + s1) + (s2 + s3)); asm volatile("" : "+v"(x3) : : "memory"); }
    { float s0 = 0.f, s1 = 0.f, s2 = 0.f, s3 = 0.f; { const f32x4 l = *(const LAS f32x4*)(Lc + 136); s3 = fmaf(x3, l[3], s3); } { const f32x4 l = *(const LAS f32x4*)(Lc + 140); s0 = fmaf(x4, l[0], s0); s1 = fmaf(x5, l[1], s1); s2 = fmaf(x6, l[2], s2); s3 = fmaf(x7, l[3], s3); } { const f32x4 l = *(const LAS f32x4*)(Lc + 144); s0 = fmaf(x8, l[0], s0); s1 = fmaf(x9, l[1], s1); s2 = fmaf(x10, l[2], s2); s3 = fmaf(x11, l[3], s3); } { const f32x4 l = *(const LAS f32x4*)(Lc + 148); s0 = fmaf(x12, l[0], s0); s1 = fmaf(x13, l[1], s1); s2 = fmaf(x14, l[2], s2); s3 = fmaf(x15, l[3], s3); } { const f32x4 l = *(const LAS f32x4*)(Lc + 152); s0 = fmaf(x16, l[0], s0); s1 = fmaf(x17, l[1], s1); s2 = fmaf(x18, l[2], s2); s3 = fmaf(x19, l[3], s3); } { const f32x4 l = *(const LAS f32x4*)(Lc + 156); s0 = fmaf(x20, l[0], s0); s1 = fmaf(x21, l[1], s1); s2 = fmaf(x22, l[2], s2); s3 = fmaf(x23, l[3], s3); } { const f32x4 l = *(const LAS f32x4*)(Lc + 160); s0 = fmaf(x24, l[0], s0); s1 = fmaf(x25, l[1], s1); s2 = fmaf(x26, l[2], s2); s3 = fmaf(x27, l[3], s3); } { const f32x4 l = *(const LAS f32x4*)(Lc + 164); s0 = fmaf(x28, l[0], s0); s1 = fmaf(x29, l[1], s1); s2 = fmaf(x30, l[2], s2); s3 = fmaf(x31, l[3], s3); } { const f32x4 l = *(const LAS f32x4*)(Lc + 168); s0 = fmaf(x32, l[0], s0); s1 = fmaf(x33, l[1], s1); s2 = fmaf(x34, l[2], s2); s3 = fmaf(x35, l[3], s3); } { const f32x4 l = *(const LAS f32x4*)(Lc + 172); s0 = fmaf(x36, l[0], s0); s1 = fmaf(x37, l[1], s1); s2 = fmaf(x38, l[2], s2); s3 = fmaf(x39, l[3], s3); } { const f32x4 l = *(const LAS f32x4*)(Lc + 176); s0 = fmaf(x40, l[0], s0); s1 = fmaf(x41, l[1], s1); s2 = fmaf(x42, l[2], s2); s3 = fmaf(x43, l[3], s3); } { const f32x4 l = *(const LAS f32x4*)(Lc + 180); s0 = fmaf(x44, l[0], s0); s1 = fmaf(x45, l[1], s1); s2 = fmaf(x46, l[2], s2); s3 = fmaf(x47, l[3], s3); } { const f32x4 l = *(const LAS f32x4*)(Lc + 184); s0 = fmaf(x48, l[0], s0); s1 = fmaf(x49, l[1], s1); s2 = fmaf(x50, l[2], s2); s3 = fmaf(x51, l[3], s3); } { const f32x4 l = *(const LAS f32x4*)(Lc + 188); s0 = fmaf(x52, l[0], s0); s1 = fmaf(x53, l[1], s1); s2 = fmaf(x54, l[2], s2); s3 = fmaf(x55, l[3], s3); } { const f32x4 l = *(const LAS f32x4*)(Lc + 192); s0 = fmaf(x56, l[0], s0); s1 = fmaf(x57, l[1], s1); s2 = fmaf(x58, l[2], s2); s3 = fmaf(x59, l[3], s3); } { const f32x4 l = *(const LAS f32x4*)(Lc + 196); s0 = fmaf(x60, l[0], s0); s1 = fmaf(x61, l[1], s1); s2 = fmaf(x62, l[2], s2); s3 = fmaf(x63, l[3], s3); } x2 = (lane == 2) ? 1.0f : -((s0 + s1) + (s2 + s3)); asm volatile("" : "+v"(x2) : : "memory"); }
    { float s0 = 0.f, s1 = 0.f, s2 = 0.f, s3 = 0.f; { const f32x4 l = *(const LAS f32x4*)(Lc + 68); s2 = fmaf(x2, l[2], s2); s3 = fmaf(x3, l[3], s3); } { const f32x4 l = *(const LAS f32x4*)(Lc + 72); s0 = fmaf(x4, l[0], s0); s1 = fmaf(x5, l[1], s1); s2 = fmaf(x6, l[2], s2); s3 = fmaf(x7, l[3], s3); } { const f32x4 l = *(const LAS f32x4*)(Lc + 76); s0 = fmaf(x8, l[0], s0); s1 = fmaf(x9, l[1], s1); s2 = fmaf(x10, l[2], s2); s3 = fmaf(x11, l[3], s3); } { const f32x4 l = *(const LAS f32x4*)(Lc + 80); s0 = fmaf(x12, l[0], s0); s1 = fmaf(x13, l[1], s1); s2 = fmaf(x14, l[2], s2); s3 = fmaf(x15, l[3], s3); } { const f32x4 l = *(const LAS f32x4*)(Lc + 84); s0 = fmaf(x16, l[0], s0); s1 = fmaf(x17, l[1], s1); s2 = fmaf(x18, l[2], s2); s3 = fmaf(x19, l[3], s3); } { const f32x4 l = *(const LAS f32x4*)(Lc + 88); s0 = fmaf(x20, l[0], s0); s1 = fmaf(x21, l[1], s1); s2 = fmaf(x22, l[2], s2); s3 = fmaf(x23, l[3], s3); } { const f32x4 l = *(const LAS f32x4*)(Lc + 92); s0 = fmaf(x24, l[0], s0); s1 = fmaf(x25, l[1], s1); s2 = fmaf(x26, l[2], s2); s3 = fmaf(x27, l[3], s3); } { const f32x4 l = *(const LAS f32x4*)(Lc + 96); s0 = fmaf(x28, l[0], s0); s1 = fmaf(x29, l[1], s1); s2 = fmaf(x30, l[2], s2); s3 = fmaf(x31, l[3], s3); } { const f32x4 l = *(const LAS f32x4*)(Lc + 100); s0 = fmaf(x32, l[0], s0); s1 = fmaf(x33, l[1], s1); s2 = fmaf(x34, l[2], s2); s3 = fmaf(x35, l[3], s3); } { const f32x4 l = *(const LAS f32x4*)(Lc + 104); s0 = fmaf(x36, l[0], s0); s1 = fmaf(x37, l[1], s1); s2 = fmaf(x38, l[2], s2); s3 = fmaf(x39, l[3], s3); } { const f32x4 l = *(const LAS f32x4*)(Lc + 108); s0 = fmaf(x40, l[0], s0); s1 = fmaf(x41, l[1], s1); s2 = fmaf(x42, l[2], s2); s3 = fmaf(x43, l[3], s3); } { const f32x4 l = *(const LAS f32x4*)(Lc + 112); s0 = fmaf(x44, l[0], s0); s1 = fmaf(x45, l[1], s1); s2 = fmaf(x46, l[2], s2); s3 = fmaf(x47, l[3], s3); } { const f32x4 l = *(const LAS f32x4*)(Lc + 116); s0 = fmaf(x48, l[0], s0); s1 = fmaf(x49, l[1], s1); s2 = fmaf(x50, l[2], s2); s3 = fmaf(x51, l[3], s3); } { const f32x4 l = *(const LAS f32x4*)(Lc + 120); s0 = fmaf(x52, l[0], s0); s1 = fmaf(x53, l[1], s1); s2 = fmaf(x54, l[2], s2); s3 = fmaf(x55, l[3], s3); } { const f32x4 l = *(const LAS f32x4*)(Lc + 124); s0 = fmaf(x56, l[0], s0); s1 = fmaf(x57, l[1], s1); s2 = fmaf(x58, l[2], s2); s3 = fmaf(x59, l[3], s3); } { const f32x4 l = *(const LAS f32x4*)(Lc + 128); s0 = fmaf(x60, l[0], s0); s1 = fmaf(x61, l[1], s1); s2 = fmaf(x62, l[2], s2); s3 = fmaf(x63, l[3], s3); } x1 = (lane == 1) ? 1.0f : -((s0 + s1) + (s2 + s3)); asm volatile("" : "+v"(x1) : : "memory"); }
    { float s0 = 0.f, s1 = 0.f, s2 = 0.f, s3 = 0.f; { const f32x4 l = *(const LAS f32x4*)(Lc + 0); s1 = fmaf(x1, l[1], s1); s2 = fmaf(x2, l[2], s2); s3 = fmaf(x3, l[3], s3); } { const f32x4 l = *(const LAS f32x4*)(Lc + 4); s0 = fmaf(x4, l[0], s0); s1 = fmaf(x5, l[1], s1); s2 = fmaf(x6, l[2], s2); s3 = fmaf(x7, l[3], s3); } { const f32x4 l = *(const LAS f32x4*)(Lc + 8); s0 = fmaf(x8, l[0], s0); s1 = fmaf(x9, l[1], s1); s2 = fmaf(x10, l[2], s2); s3 = fmaf(x11, l[3], s3); } { const f32x4 l = *(const LAS f32x4*)(Lc + 12); s0 = fmaf(x12, l[0], s0); s1 = fmaf(x13, l[1], s1); s2 = fmaf(x14, l[2], s2); s3 = fmaf(x15, l[3], s3); } { const f32x4 l = *(const LAS f32x4*)(Lc + 16); s0 = fmaf(x16, l[0], s0); s1 = fmaf(x17, l[1], s1); s2 = fmaf(x18, l[2], s2); s3 = fmaf(x19, l[3], s3); } { const f32x4 l = *(const LAS f32x4*)(Lc + 20); s0 = fmaf(x20, l[0], s0); s1 = fmaf(x21, l[1], s1); s2 = fmaf(x22, l[2], s2); s3 = fmaf(x23, l[3], s3); } { const f32x4 l = *(const LAS f32x4*)(Lc + 24); s0 = fmaf(x24, l[0], s0); s1 = fmaf(x25, l[1], s1); s2 = fmaf(x26, l[2], s2); s3 = fmaf(x27, l[3], s3); } { const f32x4 l = *(const LAS f32x4*)(Lc + 28); s0 = fmaf(x28, l[0], s0); s1 = fmaf(x29, l[1], s1); s2 = fmaf(x30, l[2], s2); s3 = fmaf(x31, l[3], s3); } { const f32x4 l = *(const LAS f32x4*)(Lc + 32); s0 = fmaf(x32, l[0], s0); s1 = fmaf(x33, l[1], s1); s2 = fmaf(x34, l[2], s2); s3 = fmaf(x35, l[3], s3); } { const f32x4 l = *(const LAS f32x4*)(Lc + 36); s0 = fmaf(x36, l[0], s0); s1 = fmaf(x37, l[1], s1); s2 = fmaf(x38, l[2], s2); s3 = fmaf(x39, l[3], s3); } { const f32x4 l = *(const LAS f32x4*)(Lc + 40); s0 = fmaf(x40, l[0], s0); s1 = fmaf(x41, l[1], s1); s2 = fmaf(x42, l[2], s2); s3 = fmaf(x43, l[3], s3); } { const f32x4 l = *(const LAS f32x4*)(Lc + 44); s0 = fmaf(x44, l[0], s0); s1 = fmaf(x45, l[1], s1); s2 = fmaf(x46, l[2], s2); s3 = fmaf(x47, l[3], s3); } { const f32x4 l = *(const LAS f32x4*)(Lc + 48); s0 = fmaf(x48, l[0], s0); s1 = fmaf(x49, l[1], s1); s2 = fmaf(x50, l[2], s2); s3 = fmaf(x51, l[3], s3); } { const f32x4 l = *(const LAS f32x4*)(Lc + 52); s0 = fmaf(x52, l[0], s0); s1 = fmaf(x53, l[1], s1); s2 = fmaf(x54, l[2], s2); s3 = fmaf(x55, l[3], s3); } { const f32x4 l = *(const LAS f32x4*)(Lc + 56); s0 = fmaf(x56, l[0], s0); s1 = fmaf(x57, l[1], s1); s2 = fmaf(x58, l[2], s2); s3 = fmaf(x59, l[3], s3); } { const f32x4 l = *(const LAS f32x4*)(Lc + 60); s0 = fmaf(x60, l[0], s0); s1 = fmaf(x61, l[1], s1); s2 = fmaf(x62, l[2], s2); s3 = fmaf(x63, l[3], s3); } x0 = (lane == 0) ? 1.0f : -((s0 + s1) + (s2 + s3)); asm volatile("" : "+v"(x0) : : "memory"); }
    { v4u o; o.x = cvtpk(x0, x1); o.y = cvtpk(x2, x3); o.z = cvtpk(x4, x5); o.w = cvtpk(x6, x7); *(LAS v4u*)(Xs + lane * 72 + 0) = o; }
    { v4u o; o.x = cvtpk(x8, x9); o.y = cvtpk(x10, x11); o.z = cvtpk(x12, x13); o.w = cvtpk(x14, x15); *(LAS v4u*)(Xs + lane * 72 + 8) = o; }
    { v4u o; o.x = cvtpk(x16, x17); o.y = cvtpk(x18, x19); o.z = cvtpk(x20, x21); o.w = cvtpk(x22, x23); *(LAS v4u*)(Xs + lane * 72 + 16) = o; }
    { v4u o; o.x = cvtpk(x24, x25); o.y = cvtpk(x26, x27); o.z = cvtpk(x28, x29); o.w = cvtpk(x30, x31); *(LAS v4u*)(Xs + lane * 72 + 24) = o; }
    { v4u o; o.x = cvtpk(x32, x33); o.y = cvtpk(x34, x35); o.z = cvtpk(x36, x37); o.w = cvtpk(x38, x39); *(LAS v4u*)(Xs + lane * 72 + 32) = o; }
    { v4u o; o.x = cvtpk(x40, x41); o.y = cvtpk(x42, x43); o.z = cvtpk(x44, x45); o.w = cvtpk(x46, x47); *(LAS v4u*)(Xs + lane * 72 + 40) = o; }
    { v4u o; o.x = cvtpk(x48, x49); o.y = cvtpk(x50, x51); o.z = cvtpk(x52, x53); o.w = cvtpk(x54, x55); *(LAS v4u*)(Xs + lane * 72 + 48) = o; }
    { v4u o; o.x = cvtpk(x56, x57); o.y = cvtpk(x58, x59); o.z = cvtpk(x60, x61); o.w = cvtpk(x62, x63); *(LAS v4u*)(Xs + lane * 72 + 56) = o; }
}
#ifndef G1P
#define G1P 15
#endif

#define MF16(a, b, c) __builtin_amdgcn_mfma_f32_16x16x32_bf16((a), (b), (c), 0, 0, 0)
__device__ __forceinline__ bf16x8 ld16g(const bf16* p) { return *(const GAS bf16x8*)p; }
__device__ __forceinline__ float ldbf(const bf16* p) { return __uint_as_float(((unsigned)*(const GAS unsigned short*)p) << 16); }
__device__ __forceinline__ void st8(bf16* p, float a, float b, float c, float d) { u32x2v o; o.x = cvtpk(a, b); o.y = cvtpk(c, d); *(GAS u32x2v*)p = o; }

__device__ __forceinline__ void p_ga(const Frame& F, const Args& a, int L) {
    GAS unsigned char* ws = (GAS unsigned char*)a.ws; asm volatile("" : "+s"(ws)); int lane_ = F.lane; asm volatile("" : "+v"(lane_)); const int j = L >> 1, lane = lane_;
    const bf16* PO = (const bf16*)(ws + WS_ARENA + AR_PO);
    bf16 *QN = (bf16*)(ws + WS_ARENA + AR_QN), *KN = (bf16*)(ws + WS_ARENA + AR_KN), *KGT = (bf16*)(ws + WS_ARENA + AR_KGT), *VBT = (bf16*)(ws + WS_ARENA + AR_VBT), *KTT = (bf16*)(ws + WS_ARENA + AR_KTT);
    const float* gg = (const float*)(ws + WS_GB); const float* gbeta = gg + S_ * 8; float* dn = (float*)(ws + WS_TOK + TOK_DN); float* gcs = (float*)(ws + WS_GC);
    const float* cw = (const float*)a.in[16] + (size_t)j * 4 * 3072;
    LAS bf16* tile = (LAS bf16*)(F.lds + F.wave * WAVE_LDS);
    const int dg = lane & 15, ts = lane >> 4, d0 = 8 * dg;
#pragma unroll 1
    for (int tp_ = 2 * F.vcu + (F.wave >> 2); tp_ < 512; tp_ += 2 * F.G) {
        const int u = (4 * (tp_ >> 3) + (F.wave & 3)) * 8 + (tp_ & 7);
        const int n = u >> 3, hh = u & 7, tok0 = 64 * n;
        float sA, sB, sBeta;
        {
            const float gv = *(const GAS float*)(gg + (size_t)(tok0 + lane) * 8 + hh), beta = *(const GAS float*)(gbeta + (size_t)(tok0 + lane) * 8 + hh);
            float gc = gv;
#pragma unroll
            for (int o = 1; o < 64; o <<= 1) { const float t = __shfl_up(gc, o); if (lane >= o) gc += t; }
            const float glast = __shfl(gc, 63);
            *(GAS float*)(gcs + (size_t)(tok0 + lane) * 8 + hh) = gc;
            if (lane == 0) dn[u] = expf(glast);
            sA = beta * expf(gc); sB = expf(glast - gc); sBeta = beta;
        }
#pragma unroll 1
        for (int qkv = 0; qkv < 3; ++qkv) {
            const int coff = qkv * 1024 + hh * 128 + d0;
            float w[4][8];
#pragma unroll
            for (int jj = 0; jj < 4; ++jj)
#pragma unroll
                for (int e = 0; e < 8; ++e) w[jj][e] = *(const GAS float*)(cw + jj * 3072 + coff + e);
            asm volatile("s_waitcnt lgkmcnt(0)" ::: "memory");
#pragma unroll 4
            for (int it = 0; it < 16; ++it) {
                const int i = 4 * it + ts, tok = tok0 + i; float acc[8];
                v4u rv[4];
#pragma unroll
                for (int jj = 0; jj < 4; ++jj) { const int r = tok - 3 + jj; rv[jj] = *(const GAS v4u*)(PO + (size_t)(r < 0 ? 0 : r) * OIN + coff); }
#pragma unroll
                for (int e = 0; e < 8; ++e) acc[e] = 0.f;
#pragma unroll
                for (int jj = 0; jj < 4; ++jj) { const float on = (tok - 3 + jj >= 0) ? 1.0f : 0.0f; const unsigned vv[4] = {rv[jj].x, rv[jj].y, rv[jj].z, rv[jj].w};
#pragma unroll
                    for (int q = 0; q < 4; ++q) { acc[2 * q] += (w[jj][2 * q] * on) * bflo(vv[q]); acc[2 * q + 1] += (w[jj][2 * q + 1] * on) * bfhi(vv[q]); } }
                float ss = 0.f;
#pragma unroll
                for (int e = 0; e < 8; ++e) { acc[e] = silu(acc[e]); ss += acc[e] * acc[e]; }
                ss += __shfl_xor(ss, 1); ss += __shfl_xor(ss, 2); ss += __shfl_xor(ss, 4); ss += __shfl_xor(ss, 8);
                const float rn = __builtin_amdgcn_rsqf(ss + 1e-6f);
                const float s1 = (qkv == 0) ? rn * 0.08838834764831845f : (qkv == 1 ? rn : 1.0f);
                v4u o; o.x = cvtpk(acc[0] * s1, acc[1] * s1); o.y = cvtpk(acc[2] * s1, acc[3] * s1); o.z = cvtpk(acc[4] * s1, acc[5] * s1); o.w = cvtpk(acc[6] * s1, acc[7] * s1);
                if (qkv < 2) *(GAS v4u*)((qkv == 0 ? QN : KN) + (size_t)tok * D_ + hh * 128 + d0) = o;
                if (qkv > 0) *(LAS v4u*)(tile + i * 136 + d0) = o;
            }
            if (qkv == 0) continue;
            asm volatile("s_waitcnt lgkmcnt(0)" ::: "memory");
#pragma unroll 1
            for (int half = 0; half < 2; ++half) {
                const int d = 64 * half + lane; const size_t obase = ((size_t)u * 128 + d) * 64;
                const LAS unsigned short* tp = (const LAS unsigned short*)tile + d;
#pragma unroll
                for (int ig = 0; ig < 8; ++ig) {
                    float o1[8], o2[8];
#pragma unroll
                    for (int e = 0; e < 8; ++e) { const int t = 8 * ig + e; const float v = __uint_as_float(((unsigned)tp[t * 136]) << 16);
                        const float m1 = __builtin_bit_cast(float, __builtin_amdgcn_readlane(__builtin_bit_cast(int, (qkv == 1) ? sA : sBeta), t));
                        const float m2 = __builtin_bit_cast(float, __builtin_amdgcn_readlane(__builtin_bit_cast(int, sB), t));
                        o1[e] = v * m1; o2[e] = v * m2; }
                    v4u o; o.x = cvtpk(o1[0], o1[1]); o.y = cvtpk(o1[2], o1[3]); o.z = cvtpk(o1[4], o1[5]); o.w = cvtpk(o1[6], o1[7]);
                    *(GAS v4u*)((qkv == 1 ? KGT : VBT) + obase + 8 * ig) = o;
                    if (qkv == 1) { o.x = cvtpk(o2[0], o2[1]); o.y = cvtpk(o2[2], o2[3]); o.z = cvtpk(o2[4], o2[5]); o.w = cvtpk(o2[6], o2[7]); *(GAS v4u*)(KTT + obase + 8 * ig) = o; }
                }
            }
        }
    }
}

__device__ __forceinline__ void p_g1(const Frame& F, const Args& a) {
    GAS unsigned char* ws = (GAS unsigned char*)a.ws; asm volatile("" : "+s"(ws)); int lane_ = F.lane; asm volatile("" : "+v"(lane_)); const int lane = lane_, r16 = lane & 15, g = lane >> 4;
    const bf16 *QN = (const bf16*)(ws + WS_ARENA + AR_QN), *KN = (const bf16*)(ws + WS_ARENA + AR_KN), *KGT = (const bf16*)(ws + WS_ARENA + AR_KGT), *VBT = (const bf16*)(ws + WS_ARENA + AR_VBT), *KTT = (const bf16*)(ws + WS_ARENA + AR_KTT);
    bf16 *AI = (bf16*)(ws + WS_ARENA + AR_AI), *NEGW = (bf16*)(ws + WS_ARENA + AR_NEGW), *UT = (bf16*)(ws + WS_ARENA + AR_UT), *MP = (bf16*)(ws + WS_ARENA + AR_MP), *NT = (bf16*)(ws + WS_ARENA + AR_NT), *WT = (bf16*)(ws + WS_ARENA + AR_WT);
    const float* gg = (const float*)(ws + WS_GC); const float* gbeta = (const float*)(ws + WS_GB) + S_ * 8;
    LAS float* Lc = (LAS float*)(F.lds + F.wave * WAVE_LDS);
    LAS bf16* Xs = (LAS bf16*)(F.lds + F.wave * WAVE_LDS);
    const f32x4 Z4 = {0.f, 0.f, 0.f, 0.f};
#ifdef PROBE_G1P
    const int g1p = a.use_bar ? 15 : PROBE_G1P;
#else
    const int g1p = 15;
#endif
#pragma unroll 1
    for (int tp_ = 2 * F.vcu + (F.wave >> 2); tp_ < 512; tp_ += 2 * F.G) {
        const int u = (4 * (tp_ >> 3) + (F.wave & 3)) * 8 + (tp_ & 7);
        const int n = u >> 3, hh = u & 7, tok0 = 64 * n; const int uh = hh * NCHUNK + n;
        const float gc = gg[(size_t)(tok0 + lane) * 8 + hh], beta = gbeta[(size_t)(tok0 + lane) * 8 + hh];
        if (g1p & 1) {
        {
            bf16x8 kf[4][4];
#pragma unroll
            for (int t = 0; t < 4; ++t)
#pragma unroll
                for (int kk = 0; kk < 4; ++kk) kf[t][kk] = ld16g(KN + (size_t)(tok0 + 16 * t + r16) * D_ + hh * 128 + 32 * kk + 8 * g);
#pragma unroll
            for (int ti = 0; ti < 4; ++ti)
#pragma unroll
                for (int tj = 0; tj <= ti; ++tj) {
                    f32x4 Dv = Z4;
#pragma unroll
                    for (int kk = 0; kk < 4; ++kk) Dv = MF16(kf[ti][kk], kf[tj][kk], Dv);
                    const int jx = 16 * tj + r16; const float gcj = __shfl(gc, jx); f32x4 val;
#pragma unroll
                    for (int r = 0; r < 4; ++r) { const int ix = 16 * ti + 4 * g + r; const float gci = __shfl(gc, ix), bi = __shfl(beta, ix); val[r] = (ix > jx) ? bi * Dv[r] * expf(gci - gcj) : 0.f; }
                    *(LAS f32x4*)(Lc + jx * 68 + 16 * ti + 4 * g) = val;
                }
#pragma unroll
            for (int ti = 0; ti < 4; ++ti) {
                bf16x8 qf[4];
#pragma unroll
                for (int kk = 0; kk < 4; ++kk) qf[kk] = ld16g(QN + (size_t)(tok0 + 16 * ti + r16) * D_ + hh * 128 + 32 * kk + 8 * g);
                const int ix = 16 * ti + r16; const float gci = __shfl(gc, ix);
#pragma unroll
                for (int tj = 0; tj < 4; ++tj) {
                    f32x4 val = Z4;
                    if (tj <= ti) {
                        f32x4 Dv = Z4;
#pragma unroll
                        for (int kk = 0; kk < 4; ++kk) Dv = MF16(kf[tj][kk], qf[kk], Dv);
#pragma unroll
                        for (int r = 0; r < 4; ++r) { const int jx = 16 * tj + 4 * g + r; const float gcj = __shfl(gc, jx); val[r] = (ix >= jx) ? Dv[r] * expf(gci - gcj) : 0.f; }
                    }
                    st8(AI + ((size_t)u * 64 + ix) * 64 + 16 * tj + 4 * g, val[0], val[1], val[2], val[3]);
                }
            }
        }
        asm volatile("s_waitcnt lgkmcnt(0)" ::: "memory");
        }
        if (g1p & 2) {
        tri_solve(Lc, Xs, lane);
        }
        if (g1p & 4) {
        asm volatile("s_waitcnt lgkmcnt(0)" ::: "memory");
        {
            bf16x8 xf[4][2];
#pragma unroll
            for (int t = 0; t < 4; ++t)
#pragma unroll
                for (int kk = 0; kk < 2; ++kk) xf[t][kk] = *(const LAS bf16x8*)(Xs + (16 * t + r16) * 72 + 32 * kk + 8 * g);
#pragma unroll 2
            for (int td = 0; td < 8; ++td) {
                const size_t rb = ((size_t)u * 128 + 16 * td + r16) * 64;
                const bf16x8 vb0 = ld16g(VBT + rb + 8 * g), vb1 = ld16g(VBT + rb + 32 + 8 * g), kg0 = ld16g(KGT + rb + 8 * g), kg1 = ld16g(KGT + rb + 32 + 8 * g);
#pragma unroll
                for (int ti = 0; ti < 4; ++ti) {
                    f32x4 Du = MF16(xf[ti][0], vb0, Z4); Du = MF16(xf[ti][1], vb1, Du);
                    st8(UT + rb + 16 * ti + 4 * g, Du[0], Du[1], Du[2], Du[3]);
                    f32x4 Dn = MF16(kg0, xf[ti][0], Z4); Dn = MF16(kg1, xf[ti][1], Dn);
                    st8(NEGW + (size_t)(tok0 + 16 * ti + r16) * D_ + hh * 128 + 16 * td + 4 * g, -Dn[0], -Dn[1], -Dn[2], -Dn[3]);
                }
            }
        }
        }
    }
}

template <int NS, int SGSTEP> __device__ __forceinline__ void p_g2(const Frame& F, const Args& a, const bf16* MPsrc, const bf16* NTsrc, const float* dnsrc) {
    GAS unsigned char* ws = (GAS unsigned char*)a.ws; asm volatile("" : "+s"(ws)); int lane_ = F.lane; asm volatile("" : "+v"(lane_)); const int lane = lane_, r16 = lane & 15, g = lane >> 4, w = F.wave;
    const bf16 *MP = MPsrc, *NT = NTsrc; bf16* SG = (bf16*)(ws + WS_ARENA + AR_SG);
    const float* dn = dnsrc;
    LAS bf16* St = (LAS bf16*)F.lds;
    const int args_use_bar = a.use_bar; (void)args_use_bar;
#pragma unroll 1
    for (int asg = F.vcu; asg < 64; asg += F.G) {
        const int hh = asg >> 3, sl = asg & 7;
        __syncthreads();
        for (int idx = F.tid; idx < 2 * 16 * 136 / 2; idx += NWAVES * 64) ((LAS unsigned*)St)[idx] = 0u;
        __syncthreads();
        if (w >= 4) {
            const int st = F.tid - 256, row = st >> 4, chunk = st & 15;
#pragma unroll 1
            for (int n = 0; n < NS; ++n) {
                const v4u v = *(const LAS v4u*)(St + (n & 1) * (16 * 136) + row * 136 + chunk * 8);
                *(GAS v4u*)(SG + ((size_t)(hh * NCHUNK + n * SGSTEP) * 128 + 16 * sl + row) * 128 + chunk * 8) = v;
                asm volatile("s_waitcnt lgkmcnt(0)" ::: "memory"); __builtin_amdgcn_s_barrier(); asm volatile("" ::: "memory");
            }
        } else {
            f32x4 Sv[2] = {{0.f, 0.f, 0.f, 0.f}, {0.f, 0.f, 0.f, 0.f}};
            bf16x8 A0[2][4], A1[2][4], A2[2][4], A3[2][4]; u32x2v C0[2], C1[2], C2[2], C3[2]; float d0, d1, d2, d3;
#define G2_LOAD(AX, CX, DX, nn) do { const int u_ = hh * NS + (nn); \
            _Pragma("unroll") for (int t = 0; t < 2; ++t) { \
                _Pragma("unroll") for (int kk = 0; kk < 4; ++kk) AX[t][kk] = ld16g(MP + ((size_t)u_ * 128 + 32 * w + 16 * t + r16) * 128 + 32 * kk + 8 * g); \
                CX[t] = *(const GAS u32x2v*)(NT + ((size_t)u_ * 128 + 16 * sl + r16) * 128 + 32 * w + 16 * t + 4 * g); } \
            DX = *(const GAS float*)(dn + (nn) * 8 + hh); } while (0)
#ifdef PROBE_G2_NOLOAD
#define G2_STEPLOAD(AL, CL, DL, nn) do { if (args_use_bar) G2_LOAD(AL, CL, DL, nn); } while (0)
#else
#define G2_STEPLOAD(AL, CL, DL, nn) G2_LOAD(AL, CL, DL, nn)
#endif
#define G2_STEP(AU, CU, DU, AL, CL, DL, nn) do { const int n_ = (nn); const int n2_ = (n_ + 3 < NS) ? n_ + 3 : NS - 1; \
            G2_STEPLOAD(AL, CL, DL, n2_); \
            LAS bf16* Sc = St + (n_ & 1) * (16 * 136); LAS bf16* Sn = St + ((n_ & 1) ^ 1) * (16 * 136); \
            f32x4 D0 = {bflo(CU[0].x), bfhi(CU[0].x), bflo(CU[0].y), bfhi(CU[0].y)}, D1 = {bflo(CU[1].x), bfhi(CU[1].x), bflo(CU[1].y), bfhi(CU[1].y)}; \
            _Pragma("unroll") for (int kk = 0; kk < 4; ++kk) { const bf16x8 Bf = *(const LAS bf16x8*)(Sc + r16 * 136 + 32 * kk + 8 * g); D0 = MF16(AU[0][kk], Bf, D0); D1 = MF16(AU[1][kk], Bf, D1); } \
            Sv[0] = Sv[0] * DU + D0; Sv[1] = Sv[1] * DU + D1; \
            { u32x2v o; o.x = cvtpk(Sv[0][0], Sv[0][1]); o.y = cvtpk(Sv[0][2], Sv[0][3]); *(LAS u32x2v*)(Sn + r16 * 136 + 32 * w + 4 * g) = o; \
              o.x = cvtpk(Sv[1][0], Sv[1][1]); o.y = cvtpk(Sv[1][2], Sv[1][3]); *(LAS u32x2v*)(Sn + r16 * 136 + 32 * w + 16 + 4 * g) = o; } \
            asm volatile("s_waitcnt lgkmcnt(0)" ::: "memory"); __builtin_amdgcn_s_barrier(); asm volatile("" ::: "memory"); } while (0)
            G2_LOAD(A0, C0, d0, 0); G2_LOAD(A1, C1, d1, 1); G2_LOAD(A2, C2, d2, 2);
            static_assert(NS % 24 == 16, "scan loop: trips of 24 steps + a 16-step tail");
            int n = 0;
#pragma unroll 1
            for (; n + 24 <= NS - 16; n += 24) {
                G2_STEP(A0, C0, d0, A3, C3, d3, n + 0);
                G2_STEP(A1, C1, d1, A0, C0, d0, n + 1);
                G2_STEP(A2, C2, d2, A1, C1, d1, n + 2);
                G2_STEP(A3, C3, d3, A2, C2, d2, n + 3);
                G2_STEP(A0, C0, d0, A3, C3, d3, n + 4);
                G2_STEP(A1, C1, d1, A0, C0, d0, n + 5);
                G2_STEP(A2, C2, d2, A1, C1, d1, n + 6);
                G2_STEP(A3, C3, d3, A2, C2, d2, n + 7);
                G2_STEP(A0, C0, d0, A3, C3, d3, n + 8);
                G2_STEP(A1, C1, d1, A0, C0, d0, n + 9);
                G2_STEP(A2, C2, d2, A1, C1, d1, n + 10);
                G2_STEP(A3, C3, d3, A2, C2, d2, n + 11);
                G2_STEP(A0, C0, d0, A3, C3, d3, n + 12);
                G2_STEP(A1, C1, d1, A0, C0, d0, n + 13);
                G2_STEP(A2, C2, d2, A1, C1, d1, n + 14);
                G2_STEP(A3, C3, d3, A2, C2, d2, n + 15);
                G2_STEP(A0, C0, d0, A3, C3, d3, n + 16);
                G2_STEP(A1, C1, d1, A0, C0, d0, n + 17);
                G2_STEP(A2, C2, d2, A1, C1, d1, n + 18);
                G2_STEP(A3, C3, d3, A2, C2, d2, n + 19);
                G2_STEP(A0, C0, d0, A3, C3, d3, n + 20);
                G2_STEP(A1, C1, d1, A0, C0, d0, n + 21);
                G2_STEP(A2, C2, d2, A1, C1, d1, n + 22);
                G2_STEP(A3, C3, d3, A2, C2, d2, n + 23);
            }
            G2_STEP(A0, C0, d0, A3, C3, d3, n + 0);
            G2_STEP(A1, C1, d1, A0, C0, d0, n + 1);
            G2_STEP(A2, C2, d2, A1, C1, d1, n + 2);
            G2_STEP(A3, C3, d3, A2, C2, d2, n + 3);
            G2_STEP(A0, C0, d0, A3, C3, d3, n + 4);
            G2_STEP(A1, C1, d1, A0, C0, d0, n + 5);
            G2_STEP(A2, C2, d2, A1, C1, d1, n + 6);
            G2_STEP(A3, C3, d3, A2, C2, d2, n + 7);
            G2_STEP(A0, C0, d0, A3, C3, d3, n + 8);
            G2_STEP(A1, C1, d1, A0, C0, d0, n + 9);
            G2_STEP(A2, C2, d2, A1, C1, d1, n + 10);
            G2_STEP(A3, C3, d3, A2, C2, d2, n + 11);
            G2_STEP(A0, C0, d0, A3, C3, d3, n + 12);
            G2_STEP(A1, C1, d1, A0, C0, d0, n + 13);
            G2_STEP(A2, C2, d2, A1, C1, d1, n + 14);
            G2_STEP(A3, C3, d3, A2, C2, d2, n + 15);
#undef G2_STEP
#undef G2_LOAD
        }
    }
}


constexpr int GST_W = 64 * 136, GST_K = 128 * 68, GST_PAIR = GST_W + GST_K, GST_BYTES = 2 * GST_PAIR * 2, GW_BYTES = 8704;
static_assert(GST_BYTES + 8 * GW_BYTES <= LDSCTL_OFF, "group-phase LDS map");
__device__ __forceinline__ void g_stage(const Frame& F, const bf16* NEGW, const bf16* KTT, int p, int n, int hh, bool on) {
    LAS bf16* sw = (LAS bf16*)F.lds + p * GST_PAIR; LAS bf16* sk = sw + GST_W;
#pragma unroll
    for (int q = 0; q < 2; ++q) { const int idx = F.tid + 512 * q;
        { const int row = idx >> 4, ch = idx & 15; v4u v = {0u, 0u, 0u, 0u}; if (on) v = *(const GAS v4u*)(NEGW + (size_t)(64 * n + row) * D_ + hh * 128 + ch * 8); *(LAS v4u*)(sw + row * 136 + ch * 8) = v; }
        { const int row = idx >> 3, ch = idx & 7; u32x2v a = {0u, 0u}, b = a; if (on) { const v4u v = *(const GAS v4u*)(KTT + ((size_t)(n * 8 + hh) * 128 + row) * 64 + ch * 8); a.x = v.x; a.y = v.y; b.x = v.z; b.y = v.w; }
          *(LAS u32x2v*)(sk + row * 68 + ch * 8) = a; *(LAS u32x2v*)(sk + row * 68 + ch * 8 + 4) = b; } }
}
template <bool PERM> __device__ __forceinline__ void g_prod1(f32x4 (&T)[4][2], const LAS bf16* sw, const bf16x8 (&xo)[4][2], int r16, int g) {
#pragma unroll
    for (int mt = 0; mt < 4; ++mt) {
        bf16x8 af[4];
#pragma unroll
        for (int s = 0; s < 4; ++s) {
            if (PERM) { const LAS bf16* rp = sw + (16 * mt + r16) * 136 + 32 * s + 4 * g; const u32x2v lo = *(const LAS u32x2v*)rp, hi = *(const LAS u32x2v*)(rp + 16); const v4u pk = {lo.x, lo.y, hi.x, hi.y}; af[s] = __builtin_bit_cast(bf16x8, pk); }
            else af[s] = *(const LAS bf16x8*)(sw + (16 * mt + r16) * 136 + 32 * s + 8 * g); }
#pragma unroll
        for (int nt = 0; nt < 2; ++nt)
#pragma unroll
            for (int s = 0; s < 4; ++s) T[mt][nt] = MF16(af[s], xo[s][nt], T[mt][nt]);
        asm volatile("" ::: "memory");
    }
}
__device__ __forceinline__ void g_prod2(f32x4 (&X)[8][2], const LAS bf16* sk, const f32x4 (&T)[4][2], int r16, int g) {
    bf16x8 to[2][2];
#pragma unroll
    for (int s = 0; s < 2; ++s)
#pragma unroll
        for (int nt = 0; nt < 2; ++nt) { v4u p; p.x = cvtpk(T[2 * s][nt][0], T[2 * s][nt][1]); p.y = cvtpk(T[2 * s][nt][2], T[2 * s][nt][3]); p.z = cvtpk(T[2 * s + 1][nt][0], T[2 * s + 1][nt][1]); p.w = cvtpk(T[2 * s + 1][nt][2], T[2 * s + 1][nt][3]);
            to[s][nt] = __builtin_bit_cast(bf16x8, p); }
#pragma unroll
    for (int mt = 0; mt < 8; ++mt) {
        bf16x8 af[2];
#pragma unroll
        for (int s = 0; s < 2; ++s) { const LAS bf16* rp = sk + (16 * mt + r16) * 68 + 32 * s + 4 * g; const u32x2v lo = *(const LAS u32x2v*)rp, hi = *(const LAS u32x2v*)(rp + 16); const v4u pk = {lo.x, lo.y, hi.x, hi.y}; af[s] = __builtin_bit_cast(bf16x8, pk); }
#pragma unroll
        for (int nt = 0; nt < 2; ++nt)
#pragma unroll
            for (int s = 0; s < 2; ++s) X[mt][nt] = MF16(af[s], to[s][nt], X[mt][nt]);
        asm volatile("" ::: "memory");
    }
}
__device__ __forceinline__ void p_g1b(const Frame& F, const Args& a) {
    GAS unsigned char* ws = (GAS unsigned char*)a.ws; asm volatile("" : "+s"(ws)); int lane_ = F.lane; asm volatile("" : "+v"(lane_)); const int lane = lane_, r16 = lane & 15, g = lane >> 4;
    const bf16 *NEGW = (const bf16*)(ws + WS_ARENA + AR_NEGW), *KTT = (const bf16*)(ws + WS_ARENA + AR_KTT), *UT = (const bf16*)(ws + WS_ARENA + AR_UT); const float* dn = (const float*)(ws + WS_TOK + TOK_DN);
    bf16 *MPc = (bf16*)(ws + WS_ARENA + AR_MPC), *NTc = (bf16*)(ws + WS_ARENA + AR_NTC); float* dnc = (float*)(ws + WS_TOK + TOK_DNC);
    const bool isB = F.wave >= 4; const int sl = F.wave & 3, c0 = 32 * sl;
    const LAS bf16* sw = (const LAS bf16*)F.lds; const LAS bf16* sk = sw + GST_W; LAS bf16* wa = (LAS bf16*)(F.lds + GST_BYTES + F.wave * GW_BYTES);
#pragma unroll 1
    for (int tp = 2 * F.vcu; tp < 512; tp += (tp & 1) ? 2 * F.G - 1 : 1) {
        const int hh = tp & 7, gq = tp >> 3;
        f32x4 X[8][2]; float Dd = 1.0f;
#pragma unroll
        for (int mt = 0; mt < 8; ++mt)
#pragma unroll
            for (int nt = 0; nt < 2; ++nt) X[mt][nt] = (f32x4){0.f, 0.f, 0.f, 0.f};
#pragma unroll 1
        for (int i = 0; i < 4; ++i) {
            const int n = 4 * gq + i; const float di = *(const GAS float*)(dn + n * 8 + hh);
            bf16x8 xo[4][2]; const float dadd = isB ? 0.0f : Dd;
#pragma unroll
            for (int s = 0; s < 4; ++s)
#pragma unroll
                for (int nt = 0; nt < 2; ++nt) { v4u pr; const int col = c0 + 16 * nt + r16; f32x4 t0 = X[2 * s][nt], t1 = X[2 * s + 1][nt];
#pragma unroll
                    for (int r = 0; r < 4; ++r) { if (32 * s + 4 * g + r == col) t0[r] += dadd; if (32 * s + 16 + 4 * g + r == col) t1[r] += dadd; }
                    pr.x = cvtpk(t0[0], t0[1]); pr.y = cvtpk(t0[2], t0[3]); pr.z = cvtpk(t1[0], t1[1]); pr.w = cvtpk(t1[2], t1[3]); xo[s][nt] = __builtin_bit_cast(bf16x8, pr); }
            __syncthreads();
            g_stage(F, NEGW, KTT, 0, n, hh, true);
            f32x4 T[4][2];
#pragma unroll
            for (int mt = 0; mt < 4; ++mt)
#pragma unroll
                for (int nt = 0; nt < 2; ++nt) { T[mt][nt] = (f32x4){0.f, 0.f, 0.f, 0.f};
                    if (isB) { const u32x2v uu = *(const GAS u32x2v*)(UT + ((size_t)(n * 8 + hh) * 128 + c0 + 16 * nt + r16) * 64 + 16 * mt + 4 * g); T[mt][nt] = (f32x4){bflo(uu.x), bfhi(uu.x), bflo(uu.y), bfhi(uu.y)}; } }
            __syncthreads();
            g_prod1<true>(T, sw, xo, r16, g);
#pragma unroll
            for (int mt = 0; mt < 8; ++mt)
#pragma unroll
                for (int nt = 0; nt < 2; ++nt) X[mt][nt] = X[mt][nt] * di;
            g_prod2(X, sk, T, r16, g);
            Dd *= di;
        }
        const int uc = hh * 64 + gq;
        if (isB) {
#pragma unroll
            for (int mt = 0; mt < 8; ++mt)
#pragma unroll
                for (int nt = 0; nt < 2; ++nt) st8(NTc + ((size_t)uc * 128 + c0 + 16 * nt + r16) * 128 + 16 * mt + 4 * g, X[mt][nt][0], X[mt][nt][1], X[mt][nt][2], X[mt][nt][3]);
        } else {
            if (sl == 0 && lane == 0) dnc[gq * 8 + hh] = Dd;
#pragma unroll
            for (int hf = 0; hf < 2; ++hf) {
                asm volatile("s_waitcnt lgkmcnt(0)" ::: "memory");
#pragma unroll
                for (int m4 = 0; m4 < 4; ++m4)
#pragma unroll
                    for (int nt = 0; nt < 2; ++nt)
#pragma unroll
                        for (int r = 0; r < 4; ++r) wa[(16 * m4 + 4 * g + r) * 40 + 16 * nt + r16] = (unsigned short)(cvtpk(X[4 * hf + m4][nt][r], 0.f) & 0xffffu);
                asm volatile("s_waitcnt lgkmcnt(0)" ::: "memory");
#pragma unroll
                for (int q = 0; q < 4; ++q) { const int row = 16 * q + (lane >> 2), ch = lane & 3; const v4u v = *(const LAS v4u*)(wa + row * 40 + ch * 8);
                    *(GAS v4u*)(MPc + ((size_t)uc * 128 + 64 * hf + row) * 128 + c0 + ch * 8) = v; }
            }
        }
    }
    __syncthreads();
}

__device__ __forceinline__ void p_g23(const Frame& F, const Args& a, int L) {
    GAS unsigned char* ws = (GAS unsigned char*)a.ws; asm volatile("" : "+s"(ws)); int lane_ = F.lane; asm volatile("" : "+v"(lane_)); const int lane = lane_, r16 = lane & 15, g = lane >> 4;
    const bf16 *NEGW = (const bf16*)(ws + WS_ARENA + AR_NEGW), *KTT = (const bf16*)(ws + WS_ARENA + AR_KTT), *UT = (const bf16*)(ws + WS_ARENA + AR_UT), *SG = (const bf16*)(ws + WS_ARENA + AR_SG),
               *QN = (const bf16*)(ws + WS_ARENA + AR_QN), *AI = (const bf16*)(ws + WS_ARENA + AR_AI), *PO = (const bf16*)(ws + WS_ARENA + AR_PO);
    const float* gcs = (const float*)(ws + WS_GC);
    const float* dn = (const float*)(ws + WS_TOK + TOK_DN); bf16* mix = (bf16*)(ws + WS_MIX); const float* onorm = (const float*)a.in[19] + (L >> 1) * 128;
    const int pw = F.wave >> 2, qf = F.wave & 3, c0 = 32 * qf;
    const LAS bf16* sw = (const LAS bf16*)F.lds + pw * GST_PAIR; const LAS bf16* sk = sw + GST_W; LAS bf16* Sl = (LAS bf16*)(F.lds + GST_BYTES + F.wave * GW_BYTES);
    LAS float* xch = (LAS float*)(F.lds + RT_OFF);
#pragma unroll 1
    for (int tp0 = 2 * F.vcu; tp0 < 512; tp0 += 2 * F.G) {
        const int tp = tp0 + pw; const bool on = tp < 512; const int tpc = on ? tp : 0, hh = tpc & 7, gq = tpc >> 3;
        const int tpa = tp0, tpb = (tp0 + 1 < 512) ? tp0 + 1 : 0;
        { const int u0 = hh * NCHUNK + 4 * gq;
#pragma unroll
          for (int q = 0; q < 8; ++q) { const int row = 4 * q + (lane >> 4), ch = lane & 15; const v4u v = *(const GAS v4u*)(SG + ((size_t)u0 * 128 + c0 + row) * 128 + ch * 8); *(LAS v4u*)(Sl + row * 136 + ch * 8) = v; } }
#pragma unroll 1
        for (int i = 0; i < 4; ++i) {
            __syncthreads();
            g_stage(F, NEGW, KTT, 0, 4 * (tpa >> 3) + i, tpa & 7, tpa < 512); g_stage(F, NEGW, KTT, 1, 4 * (tpb >> 3) + i, tpb & 7, tp0 + 1 < 512);
            const int n = 4 * gq + i, u = n * 8 + hh, tok0 = 64 * n; const float di = *(const GAS float*)(dn + n * 8 + hh);
            f32x4 T[4][2];
#pragma unroll
            for (int mt = 0; mt < 4; ++mt)
#pragma unroll
                for (int nt = 0; nt < 2; ++nt) { const u32x2v uu = *(const GAS u32x2v*)(UT + ((size_t)u * 128 + c0 + 16 * nt + r16) * 64 + 16 * mt + 4 * g); T[mt][nt] = (f32x4){bflo(uu.x), bfhi(uu.x), bflo(uu.y), bfhi(uu.y)}; }
            asm volatile("s_waitcnt lgkmcnt(0)" ::: "memory");
            bf16x8 Bf[4][2];
#pragma unroll
            for (int nt = 0; nt < 2; ++nt)
#pragma unroll
                for (int s = 0; s < 4; ++s) Bf[s][nt] = *(const LAS bf16x8*)(Sl + (16 * nt + r16) * 136 + 32 * s + 8 * g);
            __syncthreads();
            g_prod1<false>(T, sw, Bf, r16, g);
            bf16x8 vo[2][2];
#pragma unroll
            for (int s = 0; s < 2; ++s)
#pragma unroll
                for (int nt = 0; nt < 2; ++nt) { v4u p; p.x = cvtpk(T[2 * s][nt][0], T[2 * s][nt][1]); p.y = cvtpk(T[2 * s][nt][2], T[2 * s][nt][3]); p.z = cvtpk(T[2 * s + 1][nt][0], T[2 * s + 1][nt][1]); p.w = cvtpk(T[2 * s + 1][nt][2], T[2 * s + 1][nt][3]);
                    vo[s][nt] = __builtin_bit_cast(bf16x8, p); }
            f32x4 o[2][4];
#pragma unroll
            for (int it = 0; it < 4; ++it) {
                const int tok = tok0 + 16 * it + r16; bf16x8 qfr[4], afr[2];
                { const float eg = expf(*(const GAS float*)(gcs + (size_t)tok * 8 + hh));
#pragma unroll
                  for (int s = 0; s < 4; ++s) { const v4u qv = *(const GAS v4u*)(QN + (size_t)tok * D_ + hh * 128 + 32 * s + 8 * g); v4u qs;
                      qs.x = cvtpk(bflo(qv.x) * eg, bfhi(qv.x) * eg); qs.y = cvtpk(bflo(qv.y) * eg, bfhi(qv.y) * eg); qs.z = cvtpk(bflo(qv.z) * eg, bfhi(qv.z) * eg); qs.w = cvtpk(bflo(qv.w) * eg, bfhi(qv.w) * eg);
                      qfr[s] = __builtin_bit_cast(bf16x8, qs); } }
#pragma unroll
                for (int s = 0; s < 2; ++s) { const bf16* ap = AI + ((size_t)u * 64 + 16 * it + r16) * 64 + 32 * s + 4 * g; const u32x2v lo = *(const GAS u32x2v*)ap, hi = *(const GAS u32x2v*)(ap + 16);
                    const v4u pk = {lo.x, lo.y, hi.x, hi.y}; afr[s] = __builtin_bit_cast(bf16x8, pk); }
#pragma unroll
                for (int nt = 0; nt < 2; ++nt) { f32x4 Dv = {0.f, 0.f, 0.f, 0.f};
#pragma unroll
                    for (int s = 0; s < 4; ++s) Dv = MF16(Bf[s][nt], qfr[s], Dv);
#pragma unroll
                    for (int s = 0; s < 2; ++s) Dv = MF16(vo[s][nt], afr[s], Dv);
                    o[nt][it] = Dv; }
            }
            __syncthreads();
#pragma unroll
            for (int it = 0; it < 4; ++it) { float ss = 0.f;
#pragma unroll
                for (int nt = 0; nt < 2; ++nt) ss += (o[nt][it][0] * o[nt][it][0] + o[nt][it][1] * o[nt][it][1]) + (o[nt][it][2] * o[nt][it][2] + o[nt][it][3] * o[nt][it][3]);
                ss += __shfl_xor(ss, 16); ss += __shfl_xor(ss, 32);
                if (g == 0) xch[(pw * 4 + qf) * 64 + 16 * it + r16] = ss; }
            __syncthreads();
#pragma unroll
            for (int it = 0; it < 4; ++it) { const int ti = 16 * it + r16, tok = tok0 + ti;
                const float ssq = (xch[(pw * 4 + 0) * 64 + ti] + xch[(pw * 4 + 1) * 64 + ti]) + (xch[(pw * 4 + 2) * 64 + ti] + xch[(pw * 4 + 3) * 64 + ti]);
                const float rms = __builtin_amdgcn_rsqf(ssq * (1.0f / 128.0f) + RMS_EPS);
#pragma unroll
                for (int nt = 0; nt < 2; ++nt) { const int col = c0 + 16 * nt + 4 * g;
                    const u32x2v z = *(const GAS u32x2v*)(PO + (size_t)tok * OIN + 3072 + hh * 128 + col); const f32x4 gn = *(const GAS f32x4*)(onorm + col);
                    if (on) st8(mix + (size_t)tok * D_ + hh * 128 + col, o[nt][it][0] * rms * gn[0] * silu(bflo(z.x)), o[nt][it][1] * rms * gn[1] * silu(bfhi(z.x)),
                                o[nt][it][2] * rms * gn[2] * silu(bflo(z.y)), o[nt][it][3] * rms * gn[3] * silu(bfhi(z.y))); } }
            if (i < 3) {
                f32x4 acc[8][2];
#pragma unroll
                for (int mt = 0; mt < 8; ++mt)
#pragma unroll
                    for (int nt = 0; nt < 2; ++nt) { const u32x2v so = *(const LAS u32x2v*)(Sl + (16 * nt + r16) * 136 + 16 * mt + 4 * g); acc[mt][nt] = (f32x4){di * bflo(so.x), di * bfhi(so.x), di * bflo(so.y), di * bfhi(so.y)}; }
                g_prod2(acc, sk, T, r16, g);
                asm volatile("s_waitcnt lgkmcnt(0)" ::: "memory");
#pragma unroll
                for (int mt = 0; mt < 8; ++mt)
#pragma unroll
                    for (int nt = 0; nt < 2; ++nt) { u32x2v ov; ov.x = cvtpk(acc[mt][nt][0], acc[mt][nt][1]); ov.y = cvtpk(acc[mt][nt][2], acc[mt][nt][3]); *(LAS u32x2v*)(Sl + (16 * nt + r16) * 136 + 16 * mt + 4 * g) = ov; }
            }
        }
    }
    __syncthreads();
}

__device__ __forceinline__ void p_g3(const Frame& F, const Args& a, int L) {
    GAS unsigned char* ws = (GAS unsigned char*)a.ws; asm volatile("" : "+s"(ws)); int lane_ = F.lane; asm volatile("" : "+v"(lane_)); const int j = L >> 1, lane = lane_, r16 = lane & 15, g = lane >> 4;
    const bf16 *PO = (const bf16*)(ws + WS_ARENA + AR_PO), *QT = (const bf16*)(ws + WS_ARENA + AR_QT), *AI = (const bf16*)(ws + WS_ARENA + AR_AI), *NEGW = (const bf16*)(ws + WS_ARENA + AR_NEGW),
               *UT = (const bf16*)(ws + WS_ARENA + AR_UT), *SG = (const bf16*)(ws + WS_ARENA + AR_SG);
    bf16* mix = (bf16*)(ws + WS_MIX); const float* onorm = (const float*)a.in[19] + j * 128;
    const f32x4 Z4 = {0.f, 0.f, 0.f, 0.f};
#pragma unroll 1
    for (int tp_ = 2 * F.vcu + (F.wave >> 2); tp_ < 512; tp_ += 2 * F.G) {
        const int u = (4 * (tp_ >> 3) + (F.wave & 3)) * 8 + (tp_ & 7);
        const int n = u >> 3, hh = u & 7, tok0 = 64 * n; const int uh = hh * NCHUNK + n;
        unsigned vn[8][4][2];
        {
            bf16x8 nw[4][4];
#pragma unroll
            for (int jt = 0; jt < 4; ++jt)
#pragma unroll
                for (int kk = 0; kk < 4; ++kk) nw[jt][kk] = ld16g(NEGW + (size_t)(tok0 + 16 * jt + r16) * D_ + hh * 128 + 32 * kk + 8 * g);
#pragma unroll
            for (int d2t = 0; d2t < 8; ++d2t) {
                bf16x8 sg[4];
#pragma unroll
                for (int kk = 0; kk < 4; ++kk) sg[kk] = ld16g(SG + ((size_t)uh * 128 + 16 * d2t + r16) * 128 + 32 * kk + 8 * g);
#pragma unroll
                for (int jt = 0; jt < 4; ++jt) {
                    const u32x2v c = *(const GAS u32x2v*)(UT + ((size_t)u * 128 + 16 * d2t + r16) * 64 + 16 * jt + 4 * g);
                    f32x4 Dv = {bflo(c.x), bfhi(c.x), bflo(c.y), bfhi(c.y)};
#pragma unroll
                    for (int kk = 0; kk < 4; ++kk) Dv = MF16(nw[jt][kk], sg[kk], Dv);
                    vn[d2t][jt][0] = cvtpk(Dv[0], Dv[1]); vn[d2t][jt][1] = cvtpk(Dv[2], Dv[3]);
                    asm volatile("" : "+v"(vn[d2t][jt][0]), "+v"(vn[d2t][jt][1]));
                }
                asm volatile("" ::: "memory");
            }
        }
#pragma unroll 1
        for (int ti = 0; ti < 4; ++ti) {
            const int tok = tok0 + 16 * ti + r16;
            bf16x8 qf[4], af[2];
#pragma unroll
            for (int kk = 0; kk < 4; ++kk) qf[kk] = ld16g(QT + (size_t)tok * D_ + hh * 128 + 32 * kk + 8 * g);
#pragma unroll
            for (int k2 = 0; k2 < 2; ++k2) { const u32x2v lo = *(const GAS u32x2v*)(AI + ((size_t)u * 64 + 16 * ti + r16) * 64 + 32 * k2 + 4 * g), hi = *(const GAS u32x2v*)(AI + ((size_t)u * 64 + 16 * ti + r16) * 64 + 32 * k2 + 16 + 4 * g);
                const v4u pk = {lo.x, lo.y, hi.x, hi.y}; af[k2] = __builtin_bit_cast(bf16x8, pk); }
            f32x4 acc[8]; float ss = 0.f;
#pragma unroll
            for (int d2t = 0; d2t < 8; ++d2t) {
                f32x4 Dv = Z4;
#pragma unroll
                for (int kk = 0; kk < 4; ++kk) { const bf16x8 sgf = ld16g(SG + ((size_t)uh * 128 + 16 * d2t + r16) * 128 + 32 * kk + 8 * g); Dv = MF16(sgf, qf[kk], Dv); }
#pragma unroll
                for (int k2 = 0; k2 < 2; ++k2) { const v4u pk = {vn[d2t][2 * k2][0], vn[d2t][2 * k2][1], vn[d2t][2 * k2 + 1][0], vn[d2t][2 * k2 + 1][1]}; Dv = MF16(__builtin_bit_cast(bf16x8, pk), af[k2], Dv); }
                acc[d2t] = Dv; ss += (Dv[0] * Dv[0] + Dv[1] * Dv[1]) + (Dv[2] * Dv[2] + Dv[3] * Dv[3]);
            }
            ss += __shfl_xor(ss, 16); ss += __shfl_xor(ss, 32);
            const float rms = __builtin_amdgcn_rsqf(ss * (1.0f / 128.0f) + RMS_EPS);
#pragma unroll
            for (int d2t = 0; d2t < 8; ++d2t) {
                const u32x2v z = *(const GAS u32x2v*)(PO + (size_t)tok * OIN + 3072 + hh * 128 + 16 * d2t + 4 * g); const f32x4 gn = *(const GAS f32x4*)(onorm + 16 * d2t + 4 * g);
                st8(mix + (size_t)tok * D_ + hh * 128 + 16 * d2t + 4 * g, acc[d2t][0] * rms * gn[0] * silu(bflo(z.x)), acc[d2t][1] * rms * gn[1] * silu(bfhi(z.x)),
                    acc[d2t][2] * rms * gn[2] * silu(bflo(z.y)), acc[d2t][3] * rms * gn[3] * silu(bfhi(z.y)));
            }
        }
    }
}

__device__ __forceinline__ void p_r1(const Frame& F, const Args& a, int L) {
    GAS unsigned char* ws = (GAS unsigned char*)a.ws; asm volatile("" : "+s"(ws)); int lane_ = F.lane; asm volatile("" : "+v"(lane_)); const int j = L >> 1, lane = lane_;
    const float* ssq = (const float*)(ws + WS_SSQA); const float* wr = (const float*)a.in[24] + (size_t)j * D_ * NEXP; const float* ln = (const float*)a.in[4] + L * D_;
    int* tok_e = (int*)(ws + WS_TOK + TOK_E); int* tok_r = (int*)(ws + WS_TOK + TOK_R); float* tok_g = (float*)(ws + WS_TOK + TOK_G);
    unsigned* gcount = (unsigned*)(ws + WS_CTL) + CW_CNT + 64 * j;
    LAS int* rt = (LAS int*)(F.lds + RT_OFF);
    if (F.tid < 16) rt[F.tid] = 0;
    __syncthreads();
    const GAS float* hG = (const GAS float*)a.out; const GAS float* wrG = (const GAS float*)wr; const GAS float* lnG = (const GAS float*)ln;
    float lnr[16];
#pragma unroll
    for (int i = 0; i < 16; ++i) lnr[i] = lnG[64 * i + lane];
#pragma unroll 1
    for (int t = F.gw; t < S_; t += 2 * F.NGW) {
        const int tb = t + F.NGW; const bool hasb = tb < S_; const int tbc = hasb ? tb : t;
        float xa[16], xb[16];
#pragma unroll
        for (int i = 0; i < 16; ++i) { xa[i] = hG[(size_t)t * D_ + 64 * i + lane]; xb[i] = hG[(size_t)tbc * D_ + 64 * i + lane]; }
        const float rsa = pg8::rstd_row(ssq, t), rsb = pg8::rstd_row(ssq, tbc);
        float acca[8], accb[8];
#pragma unroll
        for (int e = 0; e < 8; ++e) { acca[e] = 0.f; accb[e] = 0.f; }
#pragma unroll
        for (int i = 0; i < 16; ++i) { const int k = 64 * i + lane; const f32x4 w0 = *(const GAS f32x4*)(wrG + (size_t)k * 8), w1 = *(const GAS f32x4*)(wrG + (size_t)k * 8 + 4);
            const float x = xa[i] * lnr[i], y = xb[i] * lnr[i];
            acca[0] += x * w0[0]; acca[1] += x * w0[1]; acca[2] += x * w0[2]; acca[3] += x * w0[3]; acca[4] += x * w1[0]; acca[5] += x * w1[1]; acca[6] += x * w1[2]; acca[7] += x * w1[3];
            accb[0] += y * w0[0]; accb[1] += y * w0[1]; accb[2] += y * w0[2]; accb[3] += y * w0[3]; accb[4] += y * w1[0]; accb[5] += y * w1[1]; accb[6] += y * w1[2]; accb[7] += y * w1[3]; }
#pragma unroll
        for (int e = 0; e < 8; ++e) { acca[e] = wave_sum(acca[e]) * rsa; accb[e] = wave_sum(accb[e]) * rsb; }
#pragma unroll
        for (int half = 0; half < 2; ++half) {
            if (half == 1 && !hasb) break;
            const int tt = half ? tb : t; float acc[8];
#pragma unroll
            for (int e = 0; e < 8; ++e) acc[e] = half ? accb[e] : acca[e];
            int e0 = 0; float l0 = acc[0];
#pragma unroll
            for (int e = 1; e < 8; ++e) if (acc[e] > l0) { l0 = acc[e]; e0 = e; }
            int e1 = -1; float l1 = -INFINITY;
#pragma unroll
            for (int e = 0; e < 8; ++e) if (e != e0 && acc[e] > l1) { l1 = acc[e]; e1 = e; }
            const float g1 = 1.0f / (1.0f + expf(l0 - l1)), g0 = 1.0f - g1;
            if (lane == 0) {
                const int r0 = __hip_atomic_fetch_add(rt + e0, 1, __ATOMIC_RELAXED, __HIP_MEMORY_SCOPE_WORKGROUP), r1 = __hip_atomic_fetch_add(rt + e1, 1, __ATOMIC_RELAXED, __HIP_MEMORY_SCOPE_WORKGROUP);
                tok_e[2 * tt] = e0; tok_e[2 * tt + 1] = e1; tok_r[2 * tt] = r0; tok_r[2 * tt + 1] = r1; tok_g[2 * tt] = g0; tok_g[2 * tt + 1] = g1;
            }
        }
    }
    __syncthreads();
    if (F.tid < 8) rt[8 + F.tid] = (int)__hip_atomic_fetch_add(gcount + F.tid, (unsigned)rt[F.tid], __ATOMIC_RELAXED, __HIP_MEMORY_SCOPE_AGENT);
    __syncthreads();
#pragma unroll 1
    for (int t = F.gw; t < S_; t += F.NGW) if (lane < 2) { const int e = tok_e[2 * t + lane]; tok_r[2 * t + lane] += rt[8 + e]; }
    __syncthreads();
}
__device__ __forceinline__ int moe_pstart(const unsigned* gcount, int e) {
    int ps = 0;
#pragma unroll
    for (int q = 0; q < 8; ++q) { const int c = (int)gcount[q]; if (q < e) ps += ((c + 255) >> 8) << 8; }
    return ps;
}
__device__ __forceinline__ void p_r2(const Frame& F, const Args& a, int L) {
    GAS unsigned char* ws = (GAS unsigned char*)a.ws; asm volatile("" : "+s"(ws)); int lane_ = F.lane; asm volatile("" : "+v"(lane_)); const int j = L >> 1, lane = lane_;
    const float* ssq = (const float*)(ws + WS_SSQA);
    const int* tok_e = (const int*)(ws + WS_TOK + TOK_E); const int* tok_r = (const int*)(ws + WS_TOK + TOK_R); const float* tok_g = (const float*)(ws + WS_TOK + TOK_G);
    int* dst = (int*)(ws + WS_TOK + TOK_DST); float* gpad = (float*)(ws + WS_TOK + TOK_GPAD);
    const unsigned* gcount = (const unsigned*)(ws + WS_CTL) + CW_CNT + 64 * j; bf16* XS = (bf16*)(ws + WS_ARENA + AR_XS);
    int pst[8]; { int ps = 0;
#pragma unroll
        for (int q = 0; q < 8; ++q) { pst[q] = ps; ps += (((int)gcount[q] + 255) >> 8) << 8; } }
    const GAS float* hG = (const GAS float*)a.out;
#pragma unroll 1
    for (int t0 = F.gw; t0 < S_; t0 += 4 * F.NGW) {
        int tt[4], da[4], db[4]; float rs[4], ga[4], gb[4]; f32x4 v[4][4];
#pragma unroll
        for (int u = 0; u < 4; ++u) { const int t = t0 + u * F.NGW; tt[u] = t < S_ ? t : t0;
#pragma unroll
            for (int q = 0; q < 4; ++q) v[u][q] = *((const GAS f32x4*)(hG + (size_t)tt[u] * D_) + 64 * q + lane); }
#pragma unroll
        for (int u = 0; u < 4; ++u) { const int t = tt[u]; rs[u] = pg8::rstd_row(ssq, t);
            const int ea = tok_e[2 * t], eb = tok_e[2 * t + 1]; int pa = 0, pb = 0;
#pragma unroll
            for (int q = 0; q < 8; ++q) { pa = (q == ea) ? pst[q] : pa; pb = (q == eb) ? pst[q] : pb; }
            da[u] = pa + tok_r[2 * t]; db[u] = pb + tok_r[2 * t + 1]; ga[u] = tok_g[2 * t]; gb[u] = tok_g[2 * t + 1]; }
#pragma unroll
        for (int u = 0; u < 4; ++u) { if (t0 + u * F.NGW >= S_) break; const int t = tt[u];
            if (lane == 0) { dst[2 * t] = da[u]; dst[2 * t + 1] = db[u]; gpad[da[u]] = ga[u]; gpad[db[u]] = gb[u]; }
#pragma unroll
            for (int q = 0; q < 4; ++q) { const f32x4 x = v[u][q] * rs[u]; u32x2v o; o.x = cvtpk(x[0], x[1]); o.y = cvtpk(x[2], x[3]);
                *((GAS u32x2v*)(XS + (size_t)da[u] * D_) + 64 * q + lane) = o; *((GAS u32x2v*)(XS + (size_t)db[u] * D_) + 64 * q + lane) = o; } }
    }
}
__device__ __forceinline__ int moe_blocks(const Frame& F, const Args& a, int L) {
    const unsigned* gcount = (const unsigned*)(a.ws + WS_CTL) + CW_CNT + 64 * (L >> 1);
    LAS int* blk = (LAS int*)(F.lds + BLKE_OFF);
    int nb_tot = 0, mine = 7;
#pragma unroll
    for (int q = 0; q < 8; ++q) { const int nb = ((int)gcount[q] + 255) >> 8; if (F.tid >= nb_tot && F.tid < nb_tot + nb) mine = q; nb_tot += nb; }
    __syncthreads();
    if (F.tid < 160) blk[F.tid] = mine;
    __syncthreads();
    return nb_tot;
}
__device__ __forceinline__ void p_combine(const Frame& F, const Args& a) {
    GAS unsigned char* ws = (GAS unsigned char*)a.ws; asm volatile("" : "+s"(ws)); int lane_ = F.lane; asm volatile("" : "+v"(lane_)); const int lane = lane_;
    const int* dst = (const int*)(ws + WS_TOK + TOK_DST); const bf16* Y = (const bf16*)(ws + WS_ARENA + AR_Y); bf16* hb = (bf16*)(ws + WS_HBF); float* ssq = (float*)(ws + WS_SSQA);
    const GAS float* hG = (const GAS float*)a.out;
#pragma unroll 1
    for (int t0 = F.gw; t0 < S_; t0 += 2 * F.NGW) {
        int tt[2], da[2], db[2]; f32x4 v[2][4]; u32x2v ya[2][4], yb[2][4];
#pragma unroll
        for (int u = 0; u < 2; ++u) { const int t = t0 + u * F.NGW; tt[u] = t < S_ ? t : t0; da[u] = dst[2 * tt[u]]; db[u] = dst[2 * tt[u] + 1];
#pragma unroll
            for (int q = 0; q < 4; ++q) v[u][q] = *((const GAS f32x4*)(hG + (size_t)tt[u] * D_) + 64 * q + lane); }
#pragma unroll
        for (int u = 0; u < 2; ++u)
#pragma unroll
            for (int q = 0; q < 4; ++q) { ya[u][q] = *((const GAS u32x2v*)(Y + (size_t)da[u] * D_) + 64 * q + lane); yb[u][q] = *((const GAS u32x2v*)(Y + (size_t)db[u] * D_) + 64 * q + lane); }
#pragma unroll
        for (int u = 0; u < 2; ++u) { if (t0 + u * F.NGW >= S_) break; const int t = tt[u]; float ss = 0.f;
#pragma unroll
            for (int q = 0; q < 4; ++q) { f32x4 x = v[u][q];
                x[0] += bflo(ya[u][q].x) + bflo(yb[u][q].x); x[1] += bfhi(ya[u][q].x) + bfhi(yb[u][q].x); x[2] += bflo(ya[u][q].y) + bflo(yb[u][q].y); x[3] += bfhi(ya[u][q].y) + bfhi(yb[u][q].y);
                *((GAS f32x4*)(a.out + (size_t)t * D_) + 64 * q + lane) = x; ss += (x[0] * x[0] + x[1] * x[1]) + (x[2] * x[2] + x[3] * x[3]);
                u32x2v o; o.x = cvtpk(x[0], x[1]); o.y = cvtpk(x[2], x[3]); *((GAS u32x2v*)(hb + (size_t)t * D_) + 64 * q + lane) = o; }
            ss = wave_sum(ss);
            if (lane < 16) ssq[(size_t)t * 16 + lane] = (lane == 0) ? ss : 0.f; }
    }
}
__device__ __forceinline__ void p_final(const Frame& F, const Args& a) {
    GAS unsigned char* ws = (GAS unsigned char*)a.ws; asm volatile("" : "+s"(ws)); int lane_ = F.lane; asm volatile("" : "+v"(lane_)); const int lane = lane_; const float* ssq = (const float*)(ws + WS_SSQB); const float* ln = (const float*)a.in[6];
#pragma unroll 1
    for (int t = F.gw; t < S_; t += F.NGW) { const float rs = pg8::rstd_row(ssq, t);
#pragma unroll
        for (int q = 0; q < 4; ++q) { GAS f32x4* hp = (GAS f32x4*)(a.out + (size_t)t * D_) + 64 * q + lane; const f32x4 gq = *((const GAS f32x4*)ln + 64 * q + lane); *hp = (*hp) * rs * gq; } }
}
__device__ __forceinline__ void p_moe_weights(const Frame& F, const Args& a, int L, int w0, int nw, int part) {
    LAS float* scr = (LAS float*)(F.lds + F.wave * WAVE_LDS);
    int base = 0;
#pragma unroll 1
    for (int id = 0; id < 24; ++id) { if (part >= 0 && (((id % 3) == 2) != (part == 1))) continue; const MatD m = moe_mat(a, L >> 1, id);
        int first = (w0 - base) % nw; if (first < 0) first += nw;
#pragma unroll 1
        for (int it = first; it < m.items; it += nw) xpose_item(m.W, m.ldw, m.K, m.N, m.gain, m.WT, m.ilv, scr, it, F.lane);
        base += m.items; }
}

constexpr int P_PRO = 0, P_FINAL = 81, LP_ROT = 16, LP_G1B = 17, LP_G2B = 18, LPN = 20, LP_PROJ = 0, LP_ATT = 1, LP_MIXPREP = 2, LP_GA = 3, LP_G1 = 4, LP_G2 = 5, LP_G3 = 6, LP_OUT = 7, LP_UP = 8, LP_DOWN = 9, LP_R1 = 10, LP_R2 = 11, LP_M1 = 12, LP_M2 = 13, LP_COMB = 14, LP_PLE = 15;

#ifndef PH_MASK
#define PH_MASK 0xffffffffull
#endif
#define IN(k) (lo <= (k) && (k) < hi)
#define INL(lp) ((((unsigned long long)(PH_MASK) >> (lp)) & 1) && lo <= pb + (lp) && pb + (lp) < hi)
#define SEAM() do { if (args.use_bar) xcd_barrier(bar); } while (0)
#ifndef REP_LP
#define REP_LP -1
#endif
#ifndef REP_L
#define REP_L -1
#endif
#ifndef REP_N
#define REP_N 2
#endif
#define REPS(lp) ((L == (REP_L) && (lp) == (REP_LP)) ? 1 + (REP_N) : 1)
#if REP_LP >= 0
#define REPLOOP(lp) _Pragma("unroll 1") for (int rep_ = 0; rep_ < REPS(lp); ++rep_)
#else
#define REPLOOP(lp)
#endif
#define PHASE_WS() GAS unsigned char* ws = (GAS unsigned char*)ws0; asm volatile("" : "+s"(ws)); bf16* HBF = (bf16*)(ws + WS_HBF); bf16* MIX = (bf16*)(ws + WS_MIX); bf16* PP = (bf16*)(ws + WS_PP); float* SSQA = (float*)(ws + WS_SSQA); float* SSQB = (float*)(ws + WS_SSQB); (void)HBF; (void)MIX; (void)PP; (void)SSQA; (void)SSQB
template <int L> __device__ __forceinline__ void run_layer(const Frame& F, const Args& args, unsigned char* lds, const XcdBarrier& bar, unsigned char* ws0, const int lo, const int hi, const int cid) {
        const int pb = 1 + LPN * L, j = L >> 1; const bool odd = (L & 1) != 0;
        REPLOOP(LP_PROJ) if (INL(LP_PROJ)) { PHASE_WS();
            if (!odd) {
                pg8::Gemm gm{HBF, (const bf16*)(ws + WS_WINE) + (size_t)j * EIN * D_, S_, EIN, D_, 0}; pg8::StaticOrder So; So.init(S_, EIN, F.G, cid);
                pg8::EpiBf16 E{(bf16*)(ws + WS_ARENA + AR_PE), EIN, SSQB, pg8::C2, 512};
                pg8::gemm_phase<pg8::EpiBf16, pg8::StaticOrder, true, true>(F.lds + RING_OFF, gm, So, E);
            } else {
                pg8::Gemm gm{HBF, (const bf16*)(ws + WS_WINO) + (size_t)j * OIN * D_, S_, OIN, D_, 0}; pg8::StaticOrder So; So.init(S_, OIN, F.G, cid);
                pg8::EpiBf16 E{(bf16*)(ws + WS_ARENA + AR_PO), OIN, SSQB, 1.0f, 0};
                pg8::gemm_phase<pg8::EpiBf16, pg8::StaticOrder, true, true>(F.lds + RING_OFF, gm, So, E);
            }
            {
                pg8::Gemm gm{(const bf16*)(ws + WS_PBF) + (size_t)L * S_ * PLE, (const bf16*)(ws + WS_WP) + (size_t)L * D_ * PLE, S_, D_, PLE, 0}; pg8::StaticOrder So; So.init(S_, D_, F.G, cid);
                pg8::EpiBf16 E{PP, D_, nullptr, 1.0f, 0};
                pg8::gemm_phase<pg8::EpiBf16, pg8::StaticOrder, true, true>(F.lds + RING_OFF, gm, So, E);
            }
            if (odd) p_ab(F, args, L);
            SEAM();
        }
        if (!odd) {
            REPLOOP(LP_ROT) if (INL(LP_ROT)) { PHASE_WS(); p_rot(F, args); SEAM(); }
            REPLOOP(LP_ATT) if (INL(LP_ATT)) { PHASE_WS(); attn_body::attn_phase<8>((char*)lds + RING_OFF, (const attn_body::bf16*)(ws + WS_ARENA + AR_PE), (attn_body::bf16*)(ws + WS_ARENA + AR_AO), F.vcu, F.G); SEAM(); }
            REPLOOP(LP_MIXPREP) if (INL(LP_MIXPREP)) { PHASE_WS(); p_mixprep(F, args, L); SEAM(); }
        } else {
            REPLOOP(LP_GA) if (INL(LP_GA)) { PHASE_WS();
#ifdef PROBE_GSEL
                const int gsel = args.use_bar ? 7 : PROBE_GSEL;
#else
                const int gsel = 7;
#endif
                if (gsel & 1) p_ga(F, args, L); asm volatile("s_waitcnt vmcnt(0)" ::: "memory"); __syncthreads(); if (gsel & 2) p_g1(F, args); asm volatile("s_waitcnt vmcnt(0)" ::: "memory"); __syncthreads(); if (gsel & 4) p_g1b(F, args); SEAM(); }
            REPLOOP(LP_G2) if (INL(LP_G2)) { PHASE_WS();
                const int nscan = F.G < 64 ? F.G : 64;
#ifdef PROBE_NOCONV
                if (!args.use_bar) { if (F.vcu < nscan) p_g2<64, 4>(F, args, (const bf16*)(ws + WS_ARENA + AR_MPC), (const bf16*)(ws + WS_ARENA + AR_NTC), (const float*)(ws + WS_TOK + TOK_DNC)); } else
#endif
#ifdef PROBE_NOSCAN
                if (!args.use_bar) { if (F.vcu >= nscan) p_moe_weights(F, args, L, (F.vcu - nscan) * NWAVES + F.wave, (F.G - nscan) * NWAVES, -1); } else
#endif
                if (F.vcu < nscan) p_g2<64, 4>(F, args, (const bf16*)(ws + WS_ARENA + AR_MPC), (const bf16*)(ws + WS_ARENA + AR_NTC), (const float*)(ws + WS_TOK + TOK_DNC));
                else p_moe_weights(F, args, L, (F.vcu - nscan) * NWAVES + F.wave, (F.G - nscan) * NWAVES, -1);
                if (F.G <= 64) p_moe_weights(F, args, L, F.gw, F.NGW, -1);
                SEAM();
            }
            REPLOOP(LP_G3) if (INL(LP_G3)) { PHASE_WS(); p_g23(F, args, L); SEAM(); }
        }
        REPLOOP(LP_OUT) if (INL(LP_OUT)) { PHASE_WS();
            const bf16* Wo = odd ? (const bf16*)(ws + WS_WOUTO) + (size_t)j * D_ * D_ : (const bf16*)(ws + WS_WOUTE) + (size_t)j * D_ * D_;
            pg8::Gemm gm{MIX, Wo, S_, D_, D_, 0}; pg8::StaticOrder So; So.init(S_, D_, F.G, cid);
            pg8::EpiResid E{args.out, HBF, SSQA};
            pg8::gemm_phase<pg8::EpiResid, pg8::StaticOrder, true, true>(F.lds + RING_OFF, gm, So, E);
            SEAM();
        }
        if (!odd) {
            REPLOOP(LP_UP) if (INL(LP_UP)) { PHASE_WS();
                pg8::Gemm gm{HBF, (const bf16*)(ws + WS_W13D) + (size_t)j * 2 * DFF * D_, S_, 2 * DFF, D_, 0}; pg8::StaticOrder So; So.init(S_, 2 * DFF, F.G, cid);
                pg8::EpiSwiglu E{(bf16*)(ws + WS_ARENA + AR_ACT), SSQA};
                pg8::gemm_phase<pg8::EpiSwiglu, pg8::StaticOrder, true, true>(F.lds + RING_OFF, gm, So, E);
                SEAM();
            }
            REPLOOP(LP_DOWN) if (INL(LP_DOWN)) { PHASE_WS();
                pg8::Gemm gm{(const bf16*)(ws + WS_ARENA + AR_ACT), (const bf16*)(ws + WS_W2D) + (size_t)j * D_ * DFF, S_, D_, DFF, 0}; pg8::StaticOrder So; So.init(S_, D_, F.G, cid);
                pg8::EpiResid E{args.out, HBF, SSQA};
                pg8::gemm_phase<pg8::EpiResid, pg8::StaticOrder, true, true>(F.lds + RING_OFF, gm, So, E);
                SEAM();
            }
        } else {
            REPLOOP(LP_R1) if (INL(LP_R1)) { PHASE_WS(); p_r1(F, args, L); SEAM(); }
            REPLOOP(LP_R2) if (INL(LP_R2)) { PHASE_WS(); p_r2(F, args, L); SEAM(); }
            REPLOOP(LP_M1) if (INL(LP_M1)) { PHASE_WS();
                const int nb = moe_blocks(F, args, L);
                pg8::Gemm gm{(const bf16*)(ws + WS_ARENA + AR_XS), (const bf16*)(ws + WS_W13M), nb * 256, 2 * DFF, D_, (size_t)2 * DFF * D_ * 2}; pg8::MoeOrder So; So.init(nb * 256, 2 * DFF, F.G, cid); So.blk_e = (const LAS int*)(F.lds + BLKE_OFF);
                pg8::EpiSwiglu E{(bf16*)(ws + WS_ARENA + AR_ACT), nullptr};
                pg8::gemm_phase<pg8::EpiSwiglu, pg8::MoeOrder, true, true>(F.lds + RING_OFF, gm, So, E);
                SEAM();
            }
            REPLOOP(LP_M2) if (INL(LP_M2)) { PHASE_WS();
                const int nb = moe_blocks(F, args, L);
                pg8::Gemm gm{(const bf16*)(ws + WS_ARENA + AR_ACT), (const bf16*)(ws + WS_W2M), nb * 256, D_, DFF, (size_t)D_ * DFF * 2}; pg8::MoeOrder So; So.init(nb * 256, D_, F.G, cid); So.blk_e = (const LAS int*)(F.lds + BLKE_OFF);
                pg8::EpiMoeDown E{(bf16*)(ws + WS_ARENA + AR_Y), (const float*)(ws + WS_TOK + TOK_GPAD)};
                pg8::gemm_phase<pg8::EpiMoeDown, pg8::MoeOrder, true, true>(F.lds + RING_OFF, gm, So, E);
                SEAM();
            }
            REPLOOP(LP_COMB) if (INL(LP_COMB)) { PHASE_WS(); p_combine(F, args); SEAM(); }
        }
        REPLOOP(LP_PLE) if (INL(LP_PLE)) { PHASE_WS();
            pg8::Gemm gm{HBF, (const bf16*)(ws + WS_WG) + (size_t)L * D_ * D_, S_, D_, D_, 0}; pg8::StaticOrder So; So.init(S_, D_, F.G, cid);
            pg8::EpiPle E{args.out, HBF, SSQA, SSQB, PP};
            pg8::gemm_phase<pg8::EpiPle, pg8::StaticOrder, true, true>(F.lds + RING_OFF, gm, So, E);
            SEAM();
        }
    }

__global__ void __launch_bounds__(NWAVES * 64, 2) fwd(Args args) {
    extern __shared__ __attribute__((aligned(16))) unsigned char lds[];
    Frame F;
    F.lds = (LAS unsigned char*)lds; F.tid = threadIdx.x; F.lane = F.tid & 63; F.wave = __builtin_amdgcn_readfirstlane(F.tid >> 6);
    F.G = gridDim.x; { const int bx = blockIdx.x; F.vcu = (F.G % 8 == 0) ? (bx % 8) * (F.G / 8) + bx / 8 : bx; }
    F.gw = F.vcu * NWAVES + F.wave; F.NGW = F.G * NWAVES;
    unsigned char* ws0 = args.ws;
    for (int u = F.tid; u < (LDS_BYTES - LDSCTL_OFF) / 4; u += NWAVES * 64) ((LAS unsigned*)(F.lds + LDSCTL_OFF))[u] = 0u;
    __syncthreads();
    XcdBarrier bar; bar.bar = (unsigned*)(ws0 + WS_CTL) + CW_BAR; bar.x = 0; bar.st = nullptr;
    if (args.use_bar) bar = xcd_barrier_post((unsigned*)(ws0 + WS_CTL) + CW_BAR, (volatile LAS unsigned*)(F.lds + MISC_OFF));
    const int lo = args.ph_lo, hi = args.ph_hi;
    const int cid = (int)blockIdx.x;

    if ((((unsigned long long)(PH_MASK) >> 30) & 1) && IN(P_PRO)) { p_prologue(F, args); SEAM(); }

#ifdef FIXED_L
    run_layer<FIXED_L>(F, args, lds, bar, ws0, lo, hi, cid);
#else
    run_layer<0>(F, args, lds, bar, ws0, lo, hi, cid); run_layer<1>(F, args, lds, bar, ws0, lo, hi, cid); run_layer<2>(F, args, lds, bar, ws0, lo, hi, cid); run_layer<3>(F, args, lds, bar, ws0, lo, hi, cid);
#endif
    if ((((unsigned long long)(PH_MASK) >> 31) & 1) && IN(P_FINAL)) p_final(F, args);
#undef IN
#undef INL
#undef SEAM
}


#ifndef DBG
#define DBG 0
#endif
#if DBG
#ifndef DBG_ASLOT
#define DBG_ASLOT 9
#endif
#ifndef DBG_BSLOT
#define DBG_BSLOT 11
#endif
__global__ void dbg_scan(const void* p, size_t n, int is_f32, unsigned* slot) {
    unsigned cnt = 0;
    for (size_t i = (size_t)blockIdx.x * blockDim.x + threadIdx.x; i < n; i += (size_t)gridDim.x * blockDim.x) {
        const float v = is_f32 ? ((const float*)p)[i] : __uint_as_float(((unsigned)((const unsigned short*)p)[i]) << 16);
        if (!(fabsf(v) < 1e30f)) ++cnt; }
    if (cnt) atomicAdd(slot, cnt);
}
__global__ void dbg_fill(float* out, size_t n, const unsigned* slots, int nslots) {
    int first = -1; for (int i = 0; i < nslots; ++i) if (slots[i]) { first = i; break; }
    float c, V;
    if (first >= 0) { c = sqrtf((float)(10 + first) * 1e6f); V = c; }
    else { const float ea = fmaxf(__uint_as_float(slots[256 + DBG_ASLOT]), 1e-5f), eb = fmaxf(__uint_as_float(slots[256 + DBG_BSLOT]), 1e-5f);
        c = sqrtf((10.f + fminf(60.f, rintf(10.f * (log10f(ea) + 5.f)))) * 1e4f); V = (50.f + rintf(10.f * log10f(eb))) * 1e3f; }
    for (size_t i = (size_t)blockIdx.x * blockDim.x + threadIdx.x; i < n; i += (size_t)gridDim.x * blockDim.x) out[i] = (i == 0) ? V : c;
}
__device__ __forceinline__ float dbg_bf(const unsigned short* p, size_t i) { return __uint_as_float(((unsigned)p[i]) << 16); }
__device__ __forceinline__ float dbg_rstd(const float* ssq, int row) { float s = 0.f; for (int i = 0; i < 16; ++i) s += ssq[(size_t)row * 16 + i]; return 1.0f / sqrtf(s / 1024.0f + 1e-6f); }
__device__ __forceinline__ float dbg_blocksum(float v, float* red) {
    __syncthreads(); red[threadIdx.x] = v; __syncthreads();
    for (int o = 128; o > 0; o >>= 1) { if ((int)threadIdx.x < o) red[threadIdx.x] += red[threadIdx.x + o]; __syncthreads(); }
    const float r = red[0]; __syncthreads(); return r;
}
__device__ __forceinline__ void dbg_report(unsigned* slot, float num, float den) { if (threadIdx.x == 0) atomicMax(slot, __float_as_uint(sqrtf(num / fmaxf(den, 1e-20f)))); }
__global__ void chk_ffn(const float* hpre, const float* hpost, const float* ssq, const float* ln, const float* wr, const float* w1, const float* w3, const float* w2, int moe, unsigned* slot) {
    __shared__ float xn[1024]; __shared__ float hid[3584]; __shared__ float red[256]; __shared__ float lg[8];
    const int t = (blockIdx.x * 997 + 13) % S_, tid = threadIdx.x;
    const float rs = dbg_rstd(ssq, t);
    for (int k = tid; k < 1024; k += 256) xn[k] = hpre[(size_t)t * 1024 + k] * rs * ln[k];
    __syncthreads();
    int e0 = 0, e1 = 0; float g0 = 1.f, g1 = 0.f;
    if (moe) {
        if (tid < 8) { float s = 0.f; for (int k = 0; k < 1024; ++k) s += xn[k] * wr[(size_t)k * 8 + tid]; lg[tid] = s; }
        __syncthreads();
        float l0 = lg[0]; for (int e = 1; e < 8; ++e) if (lg[e] > l0) { l0 = lg[e]; e0 = e; }
        float l1 = -1e30f; e1 = -1; for (int e = 0; e < 8; ++e) if (e != e0 && lg[e] > l1) { l1 = lg[e]; e1 = e; }
        const float m0 = expf(l0 - l0), m1 = expf(l1 - l0); g0 = m0 / (m0 + m1); g1 = m1 / (m0 + m1);
    }
    float acc[4] = {0.f, 0.f, 0.f, 0.f};
    for (int pass = 0; pass < (moe ? 2 : 1); ++pass) {
        const int e = pass == 0 ? e0 : e1; const float gt = pass == 0 ? g0 : g1;
        const float* W1 = w1 + (size_t)e * 1024 * 3584; const float* W3 = w3 + (size_t)e * 1024 * 3584; const float* W2 = w2 + (size_t)e * 3584 * 1024;
        __syncthreads();
        for (int f = tid; f < 3584; f += 256) { float a = 0.f, b = 0.f; for (int k = 0; k < 1024; ++k) { a += xn[k] * W1[(size_t)k * 3584 + f]; b += xn[k] * W3[(size_t)k * 3584 + f]; } hid[f] = a / (1.f + expf(-a)) * b; }
        __syncthreads();
        for (int q = 0; q < 4; ++q) { const int c = tid + 256 * q; float y = 0.f; for (int f = 0; f < 3584; ++f) y += hid[f] * W2[(size_t)f * 1024 + c]; acc[q] += gt * y; }
    }
    float num = 0.f, den = 0.f;
    for (int q = 0; q < 4; ++q) { const int c = tid + 256 * q; const float ex = acc[q], got = hpost[(size_t)t * 1024 + c] - hpre[(size_t)t * 1024 + c]; num += (got - ex) * (got - ex); den += ex * ex; }
    num = dbg_blocksum(num, red); den = dbg_blocksum(den, red);
    dbg_report(slot, num, den);
}
__global__ void chk_ple(const float* hpre, const float* hpost, const float* ssq, const float* ln, const float* wg, const float* p, const float* wp, unsigned* slot) {
    __shared__ float xn[1024]; __shared__ float red[256];
    const int t = (blockIdx.x * 997 + 13) % S_, tid = threadIdx.x; const float rs = dbg_rstd(ssq, t);
    for (int k = tid; k < 1024; k += 256) xn[k] = hpre[(size_t)t * 1024 + k] * rs * ln[k];
    __syncthreads();
    float num = 0.f, den = 0.f;
    for (int q = 0; q < 4; ++q) { const int c = tid + 256 * q; float a = 0.f, b = 0.f; for (int k = 0; k < 1024; ++k) a += xn[k] * wg[(size_t)k * 1024 + c]; for (int k = 0; k < 256; ++k) b += p[(size_t)t * 256 + k] * wp[(size_t)k * 1024 + c];
        const float ex = b / (1.f + expf(-a)), got = hpost[(size_t)t * 1024 + c] - hpre[(size_t)t * 1024 + c]; num += (got - ex) * (got - ex); den += ex * ex; }
    num = dbg_blocksum(num, red); den = dbg_blocksum(den, red); dbg_report(slot, num, den);
}
constexpr int DBG_TC = 512;
__global__ void chk_gdn_proj(const float* h, const float* ssq, const float* ln, const float* W, int hh, float* raw) {
    const int idx = blockIdx.x * blockDim.x + threadIdx.x; if (idx >= DBG_TC * 514) return;
    const int t = idx / 514, c = idx % 514;
    const int col = c < 128 ? hh * 128 + c : c < 256 ? 1024 + hh * 128 + (c - 128) : c < 384 ? 2048 + hh * 128 + (c - 256) : c < 512 ? 3072 + hh * 128 + (c - 384) : c == 512 ? 4096 + hh : 4104 + hh;
    const float rs = dbg_rstd(ssq, t); float s = 0.f;
    for (int k = 0; k < 1024; ++k) s += h[(size_t)t * 1024 + k] * ln[k] * W[(size_t)k * OIN_SRC + col];
    raw[(size_t)t * 514 + c] = s * rs;
}
__global__ void chk_gdn_rec(const float* raw, const float* cw, const float* alog, const float* dtb, const float* onorm, int hh, const unsigned short* mix, unsigned* slot) {
    extern __shared__ float sm[];
    float* Sm = sm; float* q = sm + 128 * 129; float* kk = q + 128; float* v = kk + 128; float* kv = v + 128; float* dl = kv + 128; float* o = dl + 128; float* red = o + 128;
    const int tid = threadIdx.x;
    for (int i = tid; i < 128 * 129; i += 256) Sm[i] = 0.f;
    __syncthreads();
    float worst = 0.f;
    for (int t = 0; t < DBG_TC; ++t) {
        if (tid < 128) { const int d = tid; float aq = 0.f, ak = 0.f, av = 0.f;
            for (int jj = 0; jj < 4; ++jj) { const int r = t - 3 + jj; if (r >= 0) { aq += cw[jj * 3072 + hh * 128 + d] * raw[(size_t)r * 514 + d]; ak += cw[jj * 3072 + 1024 + hh * 128 + d] * raw[(size_t)r * 514 + 128 + d]; av += cw[jj * 3072 + 2048 + hh * 128 + d] * raw[(size_t)r * 514 + 256 + d]; } }
            q[d] = aq / (1.f + expf(-aq)); kk[d] = ak / (1.f + expf(-ak)); v[d] = av / (1.f + expf(-av)); }
        __syncthreads();
        const float sq = dbg_blocksum(tid < 128 ? q[tid] * q[tid] : 0.f, red), sk = dbg_blocksum(tid < 128 ? kk[tid] * kk[tid] : 0.f, red);
        if (tid < 128) { q[tid] *= 1.0f / sqrtf(sq + 1e-6f) * 0.08838834764831845f; kk[tid] *= 1.0f / sqrtf(sk + 1e-6f); }
        const float bb = raw[(size_t)t * 514 + 512], aa = raw[(size_t)t * 514 + 513];
        const float beta = 1.f / (1.f + expf(-bb)); const float z = aa + dtb[hh]; const float g = -expf(alog[hh]) * (z > 20.f ? z : log1pf(expf(z))); const float alpha = expf(g);
        __syncthreads();
        for (int i = tid; i < 128 * 128; i += 256) { const int d = i >> 7, j = i & 127; Sm[d * 129 + j] *= alpha; }
        __syncthreads();
        if (tid < 128) { float s = 0.f; for (int d = 0; d < 128; ++d) s += kk[d] * Sm[d * 129 + tid]; dl[tid] = beta * (v[tid] - s); }
        __syncthreads();
        for (int i = tid; i < 128 * 128; i += 256) { const int d = i >> 7, j = i & 127; Sm[d * 129 + j] += kk[d] * dl[j]; }
        __syncthreads();
        if (tid < 128) { float s = 0.f; for (int d = 0; d < 128; ++d) s += q[d] * Sm[d * 129 + tid]; o[tid] = s; }
        __syncthreads();
        const float so = dbg_blocksum(tid < 128 ? o[tid] * o[tid] : 0.f, red); const float rms = 1.0f / sqrtf(so / 128.f + 1e-6f);
        float num = 0.f, den = 0.f;
        if (tid < 128) { const float zz = raw[(size_t)t * 514 + 384 + tid]; const float ex = o[tid] * rms * onorm[tid] * (zz / (1.f + expf(-zz))); const float got = dbg_bf(mix, (size_t)t * 1024 + hh * 128 + tid); num = (got - ex) * (got - ex); den = ex * ex; }
        num = dbg_blocksum(num, red); den = dbg_blocksum(den, red);
        worst = fmaxf(worst, sqrtf(num / fmaxf(den, 1e-20f)));
    }
    if (tid == 0) atomicMax(slot, __float_as_uint(worst));
}

__global__ void chk_even_kv(const float* h, const float* ssq, const float* ln, const float* W, float* KV) {
    const size_t idx = (size_t)blockIdx.x * blockDim.x + threadIdx.x; if (idx >= (size_t)S_ * 1024) return;
    const int t = (int)(idx >> 10), c = (int)(idx & 1023); const float rs = dbg_rstd(ssq, t); float s = 0.f;
    for (int k = 0; k < 1024; ++k) s += h[(size_t)t * 1024 + k] * ln[k] * W[(size_t)k * EIN + 512 + c];
    KV[idx] = s * rs;
}
__global__ void chk_even_mix(const float* h, const float* ssq, const float* ln, const float* W, const float* KV, const int* pos, const float* lq1, const float* lk1, const float* lq2, const float* lk2, const float* subg, const float* cw,
                             float lam0, const unsigned short* PE, const unsigned short* AO, const unsigned short* MIXb, unsigned* slot) {
    __shared__ float q[2][64]; __shared__ float p[128]; __shared__ float red[256]; __shared__ float o2[2][128]; __shared__ float hn[1024];
    const int toks[6] = {5, 200, 1000, 4097, 9000, 16383};
    const int t = toks[blockIdx.x / 4], hh = blockIdx.x % 4, tid = threadIdx.x;
    auto bsum = [&](float v) { __syncthreads(); red[tid] = v; __syncthreads(); for (int o = 64; o > 0; o >>= 1) { if (tid < o) red[tid] += red[tid + o]; __syncthreads(); } const float r = red[0]; __syncthreads(); return r; };
    auto bmax = [&](float v) { __syncthreads(); red[tid] = v; __syncthreads(); for (int o = 64; o > 0; o >>= 1) { if (tid < o) red[tid] = fmaxf(red[tid], red[tid + o]); __syncthreads(); } const float r = red[0]; __syncthreads(); return r; };
    auto invf = [&](int i) { return exp2f(-(float)i * (18.931568569324174f / 8.0f)); };
    const float rs = dbg_rstd(ssq, t);
    for (int k = tid; k < 1024; k += 128) hn[k] = h[(size_t)t * 1024 + k] * rs * ln[k];
    __syncthreads();
    { const int m = tid >> 6, d = tid & 63, col = (2 * hh + m) * 64 + d; float s = 0.f; for (int k = 0; k < 1024; ++k) s += hn[k] * W[(size_t)k * EIN + col]; q[m][d] = s; }
    __syncthreads();
    float qr;
    { const int m = tid >> 6, d = tid & 63; float v = q[m][d];
      if (d < 16) { const int i = d & 7; const float ang = (float)pos[t] * invf(i); const float c = cosf(ang), s = sinf(ang); v = d < 8 ? q[m][d] * c - q[m][d + 8] * s : q[m][d] * c + q[m][d - 8] * s; }
      qr = v * pg8::C2; }
    __syncthreads(); q[tid >> 6][tid & 63] = qr; __syncthreads();
    float num = 0.f, den = 0.f;
    { const int m = tid >> 6, d = tid & 63; const float got = dbg_bf(PE, (size_t)t * EIN + (2 * hh + m) * 64 + d); const float e2 = (got - qr) * (got - qr), r2 = qr * qr; num += e2; den += r2;
      const float na = bsum(d >= 16 ? e2 : 0.f), da = bsum(d >= 16 ? r2 : 0.f), nb = bsum(d < 16 ? e2 : 0.f), db = bsum(d < 16 ? r2 : 0.f);
      if (tid == 0) { atomicMax(slot + 4, __float_as_uint(sqrtf(na / fmaxf(da, 1e-20f)))); atomicMax(slot + 5, __float_as_uint(sqrtf(nb / fmaxf(db, 1e-20f)))); } }
    { const int m = tid >> 6, d = tid & 63; const float* kr = KV + (size_t)t * 1024 + (2 * hh + m) * 64; float v = kr[d];
      if (d < 16) { const int i = d & 7; const float ang = (float)pos[t] * invf(i); const float c = cosf(ang), s = sinf(ang); v = d < 8 ? kr[d] * c - kr[d + 8] * s : kr[d] * c + kr[d - 8] * s; }
      const float got = dbg_bf(PE, (size_t)t * EIN + 512 + (2 * hh + m) * 64 + d); const float e2 = (got - v) * (got - v), r2 = v * v; num += e2; den += r2;
      const float na = bsum(d >= 16 ? e2 : 0.f), da = bsum(d >= 16 ? r2 : 0.f), nb = bsum(d < 16 ? e2 : 0.f), db = bsum(d < 16 ? r2 : 0.f);
      const float vv = KV[(size_t)t * 1024 + 512 + hh * 128 + tid], gv = dbg_bf(PE, (size_t)t * EIN + 1024 + hh * 128 + tid); const float e3 = (gv - vv) * (gv - vv), r3 = vv * vv; num += e3; den += r3;
      const float nc = bsum(e3), dc = bsum(r3);
      if (tid == 0) { atomicMax(slot + 6, __float_as_uint(sqrtf(na / fmaxf(da, 1e-20f)))); atomicMax(slot + 7, __float_as_uint(sqrtf(nb / fmaxf(db, 1e-20f)))); atomicMax(slot + 8, __float_as_uint(sqrtf(nc / fmaxf(dc, 1e-20f)))); } }
    num = bsum(num); den = bsum(den); if (tid == 0) atomicMax(slot + 0, __float_as_uint(sqrtf(num / fmaxf(den, 1e-20f))));
    for (int m = 0; m < 2; ++m) {
        float mx = -1e30f;
        for (int j0 = 0; j0 <= t; j0 += 128) { const int j = j0 + tid; float s = -1e30f;
            if (j <= t) { const float* kr = KV + (size_t)j * 1024 + (2 * hh + m) * 64; s = 0.f;
                for (int d = 0; d < 64; ++d) { float kv = kr[d]; if (d < 16) { const int i = d & 7; const float ang = (float)pos[j] * invf(i); const float c = cosf(ang), sn = sinf(ang); kv = d < 8 ? kr[d] * c - kr[d + 8] * sn : kr[d] * c + kr[d - 8] * sn; } s += q[m][d] * kv; } }
            mx = fmaxf(mx, s); }
        mx = bmax(mx);
        float l = 0.f, acc = 0.f;
        for (int j0 = 0; j0 <= t; j0 += 128) { const int j = j0 + tid; float pe = 0.f;
            if (j <= t) { const float* kr = KV + (size_t)j * 1024 + (2 * hh + m) * 64; float s = 0.f;
                for (int d = 0; d < 64; ++d) { float kv = kr[d]; if (d < 16) { const int i = d & 7; const float ang = (float)pos[j] * invf(i); const float c = cosf(ang), sn = sinf(ang); kv = d < 8 ? kr[d] * c - kr[d + 8] * sn : kr[d] * c + kr[d - 8] * sn; } s += q[m][d] * kv; }
                pe = exp2f(s - mx); }
            __syncthreads(); p[tid] = pe; __syncthreads();
            l += pe;
            const int nj = min(128, t + 1 - j0);
            for (int i = 0; i < nj; ++i) acc += p[i] * KV[(size_t)(j0 + i) * 1024 + 512 + hh * 128 + tid]; }
        l = bsum(l);
        o2[m][tid] = acc / l;
    }
    __syncthreads();
    { float n2 = 0.f, d2 = 0.f;
      for (int m = 0; m < 2; ++m) { const float ex = o2[m][tid], got = dbg_bf(AO, (size_t)t * 1024 + hh * 256 + m * 128 + tid); n2 += (got - ex) * (got - ex); d2 += ex * ex; }
      n2 = bsum(n2); d2 = bsum(d2); if (tid == 0) atomicMax(slot + 1, __float_as_uint(sqrtf(n2 / fmaxf(d2, 1e-20f)))); }
    float s1 = 0.f, s2 = 0.f; for (int i = 0; i < 64; ++i) { s1 += lq1[i] * lk1[i]; s2 += lq2[i] * lk2[i]; }
    const float lam = expf(s1) - expf(s2) + lam0;
    const float dv = o2[0][tid] - lam * o2[1][tid]; const float ssd = bsum(dv * dv); const float ex = dv / sqrtf(ssd / 128.f + 1e-5f) * subg[tid] * (1.f - lam0);
    { const float got = dbg_bf(MIXb, (size_t)t * 1024 + hh * 128 + tid); float n2 = (got - ex) * (got - ex), d2 = ex * ex; n2 = bsum(n2); d2 = bsum(d2); if (tid == 0) atomicMax(slot + 2, __float_as_uint(sqrtf(n2 / fmaxf(d2, 1e-20f)))); }
    { const int ch = hh * 128 + tid; float cx[3] = {0.f, 0.f, 0.f}, bg = 0.f;
      for (int jj = 0; jj < 3; ++jj) { const int r = t - 2 + jj; if (r < 0) continue; const float rr = dbg_rstd(ssq, r); float c = 0.f, x = 0.f, b = 0.f;
          for (int k = 0; k < 1024; ++k) { const float hv = h[(size_t)r * 1024 + k] * ln[k]; c += hv * W[(size_t)k * EIN + 2048 + ch]; x += hv * W[(size_t)k * EIN + 2560 + ch]; if (jj == 2) b += hv * W[(size_t)k * EIN + 1536 + ch]; }
          cx[jj] = (c * rr) * (x * rr); if (jj == 2) bg = b * rr; }
      const float ex2 = bg * (cw[0 * 512 + ch] * cx[0] + cw[1 * 512 + ch] * cx[1] + cw[2 * 512 + ch] * cx[2]); const float got = dbg_bf(MIXb, (size_t)t * 1024 + 512 + ch);
      float n2 = (got - ex2) * (got - ex2), d2 = ex2 * ex2; n2 = bsum(n2); d2 = bsum(d2); if (tid == 0) atomicMax(slot + 3, __float_as_uint(sqrtf(n2 / fmaxf(d2, 1e-20f)))); }
}
static void dbg_before_phase(int ph, unsigned char* ws, float* out, hipStream_t st) {
    if (ph == P_PRO || ph == P_FINAL) return;
    const int lp = (ph - 1) % LPN;
    if (lp == LP_UP || lp == LP_R1 || lp == LP_PLE) { (void)hipMemcpyAsync(ws + WS_ARENA + 400 * MiB, out, (size_t)S_ * D_ * 4, hipMemcpyDeviceToDevice, st); (void)hipMemcpyAsync(ws + WS_ARENA + 464 * MiB, ws + WS_SSQA, (size_t)S_ * 16 * 4, hipMemcpyDeviceToDevice, st); }
}
static void dbg_checks(int ph, void* const* d_in, unsigned char* ws, float* out, hipStream_t st) {
    if (ph == P_PRO || ph == P_FINAL) return;
    unsigned* slots = (unsigned*)(ws + WS_CTL) + CW_DBG; const int L = (ph - 1) / LPN, lp = (ph - 1) % LPN, j = L >> 1; const bool odd = L & 1;
    const float* snap = (const float*)(ws + WS_ARENA + 400 * MiB);
    if (lp == LP_DOWN && L == 0) hipLaunchKernelGGL(chk_ffn, dim3(24), dim3(256), 0, st, snap, (const float*)out, (const float*)(ws + WS_ARENA + 464 * MiB), (const float*)d_in[4] + L * D_, (const float*)nullptr,
        (const float*)d_in[21] + (size_t)j * D_ * DFF, (const float*)d_in[22] + (size_t)j * D_ * DFF, (const float*)d_in[23] + (size_t)j * D_ * DFF, 0, slots + 256 + 0);
    if (lp == LP_PLE && L == 0) hipLaunchKernelGGL(chk_ple, dim3(24), dim3(256), 0, st, snap, (const float*)out, (const float*)(ws + WS_ARENA + 464 * MiB), (const float*)d_in[5] + L * D_, (const float*)d_in[28] + (size_t)L * D_ * D_,
        (const float*)d_in[1] + (size_t)L * S_ * PLE, (const float*)d_in[29] + (size_t)L * PLE * D_, slots + 256 + 1);
    if (lp == LP_G3 && L == 1) { float* raw = (float*)(ws + WS_ARENA + 400 * MiB);
        hipLaunchKernelGGL(chk_gdn_proj, dim3((DBG_TC * 514 + 255) / 256), dim3(256), 0, st, (const float*)out, (const float*)(ws + WS_SSQB), (const float*)d_in[3] + L * D_, (const float*)d_in[15] + (size_t)j * D_ * OIN_SRC, 3, raw);
        hipLaunchKernelGGL(chk_gdn_rec, dim3(1), dim3(256), (128 * 129 + 6 * 128 + 256) * 4, st, (const float*)raw, (const float*)d_in[16] + (size_t)j * 4 * 3072, (const float*)d_in[17] + j * 8, (const float*)d_in[18] + j * 8, (const float*)d_in[19] + j * 128, 3, (const unsigned short*)(ws + WS_MIX), slots + 256 + 2); }
    if (lp == LP_COMB && L == 1) hipLaunchKernelGGL(chk_ffn, dim3(24), dim3(256), 0, st, snap, (const float*)out, (const float*)(ws + WS_ARENA + 464 * MiB), (const float*)d_in[4] + L * D_, (const float*)d_in[24] + (size_t)j * D_ * NEXP,
        (const float*)d_in[25] + (size_t)j * NEXP * D_ * DFF, (const float*)d_in[26] + (size_t)j * NEXP * D_ * DFF, (const float*)d_in[27] + (size_t)j * NEXP * DFF * D_, 1, slots + 256 + 3);
    if (lp == LP_MIXPREP && L == 0) { float* KV = (float*)(ws + WS_ARENA + 400 * MiB);
        hipLaunchKernelGGL(chk_even_kv, dim3((S_ * 1024) / 256), dim3(256), 0, st, (const float*)out, (const float*)(ws + WS_SSQB), (const float*)d_in[3] + L * D_, (const float*)d_in[7] + (size_t)j * D_ * EIN, KV);
        hipLaunchKernelGGL(chk_even_mix, dim3(24), dim3(128), 0, st, (const float*)out, (const float*)(ws + WS_SSQB), (const float*)d_in[3] + L * D_, (const float*)d_in[7] + (size_t)j * D_ * EIN, (const float*)KV, (const int*)d_in[2],
            (const float*)d_in[9] + j * 64, (const float*)d_in[10] + j * 64, (const float*)d_in[11] + j * 64, (const float*)d_in[12] + j * 64, (const float*)d_in[13] + j * 128, (const float*)d_in[14] + (size_t)j * 3 * 512,
            0.8f - 0.6f * expf(-0.3f * (float)L), (const unsigned short*)(ws + WS_ARENA + AR_PE), (const unsigned short*)(ws + WS_ARENA + AR_AO), (const unsigned short*)(ws + WS_MIX), slots + 256 + 4); }
    (void)odd;
}
static void dbg_after_phase(int ph, unsigned char* ws, float* out, hipStream_t st) {
    unsigned* slots = (unsigned*)(ws + WS_CTL) + CW_DBG; unsigned* sl = slots + ph;
    auto scan = [&](const void* p, size_t n, int f32) { hipLaunchKernelGGL(dbg_scan, dim3(1024), dim3(256), 0, st, p, n, f32, sl); };
    const size_t SD = (size_t)S_ * D_; unsigned char* ar = ws + WS_ARENA;
    if (ph == P_PRO) { scan(ws + WS_HBF, SD, 0); scan(out, SD, 1); scan(ws + WS_PBF, (size_t)4 * S_ * PLE, 0); scan(ws + WS_TAB, (size_t)S_ * 16, 1); scan(ws + WS_W, (size_t)44 * MiB, 0); return; }
    if (ph == P_FINAL) return;
    const int L = (ph - 1) / LPN, lp = (ph - 1) % LPN; const bool odd = L & 1;
    switch (lp) {
    case LP_PROJ: if (!odd) scan(ar + AR_PE, (size_t)S_ * EIN, 0); else { scan(ar + AR_PO, (size_t)S_ * OIN, 0); scan(ws + WS_GB, (size_t)S_ * 16, 1); } scan(ws + WS_PP, SD, 0); break;
    case LP_ROT: scan(ar + AR_PE, (size_t)S_ * EIN, 0); break;
    case LP_ATT: scan(ar + AR_AO, SD, 0); break;
    case LP_MIXPREP: case LP_G3: scan(ws + WS_MIX, SD, 0); break;
    case LP_GA: scan(ar + AR_QN, SD * 6, 0); scan(ws + WS_GB, (size_t)S_ * 16, 1); break;
    case LP_G1: scan(ar + AR_AI, (size_t)NUNIT * 4096, 0); scan(ar + AR_NEGW, SD, 0); scan(ar + AR_UT, SD, 0); scan(ar + AR_MP, (size_t)NUNIT * 16384 * 2, 0); break;
    case LP_G2: scan(ar + AR_SG, (size_t)NUNIT * 16384, 0); break;
    case LP_OUT: case LP_DOWN: case LP_COMB: case LP_PLE: scan(out, SD, 1); scan(ws + WS_HBF, SD, 0); scan(ws + ((lp == LP_PLE) ? WS_SSQB : WS_SSQA), (size_t)S_ * 16, 1); break;
    case LP_UP: scan(ar + AR_ACT, (size_t)S_ * DFF, 0); break;
    case LP_R1: scan(ws + WS_TOK + TOK_G, (size_t)S_ * 2, 1); break;
    default: break; }
}
#endif
#ifndef MK_MULTI
#define MK_MULTI 0
#endif
extern "C" void kernel_launch(void* const* d_in, const int* in_sizes, int n_in, void* d_out, int out_size, void* d_ws, size_t ws_size, hipStream_t stream) {
    static int grid = 0;
    if (grid == 0) {
        if (n_in != 30 || out_size != S_ * D_ || ws_size < WS_NEED) { fprintf(stderr, "kernel_launch: unexpected problem (n_in %d, out %d, ws %zu < %zu)\n", n_in, out_size, ws_size, (size_t)WS_NEED); grid = -1; return; }
        int dev = 0, cus = 0, per_cu = 0;
        if (hipGetDevice(&dev) != hipSuccess || hipDeviceGetAttribute(&cus, hipDeviceAttributeMultiprocessorCount, dev) != hipSuccess) { grid = -1; return; }
        if (hipFuncSetAttribute((const void*)fwd, hipFuncAttributeMaxDynamicSharedMemorySize, LDS_BYTES) != hipSuccess) { fprintf(stderr, "kernel_launch: hipFuncSetAttribute failed\n"); grid = -1; return; }
        if (hipOccupancyMaxActiveBlocksPerMultiprocessor(&per_cu, (const void*)fwd, NWAVES * 64, LDS_BYTES) != hipSuccess || per_cu < 1) { fprintf(stderr, "kernel_launch: occupancy query says %d\n", per_cu); }
        (void)hipGetLastError();
        grid = cus;
#if DBG
        (void)hipFuncSetAttribute((const void*)chk_gdn_rec, hipFuncAttributeMaxDynamicSharedMemorySize, 72 * 1024);
#endif
    }
    if (grid < 0) return;
    (void)hipMemsetAsync((char*)d_ws + WS_CTL, 0, CTL_ZERO_BYTES, stream);
    Args a{};
    for (int i = 0; i < 30; ++i) a.in[i] = d_in[i];
    a.out = (float*)d_out; a.ws = (unsigned char*)d_ws; a.pad = 0;
#if MK_MULTI
    a.use_bar = 0;
    static const int seq_even[] = {LP_PROJ, LP_ROT, LP_ATT, LP_MIXPREP, LP_OUT, LP_UP, LP_DOWN, LP_PLE};
    static const int seq_odd[] = {LP_PROJ, LP_GA, LP_G2, LP_G3, LP_OUT, LP_R1, LP_R2, LP_M1, LP_M2, LP_COMB, LP_PLE};
    int plist[64], np = 0; plist[np++] = P_PRO;
    for (int L = 0; L < DEPTH_; ++L) { const bool odd = L & 1; const int n = odd ? 11 : 8; for (int q = 0; q < n; ++q) plist[np++] = 1 + LPN * L + (odd ? seq_odd[q] : seq_even[q]); }
    plist[np++] = P_FINAL;
    for (int pi = 0; pi < np; ++pi) { const int ph = plist[pi];
        a.ph_lo = ph; a.ph_hi = ph + 1;
#if DBG
        dbg_before_phase(ph, (unsigned char*)d_ws, (float*)d_out, stream);
#endif
        hipLaunchKernelGGL(fwd, dim3(grid), dim3(NWAVES * 64), LDS_BYTES, stream, a);
#if DBG
        dbg_after_phase(ph, (unsigned char*)d_ws, (float*)d_out, stream); dbg_checks(ph, d_in, (unsigned char*)d_ws, (float*)d_out, stream);
#endif
    }
#if DBG
    hipLaunchKernelGGL(dbg_fill, dim3(1024), dim3(256), 0, stream, (float*)d_out, (size_t)S_ * D_, (const unsigned*)((unsigned char*)d_ws + WS_CTL) + CW_DBG, P_FINAL + 1);
#endif
#else
    a.use_bar = 1; a.ph_lo = 0; a.ph_hi = P_FINAL + 1;
    hipLaunchKernelGGL(fwd, dim3(grid), dim3(NWAVES * 64), LDS_BYTES, stream, a);
#ifdef PROBE_PH
    for (int i = 0; i < PROBE_N; ++i) { a.use_bar = 0; a.ph_lo = PROBE_PH; a.ph_hi = PROBE_PH + 1; hipLaunchKernelGGL(fwd, dim3(grid), dim3(NWAVES * 64), LDS_BYTES, stream, a); }
#endif
#endif
    const hipError_t le = hipPeekAtLastError();
    if (le != hipSuccess) fprintf(stderr, "kernel_launch: launch failed: %s\n", hipGetErrorName(le));
}
```

```cpp
#include <hip/hip_runtime.h>
#include <hip/hip_bf16.h>
#include <cstdio>
#include <cstdint>
#include <cmath>

constexpr int S_ = 16384, D_ = 1024, DEPTH_ = 4;
constexpr int EIN = 3072, OIN = 4352  , OIN_W = 4096, OIN_SRC = 4112, DFF = 3584, NEXP = 8, PLE = 256;
constexpr int MOE_P = 2 * S_ + NEXP * 256;
constexpr int NCHUNK = S_ / 64, NUNIT = NCHUNK * 8;
constexpr float RMS_EPS = 1e-6f;

namespace pg8 {
#define PG8_LAS __attribute__((address_space(3)))
typedef unsigned short bf16_t;
typedef short bf16x8 __attribute__((ext_vector_type(8)));
typedef float f32x4 __attribute__((ext_vector_type(4)));
typedef float f32x2 __attribute__((ext_vector_type(2)));
typedef unsigned u32x4 __attribute__((ext_vector_type(4)));
typedef unsigned u32x2 __attribute__((ext_vector_type(2)));
constexpr int BM = 256, BK = 64, HALF = 128, HTB = HALF * BK * 2, STAGE_BYTES = 8 * HTB, NXCD = 8, WGM = 8;

__host__ __device__ __forceinline__ int lds_byte(int r, int c) { const int st = (r >> 4) * 2 + (c >> 5), rr = r & 15, cc = c & 31, ob = rr * 64 + cc * 2; return st * 1024 + (ob ^ (((ob >> 9) & 1) << 5)); }
__host__ __device__ __forceinline__ void stage_rc(int b, int& R, int& C) { const int st = b / 1024, sb = b % 1024, swz = sb ^ (((sb >> 9) & 1) << 5); R = (st >> 1) * 16 + swz / 64; C = (st & 1) * 32 + (swz % 64) / 2; }
__host__ __device__ __forceinline__ int perm32(int rho) { const int n = rho >> 4, i = rho & 15; return 8 * (i >> 2) + 4 * n + (i & 3); }

struct Unit { int pm, pn, be; };
struct Gemm { const bf16_t* A; const bf16_t* Bt; int M, N, K; size_t bstride; };

struct StaticOrder {
    int nM, nN, nwg, G, c;
    __host__ __device__ void init(int M, int N, int G_, int c_) { nM = M / BM; nN = N / BM; nwg = nM * nN; G = G_; c = c_; }
    __host__ __device__ bool next(int i, Unit& u) const {
        const long L = (long)i * G + c; if (L >= nwg) return false;
        int wgid = (int)L; { const int q = nwg / NXCD, r = nwg % NXCD, xcd = wgid % NXCD, off = wgid / NXCD; wgid = (xcd < r ? xcd * (q + 1) : r * (q + 1) + (xcd - r) * q) + off; }
        const int nig = WGM * nN, gid = wgid / nig, fm = gid * WGM, gsz = (nM - fm) < WGM ? (nM - fm) : WGM;
        u.pm = fm + ((wgid % nig) % gsz); u.pn = (wgid % nig) / gsz; u.be = 0; return true;
    }
    __device__ __forceinline__ void a_ready(const Unit&) const {}
    __device__ __forceinline__ void done(const Unit&) const {}
};
struct MoeOrder : StaticOrder {
    const PG8_LAS int* blk_e;
    __device__ __forceinline__ bool next(int i, Unit& u) const { if (!StaticOrder::next(i, u)) return false; u.be = blk_e[u.pm]; return true; }
};

__device__ __forceinline__ unsigned cvt_pk_bf16(float lo, float hi) { unsigned r; asm volatile("v_cvt_pk_bf16_f32 %0, %1, %2" : "=v"(r) : "v"(lo), "v"(hi)); return r; }
typedef __bf16 bf16x2_t_ __attribute__((ext_vector_type(2)));
__device__ __forceinline__ unsigned cvt_pk_bf16_cv(float lo, float hi) { const f32x2 v = {lo, hi}; const bf16x2_t_ b = __builtin_convertvector(v, bf16x2_t_); return __builtin_bit_cast(unsigned, b); }
__device__ __forceinline__ float bf_lo(unsigned w) { return __uint_as_float(w << 16); }
__device__ __forceinline__ float bf_hi(unsigned w) { return __uint_as_float(w & 0xffff0000u); }

__device__ __forceinline__ float rstd_row(const float* ssq, int row) {
    const f32x4* p = (const f32x4*)(ssq + (size_t)row * 16);
    const f32x4 a = p[0], b = p[1], c = p[2], d = p[3];
    const float s = (((a[0] + a[1]) + (a[2] + a[3])) + ((b[0] + b[1]) + (b[2] + b[3]))) + (((c[0] + c[1]) + (c[2] + c[3])) + ((d[0] + d[1]) + (d[2] + d[3])));
    return __builtin_amdgcn_rsqf(s * (1.0f / 1024.0f) + RMS_EPS);
}
__device__ __forceinline__ float sigmoidf_(float x) { return __builtin_amdgcn_rcpf(1.0f + __builtin_amdgcn_exp2f(-1.4426950408889634f * x)); }
__device__ __forceinline__ float siluf_(float x) { return x * sigmoidf_(x); }

constexpr float C2 = 0.125f * 1.4426950408889634f;

struct EpiProjEven {
    static constexpr bool PERM = true, AFTER_DRAIN = false;
    bf16_t* O; const float* ssq; const float* tab;
    __device__ __forceinline__ void operator()(const f32x4 (&acc)[2][2][4][2], const Unit& u, int wr, int wc, int fr, int fq) const {
        const int row0 = u.pm * BM + wr * 64 + fr, colt = u.pn * BM;
        const bool rot = (colt < 1024) && ((wc & 1) == 0);
        const float qs = (colt < 512) ? C2 : 1.0f;
#pragma unroll
        for (int ai = 0; ai < 2; ++ai)
#pragma unroll
            for (int m = 0; m < 4; ++m) {
                const int row = row0 + ai * HALF + m * 16; const float rs = rstd_row(ssq, row);
                f32x4 c0 = {1.f, 1.f, 1.f, 1.f}, c1 = c0, s0 = {0.f, 0.f, 0.f, 0.f}, s1 = s0;
                if (rot && fq < 2) { const f32x4* t = (const f32x4*)(tab + (size_t)row * 16); c0 = t[0]; c1 = t[1]; s0 = t[2]; s1 = t[3]; if (fq == 0) { s0 = -s0; s1 = -s1; } }
#pragma unroll
                for (int bj = 0; bj < 2; ++bj) {
                    f32x4 v0 = acc[ai][bj][m][0] * rs, v1 = acc[ai][bj][m][1] * rs;
                    if (rot) {
                        f32x4 p0, p1;
#pragma unroll
                        for (int i = 0; i < 4; ++i) { p0[i] = __shfl_xor(v0[i], 16); p1[i] = __shfl_xor(v1[i], 16); }
                        v0 = v0 * c0 + p0 * s0; v1 = v1 * c1 + p1 * s1;
                    }
                    v0 = v0 * qs; v1 = v1 * qs;
                    u32x4 w; w.x = cvt_pk_bf16(v0[0], v0[1]); w.y = cvt_pk_bf16(v0[2], v0[3]); w.z = cvt_pk_bf16(v1[0], v1[1]); w.w = cvt_pk_bf16(v1[2], v1[3]);
                    *(u32x4*)(O + (size_t)row * EIN + colt + bj * HALF + wc * 32 + 8 * fq) = w;
                }
                asm volatile("" ::: "memory");
            }
    }
};
struct EpiBf16 {
    static constexpr bool PERM = true, AFTER_DRAIN = false;
    bf16_t* O; int ldc; const float* ssq; float scale0; int scale_cols;
    __device__ __forceinline__ void operator()(const f32x4 (&acc)[2][2][4][2], const Unit& u, int wr, int wc, int fr, int fq) const {
        const int row0 = u.pm * BM + wr * 64 + fr, colt = u.pn * BM;
#pragma unroll
        for (int ai = 0; ai < 2; ++ai)
#pragma unroll
            for (int m = 0; m < 4; ++m) {
                const int row = row0 + ai * HALF + m * 16; const float rs = (ssq ? rstd_row(ssq, row) : 1.0f) * (colt < scale_cols ? scale0 : 1.0f);
#pragma unroll
                for (int bj = 0; bj < 2; ++bj) {
                    const f32x4 v0 = acc[ai][bj][m][0] * rs, v1 = acc[ai][bj][m][1] * rs;
                    u32x4 w; w.x = cvt_pk_bf16(v0[0], v0[1]); w.y = cvt_pk_bf16(v0[2], v0[3]); w.z = cvt_pk_bf16(v1[0], v1[1]); w.w = cvt_pk_bf16(v1[2], v1[3]);
                    *(u32x4*)(O + (size_t)row * ldc + colt + bj * HALF + wc * 32 + 8 * fq) = w;
                }
                if (m & 1) asm volatile("" ::: "memory");
            }
    }
};
struct EpiSwiglu {
    static constexpr bool PERM = true, AFTER_DRAIN = false;
    bf16_t* O; const float* ssq;
    __device__ __forceinline__ void operator()(const f32x4 (&acc)[2][2][4][2], const Unit& u, int wr, int wc, int fr, int fq) const {
        const int row0 = u.pm * BM + wr * 64 + fr, col = u.pn * HALF + wc * 32 + 8 * fq;
#pragma unroll
        for (int ai = 0; ai < 2; ++ai)
#pragma unroll
            for (int m = 0; m < 4; ++m) {
                const int row = row0 + ai * HALF + m * 16; const float rs = ssq ? rstd_row(ssq, row) : 1.0f;
                float o[8];
#pragma unroll
                for (int n = 0; n < 2; ++n)
#pragma unroll
                    for (int i = 0; i < 4; ++i) { const float a = acc[ai][0][m][n][i] * rs, b = acc[ai][1][m][n][i] * rs; o[4 * n + i] = siluf_(a) * b; }
                u32x4 w; w.x = cvt_pk_bf16(o[0], o[1]); w.y = cvt_pk_bf16(o[2], o[3]); w.z = cvt_pk_bf16(o[4], o[5]); w.w = cvt_pk_bf16(o[6], o[7]);
                *(u32x4*)(O + (size_t)row * DFF + col) = w;
                if (m & 1) asm volatile("" ::: "memory");
            }
    }
};
struct EpiResid {
    static constexpr bool PERM = true, AFTER_DRAIN = false;
    float* h; bf16_t* hb; float* ssq;
    __device__ __forceinline__ void operator()(const f32x4 (&acc)[2][2][4][2], const Unit& u, int wr, int wc, int fr, int fq) const {
        const int row0 = u.pm * BM + wr * 64 + fr, colt = u.pn * BM;
#pragma unroll
        for (int ai = 0; ai < 2; ++ai)
#pragma unroll
            for (int m = 0; m < 4; ++m) {
                const int row = row0 + ai * HALF + m * 16; float ss = 0.f;
#pragma unroll
                for (int bj = 0; bj < 2; ++bj) {
                    const size_t off = (size_t)row * D_ + colt + bj * HALF + wc * 32 + 8 * fq;
                    f32x4 x0 = *(const f32x4*)(h + off), x1 = *(const f32x4*)(h + off + 4);
                    x0 = x0 + acc[ai][bj][m][0]; x1 = x1 + acc[ai][bj][m][1];
                    *(f32x4*)(h + off) = x0; *(f32x4*)(h + off + 4) = x1;
                    ss += (x0[0] * x0[0] + x0[1] * x0[1]) + (x0[2] * x0[2] + x0[3] * x0[3]) + (x1[0] * x1[0] + x1[1] * x1[1]) + (x1[2] * x1[2] + x1[3] * x1[3]);
                    u32x4 w; w.x = cvt_pk_bf16(x0[0], x0[1]); w.y = cvt_pk_bf16(x0[2], x0[3]); w.z = cvt_pk_bf16(x1[0], x1[1]); w.w = cvt_pk_bf16(x1[2], x1[3]);
                    *(u32x4*)(hb + off) = w;
                }
                ss += __shfl_xor(ss, 16); ss += __shfl_xor(ss, 32);
                if (fq == 0) ssq[(size_t)row * 16 + u.pn * 4 + wc] = ss;
                asm volatile("" ::: "memory");
            }
    }
};
struct EpiPle {
    static constexpr bool PERM = true, AFTER_DRAIN = false;
    float* h; bf16_t* hb; const float* ssq_in; float* ssq_out; const bf16_t* pp;
    __device__ __forceinline__ void operator()(const f32x4 (&acc)[2][2][4][2], const Unit& u, int wr, int wc, int fr, int fq) const {
        const int row0 = u.pm * BM + wr * 64 + fr, colt = u.pn * BM;
#pragma unroll
        for (int ai = 0; ai < 2; ++ai)
#pragma unroll
            for (int m = 0; m < 4; ++m) {
                const int row = row0 + ai * HALF + m * 16; const float rs = rstd_row(ssq_in, row); float ss = 0.f;
#pragma unroll
                for (int bj = 0; bj < 2; ++bj) {
                    const size_t off = (size_t)row * D_ + colt + bj * HALF + wc * 32 + 8 * fq;
                    f32x4 x0 = *(const f32x4*)(h + off), x1 = *(const f32x4*)(h + off + 4);
                    const u32x4 pw = *(const u32x4*)(pp + off);
                    const f32x4 a0 = acc[ai][bj][m][0] * rs, a1 = acc[ai][bj][m][1] * rs;
                    x0[0] += sigmoidf_(a0[0]) * bf_lo(pw.x); x0[1] += sigmoidf_(a0[1]) * bf_hi(pw.x); x0[2] += sigmoidf_(a0[2]) * bf_lo(pw.y); x0[3] += sigmoidf_(a0[3]) * bf_hi(pw.y);
                    x1[0] += sigmoidf_(a1[0]) * bf_lo(pw.z); x1[1] += sigmoidf_(a1[1]) * bf_hi(pw.z); x1[2] += sigmoidf_(a1[2]) * bf_lo(pw.w); x1[3] += sigmoidf_(a1[3]) * bf_hi(pw.w);
                    *(f32x4*)(h + off) = x0; *(f32x4*)(h + off + 4) = x1;
                    ss += (x0[0] * x0[0] + x0[1] * x0[1]) + (x0[2] * x0[2] + x0[3] * x0[3]) + (x1[0] * x1[0] + x1[1] * x1[1]) + (x1[2] * x1[2] + x1[3] * x1[3]);
                    u32x4 w; w.x = cvt_pk_bf16(x0[0], x0[1]); w.y = cvt_pk_bf16(x0[2], x0[3]); w.z = cvt_pk_bf16(x1[0], x1[1]); w.w = cvt_pk_bf16(x1[2], x1[3]);
                    *(u32x4*)(hb + off) = w;
                }
                ss += __shfl_xor(ss, 16); ss += __shfl_xor(ss, 32);
                if (fq == 0) ssq_out[(size_t)row * 16 + u.pn * 4 + wc] = ss;
                asm volatile("" ::: "memory");
            }
    }
};
struct EpiMoeDown {
    static constexpr bool PERM = true, AFTER_DRAIN = false;
    bf16_t* Y; const float* gate;
    __device__ __forceinline__ void operator()(const f32x4 (&acc)[2][2][4][2], const Unit& u, int wr, int wc, int fr, int fq) const {
        const int row0 = u.pm * BM + wr * 64 + fr, colt = u.pn * BM;
#pragma unroll
        for (int ai = 0; ai < 2; ++ai)
#pragma unroll
            for (int m = 0; m < 4; ++m) {
                const int row = row0 + ai * HALF + m * 16; const float gt = gate[row];
#pragma unroll
                for (int bj = 0; bj < 2; ++bj) {
                    const f32x4 v0 = acc[ai][bj][m][0] * gt, v1 = acc[ai][bj][m][1] * gt;
                    u32x4 w; w.x = cvt_pk_bf16(v0[0], v0[1]); w.y = cvt_pk_bf16(v0[2], v0[3]); w.z = cvt_pk_bf16(v1[0], v1[1]); w.w = cvt_pk_bf16(v1[2], v1[3]);
                    *(u32x4*)(Y + (size_t)row * D_ + colt + bj * HALF + wc * 32 + 8 * fq) = w;
                }
                if (m & 1) asm volatile("" ::: "memory");
            }
    }
};

template <class Epi, class Sched, bool ALIGN_EPI = false, bool SP2 = false>
__device__ __forceinline__ void gemm_phase(PG8_LAS unsigned char* lds, const Gemm g, const Sched& S, const Epi& E) {
    int tid_ = threadIdx.x; asm volatile("" : "+v"(tid_));
    const int tid = tid_, wid = __builtin_amdgcn_readfirstlane(tid >> 6), lane = tid & 63, wr = wid >> 2, wc = wid & 3, fr = lane & 15, fq = lane >> 4;
    const int K = g.K, nt = K / BK;
    unsigned voffA[2], voffB[2];
#pragma unroll
    for (int i = 0; i < 2; ++i) { int R, C; stage_rc(tid * 16 + i * 8192, R, C); const int Rb = Epi::PERM ? ((R & ~31) + perm32(R & 31)) : R;
        voffA[i] = (unsigned)(R * K + C) * 2u; voffB[i] = (unsigned)(Rb * K + C) * 2u; }
    const size_t kstep = (size_t)(BK * 2);
    const size_t hstep = (size_t)HALF * K * 2;
    const size_t tstep = 2 * hstep;
    const unsigned ldsw = (unsigned)wid * 1024u;
    const int aoff = lds_byte(wr * 64 + fr, fq * 8), boff = lds_byte(wc * 32 + fr, fq * 8);
#define PG8_SA(b, h) (((b) * 2 + (h)) * HTB)
#define PG8_SB(b, h) ((4 + (b) * 2 + (h)) * HTB)
#define PG8_STAGE(bufoff, gbase, voff) do { _Pragma("unroll") for (int _i = 0; _i < 2; ++_i) \
        __builtin_amdgcn_global_load_lds((const unsigned*)((const char*)(gbase) + (voff)[_i]), (PG8_LAS unsigned*)(lds + (bufoff) + ldsw + _i * 8192), 16, 0, 0); } while (0)
#define PG8_LDA(dst, b, h) do { _Pragma("unroll") for (int m = 0; m < 4; ++m) _Pragma("unroll") for (int k = 0; k < 2; ++k) dst[m][k] = *(const PG8_LAS bf16x8*)(lds + PG8_SA(b, h) + aoff + m * 2048 + k * 1024); } while (0)
#define PG8_LDB(dst, b, h) do { _Pragma("unroll") for (int n = 0; n < 2; ++n) _Pragma("unroll") for (int k = 0; k < 2; ++k) dst[n][k] = *(const PG8_LAS bf16x8*)(lds + PG8_SB(b, h) + boff + n * 2048 + k * 1024); } while (0)
#define PG8_MMA(ai, bj, At, Bt) do { __builtin_amdgcn_s_setprio(1); _Pragma("unroll") for (int m = 0; m < 4; ++m) _Pragma("unroll") for (int n = 0; n < 2; ++n) _Pragma("unroll") for (int k = 0; k < 2; ++k) \
        acc[ai][bj][m][n] = __builtin_amdgcn_mfma_f32_16x16x32_bf16(Bt[n][k], At[m][k], acc[ai][bj][m][n], 0, 0, 0); __builtin_amdgcn_s_setprio(0); } while (0)
#define PG8_WAIT_V(n) asm volatile("s_waitcnt vmcnt(" #n ")" ::: "memory")
#define PG8_WAIT_L(n) asm volatile("s_waitcnt lgkmcnt(" #n ")" ::: "memory")
#define PG8_BAR __builtin_amdgcn_s_barrier()
#define PG8_SCHED __builtin_amdgcn_sched_barrier(0)
    Unit cur, nxt; int ui = 0;
    if (!S.next(0, cur)) return;
    f32x4 acc[2][2][4][2];
#pragma unroll
    for (int a = 0; a < 2; ++a)
#pragma unroll
        for (int b = 0; b < 2; ++b)
#pragma unroll
            for (int m = 0; m < 4; ++m)
#pragma unroll
                for (int n = 0; n < 2; ++n) acc[a][b][m][n] = (f32x4){0.f, 0.f, 0.f, 0.f};
    bf16x8 At[4][2], B0[2][2], B1[2][2];
    const char* cA = (const char*)g.A + (size_t)cur.pm * tstep; const char* cB = (const char*)g.Bt + (size_t)cur.pn * tstep + (size_t)cur.be * g.bstride;
    S.a_ready(cur);
    if constexpr (SP2) {
        PG8_STAGE(PG8_SB(0, 0), cB, voffB); PG8_STAGE(PG8_SB(0, 1), cB + hstep, voffB); PG8_STAGE(PG8_SA(0, 0), cA, voffA); PG8_STAGE(PG8_SA(0, 1), cA + hstep, voffA);
        if (wr == 1) PG8_BAR;
        PG8_WAIT_V(2); PG8_BAR;
        PG8_STAGE(PG8_SB(1, 0), cB + kstep, voffB); PG8_STAGE(PG8_SA(1, 0), cA + kstep, voffA); PG8_STAGE(PG8_SB(1, 1), cB + hstep + kstep, voffB);
        PG8_WAIT_V(6); PG8_BAR;
    } else {
        PG8_STAGE(PG8_SB(0, 0), cB, voffB); PG8_STAGE(PG8_SA(0, 0), cA, voffA); PG8_STAGE(PG8_SB(0, 1), cB + hstep, voffB); PG8_STAGE(PG8_SA(0, 1), cA + hstep, voffA);
        if (wr == 1) PG8_BAR;
        PG8_WAIT_V(4); PG8_BAR;
        PG8_STAGE(PG8_SB(1, 0), cB + kstep, voffB); PG8_STAGE(PG8_SA(1, 0), cA + kstep, voffA); PG8_STAGE(PG8_SB(1, 1), cB + hstep + kstep, voffB);
        PG8_WAIT_V(6); PG8_BAR;
    }
    for (;;) {
        const bool has_next = S.next(ui + 1, nxt);
        const char* nA = has_next ? (const char*)g.A + (size_t)nxt.pm * tstep : cA; const char* nB = has_next ? (const char*)g.Bt + (size_t)nxt.pn * tstep + (size_t)nxt.be * g.bstride : cB;
        for (int t = 0; t < nt; t += 2) {
            const bool last = (t == nt - 2);
            const char* a1 = cA + (size_t)(t + 1) * kstep;
            const char* a2 = last ? nA : cA + (size_t)(t + 2) * kstep; const char* b2 = last ? nB : cB + (size_t)(t + 2) * kstep;
            const char* a3 = a2 + kstep; const char* b3 = b2 + kstep;
            if (last && has_next) S.a_ready(nxt);
            if constexpr (SP2) {
            PG8_LDB(B0, 0, 0); PG8_LDB(B1, 0, 1); PG8_SCHED; PG8_LDA(At, 0, 0); PG8_STAGE(PG8_SA(1, 1), a1 + hstep, voffA);
            PG8_WAIT_V(8); PG8_WAIT_L(0); PG8_BAR; PG8_MMA(0, 0, At, B0); PG8_MMA(0, 1, At, B1); PG8_BAR; PG8_SCHED;
            PG8_LDA(At, 0, 1); PG8_STAGE(PG8_SB(0, 0), b2, voffB); PG8_STAGE(PG8_SB(0, 1), b2 + hstep, voffB); PG8_STAGE(PG8_SA(0, 0), a2, voffA);
            PG8_WAIT_V(8); PG8_WAIT_L(0); PG8_BAR; PG8_MMA(1, 0, At, B0); PG8_MMA(1, 1, At, B1); PG8_BAR; PG8_SCHED;
            PG8_LDB(B0, 1, 0); PG8_LDB(B1, 1, 1); PG8_SCHED; PG8_LDA(At, 1, 0); PG8_STAGE(PG8_SA(0, 1), a2 + hstep, voffA);
            PG8_WAIT_V(8); PG8_WAIT_L(0); PG8_BAR; PG8_MMA(0, 0, At, B0); PG8_MMA(0, 1, At, B1); PG8_BAR; PG8_SCHED;
            PG8_LDA(At, 1, 1); PG8_STAGE(PG8_SB(1, 0), b3, voffB); PG8_STAGE(PG8_SB(1, 1), b3 + hstep, voffB); PG8_STAGE(PG8_SA(1, 0), a3, voffA);
            PG8_WAIT_V(8); PG8_WAIT_L(0); PG8_BAR; PG8_MMA(1, 0, At, B0); PG8_MMA(1, 1, At, B1); PG8_BAR; PG8_SCHED;
            } else {
            PG8_LDB(B0, 0, 0); PG8_SCHED; PG8_LDA(At, 0, 0); PG8_STAGE(PG8_SA(1, 1), a1 + hstep, voffA);
            PG8_WAIT_L(8); PG8_BAR; PG8_WAIT_L(0); PG8_MMA(0, 0, At, B0); PG8_BAR; PG8_SCHED;
            PG8_LDB(B1, 0, 1); PG8_STAGE(PG8_SB(0, 0), b2, voffB);
            PG8_BAR; PG8_WAIT_L(0); PG8_MMA(0, 1, At, B1); PG8_BAR;
            PG8_LDA(At, 0, 1); PG8_STAGE(PG8_SA(0, 0), a2, voffA);
            PG8_BAR; PG8_WAIT_L(0); PG8_MMA(1, 0, At, B0); PG8_BAR; PG8_SCHED;
            PG8_STAGE(PG8_SB(0, 1), b2 + hstep, voffB);
            PG8_WAIT_V(6); PG8_BAR; PG8_MMA(1, 1, At, B1); PG8_BAR;
            PG8_LDB(B0, 1, 0); PG8_SCHED; PG8_LDA(At, 1, 0); PG8_STAGE(PG8_SA(0, 1), a2 + hstep, voffA);
            PG8_WAIT_L(8); PG8_BAR; PG8_WAIT_L(0); PG8_MMA(0, 0, At, B0); PG8_BAR; PG8_SCHED;
            PG8_LDB(B1, 1, 1); PG8_STAGE(PG8_SB(1, 0), b3, voffB);
            PG8_BAR; PG8_WAIT_L(0); PG8_MMA(0, 1, At, B1); PG8_BAR;
            PG8_LDA(At, 1, 1); PG8_STAGE(PG8_SA(1, 0), a3, voffA);
            PG8_BAR; PG8_WAIT_L(0); PG8_MMA(1, 0, At, B0); PG8_BAR; PG8_SCHED;
            PG8_STAGE(PG8_SB(1, 1), b3 + hstep, voffB);
            PG8_WAIT_V(6); PG8_BAR; PG8_MMA(1, 1, At, B1); PG8_BAR;
            }
        }
        if constexpr (ALIGN_EPI) { if (wr == 0) PG8_BAR; }
        if constexpr (!Epi::AFTER_DRAIN) { E(acc, cur, wr, wc, fr, fq); S.done(cur); }
        if (!has_next) break;
#pragma unroll
        for (int a = 0; a < 2; ++a)
#pragma unroll
            for (int b = 0; b < 2; ++b)
#pragma unroll
                for (int m = 0; m < 4; ++m)
#pragma unroll
                    for (int n = 0; n < 2; ++n) acc[a][b][m][n] = (f32x4){0.f, 0.f, 0.f, 0.f};
        cur = nxt; cA = nA; cB = nB; ++ui;
        if constexpr (ALIGN_EPI) { if (wr == 1) PG8_BAR; }
    }
    PG8_WAIT_V(0);
    if constexpr (!ALIGN_EPI) { if (wr == 0) PG8_BAR; }
    PG8_BAR;
    if constexpr (Epi::AFTER_DRAIN) { E.fused(acc, cur, wr, wc, fr, fq, lds, wid, lane); S.done(cur); }
#undef PG8_SA
#undef PG8_SB
#undef PG8_STAGE
#undef PG8_LDA
#undef PG8_LDB
#undef PG8_MMA
#undef PG8_WAIT_V
#undef PG8_WAIT_L
#undef PG8_BAR
#undef PG8_SCHED
}
}

#include <hip/hip_bf16.h>
#include <cmath>
namespace attn_body {
using bf16=__hip_bfloat16;
using bf16x8=__attribute__((ext_vector_type(8)))short;
using s16x4=__attribute__((ext_vector_type(4)))short;
using f32x16=__attribute__((ext_vector_type(16)))float;
using u32x4=__attribute__((ext_vector_type(4)))unsigned;
constexpr int SEQ=16384,D=64,LDP=3072,LDO=1024;
constexpr int NW=8,QBLK=32,QB=QBLK*NW,KVBLK=64,NQB=SEQ/QB;
constexpr int ATTN_UNIT_ROWS=QB;
__device__ __forceinline__ int crow(int r,int hi){return (r&3)+8*(r>>2)+4*hi;}
#define SBAR() __builtin_amdgcn_sched_barrier(0)
__device__ __forceinline__ void cmask(f32x16&p0,f32x16&p1,int jb,int qrel,int hi){
  const float NEG=-INFINITY; int kb=64*jb+4*hi;
  #pragma unroll
  for(int r=0;r<16;++r){int kv=kb+(r&3)+8*(r>>2); if(kv>qrel)p0[r]=NEG; if(kv+32>qrel)p1[r]=NEG;}
}

constexpr int NSLOT=3, SLOTB=8192, VSLOTB=2*SLOTB;
constexpr int LDS_K=0, LDS_V=NSLOT*SLOTB, LDS_WS=LDS_V+NSLOT*VSLOTB, LDS_OST=0  , LDS_BYTES=LDS_WS+NW*64*4;
constexpr float C2=0.125f*1.4426950408889634f;
__device__ __forceinline__ void glds16(const void*gsrc,unsigned lds_dst){unsigned keep;
  asm volatile("s_mov_b32 %0, m0\n\ts_mov_b32 m0, %2\n\ts_nop 0\n\tglobal_load_lds_dwordx4 %1, off\n\ts_mov_b32 m0, %0":"=&s"(keep):"v"(gsrc),"s"(lds_dst):"memory");}
__device__ __forceinline__ float max3f(float a,float b,float c){float r;asm("v_max3_f32 %0, %1, %2, %3":"=v"(r):"v"(a),"v"(b),"v"(c));return r;}
__device__ __forceinline__ float max2f(float a,float b){float r;asm("v_max_f32_e32 %0, %1, %2":"=v"(r):"v"(a),"v"(b));return r;}
__device__ __forceinline__ float fadd_s(float a,float b){float r;asm("v_add_f32_e32 %0, %1, %2":"=v"(r):"v"(a),"v"(b));return r;}
__device__ __forceinline__ float fsub_s(float a,float b){float r;asm("v_sub_f32_e32 %0, %1, %2":"=v"(r):"v"(a),"v"(b));return r;}
typedef float f32x2_t __attribute__((ext_vector_type(2))); typedef __bf16 bf16x2_t __attribute__((ext_vector_type(2)));
__device__ __forceinline__ unsigned cvtpk_s(float lo,float hi){f32x2_t v={lo,hi};bf16x2_t b=__builtin_convertvector(v,bf16x2_t);return __builtin_bit_cast(unsigned,b);}
#define WAIT_BAR(N) asm volatile("s_waitcnt vmcnt(" #N ") lgkmcnt(0)\n\ts_barrier":::"memory")

__device__ __forceinline__ void qkt(f32x16&p0,f32x16&p1,const char*Kslot,const bf16x8*qr,int r32,int hi){
  const char*kb=Kslot+hi*1024+r32*16;
  #pragma unroll
  for(int d0=0;d0<4;++d0){
    const bf16x8 b0=*reinterpret_cast<const bf16x8*>(kb+d0*2048);
    const bf16x8 b1=*reinterpret_cast<const bf16x8*>(kb+d0*2048+512);
    if(d0==0){p0=__builtin_amdgcn_mfma_f32_32x32x16_bf16(b0,qr[0],f32x16{},0,0,0);p1=__builtin_amdgcn_mfma_f32_32x32x16_bf16(b1,qr[0],f32x16{},0,0,0);}
    else{p0=__builtin_amdgcn_mfma_f32_32x32x16_bf16(b0,qr[d0],p0,0,0,0);p1=__builtin_amdgcn_mfma_f32_32x32x16_bf16(b1,qr[d0],p1,0,0,0);}}
}
typedef __attribute__((address_space(3))) const char* lds_cptr;
typedef short v4i16_t __attribute__((ext_vector_type(4)));
__device__ __forceinline__ void kload8(bf16x8*kf,lds_cptr kp){
  kf[0]=*(const __attribute__((address_space(3))) bf16x8*)(kp);      kf[1]=*(const __attribute__((address_space(3))) bf16x8*)(kp+512);
  kf[2]=*(const __attribute__((address_space(3))) bf16x8*)(kp+2048); kf[3]=*(const __attribute__((address_space(3))) bf16x8*)(kp+2560);
  kf[4]=*(const __attribute__((address_space(3))) bf16x8*)(kp+4096); kf[5]=*(const __attribute__((address_space(3))) bf16x8*)(kp+4608);
  kf[6]=*(const __attribute__((address_space(3))) bf16x8*)(kp+6144); kf[7]=*(const __attribute__((address_space(3))) bf16x8*)(kp+6656);
}
__device__ __forceinline__ void kload2(bf16x8*kf,lds_cptr kp,int j){ kf[2*j]=*(const __attribute__((address_space(3))) bf16x8*)(kp+j*2048); kf[2*j+1]=*(const __attribute__((address_space(3))) bf16x8*)(kp+j*2048+512); }
__device__ __forceinline__ s16x4 vtr(lds_cptr p){ return __builtin_bit_cast(s16x4,__builtin_amdgcn_ds_read_tr16_b64_v4i16((__attribute__((address_space(3))) v4i16_t*)p)); }
__device__ __forceinline__ float rowmax(const f32x16&p0,const f32x16&p1){
  float a=max3f(p0[0],p0[1],p1[0]),b=max3f(p0[2],p0[3],p1[1]);a=max3f(a,p1[2],p1[3]);
  #pragma unroll
  for(int r=4;r<16;r+=4){a=max3f(a,p0[r],p0[r+1]);b=max3f(b,p0[r+2],p0[r+3]);a=max3f(a,p1[r],p1[r+1]);b=max3f(b,p1[r+2],p1[r+3]);}
  const float m=max2f(a,b);
  auto rr=__builtin_amdgcn_permlane32_swap(__float_as_uint(m),__float_as_uint(m),false,false);
  return max2f(__uint_as_float(rr[0]),__uint_as_float(rr[1]));
}
__device__ __forceinline__ void pv(f32x16*o,int vb,bf16x8 pa0,bf16x8 pa1,bf16x8 pa2,bf16x8 pa3){
  #pragma unroll
  for(int d0=0;d0<4;++d0){s16x4 lo[4],hi[4];
    #pragma unroll
    for(int ks=0;ks<4;++ks){
      asm volatile("ds_read_b64_tr_b16 %0,%1 offset:%c2":"=&v"(lo[ks]):"v"(vb),"i"(d0*4096+ks*1024):"memory");
      asm volatile("ds_read_b64_tr_b16 %0,%1 offset:%c2":"=&v"(hi[ks]):"v"(vb),"i"(d0*4096+ks*1024+512):"memory");}
    asm volatile("s_waitcnt lgkmcnt(0)":::"memory");SBAR();
    #define PK(k) (bf16x8){lo[k][0],lo[k][1],lo[k][2],lo[k][3],hi[k][0],hi[k][1],hi[k][2],hi[k][3]}
    o[d0]=__builtin_amdgcn_mfma_f32_32x32x16_bf16(pa0,PK(0),o[d0],0,0,0);
    o[d0]=__builtin_amdgcn_mfma_f32_32x32x16_bf16(pa1,PK(1),o[d0],0,0,0);
    o[d0]=__builtin_amdgcn_mfma_f32_32x32x16_bf16(pa2,PK(2),o[d0],0,0,0);
    o[d0]=__builtin_amdgcn_mfma_f32_32x32x16_bf16(pa3,PK(3),o[d0],0,0,0);
    #undef PK
  }
}

#ifndef ATTN_STORE16
#define ATTN_STORE16(p,v) (*(u32x4*)(p)=(v))
#endif
template<int THRL> __device__ __forceinline__ void attn_unit(int qb,const bf16*Qh,const bf16*__restrict__ Kh,const bf16*__restrict__ Vh,bf16*Oh,char*shm){
  int tid_=threadIdx.x; asm volatile("":"+v"(tid_));
  const int tid=tid_,lane=tid&63,r32=lane&31,hi=lane>>5; const int wid=__builtin_amdgcn_readfirstlane(tid>>6);
  const int q0=qb*QB;
  const bf16*Qw=Qh+(long)(q0+wid*QBLK)*LDP;
  const unsigned lds0=(unsigned)(uintptr_t)shm;
  float*wsf=(float*)(shm+LDS_WS)+wid*64;
  const bf16*ksrc=Kh+(long)lane*LDP+wid*8;
  const bf16*vsrc=Vh+(long)(16*(wid&3)+(lane>>2))*LDP+(wid>>2)*32+(lane&3)*8;
  const unsigned kdst=lds0+LDS_K+wid*1024, vdst=lds0+LDS_V+wid*1024;
  #define DMA_K(t,slot) glds16(ksrc+(long)(t)*KVBLK*LDP,(unsigned)__builtin_amdgcn_readfirstlane(kdst+(slot)))
  #define DMA_V(t,slot) do{ glds16(vsrc+(long)(t)*KVBLK*LDP,(unsigned)__builtin_amdgcn_readfirstlane(vdst+2*(slot))); glds16(vsrc+64+(long)(t)*KVBLK*LDP,(unsigned)__builtin_amdgcn_readfirstlane(vdst+2*(slot)+8192)); }while(0)
  const int vb0=(int)(lds0+LDS_V)+((lane>>4)&1)*32+(lane&3)*8+(4*hi+((lane&15)>>2))*64;
  const char*Kbase=shm+LDS_K; bf16x8 kf[8];
  const lds_cptr shm3=(lds_cptr)shm; const lds_cptr kp0=shm3+LDS_K+hi*1024+r32*16; const lds_cptr vp0=shm3+LDS_V+((lane>>4)&1)*32+(lane&3)*8+(4*hi+((lane&15)>>2))*64;
  const int NT=(q0+QB)/KVBLK;
  DMA_K(0,0);DMA_V(0,0);DMA_K(1,SLOTB);
  bf16x8 qr[4];
  #pragma unroll
  for(int d0=0;d0<4;++d0)qr[d0]=*reinterpret_cast<const bf16x8*>(&Qw[(long)r32*LDP+d0*16+hi*8]);
  float mhat=0.f,l_reg=0.f;f32x16 o[4];o[0]=f32x16{};o[1]=f32x16{};o[2]=f32x16{};o[3]=f32x16{};
  const int qrel=wid*QBLK+r32;
  #define CMASK(P0,P1,t) do{int jb_=(t)-(NT-4); if(jb_>=0)cmask(P0,P1,jb_,qrel,hi);}while(0)
  bool resc=false;
  #define START(P0,P1) do{ const float rm=rowmax(P0,P1); resc=false; mhat=rm; \
    _Pragma("unroll") for(int r=0;r<16;++r)P0[r]=__builtin_amdgcn_exp2f(fsub_s(P0[r],mhat)); }while(0)
  #define RESC() do{ if(resc){ asm volatile("s_waitcnt lgkmcnt(0)":::"memory"); \
      _Pragma("unroll") for(int d_=0;d_<4;++d_) _Pragma("unroll") for(int r=0;r<16;++r)o[d_][r]*=wsf[crow(r,hi)]; } }while(0)
  f32x16 pA0,pA1,pB0,pB1;
  int sl_prev=0,sl_cur=0,sl_next=SLOTB;
  #define ROT() do{sl_prev=sl_cur;sl_cur=sl_next;sl_next=(sl_next==(NSLOT-1)*SLOTB)?0:sl_next+SLOTB;}while(0)
  DMA_K(2,2*SLOTB);
  WAIT_BAR(4);
  qkt(pA0,pA1,Kbase,qr,r32,hi);asm volatile("s_nop 15\n\ts_nop 7":"+v"(pA0),"+v"(pA1));CMASK(pA0,pA1,0);
  START(pA0,pA1);
  _Pragma("unroll") for(int r=0;r<16;++r)pA1[r]=__builtin_amdgcn_exp2f(pA1[r]-mhat);
  WAIT_BAR(0);
  DMA_K(3,0);DMA_V(1,SLOTB);
  ROT();
  kload8(kf,kp0+sl_cur);
  WAIT_BAR(3);
  s16x4 vlo[3],vhi[3]; u32x4 pw0,pw1,pw2,pw3;
  #define PKW(P,B) cvtpk_s(P[B],P[B+1])
  #define PAF(k) __builtin_bit_cast(bf16x8,pw##k)
  #define VFJ(j) (bf16x8){vlo[(j)%3][0],vlo[(j)%3][1],vlo[(j)%3][2],vlo[(j)%3][3],vhi[(j)%3][0],vhi[(j)%3][1],vhi[(j)%3][2],vhi[(j)%3][3]}
  #define PIN(x) asm volatile("":"+v"(x))
  #define MX3(a,b,c) __builtin_fmaxf(__builtin_fmaxf((a),(b)),(c))
  #define GAPA(MF,A0,A1,A2,A3,W0,W1,PW) do{ MF; sacc+=A0; sacc+=A1; sacc+=A2; sacc+=A3; PIN(sacc); W0; W1; PIN(PW); SBAR(); }while(0)
  #define EX(v) __builtin_amdgcn_exp2f(v)
  #define VJ(j) do{ vlo[(j)%3]=vtr(vp_+(((j)&3)*4096+((j)>>2)*1024)); vhi[(j)%3]=vtr(vp_+(((j)&3)*4096+((j)>>2)*1024+512)); }while(0)
  #define PVJ(j,PA,X,B) do{ if((j)+2<16){ VJ((j)+2); SBAR(); } o[(j)&3]=__builtin_amdgcn_mfma_f32_32x32x16_bf16(PA,VFJ(j),o[(j)&3],0,0,0); X[B]=EX(X[B]-mhat); X[B+1]=EX(X[B+1]-mhat); PIN(X); SBAR(); }while(0)
  #define KRD(G,j) do{ if(G){ kload2(kf,kp0+sl_next,j); SBAR(); } }while(0)
  #define STEP(C0,C1,P0,P1,t,GK,GV,GL) do{ SBAR(); \
    const lds_cptr vp_=vp0+2*sl_prev; \
    float sacc=(P0[0]+P0[1]); \
    GAPA(C0=__builtin_amdgcn_mfma_f32_32x32x16_bf16(kf[0],qr[0],f32x16{},0,0,0), P0[2],P0[3],P0[4],P0[5],     pw0[0]=PKW(P0,0), pw0[1]=PKW(P0,2), pw0); \
    GAPA(C1=__builtin_amdgcn_mfma_f32_32x32x16_bf16(kf[1],qr[0],f32x16{},0,0,0), P0[6],P0[7],P0[8],P0[9],     pw0[2]=PKW(P0,4), pw0[3]=PKW(P0,6), pw0); \
    GAPA(C0=__builtin_amdgcn_mfma_f32_32x32x16_bf16(kf[2],qr[1],C0,0,0,0),   P0[10],P0[11],P0[12],P0[13], pw1[0]=PKW(P0,8), pw1[1]=PKW(P0,10), pw1); \
    GAPA(C1=__builtin_amdgcn_mfma_f32_32x32x16_bf16(kf[3],qr[1],C1,0,0,0),   P0[14],P0[15],P1[0],P1[1],   pw1[2]=PKW(P0,12),pw1[3]=PKW(P0,14), pw1); \
    GAPA(C0=__builtin_amdgcn_mfma_f32_32x32x16_bf16(kf[4],qr[2],C0,0,0,0),   P1[2],P1[3],P1[4],P1[5],     pw2[0]=PKW(P1,0), pw2[1]=PKW(P1,2), pw2); \
    GAPA(C1=__builtin_amdgcn_mfma_f32_32x32x16_bf16(kf[5],qr[2],C1,0,0,0),   P1[6],P1[7],P1[8],P1[9],     pw2[2]=PKW(P1,4), pw2[3]=PKW(P1,6), pw2); \
    GAPA(C0=__builtin_amdgcn_mfma_f32_32x32x16_bf16(kf[6],qr[3],C0,0,0,0),   P1[10],P1[11],P1[12],P1[13], pw3[0]=PKW(P1,8), pw3[1]=PKW(P1,10), pw3); \
    GAPA(C1=__builtin_amdgcn_mfma_f32_32x32x16_bf16(kf[7],qr[3],C1,0,0,0),   P1[14],P1[15],0.f,0.f,       pw3[2]=PKW(P1,12),pw3[3]=PKW(P1,14), pw3); \
    l_reg+=sacc; VJ(0); VJ(1); SBAR(); \
 \
    if(GK){DMA_K((t)+3,sl_cur);} if(GV){DMA_V((t)+1,sl_next);} \
    CMASK(C0,C1,t); \
    { float a=MX3(C0[0],C0[1],C1[0]),b=MX3(C0[2],C0[3],C1[1]); a=MX3(a,C1[2],C1[3]); \
      _Pragma("unroll") for(int r=4;r<16;r+=4){a=MX3(a,C0[r],C0[r+1]);b=MX3(b,C0[r+2],C0[r+3]);a=MX3(a,C1[r],C1[r+1]);b=MX3(b,C1[r+2],C1[r+3]);} \
      float rm=__builtin_fmaxf(a,b); { auto rr=__builtin_amdgcn_permlane32_swap(__float_as_uint(rm),__float_as_uint(rm),false,false); rm=__builtin_fmaxf(__uint_as_float(rr[0]),__uint_as_float(rr[1])); } \
      resc=false; const float rel=rm-mhat; \
      if(__builtin_expect(__any(rel>(float)THRL),0)){ const float dl=__builtin_fmaxf(rel,0.f); mhat+=dl; \
        const float f=__builtin_amdgcn_exp2f(-dl); l_reg*=f; if(hi==0)wsf[r32]=f; resc=true; } } \
    SBAR(); \
    PVJ(0, PAF(0),C0,0);  PVJ(1, PAF(0),C0,2);  PVJ(2, PAF(0),C0,4);  PVJ(3, PAF(0),C0,6); \
    KRD(GL,0); PVJ(4, PAF(1),C0,8);  PVJ(5, PAF(1),C0,10); KRD(GL,1); PVJ(6, PAF(1),C0,12); PVJ(7, PAF(1),C0,14); \
    KRD(GL,2); PVJ(8, PAF(2),C1,0);  PVJ(9, PAF(2),C1,2);  KRD(GL,3); PVJ(10,PAF(2),C1,4);  PVJ(11,PAF(2),C1,6); \
    PVJ(12,PAF(3),C1,8);  PVJ(13,PAF(3),C1,10); PVJ(14,PAF(3),C1,12); PVJ(15,PAF(3),C1,14); \
    }while(0)
  int t=1;
  #undef CMASK
  #define CMASK(P0,P1,t) do{}while(0)
  for(;t+5<NT;t+=2){
    STEP(pB0,pB1,pA0,pA1,t,true,true,true);     WAIT_BAR(3); RESC(); ROT();
    STEP(pA0,pA1,pB0,pB1,t+1,true,true,true);   WAIT_BAR(3); RESC(); ROT();
  }
  #undef CMASK
  int hi_b=hi,qrel_b=qrel; asm volatile("":"+v"(hi_b),"+v"(qrel_b));
  #define CMASK(P0,P1,t) do{int jb_=(t)-(NT-4); if(jb_>=0)cmask(P0,P1,jb_,qrel_b,hi_b);}while(0)
  #define ENDW(tt) do{ if((tt)+3<NT){WAIT_BAR(3);} else if((tt)+2<NT){WAIT_BAR(2);} else {WAIT_BAR(0);} }while(0)
  for(;t+1<NT;t+=2){
    STEP(pB0,pB1,pA0,pA1,t,(t+3<NT),(t+1<NT),(t+1<NT));       ENDW(t);   RESC(); ROT();
    STEP(pA0,pA1,pB0,pB1,t+1,(t+4<NT),(t+2<NT),(t+2<NT));     ENDW(t+1); RESC(); ROT();
  }
  STEP(pB0,pB1,pA0,pA1,NT-1,false,false,false); RESC();
  { float sacc=pB0[0]+pB0[1]; _Pragma("unroll") for(int r=2;r<16;++r)sacc+=pB0[r]; _Pragma("unroll") for(int r=0;r<16;++r)sacc+=pB1[r]; l_reg+=sacc;
    pw0=(u32x4){PKW(pB0,0),PKW(pB0,2),PKW(pB0,4),PKW(pB0,6)};pw1=(u32x4){PKW(pB0,8),PKW(pB0,10),PKW(pB0,12),PKW(pB0,14)};pw2=(u32x4){PKW(pB1,0),PKW(pB1,2),PKW(pB1,4),PKW(pB1,6)};pw3=(u32x4){PKW(pB1,8),PKW(pB1,10),PKW(pB1,12),PKW(pB1,14)};
    SBAR(); pv(o,vb0+2*sl_cur,PAF(0),PAF(1),PAF(2),PAF(3)); }
  #undef PKW
  #undef PAF
  #undef VFJ
  #undef VJ
  #undef PVJ
  #undef PIN
  #undef MX3
  #undef GAPA
  #undef EX
  #undef KRD
  #undef STEP
  #undef ENDW
  int lanee=lane; asm volatile("":"+v"(lanee)); const int r32e=lanee&31,hie=lanee>>5;
  {auto rr=__builtin_amdgcn_permlane32_swap(__float_as_uint(l_reg),__float_as_uint(l_reg),false,false);l_reg=__uint_as_float(rr[0])+__uint_as_float(rr[1]);}
  if(hie==0)wsf[32+r32e]=l_reg;asm volatile("s_waitcnt lgkmcnt(0)":::"memory");
  float rli[16];
  #pragma unroll
  for(int r=0;r<16;++r)rli[r]=__builtin_amdgcn_rcpf(wsf[32+crow(r,hie)]);
  bf16*Ow=Oh+(long)(q0+wid*QBLK)*LDO;
  asm volatile("s_waitcnt lgkmcnt(0)\n\ts_barrier":::"memory");
  { bf16*stg=(bf16*)(shm)+wid*4096;
    #pragma unroll
    for(int r=0;r<16;++r){const int orow=crow(r,hie);
      #pragma unroll
      for(int d0=0;d0<4;++d0)stg[orow*128+d0*32+r32e]=__float2bfloat16(o[d0][r]*rli[r]);}
    asm volatile("s_waitcnt lgkmcnt(0)":::"memory");
    #pragma unroll
    for(int i=0;i<8;++i){const int row=i*4+(lanee>>4),ch=lanee&15; const u32x4 v=*(const u32x4*)(stg+row*128+ch*8); ATTN_STORE16(Ow+(long)row*LDO+ch*8,v);} }
  asm volatile("s_waitcnt lgkmcnt(0)\n\ts_barrier":::"memory");
  #undef DMA_K
  #undef DMA_V
  #undef CMASK
  #undef START
  #undef RESC
  #undef ROT
}
constexpr int ATTN_LDS_BYTES=LDS_BYTES;
template<int THRL=8> __device__ __forceinline__ void attn_phase(char*lds,const bf16*PE,bf16*AO,int vcu,int G){
  const int nu=(G==256)?2:((8*NQB-vcu+G-1)/G);
  #pragma unroll 1
  for(int i=0;i<nu;++i){
    int h2,qb;
    if(G==256){ const int s=vcu&31; h2=vcu>>5; qb=(i==0)?s:63-s; }
    else { const int u=vcu+i*G; h2=u/NQB; qb=u%NQB; }
    attn_unit<THRL>(qb,PE+h2*64,PE+512+h2*64,PE+1024+(h2>>1)*128,AO+h2*128,lds);
  }
}
#undef SBAR
#undef WAIT_BAR
}

#define GAS __attribute__((address_space(1)))
#define LAS __attribute__((address_space(3)))
typedef unsigned short bf16;
typedef unsigned v4u __attribute__((ext_vector_type(4)));
typedef float f32x4 __attribute__((ext_vector_type(4)));
typedef short bf16x8 __attribute__((ext_vector_type(8)));
typedef GAS unsigned gu32;
typedef GAS unsigned long long gu64;
#define RLX_AGENT __ATOMIC_RELAXED, __HIP_MEMORY_SCOPE_AGENT
#define LDS_WAIT() asm volatile("s_waitcnt lgkmcnt(0)" ::: "memory")
#define VM_WAIT() asm volatile("s_waitcnt vmcnt(0)" ::: "memory")
__device__ __forceinline__ unsigned long long rt() { return __builtin_amdgcn_s_memrealtime(); }
__device__ __forceinline__ unsigned f2bf(float f) { unsigned u = __builtin_bit_cast(unsigned, f); return (u + 0x7fffu + ((u >> 16) & 1u)) >> 16; }
__device__ __forceinline__ unsigned pk2(float lo, float hi) { return f2bf(lo) | (f2bf(hi) << 16); }

#define XB_TMO      128
#define XB_XCNT(j)  (256  + 64 * (j))
#define XB_XSUB(j)  (1280 + 64 * (j))
#define XB_XGEN(j)  (2304 + 64 * (j))
#define XB_TOP      3328
#define XB_TOPGEN   3392
#define XCD_BAR_WORDS 3456
#define XB_SPIN_CAP (1u << 18)

__device__ __forceinline__ unsigned xb_ld(unsigned* p)              { return __hip_atomic_load(p, __ATOMIC_RELAXED, __HIP_MEMORY_SCOPE_AGENT); }
__device__ __forceinline__ unsigned xb_add(unsigned* p, unsigned v) { return __hip_atomic_fetch_add(p, v, __ATOMIC_RELAXED, __HIP_MEMORY_SCOPE_AGENT); }
__device__ __forceinline__ unsigned xb_xcc_id() { return (unsigned)__builtin_amdgcn_s_getreg((3 << 11) | 20) & 0xFu; }
#define XB_SPIN(cond, bar) do { unsigned _sp = 0; while (cond) { __builtin_amdgcn_s_sleep(1); \
    if ((++_sp & 255u) == 0u) { if (xb_ld(&(bar)[XB_TMO])) break; if (_sp > XB_SPIN_CAP) { atomicAdd(&(bar)[XB_TMO], 1u); break; } } } } while (0)

struct XcdBarrier {
    unsigned* bar; unsigned x;
    volatile LAS unsigned* st;
};

__device__ __forceinline__ XcdBarrier xcd_barrier_post(unsigned* bar, volatile LAS unsigned* st) {
    XcdBarrier b; b.bar = bar; b.x = xb_xcc_id(); b.st = st;
    if (threadIdx.x == 0) (void)xb_add(&bar[XB_XCNT(b.x)], 1u);
    return b;
}
__device__ __forceinline__ void xcd_barrier_complete(unsigned* bar, unsigned x, unsigned& nloc, unsigned& nx) {
    const unsigned G = gridDim.x * gridDim.y * gridDim.z;
    unsigned sum, cnt, mine, sp = 0u;
    for (;;) {
        sum = 0u; cnt = 0u; mine = 0u;
#pragma unroll
        for (unsigned j = 0; j < 16; ++j) { const unsigned c = xb_ld(&bar[XB_XCNT(j)]); sum += c; cnt += (c > 0u) ? 1u : 0u; mine = (j == x) ? c : mine; }
        if (sum == G) break;
        __builtin_amdgcn_s_sleep(1);
        if ((++sp & 255u) == 0u) { if (xb_ld(&bar[XB_TMO])) break; if (sp > XB_SPIN_CAP) { atomicAdd(&bar[XB_TMO], 1u); break; } }
    }
    nloc = mine > 0u ? mine : 1u; nx = cnt > 0u ? cnt : 1u;
}

__device__ __forceinline__ void xcd_barrier(const XcdBarrier& b) {
    asm volatile("s_waitcnt vmcnt(0)" ::: "memory");
    __syncthreads();
    if (threadIdx.x == 0) {
        unsigned* bar = b.bar;
        __builtin_amdgcn_s_waitcnt(0);
        unsigned nloc = b.st[0], nx = b.st[1];
        if (nloc == 0u) { xcd_barrier_complete(bar, b.x, nloc, nx); b.st[0] = nloc; b.st[1] = nx; }
        const unsigned old = xb_add(&bar[XB_XSUB(b.x)], 1u);
        const unsigned gen = old / nloc;
        if (old + 1u == (gen + 1u) * nloc) {
            __builtin_amdgcn_fence(__ATOMIC_RELEASE, "agent");
            asm volatile("s_waitcnt vmcnt(0)" ::: "memory");
            const unsigned og = xb_add(&bar[XB_TOP], 1u);
            const unsigned tg = og / nx;
            if (og + 1u == (tg + 1u) * nx) xb_add(&bar[XB_TOPGEN], 1u);
            else XB_SPIN(xb_ld(&bar[XB_TOPGEN]) == tg, bar);
            __builtin_amdgcn_fence(__ATOMIC_ACQUIRE, "agent");
            xb_add(&bar[XB_XGEN(b.x)], 1u);
            asm volatile("s_waitcnt vmcnt(0)" ::: "memory");
        } else {
            XB_SPIN(xb_ld(&bar[XB_XGEN(b.x)]) == gen, bar);
            __builtin_amdgcn_fence(__ATOMIC_ACQUIRE, "agent");
            asm volatile("s_waitcnt vmcnt(0)" ::: "memory");
        }
    }
    __syncthreads();
}

constexpr int NWAVES = 8;
constexpr size_t MiB = 1u << 20;
constexpr size_t WS_CTL = 0, CTL_ZERO_BYTES = 1 * MiB;
constexpr size_t WS_TAB = 1 * MiB;
constexpr size_t WS_SSQA = 2 * MiB, WS_SSQB = 3 * MiB;
constexpr size_t WS_GB = 4 * MiB;
constexpr size_t WS_GC = 512 * 1024;
constexpr size_t WS_TOK = 5 * MiB;
constexpr size_t WS_W = 6 * MiB;
constexpr size_t WS_WINE = WS_W, WS_WOUTE = WS_W + 12 * MiB, WS_W13D = WS_W + 16 * MiB, WS_W2D = WS_W + 44 * MiB, WS_WINO = WS_W + 58 * MiB  , WS_WOUTO = WS_W + 76 * MiB,
                 WS_WG = WS_W + 80 * MiB, WS_WP = WS_W + 88 * MiB, WS_W13M = WS_W + 90 * MiB, WS_W2M = WS_W + 202 * MiB;
static_assert(WS_W2M + 56 * MiB <= 264 * MiB, "weight copies end below the p copy");
constexpr size_t WS_PBF = 264 * MiB, WS_HBF = 296 * MiB, WS_PP = 328 * MiB, WS_MIX = 360 * MiB, WS_ARENA = 392 * MiB;
constexpr size_t AR_PE = 0, AR_AO = 96 * MiB;
constexpr size_t AR_PO = 0  , AR_QN = 144 * MiB, AR_KN = 176 * MiB, AR_KGT = 208 * MiB, AR_VBT = 240 * MiB, AR_KTT = 272 * MiB, AR_AI = 304 * MiB, AR_NEGW = 320 * MiB, AR_UT = 352 * MiB,
                 AR_SG = 384 * MiB  , AR_MPC = 448 * MiB  , AR_NTC = 464 * MiB, AR_END = 480 * MiB;
constexpr size_t AR_ACT = 0, AR_XS = 240 * MiB, AR_Y = 308 * MiB;
constexpr size_t WS_NEED = WS_ARENA + AR_END;
constexpr size_t TOK_E = 0, TOK_R = 128 * 1024, TOK_G = 256 * 1024, TOK_DST = 384 * 1024, TOK_GPAD = 512 * 1024, TOK_DN = 704 * 1024, TOK_DNC = 720 * 1024;
constexpr int CW_TMO = 0, CW_BAR = 4096, CW_CNT = 8192  , CW_DBG = 12288;

constexpr int RING_OFF = 0, WAVE_LDS = 17408;
constexpr int LDSCTL_OFF = 139264, MISC_OFF = LDSCTL_OFF + 64, BLKE_OFF = LDSCTL_OFF + 256  , RT_OFF = LDSCTL_OFF + 1024  ;
constexpr int LDS_BYTES = 147456;

typedef unsigned u32x2v __attribute__((ext_vector_type(2)));
__device__ __forceinline__ float bflo(unsigned w) { return __uint_as_float(w << 16); }
__device__ __forceinline__ float bfhi(unsigned w) { return __uint_as_float(w & 0xffff0000u); }
__device__ __forceinline__ unsigned cvtpk(float lo, float hi) { return pg8::cvt_pk_bf16_cv(lo, hi); }
__device__ __forceinline__ float wave_sum(float v) {
#pragma unroll
    for (int o = 1; o < 64; o <<= 1) v += __shfl_xor(v, o);
    return v;
}
__device__ __forceinline__ float sigm(float x) { return pg8::sigmoidf_(x); }
__device__ __forceinline__ float silu(float x) { return x * pg8::sigmoidf_(x); }

struct Args { const void* in[30]; float* out; unsigned char* ws; int ph_lo, ph_hi, use_bar, pad; };

struct Frame {
    LAS unsigned char* lds; int tid, lane, wave, vcu, G, gw, NGW;
};

__device__ __forceinline__ void xpose_item(const float* W, int ldw, int K, int N, const float* gain, bf16* WT, int ilv, LAS float* scr, int item, int lane) {
    const int nblk = N / 64, kb = item / nblk, nb = item % nblk, k0 = 64 * kb, n0 = 64 * nb;
    const int lr = lane >> 4, lc = (lane & 15) * 4;
    f32x4 v[16];
#pragma unroll
    for (int i = 0; i < 16; ++i) v[i] = *(const GAS f32x4*)(W + (size_t)(k0 + 4 * i + lr) * ldw + n0 + lc);
    if (gain) {
#pragma unroll
        for (int i = 0; i < 16; ++i) v[i] = v[i] * gain[k0 + 4 * i + lr]; }
#pragma unroll
    for (int i = 0; i < 16; ++i) { LAS float* s = scr + (4 * i + lr) * 65 + lc; s[0] = v[i][0]; s[1] = v[i][1]; s[2] = v[i][2]; s[3] = v[i][3]; }
    LDS_WAIT(); asm volatile("" ::: "memory");
    const int c = lane & 7;
#pragma unroll
    for (int j = 0; j < 8; ++j) { const int nl = (lane >> 3) + 8 * j, n = n0 + nl; const LAS float* s = scr + (8 * c) * 65 + nl;
        const int dr = ilv ? (((n >> 7) << 8) + (n & 127) + (ilv == 2 ? 128 : 0)) : n;
        v4u o; o.x = pk2(s[0 * 65], s[1 * 65]); o.y = pk2(s[2 * 65], s[3 * 65]); o.z = pk2(s[4 * 65], s[5 * 65]); o.w = pk2(s[6 * 65], s[7 * 65]);
        *(GAS v4u*)(WT + (size_t)dr * K + k0 + 8 * c) = o; }
    LDS_WAIT(); asm volatile("" ::: "memory");
}
struct MatD { const float* W; int ldw, K, N; const float* gain; bf16* WT; int ilv; int items; };
__device__ __forceinline__ MatD dense_mat(const Args& a, int id) {
    unsigned char* ws = a.ws; MatD m; m.gain = nullptr; m.ilv = 0;
    if (id < 2)       { const int j = id;      m.W = (const float*)a.in[7] + (size_t)j * D_ * EIN;    m.ldw = EIN; m.K = D_; m.N = EIN; m.gain = (const float*)a.in[3] + (2 * j) * D_; m.WT = (bf16*)(ws + WS_WINE) + (size_t)j * EIN * D_; }
    else if (id < 4)  { const int j = id - 2;  m.W = (const float*)a.in[8] + (size_t)j * D_ * D_;     m.ldw = D_; m.K = D_; m.N = D_; m.WT = (bf16*)(ws + WS_WOUTE) + (size_t)j * D_ * D_; }
    else if (id < 6)  { const int j = id - 4;  m.W = (const float*)a.in[21] + (size_t)j * D_ * DFF;   m.ldw = DFF; m.K = D_; m.N = DFF; m.gain = (const float*)a.in[4] + (2 * j) * D_; m.WT = (bf16*)(ws + WS_W13D) + (size_t)j * 2 * DFF * D_; m.ilv = 1; }
    else if (id < 8)  { const int j = id - 6;  m.W = (const float*)a.in[22] + (size_t)j * D_ * DFF;   m.ldw = DFF; m.K = D_; m.N = DFF; m.gain = (const float*)a.in[4] + (2 * j) * D_; m.WT = (bf16*)(ws + WS_W13D) + (size_t)j * 2 * DFF * D_; m.ilv = 2; }
    else if (id < 10) { const int j = id - 8;  m.W = (const float*)a.in[23] + (size_t)j * DFF * D_;   m.ldw = D_; m.K = DFF; m.N = D_; m.WT = (bf16*)(ws + WS_W2D) + (size_t)j * D_ * DFF; }
    else if (id < 12) { const int j = id - 10; m.W = (const float*)a.in[15] + (size_t)j * D_ * OIN_SRC; m.ldw = OIN_SRC; m.K = D_; m.N = OIN_W; m.gain = (const float*)a.in[3] + (2 * j + 1) * D_; m.WT = (bf16*)(ws + WS_WINO) + (size_t)j * OIN * D_; }
    else if (id < 14) { const int j = id - 12; m.W = (const float*)a.in[20] + (size_t)j * D_ * D_;    m.ldw = D_; m.K = D_; m.N = D_; m.WT = (bf16*)(ws + WS_WOUTO) + (size_t)j * D_ * D_; }
    else if (id < 18) { const int i = id - 14; m.W = (const float*)a.in[28] + (size_t)i * D_ * D_;    m.ldw = D_; m.K = D_; m.N = D_; m.gain = (const float*)a.in[5] + i * D_; m.WT = (bf16*)(ws + WS_WG) + (size_t)i * D_ * D_; }
    else              { const int i = id - 18; m.W = (const float*)a.in[29] + (size_t)i * PLE * D_;   m.ldw = D_; m.K = PLE; m.N = D_; m.WT = (bf16*)(ws + WS_WP) + (size_t)i * D_ * PLE; }
    m.items = (m.K / 64) * (m.N / 64); return m;
}
__device__ __forceinline__ MatD moe_mat(const Args& a, int j, int id) {
    unsigned char* ws = a.ws; MatD m; m.gain = nullptr; m.ilv = 0; const int e = id / 3, k = id % 3;
    if (k < 2) { m.W = (const float*)a.in[25 + k] + ((size_t)j * NEXP + e) * D_ * DFF; m.ldw = DFF; m.K = D_; m.N = DFF; m.gain = (const float*)a.in[4] + (2 * j + 1) * D_; m.WT = (bf16*)(ws + WS_W13M) + (size_t)e * 2 * DFF * D_; m.ilv = 1 + k; }
    else       { m.W = (const float*)a.in[27] + ((size_t)j * NEXP + e) * DFF * D_; m.ldw = D_; m.K = DFF; m.N = D_; m.WT = (bf16*)(ws + WS_W2M) + (size_t)e * D_ * DFF; }
    m.items = (m.K / 64) * (m.N / 64); return m;
}

__device__ __forceinline__ void p_prologue(const Frame& F, const Args& a) {
    LAS float* scr = (LAS float*)(F.lds + F.wave * WAVE_LDS);
    unsigned char* ws = a.ws;
    {
        int base = 0;
#pragma unroll 1
        for (int id = 0; id < 22; ++id) { const MatD m = dense_mat(a, id);
            int first = (F.gw - base) % F.NGW; if (first < 0) first += F.NGW;
#pragma unroll 1
            for (int it = first; it < m.items; it += F.NGW) xpose_item(m.W, m.ldw, m.K, m.N, m.gain, m.WT, m.ilv, scr, it, F.lane);
            base += m.items; }
    }
    for (int idx = F.gw * 64 + F.lane; idx < 2 * 256 * (D_ / 8); idx += F.NGW * 64) { const int j = idx / (256 * (D_ / 8)), r = (idx / (D_ / 8)) % 256, k0 = (idx % (D_ / 8)) * 8;
        const float* W = (const float*)a.in[15] + (size_t)j * D_ * OIN_SRC; const float* ln = (const float*)a.in[3] + (2 * j + 1) * D_; float v[8];
#pragma unroll
        for (int e = 0; e < 8; ++e) v[e] = (r < 16) ? ln[k0 + e] * W[(size_t)(k0 + e) * OIN_SRC + OIN_W + r] : 0.f;
        v4u o; o.x = cvtpk(v[0], v[1]); o.y = cvtpk(v[2], v[3]); o.z = cvtpk(v[4], v[5]); o.w = cvtpk(v[6], v[7]);
        *(GAS v4u*)((bf16*)(ws + WS_WINO) + ((size_t)j * OIN + OIN_W + r) * D_ + k0) = o; }
    { const float* p = (const float*)a.in[1]; bf16* pb = (bf16*)(ws + WS_PBF); const size_t n8 = (size_t)DEPTH_ * S_ * PLE / 8;
#pragma unroll 1
      for (size_t i = (size_t)F.gw * 64 + F.lane; i < n8; i += (size_t)F.NGW * 64) { const f32x4 x0 = *(const GAS f32x4*)(p + i * 8), x1 = *(const GAS f32x4*)(p + i * 8 + 4);
          v4u o; o.x = cvtpk(x0[0], x0[1]); o.y = cvtpk(x0[2], x0[3]); o.z = cvtpk(x1[0], x1[1]); o.w = cvtpk(x1[2], x1[3]); *(GAS v4u*)(pb + i * 8) = o; } }
#ifdef PROBE_PRO_NOC
    if (a.use_bar)
#endif
    { const float* x = (const float*)a.in[0]; bf16* hb = (bf16*)(ws + WS_HBF); float* ssq = (float*)(ws + WS_SSQB);
#pragma unroll 1
      for (int m = F.gw; m < S_; m += F.NGW) { const GAS f32x4* xr = (const GAS f32x4*)(x + (size_t)m * D_) + F.lane; float s = 0.f;
#pragma unroll
          for (int j = 0; j < 4; ++j) { const f32x4 v = xr[64 * j]; s += (v[0] * v[0] + v[1] * v[1]) + (v[2] * v[2] + v[3] * v[3]);
              *((GAS f32x4*)(a.out + (size_t)m * D_) + F.lane + 64 * j) = v;
              u32x2v o; o.x = cvtpk(v[0], v[1]); o.y = cvtpk(v[2], v[3]); *((GAS u32x2v*)(hb + (size_t)m * D_) + F.lane + 64 * j) = o; }
          s = wave_sum(s);
          if (F.lane < 16) ssq[(size_t)m * 16 + F.lane] = (F.lane == 0) ? s : 0.f; } }
    { const int* pos = (const int*)a.in[2]; float* tab = (float*)(ws + WS_TAB);
#pragma unroll 1
      for (int idx = F.gw * 64 + F.lane; idx < S_ * 8; idx += F.NGW * 64) { const int row = idx >> 3, i = idx & 7;
          const float inv = exp2f(-(float)i * (18.931568569324174f / 8.0f));
          const float ang = (float)pos[row] * inv;
          double t = (double)ang * 0.15915494309189535; t -= rint(t); const float tf = (float)t;
          tab[(size_t)row * 16 + i] = __builtin_amdgcn_cosf(tf); tab[(size_t)row * 16 + 8 + i] = __builtin_amdgcn_sinf(tf); } }
}

__device__ __forceinline__ void p_mixprep(const Frame& F, const Args& a, int L) {
    GAS unsigned char* ws = (GAS unsigned char*)a.ws; asm volatile("" : "+s"(ws)); int lane_ = F.lane; asm volatile("" : "+v"(lane_)); const int j = L >> 1, lane = lane_;
    const bf16* AO = (const bf16*)(ws + WS_ARENA + AR_AO); const bf16* PE = (const bf16*)(ws + WS_ARENA + AR_PE); bf16* mix = (bf16*)(ws + WS_MIX);
    const float lam0 = 0.8f - 0.6f * expf(-0.3f * (float)L);
    float s1 = ((const float*)a.in[9])[j * 64 + lane] * ((const float*)a.in[10])[j * 64 + lane], s2 = ((const float*)a.in[11])[j * 64 + lane] * ((const float*)a.in[12])[j * 64 + lane];
    s1 = wave_sum(s1); s2 = wave_sum(s2);
    const float lam = expf(s1) - expf(s2) + lam0, post = 1.0f - lam0;
    const int hh = lane >> 4, dd = (lane & 15) * 8, ch = lane * 8;
    float sg[8], w0[8], w1[8], w2[8];
#pragma unroll
    for (int e = 0; e < 8; ++e) { sg[e] = ((const float*)a.in[13])[j * 128 + dd + e] * post;
        w0[e] = ((const float*)a.in[14])[(j * 3 + 0) * 512 + ch + e]; w1[e] = ((const float*)a.in[14])[(j * 3 + 1) * 512 + ch + e]; w2[e] = ((const float*)a.in[14])[(j * 3 + 2) * 512 + ch + e]; }
#pragma unroll 1
    for (int t = F.gw; t < S_; t += F.NGW) {
        const v4u o1 = *(const GAS v4u*)(AO + (size_t)t * D_ + 256 * hh + dd), o2 = *(const GAS v4u*)(AO + (size_t)t * D_ + 256 * hh + 128 + dd);
        float d[8]; const unsigned a1[4] = {o1.x, o1.y, o1.z, o1.w}, a2[4] = {o2.x, o2.y, o2.z, o2.w}; float ss = 0.f;
#pragma unroll
        for (int q = 0; q < 4; ++q) { d[2 * q] = bflo(a1[q]) - lam * bflo(a2[q]); d[2 * q + 1] = bfhi(a1[q]) - lam * bfhi(a2[q]); ss += d[2 * q] * d[2 * q] + d[2 * q + 1] * d[2 * q + 1]; }
        ss += __shfl_xor(ss, 1); ss += __shfl_xor(ss, 2); ss += __shfl_xor(ss, 4); ss += __shfl_xor(ss, 8);
        const float rms = __builtin_amdgcn_rsqf(ss * (1.0f / 128.0f) + 1e-5f);
        v4u o; o.x = cvtpk(d[0] * rms * sg[0], d[1] * rms * sg[1]); o.y = cvtpk(d[2] * rms * sg[2], d[3] * rms * sg[3]); o.z = cvtpk(d[4] * rms * sg[4], d[5] * rms * sg[5]); o.w = cvtpk(d[6] * rms * sg[6], d[7] * rms * sg[7]);
        *(GAS v4u*)(mix + (size_t)t * D_ + hh * 128 + dd) = o;
        const bf16* r0 = PE + (size_t)t * EIN;
        const v4u bb = *(const GAS v4u*)(r0 + 1536 + ch), c0 = *(const GAS v4u*)(r0 + 2048 + ch), x0 = *(const GAS v4u*)(r0 + 2560 + ch);
        v4u c1 = {0u, 0u, 0u, 0u}, x1 = c1, c2 = c1, x2 = c1;
        if (t >= 1) { c1 = *(const GAS v4u*)(r0 - EIN + 2048 + ch); x1 = *(const GAS v4u*)(r0 - EIN + 2560 + ch); }
        if (t >= 2) { c2 = *(const GAS v4u*)(r0 - 2 * EIN + 2048 + ch); x2 = *(const GAS v4u*)(r0 - 2 * EIN + 2560 + ch); }
        const unsigned B[4] = {bb.x, bb.y, bb.z, bb.w}, C0[4] = {c0.x, c0.y, c0.z, c0.w}, X0[4] = {x0.x, x0.y, x0.z, x0.w}, C1[4] = {c1.x, c1.y, c1.z, c1.w}, X1[4] = {x1.x, x1.y, x1.z, x1.w},
                       C2[4] = {c2.x, c2.y, c2.z, c2.w}, X2[4] = {x2.x, x2.y, x2.z, x2.w};
        float sc[8];
#pragma unroll
        for (int q = 0; q < 4; ++q) {
            sc[2 * q] = bflo(B[q]) * (w2[2 * q] * (bflo(C0[q]) * bflo(X0[q])) + w1[2 * q] * (bflo(C1[q]) * bflo(X1[q])) + w0[2 * q] * (bflo(C2[q]) * bflo(X2[q])));
            sc[2 * q + 1] = bfhi(B[q]) * (w2[2 * q + 1] * (bfhi(C0[q]) * bfhi(X0[q])) + w1[2 * q + 1] * (bfhi(C1[q]) * bfhi(X1[q])) + w0[2 * q + 1] * (bfhi(C2[q]) * bfhi(X2[q]))); }
        v4u so; so.x = cvtpk(sc[0], sc[1]); so.y = cvtpk(sc[2], sc[3]); so.z = cvtpk(sc[4], sc[5]); so.w = cvtpk(sc[6], sc[7]);
        *(GAS v4u*)(mix + (size_t)t * D_ + 512 + ch) = so;
    }
}


__device__ __forceinline__ void p_rot(const Frame& F, const Args& a) {
    GAS unsigned char* ws = (GAS unsigned char*)a.ws; asm volatile("" : "+s"(ws)); int lane_ = F.lane; asm volatile("" : "+v"(lane_)); const int lane = lane_;
    bf16* PE = (bf16*)(ws + WS_ARENA + AR_PE); const float* tab = (const float*)(ws + WS_TAB);
    const int hd = lane >> 2, i0 = 2 * (lane & 3), col = (hd < 8 ? hd * 64 : 512 + (hd - 8) * 64) + i0;
#pragma unroll 1
    for (int t = F.gw; t < S_; t += F.NGW) {
        GAS unsigned* p1 = (GAS unsigned*)(PE + (size_t)t * EIN + col); GAS unsigned* p2 = (GAS unsigned*)(PE + (size_t)t * EIN + col + 8);
        const unsigned w1 = *p1, w2 = *p2;
        const float c0 = tab[(size_t)t * 16 + i0], c1 = tab[(size_t)t * 16 + i0 + 1], s0 = tab[(size_t)t * 16 + 8 + i0], s1 = tab[(size_t)t * 16 + 8 + i0 + 1];
        const float a0 = bflo(w1), a1 = bfhi(w1), b0 = bflo(w2), b1 = bfhi(w2);
        *p1 = cvtpk(a0 * c0 - b0 * s0, a1 * c1 - b1 * s1); *p2 = cvtpk(b0 * c0 + a0 * s0, b1 * c1 + a1 * s1);
    }
}
__device__ __forceinline__ void tri_solve(const LAS float* Lc, LAS bf16* Xs, int lane) {
    float x0, x1, x2, x3, x4, x5, x6, x7, x8, x9, x10, x11, x12, x13, x14, x15, x16, x17, x18, x19, x20, x21, x22, x23, x24, x25, x26, x27, x28, x29, x30, x31, x32, x33, x34, x35, x36, x37, x38, x39, x40, x41, x42, x43, x44, x45, x46, x47, x48, x49, x50, x51, x52, x53, x54, x55, x56, x57, x58, x59, x60, x61, x62, x63;
    { x63 = (lane == 63) ? 1.0f : 0.0f; asm volatile("" : "+v"(x63) : : "memory"); }
    { float s0 = 0.f, s1 = 0.f, s2 = 0.f, s3 = 0.f; { const f32x4 l = *(const LAS f32x4*)(Lc + 4276); s3 = fmaf(x63, l[3], s3); } x62 = (lane == 62) ? 1.0f : -((s0 + s1) + (s2 + s3)); asm volatile("" : "+v"(x62) : : "memory"); }
    { float s0 = 0.f, s1 = 0.f, s2 = 0.f, s3 = 0.f; { const f32x4 l = *(const LAS f32x4*)(Lc + 4208); s2 = fmaf(x62, l[2], s2); s3 = fmaf(x63, l[3], s3); } x61 = (lane == 61) ? 1.0f : -((s0 + s1) + (s2 + s3)); asm volatile("" : "+v"(x61) : : "memory"); }
    { float s0 = 0.f, s1 = 0.f, s2 = 0.f, s3 = 0.f; { const f32x4 l = *(const LAS f32x4*)(Lc + 4140); s1 = fmaf(x61, l[1], s1); s2 = fmaf(x62, l[2], s2); s3 = fmaf(x63, l[3], s3); } x60 = (lane == 60) ? 1.0f : -((s0 + s1) + (s2 + s3)); asm volatile("" : "+v"(x60) : : "memory"); }
    { float s0 = 0.f, s1 = 0.f, s2 = 0.f, s3 = 0.f; { const f32x4 l = *(const LAS f32x4*)(Lc + 4072); s0 = fmaf(x60, l[0], s0); s1 = fmaf(x61, l[1], s1); s2 = fmaf(x62, l[2], s2); s3 = fmaf(x63, l[3], s3); } x59 = (lane == 59) ? 1.0f : -((s0 + s1) + (s2 + s3)); asm volatile("" : "+v"(x59) : : "memory"); }
    { float s0 = 0.f, s1 = 0.f, s2 = 0.f, s3 = 0.f; { const f32x4 l = *(const LAS f32x4*)(Lc + 4000); s3 = fmaf(x59, l[3], s3); } { const f32x4 l = *(const LAS f32x4*)(Lc + 4004); s0 = fmaf(x60, l[0], s0); s1 = fmaf(x61, l[1], s1); s2 = fmaf(x62, l[2], s2); s3 = fmaf(x63, l[3], s3); } x58 = (lane == 58) ? 1.0f : -((s0 + s1) + (s2 + s3)); asm volatile("" : "+v"(x58) : : "memory"); }
    { float s0 = 0.f, s1 = 0.f, s2 = 0.f, s3 = 0.f; { const f32x4 l = *(const LAS f32x4*)(Lc + 3932); s2 = fmaf(x58, l[2], s2); s3 = fmaf(x59, l[3], s3); } { const f32x4 l = *(const LAS f32x4*)(Lc + 3936); s0 = fmaf(x60, l[0], s0); s1 = fmaf(x61, l[1], s1); s2 = fmaf(x62, l[2], s2); s3 = fmaf(x63, l[3], s3); } x57 = (lane == 57) ? 1.0f : -((s0 + s1) + (s2 + s3)); asm volatile("" : "+v"(x57) : : "memory"); }
    { float s0 = 0.f, s1 = 0.f, s2 = 0.f, s3 = 0.f; { const f32x4 l = *(const LAS f32x4*)(Lc + 3864); s1 = fmaf(x57, l[1], s1); s2 = fmaf(x58, l[2], s2); s3 = fmaf(x59, l[3], s3); } { const f32x4 l = *(const LAS f32x4*)(Lc + 3868); s0 = fmaf(x60, l[0], s0); s1 = fmaf(x61, l[1], s1); s2 = fmaf(x62, l[2], s2); s3 = fmaf(x63, l[3], s3); } x56 = (lane == 56) ? 1.0f : -((s0 + s1) + (s2 + s3)); asm volatile("" : "+v"(x56) : : "memory"); }
    { float s0 = 0.f, s1 = 0.f, s2 = 0.f, s3 = 0.f; { const f32x4 l = *(const LAS f32x4*)(Lc + 3796); s0 = fmaf(x56, l[0], s0); s1 = fmaf(x57, l[1], s1); s2 = fmaf(x58, l[2], s2); s3 = fmaf(x59, l[3], s3); } { const f32x4 l = *(const LAS f32x4*)(Lc + 3800); s0 = fmaf(x60, l[0], s0); s1 = fmaf(x61, l[1], s1); s2 = fmaf(x62, l[2], s2); s3 = fmaf(x63, l[3], s3); } x55 = (lane == 55) ? 1.0f : -((s0 + s1) + (s2 + s3)); asm volatile("" : "+v"(x55) : : "memory"); }
    { float s0 = 0.f, s1 = 0.f, s2 = 0.f, s3 = 0.f; { const f32x4 l = *(const LAS f32x4*)(Lc + 3724); s3 = fmaf(x55, l[3], s3); } { const f32x4 l = *(const LAS f32x4*)(Lc + 3728); s0 = fmaf(x56, l[0], s0); s1 = fmaf(x57, l[1], s1); s2 = fmaf(x58, l[2], s2); s3 = fmaf(x59, l[3], s3); } { const f32x4 l = *(const LAS f32x4*)(Lc + 3732); s0 = fmaf(x60, l[0], s0); s1 = fmaf(x61, l[1], s1); s2 = fmaf(x62, l[2], s2); s3 = fmaf(x63, l[3], s3); } x54 = (lane == 54) ? 1.0f : -((s0 + s1) + (s2 + s3)); asm volatile("" : "+v"(x54) : : "memory"); }
    { float s0 = 0.f, s1 = 0.f, s2 = 0.f, s3 = 0.f; { const f32x4 l = *(const LAS f32x4*)(Lc + 3656); s2 = fmaf(x54, l[2], s2); s3 = fmaf(x55, l[3], s3); } { const f32x4 l = *(const LAS f32x4*)(Lc + 3660); s0 = fmaf(x56, l[0], s0); s1 = fmaf(x57, l[1], s1); s2 = fmaf(x58, l[2], s2); s3 = fmaf(x59, l[3], s3); } { const f32x4 l = *(const LAS f32x4*)(Lc + 3664); s0 = fmaf(x60, l[0], s0); s1 = fmaf(x61, l[1], s1); s2 = fmaf(x62, l[2], s2); s3 = fmaf(x63, l[3], s3); } x53 = (lane == 53) ? 1.0f : -((s0 + s1) + (s2 + s3)); asm volatile("" : "+v"(x53) : : "memory"); }
    { float s0 = 0.f, s1 = 0.f, s2 = 0.f, s3 = 0.f; { const f32x4 l = *(const LAS f32x4*)(Lc + 3588); s1 = fmaf(x53, l[1], s1); s2 = fmaf(x54, l[2], s2); s3 = fmaf(x55, l[3], s3); } { const f32x4 l = *(const LAS f32x4*)(Lc + 3592); s0 = fmaf(x56, l[0], s0); s1 = fmaf(x57, l[1], s1); s2 = fmaf(x58, l[2], s2); s3 = fmaf(x59, l[3], s3); } { const f32x4 l = *(const LAS f32x4*)(Lc + 3596); s0 = fmaf(x60, l[0], s0); s1 = fmaf(x61, l[1], s1); s2 = fmaf(x62, l[2], s2); s3 = fmaf(x63, l[3], s3); } x52 = (lane == 52) ? 1.0f : -((s0 + s1) + (s2 + s3)); asm volatile("" : "+v"(x52) : : "memory"); }
    { float s0 = 0.f, s1 = 0.f, s2 = 0.f, s3 = 0.f; { const f32x4 l = *(const LAS f32x4*)(Lc + 3520); s0 = fmaf(x52, l[0], s0); s1 = fmaf(x53, l[1], s1); s2 = fmaf(x54, l[2], s2); s3 = fmaf(x55, l[3], s3); } { const f32x4 l = *(const LAS f32x4*)(Lc + 3524); s0 = fmaf(x56, l[0], s0); s1 = fmaf(x57, l[1], s1); s2 = fmaf(x58, l[2], s2); s3 = fmaf(x59, l[3], s3); } { const f32x4 l = *(const LAS f32x4*)(Lc + 3528); s0 = fmaf(x60, l[0], s0); s1 = fmaf(x61, l[1], s1); s2 = fmaf(x62, l[2], s2); s3 = fmaf(x63, l[3], s3); } x51 = (lane == 51) ? 1.0f : -((s0 + s1) + (s2 + s3)); asm volatile("" : "+v"(x51) : : "memory"); }
    { float s0 = 0.f, s1 = 0.f, s2 = 0.f, s3 = 0.f; { const f32x4 l = *(const LAS f32x4*)(Lc + 3448); s3 = fmaf(x51, l[3], s3); } { const f32x4 l = *(const LAS f32x4*)(Lc + 3452); s0 = fmaf(x52, l[0], s0); s1 = fmaf(x53, l[1], s1); s2 = fmaf(x54, l[2], s2); s3 = fmaf(x55, l[3], s3); } { const f32x4 l = *(const LAS f32x4*)(Lc + 3456); s0 = fmaf(x56, l[0], s0); s1 = fmaf(x57, l[1], s1); s2 = fmaf(x58, l[2], s2); s3 = fmaf(x59, l[3], s3); } { const f32x4 l = *(const LAS f32x4*)(Lc + 3460); s0 = fmaf(x60, l[0], s0); s1 = fmaf(x61, l[1], s1); s2 = fmaf(x62, l[2], s2); s3 = fmaf(x63, l[3], s3); } x50 = (lane == 50) ? 1.0f : -((s0 + s1) + (s2 + s3)); asm volatile("" : "+v"(x50) : : "memory"); }
    { float s0 = 0.f, s1 = 0.f, s2 = 0.f, s3 = 0.f; { const f32x4 l = *(const LAS f32x4*)(Lc + 3380); s2 = fmaf(x50, l[2], s2); s3 = fmaf(x51, l[3], s3); } { const f32x4 l = *(const LAS f32x4*)(Lc + 3384); s0 = fmaf(x52, l[0], s0); s1 = fmaf(x53, l[1], s1); s2 = fmaf(x54, l[2], s2); s3 = fmaf(x55, l[3], s3); } { const f32x4 l = *(const LAS f32x4*)(Lc + 3388); s0 = fmaf(x56, l[0], s0); s1 = fmaf(x57, l[1], s1); s2 = fmaf(x58, l[2], s2); s3 = fmaf(x59, l[3], s3); } { const f32x4 l = *(const LAS f32x4*)(Lc + 3392); s0 = fmaf(x60, l[0], s0); s1 = fmaf(x61, l[1], s1); s2 = fmaf(x62, l[2], s2); s3 = fmaf(x63, l[3], s3); } x49 = (lane == 49) ? 1.0f : -((s0 + s1) + (s2 + s3)); asm volatile("" : "+v"(x49) : : "memory"); }
    { float s0 = 0.f, s1 = 0.f, s2 = 0.f, s3 = 0.f; { const f32x4 l = *(const LAS f32x4*)(Lc + 3312); s1 = fmaf(x49, l[1], s1); s2 = fmaf(x50, l[2], s2); s3 = fmaf(x51, l[3], s3); } { const f32x4 l = *(const LAS f32x4*)(Lc + 3316); s0 = fmaf(x52, l[0], s0); s1 = fmaf(x53, l[1], s1); s2 = fmaf(x54, l[2], s2); s3 = fmaf(x55, l[3], s3); } { const f32x4 l = *(const LAS f32x4*)(Lc + 3320); s0 = fmaf(x56, l[0], s0); s1 = fmaf(x57, l[1], s1); s2 = fmaf(x58, l[2], s2); s3 = fmaf(x59, l[3], s3); } { const f32x4 l = *(const LAS f32x4*)(Lc + 3324); s0 = fmaf(x60, l[0], s0); s1 = fmaf(x61, l[1], s1); s2 = fmaf(x62, l[2], s2); s3 = fmaf(x63, l[3], s3); } x48 = (lane == 48) ? 1.0f : -((s0 + s1) + (s2 + s3)); asm volatile("" : "+v"(x48) : : "memory"); }
    { float s0 = 0.f, s1 = 0.f, s2 = 0.f, s3 = 0.f; { const f32x4 l = *(const LAS f32x4*)(Lc + 3244); s0 = fmaf(x48, l[0], s0); s1 = fmaf(x49, l[1], s1); s2 = fmaf(x50, l[2], s2); s3 = fmaf(x51, l[3], s3); } { const f32x4 l = *(const LAS f32x4*)(Lc + 3248); s0 = fmaf(x52, l[0], s0); s1 = fmaf(x53, l[1], s1); s2 = fmaf(x54, l[2], s2); s3 = fmaf(x55, l[3], s3); } { const f32x4 l = *(const LAS f32x4*)(Lc + 3252); s0 = fmaf(x56, l[0], s0); s1 = fmaf(x57, l[1], s1); s2 = fmaf(x58, l[2], s2); s3 = fmaf(x59, l[3], s3); } { const f32x4 l = *(const LAS f32x4*)(Lc + 3256); s0 = fmaf(x60, l[0], s0); s1 = fmaf(x61, l[1], s1); s2 = fmaf(x62, l[2], s2); s3 = fmaf(x63, l[3], s3); } x47 = (lane == 47) ? 1.0f : -((s0 + s1) + (s2 + s3)); asm volatile("" : "+v"(x47) : : "memory"); }
    { float s0 = 0.f, s1 = 0.f, s2 = 0.f, s3 = 0.f; { const f32x4 l = *(const LAS f32x4*)(Lc + 3172); s3 = fmaf(x47, l[3], s3); } { const f32x4 l = *(const LAS f32x4*)(Lc + 3176); s0 = fmaf(x48, l[0], s0); s1 = fmaf(x49, l[1], s1); s2 = fmaf(x50, l[2], s2); s3 = fmaf(x51, l[3], s3); } { const f32x4 l = *(const LAS f32x4*)(Lc + 3180); s0 = fmaf(x52, l[0], s0); s1 = fmaf(x53, l[1], s1); s2 = fmaf(x54, l[2], s2); s3 = fmaf(x55, l[3], s3); } { const f32x4 l = *(const LAS f32x4*)(Lc + 3184); s0 = fmaf(x56, l[0], s0); s1 = fmaf(x57, l[1], s1); s2 = fmaf(x58, l[2], s2); s3 = fmaf(x59, l[3], s3); } { const f32x4 l = *(const LAS f32x4*)(Lc + 3188); s0 = fmaf(x60, l[0], s0); s1 = fmaf(x61, l[1], s1); s2 = fmaf(x62, l[2], s2); s3 = fmaf(x63, l[3], s3); } x46 = (lane == 46) ? 1.0f : -((s0 + s1) + (s2 + s3)); asm volatile("" : "+v"(x46) : : "memory"); }
    { float s0 = 0.f, s1 = 0.f, s2 = 0.f, s3 = 0.f; { const f32x4 l = *(const LAS f32x4*)(Lc + 3104); s2 = fmaf(x46, l[2], s2); s3 = fmaf(x47, l[3], s3); } { const f32x4 l = *(const LAS f32x4*)(Lc + 3108); s0 = fmaf(x48, l[0], s0); s1 = fmaf(x49, l[1], s1); s2 = fmaf(x50, l[2], s2); s3 = fmaf(x51, l[3], s3); } { const f32x4 l = *(const LAS f32x4*)(Lc + 3112); s0 = fmaf(x52, l[0], s0); s1 = fmaf(x53, l[1], s1); s2 = fmaf(x54, l[2], s2); s3 = fmaf(x55, l[3], s3); } { const f32x4 l = *(const LAS f32x4*)(Lc + 3116); s0 = fmaf(x56, l[0], s0); s1 = fmaf(x57, l[1], s1); s2 = fmaf(x58, l[2], s2); s3 = fmaf(x59, l[3], s3); } { const f32x4 l = *(const LAS f32x4*)(Lc + 3120); s0 = fmaf(x60, l[0], s0); s1 = fmaf(x61, l[1], s1); s2 = fmaf(x62, l[2], s2); s3 = fmaf(x63, l[3], s3); } x45 = (lane == 45) ? 1.0f : -((s0 + s1) + (s2 + s3)); asm volatile("" : "+v"(x45) : : "memory"); }
    { float s0 = 0.f, s1 = 0.f, s2 = 0.f, s3 = 0.f; { const f32x4 l = *(const LAS f32x4*)(Lc + 3036); s1 = fmaf(x45, l[1], s1); s2 = fmaf(x46, l[2], s2); s3 = fmaf(x47, l[3], s3); } { const f32x4 l = *(const LAS f32x4*)(Lc + 3040); s0 = fmaf(x48, l[0], s0); s1 = fmaf(x49, l[1], s1); s2 = fmaf(x50, l[2], s2); s3 = fmaf(x51, l[3], s3); } { const f32x4 l = *(const LAS f32x4*)(Lc + 3044); s0 = fmaf(x52, l[0], s0); s1 = fmaf(x53, l[1], s1); s2 = fmaf(x54, l[2], s2); s3 = fmaf(x55, l[3], s3); } { const f32x4 l = *(const LAS f32x4*)(Lc + 3048); s0 = fmaf(x56, l[0], s0); s1 = fmaf(x57, l[1], s1); s2 = fmaf(x58, l[2], s2); s3 = fmaf(x59, l[3], s3); } { const f32x4 l = *(const LAS f32x4*)(Lc + 3052); s0 = fmaf(x60, l[0], s0); s1 = fmaf(x61, l[1], s1); s2 = fmaf(x62, l[2], s2); s3 = fmaf(x63, l[3], s3); } x44 = (lane == 44) ? 1.0f : -((s0 + s1) + (s2 + s3)); asm volatile("" : "+v"(x44) : : "memory"); }
    { float s0 = 0.f, s1 = 0.f, s2 = 0.f, s3 = 0.f; { const f32x4 l = *(const LAS f32x4*)(Lc + 2968); s0 = fmaf(x44, l[0], s0); s1 = fmaf(x45, l[1], s1); s2 = fmaf(x46, l[2], s2); s3 = fmaf(x47, l[3], s3); } { const f32x4 l = *(const LAS f32x4*)(Lc + 2972); s0 = fmaf(x48, l[0], s0); s1 = fmaf(x49, l[1], s1); s2 = fmaf(x50, l[2], s2); s3 = fmaf(x51, l[3], s3); } { const f32x4 l = *(const LAS f32x4*)(Lc + 2976); s0 = fmaf(x52, l[0], s0); s1 = fmaf(x53, l[1], s1); s2 = fmaf(x54, l[2], s2); s3 = fmaf(x55, l[3], s3); } { const f32x4 l = *(const LAS f32x4*)(Lc + 2980); s0 = fmaf(x56, l[0], s0); s1 = fmaf(x57, l[1], s1); s2 = fmaf(x58, l[2], s2); s3 = fmaf(x59, l[3], s3); } { const f32x4 l = *(const LAS f32x4*)(Lc + 2984); s0 = fmaf(x60, l[0], s0); s1 = fmaf(x61, l[1], s1); s2 = fmaf(x62, l[2], s2); s3 = fmaf(x63, l[3], s3); } x43 = (lane == 43) ? 1.0f : -((s0 + s1) + (s2 + s3)); asm volatile("" : "+v"(x43) : : "memory"); }
    { float s0 = 0.f, s1 = 0.f, s2 = 0.f, s3 = 0.f; { const f32x4 l = *(const LAS f32x4*)(Lc + 2896); s3 = fmaf(x43, l[3], s3); } { const f32x4 l = *(const LAS f32x4*)(Lc + 2900); s0 = fmaf(x44, l[0], s0); s1 = fmaf(x45, l[1], s1); s2 = fmaf(x46, l[2], s2); s3 = fmaf(x47, l[3], s3); } { const f32x4 l = *(const LAS f32x4*)(Lc + 2904); s0 = fmaf(x48, l[0], s0); s1 = fmaf(x49, l[1], s1); s2 = fmaf(x50, l[2], s2); s3 = fmaf(x51, l[3], s3); } { const f32x4 l = *(const LAS f32x4*)(Lc + 2908); s0 = fmaf(x52, l[0], s0); s1 = fmaf(x53, l[1], s1); s2 = fmaf(x54, l[2], s2); s3 = fmaf(x55, l[3], s3); } { const f32x4 l = *(const LAS f32x4*)(Lc + 2912); s0 = fmaf(x56, l[0], s0); s1 = fmaf(x57, l[1], s1); s2 = fmaf(x58, l[2], s2); s3 = fmaf(x59, l[3], s3); } { const f32x4 l = *(const LAS f32x4*)(Lc + 2916); s0 = fmaf(x60, l[0], s0); s1 = fmaf(x61, l[1], s1); s2 = fmaf(x62, l[2], s2); s3 = fmaf(x63, l[3], s3); } x42 = (lane == 42) ? 1.0f : -((s0 + s1) + (s2 + s3)); asm volatile("" : "+v"(x42) : : "memory"); }
    { float s0 = 0.f, s1 = 0.f, s2 = 0.f, s3 = 0.f; { const f32x4 l = *(const LAS f32x4*)(Lc + 2828); s2 = fmaf(x42, l[2], s2); s3 = fmaf(x43, l[3], s3); } { const f32x4 l = *(const LAS f32x4*)(Lc + 2832); s0 = fmaf(x44, l[0], s0); s1 = fmaf(x45, l[1], s1); s2 = fmaf(x46, l[2], s2); s3 = fmaf(x47, l[3], s3); } { const f32x4 l = *(const LAS f32x4*)(Lc + 2836); s0 = fmaf(x48, l[0], s0); s1 = fmaf(x49, l[1], s1); s2 = fmaf(x50, l[2], s2); s3 = fmaf(x51, l[3], s3); } { const f32x4 l = *(const LAS f32x4*)(Lc + 2840); s0 = fmaf(x52, l[0], s0); s1 = fmaf(x53, l[1], s1); s2 = fmaf(x54, l[2], s2); s3 = fmaf(x55, l[3], s3); } { const f32x4 l = *(const LAS f32x4*)(Lc + 2844); s0 = fmaf(x56, l[0], s0); s1 = fmaf(x57, l[1], s1); s2 = fmaf(x58, l[2], s2); s3 = fmaf(x59, l[3], s3); } { const f32x4 l = *(const LAS f32x4*)(Lc + 2848); s0 = fmaf(x60, l[0], s0); s1 = fmaf(x61, l[1], s1); s2 = fmaf(x62, l[2], s2); s3 = fmaf(x63, l[3], s3); } x41 = (lane == 41) ? 1.0f : -((s0 + s1) + (s2 + s3)); asm volatile("" : "+v"(x41) : : "memory"); }
    { float s0 = 0.f, s1 = 0.f, s2 = 0.f, s3 = 0.f; { const f32x4 l = *(const LAS f32x4*)(Lc + 2760); s1 = fmaf(x41, l[1], s1); s2 = fmaf(x42, l[2], s2); s3 = fmaf(x43, l[3], s3); } { const f32x4 l = *(const LAS f32x4*)(Lc + 2764); s0 = fmaf(x44, l[0], s0); s1 = fmaf(x45, l[1], s1); s2 = fmaf(x46, l[2], s2); s3 = fmaf(x47, l[3], s3); } { const f32x4 l = *(const LAS f32x4*)(Lc + 2768); s0 = fmaf(x48, l[0], s0); s1 = fmaf(x49, l[1], s1); s2 = fmaf(x50, l[2], s2); s3 = fmaf(x51, l[3], s3); } { const f32x4 l = *(const LAS f32x4*)(Lc + 2772); s0 = fmaf(x52, l[0], s0); s1 = fmaf(x53, l[1], s1); s2 = fmaf(x54, l[2], s2); s3 = fmaf(x55, l[3], s3); } { const f32x4 l = *(const LAS f32x4*)(Lc + 2776); s0 = fmaf(x56, l[0], s0); s1 = fmaf(x57, l[1], s1); s2 = fmaf(x58, l[2], s2); s3 = fmaf(x59, l[3], s3); } { const f32x4 l = *(const LAS f32x4*)(Lc + 2780); s0 = fmaf(x60, l[0], s0); s1 = fmaf(x61, l[1], s1); s2 = fmaf(x62, l[2], s2); s3 = fmaf(x63, l[3], s3); } x40 = (lane == 40) ? 1.0f : -((s0 + s1) + (s2 + s3)); asm volatile("" : "+v"(x40) : : "memory"); }
    { float s0 = 0.f, s1 = 0.f, s2 = 0.f, s3 = 0.f; { const f32x4 l = *(const LAS f32x4*)(Lc + 2692); s0 = fmaf(x40, l[0], s0); s1 = fmaf(x41, l[1], s1); s2 = fmaf(x42, l[2], s2); s3 = fmaf(x43, l[3], s3); } { const f32x4 l = *(const LAS f32x4*)(Lc + 2696); s0 = fmaf(x44, l[0], s0); s1 = fmaf(x45, l[1], s1); s2 = fmaf(x46, l[2], s2); s3 = fmaf(x47, l[3], s3); } { const f32x4 l = *(const LAS f32x4*)(Lc + 2700); s0 = fmaf(x48, l[0], s0); s1 = fmaf(x49, l[1], s1); s2 = fmaf(x50, l[2], s2); s3 = fmaf(x51, l[3], s3); } { const f32x4 l = *(const LAS f32x4*)(Lc + 2704); s0 = fmaf(x52, l[0], s0); s1 = fmaf(x53, l[1], s1); s2 = fmaf(x54, l[2], s2); s3 = fmaf(x55, l[3], s3); } { const f32x4 l = *(const LAS f32x4*)(Lc + 2708); s0 = fmaf(x56, l[0], s0); s1 = fmaf(x57, l[1], s1); s2 = fmaf(x58, l[2], s2); s3 = fmaf(x59, l[3], s3); } { const f32x4 l = *(const LAS f32x4*)(Lc + 2712); s0 = fmaf(x60, l[0], s0); s1 = fmaf(x61, l[1], s1); s2 = fmaf(x62, l[2], s2); s3 = fmaf(x63, l[3], s3); } x39 = (lane == 39) ? 1.0f : -((s0 + s1) + (s2 + s3)); asm volatile("" : "+v"(x39) : : "memory"); }
    { float s0 = 0.f, s1 = 0.f, s2 = 0.f, s3 = 0.f; { const f32x4 l = *(const LAS f32x4*)(Lc + 2620); s3 = fmaf(x39, l[3], s3); } { const f32x4 l = *(const LAS f32x4*)(Lc + 2624); s0 = fmaf(x40, l[0], s0); s1 = fmaf(x41, l[1], s1); s2 = fmaf(x42, l[2], s2); s3 = fmaf(x43, l[3], s3); } { const f32x4 l = *(const LAS f32x4*)(Lc + 2628); s0 = fmaf(x44, l[0], s0); s1 = fmaf(x45, l[1], s1); s2 = fmaf(x46, l[2], s2); s3 = fmaf(x47, l[3], s3); } { const f32x4 l = *(const LAS f32x4*)(Lc + 2632); s0 = fmaf(x48, l[0], s0); s1 = fmaf(x49, l[1], s1); s2 = fmaf(x50, l[2], s2); s3 = fmaf(x51, l[3], s3); } { const f32x4 l = *(const LAS f32x4*)(Lc + 2636); s0 = fmaf(x52, l[0], s0); s1 = fmaf(x53, l[1], s1); s2 = fmaf(x54, l[2], s2); s3 = fmaf(x55, l[3], s3); } { const f32x4 l = *(const LAS f32x4*)(Lc + 2640); s0 = fmaf(x56, l[0], s0); s1 = fmaf(x57, l[1], s1); s2 = fmaf(x58, l[2], s2); s3 = fmaf(x59, l[3], s3); } { const f32x4 l = *(const LAS f32x4*)(Lc + 2644); s0 = fmaf(x60, l[0], s0); s1 = fmaf(x61, l[1], s1); s2 = fmaf(x62, l[2], s2); s3 = fmaf(x63, l[3], s3); } x38 = (lane == 38) ? 1.0f : -((s0 + s1) + (s2 + s3)); asm volatile("" : "+v"(x38) : : "memory"); }
    { float s0 = 0.f, s1 = 0.f, s2 = 0.f, s3 = 0.f; { const f32x4 l = *(const LAS f32x4*)(Lc + 2552); s2 = fmaf(x38, l[2], s2); s3 = fmaf(x39, l[3], s3); } { const f32x4 l = *(const LAS f32x4*)(Lc + 2556); s0 = fmaf(x40, l[0], s0); s1 = fmaf(x41, l[1], s1); s2 = fmaf(x42, l[2], s2); s3 = fmaf(x43, l[3], s3); } { const f32x4 l = *(const LAS f32x4*)(Lc + 2560); s0 = fmaf(x44, l[0], s0); s1 = fmaf(x45, l[1], s1); s2 = fmaf(x46, l[2], s2); s3 = fmaf(x47, l[3], s3); } { const f32x4 l = *(const LAS f32x4*)(Lc + 2564); s0 = fmaf(x48, l[0], s0); s1 = fmaf(x49, l[1], s1); s2 = fmaf(x50, l[2], s2); s3 = fmaf(x51, l[3], s3); } { const f32x4 l = *(const LAS f32x4*)(Lc + 2568); s0 = fmaf(x52, l[0], s0); s1 = fmaf(x53, l[1], s1); s2 = fmaf(x54, l[2], s2); s3 = fmaf(x55, l[3], s3); } { const f32x4 l = *(const LAS f32x4*)(Lc + 2572); s0 = fmaf(x56, l[0], s0); s1 = fmaf(x57, l[1], s1); s2 = fmaf(x58, l[2], s2); s3 = fmaf(x59, l[3], s3); } { const f32x4 l = *(const LAS f32x4*)(Lc + 2576); s0 = fmaf(x60, l[0], s0); s1 = fmaf(x61, l[1], s1); s2 = fmaf(x62, l[2], s2); s3 = fmaf(x63, l[3], s3); } x37 = (lane == 37) ? 1.0f : -((s0 + s1) + (s2 + s3)); asm volatile("" : "+v"(x37) : : "memory"); }
    { float s0 = 0.f, s1 = 0.f, s2 = 0.f, s3 = 0.f; { const f32x4 l = *(const LAS f32x4*)(Lc + 2484); s1 = fmaf(x37, l[1], s1); s2 = fmaf(x38, l[2], s2); s3 = fmaf(x39, l[3], s3); } { const f32x4 l = *(const LAS f32x4*)(Lc + 2488); s0 = fmaf(x40, l[0], s0); s1 = fmaf(x41, l[1], s1); s2 = fmaf(x42, l[2], s2); s3 = fmaf(x43, l[3], s3); } { const f32x4 l = *(const LAS f32x4*)(Lc + 2492); s0 = fmaf(x44, l[0], s0); s1 = fmaf(x45, l[1], s1); s2 = fmaf(x46, l[2], s2); s3 = fmaf(x47, l[3], s3); } { const f32x4 l = *(const LAS f32x4*)(Lc + 2496); s0 = fmaf(x48, l[0], s0); s1 = fmaf(x49, l[1], s1); s2 = fmaf(x50, l[2], s2); s3 = fmaf(x51, l[3], s3); } { const f32x4 l = *(const LAS f32x4*)(Lc + 2500); s0 = fmaf(x52, l[0], s0); s1 = fmaf(x53, l[1], s1); s2 = fmaf(x54, l[2], s2); s3 = fmaf(x55, l[3], s3); } { const f32x4 l = *(const LAS f32x4*)(Lc + 2504); s0 = fmaf(x56, l[0], s0); s1 = fmaf(x57, l[1], s1); s2 = fmaf(x58, l[2], s2); s3 = fmaf(x59, l[3], s3); } { const f32x4 l = *(const LAS f32x4*)(Lc + 2508); s0 = fmaf(x60, l[0], s0); s1 = fmaf(x61, l[1], s1); s2 = fmaf(x62, l[2], s2); s3 = fmaf(x63, l[3], s3); } x36 = (lane == 36) ? 1.0f : -((s0 + s1) + (s2 + s3)); asm volatile("" : "+v"(x36) : : "memory"); }
    { float s0 = 0.f, s1 = 0.f, s2 = 0.f, s3 = 0.f; { const f32x4 l = *(const LAS f32x4*)(Lc + 2416); s0 = fmaf(x36, l[0], s0); s1 = fmaf(x37, l[1], s1); s2 = fmaf(x38, l[2], s2); s3 = fmaf(x39, l[3], s3); } { const f32x4 l = *(const LAS f32x4*)(Lc + 2420); s0 = fmaf(x40, l[0], s0); s1 = fmaf(x41, l[1], s1); s2 = fmaf(x42, l[2], s2); s3 = fmaf(x43, l[3], s3); } { const f32x4 l = *(const LAS f32x4*)(Lc + 2424); s0 = fmaf(x44, l[0], s0); s1 = fmaf(x45, l[1], s1); s2 = fmaf(x46, l[2], s2); s3 = fmaf(x47, l[3], s3); } { const f32x4 l = *(const LAS f32x4*)(Lc + 2428); s0 = fmaf(x48, l[0], s0); s1 = fmaf(x49, l[1], s1); s2 = fmaf(x50, l[2], s2); s3 = fmaf(x51, l[3], s3); } { const f32x4 l = *(const LAS f32x4*)(Lc + 2432); s0 = fmaf(x52, l[0], s0); s1 = fmaf(x53, l[1], s1); s2 = fmaf(x54, l[2], s2); s3 = fmaf(x55, l[3], s3); } { const f32x4 l = *(const LAS f32x4*)(Lc + 2436); s0 = fmaf(x56, l[0], s0); s1 = fmaf(x57, l[1], s1); s2 = fmaf(x58, l[2], s2); s3 = fmaf(x59, l[3], s3); } { const f32x4 l = *(const LAS f32x4*)(Lc + 2440); s0 = fmaf(x60, l[0], s0); s1 = fmaf(x61, l[1], s1); s2 = fmaf(x62, l[2], s2); s3 = fmaf(x63, l[3], s3); } x35 = (lane == 35) ? 1.0f : -((s0 + s1) + (s2 + s3)); asm volatile("" : "+v"(x35) : : "memory"); }
    { float s0 = 0.f, s1 = 0.f, s2 = 0.f, s3 = 0.f; { const f32x4 l = *(const LAS f32x4*)(Lc + 2344); s3 = fmaf(x35, l[3], s3); } { const f32x4 l = *(const LAS f32x4*)(Lc + 2348); s0 = fmaf(x36, l[0], s0); s1 = fmaf(x37, l[1], s1); s2 = fmaf(x38, l[2], s2); s3 = fmaf(x39, l[3], s3); } { const f32x4 l = *(const LAS f32x4*)(Lc + 2352); s0 = fmaf(x40, l[0], s0); s1 = fmaf(x41, l[1], s1); s2 = fmaf(x42, l[2], s2); s3 = fmaf(x43, l[3], s3); } { const f32x4 l = *(const LAS f32x4*)(Lc + 2356); s0 = fmaf(x44, l[0], s0); s1 = fmaf(x45, l[1], s1); s2 = fmaf(x46, l[2], s2); s3 = fmaf(x47, l[3], s3); } { const f32x4 l = *(const LAS f32x4*)(Lc + 2360); s0 = fmaf(x48, l[0], s0); s1 = fmaf(x49, l[1], s1); s2 = fmaf(x50, l[2], s2); s3 = fmaf(x51, l[3], s3); } { const f32x4 l = *(const LAS f32x4*)(Lc + 2364); s0 = fmaf(x52, l[0], s0); s1 = fmaf(x53, l[1], s1); s2 = fmaf(x54, l[2], s2); s3 = fmaf(x55, l[3], s3); } { const f32x4 l = *(const LAS f32x4*)(Lc + 2368); s0 = fmaf(x56, l[0], s0); s1 = fmaf(x57, l[1], s1); s2 = fmaf(x58, l[2], s2); s3 = fmaf(x59, l[3], s3); } { const f32x4 l = *(const LAS f32x4*)(Lc + 2372); s0 = fmaf(x60, l[0], s0); s1 = fmaf(x61, l[1], s1); s2 = fmaf(x62, l[2], s2); s3 = fmaf(x63, l[3], s3); } x34 = (lane == 34) ? 1.0f : -((s0 + s1) + (s2 + s3)); asm volatile("" : "+v"(x34) : : "memory"); }
    { float s0 = 0.f, s1 = 0.f, s2 = 0.f, s3 = 0.f; { const f32x4 l = *(const LAS f32x4*)(Lc + 2276); s2 = fmaf(x34, l[2], s2); s3 = fmaf(x35, l[3], s3); } { const f32x4 l = *(const LAS f32x4*)(Lc + 2280); s0 = fmaf(x36, l[0], s0); s1 = fmaf(x37, l[1], s1); s2 = fmaf(x38, l[2], s2); s3 = fmaf(x39, l[3], s3); } { const f32x4 l = *(const LAS f32x4*)(Lc + 2284); s0 = fmaf(x40, l[0], s0); s1 = fmaf(x41, l[1], s1); s2 = fmaf(x42, l[2], s2); s3 = fmaf(x43, l[3], s3); } { const f32x4 l = *(const LAS f32x4*)(Lc + 2288); s0 = fmaf(x44, l[0], s0); s1 = fmaf(x45, l[1], s1); s2 = fmaf(x46, l[2], s2); s3 = fmaf(x47, l[3], s3); } { const f32x4 l = *(const LAS f32x4*)(Lc + 2292); s0 = fmaf(x48, l[0], s0); s1 = fmaf(x49, l[1], s1); s2 = fmaf(x50, l[2], s2); s3 = fmaf(x51, l[3], s3); } { const f32x4 l = *(const LAS f32x4*)(Lc + 2296); s0 = fmaf(x52, l[0], s0); s1 = fmaf(x53, l[1], s1); s2 = fmaf(x54, l[2], s2); s3 = fmaf(x55, l[3], s3); } { const f32x4 l = *(const LAS f32x4*)(Lc + 2300); s0 = fmaf(x56, l[0], s0); s1 = fmaf(x57, l[1], s1); s2 = fmaf(x58, l[2], s2); s3 = fmaf(x59, l[3], s3); } { const f32x4 l = *(const LAS f32x4*)(Lc + 2304); s0 = fmaf(x60, l[0], s0); s1 = fmaf(x61, l[1], s1); s2 = fmaf(x62, l[2], s2); s3 = fmaf(x63, l[3], s3); } x33 = (lane == 33) ? 1.0f : -((s0 + s1) + (s2 + s3)); asm volatile("" : "+v"(x33) : : "memory"); }
    { float s0 = 0.f, s1 = 0.f, s2 = 0.f, s3 = 0.f; { const f32x4 l = *(const LAS f32x4*)(Lc + 2208); s1 = fmaf(x33, l[1], s1); s2 = fmaf(x34, l[2], s2); s3 = fmaf(x35, l[3], s3); } { const f32x4 l = *(const LAS f32x4*)(Lc + 2212); s0 = fmaf(x36, l[0], s0); s1 = fmaf(x37, l[1], s1); s2 = fmaf(x38, l[2], s2); s3 = fmaf(x39, l[3], s3); } { const f32x4 l = *(const LAS f32x4*)(Lc + 2216); s0 = fmaf(x40, l[0], s0); s1 = fmaf(x41, l[1], s1); s2 = fmaf(x42, l[2], s2); s3 = fmaf(x43, l[3], s3); } { const f32x4 l = *(const LAS f32x4*)(Lc + 2220); s0 = fmaf(x44, l[0], s0); s1 = fmaf(x45, l[1], s1); s2 = fmaf(x46, l[2], s2); s3 = fmaf(x47, l[3], s3); } { const f32x4 l = *(const LAS f32x4*)(Lc + 2224); s0 = fmaf(x48, l[0], s0); s1 = fmaf(x49, l[1], s1); s2 = fmaf(x50, l[2], s2); s3 = fmaf(x51, l[3], s3); } { const f32x4 l = *(const LAS f32x4*)(Lc + 2228); s0 = fmaf(x52, l[0], s0); s1 = fmaf(x53, l[1], s1); s2 = fmaf(x54, l[2], s2); s3 = fmaf(x55, l[3], s3); } { const f32x4 l = *(const LAS f32x4*)(Lc + 2232); s0 = fmaf(x56, l[0], s0); s1 = fmaf(x57, l[1], s1); s2 = fmaf(x58, l[2], s2); s3 = fmaf(x59, l[3], s3); } { const f32x4 l = *(const LAS f32x4*)(Lc + 2236); s0 = fmaf(x60, l[0], s0); s1 = fmaf(x61, l[1], s1); s2 = fmaf(x62, l[2], s2); s3 = fmaf(x63, l[3], s3); } x32 = (lane == 32) ? 1.0f : -((s0 + s1) + (s2 + s3)); asm volatile("" : "+v"(x32) : : "memory"); }
    { float s0 = 0.f, s1 = 0.f, s2 = 0.f, s3 = 0.f; { const f32x4 l = *(const LAS f32x4*)(Lc + 2140); s0 = fmaf(x32, l[0], s0); s1 = fmaf(x33, l[1], s1); s2 = fmaf(x34, l[2], s2); s3 = fmaf(x35, l[3], s3); } { const f32x4 l = *(const LAS f32x4*)(Lc + 2144); s0 = fmaf(x36, l[0], s0); s1 = fmaf(x37, l[1], s1); s2 = fmaf(x38, l[2], s2); s3 = fmaf(x39, l[3], s3); } { const f32x4 l = *(const LAS f32x4*)(Lc + 2148); s0 = fmaf(x40, l[0], s0); s1 = fmaf(x41, l[1], s1); s2 = fmaf(x42, l[2], s2); s3 = fmaf(x43, l[3], s3); } { const f32x4 l = *(const LAS f32x4*)(Lc + 2152); s0 = fmaf(x44, l[0], s0); s1 = fmaf(x45, l[1], s1); s2 = fmaf(x46, l[2], s2); s3 = fmaf(x47, l[3], s3); } { const f32x4 l = *(const LAS f32x4*)(Lc + 2156); s0 = fmaf(x48, l[0], s0); s1 = fmaf(x49, l[1], s1); s2 = fmaf(x50, l[2], s2); s3 = fmaf(x51, l[3], s3); } { const f32x4 l = *(const LAS f32x4*)(Lc + 2160); s0 = fmaf(x52, l[0], s0); s1 = fmaf(x53, l[1], s1); s2 = fmaf(x54, l[2], s2); s3 = fmaf(x55, l[3], s3); } { const f32x4 l = *(const LAS f32x4*)(Lc + 2164); s0 = fmaf(x56, l[0], s0); s1 = fmaf(x57, l[1], s1); s2 = fmaf(x58, l[2], s2); s3 = fmaf(x59, l[3], s3); } { const f32x4 l = *(const LAS f32x4*)(Lc + 2168); s0 = fmaf(x60, l[0], s0); s1 = fmaf(x61, l[1], s1); s2 = fmaf(x62, l[2], s2); s3 = fmaf(x63, l[3], s3); } x31 = (lane == 31) ? 1.0f : -((s0 + s1) + (s2 + s3)); asm volatile("" : "+v"(x31) : : "memory"); }
    { float s0 = 0.f, s1 = 0.f, s2 = 0.f, s3 = 0.f; { const f32x4 l = *(const LAS f32x4*)(Lc + 2068); s3 = fmaf(x31, l[3], s3); } { const f32x4 l = *(const LAS f32x4*)(Lc + 2072); s0 = fmaf(x32, l[0], s0); s1 = fmaf(x33, l[1], s1); s2 = fmaf(x34, l[2], s2); s3 = fmaf(x35, l[3], s3); } { const f32x4 l = *(const LAS f32x4*)(Lc + 2076); s0 = fmaf(x36, l[0], s0); s1 = fmaf(x37, l[1], s1); s2 = fmaf(x38, l[2], s2); s3 = fmaf(x39, l[3], s3); } { const f32x4 l = *(const LAS f32x4*)(Lc + 2080); s0 = fmaf(x40, l[0], s0); s1 = fmaf(x41, l[1], s1); s2 = fmaf(x42, l[2], s2); s3 = fmaf(x43, l[3], s3); } { const f32x4 l = *(const LAS f32x4*)(Lc + 2084); s0 = fmaf(x44, l[0], s0); s1 = fmaf(x45, l[1], s1); s2 = fmaf(x46, l[2], s2); s3 = fmaf(x47, l[3], s3); } { const f32x4 l = *(const LAS f32x4*)(Lc + 2088); s0 = fmaf(x48, l[0], s0); s1 = fmaf(x49, l[1], s1); s2 = fmaf(x50, l[2], s2); s3 = fmaf(x51, l[3], s3); } { const f32x4 l = *(const LAS f32x4*)(Lc + 2092); s0 = fmaf(x52, l[0], s0); s1 = fmaf(x53, l[1], s1); s2 = fmaf(x54, l[2], s2); s3 = fmaf(x55, l[3], s3); } { const f32x4 l = *(const LAS f32x4*)(Lc + 2096); s0 = fmaf(x56, l[0], s0); s1 = fmaf(x57, l[1], s1); s2 = fmaf(x58, l[2], s2); s3 = fmaf(x59, l[3], s3); } { const f32x4 l = *(const LAS f32x4*)(Lc + 2100); s0 = fmaf(x60, l[0], s0); s1 = fmaf(x61, l[1], s1); s2 = fmaf(x62, l[2], s2); s3 = fmaf(x63, l[3], s3); } x30 = (lane == 30) ? 1.0f : -((s0 + s1) + (s2 + s3)); asm volatile("" : "+v"(x30) : : "memory"); }
    { float s0 = 0.f, s1 = 0.f, s2 = 0.f, s3 = 0.f; { const f32x4 l = *(const LAS f32x4*)(Lc + 2000); s2 = fmaf(x30, l[2], s2); s3 = fmaf(x31, l[3], s3); } { const f32x4 l = *(const LAS f32x4*)(Lc + 2004); s0 = fmaf(x32, l[0], s0); s1 = fmaf(x33, l[1], s1); s2 = fmaf(x34, l[2], s2); s3 = fmaf(x35, l[3], s3); } { const f32x4 l = *(const LAS f32x4*)(Lc + 2008); s0 = fmaf(x36, l[0], s0); s1 = fmaf(x37, l[1], s1); s2 = fmaf(x38, l[2], s2); s3 = fmaf(x39, l[3], s3); } { const f32x4 l = *(const LAS f32x4*)(Lc + 2012); s0 = fmaf(x40, l[0], s0); s1 = fmaf(x41, l[1], s1); s2 = fmaf(x42, l[2], s2); s3 = fmaf(x43, l[3], s3); } { const f32x4 l = *(const LAS f32x4*)(Lc + 2016); s0 = fmaf(x44, l[0], s0); s1 = fmaf(x45, l[1], s1); s2 = fmaf(x46, l[2], s2); s3 = fmaf(x47, l[3], s3); } { const f32x4 l = *(const LAS f32x4*)(Lc + 2020); s0 = fmaf(x48, l[0], s0); s1 = fmaf(x49, l[1], s1); s2 = fmaf(x50, l[2], s2); s3 = fmaf(x51, l[3], s3); } { const f32x4 l = *(const LAS f32x4*)(Lc + 2024); s0 = fmaf(x52, l[0], s0); s1 = fmaf(x53, l[1], s1); s2 = fmaf(x54, l[2], s2); s3 = fmaf(x55, l[3], s3); } { const f32x4 l = *(const LAS f32x4*)(Lc + 2028); s0 = fmaf(x56, l[0], s0); s1 = fmaf(x57, l[1], s1); s2 = fmaf(x58, l[2], s2); s3 = fmaf(x59, l[3], s3); } { const f32x4 l = *(const LAS f32x4*)(Lc + 2032); s0 = fmaf(x60, l[0], s0); s1 = fmaf(x61, l[1], s1); s2 = fmaf(x62, l[2], s2); s3 = fmaf(x63, l[3], s3); } x29 = (lane == 29) ? 1.0f : -((s0 + s1) + (s2 + s3)); asm volatile("" : "+v"(x29) : : "memory"); }
    { float s0 = 0.f, s1 = 0.f, s2 = 0.f, s3 = 0.f; { const f32x4 l = *(const LAS f32x4*)(Lc + 1932); s1 = fmaf(x29, l[1], s1); s2 = fmaf(x30, l[2], s2); s3 = fmaf(x31, l[3], s3); } { const f32x4 l = *(const LAS f32x4*)(Lc + 1936); s0 = fmaf(x32, l[0], s0); s1 = fmaf(x33, l[1], s1); s2 = fmaf(x34, l[2], s2); s3 = fmaf(x35, l[3], s3); } { const f32x4 l = *(const LAS f32x4*)(Lc + 1940); s0 = fmaf(x36, l[0], s0); s1 = fmaf(x37, l[1], s1); s2 = fmaf(x38, l[2], s2); s3 = fmaf(x39, l[3], s3); } { const f32x4 l = *(const LAS f32x4*)(Lc + 1944); s0 = fmaf(x40, l[0], s0); s1 = fmaf(x41, l[1], s1); s2 = fmaf(x42, l[2], s2); s3 = fmaf(x43, l[3], s3); } { const f32x4 l = *(const LAS f32x4*)(Lc + 1948); s0 = fmaf(x44, l[0], s0); s1 = fmaf(x45, l[1], s1); s2 = fmaf(x46, l[2], s2); s3 = fmaf(x47, l[3], s3); } { const f32x4 l = *(const LAS f32x4*)(Lc + 1952); s0 = fmaf(x48, l[0], s0); s1 = fmaf(x49, l[1], s1); s2 = fmaf(x50, l[2], s2); s3 = fmaf(x51, l[3], s3); } { const f32x4 l = *(const LAS f32x4*)(Lc + 1956); s0 = fmaf(x52, l[0], s0); s1 = fmaf(x53, l[1], s1); s2 = fmaf(x54, l[2], s2); s3 = fmaf(x55, l[3], s3); } { const f32x4 l = *(const LAS f32x4*)(Lc + 1960); s0 = fmaf(x56, l[0], s0); s1 = fmaf(x57, l[1], s1); s2 = fmaf(x58, l[2], s2); s3 = fmaf(x59, l[3], s3); } { const f32x4 l = *(const LAS f32x4*)(Lc + 1964); s0 = fmaf(x60, l[0], s0); s1 = fmaf(x61, l[1], s1); s2 = fmaf(x62, l[2], s2); s3 = fmaf(x63, l[3], s3); } x28 = (lane == 28) ? 1.0f : -((s0 + s1) + (s2 + s3)); asm volatile("" : "+v"(x28) : : "memory"); }
    { float s0 = 0.f, s1 = 0.f, s2 = 0.f, s3 = 0.f; { const f32x4 l = *(const LAS f32x4*)(Lc + 1864); s0 = fmaf(x28, l[0], s0); s1 = fmaf(x29, l[1], s1); s2 = fmaf(x30, l[2], s2); s3 = fmaf(x31, l[3], s3); } { const f32x4 l = *(const LAS f32x4*)(Lc + 1868); s0 = fmaf(x32, l[0], s0); s1 = fmaf(x33, l[1], s1); s2 = fmaf(x34, l[2], s2); s3 = fmaf(x35, l[3], s3); } { const f32x4 l = *(const LAS f32x4*)(Lc + 1872); s0 = fmaf(x36, l[0], s0); s1 = fmaf(x37, l[1], s1); s2 = fmaf(x38, l[2], s2); s3 = fmaf(x39, l[3], s3); } { const f32x4 l = *(const LAS f32x4*)(Lc + 1876); s0 = fmaf(x40, l[0], s0); s1 = fmaf(x41, l[1], s1); s2 = fmaf(x42, l[2], s2); s3 = fmaf(x43, l[3], s3); } { const f32x4 l = *(const LAS f32x4*)(Lc + 1880); s0 = fmaf(x44, l[0], s0); s1 = fmaf(x45, l[1], s1); s2 = fmaf(x46, l[2], s2); s3 = fmaf(x47, l[3], s3); } { const f32x4 l = *(const LAS f32x4*)(Lc + 1884); s0 = fmaf(x48, l[0], s0); s1 = fmaf(x49, l[1], s1); s2 = fmaf(x50, l[2], s2); s3 = fmaf(x51, l[3], s3); } { const f32x4 l = *(const LAS f32x4*)(Lc + 1888); s0 = fmaf(x52, l[0], s0); s1 = fmaf(x53, l[1], s1); s2 = fmaf(x54, l[2], s2); s3 = fmaf(x55, l[3], s3); } { const f32x4 l = *(const LAS f32x4*)(Lc + 1892); s0 = fmaf(x56, l[0], s0); s1 = fmaf(x57, l[1], s1); s2 = fmaf(x58, l[2], s2); s3 = fmaf(x59, l[3], s3); } { const f32x4 l = *(const LAS f32x4*)(Lc + 1896); s0 = fmaf(x60, l[0], s0); s1 = fmaf(x61, l[1], s1); s2 = fmaf(x62, l[2], s2); s3 = fmaf(x63, l[3], s3); } x27 = (lane == 27) ? 1.0f : -((s0 + s1) + (s2 + s3)); asm volatile("" : "+v"(x27) : : "memory"); }
    { float s0 = 0.f, s1 = 0.f, s2 = 0.f, s3 = 0.f; { const f32x4 l = *(const LAS f32x4*)(Lc + 1792); s3 = fmaf(x27, l[3], s3); } { const f32x4 l = *(const LAS f32x4*)(Lc + 1796); s0 = fmaf(x28, l[0], s0); s1 = fmaf(x29, l[1], s1); s2 = fmaf(x30, l[2], s2); s3 = fmaf(x31, l[3], s3); } { const f32x4 l = *(const LAS f32x4*)(Lc + 1800); s0 = fmaf(x32, l[0], s0); s1 = fmaf(x33, l[1], s1); s2 = fmaf(x34, l[2], s2); s3 = fmaf(x35, l[3], s3); } { const f32x4 l = *(const LAS f32x4*)(Lc + 1804); s0 = fmaf(x36, l[0], s0); s1 = fmaf(x37, l[1], s1); s2 = fmaf(x38, l[2], s2); s3 = fmaf(x39, l[3], s3); } { const f32x4 l = *(const LAS f32x4*)(Lc + 1808); s0 = fmaf(x40, l[0], s0); s1 = fmaf(x41, l[1], s1); s2 = fmaf(x42, l[2], s2); s3 = fmaf(x43, l[3], s3); } { const f32x4 l = *(const LAS f32x4*)(Lc + 1812); s0 = fmaf(x44, l[0], s0); s1 = fmaf(x45, l[1], s1); s2 = fmaf(x46, l[2], s2); s3 = fmaf(x47, l[3], s3); } { const f32x4 l = *(const LAS f32x4*)(Lc + 1816); s0 = fmaf(x48, l[0], s0); s1 = fmaf(x49, l[1], s1); s2 = fmaf(x50, l[2], s2); s3 = fmaf(x51, l[3], s3); } { const f32x4 l = *(const LAS f32x4*)(Lc + 1820); s0 = fmaf(x52, l[0], s0); s1 = fmaf(x53, l[1], s1); s2 = fmaf(x54, l[2], s2); s3 = fmaf(x55, l[3], s3); } { const f32x4 l = *(const LAS f32x4*)(Lc + 1824); s0 = fmaf(x56, l[0], s0); s1 = fmaf(x57, l[1], s1); s2 = fmaf(x58, l[2], s2); s3 = fmaf(x59, l[3], s3); } { const f32x4 l = *(const LAS f32x4*)(Lc + 1828); s0 = fmaf(x60, l[0], s0); s1 = fmaf(x61, l[1], s1); s2 = fmaf(x62, l[2], s2); s3 = fmaf(x63, l[3], s3); } x26 = (lane == 26) ? 1.0f : -((s0 + s1) + (s2 + s3)); asm volatile("" : "+v"(x26) : : "memory"); }
    { float s0 = 0.f, s1 = 0.f, s2 = 0.f, s3 = 0.f; { const f32x4 l = *(const LAS f32x4*)(Lc + 1724); s2 = fmaf(x26, l[2], s2); s3 = fmaf(x27, l[3], s3); } { const f32x4 l = *(const LAS f32x4*)(Lc + 1728); s0 = fmaf(x28, l[0], s0); s1 = fmaf(x29, l[1], s1); s2 = fmaf(x30, l[2], s2); s3 = fmaf(x31, l[3], s3); } { const f32x4 l = *(const LAS f32x4*)(Lc + 1732); s0 = fmaf(x32, l[0], s0); s1 = fmaf(x33, l[1], s1); s2 = fmaf(x34, l[2], s2); s3 = fmaf(x35, l[3], s3); } { const f32x4 l = *(const LAS f32x4*)(Lc + 1736); s0 = fmaf(x36, l[0], s0); s1 = fmaf(x37, l[1], s1); s2 = fmaf(x38, l[2], s2); s3 = fmaf(x39, l[3], s3); } { const f32x4 l = *(const LAS f32x4*)(Lc + 1740); s0 = fmaf(x40, l[0], s0); s1 = fmaf(x41, l[1], s1); s2 = fmaf(x42, l[2], s2); s3 = fmaf(x43, l[3], s3); } { const f32x4 l = *(const LAS f32x4*)(Lc + 1744); s0 = fmaf(x44, l[0], s0); s1 = fmaf(x45, l[1], s1); s2 = fmaf(x46, l[2], s2); s3 = fmaf(x47, l[3], s3); } { const f32x4 l = *(const LAS f32x4*)(Lc + 1748); s0 = fmaf(x48, l[0], s0); s1 = fmaf(x49, l[1], s1); s2 = fmaf(x50, l[2], s2); s3 = fmaf(x51, l[3], s3); } { const f32x4 l = *(const LAS f32x4*)(Lc + 1752); s0 = fmaf(x52, l[0], s0); s1 = fmaf(x53, l[1], s1); s2 = fmaf(x54, l[2], s2); s3 = fmaf(x55, l[3], s3); } { const f32x4 l = *(const LAS f32x4*)(Lc + 1756); s0 = fmaf(x56, l[0], s0); s1 = fmaf(x57, l[1], s1); s2 = fmaf(x58, l[2], s2); s3 = fmaf(x59, l[3], s3); } { const f32x4 l = *(const LAS f32x4*)(Lc + 1760); s0 = fmaf(x60, l[0], s0); s1 = fmaf(x61, l[1], s1); s2 = fmaf(x62, l[2], s2); s3 = fmaf(x63, l[3], s3); } x25 = (lane == 25) ? 1.0f : -((s0 + s1) + (s2 + s3)); asm volatile("" : "+v"(x25) : : "memory"); }
    { float s0 = 0.f, s1 = 0.f, s2 = 0.f, s3 = 0.f; { const f32x4 l = *(const LAS f32x4*)(Lc + 1656); s1 = fmaf(x25, l[1], s1); s2 = fmaf(x26, l[2], s2); s3 = fmaf(x27, l[3], s3); } { const f32x4 l = *(const LAS f32x4*)(Lc + 1660); s0 = fmaf(x28, l[0], s0); s1 = fmaf(x29, l[1], s1); s2 = fmaf(x30, l[2], s2); s3 = fmaf(x31, l[3], s3); } { const f32x4 l = *(const LAS f32x4*)(Lc + 1664); s0 = fmaf(x32, l[0], s0); s1 = fmaf(x33, l[1], s1); s2 = fmaf(x34, l[2], s2); s3 = fmaf(x35, l[3], s3); } { const f32x4 l = *(const LAS f32x4*)(Lc + 1668); s0 = fmaf(x36, l[0], s0); s1 = fmaf(x37, l[1], s1); s2 = fmaf(x38, l[2], s2); s3 = fmaf(x39, l[3], s3); } { const f32x4 l = *(const LAS f32x4*)(Lc + 1672); s0 = fmaf(x40, l[0], s0); s1 = fmaf(x41, l[1], s1); s2 = fmaf(x42, l[2], s2); s3 = fmaf(x43, l[3], s3); } { const f32x4 l = *(const LAS f32x4*)(Lc + 1676); s0 = fmaf(x44, l[0], s0); s1 = fmaf(x45, l[1], s1); s2 = fmaf(x46, l[2], s2); s3 = fmaf(x47, l[3], s3); } { const f32x4 l = *(const LAS f32x4*)(Lc + 1680); s0 = fmaf(x48, l[0], s0); s1 = fmaf(x49, l[1], s1); s2 = fmaf(x50, l[2], s2); s3 = fmaf(x51, l[3], s3); } { const f32x4 l = *(const LAS f32x4*)(Lc + 1684); s0 = fmaf(x52, l[0], s0); s1 = fmaf(x53, l[1], s1); s2 = fmaf(x54, l[2], s2); s3 = fmaf(x55, l[3], s3); } { const f32x4 l = *(const LAS f32x4*)(Lc + 1688); s0 = fmaf(x56, l[0], s0); s1 = fmaf(x57, l[1], s1); s2 = fmaf(x58, l[2], s2); s3 = fmaf(x59, l[3], s3); } { const f32x4 l = *(const LAS f32x4*)(Lc + 1692); s0 = fmaf(x60, l[0], s0); s1 = fmaf(x61, l[1], s1); s2 = fmaf(x62, l[2], s2); s3 = fmaf(x63, l[3], s3); } x24 = (lane == 24) ? 1.0f : -((s0 + s1) + (s2 + s3)); asm volatile("" : "+v"(x24) : : "memory"); }
    { float s0 = 0.f, s1 = 0.f, s2 = 0.f, s3 = 0.f; { const f32x4 l = *(const LAS f32x4*)(Lc + 1588); s0 = fmaf(x24, l[0], s0); s1 = fmaf(x25, l[1], s1); s2 = fmaf(x26, l[2], s2); s3 = fmaf(x27, l[3], s3); } { const f32x4 l = *(const LAS f32x4*)(Lc + 1592); s0 = fmaf(x28, l[0], s0); s1 = fmaf(x29, l[1], s1); s2 = fmaf(x30, l[2], s2); s3 = fmaf(x31, l[3], s3); } { const f32x4 l = *(const LAS f32x4*)(Lc + 1596); s0 = fmaf(x32, l[0], s0); s1 = fmaf(x33, l[1], s1); s2 = fmaf(x34, l[2], s2); s3 = fmaf(x35, l[3], s3); } { const f32x4 l = *(const LAS f32x4*)(Lc + 1600); s0 = fmaf(x36, l[0], s0); s1 = fmaf(x37, l[1], s1); s2 = fmaf(x38, l[2], s2); s3 = fmaf(x39, l[3], s3); } { const f32x4 l = *(const LAS f32x4*)(Lc + 1604); s0 = fmaf(x40, l[0], s0); s1 = fmaf(x41, l[1], s1); s2 = fmaf(x42, l[2], s2); s3 = fmaf(x43, l[3], s3); } { const f32x4 l = *(const LAS f32x4*)(Lc + 1608); s0 = fmaf(x44, l[0], s0); s1 = fmaf(x45, l[1], s1); s2 = fmaf(x46, l[2], s2); s3 = fmaf(x47, l[3], s3); } { const f32x4 l = *(const LAS f32x4*)(Lc + 1612); s0 = fmaf(x48, l[0], s0); s1 = fmaf(x49, l[1], s1); s2 = fmaf(x50, l[2], s2); s3 = fmaf(x51, l[3], s3); } { const f32x4 l = *(const LAS f32x4*)(Lc + 1616); s0 = fmaf(x52, l[0], s0); s1 = fmaf(x53, l[1], s1); s2 = fmaf(x54, l[2], s2); s3 = fmaf(x55, l[3], s3); } { const f32x4 l = *(const LAS f32x4*)(Lc + 1620); s0 = fmaf(x56, l[0], s0); s1 = fmaf(x57, l[1], s1); s2 = fmaf(x58, l[2], s2); s3 = fmaf(x59, l[3], s3); } { const f32x4 l = *(const LAS f32x4*)(Lc + 1624); s0 = fmaf(x60, l[0], s0); s1 = fmaf(x61, l[1], s1); s2 = fmaf(x62, l[2], s2); s3 = fmaf(x63, l[3], s3); } x23 = (lane == 23) ? 1.0f : -((s0 + s1) + (s2 + s3)); asm volatile("" : "+v"(x23) : : "memory"); }
    { float s0 = 0.f, s1 = 0.f, s2 = 0.f, s3 = 0.f; { const f32x4 l = *(const LAS f32x4*)(Lc + 1516); s3 = fmaf(x23, l[3], s3); } { const f32x4 l = *(const LAS f32x4*)(Lc + 1520); s0 = fmaf(x24, l[0], s0); s1 = fmaf(x25, l[1], s1); s2 = fmaf(x26, l[2], s2); s3 = fmaf(x27, l[3], s3); } { const f32x4 l = *(const LAS f32x4*)(Lc + 1524); s0 = fmaf(x28, l[0], s0); s1 = fmaf(x29, l[1], s1); s2 = fmaf(x30, l[2], s2); s3 = fmaf(x31, l[3], s3); } { const f32x4 l = *(const LAS f32x4*)(Lc + 1528); s0 = fmaf(x32, l[0], s0); s1 = fmaf(x33, l[1], s1); s2 = fmaf(x34, l[2], s2); s3 = fmaf(x35, l[3], s3); } { const f32x4 l = *(const LAS f32x4*)(Lc + 1532); s0 = fmaf(x36, l[0], s0); s1 = fmaf(x37, l[1], s1); s2 = fmaf(x38, l[2], s2); s3 = fmaf(x39, l[3], s3); } { const f32x4 l = *(const LAS f32x4*)(Lc + 1536); s0 = fmaf(x40, l[0], s0); s1 = fmaf(x41, l[1], s1); s2 = fmaf(x42, l[2], s2); s3 = fmaf(x43, l[3], s3); } { const f32x4 l = *(const LAS f32x4*)(Lc + 1540); s0 = fmaf(x44, l[0], s0); s1 = fmaf(x45, l[1], s1); s2 = fmaf(x46, l[2], s2); s3 = fmaf(x47, l[3], s3); } { const f32x4 l = *(const LAS f32x4*)(Lc + 1544); s0 = fmaf(x48, l[0], s0); s1 = fmaf(x49, l[1], s1); s2 = fmaf(x50, l[2], s2); s3 = fmaf(x51, l[3], s3); } { const f32x4 l = *(const LAS f32x4*)(Lc + 1548); s0 = fmaf(x52, l[0], s0); s1 = fmaf(x53, l[1], s1); s2 = fmaf(x54, l[2], s2); s3 = fmaf(x55, l[3], s3); } { const f32x4 l = *(const LAS f32x4*)(Lc + 1552); s0 = fmaf(x56, l[0], s0); s1 = fmaf(x57, l[1], s1); s2 = fmaf(x58, l[2], s2); s3 = fmaf(x59, l[3], s3); } { const f32x4 l = *(const LAS f32x4*)(Lc + 1556); s0 = fmaf(x60, l[0], s0); s1 = fmaf(x61, l[1], s1); s2 = fmaf(x62, l[2], s2); s3 = fmaf(x63, l[3], s3); } x22 = (lane == 22) ? 1.0f : -((s0 + s1) + (s2 + s3)); asm volatile("" : "+v"(x22) : : "memory"); }
    { float s0 = 0.f, s1 = 0.f, s2 = 0.f, s3 = 0.f; { const f32x4 l = *(const LAS f32x4*)(Lc + 1448); s2 = fmaf(x22, l[2], s2); s3 = fmaf(x23, l[3], s3); } { const f32x4 l = *(const LAS f32x4*)(Lc + 1452); s0 = fmaf(x24, l[0], s0); s1 = fmaf(x25, l[1], s1); s2 = fmaf(x26, l[2], s2); s3 = fmaf(x27, l[3], s3); } { const f32x4 l = *(const LAS f32x4*)(Lc + 1456); s0 = fmaf(x28, l[0], s0); s1 = fmaf(x29, l[1], s1); s2 = fmaf(x30, l[2], s2); s3 = fmaf(x31, l[3], s3); } { const f32x4 l = *(const LAS f32x4*)(Lc + 1460); s0 = fmaf(x32, l[0], s0); s1 = fmaf(x33, l[1], s1); s2 = fmaf(x34, l[2], s2); s3 = fmaf(x35, l[3], s3); } { const f32x4 l = *(const LAS f32x4*)(Lc + 1464); s0 = fmaf(x36, l[0], s0); s1 = fmaf(x37, l[1], s1); s2 = fmaf(x38, l[2], s2); s3 = fmaf(x39, l[3], s3); } { const f32x4 l = *(const LAS f32x4*)(Lc + 1468); s0 = fmaf(x40, l[0], s0); s1 = fmaf(x41, l[1], s1); s2 = fmaf(x42, l[2], s2); s3 = fmaf(x43, l[3], s3); } { const f32x4 l = *(const LAS f32x4*)(Lc + 1472); s0 = fmaf(x44, l[0], s0); s1 = fmaf(x45, l[1], s1); s2 = fmaf(x46, l[2], s2); s3 = fmaf(x47, l[3], s3); } { const f32x4 l = *(const LAS f32x4*)(Lc + 1476); s0 = fmaf(x48, l[0], s0); s1 = fmaf(x49, l[1], s1); s2 = fmaf(x50, l[2], s2); s3 = fmaf(x51, l[3], s3); } { const f32x4 l = *(const LAS f32x4*)(Lc + 1480); s0 = fmaf(x52, l[0], s0); s1 = fmaf(x53, l[1], s1); s2 = fmaf(x54, l[2], s2); s3 = fmaf(x55, l[3], s3); } { const f32x4 l = *(const LAS f32x4*)(Lc + 1484); s0 = fmaf(x56, l[0], s0); s1 = fmaf(x57, l[1], s1); s2 = fmaf(x58, l[2], s2); s3 = fmaf(x59, l[3], s3); } { const f32x4 l = *(const LAS f32x4*)(Lc + 1488); s0 = fmaf(x60, l[0], s0); s1 = fmaf(x61, l[1], s1); s2 = fmaf(x62, l[2], s2); s3 = fmaf(x63, l[3], s3); } x21 = (lane == 21) ? 1.0f : -((s0 + s1) + (s2 + s3)); asm volatile("" : "+v"(x21) : : "memory"); }
    { float s0 = 0.f, s1 = 0.f, s2 = 0.f, s3 = 0.f; { const f32x4 l = *(const LAS f32x4*)(Lc + 1380); s1 = fmaf(x21, l[1], s1); s2 = fmaf(x22, l[2], s2); s3 = fmaf(x23, l[3], s3); } { const f32x4 l = *(const LAS f32x4*)(Lc + 1384); s0 = fmaf(x24, l[0], s0); s1 = fmaf(x25, l[1], s1); s2 = fmaf(x26, l[2], s2); s3 = fmaf(x27, l[3], s3); } { const f32x4 l = *(const LAS f32x4*)(Lc + 1388); s0 = fmaf(x28, l[0], s0); s1 = fmaf(x29, l[1], s1); s2 = fmaf(x30, l[2], s2); s3 = fmaf(x31, l[3], s3); } { const f32x4 l = *(const LAS f32x4*)(Lc + 1392); s0 = fmaf(x32, l[0], s0); s1 = fmaf(x33, l[1], s1); s2 = fmaf(x34, l[2], s2); s3 = fmaf(x35, l[3], s3); } { const f32x4 l = *(const LAS f32x4*)(Lc + 1396); s0 = fmaf(x36, l[0], s0); s1 = fmaf(x37, l[1], s1); s2 = fmaf(x38, l[2], s2); s3 = fmaf(x39, l[3], s3); } { const f32x4 l = *(const LAS f32x4*)(Lc + 1400); s0 = fmaf(x40, l[0], s0); s1 = fmaf(x41, l[1], s1); s2 = fmaf(x42, l[2], s2); s3 = fmaf(x43, l[3], s3); } { const f32x4 l = *(const LAS f32x4*)(Lc + 1404); s0 = fmaf(x44, l[0], s0); s1 = fmaf(x45, l[1], s1); s2 = fmaf(x46, l[2], s2); s3 = fmaf(x47, l[3], s3); } { const f32x4 l = *(const LAS f32x4*)(Lc + 1408); s0 = fmaf(x48, l[0], s0); s1 = fmaf(x49, l[1], s1); s2 = fmaf(x50, l[2], s2); s3 = fmaf(x51, l[3], s3); } { const f32x4 l = *(const LAS f32x4*)(Lc + 1412); s0 = fmaf(x52, l[0], s0); s1 = fmaf(x53, l[1], s1); s2 = fmaf(x54, l[2], s2); s3 = fmaf(x55, l[3], s3); } { const f32x4 l = *(const LAS f32x4*)(Lc + 1416); s0 = fmaf(x56, l[0], s0); s1 = fmaf(x57, l[1], s1); s2 = fmaf(x58, l[2], s2); s3 = fmaf(x59, l[3], s3); } { const f32x4 l = *(const LAS f32x4*)(Lc + 1420); s0 = fmaf(x60, l[0], s0); s1 = fmaf(x61, l[1], s1); s2 = fmaf(x62, l[2], s2); s3 = fmaf(x63, l[3], s3); } x20 = (lane == 20) ? 1.0f : -((s0 + s1) + (s2 + s3)); asm volatile("" : "+v"(x20) : : "memory"); }
    { float s0 = 0.f, s1 = 0.f, s2 = 0.f, s3 = 0.f; { const f32x4 l = *(const LAS f32x4*)(Lc + 1312); s0 = fmaf(x20, l[0], s0); s1 = fmaf(x21, l[1], s1); s2 = fmaf(x22, l[2], s2); s3 = fmaf(x23, l[3], s3); } { const f32x4 l = *(const LAS f32x4*)(Lc + 1316); s0 = fmaf(x24, l[0], s0); s1 = fmaf(x25, l[1], s1); s2 = fmaf(x26, l[2], s2); s3 = fmaf(x27, l[3], s3); } { const f32x4 l = *(const LAS f32x4*)(Lc + 1320); s0 = fmaf(x28, l[0], s0); s1 = fmaf(x29, l[1], s1); s2 = fmaf(x30, l[2], s2); s3 = fmaf(x31, l[3], s3); } { const f32x4 l = *(const LAS f32x4*)(Lc + 1324); s0 = fmaf(x32, l[0], s0); s1 = fmaf(x33, l[1], s1); s2 = fmaf(x34, l[2], s2); s3 = fmaf(x35, l[3], s3); } { const f32x4 l = *(const LAS f32x4*)(Lc + 1328); s0 = fmaf(x36, l[0], s0); s1 = fmaf(x37, l[1], s1); s2 = fmaf(x38, l[2], s2); s3 = fmaf(x39, l[3], s3); } { const f32x4 l = *(const LAS f32x4*)(Lc + 1332); s0 = fmaf(x40, l[0], s0); s1 = fmaf(x41, l[1], s1); s2 = fmaf(x42, l[2], s2); s3 = fmaf(x43, l[3], s3); } { const f32x4 l = *(const LAS f32x4*)(Lc + 1336); s0 = fmaf(x44, l[0], s0); s1 = fmaf(x45, l[1], s1); s2 = fmaf(x46, l[2], s2); s3 = fmaf(x47, l[3], s3); } { const f32x4 l = *(const LAS f32x4*)(Lc + 1340); s0 = fmaf(x48, l[0], s0); s1 = fmaf(x49, l[1], s1); s2 = fmaf(x50, l[2], s2); s3 = fmaf(x51, l[3], s3); } { const f32x4 l = *(const LAS f32x4*)(Lc + 1344); s0 = fmaf(x52, l[0], s0); s1 = fmaf(x53, l[1], s1); s2 = fmaf(x54, l[2], s2); s3 = fmaf(x55, l[3], s3); } { const f32x4 l = *(const LAS f32x4*)(Lc + 1348); s0 = fmaf(x56, l[0], s0); s1 = fmaf(x57, l[1], s1); s2 = fmaf(x58, l[2], s2); s3 = fmaf(x59, l[3], s3); } { const f32x4 l = *(const LAS f32x4*)(Lc + 1352); s0 = fmaf(x60, l[0], s0); s1 = fmaf(x61, l[1], s1); s2 = fmaf(x62, l[2], s2); s3 = fmaf(x63, l[3], s3); } x19 = (lane == 19) ? 1.0f : -((s0 + s1) + (s2 + s3)); asm volatile("" : "+v"(x19) : : "memory"); }
    { float s0 = 0.f, s1 = 0.f, s2 = 0.f, s3 = 0.f; { const f32x4 l = *(const LAS f32x4*)(Lc + 1240); s3 = fmaf(x19, l[3], s3); } { const f32x4 l = *(const LAS f32x4*)(Lc + 1244); s0 = fmaf(x20, l[0], s0); s1 = fmaf(x21, l[1], s1); s2 = fmaf(x22, l[2], s2); s3 = fmaf(x23, l[3], s3); } { const f32x4 l = *(const LAS f32x4*)(Lc + 1248); s0 = fmaf(x24, l[0], s0); s1 = fmaf(x25, l[1], s1); s2 = fmaf(x26, l[2], s2); s3 = fmaf(x27, l[3], s3); } { const f32x4 l = *(const LAS f32x4*)(Lc + 1252); s0 = fmaf(x28, l[0], s0); s1 = fmaf(x29, l[1], s1); s2 = fmaf(x30, l[2], s2); s3 = fmaf(x31, l[3], s3); } { const f32x4 l = *(const LAS f32x4*)(Lc + 1256); s0 = fmaf(x32, l[0], s0); s1 = fmaf(x33, l[1], s1); s2 = fmaf(x34, l[2], s2); s3 = fmaf(x35, l[3], s3); } { const f32x4 l = *(const LAS f32x4*)(Lc + 1260); s0 = fmaf(x36, l[0], s0); s1 = fmaf(x37, l[1], s1); s2 = fmaf(x38, l[2], s2); s3 = fmaf(x39, l[3], s3); } { const f32x4 l = *(const LAS f32x4*)(Lc + 1264); s0 = fmaf(x40, l[0], s0); s1 = fmaf(x41, l[1], s1); s2 = fmaf(x42, l[2], s2); s3 = fmaf(x43, l[3], s3); } { const f32x4 l = *(const LAS f32x4*)(Lc + 1268); s0 = fmaf(x44, l[0], s0); s1 = fmaf(x45, l[1], s1); s2 = fmaf(x46, l[2], s2); s3 = fmaf(x47, l[3], s3); } { const f32x4 l = *(const LAS f32x4*)(Lc + 1272); s0 = fmaf(x48, l[0], s0); s1 = fmaf(x49, l[1], s1); s2 = fmaf(x50, l[2], s2); s3 = fmaf(x51, l[3], s3); } { const f32x4 l = *(const LAS f32x4*)(Lc + 1276); s0 = fmaf(x52, l[0], s0); s1 = fmaf(x53, l[1], s1); s2 = fmaf(x54, l[2], s2); s3 = fmaf(x55, l[3], s3); } { const f32x4 l = *(const LAS f32x4*)(Lc + 1280); s0 = fmaf(x56, l[0], s0); s1 = fmaf(x57, l[1], s1); s2 = fmaf(x58, l[2], s2); s3 = fmaf(x59, l[3], s3); } { const f32x4 l = *(const LAS f32x4*)(Lc + 1284); s0 = fmaf(x60, l[0], s0); s1 = fmaf(x61, l[1], s1); s2 = fmaf(x62, l[2], s2); s3 = fmaf(x63, l[3], s3); } x18 = (lane == 18) ? 1.0f : -((s0 + s1) + (s2 + s3)); asm volatile("" : "+v"(x18) : : "memory"); }
    { float s0 = 0.f, s1 = 0.f, s2 = 0.f, s3 = 0.f; { const f32x4 l = *(const LAS f32x4*)(Lc + 1172); s2 = fmaf(x18, l[2], s2); s3 = fmaf(x19, l[3], s3); } { const f32x4 l = *(const LAS f32x4*)(Lc + 1176); s0 = fmaf(x20, l[0], s0); s1 = fmaf(x21, l[1], s1); s2 = fmaf(x22, l[2], s2); s3 = fmaf(x23, l[3], s3); } { const f32x4 l = *(const LAS f32x4*)(Lc + 1180); s0 = fmaf(x24, l[0], s0); s1 = fmaf(x25, l[1], s1); s2 = fmaf(x26, l[2], s2); s3 = fmaf(x27, l[3], s3); } { const f32x4 l = *(const LAS f32x4*)(Lc + 1184); s0 = fmaf(x28, l[0], s0); s1 = fmaf(x29, l[1], s1); s2 = fmaf(x30, l[2], s2); s3 = fmaf(x31, l[3], s3); } { const f32x4 l = *(const LAS f32x4*)(Lc + 1188); s0 = fmaf(x32, l[0], s0); s1 = fmaf(x33, l[1], s1); s2 = fmaf(x34, l[2], s2); s3 = fmaf(x35, l[3], s3); } { const f32x4 l = *(const LAS f32x4*)(Lc + 1192); s0 = fmaf(x36, l[0], s0); s1 = fmaf(x37, l[1], s1); s2 = fmaf(x38, l[2], s2); s3 = fmaf(x39, l[3], s3); } { const f32x4 l = *(const LAS f32x4*)(Lc + 1196); s0 = fmaf(x40, l[0], s0); s1 = fmaf(x41, l[1], s1); s2 = fmaf(x42, l[2], s2); s3 = fmaf(x43, l[3], s3); } { const f32x4 l = *(const LAS f32x4*)(Lc + 1200); s0 = fmaf(x44, l[0], s0); s1 = fmaf(x45, l[1], s1); s2 = fmaf(x46, l[2], s2); s3 = fmaf(x47, l[3], s3); } { const f32x4 l = *(const LAS f32x4*)(Lc + 1204); s0 = fmaf(x48, l[0], s0); s1 = fmaf(x49, l[1], s1); s2 = fmaf(x50, l[2], s2); s3 = fmaf(x51, l[3], s3); } { const f32x4 l = *(const LAS f32x4*)(Lc + 1208); s0 = fmaf(x52, l[0], s0); s1 = fmaf(x53, l[1], s1); s2 = fmaf(x54, l[2], s2); s3 = fmaf(x55, l[3], s3); } { const f32x4 l = *(const LAS f32x4*)(Lc + 1212); s0 = fmaf(x56, l[0], s0); s1 = fmaf(x57, l[1], s1); s2 = fmaf(x58, l[2], s2); s3 = fmaf(x59, l[3], s3); } { const f32x4 l = *(const LAS f32x4*)(Lc + 1216); s0 = fmaf(x60, l[0], s0); s1 = fmaf(x61, l[1], s1); s2 = fmaf(x62, l[2], s2); s3 = fmaf(x63, l[3], s3); } x17 = (lane == 17) ? 1.0f : -((s0 + s1) + (s2 + s3)); asm volatile("" : "+v"(x17) : : "memory"); }
    { float s0 = 0.f, s1 = 0.f, s2 = 0.f, s3 = 0.f; { const f32x4 l = *(const LAS f32x4*)(Lc + 1104); s1 = fmaf(x17, l[1], s1); s2 = fmaf(x18, l[2], s2); s3 = fmaf(x19, l[3], s3); } { const f32x4 l = *(const LAS f32x4*)(Lc + 1108); s0 = fmaf(x20, l[0], s0); s1 = fmaf(x21, l[1], s1); s2 = fmaf(x22, l[2], s2); s3 = fmaf(x23, l[3], s3); } { const f32x4 l = *(const LAS f32x4*)(Lc + 1112); s0 = fmaf(x24, l[0], s0); s1 = fmaf(x25, l[1], s1); s2 = fmaf(x26, l[2], s2); s3 = fmaf(x27, l[3], s3); } { const f32x4 l = *(const LAS f32x4*)(Lc + 1116); s0 = fmaf(x28, l[0], s0); s1 = fmaf(x29, l[1], s1); s2 = fmaf(x30, l[2], s2); s3 = fmaf(x31, l[3], s3); } { const f32x4 l = *(const LAS f32x4*)(Lc + 1120); s0 = fmaf(x32, l[0], s0); s1 = fmaf(x33, l[1], s1); s2 = fmaf(x34, l[2], s2); s3 = fmaf(x35, l[3], s3); } { const f32x4 l = *(const LAS f32x4*)(Lc + 1124); s0 = fmaf(x36, l[0], s0); s1 = fmaf(x37, l[1], s1); s2 = fmaf(x38, l[2], s2); s3 = fmaf(x39, l[3], s3); } { const f32x4 l = *(const LAS f32x4*)(Lc + 1128); s0 = fmaf(x40, l[0], s0); s1 = fmaf(x41, l[1], s1); s2 = fmaf(x42, l[2], s2); s3 = fmaf(x43, l[3], s3); } { const f32x4 l = *(const LAS f32x4*)(Lc + 1132); s0 = fmaf(x44, l[0], s0); s1 = fmaf(x45, l[1], s1); s2 = fmaf(x46, l[2], s2); s3 = fmaf(x47, l[3], s3); } { const f32x4 l = *(const LAS f32x4*)(Lc + 1136); s0 = fmaf(x48, l[0], s0); s1 = fmaf(x49, l[1], s1); s2 = fmaf(x50, l[2], s2); s3 = fmaf(x51, l[3], s3); } { const f32x4 l = *(const LAS f32x4*)(Lc + 1140); s0 = fmaf(x52, l[0], s0); s1 = fmaf(x53, l[1], s1); s2 = fmaf(x54, l[2], s2); s3 = fmaf(x55, l[3], s3); } { const f32x4 l = *(const LAS f32x4*)(Lc + 1144); s0 = fmaf(x56, l[0], s0); s1 = fmaf(x57, l[1], s1); s2 = fmaf(x58, l[2], s2); s3 = fmaf(x59, l[3], s3); } { const f32x4 l = *(const LAS f32x4*)(Lc + 1148); s0 = fmaf(x60, l[0], s0); s1 = fmaf(x61, l[1], s1); s2 = fmaf(x62, l[2], s2); s3 = fmaf(x63, l[3], s3); } x16 = (lane == 16) ? 1.0f : -((s0 + s1) + (s2 + s3)); asm volatile("" : "+v"(x16) : : "memory"); }
    { float s0 = 0.f, s1 = 0.f, s2 = 0.f, s3 = 0.f; { const f32x4 l = *(const LAS f32x4*)(Lc + 1036); s0 = fmaf(x16, l[0], s0); s1 = fmaf(x17, l[1], s1); s2 = fmaf(x18, l[2], s2); s3 = fmaf(x19, l[3], s3); } { const f32x4 l = *(const LAS f32x4*)(Lc + 1040); s0 = fmaf(x20, l[0], s0); s1 = fmaf(x21, l[1], s1); s2 = fmaf(x22, l[2], s2); s3 = fmaf(x23, l[3], s3); } { const f32x4 l = *(const LAS f32x4*)(Lc + 1044); s0 = fmaf(x24, l[0], s0); s1 = fmaf(x25, l[1], s1); s2 = fmaf(x26, l[2], s2); s3 = fmaf(x27, l[3], s3); } { const f32x4 l = *(const LAS f32x4*)(Lc + 1048); s0 = fmaf(x28, l[0], s0); s1 = fmaf(x29, l[1], s1); s2 = fmaf(x30, l[2], s2); s3 = fmaf(x31, l[3], s3); } { const f32x4 l = *(const LAS f32x4*)(Lc + 1052); s0 = fmaf(x32, l[0], s0); s1 = fmaf(x33, l[1], s1); s2 = fmaf(x34, l[2], s2); s3 = fmaf(x35, l[3], s3); } { const f32x4 l = *(const LAS f32x4*)(Lc + 1056); s0 = fmaf(x36, l[0], s0); s1 = fmaf(x37, l[1], s1); s2 = fmaf(x38, l[2], s2); s3 = fmaf(x39, l[3], s3); } { const f32x4 l = *(const LAS f32x4*)(Lc + 1060); s0 = fmaf(x40, l[0], s0); s1 = fmaf(x41, l[1], s1); s2 = fmaf(x42, l[2], s2); s3 = fmaf(x43, l[3], s3); } { const f32x4 l = *(const LAS f32x4*)(Lc + 1064); s0 = fmaf(x44, l[0], s0); s1 = fmaf(x45, l[1], s1); s2 = fmaf(x46, l[2], s2); s3 = fmaf(x47, l[3], s3); } { const f32x4 l = *(const LAS f32x4*)(Lc + 1068); s0 = fmaf(x48, l[0], s0); s1 = fmaf(x49, l[1], s1); s2 = fmaf(x50, l[2], s2); s3 = fmaf(x51, l[3], s3); } { const f32x4 l = *(const LAS f32x4*)(Lc + 1072); s0 = fmaf(x52, l[0], s0); s1 = fmaf(x53, l[1], s1); s2 = fmaf(x54, l[2], s2); s3 = fmaf(x55, l[3], s3); } { const f32x4 l = *(const LAS f32x4*)(Lc + 1076); s0 = fmaf(x56, l[0], s0); s1 = fmaf(x57, l[1], s1); s2 = fmaf(x58, l[2], s2); s3 = fmaf(x59, l[3], s3); } { const f32x4 l = *(const LAS f32x4*)(Lc + 1080); s0 = fmaf(x60, l[0], s0); s1 = fmaf(x61, l[1], s1); s2 = fmaf(x62, l[2], s2); s3 = fmaf(x63, l[3], s3); } x15 = (lane == 15) ? 1.0f : -((s0 + s1) + (s2 + s3)); asm volatile("" : "+v"(x15) : : "memory"); }
    { float s0 = 0.f, s1 = 0.f, s2 = 0.f, s3 = 0.f; { const f32x4 l = *(const LAS f32x4*)(Lc + 964); s3 = fmaf(x15, l[3], s3); } { const f32x4 l = *(const LAS f32x4*)(Lc + 968); s0 = fmaf(x16, l[0], s0); s1 = fmaf(x17, l[1], s1); s2 = fmaf(x18, l[2], s2); s3 = fmaf(x19, l[3], s3); } { const f32x4 l = *(const LAS f32x4*)(Lc + 972); s0 = fmaf(x20, l[0], s0); s1 = fmaf(x21, l[1], s1); s2 = fmaf(x22, l[2], s2); s3 = fmaf(x23, l[3], s3); } { const f32x4 l = *(const LAS f32x4*)(Lc + 976); s0 = fmaf(x24, l[0], s0); s1 = fmaf(x25, l[1], s1); s2 = fmaf(x26, l[2], s2); s3 = fmaf(x27, l[3], s3); } { const f32x4 l = *(const LAS f32x4*)(Lc + 980); s0 = fmaf(x28, l[0], s0); s1 = fmaf(x29, l[1], s1); s2 = fmaf(x30, l[2], s2); s3 = fmaf(x31, l[3], s3); } { const f32x4 l = *(const LAS f32x4*)(Lc + 984); s0 = fmaf(x32, l[0], s0); s1 = fmaf(x33, l[1], s1); s2 = fmaf(x34, l[2], s2); s3 = fmaf(x35, l[3], s3); } { const f32x4 l = *(const LAS f32x4*)(Lc + 988); s0 = fmaf(x36, l[0], s0); s1 = fmaf(x37, l[1], s1); s2 = fmaf(x38, l[2], s2); s3 = fmaf(x39, l[3], s3); } { const f32x4 l = *(const LAS f32x4*)(Lc + 992); s0 = fmaf(x40, l[0], s0); s1 = fmaf(x41, l[1], s1); s2 = fmaf(x42, l[2], s2); s3 = fmaf(x43, l[3], s3); } { const f32x4 l = *(const LAS f32x4*)(Lc + 996); s0 = fmaf(x44, l[0], s0); s1 = fmaf(x45, l[1], s1); s2 = fmaf(x46, l[2], s2); s3 = fmaf(x47, l[3], s3); } { const f32x4 l = *(const LAS f32x4*)(Lc + 1000); s0 = fmaf(x48, l[0], s0); s1 = fmaf(x49, l[1], s1); s2 = fmaf(x50, l[2], s2); s3 = fmaf(x51, l[3], s3); } { const f32x4 l = *(const LAS f32x4*)(Lc + 1004); s0 = fmaf(x52, l[0], s0); s1 = fmaf(x53, l[1], s1); s2 = fmaf(x54, l[2], s2); s3 = fmaf(x55, l[3], s3); } { const f32x4 l = *(const LAS f32x4*)(Lc + 1008); s0 = fmaf(x56, l[0], s0); s1 = fmaf(x57, l[1], s1); s2 = fmaf(x58, l[2], s2); s3 = fmaf(x59, l[3], s3); } { const f32x4 l = *(const LAS f32x4*)(Lc + 1012); s0 = fmaf(x60, l[0], s0); s1 = fmaf(x61, l[1], s1); s2 = fmaf(x62, l[2], s2); s3 = fmaf(x63, l[3], s3); } x14 = (lane == 14) ? 1.0f : -((s0 + s1) + (s2 + s3)); asm volatile("" : "+v"(x14) : : "memory"); }
    { float s0 = 0.f, s1 = 0.f, s2 = 0.f, s3 = 0.f; { const f32x4 l = *(const LAS f32x4*)(Lc + 896); s2 = fmaf(x14, l[2], s2); s3 = fmaf(x15, l[3], s3); } { const f32x4 l = *(const LAS f32x4*)(Lc + 900); s0 = fmaf(x16, l[0], s0); s1 = fmaf(x17, l[1], s1); s2 = fmaf(x18, l[2], s2); s3 = fmaf(x19, l[3], s3); } { const f32x4 l = *(const LAS f32x4*)(Lc + 904); s0 = fmaf(x20, l[0], s0); s1 = fmaf(x21, l[1], s1); s2 = fmaf(x22, l[2], s2); s3 = fmaf(x23, l[3], s3); } { const f32x4 l = *(const LAS f32x4*)(Lc + 908); s0 = fmaf(x24, l[0], s0); s1 = fmaf(x25, l[1], s1); s2 = fmaf(x26, l[2], s2); s3 = fmaf(x27, l[3], s3); } { const f32x4 l = *(const LAS f32x4*)(Lc + 912); s0 = fmaf(x28, l[0], s0); s1 = fmaf(x29, l[1], s1); s2 = fmaf(x30, l[2], s2); s3 = fmaf(x31, l[3], s3); } { const f32x4 l = *(const LAS f32x4*)(Lc + 916); s0 = fmaf(x32, l[0], s0); s1 = fmaf(x33, l[1], s1); s2 = fmaf(x34, l[2], s2); s3 = fmaf(x35, l[3], s3); } { const f32x4 l = *(const LAS f32x4*)(Lc + 920); s0 = fmaf(x36, l[0], s0); s1 = fmaf(x37, l[1], s1); s2 = fmaf(x38, l[2], s2); s3 = fmaf(x39, l[3], s3); } { const f32x4 l = *(const LAS f32x4*)(Lc + 924); s0 = fmaf(x40, l[0], s0); s1 = fmaf(x41, l[1], s1); s2 = fmaf(x42, l[2], s2); s3 = fmaf(x43, l[3], s3); } { const f32x4 l = *(const LAS f32x4*)(Lc + 928); s0 = fmaf(x44, l[0], s0); s1 = fmaf(x45, l[1], s1); s2 = fmaf(x46, l[2], s2); s3 = fmaf(x47, l[3], s3); } { const f32x4 l = *(const LAS f32x4*)(Lc + 932); s0 = fmaf(x48, l[0], s0); s1 = fmaf(x49, l[1], s1); s2 = fmaf(x50, l[2], s2); s3 = fmaf(x51, l[3], s3); } { const f32x4 l = *(const LAS f32x4*)(Lc + 936); s0 = fmaf(x52, l[0], s0); s1 = fmaf(x53, l[1], s1); s2 = fmaf(x54, l[2], s2); s3 = fmaf(x55, l[3], s3); } { const f32x4 l = *(const LAS f32x4*)(Lc + 940); s0 = fmaf(x56, l[0], s0); s1 = fmaf(x57, l[1], s1); s2 = fmaf(x58, l[2], s2); s3 = fmaf(x59, l[3], s3); } { const f32x4 l = *(const LAS f32x4*)(Lc + 944); s0 = fmaf(x60, l[0], s0); s1 = fmaf(x61, l[1], s1); s2 = fmaf(x62, l[2], s2); s3 = fmaf(x63, l[3], s3); } x13 = (lane == 13) ? 1.0f : -((s0 + s1) + (s2 + s3)); asm volatile("" : "+v"(x13) : : "memory"); }
    { float s0 = 0.f, s1 = 0.f, s2 = 0.f, s3 = 0.f; { const f32x4 l = *(const LAS f32x4*)(Lc + 828); s1 = fmaf(x13, l[1], s1); s2 = fmaf(x14, l[2], s2); s3 = fmaf(x15, l[3], s3); } { const f32x4 l = *(const LAS f32x4*)(Lc + 832); s0 = fmaf(x16, l[0], s0); s1 = fmaf(x17, l[1], s1); s2 = fmaf(x18, l[2], s2); s3 = fmaf(x19, l[3], s3); } { const f32x4 l = *(const LAS f32x4*)(Lc + 836); s0 = fmaf(x20, l[0], s0); s1 = fmaf(x21, l[1], s1); s2 = fmaf(x22, l[2], s2); s3 = fmaf(x23, l[3], s3); } { const f32x4 l = *(const LAS f32x4*)(Lc + 840); s0 = fmaf(x24, l[0], s0); s1 = fmaf(x25, l[1], s1); s2 = fmaf(x26, l[2], s2); s3 = fmaf(x27, l[3], s3); } { const f32x4 l = *(const LAS f32x4*)(Lc + 844); s0 = fmaf(x28, l[0], s0); s1 = fmaf(x29, l[1], s1); s2 = fmaf(x30, l[2], s2); s3 = fmaf(x31, l[3], s3); } { const f32x4 l = *(const LAS f32x4*)(Lc + 848); s0 = fmaf(x32, l[0], s0); s1 = fmaf(x33, l[1], s1); s2 = fmaf(x34, l[2], s2); s3 = fmaf(x35, l[3], s3); } { const f32x4 l = *(const LAS f32x4*)(Lc + 852); s0 = fmaf(x36, l[0], s0); s1 = fmaf(x37, l[1], s1); s2 = fmaf(x38, l[2], s2); s3 = fmaf(x39, l[3], s3); } { const f32x4 l = *(const LAS f32x4*)(Lc + 856); s0 = fmaf(x40, l[0], s0); s1 = fmaf(x41, l[1], s1); s2 = fmaf(x42, l[2], s2); s3 = fmaf(x43, l[3], s3); } { const f32x4 l = *(const LAS f32x4*)(Lc + 860); s0 = fmaf(x44, l[0], s0); s1 = fmaf(x45, l[1], s1); s2 = fmaf(x46, l[2], s2); s3 = fmaf(x47, l[3], s3); } { const f32x4 l = *(const LAS f32x4*)(Lc + 864); s0 = fmaf(x48, l[0], s0); s1 = fmaf(x49, l[1], s1); s2 = fmaf(x50, l[2], s2); s3 = fmaf(x51, l[3], s3); } { const f32x4 l = *(const LAS f32x4*)(Lc + 868); s0 = fmaf(x52, l[0], s0); s1 = fmaf(x53, l[1], s1); s2 = fmaf(x54, l[2], s2); s3 = fmaf(x55, l[3], s3); } { const f32x4 l = *(const LAS f32x4*)(Lc + 872); s0 = fmaf(x56, l[0], s0); s1 = fmaf(x57, l[1], s1); s2 = fmaf(x58, l[2], s2); s3 = fmaf(x59, l[3], s3); } { const f32x4 l = *(const LAS f32x4*)(Lc + 876); s0 = fmaf(x60, l[0], s0); s1 = fmaf(x61, l[1], s1); s2 = fmaf(x62, l[2], s2); s3 = fmaf(x63, l[3], s3); } x12 = (lane == 12) ? 1.0f : -((s0 + s1) + (s2 + s3)); asm volatile("" : "+v"(x12) : : "memory"); }
    { float s0 = 0.f, s1 = 0.f, s2 = 0.f, s3 = 0.f; { const f32x4 l = *(const LAS f32x4*)(Lc + 760); s0 = fmaf(x12, l[0], s0); s1 = fmaf(x13, l[1], s1); s2 = fmaf(x14, l[2], s2); s3 = fmaf(x15, l[3], s3); } { const f32x4 l = *(const LAS f32x4*)(Lc + 764); s0 = fmaf(x16, l[0], s0); s1 = fmaf(x17, l[1], s1); s2 = fmaf(x18, l[2], s2); s3 = fmaf(x19, l[3], s3); } { const f32x4 l = *(const LAS f32x4*)(Lc + 768); s0 = fmaf(x20, l[0], s0); s1 = fmaf(x21, l[1], s1); s2 = fmaf(x22, l[2], s2); s3 = fmaf(x23, l[3], s3); } { const f32x4 l = *(const LAS f32x4*)(Lc + 772); s0 = fmaf(x24, l[0], s0); s1 = fmaf(x25, l[1], s1); s2 = fmaf(x26, l[2], s2); s3 = fmaf(x27, l[3], s3); } { const f32x4 l = *(const LAS f32x4*)(Lc + 776); s0 = fmaf(x28, l[0], s0); s1 = fmaf(x29, l[1], s1); s2 = fmaf(x30, l[2], s2); s3 = fmaf(x31, l[3], s3); } { const f32x4 l = *(const LAS f32x4*)(Lc + 780); s0 = fmaf(x32, l[0], s0); s1 = fmaf(x33, l[1], s1); s2 = fmaf(x34, l[2], s2); s3 = fmaf(x35, l[3], s3); } { const f32x4 l = *(const LAS f32x4*)(Lc + 784); s0 = fmaf(x36, l[0], s0); s1 = fmaf(x37, l[1], s1); s2 = fmaf(x38, l[2], s2); s3 = fmaf(x39, l[3], s3); } { const f32x4 l = *(const LAS f32x4*)(Lc + 788); s0 = fmaf(x40, l[0], s0); s1 = fmaf(x41, l[1], s1); s2 = fmaf(x42, l[2], s2); s3 = fmaf(x43, l[3], s3); } { const f32x4 l = *(const LAS f32x4*)(Lc + 792); s0 = fmaf(x44, l[0], s0); s1 = fmaf(x45, l[1], s1); s2 = fmaf(x46, l[2], s2); s3 = fmaf(x47, l[3], s3); } { const f32x4 l = *(const LAS f32x4*)(Lc + 796); s0 = fmaf(x48, l[0], s0); s1 = fmaf(x49, l[1], s1); s2 = fmaf(x50, l[2], s2); s3 = fmaf(x51, l[3], s3); } { const f32x4 l = *(const LAS f32x4*)(Lc + 800); s0 = fmaf(x52, l[0], s0); s1 = fmaf(x53, l[1], s1); s2 = fmaf(x54, l[2], s2); s3 = fmaf(x55, l[3], s3); } { const f32x4 l = *(const LAS f32x4*)(Lc + 804); s0 = fmaf(x56, l[0], s0); s1 = fmaf(x57, l[1], s1); s2 = fmaf(x58, l[2], s2); s3 = fmaf(x59, l[3], s3); } { const f32x4 l = *(const LAS f32x4*)(Lc + 808); s0 = fmaf(x60, l[0], s0); s1 = fmaf(x61, l[1], s1); s2 = fmaf(x62, l[2], s2); s3 = fmaf(x63, l[3], s3); } x11 = (lane == 11) ? 1.0f : -((s0 + s1) + (s2 + s3)); asm volatile("" : "+v"(x11) : : "memory"); }
    { float s0 = 0.f, s1 = 0.f, s2 = 0.f, s3 = 0.f; { const f32x4 l = *(const LAS f32x4*)(Lc + 688); s3 = fmaf(x11, l[3], s3); } { const f32x4 l = *(const LAS f32x4*)(Lc + 692); s0 = fmaf(x12, l[0], s0); s1 = fmaf(x13, l[1], s1); s2 = fmaf(x14, l[2], s2); s3 = fmaf(x15, l[3], s3); } { const f32x4 l = *(const LAS f32x4*)(Lc + 696); s0 = fmaf(x16, l[0], s0); s1 = fmaf(x17, l[1], s1); s2 = fmaf(x18, l[2], s2); s3 = fmaf(x19, l[3], s3); } { const f32x4 l = *(const LAS f32x4*)(Lc + 700); s0 = fmaf(x20, l[0], s0); s1 = fmaf(x21, l[1], s1); s2 = fmaf(x22, l[2], s2); s3 = fmaf(x23, l[3], s3); } { const f32x4 l = *(const LAS f32x4*)(Lc + 704); s0 = fmaf(x24, l[0], s0); s1 = fmaf(x25, l[1], s1); s2 = fmaf(x26, l[2], s2); s3 = fmaf(x27, l[3], s3); } { const f32x4 l = *(const LAS f32x4*)(Lc + 708); s0 = fmaf(x28, l[0], s0); s1 = fmaf(x29, l[1], s1); s2 = fmaf(x30, l[2], s2); s3 = fmaf(x31, l[3], s3); } { const f32x4 l = *(const LAS f32x4*)(Lc + 712); s0 = fmaf(x32, l[0], s0); s1 = fmaf(x33, l[1], s1); s2 = fmaf(x34, l[2], s2); s3 = fmaf(x35, l[3], s3); } { const f32x4 l = *(const LAS f32x4*)(Lc + 716); s0 = fmaf(x36, l[0], s0); s1 = fmaf(x37, l[1], s1); s2 = fmaf(x38, l[2], s2); s3 = fmaf(x39, l[3], s3); } { const f32x4 l = *(const LAS f32x4*)(Lc + 720); s0 = fmaf(x40, l[0], s0); s1 = fmaf(x41, l[1], s1); s2 = fmaf(x42, l[2], s2); s3 = fmaf(x43, l[3], s3); } { const f32x4 l = *(const LAS f32x4*)(Lc + 724); s0 = fmaf(x44, l[0], s0); s1 = fmaf(x45, l[1], s1); s2 = fmaf(x46, l[2], s2); s3 = fmaf(x47, l[3], s3); } { const f32x4 l = *(const LAS f32x4*)(Lc + 728); s0 = fmaf(x48, l[0], s0); s1 = fmaf(x49, l[1], s1); s2 = fmaf(x50, l[2], s2); s3 = fmaf(x51, l[3], s3); } { const f32x4 l = *(const LAS f32x4*)(Lc + 732); s0 = fmaf(x52, l[0], s0); s1 = fmaf(x53, l[1], s1); s2 = fmaf(x54, l[2], s2); s3 = fmaf(x55, l[3], s3); } { const f32x4 l = *(const LAS f32x4*)(Lc + 736); s0 = fmaf(x56, l[0], s0); s1 = fmaf(x57, l[1], s1); s2 = fmaf(x58, l[2], s2); s3 = fmaf(x59, l[3], s3); } { const f32x4 l = *(const LAS f32x4*)(Lc + 740); s0 = fmaf(x60, l[0], s0); s1 = fmaf(x61, l[1], s1); s2 = fmaf(x62, l[2], s2); s3 = fmaf(x63, l[3], s3); } x10 = (lane == 10) ? 1.0f : -((s0 + s1) + (s2 + s3)); asm volatile("" : "+v"(x10) : : "memory"); }
    { float s0 = 0.f, s1 = 0.f, s2 = 0.f, s3 = 0.f; { const f32x4 l = *(const LAS f32x4*)(Lc + 620); s2 = fmaf(x10, l[2], s2); s3 = fmaf(x11, l[3], s3); } { const f32x4 l = *(const LAS f32x4*)(Lc + 624); s0 = fmaf(x12, l[0], s0); s1 = fmaf(x13, l[1], s1); s2 = fmaf(x14, l[2], s2); s3 = fmaf(x15, l[3], s3); } { const f32x4 l = *(const LAS f32x4*)(Lc + 628); s0 = fmaf(x16, l[0], s0); s1 = fmaf(x17, l[1], s1); s2 = fmaf(x18, l[2], s2); s3 = fmaf(x19, l[3], s3); } { const f32x4 l = *(const LAS f32x4*)(Lc + 632); s0 = fmaf(x20, l[0], s0); s1 = fmaf(x21, l[1], s1); s2 = fmaf(x22, l[2], s2); s3 = fmaf(x23, l[3], s3); } { const f32x4 l = *(const LAS f32x4*)(Lc + 636); s0 = fmaf(x24, l[0], s0); s1 = fmaf(x25, l[1], s1); s2 = fmaf(x26, l[2], s2); s3 = fmaf(x27, l[3], s3); } { const f32x4 l = *(const LAS f32x4*)(Lc + 640); s0 = fmaf(x28, l[0], s0); s1 = fmaf(x29, l[1], s1); s2 = fmaf(x30, l[2], s2); s3 = fmaf(x31, l[3], s3); } { const f32x4 l = *(const LAS f32x4*)(Lc + 644); s0 = fmaf(x32, l[0], s0); s1 = fmaf(x33, l[1], s1); s2 = fmaf(x34, l[2], s2); s3 = fmaf(x35, l[3], s3); } { const f32x4 l = *(const LAS f32x4*)(Lc + 648); s0 = fmaf(x36, l[0], s0); s1 = fmaf(x37, l[1], s1); s2 = fmaf(x38, l[2], s2); s3 = fmaf(x39, l[3], s3); } { const f32x4 l = *(const LAS f32x4*)(Lc + 652); s0 = fmaf(x40, l[0], s0); s1 = fmaf(x41, l[1], s1); s2 = fmaf(x42, l[2], s2); s3 = fmaf(x43, l[3], s3); } { const f32x4 l = *(const LAS f32x4*)(Lc + 656); s0 = fmaf(x44, l[0], s0); s1 = fmaf(x45, l[1], s1); s2 = fmaf(x46, l[2], s2); s3 = fmaf(x47, l[3], s3); } { const f32x4 l = *(const LAS f32x4*)(Lc + 660); s0 = fmaf(x48, l[0], s0); s1 = fmaf(x49, l[1], s1); s2 = fmaf(x50, l[2], s2); s3 = fmaf(x51, l[3], s3); } { const f32x4 l = *(const LAS f32x4*)(Lc + 664); s0 = fmaf(x52, l[0], s0); s1 = fmaf(x53, l[1], s1); s2 = fmaf(x54, l[2], s2); s3 = fmaf(x55, l[3], s3); } { const f32x4 l = *(const LAS f32x4*)(Lc + 668); s0 = fmaf(x56, l[0], s0); s1 = fmaf(x57, l[1], s1); s2 = fmaf(x58, l[2], s2); s3 = fmaf(x59, l[3], s3); } { const f32x4 l = *(const LAS f32x4*)(Lc + 672); s0 = fmaf(x60, l[0], s0); s1 = fmaf(x61, l[1], s1); s2 = fmaf(x62, l[2], s2); s3 = fmaf(x63, l[3], s3); } x9 = (lane == 9) ? 1.0f : -((s0 + s1) + (s2 + s3)); asm volatile("" : "+v"(x9) : : "memory"); }
    { float s0 = 0.f, s1 = 0.f, s2 = 0.f, s3 = 0.f; { const f32x4 l = *(const LAS f32x4*)(Lc + 552); s1 = fmaf(x9, l[1], s1); s2 = fmaf(x10, l[2], s2); s3 = fmaf(x11, l[3], s3); } { const f32x4 l = *(const LAS f32x4*)(Lc + 556); s0 = fmaf(x12, l[0], s0); s1 = fmaf(x13, l[1], s1); s2 = fmaf(x14, l[2], s2); s3 = fmaf(x15, l[3], s3); } { const f32x4 l = *(const LAS f32x4*)(Lc + 560); s0 = fmaf(x16, l[0], s0); s1 = fmaf(x17, l[1], s1); s2 = fmaf(x18, l[2], s2); s3 = fmaf(x19, l[3], s3); } { const f32x4 l = *(const LAS f32x4*)(Lc + 564); s0 = fmaf(x20, l[0], s0); s1 = fmaf(x21, l[1], s1); s2 = fmaf(x22, l[2], s2); s3 = fmaf(x23, l[3], s3); } { const f32x4 l = *(const LAS f32x4*)(Lc + 568); s0 = fmaf(x24, l[0], s0); s1 = fmaf(x25, l[1], s1); s2 = fmaf(x26, l[2], s2); s3 = fmaf(x27, l[3], s3); } { const f32x4 l = *(const LAS f32x4*)(Lc + 572); s0 = fmaf(x28, l[0], s0); s1 = fmaf(x29, l[1], s1); s2 = fmaf(x30, l[2], s2); s3 = fmaf(x31, l[3], s3); } { const f32x4 l = *(const LAS f32x4*)(Lc + 576); s0 = fmaf(x32, l[0], s0); s1 = fmaf(x33, l[1], s1); s2 = fmaf(x34, l[2], s2); s3 = fmaf(x35, l[3], s3); } { const f32x4 l = *(const LAS f32x4*)(Lc + 580); s0 = fmaf(x36, l[0], s0); s1 = fmaf(x37, l[1], s1); s2 = fmaf(x38, l[2], s2); s3 = fmaf(x39, l[3], s3); } { const f32x4 l = *(const LAS f32x4*)(Lc + 584); s0 = fmaf(x40, l[0], s0); s1 = fmaf(x41, l[1], s1); s2 = fmaf(x42, l[2], s2); s3 = fmaf(x43, l[3], s3); } { const f32x4 l = *(const LAS f32x4*)(Lc + 588); s0 = fmaf(x44, l[0], s0); s1 = fmaf(x45, l[1], s1); s2 = fmaf(x46, l[2], s2); s3 = fmaf(x47, l[3], s3); } { const f32x4 l = *(const LAS f32x4*)(Lc + 592); s0 = fmaf(x48, l[0], s0); s1 = fmaf(x49, l[1], s1); s2 = fmaf(x50, l[2], s2); s3 = fmaf(x51, l[3], s3); } { const f32x4 l = *(const LAS f32x4*)(Lc + 596); s0 = fmaf(x52, l[0], s0); s1 = fmaf(x53, l[1], s1); s2 = fmaf(x54, l[2], s2); s3 = fmaf(x55, l[3], s3); } { const f32x4 l = *(const LAS f32x4*)(Lc + 600); s0 = fmaf(x56, l[0], s0); s1 = fmaf(x57, l[1], s1); s2 = fmaf(x58, l[2], s2); s3 = fmaf(x59, l[3], s3); } { const f32x4 l = *(const LAS f32x4*)(Lc + 604); s0 = fmaf(x60, l[0], s0); s1 = fmaf(x61, l[1], s1); s2 = fmaf(x62, l[2], s2); s3 = fmaf(x63, l[3], s3); } x8 = (lane == 8) ? 1.0f : -((s0 + s1) + (s2 + s3)); asm volatile("" : "+v"(x8) : : "memory"); }
    { float s0 = 0.f, s1 = 0.f, s2 = 0.f, s3 = 0.f; { const f32x4 l = *(const LAS f32x4*)(Lc + 484); s0 = fmaf(x8, l[0], s0); s1 = fmaf(x9, l[1], s1); s2 = fmaf(x10, l[2], s2); s3 = fmaf(x11, l[3], s3); } { const f32x4 l = *(const LAS f32x4*)(Lc + 488); s0 = fmaf(x12, l[0], s0); s1 = fmaf(x13, l[1], s1); s2 = fmaf(x14, l[2], s2); s3 = fmaf(x15, l[3], s3); } { const f32x4 l = *(const LAS f32x4*)(Lc + 492); s0 = fmaf(x16, l[0], s0); s1 = fmaf(x17, l[1], s1); s2 = fmaf(x18, l[2], s2); s3 = fmaf(x19, l[3], s3); } { const f32x4 l = *(const LAS f32x4*)(Lc + 496); s0 = fmaf(x20, l[0], s0); s1 = fmaf(x21, l[1], s1); s2 = fmaf(x22, l[2], s2); s3 = fmaf(x23, l[3], s3); } { const f32x4 l = *(const LAS f32x4*)(Lc + 500); s0 = fmaf(x24, l[0], s0); s1 = fmaf(x25, l[1], s1); s2 = fmaf(x26, l[2], s2); s3 = fmaf(x27, l[3], s3); } { const f32x4 l = *(const LAS f32x4*)(Lc + 504); s0 = fmaf(x28, l[0], s0); s1 = fmaf(x29, l[1], s1); s2 = fmaf(x30, l[2], s2); s3 = fmaf(x31, l[3], s3); } { const f32x4 l = *(const LAS f32x4*)(Lc + 508); s0 = fmaf(x32, l[0], s0); s1 = fmaf(x33, l[1], s1); s2 = fmaf(x34, l[2], s2); s3 = fmaf(x35, l[3], s3); } { const f32x4 l = *(const LAS f32x4*)(Lc + 512); s0 = fmaf(x36, l[0], s0); s1 = fmaf(x37, l[1], s1); s2 = fmaf(x38, l[2], s2); s3 = fmaf(x39, l[3], s3); } { const f32x4 l = *(const LAS f32x4*)(Lc + 516); s0 = fmaf(x40, l[0], s0); s1 = fmaf(x41, l[1], s1); s2 = fmaf(x42, l[2], s2); s3 = fmaf(x43, l[3], s3); } { const f32x4 l = *(const LAS f32x4*)(Lc + 520); s0 = fmaf(x44, l[0], s0); s1 = fmaf(x45, l[1], s1); s2 = fmaf(x46, l[2], s2); s3 = fmaf(x47, l[3], s3); } { const f32x4 l = *(const LAS f32x4*)(Lc + 524); s0 = fmaf(x48, l[0], s0); s1 = fmaf(x49, l[1], s1); s2 = fmaf(x50, l[2], s2); s3 = fmaf(x51, l[3], s3); } { const f32x4 l = *(const LAS f32x4*)(Lc + 528); s0 = fmaf(x52, l[0], s0); s1 = fmaf(x53, l[1], s1); s2 = fmaf(x54, l[2], s2); s3 = fmaf(x55, l[3], s3); } { const f32x4 l = *(const LAS f32x4*)(Lc + 532); s0 = fmaf(x56, l[0], s0); s1 = fmaf(x57, l[1], s1); s2 = fmaf(x58, l[2], s2); s3 = fmaf(x59, l[3], s3); } { const f32x4 l = *(const LAS f32x4*)(Lc + 536); s0 = fmaf(x60, l[0], s0); s1 = fmaf(x61, l[1], s1); s2 = fmaf(x62, l[2], s2); s3 = fmaf(x63, l[3], s3); } x7 = (lane == 7) ? 1.0f : -((s0 + s1) + (s2 + s3)); asm volatile("" : "+v"(x7) : : "memory"); }
    { float s0 = 0.f, s1 = 0.f, s2 = 0.f, s3 = 0.f; { const f32x4 l = *(const LAS f32x4*)(Lc + 412); s3 = fmaf(x7, l[3], s3); } { const f32x4 l = *(const LAS f32x4*)(Lc + 416); s0 = fmaf(x8, l[0], s0); s1 = fmaf(x9, l[1], s1); s2 = fmaf(x10, l[2], s2); s3 = fmaf(x11, l[3], s3); } { const f32x4 l = *(const LAS f32x4*)(Lc + 420); s0 = fmaf(x12, l[0], s0); s1 = fmaf(x13, l[1], s1); s2 = fmaf(x14, l[2], s2); s3 = fmaf(x15, l[3], s3); } { const f32x4 l = *(const LAS f32x4*)(Lc + 424); s0 = fmaf(x16, l[0], s0); s1 = fmaf(x17, l[1], s1); s2 = fmaf(x18, l[2], s2); s3 = fmaf(x19, l[3], s3); } { const f32x4 l = *(const LAS f32x4*)(Lc + 428); s0 = fmaf(x20, l[0], s0); s1 = fmaf(x21, l[1], s1); s2 = fmaf(x22, l[2], s2); s3 = fmaf(x23, l[3], s3); } { const f32x4 l = *(const LAS f32x4*)(Lc + 432); s0 = fmaf(x24, l[0], s0); s1 = fmaf(x25, l[1], s1); s2 = fmaf(x26, l[2], s2); s3 = fmaf(x27, l[3], s3); } { const f32x4 l = *(const LAS f32x4*)(Lc + 436); s0 = fmaf(x28, l[0], s0); s1 = fmaf(x29, l[1], s1); s2 = fmaf(x30, l[2], s2); s3 = fmaf(x31, l[3], s3); } { const f32x4 l = *(const LAS f32x4*)(Lc + 440); s0 = fmaf(x32, l[0], s0); s1 = fmaf(x33, l[1], s1); s2 = fmaf(x34, l[2], s2); s3 = fmaf(x35, l[3], s3); } { const f32x4 l = *(const LAS f32x4*)(Lc + 444); s0 = fmaf(x36, l[0], s0); s1 = fmaf(x37, l[1], s1); s2 = fmaf(x38, l[2], s2); s3 = fmaf(x39, l[3], s3); } { const f32x4 l = *(const LAS f32x4*)(Lc + 448); s0 = fmaf(x40, l[0], s0); s1 = fmaf(x41, l[1], s1); s2 = fmaf(x42, l[2], s2); s3 = fmaf(x43, l[3], s3); } { const f32x4 l = *(const LAS f32x4*)(Lc + 452); s0 = fmaf(x44, l[0], s0); s1 = fmaf(x45, l[1], s1); s2 = fmaf(x46, l[2], s2); s3 = fmaf(x47, l[3], s3); } { const f32x4 l = *(const LAS f32x4*)(Lc + 456); s0 = fmaf(x48, l[0], s0); s1 = fmaf(x49, l[1], s1); s2 = fmaf(x50, l[2], s2); s3 = fmaf(x51, l[3], s3); } { const f32x4 l = *(const LAS f32x4*)(Lc + 460); s0 = fmaf(x52, l[0], s0); s1 = fmaf(x53, l[1], s1); s2 = fmaf(x54, l[2], s2); s3 = fmaf(x55, l[3], s3); } { const f32x4 l = *(const LAS f32x4*)(Lc + 464); s0 = fmaf(x56, l[0], s0); s1 = fmaf(x57, l[1], s1); s2 = fmaf(x58, l[2], s2); s3 = fmaf(x59, l[3], s3); } { const f32x4 l = *(const LAS f32x4*)(Lc + 468); s0 = fmaf(x60, l[0], s0); s1 = fmaf(x61, l[1], s1); s2 = fmaf(x62, l[2], s2); s3 = fmaf(x63, l[3], s3); } x6 = (lane == 6) ? 1.0f : -((s0 + s1) + (s2 + s3)); asm volatile("" : "+v"(x6) : : "memory"); }
    { float s0 = 0.f, s1 = 0.f, s2 = 0.f, s3 = 0.f; { const f32x4 l = *(const LAS f32x4*)(Lc + 344); s2 = fmaf(x6, l[2], s2); s3 = fmaf(x7, l[3], s3); } { const f32x4 l = *(const LAS f32x4*)(Lc + 348); s0 = fmaf(x8, l[0], s0); s1 = fmaf(x9, l[1], s1); s2 = fmaf(x10, l[2], s2); s3 = fmaf(x11, l[3], s3); } { const f32x4 l = *(const LAS f32x4*)(Lc + 352); s0 = fmaf(x12, l[0], s0); s1 = fmaf(x13, l[1], s1); s2 = fmaf(x14, l[2], s2); s3 = fmaf(x15, l[3], s3); } { const f32x4 l = *(const LAS f32x4*)(Lc + 356); s0 = fmaf(x16, l[0], s0); s1 = fmaf(x17, l[1], s1); s2 = fmaf(x18, l[2], s2); s3 = fmaf(x19, l[3], s3); } { const f32x4 l = *(const LAS f32x4*)(Lc + 360); s0 = fmaf(x20, l[0], s0); s1 = fmaf(x21, l[1], s1); s2 = fmaf(x22, l[2], s2); s3 = fmaf(x23, l[3], s3); } { const f32x4 l = *(const LAS f32x4*)(Lc + 364); s0 = fmaf(x24, l[0], s0); s1 = fmaf(x25, l[1], s1); s2 = fmaf(x26, l[2], s2); s3 = fmaf(x27, l[3], s3); } { const f32x4 l = *(const LAS f32x4*)(Lc + 368); s0 = fmaf(x28, l[0], s0); s1 = fmaf(x29, l[1], s1); s2 = fmaf(x30, l[2], s2); s3 = fmaf(x31, l[3], s3); } { const f32x4 l = *(const LAS f32x4*)(Lc + 372); s0 = fmaf(x32, l[0], s0); s1 = fmaf(x33, l[1], s1); s2 = fmaf(x34, l[2], s2); s3 = fmaf(x35, l[3], s3); } { const f32x4 l = *(const LAS f32x4*)(Lc + 376); s0 = fmaf(x36, l[0], s0); s1 = fmaf(x37, l[1], s1); s2 = fmaf(x38, l[2], s2); s3 = fmaf(x39, l[3], s3); } { const f32x4 l = *(const LAS f32x4*)(Lc + 380); s0 = fmaf(x40, l[0], s0); s1 = fmaf(x41, l[1], s1); s2 = fmaf(x42, l[2], s2); s3 = fmaf(x43, l[3], s3); } { const f32x4 l = *(const LAS f32x4*)(Lc + 384); s0 = fmaf(x44, l[0], s0); s1 = fmaf(x45, l[1], s1); s2 = fmaf(x46, l[2], s2); s3 = fmaf(x47, l[3], s3); } { const f32x4 l = *(const LAS f32x4*)(Lc + 388); s0 = fmaf(x48, l[0], s0); s1 = fmaf(x49, l[1], s1); s2 = fmaf(x50, l[2], s2); s3 = fmaf(x51, l[3], s3); } { const f32x4 l = *(const LAS f32x4*)(Lc + 392); s0 = fmaf(x52, l[0], s0); s1 = fmaf(x53, l[1], s1); s2 = fmaf(x54, l[2], s2); s3 = fmaf(x55, l[3], s3); } { const f32x4 l = *(const LAS f32x4*)(Lc + 396); s0 = fmaf(x56, l[0], s0); s1 = fmaf(x57, l[1], s1); s2 = fmaf(x58, l[2], s2); s3 = fmaf(x59, l[3], s3); } { const f32x4 l = *(const LAS f32x4*)(Lc + 400); s0 = fmaf(x60, l[0], s0); s1 = fmaf(x61, l[1], s1); s2 = fmaf(x62, l[2], s2); s3 = fmaf(x63, l[3], s3); } x5 = (lane == 5) ? 1.0f : -((s0 + s1) + (s2 + s3)); asm volatile("" : "+v"(x5) : : "memory"); }
    { float s0 = 0.f, s1 = 0.f, s2 = 0.f, s3 = 0.f; { const f32x4 l = *(const LAS f32x4*)(Lc + 276); s1 = fmaf(x5, l[1], s1); s2 = fmaf(x6, l[2], s2); s3 = fmaf(x7, l[3], s3); } { const f32x4 l = *(const LAS f32x4*)(Lc + 280); s0 = fmaf(x8, l[0], s0); s1 = fmaf(x9, l[1], s1); s2 = fmaf(x10, l[2], s2); s3 = fmaf(x11, l[3], s3); } { const f32x4 l = *(const LAS f32x4*)(Lc + 284); s0 = fmaf(x12, l[0], s0); s1 = fmaf(x13, l[1], s1); s2 = fmaf(x14, l[2], s2); s3 = fmaf(x15, l[3], s3); } { const f32x4 l = *(const LAS f32x4*)(Lc + 288); s0 = fmaf(x16, l[0], s0); s1 = fmaf(x17, l[1], s1); s2 = fmaf(x18, l[2], s2); s3 = fmaf(x19, l[3], s3); } { const f32x4 l = *(const LAS f32x4*)(Lc + 292); s0 = fmaf(x20, l[0], s0); s1 = fmaf(x21, l[1], s1); s2 = fmaf(x22, l[2], s2); s3 = fmaf(x23, l[3], s3); } { const f32x4 l = *(const LAS f32x4*)(Lc + 296); s0 = fmaf(x24, l[0], s0); s1 = fmaf(x25, l[1], s1); s2 = fmaf(x26, l[2], s2); s3 = fmaf(x27, l[3], s3); } { const f32x4 l = *(const LAS f32x4*)(Lc + 300); s0 = fmaf(x28, l[0], s0); s1 = fmaf(x29, l[1], s1); s2 = fmaf(x30, l[2], s2); s3 = fmaf(x31, l[3], s3); } { const f32x4 l = *(const LAS f32x4*)(Lc + 304); s0 = fmaf(x32, l[0], s0); s1 = fmaf(x33, l[1], s1); s2 = fmaf(x34, l[2], s2); s3 = fmaf(x35, l[3], s3); } { const f32x4 l = *(const LAS f32x4*)(Lc + 308); s0 = fmaf(x36, l[0], s0); s1 = fmaf(x37, l[1], s1); s2 = fmaf(x38, l[2], s2); s3 = fmaf(x39, l[3], s3); } { const f32x4 l = *(const LAS f32x4*)(Lc + 312); s0 = fmaf(x40, l[0], s0); s1 = fmaf(x41, l[1], s1); s2 = fmaf(x42, l[2], s2); s3 = fmaf(x43, l[3], s3); } { const f32x4 l = *(const LAS f32x4*)(Lc + 316); s0 = fmaf(x44, l[0], s0); s1 = fmaf(x45, l[1], s1); s2 = fmaf(x46, l[2], s2); s3 = fmaf(x47, l[3], s3); } { const f32x4 l = *(const LAS f32x4*)(Lc + 320); s0 = fmaf(x48, l[0], s0); s1 = fmaf(x49, l[1], s1); s2 = fmaf(x50, l[2], s2); s3 = fmaf(x51, l[3], s3); } { const f32x4 l = *(const LAS f32x4*)(Lc + 324); s0 = fmaf(x52, l[0], s0); s1 = fmaf(x53, l[1], s1); s2 = fmaf(x54, l[2], s2); s3 = fmaf(x55, l[3], s3); } { const f32x4 l = *(const LAS f32x4*)(Lc + 328); s0 = fmaf(x56, l[0], s0); s1 = fmaf(x57, l[1], s1); s2 = fmaf(x58, l[2], s2); s3 = fmaf(x59, l[3], s3); } { const f32x4 l = *(const LAS f32x4*)(Lc + 332); s0 = fmaf(x60, l[0], s0); s1 = fmaf(x61, l[1], s1); s2 = fmaf(x62, l[2], s2); s3 = fmaf(x63, l[3], s3); } x4 = (lane == 4) ? 1.0f : -((s0 + s1) + (s2 + s3)); asm volatile("" : "+v"(x4) : : "memory"); }
    { float s0 = 0.f, s1 = 0.f, s2 = 0.f, s3 = 0.f; { const f32x4 l = *(const LAS f32x4*)(Lc + 208); s0 = fmaf(x4, l[0], s0); s1 = fmaf(x5, l[1], s1); s2 = fmaf(x6, l[2], s2); s3 = fmaf(x7, l[3], s3); } { const f32x4 l = *(const LAS f32x4*)(Lc + 212); s0 = fmaf(x8, l[0], s0); s1 = fmaf(x9, l[1], s1); s2 = fmaf(x10, l[2], s2); s3 = fmaf(x11, l[3], s3); } { const f32x4 l = *(const LAS f32x4*)(Lc + 216); s0 = fmaf(x12, l[0], s0); s1 = fmaf(x13, l[1], s1); s2 = fmaf(x14, l[2], s2); s3 = fmaf(x15, l[3], s3); } { const f32x4 l = *(const LAS f32x4*)(Lc + 220); s0 = fmaf(x16, l[0], s0); s1 = fmaf(x17, l[1], s1); s2 = fmaf(x18, l[2], s2); s3 = fmaf(x19, l[3], s3); } { const f32x4 l = *(const LAS f32x4*)(Lc + 224); s0 = fmaf(x20, l[0], s0); s1 = fmaf(x21, l[1], s1); s2 = fmaf(x22, l[2], s2); s3 = fmaf(x23, l[3], s3); } { const f32x4 l = *(const LAS f32x4*)(Lc + 228); s0 = fmaf(x24, l[0], s0); s1 = fmaf(x25, l[1], s1); s2 = fmaf(x26, l[2], s2); s3 = fmaf(x27, l[3], s3); } { const f32x4 l = *(const LAS f32x4*)(Lc + 232); s0 = fmaf(x28, l[0], s0); s1 = fmaf(x29, l[1], s1); s2 = fmaf(x30, l[2], s2); s3 = fmaf(x31, l[3], s3); } { const f32x4 l = *(const LAS f32x4*)(Lc + 236); s0 = fmaf(x32, l[0], s0); s1 = fmaf(x33, l[1], s1); s2 = fmaf(x34, l[2], s2); s3 = fmaf(x35, l[3], s3); } { const f32x4 l = *(const LAS f32x4*)(Lc + 240); s0 = fmaf(x36, l[0], s0); s1 = fmaf(x37, l[1], s1); s2 = fmaf(x38, l[2], s2); s3 = fmaf(x39, l[3], s3); } { const f32x4 l = *(const LAS f32x4*)(Lc + 244); s0 = fmaf(x40, l[0], s0); s1 = fmaf(x41, l[1], s1); s2 = fmaf(x42, l[2], s2); s3 = fmaf(x43, l[3], s3); } { const f32x4 l = *(const LAS f32x4*)(Lc + 248); s0 = fmaf(x44, l[0], s0); s1 = fmaf(x45, l[1], s1); s2 = fmaf(x46, l[2], s2); s3 = fmaf(x47, l[3], s3); } { const f32x4 l = *(const LAS f32x4*)(Lc + 252); s0 = fmaf(x48, l[0], s0); s1 = fmaf(x49, l[1], s1); s2 = fmaf(x50, l[2], s2); s3 = fmaf(x51, l[3], s3); } { const f32x4 l = *(const LAS f32x4*)(Lc + 256); s0 = fmaf(x52, l[0], s0); s1 = fmaf(x53, l[1], s1); s2 = fmaf(x54, l[2], s2); s3 = fmaf(x55, l[3], s3); } { const f32x4 l = *(const LAS f32x4*)(Lc + 260); s0 = fmaf(x56, l[0], s0); s1 = fmaf(x57, l[1], s1); s2 = fmaf(x58, l[2], s2); s3 = fmaf(x59, l[3], s3); } { const f32x4 l = *(const LAS f32x4*)(Lc + 264); s0 = fmaf(x60, l[0], s0); s1 = fmaf(x61, l[1], s1); s2 = fmaf(x62, l[2], s2); s3 = fmaf(x63, l[3], s3); } x3 = (lane == 3) ? 1.0f : -((s0 + s1) + (s2 + s3)); asm volatile("" : "+v"(x3) : : "memory"); }
    { float s0 = 0.f, s1 = 0.f, s2 = 0.f, s3 = 0.f; { const f32x4 l = *(const LAS f32x4*)(Lc + 136); s3 = fmaf(x3, l[3], s3); } { const f32x4 l = *(const LAS f32x4*)(Lc + 140); s0 = fmaf(x4, l[0], s0); s1 = fmaf(x5, l[1], s1); s2 = fmaf(x6, l[2], s2); s3 = fmaf(x7, l[3], s3); } { const f32x4 l = *(const LAS f32x4*)(Lc + 144); s0 = fmaf(x8, l[0], s0); s1 = fmaf(x9, l[1], s1); s2 = fmaf(x10, l[2], s2); s3 = fmaf(x11, l[3], s3); } { const f32x4 l = *(const LAS f32x4*)(Lc + 148); s0 = fmaf(x12, l[0], s0); s1 = fmaf(x13, l[1], s1); s2 = fmaf(x14, l[2], s2); s3 = fmaf(x15, l[3], s3); } { const f32x4 l = *(const LAS f32x4*)(Lc + 152); s0 = fmaf(x16, l[0], s0); s1 = fmaf(x17, l[1], s1); s2 = fmaf(x18, l[2], s2); s3 = fmaf(x19, l[3], s3); } { const f32x4 l = *(const LAS f32x4*)(Lc + 156); s0 = fmaf(x20, l[0], s0); s1 = fmaf(x21, l[1], s1); s2 = fmaf(x22, l[2], s2); s3 = fmaf(x23, l[3], s3); } { const f32x4 l = *(const LAS f32x4*)(Lc + 160); s0 = fmaf(x24, l[0], s0); s1 = fmaf(x25, l[1], s1); s2 = fmaf(x26, l[2], s2); s3 = fmaf(x27, l[3], s3); } { const f32x4 l = *(const LAS f32x4*)(Lc + 164); s0 = fmaf(x28, l[0], s0); s1 = fmaf(x29, l[1], s1); s2 = fmaf(x30, l[2], s2); s3 = fmaf(x31, l[3], s3); } { const f32x4 l = *(const LAS f32x4*)(Lc + 168); s0 = fmaf(x32, l[0], s0); s1 = fmaf(x33, l[1], s1); s2 = fmaf(x34, l[2], s2); s3 = fmaf(x35, l[3], s3); } { const f32x4 l = *(const LAS f32x4*)(Lc + 172); s0 = fmaf(x36, l[0], s0); s1 = fmaf(x37, l[1], s1); s2 = fmaf(x38, l[2], s2); s3 = fmaf(x39, l[3], s3); } { const f32x4 l = *(const LAS f32x4*)(Lc + 176); s0 = fmaf(x40, l[0], s0); s1 = fmaf(x41, l[1], s1); s2 = fmaf(x42, l[2], s2); s3 = fmaf(x43, l[3], s3); } { const f32x4 l = *(const LAS f32x4*)(Lc + 180); s0 = fmaf(x44, l[0], s0); s1 = fmaf(x45, l[1], s1); s2 = fmaf(x46, l[2], s2); s3 = fmaf(x47, l[3], s3); } { const f32x4 l = *(const LAS f32x4*)(Lc + 184); s0 = fmaf(x48, l[0], s0); s1 = fmaf(x49, l[1], s1); s2 = fmaf(x50, l[2], s2); s3 = fmaf(x51, l[3], s3); } { const f32x4 l = *(const LAS f32x4*)(Lc + 188); s0 = fmaf(x52, l[0], s0); s1 = fmaf(x53, l[1], s1); s2 = fmaf(x54, l[2], s2); s3 = fmaf(x55, l[3], s3); } { const f32x4 l = *(const LAS f32x4*)(Lc + 192); s0 = fmaf(x56, l[0], s0); s1 = fmaf(x57, l[1], s1); s2 = fmaf(x58, l[2], s2); s3 = fmaf(x59, l[3], s3); } { const f32x4 l = *(const LAS f32x4*)(Lc + 196); s0 = fmaf(x60, l[0], s0); s1 = fmaf(x61, l[1], s1); s2 = fmaf(x62, l[2], s2); s3 = fmaf(x63, l[3], s3); } x2 = (lane == 2) ? 1.0f : -((s0 + s1) + (s2 + s3)); asm volatile("" : "+v"(x2) : : "memory"); }
    { float s0 = 0.f, s1 = 0.f, s2 = 0.f, s3 = 0.f; { const f32x4 l = *(const LAS f32x4*)(Lc + 68); s2 = fmaf(x2, l[2], s2); s3 = fmaf(x3, l[3], s3); } { const f32x4 l = *(const LAS f32x4*)(Lc + 72); s0 = fmaf(x4, l[0], s0); s1 = fmaf(x5, l[1], s1); s2 = fmaf(x6, l[2], s2); s3 = fmaf(x7, l[3], s3); } { const f32x4 l = *(const LAS f32x4*)(Lc + 76); s0 = fmaf(x8, l[0], s0); s1 = fmaf(x9, l[1], s1); s2 = fmaf(x10, l[2], s2); s3 = fmaf(x11, l[3], s3); } { const f32x4 l = *(const LAS f32x4*)(Lc + 80); s0 = fmaf(x12, l[0], s0); s1 = fmaf(x13, l[1], s1); s2 = fmaf(x14, l[2], s2); s3 = fmaf(x15, l[3], s3); } { const f32x4 l = *(const LAS f32x4*)(Lc + 84); s0 = fmaf(x16, l[0], s0); s1 = fmaf(x17, l[1], s1); s2 = fmaf(x18, l[2], s2); s3 = fmaf(x19, l[3], s3); } { const f32x4 l = *(const LAS f32x4*)(Lc + 88); s0 = fmaf(x20, l[0], s0); s1 = fmaf(x21, l[1], s1); s2 = fmaf(x22, l[2], s2); s3 = fmaf(x23, l[3], s3); } { const f32x4 l = *(const LAS f32x4*)(Lc + 92); s0 = fmaf(x24, l[0], s0); s1 = fmaf(x25, l[1], s1); s2 = fmaf(x26, l[2], s2); s3 = fmaf(x27, l[3], s3); } { const f32x4 l = *(const LAS f32x4*)(Lc + 96); s0 = fmaf(x28, l[0], s0); s1 = fmaf(x29, l[1], s1); s2 = fmaf(x30, l[2], s2); s3 = fmaf(x31, l[3], s3); } { const f32x4 l = *(const LAS f32x4*)(Lc + 100); s0 = fmaf(x32, l[0], s0); s1 = fmaf(x33, l[1], s1); s2 = fmaf(x34, l[2], s2); s3 = fmaf(x35, l[3], s3); } { const f32x4 l = *(const LAS f32x4*)(Lc + 104); s0 = fmaf(x36, l[0], s0); s1 = fmaf(x37, l[1], s1); s2 = fmaf(x38, l[2], s2); s3 = fmaf(x39, l[3], s3); } { const f32x4 l = *(const LAS f32x4*)(Lc + 108); s0 = fmaf(x40, l[0], s0); s1 = fmaf(x41, l[1], s1); s2 = fmaf(x42, l[2], s2); s3 = fmaf(x43, l[3], s3); } { const f32x4 l = *(const LAS f32x4*)(Lc + 112); s0 = fmaf(x44, l[0], s0); s1 = fmaf(x45, l[1], s1); s2 = fmaf(x46, l[2], s2); s3 = fmaf(x47, l[3], s3); } { const f32x4 l = *(const LAS f32x4*)(Lc + 116); s0 = fmaf(x48, l[0], s0); s1 = fmaf(x49, l[1], s1); s2 = fmaf(x50, l[2], s2); s3 = fmaf(x51, l[3], s3); } { const f32x4 l = *(const LAS f32x4*)(Lc + 120); s0 = fmaf(x52, l[0], s0); s1 = fmaf(x53, l[1], s1); s2 = fmaf(x54, l[2], s2); s3 = fmaf(x55, l[3], s3); } { const f32x4 l = *(const LAS f32x4*)(Lc + 124); s0 = fmaf(x56, l[0], s0); s1 = fmaf(x57, l[1], s1); s2 = fmaf(x58, l[2], s2); s3 = fmaf(x59, l[3], s3); } { const f32x4 l = *(const LAS f32x4*)(Lc + 128); s0 = fmaf(x60, l[0], s0); s1 = fmaf(x61, l[1], s1); s2 = fmaf(x62, l[2], s2); s3 = fmaf(x63, l[3], s3); } x1 = (lane == 1) ? 1.0f : -((s0 + s1) + (s2 + s3)); asm volatile("" : "+v"(x1) : : "memory"); }
    { float s0 = 0.f, s1 = 0.f, s2 = 0.f, s3 = 0.f; { const f32x4 l = *(const LAS f32x4*)(Lc + 0); s1 = fmaf(x1, l[1], s1); s2 = fmaf(x2, l[2], s2); s3 = fmaf(x3, l[3], s3); } { const f32x4 l = *(const LAS f32x4*)(Lc + 4); s0 = fmaf(x4, l[0], s0); s1 = fmaf(x5, l[1], s1); s2 = fmaf(x6, l[2], s2); s3 = fmaf(x7, l[3], s3); } { const f32x4 l = *(const LAS f32x4*)(Lc + 8); s0 = fmaf(x8, l[0], s0); s1 = fmaf(x9, l[1], s1); s2 = fmaf(x10, l[2], s2); s3 = fmaf(x11, l[3], s3); } { const f32x4 l = *(const LAS f32x4*)(Lc + 12); s0 = fmaf(x12, l[0], s0); s1 = fmaf(x13, l[1], s1); s2 = fmaf(x14, l[2], s2); s3 = fmaf(x15, l[3], s3); } { const f32x4 l = *(const LAS f32x4*)(Lc + 16); s0 = fmaf(x16, l[0], s0); s1 = fmaf(x17, l[1], s1); s2 = fmaf(x18, l[2], s2); s3 = fmaf(x19, l[3], s3); } { const f32x4 l = *(const LAS f32x4*)(Lc + 20); s0 = fmaf(x20, l[0], s0); s1 = fmaf(x21, l[1], s1); s2 = fmaf(x22, l[2], s2); s3 = fmaf(x23, l[3], s3); } { const f32x4 l = *(const LAS f32x4*)(Lc + 24); s0 = fmaf(x24, l[0], s0); s1 = fmaf(x25, l[1], s1); s2 = fmaf(x26, l[2], s2); s3 = fmaf(x27, l[3], s3); } { const f32x4 l = *(const LAS f32x4*)(Lc + 28); s0 = fmaf(x28, l[0], s0); s1 = fmaf(x29, l[1], s1); s2 = fmaf(x30, l[2], s2); s3 = fmaf(x31, l[3], s3); } { const f32x4 l = *(const LAS f32x4*)(Lc + 32); s0 = fmaf(x32, l[0], s0); s1 = fmaf(x33, l[1], s1); s2 = fmaf(x34, l[2], s2); s3 = fmaf(x35, l[3], s3); } { const f32x4 l = *(const LAS f32x4*)(Lc + 36); s0 = fmaf(x36, l[0], s0); s1 = fmaf(x37, l[1], s1); s2 = fmaf(x38, l[2], s2); s3 = fmaf(x39, l[3], s3); } { const f32x4 l = *(const LAS f32x4*)(Lc + 40); s0 = fmaf(x40, l[0], s0); s1 = fmaf(x41, l[1], s1); s2 = fmaf(x42, l[2], s2); s3 = fmaf(x43, l[3], s3); } { const f32x4 l = *(const LAS f32x4*)(Lc + 44); s0 = fmaf(x44, l[0], s0); s1 = fmaf(x45, l[1], s1); s2 = fmaf(x46, l[2], s2); s3 = fmaf(x47, l[3], s3); } { const f32x4 l = *(const LAS f32x4*)(Lc + 48); s0 = fmaf(x48, l[0], s0); s1 = fmaf(x49, l[1], s1); s2 = fmaf(x50, l[2], s2); s3 = fmaf(x51, l[3], s3); } { const f32x4 l = *(const LAS f32x4*)(Lc + 52); s0 = fmaf(x52, l[0], s0); s1 = fmaf(x53, l[1], s1); s2 = fmaf(x54, l[2], s2); s3 = fmaf(x55, l[3], s3); } { const f32x4 l = *(const LAS f32x4*)(Lc + 56); s0 = fmaf(x56, l[0], s0); s1 = fmaf(x57, l[1], s1); s2 = fmaf(x58, l[2], s2); s3 = fmaf(x59, l[3], s3); } { const f32x4 l = *(const LAS f32x4*)(Lc + 60); s0 = fmaf(x60, l[0], s0); s1 = fmaf(x61, l[1], s1); s2 = fmaf(x62, l[2], s2); s3 = fmaf(x63, l[3], s3); } x0 = (lane == 0) ? 1.0f : -((s0 + s1) + (s2 + s3)); asm volatile("" : "+v"(x0) : : "memory"); }
    { v4u o; o.x = cvtpk(x0, x1); o.y = cvtpk(x2, x3); o.z = cvtpk(x4, x5); o.w = cvtpk(x6, x7); *(LAS v4u*)(Xs + lane * 72 + 0) = o; }
    { v4u o; o.x = cvtpk(x8, x9); o.y = cvtpk(x10, x11); o.z = cvtpk(x12, x13); o.w = cvtpk(x14, x15); *(LAS v4u*)(Xs + lane * 72 + 8) = o; }
    { v4u o; o.x = cvtpk(x16, x17); o.y = cvtpk(x18, x19); o.z = cvtpk(x20, x21); o.w = cvtpk(x22, x23); *(LAS v4u*)(Xs + lane * 72 + 16) = o; }
    { v4u o; o.x = cvtpk(x24, x25); o.y = cvtpk(x26, x27); o.z = cvtpk(x28, x29); o.w = cvtpk(x30, x31); *(LAS v4u*)(Xs + lane * 72 + 24) = o; }
    { v4u o; o.x = cvtpk(x32, x33); o.y = cvtpk(x34, x35); o.z = cvtpk(x36, x37); o.w = cvtpk(x38, x39); *(LAS v4u*)(Xs + lane * 72 + 32) = o; }
    { v4u o; o.x = cvtpk(x40, x41); o.y = cvtpk(x42, x43); o.z = cvtpk(x44, x45); o.w = cvtpk(x46, x47); *(LAS v4u*)(Xs + lane * 72 + 40) = o; }
    { v4u o; o.x = cvtpk(x48, x49); o.y = cvtpk(x50, x51); o.z = cvtpk(x52, x53); o.w = cvtpk(x54, x55); *(LAS v4u*)(Xs + lane * 72 + 48) = o; }
    { v4u o; o.x = cvtpk(x56, x57); o.y = cvtpk(x58, x59); o.z = cvtpk(x60, x61); o.w = cvtpk(x62, x63); *(LAS v4u*)(Xs + lane * 72 + 56) = o; }
}
#ifndef G1P
#define G1P 15
#endif

#define MF16(a, b, c) __builtin_amdgcn_mfma_f32_16x16x32_bf16((a), (b), (c), 0, 0, 0)
__device__ __forceinline__ bf16x8 ld16g(const bf16* p) { return *(const GAS bf16x8*)p; }
__device__ __forceinline__ float ldbf(const bf16* p) { return __uint_as_float(((unsigned)*(const GAS unsigned short*)p) << 16); }
__device__ __forceinline__ void st8(bf16* p, float a, float b, float c, float d) { u32x2v o; o.x = cvtpk(a, b); o.y = cvtpk(c, d); *(GAS u32x2v*)p = o; }

__device__ __forceinline__ void p_ga(const Frame& F, const Args& a, int L) {
    GAS unsigned char* ws = (GAS unsigned char*)a.ws; asm volatile("" : "+s"(ws)); int lane_ = F.lane; asm volatile("" : "+v"(lane_)); const int j = L >> 1, lane = lane_;
    const bf16* PO = (const bf16*)(ws + WS_ARENA + AR_PO);
    bf16 *QN = (bf16*)(ws + WS_ARENA + AR_QN), *KN = (bf16*)(ws + WS_ARENA + AR_KN), *KGT = (bf16*)(ws + WS_ARENA + AR_KGT), *VBT = (bf16*)(ws + WS_ARENA + AR_VBT), *KTT = (bf16*)(ws + WS_ARENA + AR_KTT);
    float* gbeta = (float*)(ws + WS_GB) + S_ * 8; float* dn = (float*)(ws + WS_TOK + TOK_DN); float* gcs = (float*)(ws + WS_GC);
    const float* cw = (const float*)a.in[16] + (size_t)j * 4 * 3072;
    LAS bf16* tile = (LAS bf16*)(F.lds + F.wave * WAVE_LDS);
    const int dg = lane & 15, ts = lane >> 4, d0 = 8 * dg;
#pragma unroll 1
    for (int tp_ = 2 * F.vcu + (F.wave >> 2); tp_ < 512; tp_ += 2 * F.G) {
        const int u = (4 * (tp_ >> 3) + (F.wave & 3)) * 8 + (tp_ & 7);
        const int n = u >> 3, hh = u & 7, tok0 = 64 * n;
        float sA, sB, sBeta;
        {
            const float ealog = expf(*(const GAS float*)((const float*)a.in[17] + j * 8 + hh)), dtb = *(const GAS float*)((const float*)a.in[18] + j * 8 + hh);
            const float bb = ldbf(PO + (size_t)(tok0 + lane) * OIN + OIN_W + hh), aa = ldbf(PO + (size_t)(tok0 + lane) * OIN + OIN_W + 8 + hh);
            const float beta = sigm(bb); const float zz = aa + dtb; const float gv = -ealog * (zz > 20.f ? zz : log1pf(expf(zz)));
            *(GAS float*)(gbeta + (size_t)(tok0 + lane) * 8 + hh) = beta;
            float gc = gv;
#pragma unroll
            for (int o = 1; o < 64; o <<= 1) { const float t = __shfl_up(gc, o); if (lane >= o) gc += t; }
            const float glast = __shfl(gc, 63);
            *(GAS float*)(gcs + (size_t)(tok0 + lane) * 8 + hh) = gc;
            if (lane == 0) dn[u] = expf(glast);
            sA = beta * expf(gc); sB = expf(glast - gc); sBeta = beta;
        }
#pragma unroll 1
        for (int qkv = 0; qkv < 3; ++qkv) {
            const int coff = qkv * 1024 + hh * 128 + d0;
            float w[4][8];
#pragma unroll
            for (int jj = 0; jj < 4; ++jj)
#pragma unroll
                for (int e = 0; e < 8; ++e) w[jj][e] = *(const GAS float*)(cw + jj * 3072 + coff + e);
            asm volatile("s_waitcnt lgkmcnt(0)" ::: "memory");
#pragma unroll 4
            for (int it = 0; it < 16; ++it) {
                const int i = 4 * it + ts, tok = tok0 + i; float acc[8];
                v4u rv[4];
#pragma unroll
                for (int jj = 0; jj < 4; ++jj) { const int r = tok - 3 + jj; rv[jj] = *(const GAS v4u*)(PO + (size_t)(r < 0 ? 0 : r) * OIN + coff); }
#pragma unroll
                for (int e = 0; e < 8; ++e) acc[e] = 0.f;
#pragma unroll
                for (int jj = 0; jj < 4; ++jj) { const float on = (tok - 3 + jj >= 0) ? 1.0f : 0.0f; const unsigned vv[4] = {rv[jj].x, rv[jj].y, rv[jj].z, rv[jj].w};
#pragma unroll
                    for (int q = 0; q < 4; ++q) { acc[2 * q] += (w[jj][2 * q] * on) * bflo(vv[q]); acc[2 * q + 1] += (w[jj][2 * q + 1] * on) * bfhi(vv[q]); } }
                float ss = 0.f;
#pragma unroll
                for (int e = 0; e < 8; ++e) { acc[e] = silu(acc[e]); ss += acc[e] * acc[e]; }
                ss += __shfl_xor(ss, 1); ss += __shfl_xor(ss, 2); ss += __shfl_xor(ss, 4); ss += __shfl_xor(ss, 8);
                const float rn = __builtin_amdgcn_rsqf(ss + 1e-6f);
                const float s1 = (qkv == 0) ? rn * 0.08838834764831845f : (qkv == 1 ? rn : 1.0f);
                v4u o; o.x = cvtpk(acc[0] * s1, acc[1] * s1); o.y = cvtpk(acc[2] * s1, acc[3] * s1); o.z = cvtpk(acc[4] * s1, acc[5] * s1); o.w = cvtpk(acc[6] * s1, acc[7] * s1);
                if (qkv < 2) *(GAS v4u*)((qkv == 0 ? QN : KN) + (size_t)tok * D_ + hh * 128 + d0) = o;
                if (qkv > 0) *(LAS v4u*)(tile + i * 136 + d0) = o;
            }
            if (qkv == 0) continue;
            asm volatile("s_waitcnt lgkmcnt(0)" ::: "memory");
#pragma unroll 1
            for (int half = 0; half < 2; ++half) {
                const int d = 64 * half + lane; const size_t obase = ((size_t)u * 128 + d) * 64;
                const LAS unsigned short* tp = (const LAS unsigned short*)tile + d;
#pragma unroll
                for (int ig = 0; ig < 8; ++ig) {
                    float o1[8], o2[8];
#pragma unroll
                    for (int e = 0; e < 8; ++e) { const int t = 8 * ig + e; const float v = __uint_as_float(((unsigned)tp[t * 136]) << 16);
                        const float m1 = __builtin_bit_cast(float, __builtin_amdgcn_readlane(__builtin_bit_cast(int, (qkv == 1) ? sA : sBeta), t));
                        const float m2 = __builtin_bit_cast(float, __builtin_amdgcn_readlane(__builtin_bit_cast(int, sB), t));
                        o1[e] = v * m1; o2[e] = v * m2; }
                    v4u o; o.x = cvtpk(o1[0], o1[1]); o.y = cvtpk(o1[2], o1[3]); o.z = cvtpk(o1[4], o1[5]); o.w = cvtpk(o1[6], o1[7]);
                    *(GAS v4u*)((qkv == 1 ? KGT : VBT) + obase + 8 * ig) = o;
                    if (qkv == 1) { o.x = cvtpk(o2[0], o2[1]); o.y = cvtpk(o2[2], o2[3]); o.z = cvtpk(o2[4], o2[5]); o.w = cvtpk(o2[6], o2[7]); *(GAS v4u*)(KTT + obase + 8 * ig) = o; }
                }
            }
        }
    }
}

__device__ __forceinline__ void p_g1(const Frame& F, const Args& a) {
    GAS unsigned char* ws = (GAS unsigned char*)a.ws; asm volatile("" : "+s"(ws)); int lane_ = F.lane; asm volatile("" : "+v"(lane_)); const int lane = lane_, r16 = lane & 15, g = lane >> 4;
    const bf16 *QN = (const bf16*)(ws + WS_ARENA + AR_QN), *KN = (const bf16*)(ws + WS_ARENA + AR_KN), *KGT = (const bf16*)(ws + WS_ARENA + AR_KGT), *VBT = (const bf16*)(ws + WS_ARENA + AR_VBT), *KTT = (const bf16*)(ws + WS_ARENA + AR_KTT);
    bf16 *AI = (bf16*)(ws + WS_ARENA + AR_AI), *NEGW = (bf16*)(ws + WS_ARENA + AR_NEGW), *UT = (bf16*)(ws + WS_ARENA + AR_UT);
    const float* gg = (const float*)(ws + WS_GC); const float* gbeta = (const float*)(ws + WS_GB) + S_ * 8;
    LAS float* Lc = (LAS float*)(F.lds + F.wave * WAVE_LDS);
    LAS bf16* Xs = (LAS bf16*)(F.lds + F.wave * WAVE_LDS);
    const f32x4 Z4 = {0.f, 0.f, 0.f, 0.f};
#ifdef PROBE_G1P
    const int g1p = a.use_bar ? 15 : PROBE_G1P;
#else
    const int g1p = 15;
#endif
#pragma unroll 1
    for (int tp_ = 2 * F.vcu + (F.wave >> 2); tp_ < 512; tp_ += 2 * F.G) {
        const int u = (4 * (tp_ >> 3) + (F.wave & 3)) * 8 + (tp_ & 7);
        const int n = u >> 3, hh = u & 7, tok0 = 64 * n; const int uh = hh * NCHUNK + n;
        const float gc = gg[(size_t)(tok0 + lane) * 8 + hh], beta = gbeta[(size_t)(tok0 + lane) * 8 + hh];
        if (g1p & 1) {
        {
            bf16x8 kf[4][4];
#pragma unroll
            for (int t = 0; t < 4; ++t)
#pragma unroll
                for (int kk = 0; kk < 4; ++kk) kf[t][kk] = ld16g(KN + (size_t)(tok0 + 16 * t + r16) * D_ + hh * 128 + 32 * kk + 8 * g);
#pragma unroll
            for (int ti = 0; ti < 4; ++ti)
#pragma unroll
                for (int tj = 0; tj <= ti; ++tj) {
                    f32x4 Dv = Z4;
#pragma unroll
                    for (int kk = 0; kk < 4; ++kk) Dv = MF16(kf[ti][kk], kf[tj][kk], Dv);
                    const int jx = 16 * tj + r16; const float gcj = __shfl(gc, jx); f32x4 val;
#pragma unroll
                    for (int r = 0; r < 4; ++r) { const int ix = 16 * ti + 4 * g + r; const float gci = __shfl(gc, ix), bi = __shfl(beta, ix); val[r] = (ix > jx) ? bi * Dv[r] * expf(gci - gcj) : 0.f; }
                    *(LAS f32x4*)(Lc + jx * 68 + 16 * ti + 4 * g) = val;
                }
#pragma unroll
            for (int ti = 0; ti < 4; ++ti) {
                bf16x8 qf[4];
#pragma unroll
                for (int kk = 0; kk < 4; ++kk) qf[kk] = ld16g(QN + (size_t)(tok0 + 16 * ti + r16) * D_ + hh * 128 + 32 * kk + 8 * g);
                const int ix = 16 * ti + r16; const float gci = __shfl(gc, ix);
#pragma unroll
                for (int tj = 0; tj < 4; ++tj) {
                    f32x4 val = Z4;
                    if (tj <= ti) {
                        f32x4 Dv = Z4;
#pragma unroll
                        for (int kk = 0; kk < 4; ++kk) Dv = MF16(kf[tj][kk], qf[kk], Dv);
#pragma unroll
                        for (int r = 0; r < 4; ++r) { const int jx = 16 * tj + 4 * g + r; const float gcj = __shfl(gc, jx); val[r] = (ix >= jx) ? Dv[r] * expf(gci - gcj) : 0.f; }
                    }
                    st8(AI + ((size_t)u * 64 + ix) * 64 + 16 * tj + 4 * g, val[0], val[1], val[2], val[3]);
                }
            }
        }
        asm volatile("s_waitcnt lgkmcnt(0)" ::: "memory");
        }
        if (g1p & 2) {
        tri_solve(Lc, Xs, lane);
        }
        if (g1p & 4) {
        asm volatile("s_waitcnt lgkmcnt(0)" ::: "memory");
        {
            bf16x8 xf[4][2];
#pragma unroll
            for (int t = 0; t < 4; ++t)
#pragma unroll
                for (int kk = 0; kk < 2; ++kk) xf[t][kk] = *(const LAS bf16x8*)(Xs + (16 * t + r16) * 72 + 32 * kk + 8 * g);
#pragma unroll 2
            for (int td = 0; td < 8; ++td) {
                const size_t rb = ((size_t)u * 128 + 16 * td + r16) * 64;
                const bf16x8 vb0 = ld16g(VBT + rb + 8 * g), vb1 = ld16g(VBT + rb + 32 + 8 * g), kg0 = ld16g(KGT + rb + 8 * g), kg1 = ld16g(KGT + rb + 32 + 8 * g);
#pragma unroll
                for (int ti = 0; ti < 4; ++ti) {
                    f32x4 Du = MF16(xf[ti][0], vb0, Z4); Du = MF16(xf[ti][1], vb1, Du);
                    st8(UT + rb + 16 * ti + 4 * g, Du[0], Du[1], Du[2], Du[3]);
                    f32x4 Dn = MF16(kg0, xf[ti][0], Z4); Dn = MF16(kg1, xf[ti][1], Dn);
                    st8(NEGW + (size_t)(tok0 + 16 * ti + r16) * D_ + hh * 128 + 16 * td + 4 * g, -Dn[0], -Dn[1], -Dn[2], -Dn[3]);
                }
            }
        }
        }
    }
}

template <int NS, int SGSTEP> __device__ __forceinline__ void p_g2(const Frame& F, const Args& a, const bf16* MPsrc, const bf16* NTsrc, const float* dnsrc) {
    GAS unsigned char* ws = (GAS unsigned char*)a.ws; asm volatile("" : "+s"(ws)); int lane_ = F.lane; asm volatile("" : "+v"(lane_)); const int lane = lane_, r16 = lane & 15, g = lane >> 4, w = F.wave;
    const bf16 *MP = MPsrc, *NT = NTsrc; bf16* SG = (bf16*)(ws + WS_ARENA + AR_SG);
    const float* dn = dnsrc;
    LAS bf16* St = (LAS bf16*)F.lds;
    const int args_use_bar = a.use_bar; (void)args_use_bar;
#pragma unroll 1
    for (int asg = F.vcu; asg < 64; asg += F.G) {
        const int hh = asg >> 3, sl = asg & 7;
        __syncthreads();
        for (int idx = F.tid; idx < 2 * 16 * 136 / 2; idx += NWAVES * 64) ((LAS unsigned*)St)[idx] = 0u;
        __syncthreads();
        if (w >= 4) {
            const int st = F.tid - 256, row = st >> 4, chunk = st & 15;
#pragma unroll 1
            for (int n = 0; n < NS; ++n) {
                const v4u v = *(const LAS v4u*)(St + (n & 1) * (16 * 136) + row * 136 + chunk * 8);
                *(GAS v4u*)(SG + ((size_t)(hh * NCHUNK + n * SGSTEP) * 128 + 16 * sl + row) * 128 + chunk * 8) = v;
                asm volatile("s_waitcnt lgkmcnt(0)" ::: "memory"); __builtin_amdgcn_s_barrier(); asm volatile("" ::: "memory");
            }
        } else {
            f32x4 Sv[2] = {{0.f, 0.f, 0.f, 0.f}, {0.f, 0.f, 0.f, 0.f}};
            bf16x8 A0[2][4], A1[2][4], A2[2][4], A3[2][4]; u32x2v C0[2], C1[2], C2[2], C3[2]; float d0, d1, d2, d3;
#define G2_LOAD(AX, CX, DX, nn) do { const int u_ = hh * NS + (nn); \
            _Pragma("unroll") for (int t = 0; t < 2; ++t) { \
                _Pragma("unroll") for (int kk = 0; kk < 4; ++kk) AX[t][kk] = ld16g(MP + ((size_t)u_ * 128 + 32 * w + 16 * t + r16) * 128 + 32 * kk + 8 * g); \
                CX[t] = *(const GAS u32x2v*)(NT + ((size_t)u_ * 128 + 16 * sl + r16) * 128 + 32 * w + 16 * t + 4 * g); } \
            DX = *(const GAS float*)(dn + (nn) * 8 + hh); } while (0)
#ifdef PROBE_G2_NOLOAD
#define G2_STEPLOAD(AL, CL, DL, nn) do { if (args_use_bar) G2_LOAD(AL, CL, DL, nn); } while (0)
#else
#define G2_STEPLOAD(AL, CL, DL, nn) G2_LOAD(AL, CL, DL, nn)
#endif
#define G2_STEP(AU, CU, DU, AL, CL, DL, nn) do { const int n_ = (nn); const int n2_ = (n_ + 3 < NS) ? n_ + 3 : NS - 1; \
            G2_STEPLOAD(AL, CL, DL, n2_); \
            LAS bf16* Sc = St + (n_ & 1) * (16 * 136); LAS bf16* Sn = St + ((n_ & 1) ^ 1) * (16 * 136); \
            f32x4 D0 = {bflo(CU[0].x), bfhi(CU[0].x), bflo(CU[0].y), bfhi(CU[0].y)}, D1 = {bflo(CU[1].x), bfhi(CU[1].x), bflo(CU[1].y), bfhi(CU[1].y)}; \
            _Pragma("unroll") for (int kk = 0; kk < 4; ++kk) { const bf16x8 Bf = *(const LAS bf16x8*)(Sc + r16 * 136 + 32 * kk + 8 * g); D0 = MF16(AU[0][kk], Bf, D0); D1 = MF16(AU[1][kk], Bf, D1); } \
            Sv[0] = Sv[0] * DU + D0; Sv[1] = Sv[1] * DU + D1; \
            { u32x2v o; o.x = cvtpk(Sv[0][0], Sv[0][1]); o.y = cvtpk(Sv[0][2], Sv[0][3]); *(LAS u32x2v*)(Sn + r16 * 136 + 32 * w + 4 * g) = o; \
              o.x = cvtpk(Sv[1][0], Sv[1][1]); o.y = cvtpk(Sv[1][2], Sv[1][3]); *(LAS u32x2v*)(Sn + r16 * 136 + 32 * w + 16 + 4 * g) = o; } \
            asm volatile("s_waitcnt lgkmcnt(0)" ::: "memory"); __builtin_amdgcn_s_barrier(); asm volatile("" ::: "memory"); } while (0)
            G2_LOAD(A0, C0, d0, 0); G2_LOAD(A1, C1, d1, 1); G2_LOAD(A2, C2, d2, 2);
            static_assert(NS % 24 == 16, "scan loop: trips of 24 steps + a 16-step tail");
            int n = 0;
#pragma unroll 1
            for (; n + 24 <= NS - 16; n += 24) {
                G2_STEP(A0, C0, d0, A3, C3, d3, n + 0);
                G2_STEP(A1, C1, d1, A0, C0, d0, n + 1);
                G2_STEP(A2, C2, d2, A1, C1, d1, n + 2);
                G2_STEP(A3, C3, d3, A2, C2, d2, n + 3);
                G2_STEP(A0, C0, d0, A3, C3, d3, n + 4);
                G2_STEP(A1, C1, d1, A0, C0, d0, n + 5);
                G2_STEP(A2, C2, d2, A1, C1, d1, n + 6);
                G2_STEP(A3, C3, d3, A2, C2, d2, n + 7);
                G2_STEP(A0, C0, d0, A3, C3, d3, n + 8);
                G2_STEP(A1, C1, d1, A0, C0, d0, n + 9);
                G2_STEP(A2, C2, d2, A1, C1, d1, n + 10);
                G2_STEP(A3, C3, d3, A2, C2, d2, n + 11);
                G2_STEP(A0, C0, d0, A3, C3, d3, n + 12);
                G2_STEP(A1, C1, d1, A0, C0, d0, n + 13);
                G2_STEP(A2, C2, d2, A1, C1, d1, n + 14);
                G2_STEP(A3, C3, d3, A2, C2, d2, n + 15);
                G2_STEP(A0, C0, d0, A3, C3, d3, n + 16);
                G2_STEP(A1, C1, d1, A0, C0, d0, n + 17);
                G2_STEP(A2, C2, d2, A1, C1, d1, n + 18);
                G2_STEP(A3, C3, d3, A2, C2, d2, n + 19);
                G2_STEP(A0, C0, d0, A3, C3, d3, n + 20);
                G2_STEP(A1, C1, d1, A0, C0, d0, n + 21);
                G2_STEP(A2, C2, d2, A1, C1, d1, n + 22);
                G2_STEP(A3, C3, d3, A2, C2, d2, n + 23);
            }
            G2_STEP(A0, C0, d0, A3, C3, d3, n + 0);
            G2_STEP(A1, C1, d1, A0, C0, d0, n + 1);
            G2_STEP(A2, C2, d2, A1, C1, d1, n + 2);
            G2_STEP(A3, C3, d3, A2, C2, d2, n + 3);
            G2_STEP(A0, C0, d0, A3, C3, d3, n + 4);
            G2_STEP(A1, C1, d1, A0, C0, d0, n + 5);
            G2_STEP(A2, C2, d2, A1, C1, d1, n + 6);
            G2_STEP(A3, C3, d3, A2, C2, d2, n + 7);
            G2_STEP(A0, C0, d0, A3, C3, d3, n + 8);
            G2_STEP(A1, C1, d1, A0, C0, d0, n + 9);
            G2_STEP(A2, C2, d2, A1, C1, d1, n + 10);
            G2_STEP(A3, C3, d3, A2, C2, d2, n + 11);
            G2_STEP(A0, C0, d0, A3, C3, d3, n + 12);
            G2_STEP(A1, C1, d1, A0, C0, d0, n + 13);
            G2_STEP(A2, C2, d2, A1, C1, d1, n + 14);
            G2_STEP(A3, C3, d3, A2, C2, d2, n + 15);
#undef G2_STEP
#undef G2_LOAD
        }
    }
}


constexpr int GST_W = 64 * 136, GST_K = 128 * 68, GST_PAIR = GST_W + GST_K, GST_BYTES = 2 * GST_PAIR * 2, GW_BYTES = 8704;
static_assert(GST_BYTES + 8 * GW_BYTES <= LDSCTL_OFF, "group-phase LDS map");
__device__ __forceinline__ void g_stage(const Frame& F, const bf16* NEGW, const bf16* KTT, int p, int n, int hh, bool on) {
    LAS bf16* sw = (LAS bf16*)F.lds + p * GST_PAIR; LAS bf16* sk = sw + GST_W;
#pragma unroll
    for (int q = 0; q < 2; ++q) { const int idx = F.tid + 512 * q;
        { const int row = idx >> 4, ch = idx & 15; v4u v = {0u, 0u, 0u, 0u}; if (on) v = *(const GAS v4u*)(NEGW + (size_t)(64 * n + row) * D_ + hh * 128 + ch * 8); *(LAS v4u*)(sw + row * 136 + ch * 8) = v; }
        { const int row = idx >> 3, ch = idx & 7; u32x2v a = {0u, 0u}, b = a; if (on) { const v4u v = *(const GAS v4u*)(KTT + ((size_t)(n * 8 + hh) * 128 + row) * 64 + ch * 8); a.x = v.x; a.y = v.y; b.x = v.z; b.y = v.w; }
          *(LAS u32x2v*)(sk + row * 68 + ch * 8) = a; *(LAS u32x2v*)(sk + row * 68 + ch * 8 + 4) = b; } }
}
template <bool PERM> __device__ __forceinline__ void g_prod1(f32x4 (&T)[4][2], const LAS bf16* sw, const bf16x8 (&xo)[4][2], int r16, int g) {
#pragma unroll
    for (int mt = 0; mt < 4; ++mt) {
        bf16x8 af[4];
#pragma unroll
        for (int s = 0; s < 4; ++s) {
            if (PERM) { const LAS bf16* rp = sw + (16 * mt + r16) * 136 + 32 * s + 4 * g; const u32x2v lo = *(const LAS u32x2v*)rp, hi = *(const LAS u32x2v*)(rp + 16); const v4u pk = {lo.x, lo.y, hi.x, hi.y}; af[s] = __builtin_bit_cast(bf16x8, pk); }
            else af[s] = *(const LAS bf16x8*)(sw + (16 * mt + r16) * 136 + 32 * s + 8 * g); }
#pragma unroll
        for (int nt = 0; nt < 2; ++nt)
#pragma unroll
            for (int s = 0; s < 4; ++s) T[mt][nt] = MF16(af[s], xo[s][nt], T[mt][nt]);
        asm volatile("" ::: "memory");
    }
}
__device__ __forceinline__ void g_prod2(f32x4 (&X)[8][2], const LAS bf16* sk, const f32x4 (&T)[4][2], int r16, int g) {
    bf16x8 to[2][2];
#pragma unroll
    for (int s = 0; s < 2; ++s)
#pragma unroll
        for (int nt = 0; nt < 2; ++nt) { v4u p; p.x = cvtpk(T[2 * s][nt][0], T[2 * s][nt][1]); p.y = cvtpk(T[2 * s][nt][2], T[2 * s][nt][3]); p.z = cvtpk(T[2 * s + 1][nt][0], T[2 * s + 1][nt][1]); p.w = cvtpk(T[2 * s + 1][nt][2], T[2 * s + 1][nt][3]);
            to[s][nt] = __builtin_bit_cast(bf16x8, p); }
#pragma unroll
    for (int mt = 0; mt < 8; ++mt) {
        bf16x8 af[2];
#pragma unroll
        for (int s = 0; s < 2; ++s) { const LAS bf16* rp = sk + (16 * mt + r16) * 68 + 32 * s + 4 * g; const u32x2v lo = *(const LAS u32x2v*)rp, hi = *(const LAS u32x2v*)(rp + 16); const v4u pk = {lo.x, lo.y, hi.x, hi.y}; af[s] = __builtin_bit_cast(bf16x8, pk); }
#pragma unroll
        for (int nt = 0; nt < 2; ++nt)
#pragma unroll
            for (int s = 0; s < 2; ++s) X[mt][nt] = MF16(af[s], to[s][nt], X[mt][nt]);
        asm volatile("" ::: "memory");
    }
}
__device__ __forceinline__ void p_g1b(const Frame& F, const Args& a) {
    GAS unsigned char* ws = (GAS unsigned char*)a.ws; asm volatile("" : "+s"(ws)); int lane_ = F.lane; asm volatile("" : "+v"(lane_)); const int lane = lane_, r16 = lane & 15, g = lane >> 4;
    const bf16 *NEGW = (const bf16*)(ws + WS_ARENA + AR_NEGW), *KTT = (const bf16*)(ws + WS_ARENA + AR_KTT), *UT = (const bf16*)(ws + WS_ARENA + AR_UT); const float* dn = (const float*)(ws + WS_TOK + TOK_DN);
    bf16 *MPc = (bf16*)(ws + WS_ARENA + AR_MPC), *NTc = (bf16*)(ws + WS_ARENA + AR_NTC); float* dnc = (float*)(ws + WS_TOK + TOK_DNC);
    const bool isB = F.wave >= 4; const int sl = F.wave & 3, c0 = 32 * sl;
    const LAS bf16* sw = (const LAS bf16*)F.lds; const LAS bf16* sk = sw + GST_W; LAS bf16* wa = (LAS bf16*)(F.lds + GST_BYTES + F.wave * GW_BYTES);
#pragma unroll 1
    for (int tp = 2 * F.vcu; tp < 512; tp += (tp & 1) ? 2 * F.G - 1 : 1) {
        const int hh = tp & 7, gq = tp >> 3;
        f32x4 X[8][2]; float Dd = 1.0f;
#pragma unroll
        for (int mt = 0; mt < 8; ++mt)
#pragma unroll
            for (int nt = 0; nt < 2; ++nt) X[mt][nt] = (f32x4){0.f, 0.f, 0.f, 0.f};
#pragma unroll 1
        for (int i = 0; i < 4; ++i) {
            const int n = 4 * gq + i; const float di = *(const GAS float*)(dn + n * 8 + hh);
            bf16x8 xo[4][2]; const float dadd = isB ? 0.0f : Dd;
#pragma unroll
            for (int s = 0; s < 4; ++s)
#pragma unroll
                for (int nt = 0; nt < 2; ++nt) { v4u pr; const int col = c0 + 16 * nt + r16; f32x4 t0 = X[2 * s][nt], t1 = X[2 * s + 1][nt];
#pragma unroll
                    for (int r = 0; r < 4; ++r) { if (32 * s + 4 * g + r == col) t0[r] += dadd; if (32 * s + 16 + 4 * g + r == col) t1[r] += dadd; }
                    pr.x = cvtpk(t0[0], t0[1]); pr.y = cvtpk(t0[2], t0[3]); pr.z = cvtpk(t1[0], t1[1]); pr.w = cvtpk(t1[2], t1[3]); xo[s][nt] = __builtin_bit_cast(bf16x8, pr); }
            __syncthreads();
            g_stage(F, NEGW, KTT, 0, n, hh, true);
            f32x4 T[4][2];
#pragma unroll
            for (int mt = 0; mt < 4; ++mt)
#pragma unroll
                for (int nt = 0; nt < 2; ++nt) { T[mt][nt] = (f32x4){0.f, 0.f, 0.f, 0.f};
                    if (isB) { const u32x2v uu = *(const GAS u32x2v*)(UT + ((size_t)(n * 8 + hh) * 128 + c0 + 16 * nt + r16) * 64 + 16 * mt + 4 * g); T[mt][nt] = (f32x4){bflo(uu.x), bfhi(uu.x), bflo(uu.y), bfhi(uu.y)}; } }
            __syncthreads();
            g_prod1<true>(T, sw, xo, r16, g);
#pragma unroll
            for (int mt = 0; mt < 8; ++mt)
#pragma unroll
                for (int nt = 0; nt < 2; ++nt) X[mt][nt] = X[mt][nt] * di;
            g_prod2(X, sk, T, r16, g);
            Dd *= di;
        }
        const int uc = hh * 64 + gq;
        if (isB) {
#pragma unroll
            for (int mt = 0; mt < 8; ++mt)
#pragma unroll
                for (int nt = 0; nt < 2; ++nt) st8(NTc + ((size_t)uc * 128 + c0 + 16 * nt + r16) * 128 + 16 * mt + 4 * g, X[mt][nt][0], X[mt][nt][1], X[mt][nt][2], X[mt][nt][3]);
        } else {
            if (sl == 0 && lane == 0) dnc[gq * 8 + hh] = Dd;
#pragma unroll
            for (int hf = 0; hf < 2; ++hf) {
                asm volatile("s_waitcnt lgkmcnt(0)" ::: "memory");
#pragma unroll
                for (int m4 = 0; m4 < 4; ++m4)
#pragma unroll
                    for (int nt = 0; nt < 2; ++nt)
#pragma unroll
                        for (int r = 0; r < 4; ++r) wa[(16 * m4 + 4 * g + r) * 40 + 16 * nt + r16] = (unsigned short)(cvtpk(X[4 * hf + m4][nt][r], 0.f) & 0xffffu);
                asm volatile("s_waitcnt lgkmcnt(0)" ::: "memory");
#pragma unroll
                for (int q = 0; q < 4; ++q) { const int row = 16 * q + (lane >> 2), ch = lane & 3; const v4u v = *(const LAS v4u*)(wa + row * 40 + ch * 8);
                    *(GAS v4u*)(MPc + ((size_t)uc * 128 + 64 * hf + row) * 128 + c0 + ch * 8) = v; }
            }
        }
    }
    __syncthreads();
}

__device__ __forceinline__ void p_g23(const Frame& F, const Args& a, int L) {
    GAS unsigned char* ws = (GAS unsigned char*)a.ws; asm volatile("" : "+s"(ws)); int lane_ = F.lane; asm volatile("" : "+v"(lane_)); const int lane = lane_, r16 = lane & 15, g = lane >> 4;
    const bf16 *NEGW = (const bf16*)(ws + WS_ARENA + AR_NEGW), *KTT = (const bf16*)(ws + WS_ARENA + AR_KTT), *UT = (const bf16*)(ws + WS_ARENA + AR_UT), *SG = (const bf16*)(ws + WS_ARENA + AR_SG),
               *QN = (const bf16*)(ws + WS_ARENA + AR_QN), *AI = (const bf16*)(ws + WS_ARENA + AR_AI), *PO = (const bf16*)(ws + WS_ARENA + AR_PO);
    const float* gcs = (const float*)(ws + WS_GC);
    const float* dn = (const float*)(ws + WS_TOK + TOK_DN); bf16* mix = (bf16*)(ws + WS_MIX); const float* onorm = (const float*)a.in[19] + (L >> 1) * 128;
    const int pw = F.wave >> 2, qf = F.wave & 3, c0 = 32 * qf;
    const LAS bf16* sw = (const LAS bf16*)F.lds + pw * GST_PAIR; const LAS bf16* sk = sw + GST_W; LAS bf16* Sl = (LAS bf16*)(F.lds + GST_BYTES + F.wave * GW_BYTES);
    LAS float* xch = (LAS float*)(F.lds + RT_OFF);
#pragma unroll 1
    for (int tp0 = 2 * F.vcu; tp0 < 512; tp0 += 2 * F.G) {
        const int tp = tp0 + pw; const bool on = tp < 512; const int tpc = on ? tp : 0, hh = tpc & 7, gq = tpc >> 3;
        const int tpa = tp0, tpb = (tp0 + 1 < 512) ? tp0 + 1 : 0;
        { const int u0 = hh * NCHUNK + 4 * gq;
#pragma unroll
          for (int q = 0; q < 8; ++q) { const int row = 4 * q + (lane >> 4), ch = lane & 15; const v4u v = *(const GAS v4u*)(SG + ((size_t)u0 * 128 + c0 + row) * 128 + ch * 8); *(LAS v4u*)(Sl + row * 136 + ch * 8) = v; } }
#pragma unroll 1
        for (int i = 0; i < 4; ++i) {
            __syncthreads();
            g_stage(F, NEGW, KTT, 0, 4 * (tpa >> 3) + i, tpa & 7, tpa < 512); g_stage(F, NEGW, KTT, 1, 4 * (tpb >> 3) + i, tpb & 7, tp0 + 1 < 512);
            const int n = 4 * gq + i, u = n * 8 + hh, tok0 = 64 * n; const float di = *(const GAS float*)(dn + n * 8 + hh);
            f32x4 T[4][2];
#pragma unroll
            for (int mt = 0; mt < 4; ++mt)
#pragma unroll
                for (int nt = 0; nt < 2; ++nt) { const u32x2v uu = *(const GAS u32x2v*)(UT + ((size_t)u * 128 + c0 + 16 * nt + r16) * 64 + 16 * mt + 4 * g); T[mt][nt] = (f32x4){bflo(uu.x), bfhi(uu.x), bflo(uu.y), bfhi(uu.y)}; }
            asm volatile("s_waitcnt lgkmcnt(0)" ::: "memory");
            bf16x8 Bf[4][2];
#pragma unroll
            for (int nt = 0; nt < 2; ++nt)
#pragma unroll
                for (int s = 0; s < 4; ++s) Bf[s][nt] = *(const LAS bf16x8*)(Sl + (16 * nt + r16) * 136 + 32 * s + 8 * g);
            __syncthreads();
            g_prod1<false>(T, sw, Bf, r16, g);
            bf16x8 vo[2][2];
#pragma unroll
            for (int s = 0; s < 2; ++s)
#pragma unroll
                for (int nt = 0; nt < 2; ++nt) { v4u p; p.x = cvtpk(T[2 * s][nt][0], T[2 * s][nt][1]); p.y = cvtpk(T[2 * s][nt][2], T[2 * s][nt][3]); p.z = cvtpk(T[2 * s + 1][nt][0], T[2 * s + 1][nt][1]); p.w = cvtpk(T[2 * s + 1][nt][2], T[2 * s + 1][nt][3]);
                    vo[s][nt] = __builtin_bit_cast(bf16x8, p); }
            f32x4 o[2][4];
#pragma unroll
            for (int it = 0; it < 4; ++it) {
                const int tok = tok0 + 16 * it + r16; bf16x8 qfr[4], afr[2];
                { const float eg = expf(*(const GAS float*)(gcs + (size_t)tok * 8 + hh));
#pragma unroll
                  for (int s = 0; s < 4; ++s) { const v4u qv = *(const GAS v4u*)(QN + (size_t)tok * D_ + hh * 128 + 32 * s + 8 * g); v4u qs;
                      qs.x = cvtpk(bflo(qv.x) * eg, bfhi(qv.x) * eg); qs.y = cvtpk(bflo(qv.y) * eg, bfhi(qv.y) * eg); qs.z = cvtpk(bflo(qv.z) * eg, bfhi(qv.z) * eg); qs.w = cvtpk(bflo(qv.w) * eg, bfhi(qv.w) * eg);
                      qfr[s] = __builtin_bit_cast(bf16x8, qs); } }
#pragma unroll
                for (int s = 0; s < 2; ++s) { const bf16* ap = AI + ((size_t)u * 64 + 16 * it + r16) * 64 + 32 * s + 4 * g; const u32x2v lo = *(const GAS u32x2v*)ap, hi = *(const GAS u32x2v*)(ap + 16);
                    const v4u pk = {lo.x, lo.y, hi.x, hi.y}; afr[s] = __builtin_bit_cast(bf16x8, pk); }
#pragma unroll
                for (int nt = 0; nt < 2; ++nt) { f32x4 Dv = {0.f, 0.f, 0.f, 0.f};
#pragma unroll
                    for (int s = 0; s < 4; ++s) Dv = MF16(Bf[s][nt], qfr[s], Dv);
#pragma unroll
                    for (int s = 0; s < 2; ++s) Dv = MF16(vo[s][nt], afr[s], Dv);
                    o[nt][it] = Dv; }
            }
            __syncthreads();
#pragma unroll
            for (int it = 0; it < 4; ++it) { float ss = 0.f;
#pragma unroll
                for (int nt = 0; nt < 2; ++nt) ss += (o[nt][it][0] * o[nt][it][0] + o[nt][it][1] * o[nt][it][1]) + (o[nt][it][2] * o[nt][it][2] + o[nt][it][3] * o[nt][it][3]);
                ss += __shfl_xor(ss, 16); ss += __shfl_xor(ss, 32);
                if (g == 0) xch[(pw * 4 + qf) * 64 + 16 * it + r16] = ss; }
            __syncthreads();
#pragma unroll
            for (int it = 0; it < 4; ++it) { const int ti = 16 * it + r16, tok = tok0 + ti;
                const float ssq = (xch[(pw * 4 + 0) * 64 + ti] + xch[(pw * 4 + 1) * 64 + ti]) + (xch[(pw * 4 + 2) * 64 + ti] + xch[(pw * 4 + 3) * 64 + ti]);
                const float rms = __builtin_amdgcn_rsqf(ssq * (1.0f / 128.0f) + RMS_EPS);
#pragma unroll
                for (int nt = 0; nt < 2; ++nt) { const int col = c0 + 16 * nt + 4 * g;
                    const u32x2v z = *(const GAS u32x2v*)(PO + (size_t)tok * OIN + 3072 + hh * 128 + col); const f32x4 gn = *(const GAS f32x4*)(onorm + col);
                    if (on) st8(mix + (size_t)tok * D_ + hh * 128 + col, o[nt][it][0] * rms * gn[0] * silu(bflo(z.x)), o[nt][it][1] * rms * gn[1] * silu(bfhi(z.x)),
                                o[nt][it][2] * rms * gn[2] * silu(bflo(z.y)), o[nt][it][3] * rms * gn[3] * silu(bfhi(z.y))); } }
            if (i < 3) {
                f32x4 acc[8][2];
#pragma unroll
                for (int mt = 0; mt < 8; ++mt)
#pragma unroll
                    for (int nt = 0; nt < 2; ++nt) { const u32x2v so = *(const LAS u32x2v*)(Sl + (16 * nt + r16) * 136 + 16 * mt + 4 * g); acc[mt][nt] = (f32x4){di * bflo(so.x), di * bfhi(so.x), di * bflo(so.y), di * bfhi(so.y)}; }
                g_prod2(acc, sk, T, r16, g);
                asm volatile("s_waitcnt lgkmcnt(0)" ::: "memory");
#pragma unroll
                for (int mt = 0; mt < 8; ++mt)
#pragma unroll
                    for (int nt = 0; nt < 2; ++nt) { u32x2v ov; ov.x = cvtpk(acc[mt][nt][0], acc[mt][nt][1]); ov.y = cvtpk(acc[mt][nt][2], acc[mt][nt][3]); *(LAS u32x2v*)(Sl + (16 * nt + r16) * 136 + 16 * mt + 4 * g) = ov; }
            }
        }
    }
    __syncthreads();
}

__device__ __forceinline__ void p_r1(const Frame& F, const Args& a, int L) {
    GAS unsigned char* ws = (GAS unsigned char*)a.ws; asm volatile("" : "+s"(ws)); int lane_ = F.lane; asm volatile("" : "+v"(lane_)); const int j = L >> 1, lane = lane_;
    const float* ssq = (const float*)(ws + WS_SSQA); const float* wr = (const float*)a.in[24] + (size_t)j * D_ * NEXP; const float* ln = (const float*)a.in[4] + L * D_;
    int* tok_e = (int*)(ws + WS_TOK + TOK_E); int* tok_r = (int*)(ws + WS_TOK + TOK_R); float* tok_g = (float*)(ws + WS_TOK + TOK_G);
    unsigned* gcount = (unsigned*)(ws + WS_CTL) + CW_CNT + 64 * j;
    LAS int* rt = (LAS int*)(F.lds + RT_OFF);
    if (F.tid < 16) rt[F.tid] = 0;
    __syncthreads();
    const GAS float* hG = (const GAS float*)a.out; const GAS float* wrG = (const GAS float*)wr; const GAS float* lnG = (const GAS float*)ln;
    float lnr[16];
#pragma unroll
    for (int i = 0; i < 16; ++i) lnr[i] = lnG[64 * i + lane];
#pragma unroll 1
    for (int t = F.gw; t < S_; t += 2 * F.NGW) {
        const int tb = t + F.NGW; const bool hasb = tb < S_; const int tbc = hasb ? tb : t;
        float xa[16], xb[16];
#pragma unroll
        for (int i = 0; i < 16; ++i) { xa[i] = hG[(size_t)t * D_ + 64 * i + lane]; xb[i] = hG[(size_t)tbc * D_ + 64 * i + lane]; }
        const float rsa = pg8::rstd_row(ssq, t), rsb = pg8::rstd_row(ssq, tbc);
        float acca[8], accb[8];
#pragma unroll
        for (int e = 0; e < 8; ++e) { acca[e] = 0.f; accb[e] = 0.f; }
#pragma unroll
        for (int i = 0; i < 16; ++i) { const int k = 64 * i + lane; const f32x4 w0 = *(const GAS f32x4*)(wrG + (size_t)k * 8), w1 = *(const GAS f32x4*)(wrG + (size_t)k * 8 + 4);
            const float x = xa[i] * lnr[i], y = xb[i] * lnr[i];
            acca[0] += x * w0[0]; acca[1] += x * w0[1]; acca[2] += x * w0[2]; acca[3] += x * w0[3]; acca[4] += x * w1[0]; acca[5] += x * w1[1]; acca[6] += x * w1[2]; acca[7] += x * w1[3];
            accb[0] += y * w0[0]; accb[1] += y * w0[1]; accb[2] += y * w0[2]; accb[3] += y * w0[3]; accb[4] += y * w1[0]; accb[5] += y * w1[1]; accb[6] += y * w1[2]; accb[7] += y * w1[3]; }
#pragma unroll
        for (int e = 0; e < 8; ++e) { acca[e] = wave_sum(acca[e]) * rsa; accb[e] = wave_sum(accb[e]) * rsb; }
#pragma unroll
        for (int half = 0; half < 2; ++half) {
            if (half == 1 && !hasb) break;
            const int tt = half ? tb : t; float acc[8];
#pragma unroll
            for (int e = 0; e < 8; ++e) acc[e] = half ? accb[e] : acca[e];
            int e0 = 0; float l0 = acc[0];
#pragma unroll
            for (int e = 1; e < 8; ++e) if (acc[e] > l0) { l0 = acc[e]; e0 = e; }
            int e1 = -1; float l1 = -INFINITY;
#pragma unroll
            for (int e = 0; e < 8; ++e) if (e != e0 && acc[e] > l1) { l1 = acc[e]; e1 = e; }
            const float g1 = 1.0f / (1.0f + expf(l0 - l1)), g0 = 1.0f - g1;
            if (lane == 0) {
                const int r0 = __hip_atomic_fetch_add(rt + e0, 1, __ATOMIC_RELAXED, __HIP_MEMORY_SCOPE_WORKGROUP), r1 = __hip_atomic_fetch_add(rt + e1, 1, __ATOMIC_RELAXED, __HIP_MEMORY_SCOPE_WORKGROUP);
                tok_e[2 * tt] = e0; tok_e[2 * tt + 1] = e1; tok_r[2 * tt] = r0; tok_r[2 * tt + 1] = r1; tok_g[2 * tt] = g0; tok_g[2 * tt + 1] = g1;
            }
        }
    }
    __syncthreads();
    if (F.tid < 8) rt[8 + F.tid] = (int)__hip_atomic_fetch_add(gcount + F.tid, (unsigned)rt[F.tid], __ATOMIC_RELAXED, __HIP_MEMORY_SCOPE_AGENT);
    __syncthreads();
#pragma unroll 1
    for (int t = F.gw; t < S_; t += F.NGW) if (lane < 2) { const int e = tok_e[2 * t + lane]; tok_r[2 * t + lane] += rt[8 + e]; }
    __syncthreads();
}
__device__ __forceinline__ int moe_pstart(const unsigned* gcount, int e) {
    int ps = 0;
#pragma unroll
    for (int q = 0; q < 8; ++q) { const int c = (int)gcount[q]; if (q < e) ps += ((c + 255) >> 8) << 8; }
    return ps;
}
__device__ __forceinline__ void p_r2(const Frame& F, const Args& a, int L) {
    GAS unsigned char* ws = (GAS unsigned char*)a.ws; asm volatile("" : "+s"(ws)); int lane_ = F.lane; asm volatile("" : "+v"(lane_)); const int j = L >> 1, lane = lane_;
    const float* ssq = (const float*)(ws + WS_SSQA);
    const int* tok_e = (const int*)(ws + WS_TOK + TOK_E); const int* tok_r = (const int*)(ws + WS_TOK + TOK_R); const float* tok_g = (const float*)(ws + WS_TOK + TOK_G);
    int* dst = (int*)(ws + WS_TOK + TOK_DST); float* gpad = (float*)(ws + WS_TOK + TOK_GPAD);
    const unsigned* gcount = (const unsigned*)(ws + WS_CTL) + CW_CNT + 64 * j; bf16* XS = (bf16*)(ws + WS_ARENA + AR_XS);
    int pst[8]; { int ps = 0;
#pragma unroll
        for (int q = 0; q < 8; ++q) { pst[q] = ps; ps += (((int)gcount[q] + 255) >> 8) << 8; } }
    const GAS float* hG = (const GAS float*)a.out;
#pragma unroll 1
    for (int t0 = F.gw; t0 < S_; t0 += 4 * F.NGW) {
        int tt[4], da[4], db[4]; float rs[4], ga[4], gb[4]; f32x4 v[4][4];
#pragma unroll
        for (int u = 0; u < 4; ++u) { const int t = t0 + u * F.NGW; tt[u] = t < S_ ? t : t0;
#pragma unroll
            for (int q = 0; q < 4; ++q) v[u][q] = *((const GAS f32x4*)(hG + (size_t)tt[u] * D_) + 64 * q + lane); }
#pragma unroll
        for (int u = 0; u < 4; ++u) { const int t = tt[u]; rs[u] = pg8::rstd_row(ssq, t);
            const int ea = tok_e[2 * t], eb = tok_e[2 * t + 1]; int pa = 0, pb = 0;
#pragma unroll
            for (int q = 0; q < 8; ++q) { pa = (q == ea) ? pst[q] : pa; pb = (q == eb) ? pst[q] : pb; }
            da[u] = pa + tok_r[2 * t]; db[u] = pb + tok_r[2 * t + 1]; ga[u] = tok_g[2 * t]; gb[u] = tok_g[2 * t + 1]; }
#pragma unroll
        for (int u = 0; u < 4; ++u) { if (t0 + u * F.NGW >= S_) break; const int t = tt[u];
            if (lane == 0) { dst[2 * t] = da[u]; dst[2 * t + 1] = db[u]; gpad[da[u]] = ga[u]; gpad[db[u]] = gb[u]; }
#pragma unroll
            for (int q = 0; q < 4; ++q) { const f32x4 x = v[u][q] * rs[u]; u32x2v o; o.x = cvtpk(x[0], x[1]); o.y = cvtpk(x[2], x[3]);
                *((GAS u32x2v*)(XS + (size_t)da[u] * D_) + 64 * q + lane) = o; *((GAS u32x2v*)(XS + (size_t)db[u] * D_) + 64 * q + lane) = o; } }
    }
}
__device__ __forceinline__ int moe_blocks(const Frame& F, const Args& a, int L) {
    const unsigned* gcount = (const unsigned*)(a.ws + WS_CTL) + CW_CNT + 64 * (L >> 1);
    LAS int* blk = (LAS int*)(F.lds + BLKE_OFF);
    int nb_tot = 0, mine = 7;
#pragma unroll
    for (int q = 0; q < 8; ++q) { const int nb = ((int)gcount[q] + 255) >> 8; if (F.tid >= nb_tot && F.tid < nb_tot + nb) mine = q; nb_tot += nb; }
    __syncthreads();
    if (F.tid < 160) blk[F.tid] = mine;
    __syncthreads();
    return nb_tot;
}
__device__ __forceinline__ void p_combine(const Frame& F, const Args& a) {
    GAS unsigned char* ws = (GAS unsigned char*)a.ws; asm volatile("" : "+s"(ws)); int lane_ = F.lane; asm volatile("" : "+v"(lane_)); const int lane = lane_;
    const int* dst = (const int*)(ws + WS_TOK + TOK_DST); const bf16* Y = (const bf16*)(ws + WS_ARENA + AR_Y); bf16* hb = (bf16*)(ws + WS_HBF); float* ssq = (float*)(ws + WS_SSQA);
    const GAS float* hG = (const GAS float*)a.out;
#pragma unroll 1
    for (int t0 = F.gw; t0 < S_; t0 += 2 * F.NGW) {
        int tt[2], da[2], db[2]; f32x4 v[2][4]; u32x2v ya[2][4], yb[2][4];
#pragma unroll
        for (int u = 0; u < 2; ++u) { const int t = t0 + u * F.NGW; tt[u] = t < S_ ? t : t0; da[u] = dst[2 * tt[u]]; db[u] = dst[2 * tt[u] + 1];
#pragma unroll
            for (int q = 0; q < 4; ++q) v[u][q] = *((const GAS f32x4*)(hG + (size_t)tt[u] * D_) + 64 * q + lane); }
#pragma unroll
        for (int u = 0; u < 2; ++u)
#pragma unroll
            for (int q = 0; q < 4; ++q) { ya[u][q] = *((const GAS u32x2v*)(Y + (size_t)da[u] * D_) + 64 * q + lane); yb[u][q] = *((const GAS u32x2v*)(Y + (size_t)db[u] * D_) + 64 * q + lane); }
#pragma unroll
        for (int u = 0; u < 2; ++u) { if (t0 + u * F.NGW >= S_) break; const int t = tt[u]; float ss = 0.f;
#pragma unroll
            for (int q = 0; q < 4; ++q) { f32x4 x = v[u][q];
                x[0] += bflo(ya[u][q].x) + bflo(yb[u][q].x); x[1] += bfhi(ya[u][q].x) + bfhi(yb[u][q].x); x[2] += bflo(ya[u][q].y) + bflo(yb[u][q].y); x[3] += bfhi(ya[u][q].y) + bfhi(yb[u][q].y);
                *((GAS f32x4*)(a.out + (size_t)t * D_) + 64 * q + lane) = x; ss += (x[0] * x[0] + x[1] * x[1]) + (x[2] * x[2] + x[3] * x[3]);
                u32x2v o; o.x = cvtpk(x[0], x[1]); o.y = cvtpk(x[2], x[3]); *((GAS u32x2v*)(hb + (size_t)t * D_) + 64 * q + lane) = o; }
            ss = wave_sum(ss);
            if (lane < 16) ssq[(size_t)t * 16 + lane] = (lane == 0) ? ss : 0.f; }
    }
}
__device__ __forceinline__ void p_final(const Frame& F, const Args& a) {
    GAS unsigned char* ws = (GAS unsigned char*)a.ws; asm volatile("" : "+s"(ws)); int lane_ = F.lane; asm volatile("" : "+v"(lane_)); const int lane = lane_; const float* ssq = (const float*)(ws + WS_SSQB); const float* ln = (const float*)a.in[6];
#pragma unroll 1
    for (int t = F.gw; t < S_; t += F.NGW) { const float rs = pg8::rstd_row(ssq, t);
#pragma unroll
        for (int q = 0; q < 4; ++q) { GAS f32x4* hp = (GAS f32x4*)(a.out + (size_t)t * D_) + 64 * q + lane; const f32x4 gq = *((const GAS f32x4*)ln + 64 * q + lane); *hp = (*hp) * rs * gq; } }
}
__device__ __forceinline__ void p_moe_weights(const Frame& F, const Args& a, int L, int w0, int nw, int part) {
    LAS float* scr = (LAS float*)(F.lds + F.wave * WAVE_LDS);
    int base = 0;
#pragma unroll 1
    for (int id = 0; id < 24; ++id) { if (part >= 0 && (((id % 3) == 2) != (part == 1))) continue; const MatD m = moe_mat(a, L >> 1, id);
        int first = (w0 - base) % nw; if (first < 0) first += nw;
#pragma unroll 1
        for (int it = first; it < m.items; it += nw) xpose_item(m.W, m.ldw, m.K, m.N, m.gain, m.WT, m.ilv, scr, it, F.lane);
        base += m.items; }
}

constexpr int P_PRO = 0, P_FINAL = 81, LP_ROT = 16, LP_G1B = 17, LP_G2B = 18, LPN = 20, LP_PROJ = 0, LP_ATT = 1, LP_MIXPREP = 2, LP_GA = 3, LP_G1 = 4, LP_G2 = 5, LP_G3 = 6, LP_OUT = 7, LP_UP = 8, LP_DOWN = 9, LP_R1 = 10, LP_R2 = 11, LP_M1 = 12, LP_M2 = 13, LP_COMB = 14, LP_PLE = 15;

#ifndef PH_MASK
#define PH_MASK 0xffffffffull
#endif
#define IN(k) (lo <= (k) && (k) < hi)
#define INL(lp) ((((unsigned long long)(PH_MASK) >> (lp)) & 1) && lo <= pb + (lp) && pb + (lp) < hi)
#define SEAM() do { if (args.use_bar) xcd_barrier(bar); } while (0)
#ifndef REP_LP
#define REP_LP -1
#endif
#ifndef REP_L
#define REP_L -1
#endif
#ifndef REP_N
#define REP_N 2
#endif
#define REPS(lp) ((L == (REP_L) && (lp) == (REP_LP)) ? 1 + (REP_N) : 1)
#if REP_LP >= 0
#define REPLOOP(lp) _Pragma("unroll 1") for (int rep_ = 0; rep_ < REPS(lp); ++rep_)
#else
#define REPLOOP(lp)
#endif
#define PHASE_WS() GAS unsigned char* ws = (GAS unsigned char*)ws0; asm volatile("" : "+s"(ws)); bf16* HBF = (bf16*)(ws + WS_HBF); bf16* MIX = (bf16*)(ws + WS_MIX); bf16* PP = (bf16*)(ws + WS_PP); float* SSQA = (float*)(ws + WS_SSQA); float* SSQB = (float*)(ws + WS_SSQB); (void)HBF; (void)MIX; (void)PP; (void)SSQA; (void)SSQB
template <int L> __device__ __forceinline__ void run_layer(const Frame& F, const Args& args, unsigned char* lds, const XcdBarrier& bar, unsigned char* ws0, const int lo, const int hi, const int cid) {
        const int pb = 1 + LPN * L, j = L >> 1; const bool odd = (L & 1) != 0;
        REPLOOP(LP_PROJ) if (INL(LP_PROJ)) { PHASE_WS();
            if (!odd) {
                pg8::Gemm gm{HBF, (const bf16*)(ws + WS_WINE) + (size_t)j * EIN * D_, S_, EIN, D_, 0}; pg8::StaticOrder So; So.init(S_, EIN, F.G, cid);
                pg8::EpiBf16 E{(bf16*)(ws + WS_ARENA + AR_PE), EIN, SSQB, pg8::C2, 512};
                pg8::gemm_phase<pg8::EpiBf16, pg8::StaticOrder, true, true>(F.lds + RING_OFF, gm, So, E);
            } else {
                pg8::Gemm gm{HBF, (const bf16*)(ws + WS_WINO) + (size_t)j * OIN * D_, S_, OIN, D_, 0}; pg8::StaticOrder So; So.init(S_, OIN, F.G, cid);
                pg8::EpiBf16 E{(bf16*)(ws + WS_ARENA + AR_PO), OIN, SSQB, 1.0f, 0};
                pg8::gemm_phase<pg8::EpiBf16, pg8::StaticOrder, true, true>(F.lds + RING_OFF, gm, So, E);
            }
            {
                pg8::Gemm gm{(const bf16*)(ws + WS_PBF) + (size_t)L * S_ * PLE, (const bf16*)(ws + WS_WP) + (size_t)L * D_ * PLE, S_, D_, PLE, 0}; pg8::StaticOrder So; So.init(S_, D_, F.G, cid);
                pg8::EpiBf16 E{PP, D_, nullptr, 1.0f, 0};
                pg8::gemm_phase<pg8::EpiBf16, pg8::StaticOrder, true, true>(F.lds + RING_OFF, gm, So, E);
            }
            SEAM();
        }
        if (!odd) {
            REPLOOP(LP_ROT) if (INL(LP_ROT)) { PHASE_WS(); p_rot(F, args); SEAM(); }
            REPLOOP(LP_ATT) if (INL(LP_ATT)) { PHASE_WS(); attn_body::attn_phase<8>((char*)lds + RING_OFF, (const attn_body::bf16*)(ws + WS_ARENA + AR_PE), (attn_body::bf16*)(ws + WS_ARENA + AR_AO), F.vcu, F.G); SEAM(); }
            REPLOOP(LP_MIXPREP) if (INL(LP_MIXPREP)) { PHASE_WS(); p_mixprep(F, args, L); SEAM(); }
        } else {
            REPLOOP(LP_GA) if (INL(LP_GA)) { PHASE_WS();
#ifdef PROBE_GSEL
                const int gsel = args.use_bar ? 7 : PROBE_GSEL;
#else
                const int gsel = 7;
#endif
                if (gsel & 1) p_ga(F, args, L); asm volatile("s_waitcnt vmcnt(0)" ::: "memory"); __syncthreads(); if (gsel & 2) p_g1(F, args); asm volatile("s_waitcnt vmcnt(0)" ::: "memory"); __syncthreads(); if (gsel & 4) p_g1b(F, args); SEAM(); }
            REPLOOP(LP_G2) if (INL(LP_G2)) { PHASE_WS();
                const int nscan = F.G < 64 ? F.G : 64;
#ifdef PROBE_NOCONV
                if (!args.use_bar) { if (F.vcu < nscan) p_g2<64, 4>(F, args, (const bf16*)(ws + WS_ARENA + AR_MPC), (const bf16*)(ws + WS_ARENA + AR_NTC), (const float*)(ws + WS_TOK + TOK_DNC)); } else
#endif
#ifdef PROBE_NOSCAN
                if (!args.use_bar) { if (F.vcu >= nscan) p_moe_weights(F, args, L, (F.vcu - nscan) * NWAVES + F.wave, (F.G - nscan) * NWAVES, -1); } else
#endif
                if (F.vcu < nscan) p_g2<64, 4>(F, args, (const bf16*)(ws + WS_ARENA + AR_MPC), (const bf16*)(ws + WS_ARENA + AR_NTC), (const float*)(ws + WS_TOK + TOK_DNC));
                else p_moe_weights(F, args, L, (F.vcu - nscan) * NWAVES + F.wave, (F.G - nscan) * NWAVES, -1);
                if (F.G <= 64) p_moe_weights(F, args, L, F.gw, F.NGW, -1);
                SEAM();
            }
            REPLOOP(LP_G3) if (INL(LP_G3)) { PHASE_WS(); p_g23(F, args, L); SEAM(); }
        }
        REPLOOP(LP_OUT) if (INL(LP_OUT)) { PHASE_WS();
            const bf16* Wo = odd ? (const bf16*)(ws + WS_WOUTO) + (size_t)j * D_ * D_ : (const bf16*)(ws + WS_WOUTE) + (size_t)j * D_ * D_;
            pg8::Gemm gm{MIX, Wo, S_, D_, D_, 0}; pg8::StaticOrder So; So.init(S_, D_, F.G, cid);
            pg8::EpiResid E{args.out, HBF, SSQA};
            pg8::gemm_phase<pg8::EpiResid, pg8::StaticOrder, true, true>(F.lds + RING_OFF, gm, So, E);
            SEAM();
        }
        if (!odd) {
            REPLOOP(LP_UP) if (INL(LP_UP)) { PHASE_WS();
                pg8::Gemm gm{HBF, (const bf16*)(ws + WS_W13D) + (size_t)j * 2 * DFF * D_, S_, 2 * DFF, D_, 0}; pg8::StaticOrder So; So.init(S_, 2 * DFF, F.G, cid);
                pg8::EpiSwiglu E{(bf16*)(ws + WS_ARENA + AR_ACT), SSQA};
                pg8::gemm_phase<pg8::EpiSwiglu, pg8::StaticOrder, true, true>(F.lds + RING_OFF, gm, So, E);
                SEAM();
            }
            REPLOOP(LP_DOWN) if (INL(LP_DOWN)) { PHASE_WS();
                pg8::Gemm gm{(const bf16*)(ws + WS_ARENA + AR_ACT), (const bf16*)(ws + WS_W2D) + (size_t)j * D_ * DFF, S_, D_, DFF, 0}; pg8::StaticOrder So; So.init(S_, D_, F.G, cid);
                pg8::EpiResid E{args.out, HBF, SSQA};
                pg8::gemm_phase<pg8::EpiResid, pg8::StaticOrder, true, true>(F.lds + RING_OFF, gm, So, E);
                SEAM();
            }
        } else {
            REPLOOP(LP_R1) if (INL(LP_R1)) { PHASE_WS(); p_r1(F, args, L); SEAM(); }
            REPLOOP(LP_R2) if (INL(LP_R2)) { PHASE_WS(); p_r2(F, args, L); SEAM(); }
            REPLOOP(LP_M1) if (INL(LP_M1)) { PHASE_WS();
                const int nb = moe_blocks(F, args, L);
                pg8::Gemm gm{(const bf16*)(ws + WS_ARENA + AR_XS), (const bf16*)(ws + WS_W13M), nb * 256, 2 * DFF, D_, (size_t)2 * DFF * D_ * 2}; pg8::MoeOrder So; So.init(nb * 256, 2 * DFF, F.G, cid); So.blk_e = (const LAS int*)(F.lds + BLKE_OFF);
                pg8::EpiSwiglu E{(bf16*)(ws + WS_ARENA + AR_ACT), nullptr};
                pg8::gemm_phase<pg8::EpiSwiglu, pg8::MoeOrder, true, true>(F.lds + RING_OFF, gm, So, E);
                SEAM();
            }
            REPLOOP(LP_M2) if (INL(LP_M2)) { PHASE_WS();
                const int nb = moe_blocks(F, args, L);
                pg8::Gemm gm{(const bf16*)(ws + WS_ARENA + AR_ACT), (const bf16*)(ws + WS_W2M), nb * 256, D_, DFF, (size_t)D_ * DFF * 2}; pg8::MoeOrder So; So.init(nb * 256, D_, F.G, cid); So.blk_e = (const LAS int*)(F.lds + BLKE_OFF);
                pg8::EpiMoeDown E{(bf16*)(ws + WS_ARENA + AR_Y), (const float*)(ws + WS_TOK + TOK_GPAD)};
                pg8::gemm_phase<pg8::EpiMoeDown, pg8::MoeOrder, true, true>(F.lds + RING_OFF, gm, So, E);
                SEAM();
            }
            REPLOOP(LP_COMB) if (INL(LP_COMB)) { PHASE_WS(); p_combine(F, args); SEAM(); }
        }
        REPLOOP(LP_PLE) if (INL(LP_PLE)) { PHASE_WS();
            pg8::Gemm gm{HBF, (const bf16*)(ws + WS_WG) + (size_t)L * D_ * D_, S_, D_, D_, 0}; pg8::StaticOrder So; So.init(S_, D_, F.G, cid);
            pg8::EpiPle E{args.out, HBF, SSQA, SSQB, PP};
            pg8::gemm_phase<pg8::EpiPle, pg8::StaticOrder, true, true>(F.lds + RING_OFF, gm, So, E);
            SEAM();
        }
    }

__global__ void __launch_bounds__(NWAVES * 64, 2) fwd(Args args) {
    extern __shared__ __attribute__((aligned(16))) unsigned char lds[];
    Frame F;
    F.lds = (LAS unsigned char*)lds; F.tid = threadIdx.x; F.lane = F.tid & 63; F.wave = __builtin_amdgcn_readfirstlane(F.tid >> 6);
    F.G = gridDim.x; { const int bx = blockIdx.x; F.vcu = (F.G % 8 == 0) ? (bx % 8) * (F.G / 8) + bx / 8 : bx; }
    F.gw = F.vcu * NWAVES + F.wave; F.NGW = F.G * NWAVES;
    unsigned char* ws0 = args.ws;
    for (int u = F.tid; u < (LDS_BYTES - LDSCTL_OFF) / 4; u += NWAVES * 64) ((LAS unsigned*)(F.lds + LDSCTL_OFF))[u] = 0u;
    __syncthreads();
    XcdBarrier bar; bar.bar = (unsigned*)(ws0 + WS_CTL) + CW_BAR; bar.x = 0; bar.st = nullptr;
    if (args.use_bar) bar = xcd_barrier_post((unsigned*)(ws0 + WS_CTL) + CW_BAR, (volatile LAS unsigned*)(F.lds + MISC_OFF));
    const int lo = args.ph_lo, hi = args.ph_hi;
    const int cid = (int)blockIdx.x;

    if ((((unsigned long long)(PH_MASK) >> 30) & 1) && IN(P_PRO)) { p_prologue(F, args); SEAM(); }

#ifdef FIXED_L
    run_layer<FIXED_L>(F, args, lds, bar, ws0, lo, hi, cid);
#else
    run_layer<0>(F, args, lds, bar, ws0, lo, hi, cid); run_layer<1>(F, args, lds, bar, ws0, lo, hi, cid); run_layer<2>(F, args, lds, bar, ws0, lo, hi, cid); run_layer<3>(F, args, lds, bar, ws0, lo, hi, cid);
#endif
    if ((((unsigned long long)(PH_MASK) >> 31) & 1) && IN(P_FINAL)) p_final(F, args);
#undef IN
#undef INL
#undef SEAM
}


#ifndef DBG
#define DBG 0
#endif
#if DBG
#ifndef DBG_ASLOT
#define DBG_ASLOT 9
#endif
#ifndef DBG_BSLOT
#define DBG_BSLOT 11
#endif
__global__ void dbg_scan(const void* p, size_t n, int is_f32, unsigned* slot) {
    unsigned cnt = 0;
    for (size_t i = (size_t)blockIdx.x * blockDim.x + threadIdx.x; i < n; i += (size_t)gridDim.x * blockDim.x) {
        const float v = is_f32 ? ((const float*)p)[i] : __uint_as_float(((unsigned)((const unsigned short*)p)[i]) << 16);
        if (!(fabsf(v) < 1e30f)) ++cnt; }
    if (cnt) atomicAdd(slot, cnt);
}
__global__ void dbg_fill(float* out, size_t n, const unsigned* slots, int nslots) {
    int first = -1; for (int i = 0; i < nslots; ++i) if (slots[i]) { first = i; break; }
    float c, V;
    if (first >= 0) { c = sqrtf((float)(10 + first) * 1e6f); V = c; }
    else { const float ea = fmaxf(__uint_as_float(slots[256 + DBG_ASLOT]), 1e-5f), eb = fmaxf(__uint_as_float(slots[256 + DBG_BSLOT]), 1e-5f);
        c = sqrtf((10.f + fminf(60.f, rintf(10.f * (log10f(ea) + 5.f)))) * 1e4f); V = (50.f + rintf(10.f * log10f(eb))) * 1e3f; }
    for (size_t i = (size_t)blockIdx.x * blockDim.x + threadIdx.x; i < n; i += (size_t)gridDim.x * blockDim.x) out[i] = (i == 0) ? V : c;
}
__device__ __forceinline__ float dbg_bf(const unsigned short* p, size_t i) { return __uint_as_float(((unsigned)p[i]) << 16); }
__device__ __forceinline__ float dbg_rstd(const float* ssq, int row) { float s = 0.f; for (int i = 0; i < 16; ++i) s += ssq[(size_t)row * 16 + i]; return 1.0f / sqrtf(s / 1024.0f + 1e-6f); }
__device__ __forceinline__ float dbg_blocksum(float v, float* red) {
    __syncthreads(); red[threadIdx.x] = v; __syncthreads();
    for (int o = 128; o > 0; o >>= 1) { if ((int)threadIdx.x < o) red[threadIdx.x] += red[threadIdx.x + o]; __syncthreads(); }
    const float r = red[0]; __syncthreads(); return r;
}
__device__ __forceinline__ void dbg_report(unsigned* slot, float num, float den) { if (threadIdx.x == 0) atomicMax(slot, __float_as_uint(sqrtf(num / fmaxf(den, 1e-20f)))); }
__global__ void chk_ffn(const float* hpre, const float* hpost, const float* ssq, const float* ln, const float* wr, const float* w1, const float* w3, const float* w2, int moe, unsigned* slot) {
    __shared__ float xn[1024]; __shared__ float hid[3584]; __shared__ float red[256]; __shared__ float lg[8];
    const int t = (blockIdx.x * 997 + 13) % S_, tid = threadIdx.x;
    const float rs = dbg_rstd(ssq, t);
    for (int k = tid; k < 1024; k += 256) xn[k] = hpre[(size_t)t * 1024 + k] * rs * ln[k];
    __syncthreads();
    int e0 = 0, e1 = 0; float g0 = 1.f, g1 = 0.f;
    if (moe) {
        if (tid < 8) { float s = 0.f; for (int k = 0; k < 1024; ++k) s += xn[k] * wr[(size_t)k * 8 + tid]; lg[tid] = s; }
        __syncthreads();
        float l0 = lg[0]; for (int e = 1; e < 8; ++e) if (lg[e] > l0) { l0 = lg[e]; e0 = e; }
        float l1 = -1e30f; e1 = -1; for (int e = 0; e < 8; ++e) if (e != e0 && lg[e] > l1) { l1 = lg[e]; e1 = e; }
        const float m0 = expf(l0 - l0), m1 = expf(l1 - l0); g0 = m0 / (m0 + m1); g1 = m1 / (m0 + m1);
    }
    float acc[4] = {0.f, 0.f, 0.f, 0.f};
    for (int pass = 0; pass < (moe ? 2 : 1); ++pass) {
        const int e = pass == 0 ? e0 : e1; const float gt = pass == 0 ? g0 : g1;
        const float* W1 = w1 + (size_t)e * 1024 * 3584; const float* W3 = w3 + (size_t)e * 1024 * 3584; const float* W2 = w2 + (size_t)e * 3584 * 1024;
        __syncthreads();
        for (int f = tid; f < 3584; f += 256) { float a = 0.f, b = 0.f; for (int k = 0; k < 1024; ++k) { a += xn[k] * W1[(size_t)k * 3584 + f]; b += xn[k] * W3[(size_t)k * 3584 + f]; } hid[f] = a / (1.f + expf(-a)) * b; }
        __syncthreads();
        for (int q = 0; q < 4; ++q) { const int c = tid + 256 * q; float y = 0.f; for (int f = 0; f < 3584; ++f) y += hid[f] * W2[(size_t)f * 1024 + c]; acc[q] += gt * y; }
    }
    float num = 0.f, den = 0.f;
    for (int q = 0; q < 4; ++q) { const int c = tid + 256 * q; const float ex = acc[q], got = hpost[(size_t)t * 1024 + c] - hpre[(size_t)t * 1024 + c]; num += (got - ex) * (got - ex); den += ex * ex; }
    num = dbg_blocksum(num, red); den = dbg_blocksum(den, red);
    dbg_report(slot, num, den);
}
__global__ void chk_ple(const float* hpre, const float* hpost, const float* ssq, const float* ln, const float* wg, const float* p, const float* wp, unsigned* slot) {
    __shared__ float xn[1024]; __shared__ float red[256];
    const int t = (blockIdx.x * 997 + 13) % S_, tid = threadIdx.x; const float rs = dbg_rstd(ssq, t);
    for (int k = tid; k < 1024; k += 256) xn[k] = hpre[(size_t)t * 1024 + k] * rs * ln[k];
    __syncthreads();
    float num = 0.f, den = 0.f;
    for (int q = 0; q < 4; ++q) { const int c = tid + 256 * q; float a = 0.f, b = 0.f; for (int k = 0; k < 1024; ++k) a += xn[k] * wg[(size_t)k * 1024 + c]; for (int k = 0; k < 256; ++k) b += p[(size_t)t * 256 + k] * wp[(size_t)k * 1024 + c];
        const float ex = b / (1.f + expf(-a)), got = hpost[(size_t)t * 1024 + c] - hpre[(size_t)t * 1024 + c]; num += (got - ex) * (got - ex); den += ex * ex; }
    num = dbg_blocksum(num, red); den = dbg_blocksum(den, red); dbg_report(slot, num, den);
}
constexpr int DBG_TC = 512;
__global__ void chk_gdn_proj(const float* h, const float* ssq, const float* ln, const float* W, int hh, float* raw) {
    const int idx = blockIdx.x * blockDim.x + threadIdx.x; if (idx >= DBG_TC * 514) return;
    const int t = idx / 514, c = idx % 514;
    const int col = c < 128 ? hh * 128 + c : c < 256 ? 1024 + hh * 128 + (c - 128) : c < 384 ? 2048 + hh * 128 + (c - 256) : c < 512 ? 3072 + hh * 128 + (c - 384) : c == 512 ? 4096 + hh : 4104 + hh;
    const float rs = dbg_rstd(ssq, t); float s = 0.f;
    for (int k = 0; k < 1024; ++k) s += h[(size_t)t * 1024 + k] * ln[k] * W[(size_t)k * OIN_SRC + col];
    raw[(size_t)t * 514 + c] = s * rs;
}
__global__ void chk_gdn_rec(const float* raw, const float* cw, const float* alog, const float* dtb, const float* onorm, int hh, const unsigned short* mix, unsigned* slot) {
    extern __shared__ float sm[];
    float* Sm = sm; float* q = sm + 128 * 129; float* kk = q + 128; float* v = kk + 128; float* kv = v + 128; float* dl = kv + 128; float* o = dl + 128; float* red = o + 128;
    const int tid = threadIdx.x;
    for (int i = tid; i < 128 * 129; i += 256) Sm[i] = 0.f;
    __syncthreads();
    float worst = 0.f;
    for (int t = 0; t < DBG_TC; ++t) {
        if (tid < 128) { const int d = tid; float aq = 0.f, ak = 0.f, av = 0.f;
            for (int jj = 0; jj < 4; ++jj) { const int r = t - 3 + jj; if (r >= 0) { aq += cw[jj * 3072 + hh * 128 + d] * raw[(size_t)r * 514 + d]; ak += cw[jj * 3072 + 1024 + hh * 128 + d] * raw[(size_t)r * 514 + 128 + d]; av += cw[jj * 3072 + 2048 + hh * 128 + d] * raw[(size_t)r * 514 + 256 + d]; } }
            q[d] = aq / (1.f + expf(-aq)); kk[d] = ak / (1.f + expf(-ak)); v[d] = av / (1.f + expf(-av)); }
        __syncthreads();
        const float sq = dbg_blocksum(tid < 128 ? q[tid] * q[tid] : 0.f, red), sk = dbg_blocksum(tid < 128 ? kk[tid] * kk[tid] : 0.f, red);
        if (tid < 128) { q[tid] *= 1.0f / sqrtf(sq + 1e-6f) * 0.08838834764831845f; kk[tid] *= 1.0f / sqrtf(sk + 1e-6f); }
        const float bb = raw[(size_t)t * 514 + 512], aa = raw[(size_t)t * 514 + 513];
        const float beta = 1.f / (1.f + expf(-bb)); const float z = aa + dtb[hh]; const float g = -expf(alog[hh]) * (z > 20.f ? z : log1pf(expf(z))); const float alpha = expf(g);
        __syncthreads();
        for (int i = tid; i < 128 * 128; i += 256) { const int d = i >> 7, j = i & 127; Sm[d * 129 + j] *= alpha; }
        __syncthreads();
        if (tid < 128) { float s = 0.f; for (int d = 0; d < 128; ++d) s += kk[d] * Sm[d * 129 + tid]; dl[tid] = beta * (v[tid] - s); }
        __syncthreads();
        for (int i = tid; i < 128 * 128; i += 256) { const int d = i >> 7, j = i & 127; Sm[d * 129 + j] += kk[d] * dl[j]; }
        __syncthreads();
        if (tid < 128) { float s = 0.f; for (int d = 0; d < 128; ++d) s += q[d] * Sm[d * 129 + tid]; o[tid] = s; }
        __syncthreads();
        const float so = dbg_blocksum(tid < 128 ? o[tid] * o[tid] : 0.f, red); const float rms = 1.0f / sqrtf(so / 128.f + 1e-6f);
        float num = 0.f, den = 0.f;
        if (tid < 128) { const float zz = raw[(size_t)t * 514 + 384 + tid]; const float ex = o[tid] * rms * onorm[tid] * (zz / (1.f + expf(-zz))); const float got = dbg_bf(mix, (size_t)t * 1024 + hh * 128 + tid); num = (got - ex) * (got - ex); den = ex * ex; }
        num = dbg_blocksum(num, red); den = dbg_blocksum(den, red);
        worst = fmaxf(worst, sqrtf(num / fmaxf(den, 1e-20f)));
    }
    if (tid == 0) atomicMax(slot, __float_as_uint(worst));
}

__global__ void chk_even_kv(const float* h, const float* ssq, const float* ln, const float* W, float* KV) {
    const size_t idx = (size_t)blockIdx.x * blockDim.x + threadIdx.x; if (idx >= (size_t)S_ * 1024) return;
    const int t = (int)(idx >> 10), c = (int)(idx & 1023); const float rs = dbg_rstd(ssq, t); float s = 0.f;
    for (int k = 0; k < 1024; ++k) s += h[(size_t)t * 1024 + k] * ln[k] * W[(size_t)k * EIN + 512 + c];
    KV[idx] = s * rs;
}
__global__ void chk_even_mix(const float* h, const float* ssq, const float* ln, const float* W, const float* KV, const int* pos, const float* lq1, const float* lk1, const float* lq2, const float* lk2, const float* subg, const float* cw,
                             float lam0, const unsigned short* PE, const unsigned short* AO, const unsigned short* MIXb, unsigned* slot) {
    __shared__ float q[2][64]; __shared__ float p[128]; __shared__ float red[256]; __shared__ float o2[2][128]; __shared__ float hn[1024];
    const int toks[6] = {5, 200, 1000, 4097, 9000, 16383};
    const int t = toks[blockIdx.x / 4], hh = blockIdx.x % 4, tid = threadIdx.x;
    auto bsum = [&](float v) { __syncthreads(); red[tid] = v; __syncthreads(); for (int o = 64; o > 0; o >>= 1) { if (tid < o) red[tid] += red[tid + o]; __syncthreads(); } const float r = red[0]; __syncthreads(); return r; };
    auto bmax = [&](float v) { __syncthreads(); red[tid] = v; __syncthreads(); for (int o = 64; o > 0; o >>= 1) { if (tid < o) red[tid] = fmaxf(red[tid], red[tid + o]); __syncthreads(); } const float r = red[0]; __syncthreads(); return r; };
    auto invf = [&](int i) { return exp2f(-(float)i * (18.931568569324174f / 8.0f)); };
    const float rs = dbg_rstd(ssq, t);
    for (int k = tid; k < 1024; k += 128) hn[k] = h[(size_t)t * 1024 + k] * rs * ln[k];
    __syncthreads();
    { const int m = tid >> 6, d = tid & 63, col = (2 * hh + m) * 64 + d; float s = 0.f; for (int k = 0; k < 1024; ++k) s += hn[k] * W[(size_t)k * EIN + col]; q[m][d] = s; }
    __syncthreads();
    float qr;
    { const int m = tid >> 6, d = tid & 63; float v = q[m][d];
      if (d < 16) { const int i = d & 7; const float ang = (float)pos[t] * invf(i); const float c = cosf(ang), s = sinf(ang); v = d < 8 ? q[m][d] * c - q[m][d + 8] * s : q[m][d] * c + q[m][d - 8] * s; }
      qr = v * pg8::C2; }
    __syncthreads(); q[tid >> 6][tid & 63] = qr; __syncthreads();
    float num = 0.f, den = 0.f;
    { const int m = tid >> 6, d = tid & 63; const float got = dbg_bf(PE, (size_t)t * EIN + (2 * hh + m) * 64 + d); const float e2 = (got - qr) * (got - qr), r2 = qr * qr; num += e2; den += r2;
      const float na = bsum(d >= 16 ? e2 : 0.f), da = bsum(d >= 16 ? r2 : 0.f), nb = bsum(d < 16 ? e2 : 0.f), db = bsum(d < 16 ? r2 : 0.f);
      if (tid == 0) { atomicMax(slot + 4, __float_as_uint(sqrtf(na / fmaxf(da, 1e-20f)))); atomicMax(slot + 5, __float_as_uint(sqrtf(nb / fmaxf(db, 1e-20f)))); } }
    { const int m = tid >> 6, d = tid & 63; const float* kr = KV + (size_t)t * 1024 + (2 * hh + m) * 64; float v = kr[d];
      if (d < 16) { const int i = d & 7; const float ang = (float)pos[t] * invf(i); const float c = cosf(ang), s = sinf(ang); v = d < 8 ? kr[d] * c - kr[d + 8] * s : kr[d] * c + kr[d - 8] * s; }
      const float got = dbg_bf(PE, (size_t)t * EIN + 512 + (2 * hh + m) * 64 + d); const float e2 = (got - v) * (got - v), r2 = v * v; num += e2; den += r2;
      const float na = bsum(d >= 16 ? e2 : 0.f), da = bsum(d >= 16 ? r2 : 0.f), nb = bsum(d < 16 ? e2 : 0.f), db = bsum(d < 16 ? r2 : 0.f);
      const float vv = KV[(size_t)t * 1024 + 512 + hh * 128 + tid], gv = dbg_bf(PE, (size_t)t * EIN + 1024 + hh * 128 + tid); const float e3 = (gv - vv) * (gv - vv), r3 = vv * vv; num += e3; den += r3;
      const float nc = bsum(e3), dc = bsum(r3);
      if (tid == 0) { atomicMax(slot + 6, __float_as_uint(sqrtf(na / fmaxf(da, 1e-20f)))); atomicMax(slot + 7, __float_as_uint(sqrtf(nb / fmaxf(db, 1e-20f)))); atomicMax(slot + 8, __float_as_uint(sqrtf(nc / fmaxf(dc, 1e-20f)))); } }
    num = bsum(num); den = bsum(den); if (tid == 0) atomicMax(slot + 0, __float_as_uint(sqrtf(num / fmaxf(den, 1e-20f))));
    for (int m = 0; m < 2; ++m) {
        float mx = -1e30f;
        for (int j0 = 0; j0 <= t; j0 += 128) { const int j = j0 + tid; float s = -1e30f;
            if (j <= t) { const float* kr = KV + (size_t)j * 1024 + (2 * hh + m) * 64; s = 0.f;
                for (int d = 0; d < 64; ++d) { float kv = kr[d]; if (d < 16) { const int i = d & 7; const float ang = (float)pos[j] * invf(i); const float c = cosf(ang), sn = sinf(ang); kv = d < 8 ? kr[d] * c - kr[d + 8] * sn : kr[d] * c + kr[d - 8] * sn; } s += q[m][d] * kv; } }
            mx = fmaxf(mx, s); }
        mx = bmax(mx);
        float l = 0.f, acc = 0.f;
        for (int j0 = 0; j0 <= t; j0 += 128) { const int j = j0 + tid; float pe = 0.f;
            if (j <= t) { const float* kr = KV + (size_t)j * 1024 + (2 * hh + m) * 64; float s = 0.f;
                for (int d = 0; d < 64; ++d) { float kv = kr[d]; if (d < 16) { const int i = d & 7; const float ang = (float)pos[j] * invf(i); const float c = cosf(ang), sn = sinf(ang); kv = d < 8 ? kr[d] * c - kr[d + 8] * sn : kr[d] * c + kr[d - 8] * sn; } s += q[m][d] * kv; }
                pe = exp2f(s - mx); }
            __syncthreads(); p[tid] = pe; __syncthreads();
            l += pe;
            const int nj = min(128, t + 1 - j0);
            for (int i = 0; i < nj; ++i) acc += p[i] * KV[(size_t)(j0 + i) * 1024 + 512 + hh * 128 + tid]; }
        l = bsum(l);
        o2[m][tid] = acc / l;
    }
    __syncthreads();
    { float n2 = 0.f, d2 = 0.f;
      for (int m = 0; m < 2; ++m) { const float ex = o2[m][tid], got = dbg_bf(AO, (size_t)t * 1024 + hh * 256 + m * 128 + tid); n2 += (got - ex) * (got - ex); d2 += ex * ex; }
      n2 = bsum(n2); d2 = bsum(d2); if (tid == 0) atomicMax(slot + 1, __float_as_uint(sqrtf(n2 / fmaxf(d2, 1e-20f)))); }
    float s1 = 0.f, s2 = 0.f; for (int i = 0; i < 64; ++i) { s1 += lq1[i] * lk1[i]; s2 += lq2[i] * lk2[i]; }
    const float lam = expf(s1) - expf(s2) + lam0;
    const float dv = o2[0][tid] - lam * o2[1][tid]; const float ssd = bsum(dv * dv); const float ex = dv / sqrtf(ssd / 128.f + 1e-5f) * subg[tid] * (1.f - lam0);
    { const float got = dbg_bf(MIXb, (size_t)t * 1024 + hh * 128 + tid); float n2 = (got - ex) * (got - ex), d2 = ex * ex; n2 = bsum(n2); d2 = bsum(d2); if (tid == 0) atomicMax(slot + 2, __float_as_uint(sqrtf(n2 / fmaxf(d2, 1e-20f)))); }
    { const int ch = hh * 128 + tid; float cx[3] = {0.f, 0.f, 0.f}, bg = 0.f;
      for (int jj = 0; jj < 3; ++jj) { const int r = t - 2 + jj; if (r < 0) continue; const float rr = dbg_rstd(ssq, r); float c = 0.f, x = 0.f, b = 0.f;
          for (int k = 0; k < 1024; ++k) { const float hv = h[(size_t)r * 1024 + k] * ln[k]; c += hv * W[(size_t)k * EIN + 2048 + ch]; x += hv * W[(size_t)k * EIN + 2560 + ch]; if (jj == 2) b += hv * W[(size_t)k * EIN + 1536 + ch]; }
          cx[jj] = (c * rr) * (x * rr); if (jj == 2) bg = b * rr; }
      const float ex2 = bg * (cw[0 * 512 + ch] * cx[0] + cw[1 * 512 + ch] * cx[1] + cw[2 * 512 + ch] * cx[2]); const float got = dbg_bf(MIXb, (size_t)t * 1024 + 512 + ch);
      float n2 = (got - ex2) * (got - ex2), d2 = ex2 * ex2; n2 = bsum(n2); d2 = bsum(d2); if (tid == 0) atomicMax(slot + 3, __float_as_uint(sqrtf(n2 / fmaxf(d2, 1e-20f)))); }
}
static void dbg_before_phase(int ph, unsigned char* ws, float* out, hipStream_t st) {
    if (ph == P_PRO || ph == P_FINAL) return;
    const int lp = (ph - 1) % LPN;
    if (lp == LP_UP || lp == LP_R1 || lp == LP_PLE) { (void)hipMemcpyAsync(ws + WS_ARENA + 400 * MiB, out, (size_t)S_ * D_ * 4, hipMemcpyDeviceToDevice, st); (void)hipMemcpyAsync(ws + WS_ARENA + 464 * MiB, ws + WS_SSQA, (size_t)S_ * 16 * 4, hipMemcpyDeviceToDevice, st); }
}
static void dbg_checks(int ph, void* const* d_in, unsigned char* ws, float* out, hipStream_t st) {
    if (ph == P_PRO || ph == P_FINAL) return;
    unsigned* slots = (unsigned*)(ws + WS_CTL) + CW_DBG; const int L = (ph - 1) / LPN, lp = (ph - 1) % LPN, j = L >> 1; const bool odd = L & 1;
    const float* snap = (const float*)(ws + WS_ARENA + 400 * MiB);
    if (lp == LP_DOWN && L == 0) hipLaunchKernelGGL(chk_ffn, dim3(24), dim3(256), 0, st, snap, (const float*)out, (const float*)(ws + WS_ARENA + 464 * MiB), (const float*)d_in[4] + L * D_, (const float*)nullptr,
        (const float*)d_in[21] + (size_t)j * D_ * DFF, (const float*)d_in[22] + (size_t)j * D_ * DFF, (const float*)d_in[23] + (size_t)j * D_ * DFF, 0, slots + 256 + 0);
    if (lp == LP_PLE && L == 0) hipLaunchKernelGGL(chk_ple, dim3(24), dim3(256), 0, st, snap, (const float*)out, (const float*)(ws + WS_ARENA + 464 * MiB), (const float*)d_in[5] + L * D_, (const float*)d_in[28] + (size_t)L * D_ * D_,
        (const float*)d_in[1] + (size_t)L * S_ * PLE, (const float*)d_in[29] + (size_t)L * PLE * D_, slots + 256 + 1);
    if (lp == LP_G3 && L == 1) { float* raw = (float*)(ws + WS_ARENA + 400 * MiB);
        hipLaunchKernelGGL(chk_gdn_proj, dim3((DBG_TC * 514 + 255) / 256), dim3(256), 0, st, (const float*)out, (const float*)(ws + WS_SSQB), (const float*)d_in[3] + L * D_, (const float*)d_in[15] + (size_t)j * D_ * OIN_SRC, 3, raw);
        hipLaunchKernelGGL(chk_gdn_rec, dim3(1), dim3(256), (128 * 129 + 6 * 128 + 256) * 4, st, (const float*)raw, (const float*)d_in[16] + (size_t)j * 4 * 3072, (const float*)d_in[17] + j * 8, (const float*)d_in[18] + j * 8, (const float*)d_in[19] + j * 128, 3, (const unsigned short*)(ws + WS_MIX), slots + 256 + 2); }
    if (lp == LP_COMB && L == 1) hipLaunchKernelGGL(chk_ffn, dim3(24), dim3(256), 0, st, snap, (const float*)out, (const float*)(ws + WS_ARENA + 464 * MiB), (const float*)d_in[4] + L * D_, (const float*)d_in[24] + (size_t)j * D_ * NEXP,
        (const float*)d_in[25] + (size_t)j * NEXP * D_ * DFF, (const float*)d_in[26] + (size_t)j * NEXP * D_ * DFF, (const float*)d_in[27] + (size_t)j * NEXP * DFF * D_, 1, slots + 256 + 3);
    if (lp == LP_MIXPREP && L == 0) { float* KV = (float*)(ws + WS_ARENA + 400 * MiB);
        hipLaunchKernelGGL(chk_even_kv, dim3((S_ * 1024) / 256), dim3(256), 0, st, (const float*)out, (const float*)(ws + WS_SSQB), (const float*)d_in[3] + L * D_, (const float*)d_in[7] + (size_t)j * D_ * EIN, KV);
        hipLaunchKernelGGL(chk_even_mix, dim3(24), dim3(128), 0, st, (const float*)out, (const float*)(ws + WS_SSQB), (const float*)d_in[3] + L * D_, (const float*)d_in[7] + (size_t)j * D_ * EIN, (const float*)KV, (const int*)d_in[2],
            (const float*)d_in[9] + j * 64, (const float*)d_in[10] + j * 64, (const float*)d_in[11] + j * 64, (const float*)d_in[12] + j * 64, (const float*)d_in[13] + j * 128, (const float*)d_in[14] + (size_t)j * 3 * 512,
            0.8f - 0.6f * expf(-0.3f * (float)L), (const unsigned short*)(ws + WS_ARENA + AR_PE), (const unsigned short*)(ws + WS_ARENA + AR_AO), (const unsigned short*)(ws + WS_MIX), slots + 256 + 4); }
    (void)odd;
}
static void dbg_after_phase(int ph, unsigned char* ws, float* out, hipStream_t st) {
    unsigned* slots = (unsigned*)(ws + WS_CTL) + CW_DBG; unsigned* sl = slots + ph;
    auto scan = [&](const void* p, size_t n, int f32) { hipLaunchKernelGGL(dbg_scan, dim3(1024), dim3(256), 0, st, p, n, f32, sl); };
    const size_t SD = (size_t)S_ * D_; unsigned char* ar = ws + WS_ARENA;
    if (ph == P_PRO) { scan(ws + WS_HBF, SD, 0); scan(out, SD, 1); scan(ws + WS_PBF, (size_t)4 * S_ * PLE, 0); scan(ws + WS_TAB, (size_t)S_ * 16, 1); scan(ws + WS_W, (size_t)44 * MiB, 0); return; }
    if (ph == P_FINAL) return;
    const int L = (ph - 1) / LPN, lp = (ph - 1) % LPN; const bool odd = L & 1;
    switch (lp) {
    case LP_PROJ: if (!odd) scan(ar + AR_PE, (size_t)S_ * EIN, 0); else { scan(ar + AR_PO, (size_t)S_ * OIN, 0); scan(ws + WS_GB, (size_t)S_ * 16, 1); } scan(ws + WS_PP, SD, 0); break;
    case LP_ROT: scan(ar + AR_PE, (size_t)S_ * EIN, 0); break;
    case LP_ATT: scan(ar + AR_AO, SD, 0); break;
    case LP_MIXPREP: case LP_G3: scan(ws + WS_MIX, SD, 0); break;
    case LP_GA: scan(ar + AR_QN, SD * 5, 0); scan(ws + WS_GB, (size_t)S_ * 16, 1); break;
    case LP_G1: scan(ar + AR_AI, (size_t)NUNIT * 4096, 0); scan(ar + AR_NEGW, SD, 0); scan(ar + AR_UT, SD, 0); scan(ar + AR_UT, (size_t)NUNIT * 16384 * 2, 0); break;
    case LP_G2: scan(ar + AR_SG, (size_t)NUNIT * 16384, 0); break;
    case LP_OUT: case LP_DOWN: case LP_COMB: case LP_PLE: scan(out, SD, 1); scan(ws + WS_HBF, SD, 0); scan(ws + ((lp == LP_PLE) ? WS_SSQB : WS_SSQA), (size_t)S_ * 16, 1); break;
    case LP_UP: scan(ar + AR_ACT, (size_t)S_ * DFF, 0); break;
    case LP_R1: scan(ws + WS_TOK + TOK_G, (size_t)S_ * 2, 1); break;
    default: break; }
}
#endif
#ifndef MK_MULTI
#define MK_MULTI 0
#endif
extern "C" void kernel_launch(void* const* d_in, const int* in_sizes, int n_in, void* d_out, int out_size, void* d_ws, size_t ws_size, hipStream_t stream) {
    static int grid = 0;
    if (grid == 0) {
        if (n_in != 30 || out_size != S_ * D_ || ws_size < WS_NEED) { fprintf(stderr, "kernel_launch: unexpected problem (n_in %d, out %d, ws %zu < %zu)\n", n_in, out_size, ws_size, (size_t)WS_NEED); grid = -1; return; }
        int dev = 0, cus = 0, per_cu = 0;
        if (hipGetDevice(&dev) != hipSuccess || hipDeviceGetAttribute(&cus, hipDeviceAttributeMultiprocessorCount, dev) != hipSuccess) { grid = -1; return; }
        if (hipFuncSetAttribute((const void*)fwd, hipFuncAttributeMaxDynamicSharedMemorySize, LDS_BYTES) != hipSuccess) { fprintf(stderr, "kernel_launch: hipFuncSetAttribute failed\n"); grid = -1; return; }
        if (hipOccupancyMaxActiveBlocksPerMultiprocessor(&per_cu, (const void*)fwd, NWAVES * 64, LDS_BYTES) != hipSuccess || per_cu < 1) { fprintf(stderr, "kernel_launch: occupancy query says %d\n", per_cu); }
        (void)hipGetLastError();
        grid = cus;
#if DBG
        (void)hipFuncSetAttribute((const void*)chk_gdn_rec, hipFuncAttributeMaxDynamicSharedMemorySize, 72 * 1024);
#endif
    }
    if (grid < 0) return;
    (void)hipMemsetAsync((char*)d_ws + WS_CTL, 0, CTL_ZERO_BYTES, stream);
    Args a{};
    for (int i = 0; i < 30; ++i) a.in[i] = d_in[i];
    a.out = (float*)d_out; a.ws = (unsigned char*)d_ws; a.pad = 0;
#if MK_MULTI
    a.use_bar = 0;
    static const int seq_even[] = {LP_PROJ, LP_ROT, LP_ATT, LP_MIXPREP, LP_OUT, LP_UP, LP_DOWN, LP_PLE};
    static const int seq_odd[] = {LP_PROJ, LP_GA, LP_G2, LP_G3, LP_OUT, LP_R1, LP_R2, LP_M1, LP_M2, LP_COMB, LP_PLE};
    int plist[64], np = 0; plist[np++] = P_PRO;
    for (int L = 0; L < DEPTH_; ++L) { const bool odd = L & 1; const int n = odd ? 11 : 8; for (int q = 0; q < n; ++q) plist[np++] = 1 + LPN * L + (odd ? seq_odd[q] : seq_even[q]); }
    plist[np++] = P_FINAL;
    for (int pi = 0; pi < np; ++pi) { const int ph = plist[pi];
        a.ph_lo = ph; a.ph_hi = ph + 1;
#if DBG
        dbg_before_phase(ph, (unsigned char*)d_ws, (float*)d_out, stream);
#endif
        hipLaunchKernelGGL(fwd, dim3(grid), dim3(NWAVES * 64), LDS_BYTES, stream, a);
#if DBG
        dbg_after_phase(ph, (unsigned char*)d_ws, (float*)d_out, stream); dbg_checks(ph, d_in, (unsigned char*)d_ws, (float*)d_out, stream);
#endif
    }
#if DBG
    hipLaunchKernelGGL(dbg_fill, dim3(1024), dim3(256), 0, stream, (float*)d_out, (size_t)S_ * D_, (const unsigned*)((unsigned char*)d_ws + WS_CTL) + CW_DBG, P_FINAL + 1);
#endif
#else
    a.use_bar = 1; a.ph_lo = 0; a.ph_hi = P_FINAL + 1;
    hipLaunchKernelGGL(fwd, dim3(grid), dim3(NWAVES * 64), LDS_BYTES, stream, a);
#ifdef PROBE_PH
    for (int i = 0; i < PROBE_N; ++i) { a.use_bar = 0; a.ph_lo = PROBE_PH; a.ph_hi = PROBE_PH + 1; hipLaunchKernelGGL(fwd, dim3(grid), dim3(NWAVES * 64), LDS_BYTES, stream, a); }
#endif
#endif
    const hipError_t le = hipPeekAtLastError();
    if (le != hipSuccess) fprintf(stderr, "kernel_launch: launch failed: %s\n", hipGetErrorName(le));
}
```

```cpp
#include <hip/hip_runtime.h>
#include <hip/hip_bf16.h>
#include <cstdio>
#include <cstdint>
#include <cmath>

constexpr int S_ = 16384, D_ = 1024, DEPTH_ = 4;
constexpr int EIN = 3072, OIN = 4352  , OIN_W = 4096, OIN_SRC = 4112, DFF = 3584, NEXP = 8, PLE = 256;
constexpr int MOE_P = 2 * S_ + NEXP * 256;
constexpr int NCHUNK = S_ / 64, NUNIT = NCHUNK * 8;
constexpr float RMS_EPS = 1e-6f;

namespace pg8 {
#define PG8_LAS __attribute__((address_space(3)))
typedef unsigned short bf16_t;
typedef short bf16x8 __attribute__((ext_vector_type(8)));
typedef float f32x4 __attribute__((ext_vector_type(4)));
typedef float f32x2 __attribute__((ext_vector_type(2)));
typedef unsigned u32x4 __attribute__((ext_vector_type(4)));
typedef unsigned u32x2 __attribute__((ext_vector_type(2)));
constexpr int BM = 256, BK = 64, HALF = 128, HTB = HALF * BK * 2, STAGE_BYTES = 8 * HTB, NXCD = 8, WGM = 8;

__host__ __device__ __forceinline__ int lds_byte(int r, int c) { const int st = (r >> 4) * 2 + (c >> 5), rr = r & 15, cc = c & 31, ob = rr * 64 + cc * 2; return st * 1024 + (ob ^ (((ob >> 9) & 1) << 5)); }
__host__ __device__ __forceinline__ void stage_rc(int b, int& R, int& C) { const int st = b / 1024, sb = b % 1024, swz = sb ^ (((sb >> 9) & 1) << 5); R = (st >> 1) * 16 + swz / 64; C = (st & 1) * 32 + (swz % 64) / 2; }
__host__ __device__ __forceinline__ int perm32(int rho) { const int n = rho >> 4, i = rho & 15; return 8 * (i >> 2) + 4 * n + (i & 3); }

struct Unit { int pm, pn, be; };
struct Gemm { const bf16_t* A; const bf16_t* Bt; int M, N, K; size_t bstride; };

struct StaticOrder {
    int nM, nN, nwg, G, c;
    __host__ __device__ void init(int M, int N, int G_, int c_) { nM = M / BM; nN = N / BM; nwg = nM * nN; G = G_; c = c_; }
    __host__ __device__ bool next(int i, Unit& u) const {
        const long L = (long)i * G + c; if (L >= nwg) return false;
        int wgid = (int)L; { const int q = nwg / NXCD, r = nwg % NXCD, xcd = wgid % NXCD, off = wgid / NXCD; wgid = (xcd < r ? xcd * (q + 1) : r * (q + 1) + (xcd - r) * q) + off; }
        const int nig = WGM * nN, gid = wgid / nig, fm = gid * WGM, gsz = (nM - fm) < WGM ? (nM - fm) : WGM;
        u.pm = fm + ((wgid % nig) % gsz); u.pn = (wgid % nig) / gsz; u.be = 0; return true;
    }
    __device__ __forceinline__ void a_ready(const Unit&) const {}
    __device__ __forceinline__ void done(const Unit&) const {}
};
struct MoeOrder : StaticOrder {
    const PG8_LAS int* blk_e;
    __device__ __forceinline__ bool next(int i, Unit& u) const { if (!StaticOrder::next(i, u)) return false; u.be = blk_e[u.pm]; return true; }
};

__device__ __forceinline__ unsigned cvt_pk_bf16(float lo, float hi) { unsigned r; asm volatile("v_cvt_pk_bf16_f32 %0, %1, %2" : "=v"(r) : "v"(lo), "v"(hi)); return r; }
typedef __bf16 bf16x2_t_ __attribute__((ext_vector_type(2)));
__device__ __forceinline__ unsigned cvt_pk_bf16_cv(float lo, float hi) { const f32x2 v = {lo, hi}; const bf16x2_t_ b = __builtin_convertvector(v, bf16x2_t_); return __builtin_bit_cast(unsigned, b); }
__device__ __forceinline__ float bf_lo(unsigned w) { return __uint_as_float(w << 16); }
__device__ __forceinline__ float bf_hi(unsigned w) { return __uint_as_float(w & 0xffff0000u); }

__device__ __forceinline__ float rstd_row(const float* ssq, int row) {
    const f32x4* p = (const f32x4*)(ssq + (size_t)row * 16);
    const f32x4 a = p[0], b = p[1], c = p[2], d = p[3];
    const float s = (((a[0] + a[1]) + (a[2] + a[3])) + ((b[0] + b[1]) + (b[2] + b[3]))) + (((c[0] + c[1]) + (c[2] + c[3])) + ((d[0] + d[1]) + (d[2] + d[3])));
    return __builtin_amdgcn_rsqf(s * (1.0f / 1024.0f) + RMS_EPS);
}
__device__ __forceinline__ float sigmoidf_(float x) { return __builtin_amdgcn_rcpf(1.0f + __builtin_amdgcn_exp2f(-1.4426950408889634f * x)); }
__device__ __forceinline__ float siluf_(float x) { return x * sigmoidf_(x); }

constexpr float C2 = 0.125f * 1.4426950408889634f;

struct EpiProjEven {
    static constexpr bool PERM = true, AFTER_DRAIN = false;
    bf16_t* O; const float* ssq; const float* tab;
    __device__ __forceinline__ void operator()(const f32x4 (&acc)[2][2][4][2], const Unit& u, int wr, int wc, int fr, int fq) const {
        const int row0 = u.pm * BM + wr * 64 + fr, colt = u.pn * BM;
        const bool rot = (colt < 1024) && ((wc & 1) == 0);
        const float qs = (colt < 512) ? C2 : 1.0f;
#pragma unroll
        for (int ai = 0; ai < 2; ++ai)
#pragma unroll
            for (int m = 0; m < 4; ++m) {
                const int row = row0 + ai * HALF + m * 16; const float rs = rstd_row(ssq, row);
                f32x4 c0 = {1.f, 1.f, 1.f, 1.f}, c1 = c0, s0 = {0.f, 0.f, 0.f, 0.f}, s1 = s0;
                if (rot && fq < 2) { const f32x4* t = (const f32x4*)(tab + (size_t)row * 16); c0 = t[0]; c1 = t[1]; s0 = t[2]; s1 = t[3]; if (fq == 0) { s0 = -s0; s1 = -s1; } }
#pragma unroll
                for (int bj = 0; bj < 2; ++bj) {
                    f32x4 v0 = acc[ai][bj][m][0] * rs, v1 = acc[ai][bj][m][1] * rs;
                    if (rot) {
                        f32x4 p0, p1;
#pragma unroll
                        for (int i = 0; i < 4; ++i) { p0[i] = __shfl_xor(v0[i], 16); p1[i] = __shfl_xor(v1[i], 16); }
                        v0 = v0 * c0 + p0 * s0; v1 = v1 * c1 + p1 * s1;
                    }
                    v0 = v0 * qs; v1 = v1 * qs;
                    u32x4 w; w.x = cvt_pk_bf16(v0[0], v0[1]); w.y = cvt_pk_bf16(v0[2], v0[3]); w.z = cvt_pk_bf16(v1[0], v1[1]); w.w = cvt_pk_bf16(v1[2], v1[3]);
                    *(u32x4*)(O + (size_t)row * EIN + colt + bj * HALF + wc * 32 + 8 * fq) = w;
                }
                asm volatile("" ::: "memory");
            }
    }
};
struct EpiBf16 {
    static constexpr bool PERM = true, AFTER_DRAIN = false;
    bf16_t* O; int ldc; const float* ssq; float scale0; int scale_cols;
    __device__ __forceinline__ void operator()(const f32x4 (&acc)[2][2][4][2], const Unit& u, int wr, int wc, int fr, int fq) const {
        const int row0 = u.pm * BM + wr * 64 + fr, colt = u.pn * BM;
#pragma unroll
        for (int ai = 0; ai < 2; ++ai)
#pragma unroll
            for (int m = 0; m < 4; ++m) {
                const int row = row0 + ai * HALF + m * 16; const float rs = (ssq ? rstd_row(ssq, row) : 1.0f) * (colt < scale_cols ? scale0 : 1.0f);
#pragma unroll
                for (int bj = 0; bj < 2; ++bj) {
                    const f32x4 v0 = acc[ai][bj][m][0] * rs, v1 = acc[ai][bj][m][1] * rs;
                    u32x4 w; w.x = cvt_pk_bf16(v0[0], v0[1]); w.y = cvt_pk_bf16(v0[2], v0[3]); w.z = cvt_pk_bf16(v1[0], v1[1]); w.w = cvt_pk_bf16(v1[2], v1[3]);
                    *(u32x4*)(O + (size_t)row * ldc + colt + bj * HALF + wc * 32 + 8 * fq) = w;
                }
                if (m & 1) asm volatile("" ::: "memory");
            }
    }
};
struct EpiSwiglu {
    static constexpr bool PERM = true, AFTER_DRAIN = false;
    bf16_t* O; const float* ssq;
    __device__ __forceinline__ void operator()(const f32x4 (&acc)[2][2][4][2], const Unit& u, int wr, int wc, int fr, int fq) const {
        const int row0 = u.pm * BM + wr * 64 + fr, col = u.pn * HALF + wc * 32 + 8 * fq;
#pragma unroll
        for (int ai = 0; ai < 2; ++ai)
#pragma unroll
            for (int m = 0; m < 4; ++m) {
                const int row = row0 + ai * HALF + m * 16; const float rs = ssq ? rstd_row(ssq, row) : 1.0f;
                float o[8];
#pragma unroll
                for (int n = 0; n < 2; ++n)
#pragma unroll
                    for (int i = 0; i < 4; ++i) { const float a = acc[ai][0][m][n][i] * rs, b = acc[ai][1][m][n][i] * rs; o[4 * n + i] = siluf_(a) * b; }
                u32x4 w; w.x = cvt_pk_bf16(o[0], o[1]); w.y = cvt_pk_bf16(o[2], o[3]); w.z = cvt_pk_bf16(o[4], o[5]); w.w = cvt_pk_bf16(o[6], o[7]);
                *(u32x4*)(O + (size_t)row * DFF + col) = w;
                if (m & 1) asm volatile("" ::: "memory");
            }
    }
};
struct EpiResid {
    static constexpr bool PERM = true, AFTER_DRAIN = false;
    bf16_t* hb; float* ssq;
    __device__ __forceinline__ void operator()(const f32x4 (&acc)[2][2][4][2], const Unit& u, int wr, int wc, int fr, int fq) const {
        const int row0 = u.pm * BM + wr * 64 + fr, colt = u.pn * BM;
#pragma unroll
        for (int ai = 0; ai < 2; ++ai)
#pragma unroll
            for (int m = 0; m < 4; ++m) {
                const int row = row0 + ai * HALF + m * 16; float ss = 0.f;
#pragma unroll
                for (int bj = 0; bj < 2; ++bj) {
                    const size_t off = (size_t)row * D_ + colt + bj * HALF + wc * 32 + 8 * fq;
                    const u32x4 hv = *(const u32x4*)(hb + off);
                    f32x4 x0 = {bf_lo(hv.x), bf_hi(hv.x), bf_lo(hv.y), bf_hi(hv.y)}, x1 = {bf_lo(hv.z), bf_hi(hv.z), bf_lo(hv.w), bf_hi(hv.w)};
                    x0 = x0 + acc[ai][bj][m][0]; x1 = x1 + acc[ai][bj][m][1];
                    ss += (x0[0] * x0[0] + x0[1] * x0[1]) + (x0[2] * x0[2] + x0[3] * x0[3]) + (x1[0] * x1[0] + x1[1] * x1[1]) + (x1[2] * x1[2] + x1[3] * x1[3]);
                    u32x4 w; w.x = cvt_pk_bf16(x0[0], x0[1]); w.y = cvt_pk_bf16(x0[2], x0[3]); w.z = cvt_pk_bf16(x1[0], x1[1]); w.w = cvt_pk_bf16(x1[2], x1[3]);
                    *(u32x4*)(hb + off) = w;
                }
                ss += __shfl_xor(ss, 16); ss += __shfl_xor(ss, 32);
                if (fq == 0) ssq[(size_t)row * 16 + u.pn * 4 + wc] = ss;
                asm volatile("" ::: "memory");
            }
    }
};
struct EpiPle {
    static constexpr bool PERM = true, AFTER_DRAIN = false;
    bf16_t* hb; const float* ssq_in; float* ssq_out; const bf16_t* pp;
    __device__ __forceinline__ void operator()(const f32x4 (&acc)[2][2][4][2], const Unit& u, int wr, int wc, int fr, int fq) const {
        const int row0 = u.pm * BM + wr * 64 + fr, colt = u.pn * BM;
#pragma unroll
        for (int ai = 0; ai < 2; ++ai)
#pragma unroll
            for (int m = 0; m < 4; ++m) {
                const int row = row0 + ai * HALF + m * 16; const float rs = rstd_row(ssq_in, row); float ss = 0.f;
#pragma unroll
                for (int bj = 0; bj < 2; ++bj) {
                    const size_t off = (size_t)row * D_ + colt + bj * HALF + wc * 32 + 8 * fq;
                    const u32x4 hv = *(const u32x4*)(hb + off); const u32x4 pw = *(const u32x4*)(pp + off);
                    f32x4 x0 = {bf_lo(hv.x), bf_hi(hv.x), bf_lo(hv.y), bf_hi(hv.y)}, x1 = {bf_lo(hv.z), bf_hi(hv.z), bf_lo(hv.w), bf_hi(hv.w)};
                    const f32x4 a0 = acc[ai][bj][m][0] * rs, a1 = acc[ai][bj][m][1] * rs;
                    x0[0] += sigmoidf_(a0[0]) * bf_lo(pw.x); x0[1] += sigmoidf_(a0[1]) * bf_hi(pw.x); x0[2] += sigmoidf_(a0[2]) * bf_lo(pw.y); x0[3] += sigmoidf_(a0[3]) * bf_hi(pw.y);
                    x1[0] += sigmoidf_(a1[0]) * bf_lo(pw.z); x1[1] += sigmoidf_(a1[1]) * bf_hi(pw.z); x1[2] += sigmoidf_(a1[2]) * bf_lo(pw.w); x1[3] += sigmoidf_(a1[3]) * bf_hi(pw.w);
                    ss += (x0[0] * x0[0] + x0[1] * x0[1]) + (x0[2] * x0[2] + x0[3] * x0[3]) + (x1[0] * x1[0] + x1[1] * x1[1]) + (x1[2] * x1[2] + x1[3] * x1[3]);
                    u32x4 w; w.x = cvt_pk_bf16(x0[0], x0[1]); w.y = cvt_pk_bf16(x0[2], x0[3]); w.z = cvt_pk_bf16(x1[0], x1[1]); w.w = cvt_pk_bf16(x1[2], x1[3]);
                    *(u32x4*)(hb + off) = w;
                }
                ss += __shfl_xor(ss, 16); ss += __shfl_xor(ss, 32);
                if (fq == 0) ssq_out[(size_t)row * 16 + u.pn * 4 + wc] = ss;
                asm volatile("" ::: "memory");
            }
    }
};
struct EpiMoeDown {
    static constexpr bool PERM = true, AFTER_DRAIN = false;
    bf16_t* Y; const float* gate;
    __device__ __forceinline__ void operator()(const f32x4 (&acc)[2][2][4][2], const Unit& u, int wr, int wc, int fr, int fq) const {
        const int row0 = u.pm * BM + wr * 64 + fr, colt = u.pn * BM;
#pragma unroll
        for (int ai = 0; ai < 2; ++ai)
#pragma unroll
            for (int m = 0; m < 4; ++m) {
                const int row = row0 + ai * HALF + m * 16; const float gt = gate[row];
#pragma unroll
                for (int bj = 0; bj < 2; ++bj) {
                    const f32x4 v0 = acc[ai][bj][m][0] * gt, v1 = acc[ai][bj][m][1] * gt;
                    u32x4 w; w.x = cvt_pk_bf16(v0[0], v0[1]); w.y = cvt_pk_bf16(v0[2], v0[3]); w.z = cvt_pk_bf16(v1[0], v1[1]); w.w = cvt_pk_bf16(v1[2], v1[3]);
                    *(u32x4*)(Y + (size_t)row * D_ + colt + bj * HALF + wc * 32 + 8 * fq) = w;
                }
                if (m & 1) asm volatile("" ::: "memory");
            }
    }
};

template <class Epi, class Sched, bool ALIGN_EPI = false, bool SP2 = false>
__device__ __forceinline__ void gemm_phase(PG8_LAS unsigned char* lds, const Gemm g, const Sched& S, const Epi& E) {
    int tid_ = threadIdx.x; asm volatile("" : "+v"(tid_));
    const int tid = tid_, wid = __builtin_amdgcn_readfirstlane(tid >> 6), lane = tid & 63, wr = wid >> 2, wc = wid & 3, fr = lane & 15, fq = lane >> 4;
    const int K = g.K, nt = K / BK;
    unsigned voffA[2], voffB[2];
#pragma unroll
    for (int i = 0; i < 2; ++i) { int R, C; stage_rc(tid * 16 + i * 8192, R, C); const int Rb = Epi::PERM ? ((R & ~31) + perm32(R & 31)) : R;
        voffA[i] = (unsigned)(R * K + C) * 2u; voffB[i] = (unsigned)(Rb * K + C) * 2u; }
    const size_t kstep = (size_t)(BK * 2);
    const size_t hstep = (size_t)HALF * K * 2;
    const size_t tstep = 2 * hstep;
    const unsigned ldsw = (unsigned)wid * 1024u;
    const int aoff = lds_byte(wr * 64 + fr, fq * 8), boff = lds_byte(wc * 32 + fr, fq * 8);
#define PG8_SA(b, h) (((b) * 2 + (h)) * HTB)
#define PG8_SB(b, h) ((4 + (b) * 2 + (h)) * HTB)
#define PG8_STAGE(bufoff, gbase, voff) do { _Pragma("unroll") for (int _i = 0; _i < 2; ++_i) \
        __builtin_amdgcn_global_load_lds((const unsigned*)((const char*)(gbase) + (voff)[_i]), (PG8_LAS unsigned*)(lds + (bufoff) + ldsw + _i * 8192), 16, 0, 0); } while (0)
#define PG8_LDA(dst, b, h) do { _Pragma("unroll") for (int m = 0; m < 4; ++m) _Pragma("unroll") for (int k = 0; k < 2; ++k) dst[m][k] = *(const PG8_LAS bf16x8*)(lds + PG8_SA(b, h) + aoff + m * 2048 + k * 1024); } while (0)
#define PG8_LDB(dst, b, h) do { _Pragma("unroll") for (int n = 0; n < 2; ++n) _Pragma("unroll") for (int k = 0; k < 2; ++k) dst[n][k] = *(const PG8_LAS bf16x8*)(lds + PG8_SB(b, h) + boff + n * 2048 + k * 1024); } while (0)
#define PG8_MMA(ai, bj, At, Bt) do { __builtin_amdgcn_s_setprio(1); _Pragma("unroll") for (int m = 0; m < 4; ++m) _Pragma("unroll") for (int n = 0; n < 2; ++n) _Pragma("unroll") for (int k = 0; k < 2; ++k) \
        acc[ai][bj][m][n] = __builtin_amdgcn_mfma_f32_16x16x32_bf16(Bt[n][k], At[m][k], acc[ai][bj][m][n], 0, 0, 0); __builtin_amdgcn_s_setprio(0); } while (0)
#define PG8_WAIT_V(n) asm volatile("s_waitcnt vmcnt(" #n ")" ::: "memory")
#define PG8_WAIT_L(n) asm volatile("s_waitcnt lgkmcnt(" #n ")" ::: "memory")
#define PG8_BAR __builtin_amdgcn_s_barrier()
#define PG8_SCHED __builtin_amdgcn_sched_barrier(0)
    Unit cur, nxt; int ui = 0;
    if (!S.next(0, cur)) return;
    f32x4 acc[2][2][4][2];
#pragma unroll
    for (int a = 0; a < 2; ++a)
#pragma unroll
        for (int b = 0; b < 2; ++b)
#pragma unroll
            for (int m = 0; m < 4; ++m)
#pragma unroll
                for (int n = 0; n < 2; ++n) acc[a][b][m][n] = (f32x4){0.f, 0.f, 0.f, 0.f};
    bf16x8 At[4][2], B0[2][2], B1[2][2];
    const char* cA = (const char*)g.A + (size_t)cur.pm * tstep; const char* cB = (const char*)g.Bt + (size_t)cur.pn * tstep + (size_t)cur.be * g.bstride;
    S.a_ready(cur);
    if constexpr (SP2) {
        PG8_STAGE(PG8_SB(0, 0), cB, voffB); PG8_STAGE(PG8_SB(0, 1), cB + hstep, voffB); PG8_STAGE(PG8_SA(0, 0), cA, voffA); PG8_STAGE(PG8_SA(0, 1), cA + hstep, voffA);
        if (wr == 1) PG8_BAR;
        PG8_WAIT_V(2); PG8_BAR;
        PG8_STAGE(PG8_SB(1, 0), cB + kstep, voffB); PG8_STAGE(PG8_SA(1, 0), cA + kstep, voffA); PG8_STAGE(PG8_SB(1, 1), cB + hstep + kstep, voffB);
        PG8_WAIT_V(6); PG8_BAR;
    } else {
        PG8_STAGE(PG8_SB(0, 0), cB, voffB); PG8_STAGE(PG8_SA(0, 0), cA, voffA); PG8_STAGE(PG8_SB(0, 1), cB + hstep, voffB); PG8_STAGE(PG8_SA(0, 1), cA + hstep, voffA);
        if (wr == 1) PG8_BAR;
        PG8_WAIT_V(4); PG8_BAR;
        PG8_STAGE(PG8_SB(1, 0), cB + kstep, voffB); PG8_STAGE(PG8_SA(1, 0), cA + kstep, voffA); PG8_STAGE(PG8_SB(1, 1), cB + hstep + kstep, voffB);
        PG8_WAIT_V(6); PG8_BAR;
    }
    for (;;) {
        const bool has_next = S.next(ui + 1, nxt);
        const char* nA = has_next ? (const char*)g.A + (size_t)nxt.pm * tstep : cA; const char* nB = has_next ? (const char*)g.Bt + (size_t)nxt.pn * tstep + (size_t)nxt.be * g.bstride : cB;
        for (int t = 0; t < nt; t += 2) {
            const bool last = (t == nt - 2);
            const char* a1 = cA + (size_t)(t + 1) * kstep;
            const char* a2 = last ? nA : cA + (size_t)(t + 2) * kstep; const char* b2 = last ? nB : cB + (size_t)(t + 2) * kstep;
            const char* a3 = a2 + kstep; const char* b3 = b2 + kstep;
            if (last && has_next) S.a_ready(nxt);
            if constexpr (SP2) {
            PG8_LDB(B0, 0, 0); PG8_LDB(B1, 0, 1); PG8_SCHED; PG8_LDA(At, 0, 0); PG8_STAGE(PG8_SA(1, 1), a1 + hstep, voffA);
            PG8_WAIT_V(8); PG8_WAIT_L(0); PG8_BAR; PG8_MMA(0, 0, At, B0); PG8_MMA(0, 1, At, B1); PG8_BAR; PG8_SCHED;
            PG8_LDA(At, 0, 1); PG8_STAGE(PG8_SB(0, 0), b2, voffB); PG8_STAGE(PG8_SB(0, 1), b2 + hstep, voffB); PG8_STAGE(PG8_SA(0, 0), a2, voffA);
            PG8_WAIT_V(8); PG8_WAIT_L(0); PG8_BAR; PG8_MMA(1, 0, At, B0); PG8_MMA(1, 1, At, B1); PG8_BAR; PG8_SCHED;
            PG8_LDB(B0, 1, 0); PG8_LDB(B1, 1, 1); PG8_SCHED; PG8_LDA(At, 1, 0); PG8_STAGE(PG8_SA(0, 1), a2 + hstep, voffA);
            PG8_WAIT_V(8); PG8_WAIT_L(0); PG8_BAR; PG8_MMA(0, 0, At, B0); PG8_MMA(0, 1, At, B1); PG8_BAR; PG8_SCHED;
            PG8_LDA(At, 1, 1); PG8_STAGE(PG8_SB(1, 0), b3, voffB); PG8_STAGE(PG8_SB(1, 1), b3 + hstep, voffB); PG8_STAGE(PG8_SA(1, 0), a3, voffA);
            PG8_WAIT_V(8); PG8_WAIT_L(0); PG8_BAR; PG8_MMA(1, 0, At, B0); PG8_MMA(1, 1, At, B1); PG8_BAR; PG8_SCHED;
            } else {
            PG8_LDB(B0, 0, 0); PG8_SCHED; PG8_LDA(At, 0, 0); PG8_STAGE(PG8_SA(1, 1), a1 + hstep, voffA);
            PG8_WAIT_L(8); PG8_BAR; PG8_WAIT_L(0); PG8_MMA(0, 0, At, B0); PG8_BAR; PG8_SCHED;
            PG8_LDB(B1, 0, 1); PG8_STAGE(PG8_SB(0, 0), b2, voffB);
            PG8_BAR; PG8_WAIT_L(0); PG8_MMA(0, 1, At, B1); PG8_BAR;
            PG8_LDA(At, 0, 1); PG8_STAGE(PG8_SA(0, 0), a2, voffA);
            PG8_BAR; PG8_WAIT_L(0); PG8_MMA(1, 0, At, B0); PG8_BAR; PG8_SCHED;
            PG8_STAGE(PG8_SB(0, 1), b2 + hstep, voffB);
            PG8_WAIT_V(6); PG8_BAR; PG8_MMA(1, 1, At, B1); PG8_BAR;
            PG8_LDB(B0, 1, 0); PG8_SCHED; PG8_LDA(At, 1, 0); PG8_STAGE(PG8_SA(0, 1), a2 + hstep, voffA);
            PG8_WAIT_L(8); PG8_BAR; PG8_WAIT_L(0); PG8_MMA(0, 0, At, B0); PG8_BAR; PG8_SCHED;
            PG8_LDB(B1, 1, 1); PG8_STAGE(PG8_SB(1, 0), b3, voffB);
            PG8_BAR; PG8_WAIT_L(0); PG8_MMA(0, 1, At, B1); PG8_BAR;
            PG8_LDA(At, 1, 1); PG8_STAGE(PG8_SA(1, 0), a3, voffA);
            PG8_BAR; PG8_WAIT_L(0); PG8_MMA(1, 0, At, B0); PG8_BAR; PG8_SCHED;
            PG8_STAGE(PG8_SB(1, 1), b3 + hstep, voffB);
            PG8_WAIT_V(6); PG8_BAR; PG8_MMA(1, 1, At, B1); PG8_BAR;
            }
        }
        if constexpr (ALIGN_EPI) { if (wr == 0) PG8_BAR; }
        if constexpr (!Epi::AFTER_DRAIN) { E(acc, cur, wr, wc, fr, fq); S.done(cur); }
        if (!has_next) break;
#pragma unroll
        for (int a = 0; a < 2; ++a)
#pragma unroll
            for (int b = 0; b < 2; ++b)
#pragma unroll
                for (int m = 0; m < 4; ++m)
#pragma unroll
                    for (int n = 0; n < 2; ++n) acc[a][b][m][n] = (f32x4){0.f, 0.f, 0.f, 0.f};
        cur = nxt; cA = nA; cB = nB; ++ui;
        if constexpr (ALIGN_EPI) { if (wr == 1) PG8_BAR; }
    }
    PG8_WAIT_V(0);
    if constexpr (!ALIGN_EPI) { if (wr == 0) PG8_BAR; }
    PG8_BAR;
    if constexpr (Epi::AFTER_DRAIN) { E.fused(acc, cur, wr, wc, fr, fq, lds, wid, lane); S.done(cur); }
#undef PG8_SA
#undef PG8_SB
#undef PG8_STAGE
#undef PG8_LDA
#undef PG8_LDB
#undef PG8_MMA
#undef PG8_WAIT_V
#undef PG8_WAIT_L
#undef PG8_BAR
#undef PG8_SCHED
}
}

#include <hip/hip_bf16.h>
#include <cmath>
namespace attn_body {
using bf16=__hip_bfloat16;
using bf16x8=__attribute__((ext_vector_type(8)))short;
using s16x4=__attribute__((ext_vector_type(4)))short;
using f32x16=__attribute__((ext_vector_type(16)))float;
using u32x4=__attribute__((ext_vector_type(4)))unsigned;
constexpr int SEQ=16384,D=64,LDP=3072,LDO=1024;
constexpr int NW=8,QBLK=32,QB=QBLK*NW,KVBLK=64,NQB=SEQ/QB;
constexpr int ATTN_UNIT_ROWS=QB;
__device__ __forceinline__ int crow(int r,int hi){return (r&3)+8*(r>>2)+4*hi;}
#define SBAR() __builtin_amdgcn_sched_barrier(0)
__device__ __forceinline__ void cmask(f32x16&p0,f32x16&p1,int jb,int qrel,int hi){
  const float NEG=-INFINITY; int kb=64*jb+4*hi;
  #pragma unroll
  for(int r=0;r<16;++r){int kv=kb+(r&3)+8*(r>>2); if(kv>qrel)p0[r]=NEG; if(kv+32>qrel)p1[r]=NEG;}
}

constexpr int NSLOT=3, SLOTB=8192, VSLOTB=2*SLOTB;
constexpr int LDS_K=0, LDS_V=NSLOT*SLOTB, LDS_WS=LDS_V+NSLOT*VSLOTB, LDS_OST=0  , LDS_BYTES=LDS_WS+NW*64*4;
constexpr float C2=0.125f*1.4426950408889634f;
__device__ __forceinline__ void glds16(const void*gsrc,unsigned lds_dst){unsigned keep;
  asm volatile("s_mov_b32 %0, m0\n\ts_mov_b32 m0, %2\n\ts_nop 0\n\tglobal_load_lds_dwordx4 %1, off\n\ts_mov_b32 m0, %0":"=&s"(keep):"v"(gsrc),"s"(lds_dst):"memory");}
__device__ __forceinline__ float max3f(float a,float b,float c){float r;asm("v_max3_f32 %0, %1, %2, %3":"=v"(r):"v"(a),"v"(b),"v"(c));return r;}
__device__ __forceinline__ float max2f(float a,float b){float r;asm("v_max_f32_e32 %0, %1, %2":"=v"(r):"v"(a),"v"(b));return r;}
__device__ __forceinline__ float fadd_s(float a,float b){float r;asm("v_add_f32_e32 %0, %1, %2":"=v"(r):"v"(a),"v"(b));return r;}
__device__ __forceinline__ float fsub_s(float a,float b){float r;asm("v_sub_f32_e32 %0, %1, %2":"=v"(r):"v"(a),"v"(b));return r;}
typedef float f32x2_t __attribute__((ext_vector_type(2))); typedef __bf16 bf16x2_t __attribute__((ext_vector_type(2)));
__device__ __forceinline__ unsigned cvtpk_s(float lo,float hi){f32x2_t v={lo,hi};bf16x2_t b=__builtin_convertvector(v,bf16x2_t);return __builtin_bit_cast(unsigned,b);}
#define WAIT_BAR(N) asm volatile("s_waitcnt vmcnt(" #N ") lgkmcnt(0)\n\ts_barrier":::"memory")

__device__ __forceinline__ void qkt(f32x16&p0,f32x16&p1,const char*Kslot,const bf16x8*qr,int r32,int hi){
  const char*kb=Kslot+hi*1024+r32*16;
  #pragma unroll
  for(int d0=0;d0<4;++d0){
    const bf16x8 b0=*reinterpret_cast<const bf16x8*>(kb+d0*2048);
    const bf16x8 b1=*reinterpret_cast<const bf16x8*>(kb+d0*2048+512);
    if(d0==0){p0=__builtin_amdgcn_mfma_f32_32x32x16_bf16(b0,qr[0],f32x16{},0,0,0);p1=__builtin_amdgcn_mfma_f32_32x32x16_bf16(b1,qr[0],f32x16{},0,0,0);}
    else{p0=__builtin_amdgcn_mfma_f32_32x32x16_bf16(b0,qr[d0],p0,0,0,0);p1=__builtin_amdgcn_mfma_f32_32x32x16_bf16(b1,qr[d0],p1,0,0,0);}}
}
typedef __attribute__((address_space(3))) const char* lds_cptr;
typedef short v4i16_t __attribute__((ext_vector_type(4)));
__device__ __forceinline__ void kload8(bf16x8*kf,lds_cptr kp){
  kf[0]=*(const __attribute__((address_space(3))) bf16x8*)(kp);      kf[1]=*(const __attribute__((address_space(3))) bf16x8*)(kp+512);
  kf[2]=*(const __attribute__((address_space(3))) bf16x8*)(kp+2048); kf[3]=*(const __attribute__((address_space(3))) bf16x8*)(kp+2560);
  kf[4]=*(const __attribute__((address_space(3))) bf16x8*)(kp+4096); kf[5]=*(const __attribute__((address_space(3))) bf16x8*)(kp+4608);
  kf[6]=*(const __attribute__((address_space(3))) bf16x8*)(kp+6144); kf[7]=*(const __attribute__((address_space(3))) bf16x8*)(kp+6656);
}
__device__ __forceinline__ void kload2(bf16x8*kf,lds_cptr kp,int j){ kf[2*j]=*(const __attribute__((address_space(3))) bf16x8*)(kp+j*2048); kf[2*j+1]=*(const __attribute__((address_space(3))) bf16x8*)(kp+j*2048+512); }
__device__ __forceinline__ s16x4 vtr(lds_cptr p){ return __builtin_bit_cast(s16x4,__builtin_amdgcn_ds_read_tr16_b64_v4i16((__attribute__((address_space(3))) v4i16_t*)p)); }
__device__ __forceinline__ float rowmax(const f32x16&p0,const f32x16&p1){
  float a=max3f(p0[0],p0[1],p1[0]),b=max3f(p0[2],p0[3],p1[1]);a=max3f(a,p1[2],p1[3]);
  #pragma unroll
  for(int r=4;r<16;r+=4){a=max3f(a,p0[r],p0[r+1]);b=max3f(b,p0[r+2],p0[r+3]);a=max3f(a,p1[r],p1[r+1]);b=max3f(b,p1[r+2],p1[r+3]);}
  const float m=max2f(a,b);
  auto rr=__builtin_amdgcn_permlane32_swap(__float_as_uint(m),__float_as_uint(m),false,false);
  return max2f(__uint_as_float(rr[0]),__uint_as_float(rr[1]));
}
__device__ __forceinline__ void pv(f32x16*o,int vb,bf16x8 pa0,bf16x8 pa1,bf16x8 pa2,bf16x8 pa3){
  #pragma unroll
  for(int d0=0;d0<4;++d0){s16x4 lo[4],hi[4];
    #pragma unroll
    for(int ks=0;ks<4;++ks){
      asm volatile("ds_read_b64_tr_b16 %0,%1 offset:%c2":"=&v"(lo[ks]):"v"(vb),"i"(d0*4096+ks*1024):"memory");
      asm volatile("ds_read_b64_tr_b16 %0,%1 offset:%c2":"=&v"(hi[ks]):"v"(vb),"i"(d0*4096+ks*1024+512):"memory");}
    asm volatile("s_waitcnt lgkmcnt(0)":::"memory");SBAR();
    #define PK(k) (bf16x8){lo[k][0],lo[k][1],lo[k][2],lo[k][3],hi[k][0],hi[k][1],hi[k][2],hi[k][3]}
    o[d0]=__builtin_amdgcn_mfma_f32_32x32x16_bf16(pa0,PK(0),o[d0],0,0,0);
    o[d0]=__builtin_amdgcn_mfma_f32_32x32x16_bf16(pa1,PK(1),o[d0],0,0,0);
    o[d0]=__builtin_amdgcn_mfma_f32_32x32x16_bf16(pa2,PK(2),o[d0],0,0,0);
    o[d0]=__builtin_amdgcn_mfma_f32_32x32x16_bf16(pa3,PK(3),o[d0],0,0,0);
    #undef PK
  }
}

#ifndef ATTN_STORE16
#define ATTN_STORE16(p,v) (*(u32x4*)(p)=(v))
#endif
template<int THRL> __device__ __forceinline__ void attn_unit(int qb,const bf16*Qh,const bf16*__restrict__ Kh,const bf16*__restrict__ Vh,bf16*Oh,char*shm){
  int tid_=threadIdx.x; asm volatile("":"+v"(tid_));
  const int tid=tid_,lane=tid&63,r32=lane&31,hi=lane>>5; const int wid=__builtin_amdgcn_readfirstlane(tid>>6);
  const int q0=qb*QB;
  const bf16*Qw=Qh+(long)(q0+wid*QBLK)*LDP;
  const unsigned lds0=(unsigned)(uintptr_t)shm;
  float*wsf=(float*)(shm+LDS_WS)+wid*64;
  const bf16*ksrc=Kh+(long)lane*LDP+wid*8;
  const bf16*vsrc=Vh+(long)(16*(wid&3)+(lane>>2))*LDP+(wid>>2)*32+(lane&3)*8;
  const unsigned kdst=lds0+LDS_K+wid*1024, vdst=lds0+LDS_V+wid*1024;
  #define DMA_K(t,slot) glds16(ksrc+(long)(t)*KVBLK*LDP,(unsigned)__builtin_amdgcn_readfirstlane(kdst+(slot)))
  #define DMA_V(t,slot) do{ glds16(vsrc+(long)(t)*KVBLK*LDP,(unsigned)__builtin_amdgcn_readfirstlane(vdst+2*(slot))); glds16(vsrc+64+(long)(t)*KVBLK*LDP,(unsigned)__builtin_amdgcn_readfirstlane(vdst+2*(slot)+8192)); }while(0)
  const int vb0=(int)(lds0+LDS_V)+((lane>>4)&1)*32+(lane&3)*8+(4*hi+((lane&15)>>2))*64;
  const char*Kbase=shm+LDS_K; bf16x8 kf[8];
  const lds_cptr shm3=(lds_cptr)shm; const lds_cptr kp0=shm3+LDS_K+hi*1024+r32*16; const lds_cptr vp0=shm3+LDS_V+((lane>>4)&1)*32+(lane&3)*8+(4*hi+((lane&15)>>2))*64;
  const int NT=(q0+QB)/KVBLK;
  DMA_K(0,0);DMA_V(0,0);DMA_K(1,SLOTB);
  bf16x8 qr[4];
  #pragma unroll
  for(int d0=0;d0<4;++d0)qr[d0]=*reinterpret_cast<const bf16x8*>(&Qw[(long)r32*LDP+d0*16+hi*8]);
  float mhat=0.f,l_reg=0.f;f32x16 o[4];o[0]=f32x16{};o[1]=f32x16{};o[2]=f32x16{};o[3]=f32x16{};
  const int qrel=wid*QBLK+r32;
  #define CMASK(P0,P1,t) do{int jb_=(t)-(NT-4); if(jb_>=0)cmask(P0,P1,jb_,qrel,hi);}while(0)
  bool resc=false;
  #define START(P0,P1) do{ const float rm=rowmax(P0,P1); resc=false; mhat=rm; \
    _Pragma("unroll") for(int r=0;r<16;++r)P0[r]=__builtin_amdgcn_exp2f(fsub_s(P0[r],mhat)); }while(0)
  #define RESC() do{ if(resc){ asm volatile("s_waitcnt lgkmcnt(0)":::"memory"); \
      _Pragma("unroll") for(int d_=0;d_<4;++d_) _Pragma("unroll") for(int r=0;r<16;++r)o[d_][r]*=wsf[crow(r,hi)]; } }while(0)
  f32x16 pA0,pA1,pB0,pB1;
  int sl_prev=0,sl_cur=0,sl_next=SLOTB;
  #define ROT() do{sl_prev=sl_cur;sl_cur=sl_next;sl_next=(sl_next==(NSLOT-1)*SLOTB)?0:sl_next+SLOTB;}while(0)
  DMA_K(2,2*SLOTB);
  WAIT_BAR(4);
  qkt(pA0,pA1,Kbase,qr,r32,hi);asm volatile("s_nop 15\n\ts_nop 7":"+v"(pA0),"+v"(pA1));CMASK(pA0,pA1,0);
  START(pA0,pA1);
  _Pragma("unroll") for(int r=0;r<16;++r)pA1[r]=__builtin_amdgcn_exp2f(pA1[r]-mhat);
  WAIT_BAR(0);
  DMA_K(3,0);DMA_V(1,SLOTB);
  ROT();
  kload8(kf,kp0+sl_cur);
  WAIT_BAR(3);
  s16x4 vlo[3],vhi[3]; u32x4 pw0,pw1,pw2,pw3;
  #define PKW(P,B) cvtpk_s(P[B],P[B+1])
  #define PAF(k) __builtin_bit_cast(bf16x8,pw##k)
  #define VFJ(j) (bf16x8){vlo[(j)%3][0],vlo[(j)%3][1],vlo[(j)%3][2],vlo[(j)%3][3],vhi[(j)%3][0],vhi[(j)%3][1],vhi[(j)%3][2],vhi[(j)%3][3]}
  #define PIN(x) asm volatile("":"+v"(x))
  #define MX3(a,b,c) __builtin_fmaxf(__builtin_fmaxf((a),(b)),(c))
  #define GAPA(MF,A0,A1,A2,A3,W0,W1,PW) do{ MF; sacc+=A0; sacc+=A1; sacc+=A2; sacc+=A3; PIN(sacc); W0; W1; PIN(PW); SBAR(); }while(0)
  #define EX(v) __builtin_amdgcn_exp2f(v)
  #define VJ(j) do{ vlo[(j)%3]=vtr(vp_+(((j)&3)*4096+((j)>>2)*1024)); vhi[(j)%3]=vtr(vp_+(((j)&3)*4096+((j)>>2)*1024+512)); }while(0)
  #define PVJ(j,PA,X,B) do{ if((j)+2<16){ VJ((j)+2); SBAR(); } o[(j)&3]=__builtin_amdgcn_mfma_f32_32x32x16_bf16(PA,VFJ(j),o[(j)&3],0,0,0); X[B]=EX(X[B]-mhat); X[B+1]=EX(X[B+1]-mhat); PIN(X); SBAR(); }while(0)
  #define KRD(G,j) do{ if(G){ kload2(kf,kp0+sl_next,j); SBAR(); } }while(0)
  #define STEP(C0,C1,P0,P1,t,GK,GV,GL) do{ SBAR(); \
    const lds_cptr vp_=vp0+2*sl_prev; \
    float sacc=(P0[0]+P0[1]); \
    GAPA(C0=__builtin_amdgcn_mfma_f32_32x32x16_bf16(kf[0],qr[0],f32x16{},0,0,0), P0[2],P0[3],P0[4],P0[5],     pw0[0]=PKW(P0,0), pw0[1]=PKW(P0,2), pw0); \
    GAPA(C1=__builtin_amdgcn_mfma_f32_32x32x16_bf16(kf[1],qr[0],f32x16{},0,0,0), P0[6],P0[7],P0[8],P0[9],     pw0[2]=PKW(P0,4), pw0[3]=PKW(P0,6), pw0); \
    GAPA(C0=__builtin_amdgcn_mfma_f32_32x32x16_bf16(kf[2],qr[1],C0,0,0,0),   P0[10],P0[11],P0[12],P0[13], pw1[0]=PKW(P0,8), pw1[1]=PKW(P0,10), pw1); \
    GAPA(C1=__builtin_amdgcn_mfma_f32_32x32x16_bf16(kf[3],qr[1],C1,0,0,0),   P0[14],P0[15],P1[0],P1[1],   pw1[2]=PKW(P0,12),pw1[3]=PKW(P0,14), pw1); \
    GAPA(C0=__builtin_amdgcn_mfma_f32_32x32x16_bf16(kf[4],qr[2],C0,0,0,0),   P1[2],P1[3],P1[4],P1[5],     pw2[0]=PKW(P1,0), pw2[1]=PKW(P1,2), pw2); \
    GAPA(C1=__builtin_amdgcn_mfma_f32_32x32x16_bf16(kf[5],qr[2],C1,0,0,0),   P1[6],P1[7],P1[8],P1[9],     pw2[2]=PKW(P1,4), pw2[3]=PKW(P1,6), pw2); \
    GAPA(C0=__builtin_amdgcn_mfma_f32_32x32x16_bf16(kf[6],qr[3],C0,0,0,0),   P1[10],P1[11],P1[12],P1[13], pw3[0]=PKW(P1,8), pw3[1]=PKW(P1,10), pw3); \
    GAPA(C1=__builtin_amdgcn_mfma_f32_32x32x16_bf16(kf[7],qr[3],C1,0,0,0),   P1[14],P1[15],0.f,0.f,       pw3[2]=PKW(P1,12),pw3[3]=PKW(P1,14), pw3); \
    l_reg+=sacc; VJ(0); VJ(1); SBAR(); \
 \
    if(GK){DMA_K((t)+3,sl_cur);} if(GV){DMA_V((t)+1,sl_next);} \
    CMASK(C0,C1,t); \
    { float a=MX3(C0[0],C0[1],C1[0]),b=MX3(C0[2],C0[3],C1[1]); a=MX3(a,C1[2],C1[3]); \
      _Pragma("unroll") for(int r=4;r<16;r+=4){a=MX3(a,C0[r],C0[r+1]);b=MX3(b,C0[r+2],C0[r+3]);a=MX3(a,C1[r],C1[r+1]);b=MX3(b,C1[r+2],C1[r+3]);} \
      float rm=__builtin_fmaxf(a,b); { auto rr=__builtin_amdgcn_permlane32_swap(__float_as_uint(rm),__float_as_uint(rm),false,false); rm=__builtin_fmaxf(__uint_as_float(rr[0]),__uint_as_float(rr[1])); } \
      resc=false; const float rel=rm-mhat; \
      if(__builtin_expect(__any(rel>(float)THRL),0)){ const float dl=__builtin_fmaxf(rel,0.f); mhat+=dl; \
        const float f=__builtin_amdgcn_exp2f(-dl); l_reg*=f; if(hi==0)wsf[r32]=f; resc=true; } } \
    SBAR(); \
    PVJ(0, PAF(0),C0,0);  PVJ(1, PAF(0),C0,2);  PVJ(2, PAF(0),C0,4);  PVJ(3, PAF(0),C0,6); \
    KRD(GL,0); PVJ(4, PAF(1),C0,8);  PVJ(5, PAF(1),C0,10); KRD(GL,1); PVJ(6, PAF(1),C0,12); PVJ(7, PAF(1),C0,14); \
    KRD(GL,2); PVJ(8, PAF(2),C1,0);  PVJ(9, PAF(2),C1,2);  KRD(GL,3); PVJ(10,PAF(2),C1,4);  PVJ(11,PAF(2),C1,6); \
    PVJ(12,PAF(3),C1,8);  PVJ(13,PAF(3),C1,10); PVJ(14,PAF(3),C1,12); PVJ(15,PAF(3),C1,14); \
    }while(0)
  int t=1;
  #undef CMASK
  #define CMASK(P0,P1,t) do{}while(0)
  for(;t+5<NT;t+=2){
    STEP(pB0,pB1,pA0,pA1,t,true,true,true);     WAIT_BAR(3); RESC(); ROT();
    STEP(pA0,pA1,pB0,pB1,t+1,true,true,true);   WAIT_BAR(3); RESC(); ROT();
  }
  #undef CMASK
  int hi_b=hi,qrel_b=qrel; asm volatile("":"+v"(hi_b),"+v"(qrel_b));
  #define CMASK(P0,P1,t) do{int jb_=(t)-(NT-4); if(jb_>=0)cmask(P0,P1,jb_,qrel_b,hi_b);}while(0)
  #define ENDW(tt) do{ if((tt)+3<NT){WAIT_BAR(3);} else if((tt)+2<NT){WAIT_BAR(2);} else {WAIT_BAR(0);} }while(0)
  for(;t+1<NT;t+=2){
    STEP(pB0,pB1,pA0,pA1,t,(t+3<NT),(t+1<NT),(t+1<NT));       ENDW(t);   RESC(); ROT();
    STEP(pA0,pA1,pB0,pB1,t+1,(t+4<NT),(t+2<NT),(t+2<NT));     ENDW(t+1); RESC(); ROT();
  }
  STEP(pB0,pB1,pA0,pA1,NT-1,false,false,false); RESC();
  { float sacc=pB0[0]+pB0[1]; _Pragma("unroll") for(int r=2;r<16;++r)sacc+=pB0[r]; _Pragma("unroll") for(int r=0;r<16;++r)sacc+=pB1[r]; l_reg+=sacc;
    pw0=(u32x4){PKW(pB0,0),PKW(pB0,2),PKW(pB0,4),PKW(pB0,6)};pw1=(u32x4){PKW(pB0,8),PKW(pB0,10),PKW(pB0,12),PKW(pB0,14)};pw2=(u32x4){PKW(pB1,0),PKW(pB1,2),PKW(pB1,4),PKW(pB1,6)};pw3=(u32x4){PKW(pB1,8),PKW(pB1,10),PKW(pB1,12),PKW(pB1,14)};
    SBAR(); pv(o,vb0+2*sl_cur,PAF(0),PAF(1),PAF(2),PAF(3)); }
  #undef PKW
  #undef PAF
  #undef VFJ
  #undef VJ
  #undef PVJ
  #undef PIN
  #undef MX3
  #undef GAPA
  #undef EX
  #undef KRD
  #undef STEP
  #undef ENDW
  int lanee=lane; asm volatile("":"+v"(lanee)); const int r32e=lanee&31,hie=lanee>>5;
  {auto rr=__builtin_amdgcn_permlane32_swap(__float_as_uint(l_reg),__float_as_uint(l_reg),false,false);l_reg=__uint_as_float(rr[0])+__uint_as_float(rr[1]);}
  if(hie==0)wsf[32+r32e]=l_reg;asm volatile("s_waitcnt lgkmcnt(0)":::"memory");
  float rli[16];
  #pragma unroll
  for(int r=0;r<16;++r)rli[r]=__builtin_amdgcn_rcpf(wsf[32+crow(r,hie)]);
  bf16*Ow=Oh+(long)(q0+wid*QBLK)*LDO;
  asm volatile("s_waitcnt lgkmcnt(0)\n\ts_barrier":::"memory");
  { bf16*stg=(bf16*)(shm)+wid*4096;
    #pragma unroll
    for(int r=0;r<16;++r){const int orow=crow(r,hie);
      #pragma unroll
      for(int d0=0;d0<4;++d0)stg[orow*128+d0*32+r32e]=__float2bfloat16(o[d0][r]*rli[r]);}
    asm volatile("s_waitcnt lgkmcnt(0)":::"memory");
    #pragma unroll
    for(int i=0;i<8;++i){const int row=i*4+(lanee>>4),ch=lanee&15; const u32x4 v=*(const u32x4*)(stg+row*128+ch*8); ATTN_STORE16(Ow+(long)row*LDO+ch*8,v);} }
  asm volatile("s_waitcnt lgkmcnt(0)\n\ts_barrier":::"memory");
  #undef DMA_K
  #undef DMA_V
  #undef CMASK
  #undef START
  #undef RESC
  #undef ROT
}
constexpr int ATTN_LDS_BYTES=LDS_BYTES;
template<int THRL=8> __device__ __forceinline__ void attn_phase(char*lds,const bf16*PE,bf16*AO,int vcu,int G){
  const int nu=(G==256)?2:((8*NQB-vcu+G-1)/G);
  #pragma unroll 1
  for(int i=0;i<nu;++i){
    int h2,qb;
    if(G==256){ const int s=vcu&31; h2=vcu>>5; qb=(i==0)?s:63-s; }
    else { const int u=vcu+i*G; h2=u/NQB; qb=u%NQB; }
    attn_unit<THRL>(qb,PE+h2*64,PE+512+h2*64,PE+1024+(h2>>1)*128,AO+h2*128,lds);
  }
}
#undef SBAR
#undef WAIT_BAR
}

#define GAS __attribute__((address_space(1)))
#define LAS __attribute__((address_space(3)))
typedef unsigned short bf16;
typedef unsigned v4u __attribute__((ext_vector_type(4)));
typedef float f32x4 __attribute__((ext_vector_type(4)));
typedef short bf16x8 __attribute__((ext_vector_type(8)));
typedef GAS unsigned gu32;
typedef GAS unsigned long long gu64;
#define RLX_AGENT __ATOMIC_RELAXED, __HIP_MEMORY_SCOPE_AGENT
#define LDS_WAIT() asm volatile("s_waitcnt lgkmcnt(0)" ::: "memory")
#define VM_WAIT() asm volatile("s_waitcnt vmcnt(0)" ::: "memory")
__device__ __forceinline__ unsigned long long rt() { return __builtin_amdgcn_s_memrealtime(); }
__device__ __forceinline__ unsigned f2bf(float f) { unsigned u = __builtin_bit_cast(unsigned, f); return (u + 0x7fffu + ((u >> 16) & 1u)) >> 16; }
__device__ __forceinline__ unsigned pk2(float lo, float hi) { return f2bf(lo) | (f2bf(hi) << 16); }

#define XB_TMO      128
#define XB_XCNT(j)  (256  + 64 * (j))
#define XB_XSUB(j)  (1280 + 64 * (j))
#define XB_XGEN(j)  (2304 + 64 * (j))
#define XB_TOP      3328
#define XB_TOPGEN   3392
#define XCD_BAR_WORDS 3456
#define XB_SPIN_CAP (1u << 18)

__device__ __forceinline__ unsigned xb_ld(unsigned* p)              { return __hip_atomic_load(p, __ATOMIC_RELAXED, __HIP_MEMORY_SCOPE_AGENT); }
__device__ __forceinline__ unsigned xb_add(unsigned* p, unsigned v) { return __hip_atomic_fetch_add(p, v, __ATOMIC_RELAXED, __HIP_MEMORY_SCOPE_AGENT); }
__device__ __forceinline__ unsigned xb_xcc_id() { return (unsigned)__builtin_amdgcn_s_getreg((3 << 11) | 20) & 0xFu; }
#define XB_SPIN(cond, bar) do { unsigned _sp = 0; while (cond) { __builtin_amdgcn_s_sleep(1); \
    if ((++_sp & 255u) == 0u) { if (xb_ld(&(bar)[XB_TMO])) break; if (_sp > XB_SPIN_CAP) { atomicAdd(&(bar)[XB_TMO], 1u); break; } } } } while (0)

struct XcdBarrier {
    unsigned* bar; unsigned x;
    volatile LAS unsigned* st;
};

__device__ __forceinline__ XcdBarrier xcd_barrier_post(unsigned* bar, volatile LAS unsigned* st) {
    XcdBarrier b; b.bar = bar; b.x = xb_xcc_id(); b.st = st;
    if (threadIdx.x == 0) (void)xb_add(&bar[XB_XCNT(b.x)], 1u);
    return b;
}
__device__ __forceinline__ void xcd_barrier_complete(unsigned* bar, unsigned x, unsigned& nloc, unsigned& nx) {
    const unsigned G = gridDim.x * gridDim.y * gridDim.z;
    unsigned sum, cnt, mine, sp = 0u;
    for (;;) {
        sum = 0u; cnt = 0u; mine = 0u;
#pragma unroll
        for (unsigned j = 0; j < 16; ++j) { const unsigned c = xb_ld(&bar[XB_XCNT(j)]); sum += c; cnt += (c > 0u) ? 1u : 0u; mine = (j == x) ? c : mine; }
        if (sum == G) break;
        __builtin_amdgcn_s_sleep(1);
        if ((++sp & 255u) == 0u) { if (xb_ld(&bar[XB_TMO])) break; if (sp > XB_SPIN_CAP) { atomicAdd(&bar[XB_TMO], 1u); break; } }
    }
    nloc = mine > 0u ? mine : 1u; nx = cnt > 0u ? cnt : 1u;
}

__device__ __forceinline__ void xcd_barrier(const XcdBarrier& b) {
    asm volatile("s_waitcnt vmcnt(0)" ::: "memory");
    __syncthreads();
    if (threadIdx.x == 0) {
        unsigned* bar = b.bar;
        __builtin_amdgcn_s_waitcnt(0);
        unsigned nloc = b.st[0], nx = b.st[1];
        if (nloc == 0u) { xcd_barrier_complete(bar, b.x, nloc, nx); b.st[0] = nloc; b.st[1] = nx; }
        const unsigned old = xb_add(&bar[XB_XSUB(b.x)], 1u);
        const unsigned gen = old / nloc;
        if (old + 1u == (gen + 1u) * nloc) {
            __builtin_amdgcn_fence(__ATOMIC_RELEASE, "agent");
            asm volatile("s_waitcnt vmcnt(0)" ::: "memory");
            const unsigned og = xb_add(&bar[XB_TOP], 1u);
            const unsigned tg = og / nx;
            if (og + 1u == (tg + 1u) * nx) xb_add(&bar[XB_TOPGEN], 1u);
            else XB_SPIN(xb_ld(&bar[XB_TOPGEN]) == tg, bar);
            __builtin_amdgcn_fence(__ATOMIC_ACQUIRE, "agent");
            xb_add(&bar[XB_XGEN(b.x)], 1u);
            asm volatile("s_waitcnt vmcnt(0)" ::: "memory");
        } else {
            XB_SPIN(xb_ld(&bar[XB_XGEN(b.x)]) == gen, bar);
            __builtin_amdgcn_fence(__ATOMIC_ACQUIRE, "agent");
            asm volatile("s_waitcnt vmcnt(0)" ::: "memory");
        }
    }
    __syncthreads();
}

constexpr int NWAVES = 8;
constexpr size_t MiB = 1u << 20;
constexpr size_t WS_CTL = 0, CTL_ZERO_BYTES = 1 * MiB;
constexpr size_t WS_TAB = 1 * MiB;
constexpr size_t WS_SSQA = 2 * MiB, WS_SSQB = 3 * MiB;
constexpr size_t WS_GB = 4 * MiB;
constexpr size_t WS_GC = 512 * 1024;
constexpr size_t WS_TOK = 5 * MiB;
constexpr size_t WS_W = 6 * MiB;
constexpr size_t WS_WINE = WS_W, WS_WOUTE = WS_W + 12 * MiB, WS_W13D = WS_W + 16 * MiB, WS_W2D = WS_W + 44 * MiB, WS_WINO = WS_W + 58 * MiB  , WS_WOUTO = WS_W + 76 * MiB,
                 WS_WG = WS_W + 80 * MiB, WS_WP = WS_W + 88 * MiB, WS_W13M = WS_W + 90 * MiB, WS_W2M = WS_W + 202 * MiB;
static_assert(WS_W2M + 56 * MiB <= 264 * MiB, "weight copies end below the p copy");
constexpr size_t WS_PBF = 264 * MiB, WS_HBF = 296 * MiB, WS_PP = 328 * MiB, WS_MIX = 360 * MiB, WS_ARENA = 392 * MiB;
constexpr size_t AR_PE = 0, AR_AO = 96 * MiB;
constexpr size_t AR_PO = 0  , AR_QN = 144 * MiB, AR_KN = 176 * MiB, AR_KGT = 208 * MiB, AR_VBT = 240 * MiB, AR_KTT = 272 * MiB, AR_AI = 304 * MiB, AR_NEGW = 320 * MiB, AR_UT = 352 * MiB,
                 AR_SG = 384 * MiB  , AR_MPC = 448 * MiB  , AR_NTC = 464 * MiB, AR_END = 480 * MiB;
constexpr size_t AR_ACT = 0, AR_XS = 240 * MiB, AR_Y = 308 * MiB;
constexpr size_t WS_NEED = WS_ARENA + AR_END;
constexpr size_t TOK_E = 0, TOK_R = 128 * 1024, TOK_G = 256 * 1024, TOK_DST = 384 * 1024, TOK_GPAD = 512 * 1024, TOK_DN = 704 * 1024, TOK_DNC = 720 * 1024;
constexpr int CW_TMO = 0, CW_BAR = 4096, CW_CNT = 8192  , CW_DBG = 12288;

constexpr int RING_OFF = 0, WAVE_LDS = 17408;
constexpr int LDSCTL_OFF = 139264, MISC_OFF = LDSCTL_OFF + 64, BLKE_OFF = LDSCTL_OFF + 256  , RT_OFF = LDSCTL_OFF + 1024  ;
constexpr int LDS_BYTES = 147456;

typedef unsigned u32x2v __attribute__((ext_vector_type(2)));
__device__ __forceinline__ float bflo(unsigned w) { return __uint_as_float(w << 16); }
__device__ __forceinline__ float bfhi(unsigned w) { return __uint_as_float(w & 0xffff0000u); }
__device__ __forceinline__ unsigned cvtpk(float lo, float hi) { return pg8::cvt_pk_bf16_cv(lo, hi); }
__device__ __forceinline__ float wave_sum(float v) {
#pragma unroll
    for (int o = 1; o < 64; o <<= 1) v += __shfl_xor(v, o);
    return v;
}
__device__ __forceinline__ float sigm(float x) { return pg8::sigmoidf_(x); }
__device__ __forceinline__ float silu(float x) { return x * pg8::sigmoidf_(x); }

struct Args { const void* in[30]; float* out; unsigned char* ws; int ph_lo, ph_hi, use_bar, pad; };

struct Frame {
    LAS unsigned char* lds; int tid, lane, wave, vcu, G, gw, NGW;
};

__device__ __forceinline__ void xpose_item(const float* W, int ldw, int K, int N, const float* gain, bf16* WT, int ilv, LAS float* scr, int item, int lane) {
    const int nblk = N / 64, kb = item / nblk, nb = item % nblk, k0 = 64 * kb, n0 = 64 * nb;
    const int lr = lane >> 4, lc = (lane & 15) * 4;
    f32x4 v[16];
#pragma unroll
    for (int i = 0; i < 16; ++i) v[i] = *(const GAS f32x4*)(W + (size_t)(k0 + 4 * i + lr) * ldw + n0 + lc);
    if (gain) {
#pragma unroll
        for (int i = 0; i < 16; ++i) v[i] = v[i] * gain[k0 + 4 * i + lr]; }
#pragma unroll
    for (int i = 0; i < 16; ++i) { LAS float* s = scr + (4 * i + lr) * 65 + lc; s[0] = v[i][0]; s[1] = v[i][1]; s[2] = v[i][2]; s[3] = v[i][3]; }
    LDS_WAIT(); asm volatile("" ::: "memory");
    const int c = lane & 7;
#pragma unroll
    for (int j = 0; j < 8; ++j) { const int nl = (lane >> 3) + 8 * j, n = n0 + nl; const LAS float* s = scr + (8 * c) * 65 + nl;
        const int dr = ilv ? (((n >> 7) << 8) + (n & 127) + (ilv == 2 ? 128 : 0)) : n;
        v4u o; o.x = pk2(s[0 * 65], s[1 * 65]); o.y = pk2(s[2 * 65], s[3 * 65]); o.z = pk2(s[4 * 65], s[5 * 65]); o.w = pk2(s[6 * 65], s[7 * 65]);
        *(GAS v4u*)(WT + (size_t)dr * K + k0 + 8 * c) = o; }
    LDS_WAIT(); asm volatile("" ::: "memory");
}
struct MatD { const float* W; int ldw, K, N; const float* gain; bf16* WT; int ilv; int items; };
__device__ __forceinline__ MatD dense_mat(const Args& a, int id) {
    unsigned char* ws = a.ws; MatD m; m.gain = nullptr; m.ilv = 0;
    if (id < 2)       { const int j = id;      m.W = (const float*)a.in[7] + (size_t)j * D_ * EIN;    m.ldw = EIN; m.K = D_; m.N = EIN; m.gain = (const float*)a.in[3] + (2 * j) * D_; m.WT = (bf16*)(ws + WS_WINE) + (size_t)j * EIN * D_; }
    else if (id < 4)  { const int j = id - 2;  m.W = (const float*)a.in[8] + (size_t)j * D_ * D_;     m.ldw = D_; m.K = D_; m.N = D_; m.WT = (bf16*)(ws + WS_WOUTE) + (size_t)j * D_ * D_; }
    else if (id < 6)  { const int j = id - 4;  m.W = (const float*)a.in[21] + (size_t)j * D_ * DFF;   m.ldw = DFF; m.K = D_; m.N = DFF; m.gain = (const float*)a.in[4] + (2 * j) * D_; m.WT = (bf16*)(ws + WS_W13D) + (size_t)j * 2 * DFF * D_; m.ilv = 1; }
    else if (id < 8)  { const int j = id - 6;  m.W = (const float*)a.in[22] + (size_t)j * D_ * DFF;   m.ldw = DFF; m.K = D_; m.N = DFF; m.gain = (const float*)a.in[4] + (2 * j) * D_; m.WT = (bf16*)(ws + WS_W13D) + (size_t)j * 2 * DFF * D_; m.ilv = 2; }
    else if (id < 10) { const int j = id - 8;  m.W = (const float*)a.in[23] + (size_t)j * DFF * D_;   m.ldw = D_; m.K = DFF; m.N = D_; m.WT = (bf16*)(ws + WS_W2D) + (size_t)j * D_ * DFF; }
    else if (id < 12) { const int j = id - 10; m.W = (const float*)a.in[15] + (size_t)j * D_ * OIN_SRC; m.ldw = OIN_SRC; m.K = D_; m.N = OIN_W; m.gain = (const float*)a.in[3] + (2 * j + 1) * D_; m.WT = (bf16*)(ws + WS_WINO) + (size_t)j * OIN * D_; }
    else if (id < 14) { const int j = id - 12; m.W = (const float*)a.in[20] + (size_t)j * D_ * D_;    m.ldw = D_; m.K = D_; m.N = D_; m.WT = (bf16*)(ws + WS_WOUTO) + (size_t)j * D_ * D_; }
    else if (id < 18) { const int i = id - 14; m.W = (const float*)a.in[28] + (size_t)i * D_ * D_;    m.ldw = D_; m.K = D_; m.N = D_; m.gain = (const float*)a.in[5] + i * D_; m.WT = (bf16*)(ws + WS_WG) + (size_t)i * D_ * D_; }
    else              { const int i = id - 18; m.W = (const float*)a.in[29] + (size_t)i * PLE * D_;   m.ldw = D_; m.K = PLE; m.N = D_; m.WT = (bf16*)(ws + WS_WP) + (size_t)i * D_ * PLE; }
    m.items = (m.K / 64) * (m.N / 64); return m;
}
__device__ __forceinline__ MatD moe_mat(const Args& a, int j, int id) {
    unsigned char* ws = a.ws; MatD m; m.gain = nullptr; m.ilv = 0; const int e = id / 3, k = id % 3;
    if (k < 2) { m.W = (const float*)a.in[25 + k] + ((size_t)j * NEXP + e) * D_ * DFF; m.ldw = DFF; m.K = D_; m.N = DFF; m.gain = (const float*)a.in[4] + (2 * j + 1) * D_; m.WT = (bf16*)(ws + WS_W13M) + (size_t)e * 2 * DFF * D_; m.ilv = 1 + k; }
    else       { m.W = (const float*)a.in[27] + ((size_t)j * NEXP + e) * DFF * D_; m.ldw = D_; m.K = DFF; m.N = D_; m.WT = (bf16*)(ws + WS_W2M) + (size_t)e * D_ * DFF; }
    m.items = (m.K / 64) * (m.N / 64); return m;
}

__device__ __forceinline__ void p_prologue(const Frame& F, const Args& a) {
    LAS float* scr = (LAS float*)(F.lds + F.wave * WAVE_LDS);
    unsigned char* ws = a.ws;
    {
        int base = 0;
#pragma unroll 1
        for (int id = 0; id < 22; ++id) { const MatD m = dense_mat(a, id);
            int first = (F.gw - base) % F.NGW; if (first < 0) first += F.NGW;
#pragma unroll 1
            for (int it = first; it < m.items; it += F.NGW) xpose_item(m.W, m.ldw, m.K, m.N, m.gain, m.WT, m.ilv, scr, it, F.lane);
            base += m.items; }
    }
    for (int idx = F.gw * 64 + F.lane; idx < 2 * 256 * (D_ / 8); idx += F.NGW * 64) { const int j = idx / (256 * (D_ / 8)), r = (idx / (D_ / 8)) % 256, k0 = (idx % (D_ / 8)) * 8;
        const float* W = (const float*)a.in[15] + (size_t)j * D_ * OIN_SRC; const float* ln = (const float*)a.in[3] + (2 * j + 1) * D_; float v[8];
#pragma unroll
        for (int e = 0; e < 8; ++e) v[e] = (r < 16) ? ln[k0 + e] * W[(size_t)(k0 + e) * OIN_SRC + OIN_W + r] : 0.f;
        v4u o; o.x = cvtpk(v[0], v[1]); o.y = cvtpk(v[2], v[3]); o.z = cvtpk(v[4], v[5]); o.w = cvtpk(v[6], v[7]);
        *(GAS v4u*)((bf16*)(ws + WS_WINO) + ((size_t)j * OIN + OIN_W + r) * D_ + k0) = o; }
    { const float* p = (const float*)a.in[1]; bf16* pb = (bf16*)(ws + WS_PBF); const size_t n8 = (size_t)DEPTH_ * S_ * PLE / 8;
#pragma unroll 1
      for (size_t i = (size_t)F.gw * 64 + F.lane; i < n8; i += (size_t)F.NGW * 64) { const f32x4 x0 = *(const GAS f32x4*)(p + i * 8), x1 = *(const GAS f32x4*)(p + i * 8 + 4);
          v4u o; o.x = cvtpk(x0[0], x0[1]); o.y = cvtpk(x0[2], x0[3]); o.z = cvtpk(x1[0], x1[1]); o.w = cvtpk(x1[2], x1[3]); *(GAS v4u*)(pb + i * 8) = o; } }
#ifdef PROBE_PRO_NOC
    if (a.use_bar)
#endif
    { const float* x = (const float*)a.in[0]; bf16* hb = (bf16*)(ws + WS_HBF); float* ssq = (float*)(ws + WS_SSQB);
#pragma unroll 1
      for (int m = F.gw; m < S_; m += F.NGW) { const GAS f32x4* xr = (const GAS f32x4*)(x + (size_t)m * D_) + F.lane; float s = 0.f;
#pragma unroll
          for (int j = 0; j < 4; ++j) { const f32x4 v = xr[64 * j]; s += (v[0] * v[0] + v[1] * v[1]) + (v[2] * v[2] + v[3] * v[3]);
              u32x2v o; o.x = cvtpk(v[0], v[1]); o.y = cvtpk(v[2], v[3]); *((GAS u32x2v*)(hb + (size_t)m * D_) + F.lane + 64 * j) = o; }
          s = wave_sum(s);
          if (F.lane < 16) ssq[(size_t)m * 16 + F.lane] = (F.lane == 0) ? s : 0.f; } }
    { const int* pos = (const int*)a.in[2]; float* tab = (float*)(ws + WS_TAB);
#pragma unroll 1
      for (int idx = F.gw * 64 + F.lane; idx < S_ * 8; idx += F.NGW * 64) { const int row = idx >> 3, i = idx & 7;
          const float inv = exp2f(-(float)i * (18.931568569324174f / 8.0f));
          const float ang = (float)pos[row] * inv;
          double t = (double)ang * 0.15915494309189535; t -= rint(t); const float tf = (float)t;
          tab[(size_t)row * 16 + i] = __builtin_amdgcn_cosf(tf); tab[(size_t)row * 16 + 8 + i] = __builtin_amdgcn_sinf(tf); } }
}

__device__ __forceinline__ void p_mixprep(const Frame& F, const Args& a, int L) {
    GAS unsigned char* ws = (GAS unsigned char*)a.ws; asm volatile("" : "+s"(ws)); int lane_ = F.lane; asm volatile("" : "+v"(lane_)); const int j = L >> 1, lane = lane_;
    const bf16* AO = (const bf16*)(ws + WS_ARENA + AR_AO); const bf16* PE = (const bf16*)(ws + WS_ARENA + AR_PE); bf16* mix = (bf16*)(ws + WS_MIX);
    const float lam0 = 0.8f - 0.6f * expf(-0.3f * (float)L);
    float s1 = ((const float*)a.in[9])[j * 64 + lane] * ((const float*)a.in[10])[j * 64 + lane], s2 = ((const float*)a.in[11])[j * 64 + lane] * ((const float*)a.in[12])[j * 64 + lane];
    s1 = wave_sum(s1); s2 = wave_sum(s2);
    const float lam = expf(s1) - expf(s2) + lam0, post = 1.0f - lam0;
    const int hh = lane >> 4, dd = (lane & 15) * 8, ch = lane * 8;
    float sg[8], w0[8], w1[8], w2[8];
#pragma unroll
    for (int e = 0; e < 8; ++e) { sg[e] = ((const float*)a.in[13])[j * 128 + dd + e] * post;
        w0[e] = ((const float*)a.in[14])[(j * 3 + 0) * 512 + ch + e]; w1[e] = ((const float*)a.in[14])[(j * 3 + 1) * 512 + ch + e]; w2[e] = ((const float*)a.in[14])[(j * 3 + 2) * 512 + ch + e]; }
#pragma unroll 1
    for (int t = F.gw; t < S_; t += F.NGW) {
        const v4u o1 = *(const GAS v4u*)(AO + (size_t)t * D_ + 256 * hh + dd), o2 = *(const GAS v4u*)(AO + (size_t)t * D_ + 256 * hh + 128 + dd);
        float d[8]; const unsigned a1[4] = {o1.x, o1.y, o1.z, o1.w}, a2[4] = {o2.x, o2.y, o2.z, o2.w}; float ss = 0.f;
#pragma unroll
        for (int q = 0; q < 4; ++q) { d[2 * q] = bflo(a1[q]) - lam * bflo(a2[q]); d[2 * q + 1] = bfhi(a1[q]) - lam * bfhi(a2[q]); ss += d[2 * q] * d[2 * q] + d[2 * q + 1] * d[2 * q + 1]; }
        ss += __shfl_xor(ss, 1); ss += __shfl_xor(ss, 2); ss += __shfl_xor(ss, 4); ss += __shfl_xor(ss, 8);
        const float rms = __builtin_amdgcn_rsqf(ss * (1.0f / 128.0f) + 1e-5f);
        v4u o; o.x = cvtpk(d[0] * rms * sg[0], d[1] * rms * sg[1]); o.y = cvtpk(d[2] * rms * sg[2], d[3] * rms * sg[3]); o.z = cvtpk(d[4] * rms * sg[4], d[5] * rms * sg[5]); o.w = cvtpk(d[6] * rms * sg[6], d[7] * rms * sg[7]);
        *(GAS v4u*)(mix + (size_t)t * D_ + hh * 128 + dd) = o;
        const bf16* r0 = PE + (size_t)t * EIN;
        const v4u bb = *(const GAS v4u*)(r0 + 1536 + ch), c0 = *(const GAS v4u*)(r0 + 2048 + ch), x0 = *(const GAS v4u*)(r0 + 2560 + ch);
        v4u c1 = {0u, 0u, 0u, 0u}, x1 = c1, c2 = c1, x2 = c1;
        if (t >= 1) { c1 = *(const GAS v4u*)(r0 - EIN + 2048 + ch); x1 = *(const GAS v4u*)(r0 - EIN + 2560 + ch); }
        if (t >= 2) { c2 = *(const GAS v4u*)(r0 - 2 * EIN + 2048 + ch); x2 = *(const GAS v4u*)(r0 - 2 * EIN + 2560 + ch); }
        const unsigned B[4] = {bb.x, bb.y, bb.z, bb.w}, C0[4] = {c0.x, c0.y, c0.z, c0.w}, X0[4] = {x0.x, x0.y, x0.z, x0.w}, C1[4] = {c1.x, c1.y, c1.z, c1.w}, X1[4] = {x1.x, x1.y, x1.z, x1.w},
                       C2[4] = {c2.x, c2.y, c2.z, c2.w}, X2[4] = {x2.x, x2.y, x2.z, x2.w};
        float sc[8];
#pragma unroll
        for (int q = 0; q < 4; ++q) {
            sc[2 * q] = bflo(B[q]) * (w2[2 * q] * (bflo(C0[q]) * bflo(X0[q])) + w1[2 * q] * (bflo(C1[q]) * bflo(X1[q])) + w0[2 * q] * (bflo(C2[q]) * bflo(X2[q])));
            sc[2 * q + 1] = bfhi(B[q]) * (w2[2 * q + 1] * (bfhi(C0[q]) * bfhi(X0[q])) + w1[2 * q + 1] * (bfhi(C1[q]) * bfhi(X1[q])) + w0[2 * q + 1] * (bfhi(C2[q]) * bfhi(X2[q]))); }
        v4u so; so.x = cvtpk(sc[0], sc[1]); so.y = cvtpk(sc[2], sc[3]); so.z = cvtpk(sc[4], sc[5]); so.w = cvtpk(sc[6], sc[7]);
        *(GAS v4u*)(mix + (size_t)t * D_ + 512 + ch) = so;
    }
}


__device__ __forceinline__ void p_rot(const Frame& F, const Args& a) {
    GAS unsigned char* ws = (GAS unsigned char*)a.ws; asm volatile("" : "+s"(ws)); int lane_ = F.lane; asm volatile("" : "+v"(lane_)); const int lane = lane_;
    bf16* PE = (bf16*)(ws + WS_ARENA + AR_PE); const float* tab = (const float*)(ws + WS_TAB);
    const int hd = lane >> 2, i0 = 2 * (lane & 3), col = (hd < 8 ? hd * 64 : 512 + (hd - 8) * 64) + i0;
#pragma unroll 1
    for (int t = F.gw; t < S_; t += F.NGW) {
        GAS unsigned* p1 = (GAS unsigned*)(PE + (size_t)t * EIN + col); GAS unsigned* p2 = (GAS unsigned*)(PE + (size_t)t * EIN + col + 8);
        const unsigned w1 = *p1, w2 = *p2;
        const float c0 = tab[(size_t)t * 16 + i0], c1 = tab[(size_t)t * 16 + i0 + 1], s0 = tab[(size_t)t * 16 + 8 + i0], s1 = tab[(size_t)t * 16 + 8 + i0 + 1];
        const float a0 = bflo(w1), a1 = bfhi(w1), b0 = bflo(w2), b1 = bfhi(w2);
        *p1 = cvtpk(a0 * c0 - b0 * s0, a1 * c1 - b1 * s1); *p2 = cvtpk(b0 * c0 + a0 * s0, b1 * c1 + a1 * s1);
    }
}
__device__ __forceinline__ void tri_solve(const LAS float* Lc, LAS bf16* Xs, int lane) {
    float x0, x1, x2, x3, x4, x5, x6, x7, x8, x9, x10, x11, x12, x13, x14, x15, x16, x17, x18, x19, x20, x21, x22, x23, x24, x25, x26, x27, x28, x29, x30, x31, x32, x33, x34, x35, x36, x37, x38, x39, x40, x41, x42, x43, x44, x45, x46, x47, x48, x49, x50, x51, x52, x53, x54, x55, x56, x57, x58, x59, x60, x61, x62, x63;
    { x63 = (lane == 63) ? 1.0f : 0.0f; asm volatile("" : "+v"(x63) : : "memory"); }
    { float s0 = 0.f, s1 = 0.f, s2 = 0.f, s3 = 0.f; { const f32x4 l = *(const LAS f32x4*)(Lc + 4276); s3 = fmaf(x63, l[3], s3); } x62 = (lane == 62) ? 1.0f : -((s0 + s1) + (s2 + s3)); asm volatile("" : "+v"(x62) : : "memory"); }
    { float s0 = 0.f, s1 = 0.f, s2 = 0.f, s3 = 0.f; { const f32x4 l = *(const LAS f32x4*)(Lc + 4208); s2 = fmaf(x62, l[2], s2); s3 = fmaf(x63, l[3], s3); } x61 = (lane == 61) ? 1.0f : -((s0 + s1) + (s2 + s3)); asm volatile("" : "+v"(x61) : : "memory"); }
    { float s0 = 0.f, s1 = 0.f, s2 = 0.f, s3 = 0.f; { const f32x4 l = *(const LAS f32x4*)(Lc + 4140); s1 = fmaf(x61, l[1], s1); s2 = fmaf(x62, l[2], s2); s3 = fmaf(x63, l[3], s3); } x60 = (lane == 60) ? 1.0f : -((s0 + s1) + (s2 + s3)); asm volatile("" : "+v"(x60) : : "memory"); }
    { float s0 = 0.f, s1 = 0.f, s2 = 0.f, s3 = 0.f; { const f32x4 l = *(const LAS f32x4*)(Lc + 4072); s0 = fmaf(x60, l[0], s0); s1 = fmaf(x61, l[1], s1); s2 = fmaf(x62, l[2], s2); s3 = fmaf(x63, l[3], s3); } x59 = (lane == 59) ? 1.0f : -((s0 + s1) + (s2 + s3)); asm volatile("" : "+v"(x59) : : "memory"); }
    { float s0 = 0.f, s1 = 0.f, s2 = 0.f, s3 = 0.f; { const f32x4 l = *(const LAS f32x4*)(Lc + 4000); s3 = fmaf(x59, l[3], s3); } { const f32x4 l = *(const LAS f32x4*)(Lc + 4004); s0 = fmaf(x60, l[0], s0); s1 = fmaf(x61, l[1], s1); s2 = fmaf(x62, l[2], s2); s3 = fmaf(x63, l[3], s3); } x58 = (lane == 58) ? 1.0f : -((s0 + s1) + (s2 + s3)); asm volatile("" : "+v"(x58) : : "memory"); }
    { float s0 = 0.f, s1 = 0.f, s2 = 0.f, s3 = 0.f; { const f32x4 l = *(const LAS f32x4*)(Lc + 3932); s2 = fmaf(x58, l[2], s2); s3 = fmaf(x59, l[3], s3); } { const f32x4 l = *(const LAS f32x4*)(Lc + 3936); s0 = fmaf(x60, l[0], s0); s1 = fmaf(x61, l[1], s1); s2 = fmaf(x62, l[2], s2); s3 = fmaf(x63, l[3], s3); } x57 = (lane == 57) ? 1.0f : -((s0 + s1) + (s2 + s3)); asm volatile("" : "+v"(x57) : : "memory"); }
    { float s0 = 0.f, s1 = 0.f, s2 = 0.f, s3 = 0.f; { const f32x4 l = *(const LAS f32x4*)(Lc + 3864); s1 = fmaf(x57, l[1], s1); s2 = fmaf(x58, l[2], s2); s3 = fmaf(x59, l[3], s3); } { const f32x4 l = *(const LAS f32x4*)(Lc + 3868); s0 = fmaf(x60, l[0], s0); s1 = fmaf(x61, l[1], s1); s2 = fmaf(x62, l[2], s2); s3 = fmaf(x63, l[3], s3); } x56 = (lane == 56) ? 1.0f : -((s0 + s1) + (s2 + s3)); asm volatile("" : "+v"(x56) : : "memory"); }
    { float s0 = 0.f, s1 = 0.f, s2 = 0.f, s3 = 0.f; { const f32x4 l = *(const LAS f32x4*)(Lc + 3796); s0 = fmaf(x56, l[0], s0); s1 = fmaf(x57, l[1], s1); s2 = fmaf(x58, l[2], s2); s3 = fmaf(x59, l[3], s3); } { const f32x4 l = *(const LAS f32x4*)(Lc + 3800); s0 = fmaf(x60, l[0], s0); s1 = fmaf(x61, l[1], s1); s2 = fmaf(x62, l[2], s2); s3 = fmaf(x63, l[3], s3); } x55 = (lane == 55) ? 1.0f : -((s0 + s1) + (s2 + s3)); asm volatile("" : "+v"(x55) : : "memory"); }
    { float s0 = 0.f, s1 = 0.f, s2 = 0.f, s3 = 0.f; { const f32x4 l = *(const LAS f32x4*)(Lc + 3724); s3 = fmaf(x55, l[3], s3); } { const f32x4 l = *(const LAS f32x4*)(Lc + 3728); s0 = fmaf(x56, l[0], s0); s1 = fmaf(x57, l[1], s1); s2 = fmaf(x58, l[2], s2); s3 = fmaf(x59, l[3], s3); } { const f32x4 l = *(const LAS f32x4*)(Lc + 3732); s0 = fmaf(x60, l[0], s0); s1 = fmaf(x61, l[1], s1); s2 = fmaf(x62, l[2], s2); s3 = fmaf(x63, l[3], s3); } x54 = (lane == 54) ? 1.0f : -((s0 + s1) + (s2 + s3)); asm volatile("" : "+v"(x54) : : "memory"); }
    { float s0 = 0.f, s1 = 0.f, s2 = 0.f, s3 = 0.f; { const f32x4 l = *(const LAS f32x4*)(Lc + 3656); s2 = fmaf(x54, l[2], s2); s3 = fmaf(x55, l[3], s3); } { const f32x4 l = *(const LAS f32x4*)(Lc + 3660); s0 = fmaf(x56, l[0], s0); s1 = fmaf(x57, l[1], s1); s2 = fmaf(x58, l[2], s2); s3 = fmaf(x59, l[3], s3); } { const f32x4 l = *(const LAS f32x4*)(Lc + 3664); s0 = fmaf(x60, l[0], s0); s1 = fmaf(x61, l[1], s1); s2 = fmaf(x62, l[2], s2); s3 = fmaf(x63, l[3], s3); } x53 = (lane == 53) ? 1.0f : -((s0 + s1) + (s2 + s3)); asm volatile("" : "+v"(x53) : : "memory"); }
    { float s0 = 0.f, s1 = 0.f, s2 = 0.f, s3 = 0.f; { const f32x4 l = *(const LAS f32x4*)(Lc + 3588); s1 = fmaf(x53, l[1], s1); s2 = fmaf(x54, l[2], s2); s3 = fmaf(x55, l[3], s3); } { const f32x4 l = *(const LAS f32x4*)(Lc + 3592); s0 = fmaf(x56, l[0], s0); s1 = fmaf(x57, l[1], s1); s2 = fmaf(x58, l[2], s2); s3 = fmaf(x59, l[3], s3); } { const f32x4 l = *(const LAS f32x4*)(Lc + 3596); s0 = fmaf(x60, l[0], s0); s1 = fmaf(x61, l[1], s1); s2 = fmaf(x62, l[2], s2); s3 = fmaf(x63, l[3], s3); } x52 = (lane == 52) ? 1.0f : -((s0 + s1) + (s2 + s3)); asm volatile("" : "+v"(x52) : : "memory"); }
    { float s0 = 0.f, s1 = 0.f, s2 = 0.f, s3 = 0.f; { const f32x4 l = *(const LAS f32x4*)(Lc + 3520); s0 = fmaf(x52, l[0], s0); s1 = fmaf(x53, l[1], s1); s2 = fmaf(x54, l[2], s2); s3 = fmaf(x55, l[3], s3); } { const f32x4 l = *(const LAS f32x4*)(Lc + 3524); s0 = fmaf(x56, l[0], s0); s1 = fmaf(x57, l[1], s1); s2 = fmaf(x58, l[2], s2); s3 = fmaf(x59, l[3], s3); } { const f32x4 l = *(const LAS f32x4*)(Lc + 3528); s0 = fmaf(x60, l[0], s0); s1 = fmaf(x61, l[1], s1); s2 = fmaf(x62, l[2], s2); s3 = fmaf(x63, l[3], s3); } x51 = (lane == 51) ? 1.0f : -((s0 + s1) + (s2 + s3)); asm volatile("" : "+v"(x51) : : "memory"); }
    { float s0 = 0.f, s1 = 0.f, s2 = 0.f, s3 = 0.f; { const f32x4 l = *(const LAS f32x4*)(Lc + 3448); s3 = fmaf(x51, l[3], s3); } { const f32x4 l = *(const LAS f32x4*)(Lc + 3452); s0 = fmaf(x52, l[0], s0); s1 = fmaf(x53, l[1], s1); s2 = fmaf(x54, l[2], s2); s3 = fmaf(x55, l[3], s3); } { const f32x4 l = *(const LAS f32x4*)(Lc + 3456); s0 = fmaf(x56, l[0], s0); s1 = fmaf(x57, l[1], s1); s2 = fmaf(x58, l[2], s2); s3 = fmaf(x59, l[3], s3); } { const f32x4 l = *(const LAS f32x4*)(Lc + 3460); s0 = fmaf(x60, l[0], s0); s1 = fmaf(x61, l[1], s1); s2 = fmaf(x62, l[2], s2); s3 = fmaf(x63, l[3], s3); } x50 = (lane == 50) ? 1.0f : -((s0 + s1) + (s2 + s3)); asm volatile("" : "+v"(x50) : : "memory"); }
    { float s0 = 0.f, s1 = 0.f, s2 = 0.f, s3 = 0.f; { const f32x4 l = *(const LAS f32x4*)(Lc + 3380); s2 = fmaf(x50, l[2], s2); s3 = fmaf(x51, l[3], s3); } { const f32x4 l = *(const LAS f32x4*)(Lc + 3384); s0 = fmaf(x52, l[0], s0); s1 = fmaf(x53, l[1], s1); s2 = fmaf(x54, l[2], s2); s3 = fmaf(x55, l[3], s3); } { const f32x4 l = *(const LAS f32x4*)(Lc + 3388); s0 = fmaf(x56, l[0], s0); s1 = fmaf(x57, l[1], s1); s2 = fmaf(x58, l[2], s2); s3 = fmaf(x59, l[3], s3); } { const f32x4 l = *(const LAS f32x4*)(Lc + 3392); s0 = fmaf(x60, l[0], s0); s1 = fmaf(x61, l[1], s1); s2 = fmaf(x62, l[2], s2); s3 = fmaf(x63, l[3], s3); } x49 = (lane == 49) ? 1.0f : -((s0 + s1) + (s2 + s3)); asm volatile("" : "+v"(x49) : : "memory"); }
    { float s0 = 0.f, s1 = 0.f, s2 = 0.f, s3 = 0.f; { const f32x4 l = *(const LAS f32x4*)(Lc + 3312); s1 = fmaf(x49, l[1], s1); s2 = fmaf(x50, l[2], s2); s3 = fmaf(x51, l[3], s3); } { const f32x4 l = *(const LAS f32x4*)(Lc + 3316); s0 = fmaf(x52, l[0], s0); s1 = fmaf(x53, l[1], s1); s2 = fmaf(x54, l[2], s2); s3 = fmaf(x55, l[3], s3); } { const f32x4 l = *(const LAS f32x4*)(Lc + 3320); s0 = fmaf(x56, l[0], s0); s1 = fmaf(x57, l[1], s1); s2 = fmaf(x58, l[2], s2); s3 = fmaf(x59, l[3], s3); } { const f32x4 l = *(const LAS f32x4*)(Lc + 3324); s0 = fmaf(x60, l[0], s0); s1 = fmaf(x61, l[1], s1); s2 = fmaf(x62, l[2], s2); s3 = fmaf(x63, l[3], s3); } x48 = (lane == 48) ? 1.0f : -((s0 + s1) + (s2 + s3)); asm volatile("" : "+v"(x48) : : "memory"); }
    { float s0 = 0.f, s1 = 0.f, s2 = 0.f, s3 = 0.f; { const f32x4 l = *(const LAS f32x4*)(Lc + 3244); s0 = fmaf(x48, l[0], s0); s1 = fmaf(x49, l[1], s1); s2 = fmaf(x50, l[2], s2); s3 = fmaf(x51, l[3], s3); } { const f32x4 l = *(const LAS f32x4*)(Lc + 3248); s0 = fmaf(x52, l[0], s0); s1 = fmaf(x53, l[1], s1); s2 = fmaf(x54, l[2], s2); s3 = fmaf(x55, l[3], s3); } { const f32x4 l = *(const LAS f32x4*)(Lc + 3252); s0 = fmaf(x56, l[0], s0); s1 = fmaf(x57, l[1], s1); s2 = fmaf(x58, l[2], s2); s3 = fmaf(x59, l[3], s3); } { const f32x4 l = *(const LAS f32x4*)(Lc + 3256); s0 = fmaf(x60, l[0], s0); s1 = fmaf(x61, l[1], s1); s2 = fmaf(x62, l[2], s2); s3 = fmaf(x63, l[3], s3); } x47 = (lane == 47) ? 1.0f : -((s0 + s1) + (s2 + s3)); asm volatile("" : "+v"(x47) : : "memory"); }
    { float s0 = 0.f, s1 = 0.f, s2 = 0.f, s3 = 0.f; { const f32x4 l = *(const LAS f32x4*)(Lc + 3172); s3 = fmaf(x47, l[3], s3); } { const f32x4 l = *(const LAS f32x4*)(Lc + 3176); s0 = fmaf(x48, l[0], s0); s1 = fmaf(x49, l[1], s1); s2 = fmaf(x50, l[2], s2); s3 = fmaf(x51, l[3], s3); } { const f32x4 l = *(const LAS f32x4*)(Lc + 3180); s0 = fmaf(x52, l[0], s0); s1 = fmaf(x53, l[1], s1); s2 = fmaf(x54, l[2], s2); s3 = fmaf(x55, l[3], s3); } { const f32x4 l = *(const LAS f32x4*)(Lc + 3184); s0 = fmaf(x56, l[0], s0); s1 = fmaf(x57, l[1], s1); s2 = fmaf(x58, l[2], s2); s3 = fmaf(x59, l[3], s3); } { const f32x4 l = *(const LAS f32x4*)(Lc + 3188); s0 = fmaf(x60, l[0], s0); s1 = fmaf(x61, l[1], s1); s2 = fmaf(x62, l[2], s2); s3 = fmaf(x63, l[3], s3); } x46 = (lane == 46) ? 1.0f : -((s0 + s1) + (s2 + s3)); asm volatile("" : "+v"(x46) : : "memory"); }
    { float s0 = 0.f, s1 = 0.f, s2 = 0.f, s3 = 0.f; { const f32x4 l = *(const LAS f32x4*)(Lc + 3104); s2 = fmaf(x46, l[2], s2); s3 = fmaf(x47, l[3], s3); } { const f32x4 l = *(const LAS f32x4*)(Lc + 3108); s0 = fmaf(x48, l[0], s0); s1 = fmaf(x49, l[1], s1); s2 = fmaf(x50, l[2], s2); s3 = fmaf(x51, l[3], s3); } { const f32x4 l = *(const LAS f32x4*)(Lc + 3112); s0 = fmaf(x52, l[0], s0); s1 = fmaf(x53, l[1], s1); s2 = fmaf(x54, l[2], s2); s3 = fmaf(x55, l[3], s3); } { const f32x4 l = *(const LAS f32x4*)(Lc + 3116); s0 = fmaf(x56, l[0], s0); s1 = fmaf(x57, l[1], s1); s2 = fmaf(x58, l[2], s2); s3 = fmaf(x59, l[3], s3); } { const f32x4 l = *(const LAS f32x4*)(Lc + 3120); s0 = fmaf(x60, l[0], s0); s1 = fmaf(x61, l[1], s1); s2 = fmaf(x62, l[2], s2); s3 = fmaf(x63, l[3], s3); } x45 = (lane == 45) ? 1.0f : -((s0 + s1) + (s2 + s3)); asm volatile("" : "+v"(x45) : : "memory"); }
    { float s0 = 0.f, s1 = 0.f, s2 = 0.f, s3 = 0.f; { const f32x4 l = *(const LAS f32x4*)(Lc + 3036); s1 = fmaf(x45, l[1], s1); s2 = fmaf(x46, l[2], s2); s3 = fmaf(x47, l[3], s3); } { const f32x4 l = *(const LAS f32x4*)(Lc + 3040); s0 = fmaf(x48, l[0], s0); s1 = fmaf(x49, l[1], s1); s2 = fmaf(x50, l[2], s2); s3 = fmaf(x51, l[3], s3); } { const f32x4 l = *(const LAS f32x4*)(Lc + 3044); s0 = fmaf(x52, l[0], s0); s1 = fmaf(x53, l[1], s1); s2 = fmaf(x54, l[2], s2); s3 = fmaf(x55, l[3], s3); } { const f32x4 l = *(const LAS f32x4*)(Lc + 3048); s0 = fmaf(x56, l[0], s0); s1 = fmaf(x57, l[1], s1); s2 = fmaf(x58, l[2], s2); s3 = fmaf(x59, l[3], s3); } { const f32x4 l = *(const LAS f32x4*)(Lc + 3052); s0 = fmaf(x60, l[0], s0); s1 = fmaf(x61, l[1], s1); s2 = fmaf(x62, l[2], s2); s3 = fmaf(x63, l[3], s3); } x44 = (lane == 44) ? 1.0f : -((s0 + s1) + (s2 + s3)); asm volatile("" : "+v"(x44) : : "memory"); }
    { float s0 = 0.f, s1 = 0.f, s2 = 0.f, s3 = 0.f; { const f32x4 l = *(const LAS f32x4*)(Lc + 2968); s0 = fmaf(x44, l[0], s0); s1 = fmaf(x45, l[1], s1); s2 = fmaf(x46, l[2], s2); s3 = fmaf(x47, l[3], s3); } { const f32x4 l = *(const LAS f32x4*)(Lc + 2972); s0 = fmaf(x48, l[0], s0); s1 = fmaf(x49, l[1], s1); s2 = fmaf(x50, l[2], s2); s3 = fmaf(x51, l[3], s3); } { const f32x4 l = *(const LAS f32x4*)(Lc + 2976); s0 = fmaf(x52, l[0], s0); s1 = fmaf(x53, l[1], s1); s2 = fmaf(x54, l[2], s2); s3 = fmaf(x55, l[3], s3); } { const f32x4 l = *(const LAS f32x4*)(Lc + 2980); s0 = fmaf(x56, l[0], s0); s1 = fmaf(x57, l[1], s1); s2 = fmaf(x58, l[2], s2); s3 = fmaf(x59, l[3], s3); } { const f32x4 l = *(const LAS f32x4*)(Lc + 2984); s0 = fmaf(x60, l[0], s0); s1 = fmaf(x61, l[1], s1); s2 = fmaf(x62, l[2], s2); s3 = fmaf(x63, l[3], s3); } x43 = (lane == 43) ? 1.0f : -((s0 + s1) + (s2 + s3)); asm volatile("" : "+v"(x43) : : "memory"); }
    { float s0 = 0.f, s1 = 0.f, s2 = 0.f, s3 = 0.f; { const f32x4 l = *(const LAS f32x4*)(Lc + 2896); s3 = fmaf(x43, l[3], s3); } { const f32x4 l = *(const LAS f32x4*)(Lc + 2900); s0 = fmaf(x44, l[0], s0); s1 = fmaf(x45, l[1], s1); s2 = fmaf(x46, l[2], s2); s3 = fmaf(x47, l[3], s3); } { const f32x4 l = *(const LAS f32x4*)(Lc + 2904); s0 = fmaf(x48, l[0], s0); s1 = fmaf(x49, l[1], s1); s2 = fmaf(x50, l[2], s2); s3 = fmaf(x51, l[3], s3); } { const f32x4 l = *(const LAS f32x4*)(Lc + 2908); s0 = fmaf(x52, l[0], s0); s1 = fmaf(x53, l[1], s1); s2 = fmaf(x54, l[2], s2); s3 = fmaf(x55, l[3], s3); } { const f32x4 l = *(const LAS f32x4*)(Lc + 2912); s0 = fmaf(x56, l[0], s0); s1 = fmaf(x57, l[1], s1); s2 = fmaf(x58, l[2], s2); s3 = fmaf(x59, l[3], s3); } { const f32x4 l = *(const LAS f32x4*)(Lc + 2916); s0 = fmaf(x60, l[0], s0); s1 = fmaf(x61, l[1], s1); s2 = fmaf(x62, l[2], s2); s3 = fmaf(x63, l[3], s3); } x42 = (lane == 42) ? 1.0f : -((s0 + s1) + (s2 + s3)); asm volatile("" : "+v"(x42) : : "memory"); }
    { float s0 = 0.f, s1 = 0.f, s2 = 0.f, s3 = 0.f; { const f32x4 l = *(const LAS f32x4*)(Lc + 2828); s2 = fmaf(x42, l[2], s2); s3 = fmaf(x43, l[3], s3); } { const f32x4 l = *(const LAS f32x4*)(Lc + 2832); s0 = fmaf(x44, l[0], s0); s1 = fmaf(x45, l[1], s1); s2 = fmaf(x46, l[2], s2); s3 = fmaf(x47, l[3], s3); } { const f32x4 l = *(const LAS f32x4*)(Lc + 2836); s0 = fmaf(x48, l[0], s0); s1 = fmaf(x49, l[1], s1); s2 = fmaf(x50, l[2], s2); s3 = fmaf(x51, l[3], s3); } { const f32x4 l = *(const LAS f32x4*)(Lc + 2840); s0 = fmaf(x52, l[0], s0); s1 = fmaf(x53, l[1], s1); s2 = fmaf(x54, l[2], s2); s3 = fmaf(x55, l[3], s3); } { const f32x4 l = *(const LAS f32x4*)(Lc + 2844); s0 = fmaf(x56, l[0], s0); s1 = fmaf(x57, l[1], s1); s2 = fmaf(x58, l[2], s2); s3 = fmaf(x59, l[3], s3); } { const f32x4 l = *(const LAS f32x4*)(Lc + 2848); s0 = fmaf(x60, l[0], s0); s1 = fmaf(x61, l[1], s1); s2 = fmaf(x62, l[2], s2); s3 = fmaf(x63, l[3], s3); } x41 = (lane == 41) ? 1.0f : -((s0 + s1) + (s2 + s3)); asm volatile("" : "+v"(x41) : : "memory"); }
    { float s0 = 0.f, s1 = 0.f, s2 = 0.f, s3 = 0.f; { const f32x4 l = *(const LAS f32x4*)(Lc + 2760); s1 = fmaf(x41, l[1], s1); s2 = fmaf(x42, l[2], s2); s3 = fmaf(x43, l[3], s3); } { const f32x4 l = *(const LAS f32x4*)(Lc + 2764); s0 = fmaf(x44, l[0], s0); s1 = fmaf(x45, l[1], s1); s2 = fmaf(x46, l[2], s2); s3 = fmaf(x47, l[3], s3); } { const f32x4 l = *(const LAS f32x4*)(Lc + 2768); s0 = fmaf(x48, l[0], s0); s1 = fmaf(x49, l[1], s1); s2 = fmaf(x50, l[2], s2); s3 = fmaf(x51, l[3], s3); } { const f32x4 l = *(const LAS f32x4*)(Lc + 2772); s0 = fmaf(x52, l[0], s0); s1 = fmaf(x53, l[1], s1); s2 = fmaf(x54, l[2], s2); s3 = fmaf(x55, l[3], s3); } { const f32x4 l = *(const LAS f32x4*)(Lc + 2776); s0 = fmaf(x56, l[0], s0); s1 = fmaf(x57, l[1], s1); s2 = fmaf(x58, l[2], s2); s3 = fmaf(x59, l[3], s3); } { const f32x4 l = *(const LAS f32x4*)(Lc + 2780); s0 = fmaf(x60, l[0], s0); s1 = fmaf(x61, l[1], s1); s2 = fmaf(x62, l[2], s2); s3 = fmaf(x63, l[3], s3); } x40 = (lane == 40) ? 1.0f : -((s0 + s1) + (s2 + s3)); asm volatile("" : "+v"(x40) : : "memory"); }
    { float s0 = 0.f, s1 = 0.f, s2 = 0.f, s3 = 0.f; { const f32x4 l = *(const LAS f32x4*)(Lc + 2692); s0 = fmaf(x40, l[0], s0); s1 = fmaf(x41, l[1], s1); s2 = fmaf(x42, l[2], s2); s3 = fmaf(x43, l[3], s3); } { const f32x4 l = *(const LAS f32x4*)(Lc + 2696); s0 = fmaf(x44, l[0], s0); s1 = fmaf(x45, l[1], s1); s2 = fmaf(x46, l[2], s2); s3 = fmaf(x47, l[3], s3); } { const f32x4 l = *(const LAS f32x4*)(Lc + 2700); s0 = fmaf(x48, l[0], s0); s1 = fmaf(x49, l[1], s1); s2 = fmaf(x50, l[2], s2); s3 = fmaf(x51, l[3], s3); } { const f32x4 l = *(const LAS f32x4*)(Lc + 2704); s0 = fmaf(x52, l[0], s0); s1 = fmaf(x53, l[1], s1); s2 = fmaf(x54, l[2], s2); s3 = fmaf(x55, l[3], s3); } { const f32x4 l = *(const LAS f32x4*)(Lc + 2708); s0 = fmaf(x56, l[0], s0); s1 = fmaf(x57, l[1], s1); s2 = fmaf(x58, l[2], s2); s3 = fmaf(x59, l[3], s3); } { const f32x4 l = *(const LAS f32x4*)(Lc + 2712); s0 = fmaf(x60, l[0], s0); s1 = fmaf(x61, l[1], s1); s2 = fmaf(x62, l[2], s2); s3 = fmaf(x63, l[3], s3); } x39 = (lane == 39) ? 1.0f : -((s0 + s1) + (s2 + s3)); asm volatile("" : "+v"(x39) : : "memory"); }
    { float s0 = 0.f, s1 = 0.f, s2 = 0.f, s3 = 0.f; { const f32x4 l = *(const LAS f32x4*)(Lc + 2620); s3 = fmaf(x39, l[3], s3); } { const f32x4 l = *(const LAS f32x4*)(Lc + 2624); s0 = fmaf(x40, l[0], s0); s1 = fmaf(x41, l[1], s1); s2 = fmaf(x42, l[2], s2); s3 = fmaf(x43, l[3], s3); } { const f32x4 l = *(const LAS f32x4*)(Lc + 2628); s0 = fmaf(x44, l[0], s0); s1 = fmaf(x45, l[1], s1); s2 = fmaf(x46, l[2], s2); s3 = fmaf(x47, l[3], s3); } { const f32x4 l = *(const LAS f32x4*)(Lc + 2632); s0 = fmaf(x48, l[0], s0); s1 = fmaf(x49, l[1], s1); s2 = fmaf(x50, l[2], s2); s3 = fmaf(x51, l[3], s3); } { const f32x4 l = *(const LAS f32x4*)(Lc + 2636); s0 = fmaf(x52, l[0], s0); s1 = fmaf(x53, l[1], s1); s2 = fmaf(x54, l[2], s2); s3 = fmaf(x55, l[3], s3); } { const f32x4 l = *(const LAS f32x4*)(Lc + 2640); s0 = fmaf(x56, l[0], s0); s1 = fmaf(x57, l[1], s1); s2 = fmaf(x58, l[2], s2); s3 = fmaf(x59, l[3], s3); } { const f32x4 l = *(const LAS f32x4*)(Lc + 2644); s0 = fmaf(x60, l[0], s0); s1 = fmaf(x61, l[1], s1); s2 = fmaf(x62, l[2], s2); s3 = fmaf(x63, l[3], s3); } x38 = (lane == 38) ? 1.0f : -((s0 + s1) + (s2 + s3)); asm volatile("" : "+v"(x38) : : "memory"); }
    { float s0 = 0.f, s1 = 0.f, s2 = 0.f, s3 = 0.f; { const f32x4 l = *(const LAS f32x4*)(Lc + 2552); s2 = fmaf(x38, l[2], s2); s3 = fmaf(x39, l[3], s3); } { const f32x4 l = *(const LAS f32x4*)(Lc + 2556); s0 = fmaf(x40, l[0], s0); s1 = fmaf(x41, l[1], s1); s2 = fmaf(x42, l[2], s2); s3 = fmaf(x43, l[3], s3); } { const f32x4 l = *(const LAS f32x4*)(Lc + 2560); s0 = fmaf(x44, l[0], s0); s1 = fmaf(x45, l[1], s1); s2 = fmaf(x46, l[2], s2); s3 = fmaf(x47, l[3], s3); } { const f32x4 l = *(const LAS f32x4*)(Lc + 2564); s0 = fmaf(x48, l[0], s0); s1 = fmaf(x49, l[1], s1); s2 = fmaf(x50, l[2], s2); s3 = fmaf(x51, l[3], s3); } { const f32x4 l = *(const LAS f32x4*)(Lc + 2568); s0 = fmaf(x52, l[0], s0); s1 = fmaf(x53, l[1], s1); s2 = fmaf(x54, l[2], s2); s3 = fmaf(x55, l[3], s3); } { const f32x4 l = *(const LAS f32x4*)(Lc + 2572); s0 = fmaf(x56, l[0], s0); s1 = fmaf(x57, l[1], s1); s2 = fmaf(x58, l[2], s2); s3 = fmaf(x59, l[3], s3); } { const f32x4 l = *(const LAS f32x4*)(Lc + 2576); s0 = fmaf(x60, l[0], s0); s1 = fmaf(x61, l[1], s1); s2 = fmaf(x62, l[2], s2); s3 = fmaf(x63, l[3], s3); } x37 = (lane == 37) ? 1.0f : -((s0 + s1) + (s2 + s3)); asm volatile("" : "+v"(x37) : : "memory"); }
    { float s0 = 0.f, s1 = 0.f, s2 = 0.f, s3 = 0.f; { const f32x4 l = *(const LAS f32x4*)(Lc + 2484); s1 = fmaf(x37, l[1], s1); s2 = fmaf(x38, l[2], s2); s3 = fmaf(x39, l[3], s3); } { const f32x4 l = *(const LAS f32x4*)(Lc + 2488); s0 = fmaf(x40, l[0], s0); s1 = fmaf(x41, l[1], s1); s2 = fmaf(x42, l[2], s2); s3 = fmaf(x43, l[3], s3); } { const f32x4 l = *(const LAS f32x4*)(Lc + 2492); s0 = fmaf(x44, l[0], s0); s1 = fmaf(x45, l[1], s1); s2 = fmaf(x46, l[2], s2); s3 = fmaf(x47, l[3], s3); } { const f32x4 l = *(const LAS f32x4*)(Lc + 2496); s0 = fmaf(x48, l[0], s0); s1 = fmaf(x49, l[1], s1); s2 = fmaf(x50, l[2], s2); s3 = fmaf(x51, l[3], s3); } { const f32x4 l = *(const LAS f32x4*)(Lc + 2500); s0 = fmaf(x52, l[0], s0); s1 = fmaf(x53, l[1], s1); s2 = fmaf(x54, l[2], s2); s3 = fmaf(x55, l[3], s3); } { const f32x4 l = *(const LAS f32x4*)(Lc + 2504); s0 = fmaf(x56, l[0], s0); s1 = fmaf(x57, l[1], s1); s2 = fmaf(x58, l[2], s2); s3 = fmaf(x59, l[3], s3); } { const f32x4 l = *(const LAS f32x4*)(Lc + 2508); s0 = fmaf(x60, l[0], s0); s1 = fmaf(x61, l[1], s1); s2 = fmaf(x62, l[2], s2); s3 = fmaf(x63, l[3], s3); } x36 = (lane == 36) ? 1.0f : -((s0 + s1) + (s2 + s3)); asm volatile("" : "+v"(x36) : : "memory"); }
    { float s0 = 0.f, s1 = 0.f, s2 = 0.f, s3 = 0.f; { const f32x4 l = *(const LAS f32x4*)(Lc + 2416); s0 = fmaf(x36, l[0], s0); s1 = fmaf(x37, l[1], s1); s2 = fmaf(x38, l[2], s2); s3 = fmaf(x39, l[3], s3); } { const f32x4 l = *(const LAS f32x4*)(Lc + 2420); s0 = fmaf(x40, l[0], s0); s1 = fmaf(x41, l[1], s1); s2 = fmaf(x42, l[2], s2); s3 = fmaf(x43, l[3], s3); } { const f32x4 l = *(const LAS f32x4*)(Lc + 2424); s0 = fmaf(x44, l[0], s0); s1 = fmaf(x45, l[1], s1); s2 = fmaf(x46, l[2], s2); s3 = fmaf(x47, l[3], s3); } { const f32x4 l = *(const LAS f32x4*)(Lc + 2428); s0 = fmaf(x48, l[0], s0); s1 = fmaf(x49, l[1], s1); s2 = fmaf(x50, l[2], s2); s3 = fmaf(x51, l[3], s3); } { const f32x4 l = *(const LAS f32x4*)(Lc + 2432); s0 = fmaf(x52, l[0], s0); s1 = fmaf(x53, l[1], s1); s2 = fmaf(x54, l[2], s2); s3 = fmaf(x55, l[3], s3); } { const f32x4 l = *(const LAS f32x4*)(Lc + 2436); s0 = fmaf(x56, l[0], s0); s1 = fmaf(x57, l[1], s1); s2 = fmaf(x58, l[2], s2); s3 = fmaf(x59, l[3], s3); } { const f32x4 l = *(const LAS f32x4*)(Lc + 2440); s0 = fmaf(x60, l[0], s0); s1 = fmaf(x61, l[1], s1); s2 = fmaf(x62, l[2], s2); s3 = fmaf(x63, l[3], s3); } x35 = (lane == 35) ? 1.0f : -((s0 + s1) + (s2 + s3)); asm volatile("" : "+v"(x35) : : "memory"); }
    { float s0 = 0.f, s1 = 0.f, s2 = 0.f, s3 = 0.f; { const f32x4 l = *(const LAS f32x4*)(Lc + 2344); s3 = fmaf(x35, l[3], s3); } { const f32x4 l = *(const LAS f32x4*)(Lc + 2348); s0 = fmaf(x36, l[0], s0); s1 = fmaf(x37, l[1], s1); s2 = fmaf(x38, l[2], s2); s3 = fmaf(x39, l[3], s3); } { const f32x4 l = *(const LAS f32x4*)(Lc + 2352); s0 = fmaf(x40, l[0], s0); s1 = fmaf(x41, l[1], s1); s2 = fmaf(x42, l[2], s2); s3 = fmaf(x43, l[3], s3); } { const f32x4 l = *(const LAS f32x4*)(Lc + 2356); s0 = fmaf(x44, l[0], s0); s1 = fmaf(x45, l[1], s1); s2 = fmaf(x46, l[2], s2); s3 = fmaf(x47, l[3], s3); } { const f32x4 l = *(const LAS f32x4*)(Lc + 2360); s0 = fmaf(x48, l[0], s0); s1 = fmaf(x49, l[1], s1); s2 = fmaf(x50, l[2], s2); s3 = fmaf(x51, l[3], s3); } { const f32x4 l = *(const LAS f32x4*)(Lc + 2364); s0 = fmaf(x52, l[0], s0); s1 = fmaf(x53, l[1], s1); s2 = fmaf(x54, l[2], s2); s3 = fmaf(x55, l[3], s3); } { const f32x4 l = *(const LAS f32x4*)(Lc + 2368); s0 = fmaf(x56, l[0], s0); s1 = fmaf(x57, l[1], s1); s2 = fmaf(x58, l[2], s2); s3 = fmaf(x59, l[3], s3); } { const f32x4 l = *(const LAS f32x4*)(Lc + 2372); s0 = fmaf(x60, l[0], s0); s1 = fmaf(x61, l[1], s1); s2 = fmaf(x62, l[2], s2); s3 = fmaf(x63, l[3], s3); } x34 = (lane == 34) ? 1.0f : -((s0 + s1) + (s2 + s3)); asm volatile("" : "+v"(x34) : : "memory"); }
    { float s0 = 0.f, s1 = 0.f, s2 = 0.f, s3 = 0.f; { const f32x4 l = *(const LAS f32x4*)(Lc + 2276); s2 = fmaf(x34, l[2], s2); s3 = fmaf(x35, l[3], s3); } { const f32x4 l = *(const LAS f32x4*)(Lc + 2280); s0 = fmaf(x36, l[0], s0); s1 = fmaf(x37, l[1], s1); s2 = fmaf(x38, l[2], s2); s3 = fmaf(x39, l[3], s3); } { const f32x4 l = *(const LAS f32x4*)(Lc + 2284); s0 = fmaf(x40, l[0], s0); s1 = fmaf(x41, l[1], s1); s2 = fmaf(x42, l[2], s2); s3 = fmaf(x43, l[3], s3); } { const f32x4 l = *(const LAS f32x4*)(Lc + 2288); s0 = fmaf(x44, l[0], s0); s1 = fmaf(x45, l[1], s1); s2 = fmaf(x46, l[2], s2); s3 = fmaf(x47, l[3], s3); } { const f32x4 l = *(const LAS f32x4*)(Lc + 2292); s0 = fmaf(x48, l[0], s0); s1 = fmaf(x49, l[1], s1); s2 = fmaf(x50, l[2], s2); s3 = fmaf(x51, l[3], s3); } { const f32x4 l = *(const LAS f32x4*)(Lc + 2296); s0 = fmaf(x52, l[0], s0); s1 = fmaf(x53, l[1], s1); s2 = fmaf(x54, l[2], s2); s3 = fmaf(x55, l[3], s3); } { const f32x4 l = *(const LAS f32x4*)(Lc + 2300); s0 = fmaf(x56, l[0], s0); s1 = fmaf(x57, l[1], s1); s2 = fmaf(x58, l[2], s2); s3 = fmaf(x59, l[3], s3); } { const f32x4 l = *(const LAS f32x4*)(Lc + 2304); s0 = fmaf(x60, l[0], s0); s1 = fmaf(x61, l[1], s1); s2 = fmaf(x62, l[2], s2); s3 = fmaf(x63, l[3], s3); } x33 = (lane == 33) ? 1.0f : -((s0 + s1) + (s2 + s3)); asm volatile("" : "+v"(x33) : : "memory"); }
    { float s0 = 0.f, s1 = 0.f, s2 = 0.f, s3 = 0.f; { const f32x4 l = *(const LAS f32x4*)(Lc + 2208); s1 = fmaf(x33, l[1], s1); s2 = fmaf(x34, l[2], s2); s3 = fmaf(x35, l[3], s3); } { const f32x4 l = *(const LAS f32x4*)(Lc + 2212); s0 = fmaf(x36, l[0], s0); s1 = fmaf(x37, l[1], s1); s2 = fmaf(x38, l[2], s2); s3 = fmaf(x39, l[3], s3); } { const f32x4 l = *(const LAS f32x4*)(Lc + 2216); s0 = fmaf(x40, l[0], s0); s1 = fmaf(x41, l[1], s1); s2 = fmaf(x42, l[2], s2); s3 = fmaf(x43, l[3], s3); } { const f32x4 l = *(const LAS f32x4*)(Lc + 2220); s0 = fmaf(x44, l[0], s0); s1 = fmaf(x45, l[1], s1); s2 = fmaf(x46, l[2], s2); s3 = fmaf(x47, l[3], s3); } { const f32x4 l = *(const LAS f32x4*)(Lc + 2224); s0 = fmaf(x48, l[0], s0); s1 = fmaf(x49, l[1], s1); s2 = fmaf(x50, l[2], s2); s3 = fmaf(x51, l[3], s3); } { const f32x4 l = *(const LAS f32x4*)(Lc + 2228); s0 = fmaf(x52, l[0], s0); s1 = fmaf(x53, l[1], s1); s2 = fmaf(x54, l[2], s2); s3 = fmaf(x55, l[3], s3); } { const f32x4 l = *(const LAS f32x4*)(Lc + 2232); s0 = fmaf(x56, l[0], s0); s1 = fmaf(x57, l[1], s1); s2 = fmaf(x58, l[2], s2); s3 = fmaf(x59, l[3], s3); } { const f32x4 l = *(const LAS f32x4*)(Lc + 2236); s0 = fmaf(x60, l[0], s0); s1 = fmaf(x61, l[1], s1); s2 = fmaf(x62, l[2], s2); s3 = fmaf(x63, l[3], s3); } x32 = (lane == 32) ? 1.0f : -((s0 + s1) + (s2 + s3)); asm volatile("" : "+v"(x32) : : "memory"); }
    { float s0 = 0.f, s1 = 0.f, s2 = 0.f, s3 = 0.f; { const f32x4 l = *(const LAS f32x4*)(Lc + 2140); s0 = fmaf(x32, l[0], s0); s1 = fmaf(x33, l[1], s1); s2 = fmaf(x34, l[2], s2); s3 = fmaf(x35, l[3], s3); } { const f32x4 l = *(const LAS f32x4*)(Lc + 2144); s0 = fmaf(x36, l[0], s0); s1 = fmaf(x37, l[1], s1); s2 = fmaf(x38, l[2], s2); s3 = fmaf(x39, l[3], s3); } { const f32x4 l = *(const LAS f32x4*)(Lc + 2148); s0 = fmaf(x40, l[0], s0); s1 = fmaf(x41, l[1], s1); s2 = fmaf(x42, l[2], s2); s3 = fmaf(x43, l[3], s3); } { const f32x4 l = *(const LAS f32x4*)(Lc + 2152); s0 = fmaf(x44, l[0], s0); s1 = fmaf(x45, l[1], s1); s2 = fmaf(x46, l[2], s2); s3 = fmaf(x47, l[3], s3); } { const f32x4 l = *(const LAS f32x4*)(Lc + 2156); s0 = fmaf(x48, l[0], s0); s1 = fmaf(x49, l[1], s1); s2 = fmaf(x50, l[2], s2); s3 = fmaf(x51, l[3], s3); } { const f32x4 l = *(const LAS f32x4*)(Lc + 2160); s0 = fmaf(x52, l[0], s0); s1 = fmaf(x53, l[1], s1); s2 = fmaf(x54, l[2], s2); s3 = fmaf(x55, l[3], s3); } { const f32x4 l = *(const LAS f32x4*)(Lc + 2164); s0 = fmaf(x56, l[0], s0); s1 = fmaf(x57, l[1], s1); s2 = fmaf(x58, l[2], s2); s3 = fmaf(x59, l[3], s3); } { const f32x4 l = *(const LAS f32x4*)(Lc + 2168); s0 = fmaf(x60, l[0], s0); s1 = fmaf(x61, l[1], s1); s2 = fmaf(x62, l[2], s2); s3 = fmaf(x63, l[3], s3); } x31 = (lane == 31) ? 1.0f : -((s0 + s1) + (s2 + s3)); asm volatile("" : "+v"(x31) : : "memory"); }
    { float s0 = 0.f, s1 = 0.f, s2 = 0.f, s3 = 0.f; { const f32x4 l = *(const LAS f32x4*)(Lc + 2068); s3 = fmaf(x31, l[3], s3); } { const f32x4 l = *(const LAS f32x4*)(Lc + 2072); s0 = fmaf(x32, l[0], s0); s1 = fmaf(x33, l[1], s1); s2 = fmaf(x34, l[2], s2); s3 = fmaf(x35, l[3], s3); } { const f32x4 l = *(const LAS f32x4*)(Lc + 2076); s0 = fmaf(x36, l[0], s0); s1 = fmaf(x37, l[1], s1); s2 = fmaf(x38, l[2], s2); s3 = fmaf(x39, l[3], s3); } { const f32x4 l = *(const LAS f32x4*)(Lc + 2080); s0 = fmaf(x40, l[0], s0); s1 = fmaf(x41, l[1], s1); s2 = fmaf(x42, l[2], s2); s3 = fmaf(x43, l[3], s3); } { const f32x4 l = *(const LAS f32x4*)(Lc + 2084); s0 = fmaf(x44, l[0], s0); s1 = fmaf(x45, l[1], s1); s2 = fmaf(x46, l[2], s2); s3 = fmaf(x47, l[3], s3); } { const f32x4 l = *(const LAS f32x4*)(Lc + 2088); s0 = fmaf(x48, l[0], s0); s1 = fmaf(x49, l[1], s1); s2 = fmaf(x50, l[2], s2); s3 = fmaf(x51, l[3], s3); } { const f32x4 l = *(const LAS f32x4*)(Lc + 2092); s0 = fmaf(x52, l[0], s0); s1 = fmaf(x53, l[1], s1); s2 = fmaf(x54, l[2], s2); s3 = fmaf(x55, l[3], s3); } { const f32x4 l = *(const LAS f32x4*)(Lc + 2096); s0 = fmaf(x56, l[0], s0); s1 = fmaf(x57, l[1], s1); s2 = fmaf(x58, l[2], s2); s3 = fmaf(x59, l[3], s3); } { const f32x4 l = *(const LAS f32x4*)(Lc + 2100); s0 = fmaf(x60, l[0], s0); s1 = fmaf(x61, l[1], s1); s2 = fmaf(x62, l[2], s2); s3 = fmaf(x63, l[3], s3); } x30 = (lane == 30) ? 1.0f : -((s0 + s1) + (s2 + s3)); asm volatile("" : "+v"(x30) : : "memory"); }
    { float s0 = 0.f, s1 = 0.f, s2 = 0.f, s3 = 0.f; { const f32x4 l = *(const LAS f32x4*)(Lc + 2000); s2 = fmaf(x30, l[2], s2); s3 = fmaf(x31, l[3], s3); } { const f32x4 l = *(const LAS f32x4*)(Lc + 2004); s0 = fmaf(x32, l[0], s0); s1 = fmaf(x33, l[1], s1); s2 = fmaf(x34, l[2], s2); s3 = fmaf(x35, l[3], s3); } { const f32x4 l = *(const LAS f32x4*)(Lc + 2008); s0 = fmaf(x36, l[0], s0); s1 = fmaf(x37, l[1], s1); s2 = fmaf(x38, l[2], s2); s3 = fmaf(x39, l[3], s3); } { const f32x4 l = *(const LAS f32x4*)(Lc + 2012); s0 = fmaf(x40, l[0], s0); s1 = fmaf(x41, l[1], s1); s2 = fmaf(x42, l[2], s2); s3 = fmaf(x43, l[3], s3); } { const f32x4 l = *(const LAS f32x4*)(Lc + 2016); s0 = fmaf(x44, l[0], s0); s1 = fmaf(x45, l[1], s1); s2 = fmaf(x46, l[2], s2); s3 = fmaf(x47, l[3], s3); } { const f32x4 l = *(const LAS f32x4*)(Lc + 2020); s0 = fmaf(x48, l[0], s0); s1 = fmaf(x49, l[1], s1); s2 = fmaf(x50, l[2], s2); s3 = fmaf(x51, l[3], s3); } { const f32x4 l = *(const LAS f32x4*)(Lc + 2024); s0 = fmaf(x52, l[0], s0); s1 = fmaf(x53, l[1], s1); s2 = fmaf(x54, l[2], s2); s3 = fmaf(x55, l[3], s3); } { const f32x4 l = *(const LAS f32x4*)(Lc + 2028); s0 = fmaf(x56, l[0], s0); s1 = fmaf(x57, l[1], s1); s2 = fmaf(x58, l[2], s2); s3 = fmaf(x59, l[3], s3); } { const f32x4 l = *(const LAS f32x4*)(Lc + 2032); s0 = fmaf(x60, l[0], s0); s1 = fmaf(x61, l[1], s1); s2 = fmaf(x62, l[2], s2); s3 = fmaf(x63, l[3], s3); } x29 = (lane == 29) ? 1.0f : -((s0 + s1) + (s2 + s3)); asm volatile("" : "+v"(x29) : : "memory"); }
    { float s0 = 0.f, s1 = 0.f, s2 = 0.f, s3 = 0.f; { const f32x4 l = *(const LAS f32x4*)(Lc + 1932); s1 = fmaf(x29, l[1], s1); s2 = fmaf(x30, l[2], s2); s3 = fmaf(x31, l[3], s3); } { const f32x4 l = *(const LAS f32x4*)(Lc + 1936); s0 = fmaf(x32, l[0], s0); s1 = fmaf(x33, l[1], s1); s2 = fmaf(x34, l[2], s2); s3 = fmaf(x35, l[3], s3); } { const f32x4 l = *(const LAS f32x4*)(Lc + 1940); s0 = fmaf(x36, l[0], s0); s1 = fmaf(x37, l[1], s1); s2 = fmaf(x38, l[2], s2); s3 = fmaf(x39, l[3], s3); } { const f32x4 l = *(const LAS f32x4*)(Lc + 1944); s0 = fmaf(x40, l[0], s0); s1 = fmaf(x41, l[1], s1); s2 = fmaf(x42, l[2], s2); s3 = fmaf(x43, l[3], s3); } { const f32x4 l = *(const LAS f32x4*)(Lc + 1948); s0 = fmaf(x44, l[0], s0); s1 = fmaf(x45, l[1], s1); s2 = fmaf(x46, l[2], s2); s3 = fmaf(x47, l[3], s3); } { const f32x4 l = *(const LAS f32x4*)(Lc + 1952); s0 = fmaf(x48, l[0], s0); s1 = fmaf(x49, l[1], s1); s2 = fmaf(x50, l[2], s2); s3 = fmaf(x51, l[3], s3); } { const f32x4 l = *(const LAS f32x4*)(Lc + 1956); s0 = fmaf(x52, l[0], s0); s1 = fmaf(x53, l[1], s1); s2 = fmaf(x54, l[2], s2); s3 = fmaf(x55, l[3], s3); } { const f32x4 l = *(const LAS f32x4*)(Lc + 1960); s0 = fmaf(x56, l[0], s0); s1 = fmaf(x57, l[1], s1); s2 = fmaf(x58, l[2], s2); s3 = fmaf(x59, l[3], s3); } { const f32x4 l = *(const LAS f32x4*)(Lc + 1964); s0 = fmaf(x60, l[0], s0); s1 = fmaf(x61, l[1], s1); s2 = fmaf(x62, l[2], s2); s3 = fmaf(x63, l[3], s3); } x28 = (lane == 28) ? 1.0f : -((s0 + s1) + (s2 + s3)); asm volatile("" : "+v"(x28) : : "memory"); }
    { float s0 = 0.f, s1 = 0.f, s2 = 0.f, s3 = 0.f; { const f32x4 l = *(const LAS f32x4*)(Lc + 1864); s0 = fmaf(x28, l[0], s0); s1 = fmaf(x29, l[1], s1); s2 = fmaf(x30, l[2], s2); s3 = fmaf(x31, l[3], s3); } { const f32x4 l = *(const LAS f32x4*)(Lc + 1868); s0 = fmaf(x32, l[0], s0); s1 = fmaf(x33, l[1], s1); s2 = fmaf(x34, l[2], s2); s3 = fmaf(x35, l[3], s3); } { const f32x4 l = *(const LAS f32x4*)(Lc + 1872); s0 = fmaf(x36, l[0], s0); s1 = fmaf(x37, l[1], s1); s2 = fmaf(x38, l[2], s2); s3 = fmaf(x39, l[3], s3); } { const f32x4 l = *(const LAS f32x4*)(Lc + 1876); s0 = fmaf(x40, l[0], s0); s1 = fmaf(x41, l[1], s1); s2 = fmaf(x42, l[2], s2); s3 = fmaf(x43, l[3], s3); } { const f32x4 l = *(const LAS f32x4*)(Lc + 1880); s0 = fmaf(x44, l[0], s0); s1 = fmaf(x45, l[1], s1); s2 = fmaf(x46, l[2], s2); s3 = fmaf(x47, l[3], s3); } { const f32x4 l = *(const LAS f32x4*)(Lc + 1884); s0 = fmaf(x48, l[0], s0); s1 = fmaf(x49, l[1], s1); s2 = fmaf(x50, l[2], s2); s3 = fmaf(x51, l[3], s3); } { const f32x4 l = *(const LAS f32x4*)(Lc + 1888); s0 = fmaf(x52, l[0], s0); s1 = fmaf(x53, l[1], s1); s2 = fmaf(x54, l[2], s2); s3 = fmaf(x55, l[3], s3); } { const f32x4 l = *(const LAS f32x4*)(Lc + 1892); s0 = fmaf(x56, l[0], s0); s1 = fmaf(x57, l[1], s1); s2 = fmaf(x58, l[2], s2); s3 = fmaf(x59, l[3], s3); } { const f32x4 l = *(const LAS f32x4*)(Lc + 1896); s0 = fmaf(x60, l[0], s0); s1 = fmaf(x61, l[1], s1); s2 = fmaf(x62, l[2], s2); s3 = fmaf(x63, l[3], s3); } x27 = (lane == 27) ? 1.0f : -((s0 + s1) + (s2 + s3)); asm volatile("" : "+v"(x27) : : "memory"); }
    { float s0 = 0.f, s1 = 0.f, s2 = 0.f, s3 = 0.f; { const f32x4 l = *(const LAS f32x4*)(Lc + 1792); s3 = fmaf(x27, l[3], s3); } { const f32x4 l = *(const LAS f32x4*)(Lc + 1796); s0 = fmaf(x28, l[0], s0); s1 = fmaf(x29, l[1], s1); s2 = fmaf(x30, l[2], s2); s3 = fmaf(x31, l[3], s3); } { const f32x4 l = *(const LAS f32x4*)(Lc + 1800); s0 = fmaf(x32, l[0], s0); s1 = fmaf(x33, l[1], s1); s2 = fmaf(x34, l[2], s2); s3 = fmaf(x35, l[3], s3); } { const f32x4 l = *(const LAS f32x4*)(Lc + 1804); s0 = fmaf(x36, l[0], s0); s1 = fmaf(x37, l[1], s1); s2 = fmaf(x38, l[2], s2); s3 = fmaf(x39, l[3], s3); } { const f32x4 l = *(const LAS f32x4*)(Lc + 1808); s0 = fmaf(x40, l[0], s0); s1 = fmaf(x41, l[1], s1); s2 = fmaf(x42, l[2], s2); s3 = fmaf(x43, l[3], s3); } { const f32x4 l = *(const LAS f32x4*)(Lc + 1812); s0 = fmaf(x44, l[0], s0); s1 = fmaf(x45, l[1], s1); s2 = fmaf(x46, l[2], s2); s3 = fmaf(x47, l[3], s3); } { const f32x4 l = *(const LAS f32x4*)(Lc + 1816); s0 = fmaf(x48, l[0], s0); s1 = fmaf(x49, l[1], s1); s2 = fmaf(x50, l[2], s2); s3 = fmaf(x51, l[3], s3); } { const f32x4 l = *(const LAS f32x4*)(Lc + 1820); s0 = fmaf(x52, l[0], s0); s1 = fmaf(x53, l[1], s1); s2 = fmaf(x54, l[2], s2); s3 = fmaf(x55, l[3], s3); } { const f32x4 l = *(const LAS f32x4*)(Lc + 1824); s0 = fmaf(x56, l[0], s0); s1 = fmaf(x57, l[1], s1); s2 = fmaf(x58, l[2], s2); s3 = fmaf(x59, l[3], s3); } { const f32x4 l = *(const LAS f32x4*)(Lc + 1828); s0 = fmaf(x60, l[0], s0); s1 = fmaf(x61, l[1], s1); s2 = fmaf(x62, l[2], s2); s3 = fmaf(x63, l[3], s3); } x26 = (lane == 26) ? 1.0f : -((s0 + s1) + (s2 + s3)); asm volatile("" : "+v"(x26) : : "memory"); }
    { float s0 = 0.f, s1 = 0.f, s2 = 0.f, s3 = 0.f; { const f32x4 l = *(const LAS f32x4*)(Lc + 1724); s2 = fmaf(x26, l[2], s2); s3 = fmaf(x27, l[3], s3); } { const f32x4 l = *(const LAS f32x4*)(Lc + 1728); s0 = fmaf(x28, l[0], s0); s1 = fmaf(x29, l[1], s1); s2 = fmaf(x30, l[2], s2); s3 = fmaf(x31, l[3], s3); } { const f32x4 l = *(const LAS f32x4*)(Lc + 1732); s0 = fmaf(x32, l[0], s0); s1 = fmaf(x33, l[1], s1); s2 = fmaf(x34, l[2], s2); s3 = fmaf(x35, l[3], s3); } { const f32x4 l = *(const LAS f32x4*)(Lc + 1736); s0 = fmaf(x36, l[0], s0); s1 = fmaf(x37, l[1], s1); s2 = fmaf(x38, l[2], s2); s3 = fmaf(x39, l[3], s3); } { const f32x4 l = *(const LAS f32x4*)(Lc + 1740); s0 = fmaf(x40, l[0], s0); s1 = fmaf(x41, l[1], s1); s2 = fmaf(x42, l[2], s2); s3 = fmaf(x43, l[3], s3); } { const f32x4 l = *(const LAS f32x4*)(Lc + 1744); s0 = fmaf(x44, l[0], s0); s1 = fmaf(x45, l[1], s1); s2 = fmaf(x46, l[2], s2); s3 = fmaf(x47, l[3], s3); } { const f32x4 l = *(const LAS f32x4*)(Lc + 1748); s0 = fmaf(x48, l[0], s0); s1 = fmaf(x49, l[1], s1); s2 = fmaf(x50, l[2], s2); s3 = fmaf(x51, l[3], s3); } { const f32x4 l = *(const LAS f32x4*)(Lc + 1752); s0 = fmaf(x52, l[0], s0); s1 = fmaf(x53, l[1], s1); s2 = fmaf(x54, l[2], s2); s3 = fmaf(x55, l[3], s3); } { const f32x4 l = *(const LAS f32x4*)(Lc + 1756); s0 = fmaf(x56, l[0], s0); s1 = fmaf(x57, l[1], s1); s2 = fmaf(x58, l[2], s2); s3 = fmaf(x59, l[3], s3); } { const f32x4 l = *(const LAS f32x4*)(Lc + 1760); s0 = fmaf(x60, l[0], s0); s1 = fmaf(x61, l[1], s1); s2 = fmaf(x62, l[2], s2); s3 = fmaf(x63, l[3], s3); } x25 = (lane == 25) ? 1.0f : -((s0 + s1) + (s2 + s3)); asm volatile("" : "+v"(x25) : : "memory"); }
    { float s0 = 0.f, s1 = 0.f, s2 = 0.f, s3 = 0.f; { const f32x4 l = *(const LAS f32x4*)(Lc + 1656); s1 = fmaf(x25, l[1], s1); s2 = fmaf(x26, l[2], s2); s3 = fmaf(x27, l[3], s3); } { const f32x4 l = *(const LAS f32x4*)(Lc + 1660); s0 = fmaf(x28, l[0], s0); s1 = fmaf(x29, l[1], s1); s2 = fmaf(x30, l[2], s2); s3 = fmaf(x31, l[3], s3); } { const f32x4 l = *(const LAS f32x4*)(Lc + 1664); s0 = fmaf(x32, l[0], s0); s1 = fmaf(x33, l[1], s1); s2 = fmaf(x34, l[2], s2); s3 = fmaf(x35, l[3], s3); } { const f32x4 l = *(const LAS f32x4*)(Lc + 1668); s0 = fmaf(x36, l[0], s0); s1 = fmaf(x37, l[1], s1); s2 = fmaf(x38, l[2], s2); s3 = fmaf(x39, l[3], s3); } { const f32x4 l = *(const LAS f32x4*)(Lc + 1672); s0 = fmaf(x40, l[0], s0); s1 = fmaf(x41, l[1], s1); s2 = fmaf(x42, l[2], s2); s3 = fmaf(x43, l[3], s3); } { const f32x4 l = *(const LAS f32x4*)(Lc + 1676); s0 = fmaf(x44, l[0], s0); s1 = fmaf(x45, l[1], s1); s2 = fmaf(x46, l[2], s2); s3 = fmaf(x47, l[3], s3); } { const f32x4 l = *(const LAS f32x4*)(Lc + 1680); s0 = fmaf(x48, l[0], s0); s1 = fmaf(x49, l[1], s1); s2 = fmaf(x50, l[2], s2); s3 = fmaf(x51, l[3], s3); } { const f32x4 l = *(const LAS f32x4*)(Lc + 1684); s0 = fmaf(x52, l[0], s0); s1 = fmaf(x53, l[1], s1); s2 = fmaf(x54, l[2], s2); s3 = fmaf(x55, l[3], s3); } { const f32x4 l = *(const LAS f32x4*)(Lc + 1688); s0 = fmaf(x56, l[0], s0); s1 = fmaf(x57, l[1], s1); s2 = fmaf(x58, l[2], s2); s3 = fmaf(x59, l[3], s3); } { const f32x4 l = *(const LAS f32x4*)(Lc + 1692); s0 = fmaf(x60, l[0], s0); s1 = fmaf(x61, l[1], s1); s2 = fmaf(x62, l[2], s2); s3 = fmaf(x63, l[3], s3); } x24 = (lane == 24) ? 1.0f : -((s0 + s1) + (s2 + s3)); asm volatile("" : "+v"(x24) : : "memory"); }
    { float s0 = 0.f, s1 = 0.f, s2 = 0.f, s3 = 0.f; { const f32x4 l = *(const LAS f32x4*)(Lc + 1588); s0 = fmaf(x24, l[0], s0); s1 = fmaf(x25, l[1], s1); s2 = fmaf(x26, l[2], s2); s3 = fmaf(x27, l[3], s3); } { const f32x4 l = *(const LAS f32x4*)(Lc + 1592); s0 = fmaf(x28, l[0], s0); s1 = fmaf(x29, l[1], s1); s2 = fmaf(x30, l[2], s2); s3 = fmaf(x31, l[3], s3); } { const f32x4 l = *(const LAS f32x4*)(Lc + 1596); s0 = fmaf(x32, l[0], s0); s1 = fmaf(x33, l[1], s1); s2 = fmaf(x34, l[2], s2); s3 = fmaf(x35, l[3], s3); } { const f32x4 l = *(const LAS f32x4*)(Lc + 1600); s0 = fmaf(x36, l[0], s0); s1 = fmaf(x37, l[1], s1); s2 = fmaf(x38, l[2], s2); s3 = fmaf(x39, l[3], s3); } { const f32x4 l = *(const LAS f32x4*)(Lc + 1604); s0 = fmaf(x40, l[0], s0); s1 = fmaf(x41, l[1], s1); s2 = fmaf(x42, l[2], s2); s3 = fmaf(x43, l[3], s3); } { const f32x4 l = *(const LAS f32x4*)(Lc + 1608); s0 = fmaf(x44, l[0], s0); s1 = fmaf(x45, l[1], s1); s2 = fmaf(x46, l[2], s2); s3 = fmaf(x47, l[3], s3); } { const f32x4 l = *(const LAS f32x4*)(Lc + 1612); s0 = fmaf(x48, l[0], s0); s1 = fmaf(x49, l[1], s1); s2 = fmaf(x50, l[2], s2); s3 = fmaf(x51, l[3], s3); } { const f32x4 l = *(const LAS f32x4*)(Lc + 1616); s0 = fmaf(x52, l[0], s0); s1 = fmaf(x53, l[1], s1); s2 = fmaf(x54, l[2], s2); s3 = fmaf(x55, l[3], s3); } { const f32x4 l = *(const LAS f32x4*)(Lc + 1620); s0 = fmaf(x56, l[0], s0); s1 = fmaf(x57, l[1], s1); s2 = fmaf(x58, l[2], s2); s3 = fmaf(x59, l[3], s3); } { const f32x4 l = *(const LAS f32x4*)(Lc + 1624); s0 = fmaf(x60, l[0], s0); s1 = fmaf(x61, l[1], s1); s2 = fmaf(x62, l[2], s2); s3 = fmaf(x63, l[3], s3); } x23 = (lane == 23) ? 1.0f : -((s0 + s1) + (s2 + s3)); asm volatile("" : "+v"(x23) : : "memory"); }
    { float s0 = 0.f, s1 = 0.f, s2 = 0.f, s3 = 0.f; { const f32x4 l = *(const LAS f32x4*)(Lc + 1516); s3 = fmaf(x23, l[3], s3); } { const f32x4 l = *(const LAS f32x4*)(Lc + 1520); s0 = fmaf(x24, l[0], s0); s1 = fmaf(x25, l[1], s1); s2 = fmaf(x26, l[2], s2); s3 = fmaf(x27, l[3], s3); } { const f32x4 l = *(const LAS f32x4*)(Lc + 1524); s0 = fmaf(x28, l[0], s0); s1 = fmaf(x29, l[1], s1); s2 = fmaf(x30, l[2], s2); s3 = fmaf(x31, l[3], s3); } { const f32x4 l = *(const LAS f32x4*)(Lc + 1528); s0 = fmaf(x32, l[0], s0); s1 = fmaf(x33, l[1], s1); s2 = fmaf(x34, l[2], s2); s3 = fmaf(x35, l[3], s3); } { const f32x4 l = *(const LAS f32x4*)(Lc + 1532); s0 = fmaf(x36, l[0], s0); s1 = fmaf(x37, l[1], s1); s2 = fmaf(x38, l[2], s2); s3 = fmaf(x39, l[3], s3); } { const f32x4 l = *(const LAS f32x4*)(Lc + 1536); s0 = fmaf(x40, l[0], s0); s1 = fmaf(x41, l[1], s1); s2 = fmaf(x42, l[2], s2); s3 = fmaf(x43, l[3], s3); } { const f32x4 l = *(const LAS f32x4*)(Lc + 1540); s0 = fmaf(x44, l[0], s0); s1 = fmaf(x45, l[1], s1); s2 = fmaf(x46, l[2], s2); s3 = fmaf(x47, l[3], s3); } { const f32x4 l = *(const LAS f32x4*)(Lc + 1544); s0 = fmaf(x48, l[0], s0); s1 = fmaf(x49, l[1], s1); s2 = fmaf(x50, l[2], s2); s3 = fmaf(x51, l[3], s3); } { const f32x4 l = *(const LAS f32x4*)(Lc + 1548); s0 = fmaf(x52, l[0], s0); s1 = fmaf(x53, l[1], s1); s2 = fmaf(x54, l[2], s2); s3 = fmaf(x55, l[3], s3); } { const f32x4 l = *(const LAS f32x4*)(Lc + 1552); s0 = fmaf(x56, l[0], s0); s1 = fmaf(x57, l[1], s1); s2 = fmaf(x58, l[2], s2); s3 = fmaf(x59, l[3], s3); } { const f32x4 l = *(const LAS f32x4*)(Lc + 1556); s0 = fmaf(x60, l[0], s0); s1 = fmaf(x61, l[1], s1); s2 = fmaf(x62, l[2], s2); s3 = fmaf(x63, l[3], s3); } x22 = (lane == 22) ? 1.0f : -((s0 + s1) + (s2 + s3)); asm volatile("" : "+v"(x22) : : "memory"); }
    { float s0 = 0.f, s1 = 0.f, s2 = 0.f, s3 = 0.f; { const f32x4 l = *(const LAS f32x4*)(Lc + 1448); s2 = fmaf(x22, l[2], s2); s3 = fmaf(x23, l[3], s3); } { const f32x4 l = *(const LAS f32x4*)(Lc + 1452); s0 = fmaf(x24, l[0], s0); s1 = fmaf(x25, l[1], s1); s2 = fmaf(x26, l[2], s2); s3 = fmaf(x27, l[3], s3); } { const f32x4 l = *(const LAS f32x4*)(Lc + 1456); s0 = fmaf(x28, l[0], s0); s1 = fmaf(x29, l[1], s1); s2 = fmaf(x30, l[2], s2); s3 = fmaf(x31, l[3], s3); } { const f32x4 l = *(const LAS f32x4*)(Lc + 1460); s0 = fmaf(x32, l[0], s0); s1 = fmaf(x33, l[1], s1); s2 = fmaf(x34, l[2], s2); s3 = fmaf(x35, l[3], s3); } { const f32x4 l = *(const LAS f32x4*)(Lc + 1464); s0 = fmaf(x36, l[0], s0); s1 = fmaf(x37, l[1], s1); s2 = fmaf(x38, l[2], s2); s3 = fmaf(x39, l[3], s3); } { const f32x4 l = *(const LAS f32x4*)(Lc + 1468); s0 = fmaf(x40, l[0], s0); s1 = fmaf(x41, l[1], s1); s2 = fmaf(x42, l[2], s2); s3 = fmaf(x43, l[3], s3); } { const f32x4 l = *(const LAS f32x4*)(Lc + 1472); s0 = fmaf(x44, l[0], s0); s1 = fmaf(x45, l[1], s1); s2 = fmaf(x46, l[2], s2); s3 = fmaf(x47, l[3], s3); } { const f32x4 l = *(const LAS f32x4*)(Lc + 1476); s0 = fmaf(x48, l[0], s0); s1 = fmaf(x49, l[1], s1); s2 = fmaf(x50, l[2], s2); s3 = fmaf(x51, l[3], s3); } { const f32x4 l = *(const LAS f32x4*)(Lc + 1480); s0 = fmaf(x52, l[0], s0); s1 = fmaf(x53, l[1], s1); s2 = fmaf(x54, l[2], s2); s3 = fmaf(x55, l[3], s3); } { const f32x4 l = *(const LAS f32x4*)(Lc + 1484); s0 = fmaf(x56, l[0], s0); s1 = fmaf(x57, l[1], s1); s2 = fmaf(x58, l[2], s2); s3 = fmaf(x59, l[3], s3); } { const f32x4 l = *(const LAS f32x4*)(Lc + 1488); s0 = fmaf(x60, l[0], s0); s1 = fmaf(x61, l[1], s1); s2 = fmaf(x62, l[2], s2); s3 = fmaf(x63, l[3], s3); } x21 = (lane == 21) ? 1.0f : -((s0 + s1) + (s2 + s3)); asm volatile("" : "+v"(x21) : : "memory"); }
    { float s0 = 0.f, s1 = 0.f, s2 = 0.f, s3 = 0.f; { const f32x4 l = *(const LAS f32x4*)(Lc + 1380); s1 = fmaf(x21, l[1], s1); s2 = fmaf(x22, l[2], s2); s3 = fmaf(x23, l[3], s3); } { const f32x4 l = *(const LAS f32x4*)(Lc + 1384); s0 = fmaf(x24, l[0], s0); s1 = fmaf(x25, l[1], s1); s2 = fmaf(x26, l[2], s2); s3 = fmaf(x27, l[3], s3); } { const f32x4 l = *(const LAS f32x4*)(Lc + 1388); s0 = fmaf(x28, l[0], s0); s1 = fmaf(x29, l[1], s1); s2 = fmaf(x30, l[2], s2); s3 = fmaf(x31, l[3], s3); } { const f32x4 l = *(const LAS f32x4*)(Lc + 1392); s0 = fmaf(x32, l[0], s0); s1 = fmaf(x33, l[1], s1); s2 = fmaf(x34, l[2], s2); s3 = fmaf(x35, l[3], s3); } { const f32x4 l = *(const LAS f32x4*)(Lc + 1396); s0 = fmaf(x36, l[0], s0); s1 = fmaf(x37, l[1], s1); s2 = fmaf(x38, l[2], s2); s3 = fmaf(x39, l[3], s3); } { const f32x4 l = *(const LAS f32x4*)(Lc + 1400); s0 = fmaf(x40, l[0], s0); s1 = fmaf(x41, l[1], s1); s2 = fmaf(x42, l[2], s2); s3 = fmaf(x43, l[3], s3); } { const f32x4 l = *(const LAS f32x4*)(Lc + 1404); s0 = fmaf(x44, l[0], s0); s1 = fmaf(x45, l[1], s1); s2 = fmaf(x46, l[2], s2); s3 = fmaf(x47, l[3], s3); } { const f32x4 l = *(const LAS f32x4*)(Lc + 1408); s0 = fmaf(x48, l[0], s0); s1 = fmaf(x49, l[1], s1); s2 = fmaf(x50, l[2], s2); s3 = fmaf(x51, l[3], s3); } { const f32x4 l = *(const LAS f32x4*)(Lc + 1412); s0 = fmaf(x52, l[0], s0); s1 = fmaf(x53, l[1], s1); s2 = fmaf(x54, l[2], s2); s3 = fmaf(x55, l[3], s3); } { const f32x4 l = *(const LAS f32x4*)(Lc + 1416); s0 = fmaf(x56, l[0], s0); s1 = fmaf(x57, l[1], s1); s2 = fmaf(x58, l[2], s2); s3 = fmaf(x59, l[3], s3); } { const f32x4 l = *(const LAS f32x4*)(Lc + 1420); s0 = fmaf(x60, l[0], s0); s1 = fmaf(x61, l[1], s1); s2 = fmaf(x62, l[2], s2); s3 = fmaf(x63, l[3], s3); } x20 = (lane == 20) ? 1.0f : -((s0 + s1) + (s2 + s3)); asm volatile("" : "+v"(x20) : : "memory"); }
    { float s0 = 0.f, s1 = 0.f, s2 = 0.f, s3 = 0.f; { const f32x4 l = *(const LAS f32x4*)(Lc + 1312); s0 = fmaf(x20, l[0], s0); s1 = fmaf(x21, l[1], s1); s2 = fmaf(x22, l[2], s2); s3 = fmaf(x23, l[3], s3); } { const f32x4 l = *(const LAS f32x4*)(Lc + 1316); s0 = fmaf(x24, l[0], s0); s1 = fmaf(x25, l[1], s1); s2 = fmaf(x26, l[2], s2); s3 = fmaf(x27, l[3], s3); } { const f32x4 l = *(const LAS f32x4*)(Lc + 1320); s0 = fmaf(x28, l[0], s0); s1 = fmaf(x29, l[1], s1); s2 = fmaf(x30, l[2], s2); s3 = fmaf(x31, l[3], s3); } { const f32x4 l = *(const LAS f32x4*)(Lc + 1324); s0 = fmaf(x32, l[0], s0); s1 = fmaf(x33, l[1], s1); s2 = fmaf(x34, l[2], s2); s3 = fmaf(x35, l[3], s3); } { const f32x4 l = *(const LAS f32x4*)(Lc + 1328); s0 = fmaf(x36, l[0], s0); s1 = fmaf(x37, l[1], s1); s2 = fmaf(x38, l[2], s2); s3 = fmaf(x39, l[3], s3); } { const f32x4 l = *(const LAS f32x4*)(Lc + 1332); s0 = fmaf(x40, l[0], s0); s1 = fmaf(x41, l[1], s1); s2 = fmaf(x42, l[2], s2); s3 = fmaf(x43, l[3], s3); } { const f32x4 l = *(const LAS f32x4*)(Lc + 1336); s0 = fmaf(x44, l[0], s0); s1 = fmaf(x45, l[1], s1); s2 = fmaf(x46, l[2], s2); s3 = fmaf(x47, l[3], s3); } { const f32x4 l = *(const LAS f32x4*)(Lc + 1340); s0 = fmaf(x48, l[0], s0); s1 = fmaf(x49, l[1], s1); s2 = fmaf(x50, l[2], s2); s3 = fmaf(x51, l[3], s3); } { const f32x4 l = *(const LAS f32x4*)(Lc + 1344); s0 = fmaf(x52, l[0], s0); s1 = fmaf(x53, l[1], s1); s2 = fmaf(x54, l[2], s2); s3 = fmaf(x55, l[3], s3); } { const f32x4 l = *(const LAS f32x4*)(Lc + 1348); s0 = fmaf(x56, l[0], s0); s1 = fmaf(x57, l[1], s1); s2 = fmaf(x58, l[2], s2); s3 = fmaf(x59, l[3], s3); } { const f32x4 l = *(const LAS f32x4*)(Lc + 1352); s0 = fmaf(x60, l[0], s0); s1 = fmaf(x61, l[1], s1); s2 = fmaf(x62, l[2], s2); s3 = fmaf(x63, l[3], s3); } x19 = (lane == 19) ? 1.0f : -((s0 + s1) + (s2 + s3)); asm volatile("" : "+v"(x19) : : "memory"); }
    { float s0 = 0.f, s1 = 0.f, s2 = 0.f, s3 = 0.f; { const f32x4 l = *(const LAS f32x4*)(Lc + 1240); s3 = fmaf(x19, l[3], s3); } { const f32x4 l = *(const LAS f32x4*)(Lc + 1244); s0 = fmaf(x20, l[0], s0); s1 = fmaf(x21, l[1], s1); s2 = fmaf(x22, l[2], s2); s3 = fmaf(x23, l[3], s3); } { const f32x4 l = *(const LAS f32x4*)(Lc + 1248); s0 = fmaf(x24, l[0], s0); s1 = fmaf(x25, l[1], s1); s2 = fmaf(x26, l[2], s2); s3 = fmaf(x27, l[3], s3); } { const f32x4 l = *(const LAS f32x4*)(Lc + 1252); s0 = fmaf(x28, l[0], s0); s1 = fmaf(x29, l[1], s1); s2 = fmaf(x30, l[2], s2); s3 = fmaf(x31, l[3], s3); } { const f32x4 l = *(const LAS f32x4*)(Lc + 1256); s0 = fmaf(x32, l[0], s0); s1 = fmaf(x33, l[1], s1); s2 = fmaf(x34, l[2], s2); s3 = fmaf(x35, l[3], s3); } { const f32x4 l = *(const LAS f32x4*)(Lc + 1260); s0 = fmaf(x36, l[0], s0); s1 = fmaf(x37, l[1], s1); s2 = fmaf(x38, l[2], s2); s3 = fmaf(x39, l[3], s3); } { const f32x4 l = *(const LAS f32x4*)(Lc + 1264); s0 = fmaf(x40, l[0], s0); s1 = fmaf(x41, l[1], s1); s2 = fmaf(x42, l[2], s2); s3 = fmaf(x43, l[3], s3); } { const f32x4 l = *(const LAS f32x4*)(Lc + 1268); s0 = fmaf(x44, l[0], s0); s1 = fmaf(x45, l[1], s1); s2 = fmaf(x46, l[2], s2); s3 = fmaf(x47, l[3], s3); } { const f32x4 l = *(const LAS f32x4*)(Lc + 1272); s0 = fmaf(x48, l[0], s0); s1 = fmaf(x49, l[1], s1); s2 = fmaf(x50, l[2], s2); s3 = fmaf(x51, l[3], s3); } { const f32x4 l = *(const LAS f32x4*)(Lc + 1276); s0 = fmaf(x52, l[0], s0); s1 = fmaf(x53, l[1], s1); s2 = fmaf(x54, l[2], s2); s3 = fmaf(x55, l[3], s3); } { const f32x4 l = *(const LAS f32x4*)(Lc + 1280); s0 = fmaf(x56, l[0], s0); s1 = fmaf(x57, l[1], s1); s2 = fmaf(x58, l[2], s2); s3 = fmaf(x59, l[3], s3); } { const f32x4 l = *(const LAS f32x4*)(Lc + 1284); s0 = fmaf(x60, l[0], s0); s1 = fmaf(x61, l[1], s1); s2 = fmaf(x62, l[2], s2); s3 = fmaf(x63, l[3], s3); } x18 = (lane == 18) ? 1.0f : -((s0 + s1) + (s2 + s3)); asm volatile("" : "+v"(x18) : : "memory"); }
    { float s0 = 0.f, s1 = 0.f, s2 = 0.f, s3 = 0.f; { const f32x4 l = *(const LAS f32x4*)(Lc + 1172); s2 = fmaf(x18, l[2], s2); s3 = fmaf(x19, l[3], s3); } { const f32x4 l = *(const LAS f32x4*)(Lc + 1176); s0 = fmaf(x20, l[0], s0); s1 = fmaf(x21, l[1], s1); s2 = fmaf(x22, l[2], s2); s3 = fmaf(x23, l[3], s3); } { const f32x4 l = *(const LAS f32x4*)(Lc + 1180); s0 = fmaf(x24, l[0], s0); s1 = fmaf(x25, l[1], s1); s2 = fmaf(x26, l[2], s2); s3 = fmaf(x27, l[3], s3); } { const f32x4 l = *(const LAS f32x4*)(Lc + 1184); s0 = fmaf(x28, l[0], s0); s1 = fmaf(x29, l[1], s1); s2 = fmaf(x30, l[2], s2); s3 = fmaf(x31, l[3], s3); } { const f32x4 l = *(const LAS f32x4*)(Lc + 1188); s0 = fmaf(x32, l[0], s0); s1 = fmaf(x33, l[1], s1); s2 = fmaf(x34, l[2], s2); s3 = fmaf(x35, l[3], s3); } { const f32x4 l = *(const LAS f32x4*)(Lc + 1192); s0 = fmaf(x36, l[0], s0); s1 = fmaf(x37, l[1], s1); s2 = fmaf(x38, l[2], s2); s3 = fmaf(x39, l[3], s3); } { const f32x4 l = *(const LAS f32x4*)(Lc + 1196); s0 = fmaf(x40, l[0], s0); s1 = fmaf(x41, l[1], s1); s2 = fmaf(x42, l[2], s2); s3 = fmaf(x43, l[3], s3); } { const f32x4 l = *(const LAS f32x4*)(Lc + 1200); s0 = fmaf(x44, l[0], s0); s1 = fmaf(x45, l[1], s1); s2 = fmaf(x46, l[2], s2); s3 = fmaf(x47, l[3], s3); } { const f32x4 l = *(const LAS f32x4*)(Lc + 1204); s0 = fmaf(x48, l[0], s0); s1 = fmaf(x49, l[1], s1); s2 = fmaf(x50, l[2], s2); s3 = fmaf(x51, l[3], s3); } { const f32x4 l = *(const LAS f32x4*)(Lc + 1208); s0 = fmaf(x52, l[0], s0); s1 = fmaf(x53, l[1], s1); s2 = fmaf(x54, l[2], s2); s3 = fmaf(x55, l[3], s3); } { const f32x4 l = *(const LAS f32x4*)(Lc + 1212); s0 = fmaf(x56, l[0], s0); s1 = fmaf(x57, l[1], s1); s2 = fmaf(x58, l[2], s2); s3 = fmaf(x59, l[3], s3); } { const f32x4 l = *(const LAS f32x4*)(Lc + 1216); s0 = fmaf(x60, l[0], s0); s1 = fmaf(x61, l[1], s1); s2 = fmaf(x62, l[2], s2); s3 = fmaf(x63, l[3], s3); } x17 = (lane == 17) ? 1.0f : -((s0 + s1) + (s2 + s3)); asm volatile("" : "+v"(x17) : : "memory"); }
    { float s0 = 0.f, s1 = 0.f, s2 = 0.f, s3 = 0.f; { const f32x4 l = *(const LAS f32x4*)(Lc + 1104); s1 = fmaf(x17, l[1], s1); s2 = fmaf(x18, l[2], s2); s3 = fmaf(x19, l[3], s3); } { const f32x4 l = *(const LAS f32x4*)(Lc + 1108); s0 = fmaf(x20, l[0], s0); s1 = fmaf(x21, l[1], s1); s2 = fmaf(x22, l[2], s2); s3 = fmaf(x23, l[3], s3); } { const f32x4 l = *(const LAS f32x4*)(Lc + 1112); s0 = fmaf(x24, l[0], s0); s1 = fmaf(x25, l[1], s1); s2 = fmaf(x26, l[2], s2); s3 = fmaf(x27, l[3], s3); } { const f32x4 l = *(const LAS f32x4*)(Lc + 1116); s0 = fmaf(x28, l[0], s0); s1 = fmaf(x29, l[1], s1); s2 = fmaf(x30, l[2], s2); s3 = fmaf(x31, l[3], s3); } { const f32x4 l = *(const LAS f32x4*)(Lc + 1120); s0 = fmaf(x32, l[0], s0); s1 = fmaf(x33, l[1], s1); s2 = fmaf(x34, l[2], s2); s3 = fmaf(x35, l[3], s3); } { const f32x4 l = *(const LAS f32x4*)(Lc + 1124); s0 = fmaf(x36, l[0], s0); s1 = fmaf(x37, l[1], s1); s2 = fmaf(x38, l[2], s2); s3 = fmaf(x39, l[3], s3); } { const f32x4 l = *(const LAS f32x4*)(Lc + 1128); s0 = fmaf(x40, l[0], s0); s1 = fmaf(x41, l[1], s1); s2 = fmaf(x42, l[2], s2); s3 = fmaf(x43, l[3], s3); } { const f32x4 l = *(const LAS f32x4*)(Lc + 1132); s0 = fmaf(x44, l[0], s0); s1 = fmaf(x45, l[1], s1); s2 = fmaf(x46, l[2], s2); s3 = fmaf(x47, l[3], s3); } { const f32x4 l = *(const LAS f32x4*)(Lc + 1136); s0 = fmaf(x48, l[0], s0); s1 = fmaf(x49, l[1], s1); s2 = fmaf(x50, l[2], s2); s3 = fmaf(x51, l[3], s3); } { const f32x4 l = *(const LAS f32x4*)(Lc + 1140); s0 = fmaf(x52, l[0], s0); s1 = fmaf(x53, l[1], s1); s2 = fmaf(x54, l[2], s2); s3 = fmaf(x55, l[3], s3); } { const f32x4 l = *(const LAS f32x4*)(Lc + 1144); s0 = fmaf(x56, l[0], s0); s1 = fmaf(x57, l[1], s1); s2 = fmaf(x58, l[2], s2); s3 = fmaf(x59, l[3], s3); } { const f32x4 l = *(const LAS f32x4*)(Lc + 1148); s0 = fmaf(x60, l[0], s0); s1 = fmaf(x61, l[1], s1); s2 = fmaf(x62, l[2], s2); s3 = fmaf(x63, l[3], s3); } x16 = (lane == 16) ? 1.0f : -((s0 + s1) + (s2 + s3)); asm volatile("" : "+v"(x16) : : "memory"); }
    { float s0 = 0.f, s1 = 0.f, s2 = 0.f, s3 = 0.f; { const f32x4 l = *(const LAS f32x4*)(Lc + 1036); s0 = fmaf(x16, l[0], s0); s1 = fmaf(x17, l[1], s1); s2 = fmaf(x18, l[2], s2); s3 = fmaf(x19, l[3], s3); } { const f32x4 l = *(const LAS f32x4*)(Lc + 1040); s0 = fmaf(x20, l[0], s0); s1 = fmaf(x21, l[1], s1); s2 = fmaf(x22, l[2], s2); s3 = fmaf(x23, l[3], s3); } { const f32x4 l = *(const LAS f32x4*)(Lc + 1044); s0 = fmaf(x24, l[0], s0); s1 = fmaf(x25, l[1], s1); s2 = fmaf(x26, l[2], s2); s3 = fmaf(x27, l[3], s3); } { const f32x4 l = *(const LAS f32x4*)(Lc + 1048); s0 = fmaf(x28, l[0], s0); s1 = fmaf(x29, l[1], s1); s2 = fmaf(x30, l[2], s2); s3 = fmaf(x31, l[3], s3); } { const f32x4 l = *(const LAS f32x4*)(Lc + 1052); s0 = fmaf(x32, l[0], s0); s1 = fmaf(x33, l[1], s1); s2 = fmaf(x34, l[2], s2); s3 = fmaf(x35, l[3], s3); } { const f32x4 l = *(const LAS f32x4*)(Lc + 1056); s0 = fmaf(x36, l[0], s0); s1 = fmaf(x37, l[1], s1); s2 = fmaf(x38, l[2], s2); s3 = fmaf(x39, l[3], s3); } { const f32x4 l = *(const LAS f32x4*)(Lc + 1060); s0 = fmaf(x40, l[0], s0); s1 = fmaf(x41, l[1], s1); s2 = fmaf(x42, l[2], s2); s3 = fmaf(x43, l[3], s3); } { const f32x4 l = *(const LAS f32x4*)(Lc + 1064); s0 = fmaf(x44, l[0], s0); s1 = fmaf(x45, l[1], s1); s2 = fmaf(x46, l[2], s2); s3 = fmaf(x47, l[3], s3); } { const f32x4 l = *(const LAS f32x4*)(Lc + 1068); s0 = fmaf(x48, l[0], s0); s1 = fmaf(x49, l[1], s1); s2 = fmaf(x50, l[2], s2); s3 = fmaf(x51, l[3], s3); } { const f32x4 l = *(const LAS f32x4*)(Lc + 1072); s0 = fmaf(x52, l[0], s0); s1 = fmaf(x53, l[1], s1); s2 = fmaf(x54, l[2], s2); s3 = fmaf(x55, l[3], s3); } { const f32x4 l = *(const LAS f32x4*)(Lc + 1076); s0 = fmaf(x56, l[0], s0); s1 = fmaf(x57, l[1], s1); s2 = fmaf(x58, l[2], s2); s3 = fmaf(x59, l[3], s3); } { const f32x4 l = *(const LAS f32x4*)(Lc + 1080); s0 = fmaf(x60, l[0], s0); s1 = fmaf(x61, l[1], s1); s2 = fmaf(x62, l[2], s2); s3 = fmaf(x63, l[3], s3); } x15 = (lane == 15) ? 1.0f : -((s0 + s1) + (s2 + s3)); asm volatile("" : "+v"(x15) : : "memory"); }
    { float s0 = 0.f, s1 = 0.f, s2 = 0.f, s3 = 0.f; { const f32x4 l = *(const LAS f32x4*)(Lc + 964); s3 = fmaf(x15, l[3], s3); } { const f32x4 l = *(const LAS f32x4*)(Lc + 968); s0 = fmaf(x16, l[0], s0); s1 = fmaf(x17, l[1], s1); s2 = fmaf(x18, l[2], s2); s3 = fmaf(x19, l[3], s3); } { const f32x4 l = *(const LAS f32x4*)(Lc + 972); s0 = fmaf(x20, l[0], s0); s1 = fmaf(x21, l[1], s1); s2 = fmaf(x22, l[2], s2); s3 = fmaf(x23, l[3], s3); } { const f32x4 l = *(const LAS f32x4*)(Lc + 976); s0 = fmaf(x24, l[0], s0); s1 = fmaf(x25, l[1], s1); s2 = fmaf(x26, l[2], s2); s3 = fmaf(x27, l[3], s3); } { const f32x4 l = *(const LAS f32x4*)(Lc + 980); s0 = fmaf(x28, l[0], s0); s1 = fmaf(x29, l[1], s1); s2 = fmaf(x30, l[2], s2); s3 = fmaf(x31, l[3], s3); } { const f32x4 l = *(const LAS f32x4*)(Lc + 984); s0 = fmaf(x32, l[0], s0); s1 = fmaf(x33, l[1], s1); s2 = fmaf(x34, l[2], s2); s3 = fmaf(x35, l[3], s3); } { const f32x4 l = *(const LAS f32x4*)(Lc + 988); s0 = fmaf(x36, l[0], s0); s1 = fmaf(x37, l[1], s1); s2 = fmaf(x38, l[2], s2); s3 = fmaf(x39, l[3], s3); } { const f32x4 l = *(const LAS f32x4*)(Lc + 992); s0 = fmaf(x40, l[0], s0); s1 = fmaf(x41, l[1], s1); s2 = fmaf(x42, l[2], s2); s3 = fmaf(x43, l[3], s3); } { const f32x4 l = *(const LAS f32x4*)(Lc + 996); s0 = fmaf(x44, l[0], s0); s1 = fmaf(x45, l[1], s1); s2 = fmaf(x46, l[2], s2); s3 = fmaf(x47, l[3], s3); } { const f32x4 l = *(const LAS f32x4*)(Lc + 1000); s0 = fmaf(x48, l[0], s0); s1 = fmaf(x49, l[1], s1); s2 = fmaf(x50, l[2], s2); s3 = fmaf(x51, l[3], s3); } { const f32x4 l = *(const LAS f32x4*)(Lc + 1004); s0 = fmaf(x52, l[0], s0); s1 = fmaf(x53, l[1], s1); s2 = fmaf(x54, l[2], s2); s3 = fmaf(x55, l[3], s3); } { const f32x4 l = *(const LAS f32x4*)(Lc + 1008); s0 = fmaf(x56, l[0], s0); s1 = fmaf(x57, l[1], s1); s2 = fmaf(x58, l[2], s2); s3 = fmaf(x59, l[3], s3); } { const f32x4 l = *(const LAS f32x4*)(Lc + 1012); s0 = fmaf(x60, l[0], s0); s1 = fmaf(x61, l[1], s1); s2 = fmaf(x62, l[2], s2); s3 = fmaf(x63, l[3], s3); } x14 = (lane == 14) ? 1.0f : -((s0 + s1) + (s2 + s3)); asm volatile("" : "+v"(x14) : : "memory"); }
    { float s0 = 0.f, s1 = 0.f, s2 = 0.f, s3 = 0.f; { const f32x4 l = *(const LAS f32x4*)(Lc + 896); s2 = fmaf(x14, l[2], s2); s3 = fmaf(x15, l[3], s3); } { const f32x4 l = *(const LAS f32x4*)(Lc + 900); s0 = fmaf(x16, l[0], s0); s1 = fmaf(x17, l[1], s1); s2 = fmaf(x18, l[2], s2); s3 = fmaf(x19, l[3], s3); } { const f32x4 l = *(const LAS f32x4*)(Lc + 904); s0 = fmaf(x20, l[0], s0); s1 = fmaf(x21, l[1], s1); s2 = fmaf(x22, l[2], s2); s3 = fmaf(x23, l[3], s3); } { const f32x4 l = *(const LAS f32x4*)(Lc + 908); s0 = fmaf(x24, l[0], s0); s1 = fmaf(x25, l[1], s1); s2 = fmaf(x26, l[2], s2); s3 = fmaf(x27, l[3], s3); } { const f32x4 l = *(const LAS f32x4*)(Lc + 912); s0 = fmaf(x28, l[0], s0); s1 = fmaf(x29, l[1], s1); s2 = fmaf(x30, l[2], s2); s3 = fmaf(x31, l[3], s3); } { const f32x4 l = *(const LAS f32x4*)(Lc + 916); s0 = fmaf(x32, l[0], s0); s1 = fmaf(x33, l[1], s1); s2 = fmaf(x34, l[2], s2); s3 = fmaf(x35, l[3], s3); } { const f32x4 l = *(const LAS f32x4*)(Lc + 920); s0 = fmaf(x36, l[0], s0); s1 = fmaf(x37, l[1], s1); s2 = fmaf(x38, l[2], s2); s3 = fmaf(x39, l[3], s3); } { const f32x4 l = *(const LAS f32x4*)(Lc + 924); s0 = fmaf(x40, l[0], s0); s1 = fmaf(x41, l[1], s1); s2 = fmaf(x42, l[2], s2); s3 = fmaf(x43, l[3], s3); } { const f32x4 l = *(const LAS f32x4*)(Lc + 928); s0 = fmaf(x44, l[0], s0); s1 = fmaf(x45, l[1], s1); s2 = fmaf(x46, l[2], s2); s3 = fmaf(x47, l[3], s3); } { const f32x4 l = *(const LAS f32x4*)(Lc + 932); s0 = fmaf(x48, l[0], s0); s1 = fmaf(x49, l[1], s1); s2 = fmaf(x50, l[2], s2); s3 = fmaf(x51, l[3], s3); } { const f32x4 l = *(const LAS f32x4*)(Lc + 936); s0 = fmaf(x52, l[0], s0); s1 = fmaf(x53, l[1], s1); s2 = fmaf(x54, l[2], s2); s3 = fmaf(x55, l[3], s3); } { const f32x4 l = *(const LAS f32x4*)(Lc + 940); s0 = fmaf(x56, l[0], s0); s1 = fmaf(x57, l[1], s1); s2 = fmaf(x58, l[2], s2); s3 = fmaf(x59, l[3], s3); } { const f32x4 l = *(const LAS f32x4*)(Lc + 944); s0 = fmaf(x60, l[0], s0); s1 = fmaf(x61, l[1], s1); s2 = fmaf(x62, l[2], s2); s3 = fmaf(x63, l[3], s3); } x13 = (lane == 13) ? 1.0f : -((s0 + s1) + (s2 + s3)); asm volatile("" : "+v"(x13) : : "memory"); }
    { float s0 = 0.f, s1 = 0.f, s2 = 0.f, s3 = 0.f; { const f32x4 l = *(const LAS f32x4*)(Lc + 828); s1 = fmaf(x13, l[1], s1); s2 = fmaf(x14, l[2], s2); s3 = fmaf(x15, l[3], s3); } { const f32x4 l = *(const LAS f32x4*)(Lc + 832); s0 = fmaf(x16, l[0], s0); s1 = fmaf(x17, l[1], s1); s2 = fmaf(x18, l[2], s2); s3 = fmaf(x19, l[3], s3); } { const f32x4 l = *(const LAS f32x4*)(Lc + 836); s0 = fmaf(x20, l[0], s0); s1 = fmaf(x21, l[1], s1); s2 = fmaf(x22, l[2], s2); s3 = fmaf(x23, l[3], s3); } { const f32x4 l = *(const LAS f32x4*)(Lc + 840); s0 = fmaf(x24, l[0], s0); s1 = fmaf(x25, l[1], s1); s2 = fmaf(x26, l[2], s2); s3 = fmaf(x27, l[3], s3); } { const f32x4 l = *(const LAS f32x4*)(Lc + 844); s0 = fmaf(x28, l[0], s0); s1 = fmaf(x29, l[1], s1); s2 = fmaf(x30, l[2], s2); s3 = fmaf(x31, l[3], s3); } { const f32x4 l = *(const LAS f32x4*)(Lc + 848); s0 = fmaf(x32, l[0], s0); s1 = fmaf(x33, l[1], s1); s2 = fmaf(x34, l[2], s2); s3 = fmaf(x35, l[3], s3); } { const f32x4 l = *(const LAS f32x4*)(Lc + 852); s0 = fmaf(x36, l[0], s0); s1 = fmaf(x37, l[1], s1); s2 = fmaf(x38, l[2], s2); s3 = fmaf(x39, l[3], s3); } { const f32x4 l = *(const LAS f32x4*)(Lc + 856); s0 = fmaf(x40, l[0], s0); s1 = fmaf(x41, l[1], s1); s2 = fmaf(x42, l[2], s2); s3 = fmaf(x43, l[3], s3); } { const f32x4 l = *(const LAS f32x4*)(Lc + 860); s0 = fmaf(x44, l[0], s0); s1 = fmaf(x45, l[1], s1); s2 = fmaf(x46, l[2], s2); s3 = fmaf(x47, l[3], s3); } { const f32x4 l = *(const LAS f32x4*)(Lc + 864); s0 = fmaf(x48, l[0], s0); s1 = fmaf(x49, l[1], s1); s2 = fmaf(x50, l[2], s2); s3 = fmaf(x51, l[3], s3); } { const f32x4 l = *(const LAS f32x4*)(Lc + 868); s0 = fmaf(x52, l[0], s0); s1 = fmaf(x53, l[1], s1); s2 = fmaf(x54, l[2], s2); s3 = fmaf(x55, l[3], s3); } { const f32x4 l = *(const LAS f32x4*)(Lc + 872); s0 = fmaf(x56, l[0], s0); s1 = fmaf(x57, l[1], s1); s2 = fmaf(x58, l[2], s2); s3 = fmaf(x59, l[3], s3); } { const f32x4 l = *(const LAS f32x4*)(Lc + 876); s0 = fmaf(x60, l[0], s0); s1 = fmaf(x61, l[1], s1); s2 = fmaf(x62, l[2], s2); s3 = fmaf(x63, l[3], s3); } x12 = (lane == 12) ? 1.0f : -((s0 + s1) + (s2 + s3)); asm volatile("" : "+v"(x12) : : "memory"); }
    { float s0 = 0.f, s1 = 0.f, s2 = 0.f, s3 = 0.f; { const f32x4 l = *(const LAS f32x4*)(Lc + 760); s0 = fmaf(x12, l[0], s0); s1 = fmaf(x13, l[1], s1); s2 = fmaf(x14, l[2], s2); s3 = fmaf(x15, l[3], s3); } { const f32x4 l = *(const LAS f32x4*)(Lc + 764); s0 = fmaf(x16, l[0], s0); s1 = fmaf(x17, l[1], s1); s2 = fmaf(x18, l[2], s2); s3 = fmaf(x19, l[3], s3); } { const f32x4 l = *(const LAS f32x4*)(Lc + 768); s0 = fmaf(x20, l[0], s0); s1 = fmaf(x21, l[1], s1); s2 = fmaf(x22, l[2], s2); s3 = fmaf(x23, l[3], s3); } { const f32x4 l = *(const LAS f32x4*)(Lc + 772); s0 = fmaf(x24, l[0], s0); s1 = fmaf(x25, l[1], s1); s2 = fmaf(x26, l[2], s2); s3 = fmaf(x27, l[3], s3); } { const f32x4 l = *(const LAS f32x4*)(Lc + 776); s0 = fmaf(x28, l[0], s0); s1 = fmaf(x29, l[1], s1); s2 = fmaf(x30, l[2], s2); s3 = fmaf(x31, l[3], s3); } { const f32x4 l = *(const LAS f32x4*)(Lc + 780); s0 = fmaf(x32, l[0], s0); s1 = fmaf(x33, l[1], s1); s2 = fmaf(x34, l[2], s2); s3 = fmaf(x35, l[3], s3); } { const f32x4 l = *(const LAS f32x4*)(Lc + 784); s0 = fmaf(x36, l[0], s0); s1 = fmaf(x37, l[1], s1); s2 = fmaf(x38, l[2], s2); s3 = fmaf(x39, l[3], s3); } { const f32x4 l = *(const LAS f32x4*)(Lc + 788); s0 = fmaf(x40, l[0], s0); s1 = fmaf(x41, l[1], s1); s2 = fmaf(x42, l[2], s2); s3 = fmaf(x43, l[3], s3); } { const f32x4 l = *(const LAS f32x4*)(Lc + 792); s0 = fmaf(x44, l[0], s0); s1 = fmaf(x45, l[1], s1); s2 = fmaf(x46, l[2], s2); s3 = fmaf(x47, l[3], s3); } { const f32x4 l = *(const LAS f32x4*)(Lc + 796); s0 = fmaf(x48, l[0], s0); s1 = fmaf(x49, l[1], s1); s2 = fmaf(x50, l[2], s2); s3 = fmaf(x51, l[3], s3); } { const f32x4 l = *(const LAS f32x4*)(Lc + 800); s0 = fmaf(x52, l[0], s0); s1 = fmaf(x53, l[1], s1); s2 = fmaf(x54, l[2], s2); s3 = fmaf(x55, l[3], s3); } { const f32x4 l = *(const LAS f32x4*)(Lc + 804); s0 = fmaf(x56, l[0], s0); s1 = fmaf(x57, l[1], s1); s2 = fmaf(x58, l[2], s2); s3 = fmaf(x59, l[3], s3); } { const f32x4 l = *(const LAS f32x4*)(Lc + 808); s0 = fmaf(x60, l[0], s0); s1 = fmaf(x61, l[1], s1); s2 = fmaf(x62, l[2], s2); s3 = fmaf(x63, l[3], s3); } x11 = (lane == 11) ? 1.0f : -((s0 + s1) + (s2 + s3)); asm volatile("" : "+v"(x11) : : "memory"); }
    { float s0 = 0.f, s1 = 0.f, s2 = 0.f, s3 = 0.f; { const f32x4 l = *(const LAS f32x4*)(Lc + 688); s3 = fmaf(x11, l[3], s3); } { const f32x4 l = *(const LAS f32x4*)(Lc + 692); s0 = fmaf(x12, l[0], s0); s1 = fmaf(x13, l[1], s1); s2 = fmaf(x14, l[2], s2); s3 = fmaf(x15, l[3], s3); } { const f32x4 l = *(const LAS f32x4*)(Lc + 696); s0 = fmaf(x16, l[0], s0); s1 = fmaf(x17, l[1], s1); s2 = fmaf(x18, l[2], s2); s3 = fmaf(x19, l[3], s3); } { const f32x4 l = *(const LAS f32x4*)(Lc + 700); s0 = fmaf(x20, l[0], s0); s1 = fmaf(x21, l[1], s1); s2 = fmaf(x22, l[2], s2); s3 = fmaf(x23, l[3], s3); } { const f32x4 l = *(const LAS f32x4*)(Lc + 704); s0 = fmaf(x24, l[0], s0); s1 = fmaf(x25, l[1], s1); s2 = fmaf(x26, l[2], s2); s3 = fmaf(x27, l[3], s3); } { const f32x4 l = *(const LAS f32x4*)(Lc + 708); s0 = fmaf(x28, l[0], s0); s1 = fmaf(x29, l[1], s1); s2 = fmaf(x30, l[2], s2); s3 = fmaf(x31, l[3], s3); } { const f32x4 l = *(const LAS f32x4*)(Lc + 712); s0 = fmaf(x32, l[0], s0); s1 = fmaf(x33, l[1], s1); s2 = fmaf(x34, l[2], s2); s3 = fmaf(x35, l[3], s3); } { const f32x4 l = *(const LAS f32x4*)(Lc + 716); s0 = fmaf(x36, l[0], s0); s1 = fmaf(x37, l[1], s1); s2 = fmaf(x38, l[2], s2); s3 = fmaf(x39, l[3], s3); } { const f32x4 l = *(const LAS f32x4*)(Lc + 720); s0 = fmaf(x40, l[0], s0); s1 = fmaf(x41, l[1], s1); s2 = fmaf(x42, l[2], s2); s3 = fmaf(x43, l[3], s3); } { const f32x4 l = *(const LAS f32x4*)(Lc + 724); s0 = fmaf(x44, l[0], s0); s1 = fmaf(x45, l[1], s1); s2 = fmaf(x46, l[2], s2); s3 = fmaf(x47, l[3], s3); } { const f32x4 l = *(const LAS f32x4*)(Lc + 728); s0 = fmaf(x48, l[0], s0); s1 = fmaf(x49, l[1], s1); s2 = fmaf(x50, l[2], s2); s3 = fmaf(x51, l[3], s3); } { const f32x4 l = *(const LAS f32x4*)(Lc + 732); s0 = fmaf(x52, l[0], s0); s1 = fmaf(x53, l[1], s1); s2 = fmaf(x54, l[2], s2); s3 = fmaf(x55, l[3], s3); } { const f32x4 l = *(const LAS f32x4*)(Lc + 736); s0 = fmaf(x56, l[0], s0); s1 = fmaf(x57, l[1], s1); s2 = fmaf(x58, l[2], s2); s3 = fmaf(x59, l[3], s3); } { const f32x4 l = *(const LAS f32x4*)(Lc + 740); s0 = fmaf(x60, l[0], s0); s1 = fmaf(x61, l[1], s1); s2 = fmaf(x62, l[2], s2); s3 = fmaf(x63, l[3], s3); } x10 = (lane == 10) ? 1.0f : -((s0 + s1) + (s2 + s3)); asm volatile("" : "+v"(x10) : : "memory"); }
    { float s0 = 0.f, s1 = 0.f, s2 = 0.f, s3 = 0.f; { const f32x4 l = *(const LAS f32x4*)(Lc + 620); s2 = fmaf(x10, l[2], s2); s3 = fmaf(x11, l[3], s3); } { const f32x4 l = *(const LAS f32x4*)(Lc + 624); s0 = fmaf(x12, l[0], s0); s1 = fmaf(x13, l[1], s1); s2 = fmaf(x14, l[2], s2); s3 = fmaf(x15, l[3], s3); } { const f32x4 l = *(const LAS f32x4*)(Lc + 628); s0 = fmaf(x16, l[0], s0); s1 = fmaf(x17, l[1], s1); s2 = fmaf(x18, l[2], s2); s3 = fmaf(x19, l[3], s3); } { const f32x4 l = *(const LAS f32x4*)(Lc + 632); s0 = fmaf(x20, l[0], s0); s1 = fmaf(x21, l[1], s1); s2 = fmaf(x22, l[2], s2); s3 = fmaf(x23, l[3], s3); } { const f32x4 l = *(const LAS f32x4*)(Lc + 636); s0 = fmaf(x24, l[0], s0); s1 = fmaf(x25, l[1], s1); s2 = fmaf(x26, l[2], s2); s3 = fmaf(x27, l[3], s3); } { const f32x4 l = *(const LAS f32x4*)(Lc + 640); s0 = fmaf(x28, l[0], s0); s1 = fmaf(x29, l[1], s1); s2 = fmaf(x30, l[2], s2); s3 = fmaf(x31, l[3], s3); } { const f32x4 l = *(const LAS f32x4*)(Lc + 644); s0 = fmaf(x32, l[0], s0); s1 = fmaf(x33, l[1], s1); s2 = fmaf(x34, l[2], s2); s3 = fmaf(x35, l[3], s3); } { const f32x4 l = *(const LAS f32x4*)(Lc + 648); s0 = fmaf(x36, l[0], s0); s1 = fmaf(x37, l[1], s1); s2 = fmaf(x38, l[2], s2); s3 = fmaf(x39, l[3], s3); } { const f32x4 l = *(const LAS f32x4*)(Lc + 652); s0 = fmaf(x40, l[0], s0); s1 = fmaf(x41, l[1], s1); s2 = fmaf(x42, l[2], s2); s3 = fmaf(x43, l[3], s3); } { const f32x4 l = *(const LAS f32x4*)(Lc + 656); s0 = fmaf(x44, l[0], s0); s1 = fmaf(x45, l[1], s1); s2 = fmaf(x46, l[2], s2); s3 = fmaf(x47, l[3], s3); } { const f32x4 l = *(const LAS f32x4*)(Lc + 660); s0 = fmaf(x48, l[0], s0); s1 = fmaf(x49, l[1], s1); s2 = fmaf(x50, l[2], s2); s3 = fmaf(x51, l[3], s3); } { const f32x4 l = *(const LAS f32x4*)(Lc + 664); s0 = fmaf(x52, l[0], s0); s1 = fmaf(x53, l[1], s1); s2 = fmaf(x54, l[2], s2); s3 = fmaf(x55, l[3], s3); } { const f32x4 l = *(const LAS f32x4*)(Lc + 668); s0 = fmaf(x56, l[0], s0); s1 = fmaf(x57, l[1], s1); s2 = fmaf(x58, l[2], s2); s3 = fmaf(x59, l[3], s3); } { const f32x4 l = *(const LAS f32x4*)(Lc + 672); s0 = fmaf(x60, l[0], s0); s1 = fmaf(x61, l[1], s1); s2 = fmaf(x62, l[2], s2); s3 = fmaf(x63, l[3], s3); } x9 = (lane == 9) ? 1.0f : -((s0 + s1) + (s2 + s3)); asm volatile("" : "+v"(x9) : : "memory"); }
    { float s0 = 0.f, s1 = 0.f, s2 = 0.f, s3 = 0.f; { const f32x4 l = *(const LAS f32x4*)(Lc + 552); s1 = fmaf(x9, l[1], s1); s2 = fmaf(x10, l[2], s2); s3 = fmaf(x11, l[3], s3); } { const f32x4 l = *(const LAS f32x4*)(Lc + 556); s0 = fmaf(x12, l[0], s0); s1 = fmaf(x13, l[1], s1); s2 = fmaf(x14, l[2], s2); s3 = fmaf(x15, l[3], s3); } { const f32x4 l = *(const LAS f32x4*)(Lc + 560); s0 = fmaf(x16, l[0], s0); s1 = fmaf(x17, l[1], s1); s2 = fmaf(x18, l[2], s2); s3 = fmaf(x19, l[3], s3); } { const f32x4 l = *(const LAS f32x4*)(Lc + 564); s0 = fmaf(x20, l[0], s0); s1 = fmaf(x21, l[1], s1); s2 = fmaf(x22, l[2], s2); s3 = fmaf(x23, l[3], s3); } { const f32x4 l = *(const LAS f32x4*)(Lc + 568); s0 = fmaf(x24, l[0], s0); s1 = fmaf(x25, l[1], s1); s2 = fmaf(x26, l[2], s2); s3 = fmaf(x27, l[3], s3); } { const f32x4 l = *(const LAS f32x4*)(Lc + 572); s0 = fmaf(x28, l[0], s0); s1 = fmaf(x29, l[1], s1); s2 = fmaf(x30, l[2], s2); s3 = fmaf(x31, l[3], s3); } { const f32x4 l = *(const LAS f32x4*)(Lc + 576); s0 = fmaf(x32, l[0], s0); s1 = fmaf(x33, l[1], s1); s2 = fmaf(x34, l[2], s2); s3 = fmaf(x35, l[3], s3); } { const f32x4 l = *(const LAS f32x4*)(Lc + 580); s0 = fmaf(x36, l[0], s0); s1 = fmaf(x37, l[1], s1); s2 = fmaf(x38, l[2], s2); s3 = fmaf(x39, l[3], s3); } { const f32x4 l = *(const LAS f32x4*)(Lc + 584); s0 = fmaf(x40, l[0], s0); s1 = fmaf(x41, l[1], s1); s2 = fmaf(x42, l[2], s2); s3 = fmaf(x43, l[3], s3); } { const f32x4 l = *(const LAS f32x4*)(Lc + 588); s0 = fmaf(x44, l[0], s0); s1 = fmaf(x45, l[1], s1); s2 = fmaf(x46, l[2], s2); s3 = fmaf(x47, l[3], s3); } { const f32x4 l = *(const LAS f32x4*)(Lc + 592); s0 = fmaf(x48, l[0], s0); s1 = fmaf(x49, l[1], s1); s2 = fmaf(x50, l[2], s2); s3 = fmaf(x51, l[3], s3); } { const f32x4 l = *(const LAS f32x4*)(Lc + 596); s0 = fmaf(x52, l[0], s0); s1 = fmaf(x53, l[1], s1); s2 = fmaf(x54, l[2], s2); s3 = fmaf(x55, l[3], s3); } { const f32x4 l = *(const LAS f32x4*)(Lc + 600); s0 = fmaf(x56, l[0], s0); s1 = fmaf(x57, l[1], s1); s2 = fmaf(x58, l[2], s2); s3 = fmaf(x59, l[3], s3); } { const f32x4 l = *(const LAS f32x4*)(Lc + 604); s0 = fmaf(x60, l[0], s0); s1 = fmaf(x61, l[1], s1); s2 = fmaf(x62, l[2], s2); s3 = fmaf(x63, l[3], s3); } x8 = (lane == 8) ? 1.0f : -((s0 + s1) + (s2 + s3)); asm volatile("" : "+v"(x8) : : "memory"); }
    { float s0 = 0.f, s1 = 0.f, s2 = 0.f, s3 = 0.f; { const f32x4 l = *(const LAS f32x4*)(Lc + 484); s0 = fmaf(x8, l[0], s0); s1 = fmaf(x9, l[1], s1); s2 = fmaf(x10, l[2], s2); s3 = fmaf(x11, l[3], s3); } { const f32x4 l = *(const LAS f32x4*)(Lc + 488); s0 = fmaf(x12, l[0], s0); s1 = fmaf(x13, l[1], s1); s2 = fmaf(x14, l[2], s2); s3 = fmaf(x15, l[3], s3); } { const f32x4 l = *(const LAS f32x4*)(Lc + 492); s0 = fmaf(x16, l[0], s0); s1 = fmaf(x17, l[1], s1); s2 = fmaf(x18, l[2], s2); s3 = fmaf(x19, l[3], s3); } { const f32x4 l = *(const LAS f32x4*)(Lc + 496); s0 = fmaf(x20, l[0], s0); s1 = fmaf(x21, l[1], s1); s2 = fmaf(x22, l[2], s2); s3 = fmaf(x23, l[3], s3); } { const f32x4 l = *(const LAS f32x4*)(Lc + 500); s0 = fmaf(x24, l[0], s0); s1 = fmaf(x25, l[1], s1); s2 = fmaf(x26, l[2], s2); s3 = fmaf(x27, l[3], s3); } { const f32x4 l = *(const LAS f32x4*)(Lc + 504); s0 = fmaf(x28, l[0], s0); s1 = fmaf(x29, l[1], s1); s2 = fmaf(x30, l[2], s2); s3 = fmaf(x31, l[3], s3); } { const f32x4 l = *(const LAS f32x4*)(Lc + 508); s0 = fmaf(x32, l[0], s0); s1 = fmaf(x33, l[1], s1); s2 = fmaf(x34, l[2], s2); s3 = fmaf(x35, l[3], s3); } { const f32x4 l = *(const LAS f32x4*)(Lc + 512); s0 = fmaf(x36, l[0], s0); s1 = fmaf(x37, l[1], s1); s2 = fmaf(x38, l[2], s2); s3 = fmaf(x39, l[3], s3); } { const f32x4 l = *(const LAS f32x4*)(Lc + 516); s0 = fmaf(x40, l[0], s0); s1 = fmaf(x41, l[1], s1); s2 = fmaf(x42, l[2], s2); s3 = fmaf(x43, l[3], s3); } { const f32x4 l = *(const LAS f32x4*)(Lc + 520); s0 = fmaf(x44, l[0], s0); s1 = fmaf(x45, l[1], s1); s2 = fmaf(x46, l[2], s2); s3 = fmaf(x47, l[3], s3); } { const f32x4 l = *(const LAS f32x4*)(Lc + 524); s0 = fmaf(x48, l[0], s0); s1 = fmaf(x49, l[1], s1); s2 = fmaf(x50, l[2], s2); s3 = fmaf(x51, l[3], s3); } { const f32x4 l = *(const LAS f32x4*)(Lc + 528); s0 = fmaf(x52, l[0], s0); s1 = fmaf(x53, l[1], s1); s2 = fmaf(x54, l[2], s2); s3 = fmaf(x55, l[3], s3); } { const f32x4 l = *(const LAS f32x4*)(Lc + 532); s0 = fmaf(x56, l[0], s0); s1 = fmaf(x57, l[1], s1); s2 = fmaf(x58, l[2], s2); s3 = fmaf(x59, l[3], s3); } { const f32x4 l = *(const LAS f32x4*)(Lc + 536); s0 = fmaf(x60, l[0], s0); s1 = fmaf(x61, l[1], s1); s2 = fmaf(x62, l[2], s2); s3 = fmaf(x63, l[3], s3); } x7 = (lane == 7) ? 1.0f : -((s0 + s1) + (s2 + s3)); asm volatile("" : "+v"(x7) : : "memory"); }
    { float s0 = 0.f, s1 = 0.f, s2 = 0.f, s3 = 0.f; { const f32x4 l = *(const LAS f32x4*)(Lc + 412); s3 = fmaf(x7, l[3], s3); } { const f32x4 l = *(const LAS f32x4*)(Lc + 416); s0 = fmaf(x8, l[0], s0); s1 = fmaf(x9, l[1], s1); s2 = fmaf(x10, l[2], s2); s3 = fmaf(x11, l[3], s3); } { const f32x4 l = *(const LAS f32x4*)(Lc + 420); s0 = fmaf(x12, l[0], s0); s1 = fmaf(x13, l[1], s1); s2 = fmaf(x14, l[2], s2); s3 = fmaf(x15, l[3], s3); } { const f32x4 l = *(const LAS f32x4*)(Lc + 424); s0 = fmaf(x16, l[0], s0); s1 = fmaf(x17, l[1], s1); s2 = fmaf(x18, l[2], s2); s3 = fmaf(x19, l[3], s3); } { const f32x4 l = *(const LAS f32x4*)(Lc + 428); s0 = fmaf(x20, l[0], s0); s1 = fmaf(x21, l[1], s1); s2 = fmaf(x22, l[2], s2); s3 = fmaf(x23, l[3], s3); } { const f32x4 l = *(const LAS f32x4*)(Lc + 432); s0 = fmaf(x24, l[0], s0); s1 = fmaf(x25, l[1], s1); s2 = fmaf(x26, l[2], s2); s3 = fmaf(x27, l[3], s3); } { const f32x4 l = *(const LAS f32x4*)(Lc + 436); s0 = fmaf(x28, l[0], s0); s1 = fmaf(x29, l[1], s1); s2 = fmaf(x30, l[2], s2); s3 = fmaf(x31, l[3], s3); } { const f32x4 l = *(const LAS f32x4*)(Lc + 440); s0 = fmaf(x32, l[0], s0); s1 = fmaf(x33, l[1], s1); s2 = fmaf(x34, l[2], s2); s3 = fmaf(x35, l[3], s3); } { const f32x4 l = *(const LAS f32x4*)(Lc + 444); s0 = fmaf(x36, l[0], s0); s1 = fmaf(x37, l[1], s1); s2 = fmaf(x38, l[2], s2); s3 = fmaf(x39, l[3], s3); } { const f32x4 l = *(const LAS f32x4*)(Lc + 448); s0 = fmaf(x40, l[0], s0); s1 = fmaf(x41, l[1], s1); s2 = fmaf(x42, l[2], s2); s3 = fmaf(x43, l[3], s3); } { const f32x4 l = *(const LAS f32x4*)(Lc + 452); s0 = fmaf(x44, l[0], s0); s1 = fmaf(x45, l[1], s1); s2 = fmaf(x46, l[2], s2); s3 = fmaf(x47, l[3], s3); } { const f32x4 l = *(const LAS f32x4*)(Lc + 456); s0 = fmaf(x48, l[0], s0); s1 = fmaf(x49, l[1], s1); s2 = fmaf(x50, l[2], s2); s3 = fmaf(x51, l[3], s3); } { const f32x4 l = *(const LAS f32x4*)(Lc + 460); s0 = fmaf(x52, l[0], s0); s1 = fmaf(x53, l[1], s1); s2 = fmaf(x54, l[2], s2); s3 = fmaf(x55, l[3], s3); } { const f32x4 l = *(const LAS f32x4*)(Lc + 464); s0 = fmaf(x56, l[0], s0); s1 = fmaf(x57, l[1], s1); s2 = fmaf(x58, l[2], s2); s3 = fmaf(x59, l[3], s3); } { const f32x4 l = *(const LAS f32x4*)(Lc + 468); s0 = fmaf(x60, l[0], s0); s1 = fmaf(x61, l[1], s1); s2 = fmaf(x62, l[2], s2); s3 = fmaf(x63, l[3], s3); } x6 = (lane == 6) ? 1.0f : -((s0 + s1) + (s2 + s3)); asm volatile("" : "+v"(x6) : : "memory"); }
    { float s0 = 0.f, s1 = 0.f, s2 = 0.f, s3 = 0.f; { const f32x4 l = *(const LAS f32x4*)(Lc + 344); s2 = fmaf(x6, l[2], s2); s3 = fmaf(x7, l[3], s3); } { const f32x4 l = *(const LAS f32x4*)(Lc + 348); s0 = fmaf(x8, l[0], s0); s1 = fmaf(x9, l[1], s1); s2 = fmaf(x10, l[2], s2); s3 = fmaf(x11, l[3], s3); } { const f32x4 l = *(const LAS f32x4*)(Lc + 352); s0 = fmaf(x12, l[0], s0); s1 = fmaf(x13, l[1], s1); s2 = fmaf(x14, l[2], s2); s3 = fmaf(x15, l[3], s3); } { const f32x4 l = *(const LAS f32x4*)(Lc + 356); s0 = fmaf(x16, l[0], s0); s1 = fmaf(x17, l[1], s1); s2 = fmaf(x18, l[2], s2); s3 = fmaf(x19, l[3], s3); } { const f32x4 l = *(const LAS f32x4*)(Lc + 360); s0 = fmaf(x20, l[0], s0); s1 = fmaf(x21, l[1], s1); s2 = fmaf(x22, l[2], s2); s3 = fmaf(x23, l[3], s3); } { const f32x4 l = *(const LAS f32x4*)(Lc + 364); s0 = fmaf(x24, l[0], s0); s1 = fmaf(x25, l[1], s1); s2 = fmaf(x26, l[2], s2); s3 = fmaf(x27, l[3], s3); } { const f32x4 l = *(const LAS f32x4*)(Lc + 368); s0 = fmaf(x28, l[0], s0); s1 = fmaf(x29, l[1], s1); s2 = fmaf(x30, l[2], s2); s3 = fmaf(x31, l[3], s3); } { const f32x4 l = *(const LAS f32x4*)(Lc + 372); s0 = fmaf(x32, l[0], s0); s1 = fmaf(x33, l[1], s1); s2 = fmaf(x34, l[2], s2); s3 = fmaf(x35, l[3], s3); } { const f32x4 l = *(const LAS f32x4*)(Lc + 376); s0 = fmaf(x36, l[0], s0); s1 = fmaf(x37, l[1], s1); s2 = fmaf(x38, l[2], s2); s3 = fmaf(x39, l[3], s3); } { const f32x4 l = *(const LAS f32x4*)(Lc + 380); s0 = fmaf(x40, l[0], s0); s1 = fmaf(x41, l[1], s1); s2 = fmaf(x42, l[2], s2); s3 = fmaf(x43, l[3], s3); } { const f32x4 l = *(const LAS f32x4*)(Lc + 384); s0 = fmaf(x44, l[0], s0); s1 = fmaf(x45, l[1], s1); s2 = fmaf(x46, l[2], s2); s3 = fmaf(x47, l[3], s3); } { const f32x4 l = *(const LAS f32x4*)(Lc + 388); s0 = fmaf(x48, l[0], s0); s1 = fmaf(x49, l[1], s1); s2 = fmaf(x50, l[2], s2); s3 = fmaf(x51, l[3], s3); } { const f32x4 l = *(const LAS f32x4*)(Lc + 392); s0 = fmaf(x52, l[0], s0); s1 = fmaf(x53, l[1], s1); s2 = fmaf(x54, l[2], s2); s3 = fmaf(x55, l[3], s3); } { const f32x4 l = *(const LAS f32x4*)(Lc + 396); s0 = fmaf(x56, l[0], s0); s1 = fmaf(x57, l[1], s1); s2 = fmaf(x58, l[2], s2); s3 = fmaf(x59, l[3], s3); } { const f32x4 l = *(const LAS f32x4*)(Lc + 400); s0 = fmaf(x60, l[0], s0); s1 = fmaf(x61, l[1], s1); s2 = fmaf(x62, l[2], s2); s3 = fmaf(x63, l[3], s3); } x5 = (lane == 5) ? 1.0f : -((s0 + s1) + (s2 + s3)); asm volatile("" : "+v"(x5) : : "memory"); }
    { float s0 = 0.f, s1 = 0.f, s2 = 0.f, s3 = 0.f; { const f32x4 l = *(const LAS f32x4*)(Lc + 276); s1 = fmaf(x5, l[1], s1); s2 = fmaf(x6, l[2], s2); s3 = fmaf(x7, l[3], s3); } { const f32x4 l = *(const LAS f32x4*)(Lc + 280); s0 = fmaf(x8, l[0], s0); s1 = fmaf(x9, l[1], s1); s2 = fmaf(x10, l[2], s2); s3 = fmaf(x11, l[3], s3); } { const f32x4 l = *(const LAS f32x4*)(Lc + 284); s0 = fmaf(x12, l[0], s0); s1 = fmaf(x13, l[1], s1); s2 = fmaf(x14, l[2], s2); s3 = fmaf(x15, l[3], s3); } { const f32x4 l = *(const LAS f32x4*)(Lc + 288); s0 = fmaf(x16, l[0], s0); s1 = fmaf(x17, l[1], s1); s2 = fmaf(x18, l[2], s2); s3 = fmaf(x19, l[3], s3); } { const f32x4 l = *(const LAS f32x4*)(Lc + 292); s0 = fmaf(x20, l[0], s0); s1 = fmaf(x21, l[1], s1); s2 = fmaf(x22, l[2], s2); s3 = fmaf(x23, l[3], s3); } { const f32x4 l = *(const LAS f32x4*)(Lc + 296); s0 = fmaf(x24, l[0], s0); s1 = fmaf(x25, l[1], s1); s2 = fmaf(x26, l[2], s2); s3 = fmaf(x27, l[3], s3); } { const f32x4 l = *(const LAS f32x4*)(Lc + 300); s0 = fmaf(x28, l[0], s0); s1 = fmaf(x29, l[1], s1); s2 = fmaf(x30, l[2], s2); s3 = fmaf(x31, l[3], s3); } { const f32x4 l = *(const LAS f32x4*)(Lc + 304); s0 = fmaf(x32, l[0], s0); s1 = fmaf(x33, l[1], s1); s2 = fmaf(x34, l[2], s2); s3 = fmaf(x35, l[3], s3); } { const f32x4 l = *(const LAS f32x4*)(Lc + 308); s0 = fmaf(x36, l[0], s0); s1 = fmaf(x37, l[1], s1); s2 = fmaf(x38, l[2], s2); s3 = fmaf(x39, l[3], s3); } { const f32x4 l = *(const LAS f32x4*)(Lc + 312); s0 = fmaf(x40, l[0], s0); s1 = fmaf(x41, l[1], s1); s2 = fmaf(x42, l[2], s2); s3 = fmaf(x43, l[3], s3); } { const f32x4 l = *(const LAS f32x4*)(Lc + 316); s0 = fmaf(x44, l[0], s0); s1 = fmaf(x45, l[1], s1); s2 = fmaf(x46, l[2], s2); s3 = fmaf(x47, l[3], s3); } { const f32x4 l = *(const LAS f32x4*)(Lc + 320); s0 = fmaf(x48, l[0], s0); s1 = fmaf(x49, l[1], s1); s2 = fmaf(x50, l[2], s2); s3 = fmaf(x51, l[3], s3); } { const f32x4 l = *(const LAS f32x4*)(Lc + 324); s0 = fmaf(x52, l[0], s0); s1 = fmaf(x53, l[1], s1); s2 = fmaf(x54, l[2], s2); s3 = fmaf(x55, l[3], s3); } { const f32x4 l = *(const LAS f32x4*)(Lc + 328); s0 = fmaf(x56, l[0], s0); s1 = fmaf(x57, l[1], s1); s2 = fmaf(x58, l[2], s2); s3 = fmaf(x59, l[3], s3); } { const f32x4 l = *(const LAS f32x4*)(Lc + 332); s0 = fmaf(x60, l[0], s0); s1 = fmaf(x61, l[1], s1); s2 = fmaf(x62, l[2], s2); s3 = fmaf(x63, l[3], s3); } x4 = (lane == 4) ? 1.0f : -((s0 + s1) + (s2 + s3)); asm volatile("" : "+v"(x4) : : "memory"); }
    { float s0 = 0.f, s1 = 0.f, s2 = 0.f, s3 = 0.f; { const f32x4 l = *(const LAS f32x4*)(Lc + 208); s0 = fmaf(x4, l[0], s0); s1 = fmaf(x5, l[1], s1); s2 = fmaf(x6, l[2], s2); s3 = fmaf(x7, l[3], s3); } { const f32x4 l = *(const LAS f32x4*)(Lc + 212); s0 = fmaf(x8, l[0], s0); s1 = fmaf(x9, l[1], s1); s2 = fmaf(x10, l[2], s2); s3 = fmaf(x11, l[3], s3); } { const f32x4 l = *(const LAS f32x4*)(Lc + 216); s0 = fmaf(x12, l[0], s0); s1 = fmaf(x13, l[1], s1); s2 = fmaf(x14, l[2], s2); s3 = fmaf(x15, l[3], s3); } { const f32x4 l = *(const LAS f32x4*)(Lc + 220); s0 = fmaf(x16, l[0], s0); s1 = fmaf(x17, l[1], s1); s2 = fmaf(x18, l[2], s2); s3 = fmaf(x19, l[3], s3); } { const f32x4 l = *(const LAS f32x4*)(Lc + 224); s0 = fmaf(x20, l[0], s0); s1 = fmaf(x21, l[1], s1); s2 = fmaf(x22, l[2], s2); s3 = fmaf(x23, l[3], s3); } { const f32x4 l = *(const LAS f32x4*)(Lc + 228); s0 = fmaf(x24, l[0], s0); s1 = fmaf(x25, l[1], s1); s2 = fmaf(x26, l[2], s2); s3 = fmaf(x27, l[3], s3); } { const f32x4 l = *(const LAS f32x4*)(Lc + 232); s0 = fmaf(x28, l[0], s0); s1 = fmaf(x29, l[1], s1); s2 = fmaf(x30, l[2], s2); s3 = fmaf(x31, l[3], s3); } { const f32x4 l = *(const LAS f32x4*)(Lc + 236); s0 = fmaf(x32, l[0], s0); s1 = fmaf(x33, l[1], s1); s2 = fmaf(x34, l[2], s2); s3 = fmaf(x35, l[3], s3); } { const f32x4 l = *(const LAS f32x4*)(Lc + 240); s0 = fmaf(x36, l[0], s0); s1 = fmaf(x37, l[1], s1); s2 = fmaf(x38, l[2], s2); s3 = fmaf(x39, l[3], s3); } { const f32x4 l = *(const LAS f32x4*)(Lc + 244); s0 = fmaf(x40, l[0], s0); s1 = fmaf(x41, l[1], s1); s2 = fmaf(x42, l[2], s2); s3 = fmaf(x43, l[3], s3); } { const f32x4 l = *(const LAS f32x4*)(Lc + 248); s0 = fmaf(x44, l[0], s0); s1 = fmaf(x45, l[1], s1); s2 = fmaf(x46, l[2], s2); s3 = fmaf(x47, l[3], s3); } { const f32x4 l = *(const LAS f32x4*)(Lc + 252); s0 = fmaf(x48, l[0], s0); s1 = fmaf(x49, l[1], s1); s2 = fmaf(x50, l[2], s2); s3 = fmaf(x51, l[3], s3); } { const f32x4 l = *(const LAS f32x4*)(Lc + 256); s0 = fmaf(x52, l[0], s0); s1 = fmaf(x53, l[1], s1); s2 = fmaf(x54, l[2], s2); s3 = fmaf(x55, l[3], s3); } { const f32x4 l = *(const LAS f32x4*)(Lc + 260); s0 = fmaf(x56, l[0], s0); s1 = fmaf(x57, l[1], s1); s2 = fmaf(x58, l[2], s2); s3 = fmaf(x59, l[3], s3); } { const f32x4 l = *(const LAS f32x4*)(Lc + 264); s0 = fmaf(x60, l[0], s0); s1 = fmaf(x61, l[1], s1); s2 = fmaf(x62, l[2], s2); s3 = fmaf(x63, l[3], s3); } x3 = (lane == 3) ? 1.0f : -((s0 + s1) + (s2 + s3)); asm volatile("" : "+v"(x3) : : "memory"); }
    { float s0 = 0.f, s1 = 0.f, s2 = 0.f, s3 = 0.f; { const f32x4 l = *(const LAS f32x4*)(Lc + 136); s3 = fmaf(x3, l[3], s3); } { const f32x4 l = *(const LAS f32x4*)(Lc + 140); s0 = fmaf(x4, l[0], s0); s1 = fmaf(x5, l[1], s1); s2 = fmaf(x6, l[2], s2); s3 = fmaf(x7, l[3], s3); } { const f32x4 l = *(const LAS f32x4*)(Lc + 144); s0 = fmaf(x8, l[0], s0); s1 = fmaf(x9, l[1], s1); s2 = fmaf(x10, l[2], s2); s3 = fmaf(x11, l[3], s3); } { const f32x4 l = *(const LAS f32x4*)(Lc + 148); s0 = fmaf(x12, l[0], s0); s1 = fmaf(x13, l[1], s1); s2 = fmaf(x14, l[2], s2); s3 = fmaf(x15, l[3], s3); } { const f32x4 l = *(const LAS f32x4*)(Lc + 152); s0 = fmaf(x16, l[0], s0); s1 = fmaf(x17, l[1], s1); s2 = fmaf(x18, l[2], s2); s3 = fmaf(x19, l[3], s3); } { const f32x4 l = *(const LAS f32x4*)(Lc + 156); s0 = fmaf(x20, l[0], s0); s1 = fmaf(x21, l[1], s1); s2 = fmaf(x22, l[2], s2); s3 = fmaf(x23, l[3], s3); } { const f32x4 l = *(const LAS f32x4*)(Lc + 160); s0 = fmaf(x24, l[0], s0); s1 = fmaf(x25, l[1], s1); s2 = fmaf(x26, l[2], s2); s3 = fmaf(x27, l[3], s3); } { const f32x4 l = *(const LAS f32x4*)(Lc + 164); s0 = fmaf(x28, l[0], s0); s1 = fmaf(x29, l[1], s1); s2 = fmaf(x30, l[2], s2); s3 = fmaf(x31, l[3], s3); } { const f32x4 l = *(const LAS f32x4*)(Lc + 168); s0 = fmaf(x32, l[0], s0); s1 = fmaf(x33, l[1], s1); s2 = fmaf(x34, l[2], s2); s3 = fmaf(x35, l[3], s3); } { const f32x4 l = *(const LAS f32x4*)(Lc + 172); s0 = fmaf(x36, l[0], s0); s1 = fmaf(x37, l[1], s1); s2 = fmaf(x38, l[2], s2); s3 = fmaf(x39, l[3], s3); } { const f32x4 l = *(const LAS f32x4*)(Lc + 176); s0 = fmaf(x40, l[0], s0); s1 = fmaf(x41, l[1], s1); s2 = fmaf(x42, l[2], s2); s3 = fmaf(x43, l[3], s3); } { const f32x4 l = *(const LAS f32x4*)(Lc + 180); s0 = fmaf(x44, l[0], s0); s1 = fmaf(x45, l[1], s1); s2 = fmaf(x46, l[2], s2); s3 = fmaf(x47, l[3], s3); } { const f32x4 l = *(const LAS f32x4*)(Lc + 184); s0 = fmaf(x48, l[0], s0); s1 = fmaf(x49, l[1], s1); s2 = fmaf(x50, l[2], s2); s3 = fmaf(x51, l[3], s3); } { const f32x4 l = *(const LAS f32x4*)(Lc + 188); s0 = fmaf(x52, l[0], s0); s1 = fmaf(x53, l[1], s1); s2 = fmaf(x54, l[2], s2); s3 = fmaf(x55, l[3], s3); } { const f32x4 l = *(const LAS f32x4*)(Lc + 192); s0 = fmaf(x56, l[0], s0); s1 = fmaf(x57, l[1], s1); s2 = fmaf(x58, l[2], s2); s3 = fmaf(x59, l[3], s3); } { const f32x4 l = *(const LAS f32x4*)(Lc + 196); s0 = fmaf(x60, l[0], s0); s1 = fmaf(x61, l[1], s1); s2 = fmaf(x62, l[2], s2); s3 = fmaf(x63, l[3], s3); } x2 = (lane == 2) ? 1.0f : -((s0 + s1) + (s2 + s3)); asm volatile("" : "+v"(x2) : : "memory"); }
    { float s0 = 0.f, s1 = 0.f, s2 = 0.f, s3 = 0.f; { const f32x4 l = *(const LAS f32x4*)(Lc + 68); s2 = fmaf(x2, l[2], s2); s3 = fmaf(x3, l[3], s3); } { const f32x4 l = *(const LAS f32x4*)(Lc + 72); s0 = fmaf(x4, l[0], s0); s1 = fmaf(x5, l[1], s1); s2 = fmaf(x6, l[2], s2); s3 = fmaf(x7, l[3], s3); } { const f32x4 l = *(const LAS f32x4*)(Lc + 76); s0 = fmaf(x8, l[0], s0); s1 = fmaf(x9, l[1], s1); s2 = fmaf(x10, l[2], s2); s3 = fmaf(x11, l[3], s3); } { const f32x4 l = *(const LAS f32x4*)(Lc + 80); s0 = fmaf(x12, l[0], s0); s1 = fmaf(x13, l[1], s1); s2 = fmaf(x14, l[2], s2); s3 = fmaf(x15, l[3], s3); } { const f32x4 l = *(const LAS f32x4*)(Lc + 84); s0 = fmaf(x16, l[0], s0); s1 = fmaf(x17, l[1], s1); s2 = fmaf(x18, l[2], s2); s3 = fmaf(x19, l[3], s3); } { const f32x4 l = *(const LAS f32x4*)(Lc + 88); s0 = fmaf(x20, l[0], s0); s1 = fmaf(x21, l[1], s1); s2 = fmaf(x22, l[2], s2); s3 = fmaf(x23, l[3], s3); } { const f32x4 l = *(const LAS f32x4*)(Lc + 92); s0 = fmaf(x24, l[0], s0); s1 = fmaf(x25, l[1], s1); s2 = fmaf(x26, l[2], s2); s3 = fmaf(x27, l[3], s3); } { const f32x4 l = *(const LAS f32x4*)(Lc + 96); s0 = fmaf(x28, l[0], s0); s1 = fmaf(x29, l[1], s1); s2 = fmaf(x30, l[2], s2); s3 = fmaf(x31, l[3], s3); } { const f32x4 l = *(const LAS f32x4*)(Lc + 100); s0 = fmaf(x32, l[0], s0); s1 = fmaf(x33, l[1], s1); s2 = fmaf(x34, l[2], s2); s3 = fmaf(x35, l[3], s3); } { const f32x4 l = *(const LAS f32x4*)(Lc + 104); s0 = fmaf(x36, l[0], s0); s1 = fmaf(x37, l[1], s1); s2 = fmaf(x38, l[2], s2); s3 = fmaf(x39, l[3], s3); } { const f32x4 l = *(const LAS f32x4*)(Lc + 108); s0 = fmaf(x40, l[0], s0); s1 = fmaf(x41, l[1], s1); s2 = fmaf(x42, l[2], s2); s3 = fmaf(x43, l[3], s3); } { const f32x4 l = *(const LAS f32x4*)(Lc + 112); s0 = fmaf(x44, l[0], s0); s1 = fmaf(x45, l[1], s1); s2 = fmaf(x46, l[2], s2); s3 = fmaf(x47, l[3], s3); } { const f32x4 l = *(const LAS f32x4*)(Lc + 116); s0 = fmaf(x48, l[0], s0); s1 = fmaf(x49, l[1], s1); s2 = fmaf(x50, l[2], s2); s3 = fmaf(x51, l[3], s3); } { const f32x4 l = *(const LAS f32x4*)(Lc + 120); s0 = fmaf(x52, l[0], s0); s1 = fmaf(x53, l[1], s1); s2 = fmaf(x54, l[2], s2); s3 = fmaf(x55, l[3], s3); } { const f32x4 l = *(const LAS f32x4*)(Lc + 124); s0 = fmaf(x56, l[0], s0); s1 = fmaf(x57, l[1], s1); s2 = fmaf(x58, l[2], s2); s3 = fmaf(x59, l[3], s3); } { const f32x4 l = *(const LAS f32x4*)(Lc + 128); s0 = fmaf(x60, l[0], s0); s1 = fmaf(x61, l[1], s1); s2 = fmaf(x62, l[2], s2); s3 = fmaf(x63, l[3], s3); } x1 = (lane == 1) ? 1.0f : -((s0 + s1) + (s2 + s3)); asm volatile("" : "+v"(x1) : : "memory"); }
    { float s0 = 0.f, s1 = 0.f, s2 = 0.f, s3 = 0.f; { const f32x4 l = *(const LAS f32x4*)(Lc + 0); s1 = fmaf(x1, l[1], s1); s2 = fmaf(x2, l[2], s2); s3 = fmaf(x3, l[3], s3); } { const f32x4 l = *(const LAS f32x4*)(Lc + 4); s0 = fmaf(x4, l[0], s0); s1 = fmaf(x5, l[1], s1); s2 = fmaf(x6, l[2], s2); s3 = fmaf(x7, l[3], s3); } { const f32x4 l = *(const LAS f32x4*)(Lc + 8); s0 = fmaf(x8, l[0], s0); s1 = fmaf(x9, l[1], s1); s2 = fmaf(x10, l[2], s2); s3 = fmaf(x11, l[3], s3); } { const f32x4 l = *(const LAS f32x4*)(Lc + 12); s0 = fmaf(x12, l[0], s0); s1 = fmaf(x13, l[1], s1); s2 = fmaf(x14, l[2], s2); s3 = fmaf(x15, l[3], s3); } { const f32x4 l = *(const LAS f32x4*)(Lc + 16); s0 = fmaf(x16, l[0], s0); s1 = fmaf(x17, l[1], s1); s2 = fmaf(x18, l[2], s2); s3 = fmaf(x19, l[3], s3); } { const f32x4 l = *(const LAS f32x4*)(Lc + 20); s0 = fmaf(x20, l[0], s0); s1 = fmaf(x21, l[1], s1); s2 = fmaf(x22, l[2], s2); s3 = fmaf(x23, l[3], s3); } { const f32x4 l = *(const LAS f32x4*)(Lc + 24); s0 = fmaf(x24, l[0], s0); s1 = fmaf(x25, l[1], s1); s2 = fmaf(x26, l[2], s2); s3 = fmaf(x27, l[3], s3); } { const f32x4 l = *(const LAS f32x4*)(Lc + 28); s0 = fmaf(x28, l[0], s0); s1 = fmaf(x29, l[1], s1); s2 = fmaf(x30, l[2], s2); s3 = fmaf(x31, l[3], s3); } { const f32x4 l = *(const LAS f32x4*)(Lc + 32); s0 = fmaf(x32, l[0], s0); s1 = fmaf(x33, l[1], s1); s2 = fmaf(x34, l[2], s2); s3 = fmaf(x35, l[3], s3); } { const f32x4 l = *(const LAS f32x4*)(Lc + 36); s0 = fmaf(x36, l[0], s0); s1 = fmaf(x37, l[1], s1); s2 = fmaf(x38, l[2], s2); s3 = fmaf(x39, l[3], s3); } { const f32x4 l = *(const LAS f32x4*)(Lc + 40); s0 = fmaf(x40, l[0], s0); s1 = fmaf(x41, l[1], s1); s2 = fmaf(x42, l[2], s2); s3 = fmaf(x43, l[3], s3); } { const f32x4 l = *(const LAS f32x4*)(Lc + 44); s0 = fmaf(x44, l[0], s0); s1 = fmaf(x45, l[1], s1); s2 = fmaf(x46, l[2], s2); s3 = fmaf(x47, l[3], s3); } { const f32x4 l = *(const LAS f32x4*)(Lc + 48); s0 = fmaf(x48, l[0], s0); s1 = fmaf(x49, l[1], s1); s2 = fmaf(x50, l[2], s2); s3 = fmaf(x51, l[3], s3); } { const f32x4 l = *(const LAS f32x4*)(Lc + 52); s0 = fmaf(x52, l[0], s0); s1 = fmaf(x53, l[1], s1); s2 = fmaf(x54, l[2], s2); s3 = fmaf(x55, l[3], s3); } { const f32x4 l = *(const LAS f32x4*)(Lc + 56); s0 = fmaf(x56, l[0], s0); s1 = fmaf(x57, l[1], s1); s2 = fmaf(x58, l[2], s2); s3 = fmaf(x59, l[3], s3); } { const f32x4 l = *(const LAS f32x4*)(Lc + 60); s0 = fmaf(x60, l[0], s0); s1 = fmaf(x61, l[1], s1); s2 = fmaf(x62, l[2], s2); s3 = fmaf(x63, l[3], s3); } x0 = (lane == 0) ? 1.0f : -((s0 + s1) + (s2 + s3)); asm volatile("" : "+v"(x0) : : "memory"); }
    { v4u o; o.x = cvtpk(x0, x1); o.y = cvtpk(x2, x3); o.z = cvtpk(x4, x5); o.w = cvtpk(x6, x7); *(LAS v4u*)(Xs + lane * 72 + 0) = o; }
    { v4u o; o.x = cvtpk(x8, x9); o.y = cvtpk(x10, x11); o.z = cvtpk(x12, x13); o.w = cvtpk(x14, x15); *(LAS v4u*)(Xs + lane * 72 + 8) = o; }
    { v4u o; o.x = cvtpk(x16, x17); o.y = cvtpk(x18, x19); o.z = cvtpk(x20, x21); o.w = cvtpk(x22, x23); *(LAS v4u*)(Xs + lane * 72 + 16) = o; }
    { v4u o; o.x = cvtpk(x24, x25); o.y = cvtpk(x26, x27); o.z = cvtpk(x28, x29); o.w = cvtpk(x30, x31); *(LAS v4u*)(Xs + lane * 72 + 24) = o; }
    { v4u o; o.x = cvtpk(x32, x33); o.y = cvtpk(x34, x35); o.z = cvtpk(x36, x37); o.w = cvtpk(x38, x39); *(LAS v4u*)(Xs + lane * 72 + 32) = o; }
    { v4u o; o.x = cvtpk(x40, x41); o.y = cvtpk(x42, x43); o.z = cvtpk(x44, x45); o.w = cvtpk(x46, x47); *(LAS v4u*)(Xs + lane * 72 + 40) = o; }
    { v4u o; o.x = cvtpk(x48, x49); o.y = cvtpk(x50, x51); o.z = cvtpk(x52, x53); o.w = cvtpk(x54, x55); *(LAS v4u*)(Xs + lane * 72 + 48) = o; }
    { v4u o; o.x = cvtpk(x56, x57); o.y = cvtpk(x58, x59); o.z = cvtpk(x60, x61); o.w = cvtpk(x62, x63); *(LAS v4u*)(Xs + lane * 72 + 56) = o; }
}
#ifndef G1P
#define G1P 15
#endif

#define MF16(a, b, c) __builtin_amdgcn_mfma_f32_16x16x32_bf16((a), (b), (c), 0, 0, 0)
__device__ __forceinline__ bf16x8 ld16g(const bf16* p) { return *(const GAS bf16x8*)p; }
__device__ __forceinline__ float ldbf(const bf16* p) { return __uint_as_float(((unsigned)*(const GAS unsigned short*)p) << 16); }
__device__ __forceinline__ void st8(bf16* p, float a, float b, float c, float d) { u32x2v o; o.x = cvtpk(a, b); o.y = cvtpk(c, d); *(GAS u32x2v*)p = o; }

__device__ __forceinline__ void p_ga(const Frame& F, const Args& a, int L) {
    GAS unsigned char* ws = (GAS unsigned char*)a.ws; asm volatile("" : "+s"(ws)); int lane_ = F.lane; asm volatile("" : "+v"(lane_)); const int j = L >> 1, lane = lane_;
    const bf16* PO = (const bf16*)(ws + WS_ARENA + AR_PO);
    bf16 *QN = (bf16*)(ws + WS_ARENA + AR_QN), *KN = (bf16*)(ws + WS_ARENA + AR_KN), *KGT = (bf16*)(ws + WS_ARENA + AR_KGT), *VBT = (bf16*)(ws + WS_ARENA + AR_VBT), *KTT = (bf16*)(ws + WS_ARENA + AR_KTT);
    float* gbeta = (float*)(ws + WS_GB) + S_ * 8; float* dn = (float*)(ws + WS_TOK + TOK_DN); float* gcs = (float*)(ws + WS_GC);
    const float* cw = (const float*)a.in[16] + (size_t)j * 4 * 3072;
    LAS bf16* tile = (LAS bf16*)(F.lds + F.wave * WAVE_LDS);
    const int dg = lane & 15, ts = lane >> 4, d0 = 8 * dg;
#pragma unroll 1
    for (int tp_ = 2 * F.vcu + (F.wave >> 2); tp_ < 512; tp_ += 2 * F.G) {
        const int u = (4 * (tp_ >> 3) + (F.wave & 3)) * 8 + (tp_ & 7);
        const int n = u >> 3, hh = u & 7, tok0 = 64 * n;
        float sA, sB, sBeta;
        {
            const float ealog = expf(*(const GAS float*)((const float*)a.in[17] + j * 8 + hh)), dtb = *(const GAS float*)((const float*)a.in[18] + j * 8 + hh);
            const float bb = ldbf(PO + (size_t)(tok0 + lane) * OIN + OIN_W + hh), aa = ldbf(PO + (size_t)(tok0 + lane) * OIN + OIN_W + 8 + hh);
            const float beta = sigm(bb); const float zz = aa + dtb; const float gv = -ealog * (zz > 20.f ? zz : log1pf(expf(zz)));
            *(GAS float*)(gbeta + (size_t)(tok0 + lane) * 8 + hh) = beta;
            float gc = gv;
#pragma unroll
            for (int o = 1; o < 64; o <<= 1) { const float t = __shfl_up(gc, o); if (lane >= o) gc += t; }
            const float glast = __shfl(gc, 63);
            *(GAS float*)(gcs + (size_t)(tok0 + lane) * 8 + hh) = gc;
            if (lane == 0) dn[u] = expf(glast);
            sA = beta * expf(gc); sB = expf(glast - gc); sBeta = beta;
        }
#pragma unroll 1
        for (int qkv = 0; qkv < 3; ++qkv) {
            const int coff = qkv * 1024 + hh * 128 + d0;
            float w[4][8];
#pragma unroll
            for (int jj = 0; jj < 4; ++jj)
#pragma unroll
                for (int e = 0; e < 8; ++e) w[jj][e] = *(const GAS float*)(cw + jj * 3072 + coff + e);
            asm volatile("s_waitcnt lgkmcnt(0)" ::: "memory");
#pragma unroll 4
            for (int it = 0; it < 16; ++it) {
                const int i = 4 * it + ts, tok = tok0 + i; float acc[8];
                v4u rv[4];
#pragma unroll
                for (int jj = 0; jj < 4; ++jj) { const int r = tok - 3 + jj; rv[jj] = *(const GAS v4u*)(PO + (size_t)(r < 0 ? 0 : r) * OIN + coff); }
#pragma unroll
                for (int e = 0; e < 8; ++e) acc[e] = 0.f;
#pragma unroll
                for (int jj = 0; jj < 4; ++jj) { const float on = (tok - 3 + jj >= 0) ? 1.0f : 0.0f; const unsigned vv[4] = {rv[jj].x, rv[jj].y, rv[jj].z, rv[jj].w};
#pragma unroll
                    for (int q = 0; q < 4; ++q) { acc[2 * q] += (w[jj][2 * q] * on) * bflo(vv[q]); acc[2 * q + 1] += (w[jj][2 * q + 1] * on) * bfhi(vv[q]); } }
                float ss = 0.f;
#pragma unroll
                for (int e = 0; e < 8; ++e) { acc[e] = silu(acc[e]); ss += acc[e] * acc[e]; }
                ss += __shfl_xor(ss, 1); ss += __shfl_xor(ss, 2); ss += __shfl_xor(ss, 4); ss += __shfl_xor(ss, 8);
                const float rn = __builtin_amdgcn_rsqf(ss + 1e-6f);
                const float s1 = (qkv == 0) ? rn * 0.08838834764831845f : (qkv == 1 ? rn : 1.0f);
                v4u o; o.x = cvtpk(acc[0] * s1, acc[1] * s1); o.y = cvtpk(acc[2] * s1, acc[3] * s1); o.z = cvtpk(acc[4] * s1, acc[5] * s1); o.w = cvtpk(acc[6] * s1, acc[7] * s1);
                if (qkv < 2) *(GAS v4u*)((qkv == 0 ? QN : KN) + (size_t)tok * D_ + hh * 128 + d0) = o;
                if (qkv > 0) *(LAS v4u*)(tile + i * 136 + d0) = o;
            }
            if (qkv == 0) continue;
            asm volatile("s_waitcnt lgkmcnt(0)" ::: "memory");
#pragma unroll 1
            for (int half = 0; half < 2; ++half) {
                const int d = 64 * half + lane; const size_t obase = ((size_t)u * 128 + d) * 64;
                const LAS unsigned short* tp = (const LAS unsigned short*)tile + d;
#pragma unroll
                for (int ig = 0; ig < 8; ++ig) {
                    float o1[8], o2[8];
#pragma unroll
                    for (int e = 0; e < 8; ++e) { const int t = 8 * ig + e; const float v = __uint_as_float(((unsigned)tp[t * 136]) << 16);
                        const float m1 = __builtin_bit_cast(float, __builtin_amdgcn_readlane(__builtin_bit_cast(int, (qkv == 1) ? sA : sBeta), t));
                        const float m2 = __builtin_bit_cast(float, __builtin_amdgcn_readlane(__builtin_bit_cast(int, sB), t));
                        o1[e] = v * m1; o2[e] = v * m2; }
                    v4u o; o.x = cvtpk(o1[0], o1[1]); o.y = cvtpk(o1[2], o1[3]); o.z = cvtpk(o1[4], o1[5]); o.w = cvtpk(o1[6], o1[7]);
                    *(GAS v4u*)((qkv == 1 ? KGT : VBT) + obase + 8 * ig) = o;
                    if (qkv == 1) { o.x = cvtpk(o2[0], o2[1]); o.y = cvtpk(o2[2], o2[3]); o.z = cvtpk(o2[4], o2[5]); o.w = cvtpk(o2[6], o2[7]); *(GAS v4u*)(KTT + obase + 8 * ig) = o; }
                }
            }
        }
    }
}

__device__ __forceinline__ void p_g1(const Frame& F, const Args& a) {
    GAS unsigned char* ws = (GAS unsigned char*)a.ws; asm volatile("" : "+s"(ws)); int lane_ = F.lane; asm volatile("" : "+v"(lane_)); const int lane = lane_, r16 = lane & 15, g = lane >> 4;
    const bf16 *QN = (const bf16*)(ws + WS_ARENA + AR_QN), *KN = (const bf16*)(ws + WS_ARENA + AR_KN), *KGT = (const bf16*)(ws + WS_ARENA + AR_KGT), *VBT = (const bf16*)(ws + WS_ARENA + AR_VBT), *KTT = (const bf16*)(ws + WS_ARENA + AR_KTT);
    bf16 *AI = (bf16*)(ws + WS_ARENA + AR_AI), *NEGW = (bf16*)(ws + WS_ARENA + AR_NEGW), *UT = (bf16*)(ws + WS_ARENA + AR_UT);
    const float* gg = (const float*)(ws + WS_GC); const float* gbeta = (const float*)(ws + WS_GB) + S_ * 8;
    LAS float* Lc = (LAS float*)(F.lds + F.wave * WAVE_LDS);
    LAS bf16* Xs = (LAS bf16*)(F.lds + F.wave * WAVE_LDS);
    const f32x4 Z4 = {0.f, 0.f, 0.f, 0.f};
#ifdef PROBE_G1P
    const int g1p = a.use_bar ? 15 : PROBE_G1P;
#else
    const int g1p = 15;
#endif
#pragma unroll 1
    for (int tp_ = 2 * F.vcu + (F.wave >> 2); tp_ < 512; tp_ += 2 * F.G) {
        const int u = (4 * (tp_ >> 3) + (F.wave & 3)) * 8 + (tp_ & 7);
        const int n = u >> 3, hh = u & 7, tok0 = 64 * n; const int uh = hh * NCHUNK + n;
        const float gc = gg[(size_t)(tok0 + lane) * 8 + hh], beta = gbeta[(size_t)(tok0 + lane) * 8 + hh];
        if (g1p & 1) {
        {
            bf16x8 kf[4][4];
#pragma unroll
            for (int t = 0; t < 4; ++t)
#pragma unroll
                for (int kk = 0; kk < 4; ++kk) kf[t][kk] = ld16g(KN + (size_t)(tok0 + 16 * t + r16) * D_ + hh * 128 + 32 * kk + 8 * g);
#pragma unroll
            for (int ti = 0; ti < 4; ++ti)
#pragma unroll
                for (int tj = 0; tj <= ti; ++tj) {
                    f32x4 Dv = Z4;
#pragma unroll
                    for (int kk = 0; kk < 4; ++kk) Dv = MF16(kf[ti][kk], kf[tj][kk], Dv);
                    const int jx = 16 * tj + r16; const float gcj = __shfl(gc, jx); f32x4 val;
#pragma unroll
                    for (int r = 0; r < 4; ++r) { const int ix = 16 * ti + 4 * g + r; const float gci = __shfl(gc, ix), bi = __shfl(beta, ix); val[r] = (ix > jx) ? bi * Dv[r] * expf(gci - gcj) : 0.f; }
                    *(LAS f32x4*)(Lc + jx * 68 + 16 * ti + 4 * g) = val;
                }
#pragma unroll
            for (int ti = 0; ti < 4; ++ti) {
                bf16x8 qf[4];
#pragma unroll
                for (int kk = 0; kk < 4; ++kk) qf[kk] = ld16g(QN + (size_t)(tok0 + 16 * ti + r16) * D_ + hh * 128 + 32 * kk + 8 * g);
                const int ix = 16 * ti + r16; const float gci = __shfl(gc, ix);
#pragma unroll
                for (int tj = 0; tj < 4; ++tj) {
                    f32x4 val = Z4;
                    if (tj <= ti) {
                        f32x4 Dv = Z4;
#pragma unroll
                        for (int kk = 0; kk < 4; ++kk) Dv = MF16(kf[tj][kk], qf[kk], Dv);
#pragma unroll
                        for (int r = 0; r < 4; ++r) { const int jx = 16 * tj + 4 * g + r; const float gcj = __shfl(gc, jx); val[r] = (ix >= jx) ? Dv[r] * expf(gci - gcj) : 0.f; }
                    }
                    st8(AI + ((size_t)u * 64 + ix) * 64 + 16 * tj + 4 * g, val[0], val[1], val[2], val[3]);
                }
            }
        }
        asm volatile("s_waitcnt lgkmcnt(0)" ::: "memory");
        }
        if (g1p & 2) {
        tri_solve(Lc, Xs, lane);
        }
        if (g1p & 4) {
        asm volatile("s_waitcnt lgkmcnt(0)" ::: "memory");
        {
            bf16x8 xf[4][2];
#pragma unroll
            for (int t = 0; t < 4; ++t)
#pragma unroll
                for (int kk = 0; kk < 2; ++kk) xf[t][kk] = *(const LAS bf16x8*)(Xs + (16 * t + r16) * 72 + 32 * kk + 8 * g);
#pragma unroll 2
            for (int td = 0; td < 8; ++td) {
                const size_t rb = ((size_t)u * 128 + 16 * td + r16) * 64;
                const bf16x8 vb0 = ld16g(VBT + rb + 8 * g), vb1 = ld16g(VBT + rb + 32 + 8 * g), kg0 = ld16g(KGT + rb + 8 * g), kg1 = ld16g(KGT + rb + 32 + 8 * g);
#pragma unroll
                for (int ti = 0; ti < 4; ++ti) {
                    f32x4 Du = MF16(xf[ti][0], vb0, Z4); Du = MF16(xf[ti][1], vb1, Du);
                    st8(UT + rb + 16 * ti + 4 * g, Du[0], Du[1], Du[2], Du[3]);
                    f32x4 Dn = MF16(kg0, xf[ti][0], Z4); Dn = MF16(kg1, xf[ti][1], Dn);
                    st8(NEGW + (size_t)(tok0 + 16 * ti + r16) * D_ + hh * 128 + 16 * td + 4 * g, -Dn[0], -Dn[1], -Dn[2], -Dn[3]);
                }
            }
        }
        }
    }
}

template <int NS, int SGSTEP> __device__ __forceinline__ void p_g2(const Frame& F, const Args& a, const bf16* MPsrc, const bf16* NTsrc, const float* dnsrc) {
    GAS unsigned char* ws = (GAS unsigned char*)a.ws; asm volatile("" : "+s"(ws)); int lane_ = F.lane; asm volatile("" : "+v"(lane_)); const int lane = lane_, r16 = lane & 15, g = lane >> 4, w = F.wave;
    const bf16 *MP = MPsrc, *NT = NTsrc; bf16* SG = (bf16*)(ws + WS_ARENA + AR_SG);
    const float* dn = dnsrc;
    LAS bf16* St = (LAS bf16*)F.lds;
    const int args_use_bar = a.use_bar; (void)args_use_bar;
#pragma unroll 1
    for (int asg = F.vcu; asg < 64; asg += F.G) {
        const int hh = asg >> 3, sl = asg & 7;
        __syncthreads();
        for (int idx = F.tid; idx < 2 * 16 * 136 / 2; idx += NWAVES * 64) ((LAS unsigned*)St)[idx] = 0u;
        __syncthreads();
        if (w >= 4) {
            const int st = F.tid - 256, row = st >> 4, chunk = st & 15;
#pragma unroll 1
            for (int n = 0; n < NS; ++n) {
                const v4u v = *(const LAS v4u*)(St + (n & 1) * (16 * 136) + row * 136 + chunk * 8);
                *(GAS v4u*)(SG + ((size_t)(hh * NCHUNK + n * SGSTEP) * 128 + 16 * sl + row) * 128 + chunk * 8) = v;
                asm volatile("s_waitcnt lgkmcnt(0)" ::: "memory"); __builtin_amdgcn_s_barrier(); asm volatile("" ::: "memory");
            }
        } else {
            f32x4 Sv[2] = {{0.f, 0.f, 0.f, 0.f}, {0.f, 0.f, 0.f, 0.f}};
            bf16x8 A0[2][4], A1[2][4], A2[2][4], A3[2][4]; u32x2v C0[2], C1[2], C2[2], C3[2]; float d0, d1, d2, d3;
#define G2_LOAD(AX, CX, DX, nn) do { const int u_ = hh * NS + (nn); \
            _Pragma("unroll") for (int t = 0; t < 2; ++t) { \
                _Pragma("unroll") for (int kk = 0; kk < 4; ++kk) AX[t][kk] = ld16g(MP + ((size_t)u_ * 128 + 32 * w + 16 * t + r16) * 128 + 32 * kk + 8 * g); \
                CX[t] = *(const GAS u32x2v*)(NT + ((size_t)u_ * 128 + 16 * sl + r16) * 128 + 32 * w + 16 * t + 4 * g); } \
            DX = *(const GAS float*)(dn + (nn) * 8 + hh); } while (0)
#ifdef PROBE_G2_NOLOAD
#define G2_STEPLOAD(AL, CL, DL, nn) do { if (args_use_bar) G2_LOAD(AL, CL, DL, nn); } while (0)
#else
#define G2_STEPLOAD(AL, CL, DL, nn) G2_LOAD(AL, CL, DL, nn)
#endif
#define G2_STEP(AU, CU, DU, AL, CL, DL, nn) do { const int n_ = (nn); const int n2_ = (n_ + 3 < NS) ? n_ + 3 : NS - 1; \
            G2_STEPLOAD(AL, CL, DL, n2_); \
            LAS bf16* Sc = St + (n_ & 1) * (16 * 136); LAS bf16* Sn = St + ((n_ & 1) ^ 1) * (16 * 136); \
            f32x4 D0 = {bflo(CU[0].x), bfhi(CU[0].x), bflo(CU[0].y), bfhi(CU[0].y)}, D1 = {bflo(CU[1].x), bfhi(CU[1].x), bflo(CU[1].y), bfhi(CU[1].y)}; \
            _Pragma("unroll") for (int kk = 0; kk < 4; ++kk) { const bf16x8 Bf = *(const LAS bf16x8*)(Sc + r16 * 136 + 32 * kk + 8 * g); D0 = MF16(AU[0][kk], Bf, D0); D1 = MF16(AU[1][kk], Bf, D1); } \
            Sv[0] = Sv[0] * DU + D0; Sv[1] = Sv[1] * DU + D1; \
            { u32x2v o; o.x = cvtpk(Sv[0][0], Sv[0][1]); o.y = cvtpk(Sv[0][2], Sv[0][3]); *(LAS u32x2v*)(Sn + r16 * 136 + 32 * w + 4 * g) = o; \
              o.x = cvtpk(Sv[1][0], Sv[1][1]); o.y = cvtpk(Sv[1][2], Sv[1][3]); *(LAS u32x2v*)(Sn + r16 * 136 + 32 * w + 16 + 4 * g) = o; } \
            asm volatile("s_waitcnt lgkmcnt(0)" ::: "memory"); __builtin_amdgcn_s_barrier(); asm volatile("" ::: "memory"); } while (0)
            G2_LOAD(A0, C0, d0, 0); G2_LOAD(A1, C1, d1, 1); G2_LOAD(A2, C2, d2, 2);
            static_assert(NS % 24 == 16, "scan loop: trips of 24 steps + a 16-step tail");
            int n = 0;
#pragma unroll 1
            for (; n + 24 <= NS - 16; n += 24) {
                G2_STEP(A0, C0, d0, A3, C3, d3, n + 0);
                G2_STEP(A1, C1, d1, A0, C0, d0, n + 1);
                G2_STEP(A2, C2, d2, A1, C1, d1, n + 2);
                G2_STEP(A3, C3, d3, A2, C2, d2, n + 3);
                G2_STEP(A0, C0, d0, A3, C3, d3, n + 4);
                G2_STEP(A1, C1, d1, A0, C0, d0, n + 5);
                G2_STEP(A2, C2, d2, A1, C1, d1, n + 6);
                G2_STEP(A3, C3, d3, A2, C2, d2, n + 7);
                G2_STEP(A0, C0, d0, A3, C3, d3, n + 8);
                G2_STEP(A1, C1, d1, A0, C0, d0, n + 9);
                G2_STEP(A2, C2, d2, A1, C1, d1, n + 10);
                G2_STEP(A3, C3, d3, A2, C2, d2, n + 11);
                G2_STEP(A0, C0, d0, A3, C3, d3, n + 12);
                G2_STEP(A1, C1, d1, A0, C0, d0, n + 13);
                G2_STEP(A2, C2, d2, A1, C1, d1, n + 14);
                G2_STEP(A3, C3, d3, A2, C2, d2, n + 15);
                G2_STEP(A0, C0, d0, A3, C3, d3, n + 16);
                G2_STEP(A1, C1, d1, A0, C0, d0, n + 17);
                G2_STEP(A2, C2, d2, A1, C1, d1, n + 18);
                G2_STEP(A3, C3, d3, A2, C2, d2, n + 19);
                G2_STEP(A0, C0, d0, A3, C3, d3, n + 20);
                G2_STEP(A1, C1, d1, A0, C0, d0, n + 21);
                G2_STEP(A2, C2, d2, A1, C1, d1, n + 22);
                G2_STEP(A3, C3, d3, A2, C2, d2, n + 23);
            }
            G2_STEP(A0, C0, d0, A3, C3, d3, n + 0);
            G2_STEP(A1, C1, d1, A0, C0, d0, n + 1);
            G2_STEP(A2, C2, d2, A1, C1, d1, n + 2);
            G2_STEP(A3, C3, d3, A2, C2, d2, n + 3);
            G2_STEP(A0, C0, d0, A3, C3, d3, n + 4);
            G2_STEP(A1, C1, d1, A0, C0, d0, n + 5);
            G2_STEP(A2, C2, d2, A1, C1, d1, n + 6);
            G2_STEP(A3, C3, d3, A2, C2, d2, n + 7);
            G2_STEP(A0, C0, d0, A3, C3, d3, n + 8);
            G2_STEP(A1, C1, d1, A0, C0, d0, n + 9);
            G2_STEP(A2, C2, d2, A1, C1, d1, n + 10);
            G2_STEP(A3, C3, d3, A2, C2, d2, n + 11);
            G2_STEP(A0, C0, d0, A3, C3, d3, n + 12);
            G2_STEP(A1, C1, d1, A0, C0, d0, n + 13);
            G2_STEP(A2, C2, d2, A1, C1, d1, n + 14);
            G2_STEP(A3, C3, d3, A2, C2, d2, n + 15);
#undef G2_STEP
#undef G2_LOAD
        }
    }
}


constexpr int GST_W = 64 * 136, GST_K = 128 * 68, GST_PAIR = GST_W + GST_K, GST_BYTES = 2 * GST_PAIR * 2, GW_BYTES = 8704;
static_assert(GST_BYTES + 8 * GW_BYTES <= LDSCTL_OFF, "group-phase LDS map");
__device__ __forceinline__ void g_stage(const Frame& F, const bf16* NEGW, const bf16* KTT, int p, int n, int hh, bool on) {
    LAS bf16* sw = (LAS bf16*)F.lds + p * GST_PAIR; LAS bf16* sk = sw + GST_W;
#pragma unroll
    for (int q = 0; q < 2; ++q) { const int idx = F.tid + 512 * q;
        { const int row = idx >> 4, ch = idx & 15; v4u v = {0u, 0u, 0u, 0u}; if (on) v = *(const GAS v4u*)(NEGW + (size_t)(64 * n + row) * D_ + hh * 128 + ch * 8); *(LAS v4u*)(sw + row * 136 + ch * 8) = v; }
        { const int row = idx >> 3, ch = idx & 7; u32x2v a = {0u, 0u}, b = a; if (on) { const v4u v = *(const GAS v4u*)(KTT + ((size_t)(n * 8 + hh) * 128 + row) * 64 + ch * 8); a.x = v.x; a.y = v.y; b.x = v.z; b.y = v.w; }
          *(LAS u32x2v*)(sk + row * 68 + ch * 8) = a; *(LAS u32x2v*)(sk + row * 68 + ch * 8 + 4) = b; } }
}
template <bool PERM> __device__ __forceinline__ void g_prod1(f32x4 (&T)[4][2], const LAS bf16* sw, const bf16x8 (&xo)[4][2], int r16, int g) {
#pragma unroll
    for (int mt = 0; mt < 4; ++mt) {
        bf16x8 af[4];
#pragma unroll
        for (int s = 0; s < 4; ++s) {
            if (PERM) { const LAS bf16* rp = sw + (16 * mt + r16) * 136 + 32 * s + 4 * g; const u32x2v lo = *(const LAS u32x2v*)rp, hi = *(const LAS u32x2v*)(rp + 16); const v4u pk = {lo.x, lo.y, hi.x, hi.y}; af[s] = __builtin_bit_cast(bf16x8, pk); }
            else af[s] = *(const LAS bf16x8*)(sw + (16 * mt + r16) * 136 + 32 * s + 8 * g); }
#pragma unroll
        for (int nt = 0; nt < 2; ++nt)
#pragma unroll
            for (int s = 0; s < 4; ++s) T[mt][nt] = MF16(af[s], xo[s][nt], T[mt][nt]);
        asm volatile("" ::: "memory");
    }
}
__device__ __forceinline__ void g_prod2(f32x4 (&X)[8][2], const LAS bf16* sk, const f32x4 (&T)[4][2], int r16, int g) {
    bf16x8 to[2][2];
#pragma unroll
    for (int s = 0; s < 2; ++s)
#pragma unroll
        for (int nt = 0; nt < 2; ++nt) { v4u p; p.x = cvtpk(T[2 * s][nt][0], T[2 * s][nt][1]); p.y = cvtpk(T[2 * s][nt][2], T[2 * s][nt][3]); p.z = cvtpk(T[2 * s + 1][nt][0], T[2 * s + 1][nt][1]); p.w = cvtpk(T[2 * s + 1][nt][2], T[2 * s + 1][nt][3]);
            to[s][nt] = __builtin_bit_cast(bf16x8, p); }
#pragma unroll
    for (int mt = 0; mt < 8; ++mt) {
        bf16x8 af[2];
#pragma unroll
        for (int s = 0; s < 2; ++s) { const LAS bf16* rp = sk + (16 * mt + r16) * 68 + 32 * s + 4 * g; const u32x2v lo = *(const LAS u32x2v*)rp, hi = *(const LAS u32x2v*)(rp + 16); const v4u pk = {lo.x, lo.y, hi.x, hi.y}; af[s] = __builtin_bit_cast(bf16x8, pk); }
#pragma unroll
        for (int nt = 0; nt < 2; ++nt)
#pragma unroll
            for (int s = 0; s < 2; ++s) X[mt][nt] = MF16(af[s], to[s][nt], X[mt][nt]);
        asm volatile("" ::: "memory");
    }
}
__device__ __forceinline__ void p_g1b(const Frame& F, const Args& a) {
    GAS unsigned char* ws = (GAS unsigned char*)a.ws; asm volatile("" : "+s"(ws)); int lane_ = F.lane; asm volatile("" : "+v"(lane_)); const int lane = lane_, r16 = lane & 15, g = lane >> 4;
    const bf16 *NEGW = (const bf16*)(ws + WS_ARENA + AR_NEGW), *KTT = (const bf16*)(ws + WS_ARENA + AR_KTT), *UT = (const bf16*)(ws + WS_ARENA + AR_UT); const float* dn = (const float*)(ws + WS_TOK + TOK_DN);
    bf16 *MPc = (bf16*)(ws + WS_ARENA + AR_MPC), *NTc = (bf16*)(ws + WS_ARENA + AR_NTC); float* dnc = (float*)(ws + WS_TOK + TOK_DNC);
    const bool isB = F.wave >= 4; const int sl = F.wave & 3, c0 = 32 * sl;
    const LAS bf16* sw = (const LAS bf16*)F.lds; const LAS bf16* sk = sw + GST_W; LAS bf16* wa = (LAS bf16*)(F.lds + GST_BYTES + F.wave * GW_BYTES);
#pragma unroll 1
    for (int tp = 2 * F.vcu; tp < 512; tp += (tp & 1) ? 2 * F.G - 1 : 1) {
        const int hh = tp & 7, gq = tp >> 3;
        f32x4 X[8][2]; float Dd = 1.0f;
#pragma unroll
        for (int mt = 0; mt < 8; ++mt)
#pragma unroll
            for (int nt = 0; nt < 2; ++nt) X[mt][nt] = (f32x4){0.f, 0.f, 0.f, 0.f};
#pragma unroll 1
        for (int i = 0; i < 4; ++i) {
            const int n = 4 * gq + i; const float di = *(const GAS float*)(dn + n * 8 + hh);
            bf16x8 xo[4][2]; const float dadd = isB ? 0.0f : Dd;
#pragma unroll
            for (int s = 0; s < 4; ++s)
#pragma unroll
                for (int nt = 0; nt < 2; ++nt) { v4u pr; const int col = c0 + 16 * nt + r16; f32x4 t0 = X[2 * s][nt], t1 = X[2 * s + 1][nt];
#pragma unroll
                    for (int r = 0; r < 4; ++r) { if (32 * s + 4 * g + r == col) t0[r] += dadd; if (32 * s + 16 + 4 * g + r == col) t1[r] += dadd; }
                    pr.x = cvtpk(t0[0], t0[1]); pr.y = cvtpk(t0[2], t0[3]); pr.z = cvtpk(t1[0], t1[1]); pr.w = cvtpk(t1[2], t1[3]); xo[s][nt] = __builtin_bit_cast(bf16x8, pr); }
            __syncthreads();
            g_stage(F, NEGW, KTT, 0, n, hh, true);
            f32x4 T[4][2];
#pragma unroll
            for (int mt = 0; mt < 4; ++mt)
#pragma unroll
                for (int nt = 0; nt < 2; ++nt) { T[mt][nt] = (f32x4){0.f, 0.f, 0.f, 0.f};
                    if (isB) { const u32x2v uu = *(const GAS u32x2v*)(UT + ((size_t)(n * 8 + hh) * 128 + c0 + 16 * nt + r16) * 64 + 16 * mt + 4 * g); T[mt][nt] = (f32x4){bflo(uu.x), bfhi(uu.x), bflo(uu.y), bfhi(uu.y)}; } }
            __syncthreads();
            g_prod1<true>(T, sw, xo, r16, g);
#pragma unroll
            for (int mt = 0; mt < 8; ++mt)
#pragma unroll
                for (int nt = 0; nt < 2; ++nt) X[mt][nt] = X[mt][nt] * di;
            g_prod2(X, sk, T, r16, g);
            Dd *= di;
        }
        const int uc = hh * 64 + gq;
        if (isB) {
#pragma unroll
            for (int mt = 0; mt < 8; ++mt)
#pragma unroll
                for (int nt = 0; nt < 2; ++nt) st8(NTc + ((size_t)uc * 128 + c0 + 16 * nt + r16) * 128 + 16 * mt + 4 * g, X[mt][nt][0], X[mt][nt][1], X[mt][nt][2], X[mt][nt][3]);
        } else {
            if (sl == 0 && lane == 0) dnc[gq * 8 + hh] = Dd;
#pragma unroll
            for (int hf = 0; hf < 2; ++hf) {
                asm volatile("s_waitcnt lgkmcnt(0)" ::: "memory");
#pragma unroll
                for (int m4 = 0; m4 < 4; ++m4)
#pragma unroll
                    for (int nt = 0; nt < 2; ++nt)
#pragma unroll
                        for (int r = 0; r < 4; ++r) wa[(16 * m4 + 4 * g + r) * 40 + 16 * nt + r16] = (unsigned short)(cvtpk(X[4 * hf + m4][nt][r], 0.f) & 0xffffu);
                asm volatile("s_waitcnt lgkmcnt(0)" ::: "memory");
#pragma unroll
                for (int q = 0; q < 4; ++q) { const int row = 16 * q + (lane >> 2), ch = lane & 3; const v4u v = *(const LAS v4u*)(wa + row * 40 + ch * 8);
                    *(GAS v4u*)(MPc + ((size_t)uc * 128 + 64 * hf + row) * 128 + c0 + ch * 8) = v; }
            }
        }
    }
    __syncthreads();
}

__device__ __forceinline__ void p_g23(const Frame& F, const Args& a, int L) {
    GAS unsigned char* ws = (GAS unsigned char*)a.ws; asm volatile("" : "+s"(ws)); int lane_ = F.lane; asm volatile("" : "+v"(lane_)); const int lane = lane_, r16 = lane & 15, g = lane >> 4;
    const bf16 *NEGW = (const bf16*)(ws + WS_ARENA + AR_NEGW), *KTT = (const bf16*)(ws + WS_ARENA + AR_KTT), *UT = (const bf16*)(ws + WS_ARENA + AR_UT), *SG = (const bf16*)(ws + WS_ARENA + AR_SG),
               *QN = (const bf16*)(ws + WS_ARENA + AR_QN), *AI = (const bf16*)(ws + WS_ARENA + AR_AI), *PO = (const bf16*)(ws + WS_ARENA + AR_PO);
    const float* gcs = (const float*)(ws + WS_GC);
    const float* dn = (const float*)(ws + WS_TOK + TOK_DN); bf16* mix = (bf16*)(ws + WS_MIX); const float* onorm = (const float*)a.in[19] + (L >> 1) * 128;
    const int pw = F.wave >> 2, qf = F.wave & 3, c0 = 32 * qf;
    const LAS bf16* sw = (const LAS bf16*)F.lds + pw * GST_PAIR; const LAS bf16* sk = sw + GST_W; LAS bf16* Sl = (LAS bf16*)(F.lds + GST_BYTES + F.wave * GW_BYTES);
    LAS float* xch = (LAS float*)(F.lds + RT_OFF);
#pragma unroll 1
    for (int tp0 = 2 * F.vcu; tp0 < 512; tp0 += 2 * F.G) {
        const int tp = tp0 + pw; const bool on = tp < 512; const int tpc = on ? tp : 0, hh = tpc & 7, gq = tpc >> 3;
        const int tpa = tp0, tpb = (tp0 + 1 < 512) ? tp0 + 1 : 0;
        { const int u0 = hh * NCHUNK + 4 * gq;
#pragma unroll
          for (int q = 0; q < 8; ++q) { const int row = 4 * q + (lane >> 4), ch = lane & 15; const v4u v = *(const GAS v4u*)(SG + ((size_t)u0 * 128 + c0 + row) * 128 + ch * 8); *(LAS v4u*)(Sl + row * 136 + ch * 8) = v; } }
#pragma unroll 1
        for (int i = 0; i < 4; ++i) {
            __syncthreads();
            g_stage(F, NEGW, KTT, 0, 4 * (tpa >> 3) + i, tpa & 7, tpa < 512); g_stage(F, NEGW, KTT, 1, 4 * (tpb >> 3) + i, tpb & 7, tp0 + 1 < 512);
            const int n = 4 * gq + i, u = n * 8 + hh, tok0 = 64 * n; const float di = *(const GAS float*)(dn + n * 8 + hh);
            f32x4 T[4][2];
#pragma unroll
            for (int mt = 0; mt < 4; ++mt)
#pragma unroll
                for (int nt = 0; nt < 2; ++nt) { const u32x2v uu = *(const GAS u32x2v*)(UT + ((size_t)u * 128 + c0 + 16 * nt + r16) * 64 + 16 * mt + 4 * g); T[mt][nt] = (f32x4){bflo(uu.x), bfhi(uu.x), bflo(uu.y), bfhi(uu.y)}; }
            asm volatile("s_waitcnt lgkmcnt(0)" ::: "memory");
            bf16x8 Bf[4][2];
#pragma unroll
            for (int nt = 0; nt < 2; ++nt)
#pragma unroll
                for (int s = 0; s < 4; ++s) Bf[s][nt] = *(const LAS bf16x8*)(Sl + (16 * nt + r16) * 136 + 32 * s + 8 * g);
            __syncthreads();
            g_prod1<false>(T, sw, Bf, r16, g);
            bf16x8 vo[2][2];
#pragma unroll
            for (int s = 0; s < 2; ++s)
#pragma unroll
                for (int nt = 0; nt < 2; ++nt) { v4u p; p.x = cvtpk(T[2 * s][nt][0], T[2 * s][nt][1]); p.y = cvtpk(T[2 * s][nt][2], T[2 * s][nt][3]); p.z = cvtpk(T[2 * s + 1][nt][0], T[2 * s + 1][nt][1]); p.w = cvtpk(T[2 * s + 1][nt][2], T[2 * s + 1][nt][3]);
                    vo[s][nt] = __builtin_bit_cast(bf16x8, p); }
            f32x4 o[2][4];
#pragma unroll
            for (int it = 0; it < 4; ++it) {
                const int tok = tok0 + 16 * it + r16; bf16x8 qfr[4], afr[2];
                { const float eg = expf(*(const GAS float*)(gcs + (size_t)tok * 8 + hh));
#pragma unroll
                  for (int s = 0; s < 4; ++s) { const v4u qv = *(const GAS v4u*)(QN + (size_t)tok * D_ + hh * 128 + 32 * s + 8 * g); v4u qs;
                      qs.x = cvtpk(bflo(qv.x) * eg, bfhi(qv.x) * eg); qs.y = cvtpk(bflo(qv.y) * eg, bfhi(qv.y) * eg); qs.z = cvtpk(bflo(qv.z) * eg, bfhi(qv.z) * eg); qs.w = cvtpk(bflo(qv.w) * eg, bfhi(qv.w) * eg);
                      qfr[s] = __builtin_bit_cast(bf16x8, qs); } }
#pragma unroll
                for (int s = 0; s < 2; ++s) { const bf16* ap = AI + ((size_t)u * 64 + 16 * it + r16) * 64 + 32 * s + 4 * g; const u32x2v lo = *(const GAS u32x2v*)ap, hi = *(const GAS u32x2v*)(ap + 16);
                    const v4u pk = {lo.x, lo.y, hi.x, hi.y}; afr[s] = __builtin_bit_cast(bf16x8, pk); }
#pragma unroll
                for (int nt = 0; nt < 2; ++nt) { f32x4 Dv = {0.f, 0.f, 0.f, 0.f};
#pragma unroll
                    for (int s = 0; s < 4; ++s) Dv = MF16(Bf[s][nt], qfr[s], Dv);
#pragma unroll
                    for (int s = 0; s < 2; ++s) Dv = MF16(vo[s][nt], afr[s], Dv);
                    o[nt][it] = Dv; }
            }
            __syncthreads();
#pragma unroll
            for (int it = 0; it < 4; ++it) { float ss = 0.f;
#pragma unroll
                for (int nt = 0; nt < 2; ++nt) ss += (o[nt][it][0] * o[nt][it][0] + o[nt][it][1] * o[nt][it][1]) + (o[nt][it][2] * o[nt][it][2] + o[nt][it][3] * o[nt][it][3]);
                ss += __shfl_xor(ss, 16); ss += __shfl_xor(ss, 32);
                if (g == 0) xch[(pw * 4 + qf) * 64 + 16 * it + r16] = ss; }
            __syncthreads();
#pragma unroll
            for (int it = 0; it < 4; ++it) { const int ti = 16 * it + r16, tok = tok0 + ti;
                const float ssq = (xch[(pw * 4 + 0) * 64 + ti] + xch[(pw * 4 + 1) * 64 + ti]) + (xch[(pw * 4 + 2) * 64 + ti] + xch[(pw * 4 + 3) * 64 + ti]);
                const float rms = __builtin_amdgcn_rsqf(ssq * (1.0f / 128.0f) + RMS_EPS);
#pragma unroll
                for (int nt = 0; nt < 2; ++nt) { const int col = c0 + 16 * nt + 4 * g;
                    const u32x2v z = *(const GAS u32x2v*)(PO + (size_t)tok * OIN + 3072 + hh * 128 + col); const f32x4 gn = *(const GAS f32x4*)(onorm + col);
                    if (on) st8(mix + (size_t)tok * D_ + hh * 128 + col, o[nt][it][0] * rms * gn[0] * silu(bflo(z.x)), o[nt][it][1] * rms * gn[1] * silu(bfhi(z.x)),
                                o[nt][it][2] * rms * gn[2] * silu(bflo(z.y)), o[nt][it][3] * rms * gn[3] * silu(bfhi(z.y))); } }
            if (i < 3) {
                f32x4 acc[8][2];
#pragma unroll
                for (int mt = 0; mt < 8; ++mt)
#pragma unroll
                    for (int nt = 0; nt < 2; ++nt) { const u32x2v so = *(const LAS u32x2v*)(Sl + (16 * nt + r16) * 136 + 16 * mt + 4 * g); acc[mt][nt] = (f32x4){di * bflo(so.x), di * bfhi(so.x), di * bflo(so.y), di * bfhi(so.y)}; }
                g_prod2(acc, sk, T, r16, g);
                asm volatile("s_waitcnt lgkmcnt(0)" ::: "memory");
#pragma unroll
                for (int mt = 0; mt < 8; ++mt)
#pragma unroll
                    for (int nt = 0; nt < 2; ++nt) { u32x2v ov; ov.x = cvtpk(acc[mt][nt][0], acc[mt][nt][1]); ov.y = cvtpk(acc[mt][nt][2], acc[mt][nt][3]); *(LAS u32x2v*)(Sl + (16 * nt + r16) * 136 + 16 * mt + 4 * g) = ov; }
            }
        }
    }
    __syncthreads();
}

__device__ __forceinline__ void p_r1(const Frame& F, const Args& a, int L) {
    GAS unsigned char* ws = (GAS unsigned char*)a.ws; asm volatile("" : "+s"(ws)); int lane_ = F.lane; asm volatile("" : "+v"(lane_)); const int j = L >> 1, lane = lane_;
    const float* ssq = (const float*)(ws + WS_SSQA); const float* wr = (const float*)a.in[24] + (size_t)j * D_ * NEXP; const float* ln = (const float*)a.in[4] + L * D_;
    int* tok_e = (int*)(ws + WS_TOK + TOK_E); int* tok_r = (int*)(ws + WS_TOK + TOK_R); float* tok_g = (float*)(ws + WS_TOK + TOK_G);
    unsigned* gcount = (unsigned*)(ws + WS_CTL) + CW_CNT + 64 * j;
    LAS int* rt = (LAS int*)(F.lds + RT_OFF);
    if (F.tid < 16) rt[F.tid] = 0;
    __syncthreads();
    const GAS unsigned short* hB = (const GAS unsigned short*)(ws + WS_HBF); const GAS float* wrG = (const GAS float*)wr; const GAS float* lnG = (const GAS float*)ln;
    float lnr[16];
#pragma unroll
    for (int i = 0; i < 16; ++i) lnr[i] = lnG[64 * i + lane];
#pragma unroll 1
    for (int t = F.gw; t < S_; t += 2 * F.NGW) {
        const int tb = t + F.NGW; const bool hasb = tb < S_; const int tbc = hasb ? tb : t;
        float xa[16], xb[16];
#pragma unroll
        for (int i = 0; i < 16; ++i) { xa[i] = __uint_as_float(((unsigned)hB[(size_t)t * D_ + 64 * i + lane]) << 16); xb[i] = __uint_as_float(((unsigned)hB[(size_t)tbc * D_ + 64 * i + lane]) << 16); }
        const float rsa = pg8::rstd_row(ssq, t), rsb = pg8::rstd_row(ssq, tbc);
        float acca[8], accb[8];
#pragma unroll
        for (int e = 0; e < 8; ++e) { acca[e] = 0.f; accb[e] = 0.f; }
#pragma unroll
        for (int i = 0; i < 16; ++i) { const int k = 64 * i + lane; const f32x4 w0 = *(const GAS f32x4*)(wrG + (size_t)k * 8), w1 = *(const GAS f32x4*)(wrG + (size_t)k * 8 + 4);
            const float x = xa[i] * lnr[i], y = xb[i] * lnr[i];
            acca[0] += x * w0[0]; acca[1] += x * w0[1]; acca[2] += x * w0[2]; acca[3] += x * w0[3]; acca[4] += x * w1[0]; acca[5] += x * w1[1]; acca[6] += x * w1[2]; acca[7] += x * w1[3];
            accb[0] += y * w0[0]; accb[1] += y * w0[1]; accb[2] += y * w0[2]; accb[3] += y * w0[3]; accb[4] += y * w1[0]; accb[5] += y * w1[1]; accb[6] += y * w1[2]; accb[7] += y * w1[3]; }
#pragma unroll
        for (int e = 0; e < 8; ++e) { acca[e] = wave_sum(acca[e]) * rsa; accb[e] = wave_sum(accb[e]) * rsb; }
#pragma unroll
        for (int half = 0; half < 2; ++half) {
            if (half == 1 && !hasb) break;
            const int tt = half ? tb : t; float acc[8];
#pragma unroll
            for (int e = 0; e < 8; ++e) acc[e] = half ? accb[e] : acca[e];
            int e0 = 0; float l0 = acc[0];
#pragma unroll
            for (int e = 1; e < 8; ++e) if (acc[e] > l0) { l0 = acc[e]; e0 = e; }
            int e1 = -1; float l1 = -INFINITY;
#pragma unroll
            for (int e = 0; e < 8; ++e) if (e != e0 && acc[e] > l1) { l1 = acc[e]; e1 = e; }
            const float g1 = 1.0f / (1.0f + expf(l0 - l1)), g0 = 1.0f - g1;
            if (lane == 0) {
                const int r0 = __hip_atomic_fetch_add(rt + e0, 1, __ATOMIC_RELAXED, __HIP_MEMORY_SCOPE_WORKGROUP), r1 = __hip_atomic_fetch_add(rt + e1, 1, __ATOMIC_RELAXED, __HIP_MEMORY_SCOPE_WORKGROUP);
                tok_e[2 * tt] = e0; tok_e[2 * tt + 1] = e1; tok_r[2 * tt] = r0; tok_r[2 * tt + 1] = r1; tok_g[2 * tt] = g0; tok_g[2 * tt + 1] = g1;
            }
        }
    }
    __syncthreads();
    if (F.tid < 8) rt[8 + F.tid] = (int)__hip_atomic_fetch_add(gcount + F.tid, (unsigned)rt[F.tid], __ATOMIC_RELAXED, __HIP_MEMORY_SCOPE_AGENT);
    __syncthreads();
#pragma unroll 1
    for (int t = F.gw; t < S_; t += F.NGW) if (lane < 2) { const int e = tok_e[2 * t + lane]; tok_r[2 * t + lane] += rt[8 + e]; }
    __syncthreads();
}
__device__ __forceinline__ int moe_pstart(const unsigned* gcount, int e) {
    int ps = 0;
#pragma unroll
    for (int q = 0; q < 8; ++q) { const int c = (int)gcount[q]; if (q < e) ps += ((c + 255) >> 8) << 8; }
    return ps;
}
__device__ __forceinline__ void p_r2(const Frame& F, const Args& a, int L) {
    GAS unsigned char* ws = (GAS unsigned char*)a.ws; asm volatile("" : "+s"(ws)); int lane_ = F.lane; asm volatile("" : "+v"(lane_)); const int j = L >> 1, lane = lane_;
    const float* ssq = (const float*)(ws + WS_SSQA);
    const int* tok_e = (const int*)(ws + WS_TOK + TOK_E); const int* tok_r = (const int*)(ws + WS_TOK + TOK_R); const float* tok_g = (const float*)(ws + WS_TOK + TOK_G);
    int* dst = (int*)(ws + WS_TOK + TOK_DST); float* gpad = (float*)(ws + WS_TOK + TOK_GPAD);
    const unsigned* gcount = (const unsigned*)(ws + WS_CTL) + CW_CNT + 64 * j; bf16* XS = (bf16*)(ws + WS_ARENA + AR_XS);
    int pst[8]; { int ps = 0;
#pragma unroll
        for (int q = 0; q < 8; ++q) { pst[q] = ps; ps += (((int)gcount[q] + 255) >> 8) << 8; } }
    const GAS unsigned short* hB = (const GAS unsigned short*)(ws + WS_HBF);
#pragma unroll 1
    for (int t0 = F.gw; t0 < S_; t0 += 4 * F.NGW) {
        int tt[4], da[4], db[4]; float rs[4], ga[4], gb[4]; u32x2v v[4][4];
#pragma unroll
        for (int u = 0; u < 4; ++u) { const int t = t0 + u * F.NGW; tt[u] = t < S_ ? t : t0;
#pragma unroll
            for (int q = 0; q < 4; ++q) v[u][q] = *((const GAS u32x2v*)(hB + (size_t)tt[u] * D_) + 64 * q + lane); }
#pragma unroll
        for (int u = 0; u < 4; ++u) { const int t = tt[u]; rs[u] = pg8::rstd_row(ssq, t);
            const int ea = tok_e[2 * t], eb = tok_e[2 * t + 1]; int pa = 0, pb = 0;
#pragma unroll
            for (int q = 0; q < 8; ++q) { pa = (q == ea) ? pst[q] : pa; pb = (q == eb) ? pst[q] : pb; }
            da[u] = pa + tok_r[2 * t]; db[u] = pb + tok_r[2 * t + 1]; ga[u] = tok_g[2 * t]; gb[u] = tok_g[2 * t + 1]; }
#pragma unroll
        for (int u = 0; u < 4; ++u) { if (t0 + u * F.NGW >= S_) break; const int t = tt[u];
            if (lane == 0) { dst[2 * t] = da[u]; dst[2 * t + 1] = db[u]; gpad[da[u]] = ga[u]; gpad[db[u]] = gb[u]; }
#pragma unroll
            for (int q = 0; q < 4; ++q) { u32x2v o; o.x = cvtpk(bflo(v[u][q].x) * rs[u], bfhi(v[u][q].x) * rs[u]); o.y = cvtpk(bflo(v[u][q].y) * rs[u], bfhi(v[u][q].y) * rs[u]);
                *((GAS u32x2v*)(XS + (size_t)da[u] * D_) + 64 * q + lane) = o; *((GAS u32x2v*)(XS + (size_t)db[u] * D_) + 64 * q + lane) = o; } }
    }
}
__device__ __forceinline__ int moe_blocks(const Frame& F, const Args& a, int L) {
    const unsigned* gcount = (const unsigned*)(a.ws + WS_CTL) + CW_CNT + 64 * (L >> 1);
    LAS int* blk = (LAS int*)(F.lds + BLKE_OFF);
    int nb_tot = 0, mine = 7;
#pragma unroll
    for (int q = 0; q < 8; ++q) { const int nb = ((int)gcount[q] + 255) >> 8; if (F.tid >= nb_tot && F.tid < nb_tot + nb) mine = q; nb_tot += nb; }
    __syncthreads();
    if (F.tid < 160) blk[F.tid] = mine;
    __syncthreads();
    return nb_tot;
}
__device__ __forceinline__ void p_combine(const Frame& F, const Args& a) {
    GAS unsigned char* ws = (GAS unsigned char*)a.ws; asm volatile("" : "+s"(ws)); int lane_ = F.lane; asm volatile("" : "+v"(lane_)); const int lane = lane_;
    const int* dst = (const int*)(ws + WS_TOK + TOK_DST); const bf16* Y = (const bf16*)(ws + WS_ARENA + AR_Y); bf16* hb = (bf16*)(ws + WS_HBF); float* ssq = (float*)(ws + WS_SSQA);
#pragma unroll 1
    for (int t0 = F.gw; t0 < S_; t0 += 2 * F.NGW) {
        int tt[2], da[2], db[2]; u32x2v v[2][4]; u32x2v ya[2][4], yb[2][4];
#pragma unroll
        for (int u = 0; u < 2; ++u) { const int t = t0 + u * F.NGW; tt[u] = t < S_ ? t : t0; da[u] = dst[2 * tt[u]]; db[u] = dst[2 * tt[u] + 1];
#pragma unroll
            for (int q = 0; q < 4; ++q) v[u][q] = *((const GAS u32x2v*)(hb + (size_t)tt[u] * D_) + 64 * q + lane); }
#pragma unroll
        for (int u = 0; u < 2; ++u)
#pragma unroll
            for (int q = 0; q < 4; ++q) { ya[u][q] = *((const GAS u32x2v*)(Y + (size_t)da[u] * D_) + 64 * q + lane); yb[u][q] = *((const GAS u32x2v*)(Y + (size_t)db[u] * D_) + 64 * q + lane); }
#pragma unroll
        for (int u = 0; u < 2; ++u) { if (t0 + u * F.NGW >= S_) break; const int t = tt[u]; float ss = 0.f;
#pragma unroll
            for (int q = 0; q < 4; ++q) { f32x4 x = {bflo(v[u][q].x), bfhi(v[u][q].x), bflo(v[u][q].y), bfhi(v[u][q].y)};
                x[0] += bflo(ya[u][q].x) + bflo(yb[u][q].x); x[1] += bfhi(ya[u][q].x) + bfhi(yb[u][q].x); x[2] += bflo(ya[u][q].y) + bflo(yb[u][q].y); x[3] += bfhi(ya[u][q].y) + bfhi(yb[u][q].y);
                ss += (x[0] * x[0] + x[1] * x[1]) + (x[2] * x[2] + x[3] * x[3]);
                u32x2v o; o.x = cvtpk(x[0], x[1]); o.y = cvtpk(x[2], x[3]); *((GAS u32x2v*)(hb + (size_t)t * D_) + 64 * q + lane) = o; }
            ss = wave_sum(ss);
            if (lane < 16) ssq[(size_t)t * 16 + lane] = (lane == 0) ? ss : 0.f; }
    }
}
__device__ __forceinline__ void p_final(const Frame& F, const Args& a) {
    GAS unsigned char* ws = (GAS unsigned char*)a.ws; asm volatile("" : "+s"(ws)); int lane_ = F.lane; asm volatile("" : "+v"(lane_)); const int lane = lane_; const float* ssq = (const float*)(ws + WS_SSQB); const float* ln = (const float*)a.in[6]; const bf16* hb = (const bf16*)(ws + WS_HBF);
#pragma unroll 1
    for (int t = F.gw; t < S_; t += F.NGW) { const float rs = pg8::rstd_row(ssq, t);
#pragma unroll
        for (int q = 0; q < 4; ++q) { const u32x2v hv = *((const GAS u32x2v*)(hb + (size_t)t * D_) + 64 * q + lane); const f32x4 gq = *((const GAS f32x4*)ln + 64 * q + lane);
            const f32x4 x = {bflo(hv.x), bfhi(hv.x), bflo(hv.y), bfhi(hv.y)}; *((GAS f32x4*)(a.out + (size_t)t * D_) + 64 * q + lane) = x * rs * gq; } }
}
__device__ __forceinline__ void p_moe_weights(const Frame& F, const Args& a, int L, int w0, int nw, int part) {
    LAS float* scr = (LAS float*)(F.lds + F.wave * WAVE_LDS);
    int base = 0;
#pragma unroll 1
    for (int id = 0; id < 24; ++id) { if (part >= 0 && (((id % 3) == 2) != (part == 1))) continue; const MatD m = moe_mat(a, L >> 1, id);
        int first = (w0 - base) % nw; if (first < 0) first += nw;
#pragma unroll 1
        for (int it = first; it < m.items; it += nw) xpose_item(m.W, m.ldw, m.K, m.N, m.gain, m.WT, m.ilv, scr, it, F.lane);
        base += m.items; }
}

constexpr int P_PRO = 0, P_FINAL = 81, LP_ROT = 16, LP_G1B = 17, LP_G2B = 18, LPN = 20, LP_PROJ = 0, LP_ATT = 1, LP_MIXPREP = 2, LP_GA = 3, LP_G1 = 4, LP_G2 = 5, LP_G3 = 6, LP_OUT = 7, LP_UP = 8, LP_DOWN = 9, LP_R1 = 10, LP_R2 = 11, LP_M1 = 12, LP_M2 = 13, LP_COMB = 14, LP_PLE = 15;

#ifndef PH_MASK
#define PH_MASK 0xffffffffull
#endif
#define IN(k) (lo <= (k) && (k) < hi)
#define INL(lp) ((((unsigned long long)(PH_MASK) >> (lp)) & 1) && lo <= pb + (lp) && pb + (lp) < hi)
#define SEAM() do { if (args.use_bar) xcd_barrier(bar); } while (0)
#ifndef REP_LP
#define REP_LP -1
#endif
#ifndef REP_L
#define REP_L -1
#endif
#ifndef REP_N
#define REP_N 2
#endif
#define REPS(lp) ((L == (REP_L) && (lp) == (REP_LP)) ? 1 + (REP_N) : 1)
#if REP_LP >= 0
#define REPLOOP(lp) _Pragma("unroll 1") for (int rep_ = 0; rep_ < REPS(lp); ++rep_)
#else
#define REPLOOP(lp)
#endif
#define PHASE_WS() GAS unsigned char* ws = (GAS unsigned char*)ws0; asm volatile("" : "+s"(ws)); bf16* HBF = (bf16*)(ws + WS_HBF); bf16* MIX = (bf16*)(ws + WS_MIX); bf16* PP = (bf16*)(ws + WS_PP); float* SSQA = (float*)(ws + WS_SSQA); float* SSQB = (float*)(ws + WS_SSQB); (void)HBF; (void)MIX; (void)PP; (void)SSQA; (void)SSQB
template <int L> __device__ __forceinline__ void run_layer(const Frame& F, const Args& args, unsigned char* lds, const XcdBarrier& bar, unsigned char* ws0, const int lo, const int hi, const int cid) {
        const int pb = 1 + LPN * L, j = L >> 1; const bool odd = (L & 1) != 0;
        REPLOOP(LP_PROJ) if (INL(LP_PROJ)) { PHASE_WS();
            if (!odd) {
                pg8::Gemm gm{HBF, (const bf16*)(ws + WS_WINE) + (size_t)j * EIN * D_, S_, EIN, D_, 0}; pg8::StaticOrder So; So.init(S_, EIN, F.G, cid);
                pg8::EpiBf16 E{(bf16*)(ws + WS_ARENA + AR_PE), EIN, SSQB, pg8::C2, 512};
                pg8::gemm_phase<pg8::EpiBf16, pg8::StaticOrder, true, true>(F.lds + RING_OFF, gm, So, E);
            } else {
                pg8::Gemm gm{HBF, (const bf16*)(ws + WS_WINO) + (size_t)j * OIN * D_, S_, OIN, D_, 0}; pg8::StaticOrder So; So.init(S_, OIN, F.G, cid);
                pg8::EpiBf16 E{(bf16*)(ws + WS_ARENA + AR_PO), OIN, SSQB, 1.0f, 0};
                pg8::gemm_phase<pg8::EpiBf16, pg8::StaticOrder, true, true>(F.lds + RING_OFF, gm, So, E);
            }
            {
                pg8::Gemm gm{(const bf16*)(ws + WS_PBF) + (size_t)L * S_ * PLE, (const bf16*)(ws + WS_WP) + (size_t)L * D_ * PLE, S_, D_, PLE, 0}; pg8::StaticOrder So; So.init(S_, D_, F.G, cid);
                pg8::EpiBf16 E{PP, D_, nullptr, 1.0f, 0};
                pg8::gemm_phase<pg8::EpiBf16, pg8::StaticOrder, true, true>(F.lds + RING_OFF, gm, So, E);
            }
            SEAM();
        }
        if (!odd) {
            REPLOOP(LP_ROT) if (INL(LP_ROT)) { PHASE_WS(); p_rot(F, args); SEAM(); }
            REPLOOP(LP_ATT) if (INL(LP_ATT)) { PHASE_WS(); attn_body::attn_phase<8>((char*)lds + RING_OFF, (const attn_body::bf16*)(ws + WS_ARENA + AR_PE), (attn_body::bf16*)(ws + WS_ARENA + AR_AO), F.vcu, F.G); SEAM(); }
            REPLOOP(LP_MIXPREP) if (INL(LP_MIXPREP)) { PHASE_WS(); p_mixprep(F, args, L); SEAM(); }
        } else {
            REPLOOP(LP_GA) if (INL(LP_GA)) { PHASE_WS();
#ifdef PROBE_GSEL
                const int gsel = args.use_bar ? 7 : PROBE_GSEL;
#else
                const int gsel = 7;
#endif
                if (gsel & 1) p_ga(F, args, L); asm volatile("s_waitcnt vmcnt(0)" ::: "memory"); __syncthreads(); if (gsel & 2) p_g1(F, args); asm volatile("s_waitcnt vmcnt(0)" ::: "memory"); __syncthreads(); if (gsel & 4) p_g1b(F, args); SEAM(); }
            REPLOOP(LP_G2) if (INL(LP_G2)) { PHASE_WS();
                const int nscan = F.G < 64 ? F.G : 64;
#ifdef PROBE_NOCONV
                if (!args.use_bar) { if (F.vcu < nscan) p_g2<64, 4>(F, args, (const bf16*)(ws + WS_ARENA + AR_MPC), (const bf16*)(ws + WS_ARENA + AR_NTC), (const float*)(ws + WS_TOK + TOK_DNC)); } else
#endif
#ifdef PROBE_NOSCAN
                if (!args.use_bar) { if (F.vcu >= nscan) p_moe_weights(F, args, L, (F.vcu - nscan) * NWAVES + F.wave, (F.G - nscan) * NWAVES, -1); } else
#endif
                if (F.vcu < nscan) p_g2<64, 4>(F, args, (const bf16*)(ws + WS_ARENA + AR_MPC), (const bf16*)(ws + WS_ARENA + AR_NTC), (const float*)(ws + WS_TOK + TOK_DNC));
                else p_moe_weights(F, args, L, (F.vcu - nscan) * NWAVES + F.wave, (F.G - nscan) * NWAVES, -1);
                if (F.G <= 64) p_moe_weights(F, args, L, F.gw, F.NGW, -1);
                SEAM();
            }
            REPLOOP(LP_G3) if (INL(LP_G3)) { PHASE_WS(); p_g23(F, args, L); SEAM(); }
        }
        REPLOOP(LP_OUT) if (INL(LP_OUT)) { PHASE_WS();
            const bf16* Wo = odd ? (const bf16*)(ws + WS_WOUTO) + (size_t)j * D_ * D_ : (const bf16*)(ws + WS_WOUTE) + (size_t)j * D_ * D_;
            pg8::Gemm gm{MIX, Wo, S_, D_, D_, 0}; pg8::StaticOrder So; So.init(S_, D_, F.G, cid);
            pg8::EpiResid E{HBF, SSQA};
            pg8::gemm_phase<pg8::EpiResid, pg8::StaticOrder, true, true>(F.lds + RING_OFF, gm, So, E);
            SEAM();
        }
        if (!odd) {
            REPLOOP(LP_UP) if (INL(LP_UP)) { PHASE_WS();
                pg8::Gemm gm{HBF, (const bf16*)(ws + WS_W13D) + (size_t)j * 2 * DFF * D_, S_, 2 * DFF, D_, 0}; pg8::StaticOrder So; So.init(S_, 2 * DFF, F.G, cid);
                pg8::EpiSwiglu E{(bf16*)(ws + WS_ARENA + AR_ACT), SSQA};
                pg8::gemm_phase<pg8::EpiSwiglu, pg8::StaticOrder, true, true>(F.lds + RING_OFF, gm, So, E);
                SEAM();
            }
            REPLOOP(LP_DOWN) if (INL(LP_DOWN)) { PHASE_WS();
                pg8::Gemm gm{(const bf16*)(ws + WS_ARENA + AR_ACT), (const bf16*)(ws + WS_W2D) + (size_t)j * D_ * DFF, S_, D_, DFF, 0}; pg8::StaticOrder So; So.init(S_, D_, F.G, cid);
                pg8::EpiResid E{HBF, SSQA};
                pg8::gemm_phase<pg8::EpiResid, pg8::StaticOrder, true, true>(F.lds + RING_OFF, gm, So, E);
                SEAM();
            }
        } else {
            REPLOOP(LP_R1) if (INL(LP_R1)) { PHASE_WS(); p_r1(F, args, L); SEAM(); }
            REPLOOP(LP_R2) if (INL(LP_R2)) { PHASE_WS(); p_r2(F, args, L); SEAM(); }
            REPLOOP(LP_M1) if (INL(LP_M1)) { PHASE_WS();
                const int nb = moe_blocks(F, args, L);
                pg8::Gemm gm{(const bf16*)(ws + WS_ARENA + AR_XS), (const bf16*)(ws + WS_W13M), nb * 256, 2 * DFF, D_, (size_t)2 * DFF * D_ * 2}; pg8::MoeOrder So; So.init(nb * 256, 2 * DFF, F.G, cid); So.blk_e = (const LAS int*)(F.lds + BLKE_OFF);
                pg8::EpiSwiglu E{(bf16*)(ws + WS_ARENA + AR_ACT), nullptr};
                pg8::gemm_phase<pg8::EpiSwiglu, pg8::MoeOrder, true, true>(F.lds + RING_OFF, gm, So, E);
                SEAM();
            }
            REPLOOP(LP_M2) if (INL(LP_M2)) { PHASE_WS();
                const int nb = moe_blocks(F, args, L);
                pg8::Gemm gm{(const bf16*)(ws + WS_ARENA + AR_ACT), (const bf16*)(ws + WS_W2M), nb * 256, D_, DFF, (size_t)D_ * DFF * 2}; pg8::MoeOrder So; So.init(nb * 256, D_, F.G, cid); So.blk_e = (const LAS int*)(F.lds + BLKE_OFF);
                pg8::EpiMoeDown E{(bf16*)(ws + WS_ARENA + AR_Y), (const float*)(ws + WS_TOK + TOK_GPAD)};
                pg8::gemm_phase<pg8::EpiMoeDown, pg8::MoeOrder, true, true>(F.lds + RING_OFF, gm, So, E);
                SEAM();
            }
            REPLOOP(LP_COMB) if (INL(LP_COMB)) { PHASE_WS(); p_combine(F, args); SEAM(); }
        }
        REPLOOP(LP_PLE) if (INL(LP_PLE)) { PHASE_WS();
            pg8::Gemm gm{HBF, (const bf16*)(ws + WS_WG) + (size_t)L * D_ * D_, S_, D_, D_, 0}; pg8::StaticOrder So; So.init(S_, D_, F.G, cid);
            pg8::EpiPle E{HBF, SSQA, SSQB, PP};
            pg8::gemm_phase<pg8::EpiPle, pg8::StaticOrder, true, true>(F.lds + RING_OFF, gm, So, E);
            SEAM();
        }
    }

__global__ void __launch_bounds__(NWAVES * 64, 2) fwd(Args args) {
    extern __shared__ __attribute__((aligned(16))) unsigned char lds[];
    Frame F;
    F.lds = (LAS unsigned char*)lds; F.tid = threadIdx.x; F.lane = F.tid & 63; F.wave = __builtin_amdgcn_readfirstlane(F.tid >> 6);
    F.G = gridDim.x; { const int bx = blockIdx.x; F.vcu = (F.G % 8 == 0) ? (bx % 8) * (F.G / 8) + bx / 8 : bx; }
    F.gw = F.vcu * NWAVES + F.wave; F.NGW = F.G * NWAVES;
    unsigned char* ws0 = args.ws;
    for (int u = F.tid; u < (LDS_BYTES - LDSCTL_OFF) / 4; u += NWAVES * 64) ((LAS unsigned*)(F.lds + LDSCTL_OFF))[u] = 0u;
    __syncthreads();
    XcdBarrier bar; bar.bar = (unsigned*)(ws0 + WS_CTL) + CW_BAR; bar.x = 0; bar.st = nullptr;
    if (args.use_bar) bar = xcd_barrier_post((unsigned*)(ws0 + WS_CTL) + CW_BAR, (volatile LAS unsigned*)(F.lds + MISC_OFF));
    const int lo = args.ph_lo, hi = args.ph_hi;
    const int cid = (int)blockIdx.x;

    if ((((unsigned long long)(PH_MASK) >> 30) & 1) && IN(P_PRO)) { p_prologue(F, args); SEAM(); }

#ifdef FIXED_L
    run_layer<FIXED_L>(F, args, lds, bar, ws0, lo, hi, cid);
#else
    run_layer<0>(F, args, lds, bar, ws0, lo, hi, cid); run_layer<1>(F, args, lds, bar, ws0, lo, hi, cid); run_layer<2>(F, args, lds, bar, ws0, lo, hi, cid); run_layer<3>(F, args, lds, bar, ws0, lo, hi, cid);
#endif
    if ((((unsigned long long)(PH_MASK) >> 31) & 1) && IN(P_FINAL)) p_final(F, args);
#undef IN
#undef INL
#undef SEAM
}


#ifndef DBG
#define DBG 0
#endif
#if DBG
#ifndef DBG_ASLOT
#define DBG_ASLOT 9
#endif
#ifndef DBG_BSLOT
#define DBG_BSLOT 11
#endif
__global__ void dbg_scan(const void* p, size_t n, int is_f32, unsigned* slot) {
    unsigned cnt = 0;
    for (size_t i = (size_t)blockIdx.x * blockDim.x + threadIdx.x; i < n; i += (size_t)gridDim.x * blockDim.x) {
        const float v = is_f32 ? ((const float*)p)[i] : __uint_as_float(((unsigned)((const unsigned short*)p)[i]) << 16);
        if (!(fabsf(v) < 1e30f)) ++cnt; }
    if (cnt) atomicAdd(slot, cnt);
}
__global__ void dbg_fill(float* out, size_t n, const unsigned* slots, int nslots) {
    int first = -1; for (int i = 0; i < nslots; ++i) if (slots[i]) { first = i; break; }
    float c, V;
    if (first >= 0) { c = sqrtf((float)(10 + first) * 1e6f); V = c; }
    else { const float ea = fmaxf(__uint_as_float(slots[256 + DBG_ASLOT]), 1e-5f), eb = fmaxf(__uint_as_float(slots[256 + DBG_BSLOT]), 1e-5f);
        c = sqrtf((10.f + fminf(60.f, rintf(10.f * (log10f(ea) + 5.f)))) * 1e4f); V = (50.f + rintf(10.f * log10f(eb))) * 1e3f; }
    for (size_t i = (size_t)blockIdx.x * blockDim.x + threadIdx.x; i < n; i += (size_t)gridDim.x * blockDim.x) out[i] = (i == 0) ? V : c;
}
__device__ __forceinline__ float dbg_bf(const unsigned short* p, size_t i) { return __uint_as_float(((unsigned)p[i]) << 16); }
__device__ __forceinline__ float dbg_rstd(const float* ssq, int row) { float s = 0.f; for (int i = 0; i < 16; ++i) s += ssq[(size_t)row * 16 + i]; return 1.0f / sqrtf(s / 1024.0f + 1e-6f); }
__device__ __forceinline__ float dbg_blocksum(float v, float* red) {
    __syncthreads(); red[threadIdx.x] = v; __syncthreads();
    for (int o = 128; o > 0; o >>= 1) { if ((int)threadIdx.x < o) red[threadIdx.x] += red[threadIdx.x + o]; __syncthreads(); }
    const float r = red[0]; __syncthreads(); return r;
}
__device__ __forceinline__ void dbg_report(unsigned* slot, float num, float den) { if (threadIdx.x == 0) atomicMax(slot, __float_as_uint(sqrtf(num / fmaxf(den, 1e-20f)))); }
__global__ void chk_ffn(const float* hpre, const float* hpost, const float* ssq, const float* ln, const float* wr, const float* w1, const float* w3, const float* w2, int moe, unsigned* slot) {
    __shared__ float xn[1024]; __shared__ float hid[3584]; __shared__ float red[256]; __shared__ float lg[8];
    const int t = (blockIdx.x * 997 + 13) % S_, tid = threadIdx.x;
    const float rs = dbg_rstd(ssq, t);
    for (int k = tid; k < 1024; k += 256) xn[k] = hpre[(size_t)t * 1024 + k] * rs * ln[k];
    __syncthreads();
    int e0 = 0, e1 = 0; float g0 = 1.f, g1 = 0.f;
    if (moe) {
        if (tid < 8) { float s = 0.f; for (int k = 0; k < 1024; ++k) s += xn[k] * wr[(size_t)k * 8 + tid]; lg[tid] = s; }
        __syncthreads();
        float l0 = lg[0]; for (int e = 1; e < 8; ++e) if (lg[e] > l0) { l0 = lg[e]; e0 = e; }
        float l1 = -1e30f; e1 = -1; for (int e = 0; e < 8; ++e) if (e != e0 && lg[e] > l1) { l1 = lg[e]; e1 = e; }
        const float m0 = expf(l0 - l0), m1 = expf(l1 - l0); g0 = m0 / (m0 + m1); g1 = m1 / (m0 + m1);
    }
    float acc[4] = {0.f, 0.f, 0.f, 0.f};
    for (int pass = 0; pass < (moe ? 2 : 1); ++pass) {
        const int e = pass == 0 ? e0 : e1; const float gt = pass == 0 ? g0 : g1;
        const float* W1 = w1 + (size_t)e * 1024 * 3584; const float* W3 = w3 + (size_t)e * 1024 * 3584; const float* W2 = w2 + (size_t)e * 3584 * 1024;
        __syncthreads();
        for (int f = tid; f < 3584; f += 256) { float a = 0.f, b = 0.f; for (int k = 0; k < 1024; ++k) { a += xn[k] * W1[(size_t)k * 3584 + f]; b += xn[k] * W3[(size_t)k * 3584 + f]; } hid[f] = a / (1.f + expf(-a)) * b; }
        __syncthreads();
        for (int q = 0; q < 4; ++q) { const int c = tid + 256 * q; float y = 0.f; for (int f = 0; f < 3584; ++f) y += hid[f] * W2[(size_t)f * 1024 + c]; acc[q] += gt * y; }
    }
    float num = 0.f, den = 0.f;
    for (int q = 0; q < 4; ++q) { const int c = tid + 256 * q; const float ex = acc[q], got = hpost[(size_t)t * 1024 + c] - hpre[(size_t)t * 1024 + c]; num += (got - ex) * (got - ex); den += ex * ex; }
    num = dbg_blocksum(num, red); den = dbg_blocksum(den, red);
    dbg_report(slot, num, den);
}
__global__ void chk_ple(const float* hpre, const float* hpost, const float* ssq, const float* ln, const float* wg, const float* p, const float* wp, unsigned* slot) {
    __shared__ float xn[1024]; __shared__ float red[256];
    const int t = (blockIdx.x * 997 + 13) % S_, tid = threadIdx.x; const float rs = dbg_rstd(ssq, t);
    for (int k = tid; k < 1024; k += 256) xn[k] = hpre[(size_t)t * 1024 + k] * rs * ln[k];
    __syncthreads();
    float num = 0.f, den = 0.f;
    for (int q = 0; q < 4; ++q) { const int c = tid + 256 * q; float a = 0.f, b = 0.f; for (int k = 0; k < 1024; ++k) a += xn[k] * wg[(size_t)k * 1024 + c]; for (int k = 0; k < 256; ++k) b += p[(size_t)t * 256 + k] * wp[(size_t)k * 1024 + c];
        const float ex = b / (1.f + expf(-a)), got = hpost[(size_t)t * 1024 + c] - hpre[(size_t)t * 1024 + c]; num += (got - ex) * (got - ex); den += ex * ex; }
    num = dbg_blocksum(num, red); den = dbg_blocksum(den, red); dbg_report(slot, num, den);
}
constexpr int DBG_TC = 512;
__global__ void chk_gdn_proj(const float* h, const float* ssq, const float* ln, const float* W, int hh, float* raw) {
    const int idx = blockIdx.x * blockDim.x + threadIdx.x; if (idx >= DBG_TC * 514) return;
    const int t = idx / 514, c = idx % 514;
    const int col = c < 128 ? hh * 128 + c : c < 256 ? 1024 + hh * 128 + (c - 128) : c < 384 ? 2048 + hh * 128 + (c - 256) : c < 512 ? 3072 + hh * 128 + (c - 384) : c == 512 ? 4096 + hh : 4104 + hh;
    const float rs = dbg_rstd(ssq, t); float s = 0.f;
    for (int k = 0; k < 1024; ++k) s += h[(size_t)t * 1024 + k] * ln[k] * W[(size_t)k * OIN_SRC + col];
    raw[(size_t)t * 514 + c] = s * rs;
}
__global__ void chk_gdn_rec(const float* raw, const float* cw, const float* alog, const float* dtb, const float* onorm, int hh, const unsigned short* mix, unsigned* slot) {
    extern __shared__ float sm[];
    float* Sm = sm; float* q = sm + 128 * 129; float* kk = q + 128; float* v = kk + 128; float* kv = v + 128; float* dl = kv + 128; float* o = dl + 128; float* red = o + 128;
    const int tid = threadIdx.x;
    for (int i = tid; i < 128 * 129; i += 256) Sm[i] = 0.f;
    __syncthreads();
    float worst = 0.f;
    for (int t = 0; t < DBG_TC; ++t) {
        if (tid < 128) { const int d = tid; float aq = 0.f, ak = 0.f, av = 0.f;
            for (int jj = 0; jj < 4; ++jj) { const int r = t - 3 + jj; if (r >= 0) { aq += cw[jj * 3072 + hh * 128 + d] * raw[(size_t)r * 514 + d]; ak += cw[jj * 3072 + 1024 + hh * 128 + d] * raw[(size_t)r * 514 + 128 + d]; av += cw[jj * 3072 + 2048 + hh * 128 + d] * raw[(size_t)r * 514 + 256 + d]; } }
            q[d] = aq / (1.f + expf(-aq)); kk[d] = ak / (1.f + expf(-ak)); v[d] = av / (1.f + expf(-av)); }
        __syncthreads();
        const float sq = dbg_blocksum(tid < 128 ? q[tid] * q[tid] : 0.f, red), sk = dbg_blocksum(tid < 128 ? kk[tid] * kk[tid] : 0.f, red);
        if (tid < 128) { q[tid] *= 1.0f / sqrtf(sq + 1e-6f) * 0.08838834764831845f; kk[tid] *= 1.0f / sqrtf(sk + 1e-6f); }
        const float bb = raw[(size_t)t * 514 + 512], aa = raw[(size_t)t * 514 + 513];
        const float beta = 1.f / (1.f + expf(-bb)); const float z = aa + dtb[hh]; const float g = -expf(alog[hh]) * (z > 20.f ? z : log1pf(expf(z))); const float alpha = expf(g);
        __syncthreads();
        for (int i = tid; i < 128 * 128; i += 256) { const int d = i >> 7, j = i & 127; Sm[d * 129 + j] *= alpha; }
        __syncthreads();
        if (tid < 128) { float s = 0.f; for (int d = 0; d < 128; ++d) s += kk[d] * Sm[d * 129 + tid]; dl[tid] = beta * (v[tid] - s); }
        __syncthreads();
        for (int i = tid; i < 128 * 128; i += 256) { const int d = i >> 7, j = i & 127; Sm[d * 129 + j] += kk[d] * dl[j]; }
        __syncthreads();
        if (tid < 128) { float s = 0.f; for (int d = 0; d < 128; ++d) s += q[d] * Sm[d * 129 + tid]; o[tid] = s; }
        __syncthreads();
        const float so = dbg_blocksum(tid < 128 ? o[tid] * o[tid] : 0.f, red); const float rms = 1.0f / sqrtf(so / 128.f + 1e-6f);
        float num = 0.f, den = 0.f;
        if (tid < 128) { const float zz = raw[(size_t)t * 514 + 384 + tid]; const float ex = o[tid] * rms * onorm[tid] * (zz / (1.f + expf(-zz))); const float got = dbg_bf(mix, (size_t)t * 1024 + hh * 128 + tid); num = (got - ex) * (got - ex); den = ex * ex; }
        num = dbg_blocksum(num, red); den = dbg_blocksum(den, red);
        worst = fmaxf(worst, sqrtf(num / fmaxf(den, 1e-20f)));
    }
    if (tid == 0) atomicMax(slot, __float_as_uint(worst));
}

__global__ void chk_even_kv(const float* h, const float* ssq, const float* ln, const float* W, float* KV) {
    const size_t idx = (size_t)blockIdx.x * blockDim.x + threadIdx.x; if (idx >= (size_t)S_ * 1024) return;
    const int t = (int)(idx >> 10), c = (int)(idx & 1023); const float rs = dbg_rstd(ssq, t); float s = 0.f;
    for (int k = 0; k < 1024; ++k) s += h[(size_t)t * 1024 + k] * ln[k] * W[(size_t)k * EIN + 512 + c];
    KV[idx] = s * rs;
}
__global__ void chk_even_mix(const float* h, const float* ssq, const float* ln, const float* W, const float* KV, const int* pos, const float* lq1, const float* lk1, const float* lq2, const float* lk2, const float* subg, const float* cw,
                             float lam0, const unsigned short* PE, const unsigned short* AO, const unsigned short* MIXb, unsigned* slot) {
    __shared__ float q[2][64]; __shared__ float p[128]; __shared__ float red[256]; __shared__ float o2[2][128]; __shared__ float hn[1024];
    const int toks[6] = {5, 200, 1000, 4097, 9000, 16383};
    const int t = toks[blockIdx.x / 4], hh = blockIdx.x % 4, tid = threadIdx.x;
    auto bsum = [&](float v) { __syncthreads(); red[tid] = v; __syncthreads(); for (int o = 64; o > 0; o >>= 1) { if (tid < o) red[tid] += red[tid + o]; __syncthreads(); } const float r = red[0]; __syncthreads(); return r; };
    auto bmax = [&](float v) { __syncthreads(); red[tid] = v; __syncthreads(); for (int o = 64; o > 0; o >>= 1) { if (tid < o) red[tid] = fmaxf(red[tid], red[tid + o]); __syncthreads(); } const float r = red[0]; __syncthreads(); return r; };
    auto invf = [&](int i) { return exp2f(-(float)i * (18.931568569324174f / 8.0f)); };
    const float rs = dbg_rstd(ssq, t);
    for (int k = tid; k < 1024; k += 128) hn[k] = h[(size_t)t * 1024 + k] * rs * ln[k];
    __syncthreads();
    { const int m = tid >> 6, d = tid & 63, col = (2 * hh + m) * 64 + d; float s = 0.f; for (int k = 0; k < 1024; ++k) s += hn[k] * W[(size_t)k * EIN + col]; q[m][d] = s; }
    __syncthreads();
    float qr;
    { const int m = tid >> 6, d = tid & 63; float v = q[m][d];
      if (d < 16) { const int i = d & 7; const float ang = (float)pos[t] * invf(i); const float c = cosf(ang), s = sinf(ang); v = d < 8 ? q[m][d] * c - q[m][d + 8] * s : q[m][d] * c + q[m][d - 8] * s; }
      qr = v * pg8::C2; }
    __syncthreads(); q[tid >> 6][tid & 63] = qr; __syncthreads();
    float num = 0.f, den = 0.f;
    { const int m = tid >> 6, d = tid & 63; const float got = dbg_bf(PE, (size_t)t * EIN + (2 * hh + m) * 64 + d); const float e2 = (got - qr) * (got - qr), r2 = qr * qr; num += e2; den += r2;
      const float na = bsum(d >= 16 ? e2 : 0.f), da = bsum(d >= 16 ? r2 : 0.f), nb = bsum(d < 16 ? e2 : 0.f), db = bsum(d < 16 ? r2 : 0.f);
      if (tid == 0) { atomicMax(slot + 4, __float_as_uint(sqrtf(na / fmaxf(da, 1e-20f)))); atomicMax(slot + 5, __float_as_uint(sqrtf(nb / fmaxf(db, 1e-20f)))); } }
    { const int m = tid >> 6, d = tid & 63; const float* kr = KV + (size_t)t * 1024 + (2 * hh + m) * 64; float v = kr[d];
      if (d < 16) { const int i = d & 7; const float ang = (float)pos[t] * invf(i); const float c = cosf(ang), s = sinf(ang); v = d < 8 ? kr[d] * c - kr[d + 8] * s : kr[d] * c + kr[d - 8] * s; }
      const float got = dbg_bf(PE, (size_t)t * EIN + 512 + (2 * hh + m) * 64 + d); const float e2 = (got - v) * (got - v), r2 = v * v; num += e2; den += r2;
      const float na = bsum(d >= 16 ? e2 : 0.f), da = bsum(d >= 16 ? r2 : 0.f), nb = bsum(d < 16 ? e2 : 0.f), db = bsum(d < 16 ? r2 : 0.f);
      const float vv = KV[(size_t)t * 1024 + 512 + hh * 128 + tid], gv = dbg_bf(PE, (size_t)t * EIN + 1024 + hh * 128 + tid); const float e3 = (gv - vv) * (gv - vv), r3 = vv * vv; num += e3; den += r3;
      const float nc = bsum(e3), dc = bsum(r3);
      if (tid == 0) { atomicMax(slot + 6, __float_as_uint(sqrtf(na / fmaxf(da, 1e-20f)))); atomicMax(slot + 7, __float_as_uint(sqrtf(nb / fmaxf(db, 1e-20f)))); atomicMax(slot + 8, __float_as_uint(sqrtf(nc / fmaxf(dc, 1e-20f)))); } }
    num = bsum(num); den = bsum(den); if (tid == 0) atomicMax(slot + 0, __float_as_uint(sqrtf(num / fmaxf(den, 1e-20f))));
    for (int m = 0; m < 2; ++m) {
        float mx = -1e30f;
        for (int j0 = 0; j0 <= t; j0 += 128) { const int j = j0 + tid; float s = -1e30f;
            if (j <= t) { const float* kr = KV + (size_t)j * 1024 + (2 * hh + m) * 64; s = 0.f;
                for (int d = 0; d < 64; ++d) { float kv = kr[d]; if (d < 16) { const int i = d & 7; const float ang = (float)pos[j] * invf(i); const float c = cosf(ang), sn = sinf(ang); kv = d < 8 ? kr[d] * c - kr[d + 8] * sn : kr[d] * c + kr[d - 8] * sn; } s += q[m][d] * kv; } }
            mx = fmaxf(mx, s); }
        mx = bmax(mx);
        float l = 0.f, acc = 0.f;
        for (int j0 = 0; j0 <= t; j0 += 128) { const int j = j0 + tid; float pe = 0.f;
            if (j <= t) { const float* kr = KV + (size_t)j * 1024 + (2 * hh + m) * 64; float s = 0.f;
                for (int d = 0; d < 64; ++d) { float kv = kr[d]; if (d < 16) { const int i = d & 7; const float ang = (float)pos[j] * invf(i); const float c = cosf(ang), sn = sinf(ang); kv = d < 8 ? kr[d] * c - kr[d + 8] * sn : kr[d] * c + kr[d - 8] * sn; } s += q[m][d] * kv; }
                pe = exp2f(s - mx); }
            __syncthreads(); p[tid] = pe; __syncthreads();
            l += pe;
            const int nj = min(128, t + 1 - j0);
            for (int i = 0; i < nj; ++i) acc += p[i] * KV[(size_t)(j0 + i) * 1024 + 512 + hh * 128 + tid]; }
        l = bsum(l);
        o2[m][tid] = acc / l;
    }
    __syncthreads();
    { float n2 = 0.f, d2 = 0.f;
      for (int m = 0; m < 2; ++m) { const float ex = o2[m][tid], got = dbg_bf(AO, (size_t)t * 1024 + hh * 256 + m * 128 + tid); n2 += (got - ex) * (got - ex); d2 += ex * ex; }
      n2 = bsum(n2); d2 = bsum(d2); if (tid == 0) atomicMax(slot + 1, __float_as_uint(sqrtf(n2 / fmaxf(d2, 1e-20f)))); }
    float s1 = 0.f, s2 = 0.f; for (int i = 0; i < 64; ++i) { s1 += lq1[i] * lk1[i]; s2 += lq2[i] * lk2[i]; }
    const float lam = expf(s1) - expf(s2) + lam0;
    const float dv = o2[0][tid] - lam * o2[1][tid]; const float ssd = bsum(dv * dv); const float ex = dv / sqrtf(ssd / 128.f + 1e-5f) * subg[tid] * (1.f - lam0);
    { const float got = dbg_bf(MIXb, (size_t)t * 1024 + hh * 128 + tid); float n2 = (got - ex) * (got - ex), d2 = ex * ex; n2 = bsum(n2); d2 = bsum(d2); if (tid == 0) atomicMax(slot + 2, __float_as_uint(sqrtf(n2 / fmaxf(d2, 1e-20f)))); }
    { const int ch = hh * 128 + tid; float cx[3] = {0.f, 0.f, 0.f}, bg = 0.f;
      for (int jj = 0; jj < 3; ++jj) { const int r = t - 2 + jj; if (r < 0) continue; const float rr = dbg_rstd(ssq, r); float c = 0.f, x = 0.f, b = 0.f;
          for (int k = 0; k < 1024; ++k) { const float hv = h[(size_t)r * 1024 + k] * ln[k]; c += hv * W[(size_t)k * EIN + 2048 + ch]; x += hv * W[(size_t)k * EIN + 2560 + ch]; if (jj == 2) b += hv * W[(size_t)k * EIN + 1536 + ch]; }
          cx[jj] = (c * rr) * (x * rr); if (jj == 2) bg = b * rr; }
      const float ex2 = bg * (cw[0 * 512 + ch] * cx[0] + cw[1 * 512 + ch] * cx[1] + cw[2 * 512 + ch] * cx[2]); const float got = dbg_bf(MIXb, (size_t)t * 1024 + 512 + ch);
      float n2 = (got - ex2) * (got - ex2), d2 = ex2 * ex2; n2 = bsum(n2); d2 = bsum(d2); if (tid == 0) atomicMax(slot + 3, __float_as_uint(sqrtf(n2 / fmaxf(d2, 1e-20f)))); }
}
static void dbg_before_phase(int ph, unsigned char* ws, float* out, hipStream_t st) {
    if (ph == P_PRO || ph == P_FINAL) return;
    const int lp = (ph - 1) % LPN;
    if (lp == LP_UP || lp == LP_R1 || lp == LP_PLE) { (void)hipMemcpyAsync(ws + WS_ARENA + 400 * MiB, out, (size_t)S_ * D_ * 4, hipMemcpyDeviceToDevice, st); (void)hipMemcpyAsync(ws + WS_ARENA + 464 * MiB, ws + WS_SSQA, (size_t)S_ * 16 * 4, hipMemcpyDeviceToDevice, st); }
}
static void dbg_checks(int ph, void* const* d_in, unsigned char* ws, float* out, hipStream_t st) {
    if (ph == P_PRO || ph == P_FINAL) return;
    unsigned* slots = (unsigned*)(ws + WS_CTL) + CW_DBG; const int L = (ph - 1) / LPN, lp = (ph - 1) % LPN, j = L >> 1; const bool odd = L & 1;
    const float* snap = (const float*)(ws + WS_ARENA + 400 * MiB);
    if (lp == LP_DOWN && L == 0) hipLaunchKernelGGL(chk_ffn, dim3(24), dim3(256), 0, st, snap, (const float*)out, (const float*)(ws + WS_ARENA + 464 * MiB), (const float*)d_in[4] + L * D_, (const float*)nullptr,
        (const float*)d_in[21] + (size_t)j * D_ * DFF, (const float*)d_in[22] + (size_t)j * D_ * DFF, (const float*)d_in[23] + (size_t)j * D_ * DFF, 0, slots + 256 + 0);
    if (lp == LP_PLE && L == 0) hipLaunchKernelGGL(chk_ple, dim3(24), dim3(256), 0, st, snap, (const float*)out, (const float*)(ws + WS_ARENA + 464 * MiB), (const float*)d_in[5] + L * D_, (const float*)d_in[28] + (size_t)L * D_ * D_,
        (const float*)d_in[1] + (size_t)L * S_ * PLE, (const float*)d_in[29] + (size_t)L * PLE * D_, slots + 256 + 1);
    if (lp == LP_G3 && L == 1) { float* raw = (float*)(ws + WS_ARENA + 400 * MiB);
        hipLaunchKernelGGL(chk_gdn_proj, dim3((DBG_TC * 514 + 255) / 256), dim3(256), 0, st, (const float*)out, (const float*)(ws + WS_SSQB), (const float*)d_in[3] + L * D_, (const float*)d_in[15] + (size_t)j * D_ * OIN_SRC, 3, raw);
        hipLaunchKernelGGL(chk_gdn_rec, dim3(1), dim3(256), (128 * 129 + 6 * 128 + 256) * 4, st, (const float*)raw, (const float*)d_in[16] + (size_t)j * 4 * 3072, (const float*)d_in[17] + j * 8, (const float*)d_in[18] + j * 8, (const float*)d_in[19] + j * 128, 3, (const unsigned short*)(ws + WS_MIX), slots + 256 + 2); }
    if (lp == LP_COMB && L == 1) hipLaunchKernelGGL(chk_ffn, dim3(24), dim3(256), 0, st, snap, (const float*)out, (const float*)(ws + WS_ARENA + 464 * MiB), (const float*)d_in[4] + L * D_, (const float*)d_in[24] + (size_t)j * D_ * NEXP,
        (const float*)d_in[25] + (size_t)j * NEXP * D_ * DFF, (const float*)d_in[26] + (size_t)j * NEXP * D_ * DFF, (const float*)d_in[27] + (size_t)j * NEXP * DFF * D_, 1, slots + 256 + 3);
    if (lp == LP_MIXPREP && L == 0) { float* KV = (float*)(ws + WS_ARENA + 400 * MiB);
        hipLaunchKernelGGL(chk_even_kv, dim3((S_ * 1024) / 256), dim3(256), 0, st, (const float*)out, (const float*)(ws + WS_SSQB), (const float*)d_in[3] + L * D_, (const float*)d_in[7] + (size_t)j * D_ * EIN, KV);
        hipLaunchKernelGGL(chk_even_mix, dim3(24), dim3(128), 0, st, (const float*)out, (const float*)(ws + WS_SSQB), (const float*)d_in[3] + L * D_, (const float*)d_in[7] + (size_t)j * D_ * EIN, (const float*)KV, (const int*)d_in[2],
            (const float*)d_in[9] + j * 64, (const float*)d_in[10] + j * 64, (const float*)d_in[11] + j * 64, (const float*)d_in[12] + j * 64, (const float*)d_in[13] + j * 128, (const float*)d_in[14] + (size_t)j * 3 * 512,
            0.8f - 0.6f * expf(-0.3f * (float)L), (const unsigned short*)(ws + WS_ARENA + AR_PE), (const unsigned short*)(ws + WS_ARENA + AR_AO), (const unsigned short*)(ws + WS_MIX), slots + 256 + 4); }
    (void)odd;
}
static void dbg_after_phase(int ph, unsigned char* ws, float* out, hipStream_t st) {
    unsigned* slots = (unsigned*)(ws + WS_CTL) + CW_DBG; unsigned* sl = slots + ph;
    auto scan = [&](const void* p, size_t n, int f32) { hipLaunchKernelGGL(dbg_scan, dim3(1024), dim3(256), 0, st, p, n, f32, sl); };
    const size_t SD = (size_t)S_ * D_; unsigned char* ar = ws + WS_ARENA;
    if (ph == P_PRO) { scan(ws + WS_HBF, SD, 0); scan(out, SD, 1); scan(ws + WS_PBF, (size_t)4 * S_ * PLE, 0); scan(ws + WS_TAB, (size_t)S_ * 16, 1); scan(ws + WS_W, (size_t)44 * MiB, 0); return; }
    if (ph == P_FINAL) return;
    const int L = (ph - 1) / LPN, lp = (ph - 1) % LPN; const bool odd = L & 1;
    switch (lp) {
    case LP_PROJ: if (!odd) scan(ar + AR_PE, (size_t)S_ * EIN, 0); else { scan(ar + AR_PO, (size_t)S_ * OIN, 0); scan(ws + WS_GB, (size_t)S_ * 16, 1); } scan(ws + WS_PP, SD, 0); break;
    case LP_ROT: scan(ar + AR_PE, (size_t)S_ * EIN, 0); break;
    case LP_ATT: scan(ar + AR_AO, SD, 0); break;
    case LP_MIXPREP: case LP_G3: scan(ws + WS_MIX, SD, 0); break;
    case LP_GA: scan(ar + AR_QN, SD * 5, 0); scan(ws + WS_GB, (size_t)S_ * 16, 1); break;
    case LP_G1: scan(ar + AR_AI, (size_t)NUNIT * 4096, 0); scan(ar + AR_NEGW, SD, 0); scan(ar + AR_UT, SD, 0); scan(ar + AR_UT, (size_t)NUNIT * 16384 * 2, 0); break;
    case LP_G2: scan(ar + AR_SG, (size_t)NUNIT * 16384, 0); break;
    case LP_OUT: case LP_DOWN: case LP_COMB: case LP_PLE: scan(out, SD, 1); scan(ws + WS_HBF, SD, 0); scan(ws + ((lp == LP_PLE) ? WS_SSQB : WS_SSQA), (size_t)S_ * 16, 1); break;
    case LP_UP: scan(ar + AR_ACT, (size_t)S_ * DFF, 0); break;
    case LP_R1: scan(ws + WS_TOK + TOK_G, (size_t)S_ * 2, 1); break;
    default: break; }
}
#endif
#ifndef MK_MULTI
#define MK_MULTI 0
#endif
extern "C" void kernel_launch(void* const* d_in, const int* in_sizes, int n_in, void* d_out, int out_size, void* d_ws, size_t ws_size, hipStream_t stream) {
    static int grid = 0;
    if (grid == 0) {
        if (n_in != 30 || out_size != S_ * D_ || ws_size < WS_NEED) { fprintf(stderr, "kernel_launch: unexpected problem (n_in %d, out %d, ws %zu < %zu)\n", n_in, out_size, ws_size, (size_t)WS_NEED); grid = -1; return; }
        int dev = 0, cus = 0, per_cu = 0;
        if (hipGetDevice(&dev) != hipSuccess || hipDeviceGetAttribute(&cus, hipDeviceAttributeMultiprocessorCount, dev) != hipSuccess) { grid = -1; return; }
        if (hipFuncSetAttribute((const void*)fwd, hipFuncAttributeMaxDynamicSharedMemorySize, LDS_BYTES) != hipSuccess) { fprintf(stderr, "kernel_launch: hipFuncSetAttribute failed\n"); grid = -1; return; }
        if (hipOccupancyMaxActiveBlocksPerMultiprocessor(&per_cu, (const void*)fwd, NWAVES * 64, LDS_BYTES) != hipSuccess || per_cu < 1) { fprintf(stderr, "kernel_launch: occupancy query says %d\n", per_cu); }
        (void)hipGetLastError();
        grid = cus;
#if DBG
        (void)hipFuncSetAttribute((const void*)chk_gdn_rec, hipFuncAttributeMaxDynamicSharedMemorySize, 72 * 1024);
#endif
    }
    if (grid < 0) return;
    (void)hipMemsetAsync((char*)d_ws + WS_CTL, 0, CTL_ZERO_BYTES, stream);
    Args a{};
    for (int i = 0; i < 30; ++i) a.in[i] = d_in[i];
    a.out = (float*)d_out; a.ws = (unsigned char*)d_ws; a.pad = 0;
#if MK_MULTI
    a.use_bar = 0;
    static const int seq_even[] = {LP_PROJ, LP_ROT, LP_ATT, LP_MIXPREP, LP_OUT, LP_UP, LP_DOWN, LP_PLE};
    static const int seq_odd[] = {LP_PROJ, LP_GA, LP_G2, LP_G3, LP_OUT, LP_R1, LP_R2, LP_M1, LP_M2, LP_COMB, LP_PLE};
    int plist[64], np = 0; plist[np++] = P_PRO;
    for (int L = 0; L < DEPTH_; ++L) { const bool odd = L & 1; const int n = odd ? 11 : 8; for (int q = 0; q < n; ++q) plist[np++] = 1 + LPN * L + (odd ? seq_odd[q] : seq_even[q]); }
    plist[np++] = P_FINAL;
    for (int pi = 0; pi < np; ++pi) { const int ph = plist[pi];
        a.ph_lo = ph; a.ph_hi = ph + 1;
#if DBG
        dbg_before_phase(ph, (unsigned char*)d_ws, (float*)d_out, stream);
#endif
        hipLaunchKernelGGL(fwd, dim3(grid), dim3(NWAVES * 64), LDS_BYTES, stream, a);
#if DBG
        dbg_after_phase(ph, (unsigned char*)d_ws, (float*)d_out, stream); dbg_checks(ph, d_in, (unsigned char*)d_ws, (float*)d_out, stream);
#endif
    }
#if DBG
    hipLaunchKernelGGL(dbg_fill, dim3(1024), dim3(256), 0, stream, (float*)d_out, (size_t)S_ * D_, (const unsigned*)((unsigned char*)d_ws + WS_CTL) + CW_DBG, P_FINAL + 1);
#endif
#else
    a.use_bar = 1; a.ph_lo = 0; a.ph_hi = P_FINAL + 1;
    hipLaunchKernelGGL(fwd, dim3(grid), dim3(NWAVES * 64), LDS_BYTES, stream, a);
#ifdef PROBE_PH
    for (int i = 0; i < PROBE_N; ++i) { a.use_bar = 0; a.ph_lo = PROBE_PH; a.ph_hi = PROBE_PH + 1; hipLaunchKernelGGL(fwd, dim3(grid), dim3(NWAVES * 64), LDS_BYTES, stream, a); }
#endif
#endif
    const hipError_t le = hipPeekAtLastError();
    if (le != hipSuccess) fprintf(stderr, "kernel_launch: launch failed: %s\n", hipGetErrorName(le));
}
```

```cpp
#include <hip/hip_runtime.h>
#include <hip/hip_bf16.h>
#include <cstdio>
#include <cstdint>
#include <cmath>

constexpr int S_ = 16384, D_ = 1024, DEPTH_ = 4;
constexpr int EIN = 3072, OIN = 4096  , OIN_W = 4096, OIN_ROWS = 4112  , OIN_SRC = 4112, DFF = 3584, NEXP = 8, PLE = 256;
constexpr int MOE_P = 2 * S_ + NEXP * 256;
constexpr int NCHUNK = S_ / 64, NUNIT = NCHUNK * 8;
constexpr float RMS_EPS = 1e-6f;

namespace pg8 {
#define PG8_LAS __attribute__((address_space(3)))
typedef unsigned short bf16_t;
typedef short bf16x8 __attribute__((ext_vector_type(8)));
typedef float f32x4 __attribute__((ext_vector_type(4)));
typedef float f32x2 __attribute__((ext_vector_type(2)));
typedef unsigned u32x4 __attribute__((ext_vector_type(4)));
typedef unsigned u32x2 __attribute__((ext_vector_type(2)));
constexpr int BM = 256, BK = 64, HALF = 128, HTB = HALF * BK * 2, STAGE_BYTES = 8 * HTB, NXCD = 8, WGM = 8;

__host__ __device__ __forceinline__ int lds_byte(int r, int c) { const int st = (r >> 4) * 2 + (c >> 5), rr = r & 15, cc = c & 31, ob = rr * 64 + cc * 2; return st * 1024 + (ob ^ (((ob >> 9) & 1) << 5)); }
__host__ __device__ __forceinline__ void stage_rc(int b, int& R, int& C) { const int st = b / 1024, sb = b % 1024, swz = sb ^ (((sb >> 9) & 1) << 5); R = (st >> 1) * 16 + swz / 64; C = (st & 1) * 32 + (swz % 64) / 2; }
__host__ __device__ __forceinline__ int perm32(int rho) { const int n = rho >> 4, i = rho & 15; return 8 * (i >> 2) + 4 * n + (i & 3); }

struct Unit { int pm, pn, be; };
struct Gemm { const bf16_t* A; const bf16_t* Bt; int M, N, K; size_t bstride; };

struct StaticOrder {
    int nM, nN, nwg, G, c;
    __host__ __device__ void init(int M, int N, int G_, int c_) { nM = M / BM; nN = N / BM; nwg = nM * nN; G = G_; c = c_; }
    __host__ __device__ bool next(int i, Unit& u) const {
        const long L = (long)i * G + c; if (L >= nwg) return false;
        int wgid = (int)L; { const int q = nwg / NXCD, r = nwg % NXCD, xcd = wgid % NXCD, off = wgid / NXCD; wgid = (xcd < r ? xcd * (q + 1) : r * (q + 1) + (xcd - r) * q) + off; }
        const int nig = WGM * nN, gid = wgid / nig, fm = gid * WGM, gsz = (nM - fm) < WGM ? (nM - fm) : WGM;
        u.pm = fm + ((wgid % nig) % gsz); u.pn = (wgid % nig) / gsz; u.be = 0; return true;
    }
    __device__ __forceinline__ void a_ready(const Unit&) const {}
    __device__ __forceinline__ void done(const Unit&) const {}
};
struct MoeOrder : StaticOrder {
    const PG8_LAS int* blk_e;
    __device__ __forceinline__ bool next(int i, Unit& u) const { if (!StaticOrder::next(i, u)) return false; u.be = blk_e[u.pm]; return true; }
};

__device__ __forceinline__ unsigned cvt_pk_bf16(float lo, float hi) { unsigned r; asm volatile("v_cvt_pk_bf16_f32 %0, %1, %2" : "=v"(r) : "v"(lo), "v"(hi)); return r; }
typedef __bf16 bf16x2_t_ __attribute__((ext_vector_type(2)));
__device__ __forceinline__ unsigned cvt_pk_bf16_cv(float lo, float hi) { const f32x2 v = {lo, hi}; const bf16x2_t_ b = __builtin_convertvector(v, bf16x2_t_); return __builtin_bit_cast(unsigned, b); }
__device__ __forceinline__ float bf_lo(unsigned w) { return __uint_as_float(w << 16); }
__device__ __forceinline__ float bf_hi(unsigned w) { return __uint_as_float(w & 0xffff0000u); }

__device__ __forceinline__ float rstd_row(const float* ssq, int row) {
    const f32x4* p = (const f32x4*)(ssq + (size_t)row * 16);
    const f32x4 a = p[0], b = p[1], c = p[2], d = p[3];
    const float s = (((a[0] + a[1]) + (a[2] + a[3])) + ((b[0] + b[1]) + (b[2] + b[3]))) + (((c[0] + c[1]) + (c[2] + c[3])) + ((d[0] + d[1]) + (d[2] + d[3])));
    return __builtin_amdgcn_rsqf(s * (1.0f / 1024.0f) + RMS_EPS);
}
__device__ __forceinline__ float sigmoidf_(float x) { return __builtin_amdgcn_rcpf(1.0f + __builtin_amdgcn_exp2f(-1.4426950408889634f * x)); }
__device__ __forceinline__ float siluf_(float x) { return x * sigmoidf_(x); }

constexpr float C2 = 0.125f * 1.4426950408889634f;

struct EpiProjEven {
    static constexpr bool PERM = true, AFTER_DRAIN = false;
    bf16_t* O; const float* ssq; const float* tab;
    __device__ __forceinline__ void operator()(const f32x4 (&acc)[2][2][4][2], const Unit& u, int wr, int wc, int fr, int fq) const {
        const int row0 = u.pm * BM + wr * 64 + fr, colt = u.pn * BM;
        const bool rot = (colt < 1024) && ((wc & 1) == 0);
        const float qs = (colt < 512) ? C2 : 1.0f;
#pragma unroll
        for (int ai = 0; ai < 2; ++ai)
#pragma unroll
            for (int m = 0; m < 4; ++m) {
                const int row = row0 + ai * HALF + m * 16; const float rs = rstd_row(ssq, row);
                f32x4 c0 = {1.f, 1.f, 1.f, 1.f}, c1 = c0, s0 = {0.f, 0.f, 0.f, 0.f}, s1 = s0;
                if (rot && fq < 2) { const f32x4* t = (const f32x4*)(tab + (size_t)row * 16); c0 = t[0]; c1 = t[1]; s0 = t[2]; s1 = t[3]; if (fq == 0) { s0 = -s0; s1 = -s1; } }
#pragma unroll
                for (int bj = 0; bj < 2; ++bj) {
                    f32x4 v0 = acc[ai][bj][m][0] * rs, v1 = acc[ai][bj][m][1] * rs;
                    if (rot) {
                        f32x4 p0, p1;
#pragma unroll
                        for (int i = 0; i < 4; ++i) { p0[i] = __shfl_xor(v0[i], 16); p1[i] = __shfl_xor(v1[i], 16); }
                        v0 = v0 * c0 + p0 * s0; v1 = v1 * c1 + p1 * s1;
                    }
                    v0 = v0 * qs; v1 = v1 * qs;
                    u32x4 w; w.x = cvt_pk_bf16(v0[0], v0[1]); w.y = cvt_pk_bf16(v0[2], v0[3]); w.z = cvt_pk_bf16(v1[0], v1[1]); w.w = cvt_pk_bf16(v1[2], v1[3]);
                    *(u32x4*)(O + (size_t)row * EIN + colt + bj * HALF + wc * 32 + 8 * fq) = w;
                }
                asm volatile("" ::: "memory");
            }
    }
};
struct EpiBf16 {
    static constexpr bool PERM = true, AFTER_DRAIN = false;
    bf16_t* O; int ldc; const float* ssq; float scale0; int scale_cols;
    __device__ __forceinline__ void operator()(const f32x4 (&acc)[2][2][4][2], const Unit& u, int wr, int wc, int fr, int fq) const {
        const int row0 = u.pm * BM + wr * 64 + fr, colt = u.pn * BM;
#pragma unroll
        for (int ai = 0; ai < 2; ++ai)
#pragma unroll
            for (int m = 0; m < 4; ++m) {
                const int row = row0 + ai * HALF + m * 16; const float rs = (ssq ? rstd_row(ssq, row) : 1.0f) * (colt < scale_cols ? scale0 : 1.0f);
#pragma unroll
                for (int bj = 0; bj < 2; ++bj) {
                    const f32x4 v0 = acc[ai][bj][m][0] * rs, v1 = acc[ai][bj][m][1] * rs;
                    u32x4 w; w.x = cvt_pk_bf16(v0[0], v0[1]); w.y = cvt_pk_bf16(v0[2], v0[3]); w.z = cvt_pk_bf16(v1[0], v1[1]); w.w = cvt_pk_bf16(v1[2], v1[3]);
                    *(u32x4*)(O + (size_t)row * ldc + colt + bj * HALF + wc * 32 + 8 * fq) = w;
                }
                if (m & 1) asm volatile("" ::: "memory");
            }
    }
};
struct EpiSwiglu {
    static constexpr bool PERM = true, AFTER_DRAIN = false;
    bf16_t* O; const float* ssq;
    __device__ __forceinline__ void operator()(const f32x4 (&acc)[2][2][4][2], const Unit& u, int wr, int wc, int fr, int fq) const {
        const int row0 = u.pm * BM + wr * 64 + fr, col = u.pn * HALF + wc * 32 + 8 * fq;
#pragma unroll
        for (int ai = 0; ai < 2; ++ai)
#pragma unroll
            for (int m = 0; m < 4; ++m) {
                const int row = row0 + ai * HALF + m * 16; const float rs = ssq ? rstd_row(ssq, row) : 1.0f;
                float o[8];
#pragma unroll
                for (int n = 0; n < 2; ++n)
#pragma unroll
                    for (int i = 0; i < 4; ++i) { const float a = acc[ai][0][m][n][i] * rs, b = acc[ai][1][m][n][i] * rs; o[4 * n + i] = siluf_(a) * b; }
                u32x4 w; w.x = cvt_pk_bf16(o[0], o[1]); w.y = cvt_pk_bf16(o[2], o[3]); w.z = cvt_pk_bf16(o[4], o[5]); w.w = cvt_pk_bf16(o[6], o[7]);
                *(u32x4*)(O + (size_t)row * DFF + col) = w;
                if (m & 1) asm volatile("" ::: "memory");
            }
    }
};
struct EpiResid {
    static constexpr bool PERM = true, AFTER_DRAIN = false;
    bf16_t* hb; float* ssq;
    __device__ __forceinline__ void operator()(const f32x4 (&acc)[2][2][4][2], const Unit& u, int wr, int wc, int fr, int fq) const {
        const int row0 = u.pm * BM + wr * 64 + fr, colt = u.pn * BM;
#pragma unroll
        for (int ai = 0; ai < 2; ++ai)
#pragma unroll
            for (int m = 0; m < 4; ++m) {
                const int row = row0 + ai * HALF + m * 16; float ss = 0.f;
#pragma unroll
                for (int bj = 0; bj < 2; ++bj) {
                    const size_t off = (size_t)row * D_ + colt + bj * HALF + wc * 32 + 8 * fq;
                    const u32x4 hv = *(const u32x4*)(hb + off);
                    f32x4 x0 = {bf_lo(hv.x), bf_hi(hv.x), bf_lo(hv.y), bf_hi(hv.y)}, x1 = {bf_lo(hv.z), bf_hi(hv.z), bf_lo(hv.w), bf_hi(hv.w)};
                    x0 = x0 + acc[ai][bj][m][0]; x1 = x1 + acc[ai][bj][m][1];
                    ss += (x0[0] * x0[0] + x0[1] * x0[1]) + (x0[2] * x0[2] + x0[3] * x0[3]) + (x1[0] * x1[0] + x1[1] * x1[1]) + (x1[2] * x1[2] + x1[3] * x1[3]);
                    u32x4 w; w.x = cvt_pk_bf16(x0[0], x0[1]); w.y = cvt_pk_bf16(x0[2], x0[3]); w.z = cvt_pk_bf16(x1[0], x1[1]); w.w = cvt_pk_bf16(x1[2], x1[3]);
                    *(u32x4*)(hb + off) = w;
                }
                ss += __shfl_xor(ss, 16); ss += __shfl_xor(ss, 32);
                if (fq == 0) ssq[(size_t)row * 16 + u.pn * 4 + wc] = ss;
                asm volatile("" ::: "memory");
            }
    }
};
struct EpiPle {
    static constexpr bool PERM = true, AFTER_DRAIN = false;
    bf16_t* hb; const float* ssq_in; float* ssq_out; const bf16_t* pp;
    __device__ __forceinline__ void operator()(const f32x4 (&acc)[2][2][4][2], const Unit& u, int wr, int wc, int fr, int fq) const {
        const int row0 = u.pm * BM + wr * 64 + fr, colt = u.pn * BM;
#pragma unroll
        for (int ai = 0; ai < 2; ++ai)
#pragma unroll
            for (int m = 0; m < 4; ++m) {
                const int row = row0 + ai * HALF + m * 16; const float rs = rstd_row(ssq_in, row); float ss = 0.f;
#pragma unroll
                for (int bj = 0; bj < 2; ++bj) {
                    const size_t off = (size_t)row * D_ + colt + bj * HALF + wc * 32 + 8 * fq;
                    const u32x4 hv = *(const u32x4*)(hb + off); const u32x4 pw = *(const u32x4*)(pp + off);
                    f32x4 x0 = {bf_lo(hv.x), bf_hi(hv.x), bf_lo(hv.y), bf_hi(hv.y)}, x1 = {bf_lo(hv.z), bf_hi(hv.z), bf_lo(hv.w), bf_hi(hv.w)};
                    const f32x4 a0 = acc[ai][bj][m][0] * rs, a1 = acc[ai][bj][m][1] * rs;
                    x0[0] += sigmoidf_(a0[0]) * bf_lo(pw.x); x0[1] += sigmoidf_(a0[1]) * bf_hi(pw.x); x0[2] += sigmoidf_(a0[2]) * bf_lo(pw.y); x0[3] += sigmoidf_(a0[3]) * bf_hi(pw.y);
                    x1[0] += sigmoidf_(a1[0]) * bf_lo(pw.z); x1[1] += sigmoidf_(a1[1]) * bf_hi(pw.z); x1[2] += sigmoidf_(a1[2]) * bf_lo(pw.w); x1[3] += sigmoidf_(a1[3]) * bf_hi(pw.w);
                    ss += (x0[0] * x0[0] + x0[1] * x0[1]) + (x0[2] * x0[2] + x0[3] * x0[3]) + (x1[0] * x1[0] + x1[1] * x1[1]) + (x1[2] * x1[2] + x1[3] * x1[3]);
                    u32x4 w; w.x = cvt_pk_bf16(x0[0], x0[1]); w.y = cvt_pk_bf16(x0[2], x0[3]); w.z = cvt_pk_bf16(x1[0], x1[1]); w.w = cvt_pk_bf16(x1[2], x1[3]);
                    *(u32x4*)(hb + off) = w;
                }
                ss += __shfl_xor(ss, 16); ss += __shfl_xor(ss, 32);
                if (fq == 0) ssq_out[(size_t)row * 16 + u.pn * 4 + wc] = ss;
                asm volatile("" ::: "memory");
            }
    }
};
struct EpiMoeDown {
    static constexpr bool PERM = true, AFTER_DRAIN = false;
    bf16_t* Y; const float* gate;
    __device__ __forceinline__ void operator()(const f32x4 (&acc)[2][2][4][2], const Unit& u, int wr, int wc, int fr, int fq) const {
        const int row0 = u.pm * BM + wr * 64 + fr, colt = u.pn * BM;
#pragma unroll
        for (int ai = 0; ai < 2; ++ai)
#pragma unroll
            for (int m = 0; m < 4; ++m) {
                const int row = row0 + ai * HALF + m * 16; const float gt = gate[row];
#pragma unroll
                for (int bj = 0; bj < 2; ++bj) {
                    const f32x4 v0 = acc[ai][bj][m][0] * gt, v1 = acc[ai][bj][m][1] * gt;
                    u32x4 w; w.x = cvt_pk_bf16(v0[0], v0[1]); w.y = cvt_pk_bf16(v0[2], v0[3]); w.z = cvt_pk_bf16(v1[0], v1[1]); w.w = cvt_pk_bf16(v1[2], v1[3]);
                    *(u32x4*)(Y + (size_t)row * D_ + colt + bj * HALF + wc * 32 + 8 * fq) = w;
                }
                if (m & 1) asm volatile("" ::: "memory");
            }
    }
};

template <class Epi, class Sched, bool ALIGN_EPI = false, bool SP2 = false>
__device__ __forceinline__ void gemm_phase(PG8_LAS unsigned char* lds, const Gemm g, const Sched& S, const Epi& E) {
    int tid_ = threadIdx.x; asm volatile("" : "+v"(tid_));
    const int tid = tid_, wid = __builtin_amdgcn_readfirstlane(tid >> 6), lane = tid & 63, wr = wid >> 2, wc = wid & 3, fr = lane & 15, fq = lane >> 4;
    const int K = g.K, nt = K / BK;
    unsigned voffA[2], voffB[2];
#pragma unroll
    for (int i = 0; i < 2; ++i) { int R, C; stage_rc(tid * 16 + i * 8192, R, C); const int Rb = Epi::PERM ? ((R & ~31) + perm32(R & 31)) : R;
        voffA[i] = (unsigned)(R * K + C) * 2u; voffB[i] = (unsigned)(Rb * K + C) * 2u; }
    const size_t kstep = (size_t)(BK * 2);
    const size_t hstep = (size_t)HALF * K * 2;
    const size_t tstep = 2 * hstep;
    const unsigned ldsw = (unsigned)wid * 1024u;
    const int aoff = lds_byte(wr * 64 + fr, fq * 8), boff = lds_byte(wc * 32 + fr, fq * 8);
#define PG8_SA(b, h) (((b) * 2 + (h)) * HTB)
#define PG8_SB(b, h) ((4 + (b) * 2 + (h)) * HTB)
#define PG8_STAGE(bufoff, gbase, voff) do { _Pragma("unroll") for (int _i = 0; _i < 2; ++_i) \
        __builtin_amdgcn_global_load_lds((const unsigned*)((const char*)(gbase) + (voff)[_i]), (PG8_LAS unsigned*)(lds + (bufoff) + ldsw + _i * 8192), 16, 0, 0); } while (0)
#define PG8_LDA(dst, b, h) do { _Pragma("unroll") for (int m = 0; m < 4; ++m) _Pragma("unroll") for (int k = 0; k < 2; ++k) dst[m][k] = *(const PG8_LAS bf16x8*)(lds + PG8_SA(b, h) + aoff + m * 2048 + k * 1024); } while (0)
#define PG8_LDB(dst, b, h) do { _Pragma("unroll") for (int n = 0; n < 2; ++n) _Pragma("unroll") for (int k = 0; k < 2; ++k) dst[n][k] = *(const PG8_LAS bf16x8*)(lds + PG8_SB(b, h) + boff + n * 2048 + k * 1024); } while (0)
#define PG8_MMA(ai, bj, At, Bt) do { __builtin_amdgcn_s_setprio(1); _Pragma("unroll") for (int m = 0; m < 4; ++m) _Pragma("unroll") for (int n = 0; n < 2; ++n) _Pragma("unroll") for (int k = 0; k < 2; ++k) \
        acc[ai][bj][m][n] = __builtin_amdgcn_mfma_f32_16x16x32_bf16(Bt[n][k], At[m][k], acc[ai][bj][m][n], 0, 0, 0); __builtin_amdgcn_s_setprio(0); } while (0)
#define PG8_WAIT_V(n) asm volatile("s_waitcnt vmcnt(" #n ")" ::: "memory")
#define PG8_WAIT_L(n) asm volatile("s_waitcnt lgkmcnt(" #n ")" ::: "memory")
#define PG8_BAR __builtin_amdgcn_s_barrier()
#define PG8_SCHED __builtin_amdgcn_sched_barrier(0)
    Unit cur, nxt; int ui = 0;
    if (!S.next(0, cur)) return;
    f32x4 acc[2][2][4][2];
#pragma unroll
    for (int a = 0; a < 2; ++a)
#pragma unroll
        for (int b = 0; b < 2; ++b)
#pragma unroll
            for (int m = 0; m < 4; ++m)
#pragma unroll
                for (int n = 0; n < 2; ++n) acc[a][b][m][n] = (f32x4){0.f, 0.f, 0.f, 0.f};
    bf16x8 At[4][2], B0[2][2], B1[2][2];
    const char* cA = (const char*)g.A + (size_t)cur.pm * tstep; const char* cB = (const char*)g.Bt + (size_t)cur.pn * tstep + (size_t)cur.be * g.bstride;
    S.a_ready(cur);
    if constexpr (SP2) {
        PG8_STAGE(PG8_SB(0, 0), cB, voffB); PG8_STAGE(PG8_SB(0, 1), cB + hstep, voffB); PG8_STAGE(PG8_SA(0, 0), cA, voffA); PG8_STAGE(PG8_SA(0, 1), cA + hstep, voffA);
        if (wr == 1) PG8_BAR;
        PG8_WAIT_V(2); PG8_BAR;
        PG8_STAGE(PG8_SB(1, 0), cB + kstep, voffB); PG8_STAGE(PG8_SA(1, 0), cA + kstep, voffA); PG8_STAGE(PG8_SB(1, 1), cB + hstep + kstep, voffB);
        PG8_WAIT_V(6); PG8_BAR;
    } else {
        PG8_STAGE(PG8_SB(0, 0), cB, voffB); PG8_STAGE(PG8_SA(0, 0), cA, voffA); PG8_STAGE(PG8_SB(0, 1), cB + hstep, voffB); PG8_STAGE(PG8_SA(0, 1), cA + hstep, voffA);
        if (wr == 1) PG8_BAR;
        PG8_WAIT_V(4); PG8_BAR;
        PG8_STAGE(PG8_SB(1, 0), cB + kstep, voffB); PG8_STAGE(PG8_SA(1, 0), cA + kstep, voffA); PG8_STAGE(PG8_SB(1, 1), cB + hstep + kstep, voffB);
        PG8_WAIT_V(6); PG8_BAR;
    }
    for (;;) {
        const bool has_next = S.next(ui + 1, nxt);
        const char* nA = has_next ? (const char*)g.A + (size_t)nxt.pm * tstep : cA; const char* nB = has_next ? (const char*)g.Bt + (size_t)nxt.pn * tstep + (size_t)nxt.be * g.bstride : cB;
        for (int t = 0; t < nt; t += 2) {
            const bool last = (t == nt - 2);
            const char* a1 = cA + (size_t)(t + 1) * kstep;
            const char* a2 = last ? nA : cA + (size_t)(t + 2) * kstep; const char* b2 = last ? nB : cB + (size_t)(t + 2) * kstep;
            const char* a3 = a2 + kstep; const char* b3 = b2 + kstep;
            if (last && has_next) S.a_ready(nxt);
            if constexpr (SP2) {
            PG8_LDB(B0, 0, 0); PG8_LDB(B1, 0, 1); PG8_SCHED; PG8_LDA(At, 0, 0); PG8_STAGE(PG8_SA(1, 1), a1 + hstep, voffA);
            PG8_WAIT_V(8); PG8_WAIT_L(0); PG8_BAR; PG8_MMA(0, 0, At, B0); PG8_MMA(0, 1, At, B1); PG8_BAR; PG8_SCHED;
            PG8_LDA(At, 0, 1); PG8_STAGE(PG8_SB(0, 0), b2, voffB); PG8_STAGE(PG8_SB(0, 1), b2 + hstep, voffB); PG8_STAGE(PG8_SA(0, 0), a2, voffA);
            PG8_WAIT_V(8); PG8_WAIT_L(0); PG8_BAR; PG8_MMA(1, 0, At, B0); PG8_MMA(1, 1, At, B1); PG8_BAR; PG8_SCHED;
            PG8_LDB(B0, 1, 0); PG8_LDB(B1, 1, 1); PG8_SCHED; PG8_LDA(At, 1, 0); PG8_STAGE(PG8_SA(0, 1), a2 + hstep, voffA);
            PG8_WAIT_V(8); PG8_WAIT_L(0); PG8_BAR; PG8_MMA(0, 0, At, B0); PG8_MMA(0, 1, At, B1); PG8_BAR; PG8_SCHED;
            PG8_LDA(At, 1, 1); PG8_STAGE(PG8_SB(1, 0), b3, voffB); PG8_STAGE(PG8_SB(1, 1), b3 + hstep, voffB); PG8_STAGE(PG8_SA(1, 0), a3, voffA);
            PG8_WAIT_V(8); PG8_WAIT_L(0); PG8_BAR; PG8_MMA(1, 0, At, B0); PG8_MMA(1, 1, At, B1); PG8_BAR; PG8_SCHED;
            } else {
            PG8_LDB(B0, 0, 0); PG8_SCHED; PG8_LDA(At, 0, 0); PG8_STAGE(PG8_SA(1, 1), a1 + hstep, voffA);
            PG8_WAIT_L(8); PG8_BAR; PG8_WAIT_L(0); PG8_MMA(0, 0, At, B0); PG8_BAR; PG8_SCHED;
            PG8_LDB(B1, 0, 1); PG8_STAGE(PG8_SB(0, 0), b2, voffB);
            PG8_BAR; PG8_WAIT_L(0); PG8_MMA(0, 1, At, B1); PG8_BAR;
            PG8_LDA(At, 0, 1); PG8_STAGE(PG8_SA(0, 0), a2, voffA);
            PG8_BAR; PG8_WAIT_L(0); PG8_MMA(1, 0, At, B0); PG8_BAR; PG8_SCHED;
            PG8_STAGE(PG8_SB(0, 1), b2 + hstep, voffB);
            PG8_WAIT_V(6); PG8_BAR; PG8_MMA(1, 1, At, B1); PG8_BAR;
            PG8_LDB(B0, 1, 0); PG8_SCHED; PG8_LDA(At, 1, 0); PG8_STAGE(PG8_SA(0, 1), a2 + hstep, voffA);
            PG8_WAIT_L(8); PG8_BAR; PG8_WAIT_L(0); PG8_MMA(0, 0, At, B0); PG8_BAR; PG8_SCHED;
            PG8_LDB(B1, 1, 1); PG8_STAGE(PG8_SB(1, 0), b3, voffB);
            PG8_BAR; PG8_WAIT_L(0); PG8_MMA(0, 1, At, B1); PG8_BAR;
            PG8_LDA(At, 1, 1); PG8_STAGE(PG8_SA(1, 0), a3, voffA);
            PG8_BAR; PG8_WAIT_L(0); PG8_MMA(1, 0, At, B0); PG8_BAR; PG8_SCHED;
            PG8_STAGE(PG8_SB(1, 1), b3 + hstep, voffB);
            PG8_WAIT_V(6); PG8_BAR; PG8_MMA(1, 1, At, B1); PG8_BAR;
            }
        }
        if constexpr (ALIGN_EPI) { if (wr == 0) PG8_BAR; }
        if constexpr (!Epi::AFTER_DRAIN) { E(acc, cur, wr, wc, fr, fq); S.done(cur); }
        if (!has_next) break;
#pragma unroll
        for (int a = 0; a < 2; ++a)
#pragma unroll
            for (int b = 0; b < 2; ++b)
#pragma unroll
                for (int m = 0; m < 4; ++m)
#pragma unroll
                    for (int n = 0; n < 2; ++n) acc[a][b][m][n] = (f32x4){0.f, 0.f, 0.f, 0.f};
        cur = nxt; cA = nA; cB = nB; ++ui;
        if constexpr (ALIGN_EPI) { if (wr == 1) PG8_BAR; }
    }
    PG8_WAIT_V(0);
    if constexpr (!ALIGN_EPI) { if (wr == 0) PG8_BAR; }
    PG8_BAR;
    if constexpr (Epi::AFTER_DRAIN) { E.fused(acc, cur, wr, wc, fr, fq, lds, wid, lane); S.done(cur); }
#undef PG8_SA
#undef PG8_SB
#undef PG8_STAGE
#undef PG8_LDA
#undef PG8_LDB
#undef PG8_MMA
#undef PG8_WAIT_V
#undef PG8_WAIT_L
#undef PG8_BAR
#undef PG8_SCHED
}
}

#include <hip/hip_bf16.h>
#include <cmath>
namespace attn_body {
using bf16=__hip_bfloat16;
using bf16x8=__attribute__((ext_vector_type(8)))short;
using s16x4=__attribute__((ext_vector_type(4)))short;
using f32x16=__attribute__((ext_vector_type(16)))float;
using u32x4=__attribute__((ext_vector_type(4)))unsigned;
constexpr int SEQ=16384,D=64,LDP=3072,LDO=1024;
constexpr int NW=8,QBLK=32,QB=QBLK*NW,KVBLK=64,NQB=SEQ/QB;
constexpr int ATTN_UNIT_ROWS=QB;
__device__ __forceinline__ int crow(int r,int hi){return (r&3)+8*(r>>2)+4*hi;}
#define SBAR() __builtin_amdgcn_sched_barrier(0)
__device__ __forceinline__ void cmask(f32x16&p0,f32x16&p1,int jb,int qrel,int hi){
  const float NEG=-INFINITY; int kb=64*jb+4*hi;
  #pragma unroll
  for(int r=0;r<16;++r){int kv=kb+(r&3)+8*(r>>2); if(kv>qrel)p0[r]=NEG; if(kv+32>qrel)p1[r]=NEG;}
}

constexpr int NSLOT=3, SLOTB=8192, VSLOTB=2*SLOTB;
constexpr int LDS_K=0, LDS_V=NSLOT*SLOTB, LDS_WS=LDS_V+NSLOT*VSLOTB, LDS_OST=0  , LDS_BYTES=LDS_WS+NW*64*4;
constexpr float C2=0.125f*1.4426950408889634f;
__device__ __forceinline__ void glds16(const void*gsrc,unsigned lds_dst){unsigned keep;
  asm volatile("s_mov_b32 %0, m0\n\ts_mov_b32 m0, %2\n\ts_nop 0\n\tglobal_load_lds_dwordx4 %1, off\n\ts_mov_b32 m0, %0":"=&s"(keep):"v"(gsrc),"s"(lds_dst):"memory");}
__device__ __forceinline__ float max3f(float a,float b,float c){float r;asm("v_max3_f32 %0, %1, %2, %3":"=v"(r):"v"(a),"v"(b),"v"(c));return r;}
__device__ __forceinline__ float max2f(float a,float b){float r;asm("v_max_f32_e32 %0, %1, %2":"=v"(r):"v"(a),"v"(b));return r;}
__device__ __forceinline__ float fadd_s(float a,float b){float r;asm("v_add_f32_e32 %0, %1, %2":"=v"(r):"v"(a),"v"(b));return r;}
__device__ __forceinline__ float fsub_s(float a,float b){float r;asm("v_sub_f32_e32 %0, %1, %2":"=v"(r):"v"(a),"v"(b));return r;}
typedef float f32x2_t __attribute__((ext_vector_type(2))); typedef __bf16 bf16x2_t __attribute__((ext_vector_type(2)));
__device__ __forceinline__ unsigned cvtpk_s(float lo,float hi){f32x2_t v={lo,hi};bf16x2_t b=__builtin_convertvector(v,bf16x2_t);return __builtin_bit_cast(unsigned,b);}
#define WAIT_BAR(N) asm volatile("s_waitcnt vmcnt(" #N ") lgkmcnt(0)\n\ts_barrier":::"memory")

__device__ __forceinline__ void qkt(f32x16&p0,f32x16&p1,const char*Kslot,const bf16x8*qr,int r32,int hi){
  const char*kb=Kslot+hi*1024+r32*16;
  #pragma unroll
  for(int d0=0;d0<4;++d0){
    const bf16x8 b0=*reinterpret_cast<const bf16x8*>(kb+d0*2048);
    const bf16x8 b1=*reinterpret_cast<const bf16x8*>(kb+d0*2048+512);
    if(d0==0){p0=__builtin_amdgcn_mfma_f32_32x32x16_bf16(b0,qr[0],f32x16{},0,0,0);p1=__builtin_amdgcn_mfma_f32_32x32x16_bf16(b1,qr[0],f32x16{},0,0,0);}
    else{p0=__builtin_amdgcn_mfma_f32_32x32x16_bf16(b0,qr[d0],p0,0,0,0);p1=__builtin_amdgcn_mfma_f32_32x32x16_bf16(b1,qr[d0],p1,0,0,0);}}
}
typedef __attribute__((address_space(3))) const char* lds_cptr;
typedef short v4i16_t __attribute__((ext_vector_type(4)));
__device__ __forceinline__ void kload8(bf16x8*kf,lds_cptr kp){
  kf[0]=*(const __attribute__((address_space(3))) bf16x8*)(kp);      kf[1]=*(const __attribute__((address_space(3))) bf16x8*)(kp+512);
  kf[2]=*(const __attribute__((address_space(3))) bf16x8*)(kp+2048); kf[3]=*(const __attribute__((address_space(3))) bf16x8*)(kp+2560);
  kf[4]=*(const __attribute__((address_space(3))) bf16x8*)(kp+4096); kf[5]=*(const __attribute__((address_space(3))) bf16x8*)(kp+4608);
  kf[6]=*(const __attribute__((address_space(3))) bf16x8*)(kp+6144); kf[7]=*(const __attribute__((address_space(3))) bf16x8*)(kp+6656);
}
__device__ __forceinline__ void kload2(bf16x8*kf,lds_cptr kp,int j){ kf[2*j]=*(const __attribute__((address_space(3))) bf16x8*)(kp+j*2048); kf[2*j+1]=*(const __attribute__((address_space(3))) bf16x8*)(kp+j*2048+512); }
__device__ __forceinline__ s16x4 vtr(lds_cptr p){ return __builtin_bit_cast(s16x4,__builtin_amdgcn_ds_read_tr16_b64_v4i16((__attribute__((address_space(3))) v4i16_t*)p)); }
__device__ __forceinline__ float rowmax(const f32x16&p0,const f32x16&p1){
  float a=max3f(p0[0],p0[1],p1[0]),b=max3f(p0[2],p0[3],p1[1]);a=max3f(a,p1[2],p1[3]);
  #pragma unroll
  for(int r=4;r<16;r+=4){a=max3f(a,p0[r],p0[r+1]);b=max3f(b,p0[r+2],p0[r+3]);a=max3f(a,p1[r],p1[r+1]);b=max3f(b,p1[r+2],p1[r+3]);}
  const float m=max2f(a,b);
  auto rr=__builtin_amdgcn_permlane32_swap(__float_as_uint(m),__float_as_uint(m),false,false);
  return max2f(__uint_as_float(rr[0]),__uint_as_float(rr[1]));
}
__device__ __forceinline__ void pv(f32x16*o,int vb,bf16x8 pa0,bf16x8 pa1,bf16x8 pa2,bf16x8 pa3){
  #pragma unroll
  for(int d0=0;d0<4;++d0){s16x4 lo[4],hi[4];
    #pragma unroll
    for(int ks=0;ks<4;++ks){
      asm volatile("ds_read_b64_tr_b16 %0,%1 offset:%c2":"=&v"(lo[ks]):"v"(vb),"i"(d0*4096+ks*1024):"memory");
      asm volatile("ds_read_b64_tr_b16 %0,%1 offset:%c2":"=&v"(hi[ks]):"v"(vb),"i"(d0*4096+ks*1024+512):"memory");}
    asm volatile("s_waitcnt lgkmcnt(0)":::"memory");SBAR();
    #define PK(k) (bf16x8){lo[k][0],lo[k][1],lo[k][2],lo[k][3],hi[k][0],hi[k][1],hi[k][2],hi[k][3]}
    o[d0]=__builtin_amdgcn_mfma_f32_32x32x16_bf16(pa0,PK(0),o[d0],0,0,0);
    o[d0]=__builtin_amdgcn_mfma_f32_32x32x16_bf16(pa1,PK(1),o[d0],0,0,0);
    o[d0]=__builtin_amdgcn_mfma_f32_32x32x16_bf16(pa2,PK(2),o[d0],0,0,0);
    o[d0]=__builtin_amdgcn_mfma_f32_32x32x16_bf16(pa3,PK(3),o[d0],0,0,0);
    #undef PK
  }
}

#ifndef ATTN_STORE16
#define ATTN_STORE16(p,v) (*(u32x4*)(p)=(v))
#endif
template<int THRL> __device__ __forceinline__ void attn_unit(int qb,const bf16*Qh,const bf16*__restrict__ Kh,const bf16*__restrict__ Vh,bf16*Oh,char*shm){
  int tid_=threadIdx.x; asm volatile("":"+v"(tid_));
  const int tid=tid_,lane=tid&63,r32=lane&31,hi=lane>>5; const int wid=__builtin_amdgcn_readfirstlane(tid>>6);
  const int q0=qb*QB;
  const bf16*Qw=Qh+(long)(q0+wid*QBLK)*LDP;
  const unsigned lds0=(unsigned)(uintptr_t)shm;
  float*wsf=(float*)(shm+LDS_WS)+wid*64;
  const bf16*ksrc=Kh+(long)lane*LDP+wid*8;
  const bf16*vsrc=Vh+(long)(16*(wid&3)+(lane>>2))*LDP+(wid>>2)*32+(lane&3)*8;
  const unsigned kdst=lds0+LDS_K+wid*1024, vdst=lds0+LDS_V+wid*1024;
  #define DMA_K(t,slot) glds16(ksrc+(long)(t)*KVBLK*LDP,(unsigned)__builtin_amdgcn_readfirstlane(kdst+(slot)))
  #define DMA_V(t,slot) do{ glds16(vsrc+(long)(t)*KVBLK*LDP,(unsigned)__builtin_amdgcn_readfirstlane(vdst+2*(slot))); glds16(vsrc+64+(long)(t)*KVBLK*LDP,(unsigned)__builtin_amdgcn_readfirstlane(vdst+2*(slot)+8192)); }while(0)
  const int vb0=(int)(lds0+LDS_V)+((lane>>4)&1)*32+(lane&3)*8+(4*hi+((lane&15)>>2))*64;
  const char*Kbase=shm+LDS_K; bf16x8 kf[8];
  const lds_cptr shm3=(lds_cptr)shm; const lds_cptr kp0=shm3+LDS_K+hi*1024+r32*16; const lds_cptr vp0=shm3+LDS_V+((lane>>4)&1)*32+(lane&3)*8+(4*hi+((lane&15)>>2))*64;
  const int NT=(q0+QB)/KVBLK;
  DMA_K(0,0);DMA_V(0,0);DMA_K(1,SLOTB);
  bf16x8 qr[4];
  #pragma unroll
  for(int d0=0;d0<4;++d0)qr[d0]=*reinterpret_cast<const bf16x8*>(&Qw[(long)r32*LDP+d0*16+hi*8]);
  float mhat=0.f,l_reg=0.f;f32x16 o[4];o[0]=f32x16{};o[1]=f32x16{};o[2]=f32x16{};o[3]=f32x16{};
  const int qrel=wid*QBLK+r32;
  #define CMASK(P0,P1,t) do{int jb_=(t)-(NT-4); if(jb_>=0)cmask(P0,P1,jb_,qrel,hi);}while(0)
  bool resc=false;
  #define START(P0,P1) do{ const float rm=rowmax(P0,P1); resc=false; mhat=rm; \
    _Pragma("unroll") for(int r=0;r<16;++r)P0[r]=__builtin_amdgcn_exp2f(fsub_s(P0[r],mhat)); }while(0)
  #define RESC() do{ if(resc){ asm volatile("s_waitcnt lgkmcnt(0)":::"memory"); \
      _Pragma("unroll") for(int d_=0;d_<4;++d_) _Pragma("unroll") for(int r=0;r<16;++r)o[d_][r]*=wsf[crow(r,hi)]; } }while(0)
  f32x16 pA0,pA1,pB0,pB1;
  int sl_prev=0,sl_cur=0,sl_next=SLOTB;
  #define ROT() do{sl_prev=sl_cur;sl_cur=sl_next;sl_next=(sl_next==(NSLOT-1)*SLOTB)?0:sl_next+SLOTB;}while(0)
  DMA_K(2,2*SLOTB);
  WAIT_BAR(4);
  qkt(pA0,pA1,Kbase,qr,r32,hi);asm volatile("s_nop 15\n\ts_nop 7":"+v"(pA0),"+v"(pA1));CMASK(pA0,pA1,0);
  START(pA0,pA1);
  _Pragma("unroll") for(int r=0;r<16;++r)pA1[r]=__builtin_amdgcn_exp2f(pA1[r]-mhat);
  WAIT_BAR(0);
  DMA_K(3,0);DMA_V(1,SLOTB);
  ROT();
  kload8(kf,kp0+sl_cur);
  WAIT_BAR(3);
  s16x4 vlo[3],vhi[3]; u32x4 pw0,pw1,pw2,pw3;
  #define PKW(P,B) cvtpk_s(P[B],P[B+1])
  #define PAF(k) __builtin_bit_cast(bf16x8,pw##k)
  #define VFJ(j) (bf16x8){vlo[(j)%3][0],vlo[(j)%3][1],vlo[(j)%3][2],vlo[(j)%3][3],vhi[(j)%3][0],vhi[(j)%3][1],vhi[(j)%3][2],vhi[(j)%3][3]}
  #define PIN(x) asm volatile("":"+v"(x))
  #define MX3(a,b,c) __builtin_fmaxf(__builtin_fmaxf((a),(b)),(c))
  #define GAPA(MF,A0,A1,A2,A3,W0,W1,PW) do{ MF; sacc+=A0; sacc+=A1; sacc+=A2; sacc+=A3; PIN(sacc); W0; W1; PIN(PW); SBAR(); }while(0)
  #define EX(v) __builtin_amdgcn_exp2f(v)
  #define VJ(j) do{ vlo[(j)%3]=vtr(vp_+(((j)&3)*4096+((j)>>2)*1024)); vhi[(j)%3]=vtr(vp_+(((j)&3)*4096+((j)>>2)*1024+512)); }while(0)
  #define PVJ(j,PA,X,B) do{ if((j)+2<16){ VJ((j)+2); SBAR(); } o[(j)&3]=__builtin_amdgcn_mfma_f32_32x32x16_bf16(PA,VFJ(j),o[(j)&3],0,0,0); X[B]=EX(X[B]-mhat); X[B+1]=EX(X[B+1]-mhat); PIN(X); SBAR(); }while(0)
  #define KRD(G,j) do{ if(G){ kload2(kf,kp0+sl_next,j); SBAR(); } }while(0)
  #define STEP(C0,C1,P0,P1,t,GK,GV,GL) do{ SBAR(); \
    const lds_cptr vp_=vp0+2*sl_prev; \
    float sacc=(P0[0]+P0[1]); \
    GAPA(C0=__builtin_amdgcn_mfma_f32_32x32x16_bf16(kf[0],qr[0],f32x16{},0,0,0), P0[2],P0[3],P0[4],P0[5],     pw0[0]=PKW(P0,0), pw0[1]=PKW(P0,2), pw0); \
    GAPA(C1=__builtin_amdgcn_mfma_f32_32x32x16_bf16(kf[1],qr[0],f32x16{},0,0,0), P0[6],P0[7],P0[8],P0[9],     pw0[2]=PKW(P0,4), pw0[3]=PKW(P0,6), pw0); \
    GAPA(C0=__builtin_amdgcn_mfma_f32_32x32x16_bf16(kf[2],qr[1],C0,0,0,0),   P0[10],P0[11],P0[12],P0[13], pw1[0]=PKW(P0,8), pw1[1]=PKW(P0,10), pw1); \
    GAPA(C1=__builtin_amdgcn_mfma_f32_32x32x16_bf16(kf[3],qr[1],C1,0,0,0),   P0[14],P0[15],P1[0],P1[1],   pw1[2]=PKW(P0,12),pw1[3]=PKW(P0,14), pw1); \
    GAPA(C0=__builtin_amdgcn_mfma_f32_32x32x16_bf16(kf[4],qr[2],C0,0,0,0),   P1[2],P1[3],P1[4],P1[5],     pw2[0]=PKW(P1,0), pw2[1]=PKW(P1,2), pw2); \
    GAPA(C1=__builtin_amdgcn_mfma_f32_32x32x16_bf16(kf[5],qr[2],C1,0,0,0),   P1[6],P1[7],P1[8],P1[9],     pw2[2]=PKW(P1,4), pw2[3]=PKW(P1,6), pw2); \
    GAPA(C0=__builtin_amdgcn_mfma_f32_32x32x16_bf16(kf[6],qr[3],C0,0,0,0),   P1[10],P1[11],P1[12],P1[13], pw3[0]=PKW(P1,8), pw3[1]=PKW(P1,10), pw3); \
    GAPA(C1=__builtin_amdgcn_mfma_f32_32x32x16_bf16(kf[7],qr[3],C1,0,0,0),   P1[14],P1[15],0.f,0.f,       pw3[2]=PKW(P1,12),pw3[3]=PKW(P1,14), pw3); \
    l_reg+=sacc; VJ(0); VJ(1); SBAR(); \
 \
    if(GK){DMA_K((t)+3,sl_cur);} if(GV){DMA_V((t)+1,sl_next);} \
    CMASK(C0,C1,t); \
    { float a=MX3(C0[0],C0[1],C1[0]),b=MX3(C0[2],C0[3],C1[1]); a=MX3(a,C1[2],C1[3]); \
      _Pragma("unroll") for(int r=4;r<16;r+=4){a=MX3(a,C0[r],C0[r+1]);b=MX3(b,C0[r+2],C0[r+3]);a=MX3(a,C1[r],C1[r+1]);b=MX3(b,C1[r+2],C1[r+3]);} \
      float rm=__builtin_fmaxf(a,b); { auto rr=__builtin_amdgcn_permlane32_swap(__float_as_uint(rm),__float_as_uint(rm),false,false); rm=__builtin_fmaxf(__uint_as_float(rr[0]),__uint_as_float(rr[1])); } \
      resc=false; const float rel=rm-mhat; \
      if(__builtin_expect(__any(rel>(float)THRL),0)){ const float dl=__builtin_fmaxf(rel,0.f); mhat+=dl; \
        const float f=__builtin_amdgcn_exp2f(-dl); l_reg*=f; if(hi==0)wsf[r32]=f; resc=true; } } \
    SBAR(); \
    PVJ(0, PAF(0),C0,0);  PVJ(1, PAF(0),C0,2);  PVJ(2, PAF(0),C0,4);  PVJ(3, PAF(0),C0,6); \
    KRD(GL,0); PVJ(4, PAF(1),C0,8);  PVJ(5, PAF(1),C0,10); KRD(GL,1); PVJ(6, PAF(1),C0,12); PVJ(7, PAF(1),C0,14); \
    KRD(GL,2); PVJ(8, PAF(2),C1,0);  PVJ(9, PAF(2),C1,2);  KRD(GL,3); PVJ(10,PAF(2),C1,4);  PVJ(11,PAF(2),C1,6); \
    PVJ(12,PAF(3),C1,8);  PVJ(13,PAF(3),C1,10); PVJ(14,PAF(3),C1,12); PVJ(15,PAF(3),C1,14); \
    }while(0)
  int t=1;
  #undef CMASK
  #define CMASK(P0,P1,t) do{}while(0)
  for(;t+5<NT;t+=2){
    STEP(pB0,pB1,pA0,pA1,t,true,true,true);     WAIT_BAR(3); RESC(); ROT();
    STEP(pA0,pA1,pB0,pB1,t+1,true,true,true);   WAIT_BAR(3); RESC(); ROT();
  }
  #undef CMASK
  int hi_b=hi,qrel_b=qrel; asm volatile("":"+v"(hi_b),"+v"(qrel_b));
  #define CMASK(P0,P1,t) do{int jb_=(t)-(NT-4); if(jb_>=0)cmask(P0,P1,jb_,qrel_b,hi_b);}while(0)
  #define ENDW(tt) do{ if((tt)+3<NT){WAIT_BAR(3);} else if((tt)+2<NT){WAIT_BAR(2);} else {WAIT_BAR(0);} }while(0)
  for(;t+1<NT;t+=2){
    STEP(pB0,pB1,pA0,pA1,t,(t+3<NT),(t+1<NT),(t+1<NT));       ENDW(t);   RESC(); ROT();
    STEP(pA0,pA1,pB0,pB1,t+1,(t+4<NT),(t+2<NT),(t+2<NT));     ENDW(t+1); RESC(); ROT();
  }
  STEP(pB0,pB1,pA0,pA1,NT-1,false,false,false); RESC();
  { float sacc=pB0[0]+pB0[1]; _Pragma("unroll") for(int r=2;r<16;++r)sacc+=pB0[r]; _Pragma("unroll") for(int r=0;r<16;++r)sacc+=pB1[r]; l_reg+=sacc;
    pw0=(u32x4){PKW(pB0,0),PKW(pB0,2),PKW(pB0,4),PKW(pB0,6)};pw1=(u32x4){PKW(pB0,8),PKW(pB0,10),PKW(pB0,12),PKW(pB0,14)};pw2=(u32x4){PKW(pB1,0),PKW(pB1,2),PKW(pB1,4),PKW(pB1,6)};pw3=(u32x4){PKW(pB1,8),PKW(pB1,10),PKW(pB1,12),PKW(pB1,14)};
    SBAR(); pv(o,vb0+2*sl_cur,PAF(0),PAF(1),PAF(2),PAF(3)); }
  #undef PKW
  #undef PAF
  #undef VFJ
  #undef VJ
  #undef PVJ
  #undef PIN
  #undef MX3
  #undef GAPA
  #undef EX
  #undef KRD
  #undef STEP
  #undef ENDW
  int lanee=lane; asm volatile("":"+v"(lanee)); const int r32e=lanee&31,hie=lanee>>5;
  {auto rr=__builtin_amdgcn_permlane32_swap(__float_as_uint(l_reg),__float_as_uint(l_reg),false,false);l_reg=__uint_as_float(rr[0])+__uint_as_float(rr[1]);}
  if(hie==0)wsf[32+r32e]=l_reg;asm volatile("s_waitcnt lgkmcnt(0)":::"memory");
  float rli[16];
  #pragma unroll
  for(int r=0;r<16;++r)rli[r]=__builtin_amdgcn_rcpf(wsf[32+crow(r,hie)]);
  bf16*Ow=Oh+(long)(q0+wid*QBLK)*LDO;
  asm volatile("s_waitcnt lgkmcnt(0)\n\ts_barrier":::"memory");
  { bf16*stg=(bf16*)(shm)+wid*4096;
    #pragma unroll
    for(int r=0;r<16;++r){const int orow=crow(r,hie);
      #pragma unroll
      for(int d0=0;d0<4;++d0)stg[orow*128+d0*32+r32e]=__float2bfloat16(o[d0][r]*rli[r]);}
    asm volatile("s_waitcnt lgkmcnt(0)":::"memory");
    #pragma unroll
    for(int i=0;i<8;++i){const int row=i*4+(lanee>>4),ch=lanee&15; const u32x4 v=*(const u32x4*)(stg+row*128+ch*8); ATTN_STORE16(Ow+(long)row*LDO+ch*8,v);} }
  asm volatile("s_waitcnt lgkmcnt(0)\n\ts_barrier":::"memory");
  #undef DMA_K
  #undef DMA_V
  #undef CMASK
  #undef START
  #undef RESC
  #undef ROT
}
constexpr int ATTN_LDS_BYTES=LDS_BYTES;
template<int THRL=8> __device__ __forceinline__ void attn_phase(char*lds,const bf16*PE,bf16*AO,int vcu,int G){
  const int nu=(G==256)?2:((8*NQB-vcu+G-1)/G);
  #pragma unroll 1
  for(int i=0;i<nu;++i){
    int h2,qb;
    if(G==256){ const int s=vcu&31; h2=vcu>>5; qb=(i==0)?s:63-s; }
    else { const int u=vcu+i*G; h2=u/NQB; qb=u%NQB; }
    attn_unit<THRL>(qb,PE+h2*64,PE+512+h2*64,PE+1024+(h2>>1)*128,AO+h2*128,lds);
  }
}
#undef SBAR
#undef WAIT_BAR
}

#define GAS __attribute__((address_space(1)))
#define LAS __attribute__((address_space(3)))
typedef unsigned short bf16;
typedef unsigned v4u __attribute__((ext_vector_type(4)));
typedef float f32x4 __attribute__((ext_vector_type(4)));
typedef short bf16x8 __attribute__((ext_vector_type(8)));
typedef GAS unsigned gu32;
typedef GAS unsigned long long gu64;
#define RLX_AGENT __ATOMIC_RELAXED, __HIP_MEMORY_SCOPE_AGENT
#define LDS_WAIT() asm volatile("s_waitcnt lgkmcnt(0)" ::: "memory")
#define VM_WAIT() asm volatile("s_waitcnt vmcnt(0)" ::: "memory")
__device__ __forceinline__ unsigned long long rt() { return __builtin_amdgcn_s_memrealtime(); }
__device__ __forceinline__ unsigned f2bf(float f) { unsigned u = __builtin_bit_cast(unsigned, f); return (u + 0x7fffu + ((u >> 16) & 1u)) >> 16; }
__device__ __forceinline__ unsigned pk2(float lo, float hi) { return f2bf(lo) | (f2bf(hi) << 16); }

#define XB_TMO      128
#define XB_XCNT(j)  (256  + 64 * (j))
#define XB_XSUB(j)  (1280 + 64 * (j))
#define XB_XGEN(j)  (2304 + 64 * (j))
#define XB_TOP      3328
#define XB_TOPGEN   3392
#define XCD_BAR_WORDS 3456
#define XB_SPIN_CAP (1u << 18)

__device__ __forceinline__ unsigned xb_ld(unsigned* p)              { return __hip_atomic_load(p, __ATOMIC_RELAXED, __HIP_MEMORY_SCOPE_AGENT); }
__device__ __forceinline__ unsigned xb_add(unsigned* p, unsigned v) { return __hip_atomic_fetch_add(p, v, __ATOMIC_RELAXED, __HIP_MEMORY_SCOPE_AGENT); }
__device__ __forceinline__ unsigned xb_xcc_id() { return (unsigned)__builtin_amdgcn_s_getreg((3 << 11) | 20) & 0xFu; }
#define XB_SPIN(cond, bar) do { unsigned _sp = 0; while (cond) { __builtin_amdgcn_s_sleep(1); \
    if ((++_sp & 255u) == 0u) { if (xb_ld(&(bar)[XB_TMO])) break; if (_sp > XB_SPIN_CAP) { atomicAdd(&(bar)[XB_TMO], 1u); break; } } } } while (0)

struct XcdBarrier {
    unsigned* bar; unsigned x;
    volatile LAS unsigned* st;
};

__device__ __forceinline__ XcdBarrier xcd_barrier_post(unsigned* bar, volatile LAS unsigned* st) {
    XcdBarrier b; b.bar = bar; b.x = xb_xcc_id(); b.st = st;
    if (threadIdx.x == 0) (void)xb_add(&bar[XB_XCNT(b.x)], 1u);
    return b;
}
__device__ __forceinline__ void xcd_barrier_complete(unsigned* bar, unsigned x, unsigned& nloc, unsigned& nx) {
    const unsigned G = gridDim.x * gridDim.y * gridDim.z;
    unsigned sum, cnt, mine, sp = 0u;
    for (;;) {
        sum = 0u; cnt = 0u; mine = 0u;
#pragma unroll
        for (unsigned j = 0; j < 16; ++j) { const unsigned c = xb_ld(&bar[XB_XCNT(j)]); sum += c; cnt += (c > 0u) ? 1u : 0u; mine = (j == x) ? c : mine; }
        if (sum == G) break;
        __builtin_amdgcn_s_sleep(1);
        if ((++sp & 255u) == 0u) { if (xb_ld(&bar[XB_TMO])) break; if (sp > XB_SPIN_CAP) { atomicAdd(&bar[XB_TMO], 1u); break; } }
    }
    nloc = mine > 0u ? mine : 1u; nx = cnt > 0u ? cnt : 1u;
}

__device__ __forceinline__ void xcd_barrier(const XcdBarrier& b) {
    asm volatile("s_waitcnt vmcnt(0)" ::: "memory");
    __syncthreads();
    if (threadIdx.x == 0) {
        unsigned* bar = b.bar;
        __builtin_amdgcn_s_waitcnt(0);
        unsigned nloc = b.st[0], nx = b.st[1];
        if (nloc == 0u) { xcd_barrier_complete(bar, b.x, nloc, nx); b.st[0] = nloc; b.st[1] = nx; }
        const unsigned old = xb_add(&bar[XB_XSUB(b.x)], 1u);
        const unsigned gen = old / nloc;
        if (old + 1u == (gen + 1u) * nloc) {
            __builtin_amdgcn_fence(__ATOMIC_RELEASE, "agent");
            asm volatile("s_waitcnt vmcnt(0)" ::: "memory");
            const unsigned og = xb_add(&bar[XB_TOP], 1u);
            const unsigned tg = og / nx;
            if (og + 1u == (tg + 1u) * nx) xb_add(&bar[XB_TOPGEN], 1u);
            else XB_SPIN(xb_ld(&bar[XB_TOPGEN]) == tg, bar);
            __builtin_amdgcn_fence(__ATOMIC_ACQUIRE, "agent");
            xb_add(&bar[XB_XGEN(b.x)], 1u);
            asm volatile("s_waitcnt vmcnt(0)" ::: "memory");
        } else {
            XB_SPIN(xb_ld(&bar[XB_XGEN(b.x)]) == gen, bar);
            __builtin_amdgcn_fence(__ATOMIC_ACQUIRE, "agent");
            asm volatile("s_waitcnt vmcnt(0)" ::: "memory");
        }
    }
    __syncthreads();
}

constexpr int NWAVES = 8;
constexpr size_t MiB = 1u << 20;
constexpr size_t WS_CTL = 0, CTL_ZERO_BYTES = 1 * MiB;
constexpr size_t WS_TAB = 1 * MiB;
constexpr size_t WS_SSQA = 2 * MiB, WS_SSQB = 3 * MiB;
constexpr size_t WS_GB = 4 * MiB;
constexpr size_t WS_GC = 512 * 1024;
constexpr size_t WS_TOK = 5 * MiB;
constexpr size_t WS_W = 6 * MiB;
constexpr size_t WS_WINE = WS_W, WS_WOUTE = WS_W + 12 * MiB, WS_W13D = WS_W + 16 * MiB, WS_W2D = WS_W + 44 * MiB, WS_WINO = WS_W + 58 * MiB  , WS_WOUTO = WS_W + 76 * MiB,
                 WS_WG = WS_W + 80 * MiB, WS_WP = WS_W + 88 * MiB, WS_W13M = WS_W + 90 * MiB, WS_W2M = WS_W + 202 * MiB;
static_assert(WS_W2M + 56 * MiB <= 264 * MiB, "weight copies end below the p copy");
constexpr size_t WS_PBF = 264 * MiB, WS_HBF = 296 * MiB, WS_PP = 328 * MiB, WS_MIX = 360 * MiB, WS_ARENA = 392 * MiB;
constexpr size_t AR_PE = 0, AR_AO = 96 * MiB;
constexpr size_t AR_PO = 0  , AR_QN = 144 * MiB, AR_KN = 176 * MiB, AR_KGT = 208 * MiB, AR_VBT = 240 * MiB, AR_KTT = 272 * MiB, AR_AI = 304 * MiB, AR_NEGW = 320 * MiB, AR_UT = 352 * MiB,
                 AR_SG = 384 * MiB  , AR_MPC = 448 * MiB  , AR_NTC = 464 * MiB, AR_END = 480 * MiB;
constexpr size_t AR_ACT = 0, AR_XS = 240 * MiB, AR_Y = 308 * MiB;
constexpr size_t WS_NEED = WS_ARENA + AR_END;
constexpr size_t TOK_E = 0, TOK_R = 128 * 1024, TOK_G = 256 * 1024, TOK_DST = 384 * 1024, TOK_GPAD = 512 * 1024, TOK_DN = 704 * 1024, TOK_DNC = 720 * 1024;
constexpr int CW_TMO = 0, CW_BAR = 4096, CW_CNT = 8192  , CW_DBG = 12288;

constexpr int RING_OFF = 0, WAVE_LDS = 17408;
constexpr int LDSCTL_OFF = 139264, MISC_OFF = LDSCTL_OFF + 64, BLKE_OFF = LDSCTL_OFF + 256  , RT_OFF = LDSCTL_OFF + 1024  ;
constexpr int LDS_BYTES = 147456;

typedef unsigned u32x2v __attribute__((ext_vector_type(2)));
__device__ __forceinline__ float bflo(unsigned w) { return __uint_as_float(w << 16); }
__device__ __forceinline__ float bfhi(unsigned w) { return __uint_as_float(w & 0xffff0000u); }
__device__ __forceinline__ unsigned cvtpk(float lo, float hi) { return pg8::cvt_pk_bf16_cv(lo, hi); }
__device__ __forceinline__ float wave_sum(float v) {
#pragma unroll
    for (int o = 1; o < 64; o <<= 1) v += __shfl_xor(v, o);
    return v;
}
__device__ __forceinline__ float sigm(float x) { return pg8::sigmoidf_(x); }
__device__ __forceinline__ float silu(float x) { return x * pg8::sigmoidf_(x); }

struct Args { const void* in[30]; float* out; unsigned char* ws; int ph_lo, ph_hi, use_bar, pad; };

struct Frame {
    LAS unsigned char* lds; int tid, lane, wave, vcu, G, gw, NGW;
};

struct XItem { f32x4 v[16]; };
__device__ __forceinline__ void xpose_load(XItem& x, const float* W, int ldw, int N, int item, int lane) {
    const int nblk = N / 64, kb = item / nblk, nb = item % nblk, k0 = 64 * kb, n0 = 64 * nb; const int lr = lane >> 4, lc = (lane & 15) * 4;
#pragma unroll
    for (int i = 0; i < 16; ++i) x.v[i] = *(const GAS f32x4*)(W + (size_t)(k0 + 4 * i + lr) * ldw + n0 + lc);
}
__device__ __forceinline__ void xpose_finish(XItem& x, int K, int N, const float* gain, bf16* WT, int ilv, LAS float* scr, int item, int lane) {
    const int nblk = N / 64, kb = item / nblk, nb = item % nblk, k0 = 64 * kb, n0 = 64 * nb; const int lr = lane >> 4, lc = (lane & 15) * 4;
    if (gain) {
#pragma unroll
        for (int i = 0; i < 16; ++i) x.v[i] = x.v[i] * gain[k0 + 4 * i + lr]; }
#pragma unroll
    for (int i = 0; i < 16; ++i) { LAS float* s = scr + (4 * i + lr) * 65 + lc; s[0] = x.v[i][0]; s[1] = x.v[i][1]; s[2] = x.v[i][2]; s[3] = x.v[i][3]; }
    LDS_WAIT(); asm volatile("" ::: "memory");
    const int c = lane & 7;
#pragma unroll
    for (int j = 0; j < 8; ++j) { const int nl = (lane >> 3) + 8 * j, n = n0 + nl; const LAS float* s = scr + (8 * c) * 65 + nl;
        const int dr = ilv ? (((n >> 7) << 8) + (n & 127) + (ilv == 2 ? 128 : 0)) : n;
        v4u o; o.x = pk2(s[0 * 65], s[1 * 65]); o.y = pk2(s[2 * 65], s[3 * 65]); o.z = pk2(s[4 * 65], s[5 * 65]); o.w = pk2(s[6 * 65], s[7 * 65]);
        *(GAS v4u*)(WT + (size_t)dr * K + k0 + 8 * c) = o; }
    LDS_WAIT(); asm volatile("" ::: "memory");
}
__device__ __forceinline__ void xpose_item(const float* W, int ldw, int K, int N, const float* gain, bf16* WT, int ilv, LAS float* scr, int item, int lane) {
    XItem x; xpose_load(x, W, ldw, N, item, lane); xpose_finish(x, K, N, gain, WT, ilv, scr, item, lane);
}
struct MatD { const float* W; int ldw, K, N; const float* gain; bf16* WT; int ilv; int items; };
__device__ __forceinline__ MatD dense_mat(const Args& a, int id) {
    unsigned char* ws = a.ws; MatD m; m.gain = nullptr; m.ilv = 0;
    if (id < 2)       { const int j = id;      m.W = (const float*)a.in[7] + (size_t)j * D_ * EIN;    m.ldw = EIN; m.K = D_; m.N = EIN; m.gain = (const float*)a.in[3] + (2 * j) * D_; m.WT = (bf16*)(ws + WS_WINE) + (size_t)j * EIN * D_; }
    else if (id < 4)  { const int j = id - 2;  m.W = (const float*)a.in[8] + (size_t)j * D_ * D_;     m.ldw = D_; m.K = D_; m.N = D_; m.WT = (bf16*)(ws + WS_WOUTE) + (size_t)j * D_ * D_; }
    else if (id < 6)  { const int j = id - 4;  m.W = (const float*)a.in[21] + (size_t)j * D_ * DFF;   m.ldw = DFF; m.K = D_; m.N = DFF; m.gain = (const float*)a.in[4] + (2 * j) * D_; m.WT = (bf16*)(ws + WS_W13D) + (size_t)j * 2 * DFF * D_; m.ilv = 1; }
    else if (id < 8)  { const int j = id - 6;  m.W = (const float*)a.in[22] + (size_t)j * D_ * DFF;   m.ldw = DFF; m.K = D_; m.N = DFF; m.gain = (const float*)a.in[4] + (2 * j) * D_; m.WT = (bf16*)(ws + WS_W13D) + (size_t)j * 2 * DFF * D_; m.ilv = 2; }
    else if (id < 10) { const int j = id - 8;  m.W = (const float*)a.in[23] + (size_t)j * DFF * D_;   m.ldw = D_; m.K = DFF; m.N = D_; m.WT = (bf16*)(ws + WS_W2D) + (size_t)j * D_ * DFF; }
    else if (id < 12) { const int j = id - 10; m.W = (const float*)a.in[15] + (size_t)j * D_ * OIN_SRC; m.ldw = OIN_SRC; m.K = D_; m.N = OIN_W; m.gain = (const float*)a.in[3] + (2 * j + 1) * D_; m.WT = (bf16*)(ws + WS_WINO) + (size_t)j * OIN_ROWS * D_; }
    else if (id < 14) { const int j = id - 12; m.W = (const float*)a.in[20] + (size_t)j * D_ * D_;    m.ldw = D_; m.K = D_; m.N = D_; m.WT = (bf16*)(ws + WS_WOUTO) + (size_t)j * D_ * D_; }
    else if (id < 18) { const int i = id - 14; m.W = (const float*)a.in[28] + (size_t)i * D_ * D_;    m.ldw = D_; m.K = D_; m.N = D_; m.gain = (const float*)a.in[5] + i * D_; m.WT = (bf16*)(ws + WS_WG) + (size_t)i * D_ * D_; }
    else              { const int i = id - 18; m.W = (const float*)a.in[29] + (size_t)i * PLE * D_;   m.ldw = D_; m.K = PLE; m.N = D_; m.WT = (bf16*)(ws + WS_WP) + (size_t)i * D_ * PLE; }
    m.items = (m.K / 64) * (m.N / 64); return m;
}
__device__ __forceinline__ MatD moe_mat(const Args& a, int j, int id) {
    unsigned char* ws = a.ws; MatD m; m.gain = nullptr; m.ilv = 0; const int e = id / 3, k = id % 3;
    if (k < 2) { m.W = (const float*)a.in[25 + k] + ((size_t)j * NEXP + e) * D_ * DFF; m.ldw = DFF; m.K = D_; m.N = DFF; m.gain = (const float*)a.in[4] + (2 * j + 1) * D_; m.WT = (bf16*)(ws + WS_W13M) + (size_t)e * 2 * DFF * D_; m.ilv = 1 + k; }
    else       { m.W = (const float*)a.in[27] + ((size_t)j * NEXP + e) * DFF * D_; m.ldw = D_; m.K = DFF; m.N = D_; m.WT = (bf16*)(ws + WS_W2M) + (size_t)e * D_ * DFF; }
    m.items = (m.K / 64) * (m.N / 64); return m;
}

__device__ __forceinline__ void p_prologue(const Frame& F, const Args& a) {
    LAS float* scr = (LAS float*)(F.lds + F.wave * WAVE_LDS);
    unsigned char* ws = a.ws;
    {
        int base = 0;
#pragma unroll 1
        for (int id = 0; id < 22; ++id) { const MatD m = dense_mat(a, id);
            int first = (F.gw - base) % F.NGW; if (first < 0) first += F.NGW;
#pragma unroll 1
            for (int it = first; it < m.items; it += F.NGW) xpose_item(m.W, m.ldw, m.K, m.N, m.gain, m.WT, m.ilv, scr, it, F.lane);
            base += m.items; }
    }
    for (int idx = F.gw * 64 + F.lane; idx < 2 * 16 * (D_ / 8); idx += F.NGW * 64) { const int j = idx / (16 * (D_ / 8)), r = (idx / (D_ / 8)) % 16, k0 = (idx % (D_ / 8)) * 8;
        const float* W = (const float*)a.in[15] + (size_t)j * D_ * OIN_SRC; const float* ln = (const float*)a.in[3] + (2 * j + 1) * D_; float v[8];
#pragma unroll
        for (int e = 0; e < 8; ++e) v[e] = ln[k0 + e] * W[(size_t)(k0 + e) * OIN_SRC + OIN_W + r];
        v4u o; o.x = cvtpk(v[0], v[1]); o.y = cvtpk(v[2], v[3]); o.z = cvtpk(v[4], v[5]); o.w = cvtpk(v[6], v[7]);
        *(GAS v4u*)((bf16*)(ws + WS_WINO) + ((size_t)j * OIN_ROWS + OIN_W + r) * D_ + k0) = o; }
    { const float* p = (const float*)a.in[1]; bf16* pb = (bf16*)(ws + WS_PBF); const size_t n8 = (size_t)DEPTH_ * S_ * PLE / 8;
#pragma unroll 1
      for (size_t i = (size_t)F.gw * 64 + F.lane; i < n8; i += (size_t)F.NGW * 64) { const f32x4 x0 = *(const GAS f32x4*)(p + i * 8), x1 = *(const GAS f32x4*)(p + i * 8 + 4);
          v4u o; o.x = cvtpk(x0[0], x0[1]); o.y = cvtpk(x0[2], x0[3]); o.z = cvtpk(x1[0], x1[1]); o.w = cvtpk(x1[2], x1[3]); *(GAS v4u*)(pb + i * 8) = o; } }
#ifdef PROBE_PRO_NOC
    if (a.use_bar)
#endif
    { const float* x = (const float*)a.in[0]; bf16* hb = (bf16*)(ws + WS_HBF); float* ssq = (float*)(ws + WS_SSQB);
#pragma unroll 1
      for (int m = F.gw; m < S_; m += F.NGW) { const GAS f32x4* xr = (const GAS f32x4*)(x + (size_t)m * D_) + F.lane; float s = 0.f;
#pragma unroll
          for (int j = 0; j < 4; ++j) { const f32x4 v = xr[64 * j]; s += (v[0] * v[0] + v[1] * v[1]) + (v[2] * v[2] + v[3] * v[3]);
              u32x2v o; o.x = cvtpk(v[0], v[1]); o.y = cvtpk(v[2], v[3]); *((GAS u32x2v*)(hb + (size_t)m * D_) + F.lane + 64 * j) = o; }
          s = wave_sum(s);
          if (F.lane < 16) ssq[(size_t)m * 16 + F.lane] = (F.lane == 0) ? s : 0.f; } }
    { const int* pos = (const int*)a.in[2]; float* tab = (float*)(ws + WS_TAB);
#pragma unroll 1
      for (int idx = F.gw * 64 + F.lane; idx < S_ * 8; idx += F.NGW * 64) { const int row = idx >> 3, i = idx & 7;
          const float inv = exp2f(-(float)i * (18.931568569324174f / 8.0f));
          const float ang = (float)pos[row] * inv;
          double t = (double)ang * 0.15915494309189535; t -= rint(t); const float tf = (float)t;
          tab[(size_t)row * 16 + i] = __builtin_amdgcn_cosf(tf); tab[(size_t)row * 16 + 8 + i] = __builtin_amdgcn_sinf(tf); } }
}

__device__ __forceinline__ void p_mixprep(const Frame& F, const Args& a, int L) {
    GAS unsigned char* ws = (GAS unsigned char*)a.ws; asm volatile("" : "+s"(ws)); int lane_ = F.lane; asm volatile("" : "+v"(lane_)); const int j = L >> 1, lane = lane_;
    const bf16* AO = (const bf16*)(ws + WS_ARENA + AR_AO); const bf16* PE = (const bf16*)(ws + WS_ARENA + AR_PE); bf16* mix = (bf16*)(ws + WS_MIX);
    const float lam0 = 0.8f - 0.6f * expf(-0.3f * (float)L);
    float s1 = ((const float*)a.in[9])[j * 64 + lane] * ((const float*)a.in[10])[j * 64 + lane], s2 = ((const float*)a.in[11])[j * 64 + lane] * ((const float*)a.in[12])[j * 64 + lane];
    s1 = wave_sum(s1); s2 = wave_sum(s2);
    const float lam = expf(s1) - expf(s2) + lam0, post = 1.0f - lam0;
    const int hh = lane >> 4, dd = (lane & 15) * 8, ch = lane * 8;
    float sg[8], w0[8], w1[8], w2[8];
#pragma unroll
    for (int e = 0; e < 8; ++e) { sg[e] = ((const float*)a.in[13])[j * 128 + dd + e] * post;
        w0[e] = ((const float*)a.in[14])[(j * 3 + 0) * 512 + ch + e]; w1[e] = ((const float*)a.in[14])[(j * 3 + 1) * 512 + ch + e]; w2[e] = ((const float*)a.in[14])[(j * 3 + 2) * 512 + ch + e]; }
#pragma unroll 1
    for (int t = F.gw; t < S_; t += F.NGW) {
        const v4u o1 = *(const GAS v4u*)(AO + (size_t)t * D_ + 256 * hh + dd), o2 = *(const GAS v4u*)(AO + (size_t)t * D_ + 256 * hh + 128 + dd);
        float d[8]; const unsigned a1[4] = {o1.x, o1.y, o1.z, o1.w}, a2[4] = {o2.x, o2.y, o2.z, o2.w}; float ss = 0.f;
#pragma unroll
        for (int q = 0; q < 4; ++q) { d[2 * q] = bflo(a1[q]) - lam * bflo(a2[q]); d[2 * q + 1] = bfhi(a1[q]) - lam * bfhi(a2[q]); ss += d[2 * q] * d[2 * q] + d[2 * q + 1] * d[2 * q + 1]; }
        ss += __shfl_xor(ss, 1); ss += __shfl_xor(ss, 2); ss += __shfl_xor(ss, 4); ss += __shfl_xor(ss, 8);
        const float rms = __builtin_amdgcn_rsqf(ss * (1.0f / 128.0f) + 1e-5f);
        v4u o; o.x = cvtpk(d[0] * rms * sg[0], d[1] * rms * sg[1]); o.y = cvtpk(d[2] * rms * sg[2], d[3] * rms * sg[3]); o.z = cvtpk(d[4] * rms * sg[4], d[5] * rms * sg[5]); o.w = cvtpk(d[6] * rms * sg[6], d[7] * rms * sg[7]);
        *(GAS v4u*)(mix + (size_t)t * D_ + hh * 128 + dd) = o;
        const bf16* r0 = PE + (size_t)t * EIN;
        const v4u bb = *(const GAS v4u*)(r0 + 1536 + ch), c0 = *(const GAS v4u*)(r0 + 2048 + ch), x0 = *(const GAS v4u*)(r0 + 2560 + ch);
        v4u c1 = {0u, 0u, 0u, 0u}, x1 = c1, c2 = c1, x2 = c1;
        if (t >= 1) { c1 = *(const GAS v4u*)(r0 - EIN + 2048 + ch); x1 = *(const GAS v4u*)(r0 - EIN + 2560 + ch); }
        if (t >= 2) { c2 = *(const GAS v4u*)(r0 - 2 * EIN + 2048 + ch); x2 = *(const GAS v4u*)(r0 - 2 * EIN + 2560 + ch); }
        const unsigned B[4] = {bb.x, bb.y, bb.z, bb.w}, C0[4] = {c0.x, c0.y, c0.z, c0.w}, X0[4] = {x0.x, x0.y, x0.z, x0.w}, C1[4] = {c1.x, c1.y, c1.z, c1.w}, X1[4] = {x1.x, x1.y, x1.z, x1.w},
                       C2[4] = {c2.x, c2.y, c2.z, c2.w}, X2[4] = {x2.x, x2.y, x2.z, x2.w};
        float sc[8];
#pragma unroll
        for (int q = 0; q < 4; ++q) {
            sc[2 * q] = bflo(B[q]) * (w2[2 * q] * (bflo(C0[q]) * bflo(X0[q])) + w1[2 * q] * (bflo(C1[q]) * bflo(X1[q])) + w0[2 * q] * (bflo(C2[q]) * bflo(X2[q])));
            sc[2 * q + 1] = bfhi(B[q]) * (w2[2 * q + 1] * (bfhi(C0[q]) * bfhi(X0[q])) + w1[2 * q + 1] * (bfhi(C1[q]) * bfhi(X1[q])) + w0[2 * q + 1] * (bfhi(C2[q]) * bfhi(X2[q]))); }
        v4u so; so.x = cvtpk(sc[0], sc[1]); so.y = cvtpk(sc[2], sc[3]); so.z = cvtpk(sc[4], sc[5]); so.w = cvtpk(sc[6], sc[7]);
        *(GAS v4u*)(mix + (size_t)t * D_ + 512 + ch) = so;
    }
}


__device__ __forceinline__ void p_ab(const Frame& F, const Args& a, int L) {
    GAS unsigned char* ws = (GAS unsigned char*)a.ws; asm volatile("" : "+s"(ws)); int lane_ = F.lane; asm volatile("" : "+v"(lane_)); const int j = L >> 1, lane = lane_, r16 = lane & 15, g = lane >> 4;
    const bf16* hb = (const bf16*)(ws + WS_HBF); const bf16* Wab = (const bf16*)(ws + WS_WINO) + ((size_t)j * OIN_ROWS + OIN_W) * D_;
    const float* ssq = (const float*)(ws + WS_SSQB); float* gg = (float*)(ws + WS_GB); float* gbeta = gg + S_ * 8;
    const float ealog = expf(*(const GAS float*)((const float*)a.in[17] + j * 8 + (r16 & 7))), dtb = *(const GAS float*)((const float*)a.in[18] + j * 8 + (r16 & 7));
    if (F.wave & 1) return;
#pragma unroll 1
    for (int task = F.vcu * 4 + (F.wave >> 1); task < S_ / 16; task += F.G * 4) {
        const int t0 = 16 * task; f32x4 acc = {0.f, 0.f, 0.f, 0.f};
#pragma unroll 8
        for (int s = 0; s < 32; ++s) { const bf16x8 wf = *(const GAS bf16x8*)(Wab + (size_t)r16 * D_ + 32 * s + 8 * g), xf = *(const GAS bf16x8*)(hb + (size_t)(t0 + r16) * D_ + 32 * s + 8 * g);
            acc = __builtin_amdgcn_mfma_f32_16x16x32_bf16(wf, xf, acc, 0, 0, 0); }
#pragma unroll
        for (int r = 0; r < 4; ++r) { const int c = 4 * g + r, t = t0 + r16; const float v = acc[r] * pg8::rstd_row(ssq, t);
            const float al = __shfl(ealog, c & 7), db = __shfl(dtb, c & 7);
            const float z = v + db; const float gv = -al * (z > 20.f ? z : log1pf(expf(z)));
            if (c < 8) gbeta[(size_t)t * 8 + c] = sigm(v); else gg[(size_t)t * 8 + c - 8] = gv; }
    }
}

__device__ __forceinline__ void p_rot_tiles(const Frame& F, const Args& a, const pg8::StaticOrder& So) {
    GAS unsigned char* ws = (GAS unsigned char*)a.ws; asm volatile("" : "+s"(ws)); int tid_ = F.tid; asm volatile("" : "+v"(tid_));
    bf16* PE = (bf16*)(ws + WS_ARENA + AR_PE); const float* tab = (const float*)(ws + WS_TAB);
    asm volatile("s_waitcnt vmcnt(0)" ::: "memory"); __syncthreads();
    pg8::Unit u;
#pragma unroll 1
    for (int i = 0; So.next(i, u); ++i) {
        if (u.pn >= 4) continue;
#pragma unroll
        for (int q = 0; q < 2; ++q) { const int it = tid_ + 512 * q, row = u.pm * 256 + (it >> 2), col = u.pn * 256 + (it & 3) * 64;
            GAS v4u* p = (GAS v4u*)(PE + (size_t)row * EIN + col); const v4u x1 = p[0], x2 = p[1];
            const GAS f32x4* t = (const GAS f32x4*)(tab + (size_t)row * 16); const f32x4 c0 = t[0], c1 = t[1], s0 = t[2], s1 = t[3];
            const unsigned A[4] = {x1.x, x1.y, x1.z, x1.w}, B[4] = {x2.x, x2.y, x2.z, x2.w}; unsigned oa[4], ob[4];
#pragma unroll
            for (int w = 0; w < 4; ++w) { const float cl = (w < 2 ? c0 : c1)[2 * (w & 1)], ch = (w < 2 ? c0 : c1)[2 * (w & 1) + 1], sl = (w < 2 ? s0 : s1)[2 * (w & 1)], sh = (w < 2 ? s0 : s1)[2 * (w & 1) + 1];
                const float a0 = bflo(A[w]), a1 = bfhi(A[w]), b0 = bflo(B[w]), b1 = bfhi(B[w]);
                oa[w] = cvtpk(a0 * cl - b0 * sl, a1 * ch - b1 * sh); ob[w] = cvtpk(b0 * cl + a0 * sl, b1 * ch + a1 * sh); }
            p[0] = (v4u){oa[0], oa[1], oa[2], oa[3]}; p[1] = (v4u){ob[0], ob[1], ob[2], ob[3]}; }
    }
}
__device__ __forceinline__ void tri_solve(const LAS float* Lc, LAS bf16* Xs, int lane) {
    float x0, x1, x2, x3, x4, x5, x6, x7, x8, x9, x10, x11, x12, x13, x14, x15, x16, x17, x18, x19, x20, x21, x22, x23, x24, x25, x26, x27, x28, x29, x30, x31, x32, x33, x34, x35, x36, x37, x38, x39, x40, x41, x42, x43, x44, x45, x46, x47, x48, x49, x50, x51, x52, x53, x54, x55, x56, x57, x58, x59, x60, x61, x62, x63;
    { x63 = (lane == 63) ? 1.0f : 0.0f; asm volatile("" : "+v"(x63) : : "memory"); }
    { float s0 = 0.f, s1 = 0.f, s2 = 0.f, s3 = 0.f; { const f32x4 l = *(const LAS f32x4*)(Lc + 4276); s3 = fmaf(x63, l[3], s3); } x62 = (lane == 62) ? 1.0f : -((s0 + s1) + (s2 + s3)); asm volatile("" : "+v"(x62) : : "memory"); }
    { float s0 = 0.f, s1 = 0.f, s2 = 0.f, s3 = 0.f; { const f32x4 l = *(const LAS f32x4*)(Lc + 4208); s2 = fmaf(x62, l[2], s2); s3 = fmaf(x63, l[3], s3); } x61 = (lane == 61) ? 1.0f : -((s0 + s1) + (s2 + s3)); asm volatile("" : "+v"(x61) : : "memory"); }
    { float s0 = 0.f, s1 = 0.f, s2 = 0.f, s3 = 0.f; { const f32x4 l = *(const LAS f32x4*)(Lc + 4140); s1 = fmaf(x61, l[1], s1); s2 = fmaf(x62, l[2], s2); s3 = fmaf(x63, l[3], s3); } x60 = (lane == 60) ? 1.0f : -((s0 + s1) + (s2 + s3)); asm volatile("" : "+v"(x60) : : "memory"); }
    { float s0 = 0.f, s1 = 0.f, s2 = 0.f, s3 = 0.f; { const f32x4 l = *(const LAS f32x4*)(Lc + 4072); s0 = fmaf(x60, l[0], s0); s1 = fmaf(x61, l[1], s1); s2 = fmaf(x62, l[2], s2); s3 = fmaf(x63, l[3], s3); } x59 = (lane == 59) ? 1.0f : -((s0 + s1) + (s2 + s3)); asm volatile("" : "+v"(x59) : : "memory"); }
    { float s0 = 0.f, s1 = 0.f, s2 = 0.f, s3 = 0.f; { const f32x4 l = *(const LAS f32x4*)(Lc + 4000); s3 = fmaf(x59, l[3], s3); } { const f32x4 l = *(const LAS f32x4*)(Lc + 4004); s0 = fmaf(x60, l[0], s0); s1 = fmaf(x61, l[1], s1); s2 = fmaf(x62, l[2], s2); s3 = fmaf(x63, l[3], s3); } x58 = (lane == 58) ? 1.0f : -((s0 + s1) + (s2 + s3)); asm volatile("" : "+v"(x58) : : "memory"); }
    { float s0 = 0.f, s1 = 0.f, s2 = 0.f, s3 = 0.f; { const f32x4 l = *(const LAS f32x4*)(Lc + 3932); s2 = fmaf(x58, l[2], s2); s3 = fmaf(x59, l[3], s3); } { const f32x4 l = *(const LAS f32x4*)(Lc + 3936); s0 = fmaf(x60, l[0], s0); s1 = fmaf(x61, l[1], s1); s2 = fmaf(x62, l[2], s2); s3 = fmaf(x63, l[3], s3); } x57 = (lane == 57) ? 1.0f : -((s0 + s1) + (s2 + s3)); asm volatile("" : "+v"(x57) : : "memory"); }
    { float s0 = 0.f, s1 = 0.f, s2 = 0.f, s3 = 0.f; { const f32x4 l = *(const LAS f32x4*)(Lc + 3864); s1 = fmaf(x57, l[1], s1); s2 = fmaf(x58, l[2], s2); s3 = fmaf(x59, l[3], s3); } { const f32x4 l = *(const LAS f32x4*)(Lc + 3868); s0 = fmaf(x60, l[0], s0); s1 = fmaf(x61, l[1], s1); s2 = fmaf(x62, l[2], s2); s3 = fmaf(x63, l[3], s3); } x56 = (lane == 56) ? 1.0f : -((s0 + s1) + (s2 + s3)); asm volatile("" : "+v"(x56) : : "memory"); }
    { float s0 = 0.f, s1 = 0.f, s2 = 0.f, s3 = 0.f; { const f32x4 l = *(const LAS f32x4*)(Lc + 3796); s0 = fmaf(x56, l[0], s0); s1 = fmaf(x57, l[1], s1); s2 = fmaf(x58, l[2], s2); s3 = fmaf(x59, l[3], s3); } { const f32x4 l = *(const LAS f32x4*)(Lc + 3800); s0 = fmaf(x60, l[0], s0); s1 = fmaf(x61, l[1], s1); s2 = fmaf(x62, l[2], s2); s3 = fmaf(x63, l[3], s3); } x55 = (lane == 55) ? 1.0f : -((s0 + s1) + (s2 + s3)); asm volatile("" : "+v"(x55) : : "memory"); }
    { float s0 = 0.f, s1 = 0.f, s2 = 0.f, s3 = 0.f; { const f32x4 l = *(const LAS f32x4*)(Lc + 3724); s3 = fmaf(x55, l[3], s3); } { const f32x4 l = *(const LAS f32x4*)(Lc + 3728); s0 = fmaf(x56, l[0], s0); s1 = fmaf(x57, l[1], s1); s2 = fmaf(x58, l[2], s2); s3 = fmaf(x59, l[3], s3); } { const f32x4 l = *(const LAS f32x4*)(Lc + 3732); s0 = fmaf(x60, l[0], s0); s1 = fmaf(x61, l[1], s1); s2 = fmaf(x62, l[2], s2); s3 = fmaf(x63, l[3], s3); } x54 = (lane == 54) ? 1.0f : -((s0 + s1) + (s2 + s3)); asm volatile("" : "+v"(x54) : : "memory"); }
    { float s0 = 0.f, s1 = 0.f, s2 = 0.f, s3 = 0.f; { const f32x4 l = *(const LAS f32x4*)(Lc + 3656); s2 = fmaf(x54, l[2], s2); s3 = fmaf(x55, l[3], s3); } { const f32x4 l = *(const LAS f32x4*)(Lc + 3660); s0 = fmaf(x56, l[0], s0); s1 = fmaf(x57, l[1], s1); s2 = fmaf(x58, l[2], s2); s3 = fmaf(x59, l[3], s3); } { const f32x4 l = *(const LAS f32x4*)(Lc + 3664); s0 = fmaf(x60, l[0], s0); s1 = fmaf(x61, l[1], s1); s2 = fmaf(x62, l[2], s2); s3 = fmaf(x63, l[3], s3); } x53 = (lane == 53) ? 1.0f : -((s0 + s1) + (s2 + s3)); asm volatile("" : "+v"(x53) : : "memory"); }
    { float s0 = 0.f, s1 = 0.f, s2 = 0.f, s3 = 0.f; { const f32x4 l = *(const LAS f32x4*)(Lc + 3588); s1 = fmaf(x53, l[1], s1); s2 = fmaf(x54, l[2], s2); s3 = fmaf(x55, l[3], s3); } { const f32x4 l = *(const LAS f32x4*)(Lc + 3592); s0 = fmaf(x56, l[0], s0); s1 = fmaf(x57, l[1], s1); s2 = fmaf(x58, l[2], s2); s3 = fmaf(x59, l[3], s3); } { const f32x4 l = *(const LAS f32x4*)(Lc + 3596); s0 = fmaf(x60, l[0], s0); s1 = fmaf(x61, l[1], s1); s2 = fmaf(x62, l[2], s2); s3 = fmaf(x63, l[3], s3); } x52 = (lane == 52) ? 1.0f : -((s0 + s1) + (s2 + s3)); asm volatile("" : "+v"(x52) : : "memory"); }
    { float s0 = 0.f, s1 = 0.f, s2 = 0.f, s3 = 0.f; { const f32x4 l = *(const LAS f32x4*)(Lc + 3520); s0 = fmaf(x52, l[0], s0); s1 = fmaf(x53, l[1], s1); s2 = fmaf(x54, l[2], s2); s3 = fmaf(x55, l[3], s3); } { const f32x4 l = *(const LAS f32x4*)(Lc + 3524); s0 = fmaf(x56, l[0], s0); s1 = fmaf(x57, l[1], s1); s2 = fmaf(x58, l[2], s2); s3 = fmaf(x59, l[3], s3); } { const f32x4 l = *(const LAS f32x4*)(Lc + 3528); s0 = fmaf(x60, l[0], s0); s1 = fmaf(x61, l[1], s1); s2 = fmaf(x62, l[2], s2); s3 = fmaf(x63, l[3], s3); } x51 = (lane == 51) ? 1.0f : -((s0 + s1) + (s2 + s3)); asm volatile("" : "+v"(x51) : : "memory"); }
    { float s0 = 0.f, s1 = 0.f, s2 = 0.f, s3 = 0.f; { const f32x4 l = *(const LAS f32x4*)(Lc + 3448); s3 = fmaf(x51, l[3], s3); } { const f32x4 l = *(const LAS f32x4*)(Lc + 3452); s0 = fmaf(x52, l[0], s0); s1 = fmaf(x53, l[1], s1); s2 = fmaf(x54, l[2], s2); s3 = fmaf(x55, l[3], s3); } { const f32x4 l = *(const LAS f32x4*)(Lc + 3456); s0 = fmaf(x56, l[0], s0); s1 = fmaf(x57, l[1], s1); s2 = fmaf(x58, l[2], s2); s3 = fmaf(x59, l[3], s3); } { const f32x4 l = *(const LAS f32x4*)(Lc + 3460); s0 = fmaf(x60, l[0], s0); s1 = fmaf(x61, l[1], s1); s2 = fmaf(x62, l[2], s2); s3 = fmaf(x63, l[3], s3); } x50 = (lane == 50) ? 1.0f : -((s0 + s1) + (s2 + s3)); asm volatile("" : "+v"(x50) : : "memory"); }
    { float s0 = 0.f, s1 = 0.f, s2 = 0.f, s3 = 0.f; { const f32x4 l = *(const LAS f32x4*)(Lc + 3380); s2 = fmaf(x50, l[2], s2); s3 = fmaf(x51, l[3], s3); } { const f32x4 l = *(const LAS f32x4*)(Lc + 3384); s0 = fmaf(x52, l[0], s0); s1 = fmaf(x53, l[1], s1); s2 = fmaf(x54, l[2], s2); s3 = fmaf(x55, l[3], s3); } { const f32x4 l = *(const LAS f32x4*)(Lc + 3388); s0 = fmaf(x56, l[0], s0); s1 = fmaf(x57, l[1], s1); s2 = fmaf(x58, l[2], s2); s3 = fmaf(x59, l[3], s3); } { const f32x4 l = *(const LAS f32x4*)(Lc + 3392); s0 = fmaf(x60, l[0], s0); s1 = fmaf(x61, l[1], s1); s2 = fmaf(x62, l[2], s2); s3 = fmaf(x63, l[3], s3); } x49 = (lane == 49) ? 1.0f : -((s0 + s1) + (s2 + s3)); asm volatile("" : "+v"(x49) : : "memory"); }
    { float s0 = 0.f, s1 = 0.f, s2 = 0.f, s3 = 0.f; { const f32x4 l = *(const LAS f32x4*)(Lc + 3312); s1 = fmaf(x49, l[1], s1); s2 = fmaf(x50, l[2], s2); s3 = fmaf(x51, l[3], s3); } { const f32x4 l = *(const LAS f32x4*)(Lc + 3316); s0 = fmaf(x52, l[0], s0); s1 = fmaf(x53, l[1], s1); s2 = fmaf(x54, l[2], s2); s3 = fmaf(x55, l[3], s3); } { const f32x4 l = *(const LAS f32x4*)(Lc + 3320); s0 = fmaf(x56, l[0], s0); s1 = fmaf(x57, l[1], s1); s2 = fmaf(x58, l[2], s2); s3 = fmaf(x59, l[3], s3); } { const f32x4 l = *(const LAS f32x4*)(Lc + 3324); s0 = fmaf(x60, l[0], s0); s1 = fmaf(x61, l[1], s1); s2 = fmaf(x62, l[2], s2); s3 = fmaf(x63, l[3], s3); } x48 = (lane == 48) ? 1.0f : -((s0 + s1) + (s2 + s3)); asm volatile("" : "+v"(x48) : : "memory"); }
    { float s0 = 0.f, s1 = 0.f, s2 = 0.f, s3 = 0.f; { const f32x4 l = *(const LAS f32x4*)(Lc + 3244); s0 = fmaf(x48, l[0], s0); s1 = fmaf(x49, l[1], s1); s2 = fmaf(x50, l[2], s2); s3 = fmaf(x51, l[3], s3); } { const f32x4 l = *(const LAS f32x4*)(Lc + 3248); s0 = fmaf(x52, l[0], s0); s1 = fmaf(x53, l[1], s1); s2 = fmaf(x54, l[2], s2); s3 = fmaf(x55, l[3], s3); } { const f32x4 l = *(const LAS f32x4*)(Lc + 3252); s0 = fmaf(x56, l[0], s0); s1 = fmaf(x57, l[1], s1); s2 = fmaf(x58, l[2], s2); s3 = fmaf(x59, l[3], s3); } { const f32x4 l = *(const LAS f32x4*)(Lc + 3256); s0 = fmaf(x60, l[0], s0); s1 = fmaf(x61, l[1], s1); s2 = fmaf(x62, l[2], s2); s3 = fmaf(x63, l[3], s3); } x47 = (lane == 47) ? 1.0f : -((s0 + s1) + (s2 + s3)); asm volatile("" : "+v"(x47) : : "memory"); }
    { float s0 = 0.f, s1 = 0.f, s2 = 0.f, s3 = 0.f; { const f32x4 l = *(const LAS f32x4*)(Lc + 3172); s3 = fmaf(x47, l[3], s3); } { const f32x4 l = *(const LAS f32x4*)(Lc + 3176); s0 = fmaf(x48, l[0], s0); s1 = fmaf(x49, l[1], s1); s2 = fmaf(x50, l[2], s2); s3 = fmaf(x51, l[3], s3); } { const f32x4 l = *(const LAS f32x4*)(Lc + 3180); s0 = fmaf(x52, l[0], s0); s1 = fmaf(x53, l[1], s1); s2 = fmaf(x54, l[2], s2); s3 = fmaf(x55, l[3], s3); } { const f32x4 l = *(const LAS f32x4*)(Lc + 3184); s0 = fmaf(x56, l[0], s0); s1 = fmaf(x57, l[1], s1); s2 = fmaf(x58, l[2], s2); s3 = fmaf(x59, l[3], s3); } { const f32x4 l = *(const LAS f32x4*)(Lc + 3188); s0 = fmaf(x60, l[0], s0); s1 = fmaf(x61, l[1], s1); s2 = fmaf(x62, l[2], s2); s3 = fmaf(x63, l[3], s3); } x46 = (lane == 46) ? 1.0f : -((s0 + s1) + (s2 + s3)); asm volatile("" : "+v"(x46) : : "memory"); }
    { float s0 = 0.f, s1 = 0.f, s2 = 0.f, s3 = 0.f; { const f32x4 l = *(const LAS f32x4*)(Lc + 3104); s2 = fmaf(x46, l[2], s2); s3 = fmaf(x47, l[3], s3); } { const f32x4 l = *(const LAS f32x4*)(Lc + 3108); s0 = fmaf(x48, l[0], s0); s1 = fmaf(x49, l[1], s1); s2 = fmaf(x50, l[2], s2); s3 = fmaf(x51, l[3], s3); } { const f32x4 l = *(const LAS f32x4*)(Lc + 3112); s0 = fmaf(x52, l[0], s0); s1 = fmaf(x53, l[1], s1); s2 = fmaf(x54, l[2], s2); s3 = fmaf(x55, l[3], s3); } { const f32x4 l = *(const LAS f32x4*)(Lc + 3116); s0 = fmaf(x56, l[0], s0); s1 = fmaf(x57, l[1], s1); s2 = fmaf(x58, l[2], s2); s3 = fmaf(x59, l[3], s3); } { const f32x4 l = *(const LAS f32x4*)(Lc + 3120); s0 = fmaf(x60, l[0], s0); s1 = fmaf(x61, l[1], s1); s2 = fmaf(x62, l[2], s2); s3 = fmaf(x63, l[3], s3); } x45 = (lane == 45) ? 1.0f : -((s0 + s1) + (s2 + s3)); asm volatile("" : "+v"(x45) : : "memory"); }
    { float s0 = 0.f, s1 = 0.f, s2 = 0.f, s3 = 0.f; { const f32x4 l = *(const LAS f32x4*)(Lc + 3036); s1 = fmaf(x45, l[1], s1); s2 = fmaf(x46, l[2], s2); s3 = fmaf(x47, l[3], s3); } { const f32x4 l = *(const LAS f32x4*)(Lc + 3040); s0 = fmaf(x48, l[0], s0); s1 = fmaf(x49, l[1], s1); s2 = fmaf(x50, l[2], s2); s3 = fmaf(x51, l[3], s3); } { const f32x4 l = *(const LAS f32x4*)(Lc + 3044); s0 = fmaf(x52, l[0], s0); s1 = fmaf(x53, l[1], s1); s2 = fmaf(x54, l[2], s2); s3 = fmaf(x55, l[3], s3); } { const f32x4 l = *(const LAS f32x4*)(Lc + 3048); s0 = fmaf(x56, l[0], s0); s1 = fmaf(x57, l[1], s1); s2 = fmaf(x58, l[2], s2); s3 = fmaf(x59, l[3], s3); } { const f32x4 l = *(const LAS f32x4*)(Lc + 3052); s0 = fmaf(x60, l[0], s0); s1 = fmaf(x61, l[1], s1); s2 = fmaf(x62, l[2], s2); s3 = fmaf(x63, l[3], s3); } x44 = (lane == 44) ? 1.0f : -((s0 + s1) + (s2 + s3)); asm volatile("" : "+v"(x44) : : "memory"); }
    { float s0 = 0.f, s1 = 0.f, s2 = 0.f, s3 = 0.f; { const f32x4 l = *(const LAS f32x4*)(Lc + 2968); s0 = fmaf(x44, l[0], s0); s1 = fmaf(x45, l[1], s1); s2 = fmaf(x46, l[2], s2); s3 = fmaf(x47, l[3], s3); } { const f32x4 l = *(const LAS f32x4*)(Lc + 2972); s0 = fmaf(x48, l[0], s0); s1 = fmaf(x49, l[1], s1); s2 = fmaf(x50, l[2], s2); s3 = fmaf(x51, l[3], s3); } { const f32x4 l = *(const LAS f32x4*)(Lc + 2976); s0 = fmaf(x52, l[0], s0); s1 = fmaf(x53, l[1], s1); s2 = fmaf(x54, l[2], s2); s3 = fmaf(x55, l[3], s3); } { const f32x4 l = *(const LAS f32x4*)(Lc + 2980); s0 = fmaf(x56, l[0], s0); s1 = fmaf(x57, l[1], s1); s2 = fmaf(x58, l[2], s2); s3 = fmaf(x59, l[3], s3); } { const f32x4 l = *(const LAS f32x4*)(Lc + 2984); s0 = fmaf(x60, l[0], s0); s1 = fmaf(x61, l[1], s1); s2 = fmaf(x62, l[2], s2); s3 = fmaf(x63, l[3], s3); } x43 = (lane == 43) ? 1.0f : -((s0 + s1) + (s2 + s3)); asm volatile("" : "+v"(x43) : : "memory"); }
    { float s0 = 0.f, s1 = 0.f, s2 = 0.f, s3 = 0.f; { const f32x4 l = *(const LAS f32x4*)(Lc + 2896); s3 = fmaf(x43, l[3], s3); } { const f32x4 l = *(const LAS f32x4*)(Lc + 2900); s0 = fmaf(x44, l[0], s0); s1 = fmaf(x45, l[1], s1); s2 = fmaf(x46, l[2], s2); s3 = fmaf(x47, l[3], s3); } { const f32x4 l = *(const LAS f32x4*)(Lc + 2904); s0 = fmaf(x48, l[0], s0); s1 = fmaf(x49, l[1], s1); s2 = fmaf(x50, l[2], s2); s3 = fmaf(x51, l[3], s3); } { const f32x4 l = *(const LAS f32x4*)(Lc + 2908); s0 = fmaf(x52, l[0], s0); s1 = fmaf(x53, l[1], s1); s2 = fmaf(x54, l[2], s2); s3 = fmaf(x55, l[3], s3); } { const f32x4 l = *(const LAS f32x4*)(Lc + 2912); s0 = fmaf(x56, l[0], s0); s1 = fmaf(x57, l[1], s1); s2 = fmaf(x58, l[2], s2); s3 = fmaf(x59, l[3], s3); } { const f32x4 l = *(const LAS f32x4*)(Lc + 2916); s0 = fmaf(x60, l[0], s0); s1 = fmaf(x61, l[1], s1); s2 = fmaf(x62, l[2], s2); s3 = fmaf(x63, l[3], s3); } x42 = (lane == 42) ? 1.0f : -((s0 + s1) + (s2 + s3)); asm volatile("" : "+v"(x42) : : "memory"); }
    { float s0 = 0.f, s1 = 0.f, s2 = 0.f, s3 = 0.f; { const f32x4 l = *(const LAS f32x4*)(Lc + 2828); s2 = fmaf(x42, l[2], s2); s3 = fmaf(x43, l[3], s3); } { const f32x4 l = *(const LAS f32x4*)(Lc + 2832); s0 = fmaf(x44, l[0], s0); s1 = fmaf(x45, l[1], s1); s2 = fmaf(x46, l[2], s2); s3 = fmaf(x47, l[3], s3); } { const f32x4 l = *(const LAS f32x4*)(Lc + 2836); s0 = fmaf(x48, l[0], s0); s1 = fmaf(x49, l[1], s1); s2 = fmaf(x50, l[2], s2); s3 = fmaf(x51, l[3], s3); } { const f32x4 l = *(const LAS f32x4*)(Lc + 2840); s0 = fmaf(x52, l[0], s0); s1 = fmaf(x53, l[1], s1); s2 = fmaf(x54, l[2], s2); s3 = fmaf(x55, l[3], s3); } { const f32x4 l = *(const LAS f32x4*)(Lc + 2844); s0 = fmaf(x56, l[0], s0); s1 = fmaf(x57, l[1], s1); s2 = fmaf(x58, l[2], s2); s3 = fmaf(x59, l[3], s3); } { const f32x4 l = *(const LAS f32x4*)(Lc + 2848); s0 = fmaf(x60, l[0], s0); s1 = fmaf(x61, l[1], s1); s2 = fmaf(x62, l[2], s2); s3 = fmaf(x63, l[3], s3); } x41 = (lane == 41) ? 1.0f : -((s0 + s1) + (s2 + s3)); asm volatile("" : "+v"(x41) : : "memory"); }
    { float s0 = 0.f, s1 = 0.f, s2 = 0.f, s3 = 0.f; { const f32x4 l = *(const LAS f32x4*)(Lc + 2760); s1 = fmaf(x41, l[1], s1); s2 = fmaf(x42, l[2], s2); s3 = fmaf(x43, l[3], s3); } { const f32x4 l = *(const LAS f32x4*)(Lc + 2764); s0 = fmaf(x44, l[0], s0); s1 = fmaf(x45, l[1], s1); s2 = fmaf(x46, l[2], s2); s3 = fmaf(x47, l[3], s3); } { const f32x4 l = *(const LAS f32x4*)(Lc + 2768); s0 = fmaf(x48, l[0], s0); s1 = fmaf(x49, l[1], s1); s2 = fmaf(x50, l[2], s2); s3 = fmaf(x51, l[3], s3); } { const f32x4 l = *(const LAS f32x4*)(Lc + 2772); s0 = fmaf(x52, l[0], s0); s1 = fmaf(x53, l[1], s1); s2 = fmaf(x54, l[2], s2); s3 = fmaf(x55, l[3], s3); } { const f32x4 l = *(const LAS f32x4*)(Lc + 2776); s0 = fmaf(x56, l[0], s0); s1 = fmaf(x57, l[1], s1); s2 = fmaf(x58, l[2], s2); s3 = fmaf(x59, l[3], s3); } { const f32x4 l = *(const LAS f32x4*)(Lc + 2780); s0 = fmaf(x60, l[0], s0); s1 = fmaf(x61, l[1], s1); s2 = fmaf(x62, l[2], s2); s3 = fmaf(x63, l[3], s3); } x40 = (lane == 40) ? 1.0f : -((s0 + s1) + (s2 + s3)); asm volatile("" : "+v"(x40) : : "memory"); }
    { float s0 = 0.f, s1 = 0.f, s2 = 0.f, s3 = 0.f; { const f32x4 l = *(const LAS f32x4*)(Lc + 2692); s0 = fmaf(x40, l[0], s0); s1 = fmaf(x41, l[1], s1); s2 = fmaf(x42, l[2], s2); s3 = fmaf(x43, l[3], s3); } { const f32x4 l = *(const LAS f32x4*)(Lc + 2696); s0 = fmaf(x44, l[0], s0); s1 = fmaf(x45, l[1], s1); s2 = fmaf(x46, l[2], s2); s3 = fmaf(x47, l[3], s3); } { const f32x4 l = *(const LAS f32x4*)(Lc + 2700); s0 = fmaf(x48, l[0], s0); s1 = fmaf(x49, l[1], s1); s2 = fmaf(x50, l[2], s2); s3 = fmaf(x51, l[3], s3); } { const f32x4 l = *(const LAS f32x4*)(Lc + 2704); s0 = fmaf(x52, l[0], s0); s1 = fmaf(x53, l[1], s1); s2 = fmaf(x54, l[2], s2); s3 = fmaf(x55, l[3], s3); } { const f32x4 l = *(const LAS f32x4*)(Lc + 2708); s0 = fmaf(x56, l[0], s0); s1 = fmaf(x57, l[1], s1); s2 = fmaf(x58, l[2], s2); s3 = fmaf(x59, l[3], s3); } { const f32x4 l = *(const LAS f32x4*)(Lc + 2712); s0 = fmaf(x60, l[0], s0); s1 = fmaf(x61, l[1], s1); s2 = fmaf(x62, l[2], s2); s3 = fmaf(x63, l[3], s3); } x39 = (lane == 39) ? 1.0f : -((s0 + s1) + (s2 + s3)); asm volatile("" : "+v"(x39) : : "memory"); }
    { float s0 = 0.f, s1 = 0.f, s2 = 0.f, s3 = 0.f; { const f32x4 l = *(const LAS f32x4*)(Lc + 2620); s3 = fmaf(x39, l[3], s3); } { const f32x4 l = *(const LAS f32x4*)(Lc + 2624); s0 = fmaf(x40, l[0], s0); s1 = fmaf(x41, l[1], s1); s2 = fmaf(x42, l[2], s2); s3 = fmaf(x43, l[3], s3); } { const f32x4 l = *(const LAS f32x4*)(Lc + 2628); s0 = fmaf(x44, l[0], s0); s1 = fmaf(x45, l[1], s1); s2 = fmaf(x46, l[2], s2); s3 = fmaf(x47, l[3], s3); } { const f32x4 l = *(const LAS f32x4*)(Lc + 2632); s0 = fmaf(x48, l[0], s0); s1 = fmaf(x49, l[1], s1); s2 = fmaf(x50, l[2], s2); s3 = fmaf(x51, l[3], s3); } { const f32x4 l = *(const LAS f32x4*)(Lc + 2636); s0 = fmaf(x52, l[0], s0); s1 = fmaf(x53, l[1], s1); s2 = fmaf(x54, l[2], s2); s3 = fmaf(x55, l[3], s3); } { const f32x4 l = *(const LAS f32x4*)(Lc + 2640); s0 = fmaf(x56, l[0], s0); s1 = fmaf(x57, l[1], s1); s2 = fmaf(x58, l[2], s2); s3 = fmaf(x59, l[3], s3); } { const f32x4 l = *(const LAS f32x4*)(Lc + 2644); s0 = fmaf(x60, l[0], s0); s1 = fmaf(x61, l[1], s1); s2 = fmaf(x62, l[2], s2); s3 = fmaf(x63, l[3], s3); } x38 = (lane == 38) ? 1.0f : -((s0 + s1) + (s2 + s3)); asm volatile("" : "+v"(x38) : : "memory"); }
    { float s0 = 0.f, s1 = 0.f, s2 = 0.f, s3 = 0.f; { const f32x4 l = *(const LAS f32x4*)(Lc + 2552); s2 = fmaf(x38, l[2], s2); s3 = fmaf(x39, l[3], s3); } { const f32x4 l = *(const LAS f32x4*)(Lc + 2556); s0 = fmaf(x40, l[0], s0); s1 = fmaf(x41, l[1], s1); s2 = fmaf(x42, l[2], s2); s3 = fmaf(x43, l[3], s3); } { const f32x4 l = *(const LAS f32x4*)(Lc + 2560); s0 = fmaf(x44, l[0], s0); s1 = fmaf(x45, l[1], s1); s2 = fmaf(x46, l[2], s2); s3 = fmaf(x47, l[3], s3); } { const f32x4 l = *(const LAS f32x4*)(Lc + 2564); s0 = fmaf(x48, l[0], s0); s1 = fmaf(x49, l[1], s1); s2 = fmaf(x50, l[2], s2); s3 = fmaf(x51, l[3], s3); } { const f32x4 l = *(const LAS f32x4*)(Lc + 2568); s0 = fmaf(x52, l[0], s0); s1 = fmaf(x53, l[1], s1); s2 = fmaf(x54, l[2], s2); s3 = fmaf(x55, l[3], s3); } { const f32x4 l = *(const LAS f32x4*)(Lc + 2572); s0 = fmaf(x56, l[0], s0); s1 = fmaf(x57, l[1], s1); s2 = fmaf(x58, l[2], s2); s3 = fmaf(x59, l[3], s3); } { const f32x4 l = *(const LAS f32x4*)(Lc + 2576); s0 = fmaf(x60, l[0], s0); s1 = fmaf(x61, l[1], s1); s2 = fmaf(x62, l[2], s2); s3 = fmaf(x63, l[3], s3); } x37 = (lane == 37) ? 1.0f : -((s0 + s1) + (s2 + s3)); asm volatile("" : "+v"(x37) : : "memory"); }
    { float s0 = 0.f, s1 = 0.f, s2 = 0.f, s3 = 0.f; { const f32x4 l = *(const LAS f32x4*)(Lc + 2484); s1 = fmaf(x37, l[1], s1); s2 = fmaf(x38, l[2], s2); s3 = fmaf(x39, l[3], s3); } { const f32x4 l = *(const LAS f32x4*)(Lc + 2488); s0 = fmaf(x40, l[0], s0); s1 = fmaf(x41, l[1], s1); s2 = fmaf(x42, l[2], s2); s3 = fmaf(x43, l[3], s3); } { const f32x4 l = *(const LAS f32x4*)(Lc + 2492); s0 = fmaf(x44, l[0], s0); s1 = fmaf(x45, l[1], s1); s2 = fmaf(x46, l[2], s2); s3 = fmaf(x47, l[3], s3); } { const f32x4 l = *(const LAS f32x4*)(Lc + 2496); s0 = fmaf(x48, l[0], s0); s1 = fmaf(x49, l[1], s1); s2 = fmaf(x50, l[2], s2); s3 = fmaf(x51, l[3], s3); } { const f32x4 l = *(const LAS f32x4*)(Lc + 2500); s0 = fmaf(x52, l[0], s0); s1 = fmaf(x53, l[1], s1); s2 = fmaf(x54, l[2], s2); s3 = fmaf(x55, l[3], s3); } { const f32x4 l = *(const LAS f32x4*)(Lc + 2504); s0 = fmaf(x56, l[0], s0); s1 = fmaf(x57, l[1], s1); s2 = fmaf(x58, l[2], s2); s3 = fmaf(x59, l[3], s3); } { const f32x4 l = *(const LAS f32x4*)(Lc + 2508); s0 = fmaf(x60, l[0], s0); s1 = fmaf(x61, l[1], s1); s2 = fmaf(x62, l[2], s2); s3 = fmaf(x63, l[3], s3); } x36 = (lane == 36) ? 1.0f : -((s0 + s1) + (s2 + s3)); asm volatile("" : "+v"(x36) : : "memory"); }
    { float s0 = 0.f, s1 = 0.f, s2 = 0.f, s3 = 0.f; { const f32x4 l = *(const LAS f32x4*)(Lc + 2416); s0 = fmaf(x36, l[0], s0); s1 = fmaf(x37, l[1], s1); s2 = fmaf(x38, l[2], s2); s3 = fmaf(x39, l[3], s3); } { const f32x4 l = *(const LAS f32x4*)(Lc + 2420); s0 = fmaf(x40, l[0], s0); s1 = fmaf(x41, l[1], s1); s2 = fmaf(x42, l[2], s2); s3 = fmaf(x43, l[3], s3); } { const f32x4 l = *(const LAS f32x4*)(Lc + 2424); s0 = fmaf(x44, l[0], s0); s1 = fmaf(x45, l[1], s1); s2 = fmaf(x46, l[2], s2); s3 = fmaf(x47, l[3], s3); } { const f32x4 l = *(const LAS f32x4*)(Lc + 2428); s0 = fmaf(x48, l[0], s0); s1 = fmaf(x49, l[1], s1); s2 = fmaf(x50, l[2], s2); s3 = fmaf(x51, l[3], s3); } { const f32x4 l = *(const LAS f32x4*)(Lc + 2432); s0 = fmaf(x52, l[0], s0); s1 = fmaf(x53, l[1], s1); s2 = fmaf(x54, l[2], s2); s3 = fmaf(x55, l[3], s3); } { const f32x4 l = *(const LAS f32x4*)(Lc + 2436); s0 = fmaf(x56, l[0], s0); s1 = fmaf(x57, l[1], s1); s2 = fmaf(x58, l[2], s2); s3 = fmaf(x59, l[3], s3); } { const f32x4 l = *(const LAS f32x4*)(Lc + 2440); s0 = fmaf(x60, l[0], s0); s1 = fmaf(x61, l[1], s1); s2 = fmaf(x62, l[2], s2); s3 = fmaf(x63, l[3], s3); } x35 = (lane == 35) ? 1.0f : -((s0 + s1) + (s2 + s3)); asm volatile("" : "+v"(x35) : : "memory"); }
    { float s0 = 0.f, s1 = 0.f, s2 = 0.f, s3 = 0.f; { const f32x4 l = *(const LAS f32x4*)(Lc + 2344); s3 = fmaf(x35, l[3], s3); } { const f32x4 l = *(const LAS f32x4*)(Lc + 2348); s0 = fmaf(x36, l[0], s0); s1 = fmaf(x37, l[1], s1); s2 = fmaf(x38, l[2], s2); s3 = fmaf(x39, l[3], s3); } { const f32x4 l = *(const LAS f32x4*)(Lc + 2352); s0 = fmaf(x40, l[0], s0); s1 = fmaf(x41, l[1], s1); s2 = fmaf(x42, l[2], s2); s3 = fmaf(x43, l[3], s3); } { const f32x4 l = *(const LAS f32x4*)(Lc + 2356); s0 = fmaf(x44, l[0], s0); s1 = fmaf(x45, l[1], s1); s2 = fmaf(x46, l[2], s2); s3 = fmaf(x47, l[3], s3); } { const f32x4 l = *(const LAS f32x4*)(Lc + 2360); s0 = fmaf(x48, l[0], s0); s1 = fmaf(x49, l[1], s1); s2 = fmaf(x50, l[2], s2); s3 = fmaf(x51, l[3], s3); } { const f32x4 l = *(const LAS f32x4*)(Lc + 2364); s0 = fmaf(x52, l[0], s0); s1 = fmaf(x53, l[1], s1); s2 = fmaf(x54, l[2], s2); s3 = fmaf(x55, l[3], s3); } { const f32x4 l = *(const LAS f32x4*)(Lc + 2368); s0 = fmaf(x56, l[0], s0); s1 = fmaf(x57, l[1], s1); s2 = fmaf(x58, l[2], s2); s3 = fmaf(x59, l[3], s3); } { const f32x4 l = *(const LAS f32x4*)(Lc + 2372); s0 = fmaf(x60, l[0], s0); s1 = fmaf(x61, l[1], s1); s2 = fmaf(x62, l[2], s2); s3 = fmaf(x63, l[3], s3); } x34 = (lane == 34) ? 1.0f : -((s0 + s1) + (s2 + s3)); asm volatile("" : "+v"(x34) : : "memory"); }
    { float s0 = 0.f, s1 = 0.f, s2 = 0.f, s3 = 0.f; { const f32x4 l = *(const LAS f32x4*)(Lc + 2276); s2 = fmaf(x34, l[2], s2); s3 = fmaf(x35, l[3], s3); } { const f32x4 l = *(const LAS f32x4*)(Lc + 2280); s0 = fmaf(x36, l[0], s0); s1 = fmaf(x37, l[1], s1); s2 = fmaf(x38, l[2], s2); s3 = fmaf(x39, l[3], s3); } { const f32x4 l = *(const LAS f32x4*)(Lc + 2284); s0 = fmaf(x40, l[0], s0); s1 = fmaf(x41, l[1], s1); s2 = fmaf(x42, l[2], s2); s3 = fmaf(x43, l[3], s3); } { const f32x4 l = *(const LAS f32x4*)(Lc + 2288); s0 = fmaf(x44, l[0], s0); s1 = fmaf(x45, l[1], s1); s2 = fmaf(x46, l[2], s2); s3 = fmaf(x47, l[3], s3); } { const f32x4 l = *(const LAS f32x4*)(Lc + 2292); s0 = fmaf(x48, l[0], s0); s1 = fmaf(x49, l[1], s1); s2 = fmaf(x50, l[2], s2); s3 = fmaf(x51, l[3], s3); } { const f32x4 l = *(const LAS f32x4*)(Lc + 2296); s0 = fmaf(x52, l[0], s0); s1 = fmaf(x53, l[1], s1); s2 = fmaf(x54, l[2], s2); s3 = fmaf(x55, l[3], s3); } { const f32x4 l = *(const LAS f32x4*)(Lc + 2300); s0 = fmaf(x56, l[0], s0); s1 = fmaf(x57, l[1], s1); s2 = fmaf(x58, l[2], s2); s3 = fmaf(x59, l[3], s3); } { const f32x4 l = *(const LAS f32x4*)(Lc + 2304); s0 = fmaf(x60, l[0], s0); s1 = fmaf(x61, l[1], s1); s2 = fmaf(x62, l[2], s2); s3 = fmaf(x63, l[3], s3); } x33 = (lane == 33) ? 1.0f : -((s0 + s1) + (s2 + s3)); asm volatile("" : "+v"(x33) : : "memory"); }
    { float s0 = 0.f, s1 = 0.f, s2 = 0.f, s3 = 0.f; { const f32x4 l = *(const LAS f32x4*)(Lc + 2208); s1 = fmaf(x33, l[1], s1); s2 = fmaf(x34, l[2], s2); s3 = fmaf(x35, l[3], s3); } { const f32x4 l = *(const LAS f32x4*)(Lc + 2212); s0 = fmaf(x36, l[0], s0); s1 = fmaf(x37, l[1], s1); s2 = fmaf(x38, l[2], s2); s3 = fmaf(x39, l[3], s3); } { const f32x4 l = *(const LAS f32x4*)(Lc + 2216); s0 = fmaf(x40, l[0], s0); s1 = fmaf(x41, l[1], s1); s2 = fmaf(x42, l[2], s2); s3 = fmaf(x43, l[3], s3); } { const f32x4 l = *(const LAS f32x4*)(Lc + 2220); s0 = fmaf(x44, l[0], s0); s1 = fmaf(x45, l[1], s1); s2 = fmaf(x46, l[2], s2); s3 = fmaf(x47, l[3], s3); } { const f32x4 l = *(const LAS f32x4*)(Lc + 2224); s0 = fmaf(x48, l[0], s0); s1 = fmaf(x49, l[1], s1); s2 = fmaf(x50, l[2], s2); s3 = fmaf(x51, l[3], s3); } { const f32x4 l = *(const LAS f32x4*)(Lc + 2228); s0 = fmaf(x52, l[0], s0); s1 = fmaf(x53, l[1], s1); s2 = fmaf(x54, l[2], s2); s3 = fmaf(x55, l[3], s3); } { const f32x4 l = *(const LAS f32x4*)(Lc + 2232); s0 = fmaf(x56, l[0], s0); s1 = fmaf(x57, l[1], s1); s2 = fmaf(x58, l[2], s2); s3 = fmaf(x59, l[3], s3); } { const f32x4 l = *(const LAS f32x4*)(Lc + 2236); s0 = fmaf(x60, l[0], s0); s1 = fmaf(x61, l[1], s1); s2 = fmaf(x62, l[2], s2); s3 = fmaf(x63, l[3], s3); } x32 = (lane == 32) ? 1.0f : -((s0 + s1) + (s2 + s3)); asm volatile("" : "+v"(x32) : : "memory"); }
    { float s0 = 0.f, s1 = 0.f, s2 = 0.f, s3 = 0.f; { const f32x4 l = *(const LAS f32x4*)(Lc + 2140); s0 = fmaf(x32, l[0], s0); s1 = fmaf(x33, l[1], s1); s2 = fmaf(x34, l[2], s2); s3 = fmaf(x35, l[3], s3); } { const f32x4 l = *(const LAS f32x4*)(Lc + 2144); s0 = fmaf(x36, l[0], s0); s1 = fmaf(x37, l[1], s1); s2 = fmaf(x38, l[2], s2); s3 = fmaf(x39, l[3], s3); } { const f32x4 l = *(const LAS f32x4*)(Lc + 2148); s0 = fmaf(x40, l[0], s0); s1 = fmaf(x41, l[1], s1); s2 = fmaf(x42, l[2], s2); s3 = fmaf(x43, l[3], s3); } { const f32x4 l = *(const LAS f32x4*)(Lc + 2152); s0 = fmaf(x44, l[0], s0); s1 = fmaf(x45, l[1], s1); s2 = fmaf(x46, l[2], s2); s3 = fmaf(x47, l[3], s3); } { const f32x4 l = *(const LAS f32x4*)(Lc + 2156); s0 = fmaf(x48, l[0], s0); s1 = fmaf(x49, l[1], s1); s2 = fmaf(x50, l[2], s2); s3 = fmaf(x51, l[3], s3); } { const f32x4 l = *(const LAS f32x4*)(Lc + 2160); s0 = fmaf(x52, l[0], s0); s1 = fmaf(x53, l[1], s1); s2 = fmaf(x54, l[2], s2); s3 = fmaf(x55, l[3], s3); } { const f32x4 l = *(const LAS f32x4*)(Lc + 2164); s0 = fmaf(x56, l[0], s0); s1 = fmaf(x57, l[1], s1); s2 = fmaf(x58, l[2], s2); s3 = fmaf(x59, l[3], s3); } { const f32x4 l = *(const LAS f32x4*)(Lc + 2168); s0 = fmaf(x60, l[0], s0); s1 = fmaf(x61, l[1], s1); s2 = fmaf(x62, l[2], s2); s3 = fmaf(x63, l[3], s3); } x31 = (lane == 31) ? 1.0f : -((s0 + s1) + (s2 + s3)); asm volatile("" : "+v"(x31) : : "memory"); }
    { float s0 = 0.f, s1 = 0.f, s2 = 0.f, s3 = 0.f; { const f32x4 l = *(const LAS f32x4*)(Lc + 2068); s3 = fmaf(x31, l[3], s3); } { const f32x4 l = *(const LAS f32x4*)(Lc + 2072); s0 = fmaf(x32, l[0], s0); s1 = fmaf(x33, l[1], s1); s2 = fmaf(x34, l[2], s2); s3 = fmaf(x35, l[3], s3); } { const f32x4 l = *(const LAS f32x4*)(Lc + 2076); s0 = fmaf(x36, l[0], s0); s1 = fmaf(x37, l[1], s1); s2 = fmaf(x38, l[2], s2); s3 = fmaf(x39, l[3], s3); } { const f32x4 l = *(const LAS f32x4*)(Lc + 2080); s0 = fmaf(x40, l[0], s0); s1 = fmaf(x41, l[1], s1); s2 = fmaf(x42, l[2], s2); s3 = fmaf(x43, l[3], s3); } { const f32x4 l = *(const LAS f32x4*)(Lc + 2084); s0 = fmaf(x44, l[0], s0); s1 = fmaf(x45, l[1], s1); s2 = fmaf(x46, l[2], s2); s3 = fmaf(x47, l[3], s3); } { const f32x4 l = *(const LAS f32x4*)(Lc + 2088); s0 = fmaf(x48, l[0], s0); s1 = fmaf(x49, l[1], s1); s2 = fmaf(x50, l[2], s2); s3 = fmaf(x51, l[3], s3); } { const f32x4 l = *(const LAS f32x4*)(Lc + 2092); s0 = fmaf(x52, l[0], s0); s1 = fmaf(x53, l[1], s1); s2 = fmaf(x54, l[2], s2); s3 = fmaf(x55, l[3], s3); } { const f32x4 l = *(const LAS f32x4*)(Lc + 2096); s0 = fmaf(x56, l[0], s0); s1 = fmaf(x57, l[1], s1); s2 = fmaf(x58, l[2], s2); s3 = fmaf(x59, l[3], s3); } { const f32x4 l = *(const LAS f32x4*)(Lc + 2100); s0 = fmaf(x60, l[0], s0); s1 = fmaf(x61, l[1], s1); s2 = fmaf(x62, l[2], s2); s3 = fmaf(x63, l[3], s3); } x30 = (lane == 30) ? 1.0f : -((s0 + s1) + (s2 + s3)); asm volatile("" : "+v"(x30) : : "memory"); }
    { float s0 = 0.f, s1 = 0.f, s2 = 0.f, s3 = 0.f; { const f32x4 l = *(const LAS f32x4*)(Lc + 2000); s2 = fmaf(x30, l[2], s2); s3 = fmaf(x31, l[3], s3); } { const f32x4 l = *(const LAS f32x4*)(Lc + 2004); s0 = fmaf(x32, l[0], s0); s1 = fmaf(x33, l[1], s1); s2 = fmaf(x34, l[2], s2); s3 = fmaf(x35, l[3], s3); } { const f32x4 l = *(const LAS f32x4*)(Lc + 2008); s0 = fmaf(x36, l[0], s0); s1 = fmaf(x37, l[1], s1); s2 = fmaf(x38, l[2], s2); s3 = fmaf(x39, l[3], s3); } { const f32x4 l = *(const LAS f32x4*)(Lc + 2012); s0 = fmaf(x40, l[0], s0); s1 = fmaf(x41, l[1], s1); s2 = fmaf(x42, l[2], s2); s3 = fmaf(x43, l[3], s3); } { const f32x4 l = *(const LAS f32x4*)(Lc + 2016); s0 = fmaf(x44, l[0], s0); s1 = fmaf(x45, l[1], s1); s2 = fmaf(x46, l[2], s2); s3 = fmaf(x47, l[3], s3); } { const f32x4 l = *(const LAS f32x4*)(Lc + 2020); s0 = fmaf(x48, l[0], s0); s1 = fmaf(x49, l[1], s1); s2 = fmaf(x50, l[2], s2); s3 = fmaf(x51, l[3], s3); } { const f32x4 l = *(const LAS f32x4*)(Lc + 2024); s0 = fmaf(x52, l[0], s0); s1 = fmaf(x53, l[1], s1); s2 = fmaf(x54, l[2], s2); s3 = fmaf(x55, l[3], s3); } { const f32x4 l = *(const LAS f32x4*)(Lc + 2028); s0 = fmaf(x56, l[0], s0); s1 = fmaf(x57, l[1], s1); s2 = fmaf(x58, l[2], s2); s3 = fmaf(x59, l[3], s3); } { const f32x4 l = *(const LAS f32x4*)(Lc + 2032); s0 = fmaf(x60, l[0], s0); s1 = fmaf(x61, l[1], s1); s2 = fmaf(x62, l[2], s2); s3 = fmaf(x63, l[3], s3); } x29 = (lane == 29) ? 1.0f : -((s0 + s1) + (s2 + s3)); asm volatile("" : "+v"(x29) : : "memory"); }
    { float s0 = 0.f, s1 = 0.f, s2 = 0.f, s3 = 0.f; { const f32x4 l = *(const LAS f32x4*)(Lc + 1932); s1 = fmaf(x29, l[1], s1); s2 = fmaf(x30, l[2], s2); s3 = fmaf(x31, l[3], s3); } { const f32x4 l = *(const LAS f32x4*)(Lc + 1936); s0 = fmaf(x32, l[0], s0); s1 = fmaf(x33, l[1], s1); s2 = fmaf(x34, l[2], s2); s3 = fmaf(x35, l[3], s3); } { const f32x4 l = *(const LAS f32x4*)(Lc + 1940); s0 = fmaf(x36, l[0], s0); s1 = fmaf(x37, l[1], s1); s2 = fmaf(x38, l[2], s2); s3 = fmaf(x39, l[3], s3); } { const f32x4 l = *(const LAS f32x4*)(Lc + 1944); s0 = fmaf(x40, l[0], s0); s1 = fmaf(x41, l[1], s1); s2 = fmaf(x42, l[2], s2); s3 = fmaf(x43, l[3], s3); } { const f32x4 l = *(const LAS f32x4*)(Lc + 1948); s0 = fmaf(x44, l[0], s0); s1 = fmaf(x45, l[1], s1); s2 = fmaf(x46, l[2], s2); s3 = fmaf(x47, l[3], s3); } { const f32x4 l = *(const LAS f32x4*)(Lc + 1952); s0 = fmaf(x48, l[0], s0); s1 = fmaf(x49, l[1], s1); s2 = fmaf(x50, l[2], s2); s3 = fmaf(x51, l[3], s3); } { const f32x4 l = *(const LAS f32x4*)(Lc + 1956); s0 = fmaf(x52, l[0], s0); s1 = fmaf(x53, l[1], s1); s2 = fmaf(x54, l[2], s2); s3 = fmaf(x55, l[3], s3); } { const f32x4 l = *(const LAS f32x4*)(Lc + 1960); s0 = fmaf(x56, l[0], s0); s1 = fmaf(x57, l[1], s1); s2 = fmaf(x58, l[2], s2); s3 = fmaf(x59, l[3], s3); } { const f32x4 l = *(const LAS f32x4*)(Lc + 1964); s0 = fmaf(x60, l[0], s0); s1 = fmaf(x61, l[1], s1); s2 = fmaf(x62, l[2], s2); s3 = fmaf(x63, l[3], s3); } x28 = (lane == 28) ? 1.0f : -((s0 + s1) + (s2 + s3)); asm volatile("" : "+v"(x28) : : "memory"); }
    { float s0 = 0.f, s1 = 0.f, s2 = 0.f, s3 = 0.f; { const f32x4 l = *(const LAS f32x4*)(Lc + 1864); s0 = fmaf(x28, l[0], s0); s1 = fmaf(x29, l[1], s1); s2 = fmaf(x30, l[2], s2); s3 = fmaf(x31, l[3], s3); } { const f32x4 l = *(const LAS f32x4*)(Lc + 1868); s0 = fmaf(x32, l[0], s0); s1 = fmaf(x33, l[1], s1); s2 = fmaf(x34, l[2], s2); s3 = fmaf(x35, l[3], s3); } { const f32x4 l = *(const LAS f32x4*)(Lc + 1872); s0 = fmaf(x36, l[0], s0); s1 = fmaf(x37, l[1], s1); s2 = fmaf(x38, l[2], s2); s3 = fmaf(x39, l[3], s3); } { const f32x4 l = *(const LAS f32x4*)(Lc + 1876); s0 = fmaf(x40, l[0], s0); s1 = fmaf(x41, l[1], s1); s2 = fmaf(x42, l[2], s2); s3 = fmaf(x43, l[3], s3); } { const f32x4 l = *(const LAS f32x4*)(Lc + 1880); s0 = fmaf(x44, l[0], s0); s1 = fmaf(x45, l[1], s1); s2 = fmaf(x46, l[2], s2); s3 = fmaf(x47, l[3], s3); } { const f32x4 l = *(const LAS f32x4*)(Lc + 1884); s0 = fmaf(x48, l[0], s0); s1 = fmaf(x49, l[1], s1); s2 = fmaf(x50, l[2], s2); s3 = fmaf(x51, l[3], s3); } { const f32x4 l = *(const LAS f32x4*)(Lc + 1888); s0 = fmaf(x52, l[0], s0); s1 = fmaf(x53, l[1], s1); s2 = fmaf(x54, l[2], s2); s3 = fmaf(x55, l[3], s3); } { const f32x4 l = *(const LAS f32x4*)(Lc + 1892); s0 = fmaf(x56, l[0], s0); s1 = fmaf(x57, l[1], s1); s2 = fmaf(x58, l[2], s2); s3 = fmaf(x59, l[3], s3); } { const f32x4 l = *(const LAS f32x4*)(Lc + 1896); s0 = fmaf(x60, l[0], s0); s1 = fmaf(x61, l[1], s1); s2 = fmaf(x62, l[2], s2); s3 = fmaf(x63, l[3], s3); } x27 = (lane == 27) ? 1.0f : -((s0 + s1) + (s2 + s3)); asm volatile("" : "+v"(x27) : : "memory"); }
    { float s0 = 0.f, s1 = 0.f, s2 = 0.f, s3 = 0.f; { const f32x4 l = *(const LAS f32x4*)(Lc + 1792); s3 = fmaf(x27, l[3], s3); } { const f32x4 l = *(const LAS f32x4*)(Lc + 1796); s0 = fmaf(x28, l[0], s0); s1 = fmaf(x29, l[1], s1); s2 = fmaf(x30, l[2], s2); s3 = fmaf(x31, l[3], s3); } { const f32x4 l = *(const LAS f32x4*)(Lc + 1800); s0 = fmaf(x32, l[0], s0); s1 = fmaf(x33, l[1], s1); s2 = fmaf(x34, l[2], s2); s3 = fmaf(x35, l[3], s3); } { const f32x4 l = *(const LAS f32x4*)(Lc + 1804); s0 = fmaf(x36, l[0], s0); s1 = fmaf(x37, l[1], s1); s2 = fmaf(x38, l[2], s2); s3 = fmaf(x39, l[3], s3); } { const f32x4 l = *(const LAS f32x4*)(Lc + 1808); s0 = fmaf(x40, l[0], s0); s1 = fmaf(x41, l[1], s1); s2 = fmaf(x42, l[2], s2); s3 = fmaf(x43, l[3], s3); } { const f32x4 l = *(const LAS f32x4*)(Lc + 1812); s0 = fmaf(x44, l[0], s0); s1 = fmaf(x45, l[1], s1); s2 = fmaf(x46, l[2], s2); s3 = fmaf(x47, l[3], s3); } { const f32x4 l = *(const LAS f32x4*)(Lc + 1816); s0 = fmaf(x48, l[0], s0); s1 = fmaf(x49, l[1], s1); s2 = fmaf(x50, l[2], s2); s3 = fmaf(x51, l[3], s3); } { const f32x4 l = *(const LAS f32x4*)(Lc + 1820); s0 = fmaf(x52, l[0], s0); s1 = fmaf(x53, l[1], s1); s2 = fmaf(x54, l[2], s2); s3 = fmaf(x55, l[3], s3); } { const f32x4 l = *(const LAS f32x4*)(Lc + 1824); s0 = fmaf(x56, l[0], s0); s1 = fmaf(x57, l[1], s1); s2 = fmaf(x58, l[2], s2); s3 = fmaf(x59, l[3], s3); } { const f32x4 l = *(const LAS f32x4*)(Lc + 1828); s0 = fmaf(x60, l[0], s0); s1 = fmaf(x61, l[1], s1); s2 = fmaf(x62, l[2], s2); s3 = fmaf(x63, l[3], s3); } x26 = (lane == 26) ? 1.0f : -((s0 + s1) + (s2 + s3)); asm volatile("" : "+v"(x26) : : "memory"); }
    { float s0 = 0.f, s1 = 0.f, s2 = 0.f, s3 = 0.f; { const f32x4 l = *(const LAS f32x4*)(Lc + 1724); s2 = fmaf(x26, l[2], s2); s3 = fmaf(x27, l[3], s3); } { const f32x4 l = *(const LAS f32x4*)(Lc + 1728); s0 = fmaf(x28, l[0], s0); s1 = fmaf(x29, l[1], s1); s2 = fmaf(x30, l[2], s2); s3 = fmaf(x31, l[3], s3); } { const f32x4 l = *(const LAS f32x4*)(Lc + 1732); s0 = fmaf(x32, l[0], s0); s1 = fmaf(x33, l[1], s1); s2 = fmaf(x34, l[2], s2); s3 = fmaf(x35, l[3], s3); } { const f32x4 l = *(const LAS f32x4*)(Lc + 1736); s0 = fmaf(x36, l[0], s0); s1 = fmaf(x37, l[1], s1); s2 = fmaf(x38, l[2], s2); s3 = fmaf(x39, l[3], s3); } { const f32x4 l = *(const LAS f32x4*)(Lc + 1740); s0 = fmaf(x40, l[0], s0); s1 = fmaf(x41, l[1], s1); s2 = fmaf(x42, l[2], s2); s3 = fmaf(x43, l[3], s3); } { const f32x4 l = *(const LAS f32x4*)(Lc + 1744); s0 = fmaf(x44, l[0], s0); s1 = fmaf(x45, l[1], s1); s2 = fmaf(x46, l[2], s2); s3 = fmaf(x47, l[3], s3); } { const f32x4 l = *(const LAS f32x4*)(Lc + 1748); s0 = fmaf(x48, l[0], s0); s1 = fmaf(x49, l[1], s1); s2 = fmaf(x50, l[2], s2); s3 = fmaf(x51, l[3], s3); } { const f32x4 l = *(const LAS f32x4*)(Lc + 1752); s0 = fmaf(x52, l[0], s0); s1 = fmaf(x53, l[1], s1); s2 = fmaf(x54, l[2], s2); s3 = fmaf(x55, l[3], s3); } { const f32x4 l = *(const LAS f32x4*)(Lc + 1756); s0 = fmaf(x56, l[0], s0); s1 = fmaf(x57, l[1], s1); s2 = fmaf(x58, l[2], s2); s3 = fmaf(x59, l[3], s3); } { const f32x4 l = *(const LAS f32x4*)(Lc + 1760); s0 = fmaf(x60, l[0], s0); s1 = fmaf(x61, l[1], s1); s2 = fmaf(x62, l[2], s2); s3 = fmaf(x63, l[3], s3); } x25 = (lane == 25) ? 1.0f : -((s0 + s1) + (s2 + s3)); asm volatile("" : "+v"(x25) : : "memory"); }
    { float s0 = 0.f, s1 = 0.f, s2 = 0.f, s3 = 0.f; { const f32x4 l = *(const LAS f32x4*)(Lc + 1656); s1 = fmaf(x25, l[1], s1); s2 = fmaf(x26, l[2], s2); s3 = fmaf(x27, l[3], s3); } { const f32x4 l = *(const LAS f32x4*)(Lc + 1660); s0 = fmaf(x28, l[0], s0); s1 = fmaf(x29, l[1], s1); s2 = fmaf(x30, l[2], s2); s3 = fmaf(x31, l[3], s3); } { const f32x4 l = *(const LAS f32x4*)(Lc + 1664); s0 = fmaf(x32, l[0], s0); s1 = fmaf(x33, l[1], s1); s2 = fmaf(x34, l[2], s2); s3 = fmaf(x35, l[3], s3); } { const f32x4 l = *(const LAS f32x4*)(Lc + 1668); s0 = fmaf(x36, l[0], s0); s1 = fmaf(x37, l[1], s1); s2 = fmaf(x38, l[2], s2); s3 = fmaf(x39, l[3], s3); } { const f32x4 l = *(const LAS f32x4*)(Lc + 1672); s0 = fmaf(x40, l[0], s0); s1 = fmaf(x41, l[1], s1); s2 = fmaf(x42, l[2], s2); s3 = fmaf(x43, l[3], s3); } { const f32x4 l = *(const LAS f32x4*)(Lc + 1676); s0 = fmaf(x44, l[0], s0); s1 = fmaf(x45, l[1], s1); s2 = fmaf(x46, l[2], s2); s3 = fmaf(x47, l[3], s3); } { const f32x4 l = *(const LAS f32x4*)(Lc + 1680); s0 = fmaf(x48, l[0], s0); s1 = fmaf(x49, l[1], s1); s2 = fmaf(x50, l[2], s2); s3 = fmaf(x51, l[3], s3); } { const f32x4 l = *(const LAS f32x4*)(Lc + 1684); s0 = fmaf(x52, l[0], s0); s1 = fmaf(x53, l[1], s1); s2 = fmaf(x54, l[2], s2); s3 = fmaf(x55, l[3], s3); } { const f32x4 l = *(const LAS f32x4*)(Lc + 1688); s0 = fmaf(x56, l[0], s0); s1 = fmaf(x57, l[1], s1); s2 = fmaf(x58, l[2], s2); s3 = fmaf(x59, l[3], s3); } { const f32x4 l = *(const LAS f32x4*)(Lc + 1692); s0 = fmaf(x60, l[0], s0); s1 = fmaf(x61, l[1], s1); s2 = fmaf(x62, l[2], s2); s3 = fmaf(x63, l[3], s3); } x24 = (lane == 24) ? 1.0f : -((s0 + s1) + (s2 + s3)); asm volatile("" : "+v"(x24) : : "memory"); }
    { float s0 = 0.f, s1 = 0.f, s2 = 0.f, s3 = 0.f; { const f32x4 l = *(const LAS f32x4*)(Lc + 1588); s0 = fmaf(x24, l[0], s0); s1 = fmaf(x25, l[1], s1); s2 = fmaf(x26, l[2], s2); s3 = fmaf(x27, l[3], s3); } { const f32x4 l = *(const LAS f32x4*)(Lc + 1592); s0 = fmaf(x28, l[0], s0); s1 = fmaf(x29, l[1], s1); s2 = fmaf(x30, l[2], s2); s3 = fmaf(x31, l[3], s3); } { const f32x4 l = *(const LAS f32x4*)(Lc + 1596); s0 = fmaf(x32, l[0], s0); s1 = fmaf(x33, l[1], s1); s2 = fmaf(x34, l[2], s2); s3 = fmaf(x35, l[3], s3); } { const f32x4 l = *(const LAS f32x4*)(Lc + 1600); s0 = fmaf(x36, l[0], s0); s1 = fmaf(x37, l[1], s1); s2 = fmaf(x38, l[2], s2); s3 = fmaf(x39, l[3], s3); } { const f32x4 l = *(const LAS f32x4*)(Lc + 1604); s0 = fmaf(x40, l[0], s0); s1 = fmaf(x41, l[1], s1); s2 = fmaf(x42, l[2], s2); s3 = fmaf(x43, l[3], s3); } { const f32x4 l = *(const LAS f32x4*)(Lc + 1608); s0 = fmaf(x44, l[0], s0); s1 = fmaf(x45, l[1], s1); s2 = fmaf(x46, l[2], s2); s3 = fmaf(x47, l[3], s3); } { const f32x4 l = *(const LAS f32x4*)(Lc + 1612); s0 = fmaf(x48, l[0], s0); s1 = fmaf(x49, l[1], s1); s2 = fmaf(x50, l[2], s2); s3 = fmaf(x51, l[3], s3); } { const f32x4 l = *(const LAS f32x4*)(Lc + 1616); s0 = fmaf(x52, l[0], s0); s1 = fmaf(x53, l[1], s1); s2 = fmaf(x54, l[2], s2); s3 = fmaf(x55, l[3], s3); } { const f32x4 l = *(const LAS f32x4*)(Lc + 1620); s0 = fmaf(x56, l[0], s0); s1 = fmaf(x57, l[1], s1); s2 = fmaf(x58, l[2], s2); s3 = fmaf(x59, l[3], s3); } { const f32x4 l = *(const LAS f32x4*)(Lc + 1624); s0 = fmaf(x60, l[0], s0); s1 = fmaf(x61, l[1], s1); s2 = fmaf(x62, l[2], s2); s3 = fmaf(x63, l[3], s3); } x23 = (lane == 23) ? 1.0f : -((s0 + s1) + (s2 + s3)); asm volatile("" : "+v"(x23) : : "memory"); }
    { float s0 = 0.f, s1 = 0.f, s2 = 0.f, s3 = 0.f; { const f32x4 l = *(const LAS f32x4*)(Lc + 1516); s3 = fmaf(x23, l[3], s3); } { const f32x4 l = *(const LAS f32x4*)(Lc + 1520); s0 = fmaf(x24, l[0], s0); s1 = fmaf(x25, l[1], s1); s2 = fmaf(x26, l[2], s2); s3 = fmaf(x27, l[3], s3); } { const f32x4 l = *(const LAS f32x4*)(Lc + 1524); s0 = fmaf(x28, l[0], s0); s1 = fmaf(x29, l[1], s1); s2 = fmaf(x30, l[2], s2); s3 = fmaf(x31, l[3], s3); } { const f32x4 l = *(const LAS f32x4*)(Lc + 1528); s0 = fmaf(x32, l[0], s0); s1 = fmaf(x33, l[1], s1); s2 = fmaf(x34, l[2], s2); s3 = fmaf(x35, l[3], s3); } { const f32x4 l = *(const LAS f32x4*)(Lc + 1532); s0 = fmaf(x36, l[0], s0); s1 = fmaf(x37, l[1], s1); s2 = fmaf(x38, l[2], s2); s3 = fmaf(x39, l[3], s3); } { const f32x4 l = *(const LAS f32x4*)(Lc + 1536); s0 = fmaf(x40, l[0], s0); s1 = fmaf(x41, l[1], s1); s2 = fmaf(x42, l[2], s2); s3 = fmaf(x43, l[3], s3); } { const f32x4 l = *(const LAS f32x4*)(Lc + 1540); s0 = fmaf(x44, l[0], s0); s1 = fmaf(x45, l[1], s1); s2 = fmaf(x46, l[2], s2); s3 = fmaf(x47, l[3], s3); } { const f32x4 l = *(const LAS f32x4*)(Lc + 1544); s0 = fmaf(x48, l[0], s0); s1 = fmaf(x49, l[1], s1); s2 = fmaf(x50, l[2], s2); s3 = fmaf(x51, l[3], s3); } { const f32x4 l = *(const LAS f32x4*)(Lc + 1548); s0 = fmaf(x52, l[0], s0); s1 = fmaf(x53, l[1], s1); s2 = fmaf(x54, l[2], s2); s3 = fmaf(x55, l[3], s3); } { const f32x4 l = *(const LAS f32x4*)(Lc + 1552); s0 = fmaf(x56, l[0], s0); s1 = fmaf(x57, l[1], s1); s2 = fmaf(x58, l[2], s2); s3 = fmaf(x59, l[3], s3); } { const f32x4 l = *(const LAS f32x4*)(Lc + 1556); s0 = fmaf(x60, l[0], s0); s1 = fmaf(x61, l[1], s1); s2 = fmaf(x62, l[2], s2); s3 = fmaf(x63, l[3], s3); } x22 = (lane == 22) ? 1.0f : -((s0 + s1) + (s2 + s3)); asm volatile("" : "+v"(x22) : : "memory"); }
    { float s0 = 0.f, s1 = 0.f, s2 = 0.f, s3 = 0.f; { const f32x4 l = *(const LAS f32x4*)(Lc + 1448); s2 = fmaf(x22, l[2], s2); s3 = fmaf(x23, l[3], s3); } { const f32x4 l = *(const LAS f32x4*)(Lc + 1452); s0 = fmaf(x24, l[0], s0); s1 = fmaf(x25, l[1], s1); s2 = fmaf(x26, l[2], s2); s3 = fmaf(x27, l[3], s3); } { const f32x4 l = *(const LAS f32x4*)(Lc + 1456); s0 = fmaf(x28, l[0], s0); s1 = fmaf(x29, l[1], s1); s2 = fmaf(x30, l[2], s2); s3 = fmaf(x31, l[3], s3); } { const f32x4 l = *(const LAS f32x4*)(Lc + 1460); s0 = fmaf(x32, l[0], s0); s1 = fmaf(x33, l[1], s1); s2 = fmaf(x34, l[2], s2); s3 = fmaf(x35, l[3], s3); } { const f32x4 l = *(const LAS f32x4*)(Lc + 1464); s0 = fmaf(x36, l[0], s0); s1 = fmaf(x37, l[1], s1); s2 = fmaf(x38, l[2], s2); s3 = fmaf(x39, l[3], s3); } { const f32x4 l = *(const LAS f32x4*)(Lc + 1468); s0 = fmaf(x40, l[0], s0); s1 = fmaf(x41, l[1], s1); s2 = fmaf(x42, l[2], s2); s3 = fmaf(x43, l[3], s3); } { const f32x4 l = *(const LAS f32x4*)(Lc + 1472); s0 = fmaf(x44, l[0], s0); s1 = fmaf(x45, l[1], s1); s2 = fmaf(x46, l[2], s2); s3 = fmaf(x47, l[3], s3); } { const f32x4 l = *(const LAS f32x4*)(Lc + 1476); s0 = fmaf(x48, l[0], s0); s1 = fmaf(x49, l[1], s1); s2 = fmaf(x50, l[2], s2); s3 = fmaf(x51, l[3], s3); } { const f32x4 l = *(const LAS f32x4*)(Lc + 1480); s0 = fmaf(x52, l[0], s0); s1 = fmaf(x53, l[1], s1); s2 = fmaf(x54, l[2], s2); s3 = fmaf(x55, l[3], s3); } { const f32x4 l = *(const LAS f32x4*)(Lc + 1484); s0 = fmaf(x56, l[0], s0); s1 = fmaf(x57, l[1], s1); s2 = fmaf(x58, l[2], s2); s3 = fmaf(x59, l[3], s3); } { const f32x4 l = *(const LAS f32x4*)(Lc + 1488); s0 = fmaf(x60, l[0], s0); s1 = fmaf(x61, l[1], s1); s2 = fmaf(x62, l[2], s2); s3 = fmaf(x63, l[3], s3); } x21 = (lane == 21) ? 1.0f : -((s0 + s1) + (s2 + s3)); asm volatile("" : "+v"(x21) : : "memory"); }
    { float s0 = 0.f, s1 = 0.f, s2 = 0.f, s3 = 0.f; { const f32x4 l = *(const LAS f32x4*)(Lc + 1380); s1 = fmaf(x21, l[1], s1); s2 = fmaf(x22, l[2], s2); s3 = fmaf(x23, l[3], s3); } { const f32x4 l = *(const LAS f32x4*)(Lc + 1384); s0 = fmaf(x24, l[0], s0); s1 = fmaf(x25, l[1], s1); s2 = fmaf(x26, l[2], s2); s3 = fmaf(x27, l[3], s3); } { const f32x4 l = *(const LAS f32x4*)(Lc + 1388); s0 = fmaf(x28, l[0], s0); s1 = fmaf(x29, l[1], s1); s2 = fmaf(x30, l[2], s2); s3 = fmaf(x31, l[3], s3); } { const f32x4 l = *(const LAS f32x4*)(Lc + 1392); s0 = fmaf(x32, l[0], s0); s1 = fmaf(x33, l[1], s1); s2 = fmaf(x34, l[2], s2); s3 = fmaf(x35, l[3], s3); } { const f32x4 l = *(const LAS f32x4*)(Lc + 1396); s0 = fmaf(x36, l[0], s0); s1 = fmaf(x37, l[1], s1); s2 = fmaf(x38, l[2], s2); s3 = fmaf(x39, l[3], s3); } { const f32x4 l = *(const LAS f32x4*)(Lc + 1400); s0 = fmaf(x40, l[0], s0); s1 = fmaf(x41, l[1], s1); s2 = fmaf(x42, l[2], s2); s3 = fmaf(x43, l[3], s3); } { const f32x4 l = *(const LAS f32x4*)(Lc + 1404); s0 = fmaf(x44, l[0], s0); s1 = fmaf(x45, l[1], s1); s2 = fmaf(x46, l[2], s2); s3 = fmaf(x47, l[3], s3); } { const f32x4 l = *(const LAS f32x4*)(Lc + 1408); s0 = fmaf(x48, l[0], s0); s1 = fmaf(x49, l[1], s1); s2 = fmaf(x50, l[2], s2); s3 = fmaf(x51, l[3], s3); } { const f32x4 l = *(const LAS f32x4*)(Lc + 1412); s0 = fmaf(x52, l[0], s0); s1 = fmaf(x53, l[1], s1); s2 = fmaf(x54, l[2], s2); s3 = fmaf(x55, l[3], s3); } { const f32x4 l = *(const LAS f32x4*)(Lc + 1416); s0 = fmaf(x56, l[0], s0); s1 = fmaf(x57, l[1], s1); s2 = fmaf(x58, l[2], s2); s3 = fmaf(x59, l[3], s3); } { const f32x4 l = *(const LAS f32x4*)(Lc + 1420); s0 = fmaf(x60, l[0], s0); s1 = fmaf(x61, l[1], s1); s2 = fmaf(x62, l[2], s2); s3 = fmaf(x63, l[3], s3); } x20 = (lane == 20) ? 1.0f : -((s0 + s1) + (s2 + s3)); asm volatile("" : "+v"(x20) : : "memory"); }
    { float s0 = 0.f, s1 = 0.f, s2 = 0.f, s3 = 0.f; { const f32x4 l = *(const LAS f32x4*)(Lc + 1312); s0 = fmaf(x20, l[0], s0); s1 = fmaf(x21, l[1], s1); s2 = fmaf(x22, l[2], s2); s3 = fmaf(x23, l[3], s3); } { const f32x4 l = *(const LAS f32x4*)(Lc + 1316); s0 = fmaf(x24, l[0], s0); s1 = fmaf(x25, l[1], s1); s2 = fmaf(x26, l[2], s2); s3 = fmaf(x27, l[3], s3); } { const f32x4 l = *(const LAS f32x4*)(Lc + 1320); s0 = fmaf(x28, l[0], s0); s1 = fmaf(x29, l[1], s1); s2 = fmaf(x30, l[2], s2); s3 = fmaf(x31, l[3], s3); } { const f32x4 l = *(const LAS f32x4*)(Lc + 1324); s0 = fmaf(x32, l[0], s0); s1 = fmaf(x33, l[1], s1); s2 = fmaf(x34, l[2], s2); s3 = fmaf(x35, l[3], s3); } { const f32x4 l = *(const LAS f32x4*)(Lc + 1328); s0 = fmaf(x36, l[0], s0); s1 = fmaf(x37, l[1], s1); s2 = fmaf(x38, l[2], s2); s3 = fmaf(x39, l[3], s3); } { const f32x4 l = *(const LAS f32x4*)(Lc + 1332); s0 = fmaf(x40, l[0], s0); s1 = fmaf(x41, l[1], s1); s2 = fmaf(x42, l[2], s2); s3 = fmaf(x43, l[3], s3); } { const f32x4 l = *(const LAS f32x4*)(Lc + 1336); s0 = fmaf(x44, l[0], s0); s1 = fmaf(x45, l[1], s1); s2 = fmaf(x46, l[2], s2); s3 = fmaf(x47, l[3], s3); } { const f32x4 l = *(const LAS f32x4*)(Lc + 1340); s0 = fmaf(x48, l[0], s0); s1 = fmaf(x49, l[1], s1); s2 = fmaf(x50, l[2], s2); s3 = fmaf(x51, l[3], s3); } { const f32x4 l = *(const LAS f32x4*)(Lc + 1344); s0 = fmaf(x52, l[0], s0); s1 = fmaf(x53, l[1], s1); s2 = fmaf(x54, l[2], s2); s3 = fmaf(x55, l[3], s3); } { const f32x4 l = *(const LAS f32x4*)(Lc + 1348); s0 = fmaf(x56, l[0], s0); s1 = fmaf(x57, l[1], s1); s2 = fmaf(x58, l[2], s2); s3 = fmaf(x59, l[3], s3); } { const f32x4 l = *(const LAS f32x4*)(Lc + 1352); s0 = fmaf(x60, l[0], s0); s1 = fmaf(x61, l[1], s1); s2 = fmaf(x62, l[2], s2); s3 = fmaf(x63, l[3], s3); } x19 = (lane == 19) ? 1.0f : -((s0 + s1) + (s2 + s3)); asm volatile("" : "+v"(x19) : : "memory"); }
    { float s0 = 0.f, s1 = 0.f, s2 = 0.f, s3 = 0.f; { const f32x4 l = *(const LAS f32x4*)(Lc + 1240); s3 = fmaf(x19, l[3], s3); } { const f32x4 l = *(const LAS f32x4*)(Lc + 1244); s0 = fmaf(x20, l[0], s0); s1 = fmaf(x21, l[1], s1); s2 = fmaf(x22, l[2], s2); s3 = fmaf(x23, l[3], s3); } { const f32x4 l = *(const LAS f32x4*)(Lc + 1248); s0 = fmaf(x24, l[0], s0); s1 = fmaf(x25, l[1], s1); s2 = fmaf(x26, l[2], s2); s3 = fmaf(x27, l[3], s3); } { const f32x4 l = *(const LAS f32x4*)(Lc + 1252); s0 = fmaf(x28, l[0], s0); s1 = fmaf(x29, l[1], s1); s2 = fmaf(x30, l[2], s2); s3 = fmaf(x31, l[3], s3); } { const f32x4 l = *(const LAS f32x4*)(Lc + 1256); s0 = fmaf(x32, l[0], s0); s1 = fmaf(x33, l[1], s1); s2 = fmaf(x34, l[2], s2); s3 = fmaf(x35, l[3], s3); } { const f32x4 l = *(const LAS f32x4*)(Lc + 1260); s0 = fmaf(x36, l[0], s0); s1 = fmaf(x37, l[1], s1); s2 = fmaf(x38, l[2], s2); s3 = fmaf(x39, l[3], s3); } { const f32x4 l = *(const LAS f32x4*)(Lc + 1264); s0 = fmaf(x40, l[0], s0); s1 = fmaf(x41, l[1], s1); s2 = fmaf(x42, l[2], s2); s3 = fmaf(x43, l[3], s3); } { const f32x4 l = *(const LAS f32x4*)(Lc + 1268); s0 = fmaf(x44, l[0], s0); s1 = fmaf(x45, l[1], s1); s2 = fmaf(x46, l[2], s2); s3 = fmaf(x47, l[3], s3); } { const f32x4 l = *(const LAS f32x4*)(Lc + 1272); s0 = fmaf(x48, l[0], s0); s1 = fmaf(x49, l[1], s1); s2 = fmaf(x50, l[2], s2); s3 = fmaf(x51, l[3], s3); } { const f32x4 l = *(const LAS f32x4*)(Lc + 1276); s0 = fmaf(x52, l[0], s0); s1 = fmaf(x53, l[1], s1); s2 = fmaf(x54, l[2], s2); s3 = fmaf(x55, l[3], s3); } { const f32x4 l = *(const LAS f32x4*)(Lc + 1280); s0 = fmaf(x56, l[0], s0); s1 = fmaf(x57, l[1], s1); s2 = fmaf(x58, l[2], s2); s3 = fmaf(x59, l[3], s3); } { const f32x4 l = *(const LAS f32x4*)(Lc + 1284); s0 = fmaf(x60, l[0], s0); s1 = fmaf(x61, l[1], s1); s2 = fmaf(x62, l[2], s2); s3 = fmaf(x63, l[3], s3); } x18 = (lane == 18) ? 1.0f : -((s0 + s1) + (s2 + s3)); asm volatile("" : "+v"(x18) : : "memory"); }
    { float s0 = 0.f, s1 = 0.f, s2 = 0.f, s3 = 0.f; { const f32x4 l = *(const LAS f32x4*)(Lc + 1172); s2 = fmaf(x18, l[2], s2); s3 = fmaf(x19, l[3], s3); } { const f32x4 l = *(const LAS f32x4*)(Lc + 1176); s0 = fmaf(x20, l[0], s0); s1 = fmaf(x21, l[1], s1); s2 = fmaf(x22, l[2], s2); s3 = fmaf(x23, l[3], s3); } { const f32x4 l = *(const LAS f32x4*)(Lc + 1180); s0 = fmaf(x24, l[0], s0); s1 = fmaf(x25, l[1], s1); s2 = fmaf(x26, l[2], s2); s3 = fmaf(x27, l[3], s3); } { const f32x4 l = *(const LAS f32x4*)(Lc + 1184); s0 = fmaf(x28, l[0], s0); s1 = fmaf(x29, l[1], s1); s2 = fmaf(x30, l[2], s2); s3 = fmaf(x31, l[3], s3); } { const f32x4 l = *(const LAS f32x4*)(Lc + 1188); s0 = fmaf(x32, l[0], s0); s1 = fmaf(x33, l[1], s1); s2 = fmaf(x34, l[2], s2); s3 = fmaf(x35, l[3], s3); } { const f32x4 l = *(const LAS f32x4*)(Lc + 1192); s0 = fmaf(x36, l[0], s0); s1 = fmaf(x37, l[1], s1); s2 = fmaf(x38, l[2], s2); s3 = fmaf(x39, l[3], s3); } { const f32x4 l = *(const LAS f32x4*)(Lc + 1196); s0 = fmaf(x40, l[0], s0); s1 = fmaf(x41, l[1], s1); s2 = fmaf(x42, l[2], s2); s3 = fmaf(x43, l[3], s3); } { const f32x4 l = *(const LAS f32x4*)(Lc + 1200); s0 = fmaf(x44, l[0], s0); s1 = fmaf(x45, l[1], s1); s2 = fmaf(x46, l[2], s2); s3 = fmaf(x47, l[3], s3); } { const f32x4 l = *(const LAS f32x4*)(Lc + 1204); s0 = fmaf(x48, l[0], s0); s1 = fmaf(x49, l[1], s1); s2 = fmaf(x50, l[2], s2); s3 = fmaf(x51, l[3], s3); } { const f32x4 l = *(const LAS f32x4*)(Lc + 1208); s0 = fmaf(x52, l[0], s0); s1 = fmaf(x53, l[1], s1); s2 = fmaf(x54, l[2], s2); s3 = fmaf(x55, l[3], s3); } { const f32x4 l = *(const LAS f32x4*)(Lc + 1212); s0 = fmaf(x56, l[0], s0); s1 = fmaf(x57, l[1], s1); s2 = fmaf(x58, l[2], s2); s3 = fmaf(x59, l[3], s3); } { const f32x4 l = *(const LAS f32x4*)(Lc + 1216); s0 = fmaf(x60, l[0], s0); s1 = fmaf(x61, l[1], s1); s2 = fmaf(x62, l[2], s2); s3 = fmaf(x63, l[3], s3); } x17 = (lane == 17) ? 1.0f : -((s0 + s1) + (s2 + s3)); asm volatile("" : "+v"(x17) : : "memory"); }
    { float s0 = 0.f, s1 = 0.f, s2 = 0.f, s3 = 0.f; { const f32x4 l = *(const LAS f32x4*)(Lc + 1104); s1 = fmaf(x17, l[1], s1); s2 = fmaf(x18, l[2], s2); s3 = fmaf(x19, l[3], s3); } { const f32x4 l = *(const LAS f32x4*)(Lc + 1108); s0 = fmaf(x20, l[0], s0); s1 = fmaf(x21, l[1], s1); s2 = fmaf(x22, l[2], s2); s3 = fmaf(x23, l[3], s3); } { const f32x4 l = *(const LAS f32x4*)(Lc + 1112); s0 = fmaf(x24, l[0], s0); s1 = fmaf(x25, l[1], s1); s2 = fmaf(x26, l[2], s2); s3 = fmaf(x27, l[3], s3); } { const f32x4 l = *(const LAS f32x4*)(Lc + 1116); s0 = fmaf(x28, l[0], s0); s1 = fmaf(x29, l[1], s1); s2 = fmaf(x30, l[2], s2); s3 = fmaf(x31, l[3], s3); } { const f32x4 l = *(const LAS f32x4*)(Lc + 1120); s0 = fmaf(x32, l[0], s0); s1 = fmaf(x33, l[1], s1); s2 = fmaf(x34, l[2], s2); s3 = fmaf(x35, l[3], s3); } { const f32x4 l = *(const LAS f32x4*)(Lc + 1124); s0 = fmaf(x36, l[0], s0); s1 = fmaf(x37, l[1], s1); s2 = fmaf(x38, l[2], s2); s3 = fmaf(x39, l[3], s3); } { const f32x4 l = *(const LAS f32x4*)(Lc + 1128); s0 = fmaf(x40, l[0], s0); s1 = fmaf(x41, l[1], s1); s2 = fmaf(x42, l[2], s2); s3 = fmaf(x43, l[3], s3); } { const f32x4 l = *(const LAS f32x4*)(Lc + 1132); s0 = fmaf(x44, l[0], s0); s1 = fmaf(x45, l[1], s1); s2 = fmaf(x46, l[2], s2); s3 = fmaf(x47, l[3], s3); } { const f32x4 l = *(const LAS f32x4*)(Lc + 1136); s0 = fmaf(x48, l[0], s0); s1 = fmaf(x49, l[1], s1); s2 = fmaf(x50, l[2], s2); s3 = fmaf(x51, l[3], s3); } { const f32x4 l = *(const LAS f32x4*)(Lc + 1140); s0 = fmaf(x52, l[0], s0); s1 = fmaf(x53, l[1], s1); s2 = fmaf(x54, l[2], s2); s3 = fmaf(x55, l[3], s3); } { const f32x4 l = *(const LAS f32x4*)(Lc + 1144); s0 = fmaf(x56, l[0], s0); s1 = fmaf(x57, l[1], s1); s2 = fmaf(x58, l[2], s2); s3 = fmaf(x59, l[3], s3); } { const f32x4 l = *(const LAS f32x4*)(Lc + 1148); s0 = fmaf(x60, l[0], s0); s1 = fmaf(x61, l[1], s1); s2 = fmaf(x62, l[2], s2); s3 = fmaf(x63, l[3], s3); } x16 = (lane == 16) ? 1.0f : -((s0 + s1) + (s2 + s3)); asm volatile("" : "+v"(x16) : : "memory"); }
    { float s0 = 0.f, s1 = 0.f, s2 = 0.f, s3 = 0.f; { const f32x4 l = *(const LAS f32x4*)(Lc + 1036); s0 = fmaf(x16, l[0], s0); s1 = fmaf(x17, l[1], s1); s2 = fmaf(x18, l[2], s2); s3 = fmaf(x19, l[3], s3); } { const f32x4 l = *(const LAS f32x4*)(Lc + 1040); s0 = fmaf(x20, l[0], s0); s1 = fmaf(x21, l[1], s1); s2 = fmaf(x22, l[2], s2); s3 = fmaf(x23, l[3], s3); } { const f32x4 l = *(const LAS f32x4*)(Lc + 1044); s0 = fmaf(x24, l[0], s0); s1 = fmaf(x25, l[1], s1); s2 = fmaf(x26, l[2], s2); s3 = fmaf(x27, l[3], s3); } { const f32x4 l = *(const LAS f32x4*)(Lc + 1048); s0 = fmaf(x28, l[0], s0); s1 = fmaf(x29, l[1], s1); s2 = fmaf(x30, l[2], s2); s3 = fmaf(x31, l[3], s3); } { const f32x4 l = *(const LAS f32x4*)(Lc + 1052); s0 = fmaf(x32, l[0], s0); s1 = fmaf(x33, l[1], s1); s2 = fmaf(x34, l[2], s2); s3 = fmaf(x35, l[3], s3); } { const f32x4 l = *(const LAS f32x4*)(Lc + 1056); s0 = fmaf(x36, l[0], s0); s1 = fmaf(x37, l[1], s1); s2 = fmaf(x38, l[2], s2); s3 = fmaf(x39, l[3], s3); } { const f32x4 l = *(const LAS f32x4*)(Lc + 1060); s0 = fmaf(x40, l[0], s0); s1 = fmaf(x41, l[1], s1); s2 = fmaf(x42, l[2], s2); s3 = fmaf(x43, l[3], s3); } { const f32x4 l = *(const LAS f32x4*)(Lc + 1064); s0 = fmaf(x44, l[0], s0); s1 = fmaf(x45, l[1], s1); s2 = fmaf(x46, l[2], s2); s3 = fmaf(x47, l[3], s3); } { const f32x4 l = *(const LAS f32x4*)(Lc + 1068); s0 = fmaf(x48, l[0], s0); s1 = fmaf(x49, l[1], s1); s2 = fmaf(x50, l[2], s2); s3 = fmaf(x51, l[3], s3); } { const f32x4 l = *(const LAS f32x4*)(Lc + 1072); s0 = fmaf(x52, l[0], s0); s1 = fmaf(x53, l[1], s1); s2 = fmaf(x54, l[2], s2); s3 = fmaf(x55, l[3], s3); } { const f32x4 l = *(const LAS f32x4*)(Lc + 1076); s0 = fmaf(x56, l[0], s0); s1 = fmaf(x57, l[1], s1); s2 = fmaf(x58, l[2], s2); s3 = fmaf(x59, l[3], s3); } { const f32x4 l = *(const LAS f32x4*)(Lc + 1080); s0 = fmaf(x60, l[0], s0); s1 = fmaf(x61, l[1], s1); s2 = fmaf(x62, l[2], s2); s3 = fmaf(x63, l[3], s3); } x15 = (lane == 15) ? 1.0f : -((s0 + s1) + (s2 + s3)); asm volatile("" : "+v"(x15) : : "memory"); }
    { float s0 = 0.f, s1 = 0.f, s2 = 0.f, s3 = 0.f; { const f32x4 l = *(const LAS f32x4*)(Lc + 964); s3 = fmaf(x15, l[3], s3); } { const f32x4 l = *(const LAS f32x4*)(Lc + 968); s0 = fmaf(x16, l[0], s0); s1 = fmaf(x17, l[1], s1); s2 = fmaf(x18, l[2], s2); s3 = fmaf(x19, l[3], s3); } { const f32x4 l = *(const LAS f32x4*)(Lc + 972); s0 = fmaf(x20, l[0], s0); s1 = fmaf(x21, l[1], s1); s2 = fmaf(x22, l[2], s2); s3 = fmaf(x23, l[3], s3); } { const f32x4 l = *(const LAS f32x4*)(Lc + 976); s0 = fmaf(x24, l[0], s0); s1 = fmaf(x25, l[1], s1); s2 = fmaf(x26, l[2], s2); s3 = fmaf(x27, l[3], s3); } { const f32x4 l = *(const LAS f32x4*)(Lc + 980); s0 = fmaf(x28, l[0], s0); s1 = fmaf(x29, l[1], s1); s2 = fmaf(x30, l[2], s2); s3 = fmaf(x31, l[3], s3); } { const f32x4 l = *(const LAS f32x4*)(Lc + 984); s0 = fmaf(x32, l[0], s0); s1 = fmaf(x33, l[1], s1); s2 = fmaf(x34, l[2], s2); s3 = fmaf(x35, l[3], s3); } { const f32x4 l = *(const LAS f32x4*)(Lc + 988); s0 = fmaf(x36, l[0], s0); s1 = fmaf(x37, l[1], s1); s2 = fmaf(x38, l[2], s2); s3 = fmaf(x39, l[3], s3); } { const f32x4 l = *(const LAS f32x4*)(Lc + 992); s0 = fmaf(x40, l[0], s0); s1 = fmaf(x41, l[1], s1); s2 = fmaf(x42, l[2], s2); s3 = fmaf(x43, l[3], s3); } { const f32x4 l = *(const LAS f32x4*)(Lc + 996); s0 = fmaf(x44, l[0], s0); s1 = fmaf(x45, l[1], s1); s2 = fmaf(x46, l[2], s2); s3 = fmaf(x47, l[3], s3); } { const f32x4 l = *(const LAS f32x4*)(Lc + 1000); s0 = fmaf(x48, l[0], s0); s1 = fmaf(x49, l[1], s1); s2 = fmaf(x50, l[2], s2); s3 = fmaf(x51, l[3], s3); } { const f32x4 l = *(const LAS f32x4*)(Lc + 1004); s0 = fmaf(x52, l[0], s0); s1 = fmaf(x53, l[1], s1); s2 = fmaf(x54, l[2], s2); s3 = fmaf(x55, l[3], s3); } { const f32x4 l = *(const LAS f32x4*)(Lc + 1008); s0 = fmaf(x56, l[0], s0); s1 = fmaf(x57, l[1], s1); s2 = fmaf(x58, l[2], s2); s3 = fmaf(x59, l[3], s3); } { const f32x4 l = *(const LAS f32x4*)(Lc + 1012); s0 = fmaf(x60, l[0], s0); s1 = fmaf(x61, l[1], s1); s2 = fmaf(x62, l[2], s2); s3 = fmaf(x63, l[3], s3); } x14 = (lane == 14) ? 1.0f : -((s0 + s1) + (s2 + s3)); asm volatile("" : "+v"(x14) : : "memory"); }
    { float s0 = 0.f, s1 = 0.f, s2 = 0.f, s3 = 0.f; { const f32x4 l = *(const LAS f32x4*)(Lc + 896); s2 = fmaf(x14, l[2], s2); s3 = fmaf(x15, l[3], s3); } { const f32x4 l = *(const LAS f32x4*)(Lc + 900); s0 = fmaf(x16, l[0], s0); s1 = fmaf(x17, l[1], s1); s2 = fmaf(x18, l[2], s2); s3 = fmaf(x19, l[3], s3); } { const f32x4 l = *(const LAS f32x4*)(Lc + 904); s0 = fmaf(x20, l[0], s0); s1 = fmaf(x21, l[1], s1); s2 = fmaf(x22, l[2], s2); s3 = fmaf(x23, l[3], s3); } { const f32x4 l = *(const LAS f32x4*)(Lc + 908); s0 = fmaf(x24, l[0], s0); s1 = fmaf(x25, l[1], s1); s2 = fmaf(x26, l[2], s2); s3 = fmaf(x27, l[3], s3); } { const f32x4 l = *(const LAS f32x4*)(Lc + 912); s0 = fmaf(x28, l[0], s0); s1 = fmaf(x29, l[1], s1); s2 = fmaf(x30, l[2], s2); s3 = fmaf(x31, l[3], s3); } { const f32x4 l = *(const LAS f32x4*)(Lc + 916); s0 = fmaf(x32, l[0], s0); s1 = fmaf(x33, l[1], s1); s2 = fmaf(x34, l[2], s2); s3 = fmaf(x35, l[3], s3); } { const f32x4 l = *(const LAS f32x4*)(Lc + 920); s0 = fmaf(x36, l[0], s0); s1 = fmaf(x37, l[1], s1); s2 = fmaf(x38, l[2], s2); s3 = fmaf(x39, l[3], s3); } { const f32x4 l = *(const LAS f32x4*)(Lc + 924); s0 = fmaf(x40, l[0], s0); s1 = fmaf(x41, l[1], s1); s2 = fmaf(x42, l[2], s2); s3 = fmaf(x43, l[3], s3); } { const f32x4 l = *(const LAS f32x4*)(Lc + 928); s0 = fmaf(x44, l[0], s0); s1 = fmaf(x45, l[1], s1); s2 = fmaf(x46, l[2], s2); s3 = fmaf(x47, l[3], s3); } { const f32x4 l = *(const LAS f32x4*)(Lc + 932); s0 = fmaf(x48, l[0], s0); s1 = fmaf(x49, l[1], s1); s2 = fmaf(x50, l[2], s2); s3 = fmaf(x51, l[3], s3); } { const f32x4 l = *(const LAS f32x4*)(Lc + 936); s0 = fmaf(x52, l[0], s0); s1 = fmaf(x53, l[1], s1); s2 = fmaf(x54, l[2], s2); s3 = fmaf(x55, l[3], s3); } { const f32x4 l = *(const LAS f32x4*)(Lc + 940); s0 = fmaf(x56, l[0], s0); s1 = fmaf(x57, l[1], s1); s2 = fmaf(x58, l[2], s2); s3 = fmaf(x59, l[3], s3); } { const f32x4 l = *(const LAS f32x4*)(Lc + 944); s0 = fmaf(x60, l[0], s0); s1 = fmaf(x61, l[1], s1); s2 = fmaf(x62, l[2], s2); s3 = fmaf(x63, l[3], s3); } x13 = (lane == 13) ? 1.0f : -((s0 + s1) + (s2 + s3)); asm volatile("" : "+v"(x13) : : "memory"); }
    { float s0 = 0.f, s1 = 0.f, s2 = 0.f, s3 = 0.f; { const f32x4 l = *(const LAS f32x4*)(Lc + 828); s1 = fmaf(x13, l[1], s1); s2 = fmaf(x14, l[2], s2); s3 = fmaf(x15, l[3], s3); } { const f32x4 l = *(const LAS f32x4*)(Lc + 832); s0 = fmaf(x16, l[0], s0); s1 = fmaf(x17, l[1], s1); s2 = fmaf(x18, l[2], s2); s3 = fmaf(x19, l[3], s3); } { const f32x4 l = *(const LAS f32x4*)(Lc + 836); s0 = fmaf(x20, l[0], s0); s1 = fmaf(x21, l[1], s1); s2 = fmaf(x22, l[2], s2); s3 = fmaf(x23, l[3], s3); } { const f32x4 l = *(const LAS f32x4*)(Lc + 840); s0 = fmaf(x24, l[0], s0); s1 = fmaf(x25, l[1], s1); s2 = fmaf(x26, l[2], s2); s3 = fmaf(x27, l[3], s3); } { const f32x4 l = *(const LAS f32x4*)(Lc + 844); s0 = fmaf(x28, l[0], s0); s1 = fmaf(x29, l[1], s1); s2 = fmaf(x30, l[2], s2); s3 = fmaf(x31, l[3], s3); } { const f32x4 l = *(const LAS f32x4*)(Lc + 848); s0 = fmaf(x32, l[0], s0); s1 = fmaf(x33, l[1], s1); s2 = fmaf(x34, l[2], s2); s3 = fmaf(x35, l[3], s3); } { const f32x4 l = *(const LAS f32x4*)(Lc + 852); s0 = fmaf(x36, l[0], s0); s1 = fmaf(x37, l[1], s1); s2 = fmaf(x38, l[2], s2); s3 = fmaf(x39, l[3], s3); } { const f32x4 l = *(const LAS f32x4*)(Lc + 856); s0 = fmaf(x40, l[0], s0); s1 = fmaf(x41, l[1], s1); s2 = fmaf(x42, l[2], s2); s3 = fmaf(x43, l[3], s3); } { const f32x4 l = *(const LAS f32x4*)(Lc + 860); s0 = fmaf(x44, l[0], s0); s1 = fmaf(x45, l[1], s1); s2 = fmaf(x46, l[2], s2); s3 = fmaf(x47, l[3], s3); } { const f32x4 l = *(const LAS f32x4*)(Lc + 864); s0 = fmaf(x48, l[0], s0); s1 = fmaf(x49, l[1], s1); s2 = fmaf(x50, l[2], s2); s3 = fmaf(x51, l[3], s3); } { const f32x4 l = *(const LAS f32x4*)(Lc + 868); s0 = fmaf(x52, l[0], s0); s1 = fmaf(x53, l[1], s1); s2 = fmaf(x54, l[2], s2); s3 = fmaf(x55, l[3], s3); } { const f32x4 l = *(const LAS f32x4*)(Lc + 872); s0 = fmaf(x56, l[0], s0); s1 = fmaf(x57, l[1], s1); s2 = fmaf(x58, l[2], s2); s3 = fmaf(x59, l[3], s3); } { const f32x4 l = *(const LAS f32x4*)(Lc + 876); s0 = fmaf(x60, l[0], s0); s1 = fmaf(x61, l[1], s1); s2 = fmaf(x62, l[2], s2); s3 = fmaf(x63, l[3], s3); } x12 = (lane == 12) ? 1.0f : -((s0 + s1) + (s2 + s3)); asm volatile("" : "+v"(x12) : : "memory"); }
    { float s0 = 0.f, s1 = 0.f, s2 = 0.f, s3 = 0.f; { const f32x4 l = *(const LAS f32x4*)(Lc + 760); s0 = fmaf(x12, l[0], s0); s1 = fmaf(x13, l[1], s1); s2 = fmaf(x14, l[2], s2); s3 = fmaf(x15, l[3], s3); } { const f32x4 l = *(const LAS f32x4*)(Lc + 764); s0 = fmaf(x16, l[0], s0); s1 = fmaf(x17, l[1], s1); s2 = fmaf(x18, l[2], s2); s3 = fmaf(x19, l[3], s3); } { const f32x4 l = *(const LAS f32x4*)(Lc + 768); s0 = fmaf(x20, l[0], s0); s1 = fmaf(x21, l[1], s1); s2 = fmaf(x22, l[2], s2); s3 = fmaf(x23, l[3], s3); } { const f32x4 l = *(const LAS f32x4*)(Lc + 772); s0 = fmaf(x24, l[0], s0); s1 = fmaf(x25, l[1], s1); s2 = fmaf(x26, l[2], s2); s3 = fmaf(x27, l[3], s3); } { const f32x4 l = *(const LAS f32x4*)(Lc + 776); s0 = fmaf(x28, l[0], s0); s1 = fmaf(x29, l[1], s1); s2 = fmaf(x30, l[2], s2); s3 = fmaf(x31, l[3], s3); } { const f32x4 l = *(const LAS f32x4*)(Lc + 780); s0 = fmaf(x32, l[0], s0); s1 = fmaf(x33, l[1], s1); s2 = fmaf(x34, l[2], s2); s3 = fmaf(x35, l[3], s3); } { const f32x4 l = *(const LAS f32x4*)(Lc + 784); s0 = fmaf(x36, l[0], s0); s1 = fmaf(x37, l[1], s1); s2 = fmaf(x38, l[2], s2); s3 = fmaf(x39, l[3], s3); } { const f32x4 l = *(const LAS f32x4*)(Lc + 788); s0 = fmaf(x40, l[0], s0); s1 = fmaf(x41, l[1], s1); s2 = fmaf(x42, l[2], s2); s3 = fmaf(x43, l[3], s3); } { const f32x4 l = *(const LAS f32x4*)(Lc + 792); s0 = fmaf(x44, l[0], s0); s1 = fmaf(x45, l[1], s1); s2 = fmaf(x46, l[2], s2); s3 = fmaf(x47, l[3], s3); } { const f32x4 l = *(const LAS f32x4*)(Lc + 796); s0 = fmaf(x48, l[0], s0); s1 = fmaf(x49, l[1], s1); s2 = fmaf(x50, l[2], s2); s3 = fmaf(x51, l[3], s3); } { const f32x4 l = *(const LAS f32x4*)(Lc + 800); s0 = fmaf(x52, l[0], s0); s1 = fmaf(x53, l[1], s1); s2 = fmaf(x54, l[2], s2); s3 = fmaf(x55, l[3], s3); } { const f32x4 l = *(const LAS f32x4*)(Lc + 804); s0 = fmaf(x56, l[0], s0); s1 = fmaf(x57, l[1], s1); s2 = fmaf(x58, l[2], s2); s3 = fmaf(x59, l[3], s3); } { const f32x4 l = *(const LAS f32x4*)(Lc + 808); s0 = fmaf(x60, l[0], s0); s1 = fmaf(x61, l[1], s1); s2 = fmaf(x62, l[2], s2); s3 = fmaf(x63, l[3], s3); } x11 = (lane == 11) ? 1.0f : -((s0 + s1) + (s2 + s3)); asm volatile("" : "+v"(x11) : : "memory"); }
    { float s0 = 0.f, s1 = 0.f, s2 = 0.f, s3 = 0.f; { const f32x4 l = *(const LAS f32x4*)(Lc + 688); s3 = fmaf(x11, l[3], s3); } { const f32x4 l = *(const LAS f32x4*)(Lc + 692); s0 = fmaf(x12, l[0], s0); s1 = fmaf(x13, l[1], s1); s2 = fmaf(x14, l[2], s2); s3 = fmaf(x15, l[3], s3); } { const f32x4 l = *(const LAS f32x4*)(Lc + 696); s0 = fmaf(x16, l[0], s0); s1 = fmaf(x17, l[1], s1); s2 = fmaf(x18, l[2], s2); s3 = fmaf(x19, l[3], s3); } { const f32x4 l = *(const LAS f32x4*)(Lc + 700); s0 = fmaf(x20, l[0], s0); s1 = fmaf(x21, l[1], s1); s2 = fmaf(x22, l[2], s2); s3 = fmaf(x23, l[3], s3); } { const f32x4 l = *(const LAS f32x4*)(Lc + 704); s0 = fmaf(x24, l[0], s0); s1 = fmaf(x25, l[1], s1); s2 = fmaf(x26, l[2], s2); s3 = fmaf(x27, l[3], s3); } { const f32x4 l = *(const LAS f32x4*)(Lc + 708); s0 = fmaf(x28, l[0], s0); s1 = fmaf(x29, l[1], s1); s2 = fmaf(x30, l[2], s2); s3 = fmaf(x31, l[3], s3); } { const f32x4 l = *(const LAS f32x4*)(Lc + 712); s0 = fmaf(x32, l[0], s0); s1 = fmaf(x33, l[1], s1); s2 = fmaf(x34, l[2], s2); s3 = fmaf(x35, l[3], s3); } { const f32x4 l = *(const LAS f32x4*)(Lc + 716); s0 = fmaf(x36, l[0], s0); s1 = fmaf(x37, l[1], s1); s2 = fmaf(x38, l[2], s2); s3 = fmaf(x39, l[3], s3); } { const f32x4 l = *(const LAS f32x4*)(Lc + 720); s0 = fmaf(x40, l[0], s0); s1 = fmaf(x41, l[1], s1); s2 = fmaf(x42, l[2], s2); s3 = fmaf(x43, l[3], s3); } { const f32x4 l = *(const LAS f32x4*)(Lc + 724); s0 = fmaf(x44, l[0], s0); s1 = fmaf(x45, l[1], s1); s2 = fmaf(x46, l[2], s2); s3 = fmaf(x47, l[3], s3); } { const f32x4 l = *(const LAS f32x4*)(Lc + 728); s0 = fmaf(x48, l[0], s0); s1 = fmaf(x49, l[1], s1); s2 = fmaf(x50, l[2], s2); s3 = fmaf(x51, l[3], s3); } { const f32x4 l = *(const LAS f32x4*)(Lc + 732); s0 = fmaf(x52, l[0], s0); s1 = fmaf(x53, l[1], s1); s2 = fmaf(x54, l[2], s2); s3 = fmaf(x55, l[3], s3); } { const f32x4 l = *(const LAS f32x4*)(Lc + 736); s0 = fmaf(x56, l[0], s0); s1 = fmaf(x57, l[1], s1); s2 = fmaf(x58, l[2], s2); s3 = fmaf(x59, l[3], s3); } { const f32x4 l = *(const LAS f32x4*)(Lc + 740); s0 = fmaf(x60, l[0], s0); s1 = fmaf(x61, l[1], s1); s2 = fmaf(x62, l[2], s2); s3 = fmaf(x63, l[3], s3); } x10 = (lane == 10) ? 1.0f : -((s0 + s1) + (s2 + s3)); asm volatile("" : "+v"(x10) : : "memory"); }
    { float s0 = 0.f, s1 = 0.f, s2 = 0.f, s3 = 0.f; { const f32x4 l = *(const LAS f32x4*)(Lc + 620); s2 = fmaf(x10, l[2], s2); s3 = fmaf(x11, l[3], s3); } { const f32x4 l = *(const LAS f32x4*)(Lc + 624); s0 = fmaf(x12, l[0], s0); s1 = fmaf(x13, l[1], s1); s2 = fmaf(x14, l[2], s2); s3 = fmaf(x15, l[3], s3); } { const f32x4 l = *(const LAS f32x4*)(Lc + 628); s0 = fmaf(x16, l[0], s0); s1 = fmaf(x17, l[1], s1); s2 = fmaf(x18, l[2], s2); s3 = fmaf(x19, l[3], s3); } { const f32x4 l = *(const LAS f32x4*)(Lc + 632); s0 = fmaf(x20, l[0], s0); s1 = fmaf(x21, l[1], s1); s2 = fmaf(x22, l[2], s2); s3 = fmaf(x23, l[3], s3); } { const f32x4 l = *(const LAS f32x4*)(Lc + 636); s0 = fmaf(x24, l[0], s0); s1 = fmaf(x25, l[1], s1); s2 = fmaf(x26, l[2], s2); s3 = fmaf(x27, l[3], s3); } { const f32x4 l = *(const LAS f32x4*)(Lc + 640); s0 = fmaf(x28, l[0], s0); s1 = fmaf(x29, l[1], s1); s2 = fmaf(x30, l[2], s2); s3 = fmaf(x31, l[3], s3); } { const f32x4 l = *(const LAS f32x4*)(Lc + 644); s0 = fmaf(x32, l[0], s0); s1 = fmaf(x33, l[1], s1); s2 = fmaf(x34, l[2], s2); s3 = fmaf(x35, l[3], s3); } { const f32x4 l = *(const LAS f32x4*)(Lc + 648); s0 = fmaf(x36, l[0], s0); s1 = fmaf(x37, l[1], s1); s2 = fmaf(x38, l[2], s2); s3 = fmaf(x39, l[3], s3); } { const f32x4 l = *(const LAS f32x4*)(Lc + 652); s0 = fmaf(x40, l[0], s0); s1 = fmaf(x41, l[1], s1); s2 = fmaf(x42, l[2], s2); s3 = fmaf(x43, l[3], s3); } { const f32x4 l = *(const LAS f32x4*)(Lc + 656); s0 = fmaf(x44, l[0], s0); s1 = fmaf(x45, l[1], s1); s2 = fmaf(x46, l[2], s2); s3 = fmaf(x47, l[3], s3); } { const f32x4 l = *(const LAS f32x4*)(Lc + 660); s0 = fmaf(x48, l[0], s0); s1 = fmaf(x49, l[1], s1); s2 = fmaf(x50, l[2], s2); s3 = fmaf(x51, l[3], s3); } { const f32x4 l = *(const LAS f32x4*)(Lc + 664); s0 = fmaf(x52, l[0], s0); s1 = fmaf(x53, l[1], s1); s2 = fmaf(x54, l[2], s2); s3 = fmaf(x55, l[3], s3); } { const f32x4 l = *(const LAS f32x4*)(Lc + 668); s0 = fmaf(x56, l[0], s0); s1 = fmaf(x57, l[1], s1); s2 = fmaf(x58, l[2], s2); s3 = fmaf(x59, l[3], s3); } { const f32x4 l = *(const LAS f32x4*)(Lc + 672); s0 = fmaf(x60, l[0], s0); s1 = fmaf(x61, l[1], s1); s2 = fmaf(x62, l[2], s2); s3 = fmaf(x63, l[3], s3); } x9 = (lane == 9) ? 1.0f : -((s0 + s1) + (s2 + s3)); asm volatile("" : "+v"(x9) : : "memory"); }
    { float s0 = 0.f, s1 = 0.f, s2 = 0.f, s3 = 0.f; { const f32x4 l = *(const LAS f32x4*)(Lc + 552); s1 = fmaf(x9, l[1], s1); s2 = fmaf(x10, l[2], s2); s3 = fmaf(x11, l[3], s3); } { const f32x4 l = *(const LAS f32x4*)(Lc + 556); s0 = fmaf(x12, l[0], s0); s1 = fmaf(x13, l[1], s1); s2 = fmaf(x14, l[2], s2); s3 = fmaf(x15, l[3], s3); } { const f32x4 l = *(const LAS f32x4*)(Lc + 560); s0 = fmaf(x16, l[0], s0); s1 = fmaf(x17, l[1], s1); s2 = fmaf(x18, l[2], s2); s3 = fmaf(x19, l[3], s3); } { const f32x4 l = *(const LAS f32x4*)(Lc + 564); s0 = fmaf(x20, l[0], s0); s1 = fmaf(x21, l[1], s1); s2 = fmaf(x22, l[2], s2); s3 = fmaf(x23, l[3], s3); } { const f32x4 l = *(const LAS f32x4*)(Lc + 568); s0 = fmaf(x24, l[0], s0); s1 = fmaf(x25, l[1], s1); s2 = fmaf(x26, l[2], s2); s3 = fmaf(x27, l[3], s3); } { const f32x4 l = *(const LAS f32x4*)(Lc + 572); s0 = fmaf(x28, l[0], s0); s1 = fmaf(x29, l[1], s1); s2 = fmaf(x30, l[2], s2); s3 = fmaf(x31, l[3], s3); } { const f32x4 l = *(const LAS f32x4*)(Lc + 576); s0 = fmaf(x32, l[0], s0); s1 = fmaf(x33, l[1], s1); s2 = fmaf(x34, l[2], s2); s3 = fmaf(x35, l[3], s3); } { const f32x4 l = *(const LAS f32x4*)(Lc + 580); s0 = fmaf(x36, l[0], s0); s1 = fmaf(x37, l[1], s1); s2 = fmaf(x38, l[2], s2); s3 = fmaf(x39, l[3], s3); } { const f32x4 l = *(const LAS f32x4*)(Lc + 584); s0 = fmaf(x40, l[0], s0); s1 = fmaf(x41, l[1], s1); s2 = fmaf(x42, l[2], s2); s3 = fmaf(x43, l[3], s3); } { const f32x4 l = *(const LAS f32x4*)(Lc + 588); s0 = fmaf(x44, l[0], s0); s1 = fmaf(x45, l[1], s1); s2 = fmaf(x46, l[2], s2); s3 = fmaf(x47, l[3], s3); } { const f32x4 l = *(const LAS f32x4*)(Lc + 592); s0 = fmaf(x48, l[0], s0); s1 = fmaf(x49, l[1], s1); s2 = fmaf(x50, l[2], s2); s3 = fmaf(x51, l[3], s3); } { const f32x4 l = *(const LAS f32x4*)(Lc + 596); s0 = fmaf(x52, l[0], s0); s1 = fmaf(x53, l[1], s1); s2 = fmaf(x54, l[2], s2); s3 = fmaf(x55, l[3], s3); } { const f32x4 l = *(const LAS f32x4*)(Lc + 600); s0 = fmaf(x56, l[0], s0); s1 = fmaf(x57, l[1], s1); s2 = fmaf(x58, l[2], s2); s3 = fmaf(x59, l[3], s3); } { const f32x4 l = *(const LAS f32x4*)(Lc + 604); s0 = fmaf(x60, l[0], s0); s1 = fmaf(x61, l[1], s1); s2 = fmaf(x62, l[2], s2); s3 = fmaf(x63, l[3], s3); } x8 = (lane == 8) ? 1.0f : -((s0 + s1) + (s2 + s3)); asm volatile("" : "+v"(x8) : : "memory"); }
    { float s0 = 0.f, s1 = 0.f, s2 = 0.f, s3 = 0.f; { const f32x4 l = *(const LAS f32x4*)(Lc + 484); s0 = fmaf(x8, l[0], s0); s1 = fmaf(x9, l[1], s1); s2 = fmaf(x10, l[2], s2); s3 = fmaf(x11, l[3], s3); } { const f32x4 l = *(const LAS f32x4*)(Lc + 488); s0 = fmaf(x12, l[0], s0); s1 = fmaf(x13, l[1], s1); s2 = fmaf(x14, l[2], s2); s3 = fmaf(x15, l[3], s3); } { const f32x4 l = *(const LAS f32x4*)(Lc + 492); s0 = fmaf(x16, l[0], s0); s1 = fmaf(x17, l[1], s1); s2 = fmaf(x18, l[2], s2); s3 = fmaf(x19, l[3], s3); } { const f32x4 l = *(const LAS f32x4*)(Lc + 496); s0 = fmaf(x20, l[0], s0); s1 = fmaf(x21, l[1], s1); s2 = fmaf(x22, l[2], s2); s3 = fmaf(x23, l[3], s3); } { const f32x4 l = *(const LAS f32x4*)(Lc + 500); s0 = fmaf(x24, l[0], s0); s1 = fmaf(x25, l[1], s1); s2 = fmaf(x26, l[2], s2); s3 = fmaf(x27, l[3], s3); } { const f32x4 l = *(const LAS f32x4*)(Lc + 504); s0 = fmaf(x28, l[0], s0); s1 = fmaf(x29, l[1], s1); s2 = fmaf(x30, l[2], s2); s3 = fmaf(x31, l[3], s3); } { const f32x4 l = *(const LAS f32x4*)(Lc + 508); s0 = fmaf(x32, l[0], s0); s1 = fmaf(x33, l[1], s1); s2 = fmaf(x34, l[2], s2); s3 = fmaf(x35, l[3], s3); } { const f32x4 l = *(const LAS f32x4*)(Lc + 512); s0 = fmaf(x36, l[0], s0); s1 = fmaf(x37, l[1], s1); s2 = fmaf(x38, l[2], s2); s3 = fmaf(x39, l[3], s3); } { const f32x4 l = *(const LAS f32x4*)(Lc + 516); s0 = fmaf(x40, l[0], s0); s1 = fmaf(x41, l[1], s1); s2 = fmaf(x42, l[2], s2); s3 = fmaf(x43, l[3], s3); } { const f32x4 l = *(const LAS f32x4*)(Lc + 520); s0 = fmaf(x44, l[0], s0); s1 = fmaf(x45, l[1], s1); s2 = fmaf(x46, l[2], s2); s3 = fmaf(x47, l[3], s3); } { const f32x4 l = *(const LAS f32x4*)(Lc + 524); s0 = fmaf(x48, l[0], s0); s1 = fmaf(x49, l[1], s1); s2 = fmaf(x50, l[2], s2); s3 = fmaf(x51, l[3], s3); } { const f32x4 l = *(const LAS f32x4*)(Lc + 528); s0 = fmaf(x52, l[0], s0); s1 = fmaf(x53, l[1], s1); s2 = fmaf(x54, l[2], s2); s3 = fmaf(x55, l[3], s3); } { const f32x4 l = *(const LAS f32x4*)(Lc + 532); s0 = fmaf(x56, l[0], s0); s1 = fmaf(x57, l[1], s1); s2 = fmaf(x58, l[2], s2); s3 = fmaf(x59, l[3], s3); } { const f32x4 l = *(const LAS f32x4*)(Lc + 536); s0 = fmaf(x60, l[0], s0); s1 = fmaf(x61, l[1], s1); s2 = fmaf(x62, l[2], s2); s3 = fmaf(x63, l[3], s3); } x7 = (lane == 7) ? 1.0f : -((s0 + s1) + (s2 + s3)); asm volatile("" : "+v"(x7) : : "memory"); }
    { float s0 = 0.f, s1 = 0.f, s2 = 0.f, s3 = 0.f; { const f32x4 l = *(const LAS f32x4*)(Lc + 412); s3 = fmaf(x7, l[3], s3); } { const f32x4 l = *(const LAS f32x4*)(Lc + 416); s0 = fmaf(x8, l[0], s0); s1 = fmaf(x9, l[1], s1); s2 = fmaf(x10, l[2], s2); s3 = fmaf(x11, l[3], s3); } { const f32x4 l = *(const LAS f32x4*)(Lc + 420); s0 = fmaf(x12, l[0], s0); s1 = fmaf(x13, l[1], s1); s2 = fmaf(x14, l[2], s2); s3 = fmaf(x15, l[3], s3); } { const f32x4 l = *(const LAS f32x4*)(Lc + 424); s0 = fmaf(x16, l[0], s0); s1 = fmaf(x17, l[1], s1); s2 = fmaf(x18, l[2], s2); s3 = fmaf(x19, l[3], s3); } { const f32x4 l = *(const LAS f32x4*)(Lc + 428); s0 = fmaf(x20, l[0], s0); s1 = fmaf(x21, l[1], s1); s2 = fmaf(x22, l[2], s2); s3 = fmaf(x23, l[3], s3); } { const f32x4 l = *(const LAS f32x4*)(Lc + 432); s0 = fmaf(x24, l[0], s0); s1 = fmaf(x25, l[1], s1); s2 = fmaf(x26, l[2], s2); s3 = fmaf(x27, l[3], s3); } { const f32x4 l = *(const LAS f32x4*)(Lc + 436); s0 = fmaf(x28, l[0], s0); s1 = fmaf(x29, l[1], s1); s2 = fmaf(x30, l[2], s2); s3 = fmaf(x31, l[3], s3); } { const f32x4 l = *(const LAS f32x4*)(Lc + 440); s0 = fmaf(x32, l[0], s0); s1 = fmaf(x33, l[1], s1); s2 = fmaf(x34, l[2], s2); s3 = fmaf(x35, l[3], s3); } { const f32x4 l = *(const LAS f32x4*)(Lc + 444); s0 = fmaf(x36, l[0], s0); s1 = fmaf(x37, l[1], s1); s2 = fmaf(x38, l[2], s2); s3 = fmaf(x39, l[3], s3); } { const f32x4 l = *(const LAS f32x4*)(Lc + 448); s0 = fmaf(x40, l[0], s0); s1 = fmaf(x41, l[1], s1); s2 = fmaf(x42, l[2], s2); s3 = fmaf(x43, l[3], s3); } { const f32x4 l = *(const LAS f32x4*)(Lc + 452); s0 = fmaf(x44, l[0], s0); s1 = fmaf(x45, l[1], s1); s2 = fmaf(x46, l[2], s2); s3 = fmaf(x47, l[3], s3); } { const f32x4 l = *(const LAS f32x4*)(Lc + 456); s0 = fmaf(x48, l[0], s0); s1 = fmaf(x49, l[1], s1); s2 = fmaf(x50, l[2], s2); s3 = fmaf(x51, l[3], s3); } { const f32x4 l = *(const LAS f32x4*)(Lc + 460); s0 = fmaf(x52, l[0], s0); s1 = fmaf(x53, l[1], s1); s2 = fmaf(x54, l[2], s2); s3 = fmaf(x55, l[3], s3); } { const f32x4 l = *(const LAS f32x4*)(Lc + 464); s0 = fmaf(x56, l[0], s0); s1 = fmaf(x57, l[1], s1); s2 = fmaf(x58, l[2], s2); s3 = fmaf(x59, l[3], s3); } { const f32x4 l = *(const LAS f32x4*)(Lc + 468); s0 = fmaf(x60, l[0], s0); s1 = fmaf(x61, l[1], s1); s2 = fmaf(x62, l[2], s2); s3 = fmaf(x63, l[3], s3); } x6 = (lane == 6) ? 1.0f : -((s0 + s1) + (s2 + s3)); asm volatile("" : "+v"(x6) : : "memory"); }
    { float s0 = 0.f, s1 = 0.f, s2 = 0.f, s3 = 0.f; { const f32x4 l = *(const LAS f32x4*)(Lc + 344); s2 = fmaf(x6, l[2], s2); s3 = fmaf(x7, l[3], s3); } { const f32x4 l = *(const LAS f32x4*)(Lc + 348); s0 = fmaf(x8, l[0], s0); s1 = fmaf(x9, l[1], s1); s2 = fmaf(x10, l[2], s2); s3 = fmaf(x11, l[3], s3); } { const f32x4 l = *(const LAS f32x4*)(Lc + 352); s0 = fmaf(x12, l[0], s0); s1 = fmaf(x13, l[1], s1); s2 = fmaf(x14, l[2], s2); s3 = fmaf(x15, l[3], s3); } { const f32x4 l = *(const LAS f32x4*)(Lc + 356); s0 = fmaf(x16, l[0], s0); s1 = fmaf(x17, l[1], s1); s2 = fmaf(x18, l[2], s2); s3 = fmaf(x19, l[3], s3); } { const f32x4 l = *(const LAS f32x4*)(Lc + 360); s0 = fmaf(x20, l[0], s0); s1 = fmaf(x21, l[1], s1); s2 = fmaf(x22, l[2], s2); s3 = fmaf(x23, l[3], s3); } { const f32x4 l = *(const LAS f32x4*)(Lc + 364); s0 = fmaf(x24, l[0], s0); s1 = fmaf(x25, l[1], s1); s2 = fmaf(x26, l[2], s2); s3 = fmaf(x27, l[3], s3); } { const f32x4 l = *(const LAS f32x4*)(Lc + 368); s0 = fmaf(x28, l[0], s0); s1 = fmaf(x29, l[1], s1); s2 = fmaf(x30, l[2], s2); s3 = fmaf(x31, l[3], s3); } { const f32x4 l = *(const LAS f32x4*)(Lc + 372); s0 = fmaf(x32, l[0], s0); s1 = fmaf(x33, l[1], s1); s2 = fmaf(x34, l[2], s2); s3 = fmaf(x35, l[3], s3); } { const f32x4 l = *(const LAS f32x4*)(Lc + 376); s0 = fmaf(x36, l[0], s0); s1 = fmaf(x37, l[1], s1); s2 = fmaf(x38, l[2], s2); s3 = fmaf(x39, l[3], s3); } { const f32x4 l = *(const LAS f32x4*)(Lc + 380); s0 = fmaf(x40, l[0], s0); s1 = fmaf(x41, l[1], s1); s2 = fmaf(x42, l[2], s2); s3 = fmaf(x43, l[3], s3); } { const f32x4 l = *(const LAS f32x4*)(Lc + 384); s0 = fmaf(x44, l[0], s0); s1 = fmaf(x45, l[1], s1); s2 = fmaf(x46, l[2], s2); s3 = fmaf(x47, l[3], s3); } { const f32x4 l = *(const LAS f32x4*)(Lc + 388); s0 = fmaf(x48, l[0], s0); s1 = fmaf(x49, l[1], s1); s2 = fmaf(x50, l[2], s2); s3 = fmaf(x51, l[3], s3); } { const f32x4 l = *(const LAS f32x4*)(Lc + 392); s0 = fmaf(x52, l[0], s0); s1 = fmaf(x53, l[1], s1); s2 = fmaf(x54, l[2], s2); s3 = fmaf(x55, l[3], s3); } { const f32x4 l = *(const LAS f32x4*)(Lc + 396); s0 = fmaf(x56, l[0], s0); s1 = fmaf(x57, l[1], s1); s2 = fmaf(x58, l[2], s2); s3 = fmaf(x59, l[3], s3); } { const f32x4 l = *(const LAS f32x4*)(Lc + 400); s0 = fmaf(x60, l[0], s0); s1 = fmaf(x61, l[1], s1); s2 = fmaf(x62, l[2], s2); s3 = fmaf(x63, l[3], s3); } x5 = (lane == 5) ? 1.0f : -((s0 + s1) + (s2 + s3)); asm volatile("" : "+v"(x5) : : "memory"); }
    { float s0 = 0.f, s1 = 0.f, s2 = 0.f, s3 = 0.f; { const f32x4 l = *(const LAS f32x4*)(Lc + 276); s1 = fmaf(x5, l[1], s1); s2 = fmaf(x6, l[2], s2); s3 = fmaf(x7, l[3], s3); } { const f32x4 l = *(const LAS f32x4*)(Lc + 280); s0 = fmaf(x8, l[0], s0); s1 = fmaf(x9, l[1], s1); s2 = fmaf(x10, l[2], s2); s3 = fmaf(x11, l[3], s3); } { const f32x4 l = *(const LAS f32x4*)(Lc + 284); s0 = fmaf(x12, l[0], s0); s1 = fmaf(x13, l[1], s1); s2 = fmaf(x14, l[2], s2); s3 = fmaf(x15, l[3], s3); } { const f32x4 l = *(const LAS f32x4*)(Lc + 288); s0 = fmaf(x16, l[0], s0); s1 = fmaf(x17, l[1], s1); s2 = fmaf(x18, l[2], s2); s3 = fmaf(x19, l[3], s3); } { const f32x4 l = *(const LAS f32x4*)(Lc + 292); s0 = fmaf(x20, l[0], s0); s1 = fmaf(x21, l[1], s1); s2 = fmaf(x22, l[2], s2); s3 = fmaf(x23, l[3], s3); } { const f32x4 l = *(const LAS f32x4*)(Lc + 296); s0 = fmaf(x24, l[0], s0); s1 = fmaf(x25, l[1], s1); s2 = fmaf(x26, l[2], s2); s3 = fmaf(x27, l[3], s3); } { const f32x4 l = *(const LAS f32x4*)(Lc + 300); s0 = fmaf(x28, l[0], s0); s1 = fmaf(x29, l[1], s1); s2 = fmaf(x30, l[2], s2); s3 = fmaf(x31, l[3], s3); } { const f32x4 l = *(const LAS f32x4*)(Lc + 304); s0 = fmaf(x32, l[0], s0); s1 = fmaf(x33, l[1], s1); s2 = fmaf(x34, l[2], s2); s3 = fmaf(x35, l[3], s3); } { const f32x4 l = *(const LAS f32x4*)(Lc + 308); s0 = fmaf(x36, l[0], s0); s1 = fmaf(x37, l[1], s1); s2 = fmaf(x38, l[2], s2); s3 = fmaf(x39, l[3], s3); } { const f32x4 l = *(const LAS f32x4*)(Lc + 312); s0 = fmaf(x40, l[0], s0); s1 = fmaf(x41, l[1], s1); s2 = fmaf(x42, l[2], s2); s3 = fmaf(x43, l[3], s3); } { const f32x4 l = *(const LAS f32x4*)(Lc + 316); s0 = fmaf(x44, l[0], s0); s1 = fmaf(x45, l[1], s1); s2 = fmaf(x46, l[2], s2); s3 = fmaf(x47, l[3], s3); } { const f32x4 l = *(const LAS f32x4*)(Lc + 320); s0 = fmaf(x48, l[0], s0); s1 = fmaf(x49, l[1], s1); s2 = fmaf(x50, l[2], s2); s3 = fmaf(x51, l[3], s3); } { const f32x4 l = *(const LAS f32x4*)(Lc + 324); s0 = fmaf(x52, l[0], s0); s1 = fmaf(x53, l[1], s1); s2 = fmaf(x54, l[2], s2); s3 = fmaf(x55, l[3], s3); } { const f32x4 l = *(const LAS f32x4*)(Lc + 328); s0 = fmaf(x56, l[0], s0); s1 = fmaf(x57, l[1], s1); s2 = fmaf(x58, l[2], s2); s3 = fmaf(x59, l[3], s3); } { const f32x4 l = *(const LAS f32x4*)(Lc + 332); s0 = fmaf(x60, l[0], s0); s1 = fmaf(x61, l[1], s1); s2 = fmaf(x62, l[2], s2); s3 = fmaf(x63, l[3], s3); } x4 = (lane == 4) ? 1.0f : -((s0 + s1) + (s2 + s3)); asm volatile("" : "+v"(x4) : : "memory"); }
    { float s0 = 0.f, s1 = 0.f, s2 = 0.f, s3 = 0.f; { const f32x4 l = *(const LAS f32x4*)(Lc + 208); s0 = fmaf(x4, l[0], s0); s1 = fmaf(x5, l[1], s1); s2 = fmaf(x6, l[2], s2); s3 = fmaf(x7, l[3], s3); } { const f32x4 l = *(const LAS f32x4*)(Lc + 212); s0 = fmaf(x8, l[0], s0); s1 = fmaf(x9, l[1], s1); s2 = fmaf(x10, l[2], s2); s3 = fmaf(x11, l[3], s3); } { const f32x4 l = *(const LAS f32x4*)(Lc + 216); s0 = fmaf(x12, l[0], s0); s1 = fmaf(x13, l[1], s1); s2 = fmaf(x14, l[2], s2); s3 = fmaf(x15, l[3], s3); } { const f32x4 l = *(const LAS f32x4*)(Lc + 220); s0 = fmaf(x16, l[0], s0); s1 = fmaf(x17, l[1], s1); s2 = fmaf(x18, l[2], s2); s3 = fmaf(x19, l[3], s3); } { const f32x4 l = *(const LAS f32x4*)(Lc + 224); s0 = fmaf(x20, l[0], s0); s1 = fmaf(x21, l[1], s1); s2 = fmaf(x22, l[2], s2); s3 = fmaf(x23, l[3], s3); } { const f32x4 l = *(const LAS f32x4*)(Lc + 228); s0 = fmaf(x24, l[0], s0); s1 = fmaf(x25, l[1], s1); s2 = fmaf(x26, l[2], s2); s3 = fmaf(x27, l[3], s3); } { const f32x4 l = *(const LAS f32x4*)(Lc + 232); s0 = fmaf(x28, l[0], s0); s1 = fmaf(x29, l[1], s1); s2 = fmaf(x30, l[2], s2); s3 = fmaf(x31, l[3], s3); } { const f32x4 l = *(const LAS f32x4*)(Lc + 236); s0 = fmaf(x32, l[0], s0); s1 = fmaf(x33, l[1], s1); s2 = fmaf(x34, l[2], s2); s3 = fmaf(x35, l[3], s3); } { const f32x4 l = *(const LAS f32x4*)(Lc + 240); s0 = fmaf(x36, l[0], s0); s1 = fmaf(x37, l[1], s1); s2 = fmaf(x38, l[2], s2); s3 = fmaf(x39, l[3], s3); } { const f32x4 l = *(const LAS f32x4*)(Lc + 244); s0 = fmaf(x40, l[0], s0); s1 = fmaf(x41, l[1], s1); s2 = fmaf(x42, l[2], s2); s3 = fmaf(x43, l[3], s3); } { const f32x4 l = *(const LAS f32x4*)(Lc + 248); s0 = fmaf(x44, l[0], s0); s1 = fmaf(x45, l[1], s1); s2 = fmaf(x46, l[2], s2); s3 = fmaf(x47, l[3], s3); } { const f32x4 l = *(const LAS f32x4*)(Lc + 252); s0 = fmaf(x48, l[0], s0); s1 = fmaf(x49, l[1], s1); s2 = fmaf(x50, l[2], s2); s3 = fmaf(x51, l[3], s3); } { const f32x4 l = *(const LAS f32x4*)(Lc + 256); s0 = fmaf(x52, l[0], s0); s1 = fmaf(x53, l[1], s1); s2 = fmaf(x54, l[2], s2); s3 = fmaf(x55, l[3], s3); } { const f32x4 l = *(const LAS f32x4*)(Lc + 260); s0 = fmaf(x56, l[0], s0); s1 = fmaf(x57, l[1], s1); s2 = fmaf(x58, l[2], s2); s3 = fmaf(x59, l[3], s3); } { const f32x4 l = *(const LAS f32x4*)(Lc + 264); s0 = fmaf(x60, l[0], s0); s1 = fmaf(x61, l[1], s1); s2 = fmaf(x62, l[2], s2); s3 = fmaf(x63, l[3], s3); } x3 = (lane == 3) ? 1.0f : -((s0 + s1) + (s2 + s3)); asm volatile("" : "+v"(x3) : : "memory"); }
    { float s0 = 0.f, s1 = 0.f, s2 = 0.f, s3 = 0.f; { const f32x4 l = *(const LAS f32x4*)(Lc + 136); s3 = fmaf(x3, l[3], s3); } { const f32x4 l = *(const LAS f32x4*)(Lc + 140); s0 = fmaf(x4, l[0], s0); s1 = fmaf(x5, l[1], s1); s2 = fmaf(x6, l[2], s2); s3 = fmaf(x7, l[3], s3); } { const f32x4 l = *(const LAS f32x4*)(Lc + 144); s0 = fmaf(x8, l[0], s0); s1 = fmaf(x9, l[1], s1); s2 = fmaf(x10, l[2], s2); s3 = fmaf(x11, l[3], s3); } { const f32x4 l = *(const LAS f32x4*)(Lc + 148); s0 = fmaf(x12, l[0], s0); s1 = fmaf(x13, l[1], s1); s2 = fmaf(x14, l[2], s2); s3 = fmaf(x15, l[3], s3); } { const f32x4 l = *(const LAS f32x4*)(Lc + 152); s0 = fmaf(x16, l[0], s0); s1 = fmaf(x17, l[1], s1); s2 = fmaf(x18, l[2], s2); s3 = fmaf(x19, l[3], s3); } { const f32x4 l = *(const LAS f32x4*)(Lc + 156); s0 = fmaf(x20, l[0], s0); s1 = fmaf(x21, l[1], s1); s2 = fmaf(x22, l[2], s2); s3 = fmaf(x23, l[3], s3); } { const f32x4 l = *(const LAS f32x4*)(Lc + 160); s0 = fmaf(x24, l[0], s0); s1 = fmaf(x25, l[1], s1); s2 = fmaf(x26, l[2], s2); s3 = fmaf(x27, l[3], s3); } { const f32x4 l = *(const LAS f32x4*)(Lc + 164); s0 = fmaf(x28, l[0], s0); s1 = fmaf(x29, l[1], s1); s2 = fmaf(x30, l[2], s2); s3 = fmaf(x31, l[3], s3); } { const f32x4 l = *(const LAS f32x4*)(Lc + 168); s0 = fmaf(x32, l[0], s0); s1 = fmaf(x33, l[1], s1); s2 = fmaf(x34, l[2], s2); s3 = fmaf(x35, l[3], s3); } { const f32x4 l = *(const LAS f32x4*)(Lc + 172); s0 = fmaf(x36, l[0], s0); s1 = fmaf(x37, l[1], s1); s2 = fmaf(x38, l[2], s2); s3 = fmaf(x39, l[3], s3); } { const f32x4 l = *(const LAS f32x4*)(Lc + 176); s0 = fmaf(x40, l[0], s0); s1 = fmaf(x41, l[1], s1); s2 = fmaf(x42, l[2], s2); s3 = fmaf(x43, l[3], s3); } { const f32x4 l = *(const LAS f32x4*)(Lc + 180); s0 = fmaf(x44, l[0], s0); s1 = fmaf(x45, l[1], s1); s2 = fmaf(x46, l[2], s2); s3 = fmaf(x47, l[3], s3); } { const f32x4 l = *(const LAS f32x4*)(Lc + 184); s0 = fmaf(x48, l[0], s0); s1 = fmaf(x49, l[1], s1); s2 = fmaf(x50, l[2], s2); s3 = fmaf(x51, l[3], s3); } { const f32x4 l = *(const LAS f32x4*)(Lc + 188); s0 = fmaf(x52, l[0], s0); s1 = fmaf(x53, l[1], s1); s2 = fmaf(x54, l[2], s2); s3 = fmaf(x55, l[3], s3); } { const f32x4 l = *(const LAS f32x4*)(Lc + 192); s0 = fmaf(x56, l[0], s0); s1 = fmaf(x57, l[1], s1); s2 = fmaf(x58, l[2], s2); s3 = fmaf(x59, l[3], s3); } { const f32x4 l = *(const LAS f32x4*)(Lc + 196); s0 = fmaf(x60, l[0], s0); s1 = fmaf(x61, l[1], s1); s2 = fmaf(x62, l[2], s2); s3 = fmaf(x63, l[3], s3); } x2 = (lane == 2) ? 1.0f : -((s0 + s1) + (s2 + s3)); asm volatile("" : "+v"(x2) : : "memory"); }
    { float s0 = 0.f, s1 = 0.f, s2 = 0.f, s3 = 0.f; { const f32x4 l = *(const LAS f32x4*)(Lc + 68); s2 = fmaf(x2, l[2], s2); s3 = fmaf(x3, l[3], s3); } { const f32x4 l = *(const LAS f32x4*)(Lc + 72); s0 = fmaf(x4, l[0], s0); s1 = fmaf(x5, l[1], s1); s2 = fmaf(x6, l[2], s2); s3 = fmaf(x7, l[3], s3); } { const f32x4 l = *(const LAS f32x4*)(Lc + 76); s0 = fmaf(x8, l[0], s0); s1 = fmaf(x9, l[1], s1); s2 = fmaf(x10, l[2], s2); s3 = fmaf(x11, l[3], s3); } { const f32x4 l = *(const LAS f32x4*)(Lc + 80); s0 = fmaf(x12, l[0], s0); s1 = fmaf(x13, l[1], s1); s2 = fmaf(x14, l[2], s2); s3 = fmaf(x15, l[3], s3); } { const f32x4 l = *(const LAS f32x4*)(Lc + 84); s0 = fmaf(x16, l[0], s0); s1 = fmaf(x17, l[1], s1); s2 = fmaf(x18, l[2], s2); s3 = fmaf(x19, l[3], s3); } { const f32x4 l = *(const LAS f32x4*)(Lc + 88); s0 = fmaf(x20, l[0], s0); s1 = fmaf(x21, l[1], s1); s2 = fmaf(x22, l[2], s2); s3 = fmaf(x23, l[3], s3); } { const f32x4 l = *(const LAS f32x4*)(Lc + 92); s0 = fmaf(x24, l[0], s0); s1 = fmaf(x25, l[1], s1); s2 = fmaf(x26, l[2], s2); s3 = fmaf(x27, l[3], s3); } { const f32x4 l = *(const LAS f32x4*)(Lc + 96); s0 = fmaf(x28, l[0], s0); s1 = fmaf(x29, l[1], s1); s2 = fmaf(x30, l[2], s2); s3 = fmaf(x31, l[3], s3); } { const f32x4 l = *(const LAS f32x4*)(Lc + 100); s0 = fmaf(x32, l[0], s0); s1 = fmaf(x33, l[1], s1); s2 = fmaf(x34, l[2], s2); s3 = fmaf(x35, l[3], s3); } { const f32x4 l = *(const LAS f32x4*)(Lc + 104); s0 = fmaf(x36, l[0], s0); s1 = fmaf(x37, l[1], s1); s2 = fmaf(x38, l[2], s2); s3 = fmaf(x39, l[3], s3); } { const f32x4 l = *(const LAS f32x4*)(Lc + 108); s0 = fmaf(x40, l[0], s0); s1 = fmaf(x41, l[1], s1); s2 = fmaf(x42, l[2], s2); s3 = fmaf(x43, l[3], s3); } { const f32x4 l = *(const LAS f32x4*)(Lc + 112); s0 = fmaf(x44, l[0], s0); s1 = fmaf(x45, l[1], s1); s2 = fmaf(x46, l[2], s2); s3 = fmaf(x47, l[3], s3); } { const f32x4 l = *(const LAS f32x4*)(Lc + 116); s0 = fmaf(x48, l[0], s0); s1 = fmaf(x49, l[1], s1); s2 = fmaf(x50, l[2], s2); s3 = fmaf(x51, l[3], s3); } { const f32x4 l = *(const LAS f32x4*)(Lc + 120); s0 = fmaf(x52, l[0], s0); s1 = fmaf(x53, l[1], s1); s2 = fmaf(x54, l[2], s2); s3 = fmaf(x55, l[3], s3); } { const f32x4 l = *(const LAS f32x4*)(Lc + 124); s0 = fmaf(x56, l[0], s0); s1 = fmaf(x57, l[1], s1); s2 = fmaf(x58, l[2], s2); s3 = fmaf(x59, l[3], s3); } { const f32x4 l = *(const LAS f32x4*)(Lc + 128); s0 = fmaf(x60, l[0], s0); s1 = fmaf(x61, l[1], s1); s2 = fmaf(x62, l[2], s2); s3 = fmaf(x63, l[3], s3); } x1 = (lane == 1) ? 1.0f : -((s0 + s1) + (s2 + s3)); asm volatile("" : "+v"(x1) : : "memory"); }
    { float s0 = 0.f, s1 = 0.f, s2 = 0.f, s3 = 0.f; { const f32x4 l = *(const LAS f32x4*)(Lc + 0); s1 = fmaf(x1, l[1], s1); s2 = fmaf(x2, l[2], s2); s3 = fmaf(x3, l[3], s3); } { const f32x4 l = *(const LAS f32x4*)(Lc + 4); s0 = fmaf(x4, l[0], s0); s1 = fmaf(x5, l[1], s1); s2 = fmaf(x6, l[2], s2); s3 = fmaf(x7, l[3], s3); } { const f32x4 l = *(const LAS f32x4*)(Lc + 8); s0 = fmaf(x8, l[0], s0); s1 = fmaf(x9, l[1], s1); s2 = fmaf(x10, l[2], s2); s3 = fmaf(x11, l[3], s3); } { const f32x4 l = *(const LAS f32x4*)(Lc + 12); s0 = fmaf(x12, l[0], s0); s1 = fmaf(x13, l[1], s1); s2 = fmaf(x14, l[2], s2); s3 = fmaf(x15, l[3], s3); } { const f32x4 l = *(const LAS f32x4*)(Lc + 16); s0 = fmaf(x16, l[0], s0); s1 = fmaf(x17, l[1], s1); s2 = fmaf(x18, l[2], s2); s3 = fmaf(x19, l[3], s3); } { const f32x4 l = *(const LAS f32x4*)(Lc + 20); s0 = fmaf(x20, l[0], s0); s1 = fmaf(x21, l[1], s1); s2 = fmaf(x22, l[2], s2); s3 = fmaf(x23, l[3], s3); } { const f32x4 l = *(const LAS f32x4*)(Lc + 24); s0 = fmaf(x24, l[0], s0); s1 = fmaf(x25, l[1], s1); s2 = fmaf(x26, l[2], s2); s3 = fmaf(x27, l[3], s3); } { const f32x4 l = *(const LAS f32x4*)(Lc + 28); s0 = fmaf(x28, l[0], s0); s1 = fmaf(x29, l[1], s1); s2 = fmaf(x30, l[2], s2); s3 = fmaf(x31, l[3], s3); } { const f32x4 l = *(const LAS f32x4*)(Lc + 32); s0 = fmaf(x32, l[0], s0); s1 = fmaf(x33, l[1], s1); s2 = fmaf(x34, l[2], s2); s3 = fmaf(x35, l[3], s3); } { const f32x4 l = *(const LAS f32x4*)(Lc + 36); s0 = fmaf(x36, l[0], s0); s1 = fmaf(x37, l[1], s1); s2 = fmaf(x38, l[2], s2); s3 = fmaf(x39, l[3], s3); } { const f32x4 l = *(const LAS f32x4*)(Lc + 40); s0 = fmaf(x40, l[0], s0); s1 = fmaf(x41, l[1], s1); s2 = fmaf(x42, l[2], s2); s3 = fmaf(x43, l[3], s3); } { const f32x4 l = *(const LAS f32x4*)(Lc + 44); s0 = fmaf(x44, l[0], s0); s1 = fmaf(x45, l[1], s1); s2 = fmaf(x46, l[2], s2); s3 = fmaf(x47, l[3], s3); } { const f32x4 l = *(const LAS f32x4*)(Lc + 48); s0 = fmaf(x48, l[0], s0); s1 = fmaf(x49, l[1], s1); s2 = fmaf(x50, l[2], s2); s3 = fmaf(x51, l[3], s3); } { const f32x4 l = *(const LAS f32x4*)(Lc + 52); s0 = fmaf(x52, l[0], s0); s1 = fmaf(x53, l[1], s1); s2 = fmaf(x54, l[2], s2); s3 = fmaf(x55, l[3], s3); } { const f32x4 l = *(const LAS f32x4*)(Lc + 56); s0 = fmaf(x56, l[0], s0); s1 = fmaf(x57, l[1], s1); s2 = fmaf(x58, l[2], s2); s3 = fmaf(x59, l[3], s3); } { const f32x4 l = *(const LAS f32x4*)(Lc + 60); s0 = fmaf(x60, l[0], s0); s1 = fmaf(x61, l[1], s1); s2 = fmaf(x62, l[2], s2); s3 = fmaf(x63, l[3], s3); } x0 = (lane == 0) ? 1.0f : -((s0 + s1) + (s2 + s3)); asm volatile("" : "+v"(x0) : : "memory"); }
    { v4u o; o.x = cvtpk(x0, x1); o.y = cvtpk(x2, x3); o.z = cvtpk(x4, x5); o.w = cvtpk(x6, x7); *(LAS v4u*)(Xs + lane * 72 + 0) = o; }
    { v4u o; o.x = cvtpk(x8, x9); o.y = cvtpk(x10, x11); o.z = cvtpk(x12, x13); o.w = cvtpk(x14, x15); *(LAS v4u*)(Xs + lane * 72 + 8) = o; }
    { v4u o; o.x = cvtpk(x16, x17); o.y = cvtpk(x18, x19); o.z = cvtpk(x20, x21); o.w = cvtpk(x22, x23); *(LAS v4u*)(Xs + lane * 72 + 16) = o; }
    { v4u o; o.x = cvtpk(x24, x25); o.y = cvtpk(x26, x27); o.z = cvtpk(x28, x29); o.w = cvtpk(x30, x31); *(LAS v4u*)(Xs + lane * 72 + 24) = o; }
    { v4u o; o.x = cvtpk(x32, x33); o.y = cvtpk(x34, x35); o.z = cvtpk(x36, x37); o.w = cvtpk(x38, x39); *(LAS v4u*)(Xs + lane * 72 + 32) = o; }
    { v4u o; o.x = cvtpk(x40, x41); o.y = cvtpk(x42, x43); o.z = cvtpk(x44, x45); o.w = cvtpk(x46, x47); *(LAS v4u*)(Xs + lane * 72 + 40) = o; }
    { v4u o; o.x = cvtpk(x48, x49); o.y = cvtpk(x50, x51); o.z = cvtpk(x52, x53); o.w = cvtpk(x54, x55); *(LAS v4u*)(Xs + lane * 72 + 48) = o; }
    { v4u o; o.x = cvtpk(x56, x57); o.y = cvtpk(x58, x59); o.z = cvtpk(x60, x61); o.w = cvtpk(x62, x63); *(LAS v4u*)(Xs + lane * 72 + 56) = o; }
}
#ifndef G1P
#define G1P 15
#endif

#define MF16(a, b, c) __builtin_amdgcn_mfma_f32_16x16x32_bf16((a), (b), (c), 0, 0, 0)
__device__ __forceinline__ bf16x8 ld16g(const bf16* p) { return *(const GAS bf16x8*)p; }
__device__ __forceinline__ float ldbf(const bf16* p) { return __uint_as_float(((unsigned)*(const GAS unsigned short*)p) << 16); }
__device__ __forceinline__ void st8(bf16* p, float a, float b, float c, float d) { u32x2v o; o.x = cvtpk(a, b); o.y = cvtpk(c, d); *(GAS u32x2v*)p = o; }

__device__ __forceinline__ void p_ga(const Frame& F, const Args& a, int L) {
    GAS unsigned char* ws = (GAS unsigned char*)a.ws; asm volatile("" : "+s"(ws)); int lane_ = F.lane; asm volatile("" : "+v"(lane_)); const int j = L >> 1, lane = lane_;
    const bf16* PO = (const bf16*)(ws + WS_ARENA + AR_PO);
    bf16 *QN = (bf16*)(ws + WS_ARENA + AR_QN), *KN = (bf16*)(ws + WS_ARENA + AR_KN), *KGT = (bf16*)(ws + WS_ARENA + AR_KGT), *VBT = (bf16*)(ws + WS_ARENA + AR_VBT), *KTT = (bf16*)(ws + WS_ARENA + AR_KTT);
    const float* gg = (const float*)(ws + WS_GB); const float* gbeta = gg + S_ * 8; float* dn = (float*)(ws + WS_TOK + TOK_DN); float* gcs = (float*)(ws + WS_GC);
    const float* cw = (const float*)a.in[16] + (size_t)j * 4 * 3072;
    LAS bf16* tile = (LAS bf16*)(F.lds + F.wave * WAVE_LDS);
    const int dg = lane & 15, ts = lane >> 4, d0 = 8 * dg;
#pragma unroll 1
    for (int tp_ = 2 * F.vcu + (F.wave >> 2); tp_ < 512; tp_ += 2 * F.G) {
        const int u = (4 * (tp_ >> 3) + (F.wave & 3)) * 8 + (tp_ & 7);
        const int n = u >> 3, hh = u & 7, tok0 = 64 * n;
        float sA, sB, sBeta;
        {
            const float gv = *(const GAS float*)(gg + (size_t)(tok0 + lane) * 8 + hh), beta = *(const GAS float*)(gbeta + (size_t)(tok0 + lane) * 8 + hh);
            float gc = gv;
#pragma unroll
            for (int o = 1; o < 64; o <<= 1) { const float t = __shfl_up(gc, o); if (lane >= o) gc += t; }
            const float glast = __shfl(gc, 63);
            *(GAS float*)(gcs + (size_t)(tok0 + lane) * 8 + hh) = gc;
            if (lane == 0) dn[u] = expf(glast);
            sA = beta * expf(gc); sB = expf(glast - gc); sBeta = beta;
        }
#pragma unroll 1
        for (int qkv = 0; qkv < 3; ++qkv) {
            const int coff = qkv * 1024 + hh * 128 + d0;
            float w[4][8];
#pragma unroll
            for (int jj = 0; jj < 4; ++jj)
#pragma unroll
                for (int e = 0; e < 8; ++e) w[jj][e] = *(const GAS float*)(cw + jj * 3072 + coff + e);
            asm volatile("s_waitcnt lgkmcnt(0)" ::: "memory");
#pragma unroll 4
            for (int it = 0; it < 16; ++it) {
                const int i = 4 * it + ts, tok = tok0 + i; float acc[8];
                v4u rv[4];
#pragma unroll
                for (int jj = 0; jj < 4; ++jj) { const int r = tok - 3 + jj; rv[jj] = *(const GAS v4u*)(PO + (size_t)(r < 0 ? 0 : r) * OIN + coff); }
#pragma unroll
                for (int e = 0; e < 8; ++e) acc[e] = 0.f;
#pragma unroll
                for (int jj = 0; jj < 4; ++jj) { const float on = (tok - 3 + jj >= 0) ? 1.0f : 0.0f; const unsigned vv[4] = {rv[jj].x, rv[jj].y, rv[jj].z, rv[jj].w};
#pragma unroll
                    for (int q = 0; q < 4; ++q) { acc[2 * q] += (w[jj][2 * q] * on) * bflo(vv[q]); acc[2 * q + 1] += (w[jj][2 * q + 1] * on) * bfhi(vv[q]); } }
                float ss = 0.f;
#pragma unroll
                for (int e = 0; e < 8; ++e) { acc[e] = silu(acc[e]); ss += acc[e] * acc[e]; }
                ss += __shfl_xor(ss, 1); ss += __shfl_xor(ss, 2); ss += __shfl_xor(ss, 4); ss += __shfl_xor(ss, 8);
                const float rn = __builtin_amdgcn_rsqf(ss + 1e-6f);
                const float s1 = (qkv == 0) ? rn * 0.08838834764831845f : (qkv == 1 ? rn : 1.0f);
                v4u o; o.x = cvtpk(acc[0] * s1, acc[1] * s1); o.y = cvtpk(acc[2] * s1, acc[3] * s1); o.z = cvtpk(acc[4] * s1, acc[5] * s1); o.w = cvtpk(acc[6] * s1, acc[7] * s1);
                if (qkv < 2) *(GAS v4u*)((qkv == 0 ? QN : KN) + (size_t)tok * D_ + hh * 128 + d0) = o;
                if (qkv > 0) *(LAS v4u*)(tile + i * 136 + d0) = o;
            }
            if (qkv == 0) continue;
            asm volatile("s_waitcnt lgkmcnt(0)" ::: "memory");
#pragma unroll 1
            for (int half = 0; half < 2; ++half) {
                const int d = 64 * half + lane; const size_t obase = ((size_t)u * 128 + d) * 64;
                const LAS unsigned short* tp = (const LAS unsigned short*)tile + d;
#pragma unroll
                for (int ig = 0; ig < 8; ++ig) {
                    float o1[8], o2[8];
#pragma unroll
                    for (int e = 0; e < 8; ++e) { const int t = 8 * ig + e; const float v = __uint_as_float(((unsigned)tp[t * 136]) << 16);
                        const float m1 = __builtin_bit_cast(float, __builtin_amdgcn_readlane(__builtin_bit_cast(int, (qkv == 1) ? sA : sBeta), t));
                        const float m2 = __builtin_bit_cast(float, __builtin_amdgcn_readlane(__builtin_bit_cast(int, sB), t));
                        o1[e] = v * m1; o2[e] = v * m2; }
                    v4u o; o.x = cvtpk(o1[0], o1[1]); o.y = cvtpk(o1[2], o1[3]); o.z = cvtpk(o1[4], o1[5]); o.w = cvtpk(o1[6], o1[7]);
                    *(GAS v4u*)((qkv == 1 ? KGT : VBT) + obase + 8 * ig) = o;
                    if (qkv == 1) { o.x = cvtpk(o2[0], o2[1]); o.y = cvtpk(o2[2], o2[3]); o.z = cvtpk(o2[4], o2[5]); o.w = cvtpk(o2[6], o2[7]); *(GAS v4u*)(KTT + obase + 8 * ig) = o; }
                }
            }
        }
    }
}

__device__ __forceinline__ void p_g1(const Frame& F, const Args& a) {
    GAS unsigned char* ws = (GAS unsigned char*)a.ws; asm volatile("" : "+s"(ws)); int lane_ = F.lane; asm volatile("" : "+v"(lane_)); const int lane = lane_, r16 = lane & 15, g = lane >> 4;
    const bf16 *QN = (const bf16*)(ws + WS_ARENA + AR_QN), *KN = (const bf16*)(ws + WS_ARENA + AR_KN), *KGT = (const bf16*)(ws + WS_ARENA + AR_KGT), *VBT = (const bf16*)(ws + WS_ARENA + AR_VBT), *KTT = (const bf16*)(ws + WS_ARENA + AR_KTT);
    bf16 *AI = (bf16*)(ws + WS_ARENA + AR_AI), *NEGW = (bf16*)(ws + WS_ARENA + AR_NEGW), *UT = (bf16*)(ws + WS_ARENA + AR_UT);
    const float* gg = (const float*)(ws + WS_GC); const float* gbeta = (const float*)(ws + WS_GB) + S_ * 8;
    LAS float* Lc = (LAS float*)(F.lds + F.wave * WAVE_LDS);
    LAS bf16* Xs = (LAS bf16*)(F.lds + F.wave * WAVE_LDS);
    const f32x4 Z4 = {0.f, 0.f, 0.f, 0.f};
#ifdef PROBE_G1P
    const int g1p = a.use_bar ? 15 : PROBE_G1P;
#else
    const int g1p = 15;
#endif
#pragma unroll 1
    for (int tp_ = 2 * F.vcu + (F.wave >> 2); tp_ < 512; tp_ += 2 * F.G) {
        const int u = (4 * (tp_ >> 3) + (F.wave & 3)) * 8 + (tp_ & 7);
        const int n = u >> 3, hh = u & 7, tok0 = 64 * n; const int uh = hh * NCHUNK + n;
        const float gc = gg[(size_t)(tok0 + lane) * 8 + hh], beta = gbeta[(size_t)(tok0 + lane) * 8 + hh];
        if (g1p & 1) {
        {
            bf16x8 kf[4][4];
#pragma unroll
            for (int t = 0; t < 4; ++t)
#pragma unroll
                for (int kk = 0; kk < 4; ++kk) kf[t][kk] = ld16g(KN + (size_t)(tok0 + 16 * t + r16) * D_ + hh * 128 + 32 * kk + 8 * g);
#pragma unroll
            for (int ti = 0; ti < 4; ++ti)
#pragma unroll
                for (int tj = 0; tj <= ti; ++tj) {
                    f32x4 Dv = Z4;
#pragma unroll
                    for (int kk = 0; kk < 4; ++kk) Dv = MF16(kf[ti][kk], kf[tj][kk], Dv);
                    const int jx = 16 * tj + r16; const float gcj = __shfl(gc, jx); f32x4 val;
#pragma unroll
                    for (int r = 0; r < 4; ++r) { const int ix = 16 * ti + 4 * g + r; const float gci = __shfl(gc, ix), bi = __shfl(beta, ix); val[r] = (ix > jx) ? bi * Dv[r] * expf(gci - gcj) : 0.f; }
                    *(LAS f32x4*)(Lc + jx * 68 + 16 * ti + 4 * g) = val;
                }
#pragma unroll
            for (int ti = 0; ti < 4; ++ti) {
                bf16x8 qf[4];
#pragma unroll
                for (int kk = 0; kk < 4; ++kk) qf[kk] = ld16g(QN + (size_t)(tok0 + 16 * ti + r16) * D_ + hh * 128 + 32 * kk + 8 * g);
                const int ix = 16 * ti + r16; const float gci = __shfl(gc, ix);
#pragma unroll
                for (int tj = 0; tj < 4; ++tj) {
                    f32x4 val = Z4;
                    if (tj <= ti) {
                        f32x4 Dv = Z4;
#pragma unroll
                        for (int kk = 0; kk < 4; ++kk) Dv = MF16(kf[tj][kk], qf[kk], Dv);
#pragma unroll
                        for (int r = 0; r < 4; ++r) { const int jx = 16 * tj + 4 * g + r; const float gcj = __shfl(gc, jx); val[r] = (ix >= jx) ? Dv[r] * expf(gci - gcj) : 0.f; }
                    }
                    st8(AI + ((size_t)u * 64 + ix) * 64 + 16 * tj + 4 * g, val[0], val[1], val[2], val[3]);
                }
            }
        }
        asm volatile("s_waitcnt lgkmcnt(0)" ::: "memory");
        }
        if (g1p & 2) {
        tri_solve(Lc, Xs, lane);
        }
        if (g1p & 4) {
        asm volatile("s_waitcnt lgkmcnt(0)" ::: "memory");
        {
            bf16x8 xf[4][2];
#pragma unroll
            for (int t = 0; t < 4; ++t)
#pragma unroll
                for (int kk = 0; kk < 2; ++kk) xf[t][kk] = *(const LAS bf16x8*)(Xs + (16 * t + r16) * 72 + 32 * kk + 8 * g);
#pragma unroll 2
            for (int td = 0; td < 8; ++td) {
                const size_t rb = ((size_t)u * 128 + 16 * td + r16) * 64;
                const bf16x8 vb0 = ld16g(VBT + rb + 8 * g), vb1 = ld16g(VBT + rb + 32 + 8 * g), kg0 = ld16g(KGT + rb + 8 * g), kg1 = ld16g(KGT + rb + 32 + 8 * g);
#pragma unroll
                for (int ti = 0; ti < 4; ++ti) {
                    f32x4 Du = MF16(xf[ti][0], vb0, Z4); Du = MF16(xf[ti][1], vb1, Du);
                    st8(UT + rb + 16 * ti + 4 * g, Du[0], Du[1], Du[2], Du[3]);
                    f32x4 Dn = MF16(kg0, xf[ti][0], Z4); Dn = MF16(kg1, xf[ti][1], Dn);
                    st8(NEGW + (size_t)(tok0 + 16 * ti + r16) * D_ + hh * 128 + 16 * td + 4 * g, -Dn[0], -Dn[1], -Dn[2], -Dn[3]);
                }
            }
        }
        }
    }
}

template <int NS, int SGSTEP> __device__ __forceinline__ void p_g2(const Frame& F, const Args& a, const bf16* MPsrc, const bf16* NTsrc, const float* dnsrc) {
    GAS unsigned char* ws = (GAS unsigned char*)a.ws; asm volatile("" : "+s"(ws)); int lane_ = F.lane; asm volatile("" : "+v"(lane_)); const int lane = lane_, r16 = lane & 15, g = lane >> 4, w = F.wave;
    const bf16 *MP = MPsrc, *NT = NTsrc; bf16* SG = (bf16*)(ws + WS_ARENA + AR_SG);
    const float* dn = dnsrc;
    LAS bf16* St = (LAS bf16*)F.lds;
    const int args_use_bar = a.use_bar; (void)args_use_bar;
#pragma unroll 1
    for (int asg = F.vcu; asg < 64; asg += F.G) {
        const int hh = asg >> 3, sl = asg & 7;
        __syncthreads();
        for (int idx = F.tid; idx < 2 * 16 * 136 / 2; idx += NWAVES * 64) ((LAS unsigned*)St)[idx] = 0u;
        __syncthreads();
        if (w >= 4) {
            const int st = F.tid - 256, row = st >> 4, chunk = st & 15;
#pragma unroll 1
            for (int n = 0; n < NS; ++n) {
                const v4u v = *(const LAS v4u*)(St + (n & 1) * (16 * 136) + row * 136 + chunk * 8);
                *(GAS v4u*)(SG + ((size_t)(hh * NCHUNK + n * SGSTEP) * 128 + 16 * sl + row) * 128 + chunk * 8) = v;
                asm volatile("s_waitcnt lgkmcnt(0)" ::: "memory"); __builtin_amdgcn_s_barrier(); asm volatile("" ::: "memory");
            }
        } else {
            f32x4 Sv[2] = {{0.f, 0.f, 0.f, 0.f}, {0.f, 0.f, 0.f, 0.f}};
            bf16x8 A0[2][4], A1[2][4], A2[2][4], A3[2][4]; u32x2v C0[2], C1[2], C2[2], C3[2]; float d0, d1, d2, d3;
#define G2_LOAD(AX, CX, DX, nn) do { const int u_ = hh * NS + (nn); \
            _Pragma("unroll") for (int t = 0; t < 2; ++t) { \
                _Pragma("unroll") for (int kk = 0; kk < 4; ++kk) AX[t][kk] = ld16g(MP + ((size_t)u_ * 128 + 32 * w + 16 * t + r16) * 128 + 32 * kk + 8 * g); \
                CX[t] = *(const GAS u32x2v*)(NT + ((size_t)u_ * 128 + 16 * sl + r16) * 128 + 32 * w + 16 * t + 4 * g); } \
            DX = *(const GAS float*)(dn + (nn) * 8 + hh); } while (0)
#ifdef PROBE_G2_NOLOAD
#define G2_STEPLOAD(AL, CL, DL, nn) do { if (args_use_bar) G2_LOAD(AL, CL, DL, nn); } while (0)
#else
#define G2_STEPLOAD(AL, CL, DL, nn) G2_LOAD(AL, CL, DL, nn)
#endif
#define G2_STEP(AU, CU, DU, AL, CL, DL, nn) do { const int n_ = (nn); const int n2_ = (n_ + 3 < NS) ? n_ + 3 : NS - 1; \
            G2_STEPLOAD(AL, CL, DL, n2_); \
            LAS bf16* Sc = St + (n_ & 1) * (16 * 136); LAS bf16* Sn = St + ((n_ & 1) ^ 1) * (16 * 136); \
            f32x4 D0 = {bflo(CU[0].x), bfhi(CU[0].x), bflo(CU[0].y), bfhi(CU[0].y)}, D1 = {bflo(CU[1].x), bfhi(CU[1].x), bflo(CU[1].y), bfhi(CU[1].y)}; \
            _Pragma("unroll") for (int kk = 0; kk < 4; ++kk) { const bf16x8 Bf = *(const LAS bf16x8*)(Sc + r16 * 136 + 32 * kk + 8 * g); D0 = MF16(AU[0][kk], Bf, D0); D1 = MF16(AU[1][kk], Bf, D1); } \
            Sv[0] = Sv[0] * DU + D0; Sv[1] = Sv[1] * DU + D1; \
            { u32x2v o; o.x = cvtpk(Sv[0][0], Sv[0][1]); o.y = cvtpk(Sv[0][2], Sv[0][3]); *(LAS u32x2v*)(Sn + r16 * 136 + 32 * w + 4 * g) = o; \
              o.x = cvtpk(Sv[1][0], Sv[1][1]); o.y = cvtpk(Sv[1][2], Sv[1][3]); *(LAS u32x2v*)(Sn + r16 * 136 + 32 * w + 16 + 4 * g) = o; } \
            asm volatile("s_waitcnt lgkmcnt(0)" ::: "memory"); __builtin_amdgcn_s_barrier(); asm volatile("" ::: "memory"); } while (0)
            G2_LOAD(A0, C0, d0, 0); G2_LOAD(A1, C1, d1, 1); G2_LOAD(A2, C2, d2, 2);
            static_assert(NS % 24 == 16, "scan loop: trips of 24 steps + a 16-step tail");
            int n = 0;
#pragma unroll 1
            for (; n + 24 <= NS - 16; n += 24) {
                G2_STEP(A0, C0, d0, A3, C3, d3, n + 0);
                G2_STEP(A1, C1, d1, A0, C0, d0, n + 1);
                G2_STEP(A2, C2, d2, A1, C1, d1, n + 2);
                G2_STEP(A3, C3, d3, A2, C2, d2, n + 3);
                G2_STEP(A0, C0, d0, A3, C3, d3, n + 4);
                G2_STEP(A1, C1, d1, A0, C0, d0, n + 5);
                G2_STEP(A2, C2, d2, A1, C1, d1, n + 6);
                G2_STEP(A3, C3, d3, A2, C2, d2, n + 7);
                G2_STEP(A0, C0, d0, A3, C3, d3, n + 8);
                G2_STEP(A1, C1, d1, A0, C0, d0, n + 9);
                G2_STEP(A2, C2, d2, A1, C1, d1, n + 10);
                G2_STEP(A3, C3, d3, A2, C2, d2, n + 11);
                G2_STEP(A0, C0, d0, A3, C3, d3, n + 12);
                G2_STEP(A1, C1, d1, A0, C0, d0, n + 13);
                G2_STEP(A2, C2, d2, A1, C1, d1, n + 14);
                G2_STEP(A3, C3, d3, A2, C2, d2, n + 15);
                G2_STEP(A0, C0, d0, A3, C3, d3, n + 16);
                G2_STEP(A1, C1, d1, A0, C0, d0, n + 17);
                G2_STEP(A2, C2, d2, A1, C1, d1, n + 18);
                G2_STEP(A3, C3, d3, A2, C2, d2, n + 19);
                G2_STEP(A0, C0, d0, A3, C3, d3, n + 20);
                G2_STEP(A1, C1, d1, A0, C0, d0, n + 21);
                G2_STEP(A2, C2, d2, A1, C1, d1, n + 22);
                G2_STEP(A3, C3, d3, A2, C2, d2, n + 23);
            }
            G2_STEP(A0, C0, d0, A3, C3, d3, n + 0);
            G2_STEP(A1, C1, d1, A0, C0, d0, n + 1);
            G2_STEP(A2, C2, d2, A1, C1, d1, n + 2);
            G2_STEP(A3, C3, d3, A2, C2, d2, n + 3);
            G2_STEP(A0, C0, d0, A3, C3, d3, n + 4);
            G2_STEP(A1, C1, d1, A0, C0, d0, n + 5);
            G2_STEP(A2, C2, d2, A1, C1, d1, n + 6);
            G2_STEP(A3, C3, d3, A2, C2, d2, n + 7);
            G2_STEP(A0, C0, d0, A3, C3, d3, n + 8);
            G2_STEP(A1, C1, d1, A0, C0, d0, n + 9);
            G2_STEP(A2, C2, d2, A1, C1, d1, n + 10);
            G2_STEP(A3, C3, d3, A2, C2, d2, n + 11);
            G2_STEP(A0, C0, d0, A3, C3, d3, n + 12);
            G2_STEP(A1, C1, d1, A0, C0, d0, n + 13);
            G2_STEP(A2, C2, d2, A1, C1, d1, n + 14);
            G2_STEP(A3, C3, d3, A2, C2, d2, n + 15);
#undef G2_STEP
#undef G2_LOAD
        }
    }
}


constexpr int GST_W = 64 * 136, GST_K = 128 * 68, GST_PAIR = GST_W + GST_K, GST_BYTES = 2 * GST_PAIR * 2, GW_BYTES = 8704;
static_assert(GST_BYTES + 8 * GW_BYTES <= LDSCTL_OFF, "group-phase LDS map");
__device__ __forceinline__ void g_stage(const Frame& F, const bf16* NEGW, const bf16* KTT, int p, int n, int hh, bool on) {
    LAS bf16* sw = (LAS bf16*)F.lds + p * GST_PAIR; LAS bf16* sk = sw + GST_W;
#pragma unroll
    for (int q = 0; q < 2; ++q) { const int idx = F.tid + 512 * q;
        { const int row = idx >> 4, ch = idx & 15; v4u v = {0u, 0u, 0u, 0u}; if (on) v = *(const GAS v4u*)(NEGW + (size_t)(64 * n + row) * D_ + hh * 128 + ch * 8); *(LAS v4u*)(sw + row * 136 + ch * 8) = v; }
        { const int row = idx >> 3, ch = idx & 7; u32x2v a = {0u, 0u}, b = a; if (on) { const v4u v = *(const GAS v4u*)(KTT + ((size_t)(n * 8 + hh) * 128 + row) * 64 + ch * 8); a.x = v.x; a.y = v.y; b.x = v.z; b.y = v.w; }
          *(LAS u32x2v*)(sk + row * 68 + ch * 8) = a; *(LAS u32x2v*)(sk + row * 68 + ch * 8 + 4) = b; } }
}
template <bool PERM> __device__ __forceinline__ void g_prod1(f32x4 (&T)[4][2], const LAS bf16* sw, const bf16x8 (&xo)[4][2], int r16, int g) {
#pragma unroll
    for (int mt = 0; mt < 4; ++mt) {
        bf16x8 af[4];
#pragma unroll
        for (int s = 0; s < 4; ++s) {
            if (PERM) { const LAS bf16* rp = sw + (16 * mt + r16) * 136 + 32 * s + 4 * g; const u32x2v lo = *(const LAS u32x2v*)rp, hi = *(const LAS u32x2v*)(rp + 16); const v4u pk = {lo.x, lo.y, hi.x, hi.y}; af[s] = __builtin_bit_cast(bf16x8, pk); }
            else af[s] = *(const LAS bf16x8*)(sw + (16 * mt + r16) * 136 + 32 * s + 8 * g); }
#pragma unroll
        for (int nt = 0; nt < 2; ++nt)
#pragma unroll
            for (int s = 0; s < 4; ++s) T[mt][nt] = MF16(af[s], xo[s][nt], T[mt][nt]);
        asm volatile("" ::: "memory");
    }
}
__device__ __forceinline__ void g_prod2(f32x4 (&X)[8][2], const LAS bf16* sk, const f32x4 (&T)[4][2], int r16, int g) {
    bf16x8 to[2][2];
#pragma unroll
    for (int s = 0; s < 2; ++s)
#pragma unroll
        for (int nt = 0; nt < 2; ++nt) { v4u p; p.x = cvtpk(T[2 * s][nt][0], T[2 * s][nt][1]); p.y = cvtpk(T[2 * s][nt][2], T[2 * s][nt][3]); p.z = cvtpk(T[2 * s + 1][nt][0], T[2 * s + 1][nt][1]); p.w = cvtpk(T[2 * s + 1][nt][2], T[2 * s + 1][nt][3]);
            to[s][nt] = __builtin_bit_cast(bf16x8, p); }
#pragma unroll
    for (int mt = 0; mt < 8; ++mt) {
        bf16x8 af[2];
#pragma unroll
        for (int s = 0; s < 2; ++s) { const LAS bf16* rp = sk + (16 * mt + r16) * 68 + 32 * s + 4 * g; const u32x2v lo = *(const LAS u32x2v*)rp, hi = *(const LAS u32x2v*)(rp + 16); const v4u pk = {lo.x, lo.y, hi.x, hi.y}; af[s] = __builtin_bit_cast(bf16x8, pk); }
#pragma unroll
        for (int nt = 0; nt < 2; ++nt)
#pragma unroll
            for (int s = 0; s < 2; ++s) X[mt][nt] = MF16(af[s], to[s][nt], X[mt][nt]);
        asm volatile("" ::: "memory");
    }
}
__device__ __forceinline__ void p_g1b(const Frame& F, const Args& a) {
    GAS unsigned char* ws = (GAS unsigned char*)a.ws; asm volatile("" : "+s"(ws)); int lane_ = F.lane; asm volatile("" : "+v"(lane_)); const int lane = lane_, r16 = lane & 15, g = lane >> 4;
    const bf16 *NEGW = (const bf16*)(ws + WS_ARENA + AR_NEGW), *KTT = (const bf16*)(ws + WS_ARENA + AR_KTT), *UT = (const bf16*)(ws + WS_ARENA + AR_UT); const float* dn = (const float*)(ws + WS_TOK + TOK_DN);
    bf16 *MPc = (bf16*)(ws + WS_ARENA + AR_MPC), *NTc = (bf16*)(ws + WS_ARENA + AR_NTC); float* dnc = (float*)(ws + WS_TOK + TOK_DNC);
    const bool isB = F.wave >= 4; const int sl = F.wave & 3, c0 = 32 * sl;
    const LAS bf16* sw = (const LAS bf16*)F.lds; const LAS bf16* sk = sw + GST_W; LAS bf16* wa = (LAS bf16*)(F.lds + GST_BYTES + F.wave * GW_BYTES);
#pragma unroll 1
    for (int tp = 2 * F.vcu; tp < 512; tp += (tp & 1) ? 2 * F.G - 1 : 1) {
        const int hh = tp & 7, gq = tp >> 3;
        f32x4 X[8][2]; float Dd = 1.0f;
#pragma unroll
        for (int mt = 0; mt < 8; ++mt)
#pragma unroll
            for (int nt = 0; nt < 2; ++nt) X[mt][nt] = (f32x4){0.f, 0.f, 0.f, 0.f};
#pragma unroll 1
        for (int i = 0; i < 4; ++i) {
            const int n = 4 * gq + i; const float di = *(const GAS float*)(dn + n * 8 + hh);
            bf16x8 xo[4][2]; const float dadd = isB ? 0.0f : Dd;
#pragma unroll
            for (int s = 0; s < 4; ++s)
#pragma unroll
                for (int nt = 0; nt < 2; ++nt) { v4u pr; const int col = c0 + 16 * nt + r16; f32x4 t0 = X[2 * s][nt], t1 = X[2 * s + 1][nt];
#pragma unroll
                    for (int r = 0; r < 4; ++r) { if (32 * s + 4 * g + r == col) t0[r] += dadd; if (32 * s + 16 + 4 * g + r == col) t1[r] += dadd; }
                    pr.x = cvtpk(t0[0], t0[1]); pr.y = cvtpk(t0[2], t0[3]); pr.z = cvtpk(t1[0], t1[1]); pr.w = cvtpk(t1[2], t1[3]); xo[s][nt] = __builtin_bit_cast(bf16x8, pr); }
            __syncthreads();
            g_stage(F, NEGW, KTT, 0, n, hh, true);
            f32x4 T[4][2];
#pragma unroll
            for (int mt = 0; mt < 4; ++mt)
#pragma unroll
                for (int nt = 0; nt < 2; ++nt) { T[mt][nt] = (f32x4){0.f, 0.f, 0.f, 0.f};
                    if (isB) { const u32x2v uu = *(const GAS u32x2v*)(UT + ((size_t)(n * 8 + hh) * 128 + c0 + 16 * nt + r16) * 64 + 16 * mt + 4 * g); T[mt][nt] = (f32x4){bflo(uu.x), bfhi(uu.x), bflo(uu.y), bfhi(uu.y)}; } }
            __syncthreads();
            g_prod1<true>(T, sw, xo, r16, g);
#pragma unroll
            for (int mt = 0; mt < 8; ++mt)
#pragma unroll
                for (int nt = 0; nt < 2; ++nt) X[mt][nt] = X[mt][nt] * di;
            g_prod2(X, sk, T, r16, g);
            Dd *= di;
        }
        const int uc = hh * 64 + gq;
        if (isB) {
#pragma unroll
            for (int mt = 0; mt < 8; ++mt)
#pragma unroll
                for (int nt = 0; nt < 2; ++nt) st8(NTc + ((size_t)uc * 128 + c0 + 16 * nt + r16) * 128 + 16 * mt + 4 * g, X[mt][nt][0], X[mt][nt][1], X[mt][nt][2], X[mt][nt][3]);
        } else {
            if (sl == 0 && lane == 0) dnc[gq * 8 + hh] = Dd;
#pragma unroll
            for (int hf = 0; hf < 2; ++hf) {
                asm volatile("s_waitcnt lgkmcnt(0)" ::: "memory");
#pragma unroll
                for (int m4 = 0; m4 < 4; ++m4)
#pragma unroll
                    for (int nt = 0; nt < 2; ++nt)
#pragma unroll
                        for (int r = 0; r < 4; ++r) wa[(16 * m4 + 4 * g + r) * 40 + 16 * nt + r16] = (unsigned short)(cvtpk(X[4 * hf + m4][nt][r], 0.f) & 0xffffu);
                asm volatile("s_waitcnt lgkmcnt(0)" ::: "memory");
#pragma unroll
                for (int q = 0; q < 4; ++q) { const int row = 16 * q + (lane >> 2), ch = lane & 3; const v4u v = *(const LAS v4u*)(wa + row * 40 + ch * 8);
                    *(GAS v4u*)(MPc + ((size_t)uc * 128 + 64 * hf + row) * 128 + c0 + ch * 8) = v; }
            }
        }
    }
    __syncthreads();
}

__device__ __forceinline__ void p_g23(const Frame& F, const Args& a, int L) {
    GAS unsigned char* ws = (GAS unsigned char*)a.ws; asm volatile("" : "+s"(ws)); int lane_ = F.lane; asm volatile("" : "+v"(lane_)); const int lane = lane_, r16 = lane & 15, g = lane >> 4;
    const bf16 *NEGW = (const bf16*)(ws + WS_ARENA + AR_NEGW), *KTT = (const bf16*)(ws + WS_ARENA + AR_KTT), *UT = (const bf16*)(ws + WS_ARENA + AR_UT), *SG = (const bf16*)(ws + WS_ARENA + AR_SG),
               *QN = (const bf16*)(ws + WS_ARENA + AR_QN), *AI = (const bf16*)(ws + WS_ARENA + AR_AI), *PO = (const bf16*)(ws + WS_ARENA + AR_PO);
    const float* gcs = (const float*)(ws + WS_GC);
    const float* dn = (const float*)(ws + WS_TOK + TOK_DN); bf16* mix = (bf16*)(ws + WS_MIX); const float* onorm = (const float*)a.in[19] + (L >> 1) * 128;
    const int pw = F.wave >> 2, qf = F.wave & 3, c0 = 32 * qf;
    const LAS bf16* sw = (const LAS bf16*)F.lds + pw * GST_PAIR; const LAS bf16* sk = sw + GST_W; LAS bf16* Sl = (LAS bf16*)(F.lds + GST_BYTES + F.wave * GW_BYTES);
    LAS float* xch = (LAS float*)(F.lds + RT_OFF);
#pragma unroll 1
    for (int tp0 = 2 * F.vcu; tp0 < 512; tp0 += 2 * F.G) {
        const int tp = tp0 + pw; const bool on = tp < 512; const int tpc = on ? tp : 0, hh = tpc & 7, gq = tpc >> 3;
        const int tpa = tp0, tpb = (tp0 + 1 < 512) ? tp0 + 1 : 0;
        { const int u0 = hh * NCHUNK + 4 * gq;
#pragma unroll
          for (int q = 0; q < 8; ++q) { const int row = 4 * q + (lane >> 4), ch = lane & 15; const v4u v = *(const GAS v4u*)(SG + ((size_t)u0 * 128 + c0 + row) * 128 + ch * 8); *(LAS v4u*)(Sl + row * 136 + ch * 8) = v; } }
#pragma unroll 1
        for (int i = 0; i < 4; ++i) {
            __syncthreads();
            g_stage(F, NEGW, KTT, 0, 4 * (tpa >> 3) + i, tpa & 7, tpa < 512); g_stage(F, NEGW, KTT, 1, 4 * (tpb >> 3) + i, tpb & 7, tp0 + 1 < 512);
            const int n = 4 * gq + i, u = n * 8 + hh, tok0 = 64 * n; const float di = *(const GAS float*)(dn + n * 8 + hh);
            f32x4 T[4][2];
#pragma unroll
            for (int mt = 0; mt < 4; ++mt)
#pragma unroll
                for (int nt = 0; nt < 2; ++nt) { const u32x2v uu = *(const GAS u32x2v*)(UT + ((size_t)u * 128 + c0 + 16 * nt + r16) * 64 + 16 * mt + 4 * g); T[mt][nt] = (f32x4){bflo(uu.x), bfhi(uu.x), bflo(uu.y), bfhi(uu.y)}; }
            asm volatile("s_waitcnt lgkmcnt(0)" ::: "memory");
            bf16x8 Bf[4][2];
#pragma unroll
            for (int nt = 0; nt < 2; ++nt)
#pragma unroll
                for (int s = 0; s < 4; ++s) Bf[s][nt] = *(const LAS bf16x8*)(Sl + (16 * nt + r16) * 136 + 32 * s + 8 * g);
            __syncthreads();
            g_prod1<false>(T, sw, Bf, r16, g);
            bf16x8 vo[2][2];
#pragma unroll
            for (int s = 0; s < 2; ++s)
#pragma unroll
                for (int nt = 0; nt < 2; ++nt) { v4u p; p.x = cvtpk(T[2 * s][nt][0], T[2 * s][nt][1]); p.y = cvtpk(T[2 * s][nt][2], T[2 * s][nt][3]); p.z = cvtpk(T[2 * s + 1][nt][0], T[2 * s + 1][nt][1]); p.w = cvtpk(T[2 * s + 1][nt][2], T[2 * s + 1][nt][3]);
                    vo[s][nt] = __builtin_bit_cast(bf16x8, p); }
            f32x4 o[2][4];
#pragma unroll
            for (int it = 0; it < 4; ++it) {
                const int tok = tok0 + 16 * it + r16; bf16x8 qfr[4], afr[2];
                { const float eg = expf(*(const GAS float*)(gcs + (size_t)tok * 8 + hh));
#pragma unroll
                  for (int s = 0; s < 4; ++s) { const v4u qv = *(const GAS v4u*)(QN + (size_t)tok * D_ + hh * 128 + 32 * s + 8 * g); v4u qs;
                      qs.x = cvtpk(bflo(qv.x) * eg, bfhi(qv.x) * eg); qs.y = cvtpk(bflo(qv.y) * eg, bfhi(qv.y) * eg); qs.z = cvtpk(bflo(qv.z) * eg, bfhi(qv.z) * eg); qs.w = cvtpk(bflo(qv.w) * eg, bfhi(qv.w) * eg);
                      qfr[s] = __builtin_bit_cast(bf16x8, qs); } }
#pragma unroll
                for (int s = 0; s < 2; ++s) { const bf16* ap = AI + ((size_t)u * 64 + 16 * it + r16) * 64 + 32 * s + 4 * g; const u32x2v lo = *(const GAS u32x2v*)ap, hi = *(const GAS u32x2v*)(ap + 16);
                    const v4u pk = {lo.x, lo.y, hi.x, hi.y}; afr[s] = __builtin_bit_cast(bf16x8, pk); }
#pragma unroll
                for (int nt = 0; nt < 2; ++nt) { f32x4 Dv = {0.f, 0.f, 0.f, 0.f};
#pragma unroll
                    for (int s = 0; s < 4; ++s) Dv = MF16(Bf[s][nt], qfr[s], Dv);
#pragma unroll
                    for (int s = 0; s < 2; ++s) Dv = MF16(vo[s][nt], afr[s], Dv);
                    o[nt][it] = Dv; }
            }
            __syncthreads();
#pragma unroll
            for (int it = 0; it < 4; ++it) { float ss = 0.f;
#pragma unroll
                for (int nt = 0; nt < 2; ++nt) ss += (o[nt][it][0] * o[nt][it][0] + o[nt][it][1] * o[nt][it][1]) + (o[nt][it][2] * o[nt][it][2] + o[nt][it][3] * o[nt][it][3]);
                ss += __shfl_xor(ss, 16); ss += __shfl_xor(ss, 32);
                if (g == 0) xch[(pw * 4 + qf) * 64 + 16 * it + r16] = ss; }
            __syncthreads();
#pragma unroll
            for (int it = 0; it < 4; ++it) { const int ti = 16 * it + r16, tok = tok0 + ti;
                const float ssq = (xch[(pw * 4 + 0) * 64 + ti] + xch[(pw * 4 + 1) * 64 + ti]) + (xch[(pw * 4 + 2) * 64 + ti] + xch[(pw * 4 + 3) * 64 + ti]);
                const float rms = __builtin_amdgcn_rsqf(ssq * (1.0f / 128.0f) + RMS_EPS);
#pragma unroll
                for (int nt = 0; nt < 2; ++nt) { const int col = c0 + 16 * nt + 4 * g;
                    const u32x2v z = *(const GAS u32x2v*)(PO + (size_t)tok * OIN + 3072 + hh * 128 + col); const f32x4 gn = *(const GAS f32x4*)(onorm + col);
                    if (on) st8(mix + (size_t)tok * D_ + hh * 128 + col, o[nt][it][0] * rms * gn[0] * silu(bflo(z.x)), o[nt][it][1] * rms * gn[1] * silu(bfhi(z.x)),
                                o[nt][it][2] * rms * gn[2] * silu(bflo(z.y)), o[nt][it][3] * rms * gn[3] * silu(bfhi(z.y))); } }
            if (i < 3) {
                f32x4 acc[8][2];
#pragma unroll
                for (int mt = 0; mt < 8; ++mt)
#pragma unroll
                    for (int nt = 0; nt < 2; ++nt) { const u32x2v so = *(const LAS u32x2v*)(Sl + (16 * nt + r16) * 136 + 16 * mt + 4 * g); acc[mt][nt] = (f32x4){di * bflo(so.x), di * bfhi(so.x), di * bflo(so.y), di * bfhi(so.y)}; }
                g_prod2(acc, sk, T, r16, g);
                asm volatile("s_waitcnt lgkmcnt(0)" ::: "memory");
#pragma unroll
                for (int mt = 0; mt < 8; ++mt)
#pragma unroll
                    for (int nt = 0; nt < 2; ++nt) { u32x2v ov; ov.x = cvtpk(acc[mt][nt][0], acc[mt][nt][1]); ov.y = cvtpk(acc[mt][nt][2], acc[mt][nt][3]); *(LAS u32x2v*)(Sl + (16 * nt + r16) * 136 + 16 * mt + 4 * g) = ov; }
            }
        }
    }
    __syncthreads();
}

__device__ __forceinline__ void p_r1(const Frame& F, const Args& a, int L) {
    GAS unsigned char* ws = (GAS unsigned char*)a.ws; asm volatile("" : "+s"(ws)); int lane_ = F.lane; asm volatile("" : "+v"(lane_)); const int j = L >> 1, lane = lane_;
    const float* ssq = (const float*)(ws + WS_SSQA); const float* wr = (const float*)a.in[24] + (size_t)j * D_ * NEXP; const float* ln = (const float*)a.in[4] + L * D_;
    int* tok_e = (int*)(ws + WS_TOK + TOK_E); int* tok_r = (int*)(ws + WS_TOK + TOK_R); float* tok_g = (float*)(ws + WS_TOK + TOK_G);
    unsigned* gcount = (unsigned*)(ws + WS_CTL) + CW_CNT + 64 * j;
    LAS int* rt = (LAS int*)(F.lds + RT_OFF);
    if (F.tid < 16) rt[F.tid] = 0;
    __syncthreads();
    const GAS unsigned short* hB = (const GAS unsigned short*)(ws + WS_HBF); const GAS float* wrG = (const GAS float*)wr; const GAS float* lnG = (const GAS float*)ln;
    float lnr[16];
#pragma unroll
    for (int i = 0; i < 16; ++i) lnr[i] = lnG[64 * i + lane];
#pragma unroll 1
    for (int t = F.gw; t < S_; t += 2 * F.NGW) {
        const int tb = t + F.NGW; const bool hasb = tb < S_; const int tbc = hasb ? tb : t;
        float xa[16], xb[16];
#pragma unroll
        for (int i = 0; i < 16; ++i) { xa[i] = __uint_as_float(((unsigned)hB[(size_t)t * D_ + 64 * i + lane]) << 16); xb[i] = __uint_as_float(((unsigned)hB[(size_t)tbc * D_ + 64 * i + lane]) << 16); }
        const float rsa = pg8::rstd_row(ssq, t), rsb = pg8::rstd_row(ssq, tbc);
        float acca[8], accb[8];
#pragma unroll
        for (int e = 0; e < 8; ++e) { acca[e] = 0.f; accb[e] = 0.f; }
#pragma unroll
        for (int i = 0; i < 16; ++i) { const int k = 64 * i + lane; const f32x4 w0 = *(const GAS f32x4*)(wrG + (size_t)k * 8), w1 = *(const GAS f32x4*)(wrG + (size_t)k * 8 + 4);
            const float x = xa[i] * lnr[i], y = xb[i] * lnr[i];
            acca[0] += x * w0[0]; acca[1] += x * w0[1]; acca[2] += x * w0[2]; acca[3] += x * w0[3]; acca[4] += x * w1[0]; acca[5] += x * w1[1]; acca[6] += x * w1[2]; acca[7] += x * w1[3];
            accb[0] += y * w0[0]; accb[1] += y * w0[1]; accb[2] += y * w0[2]; accb[3] += y * w0[3]; accb[4] += y * w1[0]; accb[5] += y * w1[1]; accb[6] += y * w1[2]; accb[7] += y * w1[3]; }
#pragma unroll
        for (int e = 0; e < 8; ++e) { acca[e] = wave_sum(acca[e]) * rsa; accb[e] = wave_sum(accb[e]) * rsb; }
#pragma unroll
        for (int half = 0; half < 2; ++half) {
            if (half == 1 && !hasb) break;
            const int tt = half ? tb : t; float acc[8];
#pragma unroll
            for (int e = 0; e < 8; ++e) acc[e] = half ? accb[e] : acca[e];
            int e0 = 0; float l0 = acc[0];
#pragma unroll
            for (int e = 1; e < 8; ++e) if (acc[e] > l0) { l0 = acc[e]; e0 = e; }
            int e1 = -1; float l1 = -INFINITY;
#pragma unroll
            for (int e = 0; e < 8; ++e) if (e != e0 && acc[e] > l1) { l1 = acc[e]; e1 = e; }
            const float g1 = 1.0f / (1.0f + expf(l0 - l1)), g0 = 1.0f - g1;
            if (lane == 0) {
                const int r0 = __hip_atomic_fetch_add(rt + e0, 1, __ATOMIC_RELAXED, __HIP_MEMORY_SCOPE_WORKGROUP), r1 = __hip_atomic_fetch_add(rt + e1, 1, __ATOMIC_RELAXED, __HIP_MEMORY_SCOPE_WORKGROUP);
                tok_e[2 * tt] = e0; tok_e[2 * tt + 1] = e1; tok_r[2 * tt] = r0; tok_r[2 * tt + 1] = r1; tok_g[2 * tt] = g0; tok_g[2 * tt + 1] = g1;
            }
        }
    }
    __syncthreads();
    if (F.tid < 8) rt[8 + F.tid] = (int)__hip_atomic_fetch_add(gcount + F.tid, (unsigned)rt[F.tid], __ATOMIC_RELAXED, __HIP_MEMORY_SCOPE_AGENT);
    __syncthreads();
#pragma unroll 1
    for (int t = F.gw; t < S_; t += F.NGW) if (lane < 2) { const int e = tok_e[2 * t + lane]; tok_r[2 * t + lane] += rt[8 + e]; }
    __syncthreads();
}
__device__ __forceinline__ int moe_pstart(const unsigned* gcount, int e) {
    int ps = 0;
#pragma unroll
    for (int q = 0; q < 8; ++q) { const int c = (int)gcount[q]; if (q < e) ps += ((c + 255) >> 8) << 8; }
    return ps;
}
__device__ __forceinline__ void p_r2(const Frame& F, const Args& a, int L) {
    GAS unsigned char* ws = (GAS unsigned char*)a.ws; asm volatile("" : "+s"(ws)); int lane_ = F.lane; asm volatile("" : "+v"(lane_)); const int j = L >> 1, lane = lane_;
    const float* ssq = (const float*)(ws + WS_SSQA);
    const int* tok_e = (const int*)(ws + WS_TOK + TOK_E); const int* tok_r = (const int*)(ws + WS_TOK + TOK_R); const float* tok_g = (const float*)(ws + WS_TOK + TOK_G);
    int* dst = (int*)(ws + WS_TOK + TOK_DST); float* gpad = (float*)(ws + WS_TOK + TOK_GPAD);
    const unsigned* gcount = (const unsigned*)(ws + WS_CTL) + CW_CNT + 64 * j; bf16* XS = (bf16*)(ws + WS_ARENA + AR_XS);
    int pst[8]; { int ps = 0;
#pragma unroll
        for (int q = 0; q < 8; ++q) { pst[q] = ps; ps += (((int)gcount[q] + 255) >> 8) << 8; } }
    const GAS unsigned short* hB = (const GAS unsigned short*)(ws + WS_HBF);
#pragma unroll 1
    for (int t0 = F.gw; t0 < S_; t0 += 4 * F.NGW) {
        int tt[4], da[4], db[4]; float rs[4], ga[4], gb[4]; u32x2v v[4][4];
#pragma unroll
        for (int u = 0; u < 4; ++u) { const int t = t0 + u * F.NGW; tt[u] = t < S_ ? t : t0;
#pragma unroll
            for (int q = 0; q < 4; ++q) v[u][q] = *((const GAS u32x2v*)(hB + (size_t)tt[u] * D_) + 64 * q + lane); }
#pragma unroll
        for (int u = 0; u < 4; ++u) { const int t = tt[u]; rs[u] = pg8::rstd_row(ssq, t);
            const int ea = tok_e[2 * t], eb = tok_e[2 * t + 1]; int pa = 0, pb = 0;
#pragma unroll
            for (int q = 0; q < 8; ++q) { pa = (q == ea) ? pst[q] : pa; pb = (q == eb) ? pst[q] : pb; }
            da[u] = pa + tok_r[2 * t]; db[u] = pb + tok_r[2 * t + 1]; ga[u] = tok_g[2 * t]; gb[u] = tok_g[2 * t + 1]; }
#pragma unroll
        for (int u = 0; u < 4; ++u) { if (t0 + u * F.NGW >= S_) break; const int t = tt[u];
            if (lane == 0) { dst[2 * t] = da[u]; dst[2 * t + 1] = db[u]; gpad[da[u]] = ga[u]; gpad[db[u]] = gb[u]; }
#pragma unroll
            for (int q = 0; q < 4; ++q) { u32x2v o; o.x = cvtpk(bflo(v[u][q].x) * rs[u], bfhi(v[u][q].x) * rs[u]); o.y = cvtpk(bflo(v[u][q].y) * rs[u], bfhi(v[u][q].y) * rs[u]);
                *((GAS u32x2v*)(XS + (size_t)da[u] * D_) + 64 * q + lane) = o; *((GAS u32x2v*)(XS + (size_t)db[u] * D_) + 64 * q + lane) = o; } }
    }
}
__device__ __forceinline__ int moe_blocks(const Frame& F, const Args& a, int L) {
    const unsigned* gcount = (const unsigned*)(a.ws + WS_CTL) + CW_CNT + 64 * (L >> 1);
    LAS int* blk = (LAS int*)(F.lds + BLKE_OFF);
    int nb_tot = 0, mine = 7;
#pragma unroll
    for (int q = 0; q < 8; ++q) { const int nb = ((int)gcount[q] + 255) >> 8; if (F.tid >= nb_tot && F.tid < nb_tot + nb) mine = q; nb_tot += nb; }
    __syncthreads();
    if (F.tid < 160) blk[F.tid] = mine;
    __syncthreads();
    return nb_tot;
}
__device__ __forceinline__ void p_combine(const Frame& F, const Args& a) {
    GAS unsigned char* ws = (GAS unsigned char*)a.ws; asm volatile("" : "+s"(ws)); int lane_ = F.lane; asm volatile("" : "+v"(lane_)); const int lane = lane_;
    const int* dst = (const int*)(ws + WS_TOK + TOK_DST); const bf16* Y = (const bf16*)(ws + WS_ARENA + AR_Y); bf16* hb = (bf16*)(ws + WS_HBF); float* ssq = (float*)(ws + WS_SSQA);
#pragma unroll 1
    for (int t0 = F.gw; t0 < S_; t0 += 2 * F.NGW) {
        int tt[2], da[2], db[2]; u32x2v v[2][4]; u32x2v ya[2][4], yb[2][4];
#pragma unroll
        for (int u = 0; u < 2; ++u) { const int t = t0 + u * F.NGW; tt[u] = t < S_ ? t : t0; da[u] = dst[2 * tt[u]]; db[u] = dst[2 * tt[u] + 1];
#pragma unroll
            for (int q = 0; q < 4; ++q) v[u][q] = *((const GAS u32x2v*)(hb + (size_t)tt[u] * D_) + 64 * q + lane); }
#pragma unroll
        for (int u = 0; u < 2; ++u)
#pragma unroll
            for (int q = 0; q < 4; ++q) { ya[u][q] = *((const GAS u32x2v*)(Y + (size_t)da[u] * D_) + 64 * q + lane); yb[u][q] = *((const GAS u32x2v*)(Y + (size_t)db[u] * D_) + 64 * q + lane); }
#pragma unroll
        for (int u = 0; u < 2; ++u) { if (t0 + u * F.NGW >= S_) break; const int t = tt[u]; float ss = 0.f;
#pragma unroll
            for (int q = 0; q < 4; ++q) { f32x4 x = {bflo(v[u][q].x), bfhi(v[u][q].x), bflo(v[u][q].y), bfhi(v[u][q].y)};
                x[0] += bflo(ya[u][q].x) + bflo(yb[u][q].x); x[1] += bfhi(ya[u][q].x) + bfhi(yb[u][q].x); x[2] += bflo(ya[u][q].y) + bflo(yb[u][q].y); x[3] += bfhi(ya[u][q].y) + bfhi(yb[u][q].y);
                ss += (x[0] * x[0] + x[1] * x[1]) + (x[2] * x[2] + x[3] * x[3]);
                u32x2v o; o.x = cvtpk(x[0], x[1]); o.y = cvtpk(x[2], x[3]); *((GAS u32x2v*)(hb + (size_t)t * D_) + 64 * q + lane) = o; }
            ss = wave_sum(ss);
            if (lane < 16) ssq[(size_t)t * 16 + lane] = (lane == 0) ? ss : 0.f; }
    }
}
__device__ __forceinline__ void p_final(const Frame& F, const Args& a) {
    GAS unsigned char* ws = (GAS unsigned char*)a.ws; asm volatile("" : "+s"(ws)); int lane_ = F.lane; asm volatile("" : "+v"(lane_)); const int lane = lane_; const float* ssq = (const float*)(ws + WS_SSQB); const float* ln = (const float*)a.in[6]; const bf16* hb = (const bf16*)(ws + WS_HBF);
#pragma unroll 1
    for (int t = F.gw; t < S_; t += F.NGW) { const float rs = pg8::rstd_row(ssq, t);
#pragma unroll
        for (int q = 0; q < 4; ++q) { const u32x2v hv = *((const GAS u32x2v*)(hb + (size_t)t * D_) + 64 * q + lane); const f32x4 gq = *((const GAS f32x4*)ln + 64 * q + lane);
            const f32x4 x = {bflo(hv.x), bfhi(hv.x), bflo(hv.y), bfhi(hv.y)}; *((GAS f32x4*)(a.out + (size_t)t * D_) + 64 * q + lane) = x * rs * gq; } }
}
__device__ __forceinline__ void p_moe_weights(const Frame& F, const Args& a, int L, int w0, int nw, int part) {
    LAS float* scr = (LAS float*)(F.lds + F.wave * WAVE_LDS); (void)part;
    constexpr int IPM = (D_ / 64) * (DFF / 64), NI = 24 * IPM;
    XItem xc, xn;
    int gi = w0; if (gi >= NI) return;
    { const MatD m = moe_mat(a, L >> 1, gi / IPM); xpose_load(xc, m.W, m.ldw, m.N, gi % IPM, F.lane); }
#pragma unroll 1
    for (; gi < NI; gi += nw) {
        const int gn = gi + nw; const bool hasn = gn < NI;
        if (hasn) { const MatD mn = moe_mat(a, L >> 1, gn / IPM); xpose_load(xn, mn.W, mn.ldw, mn.N, gn % IPM, F.lane); }
        const MatD m = moe_mat(a, L >> 1, gi / IPM);
        xpose_finish(xc, m.K, m.N, m.gain, m.WT, m.ilv, scr, gi % IPM, F.lane);
        if (hasn) { _Pragma("unroll") for (int i = 0; i < 16; ++i) xc.v[i] = xn.v[i]; }
    }
}

constexpr int P_PRO = 0, P_FINAL = 81, LP_ROT = 16, LP_G1B = 17, LP_G2B = 18, LPN = 20, LP_PROJ = 0, LP_ATT = 1, LP_MIXPREP = 2, LP_GA = 3, LP_G1 = 4, LP_G2 = 5, LP_G3 = 6, LP_OUT = 7, LP_UP = 8, LP_DOWN = 9, LP_R1 = 10, LP_R2 = 11, LP_M1 = 12, LP_M2 = 13, LP_COMB = 14, LP_PLE = 15;

#ifndef PH_MASK
#define PH_MASK 0xffffffffull
#endif
#define IN(k) (lo <= (k) && (k) < hi)
#define INL(lp) ((((unsigned long long)(PH_MASK) >> (lp)) & 1) && lo <= pb + (lp) && pb + (lp) < hi)
#define SEAM() do { if (args.use_bar) xcd_barrier(bar); } while (0)
#ifndef REP_LP
#define REP_LP -1
#endif
#ifndef REP_L
#define REP_L -1
#endif
#ifndef REP_N
#define REP_N 2
#endif
#define REPS(lp) ((L == (REP_L) && (lp) == (REP_LP)) ? 1 + (REP_N) : 1)
#if REP_LP >= 0
#define REPLOOP(lp) _Pragma("unroll 1") for (int rep_ = 0; rep_ < REPS(lp); ++rep_)
#else
#define REPLOOP(lp)
#endif
#define PHASE_WS() GAS unsigned char* ws = (GAS unsigned char*)ws0; asm volatile("" : "+s"(ws)); bf16* HBF = (bf16*)(ws + WS_HBF); bf16* MIX = (bf16*)(ws + WS_MIX); bf16* PP = (bf16*)(ws + WS_PP); float* SSQA = (float*)(ws + WS_SSQA); float* SSQB = (float*)(ws + WS_SSQB); (void)HBF; (void)MIX; (void)PP; (void)SSQA; (void)SSQB
template <int L> __device__ __forceinline__ void run_layer(const Frame& F, const Args& args, unsigned char* lds, const XcdBarrier& bar, unsigned char* ws0, const int lo, const int hi, const int cid) {
        const int pb = 1 + LPN * L, j = L >> 1; const bool odd = (L & 1) != 0;
        REPLOOP(LP_PROJ) if (INL(LP_PROJ)) { PHASE_WS();
            if (!odd) {
                pg8::Gemm gm{HBF, (const bf16*)(ws + WS_WINE) + (size_t)j * EIN * D_, S_, EIN, D_, 0}; pg8::StaticOrder So; So.init(S_, EIN, F.G, cid);
                pg8::EpiBf16 E{(bf16*)(ws + WS_ARENA + AR_PE), EIN, SSQB, pg8::C2, 512};
                pg8::gemm_phase<pg8::EpiBf16, pg8::StaticOrder, true, true>(F.lds + RING_OFF, gm, So, E);
            } else {
                pg8::Gemm gm{HBF, (const bf16*)(ws + WS_WINO) + (size_t)j * OIN_ROWS * D_, S_, OIN, D_, 0}; pg8::StaticOrder So; So.init(S_, OIN, F.G, cid);
                pg8::EpiBf16 E{(bf16*)(ws + WS_ARENA + AR_PO), OIN, SSQB, 1.0f, 0};
                pg8::gemm_phase<pg8::EpiBf16, pg8::StaticOrder, true, true>(F.lds + RING_OFF, gm, So, E);
            }
            {
                pg8::Gemm gm{(const bf16*)(ws + WS_PBF) + (size_t)L * S_ * PLE, (const bf16*)(ws + WS_WP) + (size_t)L * D_ * PLE, S_, D_, PLE, 0}; pg8::StaticOrder So; So.init(S_, D_, F.G, cid);
                pg8::EpiBf16 E{PP, D_, nullptr, 1.0f, 0};
                pg8::gemm_phase<pg8::EpiBf16, pg8::StaticOrder, true, true>(F.lds + RING_OFF, gm, So, E);
            }
            if (odd) p_ab(F, args, L);
            if (!odd) { pg8::StaticOrder Sr; Sr.init(S_, EIN, F.G, cid); p_rot_tiles(F, args, Sr); }
            SEAM();
        }
        if (!odd) {
            REPLOOP(LP_ATT) if (INL(LP_ATT)) { PHASE_WS(); attn_body::attn_phase<8>((char*)lds + RING_OFF, (const attn_body::bf16*)(ws + WS_ARENA + AR_PE), (attn_body::bf16*)(ws + WS_ARENA + AR_AO), F.vcu, F.G); SEAM(); }
            REPLOOP(LP_MIXPREP) if (INL(LP_MIXPREP)) { PHASE_WS(); p_mixprep(F, args, L); SEAM(); }
        } else {
            REPLOOP(LP_GA) if (INL(LP_GA)) { PHASE_WS();
#ifdef PROBE_GSEL
                const int gsel = args.use_bar ? 7 : PROBE_GSEL;
#else
                const int gsel = 7;
#endif
                if (gsel & 1) p_ga(F, args, L); asm volatile("s_waitcnt vmcnt(0)" ::: "memory"); __syncthreads(); if (gsel & 2) p_g1(F, args); asm volatile("s_waitcnt vmcnt(0)" ::: "memory"); __syncthreads(); if (gsel & 4) p_g1b(F, args); SEAM(); }
            REPLOOP(LP_G2) if (INL(LP_G2)) { PHASE_WS();
                const int nscan = F.G < 64 ? F.G : 64;
#ifdef PROBE_NOCONV
                if (!args.use_bar) { if (F.vcu < nscan) p_g2<64, 4>(F, args, (const bf16*)(ws + WS_ARENA + AR_MPC), (const bf16*)(ws + WS_ARENA + AR_NTC), (const float*)(ws + WS_TOK + TOK_DNC)); } else
#endif
#ifdef PROBE_NOSCAN
                if (!args.use_bar) { if (F.vcu >= nscan) p_moe_weights(F, args, L, (F.vcu - nscan) * NWAVES + F.wave, (F.G - nscan) * NWAVES, -1); } else
#endif
                if (F.vcu < nscan) p_g2<64, 4>(F, args, (const bf16*)(ws + WS_ARENA + AR_MPC), (const bf16*)(ws + WS_ARENA + AR_NTC), (const float*)(ws + WS_TOK + TOK_DNC));
                else p_moe_weights(F, args, L, (F.vcu - nscan) * NWAVES + F.wave, (F.G - nscan) * NWAVES, -1);
                if (F.G <= 64) p_moe_weights(F, args, L, F.gw, F.NGW, -1);
                SEAM();
            }
            REPLOOP(LP_G3) if (INL(LP_G3)) { PHASE_WS(); p_g23(F, args, L); SEAM(); }
        }
        REPLOOP(LP_OUT) if (INL(LP_OUT)) { PHASE_WS();
            const bf16* Wo = odd ? (const bf16*)(ws + WS_WOUTO) + (size_t)j * D_ * D_ : (const bf16*)(ws + WS_WOUTE) + (size_t)j * D_ * D_;
            pg8::Gemm gm{MIX, Wo, S_, D_, D_, 0}; pg8::StaticOrder So; So.init(S_, D_, F.G, cid);
            pg8::EpiResid E{HBF, SSQA};
            pg8::gemm_phase<pg8::EpiResid, pg8::StaticOrder, true, true>(F.lds + RING_OFF, gm, So, E);
            SEAM();
        }
        if (!odd) {
            REPLOOP(LP_UP) if (INL(LP_UP)) { PHASE_WS();
                pg8::Gemm gm{HBF, (const bf16*)(ws + WS_W13D) + (size_t)j * 2 * DFF * D_, S_, 2 * DFF, D_, 0}; pg8::StaticOrder So; So.init(S_, 2 * DFF, F.G, cid);
                pg8::EpiSwiglu E{(bf16*)(ws + WS_ARENA + AR_ACT), SSQA};
                pg8::gemm_phase<pg8::EpiSwiglu, pg8::StaticOrder, true, true>(F.lds + RING_OFF, gm, So, E);
                SEAM();
            }
            REPLOOP(LP_DOWN) if (INL(LP_DOWN)) { PHASE_WS();
                pg8::Gemm gm{(const bf16*)(ws + WS_ARENA + AR_ACT), (const bf16*)(ws + WS_W2D) + (size_t)j * D_ * DFF, S_, D_, DFF, 0}; pg8::StaticOrder So; So.init(S_, D_, F.G, cid);
                pg8::EpiResid E{HBF, SSQA};
                pg8::gemm_phase<pg8::EpiResid, pg8::StaticOrder, true, true>(F.lds + RING_OFF, gm, So, E);
                SEAM();
            }
        } else {
            REPLOOP(LP_R1) if (INL(LP_R1)) { PHASE_WS(); p_r1(F, args, L); SEAM(); }
            REPLOOP(LP_R2) if (INL(LP_R2)) { PHASE_WS(); p_r2(F, args, L); SEAM(); }
            REPLOOP(LP_M1) if (INL(LP_M1)) { PHASE_WS();
                const int nb = moe_blocks(F, args, L);
                pg8::Gemm gm{(const bf16*)(ws + WS_ARENA + AR_XS), (const bf16*)(ws + WS_W13M), nb * 256, 2 * DFF, D_, (size_t)2 * DFF * D_ * 2}; pg8::MoeOrder So; So.init(nb * 256, 2 * DFF, F.G, cid); So.blk_e = (const LAS int*)(F.lds + BLKE_OFF);
                pg8::EpiSwiglu E{(bf16*)(ws + WS_ARENA + AR_ACT), nullptr};
                pg8::gemm_phase<pg8::EpiSwiglu, pg8::MoeOrder, true, true>(F.lds + RING_OFF, gm, So, E);
                SEAM();
            }
            REPLOOP(LP_M2) if (INL(LP_M2)) { PHASE_WS();
                const int nb = moe_blocks(F, args, L);
                pg8::Gemm gm{(const bf16*)(ws + WS_ARENA + AR_ACT), (const bf16*)(ws + WS_W2M), nb * 256, D_, DFF, (size_t)D_ * DFF * 2}; pg8::MoeOrder So; So.init(nb * 256, D_, F.G, cid); So.blk_e = (const LAS int*)(F.lds + BLKE_OFF);
                pg8::EpiMoeDown E{(bf16*)(ws + WS_ARENA + AR_Y), (const float*)(ws + WS_TOK + TOK_GPAD)};
                pg8::gemm_phase<pg8::EpiMoeDown, pg8::MoeOrder, true, true>(F.lds + RING_OFF, gm, So, E);
                SEAM();
            }
            REPLOOP(LP_COMB) if (INL(LP_COMB)) { PHASE_WS(); p_combine(F, args); SEAM(); }
        }
        REPLOOP(LP_PLE) if (INL(LP_PLE)) { PHASE_WS();
            pg8::Gemm gm{HBF, (const bf16*)(ws + WS_WG) + (size_t)L * D_ * D_, S_, D_, D_, 0}; pg8::StaticOrder So; So.init(S_, D_, F.G, cid);
            pg8::EpiPle E{HBF, SSQA, SSQB, PP};
            pg8::gemm_phase<pg8::EpiPle, pg8::StaticOrder, true, true>(F.lds + RING_OFF, gm, So, E);
            SEAM();
        }
    }

__global__ void __launch_bounds__(NWAVES * 64, 2) fwd(Args args) {
    extern __shared__ __attribute__((aligned(16))) unsigned char lds[];
    Frame F;
    F.lds = (LAS unsigned char*)lds; F.tid = threadIdx.x; F.lane = F.tid & 63; F.wave = __builtin_amdgcn_readfirstlane(F.tid >> 6);
    F.G = gridDim.x; { const int bx = blockIdx.x; F.vcu = (F.G % 8 == 0) ? (bx % 8) * (F.G / 8) + bx / 8 : bx; }
    F.gw = F.vcu * NWAVES + F.wave; F.NGW = F.G * NWAVES;
    unsigned char* ws0 = args.ws;
    for (int u = F.tid; u < (LDS_BYTES - LDSCTL_OFF) / 4; u += NWAVES * 64) ((LAS unsigned*)(F.lds + LDSCTL_OFF))[u] = 0u;
    __syncthreads();
    XcdBarrier bar; bar.bar = (unsigned*)(ws0 + WS_CTL) + CW_BAR; bar.x = 0; bar.st = nullptr;
    if (args.use_bar) bar = xcd_barrier_post((unsigned*)(ws0 + WS_CTL) + CW_BAR, (volatile LAS unsigned*)(F.lds + MISC_OFF));
    const int lo = args.ph_lo, hi = args.ph_hi;
    const int cid = (int)blockIdx.x;

    if ((((unsigned long long)(PH_MASK) >> 30) & 1) && IN(P_PRO)) { p_prologue(F, args); SEAM(); }

#ifdef FIXED_L
    run_layer<FIXED_L>(F, args, lds, bar, ws0, lo, hi, cid);
#else
    run_layer<0>(F, args, lds, bar, ws0, lo, hi, cid); run_layer<1>(F, args, lds, bar, ws0, lo, hi, cid); run_layer<2>(F, args, lds, bar, ws0, lo, hi, cid); run_layer<3>(F, args, lds, bar, ws0, lo, hi, cid);
#endif
    if ((((unsigned long long)(PH_MASK) >> 31) & 1) && IN(P_FINAL)) p_final(F, args);
#undef IN
#undef INL
#undef SEAM
}


#ifndef DBG
#define DBG 0
#endif
#if DBG
#ifndef DBG_ASLOT
#define DBG_ASLOT 9
#endif
#ifndef DBG_BSLOT
#define DBG_BSLOT 11
#endif
__global__ void dbg_scan(const void* p, size_t n, int is_f32, unsigned* slot) {
    unsigned cnt = 0;
    for (size_t i = (size_t)blockIdx.x * blockDim.x + threadIdx.x; i < n; i += (size_t)gridDim.x * blockDim.x) {
        const float v = is_f32 ? ((const float*)p)[i] : __uint_as_float(((unsigned)((const unsigned short*)p)[i]) << 16);
        if (!(fabsf(v) < 1e30f)) ++cnt; }
    if (cnt) atomicAdd(slot, cnt);
}
__global__ void dbg_fill(float* out, size_t n, const unsigned* slots, int nslots) {
    int first = -1; for (int i = 0; i < nslots; ++i) if (slots[i]) { first = i; break; }
    float c, V;
    if (first >= 0) { c = sqrtf((float)(10 + first) * 1e6f); V = c; }
    else { const float ea = fmaxf(__uint_as_float(slots[256 + DBG_ASLOT]), 1e-5f), eb = fmaxf(__uint_as_float(slots[256 + DBG_BSLOT]), 1e-5f);
        c = sqrtf((10.f + fminf(60.f, rintf(10.f * (log10f(ea) + 5.f)))) * 1e4f); V = (50.f + rintf(10.f * log10f(eb))) * 1e3f; }
    for (size_t i = (size_t)blockIdx.x * blockDim.x + threadIdx.x; i < n; i += (size_t)gridDim.x * blockDim.x) out[i] = (i == 0) ? V : c;
}
__device__ __forceinline__ float dbg_bf(const unsigned short* p, size_t i) { return __uint_as_float(((unsigned)p[i]) << 16); }
__device__ __forceinline__ float dbg_rstd(const float* ssq, int row) { float s = 0.f; for (int i = 0; i < 16; ++i) s += ssq[(size_t)row * 16 + i]; return 1.0f / sqrtf(s / 1024.0f + 1e-6f); }
__device__ __forceinline__ float dbg_blocksum(float v, float* red) {
    __syncthreads(); red[threadIdx.x] = v; __syncthreads();
    for (int o = 128; o > 0; o >>= 1) { if ((int)threadIdx.x < o) red[threadIdx.x] += red[threadIdx.x + o]; __syncthreads(); }
    const float r = red[0]; __syncthreads(); return r;
}
__device__ __forceinline__ void dbg_report(unsigned* slot, float num, float den) { if (threadIdx.x == 0) atomicMax(slot, __float_as_uint(sqrtf(num / fmaxf(den, 1e-20f)))); }
__global__ void chk_ffn(const float* hpre, const float* hpost, const float* ssq, const float* ln, const float* wr, const float* w1, const float* w3, const float* w2, int moe, unsigned* slot) {
    __shared__ float xn[1024]; __shared__ float hid[3584]; __shared__ float red[256]; __shared__ float lg[8];
    const int t = (blockIdx.x * 997 + 13) % S_, tid = threadIdx.x;
    const float rs = dbg_rstd(ssq, t);
    for (int k = tid; k < 1024; k += 256) xn[k] = hpre[(size_t)t * 1024 + k] * rs * ln[k];
    __syncthreads();
    int e0 = 0, e1 = 0; float g0 = 1.f, g1 = 0.f;
    if (moe) {
        if (tid < 8) { float s = 0.f; for (int k = 0; k < 1024; ++k) s += xn[k] * wr[(size_t)k * 8 + tid]; lg[tid] = s; }
        __syncthreads();
        float l0 = lg[0]; for (int e = 1; e < 8; ++e) if (lg[e] > l0) { l0 = lg[e]; e0 = e; }
        float l1 = -1e30f; e1 = -1; for (int e = 0; e < 8; ++e) if (e != e0 && lg[e] > l1) { l1 = lg[e]; e1 = e; }
        const float m0 = expf(l0 - l0), m1 = expf(l1 - l0); g0 = m0 / (m0 + m1); g1 = m1 / (m0 + m1);
    }
    float acc[4] = {0.f, 0.f, 0.f, 0.f};
    for (int pass = 0; pass < (moe ? 2 : 1); ++pass) {
        const int e = pass == 0 ? e0 : e1; const float gt = pass == 0 ? g0 : g1;
        const float* W1 = w1 + (size_t)e * 1024 * 3584; const float* W3 = w3 + (size_t)e * 1024 * 3584; const float* W2 = w2 + (size_t)e * 3584 * 1024;
        __syncthreads();
        for (int f = tid; f < 3584; f += 256) { float a = 0.f, b = 0.f; for (int k = 0; k < 1024; ++k) { a += xn[k] * W1[(size_t)k * 3584 + f]; b += xn[k] * W3[(size_t)k * 3584 + f]; } hid[f] = a / (1.f + expf(-a)) * b; }
        __syncthreads();
        for (int q = 0; q < 4; ++q) { const int c = tid + 256 * q; float y = 0.f; for (int f = 0; f < 3584; ++f) y += hid[f] * W2[(size_t)f * 1024 + c]; acc[q] += gt * y; }
    }
    float num = 0.f, den = 0.f;
    for (int q = 0; q < 4; ++q) { const int c = tid + 256 * q; const float ex = acc[q], got = hpost[(size_t)t * 1024 + c] - hpre[(size_t)t * 1024 + c]; num += (got - ex) * (got - ex); den += ex * ex; }
    num = dbg_blocksum(num, red); den = dbg_blocksum(den, red);
    dbg_report(slot, num, den);
}
__global__ void chk_ple(const float* hpre, const float* hpost, const float* ssq, const float* ln, const float* wg, const float* p, const float* wp, unsigned* slot) {
    __shared__ float xn[1024]; __shared__ float red[256];
    const int t = (blockIdx.x * 997 + 13) % S_, tid = threadIdx.x; const float rs = dbg_rstd(ssq, t);
    for (int k = tid; k < 1024; k += 256) xn[k] = hpre[(size_t)t * 1024 + k] * rs * ln[k];
    __syncthreads();
    float num = 0.f, den = 0.f;
    for (int q = 0; q < 4; ++q) { const int c = tid + 256 * q; float a = 0.f, b = 0.f; for (int k = 0; k < 1024; ++k) a += xn[k] * wg[(size_t)k * 1024 + c]; for (int k = 0; k < 256; ++k) b += p[(size_t)t * 256 + k] * wp[(size_t)k * 1024 + c];
        const float ex = b / (1.f + expf(-a)), got = hpost[(size_t)t * 1024 + c] - hpre[(size_t)t * 1024 + c]; num += (got - ex) * (got - ex); den += ex * ex; }
    num = dbg_blocksum(num, red); den = dbg_blocksum(den, red); dbg_report(slot, num, den);
}
constexpr int DBG_TC = 512;
__global__ void chk_gdn_proj(const float* h, const float* ssq, const float* ln, const float* W, int hh, float* raw) {
    const int idx = blockIdx.x * blockDim.x + threadIdx.x; if (idx >= DBG_TC * 514) return;
    const int t = idx / 514, c = idx % 514;
    const int col = c < 128 ? hh * 128 + c : c < 256 ? 1024 + hh * 128 + (c - 128) : c < 384 ? 2048 + hh * 128 + (c - 256) : c < 512 ? 3072 + hh * 128 + (c - 384) : c == 512 ? 4096 + hh : 4104 + hh;
    const float rs = dbg_rstd(ssq, t); float s = 0.f;
    for (int k = 0; k < 1024; ++k) s += h[(size_t)t * 1024 + k] * ln[k] * W[(size_t)k * OIN_SRC + col];
    raw[(size_t)t * 514 + c] = s * rs;
}
__global__ void chk_gdn_rec(const float* raw, const float* cw, const float* alog, const float* dtb, const float* onorm, int hh, const unsigned short* mix, unsigned* slot) {
    extern __shared__ float sm[];
    float* Sm = sm; float* q = sm + 128 * 129; float* kk = q + 128; float* v = kk + 128; float* kv = v + 128; float* dl = kv + 128; float* o = dl + 128; float* red = o + 128;
    const int tid = threadIdx.x;
    for (int i = tid; i < 128 * 129; i += 256) Sm[i] = 0.f;
    __syncthreads();
    float worst = 0.f;
    for (int t = 0; t < DBG_TC; ++t) {
        if (tid < 128) { const int d = tid; float aq = 0.f, ak = 0.f, av = 0.f;
            for (int jj = 0; jj < 4; ++jj) { const int r = t - 3 + jj; if (r >= 0) { aq += cw[jj * 3072 + hh * 128 + d] * raw[(size_t)r * 514 + d]; ak += cw[jj * 3072 + 1024 + hh * 128 + d] * raw[(size_t)r * 514 + 128 + d]; av += cw[jj * 3072 + 2048 + hh * 128 + d] * raw[(size_t)r * 514 + 256 + d]; } }
            q[d] = aq / (1.f + expf(-aq)); kk[d] = ak / (1.f + expf(-ak)); v[d] = av / (1.f + expf(-av)); }
        __syncthreads();
        const float sq = dbg_blocksum(tid < 128 ? q[tid] * q[tid] : 0.f, red), sk = dbg_blocksum(tid < 128 ? kk[tid] * kk[tid] : 0.f, red);
        if (tid < 128) { q[tid] *= 1.0f / sqrtf(sq + 1e-6f) * 0.08838834764831845f; kk[tid] *= 1.0f / sqrtf(sk + 1e-6f); }
        const float bb = raw[(size_t)t * 514 + 512], aa = raw[(size_t)t * 514 + 513];
        const float beta = 1.f / (1.f + expf(-bb)); const float z = aa + dtb[hh]; const float g = -expf(alog[hh]) * (z > 20.f ? z : log1pf(expf(z))); const float alpha = expf(g);
        __syncthreads();
        for (int i = tid; i < 128 * 128; i += 256) { const int d = i >> 7, j = i & 127; Sm[d * 129 + j] *= alpha; }
        __syncthreads();
        if (tid < 128) { float s = 0.f; for (int d = 0; d < 128; ++d) s += kk[d] * Sm[d * 129 + tid]; dl[tid] = beta * (v[tid] - s); }
        __syncthreads();
        for (int i = tid; i < 128 * 128; i += 256) { const int d = i >> 7, j = i & 127; Sm[d * 129 + j] += kk[d] * dl[j]; }
        __syncthreads();
        if (tid < 128) { float s = 0.f; for (int d = 0; d < 128; ++d) s += q[d] * Sm[d * 129 + tid]; o[tid] = s; }
        __syncthreads();
        const float so = dbg_blocksum(tid < 128 ? o[tid] * o[tid] : 0.f, red); const float rms = 1.0f / sqrtf(so / 128.f + 1e-6f);
        float num = 0.f, den = 0.f;
        if (tid < 128) { const float zz = raw[(size_t)t * 514 + 384 + tid]; const float ex = o[tid] * rms * onorm[tid] * (zz / (1.f + expf(-zz))); const float got = dbg_bf(mix, (size_t)t * 1024 + hh * 128 + tid); num = (got - ex) * (got - ex); den = ex * ex; }
        num = dbg_blocksum(num, red); den = dbg_blocksum(den, red);
        worst = fmaxf(worst, sqrtf(num / fmaxf(den, 1e-20f)));
    }
    if (tid == 0) atomicMax(slot, __float_as_uint(worst));
}

__global__ void chk_even_kv(const float* h, const float* ssq, const float* ln, const float* W, float* KV) {
    const size_t idx = (size_t)blockIdx.x * blockDim.x + threadIdx.x; if (idx >= (size_t)S_ * 1024) return;
    const int t = (int)(idx >> 10), c = (int)(idx & 1023); const float rs = dbg_rstd(ssq, t); float s = 0.f;
    for (int k = 0; k < 1024; ++k) s += h[(size_t)t * 1024 + k] * ln[k] * W[(size_t)k * EIN + 512 + c];
    KV[idx] = s * rs;
}
__global__ void chk_even_mix(const float* h, const float* ssq, const float* ln, const float* W, const float* KV, const int* pos, const float* lq1, const float* lk1, const float* lq2, const float* lk2, const float* subg, const float* cw,
                             float lam0, const unsigned short* PE, const unsigned short* AO, const unsigned short* MIXb, unsigned* slot) {
    __shared__ float q[2][64]; __shared__ float p[128]; __shared__ float red[256]; __shared__ float o2[2][128]; __shared__ float hn[1024];
    const int toks[6] = {5, 200, 1000, 4097, 9000, 16383};
    const int t = toks[blockIdx.x / 4], hh = blockIdx.x % 4, tid = threadIdx.x;
    auto bsum = [&](float v) { __syncthreads(); red[tid] = v; __syncthreads(); for (int o = 64; o > 0; o >>= 1) { if (tid < o) red[tid] += red[tid + o]; __syncthreads(); } const float r = red[0]; __syncthreads(); return r; };
    auto bmax = [&](float v) { __syncthreads(); red[tid] = v; __syncthreads(); for (int o = 64; o > 0; o >>= 1) { if (tid < o) red[tid] = fmaxf(red[tid], red[tid + o]); __syncthreads(); } const float r = red[0]; __syncthreads(); return r; };
    auto invf = [&](int i) { return exp2f(-(float)i * (18.931568569324174f / 8.0f)); };
    const float rs = dbg_rstd(ssq, t);
    for (int k = tid; k < 1024; k += 128) hn[k] = h[(size_t)t * 1024 + k] * rs * ln[k];
    __syncthreads();
    { const int m = tid >> 6, d = tid & 63, col = (2 * hh + m) * 64 + d; float s = 0.f; for (int k = 0; k < 1024; ++k) s += hn[k] * W[(size_t)k * EIN + col]; q[m][d] = s; }
    __syncthreads();
    float qr;
    { const int m = tid >> 6, d = tid & 63; float v = q[m][d];
      if (d < 16) { const int i = d & 7; const float ang = (float)pos[t] * invf(i); const float c = cosf(ang), s = sinf(ang); v = d < 8 ? q[m][d] * c - q[m][d + 8] * s : q[m][d] * c + q[m][d - 8] * s; }
      qr = v * pg8::C2; }
    __syncthreads(); q[tid >> 6][tid & 63] = qr; __syncthreads();
    float num = 0.f, den = 0.f;
    { const int m = tid >> 6, d = tid & 63; const float got = dbg_bf(PE, (size_t)t * EIN + (2 * hh + m) * 64 + d); const float e2 = (got - qr) * (got - qr), r2 = qr * qr; num += e2; den += r2;
      const float na = bsum(d >= 16 ? e2 : 0.f), da = bsum(d >= 16 ? r2 : 0.f), nb = bsum(d < 16 ? e2 : 0.f), db = bsum(d < 16 ? r2 : 0.f);
      if (tid == 0) { atomicMax(slot + 4, __float_as_uint(sqrtf(na / fmaxf(da, 1e-20f)))); atomicMax(slot + 5, __float_as_uint(sqrtf(nb / fmaxf(db, 1e-20f)))); } }
    { const int m = tid >> 6, d = tid & 63; const float* kr = KV + (size_t)t * 1024 + (2 * hh + m) * 64; float v = kr[d];
      if (d < 16) { const int i = d & 7; const float ang = (float)pos[t] * invf(i); const float c = cosf(ang), s = sinf(ang); v = d < 8 ? kr[d] * c - kr[d + 8] * s : kr[d] * c + kr[d - 8] * s; }
      const float got = dbg_bf(PE, (size_t)t * EIN + 512 + (2 * hh + m) * 64 + d); const float e2 = (got - v) * (got - v), r2 = v * v; num += e2; den += r2;
      const float na = bsum(d >= 16 ? e2 : 0.f), da = bsum(d >= 16 ? r2 : 0.f), nb = bsum(d < 16 ? e2 : 0.f), db = bsum(d < 16 ? r2 : 0.f);
      const float vv = KV[(size_t)t * 1024 + 512 + hh * 128 + tid], gv = dbg_bf(PE, (size_t)t * EIN + 1024 + hh * 128 + tid); const float e3 = (gv - vv) * (gv - vv), r3 = vv * vv; num += e3; den += r3;
      const float nc = bsum(e3), dc = bsum(r3);
      if (tid == 0) { atomicMax(slot + 6, __float_as_uint(sqrtf(na / fmaxf(da, 1e-20f)))); atomicMax(slot + 7, __float_as_uint(sqrtf(nb / fmaxf(db, 1e-20f)))); atomicMax(slot + 8, __float_as_uint(sqrtf(nc / fmaxf(dc, 1e-20f)))); } }
    num = bsum(num); den = bsum(den); if (tid == 0) atomicMax(slot + 0, __float_as_uint(sqrtf(num / fmaxf(den, 1e-20f))));
    for (int m = 0; m < 2; ++m) {
        float mx = -1e30f;
        for (int j0 = 0; j0 <= t; j0 += 128) { const int j = j0 + tid; float s = -1e30f;
            if (j <= t) { const float* kr = KV + (size_t)j * 1024 + (2 * hh + m) * 64; s = 0.f;
                for (int d = 0; d < 64; ++d) { float kv = kr[d]; if (d < 16) { const int i = d & 7; const float ang = (float)pos[j] * invf(i); const float c = cosf(ang), sn = sinf(ang); kv = d < 8 ? kr[d] * c - kr[d + 8] * sn : kr[d] * c + kr[d - 8] * sn; } s += q[m][d] * kv; } }
            mx = fmaxf(mx, s); }
        mx = bmax(mx);
        float l = 0.f, acc = 0.f;
        for (int j0 = 0; j0 <= t; j0 += 128) { const int j = j0 + tid; float pe = 0.f;
            if (j <= t) { const float* kr = KV + (size_t)j * 1024 + (2 * hh + m) * 64; float s = 0.f;
                for (int d = 0; d < 64; ++d) { float kv = kr[d]; if (d < 16) { const int i = d & 7; const float ang = (float)pos[j] * invf(i); const float c = cosf(ang), sn = sinf(ang); kv = d < 8 ? kr[d] * c - kr[d + 8] * sn : kr[d] * c + kr[d - 8] * sn; } s += q[m][d] * kv; }
                pe = exp2f(s - mx); }
            __syncthreads(); p[tid] = pe; __syncthreads();
            l += pe;
            const int nj = min(128, t + 1 - j0);
            for (int i = 0; i < nj; ++i) acc += p[i] * KV[(size_t)(j0 + i) * 1024 + 512 + hh * 128 + tid]; }
        l = bsum(l);
        o2[m][tid] = acc / l;
    }
    __syncthreads();
    { float n2 = 0.f, d2 = 0.f;
      for (int m = 0; m < 2; ++m) { const float ex = o2[m][tid], got = dbg_bf(AO, (size_t)t * 1024 + hh * 256 + m * 128 + tid); n2 += (got - ex) * (got - ex); d2 += ex * ex; }
      n2 = bsum(n2); d2 = bsum(d2); if (tid == 0) atomicMax(slot + 1, __float_as_uint(sqrtf(n2 / fmaxf(d2, 1e-20f)))); }
    float s1 = 0.f, s2 = 0.f; for (int i = 0; i < 64; ++i) { s1 += lq1[i] * lk1[i]; s2 += lq2[i] * lk2[i]; }
    const float lam = expf(s1) - expf(s2) + lam0;
    const float dv = o2[0][tid] - lam * o2[1][tid]; const float ssd = bsum(dv * dv); const float ex = dv / sqrtf(ssd / 128.f + 1e-5f) * subg[tid] * (1.f - lam0);
    { const float got = dbg_bf(MIXb, (size_t)t * 1024 + hh * 128 + tid); float n2 = (got - ex) * (got - ex), d2 = ex * ex; n2 = bsum(n2); d2 = bsum(d2); if (tid == 0) atomicMax(slot + 2, __float_as_uint(sqrtf(n2 / fmaxf(d2, 1e-20f)))); }
    { const int ch = hh * 128 + tid; float cx[3] = {0.f, 0.f, 0.f}, bg = 0.f;
      for (int jj = 0; jj < 3; ++jj) { const int r = t - 2 + jj; if (r < 0) continue; const float rr = dbg_rstd(ssq, r); float c = 0.f, x = 0.f, b = 0.f;
          for (int k = 0; k < 1024; ++k) { const float hv = h[(size_t)r * 1024 + k] * ln[k]; c += hv * W[(size_t)k * EIN + 2048 + ch]; x += hv * W[(size_t)k * EIN + 2560 + ch]; if (jj == 2) b += hv * W[(size_t)k * EIN + 1536 + ch]; }
          cx[jj] = (c * rr) * (x * rr); if (jj == 2) bg = b * rr; }
      const float ex2 = bg * (cw[0 * 512 + ch] * cx[0] + cw[1 * 512 + ch] * cx[1] + cw[2 * 512 + ch] * cx[2]); const float got = dbg_bf(MIXb, (size_t)t * 1024 + 512 + ch);
      float n2 = (got - ex2) * (got - ex2), d2 = ex2 * ex2; n2 = bsum(n2); d2 = bsum(d2); if (tid == 0) atomicMax(slot + 3, __float_as_uint(sqrtf(n2 / fmaxf(d2, 1e-20f)))); }
}
static void dbg_before_phase(int ph, unsigned char* ws, float* out, hipStream_t st) {
    if (ph == P_PRO || ph == P_FINAL) return;
    const int lp = (ph - 1) % LPN;
    if (lp == LP_UP || lp == LP_R1 || lp == LP_PLE) { (void)hipMemcpyAsync(ws + WS_ARENA + 400 * MiB, out, (size_t)S_ * D_ * 4, hipMemcpyDeviceToDevice, st); (void)hipMemcpyAsync(ws + WS_ARENA + 464 * MiB, ws + WS_SSQA, (size_t)S_ * 16 * 4, hipMemcpyDeviceToDevice, st); }
}
static void dbg_checks(int ph, void* const* d_in, unsigned char* ws, float* out, hipStream_t st) {
    if (ph == P_PRO || ph == P_FINAL) return;
    unsigned* slots = (unsigned*)(ws + WS_CTL) + CW_DBG; const int L = (ph - 1) / LPN, lp = (ph - 1) % LPN, j = L >> 1; const bool odd = L & 1;
    const float* snap = (const float*)(ws + WS_ARENA + 400 * MiB);
    if (lp == LP_DOWN && L == 0) hipLaunchKernelGGL(chk_ffn, dim3(24), dim3(256), 0, st, snap, (const float*)out, (const float*)(ws + WS_ARENA + 464 * MiB), (const float*)d_in[4] + L * D_, (const float*)nullptr,
        (const float*)d_in[21] + (size_t)j * D_ * DFF, (const float*)d_in[22] + (size_t)j * D_ * DFF, (const float*)d_in[23] + (size_t)j * D_ * DFF, 0, slots + 256 + 0);
    if (lp == LP_PLE && L == 0) hipLaunchKernelGGL(chk_ple, dim3(24), dim3(256), 0, st, snap, (const float*)out, (const float*)(ws + WS_ARENA + 464 * MiB), (const float*)d_in[5] + L * D_, (const float*)d_in[28] + (size_t)L * D_ * D_,
        (const float*)d_in[1] + (size_t)L * S_ * PLE, (const float*)d_in[29] + (size_t)L * PLE * D_, slots + 256 + 1);
    if (lp == LP_G3 && L == 1) { float* raw = (float*)(ws + WS_ARENA + 400 * MiB);
        hipLaunchKernelGGL(chk_gdn_proj, dim3((DBG_TC * 514 + 255) / 256), dim3(256), 0, st, (const float*)out, (const float*)(ws + WS_SSQB), (const float*)d_in[3] + L * D_, (const float*)d_in[15] + (size_t)j * D_ * OIN_SRC, 3, raw);
        hipLaunchKernelGGL(chk_gdn_rec, dim3(1), dim3(256), (128 * 129 + 6 * 128 + 256) * 4, st, (const float*)raw, (const float*)d_in[16] + (size_t)j * 4 * 3072, (const float*)d_in[17] + j * 8, (const float*)d_in[18] + j * 8, (const float*)d_in[19] + j * 128, 3, (const unsigned short*)(ws + WS_MIX), slots + 256 + 2); }
    if (lp == LP_COMB && L == 1) hipLaunchKernelGGL(chk_ffn, dim3(24), dim3(256), 0, st, snap, (const float*)out, (const float*)(ws + WS_ARENA + 464 * MiB), (const float*)d_in[4] + L * D_, (const float*)d_in[24] + (size_t)j * D_ * NEXP,
        (const float*)d_in[25] + (size_t)j * NEXP * D_ * DFF, (const float*)d_in[26] + (size_t)j * NEXP * D_ * DFF, (const float*)d_in[27] + (size_t)j * NEXP * DFF * D_, 1, slots + 256 + 3);
    if (lp == LP_MIXPREP && L == 0) { float* KV = (float*)(ws + WS_ARENA + 400 * MiB);
        hipLaunchKernelGGL(chk_even_kv, dim3((S_ * 1024) / 256), dim3(256), 0, st, (const float*)out, (const float*)(ws + WS_SSQB), (const float*)d_in[3] + L * D_, (const float*)d_in[7] + (size_t)j * D_ * EIN, KV);
        hipLaunchKernelGGL(chk_even_mix, dim3(24), dim3(128), 0, st, (const float*)out, (const float*)(ws + WS_SSQB), (const float*)d_in[3] + L * D_, (const float*)d_in[7] + (size_t)j * D_ * EIN, (const float*)KV, (const int*)d_in[2],
            (const float*)d_in[9] + j * 64, (const float*)d_in[10] + j * 64, (const float*)d_in[11] + j * 64, (const float*)d_in[12] + j * 64, (const float*)d_in[13] + j * 128, (const float*)d_in[14] + (size_t)j * 3 * 512,
            0.8f - 0.6f * expf(-0.3f * (float)L), (const unsigned short*)(ws + WS_ARENA + AR_PE), (const unsigned short*)(ws + WS_ARENA + AR_AO), (const unsigned short*)(ws + WS_MIX), slots + 256 + 4); }
    (void)odd;
}
static void dbg_after_phase(int ph, unsigned char* ws, float* out, hipStream_t st) {
    unsigned* slots = (unsigned*)(ws + WS_CTL) + CW_DBG; unsigned* sl = slots + ph;
    auto scan = [&](const void* p, size_t n, int f32) { hipLaunchKernelGGL(dbg_scan, dim3(1024), dim3(256), 0, st, p, n, f32, sl); };
    const size_t SD = (size_t)S_ * D_; unsigned char* ar = ws + WS_ARENA;
    if (ph == P_PRO) { scan(ws + WS_HBF, SD, 0); scan(out, SD, 1); scan(ws + WS_PBF, (size_t)4 * S_ * PLE, 0); scan(ws + WS_TAB, (size_t)S_ * 16, 1); scan(ws + WS_W, (size_t)44 * MiB, 0); return; }
    if (ph == P_FINAL) return;
    const int L = (ph - 1) / LPN, lp = (ph - 1) % LPN; const bool odd = L & 1;
    switch (lp) {
    case LP_PROJ: if (!odd) scan(ar + AR_PE, (size_t)S_ * EIN, 0); else { scan(ar + AR_PO, (size_t)S_ * OIN, 0); scan(ws + WS_GB, (size_t)S_ * 16, 1); } scan(ws + WS_PP, SD, 0); break;
    case LP_ROT: scan(ar + AR_PE, (size_t)S_ * EIN, 0); break;
    case LP_ATT: scan(ar + AR_AO, SD, 0); break;
    case LP_MIXPREP: case LP_G3: scan(ws + WS_MIX, SD, 0); break;
    case LP_GA: scan(ar + AR_QN, SD * 5, 0); scan(ws + WS_GB, (size_t)S_ * 16, 1); break;
    case LP_G1: scan(ar + AR_AI, (size_t)NUNIT * 4096, 0); scan(ar + AR_NEGW, SD, 0); scan(ar + AR_UT, SD, 0); scan(ar + AR_UT, (size_t)NUNIT * 16384 * 2, 0); break;
    case LP_G2: scan(ar + AR_SG, (size_t)NUNIT * 16384, 0); break;
    case LP_OUT: case LP_DOWN: case LP_COMB: case LP_PLE: scan(out, SD, 1); scan(ws + WS_HBF, SD, 0); scan(ws + ((lp == LP_PLE) ? WS_SSQB : WS_SSQA), (size_t)S_ * 16, 1); break;
    case LP_UP: scan(ar + AR_ACT, (size_t)S_ * DFF, 0); break;
    case LP_R1: scan(ws + WS_TOK + TOK_G, (size_t)S_ * 2, 1); break;
    default: break; }
}
#endif
#ifndef MK_MULTI
#define MK_MULTI 0
#endif
extern "C" void kernel_launch(void* const* d_in, const int* in_sizes, int n_in, void* d_out, int out_size, void* d_ws, size_t ws_size, hipStream_t stream) {
    static int grid = 0;
    if (grid == 0) {
        if (n_in != 30 || out_size != S_ * D_ || ws_size < WS_NEED) { fprintf(stderr, "kernel_launch: unexpected problem (n_in %d, out %d, ws %zu < %zu)\n", n_in, out_size, ws_size, (size_t)WS_NEED); grid = -1; return; }
        int dev = 0, cus = 0, per_cu = 0;
        if (hipGetDevice(&dev) != hipSuccess || hipDeviceGetAttribute(&cus, hipDeviceAttributeMultiprocessorCount, dev) != hipSuccess) { grid = -1; return; }
        if (hipFuncSetAttribute((const void*)fwd, hipFuncAttributeMaxDynamicSharedMemorySize, LDS_BYTES) != hipSuccess) { fprintf(stderr, "kernel_launch: hipFuncSetAttribute failed\n"); grid = -1; return; }
        if (hipOccupancyMaxActiveBlocksPerMultiprocessor(&per_cu, (const void*)fwd, NWAVES * 64, LDS_BYTES) != hipSuccess || per_cu < 1) { fprintf(stderr, "kernel_launch: occupancy query says %d\n", per_cu); }
        (void)hipGetLastError();
        grid = cus;
#if DBG
        (void)hipFuncSetAttribute((const void*)chk_gdn_rec, hipFuncAttributeMaxDynamicSharedMemorySize, 72 * 1024);
#endif
    }
    if (grid < 0) return;
    (void)hipMemsetAsync((char*)d_ws + WS_CTL, 0, CTL_ZERO_BYTES, stream);
    Args a{};
    for (int i = 0; i < 30; ++i) a.in[i] = d_in[i];
    a.out = (float*)d_out; a.ws = (unsigned char*)d_ws; a.pad = 0;
#if MK_MULTI
    a.use_bar = 0;
    static const int seq_even[] = {LP_PROJ, LP_ATT, LP_MIXPREP, LP_OUT, LP_UP, LP_DOWN, LP_PLE};
    static const int seq_odd[] = {LP_PROJ, LP_GA, LP_G2, LP_G3, LP_OUT, LP_R1, LP_R2, LP_M1, LP_M2, LP_COMB, LP_PLE};
    int plist[64], np = 0; plist[np++] = P_PRO;
    for (int L = 0; L < DEPTH_; ++L) { const bool odd = L & 1; const int n = odd ? 11 : 7; for (int q = 0; q < n; ++q) plist[np++] = 1 + LPN * L + (odd ? seq_odd[q] : seq_even[q]); }
    plist[np++] = P_FINAL;
    for (int pi = 0; pi < np; ++pi) { const int ph = plist[pi];
        a.ph_lo = ph; a.ph_hi = ph + 1;
#if DBG
        dbg_before_phase(ph, (unsigned char*)d_ws, (float*)d_out, stream);
#endif
        hipLaunchKernelGGL(fwd, dim3(grid), dim3(NWAVES * 64), LDS_BYTES, stream, a);
#if DBG
        dbg_after_phase(ph, (unsigned char*)d_ws, (float*)d_out, stream); dbg_checks(ph, d_in, (unsigned char*)d_ws, (float*)d_out, stream);
#endif
    }
#if DBG
    hipLaunchKernelGGL(dbg_fill, dim3(1024), dim3(256), 0, stream, (float*)d_out, (size_t)S_ * D_, (const unsigned*)((unsigned char*)d_ws + WS_CTL) + CW_DBG, P_FINAL + 1);
#endif
#else
    a.use_bar = 1; a.ph_lo = 0; a.ph_hi = P_FINAL + 1;
    hipLaunchKernelGGL(fwd, dim3(grid), dim3(NWAVES * 64), LDS_BYTES, stream, a);
#ifdef PROBE_PH
    for (int i = 0; i < PROBE_N; ++i) { a.use_bar = 0; a.ph_lo = PROBE_PH; a.ph_hi = PROBE_PH + 1; hipLaunchKernelGGL(fwd, dim3(grid), dim3(NWAVES * 64), LDS_BYTES, stream, a); }
#endif
#endif
    const hipError_t le = hipPeekAtLastError();
    if (le != hipSuccess) fprintf(stderr, "kernel_launch: launch failed: %s\n", hipGetErrorName(le));
}
```

```cpp
#include <hip/hip_runtime.h>
#include <hip/hip_bf16.h>
#include <cstdio>
#include <cstdint>
#include <cmath>

constexpr int S_ = 16384, D_ = 1024, DEPTH_ = 4;
constexpr int EIN = 3072, OIN = 4096  , OIN_W = 4096, OIN_ROWS = 4112  , OIN_SRC = 4112, DFF = 3584, NEXP = 8, PLE = 256;
constexpr int MOE_P = 2 * S_ + NEXP * 256;
constexpr int NCHUNK = S_ / 64, NUNIT = NCHUNK * 8;
constexpr float RMS_EPS = 1e-6f;

namespace pg8 {
#define PG8_LAS __attribute__((address_space(3)))
typedef unsigned short bf16_t;
typedef short bf16x8 __attribute__((ext_vector_type(8)));
typedef float f32x4 __attribute__((ext_vector_type(4)));
typedef float f32x2 __attribute__((ext_vector_type(2)));
typedef unsigned u32x4 __attribute__((ext_vector_type(4)));
typedef unsigned u32x2 __attribute__((ext_vector_type(2)));
constexpr int BM = 256, BK = 64, HALF = 128, HTB = HALF * BK * 2, STAGE_BYTES = 8 * HTB, NXCD = 8, WGM = 8;

__host__ __device__ __forceinline__ int lds_byte(int r, int c) { const int st = (r >> 4) * 2 + (c >> 5), rr = r & 15, cc = c & 31, ob = rr * 64 + cc * 2; return st * 1024 + (ob ^ (((ob >> 9) & 1) << 5)); }
__host__ __device__ __forceinline__ void stage_rc(int b, int& R, int& C) { const int st = b / 1024, sb = b % 1024, swz = sb ^ (((sb >> 9) & 1) << 5); R = (st >> 1) * 16 + swz / 64; C = (st & 1) * 32 + (swz % 64) / 2; }
__host__ __device__ __forceinline__ int perm32(int rho) { const int n = rho >> 4, i = rho & 15; return 8 * (i >> 2) + 4 * n + (i & 3); }

struct Unit { int pm, pn, be; };
struct Gemm { const bf16_t* A; const bf16_t* Bt; int M, N, K; size_t bstride; };

struct StaticOrder {
    int nM, nN, nwg, G, c;
    __host__ __device__ void init(int M, int N, int G_, int c_) { nM = M / BM; nN = N / BM; nwg = nM * nN; G = G_; c = c_; }
    __host__ __device__ bool next(int i, Unit& u) const {
        const long L = (long)i * G + c; if (L >= nwg) return false;
        int wgid = (int)L; { const int q = nwg / NXCD, r = nwg % NXCD, xcd = wgid % NXCD, off = wgid / NXCD; wgid = (xcd < r ? xcd * (q + 1) : r * (q + 1) + (xcd - r) * q) + off; }
        const int nig = WGM * nN, gid = wgid / nig, fm = gid * WGM, gsz = (nM - fm) < WGM ? (nM - fm) : WGM;
        u.pm = fm + ((wgid % nig) % gsz); u.pn = (wgid % nig) / gsz; u.be = 0; return true;
    }
    __device__ __forceinline__ void a_ready(const Unit&) const {}
    __device__ __forceinline__ void done(const Unit&) const {}
};
struct MoeOrder : StaticOrder {
    const PG8_LAS int* blk_e;
    __device__ __forceinline__ bool next(int i, Unit& u) const { if (!StaticOrder::next(i, u)) return false; u.be = blk_e[u.pm]; return true; }
};

__device__ __forceinline__ unsigned cvt_pk_bf16(float lo, float hi) { unsigned r; asm volatile("v_cvt_pk_bf16_f32 %0, %1, %2" : "=v"(r) : "v"(lo), "v"(hi)); return r; }
typedef __bf16 bf16x2_t_ __attribute__((ext_vector_type(2)));
__device__ __forceinline__ unsigned cvt_pk_bf16_cv(float lo, float hi) { const f32x2 v = {lo, hi}; const bf16x2_t_ b = __builtin_convertvector(v, bf16x2_t_); return __builtin_bit_cast(unsigned, b); }
__device__ __forceinline__ float bf_lo(unsigned w) { return __uint_as_float(w << 16); }
__device__ __forceinline__ float bf_hi(unsigned w) { return __uint_as_float(w & 0xffff0000u); }

__device__ __forceinline__ float rstd_row(const float* ssq, int row) {
    const f32x4* p = (const f32x4*)(ssq + (size_t)row * 16);
    const f32x4 a = p[0], b = p[1], c = p[2], d = p[3];
    const float s = (((a[0] + a[1]) + (a[2] + a[3])) + ((b[0] + b[1]) + (b[2] + b[3]))) + (((c[0] + c[1]) + (c[2] + c[3])) + ((d[0] + d[1]) + (d[2] + d[3])));
    return __builtin_amdgcn_rsqf(s * (1.0f / 1024.0f) + RMS_EPS);
}
__device__ __forceinline__ float sigmoidf_(float x) { return __builtin_amdgcn_rcpf(1.0f + __builtin_amdgcn_exp2f(-1.4426950408889634f * x)); }
__device__ __forceinline__ float siluf_(float x) { return x * sigmoidf_(x); }

constexpr float C2 = 0.125f * 1.4426950408889634f;

struct EpiProjEven {
    static constexpr bool PERM = true, AFTER_DRAIN = false;
    bf16_t* O; const float* ssq; const float* tab;
    __device__ __forceinline__ void operator()(const f32x4 (&acc)[2][2][4][2], const Unit& u, int wr, int wc, int fr, int fq) const {
        const int row0 = u.pm * BM + wr * 64 + fr, colt = u.pn * BM;
        const bool rot = (colt < 1024) && ((wc & 1) == 0);
        const float qs = (colt < 512) ? C2 : 1.0f;
#pragma unroll
        for (int ai = 0; ai < 2; ++ai)
#pragma unroll
            for (int m = 0; m < 4; ++m) {
                const int row = row0 + ai * HALF + m * 16; const float rs = rstd_row(ssq, row);
                f32x4 c0 = {1.f, 1.f, 1.f, 1.f}, c1 = c0, s0 = {0.f, 0.f, 0.f, 0.f}, s1 = s0;
                if (rot && fq < 2) { const f32x4* t = (const f32x4*)(tab + (size_t)row * 16); c0 = t[0]; c1 = t[1]; s0 = t[2]; s1 = t[3]; if (fq == 0) { s0 = -s0; s1 = -s1; } }
#pragma unroll
                for (int bj = 0; bj < 2; ++bj) {
                    f32x4 v0 = acc[ai][bj][m][0] * rs, v1 = acc[ai][bj][m][1] * rs;
                    if (rot) {
                        f32x4 p0, p1;
#pragma unroll
                        for (int i = 0; i < 4; ++i) { p0[i] = __shfl_xor(v0[i], 16); p1[i] = __shfl_xor(v1[i], 16); }
                        v0 = v0 * c0 + p0 * s0; v1 = v1 * c1 + p1 * s1;
                    }
                    v0 = v0 * qs; v1 = v1 * qs;
                    u32x4 w; w.x = cvt_pk_bf16(v0[0], v0[1]); w.y = cvt_pk_bf16(v0[2], v0[3]); w.z = cvt_pk_bf16(v1[0], v1[1]); w.w = cvt_pk_bf16(v1[2], v1[3]);
                    *(u32x4*)(O + (size_t)row * EIN + colt + bj * HALF + wc * 32 + 8 * fq) = w;
                }
                asm volatile("" ::: "memory");
            }
    }
};
struct EpiBf16 {
    static constexpr bool PERM = true, AFTER_DRAIN = false;
    bf16_t* O; int ldc; const float* ssq; float scale0; int scale_cols;
    __device__ __forceinline__ void operator()(const f32x4 (&acc)[2][2][4][2], const Unit& u, int wr, int wc, int fr, int fq) const {
        const int row0 = u.pm * BM + wr * 64 + fr, colt = u.pn * BM;
#pragma unroll
        for (int ai = 0; ai < 2; ++ai)
#pragma unroll
            for (int m = 0; m < 4; ++m) {
                const int row = row0 + ai * HALF + m * 16; const float rs = (ssq ? rstd_row(ssq, row) : 1.0f) * (colt < scale_cols ? scale0 : 1.0f);
#pragma unroll
                for (int bj = 0; bj < 2; ++bj) {
                    const f32x4 v0 = acc[ai][bj][m][0] * rs, v1 = acc[ai][bj][m][1] * rs;
                    u32x4 w; w.x = cvt_pk_bf16(v0[0], v0[1]); w.y = cvt_pk_bf16(v0[2], v0[3]); w.z = cvt_pk_bf16(v1[0], v1[1]); w.w = cvt_pk_bf16(v1[2], v1[3]);
                    *(u32x4*)(O + (size_t)row * ldc + colt + bj * HALF + wc * 32 + 8 * fq) = w;
                }
                if (m & 1) asm volatile("" ::: "memory");
            }
    }
};
struct EpiSwiglu {
    static constexpr bool PERM = true, AFTER_DRAIN = false;
    bf16_t* O; const float* ssq;
    __device__ __forceinline__ void operator()(const f32x4 (&acc)[2][2][4][2], const Unit& u, int wr, int wc, int fr, int fq) const {
        const int row0 = u.pm * BM + wr * 64 + fr, col = u.pn * HALF + wc * 32 + 8 * fq;
#pragma unroll
        for (int ai = 0; ai < 2; ++ai)
#pragma unroll
            for (int m = 0; m < 4; ++m) {
                const int row = row0 + ai * HALF + m * 16; const float rs = ssq ? rstd_row(ssq, row) : 1.0f;
                float o[8];
#pragma unroll
                for (int n = 0; n < 2; ++n)
#pragma unroll
                    for (int i = 0; i < 4; ++i) { const float a = acc[ai][0][m][n][i] * rs, b = acc[ai][1][m][n][i] * rs; o[4 * n + i] = siluf_(a) * b; }
                u32x4 w; w.x = cvt_pk_bf16(o[0], o[1]); w.y = cvt_pk_bf16(o[2], o[3]); w.z = cvt_pk_bf16(o[4], o[5]); w.w = cvt_pk_bf16(o[6], o[7]);
                *(u32x4*)(O + (size_t)row * DFF + col) = w;
                if (m & 1) asm volatile("" ::: "memory");
            }
    }
};
struct EpiResid {
    static constexpr bool PERM = true, AFTER_DRAIN = false;
    bf16_t* hb; float* ssq;
    __device__ __forceinline__ void operator()(const f32x4 (&acc)[2][2][4][2], const Unit& u, int wr, int wc, int fr, int fq) const {
        const int row0 = u.pm * BM + wr * 64 + fr, colt = u.pn * BM;
#pragma unroll
        for (int ai = 0; ai < 2; ++ai)
#pragma unroll
            for (int m = 0; m < 4; ++m) {
                const int row = row0 + ai * HALF + m * 16; float ss = 0.f;
#pragma unroll
                for (int bj = 0; bj < 2; ++bj) {
                    const size_t off = (size_t)row * D_ + colt + bj * HALF + wc * 32 + 8 * fq;
                    const u32x4 hv = *(const u32x4*)(hb + off);
                    f32x4 x0 = {bf_lo(hv.x), bf_hi(hv.x), bf_lo(hv.y), bf_hi(hv.y)}, x1 = {bf_lo(hv.z), bf_hi(hv.z), bf_lo(hv.w), bf_hi(hv.w)};
                    x0 = x0 + acc[ai][bj][m][0]; x1 = x1 + acc[ai][bj][m][1];
                    ss += (x0[0] * x0[0] + x0[1] * x0[1]) + (x0[2] * x0[2] + x0[3] * x0[3]) + (x1[0] * x1[0] + x1[1] * x1[1]) + (x1[2] * x1[2] + x1[3] * x1[3]);
                    u32x4 w; w.x = cvt_pk_bf16(x0[0], x0[1]); w.y = cvt_pk_bf16(x0[2], x0[3]); w.z = cvt_pk_bf16(x1[0], x1[1]); w.w = cvt_pk_bf16(x1[2], x1[3]);
                    *(u32x4*)(hb + off) = w;
                }
                ss += __shfl_xor(ss, 16); ss += __shfl_xor(ss, 32);
                if (fq == 0) ssq[(size_t)row * 16 + u.pn * 4 + wc] = ss;
                asm volatile("" ::: "memory");
            }
    }
};
struct EpiPle {
    static constexpr bool PERM = true, AFTER_DRAIN = false;
    bf16_t* hb; const float* ssq_in; float* ssq_out; const bf16_t* pp;
    __device__ __forceinline__ void operator()(const f32x4 (&acc)[2][2][4][2], const Unit& u, int wr, int wc, int fr, int fq) const {
        const int row0 = u.pm * BM + wr * 64 + fr, colt = u.pn * BM;
#pragma unroll
        for (int ai = 0; ai < 2; ++ai)
#pragma unroll
            for (int m = 0; m < 4; ++m) {
                const int row = row0 + ai * HALF + m * 16; const float rs = rstd_row(ssq_in, row); float ss = 0.f;
#pragma unroll
                for (int bj = 0; bj < 2; ++bj) {
                    const size_t off = (size_t)row * D_ + colt + bj * HALF + wc * 32 + 8 * fq;
                    const u32x4 hv = *(const u32x4*)(hb + off); const u32x4 pw = *(const u32x4*)(pp + off);
                    f32x4 x0 = {bf_lo(hv.x), bf_hi(hv.x), bf_lo(hv.y), bf_hi(hv.y)}, x1 = {bf_lo(hv.z), bf_hi(hv.z), bf_lo(hv.w), bf_hi(hv.w)};
                    const f32x4 a0 = acc[ai][bj][m][0] * rs, a1 = acc[ai][bj][m][1] * rs;
                    x0[0] += sigmoidf_(a0[0]) * bf_lo(pw.x); x0[1] += sigmoidf_(a0[1]) * bf_hi(pw.x); x0[2] += sigmoidf_(a0[2]) * bf_lo(pw.y); x0[3] += sigmoidf_(a0[3]) * bf_hi(pw.y);
                    x1[0] += sigmoidf_(a1[0]) * bf_lo(pw.z); x1[1] += sigmoidf_(a1[1]) * bf_hi(pw.z); x1[2] += sigmoidf_(a1[2]) * bf_lo(pw.w); x1[3] += sigmoidf_(a1[3]) * bf_hi(pw.w);
                    ss += (x0[0] * x0[0] + x0[1] * x0[1]) + (x0[2] * x0[2] + x0[3] * x0[3]) + (x1[0] * x1[0] + x1[1] * x1[1]) + (x1[2] * x1[2] + x1[3] * x1[3]);
                    u32x4 w; w.x = cvt_pk_bf16(x0[0], x0[1]); w.y = cvt_pk_bf16(x0[2], x0[3]); w.z = cvt_pk_bf16(x1[0], x1[1]); w.w = cvt_pk_bf16(x1[2], x1[3]);
                    *(u32x4*)(hb + off) = w;
                }
                ss += __shfl_xor(ss, 16); ss += __shfl_xor(ss, 32);
                if (fq == 0) ssq_out[(size_t)row * 16 + u.pn * 4 + wc] = ss;
                asm volatile("" ::: "memory");
            }
    }
};
struct EpiMoeDown {
    static constexpr bool PERM = true, AFTER_DRAIN = false;
    bf16_t* Y; const float* gate;
    __device__ __forceinline__ void operator()(const f32x4 (&acc)[2][2][4][2], const Unit& u, int wr, int wc, int fr, int fq) const {
        const int row0 = u.pm * BM + wr * 64 + fr, colt = u.pn * BM;
#pragma unroll
        for (int ai = 0; ai < 2; ++ai)
#pragma unroll
            for (int m = 0; m < 4; ++m) {
                const int row = row0 + ai * HALF + m * 16; const float gt = gate[row];
#pragma unroll
                for (int bj = 0; bj < 2; ++bj) {
                    const f32x4 v0 = acc[ai][bj][m][0] * gt, v1 = acc[ai][bj][m][1] * gt;
                    u32x4 w; w.x = cvt_pk_bf16(v0[0], v0[1]); w.y = cvt_pk_bf16(v0[2], v0[3]); w.z = cvt_pk_bf16(v1[0], v1[1]); w.w = cvt_pk_bf16(v1[2], v1[3]);
                    *(u32x4*)(Y + (size_t)row * D_ + colt + bj * HALF + wc * 32 + 8 * fq) = w;
                }
                if (m & 1) asm volatile("" ::: "memory");
            }
    }
};

template <class Epi, class Sched, bool ALIGN_EPI = false, bool SP2 = false>
__device__ __forceinline__ void gemm_phase(PG8_LAS unsigned char* lds, const Gemm g, const Sched& S, const Epi& E) {
    int tid_ = threadIdx.x; asm volatile("" : "+v"(tid_));
    const int tid = tid_, wid = __builtin_amdgcn_readfirstlane(tid >> 6), lane = tid & 63, wr = wid >> 2, wc = wid & 3, fr = lane & 15, fq = lane >> 4;
    const int K = g.K, nt = K / BK;
    unsigned voffA[2], voffB[2];
#pragma unroll
    for (int i = 0; i < 2; ++i) { int R, C; stage_rc(tid * 16 + i * 8192, R, C); const int Rb = Epi::PERM ? ((R & ~31) + perm32(R & 31)) : R;
        voffA[i] = (unsigned)(R * K + C) * 2u; voffB[i] = (unsigned)(Rb * K + C) * 2u; }
    const size_t kstep = (size_t)(BK * 2);
    const size_t hstep = (size_t)HALF * K * 2;
    const size_t tstep = 2 * hstep;
    const unsigned ldsw = (unsigned)wid * 1024u;
    const int aoff = lds_byte(wr * 64 + fr, fq * 8), boff = lds_byte(wc * 32 + fr, fq * 8);
#define PG8_SA(b, h) (((b) * 2 + (h)) * HTB)
#define PG8_SB(b, h) ((4 + (b) * 2 + (h)) * HTB)
#define PG8_STAGE(bufoff, gbase, voff) do { _Pragma("unroll") for (int _i = 0; _i < 2; ++_i) \
        __builtin_amdgcn_global_load_lds((const unsigned*)((const char*)(gbase) + (voff)[_i]), (PG8_LAS unsigned*)(lds + (bufoff) + ldsw + _i * 8192), 16, 0, 0); } while (0)
#define PG8_LDA(dst, b, h) do { _Pragma("unroll") for (int m = 0; m < 4; ++m) _Pragma("unroll") for (int k = 0; k < 2; ++k) dst[m][k] = *(const PG8_LAS bf16x8*)(lds + PG8_SA(b, h) + aoff + m * 2048 + k * 1024); } while (0)
#define PG8_LDB(dst, b, h) do { _Pragma("unroll") for (int n = 0; n < 2; ++n) _Pragma("unroll") for (int k = 0; k < 2; ++k) dst[n][k] = *(const PG8_LAS bf16x8*)(lds + PG8_SB(b, h) + boff + n * 2048 + k * 1024); } while (0)
#define PG8_MMA(ai, bj, At, Bt) do { __builtin_amdgcn_s_setprio(1); _Pragma("unroll") for (int m = 0; m < 4; ++m) _Pragma("unroll") for (int n = 0; n < 2; ++n) _Pragma("unroll") for (int k = 0; k < 2; ++k) \
        acc[ai][bj][m][n] = __builtin_amdgcn_mfma_f32_16x16x32_bf16(Bt[n][k], At[m][k], acc[ai][bj][m][n], 0, 0, 0); __builtin_amdgcn_s_setprio(0); } while (0)
#define PG8_WAIT_V(n) asm volatile("s_waitcnt vmcnt(" #n ")" ::: "memory")
#define PG8_WAIT_L(n) asm volatile("s_waitcnt lgkmcnt(" #n ")" ::: "memory")
#define PG8_BAR __builtin_amdgcn_s_barrier()
#define PG8_SCHED __builtin_amdgcn_sched_barrier(0)
    Unit cur, nxt; int ui = 0;
    if (!S.next(0, cur)) return;
    f32x4 acc[2][2][4][2];
#pragma unroll
    for (int a = 0; a < 2; ++a)
#pragma unroll
        for (int b = 0; b < 2; ++b)
#pragma unroll
            for (int m = 0; m < 4; ++m)
#pragma unroll
                for (int n = 0; n < 2; ++n) acc[a][b][m][n] = (f32x4){0.f, 0.f, 0.f, 0.f};
    bf16x8 At[4][2], B0[2][2], B1[2][2];
    const char* cA = (const char*)g.A + (size_t)cur.pm * tstep; const char* cB = (const char*)g.Bt + (size_t)cur.pn * tstep + (size_t)cur.be * g.bstride;
    S.a_ready(cur);
    if constexpr (SP2) {
        PG8_STAGE(PG8_SB(0, 0), cB, voffB); PG8_STAGE(PG8_SB(0, 1), cB + hstep, voffB); PG8_STAGE(PG8_SA(0, 0), cA, voffA); PG8_STAGE(PG8_SA(0, 1), cA + hstep, voffA);
        if (wr == 1) PG8_BAR;
        PG8_WAIT_V(2); PG8_BAR;
        PG8_STAGE(PG8_SB(1, 0), cB + kstep, voffB); PG8_STAGE(PG8_SA(1, 0), cA + kstep, voffA); PG8_STAGE(PG8_SB(1, 1), cB + hstep + kstep, voffB);
        PG8_WAIT_V(6); PG8_BAR;
    } else {
        PG8_STAGE(PG8_SB(0, 0), cB, voffB); PG8_STAGE(PG8_SA(0, 0), cA, voffA); PG8_STAGE(PG8_SB(0, 1), cB + hstep, voffB); PG8_STAGE(PG8_SA(0, 1), cA + hstep, voffA);
        if (wr == 1) PG8_BAR;
        PG8_WAIT_V(4); PG8_BAR;
        PG8_STAGE(PG8_SB(1, 0), cB + kstep, voffB); PG8_STAGE(PG8_SA(1, 0), cA + kstep, voffA); PG8_STAGE(PG8_SB(1, 1), cB + hstep + kstep, voffB);
        PG8_WAIT_V(6); PG8_BAR;
    }
    for (;;) {
        const bool has_next = S.next(ui + 1, nxt);
        const char* nA = has_next ? (const char*)g.A + (size_t)nxt.pm * tstep : cA; const char* nB = has_next ? (const char*)g.Bt + (size_t)nxt.pn * tstep + (size_t)nxt.be * g.bstride : cB;
        for (int t = 0; t < nt; t += 2) {
            const bool last = (t == nt - 2);
            const char* a1 = cA + (size_t)(t + 1) * kstep;
            const char* a2 = last ? nA : cA + (size_t)(t + 2) * kstep; const char* b2 = last ? nB : cB + (size_t)(t + 2) * kstep;
            const char* a3 = a2 + kstep; const char* b3 = b2 + kstep;
            if (last && has_next) S.a_ready(nxt);
            if constexpr (SP2) {
            PG8_LDB(B0, 0, 0); PG8_LDB(B1, 0, 1); PG8_SCHED; PG8_LDA(At, 0, 0); PG8_STAGE(PG8_SA(1, 1), a1 + hstep, voffA);
            PG8_WAIT_V(8); PG8_WAIT_L(0); PG8_BAR; PG8_MMA(0, 0, At, B0); PG8_MMA(0, 1, At, B1); PG8_BAR; PG8_SCHED;
            PG8_LDA(At, 0, 1); PG8_STAGE(PG8_SB(0, 0), b2, voffB); PG8_STAGE(PG8_SB(0, 1), b2 + hstep, voffB); PG8_STAGE(PG8_SA(0, 0), a2, voffA);
            PG8_WAIT_V(8); PG8_WAIT_L(0); PG8_BAR; PG8_MMA(1, 0, At, B0); PG8_MMA(1, 1, At, B1); PG8_BAR; PG8_SCHED;
            PG8_LDB(B0, 1, 0); PG8_LDB(B1, 1, 1); PG8_SCHED; PG8_LDA(At, 1, 0); PG8_STAGE(PG8_SA(0, 1), a2 + hstep, voffA);
            PG8_WAIT_V(8); PG8_WAIT_L(0); PG8_BAR; PG8_MMA(0, 0, At, B0); PG8_MMA(0, 1, At, B1); PG8_BAR; PG8_SCHED;
            PG8_LDA(At, 1, 1); PG8_STAGE(PG8_SB(1, 0), b3, voffB); PG8_STAGE(PG8_SB(1, 1), b3 + hstep, voffB); PG8_STAGE(PG8_SA(1, 0), a3, voffA);
            PG8_WAIT_V(8); PG8_WAIT_L(0); PG8_BAR; PG8_MMA(1, 0, At, B0); PG8_MMA(1, 1, At, B1); PG8_BAR; PG8_SCHED;
            } else {
            PG8_LDB(B0, 0, 0); PG8_SCHED; PG8_LDA(At, 0, 0); PG8_STAGE(PG8_SA(1, 1), a1 + hstep, voffA);
            PG8_WAIT_L(8); PG8_BAR; PG8_WAIT_L(0); PG8_MMA(0, 0, At, B0); PG8_BAR; PG8_SCHED;
            PG8_LDB(B1, 0, 1); PG8_STAGE(PG8_SB(0, 0), b2, voffB);
            PG8_BAR; PG8_WAIT_L(0); PG8_MMA(0, 1, At, B1); PG8_BAR;
            PG8_LDA(At, 0, 1); PG8_STAGE(PG8_SA(0, 0), a2, voffA);
            PG8_BAR; PG8_WAIT_L(0); PG8_MMA(1, 0, At, B0); PG8_BAR; PG8_SCHED;
            PG8_STAGE(PG8_SB(0, 1), b2 + hstep, voffB);
            PG8_WAIT_V(6); PG8_BAR; PG8_MMA(1, 1, At, B1); PG8_BAR;
            PG8_LDB(B0, 1, 0); PG8_SCHED; PG8_LDA(At, 1, 0); PG8_STAGE(PG8_SA(0, 1), a2 + hstep, voffA);
            PG8_WAIT_L(8); PG8_BAR; PG8_WAIT_L(0); PG8_MMA(0, 0, At, B0); PG8_BAR; PG8_SCHED;
            PG8_LDB(B1, 1, 1); PG8_STAGE(PG8_SB(1, 0), b3, voffB);
            PG8_BAR; PG8_WAIT_L(0); PG8_MMA(0, 1, At, B1); PG8_BAR;
            PG8_LDA(At, 1, 1); PG8_STAGE(PG8_SA(1, 0), a3, voffA);
            PG8_BAR; PG8_WAIT_L(0); PG8_MMA(1, 0, At, B0); PG8_BAR; PG8_SCHED;
            PG8_STAGE(PG8_SB(1, 1), b3 + hstep, voffB);
            PG8_WAIT_V(6); PG8_BAR; PG8_MMA(1, 1, At, B1); PG8_BAR;
            }
        }
        if constexpr (ALIGN_EPI) { if (wr == 0) PG8_BAR; }
        if constexpr (!Epi::AFTER_DRAIN) { E(acc, cur, wr, wc, fr, fq); S.done(cur); }
        if (!has_next) break;
#pragma unroll
        for (int a = 0; a < 2; ++a)
#pragma unroll
            for (int b = 0; b < 2; ++b)
#pragma unroll
                for (int m = 0; m < 4; ++m)
#pragma unroll
                    for (int n = 0; n < 2; ++n) acc[a][b][m][n] = (f32x4){0.f, 0.f, 0.f, 0.f};
        cur = nxt; cA = nA; cB = nB; ++ui;
        if constexpr (ALIGN_EPI) { if (wr == 1) PG8_BAR; }
    }
    PG8_WAIT_V(0);
    if constexpr (!ALIGN_EPI) { if (wr == 0) PG8_BAR; }
    PG8_BAR;
    if constexpr (Epi::AFTER_DRAIN) { E.fused(acc, cur, wr, wc, fr, fq, lds, wid, lane); S.done(cur); }
#undef PG8_SA
#undef PG8_SB
#undef PG8_STAGE
#undef PG8_LDA
#undef PG8_LDB
#undef PG8_MMA
#undef PG8_WAIT_V
#undef PG8_WAIT_L
#undef PG8_BAR
#undef PG8_SCHED
}
}

#include <hip/hip_bf16.h>
#include <cmath>
namespace attn_body {
using bf16=__hip_bfloat16;
using bf16x8=__attribute__((ext_vector_type(8)))short;
using s16x4=__attribute__((ext_vector_type(4)))short;
using f32x16=__attribute__((ext_vector_type(16)))float;
using u32x4=__attribute__((ext_vector_type(4)))unsigned;
constexpr int SEQ=16384,D=64,LDP=3072,LDO=1024;
constexpr int NW=8,QBLK=32,QB=QBLK*NW,KVBLK=64,NQB=SEQ/QB;
constexpr int ATTN_UNIT_ROWS=QB;
__device__ __forceinline__ int crow(int r,int hi){return (r&3)+8*(r>>2)+4*hi;}
#define SBAR() __builtin_amdgcn_sched_barrier(0)
__device__ __forceinline__ void cmask(f32x16&p0,f32x16&p1,int jb,int qrel,int hi){
  const float NEG=-INFINITY; int kb=64*jb+4*hi;
  #pragma unroll
  for(int r=0;r<16;++r){int kv=kb+(r&3)+8*(r>>2); if(kv>qrel)p0[r]=NEG; if(kv+32>qrel)p1[r]=NEG;}
}

constexpr int NSLOT=3, SLOTB=8192, VSLOTB=2*SLOTB;
constexpr int LDS_K=0, LDS_V=NSLOT*SLOTB, LDS_WS=LDS_V+NSLOT*VSLOTB, LDS_OST=0  , LDS_BYTES=LDS_WS+NW*64*4;
constexpr float C2=0.125f*1.4426950408889634f;
__device__ __forceinline__ void glds16(const void*gsrc,unsigned lds_dst){unsigned keep;
  asm volatile("s_mov_b32 %0, m0\n\ts_mov_b32 m0, %2\n\ts_nop 0\n\tglobal_load_lds_dwordx4 %1, off\n\ts_mov_b32 m0, %0":"=&s"(keep):"v"(gsrc),"s"(lds_dst):"memory");}
__device__ __forceinline__ float max3f(float a,float b,float c){float r;asm("v_max3_f32 %0, %1, %2, %3":"=v"(r):"v"(a),"v"(b),"v"(c));return r;}
__device__ __forceinline__ float max2f(float a,float b){float r;asm("v_max_f32_e32 %0, %1, %2":"=v"(r):"v"(a),"v"(b));return r;}
__device__ __forceinline__ float fadd_s(float a,float b){float r;asm("v_add_f32_e32 %0, %1, %2":"=v"(r):"v"(a),"v"(b));return r;}
__device__ __forceinline__ float fsub_s(float a,float b){float r;asm("v_sub_f32_e32 %0, %1, %2":"=v"(r):"v"(a),"v"(b));return r;}
typedef float f32x2_t __attribute__((ext_vector_type(2))); typedef __bf16 bf16x2_t __attribute__((ext_vector_type(2)));
__device__ __forceinline__ unsigned cvtpk_s(float lo,float hi){f32x2_t v={lo,hi};bf16x2_t b=__builtin_convertvector(v,bf16x2_t);return __builtin_bit_cast(unsigned,b);}
#define WAIT_BAR(N) asm volatile("s_waitcnt vmcnt(" #N ") lgkmcnt(0)\n\ts_barrier":::"memory")

__device__ __forceinline__ void qkt(f32x16&p0,f32x16&p1,const char*Kslot,const bf16x8*qr,int r32,int hi){
  const char*kb=Kslot+hi*1024+r32*16;
  #pragma unroll
  for(int d0=0;d0<4;++d0){
    const bf16x8 b0=*reinterpret_cast<const bf16x8*>(kb+d0*2048);
    const bf16x8 b1=*reinterpret_cast<const bf16x8*>(kb+d0*2048+512);
    if(d0==0){p0=__builtin_amdgcn_mfma_f32_32x32x16_bf16(b0,qr[0],f32x16{},0,0,0);p1=__builtin_amdgcn_mfma_f32_32x32x16_bf16(b1,qr[0],f32x16{},0,0,0);}
    else{p0=__builtin_amdgcn_mfma_f32_32x32x16_bf16(b0,qr[d0],p0,0,0,0);p1=__builtin_amdgcn_mfma_f32_32x32x16_bf16(b1,qr[d0],p1,0,0,0);}}
}
typedef __attribute__((address_space(3))) const char* lds_cptr;
typedef short v4i16_t __attribute__((ext_vector_type(4)));
__device__ __forceinline__ void kload8(bf16x8*kf,lds_cptr kp){
  kf[0]=*(const __attribute__((address_space(3))) bf16x8*)(kp);      kf[1]=*(const __attribute__((address_space(3))) bf16x8*)(kp+512);
  kf[2]=*(const __attribute__((address_space(3))) bf16x8*)(kp+2048); kf[3]=*(const __attribute__((address_space(3))) bf16x8*)(kp+2560);
  kf[4]=*(const __attribute__((address_space(3))) bf16x8*)(kp+4096); kf[5]=*(const __attribute__((address_space(3))) bf16x8*)(kp+4608);
  kf[6]=*(const __attribute__((address_space(3))) bf16x8*)(kp+6144); kf[7]=*(const __attribute__((address_space(3))) bf16x8*)(kp+6656);
}
__device__ __forceinline__ void kload2(bf16x8*kf,lds_cptr kp,int j){ kf[2*j]=*(const __attribute__((address_space(3))) bf16x8*)(kp+j*2048); kf[2*j+1]=*(const __attribute__((address_space(3))) bf16x8*)(kp+j*2048+512); }
__device__ __forceinline__ s16x4 vtr(lds_cptr p){ return __builtin_bit_cast(s16x4,__builtin_amdgcn_ds_read_tr16_b64_v4i16((__attribute__((address_space(3))) v4i16_t*)p)); }
__device__ __forceinline__ float rowmax(const f32x16&p0,const f32x16&p1){
  float a=max3f(p0[0],p0[1],p1[0]),b=max3f(p0[2],p0[3],p1[1]);a=max3f(a,p1[2],p1[3]);
  #pragma unroll
  for(int r=4;r<16;r+=4){a=max3f(a,p0[r],p0[r+1]);b=max3f(b,p0[r+2],p0[r+3]);a=max3f(a,p1[r],p1[r+1]);b=max3f(b,p1[r+2],p1[r+3]);}
  const float m=max2f(a,b);
  auto rr=__builtin_amdgcn_permlane32_swap(__float_as_uint(m),__float_as_uint(m),false,false);
  return max2f(__uint_as_float(rr[0]),__uint_as_float(rr[1]));
}
__device__ __forceinline__ void pv(f32x16*o,int vb,bf16x8 pa0,bf16x8 pa1,bf16x8 pa2,bf16x8 pa3){
  #pragma unroll
  for(int d0=0;d0<4;++d0){s16x4 lo[4],hi[4];
    #pragma unroll
    for(int ks=0;ks<4;++ks){
      asm volatile("ds_read_b64_tr_b16 %0,%1 offset:%c2":"=&v"(lo[ks]):"v"(vb),"i"(d0*4096+ks*1024):"memory");
      asm volatile("ds_read_b64_tr_b16 %0,%1 offset:%c2":"=&v"(hi[ks]):"v"(vb),"i"(d0*4096+ks*1024+512):"memory");}
    asm volatile("s_waitcnt lgkmcnt(0)":::"memory");SBAR();
    #define PK(k) (bf16x8){lo[k][0],lo[k][1],lo[k][2],lo[k][3],hi[k][0],hi[k][1],hi[k][2],hi[k][3]}
    o[d0]=__builtin_amdgcn_mfma_f32_32x32x16_bf16(pa0,PK(0),o[d0],0,0,0);
    o[d0]=__builtin_amdgcn_mfma_f32_32x32x16_bf16(pa1,PK(1),o[d0],0,0,0);
    o[d0]=__builtin_amdgcn_mfma_f32_32x32x16_bf16(pa2,PK(2),o[d0],0,0,0);
    o[d0]=__builtin_amdgcn_mfma_f32_32x32x16_bf16(pa3,PK(3),o[d0],0,0,0);
    #undef PK
  }
}

#ifndef ATTN_STORE16
#define ATTN_STORE16(p,v) (*(u32x4*)(p)=(v))
#endif
template<int THRL> __device__ __forceinline__ void attn_unit(int qb,const bf16*Qh,const bf16*__restrict__ Kh,const bf16*__restrict__ Vh,bf16*Oh,char*shm){
  int tid_=threadIdx.x; asm volatile("":"+v"(tid_));
  const int tid=tid_,lane=tid&63,r32=lane&31,hi=lane>>5; const int wid=__builtin_amdgcn_readfirstlane(tid>>6);
  const int q0=qb*QB;
  const bf16*Qw=Qh+(long)(q0+wid*QBLK)*LDP;
  const unsigned lds0=(unsigned)(uintptr_t)shm;
  float*wsf=(float*)(shm+LDS_WS)+wid*64;
  const bf16*ksrc=Kh+(long)lane*LDP+wid*8;
  const bf16*vsrc=Vh+(long)(16*(wid&3)+(lane>>2))*LDP+(wid>>2)*32+(lane&3)*8;
  const unsigned kdst=lds0+LDS_K+wid*1024, vdst=lds0+LDS_V+wid*1024;
  #define DMA_K(t,slot) glds16(ksrc+(long)(t)*KVBLK*LDP,(unsigned)__builtin_amdgcn_readfirstlane(kdst+(slot)))
  #define DMA_V(t,slot) do{ glds16(vsrc+(long)(t)*KVBLK*LDP,(unsigned)__builtin_amdgcn_readfirstlane(vdst+2*(slot))); glds16(vsrc+64+(long)(t)*KVBLK*LDP,(unsigned)__builtin_amdgcn_readfirstlane(vdst+2*(slot)+8192)); }while(0)
  const int vb0=(int)(lds0+LDS_V)+((lane>>4)&1)*32+(lane&3)*8+(4*hi+((lane&15)>>2))*64;
  const char*Kbase=shm+LDS_K; bf16x8 kf[8];
  const lds_cptr shm3=(lds_cptr)shm; const lds_cptr kp0=shm3+LDS_K+hi*1024+r32*16; const lds_cptr vp0=shm3+LDS_V+((lane>>4)&1)*32+(lane&3)*8+(4*hi+((lane&15)>>2))*64;
  const int NT=(q0+QB)/KVBLK;
  DMA_K(0,0);DMA_V(0,0);DMA_K(1,SLOTB);
  bf16x8 qr[4];
  #pragma unroll
  for(int d0=0;d0<4;++d0)qr[d0]=*reinterpret_cast<const bf16x8*>(&Qw[(long)r32*LDP+d0*16+hi*8]);
  float mhat=0.f,l_reg=0.f;f32x16 o[4];o[0]=f32x16{};o[1]=f32x16{};o[2]=f32x16{};o[3]=f32x16{};
  const int qrel=wid*QBLK+r32;
  #define CMASK(P0,P1,t) do{int jb_=(t)-(NT-4); if(jb_>=0)cmask(P0,P1,jb_,qrel,hi);}while(0)
  bool resc=false;
  #define START(P0,P1) do{ const float rm=rowmax(P0,P1); resc=false; mhat=rm; \
    _Pragma("unroll") for(int r=0;r<16;++r)P0[r]=__builtin_amdgcn_exp2f(fsub_s(P0[r],mhat)); }while(0)
  #define RESC() do{ if(resc){ asm volatile("s_waitcnt lgkmcnt(0)":::"memory"); \
      _Pragma("unroll") for(int d_=0;d_<4;++d_) _Pragma("unroll") for(int r=0;r<16;++r)o[d_][r]*=wsf[crow(r,hi)]; } }while(0)
  f32x16 pA0,pA1,pB0,pB1;
  int sl_prev=0,sl_cur=0,sl_next=SLOTB;
  #define ROT() do{sl_prev=sl_cur;sl_cur=sl_next;sl_next=(sl_next==(NSLOT-1)*SLOTB)?0:sl_next+SLOTB;}while(0)
  DMA_K(2,2*SLOTB);
  WAIT_BAR(4);
  qkt(pA0,pA1,Kbase,qr,r32,hi);asm volatile("s_nop 15\n\ts_nop 7":"+v"(pA0),"+v"(pA1));CMASK(pA0,pA1,0);
  START(pA0,pA1);
  _Pragma("unroll") for(int r=0;r<16;++r)pA1[r]=__builtin_amdgcn_exp2f(pA1[r]-mhat);
  WAIT_BAR(0);
  DMA_K(3,0);DMA_V(1,SLOTB);
  ROT();
  kload8(kf,kp0+sl_cur);
  WAIT_BAR(3);
  s16x4 vlo[3],vhi[3]; u32x4 pw0,pw1,pw2,pw3;
  #define PKW(P,B) cvtpk_s(P[B],P[B+1])
  #define PAF(k) __builtin_bit_cast(bf16x8,pw##k)
  #define VFJ(j) (bf16x8){vlo[(j)%3][0],vlo[(j)%3][1],vlo[(j)%3][2],vlo[(j)%3][3],vhi[(j)%3][0],vhi[(j)%3][1],vhi[(j)%3][2],vhi[(j)%3][3]}
  #define PIN(x) asm volatile("":"+v"(x))
  #define MX3(a,b,c) __builtin_fmaxf(__builtin_fmaxf((a),(b)),(c))
  #define GAPA(MF,A0,A1,A2,A3,W0,W1,PW) do{ MF; sacc+=A0; sacc+=A1; sacc+=A2; sacc+=A3; PIN(sacc); W0; W1; PIN(PW); SBAR(); }while(0)
  #define EX(v) __builtin_amdgcn_exp2f(v)
  #define VJ(j) do{ vlo[(j)%3]=vtr(vp_+(((j)&3)*4096+((j)>>2)*1024)); vhi[(j)%3]=vtr(vp_+(((j)&3)*4096+((j)>>2)*1024+512)); }while(0)
  #define PVJ(j,PA,X,B) do{ if((j)+2<16){ VJ((j)+2); SBAR(); } o[(j)&3]=__builtin_amdgcn_mfma_f32_32x32x16_bf16(PA,VFJ(j),o[(j)&3],0,0,0); X[B]=EX(X[B]-mhat); X[B+1]=EX(X[B+1]-mhat); PIN(X); SBAR(); }while(0)
  #define KRD(G,j) do{ if(G){ kload2(kf,kp0+sl_next,j); SBAR(); } }while(0)
  #define STEP(C0,C1,P0,P1,t,GK,GV,GL) do{ SBAR(); \
    const lds_cptr vp_=vp0+2*sl_prev; \
    float sacc=(P0[0]+P0[1]); \
    GAPA(C0=__builtin_amdgcn_mfma_f32_32x32x16_bf16(kf[0],qr[0],f32x16{},0,0,0), P0[2],P0[3],P0[4],P0[5],     pw0[0]=PKW(P0,0), pw0[1]=PKW(P0,2), pw0); \
    GAPA(C1=__builtin_amdgcn_mfma_f32_32x32x16_bf16(kf[1],qr[0],f32x16{},0,0,0), P0[6],P0[7],P0[8],P0[9],     pw0[2]=PKW(P0,4), pw0[3]=PKW(P0,6), pw0); \
    GAPA(C0=__builtin_amdgcn_mfma_f32_32x32x16_bf16(kf[2],qr[1],C0,0,0,0),   P0[10],P0[11],P0[12],P0[13], pw1[0]=PKW(P0,8), pw1[1]=PKW(P0,10), pw1); \
    GAPA(C1=__builtin_amdgcn_mfma_f32_32x32x16_bf16(kf[3],qr[1],C1,0,0,0),   P0[14],P0[15],P1[0],P1[1],   pw1[2]=PKW(P0,12),pw1[3]=PKW(P0,14), pw1); \
    GAPA(C0=__builtin_amdgcn_mfma_f32_32x32x16_bf16(kf[4],qr[2],C0,0,0,0),   P1[2],P1[3],P1[4],P1[5],     pw2[0]=PKW(P1,0), pw2[1]=PKW(P1,2), pw2); \
    GAPA(C1=__builtin_amdgcn_mfma_f32_32x32x16_bf16(kf[5],qr[2],C1,0,0,0),   P1[6],P1[7],P1[8],P1[9],     pw2[2]=PKW(P1,4), pw2[3]=PKW(P1,6), pw2); \
    GAPA(C0=__builtin_amdgcn_mfma_f32_32x32x16_bf16(kf[6],qr[3],C0,0,0,0),   P1[10],P1[11],P1[12],P1[13], pw3[0]=PKW(P1,8), pw3[1]=PKW(P1,10), pw3); \
    GAPA(C1=__builtin_amdgcn_mfma_f32_32x32x16_bf16(kf[7],qr[3],C1,0,0,0),   P1[14],P1[15],0.f,0.f,       pw3[2]=PKW(P1,12),pw3[3]=PKW(P1,14), pw3); \
    l_reg+=sacc; VJ(0); VJ(1); SBAR(); \
 \
    if(GK){DMA_K((t)+3,sl_cur);} if(GV){DMA_V((t)+1,sl_next);} \
    CMASK(C0,C1,t); \
    { float a=MX3(C0[0],C0[1],C1[0]),b=MX3(C0[2],C0[3],C1[1]); a=MX3(a,C1[2],C1[3]); \
      _Pragma("unroll") for(int r=4;r<16;r+=4){a=MX3(a,C0[r],C0[r+1]);b=MX3(b,C0[r+2],C0[r+3]);a=MX3(a,C1[r],C1[r+1]);b=MX3(b,C1[r+2],C1[r+3]);} \
      float rm=__builtin_fmaxf(a,b); { auto rr=__builtin_amdgcn_permlane32_swap(__float_as_uint(rm),__float_as_uint(rm),false,false); rm=__builtin_fmaxf(__uint_as_float(rr[0]),__uint_as_float(rr[1])); } \
      resc=false; const float rel=rm-mhat; \
      if(__builtin_expect(__any(rel>(float)THRL),0)){ const float dl=__builtin_fmaxf(rel,0.f); mhat+=dl; \
        const float f=__builtin_amdgcn_exp2f(-dl); l_reg*=f; if(hi==0)wsf[r32]=f; resc=true; } } \
    SBAR(); \
    PVJ(0, PAF(0),C0,0);  PVJ(1, PAF(0),C0,2);  PVJ(2, PAF(0),C0,4);  PVJ(3, PAF(0),C0,6); \
    KRD(GL,0); PVJ(4, PAF(1),C0,8);  PVJ(5, PAF(1),C0,10); KRD(GL,1); PVJ(6, PAF(1),C0,12); PVJ(7, PAF(1),C0,14); \
    KRD(GL,2); PVJ(8, PAF(2),C1,0);  PVJ(9, PAF(2),C1,2);  KRD(GL,3); PVJ(10,PAF(2),C1,4);  PVJ(11,PAF(2),C1,6); \
    PVJ(12,PAF(3),C1,8);  PVJ(13,PAF(3),C1,10); PVJ(14,PAF(3),C1,12); PVJ(15,PAF(3),C1,14); \
    }while(0)
  int t=1;
  #undef CMASK
  #define CMASK(P0,P1,t) do{}while(0)
  for(;t+5<NT;t+=2){
    STEP(pB0,pB1,pA0,pA1,t,true,true,true);     WAIT_BAR(3); RESC(); ROT();
    STEP(pA0,pA1,pB0,pB1,t+1,true,true,true);   WAIT_BAR(3); RESC(); ROT();
  }
  #undef CMASK
  int hi_b=hi,qrel_b=qrel; asm volatile("":"+v"(hi_b),"+v"(qrel_b));
  #define CMASK(P0,P1,t) do{int jb_=(t)-(NT-4); if(jb_>=0)cmask(P0,P1,jb_,qrel_b,hi_b);}while(0)
  #define ENDW(tt) do{ if((tt)+3<NT){WAIT_BAR(3);} else if((tt)+2<NT){WAIT_BAR(2);} else {WAIT_BAR(0);} }while(0)
  for(;t+1<NT;t+=2){
    STEP(pB0,pB1,pA0,pA1,t,(t+3<NT),(t+1<NT),(t+1<NT));       ENDW(t);   RESC(); ROT();
    STEP(pA0,pA1,pB0,pB1,t+1,(t+4<NT),(t+2<NT),(t+2<NT));     ENDW(t+1); RESC(); ROT();
  }
  STEP(pB0,pB1,pA0,pA1,NT-1,false,false,false); RESC();
  { float sacc=pB0[0]+pB0[1]; _Pragma("unroll") for(int r=2;r<16;++r)sacc+=pB0[r]; _Pragma("unroll") for(int r=0;r<16;++r)sacc+=pB1[r]; l_reg+=sacc;
    pw0=(u32x4){PKW(pB0,0),PKW(pB0,2),PKW(pB0,4),PKW(pB0,6)};pw1=(u32x4){PKW(pB0,8),PKW(pB0,10),PKW(pB0,12),PKW(pB0,14)};pw2=(u32x4){PKW(pB1,0),PKW(pB1,2),PKW(pB1,4),PKW(pB1,6)};pw3=(u32x4){PKW(pB1,8),PKW(pB1,10),PKW(pB1,12),PKW(pB1,14)};
    SBAR(); pv(o,vb0+2*sl_cur,PAF(0),PAF(1),PAF(2),PAF(3)); }
  #undef PKW
  #undef PAF
  #undef VFJ
  #undef VJ
  #undef PVJ
  #undef PIN
  #undef MX3
  #undef GAPA
  #undef EX
  #undef KRD
  #undef STEP
  #undef ENDW
  int lanee=lane; asm volatile("":"+v"(lanee)); const int r32e=lanee&31,hie=lanee>>5;
  {auto rr=__builtin_amdgcn_permlane32_swap(__float_as_uint(l_reg),__float_as_uint(l_reg),false,false);l_reg=__uint_as_float(rr[0])+__uint_as_float(rr[1]);}
  if(hie==0)wsf[32+r32e]=l_reg;asm volatile("s_waitcnt lgkmcnt(0)":::"memory");
  float rli[16];
  #pragma unroll
  for(int r=0;r<16;++r)rli[r]=__builtin_amdgcn_rcpf(wsf[32+crow(r,hie)]);
  bf16*Ow=Oh+(long)(q0+wid*QBLK)*LDO;
  asm volatile("s_waitcnt lgkmcnt(0)\n\ts_barrier":::"memory");
  { bf16*stg=(bf16*)(shm)+wid*4096;
    #pragma unroll
    for(int r=0;r<16;++r){const int orow=crow(r,hie);
      #pragma unroll
      for(int d0=0;d0<4;++d0)stg[orow*128+d0*32+r32e]=__float2bfloat16(o[d0][r]*rli[r]);}
    asm volatile("s_waitcnt lgkmcnt(0)":::"memory");
    #pragma unroll
    for(int i=0;i<8;++i){const int row=i*4+(lanee>>4),ch=lanee&15; const u32x4 v=*(const u32x4*)(stg+row*128+ch*8); ATTN_STORE16(Ow+(long)row*LDO+ch*8,v);} }
  asm volatile("s_waitcnt lgkmcnt(0)\n\ts_barrier":::"memory");
  #undef DMA_K
  #undef DMA_V
  #undef CMASK
  #undef START
  #undef RESC
  #undef ROT
}
constexpr int ATTN_LDS_BYTES=LDS_BYTES;
template<int THRL=8> __device__ __forceinline__ void attn_phase(char*lds,const bf16*PE,bf16*AO,int vcu,int G){
  const int nu=(G==256)?2:((8*NQB-vcu+G-1)/G);
  #pragma unroll 1
  for(int i=0;i<nu;++i){
    int h2,qb;
    if(G==256){ const int s=vcu&31; h2=vcu>>5; qb=(i==0)?s:63-s; }
    else { const int u=vcu+i*G; h2=u/NQB; qb=u%NQB; }
    attn_unit<THRL>(qb,PE+h2*64,PE+512+h2*64,PE+1024+(h2>>1)*128,AO+h2*128,lds);
  }
}
#undef SBAR
#undef WAIT_BAR
}

#define GAS __attribute__((address_space(1)))
#define LAS __attribute__((address_space(3)))
typedef unsigned short bf16;
typedef unsigned v4u __attribute__((ext_vector_type(4)));
typedef float f32x4 __attribute__((ext_vector_type(4)));
typedef short bf16x8 __attribute__((ext_vector_type(8)));
typedef GAS unsigned gu32;
typedef GAS unsigned long long gu64;
#define RLX_AGENT __ATOMIC_RELAXED, __HIP_MEMORY_SCOPE_AGENT
#define LDS_WAIT() asm volatile("s_waitcnt lgkmcnt(0)" ::: "memory")
#define VM_WAIT() asm volatile("s_waitcnt vmcnt(0)" ::: "memory")
__device__ __forceinline__ unsigned long long rt() { return __builtin_amdgcn_s_memrealtime(); }
__device__ __forceinline__ unsigned f2bf(float f) { unsigned u = __builtin_bit_cast(unsigned, f); return (u + 0x7fffu + ((u >> 16) & 1u)) >> 16; }
__device__ __forceinline__ unsigned pk2(float lo, float hi) { return f2bf(lo) | (f2bf(hi) << 16); }

#define XB_TMO      128
#define XB_XCNT(j)  (256  + 64 * (j))
#define XB_XSUB(j)  (1280 + 64 * (j))
#define XB_XGEN(j)  (2304 + 64 * (j))
#define XB_TOP      3328
#define XB_TOPGEN   3392
#define XCD_BAR_WORDS 3456
#define XB_SPIN_CAP (1u << 18)

__device__ __forceinline__ unsigned xb_ld(unsigned* p)              { return __hip_atomic_load(p, __ATOMIC_RELAXED, __HIP_MEMORY_SCOPE_AGENT); }
__device__ __forceinline__ unsigned xb_add(unsigned* p, unsigned v) { return __hip_atomic_fetch_add(p, v, __ATOMIC_RELAXED, __HIP_MEMORY_SCOPE_AGENT); }
__device__ __forceinline__ unsigned xb_xcc_id() { return (unsigned)__builtin_amdgcn_s_getreg((3 << 11) | 20) & 0xFu; }
#define XB_SPIN(cond, bar) do { unsigned _sp = 0; while (cond) { __builtin_amdgcn_s_sleep(1); \
    if ((++_sp & 255u) == 0u) { if (xb_ld(&(bar)[XB_TMO])) break; if (_sp > XB_SPIN_CAP) { atomicAdd(&(bar)[XB_TMO], 1u); break; } } } } while (0)

struct XcdBarrier {
    unsigned* bar; unsigned x;
    volatile LAS unsigned* st;
};

__device__ __forceinline__ XcdBarrier xcd_barrier_post(unsigned* bar, volatile LAS unsigned* st) {
    XcdBarrier b; b.bar = bar; b.x = xb_xcc_id(); b.st = st;
    if (threadIdx.x == 0) (void)xb_add(&bar[XB_XCNT(b.x)], 1u);
    return b;
}
__device__ __forceinline__ void xcd_barrier_complete(unsigned* bar, unsigned x, unsigned& nloc, unsigned& nx) {
    const unsigned G = gridDim.x * gridDim.y * gridDim.z;
    unsigned sum, cnt, mine, sp = 0u;
    for (;;) {
        sum = 0u; cnt = 0u; mine = 0u;
#pragma unroll
        for (unsigned j = 0; j < 16; ++j) { const unsigned c = xb_ld(&bar[XB_XCNT(j)]); sum += c; cnt += (c > 0u) ? 1u : 0u; mine = (j == x) ? c : mine; }
        if (sum == G) break;
        __builtin_amdgcn_s_sleep(1);
        if ((++sp & 255u) == 0u) { if (xb_ld(&bar[XB_TMO])) break; if (sp > XB_SPIN_CAP) { atomicAdd(&bar[XB_TMO], 1u); break; } }
    }
    nloc = mine > 0u ? mine : 1u; nx = cnt > 0u ? cnt : 1u;
}

__device__ __forceinline__ void xcd_barrier(const XcdBarrier& b) {
    asm volatile("s_waitcnt vmcnt(0)" ::: "memory");
    __syncthreads();
    if (threadIdx.x == 0) {
        unsigned* bar = b.bar;
        __builtin_amdgcn_s_waitcnt(0);
        unsigned nloc = b.st[0], nx = b.st[1];
        if (nloc == 0u) { xcd_barrier_complete(bar, b.x, nloc, nx); b.st[0] = nloc; b.st[1] = nx; }
        const unsigned old = xb_add(&bar[XB_XSUB(b.x)], 1u);
        const unsigned gen = old / nloc;
        if (old + 1u == (gen + 1u) * nloc) {
            __builtin_amdgcn_fence(__ATOMIC_RELEASE, "agent");
            asm volatile("s_waitcnt vmcnt(0)" ::: "memory");
            const unsigned og = xb_add(&bar[XB_TOP], 1u);
            const unsigned tg = og / nx;
            if (og + 1u == (tg + 1u) * nx) xb_add(&bar[XB_TOPGEN], 1u);
            else XB_SPIN(xb_ld(&bar[XB_TOPGEN]) == tg, bar);
            __builtin_amdgcn_fence(__ATOMIC_ACQUIRE, "agent");
            xb_add(&bar[XB_XGEN(b.x)], 1u);
            asm volatile("s_waitcnt vmcnt(0)" ::: "memory");
        } else {
            XB_SPIN(xb_ld(&bar[XB_XGEN(b.x)]) == gen, bar);
            __builtin_amdgcn_fence(__ATOMIC_ACQUIRE, "agent");
            asm volatile("s_waitcnt vmcnt(0)" ::: "memory");
        }
    }
    __syncthreads();
}

constexpr int NWAVES = 8;
constexpr size_t MiB = 1u << 20;
constexpr size_t WS_CTL = 0, CTL_ZERO_BYTES = 1 * MiB;
constexpr size_t WS_TAB = 1 * MiB;
constexpr size_t WS_SSQA = 2 * MiB, WS_SSQB = 3 * MiB;
constexpr size_t WS_GB = 4 * MiB;
constexpr size_t WS_GC = 512 * 1024;
constexpr size_t WS_TOK = 5 * MiB;
constexpr size_t WS_W = 6 * MiB;
constexpr size_t WS_WINE = WS_W, WS_WOUTE = WS_W + 12 * MiB, WS_W13D = WS_W + 16 * MiB, WS_W2D = WS_W + 44 * MiB, WS_WINO = WS_W + 58 * MiB  , WS_WOUTO = WS_W + 76 * MiB,
                 WS_WG = WS_W + 80 * MiB, WS_WP = WS_W + 88 * MiB, WS_W13M = WS_W + 90 * MiB, WS_W2M = WS_W + 202 * MiB;
static_assert(WS_W2M + 56 * MiB <= 264 * MiB, "weight copies end below the p copy");
constexpr size_t WS_PBF = 264 * MiB, WS_HBF = 296 * MiB, WS_PP = 328 * MiB, WS_MIX = 360 * MiB, WS_ARENA = 392 * MiB;
constexpr size_t AR_PE = 0, AR_AO = 96 * MiB;
constexpr size_t AR_PO = 0  , AR_QN = 144 * MiB, AR_KN = 176 * MiB, AR_KGT = 208 * MiB, AR_VBT = 240 * MiB, AR_KTT = 272 * MiB, AR_AI = 304 * MiB, AR_NEGW = 320 * MiB, AR_UT = 352 * MiB,
                 AR_SG = 384 * MiB  , AR_MPC = 448 * MiB  , AR_NTC = 464 * MiB, AR_END = 480 * MiB;
constexpr size_t AR_ACT = 0, AR_XS = 240 * MiB, AR_Y = 308 * MiB;
constexpr size_t WS_NEED = WS_ARENA + AR_END;
constexpr size_t TOK_E = 0, TOK_R = 128 * 1024, TOK_G = 256 * 1024, TOK_DST = 384 * 1024, TOK_GPAD = 512 * 1024, TOK_DN = 704 * 1024, TOK_DNC = 720 * 1024;
constexpr int CW_TMO = 0, CW_BAR = 4096, CW_CNT = 8192  , CW_DBG = 12288;

constexpr int RING_OFF = 0, WAVE_LDS = 17408;
constexpr int LDSCTL_OFF = 139264, MISC_OFF = LDSCTL_OFF + 64, BLKE_OFF = LDSCTL_OFF + 256  , RT_OFF = LDSCTL_OFF + 1024  ;
constexpr int LDS_BYTES = 147456;

typedef unsigned u32x2v __attribute__((ext_vector_type(2)));
__device__ __forceinline__ float bflo(unsigned w) { return __uint_as_float(w << 16); }
__device__ __forceinline__ float bfhi(unsigned w) { return __uint_as_float(w & 0xffff0000u); }
__device__ __forceinline__ unsigned cvtpk(float lo, float hi) { return pg8::cvt_pk_bf16_cv(lo, hi); }
__device__ __forceinline__ float wave_sum(float v) {
#pragma unroll
    for (int o = 1; o < 64; o <<= 1) v += __shfl_xor(v, o);
    return v;
}
__device__ __forceinline__ float sigm(float x) { return pg8::sigmoidf_(x); }
__device__ __forceinline__ float silu(float x) { return x * pg8::sigmoidf_(x); }

struct Args { const void* in[30]; float* out; unsigned char* ws; int ph_lo, ph_hi, use_bar, pad; };

struct Frame {
    LAS unsigned char* lds; int tid, lane, wave, vcu, G, gw, NGW;
};

struct XItem { f32x4 v[16]; };
__device__ __forceinline__ void xpose_load(XItem& x, const float* W, int ldw, int N, int item, int lane) {
    const int nblk = N / 64, kb = item / nblk, nb = item % nblk, k0 = 64 * kb, n0 = 64 * nb; const int lr = lane >> 4, lc = (lane & 15) * 4;
#pragma unroll
    for (int i = 0; i < 16; ++i) x.v[i] = *(const GAS f32x4*)(W + (size_t)(k0 + 4 * i + lr) * ldw + n0 + lc);
}
__device__ __forceinline__ void xpose_finish(XItem& x, int K, int N, const float* gain, bf16* WT, int ilv, LAS float* scr, int item, int lane) {
    const int nblk = N / 64, kb = item / nblk, nb = item % nblk, k0 = 64 * kb, n0 = 64 * nb; const int lr = lane >> 4, lc = (lane & 15) * 4;
    if (gain) {
#pragma unroll
        for (int i = 0; i < 16; ++i) x.v[i] = x.v[i] * gain[k0 + 4 * i + lr]; }
#pragma unroll
    for (int i = 0; i < 16; ++i) { LAS float* s = scr + (4 * i + lr) * 65 + lc; s[0] = x.v[i][0]; s[1] = x.v[i][1]; s[2] = x.v[i][2]; s[3] = x.v[i][3]; }
    LDS_WAIT(); asm volatile("" ::: "memory");
    const int c = lane & 7;
#pragma unroll
    for (int j = 0; j < 8; ++j) { const int nl = (lane >> 3) + 8 * j, n = n0 + nl; const LAS float* s = scr + (8 * c) * 65 + nl;
        const int dr = ilv ? (((n >> 7) << 8) + (n & 127) + (ilv == 2 ? 128 : 0)) : n;
        v4u o; o.x = pk2(s[0 * 65], s[1 * 65]); o.y = pk2(s[2 * 65], s[3 * 65]); o.z = pk2(s[4 * 65], s[5 * 65]); o.w = pk2(s[6 * 65], s[7 * 65]);
        *(GAS v4u*)(WT + (size_t)dr * K + k0 + 8 * c) = o; }
    LDS_WAIT(); asm volatile("" ::: "memory");
}
__device__ __forceinline__ void xpose_item(const float* W, int ldw, int K, int N, const float* gain, bf16* WT, int ilv, LAS float* scr, int item, int lane) {
    XItem x; xpose_load(x, W, ldw, N, item, lane); xpose_finish(x, K, N, gain, WT, ilv, scr, item, lane);
}
struct MatD { const float* W; int ldw, K, N; const float* gain; bf16* WT; int ilv; int items; };
__device__ __forceinline__ MatD dense_mat(const Args& a, int id) {
    unsigned char* ws = a.ws; MatD m; m.gain = nullptr; m.ilv = 0;
    if (id < 2)       { const int j = id;      m.W = (const float*)a.in[7] + (size_t)j * D_ * EIN;    m.ldw = EIN; m.K = D_; m.N = EIN; m.gain = (const float*)a.in[3] + (2 * j) * D_; m.WT = (bf16*)(ws + WS_WINE) + (size_t)j * EIN * D_; }
    else if (id < 4)  { const int j = id - 2;  m.W = (const float*)a.in[8] + (size_t)j * D_ * D_;     m.ldw = D_; m.K = D_; m.N = D_; m.WT = (bf16*)(ws + WS_WOUTE) + (size_t)j * D_ * D_; }
    else if (id < 6)  { const int j = id - 4;  m.W = (const float*)a.in[21] + (size_t)j * D_ * DFF;   m.ldw = DFF; m.K = D_; m.N = DFF; m.gain = (const float*)a.in[4] + (2 * j) * D_; m.WT = (bf16*)(ws + WS_W13D) + (size_t)j * 2 * DFF * D_; m.ilv = 1; }
    else if (id < 8)  { const int j = id - 6;  m.W = (const float*)a.in[22] + (size_t)j * D_ * DFF;   m.ldw = DFF; m.K = D_; m.N = DFF; m.gain = (const float*)a.in[4] + (2 * j) * D_; m.WT = (bf16*)(ws + WS_W13D) + (size_t)j * 2 * DFF * D_; m.ilv = 2; }
    else if (id < 10) { const int j = id - 8;  m.W = (const float*)a.in[23] + (size_t)j * DFF * D_;   m.ldw = D_; m.K = DFF; m.N = D_; m.WT = (bf16*)(ws + WS_W2D) + (size_t)j * D_ * DFF; }
    else if (id < 12) { const int j = id - 10; m.W = (const float*)a.in[15] + (size_t)j * D_ * OIN_SRC; m.ldw = OIN_SRC; m.K = D_; m.N = OIN_W; m.gain = (const float*)a.in[3] + (2 * j + 1) * D_; m.WT = (bf16*)(ws + WS_WINO) + (size_t)j * OIN_ROWS * D_; }
    else if (id < 14) { const int j = id - 12; m.W = (const float*)a.in[20] + (size_t)j * D_ * D_;    m.ldw = D_; m.K = D_; m.N = D_; m.WT = (bf16*)(ws + WS_WOUTO) + (size_t)j * D_ * D_; }
    else if (id < 18) { const int i = id - 14; m.W = (const float*)a.in[28] + (size_t)i * D_ * D_;    m.ldw = D_; m.K = D_; m.N = D_; m.gain = (const float*)a.in[5] + i * D_; m.WT = (bf16*)(ws + WS_WG) + (size_t)i * D_ * D_; }
    else              { const int i = id - 18; m.W = (const float*)a.in[29] + (size_t)i * PLE * D_;   m.ldw = D_; m.K = PLE; m.N = D_; m.WT = (bf16*)(ws + WS_WP) + (size_t)i * D_ * PLE; }
    m.items = (m.K / 64) * (m.N / 64); return m;
}
__device__ __forceinline__ MatD moe_mat(const Args& a, int j, int id) {
    unsigned char* ws = a.ws; MatD m; m.gain = nullptr; m.ilv = 0; const int e = id / 3, k = id % 3;
    if (k < 2) { m.W = (const float*)a.in[25 + k] + ((size_t)j * NEXP + e) * D_ * DFF; m.ldw = DFF; m.K = D_; m.N = DFF; m.gain = (const float*)a.in[4] + (2 * j + 1) * D_; m.WT = (bf16*)(ws + WS_W13M) + (size_t)e * 2 * DFF * D_; m.ilv = 1 + k; }
    else       { m.W = (const float*)a.in[27] + ((size_t)j * NEXP + e) * DFF * D_; m.ldw = D_; m.K = DFF; m.N = D_; m.WT = (bf16*)(ws + WS_W2M) + (size_t)e * D_ * DFF; }
    m.items = (m.K / 64) * (m.N / 64); return m;
}

__device__ __forceinline__ void p_prologue(const Frame& F, const Args& a) {
    LAS float* scr = (LAS float*)(F.lds + F.wave * WAVE_LDS);
    unsigned char* ws = a.ws;
    {
        int base = 0;
#pragma unroll 1
        for (int id = 0; id < 22; ++id) { const MatD m = dense_mat(a, id);
            int first = (F.gw - base) % F.NGW; if (first < 0) first += F.NGW;
#pragma unroll 1
            for (int it = first; it < m.items; it += F.NGW) xpose_item(m.W, m.ldw, m.K, m.N, m.gain, m.WT, m.ilv, scr, it, F.lane);
            base += m.items; }
    }
    for (int idx = F.gw * 64 + F.lane; idx < 2 * 16 * (D_ / 8); idx += F.NGW * 64) { const int j = idx / (16 * (D_ / 8)), r = (idx / (D_ / 8)) % 16, k0 = (idx % (D_ / 8)) * 8;
        const float* W = (const float*)a.in[15] + (size_t)j * D_ * OIN_SRC; const float* ln = (const float*)a.in[3] + (2 * j + 1) * D_; float v[8];
#pragma unroll
        for (int e = 0; e < 8; ++e) v[e] = ln[k0 + e] * W[(size_t)(k0 + e) * OIN_SRC + OIN_W + r];
        v4u o; o.x = cvtpk(v[0], v[1]); o.y = cvtpk(v[2], v[3]); o.z = cvtpk(v[4], v[5]); o.w = cvtpk(v[6], v[7]);
        *(GAS v4u*)((bf16*)(ws + WS_WINO) + ((size_t)j * OIN_ROWS + OIN_W + r) * D_ + k0) = o; }
    { const float* p = (const float*)a.in[1]; bf16* pb = (bf16*)(ws + WS_PBF); const size_t n8 = (size_t)DEPTH_ * S_ * PLE / 8;
#pragma unroll 1
      for (size_t i = (size_t)F.gw * 64 + F.lane; i < n8; i += (size_t)F.NGW * 64) { const f32x4 x0 = *(const GAS f32x4*)(p + i * 8), x1 = *(const GAS f32x4*)(p + i * 8 + 4);
          v4u o; o.x = cvtpk(x0[0], x0[1]); o.y = cvtpk(x0[2], x0[3]); o.z = cvtpk(x1[0], x1[1]); o.w = cvtpk(x1[2], x1[3]); *(GAS v4u*)(pb + i * 8) = o; } }
#ifdef PROBE_PRO_NOC
    if (a.use_bar)
#endif
    { const float* x = (const float*)a.in[0]; bf16* hb = (bf16*)(ws + WS_HBF); float* ssq = (float*)(ws + WS_SSQB);
#pragma unroll 1
      for (int m = F.gw; m < S_; m += F.NGW) { const GAS f32x4* xr = (const GAS f32x4*)(x + (size_t)m * D_) + F.lane; float s = 0.f;
#pragma unroll
          for (int j = 0; j < 4; ++j) { const f32x4 v = xr[64 * j]; s += (v[0] * v[0] + v[1] * v[1]) + (v[2] * v[2] + v[3] * v[3]);
              u32x2v o; o.x = cvtpk(v[0], v[1]); o.y = cvtpk(v[2], v[3]); *((GAS u32x2v*)(hb + (size_t)m * D_) + F.lane + 64 * j) = o; }
          s = wave_sum(s);
          if (F.lane < 16) ssq[(size_t)m * 16 + F.lane] = (F.lane == 0) ? s : 0.f; } }
    { const int* pos = (const int*)a.in[2]; float* tab = (float*)(ws + WS_TAB);
#pragma unroll 1
      for (int idx = F.gw * 64 + F.lane; idx < S_ * 8; idx += F.NGW * 64) { const int row = idx >> 3, i = idx & 7;
          const float inv = exp2f(-(float)i * (18.931568569324174f / 8.0f));
          const float ang = (float)pos[row] * inv;
          double t = (double)ang * 0.15915494309189535; t -= rint(t); const float tf = (float)t;
          tab[(size_t)row * 16 + i] = __builtin_amdgcn_cosf(tf); tab[(size_t)row * 16 + 8 + i] = __builtin_amdgcn_sinf(tf); } }
}

__device__ __forceinline__ void p_mixprep(const Frame& F, const Args& a, int L) {
    GAS unsigned char* ws = (GAS unsigned char*)a.ws; asm volatile("" : "+s"(ws)); int lane_ = F.lane; asm volatile("" : "+v"(lane_)); const int j = L >> 1, lane = lane_;
    const bf16* AO = (const bf16*)(ws + WS_ARENA + AR_AO); const bf16* PE = (const bf16*)(ws + WS_ARENA + AR_PE); bf16* mix = (bf16*)(ws + WS_MIX);
    const float lam0 = 0.8f - 0.6f * expf(-0.3f * (float)L);
    float s1 = ((const float*)a.in[9])[j * 64 + lane] * ((const float*)a.in[10])[j * 64 + lane], s2 = ((const float*)a.in[11])[j * 64 + lane] * ((const float*)a.in[12])[j * 64 + lane];
    s1 = wave_sum(s1); s2 = wave_sum(s2);
    const float lam = expf(s1) - expf(s2) + lam0, post = 1.0f - lam0;
    const int hh = lane >> 4, dd = (lane & 15) * 8, ch = lane * 8;
    float sg[8], w0[8], w1[8], w2[8];
#pragma unroll
    for (int e = 0; e < 8; ++e) { sg[e] = ((const float*)a.in[13])[j * 128 + dd + e] * post;
        w0[e] = ((const float*)a.in[14])[(j * 3 + 0) * 512 + ch + e]; w1[e] = ((const float*)a.in[14])[(j * 3 + 1) * 512 + ch + e]; w2[e] = ((const float*)a.in[14])[(j * 3 + 2) * 512 + ch + e]; }
#pragma unroll 1
    for (int t = F.gw; t < S_; t += F.NGW) {
        const v4u o1 = *(const GAS v4u*)(AO + (size_t)t * D_ + 256 * hh + dd), o2 = *(const GAS v4u*)(AO + (size_t)t * D_ + 256 * hh + 128 + dd);
        float d[8]; const unsigned a1[4] = {o1.x, o1.y, o1.z, o1.w}, a2[4] = {o2.x, o2.y, o2.z, o2.w}; float ss = 0.f;
#pragma unroll
        for (int q = 0; q < 4; ++q) { d[2 * q] = bflo(a1[q]) - lam * bflo(a2[q]); d[2 * q + 1] = bfhi(a1[q]) - lam * bfhi(a2[q]); ss += d[2 * q] * d[2 * q] + d[2 * q + 1] * d[2 * q + 1]; }
        ss += __shfl_xor(ss, 1); ss += __shfl_xor(ss, 2); ss += __shfl_xor(ss, 4); ss += __shfl_xor(ss, 8);
        const float rms = __builtin_amdgcn_rsqf(ss * (1.0f / 128.0f) + 1e-5f);
        v4u o; o.x = cvtpk(d[0] * rms * sg[0], d[1] * rms * sg[1]); o.y = cvtpk(d[2] * rms * sg[2], d[3] * rms * sg[3]); o.z = cvtpk(d[4] * rms * sg[4], d[5] * rms * sg[5]); o.w = cvtpk(d[6] * rms * sg[6], d[7] * rms * sg[7]);
        *(GAS v4u*)(mix + (size_t)t * D_ + hh * 128 + dd) = o;
        const bf16* r0 = PE + (size_t)t * EIN;
        const v4u bb = *(const GAS v4u*)(r0 + 1536 + ch), c0 = *(const GAS v4u*)(r0 + 2048 + ch), x0 = *(const GAS v4u*)(r0 + 2560 + ch);
        v4u c1 = {0u, 0u, 0u, 0u}, x1 = c1, c2 = c1, x2 = c1;
        if (t >= 1) { c1 = *(const GAS v4u*)(r0 - EIN + 2048 + ch); x1 = *(const GAS v4u*)(r0 - EIN + 2560 + ch); }
        if (t >= 2) { c2 = *(const GAS v4u*)(r0 - 2 * EIN + 2048 + ch); x2 = *(const GAS v4u*)(r0 - 2 * EIN + 2560 + ch); }
        const unsigned B[4] = {bb.x, bb.y, bb.z, bb.w}, C0[4] = {c0.x, c0.y, c0.z, c0.w}, X0[4] = {x0.x, x0.y, x0.z, x0.w}, C1[4] = {c1.x, c1.y, c1.z, c1.w}, X1[4] = {x1.x, x1.y, x1.z, x1.w},
                       C2[4] = {c2.x, c2.y, c2.z, c2.w}, X2[4] = {x2.x, x2.y, x2.z, x2.w};
        float sc[8];
#pragma unroll
        for (int q = 0; q < 4; ++q) {
            sc[2 * q] = bflo(B[q]) * (w2[2 * q] * (bflo(C0[q]) * bflo(X0[q])) + w1[2 * q] * (bflo(C1[q]) * bflo(X1[q])) + w0[2 * q] * (bflo(C2[q]) * bflo(X2[q])));
            sc[2 * q + 1] = bfhi(B[q]) * (w2[2 * q + 1] * (bfhi(C0[q]) * bfhi(X0[q])) + w1[2 * q + 1] * (bfhi(C1[q]) * bfhi(X1[q])) + w0[2 * q + 1] * (bfhi(C2[q]) * bfhi(X2[q]))); }
        v4u so; so.x = cvtpk(sc[0], sc[1]); so.y = cvtpk(sc[2], sc[3]); so.z = cvtpk(sc[4], sc[5]); so.w = cvtpk(sc[6], sc[7]);
        *(GAS v4u*)(mix + (size_t)t * D_ + 512 + ch) = so;
    }
}


__device__ __forceinline__ void p_ab(const Frame& F, const Args& a, int L) {
    GAS unsigned char* ws = (GAS unsigned char*)a.ws; asm volatile("" : "+s"(ws)); int lane_ = F.lane; asm volatile("" : "+v"(lane_)); const int j = L >> 1, lane = lane_, r16 = lane & 15, g = lane >> 4;
    const bf16* hb = (const bf16*)(ws + WS_HBF); const bf16* Wab = (const bf16*)(ws + WS_WINO) + ((size_t)j * OIN_ROWS + OIN_W) * D_;
    const float* ssq = (const float*)(ws + WS_SSQB); float* gg = (float*)(ws + WS_GB); float* gbeta = gg + S_ * 8;
    const float ealog = expf(*(const GAS float*)((const float*)a.in[17] + j * 8 + (r16 & 7))), dtb = *(const GAS float*)((const float*)a.in[18] + j * 8 + (r16 & 7));
    if (F.wave & 1) return;
#pragma unroll 1
    for (int task = F.vcu * 4 + (F.wave >> 1); task < S_ / 16; task += F.G * 4) {
        const int t0 = 16 * task; f32x4 acc = {0.f, 0.f, 0.f, 0.f};
#pragma unroll 8
        for (int s = 0; s < 32; ++s) { const bf16x8 wf = *(const GAS bf16x8*)(Wab + (size_t)r16 * D_ + 32 * s + 8 * g), xf = *(const GAS bf16x8*)(hb + (size_t)(t0 + r16) * D_ + 32 * s + 8 * g);
            acc = __builtin_amdgcn_mfma_f32_16x16x32_bf16(wf, xf, acc, 0, 0, 0); }
#pragma unroll
        for (int r = 0; r < 4; ++r) { const int c = 4 * g + r, t = t0 + r16; const float v = acc[r] * pg8::rstd_row(ssq, t);
            const float al = __shfl(ealog, c & 7), db = __shfl(dtb, c & 7);
            const float z = v + db; const float gv = -al * (z > 20.f ? z : log1pf(expf(z)));
            if (c < 8) gbeta[(size_t)t * 8 + c] = sigm(v); else gg[(size_t)t * 8 + c - 8] = gv; }
    }
}

__device__ __forceinline__ void p_rot_tiles(const Frame& F, const Args& a, const pg8::StaticOrder& So) {
    GAS unsigned char* ws = (GAS unsigned char*)a.ws; asm volatile("" : "+s"(ws)); int tid_ = F.tid; asm volatile("" : "+v"(tid_));
    bf16* PE = (bf16*)(ws + WS_ARENA + AR_PE); const float* tab = (const float*)(ws + WS_TAB);
    asm volatile("s_waitcnt vmcnt(0)" ::: "memory"); __syncthreads();
    pg8::Unit u;
#pragma unroll 1
    for (int i = 0; So.next(i, u); ++i) {
        if (u.pn >= 4) continue;
#pragma unroll
        for (int q = 0; q < 2; ++q) { const int it = tid_ + 512 * q, row = u.pm * 256 + (it >> 2), col = u.pn * 256 + (it & 3) * 64;
            GAS v4u* p = (GAS v4u*)(PE + (size_t)row * EIN + col); const v4u x1 = p[0], x2 = p[1];
            const GAS f32x4* t = (const GAS f32x4*)(tab + (size_t)row * 16); const f32x4 c0 = t[0], c1 = t[1], s0 = t[2], s1 = t[3];
            const unsigned A[4] = {x1.x, x1.y, x1.z, x1.w}, B[4] = {x2.x, x2.y, x2.z, x2.w}; unsigned oa[4], ob[4];
#pragma unroll
            for (int w = 0; w < 4; ++w) { const float cl = (w < 2 ? c0 : c1)[2 * (w & 1)], ch = (w < 2 ? c0 : c1)[2 * (w & 1) + 1], sl = (w < 2 ? s0 : s1)[2 * (w & 1)], sh = (w < 2 ? s0 : s1)[2 * (w & 1) + 1];
                const float a0 = bflo(A[w]), a1 = bfhi(A[w]), b0 = bflo(B[w]), b1 = bfhi(B[w]);
                oa[w] = cvtpk(a0 * cl - b0 * sl, a1 * ch - b1 * sh); ob[w] = cvtpk(b0 * cl + a0 * sl, b1 * ch + a1 * sh); }
            p[0] = (v4u){oa[0], oa[1], oa[2], oa[3]}; p[1] = (v4u){ob[0], ob[1], ob[2], ob[3]}; }
    }
}
__device__ __forceinline__ void tri_solve(const LAS float* Lc, LAS bf16* Xs, int lane) {
    float x0, x1, x2, x3, x4, x5, x6, x7, x8, x9, x10, x11, x12, x13, x14, x15, x16, x17, x18, x19, x20, x21, x22, x23, x24, x25, x26, x27, x28, x29, x30, x31, x32, x33, x34, x35, x36, x37, x38, x39, x40, x41, x42, x43, x44, x45, x46, x47, x48, x49, x50, x51, x52, x53, x54, x55, x56, x57, x58, x59, x60, x61, x62, x63;
    { x63 = (lane == 63) ? 1.0f : 0.0f; asm volatile("" : "+v"(x63) : : "memory"); }
    { float s0 = 0.f, s1 = 0.f, s2 = 0.f, s3 = 0.f; { const f32x4 l = *(const LAS f32x4*)(Lc + 4276); s3 = fmaf(x63, l[3], s3); } x62 = (lane == 62) ? 1.0f : -((s0 + s1) + (s2 + s3)); asm volatile("" : "+v"(x62) : : "memory"); }
    { float s0 = 0.f, s1 = 0.f, s2 = 0.f, s3 = 0.f; { const f32x4 l = *(const LAS f32x4*)(Lc + 4208); s2 = fmaf(x62, l[2], s2); s3 = fmaf(x63, l[3], s3); } x61 = (lane == 61) ? 1.0f : -((s0 + s1) + (s2 + s3)); asm volatile("" : "+v"(x61) : : "memory"); }
    { float s0 = 0.f, s1 = 0.f, s2 = 0.f, s3 = 0.f; { const f32x4 l = *(const LAS f32x4*)(Lc + 4140); s1 = fmaf(x61, l[1], s1); s2 = fmaf(x62, l[2], s2); s3 = fmaf(x63, l[3], s3); } x60 = (lane == 60) ? 1.0f : -((s0 + s1) + (s2 + s3)); asm volatile("" : "+v"(x60) : : "memory"); }
    { float s0 = 0.f, s1 = 0.f, s2 = 0.f, s3 = 0.f; { const f32x4 l = *(const LAS f32x4*)(Lc + 4072); s0 = fmaf(x60, l[0], s0); s1 = fmaf(x61, l[1], s1); s2 = fmaf(x62, l[2], s2); s3 = fmaf(x63, l[3], s3); } x59 = (lane == 59) ? 1.0f : -((s0 + s1) + (s2 + s3)); asm volatile("" : "+v"(x59) : : "memory"); }
    { float s0 = 0.f, s1 = 0.f, s2 = 0.f, s3 = 0.f; { const f32x4 l = *(const LAS f32x4*)(Lc + 4000); s3 = fmaf(x59, l[3], s3); } { const f32x4 l = *(const LAS f32x4*)(Lc + 4004); s0 = fmaf(x60, l[0], s0); s1 = fmaf(x61, l[1], s1); s2 = fmaf(x62, l[2], s2); s3 = fmaf(x63, l[3], s3); } x58 = (lane == 58) ? 1.0f : -((s0 + s1) + (s2 + s3)); asm volatile("" : "+v"(x58) : : "memory"); }
    { float s0 = 0.f, s1 = 0.f, s2 = 0.f, s3 = 0.f; { const f32x4 l = *(const LAS f32x4*)(Lc + 3932); s2 = fmaf(x58, l[2], s2); s3 = fmaf(x59, l[3], s3); } { const f32x4 l = *(const LAS f32x4*)(Lc + 3936); s0 = fmaf(x60, l[0], s0); s1 = fmaf(x61, l[1], s1); s2 = fmaf(x62, l[2], s2); s3 = fmaf(x63, l[3], s3); } x57 = (lane == 57) ? 1.0f : -((s0 + s1) + (s2 + s3)); asm volatile("" : "+v"(x57) : : "memory"); }
    { float s0 = 0.f, s1 = 0.f, s2 = 0.f, s3 = 0.f; { const f32x4 l = *(const LAS f32x4*)(Lc + 3864); s1 = fmaf(x57, l[1], s1); s2 = fmaf(x58, l[2], s2); s3 = fmaf(x59, l[3], s3); } { const f32x4 l = *(const LAS f32x4*)(Lc + 3868); s0 = fmaf(x60, l[0], s0); s1 = fmaf(x61, l[1], s1); s2 = fmaf(x62, l[2], s2); s3 = fmaf(x63, l[3], s3); } x56 = (lane == 56) ? 1.0f : -((s0 + s1) + (s2 + s3)); asm volatile("" : "+v"(x56) : : "memory"); }
    { float s0 = 0.f, s1 = 0.f, s2 = 0.f, s3 = 0.f; { const f32x4 l = *(const LAS f32x4*)(Lc + 3796); s0 = fmaf(x56, l[0], s0); s1 = fmaf(x57, l[1], s1); s2 = fmaf(x58, l[2], s2); s3 = fmaf(x59, l[3], s3); } { const f32x4 l = *(const LAS f32x4*)(Lc + 3800); s0 = fmaf(x60, l[0], s0); s1 = fmaf(x61, l[1], s1); s2 = fmaf(x62, l[2], s2); s3 = fmaf(x63, l[3], s3); } x55 = (lane == 55) ? 1.0f : -((s0 + s1) + (s2 + s3)); asm volatile("" : "+v"(x55) : : "memory"); }
    { float s0 = 0.f, s1 = 0.f, s2 = 0.f, s3 = 0.f; { const f32x4 l = *(const LAS f32x4*)(Lc + 3724); s3 = fmaf(x55, l[3], s3); } { const f32x4 l = *(const LAS f32x4*)(Lc + 3728); s0 = fmaf(x56, l[0], s0); s1 = fmaf(x57, l[1], s1); s2 = fmaf(x58, l[2], s2); s3 = fmaf(x59, l[3], s3); } { const f32x4 l = *(const LAS f32x4*)(Lc + 3732); s0 = fmaf(x60, l[0], s0); s1 = fmaf(x61, l[1], s1); s2 = fmaf(x62, l[2], s2); s3 = fmaf(x63, l[3], s3); } x54 = (lane == 54) ? 1.0f : -((s0 + s1) + (s2 + s3)); asm volatile("" : "+v"(x54) : : "memory"); }
    { float s0 = 0.f, s1 = 0.f, s2 = 0.f, s3 = 0.f; { const f32x4 l = *(const LAS f32x4*)(Lc + 3656); s2 = fmaf(x54, l[2], s2); s3 = fmaf(x55, l[3], s3); } { const f32x4 l = *(const LAS f32x4*)(Lc + 3660); s0 = fmaf(x56, l[0], s0); s1 = fmaf(x57, l[1], s1); s2 = fmaf(x58, l[2], s2); s3 = fmaf(x59, l[3], s3); } { const f32x4 l = *(const LAS f32x4*)(Lc + 3664); s0 = fmaf(x60, l[0], s0); s1 = fmaf(x61, l[1], s1); s2 = fmaf(x62, l[2], s2); s3 = fmaf(x63, l[3], s3); } x53 = (lane == 53) ? 1.0f : -((s0 + s1) + (s2 + s3)); asm volatile("" : "+v"(x53) : : "memory"); }
    { float s0 = 0.f, s1 = 0.f, s2 = 0.f, s3 = 0.f; { const f32x4 l = *(const LAS f32x4*)(Lc + 3588); s1 = fmaf(x53, l[1], s1); s2 = fmaf(x54, l[2], s2); s3 = fmaf(x55, l[3], s3); } { const f32x4 l = *(const LAS f32x4*)(Lc + 3592); s0 = fmaf(x56, l[0], s0); s1 = fmaf(x57, l[1], s1); s2 = fmaf(x58, l[2], s2); s3 = fmaf(x59, l[3], s3); } { const f32x4 l = *(const LAS f32x4*)(Lc + 3596); s0 = fmaf(x60, l[0], s0); s1 = fmaf(x61, l[1], s1); s2 = fmaf(x62, l[2], s2); s3 = fmaf(x63, l[3], s3); } x52 = (lane == 52) ? 1.0f : -((s0 + s1) + (s2 + s3)); asm volatile("" : "+v"(x52) : : "memory"); }
    { float s0 = 0.f, s1 = 0.f, s2 = 0.f, s3 = 0.f; { const f32x4 l = *(const LAS f32x4*)(Lc + 3520); s0 = fmaf(x52, l[0], s0); s1 = fmaf(x53, l[1], s1); s2 = fmaf(x54, l[2], s2); s3 = fmaf(x55, l[3], s3); } { const f32x4 l = *(const LAS f32x4*)(Lc + 3524); s0 = fmaf(x56, l[0], s0); s1 = fmaf(x57, l[1], s1); s2 = fmaf(x58, l[2], s2); s3 = fmaf(x59, l[3], s3); } { const f32x4 l = *(const LAS f32x4*)(Lc + 3528); s0 = fmaf(x60, l[0], s0); s1 = fmaf(x61, l[1], s1); s2 = fmaf(x62, l[2], s2); s3 = fmaf(x63, l[3], s3); } x51 = (lane == 51) ? 1.0f : -((s0 + s1) + (s2 + s3)); asm volatile("" : "+v"(x51) : : "memory"); }
    { float s0 = 0.f, s1 = 0.f, s2 = 0.f, s3 = 0.f; { const f32x4 l = *(const LAS f32x4*)(Lc + 3448); s3 = fmaf(x51, l[3], s3); } { const f32x4 l = *(const LAS f32x4*)(Lc + 3452); s0 = fmaf(x52, l[0], s0); s1 = fmaf(x53, l[1], s1); s2 = fmaf(x54, l[2], s2); s3 = fmaf(x55, l[3], s3); } { const f32x4 l = *(const LAS f32x4*)(Lc + 3456); s0 = fmaf(x56, l[0], s0); s1 = fmaf(x57, l[1], s1); s2 = fmaf(x58, l[2], s2); s3 = fmaf(x59, l[3], s3); } { const f32x4 l = *(const LAS f32x4*)(Lc + 3460); s0 = fmaf(x60, l[0], s0); s1 = fmaf(x61, l[1], s1); s2 = fmaf(x62, l[2], s2); s3 = fmaf(x63, l[3], s3); } x50 = (lane == 50) ? 1.0f : -((s0 + s1) + (s2 + s3)); asm volatile("" : "+v"(x50) : : "memory"); }
    { float s0 = 0.f, s1 = 0.f, s2 = 0.f, s3 = 0.f; { const f32x4 l = *(const LAS f32x4*)(Lc + 3380); s2 = fmaf(x50, l[2], s2); s3 = fmaf(x51, l[3], s3); } { const f32x4 l = *(const LAS f32x4*)(Lc + 3384); s0 = fmaf(x52, l[0], s0); s1 = fmaf(x53, l[1], s1); s2 = fmaf(x54, l[2], s2); s3 = fmaf(x55, l[3], s3); } { const f32x4 l = *(const LAS f32x4*)(Lc + 3388); s0 = fmaf(x56, l[0], s0); s1 = fmaf(x57, l[1], s1); s2 = fmaf(x58, l[2], s2); s3 = fmaf(x59, l[3], s3); } { const f32x4 l = *(const LAS f32x4*)(Lc + 3392); s0 = fmaf(x60, l[0], s0); s1 = fmaf(x61, l[1], s1); s2 = fmaf(x62, l[2], s2); s3 = fmaf(x63, l[3], s3); } x49 = (lane == 49) ? 1.0f : -((s0 + s1) + (s2 + s3)); asm volatile("" : "+v"(x49) : : "memory"); }
    { float s0 = 0.f, s1 = 0.f, s2 = 0.f, s3 = 0.f; { const f32x4 l = *(const LAS f32x4*)(Lc + 3312); s1 = fmaf(x49, l[1], s1); s2 = fmaf(x50, l[2], s2); s3 = fmaf(x51, l[3], s3); } { const f32x4 l = *(const LAS f32x4*)(Lc + 3316); s0 = fmaf(x52, l[0], s0); s1 = fmaf(x53, l[1], s1); s2 = fmaf(x54, l[2], s2); s3 = fmaf(x55, l[3], s3); } { const f32x4 l = *(const LAS f32x4*)(Lc + 3320); s0 = fmaf(x56, l[0], s0); s1 = fmaf(x57, l[1], s1); s2 = fmaf(x58, l[2], s2); s3 = fmaf(x59, l[3], s3); } { const f32x4 l = *(const LAS f32x4*)(Lc + 3324); s0 = fmaf(x60, l[0], s0); s1 = fmaf(x61, l[1], s1); s2 = fmaf(x62, l[2], s2); s3 = fmaf(x63, l[3], s3); } x48 = (lane == 48) ? 1.0f : -((s0 + s1) + (s2 + s3)); asm volatile("" : "+v"(x48) : : "memory"); }
    { float s0 = 0.f, s1 = 0.f, s2 = 0.f, s3 = 0.f; { const f32x4 l = *(const LAS f32x4*)(Lc + 3244); s0 = fmaf(x48, l[0], s0); s1 = fmaf(x49, l[1], s1); s2 = fmaf(x50, l[2], s2); s3 = fmaf(x51, l[3], s3); } { const f32x4 l = *(const LAS f32x4*)(Lc + 3248); s0 = fmaf(x52, l[0], s0); s1 = fmaf(x53, l[1], s1); s2 = fmaf(x54, l[2], s2); s3 = fmaf(x55, l[3], s3); } { const f32x4 l = *(const LAS f32x4*)(Lc + 3252); s0 = fmaf(x56, l[0], s0); s1 = fmaf(x57, l[1], s1); s2 = fmaf(x58, l[2], s2); s3 = fmaf(x59, l[3], s3); } { const f32x4 l = *(const LAS f32x4*)(Lc + 3256); s0 = fmaf(x60, l[0], s0); s1 = fmaf(x61, l[1], s1); s2 = fmaf(x62, l[2], s2); s3 = fmaf(x63, l[3], s3); } x47 = (lane == 47) ? 1.0f : -((s0 + s1) + (s2 + s3)); asm volatile("" : "+v"(x47) : : "memory"); }
    { float s0 = 0.f, s1 = 0.f, s2 = 0.f, s3 = 0.f; { const f32x4 l = *(const LAS f32x4*)(Lc + 3172); s3 = fmaf(x47, l[3], s3); } { const f32x4 l = *(const LAS f32x4*)(Lc + 3176); s0 = fmaf(x48, l[0], s0); s1 = fmaf(x49, l[1], s1); s2 = fmaf(x50, l[2], s2); s3 = fmaf(x51, l[3], s3); } { const f32x4 l = *(const LAS f32x4*)(Lc + 3180); s0 = fmaf(x52, l[0], s0); s1 = fmaf(x53, l[1], s1); s2 = fmaf(x54, l[2], s2); s3 = fmaf(x55, l[3], s3); } { const f32x4 l = *(const LAS f32x4*)(Lc + 3184); s0 = fmaf(x56, l[0], s0); s1 = fmaf(x57, l[1], s1); s2 = fmaf(x58, l[2], s2); s3 = fmaf(x59, l[3], s3); } { const f32x4 l = *(const LAS f32x4*)(Lc + 3188); s0 = fmaf(x60, l[0], s0); s1 = fmaf(x61, l[1], s1); s2 = fmaf(x62, l[2], s2); s3 = fmaf(x63, l[3], s3); } x46 = (lane == 46) ? 1.0f : -((s0 + s1) + (s2 + s3)); asm volatile("" : "+v"(x46) : : "memory"); }
    { float s0 = 0.f, s1 = 0.f, s2 = 0.f, s3 = 0.f; { const f32x4 l = *(const LAS f32x4*)(Lc + 3104); s2 = fmaf(x46, l[2], s2); s3 = fmaf(x47, l[3], s3); } { const f32x4 l = *(const LAS f32x4*)(Lc + 3108); s0 = fmaf(x48, l[0], s0); s1 = fmaf(x49, l[1], s1); s2 = fmaf(x50, l[2], s2); s3 = fmaf(x51, l[3], s3); } { const f32x4 l = *(const LAS f32x4*)(Lc + 3112); s0 = fmaf(x52, l[0], s0); s1 = fmaf(x53, l[1], s1); s2 = fmaf(x54, l[2], s2); s3 = fmaf(x55, l[3], s3); } { const f32x4 l = *(const LAS f32x4*)(Lc + 3116); s0 = fmaf(x56, l[0], s0); s1 = fmaf(x57, l[1], s1); s2 = fmaf(x58, l[2], s2); s3 = fmaf(x59, l[3], s3); } { const f32x4 l = *(const LAS f32x4*)(Lc + 3120); s0 = fmaf(x60, l[0], s0); s1 = fmaf(x61, l[1], s1); s2 = fmaf(x62, l[2], s2); s3 = fmaf(x63, l[3], s3); } x45 = (lane == 45) ? 1.0f : -((s0 + s1) + (s2 + s3)); asm volatile("" : "+v"(x45) : : "memory"); }
    { float s0 = 0.f, s1 = 0.f, s2 = 0.f, s3 = 0.f; { const f32x4 l = *(const LAS f32x4*)(Lc + 3036); s1 = fmaf(x45, l[1], s1); s2 = fmaf(x46, l[2], s2); s3 = fmaf(x47, l[3], s3); } { const f32x4 l = *(const LAS f32x4*)(Lc + 3040); s0 = fmaf(x48, l[0], s0); s1 = fmaf(x49, l[1], s1); s2 = fmaf(x50, l[2], s2); s3 = fmaf(x51, l[3], s3); } { const f32x4 l = *(const LAS f32x4*)(Lc + 3044); s0 = fmaf(x52, l[0], s0); s1 = fmaf(x53, l[1], s1); s2 = fmaf(x54, l[2], s2); s3 = fmaf(x55, l[3], s3); } { const f32x4 l = *(const LAS f32x4*)(Lc + 3048); s0 = fmaf(x56, l[0], s0); s1 = fmaf(x57, l[1], s1); s2 = fmaf(x58, l[2], s2); s3 = fmaf(x59, l[3], s3); } { const f32x4 l = *(const LAS f32x4*)(Lc + 3052); s0 = fmaf(x60, l[0], s0); s1 = fmaf(x61, l[1], s1); s2 = fmaf(x62, l[2], s2); s3 = fmaf(x63, l[3], s3); } x44 = (lane == 44) ? 1.0f : -((s0 + s1) + (s2 + s3)); asm volatile("" : "+v"(x44) : : "memory"); }
    { float s0 = 0.f, s1 = 0.f, s2 = 0.f, s3 = 0.f; { const f32x4 l = *(const LAS f32x4*)(Lc + 2968); s0 = fmaf(x44, l[0], s0); s1 = fmaf(x45, l[1], s1); s2 = fmaf(x46, l[2], s2); s3 = fmaf(x47, l[3], s3); } { const f32x4 l = *(const LAS f32x4*)(Lc + 2972); s0 = fmaf(x48, l[0], s0); s1 = fmaf(x49, l[1], s1); s2 = fmaf(x50, l[2], s2); s3 = fmaf(x51, l[3], s3); } { const f32x4 l = *(const LAS f32x4*)(Lc + 2976); s0 = fmaf(x52, l[0], s0); s1 = fmaf(x53, l[1], s1); s2 = fmaf(x54, l[2], s2); s3 = fmaf(x55, l[3], s3); } { const f32x4 l = *(const LAS f32x4*)(Lc + 2980); s0 = fmaf(x56, l[0], s0); s1 = fmaf(x57, l[1], s1); s2 = fmaf(x58, l[2], s2); s3 = fmaf(x59, l[3], s3); } { const f32x4 l = *(const LAS f32x4*)(Lc + 2984); s0 = fmaf(x60, l[0], s0); s1 = fmaf(x61, l[1], s1); s2 = fmaf(x62, l[2], s2); s3 = fmaf(x63, l[3], s3); } x43 = (lane == 43) ? 1.0f : -((s0 + s1) + (s2 + s3)); asm volatile("" : "+v"(x43) : : "memory"); }
    { float s0 = 0.f, s1 = 0.f, s2 = 0.f, s3 = 0.f; { const f32x4 l = *(const LAS f32x4*)(Lc + 2896); s3 = fmaf(x43, l[3], s3); } { const f32x4 l = *(const LAS f32x4*)(Lc + 2900); s0 = fmaf(x44, l[0], s0); s1 = fmaf(x45, l[1], s1); s2 = fmaf(x46, l[2], s2); s3 = fmaf(x47, l[3], s3); } { const f32x4 l = *(const LAS f32x4*)(Lc + 2904); s0 = fmaf(x48, l[0], s0); s1 = fmaf(x49, l[1], s1); s2 = fmaf(x50, l[2], s2); s3 = fmaf(x51, l[3], s3); } { const f32x4 l = *(const LAS f32x4*)(Lc + 2908); s0 = fmaf(x52, l[0], s0); s1 = fmaf(x53, l[1], s1); s2 = fmaf(x54, l[2], s2); s3 = fmaf(x55, l[3], s3); } { const f32x4 l = *(const LAS f32x4*)(Lc + 2912); s0 = fmaf(x56, l[0], s0); s1 = fmaf(x57, l[1], s1); s2 = fmaf(x58, l[2], s2); s3 = fmaf(x59, l[3], s3); } { const f32x4 l = *(const LAS f32x4*)(Lc + 2916); s0 = fmaf(x60, l[0], s0); s1 = fmaf(x61, l[1], s1); s2 = fmaf(x62, l[2], s2); s3 = fmaf(x63, l[3], s3); } x42 = (lane == 42) ? 1.0f : -((s0 + s1) + (s2 + s3)); asm volatile("" : "+v"(x42) : : "memory"); }
    { float s0 = 0.f, s1 = 0.f, s2 = 0.f, s3 = 0.f; { const f32x4 l = *(const LAS f32x4*)(Lc + 2828); s2 = fmaf(x42, l[2], s2); s3 = fmaf(x43, l[3], s3); } { const f32x4 l = *(const LAS f32x4*)(Lc + 2832); s0 = fmaf(x44, l[0], s0); s1 = fmaf(x45, l[1], s1); s2 = fmaf(x46, l[2], s2); s3 = fmaf(x47, l[3], s3); } { const f32x4 l = *(const LAS f32x4*)(Lc + 2836); s0 = fmaf(x48, l[0], s0); s1 = fmaf(x49, l[1], s1); s2 = fmaf(x50, l[2], s2); s3 = fmaf(x51, l[3], s3); } { const f32x4 l = *(const LAS f32x4*)(Lc + 2840); s0 = fmaf(x52, l[0], s0); s1 = fmaf(x53, l[1], s1); s2 = fmaf(x54, l[2], s2); s3 = fmaf(x55, l[3], s3); } { const f32x4 l = *(const LAS f32x4*)(Lc + 2844); s0 = fmaf(x56, l[0], s0); s1 = fmaf(x57, l[1], s1); s2 = fmaf(x58, l[2], s2); s3 = fmaf(x59, l[3], s3); } { const f32x4 l = *(const LAS f32x4*)(Lc + 2848); s0 = fmaf(x60, l[0], s0); s1 = fmaf(x61, l[1], s1); s2 = fmaf(x62, l[2], s2); s3 = fmaf(x63, l[3], s3); } x41 = (lane == 41) ? 1.0f : -((s0 + s1) + (s2 + s3)); asm volatile("" : "+v"(x41) : : "memory"); }
    { float s0 = 0.f, s1 = 0.f, s2 = 0.f, s3 = 0.f; { const f32x4 l = *(const LAS f32x4*)(Lc + 2760); s1 = fmaf(x41, l[1], s1); s2 = fmaf(x42, l[2], s2); s3 = fmaf(x43, l[3], s3); } { const f32x4 l = *(const LAS f32x4*)(Lc + 2764); s0 = fmaf(x44, l[0], s0); s1 = fmaf(x45, l[1], s1); s2 = fmaf(x46, l[2], s2); s3 = fmaf(x47, l[3], s3); } { const f32x4 l = *(const LAS f32x4*)(Lc + 2768); s0 = fmaf(x48, l[0], s0); s1 = fmaf(x49, l[1], s1); s2 = fmaf(x50, l[2], s2); s3 = fmaf(x51, l[3], s3); } { const f32x4 l = *(const LAS f32x4*)(Lc + 2772); s0 = fmaf(x52, l[0], s0); s1 = fmaf(x53, l[1], s1); s2 = fmaf(x54, l[2], s2); s3 = fmaf(x55, l[3], s3); } { const f32x4 l = *(const LAS f32x4*)(Lc + 2776); s0 = fmaf(x56, l[0], s0); s1 = fmaf(x57, l[1], s1); s2 = fmaf(x58, l[2], s2); s3 = fmaf(x59, l[3], s3); } { const f32x4 l = *(const LAS f32x4*)(Lc + 2780); s0 = fmaf(x60, l[0], s0); s1 = fmaf(x61, l[1], s1); s2 = fmaf(x62, l[2], s2); s3 = fmaf(x63, l[3], s3); } x40 = (lane == 40) ? 1.0f : -((s0 + s1) + (s2 + s3)); asm volatile("" : "+v"(x40) : : "memory"); }
    { float s0 = 0.f, s1 = 0.f, s2 = 0.f, s3 = 0.f; { const f32x4 l = *(const LAS f32x4*)(Lc + 2692); s0 = fmaf(x40, l[0], s0); s1 = fmaf(x41, l[1], s1); s2 = fmaf(x42, l[2], s2); s3 = fmaf(x43, l[3], s3); } { const f32x4 l = *(const LAS f32x4*)(Lc + 2696); s0 = fmaf(x44, l[0], s0); s1 = fmaf(x45, l[1], s1); s2 = fmaf(x46, l[2], s2); s3 = fmaf(x47, l[3], s3); } { const f32x4 l = *(const LAS f32x4*)(Lc + 2700); s0 = fmaf(x48, l[0], s0); s1 = fmaf(x49, l[1], s1); s2 = fmaf(x50, l[2], s2); s3 = fmaf(x51, l[3], s3); } { const f32x4 l = *(const LAS f32x4*)(Lc + 2704); s0 = fmaf(x52, l[0], s0); s1 = fmaf(x53, l[1], s1); s2 = fmaf(x54, l[2], s2); s3 = fmaf(x55, l[3], s3); } { const f32x4 l = *(const LAS f32x4*)(Lc + 2708); s0 = fmaf(x56, l[0], s0); s1 = fmaf(x57, l[1], s1); s2 = fmaf(x58, l[2], s2); s3 = fmaf(x59, l[3], s3); } { const f32x4 l = *(const LAS f32x4*)(Lc + 2712); s0 = fmaf(x60, l[0], s0); s1 = fmaf(x61, l[1], s1); s2 = fmaf(x62, l[2], s2); s3 = fmaf(x63, l[3], s3); } x39 = (lane == 39) ? 1.0f : -((s0 + s1) + (s2 + s3)); asm volatile("" : "+v"(x39) : : "memory"); }
    { float s0 = 0.f, s1 = 0.f, s2 = 0.f, s3 = 0.f; { const f32x4 l = *(const LAS f32x4*)(Lc + 2620); s3 = fmaf(x39, l[3], s3); } { const f32x4 l = *(const LAS f32x4*)(Lc + 2624); s0 = fmaf(x40, l[0], s0); s1 = fmaf(x41, l[1], s1); s2 = fmaf(x42, l[2], s2); s3 = fmaf(x43, l[3], s3); } { const f32x4 l = *(const LAS f32x4*)(Lc + 2628); s0 = fmaf(x44, l[0], s0); s1 = fmaf(x45, l[1], s1); s2 = fmaf(x46, l[2], s2); s3 = fmaf(x47, l[3], s3); } { const f32x4 l = *(const LAS f32x4*)(Lc + 2632); s0 = fmaf(x48, l[0], s0); s1 = fmaf(x49, l[1], s1); s2 = fmaf(x50, l[2], s2); s3 = fmaf(x51, l[3], s3); } { const f32x4 l = *(const LAS f32x4*)(Lc + 2636); s0 = fmaf(x52, l[0], s0); s1 = fmaf(x53, l[1], s1); s2 = fmaf(x54, l[2], s2); s3 = fmaf(x55, l[3], s3); } { const f32x4 l = *(const LAS f32x4*)(Lc + 2640); s0 = fmaf(x56, l[0], s0); s1 = fmaf(x57, l[1], s1); s2 = fmaf(x58, l[2], s2); s3 = fmaf(x59, l[3], s3); } { const f32x4 l = *(const LAS f32x4*)(Lc + 2644); s0 = fmaf(x60, l[0], s0); s1 = fmaf(x61, l[1], s1); s2 = fmaf(x62, l[2], s2); s3 = fmaf(x63, l[3], s3); } x38 = (lane == 38) ? 1.0f : -((s0 + s1) + (s2 + s3)); asm volatile("" : "+v"(x38) : : "memory"); }
    { float s0 = 0.f, s1 = 0.f, s2 = 0.f, s3 = 0.f; { const f32x4 l = *(const LAS f32x4*)(Lc + 2552); s2 = fmaf(x38, l[2], s2); s3 = fmaf(x39, l[3], s3); } { const f32x4 l = *(const LAS f32x4*)(Lc + 2556); s0 = fmaf(x40, l[0], s0); s1 = fmaf(x41, l[1], s1); s2 = fmaf(x42, l[2], s2); s3 = fmaf(x43, l[3], s3); } { const f32x4 l = *(const LAS f32x4*)(Lc + 2560); s0 = fmaf(x44, l[0], s0); s1 = fmaf(x45, l[1], s1); s2 = fmaf(x46, l[2], s2); s3 = fmaf(x47, l[3], s3); } { const f32x4 l = *(const LAS f32x4*)(Lc + 2564); s0 = fmaf(x48, l[0], s0); s1 = fmaf(x49, l[1], s1); s2 = fmaf(x50, l[2], s2); s3 = fmaf(x51, l[3], s3); } { const f32x4 l = *(const LAS f32x4*)(Lc + 2568); s0 = fmaf(x52, l[0], s0); s1 = fmaf(x53, l[1], s1); s2 = fmaf(x54, l[2], s2); s3 = fmaf(x55, l[3], s3); } { const f32x4 l = *(const LAS f32x4*)(Lc + 2572); s0 = fmaf(x56, l[0], s0); s1 = fmaf(x57, l[1], s1); s2 = fmaf(x58, l[2], s2); s3 = fmaf(x59, l[3], s3); } { const f32x4 l = *(const LAS f32x4*)(Lc + 2576); s0 = fmaf(x60, l[0], s0); s1 = fmaf(x61, l[1], s1); s2 = fmaf(x62, l[2], s2); s3 = fmaf(x63, l[3], s3); } x37 = (lane == 37) ? 1.0f : -((s0 + s1) + (s2 + s3)); asm volatile("" : "+v"(x37) : : "memory"); }
    { float s0 = 0.f, s1 = 0.f, s2 = 0.f, s3 = 0.f; { const f32x4 l = *(const LAS f32x4*)(Lc + 2484); s1 = fmaf(x37, l[1], s1); s2 = fmaf(x38, l[2], s2); s3 = fmaf(x39, l[3], s3); } { const f32x4 l = *(const LAS f32x4*)(Lc + 2488); s0 = fmaf(x40, l[0], s0); s1 = fmaf(x41, l[1], s1); s2 = fmaf(x42, l[2], s2); s3 = fmaf(x43, l[3], s3); } { const f32x4 l = *(const LAS f32x4*)(Lc + 2492); s0 = fmaf(x44, l[0], s0); s1 = fmaf(x45, l[1], s1); s2 = fmaf(x46, l[2], s2); s3 = fmaf(x47, l[3], s3); } { const f32x4 l = *(const LAS f32x4*)(Lc + 2496); s0 = fmaf(x48, l[0], s0); s1 = fmaf(x49, l[1], s1); s2 = fmaf(x50, l[2], s2); s3 = fmaf(x51, l[3], s3); } { const f32x4 l = *(const LAS f32x4*)(Lc + 2500); s0 = fmaf(x52, l[0], s0); s1 = fmaf(x53, l[1], s1); s2 = fmaf(x54, l[2], s2); s3 = fmaf(x55, l[3], s3); } { const f32x4 l = *(const LAS f32x4*)(Lc + 2504); s0 = fmaf(x56, l[0], s0); s1 = fmaf(x57, l[1], s1); s2 = fmaf(x58, l[2], s2); s3 = fmaf(x59, l[3], s3); } { const f32x4 l = *(const LAS f32x4*)(Lc + 2508); s0 = fmaf(x60, l[0], s0); s1 = fmaf(x61, l[1], s1); s2 = fmaf(x62, l[2], s2); s3 = fmaf(x63, l[3], s3); } x36 = (lane == 36) ? 1.0f : -((s0 + s1) + (s2 + s3)); asm volatile("" : "+v"(x36) : : "memory"); }
    { float s0 = 0.f, s1 = 0.f, s2 = 0.f, s3 = 0.f; { const f32x4 l = *(const LAS f32x4*)(Lc + 2416); s0 = fmaf(x36, l[0], s0); s1 = fmaf(x37, l[1], s1); s2 = fmaf(x38, l[2], s2); s3 = fmaf(x39, l[3], s3); } { const f32x4 l = *(const LAS f32x4*)(Lc + 2420); s0 = fmaf(x40, l[0], s0); s1 = fmaf(x41, l[1], s1); s2 = fmaf(x42, l[2], s2); s3 = fmaf(x43, l[3], s3); } { const f32x4 l = *(const LAS f32x4*)(Lc + 2424); s0 = fmaf(x44, l[0], s0); s1 = fmaf(x45, l[1], s1); s2 = fmaf(x46, l[2], s2); s3 = fmaf(x47, l[3], s3); } { const f32x4 l = *(const LAS f32x4*)(Lc + 2428); s0 = fmaf(x48, l[0], s0); s1 = fmaf(x49, l[1], s1); s2 = fmaf(x50, l[2], s2); s3 = fmaf(x51, l[3], s3); } { const f32x4 l = *(const LAS f32x4*)(Lc + 2432); s0 = fmaf(x52, l[0], s0); s1 = fmaf(x53, l[1], s1); s2 = fmaf(x54, l[2], s2); s3 = fmaf(x55, l[3], s3); } { const f32x4 l = *(const LAS f32x4*)(Lc + 2436); s0 = fmaf(x56, l[0], s0); s1 = fmaf(x57, l[1], s1); s2 = fmaf(x58, l[2], s2); s3 = fmaf(x59, l[3], s3); } { const f32x4 l = *(const LAS f32x4*)(Lc + 2440); s0 = fmaf(x60, l[0], s0); s1 = fmaf(x61, l[1], s1); s2 = fmaf(x62, l[2], s2); s3 = fmaf(x63, l[3], s3); } x35 = (lane == 35) ? 1.0f : -((s0 + s1) + (s2 + s3)); asm volatile("" : "+v"(x35) : : "memory"); }
    { float s0 = 0.f, s1 = 0.f, s2 = 0.f, s3 = 0.f; { const f32x4 l = *(const LAS f32x4*)(Lc + 2344); s3 = fmaf(x35, l[3], s3); } { const f32x4 l = *(const LAS f32x4*)(Lc + 2348); s0 = fmaf(x36, l[0], s0); s1 = fmaf(x37, l[1], s1); s2 = fmaf(x38, l[2], s2); s3 = fmaf(x39, l[3], s3); } { const f32x4 l = *(const LAS f32x4*)(Lc + 2352); s0 = fmaf(x40, l[0], s0); s1 = fmaf(x41, l[1], s1); s2 = fmaf(x42, l[2], s2); s3 = fmaf(x43, l[3], s3); } { const f32x4 l = *(const LAS f32x4*)(Lc + 2356); s0 = fmaf(x44, l[0], s0); s1 = fmaf(x45, l[1], s1); s2 = fmaf(x46, l[2], s2); s3 = fmaf(x47, l[3], s3); } { const f32x4 l = *(const LAS f32x4*)(Lc + 2360); s0 = fmaf(x48, l[0], s0); s1 = fmaf(x49, l[1], s1); s2 = fmaf(x50, l[2], s2); s3 = fmaf(x51, l[3], s3); } { const f32x4 l = *(const LAS f32x4*)(Lc + 2364); s0 = fmaf(x52, l[0], s0); s1 = fmaf(x53, l[1], s1); s2 = fmaf(x54, l[2], s2); s3 = fmaf(x55, l[3], s3); } { const f32x4 l = *(const LAS f32x4*)(Lc + 2368); s0 = fmaf(x56, l[0], s0); s1 = fmaf(x57, l[1], s1); s2 = fmaf(x58, l[2], s2); s3 = fmaf(x59, l[3], s3); } { const f32x4 l = *(const LAS f32x4*)(Lc + 2372); s0 = fmaf(x60, l[0], s0); s1 = fmaf(x61, l[1], s1); s2 = fmaf(x62, l[2], s2); s3 = fmaf(x63, l[3], s3); } x34 = (lane == 34) ? 1.0f : -((s0 + s1) + (s2 + s3)); asm volatile("" : "+v"(x34) : : "memory"); }
    { float s0 = 0.f, s1 = 0.f, s2 = 0.f, s3 = 0.f; { const f32x4 l = *(const LAS f32x4*)(Lc + 2276); s2 = fmaf(x34, l[2], s2); s3 = fmaf(x35, l[3], s3); } { const f32x4 l = *(const LAS f32x4*)(Lc + 2280); s0 = fmaf(x36, l[0], s0); s1 = fmaf(x37, l[1], s1); s2 = fmaf(x38, l[2], s2); s3 = fmaf(x39, l[3], s3); } { const f32x4 l = *(const LAS f32x4*)(Lc + 2284); s0 = fmaf(x40, l[0], s0); s1 = fmaf(x41, l[1], s1); s2 = fmaf(x42, l[2], s2); s3 = fmaf(x43, l[3], s3); } { const f32x4 l = *(const LAS f32x4*)(Lc + 2288); s0 = fmaf(x44, l[0], s0); s1 = fmaf(x45, l[1], s1); s2 = fmaf(x46, l[2], s2); s3 = fmaf(x47, l[3], s3); } { const f32x4 l = *(const LAS f32x4*)(Lc + 2292); s0 = fmaf(x48, l[0], s0); s1 = fmaf(x49, l[1], s1); s2 = fmaf(x50, l[2], s2); s3 = fmaf(x51, l[3], s3); } { const f32x4 l = *(const LAS f32x4*)(Lc + 2296); s0 = fmaf(x52, l[0], s0); s1 = fmaf(x53, l[1], s1); s2 = fmaf(x54, l[2], s2); s3 = fmaf(x55, l[3], s3); } { const f32x4 l = *(const LAS f32x4*)(Lc + 2300); s0 = fmaf(x56, l[0], s0); s1 = fmaf(x57, l[1], s1); s2 = fmaf(x58, l[2], s2); s3 = fmaf(x59, l[3], s3); } { const f32x4 l = *(const LAS f32x4*)(Lc + 2304); s0 = fmaf(x60, l[0], s0); s1 = fmaf(x61, l[1], s1); s2 = fmaf(x62, l[2], s2); s3 = fmaf(x63, l[3], s3); } x33 = (lane == 33) ? 1.0f : -((s0 + s1) + (s2 + s3)); asm volatile("" : "+v"(x33) : : "memory"); }
    { float s0 = 0.f, s1 = 0.f, s2 = 0.f, s3 = 0.f; { const f32x4 l = *(const LAS f32x4*)(Lc + 2208); s1 = fmaf(x33, l[1], s1); s2 = fmaf(x34, l[2], s2); s3 = fmaf(x35, l[3], s3); } { const f32x4 l = *(const LAS f32x4*)(Lc + 2212); s0 = fmaf(x36, l[0], s0); s1 = fmaf(x37, l[1], s1); s2 = fmaf(x38, l[2], s2); s3 = fmaf(x39, l[3], s3); } { const f32x4 l = *(const LAS f32x4*)(Lc + 2216); s0 = fmaf(x40, l[0], s0); s1 = fmaf(x41, l[1], s1); s2 = fmaf(x42, l[2], s2); s3 = fmaf(x43, l[3], s3); } { const f32x4 l = *(const LAS f32x4*)(Lc + 2220); s0 = fmaf(x44, l[0], s0); s1 = fmaf(x45, l[1], s1); s2 = fmaf(x46, l[2], s2); s3 = fmaf(x47, l[3], s3); } { const f32x4 l = *(const LAS f32x4*)(Lc + 2224); s0 = fmaf(x48, l[0], s0); s1 = fmaf(x49, l[1], s1); s2 = fmaf(x50, l[2], s2); s3 = fmaf(x51, l[3], s3); } { const f32x4 l = *(const LAS f32x4*)(Lc + 2228); s0 = fmaf(x52, l[0], s0); s1 = fmaf(x53, l[1], s1); s2 = fmaf(x54, l[2], s2); s3 = fmaf(x55, l[3], s3); } { const f32x4 l = *(const LAS f32x4*)(Lc + 2232); s0 = fmaf(x56, l[0], s0); s1 = fmaf(x57, l[1], s1); s2 = fmaf(x58, l[2], s2); s3 = fmaf(x59, l[3], s3); } { const f32x4 l = *(const LAS f32x4*)(Lc + 2236); s0 = fmaf(x60, l[0], s0); s1 = fmaf(x61, l[1], s1); s2 = fmaf(x62, l[2], s2); s3 = fmaf(x63, l[3], s3); } x32 = (lane == 32) ? 1.0f : -((s0 + s1) + (s2 + s3)); asm volatile("" : "+v"(x32) : : "memory"); }
    { float s0 = 0.f, s1 = 0.f, s2 = 0.f, s3 = 0.f; { const f32x4 l = *(const LAS f32x4*)(Lc + 2140); s0 = fmaf(x32, l[0], s0); s1 = fmaf(x33, l[1], s1); s2 = fmaf(x34, l[2], s2); s3 = fmaf(x35, l[3], s3); } { const f32x4 l = *(const LAS f32x4*)(Lc + 2144); s0 = fmaf(x36, l[0], s0); s1 = fmaf(x37, l[1], s1); s2 = fmaf(x38, l[2], s2); s3 = fmaf(x39, l[3], s3); } { const f32x4 l = *(const LAS f32x4*)(Lc + 2148); s0 = fmaf(x40, l[0], s0); s1 = fmaf(x41, l[1], s1); s2 = fmaf(x42, l[2], s2); s3 = fmaf(x43, l[3], s3); } { const f32x4 l = *(const LAS f32x4*)(Lc + 2152); s0 = fmaf(x44, l[0], s0); s1 = fmaf(x45, l[1], s1); s2 = fmaf(x46, l[2], s2); s3 = fmaf(x47, l[3], s3); } { const f32x4 l = *(const LAS f32x4*)(Lc + 2156); s0 = fmaf(x48, l[0], s0); s1 = fmaf(x49, l[1], s1); s2 = fmaf(x50, l[2], s2); s3 = fmaf(x51, l[3], s3); } { const f32x4 l = *(const LAS f32x4*)(Lc + 2160); s0 = fmaf(x52, l[0], s0); s1 = fmaf(x53, l[1], s1); s2 = fmaf(x54, l[2], s2); s3 = fmaf(x55, l[3], s3); } { const f32x4 l = *(const LAS f32x4*)(Lc + 2164); s0 = fmaf(x56, l[0], s0); s1 = fmaf(x57, l[1], s1); s2 = fmaf(x58, l[2], s2); s3 = fmaf(x59, l[3], s3); } { const f32x4 l = *(const LAS f32x4*)(Lc + 2168); s0 = fmaf(x60, l[0], s0); s1 = fmaf(x61, l[1], s1); s2 = fmaf(x62, l[2], s2); s3 = fmaf(x63, l[3], s3); } x31 = (lane == 31) ? 1.0f : -((s0 + s1) + (s2 + s3)); asm volatile("" : "+v"(x31) : : "memory"); }
    { float s0 = 0.f, s1 = 0.f, s2 = 0.f, s3 = 0.f; { const f32x4 l = *(const LAS f32x4*)(Lc + 2068); s3 = fmaf(x31, l[3], s3); } { const f32x4 l = *(const LAS f32x4*)(Lc + 2072); s0 = fmaf(x32, l[0], s0); s1 = fmaf(x33, l[1], s1); s2 = fmaf(x34, l[2], s2); s3 = fmaf(x35, l[3], s3); } { const f32x4 l = *(const LAS f32x4*)(Lc + 2076); s0 = fmaf(x36, l[0], s0); s1 = fmaf(x37, l[1], s1); s2 = fmaf(x38, l[2], s2); s3 = fmaf(x39, l[3], s3); } { const f32x4 l = *(const LAS f32x4*)(Lc + 2080); s0 = fmaf(x40, l[0], s0); s1 = fmaf(x41, l[1], s1); s2 = fmaf(x42, l[2], s2); s3 = fmaf(x43, l[3], s3); } { const f32x4 l = *(const LAS f32x4*)(Lc + 2084); s0 = fmaf(x44, l[0], s0); s1 = fmaf(x45, l[1], s1); s2 = fmaf(x46, l[2], s2); s3 = fmaf(x47, l[3], s3); } { const f32x4 l = *(const LAS f32x4*)(Lc + 2088); s0 = fmaf(x48, l[0], s0); s1 = fmaf(x49, l[1], s1); s2 = fmaf(x50, l[2], s2); s3 = fmaf(x51, l[3], s3); } { const f32x4 l = *(const LAS f32x4*)(Lc + 2092); s0 = fmaf(x52, l[0], s0); s1 = fmaf(x53, l[1], s1); s2 = fmaf(x54, l[2], s2); s3 = fmaf(x55, l[3], s3); } { const f32x4 l = *(const LAS f32x4*)(Lc + 2096); s0 = fmaf(x56, l[0], s0); s1 = fmaf(x57, l[1], s1); s2 = fmaf(x58, l[2], s2); s3 = fmaf(x59, l[3], s3); } { const f32x4 l = *(const LAS f32x4*)(Lc + 2100); s0 = fmaf(x60, l[0], s0); s1 = fmaf(x61, l[1], s1); s2 = fmaf(x62, l[2], s2); s3 = fmaf(x63, l[3], s3); } x30 = (lane == 30) ? 1.0f : -((s0 + s1) + (s2 + s3)); asm volatile("" : "+v"(x30) : : "memory"); }
    { float s0 = 0.f, s1 = 0.f, s2 = 0.f, s3 = 0.f; { const f32x4 l = *(const LAS f32x4*)(Lc + 2000); s2 = fmaf(x30, l[2], s2); s3 = fmaf(x31, l[3], s3); } { const f32x4 l = *(const LAS f32x4*)(Lc + 2004); s0 = fmaf(x32, l[0], s0); s1 = fmaf(x33, l[1], s1); s2 = fmaf(x34, l[2], s2); s3 = fmaf(x35, l[3], s3); } { const f32x4 l = *(const LAS f32x4*)(Lc + 2008); s0 = fmaf(x36, l[0], s0); s1 = fmaf(x37, l[1], s1); s2 = fmaf(x38, l[2], s2); s3 = fmaf(x39, l[3], s3); } { const f32x4 l = *(const LAS f32x4*)(Lc + 2012); s0 = fmaf(x40, l[0], s0); s1 = fmaf(x41, l[1], s1); s2 = fmaf(x42, l[2], s2); s3 = fmaf(x43, l[3], s3); } { const f32x4 l = *(const LAS f32x4*)(Lc + 2016); s0 = fmaf(x44, l[0], s0); s1 = fmaf(x45, l[1], s1); s2 = fmaf(x46, l[2], s2); s3 = fmaf(x47, l[3], s3); } { const f32x4 l = *(const LAS f32x4*)(Lc + 2020); s0 = fmaf(x48, l[0], s0); s1 = fmaf(x49, l[1], s1); s2 = fmaf(x50, l[2], s2); s3 = fmaf(x51, l[3], s3); } { const f32x4 l = *(const LAS f32x4*)(Lc + 2024); s0 = fmaf(x52, l[0], s0); s1 = fmaf(x53, l[1], s1); s2 = fmaf(x54, l[2], s2); s3 = fmaf(x55, l[3], s3); } { const f32x4 l = *(const LAS f32x4*)(Lc + 2028); s0 = fmaf(x56, l[0], s0); s1 = fmaf(x57, l[1], s1); s2 = fmaf(x58, l[2], s2); s3 = fmaf(x59, l[3], s3); } { const f32x4 l = *(const LAS f32x4*)(Lc + 2032); s0 = fmaf(x60, l[0], s0); s1 = fmaf(x61, l[1], s1); s2 = fmaf(x62, l[2], s2); s3 = fmaf(x63, l[3], s3); } x29 = (lane == 29) ? 1.0f : -((s0 + s1) + (s2 + s3)); asm volatile("" : "+v"(x29) : : "memory"); }
    { float s0 = 0.f, s1 = 0.f, s2 = 0.f, s3 = 0.f; { const f32x4 l = *(const LAS f32x4*)(Lc + 1932); s1 = fmaf(x29, l[1], s1); s2 = fmaf(x30, l[2], s2); s3 = fmaf(x31, l[3], s3); } { const f32x4 l = *(const LAS f32x4*)(Lc + 1936); s0 = fmaf(x32, l[0], s0); s1 = fmaf(x33, l[1], s1); s2 = fmaf(x34, l[2], s2); s3 = fmaf(x35, l[3], s3); } { const f32x4 l = *(const LAS f32x4*)(Lc + 1940); s0 = fmaf(x36, l[0], s0); s1 = fmaf(x37, l[1], s1); s2 = fmaf(x38, l[2], s2); s3 = fmaf(x39, l[3], s3); } { const f32x4 l = *(const LAS f32x4*)(Lc + 1944); s0 = fmaf(x40, l[0], s0); s1 = fmaf(x41, l[1], s1); s2 = fmaf(x42, l[2], s2); s3 = fmaf(x43, l[3], s3); } { const f32x4 l = *(const LAS f32x4*)(Lc + 1948); s0 = fmaf(x44, l[0], s0); s1 = fmaf(x45, l[1], s1); s2 = fmaf(x46, l[2], s2); s3 = fmaf(x47, l[3], s3); } { const f32x4 l = *(const LAS f32x4*)(Lc + 1952); s0 = fmaf(x48, l[0], s0); s1 = fmaf(x49, l[1], s1); s2 = fmaf(x50, l[2], s2); s3 = fmaf(x51, l[3], s3); } { const f32x4 l = *(const LAS f32x4*)(Lc + 1956); s0 = fmaf(x52, l[0], s0); s1 = fmaf(x53, l[1], s1); s2 = fmaf(x54, l[2], s2); s3 = fmaf(x55, l[3], s3); } { const f32x4 l = *(const LAS f32x4*)(Lc + 1960); s0 = fmaf(x56, l[0], s0); s1 = fmaf(x57, l[1], s1); s2 = fmaf(x58, l[2], s2); s3 = fmaf(x59, l[3], s3); } { const f32x4 l = *(const LAS f32x4*)(Lc + 1964); s0 = fmaf(x60, l[0], s0); s1 = fmaf(x61, l[1], s1); s2 = fmaf(x62, l[2], s2); s3 = fmaf(x63, l[3], s3); } x28 = (lane == 28) ? 1.0f : -((s0 + s1) + (s2 + s3)); asm volatile("" : "+v"(x28) : : "memory"); }
    { float s0 = 0.f, s1 = 0.f, s2 = 0.f, s3 = 0.f; { const f32x4 l = *(const LAS f32x4*)(Lc + 1864); s0 = fmaf(x28, l[0], s0); s1 = fmaf(x29, l[1], s1); s2 = fmaf(x30, l[2], s2); s3 = fmaf(x31, l[3], s3); } { const f32x4 l = *(const LAS f32x4*)(Lc + 1868); s0 = fmaf(x32, l[0], s0); s1 = fmaf(x33, l[1], s1); s2 = fmaf(x34, l[2], s2); s3 = fmaf(x35, l[3], s3); } { const f32x4 l = *(const LAS f32x4*)(Lc + 1872); s0 = fmaf(x36, l[0], s0); s1 = fmaf(x37, l[1], s1); s2 = fmaf(x38, l[2], s2); s3 = fmaf(x39, l[3], s3); } { const f32x4 l = *(const LAS f32x4*)(Lc + 1876); s0 = fmaf(x40, l[0], s0); s1 = fmaf(x41, l[1], s1); s2 = fmaf(x42, l[2], s2); s3 = fmaf(x43, l[3], s3); } { const f32x4 l = *(const LAS f32x4*)(Lc + 1880); s0 = fmaf(x44, l[0], s0); s1 = fmaf(x45, l[1], s1); s2 = fmaf(x46, l[2], s2); s3 = fmaf(x47, l[3], s3); } { const f32x4 l = *(const LAS f32x4*)(Lc + 1884); s0 = fmaf(x48, l[0], s0); s1 = fmaf(x49, l[1], s1); s2 = fmaf(x50, l[2], s2); s3 = fmaf(x51, l[3], s3); } { const f32x4 l = *(const LAS f32x4*)(Lc + 1888); s0 = fmaf(x52, l[0], s0); s1 = fmaf(x53, l[1], s1); s2 = fmaf(x54, l[2], s2); s3 = fmaf(x55, l[3], s3); } { const f32x4 l = *(const LAS f32x4*)(Lc + 1892); s0 = fmaf(x56, l[0], s0); s1 = fmaf(x57, l[1], s1); s2 = fmaf(x58, l[2], s2); s3 = fmaf(x59, l[3], s3); } { const f32x4 l = *(const LAS f32x4*)(Lc + 1896); s0 = fmaf(x60, l[0], s0); s1 = fmaf(x61, l[1], s1); s2 = fmaf(x62, l[2], s2); s3 = fmaf(x63, l[3], s3); } x27 = (lane == 27) ? 1.0f : -((s0 + s1) + (s2 + s3)); asm volatile("" : "+v"(x27) : : "memory"); }
    { float s0 = 0.f, s1 = 0.f, s2 = 0.f, s3 = 0.f; { const f32x4 l = *(const LAS f32x4*)(Lc + 1792); s3 = fmaf(x27, l[3], s3); } { const f32x4 l = *(const LAS f32x4*)(Lc + 1796); s0 = fmaf(x28, l[0], s0); s1 = fmaf(x29, l[1], s1); s2 = fmaf(x30, l[2], s2); s3 = fmaf(x31, l[3], s3); } { const f32x4 l = *(const LAS f32x4*)(Lc + 1800); s0 = fmaf(x32, l[0], s0); s1 = fmaf(x33, l[1], s1); s2 = fmaf(x34, l[2], s2); s3 = fmaf(x35, l[3], s3); } { const f32x4 l = *(const LAS f32x4*)(Lc + 1804); s0 = fmaf(x36, l[0], s0); s1 = fmaf(x37, l[1], s1); s2 = fmaf(x38, l[2], s2); s3 = fmaf(x39, l[3], s3); } { const f32x4 l = *(const LAS f32x4*)(Lc + 1808); s0 = fmaf(x40, l[0], s0); s1 = fmaf(x41, l[1], s1); s2 = fmaf(x42, l[2], s2); s3 = fmaf(x43, l[3], s3); } { const f32x4 l = *(const LAS f32x4*)(Lc + 1812); s0 = fmaf(x44, l[0], s0); s1 = fmaf(x45, l[1], s1); s2 = fmaf(x46, l[2], s2); s3 = fmaf(x47, l[3], s3); } { const f32x4 l = *(const LAS f32x4*)(Lc + 1816); s0 = fmaf(x48, l[0], s0); s1 = fmaf(x49, l[1], s1); s2 = fmaf(x50, l[2], s2); s3 = fmaf(x51, l[3], s3); } { const f32x4 l = *(const LAS f32x4*)(Lc + 1820); s0 = fmaf(x52, l[0], s0); s1 = fmaf(x53, l[1], s1); s2 = fmaf(x54, l[2], s2); s3 = fmaf(x55, l[3], s3); } { const f32x4 l = *(const LAS f32x4*)(Lc + 1824); s0 = fmaf(x56, l[0], s0); s1 = fmaf(x57, l[1], s1); s2 = fmaf(x58, l[2], s2); s3 = fmaf(x59, l[3], s3); } { const f32x4 l = *(const LAS f32x4*)(Lc + 1828); s0 = fmaf(x60, l[0], s0); s1 = fmaf(x61, l[1], s1); s2 = fmaf(x62, l[2], s2); s3 = fmaf(x63, l[3], s3); } x26 = (lane == 26) ? 1.0f : -((s0 + s1) + (s2 + s3)); asm volatile("" : "+v"(x26) : : "memory"); }
    { float s0 = 0.f, s1 = 0.f, s2 = 0.f, s3 = 0.f; { const f32x4 l = *(const LAS f32x4*)(Lc + 1724); s2 = fmaf(x26, l[2], s2); s3 = fmaf(x27, l[3], s3); } { const f32x4 l = *(const LAS f32x4*)(Lc + 1728); s0 = fmaf(x28, l[0], s0); s1 = fmaf(x29, l[1], s1); s2 = fmaf(x30, l[2], s2); s3 = fmaf(x31, l[3], s3); } { const f32x4 l = *(const LAS f32x4*)(Lc + 1732); s0 = fmaf(x32, l[0], s0); s1 = fmaf(x33, l[1], s1); s2 = fmaf(x34, l[2], s2); s3 = fmaf(x35, l[3], s3); } { const f32x4 l = *(const LAS f32x4*)(Lc + 1736); s0 = fmaf(x36, l[0], s0); s1 = fmaf(x37, l[1], s1); s2 = fmaf(x38, l[2], s2); s3 = fmaf(x39, l[3], s3); } { const f32x4 l = *(const LAS f32x4*)(Lc + 1740); s0 = fmaf(x40, l[0], s0); s1 = fmaf(x41, l[1], s1); s2 = fmaf(x42, l[2], s2); s3 = fmaf(x43, l[3], s3); } { const f32x4 l = *(const LAS f32x4*)(Lc + 1744); s0 = fmaf(x44, l[0], s0); s1 = fmaf(x45, l[1], s1); s2 = fmaf(x46, l[2], s2); s3 = fmaf(x47, l[3], s3); } { const f32x4 l = *(const LAS f32x4*)(Lc + 1748); s0 = fmaf(x48, l[0], s0); s1 = fmaf(x49, l[1], s1); s2 = fmaf(x50, l[2], s2); s3 = fmaf(x51, l[3], s3); } { const f32x4 l = *(const LAS f32x4*)(Lc + 1752); s0 = fmaf(x52, l[0], s0); s1 = fmaf(x53, l[1], s1); s2 = fmaf(x54, l[2], s2); s3 = fmaf(x55, l[3], s3); } { const f32x4 l = *(const LAS f32x4*)(Lc + 1756); s0 = fmaf(x56, l[0], s0); s1 = fmaf(x57, l[1], s1); s2 = fmaf(x58, l[2], s2); s3 = fmaf(x59, l[3], s3); } { const f32x4 l = *(const LAS f32x4*)(Lc + 1760); s0 = fmaf(x60, l[0], s0); s1 = fmaf(x61, l[1], s1); s2 = fmaf(x62, l[2], s2); s3 = fmaf(x63, l[3], s3); } x25 = (lane == 25) ? 1.0f : -((s0 + s1) + (s2 + s3)); asm volatile("" : "+v"(x25) : : "memory"); }
    { float s0 = 0.f, s1 = 0.f, s2 = 0.f, s3 = 0.f; { const f32x4 l = *(const LAS f32x4*)(Lc + 1656); s1 = fmaf(x25, l[1], s1); s2 = fmaf(x26, l[2], s2); s3 = fmaf(x27, l[3], s3); } { const f32x4 l = *(const LAS f32x4*)(Lc + 1660); s0 = fmaf(x28, l[0], s0); s1 = fmaf(x29, l[1], s1); s2 = fmaf(x30, l[2], s2); s3 = fmaf(x31, l[3], s3); } { const f32x4 l = *(const LAS f32x4*)(Lc + 1664); s0 = fmaf(x32, l[0], s0); s1 = fmaf(x33, l[1], s1); s2 = fmaf(x34, l[2], s2); s3 = fmaf(x35, l[3], s3); } { const f32x4 l = *(const LAS f32x4*)(Lc + 1668); s0 = fmaf(x36, l[0], s0); s1 = fmaf(x37, l[1], s1); s2 = fmaf(x38, l[2], s2); s3 = fmaf(x39, l[3], s3); } { const f32x4 l = *(const LAS f32x4*)(Lc + 1672); s0 = fmaf(x40, l[0], s0); s1 = fmaf(x41, l[1], s1); s2 = fmaf(x42, l[2], s2); s3 = fmaf(x43, l[3], s3); } { const f32x4 l = *(const LAS f32x4*)(Lc + 1676); s0 = fmaf(x44, l[0], s0); s1 = fmaf(x45, l[1], s1); s2 = fmaf(x46, l[2], s2); s3 = fmaf(x47, l[3], s3); } { const f32x4 l = *(const LAS f32x4*)(Lc + 1680); s0 = fmaf(x48, l[0], s0); s1 = fmaf(x49, l[1], s1); s2 = fmaf(x50, l[2], s2); s3 = fmaf(x51, l[3], s3); } { const f32x4 l = *(const LAS f32x4*)(Lc + 1684); s0 = fmaf(x52, l[0], s0); s1 = fmaf(x53, l[1], s1); s2 = fmaf(x54, l[2], s2); s3 = fmaf(x55, l[3], s3); } { const f32x4 l = *(const LAS f32x4*)(Lc + 1688); s0 = fmaf(x56, l[0], s0); s1 = fmaf(x57, l[1], s1); s2 = fmaf(x58, l[2], s2); s3 = fmaf(x59, l[3], s3); } { const f32x4 l = *(const LAS f32x4*)(Lc + 1692); s0 = fmaf(x60, l[0], s0); s1 = fmaf(x61, l[1], s1); s2 = fmaf(x62, l[2], s2); s3 = fmaf(x63, l[3], s3); } x24 = (lane == 24) ? 1.0f : -((s0 + s1) + (s2 + s3)); asm volatile("" : "+v"(x24) : : "memory"); }
    { float s0 = 0.f, s1 = 0.f, s2 = 0.f, s3 = 0.f; { const f32x4 l = *(const LAS f32x4*)(Lc + 1588); s0 = fmaf(x24, l[0], s0); s1 = fmaf(x25, l[1], s1); s2 = fmaf(x26, l[2], s2); s3 = fmaf(x27, l[3], s3); } { const f32x4 l = *(const LAS f32x4*)(Lc + 1592); s0 = fmaf(x28, l[0], s0); s1 = fmaf(x29, l[1], s1); s2 = fmaf(x30, l[2], s2); s3 = fmaf(x31, l[3], s3); } { const f32x4 l = *(const LAS f32x4*)(Lc + 1596); s0 = fmaf(x32, l[0], s0); s1 = fmaf(x33, l[1], s1); s2 = fmaf(x34, l[2], s2); s3 = fmaf(x35, l[3], s3); } { const f32x4 l = *(const LAS f32x4*)(Lc + 1600); s0 = fmaf(x36, l[0], s0); s1 = fmaf(x37, l[1], s1); s2 = fmaf(x38, l[2], s2); s3 = fmaf(x39, l[3], s3); } { const f32x4 l = *(const LAS f32x4*)(Lc + 1604); s0 = fmaf(x40, l[0], s0); s1 = fmaf(x41, l[1], s1); s2 = fmaf(x42, l[2], s2); s3 = fmaf(x43, l[3], s3); } { const f32x4 l = *(const LAS f32x4*)(Lc + 1608); s0 = fmaf(x44, l[0], s0); s1 = fmaf(x45, l[1], s1); s2 = fmaf(x46, l[2], s2); s3 = fmaf(x47, l[3], s3); } { const f32x4 l = *(const LAS f32x4*)(Lc + 1612); s0 = fmaf(x48, l[0], s0); s1 = fmaf(x49, l[1], s1); s2 = fmaf(x50, l[2], s2); s3 = fmaf(x51, l[3], s3); } { const f32x4 l = *(const LAS f32x4*)(Lc + 1616); s0 = fmaf(x52, l[0], s0); s1 = fmaf(x53, l[1], s1); s2 = fmaf(x54, l[2], s2); s3 = fmaf(x55, l[3], s3); } { const f32x4 l = *(const LAS f32x4*)(Lc + 1620); s0 = fmaf(x56, l[0], s0); s1 = fmaf(x57, l[1], s1); s2 = fmaf(x58, l[2], s2); s3 = fmaf(x59, l[3], s3); } { const f32x4 l = *(const LAS f32x4*)(Lc + 1624); s0 = fmaf(x60, l[0], s0); s1 = fmaf(x61, l[1], s1); s2 = fmaf(x62, l[2], s2); s3 = fmaf(x63, l[3], s3); } x23 = (lane == 23) ? 1.0f : -((s0 + s1) + (s2 + s3)); asm volatile("" : "+v"(x23) : : "memory"); }
    { float s0 = 0.f, s1 = 0.f, s2 = 0.f, s3 = 0.f; { const f32x4 l = *(const LAS f32x4*)(Lc + 1516); s3 = fmaf(x23, l[3], s3); } { const f32x4 l = *(const LAS f32x4*)(Lc + 1520); s0 = fmaf(x24, l[0], s0); s1 = fmaf(x25, l[1], s1); s2 = fmaf(x26, l[2], s2); s3 = fmaf(x27, l[3], s3); } { const f32x4 l = *(const LAS f32x4*)(Lc + 1524); s0 = fmaf(x28, l[0], s0); s1 = fmaf(x29, l[1], s1); s2 = fmaf(x30, l[2], s2); s3 = fmaf(x31, l[3], s3); } { const f32x4 l = *(const LAS f32x4*)(Lc + 1528); s0 = fmaf(x32, l[0], s0); s1 = fmaf(x33, l[1], s1); s2 = fmaf(x34, l[2], s2); s3 = fmaf(x35, l[3], s3); } { const f32x4 l = *(const LAS f32x4*)(Lc + 1532); s0 = fmaf(x36, l[0], s0); s1 = fmaf(x37, l[1], s1); s2 = fmaf(x38, l[2], s2); s3 = fmaf(x39, l[3], s3); } { const f32x4 l = *(const LAS f32x4*)(Lc + 1536); s0 = fmaf(x40, l[0], s0); s1 = fmaf(x41, l[1], s1); s2 = fmaf(x42, l[2], s2); s3 = fmaf(x43, l[3], s3); } { const f32x4 l = *(const LAS f32x4*)(Lc + 1540); s0 = fmaf(x44, l[0], s0); s1 = fmaf(x45, l[1], s1); s2 = fmaf(x46, l[2], s2); s3 = fmaf(x47, l[3], s3); } { const f32x4 l = *(const LAS f32x4*)(Lc + 1544); s0 = fmaf(x48, l[0], s0); s1 = fmaf(x49, l[1], s1); s2 = fmaf(x50, l[2], s2); s3 = fmaf(x51, l[3], s3); } { const f32x4 l = *(const LAS f32x4*)(Lc + 1548); s0 = fmaf(x52, l[0], s0); s1 = fmaf(x53, l[1], s1); s2 = fmaf(x54, l[2], s2); s3 = fmaf(x55, l[3], s3); } { const f32x4 l = *(const LAS f32x4*)(Lc + 1552); s0 = fmaf(x56, l[0], s0); s1 = fmaf(x57, l[1], s1); s2 = fmaf(x58, l[2], s2); s3 = fmaf(x59, l[3], s3); } { const f32x4 l = *(const LAS f32x4*)(Lc + 1556); s0 = fmaf(x60, l[0], s0); s1 = fmaf(x61, l[1], s1); s2 = fmaf(x62, l[2], s2); s3 = fmaf(x63, l[3], s3); } x22 = (lane == 22) ? 1.0f : -((s0 + s1) + (s2 + s3)); asm volatile("" : "+v"(x22) : : "memory"); }
    { float s0 = 0.f, s1 = 0.f, s2 = 0.f, s3 = 0.f; { const f32x4 l = *(const LAS f32x4*)(Lc + 1448); s2 = fmaf(x22, l[2], s2); s3 = fmaf(x23, l[3], s3); } { const f32x4 l = *(const LAS f32x4*)(Lc + 1452); s0 = fmaf(x24, l[0], s0); s1 = fmaf(x25, l[1], s1); s2 = fmaf(x26, l[2], s2); s3 = fmaf(x27, l[3], s3); } { const f32x4 l = *(const LAS f32x4*)(Lc + 1456); s0 = fmaf(x28, l[0], s0); s1 = fmaf(x29, l[1], s1); s2 = fmaf(x30, l[2], s2); s3 = fmaf(x31, l[3], s3); } { const f32x4 l = *(const LAS f32x4*)(Lc + 1460); s0 = fmaf(x32, l[0], s0); s1 = fmaf(x33, l[1], s1); s2 = fmaf(x34, l[2], s2); s3 = fmaf(x35, l[3], s3); } { const f32x4 l = *(const LAS f32x4*)(Lc + 1464); s0 = fmaf(x36, l[0], s0); s1 = fmaf(x37, l[1], s1); s2 = fmaf(x38, l[2], s2); s3 = fmaf(x39, l[3], s3); } { const f32x4 l = *(const LAS f32x4*)(Lc + 1468); s0 = fmaf(x40, l[0], s0); s1 = fmaf(x41, l[1], s1); s2 = fmaf(x42, l[2], s2); s3 = fmaf(x43, l[3], s3); } { const f32x4 l = *(const LAS f32x4*)(Lc + 1472); s0 = fmaf(x44, l[0], s0); s1 = fmaf(x45, l[1], s1); s2 = fmaf(x46, l[2], s2); s3 = fmaf(x47, l[3], s3); } { const f32x4 l = *(const LAS f32x4*)(Lc + 1476); s0 = fmaf(x48, l[0], s0); s1 = fmaf(x49, l[1], s1); s2 = fmaf(x50, l[2], s2); s3 = fmaf(x51, l[3], s3); } { const f32x4 l = *(const LAS f32x4*)(Lc + 1480); s0 = fmaf(x52, l[0], s0); s1 = fmaf(x53, l[1], s1); s2 = fmaf(x54, l[2], s2); s3 = fmaf(x55, l[3], s3); } { const f32x4 l = *(const LAS f32x4*)(Lc + 1484); s0 = fmaf(x56, l[0], s0); s1 = fmaf(x57, l[1], s1); s2 = fmaf(x58, l[2], s2); s3 = fmaf(x59, l[3], s3); } { const f32x4 l = *(const LAS f32x4*)(Lc + 1488); s0 = fmaf(x60, l[0], s0); s1 = fmaf(x61, l[1], s1); s2 = fmaf(x62, l[2], s2); s3 = fmaf(x63, l[3], s3); } x21 = (lane == 21) ? 1.0f : -((s0 + s1) + (s2 + s3)); asm volatile("" : "+v"(x21) : : "memory"); }
    { float s0 = 0.f, s1 = 0.f, s2 = 0.f, s3 = 0.f; { const f32x4 l = *(const LAS f32x4*)(Lc + 1380); s1 = fmaf(x21, l[1], s1); s2 = fmaf(x22, l[2], s2); s3 = fmaf(x23, l[3], s3); } { const f32x4 l = *(const LAS f32x4*)(Lc + 1384); s0 = fmaf(x24, l[0], s0); s1 = fmaf(x25, l[1], s1); s2 = fmaf(x26, l[2], s2); s3 = fmaf(x27, l[3], s3); } { const f32x4 l = *(const LAS f32x4*)(Lc + 1388); s0 = fmaf(x28, l[0], s0); s1 = fmaf(x29, l[1], s1); s2 = fmaf(x30, l[2], s2); s3 = fmaf(x31, l[3], s3); } { const f32x4 l = *(const LAS f32x4*)(Lc + 1392); s0 = fmaf(x32, l[0], s0); s1 = fmaf(x33, l[1], s1); s2 = fmaf(x34, l[2], s2); s3 = fmaf(x35, l[3], s3); } { const f32x4 l = *(const LAS f32x4*)(Lc + 1396); s0 = fmaf(x36, l[0], s0); s1 = fmaf(x37, l[1], s1); s2 = fmaf(x38, l[2], s2); s3 = fmaf(x39, l[3], s3); } { const f32x4 l = *(const LAS f32x4*)(Lc + 1400); s0 = fmaf(x40, l[0], s0); s1 = fmaf(x41, l[1], s1); s2 = fmaf(x42, l[2], s2); s3 = fmaf(x43, l[3], s3); } { const f32x4 l = *(const LAS f32x4*)(Lc + 1404); s0 = fmaf(x44, l[0], s0); s1 = fmaf(x45, l[1], s1); s2 = fmaf(x46, l[2], s2); s3 = fmaf(x47, l[3], s3); } { const f32x4 l = *(const LAS f32x4*)(Lc + 1408); s0 = fmaf(x48, l[0], s0); s1 = fmaf(x49, l[1], s1); s2 = fmaf(x50, l[2], s2); s3 = fmaf(x51, l[3], s3); } { const f32x4 l = *(const LAS f32x4*)(Lc + 1412); s0 = fmaf(x52, l[0], s0); s1 = fmaf(x53, l[1], s1); s2 = fmaf(x54, l[2], s2); s3 = fmaf(x55, l[3], s3); } { const f32x4 l = *(const LAS f32x4*)(Lc + 1416); s0 = fmaf(x56, l[0], s0); s1 = fmaf(x57, l[1], s1); s2 = fmaf(x58, l[2], s2); s3 = fmaf(x59, l[3], s3); } { const f32x4 l = *(const LAS f32x4*)(Lc + 1420); s0 = fmaf(x60, l[0], s0); s1 = fmaf(x61, l[1], s1); s2 = fmaf(x62, l[2], s2); s3 = fmaf(x63, l[3], s3); } x20 = (lane == 20) ? 1.0f : -((s0 + s1) + (s2 + s3)); asm volatile("" : "+v"(x20) : : "memory"); }
    { float s0 = 0.f, s1 = 0.f, s2 = 0.f, s3 = 0.f; { const f32x4 l = *(const LAS f32x4*)(Lc + 1312); s0 = fmaf(x20, l[0], s0); s1 = fmaf(x21, l[1], s1); s2 = fmaf(x22, l[2], s2); s3 = fmaf(x23, l[3], s3); } { const f32x4 l = *(const LAS f32x4*)(Lc + 1316); s0 = fmaf(x24, l[0], s0); s1 = fmaf(x25, l[1], s1); s2 = fmaf(x26, l[2], s2); s3 = fmaf(x27, l[3], s3); } { const f32x4 l = *(const LAS f32x4*)(Lc + 1320); s0 = fmaf(x28, l[0], s0); s1 = fmaf(x29, l[1], s1); s2 = fmaf(x30, l[2], s2); s3 = fmaf(x31, l[3], s3); } { const f32x4 l = *(const LAS f32x4*)(Lc + 1324); s0 = fmaf(x32, l[0], s0); s1 = fmaf(x33, l[1], s1); s2 = fmaf(x34, l[2], s2); s3 = fmaf(x35, l[3], s3); } { const f32x4 l = *(const LAS f32x4*)(Lc + 1328); s0 = fmaf(x36, l[0], s0); s1 = fmaf(x37, l[1], s1); s2 = fmaf(x38, l[2], s2); s3 = fmaf(x39, l[3], s3); } { const f32x4 l = *(const LAS f32x4*)(Lc + 1332); s0 = fmaf(x40, l[0], s0); s1 = fmaf(x41, l[1], s1); s2 = fmaf(x42, l[2], s2); s3 = fmaf(x43, l[3], s3); } { const f32x4 l = *(const LAS f32x4*)(Lc + 1336); s0 = fmaf(x44, l[0], s0); s1 = fmaf(x45, l[1], s1); s2 = fmaf(x46, l[2], s2); s3 = fmaf(x47, l[3], s3); } { const f32x4 l = *(const LAS f32x4*)(Lc + 1340); s0 = fmaf(x48, l[0], s0); s1 = fmaf(x49, l[1], s1); s2 = fmaf(x50, l[2], s2); s3 = fmaf(x51, l[3], s3); } { const f32x4 l = *(const LAS f32x4*)(Lc + 1344); s0 = fmaf(x52, l[0], s0); s1 = fmaf(x53, l[1], s1); s2 = fmaf(x54, l[2], s2); s3 = fmaf(x55, l[3], s3); } { const f32x4 l = *(const LAS f32x4*)(Lc + 1348); s0 = fmaf(x56, l[0], s0); s1 = fmaf(x57, l[1], s1); s2 = fmaf(x58, l[2], s2); s3 = fmaf(x59, l[3], s3); } { const f32x4 l = *(const LAS f32x4*)(Lc + 1352); s0 = fmaf(x60, l[0], s0); s1 = fmaf(x61, l[1], s1); s2 = fmaf(x62, l[2], s2); s3 = fmaf(x63, l[3], s3); } x19 = (lane == 19) ? 1.0f : -((s0 + s1) + (s2 + s3)); asm volatile("" : "+v"(x19) : : "memory"); }
    { float s0 = 0.f, s1 = 0.f, s2 = 0.f, s3 = 0.f; { const f32x4 l = *(const LAS f32x4*)(Lc + 1240); s3 = fmaf(x19, l[3], s3); } { const f32x4 l = *(const LAS f32x4*)(Lc + 1244); s0 = fmaf(x20, l[0], s0); s1 = fmaf(x21, l[1], s1); s2 = fmaf(x22, l[2], s2); s3 = fmaf(x23, l[3], s3); } { const f32x4 l = *(const LAS f32x4*)(Lc + 1248); s0 = fmaf(x24, l[0], s0); s1 = fmaf(x25, l[1], s1); s2 = fmaf(x26, l[2], s2); s3 = fmaf(x27, l[3], s3); } { const f32x4 l = *(const LAS f32x4*)(Lc + 1252); s0 = fmaf(x28, l[0], s0); s1 = fmaf(x29, l[1], s1); s2 = fmaf(x30, l[2], s2); s3 = fmaf(x31, l[3], s3); } { const f32x4 l = *(const LAS f32x4*)(Lc + 1256); s0 = fmaf(x32, l[0], s0); s1 = fmaf(x33, l[1], s1); s2 = fmaf(x34, l[2], s2); s3 = fmaf(x35, l[3], s3); } { const f32x4 l = *(const LAS f32x4*)(Lc + 1260); s0 = fmaf(x36, l[0], s0); s1 = fmaf(x37, l[1], s1); s2 = fmaf(x38, l[2], s2); s3 = fmaf(x39, l[3], s3); } { const f32x4 l = *(const LAS f32x4*)(Lc + 1264); s0 = fmaf(x40, l[0], s0); s1 = fmaf(x41, l[1], s1); s2 = fmaf(x42, l[2], s2); s3 = fmaf(x43, l[3], s3); } { const f32x4 l = *(const LAS f32x4*)(Lc + 1268); s0 = fmaf(x44, l[0], s0); s1 = fmaf(x45, l[1], s1); s2 = fmaf(x46, l[2], s2); s3 = fmaf(x47, l[3], s3); } { const f32x4 l = *(const LAS f32x4*)(Lc + 1272); s0 = fmaf(x48, l[0], s0); s1 = fmaf(x49, l[1], s1); s2 = fmaf(x50, l[2], s2); s3 = fmaf(x51, l[3], s3); } { const f32x4 l = *(const LAS f32x4*)(Lc + 1276); s0 = fmaf(x52, l[0], s0); s1 = fmaf(x53, l[1], s1); s2 = fmaf(x54, l[2], s2); s3 = fmaf(x55, l[3], s3); } { const f32x4 l = *(const LAS f32x4*)(Lc + 1280); s0 = fmaf(x56, l[0], s0); s1 = fmaf(x57, l[1], s1); s2 = fmaf(x58, l[2], s2); s3 = fmaf(x59, l[3], s3); } { const f32x4 l = *(const LAS f32x4*)(Lc + 1284); s0 = fmaf(x60, l[0], s0); s1 = fmaf(x61, l[1], s1); s2 = fmaf(x62, l[2], s2); s3 = fmaf(x63, l[3], s3); } x18 = (lane == 18) ? 1.0f : -((s0 + s1) + (s2 + s3)); asm volatile("" : "+v"(x18) : : "memory"); }
    { float s0 = 0.f, s1 = 0.f, s2 = 0.f, s3 = 0.f; { const f32x4 l = *(const LAS f32x4*)(Lc + 1172); s2 = fmaf(x18, l[2], s2); s3 = fmaf(x19, l[3], s3); } { const f32x4 l = *(const LAS f32x4*)(Lc + 1176); s0 = fmaf(x20, l[0], s0); s1 = fmaf(x21, l[1], s1); s2 = fmaf(x22, l[2], s2); s3 = fmaf(x23, l[3], s3); } { const f32x4 l = *(const LAS f32x4*)(Lc + 1180); s0 = fmaf(x24, l[0], s0); s1 = fmaf(x25, l[1], s1); s2 = fmaf(x26, l[2], s2); s3 = fmaf(x27, l[3], s3); } { const f32x4 l = *(const LAS f32x4*)(Lc + 1184); s0 = fmaf(x28, l[0], s0); s1 = fmaf(x29, l[1], s1); s2 = fmaf(x30, l[2], s2); s3 = fmaf(x31, l[3], s3); } { const f32x4 l = *(const LAS f32x4*)(Lc + 1188); s0 = fmaf(x32, l[0], s0); s1 = fmaf(x33, l[1], s1); s2 = fmaf(x34, l[2], s2); s3 = fmaf(x35, l[3], s3); } { const f32x4 l = *(const LAS f32x4*)(Lc + 1192); s0 = fmaf(x36, l[0], s0); s1 = fmaf(x37, l[1], s1); s2 = fmaf(x38, l[2], s2); s3 = fmaf(x39, l[3], s3); } { const f32x4 l = *(const LAS f32x4*)(Lc + 1196); s0 = fmaf(x40, l[0], s0); s1 = fmaf(x41, l[1], s1); s2 = fmaf(x42, l[2], s2); s3 = fmaf(x43, l[3], s3); } { const f32x4 l = *(const LAS f32x4*)(Lc + 1200); s0 = fmaf(x44, l[0], s0); s1 = fmaf(x45, l[1], s1); s2 = fmaf(x46, l[2], s2); s3 = fmaf(x47, l[3], s3); } { const f32x4 l = *(const LAS f32x4*)(Lc + 1204); s0 = fmaf(x48, l[0], s0); s1 = fmaf(x49, l[1], s1); s2 = fmaf(x50, l[2], s2); s3 = fmaf(x51, l[3], s3); } { const f32x4 l = *(const LAS f32x4*)(Lc + 1208); s0 = fmaf(x52, l[0], s0); s1 = fmaf(x53, l[1], s1); s2 = fmaf(x54, l[2], s2); s3 = fmaf(x55, l[3], s3); } { const f32x4 l = *(const LAS f32x4*)(Lc + 1212); s0 = fmaf(x56, l[0], s0); s1 = fmaf(x57, l[1], s1); s2 = fmaf(x58, l[2], s2); s3 = fmaf(x59, l[3], s3); } { const f32x4 l = *(const LAS f32x4*)(Lc + 1216); s0 = fmaf(x60, l[0], s0); s1 = fmaf(x61, l[1], s1); s2 = fmaf(x62, l[2], s2); s3 = fmaf(x63, l[3], s3); } x17 = (lane == 17) ? 1.0f : -((s0 + s1) + (s2 + s3)); asm volatile("" : "+v"(x17) : : "memory"); }
    { float s0 = 0.f, s1 = 0.f, s2 = 0.f, s3 = 0.f; { const f32x4 l = *(const LAS f32x4*)(Lc + 1104); s1 = fmaf(x17, l[1], s1); s2 = fmaf(x18, l[2], s2); s3 = fmaf(x19, l[3], s3); } { const f32x4 l = *(const LAS f32x4*)(Lc + 1108); s0 = fmaf(x20, l[0], s0); s1 = fmaf(x21, l[1], s1); s2 = fmaf(x22, l[2], s2); s3 = fmaf(x23, l[3], s3); } { const f32x4 l = *(const LAS f32x4*)(Lc + 1112); s0 = fmaf(x24, l[0], s0); s1 = fmaf(x25, l[1], s1); s2 = fmaf(x26, l[2], s2); s3 = fmaf(x27, l[3], s3); } { const f32x4 l = *(const LAS f32x4*)(Lc + 1116); s0 = fmaf(x28, l[0], s0); s1 = fmaf(x29, l[1], s1); s2 = fmaf(x30, l[2], s2); s3 = fmaf(x31, l[3], s3); } { const f32x4 l = *(const LAS f32x4*)(Lc + 1120); s0 = fmaf(x32, l[0], s0); s1 = fmaf(x33, l[1], s1); s2 = fmaf(x34, l[2], s2); s3 = fmaf(x35, l[3], s3); } { const f32x4 l = *(const LAS f32x4*)(Lc + 1124); s0 = fmaf(x36, l[0], s0); s1 = fmaf(x37, l[1], s1); s2 = fmaf(x38, l[2], s2); s3 = fmaf(x39, l[3], s3); } { const f32x4 l = *(const LAS f32x4*)(Lc + 1128); s0 = fmaf(x40, l[0], s0); s1 = fmaf(x41, l[1], s1); s2 = fmaf(x42, l[2], s2); s3 = fmaf(x43, l[3], s3); } { const f32x4 l = *(const LAS f32x4*)(Lc + 1132); s0 = fmaf(x44, l[0], s0); s1 = fmaf(x45, l[1], s1); s2 = fmaf(x46, l[2], s2); s3 = fmaf(x47, l[3], s3); } { const f32x4 l = *(const LAS f32x4*)(Lc + 1136); s0 = fmaf(x48, l[0], s0); s1 = fmaf(x49, l[1], s1); s2 = fmaf(x50, l[2], s2); s3 = fmaf(x51, l[3], s3); } { const f32x4 l = *(const LAS f32x4*)(Lc + 1140); s0 = fmaf(x52, l[0], s0); s1 = fmaf(x53, l[1], s1); s2 = fmaf(x54, l[2], s2); s3 = fmaf(x55, l[3], s3); } { const f32x4 l = *(const LAS f32x4*)(Lc + 1144); s0 = fmaf(x56, l[0], s0); s1 = fmaf(x57, l[1], s1); s2 = fmaf(x58, l[2], s2); s3 = fmaf(x59, l[3], s3); } { const f32x4 l = *(const LAS f32x4*)(Lc + 1148); s0 = fmaf(x60, l[0], s0); s1 = fmaf(x61, l[1], s1); s2 = fmaf(x62, l[2], s2); s3 = fmaf(x63, l[3], s3); } x16 = (lane == 16) ? 1.0f : -((s0 + s1) + (s2 + s3)); asm volatile("" : "+v"(x16) : : "memory"); }
    { float s0 = 0.f, s1 = 0.f, s2 = 0.f, s3 = 0.f; { const f32x4 l = *(const LAS f32x4*)(Lc + 1036); s0 = fmaf(x16, l[0], s0); s1 = fmaf(x17, l[1], s1); s2 = fmaf(x18, l[2], s2); s3 = fmaf(x19, l[3], s3); } { const f32x4 l = *(const LAS f32x4*)(Lc + 1040); s0 = fmaf(x20, l[0], s0); s1 = fmaf(x21, l[1], s1); s2 = fmaf(x22, l[2], s2); s3 = fmaf(x23, l[3], s3); } { const f32x4 l = *(const LAS f32x4*)(Lc + 1044); s0 = fmaf(x24, l[0], s0); s1 = fmaf(x25, l[1], s1); s2 = fmaf(x26, l[2], s2); s3 = fmaf(x27, l[3], s3); } { const f32x4 l = *(const LAS f32x4*)(Lc + 1048); s0 = fmaf(x28, l[0], s0); s1 = fmaf(x29, l[1], s1); s2 = fmaf(x30, l[2], s2); s3 = fmaf(x31, l[3], s3); } { const f32x4 l = *(const LAS f32x4*)(Lc + 1052); s0 = fmaf(x32, l[0], s0); s1 = fmaf(x33, l[1], s1); s2 = fmaf(x34, l[2], s2); s3 = fmaf(x35, l[3], s3); } { const f32x4 l = *(const LAS f32x4*)(Lc + 1056); s0 = fmaf(x36, l[0], s0); s1 = fmaf(x37, l[1], s1); s2 = fmaf(x38, l[2], s2); s3 = fmaf(x39, l[3], s3); } { const f32x4 l = *(const LAS f32x4*)(Lc + 1060); s0 = fmaf(x40, l[0], s0); s1 = fmaf(x41, l[1], s1); s2 = fmaf(x42, l[2], s2); s3 = fmaf(x43, l[3], s3); } { const f32x4 l = *(const LAS f32x4*)(Lc + 1064); s0 = fmaf(x44, l[0], s0); s1 = fmaf(x45, l[1], s1); s2 = fmaf(x46, l[2], s2); s3 = fmaf(x47, l[3], s3); } { const f32x4 l = *(const LAS f32x4*)(Lc + 1068); s0 = fmaf(x48, l[0], s0); s1 = fmaf(x49, l[1], s1); s2 = fmaf(x50, l[2], s2); s3 = fmaf(x51, l[3], s3); } { const f32x4 l = *(const LAS f32x4*)(Lc + 1072); s0 = fmaf(x52, l[0], s0); s1 = fmaf(x53, l[1], s1); s2 = fmaf(x54, l[2], s2); s3 = fmaf(x55, l[3], s3); } { const f32x4 l = *(const LAS f32x4*)(Lc + 1076); s0 = fmaf(x56, l[0], s0); s1 = fmaf(x57, l[1], s1); s2 = fmaf(x58, l[2], s2); s3 = fmaf(x59, l[3], s3); } { const f32x4 l = *(const LAS f32x4*)(Lc + 1080); s0 = fmaf(x60, l[0], s0); s1 = fmaf(x61, l[1], s1); s2 = fmaf(x62, l[2], s2); s3 = fmaf(x63, l[3], s3); } x15 = (lane == 15) ? 1.0f : -((s0 + s1) + (s2 + s3)); asm volatile("" : "+v"(x15) : : "memory"); }
    { float s0 = 0.f, s1 = 0.f, s2 = 0.f, s3 = 0.f; { const f32x4 l = *(const LAS f32x4*)(Lc + 964); s3 = fmaf(x15, l[3], s3); } { const f32x4 l = *(const LAS f32x4*)(Lc + 968); s0 = fmaf(x16, l[0], s0); s1 = fmaf(x17, l[1], s1); s2 = fmaf(x18, l[2], s2); s3 = fmaf(x19, l[3], s3); } { const f32x4 l = *(const LAS f32x4*)(Lc + 972); s0 = fmaf(x20, l[0], s0); s1 = fmaf(x21, l[1], s1); s2 = fmaf(x22, l[2], s2); s3 = fmaf(x23, l[3], s3); } { const f32x4 l = *(const LAS f32x4*)(Lc + 976); s0 = fmaf(x24, l[0], s0); s1 = fmaf(x25, l[1], s1); s2 = fmaf(x26, l[2], s2); s3 = fmaf(x27, l[3], s3); } { const f32x4 l = *(const LAS f32x4*)(Lc + 980); s0 = fmaf(x28, l[0], s0); s1 = fmaf(x29, l[1], s1); s2 = fmaf(x30, l[2], s2); s3 = fmaf(x31, l[3], s3); } { const f32x4 l = *(const LAS f32x4*)(Lc + 984); s0 = fmaf(x32, l[0], s0); s1 = fmaf(x33, l[1], s1); s2 = fmaf(x34, l[2], s2); s3 = fmaf(x35, l[3], s3); } { const f32x4 l = *(const LAS f32x4*)(Lc + 988); s0 = fmaf(x36, l[0], s0); s1 = fmaf(x37, l[1], s1); s2 = fmaf(x38, l[2], s2); s3 = fmaf(x39, l[3], s3); } { const f32x4 l = *(const LAS f32x4*)(Lc + 992); s0 = fmaf(x40, l[0], s0); s1 = fmaf(x41, l[1], s1); s2 = fmaf(x42, l[2], s2); s3 = fmaf(x43, l[3], s3); } { const f32x4 l = *(const LAS f32x4*)(Lc + 996); s0 = fmaf(x44, l[0], s0); s1 = fmaf(x45, l[1], s1); s2 = fmaf(x46, l[2], s2); s3 = fmaf(x47, l[3], s3); } { const f32x4 l = *(const LAS f32x4*)(Lc + 1000); s0 = fmaf(x48, l[0], s0); s1 = fmaf(x49, l[1], s1); s2 = fmaf(x50, l[2], s2); s3 = fmaf(x51, l[3], s3); } { const f32x4 l = *(const LAS f32x4*)(Lc + 1004); s0 = fmaf(x52, l[0], s0); s1 = fmaf(x53, l[1], s1); s2 = fmaf(x54, l[2], s2); s3 = fmaf(x55, l[3], s3); } { const f32x4 l = *(const LAS f32x4*)(Lc + 1008); s0 = fmaf(x56, l[0], s0); s1 = fmaf(x57, l[1], s1); s2 = fmaf(x58, l[2], s2); s3 = fmaf(x59, l[3], s3); } { const f32x4 l = *(const LAS f32x4*)(Lc + 1012); s0 = fmaf(x60, l[0], s0); s1 = fmaf(x61, l[1], s1); s2 = fmaf(x62, l[2], s2); s3 = fmaf(x63, l[3], s3); } x14 = (lane == 14) ? 1.0f : -((s0 + s1) + (s2 + s3)); asm volatile("" : "+v"(x14) : : "memory"); }
    { float s0 = 0.f, s1 = 0.f, s2 = 0.f, s3 = 0.f; { const f32x4 l = *(const LAS f32x4*)(Lc + 896); s2 = fmaf(x14, l[2], s2); s3 = fmaf(x15, l[3], s3); } { const f32x4 l = *(const LAS f32x4*)(Lc + 900); s0 = fmaf(x16, l[0], s0); s1 = fmaf(x17, l[1], s1); s2 = fmaf(x18, l[2], s2); s3 = fmaf(x19, l[3], s3); } { const f32x4 l = *(const LAS f32x4*)(Lc + 904); s0 = fmaf(x20, l[0], s0); s1 = fmaf(x21, l[1], s1); s2 = fmaf(x22, l[2], s2); s3 = fmaf(x23, l[3], s3); } { const f32x4 l = *(const LAS f32x4*)(Lc + 908); s0 = fmaf(x24, l[0], s0); s1 = fmaf(x25, l[1], s1); s2 = fmaf(x26, l[2], s2); s3 = fmaf(x27, l[3], s3); } { const f32x4 l = *(const LAS f32x4*)(Lc + 912); s0 = fmaf(x28, l[0], s0); s1 = fmaf(x29, l[1], s1); s2 = fmaf(x30, l[2], s2); s3 = fmaf(x31, l[3], s3); } { const f32x4 l = *(const LAS f32x4*)(Lc + 916); s0 = fmaf(x32, l[0], s0); s1 = fmaf(x33, l[1], s1); s2 = fmaf(x34, l[2], s2); s3 = fmaf(x35, l[3], s3); } { const f32x4 l = *(const LAS f32x4*)(Lc + 920); s0 = fmaf(x36, l[0], s0); s1 = fmaf(x37, l[1], s1); s2 = fmaf(x38, l[2], s2); s3 = fmaf(x39, l[3], s3); } { const f32x4 l = *(const LAS f32x4*)(Lc + 924); s0 = fmaf(x40, l[0], s0); s1 = fmaf(x41, l[1], s1); s2 = fmaf(x42, l[2], s2); s3 = fmaf(x43, l[3], s3); } { const f32x4 l = *(const LAS f32x4*)(Lc + 928); s0 = fmaf(x44, l[0], s0); s1 = fmaf(x45, l[1], s1); s2 = fmaf(x46, l[2], s2); s3 = fmaf(x47, l[3], s3); } { const f32x4 l = *(const LAS f32x4*)(Lc + 932); s0 = fmaf(x48, l[0], s0); s1 = fmaf(x49, l[1], s1); s2 = fmaf(x50, l[2], s2); s3 = fmaf(x51, l[3], s3); } { const f32x4 l = *(const LAS f32x4*)(Lc + 936); s0 = fmaf(x52, l[0], s0); s1 = fmaf(x53, l[1], s1); s2 = fmaf(x54, l[2], s2); s3 = fmaf(x55, l[3], s3); } { const f32x4 l = *(const LAS f32x4*)(Lc + 940); s0 = fmaf(x56, l[0], s0); s1 = fmaf(x57, l[1], s1); s2 = fmaf(x58, l[2], s2); s3 = fmaf(x59, l[3], s3); } { const f32x4 l = *(const LAS f32x4*)(Lc + 944); s0 = fmaf(x60, l[0], s0); s1 = fmaf(x61, l[1], s1); s2 = fmaf(x62, l[2], s2); s3 = fmaf(x63, l[3], s3); } x13 = (lane == 13) ? 1.0f : -((s0 + s1) + (s2 + s3)); asm volatile("" : "+v"(x13) : : "memory"); }
    { float s0 = 0.f, s1 = 0.f, s2 = 0.f, s3 = 0.f; { const f32x4 l = *(const LAS f32x4*)(Lc + 828); s1 = fmaf(x13, l[1], s1); s2 = fmaf(x14, l[2], s2); s3 = fmaf(x15, l[3], s3); } { const f32x4 l = *(const LAS f32x4*)(Lc + 832); s0 = fmaf(x16, l[0], s0); s1 = fmaf(x17, l[1], s1); s2 = fmaf(x18, l[2], s2); s3 = fmaf(x19, l[3], s3); } { const f32x4 l = *(const LAS f32x4*)(Lc + 836); s0 = fmaf(x20, l[0], s0); s1 = fmaf(x21, l[1], s1); s2 = fmaf(x22, l[2], s2); s3 = fmaf(x23, l[3], s3); } { const f32x4 l = *(const LAS f32x4*)(Lc + 840); s0 = fmaf(x24, l[0], s0); s1 = fmaf(x25, l[1], s1); s2 = fmaf(x26, l[2], s2); s3 = fmaf(x27, l[3], s3); } { const f32x4 l = *(const LAS f32x4*)(Lc + 844); s0 = fmaf(x28, l[0], s0); s1 = fmaf(x29, l[1], s1); s2 = fmaf(x30, l[2], s2); s3 = fmaf(x31, l[3], s3); } { const f32x4 l = *(const LAS f32x4*)(Lc + 848); s0 = fmaf(x32, l[0], s0); s1 = fmaf(x33, l[1], s1); s2 = fmaf(x34, l[2], s2); s3 = fmaf(x35, l[3], s3); } { const f32x4 l = *(const LAS f32x4*)(Lc + 852); s0 = fmaf(x36, l[0], s0); s1 = fmaf(x37, l[1], s1); s2 = fmaf(x38, l[2], s2); s3 = fmaf(x39, l[3], s3); } { const f32x4 l = *(const LAS f32x4*)(Lc + 856); s0 = fmaf(x40, l[0], s0); s1 = fmaf(x41, l[1], s1); s2 = fmaf(x42, l[2], s2); s3 = fmaf(x43, l[3], s3); } { const f32x4 l = *(const LAS f32x4*)(Lc + 860); s0 = fmaf(x44, l[0], s0); s1 = fmaf(x45, l[1], s1); s2 = fmaf(x46, l[2], s2); s3 = fmaf(x47, l[3], s3); } { const f32x4 l = *(const LAS f32x4*)(Lc + 864); s0 = fmaf(x48, l[0], s0); s1 = fmaf(x49, l[1], s1); s2 = fmaf(x50, l[2], s2); s3 = fmaf(x51, l[3], s3); } { const f32x4 l = *(const LAS f32x4*)(Lc + 868); s0 = fmaf(x52, l[0], s0); s1 = fmaf(x53, l[1], s1); s2 = fmaf(x54, l[2], s2); s3 = fmaf(x55, l[3], s3); } { const f32x4 l = *(const LAS f32x4*)(Lc + 872); s0 = fmaf(x56, l[0], s0); s1 = fmaf(x57, l[1], s1); s2 = fmaf(x58, l[2], s2); s3 = fmaf(x59, l[3], s3); } { const f32x4 l = *(const LAS f32x4*)(Lc + 876); s0 = fmaf(x60, l[0], s0); s1 = fmaf(x61, l[1], s1); s2 = fmaf(x62, l[2], s2); s3 = fmaf(x63, l[3], s3); } x12 = (lane == 12) ? 1.0f : -((s0 + s1) + (s2 + s3)); asm volatile("" : "+v"(x12) : : "memory"); }
    { float s0 = 0.f, s1 = 0.f, s2 = 0.f, s3 = 0.f; { const f32x4 l = *(const LAS f32x4*)(Lc + 760); s0 = fmaf(x12, l[0], s0); s1 = fmaf(x13, l[1], s1); s2 = fmaf(x14, l[2], s2); s3 = fmaf(x15, l[3], s3); } { const f32x4 l = *(const LAS f32x4*)(Lc + 764); s0 = fmaf(x16, l[0], s0); s1 = fmaf(x17, l[1], s1); s2 = fmaf(x18, l[2], s2); s3 = fmaf(x19, l[3], s3); } { const f32x4 l = *(const LAS f32x4*)(Lc + 768); s0 = fmaf(x20, l[0], s0); s1 = fmaf(x21, l[1], s1); s2 = fmaf(x22, l[2], s2); s3 = fmaf(x23, l[3], s3); } { const f32x4 l = *(const LAS f32x4*)(Lc + 772); s0 = fmaf(x24, l[0], s0); s1 = fmaf(x25, l[1], s1); s2 = fmaf(x26, l[2], s2); s3 = fmaf(x27, l[3], s3); } { const f32x4 l = *(const LAS f32x4*)(Lc + 776); s0 = fmaf(x28, l[0], s0); s1 = fmaf(x29, l[1], s1); s2 = fmaf(x30, l[2], s2); s3 = fmaf(x31, l[3], s3); } { const f32x4 l = *(const LAS f32x4*)(Lc + 780); s0 = fmaf(x32, l[0], s0); s1 = fmaf(x33, l[1], s1); s2 = fmaf(x34, l[2], s2); s3 = fmaf(x35, l[3], s3); } { const f32x4 l = *(const LAS f32x4*)(Lc + 784); s0 = fmaf(x36, l[0], s0); s1 = fmaf(x37, l[1], s1); s2 = fmaf(x38, l[2], s2); s3 = fmaf(x39, l[3], s3); } { const f32x4 l = *(const LAS f32x4*)(Lc + 788); s0 = fmaf(x40, l[0], s0); s1 = fmaf(x41, l[1], s1); s2 = fmaf(x42, l[2], s2); s3 = fmaf(x43, l[3], s3); } { const f32x4 l = *(const LAS f32x4*)(Lc + 792); s0 = fmaf(x44, l[0], s0); s1 = fmaf(x45, l[1], s1); s2 = fmaf(x46, l[2], s2); s3 = fmaf(x47, l[3], s3); } { const f32x4 l = *(const LAS f32x4*)(Lc + 796); s0 = fmaf(x48, l[0], s0); s1 = fmaf(x49, l[1], s1); s2 = fmaf(x50, l[2], s2); s3 = fmaf(x51, l[3], s3); } { const f32x4 l = *(const LAS f32x4*)(Lc + 800); s0 = fmaf(x52, l[0], s0); s1 = fmaf(x53, l[1], s1); s2 = fmaf(x54, l[2], s2); s3 = fmaf(x55, l[3], s3); } { const f32x4 l = *(const LAS f32x4*)(Lc + 804); s0 = fmaf(x56, l[0], s0); s1 = fmaf(x57, l[1], s1); s2 = fmaf(x58, l[2], s2); s3 = fmaf(x59, l[3], s3); } { const f32x4 l = *(const LAS f32x4*)(Lc + 808); s0 = fmaf(x60, l[0], s0); s1 = fmaf(x61, l[1], s1); s2 = fmaf(x62, l[2], s2); s3 = fmaf(x63, l[3], s3); } x11 = (lane == 11) ? 1.0f : -((s0 + s1) + (s2 + s3)); asm volatile("" : "+v"(x11) : : "memory"); }
    { float s0 = 0.f, s1 = 0.f, s2 = 0.f, s3 = 0.f; { const f32x4 l = *(const LAS f32x4*)(Lc + 688); s3 = fmaf(x11, l[3], s3); } { const f32x4 l = *(const LAS f32x4*)(Lc + 692); s0 = fmaf(x12, l[0], s0); s1 = fmaf(x13, l[1], s1); s2 = fmaf(x14, l[2], s2); s3 = fmaf(x15, l[3], s3); } { const f32x4 l = *(const LAS f32x4*)(Lc + 696); s0 = fmaf(x16, l[0], s0); s1 = fmaf(x17, l[1], s1); s2 = fmaf(x18, l[2], s2); s3 = fmaf(x19, l[3], s3); } { const f32x4 l = *(const LAS f32x4*)(Lc + 700); s0 = fmaf(x20, l[0], s0); s1 = fmaf(x21, l[1], s1); s2 = fmaf(x22, l[2], s2); s3 = fmaf(x23, l[3], s3); } { const f32x4 l = *(const LAS f32x4*)(Lc + 704); s0 = fmaf(x24, l[0], s0); s1 = fmaf(x25, l[1], s1); s2 = fmaf(x26, l[2], s2); s3 = fmaf(x27, l[3], s3); } { const f32x4 l = *(const LAS f32x4*)(Lc + 708); s0 = fmaf(x28, l[0], s0); s1 = fmaf(x29, l[1], s1); s2 = fmaf(x30, l[2], s2); s3 = fmaf(x31, l[3], s3); } { const f32x4 l = *(const LAS f32x4*)(Lc + 712); s0 = fmaf(x32, l[0], s0); s1 = fmaf(x33, l[1], s1); s2 = fmaf(x34, l[2], s2); s3 = fmaf(x35, l[3], s3); } { const f32x4 l = *(const LAS f32x4*)(Lc + 716); s0 = fmaf(x36, l[0], s0); s1 = fmaf(x37, l[1], s1); s2 = fmaf(x38, l[2], s2); s3 = fmaf(x39, l[3], s3); } { const f32x4 l = *(const LAS f32x4*)(Lc + 720); s0 = fmaf(x40, l[0], s0); s1 = fmaf(x41, l[1], s1); s2 = fmaf(x42, l[2], s2); s3 = fmaf(x43, l[3], s3); } { const f32x4 l = *(const LAS f32x4*)(Lc + 724); s0 = fmaf(x44, l[0], s0); s1 = fmaf(x45, l[1], s1); s2 = fmaf(x46, l[2], s2); s3 = fmaf(x47, l[3], s3); } { const f32x4 l = *(const LAS f32x4*)(Lc + 728); s0 = fmaf(x48, l[0], s0); s1 = fmaf(x49, l[1], s1); s2 = fmaf(x50, l[2], s2); s3 = fmaf(x51, l[3], s3); } { const f32x4 l = *(const LAS f32x4*)(Lc + 732); s0 = fmaf(x52, l[0], s0); s1 = fmaf(x53, l[1], s1); s2 = fmaf(x54, l[2], s2); s3 = fmaf(x55, l[3], s3); } { const f32x4 l = *(const LAS f32x4*)(Lc + 736); s0 = fmaf(x56, l[0], s0); s1 = fmaf(x57, l[1], s1); s2 = fmaf(x58, l[2], s2); s3 = fmaf(x59, l[3], s3); } { const f32x4 l = *(const LAS f32x4*)(Lc + 740); s0 = fmaf(x60, l[0], s0); s1 = fmaf(x61, l[1], s1); s2 = fmaf(x62, l[2], s2); s3 = fmaf(x63, l[3], s3); } x10 = (lane == 10) ? 1.0f : -((s0 + s1) + (s2 + s3)); asm volatile("" : "+v"(x10) : : "memory"); }
    { float s0 = 0.f, s1 = 0.f, s2 = 0.f, s3 = 0.f; { const f32x4 l = *(const LAS f32x4*)(Lc + 620); s2 = fmaf(x10, l[2], s2); s3 = fmaf(x11, l[3], s3); } { const f32x4 l = *(const LAS f32x4*)(Lc + 624); s0 = fmaf(x12, l[0], s0); s1 = fmaf(x13, l[1], s1); s2 = fmaf(x14, l[2], s2); s3 = fmaf(x15, l[3], s3); } { const f32x4 l = *(const LAS f32x4*)(Lc + 628); s0 = fmaf(x16, l[0], s0); s1 = fmaf(x17, l[1], s1); s2 = fmaf(x18, l[2], s2); s3 = fmaf(x19, l[3], s3); } { const f32x4 l = *(const LAS f32x4*)(Lc + 632); s0 = fmaf(x20, l[0], s0); s1 = fmaf(x21, l[1], s1); s2 = fmaf(x22, l[2], s2); s3 = fmaf(x23, l[3], s3); } { const f32x4 l = *(const LAS f32x4*)(Lc + 636); s0 = fmaf(x24, l[0], s0); s1 = fmaf(x25, l[1], s1); s2 = fmaf(x26, l[2], s2); s3 = fmaf(x27, l[3], s3); } { const f32x4 l = *(const LAS f32x4*)(Lc + 640); s0 = fmaf(x28, l[0], s0); s1 = fmaf(x29, l[1], s1); s2 = fmaf(x30, l[2], s2); s3 = fmaf(x31, l[3], s3); } { const f32x4 l = *(const LAS f32x4*)(Lc + 644); s0 = fmaf(x32, l[0], s0); s1 = fmaf(x33, l[1], s1); s2 = fmaf(x34, l[2], s2); s3 = fmaf(x35, l[3], s3); } { const f32x4 l = *(const LAS f32x4*)(Lc + 648); s0 = fmaf(x36, l[0], s0); s1 = fmaf(x37, l[1], s1); s2 = fmaf(x38, l[2], s2); s3 = fmaf(x39, l[3], s3); } { const f32x4 l = *(const LAS f32x4*)(Lc + 652); s0 = fmaf(x40, l[0], s0); s1 = fmaf(x41, l[1], s1); s2 = fmaf(x42, l[2], s2); s3 = fmaf(x43, l[3], s3); } { const f32x4 l = *(const LAS f32x4*)(Lc + 656); s0 = fmaf(x44, l[0], s0); s1 = fmaf(x45, l[1], s1); s2 = fmaf(x46, l[2], s2); s3 = fmaf(x47, l[3], s3); } { const f32x4 l = *(const LAS f32x4*)(Lc + 660); s0 = fmaf(x48, l[0], s0); s1 = fmaf(x49, l[1], s1); s2 = fmaf(x50, l[2], s2); s3 = fmaf(x51, l[3], s3); } { const f32x4 l = *(const LAS f32x4*)(Lc + 664); s0 = fmaf(x52, l[0], s0); s1 = fmaf(x53, l[1], s1); s2 = fmaf(x54, l[2], s2); s3 = fmaf(x55, l[3], s3); } { const f32x4 l = *(const LAS f32x4*)(Lc + 668); s0 = fmaf(x56, l[0], s0); s1 = fmaf(x57, l[1], s1); s2 = fmaf(x58, l[2], s2); s3 = fmaf(x59, l[3], s3); } { const f32x4 l = *(const LAS f32x4*)(Lc + 672); s0 = fmaf(x60, l[0], s0); s1 = fmaf(x61, l[1], s1); s2 = fmaf(x62, l[2], s2); s3 = fmaf(x63, l[3], s3); } x9 = (lane == 9) ? 1.0f : -((s0 + s1) + (s2 + s3)); asm volatile("" : "+v"(x9) : : "memory"); }
    { float s0 = 0.f, s1 = 0.f, s2 = 0.f, s3 = 0.f; { const f32x4 l = *(const LAS f32x4*)(Lc + 552); s1 = fmaf(x9, l[1], s1); s2 = fmaf(x10, l[2], s2); s3 = fmaf(x11, l[3], s3); } { const f32x4 l = *(const LAS f32x4*)(Lc + 556); s0 = fmaf(x12, l[0], s0); s1 = fmaf(x13, l[1], s1); s2 = fmaf(x14, l[2], s2); s3 = fmaf(x15, l[3], s3); } { const f32x4 l = *(const LAS f32x4*)(Lc + 560); s0 = fmaf(x16, l[0], s0); s1 = fmaf(x17, l[1], s1); s2 = fmaf(x18, l[2], s2); s3 = fmaf(x19, l[3], s3); } { const f32x4 l = *(const LAS f32x4*)(Lc + 564); s0 = fmaf(x20, l[0], s0); s1 = fmaf(x21, l[1], s1); s2 = fmaf(x22, l[2], s2); s3 = fmaf(x23, l[3], s3); } { const f32x4 l = *(const LAS f32x4*)(Lc + 568); s0 = fmaf(x24, l[0], s0); s1 = fmaf(x25, l[1], s1); s2 = fmaf(x26, l[2], s2); s3 = fmaf(x27, l[3], s3); } { const f32x4 l = *(const LAS f32x4*)(Lc + 572); s0 = fmaf(x28, l[0], s0); s1 = fmaf(x29, l[1], s1); s2 = fmaf(x30, l[2], s2); s3 = fmaf(x31, l[3], s3); } { const f32x4 l = *(const LAS f32x4*)(Lc + 576); s0 = fmaf(x32, l[0], s0); s1 = fmaf(x33, l[1], s1); s2 = fmaf(x34, l[2], s2); s3 = fmaf(x35, l[3], s3); } { const f32x4 l = *(const LAS f32x4*)(Lc + 580); s0 = fmaf(x36, l[0], s0); s1 = fmaf(x37, l[1], s1); s2 = fmaf(x38, l[2], s2); s3 = fmaf(x39, l[3], s3); } { const f32x4 l = *(const LAS f32x4*)(Lc + 584); s0 = fmaf(x40, l[0], s0); s1 = fmaf(x41, l[1], s1); s2 = fmaf(x42, l[2], s2); s3 = fmaf(x43, l[3], s3); } { const f32x4 l = *(const LAS f32x4*)(Lc + 588); s0 = fmaf(x44, l[0], s0); s1 = fmaf(x45, l[1], s1); s2 = fmaf(x46, l[2], s2); s3 = fmaf(x47, l[3], s3); } { const f32x4 l = *(const LAS f32x4*)(Lc + 592); s0 = fmaf(x48, l[0], s0); s1 = fmaf(x49, l[1], s1); s2 = fmaf(x50, l[2], s2); s3 = fmaf(x51, l[3], s3); } { const f32x4 l = *(const LAS f32x4*)(Lc + 596); s0 = fmaf(x52, l[0], s0); s1 = fmaf(x53, l[1], s1); s2 = fmaf(x54, l[2], s2); s3 = fmaf(x55, l[3], s3); } { const f32x4 l = *(const LAS f32x4*)(Lc + 600); s0 = fmaf(x56, l[0], s0); s1 = fmaf(x57, l[1], s1); s2 = fmaf(x58, l[2], s2); s3 = fmaf(x59, l[3], s3); } { const f32x4 l = *(const LAS f32x4*)(Lc + 604); s0 = fmaf(x60, l[0], s0); s1 = fmaf(x61, l[1], s1); s2 = fmaf(x62, l[2], s2); s3 = fmaf(x63, l[3], s3); } x8 = (lane == 8) ? 1.0f : -((s0 + s1) + (s2 + s3)); asm volatile("" : "+v"(x8) : : "memory"); }
    { float s0 = 0.f, s1 = 0.f, s2 = 0.f, s3 = 0.f; { const f32x4 l = *(const LAS f32x4*)(Lc + 484); s0 = fmaf(x8, l[0], s0); s1 = fmaf(x9, l[1], s1); s2 = fmaf(x10, l[2], s2); s3 = fmaf(x11, l[3], s3); } { const f32x4 l = *(const LAS f32x4*)(Lc + 488); s0 = fmaf(x12, l[0], s0); s1 = fmaf(x13, l[1], s1); s2 = fmaf(x14, l[2], s2); s3 = fmaf(x15, l[3], s3); } { const f32x4 l = *(const LAS f32x4*)(Lc + 492); s0 = fmaf(x16, l[0], s0); s1 = fmaf(x17, l[1], s1); s2 = fmaf(x18, l[2], s2); s3 = fmaf(x19, l[3], s3); } { const f32x4 l = *(const LAS f32x4*)(Lc + 496); s0 = fmaf(x20, l[0], s0); s1 = fmaf(x21, l[1], s1); s2 = fmaf(x22, l[2], s2); s3 = fmaf(x23, l[3], s3); } { const f32x4 l = *(const LAS f32x4*)(Lc + 500); s0 = fmaf(x24, l[0], s0); s1 = fmaf(x25, l[1], s1); s2 = fmaf(x26, l[2], s2); s3 = fmaf(x27, l[3], s3); } { const f32x4 l = *(const LAS f32x4*)(Lc + 504); s0 = fmaf(x28, l[0], s0); s1 = fmaf(x29, l[1], s1); s2 = fmaf(x30, l[2], s2); s3 = fmaf(x31, l[3], s3); } { const f32x4 l = *(const LAS f32x4*)(Lc + 508); s0 = fmaf(x32, l[0], s0); s1 = fmaf(x33, l[1], s1); s2 = fmaf(x34, l[2], s2); s3 = fmaf(x35, l[3], s3); } { const f32x4 l = *(const LAS f32x4*)(Lc + 512); s0 = fmaf(x36, l[0], s0); s1 = fmaf(x37, l[1], s1); s2 = fmaf(x38, l[2], s2); s3 = fmaf(x39, l[3], s3); } { const f32x4 l = *(const LAS f32x4*)(Lc + 516); s0 = fmaf(x40, l[0], s0); s1 = fmaf(x41, l[1], s1); s2 = fmaf(x42, l[2], s2); s3 = fmaf(x43, l[3], s3); } { const f32x4 l = *(const LAS f32x4*)(Lc + 520); s0 = fmaf(x44, l[0], s0); s1 = fmaf(x45, l[1], s1); s2 = fmaf(x46, l[2], s2); s3 = fmaf(x47, l[3], s3); } { const f32x4 l = *(const LAS f32x4*)(Lc + 524); s0 = fmaf(x48, l[0], s0); s1 = fmaf(x49, l[1], s1); s2 = fmaf(x50, l[2], s2); s3 = fmaf(x51, l[3], s3); } { const f32x4 l = *(const LAS f32x4*)(Lc + 528); s0 = fmaf(x52, l[0], s0); s1 = fmaf(x53, l[1], s1); s2 = fmaf(x54, l[2], s2); s3 = fmaf(x55, l[3], s3); } { const f32x4 l = *(const LAS f32x4*)(Lc + 532); s0 = fmaf(x56, l[0], s0); s1 = fmaf(x57, l[1], s1); s2 = fmaf(x58, l[2], s2); s3 = fmaf(x59, l[3], s3); } { const f32x4 l = *(const LAS f32x4*)(Lc + 536); s0 = fmaf(x60, l[0], s0); s1 = fmaf(x61, l[1], s1); s2 = fmaf(x62, l[2], s2); s3 = fmaf(x63, l[3], s3); } x7 = (lane == 7) ? 1.0f : -((s0 + s1) + (s2 + s3)); asm volatile("" : "+v"(x7) : : "memory"); }
    { float s0 = 0.f, s1 = 0.f, s2 = 0.f, s3 = 0.f; { const f32x4 l = *(const LAS f32x4*)(Lc + 412); s3 = fmaf(x7, l[3], s3); } { const f32x4 l = *(const LAS f32x4*)(Lc + 416); s0 = fmaf(x8, l[0], s0); s1 = fmaf(x9, l[1], s1); s2 = fmaf(x10, l[2], s2); s3 = fmaf(x11, l[3], s3); } { const f32x4 l = *(const LAS f32x4*)(Lc + 420); s0 = fmaf(x12, l[0], s0); s1 = fmaf(x13, l[1], s1); s2 = fmaf(x14, l[2], s2); s3 = fmaf(x15, l[3], s3); } { const f32x4 l = *(const LAS f32x4*)(Lc + 424); s0 = fmaf(x16, l[0], s0); s1 = fmaf(x17, l[1], s1); s2 = fmaf(x18, l[2], s2); s3 = fmaf(x19, l[3], s3); } { const f32x4 l = *(const LAS f32x4*)(Lc + 428); s0 = fmaf(x20, l[0], s0); s1 = fmaf(x21, l[1], s1); s2 = fmaf(x22, l[2], s2); s3 = fmaf(x23, l[3], s3); } { const f32x4 l = *(const LAS f32x4*)(Lc + 432); s0 = fmaf(x24, l[0], s0); s1 = fmaf(x25, l[1], s1); s2 = fmaf(x26, l[2], s2); s3 = fmaf(x27, l[3], s3); } { const f32x4 l = *(const LAS f32x4*)(Lc + 436); s0 = fmaf(x28, l[0], s0); s1 = fmaf(x29, l[1], s1); s2 = fmaf(x30, l[2], s2); s3 = fmaf(x31, l[3], s3); } { const f32x4 l = *(const LAS f32x4*)(Lc + 440); s0 = fmaf(x32, l[0], s0); s1 = fmaf(x33, l[1], s1); s2 = fmaf(x34, l[2], s2); s3 = fmaf(x35, l[3], s3); } { const f32x4 l = *(const LAS f32x4*)(Lc + 444); s0 = fmaf(x36, l[0], s0); s1 = fmaf(x37, l[1], s1); s2 = fmaf(x38, l[2], s2); s3 = fmaf(x39, l[3], s3); } { const f32x4 l = *(const LAS f32x4*)(Lc + 448); s0 = fmaf(x40, l[0], s0); s1 = fmaf(x41, l[1], s1); s2 = fmaf(x42, l[2], s2); s3 = fmaf(x43, l[3], s3); } { const f32x4 l = *(const LAS f32x4*)(Lc + 452); s0 = fmaf(x44, l[0], s0); s1 = fmaf(x45, l[1], s1); s2 = fmaf(x46, l[2], s2); s3 = fmaf(x47, l[3], s3); } { const f32x4 l = *(const LAS f32x4*)(Lc + 456); s0 = fmaf(x48, l[0], s0); s1 = fmaf(x49, l[1], s1); s2 = fmaf(x50, l[2], s2); s3 = fmaf(x51, l[3], s3); } { const f32x4 l = *(const LAS f32x4*)(Lc + 460); s0 = fmaf(x52, l[0], s0); s1 = fmaf(x53, l[1], s1); s2 = fmaf(x54, l[2], s2); s3 = fmaf(x55, l[3], s3); } { const f32x4 l = *(const LAS f32x4*)(Lc + 464); s0 = fmaf(x56, l[0], s0); s1 = fmaf(x57, l[1], s1); s2 = fmaf(x58, l[2], s2); s3 = fmaf(x59, l[3], s3); } { const f32x4 l = *(const LAS f32x4*)(Lc + 468); s0 = fmaf(x60, l[0], s0); s1 = fmaf(x61, l[1], s1); s2 = fmaf(x62, l[2], s2); s3 = fmaf(x63, l[3], s3); } x6 = (lane == 6) ? 1.0f : -((s0 + s1) + (s2 + s3)); asm volatile("" : "+v"(x6) : : "memory"); }
    { float s0 = 0.f, s1 = 0.f, s2 = 0.f, s3 = 0.f; { const f32x4 l = *(const LAS f32x4*)(Lc + 344); s2 = fmaf(x6, l[2], s2); s3 = fmaf(x7, l[3], s3); } { const f32x4 l = *(const LAS f32x4*)(Lc + 348); s0 = fmaf(x8, l[0], s0); s1 = fmaf(x9, l[1], s1); s2 = fmaf(x10, l[2], s2); s3 = fmaf(x11, l[3], s3); } { const f32x4 l = *(const LAS f32x4*)(Lc + 352); s0 = fmaf(x12, l[0], s0); s1 = fmaf(x13, l[1], s1); s2 = fmaf(x14, l[2], s2); s3 = fmaf(x15, l[3], s3); } { const f32x4 l = *(const LAS f32x4*)(Lc + 356); s0 = fmaf(x16, l[0], s0); s1 = fmaf(x17, l[1], s1); s2 = fmaf(x18, l[2], s2); s3 = fmaf(x19, l[3], s3); } { const f32x4 l = *(const LAS f32x4*)(Lc + 360); s0 = fmaf(x20, l[0], s0); s1 = fmaf(x21, l[1], s1); s2 = fmaf(x22, l[2], s2); s3 = fmaf(x23, l[3], s3); } { const f32x4 l = *(const LAS f32x4*)(Lc + 364); s0 = fmaf(x24, l[0], s0); s1 = fmaf(x25, l[1], s1); s2 = fmaf(x26, l[2], s2); s3 = fmaf(x27, l[3], s3); } { const f32x4 l = *(const LAS f32x4*)(Lc + 368); s0 = fmaf(x28, l[0], s0); s1 = fmaf(x29, l[1], s1); s2 = fmaf(x30, l[2], s2); s3 = fmaf(x31, l[3], s3); } { const f32x4 l = *(const LAS f32x4*)(Lc + 372); s0 = fmaf(x32, l[0], s0); s1 = fmaf(x33, l[1], s1); s2 = fmaf(x34, l[2], s2); s3 = fmaf(x35, l[3], s3); } { const f32x4 l = *(const LAS f32x4*)(Lc + 376); s0 = fmaf(x36, l[0], s0); s1 = fmaf(x37, l[1], s1); s2 = fmaf(x38, l[2], s2); s3 = fmaf(x39, l[3], s3); } { const f32x4 l = *(const LAS f32x4*)(Lc + 380); s0 = fmaf(x40, l[0], s0); s1 = fmaf(x41, l[1], s1); s2 = fmaf(x42, l[2], s2); s3 = fmaf(x43, l[3], s3); } { const f32x4 l = *(const LAS f32x4*)(Lc + 384); s0 = fmaf(x44, l[0], s0); s1 = fmaf(x45, l[1], s1); s2 = fmaf(x46, l[2], s2); s3 = fmaf(x47, l[3], s3); } { const f32x4 l = *(const LAS f32x4*)(Lc + 388); s0 = fmaf(x48, l[0], s0); s1 = fmaf(x49, l[1], s1); s2 = fmaf(x50, l[2], s2); s3 = fmaf(x51, l[3], s3); } { const f32x4 l = *(const LAS f32x4*)(Lc + 392); s0 = fmaf(x52, l[0], s0); s1 = fmaf(x53, l[1], s1); s2 = fmaf(x54, l[2], s2); s3 = fmaf(x55, l[3], s3); } { const f32x4 l = *(const LAS f32x4*)(Lc + 396); s0 = fmaf(x56, l[0], s0); s1 = fmaf(x57, l[1], s1); s2 = fmaf(x58, l[2], s2); s3 = fmaf(x59, l[3], s3); } { const f32x4 l = *(const LAS f32x4*)(Lc + 400); s0 = fmaf(x60, l[0], s0); s1 = fmaf(x61, l[1], s1); s2 = fmaf(x62, l[2], s2); s3 = fmaf(x63, l[3], s3); } x5 = (lane == 5) ? 1.0f : -((s0 + s1) + (s2 + s3)); asm volatile("" : "+v"(x5) : : "memory"); }
    { float s0 = 0.f, s1 = 0.f, s2 = 0.f, s3 = 0.f; { const f32x4 l = *(const LAS f32x4*)(Lc + 276); s1 = fmaf(x5, l[1], s1); s2 = fmaf(x6, l[2], s2); s3 = fmaf(x7, l[3], s3); } { const f32x4 l = *(const LAS f32x4*)(Lc + 280); s0 = fmaf(x8, l[0], s0); s1 = fmaf(x9, l[1], s1); s2 = fmaf(x10, l[2], s2); s3 = fmaf(x11, l[3], s3); } { const f32x4 l = *(const LAS f32x4*)(Lc + 284); s0 = fmaf(x12, l[0], s0); s1 = fmaf(x13, l[1], s1); s2 = fmaf(x14, l[2], s2); s3 = fmaf(x15, l[3], s3); } { const f32x4 l = *(const LAS f32x4*)(Lc + 288); s0 = fmaf(x16, l[0], s0); s1 = fmaf(x17, l[1], s1); s2 = fmaf(x18, l[2], s2); s3 = fmaf(x19, l[3], s3); } { const f32x4 l = *(const LAS f32x4*)(Lc + 292); s0 = fmaf(x20, l[0], s0); s1 = fmaf(x21, l[1], s1); s2 = fmaf(x22, l[2], s2); s3 = fmaf(x23, l[3], s3); } { const f32x4 l = *(const LAS f32x4*)(Lc + 296); s0 = fmaf(x24, l[0], s0); s1 = fmaf(x25, l[1], s1); s2 = fmaf(x26, l[2], s2); s3 = fmaf(x27, l[3], s3); } { const f32x4 l = *(const LAS f32x4*)(Lc + 300); s0 = fmaf(x28, l[0], s0); s1 = fmaf(x29, l[1], s1); s2 = fmaf(x30, l[2], s2); s3 = fmaf(x31, l[3], s3); } { const f32x4 l = *(const LAS f32x4*)(Lc + 304); s0 = fmaf(x32, l[0], s0); s1 = fmaf(x33, l[1], s1); s2 = fmaf(x34, l[2], s2); s3 = fmaf(x35, l[3], s3); } { const f32x4 l = *(const LAS f32x4*)(Lc + 308); s0 = fmaf(x36, l[0], s0); s1 = fmaf(x37, l[1], s1); s2 = fmaf(x38, l[2], s2); s3 = fmaf(x39, l[3], s3); } { const f32x4 l = *(const LAS f32x4*)(Lc + 312); s0 = fmaf(x40, l[0], s0); s1 = fmaf(x41, l[1], s1); s2 = fmaf(x42, l[2], s2); s3 = fmaf(x43, l[3], s3); } { const f32x4 l = *(const LAS f32x4*)(Lc + 316); s0 = fmaf(x44, l[0], s0); s1 = fmaf(x45, l[1], s1); s2 = fmaf(x46, l[2], s2); s3 = fmaf(x47, l[3], s3); } { const f32x4 l = *(const LAS f32x4*)(Lc + 320); s0 = fmaf(x48, l[0], s0); s1 = fmaf(x49, l[1], s1); s2 = fmaf(x50, l[2], s2); s3 = fmaf(x51, l[3], s3); } { const f32x4 l = *(const LAS f32x4*)(Lc + 324); s0 = fmaf(x52, l[0], s0); s1 = fmaf(x53, l[1], s1); s2 = fmaf(x54, l[2], s2); s3 = fmaf(x55, l[3], s3); } { const f32x4 l = *(const LAS f32x4*)(Lc + 328); s0 = fmaf(x56, l[0], s0); s1 = fmaf(x57, l[1], s1); s2 = fmaf(x58, l[2], s2); s3 = fmaf(x59, l[3], s3); } { const f32x4 l = *(const LAS f32x4*)(Lc + 332); s0 = fmaf(x60, l[0], s0); s1 = fmaf(x61, l[1], s1); s2 = fmaf(x62, l[2], s2); s3 = fmaf(x63, l[3], s3); } x4 = (lane == 4) ? 1.0f : -((s0 + s1) + (s2 + s3)); asm volatile("" : "+v"(x4) : : "memory"); }
    { float s0 = 0.f, s1 = 0.f, s2 = 0.f, s3 = 0.f; { const f32x4 l = *(const LAS f32x4*)(Lc + 208); s0 = fmaf(x4, l[0], s0); s1 = fmaf(x5, l[1], s1); s2 = fmaf(x6, l[2], s2); s3 = fmaf(x7, l[3], s3); } { const f32x4 l = *(const LAS f32x4*)(Lc + 212); s0 = fmaf(x8, l[0], s0); s1 = fmaf(x9, l[1], s1); s2 = fmaf(x10, l[2], s2); s3 = fmaf(x11, l[3], s3); } { const f32x4 l = *(const LAS f32x4*)(Lc + 216); s0 = fmaf(x12, l[0], s0); s1 = fmaf(x13, l[1], s1); s2 = fmaf(x14, l[2], s2); s3 = fmaf(x15, l[3], s3); } { const f32x4 l = *(const LAS f32x4*)(Lc + 220); s0 = fmaf(x16, l[0], s0); s1 = fmaf(x17, l[1], s1); s2 = fmaf(x18, l[2], s2); s3 = fmaf(x19, l[3], s3); } { const f32x4 l = *(const LAS f32x4*)(Lc + 224); s0 = fmaf(x20, l[0], s0); s1 = fmaf(x21, l[1], s1); s2 = fmaf(x22, l[2], s2); s3 = fmaf(x23, l[3], s3); } { const f32x4 l = *(const LAS f32x4*)(Lc + 228); s0 = fmaf(x24, l[0], s0); s1 = fmaf(x25, l[1], s1); s2 = fmaf(x26, l[2], s2); s3 = fmaf(x27, l[3], s3); } { const f32x4 l = *(const LAS f32x4*)(Lc + 232); s0 = fmaf(x28, l[0], s0); s1 = fmaf(x29, l[1], s1); s2 = fmaf(x30, l[2], s2); s3 = fmaf(x31, l[3], s3); } { const f32x4 l = *(const LAS f32x4*)(Lc + 236); s0 = fmaf(x32, l[0], s0); s1 = fmaf(x33, l[1], s1); s2 = fmaf(x34, l[2], s2); s3 = fmaf(x35, l[3], s3); } { const f32x4 l = *(const LAS f32x4*)(Lc + 240); s0 = fmaf(x36, l[0], s0); s1 = fmaf(x37, l[1], s1); s2 = fmaf(x38, l[2], s2); s3 = fmaf(x39, l[3], s3); } { const f32x4 l = *(const LAS f32x4*)(Lc + 244); s0 = fmaf(x40, l[0], s0); s1 = fmaf(x41, l[1], s1); s2 = fmaf(x42, l[2], s2); s3 = fmaf(x43, l[3], s3); } { const f32x4 l = *(const LAS f32x4*)(Lc + 248); s0 = fmaf(x44, l[0], s0); s1 = fmaf(x45, l[1], s1); s2 = fmaf(x46, l[2], s2); s3 = fmaf(x47, l[3], s3); } { const f32x4 l = *(const LAS f32x4*)(Lc + 252); s0 = fmaf(x48, l[0], s0); s1 = fmaf(x49, l[1], s1); s2 = fmaf(x50, l[2], s2); s3 = fmaf(x51, l[3], s3); } { const f32x4 l = *(const LAS f32x4*)(Lc + 256); s0 = fmaf(x52, l[0], s0); s1 = fmaf(x53, l[1], s1); s2 = fmaf(x54, l[2], s2); s3 = fmaf(x55, l[3], s3); } { const f32x4 l = *(const LAS f32x4*)(Lc + 260); s0 = fmaf(x56, l[0], s0); s1 = fmaf(x57, l[1], s1); s2 = fmaf(x58, l[2], s2); s3 = fmaf(x59, l[3], s3); } { const f32x4 l = *(const LAS f32x4*)(Lc + 264); s0 = fmaf(x60, l[0], s0); s1 = fmaf(x61, l[1], s1); s2 = fmaf(x62, l[2], s2); s3 = fmaf(x63, l[3], s3); } x3 = (lane == 3) ? 1.0f : -((s0 + s1) + (s2 + s3)); asm volatile("" : "+v"(x3) : : "memory"); }
    { float s0 = 0.f, s1 = 0.f, s2 = 0.f, s3 = 0.f; { const f32x4 l = *(const LAS f32x4*)(Lc + 136); s3 = fmaf(x3, l[3], s3); } { const f32x4 l = *(const LAS f32x4*)(Lc + 140); s0 = fmaf(x4, l[0], s0); s1 = fmaf(x5, l[1], s1); s2 = fmaf(x6, l[2], s2); s3 = fmaf(x7, l[3], s3); } { const f32x4 l = *(const LAS f32x4*)(Lc + 144); s0 = fmaf(x8, l[0], s0); s1 = fmaf(x9, l[1], s1); s2 = fmaf(x10, l[2], s2); s3 = fmaf(x11, l[3], s3); } { const f32x4 l = *(const LAS f32x4*)(Lc + 148); s0 = fmaf(x12, l[0], s0); s1 = fmaf(x13, l[1], s1); s2 = fmaf(x14, l[2], s2); s3 = fmaf(x15, l[3], s3); } { const f32x4 l = *(const LAS f32x4*)(Lc + 152); s0 = fmaf(x16, l[0], s0); s1 = fmaf(x17, l[1], s1); s2 = fmaf(x18, l[2], s2); s3 = fmaf(x19, l[3], s3); } { const f32x4 l = *(const LAS f32x4*)(Lc + 156); s0 = fmaf(x20, l[0], s0); s1 = fmaf(x21, l[1], s1); s2 = fmaf(x22, l[2], s2); s3 = fmaf(x23, l[3], s3); } { const f32x4 l = *(const LAS f32x4*)(Lc + 160); s0 = fmaf(x24, l[0], s0); s1 = fmaf(x25, l[1], s1); s2 = fmaf(x26, l[2], s2); s3 = fmaf(x27, l[3], s3); } { const f32x4 l = *(const LAS f32x4*)(Lc + 164); s0 = fmaf(x28, l[0], s0); s1 = fmaf(x29, l[1], s1); s2 = fmaf(x30, l[2], s2); s3 = fmaf(x31, l[3], s3); } { const f32x4 l = *(const LAS f32x4*)(Lc + 168); s0 = fmaf(x32, l[0], s0); s1 = fmaf(x33, l[1], s1); s2 = fmaf(x34, l[2], s2); s3 = fmaf(x35, l[3], s3); } { const f32x4 l = *(const LAS f32x4*)(Lc + 172); s0 = fmaf(x36, l[0], s0); s1 = fmaf(x37, l[1], s1); s2 = fmaf(x38, l[2], s2); s3 = fmaf(x39, l[3], s3); } { const f32x4 l = *(const LAS f32x4*)(Lc + 176); s0 = fmaf(x40, l[0], s0); s1 = fmaf(x41, l[1], s1); s2 = fmaf(x42, l[2], s2); s3 = fmaf(x43, l[3], s3); } { const f32x4 l = *(const LAS f32x4*)(Lc + 180); s0 = fmaf(x44, l[0], s0); s1 = fmaf(x45, l[1], s1); s2 = fmaf(x46, l[2], s2); s3 = fmaf(x47, l[3], s3); } { const f32x4 l = *(const LAS f32x4*)(Lc + 184); s0 = fmaf(x48, l[0], s0); s1 = fmaf(x49, l[1], s1); s2 = fmaf(x50, l[2], s2); s3 = fmaf(x51, l[3], s3); } { const f32x4 l = *(const LAS f32x4*)(Lc + 188); s0 = fmaf(x52, l[0], s0); s1 = fmaf(x53, l[1], s1); s2 = fmaf(x54, l[2], s2); s3 = fmaf(x55, l[3], s3); } { const f32x4 l = *(const LAS f32x4*)(Lc + 192); s0 = fmaf(x56, l[0], s0); s1 = fmaf(x57, l[1], s1); s2 = fmaf(x58, l[2], s2); s3 = fmaf(x59, l[3], s3); } { const f32x4 l = *(const LAS f32x4*)(Lc + 196); s0 = fmaf(x60, l[0], s0); s1 = fmaf(x61, l[1], s1); s2 = fmaf(x62, l[2], s2); s3 = fmaf(x63, l[3], s3); } x2 = (lane == 2) ? 1.0f : -((s0 + s1) + (s2 + s3)); asm volatile("" : "+v"(x2) : : "memory"); }
    { float s0 = 0.f, s1 = 0.f, s2 = 0.f, s3 = 0.f; { const f32x4 l = *(const LAS f32x4*)(Lc + 68); s2 = fmaf(x2, l[2], s2); s3 = fmaf(x3, l[3], s3); } { const f32x4 l = *(const LAS f32x4*)(Lc + 72); s0 = fmaf(x4, l[0], s0); s1 = fmaf(x5, l[1], s1); s2 = fmaf(x6, l[2], s2); s3 = fmaf(x7, l[3], s3); } { const f32x4 l = *(const LAS f32x4*)(Lc + 76); s0 = fmaf(x8, l[0], s0); s1 = fmaf(x9, l[1], s1); s2 = fmaf(x10, l[2], s2); s3 = fmaf(x11, l[3], s3); } { const f32x4 l = *(const LAS f32x4*)(Lc + 80); s0 = fmaf(x12, l[0], s0); s1 = fmaf(x13, l[1], s1); s2 = fmaf(x14, l[2], s2); s3 = fmaf(x15, l[3], s3); } { const f32x4 l = *(const LAS f32x4*)(Lc + 84); s0 = fmaf(x16, l[0], s0); s1 = fmaf(x17, l[1], s1); s2 = fmaf(x18, l[2], s2); s3 = fmaf(x19, l[3], s3); } { const f32x4 l = *(const LAS f32x4*)(Lc + 88); s0 = fmaf(x20, l[0], s0); s1 = fmaf(x21, l[1], s1); s2 = fmaf(x22, l[2], s2); s3 = fmaf(x23, l[3], s3); } { const f32x4 l = *(const LAS f32x4*)(Lc + 92); s0 = fmaf(x24, l[0], s0); s1 = fmaf(x25, l[1], s1); s2 = fmaf(x26, l[2], s2); s3 = fmaf(x27, l[3], s3); } { const f32x4 l = *(const LAS f32x4*)(Lc + 96); s0 = fmaf(x28, l[0], s0); s1 = fmaf(x29, l[1], s1); s2 = fmaf(x30, l[2], s2); s3 = fmaf(x31, l[3], s3); } { const f32x4 l = *(const LAS f32x4*)(Lc + 100); s0 = fmaf(x32, l[0], s0); s1 = fmaf(x33, l[1], s1); s2 = fmaf(x34, l[2], s2); s3 = fmaf(x35, l[3], s3); } { const f32x4 l = *(const LAS f32x4*)(Lc + 104); s0 = fmaf(x36, l[0], s0); s1 = fmaf(x37, l[1], s1); s2 = fmaf(x38, l[2], s2); s3 = fmaf(x39, l[3], s3); } { const f32x4 l = *(const LAS f32x4*)(Lc + 108); s0 = fmaf(x40, l[0], s0); s1 = fmaf(x41, l[1], s1); s2 = fmaf(x42, l[2], s2); s3 = fmaf(x43, l[3], s3); } { const f32x4 l = *(const LAS f32x4*)(Lc + 112); s0 = fmaf(x44, l[0], s0); s1 = fmaf(x45, l[1], s1); s2 = fmaf(x46, l[2], s2); s3 = fmaf(x47, l[3], s3); } { const f32x4 l = *(const LAS f32x4*)(Lc + 116); s0 = fmaf(x48, l[0], s0); s1 = fmaf(x49, l[1], s1); s2 = fmaf(x50, l[2], s2); s3 = fmaf(x51, l[3], s3); } { const f32x4 l = *(const LAS f32x4*)(Lc + 120); s0 = fmaf(x52, l[0], s0); s1 = fmaf(x53, l[1], s1); s2 = fmaf(x54, l[2], s2); s3 = fmaf(x55, l[3], s3); } { const f32x4 l = *(const LAS f32x4*)(Lc + 124); s0 = fmaf(x56, l[0], s0); s1 = fmaf(x57, l[1], s1); s2 = fmaf(x58, l[2], s2); s3 = fmaf(x59, l[3], s3); } { const f32x4 l = *(const LAS f32x4*)(Lc + 128); s0 = fmaf(x60, l[0], s0); s1 = fmaf(x61, l[1], s1); s2 = fmaf(x62, l[2], s2); s3 = fmaf(x63, l[3], s3); } x1 = (lane == 1) ? 1.0f : -((s0 + s1) + (s2 + s3)); asm volatile("" : "+v"(x1) : : "memory"); }
    { float s0 = 0.f, s1 = 0.f, s2 = 0.f, s3 = 0.f; { const f32x4 l = *(const LAS f32x4*)(Lc + 0); s1 = fmaf(x1, l[1], s1); s2 = fmaf(x2, l[2], s2); s3 = fmaf(x3, l[3], s3); } { const f32x4 l = *(const LAS f32x4*)(Lc + 4); s0 = fmaf(x4, l[0], s0); s1 = fmaf(x5, l[1], s1); s2 = fmaf(x6, l[2], s2); s3 = fmaf(x7, l[3], s3); } { const f32x4 l = *(const LAS f32x4*)(Lc + 8); s0 = fmaf(x8, l[0], s0); s1 = fmaf(x9, l[1], s1); s2 = fmaf(x10, l[2], s2); s3 = fmaf(x11, l[3], s3); } { const f32x4 l = *(const LAS f32x4*)(Lc + 12); s0 = fmaf(x12, l[0], s0); s1 = fmaf(x13, l[1], s1); s2 = fmaf(x14, l[2], s2); s3 = fmaf(x15, l[3], s3); } { const f32x4 l = *(const LAS f32x4*)(Lc + 16); s0 = fmaf(x16, l[0], s0); s1 = fmaf(x17, l[1], s1); s2 = fmaf(x18, l[2], s2); s3 = fmaf(x19, l[3], s3); } { const f32x4 l = *(const LAS f32x4*)(Lc + 20); s0 = fmaf(x20, l[0], s0); s1 = fmaf(x21, l[1], s1); s2 = fmaf(x22, l[2], s2); s3 = fmaf(x23, l[3], s3); } { const f32x4 l = *(const LAS f32x4*)(Lc + 24); s0 = fmaf(x24, l[0], s0); s1 = fmaf(x25, l[1], s1); s2 = fmaf(x26, l[2], s2); s3 = fmaf(x27, l[3], s3); } { const f32x4 l = *(const LAS f32x4*)(Lc + 28); s0 = fmaf(x28, l[0], s0); s1 = fmaf(x29, l[1], s1); s2 = fmaf(x30, l[2], s2); s3 = fmaf(x31, l[3], s3); } { const f32x4 l = *(const LAS f32x4*)(Lc + 32); s0 = fmaf(x32, l[0], s0); s1 = fmaf(x33, l[1], s1); s2 = fmaf(x34, l[2], s2); s3 = fmaf(x35, l[3], s3); } { const f32x4 l = *(const LAS f32x4*)(Lc + 36); s0 = fmaf(x36, l[0], s0); s1 = fmaf(x37, l[1], s1); s2 = fmaf(x38, l[2], s2); s3 = fmaf(x39, l[3], s3); } { const f32x4 l = *(const LAS f32x4*)(Lc + 40); s0 = fmaf(x40, l[0], s0); s1 = fmaf(x41, l[1], s1); s2 = fmaf(x42, l[2], s2); s3 = fmaf(x43, l[3], s3); } { const f32x4 l = *(const LAS f32x4*)(Lc + 44); s0 = fmaf(x44, l[0], s0); s1 = fmaf(x45, l[1], s1); s2 = fmaf(x46, l[2], s2); s3 = fmaf(x47, l[3], s3); } { const f32x4 l = *(const LAS f32x4*)(Lc + 48); s0 = fmaf(x48, l[0], s0); s1 = fmaf(x49, l[1], s1); s2 = fmaf(x50, l[2], s2); s3 = fmaf(x51, l[3], s3); } { const f32x4 l = *(const LAS f32x4*)(Lc + 52); s0 = fmaf(x52, l[0], s0); s1 = fmaf(x53, l[1], s1); s2 = fmaf(x54, l[2], s2); s3 = fmaf(x55, l[3], s3); } { const f32x4 l = *(const LAS f32x4*)(Lc + 56); s0 = fmaf(x56, l[0], s0); s1 = fmaf(x57, l[1], s1); s2 = fmaf(x58, l[2], s2); s3 = fmaf(x59, l[3], s3); } { const f32x4 l = *(const LAS f32x4*)(Lc + 60); s0 = fmaf(x60, l[0], s0); s1 = fmaf(x61, l[1], s1); s2 = fmaf(x62, l[2], s2); s3 = fmaf(x63, l[3], s3); } x0 = (lane == 0) ? 1.0f : -((s0 + s1) + (s2 + s3)); asm volatile("" : "+v"(x0) : : "memory"); }
    { v4u o; o.x = cvtpk(x0, x1); o.y = cvtpk(x2, x3); o.z = cvtpk(x4, x5); o.w = cvtpk(x6, x7); *(LAS v4u*)(Xs + lane * 72 + 0) = o; }
    { v4u o; o.x = cvtpk(x8, x9); o.y = cvtpk(x10, x11); o.z = cvtpk(x12, x13); o.w = cvtpk(x14, x15); *(LAS v4u*)(Xs + lane * 72 + 8) = o; }
    { v4u o; o.x = cvtpk(x16, x17); o.y = cvtpk(x18, x19); o.z = cvtpk(x20, x21); o.w = cvtpk(x22, x23); *(LAS v4u*)(Xs + lane * 72 + 16) = o; }
    { v4u o; o.x = cvtpk(x24, x25); o.y = cvtpk(x26, x27); o.z = cvtpk(x28, x29); o.w = cvtpk(x30, x31); *(LAS v4u*)(Xs + lane * 72 + 24) = o; }
    { v4u o; o.x = cvtpk(x32, x33); o.y = cvtpk(x34, x35); o.z = cvtpk(x36, x37); o.w = cvtpk(x38, x39); *(LAS v4u*)(Xs + lane * 72 + 32) = o; }
    { v4u o; o.x = cvtpk(x40, x41); o.y = cvtpk(x42, x43); o.z = cvtpk(x44, x45); o.w = cvtpk(x46, x47); *(LAS v4u*)(Xs + lane * 72 + 40) = o; }
    { v4u o; o.x = cvtpk(x48, x49); o.y = cvtpk(x50, x51); o.z = cvtpk(x52, x53); o.w = cvtpk(x54, x55); *(LAS v4u*)(Xs + lane * 72 + 48) = o; }
    { v4u o; o.x = cvtpk(x56, x57); o.y = cvtpk(x58, x59); o.z = cvtpk(x60, x61); o.w = cvtpk(x62, x63); *(LAS v4u*)(Xs + lane * 72 + 56) = o; }
}
#ifndef G1P
#define G1P 15
#endif

#define MF16(a, b, c) __builtin_amdgcn_mfma_f32_16x16x32_bf16((a), (b), (c), 0, 0, 0)
__device__ __forceinline__ bf16x8 ld16g(const bf16* p) { return *(const GAS bf16x8*)p; }
__device__ __forceinline__ float ldbf(const bf16* p) { return __uint_as_float(((unsigned)*(const GAS unsigned short*)p) << 16); }
__device__ __forceinline__ void st8(bf16* p, float a, float b, float c, float d) { u32x2v o; o.x = cvtpk(a, b); o.y = cvtpk(c, d); *(GAS u32x2v*)p = o; }

__device__ __forceinline__ void p_ga(const Frame& F, const Args& a, int L) {
    GAS unsigned char* ws = (GAS unsigned char*)a.ws; asm volatile("" : "+s"(ws)); int lane_ = F.lane; asm volatile("" : "+v"(lane_)); const int j = L >> 1, lane = lane_;
    const bf16* PO = (const bf16*)(ws + WS_ARENA + AR_PO);
    bf16 *QN = (bf16*)(ws + WS_ARENA + AR_QN), *KN = (bf16*)(ws + WS_ARENA + AR_KN), *KGT = (bf16*)(ws + WS_ARENA + AR_KGT), *VBT = (bf16*)(ws + WS_ARENA + AR_VBT), *KTT = (bf16*)(ws + WS_ARENA + AR_KTT);
    const float* gg = (const float*)(ws + WS_GB); const float* gbeta = gg + S_ * 8; float* dn = (float*)(ws + WS_TOK + TOK_DN); float* gcs = (float*)(ws + WS_GC);
    const float* cw = (const float*)a.in[16] + (size_t)j * 4 * 3072;
    LAS bf16* tile = (LAS bf16*)(F.lds + F.wave * WAVE_LDS);
    const int dg = lane & 15, ts = lane >> 4, d0 = 8 * dg;
#pragma unroll 1
    for (int tp_ = 2 * F.vcu + (F.wave >> 2); tp_ < 512; tp_ += 2 * F.G) {
        const int u = (4 * (tp_ >> 3) + (F.wave & 3)) * 8 + (tp_ & 7);
        const int n = u >> 3, hh = u & 7, tok0 = 64 * n;
        float sA, sB, sBeta;
        {
            const float gv = *(const GAS float*)(gg + (size_t)(tok0 + lane) * 8 + hh), beta = *(const GAS float*)(gbeta + (size_t)(tok0 + lane) * 8 + hh);
            float gc = gv;
#pragma unroll
            for (int o = 1; o < 64; o <<= 1) { const float t = __shfl_up(gc, o); if (lane >= o) gc += t; }
            const float glast = __shfl(gc, 63);
            *(GAS float*)(gcs + (size_t)(tok0 + lane) * 8 + hh) = gc;
            if (lane == 0) dn[u] = expf(glast);
            sA = beta * expf(gc); sB = expf(glast - gc); sBeta = beta;
        }
#pragma unroll 1
        for (int qkv = 0; qkv < 3; ++qkv) {
            const int coff = qkv * 1024 + hh * 128 + d0;
            float w[4][8];
#pragma unroll
            for (int jj = 0; jj < 4; ++jj)
#pragma unroll
                for (int e = 0; e < 8; ++e) w[jj][e] = *(const GAS float*)(cw + jj * 3072 + coff + e);
            asm volatile("s_waitcnt lgkmcnt(0)" ::: "memory");
#pragma unroll 4
            for (int it = 0; it < 16; ++it) {
                const int i = 4 * it + ts, tok = tok0 + i; float acc[8];
                v4u rv[4];
#pragma unroll
                for (int jj = 0; jj < 4; ++jj) { const int r = tok - 3 + jj; rv[jj] = *(const GAS v4u*)(PO + (size_t)(r < 0 ? 0 : r) * OIN + coff); }
#pragma unroll
                for (int e = 0; e < 8; ++e) acc[e] = 0.f;
#pragma unroll
                for (int jj = 0; jj < 4; ++jj) { const float on = (tok - 3 + jj >= 0) ? 1.0f : 0.0f; const unsigned vv[4] = {rv[jj].x, rv[jj].y, rv[jj].z, rv[jj].w};
#pragma unroll
                    for (int q = 0; q < 4; ++q) { acc[2 * q] += (w[jj][2 * q] * on) * bflo(vv[q]); acc[2 * q + 1] += (w[jj][2 * q + 1] * on) * bfhi(vv[q]); } }
                float ss = 0.f;
#pragma unroll
                for (int e = 0; e < 8; ++e) { acc[e] = silu(acc[e]); ss += acc[e] * acc[e]; }
                ss += __shfl_xor(ss, 1); ss += __shfl_xor(ss, 2); ss += __shfl_xor(ss, 4); ss += __shfl_xor(ss, 8);
                const float rn = __builtin_amdgcn_rsqf(ss + 1e-6f);
                const float s1 = (qkv == 0) ? rn * 0.08838834764831845f : (qkv == 1 ? rn : 1.0f);
                v4u o; o.x = cvtpk(acc[0] * s1, acc[1] * s1); o.y = cvtpk(acc[2] * s1, acc[3] * s1); o.z = cvtpk(acc[4] * s1, acc[5] * s1); o.w = cvtpk(acc[6] * s1, acc[7] * s1);
                if (qkv < 2) *(GAS v4u*)((qkv == 0 ? QN : KN) + (size_t)tok * D_ + hh * 128 + d0) = o;
                if (qkv > 0) *(LAS v4u*)(tile + i * 136 + d0) = o;
            }
            if (qkv == 0) continue;
            asm volatile("s_waitcnt lgkmcnt(0)" ::: "memory");
#pragma unroll 1
            for (int half = 0; half < 2; ++half) {
                const int d = 64 * half + lane; const size_t obase = ((size_t)u * 128 + d) * 64;
                const LAS unsigned short* tp = (const LAS unsigned short*)tile + d;
#pragma unroll
                for (int ig = 0; ig < 8; ++ig) {
                    float o1[8], o2[8];
#pragma unroll
                    for (int e = 0; e < 8; ++e) { const int t = 8 * ig + e; const float v = __uint_as_float(((unsigned)tp[t * 136]) << 16);
                        const float m1 = __builtin_bit_cast(float, __builtin_amdgcn_readlane(__builtin_bit_cast(int, (qkv == 1) ? sA : sBeta), t));
                        const float m2 = __builtin_bit_cast(float, __builtin_amdgcn_readlane(__builtin_bit_cast(int, sB), t));
                        o1[e] = v * m1; o2[e] = v * m2; }
                    v4u o; o.x = cvtpk(o1[0], o1[1]); o.y = cvtpk(o1[2], o1[3]); o.z = cvtpk(o1[4], o1[5]); o.w = cvtpk(o1[6], o1[7]);
                    *(GAS v4u*)((qkv == 1 ? KGT : VBT) + obase + 8 * ig) = o;
                    if (qkv == 1) { o.x = cvtpk(o2[0], o2[1]); o.y = cvtpk(o2[2], o2[3]); o.z = cvtpk(o2[4], o2[5]); o.w = cvtpk(o2[6], o2[7]); *(GAS v4u*)(KTT + obase + 8 * ig) = o; }
                }
            }
        }
    }
}

__device__ __forceinline__ void p_g1(const Frame& F, const Args& a) {
    GAS unsigned char* ws = (GAS unsigned char*)a.ws; asm volatile("" : "+s"(ws)); int lane_ = F.lane; asm volatile("" : "+v"(lane_)); const int lane = lane_, r16 = lane & 15, g = lane >> 4;
    const bf16 *QN = (const bf16*)(ws + WS_ARENA + AR_QN), *KN = (const bf16*)(ws + WS_ARENA + AR_KN), *KGT = (const bf16*)(ws + WS_ARENA + AR_KGT), *VBT = (const bf16*)(ws + WS_ARENA + AR_VBT), *KTT = (const bf16*)(ws + WS_ARENA + AR_KTT);
    bf16 *AI = (bf16*)(ws + WS_ARENA + AR_AI), *NEGW = (bf16*)(ws + WS_ARENA + AR_NEGW), *UT = (bf16*)(ws + WS_ARENA + AR_UT);
    const float* gg = (const float*)(ws + WS_GC); const float* gbeta = (const float*)(ws + WS_GB) + S_ * 8;
    LAS float* Lc = (LAS float*)(F.lds + F.wave * WAVE_LDS);
    LAS bf16* Xs = (LAS bf16*)(F.lds + F.wave * WAVE_LDS);
    const f32x4 Z4 = {0.f, 0.f, 0.f, 0.f};
#ifdef PROBE_G1P
    const int g1p = a.use_bar ? 15 : PROBE_G1P;
#else
    const int g1p = 15;
#endif
#pragma unroll 1
    for (int tp_ = 2 * F.vcu + (F.wave >> 2); tp_ < 512; tp_ += 2 * F.G) {
        const int u = (4 * (tp_ >> 3) + (F.wave & 3)) * 8 + (tp_ & 7);
        const int n = u >> 3, hh = u & 7, tok0 = 64 * n; const int uh = hh * NCHUNK + n;
        const float gc = gg[(size_t)(tok0 + lane) * 8 + hh], beta = gbeta[(size_t)(tok0 + lane) * 8 + hh];
        if (g1p & 1) {
        {
            bf16x8 kf[4][4];
#pragma unroll
            for (int t = 0; t < 4; ++t)
#pragma unroll
                for (int kk = 0; kk < 4; ++kk) kf[t][kk] = ld16g(KN + (size_t)(tok0 + 16 * t + r16) * D_ + hh * 128 + 32 * kk + 8 * g);
#pragma unroll
            for (int ti = 0; ti < 4; ++ti)
#pragma unroll
                for (int tj = 0; tj <= ti; ++tj) {
                    f32x4 Dv = Z4;
#pragma unroll
                    for (int kk = 0; kk < 4; ++kk) Dv = MF16(kf[ti][kk], kf[tj][kk], Dv);
                    const int jx = 16 * tj + r16; const float gcj = __shfl(gc, jx); f32x4 val;
#pragma unroll
                    for (int r = 0; r < 4; ++r) { const int ix = 16 * ti + 4 * g + r; const float gci = __shfl(gc, ix), bi = __shfl(beta, ix); val[r] = (ix > jx) ? bi * Dv[r] * expf(gci - gcj) : 0.f; }
                    *(LAS f32x4*)(Lc + jx * 68 + 16 * ti + 4 * g) = val;
                }
#pragma unroll
            for (int ti = 0; ti < 4; ++ti) {
                bf16x8 qf[4];
#pragma unroll
                for (int kk = 0; kk < 4; ++kk) qf[kk] = ld16g(QN + (size_t)(tok0 + 16 * ti + r16) * D_ + hh * 128 + 32 * kk + 8 * g);
                const int ix = 16 * ti + r16; const float gci = __shfl(gc, ix);
#pragma unroll
                for (int tj = 0; tj < 4; ++tj) {
                    f32x4 val = Z4;
                    if (tj <= ti) {
                        f32x4 Dv = Z4;
#pragma unroll
                        for (int kk = 0; kk < 4; ++kk) Dv = MF16(kf[tj][kk], qf[kk], Dv);
#pragma unroll
                        for (int r = 0; r < 4; ++r) { const int jx = 16 * tj + 4 * g + r; const float gcj = __shfl(gc, jx); val[r] = (ix >= jx) ? Dv[r] * expf(gci - gcj) : 0.f; }
                    }
                    st8(AI + ((size_t)u * 64 + ix) * 64 + 16 * tj + 4 * g, val[0], val[1], val[2], val[3]);
                }
            }
        }
        asm volatile("s_waitcnt lgkmcnt(0)" ::: "memory");
        }
        if (g1p & 2) {
        tri_solve(Lc, Xs, lane);
        }
        if (g1p & 4) {
        asm volatile("s_waitcnt lgkmcnt(0)" ::: "memory");
        {
            bf16x8 xf[4][2];
#pragma unroll
            for (int t = 0; t < 4; ++t)
#pragma unroll
                for (int kk = 0; kk < 2; ++kk) xf[t][kk] = *(const LAS bf16x8*)(Xs + (16 * t + r16) * 72 + 32 * kk + 8 * g);
#pragma unroll 2
            for (int td = 0; td < 8; ++td) {
                const size_t rb = ((size_t)u * 128 + 16 * td + r16) * 64;
                const bf16x8 vb0 = ld16g(VBT + rb + 8 * g), vb1 = ld16g(VBT + rb + 32 + 8 * g), kg0 = ld16g(KGT + rb + 8 * g), kg1 = ld16g(KGT + rb + 32 + 8 * g);
#pragma unroll
                for (int ti = 0; ti < 4; ++ti) {
                    f32x4 Du = MF16(xf[ti][0], vb0, Z4); Du = MF16(xf[ti][1], vb1, Du);
                    st8(UT + rb + 16 * ti + 4 * g, Du[0], Du[1], Du[2], Du[3]);
                    f32x4 Dn = MF16(kg0, xf[ti][0], Z4); Dn = MF16(kg1, xf[ti][1], Dn);
                    st8(NEGW + (size_t)(tok0 + 16 * ti + r16) * D_ + hh * 128 + 16 * td + 4 * g, -Dn[0], -Dn[1], -Dn[2], -Dn[3]);
                }
            }
        }
        }
    }
}

template <int NS, int SGSTEP> __device__ __forceinline__ void p_g2(const Frame& F, const Args& a, const bf16* MPsrc, const bf16* NTsrc, const float* dnsrc, int scan_id) {
    GAS unsigned char* ws = (GAS unsigned char*)a.ws; asm volatile("" : "+s"(ws)); int lane_ = F.lane; asm volatile("" : "+v"(lane_)); const int lane = lane_, r16 = lane & 15, g = lane >> 4, w = F.wave;
    const bf16 *MP = MPsrc, *NT = NTsrc; bf16* SG = (bf16*)(ws + WS_ARENA + AR_SG);
    const float* dn = dnsrc;
    LAS bf16* St = (LAS bf16*)F.lds;
    const int args_use_bar = a.use_bar; (void)args_use_bar;
#pragma unroll 1
    for (int asg = scan_id; asg < 64; asg += F.G) {
        const int hh = asg >> 3, sl = asg & 7;
        __syncthreads();
        for (int idx = F.tid; idx < 2 * 16 * 136 / 2; idx += NWAVES * 64) ((LAS unsigned*)St)[idx] = 0u;
        __syncthreads();
        if (w >= 4) {
            const int st = F.tid - 256, row = st >> 4, chunk = st & 15;
#pragma unroll 1
            for (int n = 0; n < NS; ++n) {
                const v4u v = *(const LAS v4u*)(St + (n & 1) * (16 * 136) + row * 136 + chunk * 8);
                *(GAS v4u*)(SG + ((size_t)(hh * NCHUNK + n * SGSTEP) * 128 + 16 * sl + row) * 128 + chunk * 8) = v;
                asm volatile("s_waitcnt lgkmcnt(0)" ::: "memory"); __builtin_amdgcn_s_barrier(); asm volatile("" ::: "memory");
            }
        } else {
            f32x4 Sv[2] = {{0.f, 0.f, 0.f, 0.f}, {0.f, 0.f, 0.f, 0.f}};
            bf16x8 A0[2][4], A1[2][4], A2[2][4], A3[2][4]; u32x2v C0[2], C1[2], C2[2], C3[2]; float d0, d1, d2, d3;
#define G2_LOAD(AX, CX, DX, nn) do { const int u_ = hh * NS + (nn); \
            _Pragma("unroll") for (int t = 0; t < 2; ++t) { \
                _Pragma("unroll") for (int kk = 0; kk < 4; ++kk) AX[t][kk] = ld16g(MP + ((size_t)u_ * 128 + 32 * w + 16 * t + r16) * 128 + 32 * kk + 8 * g); \
                CX[t] = *(const GAS u32x2v*)(NT + ((size_t)u_ * 128 + 16 * sl + r16) * 128 + 32 * w + 16 * t + 4 * g); } \
            DX = *(const GAS float*)(dn + (nn) * 8 + hh); } while (0)
#ifdef PROBE_G2_NOLOAD
#define G2_STEPLOAD(AL, CL, DL, nn) do { if (args_use_bar) G2_LOAD(AL, CL, DL, nn); } while (0)
#else
#define G2_STEPLOAD(AL, CL, DL, nn) G2_LOAD(AL, CL, DL, nn)
#endif
#define G2_STEP(AU, CU, DU, AL, CL, DL, nn) do { const int n_ = (nn); const int n2_ = (n_ + 3 < NS) ? n_ + 3 : NS - 1; \
            G2_STEPLOAD(AL, CL, DL, n2_); \
            LAS bf16* Sc = St + (n_ & 1) * (16 * 136); LAS bf16* Sn = St + ((n_ & 1) ^ 1) * (16 * 136); \
            f32x4 D0 = {bflo(CU[0].x), bfhi(CU[0].x), bflo(CU[0].y), bfhi(CU[0].y)}, D1 = {bflo(CU[1].x), bfhi(CU[1].x), bflo(CU[1].y), bfhi(CU[1].y)}; \
            _Pragma("unroll") for (int kk = 0; kk < 4; ++kk) { const bf16x8 Bf = *(const LAS bf16x8*)(Sc + r16 * 136 + 32 * kk + 8 * g); D0 = MF16(AU[0][kk], Bf, D0); D1 = MF16(AU[1][kk], Bf, D1); } \
            Sv[0] = Sv[0] * DU + D0; Sv[1] = Sv[1] * DU + D1; \
            { u32x2v o; o.x = cvtpk(Sv[0][0], Sv[0][1]); o.y = cvtpk(Sv[0][2], Sv[0][3]); *(LAS u32x2v*)(Sn + r16 * 136 + 32 * w + 4 * g) = o; \
              o.x = cvtpk(Sv[1][0], Sv[1][1]); o.y = cvtpk(Sv[1][2], Sv[1][3]); *(LAS u32x2v*)(Sn + r16 * 136 + 32 * w + 16 + 4 * g) = o; } \
            asm volatile("s_waitcnt lgkmcnt(0)" ::: "memory"); __builtin_amdgcn_s_barrier(); asm volatile("" ::: "memory"); } while (0)
            G2_LOAD(A0, C0, d0, 0); G2_LOAD(A1, C1, d1, 1); G2_LOAD(A2, C2, d2, 2);
            static_assert(NS % 24 == 16, "scan loop: trips of 24 steps + a 16-step tail");
            int n = 0;
#pragma unroll 1
            for (; n + 24 <= NS - 16; n += 24) {
                G2_STEP(A0, C0, d0, A3, C3, d3, n + 0);
                G2_STEP(A1, C1, d1, A0, C0, d0, n + 1);
                G2_STEP(A2, C2, d2, A1, C1, d1, n + 2);
                G2_STEP(A3, C3, d3, A2, C2, d2, n + 3);
                G2_STEP(A0, C0, d0, A3, C3, d3, n + 4);
                G2_STEP(A1, C1, d1, A0, C0, d0, n + 5);
                G2_STEP(A2, C2, d2, A1, C1, d1, n + 6);
                G2_STEP(A3, C3, d3, A2, C2, d2, n + 7);
                G2_STEP(A0, C0, d0, A3, C3, d3, n + 8);
                G2_STEP(A1, C1, d1, A0, C0, d0, n + 9);
                G2_STEP(A2, C2, d2, A1, C1, d1, n + 10);
                G2_STEP(A3, C3, d3, A2, C2, d2, n + 11);
                G2_STEP(A0, C0, d0, A3, C3, d3, n + 12);
                G2_STEP(A1, C1, d1, A0, C0, d0, n + 13);
                G2_STEP(A2, C2, d2, A1, C1, d1, n + 14);
                G2_STEP(A3, C3, d3, A2, C2, d2, n + 15);
                G2_STEP(A0, C0, d0, A3, C3, d3, n + 16);
                G2_STEP(A1, C1, d1, A0, C0, d0, n + 17);
                G2_STEP(A2, C2, d2, A1, C1, d1, n + 18);
                G2_STEP(A3, C3, d3, A2, C2, d2, n + 19);
                G2_STEP(A0, C0, d0, A3, C3, d3, n + 20);
                G2_STEP(A1, C1, d1, A0, C0, d0, n + 21);
                G2_STEP(A2, C2, d2, A1, C1, d1, n + 22);
                G2_STEP(A3, C3, d3, A2, C2, d2, n + 23);
            }
            G2_STEP(A0, C0, d0, A3, C3, d3, n + 0);
            G2_STEP(A1, C1, d1, A0, C0, d0, n + 1);
            G2_STEP(A2, C2, d2, A1, C1, d1, n + 2);
            G2_STEP(A3, C3, d3, A2, C2, d2, n + 3);
            G2_STEP(A0, C0, d0, A3, C3, d3, n + 4);
            G2_STEP(A1, C1, d1, A0, C0, d0, n + 5);
            G2_STEP(A2, C2, d2, A1, C1, d1, n + 6);
            G2_STEP(A3, C3, d3, A2, C2, d2, n + 7);
            G2_STEP(A0, C0, d0, A3, C3, d3, n + 8);
            G2_STEP(A1, C1, d1, A0, C0, d0, n + 9);
            G2_STEP(A2, C2, d2, A1, C1, d1, n + 10);
            G2_STEP(A3, C3, d3, A2, C2, d2, n + 11);
            G2_STEP(A0, C0, d0, A3, C3, d3, n + 12);
            G2_STEP(A1, C1, d1, A0, C0, d0, n + 13);
            G2_STEP(A2, C2, d2, A1, C1, d1, n + 14);
            G2_STEP(A3, C3, d3, A2, C2, d2, n + 15);
#undef G2_STEP
#undef G2_LOAD
        }
    }
}


constexpr int GST_W = 64 * 136, GST_K = 128 * 68, GST_PAIR = GST_W + GST_K, GST_BYTES = 2 * GST_PAIR * 2, GW_BYTES = 8704;
static_assert(GST_BYTES + 8 * GW_BYTES <= LDSCTL_OFF, "group-phase LDS map");
__device__ __forceinline__ void g_stage(const Frame& F, const bf16* NEGW, const bf16* KTT, int p, int n, int hh, bool on) {
    LAS bf16* sw = (LAS bf16*)F.lds + p * GST_PAIR; LAS bf16* sk = sw + GST_W;
#pragma unroll
    for (int q = 0; q < 2; ++q) { const int idx = F.tid + 512 * q;
        { const int row = idx >> 4, ch = idx & 15; v4u v = {0u, 0u, 0u, 0u}; if (on) v = *(const GAS v4u*)(NEGW + (size_t)(64 * n + row) * D_ + hh * 128 + ch * 8); *(LAS v4u*)(sw + row * 136 + ch * 8) = v; }
        { const int row = idx >> 3, ch = idx & 7; u32x2v a = {0u, 0u}, b = a; if (on) { const v4u v = *(const GAS v4u*)(KTT + ((size_t)(n * 8 + hh) * 128 + row) * 64 + ch * 8); a.x = v.x; a.y = v.y; b.x = v.z; b.y = v.w; }
          *(LAS u32x2v*)(sk + row * 68 + ch * 8) = a; *(LAS u32x2v*)(sk + row * 68 + ch * 8 + 4) = b; } }
}
template <bool PERM> __device__ __forceinline__ void g_prod1(f32x4 (&T)[4][2], const LAS bf16* sw, const bf16x8 (&xo)[4][2], int r16, int g) {
#pragma unroll
    for (int mt = 0; mt < 4; ++mt) {
        bf16x8 af[4];
#pragma unroll
        for (int s = 0; s < 4; ++s) {
            if (PERM) { const LAS bf16* rp = sw + (16 * mt + r16) * 136 + 32 * s + 4 * g; const u32x2v lo = *(const LAS u32x2v*)rp, hi = *(const LAS u32x2v*)(rp + 16); const v4u pk = {lo.x, lo.y, hi.x, hi.y}; af[s] = __builtin_bit_cast(bf16x8, pk); }
            else af[s] = *(const LAS bf16x8*)(sw + (16 * mt + r16) * 136 + 32 * s + 8 * g); }
#pragma unroll
        for (int nt = 0; nt < 2; ++nt)
#pragma unroll
            for (int s = 0; s < 4; ++s) T[mt][nt] = MF16(af[s], xo[s][nt], T[mt][nt]);
        asm volatile("" ::: "memory");
    }
}
__device__ __forceinline__ void g_prod2(f32x4 (&X)[8][2], const LAS bf16* sk, const f32x4 (&T)[4][2], int r16, int g) {
    bf16x8 to[2][2];
#pragma unroll
    for (int s = 0; s < 2; ++s)
#pragma unroll
        for (int nt = 0; nt < 2; ++nt) { v4u p; p.x = cvtpk(T[2 * s][nt][0], T[2 * s][nt][1]); p.y = cvtpk(T[2 * s][nt][2], T[2 * s][nt][3]); p.z = cvtpk(T[2 * s + 1][nt][0], T[2 * s + 1][nt][1]); p.w = cvtpk(T[2 * s + 1][nt][2], T[2 * s + 1][nt][3]);
            to[s][nt] = __builtin_bit_cast(bf16x8, p); }
#pragma unroll
    for (int mt = 0; mt < 8; ++mt) {
        bf16x8 af[2];
#pragma unroll
        for (int s = 0; s < 2; ++s) { const LAS bf16* rp = sk + (16 * mt + r16) * 68 + 32 * s + 4 * g; const u32x2v lo = *(const LAS u32x2v*)rp, hi = *(const LAS u32x2v*)(rp + 16); const v4u pk = {lo.x, lo.y, hi.x, hi.y}; af[s] = __builtin_bit_cast(bf16x8, pk); }
#pragma unroll
        for (int nt = 0; nt < 2; ++nt)
#pragma unroll
            for (int s = 0; s < 2; ++s) X[mt][nt] = MF16(af[s], to[s][nt], X[mt][nt]);
        asm volatile("" ::: "memory");
    }
}
__device__ __forceinline__ void p_g1b(const Frame& F, const Args& a) {
    GAS unsigned char* ws = (GAS unsigned char*)a.ws; asm volatile("" : "+s"(ws)); int lane_ = F.lane; asm volatile("" : "+v"(lane_)); const int lane = lane_, r16 = lane & 15, g = lane >> 4;
    const bf16 *NEGW = (const bf16*)(ws + WS_ARENA + AR_NEGW), *KTT = (const bf16*)(ws + WS_ARENA + AR_KTT), *UT = (const bf16*)(ws + WS_ARENA + AR_UT); const float* dn = (const float*)(ws + WS_TOK + TOK_DN);
    bf16 *MPc = (bf16*)(ws + WS_ARENA + AR_MPC), *NTc = (bf16*)(ws + WS_ARENA + AR_NTC); float* dnc = (float*)(ws + WS_TOK + TOK_DNC);
    const bool isB = F.wave >= 4; const int sl = F.wave & 3, c0 = 32 * sl;
    const LAS bf16* sw = (const LAS bf16*)F.lds; const LAS bf16* sk = sw + GST_W; LAS bf16* wa = (LAS bf16*)(F.lds + GST_BYTES + F.wave * GW_BYTES);
#pragma unroll 1
    for (int tp = 2 * F.vcu; tp < 512; tp += (tp & 1) ? 2 * F.G - 1 : 1) {
        const int hh = tp & 7, gq = tp >> 3;
        f32x4 X[8][2]; float Dd = 1.0f;
#pragma unroll
        for (int mt = 0; mt < 8; ++mt)
#pragma unroll
            for (int nt = 0; nt < 2; ++nt) X[mt][nt] = (f32x4){0.f, 0.f, 0.f, 0.f};
#pragma unroll 1
        for (int i = 0; i < 4; ++i) {
            const int n = 4 * gq + i; const float di = *(const GAS float*)(dn + n * 8 + hh);
            bf16x8 xo[4][2]; const float dadd = isB ? 0.0f : Dd;
#pragma unroll
            for (int s = 0; s < 4; ++s)
#pragma unroll
                for (int nt = 0; nt < 2; ++nt) { v4u pr; const int col = c0 + 16 * nt + r16; f32x4 t0 = X[2 * s][nt], t1 = X[2 * s + 1][nt];
#pragma unroll
                    for (int r = 0; r < 4; ++r) { if (32 * s + 4 * g + r == col) t0[r] += dadd; if (32 * s + 16 + 4 * g + r == col) t1[r] += dadd; }
                    pr.x = cvtpk(t0[0], t0[1]); pr.y = cvtpk(t0[2], t0[3]); pr.z = cvtpk(t1[0], t1[1]); pr.w = cvtpk(t1[2], t1[3]); xo[s][nt] = __builtin_bit_cast(bf16x8, pr); }
            __syncthreads();
            g_stage(F, NEGW, KTT, 0, n, hh, true);
            f32x4 T[4][2];
#pragma unroll
            for (int mt = 0; mt < 4; ++mt)
#pragma unroll
                for (int nt = 0; nt < 2; ++nt) { T[mt][nt] = (f32x4){0.f, 0.f, 0.f, 0.f};
                    if (isB) { const u32x2v uu = *(const GAS u32x2v*)(UT + ((size_t)(n * 8 + hh) * 128 + c0 + 16 * nt + r16) * 64 + 16 * mt + 4 * g); T[mt][nt] = (f32x4){bflo(uu.x), bfhi(uu.x), bflo(uu.y), bfhi(uu.y)}; } }
            __syncthreads();
            g_prod1<true>(T, sw, xo, r16, g);
#pragma unroll
            for (int mt = 0; mt < 8; ++mt)
#pragma unroll
                for (int nt = 0; nt < 2; ++nt) X[mt][nt] = X[mt][nt] * di;
            g_prod2(X, sk, T, r16, g);
            Dd *= di;
        }
        const int uc = hh * 64 + gq;
        if (isB) {
#pragma unroll
            for (int mt = 0; mt < 8; ++mt)
#pragma unroll
                for (int nt = 0; nt < 2; ++nt) st8(NTc + ((size_t)uc * 128 + c0 + 16 * nt + r16) * 128 + 16 * mt + 4 * g, X[mt][nt][0], X[mt][nt][1], X[mt][nt][2], X[mt][nt][3]);
        } else {
            if (sl == 0 && lane == 0) dnc[gq * 8 + hh] = Dd;
#pragma unroll
            for (int hf = 0; hf < 2; ++hf) {
                asm volatile("s_waitcnt lgkmcnt(0)" ::: "memory");
#pragma unroll
                for (int m4 = 0; m4 < 4; ++m4)
#pragma unroll
                    for (int nt = 0; nt < 2; ++nt)
#pragma unroll
                        for (int r = 0; r < 4; ++r) wa[(16 * m4 + 4 * g + r) * 40 + 16 * nt + r16] = (unsigned short)(cvtpk(X[4 * hf + m4][nt][r], 0.f) & 0xffffu);
                asm volatile("s_waitcnt lgkmcnt(0)" ::: "memory");
#pragma unroll
                for (int q = 0; q < 4; ++q) { const int row = 16 * q + (lane >> 2), ch = lane & 3; const v4u v = *(const LAS v4u*)(wa + row * 40 + ch * 8);
                    *(GAS v4u*)(MPc + ((size_t)uc * 128 + 64 * hf + row) * 128 + c0 + ch * 8) = v; }
            }
        }
    }
    __syncthreads();
}

__device__ __forceinline__ void p_g23(const Frame& F, const Args& a, int L) {
    GAS unsigned char* ws = (GAS unsigned char*)a.ws; asm volatile("" : "+s"(ws)); int lane_ = F.lane; asm volatile("" : "+v"(lane_)); const int lane = lane_, r16 = lane & 15, g = lane >> 4;
    const bf16 *NEGW = (const bf16*)(ws + WS_ARENA + AR_NEGW), *KTT = (const bf16*)(ws + WS_ARENA + AR_KTT), *UT = (const bf16*)(ws + WS_ARENA + AR_UT), *SG = (const bf16*)(ws + WS_ARENA + AR_SG),
               *QN = (const bf16*)(ws + WS_ARENA + AR_QN), *AI = (const bf16*)(ws + WS_ARENA + AR_AI), *PO = (const bf16*)(ws + WS_ARENA + AR_PO);
    const float* gcs = (const float*)(ws + WS_GC);
    const float* dn = (const float*)(ws + WS_TOK + TOK_DN); bf16* mix = (bf16*)(ws + WS_MIX); const float* onorm = (const float*)a.in[19] + (L >> 1) * 128;
    const int pw = F.wave >> 2, qf = F.wave & 3, c0 = 32 * qf;
    const LAS bf16* sw = (const LAS bf16*)F.lds + pw * GST_PAIR; const LAS bf16* sk = sw + GST_W; LAS bf16* Sl = (LAS bf16*)(F.lds + GST_BYTES + F.wave * GW_BYTES);
    LAS float* xch = (LAS float*)(F.lds + RT_OFF);
#pragma unroll 1
    for (int tp0 = 2 * F.vcu; tp0 < 512; tp0 += 2 * F.G) {
        const int tp = tp0 + pw; const bool on = tp < 512; const int tpc = on ? tp : 0, hh = tpc & 7, gq = tpc >> 3;
        const int tpa = tp0, tpb = (tp0 + 1 < 512) ? tp0 + 1 : 0;
        { const int u0 = hh * NCHUNK + 4 * gq;
#pragma unroll
          for (int q = 0; q < 8; ++q) { const int row = 4 * q + (lane >> 4), ch = lane & 15; const v4u v = *(const GAS v4u*)(SG + ((size_t)u0 * 128 + c0 + row) * 128 + ch * 8); *(LAS v4u*)(Sl + row * 136 + ch * 8) = v; } }
#pragma unroll 1
        for (int i = 0; i < 4; ++i) {
            __syncthreads();
            g_stage(F, NEGW, KTT, 0, 4 * (tpa >> 3) + i, tpa & 7, tpa < 512); g_stage(F, NEGW, KTT, 1, 4 * (tpb >> 3) + i, tpb & 7, tp0 + 1 < 512);
            const int n = 4 * gq + i, u = n * 8 + hh, tok0 = 64 * n; const float di = *(const GAS float*)(dn + n * 8 + hh);
            f32x4 T[4][2];
#pragma unroll
            for (int mt = 0; mt < 4; ++mt)
#pragma unroll
                for (int nt = 0; nt < 2; ++nt) { const u32x2v uu = *(const GAS u32x2v*)(UT + ((size_t)u * 128 + c0 + 16 * nt + r16) * 64 + 16 * mt + 4 * g); T[mt][nt] = (f32x4){bflo(uu.x), bfhi(uu.x), bflo(uu.y), bfhi(uu.y)}; }
            asm volatile("s_waitcnt lgkmcnt(0)" ::: "memory");
            bf16x8 Bf[4][2];
#pragma unroll
            for (int nt = 0; nt < 2; ++nt)
#pragma unroll
                for (int s = 0; s < 4; ++s) Bf[s][nt] = *(const LAS bf16x8*)(Sl + (16 * nt + r16) * 136 + 32 * s + 8 * g);
            __syncthreads();
            g_prod1<false>(T, sw, Bf, r16, g);
            bf16x8 vo[2][2];
#pragma unroll
            for (int s = 0; s < 2; ++s)
#pragma unroll
                for (int nt = 0; nt < 2; ++nt) { v4u p; p.x = cvtpk(T[2 * s][nt][0], T[2 * s][nt][1]); p.y = cvtpk(T[2 * s][nt][2], T[2 * s][nt][3]); p.z = cvtpk(T[2 * s + 1][nt][0], T[2 * s + 1][nt][1]); p.w = cvtpk(T[2 * s + 1][nt][2], T[2 * s + 1][nt][3]);
                    vo[s][nt] = __builtin_bit_cast(bf16x8, p); }
            f32x4 o[2][4];
#pragma unroll
            for (int it = 0; it < 4; ++it) {
                const int tok = tok0 + 16 * it + r16; bf16x8 qfr[4], afr[2];
                { const float eg = expf(*(const GAS float*)(gcs + (size_t)tok * 8 + hh));
#pragma unroll
                  for (int s = 0; s < 4; ++s) { const v4u qv = *(const GAS v4u*)(QN + (size_t)tok * D_ + hh * 128 + 32 * s + 8 * g); v4u qs;
                      qs.x = cvtpk(bflo(qv.x) * eg, bfhi(qv.x) * eg); qs.y = cvtpk(bflo(qv.y) * eg, bfhi(qv.y) * eg); qs.z = cvtpk(bflo(qv.z) * eg, bfhi(qv.z) * eg); qs.w = cvtpk(bflo(qv.w) * eg, bfhi(qv.w) * eg);
                      qfr[s] = __builtin_bit_cast(bf16x8, qs); } }
#pragma unroll
                for (int s = 0; s < 2; ++s) { const bf16* ap = AI + ((size_t)u * 64 + 16 * it + r16) * 64 + 32 * s + 4 * g; const u32x2v lo = *(const GAS u32x2v*)ap, hi = *(const GAS u32x2v*)(ap + 16);
                    const v4u pk = {lo.x, lo.y, hi.x, hi.y}; afr[s] = __builtin_bit_cast(bf16x8, pk); }
#pragma unroll
                for (int nt = 0; nt < 2; ++nt) { f32x4 Dv = {0.f, 0.f, 0.f, 0.f};
#pragma unroll
                    for (int s = 0; s < 4; ++s) Dv = MF16(Bf[s][nt], qfr[s], Dv);
#pragma unroll
                    for (int s = 0; s < 2; ++s) Dv = MF16(vo[s][nt], afr[s], Dv);
                    o[nt][it] = Dv; }
            }
            __syncthreads();
#pragma unroll
            for (int it = 0; it < 4; ++it) { float ss = 0.f;
#pragma unroll
                for (int nt = 0; nt < 2; ++nt) ss += (o[nt][it][0] * o[nt][it][0] + o[nt][it][1] * o[nt][it][1]) + (o[nt][it][2] * o[nt][it][2] + o[nt][it][3] * o[nt][it][3]);
                ss += __shfl_xor(ss, 16); ss += __shfl_xor(ss, 32);
                if (g == 0) xch[(pw * 4 + qf) * 64 + 16 * it + r16] = ss; }
            __syncthreads();
#pragma unroll
            for (int it = 0; it < 4; ++it) { const int ti = 16 * it + r16, tok = tok0 + ti;
                const float ssq = (xch[(pw * 4 + 0) * 64 + ti] + xch[(pw * 4 + 1) * 64 + ti]) + (xch[(pw * 4 + 2) * 64 + ti] + xch[(pw * 4 + 3) * 64 + ti]);
                const float rms = __builtin_amdgcn_rsqf(ssq * (1.0f / 128.0f) + RMS_EPS);
#pragma unroll
                for (int nt = 0; nt < 2; ++nt) { const int col = c0 + 16 * nt + 4 * g;
                    const u32x2v z = *(const GAS u32x2v*)(PO + (size_t)tok * OIN + 3072 + hh * 128 + col); const f32x4 gn = *(const GAS f32x4*)(onorm + col);
                    if (on) st8(mix + (size_t)tok * D_ + hh * 128 + col, o[nt][it][0] * rms * gn[0] * silu(bflo(z.x)), o[nt][it][1] * rms * gn[1] * silu(bfhi(z.x)),
                                o[nt][it][2] * rms * gn[2] * silu(bflo(z.y)), o[nt][it][3] * rms * gn[3] * silu(bfhi(z.y))); } }
            if (i < 3) {
                f32x4 acc[8][2];
#pragma unroll
                for (int mt = 0; mt < 8; ++mt)
#pragma unroll
                    for (int nt = 0; nt < 2; ++nt) { const u32x2v so = *(const LAS u32x2v*)(Sl + (16 * nt + r16) * 136 + 16 * mt + 4 * g); acc[mt][nt] = (f32x4){di * bflo(so.x), di * bfhi(so.x), di * bflo(so.y), di * bfhi(so.y)}; }
                g_prod2(acc, sk, T, r16, g);
                asm volatile("s_waitcnt lgkmcnt(0)" ::: "memory");
#pragma unroll
                for (int mt = 0; mt < 8; ++mt)
#pragma unroll
                    for (int nt = 0; nt < 2; ++nt) { u32x2v ov; ov.x = cvtpk(acc[mt][nt][0], acc[mt][nt][1]); ov.y = cvtpk(acc[mt][nt][2], acc[mt][nt][3]); *(LAS u32x2v*)(Sl + (16 * nt + r16) * 136 + 16 * mt + 4 * g) = ov; }
            }
        }
    }
    __syncthreads();
}

__device__ __forceinline__ void p_r1(const Frame& F, const Args& a, int L) {
    GAS unsigned char* ws = (GAS unsigned char*)a.ws; asm volatile("" : "+s"(ws)); int lane_ = F.lane; asm volatile("" : "+v"(lane_)); const int j = L >> 1, lane = lane_;
    const float* ssq = (const float*)(ws + WS_SSQA); const float* wr = (const float*)a.in[24] + (size_t)j * D_ * NEXP; const float* ln = (const float*)a.in[4] + L * D_;
    int* tok_e = (int*)(ws + WS_TOK + TOK_E); int* tok_r = (int*)(ws + WS_TOK + TOK_R); float* tok_g = (float*)(ws + WS_TOK + TOK_G);
    unsigned* gcount = (unsigned*)(ws + WS_CTL) + CW_CNT + 64 * j;
    LAS int* rt = (LAS int*)(F.lds + RT_OFF);
    if (F.tid < 16) rt[F.tid] = 0;
    __syncthreads();
    const GAS unsigned short* hB = (const GAS unsigned short*)(ws + WS_HBF); const GAS float* wrG = (const GAS float*)wr; const GAS float* lnG = (const GAS float*)ln;
    float lnr[16];
#pragma unroll
    for (int i = 0; i < 16; ++i) lnr[i] = lnG[64 * i + lane];
#pragma unroll 1
    for (int t = F.gw; t < S_; t += 2 * F.NGW) {
        const int tb = t + F.NGW; const bool hasb = tb < S_; const int tbc = hasb ? tb : t;
        float xa[16], xb[16];
#pragma unroll
        for (int i = 0; i < 16; ++i) { xa[i] = __uint_as_float(((unsigned)hB[(size_t)t * D_ + 64 * i + lane]) << 16); xb[i] = __uint_as_float(((unsigned)hB[(size_t)tbc * D_ + 64 * i + lane]) << 16); }
        const float rsa = pg8::rstd_row(ssq, t), rsb = pg8::rstd_row(ssq, tbc);
        float acca[8], accb[8];
#pragma unroll
        for (int e = 0; e < 8; ++e) { acca[e] = 0.f; accb[e] = 0.f; }
#pragma unroll
        for (int i = 0; i < 16; ++i) { const int k = 64 * i + lane; const f32x4 w0 = *(const GAS f32x4*)(wrG + (size_t)k * 8), w1 = *(const GAS f32x4*)(wrG + (size_t)k * 8 + 4);
            const float x = xa[i] * lnr[i], y = xb[i] * lnr[i];
            acca[0] += x * w0[0]; acca[1] += x * w0[1]; acca[2] += x * w0[2]; acca[3] += x * w0[3]; acca[4] += x * w1[0]; acca[5] += x * w1[1]; acca[6] += x * w1[2]; acca[7] += x * w1[3];
            accb[0] += y * w0[0]; accb[1] += y * w0[1]; accb[2] += y * w0[2]; accb[3] += y * w0[3]; accb[4] += y * w1[0]; accb[5] += y * w1[1]; accb[6] += y * w1[2]; accb[7] += y * w1[3]; }
#pragma unroll
        for (int e = 0; e < 8; ++e) { acca[e] = wave_sum(acca[e]) * rsa; accb[e] = wave_sum(accb[e]) * rsb; }
#pragma unroll
        for (int half = 0; half < 2; ++half) {
            if (half == 1 && !hasb) break;
            const int tt = half ? tb : t; float acc[8];
#pragma unroll
            for (int e = 0; e < 8; ++e) acc[e] = half ? accb[e] : acca[e];
            int e0 = 0; float l0 = acc[0];
#pragma unroll
            for (int e = 1; e < 8; ++e) if (acc[e] > l0) { l0 = acc[e]; e0 = e; }
            int e1 = -1; float l1 = -INFINITY;
#pragma unroll
            for (int e = 0; e < 8; ++e) if (e != e0 && acc[e] > l1) { l1 = acc[e]; e1 = e; }
            const float g1 = 1.0f / (1.0f + expf(l0 - l1)), g0 = 1.0f - g1;
            if (lane == 0) {
                const int r0 = __hip_atomic_fetch_add(rt + e0, 1, __ATOMIC_RELAXED, __HIP_MEMORY_SCOPE_WORKGROUP), r1 = __hip_atomic_fetch_add(rt + e1, 1, __ATOMIC_RELAXED, __HIP_MEMORY_SCOPE_WORKGROUP);
                tok_e[2 * tt] = e0; tok_e[2 * tt + 1] = e1; tok_r[2 * tt] = r0; tok_r[2 * tt + 1] = r1; tok_g[2 * tt] = g0; tok_g[2 * tt + 1] = g1;
            }
        }
    }
    __syncthreads();
    if (F.tid < 8) rt[8 + F.tid] = (int)__hip_atomic_fetch_add(gcount + F.tid, (unsigned)rt[F.tid], __ATOMIC_RELAXED, __HIP_MEMORY_SCOPE_AGENT);
    __syncthreads();
#pragma unroll 1
    for (int t = F.gw; t < S_; t += F.NGW) if (lane < 2) { const int e = tok_e[2 * t + lane]; tok_r[2 * t + lane] += rt[8 + e]; }
    __syncthreads();
}
__device__ __forceinline__ int moe_pstart(const unsigned* gcount, int e) {
    int ps = 0;
#pragma unroll
    for (int q = 0; q < 8; ++q) { const int c = (int)gcount[q]; if (q < e) ps += ((c + 255) >> 8) << 8; }
    return ps;
}
__device__ __forceinline__ void p_r2(const Frame& F, const Args& a, int L) {
    GAS unsigned char* ws = (GAS unsigned char*)a.ws; asm volatile("" : "+s"(ws)); int lane_ = F.lane; asm volatile("" : "+v"(lane_)); const int j = L >> 1, lane = lane_;
    const float* ssq = (const float*)(ws + WS_SSQA);
    const int* tok_e = (const int*)(ws + WS_TOK + TOK_E); const int* tok_r = (const int*)(ws + WS_TOK + TOK_R); const float* tok_g = (const float*)(ws + WS_TOK + TOK_G);
    int* dst = (int*)(ws + WS_TOK + TOK_DST); float* gpad = (float*)(ws + WS_TOK + TOK_GPAD);
    const unsigned* gcount = (const unsigned*)(ws + WS_CTL) + CW_CNT + 64 * j; bf16* XS = (bf16*)(ws + WS_ARENA + AR_XS);
    int pst[8]; { int ps = 0;
#pragma unroll
        for (int q = 0; q < 8; ++q) { pst[q] = ps; ps += (((int)gcount[q] + 255) >> 8) << 8; } }
    const GAS unsigned short* hB = (const GAS unsigned short*)(ws + WS_HBF);
#pragma unroll 1
    for (int t0 = F.gw; t0 < S_; t0 += 4 * F.NGW) {
        int tt[4], da[4], db[4]; float rs[4], ga[4], gb[4]; u32x2v v[4][4];
#pragma unroll
        for (int u = 0; u < 4; ++u) { const int t = t0 + u * F.NGW; tt[u] = t < S_ ? t : t0;
#pragma unroll
            for (int q = 0; q < 4; ++q) v[u][q] = *((const GAS u32x2v*)(hB + (size_t)tt[u] * D_) + 64 * q + lane); }
#pragma unroll
        for (int u = 0; u < 4; ++u) { const int t = tt[u]; rs[u] = pg8::rstd_row(ssq, t);
            const int ea = tok_e[2 * t], eb = tok_e[2 * t + 1]; int pa = 0, pb = 0;
#pragma unroll
            for (int q = 0; q < 8; ++q) { pa = (q == ea) ? pst[q] : pa; pb = (q == eb) ? pst[q] : pb; }
            da[u] = pa + tok_r[2 * t]; db[u] = pb + tok_r[2 * t + 1]; ga[u] = tok_g[2 * t]; gb[u] = tok_g[2 * t + 1]; }
#pragma unroll
        for (int u = 0; u < 4; ++u) { if (t0 + u * F.NGW >= S_) break; const int t = tt[u];
            if (lane == 0) { dst[2 * t] = da[u]; dst[2 * t + 1] = db[u]; gpad[da[u]] = ga[u]; gpad[db[u]] = gb[u]; }
#pragma unroll
            for (int q = 0; q < 4; ++q) { u32x2v o; o.x = cvtpk(bflo(v[u][q].x) * rs[u], bfhi(v[u][q].x) * rs[u]); o.y = cvtpk(bflo(v[u][q].y) * rs[u], bfhi(v[u][q].y) * rs[u]);
                *((GAS u32x2v*)(XS + (size_t)da[u] * D_) + 64 * q + lane) = o; *((GAS u32x2v*)(XS + (size_t)db[u] * D_) + 64 * q + lane) = o; } }
    }
}
__device__ __forceinline__ int moe_blocks(const Frame& F, const Args& a, int L) {
    const unsigned* gcount = (const unsigned*)(a.ws + WS_CTL) + CW_CNT + 64 * (L >> 1);
    LAS int* blk = (LAS int*)(F.lds + BLKE_OFF);
    int nb_tot = 0, mine = 7;
#pragma unroll
    for (int q = 0; q < 8; ++q) { const int nb = ((int)gcount[q] + 255) >> 8; if (F.tid >= nb_tot && F.tid < nb_tot + nb) mine = q; nb_tot += nb; }
    __syncthreads();
    if (F.tid < 160) blk[F.tid] = mine;
    __syncthreads();
    return nb_tot;
}
__device__ __forceinline__ void p_combine(const Frame& F, const Args& a) {
    GAS unsigned char* ws = (GAS unsigned char*)a.ws; asm volatile("" : "+s"(ws)); int lane_ = F.lane; asm volatile("" : "+v"(lane_)); const int lane = lane_;
    const int* dst = (const int*)(ws + WS_TOK + TOK_DST); const bf16* Y = (const bf16*)(ws + WS_ARENA + AR_Y); bf16* hb = (bf16*)(ws + WS_HBF); float* ssq = (float*)(ws + WS_SSQA);
#pragma unroll 1
    for (int t0 = F.gw; t0 < S_; t0 += 2 * F.NGW) {
        int tt[2], da[2], db[2]; u32x2v v[2][4]; u32x2v ya[2][4], yb[2][4];
#pragma unroll
        for (int u = 0; u < 2; ++u) { const int t = t0 + u * F.NGW; tt[u] = t < S_ ? t : t0; da[u] = dst[2 * tt[u]]; db[u] = dst[2 * tt[u] + 1];
#pragma unroll
            for (int q = 0; q < 4; ++q) v[u][q] = *((const GAS u32x2v*)(hb + (size_t)tt[u] * D_) + 64 * q + lane); }
#pragma unroll
        for (int u = 0; u < 2; ++u)
#pragma unroll
            for (int q = 0; q < 4; ++q) { ya[u][q] = *((const GAS u32x2v*)(Y + (size_t)da[u] * D_) + 64 * q + lane); yb[u][q] = *((const GAS u32x2v*)(Y + (size_t)db[u] * D_) + 64 * q + lane); }
#pragma unroll
        for (int u = 0; u < 2; ++u) { if (t0 + u * F.NGW >= S_) break; const int t = tt[u]; float ss = 0.f;
#pragma unroll
            for (int q = 0; q < 4; ++q) { f32x4 x = {bflo(v[u][q].x), bfhi(v[u][q].x), bflo(v[u][q].y), bfhi(v[u][q].y)};
                x[0] += bflo(ya[u][q].x) + bflo(yb[u][q].x); x[1] += bfhi(ya[u][q].x) + bfhi(yb[u][q].x); x[2] += bflo(ya[u][q].y) + bflo(yb[u][q].y); x[3] += bfhi(ya[u][q].y) + bfhi(yb[u][q].y);
                ss += (x[0] * x[0] + x[1] * x[1]) + (x[2] * x[2] + x[3] * x[3]);
                u32x2v o; o.x = cvtpk(x[0], x[1]); o.y = cvtpk(x[2], x[3]); *((GAS u32x2v*)(hb + (size_t)t * D_) + 64 * q + lane) = o; }
            ss = wave_sum(ss);
            if (lane < 16) ssq[(size_t)t * 16 + lane] = (lane == 0) ? ss : 0.f; }
    }
}
__device__ __forceinline__ void p_final(const Frame& F, const Args& a) {
    GAS unsigned char* ws = (GAS unsigned char*)a.ws; asm volatile("" : "+s"(ws)); int lane_ = F.lane; asm volatile("" : "+v"(lane_)); const int lane = lane_; const float* ssq = (const float*)(ws + WS_SSQB); const float* ln = (const float*)a.in[6]; const bf16* hb = (const bf16*)(ws + WS_HBF);
#pragma unroll 1
    for (int t = F.gw; t < S_; t += F.NGW) { const float rs = pg8::rstd_row(ssq, t);
#pragma unroll
        for (int q = 0; q < 4; ++q) { const u32x2v hv = *((const GAS u32x2v*)(hb + (size_t)t * D_) + 64 * q + lane); const f32x4 gq = *((const GAS f32x4*)ln + 64 * q + lane);
            const f32x4 x = {bflo(hv.x), bfhi(hv.x), bflo(hv.y), bfhi(hv.y)}; *((GAS f32x4*)(a.out + (size_t)t * D_) + 64 * q + lane) = x * rs * gq; } }
}
__device__ __forceinline__ void p_moe_weights(const Frame& F, const Args& a, int L, int w0, int nw, int part) {
    LAS float* scr = (LAS float*)(F.lds + F.wave * WAVE_LDS); (void)part;
    constexpr int IPM = (D_ / 64) * (DFF / 64), NI = 24 * IPM;
    XItem xc, xn;
    int gi = w0; if (gi >= NI) return;
    { const MatD m = moe_mat(a, L >> 1, gi / IPM); xpose_load(xc, m.W, m.ldw, m.N, gi % IPM, F.lane); }
#pragma unroll 1
    for (; gi < NI; gi += nw) {
        const int gn = gi + nw; const bool hasn = gn < NI;
        if (hasn) { const MatD mn = moe_mat(a, L >> 1, gn / IPM); xpose_load(xn, mn.W, mn.ldw, mn.N, gn % IPM, F.lane); }
        const MatD m = moe_mat(a, L >> 1, gi / IPM);
        xpose_finish(xc, m.K, m.N, m.gain, m.WT, m.ilv, scr, gi % IPM, F.lane);
        if (hasn) { _Pragma("unroll") for (int i = 0; i < 16; ++i) xc.v[i] = xn.v[i]; }
    }
}

constexpr int P_PRO = 0, P_FINAL = 81, LP_ROT = 16, LP_G1B = 17, LP_G2B = 18, LPN = 20, LP_PROJ = 0, LP_ATT = 1, LP_MIXPREP = 2, LP_GA = 3, LP_G1 = 4, LP_G2 = 5, LP_G3 = 6, LP_OUT = 7, LP_UP = 8, LP_DOWN = 9, LP_R1 = 10, LP_R2 = 11, LP_M1 = 12, LP_M2 = 13, LP_COMB = 14, LP_PLE = 15;

#ifndef PH_MASK
#define PH_MASK 0xffffffffull
#endif
#define IN(k) (lo <= (k) && (k) < hi)
#define INL(lp) ((((unsigned long long)(PH_MASK) >> (lp)) & 1) && lo <= pb + (lp) && pb + (lp) < hi)
#define SEAM() do { if (args.use_bar) xcd_barrier(bar); } while (0)
#ifndef REP_LP
#define REP_LP -1
#endif
#ifndef REP_L
#define REP_L -1
#endif
#ifndef REP_N
#define REP_N 2
#endif
#define REPS(lp) ((L == (REP_L) && (lp) == (REP_LP)) ? 1 + (REP_N) : 1)
#if REP_LP >= 0
#define REPLOOP(lp) _Pragma("unroll 1") for (int rep_ = 0; rep_ < REPS(lp); ++rep_)
#else
#define REPLOOP(lp)
#endif
#define PHASE_WS() GAS unsigned char* ws = (GAS unsigned char*)ws0; asm volatile("" : "+s"(ws)); bf16* HBF = (bf16*)(ws + WS_HBF); bf16* MIX = (bf16*)(ws + WS_MIX); bf16* PP = (bf16*)(ws + WS_PP); float* SSQA = (float*)(ws + WS_SSQA); float* SSQB = (float*)(ws + WS_SSQB); (void)HBF; (void)MIX; (void)PP; (void)SSQA; (void)SSQB
template <int L> __device__ __forceinline__ void run_layer(const Frame& F, const Args& args, unsigned char* lds, const XcdBarrier& bar, unsigned char* ws0, const int lo, const int hi, const int cid) {
        const int pb = 1 + LPN * L, j = L >> 1; const bool odd = (L & 1) != 0;
        REPLOOP(LP_PROJ) if (INL(LP_PROJ)) { PHASE_WS();
            if (!odd) {
                pg8::Gemm gm{HBF, (const bf16*)(ws + WS_WINE) + (size_t)j * EIN * D_, S_, EIN, D_, 0}; pg8::StaticOrder So; So.init(S_, EIN, F.G, cid);
                pg8::EpiBf16 E{(bf16*)(ws + WS_ARENA + AR_PE), EIN, SSQB, pg8::C2, 512};
                pg8::gemm_phase<pg8::EpiBf16, pg8::StaticOrder, true, true>(F.lds + RING_OFF, gm, So, E);
            } else {
                pg8::Gemm gm{HBF, (const bf16*)(ws + WS_WINO) + (size_t)j * OIN_ROWS * D_, S_, OIN, D_, 0}; pg8::StaticOrder So; So.init(S_, OIN, F.G, cid);
                pg8::EpiBf16 E{(bf16*)(ws + WS_ARENA + AR_PO), OIN, SSQB, 1.0f, 0};
                pg8::gemm_phase<pg8::EpiBf16, pg8::StaticOrder, true, true>(F.lds + RING_OFF, gm, So, E);
            }
            {
                pg8::Gemm gm{(const bf16*)(ws + WS_PBF) + (size_t)L * S_ * PLE, (const bf16*)(ws + WS_WP) + (size_t)L * D_ * PLE, S_, D_, PLE, 0}; pg8::StaticOrder So; So.init(S_, D_, F.G, cid);
                pg8::EpiBf16 E{PP, D_, nullptr, 1.0f, 0};
                pg8::gemm_phase<pg8::EpiBf16, pg8::StaticOrder, true, true>(F.lds + RING_OFF, gm, So, E);
            }
            if (odd) p_ab(F, args, L);
            if (!odd) { pg8::StaticOrder Sr; Sr.init(S_, EIN, F.G, cid); p_rot_tiles(F, args, Sr); }
            SEAM();
        }
        if (!odd) {
            REPLOOP(LP_ATT) if (INL(LP_ATT)) { PHASE_WS(); attn_body::attn_phase<8>((char*)lds + RING_OFF, (const attn_body::bf16*)(ws + WS_ARENA + AR_PE), (attn_body::bf16*)(ws + WS_ARENA + AR_AO), F.vcu, F.G); SEAM(); }
            REPLOOP(LP_MIXPREP) if (INL(LP_MIXPREP)) { PHASE_WS(); p_mixprep(F, args, L); SEAM(); }
        } else {
            REPLOOP(LP_GA) if (INL(LP_GA)) { PHASE_WS();
#ifdef PROBE_GSEL
                const int gsel = args.use_bar ? 7 : PROBE_GSEL;
#else
                const int gsel = 7;
#endif
                if (gsel & 1) p_ga(F, args, L); asm volatile("s_waitcnt vmcnt(0)" ::: "memory"); __syncthreads(); if (gsel & 2) p_g1(F, args); asm volatile("s_waitcnt vmcnt(0)" ::: "memory"); __syncthreads(); if (gsel & 4) p_g1b(F, args); SEAM(); }
            REPLOOP(LP_G2) if (INL(LP_G2)) { PHASE_WS();
                const bool spread = (F.G == 256); const int nscan = F.G < 64 ? F.G : 64;
                const bool is_scan = spread ? ((F.vcu & 31) < 8) : (F.vcu < nscan);
                const int scan_id = spread ? ((F.vcu >> 5) * 8 + (F.vcu & 7)) : F.vcu;
                const int conv_id = spread ? ((F.vcu >> 5) * 24 + ((F.vcu & 31) - 8)) : (F.vcu - nscan);
                if (is_scan) p_g2<64, 4>(F, args, (const bf16*)(ws + WS_ARENA + AR_MPC), (const bf16*)(ws + WS_ARENA + AR_NTC), (const float*)(ws + WS_TOK + TOK_DNC), scan_id);
                else p_moe_weights(F, args, L, conv_id * NWAVES + F.wave, (F.G - nscan) * NWAVES, -1);
                if (F.G <= 64) p_moe_weights(F, args, L, F.gw, F.NGW, -1);
                SEAM();
            }
            REPLOOP(LP_G3) if (INL(LP_G3)) { PHASE_WS(); p_g23(F, args, L); SEAM(); }
        }
        REPLOOP(LP_OUT) if (INL(LP_OUT)) { PHASE_WS();
            const bf16* Wo = odd ? (const bf16*)(ws + WS_WOUTO) + (size_t)j * D_ * D_ : (const bf16*)(ws + WS_WOUTE) + (size_t)j * D_ * D_;
            pg8::Gemm gm{MIX, Wo, S_, D_, D_, 0}; pg8::StaticOrder So; So.init(S_, D_, F.G, cid);
            pg8::EpiResid E{HBF, SSQA};
            pg8::gemm_phase<pg8::EpiResid, pg8::StaticOrder, true, true>(F.lds + RING_OFF, gm, So, E);
            SEAM();
        }
        if (!odd) {
            REPLOOP(LP_UP) if (INL(LP_UP)) { PHASE_WS();
                pg8::Gemm gm{HBF, (const bf16*)(ws + WS_W13D) + (size_t)j * 2 * DFF * D_, S_, 2 * DFF, D_, 0}; pg8::StaticOrder So; So.init(S_, 2 * DFF, F.G, cid);
                pg8::EpiSwiglu E{(bf16*)(ws + WS_ARENA + AR_ACT), SSQA};
                pg8::gemm_phase<pg8::EpiSwiglu, pg8::StaticOrder, true, true>(F.lds + RING_OFF, gm, So, E);
                SEAM();
            }
            REPLOOP(LP_DOWN) if (INL(LP_DOWN)) { PHASE_WS();
                pg8::Gemm gm{(const bf16*)(ws + WS_ARENA + AR_ACT), (const bf16*)(ws + WS_W2D) + (size_t)j * D_ * DFF, S_, D_, DFF, 0}; pg8::StaticOrder So; So.init(S_, D_, F.G, cid);
                pg8::EpiResid E{HBF, SSQA};
                pg8::gemm_phase<pg8::EpiResid, pg8::StaticOrder, true, true>(F.lds + RING_OFF, gm, So, E);
                SEAM();
            }
        } else {
            REPLOOP(LP_R1) if (INL(LP_R1)) { PHASE_WS(); p_r1(F, args, L); SEAM(); }
            REPLOOP(LP_R2) if (INL(LP_R2)) { PHASE_WS(); p_r2(F, args, L); SEAM(); }
            REPLOOP(LP_M1) if (INL(LP_M1)) { PHASE_WS();
                const int nb = moe_blocks(F, args, L);
                pg8::Gemm gm{(const bf16*)(ws + WS_ARENA + AR_XS), (const bf16*)(ws + WS_W13M), nb * 256, 2 * DFF, D_, (size_t)2 * DFF * D_ * 2}; pg8::MoeOrder So; So.init(nb * 256, 2 * DFF, F.G, cid); So.blk_e = (const LAS int*)(F.lds + BLKE_OFF);
                pg8::EpiSwiglu E{(bf16*)(ws + WS_ARENA + AR_ACT), nullptr};
                pg8::gemm_phase<pg8::EpiSwiglu, pg8::MoeOrder, true, true>(F.lds + RING_OFF, gm, So, E);
                SEAM();
            }
            REPLOOP(LP_M2) if (INL(LP_M2)) { PHASE_WS();
                const int nb = moe_blocks(F, args, L);
                pg8::Gemm gm{(const bf16*)(ws + WS_ARENA + AR_ACT), (const bf16*)(ws + WS_W2M), nb * 256, D_, DFF, (size_t)D_ * DFF * 2}; pg8::MoeOrder So; So.init(nb * 256, D_, F.G, cid); So.blk_e = (const LAS int*)(F.lds + BLKE_OFF);
                pg8::EpiMoeDown E{(bf16*)(ws + WS_ARENA + AR_Y), (const float*)(ws + WS_TOK + TOK_GPAD)};
                pg8::gemm_phase<pg8::EpiMoeDown, pg8::MoeOrder, true, true>(F.lds + RING_OFF, gm, So, E);
                SEAM();
            }
            REPLOOP(LP_COMB) if (INL(LP_COMB)) { PHASE_WS(); p_combine(F, args); SEAM(); }
        }
        REPLOOP(LP_PLE) if (INL(LP_PLE)) { PHASE_WS();
            pg8::Gemm gm{HBF, (const bf16*)(ws + WS_WG) + (size_t)L * D_ * D_, S_, D_, D_, 0}; pg8::StaticOrder So; So.init(S_, D_, F.G, cid);
            pg8::EpiPle E{HBF, SSQA, SSQB, PP};
            pg8::gemm_phase<pg8::EpiPle, pg8::StaticOrder, true, true>(F.lds + RING_OFF, gm, So, E);
            SEAM();
        }
    }

__global__ void __launch_bounds__(NWAVES * 64, 2) fwd(Args args) {
    extern __shared__ __attribute__((aligned(16))) unsigned char lds[];
    Frame F;
    F.lds = (LAS unsigned char*)lds; F.tid = threadIdx.x; F.lane = F.tid & 63; F.wave = __builtin_amdgcn_readfirstlane(F.tid >> 6);
    F.G = gridDim.x; { const int bx = blockIdx.x; F.vcu = (F.G % 8 == 0) ? (bx % 8) * (F.G / 8) + bx / 8 : bx; }
    F.gw = F.vcu * NWAVES + F.wave; F.NGW = F.G * NWAVES;
    unsigned char* ws0 = args.ws;
    for (int u = F.tid; u < (LDS_BYTES - LDSCTL_OFF) / 4; u += NWAVES * 64) ((LAS unsigned*)(F.lds + LDSCTL_OFF))[u] = 0u;
    __syncthreads();
    XcdBarrier bar; bar.bar = (unsigned*)(ws0 + WS_CTL) + CW_BAR; bar.x = 0; bar.st = nullptr;
    if (args.use_bar) bar = xcd_barrier_post((unsigned*)(ws0 + WS_CTL) + CW_BAR, (volatile LAS unsigned*)(F.lds + MISC_OFF));
    const int lo = args.ph_lo, hi = args.ph_hi;
    const int cid = (int)blockIdx.x;

    if ((((unsigned long long)(PH_MASK) >> 30) & 1) && IN(P_PRO)) { p_prologue(F, args); SEAM(); }

#ifdef FIXED_L
    run_layer<FIXED_L>(F, args, lds, bar, ws0, lo, hi, cid);
#else
    run_layer<0>(F, args, lds, bar, ws0, lo, hi, cid); run_layer<1>(F, args, lds, bar, ws0, lo, hi, cid); run_layer<2>(F, args, lds, bar, ws0, lo, hi, cid); run_layer<3>(F, args, lds, bar, ws0, lo, hi, cid);
#endif
    if ((((unsigned long long)(PH_MASK) >> 31) & 1) && IN(P_FINAL)) p_final(F, args);
#undef IN
#undef INL
#undef SEAM
}


#ifndef DBG
#define DBG 0
#endif
#if DBG
#ifndef DBG_ASLOT
#define DBG_ASLOT 9
#endif
#ifndef DBG_BSLOT
#define DBG_BSLOT 11
#endif
__global__ void dbg_scan(const void* p, size_t n, int is_f32, unsigned* slot) {
    unsigned cnt = 0;
    for (size_t i = (size_t)blockIdx.x * blockDim.x + threadIdx.x; i < n; i += (size_t)gridDim.x * blockDim.x) {
        const float v = is_f32 ? ((const float*)p)[i] : __uint_as_float(((unsigned)((const unsigned short*)p)[i]) << 16);
        if (!(fabsf(v) < 1e30f)) ++cnt; }
    if (cnt) atomicAdd(slot, cnt);
}
__global__ void dbg_fill(float* out, size_t n, const unsigned* slots, int nslots) {
    int first = -1; for (int i = 0; i < nslots; ++i) if (slots[i]) { first = i; break; }
    float c, V;
    if (first >= 0) { c = sqrtf((float)(10 + first) * 1e6f); V = c; }
    else { const float ea = fmaxf(__uint_as_float(slots[256 + DBG_ASLOT]), 1e-5f), eb = fmaxf(__uint_as_float(slots[256 + DBG_BSLOT]), 1e-5f);
        c = sqrtf((10.f + fminf(60.f, rintf(10.f * (log10f(ea) + 5.f)))) * 1e4f); V = (50.f + rintf(10.f * log10f(eb))) * 1e3f; }
    for (size_t i = (size_t)blockIdx.x * blockDim.x + threadIdx.x; i < n; i += (size_t)gridDim.x * blockDim.x) out[i] = (i == 0) ? V : c;
}
__device__ __forceinline__ float dbg_bf(const unsigned short* p, size_t i) { return __uint_as_float(((unsigned)p[i]) << 16); }
__device__ __forceinline__ float dbg_rstd(const float* ssq, int row) { float s = 0.f; for (int i = 0; i < 16; ++i) s += ssq[(size_t)row * 16 + i]; return 1.0f / sqrtf(s / 1024.0f + 1e-6f); }
__device__ __forceinline__ float dbg_blocksum(float v, float* red) {
    __syncthreads(); red[threadIdx.x] = v; __syncthreads();
    for (int o = 128; o > 0; o >>= 1) { if ((int)threadIdx.x < o) red[threadIdx.x] += red[threadIdx.x + o]; __syncthreads(); }
    const float r = red[0]; __syncthreads(); return r;
}
__device__ __forceinline__ void dbg_report(unsigned* slot, float num, float den) { if (threadIdx.x == 0) atomicMax(slot, __float_as_uint(sqrtf(num / fmaxf(den, 1e-20f)))); }
__global__ void chk_ffn(const float* hpre, const float* hpost, const float* ssq, const float* ln, const float* wr, const float* w1, const float* w3, const float* w2, int moe, unsigned* slot) {
    __shared__ float xn[1024]; __shared__ float hid[3584]; __shared__ float red[256]; __shared__ float lg[8];
    const int t = (blockIdx.x * 997 + 13) % S_, tid = threadIdx.x;
    const float rs = dbg_rstd(ssq, t);
    for (int k = tid; k < 1024; k += 256) xn[k] = hpre[(size_t)t * 1024 + k] * rs * ln[k];
    __syncthreads();
    int e0 = 0, e1 = 0; float g0 = 1.f, g1 = 0.f;
    if (moe) {
        if (tid < 8) { float s = 0.f; for (int k = 0; k < 1024; ++k) s += xn[k] * wr[(size_t)k * 8 + tid]; lg[tid] = s; }
        __syncthreads();
        float l0 = lg[0]; for (int e = 1; e < 8; ++e) if (lg[e] > l0) { l0 = lg[e]; e0 = e; }
        float l1 = -1e30f; e1 = -1; for (int e = 0; e < 8; ++e) if (e != e0 && lg[e] > l1) { l1 = lg[e]; e1 = e; }
        const float m0 = expf(l0 - l0), m1 = expf(l1 - l0); g0 = m0 / (m0 + m1); g1 = m1 / (m0 + m1);
    }
    float acc[4] = {0.f, 0.f, 0.f, 0.f};
    for (int pass = 0; pass < (moe ? 2 : 1); ++pass) {
        const int e = pass == 0 ? e0 : e1; const float gt = pass == 0 ? g0 : g1;
        const float* W1 = w1 + (size_t)e * 1024 * 3584; const float* W3 = w3 + (size_t)e * 1024 * 3584; const float* W2 = w2 + (size_t)e * 3584 * 1024;
        __syncthreads();
        for (int f = tid; f < 3584; f += 256) { float a = 0.f, b = 0.f; for (int k = 0; k < 1024; ++k) { a += xn[k] * W1[(size_t)k * 3584 + f]; b += xn[k] * W3[(size_t)k * 3584 + f]; } hid[f] = a / (1.f + expf(-a)) * b; }
        __syncthreads();
        for (int q = 0; q < 4; ++q) { const int c = tid + 256 * q; float y = 0.f; for (int f = 0; f < 3584; ++f) y += hid[f] * W2[(size_t)f * 1024 + c]; acc[q] += gt * y; }
    }
    float num = 0.f, den = 0.f;
    for (int q = 0; q < 4; ++q) { const int c = tid + 256 * q; const float ex = acc[q], got = hpost[(size_t)t * 1024 + c] - hpre[(size_t)t * 1024 + c]; num += (got - ex) * (got - ex); den += ex * ex; }
    num = dbg_blocksum(num, red); den = dbg_blocksum(den, red);
    dbg_report(slot, num, den);
}
__global__ void chk_ple(const float* hpre, const float* hpost, const float* ssq, const float* ln, const float* wg, const float* p, const float* wp, unsigned* slot) {
    __shared__ float xn[1024]; __shared__ float red[256];
    const int t = (blockIdx.x * 997 + 13) % S_, tid = threadIdx.x; const float rs = dbg_rstd(ssq, t);
    for (int k = tid; k < 1024; k += 256) xn[k] = hpre[(size_t)t * 1024 + k] * rs * ln[k];
    __syncthreads();
    float num = 0.f, den = 0.f;
    for (int q = 0; q < 4; ++q) { const int c = tid + 256 * q; float a = 0.f, b = 0.f; for (int k = 0; k < 1024; ++k) a += xn[k] * wg[(size_t)k * 1024 + c]; for (int k = 0; k < 256; ++k) b += p[(size_t)t * 256 + k] * wp[(size_t)k * 1024 + c];
        const float ex = b / (1.f + expf(-a)), got = hpost[(size_t)t * 1024 + c] - hpre[(size_t)t * 1024 + c]; num += (got - ex) * (got - ex); den += ex * ex; }
    num = dbg_blocksum(num, red); den = dbg_blocksum(den, red); dbg_report(slot, num, den);
}
constexpr int DBG_TC = 512;
__global__ void chk_gdn_proj(const float* h, const float* ssq, const float* ln, const float* W, int hh, float* raw) {
    const int idx = blockIdx.x * blockDim.x + threadIdx.x; if (idx >= DBG_TC * 514) return;
    const int t = idx / 514, c = idx % 514;
    const int col = c < 128 ? hh * 128 + c : c < 256 ? 1024 + hh * 128 + (c - 128) : c < 384 ? 2048 + hh * 128 + (c - 256) : c < 512 ? 3072 + hh * 128 + (c - 384) : c == 512 ? 4096 + hh : 4104 + hh;
    const float rs = dbg_rstd(ssq, t); float s = 0.f;
    for (int k = 0; k < 1024; ++k) s += h[(size_t)t * 1024 + k] * ln[k] * W[(size_t)k * OIN_SRC + col];
    raw[(size_t)t * 514 + c] = s * rs;
}
__global__ void chk_gdn_rec(const float* raw, const float* cw, const float* alog, const float* dtb, const float* onorm, int hh, const unsigned short* mix, unsigned* slot) {
    extern __shared__ float sm[];
    float* Sm = sm; float* q = sm + 128 * 129; float* kk = q + 128; float* v = kk + 128; float* kv = v + 128; float* dl = kv + 128; float* o = dl + 128; float* red = o + 128;
    const int tid = threadIdx.x;
    for (int i = tid; i < 128 * 129; i += 256) Sm[i] = 0.f;
    __syncthreads();
    float worst = 0.f;
    for (int t = 0; t < DBG_TC; ++t) {
        if (tid < 128) { const int d = tid; float aq = 0.f, ak = 0.f, av = 0.f;
            for (int jj = 0; jj < 4; ++jj) { const int r = t - 3 + jj; if (r >= 0) { aq += cw[jj * 3072 + hh * 128 + d] * raw[(size_t)r * 514 + d]; ak += cw[jj * 3072 + 1024 + hh * 128 + d] * raw[(size_t)r * 514 + 128 + d]; av += cw[jj * 3072 + 2048 + hh * 128 + d] * raw[(size_t)r * 514 + 256 + d]; } }
            q[d] = aq / (1.f + expf(-aq)); kk[d] = ak / (1.f + expf(-ak)); v[d] = av / (1.f + expf(-av)); }
        __syncthreads();
        const float sq = dbg_blocksum(tid < 128 ? q[tid] * q[tid] : 0.f, red), sk = dbg_blocksum(tid < 128 ? kk[tid] * kk[tid] : 0.f, red);
        if (tid < 128) { q[tid] *= 1.0f / sqrtf(sq + 1e-6f) * 0.08838834764831845f; kk[tid] *= 1.0f / sqrtf(sk + 1e-6f); }
        const float bb = raw[(size_t)t * 514 + 512], aa = raw[(size_t)t * 514 + 513];
        const float beta = 1.f / (1.f + expf(-bb)); const float z = aa + dtb[hh]; const float g = -expf(alog[hh]) * (z > 20.f ? z : log1pf(expf(z))); const float alpha = expf(g);
        __syncthreads();
        for (int i = tid; i < 128 * 128; i += 256) { const int d = i >> 7, j = i & 127; Sm[d * 129 + j] *= alpha; }
        __syncthreads();
        if (tid < 128) { float s = 0.f; for (int d = 0; d < 128; ++d) s += kk[d] * Sm[d * 129 + tid]; dl[tid] = beta * (v[tid] - s); }
        __syncthreads();
        for (int i = tid; i < 128 * 128; i += 256) { const int d = i >> 7, j = i & 127; Sm[d * 129 + j] += kk[d] * dl[j]; }
        __syncthreads();
        if (tid < 128) { float s = 0.f; for (int d = 0; d < 128; ++d) s += q[d] * Sm[d * 129 + tid]; o[tid] = s; }
        __syncthreads();
        const float so = dbg_blocksum(tid < 128 ? o[tid] * o[tid] : 0.f, red); const float rms = 1.0f / sqrtf(so / 128.f + 1e-6f);
        float num = 0.f, den = 0.f;
        if (tid < 128) { const float zz = raw[(size_t)t * 514 + 384 + tid]; const float ex = o[tid] * rms * onorm[tid] * (zz / (1.f + expf(-zz))); const float got = dbg_bf(mix, (size_t)t * 1024 + hh * 128 + tid); num = (got - ex) * (got - ex); den = ex * ex; }
        num = dbg_blocksum(num, red); den = dbg_blocksum(den, red);
        worst = fmaxf(worst, sqrtf(num / fmaxf(den, 1e-20f)));
    }
    if (tid == 0) atomicMax(slot, __float_as_uint(worst));
}

__global__ void chk_even_kv(const float* h, const float* ssq, const float* ln, const float* W, float* KV) {
    const size_t idx = (size_t)blockIdx.x * blockDim.x + threadIdx.x; if (idx >= (size_t)S_ * 1024) return;
    const int t = (int)(idx >> 10), c = (int)(idx & 1023); const float rs = dbg_rstd(ssq, t); float s = 0.f;
    for (int k = 0; k < 1024; ++k) s += h[(size_t)t * 1024 + k] * ln[k] * W[(size_t)k * EIN + 512 + c];
    KV[idx] = s * rs;
}
__global__ void chk_even_mix(const float* h, const float* ssq, const float* ln, const float* W, const float* KV, const int* pos, const float* lq1, const float* lk1, const float* lq2, const float* lk2, const float* subg, const float* cw,
                             float lam0, const unsigned short* PE, const unsigned short* AO, const unsigned short* MIXb, unsigned* slot) {
    __shared__ float q[2][64]; __shared__ float p[128]; __shared__ float red[256]; __shared__ float o2[2][128]; __shared__ float hn[1024];
    const int toks[6] = {5, 200, 1000, 4097, 9000, 16383};
    const int t = toks[blockIdx.x / 4], hh = blockIdx.x % 4, tid = threadIdx.x;
    auto bsum = [&](float v) { __syncthreads(); red[tid] = v; __syncthreads(); for (int o = 64; o > 0; o >>= 1) { if (tid < o) red[tid] += red[tid + o]; __syncthreads(); } const float r = red[0]; __syncthreads(); return r; };
    auto bmax = [&](float v) { __syncthreads(); red[tid] = v; __syncthreads(); for (int o = 64; o > 0; o >>= 1) { if (tid < o) red[tid] = fmaxf(red[tid], red[tid + o]); __syncthreads(); } const float r = red[0]; __syncthreads(); return r; };
    auto invf = [&](int i) { return exp2f(-(float)i * (18.931568569324174f / 8.0f)); };
    const float rs = dbg_rstd(ssq, t);
    for (int k = tid; k < 1024; k += 128) hn[k] = h[(size_t)t * 1024 + k] * rs * ln[k];
    __syncthreads();
    { const int m = tid >> 6, d = tid & 63, col = (2 * hh + m) * 64 + d; float s = 0.f; for (int k = 0; k < 1024; ++k) s += hn[k] * W[(size_t)k * EIN + col]; q[m][d] = s; }
    __syncthreads();
    float qr;
    { const int m = tid >> 6, d = tid & 63; float v = q[m][d];
      if (d < 16) { const int i = d & 7; const float ang = (float)pos[t] * invf(i); const float c = cosf(ang), s = sinf(ang); v = d < 8 ? q[m][d] * c - q[m][d + 8] * s : q[m][d] * c + q[m][d - 8] * s; }
      qr = v * pg8::C2; }
    __syncthreads(); q[tid >> 6][tid & 63] = qr; __syncthreads();
    float num = 0.f, den = 0.f;
    { const int m = tid >> 6, d = tid & 63; const float got = dbg_bf(PE, (size_t)t * EIN + (2 * hh + m) * 64 + d); const float e2 = (got - qr) * (got - qr), r2 = qr * qr; num += e2; den += r2;
      const float na = bsum(d >= 16 ? e2 : 0.f), da = bsum(d >= 16 ? r2 : 0.f), nb = bsum(d < 16 ? e2 : 0.f), db = bsum(d < 16 ? r2 : 0.f);
      if (tid == 0) { atomicMax(slot + 4, __float_as_uint(sqrtf(na / fmaxf(da, 1e-20f)))); atomicMax(slot + 5, __float_as_uint(sqrtf(nb / fmaxf(db, 1e-20f)))); } }
    { const int m = tid >> 6, d = tid & 63; const float* kr = KV + (size_t)t * 1024 + (2 * hh + m) * 64; float v = kr[d];
      if (d < 16) { const int i = d & 7; const float ang = (float)pos[t] * invf(i); const float c = cosf(ang), s = sinf(ang); v = d < 8 ? kr[d] * c - kr[d + 8] * s : kr[d] * c + kr[d - 8] * s; }
      const float got = dbg_bf(PE, (size_t)t * EIN + 512 + (2 * hh + m) * 64 + d); const float e2 = (got - v) * (got - v), r2 = v * v; num += e2; den += r2;
      const float na = bsum(d >= 16 ? e2 : 0.f), da = bsum(d >= 16 ? r2 : 0.f), nb = bsum(d < 16 ? e2 : 0.f), db = bsum(d < 16 ? r2 : 0.f);
      const float vv = KV[(size_t)t * 1024 + 512 + hh * 128 + tid], gv = dbg_bf(PE, (size_t)t * EIN + 1024 + hh * 128 + tid); const float e3 = (gv - vv) * (gv - vv), r3 = vv * vv; num += e3; den += r3;
      const float nc = bsum(e3), dc = bsum(r3);
      if (tid == 0) { atomicMax(slot + 6, __float_as_uint(sqrtf(na / fmaxf(da, 1e-20f)))); atomicMax(slot + 7, __float_as_uint(sqrtf(nb / fmaxf(db, 1e-20f)))); atomicMax(slot + 8, __float_as_uint(sqrtf(nc / fmaxf(dc, 1e-20f)))); } }
    num = bsum(num); den = bsum(den); if (tid == 0) atomicMax(slot + 0, __float_as_uint(sqrtf(num / fmaxf(den, 1e-20f))));
    for (int m = 0; m < 2; ++m) {
        float mx = -1e30f;
        for (int j0 = 0; j0 <= t; j0 += 128) { const int j = j0 + tid; float s = -1e30f;
            if (j <= t) { const float* kr = KV + (size_t)j * 1024 + (2 * hh + m) * 64; s = 0.f;
                for (int d = 0; d < 64; ++d) { float kv = kr[d]; if (d < 16) { const int i = d & 7; const float ang = (float)pos[j] * invf(i); const float c = cosf(ang), sn = sinf(ang); kv = d < 8 ? kr[d] * c - kr[d + 8] * sn : kr[d] * c + kr[d - 8] * sn; } s += q[m][d] * kv; } }
            mx = fmaxf(mx, s); }
        mx = bmax(mx);
        float l = 0.f, acc = 0.f;
        for (int j0 = 0; j0 <= t; j0 += 128) { const int j = j0 + tid; float pe = 0.f;
            if (j <= t) { const float* kr = KV + (size_t)j * 1024 + (2 * hh + m) * 64; float s = 0.f;
                for (int d = 0; d < 64; ++d) { float kv = kr[d]; if (d < 16) { const int i = d & 7; const float ang = (float)pos[j] * invf(i); const float c = cosf(ang), sn = sinf(ang); kv = d < 8 ? kr[d] * c - kr[d + 8] * sn : kr[d] * c + kr[d - 8] * sn; } s += q[m][d] * kv; }
                pe = exp2f(s - mx); }
            __syncthreads(); p[tid] = pe; __syncthreads();
            l += pe;
            const int nj = min(128, t + 1 - j0);
            for (int i = 0; i < nj; ++i) acc += p[i] * KV[(size_t)(j0 + i) * 1024 + 512 + hh * 128 + tid]; }
        l = bsum(l);
        o2[m][tid] = acc / l;
    }
    __syncthreads();
    { float n2 = 0.f, d2 = 0.f;
      for (int m = 0; m < 2; ++m) { const float ex = o2[m][tid], got = dbg_bf(AO, (size_t)t * 1024 + hh * 256 + m * 128 + tid); n2 += (got - ex) * (got - ex); d2 += ex * ex; }
      n2 = bsum(n2); d2 = bsum(d2); if (tid == 0) atomicMax(slot + 1, __float_as_uint(sqrtf(n2 / fmaxf(d2, 1e-20f)))); }
    float s1 = 0.f, s2 = 0.f; for (int i = 0; i < 64; ++i) { s1 += lq1[i] * lk1[i]; s2 += lq2[i] * lk2[i]; }
    const float lam = expf(s1) - expf(s2) + lam0;
    const float dv = o2[0][tid] - lam * o2[1][tid]; const float ssd = bsum(dv * dv); const float ex = dv / sqrtf(ssd / 128.f + 1e-5f) * subg[tid] * (1.f - lam0);
    { const float got = dbg_bf(MIXb, (size_t)t * 1024 + hh * 128 + tid); float n2 = (got - ex) * (got - ex), d2 = ex * ex; n2 = bsum(n2); d2 = bsum(d2); if (tid == 0) atomicMax(slot + 2, __float_as_uint(sqrtf(n2 / fmaxf(d2, 1e-20f)))); }
    { const int ch = hh * 128 + tid; float cx[3] = {0.f, 0.f, 0.f}, bg = 0.f;
      for (int jj = 0; jj < 3; ++jj) { const int r = t - 2 + jj; if (r < 0) continue; const float rr = dbg_rstd(ssq, r); float c = 0.f, x = 0.f, b = 0.f;
          for (int k = 0; k < 1024; ++k) { const float hv = h[(size_t)r * 1024 + k] * ln[k]; c += hv * W[(size_t)k * EIN + 2048 + ch]; x += hv * W[(size_t)k * EIN + 2560 + ch]; if (jj == 2) b += hv * W[(size_t)k * EIN + 1536 + ch]; }
          cx[jj] = (c * rr) * (x * rr); if (jj == 2) bg = b * rr; }
      const float ex2 = bg * (cw[0 * 512 + ch] * cx[0] + cw[1 * 512 + ch] * cx[1] + cw[2 * 512 + ch] * cx[2]); const float got = dbg_bf(MIXb, (size_t)t * 1024 + 512 + ch);
      float n2 = (got - ex2) * (got - ex2), d2 = ex2 * ex2; n2 = bsum(n2); d2 = bsum(d2); if (tid == 0) atomicMax(slot + 3, __float_as_uint(sqrtf(n2 / fmaxf(d2, 1e-20f)))); }
}
static void dbg_before_phase(int ph, unsigned char* ws, float* out, hipStream_t st) {
    if (ph == P_PRO || ph == P_FINAL) return;
    const int lp = (ph - 1) % LPN;
    if (lp == LP_UP || lp == LP_R1 || lp == LP_PLE) { (void)hipMemcpyAsync(ws + WS_ARENA + 400 * MiB, out, (size_t)S_ * D_ * 4, hipMemcpyDeviceToDevice, st); (void)hipMemcpyAsync(ws + WS_ARENA + 464 * MiB, ws + WS_SSQA, (size_t)S_ * 16 * 4, hipMemcpyDeviceToDevice, st); }
}
static void dbg_checks(int ph, void* const* d_in, unsigned char* ws, float* out, hipStream_t st) {
    if (ph == P_PRO || ph == P_FINAL) return;
    unsigned* slots = (unsigned*)(ws + WS_CTL) + CW_DBG; const int L = (ph - 1) / LPN, lp = (ph - 1) % LPN, j = L >> 1; const bool odd = L & 1;
    const float* snap = (const float*)(ws + WS_ARENA + 400 * MiB);
    if (lp == LP_DOWN && L == 0) hipLaunchKernelGGL(chk_ffn, dim3(24), dim3(256), 0, st, snap, (const float*)out, (const float*)(ws + WS_ARENA + 464 * MiB), (const float*)d_in[4] + L * D_, (const float*)nullptr,
        (const float*)d_in[21] + (size_t)j * D_ * DFF, (const float*)d_in[22] + (size_t)j * D_ * DFF, (const float*)d_in[23] + (size_t)j * D_ * DFF, 0, slots + 256 + 0);
    if (lp == LP_PLE && L == 0) hipLaunchKernelGGL(chk_ple, dim3(24), dim3(256), 0, st, snap, (const float*)out, (const float*)(ws + WS_ARENA + 464 * MiB), (const float*)d_in[5] + L * D_, (const float*)d_in[28] + (size_t)L * D_ * D_,
        (const float*)d_in[1] + (size_t)L * S_ * PLE, (const float*)d_in[29] + (size_t)L * PLE * D_, slots + 256 + 1);
    if (lp == LP_G3 && L == 1) { float* raw = (float*)(ws + WS_ARENA + 400 * MiB);
        hipLaunchKernelGGL(chk_gdn_proj, dim3((DBG_TC * 514 + 255) / 256), dim3(256), 0, st, (const float*)out, (const float*)(ws + WS_SSQB), (const float*)d_in[3] + L * D_, (const float*)d_in[15] + (size_t)j * D_ * OIN_SRC, 3, raw);
        hipLaunchKernelGGL(chk_gdn_rec, dim3(1), dim3(256), (128 * 129 + 6 * 128 + 256) * 4, st, (const float*)raw, (const float*)d_in[16] + (size_t)j * 4 * 3072, (const float*)d_in[17] + j * 8, (const float*)d_in[18] + j * 8, (const float*)d_in[19] + j * 128, 3, (const unsigned short*)(ws + WS_MIX), slots + 256 + 2); }
    if (lp == LP_COMB && L == 1) hipLaunchKernelGGL(chk_ffn, dim3(24), dim3(256), 0, st, snap, (const float*)out, (const float*)(ws + WS_ARENA + 464 * MiB), (const float*)d_in[4] + L * D_, (const float*)d_in[24] + (size_t)j * D_ * NEXP,
        (const float*)d_in[25] + (size_t)j * NEXP * D_ * DFF, (const float*)d_in[26] + (size_t)j * NEXP * D_ * DFF, (const float*)d_in[27] + (size_t)j * NEXP * DFF * D_, 1, slots + 256 + 3);
    if (lp == LP_MIXPREP && L == 0) { float* KV = (float*)(ws + WS_ARENA + 400 * MiB);
        hipLaunchKernelGGL(chk_even_kv, dim3((S_ * 1024) / 256), dim3(256), 0, st, (const float*)out, (const float*)(ws + WS_SSQB), (const float*)d_in[3] + L * D_, (const float*)d_in[7] + (size_t)j * D_ * EIN, KV);
        hipLaunchKernelGGL(chk_even_mix, dim3(24), dim3(128), 0, st, (const float*)out, (const float*)(ws + WS_SSQB), (const float*)d_in[3] + L * D_, (const float*)d_in[7] + (size_t)j * D_ * EIN, (const float*)KV, (const int*)d_in[2],
            (const float*)d_in[9] + j * 64, (const float*)d_in[10] + j * 64, (const float*)d_in[11] + j * 64, (const float*)d_in[12] + j * 64, (const float*)d_in[13] + j * 128, (const float*)d_in[14] + (size_t)j * 3 * 512,
            0.8f - 0.6f * expf(-0.3f * (float)L), (const unsigned short*)(ws + WS_ARENA + AR_PE), (const unsigned short*)(ws + WS_ARENA + AR_AO), (const unsigned short*)(ws + WS_MIX), slots + 256 + 4); }
    (void)odd;
}
static void dbg_after_phase(int ph, unsigned char* ws, float* out, hipStream_t st) {
    unsigned* slots = (unsigned*)(ws + WS_CTL) + CW_DBG; unsigned* sl = slots + ph;
    auto scan = [&](const void* p, size_t n, int f32) { hipLaunchKernelGGL(dbg_scan, dim3(1024), dim3(256), 0, st, p, n, f32, sl); };
    const size_t SD = (size_t)S_ * D_; unsigned char* ar = ws + WS_ARENA;
    if (ph == P_PRO) { scan(ws + WS_HBF, SD, 0); scan(out, SD, 1); scan(ws + WS_PBF, (size_t)4 * S_ * PLE, 0); scan(ws + WS_TAB, (size_t)S_ * 16, 1); scan(ws + WS_W, (size_t)44 * MiB, 0); return; }
    if (ph == P_FINAL) return;
    const int L = (ph - 1) / LPN, lp = (ph - 1) % LPN; const bool odd = L & 1;
    switch (lp) {
    case LP_PROJ: if (!odd) scan(ar + AR_PE, (size_t)S_ * EIN, 0); else { scan(ar + AR_PO, (size_t)S_ * OIN, 0); scan(ws + WS_GB, (size_t)S_ * 16, 1); } scan(ws + WS_PP, SD, 0); break;
    case LP_ROT: scan(ar + AR_PE, (size_t)S_ * EIN, 0); break;
    case LP_ATT: scan(ar + AR_AO, SD, 0); break;
    case LP_MIXPREP: case LP_G3: scan(ws + WS_MIX, SD, 0); break;
    case LP_GA: scan(ar + AR_QN, SD * 5, 0); scan(ws + WS_GB, (size_t)S_ * 16, 1); break;
    case LP_G1: scan(ar + AR_AI, (size_t)NUNIT * 4096, 0); scan(ar + AR_NEGW, SD, 0); scan(ar + AR_UT, SD, 0); scan(ar + AR_UT, (size_t)NUNIT * 16384 * 2, 0); break;
    case LP_G2: scan(ar + AR_SG, (size_t)NUNIT * 16384, 0); break;
    case LP_OUT: case LP_DOWN: case LP_COMB: case LP_PLE: scan(out, SD, 1); scan(ws + WS_HBF, SD, 0); scan(ws + ((lp == LP_PLE) ? WS_SSQB : WS_SSQA), (size_t)S_ * 16, 1); break;
    case LP_UP: scan(ar + AR_ACT, (size_t)S_ * DFF, 0); break;
    case LP_R1: scan(ws + WS_TOK + TOK_G, (size_t)S_ * 2, 1); break;
    default: break; }
}
#endif
#ifndef MK_MULTI
#define MK_MULTI 0
#endif
extern "C" void kernel_launch(void* const* d_in, const int* in_sizes, int n_in, void* d_out, int out_size, void* d_ws, size_t ws_size, hipStream_t stream) {
    static int grid = 0;
    if (grid == 0) {
        if (n_in != 30 || out_size != S_ * D_ || ws_size < WS_NEED) { fprintf(stderr, "kernel_launch: unexpected problem (n_in %d, out %d, ws %zu < %zu)\n", n_in, out_size, ws_size, (size_t)WS_NEED); grid = -1; return; }
        int dev = 0, cus = 0, per_cu = 0;
        if (hipGetDevice(&dev) != hipSuccess || hipDeviceGetAttribute(&cus, hipDeviceAttributeMultiprocessorCount, dev) != hipSuccess) { grid = -1; return; }
        if (hipFuncSetAttribute((const void*)fwd, hipFuncAttributeMaxDynamicSharedMemorySize, LDS_BYTES) != hipSuccess) { fprintf(stderr, "kernel_launch: hipFuncSetAttribute failed\n"); grid = -1; return; }
        if (hipOccupancyMaxActiveBlocksPerMultiprocessor(&per_cu, (const void*)fwd, NWAVES * 64, LDS_BYTES) != hipSuccess || per_cu < 1) { fprintf(stderr, "kernel_launch: occupancy query says %d\n", per_cu); }
        (void)hipGetLastError();
        grid = cus;
#if DBG
        (void)hipFuncSetAttribute((const void*)chk_gdn_rec, hipFuncAttributeMaxDynamicSharedMemorySize, 72 * 1024);
#endif
    }
    if (grid < 0) return;
    (void)hipMemsetAsync((char*)d_ws + WS_CTL, 0, CTL_ZERO_BYTES, stream);
    Args a{};
    for (int i = 0; i < 30; ++i) a.in[i] = d_in[i];
    a.out = (float*)d_out; a.ws = (unsigned char*)d_ws; a.pad = 0;
#if MK_MULTI
    a.use_bar = 0;
    static const int seq_even[] = {LP_PROJ, LP_ATT, LP_MIXPREP, LP_OUT, LP_UP, LP_DOWN, LP_PLE};
    static const int seq_odd[] = {LP_PROJ, LP_GA, LP_G2, LP_G3, LP_OUT, LP_R1, LP_R2, LP_M1, LP_M2, LP_COMB, LP_PLE};
    int plist[64], np = 0; plist[np++] = P_PRO;
    for (int L = 0; L < DEPTH_; ++L) { const bool odd = L & 1; const int n = odd ? 11 : 7; for (int q = 0; q < n; ++q) plist[np++] = 1 + LPN * L + (odd ? seq_odd[q] : seq_even[q]); }
    plist[np++] = P_FINAL;
    for (int pi = 0; pi < np; ++pi) { const int ph = plist[pi];
        a.ph_lo = ph; a.ph_hi = ph + 1;
#if DBG
        dbg_before_phase(ph, (unsigned char*)d_ws, (float*)d_out, stream);
#endif
        hipLaunchKernelGGL(fwd, dim3(grid), dim3(NWAVES * 64), LDS_BYTES, stream, a);
#if DBG
        dbg_after_phase(ph, (unsigned char*)d_ws, (float*)d_out, stream); dbg_checks(ph, d_in, (unsigned char*)d_ws, (float*)d_out, stream);
#endif
    }
#if DBG
    hipLaunchKernelGGL(dbg_fill, dim3(1024), dim3(256), 0, stream, (float*)d_out, (size_t)S_ * D_, (const unsigned*)((unsigned char*)d_ws + WS_CTL) + CW_DBG, P_FINAL + 1);
#endif
#else
    a.use_bar = 1; a.ph_lo = 0; a.ph_hi = P_FINAL + 1;
    hipLaunchKernelGGL(fwd, dim3(grid), dim3(NWAVES * 64), LDS_BYTES, stream, a);
#ifdef PROBE_PH
    for (int i = 0; i < PROBE_N; ++i) { a.use_bar = 0; a.ph_lo = PROBE_PH; a.ph_hi = PROBE_PH + 1; hipLaunchKernelGGL(fwd, dim3(grid), dim3(NWAVES * 64), LDS_BYTES, stream, a); }
#endif
#endif
    const hipError_t le = hipPeekAtLastError();
    if (le != hipSuccess) fprintf(stderr, "kernel_launch: launch failed: %s\n", hipGetErrorName(le));
}
```
